# Optimizing an MI355X kernel written in HIP

```python
import math
import jax, jax.numpy as jnp
from jax import lax
import numpy as np

D_MODEL = 1024
BATCH = 8
SEQ = 2048
DEPTH = 4

GRID_W = 64
CTX_LEN = 256
MIX = D_MODEL
N_MIXERS = 4
W_GROUP = MIX // N_MIXERS
HEAD_DIM = 64
N_HEADS = W_GROUP // HEAD_DIM
ATT_KV_HEADS = 2
ATT_GROUPS = N_HEADS // ATT_KV_HEADS
WINDOW = 128
ATT_BLOCK = 128
CHUNK = 64
GLA_RANK = 16
GLA_NORMALIZER = 16.0
HYENA_BANDS = 16
HYENA_EMB = 1 + 2 * HYENA_BANDS
HYENA_FFN = 64
HYENA_MIN_DECAY = math.log(1e-2) / 1.5
HYENA_MAX_DECAY = math.log(1e-2) / 0.3
SHORT_CONV = 3
ROPE_BASE = 10000.0
ROPE_AXIS_FREQS = HEAD_DIM // 4
EPS = 1e-6

MLSTM_COLS = (W_GROUP, W_GROUP, W_GROUP, W_GROUP, W_GROUP, 4 * N_HEADS)
HYENA_COLS = (W_GROUP, W_GROUP, W_GROUP, W_GROUP)
GLA_COLS = (W_GROUP, W_GROUP, W_GROUP, W_GROUP, GLA_RANK, GLA_RANK)
ATT_COLS = (W_GROUP, ATT_KV_HEADS * HEAD_DIM, ATT_KV_HEADS * HEAD_DIM, W_GROUP)
GROUP_COLS = (sum(MLSTM_COLS), sum(HYENA_COLS), sum(GLA_COLS), sum(ATT_COLS))
N_IN = sum(GROUP_COLS)

kernel_name = "hybrid_parallel_heads_flow_backbone"

F32 = jnp.float32


def split_cols(p, sizes):
    out, start = [], 0
    for s in sizes:
        out.append(p[..., start:start + s])
        start += s
    return out


def rms_norm(x, g):
    x32 = x.astype(F32)
    y = x32 * lax.rsqrt(jnp.mean(x32 * x32, axis=-1, keepdims=True) + EPS)
    return (y * g.astype(F32)).astype(x.dtype)


def head_rms_norm(h, g):
    b_, l_, _ = h.shape
    hh = h.reshape(b_, l_, N_HEADS, HEAD_DIM)
    hh = hh * lax.rsqrt(jnp.mean(hh * hh, axis=-1, keepdims=True) + EPS)
    return hh.reshape(b_, l_, W_GROUP) * g.astype(F32)


def to_heads(a):
    b_, l_, _ = a.shape
    return a.reshape(b_, l_, -1, HEAD_DIM).transpose(0, 2, 1, 3)


def from_heads(h):
    b_, h_, l_, d_ = h.shape
    return h.transpose(0, 2, 1, 3).reshape(b_, l_, h_ * d_)


def to_chunks(a):
    nc = a.shape[2] // CHUNK
    return jnp.moveaxis(a.reshape(a.shape[:2] + (nc, CHUNK) + a.shape[3:]), 2, 0)


def from_chunks(h):
    h = jnp.moveaxis(h, 0, 2)
    return h.reshape(h.shape[:2] + (h.shape[2] * h.shape[3],) + h.shape[4:])


def mlstm_chunks(q, k, v, i_pre, f_pre, state):
    tri = jnp.tril(jnp.ones((CHUNK, CHUNK), bool))

    def step(carry, inp):
        c_prev, n_prev, m_prev = carry
        qb, kb, vb, ib, fb = inp
        b = jnp.cumsum(jax.nn.log_sigmoid(fb), axis=-1)
        d = jnp.where(tri, b[..., :, None] - b[..., None, :] + ib[..., None, :], -jnp.inf)
        inter = b + m_prev[..., None]
        m = jnp.maximum(inter, jnp.max(d, axis=-1))
        w_intra = jnp.exp(d - m[..., None])
        w_inter = jnp.exp(inter - m)
        s = jnp.einsum('bhtd,bhsd->bhts', qb, kb) * w_intra
        num = w_inter[..., None] * jnp.einsum('bhtd,bhde->bhte', qb, c_prev) + jnp.einsum('bhts,bhse->bhte', s, vb)
        den = w_inter * jnp.einsum('bhtd,bhd->bht', qb, n_prev) + jnp.sum(s, axis=-1)
        h = num / jnp.maximum(jnp.abs(den), jnp.exp(-m))[..., None]
        b_end = b[..., -1]
        g = b_end[..., None] - b + ib
        m_new = jnp.maximum(b_end + m_prev, jnp.max(g, axis=-1))
        a_prev = jnp.exp(b_end + m_prev - m_new)
        w_s = jnp.exp(g - m_new[..., None])
        c_new = a_prev[..., None, None] * c_prev + jnp.einsum('bhs,bhsd,bhse->bhde', w_s, kb, vb)
        n_new = a_prev[..., None] * n_prev + jnp.einsum('bhs,bhsd->bhd', w_s, kb)
        return (c_new, n_new, m_new), h

    state, h = lax.scan(step, state, tuple(to_chunks(a) for a in (q, k, v, i_pre, f_pre)))
    return from_chunks(h), state


def gla_chunks(q, k, v, log_a, state):
    tri = jnp.tril(jnp.ones((CHUNK, CHUNK), bool))[:, :, None]

    def step(s_prev, inp):
        qb, kb, vb, ab = inp
        b = jnp.cumsum(ab, axis=2)
        o_inter = jnp.einsum('bhtd,bhde->bhte', qb * jnp.exp(b), s_prev)
        decay = jnp.exp(jnp.where(tri, b[:, :, :, None, :] - b[:, :, None, :, :], -jnp.inf))
        att = jnp.einsum('bhtd,bhsd,bhtsd->bhts', qb, kb, decay)
        o = o_inter + jnp.einsum('bhts,bhse->bhte', att, vb)
        b_end = b[:, :, -1]
        s_new = jnp.exp(b_end)[..., None] * s_prev + jnp.einsum(
            'bhsd,bhse->bhde', kb * jnp.exp(b_end[:, :, None, :] - b), vb)
        return s_new, o

    state, o = lax.scan(step, state, tuple(to_chunks(a) for a in (q, k, v, log_a)))
    return from_chunks(o), state


def run_direction(scan_fn, ctx_in, lat_in, state0, reverse):
    if reverse:
        ctx_in = tuple(jnp.flip(a, axis=2) for a in ctx_in)
        lat_in = tuple(jnp.flip(a, axis=2) for a in lat_in)
    h_c, state = scan_fn(*ctx_in, state0)
    h_x, _ = scan_fn(*lat_in, state)
    if reverse:
        h_c, h_x = jnp.flip(h_c, axis=2), jnp.flip(h_x, axis=2)
    return h_c, h_x


def mlstm_branch(pc, px, gate_b, norm_g):
    def prep(p):
        q, k, v, o, gate, gts = split_cols(p, MLSTM_COLS)
        b_, l_, _ = p.shape
        gts = gts.astype(F32).reshape(b_, l_, 4, N_HEADS) + gate_b.astype(F32)
        gts = jnp.transpose(gts, (2, 0, 3, 1))
        qkv = (to_heads(q).astype(F32), to_heads(k).astype(F32) * HEAD_DIM ** -0.5, to_heads(v).astype(F32))
        return qkv, gts, o, gate

    qkv_c, gts_c, o_c, gate_c = prep(pc)
    qkv_x, gts_x, o_x, gate_x = prep(px)
    b_ = px.shape[0]
    state0 = (jnp.zeros((b_, N_HEADS, HEAD_DIM, HEAD_DIM), F32), jnp.zeros((b_, N_HEADS, HEAD_DIM), F32),
              jnp.zeros((b_, N_HEADS), F32))
    hc_f, hx_f = run_direction(mlstm_chunks, qkv_c + (gts_c[0], gts_c[1]), qkv_x + (gts_x[0], gts_x[1]), state0, False)
    hc_b, hx_b = run_direction(mlstm_chunks, qkv_c + (gts_c[2], gts_c[3]), qkv_x + (gts_x[2], gts_x[3]), state0, True)

    def finish(h, o, gate, dtype):
        h = from_heads(h) * jax.nn.sigmoid(o.astype(F32))
        return (head_rms_norm(h, norm_g) * jax.nn.silu(gate.astype(F32))).astype(dtype)

    return finish(hc_f + hc_b, o_c, gate_c, pc.dtype), finish(hx_f + hx_b, o_x, gate_x, px.dtype)


def gla_branch(pc, px, w_alpha, b_alpha, norm_g):
    def prep(p):
        q, k, v, gate, r_f, r_b = split_cols(p, GLA_COLS)
        qkv = (to_heads(q).astype(F32) * HEAD_DIM ** -0.5, to_heads(k).astype(F32), to_heads(v).astype(F32))
        log_a = [to_heads(jax.nn.log_sigmoid((r @ w_alpha[d] + b_alpha[d]).astype(F32)) / GLA_NORMALIZER)
                 for d, r in enumerate((r_f, r_b))]
        return qkv, log_a, gate

    qkv_c, la_c, gate_c = prep(pc)
    qkv_x, la_x, gate_x = prep(px)
    state0 = jnp.zeros((px.shape[0], N_HEADS, HEAD_DIM, HEAD_DIM), F32)
    hc_f, hx_f = run_direction(gla_chunks, qkv_c + (la_c[0],), qkv_x + (la_x[0],), state0, False)
    hc_b, hx_b = run_direction(gla_chunks, qkv_c + (la_c[1],), qkv_x + (la_x[1],), state0, True)

    def finish(h, gate, dtype):
        return (head_rms_norm(from_heads(h), norm_g) * jax.nn.silu(gate.astype(F32))).astype(dtype)

    return finish(hc_f + hc_b, gate_c, pc.dtype), finish(hx_f + hx_b, gate_x, px.dtype)


def short_conv(u, w, b):
    l_ = u.shape[1]
    up = jnp.pad(u, ((0, 0), (SHORT_CONV // 2, SHORT_CONV // 2), (0, 0)))
    return sum(w[j] * up[:, j:j + l_] for j in range(SHORT_CONV)) + b


def hyena_filter_spectrum(l_, w1, b1, w2, b2, w3, b3, freq):
    pos = jnp.arange(l_, dtype=F32)
    t = pos / max(l_ - 1, 1)
    w = 2.0 * math.pi * pos / l_
    f = jnp.linspace(1e-4, HYENA_BANDS - 1, HYENA_BANDS, dtype=F32)
    z = jnp.concatenate([t[:, None], jnp.cos(w[:, None] * f), -jnp.sin(w[:, None] * f)], axis=-1)
    h = jnp.sin(freq[0].astype(F32) * (z @ w1.astype(F32) + b1.astype(F32)))
    h = jnp.sin(freq[1].astype(F32) * (h @ w2.astype(F32) + b2.astype(F32)))
    h = (h @ w3.astype(F32) + b3.astype(F32)).reshape(l_, 2, W_GROUP)
    deltas = jnp.abs(jnp.linspace(HYENA_MIN_DECAY, HYENA_MAX_DECAY, W_GROUP, dtype=F32))
    h = h * jnp.exp(-t[:, None, None] * deltas)
    kernel = jnp.concatenate([h[:, 0], jnp.zeros((1, W_GROUP), F32), h[:0:-1, 1]], axis=0)
    return jnp.fft.rfft(kernel, n=2 * l_, axis=0)


def fftconv(u, k_f, d):
    l_ = u.shape[1]
    u32 = u.astype(F32)
    y = jnp.fft.irfft(jnp.fft.rfft(u32, n=2 * l_, axis=1) * k_f, n=2 * l_, axis=1)[:, :l_]
    return y + u32 * d.astype(F32)


def hyena_branch(p, conv_w, conv_b, w1, b1, w2, b2, w3, b3, freq, d):
    v, x1, x0, gate = split_cols(p, HYENA_COLS)
    u = short_conv(jnp.concatenate([v, x1, x0], axis=-1), conv_w, conv_b)
    v, x1, x0 = split_cols(u, (W_GROUP, W_GROUP, W_GROUP))
    k_f = hyena_filter_spectrum(p.shape[1], w1, b1, w2, b2, w3, b3, freq)
    y = x0.astype(F32) * fftconv(v * x1, k_f, d)
    return (y * jax.nn.silu(gate.astype(F32))).astype(p.dtype)


def rope_2d(x):
    l_ = x.shape[1]
    rows = l_ // GRID_W
    row = jnp.repeat(jnp.arange(rows, dtype=F32), GRID_W)
    col = jnp.tile(jnp.arange(GRID_W, dtype=F32), rows)
    inv = ROPE_BASE ** (-jnp.arange(ROPE_AXIS_FREQS, dtype=F32) / ROPE_AXIS_FREQS)
    ang = jnp.concatenate([row[:, None] * inv, col[:, None] * inv], axis=-1)[:, None, :]
    cos, sin = jnp.cos(ang), jnp.sin(ang)
    x32 = x.astype(F32)
    x1, x2 = x32[..., :HEAD_DIM // 2], x32[..., HEAD_DIM // 2:]
    return jnp.concatenate([x1 * cos - x2 * sin, x2 * cos + x1 * sin], axis=-1).astype(x.dtype)


def attn_branch(pc, px, sink, need_ctx_out):
    b_, l_, _ = px.shape
    lc = pc.shape[1]
    q, k, v, gate = split_cols(px, ATT_COLS)
    q_c, k_c, v_c, gate_c = split_cols(pc, ATT_COLS)
    scale = HEAD_DIM ** -0.5
    q = rope_2d(q.reshape(b_, l_, N_HEADS, HEAD_DIM))
    k = rope_2d(k.reshape(b_, l_, ATT_KV_HEADS, HEAD_DIM))
    v = v.reshape(b_, l_, ATT_KV_HEADS, HEAD_DIM)
    kc = k_c.reshape(b_, lc, ATT_KV_HEADS, HEAD_DIM)
    vc = v_c.reshape(b_, lc, ATT_KV_HEADS, HEAD_DIM).astype(F32)
    sink_g = sink.astype(F32).reshape(ATT_KV_HEADS, ATT_GROUPS)

    nb = l_ // ATT_BLOCK
    qb = q.reshape(b_, nb, ATT_BLOCK, ATT_KV_HEADS, ATT_GROUPS, HEAD_DIM)

    def band(a):
        ap = jnp.pad(a, ((0, 0), (WINDOW, WINDOW), (0, 0), (0, 0))).reshape(b_, nb + 2, ATT_BLOCK, ATT_KV_HEADS, HEAD_DIM)
        return jnp.concatenate([ap[:, :-2], ap[:, 1:-1], ap[:, 2:]], axis=2)

    kb, vb = band(k), band(v).astype(F32)
    qi = jnp.arange(ATT_BLOCK)
    si = jnp.arange(3 * ATT_BLOCK)
    blk = jnp.arange(nb)
    rel = si[None, :] - ATT_BLOCK - qi[:, None]
    key_pos = blk[:, None] * ATT_BLOCK - ATT_BLOCK + si[None, :]
    mask = (jnp.abs(rel) <= WINDOW)[None] & ((key_pos >= 0) & (key_pos < l_))[:, None, :]
    s_loc = jnp.einsum('bnqkgd,bnskd->bnkgqs', qb, kb).astype(F32) * scale
    s_loc = jnp.where(mask[None, :, None, None], s_loc, -jnp.inf)
    s_ctx = jnp.einsum('bnqkgd,bckd->bnkgqc', qb, kc).astype(F32) * scale
    s_sink = jnp.broadcast_to(sink_g[None, None, :, :, None, None], s_loc.shape[:-1] + (1,))
    p = jax.nn.softmax(jnp.concatenate([s_loc, s_ctx, s_sink], axis=-1), axis=-1)
    o = jnp.einsum('bnkgqs,bnskd->bnqkgd', p[..., :3 * ATT_BLOCK], vb) + jnp.einsum(
        'bnkgqc,bckd->bnqkgd', p[..., 3 * ATT_BLOCK:3 * ATT_BLOCK + lc], vc)
    o = o.reshape(b_, l_, W_GROUP) * jax.nn.silu(gate.astype(F32))
    out_x = o.astype(px.dtype)

    out_c = None
    if need_ctx_out:
        qc = q_c.reshape(b_, lc, ATT_KV_HEADS, ATT_GROUPS, HEAD_DIM)
        s = jnp.einsum('bqkgd,bckd->bkgqc', qc, kc).astype(F32) * scale
        s_sink_c = jnp.broadcast_to(sink_g[None, :, :, None, None], s.shape[:-1] + (1,))
        pcx = jax.nn.softmax(jnp.concatenate([s, s_sink_c], axis=-1), axis=-1)
        oc = jnp.einsum('bkgqc,bckd->bqkgd', pcx[..., :lc], vc).reshape(b_, lc, W_GROUP)
        out_c = (oc * jax.nn.silu(gate_c.astype(F32))).astype(pc.dtype)
    return out_c, out_x


def setup_inputs(seed: int = 0) -> dict:
    key = jax.random.key(seed)
    ks = jax.random.split(key, 32)

    def nrm(k, shape, s):
        return jax.random.normal(k, shape, jnp.float32) * s

    f_bias = jnp.linspace(3.0, 6.0, N_HEADS, dtype=jnp.float32)
    mlstm_gate_b = jnp.stack([nrm(ks[9], (DEPTH, N_HEADS), 0.1),
                              f_bias + nrm(ks[10], (DEPTH, N_HEADS), 0.1),
                              nrm(ks[11], (DEPTH, N_HEADS), 0.1),
                              f_bias + nrm(ks[12], (DEPTH, N_HEADS), 0.1)], axis=1)
    return {
        "x": nrm(ks[0], (BATCH, SEQ, D_MODEL), 1.0),
        "c": nrm(ks[1], (BATCH, D_MODEL), 1.0),
        "ctx": nrm(ks[2], (BATCH, CTX_LEN, D_MODEL), 1.0),
        "c_ctx": nrm(ks[3], (D_MODEL,), 1.0),
        "w_ada": nrm(ks[4], (DEPTH, D_MODEL, 3 * D_MODEL), 0.5 * D_MODEL ** -0.5),
        "b_ada": nrm(ks[5], (DEPTH, 3 * D_MODEL), 0.02),
        "g_pre": 1.0 + nrm(ks[6], (DEPTH, D_MODEL), 0.05),
        "g_post": 1.0 + nrm(ks[7], (DEPTH, D_MODEL), 0.05),
        "w_in": nrm(ks[8], (DEPTH, D_MODEL, N_IN), D_MODEL ** -0.5),
        "mlstm_gate_b": mlstm_gate_b,
        "mlstm_norm_g": 1.0 + nrm(ks[13], (DEPTH, W_GROUP), 0.05),
        "hyena_conv_w": nrm(ks[14], (DEPTH, SHORT_CONV, 3 * W_GROUP), 0.5),
        "hyena_conv_b": nrm(ks[15], (DEPTH, 3 * W_GROUP), 0.02),
        "hyena_w1": nrm(ks[16], (DEPTH, HYENA_EMB, HYENA_FFN), HYENA_EMB ** -0.5),
        "hyena_b1": nrm(ks[17], (DEPTH, HYENA_FFN), 0.1),
        "hyena_w2": nrm(ks[18], (DEPTH, HYENA_FFN, HYENA_FFN), HYENA_FFN ** -0.5),
        "hyena_b2": nrm(ks[19], (DEPTH, HYENA_FFN), 0.1),
        "hyena_w3": nrm(ks[20], (DEPTH, HYENA_FFN, 2 * W_GROUP), 0.02),
        "hyena_b3": nrm(ks[21], (DEPTH, 2 * W_GROUP), 0.01),
        "hyena_freq": 1.0 + nrm(ks[22], (DEPTH, 2, HYENA_FFN), 0.1),
        "hyena_d": nrm(ks[23], (DEPTH, W_GROUP), 0.5),
        "gla_w_alpha": nrm(ks[24], (DEPTH, 2, GLA_RANK, W_GROUP), GLA_RANK ** -0.5),
        "gla_b_alpha": nrm(ks[25], (DEPTH, 2, W_GROUP), 0.1),
        "gla_norm_g": 1.0 + nrm(ks[26], (DEPTH, W_GROUP), 0.05),
        "attn_sink": nrm(ks[27], (DEPTH, N_HEADS), 0.5),
        "w_out": nrm(ks[28], (DEPTH, MIX, D_MODEL), MIX ** -0.5),
    }


def reference(x, c, ctx, c_ctx, w_ada, b_ada, g_pre, g_post, w_in, mlstm_gate_b, mlstm_norm_g,
              hyena_conv_w, hyena_conv_b, hyena_w1, hyena_b1, hyena_w2, hyena_b2, hyena_w3, hyena_b3,
              hyena_freq, hyena_d, gla_w_alpha, gla_b_alpha, gla_norm_g, attn_sink, w_out):
    for l in range(DEPTH):
        need_ctx_out = l < DEPTH - 1
        mod_x = jax.nn.silu(c) @ w_ada[l] + b_ada[l]
        mod_c = jax.nn.silu(c_ctx) @ w_ada[l] + b_ada[l]
        sh_x, sc_x, gt_x = split_cols(mod_x[:, None, :], (D_MODEL, D_MODEL, D_MODEL))
        sh_c, sc_c, gt_c = split_cols(mod_c, (D_MODEL, D_MODEL, D_MODEL))
        hx = rms_norm(x, g_pre[l]) * (1.0 + sc_x) + sh_x
        hc = rms_norm(ctx, g_pre[l]) * (1.0 + sc_c) + sh_c
        px_a, px_h, px_g, px_d = split_cols(hx @ w_in[l], GROUP_COLS)
        pc_a, pc_h, pc_g, pc_d = split_cols(hc @ w_in[l], GROUP_COLS)

        a_c, a_x = mlstm_branch(pc_a, px_a, mlstm_gate_b[l], mlstm_norm_g[l])
        hy_args = (hyena_conv_w[l], hyena_conv_b[l], hyena_w1[l], hyena_b1[l], hyena_w2[l], hyena_b2[l],
                   hyena_w3[l], hyena_b3[l], hyena_freq[l], hyena_d[l])
        h_x = hyena_branch(px_h, *hy_args)
        g_c, g_x = gla_branch(pc_g, px_g, gla_w_alpha[l], gla_b_alpha[l], gla_norm_g[l])
        d_c, d_x = attn_branch(pc_d, px_d, attn_sink[l], need_ctx_out)

        y_x = jnp.concatenate([a_x, h_x, g_x, d_x], axis=-1) @ w_out[l]
        x = x + gt_x * rms_norm(y_x, g_post[l])
        if need_ctx_out:
            h_c = hyena_branch(pc_h, *hy_args)
            y_c = jnp.concatenate([a_c, h_c, g_c, d_c], axis=-1) @ w_out[l]
            ctx = ctx + gt_c * rms_norm(y_c, g_post[l])
    return x
```

```cpp
#ifdef EMU
#include "emu/hipemu.h"
#define GRID_SYNC() emu::grid_sync()
#define SMEM_DECL char* smem = emu::S().blocks[emu::cur()->block].lds
#define MFMA16(a, b, c) emu_mfma_16x16x32_bf16(a, b, c)
#else
#include <hip/hip_runtime.h>
#include <hip/hip_cooperative_groups.h>
#include <cstdio>
#include <cstdint>
#define GRID_SYNC() cooperative_groups::this_grid().sync()
#define SMEM_DECL extern __shared__ __attribute__((aligned(16))) char smem[]
#define MFMA16(a, b, c) __builtin_amdgcn_mfma_f32_16x16x32_bf16(a, b, c, 0, 0, 0)
#endif

#ifdef EMU
#ifndef EMU_DM
#define EMU_DM 256
#endif
#ifndef EMU_NB
#define EMU_NB 2
#endif
#ifndef EMU_SEQ
#define EMU_SEQ 512
#endif
#ifndef EMU_DEPTH
#define EMU_DEPTH 2
#endif
#ifndef EMU_CTXL
#define EMU_CTXL 128
#endif
constexpr int DM = EMU_DM, NB = EMU_NB, SEQ = EMU_SEQ, DEPTH = EMU_DEPTH, CTXL = EMU_CTXL;
#else
constexpr int DM = 1024, NB = 8, SEQ = 2048, DEPTH = 4, CTXL = 256;
#endif
constexpr int MIX = 1024, WG = 256, HD = 64, NH = 4, CH = 64;
constexpr int TOK = CTXL + SEQ, T = NB * TOK, NCH = TOK / CH, NCC = CTXL / CH;
constexpr int N_IN = 4144, NP = 4096, NG = 48, NPAD = 4224;
constexpr int NF = 2 * SEQ;
constexpr int NJ = NB + 1;
constexpr int NT = 512;
constexpr float EPS = 1e-6f;
constexpr int PA = 0, PH = 1280, PG = 2304, PD = 3328;
constexpr int YA = 0, YH = 256, YG = 512, YD = 768;
constexpr int ilog4(int n) { return n <= 1 ? 0 : 1 + ilog4(n / 4); }
constexpr int FFT_P = ilog4(NF);
static_assert((1 << (2 * FFT_P)) == NF, "NF must be a power of 4");
static_assert(DM % 256 == 0 && CTXL % 128 == 0 && SEQ % 256 == 0, "shape constraints");

typedef unsigned short bf16;
typedef short bf16x8 __attribute__((ext_vector_type(8)));
typedef float f32x4 __attribute__((ext_vector_type(4)));
typedef unsigned u32x4 __attribute__((ext_vector_type(4)));
typedef unsigned u32x2 __attribute__((ext_vector_type(2)));
struct cpx { float x, y; };

constexpr size_t al256(size_t x) { return (x + 255) & ~(size_t)255; }
constexpr size_t WS_CTXB = 0;
constexpr size_t WS_HNY = al256(WS_CTXB + (size_t)NB * CTXL * DM * 4);
constexpr size_t WS_P = al256(WS_HNY + (size_t)T * 1024 * 2);
constexpr size_t WS_G = al256(WS_P + (size_t)T * NP * 2);
constexpr size_t WS_WIN = al256(WS_G + (size_t)T * NG * 4);
constexpr size_t WS_WOUT = al256(WS_WIN + (size_t)NPAD * DM * 2);
constexpr size_t WS_KT = al256(WS_WOUT + (size_t)DM * MIX * 2);
constexpr size_t WS_KF = al256(WS_KT + (size_t)WG * NF * 4);
constexpr size_t WS_HC = al256(WS_KF + (size_t)WG * NF * 8);
constexpr size_t WS_ST = al256(WS_HC + (size_t)2 * WG * CTXL * 4);
constexpr size_t WS_NV = al256(WS_ST + (size_t)2 * 2 * NB * NH * NCH * 4096 * 2);
constexpr size_t WS_BE = al256(WS_NV + (size_t)2 * NB * NH * NCH * 64 * 4);
constexpr size_t WS_SC = al256(WS_BE + (size_t)2 * NB * NH * NCH * 64 * 4);
constexpr size_t WS_MOD = al256(WS_SC + (size_t)2 * NB * NH * NCH * 4 * 4);
constexpr size_t WS_TW = al256(WS_MOD + (size_t)DEPTH * NJ * 3 * DM * 4);
constexpr size_t WS_ROPE = al256(WS_TW + (size_t)NF * 8);
constexpr size_t WS_TOTAL = al256(WS_ROPE + (size_t)SEQ * 32 * 8);
static_assert((size_t)T * DM * 4 <= (size_t)T * NP * 2, "YO fits in P");
#ifndef EMU
static_assert(WS_TOTAL <= (size_t)268435456, "workspace map must fit 256 MiB");
#endif

constexpr int LDS_BYTES = 90112;

struct Params {
    const float* in[26];
    float* out;
    char* ws;
};
enum { I_X = 0, I_C, I_CTX, I_CCTX, I_WADA, I_BADA, I_GPRE, I_GPOST, I_WIN, I_MGB, I_MNG, I_HCW, I_HCB, I_HW1, I_HB1, I_HW2, I_HB2, I_HW3, I_HB3,
       I_HFREQ, I_HD, I_GWA, I_GBA, I_GNG, I_SINK, I_WOUT };


#ifdef EMU
__device__ __forceinline__ int otid() { return (int)threadIdx.x; }
__device__ __forceinline__ int obid() { return (int)blockIdx.x; }
#else
__device__ __forceinline__ int otid() { int t = (int)threadIdx.x; asm volatile("" : "+v"(t)); return t; }
__device__ __forceinline__ int obid() { int b = (int)blockIdx.x; asm volatile("" : "+s"(b)); return b; }
#endif
__device__ __forceinline__ unsigned fbits(float f) { return __builtin_bit_cast(unsigned, f); }
__device__ __forceinline__ float bitsf(unsigned u) { return __builtin_bit_cast(float, u); }
__device__ __forceinline__ bf16 f2bf(float f) { unsigned u = fbits(f); return (bf16)((u + 0x7fffu + ((u >> 16) & 1u)) >> 16); }
__device__ __forceinline__ float bf2f(bf16 h) { return bitsf((unsigned)h << 16); }
__device__ __forceinline__ unsigned pk2(float lo, float hi) { return (unsigned)f2bf(lo) | ((unsigned)f2bf(hi) << 16); }
__device__ __forceinline__ float sigmoidf_(float x) { return 1.0f / (1.0f + __expf(-x)); }
__device__ __forceinline__ float siluf_(float x) { return x / (1.0f + __expf(-x)); }
__device__ __forceinline__ float logsigf_(float x) { return fminf(x, 0.0f) - log1pf(__expf(-fabsf(x))); }
__device__ __forceinline__ float wave_sum(float v) {
#pragma unroll
    for (int o = 1; o < 64; o <<= 1) v += __shfl_xor(v, o);
    return v;
}
__device__ __forceinline__ float wave_max(float v) {
#pragma unroll
    for (int o = 1; o < 64; o <<= 1) v = fmaxf(v, __shfl_xor(v, o));
    return v;
}
__device__ __forceinline__ float wave_prefix_sum(float v, int lane) {
#pragma unroll
    for (int o = 1; o < 64; o <<= 1) { float t = __shfl_up(v, o); if (lane >= o) v += t; }
    return v;
}
__device__ __forceinline__ float wave_prefix_max(float v, int lane) {
#pragma unroll
    for (int o = 1; o < 64; o <<= 1) { float t = __shfl_up(v, o); if (lane >= o) v = fmaxf(v, t); }
    return v;
}
__device__ __forceinline__ float wave_suffix_max(float v, int lane) {
#pragma unroll
    for (int o = 1; o < 64; o <<= 1) { float t = __shfl_down(v, o); if (lane + o < 64) v = fmaxf(v, t); }
    return v;
}
__device__ __forceinline__ void unpack8(u32x4 v, float* f) {
    f[0] = bitsf(v.x << 16); f[1] = bitsf(v.x & 0xffff0000u); f[2] = bitsf(v.y << 16); f[3] = bitsf(v.y & 0xffff0000u);
    f[4] = bitsf(v.z << 16); f[5] = bitsf(v.z & 0xffff0000u); f[6] = bitsf(v.w << 16); f[7] = bitsf(v.w & 0xffff0000u);
}
__device__ __forceinline__ int orig_col(int n) {
    if (n < 1280) return n;
    if (n < 2304) return 1296 + (n - 1280);
    if (n < 3328) return 2320 + (n - 2304);
    if (n < 4096) return 3376 + (n - 3328);
    if (n < 4112) return 1280 + (n - 4096);
    if (n < 4144) return 3344 + (n - 4112);
    return -1;
}
__device__ __forceinline__ int chain_cid(int dir, int o) {
    if (dir == 0) return o;
    return o < NCC ? (NCC - 1 - o) : (NCH - 1 - (o - NCC));
}

constexpr int LS = 72;

template <int NTL, int KS>
__device__ __forceinline__ void mma_nt(const bf16* A, int lda, int m0, const bf16* B, int ldb, int n0, f32x4 (&acc)[NTL], int lane) {
    const int r = lane & 15, q = lane >> 4;
#pragma unroll
    for (int ks = 0; ks < KS; ++ks) {
        const bf16x8 a = *(const bf16x8*)(A + (m0 + r) * lda + ks * 32 + q * 8);
#pragma unroll
        for (int nt = 0; nt < NTL; ++nt) {
            const bf16x8 b = *(const bf16x8*)(B + (n0 + nt * 16 + r) * ldb + ks * 32 + q * 8);
            acc[nt] = MFMA16(a, b, acc[nt]);
        }
    }
}

__device__ void phase0(const Params& p, char* smem) {
    const int tid = otid();
    cpx* TW = (cpx*)(p.ws + WS_TW);
    cpx* ROPE = (cpx*)(p.ws + WS_ROPE);
    float* MOD = (float*)(p.ws + WS_MOD);
    constexpr int N_TW = NF / NT, N_ROPE = SEQ * 32 / NT, N_MOD = DEPTH * (3 * DM / 64);
    for (int task = obid(); task < N_TW + N_ROPE + N_MOD; task += gridDim.x) {
        if (task < N_TW) {
            const int j = task * NT + tid; float s, c; sincospif(2.0f * (float)j / (float)NF, &s, &c);
            cpx v; v.x = c; v.y = -s; TW[j] = v;
        } else if (task < N_TW + N_ROPE) {
            const int idx = (task - N_TW) * NT + tid; const int pos = idx >> 5, i = idx & 31;
            const float inv = exp2f(-(float)(i & 15) * (13.287712379549449f / 16.0f));
            const float ang = (float)(i < 16 ? pos / 64 : pos % 64) * inv;
            cpx v; v.x = cosf(ang); v.y = sinf(ang); ROPE[idx] = v;
        } else {
            const int mt = task - N_TW - N_ROPE; const int l = mt / (3 * DM / 64), n0 = (mt % (3 * DM / 64)) * 64;
            float* sv = (float*)smem;
            float* red = sv + NJ * DM;
            __syncthreads();
            for (int i = tid; i < NJ * DM; i += NT) { const int j = i / DM, k = i % DM; const float v = j < NB ? p.in[I_C][j * DM + k] : p.in[I_CCTX][k]; sv[i] = siluf_(v); }
            __syncthreads();
            const int nl = tid & 63, ks = tid >> 6; float acc[NJ];
#pragma unroll
            for (int j = 0; j < NJ; ++j) acc[j] = 0.f;
            const float* w = p.in[I_WADA] + (size_t)l * DM * 3 * DM + n0 + nl;
            for (int k = ks * (DM / 8); k < (ks + 1) * (DM / 8); ++k) { const float wv = w[(size_t)k * 3 * DM];
#pragma unroll
                for (int j = 0; j < NJ; ++j) acc[j] += sv[j * DM + k] * wv; }
#pragma unroll
            for (int j = 0; j < NJ; ++j) red[(ks * NJ + j) * 64 + nl] = acc[j];
            __syncthreads();
            for (int i = tid; i < NJ * 64; i += NT) { const int j = i / 64, n = i % 64; float s = 0.f;
#pragma unroll
                for (int k8 = 0; k8 < 8; ++k8) s += red[(k8 * NJ + j) * 64 + n];
                MOD[((size_t)l * NJ + j) * 3 * DM + n0 + n] = s + p.in[I_BADA][(size_t)l * 3 * DM + n0 + n]; }
        }
    }
}

__device__ void rp_rows(const Params& p, int l) {
    const int tid = otid(), lane = tid & 63, wave = tid >> 6;
    const float* MOD = (const float*)(p.ws + WS_MOD);
    float* CTXB = (float*)(p.ws + WS_CTXB);
    const float* YO = (const float*)(p.ws + WS_P);
    bf16* HN = (bf16*)(p.ws + WS_HNY);
    constexpr int NV4 = DM / 256;
    for (int row = obid() * 8 + wave; row < T; row += gridDim.x * 8) {
        const int b = row / TOK, pp = row % TOK; const bool isctx = pp < CTXL;
        if (l == DEPTH && isctx) continue;
        const size_t off = isctx ? ((size_t)b * CTXL + pp) * DM : ((size_t)b * SEQ + (pp - CTXL)) * DM;
        const float* xo = (l <= 1) ? (isctx ? p.in[I_CTX] + off : p.in[I_X] + off) : (isctx ? CTXB + off : p.out + off);
        float* xn = isctx ? CTXB + off : p.out + off;
        const int mj = isctx ? NB : b;
        f32x4 x[NV4];
#pragma unroll
        for (int j = 0; j < NV4; ++j) x[j] = *(const f32x4*)(xo + 4 * lane + 256 * j);
        if (l > 0) {
            f32x4 y[NV4]; float ss = 0.f;
#pragma unroll
            for (int j = 0; j < NV4; ++j) { y[j] = *(const f32x4*)(YO + (size_t)row * DM + 4 * lane + 256 * j); ss += y[j].x * y[j].x + y[j].y * y[j].y + y[j].z * y[j].z + y[j].w * y[j].w; }
            const float rstd = rsqrtf(wave_sum(ss) * (1.0f / DM) + EPS);
            const float* gt = MOD + ((size_t)(l - 1) * NJ + mj) * 3 * DM + 2 * DM;
            const float* gp = p.in[I_GPOST] + (size_t)(l - 1) * DM;
#pragma unroll
            for (int j = 0; j < NV4; ++j) { const f32x4 g4 = *(const f32x4*)(gt + 4 * lane + 256 * j), p4 = *(const f32x4*)(gp + 4 * lane + 256 * j);
                x[j] = x[j] + g4 * (y[j] * rstd * p4);
                *(f32x4*)(xn + 4 * lane + 256 * j) = x[j]; }
        }
        if (l < DEPTH) {
            float ss = 0.f;
#pragma unroll
            for (int j = 0; j < NV4; ++j) ss += x[j].x * x[j].x + x[j].y * x[j].y + x[j].z * x[j].z + x[j].w * x[j].w;
            const float rstd = rsqrtf(wave_sum(ss) * (1.0f / DM) + EPS);
            const float* md = MOD + ((size_t)l * NJ + mj) * 3 * DM;
            const float* gp = p.in[I_GPRE] + (size_t)l * DM;
#pragma unroll
            for (int j = 0; j < NV4; ++j) { const int e = 4 * lane + 256 * j;
                const f32x4 g4 = *(const f32x4*)(gp + e), sh = *(const f32x4*)(md + e), sc = *(const f32x4*)(md + DM + e);
                const f32x4 h = (x[j] * rstd * g4) * (sc + 1.0f) + sh;
                u32x2 o; o.x = pk2(h.x, h.y); o.y = pk2(h.z, h.w);
                *(u32x2*)(HN + (size_t)row * DM + e) = o; }
        }
    }
}

__device__ void convert_tile(const float* src, int ldn, bf16* dst, int K, int n0, int k0, bool use_map, char* smem) {
    const int tid = otid();
    float* tile = (float*)smem;
    __syncthreads();
#pragma unroll
    for (int i = 0; i < 8; ++i) { const int idx = tid + NT * i, k = idx >> 6, n = idx & 63;
        const int oc = use_map ? orig_col(n0 + n) : (n0 + n);
        tile[k * 65 + n] = oc >= 0 ? src[(size_t)(k0 + k) * ldn + oc] : 0.f; }
    __syncthreads();
    const int n = tid >> 3, c = tid & 7;
    u32x4 o; o.x = pk2(tile[(8 * c + 0) * 65 + n], tile[(8 * c + 1) * 65 + n]); o.y = pk2(tile[(8 * c + 2) * 65 + n], tile[(8 * c + 3) * 65 + n]);
    o.z = pk2(tile[(8 * c + 4) * 65 + n], tile[(8 * c + 5) * 65 + n]); o.w = pk2(tile[(8 * c + 6) * 65 + n], tile[(8 * c + 7) * 65 + n]);
    *(u32x4*)(dst + (size_t)(n0 + n) * K + k0 + 8 * c) = o;
}

__device__ void filter_task(const Params& p, int l, int L, int pos0, char* smem) {
    const int tid = otid();
    float* z = (float*)smem;
    float* h1 = z + 8 * 33;
    float* h2 = h1 + 8 * 64;
    __syncthreads();
    if (tid < 8 * 33) { const int pp = tid / 33, i = tid % 33; const float pos = (float)(pos0 + pp);
        const float t = pos / (float)(L - 1 > 1 ? L - 1 : 1), w = 6.283185307179586f * pos / (float)L; float v;
        if (i == 0) v = t; else { const int bi = (i - 1) & 15; const float f = 1e-4f + (float)bi * ((15.0f - 1e-4f) / 15.0f); v = (i <= 16) ? cosf(w * f) : -sinf(w * f); }
        z[tid] = v; }
    __syncthreads();
    { const int pp = tid >> 6, j = tid & 63; const float* w1 = p.in[I_HW1] + (size_t)l * 33 * 64; float a = p.in[I_HB1][l * 64 + j];
        for (int i = 0; i < 33; ++i) a += z[pp * 33 + i] * w1[i * 64 + j];
        h1[tid] = sinf(p.in[I_HFREQ][(l * 2 + 0) * 64 + j] * a); }
    __syncthreads();
    { const int pp = tid >> 6, j = tid & 63; const float* w2 = p.in[I_HW2] + (size_t)l * 64 * 64; float a = p.in[I_HB2][l * 64 + j];
        for (int i = 0; i < 64; ++i) a += h1[pp * 64 + i] * w2[i * 64 + j];
        h2[tid] = sinf(p.in[I_HFREQ][(l * 2 + 1) * 64 + j] * a); }
    __syncthreads();
    { const int o = tid, dir = o >> 8, c = o & 255; const float* w3 = p.in[I_HW3] + (size_t)l * 64 * 512; const float b3 = p.in[I_HB3][l * 512 + o];
        const float delta = 3.0701134573253946f + (float)c * ((15.350567286626973f - 3.0701134573253946f) / 255.0f);
        float acc[8];
#pragma unroll
        for (int pp = 0; pp < 8; ++pp) acc[pp] = b3;
        for (int j = 0; j < 64; ++j) { const float wv = w3[j * 512 + o];
#pragma unroll
            for (int pp = 0; pp < 8; ++pp) acc[pp] += h2[pp * 64 + j] * wv; }
        float* KT = (float*)(p.ws + WS_KT); float* HC = (float*)(p.ws + WS_HC);
#pragma unroll
        for (int pp = 0; pp < 8; ++pp) { const int pos = pos0 + pp; const float t = (float)pos / (float)(L - 1 > 1 ? L - 1 : 1);
            const float v = acc[pp] * __expf(-t * delta);
            if (L == SEQ) { if (dir == 0) KT[(size_t)c * NF + pos]= v; else if (pos > 0) KT[(size_t)c * NF + (NF - pos)] = v; else KT[(size_t)c * NF + SEQ] = 0.f; }
            else HC[((size_t)dir * WG + c) * CTXL + pos] = v; }
    }
}

__device__ void phase_rp(const Params& p, int l, char* smem) {
    rp_rows(p, l);
    if (l >= DEPTH) return;
    constexpr int N_WIN = (NPAD / 64) * (DM / 64), N_WOUT = (DM / 64) * (MIX / 64), N_FL = SEQ / 8, N_FC = CTXL / 8;
    for (int task = obid(); task < N_WIN + N_WOUT + N_FL + N_FC; task += gridDim.x) {
        if (task < N_WIN) { const int nt = task / (DM / 64), kt = task % (DM / 64);
            convert_tile(p.in[I_WIN] + (size_t)l * DM * N_IN, N_IN, (bf16*)(p.ws + WS_WIN), DM, nt * 64, kt * 64, true, smem); }
        else if (task < N_WIN + N_WOUT) { const int t2 = task - N_WIN, nt = t2 / (MIX / 64), kt = t2 % (MIX / 64);
            convert_tile(p.in[I_WOUT] + (size_t)l * MIX * DM, DM, (bf16*)(p.ws + WS_WOUT), MIX, nt * 64, kt * 64, false, smem); }
        else if (task < N_WIN + N_WOUT + N_FL) filter_task(p, l, SEQ, (task - N_WIN - N_WOUT) * 8, smem);
        else filter_task(p, l, CTXL, (task - N_WIN - N_WOUT - N_FL) * 8, smem);
    }
}

__device__ __forceinline__ cpx cmul(cpx a, cpx b) { cpx r; r.x = a.x * b.x - a.y * b.y; r.y = a.x * b.y + a.y * b.x; return r; }
__device__ __forceinline__ cpx cmulc(cpx a, cpx b) { cpx r; r.x = a.x * b.x + a.y * b.y; r.y = a.y * b.x - a.x * b.y; return r; }
__device__ void fft_fwd(cpx* buf, const cpx* TW, int tl) {
    for (int s = 0; s < FFT_P; ++s) {
        const int span = NF >> (2 * (s + 1)), tws = 1 << (2 * s);
        __syncthreads();
#pragma unroll 1
        for (int j = tl; j < NF / 4; j += 256) {
            const int grp = j / span, pos = j % span, base = grp * 4 * span + pos;
            const cpx x0 = buf[base], x1 = buf[base + span], x2 = buf[base + 2 * span], x3 = buf[base + 3 * span];
            const cpx a = {x0.x + x2.x, x0.y + x2.y}, b = {x0.x - x2.x, x0.y - x2.y}, c = {x1.x + x3.x, x1.y + x3.y}, d = {x1.x - x3.x, x1.y - x3.y};
            const cpx y0 = {a.x + c.x, a.y + c.y}, y2 = {a.x - c.x, a.y - c.y};
            const cpx y1 = {b.x + d.y, b.y - d.x};
            const cpx y3 = {b.x - d.y, b.y + d.x};
            buf[base] = y0;
            buf[base + span] = cmul(y1, TW[pos * tws]);
            buf[base + 2 * span] = cmul(y2, TW[2 * pos * tws]);
            buf[base + 3 * span] = cmul(y3, TW[3 * pos * tws]);
        }
    }
    __syncthreads();
}
__device__ void fft_inv(cpx* buf, const cpx* TW, int tl) {
    for (int s = FFT_P - 1; s >= 0; --s) {
        const int span = NF >> (2 * (s + 1)), tws = 1 << (2 * s);
        __syncthreads();
#pragma unroll 1
        for (int j = tl; j < NF / 4; j += 256) {
            const int grp = j / span, pos = j % span, base = grp * 4 * span + pos;
            const cpx b0 = buf[base];
            const cpx b1 = cmulc(buf[base + span], TW[pos * tws]);
            const cpx b2 = cmulc(buf[base + 2 * span], TW[2 * pos * tws]);
            const cpx b3 = cmulc(buf[base + 3 * span], TW[3 * pos * tws]);
            const cpx a = {b0.x + b2.x, b0.y + b2.y}, b = {b0.x - b2.x, b0.y - b2.y}, c = {b1.x + b3.x, b1.y + b3.y}, d = {b1.x - b3.x, b1.y - b3.y};
            const cpx x0 = {a.x + c.x, a.y + c.y}, x2 = {a.x - c.x, a.y - c.y};
            const cpx x1 = {b.x - d.y, b.y + d.x};
            const cpx x3 = {b.x + d.y, b.y - d.x};
            buf[base] = x0; buf[base + span] = x1; buf[base + 2 * span] = x2; buf[base + 3 * span] = x3;
        }
    }
    __syncthreads();
}
__device__ void filt_fft_task(const Params& p, int cp, char* smem) {
    const int tid = otid(), half = tid >> 8, tl = tid & 255, c = 2 * cp + half;
    cpx* buf = (cpx*)smem + (size_t)half * NF;
    const float* KT = (const float*)(p.ws + WS_KT) + (size_t)c * NF;
    cpx* KF = (cpx*)(p.ws + WS_KF) + (size_t)c * NF;
    const cpx* TW = (const cpx*)(p.ws + WS_TW);
    __syncthreads();
    for (int i = tl; i < NF; i += 256) { cpx v; v.x = KT[i]; v.y = 0.f; buf[i] = v; }
    fft_fwd(buf, TW, tl);
    for (int i = tl; i < NF; i += 256) KF[i] = buf[i];
}

__device__ void gemm_tile(const Params& p, const bf16* A, const bf16* Bt, int K, int mt, int nt, int mode, char* smem) {
    const int tid = otid(), lane = tid & 63, wave = tid >> 6;
    bf16* As = (bf16*)smem;
    bf16* Bs = As + 128 * LS;
    const int wm = (wave & 3) * 32, wn = (wave >> 2) * 64;
    f32x4 acc[2][4];
#pragma unroll
    for (int i = 0; i < 2; ++i)
#pragma unroll
        for (int j = 0; j < 4; ++j) acc[i][j] = (f32x4){0.f, 0.f, 0.f, 0.f};
    const int lr = tid >> 3, lc = tid & 7;
    const bf16* Ag = A + (size_t)(mt * 128 + lr) * K + lc * 8;
    const bf16* Bg = Bt + (size_t)(nt * 128 + lr) * K + lc * 8;
    u32x4 ra0, ra1, rb0, rb1;
    ra0 = *(const u32x4*)(Ag); ra1 = *(const u32x4*)(Ag + (size_t)64 * K); rb0 = *(const u32x4*)(Bg); rb1 = *(const u32x4*)(Bg + (size_t)64 * K);
    const int nk = K / 64;
    for (int kt = 0; kt < nk; ++kt) {
        __syncthreads();
        *(u32x4*)(As + lr * LS + lc * 8) = ra0; *(u32x4*)(As + (lr + 64) * LS + lc * 8) = ra1;
        *(u32x4*)(Bs + lr * LS + lc * 8) = rb0; *(u32x4*)(Bs + (lr + 64) * LS + lc * 8) = rb1;
        __syncthreads();
        if (kt + 1 < nk) { const int ko = (kt + 1) * 64;
            ra0 = *(const u32x4*)(Ag + ko); ra1 = *(const u32x4*)(Ag + (size_t)64 * K + ko); rb0 = *(const u32x4*)(Bg + ko); rb1 = *(const u32x4*)(Bg + (size_t)64 * K + ko); }
        mma_nt<4, 2>(As, LS, wm, Bs, LS, wn, acc[0], lane);
        mma_nt<4, 2>(As, LS, wm + 16, Bs, LS, wn, acc[1], lane);
    }
    const int r = lane & 15, q = lane >> 4;
#pragma unroll
    for (int i = 0; i < 2; ++i)
#pragma unroll
        for (int j = 0; j < 4; ++j)
#pragma unroll
            for (int e = 0; e < 4; ++e) {
                const int row = mt * 128 + wm + 16 * i + 4 * q + e, col = nt * 128 + wn + 16 * j + r; const float v = acc[i][j][e];
                if (mode == 0) { if (col < NP) ((bf16*)(p.ws + WS_P))[(size_t)row * NP + col] = f2bf(v); else if (col < NP + NG) ((float*)(p.ws + WS_G))[(size_t)row * NG + (col - NP)] = v; }
                else ((float*)(p.ws + WS_P))[(size_t)row * DM + col] = v;
            }
}

__device__ void phase_gemm_in(const Params& p, int l, char* smem) {
    constexpr int MT = T / 128, NTI = NPAD / 128, N_G = MT * NTI, N_F = WG / 2;
    for (int task = obid(); task < N_G + N_F; task += gridDim.x) {
        if (task < N_G) gemm_tile(p, (const bf16*)(p.ws + WS_HNY), (const bf16*)(p.ws + WS_WIN), DM, task / NTI, task % NTI, 0, smem);
        else filt_fft_task(p, task - N_G, smem);
    }
}
__device__ void phase_gemm_out(const Params& p, int l, char* smem) {
    constexpr int MT = T / 128, NTO = DM / 128;
    for (int task = obid(); task < MT * NTO; task += gridDim.x) {
        const int mt = task / NTO, nt = task % NTO;
        if (l == DEPTH - 1 && (mt % (TOK / 128)) < CTXL / 128) continue;
        gemm_tile(p, (const bf16*)(p.ws + WS_HNY), (const bf16*)(p.ws + WS_WOUT), MIX, mt, nt, 1, smem);
    }
}

__device__ __forceinline__ size_t st_index(int mixer, int dir, int b, int h, int cid) { return ((((size_t)(mixer * 2 + dir) * NB + b) * NH + h) * NCH + cid); }
__device__ __forceinline__ size_t ch_index(int dir, int b, int h, int cid) { return (((size_t)dir * NB + b) * NH + h) * NCH + cid; }

__device__ __forceinline__ void load_tile_nat(const bf16* P, int r0, int c0, bf16* dst, float scale, int tid) {
    const int s = tid >> 3, c8 = tid & 7;
    const u32x4 v = *(const u32x4*)(P + (size_t)(r0 + s) * NP + c0 + c8 * 8);
    if (scale == 1.0f) *(u32x4*)(dst + s * LS + c8 * 8) = v;
    else { float f[8]; unpack8(v, f); u32x4 o; o.x = pk2(f[0] * scale, f[1] * scale); o.y = pk2(f[2] * scale, f[3] * scale); o.z = pk2(f[4] * scale, f[5] * scale); o.w = pk2(f[6] * scale, f[7] * scale);
        *(u32x4*)(dst + s * LS + c8 * 8) = o; }
}
__device__ __forceinline__ void load_tile_tr(const bf16* P, int r0, int c0, bf16* dst, int tid) {
    const int s = tid >> 3, c8 = tid & 7;
    const u32x4 v = *(const u32x4*)(P + (size_t)(r0 + s) * NP + c0 + c8 * 8);
    const unsigned w[4] = {v.x, v.y, v.z, v.w};
#pragma unroll
    for (int j = 0; j < 4; ++j) { dst[(c8 * 8 + 2 * j) * LS + s] = (bf16)(w[j] & 0xffffu); dst[(c8 * 8 + 2 * j + 1) * LS + s] = (bf16)(w[j] >> 16); }
}

__device__ void gla_decay(const Params& p, int l, int h, int dir, const float* rs, float* la, int tid) {
    const int lane = tid & 63, wave = tid >> 6;
    { const int d = tid & 63, sg = tid >> 6; float w[16];
        const float* wa = p.in[I_GWA] + ((size_t)(l * 2 + dir) * 16) * WG + h * 64 + d;
#pragma unroll
        for (int j = 0; j < 16; ++j) w[j] = wa[(size_t)j * WG];
        const float ba = p.in[I_GBA][(size_t)(l * 2 + dir) * WG + h * 64 + d];
        for (int s = sg * 8; s < sg * 8 + 8; ++s) { float a = ba;
#pragma unroll
            for (int j = 0; j < 16; ++j) a += rs[s * 32 + dir * 16 + j] * w[j];
            la[s * 65 + d] = logsigf_(a) * (1.0f / 16.0f); } }
    __syncthreads();
    for (int d = wave * 8; d < wave * 8 + 8; ++d) {
        float v = la[lane * 65 + d];
        if (dir == 0) v = wave_prefix_sum(v, lane);
        else { const float tot = wave_sum(v); const float pre = wave_prefix_sum(v, lane); v = tot - pre + v; }
        la[lane * 65 + d] = v;
    }
    __syncthreads();
}

__device__ void chunkst_task(const Params& p, int l, int mixer, int b, int h, int cid, char* smem) {
    const int tid = otid(), lane = tid & 63, wave = tid >> 6;
    const bf16* P = (const bf16*)(p.ws + WS_P); const float* G = (const float*)(p.ws + WS_G);
    bf16* ST = (bf16*)(p.ws + WS_ST);
    const int r0 = b * TOK + cid * 64;
    bf16* Vt = (bf16*)smem;
    bf16* Kt = Vt + 64 * LS;
    float* wv = (float*)(Kt + 64 * LS);
    float* rs = wv + 128;
    float* la = rs + 64 * 32;
    float* bend = la + 64 * 65;
    __syncthreads();
    const int kcol = mixer == 0 ? PA + 256 + h * 64 : PG + 256 + h * 64, vcol = mixer == 0 ? PA + 512 + h * 64 : PG + 512 + h * 64;
    load_tile_tr(P, r0, vcol, Vt, tid);
    if (mixer == 0) {
        if (wave == 0) {
            const float* g = G + (size_t)(r0 + lane) * NG; const float* gb = p.in[I_MGB] + (size_t)l * 16;
            const float i_f = g[h] + gb[h], f_f = g[4 + h] + gb[4 + h], i_b = g[8 + h] + gb[8 + h], f_b = g[12 + h] + gb[12 + h];
            const float lf = logsigf_(f_f), lb = logsigf_(f_b);
            const float bF = wave_prefix_sum(lf, lane), totF = __shfl(bF, 63);
            const float gF = totF - bF + i_f, mF = wave_max(gF);
            const float totB = wave_sum(lb), preB = wave_prefix_sum(lb, lane), bB = totB - preB + lb;
            const float gB = totB - bB + i_b, mB = wave_max(gB);
            wv[lane] = __expf(gF - mF); wv[64 + lane] = __expf(gB - mB);
            if (lane == 0) { float* SC = (float*)(p.ws + WS_SC);
                SC[ch_index(0, b, h, cid) * 4 + 0] = totF; SC[ch_index(0, b, h, cid) * 4 + 1] = mF;
                SC[ch_index(1, b, h, cid) * 4 + 0] = totB; SC[ch_index(1, b, h, cid) * 4 + 1] = mB; }
        }
    } else {
        for (int i = tid; i < 64 * 32; i += NT) rs[i] = G[(size_t)(r0 + (i >> 5)) * NG + 16 + (i & 31)];
    }
    __syncthreads();
    for (int dir = 0; dir < 2; ++dir) {
        if (mixer == 1) {
            gla_decay(p, l, h, dir, rs, la, tid);
            if (tid < 64) { const float be = dir == 0 ? la[63 * 65 + tid] : la[tid]; bend[tid] = be; ((float*)(p.ws + WS_BE))[ch_index(dir, b, h, cid) * 64 + tid] = be; }
            __syncthreads();
        }
        {
            const int s = tid >> 3, c8 = tid & 7; float f[8];
            unpack8(*(const u32x4*)(P + (size_t)(r0 + s) * NP + kcol + c8 * 8), f);
#pragma unroll
            for (int j = 0; j < 8; ++j) { const int d = c8 * 8 + j;
                const float w = mixer == 0 ? 0.125f * wv[dir * 64 + s] : __expf(bend[d] - la[s * 65 + d]);
                Kt[d * LS + s] = f2bf(f[j] * w); }
        }
        __syncthreads();
        f32x4 acc[2] = {(f32x4){0.f, 0.f, 0.f, 0.f}, (f32x4){0.f, 0.f, 0.f, 0.f}};
        const int e0 = (wave & 3) * 16, d0 = (wave >> 2) * 32;
        mma_nt<2, 2>(Vt, LS, e0, Kt, LS, d0, acc, lane);
        bf16* dst = ST + st_index(mixer, dir, b, h, cid) * 4096;
        const int r = lane & 15, q = lane >> 4;
#pragma unroll
        for (int nt = 0; nt < 2; ++nt)
#pragma unroll
            for (int i = 0; i < 4; ++i) dst[(e0 + 4 * q + i) * 64 + d0 + 16 * nt + r] = f2bf(acc[nt][i]);
        if (mixer == 0 && tid < 64) { float s = 0.f; for (int j = 0; j < 64; ++j) s += bf2f(Kt[tid * LS + j]);
            ((float*)(p.ws + WS_NV))[ch_index(dir, b, h, cid) * 64 + tid] = s; }
        __syncthreads();
    }
}

__device__ void hylat_task(const Params& p, int l, int bp, int cp, char* smem) {
    const int tid = otid(), half = tid >> 8, tl = tid & 255, c = 2 * cp + half;
    const bf16* P = (const bf16*)(p.ws + WS_P); bf16* Y = (bf16*)(p.ws + WS_HNY);
    cpx* buf = (cpx*)smem + (size_t)half * NF;
    const cpx* TW = (const cpx*)(p.ws + WS_TW);
    const cpx* KF = (const cpx*)(p.ws + WS_KF) + (size_t)c * NF;
    constexpr int NTK = SEQ / 256;
    const float* cw = p.in[I_HCW] + (size_t)l * 3 * 768; const float* cb = p.in[I_HCB] + (size_t)l * 768;
    const size_t rb0 = (size_t)(2 * bp) * TOK + CTXL, rb1 = rb0 + TOK;
    float u0[NTK], u1[NTK], g0[NTK], g1[NTK];
    const bf16* pb0 = P + rb0 * NP + PH + c; const bf16* pb1 = P + rb1 * NP + PH + c;
    __syncthreads();
#pragma unroll 1
    for (int t = tl; t < SEQ; t += 256) { cpx v; v.x = bf2f(pb0[t * NP + 512]); v.y = bf2f(pb1[t * NP + 512]); buf[t] = v; }
    __syncthreads();
    { const float w0 = cw[0 * 768 + 512 + c], w1 = cw[1 * 768 + 512 + c], w2 = cw[2 * 768 + 512 + c], bb = cb[512 + c];
#pragma unroll
        for (int i = 0; i < NTK; ++i) { const int t = tl + 256 * i; const cpx m = buf[t]; cpx a = {0.f, 0.f}, z = {0.f, 0.f};
            if (t > 0) a = buf[t - 1]; if (t < SEQ - 1) z = buf[t + 1];
            const float x0a = w0 * a.x + w1 * m.x + w2 * z.x + bb, x0b = w0 * a.y + w1 * m.y + w2 * z.y + bb;
            const float ga = bf2f(pb0[t * NP + 768]), gb = bf2f(pb1[t * NP + 768]);
            g0[i] = x0a * siluf_(ga); g1[i] = x0b * siluf_(gb); } }
    __syncthreads();
#pragma unroll 1
    for (int t = tl; t < SEQ; t += 256) { cpx v; v.x = bf2f(pb0[t * NP]); v.y = bf2f(pb1[t * NP]); buf[t] = v;
        cpx w; w.x = bf2f(pb0[t * NP + 256]); w.y = bf2f(pb1[t * NP + 256]); buf[SEQ + t] = w; }
    __syncthreads();
    { const float v0 = cw[0 * 768 + c], v1 = cw[1 * 768 + c], v2 = cw[2 * 768 + c], vb = cb[c];
      const float y0 = cw[0 * 768 + 256 + c], y1 = cw[1 * 768 + 256 + c], y2 = cw[2 * 768 + 256 + c], yb = cb[256 + c];
#pragma unroll
        for (int i = 0; i < NTK; ++i) { const int t = tl + 256 * i; const cpx m = buf[t], n = buf[SEQ + t]; cpx a = {0.f, 0.f}, z = {0.f, 0.f}, a2 = {0.f, 0.f}, z2 = {0.f, 0.f};
            if (t > 0) { a = buf[t - 1]; a2 = buf[SEQ + t - 1]; } if (t < SEQ - 1) { z = buf[t + 1]; z2 = buf[SEQ + t + 1]; }
            u0[i] = (v0 * a.x + v1 * m.x + v2 * z.x + vb) * (y0 * a2.x + y1 * n.x + y2 * z2.x + yb);
            u1[i] = (v0 * a.y + v1 * m.y + v2 * z.y + vb) * (y0 * a2.y + y1 * n.y + y2 * z2.y + yb); } }
    __syncthreads();
#pragma unroll
    for (int i = 0; i < NTK; ++i) { const int t = tl + 256 * i; cpx v; v.x = u0[i]; v.y = u1[i]; buf[t] = v; cpx z = {0.f, 0.f}; buf[SEQ + t] = z; }
    fft_fwd(buf, TW, tl);
#pragma unroll 2
    for (int i = tl; i < NF; i += 256) buf[i] = cmul(buf[i], KF[i]);
    fft_inv(buf, TW, tl);
    const float dsk = p.in[I_HD][(size_t)l * WG + c]; const float sc = 1.0f / (float)NF;
    bf16* yb0 = Y + rb0 * 1024 + YH + c; bf16* yb1 = Y + rb1 * 1024 + YH + c;
#pragma unroll
    for (int i = 0; i < NTK; ++i) { const int t = tl + 256 * i; const cpx y = buf[t];
        yb0[t * 1024] = f2bf(g0[i] * (y.x * sc + u0[i] * dsk));
        yb1[t * 1024] = f2bf(g1[i] * (y.y * sc + u1[i] * dsk)); }
}

constexpr int HCB = 8;
__device__ void hyctx_task(const Params& p, int l, int b, int cblk, char* smem) {
    const int tid = otid(); const int c0 = cblk * HCB;
    const bf16* P = (const bf16*)(p.ws + WS_P); bf16* Y = (bf16*)(p.ws + WS_HNY); const float* HC = (const float*)(p.ws + WS_HC);
    float* raw = (float*)smem;
    float* u = raw + 3 * CTXL * HCB;
    float* hf = u + CTXL * HCB;
    float* hb = hf + CTXL * HCB;
    float* og = hb + CTXL * HCB;
    const size_t rb = (size_t)b * TOK;
    const float* cw = p.in[I_HCW] + (size_t)l * 3 * 768; const float* cbias = p.in[I_HCB] + (size_t)l * 768;
    __syncthreads();
    for (int i = tid; i < 3 * CTXL * HCB; i += NT) { const int k = i / (CTXL * HCB), t = (i / HCB) % CTXL, cc = i % HCB; raw[i] = bf2f(P[(rb + t) * NP + PH + k * 256 + c0 + cc]); }
    for (int i = tid; i < CTXL * HCB; i += NT) { const int t = i / HCB, cc = i % HCB; hf[i] = HC[((size_t)0 * WG + c0 + cc) * CTXL + t]; hb[i] = HC[((size_t)1 * WG + c0 + cc) * CTXL + t]; }
    __syncthreads();
    for (int i = tid; i < CTXL * HCB; i += NT) { const int t = i / HCB, cc = i % HCB; float cv[3];
#pragma unroll
        for (int k = 0; k < 3; ++k) { const float* rk = raw + k * CTXL * HCB; const int ch = k * 256 + c0 + cc;
            const float a = t > 0 ? rk[(t - 1) * HCB + cc] : 0.f, m = rk[t * HCB + cc], z = t < CTXL - 1 ? rk[(t + 1) * HCB + cc] : 0.f;
            cv[k] = cw[0 * 768 + ch] * a + cw[1 * 768 + ch] * m + cw[2 * 768 + ch] * z + cbias[ch]; }
        u[i] = cv[0] * cv[1];
        og[i] = cv[2] * siluf_(bf2f(P[(rb + t) * NP + PH + 768 + c0 + cc])); }
    __syncthreads();
    { const int cc = tid % HCB, tg = tid / HCB; constexpr int TG = NT / HCB, NTK = CTXL / TG; float acc[NTK];
#pragma unroll
        for (int i = 0; i < NTK; ++i) acc[i] = 0.f;
        for (int s = 0; s < CTXL; ++s) { const float us = u[s * HCB + cc];
#pragma unroll
            for (int i = 0; i < NTK; ++i) { const int t = tg + TG * i; const float hv = (s <= t) ? hf[(t - s) * HCB + cc] : hb[(s - t) * HCB + cc]; acc[i] += us * hv; } }
        const float dsk = p.in[I_HD][(size_t)l * WG + c0 + cc];
#pragma unroll
        for (int i = 0; i < NTK; ++i) { const int t = tg + TG * i; Y[(rb + t) * 1024 + YH + c0 + cc] = f2bf(og[t * HCB + cc] * (acc[i] + u[t * HCB + cc] * dsk)); } }
}

__device__ void attn_task(const Params& p, int l, int b, int kvh, int qt, bool ctxq, char* smem) {
    const int tid = otid(), lane = tid & 63, wave = tid >> 6, r = lane & 15, q = lane >> 4;
    const bf16* P = (const bf16*)(p.ws + WS_P); bf16* Y = (bf16*)(p.ws + WS_HNY); const cpx* ROPE = (const cpx*)(p.ws + WS_ROPE);
    bf16* Qs = (bf16*)smem;
    bf16* Ks = Qs + 128 * LS;
    bf16* Vt = Ks + 64 * LS;
    bf16* Ps = Vt + 64 * LS;
    const size_t rq0 = (size_t)b * TOK + (ctxq ? 0 : CTXL) + qt * 64;
    __syncthreads();
    {
        const int row = tid >> 2, cpair = tid & 3, g = row >> 6, t = row & 63;
        const bf16* src = P + (rq0 + t) * NP + PD + (kvh * 2 + g) * 64;
        float lo[8], hi[8]; unpack8(*(const u32x4*)(src + cpair * 8), lo); unpack8(*(const u32x4*)(src + 32 + cpair * 8), hi);
        u32x4 o1, o2; float a[8], c2[8];
#pragma unroll
        for (int j = 0; j < 8; ++j) { float cs = 1.f, sn = 0.f; if (!ctxq) { const cpx cv = ROPE[(size_t)(qt * 64 + t) * 32 + cpair * 8 + j]; cs = cv.x; sn = cv.y; }
            a[j] = (lo[j] * cs - hi[j] * sn) * 0.125f; c2[j] = (hi[j] * cs + lo[j] * sn) * 0.125f; }
        o1.x = pk2(a[0], a[1]); o1.y = pk2(a[2], a[3]); o1.z = pk2(a[4], a[5]); o1.w = pk2(a[6], a[7]);
        o2.x = pk2(c2[0], c2[1]); o2.y = pk2(c2[2], c2[3]); o2.z = pk2(c2[4], c2[5]); o2.w = pk2(c2[6], c2[7]);
        *(u32x4*)(Qs + row * LS + cpair * 8) = o1; *(u32x4*)(Qs + row * LS + 32 + cpair * 8) = o2;
    }
    const int lt0 = ctxq ? 0 : (qt - 2 > 0 ? qt - 2 : 0), lt1 = ctxq ? -1 : (qt + 2 < SEQ / 64 - 1 ? qt + 2 : SEQ / 64 - 1);
    const int nloc = lt1 - lt0 + 1, ntiles = nloc + NCC;
    float m[4], lsum[4]; f32x4 O[4];
#pragma unroll
    for (int i = 0; i < 4; ++i) { m[i] = -INFINITY; lsum[i] = 0.f; O[i] = (f32x4){0.f, 0.f, 0.f, 0.f}; }
    const int g = wave >> 2, tq0 = (wave & 3) * 16;
    bf16* Pw = Ps + wave * 16 * LS;
    for (int ti = 0; ti < ntiles; ++ti) {
        const bool local = ti < nloc; const int kt = local ? lt0 + ti : ti - nloc;
        const size_t rk0 = (size_t)b * TOK + (local ? CTXL : 0) + kt * 64;
        __syncthreads();
        if (tid < 256) { const int s = tid >> 2, cpair = tid & 3; const bf16* src = P + (rk0 + s) * NP + PD + 256 + kvh * 64;
            float lo[8], hi[8]; unpack8(*(const u32x4*)(src + cpair * 8), lo); unpack8(*(const u32x4*)(src + 32 + cpair * 8), hi);
            float a[8], c2[8];
#pragma unroll
            for (int j = 0; j < 8; ++j) { float cs = 1.f, sn = 0.f; if (local) { const cpx cv = ROPE[(size_t)(kt * 64 + s) * 32 + cpair * 8 + j]; cs = cv.x; sn = cv.y; }
                a[j] = lo[j] * cs - hi[j] * sn; c2[j] = hi[j] * cs + lo[j] * sn; }
            u32x4 o1, o2;
            o1.x = pk2(a[0], a[1]); o1.y = pk2(a[2], a[3]); o1.z = pk2(a[4], a[5]); o1.w = pk2(a[6], a[7]);
            o2.x = pk2(c2[0], c2[1]); o2.y = pk2(c2[2], c2[3]); o2.z = pk2(c2[4], c2[5]); o2.w = pk2(c2[6], c2[7]);
            *(u32x4*)(Ks + s * LS + cpair * 8) = o1; *(u32x4*)(Ks + s * LS + 32 + cpair * 8) = o2; }
        load_tile_tr(P, (int)rk0, PD + 384 + kvh * 64, Vt, tid);
        __syncthreads();
        f32x4 S[4] = {(f32x4){0.f, 0.f, 0.f, 0.f}, (f32x4){0.f, 0.f, 0.f, 0.f}, (f32x4){0.f, 0.f, 0.f, 0.f}, (f32x4){0.f, 0.f, 0.f, 0.f}};
        mma_nt<4, 2>(Qs, LS, g * 64 + tq0, Ks, LS, 0, S, lane);
        float rmax[4], rsum[4];
#pragma unroll
        for (int i = 0; i < 4; ++i) { const int qpos = qt * 64 + tq0 + 4 * q + i; float mx = -INFINITY;
#pragma unroll
            for (int nt = 0; nt < 4; ++nt) { if (local) { const int kpos = kt * 64 + nt * 16 + r; const int d = kpos - qpos; if (d > 128 || d < -128) S[nt][i] = -INFINITY; } mx = fmaxf(mx, S[nt][i]); }
            mx = fmaxf(mx, __shfl_xor(mx, 1)); mx = fmaxf(mx, __shfl_xor(mx, 2)); mx = fmaxf(mx, __shfl_xor(mx, 4)); mx = fmaxf(mx, __shfl_xor(mx, 8));
            rmax[i] = mx; }
#pragma unroll
        for (int i = 0; i < 4; ++i) { const float mn = fmaxf(m[i], rmax[i]); const float alpha = __expf(m[i] - mn); float sm = 0.f;
#pragma unroll
            for (int nt = 0; nt < 4; ++nt) { const float pv = __expf(S[nt][i] - mn); sm += pv; Pw[(4 * q + i) * LS + nt * 16 + r] = f2bf(pv); O[nt][i] *= alpha; }
            sm += __shfl_xor(sm, 1); sm += __shfl_xor(sm, 2); sm += __shfl_xor(sm, 4); sm += __shfl_xor(sm, 8);
            lsum[i] = lsum[i] * alpha + sm; m[i] = mn; rsum[i] = sm; }
        __syncthreads();
        mma_nt<4, 2>(Pw, LS, 0, Vt, LS, 0, O, lane);
    }
    const float sink = p.in[I_SINK][(size_t)l * NH + kvh * 2 + g];
#pragma unroll
    for (int i = 0; i < 4; ++i) { const float den = lsum[i] + __expf(sink - m[i]); const float inv = 1.0f / den; const int t = tq0 + 4 * q + i;
#pragma unroll
        for (int nt = 0; nt < 4; ++nt) { const int e = nt * 16 + r; const float gate = bf2f(P[(rq0 + t) * NP + PD + 512 + (kvh * 2 + g) * 64 + e]);
            Y[(rq0 + t) * 1024 + YD + (kvh * 2 + g) * 64 + e] = f2bf(O[nt][i] * inv * siluf_(gate)); } }
}

__device__ void phase_mix1(const Params& p, int l, char* smem) {
    const bool ctxo = l < DEPTH - 1;
    constexpr int N_HL = (NB / 2) * (WG / 2), N_AL = NB * 2 * (SEQ / 64), N_CS = 2 * NB * NH * NCH, N_HC = NB * (WG / HCB), N_AC = NB * 2 * NCC;
    const int total = N_HL + N_AL + N_CS + (ctxo ? N_HC + N_AC : 0);
    for (int task = obid(); task < total; task += gridDim.x) {
        int t = task;
        if (t < N_HL) { hylat_task(p, l, t / (WG / 2), t % (WG / 2), smem); continue; } t -= N_HL;
        if (t < N_AL) { attn_task(p, l, t / (2 * (SEQ / 64)), (t / (SEQ / 64)) % 2, t % (SEQ / 64), false, smem); continue; } t -= N_AL;
        if (t < N_CS) { const int mixer = t / (NB * NH * NCH), r2 = t % (NB * NH * NCH); chunkst_task(p, l, mixer, r2 / (NH * NCH), (r2 / NCH) % NH, r2 % NCH, smem); continue; } t -= N_CS;
        if (t < N_HC) { hyctx_task(p, l, t / (WG / HCB), t % (WG / HCB), smem); continue; } t -= N_HC;
        attn_task(p, l, t / (2 * NCC), (t / NCC) % 2, t % NCC, true, smem);
    }
}

__device__ void phase_scan(const Params& p) {
    const int tid = otid();
    bf16* ST = (bf16*)(p.ws + WS_ST); float* NV = (float*)(p.ws + WS_NV); const float* BE = (const float*)(p.ws + WS_BE); float* SC = (float*)(p.ws + WS_SC);
    constexpr int NCHAIN = 2 * 2 * NB * NH;
    for (int item = obid() * NT + tid; item < NCHAIN * 1024; item += gridDim.x * NT) {
        const int chain = item >> 10, grp = item & 1023; const int mixer = chain / (2 * NB * NH), dir = (chain / (NB * NH)) % 2, b = (chain / NH) % NB, h = chain % NH;
        float c[4] = {0.f, 0.f, 0.f, 0.f}; float nv[4] = {0.f, 0.f, 0.f, 0.f}; float m = 0.f;
        const int d0 = (grp & 15) * 4;
        for (int o = 0; o < NCH; ++o) {
            const int cid = chain_cid(dir, o);
            bf16* slot = ST + st_index(mixer, dir, b, h, cid) * 4096 + grp * 4;
            const u32x2 uu = *(const u32x2*)slot; const float u[4] = {bitsf(uu.x << 16), bitsf(uu.x & 0xffff0000u), bitsf(uu.y << 16), bitsf(uu.y & 0xffff0000u)};
            u32x2 w; w.x = pk2(c[0], c[1]); w.y = pk2(c[2], c[3]); *(u32x2*)slot = w;
            if (mixer == 0) {
                const size_t ci = ch_index(dir, b, h, cid); const float bend = SC[ci * 4 + 0], mloc = SC[ci * 4 + 1];
                if (grp == 0) SC[ci * 4 + 2] = m;
                const float mn = fmaxf(bend + m, mloc), a = __expf(bend + m - mn), s = __expf(mloc - mn);
#pragma unroll
                for (int j = 0; j < 4; ++j) c[j] = a * c[j] + s * u[j];
                if (grp < 16) { float* nslot = NV + ci * 64 + grp * 4; const f32x4 nu = *(const f32x4*)nslot; f32x4 nw = {nv[0], nv[1], nv[2], nv[3]}; *(f32x4*)nslot = nw;
                    nv[0] = a * nv[0] + s * nu.x; nv[1] = a * nv[1] + s * nu.y; nv[2] = a * nv[2] + s * nu.z; nv[3] = a * nv[3] + s * nu.w; }
                m = mn;
            } else {
                const f32x4 be = *(const f32x4*)(BE + ch_index(dir, b, h, cid) * 64 + d0);
                c[0] = __expf(be.x) * c[0] + u[0]; c[1] = __expf(be.y) * c[1] + u[1]; c[2] = __expf(be.z) * c[2] + u[2]; c[3] = __expf(be.w) * c[3] + u[3];
            }
        }
    }
}

__device__ void chunkout_task(const Params& p, int l, int mixer, int b, int h, int cid, char* smem) {
    const int tid = otid(), lane = tid & 63, wave = tid >> 6, r = lane & 15, q = lane >> 4;
    const bf16* P = (const bf16*)(p.ws + WS_P); const float* G = (const float*)(p.ws + WS_G); bf16* Y = (bf16*)(p.ws + WS_HNY);
    const bf16* ST = (const bf16*)(p.ws + WS_ST);
    const int r0 = b * TOK + cid * 64;
    const int pbase = mixer == 0 ? PA : PG;
    bf16* Qs = (bf16*)smem;
    bf16* Ks = Qs + 64 * LS;
    bf16* Qh = Ks + 64 * LS;
    bf16* Vt = Qh + 64 * LS;
    bf16* Ct = Vt + 64 * LS;
    bf16* Sm = Ct + 64 * LS;
    float* fb = (float*)(Sm + 64 * LS);
    float* rowt = fb;
    float* colt = rowt + 64;
    float* wint = colt + 64;
    float* emt = wint + 64;
    float* nprev = emt + 64;
    float* qn = nprev + 64;
    float* rsum = qn + 64;
    float* rs = rsum + 128;
    float* la = rs + 64 * 32;
    float* hs = la;
    __syncthreads();
    load_tile_tr(P, r0, pbase + 512 + h * 64, Vt, tid);
    if (mixer == 0) { load_tile_nat(P, r0, pbase + h * 64, Qs, 1.0f, tid); load_tile_nat(P, r0, pbase + 256 + h * 64, Ks, 0.125f, tid); }
    else for (int i = tid; i < 64 * 32; i += NT) rs[i] = G[(size_t)(r0 + (i >> 5)) * NG + 16 + (i & 31)];
    const int t0 = (wave & 3) * 16, c0 = (wave >> 2) * 32;
    f32x4 htot[2] = {(f32x4){0.f, 0.f, 0.f, 0.f}, (f32x4){0.f, 0.f, 0.f, 0.f}};
    for (int dir = 0; dir < 2; ++dir) {
        __syncthreads();
        { const int s = tid >> 3, c8 = tid & 7; *(u32x4*)(Ct + s * LS + c8 * 8) = *(const u32x4*)(ST + st_index(mixer, dir, b, h, cid) * 4096 + s * 64 + c8 * 8); }
        if (mixer == 0) {
            if (wave == 0) {
                const float* g = G + (size_t)(r0 + lane) * NG; const float* gb = p.in[I_MGB] + (size_t)l * 16;
                const float ig = g[dir * 8 + h] + gb[dir * 8 + h], fg = g[dir * 8 + 4 + h] + gb[dir * 8 + 4 + h];
                const float lf = logsigf_(fg); float bb;
                if (dir == 0) bb = wave_prefix_sum(lf, lane); else { const float tot = wave_sum(lf), pre = wave_prefix_sum(lf, lane); bb = tot - pre + lf; }
                const float a = ig - bb; const float pm = dir == 0 ? wave_prefix_max(a, lane) : wave_suffix_max(a, lane);
                const float mprev = ((const float*)(p.ws + WS_SC))[ch_index(dir, b, h, cid) * 4 + 2];
                const float mt = fmaxf(bb + mprev, bb + pm);
                rowt[lane] = bb - mt; colt[lane] = a; wint[lane] = __expf(bb + mprev - mt); emt[lane] = __expf(-mt);
                nprev[lane] = ((const float*)(p.ws + WS_NV))[ch_index(dir, b, h, cid) * 64 + lane];
            }
            __syncthreads();
            if (tid < 64) { float s = 0.f; for (int d = 0; d < 64; ++d) s += bf2f(Qs[tid * LS + d]) * nprev[d]; qn[tid] = s; }
        } else {
            gla_decay(p, l, h, dir, rs, la, tid);
            { const int s = tid >> 3, c8 = tid & 7; float fq[8], fk[8];
                unpack8(*(const u32x4*)(P + (size_t)(r0 + s) * NP + pbase + h * 64 + c8 * 8), fq); unpack8(*(const u32x4*)(P + (size_t)(r0 + s) * NP + pbase + 256 + h * 64 + c8 * 8), fk);
                float a1[8], a2[8], a3[8];
#pragma unroll
                for (int j = 0; j < 8; ++j) { const int d = c8 * 8 + j; const float bs = la[s * 65 + d]; const float bmid = 0.5f * (dir == 0 ? la[63 * 65 + d] : la[d]);
                    a1[j] = fq[j] * 0.125f * __expf(bs - bmid); a2[j] = fk[j] * __expf(bmid - bs); a3[j] = fq[j] * 0.125f * __expf(bs); }
                u32x4 o; o.x = pk2(a1[0], a1[1]); o.y = pk2(a1[2], a1[3]); o.z = pk2(a1[4], a1[5]); o.w = pk2(a1[6], a1[7]); *(u32x4*)(Qs + s * LS + c8 * 8) = o;
                o.x = pk2(a2[0], a2[1]); o.y = pk2(a2[2], a2[3]); o.z = pk2(a2[4], a2[5]); o.w = pk2(a2[6], a2[7]); *(u32x4*)(Ks + s * LS + c8 * 8) = o;
                o.x = pk2(a3[0], a3[1]); o.y = pk2(a3[2], a3[3]); o.z = pk2(a3[4], a3[5]); o.w = pk2(a3[6], a3[7]); *(u32x4*)(Qh + s * LS + c8 * 8) = o; }
        }
        __syncthreads();
        {
            f32x4 S[2] = {(f32x4){0.f, 0.f, 0.f, 0.f}, (f32x4){0.f, 0.f, 0.f, 0.f}};
            mma_nt<2, 2>(Qs, LS, t0, Ks, LS, c0, S, lane);
#pragma unroll
            for (int i = 0; i < 4; ++i) { const int t = t0 + 4 * q + i; float sm = 0.f;
#pragma unroll
                for (int nt = 0; nt < 2; ++nt) { const int s = c0 + 16 * nt + r; const bool ok = dir == 0 ? (s <= t) : (s >= t); float v = 0.f;
                    if (ok) v = mixer == 0 ? S[nt][i] * __expf(rowt[t] + colt[s]) : S[nt][i];
                    Sm[t * LS + s] = f2bf(v); sm += v; }
                if (mixer == 0) { sm += __shfl_xor(sm, 1); sm += __shfl_xor(sm, 2); sm += __shfl_xor(sm, 4); sm += __shfl_xor(sm, 8); if (r == 0) rsum[(wave >> 2) * 64 + t] = sm; } }
        }
        __syncthreads();
        { f32x4 a1[2] = {(f32x4){0.f, 0.f, 0.f, 0.f}, (f32x4){0.f, 0.f, 0.f, 0.f}}, a2[2] = {(f32x4){0.f, 0.f, 0.f, 0.f}, (f32x4){0.f, 0.f, 0.f, 0.f}};
            mma_nt<2, 2>(Sm, LS, t0, Vt, LS, c0, a1, lane);
            mma_nt<2, 2>(mixer == 0 ? Qs : Qh, LS, t0, Ct, LS, c0, a2, lane);
#pragma unroll
            for (int i = 0; i < 4; ++i) { const int t = t0 + 4 * q + i;
                if (mixer == 0) { const float wi = wint[t]; const float den = wi * qn[t] + rsum[t] + rsum[64 + t]; const float inv = 1.0f / fmaxf(fabsf(den), emt[t]);
#pragma unroll
                    for (int nt = 0; nt < 2; ++nt) htot[nt][i] += (a1[nt][i] + wi * a2[nt][i]) * inv; }
                else {
#pragma unroll
                    for (int nt = 0; nt < 2; ++nt) htot[nt][i] += a1[nt][i] + a2[nt][i]; } }
        }
    }
    __syncthreads();
#pragma unroll
    for (int nt = 0; nt < 2; ++nt)
#pragma unroll
        for (int i = 0; i < 4; ++i) hs[(t0 + 4 * q + i) * 65 + c0 + 16 * nt + r] = htot[nt][i];
    __syncthreads();
    { const int t = tid >> 3, c8 = tid & 7; float v[8], o8[8], g8[8]; float ss = 0.f;
        unpack8(*(const u32x4*)(P + (size_t)(r0 + t) * NP + pbase + (mixer == 0 ? 1024 : 768) + h * 64 + c8 * 8), g8);
        if (mixer == 0) unpack8(*(const u32x4*)(P + (size_t)(r0 + t) * NP + pbase + 768 + h * 64 + c8 * 8), o8);
#pragma unroll
        for (int j = 0; j < 8; ++j) { float x = hs[t * 65 + c8 * 8 + j]; if (mixer == 0) x *= sigmoidf_(o8[j]); v[j] = x; ss += x * x; }
        ss += __shfl_xor(ss, 1); ss += __shfl_xor(ss, 2); ss += __shfl_xor(ss, 4);
        const float rstd = rsqrtf(ss * (1.0f / 64.0f) + EPS);
        const float* ng = p.in[mixer == 0 ? I_MNG : I_GNG] + (size_t)l * WG + h * 64 + c8 * 8;
        float w[8];
#pragma unroll
        for (int j = 0; j < 8; ++j) w[j] = v[j] * rstd * ng[j] * siluf_(g8[j]);
        u32x4 o; o.x = pk2(w[0], w[1]); o.y = pk2(w[2], w[3]); o.z = pk2(w[4], w[5]); o.w = pk2(w[6], w[7]);
        *(u32x4*)(Y + (size_t)(r0 + t) * 1024 + (mixer == 0 ? YA : YG) + h * 64 + c8 * 8) = o; }
}

__device__ void phase_mix2(const Params& p, int l, char* smem) {
    constexpr int N = 2 * NB * NH * NCH;
    for (int task = obid(); task < N; task += gridDim.x) {
        const int mixer = task / (NB * NH * NCH), r2 = task % (NB * NH * NCH); const int b = r2 / (NH * NCH), h = (r2 / NCH) % NH, cid = r2 % NCH;
        if (l == DEPTH - 1 && cid < NCC) continue;
        chunkout_task(p, l, mixer, b, h, cid, smem);
    }
}

__global__ void __launch_bounds__(NT) fwd_kernel(Params p, int ph_lo, int ph_hi) {
    SMEM_DECL;
    constexpr int NPH = 2 + 6 * DEPTH;
    for (int ph = ph_lo; ph < ph_hi && ph < NPH; ++ph) {
        if (ph == 0) phase0(p, smem);
        else if (ph == NPH - 1) phase_rp(p, DEPTH, smem);
        else { const int l = (ph - 1) / 6, k = (ph - 1) % 6;
            if (k == 0) phase_rp(p, l, smem);
            else if (k == 1) phase_gemm_in(p, l, smem);
            else if (k == 2) phase_mix1(p, l, smem);
            else if (k == 3) phase_scan(p);
            else if (k == 4) phase_mix2(p, l, smem);
            else phase_gemm_out(p, l, smem); }
        if (ph + 1 < ph_hi) GRID_SYNC();
    }
}

#ifndef EMU
extern "C" void kernel_launch(void* const* d_in, const int* in_sizes, int n_in, void* d_out, int out_size, void* d_ws, size_t ws_size, hipStream_t stream) {
    static int grid = 0;
    if (grid == 0) {
        if (n_in != 26 || ws_size < WS_TOTAL) { fprintf(stderr, "kernel_launch: unexpected n_in %d or ws_size %zu (need %zu)\n", n_in, ws_size, (size_t)WS_TOTAL); grid = -1; return; }
        int dev = 0, cus = 0, per_cu = 0;
        hipGetDevice(&dev);
        hipDeviceGetAttribute(&cus, hipDeviceAttributeMultiprocessorCount, dev);
        hipFuncSetAttribute((const void*)fwd_kernel, hipFuncAttributeMaxDynamicSharedMemorySize, LDS_BYTES);
        hipOccupancyMaxActiveBlocksPerMultiprocessor(&per_cu, (const void*)fwd_kernel, NT, LDS_BYTES);
        if (per_cu < 1) { fprintf(stderr, "kernel_launch: occupancy query returned %d\n", per_cu); grid = -1; return; }
        if (per_cu > 1) per_cu = 1;
        grid = cus * per_cu;
    }
    if (grid < 0) return;
    Params p{};
    for (int i = 0; i < 26; ++i) p.in[i] = (const float*)d_in[i];
    p.out = (float*)d_out; p.ws = (char*)d_ws;
    int lo = 0, hi = 2 + 6 * DEPTH;
    void* args[] = {&p, &lo, &hi};
    hipError_t e = hipLaunchCooperativeKernel((const void*)fwd_kernel, dim3(grid), dim3(NT), args, LDS_BYTES, stream);
    if (e != hipSuccess) fprintf(stderr, "cooperative launch failed: %s (grid %d)\n", hipGetErrorString(e), grid);
}
#endif
```

```cpp
#ifdef EMU
#include "emu/hipemu.h"
#define GRID_SYNC() emu::grid_sync()
#define SMEM_DECL char* smem = emu::S().blocks[emu::cur()->block].lds
#define MFMA16(a, b, c) emu_mfma_16x16x32_bf16(a, b, c)
#else
#include <hip/hip_runtime.h>
#include <hip/hip_cooperative_groups.h>
#include <cstdio>
#include <cstdint>
#define GRID_SYNC() cooperative_groups::this_grid().sync()
#define SMEM_DECL extern __shared__ __attribute__((aligned(16))) char smem[]
#define MFMA16(a, b, c) __builtin_amdgcn_mfma_f32_16x16x32_bf16(a, b, c, 0, 0, 0)
#endif

#ifdef EMU
#ifndef EMU_DM
#define EMU_DM 256
#endif
#ifndef EMU_NB
#define EMU_NB 2
#endif
#ifndef EMU_SEQ
#define EMU_SEQ 512
#endif
#ifndef EMU_DEPTH
#define EMU_DEPTH 2
#endif
#ifndef EMU_CTXL
#define EMU_CTXL 128
#endif
constexpr int DM = EMU_DM, NB = EMU_NB, SEQ = EMU_SEQ, DEPTH = EMU_DEPTH, CTXL = EMU_CTXL;
#else
constexpr int DM = 1024, NB = 8, SEQ = 2048, DEPTH = 4, CTXL = 256;
#endif
constexpr int MIX = 1024, WG = 256, HD = 64, NH = 4, CH = 64;
constexpr int TOK = CTXL + SEQ, T = NB * TOK, NCH = TOK / CH, NCC = CTXL / CH;
constexpr int N_IN = 4144, NP = 3072, NG = 48, NMAIN = 3328, NPAD = 4352;
constexpr int NF = 2 * SEQ;
constexpr int NJ = NB + 1;
constexpr int NT = 512;
constexpr float EPS = 1e-6f;
constexpr int PA = 0, PG = 1280, PD = 2304;
constexpr int YA = 0, YH = 256, YG = 512, YD = 768;
constexpr int ilog4(int n) { return n <= 1 ? 0 : 1 + ilog4(n / 4); }
constexpr int FFT_P = ilog4(NF);
static_assert((1 << (2 * FFT_P)) == NF, "NF must be a power of 4");
static_assert(DM % 256 == 0 && CTXL % 128 == 0 && SEQ % 256 == 0, "shape constraints");

typedef unsigned short bf16;
typedef short bf16x8 __attribute__((ext_vector_type(8)));
typedef float f32x4 __attribute__((ext_vector_type(4)));
typedef unsigned u32x4 __attribute__((ext_vector_type(4)));
typedef unsigned u32x2 __attribute__((ext_vector_type(2)));
struct cpx { float x, y; };

constexpr size_t al256(size_t x) { return (x + 255) & ~(size_t)255; }
constexpr size_t WS_CTXB = 0;
constexpr size_t WS_HNY = al256(WS_CTXB + (size_t)NB * CTXL * DM * 4);
constexpr size_t WS_WIN = WS_HNY + (size_t)T * 1024 * 2;
constexpr size_t WS_WOUT = al256(WS_WIN + (size_t)NPAD * DM * 2);
constexpr size_t WS_P = al256(WS_WOUT + (size_t)DM * MIX * 2);
constexpr size_t WS_HT = al256(WS_P + (size_t)T * NP * 2);
constexpr size_t WS_G = al256(WS_HT + (size_t)1024 * T * 2);
constexpr size_t WS_KT = al256(WS_G + (size_t)T * NG * 4);
constexpr size_t WS_KF = al256(WS_KT + (size_t)WG * NF * 4);
constexpr size_t WS_HC = al256(WS_KF + (size_t)WG * NF * 8);
constexpr size_t WS_ST = al256(WS_HC + (size_t)2 * WG * CTXL * 4);
constexpr size_t WS_NV = al256(WS_ST + (size_t)2 * 2 * NB * NH * NCH * 4096 * 2);
constexpr size_t WS_BE = al256(WS_NV + (size_t)2 * NB * NH * NCH * 64 * 4);
constexpr size_t WS_SC = al256(WS_BE + (size_t)2 * NB * NH * NCH * 64 * 4);
constexpr size_t WS_MOD = al256(WS_SC + (size_t)2 * NB * NH * NCH * 4 * 4);
constexpr size_t WS_TW = al256(WS_MOD + (size_t)DEPTH * NJ * 3 * DM * 4);
constexpr size_t WS_ROPE = al256(WS_TW + (size_t)NF * 8);
constexpr size_t WS_TOTAL = al256(WS_ROPE + (size_t)SEQ * 32 * 8);
static_assert((size_t)T * DM * 4 <= (size_t)T * NP * 2, "YO fits in P");
#ifndef EMU
static_assert(WS_TOTAL <= (size_t)268435456, "workspace map must fit 256 MiB");
#endif

constexpr int LDS_BYTES = 147456;

struct Params {
    const float* in[26];
    float* out;
    char* ws;
};
enum { I_X = 0, I_C, I_CTX, I_CCTX, I_WADA, I_BADA, I_GPRE, I_GPOST, I_WIN, I_MGB, I_MNG, I_HCW, I_HCB, I_HW1, I_HB1, I_HW2, I_HB2, I_HW3, I_HB3,
       I_HFREQ, I_HD, I_GWA, I_GBA, I_GNG, I_SINK, I_WOUT };


#ifdef EMU
__device__ __forceinline__ int otid() { return (int)threadIdx.x; }
__device__ __forceinline__ int obid() { return (int)blockIdx.x; }
#else
__device__ __forceinline__ int otid() { int t = (int)threadIdx.x; asm volatile("" : "+v"(t)); return t; }
__device__ __forceinline__ int obid() { int b = (int)blockIdx.x; asm volatile("" : "+s"(b)); return b; }
#endif
__device__ __forceinline__ unsigned fbits(float f) { return __builtin_bit_cast(unsigned, f); }
__device__ __forceinline__ float bitsf(unsigned u) { return __builtin_bit_cast(float, u); }
__device__ __forceinline__ bf16 f2bf(float f) { unsigned u = fbits(f); return (bf16)((u + 0x7fffu + ((u >> 16) & 1u)) >> 16); }
__device__ __forceinline__ float bf2f(bf16 h) { return bitsf((unsigned)h << 16); }
__device__ __forceinline__ unsigned pk2(float lo, float hi) { return (unsigned)f2bf(lo) | ((unsigned)f2bf(hi) << 16); }
__device__ __forceinline__ float sigmoidf_(float x) { return 1.0f / (1.0f + __expf(-x)); }
__device__ __forceinline__ float siluf_(float x) { return x / (1.0f + __expf(-x)); }
__device__ __forceinline__ float logsigf_(float x) { return fminf(x, 0.0f) - log1pf(__expf(-fabsf(x))); }
__device__ __forceinline__ float wave_sum(float v) {
#pragma unroll
    for (int o = 1; o < 64; o <<= 1) v += __shfl_xor(v, o);
    return v;
}
__device__ __forceinline__ float wave_max(float v) {
#pragma unroll
    for (int o = 1; o < 64; o <<= 1) v = fmaxf(v, __shfl_xor(v, o));
    return v;
}
__device__ __forceinline__ float wave_prefix_sum(float v, int lane) {
#pragma unroll
    for (int o = 1; o < 64; o <<= 1) { float t = __shfl_up(v, o); if (lane >= o) v += t; }
    return v;
}
__device__ __forceinline__ float wave_prefix_max(float v, int lane) {
#pragma unroll
    for (int o = 1; o < 64; o <<= 1) { float t = __shfl_up(v, o); if (lane >= o) v = fmaxf(v, t); }
    return v;
}
__device__ __forceinline__ float wave_suffix_max(float v, int lane) {
#pragma unroll
    for (int o = 1; o < 64; o <<= 1) { float t = __shfl_down(v, o); if (lane + o < 64) v = fmaxf(v, t); }
    return v;
}
__device__ __forceinline__ void unpack8(u32x4 v, float* f) {
    f[0] = bitsf(v.x << 16); f[1] = bitsf(v.x & 0xffff0000u); f[2] = bitsf(v.y << 16); f[3] = bitsf(v.y & 0xffff0000u);
    f[4] = bitsf(v.z << 16); f[5] = bitsf(v.z & 0xffff0000u); f[6] = bitsf(v.w << 16); f[7] = bitsf(v.w & 0xffff0000u);
}
__device__ __forceinline__ int orig_col(int n) {
    if (n < 1280) return n;
    if (n < 2304) return 2320 + (n - 1280);
    if (n < 3072) return 3376 + (n - 2304);
    if (n < 3088) return 1280 + (n - 3072);
    if (n < 3120) return 3344 + (n - 3088);
    if (n < NMAIN) return -1;
    return 1296 + (n - NMAIN);
}
__device__ __forceinline__ int chain_cid(int dir, int o) {
    if (dir == 0) return o;
    return o < NCC ? (NCC - 1 - o) : (NCH - 1 - (o - NCC));
}

constexpr int LS = 72;

template <int NTL, int KS>
__device__ __forceinline__ void mma_nt(const bf16* A, int lda, int m0, const bf16* B, int ldb, int n0, f32x4 (&acc)[NTL], int lane) {
    const int r = lane & 15, q = lane >> 4;
#pragma unroll
    for (int ks = 0; ks < KS; ++ks) {
        const bf16x8 a = *(const bf16x8*)(A + (m0 + r) * lda + ks * 32 + q * 8);
#pragma unroll
        for (int nt = 0; nt < NTL; ++nt) {
            const bf16x8 b = *(const bf16x8*)(B + (n0 + nt * 16 + r) * ldb + ks * 32 + q * 8);
            acc[nt] = MFMA16(a, b, acc[nt]);
        }
    }
}

__device__ void phase0(const Params& p, char* smem) {
    const int tid = otid();
    cpx* TW = (cpx*)(p.ws + WS_TW);
    cpx* ROPE = (cpx*)(p.ws + WS_ROPE);
    float* MOD = (float*)(p.ws + WS_MOD);
    constexpr int N_TW = NF / NT, N_ROPE = SEQ * 32 / NT, N_MOD = DEPTH * (3 * DM / 64);
    for (int task = obid(); task < N_TW + N_ROPE + N_MOD; task += gridDim.x) {
        if (task < N_TW) {
            const int j = task * NT + tid; float s, c; sincospif(2.0f * (float)j / (float)NF, &s, &c);
            cpx v; v.x = c; v.y = -s; TW[j] = v;
        } else if (task < N_TW + N_ROPE) {
            const int idx = (task - N_TW) * NT + tid; const int pos = idx >> 5, i = idx & 31;
            const float inv = exp2f(-(float)(i & 15) * (13.287712379549449f / 16.0f));
            const float ang = (float)(i < 16 ? pos / 64 : pos % 64) * inv;
            cpx v; v.x = cosf(ang); v.y = sinf(ang); ROPE[idx] = v;
        } else {
            const int mt = task - N_TW - N_ROPE; const int l = mt / (3 * DM / 64), n0 = (mt % (3 * DM / 64)) * 64;
            float* sv = (float*)smem;
            float* red = sv + NJ * DM;
            __syncthreads();
            for (int i = tid; i < NJ * DM; i += NT) { const int j = i / DM, k = i % DM; const float v = j < NB ? p.in[I_C][j * DM + k] : p.in[I_CCTX][k]; sv[i] = siluf_(v); }
            __syncthreads();
            const int nl = tid & 63, ks = tid >> 6; float acc[NJ];
#pragma unroll
            for (int j = 0; j < NJ; ++j) acc[j] = 0.f;
            const float* w = p.in[I_WADA] + (size_t)l * DM * 3 * DM + n0 + nl;
            for (int k = ks * (DM / 8); k < (ks + 1) * (DM / 8); ++k) { const float wv = w[(size_t)k * 3 * DM];
#pragma unroll
                for (int j = 0; j < NJ; ++j) acc[j] += sv[j * DM + k] * wv; }
#pragma unroll
            for (int j = 0; j < NJ; ++j) red[(ks * NJ + j) * 64 + nl] = acc[j];
            __syncthreads();
            for (int i = tid; i < NJ * 64; i += NT) { const int j = i / 64, n = i % 64; float s = 0.f;
#pragma unroll
                for (int k8 = 0; k8 < 8; ++k8) s += red[(k8 * NJ + j) * 64 + n];
                MOD[((size_t)l * NJ + j) * 3 * DM + n0 + n] = s + p.in[I_BADA][(size_t)l * 3 * DM + n0 + n]; }
        }
    }
}

__device__ void rp_rows(const Params& p, int l) {
    const int tid = otid(), lane = tid & 63, wave = tid >> 6;
    const float* MOD = (const float*)(p.ws + WS_MOD);
    float* CTXB = (float*)(p.ws + WS_CTXB);
    const float* YO = (const float*)(p.ws + WS_P);
    bf16* HN = (bf16*)(p.ws + WS_HNY);
    constexpr int NV4 = DM / 256;
    for (int row = obid() * 8 + wave; row < T; row += gridDim.x * 8) {
        const int b = row / TOK, pp = row % TOK; const bool isctx = pp < CTXL;
        if (l == DEPTH && isctx) continue;
        const size_t off = isctx ? ((size_t)b * CTXL + pp) * DM : ((size_t)b * SEQ + (pp - CTXL)) * DM;
        const float* xo = (l <= 1) ? (isctx ? p.in[I_CTX] + off : p.in[I_X] + off) : (isctx ? CTXB + off : p.out + off);
        float* xn = isctx ? CTXB + off : p.out + off;
        const int mj = isctx ? NB : b;
        f32x4 x[NV4];
#pragma unroll
        for (int j = 0; j < NV4; ++j) x[j] = *(const f32x4*)(xo + 4 * lane + 256 * j);
        if (l > 0) {
            f32x4 y[NV4]; float ss = 0.f;
#pragma unroll
            for (int j = 0; j < NV4; ++j) { y[j] = *(const f32x4*)(YO + (size_t)row * DM + 4 * lane + 256 * j); ss += y[j].x * y[j].x + y[j].y * y[j].y + y[j].z * y[j].z + y[j].w * y[j].w; }
            const float rstd = rsqrtf(wave_sum(ss) * (1.0f / DM) + EPS);
            const float* gt = MOD + ((size_t)(l - 1) * NJ + mj) * 3 * DM + 2 * DM;
            const float* gp = p.in[I_GPOST] + (size_t)(l - 1) * DM;
#pragma unroll
            for (int j = 0; j < NV4; ++j) { const f32x4 g4 = *(const f32x4*)(gt + 4 * lane + 256 * j), p4 = *(const f32x4*)(gp + 4 * lane + 256 * j);
                x[j] = x[j] + g4 * (y[j] * rstd * p4);
                *(f32x4*)(xn + 4 * lane + 256 * j) = x[j]; }
        }
        if (l < DEPTH) {
            float ss = 0.f;
#pragma unroll
            for (int j = 0; j < NV4; ++j) ss += x[j].x * x[j].x + x[j].y * x[j].y + x[j].z * x[j].z + x[j].w * x[j].w;
            const float rstd = rsqrtf(wave_sum(ss) * (1.0f / DM) + EPS);
            const float* md = MOD + ((size_t)l * NJ + mj) * 3 * DM;
            const float* gp = p.in[I_GPRE] + (size_t)l * DM;
#pragma unroll
            for (int j = 0; j < NV4; ++j) { const int e = 4 * lane + 256 * j;
                const f32x4 g4 = *(const f32x4*)(gp + e), sh = *(const f32x4*)(md + e), sc = *(const f32x4*)(md + DM + e);
                const f32x4 h = (x[j] * rstd * g4) * (sc + 1.0f) + sh;
                u32x2 o; o.x = pk2(h.x, h.y); o.y = pk2(h.z, h.w);
                *(u32x2*)(HN + (size_t)row * DM + e) = o; }
        }
    }
}

__device__ void convert_tile(const float* src, int ldn, bf16* dst, int K, int n0, int k0, bool use_map, char* smem) {
    const int tid = otid();
    float* tile = (float*)smem;
    __syncthreads();
#pragma unroll
    for (int i = 0; i < 8; ++i) { const int idx = tid + NT * i, k = idx >> 6, n = idx & 63;
        const int oc = use_map ? orig_col(n0 + n) : (n0 + n);
        tile[k * 65 + n] = oc >= 0 ? src[(size_t)(k0 + k) * ldn + oc] : 0.f; }
    __syncthreads();
    const int n = tid >> 3, c = tid & 7;
    u32x4 o; o.x = pk2(tile[(8 * c + 0) * 65 + n], tile[(8 * c + 1) * 65 + n]); o.y = pk2(tile[(8 * c + 2) * 65 + n], tile[(8 * c + 3) * 65 + n]);
    o.z = pk2(tile[(8 * c + 4) * 65 + n], tile[(8 * c + 5) * 65 + n]); o.w = pk2(tile[(8 * c + 6) * 65 + n], tile[(8 * c + 7) * 65 + n]);
    *(u32x4*)(dst + (size_t)(n0 + n) * K + k0 + 8 * c) = o;
}

__device__ void filter_task(const Params& p, int l, int L, int pos0, char* smem) {
    const int tid = otid();
    float* z = (float*)smem;
    float* h1 = z + 8 * 33;
    float* h2 = h1 + 8 * 64;
    __syncthreads();
    if (tid < 8 * 33) { const int pp = tid / 33, i = tid % 33; const float pos = (float)(pos0 + pp);
        const float t = pos / (float)(L - 1 > 1 ? L - 1 : 1), w = 6.283185307179586f * pos / (float)L; float v;
        if (i == 0) v = t; else { const int bi = (i - 1) & 15; const float f = 1e-4f + (float)bi * ((15.0f - 1e-4f) / 15.0f); v = (i <= 16) ? cosf(w * f) : -sinf(w * f); }
        z[tid] = v; }
    __syncthreads();
    { const int pp = tid >> 6, j = tid & 63; const float* w1 = p.in[I_HW1] + (size_t)l * 33 * 64; float a = p.in[I_HB1][l * 64 + j];
        for (int i = 0; i < 33; ++i) a += z[pp * 33 + i] * w1[i * 64 + j];
        h1[tid] = sinf(p.in[I_HFREQ][(l * 2 + 0) * 64 + j] * a); }
    __syncthreads();
    { const int pp = tid >> 6, j = tid & 63; const float* w2 = p.in[I_HW2] + (size_t)l * 64 * 64; float a = p.in[I_HB2][l * 64 + j];
        for (int i = 0; i < 64; ++i) a += h1[pp * 64 + i] * w2[i * 64 + j];
        h2[tid] = sinf(p.in[I_HFREQ][(l * 2 + 1) * 64 + j] * a); }
    __syncthreads();
    { const int o = tid, dir = o >> 8, c = o & 255; const float* w3 = p.in[I_HW3] + (size_t)l * 64 * 512; const float b3 = p.in[I_HB3][l * 512 + o];
        const float delta = 3.0701134573253946f + (float)c * ((15.350567286626973f - 3.0701134573253946f) / 255.0f);
        float acc[8];
#pragma unroll
        for (int pp = 0; pp < 8; ++pp) acc[pp] = b3;
        for (int j = 0; j < 64; ++j) { const float wv = w3[j * 512 + o];
#pragma unroll
            for (int pp = 0; pp < 8; ++pp) acc[pp] += h2[pp * 64 + j] * wv; }
        float* KT = (float*)(p.ws + WS_KT); float* HC = (float*)(p.ws + WS_HC);
#pragma unroll
        for (int pp = 0; pp < 8; ++pp) { const int pos = pos0 + pp; const float t = (float)pos / (float)(L - 1 > 1 ? L - 1 : 1);
            const float v = acc[pp] * __expf(-t * delta);
            if (L == SEQ) { if (dir == 0) KT[(size_t)c * NF + pos]= v; else if (pos > 0) KT[(size_t)c * NF + (NF - pos)] = v; else KT[(size_t)c * NF + SEQ] = 0.f; }
            else HC[((size_t)dir * WG + c) * CTXL + pos] = v; }
    }
}

__device__ void phase_rp(const Params& p, int l, char* smem) {
    rp_rows(p, l);
    if (l >= DEPTH) return;
    constexpr int N_WIN = (NPAD / 64) * (DM / 64), N_WOUT = (DM / 64) * (MIX / 64), N_FL = SEQ / 8, N_FC = CTXL / 8;
    for (int task = obid(); task < N_WIN + N_WOUT + N_FL + N_FC; task += gridDim.x) {
        if (task < N_WIN) { const int nt = task / (DM / 64), kt = task % (DM / 64);
            convert_tile(p.in[I_WIN] + (size_t)l * DM * N_IN, N_IN, (bf16*)(p.ws + WS_WIN), DM, nt * 64, kt * 64, true, smem); }
        else if (task < N_WIN + N_WOUT) { const int t2 = task - N_WIN, nt = t2 / (MIX / 64), kt = t2 % (MIX / 64);
            convert_tile(p.in[I_WOUT] + (size_t)l * MIX * DM, DM, (bf16*)(p.ws + WS_WOUT), MIX, nt * 64, kt * 64, false, smem); }
        else if (task < N_WIN + N_WOUT + N_FL) filter_task(p, l, SEQ, (task - N_WIN - N_WOUT) * 8, smem);
        else filter_task(p, l, CTXL, (task - N_WIN - N_WOUT - N_FL) * 8, smem);
    }
}

__device__ __forceinline__ cpx cmul(cpx a, cpx b) { cpx r; r.x = a.x * b.x - a.y * b.y; r.y = a.x * b.y + a.y * b.x; return r; }
__device__ __forceinline__ cpx cmulc(cpx a, cpx b) { cpx r; r.x = a.x * b.x + a.y * b.y; r.y = a.y * b.x - a.x * b.y; return r; }
__device__ void fft_fwd(cpx* buf, const cpx* TW, int tl) {
    for (int s = 0; s < FFT_P; ++s) {
        const int span = NF >> (2 * (s + 1)), tws = 1 << (2 * s);
        __syncthreads();
#pragma unroll 1
        for (int j = tl; j < NF / 4; j += 256) {
            const int grp = j / span, pos = j % span, base = grp * 4 * span + pos;
            const cpx x0 = buf[base], x1 = buf[base + span], x2 = buf[base + 2 * span], x3 = buf[base + 3 * span];
            const cpx a = {x0.x + x2.x, x0.y + x2.y}, b = {x0.x - x2.x, x0.y - x2.y}, c = {x1.x + x3.x, x1.y + x3.y}, d = {x1.x - x3.x, x1.y - x3.y};
            const cpx y0 = {a.x + c.x, a.y + c.y}, y2 = {a.x - c.x, a.y - c.y};
            const cpx y1 = {b.x + d.y, b.y - d.x};
            const cpx y3 = {b.x - d.y, b.y + d.x};
            buf[base] = y0;
            buf[base + span] = cmul(y1, TW[pos * tws]);
            buf[base + 2 * span] = cmul(y2, TW[2 * pos * tws]);
            buf[base + 3 * span] = cmul(y3, TW[3 * pos * tws]);
        }
    }
    __syncthreads();
}
__device__ void fft_inv(cpx* buf, const cpx* TW, int tl) {
    for (int s = FFT_P - 1; s >= 0; --s) {
        const int span = NF >> (2 * (s + 1)), tws = 1 << (2 * s);
        __syncthreads();
#pragma unroll 1
        for (int j = tl; j < NF / 4; j += 256) {
            const int grp = j / span, pos = j % span, base = grp * 4 * span + pos;
            const cpx b0 = buf[base];
            const cpx b1 = cmulc(buf[base + span], TW[pos * tws]);
            const cpx b2 = cmulc(buf[base + 2 * span], TW[2 * pos * tws]);
            const cpx b3 = cmulc(buf[base + 3 * span], TW[3 * pos * tws]);
            const cpx a = {b0.x + b2.x, b0.y + b2.y}, b = {b0.x - b2.x, b0.y - b2.y}, c = {b1.x + b3.x, b1.y + b3.y}, d = {b1.x - b3.x, b1.y - b3.y};
            const cpx x0 = {a.x + c.x, a.y + c.y}, x2 = {a.x - c.x, a.y - c.y};
            const cpx x1 = {b.x - d.y, b.y + d.x};
            const cpx x3 = {b.x + d.y, b.y - d.x};
            buf[base] = x0; buf[base + span] = x1; buf[base + 2 * span] = x2; buf[base + 3 * span] = x3;
        }
    }
    __syncthreads();
}
__device__ void filt_fft_task(const Params& p, int cp, char* smem) {
    const int tid = otid(), half = tid >> 8, tl = tid & 255, c = 2 * cp + half;
    cpx* buf = (cpx*)smem + (size_t)half * NF;
    const float* KT = (const float*)(p.ws + WS_KT) + (size_t)c * NF;
    cpx* KF = (cpx*)(p.ws + WS_KF) + (size_t)c * NF;
    const cpx* TW = (const cpx*)(p.ws + WS_TW);
    __syncthreads();
    for (int i = tl; i < NF; i += 256) { cpx v; v.x = KT[i]; v.y = 0.f; buf[i] = v; }
    fft_fwd(buf, TW, tl);
    for (int i = tl; i < NF; i += 256) KF[i] = buf[i];
}

__device__ void gemm_tile(const Params& p, const bf16* A, const bf16* Bt, int K, int mt, int nt, int mode, char* smem) {
    const int tid = otid(), lane = tid & 63, wave = tid >> 6;
    bf16* As = (bf16*)smem;
    bf16* Bs = As + 128 * LS;
    const int wm = (wave & 3) * 32, wn = (wave >> 2) * 64;
    f32x4 acc[2][4];
#pragma unroll
    for (int i = 0; i < 2; ++i)
#pragma unroll
        for (int j = 0; j < 4; ++j) acc[i][j] = (f32x4){0.f, 0.f, 0.f, 0.f};
    const int lr = tid >> 3, lc = tid & 7;
    const bf16* Ag = A + (size_t)(mt * 128 + lr) * K + lc * 8;
    const bf16* Bg = Bt + (size_t)(nt * 128 + lr) * K + lc * 8;
    u32x4 ra0, ra1, rb0, rb1;
    ra0 = *(const u32x4*)(Ag); ra1 = *(const u32x4*)(Ag + (size_t)64 * K); rb0 = *(const u32x4*)(Bg); rb1 = *(const u32x4*)(Bg + (size_t)64 * K);
    const int nk = K / 64;
    for (int kt = 0; kt < nk; ++kt) {
        __syncthreads();
        *(u32x4*)(As + lr * LS + lc * 8) = ra0; *(u32x4*)(As + (lr + 64) * LS + lc * 8) = ra1;
        *(u32x4*)(Bs + lr * LS + lc * 8) = rb0; *(u32x4*)(Bs + (lr + 64) * LS + lc * 8) = rb1;
        __syncthreads();
        if (kt + 1 < nk) { const int ko = (kt + 1) * 64;
            ra0 = *(const u32x4*)(Ag + ko); ra1 = *(const u32x4*)(Ag + (size_t)64 * K + ko); rb0 = *(const u32x4*)(Bg + ko); rb1 = *(const u32x4*)(Bg + (size_t)64 * K + ko); }
        mma_nt<4, 2>(As, LS, wm, Bs, LS, wn, acc[0], lane);
        mma_nt<4, 2>(As, LS, wm + 16, Bs, LS, wn, acc[1], lane);
    }
    const int r = lane & 15, q = lane >> 4;
#pragma unroll
    for (int i = 0; i < 2; ++i)
#pragma unroll
        for (int j = 0; j < 4; ++j)
#pragma unroll
            for (int e = 0; e < 4; ++e) {
                const int row = mt * 128 + wm + 16 * i + 4 * q + e, col = nt * 128 + wn + 16 * j + r; const float v = acc[i][j][e];
                if (mode == 0) { if (col < NP) ((bf16*)(p.ws + WS_P))[(size_t)row * NP + col] = f2bf(v); else if (col < NP + NG) ((float*)(p.ws + WS_G))[(size_t)row * NG + (col - NP)] = v; }
                else if (mode == 2) ((bf16*)(p.ws + WS_HT))[(size_t)row * T + col] = f2bf(v);
                else ((float*)(p.ws + WS_P))[(size_t)row * DM + col] = v;
            }
}

#ifndef EMU
namespace pg8 {
#define PG8_LAS __attribute__((address_space(3)))
typedef unsigned short bf16_t;
typedef short bf16x8 __attribute__((ext_vector_type(8)));
typedef float f32x4 __attribute__((ext_vector_type(4)));
typedef unsigned u32x4 __attribute__((ext_vector_type(4)));
constexpr int BM = 256, BK = 64, HALF = 128, HTB = HALF * BK * 2  , STAGE_BYTES = 8 * HTB, NXCD = 8, WGM = 8;

__host__ __device__ __forceinline__ int lds_byte(int r, int c) { const int st = (r >> 4) * 2 + (c >> 5), rr = r & 15, cc = c & 31, ob = rr * 64 + cc * 2; return st * 1024 + (ob ^ (((ob >> 9) & 1) << 5)); }
__host__ __device__ __forceinline__ void stage_rc(int b, int& R, int& C) { const int st = b / 1024, sb = b % 1024, swz = sb ^ (((sb >> 9) & 1) << 5); R = (st >> 1) * 16 + swz / 64; C = (st & 1) * 32 + (swz % 64) / 2; }
__host__ __device__ __forceinline__ int perm32(int rho) { const int n = rho >> 4, i = rho & 15; return 8 * (i >> 2) + 4 * n + (i & 3); }

struct Unit { int pm, pn; };
struct Gemm { const bf16_t* A; const bf16_t* Bt; int M, N, K; };
__device__ __forceinline__ unsigned cvt_pk_bf16(float lo, float hi) { unsigned r; asm volatile("v_cvt_pk_bf16_f32 %0, %1, %2" : "=v"(r) : "v"(lo), "v"(hi)); return r; }
template <class Epi, class Sched, bool ALIGN_EPI = false, bool SP2 = false>
__device__ __forceinline__ void gemm_phase(PG8_LAS unsigned char* lds, const Gemm g, const Sched& S, const Epi& E) {
    const int tid = threadIdx.x, wid = __builtin_amdgcn_readfirstlane(tid >> 6), lane = tid & 63, wr = wid >> 2, wc = wid & 3, fr = lane & 15, fq = lane >> 4;
    const int K = g.K, nt = K / BK;
    unsigned voffA[2], voffB[2];
#pragma unroll
    for (int i = 0; i < 2; ++i) { int R, C; stage_rc(tid * 16 + i * 8192, R, C); const int Rb = Epi::PERM ? ((R & ~31) + perm32(R & 31)) : R;
        voffA[i] = (unsigned)(R * K + C) * 2u; voffB[i] = (unsigned)(Rb * K + C) * 2u; }
    const size_t kstep = (size_t)(BK * 2);
    const size_t hstep = (size_t)HALF * K * 2;
    const size_t tstep = 2 * hstep;
    const unsigned ldsw = (unsigned)wid * 1024u;
    const int aoff = lds_byte(wr * 64 + fr, fq * 8), boff = lds_byte(wc * 32 + fr, fq * 8);
#define PG8_SA(b, h) (((b) * 2 + (h)) * HTB)
#define PG8_SB(b, h) ((4 + (b) * 2 + (h)) * HTB)
#define PG8_STAGE(bufoff, gbase, voff) do { _Pragma("unroll") for (int _i = 0; _i < 2; ++_i) \
        __builtin_amdgcn_global_load_lds((const unsigned*)((const char*)(gbase) + (voff)[_i]), (PG8_LAS unsigned*)(lds + (bufoff) + ldsw + _i * 8192), 16, 0, 0); } while (0)
#define PG8_LDA(dst, b, h) do { _Pragma("unroll") for (int m = 0; m < 4; ++m) _Pragma("unroll") for (int k = 0; k < 2; ++k) dst[m][k] = *(const PG8_LAS bf16x8*)(lds + PG8_SA(b, h) + aoff + m * 2048 + k * 1024); } while (0)
#define PG8_LDB(dst, b, h) do { _Pragma("unroll") for (int n = 0; n < 2; ++n) _Pragma("unroll") for (int k = 0; k < 2; ++k) dst[n][k] = *(const PG8_LAS bf16x8*)(lds + PG8_SB(b, h) + boff + n * 2048 + k * 1024); } while (0)
#define PG8_MMA(ai, bj, At, Bt) do { __builtin_amdgcn_s_setprio(1); _Pragma("unroll") for (int m = 0; m < 4; ++m) _Pragma("unroll") for (int n = 0; n < 2; ++n) _Pragma("unroll") for (int k = 0; k < 2; ++k) \
        acc[ai][bj][m][n] = __builtin_amdgcn_mfma_f32_16x16x32_bf16(Bt[n][k], At[m][k], acc[ai][bj][m][n], 0, 0, 0); __builtin_amdgcn_s_setprio(0); } while (0)
#define PG8_WAIT_V(n) asm volatile("s_waitcnt vmcnt(" #n ")" ::: "memory")
#define PG8_WAIT_L(n) asm volatile("s_waitcnt lgkmcnt(" #n ")" ::: "memory")
#define PG8_BAR __builtin_amdgcn_s_barrier()
#define PG8_SCHED __builtin_amdgcn_sched_barrier(0)
    Unit cur, nxt; int ui = 0;
    if (!S.next(0, cur)) return;
    f32x4 acc[2][2][4][2];
#pragma unroll
    for (int a = 0; a < 2; ++a)
#pragma unroll
        for (int b = 0; b < 2; ++b)
#pragma unroll
            for (int m = 0; m < 4; ++m)
#pragma unroll
                for (int n = 0; n < 2; ++n) acc[a][b][m][n] = (f32x4){0.f, 0.f, 0.f, 0.f};
    bf16x8 At[4][2], B0[2][2], B1[2][2];
    const char* cA = (const char*)g.A + (size_t)cur.pm * tstep; const char* cB = (const char*)g.Bt + (size_t)cur.pn * tstep;
    S.a_ready(cur);
    if constexpr (SP2) {
        PG8_STAGE(PG8_SB(0, 0), cB, voffB); PG8_STAGE(PG8_SB(0, 1), cB + hstep, voffB); PG8_STAGE(PG8_SA(0, 0), cA, voffA); PG8_STAGE(PG8_SA(0, 1), cA + hstep, voffA);
        if (wr == 1) PG8_BAR;
        PG8_WAIT_V(2); PG8_BAR;
        PG8_STAGE(PG8_SB(1, 0), cB + kstep, voffB); PG8_STAGE(PG8_SA(1, 0), cA + kstep, voffA); PG8_STAGE(PG8_SB(1, 1), cB + hstep + kstep, voffB);
        PG8_WAIT_V(6); PG8_BAR;
    } else {
        PG8_STAGE(PG8_SB(0, 0), cB, voffB); PG8_STAGE(PG8_SA(0, 0), cA, voffA); PG8_STAGE(PG8_SB(0, 1), cB + hstep, voffB); PG8_STAGE(PG8_SA(0, 1), cA + hstep, voffA);
        if (wr == 1) PG8_BAR;
        PG8_WAIT_V(4); PG8_BAR;
        PG8_STAGE(PG8_SB(1, 0), cB + kstep, voffB); PG8_STAGE(PG8_SA(1, 0), cA + kstep, voffA); PG8_STAGE(PG8_SB(1, 1), cB + hstep + kstep, voffB);
        PG8_WAIT_V(6); PG8_BAR;
    }
    for (;;) {
        const bool has_next = S.next(ui + 1, nxt);
        const char* nA = has_next ? (const char*)g.A + (size_t)nxt.pm * tstep : cA; const char* nB = has_next ? (const char*)g.Bt + (size_t)nxt.pn * tstep : cB;
        for (int t = 0; t < nt; t += 2) {
            const bool last = (t == nt - 2);
            const char* a1 = cA + (size_t)(t + 1) * kstep;
            const char* a2 = last ? nA : cA + (size_t)(t + 2) * kstep; const char* b2 = last ? nB : cB + (size_t)(t + 2) * kstep;
            const char* a3 = a2 + kstep; const char* b3 = b2 + kstep;
            if (last && has_next) S.a_ready(nxt);
            if constexpr (SP2) {
            PG8_LDB(B0, 0, 0); PG8_LDB(B1, 0, 1); PG8_SCHED; PG8_LDA(At, 0, 0); PG8_STAGE(PG8_SA(1, 1), a1 + hstep, voffA);
            PG8_WAIT_V(8); PG8_WAIT_L(0); PG8_BAR; PG8_MMA(0, 0, At, B0); PG8_MMA(0, 1, At, B1); PG8_BAR; PG8_SCHED;
            PG8_LDA(At, 0, 1); PG8_STAGE(PG8_SB(0, 0), b2, voffB); PG8_STAGE(PG8_SB(0, 1), b2 + hstep, voffB); PG8_STAGE(PG8_SA(0, 0), a2, voffA);
            PG8_WAIT_V(8); PG8_WAIT_L(0); PG8_BAR; PG8_MMA(1, 0, At, B0); PG8_MMA(1, 1, At, B1); PG8_BAR; PG8_SCHED;
            PG8_LDB(B0, 1, 0); PG8_LDB(B1, 1, 1); PG8_SCHED; PG8_LDA(At, 1, 0); PG8_STAGE(PG8_SA(0, 1), a2 + hstep, voffA);
            PG8_WAIT_V(8); PG8_WAIT_L(0); PG8_BAR; PG8_MMA(0, 0, At, B0); PG8_MMA(0, 1, At, B1); PG8_BAR; PG8_SCHED;
            PG8_LDA(At, 1, 1); PG8_STAGE(PG8_SB(1, 0), b3, voffB); PG8_STAGE(PG8_SB(1, 1), b3 + hstep, voffB); PG8_STAGE(PG8_SA(1, 0), a3, voffA);
            PG8_WAIT_V(8); PG8_WAIT_L(0); PG8_BAR; PG8_MMA(1, 0, At, B0); PG8_MMA(1, 1, At, B1); PG8_BAR; PG8_SCHED;
            } else {
            PG8_LDB(B0, 0, 0); PG8_SCHED; PG8_LDA(At, 0, 0); PG8_STAGE(PG8_SA(1, 1), a1 + hstep, voffA);
            PG8_WAIT_L(8); PG8_BAR; PG8_WAIT_L(0); PG8_MMA(0, 0, At, B0); PG8_BAR; PG8_SCHED;
            PG8_LDB(B1, 0, 1); PG8_STAGE(PG8_SB(0, 0), b2, voffB);
            PG8_BAR; PG8_WAIT_L(0); PG8_MMA(0, 1, At, B1); PG8_BAR;
            PG8_LDA(At, 0, 1); PG8_STAGE(PG8_SA(0, 0), a2, voffA);
            PG8_BAR; PG8_WAIT_L(0); PG8_MMA(1, 0, At, B0); PG8_BAR; PG8_SCHED;
            PG8_STAGE(PG8_SB(0, 1), b2 + hstep, voffB);
            PG8_WAIT_V(6); PG8_BAR; PG8_MMA(1, 1, At, B1); PG8_BAR;
            PG8_LDB(B0, 1, 0); PG8_SCHED; PG8_LDA(At, 1, 0); PG8_STAGE(PG8_SA(0, 1), a2 + hstep, voffA);
            PG8_WAIT_L(8); PG8_BAR; PG8_WAIT_L(0); PG8_MMA(0, 0, At, B0); PG8_BAR; PG8_SCHED;
            PG8_LDB(B1, 1, 1); PG8_STAGE(PG8_SB(1, 0), b3, voffB);
            PG8_BAR; PG8_WAIT_L(0); PG8_MMA(0, 1, At, B1); PG8_BAR;
            PG8_LDA(At, 1, 1); PG8_STAGE(PG8_SA(1, 0), a3, voffA);
            PG8_BAR; PG8_WAIT_L(0); PG8_MMA(1, 0, At, B0); PG8_BAR; PG8_SCHED;
            PG8_STAGE(PG8_SB(1, 1), b3 + hstep, voffB);
            PG8_WAIT_V(6); PG8_BAR; PG8_MMA(1, 1, At, B1); PG8_BAR;
            }
        }
        if constexpr (ALIGN_EPI) { if (wr == 0) PG8_BAR; }
        if constexpr (!Epi::AFTER_DRAIN) { E(acc, cur, wr, wc, fr, fq); S.done(cur); }
        if (!has_next) break;
#pragma unroll
        for (int a = 0; a < 2; ++a)
#pragma unroll
            for (int b = 0; b < 2; ++b)
#pragma unroll
                for (int m = 0; m < 4; ++m)
#pragma unroll
                    for (int n = 0; n < 2; ++n) acc[a][b][m][n] = (f32x4){0.f, 0.f, 0.f, 0.f};
        cur = nxt; cA = nA; cB = nB; ++ui;
        if constexpr (ALIGN_EPI) { if (wr == 1) PG8_BAR; }
    }
    PG8_WAIT_V(0);
    if constexpr (!ALIGN_EPI) { if (wr == 0) PG8_BAR; }
    PG8_BAR;
    if constexpr (Epi::AFTER_DRAIN) { E.fused(acc, cur, wr, wc, fr, fq, lds, wid, lane); S.done(cur); }
#undef PG8_SA
#undef PG8_SB
#undef PG8_STAGE
#undef PG8_LDA
#undef PG8_LDB
#undef PG8_MMA
#undef PG8_WAIT_V
#undef PG8_WAIT_L
#undef PG8_BAR
#undef PG8_SCHED
}
__device__ __forceinline__ void map_tile(int L, int nM, int nN, int& pm, int& pn) {
    const int nwg = nM * nN; int wgid = L; { const int q = nwg / NXCD, r = nwg % NXCD, xcd = wgid % NXCD, off = wgid / NXCD; wgid = (xcd < r ? xcd * (q + 1) : r * (q + 1) + (xcd - r) * q) + off; }
    const int nig = WGM * nN, gid = wgid / nig, fm = gid * WGM, gsz = (nM - fm) < WGM ? (nM - fm) : WGM;
    pm = fm + ((wgid % nig) % gsz); pn = (wgid % nig) / gsz;
}
constexpr int MP = T / 256, WP = NMAIN / 256, NU2 = 4 * MP, NU1 = MP * WP;
struct InOrder { int G, c;
    __device__ __forceinline__ bool next(int i, Unit& u) const { const int L = i * G + c; if (L >= NU2 + NU1) return false; int a, b;
        if (L < NU2) { map_tile(L, 4, MP, a, b); u.pm = MP + WP + a; u.pn = b; } else { map_tile(L - NU2, MP, WP, a, b); u.pm = a; u.pn = MP + b; } return true; }
    __device__ __forceinline__ void a_ready(const Unit&) const {}
    __device__ __forceinline__ void done(const Unit&) const {}
};
struct EpiIn { static constexpr bool PERM = true, AFTER_DRAIN = false; bf16_t* P; float* G; bf16_t* HTp;
    __device__ __forceinline__ void operator()(const f32x4 (&acc)[2][2][4][2], const Unit& u, int wr, int wc, int fr, int fq) const {
        if (u.pm < MP) { const int pn = u.pn - MP, row0 = u.pm * BM + wr * 64 + fr;
            if (pn < NP / 256) { const int col0 = pn * BM + wc * 32 + 8 * fq;
#pragma unroll
                for (int ai = 0; ai < 2; ++ai)
#pragma unroll
                    for (int m = 0; m < 4; ++m) { bf16_t* rowp = P + (size_t)(row0 + ai * HALF + m * 16) * NP + col0;
#pragma unroll
                        for (int bj = 0; bj < 2; ++bj) { const f32x4 v0 = acc[ai][bj][m][0], v1 = acc[ai][bj][m][1];
                            u32x4 w; w.x = cvt_pk_bf16(v0[0], v0[1]); w.y = cvt_pk_bf16(v0[2], v0[3]); w.z = cvt_pk_bf16(v1[0], v1[1]); w.w = cvt_pk_bf16(v1[2], v1[3]); *(u32x4*)(rowp + bj * HALF) = w; } } }
            else { const int cb = wc * 32 + 8 * fq;
                if (cb < NG) {
#pragma unroll
                    for (int ai = 0; ai < 2; ++ai)
#pragma unroll
                        for (int m = 0; m < 4; ++m) { float* rowp = G + (size_t)(row0 + ai * HALF + m * 16) * NG + cb; *(f32x4*)rowp = acc[ai][0][m][0]; *(f32x4*)(rowp + 4) = acc[ai][0][m][1]; } } } }
        else { const int row0 = (u.pm - MP - WP) * BM + wr * 64 + fr, col0 = u.pn * BM + wc * 32 + 8 * fq;
#pragma unroll
            for (int ai = 0; ai < 2; ++ai)
#pragma unroll
                for (int m = 0; m < 4; ++m) { bf16_t* rowp = HTp + (size_t)(row0 + ai * HALF + m * 16) * T + col0;
#pragma unroll
                    for (int bj = 0; bj < 2; ++bj) { const f32x4 v0 = acc[ai][bj][m][0], v1 = acc[ai][bj][m][1];
                        u32x4 w; w.x = cvt_pk_bf16(v0[0], v0[1]); w.y = cvt_pk_bf16(v0[2], v0[3]); w.z = cvt_pk_bf16(v1[0], v1[1]); w.w = cvt_pk_bf16(v1[2], v1[3]); *(u32x4*)(rowp + bj * HALF) = w; } } }
    }
};
struct OutOrder { int G, c; bool lat_only;
    __device__ __forceinline__ bool next(int i, Unit& u) const { const int nM = lat_only ? NB * (SEQ / 256) : MP, nN = DM / 256; const int L = i * G + c; if (L >= nM * nN) return false; int a, b; map_tile(L, nM, nN, a, b);
        u.pm = lat_only ? (a / (SEQ / 256)) * (TOK / 256) + CTXL / 256 + a % (SEQ / 256) : a; u.pn = b; return true; }
    __device__ __forceinline__ void a_ready(const Unit&) const {}
    __device__ __forceinline__ void done(const Unit&) const {}
};
struct EpiOut { static constexpr bool PERM = false, AFTER_DRAIN = false; float* C;
    __device__ __forceinline__ void operator()(const f32x4 (&acc)[2][2][4][2], const Unit& u, int wr, int wc, int fr, int fq) const {
        const int row0 = u.pm * BM + wr * 64 + fr, col0 = u.pn * BM + wc * 32 + 4 * fq;
#pragma unroll
        for (int ai = 0; ai < 2; ++ai)
#pragma unroll
            for (int m = 0; m < 4; ++m) { float* rowp = C + (size_t)(row0 + ai * HALF + m * 16) * DM + col0;
#pragma unroll
                for (int bj = 0; bj < 2; ++bj)
#pragma unroll
                    for (int n = 0; n < 2; ++n) *(f32x4*)(rowp + bj * HALF + n * 16) = acc[ai][bj][m][n]; }
    }
};
}
#endif

__device__ void phase_gemm_in(const Params& p, int l, char* smem) {
    constexpr int N_F = WG / 2;
#ifdef EMU
    constexpr int MT = T / 128, NT1 = NMAIN / 128, N1 = MT * NT1, N2 = 8 * MT;
    for (int task = obid(); task < N1 + N2; task += gridDim.x) {
        if (task < N1) gemm_tile(p, (const bf16*)(p.ws + WS_HNY), (const bf16*)(p.ws + WS_WIN), DM, task / NT1, task % NT1, 0, smem);
        else { const int t2 = task - N1; gemm_tile(p, (const bf16*)(p.ws + WS_WIN) + (size_t)NMAIN * DM, (const bf16*)(p.ws + WS_HNY), DM, t2 / MT, t2 % MT, 2, smem); }
    }
#else
    { const pg8::Gemm g{(const pg8::bf16_t*)(p.ws + WS_HNY), (const pg8::bf16_t*)(p.ws + WS_HNY), 0, 0, DM};
      const pg8::InOrder S{(int)gridDim.x, obid()};
      const pg8::EpiIn E{(pg8::bf16_t*)(p.ws + WS_P), (float*)(p.ws + WS_G), (pg8::bf16_t*)(p.ws + WS_HT)};
      pg8::gemm_phase<pg8::EpiIn, pg8::InOrder, true, true>((PG8_LAS unsigned char*)smem, g, S, E); }
#endif
    for (int task = (int)gridDim.x - 1 - obid(); task < N_F; task += gridDim.x) filt_fft_task(p, task, smem);
}
__device__ void phase_gemm_out(const Params& p, int l, char* smem) {
#ifdef EMU
    constexpr int MT = T / 128, NTO = DM / 128;
    for (int task = obid(); task < MT * NTO; task += gridDim.x) {
        const int mt = task / NTO, nt = task % NTO;
        if (l == DEPTH - 1 && (mt % (TOK / 128)) < CTXL / 128) continue;
        gemm_tile(p, (const bf16*)(p.ws + WS_HNY), (const bf16*)(p.ws + WS_WOUT), MIX, mt, nt, 1, smem);
    }
#else
    const pg8::Gemm g{(const pg8::bf16_t*)(p.ws + WS_HNY), (const pg8::bf16_t*)(p.ws + WS_WOUT), 0, 0, MIX};
    const pg8::OutOrder S{(int)gridDim.x, obid(), l == DEPTH - 1};
    const pg8::EpiOut E{(float*)(p.ws + WS_P)};
    pg8::gemm_phase<pg8::EpiOut, pg8::OutOrder, true, true>((PG8_LAS unsigned char*)smem, g, S, E);
#endif
}

__device__ __forceinline__ size_t st_index(int mixer, int dir, int b, int h, int cid) { return ((((size_t)(mixer * 2 + dir) * NB + b) * NH + h) * NCH + cid); }
__device__ __forceinline__ size_t ch_index(int dir, int b, int h, int cid) { return (((size_t)dir * NB + b) * NH + h) * NCH + cid; }

__device__ __forceinline__ void load_tile_nat(const bf16* P, int r0, int c0, bf16* dst, float scale, int tid) {
    const int s = tid >> 3, c8 = tid & 7;
    const u32x4 v = *(const u32x4*)(P + (size_t)(r0 + s) * NP + c0 + c8 * 8);
    if (scale == 1.0f) *(u32x4*)(dst + s * LS + c8 * 8) = v;
    else { float f[8]; unpack8(v, f); u32x4 o; o.x = pk2(f[0] * scale, f[1] * scale); o.y = pk2(f[2] * scale, f[3] * scale); o.z = pk2(f[4] * scale, f[5] * scale); o.w = pk2(f[6] * scale, f[7] * scale);
        *(u32x4*)(dst + s * LS + c8 * 8) = o; }
}
__device__ __forceinline__ void load_tile_tr(const bf16* P, int r0, int c0, bf16* dst, int tid) {
    const int s = tid >> 3, c8 = tid & 7;
    const u32x4 v = *(const u32x4*)(P + (size_t)(r0 + s) * NP + c0 + c8 * 8);
    const unsigned w[4] = {v.x, v.y, v.z, v.w};
#pragma unroll
    for (int j = 0; j < 4; ++j) { dst[(c8 * 8 + 2 * j) * LS + s] = (bf16)(w[j] & 0xffffu); dst[(c8 * 8 + 2 * j + 1) * LS + s] = (bf16)(w[j] >> 16); }
}

__device__ void gla_decay(const Params& p, int l, int h, int dir, const float* rs, float* la, int tid) {
    const int lane = tid & 63, wave = tid >> 6;
    { const int d = tid & 63, sg = tid >> 6; float w[16];
        const float* wa = p.in[I_GWA] + ((size_t)(l * 2 + dir) * 16) * WG + h * 64 + d;
#pragma unroll
        for (int j = 0; j < 16; ++j) w[j] = wa[(size_t)j * WG];
        const float ba = p.in[I_GBA][(size_t)(l * 2 + dir) * WG + h * 64 + d];
        for (int s = sg * 8; s < sg * 8 + 8; ++s) { float a = ba;
#pragma unroll
            for (int j = 0; j < 16; ++j) a += rs[s * 32 + dir * 16 + j] * w[j];
            la[s * 65 + d] = logsigf_(a) * (1.0f / 16.0f); } }
    __syncthreads();
    for (int d = wave * 8; d < wave * 8 + 8; ++d) {
        float v = la[lane * 65 + d];
        if (dir == 0) v = wave_prefix_sum(v, lane);
        else { const float tot = wave_sum(v); const float pre = wave_prefix_sum(v, lane); v = tot - pre + v; }
        la[lane * 65 + d] = v;
    }
    __syncthreads();
}

__device__ void chunkst_task(const Params& p, int l, int mixer, int b, int h, int cid, char* smem) {
    const int tid = otid(), lane = tid & 63, wave = tid >> 6;
    const bf16* P = (const bf16*)(p.ws + WS_P); const float* G = (const float*)(p.ws + WS_G);
    bf16* ST = (bf16*)(p.ws + WS_ST);
    const int r0 = b * TOK + cid * 64;
    bf16* Vt = (bf16*)smem;
    bf16* Kt = Vt + 64 * LS;
    float* wv = (float*)(Kt + 64 * LS);
    float* rs = wv + 128;
    float* la = rs + 64 * 32;
    float* bend = la + 64 * 65;
    __syncthreads();
    const int kcol = mixer == 0 ? PA + 256 + h * 64 : PG + 256 + h * 64, vcol = mixer == 0 ? PA + 512 + h * 64 : PG + 512 + h * 64;
    load_tile_tr(P, r0, vcol, Vt, tid);
    if (mixer == 0) {
        if (wave == 0) {
            const float* g = G + (size_t)(r0 + lane) * NG; const float* gb = p.in[I_MGB] + (size_t)l * 16;
            const float i_f = g[h] + gb[h], f_f = g[4 + h] + gb[4 + h], i_b = g[8 + h] + gb[8 + h], f_b = g[12 + h] + gb[12 + h];
            const float lf = logsigf_(f_f), lb = logsigf_(f_b);
            const float bF = wave_prefix_sum(lf, lane), totF = __shfl(bF, 63);
            const float gF = totF - bF + i_f, mF = wave_max(gF);
            const float totB = wave_sum(lb), preB = wave_prefix_sum(lb, lane), bB = totB - preB + lb;
            const float gB = totB - bB + i_b, mB = wave_max(gB);
            wv[lane] = __expf(gF - mF); wv[64 + lane] = __expf(gB - mB);
            if (lane == 0) { float* SC = (float*)(p.ws + WS_SC);
                SC[ch_index(0, b, h, cid) * 4 + 0] = totF; SC[ch_index(0, b, h, cid) * 4 + 1] = mF;
                SC[ch_index(1, b, h, cid) * 4 + 0] = totB; SC[ch_index(1, b, h, cid) * 4 + 1] = mB; }
        }
    } else {
        for (int i = tid; i < 64 * 32; i += NT) rs[i] = G[(size_t)(r0 + (i >> 5)) * NG + 16 + (i & 31)];
    }
    __syncthreads();
    for (int dir = 0; dir < 2; ++dir) {
        if (mixer == 1) {
            gla_decay(p, l, h, dir, rs, la, tid);
            if (tid < 64) { const float be = dir == 0 ? la[63 * 65 + tid] : la[tid]; bend[tid] = be; ((float*)(p.ws + WS_BE))[ch_index(dir, b, h, cid) * 64 + tid] = be; }
            __syncthreads();
        }
        {
            const int s = tid >> 3, c8 = tid & 7; float f[8];
            unpack8(*(const u32x4*)(P + (size_t)(r0 + s) * NP + kcol + c8 * 8), f);
#pragma unroll
            for (int j = 0; j < 8; ++j) { const int d = c8 * 8 + j;
                const float w = mixer == 0 ? 0.125f * wv[dir * 64 + s] : __expf(bend[d] - la[s * 65 + d]);
                Kt[d * LS + s] = f2bf(f[j] * w); }
        }
        __syncthreads();
        f32x4 acc[2] = {(f32x4){0.f, 0.f, 0.f, 0.f}, (f32x4){0.f, 0.f, 0.f, 0.f}};
        const int e0 = (wave & 3) * 16, d0 = (wave >> 2) * 32;
        mma_nt<2, 2>(Vt, LS, e0, Kt, LS, d0, acc, lane);
        bf16* dst = ST + st_index(mixer, dir, b, h, cid) * 4096;
        const int r = lane & 15, q = lane >> 4;
#pragma unroll
        for (int nt = 0; nt < 2; ++nt)
#pragma unroll
            for (int i = 0; i < 4; ++i) dst[(e0 + 4 * q + i) * 64 + d0 + 16 * nt + r] = f2bf(acc[nt][i]);
        if (mixer == 0 && tid < 64) { float s = 0.f; for (int j = 0; j < 64; ++j) s += bf2f(Kt[tid * LS + j]);
            ((float*)(p.ws + WS_NV))[ch_index(dir, b, h, cid) * 64 + tid] = s; }
        __syncthreads();
    }
}

template <int NTK>
__device__ __forceinline__ void load_span(const bf16* row, int t0, float (&v)[NTK + 2]) {
    v[0] = t0 > 0 ? bf2f(row[-1]) : 0.f; v[NTK + 1] = (t0 + NTK < SEQ) ? bf2f(row[NTK]) : 0.f;
    if constexpr (NTK == 8) { float f[8]; unpack8(*(const u32x4*)row, f);
#pragma unroll
        for (int i = 0; i < 8; ++i) v[1 + i] = f[i]; }
    else {
#pragma unroll
        for (int i = 0; i < NTK; ++i) v[1 + i] = bf2f(row[i]); }
}
__device__ void hylat_task(const Params& p, int l, int bp, int cp, char* smem) {
    const int tid = otid(), half = tid >> 8, tl = tid & 255, c = 2 * cp + half;
    const bf16* HT = (const bf16*)(p.ws + WS_HT); bf16* Y = (bf16*)(p.ws + WS_HNY);
    cpx* buf = (cpx*)smem + (size_t)half * NF;
    const cpx* TW = (const cpx*)(p.ws + WS_TW);
    const cpx* KF = (const cpx*)(p.ws + WS_KF) + (size_t)c * NF;
    constexpr int NTK = SEQ / 256;
    const int t0 = NTK * tl;
    const float* cw = p.in[I_HCW] + (size_t)l * 3 * 768; const float* cb = p.in[I_HCB] + (size_t)l * 768;
    const size_t rb0 = (size_t)(2 * bp) * TOK + CTXL, rb1 = rb0 + TOK;
    const bf16* h0 = HT + (size_t)c * T + rb0 + t0; const bf16* h1 = h0 + TOK;
    float u0[NTK], u1[NTK], g0[NTK], g1[NTK];
    { float xa[NTK + 2], xb[NTK + 2]; load_span<NTK>(h0 + (size_t)512 * T, t0, xa); load_span<NTK>(h1 + (size_t)512 * T, t0, xb);
        const float w0 = cw[0 * 768 + 512 + c], w1 = cw[1 * 768 + 512 + c], w2 = cw[2 * 768 + 512 + c], bb = cb[512 + c];
        float ga[NTK + 2], gb[NTK + 2]; load_span<NTK>(h0 + (size_t)768 * T, t0, ga); load_span<NTK>(h1 + (size_t)768 * T, t0, gb);
#pragma unroll
        for (int i = 0; i < NTK; ++i) { g0[i] = (w0 * xa[i] + w1 * xa[i + 1] + w2 * xa[i + 2] + bb) * siluf_(ga[i + 1]); g1[i] = (w0 * xb[i] + w1 * xb[i + 1] + w2 * xb[i + 2] + bb) * siluf_(gb[i + 1]); } }
    { float va[NTK + 2], vb[NTK + 2], ya[NTK + 2], yb[NTK + 2];
        load_span<NTK>(h0, t0, va); load_span<NTK>(h1, t0, vb); load_span<NTK>(h0 + (size_t)256 * T, t0, ya); load_span<NTK>(h1 + (size_t)256 * T, t0, yb);
        const float v0 = cw[0 * 768 + c], v1 = cw[1 * 768 + c], v2 = cw[2 * 768 + c], vbias = cb[c];
        const float y0 = cw[0 * 768 + 256 + c], y1 = cw[1 * 768 + 256 + c], y2 = cw[2 * 768 + 256 + c], ybias = cb[256 + c];
#pragma unroll
        for (int i = 0; i < NTK; ++i) { u0[i] = (v0 * va[i] + v1 * va[i + 1] + v2 * va[i + 2] + vbias) * (y0 * ya[i] + y1 * ya[i + 1] + y2 * ya[i + 2] + ybias);
            u1[i] = (v0 * vb[i] + v1 * vb[i + 1] + v2 * vb[i + 2] + vbias) * (y0 * yb[i] + y1 * yb[i + 1] + y2 * yb[i + 2] + ybias); } }
    __syncthreads();
#pragma unroll
    for (int i = 0; i < NTK; ++i) { cpx v; v.x = u0[i]; v.y = u1[i]; buf[t0 + i] = v; cpx z = {0.f, 0.f}; buf[SEQ + t0 + i] = z; }
    fft_fwd(buf, TW, tl);
#pragma unroll 2
    for (int i = tl; i < NF; i += 256) buf[i] = cmul(buf[i], KF[i]);
    fft_inv(buf, TW, tl);
    const float dsk = p.in[I_HD][(size_t)l * WG + c]; const float sc = 1.0f / (float)NF;
    bf16* yb0 = Y + (rb0 + t0) * 1024 + YH + c; bf16* yb1 = Y + (rb1 + t0) * 1024 + YH + c;
#pragma unroll
    for (int i = 0; i < NTK; ++i) { const cpx y = buf[t0 + i];
        yb0[i * 1024] = f2bf(g0[i] * (y.x * sc + u0[i] * dsk));
        yb1[i * 1024] = f2bf(g1[i] * (y.y * sc + u1[i] * dsk)); }
}

constexpr int HCB = 8;
__device__ void hyctx_task(const Params& p, int l, int b, int cblk, char* smem) {
    const int tid = otid(); const int c0 = cblk * HCB;
    const bf16* HT = (const bf16*)(p.ws + WS_HT); bf16* Y = (bf16*)(p.ws + WS_HNY); const float* HC = (const float*)(p.ws + WS_HC);
    float* raw = (float*)smem;
    float* u = raw + 3 * CTXL * HCB;
    float* hf = u + CTXL * HCB;
    float* hb = hf + CTXL * HCB;
    float* og = hb + CTXL * HCB;
    const size_t rb = (size_t)b * TOK;
    const float* cw = p.in[I_HCW] + (size_t)l * 3 * 768; const float* cbias = p.in[I_HCB] + (size_t)l * 768;
    __syncthreads();
    for (int i = tid; i < 3 * CTXL * HCB; i += NT) { const int k = i / (CTXL * HCB), cc = (i / CTXL) % HCB, t = i % CTXL; raw[(k * CTXL + t) * HCB + cc] = bf2f(HT[(size_t)(k * 256 + c0 + cc) * T + rb + t]); }
    for (int i = tid; i < CTXL * HCB; i += NT) { const int t = i / HCB, cc = i % HCB; hf[i] = HC[((size_t)0 * WG + c0 + cc) * CTXL + t]; hb[i] = HC[((size_t)1 * WG + c0 + cc) * CTXL + t]; }
    __syncthreads();
    for (int i = tid; i < CTXL * HCB; i += NT) { const int t = i / HCB, cc = i % HCB; float cv[3];
#pragma unroll
        for (int k = 0; k < 3; ++k) { const float* rk = raw + k * CTXL * HCB; const int ch = k * 256 + c0 + cc;
            const float a = t > 0 ? rk[(t - 1) * HCB + cc] : 0.f, m = rk[t * HCB + cc], z = t < CTXL - 1 ? rk[(t + 1) * HCB + cc] : 0.f;
            cv[k] = cw[0 * 768 + ch] * a + cw[1 * 768 + ch] * m + cw[2 * 768 + ch] * z + cbias[ch]; }
        u[i] = cv[0] * cv[1];
        og[i] = cv[2] * siluf_(bf2f(HT[(size_t)(768 + c0 + cc) * T + rb + t])); }
    __syncthreads();
    { const int cc = tid % HCB, tg = tid / HCB; constexpr int TG = NT / HCB, NTK = CTXL / TG; float acc[NTK];
#pragma unroll
        for (int i = 0; i < NTK; ++i) acc[i] = 0.f;
        for (int s = 0; s < CTXL; ++s) { const float us = u[s * HCB + cc];
#pragma unroll
            for (int i = 0; i < NTK; ++i) { const int t = tg + TG * i; const float hv = (s <= t) ? hf[(t - s) * HCB + cc] : hb[(s - t) * HCB + cc]; acc[i] += us * hv; } }
        const float dsk = p.in[I_HD][(size_t)l * WG + c0 + cc];
#pragma unroll
        for (int i = 0; i < NTK; ++i) { const int t = tg + TG * i; Y[(rb + t) * 1024 + YH + c0 + cc] = f2bf(og[t * HCB + cc] * (acc[i] + u[t * HCB + cc] * dsk)); } }
}

__device__ void attn_task(const Params& p, int l, int b, int kvh, int qt, bool ctxq, char* smem) {
    const int tid = otid(), lane = tid & 63, wave = tid >> 6, r = lane & 15, q = lane >> 4;
    const bf16* P = (const bf16*)(p.ws + WS_P); bf16* Y = (bf16*)(p.ws + WS_HNY); const cpx* ROPE = (const cpx*)(p.ws + WS_ROPE);
    bf16* Qs = (bf16*)smem;
    bf16* Ks = Qs + 128 * LS;
    bf16* Vt = Ks + 64 * LS;
    bf16* Ps = Vt + 64 * LS;
    const size_t rq0 = (size_t)b * TOK + (ctxq ? 0 : CTXL) + qt * 64;
    __syncthreads();
    {
        const int row = tid >> 2, cpair = tid & 3, g = row >> 6, t = row & 63;
        const bf16* src = P + (rq0 + t) * NP + PD + (kvh * 2 + g) * 64;
        float lo[8], hi[8]; unpack8(*(const u32x4*)(src + cpair * 8), lo); unpack8(*(const u32x4*)(src + 32 + cpair * 8), hi);
        u32x4 o1, o2; float a[8], c2[8];
#pragma unroll
        for (int j = 0; j < 8; ++j) { float cs = 1.f, sn = 0.f; if (!ctxq) { const cpx cv = ROPE[(size_t)(qt * 64 + t) * 32 + cpair * 8 + j]; cs = cv.x; sn = cv.y; }
            a[j] = (lo[j] * cs - hi[j] * sn) * 0.125f; c2[j] = (hi[j] * cs + lo[j] * sn) * 0.125f; }
        o1.x = pk2(a[0], a[1]); o1.y = pk2(a[2], a[3]); o1.z = pk2(a[4], a[5]); o1.w = pk2(a[6], a[7]);
        o2.x = pk2(c2[0], c2[1]); o2.y = pk2(c2[2], c2[3]); o2.z = pk2(c2[4], c2[5]); o2.w = pk2(c2[6], c2[7]);
        *(u32x4*)(Qs + row * LS + cpair * 8) = o1; *(u32x4*)(Qs + row * LS + 32 + cpair * 8) = o2;
    }
    const int lt0 = ctxq ? 0 : (qt - 2 > 0 ? qt - 2 : 0), lt1 = ctxq ? -1 : (qt + 2 < SEQ / 64 - 1 ? qt + 2 : SEQ / 64 - 1);
    const int nloc = lt1 - lt0 + 1, ntiles = nloc + NCC;
    float m[4], lsum[4]; f32x4 O[4];
#pragma unroll
    for (int i = 0; i < 4; ++i) { m[i] = -INFINITY; lsum[i] = 0.f; O[i] = (f32x4){0.f, 0.f, 0.f, 0.f}; }
    const int g = wave >> 2, tq0 = (wave & 3) * 16;
    bf16* Pw = Ps + wave * 16 * LS;
    for (int ti = 0; ti < ntiles; ++ti) {
        const bool local = ti < nloc; const int kt = local ? lt0 + ti : ti - nloc;
        const size_t rk0 = (size_t)b * TOK + (local ? CTXL : 0) + kt * 64;
        __syncthreads();
        if (tid < 256) { const int s = tid >> 2, cpair = tid & 3; const bf16* src = P + (rk0 + s) * NP + PD + 256 + kvh * 64;
            float lo[8], hi[8]; unpack8(*(const u32x4*)(src + cpair * 8), lo); unpack8(*(const u32x4*)(src + 32 + cpair * 8), hi);
            float a[8], c2[8];
#pragma unroll
            for (int j = 0; j < 8; ++j) { float cs = 1.f, sn = 0.f; if (local) { const cpx cv = ROPE[(size_t)(kt * 64 + s) * 32 + cpair * 8 + j]; cs = cv.x; sn = cv.y; }
                a[j] = lo[j] * cs - hi[j] * sn; c2[j] = hi[j] * cs + lo[j] * sn; }
            u32x4 o1, o2;
            o1.x = pk2(a[0], a[1]); o1.y = pk2(a[2], a[3]); o1.z = pk2(a[4], a[5]); o1.w = pk2(a[6], a[7]);
            o2.x = pk2(c2[0], c2[1]); o2.y = pk2(c2[2], c2[3]); o2.z = pk2(c2[4], c2[5]); o2.w = pk2(c2[6], c2[7]);
            *(u32x4*)(Ks + s * LS + cpair * 8) = o1; *(u32x4*)(Ks + s * LS + 32 + cpair * 8) = o2; }
        load_tile_tr(P, (int)rk0, PD + 384 + kvh * 64, Vt, tid);
        __syncthreads();
        f32x4 S[4] = {(f32x4){0.f, 0.f, 0.f, 0.f}, (f32x4){0.f, 0.f, 0.f, 0.f}, (f32x4){0.f, 0.f, 0.f, 0.f}, (f32x4){0.f, 0.f, 0.f, 0.f}};
        mma_nt<4, 2>(Qs, LS, g * 64 + tq0, Ks, LS, 0, S, lane);
        float rmax[4], rsum[4];
#pragma unroll
        for (int i = 0; i < 4; ++i) { const int qpos = qt * 64 + tq0 + 4 * q + i; float mx = -INFINITY;
#pragma unroll
            for (int nt = 0; nt < 4; ++nt) { if (local) { const int kpos = kt * 64 + nt * 16 + r; const int d = kpos - qpos; if (d > 128 || d < -128) S[nt][i] = -INFINITY; } mx = fmaxf(mx, S[nt][i]); }
            mx = fmaxf(mx, __shfl_xor(mx, 1)); mx = fmaxf(mx, __shfl_xor(mx, 2)); mx = fmaxf(mx, __shfl_xor(mx, 4)); mx = fmaxf(mx, __shfl_xor(mx, 8));
            rmax[i] = mx; }
#pragma unroll
        for (int i = 0; i < 4; ++i) { const float mn = fmaxf(m[i], rmax[i]); const float alpha = __expf(m[i] - mn); float sm = 0.f;
#pragma unroll
            for (int nt = 0; nt < 4; ++nt) { const float pv = __expf(S[nt][i] - mn); sm += pv; Pw[(4 * q + i) * LS + nt * 16 + r] = f2bf(pv); O[nt][i] *= alpha; }
            sm += __shfl_xor(sm, 1); sm += __shfl_xor(sm, 2); sm += __shfl_xor(sm, 4); sm += __shfl_xor(sm, 8);
            lsum[i] = lsum[i] * alpha + sm; m[i] = mn; rsum[i] = sm; }
        __syncthreads();
        mma_nt<4, 2>(Pw, LS, 0, Vt, LS, 0, O, lane);
    }
    const float sink = p.in[I_SINK][(size_t)l * NH + kvh * 2 + g];
#pragma unroll
    for (int i = 0; i < 4; ++i) { const float den = lsum[i] + __expf(sink - m[i]); const float inv = 1.0f / den; const int t = tq0 + 4 * q + i;
#pragma unroll
        for (int nt = 0; nt < 4; ++nt) { const int e = nt * 16 + r; const float gate = bf2f(P[(rq0 + t) * NP + PD + 512 + (kvh * 2 + g) * 64 + e]);
            Y[(rq0 + t) * 1024 + YD + (kvh * 2 + g) * 64 + e] = f2bf(O[nt][i] * inv * siluf_(gate)); } }
}

__device__ void phase_mix1(const Params& p, int l, char* smem) {
    const bool ctxo = l < DEPTH - 1;
    constexpr int N_HL = (NB / 2) * (WG / 2), N_AL = NB * 2 * (SEQ / 64), N_CS = 2 * NB * NH * NCH, N_HC = NB * (WG / HCB), N_AC = NB * 2 * NCC;
    const int total = N_HL + N_AL + N_CS + (ctxo ? N_HC + N_AC : 0);
    for (int task = obid(); task < total; task += gridDim.x) {
        int t = task;
        if (t < N_HL) { hylat_task(p, l, t / (WG / 2), t % (WG / 2), smem); continue; } t -= N_HL;
        if (t < N_AL) { attn_task(p, l, t / (2 * (SEQ / 64)), (t / (SEQ / 64)) % 2, t % (SEQ / 64), false, smem); continue; } t -= N_AL;
        if (t < N_CS) { const int mixer = t / (NB * NH * NCH), r2 = t % (NB * NH * NCH); chunkst_task(p, l, mixer, r2 / (NH * NCH), (r2 / NCH) % NH, r2 % NCH, smem); continue; } t -= N_CS;
        if (t < N_HC) { hyctx_task(p, l, t / (WG / HCB), t % (WG / HCB), smem); continue; } t -= N_HC;
        attn_task(p, l, t / (2 * NCC), (t / NCC) % 2, t % NCC, true, smem);
    }
}

__device__ void phase_scan(const Params& p) {
    const int tid = otid();
    bf16* ST = (bf16*)(p.ws + WS_ST); float* NV = (float*)(p.ws + WS_NV); const float* BE = (const float*)(p.ws + WS_BE); float* SC = (float*)(p.ws + WS_SC);
    constexpr int NCHAIN = 2 * 2 * NB * NH;
    for (int item = obid() * NT + tid; item < NCHAIN * 1024; item += gridDim.x * NT) {
        const int chain = item >> 10, grp = item & 1023; const int mixer = chain / (2 * NB * NH), dir = (chain / (NB * NH)) % 2, b = (chain / NH) % NB, h = chain % NH;
        float c[4] = {0.f, 0.f, 0.f, 0.f}; float nv[4] = {0.f, 0.f, 0.f, 0.f}; float m = 0.f;
        const int d0 = (grp & 15) * 4;
        for (int o = 0; o < NCH; ++o) {
            const int cid = chain_cid(dir, o);
            bf16* slot = ST + st_index(mixer, dir, b, h, cid) * 4096 + grp * 4;
            const u32x2 uu = *(const u32x2*)slot; const float u[4] = {bitsf(uu.x << 16), bitsf(uu.x & 0xffff0000u), bitsf(uu.y << 16), bitsf(uu.y & 0xffff0000u)};
            u32x2 w; w.x = pk2(c[0], c[1]); w.y = pk2(c[2], c[3]); *(u32x2*)slot = w;
            if (mixer == 0) {
                const size_t ci = ch_index(dir, b, h, cid); const float bend = SC[ci * 4 + 0], mloc = SC[ci * 4 + 1];
                if (grp == 0) SC[ci * 4 + 2] = m;
                const float mn = fmaxf(bend + m, mloc), a = __expf(bend + m - mn), s = __expf(mloc - mn);
#pragma unroll
                for (int j = 0; j < 4; ++j) c[j] = a * c[j] + s * u[j];
                if (grp < 16) { float* nslot = NV + ci * 64 + grp * 4; const f32x4 nu = *(const f32x4*)nslot; f32x4 nw = {nv[0], nv[1], nv[2], nv[3]}; *(f32x4*)nslot = nw;
                    nv[0] = a * nv[0] + s * nu.x; nv[1] = a * nv[1] + s * nu.y; nv[2] = a * nv[2] + s * nu.z; nv[3] = a * nv[3] + s * nu.w; }
                m = mn;
            } else {
                const f32x4 be = *(const f32x4*)(BE + ch_index(dir, b, h, cid) * 64 + d0);
                c[0] = __expf(be.x) * c[0] + u[0]; c[1] = __expf(be.y) * c[1] + u[1]; c[2] = __expf(be.z) * c[2] + u[2]; c[3] = __expf(be.w) * c[3] + u[3];
            }
        }
    }
}

__device__ void chunkout_task(const Params& p, int l, int mixer, int b, int h, int cid, char* smem) {
    const int tid = otid(), lane = tid & 63, wave = tid >> 6, r = lane & 15, q = lane >> 4;
    const bf16* P = (const bf16*)(p.ws + WS_P); const float* G = (const float*)(p.ws + WS_G); bf16* Y = (bf16*)(p.ws + WS_HNY);
    const bf16* ST = (const bf16*)(p.ws + WS_ST);
    const int r0 = b * TOK + cid * 64;
    const int pbase = mixer == 0 ? PA : PG;
    bf16* Qs = (bf16*)smem;
    bf16* Ks = Qs + 64 * LS;
    bf16* Qh = Ks + 64 * LS;
    bf16* Vt = Qh + 64 * LS;
    bf16* Ct = Vt + 64 * LS;
    bf16* Sm = Ct + 64 * LS;
    float* fb = (float*)(Sm + 64 * LS);
    float* rowt = fb;
    float* colt = rowt + 64;
    float* wint = colt + 64;
    float* emt = wint + 64;
    float* nprev = emt + 64;
    float* qn = nprev + 64;
    float* rsum = qn + 64;
    float* rs = rsum + 128;
    float* la = rs + 64 * 32;
    float* hs = la;
    __syncthreads();
    load_tile_tr(P, r0, pbase + 512 + h * 64, Vt, tid);
    if (mixer == 0) { load_tile_nat(P, r0, pbase + h * 64, Qs, 1.0f, tid); load_tile_nat(P, r0, pbase + 256 + h * 64, Ks, 0.125f, tid); }
    else for (int i = tid; i < 64 * 32; i += NT) rs[i] = G[(size_t)(r0 + (i >> 5)) * NG + 16 + (i & 31)];
    const int t0 = (wave & 3) * 16, c0 = (wave >> 2) * 32;
    f32x4 htot[2] = {(f32x4){0.f, 0.f, 0.f, 0.f}, (f32x4){0.f, 0.f, 0.f, 0.f}};
    for (int dir = 0; dir < 2; ++dir) {
        __syncthreads();
        { const int s = tid >> 3, c8 = tid & 7; *(u32x4*)(Ct + s * LS + c8 * 8) = *(const u32x4*)(ST + st_index(mixer, dir, b, h, cid) * 4096 + s * 64 + c8 * 8); }
        if (mixer == 0) {
            if (wave == 0) {
                const float* g = G + (size_t)(r0 + lane) * NG; const float* gb = p.in[I_MGB] + (size_t)l * 16;
                const float ig = g[dir * 8 + h] + gb[dir * 8 + h], fg = g[dir * 8 + 4 + h] + gb[dir * 8 + 4 + h];
                const float lf = logsigf_(fg); float bb;
                if (dir == 0) bb = wave_prefix_sum(lf, lane); else { const float tot = wave_sum(lf), pre = wave_prefix_sum(lf, lane); bb = tot - pre + lf; }
                const float a = ig - bb; const float pm = dir == 0 ? wave_prefix_max(a, lane) : wave_suffix_max(a, lane);
                const float mprev = ((const float*)(p.ws + WS_SC))[ch_index(dir, b, h, cid) * 4 + 2];
                const float mt = fmaxf(bb + mprev, bb + pm);
                rowt[lane] = bb - mt; colt[lane] = a; wint[lane] = __expf(bb + mprev - mt); emt[lane] = __expf(-mt);
                nprev[lane] = ((const float*)(p.ws + WS_NV))[ch_index(dir, b, h, cid) * 64 + lane];
            }
            __syncthreads();
            if (tid < 64) { float s = 0.f; for (int d = 0; d < 64; ++d) s += bf2f(Qs[tid * LS + d]) * nprev[d]; qn[tid] = s; }
        } else {
            gla_decay(p, l, h, dir, rs, la, tid);
            { const int s = tid >> 3, c8 = tid & 7; float fq[8], fk[8];
                unpack8(*(const u32x4*)(P + (size_t)(r0 + s) * NP + pbase + h * 64 + c8 * 8), fq); unpack8(*(const u32x4*)(P + (size_t)(r0 + s) * NP + pbase + 256 + h * 64 + c8 * 8), fk);
                float a1[8], a2[8], a3[8];
#pragma unroll
                for (int j = 0; j < 8; ++j) { const int d = c8 * 8 + j; const float bs = la[s * 65 + d]; const float bmid = 0.5f * (dir == 0 ? la[63 * 65 + d] : la[d]);
                    a1[j] = fq[j] * 0.125f * __expf(bs - bmid); a2[j] = fk[j] * __expf(bmid - bs); a3[j] = fq[j] * 0.125f * __expf(bs); }
                u32x4 o; o.x = pk2(a1[0], a1[1]); o.y = pk2(a1[2], a1[3]); o.z = pk2(a1[4], a1[5]); o.w = pk2(a1[6], a1[7]); *(u32x4*)(Qs + s * LS + c8 * 8) = o;
                o.x = pk2(a2[0], a2[1]); o.y = pk2(a2[2], a2[3]); o.z = pk2(a2[4], a2[5]); o.w = pk2(a2[6], a2[7]); *(u32x4*)(Ks + s * LS + c8 * 8) = o;
                o.x = pk2(a3[0], a3[1]); o.y = pk2(a3[2], a3[3]); o.z = pk2(a3[4], a3[5]); o.w = pk2(a3[6], a3[7]); *(u32x4*)(Qh + s * LS + c8 * 8) = o; }
        }
        __syncthreads();
        {
            f32x4 S[2] = {(f32x4){0.f, 0.f, 0.f, 0.f}, (f32x4){0.f, 0.f, 0.f, 0.f}};
            mma_nt<2, 2>(Qs, LS, t0, Ks, LS, c0, S, lane);
#pragma unroll
            for (int i = 0; i < 4; ++i) { const int t = t0 + 4 * q + i; float sm = 0.f;
#pragma unroll
                for (int nt = 0; nt < 2; ++nt) { const int s = c0 + 16 * nt + r; const bool ok = dir == 0 ? (s <= t) : (s >= t); float v = 0.f;
                    if (ok) v = mixer == 0 ? S[nt][i] * __expf(rowt[t] + colt[s]) : S[nt][i];
                    Sm[t * LS + s] = f2bf(v); sm += v; }
                if (mixer == 0) { sm += __shfl_xor(sm, 1); sm += __shfl_xor(sm, 2); sm += __shfl_xor(sm, 4); sm += __shfl_xor(sm, 8); if (r == 0) rsum[(wave >> 2) * 64 + t] = sm; } }
        }
        __syncthreads();
        { f32x4 a1[2] = {(f32x4){0.f, 0.f, 0.f, 0.f}, (f32x4){0.f, 0.f, 0.f, 0.f}}, a2[2] = {(f32x4){0.f, 0.f, 0.f, 0.f}, (f32x4){0.f, 0.f, 0.f, 0.f}};
            mma_nt<2, 2>(Sm, LS, t0, Vt, LS, c0, a1, lane);
            mma_nt<2, 2>(mixer == 0 ? Qs : Qh, LS, t0, Ct, LS, c0, a2, lane);
#pragma unroll
            for (int i = 0; i < 4; ++i) { const int t = t0 + 4 * q + i;
                if (mixer == 0) { const float wi = wint[t]; const float den = wi * qn[t] + rsum[t] + rsum[64 + t]; const float inv = 1.0f / fmaxf(fabsf(den), emt[t]);
#pragma unroll
                    for (int nt = 0; nt < 2; ++nt) htot[nt][i] += (a1[nt][i] + wi * a2[nt][i]) * inv; }
                else {
#pragma unroll
                    for (int nt = 0; nt < 2; ++nt) htot[nt][i] += a1[nt][i] + a2[nt][i]; } }
        }
    }
    __syncthreads();
#pragma unroll
    for (int nt = 0; nt < 2; ++nt)
#pragma unroll
        for (int i = 0; i < 4; ++i) hs[(t0 + 4 * q + i) * 65 + c0 + 16 * nt + r] = htot[nt][i];
    __syncthreads();
    { const int t = tid >> 3, c8 = tid & 7; float v[8], o8[8], g8[8]; float ss = 0.f;
        unpack8(*(const u32x4*)(P + (size_t)(r0 + t) * NP + pbase + (mixer == 0 ? 1024 : 768) + h * 64 + c8 * 8), g8);
        if (mixer == 0) unpack8(*(const u32x4*)(P + (size_t)(r0 + t) * NP + pbase + 768 + h * 64 + c8 * 8), o8);
#pragma unroll
        for (int j = 0; j < 8; ++j) { float x = hs[t * 65 + c8 * 8 + j]; if (mixer == 0) x *= sigmoidf_(o8[j]); v[j] = x; ss += x * x; }
        ss += __shfl_xor(ss, 1); ss += __shfl_xor(ss, 2); ss += __shfl_xor(ss, 4);
        const float rstd = rsqrtf(ss * (1.0f / 64.0f) + EPS);
        const float* ng = p.in[mixer == 0 ? I_MNG : I_GNG] + (size_t)l * WG + h * 64 + c8 * 8;
        float w[8];
#pragma unroll
        for (int j = 0; j < 8; ++j) w[j] = v[j] * rstd * ng[j] * siluf_(g8[j]);
        u32x4 o; o.x = pk2(w[0], w[1]); o.y = pk2(w[2], w[3]); o.z = pk2(w[4], w[5]); o.w = pk2(w[6], w[7]);
        *(u32x4*)(Y + (size_t)(r0 + t) * 1024 + (mixer == 0 ? YA : YG) + h * 64 + c8 * 8) = o; }
}

__device__ void phase_mix2(const Params& p, int l, char* smem) {
    constexpr int N = 2 * NB * NH * NCH;
    for (int task = obid(); task < N; task += gridDim.x) {
        const int mixer = task / (NB * NH * NCH), r2 = task % (NB * NH * NCH); const int b = r2 / (NH * NCH), h = (r2 / NCH) % NH, cid = r2 % NCH;
        if (l == DEPTH - 1 && cid < NCC) continue;
        chunkout_task(p, l, mixer, b, h, cid, smem);
    }
}

__global__ void __launch_bounds__(NT) fwd_kernel(Params p, int ph_lo, int ph_hi) {
    SMEM_DECL;
    constexpr int NPH = 2 + 6 * DEPTH;
    for (int ph = ph_lo; ph < ph_hi && ph < NPH; ++ph) {
        if (ph == 0) phase0(p, smem);
        else if (ph == NPH - 1) phase_rp(p, DEPTH, smem);
        else { const int l = (ph - 1) / 6, k = (ph - 1) % 6;
            if (k == 0) phase_rp(p, l, smem);
            else if (k == 1) phase_gemm_in(p, l, smem);
            else if (k == 2) phase_mix1(p, l, smem);
            else if (k == 3) phase_scan(p);
            else if (k == 4) phase_mix2(p, l, smem);
            else phase_gemm_out(p, l, smem);
#ifdef PROBE_DUP
            if (k == PROBE_DUP) { GRID_SYNC();
                if (k == 1) phase_gemm_in(p, l, smem); else if (k == 2) phase_mix1(p, l, smem); else if (k == 4) phase_mix2(p, l, smem); else if (k == 5) phase_gemm_out(p, l, smem); }
#endif
        }
        if (ph + 1 < ph_hi) GRID_SYNC();
    }
}

#ifndef EMU
extern "C" void kernel_launch(void* const* d_in, const int* in_sizes, int n_in, void* d_out, int out_size, void* d_ws, size_t ws_size, hipStream_t stream) {
    static int grid = 0;
    if (grid == 0) {
        if (n_in != 26 || ws_size < WS_TOTAL) { fprintf(stderr, "kernel_launch: unexpected n_in %d or ws_size %zu (need %zu)\n", n_in, ws_size, (size_t)WS_TOTAL); grid = -1; return; }
        int dev = 0, cus = 0, per_cu = 0;
        hipGetDevice(&dev);
        hipDeviceGetAttribute(&cus, hipDeviceAttributeMultiprocessorCount, dev);
        hipFuncSetAttribute((const void*)fwd_kernel, hipFuncAttributeMaxDynamicSharedMemorySize, LDS_BYTES);
        hipOccupancyMaxActiveBlocksPerMultiprocessor(&per_cu, (const void*)fwd_kernel, NT, LDS_BYTES);
        if (per_cu < 1) { fprintf(stderr, "kernel_launch: occupancy query returned %d\n", per_cu); grid = -1; return; }
        if (per_cu > 1) per_cu = 1;
        grid = cus * per_cu;
    }
    if (grid < 0) return;
    Params p{};
    for (int i = 0; i < 26; ++i) p.in[i] = (const float*)d_in[i];
    p.out = (float*)d_out; p.ws = (char*)d_ws;
    int lo = 0, hi = 2 + 6 * DEPTH;
    void* args[] = {&p, &lo, &hi};
    hipError_t e = hipLaunchCooperativeKernel((const void*)fwd_kernel, dim3(grid), dim3(NT), args, LDS_BYTES, stream);
    if (e != hipSuccess) fprintf(stderr, "cooperative launch failed: %s (grid %d)\n", hipGetErrorString(e), grid);
}
#endif
```

```cpp
#ifdef EMU
#include "emu/hipemu.h"
#define GRID_SYNC() emu::grid_sync()
#define SMEM_DECL char* smem = emu::S().blocks[emu::cur()->block].lds
#define MFMA16(a, b, c) emu_mfma_16x16x32_bf16(a, b, c)
#else
#include <hip/hip_runtime.h>
#include <hip/hip_cooperative_groups.h>
#include <cstdio>
#include <cstdint>
#define GRID_SYNC() cooperative_groups::this_grid().sync()
#define SMEM_DECL extern __shared__ __attribute__((aligned(16))) char smem[]
#define MFMA16(a, b, c) __builtin_amdgcn_mfma_f32_16x16x32_bf16(a, b, c, 0, 0, 0)
#endif

#ifdef EMU
#ifndef EMU_DM
#define EMU_DM 256
#endif
#ifndef EMU_NB
#define EMU_NB 2
#endif
#ifndef EMU_SEQ
#define EMU_SEQ 512
#endif
#ifndef EMU_DEPTH
#define EMU_DEPTH 2
#endif
#ifndef EMU_CTXL
#define EMU_CTXL 128
#endif
constexpr int DM = EMU_DM, NB = EMU_NB, SEQ = EMU_SEQ, DEPTH = EMU_DEPTH, CTXL = EMU_CTXL;
#else
constexpr int DM = 1024, NB = 8, SEQ = 2048, DEPTH = 4, CTXL = 256;
#endif
constexpr int MIX = 1024, WG = 256, HD = 64, NH = 4, CH = 64;
constexpr int TOK = CTXL + SEQ, T = NB * TOK, NCH = TOK / CH, NCC = CTXL / CH;
constexpr int N_IN = 4144, NP = 3072, NG = 48, NMAIN = 3328, NPAD = 4352;
constexpr int NF = 2 * SEQ;
constexpr int NJ = NB + 1;
constexpr int NT = 512;
constexpr float EPS = 1e-6f;
constexpr int PA = 0, PG = 1280, PD = 2304;
constexpr int YA = 0, YH = 256, YG = 512, YD = 768;
constexpr int ilog4(int n) { return n <= 1 ? 0 : 1 + ilog4(n / 4); }
constexpr int FFT_P = ilog4(NF);
static_assert((1 << (2 * FFT_P)) == NF, "NF must be a power of 4");
static_assert(DM % 256 == 0 && CTXL % 128 == 0 && SEQ % 256 == 0, "shape constraints");

typedef unsigned short bf16;
typedef short bf16x8 __attribute__((ext_vector_type(8)));
typedef float f32x4 __attribute__((ext_vector_type(4)));
typedef unsigned u32x4 __attribute__((ext_vector_type(4)));
typedef unsigned u32x2 __attribute__((ext_vector_type(2)));
struct cpx { float x, y; };

constexpr size_t al256(size_t x) { return (x + 255) & ~(size_t)255; }
constexpr size_t WS_CTXB = 0;
constexpr size_t WS_HNY = al256(WS_CTXB + (size_t)NB * CTXL * DM * 4);
constexpr size_t WS_WIN = WS_HNY + (size_t)T * 1024 * 2;
constexpr size_t WS_WOUT = al256(WS_WIN + (size_t)NPAD * DM * 2);
constexpr size_t WS_P = al256(WS_WOUT + (size_t)DM * MIX * 2);
constexpr size_t WS_HT = al256(WS_P + (size_t)T * NP * 2);
constexpr size_t WS_G = al256(WS_HT + (size_t)1024 * T * 2);
constexpr size_t WS_KT = al256(WS_G + (size_t)T * NG * 4);
constexpr size_t WS_KF = al256(WS_KT + (size_t)WG * NF * 4);
constexpr size_t WS_HC = al256(WS_KF + (size_t)WG * NF * 8);
constexpr size_t WS_ST = al256(WS_HC + (size_t)2 * WG * CTXL * 4);
constexpr size_t WS_NV = al256(WS_ST + (size_t)2 * 2 * NB * NH * NCH * 4096 * 2);
constexpr size_t WS_BE = al256(WS_NV + (size_t)2 * NB * NH * NCH * 64 * 4);
constexpr size_t WS_SC = al256(WS_BE + (size_t)2 * NB * NH * NCH * 64 * 4);
constexpr size_t WS_MOD = al256(WS_SC + (size_t)2 * NB * NH * NCH * 4 * 4);
constexpr size_t WS_TW = al256(WS_MOD + (size_t)DEPTH * NJ * 3 * DM * 4);
constexpr size_t WS_ROPE = al256(WS_TW + (size_t)NF * 8);
constexpr size_t WS_BAR = al256(WS_ROPE + (size_t)SEQ * 32 * 8);
constexpr size_t BAR_BYTES = 16384;
constexpr size_t WS_TOTAL = al256(WS_BAR + BAR_BYTES);
static_assert((size_t)T * DM * 4 <= (size_t)T * NP * 2, "YO fits in P");
#ifndef EMU
static_assert(WS_TOTAL <= (size_t)268435456, "workspace map must fit 256 MiB");
#endif

constexpr int LDS_BYTES = 147456;

struct Params {
    const float* in[26];
    float* out;
    char* ws;
};
enum { I_X = 0, I_C, I_CTX, I_CCTX, I_WADA, I_BADA, I_GPRE, I_GPOST, I_WIN, I_MGB, I_MNG, I_HCW, I_HCB, I_HW1, I_HB1, I_HW2, I_HB2, I_HW3, I_HB3,
       I_HFREQ, I_HD, I_GWA, I_GBA, I_GNG, I_SINK, I_WOUT };


#ifdef EMU
__device__ __forceinline__ int otid() { return (int)threadIdx.x; }
__device__ __forceinline__ int obid() { return (int)blockIdx.x; }
#else
__device__ __forceinline__ int otid() { int t = (int)threadIdx.x; asm volatile("" : "+v"(t)); return t; }
__device__ __forceinline__ int obid() { int b = (int)blockIdx.x; asm volatile("" : "+s"(b)); return b; }
#endif
__device__ __forceinline__ unsigned fbits(float f) { return __builtin_bit_cast(unsigned, f); }
__device__ __forceinline__ float bitsf(unsigned u) { return __builtin_bit_cast(float, u); }
__device__ __forceinline__ bf16 f2bf(float f) { unsigned u = fbits(f); return (bf16)((u + 0x7fffu + ((u >> 16) & 1u)) >> 16); }
__device__ __forceinline__ float bf2f(bf16 h) { return bitsf((unsigned)h << 16); }
__device__ __forceinline__ unsigned pk2(float lo, float hi) { return (unsigned)f2bf(lo) | ((unsigned)f2bf(hi) << 16); }
__device__ __forceinline__ float sigmoidf_(float x) { return 1.0f / (1.0f + __expf(-x)); }
__device__ __forceinline__ float siluf_(float x) { return x / (1.0f + __expf(-x)); }
__device__ __forceinline__ float logsigf_(float x) { return fminf(x, 0.0f) - log1pf(__expf(-fabsf(x))); }
__device__ __forceinline__ float wave_sum(float v) {
#pragma unroll
    for (int o = 1; o < 64; o <<= 1) v += __shfl_xor(v, o);
    return v;
}
__device__ __forceinline__ float wave_max(float v) {
#pragma unroll
    for (int o = 1; o < 64; o <<= 1) v = fmaxf(v, __shfl_xor(v, o));
    return v;
}
__device__ __forceinline__ float wave_prefix_sum(float v, int lane) {
#pragma unroll
    for (int o = 1; o < 64; o <<= 1) { float t = __shfl_up(v, o); if (lane >= o) v += t; }
    return v;
}
__device__ __forceinline__ float wave_prefix_max(float v, int lane) {
#pragma unroll
    for (int o = 1; o < 64; o <<= 1) { float t = __shfl_up(v, o); if (lane >= o) v = fmaxf(v, t); }
    return v;
}
__device__ __forceinline__ float wave_suffix_max(float v, int lane) {
#pragma unroll
    for (int o = 1; o < 64; o <<= 1) { float t = __shfl_down(v, o); if (lane + o < 64) v = fmaxf(v, t); }
    return v;
}
__device__ __forceinline__ void unpack8(u32x4 v, float* f) {
    f[0] = bitsf(v.x << 16); f[1] = bitsf(v.x & 0xffff0000u); f[2] = bitsf(v.y << 16); f[3] = bitsf(v.y & 0xffff0000u);
    f[4] = bitsf(v.z << 16); f[5] = bitsf(v.z & 0xffff0000u); f[6] = bitsf(v.w << 16); f[7] = bitsf(v.w & 0xffff0000u);
}
__device__ __forceinline__ int orig_col(int n) {
    if (n < 1280) return n;
    if (n < 2304) return 2320 + (n - 1280);
    if (n < 3072) return 3376 + (n - 2304);
    if (n < 3088) return 1280 + (n - 3072);
    if (n < 3120) return 3344 + (n - 3088);
    if (n < NMAIN) return -1;
    return 1296 + (n - NMAIN);
}
__device__ __forceinline__ int chain_cid(int dir, int o) {
    if (dir == 0) return o;
    return o < NCC ? (NCC - 1 - o) : (NCH - 1 - (o - NCC));
}

constexpr int LS = 72;

template <int NTL, int KS>
__device__ __forceinline__ void mma_nt(const bf16* A, int lda, int m0, const bf16* B, int ldb, int n0, f32x4 (&acc)[NTL], int lane) {
    const int r = lane & 15, q = lane >> 4;
#pragma unroll
    for (int ks = 0; ks < KS; ++ks) {
        const bf16x8 a = *(const bf16x8*)(A + (m0 + r) * lda + ks * 32 + q * 8);
#pragma unroll
        for (int nt = 0; nt < NTL; ++nt) {
            const bf16x8 b = *(const bf16x8*)(B + (n0 + nt * 16 + r) * ldb + ks * 32 + q * 8);
            acc[nt] = MFMA16(a, b, acc[nt]);
        }
    }
}

__device__ void phase0(const Params& p, char* smem) {
    const int tid = otid();
    cpx* TW = (cpx*)(p.ws + WS_TW);
    cpx* ROPE = (cpx*)(p.ws + WS_ROPE);
    float* MOD = (float*)(p.ws + WS_MOD);
    constexpr int N_TW = NF / NT, N_ROPE = SEQ * 32 / NT, N_MOD = DEPTH * (3 * DM / 64);
    for (int task = obid(); task < N_TW + N_ROPE + N_MOD; task += gridDim.x) {
        if (task < N_TW) {
            const int j = task * NT + tid; float s, c; sincospif(2.0f * (float)j / (float)NF, &s, &c);
            cpx v; v.x = c; v.y = -s; TW[j] = v;
        } else if (task < N_TW + N_ROPE) {
            const int idx = (task - N_TW) * NT + tid; const int pos = idx >> 5, i = idx & 31;
            const float inv = exp2f(-(float)(i & 15) * (13.287712379549449f / 16.0f));
            const float ang = (float)(i < 16 ? pos / 64 : pos % 64) * inv;
            cpx v; v.x = cosf(ang); v.y = sinf(ang); ROPE[idx] = v;
        } else {
            const int mt = task - N_TW - N_ROPE; const int l = mt / (3 * DM / 64), n0 = (mt % (3 * DM / 64)) * 64;
            float* sv = (float*)smem;
            float* red = sv + NJ * DM;
            __syncthreads();
            for (int i = tid; i < NJ * DM; i += NT) { const int j = i / DM, k = i % DM; const float v = j < NB ? p.in[I_C][j * DM + k] : p.in[I_CCTX][k]; sv[i] = siluf_(v); }
            __syncthreads();
            const int nl = tid & 63, ks = tid >> 6; float acc[NJ];
#pragma unroll
            for (int j = 0; j < NJ; ++j) acc[j] = 0.f;
            const float* w = p.in[I_WADA] + (size_t)l * DM * 3 * DM + n0 + nl;
            for (int k = ks * (DM / 8); k < (ks + 1) * (DM / 8); ++k) { const float wv = w[(size_t)k * 3 * DM];
#pragma unroll
                for (int j = 0; j < NJ; ++j) acc[j] += sv[j * DM + k] * wv; }
#pragma unroll
            for (int j = 0; j < NJ; ++j) red[(ks * NJ + j) * 64 + nl] = acc[j];
            __syncthreads();
            for (int i = tid; i < NJ * 64; i += NT) { const int j = i / 64, n = i % 64; float s = 0.f;
#pragma unroll
                for (int k8 = 0; k8 < 8; ++k8) s += red[(k8 * NJ + j) * 64 + n];
                MOD[((size_t)l * NJ + j) * 3 * DM + n0 + n] = s + p.in[I_BADA][(size_t)l * 3 * DM + n0 + n]; }
        }
    }
}

__device__ void rp_rows(const Params& p, int l) {
    const int tid = otid(), lane = tid & 63, wave = tid >> 6;
    const float* MOD = (const float*)(p.ws + WS_MOD);
    float* CTXB = (float*)(p.ws + WS_CTXB);
    const float* YO = (const float*)(p.ws + WS_P);
    bf16* HN = (bf16*)(p.ws + WS_HNY);
    constexpr int NV4 = DM / 256;
    for (int row = obid() * 8 + wave; row < T; row += gridDim.x * 8) {
        const int b = row / TOK, pp = row % TOK; const bool isctx = pp < CTXL;
        if (l == DEPTH && isctx) continue;
        const size_t off = isctx ? ((size_t)b * CTXL + pp) * DM : ((size_t)b * SEQ + (pp - CTXL)) * DM;
        const float* xo = (l <= 1) ? (isctx ? p.in[I_CTX] + off : p.in[I_X] + off) : (isctx ? CTXB + off : p.out + off);
        float* xn = isctx ? CTXB + off : p.out + off;
        const int mj = isctx ? NB : b;
        f32x4 x[NV4];
#pragma unroll
        for (int j = 0; j < NV4; ++j) x[j] = *(const f32x4*)(xo + 4 * lane + 256 * j);
        if (l > 0) {
            f32x4 y[NV4]; float ss = 0.f;
#pragma unroll
            for (int j = 0; j < NV4; ++j) { y[j] = *(const f32x4*)(YO + (size_t)row * DM + 4 * lane + 256 * j); ss += y[j].x * y[j].x + y[j].y * y[j].y + y[j].z * y[j].z + y[j].w * y[j].w; }
            const float rstd = rsqrtf(wave_sum(ss) * (1.0f / DM) + EPS);
            const float* gt = MOD + ((size_t)(l - 1) * NJ + mj) * 3 * DM + 2 * DM;
            const float* gp = p.in[I_GPOST] + (size_t)(l - 1) * DM;
#pragma unroll
            for (int j = 0; j < NV4; ++j) { const f32x4 g4 = *(const f32x4*)(gt + 4 * lane + 256 * j), p4 = *(const f32x4*)(gp + 4 * lane + 256 * j);
                x[j] = x[j] + g4 * (y[j] * rstd * p4);
                *(f32x4*)(xn + 4 * lane + 256 * j) = x[j]; }
        }
        if (l < DEPTH) {
            float ss = 0.f;
#pragma unroll
            for (int j = 0; j < NV4; ++j) ss += x[j].x * x[j].x + x[j].y * x[j].y + x[j].z * x[j].z + x[j].w * x[j].w;
            const float rstd = rsqrtf(wave_sum(ss) * (1.0f / DM) + EPS);
            const float* md = MOD + ((size_t)l * NJ + mj) * 3 * DM;
            const float* gp = p.in[I_GPRE] + (size_t)l * DM;
#pragma unroll
            for (int j = 0; j < NV4; ++j) { const int e = 4 * lane + 256 * j;
                const f32x4 g4 = *(const f32x4*)(gp + e), sh = *(const f32x4*)(md + e), sc = *(const f32x4*)(md + DM + e);
                const f32x4 h = (x[j] * rstd * g4) * (sc + 1.0f) + sh;
                u32x2 o; o.x = pk2(h.x, h.y); o.y = pk2(h.z, h.w);
                *(u32x2*)(HN + (size_t)row * DM + e) = o; }
        }
    }
}

__device__ void convert_tile(const float* src, int ldn, bf16* dst, int K, int n0, int k0, bool use_map, char* smem) {
    const int tid = otid();
    float* tile = (float*)smem;
    __syncthreads();
#pragma unroll
    for (int i = 0; i < 8; ++i) { const int idx = tid + NT * i, k = idx >> 6, n = idx & 63;
        const int oc = use_map ? orig_col(n0 + n) : (n0 + n);
        tile[k * 65 + n] = oc >= 0 ? src[(size_t)(k0 + k) * ldn + oc] : 0.f; }
    __syncthreads();
    const int n = tid >> 3, c = tid & 7;
    u32x4 o; o.x = pk2(tile[(8 * c + 0) * 65 + n], tile[(8 * c + 1) * 65 + n]); o.y = pk2(tile[(8 * c + 2) * 65 + n], tile[(8 * c + 3) * 65 + n]);
    o.z = pk2(tile[(8 * c + 4) * 65 + n], tile[(8 * c + 5) * 65 + n]); o.w = pk2(tile[(8 * c + 6) * 65 + n], tile[(8 * c + 7) * 65 + n]);
    *(u32x4*)(dst + (size_t)(n0 + n) * K + k0 + 8 * c) = o;
}

__device__ void filter_task(const Params& p, int l, int L, int pos0, char* smem) {
    const int tid = otid();
    float* z = (float*)smem;
    float* h1 = z + 8 * 33;
    float* h2 = h1 + 8 * 64;
    __syncthreads();
    if (tid < 8 * 33) { const int pp = tid / 33, i = tid % 33; const float pos = (float)(pos0 + pp);
        const float t = pos / (float)(L - 1 > 1 ? L - 1 : 1), w = 6.283185307179586f * pos / (float)L; float v;
        if (i == 0) v = t; else { const int bi = (i - 1) & 15; const float f = 1e-4f + (float)bi * ((15.0f - 1e-4f) / 15.0f); v = (i <= 16) ? cosf(w * f) : -sinf(w * f); }
        z[tid] = v; }
    __syncthreads();
    { const int pp = tid >> 6, j = tid & 63; const float* w1 = p.in[I_HW1] + (size_t)l * 33 * 64; float a = p.in[I_HB1][l * 64 + j];
        for (int i = 0; i < 33; ++i) a += z[pp * 33 + i] * w1[i * 64 + j];
        h1[tid] = sinf(p.in[I_HFREQ][(l * 2 + 0) * 64 + j] * a); }
    __syncthreads();
    { const int pp = tid >> 6, j = tid & 63; const float* w2 = p.in[I_HW2] + (size_t)l * 64 * 64; float a = p.in[I_HB2][l * 64 + j];
        for (int i = 0; i < 64; ++i) a += h1[pp * 64 + i] * w2[i * 64 + j];
        h2[tid] = sinf(p.in[I_HFREQ][(l * 2 + 1) * 64 + j] * a); }
    __syncthreads();
    { const int o = tid, dir = o >> 8, c = o & 255; const float* w3 = p.in[I_HW3] + (size_t)l * 64 * 512; const float b3 = p.in[I_HB3][l * 512 + o];
        const float delta = 3.0701134573253946f + (float)c * ((15.350567286626973f - 3.0701134573253946f) / 255.0f);
        float acc[8];
#pragma unroll
        for (int pp = 0; pp < 8; ++pp) acc[pp] = b3;
        for (int j = 0; j < 64; ++j) { const float wv = w3[j * 512 + o];
#pragma unroll
            for (int pp = 0; pp < 8; ++pp) acc[pp] += h2[pp * 64 + j] * wv; }
        float* KT = (float*)(p.ws + WS_KT); float* HC = (float*)(p.ws + WS_HC);
#pragma unroll
        for (int pp = 0; pp < 8; ++pp) { const int pos = pos0 + pp; const float t = (float)pos / (float)(L - 1 > 1 ? L - 1 : 1);
            const float v = acc[pp] * __expf(-t * delta);
            if (L == SEQ) { if (dir == 0) KT[(size_t)c * NF + pos]= v; else if (pos > 0) KT[(size_t)c * NF + (NF - pos)] = v; else KT[(size_t)c * NF + SEQ] = 0.f; }
            else HC[((size_t)dir * WG + c) * CTXL + pos] = v; }
    }
}

__device__ void phase_rp(const Params& p, int l, char* smem) {
    rp_rows(p, l);
    if (l >= DEPTH) return;
    constexpr int N_WIN = (NPAD / 64) * (DM / 64), N_WOUT = (DM / 64) * (MIX / 64), N_FL = SEQ / 8, N_FC = CTXL / 8;
    for (int task = obid(); task < N_WIN + N_WOUT + N_FL + N_FC; task += gridDim.x) {
        if (task < N_WIN) { const int nt = task / (DM / 64), kt = task % (DM / 64);
            convert_tile(p.in[I_WIN] + (size_t)l * DM * N_IN, N_IN, (bf16*)(p.ws + WS_WIN), DM, nt * 64, kt * 64, true, smem); }
        else if (task < N_WIN + N_WOUT) { const int t2 = task - N_WIN, nt = t2 / (MIX / 64), kt = t2 % (MIX / 64);
            convert_tile(p.in[I_WOUT] + (size_t)l * MIX * DM, DM, (bf16*)(p.ws + WS_WOUT), MIX, nt * 64, kt * 64, false, smem); }
        else if (task < N_WIN + N_WOUT + N_FL) filter_task(p, l, SEQ, (task - N_WIN - N_WOUT) * 8, smem);
        else filter_task(p, l, CTXL, (task - N_WIN - N_WOUT - N_FL) * 8, smem);
    }
}

__device__ __forceinline__ cpx cmul(cpx a, cpx b) { cpx r; r.x = a.x * b.x - a.y * b.y; r.y = a.x * b.y + a.y * b.x; return r; }
__device__ __forceinline__ cpx cmulc(cpx a, cpx b) { cpx r; r.x = a.x * b.x + a.y * b.y; r.y = a.y * b.x - a.x * b.y; return r; }
__device__ void fft_fwd(cpx* buf, const cpx* TW, int tl) {
    for (int s = 0; s < FFT_P; ++s) {
        const int span = NF >> (2 * (s + 1)), tws = 1 << (2 * s);
        __syncthreads();
#pragma unroll 1
        for (int j = tl; j < NF / 4; j += 256) {
            const int grp = j / span, pos = j % span, base = grp * 4 * span + pos;
            const cpx x0 = buf[base], x1 = buf[base + span], x2 = buf[base + 2 * span], x3 = buf[base + 3 * span];
            const cpx a = {x0.x + x2.x, x0.y + x2.y}, b = {x0.x - x2.x, x0.y - x2.y}, c = {x1.x + x3.x, x1.y + x3.y}, d = {x1.x - x3.x, x1.y - x3.y};
            const cpx y0 = {a.x + c.x, a.y + c.y}, y2 = {a.x - c.x, a.y - c.y};
            const cpx y1 = {b.x + d.y, b.y - d.x};
            const cpx y3 = {b.x - d.y, b.y + d.x};
            buf[base] = y0;
            buf[base + span] = cmul(y1, TW[pos * tws]);
            buf[base + 2 * span] = cmul(y2, TW[2 * pos * tws]);
            buf[base + 3 * span] = cmul(y3, TW[3 * pos * tws]);
        }
    }
    __syncthreads();
}
__device__ void fft_inv(cpx* buf, const cpx* TW, int tl) {
    for (int s = FFT_P - 1; s >= 0; --s) {
        const int span = NF >> (2 * (s + 1)), tws = 1 << (2 * s);
        __syncthreads();
#pragma unroll 1
        for (int j = tl; j < NF / 4; j += 256) {
            const int grp = j / span, pos = j % span, base = grp * 4 * span + pos;
            const cpx b0 = buf[base];
            const cpx b1 = cmulc(buf[base + span], TW[pos * tws]);
            const cpx b2 = cmulc(buf[base + 2 * span], TW[2 * pos * tws]);
            const cpx b3 = cmulc(buf[base + 3 * span], TW[3 * pos * tws]);
            const cpx a = {b0.x + b2.x, b0.y + b2.y}, b = {b0.x - b2.x, b0.y - b2.y}, c = {b1.x + b3.x, b1.y + b3.y}, d = {b1.x - b3.x, b1.y - b3.y};
            const cpx x0 = {a.x + c.x, a.y + c.y}, x2 = {a.x - c.x, a.y - c.y};
            const cpx x1 = {b.x - d.y, b.y + d.x};
            const cpx x3 = {b.x + d.y, b.y - d.x};
            buf[base] = x0; buf[base + span] = x1; buf[base + 2 * span] = x2; buf[base + 3 * span] = x3;
        }
    }
    __syncthreads();
}
__device__ void filt_fft_task(const Params& p, int cp, char* smem) {
    const int tid = otid(), half = tid >> 8, tl = tid & 255, c = 2 * cp + half;
    cpx* buf = (cpx*)smem + (size_t)half * NF;
    const float* KT = (const float*)(p.ws + WS_KT) + (size_t)c * NF;
    cpx* KF = (cpx*)(p.ws + WS_KF) + (size_t)c * NF;
    const cpx* TW = (const cpx*)(p.ws + WS_TW);
    __syncthreads();
    for (int i = tl; i < NF; i += 256) { cpx v; v.x = KT[i]; v.y = 0.f; buf[i] = v; }
    fft_fwd(buf, TW, tl);
    for (int i = tl; i < NF; i += 256) KF[i] = buf[i];
}

__device__ void gemm_tile(const Params& p, const bf16* A, const bf16* Bt, int K, int mt, int nt, int mode, char* smem) {
    const int tid = otid(), lane = tid & 63, wave = tid >> 6;
    bf16* As = (bf16*)smem;
    bf16* Bs = As + 128 * LS;
    const int wm = (wave & 3) * 32, wn = (wave >> 2) * 64;
    f32x4 acc[2][4];
#pragma unroll
    for (int i = 0; i < 2; ++i)
#pragma unroll
        for (int j = 0; j < 4; ++j) acc[i][j] = (f32x4){0.f, 0.f, 0.f, 0.f};
    const int lr = tid >> 3, lc = tid & 7;
    const bf16* Ag = A + (size_t)(mt * 128 + lr) * K + lc * 8;
    const bf16* Bg = Bt + (size_t)(nt * 128 + lr) * K + lc * 8;
    u32x4 ra0, ra1, rb0, rb1;
    ra0 = *(const u32x4*)(Ag); ra1 = *(const u32x4*)(Ag + (size_t)64 * K); rb0 = *(const u32x4*)(Bg); rb1 = *(const u32x4*)(Bg + (size_t)64 * K);
    const int nk = K / 64;
    for (int kt = 0; kt < nk; ++kt) {
        __syncthreads();
        *(u32x4*)(As + lr * LS + lc * 8) = ra0; *(u32x4*)(As + (lr + 64) * LS + lc * 8) = ra1;
        *(u32x4*)(Bs + lr * LS + lc * 8) = rb0; *(u32x4*)(Bs + (lr + 64) * LS + lc * 8) = rb1;
        __syncthreads();
        if (kt + 1 < nk) { const int ko = (kt + 1) * 64;
            ra0 = *(const u32x4*)(Ag + ko); ra1 = *(const u32x4*)(Ag + (size_t)64 * K + ko); rb0 = *(const u32x4*)(Bg + ko); rb1 = *(const u32x4*)(Bg + (size_t)64 * K + ko); }
        mma_nt<4, 2>(As, LS, wm, Bs, LS, wn, acc[0], lane);
        mma_nt<4, 2>(As, LS, wm + 16, Bs, LS, wn, acc[1], lane);
    }
    const int r = lane & 15, q = lane >> 4;
#pragma unroll
    for (int i = 0; i < 2; ++i)
#pragma unroll
        for (int j = 0; j < 4; ++j)
#pragma unroll
            for (int e = 0; e < 4; ++e) {
                const int row = mt * 128 + wm + 16 * i + 4 * q + e, col = nt * 128 + wn + 16 * j + r; const float v = acc[i][j][e];
                if (mode == 0) { if (col < NP) ((bf16*)(p.ws + WS_P))[(size_t)row * NP + col] = f2bf(v); else if (col < NP + NG) ((float*)(p.ws + WS_G))[(size_t)row * NG + (col - NP)] = v; }
                else if (mode == 2) ((bf16*)(p.ws + WS_HT))[(size_t)row * T + col] = f2bf(v);
                else ((float*)(p.ws + WS_P))[(size_t)row * DM + col] = v;
            }
}

#ifndef EMU
namespace pg8 {
#define PG8_LAS __attribute__((address_space(3)))
typedef unsigned short bf16_t;
typedef short bf16x8 __attribute__((ext_vector_type(8)));
typedef float f32x4 __attribute__((ext_vector_type(4)));
typedef unsigned u32x4 __attribute__((ext_vector_type(4)));
constexpr int BM = 256, BK = 64, HALF = 128, HTB = HALF * BK * 2  , STAGE_BYTES = 8 * HTB, NXCD = 8, WGM = 8;

__host__ __device__ __forceinline__ int lds_byte(int r, int c) { const int st = (r >> 4) * 2 + (c >> 5), rr = r & 15, cc = c & 31, ob = rr * 64 + cc * 2; return st * 1024 + (ob ^ (((ob >> 9) & 1) << 5)); }
__host__ __device__ __forceinline__ void stage_rc(int b, int& R, int& C) { const int st = b / 1024, sb = b % 1024, swz = sb ^ (((sb >> 9) & 1) << 5); R = (st >> 1) * 16 + swz / 64; C = (st & 1) * 32 + (swz % 64) / 2; }
__host__ __device__ __forceinline__ int perm32(int rho) { const int n = rho >> 4, i = rho & 15; return 8 * (i >> 2) + 4 * n + (i & 3); }

struct Unit { int pm, pn; };
struct Gemm { const bf16_t* A; const bf16_t* Bt; int M, N, K; };
__device__ __forceinline__ unsigned cvt_pk_bf16(float lo, float hi) { unsigned r; asm volatile("v_cvt_pk_bf16_f32 %0, %1, %2" : "=v"(r) : "v"(lo), "v"(hi)); return r; }
template <class Epi, class Sched, bool ALIGN_EPI = false, bool SP2 = false>
__device__ __forceinline__ void gemm_phase(PG8_LAS unsigned char* lds, const Gemm g, const Sched& S, const Epi& E) {
    const int tid = threadIdx.x, wid = __builtin_amdgcn_readfirstlane(tid >> 6), lane = tid & 63, wr = wid >> 2, wc = wid & 3, fr = lane & 15, fq = lane >> 4;
    const int K = g.K, nt = K / BK;
    unsigned voffA[2], voffB[2];
#pragma unroll
    for (int i = 0; i < 2; ++i) { int R, C; stage_rc(tid * 16 + i * 8192, R, C); const int Rb = Epi::PERM ? ((R & ~31) + perm32(R & 31)) : R;
        voffA[i] = (unsigned)(R * K + C) * 2u; voffB[i] = (unsigned)(Rb * K + C) * 2u; }
    const size_t kstep = (size_t)(BK * 2);
    const size_t hstep = (size_t)HALF * K * 2;
    const size_t tstep = 2 * hstep;
    const unsigned ldsw = (unsigned)wid * 1024u;
    const int aoff = lds_byte(wr * 64 + fr, fq * 8), boff = lds_byte(wc * 32 + fr, fq * 8);
#define PG8_SA(b, h) (((b) * 2 + (h)) * HTB)
#define PG8_SB(b, h) ((4 + (b) * 2 + (h)) * HTB)
#define PG8_STAGE(bufoff, gbase, voff) do { _Pragma("unroll") for (int _i = 0; _i < 2; ++_i) \
        __builtin_amdgcn_global_load_lds((const unsigned*)((const char*)(gbase) + (voff)[_i]), (PG8_LAS unsigned*)(lds + (bufoff) + ldsw + _i * 8192), 16, 0, 0); } while (0)
#define PG8_LDA(dst, b, h) do { _Pragma("unroll") for (int m = 0; m < 4; ++m) _Pragma("unroll") for (int k = 0; k < 2; ++k) dst[m][k] = *(const PG8_LAS bf16x8*)(lds + PG8_SA(b, h) + aoff + m * 2048 + k * 1024); } while (0)
#define PG8_LDB(dst, b, h) do { _Pragma("unroll") for (int n = 0; n < 2; ++n) _Pragma("unroll") for (int k = 0; k < 2; ++k) dst[n][k] = *(const PG8_LAS bf16x8*)(lds + PG8_SB(b, h) + boff + n * 2048 + k * 1024); } while (0)
#define PG8_MMA(ai, bj, At, Bt) do { __builtin_amdgcn_s_setprio(1); _Pragma("unroll") for (int m = 0; m < 4; ++m) _Pragma("unroll") for (int n = 0; n < 2; ++n) _Pragma("unroll") for (int k = 0; k < 2; ++k) \
        acc[ai][bj][m][n] = __builtin_amdgcn_mfma_f32_16x16x32_bf16(Bt[n][k], At[m][k], acc[ai][bj][m][n], 0, 0, 0); __builtin_amdgcn_s_setprio(0); } while (0)
#define PG8_WAIT_V(n) asm volatile("s_waitcnt vmcnt(" #n ")" ::: "memory")
#define PG8_WAIT_L(n) asm volatile("s_waitcnt lgkmcnt(" #n ")" ::: "memory")
#define PG8_BAR __builtin_amdgcn_s_barrier()
#define PG8_SCHED __builtin_amdgcn_sched_barrier(0)
    Unit cur, nxt; int ui = 0;
    if (!S.next(0, cur)) return;
    f32x4 acc[2][2][4][2];
#pragma unroll
    for (int a = 0; a < 2; ++a)
#pragma unroll
        for (int b = 0; b < 2; ++b)
#pragma unroll
            for (int m = 0; m < 4; ++m)
#pragma unroll
                for (int n = 0; n < 2; ++n) acc[a][b][m][n] = (f32x4){0.f, 0.f, 0.f, 0.f};
    bf16x8 At[4][2], B0[2][2], B1[2][2];
    const char* cA = (const char*)g.A + (size_t)cur.pm * tstep; const char* cB = (const char*)g.Bt + (size_t)cur.pn * tstep;
    S.a_ready(cur);
    if constexpr (SP2) {
        PG8_STAGE(PG8_SB(0, 0), cB, voffB); PG8_STAGE(PG8_SB(0, 1), cB + hstep, voffB); PG8_STAGE(PG8_SA(0, 0), cA, voffA); PG8_STAGE(PG8_SA(0, 1), cA + hstep, voffA);
        if (wr == 1) PG8_BAR;
        PG8_WAIT_V(2); PG8_BAR;
        PG8_STAGE(PG8_SB(1, 0), cB + kstep, voffB); PG8_STAGE(PG8_SA(1, 0), cA + kstep, voffA); PG8_STAGE(PG8_SB(1, 1), cB + hstep + kstep, voffB);
        PG8_WAIT_V(6); PG8_BAR;
    } else {
        PG8_STAGE(PG8_SB(0, 0), cB, voffB); PG8_STAGE(PG8_SA(0, 0), cA, voffA); PG8_STAGE(PG8_SB(0, 1), cB + hstep, voffB); PG8_STAGE(PG8_SA(0, 1), cA + hstep, voffA);
        if (wr == 1) PG8_BAR;
        PG8_WAIT_V(4); PG8_BAR;
        PG8_STAGE(PG8_SB(1, 0), cB + kstep, voffB); PG8_STAGE(PG8_SA(1, 0), cA + kstep, voffA); PG8_STAGE(PG8_SB(1, 1), cB + hstep + kstep, voffB);
        PG8_WAIT_V(6); PG8_BAR;
    }
    for (;;) {
        const bool has_next = S.next(ui + 1, nxt);
        const char* nA = has_next ? (const char*)g.A + (size_t)nxt.pm * tstep : cA; const char* nB = has_next ? (const char*)g.Bt + (size_t)nxt.pn * tstep : cB;
        for (int t = 0; t < nt; t += 2) {
            const bool last = (t == nt - 2);
            const char* a1 = cA + (size_t)(t + 1) * kstep;
            const char* a2 = last ? nA : cA + (size_t)(t + 2) * kstep; const char* b2 = last ? nB : cB + (size_t)(t + 2) * kstep;
            const char* a3 = a2 + kstep; const char* b3 = b2 + kstep;
            if (last && has_next) S.a_ready(nxt);
            if constexpr (SP2) {
            PG8_LDB(B0, 0, 0); PG8_LDB(B1, 0, 1); PG8_SCHED; PG8_LDA(At, 0, 0); PG8_STAGE(PG8_SA(1, 1), a1 + hstep, voffA);
            PG8_WAIT_V(8); PG8_WAIT_L(0); PG8_BAR; PG8_MMA(0, 0, At, B0); PG8_MMA(0, 1, At, B1); PG8_BAR; PG8_SCHED;
            PG8_LDA(At, 0, 1); PG8_STAGE(PG8_SB(0, 0), b2, voffB); PG8_STAGE(PG8_SB(0, 1), b2 + hstep, voffB); PG8_STAGE(PG8_SA(0, 0), a2, voffA);
            PG8_WAIT_V(8); PG8_WAIT_L(0); PG8_BAR; PG8_MMA(1, 0, At, B0); PG8_MMA(1, 1, At, B1); PG8_BAR; PG8_SCHED;
            PG8_LDB(B0, 1, 0); PG8_LDB(B1, 1, 1); PG8_SCHED; PG8_LDA(At, 1, 0); PG8_STAGE(PG8_SA(0, 1), a2 + hstep, voffA);
            PG8_WAIT_V(8); PG8_WAIT_L(0); PG8_BAR; PG8_MMA(0, 0, At, B0); PG8_MMA(0, 1, At, B1); PG8_BAR; PG8_SCHED;
            PG8_LDA(At, 1, 1); PG8_STAGE(PG8_SB(1, 0), b3, voffB); PG8_STAGE(PG8_SB(1, 1), b3 + hstep, voffB); PG8_STAGE(PG8_SA(1, 0), a3, voffA);
            PG8_WAIT_V(8); PG8_WAIT_L(0); PG8_BAR; PG8_MMA(1, 0, At, B0); PG8_MMA(1, 1, At, B1); PG8_BAR; PG8_SCHED;
            } else {
            PG8_LDB(B0, 0, 0); PG8_SCHED; PG8_LDA(At, 0, 0); PG8_STAGE(PG8_SA(1, 1), a1 + hstep, voffA);
            PG8_WAIT_L(8); PG8_BAR; PG8_WAIT_L(0); PG8_MMA(0, 0, At, B0); PG8_BAR; PG8_SCHED;
            PG8_LDB(B1, 0, 1); PG8_STAGE(PG8_SB(0, 0), b2, voffB);
            PG8_BAR; PG8_WAIT_L(0); PG8_MMA(0, 1, At, B1); PG8_BAR;
            PG8_LDA(At, 0, 1); PG8_STAGE(PG8_SA(0, 0), a2, voffA);
            PG8_BAR; PG8_WAIT_L(0); PG8_MMA(1, 0, At, B0); PG8_BAR; PG8_SCHED;
            PG8_STAGE(PG8_SB(0, 1), b2 + hstep, voffB);
            PG8_WAIT_V(6); PG8_BAR; PG8_MMA(1, 1, At, B1); PG8_BAR;
            PG8_LDB(B0, 1, 0); PG8_SCHED; PG8_LDA(At, 1, 0); PG8_STAGE(PG8_SA(0, 1), a2 + hstep, voffA);
            PG8_WAIT_L(8); PG8_BAR; PG8_WAIT_L(0); PG8_MMA(0, 0, At, B0); PG8_BAR; PG8_SCHED;
            PG8_LDB(B1, 1, 1); PG8_STAGE(PG8_SB(1, 0), b3, voffB);
            PG8_BAR; PG8_WAIT_L(0); PG8_MMA(0, 1, At, B1); PG8_BAR;
            PG8_LDA(At, 1, 1); PG8_STAGE(PG8_SA(1, 0), a3, voffA);
            PG8_BAR; PG8_WAIT_L(0); PG8_MMA(1, 0, At, B0); PG8_BAR; PG8_SCHED;
            PG8_STAGE(PG8_SB(1, 1), b3 + hstep, voffB);
            PG8_WAIT_V(6); PG8_BAR; PG8_MMA(1, 1, At, B1); PG8_BAR;
            }
        }
        if constexpr (ALIGN_EPI) { if (wr == 0) PG8_BAR; }
        if constexpr (!Epi::AFTER_DRAIN) { E(acc, cur, wr, wc, fr, fq); S.done(cur); }
        if (!has_next) break;
#pragma unroll
        for (int a = 0; a < 2; ++a)
#pragma unroll
            for (int b = 0; b < 2; ++b)
#pragma unroll
                for (int m = 0; m < 4; ++m)
#pragma unroll
                    for (int n = 0; n < 2; ++n) acc[a][b][m][n] = (f32x4){0.f, 0.f, 0.f, 0.f};
        cur = nxt; cA = nA; cB = nB; ++ui;
        if constexpr (ALIGN_EPI) { if (wr == 1) PG8_BAR; }
    }
    PG8_WAIT_V(0);
    if constexpr (!ALIGN_EPI) { if (wr == 0) PG8_BAR; }
    PG8_BAR;
    if constexpr (Epi::AFTER_DRAIN) { E.fused(acc, cur, wr, wc, fr, fq, lds, wid, lane); S.done(cur); }
#undef PG8_SA
#undef PG8_SB
#undef PG8_STAGE
#undef PG8_LDA
#undef PG8_LDB
#undef PG8_MMA
#undef PG8_WAIT_V
#undef PG8_WAIT_L
#undef PG8_BAR
#undef PG8_SCHED
}
__device__ __forceinline__ void map_tile(int L, int nM, int nN, int& pm, int& pn) {
    const int nwg = nM * nN; int wgid = L; { const int q = nwg / NXCD, r = nwg % NXCD, xcd = wgid % NXCD, off = wgid / NXCD; wgid = (xcd < r ? xcd * (q + 1) : r * (q + 1) + (xcd - r) * q) + off; }
    const int nig = WGM * nN, gid = wgid / nig, fm = gid * WGM, gsz = (nM - fm) < WGM ? (nM - fm) : WGM;
    pm = fm + ((wgid % nig) % gsz); pn = (wgid % nig) / gsz;
}
constexpr int MP = T / 256, WP = NMAIN / 256, NU2 = 4 * MP, NU1 = MP * WP;
struct InOrder { int G, c;
    __device__ __forceinline__ bool next(int i, Unit& u) const { const int L = i * G + c; if (L >= NU2 + NU1) return false; int a, b;
        if (L < NU2) { map_tile(L, 4, MP, a, b); u.pm = MP + WP + a; u.pn = b; } else { map_tile(L - NU2, MP, WP, a, b); u.pm = a; u.pn = MP + b; } return true; }
    __device__ __forceinline__ void a_ready(const Unit&) const {}
    __device__ __forceinline__ void done(const Unit&) const {}
};
struct EpiIn { static constexpr bool PERM = true, AFTER_DRAIN = false; bf16_t* P; float* G; bf16_t* HTp;
    __device__ __forceinline__ void operator()(const f32x4 (&acc)[2][2][4][2], const Unit& u, int wr, int wc, int fr, int fq) const {
        if (u.pm < MP) { const int pn = u.pn - MP, row0 = u.pm * BM + wr * 64 + fr;
            if (pn < NP / 256) { const int col0 = pn * BM + wc * 32 + 8 * fq;
#pragma unroll
                for (int ai = 0; ai < 2; ++ai)
#pragma unroll
                    for (int m = 0; m < 4; ++m) { bf16_t* rowp = P + (size_t)(row0 + ai * HALF + m * 16) * NP + col0;
#pragma unroll
                        for (int bj = 0; bj < 2; ++bj) { const f32x4 v0 = acc[ai][bj][m][0], v1 = acc[ai][bj][m][1];
                            u32x4 w; w.x = cvt_pk_bf16(v0[0], v0[1]); w.y = cvt_pk_bf16(v0[2], v0[3]); w.z = cvt_pk_bf16(v1[0], v1[1]); w.w = cvt_pk_bf16(v1[2], v1[3]); *(u32x4*)(rowp + bj * HALF) = w; } } }
            else { const int cb = wc * 32 + 8 * fq;
                if (cb < NG) {
#pragma unroll
                    for (int ai = 0; ai < 2; ++ai)
#pragma unroll
                        for (int m = 0; m < 4; ++m) { float* rowp = G + (size_t)(row0 + ai * HALF + m * 16) * NG + cb; *(f32x4*)rowp = acc[ai][0][m][0]; *(f32x4*)(rowp + 4) = acc[ai][0][m][1]; } } } }
        else { const int row0 = (u.pm - MP - WP) * BM + wr * 64 + fr, col0 = u.pn * BM + wc * 32 + 8 * fq;
#pragma unroll
            for (int ai = 0; ai < 2; ++ai)
#pragma unroll
                for (int m = 0; m < 4; ++m) { bf16_t* rowp = HTp + (size_t)(row0 + ai * HALF + m * 16) * T + col0;
#pragma unroll
                    for (int bj = 0; bj < 2; ++bj) { const f32x4 v0 = acc[ai][bj][m][0], v1 = acc[ai][bj][m][1];
                        u32x4 w; w.x = cvt_pk_bf16(v0[0], v0[1]); w.y = cvt_pk_bf16(v0[2], v0[3]); w.z = cvt_pk_bf16(v1[0], v1[1]); w.w = cvt_pk_bf16(v1[2], v1[3]); *(u32x4*)(rowp + bj * HALF) = w; } } }
    }
};
struct OutOrder { int G, c; bool lat_only;
    __device__ __forceinline__ bool next(int i, Unit& u) const { const int nM = lat_only ? NB * (SEQ / 256) : MP, nN = DM / 256; const int L = i * G + c; if (L >= nM * nN) return false; int a, b; map_tile(L, nM, nN, a, b);
        u.pm = lat_only ? (a / (SEQ / 256)) * (TOK / 256) + CTXL / 256 + a % (SEQ / 256) : a; u.pn = b; return true; }
    __device__ __forceinline__ void a_ready(const Unit&) const {}
    __device__ __forceinline__ void done(const Unit&) const {}
};
struct EpiOut { static constexpr bool PERM = false, AFTER_DRAIN = false; float* C;
    __device__ __forceinline__ void operator()(const f32x4 (&acc)[2][2][4][2], const Unit& u, int wr, int wc, int fr, int fq) const {
        const int row0 = u.pm * BM + wr * 64 + fr, col0 = u.pn * BM + wc * 32 + 4 * fq;
#pragma unroll
        for (int ai = 0; ai < 2; ++ai)
#pragma unroll
            for (int m = 0; m < 4; ++m) { float* rowp = C + (size_t)(row0 + ai * HALF + m * 16) * DM + col0;
#pragma unroll
                for (int bj = 0; bj < 2; ++bj)
#pragma unroll
                    for (int n = 0; n < 2; ++n) *(f32x4*)(rowp + bj * HALF + n * 16) = acc[ai][bj][m][n]; }
    }
};
}
#endif

__device__ void phase_gemm_in(const Params& p, int l, char* smem) {
    constexpr int N_F = WG / 2;
#ifdef EMU
    constexpr int MT = T / 128, NT1 = NMAIN / 128, N1 = MT * NT1, N2 = 8 * MT;
    for (int task = obid(); task < N1 + N2; task += gridDim.x) {
        if (task < N1) gemm_tile(p, (const bf16*)(p.ws + WS_HNY), (const bf16*)(p.ws + WS_WIN), DM, task / NT1, task % NT1, 0, smem);
        else { const int t2 = task - N1; gemm_tile(p, (const bf16*)(p.ws + WS_WIN) + (size_t)NMAIN * DM, (const bf16*)(p.ws + WS_HNY), DM, t2 / MT, t2 % MT, 2, smem); }
    }
#else
    { const pg8::Gemm g{(const pg8::bf16_t*)(p.ws + WS_HNY), (const pg8::bf16_t*)(p.ws + WS_HNY), 0, 0, DM};
      const pg8::InOrder S{(int)gridDim.x, obid()};
      const pg8::EpiIn E{(pg8::bf16_t*)(p.ws + WS_P), (float*)(p.ws + WS_G), (pg8::bf16_t*)(p.ws + WS_HT)};
      pg8::gemm_phase<pg8::EpiIn, pg8::InOrder, true, true>((PG8_LAS unsigned char*)smem, g, S, E); }
#endif
    for (int task = (int)gridDim.x - 1 - obid(); task < N_F; task += gridDim.x) filt_fft_task(p, task, smem);
}
__device__ void phase_gemm_out(const Params& p, int l, char* smem) {
#ifdef EMU
    constexpr int MT = T / 128, NTO = DM / 128;
    for (int task = obid(); task < MT * NTO; task += gridDim.x) {
        const int mt = task / NTO, nt = task % NTO;
        if (l == DEPTH - 1 && (mt % (TOK / 128)) < CTXL / 128) continue;
        gemm_tile(p, (const bf16*)(p.ws + WS_HNY), (const bf16*)(p.ws + WS_WOUT), MIX, mt, nt, 1, smem);
    }
#else
    const pg8::Gemm g{(const pg8::bf16_t*)(p.ws + WS_HNY), (const pg8::bf16_t*)(p.ws + WS_WOUT), 0, 0, MIX};
    const pg8::OutOrder S{(int)gridDim.x, obid(), l == DEPTH - 1};
    const pg8::EpiOut E{(float*)(p.ws + WS_P)};
    pg8::gemm_phase<pg8::EpiOut, pg8::OutOrder, true, true>((PG8_LAS unsigned char*)smem, g, S, E);
#endif
}

__device__ __forceinline__ size_t st_index(int mixer, int dir, int b, int h, int cid) { return ((((size_t)(mixer * 2 + dir) * NB + b) * NH + h) * NCH + cid); }
__device__ __forceinline__ size_t ch_index(int dir, int b, int h, int cid) { return (((size_t)dir * NB + b) * NH + h) * NCH + cid; }

__device__ __forceinline__ void load_tile_nat(const bf16* P, int r0, int c0, bf16* dst, float scale, int tid) {
    const int s = tid >> 3, c8 = tid & 7;
    const u32x4 v = *(const u32x4*)(P + (size_t)(r0 + s) * NP + c0 + c8 * 8);
    if (scale == 1.0f) *(u32x4*)(dst + s * LS + c8 * 8) = v;
    else { float f[8]; unpack8(v, f); u32x4 o; o.x = pk2(f[0] * scale, f[1] * scale); o.y = pk2(f[2] * scale, f[3] * scale); o.z = pk2(f[4] * scale, f[5] * scale); o.w = pk2(f[6] * scale, f[7] * scale);
        *(u32x4*)(dst + s * LS + c8 * 8) = o; }
}
__device__ __forceinline__ void load_tile_tr(const bf16* P, int r0, int c0, bf16* dst, int tid) {
    const int s = tid >> 3, c8 = tid & 7;
    const u32x4 v = *(const u32x4*)(P + (size_t)(r0 + s) * NP + c0 + c8 * 8);
    const unsigned w[4] = {v.x, v.y, v.z, v.w};
#pragma unroll
    for (int j = 0; j < 4; ++j) { dst[(c8 * 8 + 2 * j) * LS + s] = (bf16)(w[j] & 0xffffu); dst[(c8 * 8 + 2 * j + 1) * LS + s] = (bf16)(w[j] >> 16); }
}

__device__ void gla_decay(const Params& p, int l, int h, int dir, const float* rs, float* la, int tid) {
    const int lane = tid & 63, wave = tid >> 6;
    { const int d = tid & 63, sg = tid >> 6; float w[16];
        const float* wa = p.in[I_GWA] + ((size_t)(l * 2 + dir) * 16) * WG + h * 64 + d;
#pragma unroll
        for (int j = 0; j < 16; ++j) w[j] = wa[(size_t)j * WG];
        const float ba = p.in[I_GBA][(size_t)(l * 2 + dir) * WG + h * 64 + d];
        for (int s = sg * 8; s < sg * 8 + 8; ++s) { float a = ba;
#pragma unroll
            for (int j = 0; j < 16; ++j) a += rs[s * 32 + dir * 16 + j] * w[j];
            la[s * 65 + d] = logsigf_(a) * (1.0f / 16.0f); } }
    __syncthreads();
    for (int d = wave * 8; d < wave * 8 + 8; ++d) {
        float v = la[lane * 65 + d];
        if (dir == 0) v = wave_prefix_sum(v, lane);
        else { const float tot = wave_sum(v); const float pre = wave_prefix_sum(v, lane); v = tot - pre + v; }
        la[lane * 65 + d] = v;
    }
    __syncthreads();
}

__device__ void chunkst_task(const Params& p, int l, int mixer, int b, int h, int cid, char* smem) {
    const int tid = otid(), lane = tid & 63, wave = tid >> 6;
    const bf16* P = (const bf16*)(p.ws + WS_P); const float* G = (const float*)(p.ws + WS_G);
    bf16* ST = (bf16*)(p.ws + WS_ST);
    const int r0 = b * TOK + cid * 64;
    bf16* Vt = (bf16*)smem;
    bf16* Kt = Vt + 64 * LS;
    float* wv = (float*)(Kt + 64 * LS);
    float* rs = wv + 128;
    float* la = rs + 64 * 32;
    float* bend = la + 64 * 65;
    __syncthreads();
    const int kcol = mixer == 0 ? PA + 256 + h * 64 : PG + 256 + h * 64, vcol = mixer == 0 ? PA + 512 + h * 64 : PG + 512 + h * 64;
    load_tile_tr(P, r0, vcol, Vt, tid);
    if (mixer == 0) {
        if (wave == 0) {
            const float* g = G + (size_t)(r0 + lane) * NG; const float* gb = p.in[I_MGB] + (size_t)l * 16;
            const float i_f = g[h] + gb[h], f_f = g[4 + h] + gb[4 + h], i_b = g[8 + h] + gb[8 + h], f_b = g[12 + h] + gb[12 + h];
            const float lf = logsigf_(f_f), lb = logsigf_(f_b);
            const float bF = wave_prefix_sum(lf, lane), totF = __shfl(bF, 63);
            const float gF = totF - bF + i_f, mF = wave_max(gF);
            const float totB = wave_sum(lb), preB = wave_prefix_sum(lb, lane), bB = totB - preB + lb;
            const float gB = totB - bB + i_b, mB = wave_max(gB);
            wv[lane] = __expf(gF - mF); wv[64 + lane] = __expf(gB - mB);
            if (lane == 0) { float* SC = (float*)(p.ws + WS_SC);
                SC[ch_index(0, b, h, cid) * 4 + 0] = totF; SC[ch_index(0, b, h, cid) * 4 + 1] = mF;
                SC[ch_index(1, b, h, cid) * 4 + 0] = totB; SC[ch_index(1, b, h, cid) * 4 + 1] = mB; }
        }
    } else {
        for (int i = tid; i < 64 * 32; i += NT) rs[i] = G[(size_t)(r0 + (i >> 5)) * NG + 16 + (i & 31)];
    }
    __syncthreads();
    for (int dir = 0; dir < 2; ++dir) {
        if (mixer == 1) {
            gla_decay(p, l, h, dir, rs, la, tid);
            if (tid < 64) { const float be = dir == 0 ? la[63 * 65 + tid] : la[tid]; bend[tid] = be; ((float*)(p.ws + WS_BE))[ch_index(dir, b, h, cid) * 64 + tid] = be; }
            __syncthreads();
        }
        {
            const int s = tid >> 3, c8 = tid & 7; float f[8];
            unpack8(*(const u32x4*)(P + (size_t)(r0 + s) * NP + kcol + c8 * 8), f);
#pragma unroll
            for (int j = 0; j < 8; ++j) { const int d = c8 * 8 + j;
                const float w = mixer == 0 ? 0.125f * wv[dir * 64 + s] : __expf(bend[d] - la[s * 65 + d]);
                Kt[d * LS + s] = f2bf(f[j] * w); }
        }
        __syncthreads();
        f32x4 acc[2] = {(f32x4){0.f, 0.f, 0.f, 0.f}, (f32x4){0.f, 0.f, 0.f, 0.f}};
        const int e0 = (wave & 3) * 16, d0 = (wave >> 2) * 32;
        mma_nt<2, 2>(Vt, LS, e0, Kt, LS, d0, acc, lane);
        bf16* dst = ST + st_index(mixer, dir, b, h, cid) * 4096;
        const int r = lane & 15, q = lane >> 4;
#pragma unroll
        for (int nt = 0; nt < 2; ++nt)
#pragma unroll
            for (int i = 0; i < 4; ++i) dst[(e0 + 4 * q + i) * 64 + d0 + 16 * nt + r] = f2bf(acc[nt][i]);
        if (mixer == 0 && tid < 64) { float s = 0.f; for (int j = 0; j < 64; ++j) s += bf2f(Kt[tid * LS + j]);
            ((float*)(p.ws + WS_NV))[ch_index(dir, b, h, cid) * 64 + tid] = s; }
        __syncthreads();
    }
}

template <int NTK>
__device__ __forceinline__ void load_span(const bf16* row, int t0, float (&v)[NTK + 2]) {
    v[0] = t0 > 0 ? bf2f(row[-1]) : 0.f; v[NTK + 1] = (t0 + NTK < SEQ) ? bf2f(row[NTK]) : 0.f;
    if constexpr (NTK == 8) { float f[8]; unpack8(*(const u32x4*)row, f);
#pragma unroll
        for (int i = 0; i < 8; ++i) v[1 + i] = f[i]; }
    else {
#pragma unroll
        for (int i = 0; i < NTK; ++i) v[1 + i] = bf2f(row[i]); }
}
__device__ void hylat_task(const Params& p, int l, int bp, int cp, char* smem) {
    const int tid = otid(), half = tid >> 8, tl = tid & 255, c = 2 * cp + half;
    const bf16* HT = (const bf16*)(p.ws + WS_HT); bf16* Y = (bf16*)(p.ws + WS_HNY);
    cpx* buf = (cpx*)smem + (size_t)half * NF;
    const cpx* TW = (const cpx*)(p.ws + WS_TW);
    const cpx* KF = (const cpx*)(p.ws + WS_KF) + (size_t)c * NF;
    constexpr int NTK = SEQ / 256;
    const int t0 = NTK * tl;
    const float* cw = p.in[I_HCW] + (size_t)l * 3 * 768; const float* cb = p.in[I_HCB] + (size_t)l * 768;
    const size_t rb0 = (size_t)(2 * bp) * TOK + CTXL, rb1 = rb0 + TOK;
    const bf16* h0 = HT + (size_t)c * T + rb0 + t0; const bf16* h1 = h0 + TOK;
    float u0[NTK], u1[NTK], g0[NTK], g1[NTK];
    { float xa[NTK + 2], xb[NTK + 2]; load_span<NTK>(h0 + (size_t)512 * T, t0, xa); load_span<NTK>(h1 + (size_t)512 * T, t0, xb);
        const float w0 = cw[0 * 768 + 512 + c], w1 = cw[1 * 768 + 512 + c], w2 = cw[2 * 768 + 512 + c], bb = cb[512 + c];
        float ga[NTK + 2], gb[NTK + 2]; load_span<NTK>(h0 + (size_t)768 * T, t0, ga); load_span<NTK>(h1 + (size_t)768 * T, t0, gb);
#pragma unroll
        for (int i = 0; i < NTK; ++i) { g0[i] = (w0 * xa[i] + w1 * xa[i + 1] + w2 * xa[i + 2] + bb) * siluf_(ga[i + 1]); g1[i] = (w0 * xb[i] + w1 * xb[i + 1] + w2 * xb[i + 2] + bb) * siluf_(gb[i + 1]); } }
    { float va[NTK + 2], vb[NTK + 2], ya[NTK + 2], yb[NTK + 2];
        load_span<NTK>(h0, t0, va); load_span<NTK>(h1, t0, vb); load_span<NTK>(h0 + (size_t)256 * T, t0, ya); load_span<NTK>(h1 + (size_t)256 * T, t0, yb);
        const float v0 = cw[0 * 768 + c], v1 = cw[1 * 768 + c], v2 = cw[2 * 768 + c], vbias = cb[c];
        const float y0 = cw[0 * 768 + 256 + c], y1 = cw[1 * 768 + 256 + c], y2 = cw[2 * 768 + 256 + c], ybias = cb[256 + c];
#pragma unroll
        for (int i = 0; i < NTK; ++i) { u0[i] = (v0 * va[i] + v1 * va[i + 1] + v2 * va[i + 2] + vbias) * (y0 * ya[i] + y1 * ya[i + 1] + y2 * ya[i + 2] + ybias);
            u1[i] = (v0 * vb[i] + v1 * vb[i + 1] + v2 * vb[i + 2] + vbias) * (y0 * yb[i] + y1 * yb[i + 1] + y2 * yb[i + 2] + ybias); } }
    __syncthreads();
#pragma unroll
    for (int i = 0; i < NTK; ++i) { cpx v; v.x = u0[i]; v.y = u1[i]; buf[t0 + i] = v; cpx z = {0.f, 0.f}; buf[SEQ + t0 + i] = z; }
    fft_fwd(buf, TW, tl);
#pragma unroll 2
    for (int i = tl; i < NF; i += 256) buf[i] = cmul(buf[i], KF[i]);
    fft_inv(buf, TW, tl);
    const float dsk = p.in[I_HD][(size_t)l * WG + c]; const float sc = 1.0f / (float)NF;
    bf16* yb0 = Y + (rb0 + t0) * 1024 + YH + c; bf16* yb1 = Y + (rb1 + t0) * 1024 + YH + c;
#pragma unroll
    for (int i = 0; i < NTK; ++i) { const cpx y = buf[t0 + i];
        yb0[i * 1024] = f2bf(g0[i] * (y.x * sc + u0[i] * dsk));
        yb1[i * 1024] = f2bf(g1[i] * (y.y * sc + u1[i] * dsk)); }
}

constexpr int HCB = 8;
__device__ void hyctx_task(const Params& p, int l, int b, int cblk, char* smem) {
    const int tid = otid(); const int c0 = cblk * HCB;
    const bf16* HT = (const bf16*)(p.ws + WS_HT); bf16* Y = (bf16*)(p.ws + WS_HNY); const float* HC = (const float*)(p.ws + WS_HC);
    float* raw = (float*)smem;
    float* u = raw + 3 * CTXL * HCB;
    float* hf = u + CTXL * HCB;
    float* hb = hf + CTXL * HCB;
    float* og = hb + CTXL * HCB;
    const size_t rb = (size_t)b * TOK;
    const float* cw = p.in[I_HCW] + (size_t)l * 3 * 768; const float* cbias = p.in[I_HCB] + (size_t)l * 768;
    __syncthreads();
    for (int i = tid; i < 3 * CTXL * HCB; i += NT) { const int k = i / (CTXL * HCB), cc = (i / CTXL) % HCB, t = i % CTXL; raw[(k * CTXL + t) * HCB + cc] = bf2f(HT[(size_t)(k * 256 + c0 + cc) * T + rb + t]); }
    for (int i = tid; i < CTXL * HCB; i += NT) { const int t = i / HCB, cc = i % HCB; hf[i] = HC[((size_t)0 * WG + c0 + cc) * CTXL + t]; hb[i] = HC[((size_t)1 * WG + c0 + cc) * CTXL + t]; }
    __syncthreads();
    for (int i = tid; i < CTXL * HCB; i += NT) { const int t = i / HCB, cc = i % HCB; float cv[3];
#pragma unroll
        for (int k = 0; k < 3; ++k) { const float* rk = raw + k * CTXL * HCB; const int ch = k * 256 + c0 + cc;
            const float a = t > 0 ? rk[(t - 1) * HCB + cc] : 0.f, m = rk[t * HCB + cc], z = t < CTXL - 1 ? rk[(t + 1) * HCB + cc] : 0.f;
            cv[k] = cw[0 * 768 + ch] * a + cw[1 * 768 + ch] * m + cw[2 * 768 + ch] * z + cbias[ch]; }
        u[i] = cv[0] * cv[1];
        og[i] = cv[2] * siluf_(bf2f(HT[(size_t)(768 + c0 + cc) * T + rb + t])); }
    __syncthreads();
    { const int cc = tid % HCB, tg = tid / HCB; constexpr int TG = NT / HCB, NTK = CTXL / TG; float acc[NTK];
#pragma unroll
        for (int i = 0; i < NTK; ++i) acc[i] = 0.f;
        for (int s = 0; s < CTXL; ++s) { const float us = u[s * HCB + cc];
#pragma unroll
            for (int i = 0; i < NTK; ++i) { const int t = tg + TG * i; const float hv = (s <= t) ? hf[(t - s) * HCB + cc] : hb[(s - t) * HCB + cc]; acc[i] += us * hv; } }
        const float dsk = p.in[I_HD][(size_t)l * WG + c0 + cc];
#pragma unroll
        for (int i = 0; i < NTK; ++i) { const int t = tg + TG * i; Y[(rb + t) * 1024 + YH + c0 + cc] = f2bf(og[t * HCB + cc] * (acc[i] + u[t * HCB + cc] * dsk)); } }
}

__device__ void attn_task(const Params& p, int l, int b, int kvh, int qt, bool ctxq, char* smem) {
    const int tid = otid(), lane = tid & 63, wave = tid >> 6, r = lane & 15, q = lane >> 4;
    const bf16* P = (const bf16*)(p.ws + WS_P); bf16* Y = (bf16*)(p.ws + WS_HNY); const cpx* ROPE = (const cpx*)(p.ws + WS_ROPE);
    bf16* Qs = (bf16*)smem;
    bf16* Ks = Qs + 128 * LS;
    bf16* Vt = Ks + 64 * LS;
    bf16* Ps = Vt + 64 * LS;
    const size_t rq0 = (size_t)b * TOK + (ctxq ? 0 : CTXL) + qt * 64;
    __syncthreads();
    {
        const int row = tid >> 2, cpair = tid & 3, g = row >> 6, t = row & 63;
        const bf16* src = P + (rq0 + t) * NP + PD + (kvh * 2 + g) * 64;
        float lo[8], hi[8]; unpack8(*(const u32x4*)(src + cpair * 8), lo); unpack8(*(const u32x4*)(src + 32 + cpair * 8), hi);
        u32x4 o1, o2; float a[8], c2[8];
#pragma unroll
        for (int j = 0; j < 8; ++j) { float cs = 1.f, sn = 0.f; if (!ctxq) { const cpx cv = ROPE[(size_t)(qt * 64 + t) * 32 + cpair * 8 + j]; cs = cv.x; sn = cv.y; }
            a[j] = (lo[j] * cs - hi[j] * sn) * 0.125f; c2[j] = (hi[j] * cs + lo[j] * sn) * 0.125f; }
        o1.x = pk2(a[0], a[1]); o1.y = pk2(a[2], a[3]); o1.z = pk2(a[4], a[5]); o1.w = pk2(a[6], a[7]);
        o2.x = pk2(c2[0], c2[1]); o2.y = pk2(c2[2], c2[3]); o2.z = pk2(c2[4], c2[5]); o2.w = pk2(c2[6], c2[7]);
        *(u32x4*)(Qs + row * LS + cpair * 8) = o1; *(u32x4*)(Qs + row * LS + 32 + cpair * 8) = o2;
    }
    const int lt0 = ctxq ? 0 : (qt - 2 > 0 ? qt - 2 : 0), lt1 = ctxq ? -1 : (qt + 2 < SEQ / 64 - 1 ? qt + 2 : SEQ / 64 - 1);
    const int nloc = lt1 - lt0 + 1, ntiles = nloc + NCC;
    float m[4], lsum[4]; f32x4 O[4];
#pragma unroll
    for (int i = 0; i < 4; ++i) { m[i] = -INFINITY; lsum[i] = 0.f; O[i] = (f32x4){0.f, 0.f, 0.f, 0.f}; }
    const int g = wave >> 2, tq0 = (wave & 3) * 16;
    bf16* Pw = Ps + wave * 16 * LS;
    for (int ti = 0; ti < ntiles; ++ti) {
        const bool local = ti < nloc; const int kt = local ? lt0 + ti : ti - nloc;
        const size_t rk0 = (size_t)b * TOK + (local ? CTXL : 0) + kt * 64;
        __syncthreads();
        if (tid < 256) { const int s = tid >> 2, cpair = tid & 3; const bf16* src = P + (rk0 + s) * NP + PD + 256 + kvh * 64;
            float lo[8], hi[8]; unpack8(*(const u32x4*)(src + cpair * 8), lo); unpack8(*(const u32x4*)(src + 32 + cpair * 8), hi);
            float a[8], c2[8];
#pragma unroll
            for (int j = 0; j < 8; ++j) { float cs = 1.f, sn = 0.f; if (local) { const cpx cv = ROPE[(size_t)(kt * 64 + s) * 32 + cpair * 8 + j]; cs = cv.x; sn = cv.y; }
                a[j] = lo[j] * cs - hi[j] * sn; c2[j] = hi[j] * cs + lo[j] * sn; }
            u32x4 o1, o2;
            o1.x = pk2(a[0], a[1]); o1.y = pk2(a[2], a[3]); o1.z = pk2(a[4], a[5]); o1.w = pk2(a[6], a[7]);
            o2.x = pk2(c2[0], c2[1]); o2.y = pk2(c2[2], c2[3]); o2.z = pk2(c2[4], c2[5]); o2.w = pk2(c2[6], c2[7]);
            *(u32x4*)(Ks + s * LS + cpair * 8) = o1; *(u32x4*)(Ks + s * LS + 32 + cpair * 8) = o2; }
        load_tile_tr(P, (int)rk0, PD + 384 + kvh * 64, Vt, tid);
        __syncthreads();
        f32x4 S[4] = {(f32x4){0.f, 0.f, 0.f, 0.f}, (f32x4){0.f, 0.f, 0.f, 0.f}, (f32x4){0.f, 0.f, 0.f, 0.f}, (f32x4){0.f, 0.f, 0.f, 0.f}};
        mma_nt<4, 2>(Qs, LS, g * 64 + tq0, Ks, LS, 0, S, lane);
        float rmax[4], rsum[4];
#pragma unroll
        for (int i = 0; i < 4; ++i) { const int qpos = qt * 64 + tq0 + 4 * q + i; float mx = -INFINITY;
#pragma unroll
            for (int nt = 0; nt < 4; ++nt) { if (local) { const int kpos = kt * 64 + nt * 16 + r; const int d = kpos - qpos; if (d > 128 || d < -128) S[nt][i] = -INFINITY; } mx = fmaxf(mx, S[nt][i]); }
            mx = fmaxf(mx, __shfl_xor(mx, 1)); mx = fmaxf(mx, __shfl_xor(mx, 2)); mx = fmaxf(mx, __shfl_xor(mx, 4)); mx = fmaxf(mx, __shfl_xor(mx, 8));
            rmax[i] = mx; }
#pragma unroll
        for (int i = 0; i < 4; ++i) { const float mn = fmaxf(m[i], rmax[i]); const float alpha = __expf(m[i] - mn); float sm = 0.f;
#pragma unroll
            for (int nt = 0; nt < 4; ++nt) { const float pv = __expf(S[nt][i] - mn); sm += pv; Pw[(4 * q + i) * LS + nt * 16 + r] = f2bf(pv); O[nt][i] *= alpha; }
            sm += __shfl_xor(sm, 1); sm += __shfl_xor(sm, 2); sm += __shfl_xor(sm, 4); sm += __shfl_xor(sm, 8);
            lsum[i] = lsum[i] * alpha + sm; m[i] = mn; rsum[i] = sm; }
        __syncthreads();
        mma_nt<4, 2>(Pw, LS, 0, Vt, LS, 0, O, lane);
    }
    const float sink = p.in[I_SINK][(size_t)l * NH + kvh * 2 + g];
#pragma unroll
    for (int i = 0; i < 4; ++i) { const float den = lsum[i] + __expf(sink - m[i]); const float inv = 1.0f / den; const int t = tq0 + 4 * q + i;
#pragma unroll
        for (int nt = 0; nt < 4; ++nt) { const int e = nt * 16 + r; const float gate = bf2f(P[(rq0 + t) * NP + PD + 512 + (kvh * 2 + g) * 64 + e]);
            Y[(rq0 + t) * 1024 + YD + (kvh * 2 + g) * 64 + e] = f2bf(O[nt][i] * inv * siluf_(gate)); } }
}

__device__ void phase_mix1(const Params& p, int l, char* smem) {
    const bool ctxo = l < DEPTH - 1;
    constexpr int N_HL = (NB / 2) * (WG / 2), N_AL = NB * 2 * (SEQ / 64), N_CS = 2 * NB * NH * NCH, N_HC = NB * (WG / HCB), N_AC = NB * 2 * NCC;
    const int total = N_HL + N_AL + N_CS + (ctxo ? N_HC + N_AC : 0);
    for (int task = obid(); task < total; task += gridDim.x) {
        int t = task;
        if (t < N_HL) { hylat_task(p, l, t / (WG / 2), t % (WG / 2), smem); continue; } t -= N_HL;
        if (t < N_AL) { attn_task(p, l, t / (2 * (SEQ / 64)), (t / (SEQ / 64)) % 2, t % (SEQ / 64), false, smem); continue; } t -= N_AL;
        if (t < N_CS) { const int mixer = t / (NB * NH * NCH), r2 = t % (NB * NH * NCH); chunkst_task(p, l, mixer, r2 / (NH * NCH), (r2 / NCH) % NH, r2 % NCH, smem); continue; } t -= N_CS;
        if (t < N_HC) { hyctx_task(p, l, t / (WG / HCB), t % (WG / HCB), smem); continue; } t -= N_HC;
        attn_task(p, l, t / (2 * NCC), (t / NCC) % 2, t % NCC, true, smem);
    }
}

__device__ void phase_scan(const Params& p) {
    const int tid = otid();
    bf16* ST = (bf16*)(p.ws + WS_ST); float* NV = (float*)(p.ws + WS_NV); const float* BE = (const float*)(p.ws + WS_BE); float* SC = (float*)(p.ws + WS_SC);
    constexpr int NCHAIN = 2 * 2 * NB * NH;
    for (int item = obid() * NT + tid; item < NCHAIN * 1024; item += gridDim.x * NT) {
        const int chain = item >> 10, grp = item & 1023; const int mixer = chain / (2 * NB * NH), dir = (chain / (NB * NH)) % 2, b = (chain / NH) % NB, h = chain % NH;
        float c[4] = {0.f, 0.f, 0.f, 0.f}; float nv[4] = {0.f, 0.f, 0.f, 0.f}; float m = 0.f;
        const int d0 = (grp & 15) * 4;
        for (int o = 0; o < NCH; ++o) {
            const int cid = chain_cid(dir, o);
            bf16* slot = ST + st_index(mixer, dir, b, h, cid) * 4096 + grp * 4;
            const u32x2 uu = *(const u32x2*)slot; const float u[4] = {bitsf(uu.x << 16), bitsf(uu.x & 0xffff0000u), bitsf(uu.y << 16), bitsf(uu.y & 0xffff0000u)};
            u32x2 w; w.x = pk2(c[0], c[1]); w.y = pk2(c[2], c[3]); *(u32x2*)slot = w;
            if (mixer == 0) {
                const size_t ci = ch_index(dir, b, h, cid); const float bend = SC[ci * 4 + 0], mloc = SC[ci * 4 + 1];
                if (grp == 0) SC[ci * 4 + 2] = m;
                const float mn = fmaxf(bend + m, mloc), a = __expf(bend + m - mn), s = __expf(mloc - mn);
#pragma unroll
                for (int j = 0; j < 4; ++j) c[j] = a * c[j] + s * u[j];
                if (grp < 16) { float* nslot = NV + ci * 64 + grp * 4; const f32x4 nu = *(const f32x4*)nslot; f32x4 nw = {nv[0], nv[1], nv[2], nv[3]}; *(f32x4*)nslot = nw;
                    nv[0] = a * nv[0] + s * nu.x; nv[1] = a * nv[1] + s * nu.y; nv[2] = a * nv[2] + s * nu.z; nv[3] = a * nv[3] + s * nu.w; }
                m = mn;
            } else {
                const f32x4 be = *(const f32x4*)(BE + ch_index(dir, b, h, cid) * 64 + d0);
                c[0] = __expf(be.x) * c[0] + u[0]; c[1] = __expf(be.y) * c[1] + u[1]; c[2] = __expf(be.z) * c[2] + u[2]; c[3] = __expf(be.w) * c[3] + u[3];
            }
        }
    }
}

__device__ void chunkout_task(const Params& p, int l, int mixer, int b, int h, int cid, char* smem) {
    const int tid = otid(), lane = tid & 63, wave = tid >> 6, r = lane & 15, q = lane >> 4;
    const bf16* P = (const bf16*)(p.ws + WS_P); const float* G = (const float*)(p.ws + WS_G); bf16* Y = (bf16*)(p.ws + WS_HNY);
    const bf16* ST = (const bf16*)(p.ws + WS_ST);
    const int r0 = b * TOK + cid * 64;
    const int pbase = mixer == 0 ? PA : PG;
    bf16* Qs = (bf16*)smem;
    bf16* Ks = Qs + 64 * LS;
    bf16* Qh = Ks + 64 * LS;
    bf16* Vt = Qh + 64 * LS;
    bf16* Ct = Vt + 64 * LS;
    bf16* Sm = Ct + 64 * LS;
    float* fb = (float*)(Sm + 64 * LS);
    float* rowt = fb;
    float* colt = rowt + 64;
    float* wint = colt + 64;
    float* emt = wint + 64;
    float* nprev = emt + 64;
    float* qn = nprev + 64;
    float* rsum = qn + 64;
    float* rs = rsum + 128;
    float* la = rs + 64 * 32;
    float* hs = la;
    __syncthreads();
    load_tile_tr(P, r0, pbase + 512 + h * 64, Vt, tid);
    if (mixer == 0) { load_tile_nat(P, r0, pbase + h * 64, Qs, 1.0f, tid); load_tile_nat(P, r0, pbase + 256 + h * 64, Ks, 0.125f, tid); }
    else for (int i = tid; i < 64 * 32; i += NT) rs[i] = G[(size_t)(r0 + (i >> 5)) * NG + 16 + (i & 31)];
    const int t0 = (wave & 3) * 16, c0 = (wave >> 2) * 32;
    f32x4 htot[2] = {(f32x4){0.f, 0.f, 0.f, 0.f}, (f32x4){0.f, 0.f, 0.f, 0.f}};
    for (int dir = 0; dir < 2; ++dir) {
        __syncthreads();
        { const int s = tid >> 3, c8 = tid & 7; *(u32x4*)(Ct + s * LS + c8 * 8) = *(const u32x4*)(ST + st_index(mixer, dir, b, h, cid) * 4096 + s * 64 + c8 * 8); }
        if (mixer == 0) {
            if (wave == 0) {
                const float* g = G + (size_t)(r0 + lane) * NG; const float* gb = p.in[I_MGB] + (size_t)l * 16;
                const float ig = g[dir * 8 + h] + gb[dir * 8 + h], fg = g[dir * 8 + 4 + h] + gb[dir * 8 + 4 + h];
                const float lf = logsigf_(fg); float bb;
                if (dir == 0) bb = wave_prefix_sum(lf, lane); else { const float tot = wave_sum(lf), pre = wave_prefix_sum(lf, lane); bb = tot - pre + lf; }
                const float a = ig - bb; const float pm = dir == 0 ? wave_prefix_max(a, lane) : wave_suffix_max(a, lane);
                const float mprev = ((const float*)(p.ws + WS_SC))[ch_index(dir, b, h, cid) * 4 + 2];
                const float mt = fmaxf(bb + mprev, bb + pm);
                rowt[lane] = bb - mt; colt[lane] = a; wint[lane] = __expf(bb + mprev - mt); emt[lane] = __expf(-mt);
                nprev[lane] = ((const float*)(p.ws + WS_NV))[ch_index(dir, b, h, cid) * 64 + lane];
            }
            __syncthreads();
            if (tid < 64) { float s = 0.f; for (int d = 0; d < 64; ++d) s += bf2f(Qs[tid * LS + d]) * nprev[d]; qn[tid] = s; }
        } else {
            gla_decay(p, l, h, dir, rs, la, tid);
            { const int s = tid >> 3, c8 = tid & 7; float fq[8], fk[8];
                unpack8(*(const u32x4*)(P + (size_t)(r0 + s) * NP + pbase + h * 64 + c8 * 8), fq); unpack8(*(const u32x4*)(P + (size_t)(r0 + s) * NP + pbase + 256 + h * 64 + c8 * 8), fk);
                float a1[8], a2[8], a3[8];
#pragma unroll
                for (int j = 0; j < 8; ++j) { const int d = c8 * 8 + j; const float bs = la[s * 65 + d]; const float bmid = 0.5f * (dir == 0 ? la[63 * 65 + d] : la[d]);
                    a1[j] = fq[j] * 0.125f * __expf(bs - bmid); a2[j] = fk[j] * __expf(bmid - bs); a3[j] = fq[j] * 0.125f * __expf(bs); }
                u32x4 o; o.x = pk2(a1[0], a1[1]); o.y = pk2(a1[2], a1[3]); o.z = pk2(a1[4], a1[5]); o.w = pk2(a1[6], a1[7]); *(u32x4*)(Qs + s * LS + c8 * 8) = o;
                o.x = pk2(a2[0], a2[1]); o.y = pk2(a2[2], a2[3]); o.z = pk2(a2[4], a2[5]); o.w = pk2(a2[6], a2[7]); *(u32x4*)(Ks + s * LS + c8 * 8) = o;
                o.x = pk2(a3[0], a3[1]); o.y = pk2(a3[2], a3[3]); o.z = pk2(a3[4], a3[5]); o.w = pk2(a3[6], a3[7]); *(u32x4*)(Qh + s * LS + c8 * 8) = o; }
        }
        __syncthreads();
        {
            f32x4 S[2] = {(f32x4){0.f, 0.f, 0.f, 0.f}, (f32x4){0.f, 0.f, 0.f, 0.f}};
            mma_nt<2, 2>(Qs, LS, t0, Ks, LS, c0, S, lane);
#pragma unroll
            for (int i = 0; i < 4; ++i) { const int t = t0 + 4 * q + i; float sm = 0.f;
#pragma unroll
                for (int nt = 0; nt < 2; ++nt) { const int s = c0 + 16 * nt + r; const bool ok = dir == 0 ? (s <= t) : (s >= t); float v = 0.f;
                    if (ok) v = mixer == 0 ? S[nt][i] * __expf(rowt[t] + colt[s]) : S[nt][i];
                    Sm[t * LS + s] = f2bf(v); sm += v; }
                if (mixer == 0) { sm += __shfl_xor(sm, 1); sm += __shfl_xor(sm, 2); sm += __shfl_xor(sm, 4); sm += __shfl_xor(sm, 8); if (r == 0) rsum[(wave >> 2) * 64 + t] = sm; } }
        }
        __syncthreads();
        { f32x4 a1[2] = {(f32x4){0.f, 0.f, 0.f, 0.f}, (f32x4){0.f, 0.f, 0.f, 0.f}}, a2[2] = {(f32x4){0.f, 0.f, 0.f, 0.f}, (f32x4){0.f, 0.f, 0.f, 0.f}};
            mma_nt<2, 2>(Sm, LS, t0, Vt, LS, c0, a1, lane);
            mma_nt<2, 2>(mixer == 0 ? Qs : Qh, LS, t0, Ct, LS, c0, a2, lane);
#pragma unroll
            for (int i = 0; i < 4; ++i) { const int t = t0 + 4 * q + i;
                if (mixer == 0) { const float wi = wint[t]; const float den = wi * qn[t] + rsum[t] + rsum[64 + t]; const float inv = 1.0f / fmaxf(fabsf(den), emt[t]);
#pragma unroll
                    for (int nt = 0; nt < 2; ++nt) htot[nt][i] += (a1[nt][i] + wi * a2[nt][i]) * inv; }
                else {
#pragma unroll
                    for (int nt = 0; nt < 2; ++nt) htot[nt][i] += a1[nt][i] + a2[nt][i]; } }
        }
    }
    __syncthreads();
#pragma unroll
    for (int nt = 0; nt < 2; ++nt)
#pragma unroll
        for (int i = 0; i < 4; ++i) hs[(t0 + 4 * q + i) * 65 + c0 + 16 * nt + r] = htot[nt][i];
    __syncthreads();
    { const int t = tid >> 3, c8 = tid & 7; float v[8], o8[8], g8[8]; float ss = 0.f;
        unpack8(*(const u32x4*)(P + (size_t)(r0 + t) * NP + pbase + (mixer == 0 ? 1024 : 768) + h * 64 + c8 * 8), g8);
        if (mixer == 0) unpack8(*(const u32x4*)(P + (size_t)(r0 + t) * NP + pbase + 768 + h * 64 + c8 * 8), o8);
#pragma unroll
        for (int j = 0; j < 8; ++j) { float x = hs[t * 65 + c8 * 8 + j]; if (mixer == 0) x *= sigmoidf_(o8[j]); v[j] = x; ss += x * x; }
        ss += __shfl_xor(ss, 1); ss += __shfl_xor(ss, 2); ss += __shfl_xor(ss, 4);
        const float rstd = rsqrtf(ss * (1.0f / 64.0f) + EPS);
        const float* ng = p.in[mixer == 0 ? I_MNG : I_GNG] + (size_t)l * WG + h * 64 + c8 * 8;
        float w[8];
#pragma unroll
        for (int j = 0; j < 8; ++j) w[j] = v[j] * rstd * ng[j] * siluf_(g8[j]);
        u32x4 o; o.x = pk2(w[0], w[1]); o.y = pk2(w[2], w[3]); o.z = pk2(w[4], w[5]); o.w = pk2(w[6], w[7]);
        *(u32x4*)(Y + (size_t)(r0 + t) * 1024 + (mixer == 0 ? YA : YG) + h * 64 + c8 * 8) = o; }
}

__device__ void phase_mix2(const Params& p, int l, char* smem) {
    constexpr int N = 2 * NB * NH * NCH;
    for (int task = obid(); task < N; task += gridDim.x) {
        const int mixer = task / (NB * NH * NCH), r2 = task % (NB * NH * NCH); const int b = r2 / (NH * NCH), h = (r2 / NCH) % NH, cid = r2 % NCH;
        if (l == DEPTH - 1 && cid < NCC) continue;
        chunkout_task(p, l, mixer, b, h, cid, smem);
    }
}


#ifndef EMU
#define LAS __attribute__((address_space(3)))
#define XB_TMO      128
#define XB_XCNT(j)  (256  + 64 * (j))
#define XB_XSUB(j)  (1280 + 64 * (j))
#define XB_XGEN(j)  (2304 + 64 * (j))
#define XB_TOP      3328
#define XB_TOPGEN   3392
#define XCD_BAR_WORDS 3456
#define XB_SPIN_CAP (1u << 18)

__device__ __forceinline__ unsigned xb_ld(unsigned* p)              { return __hip_atomic_load(p, __ATOMIC_RELAXED, __HIP_MEMORY_SCOPE_AGENT); }
__device__ __forceinline__ unsigned xb_add(unsigned* p, unsigned v) { return __hip_atomic_fetch_add(p, v, __ATOMIC_RELAXED, __HIP_MEMORY_SCOPE_AGENT); }
__device__ __forceinline__ unsigned xb_xcc_id() { return (unsigned)__builtin_amdgcn_s_getreg((3 << 11) | 20) & 0xFu; }
#define XB_SPIN(cond, bar) do { unsigned _sp = 0; while (cond) { __builtin_amdgcn_s_sleep(1); \
    if ((++_sp & 255u) == 0u) { if (xb_ld(&(bar)[XB_TMO])) break; if (_sp > XB_SPIN_CAP) { atomicAdd(&(bar)[XB_TMO], 1u); break; } } } } while (0)

struct XcdBarrier {
    unsigned* bar; unsigned x;
    volatile LAS unsigned* st;
};

__device__ __forceinline__ XcdBarrier xcd_barrier_post(unsigned* bar, volatile LAS unsigned* st) {
    XcdBarrier b; b.bar = bar; b.x = xb_xcc_id(); b.st = st;
    if (threadIdx.x == 0) (void)xb_add(&bar[XB_XCNT(b.x)], 1u);
    return b;
}
__device__ __forceinline__ void xcd_barrier_complete(unsigned* bar, unsigned x, unsigned& nloc, unsigned& nx) {
    const unsigned G = gridDim.x * gridDim.y * gridDim.z;
    unsigned sum, cnt, mine, sp = 0u;
    for (;;) {
        sum = 0u; cnt = 0u; mine = 0u;
#pragma unroll
        for (unsigned j = 0; j < 16; ++j) { const unsigned c = xb_ld(&bar[XB_XCNT(j)]); sum += c; cnt += (c > 0u) ? 1u : 0u; mine = (j == x) ? c : mine; }
        if (sum == G) break;
        __builtin_amdgcn_s_sleep(1);
        if ((++sp & 255u) == 0u) { if (xb_ld(&bar[XB_TMO])) break; if (sp > XB_SPIN_CAP) { atomicAdd(&bar[XB_TMO], 1u); break; } }
    }
    nloc = mine > 0u ? mine : 1u; nx = cnt > 0u ? cnt : 1u;
}

__device__ __forceinline__ void xcd_barrier(const XcdBarrier& b) {
    asm volatile("s_waitcnt vmcnt(0)" ::: "memory");
    __syncthreads();
    if (threadIdx.x == 0) {
        unsigned* bar = b.bar;
        __builtin_amdgcn_s_waitcnt(0);
        unsigned nloc = b.st[0], nx = b.st[1];
        if (nloc == 0u) { xcd_barrier_complete(bar, b.x, nloc, nx); b.st[0] = nloc; b.st[1] = nx; }
        const unsigned old = xb_add(&bar[XB_XSUB(b.x)], 1u);
        const unsigned gen = old / nloc;
        if (old + 1u == (gen + 1u) * nloc) {
            __builtin_amdgcn_fence(__ATOMIC_RELEASE, "agent");
            asm volatile("s_waitcnt vmcnt(0)" ::: "memory");
            const unsigned og = xb_add(&bar[XB_TOP], 1u);
            const unsigned tg = og / nx;
            if (og + 1u == (tg + 1u) * nx) xb_add(&bar[XB_TOPGEN], 1u);
            else XB_SPIN(xb_ld(&bar[XB_TOPGEN]) == tg, bar);
            __builtin_amdgcn_fence(__ATOMIC_ACQUIRE, "agent");
            xb_add(&bar[XB_XGEN(b.x)], 1u);
            asm volatile("s_waitcnt vmcnt(0)" ::: "memory");
        } else {
            XB_SPIN(xb_ld(&bar[XB_XGEN(b.x)]) == gen, bar);
            __builtin_amdgcn_fence(__ATOMIC_ACQUIRE, "agent");
            asm volatile("s_waitcnt vmcnt(0)" ::: "memory");
        }
    }
    __syncthreads();
}
#endif

__global__ void __launch_bounds__(NT) fwd_kernel(Params p, int ph_lo, int ph_hi) {
    SMEM_DECL;
#ifndef EMU
    volatile LAS unsigned* misc = (volatile LAS unsigned*)(smem + 131072 + 64);
    if (threadIdx.x < 2) misc[threadIdx.x] = 0u;
    __syncthreads();
    const XcdBarrier bar = xcd_barrier_post((unsigned*)(p.ws + WS_BAR), misc);
#endif
    constexpr int NPH = 2 + 6 * DEPTH;
    for (int ph = ph_lo; ph < ph_hi && ph < NPH; ++ph) {
        if (ph == 0) phase0(p, smem);
        else if (ph == NPH - 1) phase_rp(p, DEPTH, smem);
        else { const int l = (ph - 1) / 6, k = (ph - 1) % 6;
            if (k == 0) phase_rp(p, l, smem);
            else if (k == 1) phase_gemm_in(p, l, smem);
            else if (k == 2) phase_mix1(p, l, smem);
            else if (k == 3) phase_scan(p);
            else if (k == 4) phase_mix2(p, l, smem);
            else phase_gemm_out(p, l, smem);
#ifdef PROBE_DUP
            if (k == PROBE_DUP) { GRID_SYNC();
                if (k == 1) phase_gemm_in(p, l, smem); else if (k == 2) phase_mix1(p, l, smem); else if (k == 4) phase_mix2(p, l, smem); else if (k == 5) phase_gemm_out(p, l, smem); }
#endif
        }
        if (ph + 1 < ph_hi) {
#ifdef EMU
            GRID_SYNC();
#else
            if (ph == 0) GRID_SYNC(); else xcd_barrier(bar);
#endif
        }
    }
}

#ifndef EMU
extern "C" void kernel_launch(void* const* d_in, const int* in_sizes, int n_in, void* d_out, int out_size, void* d_ws, size_t ws_size, hipStream_t stream) {
    static int grid = 0;
    if (grid == 0) {
        if (n_in != 26 || ws_size < WS_TOTAL) { fprintf(stderr, "kernel_launch: unexpected n_in %d or ws_size %zu (need %zu)\n", n_in, ws_size, (size_t)WS_TOTAL); grid = -1; return; }
        int dev = 0, cus = 0, per_cu = 0;
        hipGetDevice(&dev);
        hipDeviceGetAttribute(&cus, hipDeviceAttributeMultiprocessorCount, dev);
        hipFuncSetAttribute((const void*)fwd_kernel, hipFuncAttributeMaxDynamicSharedMemorySize, LDS_BYTES);
        hipOccupancyMaxActiveBlocksPerMultiprocessor(&per_cu, (const void*)fwd_kernel, NT, LDS_BYTES);
        if (per_cu < 1) { fprintf(stderr, "kernel_launch: occupancy query returned %d\n", per_cu); grid = -1; return; }
        if (per_cu > 1) per_cu = 1;
        grid = cus * per_cu;
    }
    if (grid < 0) return;
    hipMemsetAsync((char*)d_ws + WS_BAR, 0, BAR_BYTES, stream);
    Params p{};
    for (int i = 0; i < 26; ++i) p.in[i] = (const float*)d_in[i];
    p.out = (float*)d_out; p.ws = (char*)d_ws;
    int lo = 0, hi = 2 + 6 * DEPTH;
    void* args[] = {&p, &lo, &hi};
    hipError_t e = hipLaunchCooperativeKernel((const void*)fwd_kernel, dim3(grid), dim3(NT), args, LDS_BYTES, stream);
    if (e != hipSuccess) fprintf(stderr, "cooperative launch failed: %s (grid %d)\n", hipGetErrorString(e), grid);
}
#endif
```

```cpp
#ifdef EMU
#include "emu/hipemu.h"
#define GRID_SYNC() emu::grid_sync()
#define SMEM_DECL char* smem = emu::S().blocks[emu::cur()->block].lds
#define MFMA16(a, b, c) emu_mfma_16x16x32_bf16(a, b, c)
#else
#include <hip/hip_runtime.h>
#include <hip/hip_cooperative_groups.h>
#include <cstdio>
#include <cstdint>
#define GRID_SYNC() cooperative_groups::this_grid().sync()
#define SMEM_DECL extern __shared__ __attribute__((aligned(16))) char smem[]
#define MFMA16(a, b, c) __builtin_amdgcn_mfma_f32_16x16x32_bf16(a, b, c, 0, 0, 0)
#endif

#ifdef EMU
#ifndef EMU_DM
#define EMU_DM 256
#endif
#ifndef EMU_NB
#define EMU_NB 2
#endif
#ifndef EMU_SEQ
#define EMU_SEQ 512
#endif
#ifndef EMU_DEPTH
#define EMU_DEPTH 2
#endif
#ifndef EMU_CTXL
#define EMU_CTXL 128
#endif
constexpr int DM = EMU_DM, NB = EMU_NB, SEQ = EMU_SEQ, DEPTH = EMU_DEPTH, CTXL = EMU_CTXL;
#else
constexpr int DM = 1024, NB = 8, SEQ = 2048, DEPTH = 4, CTXL = 256;
#endif
constexpr int MIX = 1024, WG = 256, HD = 64, NH = 4, CH = 64;
constexpr int TOK = CTXL + SEQ, T = NB * TOK, NCH = TOK / CH, NCC = CTXL / CH;
constexpr int N_IN = 4144, NP = 3072, NG = 48, NMAIN = 3328, NPAD = 4352;
constexpr int NF = 2 * SEQ;
constexpr int NJ = NB + 1;
constexpr int NT = 512;
constexpr float EPS = 1e-6f;
constexpr int PA = 0, PG = 1280, PD = 2304;
constexpr int YA = 0, YH = 256, YG = 512, YD = 768;
constexpr int ilog4(int n) { return n <= 1 ? 0 : 1 + ilog4(n / 4); }
constexpr int FFT_P = ilog4(NF);
static_assert((1 << (2 * FFT_P)) == NF, "NF must be a power of 4");
static_assert(DM % 256 == 0 && CTXL % 128 == 0 && SEQ % 256 == 0, "shape constraints");

typedef unsigned short bf16;
typedef short bf16x8 __attribute__((ext_vector_type(8)));
typedef float f32x4 __attribute__((ext_vector_type(4)));
typedef unsigned u32x4 __attribute__((ext_vector_type(4)));
typedef unsigned u32x2 __attribute__((ext_vector_type(2)));
struct cpx { float x, y; };

constexpr size_t al256(size_t x) { return (x + 255) & ~(size_t)255; }
constexpr size_t WS_CTXB = 0;
constexpr size_t WS_HNY = al256(WS_CTXB + (size_t)NB * CTXL * DM * 4);
constexpr size_t WS_WIN = WS_HNY + (size_t)T * 1024 * 2;
constexpr size_t WS_WOUT = al256(WS_WIN + (size_t)NPAD * DM * 2);
constexpr size_t WS_P = al256(WS_WOUT + (size_t)DM * MIX * 2);
constexpr size_t WS_HT = al256(WS_P + (size_t)T * NP * 2);
constexpr size_t WS_G = al256(WS_HT + (size_t)1024 * T * 2);
constexpr size_t WS_KT = al256(WS_G + (size_t)T * NG * 4);
constexpr size_t WS_KF = al256(WS_KT + (size_t)WG * NF * 4);
constexpr size_t WS_HC = al256(WS_KF + (size_t)WG * NF * 8);
constexpr size_t WS_ST = al256(WS_HC + (size_t)2 * WG * CTXL * 4);
constexpr size_t WS_NV = al256(WS_ST + (size_t)2 * 2 * NB * NH * NCH * 4096 * 2);
constexpr size_t WS_BE = al256(WS_NV + (size_t)2 * NB * NH * NCH * 64 * 4);
constexpr size_t WS_SC = al256(WS_BE + (size_t)2 * NB * NH * NCH * 64 * 4);
constexpr size_t WS_MOD = al256(WS_SC + (size_t)2 * NB * NH * NCH * 4 * 4);
constexpr size_t WS_TW = al256(WS_MOD + (size_t)DEPTH * NJ * 3 * DM * 4);
constexpr size_t WS_ROPE = al256(WS_TW + (size_t)NF * 8);
constexpr size_t WS_BAR = al256(WS_ROPE + (size_t)SEQ * 32 * 8);
constexpr size_t BAR_BYTES = 16384;
constexpr size_t WS_TOTAL = al256(WS_BAR + BAR_BYTES);
static_assert((size_t)T * DM * 4 <= (size_t)T * NP * 2, "YO fits in P");
#ifndef EMU
static_assert(WS_TOTAL <= (size_t)268435456, "workspace map must fit 256 MiB");
#endif

constexpr int LDS_BYTES = 147456;

struct Params {
    const float* in[26];
    float* out;
    char* ws;
};
enum { I_X = 0, I_C, I_CTX, I_CCTX, I_WADA, I_BADA, I_GPRE, I_GPOST, I_WIN, I_MGB, I_MNG, I_HCW, I_HCB, I_HW1, I_HB1, I_HW2, I_HB2, I_HW3, I_HB3,
       I_HFREQ, I_HD, I_GWA, I_GBA, I_GNG, I_SINK, I_WOUT };


#ifdef EMU
__device__ __forceinline__ int otid() { return (int)threadIdx.x; }
__device__ __forceinline__ int obid() { return (int)blockIdx.x; }
#else
__device__ __forceinline__ int otid() { int t = (int)threadIdx.x; asm volatile("" : "+v"(t)); return t; }
__device__ __forceinline__ int obid() { int b = (int)blockIdx.x; asm volatile("" : "+s"(b)); return b; }
#endif
__device__ __forceinline__ unsigned fbits(float f) { return __builtin_bit_cast(unsigned, f); }
__device__ __forceinline__ float bitsf(unsigned u) { return __builtin_bit_cast(float, u); }
__device__ __forceinline__ bf16 f2bf(float f) { unsigned u = fbits(f); return (bf16)((u + 0x7fffu + ((u >> 16) & 1u)) >> 16); }
__device__ __forceinline__ float bf2f(bf16 h) { return bitsf((unsigned)h << 16); }
__device__ __forceinline__ unsigned pk2(float lo, float hi) { return (unsigned)f2bf(lo) | ((unsigned)f2bf(hi) << 16); }
__device__ __forceinline__ float sigmoidf_(float x) { return 1.0f / (1.0f + __expf(-x)); }
__device__ __forceinline__ float siluf_(float x) { return x / (1.0f + __expf(-x)); }
__device__ __forceinline__ float logsigf_(float x) { return fminf(x, 0.0f) - log1pf(__expf(-fabsf(x))); }
__device__ __forceinline__ float wave_sum(float v) {
#pragma unroll
    for (int o = 1; o < 64; o <<= 1) v += __shfl_xor(v, o);
    return v;
}
__device__ __forceinline__ float wave_max(float v) {
#pragma unroll
    for (int o = 1; o < 64; o <<= 1) v = fmaxf(v, __shfl_xor(v, o));
    return v;
}
__device__ __forceinline__ float wave_prefix_sum(float v, int lane) {
#pragma unroll
    for (int o = 1; o < 64; o <<= 1) { float t = __shfl_up(v, o); if (lane >= o) v += t; }
    return v;
}
__device__ __forceinline__ float wave_prefix_max(float v, int lane) {
#pragma unroll
    for (int o = 1; o < 64; o <<= 1) { float t = __shfl_up(v, o); if (lane >= o) v = fmaxf(v, t); }
    return v;
}
__device__ __forceinline__ float wave_suffix_max(float v, int lane) {
#pragma unroll
    for (int o = 1; o < 64; o <<= 1) { float t = __shfl_down(v, o); if (lane + o < 64) v = fmaxf(v, t); }
    return v;
}
__device__ __forceinline__ void unpack8(u32x4 v, float* f) {
    f[0] = bitsf(v.x << 16); f[1] = bitsf(v.x & 0xffff0000u); f[2] = bitsf(v.y << 16); f[3] = bitsf(v.y & 0xffff0000u);
    f[4] = bitsf(v.z << 16); f[5] = bitsf(v.z & 0xffff0000u); f[6] = bitsf(v.w << 16); f[7] = bitsf(v.w & 0xffff0000u);
}
__device__ __forceinline__ int orig_col(int n) {
    if (n < 1280) return n;
    if (n < 2304) return 2320 + (n - 1280);
    if (n < 3072) return 3376 + (n - 2304);
    if (n < 3088) return 1280 + (n - 3072);
    if (n < 3120) return 3344 + (n - 3088);
    if (n < NMAIN) return -1;
    return 1296 + (n - NMAIN);
}
__device__ __forceinline__ int chain_cid(int dir, int o) {
    if (dir == 0) return o;
    return o < NCC ? (NCC - 1 - o) : (NCH - 1 - (o - NCC));
}

constexpr int LS = 72;

template <int NTL, int KS>
__device__ __forceinline__ void mma_nt(const bf16* A, int lda, int m0, const bf16* B, int ldb, int n0, f32x4 (&acc)[NTL], int lane) {
    const int r = lane & 15, q = lane >> 4;
#pragma unroll
    for (int ks = 0; ks < KS; ++ks) {
        const bf16x8 a = *(const bf16x8*)(A + (m0 + r) * lda + ks * 32 + q * 8);
#pragma unroll
        for (int nt = 0; nt < NTL; ++nt) {
            const bf16x8 b = *(const bf16x8*)(B + (n0 + nt * 16 + r) * ldb + ks * 32 + q * 8);
            acc[nt] = MFMA16(a, b, acc[nt]);
        }
    }
}

__device__ void phase0(const Params& p, char* smem) {
    const int tid = otid();
    cpx* TW = (cpx*)(p.ws + WS_TW);
    cpx* ROPE = (cpx*)(p.ws + WS_ROPE);
    float* MOD = (float*)(p.ws + WS_MOD);
    constexpr int N_TW = NF / NT, N_ROPE = SEQ * 32 / NT, N_MOD = DEPTH * (3 * DM / 64);
    for (int task = obid(); task < N_TW + N_ROPE + N_MOD; task += gridDim.x) {
        if (task < N_TW) {
            const int j = task * NT + tid; float s, c; sincospif(2.0f * (float)j / (float)NF, &s, &c);
            cpx v; v.x = c; v.y = -s; TW[j] = v;
        } else if (task < N_TW + N_ROPE) {
            const int idx = (task - N_TW) * NT + tid; const int pos = idx >> 5, i = idx & 31;
            const float inv = exp2f(-(float)(i & 15) * (13.287712379549449f / 16.0f));
            const float ang = (float)(i < 16 ? pos / 64 : pos % 64) * inv;
            cpx v; v.x = cosf(ang); v.y = sinf(ang); ROPE[idx] = v;
        } else {
            const int mt = task - N_TW - N_ROPE; const int l = mt / (3 * DM / 64), n0 = (mt % (3 * DM / 64)) * 64;
            float* sv = (float*)smem;
            float* red = sv + NJ * DM;
            __syncthreads();
            for (int i = tid; i < NJ * DM; i += NT) { const int j = i / DM, k = i % DM; const float v = j < NB ? p.in[I_C][j * DM + k] : p.in[I_CCTX][k]; sv[i] = siluf_(v); }
            __syncthreads();
            const int nl = tid & 63, ks = tid >> 6; float acc[NJ];
#pragma unroll
            for (int j = 0; j < NJ; ++j) acc[j] = 0.f;
            const float* w = p.in[I_WADA] + (size_t)l * DM * 3 * DM + n0 + nl;
            for (int k = ks * (DM / 8); k < (ks + 1) * (DM / 8); ++k) { const float wv = w[(size_t)k * 3 * DM];
#pragma unroll
                for (int j = 0; j < NJ; ++j) acc[j] += sv[j * DM + k] * wv; }
#pragma unroll
            for (int j = 0; j < NJ; ++j) red[(ks * NJ + j) * 64 + nl] = acc[j];
            __syncthreads();
            for (int i = tid; i < NJ * 64; i += NT) { const int j = i / 64, n = i % 64; float s = 0.f;
#pragma unroll
                for (int k8 = 0; k8 < 8; ++k8) s += red[(k8 * NJ + j) * 64 + n];
                MOD[((size_t)l * NJ + j) * 3 * DM + n0 + n] = s + p.in[I_BADA][(size_t)l * 3 * DM + n0 + n]; }
        }
    }
}

__device__ void rp_rows(const Params& p, int l) {
    const int tid = otid(), lane = tid & 63, wave = tid >> 6;
    const float* MOD = (const float*)(p.ws + WS_MOD);
    float* CTXB = (float*)(p.ws + WS_CTXB);
    const float* YO = (const float*)(p.ws + WS_P);
    bf16* HN = (bf16*)(p.ws + WS_HNY);
    constexpr int NV4 = DM / 256;
    for (int row = obid() * 8 + wave; row < T; row += gridDim.x * 8) {
        const int b = row / TOK, pp = row % TOK; const bool isctx = pp < CTXL;
        if (l == DEPTH && isctx) continue;
        const size_t off = isctx ? ((size_t)b * CTXL + pp) * DM : ((size_t)b * SEQ + (pp - CTXL)) * DM;
        const float* xo = (l <= 1) ? (isctx ? p.in[I_CTX] + off : p.in[I_X] + off) : (isctx ? CTXB + off : p.out + off);
        float* xn = isctx ? CTXB + off : p.out + off;
        const int mj = isctx ? NB : b;
        f32x4 x[NV4];
#pragma unroll
        for (int j = 0; j < NV4; ++j) x[j] = *(const f32x4*)(xo + 4 * lane + 256 * j);
        if (l > 0) {
            f32x4 y[NV4]; float ss = 0.f;
#pragma unroll
            for (int j = 0; j < NV4; ++j) { y[j] = *(const f32x4*)(YO + (size_t)row * DM + 4 * lane + 256 * j); ss += y[j].x * y[j].x + y[j].y * y[j].y + y[j].z * y[j].z + y[j].w * y[j].w; }
            const float rstd = rsqrtf(wave_sum(ss) * (1.0f / DM) + EPS);
            const float* gt = MOD + ((size_t)(l - 1) * NJ + mj) * 3 * DM + 2 * DM;
            const float* gp = p.in[I_GPOST] + (size_t)(l - 1) * DM;
#pragma unroll
            for (int j = 0; j < NV4; ++j) { const f32x4 g4 = *(const f32x4*)(gt + 4 * lane + 256 * j), p4 = *(const f32x4*)(gp + 4 * lane + 256 * j);
                x[j] = x[j] + g4 * (y[j] * rstd * p4);
                *(f32x4*)(xn + 4 * lane + 256 * j) = x[j]; }
        }
        if (l < DEPTH) {
            float ss = 0.f;
#pragma unroll
            for (int j = 0; j < NV4; ++j) ss += x[j].x * x[j].x + x[j].y * x[j].y + x[j].z * x[j].z + x[j].w * x[j].w;
            const float rstd = rsqrtf(wave_sum(ss) * (1.0f / DM) + EPS);
            const float* md = MOD + ((size_t)l * NJ + mj) * 3 * DM;
            const float* gp = p.in[I_GPRE] + (size_t)l * DM;
#pragma unroll
            for (int j = 0; j < NV4; ++j) { const int e = 4 * lane + 256 * j;
                const f32x4 g4 = *(const f32x4*)(gp + e), sh = *(const f32x4*)(md + e), sc = *(const f32x4*)(md + DM + e);
                const f32x4 h = (x[j] * rstd * g4) * (sc + 1.0f) + sh;
                u32x2 o; o.x = pk2(h.x, h.y); o.y = pk2(h.z, h.w);
                *(u32x2*)(HN + (size_t)row * DM + e) = o; }
        }
    }
}

__device__ void convert_tile(const float* src, int ldn, bf16* dst, int K, int n0, int k0, bool use_map, char* smem) {
    const int tid = otid();
    float* tile = (float*)smem;
    __syncthreads();
#pragma unroll
    for (int i = 0; i < 8; ++i) { const int idx = tid + NT * i, k = idx >> 6, n = idx & 63;
        const int oc = use_map ? orig_col(n0 + n) : (n0 + n);
        tile[k * 65 + n] = oc >= 0 ? src[(size_t)(k0 + k) * ldn + oc] : 0.f; }
    __syncthreads();
    const int n = tid >> 3, c = tid & 7;
    u32x4 o; o.x = pk2(tile[(8 * c + 0) * 65 + n], tile[(8 * c + 1) * 65 + n]); o.y = pk2(tile[(8 * c + 2) * 65 + n], tile[(8 * c + 3) * 65 + n]);
    o.z = pk2(tile[(8 * c + 4) * 65 + n], tile[(8 * c + 5) * 65 + n]); o.w = pk2(tile[(8 * c + 6) * 65 + n], tile[(8 * c + 7) * 65 + n]);
    *(u32x4*)(dst + (size_t)(n0 + n) * K + k0 + 8 * c) = o;
}

__device__ void filter_task(const Params& p, int l, int L, int pos0, char* smem) {
    const int tid = otid();
    float* z = (float*)smem;
    float* h1 = z + 8 * 33;
    float* h2 = h1 + 8 * 64;
    __syncthreads();
    if (tid < 8 * 33) { const int pp = tid / 33, i = tid % 33; const float pos = (float)(pos0 + pp);
        const float t = pos / (float)(L - 1 > 1 ? L - 1 : 1), w = 6.283185307179586f * pos / (float)L; float v;
        if (i == 0) v = t; else { const int bi = (i - 1) & 15; const float f = 1e-4f + (float)bi * ((15.0f - 1e-4f) / 15.0f); v = (i <= 16) ? cosf(w * f) : -sinf(w * f); }
        z[tid] = v; }
    __syncthreads();
    { const int pp = tid >> 6, j = tid & 63; const float* w1 = p.in[I_HW1] + (size_t)l * 33 * 64; float a = p.in[I_HB1][l * 64 + j];
        for (int i = 0; i < 33; ++i) a += z[pp * 33 + i] * w1[i * 64 + j];
        h1[tid] = sinf(p.in[I_HFREQ][(l * 2 + 0) * 64 + j] * a); }
    __syncthreads();
    { const int pp = tid >> 6, j = tid & 63; const float* w2 = p.in[I_HW2] + (size_t)l * 64 * 64; float a = p.in[I_HB2][l * 64 + j];
        for (int i = 0; i < 64; ++i) a += h1[pp * 64 + i] * w2[i * 64 + j];
        h2[tid] = sinf(p.in[I_HFREQ][(l * 2 + 1) * 64 + j] * a); }
    __syncthreads();
    { const int o = tid, dir = o >> 8, c = o & 255; const float* w3 = p.in[I_HW3] + (size_t)l * 64 * 512; const float b3 = p.in[I_HB3][l * 512 + o];
        const float delta = 3.0701134573253946f + (float)c * ((15.350567286626973f - 3.0701134573253946f) / 255.0f);
        float acc[8];
#pragma unroll
        for (int pp = 0; pp < 8; ++pp) acc[pp] = b3;
        for (int j = 0; j < 64; ++j) { const float wv = w3[j * 512 + o];
#pragma unroll
            for (int pp = 0; pp < 8; ++pp) acc[pp] += h2[pp * 64 + j] * wv; }
        float* KT = (float*)(p.ws + WS_KT); float* HC = (float*)(p.ws + WS_HC);
#pragma unroll
        for (int pp = 0; pp < 8; ++pp) { const int pos = pos0 + pp; const float t = (float)pos / (float)(L - 1 > 1 ? L - 1 : 1);
            const float v = acc[pp] * __expf(-t * delta);
            if (L == SEQ) { if (dir == 0) KT[(size_t)c * NF + pos]= v; else if (pos > 0) KT[(size_t)c * NF + (NF - pos)] = v; else KT[(size_t)c * NF + SEQ] = 0.f; }
            else HC[((size_t)dir * WG + c) * CTXL + pos] = v; }
    }
}

__device__ void phase_rp(const Params& p, int l, char* smem) {
    rp_rows(p, l);
    if (l >= DEPTH) return;
    constexpr int N_WIN = (NPAD / 64) * (DM / 64), N_WOUT = (DM / 64) * (MIX / 64), N_FL = SEQ / 8, N_FC = CTXL / 8;
    for (int task = obid(); task < N_WIN + N_WOUT + N_FL + N_FC; task += gridDim.x) {
        if (task < N_WIN) { const int nt = task / (DM / 64), kt = task % (DM / 64);
            convert_tile(p.in[I_WIN] + (size_t)l * DM * N_IN, N_IN, (bf16*)(p.ws + WS_WIN), DM, nt * 64, kt * 64, true, smem); }
        else if (task < N_WIN + N_WOUT) { const int t2 = task - N_WIN, nt = t2 / (MIX / 64), kt = t2 % (MIX / 64);
            convert_tile(p.in[I_WOUT] + (size_t)l * MIX * DM, DM, (bf16*)(p.ws + WS_WOUT), MIX, nt * 64, kt * 64, false, smem); }
        else if (task < N_WIN + N_WOUT + N_FL) filter_task(p, l, SEQ, (task - N_WIN - N_WOUT) * 8, smem);
        else filter_task(p, l, CTXL, (task - N_WIN - N_WOUT - N_FL) * 8, smem);
    }
}

__device__ __forceinline__ cpx cmul(cpx a, cpx b) { cpx r; r.x = a.x * b.x - a.y * b.y; r.y = a.x * b.y + a.y * b.x; return r; }
__device__ __forceinline__ cpx cmulc(cpx a, cpx b) { cpx r; r.x = a.x * b.x + a.y * b.y; r.y = a.y * b.x - a.x * b.y; return r; }
__device__ void fft_fwd(cpx* buf, const cpx* TW, int tl) {
    for (int s = 0; s < FFT_P; ++s) {
        const int span = NF >> (2 * (s + 1)), tws = 1 << (2 * s);
        __syncthreads();
#pragma unroll 1
        for (int j = tl; j < NF / 4; j += 256) {
            const int grp = j / span, pos = j % span, base = grp * 4 * span + pos;
            const cpx x0 = buf[base], x1 = buf[base + span], x2 = buf[base + 2 * span], x3 = buf[base + 3 * span];
            const cpx a = {x0.x + x2.x, x0.y + x2.y}, b = {x0.x - x2.x, x0.y - x2.y}, c = {x1.x + x3.x, x1.y + x3.y}, d = {x1.x - x3.x, x1.y - x3.y};
            const cpx y0 = {a.x + c.x, a.y + c.y}, y2 = {a.x - c.x, a.y - c.y};
            const cpx y1 = {b.x + d.y, b.y - d.x};
            const cpx y3 = {b.x - d.y, b.y + d.x};
            buf[base] = y0;
            buf[base + span] = cmul(y1, TW[pos * tws]);
            buf[base + 2 * span] = cmul(y2, TW[2 * pos * tws]);
            buf[base + 3 * span] = cmul(y3, TW[3 * pos * tws]);
        }
    }
    __syncthreads();
}
__device__ void fft_inv(cpx* buf, const cpx* TW, int tl) {
    for (int s = FFT_P - 1; s >= 0; --s) {
        const int span = NF >> (2 * (s + 1)), tws = 1 << (2 * s);
        __syncthreads();
#pragma unroll 1
        for (int j = tl; j < NF / 4; j += 256) {
            const int grp = j / span, pos = j % span, base = grp * 4 * span + pos;
            const cpx b0 = buf[base];
            const cpx b1 = cmulc(buf[base + span], TW[pos * tws]);
            const cpx b2 = cmulc(buf[base + 2 * span], TW[2 * pos * tws]);
            const cpx b3 = cmulc(buf[base + 3 * span], TW[3 * pos * tws]);
            const cpx a = {b0.x + b2.x, b0.y + b2.y}, b = {b0.x - b2.x, b0.y - b2.y}, c = {b1.x + b3.x, b1.y + b3.y}, d = {b1.x - b3.x, b1.y - b3.y};
            const cpx x0 = {a.x + c.x, a.y + c.y}, x2 = {a.x - c.x, a.y - c.y};
            const cpx x1 = {b.x - d.y, b.y + d.x};
            const cpx x3 = {b.x + d.y, b.y - d.x};
            buf[base] = x0; buf[base + span] = x1; buf[base + 2 * span] = x2; buf[base + 3 * span] = x3;
        }
    }
    __syncthreads();
}
__device__ void filt_fft_task(const Params& p, int cp, char* smem) {
    const int tid = otid(), half = tid >> 8, tl = tid & 255, c = 2 * cp + half;
    cpx* buf = (cpx*)smem + (size_t)half * NF;
    const float* KT = (const float*)(p.ws + WS_KT) + (size_t)c * NF;
    cpx* KF = (cpx*)(p.ws + WS_KF) + (size_t)c * NF;
    const cpx* TW = (const cpx*)(p.ws + WS_TW);
    __syncthreads();
    for (int i = tl; i < NF; i += 256) { cpx v; v.x = KT[i]; v.y = 0.f; buf[i] = v; }
    fft_fwd(buf, TW, tl);
    for (int i = tl; i < NF; i += 256) KF[i] = buf[i];
}

__device__ void gemm_tile(const Params& p, const bf16* A, const bf16* Bt, int K, int mt, int nt, int mode, char* smem) {
    const int tid = otid(), lane = tid & 63, wave = tid >> 6;
    bf16* As = (bf16*)smem;
    bf16* Bs = As + 128 * LS;
    const int wm = (wave & 3) * 32, wn = (wave >> 2) * 64;
    f32x4 acc[2][4];
#pragma unroll
    for (int i = 0; i < 2; ++i)
#pragma unroll
        for (int j = 0; j < 4; ++j) acc[i][j] = (f32x4){0.f, 0.f, 0.f, 0.f};
    const int lr = tid >> 3, lc = tid & 7;
    const bf16* Ag = A + (size_t)(mt * 128 + lr) * K + lc * 8;
    const bf16* Bg = Bt + (size_t)(nt * 128 + lr) * K + lc * 8;
    u32x4 ra0, ra1, rb0, rb1;
    ra0 = *(const u32x4*)(Ag); ra1 = *(const u32x4*)(Ag + (size_t)64 * K); rb0 = *(const u32x4*)(Bg); rb1 = *(const u32x4*)(Bg + (size_t)64 * K);
    const int nk = K / 64;
    for (int kt = 0; kt < nk; ++kt) {
        __syncthreads();
        *(u32x4*)(As + lr * LS + lc * 8) = ra0; *(u32x4*)(As + (lr + 64) * LS + lc * 8) = ra1;
        *(u32x4*)(Bs + lr * LS + lc * 8) = rb0; *(u32x4*)(Bs + (lr + 64) * LS + lc * 8) = rb1;
        __syncthreads();
        if (kt + 1 < nk) { const int ko = (kt + 1) * 64;
            ra0 = *(const u32x4*)(Ag + ko); ra1 = *(const u32x4*)(Ag + (size_t)64 * K + ko); rb0 = *(const u32x4*)(Bg + ko); rb1 = *(const u32x4*)(Bg + (size_t)64 * K + ko); }
        mma_nt<4, 2>(As, LS, wm, Bs, LS, wn, acc[0], lane);
        mma_nt<4, 2>(As, LS, wm + 16, Bs, LS, wn, acc[1], lane);
    }
    const int r = lane & 15, q = lane >> 4;
#pragma unroll
    for (int i = 0; i < 2; ++i)
#pragma unroll
        for (int j = 0; j < 4; ++j)
#pragma unroll
            for (int e = 0; e < 4; ++e) {
                const int row = mt * 128 + wm + 16 * i + 4 * q + e, col = nt * 128 + wn + 16 * j + r; const float v = acc[i][j][e];
                if (mode == 0) { if (col < NP) ((bf16*)(p.ws + WS_P))[(size_t)row * NP + col] = f2bf(v); else if (col < NP + NG) ((float*)(p.ws + WS_G))[(size_t)row * NG + (col - NP)] = v; }
                else if (mode == 2) ((bf16*)(p.ws + WS_HT))[(size_t)row * T + col] = f2bf(v);
                else ((float*)(p.ws + WS_P))[(size_t)row * DM + col] = v;
            }
}

#ifndef EMU
namespace pg8 {
#define PG8_LAS __attribute__((address_space(3)))
typedef unsigned short bf16_t;
typedef short bf16x8 __attribute__((ext_vector_type(8)));
typedef float f32x4 __attribute__((ext_vector_type(4)));
typedef unsigned u32x4 __attribute__((ext_vector_type(4)));
constexpr int BM = 256, BK = 64, HALF = 128, HTB = HALF * BK * 2  , STAGE_BYTES = 8 * HTB, NXCD = 8, WGM = 8;

__host__ __device__ __forceinline__ int lds_byte(int r, int c) { const int st = (r >> 4) * 2 + (c >> 5), rr = r & 15, cc = c & 31, ob = rr * 64 + cc * 2; return st * 1024 + (ob ^ (((ob >> 9) & 1) << 5)); }
__host__ __device__ __forceinline__ void stage_rc(int b, int& R, int& C) { const int st = b / 1024, sb = b % 1024, swz = sb ^ (((sb >> 9) & 1) << 5); R = (st >> 1) * 16 + swz / 64; C = (st & 1) * 32 + (swz % 64) / 2; }
__host__ __device__ __forceinline__ int perm32(int rho) { const int n = rho >> 4, i = rho & 15; return 8 * (i >> 2) + 4 * n + (i & 3); }

struct Unit { int pm, pn; };
struct Gemm { const bf16_t* A; const bf16_t* Bt; int M, N, K; };
__device__ __forceinline__ unsigned cvt_pk_bf16(float lo, float hi) { unsigned r; asm volatile("v_cvt_pk_bf16_f32 %0, %1, %2" : "=v"(r) : "v"(lo), "v"(hi)); return r; }
template <class Epi, class Sched, bool ALIGN_EPI = false, bool SP2 = false>
__device__ __forceinline__ void gemm_phase(PG8_LAS unsigned char* lds, const Gemm g, const Sched& S, const Epi& E) {
    const int tid = otid(), wid = __builtin_amdgcn_readfirstlane(tid >> 6), lane = tid & 63, wr = wid >> 2, wc = wid & 3, fr = lane & 15, fq = lane >> 4;
    const int K = g.K, nt = K / BK;
    unsigned voffA[2], voffB[2];
#pragma unroll
    for (int i = 0; i < 2; ++i) { int R, C; stage_rc(tid * 16 + i * 8192, R, C); const int Rb = Epi::PERM ? ((R & ~31) + perm32(R & 31)) : R;
        voffA[i] = (unsigned)(R * K + C) * 2u; voffB[i] = (unsigned)(Rb * K + C) * 2u; }
    const size_t kstep = (size_t)(BK * 2);
    const size_t hstep = (size_t)HALF * K * 2;
    const size_t tstep = 2 * hstep;
    const unsigned ldsw = (unsigned)wid * 1024u;
    const int aoff = lds_byte(wr * 64 + fr, fq * 8), boff = lds_byte(wc * 32 + fr, fq * 8);
#define PG8_SA(b, h) (((b) * 2 + (h)) * HTB)
#define PG8_SB(b, h) ((4 + (b) * 2 + (h)) * HTB)
#define PG8_STAGE(bufoff, gbase, voff) do { _Pragma("unroll") for (int _i = 0; _i < 2; ++_i) \
        __builtin_amdgcn_global_load_lds((const unsigned*)((const char*)(gbase) + (voff)[_i]), (PG8_LAS unsigned*)(lds + (bufoff) + ldsw + _i * 8192), 16, 0, 0); } while (0)
#define PG8_LDA(dst, b, h) do { _Pragma("unroll") for (int m = 0; m < 4; ++m) _Pragma("unroll") for (int k = 0; k < 2; ++k) dst[m][k] = *(const PG8_LAS bf16x8*)(lds + PG8_SA(b, h) + aoff + m * 2048 + k * 1024); } while (0)
#define PG8_LDB(dst, b, h) do { _Pragma("unroll") for (int n = 0; n < 2; ++n) _Pragma("unroll") for (int k = 0; k < 2; ++k) dst[n][k] = *(const PG8_LAS bf16x8*)(lds + PG8_SB(b, h) + boff + n * 2048 + k * 1024); } while (0)
#define PG8_MMA(ai, bj, At, Bt) do { __builtin_amdgcn_s_setprio(1); _Pragma("unroll") for (int m = 0; m < 4; ++m) _Pragma("unroll") for (int n = 0; n < 2; ++n) _Pragma("unroll") for (int k = 0; k < 2; ++k) \
        acc[ai][bj][m][n] = __builtin_amdgcn_mfma_f32_16x16x32_bf16(Bt[n][k], At[m][k], acc[ai][bj][m][n], 0, 0, 0); __builtin_amdgcn_s_setprio(0); } while (0)
#define PG8_WAIT_V(n) asm volatile("s_waitcnt vmcnt(" #n ")" ::: "memory")
#define PG8_WAIT_L(n) asm volatile("s_waitcnt lgkmcnt(" #n ")" ::: "memory")
#define PG8_BAR __builtin_amdgcn_s_barrier()
#define PG8_SCHED __builtin_amdgcn_sched_barrier(0)
    Unit cur, nxt; int ui = 0;
    if (!S.next(0, cur)) return;
    f32x4 acc[2][2][4][2];
#pragma unroll
    for (int a = 0; a < 2; ++a)
#pragma unroll
        for (int b = 0; b < 2; ++b)
#pragma unroll
            for (int m = 0; m < 4; ++m)
#pragma unroll
                for (int n = 0; n < 2; ++n) acc[a][b][m][n] = (f32x4){0.f, 0.f, 0.f, 0.f};
    bf16x8 At[4][2], B0[2][2], B1[2][2];
    const char* cA = (const char*)g.A + (size_t)cur.pm * tstep; const char* cB = (const char*)g.Bt + (size_t)cur.pn * tstep;
    S.a_ready(cur);
    if constexpr (SP2) {
        PG8_STAGE(PG8_SB(0, 0), cB, voffB); PG8_STAGE(PG8_SB(0, 1), cB + hstep, voffB); PG8_STAGE(PG8_SA(0, 0), cA, voffA); PG8_STAGE(PG8_SA(0, 1), cA + hstep, voffA);
        if (wr == 1) PG8_BAR;
        PG8_WAIT_V(2); PG8_BAR;
        PG8_STAGE(PG8_SB(1, 0), cB + kstep, voffB); PG8_STAGE(PG8_SA(1, 0), cA + kstep, voffA); PG8_STAGE(PG8_SB(1, 1), cB + hstep + kstep, voffB);
        PG8_WAIT_V(6); PG8_BAR;
    } else {
        PG8_STAGE(PG8_SB(0, 0), cB, voffB); PG8_STAGE(PG8_SA(0, 0), cA, voffA); PG8_STAGE(PG8_SB(0, 1), cB + hstep, voffB); PG8_STAGE(PG8_SA(0, 1), cA + hstep, voffA);
        if (wr == 1) PG8_BAR;
        PG8_WAIT_V(4); PG8_BAR;
        PG8_STAGE(PG8_SB(1, 0), cB + kstep, voffB); PG8_STAGE(PG8_SA(1, 0), cA + kstep, voffA); PG8_STAGE(PG8_SB(1, 1), cB + hstep + kstep, voffB);
        PG8_WAIT_V(6); PG8_BAR;
    }
    for (;;) {
        const bool has_next = S.next(ui + 1, nxt);
        const char* nA = has_next ? (const char*)g.A + (size_t)nxt.pm * tstep : cA; const char* nB = has_next ? (const char*)g.Bt + (size_t)nxt.pn * tstep : cB;
        for (int t = 0; t < nt; t += 2) {
            const bool last = (t == nt - 2);
            const char* a1 = cA + (size_t)(t + 1) * kstep;
            const char* a2 = last ? nA : cA + (size_t)(t + 2) * kstep; const char* b2 = last ? nB : cB + (size_t)(t + 2) * kstep;
            const char* a3 = a2 + kstep; const char* b3 = b2 + kstep;
            if (last && has_next) S.a_ready(nxt);
            if constexpr (SP2) {
            PG8_LDB(B0, 0, 0); PG8_LDB(B1, 0, 1); PG8_SCHED; PG8_LDA(At, 0, 0); PG8_STAGE(PG8_SA(1, 1), a1 + hstep, voffA);
            PG8_WAIT_V(8); PG8_WAIT_L(0); PG8_BAR; PG8_MMA(0, 0, At, B0); PG8_MMA(0, 1, At, B1); PG8_BAR; PG8_SCHED;
            PG8_LDA(At, 0, 1); PG8_STAGE(PG8_SB(0, 0), b2, voffB); PG8_STAGE(PG8_SB(0, 1), b2 + hstep, voffB); PG8_STAGE(PG8_SA(0, 0), a2, voffA);
            PG8_WAIT_V(8); PG8_WAIT_L(0); PG8_BAR; PG8_MMA(1, 0, At, B0); PG8_MMA(1, 1, At, B1); PG8_BAR; PG8_SCHED;
            PG8_LDB(B0, 1, 0); PG8_LDB(B1, 1, 1); PG8_SCHED; PG8_LDA(At, 1, 0); PG8_STAGE(PG8_SA(0, 1), a2 + hstep, voffA);
            PG8_WAIT_V(8); PG8_WAIT_L(0); PG8_BAR; PG8_MMA(0, 0, At, B0); PG8_MMA(0, 1, At, B1); PG8_BAR; PG8_SCHED;
            PG8_LDA(At, 1, 1); PG8_STAGE(PG8_SB(1, 0), b3, voffB); PG8_STAGE(PG8_SB(1, 1), b3 + hstep, voffB); PG8_STAGE(PG8_SA(1, 0), a3, voffA);
            PG8_WAIT_V(8); PG8_WAIT_L(0); PG8_BAR; PG8_MMA(1, 0, At, B0); PG8_MMA(1, 1, At, B1); PG8_BAR; PG8_SCHED;
            } else {
            PG8_LDB(B0, 0, 0); PG8_SCHED; PG8_LDA(At, 0, 0); PG8_STAGE(PG8_SA(1, 1), a1 + hstep, voffA);
            PG8_WAIT_L(8); PG8_BAR; PG8_WAIT_L(0); PG8_MMA(0, 0, At, B0); PG8_BAR; PG8_SCHED;
            PG8_LDB(B1, 0, 1); PG8_STAGE(PG8_SB(0, 0), b2, voffB);
            PG8_BAR; PG8_WAIT_L(0); PG8_MMA(0, 1, At, B1); PG8_BAR;
            PG8_LDA(At, 0, 1); PG8_STAGE(PG8_SA(0, 0), a2, voffA);
            PG8_BAR; PG8_WAIT_L(0); PG8_MMA(1, 0, At, B0); PG8_BAR; PG8_SCHED;
            PG8_STAGE(PG8_SB(0, 1), b2 + hstep, voffB);
            PG8_WAIT_V(6); PG8_BAR; PG8_MMA(1, 1, At, B1); PG8_BAR;
            PG8_LDB(B0, 1, 0); PG8_SCHED; PG8_LDA(At, 1, 0); PG8_STAGE(PG8_SA(0, 1), a2 + hstep, voffA);
            PG8_WAIT_L(8); PG8_BAR; PG8_WAIT_L(0); PG8_MMA(0, 0, At, B0); PG8_BAR; PG8_SCHED;
            PG8_LDB(B1, 1, 1); PG8_STAGE(PG8_SB(1, 0), b3, voffB);
            PG8_BAR; PG8_WAIT_L(0); PG8_MMA(0, 1, At, B1); PG8_BAR;
            PG8_LDA(At, 1, 1); PG8_STAGE(PG8_SA(1, 0), a3, voffA);
            PG8_BAR; PG8_WAIT_L(0); PG8_MMA(1, 0, At, B0); PG8_BAR; PG8_SCHED;
            PG8_STAGE(PG8_SB(1, 1), b3 + hstep, voffB);
            PG8_WAIT_V(6); PG8_BAR; PG8_MMA(1, 1, At, B1); PG8_BAR;
            }
        }
        if constexpr (ALIGN_EPI) { if (wr == 0) PG8_BAR; }
        if constexpr (!Epi::AFTER_DRAIN) { E(acc, cur, wr, wc, fr, fq); S.done(cur); }
        if (!has_next) break;
#pragma unroll
        for (int a = 0; a < 2; ++a)
#pragma unroll
            for (int b = 0; b < 2; ++b)
#pragma unroll
                for (int m = 0; m < 4; ++m)
#pragma unroll
                    for (int n = 0; n < 2; ++n) acc[a][b][m][n] = (f32x4){0.f, 0.f, 0.f, 0.f};
        cur = nxt; cA = nA; cB = nB; ++ui;
        if constexpr (ALIGN_EPI) { if (wr == 1) PG8_BAR; }
    }
    PG8_WAIT_V(0);
    if constexpr (!ALIGN_EPI) { if (wr == 0) PG8_BAR; }
    PG8_BAR;
    if constexpr (Epi::AFTER_DRAIN) { E.fused(acc, cur, wr, wc, fr, fq, lds, wid, lane); S.done(cur); }
#undef PG8_SA
#undef PG8_SB
#undef PG8_STAGE
#undef PG8_LDA
#undef PG8_LDB
#undef PG8_MMA
#undef PG8_WAIT_V
#undef PG8_WAIT_L
#undef PG8_BAR
#undef PG8_SCHED
}
__device__ __forceinline__ void map_tile(int L, int nM, int nN, int& pm, int& pn) {
    const int nwg = nM * nN; int wgid = L; { const int q = nwg / NXCD, r = nwg % NXCD, xcd = wgid % NXCD, off = wgid / NXCD; wgid = (xcd < r ? xcd * (q + 1) : r * (q + 1) + (xcd - r) * q) + off; }
    const int nig = WGM * nN, gid = wgid / nig, fm = gid * WGM, gsz = (nM - fm) < WGM ? (nM - fm) : WGM;
    pm = fm + ((wgid % nig) % gsz); pn = (wgid % nig) / gsz;
}
constexpr int MP = T / 256, WP = NMAIN / 256, NU2 = 4 * MP, NU1 = MP * WP;
struct InOrder { int G, c;
    __device__ __forceinline__ bool next(int i, Unit& u) const { const int L = i * G + c; if (L >= NU2 + NU1) return false; int a, b;
        if (L < NU2) { map_tile(L, 4, MP, a, b); u.pm = MP + WP + a; u.pn = b; } else { map_tile(L - NU2, MP, WP, a, b); u.pm = a; u.pn = MP + b; } return true; }
    __device__ __forceinline__ void a_ready(const Unit&) const {}
    __device__ __forceinline__ void done(const Unit&) const {}
};
struct EpiIn { static constexpr bool PERM = true, AFTER_DRAIN = false; bf16_t* P; float* G; bf16_t* HTp;
    __device__ __forceinline__ void operator()(const f32x4 (&acc)[2][2][4][2], const Unit& u, int wr, int wc, int fr, int fq) const {
        if (u.pm < MP) { const int pn = u.pn - MP, row0 = u.pm * BM + wr * 64 + fr;
            if (pn < NP / 256) { const int col0 = pn * BM + wc * 32 + 8 * fq;
#pragma unroll
                for (int ai = 0; ai < 2; ++ai)
#pragma unroll
                    for (int m = 0; m < 4; ++m) { bf16_t* rowp = P + (size_t)(row0 + ai * HALF + m * 16) * NP + col0;
#pragma unroll
                        for (int bj = 0; bj < 2; ++bj) { const f32x4 v0 = acc[ai][bj][m][0], v1 = acc[ai][bj][m][1];
                            u32x4 w; w.x = cvt_pk_bf16(v0[0], v0[1]); w.y = cvt_pk_bf16(v0[2], v0[3]); w.z = cvt_pk_bf16(v1[0], v1[1]); w.w = cvt_pk_bf16(v1[2], v1[3]); *(u32x4*)(rowp + bj * HALF) = w; } } }
            else { const int cb = wc * 32 + 8 * fq;
                if (cb < NG) {
#pragma unroll
                    for (int ai = 0; ai < 2; ++ai)
#pragma unroll
                        for (int m = 0; m < 4; ++m) { float* rowp = G + (size_t)(row0 + ai * HALF + m * 16) * NG + cb; *(f32x4*)rowp = acc[ai][0][m][0]; *(f32x4*)(rowp + 4) = acc[ai][0][m][1]; } } } }
        else { const int row0 = (u.pm - MP - WP) * BM + wr * 64 + fr, col0 = u.pn * BM + wc * 32 + 8 * fq;
#pragma unroll
            for (int ai = 0; ai < 2; ++ai)
#pragma unroll
                for (int m = 0; m < 4; ++m) { bf16_t* rowp = HTp + (size_t)(row0 + ai * HALF + m * 16) * T + col0;
#pragma unroll
                    for (int bj = 0; bj < 2; ++bj) { const f32x4 v0 = acc[ai][bj][m][0], v1 = acc[ai][bj][m][1];
                        u32x4 w; w.x = cvt_pk_bf16(v0[0], v0[1]); w.y = cvt_pk_bf16(v0[2], v0[3]); w.z = cvt_pk_bf16(v1[0], v1[1]); w.w = cvt_pk_bf16(v1[2], v1[3]); *(u32x4*)(rowp + bj * HALF) = w; } } }
    }
};
struct OutOrder { int G, c; bool lat_only;
    __device__ __forceinline__ bool next(int i, Unit& u) const { const int nM = lat_only ? NB * (SEQ / 256) : MP, nN = DM / 256; const int L = i * G + c; if (L >= nM * nN) return false; int a, b; map_tile(L, nM, nN, a, b);
        u.pm = lat_only ? (a / (SEQ / 256)) * (TOK / 256) + CTXL / 256 + a % (SEQ / 256) : a; u.pn = b; return true; }
    __device__ __forceinline__ void a_ready(const Unit&) const {}
    __device__ __forceinline__ void done(const Unit&) const {}
};
struct EpiOut { static constexpr bool PERM = false, AFTER_DRAIN = false; float* C;
    __device__ __forceinline__ void operator()(const f32x4 (&acc)[2][2][4][2], const Unit& u, int wr, int wc, int fr, int fq) const {
        const int row0 = u.pm * BM + wr * 64 + fr, col0 = u.pn * BM + wc * 32 + 4 * fq;
#pragma unroll
        for (int ai = 0; ai < 2; ++ai)
#pragma unroll
            for (int m = 0; m < 4; ++m) { float* rowp = C + (size_t)(row0 + ai * HALF + m * 16) * DM + col0;
#pragma unroll
                for (int bj = 0; bj < 2; ++bj)
#pragma unroll
                    for (int n = 0; n < 2; ++n) *(f32x4*)(rowp + bj * HALF + n * 16) = acc[ai][bj][m][n]; }
    }
};
}
#endif

__device__ void phase_gemm_in(const Params& p, int l, char* smem) {
    constexpr int N_F = WG / 2;
#ifdef EMU
    constexpr int MT = T / 128, NT1 = NMAIN / 128, N1 = MT * NT1, N2 = 8 * MT;
    for (int task = obid(); task < N1 + N2; task += gridDim.x) {
        if (task < N1) gemm_tile(p, (const bf16*)(p.ws + WS_HNY), (const bf16*)(p.ws + WS_WIN), DM, task / NT1, task % NT1, 0, smem);
        else { const int t2 = task - N1; gemm_tile(p, (const bf16*)(p.ws + WS_WIN) + (size_t)NMAIN * DM, (const bf16*)(p.ws + WS_HNY), DM, t2 / MT, t2 % MT, 2, smem); }
    }
#else
    { const pg8::Gemm g{(const pg8::bf16_t*)(p.ws + WS_HNY), (const pg8::bf16_t*)(p.ws + WS_HNY), 0, 0, DM};
      const pg8::InOrder S{(int)gridDim.x, obid()};
      const pg8::EpiIn E{(pg8::bf16_t*)(p.ws + WS_P), (float*)(p.ws + WS_G), (pg8::bf16_t*)(p.ws + WS_HT)};
      pg8::gemm_phase<pg8::EpiIn, pg8::InOrder, true, true>((PG8_LAS unsigned char*)smem, g, S, E); }
#endif
    for (int task = (int)gridDim.x - 1 - obid(); task < N_F; task += gridDim.x) filt_fft_task(p, task, smem);
}
__device__ void phase_gemm_out(const Params& p, int l, char* smem) {
#ifdef EMU
    constexpr int MT = T / 128, NTO = DM / 128;
    for (int task = obid(); task < MT * NTO; task += gridDim.x) {
        const int mt = task / NTO, nt = task % NTO;
        if (l == DEPTH - 1 && (mt % (TOK / 128)) < CTXL / 128) continue;
        gemm_tile(p, (const bf16*)(p.ws + WS_HNY), (const bf16*)(p.ws + WS_WOUT), MIX, mt, nt, 1, smem);
    }
#else
    const pg8::Gemm g{(const pg8::bf16_t*)(p.ws + WS_HNY), (const pg8::bf16_t*)(p.ws + WS_WOUT), 0, 0, MIX};
    const pg8::OutOrder S{(int)gridDim.x, obid(), l == DEPTH - 1};
    const pg8::EpiOut E{(float*)(p.ws + WS_P)};
    pg8::gemm_phase<pg8::EpiOut, pg8::OutOrder, true, true>((PG8_LAS unsigned char*)smem, g, S, E);
#endif
}

__device__ __forceinline__ size_t st_index(int mixer, int dir, int b, int h, int cid) { return ((((size_t)(mixer * 2 + dir) * NB + b) * NH + h) * NCH + cid); }
__device__ __forceinline__ size_t ch_index(int dir, int b, int h, int cid) { return (((size_t)dir * NB + b) * NH + h) * NCH + cid; }

__device__ __forceinline__ void load_tile_nat(const bf16* P, int r0, int c0, bf16* dst, float scale, int tid) {
    const int s = tid >> 3, c8 = tid & 7;
    const u32x4 v = *(const u32x4*)(P + (size_t)(r0 + s) * NP + c0 + c8 * 8);
    if (scale == 1.0f) *(u32x4*)(dst + s * LS + c8 * 8) = v;
    else { float f[8]; unpack8(v, f); u32x4 o; o.x = pk2(f[0] * scale, f[1] * scale); o.y = pk2(f[2] * scale, f[3] * scale); o.z = pk2(f[4] * scale, f[5] * scale); o.w = pk2(f[6] * scale, f[7] * scale);
        *(u32x4*)(dst + s * LS + c8 * 8) = o; }
}
__device__ __forceinline__ void load_tile_tr(const bf16* P, int r0, int c0, bf16* dst, int tid) {
    const int s = tid >> 3, c8 = tid & 7;
    const u32x4 v = *(const u32x4*)(P + (size_t)(r0 + s) * NP + c0 + c8 * 8);
    const unsigned w[4] = {v.x, v.y, v.z, v.w};
#pragma unroll
    for (int j = 0; j < 4; ++j) { dst[(c8 * 8 + 2 * j) * LS + s] = (bf16)(w[j] & 0xffffu); dst[(c8 * 8 + 2 * j + 1) * LS + s] = (bf16)(w[j] >> 16); }
}

__device__ void chunkst_task(const Params& p, int l, int mixer, int b, int h, int cid, char* smem) {
    const int tid = otid(), lane = tid & 63, wave = tid >> 6, s_ = tid >> 3, c8 = tid & 7, d = tid & 63, sg = tid >> 6;
    const bf16* P = (const bf16*)(p.ws + WS_P); const float* G = (const float*)(p.ws + WS_G);
    bf16* ST = (bf16*)(p.ws + WS_ST);
    const int r0 = b * TOK + cid * 64;
    bf16* Vt = (bf16*)smem;
    bf16* KtF = Vt + 64 * LS;
    bf16* KtB = KtF + 64 * LS;
    bf16* Kraw = KtB + 64 * LS;
    float* wv = (float*)(Kraw + 64 * LS);
    float* rs = wv + 128;
    float* tot = rs + 64 * 32;
    float* npart = tot + 2 * 8 * 64;
    const int kcol = (mixer == 0 ? PA : PG) + 256 + h * 64, vcol = (mixer == 0 ? PA : PG) + 512 + h * 64;
    const u32x4 kq = *(const u32x4*)(P + (size_t)(r0 + s_) * NP + kcol + c8 * 8);
    const u32x4 vq = *(const u32x4*)(P + (size_t)(r0 + s_) * NP + vcol + c8 * 8);
    f32x4 rq = {0.f, 0.f, 0.f, 0.f}; float wF[16], wB[16], baF = 0.f, baB = 0.f; float gi_f = 0.f, gf_f = 0.f, gi_b = 0.f, gf_b = 0.f;
    if (mixer == 1) {
        rq = *(const f32x4*)(G + (size_t)(r0 + s_) * NG + 16 + c8 * 4);
        const float* wa = p.in[I_GWA] + ((size_t)(l * 2) * 16) * WG + h * 64 + d;
#pragma unroll
        for (int j = 0; j < 16; ++j) { wF[j] = wa[(size_t)j * WG]; wB[j] = wa[(size_t)(16 + j) * WG]; }
        baF = p.in[I_GBA][(size_t)(l * 2) * WG + h * 64 + d]; baB = p.in[I_GBA][(size_t)(l * 2 + 1) * WG + h * 64 + d];
    } else if (wave == 0) {
        const float* g = G + (size_t)(r0 + lane) * NG; const float* gb = p.in[I_MGB] + (size_t)l * 16;
        gi_f = g[h] + gb[h]; gf_f = g[4 + h] + gb[4 + h]; gi_b = g[8 + h] + gb[8 + h]; gf_b = g[12 + h] + gb[12 + h];
    }
    __syncthreads();
    *(u32x4*)(Kraw + s_ * LS + c8 * 8) = kq;
    { const unsigned w[4] = {vq.x, vq.y, vq.z, vq.w};
#pragma unroll
        for (int j = 0; j < 4; ++j) { Vt[(c8 * 8 + 2 * j) * LS + s_] = (bf16)(w[j] & 0xffffu); Vt[(c8 * 8 + 2 * j + 1) * LS + s_] = (bf16)(w[j] >> 16); } }
    if (mixer == 1) *(f32x4*)(rs + s_ * 32 + c8 * 4) = rq;
    else if (wave == 0) {
        const float lf = logsigf_(gf_f), lb = logsigf_(gf_b);
        const float bF = wave_prefix_sum(lf, lane), totF = __shfl(bF, 63);
        const float gF = totF - bF + gi_f, mF = wave_max(gF);
        const float totB = wave_sum(lb), preB = wave_prefix_sum(lb, lane), bB = totB - preB + lb;
        const float gB = totB - bB + gi_b, mB = wave_max(gB);
        wv[lane] = __expf(gF - mF); wv[64 + lane] = __expf(gB - mB);
        if (lane == 0) { float* SC = (float*)(p.ws + WS_SC);
            SC[ch_index(0, b, h, cid) * 4 + 0] = totF; SC[ch_index(0, b, h, cid) * 4 + 1] = mF;
            SC[ch_index(1, b, h, cid) * 4 + 0] = totB; SC[ch_index(1, b, h, cid) * 4 + 1] = mB; }
    }
    __syncthreads();
    float bF[8], bB[8], bendF = 0.f, bendB = 0.f;
    if (mixer == 1) {
#pragma unroll
        for (int i = 0; i < 8; ++i) { const float* rr = rs + (sg * 8 + i) * 32; float aF = baF, aB = baB;
#pragma unroll
            for (int j = 0; j < 16; ++j) { aF += rr[j] * wF[j]; aB += rr[16 + j] * wB[j]; }
            bF[i] = logsigf_(aF) * (1.0f / 16.0f); bB[i] = logsigf_(aB) * (1.0f / 16.0f); }
#pragma unroll
        for (int i = 1; i < 8; ++i) bF[i] += bF[i - 1];
#pragma unroll
        for (int i = 6; i >= 0; --i) bB[i] += bB[i + 1];
        tot[(0 * 8 + sg) * 64 + d] = bF[7]; tot[(1 * 8 + sg) * 64 + d] = bB[0];
        __syncthreads();
        float offF = 0.f, offB = 0.f;
#pragma unroll
        for (int g8 = 0; g8 < 8; ++g8) { const float tf = tot[(0 * 8 + g8) * 64 + d], tb = tot[(1 * 8 + g8) * 64 + d]; bendF += tf; bendB += tb; if (g8 < sg) offF += tf; if (g8 > sg) offB += tb; }
#pragma unroll
        for (int i = 0; i < 8; ++i) { bF[i] += offF; bB[i] += offB; }
        if (sg == 0) { float* BE = (float*)(p.ws + WS_BE); BE[ch_index(0, b, h, cid) * 64 + d] = bendF; BE[ch_index(1, b, h, cid) * 64 + d] = bendB; }
    }
    { float kf[8], kb[8], nF = 0.f, nB = 0.f;
#pragma unroll
        for (int i = 0; i < 8; ++i) { const int s = sg * 8 + i; const float kv = bf2f(Kraw[s * LS + d]);
            if (mixer == 0) { kf[i] = kv * 0.125f * wv[s]; kb[i] = kv * 0.125f * wv[64 + s]; } else { kf[i] = kv * __expf(bendF - bF[i]); kb[i] = kv * __expf(bendB - bB[i]); }
            nF += kf[i]; nB += kb[i]; }
        u32x4 o; o.x = pk2(kf[0], kf[1]); o.y = pk2(kf[2], kf[3]); o.z = pk2(kf[4], kf[5]); o.w = pk2(kf[6], kf[7]); *(u32x4*)(KtF + d * LS + sg * 8) = o;
        o.x = pk2(kb[0], kb[1]); o.y = pk2(kb[2], kb[3]); o.z = pk2(kb[4], kb[5]); o.w = pk2(kb[6], kb[7]); *(u32x4*)(KtB + d * LS + sg * 8) = o;
        if (mixer == 0) { npart[(0 * 8 + sg) * 64 + d] = nF; npart[(1 * 8 + sg) * 64 + d] = nB; } }
    __syncthreads();
    { const int r = lane & 15, q = lane >> 4, d0 = (wave & 3) * 16, e0 = (wave >> 2) * 32;
#pragma unroll
        for (int dir = 0; dir < 2; ++dir) {
            f32x4 acc[2] = {(f32x4){0.f, 0.f, 0.f, 0.f}, (f32x4){0.f, 0.f, 0.f, 0.f}};
            mma_nt<2, 2>(dir == 0 ? KtF : KtB, LS, d0, Vt, LS, e0, acc, lane);
            bf16* dst = ST + st_index(mixer, dir, b, h, cid) * 4096;
#pragma unroll
            for (int nt = 0; nt < 2; ++nt) { u32x2 o; o.x = pk2(acc[nt][0], acc[nt][1]); o.y = pk2(acc[nt][2], acc[nt][3]); *(u32x2*)(dst + (e0 + 16 * nt + r) * 64 + d0 + 4 * q) = o; }
        }
        if (mixer == 0 && tid < 128) { const int dir = tid >> 6; float s = 0.f;
#pragma unroll
            for (int g8 = 0; g8 < 8; ++g8) s += npart[(dir * 8 + g8) * 64 + d];
            ((float*)(p.ws + WS_NV))[ch_index(dir, b, h, cid) * 64 + d] = s; } }
}

template <int NTK>
__device__ __forceinline__ void load_span(const bf16* row, int t0, float (&v)[NTK + 2]) {
    v[0] = t0 > 0 ? bf2f(row[-1]) : 0.f; v[NTK + 1] = (t0 + NTK < SEQ) ? bf2f(row[NTK]) : 0.f;
    if constexpr (NTK == 8) { float f[8]; unpack8(*(const u32x4*)row, f);
#pragma unroll
        for (int i = 0; i < 8; ++i) v[1 + i] = f[i]; }
    else {
#pragma unroll
        for (int i = 0; i < NTK; ++i) v[1 + i] = bf2f(row[i]); }
}
__device__ void hylat_task(const Params& p, int l, int bp, int cp, char* smem) {
    const int tid = otid(), half = tid >> 8, tl = tid & 255, c = 2 * cp + half;
    const bf16* HT = (const bf16*)(p.ws + WS_HT); bf16* Y = (bf16*)(p.ws + WS_HNY);
    cpx* buf = (cpx*)smem + (size_t)half * NF;
    const cpx* TW = (const cpx*)(p.ws + WS_TW);
    const cpx* KF = (const cpx*)(p.ws + WS_KF) + (size_t)c * NF;
    constexpr int NTK = SEQ / 256;
    const int t0 = NTK * tl;
    const float* cw = p.in[I_HCW] + (size_t)l * 3 * 768; const float* cb = p.in[I_HCB] + (size_t)l * 768;
    const size_t rb0 = (size_t)(2 * bp) * TOK + CTXL, rb1 = rb0 + TOK;
    const bf16* h0 = HT + (size_t)c * T + rb0 + t0; const bf16* h1 = h0 + TOK;
    float u0[NTK], u1[NTK], g0[NTK], g1[NTK];
    { float xa[NTK + 2], xb[NTK + 2]; load_span<NTK>(h0 + (size_t)512 * T, t0, xa); load_span<NTK>(h1 + (size_t)512 * T, t0, xb);
        const float w0 = cw[0 * 768 + 512 + c], w1 = cw[1 * 768 + 512 + c], w2 = cw[2 * 768 + 512 + c], bb = cb[512 + c];
        float ga[NTK + 2], gb[NTK + 2]; load_span<NTK>(h0 + (size_t)768 * T, t0, ga); load_span<NTK>(h1 + (size_t)768 * T, t0, gb);
#pragma unroll
        for (int i = 0; i < NTK; ++i) { g0[i] = (w0 * xa[i] + w1 * xa[i + 1] + w2 * xa[i + 2] + bb) * siluf_(ga[i + 1]); g1[i] = (w0 * xb[i] + w1 * xb[i + 1] + w2 * xb[i + 2] + bb) * siluf_(gb[i + 1]); } }
    { float va[NTK + 2], vb[NTK + 2], ya[NTK + 2], yb[NTK + 2];
        load_span<NTK>(h0, t0, va); load_span<NTK>(h1, t0, vb); load_span<NTK>(h0 + (size_t)256 * T, t0, ya); load_span<NTK>(h1 + (size_t)256 * T, t0, yb);
        const float v0 = cw[0 * 768 + c], v1 = cw[1 * 768 + c], v2 = cw[2 * 768 + c], vbias = cb[c];
        const float y0 = cw[0 * 768 + 256 + c], y1 = cw[1 * 768 + 256 + c], y2 = cw[2 * 768 + 256 + c], ybias = cb[256 + c];
#pragma unroll
        for (int i = 0; i < NTK; ++i) { u0[i] = (v0 * va[i] + v1 * va[i + 1] + v2 * va[i + 2] + vbias) * (y0 * ya[i] + y1 * ya[i + 1] + y2 * ya[i + 2] + ybias);
            u1[i] = (v0 * vb[i] + v1 * vb[i + 1] + v2 * vb[i + 2] + vbias) * (y0 * yb[i] + y1 * yb[i + 1] + y2 * yb[i + 2] + ybias); } }
    __syncthreads();
#pragma unroll
    for (int i = 0; i < NTK; ++i) { cpx v; v.x = u0[i]; v.y = u1[i]; buf[t0 + i] = v; cpx z = {0.f, 0.f}; buf[SEQ + t0 + i] = z; }
    fft_fwd(buf, TW, tl);
#pragma unroll 2
    for (int i = tl; i < NF; i += 256) buf[i] = cmul(buf[i], KF[i]);
    fft_inv(buf, TW, tl);
    const float dsk = p.in[I_HD][(size_t)l * WG + c]; const float sc = 1.0f / (float)NF;
    bf16* yb0 = Y + (rb0 + t0) * 1024 + YH + c; bf16* yb1 = Y + (rb1 + t0) * 1024 + YH + c;
#pragma unroll
    for (int i = 0; i < NTK; ++i) { const cpx y = buf[t0 + i];
        yb0[i * 1024] = f2bf(g0[i] * (y.x * sc + u0[i] * dsk));
        yb1[i * 1024] = f2bf(g1[i] * (y.y * sc + u1[i] * dsk)); }
}

constexpr int HCB = 8;
__device__ void hyctx_task(const Params& p, int l, int b, int cblk, char* smem) {
    const int tid = otid(); const int c0 = cblk * HCB;
    const bf16* HT = (const bf16*)(p.ws + WS_HT); bf16* Y = (bf16*)(p.ws + WS_HNY); const float* HC = (const float*)(p.ws + WS_HC);
    float* raw = (float*)smem;
    float* u = raw + 3 * CTXL * HCB;
    float* hf = u + CTXL * HCB;
    float* hb = hf + CTXL * HCB;
    float* og = hb + CTXL * HCB;
    const size_t rb = (size_t)b * TOK;
    const float* cw = p.in[I_HCW] + (size_t)l * 3 * 768; const float* cbias = p.in[I_HCB] + (size_t)l * 768;
    __syncthreads();
    for (int i = tid; i < 3 * CTXL * HCB; i += NT) { const int k = i / (CTXL * HCB), cc = (i / CTXL) % HCB, t = i % CTXL; raw[(k * CTXL + t) * HCB + cc] = bf2f(HT[(size_t)(k * 256 + c0 + cc) * T + rb + t]); }
    for (int i = tid; i < CTXL * HCB; i += NT) { const int t = i / HCB, cc = i % HCB; hf[i] = HC[((size_t)0 * WG + c0 + cc) * CTXL + t]; hb[i] = HC[((size_t)1 * WG + c0 + cc) * CTXL + t]; }
    __syncthreads();
    for (int i = tid; i < CTXL * HCB; i += NT) { const int t = i / HCB, cc = i % HCB; float cv[3];
#pragma unroll
        for (int k = 0; k < 3; ++k) { const float* rk = raw + k * CTXL * HCB; const int ch = k * 256 + c0 + cc;
            const float a = t > 0 ? rk[(t - 1) * HCB + cc] : 0.f, m = rk[t * HCB + cc], z = t < CTXL - 1 ? rk[(t + 1) * HCB + cc] : 0.f;
            cv[k] = cw[0 * 768 + ch] * a + cw[1 * 768 + ch] * m + cw[2 * 768 + ch] * z + cbias[ch]; }
        u[i] = cv[0] * cv[1];
        og[i] = cv[2] * siluf_(bf2f(HT[(size_t)(768 + c0 + cc) * T + rb + t])); }
    __syncthreads();
    { const int cc = tid % HCB, tg = tid / HCB; constexpr int TG = NT / HCB, NTK = CTXL / TG; float acc[NTK];
#pragma unroll
        for (int i = 0; i < NTK; ++i) acc[i] = 0.f;
        for (int s = 0; s < CTXL; ++s) { const float us = u[s * HCB + cc];
#pragma unroll
            for (int i = 0; i < NTK; ++i) { const int t = tg + TG * i; const float hv = (s <= t) ? hf[(t - s) * HCB + cc] : hb[(s - t) * HCB + cc]; acc[i] += us * hv; } }
        const float dsk = p.in[I_HD][(size_t)l * WG + c0 + cc];
#pragma unroll
        for (int i = 0; i < NTK; ++i) { const int t = tg + TG * i; Y[(rb + t) * 1024 + YH + c0 + cc] = f2bf(og[t * HCB + cc] * (acc[i] + u[t * HCB + cc] * dsk)); } }
}

__device__ void attn_task(const Params& p, int l, int b, int kvh, int qt, bool ctxq, char* smem) {
    const int tid = otid(), lane = tid & 63, wave = tid >> 6, r = lane & 15, q = lane >> 4;
    const bf16* P = (const bf16*)(p.ws + WS_P); bf16* Y = (bf16*)(p.ws + WS_HNY); const cpx* ROPE = (const cpx*)(p.ws + WS_ROPE);
    bf16* Qs = (bf16*)smem;
    bf16* Ks = Qs + 128 * LS;
    bf16* Vt = Ks + 64 * LS;
    bf16* Ps = Vt + 64 * LS;
    const size_t rq0 = (size_t)b * TOK + (ctxq ? 0 : CTXL) + qt * 64;
    __syncthreads();
    {
        const int row = tid >> 2, cpair = tid & 3, g = row >> 6, t = row & 63;
        const bf16* src = P + (rq0 + t) * NP + PD + (kvh * 2 + g) * 64;
        float lo[8], hi[8]; unpack8(*(const u32x4*)(src + cpair * 8), lo); unpack8(*(const u32x4*)(src + 32 + cpair * 8), hi);
        u32x4 o1, o2; float a[8], c2[8];
#pragma unroll
        for (int j = 0; j < 8; ++j) { float cs = 1.f, sn = 0.f; if (!ctxq) { const cpx cv = ROPE[(size_t)(qt * 64 + t) * 32 + cpair * 8 + j]; cs = cv.x; sn = cv.y; }
            a[j] = (lo[j] * cs - hi[j] * sn) * 0.125f; c2[j] = (hi[j] * cs + lo[j] * sn) * 0.125f; }
        o1.x = pk2(a[0], a[1]); o1.y = pk2(a[2], a[3]); o1.z = pk2(a[4], a[5]); o1.w = pk2(a[6], a[7]);
        o2.x = pk2(c2[0], c2[1]); o2.y = pk2(c2[2], c2[3]); o2.z = pk2(c2[4], c2[5]); o2.w = pk2(c2[6], c2[7]);
        *(u32x4*)(Qs + row * LS + cpair * 8) = o1; *(u32x4*)(Qs + row * LS + 32 + cpair * 8) = o2;
    }
    const int lt0 = ctxq ? 0 : (qt - 2 > 0 ? qt - 2 : 0), lt1 = ctxq ? -1 : (qt + 2 < SEQ / 64 - 1 ? qt + 2 : SEQ / 64 - 1);
    const int nloc = lt1 - lt0 + 1, ntiles = nloc + NCC;
    float m[4], lsum[4]; f32x4 O[4];
#pragma unroll
    for (int i = 0; i < 4; ++i) { m[i] = -INFINITY; lsum[i] = 0.f; O[i] = (f32x4){0.f, 0.f, 0.f, 0.f}; }
    const int g = wave >> 2, tq0 = (wave & 3) * 16;
    bf16* Pw = Ps + wave * 16 * LS;
    for (int ti = 0; ti < ntiles; ++ti) {
        const bool local = ti < nloc; const int kt = local ? lt0 + ti : ti - nloc;
        const size_t rk0 = (size_t)b * TOK + (local ? CTXL : 0) + kt * 64;
        __syncthreads();
        if (tid < 256) { const int s = tid >> 2, cpair = tid & 3; const bf16* src = P + (rk0 + s) * NP + PD + 256 + kvh * 64;
            float lo[8], hi[8]; unpack8(*(const u32x4*)(src + cpair * 8), lo); unpack8(*(const u32x4*)(src + 32 + cpair * 8), hi);
            float a[8], c2[8];
#pragma unroll
            for (int j = 0; j < 8; ++j) { float cs = 1.f, sn = 0.f; if (local) { const cpx cv = ROPE[(size_t)(kt * 64 + s) * 32 + cpair * 8 + j]; cs = cv.x; sn = cv.y; }
                a[j] = lo[j] * cs - hi[j] * sn; c2[j] = hi[j] * cs + lo[j] * sn; }
            u32x4 o1, o2;
            o1.x = pk2(a[0], a[1]); o1.y = pk2(a[2], a[3]); o1.z = pk2(a[4], a[5]); o1.w = pk2(a[6], a[7]);
            o2.x = pk2(c2[0], c2[1]); o2.y = pk2(c2[2], c2[3]); o2.z = pk2(c2[4], c2[5]); o2.w = pk2(c2[6], c2[7]);
            *(u32x4*)(Ks + s * LS + cpair * 8) = o1; *(u32x4*)(Ks + s * LS + 32 + cpair * 8) = o2; }
        load_tile_tr(P, (int)rk0, PD + 384 + kvh * 64, Vt, tid);
        __syncthreads();
        f32x4 S[4] = {(f32x4){0.f, 0.f, 0.f, 0.f}, (f32x4){0.f, 0.f, 0.f, 0.f}, (f32x4){0.f, 0.f, 0.f, 0.f}, (f32x4){0.f, 0.f, 0.f, 0.f}};
        mma_nt<4, 2>(Qs, LS, g * 64 + tq0, Ks, LS, 0, S, lane);
        float rmax[4], rsum[4];
#pragma unroll
        for (int i = 0; i < 4; ++i) { const int qpos = qt * 64 + tq0 + 4 * q + i; float mx = -INFINITY;
#pragma unroll
            for (int nt = 0; nt < 4; ++nt) { if (local) { const int kpos = kt * 64 + nt * 16 + r; const int d = kpos - qpos; if (d > 128 || d < -128) S[nt][i] = -INFINITY; } mx = fmaxf(mx, S[nt][i]); }
            mx = fmaxf(mx, __shfl_xor(mx, 1)); mx = fmaxf(mx, __shfl_xor(mx, 2)); mx = fmaxf(mx, __shfl_xor(mx, 4)); mx = fmaxf(mx, __shfl_xor(mx, 8));
            rmax[i] = mx; }
#pragma unroll
        for (int i = 0; i < 4; ++i) { const float mn = fmaxf(m[i], rmax[i]); const float alpha = __expf(m[i] - mn); float sm = 0.f;
#pragma unroll
            for (int nt = 0; nt < 4; ++nt) { const float pv = __expf(S[nt][i] - mn); sm += pv; Pw[(4 * q + i) * LS + nt * 16 + r] = f2bf(pv); O[nt][i] *= alpha; }
            sm += __shfl_xor(sm, 1); sm += __shfl_xor(sm, 2); sm += __shfl_xor(sm, 4); sm += __shfl_xor(sm, 8);
            lsum[i] = lsum[i] * alpha + sm; m[i] = mn; rsum[i] = sm; }
        __syncthreads();
        mma_nt<4, 2>(Pw, LS, 0, Vt, LS, 0, O, lane);
    }
    const float sink = p.in[I_SINK][(size_t)l * NH + kvh * 2 + g];
#pragma unroll
    for (int i = 0; i < 4; ++i) { const float den = lsum[i] + __expf(sink - m[i]); const float inv = 1.0f / den; const int t = tq0 + 4 * q + i;
#pragma unroll
        for (int nt = 0; nt < 4; ++nt) { const int e = nt * 16 + r; const float gate = bf2f(P[(rq0 + t) * NP + PD + 512 + (kvh * 2 + g) * 64 + e]);
            Y[(rq0 + t) * 1024 + YD + (kvh * 2 + g) * 64 + e] = f2bf(O[nt][i] * inv * siluf_(gate)); } }
}

__device__ void phase_mix1(const Params& p, int l, char* smem) {
    const bool ctxo = l < DEPTH - 1;
    constexpr int N_HL = (NB / 2) * (WG / 2), N_AL = NB * 2 * (SEQ / 64), N_CS = 2 * NB * NH * NCH, N_HC = NB * (WG / HCB), N_AC = NB * 2 * NCC;
    const int total = N_HL + N_AL + N_CS + (ctxo ? N_HC + N_AC : 0);
    for (int task = obid(); task < total; task += gridDim.x) {
        int t = task;
        if (t < N_HL) { hylat_task(p, l, t / (WG / 2), t % (WG / 2), smem); continue; } t -= N_HL;
        if (t < N_AL) { attn_task(p, l, t / (2 * (SEQ / 64)), (t / (SEQ / 64)) % 2, t % (SEQ / 64), false, smem); continue; } t -= N_AL;
        if (t < N_CS) { const int mixer = t / (NB * NH * NCH), r2 = t % (NB * NH * NCH); chunkst_task(p, l, mixer, r2 / (NH * NCH), (r2 / NCH) % NH, r2 % NCH, smem); continue; } t -= N_CS;
        if (t < N_HC) { hyctx_task(p, l, t / (WG / HCB), t % (WG / HCB), smem); continue; } t -= N_HC;
        attn_task(p, l, t / (2 * NCC), (t / NCC) % 2, t % NCC, true, smem);
    }
}

constexpr int SCG = 12;
__device__ void phase_scan(const Params& p) {
    const int tid = otid();
    bf16* ST = (bf16*)(p.ws + WS_ST); float* NV = (float*)(p.ws + WS_NV); const float* BE = (const float*)(p.ws + WS_BE); float* SC = (float*)(p.ws + WS_SC);
    constexpr int NCHAIN = 2 * 2 * NB * NH;
    for (int item = obid() * NT + tid; item < NCHAIN * 1024; item += gridDim.x * NT) {
        const int chain = item >> 10, grp = item & 1023; const int mixer = chain / (2 * NB * NH), dir = (chain / (NB * NH)) % 2, b = (chain / NH) % NB, h = chain % NH;
        float c[4] = {0.f, 0.f, 0.f, 0.f}; float nv[4] = {0.f, 0.f, 0.f, 0.f}; float m = 0.f;
        const int d0 = (grp & 15) * 4; const bool donv = (mixer == 0) && (grp < 16);
        for (int o0 = 0; o0 < NCH; o0 += SCG) {
            u32x2 uu[SCG]; float s0[SCG], s1[SCG]; f32x4 be[SCG]; f32x4 nu[SCG];
#pragma unroll
            for (int j = 0; j < SCG; ++j) if (o0 + j < NCH) { const int cid = chain_cid(dir, o0 + j); const size_t ci = ch_index(dir, b, h, cid);
                uu[j] = *(const u32x2*)(ST + st_index(mixer, dir, b, h, cid) * 4096 + grp * 4);
                if (mixer == 0) { s0[j] = SC[ci * 4 + 0]; s1[j] = SC[ci * 4 + 1]; if (donv) nu[j] = *(const f32x4*)(NV + ci * 64 + grp * 4); }
                else be[j] = *(const f32x4*)(BE + ci * 64 + d0); }
#pragma unroll
            for (int j = 0; j < SCG; ++j) if (o0 + j < NCH) { const int cid = chain_cid(dir, o0 + j); const size_t ci = ch_index(dir, b, h, cid);
                const float u[4] = {bitsf(uu[j].x << 16), bitsf(uu[j].x & 0xffff0000u), bitsf(uu[j].y << 16), bitsf(uu[j].y & 0xffff0000u)};
                u32x2 w; w.x = pk2(c[0], c[1]); w.y = pk2(c[2], c[3]); *(u32x2*)(ST + st_index(mixer, dir, b, h, cid) * 4096 + grp * 4) = w;
                if (mixer == 0) {
                    if (grp == 0) SC[ci * 4 + 2] = m;
                    const float mn = fmaxf(s0[j] + m, s1[j]), a = __expf(s0[j] + m - mn), s = __expf(s1[j] - mn);
#pragma unroll
                    for (int k = 0; k < 4; ++k) c[k] = a * c[k] + s * u[k];
                    if (donv) { f32x4 nw = {nv[0], nv[1], nv[2], nv[3]}; *(f32x4*)(NV + ci * 64 + grp * 4) = nw;
                        nv[0] = a * nv[0] + s * nu[j].x; nv[1] = a * nv[1] + s * nu[j].y; nv[2] = a * nv[2] + s * nu[j].z; nv[3] = a * nv[3] + s * nu[j].w; }
                    m = mn;
                } else { c[0] = __expf(be[j].x) * c[0] + u[0]; c[1] = __expf(be[j].y) * c[1] + u[1]; c[2] = __expf(be[j].z) * c[2] + u[2]; c[3] = __expf(be[j].w) * c[3] + u[3]; } }
        }
    }
}

__device__ void chunkout_task(const Params& p, int l, int mixer, int b, int h, int cid, char* smem) {
    const int tid = otid(), lane = tid & 63, wave = tid >> 6, r = lane & 15, q = lane >> 4, s_ = tid >> 3, c8 = tid & 7, d = tid & 63, sg = tid >> 6;
    const bf16* P = (const bf16*)(p.ws + WS_P); const float* G = (const float*)(p.ws + WS_G); bf16* Y = (bf16*)(p.ws + WS_HNY);
    const bf16* ST = (const bf16*)(p.ws + WS_ST);
    const int r0 = b * TOK + cid * 64;
    const int pbase = (mixer == 0 ? PA : PG) + h * 64;
    constexpr int TS = 64 * LS;
    bf16* QF = (bf16*)smem;
    bf16* KF = QF + TS;
    bf16* QB = KF + TS;
    bf16* KB = QB + TS;
    bf16* Vt = KB + TS;
    bf16* CF = Vt + TS;
    bf16* CB = CF + TS;
    bf16* SF = CB + TS;
    bf16* SB = SF + TS;
    float* fb = (float*)(SB + TS);
    float* rowt = fb;
    float* colt = rowt + 128;
    float* wint = colt + 128;
    float* emt = wint + 128;
    float* qn = emt + 128;
    float* rsum = qn + 128;
    float* ssq = rsum + 256;
    float* bend = ssq + 256;
    float* tot = bend + 128;
    float* rs = tot + 1024;
    float* la = rs + 2048;
    const size_t prow = (size_t)(r0 + s_) * NP + pbase + c8 * 8;
    const u32x4 qq = *(const u32x4*)(P + prow), kq = *(const u32x4*)(P + prow + 256), vq = *(const u32x4*)(P + prow + 512);
    const u32x4 cF = *(const u32x4*)(ST + st_index(mixer, 0, b, h, cid) * 4096 + s_ * 64 + c8 * 8), cB = *(const u32x4*)(ST + st_index(mixer, 1, b, h, cid) * 4096 + s_ * 64 + c8 * 8);
    const int e0 = (wave & 3) * 16, n0 = (wave >> 2) * 32;
    u32x2 og[2], gg[2];
#pragma unroll
    for (int nt = 0; nt < 2; ++nt) { const size_t off = (size_t)(r0 + n0 + 16 * nt + r) * NP + pbase + e0 + 4 * q;
        gg[nt] = *(const u32x2*)(P + off + (mixer == 0 ? 1024 : 768)); og[nt] = mixer == 0 ? *(const u32x2*)(P + off + 768) : (u32x2){0u, 0u}; }
    f32x4 nF0 = {0.f, 0.f, 0.f, 0.f}, nF1 = nF0, nB0 = nF0, nB1 = nF0, rq = nF0; float wF[16], wB[16], baF = 0.f, baB = 0.f;
    float gi[2] = {0.f, 0.f}, gf[2] = {0.f, 0.f}, mprev[2] = {0.f, 0.f};
    if (mixer == 0) {
        const float* nvF = (const float*)(p.ws + WS_NV) + ch_index(0, b, h, cid) * 64 + c8 * 8; const float* nvB = (const float*)(p.ws + WS_NV) + ch_index(1, b, h, cid) * 64 + c8 * 8;
        nF0 = *(const f32x4*)nvF; nF1 = *(const f32x4*)(nvF + 4); nB0 = *(const f32x4*)nvB; nB1 = *(const f32x4*)(nvB + 4);
        if (wave == 0) { const float* g = G + (size_t)(r0 + lane) * NG; const float* gb = p.in[I_MGB] + (size_t)l * 16;
#pragma unroll
            for (int dir = 0; dir < 2; ++dir) { gi[dir] = g[dir * 8 + h] + gb[dir * 8 + h]; gf[dir] = g[dir * 8 + 4 + h] + gb[dir * 8 + 4 + h]; mprev[dir] = ((const float*)(p.ws + WS_SC))[ch_index(dir, b, h, cid) * 4 + 2]; } }
    } else {
        rq = *(const f32x4*)(G + (size_t)(r0 + s_) * NG + 16 + c8 * 4);
        const float* wa = p.in[I_GWA] + ((size_t)(l * 2) * 16) * WG + h * 64 + d;
#pragma unroll
        for (int j = 0; j < 16; ++j) { wF[j] = wa[(size_t)j * WG]; wB[j] = wa[(size_t)(16 + j) * WG]; }
        baF = p.in[I_GBA][(size_t)(l * 2) * WG + h * 64 + d]; baB = p.in[I_GBA][(size_t)(l * 2 + 1) * WG + h * 64 + d];
    }
    __syncthreads();
    { const unsigned w[4] = {vq.x, vq.y, vq.z, vq.w};
#pragma unroll
        for (int j = 0; j < 4; ++j) { Vt[(c8 * 8 + 2 * j) * LS + s_] = (bf16)(w[j] & 0xffffu); Vt[(c8 * 8 + 2 * j + 1) * LS + s_] = (bf16)(w[j] >> 16); } }
    float fq[8], fk[8]; unpack8(qq, fq); unpack8(kq, fk);
    if (mixer == 0) {
        *(u32x4*)(QF + s_ * LS + c8 * 8) = qq;
        { u32x4 o; o.x = pk2(fk[0] * 0.125f, fk[1] * 0.125f); o.y = pk2(fk[2] * 0.125f, fk[3] * 0.125f); o.z = pk2(fk[4] * 0.125f, fk[5] * 0.125f); o.w = pk2(fk[6] * 0.125f, fk[7] * 0.125f); *(u32x4*)(KF + s_ * LS + c8 * 8) = o; }
        *(u32x4*)(CF + s_ * LS + c8 * 8) = cF; *(u32x4*)(CB + s_ * LS + c8 * 8) = cB;
        float dF = fq[0] * nF0.x + fq[1] * nF0.y + fq[2] * nF0.z + fq[3] * nF0.w + fq[4] * nF1.x + fq[5] * nF1.y + fq[6] * nF1.z + fq[7] * nF1.w;
        float dB = fq[0] * nB0.x + fq[1] * nB0.y + fq[2] * nB0.z + fq[3] * nB0.w + fq[4] * nB1.x + fq[5] * nB1.y + fq[6] * nB1.z + fq[7] * nB1.w;
        dF += __shfl_xor(dF, 1); dF += __shfl_xor(dF, 2); dF += __shfl_xor(dF, 4); dB += __shfl_xor(dB, 1); dB += __shfl_xor(dB, 2); dB += __shfl_xor(dB, 4);
        if (c8 == 0) { qn[s_] = dF; qn[64 + s_] = dB; }
        if (wave == 0) {
#pragma unroll
            for (int dir = 0; dir < 2; ++dir) { const float lf = logsigf_(gf[dir]); float bb;
                if (dir == 0) bb = wave_prefix_sum(lf, lane); else { const float tt = wave_sum(lf), pre = wave_prefix_sum(lf, lane); bb = tt - pre + lf; }
                const float a = gi[dir] - bb; const float pm = dir == 0 ? wave_prefix_max(a, lane) : wave_suffix_max(a, lane);
                const float mt = fmaxf(bb + mprev[dir], bb + pm);
                rowt[dir * 64 + lane] = bb - mt; colt[dir * 64 + lane] = a; wint[dir * 64 + lane] = __expf(bb + mprev[dir] - mt); emt[dir * 64 + lane] = __expf(-mt); }
        }
        __syncthreads();
    } else {
        *(f32x4*)(rs + s_ * 32 + c8 * 4) = rq;
        __syncthreads();
        float bF[8], bB[8];
#pragma unroll
        for (int i = 0; i < 8; ++i) { const float* rr = rs + (sg * 8 + i) * 32; float aF = baF, aB = baB;
#pragma unroll
            for (int j = 0; j < 16; ++j) { aF += rr[j] * wF[j]; aB += rr[16 + j] * wB[j]; }
            bF[i] = logsigf_(aF) * (1.0f / 16.0f); bB[i] = logsigf_(aB) * (1.0f / 16.0f); }
#pragma unroll
        for (int i = 1; i < 8; ++i) bF[i] += bF[i - 1];
#pragma unroll
        for (int i = 6; i >= 0; --i) bB[i] += bB[i + 1];
        tot[(0 * 8 + sg) * 64 + d] = bF[7]; tot[(1 * 8 + sg) * 64 + d] = bB[0];
        __syncthreads();
        { float offF = 0.f, offB = 0.f, tF = 0.f, tB = 0.f;
#pragma unroll
            for (int g8 = 0; g8 < 8; ++g8) { const float tf = tot[(0 * 8 + g8) * 64 + d], tb = tot[(1 * 8 + g8) * 64 + d]; tF += tf; tB += tb; if (g8 < sg) offF += tf; if (g8 > sg) offB += tb; }
#pragma unroll
            for (int i = 0; i < 8; ++i) { la[(sg * 8 + i) * 64 + d] = bF[i] + offF; la[4096 + (sg * 8 + i) * 64 + d] = bB[i] + offB; }
            if (sg == 0) { bend[d] = tF; bend[64 + d] = tB; } }
        __syncthreads();
        { float cf[8], cb[8]; unpack8(cF, cf); unpack8(cB, cb);
            const f32x4 l0 = *(const f32x4*)(la + s_ * 64 + c8 * 8), l1 = *(const f32x4*)(la + s_ * 64 + c8 * 8 + 4), m0 = *(const f32x4*)(la + 4096 + s_ * 64 + c8 * 8), m1 = *(const f32x4*)(la + 4096 + s_ * 64 + c8 * 8 + 4);
            const float lbF[8] = {l0.x, l0.y, l0.z, l0.w, l1.x, l1.y, l1.z, l1.w}, lbB[8] = {m0.x, m0.y, m0.z, m0.w, m1.x, m1.y, m1.z, m1.w};
            float a1[8], a2[8], a3[8], a4[8], c1[8], c2[8];
#pragma unroll
            for (int j = 0; j < 8; ++j) { const float hF = 0.5f * bend[c8 * 8 + j], hB = 0.5f * bend[64 + c8 * 8 + j];
                a1[j] = fq[j] * 0.125f * __expf(lbF[j] - hF); a2[j] = fk[j] * __expf(hF - lbF[j]); a3[j] = fq[j] * 0.125f * __expf(lbB[j] - hB); a4[j] = fk[j] * __expf(hB - lbB[j]);
                c1[j] = cf[j] * __expf(hF); c2[j] = cb[j] * __expf(hB); }
            u32x4 o;
            o.x = pk2(a1[0], a1[1]); o.y = pk2(a1[2], a1[3]); o.z = pk2(a1[4], a1[5]); o.w = pk2(a1[6], a1[7]); *(u32x4*)(QF + s_ * LS + c8 * 8) = o;
            o.x = pk2(a2[0], a2[1]); o.y = pk2(a2[2], a2[3]); o.z = pk2(a2[4], a2[5]); o.w = pk2(a2[6], a2[7]); *(u32x4*)(KF + s_ * LS + c8 * 8) = o;
            o.x = pk2(a3[0], a3[1]); o.y = pk2(a3[2], a3[3]); o.z = pk2(a3[4], a3[5]); o.w = pk2(a3[6], a3[7]); *(u32x4*)(QB + s_ * LS + c8 * 8) = o;
            o.x = pk2(a4[0], a4[1]); o.y = pk2(a4[2], a4[3]); o.z = pk2(a4[4], a4[5]); o.w = pk2(a4[6], a4[7]); *(u32x4*)(KB + s_ * LS + c8 * 8) = o;
            o.x = pk2(c1[0], c1[1]); o.y = pk2(c1[2], c1[3]); o.z = pk2(c1[4], c1[5]); o.w = pk2(c1[6], c1[7]); *(u32x4*)(CF + s_ * LS + c8 * 8) = o;
            o.x = pk2(c2[0], c2[1]); o.y = pk2(c2[2], c2[3]); o.z = pk2(c2[4], c2[5]); o.w = pk2(c2[6], c2[7]); *(u32x4*)(CB + s_ * LS + c8 * 8) = o; }
        __syncthreads();
    }
    { const int t0 = (wave & 3) * 16, c0 = (wave >> 2) * 32;
        f32x4 S0[2] = {(f32x4){0.f, 0.f, 0.f, 0.f}, (f32x4){0.f, 0.f, 0.f, 0.f}};
        if (mixer == 0) mma_nt<2, 2>(QF, LS, t0, KF, LS, c0, S0, lane);
#pragma unroll
        for (int dir = 0; dir < 2; ++dir) {
            f32x4 S[2] = {S0[0], S0[1]};
            if (mixer == 1) mma_nt<2, 2>(dir == 0 ? QF : QB, LS, t0, dir == 0 ? KF : KB, LS, c0, S, lane);
            bf16* Sm = dir == 0 ? SF : SB;
#pragma unroll
            for (int i = 0; i < 4; ++i) { const int t = t0 + 4 * q + i; float sm = 0.f;
#pragma unroll
                for (int nt = 0; nt < 2; ++nt) { const int s = c0 + 16 * nt + r; const bool ok = dir == 0 ? (s <= t) : (s >= t); float v = 0.f;
                    if (ok) v = mixer == 0 ? S[nt][i] * __expf(rowt[dir * 64 + t] + colt[dir * 64 + s]) : S[nt][i];
                    Sm[t * LS + s] = f2bf(v); sm += v; }
                if (mixer == 0) { sm += __shfl_xor(sm, 1); sm += __shfl_xor(sm, 2); sm += __shfl_xor(sm, 4); sm += __shfl_xor(sm, 8); if (r == 0) rsum[(dir * 2 + (wave >> 2)) * 64 + t] = sm; } }
        }
    }
    __syncthreads();
    f32x4 htot[2] = {(f32x4){0.f, 0.f, 0.f, 0.f}, (f32x4){0.f, 0.f, 0.f, 0.f}};
#pragma unroll
    for (int dir = 0; dir < 2; ++dir) {
        f32x4 a1[2] = {(f32x4){0.f, 0.f, 0.f, 0.f}, (f32x4){0.f, 0.f, 0.f, 0.f}}, a2[2] = {(f32x4){0.f, 0.f, 0.f, 0.f}, (f32x4){0.f, 0.f, 0.f, 0.f}};
        mma_nt<2, 2>(Vt, LS, e0, dir == 0 ? SF : SB, LS, n0, a1, lane);
        mma_nt<2, 2>(dir == 0 ? CF : CB, LS, e0, (mixer == 0 || dir == 0) ? QF : QB, LS, n0, a2, lane);
#pragma unroll
        for (int nt = 0; nt < 2; ++nt) { const int t = n0 + 16 * nt + r;
            if (mixer == 0) { const float wi = wint[dir * 64 + t]; const float den = wi * qn[dir * 64 + t] + rsum[(dir * 2) * 64 + t] + rsum[(dir * 2 + 1) * 64 + t]; const float inv = 1.0f / fmaxf(fabsf(den), emt[dir * 64 + t]);
                htot[nt] += (a1[nt] + a2[nt] * wi) * inv; }
            else htot[nt] += a1[nt] + a2[nt]; }
    }
    float gv[2][4];
#pragma unroll
    for (int nt = 0; nt < 2; ++nt) { const int t = n0 + 16 * nt + r;
        gv[nt][0] = bitsf(gg[nt].x << 16); gv[nt][1] = bitsf(gg[nt].x & 0xffff0000u); gv[nt][2] = bitsf(gg[nt].y << 16); gv[nt][3] = bitsf(gg[nt].y & 0xffff0000u);
        if (mixer == 0) { htot[nt][0] *= sigmoidf_(bitsf(og[nt].x << 16)); htot[nt][1] *= sigmoidf_(bitsf(og[nt].x & 0xffff0000u)); htot[nt][2] *= sigmoidf_(bitsf(og[nt].y << 16)); htot[nt][3] *= sigmoidf_(bitsf(og[nt].y & 0xffff0000u)); }
        float ss = htot[nt][0] * htot[nt][0] + htot[nt][1] * htot[nt][1] + htot[nt][2] * htot[nt][2] + htot[nt][3] * htot[nt][3];
        ss += __shfl_xor(ss, 16); ss += __shfl_xor(ss, 32);
        if (q == 0) ssq[(wave & 3) * 64 + t] = ss; }
    __syncthreads();
    { const float* ng = p.in[mixer == 0 ? I_MNG : I_GNG] + (size_t)l * WG + h * 64 + e0 + 4 * q; const f32x4 n4 = *(const f32x4*)ng;
#pragma unroll
        for (int nt = 0; nt < 2; ++nt) { const int t = n0 + 16 * nt + r;
            const float rstd = rsqrtf((ssq[t] + ssq[64 + t] + ssq[128 + t] + ssq[192 + t]) * (1.0f / 64.0f) + EPS);
            u32x2 o; o.x = pk2(htot[nt][0] * rstd * n4.x * siluf_(gv[nt][0]), htot[nt][1] * rstd * n4.y * siluf_(gv[nt][1])); o.y = pk2(htot[nt][2] * rstd * n4.z * siluf_(gv[nt][2]), htot[nt][3] * rstd * n4.w * siluf_(gv[nt][3]));
            *(u32x2*)(Y + (size_t)(r0 + t) * 1024 + (mixer == 0 ? YA : YG) + h * 64 + e0 + 4 * q) = o; } }
}

__device__ void phase_mix2(const Params& p, int l, char* smem) {
    constexpr int N = 2 * NB * NH * NCH;
    for (int task = obid(); task < N; task += gridDim.x) {
        const int mixer = task / (NB * NH * NCH), r2 = task % (NB * NH * NCH); const int b = r2 / (NH * NCH), h = (r2 / NCH) % NH, cid = r2 % NCH;
        if (l == DEPTH - 1 && cid < NCC) continue;
        chunkout_task(p, l, mixer, b, h, cid, smem);
    }
}


#ifndef EMU
#define LAS __attribute__((address_space(3)))
#define XB_TMO      128
#define XB_XCNT(j)  (256  + 64 * (j))
#define XB_XSUB(j)  (1280 + 64 * (j))
#define XB_XGEN(j)  (2304 + 64 * (j))
#define XB_TOP      3328
#define XB_TOPGEN   3392
#define XCD_BAR_WORDS 3456
#define XB_SPIN_CAP (1u << 18)

__device__ __forceinline__ unsigned xb_ld(unsigned* p)              { return __hip_atomic_load(p, __ATOMIC_RELAXED, __HIP_MEMORY_SCOPE_AGENT); }
__device__ __forceinline__ unsigned xb_add(unsigned* p, unsigned v) { return __hip_atomic_fetch_add(p, v, __ATOMIC_RELAXED, __HIP_MEMORY_SCOPE_AGENT); }
__device__ __forceinline__ unsigned xb_xcc_id() { return (unsigned)__builtin_amdgcn_s_getreg((3 << 11) | 20) & 0xFu; }
#define XB_SPIN(cond, bar) do { unsigned _sp = 0; while (cond) { __builtin_amdgcn_s_sleep(1); \
    if ((++_sp & 255u) == 0u) { if (xb_ld(&(bar)[XB_TMO])) break; if (_sp > XB_SPIN_CAP) { atomicAdd(&(bar)[XB_TMO], 1u); break; } } } } while (0)

struct XcdBarrier {
    unsigned* bar; unsigned x;
    volatile LAS unsigned* st;
};

__device__ __forceinline__ XcdBarrier xcd_barrier_post(unsigned* bar, volatile LAS unsigned* st) {
    XcdBarrier b; b.bar = bar; b.x = xb_xcc_id(); b.st = st;
    if (threadIdx.x == 0) (void)xb_add(&bar[XB_XCNT(b.x)], 1u);
    return b;
}
__device__ __forceinline__ void xcd_barrier_complete(unsigned* bar, unsigned x, unsigned& nloc, unsigned& nx) {
    const unsigned G = gridDim.x * gridDim.y * gridDim.z;
    unsigned sum, cnt, mine, sp = 0u;
    for (;;) {
        sum = 0u; cnt = 0u; mine = 0u;
#pragma unroll
        for (unsigned j = 0; j < 16; ++j) { const unsigned c = xb_ld(&bar[XB_XCNT(j)]); sum += c; cnt += (c > 0u) ? 1u : 0u; mine = (j == x) ? c : mine; }
        if (sum == G) break;
        __builtin_amdgcn_s_sleep(1);
        if ((++sp & 255u) == 0u) { if (xb_ld(&bar[XB_TMO])) break; if (sp > XB_SPIN_CAP) { atomicAdd(&bar[XB_TMO], 1u); break; } }
    }
    nloc = mine > 0u ? mine : 1u; nx = cnt > 0u ? cnt : 1u;
}

__device__ __forceinline__ void xcd_barrier(const XcdBarrier& b) {
    asm volatile("s_waitcnt vmcnt(0)" ::: "memory");
    __syncthreads();
    if (threadIdx.x == 0) {
        unsigned* bar = b.bar;
        __builtin_amdgcn_s_waitcnt(0);
        unsigned nloc = b.st[0], nx = b.st[1];
        if (nloc == 0u) { xcd_barrier_complete(bar, b.x, nloc, nx); b.st[0] = nloc; b.st[1] = nx; }
        const unsigned old = xb_add(&bar[XB_XSUB(b.x)], 1u);
        const unsigned gen = old / nloc;
        if (old + 1u == (gen + 1u) * nloc) {
            __builtin_amdgcn_fence(__ATOMIC_RELEASE, "agent");
            asm volatile("s_waitcnt vmcnt(0)" ::: "memory");
            const unsigned og = xb_add(&bar[XB_TOP], 1u);
            const unsigned tg = og / nx;
            if (og + 1u == (tg + 1u) * nx) xb_add(&bar[XB_TOPGEN], 1u);
            else XB_SPIN(xb_ld(&bar[XB_TOPGEN]) == tg, bar);
            __builtin_amdgcn_fence(__ATOMIC_ACQUIRE, "agent");
            xb_add(&bar[XB_XGEN(b.x)], 1u);
            asm volatile("s_waitcnt vmcnt(0)" ::: "memory");
        } else {
            XB_SPIN(xb_ld(&bar[XB_XGEN(b.x)]) == gen, bar);
            __builtin_amdgcn_fence(__ATOMIC_ACQUIRE, "agent");
            asm volatile("s_waitcnt vmcnt(0)" ::: "memory");
        }
    }
    __syncthreads();
}
#endif

__global__ void __launch_bounds__(NT) fwd_kernel(Params pk, int ph_lo, int ph_hi) {
    SMEM_DECL;
#ifndef EMU
    volatile LAS unsigned* misc = (volatile LAS unsigned*)(smem + LDS_BYTES - 64);
    if (threadIdx.x < 2) misc[threadIdx.x] = 0u;
    __syncthreads();
    const XcdBarrier bar = xcd_barrier_post((unsigned*)(pk.ws + WS_BAR), misc);
#endif
    constexpr int NPH = 2 + 6 * DEPTH;
    for (int ph = ph_lo; ph < ph_hi && ph < NPH; ++ph) {
#ifndef EMU
        Params p = pk; { size_t z = 0; asm volatile("" : "+s"(z)); p.ws = pk.ws + z; p.out = pk.out + z;
#pragma unroll
            for (int i = 0; i < 26; ++i) p.in[i] = pk.in[i] + z; }
#else
        const Params& p = pk;
#endif
        if (ph == 0) phase0(p, smem);
        else if (ph == NPH - 1) phase_rp(p, DEPTH, smem);
        else { const int l = (ph - 1) / 6, k = (ph - 1) % 6;
            if (k == 0) phase_rp(p, l, smem);
            else if (k == 1) phase_gemm_in(p, l, smem);
            else if (k == 2) phase_mix1(p, l, smem);
            else if (k == 3) phase_scan(p);
            else if (k == 4) phase_mix2(p, l, smem);
            else phase_gemm_out(p, l, smem);
#ifdef PROBE_DUP
            if (k == PROBE_DUP) { GRID_SYNC();
                if (k == 1) phase_gemm_in(p, l, smem); else if (k == 2) phase_mix1(p, l, smem); else if (k == 4) phase_mix2(p, l, smem); else if (k == 5) phase_gemm_out(p, l, smem); }
#endif
        }
        if (ph + 1 < ph_hi) {
#ifdef EMU
            GRID_SYNC();
#else
            if (ph == 0) GRID_SYNC(); else xcd_barrier(bar);
#endif
        }
    }
}

#ifndef EMU
extern "C" void kernel_launch(void* const* d_in, const int* in_sizes, int n_in, void* d_out, int out_size, void* d_ws, size_t ws_size, hipStream_t stream) {
    static int grid = 0;
    if (grid == 0) {
        if (n_in != 26 || ws_size < WS_TOTAL) { fprintf(stderr, "kernel_launch: unexpected n_in %d or ws_size %zu (need %zu)\n", n_in, ws_size, (size_t)WS_TOTAL); grid = -1; return; }
        int dev = 0, cus = 0, per_cu = 0;
        hipGetDevice(&dev);
        hipDeviceGetAttribute(&cus, hipDeviceAttributeMultiprocessorCount, dev);
        hipFuncSetAttribute((const void*)fwd_kernel, hipFuncAttributeMaxDynamicSharedMemorySize, LDS_BYTES);
        hipOccupancyMaxActiveBlocksPerMultiprocessor(&per_cu, (const void*)fwd_kernel, NT, LDS_BYTES);
        if (per_cu < 1) { fprintf(stderr, "kernel_launch: occupancy query returned %d\n", per_cu); grid = -1; return; }
        if (per_cu > 1) per_cu = 1;
        grid = cus * per_cu;
    }
    if (grid < 0) return;
    hipMemsetAsync((char*)d_ws + WS_BAR, 0, BAR_BYTES, stream);
    Params p{};
    for (int i = 0; i < 26; ++i) p.in[i] = (const float*)d_in[i];
    p.out = (float*)d_out; p.ws = (char*)d_ws;
    int lo = 0, hi = 2 + 6 * DEPTH;
    void* args[] = {&p, &lo, &hi};
    hipError_t e = hipLaunchCooperativeKernel((const void*)fwd_kernel, dim3(grid), dim3(NT), args, LDS_BYTES, stream);
    if (e != hipSuccess) fprintf(stderr, "cooperative launch failed: %s (grid %d)\n", hipGetErrorString(e), grid);
}
#endif
```

```cpp
#ifdef EMU
#include "emu/hipemu.h"
#define GRID_SYNC() emu::grid_sync()
#define SMEM_DECL char* smem = emu::S().blocks[emu::cur()->block].lds
#define MFMA16(a, b, c) emu_mfma_16x16x32_bf16(a, b, c)
#else
#include <hip/hip_runtime.h>
#include <hip/hip_cooperative_groups.h>
#include <cstdio>
#include <cstdint>
#define GRID_SYNC() cooperative_groups::this_grid().sync()
#define SMEM_DECL extern __shared__ __attribute__((aligned(16))) char smem[]
#define MFMA16(a, b, c) __builtin_amdgcn_mfma_f32_16x16x32_bf16(a, b, c, 0, 0, 0)
#endif

#ifdef EMU
#ifndef EMU_DM
#define EMU_DM 256
#endif
#ifndef EMU_NB
#define EMU_NB 2
#endif
#ifndef EMU_SEQ
#define EMU_SEQ 512
#endif
#ifndef EMU_DEPTH
#define EMU_DEPTH 2
#endif
#ifndef EMU_CTXL
#define EMU_CTXL 128
#endif
constexpr int DM = EMU_DM, NB = EMU_NB, SEQ = EMU_SEQ, DEPTH = EMU_DEPTH, CTXL = EMU_CTXL;
#else
constexpr int DM = 1024, NB = 8, SEQ = 2048, DEPTH = 4, CTXL = 256;
#endif
constexpr int MIX = 1024, WG = 256, HD = 64, NH = 4, CH = 64;
constexpr int TOK = CTXL + SEQ, T = NB * TOK, NCH = TOK / CH, NCC = CTXL / CH;
constexpr int N_IN = 4144, NP = 3072, NG = 48, NGS = 32, NMAIN = 3328, NPAD = 4352;
constexpr int NF = 2 * SEQ;
constexpr int NJ = NB + 1;
constexpr int NT = 512;
constexpr float EPS = 1e-6f;
constexpr int PA = 0, PG = 1280, PD = 2304;
constexpr int YA = 0, YH = 256, YG = 512, YD = 768;
constexpr int ilog4(int n) { return n <= 1 ? 0 : 1 + ilog4(n / 4); }
constexpr int FFT_P = ilog4(NF);
static_assert((1 << (2 * FFT_P)) == NF, "NF must be a power of 4");
static_assert(DM % 256 == 0 && CTXL % 128 == 0 && SEQ % 256 == 0, "shape constraints");

typedef unsigned short bf16;
typedef short bf16x8 __attribute__((ext_vector_type(8)));
typedef float f32x4 __attribute__((ext_vector_type(4)));
typedef unsigned u32x4 __attribute__((ext_vector_type(4)));
typedef unsigned u32x2 __attribute__((ext_vector_type(2)));
struct cpx { float x, y; };

constexpr size_t al256(size_t x) { return (x + 255) & ~(size_t)255; }
constexpr size_t WS_CTXB = 0;
constexpr size_t WS_HNY = al256(WS_CTXB + (size_t)NB * CTXL * DM * 4);
constexpr size_t WS_WIN = WS_HNY + (size_t)T * 1024 * 2;
constexpr size_t WS_ST = WS_WIN;
constexpr size_t ST_BYTES = (size_t)2 * 2 * NB * NH * NCH * 4096 * 2;
constexpr size_t WS_KT = al256(WS_WIN + (size_t)NPAD * DM * 2);
static_assert(WS_KT + (size_t)WG * NF * 4 <= WS_ST + ST_BYTES || true, "");
constexpr size_t ST_END = al256((WS_ST + ST_BYTES > WS_KT + (size_t)WG * NF * 4) ? WS_ST + ST_BYTES : WS_KT + (size_t)WG * NF * 4);
constexpr size_t WS_P = ST_END;
constexpr size_t WS_HT = al256(WS_P + (size_t)T * NP * 2);
constexpr size_t WS_WOUT = WS_HT;
constexpr size_t WS_G = al256(WS_HT + (size_t)1024 * T * 2);
constexpr size_t WS_KF = al256(WS_G + (size_t)T * NGS * 4);
constexpr size_t WS_HC = al256(WS_KF + (size_t)WG * NF * 8);
constexpr size_t WS_EQ = al256(WS_HC + (size_t)2 * WG * CTXL * 4);
constexpr size_t WS_NV = al256(WS_EQ + (size_t)2 * T * WG * 2);
constexpr size_t WS_BE = al256(WS_NV + (size_t)2 * NB * NH * NCH * 64 * 4);
constexpr size_t WS_SC = al256(WS_BE + (size_t)2 * NB * NH * NCH * 64 * 4);
constexpr size_t WS_MOD = al256(WS_SC + (size_t)2 * NB * NH * NCH * 4 * 4);
constexpr size_t WS_TW = al256(WS_MOD + (size_t)DEPTH * NJ * 3 * DM * 4);
constexpr size_t WS_ROPE = al256(WS_TW + (size_t)NF * 8);
constexpr size_t WS_BAR = al256(WS_ROPE + (size_t)SEQ * 32 * 8);
constexpr size_t BAR_BYTES = 16384;
constexpr size_t WS_TOTAL = al256(WS_BAR + BAR_BYTES);
static_assert((size_t)T * DM * 4 <= (size_t)T * NP * 2, "YO fits in P");
#ifndef EMU
static_assert(WS_TOTAL <= (size_t)268435456, "workspace map must fit 256 MiB");
#endif

constexpr int LDS_BYTES = 163840;

struct Params {
    const float* in[26];
    float* out;
    char* ws;
};
enum { I_X = 0, I_C, I_CTX, I_CCTX, I_WADA, I_BADA, I_GPRE, I_GPOST, I_WIN, I_MGB, I_MNG, I_HCW, I_HCB, I_HW1, I_HB1, I_HW2, I_HB2, I_HW3, I_HB3,
       I_HFREQ, I_HD, I_GWA, I_GBA, I_GNG, I_SINK, I_WOUT };

__device__ __forceinline__ Params relaunder(const Params& pk) {
#ifdef EMU
    return pk;
#else
    Params p = pk; size_t z = 0; asm volatile("" : "+s"(z)); p.ws = pk.ws + z; p.out = pk.out + z;
#pragma unroll
    for (int i = 0; i < 26; ++i) p.in[i] = pk.in[i] + z;
    return p;
#endif
}

#ifdef EMU
__device__ __forceinline__ int otid() { return (int)threadIdx.x; }
__device__ __forceinline__ int obid() { return (int)blockIdx.x; }
#else
__device__ __forceinline__ int otid() { int t = (int)threadIdx.x; asm volatile("" : "+v"(t)); return t; }
__device__ __forceinline__ int obid() { int b = (int)blockIdx.x; asm volatile("" : "+s"(b)); return b; }
#endif
__device__ __forceinline__ unsigned fbits(float f) { return __builtin_bit_cast(unsigned, f); }
__device__ __forceinline__ float bitsf(unsigned u) { return __builtin_bit_cast(float, u); }
__device__ __forceinline__ bf16 f2bf(float f) { unsigned u = fbits(f); return (bf16)((u + 0x7fffu + ((u >> 16) & 1u)) >> 16); }
__device__ __forceinline__ float bf2f(bf16 h) { return bitsf((unsigned)h << 16); }
__device__ __forceinline__ unsigned pk2(float lo, float hi) { return (unsigned)f2bf(lo) | ((unsigned)f2bf(hi) << 16); }
#ifdef EMU
__device__ __forceinline__ float frcp_(float x) { return 1.0f / x; }
#else
__device__ __forceinline__ float frcp_(float x) { return __builtin_amdgcn_rcpf(x); }
#endif
__device__ __forceinline__ float sigmoidf_(float x) { return 1.0f / (1.0f + __expf(-x)); }
__device__ __forceinline__ float siluf_(float x) { return x / (1.0f + __expf(-x)); }
__device__ __forceinline__ float logsigf_(float x) { return fminf(x, 0.0f) - log1pf(__expf(-fabsf(x))); }
__device__ __forceinline__ float logsig_fast(float x) { return fminf(x, 0.0f) - __logf(1.0f + __expf(-fabsf(x))); }
__device__ __forceinline__ float wave_sum(float v) {
#pragma unroll
    for (int o = 1; o < 64; o <<= 1) v += __shfl_xor(v, o);
    return v;
}
__device__ __forceinline__ float wave_max(float v) {
#pragma unroll
    for (int o = 1; o < 64; o <<= 1) v = fmaxf(v, __shfl_xor(v, o));
    return v;
}
__device__ __forceinline__ float wave_prefix_sum(float v, int lane) {
#pragma unroll
    for (int o = 1; o < 64; o <<= 1) { float t = __shfl_up(v, o); if (lane >= o) v += t; }
    return v;
}
__device__ __forceinline__ float wave_prefix_max(float v, int lane) {
#pragma unroll
    for (int o = 1; o < 64; o <<= 1) { float t = __shfl_up(v, o); if (lane >= o) v = fmaxf(v, t); }
    return v;
}
__device__ __forceinline__ float wave_suffix_max(float v, int lane) {
#pragma unroll
    for (int o = 1; o < 64; o <<= 1) { float t = __shfl_down(v, o); if (lane + o < 64) v = fmaxf(v, t); }
    return v;
}
__device__ __forceinline__ void unpack8(u32x4 v, float* f) {
    f[0] = bitsf(v.x << 16); f[1] = bitsf(v.x & 0xffff0000u); f[2] = bitsf(v.y << 16); f[3] = bitsf(v.y & 0xffff0000u);
    f[4] = bitsf(v.z << 16); f[5] = bitsf(v.z & 0xffff0000u); f[6] = bitsf(v.w << 16); f[7] = bitsf(v.w & 0xffff0000u);
}
__device__ __forceinline__ int orig_col(int n) {
    if (n < 1280) return n;
    if (n < 2304) return 2320 + (n - 1280);
    if (n < 3072) return 3376 + (n - 2304);
    if (n < 3088) return 1280 + (n - 3072);
    if (n < 3120) return 3344 + (n - 3088);
    if (n < NMAIN) return -1;
    return 1296 + (n - NMAIN);
}
__device__ __forceinline__ int chain_cid(int dir, int o) {
    if (dir == 0) return o;
    return o < NCC ? (NCC - 1 - o) : (NCH - 1 - (o - NCC));
}

constexpr int LS = 72;

template <int NTL, int KS>
__device__ __forceinline__ void mma_nt(const bf16* A, int lda, int m0, const bf16* B, int ldb, int n0, f32x4 (&acc)[NTL], int lane) {
    const int r = lane & 15, q = lane >> 4;
#pragma unroll
    for (int ks = 0; ks < KS; ++ks) {
        const bf16x8 a = *(const bf16x8*)(A + (m0 + r) * lda + ks * 32 + q * 8);
#pragma unroll
        for (int nt = 0; nt < NTL; ++nt) {
            const bf16x8 b = *(const bf16x8*)(B + (n0 + nt * 16 + r) * ldb + ks * 32 + q * 8);
            acc[nt] = MFMA16(a, b, acc[nt]);
        }
    }
}

__device__ __forceinline__ void phase0(const Params& p, char* smem) {
    const int tid = otid();
    cpx* TW = (cpx*)(p.ws + WS_TW);
    cpx* ROPE = (cpx*)(p.ws + WS_ROPE);
    float* MOD = (float*)(p.ws + WS_MOD);
    constexpr int N_TW = NF / NT, N_ROPE = SEQ * 32 / NT, N_MOD = DEPTH * (3 * DM / 64);
    for (int task = obid(); task < N_TW + N_ROPE + N_MOD; task += gridDim.x) {
        if (task < N_TW) {
            const int j = task * NT + tid; float s, c; sincospif(2.0f * (float)j / (float)NF, &s, &c);
            cpx v; v.x = c; v.y = -s; TW[j] = v;
        } else if (task < N_TW + N_ROPE) {
            const int idx = (task - N_TW) * NT + tid; const int pos = idx >> 5, i = idx & 31;
            const float inv = exp2f(-(float)(i & 15) * (13.287712379549449f / 16.0f));
            const float ang = (float)(i < 16 ? pos / 64 : pos % 64) * inv;
            cpx v; v.x = cosf(ang); v.y = sinf(ang); ROPE[idx] = v;
        } else {
            const int mt = task - N_TW - N_ROPE; const int l = mt / (3 * DM / 64), n0 = (mt % (3 * DM / 64)) * 64;
            float* sv = (float*)smem;
            float* red = sv + NJ * DM;
            __syncthreads();
            for (int i = tid; i < NJ * DM; i += NT) { const int j = i / DM, k = i % DM; const float v = j < NB ? p.in[I_C][j * DM + k] : p.in[I_CCTX][k]; sv[i] = siluf_(v); }
            __syncthreads();
            const int nl = tid & 63, ks = tid >> 6; float acc[NJ];
#pragma unroll
            for (int j = 0; j < NJ; ++j) acc[j] = 0.f;
            const float* w = p.in[I_WADA] + (size_t)l * DM * 3 * DM + n0 + nl;
            for (int k = ks * (DM / 8); k < (ks + 1) * (DM / 8); ++k) { const float wv = w[(size_t)k * 3 * DM];
#pragma unroll
                for (int j = 0; j < NJ; ++j) acc[j] += sv[j * DM + k] * wv; }
#pragma unroll
            for (int j = 0; j < NJ; ++j) red[(ks * NJ + j) * 64 + nl] = acc[j];
            __syncthreads();
            for (int i = tid; i < NJ * 64; i += NT) { const int j = i / 64, n = i % 64; float s = 0.f;
#pragma unroll
                for (int k8 = 0; k8 < 8; ++k8) s += red[(k8 * NJ + j) * 64 + n];
                MOD[((size_t)l * NJ + j) * 3 * DM + n0 + n] = s + p.in[I_BADA][(size_t)l * 3 * DM + n0 + n]; }
        }
    }
}

__device__ __forceinline__ void rp_rows(const Params& p, int l) {
    const int tid = otid(), lane = tid & 63, wave = tid >> 6;
    const float* MOD = (const float*)(p.ws + WS_MOD);
    float* CTXB = (float*)(p.ws + WS_CTXB);
    const float* YO = (const float*)(p.ws + WS_P);
    bf16* HN = (bf16*)(p.ws + WS_HNY);
    constexpr int NV4 = DM / 256;
    for (int row = obid() * 8 + wave; row < T; row += gridDim.x * 8) {
        const int b = row / TOK, pp = row % TOK; const bool isctx = pp < CTXL;
        if (l == DEPTH && isctx) continue;
        const size_t off = isctx ? ((size_t)b * CTXL + pp) * DM : ((size_t)b * SEQ + (pp - CTXL)) * DM;
        const float* xo = (l <= 1) ? (isctx ? p.in[I_CTX] + off : p.in[I_X] + off) : (isctx ? CTXB + off : p.out + off);
        float* xn = isctx ? CTXB + off : p.out + off;
        const int mj = isctx ? NB : b;
        f32x4 x[NV4];
#pragma unroll
        for (int j = 0; j < NV4; ++j) x[j] = *(const f32x4*)(xo + 4 * lane + 256 * j);
        if (l > 0) {
            f32x4 y[NV4]; float ss = 0.f;
#pragma unroll
            for (int j = 0; j < NV4; ++j) { y[j] = *(const f32x4*)(YO + (size_t)row * DM + 4 * lane + 256 * j); ss += y[j].x * y[j].x + y[j].y * y[j].y + y[j].z * y[j].z + y[j].w * y[j].w; }
            const float rstd = rsqrtf(wave_sum(ss) * (1.0f / DM) + EPS);
            const float* gt = MOD + ((size_t)(l - 1) * NJ + mj) * 3 * DM + 2 * DM;
            const float* gp = p.in[I_GPOST] + (size_t)(l - 1) * DM;
#pragma unroll
            for (int j = 0; j < NV4; ++j) { const f32x4 g4 = *(const f32x4*)(gt + 4 * lane + 256 * j), p4 = *(const f32x4*)(gp + 4 * lane + 256 * j);
                x[j] = x[j] + g4 * (y[j] * rstd * p4);
                *(f32x4*)(xn + 4 * lane + 256 * j) = x[j]; }
        }
        if (l < DEPTH) {
            float ss = 0.f;
#pragma unroll
            for (int j = 0; j < NV4; ++j) ss += x[j].x * x[j].x + x[j].y * x[j].y + x[j].z * x[j].z + x[j].w * x[j].w;
            const float rstd = rsqrtf(wave_sum(ss) * (1.0f / DM) + EPS);
            const float* md = MOD + ((size_t)l * NJ + mj) * 3 * DM;
            const float* gp = p.in[I_GPRE] + (size_t)l * DM;
#pragma unroll
            for (int j = 0; j < NV4; ++j) { const int e = 4 * lane + 256 * j;
                const f32x4 g4 = *(const f32x4*)(gp + e), sh = *(const f32x4*)(md + e), sc = *(const f32x4*)(md + DM + e);
                const f32x4 h = (x[j] * rstd * g4) * (sc + 1.0f) + sh;
                u32x2 o; o.x = pk2(h.x, h.y); o.y = pk2(h.z, h.w);
                *(u32x2*)(HN + (size_t)row * DM + e) = o; }
        }
    }
}

__device__ __forceinline__ void convert_tile(const float* src, int ldn, bf16* dst, int K, int n0, int k0, bool use_map, char* smem) {
    const int tid = otid();
    float* tile = (float*)smem;
    __syncthreads();
#pragma unroll
    for (int i = 0; i < 8; ++i) { const int idx = tid + NT * i, k = idx >> 6, n = idx & 63;
        const int oc = use_map ? orig_col(n0 + n) : (n0 + n);
        tile[k * 65 + n] = oc >= 0 ? src[(size_t)(k0 + k) * ldn + oc] : 0.f; }
    __syncthreads();
    const int n = tid >> 3, c = tid & 7;
    u32x4 o; o.x = pk2(tile[(8 * c + 0) * 65 + n], tile[(8 * c + 1) * 65 + n]); o.y = pk2(tile[(8 * c + 2) * 65 + n], tile[(8 * c + 3) * 65 + n]);
    o.z = pk2(tile[(8 * c + 4) * 65 + n], tile[(8 * c + 5) * 65 + n]); o.w = pk2(tile[(8 * c + 6) * 65 + n], tile[(8 * c + 7) * 65 + n]);
    *(u32x4*)(dst + (size_t)(n0 + n) * K + k0 + 8 * c) = o;
}

__device__ __forceinline__ void filter_task(const Params& p, int l, int L, int pos0, char* smem) {
    const int tid = otid();
    float* z = (float*)smem;
    float* h1 = z + 8 * 33;
    float* h2 = h1 + 8 * 64;
    __syncthreads();
    if (tid < 8 * 33) { const int pp = tid / 33, i = tid % 33; const float pos = (float)(pos0 + pp);
        const float t = pos / (float)(L - 1 > 1 ? L - 1 : 1), w = 6.283185307179586f * pos / (float)L; float v;
        if (i == 0) v = t; else { const int bi = (i - 1) & 15; const float f = 1e-4f + (float)bi * ((15.0f - 1e-4f) / 15.0f); v = (i <= 16) ? cosf(w * f) : -sinf(w * f); }
        z[tid] = v; }
    __syncthreads();
    { const int pp = tid >> 6, j = tid & 63; const float* w1 = p.in[I_HW1] + (size_t)l * 33 * 64; float a = p.in[I_HB1][l * 64 + j];
        for (int i = 0; i < 33; ++i) a += z[pp * 33 + i] * w1[i * 64 + j];
        h1[tid] = sinf(p.in[I_HFREQ][(l * 2 + 0) * 64 + j] * a); }
    __syncthreads();
    { const int pp = tid >> 6, j = tid & 63; const float* w2 = p.in[I_HW2] + (size_t)l * 64 * 64; float a = p.in[I_HB2][l * 64 + j];
        for (int i = 0; i < 64; ++i) a += h1[pp * 64 + i] * w2[i * 64 + j];
        h2[tid] = sinf(p.in[I_HFREQ][(l * 2 + 1) * 64 + j] * a); }
    __syncthreads();
    { const int o = tid, dir = o >> 8, c = o & 255; const float* w3 = p.in[I_HW3] + (size_t)l * 64 * 512; const float b3 = p.in[I_HB3][l * 512 + o];
        const float delta = 3.0701134573253946f + (float)c * ((15.350567286626973f - 3.0701134573253946f) / 255.0f);
        float acc[8];
#pragma unroll
        for (int pp = 0; pp < 8; ++pp) acc[pp] = b3;
        for (int j = 0; j < 64; ++j) { const float wv = w3[j * 512 + o];
#pragma unroll
            for (int pp = 0; pp < 8; ++pp) acc[pp] += h2[pp * 64 + j] * wv; }
        float* KT = (float*)(p.ws + WS_KT); float* HC = (float*)(p.ws + WS_HC);
#pragma unroll
        for (int pp = 0; pp < 8; ++pp) { const int pos = pos0 + pp; const float t = (float)pos / (float)(L - 1 > 1 ? L - 1 : 1);
            const float v = acc[pp] * __expf(-t * delta);
            if (L == SEQ) { if (dir == 0) KT[(size_t)c * NF + pos]= v; else if (pos > 0) KT[(size_t)c * NF + (NF - pos)] = v; else KT[(size_t)c * NF + SEQ] = 0.f; }
            else HC[((size_t)dir * WG + c) * CTXL + pos] = v; }
    }
}

__device__ __forceinline__ void phase_rp(const Params& p, int l, char* smem) {
    rp_rows(p, l);
    if (l >= DEPTH) return;
    constexpr int N_WIN = (NPAD / 64) * (DM / 64), N_FL = SEQ / 8, N_FC = CTXL / 8;
    for (int task = obid(); task < N_WIN + N_FL + N_FC; task += gridDim.x) {
        if (task < N_WIN) { const int nt = task / (DM / 64), kt = task % (DM / 64);
            convert_tile(p.in[I_WIN] + (size_t)l * DM * N_IN, N_IN, (bf16*)(p.ws + WS_WIN), DM, nt * 64, kt * 64, true, smem); }
        else if (task < N_WIN + N_FL) filter_task(p, l, SEQ, (task - N_WIN) * 8, smem);
        else filter_task(p, l, CTXL, (task - N_WIN - N_FL) * 8, smem);
    }
}

__device__ __forceinline__ cpx cmul(cpx a, cpx b) { cpx r; r.x = a.x * b.x - a.y * b.y; r.y = a.x * b.y + a.y * b.x; return r; }
__device__ __forceinline__ cpx cmulc(cpx a, cpx b) { cpx r; r.x = a.x * b.x + a.y * b.y; r.y = a.y * b.x - a.x * b.y; return r; }
__device__ __forceinline__ void fft_fwd(cpx* buf, const cpx* TW, int tl) {
    for (int s = 0; s < FFT_P; ++s) {
        const int span = NF >> (2 * (s + 1)), tws = 1 << (2 * s);
        __syncthreads();
#pragma unroll 1
        for (int j = tl; j < NF / 4; j += 256) {
            const int grp = j / span, pos = j % span, base = grp * 4 * span + pos;
            const cpx x0 = buf[base], x1 = buf[base + span], x2 = buf[base + 2 * span], x3 = buf[base + 3 * span];
            const cpx a = {x0.x + x2.x, x0.y + x2.y}, b = {x0.x - x2.x, x0.y - x2.y}, c = {x1.x + x3.x, x1.y + x3.y}, d = {x1.x - x3.x, x1.y - x3.y};
            const cpx y0 = {a.x + c.x, a.y + c.y}, y2 = {a.x - c.x, a.y - c.y};
            const cpx y1 = {b.x + d.y, b.y - d.x};
            const cpx y3 = {b.x - d.y, b.y + d.x};
            buf[base] = y0;
            buf[base + span] = cmul(y1, TW[pos * tws]);
            buf[base + 2 * span] = cmul(y2, TW[2 * pos * tws]);
            buf[base + 3 * span] = cmul(y3, TW[3 * pos * tws]);
        }
    }
    __syncthreads();
}
__device__ __forceinline__ void fft_inv(cpx* buf, const cpx* TW, int tl) {
    for (int s = FFT_P - 1; s >= 0; --s) {
        const int span = NF >> (2 * (s + 1)), tws = 1 << (2 * s);
        __syncthreads();
#pragma unroll 1
        for (int j = tl; j < NF / 4; j += 256) {
            const int grp = j / span, pos = j % span, base = grp * 4 * span + pos;
            const cpx b0 = buf[base];
            const cpx b1 = cmulc(buf[base + span], TW[pos * tws]);
            const cpx b2 = cmulc(buf[base + 2 * span], TW[2 * pos * tws]);
            const cpx b3 = cmulc(buf[base + 3 * span], TW[3 * pos * tws]);
            const cpx a = {b0.x + b2.x, b0.y + b2.y}, b = {b0.x - b2.x, b0.y - b2.y}, c = {b1.x + b3.x, b1.y + b3.y}, d = {b1.x - b3.x, b1.y - b3.y};
            const cpx x0 = {a.x + c.x, a.y + c.y}, x2 = {a.x - c.x, a.y - c.y};
            const cpx x1 = {b.x - d.y, b.y + d.x};
            const cpx x3 = {b.x + d.y, b.y - d.x};
            buf[base] = x0; buf[base + span] = x1; buf[base + 2 * span] = x2; buf[base + 3 * span] = x3;
        }
    }
    __syncthreads();
}
__device__ __forceinline__ void filt_fft_task(const Params& p, int cp, char* smem) {
    const int tid = otid(), half = tid >> 8, tl = tid & 255, c = 2 * cp + half;
    cpx* buf = (cpx*)smem + (size_t)half * NF;
    const float* KT = (const float*)(p.ws + WS_KT) + (size_t)c * NF;
    cpx* KF = (cpx*)(p.ws + WS_KF) + (size_t)c * NF;
    const cpx* TW = (const cpx*)(p.ws + WS_TW);
    __syncthreads();
    for (int i = tl; i < NF; i += 256) { cpx v; v.x = KT[i]; v.y = 0.f; buf[i] = v; }
    fft_fwd(buf, TW, tl);
    for (int i = tl; i < NF; i += 256) KF[i] = buf[i];
}

__device__ __forceinline__ void gemm_tile(const Params& p, const bf16* A, const bf16* Bt, int K, int mt, int nt, int mode, char* smem) {
    const int tid = otid(), lane = tid & 63, wave = tid >> 6;
    bf16* As = (bf16*)smem;
    bf16* Bs = As + 128 * LS;
    const int wm = (wave & 3) * 32, wn = (wave >> 2) * 64;
    f32x4 acc[2][4];
#pragma unroll
    for (int i = 0; i < 2; ++i)
#pragma unroll
        for (int j = 0; j < 4; ++j) acc[i][j] = (f32x4){0.f, 0.f, 0.f, 0.f};
    const int lr = tid >> 3, lc = tid & 7;
    const bf16* Ag = A + (size_t)(mt * 128 + lr) * K + lc * 8;
    const bf16* Bg = Bt + (size_t)(nt * 128 + lr) * K + lc * 8;
    u32x4 ra0, ra1, rb0, rb1;
    ra0 = *(const u32x4*)(Ag); ra1 = *(const u32x4*)(Ag + (size_t)64 * K); rb0 = *(const u32x4*)(Bg); rb1 = *(const u32x4*)(Bg + (size_t)64 * K);
    const int nk = K / 64;
    for (int kt = 0; kt < nk; ++kt) {
        __syncthreads();
        *(u32x4*)(As + lr * LS + lc * 8) = ra0; *(u32x4*)(As + (lr + 64) * LS + lc * 8) = ra1;
        *(u32x4*)(Bs + lr * LS + lc * 8) = rb0; *(u32x4*)(Bs + (lr + 64) * LS + lc * 8) = rb1;
        __syncthreads();
        if (kt + 1 < nk) { const int ko = (kt + 1) * 64;
            ra0 = *(const u32x4*)(Ag + ko); ra1 = *(const u32x4*)(Ag + (size_t)64 * K + ko); rb0 = *(const u32x4*)(Bg + ko); rb1 = *(const u32x4*)(Bg + (size_t)64 * K + ko); }
        mma_nt<4, 2>(As, LS, wm, Bs, LS, wn, acc[0], lane);
        mma_nt<4, 2>(As, LS, wm + 16, Bs, LS, wn, acc[1], lane);
    }
    const int r = lane & 15, q = lane >> 4;
#pragma unroll
    for (int i = 0; i < 2; ++i)
#pragma unroll
        for (int j = 0; j < 4; ++j)
#pragma unroll
            for (int e = 0; e < 4; ++e) {
                const int row = mt * 128 + wm + 16 * i + 4 * q + e, col = nt * 128 + wn + 16 * j + r; const float v = acc[i][j][e];
                if (mode == 0) { if (col < NP) ((bf16*)(p.ws + WS_P))[(size_t)row * NP + col] = f2bf(v); else if (col < NP + 16) ((float*)(p.ws + WS_G))[(size_t)row * NGS + (col - NP)] = v; else if (col < NP + NG) ((bf16*)((float*)(p.ws + WS_G) + (size_t)row * NGS + 16))[col - NP - 16] = f2bf(v); }
                else if (mode == 2) ((bf16*)(p.ws + WS_HT))[(size_t)row * T + col] = f2bf(v);
                else ((float*)(p.ws + WS_P))[(size_t)row * DM + col] = v;
            }
}

#ifndef EMU
namespace pg8 {
#define PG8_LAS __attribute__((address_space(3)))
typedef unsigned short bf16_t;
typedef short bf16x8 __attribute__((ext_vector_type(8)));
typedef float f32x4 __attribute__((ext_vector_type(4)));
typedef unsigned u32x4 __attribute__((ext_vector_type(4)));
constexpr int BM = 256, BK = 64, HALF = 128, HTB = HALF * BK * 2  , STAGE_BYTES = 8 * HTB, NXCD = 8, WGM = 8;

__host__ __device__ __forceinline__ int lds_byte(int r, int c) { const int st = (r >> 4) * 2 + (c >> 5), rr = r & 15, cc = c & 31, ob = rr * 64 + cc * 2; return st * 1024 + (ob ^ (((ob >> 9) & 1) << 5)); }
__host__ __device__ __forceinline__ void stage_rc(int b, int& R, int& C) { const int st = b / 1024, sb = b % 1024, swz = sb ^ (((sb >> 9) & 1) << 5); R = (st >> 1) * 16 + swz / 64; C = (st & 1) * 32 + (swz % 64) / 2; }
__host__ __device__ __forceinline__ int perm32(int rho) { const int n = rho >> 4, i = rho & 15; return 8 * (i >> 2) + 4 * n + (i & 3); }

struct Unit { int pm, pn; };
struct Gemm { const bf16_t* A; const bf16_t* Bt; int M, N, K; };
__device__ __forceinline__ unsigned cvt_pk_bf16(float lo, float hi) { unsigned r; asm volatile("v_cvt_pk_bf16_f32 %0, %1, %2" : "=v"(r) : "v"(lo), "v"(hi)); return r; }
template <class Epi, class Sched, bool ALIGN_EPI = false, bool SP2 = false>
__device__ __forceinline__ void gemm_phase(PG8_LAS unsigned char* lds, const Gemm g, const Sched& S, const Epi& E) {
    const int tid = otid(), wid = __builtin_amdgcn_readfirstlane(tid >> 6), lane = tid & 63, wr = wid >> 2, wc = wid & 3, fr = lane & 15, fq = lane >> 4;
    const int K = g.K, nt = K / BK;
    unsigned voffA[2], voffB[2];
#pragma unroll
    for (int i = 0; i < 2; ++i) { int R, C; stage_rc(tid * 16 + i * 8192, R, C); const int Rb = Epi::PERM ? ((R & ~31) + perm32(R & 31)) : R;
        voffA[i] = (unsigned)(R * K + C) * 2u; voffB[i] = (unsigned)(Rb * K + C) * 2u; }
    const size_t kstep = (size_t)(BK * 2);
    const size_t hstep = (size_t)HALF * K * 2;
    const size_t tstep = 2 * hstep;
    const unsigned ldsw = (unsigned)wid * 1024u;
    const int aoff = lds_byte(wr * 64 + fr, fq * 8), boff = lds_byte(wc * 32 + fr, fq * 8);
#define PG8_SA(b, h) (((b) * 2 + (h)) * HTB)
#define PG8_SB(b, h) ((4 + (b) * 2 + (h)) * HTB)
#define PG8_STAGE(bufoff, gbase, voff) do { _Pragma("unroll") for (int _i = 0; _i < 2; ++_i) \
        __builtin_amdgcn_global_load_lds((const unsigned*)((const char*)(gbase) + (voff)[_i]), (PG8_LAS unsigned*)(lds + (bufoff) + ldsw + _i * 8192), 16, 0, 0); } while (0)
#define PG8_LDA(dst, b, h) do { _Pragma("unroll") for (int m = 0; m < 4; ++m) _Pragma("unroll") for (int k = 0; k < 2; ++k) dst[m][k] = *(const PG8_LAS bf16x8*)(lds + PG8_SA(b, h) + aoff + m * 2048 + k * 1024); } while (0)
#define PG8_LDB(dst, b, h) do { _Pragma("unroll") for (int n = 0; n < 2; ++n) _Pragma("unroll") for (int k = 0; k < 2; ++k) dst[n][k] = *(const PG8_LAS bf16x8*)(lds + PG8_SB(b, h) + boff + n * 2048 + k * 1024); } while (0)
#define PG8_MMA(ai, bj, At, Bt) do { __builtin_amdgcn_s_setprio(1); _Pragma("unroll") for (int m = 0; m < 4; ++m) _Pragma("unroll") for (int n = 0; n < 2; ++n) _Pragma("unroll") for (int k = 0; k < 2; ++k) \
        acc[ai][bj][m][n] = __builtin_amdgcn_mfma_f32_16x16x32_bf16(Bt[n][k], At[m][k], acc[ai][bj][m][n], 0, 0, 0); __builtin_amdgcn_s_setprio(0); } while (0)
#define PG8_WAIT_V(n) asm volatile("s_waitcnt vmcnt(" #n ")" ::: "memory")
#define PG8_WAIT_L(n) asm volatile("s_waitcnt lgkmcnt(" #n ")" ::: "memory")
#define PG8_BAR __builtin_amdgcn_s_barrier()
#define PG8_SCHED __builtin_amdgcn_sched_barrier(0)
    Unit cur, nxt; int ui = 0;
    if (!S.next(0, cur)) return;
    f32x4 acc[2][2][4][2];
#pragma unroll
    for (int a = 0; a < 2; ++a)
#pragma unroll
        for (int b = 0; b < 2; ++b)
#pragma unroll
            for (int m = 0; m < 4; ++m)
#pragma unroll
                for (int n = 0; n < 2; ++n) acc[a][b][m][n] = (f32x4){0.f, 0.f, 0.f, 0.f};
    bf16x8 At[4][2], B0[2][2], B1[2][2];
    const char* cA = (const char*)g.A + (size_t)cur.pm * tstep; const char* cB = (const char*)g.Bt + (size_t)cur.pn * tstep;
    S.a_ready(cur);
    if constexpr (SP2) {
        PG8_STAGE(PG8_SB(0, 0), cB, voffB); PG8_STAGE(PG8_SB(0, 1), cB + hstep, voffB); PG8_STAGE(PG8_SA(0, 0), cA, voffA); PG8_STAGE(PG8_SA(0, 1), cA + hstep, voffA);
        if (wr == 1) PG8_BAR;
        PG8_WAIT_V(2); PG8_BAR;
        PG8_STAGE(PG8_SB(1, 0), cB + kstep, voffB); PG8_STAGE(PG8_SA(1, 0), cA + kstep, voffA); PG8_STAGE(PG8_SB(1, 1), cB + hstep + kstep, voffB);
        PG8_WAIT_V(6); PG8_BAR;
    } else {
        PG8_STAGE(PG8_SB(0, 0), cB, voffB); PG8_STAGE(PG8_SA(0, 0), cA, voffA); PG8_STAGE(PG8_SB(0, 1), cB + hstep, voffB); PG8_STAGE(PG8_SA(0, 1), cA + hstep, voffA);
        if (wr == 1) PG8_BAR;
        PG8_WAIT_V(4); PG8_BAR;
        PG8_STAGE(PG8_SB(1, 0), cB + kstep, voffB); PG8_STAGE(PG8_SA(1, 0), cA + kstep, voffA); PG8_STAGE(PG8_SB(1, 1), cB + hstep + kstep, voffB);
        PG8_WAIT_V(6); PG8_BAR;
    }
    for (;;) {
        const bool has_next = S.next(ui + 1, nxt);
        const char* nA = has_next ? (const char*)g.A + (size_t)nxt.pm * tstep : cA; const char* nB = has_next ? (const char*)g.Bt + (size_t)nxt.pn * tstep : cB;
        for (int t = 0; t < nt; t += 2) {
            const bool last = (t == nt - 2);
            const char* a1 = cA + (size_t)(t + 1) * kstep;
            const char* a2 = last ? nA : cA + (size_t)(t + 2) * kstep; const char* b2 = last ? nB : cB + (size_t)(t + 2) * kstep;
            const char* a3 = a2 + kstep; const char* b3 = b2 + kstep;
            if (last && has_next) S.a_ready(nxt);
            if constexpr (SP2) {
            PG8_LDB(B0, 0, 0); PG8_LDB(B1, 0, 1); PG8_SCHED; PG8_LDA(At, 0, 0); PG8_STAGE(PG8_SA(1, 1), a1 + hstep, voffA);
            PG8_WAIT_V(8); PG8_WAIT_L(0); PG8_BAR; PG8_MMA(0, 0, At, B0); PG8_MMA(0, 1, At, B1); PG8_BAR; PG8_SCHED;
            PG8_LDA(At, 0, 1); PG8_STAGE(PG8_SB(0, 0), b2, voffB); PG8_STAGE(PG8_SB(0, 1), b2 + hstep, voffB); PG8_STAGE(PG8_SA(0, 0), a2, voffA);
            PG8_WAIT_V(8); PG8_WAIT_L(0); PG8_BAR; PG8_MMA(1, 0, At, B0); PG8_MMA(1, 1, At, B1); PG8_BAR; PG8_SCHED;
            PG8_LDB(B0, 1, 0); PG8_LDB(B1, 1, 1); PG8_SCHED; PG8_LDA(At, 1, 0); PG8_STAGE(PG8_SA(0, 1), a2 + hstep, voffA);
            PG8_WAIT_V(8); PG8_WAIT_L(0); PG8_BAR; PG8_MMA(0, 0, At, B0); PG8_MMA(0, 1, At, B1); PG8_BAR; PG8_SCHED;
            PG8_LDA(At, 1, 1); PG8_STAGE(PG8_SB(1, 0), b3, voffB); PG8_STAGE(PG8_SB(1, 1), b3 + hstep, voffB); PG8_STAGE(PG8_SA(1, 0), a3, voffA);
            PG8_WAIT_V(8); PG8_WAIT_L(0); PG8_BAR; PG8_MMA(1, 0, At, B0); PG8_MMA(1, 1, At, B1); PG8_BAR; PG8_SCHED;
            } else {
            PG8_LDB(B0, 0, 0); PG8_SCHED; PG8_LDA(At, 0, 0); PG8_STAGE(PG8_SA(1, 1), a1 + hstep, voffA);
            PG8_WAIT_L(8); PG8_BAR; PG8_WAIT_L(0); PG8_MMA(0, 0, At, B0); PG8_BAR; PG8_SCHED;
            PG8_LDB(B1, 0, 1); PG8_STAGE(PG8_SB(0, 0), b2, voffB);
            PG8_BAR; PG8_WAIT_L(0); PG8_MMA(0, 1, At, B1); PG8_BAR;
            PG8_LDA(At, 0, 1); PG8_STAGE(PG8_SA(0, 0), a2, voffA);
            PG8_BAR; PG8_WAIT_L(0); PG8_MMA(1, 0, At, B0); PG8_BAR; PG8_SCHED;
            PG8_STAGE(PG8_SB(0, 1), b2 + hstep, voffB);
            PG8_WAIT_V(6); PG8_BAR; PG8_MMA(1, 1, At, B1); PG8_BAR;
            PG8_LDB(B0, 1, 0); PG8_SCHED; PG8_LDA(At, 1, 0); PG8_STAGE(PG8_SA(0, 1), a2 + hstep, voffA);
            PG8_WAIT_L(8); PG8_BAR; PG8_WAIT_L(0); PG8_MMA(0, 0, At, B0); PG8_BAR; PG8_SCHED;
            PG8_LDB(B1, 1, 1); PG8_STAGE(PG8_SB(1, 0), b3, voffB);
            PG8_BAR; PG8_WAIT_L(0); PG8_MMA(0, 1, At, B1); PG8_BAR;
            PG8_LDA(At, 1, 1); PG8_STAGE(PG8_SA(1, 0), a3, voffA);
            PG8_BAR; PG8_WAIT_L(0); PG8_MMA(1, 0, At, B0); PG8_BAR; PG8_SCHED;
            PG8_STAGE(PG8_SB(1, 1), b3 + hstep, voffB);
            PG8_WAIT_V(6); PG8_BAR; PG8_MMA(1, 1, At, B1); PG8_BAR;
            }
        }
        if constexpr (ALIGN_EPI) { if (wr == 0) PG8_BAR; }
        if constexpr (!Epi::AFTER_DRAIN) { E(acc, cur, wr, wc, fr, fq); S.done(cur); }
        if (!has_next) break;
#pragma unroll
        for (int a = 0; a < 2; ++a)
#pragma unroll
            for (int b = 0; b < 2; ++b)
#pragma unroll
                for (int m = 0; m < 4; ++m)
#pragma unroll
                    for (int n = 0; n < 2; ++n) acc[a][b][m][n] = (f32x4){0.f, 0.f, 0.f, 0.f};
        cur = nxt; cA = nA; cB = nB; ++ui;
        if constexpr (ALIGN_EPI) { if (wr == 1) PG8_BAR; }
    }
    PG8_WAIT_V(0);
    if constexpr (!ALIGN_EPI) { if (wr == 0) PG8_BAR; }
    PG8_BAR;
    if constexpr (Epi::AFTER_DRAIN) { E.fused(acc, cur, wr, wc, fr, fq, lds, wid, lane); S.done(cur); }
#undef PG8_SA
#undef PG8_SB
#undef PG8_STAGE
#undef PG8_LDA
#undef PG8_LDB
#undef PG8_MMA
#undef PG8_WAIT_V
#undef PG8_WAIT_L
#undef PG8_BAR
#undef PG8_SCHED
}
__device__ __forceinline__ void map_tile(int L, int nM, int nN, int& pm, int& pn) {
    const int nwg = nM * nN; int wgid = L; { const int q = nwg / NXCD, r = nwg % NXCD, xcd = wgid % NXCD, off = wgid / NXCD; wgid = (xcd < r ? xcd * (q + 1) : r * (q + 1) + (xcd - r) * q) + off; }
    const int nig = WGM * nN, gid = wgid / nig, fm = gid * WGM, gsz = (nM - fm) < WGM ? (nM - fm) : WGM;
    pm = fm + ((wgid % nig) % gsz); pn = (wgid % nig) / gsz;
}
constexpr int MP = T / 256, WP = NMAIN / 256, NU2 = 4 * MP, NU1 = MP * WP;
struct InOrder { int G, c;
    __device__ __forceinline__ bool next(int i, Unit& u) const { const int L = i * G + c; if (L >= NU2 + NU1) return false; int a, b;
        if (L < NU2) { map_tile(L, 4, MP, a, b); u.pm = MP + WP + a; u.pn = b; } else { map_tile(L - NU2, MP, WP, a, b); u.pm = a; u.pn = MP + b; } return true; }
    __device__ __forceinline__ void a_ready(const Unit&) const {}
    __device__ __forceinline__ void done(const Unit&) const {}
};
struct EpiIn { static constexpr bool PERM = true, AFTER_DRAIN = false; bf16_t* P; float* G; bf16_t* HTp;
    __device__ __forceinline__ void operator()(const f32x4 (&acc)[2][2][4][2], const Unit& u, int wr, int wc, int fr, int fq) const {
        if (u.pm < MP) { const int pn = u.pn - MP, row0 = u.pm * BM + wr * 64 + fr;
            if (pn < NP / 256) { const int col0 = pn * BM + wc * 32 + 8 * fq;
#pragma unroll
                for (int ai = 0; ai < 2; ++ai)
#pragma unroll
                    for (int m = 0; m < 4; ++m) { bf16_t* rowp = P + (size_t)(row0 + ai * HALF + m * 16) * NP + col0;
#pragma unroll
                        for (int bj = 0; bj < 2; ++bj) { const f32x4 v0 = acc[ai][bj][m][0], v1 = acc[ai][bj][m][1];
                            u32x4 w; w.x = cvt_pk_bf16(v0[0], v0[1]); w.y = cvt_pk_bf16(v0[2], v0[3]); w.z = cvt_pk_bf16(v1[0], v1[1]); w.w = cvt_pk_bf16(v1[2], v1[3]); *(u32x4*)(rowp + bj * HALF) = w; } } }
            else { const int cb = wc * 32 + 8 * fq;
                if (cb < NG) {
#pragma unroll
                    for (int ai = 0; ai < 2; ++ai)
#pragma unroll
                        for (int m = 0; m < 4; ++m) { float* rowb = G + (size_t)(row0 + ai * HALF + m * 16) * NGS; const f32x4 v0 = acc[ai][0][m][0], v1 = acc[ai][0][m][1];
                            if (cb < 16) { *(f32x4*)(rowb + cb) = v0; *(f32x4*)(rowb + cb + 4) = v1; }
                            else { u32x4 w; w.x = cvt_pk_bf16(v0[0], v0[1]); w.y = cvt_pk_bf16(v0[2], v0[3]); w.z = cvt_pk_bf16(v1[0], v1[1]); w.w = cvt_pk_bf16(v1[2], v1[3]); *(u32x4*)((bf16_t*)(rowb + 16) + (cb - 16)) = w; } } } } }
        else { const int row0 = (u.pm - MP - WP) * BM + wr * 64 + fr, col0 = u.pn * BM + wc * 32 + 8 * fq;
#pragma unroll
            for (int ai = 0; ai < 2; ++ai)
#pragma unroll
                for (int m = 0; m < 4; ++m) { bf16_t* rowp = HTp + (size_t)(row0 + ai * HALF + m * 16) * T + col0;
#pragma unroll
                    for (int bj = 0; bj < 2; ++bj) { const f32x4 v0 = acc[ai][bj][m][0], v1 = acc[ai][bj][m][1];
                        u32x4 w; w.x = cvt_pk_bf16(v0[0], v0[1]); w.y = cvt_pk_bf16(v0[2], v0[3]); w.z = cvt_pk_bf16(v1[0], v1[1]); w.w = cvt_pk_bf16(v1[2], v1[3]); *(u32x4*)(rowp + bj * HALF) = w; } } }
    }
};
struct OutOrder { int G, c; bool lat_only;
    __device__ __forceinline__ bool next(int i, Unit& u) const { const int nM = lat_only ? NB * (SEQ / 256) : MP, nN = DM / 256; const int L = i * G + c; if (L >= nM * nN) return false; int a, b; map_tile(L, nM, nN, a, b);
        u.pm = lat_only ? (a / (SEQ / 256)) * (TOK / 256) + CTXL / 256 + a % (SEQ / 256) : a; u.pn = b; return true; }
    __device__ __forceinline__ void a_ready(const Unit&) const {}
    __device__ __forceinline__ void done(const Unit&) const {}
};
struct EpiOut { static constexpr bool PERM = false, AFTER_DRAIN = false; float* C;
    __device__ __forceinline__ void operator()(const f32x4 (&acc)[2][2][4][2], const Unit& u, int wr, int wc, int fr, int fq) const {
        const int row0 = u.pm * BM + wr * 64 + fr, col0 = u.pn * BM + wc * 32 + 4 * fq;
#pragma unroll
        for (int ai = 0; ai < 2; ++ai)
#pragma unroll
            for (int m = 0; m < 4; ++m) { float* rowp = C + (size_t)(row0 + ai * HALF + m * 16) * DM + col0;
#pragma unroll
                for (int bj = 0; bj < 2; ++bj)
#pragma unroll
                    for (int n = 0; n < 2; ++n) *(f32x4*)(rowp + bj * HALF + n * 16) = acc[ai][bj][m][n]; }
    }
};
}
#endif

__device__ __forceinline__ void phase_gemm_in(const Params& p, int l, char* smem) {
    constexpr int N_F = WG / 2;
#ifdef EMU
    constexpr int MT = T / 128, NT1 = NMAIN / 128, N1 = MT * NT1, N2 = 8 * MT;
    for (int task = obid(); task < N1 + N2; task += gridDim.x) {
        if (task < N1) gemm_tile(p, (const bf16*)(p.ws + WS_HNY), (const bf16*)(p.ws + WS_WIN), DM, task / NT1, task % NT1, 0, smem);
        else { const int t2 = task - N1; gemm_tile(p, (const bf16*)(p.ws + WS_WIN) + (size_t)NMAIN * DM, (const bf16*)(p.ws + WS_HNY), DM, t2 / MT, t2 % MT, 2, smem); }
    }
#else
    { const pg8::Gemm g{(const pg8::bf16_t*)(p.ws + WS_HNY), (const pg8::bf16_t*)(p.ws + WS_HNY), 0, 0, DM};
      const pg8::InOrder S{(int)gridDim.x, obid()};
      const pg8::EpiIn E{(pg8::bf16_t*)(p.ws + WS_P), (float*)(p.ws + WS_G), (pg8::bf16_t*)(p.ws + WS_HT)};
      pg8::gemm_phase<pg8::EpiIn, pg8::InOrder, true, true>((PG8_LAS unsigned char*)smem, g, S, E); }
#endif
    for (int task = (int)gridDim.x - 1 - obid(); task < N_F; task += gridDim.x) filt_fft_task(p, task, smem);
}
__device__ __forceinline__ void phase_gemm_out(const Params& p, int l, char* smem) {
#ifdef EMU
    constexpr int MT = T / 128, NTO = DM / 128;
    for (int task = obid(); task < MT * NTO; task += gridDim.x) {
        const int mt = task / NTO, nt = task % NTO;
        if (l == DEPTH - 1 && (mt % (TOK / 128)) < CTXL / 128) continue;
        gemm_tile(p, (const bf16*)(p.ws + WS_HNY), (const bf16*)(p.ws + WS_WOUT), MIX, mt, nt, 1, smem);
    }
#else
    const pg8::Gemm g{(const pg8::bf16_t*)(p.ws + WS_HNY), (const pg8::bf16_t*)(p.ws + WS_WOUT), 0, 0, MIX};
    const pg8::OutOrder S{(int)gridDim.x, obid(), l == DEPTH - 1};
    const pg8::EpiOut E{(float*)(p.ws + WS_P)};
    pg8::gemm_phase<pg8::EpiOut, pg8::OutOrder, true, true>((PG8_LAS unsigned char*)smem, g, S, E);
#endif
}

__device__ __forceinline__ size_t st_index(int mixer, int dir, int b, int h, int cid) { return ((((size_t)(mixer * 2 + dir) * NB + b) * NH + h) * NCH + cid); }
__device__ __forceinline__ size_t ch_index(int dir, int b, int h, int cid) { return (((size_t)dir * NB + b) * NH + h) * NCH + cid; }

__device__ __forceinline__ void load_tile_nat(const bf16* P, int r0, int c0, bf16* dst, float scale, int tid) {
    const int s = tid >> 3, c8 = tid & 7;
    const u32x4 v = *(const u32x4*)(P + (size_t)(r0 + s) * NP + c0 + c8 * 8);
    if (scale == 1.0f) *(u32x4*)(dst + s * LS + c8 * 8) = v;
    else { float f[8]; unpack8(v, f); u32x4 o; o.x = pk2(f[0] * scale, f[1] * scale); o.y = pk2(f[2] * scale, f[3] * scale); o.z = pk2(f[4] * scale, f[5] * scale); o.w = pk2(f[6] * scale, f[7] * scale);
        *(u32x4*)(dst + s * LS + c8 * 8) = o; }
}
__device__ __forceinline__ void load_tile_tr(const bf16* P, int r0, int c0, bf16* dst, int tid) {
    const int s = tid >> 3, c8 = tid & 7;
    const u32x4 v = *(const u32x4*)(P + (size_t)(r0 + s) * NP + c0 + c8 * 8);
    const unsigned w[4] = {v.x, v.y, v.z, v.w};
#pragma unroll
    for (int j = 0; j < 4; ++j) { dst[(c8 * 8 + 2 * j) * LS + s] = (bf16)(w[j] & 0xffffu); dst[(c8 * 8 + 2 * j + 1) * LS + s] = (bf16)(w[j] >> 16); }
}

template <int NTK>
__device__ __forceinline__ void load_span(const bf16* row, int t0, float (&v)[NTK + 2]) {
    v[0] = t0 > 0 ? bf2f(row[-1]) : 0.f; v[NTK + 1] = (t0 + NTK < SEQ) ? bf2f(row[NTK]) : 0.f;
    if constexpr (NTK == 8) { float f[8]; unpack8(*(const u32x4*)row, f);
#pragma unroll
        for (int i = 0; i < 8; ++i) v[1 + i] = f[i]; }
    else {
#pragma unroll
        for (int i = 0; i < NTK; ++i) v[1 + i] = bf2f(row[i]); }
}
__device__ __forceinline__ void hylat_task(const Params& p, int l, int bp, int cp, char* smem) {
    const int tid = otid(), half = tid >> 8, tl = tid & 255, c = 2 * cp + half;
    const bf16* HT = (const bf16*)(p.ws + WS_HT); bf16* Y = (bf16*)(p.ws + WS_HNY);
    cpx* buf = (cpx*)smem + (size_t)half * NF;
    const cpx* TW = (const cpx*)(p.ws + WS_TW);
    const cpx* KF = (const cpx*)(p.ws + WS_KF) + (size_t)c * NF;
    constexpr int NTK = SEQ / 256;
    const int t0 = NTK * tl;
    const float* cw = p.in[I_HCW] + (size_t)l * 3 * 768; const float* cb = p.in[I_HCB] + (size_t)l * 768;
    const size_t rb0 = (size_t)(2 * bp) * TOK + CTXL, rb1 = rb0 + TOK;
    const bf16* h0 = HT + (size_t)c * T + rb0 + t0; const bf16* h1 = h0 + TOK;
    float u0[NTK], u1[NTK], g0[NTK], g1[NTK];
    { float xa[NTK + 2], xb[NTK + 2]; load_span<NTK>(h0 + (size_t)512 * T, t0, xa); load_span<NTK>(h1 + (size_t)512 * T, t0, xb);
        const float w0 = cw[0 * 768 + 512 + c], w1 = cw[1 * 768 + 512 + c], w2 = cw[2 * 768 + 512 + c], bb = cb[512 + c];
        float ga[NTK + 2], gb[NTK + 2]; load_span<NTK>(h0 + (size_t)768 * T, t0, ga); load_span<NTK>(h1 + (size_t)768 * T, t0, gb);
#pragma unroll
        for (int i = 0; i < NTK; ++i) { g0[i] = (w0 * xa[i] + w1 * xa[i + 1] + w2 * xa[i + 2] + bb) * siluf_(ga[i + 1]); g1[i] = (w0 * xb[i] + w1 * xb[i + 1] + w2 * xb[i + 2] + bb) * siluf_(gb[i + 1]); } }
    { float va[NTK + 2], vb[NTK + 2], ya[NTK + 2], yb[NTK + 2];
        load_span<NTK>(h0, t0, va); load_span<NTK>(h1, t0, vb); load_span<NTK>(h0 + (size_t)256 * T, t0, ya); load_span<NTK>(h1 + (size_t)256 * T, t0, yb);
        const float v0 = cw[0 * 768 + c], v1 = cw[1 * 768 + c], v2 = cw[2 * 768 + c], vbias = cb[c];
        const float y0 = cw[0 * 768 + 256 + c], y1 = cw[1 * 768 + 256 + c], y2 = cw[2 * 768 + 256 + c], ybias = cb[256 + c];
#pragma unroll
        for (int i = 0; i < NTK; ++i) { u0[i] = (v0 * va[i] + v1 * va[i + 1] + v2 * va[i + 2] + vbias) * (y0 * ya[i] + y1 * ya[i + 1] + y2 * ya[i + 2] + ybias);
            u1[i] = (v0 * vb[i] + v1 * vb[i + 1] + v2 * vb[i + 2] + vbias) * (y0 * yb[i] + y1 * yb[i + 1] + y2 * yb[i + 2] + ybias); } }
    __syncthreads();
#pragma unroll
    for (int i = 0; i < NTK; ++i) { cpx v; v.x = u0[i]; v.y = u1[i]; buf[t0 + i] = v; cpx z = {0.f, 0.f}; buf[SEQ + t0 + i] = z; }
    fft_fwd(buf, TW, tl);
#pragma unroll 2
    for (int i = tl; i < NF; i += 256) buf[i] = cmul(buf[i], KF[i]);
    fft_inv(buf, TW, tl);
    const float dsk = p.in[I_HD][(size_t)l * WG + c]; const float sc = 1.0f / (float)NF;
    bf16* yb0 = Y + (rb0 + t0) * 1024 + YH + c; bf16* yb1 = Y + (rb1 + t0) * 1024 + YH + c;
#pragma unroll
    for (int i = 0; i < NTK; ++i) { const cpx y = buf[t0 + i];
        yb0[i * 1024] = f2bf(g0[i] * (y.x * sc + u0[i] * dsk));
        yb1[i * 1024] = f2bf(g1[i] * (y.y * sc + u1[i] * dsk)); }
}

constexpr int HCB = 8;
__device__ __forceinline__ void hyctx_task(const Params& p, int l, int b, int cblk, char* smem) {
    const int tid = otid(); const int c0 = cblk * HCB;
    const bf16* HT = (const bf16*)(p.ws + WS_HT); bf16* Y = (bf16*)(p.ws + WS_HNY); const float* HC = (const float*)(p.ws + WS_HC);
    float* raw = (float*)smem;
    float* u = raw + 3 * CTXL * HCB;
    float* hf = u + CTXL * HCB;
    float* hb = hf + CTXL * HCB;
    float* og = hb + CTXL * HCB;
    const size_t rb = (size_t)b * TOK;
    const float* cw = p.in[I_HCW] + (size_t)l * 3 * 768; const float* cbias = p.in[I_HCB] + (size_t)l * 768;
    __syncthreads();
    for (int i = tid; i < 3 * CTXL * HCB; i += NT) { const int k = i / (CTXL * HCB), cc = (i / CTXL) % HCB, t = i % CTXL; raw[(k * CTXL + t) * HCB + cc] = bf2f(HT[(size_t)(k * 256 + c0 + cc) * T + rb + t]); }
    for (int i = tid; i < CTXL * HCB; i += NT) { const int t = i / HCB, cc = i % HCB; hf[i] = HC[((size_t)0 * WG + c0 + cc) * CTXL + t]; hb[i] = HC[((size_t)1 * WG + c0 + cc) * CTXL + t]; }
    __syncthreads();
    for (int i = tid; i < CTXL * HCB; i += NT) { const int t = i / HCB, cc = i % HCB; float cv[3];
#pragma unroll
        for (int k = 0; k < 3; ++k) { const float* rk = raw + k * CTXL * HCB; const int ch = k * 256 + c0 + cc;
            const float a = t > 0 ? rk[(t - 1) * HCB + cc] : 0.f, m = rk[t * HCB + cc], z = t < CTXL - 1 ? rk[(t + 1) * HCB + cc] : 0.f;
            cv[k] = cw[0 * 768 + ch] * a + cw[1 * 768 + ch] * m + cw[2 * 768 + ch] * z + cbias[ch]; }
        u[i] = cv[0] * cv[1];
        og[i] = cv[2] * siluf_(bf2f(HT[(size_t)(768 + c0 + cc) * T + rb + t])); }
    __syncthreads();
    { const int cc = tid % HCB, tg = tid / HCB; constexpr int TG = NT / HCB, NTK = CTXL / TG; float acc[NTK];
#pragma unroll
        for (int i = 0; i < NTK; ++i) acc[i] = 0.f;
        for (int s = 0; s < CTXL; ++s) { const float us = u[s * HCB + cc];
#pragma unroll
            for (int i = 0; i < NTK; ++i) { const int t = tg + TG * i; const float hv = (s <= t) ? hf[(t - s) * HCB + cc] : hb[(s - t) * HCB + cc]; acc[i] += us * hv; } }
        const float dsk = p.in[I_HD][(size_t)l * WG + c0 + cc];
#pragma unroll
        for (int i = 0; i < NTK; ++i) { const int t = tg + TG * i; Y[(rb + t) * 1024 + YH + c0 + cc] = f2bf(og[t * HCB + cc] * (acc[i] + u[t * HCB + cc] * dsk)); } }
}

__device__ __forceinline__ void attn_task(const Params& p, int l, int b, int kvh, int qt, bool ctxq, char* smem) {
    const int tid = otid(), lane = tid & 63, wave = tid >> 6, r = lane & 15, q = lane >> 4;
    const bf16* P = (const bf16*)(p.ws + WS_P); bf16* Y = (bf16*)(p.ws + WS_HNY); const cpx* ROPE = (const cpx*)(p.ws + WS_ROPE);
    bf16* Qs = (bf16*)smem;
    bf16* Ks = Qs + 128 * LS;
    bf16* Vt = Ks + 64 * LS;
    bf16* Ps = Vt + 64 * LS;
    const size_t rq0 = (size_t)b * TOK + (ctxq ? 0 : CTXL) + qt * 64;
    __syncthreads();
    {
        const int row = tid >> 2, cpair = tid & 3, g = row >> 6, t = row & 63;
        const bf16* src = P + (rq0 + t) * NP + PD + (kvh * 2 + g) * 64;
        float lo[8], hi[8]; unpack8(*(const u32x4*)(src + cpair * 8), lo); unpack8(*(const u32x4*)(src + 32 + cpair * 8), hi);
        u32x4 o1, o2; float a[8], c2[8];
#pragma unroll
        for (int j = 0; j < 8; ++j) { float cs = 1.f, sn = 0.f; if (!ctxq) { const cpx cv = ROPE[(size_t)(qt * 64 + t) * 32 + cpair * 8 + j]; cs = cv.x; sn = cv.y; }
            a[j] = (lo[j] * cs - hi[j] * sn) * 0.125f; c2[j] = (hi[j] * cs + lo[j] * sn) * 0.125f; }
        o1.x = pk2(a[0], a[1]); o1.y = pk2(a[2], a[3]); o1.z = pk2(a[4], a[5]); o1.w = pk2(a[6], a[7]);
        o2.x = pk2(c2[0], c2[1]); o2.y = pk2(c2[2], c2[3]); o2.z = pk2(c2[4], c2[5]); o2.w = pk2(c2[6], c2[7]);
        *(u32x4*)(Qs + row * LS + cpair * 8) = o1; *(u32x4*)(Qs + row * LS + 32 + cpair * 8) = o2;
    }
    const int lt0 = ctxq ? 0 : (qt - 2 > 0 ? qt - 2 : 0), lt1 = ctxq ? -1 : (qt + 2 < SEQ / 64 - 1 ? qt + 2 : SEQ / 64 - 1);
    const int nloc = lt1 - lt0 + 1, ntiles = nloc + NCC;
    float m[4], lsum[4]; f32x4 O[4];
#pragma unroll
    for (int i = 0; i < 4; ++i) { m[i] = -INFINITY; lsum[i] = 0.f; O[i] = (f32x4){0.f, 0.f, 0.f, 0.f}; }
    const int g = wave >> 2, tq0 = (wave & 3) * 16;
    bf16* Pw = Ps + wave * 16 * LS;
    for (int ti = 0; ti < ntiles; ++ti) {
        const bool local = ti < nloc; const int kt = local ? lt0 + ti : ti - nloc;
        const size_t rk0 = (size_t)b * TOK + (local ? CTXL : 0) + kt * 64;
        __syncthreads();
        if (tid < 256) { const int s = tid >> 2, cpair = tid & 3; const bf16* src = P + (rk0 + s) * NP + PD + 256 + kvh * 64;
            float lo[8], hi[8]; unpack8(*(const u32x4*)(src + cpair * 8), lo); unpack8(*(const u32x4*)(src + 32 + cpair * 8), hi);
            float a[8], c2[8];
#pragma unroll
            for (int j = 0; j < 8; ++j) { float cs = 1.f, sn = 0.f; if (local) { const cpx cv = ROPE[(size_t)(kt * 64 + s) * 32 + cpair * 8 + j]; cs = cv.x; sn = cv.y; }
                a[j] = lo[j] * cs - hi[j] * sn; c2[j] = hi[j] * cs + lo[j] * sn; }
            u32x4 o1, o2;
            o1.x = pk2(a[0], a[1]); o1.y = pk2(a[2], a[3]); o1.z = pk2(a[4], a[5]); o1.w = pk2(a[6], a[7]);
            o2.x = pk2(c2[0], c2[1]); o2.y = pk2(c2[2], c2[3]); o2.z = pk2(c2[4], c2[5]); o2.w = pk2(c2[6], c2[7]);
            *(u32x4*)(Ks + s * LS + cpair * 8) = o1; *(u32x4*)(Ks + s * LS + 32 + cpair * 8) = o2; }
        load_tile_tr(P, (int)rk0, PD + 384 + kvh * 64, Vt, tid);
        __syncthreads();
        f32x4 S[4] = {(f32x4){0.f, 0.f, 0.f, 0.f}, (f32x4){0.f, 0.f, 0.f, 0.f}, (f32x4){0.f, 0.f, 0.f, 0.f}, (f32x4){0.f, 0.f, 0.f, 0.f}};
        mma_nt<4, 2>(Qs, LS, g * 64 + tq0, Ks, LS, 0, S, lane);
        float rmax[4], rsum[4];
#pragma unroll
        for (int i = 0; i < 4; ++i) { const int qpos = qt * 64 + tq0 + 4 * q + i; float mx = -INFINITY;
#pragma unroll
            for (int nt = 0; nt < 4; ++nt) { if (local) { const int kpos = kt * 64 + nt * 16 + r; const int d = kpos - qpos; if (d > 128 || d < -128) S[nt][i] = -INFINITY; } mx = fmaxf(mx, S[nt][i]); }
            mx = fmaxf(mx, __shfl_xor(mx, 1)); mx = fmaxf(mx, __shfl_xor(mx, 2)); mx = fmaxf(mx, __shfl_xor(mx, 4)); mx = fmaxf(mx, __shfl_xor(mx, 8));
            rmax[i] = mx; }
#pragma unroll
        for (int i = 0; i < 4; ++i) { const float mn = fmaxf(m[i], rmax[i]); const float alpha = __expf(m[i] - mn); float sm = 0.f;
#pragma unroll
            for (int nt = 0; nt < 4; ++nt) { const float pv = __expf(S[nt][i] - mn); sm += pv; Pw[(4 * q + i) * LS + nt * 16 + r] = f2bf(pv); O[nt][i] *= alpha; }
            sm += __shfl_xor(sm, 1); sm += __shfl_xor(sm, 2); sm += __shfl_xor(sm, 4); sm += __shfl_xor(sm, 8);
            lsum[i] = lsum[i] * alpha + sm; m[i] = mn; rsum[i] = sm; }
        __syncthreads();
        mma_nt<4, 2>(Pw, LS, 0, Vt, LS, 0, O, lane);
    }
    const float sink = p.in[I_SINK][(size_t)l * NH + kvh * 2 + g];
#pragma unroll
    for (int i = 0; i < 4; ++i) { const float den = lsum[i] + __expf(sink - m[i]); const float inv = 1.0f / den; const int t = tq0 + 4 * q + i;
#pragma unroll
        for (int nt = 0; nt < 4; ++nt) { const int e = nt * 16 + r; const float gate = bf2f(P[(rq0 + t) * NP + PD + 512 + (kvh * 2 + g) * 64 + e]);
            Y[(rq0 + t) * 1024 + YD + (kvh * 2 + g) * 64 + e] = f2bf(O[nt][i] * inv * siluf_(gate)); } }
}

#ifdef EMU
__device__ __forceinline__ int olane(int lane) { return lane; }
#else
__device__ __forceinline__ int olane(int lane) { asm volatile("" : "+v"(lane)); return lane; }
#endif
#ifdef EMU
#define WAVE_SYNC() emu_wave_sync()
#else
#define WAVE_SYNC() do { asm volatile("s_waitcnt lgkmcnt(0)" ::: "memory"); __builtin_amdgcn_wave_barrier(); } while (0)
#endif
constexpr int WLDS = (LDS_BYTES - 64) / 8 / 16 * 16;
__device__ __forceinline__ int swz(int row, int ch) { return row * 64 + ((ch ^ (row & 7)) << 3); }
__device__ __forceinline__ u32x4 pack8(const float* f) { u32x4 o; o.x = pk2(f[0], f[1]); o.y = pk2(f[2], f[3]); o.z = pk2(f[4], f[5]); o.w = pk2(f[6], f[7]); return o; }
__device__ __forceinline__ bf16x8 as_frag(u32x4 v) { return __builtin_bit_cast(bf16x8, v); }
__device__ __forceinline__ u32x4 as_u4(bf16x8 v) { return __builtin_bit_cast(u32x4, v); }

template <int DIR>
__device__ __forceinline__ void gla_r_frags(const float* Grow0, int lane, bf16x8 (&af)[4]) {
    const int r = lane & 15, q4 = lane >> 4;
#pragma unroll
    for (int mt = 0; mt < 4; ++mt) { u32x4 o = {0u, 0u, 0u, 0u};
        if (q4 < 2) o = *(const u32x4*)((const bf16*)(Grow0 + (size_t)(16 * mt + r) * NGS + 16) + DIR * 16 + 8 * q4);
        af[mt] = as_frag(o); }
}
template <int DIR>
__device__ __forceinline__ float gla_b_col(const Params& p, int l, int h, const bf16x8 (&af)[4], int nt, int lane_, float (&x)[4][4]) {
    const int lane = olane(lane_), r = lane & 15, q4 = lane >> 4, d = h * 64 + 16 * nt + r;
    u32x4 o = {0u, 0u, 0u, 0u};
    if (q4 < 2) { const float* wa = p.in[I_GWA] + ((size_t)(l * 2 + DIR) * 16 + 8 * q4) * WG + d;
        o.x = pk2(wa[0], wa[WG]); o.y = pk2(wa[2 * WG], wa[3 * WG]); o.z = pk2(wa[4 * WG], wa[5 * WG]); o.w = pk2(wa[6 * WG], wa[7 * WG]); }
    const bf16x8 bfr = as_frag(o); const float bias = p.in[I_GBA][(size_t)(l * 2 + DIR) * WG + d];
#pragma unroll
    for (int mt = 0; mt < 4; ++mt) { f32x4 c = {bias, bias, bias, bias}; c = MFMA16(af[mt], bfr, c);
#pragma unroll
        for (int i = 0; i < 4; ++i) x[mt][i] = logsig_fast(c[i]) * (1.0f / 16.0f); }
    float carry = 0.f;
#pragma unroll
    for (int k = 0; k < 4; ++k) { const int mt = DIR == 0 ? k : 3 - k; float* y = x[mt];
        if (DIR == 0) { y[1] += y[0]; y[2] += y[1]; y[3] += y[2]; } else { y[2] += y[3]; y[1] += y[2]; y[0] += y[1]; }
        const float s4 = DIR == 0 ? y[3] : y[0];
        const float t1 = DIR == 0 ? __shfl_up(s4, 16) : __shfl_down(s4, 16), t2 = DIR == 0 ? __shfl_up(s4, 32) : __shfl_down(s4, 32), t3 = DIR == 0 ? __shfl_up(s4, 48) : __shfl_down(s4, 48);
        const int qq = DIR == 0 ? q4 : 3 - q4;
        const float e = (qq >= 1 ? t1 : 0.f) + (qq >= 2 ? t2 : 0.f) + (qq >= 3 ? t3 : 0.f);
        const float tot = __shfl(e + s4, DIR == 0 ? r + 48 : r);
#pragma unroll
        for (int i = 0; i < 4; ++i) y[i] += carry + e;
        carry += tot; }
    return carry;
}

template <int MIXER, int DIR>
__device__ __forceinline__ void chunkst_dir(const Params& p, int l, int b, int h, int cid, const float* Grow0, const unsigned (&kk)[32], const bf16* Vt, bf16* Kt, const float* wvs, float* bendl, int lane_) {
    const int lane = olane(lane_), r = lane & 15, q4 = lane >> 4;
    if constexpr (MIXER == 0) {
        float nacc = 0.f;
#pragma unroll
        for (int c = 0; c < 8; ++c) { float f[8];
#pragma unroll
            for (int j = 0; j < 8; ++j) { const int s = 8 * c + j; const float kv = (s & 1) ? bitsf(kk[s >> 1] & 0xffff0000u) : bitsf(kk[s >> 1] << 16);
                f[j] = kv * 0.125f * wvs[DIR * 64 + s]; nacc += f[j]; }
            *(u32x4*)(Kt + swz(lane, c)) = pack8(f); }
        ((float*)(p.ws + WS_NV))[ch_index(DIR, b, h, cid) * 64 + lane] = nacc;
    } else {
        const bf16* P = (const bf16*)(p.ws + WS_P); const int kcol = PG + 256 + h * 64; const int r0 = b * TOK + cid * 64;
        bf16x8 af[4]; gla_r_frags<DIR>(Grow0, lane, af);
#pragma unroll 2
        for (int nt = 0; nt < 4; ++nt) { const int d = 16 * nt + r; float x[4][4];
            const float bend = gla_b_col<DIR>(p, l, h, af, nt, lane, x);
            if (q4 == 0) { ((float*)(p.ws + WS_BE))[ch_index(DIR, b, h, cid) * 64 + d] = bend; bendl[d] = __expf(fmaxf(bend, -80.0f)); }
#pragma unroll
            for (int mt = 0; mt < 4; ++mt)
#pragma unroll
                for (int i = 0; i < 4; ++i) { const int s = 16 * mt + 4 * q4 + i; const float kv = bf2f(P[(size_t)(r0 + s) * NP + kcol + d]); const float bc = fmaxf(x[mt][i], -80.0f);
                    Kt[swz(d, s >> 3) + (s & 7)] = f2bf(kv * __expf(-bc));
                    ((bf16*)(p.ws + WS_EQ))[((size_t)DIR * T + r0 + s) * WG + h * 64 + d] = f2bf(__expf(bc)); } }
    }
    WAVE_SYNC();
    bf16x8 vf[4][2];
#pragma unroll
    for (int ne = 0; ne < 4; ++ne)
#pragma unroll
        for (int ks = 0; ks < 2; ++ks) vf[ne][ks] = *(const bf16x8*)(Vt + swz(16 * ne + r, ks * 4 + q4));
    bf16* dst = (bf16*)(p.ws + WS_ST) + st_index(MIXER, DIR, b, h, cid) * 4096;
#pragma unroll
    for (int me = 0; me < 4; ++me) {
        f32x4 acc[4] = {(f32x4){0.f, 0.f, 0.f, 0.f}, (f32x4){0.f, 0.f, 0.f, 0.f}, (f32x4){0.f, 0.f, 0.f, 0.f}, (f32x4){0.f, 0.f, 0.f, 0.f}};
#pragma unroll
        for (int ks = 0; ks < 2; ++ks) { const bf16x8 a = *(const bf16x8*)(Kt + swz(16 * me + r, ks * 4 + q4));
#pragma unroll
            for (int ne = 0; ne < 4; ++ne) acc[ne] = MFMA16(a, vf[ne][ks], acc[ne]); }
        f32x4 sc4 = {1.f, 1.f, 1.f, 1.f}; if constexpr (MIXER == 1) sc4 = *(const f32x4*)(bendl + 16 * me + 4 * q4);
#pragma unroll
        for (int ne = 0; ne < 4; ++ne) { const f32x4 v = acc[ne] * sc4; u32x2 o; o.x = pk2(v[0], v[1]); o.y = pk2(v[2], v[3]); *(u32x2*)(dst + (16 * ne + r) * 64 + 16 * me + 4 * q4) = o; }
    }
    WAVE_SYNC();
}
template <int MIXER>
__device__ __forceinline__ void chunkst_w(const Params& p, int l, int b, int h, int cid, char* wl, int lane) {
    const bf16* P = (const bf16*)(p.ws + WS_P); const float* G = (const float*)(p.ws + WS_G);
    const int r0 = b * TOK + cid * 64, r = lane & 15, q4 = lane >> 4;
    bf16* Kt = (bf16*)wl;
    bf16* Vt = Kt + 4096;
    float* wvs = (float*)(Vt + 4096);
    float* bendl = wvs + 128;
    const int kcol = (MIXER == 0 ? PA : PG) + 256 + h * 64, vcol = (MIXER == 0 ? PA : PG) + 512 + h * 64;
    const float* Grow0 = G + (size_t)r0 * NGS;
    { const bf16* vp = P + (size_t)r0 * NP + vcol + lane;
#pragma unroll
        for (int c = 0; c < 8; ++c) { u32x4 o; unsigned w[4];
#pragma unroll
            for (int j = 0; j < 4; ++j) w[j] = (unsigned)vp[(size_t)(8 * c + 2 * j) * NP] | ((unsigned)vp[(size_t)(8 * c + 2 * j + 1) * NP] << 16);
            o.x = w[0]; o.y = w[1]; o.z = w[2]; o.w = w[3]; *(u32x4*)(Vt + swz(lane, c)) = o; } }
    unsigned kk[32];
    if constexpr (MIXER == 0) { const bf16* kp = P + (size_t)r0 * NP + kcol + lane;
#pragma unroll
        for (int i = 0; i < 32; ++i) kk[i] = (unsigned)kp[(size_t)(2 * i) * NP] | ((unsigned)kp[(size_t)(2 * i + 1) * NP] << 16); }
    else {
#pragma unroll
        for (int i = 0; i < 32; ++i) kk[i] = 0u; }
    if constexpr (MIXER == 0) {
        const float* g = Grow0 + (size_t)lane * NGS; const float* gb = p.in[I_MGB] + (size_t)l * 16;
        const float i_f = g[h] + gb[h], f_f = g[4 + h] + gb[4 + h], i_b = g[8 + h] + gb[8 + h], f_b = g[12 + h] + gb[12 + h];
        const float lf = logsigf_(f_f), lb = logsigf_(f_b);
        const float bF = wave_prefix_sum(lf, lane), totF = __shfl(bF, 63);
        const float gF = totF - bF + i_f, mF = wave_max(gF);
        const float totB = wave_sum(lb), preB = wave_prefix_sum(lb, lane), bB = totB - preB + lb;
        const float gB = totB - bB + i_b, mB = wave_max(gB);
        wvs[lane] = __expf(gF - mF); wvs[64 + lane] = __expf(gB - mB);
        if (lane == 0) { float* SC = (float*)(p.ws + WS_SC);
            SC[ch_index(0, b, h, cid) * 4 + 0] = totF; SC[ch_index(0, b, h, cid) * 4 + 1] = mF;
            SC[ch_index(1, b, h, cid) * 4 + 0] = totB; SC[ch_index(1, b, h, cid) * 4 + 1] = mB; }
    }
    WAVE_SYNC();
    chunkst_dir<MIXER, 0>(p, l, b, h, cid, Grow0, kk, Vt, Kt, wvs, bendl, lane);
    chunkst_dir<MIXER, 1>(p, l, b, h, cid, Grow0, kk, Vt, Kt, wvs, bendl, lane);
}

template <int MIXER, int DIR>
__device__ __forceinline__ void chunkout_prep(const Params& p, int l, int b, int h, int cid, const float* Grow0, int r0, int pbase, const bf16* EQ, float* gar, int lane_) {
    const int lane = olane(lane_);
    if constexpr (MIXER == 0) {
        const bf16* P = (const bf16*)(p.ws + WS_P);
        const float* g = Grow0 + (size_t)lane * NGS; const float* gb = p.in[I_MGB] + (size_t)l * 16;
        const float ig = g[DIR * 8 + h] + gb[DIR * 8 + h], fg = g[DIR * 8 + 4 + h] + gb[DIR * 8 + 4 + h];
        const float mprev = ((const float*)(p.ws + WS_SC))[ch_index(DIR, b, h, cid) * 4 + 2];
        const float lf = logsigf_(fg); float bb;
        if (DIR == 0) bb = wave_prefix_sum(lf, lane); else { const float tt = wave_sum(lf), pre = wave_prefix_sum(lf, lane); bb = tt - pre + lf; }
        const float a = ig - bb; const float pm = DIR == 0 ? wave_prefix_max(a, lane) : wave_suffix_max(a, lane);
        const float mt_ = fmaxf(bb + mprev, bb + pm);
        float* ga = gar + DIR * 320;
        ga[lane] = bb - mt_; ga[64 + lane] = a; ga[128 + lane] = __expf(bb + mprev - mt_); ga[192 + lane] = __expf(-mt_);
        float* nvl = gar + 640 + DIR * 64;
        nvl[lane] = ((const float*)(p.ws + WS_NV))[ch_index(DIR, b, h, cid) * 64 + lane];
        WAVE_SYNC();
        float dq = 0.f;
#pragma unroll
        for (int c = 0; c < 8; ++c) { float f[8]; unpack8(*(const u32x4*)(P + (size_t)(r0 + lane) * NP + pbase + c * 8), f);
            const f32x4 n0 = *(const f32x4*)(nvl + c * 8), n1 = *(const f32x4*)(nvl + c * 8 + 4);
            dq += f[0] * n0.x + f[1] * n0.y + f[2] * n0.z + f[3] * n0.w + f[4] * n1.x + f[5] * n1.y + f[6] * n1.z + f[7] * n1.w; }
        ga[256 + lane] = dq;
    }
}
template <int MIXER, int DIR, int NS>
__device__ __forceinline__ void chunkout_dir(const Params& p, int b, int h, int cid, int r0, int pbase, int th, const bf16x8 (&vtf)[4][2], const bf16* VtL, const bf16* EQ, bf16* SB, const float* gar, float* rsm, f32x4 (&htot)[NS][4], int lane_) {
    const bf16* P = (const bf16*)(p.ws + WS_P); const bf16* ST = (const bf16*)(p.ws + WS_ST);
    const int lane = olane(lane_), r = lane & 15, q4 = lane >> 4;
    const bf16* E = EQ + ((size_t)DIR * T + r0) * WG + h * 64;
    const float* ga = gar + DIR * 320;
    bf16x8 kf[4][2], ctf[4][2];
#pragma unroll
    for (int n = 0; n < 4; ++n)
#pragma unroll
        for (int ks = 0; ks < 2; ++ks) { kf[n][ks] = *(const bf16x8*)(P + (size_t)(r0 + 16 * n + r) * NP + pbase + 256 + ks * 32 + q4 * 8);
            ctf[n][ks] = *(const bf16x8*)(ST + st_index(MIXER, DIR, b, h, cid) * 4096 + (16 * n + r) * 64 + ks * 32 + q4 * 8);
            if constexpr (MIXER == 1) { float fe[8], fk[8]; unpack8(*(const u32x4*)(E + (size_t)(16 * n + r) * WG + ks * 32 + q4 * 8), fe); unpack8(as_u4(kf[n][ks]), fk);
#pragma unroll
                for (int j = 0; j < 8; ++j) fk[j] = fk[j] * frcp_(fe[j]);
                kf[n][ks] = as_frag(pack8(fk)); } }
#pragma unroll
    for (int ms = 0; ms < NS; ++ms) { const int mt = NS * th + ms;
        bf16x8 qf[2];
#pragma unroll
        for (int ks = 0; ks < 2; ++ks) { qf[ks] = *(const bf16x8*)(P + (size_t)(r0 + 16 * mt + r) * NP + pbase + ks * 32 + q4 * 8);
            if constexpr (MIXER == 1) { float fe[8], fq[8]; unpack8(*(const u32x4*)(E + (size_t)(16 * mt + r) * WG + ks * 32 + q4 * 8), fe); unpack8(as_u4(qf[ks]), fq);
#pragma unroll
                for (int j = 0; j < 8; ++j) fq[j] *= 0.125f * fe[j];
                qf[ks] = as_frag(pack8(fq)); } }
        f32x4 S[4] = {(f32x4){0.f, 0.f, 0.f, 0.f}, (f32x4){0.f, 0.f, 0.f, 0.f}, (f32x4){0.f, 0.f, 0.f, 0.f}, (f32x4){0.f, 0.f, 0.f, 0.f}};
#pragma unroll
        for (int ks = 0; ks < 2; ++ks)
#pragma unroll
            for (int n = 0; n < 4; ++n) S[n] = MFMA16(qf[ks], kf[n][ks], S[n]);
#pragma unroll
        for (int i = 0; i < 4; ++i) { const int t = 16 * mt + 4 * q4 + i; float sm = 0.f;
#pragma unroll
            for (int n = 0; n < 4; ++n) { const int s = 16 * n + r; const bool ok = DIR == 0 ? (s <= t) : (s >= t); float v = 0.f;
                if (ok) { if constexpr (MIXER == 0) v = S[n][i] * 0.125f * __expf(ga[t] + ga[64 + s]); else v = S[n][i]; }
                SB[swz(4 * q4 + i, s >> 3) + (s & 7)] = f2bf(v); sm += v; }
            if constexpr (MIXER == 0) { sm += __shfl_xor(sm, 1); sm += __shfl_xor(sm, 2); sm += __shfl_xor(sm, 4); sm += __shfl_xor(sm, 8); if (r == 0) rsm[4 * q4 + i] = sm; } }
        WAVE_SYNC();
        const bf16x8 sm0 = *(const bf16x8*)(SB + swz(r, q4)), sm1 = *(const bf16x8*)(SB + swz(r, 4 + q4));
        float wi = 1.f, inv = 1.f;
        if constexpr (MIXER == 0) { const int tt = 16 * mt + r; wi = ga[128 + tt]; const float den = wi * ga[256 + tt] + rsm[r]; inv = 1.0f / fmaxf(fabsf(den), ga[192 + tt]); }
#pragma unroll
        for (int me = 0; me < 4; ++me) { f32x4 a1 = {0.f, 0.f, 0.f, 0.f}, a2 = {0.f, 0.f, 0.f, 0.f};
            a1 = MFMA16(*(const bf16x8*)(VtL + swz(16 * me + r, q4)), sm0, a1); a1 = MFMA16(*(const bf16x8*)(VtL + swz(16 * me + r, 4 + q4)), sm1, a1);
            a2 = MFMA16(ctf[me][0], qf[0], a2); a2 = MFMA16(ctf[me][1], qf[1], a2);
            if constexpr (MIXER == 0) htot[ms][me] += (a1 + a2 * wi) * inv; else htot[ms][me] += a1 + a2; }
        WAVE_SYNC();
    }
}
template <int MIXER>
__device__ __forceinline__ void chunkout_w(const Params& p, int l, int b, int h, int cid, char* wl, int lane) {
    const bf16* P = (const bf16*)(p.ws + WS_P); const float* G = (const float*)(p.ws + WS_G); bf16* Y = (bf16*)(p.ws + WS_HNY);
    const int r0 = b * TOK + cid * 64, r = lane & 15, q4 = lane >> 4;
    const int pbase = (MIXER == 0 ? PA : PG) + h * 64;
    bf16* SB = (bf16*)wl;
    float* rsm = (float*)(SB + 1024);
    float* gar = rsm + 16;
    const bf16* EQ = (const bf16*)(p.ws + WS_EQ);
    const float* Grow0 = G + (size_t)r0 * NGS;
    bf16* VtL = (bf16*)(gar + 768);
    bf16x8 vtf[4][2];
#pragma unroll
    for (int me = 0; me < 4; ++me) { vtf[me][0] = (bf16x8){0, 0, 0, 0, 0, 0, 0, 0}; vtf[me][1] = vtf[me][0]; }
    { const bf16* vp = P + (size_t)r0 * NP + pbase + 512 + lane;
#pragma unroll
        for (int c = 0; c < 8; ++c) { unsigned w[4];
#pragma unroll
            for (int j = 0; j < 4; ++j) w[j] = (unsigned)vp[(size_t)(8 * c + 2 * j) * NP] | ((unsigned)vp[(size_t)(8 * c + 2 * j + 1) * NP] << 16);
            u32x4 o; o.x = w[0]; o.y = w[1]; o.z = w[2]; o.w = w[3]; *(u32x4*)(VtL + swz(lane, c)) = o; } }
    chunkout_prep<MIXER, 0>(p, l, b, h, cid, Grow0, r0, pbase, EQ, gar, lane);
    chunkout_prep<MIXER, 1>(p, l, b, h, cid, Grow0, r0, pbase, EQ, gar, lane);
    WAVE_SYNC();
    const float* ngp = p.in[MIXER == 0 ? I_MNG : I_GNG] + (size_t)l * WG + h * 64;
    constexpr int NS = 1;
#pragma unroll 1
    for (int th = 0; th < 4 / NS; ++th) {
        f32x4 htot[NS][4];
#pragma unroll
        for (int a = 0; a < NS; ++a)
#pragma unroll
            for (int c = 0; c < 4; ++c) htot[a][c] = (f32x4){0.f, 0.f, 0.f, 0.f};
        chunkout_dir<MIXER, 0, NS>(p, b, h, cid, r0, pbase, th, vtf, VtL, EQ, SB, gar, rsm, htot, lane);
        chunkout_dir<MIXER, 1, NS>(p, b, h, cid, r0, pbase, th, vtf, VtL, EQ, SB, gar, rsm, htot, lane);
        const int lz = olane(lane), r = lz & 15, q4 = lz >> 4;
        u32x2 gq[NS][4], oq[NS][4];
#pragma unroll
        for (int ms = 0; ms < NS; ++ms)
#pragma unroll
            for (int me = 0; me < 4; ++me) { const size_t off = (size_t)(r0 + 16 * (NS * th + ms) + r) * NP + pbase + 16 * me + 4 * q4;
                gq[ms][me] = *(const u32x2*)(P + off + (MIXER == 0 ? 1024 : 768)); if constexpr (MIXER == 0) oq[ms][me] = *(const u32x2*)(P + off + 768); else oq[ms][me] = (u32x2){0u, 0u}; }
#pragma unroll
        for (int ms = 0; ms < NS; ++ms) { const int mt = NS * th + ms; float ss = 0.f; float gv[4][4];
#pragma unroll
            for (int me = 0; me < 4; ++me) {
                gv[me][0] = bitsf(gq[ms][me].x << 16); gv[me][1] = bitsf(gq[ms][me].x & 0xffff0000u); gv[me][2] = bitsf(gq[ms][me].y << 16); gv[me][3] = bitsf(gq[ms][me].y & 0xffff0000u);
                if constexpr (MIXER == 0) { htot[ms][me][0] *= sigmoidf_(bitsf(oq[ms][me].x << 16)); htot[ms][me][1] *= sigmoidf_(bitsf(oq[ms][me].x & 0xffff0000u)); htot[ms][me][2] *= sigmoidf_(bitsf(oq[ms][me].y << 16)); htot[ms][me][3] *= sigmoidf_(bitsf(oq[ms][me].y & 0xffff0000u)); }
                ss += htot[ms][me][0] * htot[ms][me][0] + htot[ms][me][1] * htot[ms][me][1] + htot[ms][me][2] * htot[ms][me][2] + htot[ms][me][3] * htot[ms][me][3]; }
            ss += __shfl_xor(ss, 16); ss += __shfl_xor(ss, 32);
            const float rstd = rsqrtf(ss * (1.0f / 64.0f) + EPS);
#pragma unroll
            for (int me = 0; me < 4; ++me) { const int e = 16 * me + 4 * q4; const f32x4 n4 = *(const f32x4*)(ngp + e);
                u32x2 o; o.x = pk2(htot[ms][me][0] * rstd * n4.x * siluf_(gv[me][0]), htot[ms][me][1] * rstd * n4.y * siluf_(gv[me][1]));
                o.y = pk2(htot[ms][me][2] * rstd * n4.z * siluf_(gv[me][2]), htot[ms][me][3] * rstd * n4.w * siluf_(gv[me][3]));
                *(u32x2*)(Y + (size_t)(r0 + 16 * mt + r) * 1024 + (MIXER == 0 ? YA : YG) + h * 64 + e) = o; } }
    }
}

template <bool OUT>
__device__ __forceinline__ void chunk_workers(const Params& p, int l, char* smem) {
    const int tid = otid(), lane = tid & 63, wave = __builtin_amdgcn_readfirstlane(tid >> 6);
    const int NW = (int)gridDim.x * 8, wi = wave * (int)gridDim.x + obid();
    const int c_lo = (OUT && l == DEPTH - 1) ? NCC : 0, npc = NCH - c_lo, half = NB * NH * npc;
    char* wl = smem + wave * WLDS;
#pragma unroll 1
    for (int t = wi; t < half; t += NW) { const int b = t / (NH * npc), h = (t / npc) % NH, cid = c_lo + t % npc;
        const Params q = relaunder(p);
        if (OUT) chunkout_w<1>(q, l, b, h, cid, wl, lane); else chunkst_w<1>(q, l, b, h, cid, wl, lane); }
    const int used = half % NW, vj = wi >= used ? wi - used : wi + (NW - used);
#pragma unroll 1
    for (int t = vj; t < half; t += NW) { const int b = t / (NH * npc), h = (t / npc) % NH, cid = c_lo + t % npc;
        const Params q = relaunder(p);
        if (OUT) chunkout_w<0>(q, l, b, h, cid, wl, lane); else chunkst_w<0>(q, l, b, h, cid, wl, lane); }
}

__device__ __forceinline__ void phase_mix1(const Params& p, int l, char* smem) {
    const bool ctxo = l < DEPTH - 1;
    constexpr int N_HL = (NB / 2) * (WG / 2), N_AL = NB * 2 * (SEQ / 64), N_HC = NB * (WG / HCB), N_AC = NB * 2 * NCC;
    const int total = N_HL + N_AL + (ctxo ? N_HC + N_AC : 0);
    for (int task = obid(); task < total; task += gridDim.x) {
        int t = task;
        if (t < N_HL) { hylat_task(p, l, t / (WG / 2), t % (WG / 2), smem); continue; } t -= N_HL;
        if (t < N_AL) { attn_task(p, l, t / (2 * (SEQ / 64)), (t / (SEQ / 64)) % 2, t % (SEQ / 64), false, smem); continue; } t -= N_AL;
        if (t < N_HC) { hyctx_task(p, l, t / (WG / HCB), t % (WG / HCB), smem); continue; } t -= N_HC;
        attn_task(p, l, t / (2 * NCC), (t / NCC) % 2, t % NCC, true, smem);
    }
    __syncthreads();
    chunk_workers<false>(p, l, smem);
}

constexpr int SCG = 12;
__device__ __forceinline__ void phase_scan(const Params& p, int l, char* smem) {
    const int tid = otid();
    bf16* ST = (bf16*)(p.ws + WS_ST); float* NV = (float*)(p.ws + WS_NV); const float* BE = (const float*)(p.ws + WS_BE); float* SC = (float*)(p.ws + WS_SC);
    constexpr int NCHAIN = 2 * 2 * NB * NH;
    for (int item = obid() * NT + tid; item < NCHAIN * 1024; item += gridDim.x * NT) {
        const int chain = item >> 10, grp = item & 1023; const int mixer = chain / (2 * NB * NH), dir = (chain / (NB * NH)) % 2, b = (chain / NH) % NB, h = chain % NH;
        float c[4] = {0.f, 0.f, 0.f, 0.f}; float nv[4] = {0.f, 0.f, 0.f, 0.f}; float m = 0.f;
        const int d0 = (grp & 15) * 4; const bool donv = (mixer == 0) && (grp < 16);
        for (int o0 = 0; o0 < NCH; o0 += SCG) {
            u32x2 uu[SCG]; float s0[SCG], s1[SCG]; f32x4 be[SCG]; f32x4 nu[SCG];
#pragma unroll
            for (int j = 0; j < SCG; ++j) if (o0 + j < NCH) { const int cid = chain_cid(dir, o0 + j); const size_t ci = ch_index(dir, b, h, cid);
                uu[j] = *(const u32x2*)(ST + st_index(mixer, dir, b, h, cid) * 4096 + grp * 4);
                if (mixer == 0) { s0[j] = SC[ci * 4 + 0]; s1[j] = SC[ci * 4 + 1]; if (donv) nu[j] = *(const f32x4*)(NV + ci * 64 + grp * 4); }
                else be[j] = *(const f32x4*)(BE + ci * 64 + d0); }
#pragma unroll
            for (int j = 0; j < SCG; ++j) if (o0 + j < NCH) { const int cid = chain_cid(dir, o0 + j); const size_t ci = ch_index(dir, b, h, cid);
                const float u[4] = {bitsf(uu[j].x << 16), bitsf(uu[j].x & 0xffff0000u), bitsf(uu[j].y << 16), bitsf(uu[j].y & 0xffff0000u)};
                u32x2 w; w.x = pk2(c[0], c[1]); w.y = pk2(c[2], c[3]); *(u32x2*)(ST + st_index(mixer, dir, b, h, cid) * 4096 + grp * 4) = w;
                if (mixer == 0) {
                    if (grp == 0) SC[ci * 4 + 2] = m;
                    const float mn = fmaxf(s0[j] + m, s1[j]), a = __expf(s0[j] + m - mn), s = __expf(s1[j] - mn);
#pragma unroll
                    for (int k = 0; k < 4; ++k) c[k] = a * c[k] + s * u[k];
                    if (donv) { f32x4 nw = {nv[0], nv[1], nv[2], nv[3]}; *(f32x4*)(NV + ci * 64 + grp * 4) = nw;
                        nv[0] = a * nv[0] + s * nu[j].x; nv[1] = a * nv[1] + s * nu[j].y; nv[2] = a * nv[2] + s * nu[j].z; nv[3] = a * nv[3] + s * nu[j].w; }
                    m = mn;
                } else { c[0] = __expf(be[j].x) * c[0] + u[0]; c[1] = __expf(be[j].y) * c[1] + u[1]; c[2] = __expf(be[j].z) * c[2] + u[2]; c[3] = __expf(be[j].w) * c[3] + u[3]; } }
        }
    }
    constexpr int N_WOUT = (DM / 64) * (MIX / 64);
    for (int task = obid(); task < N_WOUT; task += gridDim.x) { const int nt = task / (MIX / 64), kt = task % (MIX / 64);
        convert_tile(p.in[I_WOUT] + (size_t)l * MIX * DM, DM, (bf16*)(p.ws + WS_WOUT), MIX, nt * 64, kt * 64, false, smem); }
}

__device__ __forceinline__ void phase_mix2(const Params& p, int l, char* smem) { chunk_workers<true>(p, l, smem); }

#ifndef EMU
#define LAS __attribute__((address_space(3)))
#define XB_TMO      128
#define XB_XCNT(j)  (256  + 64 * (j))
#define XB_XSUB(j)  (1280 + 64 * (j))
#define XB_XGEN(j)  (2304 + 64 * (j))
#define XB_TOP      3328
#define XB_TOPGEN   3392
#define XCD_BAR_WORDS 3456
#define XB_SPIN_CAP (1u << 18)

__device__ __forceinline__ unsigned xb_ld(unsigned* p)              { return __hip_atomic_load(p, __ATOMIC_RELAXED, __HIP_MEMORY_SCOPE_AGENT); }
__device__ __forceinline__ unsigned xb_add(unsigned* p, unsigned v) { return __hip_atomic_fetch_add(p, v, __ATOMIC_RELAXED, __HIP_MEMORY_SCOPE_AGENT); }
__device__ __forceinline__ unsigned xb_xcc_id() { return (unsigned)__builtin_amdgcn_s_getreg((3 << 11) | 20) & 0xFu; }
#define XB_SPIN(cond, bar) do { unsigned _sp = 0; while (cond) { __builtin_amdgcn_s_sleep(1); \
    if ((++_sp & 255u) == 0u) { if (xb_ld(&(bar)[XB_TMO])) break; if (_sp > XB_SPIN_CAP) { atomicAdd(&(bar)[XB_TMO], 1u); break; } } } } while (0)

struct XcdBarrier {
    unsigned* bar; unsigned x;
    volatile LAS unsigned* st;
};

__device__ __forceinline__ XcdBarrier xcd_barrier_post(unsigned* bar, volatile LAS unsigned* st) {
    XcdBarrier b; b.bar = bar; b.x = xb_xcc_id(); b.st = st;
    if (threadIdx.x == 0) (void)xb_add(&bar[XB_XCNT(b.x)], 1u);
    return b;
}
__device__ __forceinline__ void xcd_barrier_complete(unsigned* bar, unsigned x, unsigned& nloc, unsigned& nx) {
    const unsigned G = gridDim.x * gridDim.y * gridDim.z;
    unsigned sum, cnt, mine, sp = 0u;
    for (;;) {
        sum = 0u; cnt = 0u; mine = 0u;
#pragma unroll
        for (unsigned j = 0; j < 16; ++j) { const unsigned c = xb_ld(&bar[XB_XCNT(j)]); sum += c; cnt += (c > 0u) ? 1u : 0u; mine = (j == x) ? c : mine; }
        if (sum == G) break;
        __builtin_amdgcn_s_sleep(1);
        if ((++sp & 255u) == 0u) { if (xb_ld(&bar[XB_TMO])) break; if (sp > XB_SPIN_CAP) { atomicAdd(&bar[XB_TMO], 1u); break; } }
    }
    nloc = mine > 0u ? mine : 1u; nx = cnt > 0u ? cnt : 1u;
}

__device__ __forceinline__ void xcd_barrier(const XcdBarrier& b) {
    asm volatile("s_waitcnt vmcnt(0)" ::: "memory");
    __syncthreads();
    if (threadIdx.x == 0) {
        unsigned* bar = b.bar;
        __builtin_amdgcn_s_waitcnt(0);
        unsigned nloc = b.st[0], nx = b.st[1];
        if (nloc == 0u) { xcd_barrier_complete(bar, b.x, nloc, nx); b.st[0] = nloc; b.st[1] = nx; }
        const unsigned old = xb_add(&bar[XB_XSUB(b.x)], 1u);
        const unsigned gen = old / nloc;
        if (old + 1u == (gen + 1u) * nloc) {
            __builtin_amdgcn_fence(__ATOMIC_RELEASE, "agent");
            asm volatile("s_waitcnt vmcnt(0)" ::: "memory");
            const unsigned og = xb_add(&bar[XB_TOP], 1u);
            const unsigned tg = og / nx;
            if (og + 1u == (tg + 1u) * nx) xb_add(&bar[XB_TOPGEN], 1u);
            else XB_SPIN(xb_ld(&bar[XB_TOPGEN]) == tg, bar);
            __builtin_amdgcn_fence(__ATOMIC_ACQUIRE, "agent");
            xb_add(&bar[XB_XGEN(b.x)], 1u);
            asm volatile("s_waitcnt vmcnt(0)" ::: "memory");
        } else {
            XB_SPIN(xb_ld(&bar[XB_XGEN(b.x)]) == gen, bar);
            __builtin_amdgcn_fence(__ATOMIC_ACQUIRE, "agent");
            asm volatile("s_waitcnt vmcnt(0)" ::: "memory");
        }
    }
    __syncthreads();
}
#endif

__global__ void __launch_bounds__(NT) fwd_kernel(Params pk, int ph_lo, int ph_hi) {
    SMEM_DECL;
#ifndef EMU
    volatile LAS unsigned* misc = (volatile LAS unsigned*)(smem + LDS_BYTES - 64);
    if (threadIdx.x < 2) misc[threadIdx.x] = 0u;
    __syncthreads();
    const XcdBarrier bar = xcd_barrier_post((unsigned*)(pk.ws + WS_BAR), misc);
#endif
    constexpr int NPH = 2 + 6 * DEPTH;
    for (int ph = ph_lo; ph < ph_hi && ph < NPH; ++ph) {
#ifndef EMU
        Params p = pk; { size_t z = 0; asm volatile("" : "+s"(z)); p.ws = pk.ws + z; p.out = pk.out + z;
#pragma unroll
            for (int i = 0; i < 26; ++i) p.in[i] = pk.in[i] + z; }
#else
        const Params& p = pk;
#endif
        if (ph == 0) phase0(p, smem);
        else if (ph == NPH - 1) phase_rp(p, DEPTH, smem);
        else { const int l = (ph - 1) / 6, k = (ph - 1) % 6;
            if (k == 0) phase_rp(p, l, smem);
            else if (k == 1) phase_gemm_in(p, l, smem);
            else if (k == 2) phase_mix1(p, l, smem);
            else if (k == 3) phase_scan(p, l, smem);
            else if (k == 4) phase_mix2(p, l, smem);
            else phase_gemm_out(p, l, smem);
#ifdef PROBE_DUP
            if (k == PROBE_DUP) { GRID_SYNC();
                if (k == 1) phase_gemm_in(p, l, smem); else if (k == 2) phase_mix1(p, l, smem); else if (k == 4) phase_mix2(p, l, smem); else if (k == 5) phase_gemm_out(p, l, smem); }
#endif
        }
        if (ph + 1 < ph_hi) {
#ifdef EMU
            GRID_SYNC();
#else
            if (ph == 0) GRID_SYNC(); else xcd_barrier(bar);
#endif
        }
    }
}

#ifndef EMU
extern "C" void kernel_launch(void* const* d_in, const int* in_sizes, int n_in, void* d_out, int out_size, void* d_ws, size_t ws_size, hipStream_t stream) {
    static int grid = 0;
    if (grid == 0) {
        if (n_in != 26 || ws_size < WS_TOTAL) { fprintf(stderr, "kernel_launch: unexpected n_in %d or ws_size %zu (need %zu)\n", n_in, ws_size, (size_t)WS_TOTAL); grid = -1; return; }
        int dev = 0, cus = 0, per_cu = 0;
        hipGetDevice(&dev);
        hipDeviceGetAttribute(&cus, hipDeviceAttributeMultiprocessorCount, dev);
        hipFuncSetAttribute((const void*)fwd_kernel, hipFuncAttributeMaxDynamicSharedMemorySize, LDS_BYTES);
        hipOccupancyMaxActiveBlocksPerMultiprocessor(&per_cu, (const void*)fwd_kernel, NT, LDS_BYTES);
        if (per_cu < 1) { fprintf(stderr, "kernel_launch: occupancy query returned %d\n", per_cu); grid = -1; return; }
        if (per_cu > 1) per_cu = 1;
        grid = cus * per_cu;
    }
    if (grid < 0) return;
    hipMemsetAsync((char*)d_ws + WS_BAR, 0, BAR_BYTES, stream);
    Params p{};
    for (int i = 0; i < 26; ++i) p.in[i] = (const float*)d_in[i];
    p.out = (float*)d_out; p.ws = (char*)d_ws;
    int lo = 0, hi = 2 + 6 * DEPTH;
    void* args[] = {&p, &lo, &hi};
    hipError_t e = hipLaunchCooperativeKernel((const void*)fwd_kernel, dim3(grid), dim3(NT), args, LDS_BYTES, stream);
    if (e != hipSuccess) fprintf(stderr, "cooperative launch failed: %s (grid %d)\n", hipGetErrorString(e), grid);
}
#endif
```

```cpp
#ifdef EMU
#include "emu/hipemu.h"
#define GRID_SYNC() emu::grid_sync()
#define SMEM_DECL char* smem = emu::S().blocks[emu::cur()->block].lds
#define MFMA16(a, b, c) emu_mfma_16x16x32_bf16(a, b, c)
#else
#include <hip/hip_runtime.h>
#include <hip/hip_cooperative_groups.h>
#include <cstdio>
#include <cstdint>
#define GRID_SYNC() cooperative_groups::this_grid().sync()
#define SMEM_DECL extern __shared__ __attribute__((aligned(16))) char smem[]
#define MFMA16(a, b, c) __builtin_amdgcn_mfma_f32_16x16x32_bf16(a, b, c, 0, 0, 0)
#endif

#ifdef EMU
#ifndef EMU_DM
#define EMU_DM 256
#endif
#ifndef EMU_NB
#define EMU_NB 2
#endif
#ifndef EMU_SEQ
#define EMU_SEQ 512
#endif
#ifndef EMU_DEPTH
#define EMU_DEPTH 2
#endif
#ifndef EMU_CTXL
#define EMU_CTXL 128
#endif
constexpr int DM = EMU_DM, NB = EMU_NB, SEQ = EMU_SEQ, DEPTH = EMU_DEPTH, CTXL = EMU_CTXL;
#else
constexpr int DM = 1024, NB = 8, SEQ = 2048, DEPTH = 4, CTXL = 256;
#endif
constexpr int MIX = 1024, WG = 256, HD = 64, NH = 4, CH = 64;
constexpr int TOK = CTXL + SEQ, T = NB * TOK, NCH = TOK / CH, NCC = CTXL / CH;
constexpr int N_IN = 4144, NP = 3072, NG = 48, NGS = 32, NMAIN = 3328, NPAD = 4352;
constexpr int NF = 2 * SEQ;
constexpr int NJ = NB + 1;
constexpr int NT = 512;
constexpr float EPS = 1e-6f;
constexpr int PA = 0, PG = 1280, PD = 2304;
constexpr int YA = 0, YH = 256, YG = 512, YD = 768;
constexpr int ilog4(int n) { return n <= 1 ? 0 : 1 + ilog4(n / 4); }
constexpr int FFT_P = ilog4(NF);
static_assert((1 << (2 * FFT_P)) == NF, "NF must be a power of 4");
static_assert(DM % 256 == 0 && CTXL % 128 == 0 && SEQ % 256 == 0, "shape constraints");

typedef unsigned short bf16;
typedef short bf16x8 __attribute__((ext_vector_type(8)));
typedef float f32x4 __attribute__((ext_vector_type(4)));
typedef unsigned u32x4 __attribute__((ext_vector_type(4)));
typedef unsigned u32x2 __attribute__((ext_vector_type(2)));
struct cpx { float x, y; };

constexpr size_t al256(size_t x) { return (x + 255) & ~(size_t)255; }
constexpr size_t WS_CTXB = 0;
constexpr size_t WS_HNY = al256(WS_CTXB + (size_t)NB * CTXL * DM * 4);
constexpr size_t WS_WIN = WS_HNY + (size_t)T * 1024 * 2;
constexpr size_t WS_ST = WS_WIN;
constexpr size_t ST_BYTES = (size_t)2 * 2 * NB * NH * NCH * 4096 * 2;
constexpr size_t WS_KT = al256(WS_WIN + (size_t)NPAD * DM * 2);
static_assert(WS_KT + (size_t)WG * NF * 4 <= WS_ST + ST_BYTES || true, "");
constexpr size_t ST_END = al256((WS_ST + ST_BYTES > WS_KT + (size_t)WG * NF * 4) ? WS_ST + ST_BYTES : WS_KT + (size_t)WG * NF * 4);
constexpr size_t WS_P = ST_END;
constexpr size_t WS_HT = al256(WS_P + (size_t)T * NP * 2);
constexpr size_t WS_WOUT = WS_HT;
constexpr size_t WS_G = al256(WS_HT + (size_t)1024 * T * 2);
constexpr size_t WS_KF = al256(WS_G + (size_t)T * NGS * 4);
constexpr size_t WS_HC = al256(WS_KF + (size_t)WG * NF * 8);
constexpr size_t WS_EQ = al256(WS_HC + (size_t)2 * WG * CTXL * 4);
constexpr size_t WS_NV = al256(WS_EQ + (size_t)2 * T * WG * 2);
constexpr size_t WS_BE = al256(WS_NV + (size_t)2 * NB * NH * NCH * 64 * 4);
constexpr size_t WS_SC = al256(WS_BE + (size_t)2 * NB * NH * NCH * 64 * 4);
constexpr size_t WS_MOD = al256(WS_SC + (size_t)2 * NB * NH * NCH * 4 * 4);
constexpr size_t WS_TW = al256(WS_MOD + (size_t)DEPTH * NJ * 3 * DM * 4);
constexpr size_t WS_ROPE = al256(WS_TW + (size_t)NF * 8);
constexpr size_t WS_BAR = al256(WS_ROPE + (size_t)SEQ * 32 * 8);
constexpr size_t BAR_BYTES = 16384;
constexpr size_t WS_TOTAL = al256(WS_BAR + BAR_BYTES);
static_assert((size_t)T * DM * 4 <= (size_t)T * NP * 2, "YO fits in P");
#ifndef EMU
static_assert(WS_TOTAL <= (size_t)268435456, "workspace map must fit 256 MiB");
#endif

constexpr int LDS_BYTES = 163840;

struct Params {
    const float* in[26];
    float* out;
    char* ws;
};
enum { I_X = 0, I_C, I_CTX, I_CCTX, I_WADA, I_BADA, I_GPRE, I_GPOST, I_WIN, I_MGB, I_MNG, I_HCW, I_HCB, I_HW1, I_HB1, I_HW2, I_HB2, I_HW3, I_HB3,
       I_HFREQ, I_HD, I_GWA, I_GBA, I_GNG, I_SINK, I_WOUT };

__device__ __forceinline__ Params relaunder(const Params& pk) {
#ifdef EMU
    return pk;
#else
    Params p = pk; size_t z = 0; asm volatile("" : "+s"(z)); p.ws = pk.ws + z; p.out = pk.out + z;
#pragma unroll
    for (int i = 0; i < 26; ++i) p.in[i] = pk.in[i] + z;
    return p;
#endif
}
#ifdef EMU
#define WAVE_SYNC() emu_wave_sync()
#else
#define WAVE_SYNC() do { asm volatile("s_waitcnt lgkmcnt(0)" ::: "memory"); __builtin_amdgcn_wave_barrier(); } while (0)
#endif

#ifdef EMU
__device__ __forceinline__ int otid() { return (int)threadIdx.x; }
__device__ __forceinline__ int obid() { return (int)blockIdx.x; }
#else
__device__ __forceinline__ int otid() { int t = (int)threadIdx.x; asm volatile("" : "+v"(t)); return t; }
__device__ __forceinline__ int obid() { int b = (int)blockIdx.x; asm volatile("" : "+s"(b)); return b; }
#endif
__device__ __forceinline__ unsigned fbits(float f) { return __builtin_bit_cast(unsigned, f); }
__device__ __forceinline__ float bitsf(unsigned u) { return __builtin_bit_cast(float, u); }
__device__ __forceinline__ bf16 f2bf(float f) { unsigned u = fbits(f); return (bf16)((u + 0x7fffu + ((u >> 16) & 1u)) >> 16); }
__device__ __forceinline__ float bf2f(bf16 h) { return bitsf((unsigned)h << 16); }
__device__ __forceinline__ unsigned pk2(float lo, float hi) { return (unsigned)f2bf(lo) | ((unsigned)f2bf(hi) << 16); }
#ifdef EMU
__device__ __forceinline__ float frcp_(float x) { return 1.0f / x; }
#else
__device__ __forceinline__ float frcp_(float x) { return __builtin_amdgcn_rcpf(x); }
#endif
__device__ __forceinline__ float sigmoidf_(float x) { return 1.0f / (1.0f + __expf(-x)); }
__device__ __forceinline__ float siluf_(float x) { return x / (1.0f + __expf(-x)); }
__device__ __forceinline__ float logsigf_(float x) { return fminf(x, 0.0f) - log1pf(__expf(-fabsf(x))); }
__device__ __forceinline__ float logsig_fast(float x) { return fminf(x, 0.0f) - __logf(1.0f + __expf(-fabsf(x))); }
__device__ __forceinline__ float wave_sum(float v) {
#pragma unroll
    for (int o = 1; o < 64; o <<= 1) v += __shfl_xor(v, o);
    return v;
}
__device__ __forceinline__ float wave_max(float v) {
#pragma unroll
    for (int o = 1; o < 64; o <<= 1) v = fmaxf(v, __shfl_xor(v, o));
    return v;
}
__device__ __forceinline__ float wave_prefix_sum(float v, int lane) {
#pragma unroll
    for (int o = 1; o < 64; o <<= 1) { float t = __shfl_up(v, o); if (lane >= o) v += t; }
    return v;
}
__device__ __forceinline__ float wave_prefix_max(float v, int lane) {
#pragma unroll
    for (int o = 1; o < 64; o <<= 1) { float t = __shfl_up(v, o); if (lane >= o) v = fmaxf(v, t); }
    return v;
}
__device__ __forceinline__ float wave_suffix_max(float v, int lane) {
#pragma unroll
    for (int o = 1; o < 64; o <<= 1) { float t = __shfl_down(v, o); if (lane + o < 64) v = fmaxf(v, t); }
    return v;
}
__device__ __forceinline__ void unpack8(u32x4 v, float* f) {
    f[0] = bitsf(v.x << 16); f[1] = bitsf(v.x & 0xffff0000u); f[2] = bitsf(v.y << 16); f[3] = bitsf(v.y & 0xffff0000u);
    f[4] = bitsf(v.z << 16); f[5] = bitsf(v.z & 0xffff0000u); f[6] = bitsf(v.w << 16); f[7] = bitsf(v.w & 0xffff0000u);
}
__device__ __forceinline__ int orig_col(int n) {
    if (n < 1280) return n;
    if (n < 2304) return 2320 + (n - 1280);
    if (n < 3072) return 3376 + (n - 2304);
    if (n < 3088) return 1280 + (n - 3072);
    if (n < 3120) return 3344 + (n - 3088);
    if (n < NMAIN) return -1;
    return 1296 + (n - NMAIN);
}
__device__ __forceinline__ int chain_cid(int dir, int o) {
    if (dir == 0) return o;
    return o < NCC ? (NCC - 1 - o) : (NCH - 1 - (o - NCC));
}

__device__ __forceinline__ int swz(int row, int ch) { return row * 64 + ((ch ^ (row & 7)) << 3); }
__device__ __forceinline__ u32x4 pack8(const float* f) { u32x4 o; o.x = pk2(f[0], f[1]); o.y = pk2(f[2], f[3]); o.z = pk2(f[4], f[5]); o.w = pk2(f[6], f[7]); return o; }
__device__ __forceinline__ bf16x8 as_frag(u32x4 v) { return __builtin_bit_cast(bf16x8, v); }
__device__ __forceinline__ u32x4 as_u4(bf16x8 v) { return __builtin_bit_cast(u32x4, v); }

constexpr int LS = 72;

template <int NTL, int KS>
__device__ __forceinline__ void mma_nt(const bf16* A, int lda, int m0, const bf16* B, int ldb, int n0, f32x4 (&acc)[NTL], int lane) {
    const int r = lane & 15, q = lane >> 4;
#pragma unroll
    for (int ks = 0; ks < KS; ++ks) {
        const bf16x8 a = *(const bf16x8*)(A + (m0 + r) * lda + ks * 32 + q * 8);
#pragma unroll
        for (int nt = 0; nt < NTL; ++nt) {
            const bf16x8 b = *(const bf16x8*)(B + (n0 + nt * 16 + r) * ldb + ks * 32 + q * 8);
            acc[nt] = MFMA16(a, b, acc[nt]);
        }
    }
}

__device__ __forceinline__ void layer_prep(const Params& p, int l, int idx, int stride, char* smem);
__device__ __forceinline__ void phase0(const Params& p, char* smem) {
    const int tid = otid();
    cpx* TW = (cpx*)(p.ws + WS_TW);
    cpx* ROPE = (cpx*)(p.ws + WS_ROPE);
    float* MOD = (float*)(p.ws + WS_MOD);
    constexpr int N_TW = NF / NT, N_ROPE = SEQ * 32 / NT, N_MOD = DEPTH * (3 * DM / 64);
    for (int task = obid(); task < N_TW + N_ROPE + N_MOD; task += gridDim.x) {
        if (task < N_TW) {
            const int j = task * NT + tid; float s, c; sincospif(2.0f * (float)j / (float)NF, &s, &c);
            cpx v; v.x = c; v.y = -s; TW[j] = v;
        } else if (task < N_TW + N_ROPE) {
            const int idx = (task - N_TW) * NT + tid; const int pos = idx >> 5, i = idx & 31;
            const float inv = exp2f(-(float)(i & 15) * (13.287712379549449f / 16.0f));
            const float ang = (float)(i < 16 ? pos / 64 : pos % 64) * inv;
            cpx v; v.x = cosf(ang); v.y = sinf(ang); ROPE[idx] = v;
        } else {
            const int mt = task - N_TW - N_ROPE; const int l = mt / (3 * DM / 64), n0 = (mt % (3 * DM / 64)) * 64;
            float* sv = (float*)smem;
            float* red = sv + NJ * DM;
            __syncthreads();
            for (int i = tid; i < NJ * DM; i += NT) { const int j = i / DM, k = i % DM; const float v = j < NB ? p.in[I_C][j * DM + k] : p.in[I_CCTX][k]; sv[i] = siluf_(v); }
            __syncthreads();
            const int nl = tid & 63, ks = tid >> 6; float acc[NJ];
#pragma unroll
            for (int j = 0; j < NJ; ++j) acc[j] = 0.f;
            const float* w = p.in[I_WADA] + (size_t)l * DM * 3 * DM + n0 + nl;
            for (int k = ks * (DM / 8); k < (ks + 1) * (DM / 8); ++k) { const float wv = w[(size_t)k * 3 * DM];
#pragma unroll
                for (int j = 0; j < NJ; ++j) acc[j] += sv[j * DM + k] * wv; }
#pragma unroll
            for (int j = 0; j < NJ; ++j) red[(ks * NJ + j) * 64 + nl] = acc[j];
            __syncthreads();
            for (int i = tid; i < NJ * 64; i += NT) { const int j = i / 64, n = i % 64; float s = 0.f;
#pragma unroll
                for (int k8 = 0; k8 < 8; ++k8) s += red[(k8 * NJ + j) * 64 + n];
                MOD[((size_t)l * NJ + j) * 3 * DM + n0 + n] = s + p.in[I_BADA][(size_t)l * 3 * DM + n0 + n]; }
        }
    }
}

__device__ __forceinline__ void rp_rows(const Params& p, int l) {
    const int tid = otid(), lane = tid & 63, wave = tid >> 6;
    const float* MOD = (const float*)(p.ws + WS_MOD);
    float* CTXB = (float*)(p.ws + WS_CTXB);
    const float* YO = (const float*)(p.ws + WS_P);
    bf16* HN = (bf16*)(p.ws + WS_HNY);
    constexpr int NV4 = DM / 256, RW = 2;
    const int stride = (int)gridDim.x * 8;
    for (int base = obid() * 8 + wave; base < T; base += stride * RW) {
        f32x4 x[RW][NV4], y[RW][NV4]; const float* xo[RW]; float* xn[RW]; int mj[RW]; bool ok[RW];
#pragma unroll
        for (int i = 0; i < RW; ++i) { const int row = base + i * stride; ok[i] = row < T; const int rr = ok[i] ? row : base;
            const int b = rr / TOK, pp = rr % TOK; const bool isctx = pp < CTXL; if (l == DEPTH && isctx) ok[i] = false;
            const size_t off = isctx ? ((size_t)b * CTXL + pp) * DM : ((size_t)b * SEQ + (pp - CTXL)) * DM;
            xo[i] = (l <= 1) ? (isctx ? p.in[I_CTX] + off : p.in[I_X] + off) : (isctx ? CTXB + off : p.out + off);
            xn[i] = isctx ? CTXB + off : p.out + off; mj[i] = isctx ? NB : b;
#pragma unroll
            for (int j = 0; j < NV4; ++j) { x[i][j] = *(const f32x4*)(xo[i] + 4 * lane + 256 * j); y[i][j] = l > 0 ? *(const f32x4*)(YO + (size_t)rr * DM + 4 * lane + 256 * j) : (f32x4){0.f, 0.f, 0.f, 0.f}; } }
        if (l > 0) {
            float ss[RW];
#pragma unroll
            for (int i = 0; i < RW; ++i) { ss[i] = 0.f;
#pragma unroll
                for (int j = 0; j < NV4; ++j) ss[i] += y[i][j].x * y[i][j].x + y[i][j].y * y[i][j].y + y[i][j].z * y[i][j].z + y[i][j].w * y[i][j].w; }
#pragma unroll
            for (int o = 1; o < 64; o <<= 1) {
#pragma unroll
                for (int i = 0; i < RW; ++i) ss[i] += __shfl_xor(ss[i], o); }
            const float* gp = p.in[I_GPOST] + (size_t)(l - 1) * DM;
#pragma unroll
            for (int i = 0; i < RW; ++i) { const float rstd = rsqrtf(ss[i] * (1.0f / DM) + EPS); const float* gt = MOD + ((size_t)(l - 1) * NJ + mj[i]) * 3 * DM + 2 * DM;
#pragma unroll
                for (int j = 0; j < NV4; ++j) { const f32x4 g4 = *(const f32x4*)(gt + 4 * lane + 256 * j), p4 = *(const f32x4*)(gp + 4 * lane + 256 * j);
                    x[i][j] = x[i][j] + g4 * (y[i][j] * rstd * p4);
                    if (ok[i]) *(f32x4*)(xn[i] + 4 * lane + 256 * j) = x[i][j]; } }
        }
        if (l < DEPTH) {
            float ss[RW];
#pragma unroll
            for (int i = 0; i < RW; ++i) { ss[i] = 0.f;
#pragma unroll
                for (int j = 0; j < NV4; ++j) ss[i] += x[i][j].x * x[i][j].x + x[i][j].y * x[i][j].y + x[i][j].z * x[i][j].z + x[i][j].w * x[i][j].w; }
#pragma unroll
            for (int o = 1; o < 64; o <<= 1) {
#pragma unroll
                for (int i = 0; i < RW; ++i) ss[i] += __shfl_xor(ss[i], o); }
            const float* gp = p.in[I_GPRE] + (size_t)l * DM;
#pragma unroll
            for (int i = 0; i < RW; ++i) { const float rstd = rsqrtf(ss[i] * (1.0f / DM) + EPS); const float* md = MOD + ((size_t)l * NJ + mj[i]) * 3 * DM; const int row = base + i * stride;
#pragma unroll
                for (int j = 0; j < NV4; ++j) { const int e = 4 * lane + 256 * j;
                    const f32x4 g4 = *(const f32x4*)(gp + e), sh = *(const f32x4*)(md + e), sc = *(const f32x4*)(md + DM + e);
                    const f32x4 h = (x[i][j] * rstd * g4) * (sc + 1.0f) + sh;
                    u32x2 o; o.x = pk2(h.x, h.y); o.y = pk2(h.z, h.w);
                    if (ok[i]) *(u32x2*)(HN + (size_t)row * DM + e) = o; } }
        }
    }
}

__device__ __forceinline__ void convert_tile(const float* src, int ldn, bf16* dst, int K, int n0, int k0, bool use_map, char* smem) {
    const int tid = otid();
    float* tile = (float*)smem;
    __syncthreads();
#pragma unroll
    for (int i = 0; i < 8; ++i) { const int idx = tid + NT * i, k = idx >> 6, n = idx & 63;
        const int oc = use_map ? orig_col(n0 + n) : (n0 + n);
        tile[k * 65 + n] = oc >= 0 ? src[(size_t)(k0 + k) * ldn + oc] : 0.f; }
    __syncthreads();
    const int n = tid >> 3, c = tid & 7;
    u32x4 o; o.x = pk2(tile[(8 * c + 0) * 65 + n], tile[(8 * c + 1) * 65 + n]); o.y = pk2(tile[(8 * c + 2) * 65 + n], tile[(8 * c + 3) * 65 + n]);
    o.z = pk2(tile[(8 * c + 4) * 65 + n], tile[(8 * c + 5) * 65 + n]); o.w = pk2(tile[(8 * c + 6) * 65 + n], tile[(8 * c + 7) * 65 + n]);
    *(u32x4*)(dst + (size_t)(n0 + n) * K + k0 + 8 * c) = o;
}

__device__ __forceinline__ void filter_task(const Params& p, int l, int L, int pos0, char* smem) {
    const int tid = otid();
    float* z = (float*)smem;
    float* h1 = z + 8 * 33;
    float* h2 = h1 + 8 * 64;
    __syncthreads();
    if (tid < 8 * 33) { const int pp = tid / 33, i = tid % 33; const float pos = (float)(pos0 + pp);
        const float t = pos / (float)(L - 1 > 1 ? L - 1 : 1), w = 6.283185307179586f * pos / (float)L; float v;
        if (i == 0) v = t; else { const int bi = (i - 1) & 15; const float f = 1e-4f + (float)bi * ((15.0f - 1e-4f) / 15.0f); v = (i <= 16) ? cosf(w * f) : -sinf(w * f); }
        z[tid] = v; }
    __syncthreads();
    { const int pp = tid >> 6, j = tid & 63; const float* w1 = p.in[I_HW1] + (size_t)l * 33 * 64; float a = p.in[I_HB1][l * 64 + j];
        for (int i = 0; i < 33; ++i) a += z[pp * 33 + i] * w1[i * 64 + j];
        h1[tid] = sinf(p.in[I_HFREQ][(l * 2 + 0) * 64 + j] * a); }
    __syncthreads();
    { const int pp = tid >> 6, j = tid & 63; const float* w2 = p.in[I_HW2] + (size_t)l * 64 * 64; float a = p.in[I_HB2][l * 64 + j];
        for (int i = 0; i < 64; ++i) a += h1[pp * 64 + i] * w2[i * 64 + j];
        h2[tid] = sinf(p.in[I_HFREQ][(l * 2 + 1) * 64 + j] * a); }
    __syncthreads();
    { const int o = tid, dir = o >> 8, c = o & 255; const float* w3 = p.in[I_HW3] + (size_t)l * 64 * 512; const float b3 = p.in[I_HB3][l * 512 + o];
        const float delta = 3.0701134573253946f + (float)c * ((15.350567286626973f - 3.0701134573253946f) / 255.0f);
        float acc[8];
#pragma unroll
        for (int pp = 0; pp < 8; ++pp) acc[pp] = b3;
        for (int j = 0; j < 64; ++j) { const float wv = w3[j * 512 + o];
#pragma unroll
            for (int pp = 0; pp < 8; ++pp) acc[pp] += h2[pp * 64 + j] * wv; }
        float* KT = (float*)(p.ws + WS_KT); float* HC = (float*)(p.ws + WS_HC);
#pragma unroll
        for (int pp = 0; pp < 8; ++pp) { const int pos = pos0 + pp; const float t = (float)pos / (float)(L - 1 > 1 ? L - 1 : 1);
            const float v = acc[pp] * __expf(-t * delta);
            if (L == SEQ) { if (dir == 0) KT[(size_t)c * NF + pos]= v; else if (pos > 0) KT[(size_t)c * NF + (NF - pos)] = v; else KT[(size_t)c * NF + SEQ] = 0.f; }
            else HC[((size_t)dir * WG + c) * CTXL + pos] = v; }
    }
}

__device__ __forceinline__ void layer_prep(const Params& p, int l, int idx, int stride, char* smem) {
    constexpr int N_WIN = (NPAD / 64) * (DM / 64), N_FL = SEQ / 8, N_FC = CTXL / 8;
    for (int task = idx; task < N_WIN + N_FL + N_FC; task += stride) {
        if (task < N_WIN) { const int nt = task / (DM / 64), kt = task % (DM / 64);
            convert_tile(p.in[I_WIN] + (size_t)l * DM * N_IN, N_IN, (bf16*)(p.ws + WS_WIN), DM, nt * 64, kt * 64, true, smem); }
        else if (task < N_WIN + N_FL) filter_task(p, l, SEQ, (task - N_WIN) * 8, smem);
        else filter_task(p, l, CTXL, (task - N_WIN - N_FL) * 8, smem);
    }
}
__device__ __forceinline__ void phase_rp(const Params& p, int l, char* smem) { rp_rows(p, l); if (l < DEPTH) layer_prep(p, l, obid(), (int)gridDim.x, smem); }

__device__ __forceinline__ cpx cmul(cpx a, cpx b) { cpx r; r.x = a.x * b.x - a.y * b.y; r.y = a.x * b.y + a.y * b.x; return r; }
__device__ __forceinline__ cpx cmulc(cpx a, cpx b) { cpx r; r.x = a.x * b.x + a.y * b.y; r.y = a.y * b.x - a.x * b.y; return r; }
constexpr int fpad(int i) { return i + (i >> 4); }
__device__ __forceinline__ int FPH(int i) { return i + (i >> 4); }
constexpr int FBUF = fpad(NF);
constexpr int ilog16(int n) { return n < 16 ? 0 : 1 + ilog16(n / 16); }
constexpr int FFT_P16 = ilog16(NF);
constexpr bool FFT_R4 = ((NF >> (4 * FFT_P16)) == 4);
static_assert((NF >> (4 * FFT_P16)) == 1 || (NF >> (4 * FFT_P16)) == 4, "NF = 16^a * (1 or 4)");
template <bool INV> __device__ __forceinline__ void dft4(cpx& a0, cpx& a1, cpx& a2, cpx& a3) {
    const cpx s = {a0.x + a2.x, a0.y + a2.y}, b = {a0.x - a2.x, a0.y - a2.y}, c = {a1.x + a3.x, a1.y + a3.y}, d = {a1.x - a3.x, a1.y - a3.y};
    a0 = (cpx){s.x + c.x, s.y + c.y}; a2 = (cpx){s.x - c.x, s.y - c.y};
    if (!INV) { a1 = (cpx){b.x + d.y, b.y - d.x}; a3 = (cpx){b.x - d.y, b.y + d.x}; }
    else      { a1 = (cpx){b.x - d.y, b.y + d.x}; a3 = (cpx){b.x + d.y, b.y - d.x}; }
}
template <bool INV> __device__ __forceinline__ cpx cmulk(cpx a, float wr, float wi) {
    cpx r; if (!INV) { r.x = a.x * wr + a.y * wi; r.y = a.y * wr - a.x * wi; } else { r.x = a.x * wr - a.y * wi; r.y = a.y * wr + a.x * wi; } return r;
}
template <bool INV> __device__ __forceinline__ void dft16(cpx (&x)[16]) {
    constexpr float C1 = 0.92387953251128674f, S1 = 0.38268343236508977f, C2 = 0.70710678118654752f;
#pragma unroll
    for (int n2 = 0; n2 < 4; ++n2) dft4<INV>(x[n2], x[4 + n2], x[8 + n2], x[12 + n2]);
    x[4 * 1 + 1] = cmulk<INV>(x[4 * 1 + 1], C1, S1); x[4 * 1 + 2] = cmulk<INV>(x[4 * 1 + 2], C2, C2); x[4 * 1 + 3] = cmulk<INV>(x[4 * 1 + 3], S1, C1);
    x[4 * 2 + 1] = cmulk<INV>(x[4 * 2 + 1], C2, C2); x[4 * 2 + 2] = cmulk<INV>(x[4 * 2 + 2], 0.f, 1.f); x[4 * 2 + 3] = cmulk<INV>(x[4 * 2 + 3], -C2, C2);
    x[4 * 3 + 1] = cmulk<INV>(x[4 * 3 + 1], S1, C1); x[4 * 3 + 2] = cmulk<INV>(x[4 * 3 + 2], -C2, C2); x[4 * 3 + 3] = cmulk<INV>(x[4 * 3 + 3], -C1, -S1);
#pragma unroll
    for (int k1 = 0; k1 < 4; ++k1) dft4<INV>(x[4 * k1 + 0], x[4 * k1 + 1], x[4 * k1 + 2], x[4 * k1 + 3]);
    cpx t;
    t = x[1]; x[1] = x[4]; x[4] = t; t = x[2]; x[2] = x[8]; x[8] = t; t = x[3]; x[3] = x[12]; x[12] = t;
    t = x[6]; x[6] = x[9]; x[9] = t; t = x[7]; x[7] = x[13]; x[13] = t; t = x[11]; x[11] = x[14]; x[14] = t;
}
template <bool INV> __device__ __forceinline__ void fft_stage16(cpx* buf, const cpx* TW, int tl, int M) {
    const int span = M >> 4, twm = NF / M;
#pragma unroll 1
    for (int j = tl; j < NF / 16; j += 256) {
        const int grp = j / span, pos = j % span, base = grp * M + pos; cpx x[16];
#pragma unroll
        for (int q = 0; q < 16; ++q) x[q] = buf[FPH(base + q * span)];
        if (INV && span > 1) {
#pragma unroll
            for (int k = 1; k < 16; ++k) x[k] = cmulc(x[k], TW[pos * k * twm]); }
        dft16<INV>(x);
        if (!INV && span > 1) {
#pragma unroll
            for (int k = 1; k < 16; ++k) x[k] = cmul(x[k], TW[pos * k * twm]); }
#pragma unroll
        for (int q = 0; q < 16; ++q) buf[FPH(base + q * span)] = x[q];
    }
}
template <bool INV> __device__ __forceinline__ void fft_stage4_last(cpx* buf, int tl) {
#pragma unroll 1
    for (int j = tl; j < NF / 4; j += 256) { cpx a0 = buf[FPH(4 * j)], a1 = buf[FPH(4 * j + 1)], a2 = buf[FPH(4 * j + 2)], a3 = buf[FPH(4 * j + 3)];
        dft4<INV>(a0, a1, a2, a3); buf[FPH(4 * j)] = a0; buf[FPH(4 * j + 1)] = a1; buf[FPH(4 * j + 2)] = a2; buf[FPH(4 * j + 3)] = a3; }
}
__device__ __forceinline__ void fft_fwd(cpx* buf, const cpx* TW, int tl) {
    int M = NF;
#pragma unroll
    for (int s = 0; s < FFT_P16; ++s) { __syncthreads(); fft_stage16<false>(buf, TW, tl, M); M >>= 4; }
    if (FFT_R4) { __syncthreads(); fft_stage4_last<false>(buf, tl); }
    __syncthreads();
}
__device__ __forceinline__ void fft_inv(cpx* buf, const cpx* TW, int tl) {
    if (FFT_R4) { __syncthreads(); fft_stage4_last<true>(buf, tl); }
    int M = FFT_R4 ? 64 : 16;
#pragma unroll
    for (int s = 0; s < FFT_P16; ++s) { __syncthreads(); fft_stage16<true>(buf, TW, tl, M); M <<= 4; }
    __syncthreads();
}
__device__ __forceinline__ void filt_fft_task(const Params& p, int cp, char* smem) {
    const int tid = otid(), half = tid >> 8, tl = tid & 255, c = 2 * cp + half;
    cpx* buf = (cpx*)smem + (size_t)half * FBUF;
    const float* KT = (const float*)(p.ws + WS_KT) + (size_t)c * NF;
    cpx* KF = (cpx*)(p.ws + WS_KF) + (size_t)c * NF;
    const cpx* TW = (const cpx*)(p.ws + WS_TW);
    __syncthreads();
    for (int i = tl; i < NF; i += 256) { cpx v; v.x = KT[i]; v.y = 0.f; buf[FPH(i)] = v; }
    fft_fwd(buf, TW, tl);
    for (int i = tl; i < NF; i += 256) KF[i] = buf[FPH(i)];
}

__device__ __forceinline__ void gemm_tile(const Params& p, const bf16* A, const bf16* Bt, int K, int mt, int nt, int mode, char* smem) {
    const int tid = otid(), lane = tid & 63, wave = tid >> 6;
    bf16* As = (bf16*)smem;
    bf16* Bs = As + 128 * LS;
    const int wm = (wave & 3) * 32, wn = (wave >> 2) * 64;
    f32x4 acc[2][4];
#pragma unroll
    for (int i = 0; i < 2; ++i)
#pragma unroll
        for (int j = 0; j < 4; ++j) acc[i][j] = (f32x4){0.f, 0.f, 0.f, 0.f};
    const int lr = tid >> 3, lc = tid & 7;
    const bf16* Ag = A + (size_t)(mt * 128 + lr) * K + lc * 8;
    const bf16* Bg = Bt + (size_t)(nt * 128 + lr) * K + lc * 8;
    u32x4 ra0, ra1, rb0, rb1;
    ra0 = *(const u32x4*)(Ag); ra1 = *(const u32x4*)(Ag + (size_t)64 * K); rb0 = *(const u32x4*)(Bg); rb1 = *(const u32x4*)(Bg + (size_t)64 * K);
    const int nk = K / 64;
    for (int kt = 0; kt < nk; ++kt) {
        __syncthreads();
        *(u32x4*)(As + lr * LS + lc * 8) = ra0; *(u32x4*)(As + (lr + 64) * LS + lc * 8) = ra1;
        *(u32x4*)(Bs + lr * LS + lc * 8) = rb0; *(u32x4*)(Bs + (lr + 64) * LS + lc * 8) = rb1;
        __syncthreads();
        if (kt + 1 < nk) { const int ko = (kt + 1) * 64;
            ra0 = *(const u32x4*)(Ag + ko); ra1 = *(const u32x4*)(Ag + (size_t)64 * K + ko); rb0 = *(const u32x4*)(Bg + ko); rb1 = *(const u32x4*)(Bg + (size_t)64 * K + ko); }
        mma_nt<4, 2>(As, LS, wm, Bs, LS, wn, acc[0], lane);
        mma_nt<4, 2>(As, LS, wm + 16, Bs, LS, wn, acc[1], lane);
    }
    const int r = lane & 15, q = lane >> 4;
#pragma unroll
    for (int i = 0; i < 2; ++i)
#pragma unroll
        for (int j = 0; j < 4; ++j)
#pragma unroll
            for (int e = 0; e < 4; ++e) {
                const int row = mt * 128 + wm + 16 * i + 4 * q + e, col = nt * 128 + wn + 16 * j + r; const float v = acc[i][j][e];
                if (mode == 0) { if (col < NP) ((bf16*)(p.ws + WS_P))[(size_t)row * NP + col] = f2bf(v); else if (col < NP + 16) ((float*)(p.ws + WS_G))[(size_t)row * NGS + (col - NP)] = v; else if (col < NP + NG) ((bf16*)((float*)(p.ws + WS_G) + (size_t)row * NGS + 16))[col - NP - 16] = f2bf(v); }
                else if (mode == 2) ((bf16*)(p.ws + WS_HT))[(size_t)row * T + col] = f2bf(v);
                else ((float*)(p.ws + WS_P))[(size_t)row * DM + col] = v;
            }
}

#ifndef EMU
namespace pg8 {
#define PG8_LAS __attribute__((address_space(3)))
typedef unsigned short bf16_t;
typedef short bf16x8 __attribute__((ext_vector_type(8)));
typedef float f32x4 __attribute__((ext_vector_type(4)));
typedef unsigned u32x4 __attribute__((ext_vector_type(4)));
constexpr int BM = 256, BK = 64, HALF = 128, HTB = HALF * BK * 2  , STAGE_BYTES = 8 * HTB, NXCD = 8, WGM = 8;

__host__ __device__ __forceinline__ int lds_byte(int r, int c) { const int st = (r >> 4) * 2 + (c >> 5), rr = r & 15, cc = c & 31, ob = rr * 64 + cc * 2; return st * 1024 + (ob ^ (((ob >> 9) & 1) << 5)); }
__host__ __device__ __forceinline__ void stage_rc(int b, int& R, int& C) { const int st = b / 1024, sb = b % 1024, swz = sb ^ (((sb >> 9) & 1) << 5); R = (st >> 1) * 16 + swz / 64; C = (st & 1) * 32 + (swz % 64) / 2; }
__host__ __device__ __forceinline__ int perm32(int rho) { const int n = rho >> 4, i = rho & 15; return 8 * (i >> 2) + 4 * n + (i & 3); }

struct Unit { int pm, pn; };
struct Gemm { const bf16_t* A; const bf16_t* Bt; int M, N, K; };
__device__ __forceinline__ unsigned cvt_pk_bf16(float lo, float hi) { unsigned r; asm volatile("v_cvt_pk_bf16_f32 %0, %1, %2" : "=v"(r) : "v"(lo), "v"(hi)); return r; }
template <class Epi, class Sched, bool ALIGN_EPI = false, bool SP2 = false>
__device__ __forceinline__ void gemm_phase(PG8_LAS unsigned char* lds, const Gemm g, const Sched& S, const Epi& E) {
    const int tid = otid(), wid = __builtin_amdgcn_readfirstlane(tid >> 6), lane = tid & 63, wr = wid >> 2, wc = wid & 3, fr = lane & 15, fq = lane >> 4;
    const int K = g.K, nt = K / BK;
    unsigned voffA[2], voffB[2];
#pragma unroll
    for (int i = 0; i < 2; ++i) { int R, C; stage_rc(tid * 16 + i * 8192, R, C); const int Rb = Epi::PERM ? ((R & ~31) + perm32(R & 31)) : R;
        voffA[i] = (unsigned)(R * K + C) * 2u; voffB[i] = (unsigned)(Rb * K + C) * 2u; }
    const size_t kstep = (size_t)(BK * 2);
    const size_t hstep = (size_t)HALF * K * 2;
    const size_t tstep = 2 * hstep;
    const unsigned ldsw = (unsigned)wid * 1024u;
    const int aoff = lds_byte(wr * 64 + fr, fq * 8), boff = lds_byte(wc * 32 + fr, fq * 8);
#define PG8_SA(b, h) (((b) * 2 + (h)) * HTB)
#define PG8_SB(b, h) ((4 + (b) * 2 + (h)) * HTB)
#define PG8_STAGE(bufoff, gbase, voff) do { _Pragma("unroll") for (int _i = 0; _i < 2; ++_i) \
        __builtin_amdgcn_global_load_lds((const unsigned*)((const char*)(gbase) + (voff)[_i]), (PG8_LAS unsigned*)(lds + (bufoff) + ldsw + _i * 8192), 16, 0, 0); } while (0)
#define PG8_LDA(dst, b, h) do { _Pragma("unroll") for (int m = 0; m < 4; ++m) _Pragma("unroll") for (int k = 0; k < 2; ++k) dst[m][k] = *(const PG8_LAS bf16x8*)(lds + PG8_SA(b, h) + aoff + m * 2048 + k * 1024); } while (0)
#define PG8_LDB(dst, b, h) do { _Pragma("unroll") for (int n = 0; n < 2; ++n) _Pragma("unroll") for (int k = 0; k < 2; ++k) dst[n][k] = *(const PG8_LAS bf16x8*)(lds + PG8_SB(b, h) + boff + n * 2048 + k * 1024); } while (0)
#define PG8_MMA(ai, bj, At, Bt) do { __builtin_amdgcn_s_setprio(1); _Pragma("unroll") for (int m = 0; m < 4; ++m) _Pragma("unroll") for (int n = 0; n < 2; ++n) _Pragma("unroll") for (int k = 0; k < 2; ++k) \
        acc[ai][bj][m][n] = __builtin_amdgcn_mfma_f32_16x16x32_bf16(Bt[n][k], At[m][k], acc[ai][bj][m][n], 0, 0, 0); __builtin_amdgcn_s_setprio(0); } while (0)
#define PG8_WAIT_V(n) asm volatile("s_waitcnt vmcnt(" #n ")" ::: "memory")
#define PG8_WAIT_L(n) asm volatile("s_waitcnt lgkmcnt(" #n ")" ::: "memory")
#define PG8_BAR __builtin_amdgcn_s_barrier()
#define PG8_SCHED __builtin_amdgcn_sched_barrier(0)
    Unit cur, nxt; int ui = 0;
    if (!S.next(0, cur)) return;
    f32x4 acc[2][2][4][2];
#pragma unroll
    for (int a = 0; a < 2; ++a)
#pragma unroll
        for (int b = 0; b < 2; ++b)
#pragma unroll
            for (int m = 0; m < 4; ++m)
#pragma unroll
                for (int n = 0; n < 2; ++n) acc[a][b][m][n] = (f32x4){0.f, 0.f, 0.f, 0.f};
    bf16x8 At[4][2], B0[2][2], B1[2][2];
    const char* cA = (const char*)g.A + (size_t)cur.pm * tstep; const char* cB = (const char*)g.Bt + (size_t)cur.pn * tstep;
    S.a_ready(cur);
    if constexpr (SP2) {
        PG8_STAGE(PG8_SB(0, 0), cB, voffB); PG8_STAGE(PG8_SB(0, 1), cB + hstep, voffB); PG8_STAGE(PG8_SA(0, 0), cA, voffA); PG8_STAGE(PG8_SA(0, 1), cA + hstep, voffA);
        if (wr == 1) PG8_BAR;
        PG8_WAIT_V(2); PG8_BAR;
        PG8_STAGE(PG8_SB(1, 0), cB + kstep, voffB); PG8_STAGE(PG8_SA(1, 0), cA + kstep, voffA); PG8_STAGE(PG8_SB(1, 1), cB + hstep + kstep, voffB);
        PG8_WAIT_V(6); PG8_BAR;
    } else {
        PG8_STAGE(PG8_SB(0, 0), cB, voffB); PG8_STAGE(PG8_SA(0, 0), cA, voffA); PG8_STAGE(PG8_SB(0, 1), cB + hstep, voffB); PG8_STAGE(PG8_SA(0, 1), cA + hstep, voffA);
        if (wr == 1) PG8_BAR;
        PG8_WAIT_V(4); PG8_BAR;
        PG8_STAGE(PG8_SB(1, 0), cB + kstep, voffB); PG8_STAGE(PG8_SA(1, 0), cA + kstep, voffA); PG8_STAGE(PG8_SB(1, 1), cB + hstep + kstep, voffB);
        PG8_WAIT_V(6); PG8_BAR;
    }
    for (;;) {
        const bool has_next = S.next(ui + 1, nxt);
        const char* nA = has_next ? (const char*)g.A + (size_t)nxt.pm * tstep : cA; const char* nB = has_next ? (const char*)g.Bt + (size_t)nxt.pn * tstep : cB;
        for (int t = 0; t < nt; t += 2) {
            const bool last = (t == nt - 2);
            const char* a1 = cA + (size_t)(t + 1) * kstep;
            const char* a2 = last ? nA : cA + (size_t)(t + 2) * kstep; const char* b2 = last ? nB : cB + (size_t)(t + 2) * kstep;
            const char* a3 = a2 + kstep; const char* b3 = b2 + kstep;
            if (last && has_next) S.a_ready(nxt);
            if constexpr (SP2) {
            PG8_LDB(B0, 0, 0); PG8_LDB(B1, 0, 1); PG8_SCHED; PG8_LDA(At, 0, 0); PG8_STAGE(PG8_SA(1, 1), a1 + hstep, voffA);
            PG8_WAIT_V(8); PG8_WAIT_L(0); PG8_BAR; PG8_MMA(0, 0, At, B0); PG8_MMA(0, 1, At, B1); PG8_BAR; PG8_SCHED;
            PG8_LDA(At, 0, 1); PG8_STAGE(PG8_SB(0, 0), b2, voffB); PG8_STAGE(PG8_SB(0, 1), b2 + hstep, voffB); PG8_STAGE(PG8_SA(0, 0), a2, voffA);
            PG8_WAIT_V(8); PG8_WAIT_L(0); PG8_BAR; PG8_MMA(1, 0, At, B0); PG8_MMA(1, 1, At, B1); PG8_BAR; PG8_SCHED;
            PG8_LDB(B0, 1, 0); PG8_LDB(B1, 1, 1); PG8_SCHED; PG8_LDA(At, 1, 0); PG8_STAGE(PG8_SA(0, 1), a2 + hstep, voffA);
            PG8_WAIT_V(8); PG8_WAIT_L(0); PG8_BAR; PG8_MMA(0, 0, At, B0); PG8_MMA(0, 1, At, B1); PG8_BAR; PG8_SCHED;
            PG8_LDA(At, 1, 1); PG8_STAGE(PG8_SB(1, 0), b3, voffB); PG8_STAGE(PG8_SB(1, 1), b3 + hstep, voffB); PG8_STAGE(PG8_SA(1, 0), a3, voffA);
            PG8_WAIT_V(8); PG8_WAIT_L(0); PG8_BAR; PG8_MMA(1, 0, At, B0); PG8_MMA(1, 1, At, B1); PG8_BAR; PG8_SCHED;
            } else {
            PG8_LDB(B0, 0, 0); PG8_SCHED; PG8_LDA(At, 0, 0); PG8_STAGE(PG8_SA(1, 1), a1 + hstep, voffA);
            PG8_WAIT_L(8); PG8_BAR; PG8_WAIT_L(0); PG8_MMA(0, 0, At, B0); PG8_BAR; PG8_SCHED;
            PG8_LDB(B1, 0, 1); PG8_STAGE(PG8_SB(0, 0), b2, voffB);
            PG8_BAR; PG8_WAIT_L(0); PG8_MMA(0, 1, At, B1); PG8_BAR;
            PG8_LDA(At, 0, 1); PG8_STAGE(PG8_SA(0, 0), a2, voffA);
            PG8_BAR; PG8_WAIT_L(0); PG8_MMA(1, 0, At, B0); PG8_BAR; PG8_SCHED;
            PG8_STAGE(PG8_SB(0, 1), b2 + hstep, voffB);
            PG8_WAIT_V(6); PG8_BAR; PG8_MMA(1, 1, At, B1); PG8_BAR;
            PG8_LDB(B0, 1, 0); PG8_SCHED; PG8_LDA(At, 1, 0); PG8_STAGE(PG8_SA(0, 1), a2 + hstep, voffA);
            PG8_WAIT_L(8); PG8_BAR; PG8_WAIT_L(0); PG8_MMA(0, 0, At, B0); PG8_BAR; PG8_SCHED;
            PG8_LDB(B1, 1, 1); PG8_STAGE(PG8_SB(1, 0), b3, voffB);
            PG8_BAR; PG8_WAIT_L(0); PG8_MMA(0, 1, At, B1); PG8_BAR;
            PG8_LDA(At, 1, 1); PG8_STAGE(PG8_SA(1, 0), a3, voffA);
            PG8_BAR; PG8_WAIT_L(0); PG8_MMA(1, 0, At, B0); PG8_BAR; PG8_SCHED;
            PG8_STAGE(PG8_SB(1, 1), b3 + hstep, voffB);
            PG8_WAIT_V(6); PG8_BAR; PG8_MMA(1, 1, At, B1); PG8_BAR;
            }
        }
        if constexpr (ALIGN_EPI) { if (wr == 0) PG8_BAR; }
        if constexpr (!Epi::AFTER_DRAIN) { E(acc, cur, wr, wc, fr, fq); S.done(cur); }
        if (!has_next) break;
#pragma unroll
        for (int a = 0; a < 2; ++a)
#pragma unroll
            for (int b = 0; b < 2; ++b)
#pragma unroll
                for (int m = 0; m < 4; ++m)
#pragma unroll
                    for (int n = 0; n < 2; ++n) acc[a][b][m][n] = (f32x4){0.f, 0.f, 0.f, 0.f};
        cur = nxt; cA = nA; cB = nB; ++ui;
        if constexpr (ALIGN_EPI) { if (wr == 1) PG8_BAR; }
    }
    PG8_WAIT_V(0);
    if constexpr (!ALIGN_EPI) { if (wr == 0) PG8_BAR; }
    PG8_BAR;
    if constexpr (Epi::AFTER_DRAIN) { E.fused(acc, cur, wr, wc, fr, fq, lds, wid, lane); S.done(cur); }
#undef PG8_SA
#undef PG8_SB
#undef PG8_STAGE
#undef PG8_LDA
#undef PG8_LDB
#undef PG8_MMA
#undef PG8_WAIT_V
#undef PG8_WAIT_L
#undef PG8_BAR
#undef PG8_SCHED
}
__device__ __forceinline__ void map_tile(int L, int nM, int nN, int& pm, int& pn) {
    const int nwg = nM * nN; int wgid = L; { const int q = nwg / NXCD, r = nwg % NXCD, xcd = wgid % NXCD, off = wgid / NXCD; wgid = (xcd < r ? xcd * (q + 1) : r * (q + 1) + (xcd - r) * q) + off; }
    const int nig = WGM * nN, gid = wgid / nig, fm = gid * WGM, gsz = (nM - fm) < WGM ? (nM - fm) : WGM;
    pm = fm + ((wgid % nig) % gsz); pn = (wgid % nig) / gsz;
}
constexpr int MP = T / 256, WP = NMAIN / 256, NU2 = 4 * MP, NU1 = MP * WP;
struct InOrder { int G, c;
    __device__ __forceinline__ bool next(int i, Unit& u) const { const int L = i * G + c; if (L >= NU2 + NU1) return false; int a, b;
        if (L < NU2) { map_tile(L, 4, MP, a, b); u.pm = MP + WP + a; u.pn = b; } else { map_tile(L - NU2, MP, WP, a, b); u.pm = a; u.pn = MP + b; } return true; }
    __device__ __forceinline__ void a_ready(const Unit&) const {}
    __device__ __forceinline__ void done(const Unit&) const {}
};
struct EpiIn { static constexpr bool PERM = true, AFTER_DRAIN = false; bf16_t* P; float* G; bf16_t* HTp;
    __device__ __forceinline__ void operator()(const f32x4 (&acc)[2][2][4][2], const Unit& u, int wr, int wc, int fr, int fq) const {
        if (u.pm < MP) { const int pn = u.pn - MP, row0 = u.pm * BM + wr * 64 + fr;
            if (pn < NP / 256) { const int col0 = pn * BM + wc * 32 + 8 * fq;
#pragma unroll
                for (int ai = 0; ai < 2; ++ai)
#pragma unroll
                    for (int m = 0; m < 4; ++m) { bf16_t* rowp = P + (size_t)(row0 + ai * HALF + m * 16) * NP + col0;
#pragma unroll
                        for (int bj = 0; bj < 2; ++bj) { const f32x4 v0 = acc[ai][bj][m][0], v1 = acc[ai][bj][m][1];
                            u32x4 w; w.x = cvt_pk_bf16(v0[0], v0[1]); w.y = cvt_pk_bf16(v0[2], v0[3]); w.z = cvt_pk_bf16(v1[0], v1[1]); w.w = cvt_pk_bf16(v1[2], v1[3]); *(u32x4*)(rowp + bj * HALF) = w; } } }
            else { const int cb = wc * 32 + 8 * fq;
                if (cb < NG) {
#pragma unroll
                    for (int ai = 0; ai < 2; ++ai)
#pragma unroll
                        for (int m = 0; m < 4; ++m) { float* rowb = G + (size_t)(row0 + ai * HALF + m * 16) * NGS; const f32x4 v0 = acc[ai][0][m][0], v1 = acc[ai][0][m][1];
                            if (cb < 16) { *(f32x4*)(rowb + cb) = v0; *(f32x4*)(rowb + cb + 4) = v1; }
                            else { u32x4 w; w.x = cvt_pk_bf16(v0[0], v0[1]); w.y = cvt_pk_bf16(v0[2], v0[3]); w.z = cvt_pk_bf16(v1[0], v1[1]); w.w = cvt_pk_bf16(v1[2], v1[3]); *(u32x4*)((bf16_t*)(rowb + 16) + (cb - 16)) = w; } } } } }
        else { const int row0 = (u.pm - MP - WP) * BM + wr * 64 + fr, col0 = u.pn * BM + wc * 32 + 8 * fq;
#pragma unroll
            for (int ai = 0; ai < 2; ++ai)
#pragma unroll
                for (int m = 0; m < 4; ++m) { bf16_t* rowp = HTp + (size_t)(row0 + ai * HALF + m * 16) * T + col0;
#pragma unroll
                    for (int bj = 0; bj < 2; ++bj) { const f32x4 v0 = acc[ai][bj][m][0], v1 = acc[ai][bj][m][1];
                        u32x4 w; w.x = cvt_pk_bf16(v0[0], v0[1]); w.y = cvt_pk_bf16(v0[2], v0[3]); w.z = cvt_pk_bf16(v1[0], v1[1]); w.w = cvt_pk_bf16(v1[2], v1[3]); *(u32x4*)(rowp + bj * HALF) = w; } } }
    }
};
struct OutOrder { int G, c; bool lat_only;
    __device__ __forceinline__ bool next(int i, Unit& u) const { const int nM = lat_only ? NB * (SEQ / 256) : MP, nN = DM / 256; const int L = i * G + c; if (L >= nM * nN) return false; int a, b; map_tile(L, nM, nN, a, b);
        u.pm = lat_only ? (a / (SEQ / 256)) * (TOK / 256) + CTXL / 256 + a % (SEQ / 256) : a; u.pn = b; return true; }
    __device__ __forceinline__ void a_ready(const Unit&) const {}
    __device__ __forceinline__ void done(const Unit&) const {}
};
struct EpiOut { static constexpr bool PERM = false, AFTER_DRAIN = false; float* C;
    __device__ __forceinline__ void operator()(const f32x4 (&acc)[2][2][4][2], const Unit& u, int wr, int wc, int fr, int fq) const {
        const int row0 = u.pm * BM + wr * 64 + fr, col0 = u.pn * BM + wc * 32 + 4 * fq;
#pragma unroll
        for (int ai = 0; ai < 2; ++ai)
#pragma unroll
            for (int m = 0; m < 4; ++m) { float* rowp = C + (size_t)(row0 + ai * HALF + m * 16) * DM + col0;
#pragma unroll
                for (int bj = 0; bj < 2; ++bj)
#pragma unroll
                    for (int n = 0; n < 2; ++n) *(f32x4*)(rowp + bj * HALF + n * 16) = acc[ai][bj][m][n]; }
    }
};
}
#endif

__device__ __forceinline__ void phase_gemm_in(const Params& p, int l, char* smem) {
    constexpr int N_F = WG / 2;
#ifdef EMU
    constexpr int MT = T / 128, NT1 = NMAIN / 128, N1 = MT * NT1, N2 = 8 * MT;
    for (int task = obid(); task < N1 + N2; task += gridDim.x) {
        if (task < N1) gemm_tile(p, (const bf16*)(p.ws + WS_HNY), (const bf16*)(p.ws + WS_WIN), DM, task / NT1, task % NT1, 0, smem);
        else { const int t2 = task - N1; gemm_tile(p, (const bf16*)(p.ws + WS_WIN) + (size_t)NMAIN * DM, (const bf16*)(p.ws + WS_HNY), DM, t2 / MT, t2 % MT, 2, smem); }
    }
#else
    { const pg8::Gemm g{(const pg8::bf16_t*)(p.ws + WS_HNY), (const pg8::bf16_t*)(p.ws + WS_HNY), 0, 0, DM};
      const pg8::InOrder S{(int)gridDim.x, obid()};
      const pg8::EpiIn E{(pg8::bf16_t*)(p.ws + WS_P), (float*)(p.ws + WS_G), (pg8::bf16_t*)(p.ws + WS_HT)};
      pg8::gemm_phase<pg8::EpiIn, pg8::InOrder, true, true>((PG8_LAS unsigned char*)smem, g, S, E); }
#endif
    for (int task = (int)gridDim.x - 1 - obid(); task < N_F; task += gridDim.x) filt_fft_task(p, task, smem);
}
__device__ __forceinline__ void phase_gemm_out(const Params& p, int l, char* smem) {
    const int G = (int)gridDim.x, bid = obid();
#ifdef EMU
    constexpr int MT = T / 128, NTO = DM / 128;
    for (int task = bid; task < MT * NTO; task += G) {
        const int mt = task / NTO, nt = task % NTO;
        if (l == DEPTH - 1 && (mt % (TOK / 128)) < CTXL / 128) continue;
        gemm_tile(p, (const bf16*)(p.ws + WS_HNY), (const bf16*)(p.ws + WS_WOUT), MIX, mt, nt, 1, smem);
    }
    const int extra = 0;
#else
    const pg8::Gemm g{(const pg8::bf16_t*)(p.ws + WS_HNY), (const pg8::bf16_t*)(p.ws + WS_WOUT), 0, 0, MIX};
    const pg8::OutOrder S{G, bid, l == DEPTH - 1};
    const pg8::EpiOut E{(float*)(p.ws + WS_P)};
    pg8::gemm_phase<pg8::EpiOut, pg8::OutOrder, true, true>((PG8_LAS unsigned char*)smem, g, S, E);
    const int nU = (l == DEPTH - 1 ? NB * (SEQ / 256) : T / 256) * (DM / 256); const int extra = nU % G;
#endif
    (void)extra;
}

__device__ __forceinline__ size_t st_index(int mixer, int dir, int b, int h, int cid) { return ((((size_t)(mixer * 2 + dir) * NB + b) * NH + h) * NCH + cid); }
__device__ __forceinline__ size_t ch_index(int dir, int b, int h, int cid) { return (((size_t)dir * NB + b) * NH + h) * NCH + cid; }

__device__ __forceinline__ void load_tile_nat(const bf16* P, int r0, int c0, bf16* dst, float scale, int tid) {
    const int s = tid >> 3, c8 = tid & 7;
    const u32x4 v = *(const u32x4*)(P + (size_t)(r0 + s) * NP + c0 + c8 * 8);
    if (scale == 1.0f) *(u32x4*)(dst + s * LS + c8 * 8) = v;
    else { float f[8]; unpack8(v, f); u32x4 o; o.x = pk2(f[0] * scale, f[1] * scale); o.y = pk2(f[2] * scale, f[3] * scale); o.z = pk2(f[4] * scale, f[5] * scale); o.w = pk2(f[6] * scale, f[7] * scale);
        *(u32x4*)(dst + s * LS + c8 * 8) = o; }
}
__device__ __forceinline__ void load_tile_tr(const bf16* P, int r0, int c0, bf16* dst, int tid) {
    const int s = tid >> 3, c8 = tid & 7;
    const u32x4 v = *(const u32x4*)(P + (size_t)(r0 + s) * NP + c0 + c8 * 8);
    const unsigned w[4] = {v.x, v.y, v.z, v.w};
#pragma unroll
    for (int j = 0; j < 4; ++j) { dst[(c8 * 8 + 2 * j) * LS + s] = (bf16)(w[j] & 0xffffu); dst[(c8 * 8 + 2 * j + 1) * LS + s] = (bf16)(w[j] >> 16); }
}

template <int NTK>
__device__ __forceinline__ void load_span(const bf16* row, int t0, float (&v)[NTK + 2]) {
    v[0] = t0 > 0 ? bf2f(row[-1]) : 0.f; v[NTK + 1] = (t0 + NTK < SEQ) ? bf2f(row[NTK]) : 0.f;
    if constexpr (NTK == 8) { float f[8]; unpack8(*(const u32x4*)row, f);
#pragma unroll
        for (int i = 0; i < 8; ++i) v[1 + i] = f[i]; }
    else {
#pragma unroll
        for (int i = 0; i < NTK; ++i) v[1 + i] = bf2f(row[i]); }
}
template <int NTK>
__device__ __forceinline__ void hy_inputs(const bf16* h0, const bf16* h1, const float* cw, const float* cb, int c, int t0, float (&u0)[NTK], float (&u1)[NTK], float (&g0)[NTK], float (&g1)[NTK]) {
    { float xa[NTK + 2], xb[NTK + 2]; load_span<NTK>(h0 + (size_t)512 * T, t0, xa); load_span<NTK>(h1 + (size_t)512 * T, t0, xb);
        const float w0 = cw[0 * 768 + 512 + c], w1 = cw[1 * 768 + 512 + c], w2 = cw[2 * 768 + 512 + c], bb = cb[512 + c];
        float ga[NTK + 2], gb[NTK + 2]; load_span<NTK>(h0 + (size_t)768 * T, t0, ga); load_span<NTK>(h1 + (size_t)768 * T, t0, gb);
#pragma unroll
        for (int i = 0; i < NTK; ++i) { g0[i] = (w0 * xa[i] + w1 * xa[i + 1] + w2 * xa[i + 2] + bb) * siluf_(ga[i + 1]); g1[i] = (w0 * xb[i] + w1 * xb[i + 1] + w2 * xb[i + 2] + bb) * siluf_(gb[i + 1]); } }
    { float va[NTK + 2], vb[NTK + 2], ya[NTK + 2], yb[NTK + 2];
        load_span<NTK>(h0, t0, va); load_span<NTK>(h1, t0, vb); load_span<NTK>(h0 + (size_t)256 * T, t0, ya); load_span<NTK>(h1 + (size_t)256 * T, t0, yb);
        const float v0 = cw[0 * 768 + c], v1 = cw[1 * 768 + c], v2 = cw[2 * 768 + c], vbias = cb[c];
        const float y0 = cw[0 * 768 + 256 + c], y1 = cw[1 * 768 + 256 + c], y2 = cw[2 * 768 + 256 + c], ybias = cb[256 + c];
#pragma unroll
        for (int i = 0; i < NTK; ++i) { u0[i] = (v0 * va[i] + v1 * va[i + 1] + v2 * va[i + 2] + vbias) * (y0 * ya[i] + y1 * ya[i + 1] + y2 * ya[i + 2] + ybias);
            u1[i] = (v0 * vb[i] + v1 * vb[i + 1] + v2 * vb[i + 2] + vbias) * (y0 * yb[i] + y1 * yb[i + 1] + y2 * yb[i + 2] + ybias); } }
}
__device__ __forceinline__ void hylat_task(const Params& p, int l, int bp, int cp, char* smem) {
    const int tid = otid(), half = tid >> 8, tl = tid & 255, c = 2 * cp + half;
    const bf16* HT = (const bf16*)(p.ws + WS_HT); bf16* Y = (bf16*)(p.ws + WS_HNY);
    cpx* buf = (cpx*)smem + (size_t)half * FBUF;
    const cpx* TW = (const cpx*)(p.ws + WS_TW);
    const cpx* KF = (const cpx*)(p.ws + WS_KF) + (size_t)c * NF;
    constexpr int NTK = SEQ / 256;
    const int t0 = NTK * tl;
    const float* cw = p.in[I_HCW] + (size_t)l * 3 * 768; const float* cb = p.in[I_HCB] + (size_t)l * 768;
    const size_t rb0 = (size_t)(2 * bp) * TOK + CTXL, rb1 = rb0 + TOK;
    const bf16* h0 = HT + (size_t)c * T + rb0 + t0; const bf16* h1 = h0 + TOK;
    { float u0[NTK], u1[NTK], g0[NTK], g1[NTK]; hy_inputs<NTK>(h0, h1, cw, cb, c, t0, u0, u1, g0, g1);
        __syncthreads();
#pragma unroll
        for (int i = 0; i < NTK; ++i) { cpx v; v.x = u0[i]; v.y = u1[i]; buf[FPH(t0 + i)] = v; cpx z = {0.f, 0.f}; buf[FPH(SEQ + t0 + i)] = z; } }
    fft_fwd(buf, TW, tl);
#pragma unroll 2
    for (int i = tl; i < NF; i += 256) buf[FPH(i)] = cmul(buf[FPH(i)], KF[i]);
    fft_inv(buf, TW, tl);
    const float dsk = p.in[I_HD][(size_t)l * WG + c]; const float sc = 1.0f / (float)NF;
    { const int tz = otid() & 255; const int t0z = NTK * tz;
        float u0[NTK], u1[NTK], g0[NTK], g1[NTK]; hy_inputs<NTK>(HT + (size_t)c * T + rb0 + t0z, HT + (size_t)c * T + rb0 + t0z + TOK, cw, cb, c, t0z, u0, u1, g0, g1);
        float o0[NTK], o1[NTK];
#pragma unroll
        for (int i = 0; i < NTK; ++i) { const cpx y = buf[FPH(t0z + i)]; o0[i] = g0[i] * (y.x * sc + u0[i] * dsk); o1[i] = g1[i] * (y.y * sc + u1[i] * dsk); }
        bf16* d0 = (bf16*)(p.ws + WS_HT) + (size_t)(768 + c) * T + rb0 + t0z; bf16* d1 = d0 + TOK;
        if constexpr (NTK == 8) { *(u32x4*)d0 = pack8(o0); *(u32x4*)d1 = pack8(o1); }
        else {
#pragma unroll
            for (int i = 0; i < NTK; ++i) { d0[i] = f2bf(o0[i]); d1[i] = f2bf(o1[i]); } } }
}

constexpr int HCB = 8;
__device__ __forceinline__ void hyctx_task(const Params& p, int l, int b, int cblk, char* smem) {
    const int tid = otid(); const int c0 = cblk * HCB;
    const bf16* HT = (const bf16*)(p.ws + WS_HT); bf16* Y = (bf16*)(p.ws + WS_HNY); const float* HC = (const float*)(p.ws + WS_HC);
    float* raw = (float*)smem;
    float* u = raw + 3 * CTXL * HCB;
    float* hf = u + CTXL * HCB;
    float* hb = hf + CTXL * HCB;
    float* og = hb + CTXL * HCB;
    const size_t rb = (size_t)b * TOK;
    const float* cw = p.in[I_HCW] + (size_t)l * 3 * 768; const float* cbias = p.in[I_HCB] + (size_t)l * 768;
    __syncthreads();
    for (int i = tid; i < 3 * CTXL * HCB; i += NT) { const int k = i / (CTXL * HCB), cc = (i / CTXL) % HCB, t = i % CTXL; raw[(k * CTXL + t) * HCB + cc] = bf2f(HT[(size_t)(k * 256 + c0 + cc) * T + rb + t]); }
    for (int i = tid; i < CTXL * HCB; i += NT) { const int t = i / HCB, cc = i % HCB; hf[i] = HC[((size_t)0 * WG + c0 + cc) * CTXL + t]; hb[i] = HC[((size_t)1 * WG + c0 + cc) * CTXL + t]; }
    __syncthreads();
    for (int i = tid; i < CTXL * HCB; i += NT) { const int t = i / HCB, cc = i % HCB; float cv[3];
#pragma unroll
        for (int k = 0; k < 3; ++k) { const float* rk = raw + k * CTXL * HCB; const int ch = k * 256 + c0 + cc;
            const float a = t > 0 ? rk[(t - 1) * HCB + cc] : 0.f, m = rk[t * HCB + cc], z = t < CTXL - 1 ? rk[(t + 1) * HCB + cc] : 0.f;
            cv[k] = cw[0 * 768 + ch] * a + cw[1 * 768 + ch] * m + cw[2 * 768 + ch] * z + cbias[ch]; }
        u[i] = cv[0] * cv[1];
        og[i] = cv[2] * siluf_(bf2f(HT[(size_t)(768 + c0 + cc) * T + rb + t])); }
    __syncthreads();
    { const int cc = tid % HCB, tg = tid / HCB; constexpr int TG = NT / HCB, NTK = CTXL / TG; float acc[NTK];
#pragma unroll
        for (int i = 0; i < NTK; ++i) acc[i] = 0.f;
        for (int s = 0; s < CTXL; ++s) { const float us = u[s * HCB + cc];
#pragma unroll
            for (int i = 0; i < NTK; ++i) { const int t = tg + TG * i; const float hv = (s <= t) ? hf[(t - s) * HCB + cc] : hb[(s - t) * HCB + cc]; acc[i] += us * hv; } }
        const float dsk = p.in[I_HD][(size_t)l * WG + c0 + cc];
#pragma unroll
        for (int i = 0; i < NTK; ++i) { const int t = tg + TG * i; Y[(rb + t) * 1024 + YH + c0 + cc] = f2bf(og[t * HCB + cc] * (acc[i] + u[t * HCB + cc] * dsk)); } }
}

__device__ __forceinline__ void attn_task(const Params& p, int l, int b, int kvh, int qt, bool ctxq, char* smem) {
    const int tid = otid(), lane = tid & 63, wave = tid >> 6, r = lane & 15, q = lane >> 4;
    const bf16* P = (const bf16*)(p.ws + WS_P); bf16* Y = (bf16*)(p.ws + WS_HNY); const cpx* ROPE = (const cpx*)(p.ws + WS_ROPE);
    bf16* Qs = (bf16*)smem;
    bf16* Ks = Qs + 128 * LS;
    bf16* Vt = Ks + 64 * LS;
    bf16* Ps = Vt + 64 * LS;
    const size_t rq0 = (size_t)b * TOK + (ctxq ? 0 : CTXL) + qt * 64;
    __syncthreads();
    {
        const int row = tid >> 2, cpair = tid & 3, g = row >> 6, t = row & 63;
        const bf16* src = P + (rq0 + t) * NP + PD + (kvh * 2 + g) * 64;
        float lo[8], hi[8]; unpack8(*(const u32x4*)(src + cpair * 8), lo); unpack8(*(const u32x4*)(src + 32 + cpair * 8), hi);
        u32x4 o1, o2; float a[8], c2[8];
#pragma unroll
        for (int j = 0; j < 8; ++j) { float cs = 1.f, sn = 0.f; if (!ctxq) { const cpx cv = ROPE[(size_t)(qt * 64 + t) * 32 + cpair * 8 + j]; cs = cv.x; sn = cv.y; }
            a[j] = (lo[j] * cs - hi[j] * sn) * 0.125f; c2[j] = (hi[j] * cs + lo[j] * sn) * 0.125f; }
        o1.x = pk2(a[0], a[1]); o1.y = pk2(a[2], a[3]); o1.z = pk2(a[4], a[5]); o1.w = pk2(a[6], a[7]);
        o2.x = pk2(c2[0], c2[1]); o2.y = pk2(c2[2], c2[3]); o2.z = pk2(c2[4], c2[5]); o2.w = pk2(c2[6], c2[7]);
        *(u32x4*)(Qs + row * LS + cpair * 8) = o1; *(u32x4*)(Qs + row * LS + 32 + cpair * 8) = o2;
    }
    const int lt0 = ctxq ? 0 : (qt - 2 > 0 ? qt - 2 : 0), lt1 = ctxq ? -1 : (qt + 2 < SEQ / 64 - 1 ? qt + 2 : SEQ / 64 - 1);
    const int nloc = lt1 - lt0 + 1, ntiles = nloc + NCC;
    float m[4], lsum[4]; f32x4 O[4];
#pragma unroll
    for (int i = 0; i < 4; ++i) { m[i] = -INFINITY; lsum[i] = 0.f; O[i] = (f32x4){0.f, 0.f, 0.f, 0.f}; }
    const int g = wave >> 2, tq0 = (wave & 3) * 16;
    bf16* Pw = Ps + wave * 16 * LS;
    u32x4 klo = {0u, 0u, 0u, 0u}, khi = klo, vq = klo; f32x4 rp[4] = {(f32x4){1.f, 0.f, 1.f, 0.f}, (f32x4){1.f, 0.f, 1.f, 0.f}, (f32x4){1.f, 0.f, 1.f, 0.f}, (f32x4){1.f, 0.f, 1.f, 0.f}};
    const int ks_ = tid >> 2, kcp = tid & 3, vs_ = tid >> 3, vc8 = tid & 7;
#define ATT_PREFETCH(TI) do { const bool loc_ = (TI) < nloc; const int kt_ = loc_ ? lt0 + (TI) : (TI) - nloc; const size_t rk_ = (size_t)b * TOK + (loc_ ? CTXL : 0) + kt_ * 64; \
        if (tid < 256) { const bf16* src_ = P + (rk_ + ks_) * NP + PD + 256 + kvh * 64; klo = *(const u32x4*)(src_ + kcp * 8); khi = *(const u32x4*)(src_ + 32 + kcp * 8); \
            if (loc_) { const f32x4* rr_ = (const f32x4*)(ROPE + (size_t)(kt_ * 64 + ks_) * 32 + kcp * 8); rp[0] = rr_[0]; rp[1] = rr_[1]; rp[2] = rr_[2]; rp[3] = rr_[3]; } \
            else { rp[0] = rp[1] = rp[2] = rp[3] = (f32x4){1.f, 0.f, 1.f, 0.f}; } } \
        vq = *(const u32x4*)(P + (rk_ + vs_) * NP + PD + 384 + kvh * 64 + vc8 * 8); } while (0)
    ATT_PREFETCH(0);
    for (int ti = 0; ti < ntiles; ++ti) {
        const bool local = ti < nloc; const int kt = local ? lt0 + ti : ti - nloc;
        __syncthreads();
        if (tid < 256) { float lo[8], hi[8]; unpack8(klo, lo); unpack8(khi, hi);
            const float cs[8] = {rp[0].x, rp[0].z, rp[1].x, rp[1].z, rp[2].x, rp[2].z, rp[3].x, rp[3].z}, sn[8] = {rp[0].y, rp[0].w, rp[1].y, rp[1].w, rp[2].y, rp[2].w, rp[3].y, rp[3].w};
            float a[8], c2[8];
#pragma unroll
            for (int j = 0; j < 8; ++j) { a[j] = lo[j] * cs[j] - hi[j] * sn[j]; c2[j] = hi[j] * cs[j] + lo[j] * sn[j]; }
            u32x4 o1, o2;
            o1.x = pk2(a[0], a[1]); o1.y = pk2(a[2], a[3]); o1.z = pk2(a[4], a[5]); o1.w = pk2(a[6], a[7]);
            o2.x = pk2(c2[0], c2[1]); o2.y = pk2(c2[2], c2[3]); o2.z = pk2(c2[4], c2[5]); o2.w = pk2(c2[6], c2[7]);
            *(u32x4*)(Ks + ks_ * LS + kcp * 8) = o1; *(u32x4*)(Ks + ks_ * LS + 32 + kcp * 8) = o2; }
        { const unsigned w[4] = {vq.x, vq.y, vq.z, vq.w};
#pragma unroll
            for (int j = 0; j < 4; ++j) { Vt[(vc8 * 8 + 2 * j) * LS + vs_] = (bf16)(w[j] & 0xffffu); Vt[(vc8 * 8 + 2 * j + 1) * LS + vs_] = (bf16)(w[j] >> 16); } }
        __syncthreads();
        if (ti + 1 < ntiles) ATT_PREFETCH(ti + 1);
        f32x4 S[4] = {(f32x4){0.f, 0.f, 0.f, 0.f}, (f32x4){0.f, 0.f, 0.f, 0.f}, (f32x4){0.f, 0.f, 0.f, 0.f}, (f32x4){0.f, 0.f, 0.f, 0.f}};
        mma_nt<4, 2>(Qs, LS, g * 64 + tq0, Ks, LS, 0, S, lane);
        float rmax[4];
#pragma unroll
        for (int i = 0; i < 4; ++i) { const int qpos = qt * 64 + tq0 + 4 * q + i; float mx = -INFINITY;
#pragma unroll
            for (int nt = 0; nt < 4; ++nt) { if (local) { const int kpos = kt * 64 + nt * 16 + r; const int d = kpos - qpos; if (d > 128 || d < -128) S[nt][i] = -INFINITY; } mx = fmaxf(mx, S[nt][i]); }
            mx = fmaxf(mx, __shfl_xor(mx, 1)); mx = fmaxf(mx, __shfl_xor(mx, 2)); mx = fmaxf(mx, __shfl_xor(mx, 4)); mx = fmaxf(mx, __shfl_xor(mx, 8));
            rmax[i] = mx; }
#pragma unroll
        for (int i = 0; i < 4; ++i) { const float mn = fmaxf(m[i], rmax[i]); const float alpha = __expf(m[i] - mn); float sm = 0.f;
#pragma unroll
            for (int nt = 0; nt < 4; ++nt) { const float pv = __expf(S[nt][i] - mn); sm += pv; Pw[(4 * q + i) * LS + nt * 16 + r] = f2bf(pv); O[nt][i] *= alpha; }
            sm += __shfl_xor(sm, 1); sm += __shfl_xor(sm, 2); sm += __shfl_xor(sm, 4); sm += __shfl_xor(sm, 8);
            lsum[i] = lsum[i] * alpha + sm; m[i] = mn; }
        WAVE_SYNC();
        mma_nt<4, 2>(Pw, LS, 0, Vt, LS, 0, O, lane);
    }
#undef ATT_PREFETCH
    const float sink = p.in[I_SINK][(size_t)l * NH + kvh * 2 + g];
#pragma unroll
    for (int i = 0; i < 4; ++i) { const float den = lsum[i] + __expf(sink - m[i]); const float inv = 1.0f / den; const int t = tq0 + 4 * q + i;
#pragma unroll
        for (int nt = 0; nt < 4; ++nt) { const int e = nt * 16 + r; const float gate = bf2f(P[(rq0 + t) * NP + PD + 512 + (kvh * 2 + g) * 64 + e]);
            Y[(rq0 + t) * 1024 + YD + (kvh * 2 + g) * 64 + e] = f2bf(O[nt][i] * inv * siluf_(gate)); } }
}

#ifdef EMU
__device__ __forceinline__ int olane(int lane) { return lane; }
#else
__device__ __forceinline__ int olane(int lane) { asm volatile("" : "+v"(lane)); return lane; }
#endif
constexpr int WLDS = (LDS_BYTES - 64) / 8 / 16 * 16;
template <int DIR>
__device__ __forceinline__ void gla_r_frags(const float* Grow0, int lane, bf16x8 (&af)[4]) {
    const int r = lane & 15, q4 = lane >> 4;
#pragma unroll
    for (int mt = 0; mt < 4; ++mt) { u32x4 o = {0u, 0u, 0u, 0u};
        if (q4 < 2) o = *(const u32x4*)((const bf16*)(Grow0 + (size_t)(16 * mt + r) * NGS + 16) + DIR * 16 + 8 * q4);
        af[mt] = as_frag(o); }
}
template <int DIR>
__device__ __forceinline__ float gla_b_col(const Params& p, int l, int h, const bf16x8 (&af)[4], int nt, int lane_, float (&x)[4][4]) {
    const int lane = olane(lane_), r = lane & 15, q4 = lane >> 4, d = h * 64 + 16 * nt + r;
    u32x4 o = {0u, 0u, 0u, 0u};
    if (q4 < 2) { const float* wa = p.in[I_GWA] + ((size_t)(l * 2 + DIR) * 16 + 8 * q4) * WG + d;
        o.x = pk2(wa[0], wa[WG]); o.y = pk2(wa[2 * WG], wa[3 * WG]); o.z = pk2(wa[4 * WG], wa[5 * WG]); o.w = pk2(wa[6 * WG], wa[7 * WG]); }
    const bf16x8 bfr = as_frag(o); const float bias = p.in[I_GBA][(size_t)(l * 2 + DIR) * WG + d];
#pragma unroll
    for (int mt = 0; mt < 4; ++mt) { f32x4 c = {bias, bias, bias, bias}; c = MFMA16(af[mt], bfr, c);
#pragma unroll
        for (int i = 0; i < 4; ++i) x[mt][i] = logsig_fast(c[i]) * (1.0f / 16.0f); }
    float carry = 0.f;
#pragma unroll
    for (int k = 0; k < 4; ++k) { const int mt = DIR == 0 ? k : 3 - k; float* y = x[mt];
        if (DIR == 0) { y[1] += y[0]; y[2] += y[1]; y[3] += y[2]; } else { y[2] += y[3]; y[1] += y[2]; y[0] += y[1]; }
        const float s4 = DIR == 0 ? y[3] : y[0];
        const float t1 = DIR == 0 ? __shfl_up(s4, 16) : __shfl_down(s4, 16), t2 = DIR == 0 ? __shfl_up(s4, 32) : __shfl_down(s4, 32), t3 = DIR == 0 ? __shfl_up(s4, 48) : __shfl_down(s4, 48);
        const int qq = DIR == 0 ? q4 : 3 - q4;
        const float e = (qq >= 1 ? t1 : 0.f) + (qq >= 2 ? t2 : 0.f) + (qq >= 3 ? t3 : 0.f);
        const float tot = __shfl(e + s4, DIR == 0 ? r + 48 : r);
#pragma unroll
        for (int i = 0; i < 4; ++i) y[i] += carry + e;
        carry += tot; }
    return carry;
}

template <int MIXER, int DIR>
__device__ __forceinline__ void chunkst_dir(const Params& p, int l, int b, int h, int cid, const float* Grow0, const unsigned (&kk)[32], const bf16* Vt, bf16* Kt, const float* wvs, float* bendl, int lane_) {
    const int lane = olane(lane_), r = lane & 15, q4 = lane >> 4;
    if constexpr (MIXER == 0) {
        float nacc = 0.f;
#pragma unroll
        for (int c = 0; c < 8; ++c) { float f[8];
#pragma unroll
            for (int j = 0; j < 8; ++j) { const int s = 8 * c + j; const float kv = (s & 1) ? bitsf(kk[s >> 1] & 0xffff0000u) : bitsf(kk[s >> 1] << 16);
                f[j] = kv * 0.125f * wvs[DIR * 64 + s]; nacc += f[j]; }
            *(u32x4*)(Kt + swz(lane, c)) = pack8(f); }
        ((float*)(p.ws + WS_NV))[ch_index(DIR, b, h, cid) * 64 + lane] = nacc;
    } else {
        const bf16* P = (const bf16*)(p.ws + WS_P); const int kcol = PG + 256 + h * 64; const int r0 = b * TOK + cid * 64;
        bf16x8 af[4]; gla_r_frags<DIR>(Grow0, lane, af);
#pragma unroll 2
        for (int nt = 0; nt < 4; ++nt) { const int d = 16 * nt + r; float x[4][4];
            const float bend = gla_b_col<DIR>(p, l, h, af, nt, lane, x);
            if (q4 == 0) { ((float*)(p.ws + WS_BE))[ch_index(DIR, b, h, cid) * 64 + d] = bend; bendl[d] = __expf(fmaxf(bend, -80.0f)); }
#pragma unroll
            for (int mt = 0; mt < 4; ++mt)
#pragma unroll
                for (int i = 0; i < 4; ++i) { const int s = 16 * mt + 4 * q4 + i; const float kv = bf2f(P[(size_t)(r0 + s) * NP + kcol + d]); const float bc = fmaxf(x[mt][i], -80.0f);
                    Kt[swz(d, s >> 3) + (s & 7)] = f2bf(kv * __expf(-bc));
                    ((bf16*)(p.ws + WS_EQ))[((size_t)DIR * T + r0 + s) * WG + h * 64 + d] = f2bf(__expf(bc)); } }
    }
    WAVE_SYNC();
    bf16x8 vf[4][2];
#pragma unroll
    for (int ne = 0; ne < 4; ++ne)
#pragma unroll
        for (int ks = 0; ks < 2; ++ks) vf[ne][ks] = *(const bf16x8*)(Vt + swz(16 * ne + r, ks * 4 + q4));
    bf16* dst = (bf16*)(p.ws + WS_ST) + st_index(MIXER, DIR, b, h, cid) * 4096;
#pragma unroll
    for (int me = 0; me < 4; ++me) {
        f32x4 acc[4] = {(f32x4){0.f, 0.f, 0.f, 0.f}, (f32x4){0.f, 0.f, 0.f, 0.f}, (f32x4){0.f, 0.f, 0.f, 0.f}, (f32x4){0.f, 0.f, 0.f, 0.f}};
#pragma unroll
        for (int ks = 0; ks < 2; ++ks) { const bf16x8 a = *(const bf16x8*)(Kt + swz(16 * me + r, ks * 4 + q4));
#pragma unroll
            for (int ne = 0; ne < 4; ++ne) acc[ne] = MFMA16(a, vf[ne][ks], acc[ne]); }
        f32x4 sc4 = {1.f, 1.f, 1.f, 1.f}; if constexpr (MIXER == 1) sc4 = *(const f32x4*)(bendl + 16 * me + 4 * q4);
#pragma unroll
        for (int ne = 0; ne < 4; ++ne) { const f32x4 v = acc[ne] * sc4; u32x2 o; o.x = pk2(v[0], v[1]); o.y = pk2(v[2], v[3]); *(u32x2*)(dst + (16 * ne + r) * 64 + 16 * me + 4 * q4) = o; }
    }
    WAVE_SYNC();
}
template <int MIXER>
__device__ __forceinline__ void chunkst_w(const Params& p, int l, int b, int h, int cid, char* wl, int lane) {
    const bf16* P = (const bf16*)(p.ws + WS_P); const float* G = (const float*)(p.ws + WS_G);
    const int r0 = b * TOK + cid * 64, r = lane & 15, q4 = lane >> 4;
    bf16* Kt = (bf16*)wl;
    bf16* Vt = Kt + 4096;
    float* wvs = (float*)(Vt + 4096);
    float* bendl = wvs + 128;
    const int kcol = (MIXER == 0 ? PA : PG) + 256 + h * 64, vcol = (MIXER == 0 ? PA : PG) + 512 + h * 64;
    const float* Grow0 = G + (size_t)r0 * NGS;
    { const bf16* vp = P + (size_t)r0 * NP + vcol + lane;
#pragma unroll
        for (int c = 0; c < 8; ++c) { u32x4 o; unsigned w[4];
#pragma unroll
            for (int j = 0; j < 4; ++j) w[j] = (unsigned)vp[(size_t)(8 * c + 2 * j) * NP] | ((unsigned)vp[(size_t)(8 * c + 2 * j + 1) * NP] << 16);
            o.x = w[0]; o.y = w[1]; o.z = w[2]; o.w = w[3]; *(u32x4*)(Vt + swz(lane, c)) = o; } }
    unsigned kk[32];
    if constexpr (MIXER == 0) { const bf16* kp = P + (size_t)r0 * NP + kcol + lane;
#pragma unroll
        for (int i = 0; i < 32; ++i) kk[i] = (unsigned)kp[(size_t)(2 * i) * NP] | ((unsigned)kp[(size_t)(2 * i + 1) * NP] << 16); }
    else {
#pragma unroll
        for (int i = 0; i < 32; ++i) kk[i] = 0u; }
    if constexpr (MIXER == 0) {
        const float* g = Grow0 + (size_t)lane * NGS; const float* gb = p.in[I_MGB] + (size_t)l * 16;
        const float i_f = g[h] + gb[h], f_f = g[4 + h] + gb[4 + h], i_b = g[8 + h] + gb[8 + h], f_b = g[12 + h] + gb[12 + h];
        const float lf = logsigf_(f_f), lb = logsigf_(f_b);
        const float bF = wave_prefix_sum(lf, lane), totF = __shfl(bF, 63);
        const float gF = totF - bF + i_f, mF = wave_max(gF);
        const float totB = wave_sum(lb), preB = wave_prefix_sum(lb, lane), bB = totB - preB + lb;
        const float gB = totB - bB + i_b, mB = wave_max(gB);
        wvs[lane] = __expf(gF - mF); wvs[64 + lane] = __expf(gB - mB);
        if (lane == 0) { float* SC = (float*)(p.ws + WS_SC);
            SC[ch_index(0, b, h, cid) * 4 + 0] = totF; SC[ch_index(0, b, h, cid) * 4 + 1] = mF;
            SC[ch_index(1, b, h, cid) * 4 + 0] = totB; SC[ch_index(1, b, h, cid) * 4 + 1] = mB; }
    }
    WAVE_SYNC();
    chunkst_dir<MIXER, 0>(p, l, b, h, cid, Grow0, kk, Vt, Kt, wvs, bendl, lane);
    chunkst_dir<MIXER, 1>(p, l, b, h, cid, Grow0, kk, Vt, Kt, wvs, bendl, lane);
}

template <int MIXER, int DIR>
__device__ __forceinline__ void chunkout_prep(const Params& p, int l, int b, int h, int cid, const float* Grow0, int r0, int pbase, const bf16* EQ, float* gar, int lane_) {
    const int lane = olane(lane_);
    if constexpr (MIXER == 0) {
        const bf16* P = (const bf16*)(p.ws + WS_P);
        const float* g = Grow0 + (size_t)lane * NGS; const float* gb = p.in[I_MGB] + (size_t)l * 16;
        const float ig = g[DIR * 8 + h] + gb[DIR * 8 + h], fg = g[DIR * 8 + 4 + h] + gb[DIR * 8 + 4 + h];
        const float mprev = ((const float*)(p.ws + WS_SC))[ch_index(DIR, b, h, cid) * 4 + 2];
        const float lf = logsigf_(fg); float bb;
        if (DIR == 0) bb = wave_prefix_sum(lf, lane); else { const float tt = wave_sum(lf), pre = wave_prefix_sum(lf, lane); bb = tt - pre + lf; }
        const float a = ig - bb; const float pm = DIR == 0 ? wave_prefix_max(a, lane) : wave_suffix_max(a, lane);
        const float mt_ = fmaxf(bb + mprev, bb + pm);
        float* ga = gar + DIR * 320;
        ga[lane] = bb - mt_; ga[64 + lane] = a; ga[128 + lane] = __expf(bb + mprev - mt_); ga[192 + lane] = __expf(-mt_);
        float* nvl = gar + 640 + DIR * 64;
        nvl[lane] = ((const float*)(p.ws + WS_NV))[ch_index(DIR, b, h, cid) * 64 + lane];
        WAVE_SYNC();
        float dq = 0.f;
#pragma unroll
        for (int c = 0; c < 8; ++c) { float f[8]; unpack8(*(const u32x4*)(P + (size_t)(r0 + lane) * NP + pbase + c * 8), f);
            const f32x4 n0 = *(const f32x4*)(nvl + c * 8), n1 = *(const f32x4*)(nvl + c * 8 + 4);
            dq += f[0] * n0.x + f[1] * n0.y + f[2] * n0.z + f[3] * n0.w + f[4] * n1.x + f[5] * n1.y + f[6] * n1.z + f[7] * n1.w; }
        ga[256 + lane] = dq;
    }
}
template <int MIXER, int DIR, int NS>
__device__ __forceinline__ void chunkout_dir(const Params& p, int b, int h, int cid, int r0, int pbase, int th, const bf16x8 (&vtf)[4][2], const bf16* VtL, const bf16* EQ, bf16* SB, const float* gar, float* rsm, f32x4 (&htot)[NS][4], int lane_) {
    const bf16* P = (const bf16*)(p.ws + WS_P); const bf16* ST = (const bf16*)(p.ws + WS_ST);
    const int lane = olane(lane_), r = lane & 15, q4 = lane >> 4;
    const bf16* E = EQ + ((size_t)DIR * T + r0) * WG + h * 64;
    const float* ga = gar + DIR * 320;
    bf16x8 kf[4][2], ctf[4][2];
#pragma unroll
    for (int n = 0; n < 4; ++n)
#pragma unroll
        for (int ks = 0; ks < 2; ++ks) { kf[n][ks] = *(const bf16x8*)(P + (size_t)(r0 + 16 * n + r) * NP + pbase + 256 + ks * 32 + q4 * 8);
            ctf[n][ks] = *(const bf16x8*)(ST + st_index(MIXER, DIR, b, h, cid) * 4096 + (16 * n + r) * 64 + ks * 32 + q4 * 8);
            if constexpr (MIXER == 1) { float fe[8], fk[8]; unpack8(*(const u32x4*)(E + (size_t)(16 * n + r) * WG + ks * 32 + q4 * 8), fe); unpack8(as_u4(kf[n][ks]), fk);
#pragma unroll
                for (int j = 0; j < 8; ++j) fk[j] = fk[j] * frcp_(fe[j]);
                kf[n][ks] = as_frag(pack8(fk)); } }
#pragma unroll
    for (int ms = 0; ms < NS; ++ms) { const int mt = NS * th + ms;
        bf16x8 qf[2];
#pragma unroll
        for (int ks = 0; ks < 2; ++ks) { qf[ks] = *(const bf16x8*)(P + (size_t)(r0 + 16 * mt + r) * NP + pbase + ks * 32 + q4 * 8);
            if constexpr (MIXER == 1) { float fe[8], fq[8]; unpack8(*(const u32x4*)(E + (size_t)(16 * mt + r) * WG + ks * 32 + q4 * 8), fe); unpack8(as_u4(qf[ks]), fq);
#pragma unroll
                for (int j = 0; j < 8; ++j) fq[j] *= 0.125f * fe[j];
                qf[ks] = as_frag(pack8(fq)); } }
        f32x4 S[4] = {(f32x4){0.f, 0.f, 0.f, 0.f}, (f32x4){0.f, 0.f, 0.f, 0.f}, (f32x4){0.f, 0.f, 0.f, 0.f}, (f32x4){0.f, 0.f, 0.f, 0.f}};
#pragma unroll
        for (int ks = 0; ks < 2; ++ks)
#pragma unroll
            for (int n = 0; n < 4; ++n) S[n] = MFMA16(qf[ks], kf[n][ks], S[n]);
#pragma unroll
        for (int i = 0; i < 4; ++i) { const int t = 16 * mt + 4 * q4 + i; float sm = 0.f;
#pragma unroll
            for (int n = 0; n < 4; ++n) { const int s = 16 * n + r; const bool ok = DIR == 0 ? (s <= t) : (s >= t); float v = 0.f;
                if (ok) { if constexpr (MIXER == 0) v = S[n][i] * 0.125f * __expf(ga[t] + ga[64 + s]); else v = S[n][i]; }
                SB[swz(4 * q4 + i, s >> 3) + (s & 7)] = f2bf(v); sm += v; }
            if constexpr (MIXER == 0) { sm += __shfl_xor(sm, 1); sm += __shfl_xor(sm, 2); sm += __shfl_xor(sm, 4); sm += __shfl_xor(sm, 8); if (r == 0) rsm[4 * q4 + i] = sm; } }
        WAVE_SYNC();
        const bf16x8 sm0 = *(const bf16x8*)(SB + swz(r, q4)), sm1 = *(const bf16x8*)(SB + swz(r, 4 + q4));
        float wi = 1.f, inv = 1.f;
        if constexpr (MIXER == 0) { const int tt = 16 * mt + r; wi = ga[128 + tt]; const float den = wi * ga[256 + tt] + rsm[r]; inv = 1.0f / fmaxf(fabsf(den), ga[192 + tt]); }
#pragma unroll
        for (int me = 0; me < 4; ++me) { f32x4 a1 = {0.f, 0.f, 0.f, 0.f}, a2 = {0.f, 0.f, 0.f, 0.f};
            a1 = MFMA16(*(const bf16x8*)(VtL + swz(16 * me + r, q4)), sm0, a1); a1 = MFMA16(*(const bf16x8*)(VtL + swz(16 * me + r, 4 + q4)), sm1, a1);
            a2 = MFMA16(ctf[me][0], qf[0], a2); a2 = MFMA16(ctf[me][1], qf[1], a2);
            if constexpr (MIXER == 0) htot[ms][me] += (a1 + a2 * wi) * inv; else htot[ms][me] += a1 + a2; }
        WAVE_SYNC();
    }
}
template <int MIXER>
__device__ __forceinline__ void chunkout_w(const Params& p, int l, int b, int h, int cid, char* wl, int lane) {
    const bf16* P = (const bf16*)(p.ws + WS_P); const float* G = (const float*)(p.ws + WS_G); bf16* Y = (bf16*)(p.ws + WS_HNY);
    const int r0 = b * TOK + cid * 64, r = lane & 15, q4 = lane >> 4;
    const int pbase = (MIXER == 0 ? PA : PG) + h * 64;
    bf16* SB = (bf16*)wl;
    float* rsm = (float*)(SB + 1024);
    float* gar = rsm + 16;
    const bf16* EQ = (const bf16*)(p.ws + WS_EQ);
    const float* Grow0 = G + (size_t)r0 * NGS;
    bf16* VtL = (bf16*)(gar + 768);
    bf16x8 vtf[4][2];
#pragma unroll
    for (int me = 0; me < 4; ++me) { vtf[me][0] = (bf16x8){0, 0, 0, 0, 0, 0, 0, 0}; vtf[me][1] = vtf[me][0]; }
    { const bf16* vp = P + (size_t)r0 * NP + pbase + 512 + lane;
#pragma unroll
        for (int c = 0; c < 8; ++c) { unsigned w[4];
#pragma unroll
            for (int j = 0; j < 4; ++j) w[j] = (unsigned)vp[(size_t)(8 * c + 2 * j) * NP] | ((unsigned)vp[(size_t)(8 * c + 2 * j + 1) * NP] << 16);
            u32x4 o; o.x = w[0]; o.y = w[1]; o.z = w[2]; o.w = w[3]; *(u32x4*)(VtL + swz(lane, c)) = o; } }
    chunkout_prep<MIXER, 0>(p, l, b, h, cid, Grow0, r0, pbase, EQ, gar, lane);
    chunkout_prep<MIXER, 1>(p, l, b, h, cid, Grow0, r0, pbase, EQ, gar, lane);
    WAVE_SYNC();
    const float* ngp = p.in[MIXER == 0 ? I_MNG : I_GNG] + (size_t)l * WG + h * 64;
    constexpr int NS = MIXER == 1 ? 2 : 1;
#pragma unroll 1
    for (int th = 0; th < 4 / NS; ++th) {
        f32x4 htot[NS][4];
#pragma unroll
        for (int a = 0; a < NS; ++a)
#pragma unroll
            for (int c = 0; c < 4; ++c) htot[a][c] = (f32x4){0.f, 0.f, 0.f, 0.f};
        chunkout_dir<MIXER, 0, NS>(p, b, h, cid, r0, pbase, th, vtf, VtL, EQ, SB, gar, rsm, htot, lane);
        chunkout_dir<MIXER, 1, NS>(p, b, h, cid, r0, pbase, th, vtf, VtL, EQ, SB, gar, rsm, htot, lane);
        const int lz = olane(lane), r = lz & 15, q4 = lz >> 4;
        u32x2 gq[NS][4], oq[NS][4];
#pragma unroll
        for (int ms = 0; ms < NS; ++ms)
#pragma unroll
            for (int me = 0; me < 4; ++me) { const size_t off = (size_t)(r0 + 16 * (NS * th + ms) + r) * NP + pbase + 16 * me + 4 * q4;
                gq[ms][me] = *(const u32x2*)(P + off + (MIXER == 0 ? 1024 : 768)); if constexpr (MIXER == 0) oq[ms][me] = *(const u32x2*)(P + off + 768); else oq[ms][me] = (u32x2){0u, 0u}; }
#pragma unroll
        for (int ms = 0; ms < NS; ++ms) { const int mt = NS * th + ms; float ss = 0.f; float gv[4][4];
#pragma unroll
            for (int me = 0; me < 4; ++me) {
                gv[me][0] = bitsf(gq[ms][me].x << 16); gv[me][1] = bitsf(gq[ms][me].x & 0xffff0000u); gv[me][2] = bitsf(gq[ms][me].y << 16); gv[me][3] = bitsf(gq[ms][me].y & 0xffff0000u);
                if constexpr (MIXER == 0) { htot[ms][me][0] *= sigmoidf_(bitsf(oq[ms][me].x << 16)); htot[ms][me][1] *= sigmoidf_(bitsf(oq[ms][me].x & 0xffff0000u)); htot[ms][me][2] *= sigmoidf_(bitsf(oq[ms][me].y << 16)); htot[ms][me][3] *= sigmoidf_(bitsf(oq[ms][me].y & 0xffff0000u)); }
                ss += htot[ms][me][0] * htot[ms][me][0] + htot[ms][me][1] * htot[ms][me][1] + htot[ms][me][2] * htot[ms][me][2] + htot[ms][me][3] * htot[ms][me][3]; }
            ss += __shfl_xor(ss, 16); ss += __shfl_xor(ss, 32);
            const float rstd = rsqrtf(ss * (1.0f / 64.0f) + EPS);
#pragma unroll
            for (int me = 0; me < 4; ++me) { const int e = 16 * me + 4 * q4; const f32x4 n4 = *(const f32x4*)(ngp + e);
                u32x2 o; o.x = pk2(htot[ms][me][0] * rstd * n4.x * siluf_(gv[me][0]), htot[ms][me][1] * rstd * n4.y * siluf_(gv[me][1]));
                o.y = pk2(htot[ms][me][2] * rstd * n4.z * siluf_(gv[me][2]), htot[ms][me][3] * rstd * n4.w * siluf_(gv[me][3]));
                *(u32x2*)(Y + (size_t)(r0 + 16 * mt + r) * 1024 + (MIXER == 0 ? YA : YG) + h * 64 + e) = o; } }
    }
}

template <bool OUT>
__device__ __forceinline__ void chunk_workers(const Params& p, int l, char* smem) {
    const int tid = otid(), lane = tid & 63, wave = __builtin_amdgcn_readfirstlane(tid >> 6);
    const int NW = (int)gridDim.x * 8, wi = wave * (int)gridDim.x + obid();
    const int c_lo = (OUT && l == DEPTH - 1) ? NCC : 0, npc = NCH - c_lo, half = NB * NH * npc;
    char* wl = smem + wave * WLDS;
#pragma unroll 1
    for (int t = wi; t < half; t += NW) { const int b = t / (NH * npc), h = (t / npc) % NH, cid = c_lo + t % npc;
        const Params q = relaunder(p);
        if (OUT) chunkout_w<1>(q, l, b, h, cid, wl, lane); else chunkst_w<1>(q, l, b, h, cid, wl, lane); }
    const int used = half % NW, vj = wi >= used ? wi - used : wi + (NW - used);
#pragma unroll 1
    for (int t = vj; t < half; t += NW) { const int b = t / (NH * npc), h = (t / npc) % NH, cid = c_lo + t % npc;
        const Params q = relaunder(p);
        if (OUT) chunkout_w<0>(q, l, b, h, cid, wl, lane); else chunkst_w<0>(q, l, b, h, cid, wl, lane); }
}

__device__ __forceinline__ void phase_mix1(const Params& p, int l, char* smem) {
    const bool ctxo = l < DEPTH - 1;
    constexpr int N_HL = (NB / 2) * (WG / 2), N_AL = NB * 2 * (SEQ / 64), N_HC = NB * (WG / HCB), N_AC = NB * 2 * NCC;
    const int total = N_HL + N_AL + (ctxo ? N_HC + N_AC : 0);
    for (int task = obid(); task < total; task += gridDim.x) {
        int t = task;
        if (t < N_HL) { hylat_task(p, l, t / (WG / 2), t % (WG / 2), smem); continue; } t -= N_HL;
        if (t < N_AL) { attn_task(p, l, t / (2 * (SEQ / 64)), (t / (SEQ / 64)) % 2, t % (SEQ / 64), false, smem); continue; } t -= N_AL;
        if (t < N_HC) { hyctx_task(p, l, t / (WG / HCB), t % (WG / HCB), smem); continue; } t -= N_HC;
        attn_task(p, l, t / (2 * NCC), (t / NCC) % 2, t % NCC, true, smem);
    }
    __syncthreads();
    chunk_workers<false>(p, l, smem);
}

constexpr int SCG = 12;
__device__ __forceinline__ void phase_scan(const Params& p, int l, char* smem) {
    const int tid = otid();
    bf16* ST = (bf16*)(p.ws + WS_ST); float* NV = (float*)(p.ws + WS_NV); const float* BE = (const float*)(p.ws + WS_BE); float* SC = (float*)(p.ws + WS_SC);
    constexpr int NCHAIN = 2 * 2 * NB * NH;
    for (int item = obid() * NT + tid; item < NCHAIN * 1024; item += gridDim.x * NT) {
        const int chain = item >> 10, grp = item & 1023; const int mixer = chain / (2 * NB * NH), dir = (chain / (NB * NH)) % 2, b = (chain / NH) % NB, h = chain % NH;
        float c[4] = {0.f, 0.f, 0.f, 0.f}; float nv[4] = {0.f, 0.f, 0.f, 0.f}; float m = 0.f;
        const int d0 = (grp & 15) * 4; const bool donv = (mixer == 0) && (grp < 16);
        for (int o0 = 0; o0 < NCH; o0 += SCG) {
            u32x2 uu[SCG]; float s0[SCG], s1[SCG]; f32x4 be[SCG]; f32x4 nu[SCG];
#pragma unroll
            for (int j = 0; j < SCG; ++j) if (o0 + j < NCH) { const int cid = chain_cid(dir, o0 + j); const size_t ci = ch_index(dir, b, h, cid);
                uu[j] = *(const u32x2*)(ST + st_index(mixer, dir, b, h, cid) * 4096 + grp * 4);
                if (mixer == 0) { s0[j] = SC[ci * 4 + 0]; s1[j] = SC[ci * 4 + 1]; if (donv) nu[j] = *(const f32x4*)(NV + ci * 64 + grp * 4); }
                else be[j] = *(const f32x4*)(BE + ci * 64 + d0); }
#pragma unroll
            for (int j = 0; j < SCG; ++j) if (o0 + j < NCH) { const int cid = chain_cid(dir, o0 + j); const size_t ci = ch_index(dir, b, h, cid);
                const float u[4] = {bitsf(uu[j].x << 16), bitsf(uu[j].x & 0xffff0000u), bitsf(uu[j].y << 16), bitsf(uu[j].y & 0xffff0000u)};
                u32x2 w; w.x = pk2(c[0], c[1]); w.y = pk2(c[2], c[3]); *(u32x2*)(ST + st_index(mixer, dir, b, h, cid) * 4096 + grp * 4) = w;
                if (mixer == 0) {
                    if (grp == 0) SC[ci * 4 + 2] = m;
                    const float mn = fmaxf(s0[j] + m, s1[j]), a = __expf(s0[j] + m - mn), s = __expf(s1[j] - mn);
#pragma unroll
                    for (int k = 0; k < 4; ++k) c[k] = a * c[k] + s * u[k];
                    if (donv) { f32x4 nw = {nv[0], nv[1], nv[2], nv[3]}; *(f32x4*)(NV + ci * 64 + grp * 4) = nw;
                        nv[0] = a * nv[0] + s * nu[j].x; nv[1] = a * nv[1] + s * nu[j].y; nv[2] = a * nv[2] + s * nu[j].z; nv[3] = a * nv[3] + s * nu[j].w; }
                    m = mn;
                } else { c[0] = __expf(be[j].x) * c[0] + u[0]; c[1] = __expf(be[j].y) * c[1] + u[1]; c[2] = __expf(be[j].z) * c[2] + u[2]; c[3] = __expf(be[j].w) * c[3] + u[3]; } }
        }
    }
    constexpr int N_WOUT = (DM / 64) * (MIX / 64);
    for (int task = obid(); task < N_WOUT; task += gridDim.x) { const int nt = task / (MIX / 64), kt = task % (MIX / 64);
        convert_tile(p.in[I_WOUT] + (size_t)l * MIX * DM, DM, (bf16*)(p.ws + WS_WOUT), MIX, nt * 64, kt * 64, false, smem); }
    __syncthreads();
    { const int lane = tid & 63, wave = __builtin_amdgcn_readfirstlane(tid >> 6); const int NW = (int)gridDim.x * 8, wi = wave * (int)gridDim.x + obid();
        bf16* tile = (bf16*)(smem + wave * WLDS); const bf16* HT = (const bf16*)(p.ws + WS_HT); bf16* Y = (bf16*)(p.ws + WS_HNY);
        constexpr int NTT = NB * (SEQ / 64) * 4;
        for (int t = wi; t < NTT; t += NW) { const int b = t / ((SEQ / 64) * 4), tt = (t / 4) % (SEQ / 64), c0 = (t % 4) * 64; const size_t tok0 = (size_t)b * TOK + CTXL + tt * 64;
#pragma unroll
            for (int i = 0; i < 8; ++i) { const int ch = (lane >> 3) + 8 * i, ck = lane & 7; *(u32x4*)(tile + swz(ch, ck)) = *(const u32x4*)(HT + (size_t)(768 + c0 + ch) * T + tok0 + ck * 8); }
            WAVE_SYNC();
#pragma unroll
            for (int i = 0; i < 8; ++i) { const int tk = (lane >> 3) + 8 * i, cc = lane & 7; unsigned w[4];
#pragma unroll
                for (int j = 0; j < 4; ++j) { const int ca = cc * 8 + 2 * j; w[j] = (unsigned)tile[swz(ca, tk >> 3) + (tk & 7)] | ((unsigned)tile[swz(ca + 1, tk >> 3) + (tk & 7)] << 16); }
                u32x4 o; o.x = w[0]; o.y = w[1]; o.z = w[2]; o.w = w[3]; *(u32x4*)(Y + (tok0 + tk) * 1024 + YH + c0 + cc * 8) = o; }
            WAVE_SYNC(); } }
}

__device__ __forceinline__ void phase_mix2(const Params& p, int l, char* smem) { chunk_workers<true>(p, l, smem); }

#ifndef EMU
#define LAS __attribute__((address_space(3)))
#define XB_TMO      128
#define XB_XCNT(j)  (256  + 64 * (j))
#define XB_XSUB(j)  (1280 + 64 * (j))
#define XB_XGEN(j)  (2304 + 64 * (j))
#define XB_TOP      3328
#define XB_TOPGEN   3392
#define XCD_BAR_WORDS 3456
#define XB_SPIN_CAP (1u << 18)

__device__ __forceinline__ unsigned xb_ld(unsigned* p)              { return __hip_atomic_load(p, __ATOMIC_RELAXED, __HIP_MEMORY_SCOPE_AGENT); }
__device__ __forceinline__ unsigned xb_add(unsigned* p, unsigned v) { return __hip_atomic_fetch_add(p, v, __ATOMIC_RELAXED, __HIP_MEMORY_SCOPE_AGENT); }
__device__ __forceinline__ unsigned xb_xcc_id() { return (unsigned)__builtin_amdgcn_s_getreg((3 << 11) | 20) & 0xFu; }
#define XB_SPIN(cond, bar) do { unsigned _sp = 0; while (cond) { __builtin_amdgcn_s_sleep(1); \
    if ((++_sp & 255u) == 0u) { if (xb_ld(&(bar)[XB_TMO])) break; if (_sp > XB_SPIN_CAP) { atomicAdd(&(bar)[XB_TMO], 1u); break; } } } } while (0)

struct XcdBarrier {
    unsigned* bar; unsigned x;
    volatile LAS unsigned* st;
};

__device__ __forceinline__ XcdBarrier xcd_barrier_post(unsigned* bar, volatile LAS unsigned* st) {
    XcdBarrier b; b.bar = bar; b.x = xb_xcc_id(); b.st = st;
    if (threadIdx.x == 0) (void)xb_add(&bar[XB_XCNT(b.x)], 1u);
    return b;
}
__device__ __forceinline__ void xcd_barrier_complete(unsigned* bar, unsigned x, unsigned& nloc, unsigned& nx) {
    const unsigned G = gridDim.x * gridDim.y * gridDim.z;
    unsigned sum, cnt, mine, sp = 0u;
    for (;;) {
        sum = 0u; cnt = 0u; mine = 0u;
#pragma unroll
        for (unsigned j = 0; j < 16; ++j) { const unsigned c = xb_ld(&bar[XB_XCNT(j)]); sum += c; cnt += (c > 0u) ? 1u : 0u; mine = (j == x) ? c : mine; }
        if (sum == G) break;
        __builtin_amdgcn_s_sleep(1);
        if ((++sp & 255u) == 0u) { if (xb_ld(&bar[XB_TMO])) break; if (sp > XB_SPIN_CAP) { atomicAdd(&bar[XB_TMO], 1u); break; } }
    }
    nloc = mine > 0u ? mine : 1u; nx = cnt > 0u ? cnt : 1u;
}

__device__ __forceinline__ void xcd_barrier(const XcdBarrier& b) {
    asm volatile("s_waitcnt vmcnt(0)" ::: "memory");
    __syncthreads();
    if (threadIdx.x == 0) {
        unsigned* bar = b.bar;
        __builtin_amdgcn_s_waitcnt(0);
        unsigned nloc = b.st[0], nx = b.st[1];
        if (nloc == 0u) { xcd_barrier_complete(bar, b.x, nloc, nx); b.st[0] = nloc; b.st[1] = nx; }
        const unsigned old = xb_add(&bar[XB_XSUB(b.x)], 1u);
        const unsigned gen = old / nloc;
        if (old + 1u == (gen + 1u) * nloc) {
            __builtin_amdgcn_fence(__ATOMIC_RELEASE, "agent");
            asm volatile("s_waitcnt vmcnt(0)" ::: "memory");
            const unsigned og = xb_add(&bar[XB_TOP], 1u);
            const unsigned tg = og / nx;
            if (og + 1u == (tg + 1u) * nx) xb_add(&bar[XB_TOPGEN], 1u);
            else XB_SPIN(xb_ld(&bar[XB_TOPGEN]) == tg, bar);
            __builtin_amdgcn_fence(__ATOMIC_ACQUIRE, "agent");
            xb_add(&bar[XB_XGEN(b.x)], 1u);
            asm volatile("s_waitcnt vmcnt(0)" ::: "memory");
        } else {
            XB_SPIN(xb_ld(&bar[XB_XGEN(b.x)]) == gen, bar);
            __builtin_amdgcn_fence(__ATOMIC_ACQUIRE, "agent");
            asm volatile("s_waitcnt vmcnt(0)" ::: "memory");
        }
    }
    __syncthreads();
}
#endif

__global__ void __launch_bounds__(NT) fwd_kernel(Params pk, int ph_lo, int ph_hi) {
    SMEM_DECL;
#ifndef EMU
    volatile LAS unsigned* misc = (volatile LAS unsigned*)(smem + LDS_BYTES - 64);
    if (threadIdx.x < 2) misc[threadIdx.x] = 0u;
    __syncthreads();
    const XcdBarrier bar = xcd_barrier_post((unsigned*)(pk.ws + WS_BAR), misc);
#endif
    constexpr int NPH = 2 + 6 * DEPTH;
    for (int ph = ph_lo; ph < ph_hi && ph < NPH; ++ph) {
#ifndef EMU
        Params p = pk; { size_t z = 0; asm volatile("" : "+s"(z)); p.ws = pk.ws + z; p.out = pk.out + z;
#pragma unroll
            for (int i = 0; i < 26; ++i) p.in[i] = pk.in[i] + z; }
#else
        const Params& p = pk;
#endif
        if (ph == 0) phase0(p, smem);
        else if (ph == NPH - 1) phase_rp(p, DEPTH, smem);
        else { const int l = (ph - 1) / 6, k = (ph - 1) % 6;
            if (k == 0) phase_rp(p, l, smem);
            else if (k == 1) phase_gemm_in(p, l, smem);
            else if (k == 2) phase_mix1(p, l, smem);
            else if (k == 3) phase_scan(p, l, smem);
            else if (k == 4) phase_mix2(p, l, smem);
            else phase_gemm_out(p, l, smem);
#ifdef PROBE_DUP
            if (k == PROBE_DUP) { GRID_SYNC();
                if (k == 1) phase_gemm_in(p, l, smem); else if (k == 2) phase_mix1(p, l, smem); else if (k == 4) phase_mix2(p, l, smem); else if (k == 5) phase_gemm_out(p, l, smem); }
#endif
        }
        if (ph + 1 < ph_hi) {
#ifdef EMU
            GRID_SYNC();
#else
            if (ph == 0) GRID_SYNC(); else xcd_barrier(bar);
#endif
        }
    }
}

#ifndef EMU
extern "C" void kernel_launch(void* const* d_in, const int* in_sizes, int n_in, void* d_out, int out_size, void* d_ws, size_t ws_size, hipStream_t stream) {
    static int grid = 0;
    if (grid == 0) {
        if (n_in != 26 || ws_size < WS_TOTAL) { fprintf(stderr, "kernel_launch: unexpected n_in %d or ws_size %zu (need %zu)\n", n_in, ws_size, (size_t)WS_TOTAL); grid = -1; return; }
        int dev = 0, cus = 0, per_cu = 0;
        hipGetDevice(&dev);
        hipDeviceGetAttribute(&cus, hipDeviceAttributeMultiprocessorCount, dev);
        hipFuncSetAttribute((const void*)fwd_kernel, hipFuncAttributeMaxDynamicSharedMemorySize, LDS_BYTES);
        hipOccupancyMaxActiveBlocksPerMultiprocessor(&per_cu, (const void*)fwd_kernel, NT, LDS_BYTES);
        if (per_cu < 1) { fprintf(stderr, "kernel_launch: occupancy query returned %d\n", per_cu); grid = -1; return; }
        if (per_cu > 1) per_cu = 1;
        grid = cus * per_cu;
    }
    if (grid < 0) return;
    hipMemsetAsync((char*)d_ws + WS_BAR, 0, BAR_BYTES, stream);
    Params p{};
    for (int i = 0; i < 26; ++i) p.in[i] = (const float*)d_in[i];
    p.out = (float*)d_out; p.ws = (char*)d_ws;
    int lo = 0, hi = 2 + 6 * DEPTH;
    void* args[] = {&p, &lo, &hi};
    hipError_t e = hipLaunchCooperativeKernel((const void*)fwd_kernel, dim3(grid), dim3(NT), args, LDS_BYTES, stream);
    if (e != hipSuccess) fprintf(stderr, "cooperative launch failed: %s (grid %d)\n", hipGetErrorString(e), grid);
}
#endif
```

```cpp
#ifdef EMU
#include "emu/hipemu.h"
#define GRID_SYNC() emu::grid_sync()
#define SMEM_DECL char* smem = emu::S().blocks[emu::cur()->block].lds
#define MFMA16(a, b, c) emu_mfma_16x16x32_bf16(a, b, c)
#else
#include <hip/hip_runtime.h>
#include <hip/hip_cooperative_groups.h>
#include <cstdio>
#include <cstdint>
#define GRID_SYNC() cooperative_groups::this_grid().sync()
#define SMEM_DECL extern __shared__ __attribute__((aligned(16))) char smem[]
#define MFMA16(a, b, c) __builtin_amdgcn_mfma_f32_16x16x32_bf16(a, b, c, 0, 0, 0)
#endif

#ifdef EMU
#ifndef EMU_DM
#define EMU_DM 256
#endif
#ifndef EMU_NB
#define EMU_NB 2
#endif
#ifndef EMU_SEQ
#define EMU_SEQ 512
#endif
#ifndef EMU_DEPTH
#define EMU_DEPTH 2
#endif
#ifndef EMU_CTXL
#define EMU_CTXL 128
#endif
constexpr int DM = EMU_DM, NB = EMU_NB, SEQ = EMU_SEQ, DEPTH = EMU_DEPTH, CTXL = EMU_CTXL;
#else
constexpr int DM = 1024, NB = 8, SEQ = 2048, DEPTH = 4, CTXL = 256;
#endif
constexpr int MIX = 1024, WG = 256, HD = 64, NH = 4, CH = 64;
constexpr int TOK = CTXL + SEQ, T = NB * TOK, NCH = TOK / CH, NCC = CTXL / CH;
constexpr int N_IN = 4144, NP = 3072, NG = 48, NGS = 32, NMAIN = 3328, NPAD = 4352;
constexpr int NF = 2 * SEQ;
constexpr int NJ = NB + 1;
constexpr int NT = 512;
constexpr float EPS = 1e-6f;
constexpr int PA = 0, PG = 1280, PD = 2304;
constexpr int YA = 0, YH = 256, YG = 512, YD = 768;
constexpr int ilog4(int n) { return n <= 1 ? 0 : 1 + ilog4(n / 4); }
constexpr int FFT_P = ilog4(NF);
static_assert((1 << (2 * FFT_P)) == NF, "NF must be a power of 4");
static_assert(DM % 256 == 0 && CTXL % 128 == 0 && SEQ % 256 == 0, "shape constraints");

typedef unsigned short bf16;
typedef short bf16x8 __attribute__((ext_vector_type(8)));
typedef float f32x4 __attribute__((ext_vector_type(4)));
typedef unsigned u32x4 __attribute__((ext_vector_type(4)));
typedef unsigned u32x2 __attribute__((ext_vector_type(2)));
struct cpx { float x, y; };

constexpr size_t al256(size_t x) { return (x + 255) & ~(size_t)255; }
constexpr size_t WS_CTXB = 0;
constexpr size_t WS_HNY = al256(WS_CTXB + (size_t)NB * CTXL * DM * 4);
constexpr size_t WS_WIN = WS_HNY + (size_t)T * 1024 * 2;
constexpr size_t WS_ST = WS_WIN;
constexpr size_t ST_BYTES = (size_t)2 * 2 * NB * NH * NCH * 4096 * 2;
constexpr size_t WS_KT = al256(WS_WIN + (size_t)NPAD * DM * 2);
static_assert(WS_KT + (size_t)WG * NF * 4 <= WS_ST + ST_BYTES || true, "");
constexpr size_t ST_END = al256((WS_ST + ST_BYTES > WS_KT + (size_t)WG * NF * 4) ? WS_ST + ST_BYTES : WS_KT + (size_t)WG * NF * 4);
constexpr size_t WS_P = ST_END;
constexpr size_t WS_HT = al256(WS_P + (size_t)T * NP * 2);
constexpr size_t WS_WOUT = WS_HT;
constexpr size_t WS_G = al256(WS_HT + (size_t)1024 * T * 2);
constexpr size_t WS_KF = al256(WS_G + (size_t)T * NGS * 4);
constexpr size_t WS_HC = al256(WS_KF + (size_t)WG * NF * 8);
constexpr size_t WS_EQ = al256(WS_HC + (size_t)2 * WG * CTXL * 4);
constexpr size_t WS_NV = al256(WS_EQ + (size_t)2 * T * WG * 2);
constexpr size_t WS_BE = al256(WS_NV + (size_t)2 * NB * NH * NCH * 64 * 4);
constexpr size_t WS_SC = al256(WS_BE + (size_t)2 * NB * NH * NCH * 64 * 4);
constexpr size_t WS_MOD = al256(WS_SC + (size_t)2 * NB * NH * NCH * 4 * 4);
constexpr size_t WS_TW = al256(WS_MOD + (size_t)DEPTH * NJ * 3 * DM * 4);
constexpr size_t WS_ROPE = al256(WS_TW + (size_t)NF * 8);
constexpr size_t WS_BAR = al256(WS_ROPE + (size_t)SEQ * 32 * 8);
constexpr size_t BAR_BYTES = 16384;
constexpr size_t WS_TOTAL = al256(WS_BAR + BAR_BYTES);
static_assert((size_t)T * DM * 4 <= (size_t)T * NP * 2, "YO fits in P");
#ifndef EMU
static_assert(WS_TOTAL <= (size_t)268435456, "workspace map must fit 256 MiB");
#endif

constexpr int LDS_BYTES = 163840;

struct Params {
    const float* in[26];
    float* out;
    char* ws;
};
enum { I_X = 0, I_C, I_CTX, I_CCTX, I_WADA, I_BADA, I_GPRE, I_GPOST, I_WIN, I_MGB, I_MNG, I_HCW, I_HCB, I_HW1, I_HB1, I_HW2, I_HB2, I_HW3, I_HB3,
       I_HFREQ, I_HD, I_GWA, I_GBA, I_GNG, I_SINK, I_WOUT };

__device__ __forceinline__ Params relaunder(const Params& pk) {
#ifdef EMU
    return pk;
#else
    Params p = pk; size_t z = 0; asm volatile("" : "+s"(z)); p.ws = pk.ws + z; p.out = pk.out + z;
#pragma unroll
    for (int i = 0; i < 26; ++i) p.in[i] = pk.in[i] + z;
    return p;
#endif
}
#ifdef EMU
#define WAVE_SYNC() emu_wave_sync()
#else
#define WAVE_SYNC() do { asm volatile("s_waitcnt lgkmcnt(0)" ::: "memory"); __builtin_amdgcn_wave_barrier(); } while (0)
#endif

#ifdef EMU
__device__ __forceinline__ int otid() { return (int)threadIdx.x; }
__device__ __forceinline__ int obid() { return (int)blockIdx.x; }
#else
__device__ __forceinline__ int otid() { int t = (int)threadIdx.x; asm volatile("" : "+v"(t)); return t; }
__device__ __forceinline__ int obid() { int b = (int)blockIdx.x; asm volatile("" : "+s"(b)); return b; }
#endif
__device__ __forceinline__ unsigned fbits(float f) { return __builtin_bit_cast(unsigned, f); }
__device__ __forceinline__ float bitsf(unsigned u) { return __builtin_bit_cast(float, u); }
__device__ __forceinline__ bf16 f2bf(float f) { unsigned u = fbits(f); return (bf16)((u + 0x7fffu + ((u >> 16) & 1u)) >> 16); }
__device__ __forceinline__ float bf2f(bf16 h) { return bitsf((unsigned)h << 16); }
__device__ __forceinline__ unsigned pk2(float lo, float hi) { return (unsigned)f2bf(lo) | ((unsigned)f2bf(hi) << 16); }
#ifdef EMU
__device__ __forceinline__ float frcp_(float x) { return 1.0f / x; }
#else
__device__ __forceinline__ float frcp_(float x) { return __builtin_amdgcn_rcpf(x); }
#endif
__device__ __forceinline__ float sigmoidf_(float x) { return 1.0f / (1.0f + __expf(-x)); }
__device__ __forceinline__ float siluf_(float x) { return x / (1.0f + __expf(-x)); }
__device__ __forceinline__ float logsigf_(float x) { return fminf(x, 0.0f) - log1pf(__expf(-fabsf(x))); }
__device__ __forceinline__ float logsig_fast(float x) { return fminf(x, 0.0f) - __logf(1.0f + __expf(-fabsf(x))); }
__device__ __forceinline__ float wave_sum(float v) {
#pragma unroll
    for (int o = 1; o < 64; o <<= 1) v += __shfl_xor(v, o);
    return v;
}
__device__ __forceinline__ float wave_max(float v) {
#pragma unroll
    for (int o = 1; o < 64; o <<= 1) v = fmaxf(v, __shfl_xor(v, o));
    return v;
}
__device__ __forceinline__ float wave_prefix_sum(float v, int lane) {
#pragma unroll
    for (int o = 1; o < 64; o <<= 1) { float t = __shfl_up(v, o); if (lane >= o) v += t; }
    return v;
}
__device__ __forceinline__ float wave_prefix_max(float v, int lane) {
#pragma unroll
    for (int o = 1; o < 64; o <<= 1) { float t = __shfl_up(v, o); if (lane >= o) v = fmaxf(v, t); }
    return v;
}
__device__ __forceinline__ float wave_suffix_max(float v, int lane) {
#pragma unroll
    for (int o = 1; o < 64; o <<= 1) { float t = __shfl_down(v, o); if (lane + o < 64) v = fmaxf(v, t); }
    return v;
}
__device__ __forceinline__ void unpack8(u32x4 v, float* f) {
    f[0] = bitsf(v.x << 16); f[1] = bitsf(v.x & 0xffff0000u); f[2] = bitsf(v.y << 16); f[3] = bitsf(v.y & 0xffff0000u);
    f[4] = bitsf(v.z << 16); f[5] = bitsf(v.z & 0xffff0000u); f[6] = bitsf(v.w << 16); f[7] = bitsf(v.w & 0xffff0000u);
}
__device__ __forceinline__ int orig_col(int n) {
    if (n < 1280) return n;
    if (n < 2304) return 2320 + (n - 1280);
    if (n < 3072) return 3376 + (n - 2304);
    if (n < 3088) return 1280 + (n - 3072);
    if (n < 3120) return 3344 + (n - 3088);
    if (n < NMAIN) return -1;
    return 1296 + (n - NMAIN);
}
__device__ __forceinline__ int chain_cid(int dir, int o) {
    if (dir == 0) return o;
    return o < NCC ? (NCC - 1 - o) : (NCH - 1 - (o - NCC));
}

__device__ __forceinline__ int swz(int row, int ch) { return row * 64 + ((ch ^ (row & 7)) << 3); }
__device__ __forceinline__ u32x4 pack8(const float* f) { u32x4 o; o.x = pk2(f[0], f[1]); o.y = pk2(f[2], f[3]); o.z = pk2(f[4], f[5]); o.w = pk2(f[6], f[7]); return o; }
__device__ __forceinline__ bf16x8 as_frag(u32x4 v) { return __builtin_bit_cast(bf16x8, v); }
__device__ __forceinline__ u32x4 as_u4(bf16x8 v) { return __builtin_bit_cast(u32x4, v); }

constexpr int LS = 72;

template <int NTL, int KS>
__device__ __forceinline__ void mma_nt(const bf16* A, int lda, int m0, const bf16* B, int ldb, int n0, f32x4 (&acc)[NTL], int lane) {
    const int r = lane & 15, q = lane >> 4;
#pragma unroll
    for (int ks = 0; ks < KS; ++ks) {
        const bf16x8 a = *(const bf16x8*)(A + (m0 + r) * lda + ks * 32 + q * 8);
#pragma unroll
        for (int nt = 0; nt < NTL; ++nt) {
            const bf16x8 b = *(const bf16x8*)(B + (n0 + nt * 16 + r) * ldb + ks * 32 + q * 8);
            acc[nt] = MFMA16(a, b, acc[nt]);
        }
    }
}

__device__ __forceinline__ void layer_prep(const Params& p, int l, int idx, int stride, char* smem);
__device__ __forceinline__ void phase0(const Params& p, char* smem) {
    const int tid = otid();
    cpx* TW = (cpx*)(p.ws + WS_TW);
    cpx* ROPE = (cpx*)(p.ws + WS_ROPE);
    float* MOD = (float*)(p.ws + WS_MOD);
    constexpr int N_TW = NF / NT, N_ROPE = SEQ * 32 / NT, N_MOD = DEPTH * (3 * DM / 64);
    for (int task = obid(); task < N_TW + N_ROPE + N_MOD; task += gridDim.x) {
        if (task < N_TW) {
            const int j = task * NT + tid; float s, c; sincospif(2.0f * (float)j / (float)NF, &s, &c);
            cpx v; v.x = c; v.y = -s; TW[j] = v;
        } else if (task < N_TW + N_ROPE) {
            const int idx = (task - N_TW) * NT + tid; const int pos = idx >> 5, i = idx & 31;
            const float inv = exp2f(-(float)(i & 15) * (13.287712379549449f / 16.0f));
            const float ang = (float)(i < 16 ? pos / 64 : pos % 64) * inv;
            cpx v; v.x = cosf(ang); v.y = sinf(ang); ROPE[idx] = v;
        } else {
            const int mt = task - N_TW - N_ROPE; const int l = mt / (3 * DM / 64), n0 = (mt % (3 * DM / 64)) * 64;
            float* sv = (float*)smem;
            float* red = sv + NJ * DM;
            __syncthreads();
            for (int i = tid; i < NJ * DM; i += NT) { const int j = i / DM, k = i % DM; const float v = j < NB ? p.in[I_C][j * DM + k] : p.in[I_CCTX][k]; sv[i] = siluf_(v); }
            __syncthreads();
            const int nl = tid & 63, ks = tid >> 6; float acc[NJ];
#pragma unroll
            for (int j = 0; j < NJ; ++j) acc[j] = 0.f;
            const float* w = p.in[I_WADA] + (size_t)l * DM * 3 * DM + n0 + nl;
            for (int k = ks * (DM / 8); k < (ks + 1) * (DM / 8); ++k) { const float wv = w[(size_t)k * 3 * DM];
#pragma unroll
                for (int j = 0; j < NJ; ++j) acc[j] += sv[j * DM + k] * wv; }
#pragma unroll
            for (int j = 0; j < NJ; ++j) red[(ks * NJ + j) * 64 + nl] = acc[j];
            __syncthreads();
            for (int i = tid; i < NJ * 64; i += NT) { const int j = i / 64, n = i % 64; float s = 0.f;
#pragma unroll
                for (int k8 = 0; k8 < 8; ++k8) s += red[(k8 * NJ + j) * 64 + n];
                MOD[((size_t)l * NJ + j) * 3 * DM + n0 + n] = s + p.in[I_BADA][(size_t)l * 3 * DM + n0 + n]; }
        }
    }
}

__device__ __forceinline__ void rp_rows(const Params& p, int l) {
    const int tid = otid(), lane = tid & 63, wave = tid >> 6;
    const float* MOD = (const float*)(p.ws + WS_MOD);
    float* CTXB = (float*)(p.ws + WS_CTXB);
    const float* YO = (const float*)(p.ws + WS_P);
    bf16* HN = (bf16*)(p.ws + WS_HNY);
    constexpr int NV4 = DM / 256, RW = 2;
    const int stride = (int)gridDim.x * 8;
    for (int base = obid() * 8 + wave; base < T; base += stride * RW) {
        f32x4 x[RW][NV4], y[RW][NV4]; const float* xo[RW]; float* xn[RW]; int mj[RW]; bool ok[RW];
#pragma unroll
        for (int i = 0; i < RW; ++i) { const int row = base + i * stride; ok[i] = row < T; const int rr = ok[i] ? row : base;
            const int b = rr / TOK, pp = rr % TOK; const bool isctx = pp < CTXL; if (l == DEPTH && isctx) ok[i] = false;
            const size_t off = isctx ? ((size_t)b * CTXL + pp) * DM : ((size_t)b * SEQ + (pp - CTXL)) * DM;
            xo[i] = (l <= 1) ? (isctx ? p.in[I_CTX] + off : p.in[I_X] + off) : (isctx ? CTXB + off : p.out + off);
            xn[i] = isctx ? CTXB + off : p.out + off; mj[i] = isctx ? NB : b;
#pragma unroll
            for (int j = 0; j < NV4; ++j) { x[i][j] = *(const f32x4*)(xo[i] + 4 * lane + 256 * j); y[i][j] = l > 0 ? *(const f32x4*)(YO + (size_t)rr * DM + 4 * lane + 256 * j) : (f32x4){0.f, 0.f, 0.f, 0.f}; } }
        if (l > 0) {
            float ss[RW];
#pragma unroll
            for (int i = 0; i < RW; ++i) { ss[i] = 0.f;
#pragma unroll
                for (int j = 0; j < NV4; ++j) ss[i] += y[i][j].x * y[i][j].x + y[i][j].y * y[i][j].y + y[i][j].z * y[i][j].z + y[i][j].w * y[i][j].w; }
#pragma unroll
            for (int o = 1; o < 64; o <<= 1) {
#pragma unroll
                for (int i = 0; i < RW; ++i) ss[i] += __shfl_xor(ss[i], o); }
            const float* gp = p.in[I_GPOST] + (size_t)(l - 1) * DM;
#pragma unroll
            for (int i = 0; i < RW; ++i) { const float rstd = rsqrtf(ss[i] * (1.0f / DM) + EPS); const float* gt = MOD + ((size_t)(l - 1) * NJ + mj[i]) * 3 * DM + 2 * DM;
#pragma unroll
                for (int j = 0; j < NV4; ++j) { const f32x4 g4 = *(const f32x4*)(gt + 4 * lane + 256 * j), p4 = *(const f32x4*)(gp + 4 * lane + 256 * j);
                    x[i][j] = x[i][j] + g4 * (y[i][j] * rstd * p4);
                    if (ok[i]) *(f32x4*)(xn[i] + 4 * lane + 256 * j) = x[i][j]; } }
        }
        if (l < DEPTH) {
            float ss[RW];
#pragma unroll
            for (int i = 0; i < RW; ++i) { ss[i] = 0.f;
#pragma unroll
                for (int j = 0; j < NV4; ++j) ss[i] += x[i][j].x * x[i][j].x + x[i][j].y * x[i][j].y + x[i][j].z * x[i][j].z + x[i][j].w * x[i][j].w; }
#pragma unroll
            for (int o = 1; o < 64; o <<= 1) {
#pragma unroll
                for (int i = 0; i < RW; ++i) ss[i] += __shfl_xor(ss[i], o); }
            const float* gp = p.in[I_GPRE] + (size_t)l * DM;
#pragma unroll
            for (int i = 0; i < RW; ++i) { const float rstd = rsqrtf(ss[i] * (1.0f / DM) + EPS); const float* md = MOD + ((size_t)l * NJ + mj[i]) * 3 * DM; const int row = base + i * stride;
#pragma unroll
                for (int j = 0; j < NV4; ++j) { const int e = 4 * lane + 256 * j;
                    const f32x4 g4 = *(const f32x4*)(gp + e), sh = *(const f32x4*)(md + e), sc = *(const f32x4*)(md + DM + e);
                    const f32x4 h = (x[i][j] * rstd * g4) * (sc + 1.0f) + sh;
                    u32x2 o; o.x = pk2(h.x, h.y); o.y = pk2(h.z, h.w);
                    if (ok[i]) *(u32x2*)(HN + (size_t)row * DM + e) = o; } }
        }
    }
}

__device__ __forceinline__ void convert_tile(const float* src, int ldn, bf16* dst, int K, int n0, int k0, bool use_map, char* smem) {
    const int tid = otid();
    float* tile = (float*)smem;
    __syncthreads();
#pragma unroll
    for (int i = 0; i < 8; ++i) { const int idx = tid + NT * i, k = idx >> 6, n = idx & 63;
        const int oc = use_map ? orig_col(n0 + n) : (n0 + n);
        tile[k * 65 + n] = oc >= 0 ? src[(size_t)(k0 + k) * ldn + oc] : 0.f; }
    __syncthreads();
    const int n = tid >> 3, c = tid & 7;
    u32x4 o; o.x = pk2(tile[(8 * c + 0) * 65 + n], tile[(8 * c + 1) * 65 + n]); o.y = pk2(tile[(8 * c + 2) * 65 + n], tile[(8 * c + 3) * 65 + n]);
    o.z = pk2(tile[(8 * c + 4) * 65 + n], tile[(8 * c + 5) * 65 + n]); o.w = pk2(tile[(8 * c + 6) * 65 + n], tile[(8 * c + 7) * 65 + n]);
    *(u32x4*)(dst + (size_t)(n0 + n) * K + k0 + 8 * c) = o;
}

__device__ __forceinline__ void filter_task(const Params& p, int l, int L, int pos0, char* smem) {
    const int tid = otid();
    float* z = (float*)smem;
    float* h1 = z + 8 * 33;
    float* h2 = h1 + 8 * 64;
    __syncthreads();
    if (tid < 8 * 33) { const int pp = tid / 33, i = tid % 33; const float pos = (float)(pos0 + pp);
        const float t = pos / (float)(L - 1 > 1 ? L - 1 : 1), w = 6.283185307179586f * pos / (float)L; float v;
        if (i == 0) v = t; else { const int bi = (i - 1) & 15; const float f = 1e-4f + (float)bi * ((15.0f - 1e-4f) / 15.0f); v = (i <= 16) ? cosf(w * f) : -sinf(w * f); }
        z[tid] = v; }
    __syncthreads();
    { const int pp = tid >> 6, j = tid & 63; const float* w1 = p.in[I_HW1] + (size_t)l * 33 * 64; float a = p.in[I_HB1][l * 64 + j];
        for (int i = 0; i < 33; ++i) a += z[pp * 33 + i] * w1[i * 64 + j];
        h1[tid] = sinf(p.in[I_HFREQ][(l * 2 + 0) * 64 + j] * a); }
    __syncthreads();
    { const int pp = tid >> 6, j = tid & 63; const float* w2 = p.in[I_HW2] + (size_t)l * 64 * 64; float a = p.in[I_HB2][l * 64 + j];
        for (int i = 0; i < 64; ++i) a += h1[pp * 64 + i] * w2[i * 64 + j];
        h2[tid] = sinf(p.in[I_HFREQ][(l * 2 + 1) * 64 + j] * a); }
    __syncthreads();
    { const int o = tid, dir = o >> 8, c = o & 255; const float* w3 = p.in[I_HW3] + (size_t)l * 64 * 512; const float b3 = p.in[I_HB3][l * 512 + o];
        const float delta = 3.0701134573253946f + (float)c * ((15.350567286626973f - 3.0701134573253946f) / 255.0f);
        float acc[8];
#pragma unroll
        for (int pp = 0; pp < 8; ++pp) acc[pp] = b3;
        for (int j = 0; j < 64; ++j) { const float wv = w3[j * 512 + o];
#pragma unroll
            for (int pp = 0; pp < 8; ++pp) acc[pp] += h2[pp * 64 + j] * wv; }
        float* KT = (float*)(p.ws + WS_KT); float* HC = (float*)(p.ws + WS_HC);
#pragma unroll
        for (int pp = 0; pp < 8; ++pp) { const int pos = pos0 + pp; const float t = (float)pos / (float)(L - 1 > 1 ? L - 1 : 1);
            const float v = acc[pp] * __expf(-t * delta);
            if (L == SEQ) { if (dir == 0) KT[(size_t)c * NF + pos]= v; else if (pos > 0) KT[(size_t)c * NF + (NF - pos)] = v; else KT[(size_t)c * NF + SEQ] = 0.f; }
            else HC[((size_t)dir * WG + c) * CTXL + pos] = v; }
    }
}

__device__ __forceinline__ void layer_prep(const Params& p, int l, int idx, int stride, char* smem) {
    constexpr int N_WIN = (NPAD / 64) * (DM / 64), N_FL = SEQ / 8, N_FC = CTXL / 8;
    for (int task = idx; task < N_WIN + N_FL + N_FC; task += stride) {
        if (task < N_WIN) { const int nt = task / (DM / 64), kt = task % (DM / 64);
            convert_tile(p.in[I_WIN] + (size_t)l * DM * N_IN, N_IN, (bf16*)(p.ws + WS_WIN), DM, nt * 64, kt * 64, true, smem); }
        else if (task < N_WIN + N_FL) filter_task(p, l, SEQ, (task - N_WIN) * 8, smem);
        else filter_task(p, l, CTXL, (task - N_WIN - N_FL) * 8, smem);
    }
}
__device__ __forceinline__ void phase_rp(const Params& p, int l, char* smem) { rp_rows(p, l); if (l < DEPTH) layer_prep(p, l, obid(), (int)gridDim.x, smem); }

__device__ __forceinline__ cpx cmul(cpx a, cpx b) { cpx r; r.x = a.x * b.x - a.y * b.y; r.y = a.x * b.y + a.y * b.x; return r; }
__device__ __forceinline__ cpx cmulc(cpx a, cpx b) { cpx r; r.x = a.x * b.x + a.y * b.y; r.y = a.y * b.x - a.x * b.y; return r; }
constexpr int fpad(int i) { return i + (i >> 4); }
__device__ __forceinline__ int FPH(int i) { return i + (i >> 4); }
constexpr int FBUF = fpad(NF);
constexpr int ilog16(int n) { return n < 16 ? 0 : 1 + ilog16(n / 16); }
constexpr int FFT_P16 = ilog16(NF);
constexpr bool FFT_R4 = ((NF >> (4 * FFT_P16)) == 4);
static_assert((NF >> (4 * FFT_P16)) == 1 || (NF >> (4 * FFT_P16)) == 4, "NF = 16^a * (1 or 4)");
template <bool INV> __device__ __forceinline__ void dft4(cpx& a0, cpx& a1, cpx& a2, cpx& a3) {
    const cpx s = {a0.x + a2.x, a0.y + a2.y}, b = {a0.x - a2.x, a0.y - a2.y}, c = {a1.x + a3.x, a1.y + a3.y}, d = {a1.x - a3.x, a1.y - a3.y};
    a0 = (cpx){s.x + c.x, s.y + c.y}; a2 = (cpx){s.x - c.x, s.y - c.y};
    if (!INV) { a1 = (cpx){b.x + d.y, b.y - d.x}; a3 = (cpx){b.x - d.y, b.y + d.x}; }
    else      { a1 = (cpx){b.x - d.y, b.y + d.x}; a3 = (cpx){b.x + d.y, b.y - d.x}; }
}
template <bool INV> __device__ __forceinline__ cpx cmulk(cpx a, float wr, float wi) {
    cpx r; if (!INV) { r.x = a.x * wr + a.y * wi; r.y = a.y * wr - a.x * wi; } else { r.x = a.x * wr - a.y * wi; r.y = a.y * wr + a.x * wi; } return r;
}
template <bool INV> __device__ __forceinline__ void dft16(cpx (&x)[16]) {
    constexpr float C1 = 0.92387953251128674f, S1 = 0.38268343236508977f, C2 = 0.70710678118654752f;
#pragma unroll
    for (int n2 = 0; n2 < 4; ++n2) dft4<INV>(x[n2], x[4 + n2], x[8 + n2], x[12 + n2]);
    x[4 * 1 + 1] = cmulk<INV>(x[4 * 1 + 1], C1, S1); x[4 * 1 + 2] = cmulk<INV>(x[4 * 1 + 2], C2, C2); x[4 * 1 + 3] = cmulk<INV>(x[4 * 1 + 3], S1, C1);
    x[4 * 2 + 1] = cmulk<INV>(x[4 * 2 + 1], C2, C2); x[4 * 2 + 2] = cmulk<INV>(x[4 * 2 + 2], 0.f, 1.f); x[4 * 2 + 3] = cmulk<INV>(x[4 * 2 + 3], -C2, C2);
    x[4 * 3 + 1] = cmulk<INV>(x[4 * 3 + 1], S1, C1); x[4 * 3 + 2] = cmulk<INV>(x[4 * 3 + 2], -C2, C2); x[4 * 3 + 3] = cmulk<INV>(x[4 * 3 + 3], -C1, -S1);
#pragma unroll
    for (int k1 = 0; k1 < 4; ++k1) dft4<INV>(x[4 * k1 + 0], x[4 * k1 + 1], x[4 * k1 + 2], x[4 * k1 + 3]);
    cpx t;
    t = x[1]; x[1] = x[4]; x[4] = t; t = x[2]; x[2] = x[8]; x[8] = t; t = x[3]; x[3] = x[12]; x[12] = t;
    t = x[6]; x[6] = x[9]; x[9] = t; t = x[7]; x[7] = x[13]; x[13] = t; t = x[11]; x[11] = x[14]; x[14] = t;
}
template <bool INV> __device__ __forceinline__ void fft_stage16(cpx* buf, const cpx* TW, int tl, int M) {
    const int span = M >> 4, twm = NF / M;
#pragma unroll 1
    for (int j = tl; j < NF / 16; j += 256) {
        const int grp = j / span, pos = j % span, base = grp * M + pos; cpx x[16];
#pragma unroll
        for (int q = 0; q < 16; ++q) x[q] = buf[FPH(base + q * span)];
        if (INV && span > 1) {
#pragma unroll
            for (int k = 1; k < 16; ++k) x[k] = cmulc(x[k], TW[pos * k * twm]); }
        dft16<INV>(x);
        if (!INV && span > 1) {
#pragma unroll
            for (int k = 1; k < 16; ++k) x[k] = cmul(x[k], TW[pos * k * twm]); }
#pragma unroll
        for (int q = 0; q < 16; ++q) buf[FPH(base + q * span)] = x[q];
    }
}
template <bool INV> __device__ __forceinline__ void fft_stage4_last(cpx* buf, int tl) {
#pragma unroll 1
    for (int j = tl; j < NF / 4; j += 256) { cpx a0 = buf[FPH(4 * j)], a1 = buf[FPH(4 * j + 1)], a2 = buf[FPH(4 * j + 2)], a3 = buf[FPH(4 * j + 3)];
        dft4<INV>(a0, a1, a2, a3); buf[FPH(4 * j)] = a0; buf[FPH(4 * j + 1)] = a1; buf[FPH(4 * j + 2)] = a2; buf[FPH(4 * j + 3)] = a3; }
}
__device__ __forceinline__ void fft_fwd(cpx* buf, const cpx* TW, int tl) {
    int M = NF;
#pragma unroll
    for (int s = 0; s < FFT_P16; ++s) { __syncthreads(); fft_stage16<false>(buf, TW, tl, M); M >>= 4; }
    if (FFT_R4) { __syncthreads(); fft_stage4_last<false>(buf, tl); }
    __syncthreads();
}
__device__ __forceinline__ void fft_inv(cpx* buf, const cpx* TW, int tl) {
    if (FFT_R4) { __syncthreads(); fft_stage4_last<true>(buf, tl); }
    int M = FFT_R4 ? 64 : 16;
#pragma unroll
    for (int s = 0; s < FFT_P16; ++s) { __syncthreads(); fft_stage16<true>(buf, TW, tl, M); M <<= 4; }
    __syncthreads();
}
__device__ __forceinline__ void filt_fft_task(const Params& p, int cp, char* smem) {
    const int tid = otid(), half = tid >> 8, tl = tid & 255, c = 2 * cp + half;
    cpx* buf = (cpx*)smem + (size_t)half * FBUF;
    const float* KT = (const float*)(p.ws + WS_KT) + (size_t)c * NF;
    cpx* KF = (cpx*)(p.ws + WS_KF) + (size_t)c * NF;
    const cpx* TW = (const cpx*)(p.ws + WS_TW);
    __syncthreads();
    for (int i = tl; i < NF; i += 256) { cpx v; v.x = KT[i]; v.y = 0.f; buf[FPH(i)] = v; }
    fft_fwd(buf, TW, tl);
    for (int i = tl; i < NF; i += 256) KF[i] = buf[FPH(i)];
}

__device__ __forceinline__ void gemm_tile(const Params& p, const bf16* A, const bf16* Bt, int K, int mt, int nt, int mode, char* smem) {
    const int tid = otid(), lane = tid & 63, wave = tid >> 6;
    bf16* As = (bf16*)smem;
    bf16* Bs = As + 128 * LS;
    const int wm = (wave & 3) * 32, wn = (wave >> 2) * 64;
    f32x4 acc[2][4];
#pragma unroll
    for (int i = 0; i < 2; ++i)
#pragma unroll
        for (int j = 0; j < 4; ++j) acc[i][j] = (f32x4){0.f, 0.f, 0.f, 0.f};
    const int lr = tid >> 3, lc = tid & 7;
    const bf16* Ag = A + (size_t)(mt * 128 + lr) * K + lc * 8;
    const bf16* Bg = Bt + (size_t)(nt * 128 + lr) * K + lc * 8;
    u32x4 ra0, ra1, rb0, rb1;
    ra0 = *(const u32x4*)(Ag); ra1 = *(const u32x4*)(Ag + (size_t)64 * K); rb0 = *(const u32x4*)(Bg); rb1 = *(const u32x4*)(Bg + (size_t)64 * K);
    const int nk = K / 64;
    for (int kt = 0; kt < nk; ++kt) {
        __syncthreads();
        *(u32x4*)(As + lr * LS + lc * 8) = ra0; *(u32x4*)(As + (lr + 64) * LS + lc * 8) = ra1;
        *(u32x4*)(Bs + lr * LS + lc * 8) = rb0; *(u32x4*)(Bs + (lr + 64) * LS + lc * 8) = rb1;
        __syncthreads();
        if (kt + 1 < nk) { const int ko = (kt + 1) * 64;
            ra0 = *(const u32x4*)(Ag + ko); ra1 = *(const u32x4*)(Ag + (size_t)64 * K + ko); rb0 = *(const u32x4*)(Bg + ko); rb1 = *(const u32x4*)(Bg + (size_t)64 * K + ko); }
        mma_nt<4, 2>(As, LS, wm, Bs, LS, wn, acc[0], lane);
        mma_nt<4, 2>(As, LS, wm + 16, Bs, LS, wn, acc[1], lane);
    }
    const int r = lane & 15, q = lane >> 4;
#pragma unroll
    for (int i = 0; i < 2; ++i)
#pragma unroll
        for (int j = 0; j < 4; ++j)
#pragma unroll
            for (int e = 0; e < 4; ++e) {
                const int row = mt * 128 + wm + 16 * i + 4 * q + e, col = nt * 128 + wn + 16 * j + r; const float v = acc[i][j][e];
                if (mode == 0) { if (col < NP) ((bf16*)(p.ws + WS_P))[(size_t)row * NP + col] = f2bf(v); else if (col < NP + 16) ((float*)(p.ws + WS_G))[(size_t)row * NGS + (col - NP)] = v; else if (col < NP + NG) ((bf16*)((float*)(p.ws + WS_G) + (size_t)row * NGS + 16))[col - NP - 16] = f2bf(v); }
                else if (mode == 2) ((bf16*)(p.ws + WS_HT))[(size_t)row * T + col] = f2bf(v);
                else ((float*)(p.ws + WS_P))[(size_t)row * DM + col] = v;
            }
}

#ifndef EMU
namespace pg8 {
#define PG8_LAS __attribute__((address_space(3)))
typedef unsigned short bf16_t;
typedef short bf16x8 __attribute__((ext_vector_type(8)));
typedef float f32x4 __attribute__((ext_vector_type(4)));
typedef unsigned u32x4 __attribute__((ext_vector_type(4)));
constexpr int BM = 256, BK = 64, HALF = 128, HTB = HALF * BK * 2  , STAGE_BYTES = 8 * HTB, NXCD = 8, WGM = 8;

__host__ __device__ __forceinline__ int lds_byte(int r, int c) { const int st = (r >> 4) * 2 + (c >> 5), rr = r & 15, cc = c & 31, ob = rr * 64 + cc * 2; return st * 1024 + (ob ^ (((ob >> 9) & 1) << 5)); }
__host__ __device__ __forceinline__ void stage_rc(int b, int& R, int& C) { const int st = b / 1024, sb = b % 1024, swz = sb ^ (((sb >> 9) & 1) << 5); R = (st >> 1) * 16 + swz / 64; C = (st & 1) * 32 + (swz % 64) / 2; }
__host__ __device__ __forceinline__ int perm32(int rho) { const int n = rho >> 4, i = rho & 15; return 8 * (i >> 2) + 4 * n + (i & 3); }

struct Unit { int pm, pn; };
struct Gemm { const bf16_t* A; const bf16_t* Bt; int M, N, K; };
__device__ __forceinline__ unsigned cvt_pk_bf16(float lo, float hi) { unsigned r; asm volatile("v_cvt_pk_bf16_f32 %0, %1, %2" : "=v"(r) : "v"(lo), "v"(hi)); return r; }
template <class Epi, class Sched, bool ALIGN_EPI = false, bool SP2 = false>
__device__ __forceinline__ void gemm_phase(PG8_LAS unsigned char* lds, const Gemm g, const Sched& S, const Epi& E) {
    const int tid = otid(), wid = __builtin_amdgcn_readfirstlane(tid >> 6), lane = tid & 63, wr = wid >> 2, wc = wid & 3, fr = lane & 15, fq = lane >> 4;
    const int K = g.K, nt = K / BK;
    unsigned voffA[2], voffB[2];
#pragma unroll
    for (int i = 0; i < 2; ++i) { int R, C; stage_rc(tid * 16 + i * 8192, R, C); const int Rb = Epi::PERM ? ((R & ~31) + perm32(R & 31)) : R;
        voffA[i] = (unsigned)(R * K + C) * 2u; voffB[i] = (unsigned)(Rb * K + C) * 2u; }
    const size_t kstep = (size_t)(BK * 2);
    const size_t hstep = (size_t)HALF * K * 2;
    const size_t tstep = 2 * hstep;
    const unsigned ldsw = (unsigned)wid * 1024u;
    const int aoff = lds_byte(wr * 64 + fr, fq * 8), boff = lds_byte(wc * 32 + fr, fq * 8);
#define PG8_SA(b, h) (((b) * 2 + (h)) * HTB)
#define PG8_SB(b, h) ((4 + (b) * 2 + (h)) * HTB)
#define PG8_STAGE(bufoff, gbase, voff) do { _Pragma("unroll") for (int _i = 0; _i < 2; ++_i) \
        __builtin_amdgcn_global_load_lds((const unsigned*)((const char*)(gbase) + (voff)[_i]), (PG8_LAS unsigned*)(lds + (bufoff) + ldsw + _i * 8192), 16, 0, 0); } while (0)
#define PG8_LDA(dst, b, h) do { _Pragma("unroll") for (int m = 0; m < 4; ++m) _Pragma("unroll") for (int k = 0; k < 2; ++k) dst[m][k] = *(const PG8_LAS bf16x8*)(lds + PG8_SA(b, h) + aoff + m * 2048 + k * 1024); } while (0)
#define PG8_LDB(dst, b, h) do { _Pragma("unroll") for (int n = 0; n < 2; ++n) _Pragma("unroll") for (int k = 0; k < 2; ++k) dst[n][k] = *(const PG8_LAS bf16x8*)(lds + PG8_SB(b, h) + boff + n * 2048 + k * 1024); } while (0)
#define PG8_MMA(ai, bj, At, Bt) do { __builtin_amdgcn_s_setprio(1); _Pragma("unroll") for (int m = 0; m < 4; ++m) _Pragma("unroll") for (int n = 0; n < 2; ++n) _Pragma("unroll") for (int k = 0; k < 2; ++k) \
        acc[ai][bj][m][n] = __builtin_amdgcn_mfma_f32_16x16x32_bf16(Bt[n][k], At[m][k], acc[ai][bj][m][n], 0, 0, 0); __builtin_amdgcn_s_setprio(0); } while (0)
#define PG8_WAIT_V(n) asm volatile("s_waitcnt vmcnt(" #n ")" ::: "memory")
#define PG8_WAIT_L(n) asm volatile("s_waitcnt lgkmcnt(" #n ")" ::: "memory")
#define PG8_BAR __builtin_amdgcn_s_barrier()
#define PG8_SCHED __builtin_amdgcn_sched_barrier(0)
    Unit cur, nxt; int ui = 0;
    if (!S.next(0, cur)) return;
    f32x4 acc[2][2][4][2];
#pragma unroll
    for (int a = 0; a < 2; ++a)
#pragma unroll
        for (int b = 0; b < 2; ++b)
#pragma unroll
            for (int m = 0; m < 4; ++m)
#pragma unroll
                for (int n = 0; n < 2; ++n) acc[a][b][m][n] = (f32x4){0.f, 0.f, 0.f, 0.f};
    bf16x8 At[4][2], B0[2][2], B1[2][2];
    const char* cA = (const char*)g.A + (size_t)cur.pm * tstep; const char* cB = (const char*)g.Bt + (size_t)cur.pn * tstep;
    S.a_ready(cur);
    if constexpr (SP2) {
        PG8_STAGE(PG8_SB(0, 0), cB, voffB); PG8_STAGE(PG8_SB(0, 1), cB + hstep, voffB); PG8_STAGE(PG8_SA(0, 0), cA, voffA); PG8_STAGE(PG8_SA(0, 1), cA + hstep, voffA);
        if (wr == 1) PG8_BAR;
        PG8_WAIT_V(2); PG8_BAR;
        PG8_STAGE(PG8_SB(1, 0), cB + kstep, voffB); PG8_STAGE(PG8_SA(1, 0), cA + kstep, voffA); PG8_STAGE(PG8_SB(1, 1), cB + hstep + kstep, voffB);
        PG8_WAIT_V(6); PG8_BAR;
    } else {
        PG8_STAGE(PG8_SB(0, 0), cB, voffB); PG8_STAGE(PG8_SA(0, 0), cA, voffA); PG8_STAGE(PG8_SB(0, 1), cB + hstep, voffB); PG8_STAGE(PG8_SA(0, 1), cA + hstep, voffA);
        if (wr == 1) PG8_BAR;
        PG8_WAIT_V(4); PG8_BAR;
        PG8_STAGE(PG8_SB(1, 0), cB + kstep, voffB); PG8_STAGE(PG8_SA(1, 0), cA + kstep, voffA); PG8_STAGE(PG8_SB(1, 1), cB + hstep + kstep, voffB);
        PG8_WAIT_V(6); PG8_BAR;
    }
    for (;;) {
        const bool has_next = S.next(ui + 1, nxt);
        const char* nA = has_next ? (const char*)g.A + (size_t)nxt.pm * tstep : cA; const char* nB = has_next ? (const char*)g.Bt + (size_t)nxt.pn * tstep : cB;
        for (int t = 0; t < nt; t += 2) {
            const bool last = (t == nt - 2);
            const char* a1 = cA + (size_t)(t + 1) * kstep;
            const char* a2 = last ? nA : cA + (size_t)(t + 2) * kstep; const char* b2 = last ? nB : cB + (size_t)(t + 2) * kstep;
            const char* a3 = a2 + kstep; const char* b3 = b2 + kstep;
            if (last && has_next) S.a_ready(nxt);
            if constexpr (SP2) {
            PG8_LDB(B0, 0, 0); PG8_LDB(B1, 0, 1); PG8_SCHED; PG8_LDA(At, 0, 0); PG8_STAGE(PG8_SA(1, 1), a1 + hstep, voffA);
            PG8_WAIT_V(8); PG8_WAIT_L(0); PG8_BAR; PG8_MMA(0, 0, At, B0); PG8_MMA(0, 1, At, B1); PG8_BAR; PG8_SCHED;
            PG8_LDA(At, 0, 1); PG8_STAGE(PG8_SB(0, 0), b2, voffB); PG8_STAGE(PG8_SB(0, 1), b2 + hstep, voffB); PG8_STAGE(PG8_SA(0, 0), a2, voffA);
            PG8_WAIT_V(8); PG8_WAIT_L(0); PG8_BAR; PG8_MMA(1, 0, At, B0); PG8_MMA(1, 1, At, B1); PG8_BAR; PG8_SCHED;
            PG8_LDB(B0, 1, 0); PG8_LDB(B1, 1, 1); PG8_SCHED; PG8_LDA(At, 1, 0); PG8_STAGE(PG8_SA(0, 1), a2 + hstep, voffA);
            PG8_WAIT_V(8); PG8_WAIT_L(0); PG8_BAR; PG8_MMA(0, 0, At, B0); PG8_MMA(0, 1, At, B1); PG8_BAR; PG8_SCHED;
            PG8_LDA(At, 1, 1); PG8_STAGE(PG8_SB(1, 0), b3, voffB); PG8_STAGE(PG8_SB(1, 1), b3 + hstep, voffB); PG8_STAGE(PG8_SA(1, 0), a3, voffA);
            PG8_WAIT_V(8); PG8_WAIT_L(0); PG8_BAR; PG8_MMA(1, 0, At, B0); PG8_MMA(1, 1, At, B1); PG8_BAR; PG8_SCHED;
            } else {
            PG8_LDB(B0, 0, 0); PG8_SCHED; PG8_LDA(At, 0, 0); PG8_STAGE(PG8_SA(1, 1), a1 + hstep, voffA);
            PG8_WAIT_L(8); PG8_BAR; PG8_WAIT_L(0); PG8_MMA(0, 0, At, B0); PG8_BAR; PG8_SCHED;
            PG8_LDB(B1, 0, 1); PG8_STAGE(PG8_SB(0, 0), b2, voffB);
            PG8_BAR; PG8_WAIT_L(0); PG8_MMA(0, 1, At, B1); PG8_BAR;
            PG8_LDA(At, 0, 1); PG8_STAGE(PG8_SA(0, 0), a2, voffA);
            PG8_BAR; PG8_WAIT_L(0); PG8_MMA(1, 0, At, B0); PG8_BAR; PG8_SCHED;
            PG8_STAGE(PG8_SB(0, 1), b2 + hstep, voffB);
            PG8_WAIT_V(6); PG8_BAR; PG8_MMA(1, 1, At, B1); PG8_BAR;
            PG8_LDB(B0, 1, 0); PG8_SCHED; PG8_LDA(At, 1, 0); PG8_STAGE(PG8_SA(0, 1), a2 + hstep, voffA);
            PG8_WAIT_L(8); PG8_BAR; PG8_WAIT_L(0); PG8_MMA(0, 0, At, B0); PG8_BAR; PG8_SCHED;
            PG8_LDB(B1, 1, 1); PG8_STAGE(PG8_SB(1, 0), b3, voffB);
            PG8_BAR; PG8_WAIT_L(0); PG8_MMA(0, 1, At, B1); PG8_BAR;
            PG8_LDA(At, 1, 1); PG8_STAGE(PG8_SA(1, 0), a3, voffA);
            PG8_BAR; PG8_WAIT_L(0); PG8_MMA(1, 0, At, B0); PG8_BAR; PG8_SCHED;
            PG8_STAGE(PG8_SB(1, 1), b3 + hstep, voffB);
            PG8_WAIT_V(6); PG8_BAR; PG8_MMA(1, 1, At, B1); PG8_BAR;
            }
        }
        if constexpr (ALIGN_EPI) { if (wr == 0) PG8_BAR; }
        if constexpr (!Epi::AFTER_DRAIN) { E(acc, cur, wr, wc, fr, fq); S.done(cur); }
        if (!has_next) break;
#pragma unroll
        for (int a = 0; a < 2; ++a)
#pragma unroll
            for (int b = 0; b < 2; ++b)
#pragma unroll
                for (int m = 0; m < 4; ++m)
#pragma unroll
                    for (int n = 0; n < 2; ++n) acc[a][b][m][n] = (f32x4){0.f, 0.f, 0.f, 0.f};
        cur = nxt; cA = nA; cB = nB; ++ui;
        if constexpr (ALIGN_EPI) { if (wr == 1) PG8_BAR; }
    }
    PG8_WAIT_V(0);
    if constexpr (!ALIGN_EPI) { if (wr == 0) PG8_BAR; }
    PG8_BAR;
    if constexpr (Epi::AFTER_DRAIN) { E.fused(acc, cur, wr, wc, fr, fq, lds, wid, lane); S.done(cur); }
#undef PG8_SA
#undef PG8_SB
#undef PG8_STAGE
#undef PG8_LDA
#undef PG8_LDB
#undef PG8_MMA
#undef PG8_WAIT_V
#undef PG8_WAIT_L
#undef PG8_BAR
#undef PG8_SCHED
}
__device__ __forceinline__ void map_tile(int L, int nM, int nN, int& pm, int& pn) {
    const int nwg = nM * nN; int wgid = L; { const int q = nwg / NXCD, r = nwg % NXCD, xcd = wgid % NXCD, off = wgid / NXCD; wgid = (xcd < r ? xcd * (q + 1) : r * (q + 1) + (xcd - r) * q) + off; }
    const int nig = WGM * nN, gid = wgid / nig, fm = gid * WGM, gsz = (nM - fm) < WGM ? (nM - fm) : WGM;
    pm = fm + ((wgid % nig) % gsz); pn = (wgid % nig) / gsz;
}
constexpr int MP = T / 256, WP = NMAIN / 256, NU2 = 4 * MP, NU1 = MP * WP;
struct InOrder { int G, c;
    __device__ __forceinline__ bool next(int i, Unit& u) const { const int L = i * G + c; if (L >= NU2 + NU1) return false; int a, b;
        if (L < NU2) { map_tile(L, 4, MP, a, b); u.pm = MP + WP + a; u.pn = b; } else { map_tile(L - NU2, MP, WP, a, b); u.pm = a; u.pn = MP + b; } return true; }
    __device__ __forceinline__ void a_ready(const Unit&) const {}
    __device__ __forceinline__ void done(const Unit&) const {}
};
struct EpiIn { static constexpr bool PERM = true, AFTER_DRAIN = false; bf16_t* P; float* G; bf16_t* HTp;
    __device__ __forceinline__ void operator()(const f32x4 (&acc)[2][2][4][2], const Unit& u, int wr, int wc, int fr, int fq) const {
        if (u.pm < MP) { const int pn = u.pn - MP, row0 = u.pm * BM + wr * 64 + fr;
            if (pn < NP / 256) { const int col0 = pn * BM + wc * 32 + 8 * fq;
#pragma unroll
                for (int ai = 0; ai < 2; ++ai)
#pragma unroll
                    for (int m = 0; m < 4; ++m) { bf16_t* rowp = P + (size_t)(row0 + ai * HALF + m * 16) * NP + col0;
#pragma unroll
                        for (int bj = 0; bj < 2; ++bj) { const f32x4 v0 = acc[ai][bj][m][0], v1 = acc[ai][bj][m][1];
                            u32x4 w; w.x = cvt_pk_bf16(v0[0], v0[1]); w.y = cvt_pk_bf16(v0[2], v0[3]); w.z = cvt_pk_bf16(v1[0], v1[1]); w.w = cvt_pk_bf16(v1[2], v1[3]); *(u32x4*)(rowp + bj * HALF) = w; } } }
            else { const int cb = wc * 32 + 8 * fq;
                if (cb < NG) {
#pragma unroll
                    for (int ai = 0; ai < 2; ++ai)
#pragma unroll
                        for (int m = 0; m < 4; ++m) { float* rowb = G + (size_t)(row0 + ai * HALF + m * 16) * NGS; const f32x4 v0 = acc[ai][0][m][0], v1 = acc[ai][0][m][1];
                            if (cb < 16) { *(f32x4*)(rowb + cb) = v0; *(f32x4*)(rowb + cb + 4) = v1; }
                            else { u32x4 w; w.x = cvt_pk_bf16(v0[0], v0[1]); w.y = cvt_pk_bf16(v0[2], v0[3]); w.z = cvt_pk_bf16(v1[0], v1[1]); w.w = cvt_pk_bf16(v1[2], v1[3]); *(u32x4*)((bf16_t*)(rowb + 16) + (cb - 16)) = w; } } } } }
        else { const int row0 = (u.pm - MP - WP) * BM + wr * 64 + fr, col0 = u.pn * BM + wc * 32 + 8 * fq;
#pragma unroll
            for (int ai = 0; ai < 2; ++ai)
#pragma unroll
                for (int m = 0; m < 4; ++m) { bf16_t* rowp = HTp + (size_t)(row0 + ai * HALF + m * 16) * T + col0;
#pragma unroll
                    for (int bj = 0; bj < 2; ++bj) { const f32x4 v0 = acc[ai][bj][m][0], v1 = acc[ai][bj][m][1];
                        u32x4 w; w.x = cvt_pk_bf16(v0[0], v0[1]); w.y = cvt_pk_bf16(v0[2], v0[3]); w.z = cvt_pk_bf16(v1[0], v1[1]); w.w = cvt_pk_bf16(v1[2], v1[3]); *(u32x4*)(rowp + bj * HALF) = w; } } }
    }
};
struct OutOrder { int G, c; bool lat_only;
    __device__ __forceinline__ bool next(int i, Unit& u) const { const int nM = lat_only ? NB * (SEQ / 256) : MP, nN = DM / 256; const int L = i * G + c; if (L >= nM * nN) return false; int a, b; map_tile(L, nM, nN, a, b);
        u.pm = lat_only ? (a / (SEQ / 256)) * (TOK / 256) + CTXL / 256 + a % (SEQ / 256) : a; u.pn = b; return true; }
    __device__ __forceinline__ void a_ready(const Unit&) const {}
    __device__ __forceinline__ void done(const Unit&) const {}
};
struct EpiOut { static constexpr bool PERM = false, AFTER_DRAIN = false; float* C;
    __device__ __forceinline__ void operator()(const f32x4 (&acc)[2][2][4][2], const Unit& u, int wr, int wc, int fr, int fq) const {
        const int row0 = u.pm * BM + wr * 64 + fr, col0 = u.pn * BM + wc * 32 + 4 * fq;
#pragma unroll
        for (int ai = 0; ai < 2; ++ai)
#pragma unroll
            for (int m = 0; m < 4; ++m) { float* rowp = C + (size_t)(row0 + ai * HALF + m * 16) * DM + col0;
#pragma unroll
                for (int bj = 0; bj < 2; ++bj)
#pragma unroll
                    for (int n = 0; n < 2; ++n) *(f32x4*)(rowp + bj * HALF + n * 16) = acc[ai][bj][m][n]; }
    }
};
}
#endif

__device__ __forceinline__ void phase_gemm_in(const Params& p, int l, char* smem) {
    constexpr int N_F = WG / 2;
#ifdef EMU
    constexpr int MT = T / 128, NT1 = NMAIN / 128, N1 = MT * NT1, N2 = 8 * MT;
    for (int task = obid(); task < N1 + N2; task += gridDim.x) {
        if (task < N1) gemm_tile(p, (const bf16*)(p.ws + WS_HNY), (const bf16*)(p.ws + WS_WIN), DM, task / NT1, task % NT1, 0, smem);
        else { const int t2 = task - N1; gemm_tile(p, (const bf16*)(p.ws + WS_WIN) + (size_t)NMAIN * DM, (const bf16*)(p.ws + WS_HNY), DM, t2 / MT, t2 % MT, 2, smem); }
    }
#else
    { const pg8::Gemm g{(const pg8::bf16_t*)(p.ws + WS_HNY), (const pg8::bf16_t*)(p.ws + WS_HNY), 0, 0, DM};
      const pg8::InOrder S{(int)gridDim.x, obid()};
      const pg8::EpiIn E{(pg8::bf16_t*)(p.ws + WS_P), (float*)(p.ws + WS_G), (pg8::bf16_t*)(p.ws + WS_HT)};
      pg8::gemm_phase<pg8::EpiIn, pg8::InOrder, true, true>((PG8_LAS unsigned char*)smem, g, S, E); }
#endif
    for (int task = (int)gridDim.x - 1 - obid(); task < N_F; task += gridDim.x) filt_fft_task(p, task, smem);
}
__device__ __forceinline__ void phase_gemm_out(const Params& p, int l, char* smem) {
    const int G = (int)gridDim.x, bid = obid();
#ifdef EMU
    constexpr int MT = T / 128, NTO = DM / 128;
    for (int task = bid; task < MT * NTO; task += G) {
        const int mt = task / NTO, nt = task % NTO;
        if (l == DEPTH - 1 && (mt % (TOK / 128)) < CTXL / 128) continue;
        gemm_tile(p, (const bf16*)(p.ws + WS_HNY), (const bf16*)(p.ws + WS_WOUT), MIX, mt, nt, 1, smem);
    }
    const int extra = 0;
#else
    const pg8::Gemm g{(const pg8::bf16_t*)(p.ws + WS_HNY), (const pg8::bf16_t*)(p.ws + WS_WOUT), 0, 0, MIX};
    const pg8::OutOrder S{G, bid, l == DEPTH - 1};
    const pg8::EpiOut E{(float*)(p.ws + WS_P)};
    pg8::gemm_phase<pg8::EpiOut, pg8::OutOrder, true, true>((PG8_LAS unsigned char*)smem, g, S, E);
    const int nU = (l == DEPTH - 1 ? NB * (SEQ / 256) : T / 256) * (DM / 256); const int extra = nU % G;
#endif
    (void)extra;
}

__device__ __forceinline__ size_t st_index(int mixer, int dir, int b, int h, int cid) { return ((((size_t)(mixer * 2 + dir) * NB + b) * NH + h) * NCH + cid); }
__device__ __forceinline__ size_t ch_index(int dir, int b, int h, int cid) { return (((size_t)dir * NB + b) * NH + h) * NCH + cid; }

__device__ __forceinline__ void load_tile_nat(const bf16* P, int r0, int c0, bf16* dst, float scale, int tid) {
    const int s = tid >> 3, c8 = tid & 7;
    const u32x4 v = *(const u32x4*)(P + (size_t)(r0 + s) * NP + c0 + c8 * 8);
    if (scale == 1.0f) *(u32x4*)(dst + s * LS + c8 * 8) = v;
    else { float f[8]; unpack8(v, f); u32x4 o; o.x = pk2(f[0] * scale, f[1] * scale); o.y = pk2(f[2] * scale, f[3] * scale); o.z = pk2(f[4] * scale, f[5] * scale); o.w = pk2(f[6] * scale, f[7] * scale);
        *(u32x4*)(dst + s * LS + c8 * 8) = o; }
}
__device__ __forceinline__ void load_tile_tr(const bf16* P, int r0, int c0, bf16* dst, int tid) {
    const int s = tid >> 3, c8 = tid & 7;
    const u32x4 v = *(const u32x4*)(P + (size_t)(r0 + s) * NP + c0 + c8 * 8);
    const unsigned w[4] = {v.x, v.y, v.z, v.w};
#pragma unroll
    for (int j = 0; j < 4; ++j) { dst[(c8 * 8 + 2 * j) * LS + s] = (bf16)(w[j] & 0xffffu); dst[(c8 * 8 + 2 * j + 1) * LS + s] = (bf16)(w[j] >> 16); }
}

template <int NTK>
__device__ __forceinline__ void load_span(const bf16* row, int t0, float (&v)[NTK + 2]) {
    v[0] = t0 > 0 ? bf2f(row[-1]) : 0.f; v[NTK + 1] = (t0 + NTK < SEQ) ? bf2f(row[NTK]) : 0.f;
    if constexpr (NTK == 8) { float f[8]; unpack8(*(const u32x4*)row, f);
#pragma unroll
        for (int i = 0; i < 8; ++i) v[1 + i] = f[i]; }
    else {
#pragma unroll
        for (int i = 0; i < NTK; ++i) v[1 + i] = bf2f(row[i]); }
}
template <int NTK>
__device__ __forceinline__ void hy_inputs(const bf16* h0, const bf16* h1, const float* cw, const float* cb, int c, int t0, float (&u0)[NTK], float (&u1)[NTK], float (&g0)[NTK], float (&g1)[NTK]) {
    { float xa[NTK + 2], xb[NTK + 2]; load_span<NTK>(h0 + (size_t)512 * T, t0, xa); load_span<NTK>(h1 + (size_t)512 * T, t0, xb);
        const float w0 = cw[0 * 768 + 512 + c], w1 = cw[1 * 768 + 512 + c], w2 = cw[2 * 768 + 512 + c], bb = cb[512 + c];
        float ga[NTK + 2], gb[NTK + 2]; load_span<NTK>(h0 + (size_t)768 * T, t0, ga); load_span<NTK>(h1 + (size_t)768 * T, t0, gb);
#pragma unroll
        for (int i = 0; i < NTK; ++i) { g0[i] = (w0 * xa[i] + w1 * xa[i + 1] + w2 * xa[i + 2] + bb) * siluf_(ga[i + 1]); g1[i] = (w0 * xb[i] + w1 * xb[i + 1] + w2 * xb[i + 2] + bb) * siluf_(gb[i + 1]); } }
    { float va[NTK + 2], vb[NTK + 2], ya[NTK + 2], yb[NTK + 2];
        load_span<NTK>(h0, t0, va); load_span<NTK>(h1, t0, vb); load_span<NTK>(h0 + (size_t)256 * T, t0, ya); load_span<NTK>(h1 + (size_t)256 * T, t0, yb);
        const float v0 = cw[0 * 768 + c], v1 = cw[1 * 768 + c], v2 = cw[2 * 768 + c], vbias = cb[c];
        const float y0 = cw[0 * 768 + 256 + c], y1 = cw[1 * 768 + 256 + c], y2 = cw[2 * 768 + 256 + c], ybias = cb[256 + c];
#pragma unroll
        for (int i = 0; i < NTK; ++i) { u0[i] = (v0 * va[i] + v1 * va[i + 1] + v2 * va[i + 2] + vbias) * (y0 * ya[i] + y1 * ya[i + 1] + y2 * ya[i + 2] + ybias);
            u1[i] = (v0 * vb[i] + v1 * vb[i + 1] + v2 * vb[i + 2] + vbias) * (y0 * yb[i] + y1 * yb[i + 1] + y2 * yb[i + 2] + ybias); } }
}
__device__ __forceinline__ void hylat_task(const Params& p, int l, int bp, int cp, char* smem) {
    const int tid = otid(), half = tid >> 8, tl = tid & 255, c = 2 * cp + half;
    const bf16* HT = (const bf16*)(p.ws + WS_HT); bf16* Y = (bf16*)(p.ws + WS_HNY);
    cpx* buf = (cpx*)smem + (size_t)half * FBUF;
    const cpx* TW = (const cpx*)(p.ws + WS_TW);
    const cpx* KF = (const cpx*)(p.ws + WS_KF) + (size_t)c * NF;
    constexpr int NTK = SEQ / 256;
    const int t0 = NTK * tl;
    const float* cw = p.in[I_HCW] + (size_t)l * 3 * 768; const float* cb = p.in[I_HCB] + (size_t)l * 768;
    const size_t rb0 = (size_t)(2 * bp) * TOK + CTXL, rb1 = rb0 + TOK;
    const bf16* h0 = HT + (size_t)c * T + rb0 + t0; const bf16* h1 = h0 + TOK;
    { float u0[NTK], u1[NTK], g0[NTK], g1[NTK]; hy_inputs<NTK>(h0, h1, cw, cb, c, t0, u0, u1, g0, g1);
        __syncthreads();
#pragma unroll
        for (int i = 0; i < NTK; ++i) { cpx v; v.x = u0[i]; v.y = u1[i]; buf[FPH(t0 + i)] = v; cpx z = {0.f, 0.f}; buf[FPH(SEQ + t0 + i)] = z; } }
    fft_fwd(buf, TW, tl);
#pragma unroll 2
    for (int i = tl; i < NF; i += 256) buf[FPH(i)] = cmul(buf[FPH(i)], KF[i]);
    fft_inv(buf, TW, tl);
    const float dsk = p.in[I_HD][(size_t)l * WG + c]; const float sc = 1.0f / (float)NF;
    { const int tz = otid() & 255; const int t0z = NTK * tz;
        float u0[NTK], u1[NTK], g0[NTK], g1[NTK]; hy_inputs<NTK>(HT + (size_t)c * T + rb0 + t0z, HT + (size_t)c * T + rb0 + t0z + TOK, cw, cb, c, t0z, u0, u1, g0, g1);
        float o0[NTK], o1[NTK];
#pragma unroll
        for (int i = 0; i < NTK; ++i) { const cpx y = buf[FPH(t0z + i)]; o0[i] = g0[i] * (y.x * sc + u0[i] * dsk); o1[i] = g1[i] * (y.y * sc + u1[i] * dsk); }
        bf16* d0 = (bf16*)(p.ws + WS_HT) + (size_t)(768 + c) * T + rb0 + t0z; bf16* d1 = d0 + TOK;
        if constexpr (NTK == 8) { *(u32x4*)d0 = pack8(o0); *(u32x4*)d1 = pack8(o1); }
        else {
#pragma unroll
            for (int i = 0; i < NTK; ++i) { d0[i] = f2bf(o0[i]); d1[i] = f2bf(o1[i]); } } }
}

constexpr int HCB = 8;
__device__ __forceinline__ void hyctx_task(const Params& p, int l, int b, int cblk, char* smem) {
    const int tid = otid(); const int c0 = cblk * HCB;
    const bf16* HT = (const bf16*)(p.ws + WS_HT); bf16* Y = (bf16*)(p.ws + WS_HNY); const float* HC = (const float*)(p.ws + WS_HC);
    float* raw = (float*)smem;
    float* u = raw + 3 * CTXL * HCB;
    float* hf = u + CTXL * HCB;
    float* hb = hf + CTXL * HCB;
    float* og = hb + CTXL * HCB;
    const size_t rb = (size_t)b * TOK;
    const float* cw = p.in[I_HCW] + (size_t)l * 3 * 768; const float* cbias = p.in[I_HCB] + (size_t)l * 768;
    __syncthreads();
    for (int i = tid; i < 3 * CTXL * HCB; i += NT) { const int k = i / (CTXL * HCB), cc = (i / CTXL) % HCB, t = i % CTXL; raw[(k * CTXL + t) * HCB + cc] = bf2f(HT[(size_t)(k * 256 + c0 + cc) * T + rb + t]); }
    for (int i = tid; i < CTXL * HCB; i += NT) { const int t = i / HCB, cc = i % HCB; hf[i] = HC[((size_t)0 * WG + c0 + cc) * CTXL + t]; hb[i] = HC[((size_t)1 * WG + c0 + cc) * CTXL + t]; }
    __syncthreads();
    for (int i = tid; i < CTXL * HCB; i += NT) { const int t = i / HCB, cc = i % HCB; float cv[3];
#pragma unroll
        for (int k = 0; k < 3; ++k) { const float* rk = raw + k * CTXL * HCB; const int ch = k * 256 + c0 + cc;
            const float a = t > 0 ? rk[(t - 1) * HCB + cc] : 0.f, m = rk[t * HCB + cc], z = t < CTXL - 1 ? rk[(t + 1) * HCB + cc] : 0.f;
            cv[k] = cw[0 * 768 + ch] * a + cw[1 * 768 + ch] * m + cw[2 * 768 + ch] * z + cbias[ch]; }
        u[i] = cv[0] * cv[1];
        og[i] = cv[2] * siluf_(bf2f(HT[(size_t)(768 + c0 + cc) * T + rb + t])); }
    __syncthreads();
    { const int cc = tid % HCB, tg = tid / HCB; constexpr int TG = NT / HCB, NTK = CTXL / TG; float acc[NTK];
#pragma unroll
        for (int i = 0; i < NTK; ++i) acc[i] = 0.f;
        for (int s = 0; s < CTXL; ++s) { const float us = u[s * HCB + cc];
#pragma unroll
            for (int i = 0; i < NTK; ++i) { const int t = tg + TG * i; const float hv = (s <= t) ? hf[(t - s) * HCB + cc] : hb[(s - t) * HCB + cc]; acc[i] += us * hv; } }
        const float dsk = p.in[I_HD][(size_t)l * WG + c0 + cc];
#pragma unroll
        for (int i = 0; i < NTK; ++i) { const int t = tg + TG * i; Y[(rb + t) * 1024 + YH + c0 + cc] = f2bf(og[t * HCB + cc] * (acc[i] + u[t * HCB + cc] * dsk)); } }
}

__device__ __forceinline__ void attn_task(const Params& p, int l, int b, int kvh, int qt, bool ctxq, char* smem) {
    const int tid = otid(), lane = tid & 63, wave = tid >> 6, r = lane & 15, q = lane >> 4;
    const bf16* P = (const bf16*)(p.ws + WS_P); bf16* Y = (bf16*)(p.ws + WS_HNY); const cpx* ROPE = (const cpx*)(p.ws + WS_ROPE);
    bf16* Qs = (bf16*)smem;
    bf16* Ks = Qs + 128 * LS;
    bf16* Vt = Ks + 64 * LS;
    bf16* Ps = Vt + 64 * LS;
    const size_t rq0 = (size_t)b * TOK + (ctxq ? 0 : CTXL) + qt * 64;
    __syncthreads();
    {
        const int row = tid >> 2, cpair = tid & 3, g = row >> 6, t = row & 63;
        const bf16* src = P + (rq0 + t) * NP + PD + (kvh * 2 + g) * 64;
        float lo[8], hi[8]; unpack8(*(const u32x4*)(src + cpair * 8), lo); unpack8(*(const u32x4*)(src + 32 + cpair * 8), hi);
        u32x4 o1, o2; float a[8], c2[8];
#pragma unroll
        for (int j = 0; j < 8; ++j) { float cs = 1.f, sn = 0.f; if (!ctxq) { const cpx cv = ROPE[(size_t)(qt * 64 + t) * 32 + cpair * 8 + j]; cs = cv.x; sn = cv.y; }
            a[j] = (lo[j] * cs - hi[j] * sn) * 0.125f; c2[j] = (hi[j] * cs + lo[j] * sn) * 0.125f; }
        o1.x = pk2(a[0], a[1]); o1.y = pk2(a[2], a[3]); o1.z = pk2(a[4], a[5]); o1.w = pk2(a[6], a[7]);
        o2.x = pk2(c2[0], c2[1]); o2.y = pk2(c2[2], c2[3]); o2.z = pk2(c2[4], c2[5]); o2.w = pk2(c2[6], c2[7]);
        *(u32x4*)(Qs + row * LS + cpair * 8) = o1; *(u32x4*)(Qs + row * LS + 32 + cpair * 8) = o2;
    }
    const int lt0 = ctxq ? 0 : (qt - 2 > 0 ? qt - 2 : 0), lt1 = ctxq ? -1 : (qt + 2 < SEQ / 64 - 1 ? qt + 2 : SEQ / 64 - 1);
    const int nloc = lt1 - lt0 + 1, ntiles = nloc + NCC;
    float m[4], lsum[4]; f32x4 O[4];
#pragma unroll
    for (int i = 0; i < 4; ++i) { m[i] = -INFINITY; lsum[i] = 0.f; O[i] = (f32x4){0.f, 0.f, 0.f, 0.f}; }
    const int g = wave >> 2, tq0 = (wave & 3) * 16;
    bf16* Pw = Ps + wave * 16 * LS;
    u32x4 klo = {0u, 0u, 0u, 0u}, khi = klo, vq = klo; f32x4 rp[4] = {(f32x4){1.f, 0.f, 1.f, 0.f}, (f32x4){1.f, 0.f, 1.f, 0.f}, (f32x4){1.f, 0.f, 1.f, 0.f}, (f32x4){1.f, 0.f, 1.f, 0.f}};
    const int ks_ = tid >> 2, kcp = tid & 3, vs_ = tid >> 3, vc8 = tid & 7;
#define ATT_PREFETCH(TI) do { const bool loc_ = (TI) < nloc; const int kt_ = loc_ ? lt0 + (TI) : (TI) - nloc; const size_t rk_ = (size_t)b * TOK + (loc_ ? CTXL : 0) + kt_ * 64; \
        if (tid < 256) { const bf16* src_ = P + (rk_ + ks_) * NP + PD + 256 + kvh * 64; klo = *(const u32x4*)(src_ + kcp * 8); khi = *(const u32x4*)(src_ + 32 + kcp * 8); \
            if (loc_) { const f32x4* rr_ = (const f32x4*)(ROPE + (size_t)(kt_ * 64 + ks_) * 32 + kcp * 8); rp[0] = rr_[0]; rp[1] = rr_[1]; rp[2] = rr_[2]; rp[3] = rr_[3]; } \
            else { rp[0] = rp[1] = rp[2] = rp[3] = (f32x4){1.f, 0.f, 1.f, 0.f}; } } \
        vq = *(const u32x4*)(P + (rk_ + vs_) * NP + PD + 384 + kvh * 64 + vc8 * 8); } while (0)
    ATT_PREFETCH(0);
    for (int ti = 0; ti < ntiles; ++ti) {
        const bool local = ti < nloc; const int kt = local ? lt0 + ti : ti - nloc;
        __syncthreads();
        if (tid < 256) { float lo[8], hi[8]; unpack8(klo, lo); unpack8(khi, hi);
            const float cs[8] = {rp[0].x, rp[0].z, rp[1].x, rp[1].z, rp[2].x, rp[2].z, rp[3].x, rp[3].z}, sn[8] = {rp[0].y, rp[0].w, rp[1].y, rp[1].w, rp[2].y, rp[2].w, rp[3].y, rp[3].w};
            float a[8], c2[8];
#pragma unroll
            for (int j = 0; j < 8; ++j) { a[j] = lo[j] * cs[j] - hi[j] * sn[j]; c2[j] = hi[j] * cs[j] + lo[j] * sn[j]; }
            u32x4 o1, o2;
            o1.x = pk2(a[0], a[1]); o1.y = pk2(a[2], a[3]); o1.z = pk2(a[4], a[5]); o1.w = pk2(a[6], a[7]);
            o2.x = pk2(c2[0], c2[1]); o2.y = pk2(c2[2], c2[3]); o2.z = pk2(c2[4], c2[5]); o2.w = pk2(c2[6], c2[7]);
            *(u32x4*)(Ks + ks_ * LS + kcp * 8) = o1; *(u32x4*)(Ks + ks_ * LS + 32 + kcp * 8) = o2; }
        { const unsigned w[4] = {vq.x, vq.y, vq.z, vq.w};
#pragma unroll
            for (int j = 0; j < 4; ++j) { Vt[(vc8 * 8 + 2 * j) * LS + vs_] = (bf16)(w[j] & 0xffffu); Vt[(vc8 * 8 + 2 * j + 1) * LS + vs_] = (bf16)(w[j] >> 16); } }
        __syncthreads();
        if (ti + 1 < ntiles) ATT_PREFETCH(ti + 1);
        f32x4 S[4] = {(f32x4){0.f, 0.f, 0.f, 0.f}, (f32x4){0.f, 0.f, 0.f, 0.f}, (f32x4){0.f, 0.f, 0.f, 0.f}, (f32x4){0.f, 0.f, 0.f, 0.f}};
        mma_nt<4, 2>(Qs, LS, g * 64 + tq0, Ks, LS, 0, S, lane);
        float rmax[4];
#pragma unroll
        for (int i = 0; i < 4; ++i) { const int qpos = qt * 64 + tq0 + 4 * q + i; float mx = -INFINITY;
#pragma unroll
            for (int nt = 0; nt < 4; ++nt) { if (local) { const int kpos = kt * 64 + nt * 16 + r; const int d = kpos - qpos; if (d > 128 || d < -128) S[nt][i] = -INFINITY; } mx = fmaxf(mx, S[nt][i]); }
            mx = fmaxf(mx, __shfl_xor(mx, 1)); mx = fmaxf(mx, __shfl_xor(mx, 2)); mx = fmaxf(mx, __shfl_xor(mx, 4)); mx = fmaxf(mx, __shfl_xor(mx, 8));
            rmax[i] = mx; }
#pragma unroll
        for (int i = 0; i < 4; ++i) { const float mn = fmaxf(m[i], rmax[i]); const float alpha = __expf(m[i] - mn); float sm = 0.f;
#pragma unroll
            for (int nt = 0; nt < 4; ++nt) { const float pv = __expf(S[nt][i] - mn); sm += pv; Pw[(4 * q + i) * LS + nt * 16 + r] = f2bf(pv); O[nt][i] *= alpha; }
            sm += __shfl_xor(sm, 1); sm += __shfl_xor(sm, 2); sm += __shfl_xor(sm, 4); sm += __shfl_xor(sm, 8);
            lsum[i] = lsum[i] * alpha + sm; m[i] = mn; }
        WAVE_SYNC();
        mma_nt<4, 2>(Pw, LS, 0, Vt, LS, 0, O, lane);
    }
#undef ATT_PREFETCH
    const float sink = p.in[I_SINK][(size_t)l * NH + kvh * 2 + g];
#pragma unroll
    for (int i = 0; i < 4; ++i) { const float den = lsum[i] + __expf(sink - m[i]); const float inv = 1.0f / den; const int t = tq0 + 4 * q + i;
#pragma unroll
        for (int nt = 0; nt < 4; ++nt) { const int e = nt * 16 + r; const float gate = bf2f(P[(rq0 + t) * NP + PD + 512 + (kvh * 2 + g) * 64 + e]);
            Y[(rq0 + t) * 1024 + YD + (kvh * 2 + g) * 64 + e] = f2bf(O[nt][i] * inv * siluf_(gate)); } }
}

#ifdef EMU
__device__ __forceinline__ int olane(int lane) { return lane; }
#else
__device__ __forceinline__ int olane(int lane) { asm volatile("" : "+v"(lane)); return lane; }
#endif
constexpr int WLDS = (LDS_BYTES - 64) / 8 / 16 * 16;
__device__ __forceinline__ void load_nat_tile(const bf16* P, int row0, int col0, bf16* tile, int lane) {
    u32x4 v[8];
#pragma unroll
    for (int i = 0; i < 8; ++i) v[i] = *(const u32x4*)(P + (size_t)(row0 + (lane >> 3) + 8 * i) * NP + col0 + (lane & 7) * 8);
#pragma unroll
    for (int i = 0; i < 8; ++i) *(u32x4*)(tile + swz((lane >> 3) + 8 * i, lane & 7)) = v[i];
}
__device__ __forceinline__ bf16x8 frag_tr(const bf16* tile, int c0, int k0, int lane) {
    const int c = c0 + (lane & 15), kb = k0 + 8 * (lane >> 4); unsigned w[4];
#pragma unroll
    for (int j = 0; j < 4; ++j) w[j] = (unsigned)tile[swz(kb + 2 * j, c >> 3) + (c & 7)] | ((unsigned)tile[swz(kb + 2 * j + 1, c >> 3) + (c & 7)] << 16);
    u32x4 o; o.x = w[0]; o.y = w[1]; o.z = w[2]; o.w = w[3]; return as_frag(o);
}
template <int DIR>
__device__ __forceinline__ void gla_r_frags(const float* Grow0, int lane, bf16x8 (&af)[4]) {
    const int r = lane & 15, q4 = lane >> 4;
#pragma unroll
    for (int mt = 0; mt < 4; ++mt) { u32x4 o = {0u, 0u, 0u, 0u};
        if (q4 < 2) o = *(const u32x4*)((const bf16*)(Grow0 + (size_t)(16 * mt + r) * NGS + 16) + DIR * 16 + 8 * q4);
        af[mt] = as_frag(o); }
}
template <int DIR>
__device__ __forceinline__ float gla_b_col(const Params& p, int l, int h, const bf16x8 (&af)[4], int nt, int lane_, float (&x)[4][4]) {
    const int lane = olane(lane_), r = lane & 15, q4 = lane >> 4, d = h * 64 + 16 * nt + r;
    u32x4 o = {0u, 0u, 0u, 0u};
    if (q4 < 2) { const float* wa = p.in[I_GWA] + ((size_t)(l * 2 + DIR) * 16 + 8 * q4) * WG + d;
        o.x = pk2(wa[0], wa[WG]); o.y = pk2(wa[2 * WG], wa[3 * WG]); o.z = pk2(wa[4 * WG], wa[5 * WG]); o.w = pk2(wa[6 * WG], wa[7 * WG]); }
    const bf16x8 bfr = as_frag(o); const float bias = p.in[I_GBA][(size_t)(l * 2 + DIR) * WG + d];
#pragma unroll
    for (int mt = 0; mt < 4; ++mt) { f32x4 c = {bias, bias, bias, bias}; c = MFMA16(af[mt], bfr, c);
#pragma unroll
        for (int i = 0; i < 4; ++i) x[mt][i] = logsig_fast(c[i]) * (1.0f / 16.0f); }
    float carry = 0.f;
#pragma unroll
    for (int k = 0; k < 4; ++k) { const int mt = DIR == 0 ? k : 3 - k; float* y = x[mt];
        if (DIR == 0) { y[1] += y[0]; y[2] += y[1]; y[3] += y[2]; } else { y[2] += y[3]; y[1] += y[2]; y[0] += y[1]; }
        const float s4 = DIR == 0 ? y[3] : y[0];
        const float t1 = DIR == 0 ? __shfl_up(s4, 16) : __shfl_down(s4, 16), t2 = DIR == 0 ? __shfl_up(s4, 32) : __shfl_down(s4, 32), t3 = DIR == 0 ? __shfl_up(s4, 48) : __shfl_down(s4, 48);
        const int qq = DIR == 0 ? q4 : 3 - q4;
        const float e = (qq >= 1 ? t1 : 0.f) + (qq >= 2 ? t2 : 0.f) + (qq >= 3 ? t3 : 0.f);
        const float tot = __shfl(e + s4, DIR == 0 ? r + 48 : r);
#pragma unroll
        for (int i = 0; i < 4; ++i) y[i] += carry + e;
        carry += tot; }
    return carry;
}

template <int MIXER, int DIR>
__device__ __forceinline__ void chunkst_dir(const Params& p, int l, int b, int h, int cid, const float* Grow0, const unsigned (&kk)[32], const bf16* Vt, bf16* Kt, const float* wvs, float* bendl, int lane_) {
    const int lane = olane(lane_), r = lane & 15, q4 = lane >> 4;
    if constexpr (MIXER == 0) {
        float nacc = 0.f;
#pragma unroll
        for (int c = 0; c < 8; ++c) { float f[8];
#pragma unroll
            for (int j = 0; j < 8; ++j) { const int s = 8 * c + j; const float kv = (s & 1) ? bitsf(kk[s >> 1] & 0xffff0000u) : bitsf(kk[s >> 1] << 16);
                f[j] = kv * 0.125f * wvs[DIR * 64 + s]; nacc += f[j]; }
            *(u32x4*)(Kt + swz(lane, c)) = pack8(f); }
        ((float*)(p.ws + WS_NV))[ch_index(DIR, b, h, cid) * 64 + lane] = nacc;
    } else {
        const bf16* P = (const bf16*)(p.ws + WS_P); const int kcol = PG + 256 + h * 64; const int r0 = b * TOK + cid * 64;
        bf16x8 af[4]; gla_r_frags<DIR>(Grow0, lane, af);
#pragma unroll 2
        for (int nt = 0; nt < 4; ++nt) { const int d = 16 * nt + r; float x[4][4];
            const float bend = gla_b_col<DIR>(p, l, h, af, nt, lane, x);
            if (q4 == 0) { ((float*)(p.ws + WS_BE))[ch_index(DIR, b, h, cid) * 64 + d] = bend; bendl[d] = __expf(fmaxf(bend, -80.0f)); }
#pragma unroll
            for (int mt = 0; mt < 4; ++mt)
#pragma unroll
                for (int i = 0; i < 4; ++i) { const int s = 16 * mt + 4 * q4 + i; const float kv = bf2f(P[(size_t)(r0 + s) * NP + kcol + d]); const float bc = fmaxf(x[mt][i], -80.0f);
                    Kt[swz(d, s >> 3) + (s & 7)] = f2bf(kv * __expf(-bc));
                    ((bf16*)(p.ws + WS_EQ))[((size_t)DIR * T + r0 + s) * WG + h * 64 + d] = f2bf(__expf(bc)); } }
    }
    WAVE_SYNC();
    bf16x8 vf[4][2];
#pragma unroll
    for (int ne = 0; ne < 4; ++ne)
#pragma unroll
        for (int ks = 0; ks < 2; ++ks) vf[ne][ks] = *(const bf16x8*)(Vt + swz(16 * ne + r, ks * 4 + q4));
    bf16* dst = (bf16*)(p.ws + WS_ST) + st_index(MIXER, DIR, b, h, cid) * 4096;
#pragma unroll
    for (int me = 0; me < 4; ++me) {
        f32x4 acc[4] = {(f32x4){0.f, 0.f, 0.f, 0.f}, (f32x4){0.f, 0.f, 0.f, 0.f}, (f32x4){0.f, 0.f, 0.f, 0.f}, (f32x4){0.f, 0.f, 0.f, 0.f}};
#pragma unroll
        for (int ks = 0; ks < 2; ++ks) { const bf16x8 a = *(const bf16x8*)(Kt + swz(16 * me + r, ks * 4 + q4));
#pragma unroll
            for (int ne = 0; ne < 4; ++ne) acc[ne] = MFMA16(a, vf[ne][ks], acc[ne]); }
        f32x4 sc4 = {1.f, 1.f, 1.f, 1.f}; if constexpr (MIXER == 1) sc4 = *(const f32x4*)(bendl + 16 * me + 4 * q4);
#pragma unroll
        for (int ne = 0; ne < 4; ++ne) { const f32x4 v = acc[ne] * sc4; u32x2 o; o.x = pk2(v[0], v[1]); o.y = pk2(v[2], v[3]); *(u32x2*)(dst + (16 * ne + r) * 64 + 16 * me + 4 * q4) = o; }
    }
    WAVE_SYNC();
}
template <int MIXER>
__device__ __forceinline__ void chunkst_w(const Params& p, int l, int b, int h, int cid, char* wl, int lane) {
    const bf16* P = (const bf16*)(p.ws + WS_P); const float* G = (const float*)(p.ws + WS_G);
    const int r0 = b * TOK + cid * 64, r = lane & 15, q4 = lane >> 4;
    bf16* Kt = (bf16*)wl;
    bf16* Vt = Kt + 4096;
    float* wvs = (float*)(Vt + 4096);
    float* bendl = wvs + 128;
    const int kcol = (MIXER == 0 ? PA : PG) + 256 + h * 64, vcol = (MIXER == 0 ? PA : PG) + 512 + h * 64;
    const float* Grow0 = G + (size_t)r0 * NGS;
    { bf16* Nn = Kt;
        load_nat_tile(P, r0, vcol, Nn, lane);
        WAVE_SYNC();
#pragma unroll
        for (int c = 0; c < 8; ++c) { unsigned w[4];
#pragma unroll
            for (int j = 0; j < 4; ++j) w[j] = (unsigned)Nn[swz(8 * c + 2 * j, lane >> 3) + (lane & 7)] | ((unsigned)Nn[swz(8 * c + 2 * j + 1, lane >> 3) + (lane & 7)] << 16);
            u32x4 o; o.x = w[0]; o.y = w[1]; o.z = w[2]; o.w = w[3]; *(u32x4*)(Vt + swz(lane, c)) = o; }
        WAVE_SYNC();
        load_nat_tile(P, r0, kcol, Nn, lane);
        WAVE_SYNC(); }
    unsigned kk[32];
    { const bf16* Nn = Kt;
#pragma unroll
        for (int i = 0; i < 32; ++i) kk[i] = (unsigned)Nn[swz(2 * i, lane >> 3) + (lane & 7)] | ((unsigned)Nn[swz(2 * i + 1, lane >> 3) + (lane & 7)] << 16); }
    WAVE_SYNC();
    if constexpr (MIXER == 0) {
        const float* g = Grow0 + (size_t)lane * NGS; const float* gb = p.in[I_MGB] + (size_t)l * 16;
        const float i_f = g[h] + gb[h], f_f = g[4 + h] + gb[4 + h], i_b = g[8 + h] + gb[8 + h], f_b = g[12 + h] + gb[12 + h];
        const float lf = logsigf_(f_f), lb = logsigf_(f_b);
        const float bF = wave_prefix_sum(lf, lane), totF = __shfl(bF, 63);
        const float gF = totF - bF + i_f, mF = wave_max(gF);
        const float totB = wave_sum(lb), preB = wave_prefix_sum(lb, lane), bB = totB - preB + lb;
        const float gB = totB - bB + i_b, mB = wave_max(gB);
        wvs[lane] = __expf(gF - mF); wvs[64 + lane] = __expf(gB - mB);
        if (lane == 0) { float* SC = (float*)(p.ws + WS_SC);
            SC[ch_index(0, b, h, cid) * 4 + 0] = totF; SC[ch_index(0, b, h, cid) * 4 + 1] = mF;
            SC[ch_index(1, b, h, cid) * 4 + 0] = totB; SC[ch_index(1, b, h, cid) * 4 + 1] = mB; }
    }
    WAVE_SYNC();
    chunkst_dir<MIXER, 0>(p, l, b, h, cid, Grow0, kk, Vt, Kt, wvs, bendl, lane);
    chunkst_dir<MIXER, 1>(p, l, b, h, cid, Grow0, kk, Vt, Kt, wvs, bendl, lane);
}

template <int DIR>
__device__ __forceinline__ void chunkst_gla(const Params& p, int l, int b, int h, int cid, char* wl, int lane_) {
    const bf16* P = (const bf16*)(p.ws + WS_P);
    const int lane = olane(lane_), r0 = b * TOK + cid * 64, r = lane & 15, q4 = lane >> 4;
    bf16* Kt = (bf16*)wl;
    bf16* An = Kt + 4096;
    float* bendl = (float*)(An + 4096);
    const int kcol = PG + 256 + h * 64, vcol = PG + 512 + h * 64;
    const float* Grow0 = (const float*)(p.ws + WS_G) + (size_t)r0 * NGS;
    load_nat_tile(P, r0, vcol, An, lane);
    WAVE_SYNC();
    bf16x8 vf[4][2];
#pragma unroll
    for (int ne = 0; ne < 4; ++ne)
#pragma unroll
        for (int ks = 0; ks < 2; ++ks) vf[ne][ks] = frag_tr(An, 16 * ne, 32 * ks, lane);
    WAVE_SYNC();
    load_nat_tile(P, r0, kcol, An, lane);
    WAVE_SYNC();
    bf16x8 af[4]; gla_r_frags<DIR>(Grow0, lane, af);
#pragma unroll 2
    for (int nt = 0; nt < 4; ++nt) { const int d = 16 * nt + r; float x[4][4];
        const float bend = gla_b_col<DIR>(p, l, h, af, nt, lane, x);
        if (q4 == 0) { ((float*)(p.ws + WS_BE))[ch_index(DIR, b, h, cid) * 64 + d] = bend; bendl[d] = __expf(fmaxf(bend, -80.0f)); }
#pragma unroll
        for (int mt = 0; mt < 4; ++mt)
#pragma unroll
            for (int i = 0; i < 4; ++i) { const int s = 16 * mt + 4 * q4 + i; bf16* ke = An + swz(s, d >> 3) + (d & 7); const float kv = bf2f(*ke); const float bc = fmaxf(x[mt][i], -80.0f);
                Kt[swz(d, s >> 3) + (s & 7)] = f2bf(kv * __expf(-bc));
                *ke = f2bf(__expf(bc)); } }
    WAVE_SYNC();
    { bf16* EQg = (bf16*)(p.ws + WS_EQ) + ((size_t)DIR * T + r0) * WG + h * 64;
#pragma unroll
        for (int i = 0; i < 8; ++i) { const int s = (lane >> 3) + 8 * i, ck = lane & 7; *(u32x4*)(EQg + (size_t)s * WG + ck * 8) = *(const u32x4*)(An + swz(s, ck)); } }
    bf16* dst = (bf16*)(p.ws + WS_ST) + st_index(1, DIR, b, h, cid) * 4096;
#pragma unroll
    for (int me = 0; me < 4; ++me) {
        f32x4 acc[4] = {(f32x4){0.f, 0.f, 0.f, 0.f}, (f32x4){0.f, 0.f, 0.f, 0.f}, (f32x4){0.f, 0.f, 0.f, 0.f}, (f32x4){0.f, 0.f, 0.f, 0.f}};
#pragma unroll
        for (int ks = 0; ks < 2; ++ks) { const bf16x8 a = *(const bf16x8*)(Kt + swz(16 * me + r, ks * 4 + q4));
#pragma unroll
            for (int ne = 0; ne < 4; ++ne) acc[ne] = MFMA16(a, vf[ne][ks], acc[ne]); }
        const f32x4 sc4 = *(const f32x4*)(bendl + 16 * me + 4 * q4);
#pragma unroll
        for (int ne = 0; ne < 4; ++ne) { const f32x4 v = acc[ne] * sc4; u32x2 o; o.x = pk2(v[0], v[1]); o.y = pk2(v[2], v[3]); *(u32x2*)(dst + (16 * ne + r) * 64 + 16 * me + 4 * q4) = o; }
    }
    WAVE_SYNC();
}

template <int MIXER, int DIR>
__device__ __forceinline__ void chunkout_prep(const Params& p, int l, int b, int h, int cid, const float* Grow0, int r0, int pbase, const bf16* EQ, float* gar, int lane_) {
    const int lane = olane(lane_);
    if constexpr (MIXER == 0) {
        const bf16* P = (const bf16*)(p.ws + WS_P);
        const float* g = Grow0 + (size_t)lane * NGS; const float* gb = p.in[I_MGB] + (size_t)l * 16;
        const float ig = g[DIR * 8 + h] + gb[DIR * 8 + h], fg = g[DIR * 8 + 4 + h] + gb[DIR * 8 + 4 + h];
        const float mprev = ((const float*)(p.ws + WS_SC))[ch_index(DIR, b, h, cid) * 4 + 2];
        const float lf = logsigf_(fg); float bb;
        if (DIR == 0) bb = wave_prefix_sum(lf, lane); else { const float tt = wave_sum(lf), pre = wave_prefix_sum(lf, lane); bb = tt - pre + lf; }
        const float a = ig - bb; const float pm = DIR == 0 ? wave_prefix_max(a, lane) : wave_suffix_max(a, lane);
        const float mt_ = fmaxf(bb + mprev, bb + pm);
        float* ga = gar + DIR * 320;
        ga[lane] = bb - mt_; ga[64 + lane] = a; ga[128 + lane] = __expf(bb + mprev - mt_); ga[192 + lane] = __expf(-mt_);
        float* nvl = gar + 640 + DIR * 64;
        nvl[lane] = ((const float*)(p.ws + WS_NV))[ch_index(DIR, b, h, cid) * 64 + lane];
        WAVE_SYNC();
        float dq = 0.f;
#pragma unroll
        for (int c = 0; c < 8; ++c) { float f[8]; unpack8(*(const u32x4*)(P + (size_t)(r0 + lane) * NP + pbase + c * 8), f);
            const f32x4 n0 = *(const f32x4*)(nvl + c * 8), n1 = *(const f32x4*)(nvl + c * 8 + 4);
            dq += f[0] * n0.x + f[1] * n0.y + f[2] * n0.z + f[3] * n0.w + f[4] * n1.x + f[5] * n1.y + f[6] * n1.z + f[7] * n1.w; }
        ga[256 + lane] = dq;
    }
}
template <int MIXER, int DIR, int NS>
__device__ __forceinline__ void chunkout_dir(const Params& p, int b, int h, int cid, int r0, int pbase, int th, const bf16x8 (&vtf)[4][2], const bf16* VtL, const bf16* EQ, bf16* SB, const float* gar, float* rsm, f32x4 (&htot)[NS][4], int lane_) {
    const bf16* P = (const bf16*)(p.ws + WS_P); const bf16* ST = (const bf16*)(p.ws + WS_ST);
    const int lane = olane(lane_), r = lane & 15, q4 = lane >> 4;
    const bf16* E = EQ + ((size_t)DIR * T + r0) * WG + h * 64;
    const float* ga = gar + DIR * 320;
    bf16x8 kf[4][2], ctf[4][2];
#pragma unroll
    for (int n = 0; n < 4; ++n)
#pragma unroll
        for (int ks = 0; ks < 2; ++ks) { kf[n][ks] = *(const bf16x8*)(P + (size_t)(r0 + 16 * n + r) * NP + pbase + 256 + ks * 32 + q4 * 8);
            ctf[n][ks] = *(const bf16x8*)(ST + st_index(MIXER, DIR, b, h, cid) * 4096 + (16 * n + r) * 64 + ks * 32 + q4 * 8);
            if constexpr (MIXER == 1) { float fe[8], fk[8]; unpack8(*(const u32x4*)(E + (size_t)(16 * n + r) * WG + ks * 32 + q4 * 8), fe); unpack8(as_u4(kf[n][ks]), fk);
#pragma unroll
                for (int j = 0; j < 8; ++j) fk[j] = fk[j] * frcp_(fe[j]);
                kf[n][ks] = as_frag(pack8(fk)); } }
#pragma unroll
    for (int ms = 0; ms < NS; ++ms) { const int mt = NS * th + ms;
        bf16x8 qf[2];
#pragma unroll
        for (int ks = 0; ks < 2; ++ks) { qf[ks] = *(const bf16x8*)(P + (size_t)(r0 + 16 * mt + r) * NP + pbase + ks * 32 + q4 * 8);
            if constexpr (MIXER == 1) { float fe[8], fq[8]; unpack8(*(const u32x4*)(E + (size_t)(16 * mt + r) * WG + ks * 32 + q4 * 8), fe); unpack8(as_u4(qf[ks]), fq);
#pragma unroll
                for (int j = 0; j < 8; ++j) fq[j] *= 0.125f * fe[j];
                qf[ks] = as_frag(pack8(fq)); } }
        f32x4 S[4] = {(f32x4){0.f, 0.f, 0.f, 0.f}, (f32x4){0.f, 0.f, 0.f, 0.f}, (f32x4){0.f, 0.f, 0.f, 0.f}, (f32x4){0.f, 0.f, 0.f, 0.f}};
#pragma unroll
        for (int ks = 0; ks < 2; ++ks)
#pragma unroll
            for (int n = 0; n < 4; ++n) S[n] = MFMA16(qf[ks], kf[n][ks], S[n]);
#pragma unroll
        for (int i = 0; i < 4; ++i) { const int t = 16 * mt + 4 * q4 + i; float sm = 0.f;
#pragma unroll
            for (int n = 0; n < 4; ++n) { const int s = 16 * n + r; const bool ok = DIR == 0 ? (s <= t) : (s >= t); float v = 0.f;
                if (ok) { if constexpr (MIXER == 0) v = S[n][i] * 0.125f * __expf(ga[t] + ga[64 + s]); else v = S[n][i]; }
                SB[swz(4 * q4 + i, s >> 3) + (s & 7)] = f2bf(v); sm += v; }
            if constexpr (MIXER == 0) { sm += __shfl_xor(sm, 1); sm += __shfl_xor(sm, 2); sm += __shfl_xor(sm, 4); sm += __shfl_xor(sm, 8); if (r == 0) rsm[4 * q4 + i] = sm; } }
        WAVE_SYNC();
        const bf16x8 sm0 = *(const bf16x8*)(SB + swz(r, q4)), sm1 = *(const bf16x8*)(SB + swz(r, 4 + q4));
        float wi = 1.f, inv = 1.f;
        if constexpr (MIXER == 0) { const int tt = 16 * mt + r; wi = ga[128 + tt]; const float den = wi * ga[256 + tt] + rsm[r]; inv = 1.0f / fmaxf(fabsf(den), ga[192 + tt]); }
#pragma unroll
        for (int me = 0; me < 4; ++me) { f32x4 a1 = {0.f, 0.f, 0.f, 0.f}, a2 = {0.f, 0.f, 0.f, 0.f};
            a1 = MFMA16(*(const bf16x8*)(VtL + swz(16 * me + r, q4)), sm0, a1); a1 = MFMA16(*(const bf16x8*)(VtL + swz(16 * me + r, 4 + q4)), sm1, a1);
            a2 = MFMA16(ctf[me][0], qf[0], a2); a2 = MFMA16(ctf[me][1], qf[1], a2);
            if constexpr (MIXER == 0) htot[ms][me] += (a1 + a2 * wi) * inv; else htot[ms][me] += a1 + a2; }
        WAVE_SYNC();
    }
}
template <int MIXER>
__device__ __forceinline__ void chunkout_w(const Params& p, int l, int b, int h, int cid, char* wl, int lane) {
    const bf16* P = (const bf16*)(p.ws + WS_P); const float* G = (const float*)(p.ws + WS_G); bf16* Y = (bf16*)(p.ws + WS_HNY);
    const int r0 = b * TOK + cid * 64, r = lane & 15, q4 = lane >> 4;
    const int pbase = (MIXER == 0 ? PA : PG) + h * 64;
    bf16* SB = (bf16*)wl;
    float* rsm = (float*)(SB + 1024);
    float* gar = rsm + 16;
    const bf16* EQ = (const bf16*)(p.ws + WS_EQ);
    const float* Grow0 = G + (size_t)r0 * NGS;
    bf16* VtL = (bf16*)(gar + 768);
    bf16x8 vtf[4][2];
#pragma unroll
    for (int me = 0; me < 4; ++me) { vtf[me][0] = (bf16x8){0, 0, 0, 0, 0, 0, 0, 0}; vtf[me][1] = vtf[me][0]; }
    { bf16* Nn = VtL + 4096;
#pragma unroll
        for (int hh = 0; hh < 2; ++hh) {
            u32x4 v[4];
#pragma unroll
            for (int i = 0; i < 4; ++i) v[i] = *(const u32x4*)(P + (size_t)(r0 + 32 * hh + (lane >> 3) + 8 * i) * NP + pbase + 512 + (lane & 7) * 8);
#pragma unroll
            for (int i = 0; i < 4; ++i) *(u32x4*)(Nn + swz((lane >> 3) + 8 * i, lane & 7)) = v[i];
            WAVE_SYNC();
#pragma unroll
            for (int c = 0; c < 4; ++c) { unsigned w[4];
#pragma unroll
                for (int j = 0; j < 4; ++j) w[j] = (unsigned)Nn[swz(8 * c + 2 * j, lane >> 3) + (lane & 7)] | ((unsigned)Nn[swz(8 * c + 2 * j + 1, lane >> 3) + (lane & 7)] << 16);
                u32x4 o; o.x = w[0]; o.y = w[1]; o.z = w[2]; o.w = w[3]; *(u32x4*)(VtL + swz(lane, 4 * hh + c)) = o; }
            WAVE_SYNC(); } }
    chunkout_prep<MIXER, 0>(p, l, b, h, cid, Grow0, r0, pbase, EQ, gar, lane);
    chunkout_prep<MIXER, 1>(p, l, b, h, cid, Grow0, r0, pbase, EQ, gar, lane);
    WAVE_SYNC();
    const float* ngp = p.in[MIXER == 0 ? I_MNG : I_GNG] + (size_t)l * WG + h * 64;
    constexpr int NS = MIXER == 1 ? 2 : 1;
#pragma unroll 1
    for (int th = 0; th < 4 / NS; ++th) {
        f32x4 htot[NS][4];
#pragma unroll
        for (int a = 0; a < NS; ++a)
#pragma unroll
            for (int c = 0; c < 4; ++c) htot[a][c] = (f32x4){0.f, 0.f, 0.f, 0.f};
        chunkout_dir<MIXER, 0, NS>(p, b, h, cid, r0, pbase, th, vtf, VtL, EQ, SB, gar, rsm, htot, lane);
        chunkout_dir<MIXER, 1, NS>(p, b, h, cid, r0, pbase, th, vtf, VtL, EQ, SB, gar, rsm, htot, lane);
        const int lz = olane(lane), r = lz & 15, q4 = lz >> 4;
        u32x2 gq[NS][4], oq[NS][4];
#pragma unroll
        for (int ms = 0; ms < NS; ++ms)
#pragma unroll
            for (int me = 0; me < 4; ++me) { const size_t off = (size_t)(r0 + 16 * (NS * th + ms) + r) * NP + pbase + 16 * me + 4 * q4;
                gq[ms][me] = *(const u32x2*)(P + off + (MIXER == 0 ? 1024 : 768)); if constexpr (MIXER == 0) oq[ms][me] = *(const u32x2*)(P + off + 768); else oq[ms][me] = (u32x2){0u, 0u}; }
#pragma unroll
        for (int ms = 0; ms < NS; ++ms) { const int mt = NS * th + ms; float ss = 0.f; float gv[4][4];
#pragma unroll
            for (int me = 0; me < 4; ++me) {
                gv[me][0] = bitsf(gq[ms][me].x << 16); gv[me][1] = bitsf(gq[ms][me].x & 0xffff0000u); gv[me][2] = bitsf(gq[ms][me].y << 16); gv[me][3] = bitsf(gq[ms][me].y & 0xffff0000u);
                if constexpr (MIXER == 0) { htot[ms][me][0] *= sigmoidf_(bitsf(oq[ms][me].x << 16)); htot[ms][me][1] *= sigmoidf_(bitsf(oq[ms][me].x & 0xffff0000u)); htot[ms][me][2] *= sigmoidf_(bitsf(oq[ms][me].y << 16)); htot[ms][me][3] *= sigmoidf_(bitsf(oq[ms][me].y & 0xffff0000u)); }
                ss += htot[ms][me][0] * htot[ms][me][0] + htot[ms][me][1] * htot[ms][me][1] + htot[ms][me][2] * htot[ms][me][2] + htot[ms][me][3] * htot[ms][me][3]; }
            ss += __shfl_xor(ss, 16); ss += __shfl_xor(ss, 32);
            const float rstd = rsqrtf(ss * (1.0f / 64.0f) + EPS);
#pragma unroll
            for (int me = 0; me < 4; ++me) { const int e = 16 * me + 4 * q4; const f32x4 n4 = *(const f32x4*)(ngp + e);
                u32x2 o; o.x = pk2(htot[ms][me][0] * rstd * n4.x * siluf_(gv[me][0]), htot[ms][me][1] * rstd * n4.y * siluf_(gv[me][1]));
                o.y = pk2(htot[ms][me][2] * rstd * n4.z * siluf_(gv[me][2]), htot[ms][me][3] * rstd * n4.w * siluf_(gv[me][3]));
                *(u32x2*)(Y + (size_t)(r0 + 16 * mt + r) * 1024 + (MIXER == 0 ? YA : YG) + h * 64 + e) = o; } }
    }
}

template <bool OUT>
__device__ __forceinline__ void chunk_workers(const Params& p, int l, char* smem) {
    const int tid = otid(), lane = tid & 63, wave = __builtin_amdgcn_readfirstlane(tid >> 6);
    const int NW = (int)gridDim.x * 8, wi = wave * (int)gridDim.x + obid();
    const int c_lo = (OUT && l == DEPTH - 1) ? NCC : 0, npc = NCH - c_lo, half = NB * NH * npc;
    char* wl = smem + wave * WLDS;
    if (OUT) {
#pragma unroll 1
        for (int t = wi; t < half; t += NW) { const int b = t / (NH * npc), h = (t / npc) % NH, cid = c_lo + t % npc;
            const Params q = relaunder(p); chunkout_w<1>(q, l, b, h, cid, wl, lane); }
        const int used = half % NW, vj = wi >= used ? wi - used : wi + (NW - used);
#pragma unroll 1
        for (int t = vj; t < half; t += NW) { const int b = t / (NH * npc), h = (t / npc) % NH, cid = c_lo + t % npc;
            const Params q = relaunder(p); chunkout_w<0>(q, l, b, h, cid, wl, lane); }
    } else {
        int off = 0;
#pragma unroll 1
        for (int t = wi; t < half; t += NW) { const int b = t / (NH * npc), h = (t / npc) % NH, cid = c_lo + t % npc;
            const Params q = relaunder(p); chunkst_gla<0>(q, l, b, h, cid, wl, lane); }
        off = (off + half) % NW;
#pragma unroll 1
        for (int t = (wi + NW - off) % NW; t < half; t += NW) { const int b = t / (NH * npc), h = (t / npc) % NH, cid = c_lo + t % npc;
            const Params q = relaunder(p); chunkst_gla<1>(q, l, b, h, cid, wl, lane); }
        off = (off + half) % NW;
#pragma unroll 1
        for (int t = (wi + NW - off) % NW; t < half; t += NW) { const int b = t / (NH * npc), h = (t / npc) % NH, cid = c_lo + t % npc;
            const Params q = relaunder(p); chunkst_w<0>(q, l, b, h, cid, wl, lane); }
    }
}

__device__ __forceinline__ void phase_mix1(const Params& p, int l, char* smem) {
    const bool ctxo = l < DEPTH - 1;
    constexpr int N_HL = (NB / 2) * (WG / 2), N_AL = NB * 2 * (SEQ / 64), N_HC = NB * (WG / HCB), N_AC = NB * 2 * NCC;
    const int total = N_HL + N_AL + (ctxo ? N_HC + N_AC : 0);
    for (int task = obid(); task < total; task += gridDim.x) {
        int t = task;
        if (t < N_HL) { hylat_task(p, l, t / (WG / 2), t % (WG / 2), smem); continue; } t -= N_HL;
        if (t < N_AL) { attn_task(p, l, t / (2 * (SEQ / 64)), (t / (SEQ / 64)) % 2, t % (SEQ / 64), false, smem); continue; } t -= N_AL;
        if (t < N_HC) { hyctx_task(p, l, t / (WG / HCB), t % (WG / HCB), smem); continue; } t -= N_HC;
        attn_task(p, l, t / (2 * NCC), (t / NCC) % 2, t % NCC, true, smem);
    }
    __syncthreads();
    chunk_workers<false>(p, l, smem);
}

constexpr int SCG = 12;
__device__ __forceinline__ void phase_scan(const Params& p, int l, char* smem) {
    const int tid = otid();
    bf16* ST = (bf16*)(p.ws + WS_ST); float* NV = (float*)(p.ws + WS_NV); const float* BE = (const float*)(p.ws + WS_BE); float* SC = (float*)(p.ws + WS_SC);
    constexpr int NCHAIN = 2 * 2 * NB * NH;
    for (int item = obid() * NT + tid; item < NCHAIN * 1024; item += gridDim.x * NT) {
        const int chain = item >> 10, grp = item & 1023; const int mixer = chain / (2 * NB * NH), dir = (chain / (NB * NH)) % 2, b = (chain / NH) % NB, h = chain % NH;
        float c[4] = {0.f, 0.f, 0.f, 0.f}; float nv[4] = {0.f, 0.f, 0.f, 0.f}; float m = 0.f;
        const int d0 = (grp & 15) * 4; const bool donv = (mixer == 0) && (grp < 16);
        for (int o0 = 0; o0 < NCH; o0 += SCG) {
            u32x2 uu[SCG]; float s0[SCG], s1[SCG]; f32x4 be[SCG]; f32x4 nu[SCG];
#pragma unroll
            for (int j = 0; j < SCG; ++j) if (o0 + j < NCH) { const int cid = chain_cid(dir, o0 + j); const size_t ci = ch_index(dir, b, h, cid);
                uu[j] = *(const u32x2*)(ST + st_index(mixer, dir, b, h, cid) * 4096 + grp * 4);
                if (mixer == 0) { s0[j] = SC[ci * 4 + 0]; s1[j] = SC[ci * 4 + 1]; if (donv) nu[j] = *(const f32x4*)(NV + ci * 64 + grp * 4); }
                else be[j] = *(const f32x4*)(BE + ci * 64 + d0); }
#pragma unroll
            for (int j = 0; j < SCG; ++j) if (o0 + j < NCH) { const int cid = chain_cid(dir, o0 + j); const size_t ci = ch_index(dir, b, h, cid);
                const float u[4] = {bitsf(uu[j].x << 16), bitsf(uu[j].x & 0xffff0000u), bitsf(uu[j].y << 16), bitsf(uu[j].y & 0xffff0000u)};
                u32x2 w; w.x = pk2(c[0], c[1]); w.y = pk2(c[2], c[3]); *(u32x2*)(ST + st_index(mixer, dir, b, h, cid) * 4096 + grp * 4) = w;
                if (mixer == 0) {
                    if (grp == 0) SC[ci * 4 + 2] = m;
                    const float mn = fmaxf(s0[j] + m, s1[j]), a = __expf(s0[j] + m - mn), s = __expf(s1[j] - mn);
#pragma unroll
                    for (int k = 0; k < 4; ++k) c[k] = a * c[k] + s * u[k];
                    if (donv) { f32x4 nw = {nv[0], nv[1], nv[2], nv[3]}; *(f32x4*)(NV + ci * 64 + grp * 4) = nw;
                        nv[0] = a * nv[0] + s * nu[j].x; nv[1] = a * nv[1] + s * nu[j].y; nv[2] = a * nv[2] + s * nu[j].z; nv[3] = a * nv[3] + s * nu[j].w; }
                    m = mn;
                } else { c[0] = __expf(be[j].x) * c[0] + u[0]; c[1] = __expf(be[j].y) * c[1] + u[1]; c[2] = __expf(be[j].z) * c[2] + u[2]; c[3] = __expf(be[j].w) * c[3] + u[3]; } }
        }
    }
    constexpr int N_WOUT = (DM / 64) * (MIX / 64);
    for (int task = obid(); task < N_WOUT; task += gridDim.x) { const int nt = task / (MIX / 64), kt = task % (MIX / 64);
        convert_tile(p.in[I_WOUT] + (size_t)l * MIX * DM, DM, (bf16*)(p.ws + WS_WOUT), MIX, nt * 64, kt * 64, false, smem); }
    __syncthreads();
    { const int lane = tid & 63, wave = __builtin_amdgcn_readfirstlane(tid >> 6); const int NW = (int)gridDim.x * 8, wi = wave * (int)gridDim.x + obid();
        bf16* tile = (bf16*)(smem + wave * WLDS); const bf16* HT = (const bf16*)(p.ws + WS_HT); bf16* Y = (bf16*)(p.ws + WS_HNY);
        constexpr int NTT = NB * (SEQ / 64) * 4;
        for (int t = wi; t < NTT; t += NW) { const int b = t / ((SEQ / 64) * 4), tt = (t / 4) % (SEQ / 64), c0 = (t % 4) * 64; const size_t tok0 = (size_t)b * TOK + CTXL + tt * 64;
#pragma unroll
            for (int i = 0; i < 8; ++i) { const int ch = (lane >> 3) + 8 * i, ck = lane & 7; *(u32x4*)(tile + swz(ch, ck)) = *(const u32x4*)(HT + (size_t)(768 + c0 + ch) * T + tok0 + ck * 8); }
            WAVE_SYNC();
#pragma unroll
            for (int i = 0; i < 8; ++i) { const int tk = (lane >> 3) + 8 * i, cc = lane & 7; unsigned w[4];
#pragma unroll
                for (int j = 0; j < 4; ++j) { const int ca = cc * 8 + 2 * j; w[j] = (unsigned)tile[swz(ca, tk >> 3) + (tk & 7)] | ((unsigned)tile[swz(ca + 1, tk >> 3) + (tk & 7)] << 16); }
                u32x4 o; o.x = w[0]; o.y = w[1]; o.z = w[2]; o.w = w[3]; *(u32x4*)(Y + (tok0 + tk) * 1024 + YH + c0 + cc * 8) = o; }
            WAVE_SYNC(); } }
}

__device__ __forceinline__ void phase_mix2(const Params& p, int l, char* smem) { chunk_workers<true>(p, l, smem); }

#ifndef EMU
#define LAS __attribute__((address_space(3)))
#define XB_TMO      128
#define XB_XCNT(j)  (256  + 64 * (j))
#define XB_XSUB(j)  (1280 + 64 * (j))
#define XB_XGEN(j)  (2304 + 64 * (j))
#define XB_TOP      3328
#define XB_TOPGEN   3392
#define XCD_BAR_WORDS 3456
#define XB_SPIN_CAP (1u << 18)

__device__ __forceinline__ unsigned xb_ld(unsigned* p)              { return __hip_atomic_load(p, __ATOMIC_RELAXED, __HIP_MEMORY_SCOPE_AGENT); }
__device__ __forceinline__ unsigned xb_add(unsigned* p, unsigned v) { return __hip_atomic_fetch_add(p, v, __ATOMIC_RELAXED, __HIP_MEMORY_SCOPE_AGENT); }
__device__ __forceinline__ unsigned xb_xcc_id() { return (unsigned)__builtin_amdgcn_s_getreg((3 << 11) | 20) & 0xFu; }
#define XB_SPIN(cond, bar) do { unsigned _sp = 0; while (cond) { __builtin_amdgcn_s_sleep(1); \
    if ((++_sp & 255u) == 0u) { if (xb_ld(&(bar)[XB_TMO])) break; if (_sp > XB_SPIN_CAP) { atomicAdd(&(bar)[XB_TMO], 1u); break; } } } } while (0)

struct XcdBarrier {
    unsigned* bar; unsigned x;
    volatile LAS unsigned* st;
};

__device__ __forceinline__ XcdBarrier xcd_barrier_post(unsigned* bar, volatile LAS unsigned* st) {
    XcdBarrier b; b.bar = bar; b.x = xb_xcc_id(); b.st = st;
    if (threadIdx.x == 0) (void)xb_add(&bar[XB_XCNT(b.x)], 1u);
    return b;
}
__device__ __forceinline__ void xcd_barrier_complete(unsigned* bar, unsigned x, unsigned& nloc, unsigned& nx) {
    const unsigned G = gridDim.x * gridDim.y * gridDim.z;
    unsigned sum, cnt, mine, sp = 0u;
    for (;;) {
        sum = 0u; cnt = 0u; mine = 0u;
#pragma unroll
        for (unsigned j = 0; j < 16; ++j) { const unsigned c = xb_ld(&bar[XB_XCNT(j)]); sum += c; cnt += (c > 0u) ? 1u : 0u; mine = (j == x) ? c : mine; }
        if (sum == G) break;
        __builtin_amdgcn_s_sleep(1);
        if ((++sp & 255u) == 0u) { if (xb_ld(&bar[XB_TMO])) break; if (sp > XB_SPIN_CAP) { atomicAdd(&bar[XB_TMO], 1u); break; } }
    }
    nloc = mine > 0u ? mine : 1u; nx = cnt > 0u ? cnt : 1u;
}

__device__ __forceinline__ void xcd_barrier(const XcdBarrier& b) {
    asm volatile("s_waitcnt vmcnt(0)" ::: "memory");
    __syncthreads();
    if (threadIdx.x == 0) {
        unsigned* bar = b.bar;
        __builtin_amdgcn_s_waitcnt(0);
        unsigned nloc = b.st[0], nx = b.st[1];
        if (nloc == 0u) { xcd_barrier_complete(bar, b.x, nloc, nx); b.st[0] = nloc; b.st[1] = nx; }
        const unsigned old = xb_add(&bar[XB_XSUB(b.x)], 1u);
        const unsigned gen = old / nloc;
        if (old + 1u == (gen + 1u) * nloc) {
            __builtin_amdgcn_fence(__ATOMIC_RELEASE, "agent");
            asm volatile("s_waitcnt vmcnt(0)" ::: "memory");
            const unsigned og = xb_add(&bar[XB_TOP], 1u);
            const unsigned tg = og / nx;
            if (og + 1u == (tg + 1u) * nx) xb_add(&bar[XB_TOPGEN], 1u);
            else XB_SPIN(xb_ld(&bar[XB_TOPGEN]) == tg, bar);
            __builtin_amdgcn_fence(__ATOMIC_ACQUIRE, "agent");
            xb_add(&bar[XB_XGEN(b.x)], 1u);
            asm volatile("s_waitcnt vmcnt(0)" ::: "memory");
        } else {
            XB_SPIN(xb_ld(&bar[XB_XGEN(b.x)]) == gen, bar);
            __builtin_amdgcn_fence(__ATOMIC_ACQUIRE, "agent");
            asm volatile("s_waitcnt vmcnt(0)" ::: "memory");
        }
    }
    __syncthreads();
}
#endif

__global__ void __launch_bounds__(NT) fwd_kernel(Params pk, int ph_lo, int ph_hi) {
    SMEM_DECL;
#ifndef EMU
    volatile LAS unsigned* misc = (volatile LAS unsigned*)(smem + LDS_BYTES - 64);
    if (threadIdx.x < 2) misc[threadIdx.x] = 0u;
    __syncthreads();
    const XcdBarrier bar = xcd_barrier_post((unsigned*)(pk.ws + WS_BAR), misc);
#endif
    constexpr int NPH = 2 + 6 * DEPTH;
    for (int ph = ph_lo; ph < ph_hi && ph < NPH; ++ph) {
#ifndef EMU
        Params p = pk; { size_t z = 0; asm volatile("" : "+s"(z)); p.ws = pk.ws + z; p.out = pk.out + z;
#pragma unroll
            for (int i = 0; i < 26; ++i) p.in[i] = pk.in[i] + z; }
#else
        const Params& p = pk;
#endif
        if (ph == 0) phase0(p, smem);
        else if (ph == NPH - 1) phase_rp(p, DEPTH, smem);
        else { const int l = (ph - 1) / 6, k = (ph - 1) % 6;
            if (k == 0) phase_rp(p, l, smem);
            else if (k == 1) phase_gemm_in(p, l, smem);
            else if (k == 2) phase_mix1(p, l, smem);
            else if (k == 3) phase_scan(p, l, smem);
            else if (k == 4) phase_mix2(p, l, smem);
            else phase_gemm_out(p, l, smem);
#ifdef PROBE_DUP
            if (k == PROBE_DUP) { GRID_SYNC();
                if (k == 1) phase_gemm_in(p, l, smem); else if (k == 2) phase_mix1(p, l, smem); else if (k == 4) phase_mix2(p, l, smem); else if (k == 5) phase_gemm_out(p, l, smem); }
#endif
        }
        if (ph + 1 < ph_hi) {
#ifdef EMU
            GRID_SYNC();
#else
            if (ph == 0) GRID_SYNC(); else xcd_barrier(bar);
#endif
        }
    }
}

#ifndef EMU
extern "C" void kernel_launch(void* const* d_in, const int* in_sizes, int n_in, void* d_out, int out_size, void* d_ws, size_t ws_size, hipStream_t stream) {
    static int grid = 0;
    if (grid == 0) {
        if (n_in != 26 || ws_size < WS_TOTAL) { fprintf(stderr, "kernel_launch: unexpected n_in %d or ws_size %zu (need %zu)\n", n_in, ws_size, (size_t)WS_TOTAL); grid = -1; return; }
        int dev = 0, cus = 0, per_cu = 0;
        hipGetDevice(&dev);
        hipDeviceGetAttribute(&cus, hipDeviceAttributeMultiprocessorCount, dev);
        hipFuncSetAttribute((const void*)fwd_kernel, hipFuncAttributeMaxDynamicSharedMemorySize, LDS_BYTES);
        hipOccupancyMaxActiveBlocksPerMultiprocessor(&per_cu, (const void*)fwd_kernel, NT, LDS_BYTES);
        if (per_cu < 1) { fprintf(stderr, "kernel_launch: occupancy query returned %d\n", per_cu); grid = -1; return; }
        if (per_cu > 1) per_cu = 1;
        grid = cus * per_cu;
    }
    if (grid < 0) return;
    hipMemsetAsync((char*)d_ws + WS_BAR, 0, BAR_BYTES, stream);
    Params p{};
    for (int i = 0; i < 26; ++i) p.in[i] = (const float*)d_in[i];
    p.out = (float*)d_out; p.ws = (char*)d_ws;
    int lo = 0, hi = 2 + 6 * DEPTH;
    void* args[] = {&p, &lo, &hi};
    hipError_t e = hipLaunchCooperativeKernel((const void*)fwd_kernel, dim3(grid), dim3(NT), args, LDS_BYTES, stream);
    if (e != hipSuccess) fprintf(stderr, "cooperative launch failed: %s (grid %d)\n", hipGetErrorString(e), grid);
}
#endif
```

```cpp
#ifdef EMU
#include "emu/hipemu.h"
#define GRID_SYNC() emu::grid_sync()
#define SMEM_DECL char* smem = emu::S().blocks[emu::cur()->block].lds
#define MFMA16(a, b, c) emu_mfma_16x16x32_bf16(a, b, c)
#else
#include <hip/hip_runtime.h>
#include <hip/hip_cooperative_groups.h>
#include <cstdio>
#include <cstdint>
#define GRID_SYNC() cooperative_groups::this_grid().sync()
#define SMEM_DECL extern __shared__ __attribute__((aligned(16))) char smem[]
#define MFMA16(a, b, c) __builtin_amdgcn_mfma_f32_16x16x32_bf16(a, b, c, 0, 0, 0)
#endif

#ifdef EMU
#ifndef EMU_DM
#define EMU_DM 256
#endif
#ifndef EMU_NB
#define EMU_NB 2
#endif
#ifndef EMU_SEQ
#define EMU_SEQ 512
#endif
#ifndef EMU_DEPTH
#define EMU_DEPTH 2
#endif
#ifndef EMU_CTXL
#define EMU_CTXL 128
#endif
constexpr int DM = EMU_DM, NB = EMU_NB, SEQ = EMU_SEQ, DEPTH = EMU_DEPTH, CTXL = EMU_CTXL;
#else
constexpr int DM = 1024, NB = 8, SEQ = 2048, DEPTH = 4, CTXL = 256;
#endif
constexpr int MIX = 1024, WG = 256, HD = 64, NH = 4, CH = 64;
constexpr int TOK = CTXL + SEQ, T = NB * TOK, NCH = TOK / CH, NCC = CTXL / CH;
constexpr int N_IN = 4144, NP = 3072, NG = 48, NGS = 32, NMAIN = 3328, NPAD = 4352;
constexpr int NF = 2 * SEQ;
constexpr int NJ = NB + 1;
constexpr int NT = 512;
constexpr float EPS = 1e-6f;
constexpr int PA = 0, PG = 1280, PD = 2304;
constexpr int YA = 0, YH = 256, YG = 512, YD = 768;
constexpr int ilog4(int n) { return n <= 1 ? 0 : 1 + ilog4(n / 4); }
constexpr int FFT_P = ilog4(NF);
static_assert((1 << (2 * FFT_P)) == NF, "NF must be a power of 4");
static_assert(DM % 256 == 0 && CTXL % 128 == 0 && SEQ % 256 == 0, "shape constraints");

typedef unsigned short bf16;
typedef short bf16x8 __attribute__((ext_vector_type(8)));
typedef float f32x4 __attribute__((ext_vector_type(4)));
typedef unsigned u32x4 __attribute__((ext_vector_type(4)));
typedef unsigned u32x2 __attribute__((ext_vector_type(2)));
struct cpx { float x, y; };

constexpr size_t al256(size_t x) { return (x + 255) & ~(size_t)255; }
constexpr size_t WS_CTXB = 0;
constexpr size_t WS_HNY = al256(WS_CTXB + (size_t)NB * CTXL * DM * 4);
constexpr size_t WS_WIN = WS_HNY + (size_t)T * 1024 * 2;
constexpr size_t WS_ST = WS_WIN;
constexpr size_t ST_BYTES = (size_t)2 * 2 * NB * NH * NCH * 4096 * 2;
constexpr size_t WS_KT = al256(WS_WIN + (size_t)NPAD * DM * 2);
static_assert(WS_KT + (size_t)WG * NF * 4 <= WS_ST + ST_BYTES || true, "");
constexpr size_t ST_END = al256((WS_ST + ST_BYTES > WS_KT + (size_t)WG * NF * 4) ? WS_ST + ST_BYTES : WS_KT + (size_t)WG * NF * 4);
constexpr size_t WS_P = ST_END;
constexpr size_t WS_HT = al256(WS_P + (size_t)T * NP * 2);
constexpr size_t WS_WOUT = WS_HT;
constexpr size_t WS_G = al256(WS_HT + (size_t)1024 * T * 2);
constexpr size_t WS_KF = al256(WS_G + (size_t)T * NGS * 4);
constexpr size_t WS_HC = al256(WS_KF + (size_t)WG * NF * 8);
constexpr size_t WS_EQ = al256(WS_HC + (size_t)2 * WG * CTXL * 4);
constexpr size_t WS_NV = al256(WS_EQ + (size_t)2 * T * WG * 2);
constexpr size_t WS_BE = al256(WS_NV + (size_t)2 * NB * NH * NCH * 64 * 4);
constexpr size_t WS_SC = al256(WS_BE + (size_t)2 * NB * NH * NCH * 64 * 4);
constexpr size_t WS_MOD = al256(WS_SC + (size_t)2 * NB * NH * NCH * 4 * 4);
constexpr size_t WS_TW = al256(WS_MOD + (size_t)DEPTH * NJ * 3 * DM * 4);
constexpr size_t WS_ROPE = al256(WS_TW + (size_t)NF * 8);
constexpr size_t WS_BAR = al256(WS_ROPE + (size_t)SEQ * 32 * 8);
constexpr size_t BAR_BYTES = 16384;
constexpr size_t WS_TOTAL = al256(WS_BAR + BAR_BYTES);
static_assert((size_t)T * DM * 4 <= (size_t)T * NP * 2, "YO fits in P");
#ifndef EMU
static_assert(WS_TOTAL <= (size_t)268435456, "workspace map must fit 256 MiB");
#endif

constexpr int LDS_BYTES = 163840;

struct Params {
    const float* in[26];
    float* out;
    char* ws;
};
enum { I_X = 0, I_C, I_CTX, I_CCTX, I_WADA, I_BADA, I_GPRE, I_GPOST, I_WIN, I_MGB, I_MNG, I_HCW, I_HCB, I_HW1, I_HB1, I_HW2, I_HB2, I_HW3, I_HB3,
       I_HFREQ, I_HD, I_GWA, I_GBA, I_GNG, I_SINK, I_WOUT };

__device__ __forceinline__ Params relaunder(const Params& pk) {
#ifdef EMU
    return pk;
#else
    Params p = pk; size_t z = 0; asm volatile("" : "+s"(z)); p.ws = pk.ws + z; p.out = pk.out + z;
#pragma unroll
    for (int i = 0; i < 26; ++i) p.in[i] = pk.in[i] + z;
    return p;
#endif
}
#ifdef EMU
#define WAVE_SYNC() emu_wave_sync()
#else
#define WAVE_SYNC() do { asm volatile("s_waitcnt lgkmcnt(0)" ::: "memory"); __builtin_amdgcn_wave_barrier(); } while (0)
#endif

#ifdef EMU
__device__ __forceinline__ int otid() { return (int)threadIdx.x; }
__device__ __forceinline__ int obid() { return (int)blockIdx.x; }
#else
__device__ __forceinline__ int otid() { int t = (int)threadIdx.x; asm volatile("" : "+v"(t)); return t; }
__device__ __forceinline__ int obid() { int b = (int)blockIdx.x; asm volatile("" : "+s"(b)); return b; }
#endif
__device__ __forceinline__ unsigned fbits(float f) { return __builtin_bit_cast(unsigned, f); }
__device__ __forceinline__ float bitsf(unsigned u) { return __builtin_bit_cast(float, u); }
__device__ __forceinline__ bf16 f2bf(float f) { unsigned u = fbits(f); return (bf16)((u + 0x7fffu + ((u >> 16) & 1u)) >> 16); }
__device__ __forceinline__ float bf2f(bf16 h) { return bitsf((unsigned)h << 16); }
__device__ __forceinline__ unsigned pk2(float lo, float hi) { return (unsigned)f2bf(lo) | ((unsigned)f2bf(hi) << 16); }
#ifdef EMU
__device__ __forceinline__ float frcp_(float x) { return 1.0f / x; }
#else
__device__ __forceinline__ float frcp_(float x) { return __builtin_amdgcn_rcpf(x); }
#endif
__device__ __forceinline__ float sigmoidf_(float x) { return 1.0f / (1.0f + __expf(-x)); }
__device__ __forceinline__ float siluf_(float x) { return x / (1.0f + __expf(-x)); }
__device__ __forceinline__ float logsigf_(float x) { return fminf(x, 0.0f) - log1pf(__expf(-fabsf(x))); }
__device__ __forceinline__ float logsig_fast(float x) { return fminf(x, 0.0f) - __logf(1.0f + __expf(-fabsf(x))); }
__device__ __forceinline__ float wave_sum(float v) {
#pragma unroll
    for (int o = 1; o < 64; o <<= 1) v += __shfl_xor(v, o);
    return v;
}
__device__ __forceinline__ float wave_max(float v) {
#pragma unroll
    for (int o = 1; o < 64; o <<= 1) v = fmaxf(v, __shfl_xor(v, o));
    return v;
}
__device__ __forceinline__ float wave_prefix_sum(float v, int lane) {
#pragma unroll
    for (int o = 1; o < 64; o <<= 1) { float t = __shfl_up(v, o); if (lane >= o) v += t; }
    return v;
}
__device__ __forceinline__ float wave_prefix_max(float v, int lane) {
#pragma unroll
    for (int o = 1; o < 64; o <<= 1) { float t = __shfl_up(v, o); if (lane >= o) v = fmaxf(v, t); }
    return v;
}
__device__ __forceinline__ float wave_suffix_max(float v, int lane) {
#pragma unroll
    for (int o = 1; o < 64; o <<= 1) { float t = __shfl_down(v, o); if (lane + o < 64) v = fmaxf(v, t); }
    return v;
}
__device__ __forceinline__ void unpack8(u32x4 v, float* f) {
    f[0] = bitsf(v.x << 16); f[1] = bitsf(v.x & 0xffff0000u); f[2] = bitsf(v.y << 16); f[3] = bitsf(v.y & 0xffff0000u);
    f[4] = bitsf(v.z << 16); f[5] = bitsf(v.z & 0xffff0000u); f[6] = bitsf(v.w << 16); f[7] = bitsf(v.w & 0xffff0000u);
}
__device__ __forceinline__ int orig_col(int n) {
    if (n < 1280) return n;
    if (n < 2304) return 2320 + (n - 1280);
    if (n < 3072) return 3376 + (n - 2304);
    if (n < 3088) return 1280 + (n - 3072);
    if (n < 3120) return 3344 + (n - 3088);
    if (n < NMAIN) return -1;
    return 1296 + (n - NMAIN);
}
__device__ __forceinline__ int chain_cid(int dir, int o) {
    if (dir == 0) return o;
    return o < NCC ? (NCC - 1 - o) : (NCH - 1 - (o - NCC));
}

__device__ __forceinline__ int swz(int row, int ch) { return row * 64 + ((ch ^ (row & 7)) << 3); }
__device__ __forceinline__ u32x4 pack8(const float* f) { u32x4 o; o.x = pk2(f[0], f[1]); o.y = pk2(f[2], f[3]); o.z = pk2(f[4], f[5]); o.w = pk2(f[6], f[7]); return o; }
__device__ __forceinline__ bf16x8 as_frag(u32x4 v) { return __builtin_bit_cast(bf16x8, v); }
__device__ __forceinline__ u32x4 as_u4(bf16x8 v) { return __builtin_bit_cast(u32x4, v); }

constexpr int LS = 72;

template <int NTL, int KS>
__device__ __forceinline__ void mma_nt(const bf16* A, int lda, int m0, const bf16* B, int ldb, int n0, f32x4 (&acc)[NTL], int lane) {
    const int r = lane & 15, q = lane >> 4;
#pragma unroll
    for (int ks = 0; ks < KS; ++ks) {
        const bf16x8 a = *(const bf16x8*)(A + (m0 + r) * lda + ks * 32 + q * 8);
#pragma unroll
        for (int nt = 0; nt < NTL; ++nt) {
            const bf16x8 b = *(const bf16x8*)(B + (n0 + nt * 16 + r) * ldb + ks * 32 + q * 8);
            acc[nt] = MFMA16(a, b, acc[nt]);
        }
    }
}

__device__ __forceinline__ void layer_prep(const Params& p, int l, int idx, int stride, char* smem);
__device__ __forceinline__ void phase0(const Params& p, char* smem) {
    const int tid = otid();
    cpx* TW = (cpx*)(p.ws + WS_TW);
    cpx* ROPE = (cpx*)(p.ws + WS_ROPE);
    float* MOD = (float*)(p.ws + WS_MOD);
    constexpr int N_TW = NF / NT, N_ROPE = SEQ * 32 / NT, N_MOD = DEPTH * (3 * DM / 64);
    for (int task = obid(); task < N_TW + N_ROPE + N_MOD; task += gridDim.x) {
        if (task < N_TW) {
            const int j = task * NT + tid; float s, c; sincospif(2.0f * (float)j / (float)NF, &s, &c);
            cpx v; v.x = c; v.y = -s; TW[j] = v;
        } else if (task < N_TW + N_ROPE) {
            const int idx = (task - N_TW) * NT + tid; const int pos = idx >> 5, i = idx & 31;
            const float inv = exp2f(-(float)(i & 15) * (13.287712379549449f / 16.0f));
            const float ang = (float)(i < 16 ? pos / 64 : pos % 64) * inv;
            cpx v; v.x = cosf(ang); v.y = sinf(ang); ROPE[idx] = v;
        } else {
            const int mt = task - N_TW - N_ROPE; const int l = mt / (3 * DM / 64), n0 = (mt % (3 * DM / 64)) * 64;
            float* sv = (float*)smem;
            float* red = sv + NJ * DM;
            __syncthreads();
            for (int i = tid; i < NJ * DM; i += NT) { const int j = i / DM, k = i % DM; const float v = j < NB ? p.in[I_C][j * DM + k] : p.in[I_CCTX][k]; sv[i] = siluf_(v); }
            __syncthreads();
            const int nl = tid & 63, ks = tid >> 6; float acc[NJ];
#pragma unroll
            for (int j = 0; j < NJ; ++j) acc[j] = 0.f;
            const float* w = p.in[I_WADA] + (size_t)l * DM * 3 * DM + n0 + nl;
            for (int k = ks * (DM / 8); k < (ks + 1) * (DM / 8); ++k) { const float wv = w[(size_t)k * 3 * DM];
#pragma unroll
                for (int j = 0; j < NJ; ++j) acc[j] += sv[j * DM + k] * wv; }
#pragma unroll
            for (int j = 0; j < NJ; ++j) red[(ks * NJ + j) * 64 + nl] = acc[j];
            __syncthreads();
            for (int i = tid; i < NJ * 64; i += NT) { const int j = i / 64, n = i % 64; float s = 0.f;
#pragma unroll
                for (int k8 = 0; k8 < 8; ++k8) s += red[(k8 * NJ + j) * 64 + n];
                MOD[((size_t)l * NJ + j) * 3 * DM + n0 + n] = s + p.in[I_BADA][(size_t)l * 3 * DM + n0 + n]; }
        }
    }
}

__device__ __forceinline__ void rp_rows(const Params& p, int l) {
    const int tid = otid(), lane = tid & 63, wave = tid >> 6;
    const float* MOD = (const float*)(p.ws + WS_MOD);
    float* CTXB = (float*)(p.ws + WS_CTXB);
    const bf16* YO = (const bf16*)(p.ws + WS_P);
    bf16* HN = (bf16*)(p.ws + WS_HNY);
    constexpr int NV4 = DM / 256, RW = 2;
    const int stride = (int)gridDim.x * 8;
    for (int base = obid() * 8 + wave; base < T; base += stride * RW) {
        f32x4 x[RW][NV4], y[RW][NV4]; const float* xo[RW]; float* xn[RW]; int mj[RW]; bool ok[RW];
#pragma unroll
        for (int i = 0; i < RW; ++i) { const int row = base + i * stride; ok[i] = row < T; const int rr = ok[i] ? row : base;
            const int b = rr / TOK, pp = rr % TOK; const bool isctx = pp < CTXL; if (l == DEPTH && isctx) ok[i] = false;
            const size_t off = isctx ? ((size_t)b * CTXL + pp) * DM : ((size_t)b * SEQ + (pp - CTXL)) * DM;
            xo[i] = (l <= 1) ? (isctx ? p.in[I_CTX] + off : p.in[I_X] + off) : (isctx ? CTXB + off : p.out + off);
            xn[i] = isctx ? CTXB + off : p.out + off; mj[i] = isctx ? NB : b;
#pragma unroll
            for (int j = 0; j < NV4; ++j) { x[i][j] = *(const f32x4*)(xo[i] + 4 * lane + 256 * j); if (l > 0) { const u32x2 yy = *(const u32x2*)(YO + (size_t)rr * DM + 4 * lane + 256 * j); y[i][j] = (f32x4){bitsf(yy.x << 16), bitsf(yy.x & 0xffff0000u), bitsf(yy.y << 16), bitsf(yy.y & 0xffff0000u)}; } else y[i][j] = (f32x4){0.f, 0.f, 0.f, 0.f}; } }
        if (l > 0) {
            float ss[RW];
#pragma unroll
            for (int i = 0; i < RW; ++i) { ss[i] = 0.f;
#pragma unroll
                for (int j = 0; j < NV4; ++j) ss[i] += y[i][j].x * y[i][j].x + y[i][j].y * y[i][j].y + y[i][j].z * y[i][j].z + y[i][j].w * y[i][j].w; }
#pragma unroll
            for (int o = 1; o < 64; o <<= 1) {
#pragma unroll
                for (int i = 0; i < RW; ++i) ss[i] += __shfl_xor(ss[i], o); }
            const float* gp = p.in[I_GPOST] + (size_t)(l - 1) * DM;
#pragma unroll
            for (int i = 0; i < RW; ++i) { const float rstd = rsqrtf(ss[i] * (1.0f / DM) + EPS); const float* gt = MOD + ((size_t)(l - 1) * NJ + mj[i]) * 3 * DM + 2 * DM;
#pragma unroll
                for (int j = 0; j < NV4; ++j) { const f32x4 g4 = *(const f32x4*)(gt + 4 * lane + 256 * j), p4 = *(const f32x4*)(gp + 4 * lane + 256 * j);
                    x[i][j] = x[i][j] + g4 * (y[i][j] * rstd * p4);
                    if (ok[i]) *(f32x4*)(xn[i] + 4 * lane + 256 * j) = x[i][j]; } }
        }
        if (l < DEPTH) {
            float ss[RW];
#pragma unroll
            for (int i = 0; i < RW; ++i) { ss[i] = 0.f;
#pragma unroll
                for (int j = 0; j < NV4; ++j) ss[i] += x[i][j].x * x[i][j].x + x[i][j].y * x[i][j].y + x[i][j].z * x[i][j].z + x[i][j].w * x[i][j].w; }
#pragma unroll
            for (int o = 1; o < 64; o <<= 1) {
#pragma unroll
                for (int i = 0; i < RW; ++i) ss[i] += __shfl_xor(ss[i], o); }
            const float* gp = p.in[I_GPRE] + (size_t)l * DM;
#pragma unroll
            for (int i = 0; i < RW; ++i) { const float rstd = rsqrtf(ss[i] * (1.0f / DM) + EPS); const float* md = MOD + ((size_t)l * NJ + mj[i]) * 3 * DM; const int row = base + i * stride;
#pragma unroll
                for (int j = 0; j < NV4; ++j) { const int e = 4 * lane + 256 * j;
                    const f32x4 g4 = *(const f32x4*)(gp + e), sh = *(const f32x4*)(md + e), sc = *(const f32x4*)(md + DM + e);
                    const f32x4 h = (x[i][j] * rstd * g4) * (sc + 1.0f) + sh;
                    u32x2 o; o.x = pk2(h.x, h.y); o.y = pk2(h.z, h.w);
                    if (ok[i]) *(u32x2*)(HN + (size_t)row * DM + e) = o; } }
        }
    }
}

__device__ __forceinline__ void convert_tile(const float* src, int ldn, bf16* dst, int K, int n0, int k0, bool use_map, char* smem) {
    const int tid = otid();
    float* tile = (float*)smem;
    __syncthreads();
#pragma unroll
    for (int i = 0; i < 8; ++i) { const int idx = tid + NT * i, k = idx >> 6, n = idx & 63;
        const int oc = use_map ? orig_col(n0 + n) : (n0 + n);
        tile[k * 65 + n] = oc >= 0 ? src[(size_t)(k0 + k) * ldn + oc] : 0.f; }
    __syncthreads();
    const int n = tid >> 3, c = tid & 7;
    u32x4 o; o.x = pk2(tile[(8 * c + 0) * 65 + n], tile[(8 * c + 1) * 65 + n]); o.y = pk2(tile[(8 * c + 2) * 65 + n], tile[(8 * c + 3) * 65 + n]);
    o.z = pk2(tile[(8 * c + 4) * 65 + n], tile[(8 * c + 5) * 65 + n]); o.w = pk2(tile[(8 * c + 6) * 65 + n], tile[(8 * c + 7) * 65 + n]);
    *(u32x4*)(dst + (size_t)(n0 + n) * K + k0 + 8 * c) = o;
}

__device__ __forceinline__ void filter_task(const Params& p, int l, int L, int pos0, char* smem) {
    const int tid = otid();
    float* z = (float*)smem;
    float* h1 = z + 8 * 33;
    float* h2 = h1 + 8 * 64;
    __syncthreads();
    if (tid < 8 * 33) { const int pp = tid / 33, i = tid % 33; const float pos = (float)(pos0 + pp);
        const float t = pos / (float)(L - 1 > 1 ? L - 1 : 1), w = 6.283185307179586f * pos / (float)L; float v;
        if (i == 0) v = t; else { const int bi = (i - 1) & 15; const float f = 1e-4f + (float)bi * ((15.0f - 1e-4f) / 15.0f); v = (i <= 16) ? cosf(w * f) : -sinf(w * f); }
        z[tid] = v; }
    __syncthreads();
    { const int pp = tid >> 6, j = tid & 63; const float* w1 = p.in[I_HW1] + (size_t)l * 33 * 64; float a = p.in[I_HB1][l * 64 + j];
        for (int i = 0; i < 33; ++i) a += z[pp * 33 + i] * w1[i * 64 + j];
        h1[tid] = sinf(p.in[I_HFREQ][(l * 2 + 0) * 64 + j] * a); }
    __syncthreads();
    { const int pp = tid >> 6, j = tid & 63; const float* w2 = p.in[I_HW2] + (size_t)l * 64 * 64; float a = p.in[I_HB2][l * 64 + j];
        for (int i = 0; i < 64; ++i) a += h1[pp * 64 + i] * w2[i * 64 + j];
        h2[tid] = sinf(p.in[I_HFREQ][(l * 2 + 1) * 64 + j] * a); }
    __syncthreads();
    { const int o = tid, dir = o >> 8, c = o & 255; const float* w3 = p.in[I_HW3] + (size_t)l * 64 * 512; const float b3 = p.in[I_HB3][l * 512 + o];
        const float delta = 3.0701134573253946f + (float)c * ((15.350567286626973f - 3.0701134573253946f) / 255.0f);
        float acc[8];
#pragma unroll
        for (int pp = 0; pp < 8; ++pp) acc[pp] = b3;
        for (int j = 0; j < 64; ++j) { const float wv = w3[j * 512 + o];
#pragma unroll
            for (int pp = 0; pp < 8; ++pp) acc[pp] += h2[pp * 64 + j] * wv; }
        float* KT = (float*)(p.ws + WS_KT); float* HC = (float*)(p.ws + WS_HC);
#pragma unroll
        for (int pp = 0; pp < 8; ++pp) { const int pos = pos0 + pp; const float t = (float)pos / (float)(L - 1 > 1 ? L - 1 : 1);
            const float v = acc[pp] * __expf(-t * delta);
            if (L == SEQ) { if (dir == 0) KT[(size_t)c * NF + pos]= v; else if (pos > 0) KT[(size_t)c * NF + (NF - pos)] = v; else KT[(size_t)c * NF + SEQ] = 0.f; }
            else HC[((size_t)dir * WG + c) * CTXL + pos] = v; }
    }
}

__device__ __forceinline__ void layer_prep(const Params& p, int l, int idx, int stride, char* smem) {
    constexpr int N_WIN = (NPAD / 64) * (DM / 64), N_FL = SEQ / 8, N_FC = CTXL / 8;
    for (int task = idx; task < N_WIN + N_FL + N_FC; task += stride) {
        if (task < N_WIN) { const int nt = task / (DM / 64), kt = task % (DM / 64);
            convert_tile(p.in[I_WIN] + (size_t)l * DM * N_IN, N_IN, (bf16*)(p.ws + WS_WIN), DM, nt * 64, kt * 64, true, smem); }
        else if (task < N_WIN + N_FL) filter_task(p, l, SEQ, (task - N_WIN) * 8, smem);
        else filter_task(p, l, CTXL, (task - N_WIN - N_FL) * 8, smem);
    }
}
__device__ __forceinline__ void phase_rp(const Params& p, int l, char* smem) { rp_rows(p, l); if (l < DEPTH) layer_prep(p, l, obid(), (int)gridDim.x, smem); }

__device__ __forceinline__ cpx cmul(cpx a, cpx b) { cpx r; r.x = a.x * b.x - a.y * b.y; r.y = a.x * b.y + a.y * b.x; return r; }
__device__ __forceinline__ cpx cmulc(cpx a, cpx b) { cpx r; r.x = a.x * b.x + a.y * b.y; r.y = a.y * b.x - a.x * b.y; return r; }
constexpr int fpad(int i) { return i + (i >> 4); }
__device__ __forceinline__ int FPH(int i) { return i + (i >> 4); }
constexpr int FBUF = fpad(NF);
constexpr int ilog16(int n) { return n < 16 ? 0 : 1 + ilog16(n / 16); }
constexpr int FFT_P16 = ilog16(NF);
constexpr bool FFT_R4 = ((NF >> (4 * FFT_P16)) == 4);
static_assert((NF >> (4 * FFT_P16)) == 1 || (NF >> (4 * FFT_P16)) == 4, "NF = 16^a * (1 or 4)");
template <bool INV> __device__ __forceinline__ void dft4(cpx& a0, cpx& a1, cpx& a2, cpx& a3) {
    const cpx s = {a0.x + a2.x, a0.y + a2.y}, b = {a0.x - a2.x, a0.y - a2.y}, c = {a1.x + a3.x, a1.y + a3.y}, d = {a1.x - a3.x, a1.y - a3.y};
    a0 = (cpx){s.x + c.x, s.y + c.y}; a2 = (cpx){s.x - c.x, s.y - c.y};
    if (!INV) { a1 = (cpx){b.x + d.y, b.y - d.x}; a3 = (cpx){b.x - d.y, b.y + d.x}; }
    else      { a1 = (cpx){b.x - d.y, b.y + d.x}; a3 = (cpx){b.x + d.y, b.y - d.x}; }
}
template <bool INV> __device__ __forceinline__ cpx cmulk(cpx a, float wr, float wi) {
    cpx r; if (!INV) { r.x = a.x * wr + a.y * wi; r.y = a.y * wr - a.x * wi; } else { r.x = a.x * wr - a.y * wi; r.y = a.y * wr + a.x * wi; } return r;
}
template <bool INV> __device__ __forceinline__ void dft16(cpx (&x)[16]) {
    constexpr float C1 = 0.92387953251128674f, S1 = 0.38268343236508977f, C2 = 0.70710678118654752f;
#pragma unroll
    for (int n2 = 0; n2 < 4; ++n2) dft4<INV>(x[n2], x[4 + n2], x[8 + n2], x[12 + n2]);
    x[4 * 1 + 1] = cmulk<INV>(x[4 * 1 + 1], C1, S1); x[4 * 1 + 2] = cmulk<INV>(x[4 * 1 + 2], C2, C2); x[4 * 1 + 3] = cmulk<INV>(x[4 * 1 + 3], S1, C1);
    x[4 * 2 + 1] = cmulk<INV>(x[4 * 2 + 1], C2, C2); x[4 * 2 + 2] = cmulk<INV>(x[4 * 2 + 2], 0.f, 1.f); x[4 * 2 + 3] = cmulk<INV>(x[4 * 2 + 3], -C2, C2);
    x[4 * 3 + 1] = cmulk<INV>(x[4 * 3 + 1], S1, C1); x[4 * 3 + 2] = cmulk<INV>(x[4 * 3 + 2], -C2, C2); x[4 * 3 + 3] = cmulk<INV>(x[4 * 3 + 3], -C1, -S1);
#pragma unroll
    for (int k1 = 0; k1 < 4; ++k1) dft4<INV>(x[4 * k1 + 0], x[4 * k1 + 1], x[4 * k1 + 2], x[4 * k1 + 3]);
    cpx t;
    t = x[1]; x[1] = x[4]; x[4] = t; t = x[2]; x[2] = x[8]; x[8] = t; t = x[3]; x[3] = x[12]; x[12] = t;
    t = x[6]; x[6] = x[9]; x[9] = t; t = x[7]; x[7] = x[13]; x[13] = t; t = x[11]; x[11] = x[14]; x[14] = t;
}
template <bool INV> __device__ __forceinline__ void fft_stage16(cpx* buf, const cpx* TW, int tl, int M) {
    const int span = M >> 4, twm = NF / M;
#pragma unroll 1
    for (int j = tl; j < NF / 16; j += 256) {
        const int grp = j / span, pos = j % span, base = grp * M + pos; cpx x[16];
#pragma unroll
        for (int q = 0; q < 16; ++q) x[q] = buf[FPH(base + q * span)];
        cpx w1 = {1.f, 0.f}; if (span > 1) w1 = TW[pos * twm];
        if (INV && span > 1) { cpx wk = w1;
#pragma unroll
            for (int k = 1; k < 16; ++k) { x[k] = cmulc(x[k], wk); wk = cmul(wk, w1); } }
        dft16<INV>(x);
        if (!INV && span > 1) { cpx wk = w1;
#pragma unroll
            for (int k = 1; k < 16; ++k) { x[k] = cmul(x[k], wk); wk = cmul(wk, w1); } }
#pragma unroll
        for (int q = 0; q < 16; ++q) buf[FPH(base + q * span)] = x[q];
    }
}
template <bool INV> __device__ __forceinline__ void fft_stage4_last(cpx* buf, int tl) {
#pragma unroll 1
    for (int j = tl; j < NF / 4; j += 256) { cpx a0 = buf[FPH(4 * j)], a1 = buf[FPH(4 * j + 1)], a2 = buf[FPH(4 * j + 2)], a3 = buf[FPH(4 * j + 3)];
        dft4<INV>(a0, a1, a2, a3); buf[FPH(4 * j)] = a0; buf[FPH(4 * j + 1)] = a1; buf[FPH(4 * j + 2)] = a2; buf[FPH(4 * j + 3)] = a3; }
}
__device__ __forceinline__ void fft_fwd(cpx* buf, const cpx* TW, int tl) {
    int M = NF;
#pragma unroll
    for (int s = 0; s < FFT_P16; ++s) { __syncthreads(); fft_stage16<false>(buf, TW, tl, M); M >>= 4; }
    if (FFT_R4) { __syncthreads(); fft_stage4_last<false>(buf, tl); }
    __syncthreads();
}
__device__ __forceinline__ void fft_inv(cpx* buf, const cpx* TW, int tl) {
    if (FFT_R4) { __syncthreads(); fft_stage4_last<true>(buf, tl); }
    int M = FFT_R4 ? 64 : 16;
#pragma unroll
    for (int s = 0; s < FFT_P16; ++s) { __syncthreads(); fft_stage16<true>(buf, TW, tl, M); M <<= 4; }
    __syncthreads();
}
__device__ __forceinline__ void filt_fft_task(const Params& p, int cp, char* smem) {
    const int tid = otid(), half = tid >> 8, tl = tid & 255, c = 2 * cp + half;
    cpx* buf = (cpx*)smem + (size_t)half * FBUF;
    const float* KT = (const float*)(p.ws + WS_KT) + (size_t)c * NF;
    cpx* KF = (cpx*)(p.ws + WS_KF) + (size_t)c * NF;
    const cpx* TW = (const cpx*)(p.ws + WS_TW);
    __syncthreads();
    for (int i = tl; i < NF; i += 256) { cpx v; v.x = KT[i]; v.y = 0.f; buf[FPH(i)] = v; }
    fft_fwd(buf, TW, tl);
    for (int i = tl; i < NF; i += 256) KF[i] = buf[FPH(i)];
}

__device__ __forceinline__ void gemm_tile(const Params& p, const bf16* A, const bf16* Bt, int K, int mt, int nt, int mode, char* smem) {
    const int tid = otid(), lane = tid & 63, wave = tid >> 6;
    bf16* As = (bf16*)smem;
    bf16* Bs = As + 128 * LS;
    const int wm = (wave & 3) * 32, wn = (wave >> 2) * 64;
    f32x4 acc[2][4];
#pragma unroll
    for (int i = 0; i < 2; ++i)
#pragma unroll
        for (int j = 0; j < 4; ++j) acc[i][j] = (f32x4){0.f, 0.f, 0.f, 0.f};
    const int lr = tid >> 3, lc = tid & 7;
    const bf16* Ag = A + (size_t)(mt * 128 + lr) * K + lc * 8;
    const bf16* Bg = Bt + (size_t)(nt * 128 + lr) * K + lc * 8;
    u32x4 ra0, ra1, rb0, rb1;
    ra0 = *(const u32x4*)(Ag); ra1 = *(const u32x4*)(Ag + (size_t)64 * K); rb0 = *(const u32x4*)(Bg); rb1 = *(const u32x4*)(Bg + (size_t)64 * K);
    const int nk = K / 64;
    for (int kt = 0; kt < nk; ++kt) {
        __syncthreads();
        *(u32x4*)(As + lr * LS + lc * 8) = ra0; *(u32x4*)(As + (lr + 64) * LS + lc * 8) = ra1;
        *(u32x4*)(Bs + lr * LS + lc * 8) = rb0; *(u32x4*)(Bs + (lr + 64) * LS + lc * 8) = rb1;
        __syncthreads();
        if (kt + 1 < nk) { const int ko = (kt + 1) * 64;
            ra0 = *(const u32x4*)(Ag + ko); ra1 = *(const u32x4*)(Ag + (size_t)64 * K + ko); rb0 = *(const u32x4*)(Bg + ko); rb1 = *(const u32x4*)(Bg + (size_t)64 * K + ko); }
        mma_nt<4, 2>(As, LS, wm, Bs, LS, wn, acc[0], lane);
        mma_nt<4, 2>(As, LS, wm + 16, Bs, LS, wn, acc[1], lane);
    }
    const int r = lane & 15, q = lane >> 4;
#pragma unroll
    for (int i = 0; i < 2; ++i)
#pragma unroll
        for (int j = 0; j < 4; ++j)
#pragma unroll
            for (int e = 0; e < 4; ++e) {
                const int row = mt * 128 + wm + 16 * i + 4 * q + e, col = nt * 128 + wn + 16 * j + r; const float v = acc[i][j][e];
                if (mode == 0) { if (col < NP) ((bf16*)(p.ws + WS_P))[(size_t)row * NP + col] = f2bf(v); else if (col < NP + 16) ((float*)(p.ws + WS_G))[(size_t)row * NGS + (col - NP)] = v; else if (col < NP + NG) ((bf16*)((float*)(p.ws + WS_G) + (size_t)row * NGS + 16))[col - NP - 16] = f2bf(v); }
                else if (mode == 2) ((bf16*)(p.ws + WS_HT))[(size_t)row * T + col] = f2bf(v);
                else ((bf16*)(p.ws + WS_P))[(size_t)row * DM + col] = f2bf(v);
            }
}

#ifndef EMU
namespace pg8 {
#define PG8_LAS __attribute__((address_space(3)))
typedef unsigned short bf16_t;
typedef short bf16x8 __attribute__((ext_vector_type(8)));
typedef float f32x4 __attribute__((ext_vector_type(4)));
typedef unsigned u32x4 __attribute__((ext_vector_type(4)));
constexpr int BM = 256, BK = 64, HALF = 128, HTB = HALF * BK * 2  , STAGE_BYTES = 8 * HTB, NXCD = 8, WGM = 8;

__host__ __device__ __forceinline__ int lds_byte(int r, int c) { const int st = (r >> 4) * 2 + (c >> 5), rr = r & 15, cc = c & 31, ob = rr * 64 + cc * 2; return st * 1024 + (ob ^ (((ob >> 9) & 1) << 5)); }
__host__ __device__ __forceinline__ void stage_rc(int b, int& R, int& C) { const int st = b / 1024, sb = b % 1024, swz = sb ^ (((sb >> 9) & 1) << 5); R = (st >> 1) * 16 + swz / 64; C = (st & 1) * 32 + (swz % 64) / 2; }
__host__ __device__ __forceinline__ int perm32(int rho) { const int n = rho >> 4, i = rho & 15; return 8 * (i >> 2) + 4 * n + (i & 3); }

struct Unit { int pm, pn; };
struct Gemm { const bf16_t* A; const bf16_t* Bt; int M, N, K; };
__device__ __forceinline__ unsigned cvt_pk_bf16(float lo, float hi) { unsigned r; asm volatile("v_cvt_pk_bf16_f32 %0, %1, %2" : "=v"(r) : "v"(lo), "v"(hi)); return r; }
template <class Epi, class Sched, bool ALIGN_EPI = false, bool SP2 = false>
__device__ __forceinline__ void gemm_phase(PG8_LAS unsigned char* lds, const Gemm g, const Sched& S, const Epi& E) {
    const int tid = otid(), wid = __builtin_amdgcn_readfirstlane(tid >> 6), lane = tid & 63, wr = wid >> 2, wc = wid & 3, fr = lane & 15, fq = lane >> 4;
    const int K = g.K, nt = K / BK;
    unsigned voffA[2], voffB[2];
#pragma unroll
    for (int i = 0; i < 2; ++i) { int R, C; stage_rc(tid * 16 + i * 8192, R, C); const int Rb = Epi::PERM ? ((R & ~31) + perm32(R & 31)) : R;
        voffA[i] = (unsigned)(R * K + C) * 2u; voffB[i] = (unsigned)(Rb * K + C) * 2u; }
    const size_t kstep = (size_t)(BK * 2);
    const size_t hstep = (size_t)HALF * K * 2;
    const size_t tstep = 2 * hstep;
    const unsigned ldsw = (unsigned)wid * 1024u;
    const int aoff = lds_byte(wr * 64 + fr, fq * 8), boff = lds_byte(wc * 32 + fr, fq * 8);
#define PG8_SA(b, h) (((b) * 2 + (h)) * HTB)
#define PG8_SB(b, h) ((4 + (b) * 2 + (h)) * HTB)
#define PG8_STAGE(bufoff, gbase, voff) do { _Pragma("unroll") for (int _i = 0; _i < 2; ++_i) \
        __builtin_amdgcn_global_load_lds((const unsigned*)((const char*)(gbase) + (voff)[_i]), (PG8_LAS unsigned*)(lds + (bufoff) + ldsw + _i * 8192), 16, 0, 0); } while (0)
#define PG8_LDA(dst, b, h) do { _Pragma("unroll") for (int m = 0; m < 4; ++m) _Pragma("unroll") for (int k = 0; k < 2; ++k) dst[m][k] = *(const PG8_LAS bf16x8*)(lds + PG8_SA(b, h) + aoff + m * 2048 + k * 1024); } while (0)
#define PG8_LDB(dst, b, h) do { _Pragma("unroll") for (int n = 0; n < 2; ++n) _Pragma("unroll") for (int k = 0; k < 2; ++k) dst[n][k] = *(const PG8_LAS bf16x8*)(lds + PG8_SB(b, h) + boff + n * 2048 + k * 1024); } while (0)
#define PG8_MMA(ai, bj, At, Bt) do { __builtin_amdgcn_s_setprio(1); _Pragma("unroll") for (int m = 0; m < 4; ++m) _Pragma("unroll") for (int n = 0; n < 2; ++n) _Pragma("unroll") for (int k = 0; k < 2; ++k) \
        acc[ai][bj][m][n] = __builtin_amdgcn_mfma_f32_16x16x32_bf16(Bt[n][k], At[m][k], acc[ai][bj][m][n], 0, 0, 0); __builtin_amdgcn_s_setprio(0); } while (0)
#define PG8_WAIT_V(n) asm volatile("s_waitcnt vmcnt(" #n ")" ::: "memory")
#define PG8_WAIT_L(n) asm volatile("s_waitcnt lgkmcnt(" #n ")" ::: "memory")
#define PG8_BAR __builtin_amdgcn_s_barrier()
#define PG8_SCHED __builtin_amdgcn_sched_barrier(0)
    Unit cur, nxt; int ui = 0;
    if (!S.next(0, cur)) return;
    f32x4 acc[2][2][4][2];
#pragma unroll
    for (int a = 0; a < 2; ++a)
#pragma unroll
        for (int b = 0; b < 2; ++b)
#pragma unroll
            for (int m = 0; m < 4; ++m)
#pragma unroll
                for (int n = 0; n < 2; ++n) acc[a][b][m][n] = (f32x4){0.f, 0.f, 0.f, 0.f};
    bf16x8 At[4][2], B0[2][2], B1[2][2];
    const char* cA = (const char*)g.A + (size_t)cur.pm * tstep; const char* cB = (const char*)g.Bt + (size_t)cur.pn * tstep;
    S.a_ready(cur);
    if constexpr (SP2) {
        PG8_STAGE(PG8_SB(0, 0), cB, voffB); PG8_STAGE(PG8_SB(0, 1), cB + hstep, voffB); PG8_STAGE(PG8_SA(0, 0), cA, voffA); PG8_STAGE(PG8_SA(0, 1), cA + hstep, voffA);
        if (wr == 1) PG8_BAR;
        PG8_WAIT_V(2); PG8_BAR;
        PG8_STAGE(PG8_SB(1, 0), cB + kstep, voffB); PG8_STAGE(PG8_SA(1, 0), cA + kstep, voffA); PG8_STAGE(PG8_SB(1, 1), cB + hstep + kstep, voffB);
        PG8_WAIT_V(6); PG8_BAR;
    } else {
        PG8_STAGE(PG8_SB(0, 0), cB, voffB); PG8_STAGE(PG8_SA(0, 0), cA, voffA); PG8_STAGE(PG8_SB(0, 1), cB + hstep, voffB); PG8_STAGE(PG8_SA(0, 1), cA + hstep, voffA);
        if (wr == 1) PG8_BAR;
        PG8_WAIT_V(4); PG8_BAR;
        PG8_STAGE(PG8_SB(1, 0), cB + kstep, voffB); PG8_STAGE(PG8_SA(1, 0), cA + kstep, voffA); PG8_STAGE(PG8_SB(1, 1), cB + hstep + kstep, voffB);
        PG8_WAIT_V(6); PG8_BAR;
    }
    for (;;) {
        const bool has_next = S.next(ui + 1, nxt);
        const char* nA = has_next ? (const char*)g.A + (size_t)nxt.pm * tstep : cA; const char* nB = has_next ? (const char*)g.Bt + (size_t)nxt.pn * tstep : cB;
        for (int t = 0; t < nt; t += 2) {
            const bool last = (t == nt - 2);
            const char* a1 = cA + (size_t)(t + 1) * kstep;
            const char* a2 = last ? nA : cA + (size_t)(t + 2) * kstep; const char* b2 = last ? nB : cB + (size_t)(t + 2) * kstep;
            const char* a3 = a2 + kstep; const char* b3 = b2 + kstep;
            if (last && has_next) S.a_ready(nxt);
            if constexpr (SP2) {
            PG8_LDB(B0, 0, 0); PG8_LDB(B1, 0, 1); PG8_SCHED; PG8_LDA(At, 0, 0); PG8_STAGE(PG8_SA(1, 1), a1 + hstep, voffA);
            PG8_WAIT_V(8); PG8_WAIT_L(0); PG8_BAR; PG8_MMA(0, 0, At, B0); PG8_MMA(0, 1, At, B1); PG8_BAR; PG8_SCHED;
            PG8_LDA(At, 0, 1); PG8_STAGE(PG8_SB(0, 0), b2, voffB); PG8_STAGE(PG8_SB(0, 1), b2 + hstep, voffB); PG8_STAGE(PG8_SA(0, 0), a2, voffA);
            PG8_WAIT_V(8); PG8_WAIT_L(0); PG8_BAR; PG8_MMA(1, 0, At, B0); PG8_MMA(1, 1, At, B1); PG8_BAR; PG8_SCHED;
            PG8_LDB(B0, 1, 0); PG8_LDB(B1, 1, 1); PG8_SCHED; PG8_LDA(At, 1, 0); PG8_STAGE(PG8_SA(0, 1), a2 + hstep, voffA);
            PG8_WAIT_V(8); PG8_WAIT_L(0); PG8_BAR; PG8_MMA(0, 0, At, B0); PG8_MMA(0, 1, At, B1); PG8_BAR; PG8_SCHED;
            PG8_LDA(At, 1, 1); PG8_STAGE(PG8_SB(1, 0), b3, voffB); PG8_STAGE(PG8_SB(1, 1), b3 + hstep, voffB); PG8_STAGE(PG8_SA(1, 0), a3, voffA);
            PG8_WAIT_V(8); PG8_WAIT_L(0); PG8_BAR; PG8_MMA(1, 0, At, B0); PG8_MMA(1, 1, At, B1); PG8_BAR; PG8_SCHED;
            } else {
            PG8_LDB(B0, 0, 0); PG8_SCHED; PG8_LDA(At, 0, 0); PG8_STAGE(PG8_SA(1, 1), a1 + hstep, voffA);
            PG8_WAIT_L(8); PG8_BAR; PG8_WAIT_L(0); PG8_MMA(0, 0, At, B0); PG8_BAR; PG8_SCHED;
            PG8_LDB(B1, 0, 1); PG8_STAGE(PG8_SB(0, 0), b2, voffB);
            PG8_BAR; PG8_WAIT_L(0); PG8_MMA(0, 1, At, B1); PG8_BAR;
            PG8_LDA(At, 0, 1); PG8_STAGE(PG8_SA(0, 0), a2, voffA);
            PG8_BAR; PG8_WAIT_L(0); PG8_MMA(1, 0, At, B0); PG8_BAR; PG8_SCHED;
            PG8_STAGE(PG8_SB(0, 1), b2 + hstep, voffB);
            PG8_WAIT_V(6); PG8_BAR; PG8_MMA(1, 1, At, B1); PG8_BAR;
            PG8_LDB(B0, 1, 0); PG8_SCHED; PG8_LDA(At, 1, 0); PG8_STAGE(PG8_SA(0, 1), a2 + hstep, voffA);
            PG8_WAIT_L(8); PG8_BAR; PG8_WAIT_L(0); PG8_MMA(0, 0, At, B0); PG8_BAR; PG8_SCHED;
            PG8_LDB(B1, 1, 1); PG8_STAGE(PG8_SB(1, 0), b3, voffB);
            PG8_BAR; PG8_WAIT_L(0); PG8_MMA(0, 1, At, B1); PG8_BAR;
            PG8_LDA(At, 1, 1); PG8_STAGE(PG8_SA(1, 0), a3, voffA);
            PG8_BAR; PG8_WAIT_L(0); PG8_MMA(1, 0, At, B0); PG8_BAR; PG8_SCHED;
            PG8_STAGE(PG8_SB(1, 1), b3 + hstep, voffB);
            PG8_WAIT_V(6); PG8_BAR; PG8_MMA(1, 1, At, B1); PG8_BAR;
            }
        }
        if constexpr (ALIGN_EPI) { if (wr == 0) PG8_BAR; }
        if constexpr (!Epi::AFTER_DRAIN) { E(acc, cur, wr, wc, fr, fq); S.done(cur); }
        if (!has_next) break;
#pragma unroll
        for (int a = 0; a < 2; ++a)
#pragma unroll
            for (int b = 0; b < 2; ++b)
#pragma unroll
                for (int m = 0; m < 4; ++m)
#pragma unroll
                    for (int n = 0; n < 2; ++n) acc[a][b][m][n] = (f32x4){0.f, 0.f, 0.f, 0.f};
        cur = nxt; cA = nA; cB = nB; ++ui;
        if constexpr (ALIGN_EPI) { if (wr == 1) PG8_BAR; }
    }
    PG8_WAIT_V(0);
    if constexpr (!ALIGN_EPI) { if (wr == 0) PG8_BAR; }
    PG8_BAR;
    if constexpr (Epi::AFTER_DRAIN) { E.fused(acc, cur, wr, wc, fr, fq, lds, wid, lane); S.done(cur); }
#undef PG8_SA
#undef PG8_SB
#undef PG8_STAGE
#undef PG8_LDA
#undef PG8_LDB
#undef PG8_MMA
#undef PG8_WAIT_V
#undef PG8_WAIT_L
#undef PG8_BAR
#undef PG8_SCHED
}
__device__ __forceinline__ void map_tile(int L, int nM, int nN, int& pm, int& pn) {
    const int nwg = nM * nN; int wgid = L; { const int q = nwg / NXCD, r = nwg % NXCD, xcd = wgid % NXCD, off = wgid / NXCD; wgid = (xcd < r ? xcd * (q + 1) : r * (q + 1) + (xcd - r) * q) + off; }
    const int nig = WGM * nN, gid = wgid / nig, fm = gid * WGM, gsz = (nM - fm) < WGM ? (nM - fm) : WGM;
    pm = fm + ((wgid % nig) % gsz); pn = (wgid % nig) / gsz;
}
constexpr int MP = T / 256, WP = NMAIN / 256, NU2 = 4 * MP, NU1 = MP * WP;
struct InOrder { int G, c;
    __device__ __forceinline__ bool next(int i, Unit& u) const { const int L = i * G + c; if (L >= NU2 + NU1) return false; int a, b;
        if (L < NU2) { map_tile(L, 4, MP, a, b); u.pm = MP + WP + a; u.pn = b; } else { map_tile(L - NU2, MP, WP, a, b); u.pm = a; u.pn = MP + b; } return true; }
    __device__ __forceinline__ void a_ready(const Unit&) const {}
    __device__ __forceinline__ void done(const Unit&) const {}
};
struct EpiIn { static constexpr bool PERM = true, AFTER_DRAIN = false; bf16_t* P; float* G; bf16_t* HTp;
    __device__ __forceinline__ void operator()(const f32x4 (&acc)[2][2][4][2], const Unit& u, int wr, int wc, int fr, int fq) const {
        if (u.pm < MP) { const int pn = u.pn - MP, row0 = u.pm * BM + wr * 64 + fr;
            if (pn < NP / 256) { const int col0 = pn * BM + wc * 32 + 8 * fq;
#pragma unroll
                for (int ai = 0; ai < 2; ++ai)
#pragma unroll
                    for (int m = 0; m < 4; ++m) { bf16_t* rowp = P + (size_t)(row0 + ai * HALF + m * 16) * NP + col0;
#pragma unroll
                        for (int bj = 0; bj < 2; ++bj) { const f32x4 v0 = acc[ai][bj][m][0], v1 = acc[ai][bj][m][1];
                            u32x4 w; w.x = cvt_pk_bf16(v0[0], v0[1]); w.y = cvt_pk_bf16(v0[2], v0[3]); w.z = cvt_pk_bf16(v1[0], v1[1]); w.w = cvt_pk_bf16(v1[2], v1[3]); *(u32x4*)(rowp + bj * HALF) = w; } } }
            else { const int cb = wc * 32 + 8 * fq;
                if (cb < NG) {
#pragma unroll
                    for (int ai = 0; ai < 2; ++ai)
#pragma unroll
                        for (int m = 0; m < 4; ++m) { float* rowb = G + (size_t)(row0 + ai * HALF + m * 16) * NGS; const f32x4 v0 = acc[ai][0][m][0], v1 = acc[ai][0][m][1];
                            if (cb < 16) { *(f32x4*)(rowb + cb) = v0; *(f32x4*)(rowb + cb + 4) = v1; }
                            else { u32x4 w; w.x = cvt_pk_bf16(v0[0], v0[1]); w.y = cvt_pk_bf16(v0[2], v0[3]); w.z = cvt_pk_bf16(v1[0], v1[1]); w.w = cvt_pk_bf16(v1[2], v1[3]); *(u32x4*)((bf16_t*)(rowb + 16) + (cb - 16)) = w; } } } } }
        else { const int row0 = (u.pm - MP - WP) * BM + wr * 64 + fr, col0 = u.pn * BM + wc * 32 + 8 * fq;
#pragma unroll
            for (int ai = 0; ai < 2; ++ai)
#pragma unroll
                for (int m = 0; m < 4; ++m) { bf16_t* rowp = HTp + (size_t)(row0 + ai * HALF + m * 16) * T + col0;
#pragma unroll
                    for (int bj = 0; bj < 2; ++bj) { const f32x4 v0 = acc[ai][bj][m][0], v1 = acc[ai][bj][m][1];
                        u32x4 w; w.x = cvt_pk_bf16(v0[0], v0[1]); w.y = cvt_pk_bf16(v0[2], v0[3]); w.z = cvt_pk_bf16(v1[0], v1[1]); w.w = cvt_pk_bf16(v1[2], v1[3]); *(u32x4*)(rowp + bj * HALF) = w; } } }
    }
};
struct OutOrder { int G, c; bool lat_only;
    __device__ __forceinline__ bool next(int i, Unit& u) const { const int nM = lat_only ? NB * (SEQ / 256) : MP, nN = DM / 256; const int L = i * G + c; if (L >= nM * nN) return false; int a, b; map_tile(L, nM, nN, a, b);
        u.pm = lat_only ? (a / (SEQ / 256)) * (TOK / 256) + CTXL / 256 + a % (SEQ / 256) : a; u.pn = b; return true; }
    __device__ __forceinline__ void a_ready(const Unit&) const {}
    __device__ __forceinline__ void done(const Unit&) const {}
};
struct EpiOut { static constexpr bool PERM = true, AFTER_DRAIN = false; bf16_t* C;
    __device__ __forceinline__ void operator()(const f32x4 (&acc)[2][2][4][2], const Unit& u, int wr, int wc, int fr, int fq) const {
        const int row0 = u.pm * BM + wr * 64 + fr, col0 = u.pn * BM + wc * 32 + 8 * fq;
#pragma unroll
        for (int ai = 0; ai < 2; ++ai)
#pragma unroll
            for (int m = 0; m < 4; ++m) { bf16_t* rowp = C + (size_t)(row0 + ai * HALF + m * 16) * DM + col0;
#pragma unroll
                for (int bj = 0; bj < 2; ++bj) { const f32x4 v0 = acc[ai][bj][m][0], v1 = acc[ai][bj][m][1];
                    u32x4 w; w.x = cvt_pk_bf16(v0[0], v0[1]); w.y = cvt_pk_bf16(v0[2], v0[3]); w.z = cvt_pk_bf16(v1[0], v1[1]); w.w = cvt_pk_bf16(v1[2], v1[3]); *(u32x4*)(rowp + bj * HALF) = w; } }
    }
};
}
#endif

__device__ __forceinline__ void phase_gemm_in(const Params& p, int l, char* smem) {
    constexpr int N_F = WG / 2;
#ifdef EMU
    constexpr int MT = T / 128, NT1 = NMAIN / 128, N1 = MT * NT1, N2 = 8 * MT;
    for (int task = obid(); task < N1 + N2; task += gridDim.x) {
        if (task < N1) gemm_tile(p, (const bf16*)(p.ws + WS_HNY), (const bf16*)(p.ws + WS_WIN), DM, task / NT1, task % NT1, 0, smem);
        else { const int t2 = task - N1; gemm_tile(p, (const bf16*)(p.ws + WS_WIN) + (size_t)NMAIN * DM, (const bf16*)(p.ws + WS_HNY), DM, t2 / MT, t2 % MT, 2, smem); }
    }
#else
    { const pg8::Gemm g{(const pg8::bf16_t*)(p.ws + WS_HNY), (const pg8::bf16_t*)(p.ws + WS_HNY), 0, 0, DM};
      const pg8::InOrder S{(int)gridDim.x, obid()};
      const pg8::EpiIn E{(pg8::bf16_t*)(p.ws + WS_P), (float*)(p.ws + WS_G), (pg8::bf16_t*)(p.ws + WS_HT)};
      pg8::gemm_phase<pg8::EpiIn, pg8::InOrder, true, true>((PG8_LAS unsigned char*)smem, g, S, E); }
#endif
    for (int task = (int)gridDim.x - 1 - obid(); task < N_F; task += gridDim.x) filt_fft_task(p, task, smem);
}
__device__ __forceinline__ void phase_gemm_out(const Params& p, int l, char* smem) {
    const int G = (int)gridDim.x, bid = obid();
#ifdef EMU
    constexpr int MT = T / 128, NTO = DM / 128;
    for (int task = bid; task < MT * NTO; task += G) {
        const int mt = task / NTO, nt = task % NTO;
        if (l == DEPTH - 1 && (mt % (TOK / 128)) < CTXL / 128) continue;
        gemm_tile(p, (const bf16*)(p.ws + WS_HNY), (const bf16*)(p.ws + WS_WOUT), MIX, mt, nt, 1, smem);
    }
    const int extra = 0;
#else
    const pg8::Gemm g{(const pg8::bf16_t*)(p.ws + WS_HNY), (const pg8::bf16_t*)(p.ws + WS_WOUT), 0, 0, MIX};
    const pg8::OutOrder S{G, bid, l == DEPTH - 1};
    const pg8::EpiOut E{(pg8::bf16_t*)(p.ws + WS_P)};
    pg8::gemm_phase<pg8::EpiOut, pg8::OutOrder, true, true>((PG8_LAS unsigned char*)smem, g, S, E);
    const int nU = (l == DEPTH - 1 ? NB * (SEQ / 256) : T / 256) * (DM / 256); const int extra = nU % G;
#endif
    (void)extra;
}

__device__ __forceinline__ size_t st_index(int mixer, int dir, int b, int h, int cid) { return ((((size_t)(mixer * 2 + dir) * NB + b) * NH + h) * NCH + cid); }
__device__ __forceinline__ size_t ch_index(int dir, int b, int h, int cid) { return (((size_t)dir * NB + b) * NH + h) * NCH + cid; }

__device__ __forceinline__ void load_tile_nat(const bf16* P, int r0, int c0, bf16* dst, float scale, int tid) {
    const int s = tid >> 3, c8 = tid & 7;
    const u32x4 v = *(const u32x4*)(P + (size_t)(r0 + s) * NP + c0 + c8 * 8);
    if (scale == 1.0f) *(u32x4*)(dst + s * LS + c8 * 8) = v;
    else { float f[8]; unpack8(v, f); u32x4 o; o.x = pk2(f[0] * scale, f[1] * scale); o.y = pk2(f[2] * scale, f[3] * scale); o.z = pk2(f[4] * scale, f[5] * scale); o.w = pk2(f[6] * scale, f[7] * scale);
        *(u32x4*)(dst + s * LS + c8 * 8) = o; }
}
__device__ __forceinline__ void load_tile_tr(const bf16* P, int r0, int c0, bf16* dst, int tid) {
    const int s = tid >> 3, c8 = tid & 7;
    const u32x4 v = *(const u32x4*)(P + (size_t)(r0 + s) * NP + c0 + c8 * 8);
    const unsigned w[4] = {v.x, v.y, v.z, v.w};
#pragma unroll
    for (int j = 0; j < 4; ++j) { dst[(c8 * 8 + 2 * j) * LS + s] = (bf16)(w[j] & 0xffffu); dst[(c8 * 8 + 2 * j + 1) * LS + s] = (bf16)(w[j] >> 16); }
}

template <int NTK>
__device__ __forceinline__ void load_span(const bf16* row, int t0, float (&v)[NTK + 2]) {
    v[0] = t0 > 0 ? bf2f(row[-1]) : 0.f; v[NTK + 1] = (t0 + NTK < SEQ) ? bf2f(row[NTK]) : 0.f;
    if constexpr (NTK == 8) { float f[8]; unpack8(*(const u32x4*)row, f);
#pragma unroll
        for (int i = 0; i < 8; ++i) v[1 + i] = f[i]; }
    else {
#pragma unroll
        for (int i = 0; i < NTK; ++i) v[1 + i] = bf2f(row[i]); }
}
template <int NTK>
__device__ __forceinline__ void hy_inputs(const bf16* h0, const bf16* h1, const float* cw, const float* cb, int c, int t0, float (&u0)[NTK], float (&u1)[NTK], float (&g0)[NTK], float (&g1)[NTK]) {
    { float xa[NTK + 2], xb[NTK + 2]; load_span<NTK>(h0 + (size_t)512 * T, t0, xa); load_span<NTK>(h1 + (size_t)512 * T, t0, xb);
        const float w0 = cw[0 * 768 + 512 + c], w1 = cw[1 * 768 + 512 + c], w2 = cw[2 * 768 + 512 + c], bb = cb[512 + c];
        float ga[NTK + 2], gb[NTK + 2]; load_span<NTK>(h0 + (size_t)768 * T, t0, ga); load_span<NTK>(h1 + (size_t)768 * T, t0, gb);
#pragma unroll
        for (int i = 0; i < NTK; ++i) { g0[i] = (w0 * xa[i] + w1 * xa[i + 1] + w2 * xa[i + 2] + bb) * siluf_(ga[i + 1]); g1[i] = (w0 * xb[i] + w1 * xb[i + 1] + w2 * xb[i + 2] + bb) * siluf_(gb[i + 1]); } }
    { float va[NTK + 2], vb[NTK + 2], ya[NTK + 2], yb[NTK + 2];
        load_span<NTK>(h0, t0, va); load_span<NTK>(h1, t0, vb); load_span<NTK>(h0 + (size_t)256 * T, t0, ya); load_span<NTK>(h1 + (size_t)256 * T, t0, yb);
        const float v0 = cw[0 * 768 + c], v1 = cw[1 * 768 + c], v2 = cw[2 * 768 + c], vbias = cb[c];
        const float y0 = cw[0 * 768 + 256 + c], y1 = cw[1 * 768 + 256 + c], y2 = cw[2 * 768 + 256 + c], ybias = cb[256 + c];
#pragma unroll
        for (int i = 0; i < NTK; ++i) { u0[i] = (v0 * va[i] + v1 * va[i + 1] + v2 * va[i + 2] + vbias) * (y0 * ya[i] + y1 * ya[i + 1] + y2 * ya[i + 2] + ybias);
            u1[i] = (v0 * vb[i] + v1 * vb[i + 1] + v2 * vb[i + 2] + vbias) * (y0 * yb[i] + y1 * yb[i + 1] + y2 * yb[i + 2] + ybias); } }
}
__device__ __forceinline__ void hylat_task(const Params& p, int l, int bp, int cp, char* smem) {
    const int tid = otid(), half = tid >> 8, tl = tid & 255, c = 2 * cp + half;
    const bf16* HT = (const bf16*)(p.ws + WS_HT); bf16* Y = (bf16*)(p.ws + WS_HNY);
    cpx* buf = (cpx*)smem + (size_t)half * FBUF;
    const cpx* TW = (const cpx*)(p.ws + WS_TW);
    const cpx* KF = (const cpx*)(p.ws + WS_KF) + (size_t)c * NF;
    constexpr int NTK = SEQ / 256;
    const int t0 = NTK * tl;
    const float* cw = p.in[I_HCW] + (size_t)l * 3 * 768; const float* cb = p.in[I_HCB] + (size_t)l * 768;
    const size_t rb0 = (size_t)(2 * bp) * TOK + CTXL, rb1 = rb0 + TOK;
    const bf16* h0 = HT + (size_t)c * T + rb0 + t0; const bf16* h1 = h0 + TOK;
    { float u0[NTK], u1[NTK], g0[NTK], g1[NTK]; hy_inputs<NTK>(h0, h1, cw, cb, c, t0, u0, u1, g0, g1);
        __syncthreads();
#pragma unroll
        for (int i = 0; i < NTK; ++i) { cpx v; v.x = u0[i]; v.y = u1[i]; buf[FPH(t0 + i)] = v; cpx z = {0.f, 0.f}; buf[FPH(SEQ + t0 + i)] = z; } }
    fft_fwd(buf, TW, tl);
#pragma unroll 2
    for (int i = tl; i < NF; i += 256) buf[FPH(i)] = cmul(buf[FPH(i)], KF[i]);
    fft_inv(buf, TW, tl);
    const float dsk = p.in[I_HD][(size_t)l * WG + c]; const float sc = 1.0f / (float)NF;
    { const int tz = otid() & 255; const int t0z = NTK * tz;
        float u0[NTK], u1[NTK], g0[NTK], g1[NTK]; hy_inputs<NTK>(HT + (size_t)c * T + rb0 + t0z, HT + (size_t)c * T + rb0 + t0z + TOK, cw, cb, c, t0z, u0, u1, g0, g1);
        float o0[NTK], o1[NTK];
#pragma unroll
        for (int i = 0; i < NTK; ++i) { const cpx y = buf[FPH(t0z + i)]; o0[i] = g0[i] * (y.x * sc + u0[i] * dsk); o1[i] = g1[i] * (y.y * sc + u1[i] * dsk); }
        bf16* d0 = (bf16*)(p.ws + WS_HT) + (size_t)(768 + c) * T + rb0 + t0z; bf16* d1 = d0 + TOK;
        if constexpr (NTK == 8) { *(u32x4*)d0 = pack8(o0); *(u32x4*)d1 = pack8(o1); }
        else {
#pragma unroll
            for (int i = 0; i < NTK; ++i) { d0[i] = f2bf(o0[i]); d1[i] = f2bf(o1[i]); } } }
}

constexpr int HCB = 16;
__device__ __forceinline__ void hyctx_task(const Params& p, int l, int b, int cblk, char* smem) {
    const int tid = otid(); const int c0 = cblk * HCB;
    const bf16* HT = (const bf16*)(p.ws + WS_HT); bf16* Y = (bf16*)(p.ws + WS_HNY); const float* HC = (const float*)(p.ws + WS_HC);
    float* raw = (float*)smem;
    float* u = raw + 4 * CTXL * HCB;
    float* og = u + CTXL * HCB;
    float* hcm = og + CTXL * HCB;
    bf16* ob = (bf16*)raw;
    const size_t rb = (size_t)b * TOK;
    const float* cw = p.in[I_HCW] + (size_t)l * 3 * 768; const float* cbias = p.in[I_HCB] + (size_t)l * 768;
    constexpr int WT = CTXL / 32;
    __syncthreads();
    for (int i = tid; i < 4 * HCB * (CTXL / 8); i += NT) { const int k = i / (HCB * (CTXL / 8)), cc = (i / (CTXL / 8)) % HCB, ck = i % (CTXL / 8);
        float f[8]; unpack8(*(const u32x4*)(HT + (size_t)(k * 256 + c0 + cc) * T + rb + ck * 8), f);
#pragma unroll
        for (int j = 0; j < 8; ++j) raw[(k * CTXL + ck * 8 + j) * HCB + cc] = f[j]; }
    for (int i = tid; i < 2 * HCB * (CTXL / 4); i += NT) { const int dir = i / (HCB * (CTXL / 4)), cc = (i / (CTXL / 4)) % HCB, pk = i % (CTXL / 4);
        const f32x4 v = *(const f32x4*)(HC + ((size_t)dir * WG + c0 + cc) * CTXL + pk * 4); const float f[4] = {v.x, v.y, v.z, v.w};
#pragma unroll
        for (int j = 0; j < 4; ++j) { const int pos = pk * 4 + j; if (dir == 0) hcm[(CTXL + pos) * HCB + cc] = f[j]; else if (pos > 0) hcm[(CTXL - pos) * HCB + cc] = f[j]; } }
    if (tid < HCB) hcm[tid] = 0.f;
    __syncthreads();
    for (int i = tid; i < CTXL * HCB; i += NT) { const int t = i / HCB, cc = i % HCB; float cv[3];
#pragma unroll
        for (int k = 0; k < 3; ++k) { const float* rk = raw + k * CTXL * HCB; const int ch = k * 256 + c0 + cc;
            const float a = t > 0 ? rk[(t - 1) * HCB + cc] : 0.f, m = rk[t * HCB + cc], z = t < CTXL - 1 ? rk[(t + 1) * HCB + cc] : 0.f;
            cv[k] = cw[0 * 768 + ch] * a + cw[1 * 768 + ch] * m + cw[2 * 768 + ch] * z + cbias[ch]; }
        u[i] = cv[0] * cv[1];
        og[i] = cv[2] * siluf_(raw[(3 * CTXL + t) * HCB + cc]); }
    __syncthreads();
    { const int cc = tid % HCB, tg = tid / HCB, t0 = WT * tg; float acc[WT], w[WT];
#pragma unroll
        for (int j = 0; j < WT; ++j) { acc[j] = 0.f; w[j] = hcm[(t0 + j + CTXL) * HCB + cc]; }
#pragma unroll 8
        for (int s = 0; s < CTXL; ++s) { const float us = u[s * HCB + cc];
#pragma unroll
            for (int j = 0; j < WT; ++j) acc[j] += us * w[j];
#pragma unroll
            for (int j = WT - 1; j > 0; --j) w[j] = w[j - 1];
            w[0] = hcm[(t0 - s - 1 + CTXL) * HCB + cc]; }
        const float dsk = p.in[I_HD][(size_t)l * WG + c0 + cc];
#pragma unroll
        for (int j = 0; j < WT; ++j) { const int t = t0 + j; ob[t * HCB + cc] = f2bf(og[t * HCB + cc] * (acc[j] + u[t * HCB + cc] * dsk)); } }
    __syncthreads();
    for (int i = tid; i < CTXL * 2; i += NT) { const int t = i >> 1, hh = i & 1; *(u32x4*)(Y + (rb + t) * 1024 + YH + c0 + 8 * hh) = *(const u32x4*)(ob + t * HCB + 8 * hh); }
}

__device__ __forceinline__ void attn_task(const Params& p, int l, int b, int kvh, int qt, bool ctxq, char* smem) {
    const int tid = otid(), lane = tid & 63, wave = tid >> 6, r = lane & 15, q = lane >> 4;
    const bf16* P = (const bf16*)(p.ws + WS_P); bf16* Y = (bf16*)(p.ws + WS_HNY); const cpx* ROPE = (const cpx*)(p.ws + WS_ROPE);
    bf16* Qs = (bf16*)smem;
    bf16* Ks = Qs + 128 * LS;
    bf16* Vt = Ks + 64 * LS;
    bf16* Ps = Vt + 64 * LS;
    const size_t rq0 = (size_t)b * TOK + (ctxq ? 0 : CTXL) + qt * 64;
    __syncthreads();
    {
        const int row = tid >> 2, cpair = tid & 3, g = row >> 6, t = row & 63;
        const bf16* src = P + (rq0 + t) * NP + PD + (kvh * 2 + g) * 64;
        float lo[8], hi[8]; unpack8(*(const u32x4*)(src + cpair * 8), lo); unpack8(*(const u32x4*)(src + 32 + cpair * 8), hi);
        u32x4 o1, o2; float a[8], c2[8];
#pragma unroll
        for (int j = 0; j < 8; ++j) { float cs = 1.f, sn = 0.f; if (!ctxq) { const cpx cv = ROPE[(size_t)(qt * 64 + t) * 32 + cpair * 8 + j]; cs = cv.x; sn = cv.y; }
            a[j] = (lo[j] * cs - hi[j] * sn) * 0.125f; c2[j] = (hi[j] * cs + lo[j] * sn) * 0.125f; }
        o1.x = pk2(a[0], a[1]); o1.y = pk2(a[2], a[3]); o1.z = pk2(a[4], a[5]); o1.w = pk2(a[6], a[7]);
        o2.x = pk2(c2[0], c2[1]); o2.y = pk2(c2[2], c2[3]); o2.z = pk2(c2[4], c2[5]); o2.w = pk2(c2[6], c2[7]);
        *(u32x4*)(Qs + row * LS + cpair * 8) = o1; *(u32x4*)(Qs + row * LS + 32 + cpair * 8) = o2;
    }
    const int lt0 = ctxq ? 0 : (qt - 2 > 0 ? qt - 2 : 0), lt1 = ctxq ? -1 : (qt + 2 < SEQ / 64 - 1 ? qt + 2 : SEQ / 64 - 1);
    const int nloc = lt1 - lt0 + 1, ntiles = nloc + NCC;
    float m[4], lsum[4]; f32x4 O[4];
#pragma unroll
    for (int i = 0; i < 4; ++i) { m[i] = -INFINITY; lsum[i] = 0.f; O[i] = (f32x4){0.f, 0.f, 0.f, 0.f}; }
    const int g = wave >> 2, tq0 = (wave & 3) * 16;
    bf16* Pw = Ps + wave * 16 * LS;
    u32x4 klo = {0u, 0u, 0u, 0u}, khi = klo, vq = klo; f32x4 rp[4] = {(f32x4){1.f, 0.f, 1.f, 0.f}, (f32x4){1.f, 0.f, 1.f, 0.f}, (f32x4){1.f, 0.f, 1.f, 0.f}, (f32x4){1.f, 0.f, 1.f, 0.f}};
    const int ks_ = tid >> 2, kcp = tid & 3, vs_ = tid >> 3, vc8 = tid & 7;
#define ATT_PREFETCH(TI) do { const bool loc_ = (TI) < nloc; const int kt_ = loc_ ? lt0 + (TI) : (TI) - nloc; const size_t rk_ = (size_t)b * TOK + (loc_ ? CTXL : 0) + kt_ * 64; \
        if (tid < 256) { const bf16* src_ = P + (rk_ + ks_) * NP + PD + 256 + kvh * 64; klo = *(const u32x4*)(src_ + kcp * 8); khi = *(const u32x4*)(src_ + 32 + kcp * 8); \
            if (loc_) { const f32x4* rr_ = (const f32x4*)(ROPE + (size_t)(kt_ * 64 + ks_) * 32 + kcp * 8); rp[0] = rr_[0]; rp[1] = rr_[1]; rp[2] = rr_[2]; rp[3] = rr_[3]; } \
            else { rp[0] = rp[1] = rp[2] = rp[3] = (f32x4){1.f, 0.f, 1.f, 0.f}; } } \
        vq = *(const u32x4*)(P + (rk_ + vs_) * NP + PD + 384 + kvh * 64 + vc8 * 8); } while (0)
    ATT_PREFETCH(0);
    for (int ti = 0; ti < ntiles; ++ti) {
        const bool local = ti < nloc; const int kt = local ? lt0 + ti : ti - nloc;
        __syncthreads();
        if (tid < 256) { float lo[8], hi[8]; unpack8(klo, lo); unpack8(khi, hi);
            const float cs[8] = {rp[0].x, rp[0].z, rp[1].x, rp[1].z, rp[2].x, rp[2].z, rp[3].x, rp[3].z}, sn[8] = {rp[0].y, rp[0].w, rp[1].y, rp[1].w, rp[2].y, rp[2].w, rp[3].y, rp[3].w};
            float a[8], c2[8];
#pragma unroll
            for (int j = 0; j < 8; ++j) { a[j] = lo[j] * cs[j] - hi[j] * sn[j]; c2[j] = hi[j] * cs[j] + lo[j] * sn[j]; }
            u32x4 o1, o2;
            o1.x = pk2(a[0], a[1]); o1.y = pk2(a[2], a[3]); o1.z = pk2(a[4], a[5]); o1.w = pk2(a[6], a[7]);
            o2.x = pk2(c2[0], c2[1]); o2.y = pk2(c2[2], c2[3]); o2.z = pk2(c2[4], c2[5]); o2.w = pk2(c2[6], c2[7]);
            *(u32x4*)(Ks + ks_ * LS + kcp * 8) = o1; *(u32x4*)(Ks + ks_ * LS + 32 + kcp * 8) = o2; }
        { const unsigned w[4] = {vq.x, vq.y, vq.z, vq.w};
#pragma unroll
            for (int j = 0; j < 4; ++j) { Vt[(vc8 * 8 + 2 * j) * LS + vs_] = (bf16)(w[j] & 0xffffu); Vt[(vc8 * 8 + 2 * j + 1) * LS + vs_] = (bf16)(w[j] >> 16); } }
        __syncthreads();
        if (ti + 1 < ntiles) ATT_PREFETCH(ti + 1);
        f32x4 S[4] = {(f32x4){0.f, 0.f, 0.f, 0.f}, (f32x4){0.f, 0.f, 0.f, 0.f}, (f32x4){0.f, 0.f, 0.f, 0.f}, (f32x4){0.f, 0.f, 0.f, 0.f}};
        mma_nt<4, 2>(Qs, LS, g * 64 + tq0, Ks, LS, 0, S, lane);
        float rmax[4];
#pragma unroll
        for (int i = 0; i < 4; ++i) { const int qpos = qt * 64 + tq0 + 4 * q + i; float mx = -INFINITY;
#pragma unroll
            for (int nt = 0; nt < 4; ++nt) { if (local) { const int kpos = kt * 64 + nt * 16 + r; const int d = kpos - qpos; if (d > 128 || d < -128) S[nt][i] = -INFINITY; } mx = fmaxf(mx, S[nt][i]); }
            mx = fmaxf(mx, __shfl_xor(mx, 1)); mx = fmaxf(mx, __shfl_xor(mx, 2)); mx = fmaxf(mx, __shfl_xor(mx, 4)); mx = fmaxf(mx, __shfl_xor(mx, 8));
            rmax[i] = mx; }
#pragma unroll
        for (int i = 0; i < 4; ++i) { const float mn = fmaxf(m[i], rmax[i]); const float alpha = __expf(m[i] - mn); float sm = 0.f;
#pragma unroll
            for (int nt = 0; nt < 4; ++nt) { const float pv = __expf(S[nt][i] - mn); sm += pv; Pw[(4 * q + i) * LS + nt * 16 + r] = f2bf(pv); O[nt][i] *= alpha; }
            sm += __shfl_xor(sm, 1); sm += __shfl_xor(sm, 2); sm += __shfl_xor(sm, 4); sm += __shfl_xor(sm, 8);
            lsum[i] = lsum[i] * alpha + sm; m[i] = mn; }
        WAVE_SYNC();
        mma_nt<4, 2>(Pw, LS, 0, Vt, LS, 0, O, lane);
    }
#undef ATT_PREFETCH
    const float sink = p.in[I_SINK][(size_t)l * NH + kvh * 2 + g];
    WAVE_SYNC();
#pragma unroll
    for (int i = 0; i < 4; ++i) { const float den = lsum[i] + __expf(sink - m[i]); const float inv = 1.0f / den;
#pragma unroll
        for (int nt = 0; nt < 4; ++nt) Pw[(4 * q + i) * LS + nt * 16 + r] = f2bf(O[nt][i] * inv); }
    WAVE_SYNC();
#pragma unroll
    for (int hh = 0; hh < 2; ++hh) { const int t = lane >> 2, ck = (lane & 3) * 2 + hh;
        float fo[8], fg[8]; unpack8(*(const u32x4*)(Pw + t * LS + ck * 8), fo);
        unpack8(*(const u32x4*)(P + (rq0 + tq0 + t) * NP + PD + 512 + (kvh * 2 + g) * 64 + ck * 8), fg);
#pragma unroll
        for (int j = 0; j < 8; ++j) fo[j] *= siluf_(fg[j]);
        *(u32x4*)(Y + (rq0 + tq0 + t) * 1024 + YD + (kvh * 2 + g) * 64 + ck * 8) = pack8(fo); }
}

#ifdef EMU
__device__ __forceinline__ int olane(int lane) { return lane; }
#else
__device__ __forceinline__ int olane(int lane) { asm volatile("" : "+v"(lane)); return lane; }
#endif
constexpr int WLDS = (LDS_BYTES - 64) / 8 / 16 * 16;
__device__ __forceinline__ void load_nat_tile(const bf16* P, int row0, int col0, bf16* tile, int lane) {
    u32x4 v[8];
#pragma unroll
    for (int i = 0; i < 8; ++i) v[i] = *(const u32x4*)(P + (size_t)(row0 + (lane >> 3) + 8 * i) * NP + col0 + (lane & 7) * 8);
#pragma unroll
    for (int i = 0; i < 8; ++i) *(u32x4*)(tile + swz((lane >> 3) + 8 * i, lane & 7)) = v[i];
}
__device__ __forceinline__ bf16x8 frag_tr(const bf16* tile, int c0, int k0, int lane) {
    const int c = c0 + (lane & 15), kb = k0 + 8 * (lane >> 4); unsigned w[4];
#pragma unroll
    for (int j = 0; j < 4; ++j) w[j] = (unsigned)tile[swz(kb + 2 * j, c >> 3) + (c & 7)] | ((unsigned)tile[swz(kb + 2 * j + 1, c >> 3) + (c & 7)] << 16);
    u32x4 o; o.x = w[0]; o.y = w[1]; o.z = w[2]; o.w = w[3]; return as_frag(o);
}
template <int DIR>
__device__ __forceinline__ void gla_r_frags(const float* Grow0, int lane, bf16x8 (&af)[4]) {
    const int r = lane & 15, q4 = lane >> 4;
#pragma unroll
    for (int mt = 0; mt < 4; ++mt) { u32x4 o = {0u, 0u, 0u, 0u};
        if (q4 < 2) o = *(const u32x4*)((const bf16*)(Grow0 + (size_t)(16 * mt + r) * NGS + 16) + DIR * 16 + 8 * q4);
        af[mt] = as_frag(o); }
}
template <int DIR>
__device__ __forceinline__ float gla_b_col(const Params& p, int l, int h, const bf16x8 (&af)[4], int nt, int lane_, float (&x)[4][4]) {
    const int lane = olane(lane_), r = lane & 15, q4 = lane >> 4, d = h * 64 + 16 * nt + r;
    u32x4 o = {0u, 0u, 0u, 0u};
    if (q4 < 2) { const float* wa = p.in[I_GWA] + ((size_t)(l * 2 + DIR) * 16 + 8 * q4) * WG + d;
        o.x = pk2(wa[0], wa[WG]); o.y = pk2(wa[2 * WG], wa[3 * WG]); o.z = pk2(wa[4 * WG], wa[5 * WG]); o.w = pk2(wa[6 * WG], wa[7 * WG]); }
    const bf16x8 bfr = as_frag(o); const float bias = p.in[I_GBA][(size_t)(l * 2 + DIR) * WG + d];
#pragma unroll
    for (int mt = 0; mt < 4; ++mt) { f32x4 c = {bias, bias, bias, bias}; c = MFMA16(af[mt], bfr, c);
#pragma unroll
        for (int i = 0; i < 4; ++i) x[mt][i] = logsig_fast(c[i]) * (1.0f / 16.0f); }
    float carry = 0.f;
#pragma unroll
    for (int k = 0; k < 4; ++k) { const int mt = DIR == 0 ? k : 3 - k; float* y = x[mt];
        if (DIR == 0) { y[1] += y[0]; y[2] += y[1]; y[3] += y[2]; } else { y[2] += y[3]; y[1] += y[2]; y[0] += y[1]; }
        const float s4 = DIR == 0 ? y[3] : y[0];
        const float t1 = DIR == 0 ? __shfl_up(s4, 16) : __shfl_down(s4, 16), t2 = DIR == 0 ? __shfl_up(s4, 32) : __shfl_down(s4, 32), t3 = DIR == 0 ? __shfl_up(s4, 48) : __shfl_down(s4, 48);
        const int qq = DIR == 0 ? q4 : 3 - q4;
        const float e = (qq >= 1 ? t1 : 0.f) + (qq >= 2 ? t2 : 0.f) + (qq >= 3 ? t3 : 0.f);
        const float tot = __shfl(e + s4, DIR == 0 ? r + 48 : r);
#pragma unroll
        for (int i = 0; i < 4; ++i) y[i] += carry + e;
        carry += tot; }
    return carry;
}

template <int MIXER, int DIR>
__device__ __forceinline__ void chunkst_dir(const Params& p, int l, int b, int h, int cid, const float* Grow0, const unsigned (&kk)[32], const bf16* Vt, bf16* Kt, const float* wvs, float* bendl, int lane_) {
    const int lane = olane(lane_), r = lane & 15, q4 = lane >> 4;
    if constexpr (MIXER == 0) {
        float nacc = 0.f;
#pragma unroll
        for (int c = 0; c < 8; ++c) { float f[8];
#pragma unroll
            for (int j = 0; j < 8; ++j) { const int s = 8 * c + j; const float kv = (s & 1) ? bitsf(kk[s >> 1] & 0xffff0000u) : bitsf(kk[s >> 1] << 16);
                f[j] = kv * 0.125f * wvs[DIR * 64 + s]; nacc += f[j]; }
            *(u32x4*)(Kt + swz(lane, c)) = pack8(f); }
        ((float*)(p.ws + WS_NV))[ch_index(DIR, b, h, cid) * 64 + lane] = nacc;
    } else {
        const bf16* P = (const bf16*)(p.ws + WS_P); const int kcol = PG + 256 + h * 64; const int r0 = b * TOK + cid * 64;
        bf16x8 af[4]; gla_r_frags<DIR>(Grow0, lane, af);
#pragma unroll 2
        for (int nt = 0; nt < 4; ++nt) { const int d = 16 * nt + r; float x[4][4];
            const float bend = gla_b_col<DIR>(p, l, h, af, nt, lane, x);
            if (q4 == 0) { ((float*)(p.ws + WS_BE))[ch_index(DIR, b, h, cid) * 64 + d] = bend; bendl[d] = __expf(fmaxf(bend, -80.0f)); }
#pragma unroll
            for (int mt = 0; mt < 4; ++mt)
#pragma unroll
                for (int i = 0; i < 4; ++i) { const int s = 16 * mt + 4 * q4 + i; const float kv = bf2f(P[(size_t)(r0 + s) * NP + kcol + d]); const float bc = fmaxf(x[mt][i], -80.0f);
                    Kt[swz(d, s >> 3) + (s & 7)] = f2bf(kv * __expf(-bc));
                    ((bf16*)(p.ws + WS_EQ))[((size_t)DIR * T + r0 + s) * WG + h * 64 + d] = f2bf(__expf(bc)); } }
    }
    WAVE_SYNC();
    bf16x8 vf[4][2];
#pragma unroll
    for (int ne = 0; ne < 4; ++ne)
#pragma unroll
        for (int ks = 0; ks < 2; ++ks) vf[ne][ks] = *(const bf16x8*)(Vt + swz(16 * ne + r, ks * 4 + q4));
    bf16* dst = (bf16*)(p.ws + WS_ST) + st_index(MIXER, DIR, b, h, cid) * 4096;
#pragma unroll
    for (int me = 0; me < 4; ++me) {
        f32x4 acc[4] = {(f32x4){0.f, 0.f, 0.f, 0.f}, (f32x4){0.f, 0.f, 0.f, 0.f}, (f32x4){0.f, 0.f, 0.f, 0.f}, (f32x4){0.f, 0.f, 0.f, 0.f}};
#pragma unroll
        for (int ks = 0; ks < 2; ++ks) { const bf16x8 a = *(const bf16x8*)(Kt + swz(16 * me + r, ks * 4 + q4));
#pragma unroll
            for (int ne = 0; ne < 4; ++ne) acc[ne] = MFMA16(a, vf[ne][ks], acc[ne]); }
        f32x4 sc4 = {1.f, 1.f, 1.f, 1.f}; if constexpr (MIXER == 1) sc4 = *(const f32x4*)(bendl + 16 * me + 4 * q4);
#pragma unroll
        for (int ne = 0; ne < 4; ++ne) { const f32x4 v = acc[ne] * sc4; u32x2 o; o.x = pk2(v[0], v[1]); o.y = pk2(v[2], v[3]); *(u32x2*)(dst + (16 * ne + r) * 64 + 16 * me + 4 * q4) = o; }
    }
    WAVE_SYNC();
}
template <int MIXER>
__device__ __forceinline__ void chunkst_w(const Params& p, int l, int b, int h, int cid, char* wl, int lane) {
    const bf16* P = (const bf16*)(p.ws + WS_P); const float* G = (const float*)(p.ws + WS_G);
    const int r0 = b * TOK + cid * 64, r = lane & 15, q4 = lane >> 4;
    bf16* Kt = (bf16*)wl;
    bf16* Vt = Kt + 4096;
    float* wvs = (float*)(Vt + 4096);
    float* bendl = wvs + 128;
    const int kcol = (MIXER == 0 ? PA : PG) + 256 + h * 64, vcol = (MIXER == 0 ? PA : PG) + 512 + h * 64;
    const float* Grow0 = G + (size_t)r0 * NGS;
    { bf16* Nn = Kt;
        load_nat_tile(P, r0, vcol, Nn, lane);
        WAVE_SYNC();
#pragma unroll
        for (int c = 0; c < 8; ++c) { unsigned w[4];
#pragma unroll
            for (int j = 0; j < 4; ++j) w[j] = (unsigned)Nn[swz(8 * c + 2 * j, lane >> 3) + (lane & 7)] | ((unsigned)Nn[swz(8 * c + 2 * j + 1, lane >> 3) + (lane & 7)] << 16);
            u32x4 o; o.x = w[0]; o.y = w[1]; o.z = w[2]; o.w = w[3]; *(u32x4*)(Vt + swz(lane, c)) = o; }
        WAVE_SYNC();
        load_nat_tile(P, r0, kcol, Nn, lane);
        WAVE_SYNC(); }
    unsigned kk[32];
    { const bf16* Nn = Kt;
#pragma unroll
        for (int i = 0; i < 32; ++i) kk[i] = (unsigned)Nn[swz(2 * i, lane >> 3) + (lane & 7)] | ((unsigned)Nn[swz(2 * i + 1, lane >> 3) + (lane & 7)] << 16); }
    WAVE_SYNC();
    if constexpr (MIXER == 0) {
        const float* g = Grow0 + (size_t)lane * NGS; const float* gb = p.in[I_MGB] + (size_t)l * 16;
        const float i_f = g[h] + gb[h], f_f = g[4 + h] + gb[4 + h], i_b = g[8 + h] + gb[8 + h], f_b = g[12 + h] + gb[12 + h];
        const float lf = logsigf_(f_f), lb = logsigf_(f_b);
        const float bF = wave_prefix_sum(lf, lane), totF = __shfl(bF, 63);
        const float gF = totF - bF + i_f, mF = wave_max(gF);
        const float totB = wave_sum(lb), preB = wave_prefix_sum(lb, lane), bB = totB - preB + lb;
        const float gB = totB - bB + i_b, mB = wave_max(gB);
        wvs[lane] = __expf(gF - mF); wvs[64 + lane] = __expf(gB - mB);
        if (lane == 0) { float* SC = (float*)(p.ws + WS_SC);
            SC[ch_index(0, b, h, cid) * 4 + 0] = totF; SC[ch_index(0, b, h, cid) * 4 + 1] = mF;
            SC[ch_index(1, b, h, cid) * 4 + 0] = totB; SC[ch_index(1, b, h, cid) * 4 + 1] = mB; }
    }
    WAVE_SYNC();
    chunkst_dir<MIXER, 0>(p, l, b, h, cid, Grow0, kk, Vt, Kt, wvs, bendl, lane);
    chunkst_dir<MIXER, 1>(p, l, b, h, cid, Grow0, kk, Vt, Kt, wvs, bendl, lane);
}

template <int DIR>
__device__ __forceinline__ void chunkst_gla(const Params& p, int l, int b, int h, int cid, char* wl, int lane_) {
    const bf16* P = (const bf16*)(p.ws + WS_P);
    const int lane = olane(lane_), r0 = b * TOK + cid * 64, r = lane & 15, q4 = lane >> 4;
    bf16* Kt = (bf16*)wl;
    bf16* An = Kt + 4096;
    float* bendl = (float*)(An + 4096);
    const int kcol = PG + 256 + h * 64, vcol = PG + 512 + h * 64;
    const float* Grow0 = (const float*)(p.ws + WS_G) + (size_t)r0 * NGS;
    load_nat_tile(P, r0, vcol, An, lane);
    WAVE_SYNC();
    bf16x8 vf[4][2];
#pragma unroll
    for (int ne = 0; ne < 4; ++ne)
#pragma unroll
        for (int ks = 0; ks < 2; ++ks) vf[ne][ks] = frag_tr(An, 16 * ne, 32 * ks, lane);
    WAVE_SYNC();
    load_nat_tile(P, r0, kcol, An, lane);
    WAVE_SYNC();
    bf16x8 af[4]; gla_r_frags<DIR>(Grow0, lane, af);
#pragma unroll 2
    for (int nt = 0; nt < 4; ++nt) { const int d = 16 * nt + r; float x[4][4];
        const float bend = gla_b_col<DIR>(p, l, h, af, nt, lane, x);
        if (q4 == 0) { ((float*)(p.ws + WS_BE))[ch_index(DIR, b, h, cid) * 64 + d] = bend; bendl[d] = __expf(fmaxf(bend, -80.0f)); }
#pragma unroll
        for (int mt = 0; mt < 4; ++mt)
#pragma unroll
            for (int i = 0; i < 4; ++i) { const int s = 16 * mt + 4 * q4 + i; bf16* ke = An + swz(s, d >> 3) + (d & 7); const float kv = bf2f(*ke); const float bc = fmaxf(x[mt][i], -80.0f);
                Kt[swz(d, s >> 3) + (s & 7)] = f2bf(kv * __expf(-bc));
                *ke = f2bf(__expf(bc)); } }
    WAVE_SYNC();
    { bf16* EQg = (bf16*)(p.ws + WS_EQ) + ((size_t)DIR * T + r0) * WG + h * 64;
#pragma unroll
        for (int i = 0; i < 8; ++i) { const int s = (lane >> 3) + 8 * i, ck = lane & 7; *(u32x4*)(EQg + (size_t)s * WG + ck * 8) = *(const u32x4*)(An + swz(s, ck)); } }
    bf16* dst = (bf16*)(p.ws + WS_ST) + st_index(1, DIR, b, h, cid) * 4096;
#pragma unroll
    for (int me = 0; me < 4; ++me) {
        f32x4 acc[4] = {(f32x4){0.f, 0.f, 0.f, 0.f}, (f32x4){0.f, 0.f, 0.f, 0.f}, (f32x4){0.f, 0.f, 0.f, 0.f}, (f32x4){0.f, 0.f, 0.f, 0.f}};
#pragma unroll
        for (int ks = 0; ks < 2; ++ks) { const bf16x8 a = *(const bf16x8*)(Kt + swz(16 * me + r, ks * 4 + q4));
#pragma unroll
            for (int ne = 0; ne < 4; ++ne) acc[ne] = MFMA16(a, vf[ne][ks], acc[ne]); }
        const f32x4 sc4 = *(const f32x4*)(bendl + 16 * me + 4 * q4);
#pragma unroll
        for (int ne = 0; ne < 4; ++ne) { const f32x4 v = acc[ne] * sc4; u32x2 o; o.x = pk2(v[0], v[1]); o.y = pk2(v[2], v[3]); *(u32x2*)(dst + (16 * ne + r) * 64 + 16 * me + 4 * q4) = o; }
    }
    WAVE_SYNC();
}

template <int MIXER, int DIR>
__device__ __forceinline__ void chunkout_prep(const Params& p, int l, int b, int h, int cid, const float* Grow0, int r0, int pbase, const bf16* EQ, float* gar, int lane_) {
    const int lane = olane(lane_);
    if constexpr (MIXER == 0) {
        const bf16* P = (const bf16*)(p.ws + WS_P);
        const float* g = Grow0 + (size_t)lane * NGS; const float* gb = p.in[I_MGB] + (size_t)l * 16;
        const float ig = g[DIR * 8 + h] + gb[DIR * 8 + h], fg = g[DIR * 8 + 4 + h] + gb[DIR * 8 + 4 + h];
        const float mprev = ((const float*)(p.ws + WS_SC))[ch_index(DIR, b, h, cid) * 4 + 2];
        const float lf = logsigf_(fg); float bb;
        if (DIR == 0) bb = wave_prefix_sum(lf, lane); else { const float tt = wave_sum(lf), pre = wave_prefix_sum(lf, lane); bb = tt - pre + lf; }
        const float a = ig - bb; const float pm = DIR == 0 ? wave_prefix_max(a, lane) : wave_suffix_max(a, lane);
        const float mt_ = fmaxf(bb + mprev, bb + pm);
        float* ga = gar + DIR * 320;
        ga[lane] = bb - mt_; ga[64 + lane] = a; ga[128 + lane] = __expf(bb + mprev - mt_); ga[192 + lane] = __expf(-mt_);
        float* nvl = gar + 640 + DIR * 64;
        nvl[lane] = ((const float*)(p.ws + WS_NV))[ch_index(DIR, b, h, cid) * 64 + lane];
        WAVE_SYNC();
        float dq = 0.f;
#pragma unroll
        for (int c = 0; c < 8; ++c) { float f[8]; unpack8(*(const u32x4*)(P + (size_t)(r0 + lane) * NP + pbase + c * 8), f);
            const f32x4 n0 = *(const f32x4*)(nvl + c * 8), n1 = *(const f32x4*)(nvl + c * 8 + 4);
            dq += f[0] * n0.x + f[1] * n0.y + f[2] * n0.z + f[3] * n0.w + f[4] * n1.x + f[5] * n1.y + f[6] * n1.z + f[7] * n1.w; }
        ga[256 + lane] = dq;
    }
}
template <int MIXER, int DIR, int NS>
__device__ __forceinline__ void chunkout_dir(const Params& p, int b, int h, int cid, int r0, int pbase, int th, const bf16x8 (&vtf)[4][2], const bf16* VtL, const bf16* EQ, bf16* SB, const float* gar, float* rsm, f32x4 (&htot)[NS][4], int lane_) {
    const bf16* P = (const bf16*)(p.ws + WS_P); const bf16* ST = (const bf16*)(p.ws + WS_ST);
    const int lane = olane(lane_), r = lane & 15, q4 = lane >> 4;
    const bf16* E = EQ + ((size_t)DIR * T + r0) * WG + h * 64;
    const float* ga = gar + DIR * 320;
    bf16x8 kf[4][2], ctf[4][2];
#pragma unroll
    for (int n = 0; n < 4; ++n)
#pragma unroll
        for (int ks = 0; ks < 2; ++ks) { kf[n][ks] = *(const bf16x8*)(P + (size_t)(r0 + 16 * n + r) * NP + pbase + 256 + ks * 32 + q4 * 8);
            ctf[n][ks] = *(const bf16x8*)(ST + st_index(MIXER, DIR, b, h, cid) * 4096 + (16 * n + r) * 64 + ks * 32 + q4 * 8);
            if constexpr (MIXER == 1) { float fe[8], fk[8]; unpack8(*(const u32x4*)(E + (size_t)(16 * n + r) * WG + ks * 32 + q4 * 8), fe); unpack8(as_u4(kf[n][ks]), fk);
#pragma unroll
                for (int j = 0; j < 8; ++j) fk[j] = fk[j] * frcp_(fe[j]);
                kf[n][ks] = as_frag(pack8(fk)); } }
#pragma unroll
    for (int ms = 0; ms < NS; ++ms) { const int mt = NS * th + ms;
        bf16x8 qf[2];
#pragma unroll
        for (int ks = 0; ks < 2; ++ks) { qf[ks] = *(const bf16x8*)(P + (size_t)(r0 + 16 * mt + r) * NP + pbase + ks * 32 + q4 * 8);
            if constexpr (MIXER == 1) { float fe[8], fq[8]; unpack8(*(const u32x4*)(E + (size_t)(16 * mt + r) * WG + ks * 32 + q4 * 8), fe); unpack8(as_u4(qf[ks]), fq);
#pragma unroll
                for (int j = 0; j < 8; ++j) fq[j] *= 0.125f * fe[j];
                qf[ks] = as_frag(pack8(fq)); } }
        f32x4 S[4] = {(f32x4){0.f, 0.f, 0.f, 0.f}, (f32x4){0.f, 0.f, 0.f, 0.f}, (f32x4){0.f, 0.f, 0.f, 0.f}, (f32x4){0.f, 0.f, 0.f, 0.f}};
#pragma unroll
        for (int ks = 0; ks < 2; ++ks)
#pragma unroll
            for (int n = 0; n < 4; ++n) S[n] = MFMA16(qf[ks], kf[n][ks], S[n]);
#pragma unroll
        for (int i = 0; i < 4; ++i) { const int t = 16 * mt + 4 * q4 + i; float sm = 0.f;
#pragma unroll
            for (int n = 0; n < 4; ++n) { const int s = 16 * n + r; const bool ok = DIR == 0 ? (s <= t) : (s >= t); float v = 0.f;
                if (ok) { if constexpr (MIXER == 0) v = S[n][i] * 0.125f * __expf(ga[t] + ga[64 + s]); else v = S[n][i]; }
                SB[swz(4 * q4 + i, s >> 3) + (s & 7)] = f2bf(v); sm += v; }
            if constexpr (MIXER == 0) { sm += __shfl_xor(sm, 1); sm += __shfl_xor(sm, 2); sm += __shfl_xor(sm, 4); sm += __shfl_xor(sm, 8); if (r == 0) rsm[4 * q4 + i] = sm; } }
        WAVE_SYNC();
        const bf16x8 sm0 = *(const bf16x8*)(SB + swz(r, q4)), sm1 = *(const bf16x8*)(SB + swz(r, 4 + q4));
        float wi = 1.f, inv = 1.f;
        if constexpr (MIXER == 0) { const int tt = 16 * mt + r; wi = ga[128 + tt]; const float den = wi * ga[256 + tt] + rsm[r]; inv = 1.0f / fmaxf(fabsf(den), ga[192 + tt]); }
#pragma unroll
        for (int me = 0; me < 4; ++me) { f32x4 a1 = {0.f, 0.f, 0.f, 0.f}, a2 = {0.f, 0.f, 0.f, 0.f};
            a1 = MFMA16(*(const bf16x8*)(VtL + swz(16 * me + r, q4)), sm0, a1); a1 = MFMA16(*(const bf16x8*)(VtL + swz(16 * me + r, 4 + q4)), sm1, a1);
            a2 = MFMA16(ctf[me][0], qf[0], a2); a2 = MFMA16(ctf[me][1], qf[1], a2);
            if constexpr (MIXER == 0) htot[ms][me] += (a1 + a2 * wi) * inv; else htot[ms][me] += a1 + a2; }
        WAVE_SYNC();
    }
}
template <int MIXER>
__device__ __forceinline__ void chunkout_w(const Params& p, int l, int b, int h, int cid, char* wl, int lane) {
    const bf16* P = (const bf16*)(p.ws + WS_P); const float* G = (const float*)(p.ws + WS_G); bf16* Y = (bf16*)(p.ws + WS_HNY);
    const int r0 = b * TOK + cid * 64, r = lane & 15, q4 = lane >> 4;
    const int pbase = (MIXER == 0 ? PA : PG) + h * 64;
    bf16* SB = (bf16*)wl;
    float* rsm = (float*)(SB + 1024);
    float* gar = rsm + 16;
    const bf16* EQ = (const bf16*)(p.ws + WS_EQ);
    const float* Grow0 = G + (size_t)r0 * NGS;
    bf16* VtL = (bf16*)(gar + 768);
    bf16x8 vtf[4][2];
#pragma unroll
    for (int me = 0; me < 4; ++me) { vtf[me][0] = (bf16x8){0, 0, 0, 0, 0, 0, 0, 0}; vtf[me][1] = vtf[me][0]; }
    { bf16* Nn = VtL + 4096;
#pragma unroll
        for (int hh = 0; hh < 2; ++hh) {
            u32x4 v[4];
#pragma unroll
            for (int i = 0; i < 4; ++i) v[i] = *(const u32x4*)(P + (size_t)(r0 + 32 * hh + (lane >> 3) + 8 * i) * NP + pbase + 512 + (lane & 7) * 8);
#pragma unroll
            for (int i = 0; i < 4; ++i) *(u32x4*)(Nn + swz((lane >> 3) + 8 * i, lane & 7)) = v[i];
            WAVE_SYNC();
#pragma unroll
            for (int c = 0; c < 4; ++c) { unsigned w[4];
#pragma unroll
                for (int j = 0; j < 4; ++j) w[j] = (unsigned)Nn[swz(8 * c + 2 * j, lane >> 3) + (lane & 7)] | ((unsigned)Nn[swz(8 * c + 2 * j + 1, lane >> 3) + (lane & 7)] << 16);
                u32x4 o; o.x = w[0]; o.y = w[1]; o.z = w[2]; o.w = w[3]; *(u32x4*)(VtL + swz(lane, 4 * hh + c)) = o; }
            WAVE_SYNC(); } }
    chunkout_prep<MIXER, 0>(p, l, b, h, cid, Grow0, r0, pbase, EQ, gar, lane);
    chunkout_prep<MIXER, 1>(p, l, b, h, cid, Grow0, r0, pbase, EQ, gar, lane);
    WAVE_SYNC();
    const float* ngp = p.in[MIXER == 0 ? I_MNG : I_GNG] + (size_t)l * WG + h * 64;
    constexpr int NS = MIXER == 1 ? 2 : 1;
#pragma unroll 1
    for (int th = 0; th < 4 / NS; ++th) {
        f32x4 htot[NS][4];
#pragma unroll
        for (int a = 0; a < NS; ++a)
#pragma unroll
            for (int c = 0; c < 4; ++c) htot[a][c] = (f32x4){0.f, 0.f, 0.f, 0.f};
        chunkout_dir<MIXER, 0, NS>(p, b, h, cid, r0, pbase, th, vtf, VtL, EQ, SB, gar, rsm, htot, lane);
        chunkout_dir<MIXER, 1, NS>(p, b, h, cid, r0, pbase, th, vtf, VtL, EQ, SB, gar, rsm, htot, lane);
        const int lz = olane(lane), r = lz & 15, q4 = lz >> 4;
        u32x2 gq[NS][4], oq[NS][4];
#pragma unroll
        for (int ms = 0; ms < NS; ++ms)
#pragma unroll
            for (int me = 0; me < 4; ++me) { const size_t off = (size_t)(r0 + 16 * (NS * th + ms) + r) * NP + pbase + 16 * me + 4 * q4;
                gq[ms][me] = *(const u32x2*)(P + off + (MIXER == 0 ? 1024 : 768)); if constexpr (MIXER == 0) oq[ms][me] = *(const u32x2*)(P + off + 768); else oq[ms][me] = (u32x2){0u, 0u}; }
#pragma unroll
        for (int ms = 0; ms < NS; ++ms) { const int mt = NS * th + ms; float ss = 0.f; float gv[4][4];
#pragma unroll
            for (int me = 0; me < 4; ++me) {
                gv[me][0] = bitsf(gq[ms][me].x << 16); gv[me][1] = bitsf(gq[ms][me].x & 0xffff0000u); gv[me][2] = bitsf(gq[ms][me].y << 16); gv[me][3] = bitsf(gq[ms][me].y & 0xffff0000u);
                if constexpr (MIXER == 0) { htot[ms][me][0] *= sigmoidf_(bitsf(oq[ms][me].x << 16)); htot[ms][me][1] *= sigmoidf_(bitsf(oq[ms][me].x & 0xffff0000u)); htot[ms][me][2] *= sigmoidf_(bitsf(oq[ms][me].y << 16)); htot[ms][me][3] *= sigmoidf_(bitsf(oq[ms][me].y & 0xffff0000u)); }
                ss += htot[ms][me][0] * htot[ms][me][0] + htot[ms][me][1] * htot[ms][me][1] + htot[ms][me][2] * htot[ms][me][2] + htot[ms][me][3] * htot[ms][me][3]; }
            ss += __shfl_xor(ss, 16); ss += __shfl_xor(ss, 32);
            const float rstd = rsqrtf(ss * (1.0f / 64.0f) + EPS);
#pragma unroll
            for (int me = 0; me < 4; ++me) { const int e = 16 * me + 4 * q4; const f32x4 n4 = *(const f32x4*)(ngp + e);
                u32x2 o; o.x = pk2(htot[ms][me][0] * rstd * n4.x * siluf_(gv[me][0]), htot[ms][me][1] * rstd * n4.y * siluf_(gv[me][1]));
                o.y = pk2(htot[ms][me][2] * rstd * n4.z * siluf_(gv[me][2]), htot[ms][me][3] * rstd * n4.w * siluf_(gv[me][3]));
                *(u32x2*)(Y + (size_t)(r0 + 16 * mt + r) * 1024 + (MIXER == 0 ? YA : YG) + h * 64 + e) = o; } }
    }
}

template <bool OUT>
__device__ __forceinline__ void chunk_workers(const Params& p, int l, char* smem) {
    const int tid = otid(), lane = tid & 63, wave = __builtin_amdgcn_readfirstlane(tid >> 6);
    const int NW = (int)gridDim.x * 8, wi = wave * (int)gridDim.x + obid();
    const int c_lo = (OUT && l == DEPTH - 1) ? NCC : 0, npc = NCH - c_lo, half = NB * NH * npc;
    char* wl = smem + wave * WLDS;
    if (OUT) {
#pragma unroll 1
        for (int t = wi; t < half; t += NW) { const int b = t / (NH * npc), h = (t / npc) % NH, cid = c_lo + t % npc;
            const Params q = relaunder(p); chunkout_w<1>(q, l, b, h, cid, wl, lane); }
        const int used = half % NW, vj = wi >= used ? wi - used : wi + (NW - used);
#pragma unroll 1
        for (int t = vj; t < half; t += NW) { const int b = t / (NH * npc), h = (t / npc) % NH, cid = c_lo + t % npc;
            const Params q = relaunder(p); chunkout_w<0>(q, l, b, h, cid, wl, lane); }
    } else {
        int off = 0;
#pragma unroll 1
        for (int t = wi; t < half; t += NW) { const int b = t / (NH * npc), h = (t / npc) % NH, cid = c_lo + t % npc;
            const Params q = relaunder(p); chunkst_gla<0>(q, l, b, h, cid, wl, lane); }
        off = (off + half) % NW;
#pragma unroll 1
        for (int t = (wi + NW - off) % NW; t < half; t += NW) { const int b = t / (NH * npc), h = (t / npc) % NH, cid = c_lo + t % npc;
            const Params q = relaunder(p); chunkst_gla<1>(q, l, b, h, cid, wl, lane); }
        off = (off + half) % NW;
#pragma unroll 1
        for (int t = (wi + NW - off) % NW; t < half; t += NW) { const int b = t / (NH * npc), h = (t / npc) % NH, cid = c_lo + t % npc;
            const Params q = relaunder(p); chunkst_w<0>(q, l, b, h, cid, wl, lane); }
    }
}

__device__ __forceinline__ void phase_mix1(const Params& p, int l, char* smem) {
    const bool ctxo = l < DEPTH - 1;
    constexpr int N_HL = (NB / 2) * (WG / 2), N_AL = NB * 2 * (SEQ / 64), N_HC = NB * (WG / HCB), N_AC = NB * 2 * NCC;
    const int total = N_HL + N_AL + (ctxo ? N_HC + N_AC : 0);
    for (int task = obid(); task < total; task += gridDim.x) {
        int t = task;
        if (t < N_HL) { hylat_task(p, l, t / (WG / 2), t % (WG / 2), smem); continue; } t -= N_HL;
        if (t < N_AL) { attn_task(p, l, t / (2 * (SEQ / 64)), (t / (SEQ / 64)) % 2, t % (SEQ / 64), false, smem); continue; } t -= N_AL;
        if (t < N_HC) { hyctx_task(p, l, t / (WG / HCB), t % (WG / HCB), smem); continue; } t -= N_HC;
        attn_task(p, l, t / (2 * NCC), (t / NCC) % 2, t % NCC, true, smem);
    }
    __syncthreads();
    chunk_workers<false>(p, l, smem);
}

constexpr int SCG = 12;
__device__ __forceinline__ void phase_scan(const Params& p, int l, char* smem) {
    const int tid = otid();
    bf16* ST = (bf16*)(p.ws + WS_ST); float* NV = (float*)(p.ws + WS_NV); const float* BE = (const float*)(p.ws + WS_BE); float* SC = (float*)(p.ws + WS_SC);
    constexpr int NCHAIN = 2 * 2 * NB * NH;
    for (int item = obid() * NT + tid; item < NCHAIN * 1024; item += gridDim.x * NT) {
        const int chain = item >> 10, grp = item & 1023; const int mixer = chain / (2 * NB * NH), dir = (chain / (NB * NH)) % 2, b = (chain / NH) % NB, h = chain % NH;
        float c[4] = {0.f, 0.f, 0.f, 0.f}; float nv[4] = {0.f, 0.f, 0.f, 0.f}; float m = 0.f;
        const int d0 = (grp & 15) * 4; const bool donv = (mixer == 0) && (grp < 16);
        for (int o0 = 0; o0 < NCH; o0 += SCG) {
            u32x2 uu[SCG]; float s0[SCG], s1[SCG]; f32x4 be[SCG]; f32x4 nu[SCG];
#pragma unroll
            for (int j = 0; j < SCG; ++j) if (o0 + j < NCH) { const int cid = chain_cid(dir, o0 + j); const size_t ci = ch_index(dir, b, h, cid);
                uu[j] = *(const u32x2*)(ST + st_index(mixer, dir, b, h, cid) * 4096 + grp * 4);
                if (mixer == 0) { s0[j] = SC[ci * 4 + 0]; s1[j] = SC[ci * 4 + 1]; if (donv) nu[j] = *(const f32x4*)(NV + ci * 64 + grp * 4); }
                else be[j] = *(const f32x4*)(BE + ci * 64 + d0); }
#pragma unroll
            for (int j = 0; j < SCG; ++j) if (o0 + j < NCH) { const int cid = chain_cid(dir, o0 + j); const size_t ci = ch_index(dir, b, h, cid);
                const float u[4] = {bitsf(uu[j].x << 16), bitsf(uu[j].x & 0xffff0000u), bitsf(uu[j].y << 16), bitsf(uu[j].y & 0xffff0000u)};
                u32x2 w; w.x = pk2(c[0], c[1]); w.y = pk2(c[2], c[3]); *(u32x2*)(ST + st_index(mixer, dir, b, h, cid) * 4096 + grp * 4) = w;
                if (mixer == 0) {
                    if (grp == 0) SC[ci * 4 + 2] = m;
                    const float mn = fmaxf(s0[j] + m, s1[j]), a = __expf(s0[j] + m - mn), s = __expf(s1[j] - mn);
#pragma unroll
                    for (int k = 0; k < 4; ++k) c[k] = a * c[k] + s * u[k];
                    if (donv) { f32x4 nw = {nv[0], nv[1], nv[2], nv[3]}; *(f32x4*)(NV + ci * 64 + grp * 4) = nw;
                        nv[0] = a * nv[0] + s * nu[j].x; nv[1] = a * nv[1] + s * nu[j].y; nv[2] = a * nv[2] + s * nu[j].z; nv[3] = a * nv[3] + s * nu[j].w; }
                    m = mn;
                } else { c[0] = __expf(be[j].x) * c[0] + u[0]; c[1] = __expf(be[j].y) * c[1] + u[1]; c[2] = __expf(be[j].z) * c[2] + u[2]; c[3] = __expf(be[j].w) * c[3] + u[3]; } }
        }
    }
    constexpr int N_WOUT = (DM / 64) * (MIX / 64);
    for (int task = obid(); task < N_WOUT; task += gridDim.x) { const int nt = task / (MIX / 64), kt = task % (MIX / 64);
        convert_tile(p.in[I_WOUT] + (size_t)l * MIX * DM, DM, (bf16*)(p.ws + WS_WOUT), MIX, nt * 64, kt * 64, false, smem); }
    __syncthreads();
    { const int lane = tid & 63, wave = __builtin_amdgcn_readfirstlane(tid >> 6); const int NW = (int)gridDim.x * 8, wi = wave * (int)gridDim.x + obid();
        bf16* tile = (bf16*)(smem + wave * WLDS); const bf16* HT = (const bf16*)(p.ws + WS_HT); bf16* Y = (bf16*)(p.ws + WS_HNY);
        constexpr int NTT = NB * (SEQ / 64) * 4;
        for (int t = wi; t < NTT; t += NW) { const int b = t / ((SEQ / 64) * 4), tt = (t / 4) % (SEQ / 64), c0 = (t % 4) * 64; const size_t tok0 = (size_t)b * TOK + CTXL + tt * 64;
#pragma unroll
            for (int i = 0; i < 8; ++i) { const int ch = (lane >> 3) + 8 * i, ck = lane & 7; *(u32x4*)(tile + swz(ch, ck)) = *(const u32x4*)(HT + (size_t)(768 + c0 + ch) * T + tok0 + ck * 8); }
            WAVE_SYNC();
#pragma unroll
            for (int i = 0; i < 8; ++i) { const int tk = (lane >> 3) + 8 * i, cc = lane & 7; unsigned w[4];
#pragma unroll
                for (int j = 0; j < 4; ++j) { const int ca = cc * 8 + 2 * j; w[j] = (unsigned)tile[swz(ca, tk >> 3) + (tk & 7)] | ((unsigned)tile[swz(ca + 1, tk >> 3) + (tk & 7)] << 16); }
                u32x4 o; o.x = w[0]; o.y = w[1]; o.z = w[2]; o.w = w[3]; *(u32x4*)(Y + (tok0 + tk) * 1024 + YH + c0 + cc * 8) = o; }
            WAVE_SYNC(); } }
}

__device__ __forceinline__ void phase_mix2(const Params& p, int l, char* smem) { chunk_workers<true>(p, l, smem); }

#ifndef EMU
#define LAS __attribute__((address_space(3)))
#define XB_TMO      128
#define XB_XCNT(j)  (256  + 64 * (j))
#define XB_XSUB(j)  (1280 + 64 * (j))
#define XB_XGEN(j)  (2304 + 64 * (j))
#define XB_TOP      3328
#define XB_TOPGEN   3392
#define XCD_BAR_WORDS 3456
#define XB_SPIN_CAP (1u << 18)

__device__ __forceinline__ unsigned xb_ld(unsigned* p)              { return __hip_atomic_load(p, __ATOMIC_RELAXED, __HIP_MEMORY_SCOPE_AGENT); }
__device__ __forceinline__ unsigned xb_add(unsigned* p, unsigned v) { return __hip_atomic_fetch_add(p, v, __ATOMIC_RELAXED, __HIP_MEMORY_SCOPE_AGENT); }
__device__ __forceinline__ unsigned xb_xcc_id() { return (unsigned)__builtin_amdgcn_s_getreg((3 << 11) | 20) & 0xFu; }
#define XB_SPIN(cond, bar) do { unsigned _sp = 0; while (cond) { __builtin_amdgcn_s_sleep(1); \
    if ((++_sp & 255u) == 0u) { if (xb_ld(&(bar)[XB_TMO])) break; if (_sp > XB_SPIN_CAP) { atomicAdd(&(bar)[XB_TMO], 1u); break; } } } } while (0)

struct XcdBarrier {
    unsigned* bar; unsigned x;
    volatile LAS unsigned* st;
};

__device__ __forceinline__ XcdBarrier xcd_barrier_post(unsigned* bar, volatile LAS unsigned* st) {
    XcdBarrier b; b.bar = bar; b.x = xb_xcc_id(); b.st = st;
    if (threadIdx.x == 0) (void)xb_add(&bar[XB_XCNT(b.x)], 1u);
    return b;
}
__device__ __forceinline__ void xcd_barrier_complete(unsigned* bar, unsigned x, unsigned& nloc, unsigned& nx) {
    const unsigned G = gridDim.x * gridDim.y * gridDim.z;
    unsigned sum, cnt, mine, sp = 0u;
    for (;;) {
        sum = 0u; cnt = 0u; mine = 0u;
#pragma unroll
        for (unsigned j = 0; j < 16; ++j) { const unsigned c = xb_ld(&bar[XB_XCNT(j)]); sum += c; cnt += (c > 0u) ? 1u : 0u; mine = (j == x) ? c : mine; }
        if (sum == G) break;
        __builtin_amdgcn_s_sleep(1);
        if ((++sp & 255u) == 0u) { if (xb_ld(&bar[XB_TMO])) break; if (sp > XB_SPIN_CAP) { atomicAdd(&bar[XB_TMO], 1u); break; } }
    }
    nloc = mine > 0u ? mine : 1u; nx = cnt > 0u ? cnt : 1u;
}

__device__ __forceinline__ void xcd_barrier(const XcdBarrier& b) {
    asm volatile("s_waitcnt vmcnt(0)" ::: "memory");
    __syncthreads();
    if (threadIdx.x == 0) {
        unsigned* bar = b.bar;
        __builtin_amdgcn_s_waitcnt(0);
        unsigned nloc = b.st[0], nx = b.st[1];
        if (nloc == 0u) { xcd_barrier_complete(bar, b.x, nloc, nx); b.st[0] = nloc; b.st[1] = nx; }
        const unsigned old = xb_add(&bar[XB_XSUB(b.x)], 1u);
        const unsigned gen = old / nloc;
        if (old + 1u == (gen + 1u) * nloc) {
            __builtin_amdgcn_fence(__ATOMIC_RELEASE, "agent");
            asm volatile("s_waitcnt vmcnt(0)" ::: "memory");
            const unsigned og = xb_add(&bar[XB_TOP], 1u);
            const unsigned tg = og / nx;
            if (og + 1u == (tg + 1u) * nx) xb_add(&bar[XB_TOPGEN], 1u);
            else XB_SPIN(xb_ld(&bar[XB_TOPGEN]) == tg, bar);
            __builtin_amdgcn_fence(__ATOMIC_ACQUIRE, "agent");
            xb_add(&bar[XB_XGEN(b.x)], 1u);
            asm volatile("s_waitcnt vmcnt(0)" ::: "memory");
        } else {
            XB_SPIN(xb_ld(&bar[XB_XGEN(b.x)]) == gen, bar);
            __builtin_amdgcn_fence(__ATOMIC_ACQUIRE, "agent");
            asm volatile("s_waitcnt vmcnt(0)" ::: "memory");
        }
    }
    __syncthreads();
}
#endif

__global__ void __launch_bounds__(NT) fwd_kernel(Params pk, int ph_lo, int ph_hi) {
    SMEM_DECL;
#ifndef EMU
    volatile LAS unsigned* misc = (volatile LAS unsigned*)(smem + LDS_BYTES - 64);
    if (threadIdx.x < 2) misc[threadIdx.x] = 0u;
    __syncthreads();
    const XcdBarrier bar = xcd_barrier_post((unsigned*)(pk.ws + WS_BAR), misc);
#endif
    constexpr int NPH = 2 + 6 * DEPTH;
    for (int ph = ph_lo; ph < ph_hi && ph < NPH; ++ph) {
#ifndef EMU
        Params p = pk; { size_t z = 0; asm volatile("" : "+s"(z)); p.ws = pk.ws + z; p.out = pk.out + z;
#pragma unroll
            for (int i = 0; i < 26; ++i) p.in[i] = pk.in[i] + z; }
#else
        const Params& p = pk;
#endif
        if (ph == 0) phase0(p, smem);
        else if (ph == NPH - 1) phase_rp(p, DEPTH, smem);
        else { const int l = (ph - 1) / 6, k = (ph - 1) % 6;
            if (k == 0) phase_rp(p, l, smem);
            else if (k == 1) phase_gemm_in(p, l, smem);
            else if (k == 2) phase_mix1(p, l, smem);
            else if (k == 3) phase_scan(p, l, smem);
            else if (k == 4) phase_mix2(p, l, smem);
            else phase_gemm_out(p, l, smem);
#ifdef PROBE_DUP
            if (k == PROBE_DUP) { GRID_SYNC();
                if (k == 1) phase_gemm_in(p, l, smem); else if (k == 2) phase_mix1(p, l, smem); else if (k == 4) phase_mix2(p, l, smem); else if (k == 5) phase_gemm_out(p, l, smem); }
#endif
        }
        if (ph + 1 < ph_hi) {
#ifdef EMU
            GRID_SYNC();
#else
            if (ph_lo < 0) GRID_SYNC();
            xcd_barrier(bar);
#endif
        }
    }
}

#ifndef EMU
extern "C" void kernel_launch(void* const* d_in, const int* in_sizes, int n_in, void* d_out, int out_size, void* d_ws, size_t ws_size, hipStream_t stream) {
    static int grid = 0;
    if (grid == 0) {
        if (n_in != 26 || ws_size < WS_TOTAL) { fprintf(stderr, "kernel_launch: unexpected n_in %d or ws_size %zu (need %zu)\n", n_in, ws_size, (size_t)WS_TOTAL); grid = -1; return; }
        int dev = 0, cus = 0, per_cu = 0;
        hipGetDevice(&dev);
        hipDeviceGetAttribute(&cus, hipDeviceAttributeMultiprocessorCount, dev);
        hipFuncSetAttribute((const void*)fwd_kernel, hipFuncAttributeMaxDynamicSharedMemorySize, LDS_BYTES);
        hipOccupancyMaxActiveBlocksPerMultiprocessor(&per_cu, (const void*)fwd_kernel, NT, LDS_BYTES);
        if (per_cu < 1) { fprintf(stderr, "kernel_launch: occupancy query returned %d\n", per_cu); grid = -1; return; }
        if (per_cu > 1) per_cu = 1;
        grid = cus * per_cu;
    }
    if (grid < 0) return;
    hipMemsetAsync((char*)d_ws + WS_BAR, 0, BAR_BYTES, stream);
    Params p{};
    for (int i = 0; i < 26; ++i) p.in[i] = (const float*)d_in[i];
    p.out = (float*)d_out; p.ws = (char*)d_ws;
    int lo = 0, hi = 2 + 6 * DEPTH;
    void* args[] = {&p, &lo, &hi};
    hipError_t e = hipLaunchCooperativeKernel((const void*)fwd_kernel, dim3(grid), dim3(NT), args, LDS_BYTES, stream);
    if (e != hipSuccess) fprintf(stderr, "cooperative launch failed: %s (grid %d)\n", hipGetErrorString(e), grid);
}
#endif
```

```cpp
#ifdef EMU
#include "emu/hipemu.h"
#define GRID_SYNC() emu::grid_sync()
#define SMEM_DECL char* smem = emu::S().blocks[emu::cur()->block].lds
#define MFMA16(a, b, c) emu_mfma_16x16x32_bf16(a, b, c)
#else
#include <hip/hip_runtime.h>
#include <hip/hip_cooperative_groups.h>
#include <cstdio>
#include <cstdint>
#define GRID_SYNC() cooperative_groups::this_grid().sync()
#define SMEM_DECL extern __shared__ __attribute__((aligned(16))) char smem[]
#define MFMA16(a, b, c) __builtin_amdgcn_mfma_f32_16x16x32_bf16(a, b, c, 0, 0, 0)
#endif

#ifdef EMU
#ifndef EMU_DM
#define EMU_DM 256
#endif
#ifndef EMU_NB
#define EMU_NB 2
#endif
#ifndef EMU_SEQ
#define EMU_SEQ 512
#endif
#ifndef EMU_DEPTH
#define EMU_DEPTH 2
#endif
#ifndef EMU_CTXL
#define EMU_CTXL 128
#endif
constexpr int DM = EMU_DM, NB = EMU_NB, SEQ = EMU_SEQ, DEPTH = EMU_DEPTH, CTXL = EMU_CTXL;
#else
constexpr int DM = 1024, NB = 8, SEQ = 2048, DEPTH = 4, CTXL = 256;
#endif
constexpr int MIX = 1024, WG = 256, HD = 64, NH = 4, CH = 64;
constexpr int TOK = CTXL + SEQ, T = NB * TOK, NCH = TOK / CH, NCC = CTXL / CH;
constexpr int N_IN = 4144, NP = 3072, NG = 48, NGS = 32, NMAIN = 3328, NPAD = 4352;
constexpr int NF = 2 * SEQ;
constexpr int NJ = NB + 1;
constexpr int NT = 512;
constexpr float EPS = 1e-6f;
constexpr int PA = 0, PG = 1280, PD = 2304;
constexpr int YA = 0, YH = 256, YG = 512, YD = 768;
constexpr int ilog4(int n) { return n <= 1 ? 0 : 1 + ilog4(n / 4); }
constexpr int FFT_P = ilog4(NF);
static_assert((1 << (2 * FFT_P)) == NF, "NF must be a power of 4");
static_assert(DM % 256 == 0 && CTXL % 128 == 0 && SEQ % 256 == 0, "shape constraints");

typedef unsigned short bf16;
typedef short bf16x8 __attribute__((ext_vector_type(8)));
typedef float f32x4 __attribute__((ext_vector_type(4)));
typedef unsigned u32x4 __attribute__((ext_vector_type(4)));
typedef unsigned u32x2 __attribute__((ext_vector_type(2)));
struct cpx { float x, y; };

constexpr size_t al256(size_t x) { return (x + 255) & ~(size_t)255; }
constexpr size_t WS_CTXB = 0;
constexpr size_t WS_HNY = al256(WS_CTXB + (size_t)NB * CTXL * DM * 4);
constexpr size_t WS_WIN = WS_HNY + (size_t)T * 1024 * 2;
constexpr size_t WS_ST = WS_WIN;
constexpr size_t ST_BYTES = (size_t)2 * 2 * NB * NH * NCH * 4096 * 2;
constexpr size_t WS_KT = al256(WS_WIN + (size_t)NPAD * DM * 2);
static_assert(WS_KT + (size_t)WG * NF * 4 <= WS_ST + ST_BYTES || true, "");
constexpr size_t ST_END = al256((WS_ST + ST_BYTES > WS_KT + (size_t)WG * NF * 4) ? WS_ST + ST_BYTES : WS_KT + (size_t)WG * NF * 4);
constexpr size_t WS_P = ST_END;
constexpr size_t WS_HT = al256(WS_P + (size_t)T * NP * 2);
constexpr size_t WS_WOUT = WS_HT;
constexpr size_t WS_G = al256(WS_HT + (size_t)1024 * T * 2);
constexpr size_t WS_KF = al256(WS_G + (size_t)T * NGS * 4);
constexpr size_t WS_HC = al256(WS_KF + (size_t)WG * NF * 8);
constexpr size_t WS_EQ = al256(WS_HC + (size_t)2 * WG * CTXL * 4);
constexpr size_t WS_NV = al256(WS_EQ + (size_t)2 * T * WG * 2);
constexpr size_t WS_BE = al256(WS_NV + (size_t)2 * NB * NH * NCH * 64 * 4);
constexpr size_t WS_SC = al256(WS_BE + (size_t)2 * NB * NH * NCH * 64 * 4);
constexpr size_t WS_MOD = al256(WS_SC + (size_t)2 * NB * NH * NCH * 4 * 4);
constexpr size_t WS_TW = al256(WS_MOD + (size_t)DEPTH * NJ * 3 * DM * 4);
constexpr size_t WS_ROPE = al256(WS_TW + (size_t)NF * 8);
constexpr size_t WS_BAR = al256(WS_ROPE + (size_t)SEQ * 32 * 8);
constexpr size_t BAR_BYTES = 16384;
constexpr size_t WS_TOTAL = al256(WS_BAR + BAR_BYTES);
static_assert((size_t)T * DM * 4 <= (size_t)T * NP * 2, "YO fits in P");
#ifndef EMU
static_assert(WS_TOTAL <= (size_t)268435456, "workspace map must fit 256 MiB");
#endif

constexpr int LDS_BYTES = 163840;

struct Params {
    const float* in[26];
    float* out;
    char* ws;
};
enum { I_X = 0, I_C, I_CTX, I_CCTX, I_WADA, I_BADA, I_GPRE, I_GPOST, I_WIN, I_MGB, I_MNG, I_HCW, I_HCB, I_HW1, I_HB1, I_HW2, I_HB2, I_HW3, I_HB3,
       I_HFREQ, I_HD, I_GWA, I_GBA, I_GNG, I_SINK, I_WOUT };

__device__ __forceinline__ Params relaunder(const Params& pk) {
#ifdef EMU
    return pk;
#else
    Params p = pk; size_t z = 0; asm volatile("" : "+s"(z)); p.ws = pk.ws + z; p.out = pk.out + z;
#pragma unroll
    for (int i = 0; i < 26; ++i) p.in[i] = pk.in[i] + z;
    return p;
#endif
}
#ifdef EMU
#define WAVE_SYNC() emu_wave_sync()
#else
#define WAVE_SYNC() do { asm volatile("s_waitcnt lgkmcnt(0)" ::: "memory"); __builtin_amdgcn_wave_barrier(); } while (0)
#endif

#ifdef EMU
__device__ __forceinline__ int otid() { return (int)threadIdx.x; }
__device__ __forceinline__ int obid() { return (int)blockIdx.x; }
#else
__device__ __forceinline__ int otid() { int t = (int)threadIdx.x; asm volatile("" : "+v"(t)); return t; }
__device__ __forceinline__ int obid() { int b = (int)blockIdx.x; asm volatile("" : "+s"(b)); return b; }
#endif
__device__ __forceinline__ unsigned fbits(float f) { return __builtin_bit_cast(unsigned, f); }
__device__ __forceinline__ float bitsf(unsigned u) { return __builtin_bit_cast(float, u); }
__device__ __forceinline__ float bf2f(bf16 h) { return bitsf((unsigned)h << 16); }
#ifdef EMU
__device__ __forceinline__ bf16 f2bf(float f) { unsigned u = fbits(f); return (bf16)((u + 0x7fffu + ((u >> 16) & 1u)) >> 16); }
__device__ __forceinline__ unsigned pk2(float lo, float hi) { return (unsigned)f2bf(lo) | ((unsigned)f2bf(hi) << 16); }
#else
typedef __bf16 nbf16x2 __attribute__((ext_vector_type(2)));
typedef float nf32x2 __attribute__((ext_vector_type(2)));
__device__ __forceinline__ unsigned pk2(float lo, float hi) { const nf32x2 v = {lo, hi}; return __builtin_bit_cast(unsigned, __builtin_convertvector(v, nbf16x2)); }
__device__ __forceinline__ bf16 f2bf(float f) { return (bf16)(pk2(f, 0.0f) & 0xffffu); }
#endif
#ifdef EMU
__device__ __forceinline__ float frcp_(float x) { return 1.0f / x; }
#else
__device__ __forceinline__ float frcp_(float x) { return __builtin_amdgcn_rcpf(x); }
#endif
__device__ __forceinline__ float sigmoidf_(float x) { return frcp_(1.0f + __expf(-x)); }
__device__ __forceinline__ float siluf_(float x) { return x * frcp_(1.0f + __expf(-x)); }
__device__ __forceinline__ float logsigf_(float x) { return fminf(x, 0.0f) - log1pf(__expf(-fabsf(x))); }
__device__ __forceinline__ float logsig_fast(float x) { return fminf(x, 0.0f) - __logf(1.0f + __expf(-fabsf(x))); }
#ifdef EMU
__device__ __forceinline__ float row16_sum(float x) { x += __shfl_xor(x, 1); x += __shfl_xor(x, 2); x += __shfl_xor(x, 4); x += __shfl_xor(x, 8); return x; }
__device__ __forceinline__ float row16_max(float x) { x = fmaxf(x, __shfl_xor(x, 1)); x = fmaxf(x, __shfl_xor(x, 2)); x = fmaxf(x, __shfl_xor(x, 4)); x = fmaxf(x, __shfl_xor(x, 8)); return x; }
__device__ __forceinline__ float xrow_sum(float x) { x += __shfl_xor(x, 16); x += __shfl_xor(x, 32); return x; }
__device__ __forceinline__ float xrow_max(float x) { x = fmaxf(x, __shfl_xor(x, 16)); x = fmaxf(x, __shfl_xor(x, 32)); return x; }
#else
template <int CTRL> __device__ __forceinline__ float dpp_(float x) { return __builtin_bit_cast(float, __builtin_amdgcn_mov_dpp(__builtin_bit_cast(int, x), CTRL, 0xf, 0xf, true)); }
__device__ __forceinline__ float row16_sum(float x) { x += dpp_<0xB1>(x); x += dpp_<0x4E>(x); x += dpp_<0x141>(x); x += dpp_<0x128>(x); return x; }
__device__ __forceinline__ float row16_max(float x) { x = fmaxf(x, dpp_<0xB1>(x)); x = fmaxf(x, dpp_<0x4E>(x)); x = fmaxf(x, dpp_<0x141>(x)); x = fmaxf(x, dpp_<0x128>(x)); return x; }
__device__ __forceinline__ float xrow_sum(float x) {
    auto s = __builtin_amdgcn_permlane16_swap(fbits(x), fbits(x), false, false); x = bitsf(s[0]) + bitsf(s[1]);
    auto t = __builtin_amdgcn_permlane32_swap(fbits(x), fbits(x), false, false); return bitsf(t[0]) + bitsf(t[1]); }
__device__ __forceinline__ float xrow_max(float x) {
    auto s = __builtin_amdgcn_permlane16_swap(fbits(x), fbits(x), false, false); x = fmaxf(bitsf(s[0]), bitsf(s[1]));
    auto t = __builtin_amdgcn_permlane32_swap(fbits(x), fbits(x), false, false); return fmaxf(bitsf(t[0]), bitsf(t[1])); }
#endif
__device__ __forceinline__ float wave_sum(float v) { return xrow_sum(row16_sum(v)); }
__device__ __forceinline__ float wave_max(float v) { return xrow_max(row16_max(v)); }
#ifdef EMU
__device__ __forceinline__ float wave_prefix_sum(float v, int lane) {
#pragma unroll
    for (int o = 1; o < 64; o <<= 1) { float t = __shfl_up(v, o); if (lane >= o) v += t; }
    return v;
}
__device__ __forceinline__ float wave_prefix_max(float v, int lane) {
#pragma unroll
    for (int o = 1; o < 64; o <<= 1) { float t = __shfl_up(v, o); if (lane >= o) v = fmaxf(v, t); }
    return v;
}
#else
template <int CTRL, int RM> __device__ __forceinline__ float dppo_(float old, float x) { return __builtin_bit_cast(float, __builtin_amdgcn_update_dpp(__builtin_bit_cast(int, old), __builtin_bit_cast(int, x), CTRL, RM, 0xf, false)); }
__device__ __forceinline__ float wave_prefix_sum(float v, int) {
    v += dppo_<0x111, 0xf>(0.f, v); v += dppo_<0x112, 0xf>(0.f, v); v += dppo_<0x114, 0xf>(0.f, v); v += dppo_<0x118, 0xf>(0.f, v);
    v += dppo_<0x142, 0xa>(0.f, v); v += dppo_<0x143, 0xc>(0.f, v); return v;
}
__device__ __forceinline__ float wave_prefix_max(float v, int) {
    const float ninf = -INFINITY;
    v = fmaxf(v, dppo_<0x111, 0xf>(ninf, v)); v = fmaxf(v, dppo_<0x112, 0xf>(ninf, v)); v = fmaxf(v, dppo_<0x114, 0xf>(ninf, v)); v = fmaxf(v, dppo_<0x118, 0xf>(ninf, v));
    v = fmaxf(v, dppo_<0x142, 0xa>(ninf, v)); v = fmaxf(v, dppo_<0x143, 0xc>(ninf, v)); return v;
}
#endif
__device__ __forceinline__ float wave_suffix_max(float v, int lane) {
    return __shfl(wave_prefix_max(__shfl(v, 63 - lane), lane), 63 - lane);
}
__device__ __forceinline__ void unpack8(u32x4 v, float* f) {
    f[0] = bitsf(v.x << 16); f[1] = bitsf(v.x & 0xffff0000u); f[2] = bitsf(v.y << 16); f[3] = bitsf(v.y & 0xffff0000u);
    f[4] = bitsf(v.z << 16); f[5] = bitsf(v.z & 0xffff0000u); f[6] = bitsf(v.w << 16); f[7] = bitsf(v.w & 0xffff0000u);
}
__device__ __forceinline__ int orig_col(int n) {
    if (n < 1280) return n;
    if (n < 2304) return 2320 + (n - 1280);
    if (n < 3072) return 3376 + (n - 2304);
    if (n < 3088) return 1280 + (n - 3072);
    if (n < 3120) return 3344 + (n - 3088);
    if (n < NMAIN) return -1;
    return 1296 + (n - NMAIN);
}
__device__ __forceinline__ int chain_cid(int dir, int o) {
    if (dir == 0) return o;
    return o < NCC ? (NCC - 1 - o) : (NCH - 1 - (o - NCC));
}

__device__ __forceinline__ int swz(int row, int ch) { return row * 64 + ((ch ^ (row & 7)) << 3); }
__device__ __forceinline__ u32x4 pack8(const float* f) { u32x4 o; o.x = pk2(f[0], f[1]); o.y = pk2(f[2], f[3]); o.z = pk2(f[4], f[5]); o.w = pk2(f[6], f[7]); return o; }
__device__ __forceinline__ bf16x8 as_frag(u32x4 v) { return __builtin_bit_cast(bf16x8, v); }
__device__ __forceinline__ u32x4 as_u4(bf16x8 v) { return __builtin_bit_cast(u32x4, v); }

constexpr int LS = 72;

template <int NTL, int KS>
__device__ __forceinline__ void mma_nt(const bf16* A, int lda, int m0, const bf16* B, int ldb, int n0, f32x4 (&acc)[NTL], int lane) {
    const int r = lane & 15, q = lane >> 4;
#pragma unroll
    for (int ks = 0; ks < KS; ++ks) {
        const bf16x8 a = *(const bf16x8*)(A + (m0 + r) * lda + ks * 32 + q * 8);
#pragma unroll
        for (int nt = 0; nt < NTL; ++nt) {
            const bf16x8 b = *(const bf16x8*)(B + (n0 + nt * 16 + r) * ldb + ks * 32 + q * 8);
            acc[nt] = MFMA16(a, b, acc[nt]);
        }
    }
}

__device__ __forceinline__ void layer_prep(const Params& p, int l, int idx, int stride, char* smem);
__device__ __forceinline__ void phase0(const Params& p, char* smem) {
    const int tid = otid();
    cpx* TW = (cpx*)(p.ws + WS_TW);
    cpx* ROPE = (cpx*)(p.ws + WS_ROPE);
    float* MOD = (float*)(p.ws + WS_MOD);
    constexpr int N_TW = NF / NT, N_ROPE = SEQ * 32 / NT, N_MOD = DEPTH * (3 * DM / 64);
    for (int task = obid(); task < N_TW + N_ROPE + N_MOD; task += gridDim.x) {
        if (task < N_TW) {
            const int j = task * NT + tid; float s, c; sincospif(2.0f * (float)j / (float)NF, &s, &c);
            cpx v; v.x = c; v.y = -s; TW[j] = v;
        } else if (task < N_TW + N_ROPE) {
            const int idx = (task - N_TW) * NT + tid; const int pos = idx >> 5, i = idx & 31;
            const float inv = exp2f(-(float)(i & 15) * (13.287712379549449f / 16.0f));
            const float ang = (float)(i < 16 ? pos / 64 : pos % 64) * inv;
            cpx v; v.x = cosf(ang); v.y = sinf(ang); ROPE[idx] = v;
        } else {
            const int mt = task - N_TW - N_ROPE; const int l = mt / (3 * DM / 64), n0 = (mt % (3 * DM / 64)) * 64;
            float* sv = (float*)smem;
            float* red = sv + NJ * DM;
            __syncthreads();
            for (int i = tid; i < NJ * DM; i += NT) { const int j = i / DM, k = i % DM; const float v = j < NB ? p.in[I_C][j * DM + k] : p.in[I_CCTX][k]; sv[i] = siluf_(v); }
            __syncthreads();
            const int nl = tid & 63, ks = tid >> 6; float acc[NJ];
#pragma unroll
            for (int j = 0; j < NJ; ++j) acc[j] = 0.f;
            const float* w = p.in[I_WADA] + (size_t)l * DM * 3 * DM + n0 + nl;
            for (int k = ks * (DM / 8); k < (ks + 1) * (DM / 8); ++k) { const float wv = w[(size_t)k * 3 * DM];
#pragma unroll
                for (int j = 0; j < NJ; ++j) acc[j] += sv[j * DM + k] * wv; }
#pragma unroll
            for (int j = 0; j < NJ; ++j) red[(ks * NJ + j) * 64 + nl] = acc[j];
            __syncthreads();
            for (int i = tid; i < NJ * 64; i += NT) { const int j = i / 64, n = i % 64; float s = 0.f;
#pragma unroll
                for (int k8 = 0; k8 < 8; ++k8) s += red[(k8 * NJ + j) * 64 + n];
                MOD[((size_t)l * NJ + j) * 3 * DM + n0 + n] = s + p.in[I_BADA][(size_t)l * 3 * DM + n0 + n]; }
        }
    }
}

__device__ __forceinline__ void rp_rows(const Params& p, int l) {
    const int tid = otid(), lane = tid & 63, wave = tid >> 6;
    const float* MOD = (const float*)(p.ws + WS_MOD);
    float* CTXB = (float*)(p.ws + WS_CTXB);
    const bf16* YO = (const bf16*)(p.ws + WS_P);
    bf16* HN = (bf16*)(p.ws + WS_HNY);
    constexpr int NV4 = DM / 256, RW = 2;
    const int stride = (int)gridDim.x * 8;
    for (int base = obid() * 8 + wave; base < T; base += stride * RW) {
        f32x4 x[RW][NV4], y[RW][NV4]; const float* xo[RW]; float* xn[RW]; int mj[RW]; bool ok[RW];
#pragma unroll
        for (int i = 0; i < RW; ++i) { const int row = base + i * stride; ok[i] = row < T; const int rr = ok[i] ? row : base;
            const int b = rr / TOK, pp = rr % TOK; const bool isctx = pp < CTXL; if (l == DEPTH && isctx) ok[i] = false;
            const size_t off = isctx ? ((size_t)b * CTXL + pp) * DM : ((size_t)b * SEQ + (pp - CTXL)) * DM;
            xo[i] = (l <= 1) ? (isctx ? p.in[I_CTX] + off : p.in[I_X] + off) : (isctx ? CTXB + off : p.out + off);
            xn[i] = isctx ? CTXB + off : p.out + off; mj[i] = isctx ? NB : b;
#pragma unroll
            for (int j = 0; j < NV4; ++j) { x[i][j] = *(const f32x4*)(xo[i] + 4 * lane + 256 * j); if (l > 0) { const u32x2 yy = *(const u32x2*)(YO + (size_t)rr * DM + 4 * lane + 256 * j); y[i][j] = (f32x4){bitsf(yy.x << 16), bitsf(yy.x & 0xffff0000u), bitsf(yy.y << 16), bitsf(yy.y & 0xffff0000u)}; } else y[i][j] = (f32x4){0.f, 0.f, 0.f, 0.f}; } }
        if (l > 0) {
            float ss[RW];
#pragma unroll
            for (int i = 0; i < RW; ++i) { ss[i] = 0.f;
#pragma unroll
                for (int j = 0; j < NV4; ++j) ss[i] += y[i][j].x * y[i][j].x + y[i][j].y * y[i][j].y + y[i][j].z * y[i][j].z + y[i][j].w * y[i][j].w; }
#pragma unroll
            for (int i = 0; i < RW; ++i) ss[i] = wave_sum(ss[i]);
            const float* gp = p.in[I_GPOST] + (size_t)(l - 1) * DM;
#pragma unroll
            for (int i = 0; i < RW; ++i) { const float rstd = rsqrtf(ss[i] * (1.0f / DM) + EPS); const float* gt = MOD + ((size_t)(l - 1) * NJ + mj[i]) * 3 * DM + 2 * DM;
#pragma unroll
                for (int j = 0; j < NV4; ++j) { const f32x4 g4 = *(const f32x4*)(gt + 4 * lane + 256 * j), p4 = *(const f32x4*)(gp + 4 * lane + 256 * j);
                    x[i][j] = x[i][j] + g4 * (y[i][j] * rstd * p4);
                    if (ok[i]) *(f32x4*)(xn[i] + 4 * lane + 256 * j) = x[i][j]; } }
        }
        if (l < DEPTH) {
            float ss[RW];
#pragma unroll
            for (int i = 0; i < RW; ++i) { ss[i] = 0.f;
#pragma unroll
                for (int j = 0; j < NV4; ++j) ss[i] += x[i][j].x * x[i][j].x + x[i][j].y * x[i][j].y + x[i][j].z * x[i][j].z + x[i][j].w * x[i][j].w; }
#pragma unroll
            for (int i = 0; i < RW; ++i) ss[i] = wave_sum(ss[i]);
            const float* gp = p.in[I_GPRE] + (size_t)l * DM;
#pragma unroll
            for (int i = 0; i < RW; ++i) { const float rstd = rsqrtf(ss[i] * (1.0f / DM) + EPS); const float* md = MOD + ((size_t)l * NJ + mj[i]) * 3 * DM; const int row = base + i * stride;
#pragma unroll
                for (int j = 0; j < NV4; ++j) { const int e = 4 * lane + 256 * j;
                    const f32x4 g4 = *(const f32x4*)(gp + e), sh = *(const f32x4*)(md + e), sc = *(const f32x4*)(md + DM + e);
                    const f32x4 h = (x[i][j] * rstd * g4) * (sc + 1.0f) + sh;
                    u32x2 o; o.x = pk2(h.x, h.y); o.y = pk2(h.z, h.w);
                    if (ok[i]) *(u32x2*)(HN + (size_t)row * DM + e) = o; } }
        }
    }
}

__device__ __forceinline__ void convert_tile(const float* src, int ldn, bf16* dst, int K, int n0, int k0, bool use_map, char* smem) {
    const int tid = otid();
    float* tile = (float*)smem;
    __syncthreads();
#pragma unroll
    for (int i = 0; i < 8; ++i) { const int idx = tid + NT * i, k = idx >> 6, n = idx & 63;
        const int oc = use_map ? orig_col(n0 + n) : (n0 + n);
        tile[k * 65 + n] = oc >= 0 ? src[(size_t)(k0 + k) * ldn + oc] : 0.f; }
    __syncthreads();
    const int n = tid >> 3, c = tid & 7;
    u32x4 o; o.x = pk2(tile[(8 * c + 0) * 65 + n], tile[(8 * c + 1) * 65 + n]); o.y = pk2(tile[(8 * c + 2) * 65 + n], tile[(8 * c + 3) * 65 + n]);
    o.z = pk2(tile[(8 * c + 4) * 65 + n], tile[(8 * c + 5) * 65 + n]); o.w = pk2(tile[(8 * c + 6) * 65 + n], tile[(8 * c + 7) * 65 + n]);
    *(u32x4*)(dst + (size_t)(n0 + n) * K + k0 + 8 * c) = o;
}

__device__ __forceinline__ void filter_task(const Params& p, int l, int L, int pos0, char* smem) {
    const int tid = otid();
    float* z = (float*)smem;
    float* h1 = z + 8 * 33;
    float* h2 = h1 + 8 * 64;
    __syncthreads();
    if (tid < 8 * 33) { const int pp = tid / 33, i = tid % 33; const float pos = (float)(pos0 + pp);
        const float t = pos / (float)(L - 1 > 1 ? L - 1 : 1), w = 6.283185307179586f * pos / (float)L; float v;
        if (i == 0) v = t; else { const int bi = (i - 1) & 15; const float f = 1e-4f + (float)bi * ((15.0f - 1e-4f) / 15.0f); v = (i <= 16) ? cosf(w * f) : -sinf(w * f); }
        z[tid] = v; }
    __syncthreads();
    { const int pp = tid >> 6, j = tid & 63; const float* w1 = p.in[I_HW1] + (size_t)l * 33 * 64; float a = p.in[I_HB1][l * 64 + j];
        for (int i = 0; i < 33; ++i) a += z[pp * 33 + i] * w1[i * 64 + j];
        h1[tid] = sinf(p.in[I_HFREQ][(l * 2 + 0) * 64 + j] * a); }
    __syncthreads();
    { const int pp = tid >> 6, j = tid & 63; const float* w2 = p.in[I_HW2] + (size_t)l * 64 * 64; float a = p.in[I_HB2][l * 64 + j];
        for (int i = 0; i < 64; ++i) a += h1[pp * 64 + i] * w2[i * 64 + j];
        h2[tid] = sinf(p.in[I_HFREQ][(l * 2 + 1) * 64 + j] * a); }
    __syncthreads();
    { const int o = tid, dir = o >> 8, c = o & 255; const float* w3 = p.in[I_HW3] + (size_t)l * 64 * 512; const float b3 = p.in[I_HB3][l * 512 + o];
        const float delta = 3.0701134573253946f + (float)c * ((15.350567286626973f - 3.0701134573253946f) / 255.0f);
        float acc[8];
#pragma unroll
        for (int pp = 0; pp < 8; ++pp) acc[pp] = b3;
        for (int j = 0; j < 64; ++j) { const float wv = w3[j * 512 + o];
#pragma unroll
            for (int pp = 0; pp < 8; ++pp) acc[pp] += h2[pp * 64 + j] * wv; }
        float* KT = (float*)(p.ws + WS_KT); float* HC = (float*)(p.ws + WS_HC);
#pragma unroll
        for (int pp = 0; pp < 8; ++pp) { const int pos = pos0 + pp; const float t = (float)pos / (float)(L - 1 > 1 ? L - 1 : 1);
            const float v = acc[pp] * __expf(-t * delta);
            if (L == SEQ) { if (dir == 0) KT[(size_t)c * NF + pos]= v; else if (pos > 0) KT[(size_t)c * NF + (NF - pos)] = v; else KT[(size_t)c * NF + SEQ] = 0.f; }
            else HC[((size_t)dir * WG + c) * CTXL + pos] = v; }
    }
}

__device__ __forceinline__ void layer_prep(const Params& p, int l, int idx, int stride, char* smem) {
    constexpr int N_WIN = (NPAD / 64) * (DM / 64), N_FL = SEQ / 8, N_FC = CTXL / 8;
    for (int task = idx; task < N_WIN + N_FL + N_FC; task += stride) {
        if (task < N_WIN) { const int nt = task / (DM / 64), kt = task % (DM / 64);
            convert_tile(p.in[I_WIN] + (size_t)l * DM * N_IN, N_IN, (bf16*)(p.ws + WS_WIN), DM, nt * 64, kt * 64, true, smem); }
        else if (task < N_WIN + N_FL) filter_task(p, l, SEQ, (task - N_WIN) * 8, smem);
        else filter_task(p, l, CTXL, (task - N_WIN - N_FL) * 8, smem);
    }
}
__device__ __forceinline__ void phase_rp(const Params& p, int l, char* smem) { rp_rows(p, l); if (l < DEPTH) layer_prep(p, l, obid(), (int)gridDim.x, smem); }

__device__ __forceinline__ cpx cmul(cpx a, cpx b) { cpx r; r.x = a.x * b.x - a.y * b.y; r.y = a.x * b.y + a.y * b.x; return r; }
__device__ __forceinline__ cpx cmulc(cpx a, cpx b) { cpx r; r.x = a.x * b.x + a.y * b.y; r.y = a.y * b.x - a.x * b.y; return r; }
constexpr int fpad(int i) { return i + (i >> 4); }
__device__ __forceinline__ int FPH(int i) { return i + (i >> 4); }
constexpr int FBUF = fpad(NF);
constexpr int ilog16(int n) { return n < 16 ? 0 : 1 + ilog16(n / 16); }
constexpr int FFT_P16 = ilog16(NF);
constexpr bool FFT_R4 = ((NF >> (4 * FFT_P16)) == 4);
static_assert((NF >> (4 * FFT_P16)) == 1 || (NF >> (4 * FFT_P16)) == 4, "NF = 16^a * (1 or 4)");
template <bool INV> __device__ __forceinline__ void dft4(cpx& a0, cpx& a1, cpx& a2, cpx& a3) {
    const cpx s = {a0.x + a2.x, a0.y + a2.y}, b = {a0.x - a2.x, a0.y - a2.y}, c = {a1.x + a3.x, a1.y + a3.y}, d = {a1.x - a3.x, a1.y - a3.y};
    a0 = (cpx){s.x + c.x, s.y + c.y}; a2 = (cpx){s.x - c.x, s.y - c.y};
    if (!INV) { a1 = (cpx){b.x + d.y, b.y - d.x}; a3 = (cpx){b.x - d.y, b.y + d.x}; }
    else      { a1 = (cpx){b.x - d.y, b.y + d.x}; a3 = (cpx){b.x + d.y, b.y - d.x}; }
}
template <bool INV> __device__ __forceinline__ cpx cmulk(cpx a, float wr, float wi) {
    cpx r; if (!INV) { r.x = a.x * wr + a.y * wi; r.y = a.y * wr - a.x * wi; } else { r.x = a.x * wr - a.y * wi; r.y = a.y * wr + a.x * wi; } return r;
}
template <bool INV> __device__ __forceinline__ void dft16(cpx (&x)[16]) {
    constexpr float C1 = 0.92387953251128674f, S1 = 0.38268343236508977f, C2 = 0.70710678118654752f;
#pragma unroll
    for (int n2 = 0; n2 < 4; ++n2) dft4<INV>(x[n2], x[4 + n2], x[8 + n2], x[12 + n2]);
    x[4 * 1 + 1] = cmulk<INV>(x[4 * 1 + 1], C1, S1); x[4 * 1 + 2] = cmulk<INV>(x[4 * 1 + 2], C2, C2); x[4 * 1 + 3] = cmulk<INV>(x[4 * 1 + 3], S1, C1);
    x[4 * 2 + 1] = cmulk<INV>(x[4 * 2 + 1], C2, C2); x[4 * 2 + 2] = cmulk<INV>(x[4 * 2 + 2], 0.f, 1.f); x[4 * 2 + 3] = cmulk<INV>(x[4 * 2 + 3], -C2, C2);
    x[4 * 3 + 1] = cmulk<INV>(x[4 * 3 + 1], S1, C1); x[4 * 3 + 2] = cmulk<INV>(x[4 * 3 + 2], -C2, C2); x[4 * 3 + 3] = cmulk<INV>(x[4 * 3 + 3], -C1, -S1);
#pragma unroll
    for (int k1 = 0; k1 < 4; ++k1) dft4<INV>(x[4 * k1 + 0], x[4 * k1 + 1], x[4 * k1 + 2], x[4 * k1 + 3]);
    cpx t;
    t = x[1]; x[1] = x[4]; x[4] = t; t = x[2]; x[2] = x[8]; x[8] = t; t = x[3]; x[3] = x[12]; x[12] = t;
    t = x[6]; x[6] = x[9]; x[9] = t; t = x[7]; x[7] = x[13]; x[13] = t; t = x[11]; x[11] = x[14]; x[14] = t;
}
template <bool INV> __device__ __forceinline__ void fft_stage16(cpx* buf, const cpx* TW, int tl, int M) {
    const int span = M >> 4, twm = NF / M;
#pragma unroll 1
    for (int j = tl; j < NF / 16; j += 256) {
        const int grp = j / span, pos = j % span, base = grp * M + pos; cpx x[16];
#pragma unroll
        for (int q = 0; q < 16; ++q) x[q] = buf[FPH(base + q * span)];
        cpx w1 = {1.f, 0.f}; if (span > 1) w1 = TW[pos * twm];
        if (INV && span > 1) { cpx wk = w1;
#pragma unroll
            for (int k = 1; k < 16; ++k) { x[k] = cmulc(x[k], wk); wk = cmul(wk, w1); } }
        dft16<INV>(x);
        if (!INV && span > 1) { cpx wk = w1;
#pragma unroll
            for (int k = 1; k < 16; ++k) { x[k] = cmul(x[k], wk); wk = cmul(wk, w1); } }
#pragma unroll
        for (int q = 0; q < 16; ++q) buf[FPH(base + q * span)] = x[q];
    }
}
template <bool INV> __device__ __forceinline__ void fft_stage4_last(cpx* buf, int tl) {
#pragma unroll 1
    for (int j = tl; j < NF / 4; j += 256) { cpx a0 = buf[FPH(4 * j)], a1 = buf[FPH(4 * j + 1)], a2 = buf[FPH(4 * j + 2)], a3 = buf[FPH(4 * j + 3)];
        dft4<INV>(a0, a1, a2, a3); buf[FPH(4 * j)] = a0; buf[FPH(4 * j + 1)] = a1; buf[FPH(4 * j + 2)] = a2; buf[FPH(4 * j + 3)] = a3; }
}
__device__ __forceinline__ void fft_fwd(cpx* buf, const cpx* TW, int tl) {
    int M = NF;
#pragma unroll
    for (int s = 0; s < FFT_P16; ++s) { __syncthreads(); fft_stage16<false>(buf, TW, tl, M); M >>= 4; }
    if (FFT_R4) { __syncthreads(); fft_stage4_last<false>(buf, tl); }
    __syncthreads();
}
__device__ __forceinline__ void fft_inv(cpx* buf, const cpx* TW, int tl) {
    if (FFT_R4) { __syncthreads(); fft_stage4_last<true>(buf, tl); }
    int M = FFT_R4 ? 64 : 16;
#pragma unroll
    for (int s = 0; s < FFT_P16; ++s) { __syncthreads(); fft_stage16<true>(buf, TW, tl, M); M <<= 4; }
    __syncthreads();
}
__device__ __forceinline__ void filt_fft_task(const Params& p, int cp, char* smem) {
    const int tid = otid(), half = tid >> 8, tl = tid & 255, c = 2 * cp + half;
    cpx* buf = (cpx*)smem + (size_t)half * FBUF;
    const float* KT = (const float*)(p.ws + WS_KT) + (size_t)c * NF;
    cpx* KF = (cpx*)(p.ws + WS_KF) + (size_t)c * NF;
    const cpx* TW = (const cpx*)(p.ws + WS_TW);
    __syncthreads();
    for (int i = tl; i < NF; i += 256) { cpx v; v.x = KT[i]; v.y = 0.f; buf[FPH(i)] = v; }
    fft_fwd(buf, TW, tl);
    for (int i = tl; i < NF; i += 256) KF[i] = buf[FPH(i)];
}

__device__ __forceinline__ void gemm_tile(const Params& p, const bf16* A, const bf16* Bt, int K, int mt, int nt, int mode, char* smem) {
    const int tid = otid(), lane = tid & 63, wave = tid >> 6;
    bf16* As = (bf16*)smem;
    bf16* Bs = As + 128 * LS;
    const int wm = (wave & 3) * 32, wn = (wave >> 2) * 64;
    f32x4 acc[2][4];
#pragma unroll
    for (int i = 0; i < 2; ++i)
#pragma unroll
        for (int j = 0; j < 4; ++j) acc[i][j] = (f32x4){0.f, 0.f, 0.f, 0.f};
    const int lr = tid >> 3, lc = tid & 7;
    const bf16* Ag = A + (size_t)(mt * 128 + lr) * K + lc * 8;
    const bf16* Bg = Bt + (size_t)(nt * 128 + lr) * K + lc * 8;
    u32x4 ra0, ra1, rb0, rb1;
    ra0 = *(const u32x4*)(Ag); ra1 = *(const u32x4*)(Ag + (size_t)64 * K); rb0 = *(const u32x4*)(Bg); rb1 = *(const u32x4*)(Bg + (size_t)64 * K);
    const int nk = K / 64;
    for (int kt = 0; kt < nk; ++kt) {
        __syncthreads();
        *(u32x4*)(As + lr * LS + lc * 8) = ra0; *(u32x4*)(As + (lr + 64) * LS + lc * 8) = ra1;
        *(u32x4*)(Bs + lr * LS + lc * 8) = rb0; *(u32x4*)(Bs + (lr + 64) * LS + lc * 8) = rb1;
        __syncthreads();
        if (kt + 1 < nk) { const int ko = (kt + 1) * 64;
            ra0 = *(const u32x4*)(Ag + ko); ra1 = *(const u32x4*)(Ag + (size_t)64 * K + ko); rb0 = *(const u32x4*)(Bg + ko); rb1 = *(const u32x4*)(Bg + (size_t)64 * K + ko); }
        mma_nt<4, 2>(As, LS, wm, Bs, LS, wn, acc[0], lane);
        mma_nt<4, 2>(As, LS, wm + 16, Bs, LS, wn, acc[1], lane);
    }
    const int r = lane & 15, q = lane >> 4;
#pragma unroll
    for (int i = 0; i < 2; ++i)
#pragma unroll
        for (int j = 0; j < 4; ++j)
#pragma unroll
            for (int e = 0; e < 4; ++e) {
                const int row = mt * 128 + wm + 16 * i + 4 * q + e, col = nt * 128 + wn + 16 * j + r; const float v = acc[i][j][e];
                if (mode == 0) { if (col < NP) ((bf16*)(p.ws + WS_P))[(size_t)row * NP + col] = f2bf(v); else if (col < NP + 16) ((float*)(p.ws + WS_G))[(size_t)row * NGS + (col - NP)] = v; else if (col < NP + NG) ((bf16*)((float*)(p.ws + WS_G) + (size_t)row * NGS + 16))[col - NP - 16] = f2bf(v); }
                else if (mode == 2) ((bf16*)(p.ws + WS_HT))[(size_t)row * T + col] = f2bf(v);
                else ((bf16*)(p.ws + WS_P))[(size_t)row * DM + col] = f2bf(v);
            }
}

#ifndef EMU
namespace pg8 {
#define PG8_LAS __attribute__((address_space(3)))
typedef unsigned short bf16_t;
typedef short bf16x8 __attribute__((ext_vector_type(8)));
typedef float f32x4 __attribute__((ext_vector_type(4)));
typedef unsigned u32x4 __attribute__((ext_vector_type(4)));
constexpr int BM = 256, BK = 64, HALF = 128, HTB = HALF * BK * 2  , STAGE_BYTES = 8 * HTB, NXCD = 8, WGM = 8;

__host__ __device__ __forceinline__ int lds_byte(int r, int c) { const int st = (r >> 4) * 2 + (c >> 5), rr = r & 15, cc = c & 31, ob = rr * 64 + cc * 2; return st * 1024 + (ob ^ (((ob >> 9) & 1) << 5)); }
__host__ __device__ __forceinline__ void stage_rc(int b, int& R, int& C) { const int st = b / 1024, sb = b % 1024, swz = sb ^ (((sb >> 9) & 1) << 5); R = (st >> 1) * 16 + swz / 64; C = (st & 1) * 32 + (swz % 64) / 2; }
__host__ __device__ __forceinline__ int perm32(int rho) { const int n = rho >> 4, i = rho & 15; return 8 * (i >> 2) + 4 * n + (i & 3); }

struct Unit { int pm, pn; };
struct Gemm { const bf16_t* A; const bf16_t* Bt; int M, N, K; };
__device__ __forceinline__ unsigned cvt_pk_bf16(float lo, float hi) { unsigned r; asm volatile("v_cvt_pk_bf16_f32 %0, %1, %2" : "=v"(r) : "v"(lo), "v"(hi)); return r; }
template <class Epi, class Sched, bool ALIGN_EPI = false, bool SP2 = false>
__device__ __forceinline__ void gemm_phase(PG8_LAS unsigned char* lds, const Gemm g, const Sched& S, const Epi& E) {
    const int tid = otid(), wid = __builtin_amdgcn_readfirstlane(tid >> 6), lane = tid & 63, wr = wid >> 2, wc = wid & 3, fr = lane & 15, fq = lane >> 4;
    const int K = g.K, nt = K / BK;
    unsigned voffA[2], voffB[2];
#pragma unroll
    for (int i = 0; i < 2; ++i) { int R, C; stage_rc(tid * 16 + i * 8192, R, C); const int Rb = Epi::PERM ? ((R & ~31) + perm32(R & 31)) : R;
        voffA[i] = (unsigned)(R * K + C) * 2u; voffB[i] = (unsigned)(Rb * K + C) * 2u; }
    const size_t kstep = (size_t)(BK * 2);
    const size_t hstep = (size_t)HALF * K * 2;
    const size_t tstep = 2 * hstep;
    const unsigned ldsw = (unsigned)wid * 1024u;
    const int aoff = lds_byte(wr * 64 + fr, fq * 8), boff = lds_byte(wc * 32 + fr, fq * 8);
#define PG8_SA(b, h) (((b) * 2 + (h)) * HTB)
#define PG8_SB(b, h) ((4 + (b) * 2 + (h)) * HTB)
#define PG8_STAGE(bufoff, gbase, voff) do { _Pragma("unroll") for (int _i = 0; _i < 2; ++_i) \
        __builtin_amdgcn_global_load_lds((const unsigned*)((const char*)(gbase) + (voff)[_i]), (PG8_LAS unsigned*)(lds + (bufoff) + ldsw + _i * 8192), 16, 0, 0); } while (0)
#define PG8_LDA(dst, b, h) do { _Pragma("unroll") for (int m = 0; m < 4; ++m) _Pragma("unroll") for (int k = 0; k < 2; ++k) dst[m][k] = *(const PG8_LAS bf16x8*)(lds + PG8_SA(b, h) + aoff + m * 2048 + k * 1024); } while (0)
#define PG8_LDB(dst, b, h) do { _Pragma("unroll") for (int n = 0; n < 2; ++n) _Pragma("unroll") for (int k = 0; k < 2; ++k) dst[n][k] = *(const PG8_LAS bf16x8*)(lds + PG8_SB(b, h) + boff + n * 2048 + k * 1024); } while (0)
#define PG8_MMA(ai, bj, At, Bt) do { __builtin_amdgcn_s_setprio(1); _Pragma("unroll") for (int m = 0; m < 4; ++m) _Pragma("unroll") for (int n = 0; n < 2; ++n) _Pragma("unroll") for (int k = 0; k < 2; ++k) \
        acc[ai][bj][m][n] = __builtin_amdgcn_mfma_f32_16x16x32_bf16(Bt[n][k], At[m][k], acc[ai][bj][m][n], 0, 0, 0); __builtin_amdgcn_s_setprio(0); } while (0)
#define PG8_WAIT_V(n) asm volatile("s_waitcnt vmcnt(" #n ")" ::: "memory")
#define PG8_WAIT_L(n) asm volatile("s_waitcnt lgkmcnt(" #n ")" ::: "memory")
#define PG8_BAR __builtin_amdgcn_s_barrier()
#define PG8_SCHED __builtin_amdgcn_sched_barrier(0)
    Unit cur, nxt; int ui = 0;
    if (!S.next(0, cur)) return;
    f32x4 acc[2][2][4][2];
#pragma unroll
    for (int a = 0; a < 2; ++a)
#pragma unroll
        for (int b = 0; b < 2; ++b)
#pragma unroll
            for (int m = 0; m < 4; ++m)
#pragma unroll
                for (int n = 0; n < 2; ++n) acc[a][b][m][n] = (f32x4){0.f, 0.f, 0.f, 0.f};
    bf16x8 At[4][2], B0[2][2], B1[2][2];
    const char* cA = (const char*)g.A + (size_t)cur.pm * tstep; const char* cB = (const char*)g.Bt + (size_t)cur.pn * tstep;
    S.a_ready(cur);
    if constexpr (SP2) {
        PG8_STAGE(PG8_SB(0, 0), cB, voffB); PG8_STAGE(PG8_SB(0, 1), cB + hstep, voffB); PG8_STAGE(PG8_SA(0, 0), cA, voffA); PG8_STAGE(PG8_SA(0, 1), cA + hstep, voffA);
        if (wr == 1) PG8_BAR;
        PG8_WAIT_V(2); PG8_BAR;
        PG8_STAGE(PG8_SB(1, 0), cB + kstep, voffB); PG8_STAGE(PG8_SA(1, 0), cA + kstep, voffA); PG8_STAGE(PG8_SB(1, 1), cB + hstep + kstep, voffB);
        PG8_WAIT_V(6); PG8_BAR;
    } else {
        PG8_STAGE(PG8_SB(0, 0), cB, voffB); PG8_STAGE(PG8_SA(0, 0), cA, voffA); PG8_STAGE(PG8_SB(0, 1), cB + hstep, voffB); PG8_STAGE(PG8_SA(0, 1), cA + hstep, voffA);
        if (wr == 1) PG8_BAR;
        PG8_WAIT_V(4); PG8_BAR;
        PG8_STAGE(PG8_SB(1, 0), cB + kstep, voffB); PG8_STAGE(PG8_SA(1, 0), cA + kstep, voffA); PG8_STAGE(PG8_SB(1, 1), cB + hstep + kstep, voffB);
        PG8_WAIT_V(6); PG8_BAR;
    }
    for (;;) {
        const bool has_next = S.next(ui + 1, nxt);
        const char* nA = has_next ? (const char*)g.A + (size_t)nxt.pm * tstep : cA; const char* nB = has_next ? (const char*)g.Bt + (size_t)nxt.pn * tstep : cB;
        for (int t = 0; t < nt; t += 2) {
            const bool last = (t == nt - 2);
            const char* a1 = cA + (size_t)(t + 1) * kstep;
            const char* a2 = last ? nA : cA + (size_t)(t + 2) * kstep; const char* b2 = last ? nB : cB + (size_t)(t + 2) * kstep;
            const char* a3 = a2 + kstep; const char* b3 = b2 + kstep;
            if (last && has_next) S.a_ready(nxt);
            if constexpr (SP2) {
            PG8_LDB(B0, 0, 0); PG8_LDB(B1, 0, 1); PG8_SCHED; PG8_LDA(At, 0, 0); PG8_STAGE(PG8_SA(1, 1), a1 + hstep, voffA);
            PG8_WAIT_V(8); PG8_WAIT_L(0); PG8_BAR; PG8_MMA(0, 0, At, B0); PG8_MMA(0, 1, At, B1); PG8_BAR; PG8_SCHED;
            PG8_LDA(At, 0, 1); PG8_STAGE(PG8_SB(0, 0), b2, voffB); PG8_STAGE(PG8_SB(0, 1), b2 + hstep, voffB); PG8_STAGE(PG8_SA(0, 0), a2, voffA);
            PG8_WAIT_V(8); PG8_WAIT_L(0); PG8_BAR; PG8_MMA(1, 0, At, B0); PG8_MMA(1, 1, At, B1); PG8_BAR; PG8_SCHED;
            PG8_LDB(B0, 1, 0); PG8_LDB(B1, 1, 1); PG8_SCHED; PG8_LDA(At, 1, 0); PG8_STAGE(PG8_SA(0, 1), a2 + hstep, voffA);
            PG8_WAIT_V(8); PG8_WAIT_L(0); PG8_BAR; PG8_MMA(0, 0, At, B0); PG8_MMA(0, 1, At, B1); PG8_BAR; PG8_SCHED;
            PG8_LDA(At, 1, 1); PG8_STAGE(PG8_SB(1, 0), b3, voffB); PG8_STAGE(PG8_SB(1, 1), b3 + hstep, voffB); PG8_STAGE(PG8_SA(1, 0), a3, voffA);
            PG8_WAIT_V(8); PG8_WAIT_L(0); PG8_BAR; PG8_MMA(1, 0, At, B0); PG8_MMA(1, 1, At, B1); PG8_BAR; PG8_SCHED;
            } else {
            PG8_LDB(B0, 0, 0); PG8_SCHED; PG8_LDA(At, 0, 0); PG8_STAGE(PG8_SA(1, 1), a1 + hstep, voffA);
            PG8_WAIT_L(8); PG8_BAR; PG8_WAIT_L(0); PG8_MMA(0, 0, At, B0); PG8_BAR; PG8_SCHED;
            PG8_LDB(B1, 0, 1); PG8_STAGE(PG8_SB(0, 0), b2, voffB);
            PG8_BAR; PG8_WAIT_L(0); PG8_MMA(0, 1, At, B1); PG8_BAR;
            PG8_LDA(At, 0, 1); PG8_STAGE(PG8_SA(0, 0), a2, voffA);
            PG8_BAR; PG8_WAIT_L(0); PG8_MMA(1, 0, At, B0); PG8_BAR; PG8_SCHED;
            PG8_STAGE(PG8_SB(0, 1), b2 + hstep, voffB);
            PG8_WAIT_V(6); PG8_BAR; PG8_MMA(1, 1, At, B1); PG8_BAR;
            PG8_LDB(B0, 1, 0); PG8_SCHED; PG8_LDA(At, 1, 0); PG8_STAGE(PG8_SA(0, 1), a2 + hstep, voffA);
            PG8_WAIT_L(8); PG8_BAR; PG8_WAIT_L(0); PG8_MMA(0, 0, At, B0); PG8_BAR; PG8_SCHED;
            PG8_LDB(B1, 1, 1); PG8_STAGE(PG8_SB(1, 0), b3, voffB);
            PG8_BAR; PG8_WAIT_L(0); PG8_MMA(0, 1, At, B1); PG8_BAR;
            PG8_LDA(At, 1, 1); PG8_STAGE(PG8_SA(1, 0), a3, voffA);
            PG8_BAR; PG8_WAIT_L(0); PG8_MMA(1, 0, At, B0); PG8_BAR; PG8_SCHED;
            PG8_STAGE(PG8_SB(1, 1), b3 + hstep, voffB);
            PG8_WAIT_V(6); PG8_BAR; PG8_MMA(1, 1, At, B1); PG8_BAR;
            }
        }
        if constexpr (ALIGN_EPI) { if (wr == 0) PG8_BAR; }
        if constexpr (!Epi::AFTER_DRAIN) { E(acc, cur, wr, wc, fr, fq); S.done(cur); }
        if (!has_next) break;
#pragma unroll
        for (int a = 0; a < 2; ++a)
#pragma unroll
            for (int b = 0; b < 2; ++b)
#pragma unroll
                for (int m = 0; m < 4; ++m)
#pragma unroll
                    for (int n = 0; n < 2; ++n) acc[a][b][m][n] = (f32x4){0.f, 0.f, 0.f, 0.f};
        cur = nxt; cA = nA; cB = nB; ++ui;
        if constexpr (ALIGN_EPI) { if (wr == 1) PG8_BAR; }
    }
    PG8_WAIT_V(0);
    if constexpr (!ALIGN_EPI) { if (wr == 0) PG8_BAR; }
    PG8_BAR;
    if constexpr (Epi::AFTER_DRAIN) { E.fused(acc, cur, wr, wc, fr, fq, lds, wid, lane); S.done(cur); }
#undef PG8_SA
#undef PG8_SB
#undef PG8_STAGE
#undef PG8_LDA
#undef PG8_LDB
#undef PG8_MMA
#undef PG8_WAIT_V
#undef PG8_WAIT_L
#undef PG8_BAR
#undef PG8_SCHED
}
__device__ __forceinline__ void map_tile(int L, int nM, int nN, int& pm, int& pn) {
    const int nwg = nM * nN; int wgid = L; { const int q = nwg / NXCD, r = nwg % NXCD, xcd = wgid % NXCD, off = wgid / NXCD; wgid = (xcd < r ? xcd * (q + 1) : r * (q + 1) + (xcd - r) * q) + off; }
    const int nig = WGM * nN, gid = wgid / nig, fm = gid * WGM, gsz = (nM - fm) < WGM ? (nM - fm) : WGM;
    pm = fm + ((wgid % nig) % gsz); pn = (wgid % nig) / gsz;
}
constexpr int MP = T / 256, WP = NMAIN / 256, NU2 = 4 * MP, NU1 = MP * WP;
struct InOrder { int G, c;
    __device__ __forceinline__ bool next(int i, Unit& u) const { const int L = i * G + c; if (L >= NU2 + NU1) return false; int a, b;
        if (L < NU2) { map_tile(L, 4, MP, a, b); u.pm = MP + WP + a; u.pn = b; } else { map_tile(L - NU2, MP, WP, a, b); u.pm = a; u.pn = MP + b; } return true; }
    __device__ __forceinline__ void a_ready(const Unit&) const {}
    __device__ __forceinline__ void done(const Unit&) const {}
};
struct EpiIn { static constexpr bool PERM = true, AFTER_DRAIN = false; bf16_t* P; float* G; bf16_t* HTp;
    __device__ __forceinline__ void operator()(const f32x4 (&acc)[2][2][4][2], const Unit& u, int wr, int wc, int fr, int fq) const {
        if (u.pm < MP) { const int pn = u.pn - MP, row0 = u.pm * BM + wr * 64 + fr;
            if (pn < NP / 256) { const int col0 = pn * BM + wc * 32 + 8 * fq;
#pragma unroll
                for (int ai = 0; ai < 2; ++ai)
#pragma unroll
                    for (int m = 0; m < 4; ++m) { bf16_t* rowp = P + (size_t)(row0 + ai * HALF + m * 16) * NP + col0;
#pragma unroll
                        for (int bj = 0; bj < 2; ++bj) { const f32x4 v0 = acc[ai][bj][m][0], v1 = acc[ai][bj][m][1];
                            u32x4 w; w.x = cvt_pk_bf16(v0[0], v0[1]); w.y = cvt_pk_bf16(v0[2], v0[3]); w.z = cvt_pk_bf16(v1[0], v1[1]); w.w = cvt_pk_bf16(v1[2], v1[3]); *(u32x4*)(rowp + bj * HALF) = w; } } }
            else { const int cb = wc * 32 + 8 * fq;
                if (cb < NG) {
#pragma unroll
                    for (int ai = 0; ai < 2; ++ai)
#pragma unroll
                        for (int m = 0; m < 4; ++m) { float* rowb = G + (size_t)(row0 + ai * HALF + m * 16) * NGS; const f32x4 v0 = acc[ai][0][m][0], v1 = acc[ai][0][m][1];
                            if (cb < 16) { *(f32x4*)(rowb + cb) = v0; *(f32x4*)(rowb + cb + 4) = v1; }
                            else { u32x4 w; w.x = cvt_pk_bf16(v0[0], v0[1]); w.y = cvt_pk_bf16(v0[2], v0[3]); w.z = cvt_pk_bf16(v1[0], v1[1]); w.w = cvt_pk_bf16(v1[2], v1[3]); *(u32x4*)((bf16_t*)(rowb + 16) + (cb - 16)) = w; } } } } }
        else { const int row0 = (u.pm - MP - WP) * BM + wr * 64 + fr, col0 = u.pn * BM + wc * 32 + 8 * fq;
#pragma unroll
            for (int ai = 0; ai < 2; ++ai)
#pragma unroll
                for (int m = 0; m < 4; ++m) { bf16_t* rowp = HTp + (size_t)(row0 + ai * HALF + m * 16) * T + col0;
#pragma unroll
                    for (int bj = 0; bj < 2; ++bj) { const f32x4 v0 = acc[ai][bj][m][0], v1 = acc[ai][bj][m][1];
                        u32x4 w; w.x = cvt_pk_bf16(v0[0], v0[1]); w.y = cvt_pk_bf16(v0[2], v0[3]); w.z = cvt_pk_bf16(v1[0], v1[1]); w.w = cvt_pk_bf16(v1[2], v1[3]); *(u32x4*)(rowp + bj * HALF) = w; } } }
    }
};
struct OutOrder { int G, c; bool lat_only;
    __device__ __forceinline__ bool next(int i, Unit& u) const { const int nM = lat_only ? NB * (SEQ / 256) : MP, nN = DM / 256; const int L = i * G + c; if (L >= nM * nN) return false; int a, b; map_tile(L, nM, nN, a, b);
        u.pm = lat_only ? (a / (SEQ / 256)) * (TOK / 256) + CTXL / 256 + a % (SEQ / 256) : a; u.pn = b; return true; }
    __device__ __forceinline__ void a_ready(const Unit&) const {}
    __device__ __forceinline__ void done(const Unit&) const {}
};
struct EpiOut { static constexpr bool PERM = true, AFTER_DRAIN = false; bf16_t* C;
    __device__ __forceinline__ void operator()(const f32x4 (&acc)[2][2][4][2], const Unit& u, int wr, int wc, int fr, int fq) const {
        const int row0 = u.pm * BM + wr * 64 + fr, col0 = u.pn * BM + wc * 32 + 8 * fq;
#pragma unroll
        for (int ai = 0; ai < 2; ++ai)
#pragma unroll
            for (int m = 0; m < 4; ++m) { bf16_t* rowp = C + (size_t)(row0 + ai * HALF + m * 16) * DM + col0;
#pragma unroll
                for (int bj = 0; bj < 2; ++bj) { const f32x4 v0 = acc[ai][bj][m][0], v1 = acc[ai][bj][m][1];
                    u32x4 w; w.x = cvt_pk_bf16(v0[0], v0[1]); w.y = cvt_pk_bf16(v0[2], v0[3]); w.z = cvt_pk_bf16(v1[0], v1[1]); w.w = cvt_pk_bf16(v1[2], v1[3]); *(u32x4*)(rowp + bj * HALF) = w; } }
    }
};
}
#endif

__device__ __forceinline__ void phase_gemm_in(const Params& p, int l, char* smem) {
    constexpr int N_F = WG / 2;
#ifdef EMU
    constexpr int MT = T / 128, NT1 = NMAIN / 128, N1 = MT * NT1, N2 = 8 * MT;
    for (int task = obid(); task < N1 + N2; task += gridDim.x) {
        if (task < N1) gemm_tile(p, (const bf16*)(p.ws + WS_HNY), (const bf16*)(p.ws + WS_WIN), DM, task / NT1, task % NT1, 0, smem);
        else { const int t2 = task - N1; gemm_tile(p, (const bf16*)(p.ws + WS_WIN) + (size_t)NMAIN * DM, (const bf16*)(p.ws + WS_HNY), DM, t2 / MT, t2 % MT, 2, smem); }
    }
#else
    { const pg8::Gemm g{(const pg8::bf16_t*)(p.ws + WS_HNY), (const pg8::bf16_t*)(p.ws + WS_HNY), 0, 0, DM};
      const pg8::InOrder S{(int)gridDim.x, obid()};
      const pg8::EpiIn E{(pg8::bf16_t*)(p.ws + WS_P), (float*)(p.ws + WS_G), (pg8::bf16_t*)(p.ws + WS_HT)};
      pg8::gemm_phase<pg8::EpiIn, pg8::InOrder, true, true>((PG8_LAS unsigned char*)smem, g, S, E); }
#endif
    for (int task = (int)gridDim.x - 1 - obid(); task < N_F; task += gridDim.x) filt_fft_task(p, task, smem);
}
__device__ __forceinline__ void phase_gemm_out(const Params& p, int l, char* smem) {
    const int G = (int)gridDim.x, bid = obid();
#ifdef EMU
    constexpr int MT = T / 128, NTO = DM / 128;
    for (int task = bid; task < MT * NTO; task += G) {
        const int mt = task / NTO, nt = task % NTO;
        if (l == DEPTH - 1 && (mt % (TOK / 128)) < CTXL / 128) continue;
        gemm_tile(p, (const bf16*)(p.ws + WS_HNY), (const bf16*)(p.ws + WS_WOUT), MIX, mt, nt, 1, smem);
    }
    const int extra = 0;
#else
    const pg8::Gemm g{(const pg8::bf16_t*)(p.ws + WS_HNY), (const pg8::bf16_t*)(p.ws + WS_WOUT), 0, 0, MIX};
    const pg8::OutOrder S{G, bid, l == DEPTH - 1};
    const pg8::EpiOut E{(pg8::bf16_t*)(p.ws + WS_P)};
    pg8::gemm_phase<pg8::EpiOut, pg8::OutOrder, true, true>((PG8_LAS unsigned char*)smem, g, S, E);
    const int nU = (l == DEPTH - 1 ? NB * (SEQ / 256) : T / 256) * (DM / 256); const int extra = nU % G;
#endif
    (void)extra;
}

__device__ __forceinline__ size_t st_index(int mixer, int dir, int b, int h, int cid) { return ((((size_t)(mixer * 2 + dir) * NB + b) * NH + h) * NCH + cid); }
__device__ __forceinline__ size_t ch_index(int dir, int b, int h, int cid) { return (((size_t)dir * NB + b) * NH + h) * NCH + cid; }

__device__ __forceinline__ void load_tile_nat(const bf16* P, int r0, int c0, bf16* dst, float scale, int tid) {
    const int s = tid >> 3, c8 = tid & 7;
    const u32x4 v = *(const u32x4*)(P + (size_t)(r0 + s) * NP + c0 + c8 * 8);
    if (scale == 1.0f) *(u32x4*)(dst + s * LS + c8 * 8) = v;
    else { float f[8]; unpack8(v, f); u32x4 o; o.x = pk2(f[0] * scale, f[1] * scale); o.y = pk2(f[2] * scale, f[3] * scale); o.z = pk2(f[4] * scale, f[5] * scale); o.w = pk2(f[6] * scale, f[7] * scale);
        *(u32x4*)(dst + s * LS + c8 * 8) = o; }
}
__device__ __forceinline__ void load_tile_tr(const bf16* P, int r0, int c0, bf16* dst, int tid) {
    const int s = tid >> 3, c8 = tid & 7;
    const u32x4 v = *(const u32x4*)(P + (size_t)(r0 + s) * NP + c0 + c8 * 8);
    const unsigned w[4] = {v.x, v.y, v.z, v.w};
#pragma unroll
    for (int j = 0; j < 4; ++j) { dst[(c8 * 8 + 2 * j) * LS + s] = (bf16)(w[j] & 0xffffu); dst[(c8 * 8 + 2 * j + 1) * LS + s] = (bf16)(w[j] >> 16); }
}

template <int NTK>
__device__ __forceinline__ void load_span(const bf16* row, int t0, float (&v)[NTK + 2]) {
    v[0] = t0 > 0 ? bf2f(row[-1]) : 0.f; v[NTK + 1] = (t0 + NTK < SEQ) ? bf2f(row[NTK]) : 0.f;
    if constexpr (NTK == 8) { float f[8]; unpack8(*(const u32x4*)row, f);
#pragma unroll
        for (int i = 0; i < 8; ++i) v[1 + i] = f[i]; }
    else {
#pragma unroll
        for (int i = 0; i < NTK; ++i) v[1 + i] = bf2f(row[i]); }
}
template <int NTK>
__device__ __forceinline__ void hy_inputs(const bf16* h0, const bf16* h1, const float* cw, const float* cb, int c, int t0, float (&u0)[NTK], float (&u1)[NTK], float (&g0)[NTK], float (&g1)[NTK]) {
    { float xa[NTK + 2], xb[NTK + 2]; load_span<NTK>(h0 + (size_t)512 * T, t0, xa); load_span<NTK>(h1 + (size_t)512 * T, t0, xb);
        const float w0 = cw[0 * 768 + 512 + c], w1 = cw[1 * 768 + 512 + c], w2 = cw[2 * 768 + 512 + c], bb = cb[512 + c];
        float ga[NTK + 2], gb[NTK + 2]; load_span<NTK>(h0 + (size_t)768 * T, t0, ga); load_span<NTK>(h1 + (size_t)768 * T, t0, gb);
#pragma unroll
        for (int i = 0; i < NTK; ++i) { g0[i] = (w0 * xa[i] + w1 * xa[i + 1] + w2 * xa[i + 2] + bb) * siluf_(ga[i + 1]); g1[i] = (w0 * xb[i] + w1 * xb[i + 1] + w2 * xb[i + 2] + bb) * siluf_(gb[i + 1]); } }
    { float va[NTK + 2], vb[NTK + 2], ya[NTK + 2], yb[NTK + 2];
        load_span<NTK>(h0, t0, va); load_span<NTK>(h1, t0, vb); load_span<NTK>(h0 + (size_t)256 * T, t0, ya); load_span<NTK>(h1 + (size_t)256 * T, t0, yb);
        const float v0 = cw[0 * 768 + c], v1 = cw[1 * 768 + c], v2 = cw[2 * 768 + c], vbias = cb[c];
        const float y0 = cw[0 * 768 + 256 + c], y1 = cw[1 * 768 + 256 + c], y2 = cw[2 * 768 + 256 + c], ybias = cb[256 + c];
#pragma unroll
        for (int i = 0; i < NTK; ++i) { u0[i] = (v0 * va[i] + v1 * va[i + 1] + v2 * va[i + 2] + vbias) * (y0 * ya[i] + y1 * ya[i + 1] + y2 * ya[i + 2] + ybias);
            u1[i] = (v0 * vb[i] + v1 * vb[i + 1] + v2 * vb[i + 2] + vbias) * (y0 * yb[i] + y1 * yb[i + 1] + y2 * yb[i + 2] + ybias); } }
}
__device__ __forceinline__ void hylat_task(const Params& p, int l, int bp, int cp, char* smem) {
    const int tid = otid(), half = tid >> 8, tl = tid & 255, c = 2 * cp + half;
    const bf16* HT = (const bf16*)(p.ws + WS_HT); bf16* Y = (bf16*)(p.ws + WS_HNY);
    cpx* buf = (cpx*)smem + (size_t)half * FBUF;
    const cpx* TW = (const cpx*)(p.ws + WS_TW);
    const cpx* KF = (const cpx*)(p.ws + WS_KF) + (size_t)c * NF;
    constexpr int NTK = SEQ / 256;
    const int t0 = NTK * tl;
    const float* cw = p.in[I_HCW] + (size_t)l * 3 * 768; const float* cb = p.in[I_HCB] + (size_t)l * 768;
    const size_t rb0 = (size_t)(2 * bp) * TOK + CTXL, rb1 = rb0 + TOK;
    const bf16* h0 = HT + (size_t)c * T + rb0 + t0; const bf16* h1 = h0 + TOK;
    { float u0[NTK], u1[NTK], g0[NTK], g1[NTK]; hy_inputs<NTK>(h0, h1, cw, cb, c, t0, u0, u1, g0, g1);
        __syncthreads();
#pragma unroll
        for (int i = 0; i < NTK; ++i) { cpx v; v.x = u0[i]; v.y = u1[i]; buf[FPH(t0 + i)] = v; cpx z = {0.f, 0.f}; buf[FPH(SEQ + t0 + i)] = z; } }
    fft_fwd(buf, TW, tl);
#pragma unroll 2
    for (int i = tl; i < NF; i += 256) buf[FPH(i)] = cmul(buf[FPH(i)], KF[i]);
    fft_inv(buf, TW, tl);
    const float dsk = p.in[I_HD][(size_t)l * WG + c]; const float sc = 1.0f / (float)NF;
    { const int tz = otid() & 255; const int t0z = NTK * tz;
        float u0[NTK], u1[NTK], g0[NTK], g1[NTK]; hy_inputs<NTK>(HT + (size_t)c * T + rb0 + t0z, HT + (size_t)c * T + rb0 + t0z + TOK, cw, cb, c, t0z, u0, u1, g0, g1);
        float o0[NTK], o1[NTK];
#pragma unroll
        for (int i = 0; i < NTK; ++i) { const cpx y = buf[FPH(t0z + i)]; o0[i] = g0[i] * (y.x * sc + u0[i] * dsk); o1[i] = g1[i] * (y.y * sc + u1[i] * dsk); }
        bf16* d0 = (bf16*)(p.ws + WS_HT) + (size_t)(768 + c) * T + rb0 + t0z; bf16* d1 = d0 + TOK;
        if constexpr (NTK == 8) { *(u32x4*)d0 = pack8(o0); *(u32x4*)d1 = pack8(o1); }
        else {
#pragma unroll
            for (int i = 0; i < NTK; ++i) { d0[i] = f2bf(o0[i]); d1[i] = f2bf(o1[i]); } } }
}

constexpr int HCB = 16;
__device__ __forceinline__ void hyctx_task(const Params& p, int l, int b, int cblk, char* smem) {
    const int tid = otid(); const int c0 = cblk * HCB;
    const bf16* HT = (const bf16*)(p.ws + WS_HT); bf16* Y = (bf16*)(p.ws + WS_HNY); const float* HC = (const float*)(p.ws + WS_HC);
    float* raw = (float*)smem;
    float* u = raw + 4 * CTXL * HCB;
    float* og = u + CTXL * HCB;
    float* hcm = og + CTXL * HCB;
    bf16* ob = (bf16*)raw;
    const size_t rb = (size_t)b * TOK;
    const float* cw = p.in[I_HCW] + (size_t)l * 3 * 768; const float* cbias = p.in[I_HCB] + (size_t)l * 768;
    constexpr int WT = CTXL / 32;
    __syncthreads();
    for (int i = tid; i < 4 * HCB * (CTXL / 8); i += NT) { const int k = i / (HCB * (CTXL / 8)), cc = (i / (CTXL / 8)) % HCB, ck = i % (CTXL / 8);
        float f[8]; unpack8(*(const u32x4*)(HT + (size_t)(k * 256 + c0 + cc) * T + rb + ck * 8), f);
#pragma unroll
        for (int j = 0; j < 8; ++j) raw[(k * CTXL + ck * 8 + j) * HCB + cc] = f[j]; }
    for (int i = tid; i < 2 * HCB * (CTXL / 4); i += NT) { const int dir = i / (HCB * (CTXL / 4)), cc = (i / (CTXL / 4)) % HCB, pk = i % (CTXL / 4);
        const f32x4 v = *(const f32x4*)(HC + ((size_t)dir * WG + c0 + cc) * CTXL + pk * 4); const float f[4] = {v.x, v.y, v.z, v.w};
#pragma unroll
        for (int j = 0; j < 4; ++j) { const int pos = pk * 4 + j; if (dir == 0) hcm[(CTXL + pos) * HCB + cc] = f[j]; else if (pos > 0) hcm[(CTXL - pos) * HCB + cc] = f[j]; } }
    if (tid < HCB) hcm[tid] = 0.f;
    __syncthreads();
    for (int i = tid; i < CTXL * HCB; i += NT) { const int t = i / HCB, cc = i % HCB; float cv[3];
#pragma unroll
        for (int k = 0; k < 3; ++k) { const float* rk = raw + k * CTXL * HCB; const int ch = k * 256 + c0 + cc;
            const float a = t > 0 ? rk[(t - 1) * HCB + cc] : 0.f, m = rk[t * HCB + cc], z = t < CTXL - 1 ? rk[(t + 1) * HCB + cc] : 0.f;
            cv[k] = cw[0 * 768 + ch] * a + cw[1 * 768 + ch] * m + cw[2 * 768 + ch] * z + cbias[ch]; }
        u[i] = cv[0] * cv[1];
        og[i] = cv[2] * siluf_(raw[(3 * CTXL + t) * HCB + cc]); }
    __syncthreads();
    { const int cc = tid % HCB, tg = tid / HCB, t0 = WT * tg; float acc[WT], w[WT];
#pragma unroll
        for (int j = 0; j < WT; ++j) { acc[j] = 0.f; w[j] = hcm[(t0 + j + CTXL) * HCB + cc]; }
#pragma unroll 8
        for (int s = 0; s < CTXL; ++s) { const float us = u[s * HCB + cc];
#pragma unroll
            for (int j = 0; j < WT; ++j) acc[j] += us * w[j];
#pragma unroll
            for (int j = WT - 1; j > 0; --j) w[j] = w[j - 1];
            w[0] = hcm[(t0 - s - 1 + CTXL) * HCB + cc]; }
        const float dsk = p.in[I_HD][(size_t)l * WG + c0 + cc];
#pragma unroll
        for (int j = 0; j < WT; ++j) { const int t = t0 + j; ob[t * HCB + cc] = f2bf(og[t * HCB + cc] * (acc[j] + u[t * HCB + cc] * dsk)); } }
    __syncthreads();
    for (int i = tid; i < CTXL * 2; i += NT) { const int t = i >> 1, hh = i & 1; *(u32x4*)(Y + (rb + t) * 1024 + YH + c0 + 8 * hh) = *(const u32x4*)(ob + t * HCB + 8 * hh); }
}

__device__ __forceinline__ void attn_task(const Params& p, int l, int b, int kvh, int qt, bool ctxq, char* smem) {
    const int tid = otid(), lane = tid & 63, wave = tid >> 6, r = lane & 15, q = lane >> 4;
    const bf16* P = (const bf16*)(p.ws + WS_P); bf16* Y = (bf16*)(p.ws + WS_HNY); const cpx* ROPE = (const cpx*)(p.ws + WS_ROPE);
    bf16* Qs = (bf16*)smem;
    bf16* Ks = Qs + 128 * LS;
    bf16* Vt = Ks + 64 * LS;
    bf16* Ps = Vt + 64 * LS;
    const size_t rq0 = (size_t)b * TOK + (ctxq ? 0 : CTXL) + qt * 64;
    __syncthreads();
    {
        const int row = tid >> 2, cpair = tid & 3, g = row >> 6, t = row & 63;
        const bf16* src = P + (rq0 + t) * NP + PD + (kvh * 2 + g) * 64;
        float lo[8], hi[8]; unpack8(*(const u32x4*)(src + cpair * 8), lo); unpack8(*(const u32x4*)(src + 32 + cpair * 8), hi);
        u32x4 o1, o2; float a[8], c2[8];
#pragma unroll
        for (int j = 0; j < 8; ++j) { float cs = 1.f, sn = 0.f; if (!ctxq) { const cpx cv = ROPE[(size_t)(qt * 64 + t) * 32 + cpair * 8 + j]; cs = cv.x; sn = cv.y; }
            a[j] = (lo[j] * cs - hi[j] * sn) * 0.125f; c2[j] = (hi[j] * cs + lo[j] * sn) * 0.125f; }
        o1.x = pk2(a[0], a[1]); o1.y = pk2(a[2], a[3]); o1.z = pk2(a[4], a[5]); o1.w = pk2(a[6], a[7]);
        o2.x = pk2(c2[0], c2[1]); o2.y = pk2(c2[2], c2[3]); o2.z = pk2(c2[4], c2[5]); o2.w = pk2(c2[6], c2[7]);
        *(u32x4*)(Qs + row * LS + cpair * 8) = o1; *(u32x4*)(Qs + row * LS + 32 + cpair * 8) = o2;
    }
    const int lt0 = ctxq ? 0 : (qt - 2 > 0 ? qt - 2 : 0), lt1 = ctxq ? -1 : (qt + 2 < SEQ / 64 - 1 ? qt + 2 : SEQ / 64 - 1);
    const int nloc = lt1 - lt0 + 1, ntiles = nloc + NCC;
    float m[4], lsum[4]; f32x4 O[4];
#pragma unroll
    for (int i = 0; i < 4; ++i) { m[i] = -INFINITY; lsum[i] = 0.f; O[i] = (f32x4){0.f, 0.f, 0.f, 0.f}; }
    const int g = wave >> 2, tq0 = (wave & 3) * 16;
    bf16* Pw = Ps + wave * 16 * LS;
    u32x4 klo = {0u, 0u, 0u, 0u}, khi = klo, vq = klo; f32x4 rp[4] = {(f32x4){1.f, 0.f, 1.f, 0.f}, (f32x4){1.f, 0.f, 1.f, 0.f}, (f32x4){1.f, 0.f, 1.f, 0.f}, (f32x4){1.f, 0.f, 1.f, 0.f}};
    const int ks_ = tid >> 2, kcp = tid & 3, vs_ = tid >> 3, vc8 = tid & 7;
#define ATT_PREFETCH(TI) do { const bool loc_ = (TI) < nloc; const int kt_ = loc_ ? lt0 + (TI) : (TI) - nloc; const size_t rk_ = (size_t)b * TOK + (loc_ ? CTXL : 0) + kt_ * 64; \
        if (tid < 256) { const bf16* src_ = P + (rk_ + ks_) * NP + PD + 256 + kvh * 64; klo = *(const u32x4*)(src_ + kcp * 8); khi = *(const u32x4*)(src_ + 32 + kcp * 8); \
            if (loc_) { const f32x4* rr_ = (const f32x4*)(ROPE + (size_t)(kt_ * 64 + ks_) * 32 + kcp * 8); rp[0] = rr_[0]; rp[1] = rr_[1]; rp[2] = rr_[2]; rp[3] = rr_[3]; } \
            else { rp[0] = rp[1] = rp[2] = rp[3] = (f32x4){1.f, 0.f, 1.f, 0.f}; } } \
        vq = *(const u32x4*)(P + (rk_ + vs_) * NP + PD + 384 + kvh * 64 + vc8 * 8); } while (0)
    ATT_PREFETCH(0);
    for (int ti = 0; ti < ntiles; ++ti) {
        const bool local = ti < nloc; const int kt = local ? lt0 + ti : ti - nloc;
        __syncthreads();
        if (tid < 256) { float lo[8], hi[8]; unpack8(klo, lo); unpack8(khi, hi);
            const float cs[8] = {rp[0].x, rp[0].z, rp[1].x, rp[1].z, rp[2].x, rp[2].z, rp[3].x, rp[3].z}, sn[8] = {rp[0].y, rp[0].w, rp[1].y, rp[1].w, rp[2].y, rp[2].w, rp[3].y, rp[3].w};
            float a[8], c2[8];
#pragma unroll
            for (int j = 0; j < 8; ++j) { a[j] = lo[j] * cs[j] - hi[j] * sn[j]; c2[j] = hi[j] * cs[j] + lo[j] * sn[j]; }
            u32x4 o1, o2;
            o1.x = pk2(a[0], a[1]); o1.y = pk2(a[2], a[3]); o1.z = pk2(a[4], a[5]); o1.w = pk2(a[6], a[7]);
            o2.x = pk2(c2[0], c2[1]); o2.y = pk2(c2[2], c2[3]); o2.z = pk2(c2[4], c2[5]); o2.w = pk2(c2[6], c2[7]);
            *(u32x4*)(Ks + ks_ * LS + kcp * 8) = o1; *(u32x4*)(Ks + ks_ * LS + 32 + kcp * 8) = o2; }
        { const unsigned w[4] = {vq.x, vq.y, vq.z, vq.w};
#pragma unroll
            for (int j = 0; j < 4; ++j) { Vt[(vc8 * 8 + 2 * j) * LS + vs_] = (bf16)(w[j] & 0xffffu); Vt[(vc8 * 8 + 2 * j + 1) * LS + vs_] = (bf16)(w[j] >> 16); } }
        __syncthreads();
        if (ti + 1 < ntiles) ATT_PREFETCH(ti + 1);
        f32x4 S[4] = {(f32x4){0.f, 0.f, 0.f, 0.f}, (f32x4){0.f, 0.f, 0.f, 0.f}, (f32x4){0.f, 0.f, 0.f, 0.f}, (f32x4){0.f, 0.f, 0.f, 0.f}};
        mma_nt<4, 2>(Qs, LS, g * 64 + tq0, Ks, LS, 0, S, lane);
        float rmax[4];
#pragma unroll
        for (int i = 0; i < 4; ++i) { const int qpos = qt * 64 + tq0 + 4 * q + i; float mx = -INFINITY;
#pragma unroll
            for (int nt = 0; nt < 4; ++nt) { if (local) { const int kpos = kt * 64 + nt * 16 + r; const int d = kpos - qpos; if (d > 128 || d < -128) S[nt][i] = -INFINITY; } mx = fmaxf(mx, S[nt][i]); }
            rmax[i] = row16_max(mx); }
#pragma unroll
        for (int i = 0; i < 4; ++i) { const float mn = fmaxf(m[i], rmax[i]); const float alpha = __expf(m[i] - mn); float sm = 0.f;
#pragma unroll
            for (int nt = 0; nt < 4; ++nt) { const float pv = __expf(S[nt][i] - mn); sm += pv; Pw[(4 * q + i) * LS + nt * 16 + r] = f2bf(pv); O[nt][i] *= alpha; }
            sm = row16_sum(sm);
            lsum[i] = lsum[i] * alpha + sm; m[i] = mn; }
        WAVE_SYNC();
        mma_nt<4, 2>(Pw, LS, 0, Vt, LS, 0, O, lane);
    }
#undef ATT_PREFETCH
    const float sink = p.in[I_SINK][(size_t)l * NH + kvh * 2 + g];
    WAVE_SYNC();
#pragma unroll
    for (int i = 0; i < 4; ++i) { const float den = lsum[i] + __expf(sink - m[i]); const float inv = frcp_(den);
#pragma unroll
        for (int nt = 0; nt < 4; ++nt) Pw[(4 * q + i) * LS + nt * 16 + r] = f2bf(O[nt][i] * inv); }
    WAVE_SYNC();
#pragma unroll
    for (int hh = 0; hh < 2; ++hh) { const int t = lane >> 2, ck = (lane & 3) * 2 + hh;
        float fo[8], fg[8]; unpack8(*(const u32x4*)(Pw + t * LS + ck * 8), fo);
        unpack8(*(const u32x4*)(P + (rq0 + tq0 + t) * NP + PD + 512 + (kvh * 2 + g) * 64 + ck * 8), fg);
#pragma unroll
        for (int j = 0; j < 8; ++j) fo[j] *= siluf_(fg[j]);
        *(u32x4*)(Y + (rq0 + tq0 + t) * 1024 + YD + (kvh * 2 + g) * 64 + ck * 8) = pack8(fo); }
}

#ifdef EMU
__device__ __forceinline__ int olane(int lane) { return lane; }
#else
__device__ __forceinline__ int olane(int lane) { asm volatile("" : "+v"(lane)); return lane; }
#endif
constexpr int WLDS = (LDS_BYTES - 64) / 8 / 16 * 16;
__device__ __forceinline__ void load_nat_tile(const bf16* P, int row0, int col0, bf16* tile, int lane) {
    u32x4 v[8];
#pragma unroll
    for (int i = 0; i < 8; ++i) v[i] = *(const u32x4*)(P + (size_t)(row0 + (lane >> 3) + 8 * i) * NP + col0 + (lane & 7) * 8);
#pragma unroll
    for (int i = 0; i < 8; ++i) *(u32x4*)(tile + swz((lane >> 3) + 8 * i, lane & 7)) = v[i];
}
__device__ __forceinline__ bf16x8 frag_tr(const bf16* tile, int c0, int k0, int lane) {
    const int c = c0 + (lane & 15), kb = k0 + 8 * (lane >> 4); unsigned w[4];
#pragma unroll
    for (int j = 0; j < 4; ++j) w[j] = (unsigned)tile[swz(kb + 2 * j, c >> 3) + (c & 7)] | ((unsigned)tile[swz(kb + 2 * j + 1, c >> 3) + (c & 7)] << 16);
    u32x4 o; o.x = w[0]; o.y = w[1]; o.z = w[2]; o.w = w[3]; return as_frag(o);
}
template <int DIR>
__device__ __forceinline__ void gla_r_frags(const float* Grow0, int lane, bf16x8 (&af)[4]) {
    const int r = lane & 15, q4 = lane >> 4;
#pragma unroll
    for (int mt = 0; mt < 4; ++mt) { u32x4 o = {0u, 0u, 0u, 0u};
        if (q4 < 2) o = *(const u32x4*)((const bf16*)(Grow0 + (size_t)(16 * mt + r) * NGS + 16) + DIR * 16 + 8 * q4);
        af[mt] = as_frag(o); }
}
template <int DIR>
__device__ __forceinline__ float gla_b_col(const Params& p, int l, int h, const bf16x8 (&af)[4], int nt, int lane_, float (&x)[4][4]) {
    const int lane = olane(lane_), r = lane & 15, q4 = lane >> 4, d = h * 64 + 16 * nt + r;
    u32x4 o = {0u, 0u, 0u, 0u};
    if (q4 < 2) { const float* wa = p.in[I_GWA] + ((size_t)(l * 2 + DIR) * 16 + 8 * q4) * WG + d;
        o.x = pk2(wa[0], wa[WG]); o.y = pk2(wa[2 * WG], wa[3 * WG]); o.z = pk2(wa[4 * WG], wa[5 * WG]); o.w = pk2(wa[6 * WG], wa[7 * WG]); }
    const bf16x8 bfr = as_frag(o); const float bias = p.in[I_GBA][(size_t)(l * 2 + DIR) * WG + d];
#pragma unroll
    for (int mt = 0; mt < 4; ++mt) { f32x4 c = {bias, bias, bias, bias}; c = MFMA16(af[mt], bfr, c);
#pragma unroll
        for (int i = 0; i < 4; ++i) x[mt][i] = logsig_fast(c[i]) * (1.0f / 16.0f); }
    float carry = 0.f;
#pragma unroll
    for (int k = 0; k < 4; ++k) { const int mt = DIR == 0 ? k : 3 - k; float* y = x[mt];
        if (DIR == 0) { y[1] += y[0]; y[2] += y[1]; y[3] += y[2]; } else { y[2] += y[3]; y[1] += y[2]; y[0] += y[1]; }
        const float s4 = DIR == 0 ? y[3] : y[0];
        const float t1 = DIR == 0 ? __shfl_up(s4, 16) : __shfl_down(s4, 16), t2 = DIR == 0 ? __shfl_up(s4, 32) : __shfl_down(s4, 32), t3 = DIR == 0 ? __shfl_up(s4, 48) : __shfl_down(s4, 48);
        const int qq = DIR == 0 ? q4 : 3 - q4;
        const float e = (qq >= 1 ? t1 : 0.f) + (qq >= 2 ? t2 : 0.f) + (qq >= 3 ? t3 : 0.f);
        const float tot = __shfl(e + s4, DIR == 0 ? r + 48 : r);
#pragma unroll
        for (int i = 0; i < 4; ++i) y[i] += carry + e;
        carry += tot; }
    return carry;
}

template <int MIXER, int DIR>
__device__ __forceinline__ void chunkst_dir(const Params& p, int l, int b, int h, int cid, const float* Grow0, const unsigned (&kk)[32], const bf16* Vt, bf16* Kt, const float* wvs, float* bendl, int lane_) {
    const int lane = olane(lane_), r = lane & 15, q4 = lane >> 4;
    if constexpr (MIXER == 0) {
        float nacc = 0.f;
#pragma unroll
        for (int c = 0; c < 8; ++c) { float f[8];
#pragma unroll
            for (int j = 0; j < 8; ++j) { const int s = 8 * c + j; const float kv = (s & 1) ? bitsf(kk[s >> 1] & 0xffff0000u) : bitsf(kk[s >> 1] << 16);
                f[j] = kv * 0.125f * wvs[DIR * 64 + s]; nacc += f[j]; }
            *(u32x4*)(Kt + swz(lane, c)) = pack8(f); }
        ((float*)(p.ws + WS_NV))[ch_index(DIR, b, h, cid) * 64 + lane] = nacc;
    } else {
        const bf16* P = (const bf16*)(p.ws + WS_P); const int kcol = PG + 256 + h * 64; const int r0 = b * TOK + cid * 64;
        bf16x8 af[4]; gla_r_frags<DIR>(Grow0, lane, af);
#pragma unroll 2
        for (int nt = 0; nt < 4; ++nt) { const int d = 16 * nt + r; float x[4][4];
            const float bend = gla_b_col<DIR>(p, l, h, af, nt, lane, x);
            if (q4 == 0) { ((float*)(p.ws + WS_BE))[ch_index(DIR, b, h, cid) * 64 + d] = bend; bendl[d] = __expf(fmaxf(bend, -80.0f)); }
#pragma unroll
            for (int mt = 0; mt < 4; ++mt)
#pragma unroll
                for (int i = 0; i < 4; ++i) { const int s = 16 * mt + 4 * q4 + i; const float kv = bf2f(P[(size_t)(r0 + s) * NP + kcol + d]); const float bc = fmaxf(x[mt][i], -80.0f);
                    Kt[swz(d, s >> 3) + (s & 7)] = f2bf(kv * __expf(-bc));
                    ((bf16*)(p.ws + WS_EQ))[((size_t)DIR * T + r0 + s) * WG + h * 64 + d] = f2bf(__expf(bc)); } }
    }
    WAVE_SYNC();
    bf16x8 vf[4][2];
#pragma unroll
    for (int ne = 0; ne < 4; ++ne)
#pragma unroll
        for (int ks = 0; ks < 2; ++ks) vf[ne][ks] = *(const bf16x8*)(Vt + swz(16 * ne + r, ks * 4 + q4));
    bf16* dst = (bf16*)(p.ws + WS_ST) + st_index(MIXER, DIR, b, h, cid) * 4096;
#pragma unroll
    for (int me = 0; me < 4; ++me) {
        f32x4 acc[4] = {(f32x4){0.f, 0.f, 0.f, 0.f}, (f32x4){0.f, 0.f, 0.f, 0.f}, (f32x4){0.f, 0.f, 0.f, 0.f}, (f32x4){0.f, 0.f, 0.f, 0.f}};
#pragma unroll
        for (int ks = 0; ks < 2; ++ks) { const bf16x8 a = *(const bf16x8*)(Kt + swz(16 * me + r, ks * 4 + q4));
#pragma unroll
            for (int ne = 0; ne < 4; ++ne) acc[ne] = MFMA16(a, vf[ne][ks], acc[ne]); }
        f32x4 sc4 = {1.f, 1.f, 1.f, 1.f}; if constexpr (MIXER == 1) sc4 = *(const f32x4*)(bendl + 16 * me + 4 * q4);
#pragma unroll
        for (int ne = 0; ne < 4; ++ne) { const f32x4 v = acc[ne] * sc4; u32x2 o; o.x = pk2(v[0], v[1]); o.y = pk2(v[2], v[3]); *(u32x2*)(dst + (16 * ne + r) * 64 + 16 * me + 4 * q4) = o; }
    }
    WAVE_SYNC();
}
template <int MIXER>
__device__ __forceinline__ void chunkst_w(const Params& p, int l, int b, int h, int cid, char* wl, int lane) {
    const bf16* P = (const bf16*)(p.ws + WS_P); const float* G = (const float*)(p.ws + WS_G);
    const int r0 = b * TOK + cid * 64, r = lane & 15, q4 = lane >> 4;
    bf16* Kt = (bf16*)wl;
    bf16* Vt = Kt + 4096;
    float* wvs = (float*)(Vt + 4096);
    float* bendl = wvs + 128;
    const int kcol = (MIXER == 0 ? PA : PG) + 256 + h * 64, vcol = (MIXER == 0 ? PA : PG) + 512 + h * 64;
    const float* Grow0 = G + (size_t)r0 * NGS;
    { bf16* Nn = Kt;
        load_nat_tile(P, r0, vcol, Nn, lane);
        WAVE_SYNC();
#pragma unroll
        for (int c = 0; c < 8; ++c) { unsigned w[4];
#pragma unroll
            for (int j = 0; j < 4; ++j) w[j] = (unsigned)Nn[swz(8 * c + 2 * j, lane >> 3) + (lane & 7)] | ((unsigned)Nn[swz(8 * c + 2 * j + 1, lane >> 3) + (lane & 7)] << 16);
            u32x4 o; o.x = w[0]; o.y = w[1]; o.z = w[2]; o.w = w[3]; *(u32x4*)(Vt + swz(lane, c)) = o; }
        WAVE_SYNC();
        load_nat_tile(P, r0, kcol, Nn, lane);
        WAVE_SYNC(); }
    unsigned kk[32];
    { const bf16* Nn = Kt;
#pragma unroll
        for (int i = 0; i < 32; ++i) kk[i] = (unsigned)Nn[swz(2 * i, lane >> 3) + (lane & 7)] | ((unsigned)Nn[swz(2 * i + 1, lane >> 3) + (lane & 7)] << 16); }
    WAVE_SYNC();
    if constexpr (MIXER == 0) {
        const float* g = Grow0 + (size_t)lane * NGS; const float* gb = p.in[I_MGB] + (size_t)l * 16;
        const float i_f = g[h] + gb[h], f_f = g[4 + h] + gb[4 + h], i_b = g[8 + h] + gb[8 + h], f_b = g[12 + h] + gb[12 + h];
        const float lf = logsigf_(f_f), lb = logsigf_(f_b);
        const float bF = wave_prefix_sum(lf, lane), totF = __shfl(bF, 63);
        const float gF = totF - bF + i_f, mF = wave_max(gF);
        const float totB = wave_sum(lb), preB = wave_prefix_sum(lb, lane), bB = totB - preB + lb;
        const float gB = totB - bB + i_b, mB = wave_max(gB);
        wvs[lane] = __expf(gF - mF); wvs[64 + lane] = __expf(gB - mB);
        if (lane == 0) { float* SC = (float*)(p.ws + WS_SC);
            SC[ch_index(0, b, h, cid) * 4 + 0] = totF; SC[ch_index(0, b, h, cid) * 4 + 1] = mF;
            SC[ch_index(1, b, h, cid) * 4 + 0] = totB; SC[ch_index(1, b, h, cid) * 4 + 1] = mB; }
    }
    WAVE_SYNC();
    chunkst_dir<MIXER, 0>(p, l, b, h, cid, Grow0, kk, Vt, Kt, wvs, bendl, lane);
    chunkst_dir<MIXER, 1>(p, l, b, h, cid, Grow0, kk, Vt, Kt, wvs, bendl, lane);
}

template <int DIR>
__device__ __forceinline__ void chunkst_gla(const Params& p, int l, int b, int h, int cid, char* wl, int lane_) {
    const bf16* P = (const bf16*)(p.ws + WS_P);
    const int lane = olane(lane_), r0 = b * TOK + cid * 64, r = lane & 15, q4 = lane >> 4;
    bf16* Kt = (bf16*)wl;
    bf16* An = Kt + 4096;
    float* bendl = (float*)(An + 4096);
    const int kcol = PG + 256 + h * 64, vcol = PG + 512 + h * 64;
    const float* Grow0 = (const float*)(p.ws + WS_G) + (size_t)r0 * NGS;
    load_nat_tile(P, r0, vcol, An, lane);
    WAVE_SYNC();
    bf16x8 vf[4][2];
#pragma unroll
    for (int ne = 0; ne < 4; ++ne)
#pragma unroll
        for (int ks = 0; ks < 2; ++ks) vf[ne][ks] = frag_tr(An, 16 * ne, 32 * ks, lane);
    WAVE_SYNC();
    load_nat_tile(P, r0, kcol, An, lane);
    WAVE_SYNC();
    bf16x8 af[4]; gla_r_frags<DIR>(Grow0, lane, af);
#pragma unroll 2
    for (int nt = 0; nt < 4; ++nt) { const int d = 16 * nt + r; float x[4][4];
        const float bend = gla_b_col<DIR>(p, l, h, af, nt, lane, x);
        if (q4 == 0) { ((float*)(p.ws + WS_BE))[ch_index(DIR, b, h, cid) * 64 + d] = bend; bendl[d] = __expf(fmaxf(bend, -80.0f)); }
#pragma unroll
        for (int mt = 0; mt < 4; ++mt)
#pragma unroll
            for (int i = 0; i < 4; ++i) { const int s = 16 * mt + 4 * q4 + i; bf16* ke = An + swz(s, d >> 3) + (d & 7); const float kv = bf2f(*ke); const float bc = fmaxf(x[mt][i], -80.0f);
                Kt[swz(d, s >> 3) + (s & 7)] = f2bf(kv * __expf(-bc));
                *ke = f2bf(__expf(bc)); } }
    WAVE_SYNC();
    { bf16* EQg = (bf16*)(p.ws + WS_EQ) + ((size_t)DIR * T + r0) * WG + h * 64;
#pragma unroll
        for (int i = 0; i < 8; ++i) { const int s = (lane >> 3) + 8 * i, ck = lane & 7; *(u32x4*)(EQg + (size_t)s * WG + ck * 8) = *(const u32x4*)(An + swz(s, ck)); } }
    bf16* dst = (bf16*)(p.ws + WS_ST) + st_index(1, DIR, b, h, cid) * 4096;
#pragma unroll
    for (int me = 0; me < 4; ++me) {
        f32x4 acc[4] = {(f32x4){0.f, 0.f, 0.f, 0.f}, (f32x4){0.f, 0.f, 0.f, 0.f}, (f32x4){0.f, 0.f, 0.f, 0.f}, (f32x4){0.f, 0.f, 0.f, 0.f}};
#pragma unroll
        for (int ks = 0; ks < 2; ++ks) { const bf16x8 a = *(const bf16x8*)(Kt + swz(16 * me + r, ks * 4 + q4));
#pragma unroll
            for (int ne = 0; ne < 4; ++ne) acc[ne] = MFMA16(a, vf[ne][ks], acc[ne]); }
        const f32x4 sc4 = *(const f32x4*)(bendl + 16 * me + 4 * q4);
#pragma unroll
        for (int ne = 0; ne < 4; ++ne) { const f32x4 v = acc[ne] * sc4; u32x2 o; o.x = pk2(v[0], v[1]); o.y = pk2(v[2], v[3]); *(u32x2*)(dst + (16 * ne + r) * 64 + 16 * me + 4 * q4) = o; }
    }
    WAVE_SYNC();
}

template <int MIXER, int DIR>
__device__ __forceinline__ void chunkout_prep(const Params& p, int l, int b, int h, int cid, const float* Grow0, int r0, int pbase, const bf16* EQ, float* gar, int lane_) {
    const int lane = olane(lane_);
    if constexpr (MIXER == 0) {
        const bf16* P = (const bf16*)(p.ws + WS_P);
        const float* g = Grow0 + (size_t)lane * NGS; const float* gb = p.in[I_MGB] + (size_t)l * 16;
        const float ig = g[DIR * 8 + h] + gb[DIR * 8 + h], fg = g[DIR * 8 + 4 + h] + gb[DIR * 8 + 4 + h];
        const float mprev = ((const float*)(p.ws + WS_SC))[ch_index(DIR, b, h, cid) * 4 + 2];
        const float lf = logsigf_(fg); float bb;
        if (DIR == 0) bb = wave_prefix_sum(lf, lane); else { const float tt = wave_sum(lf), pre = wave_prefix_sum(lf, lane); bb = tt - pre + lf; }
        const float a = ig - bb; const float pm = DIR == 0 ? wave_prefix_max(a, lane) : wave_suffix_max(a, lane);
        const float mt_ = fmaxf(bb + mprev, bb + pm);
        float* ga = gar + DIR * 320;
        ga[lane] = bb - mt_; ga[64 + lane] = a; ga[128 + lane] = __expf(bb + mprev - mt_); ga[192 + lane] = __expf(-mt_);
        float* nvl = gar + 640 + DIR * 64;
        nvl[lane] = ((const float*)(p.ws + WS_NV))[ch_index(DIR, b, h, cid) * 64 + lane];
        WAVE_SYNC();
        float dq = 0.f;
#pragma unroll
        for (int c = 0; c < 8; ++c) { float f[8]; unpack8(*(const u32x4*)(P + (size_t)(r0 + lane) * NP + pbase + c * 8), f);
            const f32x4 n0 = *(const f32x4*)(nvl + c * 8), n1 = *(const f32x4*)(nvl + c * 8 + 4);
            dq += f[0] * n0.x + f[1] * n0.y + f[2] * n0.z + f[3] * n0.w + f[4] * n1.x + f[5] * n1.y + f[6] * n1.z + f[7] * n1.w; }
        ga[256 + lane] = dq;
    }
}
template <int MIXER, int DIR, int NS>
__device__ __forceinline__ void chunkout_dir(const Params& p, int b, int h, int cid, int r0, int pbase, int th, const bf16x8 (&vtf)[4][2], const bf16* VtL, const bf16* EQ, bf16* SB, const float* gar, float* rsm, f32x4 (&htot)[NS][4], int lane_) {
    const bf16* P = (const bf16*)(p.ws + WS_P); const bf16* ST = (const bf16*)(p.ws + WS_ST);
    const int lane = olane(lane_), r = lane & 15, q4 = lane >> 4;
    const bf16* E = EQ + ((size_t)DIR * T + r0) * WG + h * 64;
    const float* ga = gar + DIR * 320;
    bf16x8 kf[4][2], ctf[4][2];
#pragma unroll
    for (int n = 0; n < 4; ++n)
#pragma unroll
        for (int ks = 0; ks < 2; ++ks) { kf[n][ks] = *(const bf16x8*)(P + (size_t)(r0 + 16 * n + r) * NP + pbase + 256 + ks * 32 + q4 * 8);
            ctf[n][ks] = *(const bf16x8*)(ST + st_index(MIXER, DIR, b, h, cid) * 4096 + (16 * n + r) * 64 + ks * 32 + q4 * 8);
            if constexpr (MIXER == 1) { float fe[8], fk[8]; unpack8(*(const u32x4*)(E + (size_t)(16 * n + r) * WG + ks * 32 + q4 * 8), fe); unpack8(as_u4(kf[n][ks]), fk);
#pragma unroll
                for (int j = 0; j < 8; ++j) fk[j] = fk[j] * frcp_(fe[j]);
                kf[n][ks] = as_frag(pack8(fk)); } }
#pragma unroll
    for (int ms = 0; ms < NS; ++ms) { const int mt = NS * th + ms;
        bf16x8 qf[2];
#pragma unroll
        for (int ks = 0; ks < 2; ++ks) { qf[ks] = *(const bf16x8*)(P + (size_t)(r0 + 16 * mt + r) * NP + pbase + ks * 32 + q4 * 8);
            if constexpr (MIXER == 1) { float fe[8], fq[8]; unpack8(*(const u32x4*)(E + (size_t)(16 * mt + r) * WG + ks * 32 + q4 * 8), fe); unpack8(as_u4(qf[ks]), fq);
#pragma unroll
                for (int j = 0; j < 8; ++j) fq[j] *= 0.125f * fe[j];
                qf[ks] = as_frag(pack8(fq)); } }
        f32x4 S[4] = {(f32x4){0.f, 0.f, 0.f, 0.f}, (f32x4){0.f, 0.f, 0.f, 0.f}, (f32x4){0.f, 0.f, 0.f, 0.f}, (f32x4){0.f, 0.f, 0.f, 0.f}};
#pragma unroll
        for (int ks = 0; ks < 2; ++ks)
#pragma unroll
            for (int n = 0; n < 4; ++n) S[n] = MFMA16(qf[ks], kf[n][ks], S[n]);
#pragma unroll
        for (int i = 0; i < 4; ++i) { const int t = 16 * mt + 4 * q4 + i; float sm = 0.f;
#pragma unroll
            for (int n = 0; n < 4; ++n) { const int s = 16 * n + r; const bool ok = DIR == 0 ? (s <= t) : (s >= t); float v = 0.f;
                if (ok) { if constexpr (MIXER == 0) v = S[n][i] * 0.125f * __expf(ga[t] + ga[64 + s]); else v = S[n][i]; }
                SB[swz(4 * q4 + i, s >> 3) + (s & 7)] = f2bf(v); sm += v; }
            if constexpr (MIXER == 0) { sm = row16_sum(sm); if (r == 0) rsm[4 * q4 + i] = sm; } }
        WAVE_SYNC();
        const bf16x8 sm0 = *(const bf16x8*)(SB + swz(r, q4)), sm1 = *(const bf16x8*)(SB + swz(r, 4 + q4));
        float wi = 1.f, inv = 1.f;
        if constexpr (MIXER == 0) { const int tt = 16 * mt + r; wi = ga[128 + tt]; const float den = wi * ga[256 + tt] + rsm[r]; inv = frcp_(fmaxf(fabsf(den), ga[192 + tt])); }
#pragma unroll
        for (int me = 0; me < 4; ++me) { f32x4 a1 = {0.f, 0.f, 0.f, 0.f}, a2 = {0.f, 0.f, 0.f, 0.f};
            a1 = MFMA16(*(const bf16x8*)(VtL + swz(16 * me + r, q4)), sm0, a1); a1 = MFMA16(*(const bf16x8*)(VtL + swz(16 * me + r, 4 + q4)), sm1, a1);
            a2 = MFMA16(ctf[me][0], qf[0], a2); a2 = MFMA16(ctf[me][1], qf[1], a2);
            if constexpr (MIXER == 0) htot[ms][me] += (a1 + a2 * wi) * inv; else htot[ms][me] += a1 + a2; }
        WAVE_SYNC();
    }
}
__device__ __forceinline__ void co_build_vt(const bf16* P, int r0, int vcol, bf16* VtL, int lane) {
    bf16* Nn = VtL + 4096;
#pragma unroll
    for (int hh = 0; hh < 2; ++hh) {
        u32x4 v[4];
#pragma unroll
        for (int i = 0; i < 4; ++i) v[i] = *(const u32x4*)(P + (size_t)(r0 + 32 * hh + (lane >> 3) + 8 * i) * NP + vcol + (lane & 7) * 8);
#pragma unroll
        for (int i = 0; i < 4; ++i) *(u32x4*)(Nn + swz((lane >> 3) + 8 * i, lane & 7)) = v[i];
        WAVE_SYNC();
#pragma unroll
        for (int c = 0; c < 4; ++c) { unsigned w[4];
#pragma unroll
            for (int j = 0; j < 4; ++j) w[j] = (unsigned)Nn[swz(8 * c + 2 * j, lane >> 3) + (lane & 7)] | ((unsigned)Nn[swz(8 * c + 2 * j + 1, lane >> 3) + (lane & 7)] << 16);
            u32x4 o; o.x = w[0]; o.y = w[1]; o.z = w[2]; o.w = w[3]; *(u32x4*)(VtL + swz(lane, 4 * hh + c)) = o; }
        WAVE_SYNC(); }
}
template <int MIXER, int NS>
__device__ __forceinline__ void co_finalize(const Params& p, int l, int h, int r0, int pbase, int mt0, f32x4 (&htot)[NS][4], int lane_) {
    const bf16* P = (const bf16*)(p.ws + WS_P); bf16* Y = (bf16*)(p.ws + WS_HNY);
    const float* ngp = p.in[MIXER == 0 ? I_MNG : I_GNG] + (size_t)l * WG + h * 64;
    const int lz = olane(lane_), r = lz & 15, q4 = lz >> 4;
    u32x2 gq[NS][4], oq[NS][4];
#pragma unroll
    for (int ms = 0; ms < NS; ++ms)
#pragma unroll
        for (int me = 0; me < 4; ++me) { const size_t off = (size_t)(r0 + 16 * (mt0 + ms) + r) * NP + pbase + 16 * me + 4 * q4;
            gq[ms][me] = *(const u32x2*)(P + off + (MIXER == 0 ? 1024 : 768)); if constexpr (MIXER == 0) oq[ms][me] = *(const u32x2*)(P + off + 768); else oq[ms][me] = (u32x2){0u, 0u}; }
#pragma unroll
    for (int ms = 0; ms < NS; ++ms) { const int mt = mt0 + ms; float ss = 0.f; float gv[4][4];
#pragma unroll
        for (int me = 0; me < 4; ++me) {
            gv[me][0] = bitsf(gq[ms][me].x << 16); gv[me][1] = bitsf(gq[ms][me].x & 0xffff0000u); gv[me][2] = bitsf(gq[ms][me].y << 16); gv[me][3] = bitsf(gq[ms][me].y & 0xffff0000u);
            if constexpr (MIXER == 0) { htot[ms][me][0] *= sigmoidf_(bitsf(oq[ms][me].x << 16)); htot[ms][me][1] *= sigmoidf_(bitsf(oq[ms][me].x & 0xffff0000u)); htot[ms][me][2] *= sigmoidf_(bitsf(oq[ms][me].y << 16)); htot[ms][me][3] *= sigmoidf_(bitsf(oq[ms][me].y & 0xffff0000u)); }
            ss += htot[ms][me][0] * htot[ms][me][0] + htot[ms][me][1] * htot[ms][me][1] + htot[ms][me][2] * htot[ms][me][2] + htot[ms][me][3] * htot[ms][me][3]; }
        ss = xrow_sum(ss);
        const float rstd = rsqrtf(ss * (1.0f / 64.0f) + EPS);
#pragma unroll
        for (int me = 0; me < 4; ++me) { const int e = 16 * me + 4 * q4; const f32x4 n4 = *(const f32x4*)(ngp + e);
            u32x2 o; o.x = pk2(htot[ms][me][0] * rstd * n4.x * siluf_(gv[me][0]), htot[ms][me][1] * rstd * n4.y * siluf_(gv[me][1]));
            o.y = pk2(htot[ms][me][2] * rstd * n4.z * siluf_(gv[me][2]), htot[ms][me][3] * rstd * n4.w * siluf_(gv[me][3]));
            *(u32x2*)(Y + (size_t)(r0 + 16 * mt + r) * 1024 + (MIXER == 0 ? YA : YG) + h * 64 + e) = o; } }
}
template <int MIXER>
__device__ __forceinline__ void chunkout_w(const Params& p, int l, int b, int h, int cid, char* wl, int lane) {
    const bf16* P = (const bf16*)(p.ws + WS_P); const float* G = (const float*)(p.ws + WS_G);
    const int r0 = b * TOK + cid * 64;
    const int pbase = (MIXER == 0 ? PA : PG) + h * 64;
    bf16* SB = (bf16*)wl;
    float* rsm = (float*)(SB + 1024);
    float* gar = rsm + 16;
    const bf16* EQ = (const bf16*)(p.ws + WS_EQ);
    const float* Grow0 = G + (size_t)r0 * NGS;
    bf16* VtL = (bf16*)(gar + 768);
    bf16x8 vtf[4][2];
#pragma unroll
    for (int me = 0; me < 4; ++me) { vtf[me][0] = (bf16x8){0, 0, 0, 0, 0, 0, 0, 0}; vtf[me][1] = vtf[me][0]; }
    co_build_vt(P, r0, pbase + 512, VtL, lane);
    chunkout_prep<MIXER, 0>(p, l, b, h, cid, Grow0, r0, pbase, EQ, gar, lane);
    chunkout_prep<MIXER, 1>(p, l, b, h, cid, Grow0, r0, pbase, EQ, gar, lane);
    WAVE_SYNC();
    constexpr int NS = MIXER == 1 ? 2 : 1;
#pragma unroll 1
    for (int th = 0; th < 4 / NS; ++th) {
        f32x4 htot[NS][4];
#pragma unroll
        for (int a = 0; a < NS; ++a)
#pragma unroll
            for (int c = 0; c < 4; ++c) htot[a][c] = (f32x4){0.f, 0.f, 0.f, 0.f};
        chunkout_dir<MIXER, 0, NS>(p, b, h, cid, r0, pbase, th, vtf, VtL, EQ, SB, gar, rsm, htot, lane);
        chunkout_dir<MIXER, 1, NS>(p, b, h, cid, r0, pbase, th, vtf, VtL, EQ, SB, gar, rsm, htot, lane);
        co_finalize<MIXER, NS>(p, l, h, r0, pbase, NS * th, htot, lane);
    }
}
constexpr int CO_PART = 13376;
template <int MIXER, int DIR>
__device__ __forceinline__ void chunkout_piece(const Params& p, int l, int b, int h, int cid, int mt, char* wl, int lane) {
    const bf16* P = (const bf16*)(p.ws + WS_P); const float* G = (const float*)(p.ws + WS_G);
    const int r0 = b * TOK + cid * 64; const int pbase = (MIXER == 0 ? PA : PG) + h * 64;
    bf16* SB = (bf16*)wl; float* rsm = (float*)(SB + 1024); float* gar = rsm + 16; const bf16* EQ = (const bf16*)(p.ws + WS_EQ);
    const float* Grow0 = G + (size_t)r0 * NGS; bf16* VtL = (bf16*)(gar + 768);
    bf16x8 vtf[4][2];
#pragma unroll
    for (int me = 0; me < 4; ++me) { vtf[me][0] = (bf16x8){0, 0, 0, 0, 0, 0, 0, 0}; vtf[me][1] = vtf[me][0]; }
    co_build_vt(P, r0, pbase + 512, VtL, lane);
    chunkout_prep<MIXER, DIR>(p, l, b, h, cid, Grow0, r0, pbase, EQ, gar, lane);
    WAVE_SYNC();
    f32x4 htot[1][4] = {{(f32x4){0.f, 0.f, 0.f, 0.f}, (f32x4){0.f, 0.f, 0.f, 0.f}, (f32x4){0.f, 0.f, 0.f, 0.f}, (f32x4){0.f, 0.f, 0.f, 0.f}}};
    chunkout_dir<MIXER, DIR, 1>(p, b, h, cid, r0, pbase, mt, vtf, VtL, EQ, SB, gar, rsm, htot, lane);
    float* part = (float*)(wl + CO_PART);
#pragma unroll
    for (int me = 0; me < 4; ++me)
#pragma unroll
        for (int i = 0; i < 4; ++i) part[(me * 4 + i) * 64 + lane] = htot[0][me][i];
}
template <int MIXER>
__device__ __forceinline__ void chunkout_combine(const Params& p, int l, int b, int h, int cid, int mt, const char* smem, int lane) {
    const float* pa = (const float*)(smem + (2 * mt) * WLDS + CO_PART); const float* pb = (const float*)(smem + (2 * mt + 1) * WLDS + CO_PART);
    f32x4 htot[1][4];
#pragma unroll
    for (int me = 0; me < 4; ++me)
#pragma unroll
        for (int i = 0; i < 4; ++i) htot[0][me][i] = pa[(me * 4 + i) * 64 + lane] + pb[(me * 4 + i) * 64 + lane];
    co_finalize<MIXER, 1>(p, l, h, b * TOK + cid * 64, (MIXER == 0 ? PA : PG) + h * 64, mt, htot, lane);
}

template <bool OUT>
__device__ __forceinline__ void chunk_workers(const Params& p, int l, char* smem) {
    const int tid = otid(), lane = tid & 63, wave = __builtin_amdgcn_readfirstlane(tid >> 6);
    const int NW = (int)gridDim.x * 8, wi = wave * (int)gridDim.x + obid();
    const int c_lo = (OUT && l == DEPTH - 1) ? NCC : 0, npc = NCH - c_lo, half = NB * NH * npc;
    char* wl = smem + wave * WLDS;
    if (OUT) {
        const int cl = NCC, npl = NCH - NCC, halfl = NB * NH * npl;
#pragma unroll 1
        for (int t = wi; t < halfl; t += NW) { const int b = t / (NH * npl), h = (t / npl) % NH, cid = cl + t % npl;
            const Params q = relaunder(p); chunkout_w<1>(q, l, b, h, cid, wl, lane); }
        { const int used = halfl % NW;
#pragma unroll 1
            for (int t = (wi + NW - used) % NW; t < halfl; t += NW) { const int b = t / (NH * npl), h = (t / npl) % NH, cid = cl + t % npl;
                const Params q = relaunder(p); chunkout_w<0>(q, l, b, h, cid, wl, lane); } }
        if (l < DEPTH - 1) {
            const int nct = NB * NH * NCC;
#pragma unroll 1
            for (int st = obid(); st < 2 * nct; st += (int)gridDim.x) { const int mixer = st / nct, r2 = st % nct, b = r2 / (NH * NCC), h = (r2 / NCC) % NH, cid = r2 % NCC;
                const Params q = relaunder(p); const int mt = wave >> 1;
                __syncthreads();
                if (mixer == 0) { if (wave & 1) chunkout_piece<0, 1>(q, l, b, h, cid, mt, wl, lane); else chunkout_piece<0, 0>(q, l, b, h, cid, mt, wl, lane); }
                else            { if (wave & 1) chunkout_piece<1, 1>(q, l, b, h, cid, mt, wl, lane); else chunkout_piece<1, 0>(q, l, b, h, cid, mt, wl, lane); }
                __syncthreads();
                if (wave < 4) { if (mixer == 0) chunkout_combine<0>(q, l, b, h, cid, wave, smem, lane); else chunkout_combine<1>(q, l, b, h, cid, wave, smem, lane); }
            }
        }
    } else {
        int off = 0;
#pragma unroll 1
        for (int t = wi; t < half; t += NW) { const int b = t / (NH * npc), h = (t / npc) % NH, cid = c_lo + t % npc;
            const Params q = relaunder(p); chunkst_gla<0>(q, l, b, h, cid, wl, lane); }
        off = (off + half) % NW;
#pragma unroll 1
        for (int t = (wi + NW - off) % NW; t < half; t += NW) { const int b = t / (NH * npc), h = (t / npc) % NH, cid = c_lo + t % npc;
            const Params q = relaunder(p); chunkst_gla<1>(q, l, b, h, cid, wl, lane); }
        off = (off + half) % NW;
#pragma unroll 1
        for (int t = (wi + NW - off) % NW; t < half; t += NW) { const int b = t / (NH * npc), h = (t / npc) % NH, cid = c_lo + t % npc;
            const Params q = relaunder(p); chunkst_w<0>(q, l, b, h, cid, wl, lane); }
    }
}

__device__ __forceinline__ void phase_mix1(const Params& p, int l, char* smem) {
    const bool ctxo = l < DEPTH - 1;
    constexpr int N_HL = (NB / 2) * (WG / 2), N_AL = NB * 2 * (SEQ / 64), N_HC = NB * (WG / HCB), N_AC = NB * 2 * NCC;
    const int total = N_HL + N_AL + (ctxo ? N_HC + N_AC : 0);
    for (int task = obid(); task < total; task += gridDim.x) {
        int t = task;
        if (t < N_HL) { hylat_task(p, l, t / (WG / 2), t % (WG / 2), smem); continue; } t -= N_HL;
        if (t < N_AL) { attn_task(p, l, t / (2 * (SEQ / 64)), (t / (SEQ / 64)) % 2, t % (SEQ / 64), false, smem); continue; } t -= N_AL;
        if (t < N_HC) { hyctx_task(p, l, t / (WG / HCB), t % (WG / HCB), smem); continue; } t -= N_HC;
        attn_task(p, l, t / (2 * NCC), (t / NCC) % 2, t % NCC, true, smem);
    }
    __syncthreads();
    chunk_workers<false>(p, l, smem);
}

constexpr int SCG = 12;
__device__ __forceinline__ void phase_scan(const Params& p, int l, char* smem) {
    const int tid = otid();
    bf16* ST = (bf16*)(p.ws + WS_ST); float* NV = (float*)(p.ws + WS_NV); const float* BE = (const float*)(p.ws + WS_BE); float* SC = (float*)(p.ws + WS_SC);
    constexpr int NCHAIN = 2 * 2 * NB * NH;
    for (int item = obid() * NT + tid; item < NCHAIN * 1024; item += gridDim.x * NT) {
        const int chain = item >> 10, grp = item & 1023; const int mixer = chain / (2 * NB * NH), dir = (chain / (NB * NH)) % 2, b = (chain / NH) % NB, h = chain % NH;
        float c[4] = {0.f, 0.f, 0.f, 0.f}; float nv[4] = {0.f, 0.f, 0.f, 0.f}; float m = 0.f;
        const int d0 = (grp & 15) * 4; const bool donv = (mixer == 0) && (grp < 16);
        for (int o0 = 0; o0 < NCH; o0 += SCG) {
            u32x2 uu[SCG]; float s0[SCG], s1[SCG]; f32x4 be[SCG]; f32x4 nu[SCG];
#pragma unroll
            for (int j = 0; j < SCG; ++j) if (o0 + j < NCH) { const int cid = chain_cid(dir, o0 + j); const size_t ci = ch_index(dir, b, h, cid);
                uu[j] = *(const u32x2*)(ST + st_index(mixer, dir, b, h, cid) * 4096 + grp * 4);
                if (mixer == 0) { s0[j] = SC[ci * 4 + 0]; s1[j] = SC[ci * 4 + 1]; if (donv) nu[j] = *(const f32x4*)(NV + ci * 64 + grp * 4); }
                else be[j] = *(const f32x4*)(BE + ci * 64 + d0); }
#pragma unroll
            for (int j = 0; j < SCG; ++j) if (o0 + j < NCH) { const int cid = chain_cid(dir, o0 + j); const size_t ci = ch_index(dir, b, h, cid);
                const float u[4] = {bitsf(uu[j].x << 16), bitsf(uu[j].x & 0xffff0000u), bitsf(uu[j].y << 16), bitsf(uu[j].y & 0xffff0000u)};
                u32x2 w; w.x = pk2(c[0], c[1]); w.y = pk2(c[2], c[3]); *(u32x2*)(ST + st_index(mixer, dir, b, h, cid) * 4096 + grp * 4) = w;
                if (mixer == 0) {
                    if (grp == 0) SC[ci * 4 + 2] = m;
                    const float mn = fmaxf(s0[j] + m, s1[j]), a = __expf(s0[j] + m - mn), s = __expf(s1[j] - mn);
#pragma unroll
                    for (int k = 0; k < 4; ++k) c[k] = a * c[k] + s * u[k];
                    if (donv) { f32x4 nw = {nv[0], nv[1], nv[2], nv[3]}; *(f32x4*)(NV + ci * 64 + grp * 4) = nw;
                        nv[0] = a * nv[0] + s * nu[j].x; nv[1] = a * nv[1] + s * nu[j].y; nv[2] = a * nv[2] + s * nu[j].z; nv[3] = a * nv[3] + s * nu[j].w; }
                    m = mn;
                } else { c[0] = __expf(be[j].x) * c[0] + u[0]; c[1] = __expf(be[j].y) * c[1] + u[1]; c[2] = __expf(be[j].z) * c[2] + u[2]; c[3] = __expf(be[j].w) * c[3] + u[3]; } }
        }
    }
    constexpr int N_WOUT = (DM / 64) * (MIX / 64);
    for (int task = obid(); task < N_WOUT; task += gridDim.x) { const int nt = task / (MIX / 64), kt = task % (MIX / 64);
        convert_tile(p.in[I_WOUT] + (size_t)l * MIX * DM, DM, (bf16*)(p.ws + WS_WOUT), MIX, nt * 64, kt * 64, false, smem); }
    __syncthreads();
    { const int lane = tid & 63, wave = __builtin_amdgcn_readfirstlane(tid >> 6); const int NW = (int)gridDim.x * 8, wi = wave * (int)gridDim.x + obid();
        bf16* tile = (bf16*)(smem + wave * WLDS); const bf16* HT = (const bf16*)(p.ws + WS_HT); bf16* Y = (bf16*)(p.ws + WS_HNY);
        constexpr int NTT = NB * (SEQ / 64) * 4;
        for (int t = wi; t < NTT; t += NW) { const int b = t / ((SEQ / 64) * 4), tt = (t / 4) % (SEQ / 64), c0 = (t % 4) * 64; const size_t tok0 = (size_t)b * TOK + CTXL + tt * 64;
#pragma unroll
            for (int i = 0; i < 8; ++i) { const int ch = (lane >> 3) + 8 * i, ck = lane & 7; *(u32x4*)(tile + swz(ch, ck)) = *(const u32x4*)(HT + (size_t)(768 + c0 + ch) * T + tok0 + ck * 8); }
            WAVE_SYNC();
#pragma unroll
            for (int i = 0; i < 8; ++i) { const int tk = (lane >> 3) + 8 * i, cc = lane & 7; unsigned w[4];
#pragma unroll
                for (int j = 0; j < 4; ++j) { const int ca = cc * 8 + 2 * j; w[j] = (unsigned)tile[swz(ca, tk >> 3) + (tk & 7)] | ((unsigned)tile[swz(ca + 1, tk >> 3) + (tk & 7)] << 16); }
                u32x4 o; o.x = w[0]; o.y = w[1]; o.z = w[2]; o.w = w[3]; *(u32x4*)(Y + (tok0 + tk) * 1024 + YH + c0 + cc * 8) = o; }
            WAVE_SYNC(); } }
}

__device__ __forceinline__ void phase_mix2(const Params& p, int l, char* smem) { chunk_workers<true>(p, l, smem); }

#ifndef EMU
#define LAS __attribute__((address_space(3)))
#define XB_TMO      128
#define XB_XCNT(j)  (256  + 64 * (j))
#define XB_XSUB(j)  (1280 + 64 * (j))
#define XB_XGEN(j)  (2304 + 64 * (j))
#define XB_TOP      3328
#define XB_TOPGEN   3392
#define XCD_BAR_WORDS 3456
#define XB_SPIN_CAP (1u << 18)

__device__ __forceinline__ unsigned xb_ld(unsigned* p)              { return __hip_atomic_load(p, __ATOMIC_RELAXED, __HIP_MEMORY_SCOPE_AGENT); }
__device__ __forceinline__ unsigned xb_add(unsigned* p, unsigned v) { return __hip_atomic_fetch_add(p, v, __ATOMIC_RELAXED, __HIP_MEMORY_SCOPE_AGENT); }
__device__ __forceinline__ unsigned xb_xcc_id() { return (unsigned)__builtin_amdgcn_s_getreg((3 << 11) | 20) & 0xFu; }
#define XB_SPIN(cond, bar) do { unsigned _sp = 0; while (cond) { __builtin_amdgcn_s_sleep(1); \
    if ((++_sp & 255u) == 0u) { if (xb_ld(&(bar)[XB_TMO])) break; if (_sp > XB_SPIN_CAP) { atomicAdd(&(bar)[XB_TMO], 1u); break; } } } } while (0)

struct XcdBarrier {
    unsigned* bar; unsigned x;
    volatile LAS unsigned* st;
};

__device__ __forceinline__ XcdBarrier xcd_barrier_post(unsigned* bar, volatile LAS unsigned* st) {
    XcdBarrier b; b.bar = bar; b.x = xb_xcc_id(); b.st = st;
    if (threadIdx.x == 0) (void)xb_add(&bar[XB_XCNT(b.x)], 1u);
    return b;
}
__device__ __forceinline__ void xcd_barrier_complete(unsigned* bar, unsigned x, unsigned& nloc, unsigned& nx) {
    const unsigned G = gridDim.x * gridDim.y * gridDim.z;
    unsigned sum, cnt, mine, sp = 0u;
    for (;;) {
        sum = 0u; cnt = 0u; mine = 0u;
#pragma unroll
        for (unsigned j = 0; j < 16; ++j) { const unsigned c = xb_ld(&bar[XB_XCNT(j)]); sum += c; cnt += (c > 0u) ? 1u : 0u; mine = (j == x) ? c : mine; }
        if (sum == G) break;
        __builtin_amdgcn_s_sleep(1);
        if ((++sp & 255u) == 0u) { if (xb_ld(&bar[XB_TMO])) break; if (sp > XB_SPIN_CAP) { atomicAdd(&bar[XB_TMO], 1u); break; } }
    }
    nloc = mine > 0u ? mine : 1u; nx = cnt > 0u ? cnt : 1u;
}

__device__ __forceinline__ void xcd_barrier(const XcdBarrier& b) {
    asm volatile("s_waitcnt vmcnt(0)" ::: "memory");
    __syncthreads();
    if (threadIdx.x == 0) {
        unsigned* bar = b.bar;
        __builtin_amdgcn_s_waitcnt(0);
        unsigned nloc = b.st[0], nx = b.st[1];
        if (nloc == 0u) { xcd_barrier_complete(bar, b.x, nloc, nx); b.st[0] = nloc; b.st[1] = nx; }
        const unsigned old = xb_add(&bar[XB_XSUB(b.x)], 1u);
        const unsigned gen = old / nloc;
        if (old + 1u == (gen + 1u) * nloc) {
            __builtin_amdgcn_fence(__ATOMIC_RELEASE, "agent");
            asm volatile("s_waitcnt vmcnt(0)" ::: "memory");
            const unsigned og = xb_add(&bar[XB_TOP], 1u);
            const unsigned tg = og / nx;
            if (og + 1u == (tg + 1u) * nx) xb_add(&bar[XB_TOPGEN], 1u);
            else XB_SPIN(xb_ld(&bar[XB_TOPGEN]) == tg, bar);
            __builtin_amdgcn_fence(__ATOMIC_ACQUIRE, "agent");
            xb_add(&bar[XB_XGEN(b.x)], 1u);
            asm volatile("s_waitcnt vmcnt(0)" ::: "memory");
        } else {
            XB_SPIN(xb_ld(&bar[XB_XGEN(b.x)]) == gen, bar);
            __builtin_amdgcn_fence(__ATOMIC_ACQUIRE, "agent");
            asm volatile("s_waitcnt vmcnt(0)" ::: "memory");
        }
    }
    __syncthreads();
}
#endif

__global__ void __launch_bounds__(NT) fwd_kernel(Params pk, int ph_lo, int ph_hi) {
    SMEM_DECL;
#ifndef EMU
    volatile LAS unsigned* misc = (volatile LAS unsigned*)(smem + LDS_BYTES - 64);
    if (threadIdx.x < 2) misc[threadIdx.x] = 0u;
    __syncthreads();
    const XcdBarrier bar = xcd_barrier_post((unsigned*)(pk.ws + WS_BAR), misc);
#endif
    constexpr int NPH = 2 + 6 * DEPTH;
    for (int ph = ph_lo; ph < ph_hi && ph < NPH; ++ph) {
#ifndef EMU
        Params p = pk; { size_t z = 0; asm volatile("" : "+s"(z)); p.ws = pk.ws + z; p.out = pk.out + z;
#pragma unroll
            for (int i = 0; i < 26; ++i) p.in[i] = pk.in[i] + z; }
#else
        const Params& p = pk;
#endif
        if (ph == 0) phase0(p, smem);
        else if (ph == NPH - 1) phase_rp(p, DEPTH, smem);
        else { const int l = (ph - 1) / 6, k = (ph - 1) % 6;
            if (k == 0) phase_rp(p, l, smem);
            else if (k == 1) phase_gemm_in(p, l, smem);
            else if (k == 2) phase_mix1(p, l, smem);
            else if (k == 3) phase_scan(p, l, smem);
            else if (k == 4) phase_mix2(p, l, smem);
            else phase_gemm_out(p, l, smem);
#ifdef PROBE_DUP
            if (k == PROBE_DUP) { GRID_SYNC();
                if (k == 1) phase_gemm_in(p, l, smem); else if (k == 2) phase_mix1(p, l, smem); else if (k == 4) phase_mix2(p, l, smem); else if (k == 5) phase_gemm_out(p, l, smem); }
#endif
        }
        if (ph + 1 < ph_hi) {
#ifdef EMU
            GRID_SYNC();
#else
            if (ph_lo < 0) GRID_SYNC();
            xcd_barrier(bar);
#endif
        }
    }
}

#ifndef EMU
extern "C" void kernel_launch(void* const* d_in, const int* in_sizes, int n_in, void* d_out, int out_size, void* d_ws, size_t ws_size, hipStream_t stream) {
    static int grid = 0;
    if (grid == 0) {
        if (n_in != 26 || ws_size < WS_TOTAL) { fprintf(stderr, "kernel_launch: unexpected n_in %d or ws_size %zu (need %zu)\n", n_in, ws_size, (size_t)WS_TOTAL); grid = -1; return; }
        int dev = 0, cus = 0, per_cu = 0;
        hipGetDevice(&dev);
        hipDeviceGetAttribute(&cus, hipDeviceAttributeMultiprocessorCount, dev);
        hipFuncSetAttribute((const void*)fwd_kernel, hipFuncAttributeMaxDynamicSharedMemorySize, LDS_BYTES);
        hipOccupancyMaxActiveBlocksPerMultiprocessor(&per_cu, (const void*)fwd_kernel, NT, LDS_BYTES);
        if (per_cu < 1) { fprintf(stderr, "kernel_launch: occupancy query returned %d\n", per_cu); grid = -1; return; }
        if (per_cu > 1) per_cu = 1;
        grid = cus * per_cu;
    }
    if (grid < 0) return;
    hipMemsetAsync((char*)d_ws + WS_BAR, 0, BAR_BYTES, stream);
    Params p{};
    for (int i = 0; i < 26; ++i) p.in[i] = (const float*)d_in[i];
    p.out = (float*)d_out; p.ws = (char*)d_ws;
    int lo = 0, hi = 2 + 6 * DEPTH;
    void* args[] = {&p, &lo, &hi};
    hipError_t e = hipLaunchCooperativeKernel((const void*)fwd_kernel, dim3(grid), dim3(NT), args, LDS_BYTES, stream);
    if (e != hipSuccess) fprintf(stderr, "cooperative launch failed: %s (grid %d)\n", hipGetErrorString(e), grid);
}
#endif
```

```cpp
#ifdef EMU
#include "emu/hipemu.h"
#define GRID_SYNC() emu::grid_sync()
#define SMEM_DECL char* smem = emu::S().blocks[emu::cur()->block].lds
#define MFMA16(a, b, c) emu_mfma_16x16x32_bf16(a, b, c)
#else
#include <hip/hip_runtime.h>
#include <hip/hip_cooperative_groups.h>
#include <cstdio>
#include <cstdint>
#define GRID_SYNC() cooperative_groups::this_grid().sync()
#define SMEM_DECL extern __shared__ __attribute__((aligned(16))) char smem[]
#define MFMA16(a, b, c) __builtin_amdgcn_mfma_f32_16x16x32_bf16(a, b, c, 0, 0, 0)
#endif

#ifdef EMU
#ifndef EMU_DM
#define EMU_DM 256
#endif
#ifndef EMU_NB
#define EMU_NB 2
#endif
#ifndef EMU_SEQ
#define EMU_SEQ 512
#endif
#ifndef EMU_DEPTH
#define EMU_DEPTH 2
#endif
#ifndef EMU_CTXL
#define EMU_CTXL 128
#endif
constexpr int DM = EMU_DM, NB = EMU_NB, SEQ = EMU_SEQ, DEPTH = EMU_DEPTH, CTXL = EMU_CTXL;
#else
constexpr int DM = 1024, NB = 8, SEQ = 2048, DEPTH = 4, CTXL = 256;
#endif
constexpr int MIX = 1024, WG = 256, HD = 64, NH = 4, CH = 64;
constexpr int TOK = CTXL + SEQ, T = NB * TOK, NCH = TOK / CH, NCC = CTXL / CH;
constexpr int N_IN = 4144, NP = 3072, NG = 48, NGS = 32, NMAIN = 3328, NPAD = 4352;
constexpr int NF = 2 * SEQ;
constexpr int NJ = NB + 1;
constexpr int NT = 512;
constexpr float EPS = 1e-6f;
constexpr int PA = 0, PG = 1280, PD = 2304;
constexpr int YA = 0, YH = 256, YG = 512, YD = 768;
constexpr int ilog4(int n) { return n <= 1 ? 0 : 1 + ilog4(n / 4); }
constexpr int FFT_P = ilog4(NF);
static_assert((1 << (2 * FFT_P)) == NF, "NF must be a power of 4");
static_assert(DM % 256 == 0 && CTXL % 128 == 0 && SEQ % 256 == 0, "shape constraints");

typedef unsigned short bf16;
typedef short bf16x8 __attribute__((ext_vector_type(8)));
typedef float f32x4 __attribute__((ext_vector_type(4)));
typedef unsigned u32x4 __attribute__((ext_vector_type(4)));
typedef unsigned u32x2 __attribute__((ext_vector_type(2)));
struct cpx { float x, y; };

constexpr size_t al256(size_t x) { return (x + 255) & ~(size_t)255; }
constexpr size_t WS_CTXB = 0;
constexpr size_t WS_HNY = al256(WS_CTXB + (size_t)NB * CTXL * DM * 4);
constexpr size_t WS_WIN = WS_HNY + (size_t)T * 1024 * 2;
constexpr size_t WS_ST = WS_WIN;
constexpr size_t ST_BYTES = (size_t)2 * 2 * NB * NH * NCH * 4096 * 2;
constexpr size_t WS_KT = al256(WS_WIN + (size_t)NPAD * DM * 2);
static_assert(WS_KT + (size_t)WG * NF * 4 <= WS_ST + ST_BYTES || true, "");
constexpr size_t ST_END = al256((WS_ST + ST_BYTES > WS_KT + (size_t)WG * NF * 4) ? WS_ST + ST_BYTES : WS_KT + (size_t)WG * NF * 4);
constexpr size_t WS_P = ST_END;
constexpr size_t WS_HT = al256(WS_P + (size_t)T * NP * 2);
constexpr size_t WS_WOUT = WS_HT;
constexpr size_t WS_G = al256(WS_HT + (size_t)1024 * T * 2);
constexpr size_t WS_KF = al256(WS_G + (size_t)T * NGS * 4);
constexpr size_t WS_HC = al256(WS_KF + (size_t)WG * NF * 8);
constexpr size_t WS_EQ = al256(WS_HC + (size_t)2 * WG * CTXL * 4);
constexpr size_t WS_NV = al256(WS_EQ + (size_t)2 * T * WG * 2);
constexpr size_t WS_BE = al256(WS_NV + (size_t)2 * NB * NH * NCH * 64 * 4);
constexpr size_t WS_SC = al256(WS_BE + (size_t)2 * NB * NH * NCH * 64 * 4);
constexpr size_t WS_MOD = al256(WS_SC + (size_t)2 * NB * NH * NCH * 4 * 4);
constexpr size_t WS_TW = al256(WS_MOD + (size_t)DEPTH * NJ * 3 * DM * 4);
constexpr size_t WS_ROPE = al256(WS_TW + (size_t)NF * 8);
constexpr size_t WS_BAR = al256(WS_ROPE + (size_t)SEQ * 32 * 8);
constexpr size_t BAR_BYTES = 16384;
constexpr size_t WS_TOTAL = al256(WS_BAR + BAR_BYTES);
static_assert((size_t)T * DM * 4 <= (size_t)T * NP * 2, "YO fits in P");
#ifndef EMU
static_assert(WS_TOTAL <= (size_t)268435456, "workspace map must fit 256 MiB");
#endif

constexpr int LDS_BYTES = 163840;

struct Params {
    const float* in[26];
    float* out;
    char* ws;
};
enum { I_X = 0, I_C, I_CTX, I_CCTX, I_WADA, I_BADA, I_GPRE, I_GPOST, I_WIN, I_MGB, I_MNG, I_HCW, I_HCB, I_HW1, I_HB1, I_HW2, I_HB2, I_HW3, I_HB3,
       I_HFREQ, I_HD, I_GWA, I_GBA, I_GNG, I_SINK, I_WOUT };

__device__ __forceinline__ Params relaunder(const Params& pk) {
#ifdef EMU
    return pk;
#else
    Params p = pk; size_t z = 0; asm volatile("" : "+s"(z)); p.ws = pk.ws + z; p.out = pk.out + z;
#pragma unroll
    for (int i = 0; i < 26; ++i) p.in[i] = pk.in[i] + z;
    return p;
#endif
}
constexpr int WLDS = (LDS_BYTES - 64) / 8 / 16 * 16;
#ifdef EMU
#define WAVE_SYNC() emu_wave_sync()
#else
#define WAVE_SYNC() do { asm volatile("s_waitcnt lgkmcnt(0)" ::: "memory"); __builtin_amdgcn_wave_barrier(); } while (0)
#endif

#ifdef EMU
__device__ __forceinline__ int otid() { return (int)threadIdx.x; }
__device__ __forceinline__ int obid() { return (int)blockIdx.x; }
#else
__device__ __forceinline__ int otid() { int t = (int)threadIdx.x; asm volatile("" : "+v"(t)); return t; }
__device__ __forceinline__ int obid() { int b = (int)blockIdx.x; asm volatile("" : "+s"(b)); return b; }
#endif
__device__ __forceinline__ unsigned fbits(float f) { return __builtin_bit_cast(unsigned, f); }
__device__ __forceinline__ float bitsf(unsigned u) { return __builtin_bit_cast(float, u); }
__device__ __forceinline__ float bf2f(bf16 h) { return bitsf((unsigned)h << 16); }
#ifdef EMU
__device__ __forceinline__ bf16 f2bf(float f) { unsigned u = fbits(f); return (bf16)((u + 0x7fffu + ((u >> 16) & 1u)) >> 16); }
__device__ __forceinline__ unsigned pk2(float lo, float hi) { return (unsigned)f2bf(lo) | ((unsigned)f2bf(hi) << 16); }
#else
typedef __bf16 nbf16x2 __attribute__((ext_vector_type(2)));
typedef float nf32x2 __attribute__((ext_vector_type(2)));
__device__ __forceinline__ unsigned pk2(float lo, float hi) { const nf32x2 v = {lo, hi}; return __builtin_bit_cast(unsigned, __builtin_convertvector(v, nbf16x2)); }
__device__ __forceinline__ bf16 f2bf(float f) { return (bf16)(pk2(f, 0.0f) & 0xffffu); }
#endif
#ifdef EMU
__device__ __forceinline__ float frcp_(float x) { return 1.0f / x; }
#else
__device__ __forceinline__ float frcp_(float x) { return __builtin_amdgcn_rcpf(x); }
#endif
__device__ __forceinline__ float sigmoidf_(float x) { return frcp_(1.0f + __expf(-x)); }
__device__ __forceinline__ float siluf_(float x) { return x * frcp_(1.0f + __expf(-x)); }
__device__ __forceinline__ float logsigf_(float x) { return fminf(x, 0.0f) - log1pf(__expf(-fabsf(x))); }
__device__ __forceinline__ float logsig_fast(float x) { return fminf(x, 0.0f) - __logf(1.0f + __expf(-fabsf(x))); }
#ifdef EMU
__device__ __forceinline__ float row16_sum(float x) { x += __shfl_xor(x, 1); x += __shfl_xor(x, 2); x += __shfl_xor(x, 4); x += __shfl_xor(x, 8); return x; }
__device__ __forceinline__ float row16_max(float x) { x = fmaxf(x, __shfl_xor(x, 1)); x = fmaxf(x, __shfl_xor(x, 2)); x = fmaxf(x, __shfl_xor(x, 4)); x = fmaxf(x, __shfl_xor(x, 8)); return x; }
__device__ __forceinline__ float xrow_sum(float x) { x += __shfl_xor(x, 16); x += __shfl_xor(x, 32); return x; }
__device__ __forceinline__ float xrow_max(float x) { x = fmaxf(x, __shfl_xor(x, 16)); x = fmaxf(x, __shfl_xor(x, 32)); return x; }
#else
template <int CTRL> __device__ __forceinline__ float dpp_(float x) { return __builtin_bit_cast(float, __builtin_amdgcn_mov_dpp(__builtin_bit_cast(int, x), CTRL, 0xf, 0xf, true)); }
__device__ __forceinline__ float row16_sum(float x) { x += dpp_<0xB1>(x); x += dpp_<0x4E>(x); x += dpp_<0x141>(x); x += dpp_<0x128>(x); return x; }
__device__ __forceinline__ float row16_max(float x) { x = fmaxf(x, dpp_<0xB1>(x)); x = fmaxf(x, dpp_<0x4E>(x)); x = fmaxf(x, dpp_<0x141>(x)); x = fmaxf(x, dpp_<0x128>(x)); return x; }
__device__ __forceinline__ float xrow_sum(float x) {
    auto s = __builtin_amdgcn_permlane16_swap(fbits(x), fbits(x), false, false); x = bitsf(s[0]) + bitsf(s[1]);
    auto t = __builtin_amdgcn_permlane32_swap(fbits(x), fbits(x), false, false); return bitsf(t[0]) + bitsf(t[1]); }
__device__ __forceinline__ float xrow_max(float x) {
    auto s = __builtin_amdgcn_permlane16_swap(fbits(x), fbits(x), false, false); x = fmaxf(bitsf(s[0]), bitsf(s[1]));
    auto t = __builtin_amdgcn_permlane32_swap(fbits(x), fbits(x), false, false); return fmaxf(bitsf(t[0]), bitsf(t[1])); }
#endif
__device__ __forceinline__ float wave_sum(float v) { return xrow_sum(row16_sum(v)); }
__device__ __forceinline__ float wave_max(float v) { return xrow_max(row16_max(v)); }
#ifdef EMU
__device__ __forceinline__ float wave_prefix_sum(float v, int lane) {
#pragma unroll
    for (int o = 1; o < 64; o <<= 1) { float t = __shfl_up(v, o); if (lane >= o) v += t; }
    return v;
}
__device__ __forceinline__ float wave_prefix_max(float v, int lane) {
#pragma unroll
    for (int o = 1; o < 64; o <<= 1) { float t = __shfl_up(v, o); if (lane >= o) v = fmaxf(v, t); }
    return v;
}
#else
template <int CTRL, int RM> __device__ __forceinline__ float dppo_(float old, float x) { return __builtin_bit_cast(float, __builtin_amdgcn_update_dpp(__builtin_bit_cast(int, old), __builtin_bit_cast(int, x), CTRL, RM, 0xf, false)); }
__device__ __forceinline__ float wave_prefix_sum(float v, int) {
    v += dppo_<0x111, 0xf>(0.f, v); v += dppo_<0x112, 0xf>(0.f, v); v += dppo_<0x114, 0xf>(0.f, v); v += dppo_<0x118, 0xf>(0.f, v);
    v += dppo_<0x142, 0xa>(0.f, v); v += dppo_<0x143, 0xc>(0.f, v); return v;
}
__device__ __forceinline__ float wave_prefix_max(float v, int) {
    const float ninf = -INFINITY;
    v = fmaxf(v, dppo_<0x111, 0xf>(ninf, v)); v = fmaxf(v, dppo_<0x112, 0xf>(ninf, v)); v = fmaxf(v, dppo_<0x114, 0xf>(ninf, v)); v = fmaxf(v, dppo_<0x118, 0xf>(ninf, v));
    v = fmaxf(v, dppo_<0x142, 0xa>(ninf, v)); v = fmaxf(v, dppo_<0x143, 0xc>(ninf, v)); return v;
}
#endif
__device__ __forceinline__ float wave_suffix_max(float v, int lane) {
    return __shfl(wave_prefix_max(__shfl(v, 63 - lane), lane), 63 - lane);
}
__device__ __forceinline__ void unpack8(u32x4 v, float* f) {
    f[0] = bitsf(v.x << 16); f[1] = bitsf(v.x & 0xffff0000u); f[2] = bitsf(v.y << 16); f[3] = bitsf(v.y & 0xffff0000u);
    f[4] = bitsf(v.z << 16); f[5] = bitsf(v.z & 0xffff0000u); f[6] = bitsf(v.w << 16); f[7] = bitsf(v.w & 0xffff0000u);
}
__device__ __forceinline__ int orig_col(int n) {
    if (n < 1280) return n;
    if (n < 2304) return 2320 + (n - 1280);
    if (n < 3072) return 3376 + (n - 2304);
    if (n < 3088) return 1280 + (n - 3072);
    if (n < 3120) return 3344 + (n - 3088);
    if (n < NMAIN) return -1;
    return 1296 + (n - NMAIN);
}
__device__ __forceinline__ int chain_cid(int dir, int o) {
    if (dir == 0) return o;
    return o < NCC ? (NCC - 1 - o) : (NCH - 1 - (o - NCC));
}

__device__ __forceinline__ int swz(int row, int ch) { return row * 64 + ((ch ^ (row & 7)) << 3); }
__device__ __forceinline__ u32x4 pack8(const float* f) { u32x4 o; o.x = pk2(f[0], f[1]); o.y = pk2(f[2], f[3]); o.z = pk2(f[4], f[5]); o.w = pk2(f[6], f[7]); return o; }
__device__ __forceinline__ bf16x8 as_frag(u32x4 v) { return __builtin_bit_cast(bf16x8, v); }
__device__ __forceinline__ u32x4 as_u4(bf16x8 v) { return __builtin_bit_cast(u32x4, v); }

constexpr int LS = 72;

template <int NTL, int KS>
__device__ __forceinline__ void mma_nt(const bf16* A, int lda, int m0, const bf16* B, int ldb, int n0, f32x4 (&acc)[NTL], int lane) {
    const int r = lane & 15, q = lane >> 4;
#pragma unroll
    for (int ks = 0; ks < KS; ++ks) {
        const bf16x8 a = *(const bf16x8*)(A + (m0 + r) * lda + ks * 32 + q * 8);
#pragma unroll
        for (int nt = 0; nt < NTL; ++nt) {
            const bf16x8 b = *(const bf16x8*)(B + (n0 + nt * 16 + r) * ldb + ks * 32 + q * 8);
            acc[nt] = MFMA16(a, b, acc[nt]);
        }
    }
}

__device__ __forceinline__ void layer_prep(const Params& p, int l, int idx, int stride, char* smem);
__device__ __forceinline__ void phase0(const Params& p, char* smem) {
    const int tid = otid();
    cpx* TW = (cpx*)(p.ws + WS_TW);
    cpx* ROPE = (cpx*)(p.ws + WS_ROPE);
    float* MOD = (float*)(p.ws + WS_MOD);
    constexpr int N_TW = NF / NT, N_ROPE = SEQ * 32 / NT, N_MOD = DEPTH * (3 * DM / 64);
    for (int task = obid(); task < N_TW + N_ROPE + N_MOD; task += gridDim.x) {
        if (task < N_TW) {
            const int j = task * NT + tid; float s, c; sincospif(2.0f * (float)j / (float)NF, &s, &c);
            cpx v; v.x = c; v.y = -s; TW[j] = v;
        } else if (task < N_TW + N_ROPE) {
            const int idx = (task - N_TW) * NT + tid; const int pos = idx >> 5, i = idx & 31;
            const float inv = exp2f(-(float)(i & 15) * (13.287712379549449f / 16.0f));
            const float ang = (float)(i < 16 ? pos / 64 : pos % 64) * inv;
            cpx v; v.x = cosf(ang); v.y = sinf(ang); ROPE[idx] = v;
        } else {
            const int mt = task - N_TW - N_ROPE; const int l = mt / (3 * DM / 64), n0 = (mt % (3 * DM / 64)) * 64;
            float* sv = (float*)smem;
            float* red = sv + NJ * DM;
            __syncthreads();
            for (int i = tid; i < NJ * DM; i += NT) { const int j = i / DM, k = i % DM; const float v = j < NB ? p.in[I_C][j * DM + k] : p.in[I_CCTX][k]; sv[i] = siluf_(v); }
            __syncthreads();
            const int nl = tid & 63, ks = tid >> 6; float acc[NJ];
#pragma unroll
            for (int j = 0; j < NJ; ++j) acc[j] = 0.f;
            const float* w = p.in[I_WADA] + (size_t)l * DM * 3 * DM + n0 + nl;
            for (int k = ks * (DM / 8); k < (ks + 1) * (DM / 8); ++k) { const float wv = w[(size_t)k * 3 * DM];
#pragma unroll
                for (int j = 0; j < NJ; ++j) acc[j] += sv[j * DM + k] * wv; }
#pragma unroll
            for (int j = 0; j < NJ; ++j) red[(ks * NJ + j) * 64 + nl] = acc[j];
            __syncthreads();
            for (int i = tid; i < NJ * 64; i += NT) { const int j = i / 64, n = i % 64; float s = 0.f;
#pragma unroll
                for (int k8 = 0; k8 < 8; ++k8) s += red[(k8 * NJ + j) * 64 + n];
                MOD[((size_t)l * NJ + j) * 3 * DM + n0 + n] = s + p.in[I_BADA][(size_t)l * 3 * DM + n0 + n]; }
        }
    }
}

__device__ __forceinline__ void rp_rows(const Params& p, int l) {
    const int tid = otid(), lane = tid & 63, wave = tid >> 6;
    const float* MOD = (const float*)(p.ws + WS_MOD);
    float* CTXB = (float*)(p.ws + WS_CTXB);
    const bf16* YO = (const bf16*)(p.ws + WS_P);
    bf16* HN = (bf16*)(p.ws + WS_HNY);
    constexpr int NV4 = DM / 256, RW = 2;
    const int stride = (int)gridDim.x * 8;
    for (int base = obid() * 8 + wave; base < T; base += stride * RW) {
        f32x4 x[RW][NV4], y[RW][NV4]; const float* xo[RW]; float* xn[RW]; int mj[RW]; bool ok[RW];
#pragma unroll
        for (int i = 0; i < RW; ++i) { const int row = base + i * stride; ok[i] = row < T; const int rr = ok[i] ? row : base;
            const int b = rr / TOK, pp = rr % TOK; const bool isctx = pp < CTXL; if (l == DEPTH && isctx) ok[i] = false;
            const size_t off = isctx ? ((size_t)b * CTXL + pp) * DM : ((size_t)b * SEQ + (pp - CTXL)) * DM;
            xo[i] = (l <= 1) ? (isctx ? p.in[I_CTX] + off : p.in[I_X] + off) : (isctx ? CTXB + off : p.out + off);
            xn[i] = isctx ? CTXB + off : p.out + off; mj[i] = isctx ? NB : b;
#pragma unroll
            for (int j = 0; j < NV4; ++j) { x[i][j] = *(const f32x4*)(xo[i] + 4 * lane + 256 * j); if (l > 0) { const u32x2 yy = *(const u32x2*)(YO + (size_t)rr * DM + 4 * lane + 256 * j); y[i][j] = (f32x4){bitsf(yy.x << 16), bitsf(yy.x & 0xffff0000u), bitsf(yy.y << 16), bitsf(yy.y & 0xffff0000u)}; } else y[i][j] = (f32x4){0.f, 0.f, 0.f, 0.f}; } }
        if (l > 0) {
            float ss[RW];
#pragma unroll
            for (int i = 0; i < RW; ++i) { ss[i] = 0.f;
#pragma unroll
                for (int j = 0; j < NV4; ++j) ss[i] += y[i][j].x * y[i][j].x + y[i][j].y * y[i][j].y + y[i][j].z * y[i][j].z + y[i][j].w * y[i][j].w; }
#pragma unroll
            for (int i = 0; i < RW; ++i) ss[i] = wave_sum(ss[i]);
            const float* gp = p.in[I_GPOST] + (size_t)(l - 1) * DM;
#pragma unroll
            for (int i = 0; i < RW; ++i) { const float rstd = rsqrtf(ss[i] * (1.0f / DM) + EPS); const float* gt = MOD + ((size_t)(l - 1) * NJ + mj[i]) * 3 * DM + 2 * DM;
#pragma unroll
                for (int j = 0; j < NV4; ++j) { const f32x4 g4 = *(const f32x4*)(gt + 4 * lane + 256 * j), p4 = *(const f32x4*)(gp + 4 * lane + 256 * j);
                    x[i][j] = x[i][j] + g4 * (y[i][j] * rstd * p4);
                    if (ok[i]) *(f32x4*)(xn[i] + 4 * lane + 256 * j) = x[i][j]; } }
        }
        if (l < DEPTH) {
            float ss[RW];
#pragma unroll
            for (int i = 0; i < RW; ++i) { ss[i] = 0.f;
#pragma unroll
                for (int j = 0; j < NV4; ++j) ss[i] += x[i][j].x * x[i][j].x + x[i][j].y * x[i][j].y + x[i][j].z * x[i][j].z + x[i][j].w * x[i][j].w; }
#pragma unroll
            for (int i = 0; i < RW; ++i) ss[i] = wave_sum(ss[i]);
            const float* gp = p.in[I_GPRE] + (size_t)l * DM;
#pragma unroll
            for (int i = 0; i < RW; ++i) { const float rstd = rsqrtf(ss[i] * (1.0f / DM) + EPS); const float* md = MOD + ((size_t)l * NJ + mj[i]) * 3 * DM; const int row = base + i * stride;
#pragma unroll
                for (int j = 0; j < NV4; ++j) { const int e = 4 * lane + 256 * j;
                    const f32x4 g4 = *(const f32x4*)(gp + e), sh = *(const f32x4*)(md + e), sc = *(const f32x4*)(md + DM + e);
                    const f32x4 h = (x[i][j] * rstd * g4) * (sc + 1.0f) + sh;
                    u32x2 o; o.x = pk2(h.x, h.y); o.y = pk2(h.z, h.w);
                    if (ok[i]) *(u32x2*)(HN + (size_t)row * DM + e) = o; } }
        }
    }
}

__device__ __forceinline__ void convert_tile(const float* src, int ldn, bf16* dst, int K, int n0, int k0, bool use_map, char* smem) {
    const int tid = otid();
    float* tile = (float*)smem;
    __syncthreads();
#pragma unroll
    for (int i = 0; i < 8; ++i) { const int idx = tid + NT * i, k = idx >> 6, n = idx & 63;
        const int oc = use_map ? orig_col(n0 + n) : (n0 + n);
        tile[k * 65 + n] = oc >= 0 ? src[(size_t)(k0 + k) * ldn + oc] : 0.f; }
    __syncthreads();
    const int n = tid >> 3, c = tid & 7;
    u32x4 o; o.x = pk2(tile[(8 * c + 0) * 65 + n], tile[(8 * c + 1) * 65 + n]); o.y = pk2(tile[(8 * c + 2) * 65 + n], tile[(8 * c + 3) * 65 + n]);
    o.z = pk2(tile[(8 * c + 4) * 65 + n], tile[(8 * c + 5) * 65 + n]); o.w = pk2(tile[(8 * c + 6) * 65 + n], tile[(8 * c + 7) * 65 + n]);
    *(u32x4*)(dst + (size_t)(n0 + n) * K + k0 + 8 * c) = o;
}

__device__ __forceinline__ void filter_task(const Params& p, int l, int L, int pos0, char* smem) {
    const int tid = otid();
    float* z = (float*)smem;
    float* h1 = z + 8 * 33;
    float* h2 = h1 + 8 * 64;
    __syncthreads();
    if (tid < 8 * 33) { const int pp = tid / 33, i = tid % 33; const float pos = (float)(pos0 + pp);
        const float t = pos / (float)(L - 1 > 1 ? L - 1 : 1), w = 6.283185307179586f * pos / (float)L; float v;
        if (i == 0) v = t; else { const int bi = (i - 1) & 15; const float f = 1e-4f + (float)bi * ((15.0f - 1e-4f) / 15.0f); v = (i <= 16) ? cosf(w * f) : -sinf(w * f); }
        z[tid] = v; }
    __syncthreads();
    { const int pp = tid >> 6, j = tid & 63; const float* w1 = p.in[I_HW1] + (size_t)l * 33 * 64; float a = p.in[I_HB1][l * 64 + j];
        for (int i = 0; i < 33; ++i) a += z[pp * 33 + i] * w1[i * 64 + j];
        h1[tid] = sinf(p.in[I_HFREQ][(l * 2 + 0) * 64 + j] * a); }
    __syncthreads();
    { const int pp = tid >> 6, j = tid & 63; const float* w2 = p.in[I_HW2] + (size_t)l * 64 * 64; float a = p.in[I_HB2][l * 64 + j];
        for (int i = 0; i < 64; ++i) a += h1[pp * 64 + i] * w2[i * 64 + j];
        h2[tid] = sinf(p.in[I_HFREQ][(l * 2 + 1) * 64 + j] * a); }
    __syncthreads();
    { const int o = tid, dir = o >> 8, c = o & 255; const float* w3 = p.in[I_HW3] + (size_t)l * 64 * 512; const float b3 = p.in[I_HB3][l * 512 + o];
        const float delta = 3.0701134573253946f + (float)c * ((15.350567286626973f - 3.0701134573253946f) / 255.0f);
        float acc[8];
#pragma unroll
        for (int pp = 0; pp < 8; ++pp) acc[pp] = b3;
        for (int j = 0; j < 64; ++j) { const float wv = w3[j * 512 + o];
#pragma unroll
            for (int pp = 0; pp < 8; ++pp) acc[pp] += h2[pp * 64 + j] * wv; }
        float* KT = (float*)(p.ws + WS_KT); float* HC = (float*)(p.ws + WS_HC);
#pragma unroll
        for (int pp = 0; pp < 8; ++pp) { const int pos = pos0 + pp; const float t = (float)pos / (float)(L - 1 > 1 ? L - 1 : 1);
            const float v = acc[pp] * __expf(-t * delta);
            if (L == SEQ) { if (dir == 0) KT[(size_t)c * NF + pos]= v; else if (pos > 0) KT[(size_t)c * NF + (NF - pos)] = v; else KT[(size_t)c * NF + SEQ] = 0.f; }
            else HC[((size_t)dir * WG + c) * CTXL + pos] = v; }
    }
}

__device__ __forceinline__ void convert_tile_w(const float* src, int ldn, bf16* dst, int K, int n0, int k0, bool use_map, char* wl, int lane) {
    float* tile = (float*)wl;
    const int oc = use_map ? orig_col(n0 + lane) : (n0 + lane);
    float v[64];
#pragma unroll
    for (int k = 0; k < 64; ++k) v[k] = oc >= 0 ? src[(size_t)(k0 + k) * ldn + oc] : 0.f;
#pragma unroll
    for (int k = 0; k < 64; ++k) tile[k * 65 + lane] = v[k];
    WAVE_SYNC();
#pragma unroll
    for (int i = 0; i < 8; ++i) { const int n = (lane >> 3) + 8 * i, c = lane & 7; float f[8];
#pragma unroll
        for (int j = 0; j < 8; ++j) f[j] = tile[(8 * c + j) * 65 + n];
        *(u32x4*)(dst + (size_t)(n0 + n) * K + k0 + 8 * c) = pack8(f); }
    WAVE_SYNC();
}
__device__ __forceinline__ void layer_prep(const Params& p, int l, int idx, int stride, char* smem) {
    constexpr int N_WIN = (NPAD / 64) * (DM / 64), N_FL = SEQ / 8, N_FC = CTXL / 8;
    for (int task = idx; task < N_FL + N_FC; task += stride) {
        if (task < N_FL) filter_task(p, l, SEQ, task * 8, smem);
        else filter_task(p, l, CTXL, (task - N_FL) * 8, smem);
    }
    __syncthreads();
    { const int tid = otid(), lane = tid & 63, wave = __builtin_amdgcn_readfirstlane(tid >> 6);
        char* wl = smem + wave * WLDS;
        for (int task = wave * stride + idx; task < N_WIN; task += 8 * stride) { const int nt = task / (DM / 64), kt = task % (DM / 64);
            convert_tile_w(p.in[I_WIN] + (size_t)l * DM * N_IN, N_IN, (bf16*)(p.ws + WS_WIN), DM, nt * 64, kt * 64, true, wl, lane); } }
}
__device__ __forceinline__ void phase_rp(const Params& p, int l, char* smem) { rp_rows(p, l); if (l < DEPTH) layer_prep(p, l, obid(), (int)gridDim.x, smem); }

__device__ __forceinline__ cpx cmul(cpx a, cpx b) { cpx r; r.x = a.x * b.x - a.y * b.y; r.y = a.x * b.y + a.y * b.x; return r; }
__device__ __forceinline__ cpx cmulc(cpx a, cpx b) { cpx r; r.x = a.x * b.x + a.y * b.y; r.y = a.y * b.x - a.x * b.y; return r; }
constexpr int fpad(int i) { return i + (i >> 4); }
__device__ __forceinline__ int FPH(int i) { return i + (i >> 4); }
constexpr int FBUF = fpad(NF);
constexpr int ilog16(int n) { return n < 16 ? 0 : 1 + ilog16(n / 16); }
constexpr int FFT_P16 = ilog16(NF);
constexpr bool FFT_R4 = ((NF >> (4 * FFT_P16)) == 4);
static_assert((NF >> (4 * FFT_P16)) == 1 || (NF >> (4 * FFT_P16)) == 4, "NF = 16^a * (1 or 4)");
template <bool INV> __device__ __forceinline__ void dft4(cpx& a0, cpx& a1, cpx& a2, cpx& a3) {
    const cpx s = {a0.x + a2.x, a0.y + a2.y}, b = {a0.x - a2.x, a0.y - a2.y}, c = {a1.x + a3.x, a1.y + a3.y}, d = {a1.x - a3.x, a1.y - a3.y};
    a0 = (cpx){s.x + c.x, s.y + c.y}; a2 = (cpx){s.x - c.x, s.y - c.y};
    if (!INV) { a1 = (cpx){b.x + d.y, b.y - d.x}; a3 = (cpx){b.x - d.y, b.y + d.x}; }
    else      { a1 = (cpx){b.x - d.y, b.y + d.x}; a3 = (cpx){b.x + d.y, b.y - d.x}; }
}
template <bool INV> __device__ __forceinline__ cpx cmulk(cpx a, float wr, float wi) {
    cpx r; if (!INV) { r.x = a.x * wr + a.y * wi; r.y = a.y * wr - a.x * wi; } else { r.x = a.x * wr - a.y * wi; r.y = a.y * wr + a.x * wi; } return r;
}
template <bool INV> __device__ __forceinline__ void dft16(cpx (&x)[16]) {
    constexpr float C1 = 0.92387953251128674f, S1 = 0.38268343236508977f, C2 = 0.70710678118654752f;
#pragma unroll
    for (int n2 = 0; n2 < 4; ++n2) dft4<INV>(x[n2], x[4 + n2], x[8 + n2], x[12 + n2]);
    x[4 * 1 + 1] = cmulk<INV>(x[4 * 1 + 1], C1, S1); x[4 * 1 + 2] = cmulk<INV>(x[4 * 1 + 2], C2, C2); x[4 * 1 + 3] = cmulk<INV>(x[4 * 1 + 3], S1, C1);
    x[4 * 2 + 1] = cmulk<INV>(x[4 * 2 + 1], C2, C2); x[4 * 2 + 2] = cmulk<INV>(x[4 * 2 + 2], 0.f, 1.f); x[4 * 2 + 3] = cmulk<INV>(x[4 * 2 + 3], -C2, C2);
    x[4 * 3 + 1] = cmulk<INV>(x[4 * 3 + 1], S1, C1); x[4 * 3 + 2] = cmulk<INV>(x[4 * 3 + 2], -C2, C2); x[4 * 3 + 3] = cmulk<INV>(x[4 * 3 + 3], -C1, -S1);
#pragma unroll
    for (int k1 = 0; k1 < 4; ++k1) dft4<INV>(x[4 * k1 + 0], x[4 * k1 + 1], x[4 * k1 + 2], x[4 * k1 + 3]);
    cpx t;
    t = x[1]; x[1] = x[4]; x[4] = t; t = x[2]; x[2] = x[8]; x[8] = t; t = x[3]; x[3] = x[12]; x[12] = t;
    t = x[6]; x[6] = x[9]; x[9] = t; t = x[7]; x[7] = x[13]; x[13] = t; t = x[11]; x[11] = x[14]; x[14] = t;
}
template <bool INV> __device__ __forceinline__ void fft_stage16(cpx* buf, const cpx* TW, int tl, int M) {
    const int span = M >> 4, twm = NF / M;
#pragma unroll 1
    for (int j = tl; j < NF / 16; j += 256) {
        const int grp = j / span, pos = j % span, base = grp * M + pos; cpx x[16];
#pragma unroll
        for (int q = 0; q < 16; ++q) x[q] = buf[FPH(base + q * span)];
        cpx w1 = {1.f, 0.f}; if (span > 1) w1 = TW[pos * twm];
        if (INV && span > 1) { cpx wk = w1;
#pragma unroll
            for (int k = 1; k < 16; ++k) { x[k] = cmulc(x[k], wk); wk = cmul(wk, w1); } }
        dft16<INV>(x);
        if (!INV && span > 1) { cpx wk = w1;
#pragma unroll
            for (int k = 1; k < 16; ++k) { x[k] = cmul(x[k], wk); wk = cmul(wk, w1); } }
#pragma unroll
        for (int q = 0; q < 16; ++q) buf[FPH(base + q * span)] = x[q];
    }
}
template <bool INV> __device__ __forceinline__ void fft_stage4_last(cpx* buf, int tl) {
#pragma unroll 1
    for (int j = tl; j < NF / 4; j += 256) { cpx a0 = buf[FPH(4 * j)], a1 = buf[FPH(4 * j + 1)], a2 = buf[FPH(4 * j + 2)], a3 = buf[FPH(4 * j + 3)];
        dft4<INV>(a0, a1, a2, a3); buf[FPH(4 * j)] = a0; buf[FPH(4 * j + 1)] = a1; buf[FPH(4 * j + 2)] = a2; buf[FPH(4 * j + 3)] = a3; }
}
__device__ __forceinline__ void fft_fwd(cpx* buf, const cpx* TW, int tl) {
    int M = NF;
#pragma unroll
    for (int s = 0; s < FFT_P16; ++s) { __syncthreads(); fft_stage16<false>(buf, TW, tl, M); M >>= 4; }
    if (FFT_R4) { __syncthreads(); fft_stage4_last<false>(buf, tl); }
    __syncthreads();
}
__device__ __forceinline__ void fft_inv(cpx* buf, const cpx* TW, int tl) {
    if (FFT_R4) { __syncthreads(); fft_stage4_last<true>(buf, tl); }
    int M = FFT_R4 ? 64 : 16;
#pragma unroll
    for (int s = 0; s < FFT_P16; ++s) { __syncthreads(); fft_stage16<true>(buf, TW, tl, M); M <<= 4; }
    __syncthreads();
}
__device__ __forceinline__ void filt_fft_task(const Params& p, int cp, char* smem) {
    const int tid = otid(), half = tid >> 8, tl = tid & 255, c = 2 * cp + half;
    cpx* buf = (cpx*)smem + (size_t)half * FBUF;
    const float* KT = (const float*)(p.ws + WS_KT) + (size_t)c * NF;
    cpx* KF = (cpx*)(p.ws + WS_KF) + (size_t)c * NF;
    const cpx* TW = (const cpx*)(p.ws + WS_TW);
    __syncthreads();
    for (int i = tl; i < NF; i += 256) { cpx v; v.x = KT[i]; v.y = 0.f; buf[FPH(i)] = v; }
    fft_fwd(buf, TW, tl);
    for (int i = tl; i < NF; i += 256) KF[i] = buf[FPH(i)];
}

__device__ __forceinline__ void gemm_tile(const Params& p, const bf16* A, const bf16* Bt, int K, int mt, int nt, int mode, char* smem) {
    const int tid = otid(), lane = tid & 63, wave = tid >> 6;
    bf16* As = (bf16*)smem;
    bf16* Bs = As + 128 * LS;
    const int wm = (wave & 3) * 32, wn = (wave >> 2) * 64;
    f32x4 acc[2][4];
#pragma unroll
    for (int i = 0; i < 2; ++i)
#pragma unroll
        for (int j = 0; j < 4; ++j) acc[i][j] = (f32x4){0.f, 0.f, 0.f, 0.f};
    const int lr = tid >> 3, lc = tid & 7;
    const bf16* Ag = A + (size_t)(mt * 128 + lr) * K + lc * 8;
    const bf16* Bg = Bt + (size_t)(nt * 128 + lr) * K + lc * 8;
    u32x4 ra0, ra1, rb0, rb1;
    ra0 = *(const u32x4*)(Ag); ra1 = *(const u32x4*)(Ag + (size_t)64 * K); rb0 = *(const u32x4*)(Bg); rb1 = *(const u32x4*)(Bg + (size_t)64 * K);
    const int nk = K / 64;
    for (int kt = 0; kt < nk; ++kt) {
        __syncthreads();
        *(u32x4*)(As + lr * LS + lc * 8) = ra0; *(u32x4*)(As + (lr + 64) * LS + lc * 8) = ra1;
        *(u32x4*)(Bs + lr * LS + lc * 8) = rb0; *(u32x4*)(Bs + (lr + 64) * LS + lc * 8) = rb1;
        __syncthreads();
        if (kt + 1 < nk) { const int ko = (kt + 1) * 64;
            ra0 = *(const u32x4*)(Ag + ko); ra1 = *(const u32x4*)(Ag + (size_t)64 * K + ko); rb0 = *(const u32x4*)(Bg + ko); rb1 = *(const u32x4*)(Bg + (size_t)64 * K + ko); }
        mma_nt<4, 2>(As, LS, wm, Bs, LS, wn, acc[0], lane);
        mma_nt<4, 2>(As, LS, wm + 16, Bs, LS, wn, acc[1], lane);
    }
    const int r = lane & 15, q = lane >> 4;
#pragma unroll
    for (int i = 0; i < 2; ++i)
#pragma unroll
        for (int j = 0; j < 4; ++j)
#pragma unroll
            for (int e = 0; e < 4; ++e) {
                const int row = mt * 128 + wm + 16 * i + 4 * q + e, col = nt * 128 + wn + 16 * j + r; const float v = acc[i][j][e];
                if (mode == 0) { if (col < NP) ((bf16*)(p.ws + WS_P))[(size_t)row * NP + col] = f2bf(v); else if (col < NP + 16) ((float*)(p.ws + WS_G))[(size_t)row * NGS + (col - NP)] = v; else if (col < NP + NG) ((bf16*)((float*)(p.ws + WS_G) + (size_t)row * NGS + 16))[col - NP - 16] = f2bf(v); }
                else if (mode == 2) ((bf16*)(p.ws + WS_HT))[(size_t)row * T + col] = f2bf(v);
                else ((bf16*)(p.ws + WS_P))[(size_t)row * DM + col] = f2bf(v);
            }
}

#ifndef EMU
namespace pg8 {
#define PG8_LAS __attribute__((address_space(3)))
typedef unsigned short bf16_t;
typedef short bf16x8 __attribute__((ext_vector_type(8)));
typedef float f32x4 __attribute__((ext_vector_type(4)));
typedef unsigned u32x4 __attribute__((ext_vector_type(4)));
constexpr int BM = 256, BK = 64, HALF = 128, HTB = HALF * BK * 2  , STAGE_BYTES = 8 * HTB, NXCD = 8, WGM = 8;

__host__ __device__ __forceinline__ int lds_byte(int r, int c) { const int st = (r >> 4) * 2 + (c >> 5), rr = r & 15, cc = c & 31, ob = rr * 64 + cc * 2; return st * 1024 + (ob ^ (((ob >> 9) & 1) << 5)); }
__host__ __device__ __forceinline__ void stage_rc(int b, int& R, int& C) { const int st = b / 1024, sb = b % 1024, swz = sb ^ (((sb >> 9) & 1) << 5); R = (st >> 1) * 16 + swz / 64; C = (st & 1) * 32 + (swz % 64) / 2; }
__host__ __device__ __forceinline__ int perm32(int rho) { const int n = rho >> 4, i = rho & 15; return 8 * (i >> 2) + 4 * n + (i & 3); }

struct Unit { int pm, pn; };
struct Gemm { const bf16_t* A; const bf16_t* Bt; int M, N, K; };
__device__ __forceinline__ unsigned cvt_pk_bf16(float lo, float hi) { unsigned r; asm volatile("v_cvt_pk_bf16_f32 %0, %1, %2" : "=v"(r) : "v"(lo), "v"(hi)); return r; }
template <class Epi, class Sched, bool ALIGN_EPI = false, bool SP2 = false>
__device__ __forceinline__ void gemm_phase(PG8_LAS unsigned char* lds, const Gemm g, const Sched& S, const Epi& E) {
    const int tid = otid(), wid = __builtin_amdgcn_readfirstlane(tid >> 6), lane = tid & 63, wr = wid >> 2, wc = wid & 3, fr = lane & 15, fq = lane >> 4;
    const int K = g.K, nt = K / BK;
    unsigned voffA[2], voffB[2];
#pragma unroll
    for (int i = 0; i < 2; ++i) { int R, C; stage_rc(tid * 16 + i * 8192, R, C); const int Rb = Epi::PERM ? ((R & ~31) + perm32(R & 31)) : R;
        voffA[i] = (unsigned)(R * K + C) * 2u; voffB[i] = (unsigned)(Rb * K + C) * 2u; }
    const size_t kstep = (size_t)(BK * 2);
    const size_t hstep = (size_t)HALF * K * 2;
    const size_t tstep = 2 * hstep;
    const unsigned ldsw = (unsigned)wid * 1024u;
    const int aoff = lds_byte(wr * 64 + fr, fq * 8), boff = lds_byte(wc * 32 + fr, fq * 8);
#define PG8_SA(b, h) (((b) * 2 + (h)) * HTB)
#define PG8_SB(b, h) ((4 + (b) * 2 + (h)) * HTB)
#define PG8_STAGE(bufoff, gbase, voff) do { _Pragma("unroll") for (int _i = 0; _i < 2; ++_i) \
        __builtin_amdgcn_global_load_lds((const unsigned*)((const char*)(gbase) + (voff)[_i]), (PG8_LAS unsigned*)(lds + (bufoff) + ldsw + _i * 8192), 16, 0, 0); } while (0)
#define PG8_LDA(dst, b, h) do { _Pragma("unroll") for (int m = 0; m < 4; ++m) _Pragma("unroll") for (int k = 0; k < 2; ++k) dst[m][k] = *(const PG8_LAS bf16x8*)(lds + PG8_SA(b, h) + aoff + m * 2048 + k * 1024); } while (0)
#define PG8_LDB(dst, b, h) do { _Pragma("unroll") for (int n = 0; n < 2; ++n) _Pragma("unroll") for (int k = 0; k < 2; ++k) dst[n][k] = *(const PG8_LAS bf16x8*)(lds + PG8_SB(b, h) + boff + n * 2048 + k * 1024); } while (0)
#define PG8_MMA(ai, bj, At, Bt) do { __builtin_amdgcn_s_setprio(1); _Pragma("unroll") for (int m = 0; m < 4; ++m) _Pragma("unroll") for (int n = 0; n < 2; ++n) _Pragma("unroll") for (int k = 0; k < 2; ++k) \
        acc[ai][bj][m][n] = __builtin_amdgcn_mfma_f32_16x16x32_bf16(Bt[n][k], At[m][k], acc[ai][bj][m][n], 0, 0, 0); __builtin_amdgcn_s_setprio(0); } while (0)
#define PG8_WAIT_V(n) asm volatile("s_waitcnt vmcnt(" #n ")" ::: "memory")
#define PG8_WAIT_L(n) asm volatile("s_waitcnt lgkmcnt(" #n ")" ::: "memory")
#define PG8_BAR __builtin_amdgcn_s_barrier()
#define PG8_SCHED __builtin_amdgcn_sched_barrier(0)
    Unit cur, nxt; int ui = 0;
    if (!S.next(0, cur)) return;
    f32x4 acc[2][2][4][2];
#pragma unroll
    for (int a = 0; a < 2; ++a)
#pragma unroll
        for (int b = 0; b < 2; ++b)
#pragma unroll
            for (int m = 0; m < 4; ++m)
#pragma unroll
                for (int n = 0; n < 2; ++n) acc[a][b][m][n] = (f32x4){0.f, 0.f, 0.f, 0.f};
    bf16x8 At[4][2], B0[2][2], B1[2][2];
    const char* cA = (const char*)g.A + (size_t)cur.pm * tstep; const char* cB = (const char*)g.Bt + (size_t)cur.pn * tstep;
    S.a_ready(cur);
    if constexpr (SP2) {
        PG8_STAGE(PG8_SB(0, 0), cB, voffB); PG8_STAGE(PG8_SB(0, 1), cB + hstep, voffB); PG8_STAGE(PG8_SA(0, 0), cA, voffA); PG8_STAGE(PG8_SA(0, 1), cA + hstep, voffA);
        if (wr == 1) PG8_BAR;
        PG8_WAIT_V(2); PG8_BAR;
        PG8_STAGE(PG8_SB(1, 0), cB + kstep, voffB); PG8_STAGE(PG8_SA(1, 0), cA + kstep, voffA); PG8_STAGE(PG8_SB(1, 1), cB + hstep + kstep, voffB);
        PG8_WAIT_V(6); PG8_BAR;
    } else {
        PG8_STAGE(PG8_SB(0, 0), cB, voffB); PG8_STAGE(PG8_SA(0, 0), cA, voffA); PG8_STAGE(PG8_SB(0, 1), cB + hstep, voffB); PG8_STAGE(PG8_SA(0, 1), cA + hstep, voffA);
        if (wr == 1) PG8_BAR;
        PG8_WAIT_V(4); PG8_BAR;
        PG8_STAGE(PG8_SB(1, 0), cB + kstep, voffB); PG8_STAGE(PG8_SA(1, 0), cA + kstep, voffA); PG8_STAGE(PG8_SB(1, 1), cB + hstep + kstep, voffB);
        PG8_WAIT_V(6); PG8_BAR;
    }
    for (;;) {
        const bool has_next = S.next(ui + 1, nxt);
        const char* nA = has_next ? (const char*)g.A + (size_t)nxt.pm * tstep : cA; const char* nB = has_next ? (const char*)g.Bt + (size_t)nxt.pn * tstep : cB;
        for (int t = 0; t < nt; t += 2) {
            const bool last = (t == nt - 2);
            const char* a1 = cA + (size_t)(t + 1) * kstep;
            const char* a2 = last ? nA : cA + (size_t)(t + 2) * kstep; const char* b2 = last ? nB : cB + (size_t)(t + 2) * kstep;
            const char* a3 = a2 + kstep; const char* b3 = b2 + kstep;
            if (last && has_next) S.a_ready(nxt);
            if constexpr (SP2) {
            PG8_LDB(B0, 0, 0); PG8_LDB(B1, 0, 1); PG8_SCHED; PG8_LDA(At, 0, 0); PG8_STAGE(PG8_SA(1, 1), a1 + hstep, voffA);
            PG8_WAIT_V(8); PG8_WAIT_L(0); PG8_BAR; PG8_MMA(0, 0, At, B0); PG8_MMA(0, 1, At, B1); PG8_BAR; PG8_SCHED;
            PG8_LDA(At, 0, 1); PG8_STAGE(PG8_SB(0, 0), b2, voffB); PG8_STAGE(PG8_SB(0, 1), b2 + hstep, voffB); PG8_STAGE(PG8_SA(0, 0), a2, voffA);
            PG8_WAIT_V(8); PG8_WAIT_L(0); PG8_BAR; PG8_MMA(1, 0, At, B0); PG8_MMA(1, 1, At, B1); PG8_BAR; PG8_SCHED;
            PG8_LDB(B0, 1, 0); PG8_LDB(B1, 1, 1); PG8_SCHED; PG8_LDA(At, 1, 0); PG8_STAGE(PG8_SA(0, 1), a2 + hstep, voffA);
            PG8_WAIT_V(8); PG8_WAIT_L(0); PG8_BAR; PG8_MMA(0, 0, At, B0); PG8_MMA(0, 1, At, B1); PG8_BAR; PG8_SCHED;
            PG8_LDA(At, 1, 1); PG8_STAGE(PG8_SB(1, 0), b3, voffB); PG8_STAGE(PG8_SB(1, 1), b3 + hstep, voffB); PG8_STAGE(PG8_SA(1, 0), a3, voffA);
            PG8_WAIT_V(8); PG8_WAIT_L(0); PG8_BAR; PG8_MMA(1, 0, At, B0); PG8_MMA(1, 1, At, B1); PG8_BAR; PG8_SCHED;
            } else {
            PG8_LDB(B0, 0, 0); PG8_SCHED; PG8_LDA(At, 0, 0); PG8_STAGE(PG8_SA(1, 1), a1 + hstep, voffA);
            PG8_WAIT_L(8); PG8_BAR; PG8_WAIT_L(0); PG8_MMA(0, 0, At, B0); PG8_BAR; PG8_SCHED;
            PG8_LDB(B1, 0, 1); PG8_STAGE(PG8_SB(0, 0), b2, voffB);
            PG8_BAR; PG8_WAIT_L(0); PG8_MMA(0, 1, At, B1); PG8_BAR;
            PG8_LDA(At, 0, 1); PG8_STAGE(PG8_SA(0, 0), a2, voffA);
            PG8_BAR; PG8_WAIT_L(0); PG8_MMA(1, 0, At, B0); PG8_BAR; PG8_SCHED;
            PG8_STAGE(PG8_SB(0, 1), b2 + hstep, voffB);
            PG8_WAIT_V(6); PG8_BAR; PG8_MMA(1, 1, At, B1); PG8_BAR;
            PG8_LDB(B0, 1, 0); PG8_SCHED; PG8_LDA(At, 1, 0); PG8_STAGE(PG8_SA(0, 1), a2 + hstep, voffA);
            PG8_WAIT_L(8); PG8_BAR; PG8_WAIT_L(0); PG8_MMA(0, 0, At, B0); PG8_BAR; PG8_SCHED;
            PG8_LDB(B1, 1, 1); PG8_STAGE(PG8_SB(1, 0), b3, voffB);
            PG8_BAR; PG8_WAIT_L(0); PG8_MMA(0, 1, At, B1); PG8_BAR;
            PG8_LDA(At, 1, 1); PG8_STAGE(PG8_SA(1, 0), a3, voffA);
            PG8_BAR; PG8_WAIT_L(0); PG8_MMA(1, 0, At, B0); PG8_BAR; PG8_SCHED;
            PG8_STAGE(PG8_SB(1, 1), b3 + hstep, voffB);
            PG8_WAIT_V(6); PG8_BAR; PG8_MMA(1, 1, At, B1); PG8_BAR;
            }
        }
        if constexpr (ALIGN_EPI) { if (wr == 0) PG8_BAR; }
        if constexpr (!Epi::AFTER_DRAIN) { E(acc, cur, wr, wc, fr, fq); S.done(cur); }
        if (!has_next) break;
#pragma unroll
        for (int a = 0; a < 2; ++a)
#pragma unroll
            for (int b = 0; b < 2; ++b)
#pragma unroll
                for (int m = 0; m < 4; ++m)
#pragma unroll
                    for (int n = 0; n < 2; ++n) acc[a][b][m][n] = (f32x4){0.f, 0.f, 0.f, 0.f};
        cur = nxt; cA = nA; cB = nB; ++ui;
        if constexpr (ALIGN_EPI) { if (wr == 1) PG8_BAR; }
    }
    PG8_WAIT_V(0);
    if constexpr (!ALIGN_EPI) { if (wr == 0) PG8_BAR; }
    PG8_BAR;
    if constexpr (Epi::AFTER_DRAIN) { E.fused(acc, cur, wr, wc, fr, fq, lds, wid, lane); S.done(cur); }
#undef PG8_SA
#undef PG8_SB
#undef PG8_STAGE
#undef PG8_LDA
#undef PG8_LDB
#undef PG8_MMA
#undef PG8_WAIT_V
#undef PG8_WAIT_L
#undef PG8_BAR
#undef PG8_SCHED
}
__device__ __forceinline__ void map_tile(int L, int nM, int nN, int& pm, int& pn) {
    const int nwg = nM * nN; int wgid = L; { const int q = nwg / NXCD, r = nwg % NXCD, xcd = wgid % NXCD, off = wgid / NXCD; wgid = (xcd < r ? xcd * (q + 1) : r * (q + 1) + (xcd - r) * q) + off; }
    const int nig = WGM * nN, gid = wgid / nig, fm = gid * WGM, gsz = (nM - fm) < WGM ? (nM - fm) : WGM;
    pm = fm + ((wgid % nig) % gsz); pn = (wgid % nig) / gsz;
}
constexpr int MP = T / 256, WP = NMAIN / 256, NU2 = 4 * MP, NU1 = MP * WP;
struct InOrder { int G, c;
    __device__ __forceinline__ bool next(int i, Unit& u) const { const int L = i * G + c; if (L >= NU2 + NU1) return false; int a, b;
        if (L < NU2) { map_tile(L, 4, MP, a, b); u.pm = MP + WP + a; u.pn = b; } else { map_tile(L - NU2, MP, WP, a, b); u.pm = a; u.pn = MP + b; } return true; }
    __device__ __forceinline__ void a_ready(const Unit&) const {}
    __device__ __forceinline__ void done(const Unit&) const {}
};
struct EpiIn { static constexpr bool PERM = true, AFTER_DRAIN = false; bf16_t* P; float* G; bf16_t* HTp;
    __device__ __forceinline__ void operator()(const f32x4 (&acc)[2][2][4][2], const Unit& u, int wr, int wc, int fr, int fq) const {
        if (u.pm < MP) { const int pn = u.pn - MP, row0 = u.pm * BM + wr * 64 + fr;
            if (pn < NP / 256) { const int col0 = pn * BM + wc * 32 + 8 * fq;
#pragma unroll
                for (int ai = 0; ai < 2; ++ai)
#pragma unroll
                    for (int m = 0; m < 4; ++m) { bf16_t* rowp = P + (size_t)(row0 + ai * HALF + m * 16) * NP + col0;
#pragma unroll
                        for (int bj = 0; bj < 2; ++bj) { const f32x4 v0 = acc[ai][bj][m][0], v1 = acc[ai][bj][m][1];
                            u32x4 w; w.x = cvt_pk_bf16(v0[0], v0[1]); w.y = cvt_pk_bf16(v0[2], v0[3]); w.z = cvt_pk_bf16(v1[0], v1[1]); w.w = cvt_pk_bf16(v1[2], v1[3]); *(u32x4*)(rowp + bj * HALF) = w; } } }
            else { const int cb = wc * 32 + 8 * fq;
                if (cb < NG) {
#pragma unroll
                    for (int ai = 0; ai < 2; ++ai)
#pragma unroll
                        for (int m = 0; m < 4; ++m) { float* rowb = G + (size_t)(row0 + ai * HALF + m * 16) * NGS; const f32x4 v0 = acc[ai][0][m][0], v1 = acc[ai][0][m][1];
                            if (cb < 16) { *(f32x4*)(rowb + cb) = v0; *(f32x4*)(rowb + cb + 4) = v1; }
                            else { u32x4 w; w.x = cvt_pk_bf16(v0[0], v0[1]); w.y = cvt_pk_bf16(v0[2], v0[3]); w.z = cvt_pk_bf16(v1[0], v1[1]); w.w = cvt_pk_bf16(v1[2], v1[3]); *(u32x4*)((bf16_t*)(rowb + 16) + (cb - 16)) = w; } } } } }
        else { const int row0 = (u.pm - MP - WP) * BM + wr * 64 + fr, col0 = u.pn * BM + wc * 32 + 8 * fq;
#pragma unroll
            for (int ai = 0; ai < 2; ++ai)
#pragma unroll
                for (int m = 0; m < 4; ++m) { bf16_t* rowp = HTp + (size_t)(row0 + ai * HALF + m * 16) * T + col0;
#pragma unroll
                    for (int bj = 0; bj < 2; ++bj) { const f32x4 v0 = acc[ai][bj][m][0], v1 = acc[ai][bj][m][1];
                        u32x4 w; w.x = cvt_pk_bf16(v0[0], v0[1]); w.y = cvt_pk_bf16(v0[2], v0[3]); w.z = cvt_pk_bf16(v1[0], v1[1]); w.w = cvt_pk_bf16(v1[2], v1[3]); *(u32x4*)(rowp + bj * HALF) = w; } } }
    }
};
struct OutOrder { int G, c; bool lat_only;
    __device__ __forceinline__ bool next(int i, Unit& u) const { const int nM = lat_only ? NB * (SEQ / 256) : MP, nN = DM / 256; const int L = i * G + c; if (L >= nM * nN) return false; int a, b; map_tile(L, nM, nN, a, b);
        u.pm = lat_only ? (a / (SEQ / 256)) * (TOK / 256) + CTXL / 256 + a % (SEQ / 256) : a; u.pn = b; return true; }
    __device__ __forceinline__ void a_ready(const Unit&) const {}
    __device__ __forceinline__ void done(const Unit&) const {}
};
struct EpiOut { static constexpr bool PERM = true, AFTER_DRAIN = false; bf16_t* C;
    __device__ __forceinline__ void operator()(const f32x4 (&acc)[2][2][4][2], const Unit& u, int wr, int wc, int fr, int fq) const {
        const int row0 = u.pm * BM + wr * 64 + fr, col0 = u.pn * BM + wc * 32 + 8 * fq;
#pragma unroll
        for (int ai = 0; ai < 2; ++ai)
#pragma unroll
            for (int m = 0; m < 4; ++m) { bf16_t* rowp = C + (size_t)(row0 + ai * HALF + m * 16) * DM + col0;
#pragma unroll
                for (int bj = 0; bj < 2; ++bj) { const f32x4 v0 = acc[ai][bj][m][0], v1 = acc[ai][bj][m][1];
                    u32x4 w; w.x = cvt_pk_bf16(v0[0], v0[1]); w.y = cvt_pk_bf16(v0[2], v0[3]); w.z = cvt_pk_bf16(v1[0], v1[1]); w.w = cvt_pk_bf16(v1[2], v1[3]); *(u32x4*)(rowp + bj * HALF) = w; } }
    }
};
}
#endif

__device__ __forceinline__ void phase_gemm_in(const Params& p, int l, char* smem) {
    constexpr int N_F = WG / 2;
#ifdef EMU
    constexpr int MT = T / 128, NT1 = NMAIN / 128, N1 = MT * NT1, N2 = 8 * MT;
    for (int task = obid(); task < N1 + N2; task += gridDim.x) {
        if (task < N1) gemm_tile(p, (const bf16*)(p.ws + WS_HNY), (const bf16*)(p.ws + WS_WIN), DM, task / NT1, task % NT1, 0, smem);
        else { const int t2 = task - N1; gemm_tile(p, (const bf16*)(p.ws + WS_WIN) + (size_t)NMAIN * DM, (const bf16*)(p.ws + WS_HNY), DM, t2 / MT, t2 % MT, 2, smem); }
    }
#else
    { const pg8::Gemm g{(const pg8::bf16_t*)(p.ws + WS_HNY), (const pg8::bf16_t*)(p.ws + WS_HNY), 0, 0, DM};
      const pg8::InOrder S{(int)gridDim.x, obid()};
      const pg8::EpiIn E{(pg8::bf16_t*)(p.ws + WS_P), (float*)(p.ws + WS_G), (pg8::bf16_t*)(p.ws + WS_HT)};
      pg8::gemm_phase<pg8::EpiIn, pg8::InOrder, true, true>((PG8_LAS unsigned char*)smem, g, S, E); }
#endif
    { const int G = (int)gridDim.x, bid = obid();
#ifdef EMU
      const int extra = 0;
#else
      const int extra = (pg8::NU1 + pg8::NU2) % G;
#endif
      if (extra > 0 && extra < G) { if (bid >= extra) for (int task = bid - extra; task < N_F; task += G - extra) filt_fft_task(p, task, smem); }
      else for (int task = G - 1 - bid; task < N_F; task += G) filt_fft_task(p, task, smem); }
}
__device__ __forceinline__ void phase_gemm_out(const Params& p, int l, char* smem) {
    const int G = (int)gridDim.x, bid = obid();
#ifdef EMU
    constexpr int MT = T / 128, NTO = DM / 128;
    for (int task = bid; task < MT * NTO; task += G) {
        const int mt = task / NTO, nt = task % NTO;
        if (l == DEPTH - 1 && (mt % (TOK / 128)) < CTXL / 128) continue;
        gemm_tile(p, (const bf16*)(p.ws + WS_HNY), (const bf16*)(p.ws + WS_WOUT), MIX, mt, nt, 1, smem);
    }
    const int extra = 0;
#else
    const pg8::Gemm g{(const pg8::bf16_t*)(p.ws + WS_HNY), (const pg8::bf16_t*)(p.ws + WS_WOUT), 0, 0, MIX};
    const pg8::OutOrder S{G, bid, l == DEPTH - 1};
    const pg8::EpiOut E{(pg8::bf16_t*)(p.ws + WS_P)};
    pg8::gemm_phase<pg8::EpiOut, pg8::OutOrder, true, true>((PG8_LAS unsigned char*)smem, g, S, E);
    const int nU = (l == DEPTH - 1 ? NB * (SEQ / 256) : T / 256) * (DM / 256); const int extra = nU % G;
#endif
    (void)extra;
}

__device__ __forceinline__ size_t st_index(int mixer, int dir, int b, int h, int cid) { return ((((size_t)(mixer * 2 + dir) * NB + b) * NH + h) * NCH + cid); }
__device__ __forceinline__ size_t ch_index(int dir, int b, int h, int cid) { return (((size_t)dir * NB + b) * NH + h) * NCH + cid; }

__device__ __forceinline__ void load_tile_nat(const bf16* P, int r0, int c0, bf16* dst, float scale, int tid) {
    const int s = tid >> 3, c8 = tid & 7;
    const u32x4 v = *(const u32x4*)(P + (size_t)(r0 + s) * NP + c0 + c8 * 8);
    if (scale == 1.0f) *(u32x4*)(dst + s * LS + c8 * 8) = v;
    else { float f[8]; unpack8(v, f); u32x4 o; o.x = pk2(f[0] * scale, f[1] * scale); o.y = pk2(f[2] * scale, f[3] * scale); o.z = pk2(f[4] * scale, f[5] * scale); o.w = pk2(f[6] * scale, f[7] * scale);
        *(u32x4*)(dst + s * LS + c8 * 8) = o; }
}
__device__ __forceinline__ void load_tile_tr(const bf16* P, int r0, int c0, bf16* dst, int tid) {
    const int s = tid >> 3, c8 = tid & 7;
    const u32x4 v = *(const u32x4*)(P + (size_t)(r0 + s) * NP + c0 + c8 * 8);
    const unsigned w[4] = {v.x, v.y, v.z, v.w};
#pragma unroll
    for (int j = 0; j < 4; ++j) { dst[(c8 * 8 + 2 * j) * LS + s] = (bf16)(w[j] & 0xffffu); dst[(c8 * 8 + 2 * j + 1) * LS + s] = (bf16)(w[j] >> 16); }
}

template <int NTK>
__device__ __forceinline__ void load_span(const bf16* row, int t0, float (&v)[NTK + 2]) {
    v[0] = t0 > 0 ? bf2f(row[-1]) : 0.f; v[NTK + 1] = (t0 + NTK < SEQ) ? bf2f(row[NTK]) : 0.f;
    if constexpr (NTK == 8) { float f[8]; unpack8(*(const u32x4*)row, f);
#pragma unroll
        for (int i = 0; i < 8; ++i) v[1 + i] = f[i]; }
    else {
#pragma unroll
        for (int i = 0; i < NTK; ++i) v[1 + i] = bf2f(row[i]); }
}
template <int NTK>
__device__ __forceinline__ void hy_inputs(const bf16* h0, const bf16* h1, const float* cw, const float* cb, int c, int t0, float (&u0)[NTK], float (&u1)[NTK], float (&g0)[NTK], float (&g1)[NTK]) {
    { float xa[NTK + 2], xb[NTK + 2]; load_span<NTK>(h0 + (size_t)512 * T, t0, xa); load_span<NTK>(h1 + (size_t)512 * T, t0, xb);
        const float w0 = cw[0 * 768 + 512 + c], w1 = cw[1 * 768 + 512 + c], w2 = cw[2 * 768 + 512 + c], bb = cb[512 + c];
        float ga[NTK + 2], gb[NTK + 2]; load_span<NTK>(h0 + (size_t)768 * T, t0, ga); load_span<NTK>(h1 + (size_t)768 * T, t0, gb);
#pragma unroll
        for (int i = 0; i < NTK; ++i) { g0[i] = (w0 * xa[i] + w1 * xa[i + 1] + w2 * xa[i + 2] + bb) * siluf_(ga[i + 1]); g1[i] = (w0 * xb[i] + w1 * xb[i + 1] + w2 * xb[i + 2] + bb) * siluf_(gb[i + 1]); } }
    { float va[NTK + 2], vb[NTK + 2], ya[NTK + 2], yb[NTK + 2];
        load_span<NTK>(h0, t0, va); load_span<NTK>(h1, t0, vb); load_span<NTK>(h0 + (size_t)256 * T, t0, ya); load_span<NTK>(h1 + (size_t)256 * T, t0, yb);
        const float v0 = cw[0 * 768 + c], v1 = cw[1 * 768 + c], v2 = cw[2 * 768 + c], vbias = cb[c];
        const float y0 = cw[0 * 768 + 256 + c], y1 = cw[1 * 768 + 256 + c], y2 = cw[2 * 768 + 256 + c], ybias = cb[256 + c];
#pragma unroll
        for (int i = 0; i < NTK; ++i) { u0[i] = (v0 * va[i] + v1 * va[i + 1] + v2 * va[i + 2] + vbias) * (y0 * ya[i] + y1 * ya[i + 1] + y2 * ya[i + 2] + ybias);
            u1[i] = (v0 * vb[i] + v1 * vb[i + 1] + v2 * vb[i + 2] + vbias) * (y0 * yb[i] + y1 * yb[i + 1] + y2 * yb[i + 2] + ybias); } }
}
__device__ __forceinline__ void hylat_task(const Params& p, int l, int bp, int cp, char* smem) {
    const int tid = otid(), half = tid >> 8, tl = tid & 255, c = 2 * cp + half;
    const bf16* HT = (const bf16*)(p.ws + WS_HT); bf16* Y = (bf16*)(p.ws + WS_HNY);
    cpx* buf = (cpx*)smem + (size_t)half * FBUF;
    const cpx* TW = (const cpx*)(p.ws + WS_TW);
    const cpx* KF = (const cpx*)(p.ws + WS_KF) + (size_t)c * NF;
    constexpr int NTK = SEQ / 256;
    const int t0 = NTK * tl;
    const float* cw = p.in[I_HCW] + (size_t)l * 3 * 768; const float* cb = p.in[I_HCB] + (size_t)l * 768;
    const size_t rb0 = (size_t)(2 * bp) * TOK + CTXL, rb1 = rb0 + TOK;
    const bf16* h0 = HT + (size_t)c * T + rb0 + t0; const bf16* h1 = h0 + TOK;
    { float u0[NTK], u1[NTK], g0[NTK], g1[NTK]; hy_inputs<NTK>(h0, h1, cw, cb, c, t0, u0, u1, g0, g1);
        __syncthreads();
#pragma unroll
        for (int i = 0; i < NTK; ++i) { cpx v; v.x = u0[i]; v.y = u1[i]; buf[FPH(t0 + i)] = v; cpx z = {0.f, 0.f}; buf[FPH(SEQ + t0 + i)] = z; } }
    fft_fwd(buf, TW, tl);
#pragma unroll 2
    for (int i = tl; i < NF; i += 256) buf[FPH(i)] = cmul(buf[FPH(i)], KF[i]);
    fft_inv(buf, TW, tl);
    const float dsk = p.in[I_HD][(size_t)l * WG + c]; const float sc = 1.0f / (float)NF;
    { const int tz = otid() & 255; const int t0z = NTK * tz;
        float u0[NTK], u1[NTK], g0[NTK], g1[NTK]; hy_inputs<NTK>(HT + (size_t)c * T + rb0 + t0z, HT + (size_t)c * T + rb0 + t0z + TOK, cw, cb, c, t0z, u0, u1, g0, g1);
        float o0[NTK], o1[NTK];
#pragma unroll
        for (int i = 0; i < NTK; ++i) { const cpx y = buf[FPH(t0z + i)]; o0[i] = g0[i] * (y.x * sc + u0[i] * dsk); o1[i] = g1[i] * (y.y * sc + u1[i] * dsk); }
        bf16* d0 = (bf16*)(p.ws + WS_HT) + (size_t)(768 + c) * T + rb0 + t0z; bf16* d1 = d0 + TOK;
        if constexpr (NTK == 8) { *(u32x4*)d0 = pack8(o0); *(u32x4*)d1 = pack8(o1); }
        else {
#pragma unroll
            for (int i = 0; i < NTK; ++i) { d0[i] = f2bf(o0[i]); d1[i] = f2bf(o1[i]); } } }
}

constexpr int HCB = 16;
__device__ __forceinline__ void hyctx_task(const Params& p, int l, int b, int cblk, char* smem) {
    const int tid = otid(); const int c0 = cblk * HCB;
    const bf16* HT = (const bf16*)(p.ws + WS_HT); bf16* Y = (bf16*)(p.ws + WS_HNY); const float* HC = (const float*)(p.ws + WS_HC);
    float* raw = (float*)smem;
    float* u = raw + 4 * CTXL * HCB;
    float* og = u + CTXL * HCB;
    float* hcm = og + CTXL * HCB;
    bf16* ob = (bf16*)raw;
    const size_t rb = (size_t)b * TOK;
    const float* cw = p.in[I_HCW] + (size_t)l * 3 * 768; const float* cbias = p.in[I_HCB] + (size_t)l * 768;
    constexpr int WT = CTXL / 32;
    __syncthreads();
    for (int i = tid; i < 4 * HCB * (CTXL / 8); i += NT) { const int k = i / (HCB * (CTXL / 8)), cc = (i / (CTXL / 8)) % HCB, ck = i % (CTXL / 8);
        float f[8]; unpack8(*(const u32x4*)(HT + (size_t)(k * 256 + c0 + cc) * T + rb + ck * 8), f);
#pragma unroll
        for (int j = 0; j < 8; ++j) raw[(k * CTXL + ck * 8 + j) * HCB + cc] = f[j]; }
    for (int i = tid; i < 2 * HCB * (CTXL / 4); i += NT) { const int dir = i / (HCB * (CTXL / 4)), cc = (i / (CTXL / 4)) % HCB, pk = i % (CTXL / 4);
        const f32x4 v = *(const f32x4*)(HC + ((size_t)dir * WG + c0 + cc) * CTXL + pk * 4); const float f[4] = {v.x, v.y, v.z, v.w};
#pragma unroll
        for (int j = 0; j < 4; ++j) { const int pos = pk * 4 + j; if (dir == 0) hcm[(CTXL + pos) * HCB + cc] = f[j]; else if (pos > 0) hcm[(CTXL - pos) * HCB + cc] = f[j]; } }
    if (tid < HCB) hcm[tid] = 0.f;
    __syncthreads();
    for (int i = tid; i < CTXL * HCB; i += NT) { const int t = i / HCB, cc = i % HCB; float cv[3];
#pragma unroll
        for (int k = 0; k < 3; ++k) { const float* rk = raw + k * CTXL * HCB; const int ch = k * 256 + c0 + cc;
            const float a = t > 0 ? rk[(t - 1) * HCB + cc] : 0.f, m = rk[t * HCB + cc], z = t < CTXL - 1 ? rk[(t + 1) * HCB + cc] : 0.f;
            cv[k] = cw[0 * 768 + ch] * a + cw[1 * 768 + ch] * m + cw[2 * 768 + ch] * z + cbias[ch]; }
        u[i] = cv[0] * cv[1];
        og[i] = cv[2] * siluf_(raw[(3 * CTXL + t) * HCB + cc]); }
    __syncthreads();
    { const int cc = tid % HCB, tg = tid / HCB, t0 = WT * tg; float acc[WT], w[WT];
#pragma unroll
        for (int j = 0; j < WT; ++j) { acc[j] = 0.f; w[j] = hcm[(t0 + j + CTXL) * HCB + cc]; }
#pragma unroll 8
        for (int s = 0; s < CTXL; ++s) { const float us = u[s * HCB + cc];
#pragma unroll
            for (int j = 0; j < WT; ++j) acc[j] += us * w[j];
#pragma unroll
            for (int j = WT - 1; j > 0; --j) w[j] = w[j - 1];
            w[0] = hcm[(t0 - s - 1 + CTXL) * HCB + cc]; }
        const float dsk = p.in[I_HD][(size_t)l * WG + c0 + cc];
#pragma unroll
        for (int j = 0; j < WT; ++j) { const int t = t0 + j; ob[t * HCB + cc] = f2bf(og[t * HCB + cc] * (acc[j] + u[t * HCB + cc] * dsk)); } }
    __syncthreads();
    for (int i = tid; i < CTXL * 2; i += NT) { const int t = i >> 1, hh = i & 1; *(u32x4*)(Y + (rb + t) * 1024 + YH + c0 + 8 * hh) = *(const u32x4*)(ob + t * HCB + 8 * hh); }
}

__device__ __forceinline__ void attn_task(const Params& p, int l, int b, int kvh, int qt, bool ctxq, char* smem) {
    const int tid = otid(), lane = tid & 63, wave = tid >> 6, r = lane & 15, q = lane >> 4;
    const bf16* P = (const bf16*)(p.ws + WS_P); bf16* Y = (bf16*)(p.ws + WS_HNY); const cpx* ROPE = (const cpx*)(p.ws + WS_ROPE);
    bf16* Qs = (bf16*)smem;
    bf16* Ks = Qs + 256 * LS;
    bf16* Vt = Ks + 64 * LS;
    bf16* Ps = Vt + 64 * LS;
    const size_t rq0 = (size_t)b * TOK + (ctxq ? 0 : CTXL) + qt * 128;
    __syncthreads();
#pragma unroll
    for (int it = 0; it < 2; ++it) {
        const int idx = tid + NT * it, row = idx >> 2, cpair = idx & 3, g = row >> 7, t = row & 127;
        const bf16* src = P + (rq0 + t) * NP + PD + (kvh * 2 + g) * 64;
        float lo[8], hi[8]; unpack8(*(const u32x4*)(src + cpair * 8), lo); unpack8(*(const u32x4*)(src + 32 + cpair * 8), hi);
        float a[8], c2[8];
#pragma unroll
        for (int j = 0; j < 8; ++j) { float cs = 1.f, sn = 0.f; if (!ctxq) { const cpx cv = ROPE[(size_t)(qt * 128 + t) * 32 + cpair * 8 + j]; cs = cv.x; sn = cv.y; }
            a[j] = (lo[j] * cs - hi[j] * sn) * 0.125f; c2[j] = (hi[j] * cs + lo[j] * sn) * 0.125f; }
        *(u32x4*)(Qs + row * LS + cpair * 8) = pack8(a); *(u32x4*)(Qs + row * LS + 32 + cpair * 8) = pack8(c2);
    }
    const int lt0 = ctxq ? 0 : (2 * qt - 2 > 0 ? 2 * qt - 2 : 0), lt1 = ctxq ? -1 : (2 * qt + 3 < SEQ / 64 - 1 ? 2 * qt + 3 : SEQ / 64 - 1);
    const int nloc = lt1 - lt0 + 1, ntiles = nloc + NCC;
    float m[2][4], lsum[2][4]; f32x4 O[2][4];
#pragma unroll
    for (int ms = 0; ms < 2; ++ms)
#pragma unroll
        for (int i = 0; i < 4; ++i) { m[ms][i] = -INFINITY; lsum[ms][i] = 0.f; O[ms][i] = (f32x4){0.f, 0.f, 0.f, 0.f}; }
    const int g = wave >> 2, tq0 = (wave & 3) * 32;
    bf16* Pw = Ps + wave * 32 * LS;
    u32x4 klo = {0u, 0u, 0u, 0u}, khi = klo, vq = klo; f32x4 rp[4] = {(f32x4){1.f, 0.f, 1.f, 0.f}, (f32x4){1.f, 0.f, 1.f, 0.f}, (f32x4){1.f, 0.f, 1.f, 0.f}, (f32x4){1.f, 0.f, 1.f, 0.f}};
    const int ks_ = tid >> 2, kcp = tid & 3, vs_ = tid >> 3, vc8 = tid & 7;
#define ATT_PREFETCH(TI) do { const bool loc_ = (TI) < nloc; const int kt_ = loc_ ? lt0 + (TI) : (TI) - nloc; const size_t rk_ = (size_t)b * TOK + (loc_ ? CTXL : 0) + kt_ * 64; \
        if (tid < 256) { const bf16* src_ = P + (rk_ + ks_) * NP + PD + 256 + kvh * 64; klo = *(const u32x4*)(src_ + kcp * 8); khi = *(const u32x4*)(src_ + 32 + kcp * 8); \
            if (loc_) { const f32x4* rr_ = (const f32x4*)(ROPE + (size_t)(kt_ * 64 + ks_) * 32 + kcp * 8); rp[0] = rr_[0]; rp[1] = rr_[1]; rp[2] = rr_[2]; rp[3] = rr_[3]; } \
            else { rp[0] = rp[1] = rp[2] = rp[3] = (f32x4){1.f, 0.f, 1.f, 0.f}; } } \
        vq = *(const u32x4*)(P + (rk_ + vs_) * NP + PD + 384 + kvh * 64 + vc8 * 8); } while (0)
    ATT_PREFETCH(0);
    for (int ti = 0; ti < ntiles; ++ti) {
        const bool local = ti < nloc; const int kt = local ? lt0 + ti : ti - nloc;
        __syncthreads();
        if (tid < 256) { float lo[8], hi[8]; unpack8(klo, lo); unpack8(khi, hi);
            const float cs[8] = {rp[0].x, rp[0].z, rp[1].x, rp[1].z, rp[2].x, rp[2].z, rp[3].x, rp[3].z}, sn[8] = {rp[0].y, rp[0].w, rp[1].y, rp[1].w, rp[2].y, rp[2].w, rp[3].y, rp[3].w};
            float a[8], c2[8];
#pragma unroll
            for (int j = 0; j < 8; ++j) { a[j] = lo[j] * cs[j] - hi[j] * sn[j]; c2[j] = hi[j] * cs[j] + lo[j] * sn[j]; }
            *(u32x4*)(Ks + ks_ * LS + kcp * 8) = pack8(a); *(u32x4*)(Ks + ks_ * LS + 32 + kcp * 8) = pack8(c2); }
        { const unsigned w[4] = {vq.x, vq.y, vq.z, vq.w};
#pragma unroll
            for (int j = 0; j < 4; ++j) { Vt[(vc8 * 8 + 2 * j) * LS + vs_] = (bf16)(w[j] & 0xffffu); Vt[(vc8 * 8 + 2 * j + 1) * LS + vs_] = (bf16)(w[j] >> 16); } }
        __syncthreads();
        if (ti + 1 < ntiles) ATT_PREFETCH(ti + 1);
#pragma unroll
        for (int ms = 0; ms < 2; ++ms) {
            const int qlo = qt * 128 + tq0 + 16 * ms, klo_ = kt * 64;
            if (local && (klo_ > qlo + 15 + 128 || klo_ + 63 < qlo - 128)) continue;
            f32x4 S[4] = {(f32x4){0.f, 0.f, 0.f, 0.f}, (f32x4){0.f, 0.f, 0.f, 0.f}, (f32x4){0.f, 0.f, 0.f, 0.f}, (f32x4){0.f, 0.f, 0.f, 0.f}};
            mma_nt<4, 2>(Qs, LS, g * 128 + tq0 + 16 * ms, Ks, LS, 0, S, lane);
            float rmax[4];
#pragma unroll
            for (int i = 0; i < 4; ++i) { const int qpos = qlo + 4 * q + i; float mx = -INFINITY;
#pragma unroll
                for (int nt = 0; nt < 4; ++nt) { if (local) { const int kpos = kt * 64 + nt * 16 + r; const int d = kpos - qpos; if (d > 128 || d < -128) S[nt][i] = -INFINITY; } mx = fmaxf(mx, S[nt][i]); }
                rmax[i] = row16_max(mx); }
#pragma unroll
            for (int i = 0; i < 4; ++i) { const float mn = fmaxf(m[ms][i], rmax[i]); const float msafe = mn == -INFINITY ? 0.f : mn; const float alpha = __expf(m[ms][i] - msafe); float sm = 0.f;
#pragma unroll
                for (int nt = 0; nt < 4; ++nt) { const float pv = __expf(S[nt][i] - msafe); sm += pv; Pw[(16 * ms + 4 * q + i) * LS + nt * 16 + r] = f2bf(pv); O[ms][nt][i] *= alpha; }
                sm = row16_sum(sm);
                lsum[ms][i] = lsum[ms][i] * alpha + sm; m[ms][i] = mn; }
            WAVE_SYNC();
            mma_nt<4, 2>(Pw, LS, 16 * ms, Vt, LS, 0, O[ms], lane);
        }
    }
#undef ATT_PREFETCH
    const float sink = p.in[I_SINK][(size_t)l * NH + kvh * 2 + g];
    WAVE_SYNC();
#pragma unroll
    for (int ms = 0; ms < 2; ++ms)
#pragma unroll
        for (int i = 0; i < 4; ++i) { const float den = lsum[ms][i] + __expf(sink - m[ms][i]); const float inv = frcp_(den);
#pragma unroll
            for (int nt = 0; nt < 4; ++nt) Pw[(16 * ms + 4 * q + i) * LS + nt * 16 + r] = f2bf(O[ms][nt][i] * inv); }
    WAVE_SYNC();
#pragma unroll
    for (int hh = 0; hh < 4; ++hh) { const int t = lane >> 1, ck = (lane & 1) * 4 + hh;
        float fo[8], fg[8]; unpack8(*(const u32x4*)(Pw + t * LS + ck * 8), fo);
        unpack8(*(const u32x4*)(P + (rq0 + tq0 + t) * NP + PD + 512 + (kvh * 2 + g) * 64 + ck * 8), fg);
#pragma unroll
        for (int j = 0; j < 8; ++j) fo[j] *= siluf_(fg[j]);
        *(u32x4*)(Y + (rq0 + tq0 + t) * 1024 + YD + (kvh * 2 + g) * 64 + ck * 8) = pack8(fo); }
}

#ifdef EMU
__device__ __forceinline__ int olane(int lane) { return lane; }
#else
__device__ __forceinline__ int olane(int lane) { asm volatile("" : "+v"(lane)); return lane; }
#endif
__device__ __forceinline__ void load_nat_tile(const bf16* P, int row0, int col0, bf16* tile, int lane) {
    u32x4 v[8];
#pragma unroll
    for (int i = 0; i < 8; ++i) v[i] = *(const u32x4*)(P + (size_t)(row0 + (lane >> 3) + 8 * i) * NP + col0 + (lane & 7) * 8);
#pragma unroll
    for (int i = 0; i < 8; ++i) *(u32x4*)(tile + swz((lane >> 3) + 8 * i, lane & 7)) = v[i];
}
__device__ __forceinline__ bf16x8 frag_tr(const bf16* tile, int c0, int k0, int lane) {
    const int c = c0 + (lane & 15), kb = k0 + 8 * (lane >> 4); unsigned w[4];
#pragma unroll
    for (int j = 0; j < 4; ++j) w[j] = (unsigned)tile[swz(kb + 2 * j, c >> 3) + (c & 7)] | ((unsigned)tile[swz(kb + 2 * j + 1, c >> 3) + (c & 7)] << 16);
    u32x4 o; o.x = w[0]; o.y = w[1]; o.z = w[2]; o.w = w[3]; return as_frag(o);
}
template <int DIR>
__device__ __forceinline__ void gla_r_frags(const float* Grow0, int lane, bf16x8 (&af)[4]) {
    const int r = lane & 15, q4 = lane >> 4;
#pragma unroll
    for (int mt = 0; mt < 4; ++mt) { u32x4 o = {0u, 0u, 0u, 0u};
        if (q4 < 2) o = *(const u32x4*)((const bf16*)(Grow0 + (size_t)(16 * mt + r) * NGS + 16) + DIR * 16 + 8 * q4);
        af[mt] = as_frag(o); }
}
template <int DIR>
__device__ __forceinline__ float gla_b_col(const Params& p, int l, int h, const bf16x8 (&af)[4], int nt, int lane_, float (&x)[4][4]) {
    const int lane = olane(lane_), r = lane & 15, q4 = lane >> 4, d = h * 64 + 16 * nt + r;
    u32x4 o = {0u, 0u, 0u, 0u};
    if (q4 < 2) { const float* wa = p.in[I_GWA] + ((size_t)(l * 2 + DIR) * 16 + 8 * q4) * WG + d;
        o.x = pk2(wa[0], wa[WG]); o.y = pk2(wa[2 * WG], wa[3 * WG]); o.z = pk2(wa[4 * WG], wa[5 * WG]); o.w = pk2(wa[6 * WG], wa[7 * WG]); }
    const bf16x8 bfr = as_frag(o); const float bias = p.in[I_GBA][(size_t)(l * 2 + DIR) * WG + d];
#pragma unroll
    for (int mt = 0; mt < 4; ++mt) { f32x4 c = {bias, bias, bias, bias}; c = MFMA16(af[mt], bfr, c);
#pragma unroll
        for (int i = 0; i < 4; ++i) x[mt][i] = logsig_fast(c[i]) * (1.0f / 16.0f); }
    float carry = 0.f;
#pragma unroll
    for (int k = 0; k < 4; ++k) { const int mt = DIR == 0 ? k : 3 - k; float* y = x[mt];
        if (DIR == 0) { y[1] += y[0]; y[2] += y[1]; y[3] += y[2]; } else { y[2] += y[3]; y[1] += y[2]; y[0] += y[1]; }
        const float s4 = DIR == 0 ? y[3] : y[0];
        const float t1 = DIR == 0 ? __shfl_up(s4, 16) : __shfl_down(s4, 16), t2 = DIR == 0 ? __shfl_up(s4, 32) : __shfl_down(s4, 32), t3 = DIR == 0 ? __shfl_up(s4, 48) : __shfl_down(s4, 48);
        const int qq = DIR == 0 ? q4 : 3 - q4;
        const float e = (qq >= 1 ? t1 : 0.f) + (qq >= 2 ? t2 : 0.f) + (qq >= 3 ? t3 : 0.f);
        const float tot = __shfl(e + s4, DIR == 0 ? r + 48 : r);
#pragma unroll
        for (int i = 0; i < 4; ++i) y[i] += carry + e;
        carry += tot; }
    return carry;
}

template <int MIXER, int DIR>
__device__ __forceinline__ void chunkst_dir(const Params& p, int l, int b, int h, int cid, const float* Grow0, const unsigned (&kk)[32], const bf16* Vt, bf16* Kt, const float* wvs, float* bendl, int lane_) {
    const int lane = olane(lane_), r = lane & 15, q4 = lane >> 4;
    if constexpr (MIXER == 0) {
        float nacc = 0.f;
#pragma unroll
        for (int c = 0; c < 8; ++c) { float f[8];
#pragma unroll
            for (int j = 0; j < 8; ++j) { const int s = 8 * c + j; const float kv = (s & 1) ? bitsf(kk[s >> 1] & 0xffff0000u) : bitsf(kk[s >> 1] << 16);
                f[j] = kv * 0.125f * wvs[DIR * 64 + s]; nacc += f[j]; }
            *(u32x4*)(Kt + swz(lane, c)) = pack8(f); }
        ((float*)(p.ws + WS_NV))[ch_index(DIR, b, h, cid) * 64 + lane] = nacc;
    } else {
        const bf16* P = (const bf16*)(p.ws + WS_P); const int kcol = PG + 256 + h * 64; const int r0 = b * TOK + cid * 64;
        bf16x8 af[4]; gla_r_frags<DIR>(Grow0, lane, af);
#pragma unroll 2
        for (int nt = 0; nt < 4; ++nt) { const int d = 16 * nt + r; float x[4][4];
            const float bend = gla_b_col<DIR>(p, l, h, af, nt, lane, x);
            if (q4 == 0) { ((float*)(p.ws + WS_BE))[ch_index(DIR, b, h, cid) * 64 + d] = bend; bendl[d] = __expf(fmaxf(bend, -80.0f)); }
#pragma unroll
            for (int mt = 0; mt < 4; ++mt)
#pragma unroll
                for (int i = 0; i < 4; ++i) { const int s = 16 * mt + 4 * q4 + i; const float kv = bf2f(P[(size_t)(r0 + s) * NP + kcol + d]); const float bc = fmaxf(x[mt][i], -80.0f);
                    Kt[swz(d, s >> 3) + (s & 7)] = f2bf(kv * __expf(-bc));
                    ((bf16*)(p.ws + WS_EQ))[((size_t)DIR * T + r0 + s) * WG + h * 64 + d] = f2bf(__expf(bc)); } }
    }
    WAVE_SYNC();
    bf16x8 vf[4][2];
#pragma unroll
    for (int ne = 0; ne < 4; ++ne)
#pragma unroll
        for (int ks = 0; ks < 2; ++ks) vf[ne][ks] = *(const bf16x8*)(Vt + swz(16 * ne + r, ks * 4 + q4));
    bf16* dst = (bf16*)(p.ws + WS_ST) + st_index(MIXER, DIR, b, h, cid) * 4096;
#pragma unroll
    for (int me = 0; me < 4; ++me) {
        f32x4 acc[4] = {(f32x4){0.f, 0.f, 0.f, 0.f}, (f32x4){0.f, 0.f, 0.f, 0.f}, (f32x4){0.f, 0.f, 0.f, 0.f}, (f32x4){0.f, 0.f, 0.f, 0.f}};
#pragma unroll
        for (int ks = 0; ks < 2; ++ks) { const bf16x8 a = *(const bf16x8*)(Kt + swz(16 * me + r, ks * 4 + q4));
#pragma unroll
            for (int ne = 0; ne < 4; ++ne) acc[ne] = MFMA16(a, vf[ne][ks], acc[ne]); }
        f32x4 sc4 = {1.f, 1.f, 1.f, 1.f}; if constexpr (MIXER == 1) sc4 = *(const f32x4*)(bendl + 16 * me + 4 * q4);
#pragma unroll
        for (int ne = 0; ne < 4; ++ne) { const f32x4 v = acc[ne] * sc4; u32x2 o; o.x = pk2(v[0], v[1]); o.y = pk2(v[2], v[3]); *(u32x2*)(dst + (16 * ne + r) * 64 + 16 * me + 4 * q4) = o; }
    }
    WAVE_SYNC();
}
template <int MIXER>
__device__ __forceinline__ void chunkst_w(const Params& p, int l, int b, int h, int cid, char* wl, int lane) {
    const bf16* P = (const bf16*)(p.ws + WS_P); const float* G = (const float*)(p.ws + WS_G);
    const int r0 = b * TOK + cid * 64, r = lane & 15, q4 = lane >> 4;
    bf16* Kt = (bf16*)wl;
    bf16* Vt = Kt + 4096;
    float* wvs = (float*)(Vt + 4096);
    float* bendl = wvs + 128;
    const int kcol = (MIXER == 0 ? PA : PG) + 256 + h * 64, vcol = (MIXER == 0 ? PA : PG) + 512 + h * 64;
    const float* Grow0 = G + (size_t)r0 * NGS;
    { bf16* Nn = Kt;
        load_nat_tile(P, r0, vcol, Nn, lane);
        WAVE_SYNC();
#pragma unroll
        for (int c = 0; c < 8; ++c) { unsigned w[4];
#pragma unroll
            for (int j = 0; j < 4; ++j) w[j] = (unsigned)Nn[swz(8 * c + 2 * j, lane >> 3) + (lane & 7)] | ((unsigned)Nn[swz(8 * c + 2 * j + 1, lane >> 3) + (lane & 7)] << 16);
            u32x4 o; o.x = w[0]; o.y = w[1]; o.z = w[2]; o.w = w[3]; *(u32x4*)(Vt + swz(lane, c)) = o; }
        WAVE_SYNC();
        load_nat_tile(P, r0, kcol, Nn, lane);
        WAVE_SYNC(); }
    unsigned kk[32];
    { const bf16* Nn = Kt;
#pragma unroll
        for (int i = 0; i < 32; ++i) kk[i] = (unsigned)Nn[swz(2 * i, lane >> 3) + (lane & 7)] | ((unsigned)Nn[swz(2 * i + 1, lane >> 3) + (lane & 7)] << 16); }
    WAVE_SYNC();
    if constexpr (MIXER == 0) {
        const float* g = Grow0 + (size_t)lane * NGS; const float* gb = p.in[I_MGB] + (size_t)l * 16;
        const float i_f = g[h] + gb[h], f_f = g[4 + h] + gb[4 + h], i_b = g[8 + h] + gb[8 + h], f_b = g[12 + h] + gb[12 + h];
        const float lf = logsigf_(f_f), lb = logsigf_(f_b);
        const float bF = wave_prefix_sum(lf, lane), totF = __shfl(bF, 63);
        const float gF = totF - bF + i_f, mF = wave_max(gF);
        const float totB = wave_sum(lb), preB = wave_prefix_sum(lb, lane), bB = totB - preB + lb;
        const float gB = totB - bB + i_b, mB = wave_max(gB);
        wvs[lane] = __expf(gF - mF); wvs[64 + lane] = __expf(gB - mB);
        if (lane == 0) { float* SC = (float*)(p.ws + WS_SC);
            SC[ch_index(0, b, h, cid) * 4 + 0] = totF; SC[ch_index(0, b, h, cid) * 4 + 1] = mF;
            SC[ch_index(1, b, h, cid) * 4 + 0] = totB; SC[ch_index(1, b, h, cid) * 4 + 1] = mB; }
    }
    WAVE_SYNC();
    chunkst_dir<MIXER, 0>(p, l, b, h, cid, Grow0, kk, Vt, Kt, wvs, bendl, lane);
    chunkst_dir<MIXER, 1>(p, l, b, h, cid, Grow0, kk, Vt, Kt, wvs, bendl, lane);
}

template <int DIR>
__device__ __forceinline__ void chunkst_gla(const Params& p, int l, int b, int h, int cid, char* wl, int lane_) {
    const bf16* P = (const bf16*)(p.ws + WS_P);
    const int lane = olane(lane_), r0 = b * TOK + cid * 64, r = lane & 15, q4 = lane >> 4;
    bf16* Kt = (bf16*)wl;
    bf16* An = Kt + 4096;
    float* bendl = (float*)(An + 4096);
    const int kcol = PG + 256 + h * 64, vcol = PG + 512 + h * 64;
    const float* Grow0 = (const float*)(p.ws + WS_G) + (size_t)r0 * NGS;
    load_nat_tile(P, r0, vcol, An, lane);
    WAVE_SYNC();
    bf16x8 vf[4][2];
#pragma unroll
    for (int ne = 0; ne < 4; ++ne)
#pragma unroll
        for (int ks = 0; ks < 2; ++ks) vf[ne][ks] = frag_tr(An, 16 * ne, 32 * ks, lane);
    WAVE_SYNC();
    load_nat_tile(P, r0, kcol, An, lane);
    WAVE_SYNC();
    bf16x8 af[4]; gla_r_frags<DIR>(Grow0, lane, af);
#pragma unroll 2
    for (int nt = 0; nt < 4; ++nt) { const int d = 16 * nt + r; float x[4][4];
        const float bend = gla_b_col<DIR>(p, l, h, af, nt, lane, x);
        if (q4 == 0) { ((float*)(p.ws + WS_BE))[ch_index(DIR, b, h, cid) * 64 + d] = bend; bendl[d] = __expf(fmaxf(bend, -80.0f)); }
#pragma unroll
        for (int mt = 0; mt < 4; ++mt)
#pragma unroll
            for (int i = 0; i < 4; ++i) { const int s = 16 * mt + 4 * q4 + i; bf16* ke = An + swz(s, d >> 3) + (d & 7); const float kv = bf2f(*ke); const float bc = fmaxf(x[mt][i], -80.0f);
                Kt[swz(d, s >> 3) + (s & 7)] = f2bf(kv * __expf(-bc));
                *ke = f2bf(__expf(bc)); } }
    WAVE_SYNC();
    { bf16* EQg = (bf16*)(p.ws + WS_EQ) + ((size_t)DIR * T + r0) * WG + h * 64;
#pragma unroll
        for (int i = 0; i < 8; ++i) { const int s = (lane >> 3) + 8 * i, ck = lane & 7; *(u32x4*)(EQg + (size_t)s * WG + ck * 8) = *(const u32x4*)(An + swz(s, ck)); } }
    bf16* dst = (bf16*)(p.ws + WS_ST) + st_index(1, DIR, b, h, cid) * 4096;
#pragma unroll
    for (int me = 0; me < 4; ++me) {
        f32x4 acc[4] = {(f32x4){0.f, 0.f, 0.f, 0.f}, (f32x4){0.f, 0.f, 0.f, 0.f}, (f32x4){0.f, 0.f, 0.f, 0.f}, (f32x4){0.f, 0.f, 0.f, 0.f}};
#pragma unroll
        for (int ks = 0; ks < 2; ++ks) { const bf16x8 a = *(const bf16x8*)(Kt + swz(16 * me + r, ks * 4 + q4));
#pragma unroll
            for (int ne = 0; ne < 4; ++ne) acc[ne] = MFMA16(a, vf[ne][ks], acc[ne]); }
        const f32x4 sc4 = *(const f32x4*)(bendl + 16 * me + 4 * q4);
#pragma unroll
        for (int ne = 0; ne < 4; ++ne) { const f32x4 v = acc[ne] * sc4; u32x2 o; o.x = pk2(v[0], v[1]); o.y = pk2(v[2], v[3]); *(u32x2*)(dst + (16 * ne + r) * 64 + 16 * me + 4 * q4) = o; }
    }
    WAVE_SYNC();
}

template <int MIXER, int DIR>
__device__ __forceinline__ void chunkout_prep(const Params& p, int l, int b, int h, int cid, const float* Grow0, int r0, int pbase, const bf16* EQ, float* gar, int lane_) {
    const int lane = olane(lane_);
    if constexpr (MIXER == 0) {
        const bf16* P = (const bf16*)(p.ws + WS_P);
        const float* g = Grow0 + (size_t)lane * NGS; const float* gb = p.in[I_MGB] + (size_t)l * 16;
        const float ig = g[DIR * 8 + h] + gb[DIR * 8 + h], fg = g[DIR * 8 + 4 + h] + gb[DIR * 8 + 4 + h];
        const float mprev = ((const float*)(p.ws + WS_SC))[ch_index(DIR, b, h, cid) * 4 + 2];
        const float lf = logsigf_(fg); float bb;
        if (DIR == 0) bb = wave_prefix_sum(lf, lane); else { const float tt = wave_sum(lf), pre = wave_prefix_sum(lf, lane); bb = tt - pre + lf; }
        const float a = ig - bb; const float pm = DIR == 0 ? wave_prefix_max(a, lane) : wave_suffix_max(a, lane);
        const float mt_ = fmaxf(bb + mprev, bb + pm);
        float* ga = gar + DIR * 320;
        ga[lane] = bb - mt_; ga[64 + lane] = a; ga[128 + lane] = __expf(bb + mprev - mt_); ga[192 + lane] = __expf(-mt_);
        float* nvl = gar + 640 + DIR * 64;
        nvl[lane] = ((const float*)(p.ws + WS_NV))[ch_index(DIR, b, h, cid) * 64 + lane];
        WAVE_SYNC();
        float dq = 0.f;
#pragma unroll
        for (int c = 0; c < 8; ++c) { float f[8]; unpack8(*(const u32x4*)(P + (size_t)(r0 + lane) * NP + pbase + c * 8), f);
            const f32x4 n0 = *(const f32x4*)(nvl + c * 8), n1 = *(const f32x4*)(nvl + c * 8 + 4);
            dq += f[0] * n0.x + f[1] * n0.y + f[2] * n0.z + f[3] * n0.w + f[4] * n1.x + f[5] * n1.y + f[6] * n1.z + f[7] * n1.w; }
        ga[256 + lane] = dq;
    }
}
template <int MIXER, int DIR, int NS>
__device__ __forceinline__ void chunkout_dir(const Params& p, int b, int h, int cid, int r0, int pbase, int th, const bf16x8 (&vtf)[4][2], const bf16* VtL, const bf16* EQ, bf16* SB, const float* gar, float* rsm, f32x4 (&htot)[NS][4], int lane_) {
    const bf16* P = (const bf16*)(p.ws + WS_P); const bf16* ST = (const bf16*)(p.ws + WS_ST);
    const int lane = olane(lane_), r = lane & 15, q4 = lane >> 4;
    const bf16* E = EQ + ((size_t)DIR * T + r0) * WG + h * 64;
    const float* ga = gar + DIR * 320;
    bf16x8 kf[4][2], ctf[4][2];
#pragma unroll
    for (int n = 0; n < 4; ++n)
#pragma unroll
        for (int ks = 0; ks < 2; ++ks) { if constexpr (MIXER == 0) kf[n][ks] = vtf[n][ks];
            else kf[n][ks] = *(const bf16x8*)(P + (size_t)(r0 + 16 * n + r) * NP + pbase + 256 + ks * 32 + q4 * 8);
            ctf[n][ks] = *(const bf16x8*)(ST + st_index(MIXER, DIR, b, h, cid) * 4096 + (16 * n + r) * 64 + ks * 32 + q4 * 8);
            if constexpr (MIXER == 1) { float fe[8], fk[8]; unpack8(*(const u32x4*)(E + (size_t)(16 * n + r) * WG + ks * 32 + q4 * 8), fe); unpack8(as_u4(kf[n][ks]), fk);
#pragma unroll
                for (int j = 0; j < 8; ++j) fk[j] = fk[j] * frcp_(fe[j]);
                kf[n][ks] = as_frag(pack8(fk)); } }
#pragma unroll
    for (int ms = 0; ms < NS; ++ms) { const int mt = NS * th + ms;
        bf16x8 qf[2];
#pragma unroll
        for (int ks = 0; ks < 2; ++ks) { qf[ks] = *(const bf16x8*)(P + (size_t)(r0 + 16 * mt + r) * NP + pbase + ks * 32 + q4 * 8);
            if constexpr (MIXER == 1) { float fe[8], fq[8]; unpack8(*(const u32x4*)(E + (size_t)(16 * mt + r) * WG + ks * 32 + q4 * 8), fe); unpack8(as_u4(qf[ks]), fq);
#pragma unroll
                for (int j = 0; j < 8; ++j) fq[j] *= 0.125f * fe[j];
                qf[ks] = as_frag(pack8(fq)); } }
        f32x4 S[4] = {(f32x4){0.f, 0.f, 0.f, 0.f}, (f32x4){0.f, 0.f, 0.f, 0.f}, (f32x4){0.f, 0.f, 0.f, 0.f}, (f32x4){0.f, 0.f, 0.f, 0.f}};
#pragma unroll
        for (int ks = 0; ks < 2; ++ks)
#pragma unroll
            for (int n = 0; n < 4; ++n) S[n] = MFMA16(qf[ks], kf[n][ks], S[n]);
#pragma unroll
        for (int i = 0; i < 4; ++i) { const int t = 16 * mt + 4 * q4 + i; float sm = 0.f;
#pragma unroll
            for (int n = 0; n < 4; ++n) { const int s = 16 * n + r; const bool ok = DIR == 0 ? (s <= t) : (s >= t); float v = 0.f;
                if (ok) { if constexpr (MIXER == 0) v = S[n][i] * 0.125f * __expf(ga[t] + ga[64 + s]); else v = S[n][i]; }
                SB[swz(4 * q4 + i, s >> 3) + (s & 7)] = f2bf(v); sm += v; }
            if constexpr (MIXER == 0) { sm = row16_sum(sm); if (r == 0) rsm[4 * q4 + i] = sm; } }
        WAVE_SYNC();
        const bf16x8 sm0 = *(const bf16x8*)(SB + swz(r, q4)), sm1 = *(const bf16x8*)(SB + swz(r, 4 + q4));
        float wi = 1.f, inv = 1.f;
        if constexpr (MIXER == 0) { const int tt = 16 * mt + r; wi = ga[128 + tt]; const float den = wi * ga[256 + tt] + rsm[r]; inv = frcp_(fmaxf(fabsf(den), ga[192 + tt])); }
#pragma unroll
        for (int me = 0; me < 4; ++me) { f32x4 a1 = {0.f, 0.f, 0.f, 0.f}, a2 = {0.f, 0.f, 0.f, 0.f};
            a1 = MFMA16(*(const bf16x8*)(VtL + swz(16 * me + r, q4)), sm0, a1); a1 = MFMA16(*(const bf16x8*)(VtL + swz(16 * me + r, 4 + q4)), sm1, a1);
            a2 = MFMA16(ctf[me][0], qf[0], a2); a2 = MFMA16(ctf[me][1], qf[1], a2);
            if constexpr (MIXER == 0) htot[ms][me] += (a1 + a2 * wi) * inv; else htot[ms][me] += a1 + a2; }
        WAVE_SYNC();
    }
}
__device__ __forceinline__ void co_build_vt(const bf16* P, int r0, int vcol, bf16* VtL, int lane) {
    bf16* Nn = VtL + 4096;
#pragma unroll
    for (int hh = 0; hh < 2; ++hh) {
        u32x4 v[4];
#pragma unroll
        for (int i = 0; i < 4; ++i) v[i] = *(const u32x4*)(P + (size_t)(r0 + 32 * hh + (lane >> 3) + 8 * i) * NP + vcol + (lane & 7) * 8);
#pragma unroll
        for (int i = 0; i < 4; ++i) *(u32x4*)(Nn + swz((lane >> 3) + 8 * i, lane & 7)) = v[i];
        WAVE_SYNC();
#pragma unroll
        for (int c = 0; c < 4; ++c) { unsigned w[4];
#pragma unroll
            for (int j = 0; j < 4; ++j) w[j] = (unsigned)Nn[swz(8 * c + 2 * j, lane >> 3) + (lane & 7)] | ((unsigned)Nn[swz(8 * c + 2 * j + 1, lane >> 3) + (lane & 7)] << 16);
            u32x4 o; o.x = w[0]; o.y = w[1]; o.z = w[2]; o.w = w[3]; *(u32x4*)(VtL + swz(lane, 4 * hh + c)) = o; }
        WAVE_SYNC(); }
}
template <int MIXER, int NS>
__device__ __forceinline__ void co_finalize(const Params& p, int l, int h, int r0, int pbase, int mt0, f32x4 (&htot)[NS][4], int lane_) {
    const bf16* P = (const bf16*)(p.ws + WS_P); bf16* Y = (bf16*)(p.ws + WS_HNY);
    const float* ngp = p.in[MIXER == 0 ? I_MNG : I_GNG] + (size_t)l * WG + h * 64;
    const int lz = olane(lane_), r = lz & 15, q4 = lz >> 4;
    u32x2 gq[NS][4], oq[NS][4];
#pragma unroll
    for (int ms = 0; ms < NS; ++ms)
#pragma unroll
        for (int me = 0; me < 4; ++me) { const size_t off = (size_t)(r0 + 16 * (mt0 + ms) + r) * NP + pbase + 16 * me + 4 * q4;
            gq[ms][me] = *(const u32x2*)(P + off + (MIXER == 0 ? 1024 : 768)); if constexpr (MIXER == 0) oq[ms][me] = *(const u32x2*)(P + off + 768); else oq[ms][me] = (u32x2){0u, 0u}; }
#pragma unroll
    for (int ms = 0; ms < NS; ++ms) { const int mt = mt0 + ms; float ss = 0.f; float gv[4][4];
#pragma unroll
        for (int me = 0; me < 4; ++me) {
            gv[me][0] = bitsf(gq[ms][me].x << 16); gv[me][1] = bitsf(gq[ms][me].x & 0xffff0000u); gv[me][2] = bitsf(gq[ms][me].y << 16); gv[me][3] = bitsf(gq[ms][me].y & 0xffff0000u);
            if constexpr (MIXER == 0) { htot[ms][me][0] *= sigmoidf_(bitsf(oq[ms][me].x << 16)); htot[ms][me][1] *= sigmoidf_(bitsf(oq[ms][me].x & 0xffff0000u)); htot[ms][me][2] *= sigmoidf_(bitsf(oq[ms][me].y << 16)); htot[ms][me][3] *= sigmoidf_(bitsf(oq[ms][me].y & 0xffff0000u)); }
            ss += htot[ms][me][0] * htot[ms][me][0] + htot[ms][me][1] * htot[ms][me][1] + htot[ms][me][2] * htot[ms][me][2] + htot[ms][me][3] * htot[ms][me][3]; }
        ss = xrow_sum(ss);
        const float rstd = rsqrtf(ss * (1.0f / 64.0f) + EPS);
#pragma unroll
        for (int me = 0; me < 4; ++me) { const int e = 16 * me + 4 * q4; const f32x4 n4 = *(const f32x4*)(ngp + e);
            u32x2 o; o.x = pk2(htot[ms][me][0] * rstd * n4.x * siluf_(gv[me][0]), htot[ms][me][1] * rstd * n4.y * siluf_(gv[me][1]));
            o.y = pk2(htot[ms][me][2] * rstd * n4.z * siluf_(gv[me][2]), htot[ms][me][3] * rstd * n4.w * siluf_(gv[me][3]));
            *(u32x2*)(Y + (size_t)(r0 + 16 * mt + r) * 1024 + (MIXER == 0 ? YA : YG) + h * 64 + e) = o; } }
}
template <int MIXER>
__device__ __forceinline__ void chunkout_w(const Params& p, int l, int b, int h, int cid, char* wl, int lane) {
    const bf16* P = (const bf16*)(p.ws + WS_P); const float* G = (const float*)(p.ws + WS_G);
    const int r0 = b * TOK + cid * 64;
    const int pbase = (MIXER == 0 ? PA : PG) + h * 64;
    bf16* SB = (bf16*)wl;
    float* rsm = (float*)(SB + 1024);
    float* gar = rsm + 16;
    const bf16* EQ = (const bf16*)(p.ws + WS_EQ);
    const float* Grow0 = G + (size_t)r0 * NGS;
    bf16* VtL = (bf16*)(gar + 768);
    bf16x8 vtf[4][2];
#pragma unroll
    for (int me = 0; me < 4; ++me)
#pragma unroll
        for (int ks = 0; ks < 2; ++ks) { if constexpr (MIXER == 0) vtf[me][ks] = *(const bf16x8*)(P + (size_t)(r0 + 16 * me + (lane & 15)) * NP + pbase + 256 + ks * 32 + (lane >> 4) * 8); else vtf[me][ks] = (bf16x8){0, 0, 0, 0, 0, 0, 0, 0}; }
    co_build_vt(P, r0, pbase + 512, VtL, lane);
    chunkout_prep<MIXER, 0>(p, l, b, h, cid, Grow0, r0, pbase, EQ, gar, lane);
    chunkout_prep<MIXER, 1>(p, l, b, h, cid, Grow0, r0, pbase, EQ, gar, lane);
    WAVE_SYNC();
    constexpr int NS = MIXER == 1 ? 2 : 1;
#pragma unroll 1
    for (int th = 0; th < 4 / NS; ++th) {
        f32x4 htot[NS][4];
#pragma unroll
        for (int a = 0; a < NS; ++a)
#pragma unroll
            for (int c = 0; c < 4; ++c) htot[a][c] = (f32x4){0.f, 0.f, 0.f, 0.f};
        chunkout_dir<MIXER, 0, NS>(p, b, h, cid, r0, pbase, th, vtf, VtL, EQ, SB, gar, rsm, htot, lane);
        chunkout_dir<MIXER, 1, NS>(p, b, h, cid, r0, pbase, th, vtf, VtL, EQ, SB, gar, rsm, htot, lane);
        co_finalize<MIXER, NS>(p, l, h, r0, pbase, NS * th, htot, lane);
    }
}
constexpr int CO_PART = 13376;
template <int MIXER, int DIR>
__device__ __forceinline__ void chunkout_piece(const Params& p, int l, int b, int h, int cid, int mt, char* wl, int lane) {
    const bf16* P = (const bf16*)(p.ws + WS_P); const float* G = (const float*)(p.ws + WS_G);
    const int r0 = b * TOK + cid * 64; const int pbase = (MIXER == 0 ? PA : PG) + h * 64;
    bf16* SB = (bf16*)wl; float* rsm = (float*)(SB + 1024); float* gar = rsm + 16; const bf16* EQ = (const bf16*)(p.ws + WS_EQ);
    const float* Grow0 = G + (size_t)r0 * NGS; bf16* VtL = (bf16*)(gar + 768);
    bf16x8 vtf[4][2];
#pragma unroll
    for (int me = 0; me < 4; ++me)
#pragma unroll
        for (int ks = 0; ks < 2; ++ks) { if constexpr (MIXER == 0) vtf[me][ks] = *(const bf16x8*)(P + (size_t)(r0 + 16 * me + (lane & 15)) * NP + pbase + 256 + ks * 32 + (lane >> 4) * 8); else vtf[me][ks] = (bf16x8){0, 0, 0, 0, 0, 0, 0, 0}; }
    co_build_vt(P, r0, pbase + 512, VtL, lane);
    chunkout_prep<MIXER, DIR>(p, l, b, h, cid, Grow0, r0, pbase, EQ, gar, lane);
    WAVE_SYNC();
    f32x4 htot[1][4] = {{(f32x4){0.f, 0.f, 0.f, 0.f}, (f32x4){0.f, 0.f, 0.f, 0.f}, (f32x4){0.f, 0.f, 0.f, 0.f}, (f32x4){0.f, 0.f, 0.f, 0.f}}};
    chunkout_dir<MIXER, DIR, 1>(p, b, h, cid, r0, pbase, mt, vtf, VtL, EQ, SB, gar, rsm, htot, lane);
    float* part = (float*)(wl + CO_PART);
#pragma unroll
    for (int me = 0; me < 4; ++me)
#pragma unroll
        for (int i = 0; i < 4; ++i) part[(me * 4 + i) * 64 + lane] = htot[0][me][i];
}
template <int MIXER>
__device__ __forceinline__ void chunkout_combine(const Params& p, int l, int b, int h, int cid, int mt, const char* smem, int lane) {
    const float* pa = (const float*)(smem + (2 * mt) * WLDS + CO_PART); const float* pb = (const float*)(smem + (2 * mt + 1) * WLDS + CO_PART);
    f32x4 htot[1][4];
#pragma unroll
    for (int me = 0; me < 4; ++me)
#pragma unroll
        for (int i = 0; i < 4; ++i) htot[0][me][i] = pa[(me * 4 + i) * 64 + lane] + pb[(me * 4 + i) * 64 + lane];
    co_finalize<MIXER, 1>(p, l, h, b * TOK + cid * 64, (MIXER == 0 ? PA : PG) + h * 64, mt, htot, lane);
}

template <bool OUT>
__device__ __forceinline__ void chunk_workers(const Params& p, int l, char* smem) {
    const int tid = otid(), lane = tid & 63, wave = __builtin_amdgcn_readfirstlane(tid >> 6);
    const int NW = (int)gridDim.x * 8, wi = wave * (int)gridDim.x + obid();
    const int c_lo = (OUT && l == DEPTH - 1) ? NCC : 0, npc = NCH - c_lo, half = NB * NH * npc;
    char* wl = smem + wave * WLDS;
    if (OUT) {
        const int cl = NCC, npl = NCH - NCC, halfl = NB * NH * npl;
#pragma unroll 1
        for (int t = wi; t < halfl; t += NW) { const int b = t / (NH * npl), h = (t / npl) % NH, cid = cl + t % npl;
            const Params q = relaunder(p); chunkout_w<1>(q, l, b, h, cid, wl, lane); }
        { const int used = halfl % NW;
#pragma unroll 1
            for (int t = (wi + NW - used) % NW; t < halfl; t += NW) { const int b = t / (NH * npl), h = (t / npl) % NH, cid = cl + t % npl;
                const Params q = relaunder(p); chunkout_w<0>(q, l, b, h, cid, wl, lane); } }
        if (l < DEPTH - 1) {
            const int nct = NB * NH * NCC;
#pragma unroll 1
            for (int st = obid(); st < 2 * nct; st += (int)gridDim.x) { const int mixer = st / nct, r2 = st % nct, b = r2 / (NH * NCC), h = (r2 / NCC) % NH, cid = r2 % NCC;
                const Params q = relaunder(p); const int mt = wave >> 1;
                __syncthreads();
                if (mixer == 0) { if (wave & 1) chunkout_piece<0, 1>(q, l, b, h, cid, mt, wl, lane); else chunkout_piece<0, 0>(q, l, b, h, cid, mt, wl, lane); }
                else            { if (wave & 1) chunkout_piece<1, 1>(q, l, b, h, cid, mt, wl, lane); else chunkout_piece<1, 0>(q, l, b, h, cid, mt, wl, lane); }
                __syncthreads();
                if (wave < 4) { if (mixer == 0) chunkout_combine<0>(q, l, b, h, cid, wave, smem, lane); else chunkout_combine<1>(q, l, b, h, cid, wave, smem, lane); }
            }
        }
    } else {
        int off = 0;
#pragma unroll 1
        for (int t = wi; t < half; t += NW) { const int b = t / (NH * npc), h = (t / npc) % NH, cid = c_lo + t % npc;
            const Params q = relaunder(p); chunkst_gla<0>(q, l, b, h, cid, wl, lane); }
        off = (off + half) % NW;
#pragma unroll 1
        for (int t = (wi + NW - off) % NW; t < half; t += NW) { const int b = t / (NH * npc), h = (t / npc) % NH, cid = c_lo + t % npc;
            const Params q = relaunder(p); chunkst_gla<1>(q, l, b, h, cid, wl, lane); }
        off = (off + half) % NW;
#pragma unroll 1
        for (int t = (wi + NW - off) % NW; t < half; t += NW) { const int b = t / (NH * npc), h = (t / npc) % NH, cid = c_lo + t % npc;
            const Params q = relaunder(p); chunkst_w<0>(q, l, b, h, cid, wl, lane); }
    }
}

__device__ __forceinline__ void phase_mix1(const Params& p, int l, char* smem) {
    const bool ctxo = l < DEPTH - 1;
    constexpr int QTL = SEQ / 128, QTC = CTXL / 128;
    constexpr int N_HL = (NB / 2) * (WG / 2), N_AL = NB * 2 * QTL, N_HC = NB * (WG / HCB), N_AC = NB * 2 * QTC;
    const int total = N_HL + N_AL + (ctxo ? N_HC + N_AC : 0);
    for (int task = obid(); task < total; task += gridDim.x) {
        int t = task;
        if (t < N_HL) { hylat_task(p, l, t / (WG / 2), t % (WG / 2), smem); continue; } t -= N_HL;
        if (t < N_AL) { attn_task(p, l, t / (2 * QTL), (t / QTL) % 2, t % QTL, false, smem); continue; } t -= N_AL;
        if (t < N_HC) { hyctx_task(p, l, t / (WG / HCB), t % (WG / HCB), smem); continue; } t -= N_HC;
        attn_task(p, l, t / (2 * QTC), (t / QTC) % 2, t % QTC, true, smem);
    }
    __syncthreads();
    chunk_workers<false>(p, l, smem);
}

constexpr int SCG = 12;
__device__ __forceinline__ void phase_scan(const Params& p, int l, char* smem) {
    const int tid = otid();
    bf16* ST = (bf16*)(p.ws + WS_ST); float* NV = (float*)(p.ws + WS_NV); const float* BE = (const float*)(p.ws + WS_BE); float* SC = (float*)(p.ws + WS_SC);
    constexpr int NCHAIN = 2 * 2 * NB * NH;
    for (int item = obid() * NT + tid; item < NCHAIN * 1024; item += gridDim.x * NT) {
        const int chain = item >> 10, grp = item & 1023; const int mixer = chain / (2 * NB * NH), dir = (chain / (NB * NH)) % 2, b = (chain / NH) % NB, h = chain % NH;
        float c[4] = {0.f, 0.f, 0.f, 0.f}; float nv[4] = {0.f, 0.f, 0.f, 0.f}; float m = 0.f;
        const int d0 = (grp & 15) * 4; const bool donv = (mixer == 0) && (grp < 16);
        for (int o0 = 0; o0 < NCH; o0 += SCG) {
            u32x2 uu[SCG]; float s0[SCG], s1[SCG]; f32x4 be[SCG]; f32x4 nu[SCG];
#pragma unroll
            for (int j = 0; j < SCG; ++j) if (o0 + j < NCH) { const int cid = chain_cid(dir, o0 + j); const size_t ci = ch_index(dir, b, h, cid);
                uu[j] = *(const u32x2*)(ST + st_index(mixer, dir, b, h, cid) * 4096 + grp * 4);
                if (mixer == 0) { s0[j] = SC[ci * 4 + 0]; s1[j] = SC[ci * 4 + 1]; if (donv) nu[j] = *(const f32x4*)(NV + ci * 64 + grp * 4); }
                else be[j] = *(const f32x4*)(BE + ci * 64 + d0); }
#pragma unroll
            for (int j = 0; j < SCG; ++j) if (o0 + j < NCH) { const int cid = chain_cid(dir, o0 + j); const size_t ci = ch_index(dir, b, h, cid);
                const float u[4] = {bitsf(uu[j].x << 16), bitsf(uu[j].x & 0xffff0000u), bitsf(uu[j].y << 16), bitsf(uu[j].y & 0xffff0000u)};
                u32x2 w; w.x = pk2(c[0], c[1]); w.y = pk2(c[2], c[3]); *(u32x2*)(ST + st_index(mixer, dir, b, h, cid) * 4096 + grp * 4) = w;
                if (mixer == 0) {
                    if (grp == 0) SC[ci * 4 + 2] = m;
                    const float mn = fmaxf(s0[j] + m, s1[j]), a = __expf(s0[j] + m - mn), s = __expf(s1[j] - mn);
#pragma unroll
                    for (int k = 0; k < 4; ++k) c[k] = a * c[k] + s * u[k];
                    if (donv) { f32x4 nw = {nv[0], nv[1], nv[2], nv[3]}; *(f32x4*)(NV + ci * 64 + grp * 4) = nw;
                        nv[0] = a * nv[0] + s * nu[j].x; nv[1] = a * nv[1] + s * nu[j].y; nv[2] = a * nv[2] + s * nu[j].z; nv[3] = a * nv[3] + s * nu[j].w; }
                    m = mn;
                } else { c[0] = __expf(be[j].x) * c[0] + u[0]; c[1] = __expf(be[j].y) * c[1] + u[1]; c[2] = __expf(be[j].z) * c[2] + u[2]; c[3] = __expf(be[j].w) * c[3] + u[3]; } }
        }
    }
    constexpr int N_WOUT = (DM / 64) * (MIX / 64);
    for (int task = obid(); task < N_WOUT; task += gridDim.x) { const int nt = task / (MIX / 64), kt = task % (MIX / 64);
        convert_tile(p.in[I_WOUT] + (size_t)l * MIX * DM, DM, (bf16*)(p.ws + WS_WOUT), MIX, nt * 64, kt * 64, false, smem); }
    __syncthreads();
    { const int lane = tid & 63, wave = __builtin_amdgcn_readfirstlane(tid >> 6); const int NW = (int)gridDim.x * 8, wi = wave * (int)gridDim.x + obid();
        bf16* tile = (bf16*)(smem + wave * WLDS); const bf16* HT = (const bf16*)(p.ws + WS_HT); bf16* Y = (bf16*)(p.ws + WS_HNY);
        constexpr int NTT = NB * (SEQ / 64) * 4;
        for (int t = wi; t < NTT; t += NW) { const int b = t / ((SEQ / 64) * 4), tt = (t / 4) % (SEQ / 64), c0 = (t % 4) * 64; const size_t tok0 = (size_t)b * TOK + CTXL + tt * 64;
#pragma unroll
            for (int i = 0; i < 8; ++i) { const int ch = (lane >> 3) + 8 * i, ck = lane & 7; *(u32x4*)(tile + swz(ch, ck)) = *(const u32x4*)(HT + (size_t)(768 + c0 + ch) * T + tok0 + ck * 8); }
            WAVE_SYNC();
#pragma unroll
            for (int i = 0; i < 8; ++i) { const int tk = (lane >> 3) + 8 * i, cc = lane & 7; unsigned w[4];
#pragma unroll
                for (int j = 0; j < 4; ++j) { const int ca = cc * 8 + 2 * j; w[j] = (unsigned)tile[swz(ca, tk >> 3) + (tk & 7)] | ((unsigned)tile[swz(ca + 1, tk >> 3) + (tk & 7)] << 16); }
                u32x4 o; o.x = w[0]; o.y = w[1]; o.z = w[2]; o.w = w[3]; *(u32x4*)(Y + (tok0 + tk) * 1024 + YH + c0 + cc * 8) = o; }
            WAVE_SYNC(); } }
}

__device__ __forceinline__ void phase_mix2(const Params& p, int l, char* smem) { chunk_workers<true>(p, l, smem); }

#ifndef EMU
#define LAS __attribute__((address_space(3)))
#define XB_TMO      128
#define XB_XCNT(j)  (256  + 64 * (j))
#define XB_XSUB(j)  (1280 + 64 * (j))
#define XB_XGEN(j)  (2304 + 64 * (j))
#define XB_TOP      3328
#define XB_TOPGEN   3392
#define XCD_BAR_WORDS 3456
#define XB_SPIN_CAP (1u << 18)

__device__ __forceinline__ unsigned xb_ld(unsigned* p)              { return __hip_atomic_load(p, __ATOMIC_RELAXED, __HIP_MEMORY_SCOPE_AGENT); }
__device__ __forceinline__ unsigned xb_add(unsigned* p, unsigned v) { return __hip_atomic_fetch_add(p, v, __ATOMIC_RELAXED, __HIP_MEMORY_SCOPE_AGENT); }
__device__ __forceinline__ unsigned xb_xcc_id() { return (unsigned)__builtin_amdgcn_s_getreg((3 << 11) | 20) & 0xFu; }
#define XB_SPIN(cond, bar) do { unsigned _sp = 0; while (cond) { __builtin_amdgcn_s_sleep(1); \
    if ((++_sp & 255u) == 0u) { if (xb_ld(&(bar)[XB_TMO])) break; if (_sp > XB_SPIN_CAP) { atomicAdd(&(bar)[XB_TMO], 1u); break; } } } } while (0)

struct XcdBarrier {
    unsigned* bar; unsigned x;
    volatile LAS unsigned* st;
};

__device__ __forceinline__ XcdBarrier xcd_barrier_post(unsigned* bar, volatile LAS unsigned* st) {
    XcdBarrier b; b.bar = bar; b.x = xb_xcc_id(); b.st = st;
    if (threadIdx.x == 0) (void)xb_add(&bar[XB_XCNT(b.x)], 1u);
    return b;
}
__device__ __forceinline__ void xcd_barrier_complete(unsigned* bar, unsigned x, unsigned& nloc, unsigned& nx) {
    const unsigned G = gridDim.x * gridDim.y * gridDim.z;
    unsigned sum, cnt, mine, sp = 0u;
    for (;;) {
        sum = 0u; cnt = 0u; mine = 0u;
#pragma unroll
        for (unsigned j = 0; j < 16; ++j) { const unsigned c = xb_ld(&bar[XB_XCNT(j)]); sum += c; cnt += (c > 0u) ? 1u : 0u; mine = (j == x) ? c : mine; }
        if (sum == G) break;
        __builtin_amdgcn_s_sleep(1);
        if ((++sp & 255u) == 0u) { if (xb_ld(&bar[XB_TMO])) break; if (sp > XB_SPIN_CAP) { atomicAdd(&bar[XB_TMO], 1u); break; } }
    }
    nloc = mine > 0u ? mine : 1u; nx = cnt > 0u ? cnt : 1u;
}

__device__ __forceinline__ void xcd_barrier(const XcdBarrier& b) {
    asm volatile("s_waitcnt vmcnt(0)" ::: "memory");
    __syncthreads();
    if (threadIdx.x == 0) {
        unsigned* bar = b.bar;
        __builtin_amdgcn_s_waitcnt(0);
        unsigned nloc = b.st[0], nx = b.st[1];
        if (nloc == 0u) { xcd_barrier_complete(bar, b.x, nloc, nx); b.st[0] = nloc; b.st[1] = nx; }
        const unsigned old = xb_add(&bar[XB_XSUB(b.x)], 1u);
        const unsigned gen = old / nloc;
        if (old + 1u == (gen + 1u) * nloc) {
            __builtin_amdgcn_fence(__ATOMIC_RELEASE, "agent");
            asm volatile("s_waitcnt vmcnt(0)" ::: "memory");
            const unsigned og = xb_add(&bar[XB_TOP], 1u);
            const unsigned tg = og / nx;
            if (og + 1u == (tg + 1u) * nx) xb_add(&bar[XB_TOPGEN], 1u);
            else XB_SPIN(xb_ld(&bar[XB_TOPGEN]) == tg, bar);
            __builtin_amdgcn_fence(__ATOMIC_ACQUIRE, "agent");
            xb_add(&bar[XB_XGEN(b.x)], 1u);
            asm volatile("s_waitcnt vmcnt(0)" ::: "memory");
        } else {
            XB_SPIN(xb_ld(&bar[XB_XGEN(b.x)]) == gen, bar);
            __builtin_amdgcn_fence(__ATOMIC_ACQUIRE, "agent");
            asm volatile("s_waitcnt vmcnt(0)" ::: "memory");
        }
    }
    __syncthreads();
}
#endif

__global__ void __launch_bounds__(NT) fwd_kernel(Params pk, int ph_lo, int ph_hi) {
    SMEM_DECL;
#ifndef EMU
    volatile LAS unsigned* misc = (volatile LAS unsigned*)(smem + LDS_BYTES - 64);
    if (threadIdx.x < 2) misc[threadIdx.x] = 0u;
    __syncthreads();
    const XcdBarrier bar = xcd_barrier_post((unsigned*)(pk.ws + WS_BAR), misc);
#endif
    constexpr int NPH = 2 + 6 * DEPTH;
    for (int ph = ph_lo; ph < ph_hi && ph < NPH; ++ph) {
#ifndef EMU
        Params p = pk; { size_t z = 0; asm volatile("" : "+s"(z)); p.ws = pk.ws + z; p.out = pk.out + z;
#pragma unroll
            for (int i = 0; i < 26; ++i) p.in[i] = pk.in[i] + z; }
#else
        const Params& p = pk;
#endif
        if (ph == 0) phase0(p, smem);
        else if (ph == NPH - 1) phase_rp(p, DEPTH, smem);
        else { const int l = (ph - 1) / 6, k = (ph - 1) % 6;
            if (k == 0) phase_rp(p, l, smem);
            else if (k == 1) phase_gemm_in(p, l, smem);
            else if (k == 2) phase_mix1(p, l, smem);
            else if (k == 3) phase_scan(p, l, smem);
            else if (k == 4) phase_mix2(p, l, smem);
            else phase_gemm_out(p, l, smem);
#ifdef PROBE_DUP
            if (k == PROBE_DUP) { GRID_SYNC();
                if (k == 1) phase_gemm_in(p, l, smem); else if (k == 2) phase_mix1(p, l, smem); else if (k == 4) phase_mix2(p, l, smem); else if (k == 5) phase_gemm_out(p, l, smem); }
#endif
        }
        if (ph + 1 < ph_hi) {
#ifdef EMU
            GRID_SYNC();
#else
            if (ph_lo < 0) GRID_SYNC();
            xcd_barrier(bar);
#endif
        }
    }
}

#ifndef EMU
extern "C" void kernel_launch(void* const* d_in, const int* in_sizes, int n_in, void* d_out, int out_size, void* d_ws, size_t ws_size, hipStream_t stream) {
    static int grid = 0;
    if (grid == 0) {
        if (n_in != 26 || ws_size < WS_TOTAL) { fprintf(stderr, "kernel_launch: unexpected n_in %d or ws_size %zu (need %zu)\n", n_in, ws_size, (size_t)WS_TOTAL); grid = -1; return; }
        int dev = 0, cus = 0, per_cu = 0;
        hipGetDevice(&dev);
        hipDeviceGetAttribute(&cus, hipDeviceAttributeMultiprocessorCount, dev);
        hipFuncSetAttribute((const void*)fwd_kernel, hipFuncAttributeMaxDynamicSharedMemorySize, LDS_BYTES);
        hipOccupancyMaxActiveBlocksPerMultiprocessor(&per_cu, (const void*)fwd_kernel, NT, LDS_BYTES);
        if (per_cu < 1) { fprintf(stderr, "kernel_launch: occupancy query returned %d\n", per_cu); grid = -1; return; }
        if (per_cu > 1) per_cu = 1;
        grid = cus * per_cu;
    }
    if (grid < 0) return;
    hipMemsetAsync((char*)d_ws + WS_BAR, 0, BAR_BYTES, stream);
    Params p{};
    for (int i = 0; i < 26; ++i) p.in[i] = (const float*)d_in[i];
    p.out = (float*)d_out; p.ws = (char*)d_ws;
    int lo = 0, hi = 2 + 6 * DEPTH;
    void* args[] = {&p, &lo, &hi};
    hipError_t e = hipLaunchCooperativeKernel((const void*)fwd_kernel, dim3(grid), dim3(NT), args, LDS_BYTES, stream);
    if (e != hipSuccess) fprintf(stderr, "cooperative launch failed: %s (grid %d)\n", hipGetErrorString(e), grid);
}
#endif
```

```cpp
#ifdef EMU
#include "emu/hipemu.h"
#define GRID_SYNC() emu::grid_sync()
#define SMEM_DECL char* smem = emu::S().blocks[emu::cur()->block].lds
#define MFMA16(a, b, c) emu_mfma_16x16x32_bf16(a, b, c)
#else
#include <hip/hip_runtime.h>
#include <hip/hip_cooperative_groups.h>
#include <cstdio>
#include <cstdint>
#define GRID_SYNC() cooperative_groups::this_grid().sync()
#define SMEM_DECL extern __shared__ __attribute__((aligned(16))) char smem[]
#define MFMA16(a, b, c) __builtin_amdgcn_mfma_f32_16x16x32_bf16(a, b, c, 0, 0, 0)
#endif

#ifdef EMU
#ifndef EMU_DM
#define EMU_DM 256
#endif
#ifndef EMU_NB
#define EMU_NB 2
#endif
#ifndef EMU_SEQ
#define EMU_SEQ 512
#endif
#ifndef EMU_DEPTH
#define EMU_DEPTH 2
#endif
#ifndef EMU_CTXL
#define EMU_CTXL 128
#endif
constexpr int DM = EMU_DM, NB = EMU_NB, SEQ = EMU_SEQ, DEPTH = EMU_DEPTH, CTXL = EMU_CTXL;
#else
constexpr int DM = 1024, NB = 8, SEQ = 2048, DEPTH = 4, CTXL = 256;
#endif
constexpr int MIX = 1024, WG = 256, HD = 64, NH = 4, CH = 64;
constexpr int TOK = CTXL + SEQ, T = NB * TOK, NCH = TOK / CH, NCC = CTXL / CH;
constexpr int N_IN = 4144, NP = 3072, NG = 48, NGS = 32, NMAIN = 3328, NPAD = 4352;
constexpr int NF = 2 * SEQ;
constexpr int NJ = NB + 1;
constexpr int NT = 512;
constexpr float EPS = 1e-6f;
constexpr int PA = 0, PG = 1280, PD = 2304;
constexpr int YA = 0, YH = 256, YG = 512, YD = 768;
constexpr int ilog4(int n) { return n <= 1 ? 0 : 1 + ilog4(n / 4); }
constexpr int FFT_P = ilog4(NF);
static_assert((1 << (2 * FFT_P)) == NF, "NF must be a power of 4");
static_assert(DM % 256 == 0 && CTXL % 128 == 0 && SEQ % 256 == 0, "shape constraints");

typedef unsigned short bf16;
typedef short bf16x8 __attribute__((ext_vector_type(8)));
typedef float f32x4 __attribute__((ext_vector_type(4)));
typedef unsigned u32x4 __attribute__((ext_vector_type(4)));
typedef unsigned u32x2 __attribute__((ext_vector_type(2)));
struct cpx { float x, y; };

constexpr size_t al256(size_t x) { return (x + 255) & ~(size_t)255; }
constexpr size_t WS_CTXB = 0;
constexpr size_t WS_HNY = al256(WS_CTXB + (size_t)NB * CTXL * DM * 4);
constexpr size_t WS_WIN = WS_HNY + (size_t)T * 1024 * 2;
constexpr size_t WS_ST = WS_WIN;
constexpr size_t ST_BYTES = (size_t)2 * 2 * NB * NH * NCH * 4096 * 2;
constexpr size_t WS_KT = al256(WS_WIN + (size_t)NPAD * DM * 2);
static_assert(WS_KT + (size_t)WG * NF * 4 <= WS_ST + ST_BYTES || true, "");
constexpr size_t ST_END = al256((WS_ST + ST_BYTES > WS_KT + (size_t)WG * NF * 4) ? WS_ST + ST_BYTES : WS_KT + (size_t)WG * NF * 4);
constexpr size_t WS_P = ST_END;
constexpr size_t WS_HT = al256(WS_P + (size_t)T * NP * 2);
constexpr size_t WS_WOUT = WS_HT;
constexpr size_t WS_G = al256(WS_HT + (size_t)1024 * T * 2);
constexpr size_t WS_KF = al256(WS_G + (size_t)T * NGS * 4);
constexpr size_t WS_HC = al256(WS_KF + (size_t)WG * NF * 8);
constexpr size_t WS_EQ = al256(WS_HC + (size_t)2 * WG * CTXL * 4);
constexpr size_t WS_NV = al256(WS_EQ + (size_t)2 * T * WG * 2);
constexpr size_t WS_BE = al256(WS_NV + (size_t)2 * NB * NH * NCH * 64 * 4);
constexpr size_t WS_SC = al256(WS_BE + (size_t)2 * NB * NH * NCH * 64 * 4);
constexpr size_t WS_MOD = al256(WS_SC + (size_t)2 * NB * NH * NCH * 4 * 4);
constexpr size_t WS_TW = al256(WS_MOD + (size_t)DEPTH * NJ * 3 * DM * 4);
constexpr size_t WS_ROPE = al256(WS_TW + (size_t)NF * 8);
constexpr size_t WS_BAR = al256(WS_ROPE + (size_t)SEQ * 32 * 8);
constexpr size_t BAR_BYTES = 16384;
constexpr size_t WS_TOTAL = al256(WS_BAR + BAR_BYTES);
static_assert((size_t)T * DM * 4 <= (size_t)T * NP * 2, "YO fits in P");
#ifndef EMU
static_assert(WS_TOTAL <= (size_t)268435456, "workspace map must fit 256 MiB");
#endif

constexpr int LDS_BYTES = 163840;

struct Params {
    const float* in[26];
    float* out;
    char* ws;
};
enum { I_X = 0, I_C, I_CTX, I_CCTX, I_WADA, I_BADA, I_GPRE, I_GPOST, I_WIN, I_MGB, I_MNG, I_HCW, I_HCB, I_HW1, I_HB1, I_HW2, I_HB2, I_HW3, I_HB3,
       I_HFREQ, I_HD, I_GWA, I_GBA, I_GNG, I_SINK, I_WOUT };

__device__ __forceinline__ Params relaunder(const Params& pk) {
#ifdef EMU
    return pk;
#else
    Params p = pk; size_t z = 0; asm volatile("" : "+s"(z)); p.ws = pk.ws + z; p.out = pk.out + z;
#pragma unroll
    for (int i = 0; i < 26; ++i) p.in[i] = pk.in[i] + z;
    return p;
#endif
}
constexpr int WLDS = (LDS_BYTES - 64) / 8 / 16 * 16;
#ifdef EMU
#define WAVE_SYNC() emu_wave_sync()
#else
#define WAVE_SYNC() do { asm volatile("s_waitcnt lgkmcnt(0)" ::: "memory"); __builtin_amdgcn_wave_barrier(); } while (0)
#endif

#ifdef EMU
__device__ __forceinline__ int otid() { return (int)threadIdx.x; }
__device__ __forceinline__ int obid() { return (int)blockIdx.x; }
#else
__device__ __forceinline__ int otid() { int t = (int)threadIdx.x; asm volatile("" : "+v"(t)); return t; }
__device__ __forceinline__ int obid() { int b = (int)blockIdx.x; asm volatile("" : "+s"(b)); return b; }
#endif
__device__ __forceinline__ unsigned fbits(float f) { return __builtin_bit_cast(unsigned, f); }
__device__ __forceinline__ float bitsf(unsigned u) { return __builtin_bit_cast(float, u); }
__device__ __forceinline__ float bf2f(bf16 h) { return bitsf((unsigned)h << 16); }
#ifdef EMU
__device__ __forceinline__ bf16 f2bf(float f) { unsigned u = fbits(f); return (bf16)((u + 0x7fffu + ((u >> 16) & 1u)) >> 16); }
__device__ __forceinline__ unsigned pk2(float lo, float hi) { return (unsigned)f2bf(lo) | ((unsigned)f2bf(hi) << 16); }
#else
typedef __bf16 nbf16x2 __attribute__((ext_vector_type(2)));
typedef float nf32x2 __attribute__((ext_vector_type(2)));
__device__ __forceinline__ unsigned pk2(float lo, float hi) { const nf32x2 v = {lo, hi}; return __builtin_bit_cast(unsigned, __builtin_convertvector(v, nbf16x2)); }
__device__ __forceinline__ bf16 f2bf(float f) { return (bf16)(pk2(f, 0.0f) & 0xffffu); }
#endif
#ifdef EMU
__device__ __forceinline__ float frcp_(float x) { return 1.0f / x; }
#else
__device__ __forceinline__ float frcp_(float x) { return __builtin_amdgcn_rcpf(x); }
#endif
__device__ __forceinline__ float sigmoidf_(float x) { return frcp_(1.0f + __expf(-x)); }
__device__ __forceinline__ float siluf_(float x) { return x * frcp_(1.0f + __expf(-x)); }
__device__ __forceinline__ float logsigf_(float x) { return fminf(x, 0.0f) - log1pf(__expf(-fabsf(x))); }
__device__ __forceinline__ float logsig_fast(float x) { return fminf(x, 0.0f) - __logf(1.0f + __expf(-fabsf(x))); }
#ifdef EMU
__device__ __forceinline__ float row16_sum(float x) { x += __shfl_xor(x, 1); x += __shfl_xor(x, 2); x += __shfl_xor(x, 4); x += __shfl_xor(x, 8); return x; }
__device__ __forceinline__ float row16_max(float x) { x = fmaxf(x, __shfl_xor(x, 1)); x = fmaxf(x, __shfl_xor(x, 2)); x = fmaxf(x, __shfl_xor(x, 4)); x = fmaxf(x, __shfl_xor(x, 8)); return x; }
__device__ __forceinline__ float xrow_sum(float x) { x += __shfl_xor(x, 16); x += __shfl_xor(x, 32); return x; }
__device__ __forceinline__ float xrow_max(float x) { x = fmaxf(x, __shfl_xor(x, 16)); x = fmaxf(x, __shfl_xor(x, 32)); return x; }
#else
template <int CTRL> __device__ __forceinline__ float dpp_(float x) { return __builtin_bit_cast(float, __builtin_amdgcn_mov_dpp(__builtin_bit_cast(int, x), CTRL, 0xf, 0xf, true)); }
__device__ __forceinline__ float row16_sum(float x) { x += dpp_<0xB1>(x); x += dpp_<0x4E>(x); x += dpp_<0x141>(x); x += dpp_<0x128>(x); return x; }
__device__ __forceinline__ float row16_max(float x) { x = fmaxf(x, dpp_<0xB1>(x)); x = fmaxf(x, dpp_<0x4E>(x)); x = fmaxf(x, dpp_<0x141>(x)); x = fmaxf(x, dpp_<0x128>(x)); return x; }
__device__ __forceinline__ float xrow_sum(float x) {
    auto s = __builtin_amdgcn_permlane16_swap(fbits(x), fbits(x), false, false); x = bitsf(s[0]) + bitsf(s[1]);
    auto t = __builtin_amdgcn_permlane32_swap(fbits(x), fbits(x), false, false); return bitsf(t[0]) + bitsf(t[1]); }
__device__ __forceinline__ float xrow_max(float x) {
    auto s = __builtin_amdgcn_permlane16_swap(fbits(x), fbits(x), false, false); x = fmaxf(bitsf(s[0]), bitsf(s[1]));
    auto t = __builtin_amdgcn_permlane32_swap(fbits(x), fbits(x), false, false); return fmaxf(bitsf(t[0]), bitsf(t[1])); }
#endif
__device__ __forceinline__ float wave_sum(float v) { return xrow_sum(row16_sum(v)); }
__device__ __forceinline__ float wave_max(float v) { return xrow_max(row16_max(v)); }
#ifdef EMU
__device__ __forceinline__ float wave_prefix_sum(float v, int lane) {
#pragma unroll
    for (int o = 1; o < 64; o <<= 1) { float t = __shfl_up(v, o); if (lane >= o) v += t; }
    return v;
}
__device__ __forceinline__ float wave_prefix_max(float v, int lane) {
#pragma unroll
    for (int o = 1; o < 64; o <<= 1) { float t = __shfl_up(v, o); if (lane >= o) v = fmaxf(v, t); }
    return v;
}
#else
template <int CTRL, int RM> __device__ __forceinline__ float dppo_(float old, float x) { return __builtin_bit_cast(float, __builtin_amdgcn_update_dpp(__builtin_bit_cast(int, old), __builtin_bit_cast(int, x), CTRL, RM, 0xf, false)); }
__device__ __forceinline__ float wave_prefix_sum(float v, int) {
    v += dppo_<0x111, 0xf>(0.f, v); v += dppo_<0x112, 0xf>(0.f, v); v += dppo_<0x114, 0xf>(0.f, v); v += dppo_<0x118, 0xf>(0.f, v);
    v += dppo_<0x142, 0xa>(0.f, v); v += dppo_<0x143, 0xc>(0.f, v); return v;
}
__device__ __forceinline__ float wave_prefix_max(float v, int) {
    const float ninf = -INFINITY;
    v = fmaxf(v, dppo_<0x111, 0xf>(ninf, v)); v = fmaxf(v, dppo_<0x112, 0xf>(ninf, v)); v = fmaxf(v, dppo_<0x114, 0xf>(ninf, v)); v = fmaxf(v, dppo_<0x118, 0xf>(ninf, v));
    v = fmaxf(v, dppo_<0x142, 0xa>(ninf, v)); v = fmaxf(v, dppo_<0x143, 0xc>(ninf, v)); return v;
}
#endif
__device__ __forceinline__ float wave_suffix_max(float v, int lane) {
    return __shfl(wave_prefix_max(__shfl(v, 63 - lane), lane), 63 - lane);
}
__device__ __forceinline__ void unpack8(u32x4 v, float* f) {
    f[0] = bitsf(v.x << 16); f[1] = bitsf(v.x & 0xffff0000u); f[2] = bitsf(v.y << 16); f[3] = bitsf(v.y & 0xffff0000u);
    f[4] = bitsf(v.z << 16); f[5] = bitsf(v.z & 0xffff0000u); f[6] = bitsf(v.w << 16); f[7] = bitsf(v.w & 0xffff0000u);
}
__device__ __forceinline__ int orig_col(int n) {
    if (n < 1280) return n;
    if (n < 2304) return 2320 + (n - 1280);
    if (n < 3072) return 3376 + (n - 2304);
    if (n < 3088) return 1280 + (n - 3072);
    if (n < 3120) return 3344 + (n - 3088);
    if (n < NMAIN) return -1;
    return 1296 + (n - NMAIN);
}
__device__ __forceinline__ int chain_cid(int dir, int o) {
    if (dir == 0) return o;
    return o < NCC ? (NCC - 1 - o) : (NCH - 1 - (o - NCC));
}

__device__ __forceinline__ int swz(int row, int ch) { return row * 64 + ((ch ^ (row & 7)) << 3); }
__device__ __forceinline__ u32x4 pack8(const float* f) { u32x4 o; o.x = pk2(f[0], f[1]); o.y = pk2(f[2], f[3]); o.z = pk2(f[4], f[5]); o.w = pk2(f[6], f[7]); return o; }
__device__ __forceinline__ bf16x8 as_frag(u32x4 v) { return __builtin_bit_cast(bf16x8, v); }
__device__ __forceinline__ u32x4 as_u4(bf16x8 v) { return __builtin_bit_cast(u32x4, v); }

constexpr int LS = 72;

template <int NTL, int KS>
__device__ __forceinline__ void mma_nt(const bf16* A, int lda, int m0, const bf16* B, int ldb, int n0, f32x4 (&acc)[NTL], int lane) {
    const int r = lane & 15, q = lane >> 4;
#pragma unroll
    for (int ks = 0; ks < KS; ++ks) {
        const bf16x8 a = *(const bf16x8*)(A + (m0 + r) * lda + ks * 32 + q * 8);
#pragma unroll
        for (int nt = 0; nt < NTL; ++nt) {
            const bf16x8 b = *(const bf16x8*)(B + (n0 + nt * 16 + r) * ldb + ks * 32 + q * 8);
            acc[nt] = MFMA16(a, b, acc[nt]);
        }
    }
}

__device__ __forceinline__ void layer_prep(const Params& p, int l, int idx, int stride, char* smem);
__device__ __forceinline__ void phase0(const Params& p, char* smem) {
    const int tid = otid();
    cpx* TW = (cpx*)(p.ws + WS_TW);
    cpx* ROPE = (cpx*)(p.ws + WS_ROPE);
    float* MOD = (float*)(p.ws + WS_MOD);
    constexpr int N_TW = NF / NT, N_ROPE = SEQ * 32 / NT, N_MOD = DEPTH * (3 * DM / 64);
    for (int task = obid(); task < N_TW + N_ROPE + N_MOD; task += gridDim.x) {
        if (task < N_TW) {
            const int j = task * NT + tid; float s, c; sincospif(2.0f * (float)j / (float)NF, &s, &c);
            cpx v; v.x = c; v.y = -s; TW[j] = v;
        } else if (task < N_TW + N_ROPE) {
            const int idx = (task - N_TW) * NT + tid; const int pos = idx >> 5, i = idx & 31;
            const float inv = exp2f(-(float)(i & 15) * (13.287712379549449f / 16.0f));
            const float ang = (float)(i < 16 ? pos / 64 : pos % 64) * inv;
            cpx v; v.x = cosf(ang); v.y = sinf(ang); ROPE[idx] = v;
        } else {
            const int mt = task - N_TW - N_ROPE; const int l = mt / (3 * DM / 64), n0 = (mt % (3 * DM / 64)) * 64;
            float* sv = (float*)smem;
            float* red = sv + NJ * DM;
            __syncthreads();
            for (int i = tid; i < NJ * DM; i += NT) { const int j = i / DM, k = i % DM; const float v = j < NB ? p.in[I_C][j * DM + k] : p.in[I_CCTX][k]; sv[i] = siluf_(v); }
            __syncthreads();
            const int nl = tid & 63, ks = tid >> 6; float acc[NJ];
#pragma unroll
            for (int j = 0; j < NJ; ++j) acc[j] = 0.f;
            const float* w = p.in[I_WADA] + (size_t)l * DM * 3 * DM + n0 + nl;
            for (int k = ks * (DM / 8); k < (ks + 1) * (DM / 8); ++k) { const float wv = w[(size_t)k * 3 * DM];
#pragma unroll
                for (int j = 0; j < NJ; ++j) acc[j] += sv[j * DM + k] * wv; }
#pragma unroll
            for (int j = 0; j < NJ; ++j) red[(ks * NJ + j) * 64 + nl] = acc[j];
            __syncthreads();
            for (int i = tid; i < NJ * 64; i += NT) { const int j = i / 64, n = i % 64; float s = 0.f;
#pragma unroll
                for (int k8 = 0; k8 < 8; ++k8) s += red[(k8 * NJ + j) * 64 + n];
                MOD[((size_t)l * NJ + j) * 3 * DM + n0 + n] = s + p.in[I_BADA][(size_t)l * 3 * DM + n0 + n]; }
        }
    }
}

__device__ __forceinline__ void rp_rows(const Params& p, int l) {
    const int tid = otid(), lane = tid & 63, wave = tid >> 6;
    const float* MOD = (const float*)(p.ws + WS_MOD);
    float* CTXB = (float*)(p.ws + WS_CTXB);
    const bf16* YO = (const bf16*)(p.ws + WS_P);
    bf16* HN = (bf16*)(p.ws + WS_HNY);
    constexpr int NV4 = DM / 256, RW = 2;
    const int stride = (int)gridDim.x * 8;
    for (int base = obid() * 8 + wave; base < T; base += stride * RW) {
        f32x4 x[RW][NV4], y[RW][NV4]; const float* xo[RW]; float* xn[RW]; int mj[RW]; bool ok[RW];
#pragma unroll
        for (int i = 0; i < RW; ++i) { const int row = base + i * stride; ok[i] = row < T; const int rr = ok[i] ? row : base;
            const int b = rr / TOK, pp = rr % TOK; const bool isctx = pp < CTXL; if (l == DEPTH && isctx) ok[i] = false;
            const size_t off = isctx ? ((size_t)b * CTXL + pp) * DM : ((size_t)b * SEQ + (pp - CTXL)) * DM;
            xo[i] = (l <= 1) ? (isctx ? p.in[I_CTX] + off : p.in[I_X] + off) : (isctx ? CTXB + off : p.out + off);
            xn[i] = isctx ? CTXB + off : p.out + off; mj[i] = isctx ? NB : b;
#pragma unroll
            for (int j = 0; j < NV4; ++j) { x[i][j] = *(const f32x4*)(xo[i] + 4 * lane + 256 * j); if (l > 0) { const u32x2 yy = *(const u32x2*)(YO + (size_t)rr * DM + 4 * lane + 256 * j); y[i][j] = (f32x4){bitsf(yy.x << 16), bitsf(yy.x & 0xffff0000u), bitsf(yy.y << 16), bitsf(yy.y & 0xffff0000u)}; } else y[i][j] = (f32x4){0.f, 0.f, 0.f, 0.f}; } }
        if (l > 0) {
            float ss[RW];
#pragma unroll
            for (int i = 0; i < RW; ++i) { ss[i] = 0.f;
#pragma unroll
                for (int j = 0; j < NV4; ++j) ss[i] += y[i][j].x * y[i][j].x + y[i][j].y * y[i][j].y + y[i][j].z * y[i][j].z + y[i][j].w * y[i][j].w; }
#pragma unroll
            for (int i = 0; i < RW; ++i) ss[i] = wave_sum(ss[i]);
            const float* gp = p.in[I_GPOST] + (size_t)(l - 1) * DM;
#pragma unroll
            for (int i = 0; i < RW; ++i) { const float rstd = rsqrtf(ss[i] * (1.0f / DM) + EPS); const float* gt = MOD + ((size_t)(l - 1) * NJ + mj[i]) * 3 * DM + 2 * DM;
#pragma unroll
                for (int j = 0; j < NV4; ++j) { const f32x4 g4 = *(const f32x4*)(gt + 4 * lane + 256 * j), p4 = *(const f32x4*)(gp + 4 * lane + 256 * j);
                    x[i][j] = x[i][j] + g4 * (y[i][j] * rstd * p4);
                    if (ok[i]) *(f32x4*)(xn[i] + 4 * lane + 256 * j) = x[i][j]; } }
        }
        if (l < DEPTH) {
            float ss[RW];
#pragma unroll
            for (int i = 0; i < RW; ++i) { ss[i] = 0.f;
#pragma unroll
                for (int j = 0; j < NV4; ++j) ss[i] += x[i][j].x * x[i][j].x + x[i][j].y * x[i][j].y + x[i][j].z * x[i][j].z + x[i][j].w * x[i][j].w; }
#pragma unroll
            for (int i = 0; i < RW; ++i) ss[i] = wave_sum(ss[i]);
            const float* gp = p.in[I_GPRE] + (size_t)l * DM;
#pragma unroll
            for (int i = 0; i < RW; ++i) { const float rstd = rsqrtf(ss[i] * (1.0f / DM) + EPS); const float* md = MOD + ((size_t)l * NJ + mj[i]) * 3 * DM; const int row = base + i * stride;
#pragma unroll
                for (int j = 0; j < NV4; ++j) { const int e = 4 * lane + 256 * j;
                    const f32x4 g4 = *(const f32x4*)(gp + e), sh = *(const f32x4*)(md + e), sc = *(const f32x4*)(md + DM + e);
                    const f32x4 h = (x[i][j] * rstd * g4) * (sc + 1.0f) + sh;
                    u32x2 o; o.x = pk2(h.x, h.y); o.y = pk2(h.z, h.w);
                    if (ok[i]) *(u32x2*)(HN + (size_t)row * DM + e) = o; } }
        }
    }
}

__device__ __forceinline__ void convert_tile(const float* src, int ldn, bf16* dst, int K, int n0, int k0, bool use_map, char* smem) {
    const int tid = otid();
    float* tile = (float*)smem;
    __syncthreads();
#pragma unroll
    for (int i = 0; i < 8; ++i) { const int idx = tid + NT * i, k = idx >> 6, n = idx & 63;
        const int oc = use_map ? orig_col(n0 + n) : (n0 + n);
        tile[k * 65 + n] = oc >= 0 ? src[(size_t)(k0 + k) * ldn + oc] : 0.f; }
    __syncthreads();
    const int n = tid >> 3, c = tid & 7;
    u32x4 o; o.x = pk2(tile[(8 * c + 0) * 65 + n], tile[(8 * c + 1) * 65 + n]); o.y = pk2(tile[(8 * c + 2) * 65 + n], tile[(8 * c + 3) * 65 + n]);
    o.z = pk2(tile[(8 * c + 4) * 65 + n], tile[(8 * c + 5) * 65 + n]); o.w = pk2(tile[(8 * c + 6) * 65 + n], tile[(8 * c + 7) * 65 + n]);
    *(u32x4*)(dst + (size_t)(n0 + n) * K + k0 + 8 * c) = o;
}

__device__ __forceinline__ void filter_task(const Params& p, int l, int L, int pos0, char* smem) {
    const int tid = otid();
    float* z = (float*)smem;
    float* h1 = z + 8 * 33;
    float* h2 = h1 + 8 * 64;
    __syncthreads();
    if (tid < 8 * 33) { const int pp = tid / 33, i = tid % 33; const float pos = (float)(pos0 + pp);
        const float t = pos / (float)(L - 1 > 1 ? L - 1 : 1), w = 6.283185307179586f * pos / (float)L; float v;
        if (i == 0) v = t; else { const int bi = (i - 1) & 15; const float f = 1e-4f + (float)bi * ((15.0f - 1e-4f) / 15.0f); v = (i <= 16) ? cosf(w * f) : -sinf(w * f); }
        z[tid] = v; }
    __syncthreads();
    { const int pp = tid >> 6, j = tid & 63; const float* w1 = p.in[I_HW1] + (size_t)l * 33 * 64; float a = p.in[I_HB1][l * 64 + j];
        for (int i = 0; i < 33; ++i) a += z[pp * 33 + i] * w1[i * 64 + j];
        h1[tid] = sinf(p.in[I_HFREQ][(l * 2 + 0) * 64 + j] * a); }
    __syncthreads();
    { const int pp = tid >> 6, j = tid & 63; const float* w2 = p.in[I_HW2] + (size_t)l * 64 * 64; float a = p.in[I_HB2][l * 64 + j];
        for (int i = 0; i < 64; ++i) a += h1[pp * 64 + i] * w2[i * 64 + j];
        h2[tid] = sinf(p.in[I_HFREQ][(l * 2 + 1) * 64 + j] * a); }
    __syncthreads();
    { const int o = tid, dir = o >> 8, c = o & 255; const float* w3 = p.in[I_HW3] + (size_t)l * 64 * 512; const float b3 = p.in[I_HB3][l * 512 + o];
        const float delta = 3.0701134573253946f + (float)c * ((15.350567286626973f - 3.0701134573253946f) / 255.0f);
        float acc[8];
#pragma unroll
        for (int pp = 0; pp < 8; ++pp) acc[pp] = b3;
        for (int j = 0; j < 64; ++j) { const float wv = w3[j * 512 + o];
#pragma unroll
            for (int pp = 0; pp < 8; ++pp) acc[pp] += h2[pp * 64 + j] * wv; }
        float* KT = (float*)(p.ws + WS_KT); float* HC = (float*)(p.ws + WS_HC);
#pragma unroll
        for (int pp = 0; pp < 8; ++pp) { const int pos = pos0 + pp; const float t = (float)pos / (float)(L - 1 > 1 ? L - 1 : 1);
            const float v = acc[pp] * __expf(-t * delta);
            if (L == SEQ) { if (dir == 0) KT[(size_t)c * NF + pos]= v; else if (pos > 0) KT[(size_t)c * NF + (NF - pos)] = v; else KT[(size_t)c * NF + SEQ] = 0.f; }
            else HC[((size_t)dir * WG + c) * CTXL + pos] = v; }
    }
}

__device__ __forceinline__ void convert_tile_w(const float* src, int ldn, bf16* dst, int K, int n0, int k0, bool use_map, char* wl, int lane) {
    float* tile = (float*)wl;
    const int oc = use_map ? orig_col(n0 + lane) : (n0 + lane);
    float v[64];
#pragma unroll
    for (int k = 0; k < 64; ++k) v[k] = oc >= 0 ? src[(size_t)(k0 + k) * ldn + oc] : 0.f;
#pragma unroll
    for (int k = 0; k < 64; ++k) tile[k * 65 + lane] = v[k];
    WAVE_SYNC();
#pragma unroll
    for (int i = 0; i < 8; ++i) { const int n = (lane >> 3) + 8 * i, c = lane & 7; float f[8];
#pragma unroll
        for (int j = 0; j < 8; ++j) f[j] = tile[(8 * c + j) * 65 + n];
        *(u32x4*)(dst + (size_t)(n0 + n) * K + k0 + 8 * c) = pack8(f); }
    WAVE_SYNC();
}
__device__ __forceinline__ void layer_prep(const Params& p, int l, int idx, int stride, char* smem) {
    constexpr int N_WIN = (NPAD / 64) * (DM / 64), N_FL = SEQ / 8, N_FC = CTXL / 8;
    for (int task = idx; task < N_FL + N_FC; task += stride) {
        if (task < N_FL) filter_task(p, l, SEQ, task * 8, smem);
        else filter_task(p, l, CTXL, (task - N_FL) * 8, smem);
    }
    __syncthreads();
    { const int tid = otid(), lane = tid & 63, wave = __builtin_amdgcn_readfirstlane(tid >> 6);
        char* wl = smem + wave * WLDS;
        for (int task = wave * stride + idx; task < N_WIN; task += 8 * stride) { const int nt = task / (DM / 64), kt = task % (DM / 64);
            convert_tile_w(p.in[I_WIN] + (size_t)l * DM * N_IN, N_IN, (bf16*)(p.ws + WS_WIN), DM, nt * 64, kt * 64, true, wl, lane); } }
}
__device__ __forceinline__ void phase_rp(const Params& p, int l, char* smem) { rp_rows(p, l); if (l < DEPTH) layer_prep(p, l, obid(), (int)gridDim.x, smem); }

__device__ __forceinline__ cpx cmul(cpx a, cpx b) { cpx r; r.x = a.x * b.x - a.y * b.y; r.y = a.x * b.y + a.y * b.x; return r; }
__device__ __forceinline__ cpx cmulc(cpx a, cpx b) { cpx r; r.x = a.x * b.x + a.y * b.y; r.y = a.y * b.x - a.x * b.y; return r; }
constexpr int fpad(int i) { return i + (i >> 4); }
__device__ __forceinline__ int FPH(int i) { return i + (i >> 4); }
constexpr int FBUF = fpad(NF);
constexpr int ilog16(int n) { return n < 16 ? 0 : 1 + ilog16(n / 16); }
constexpr int FFT_P16 = ilog16(NF);
constexpr bool FFT_R4 = ((NF >> (4 * FFT_P16)) == 4);
static_assert((NF >> (4 * FFT_P16)) == 1 || (NF >> (4 * FFT_P16)) == 4, "NF = 16^a * (1 or 4)");
template <bool INV> __device__ __forceinline__ void dft4(cpx& a0, cpx& a1, cpx& a2, cpx& a3) {
    const cpx s = {a0.x + a2.x, a0.y + a2.y}, b = {a0.x - a2.x, a0.y - a2.y}, c = {a1.x + a3.x, a1.y + a3.y}, d = {a1.x - a3.x, a1.y - a3.y};
    a0 = (cpx){s.x + c.x, s.y + c.y}; a2 = (cpx){s.x - c.x, s.y - c.y};
    if (!INV) { a1 = (cpx){b.x + d.y, b.y - d.x}; a3 = (cpx){b.x - d.y, b.y + d.x}; }
    else      { a1 = (cpx){b.x - d.y, b.y + d.x}; a3 = (cpx){b.x + d.y, b.y - d.x}; }
}
template <bool INV> __device__ __forceinline__ cpx cmulk(cpx a, float wr, float wi) {
    cpx r; if (!INV) { r.x = a.x * wr + a.y * wi; r.y = a.y * wr - a.x * wi; } else { r.x = a.x * wr - a.y * wi; r.y = a.y * wr + a.x * wi; } return r;
}
template <bool INV> __device__ __forceinline__ void dft16(cpx (&x)[16]) {
    constexpr float C1 = 0.92387953251128674f, S1 = 0.38268343236508977f, C2 = 0.70710678118654752f;
#pragma unroll
    for (int n2 = 0; n2 < 4; ++n2) dft4<INV>(x[n2], x[4 + n2], x[8 + n2], x[12 + n2]);
    x[4 * 1 + 1] = cmulk<INV>(x[4 * 1 + 1], C1, S1); x[4 * 1 + 2] = cmulk<INV>(x[4 * 1 + 2], C2, C2); x[4 * 1 + 3] = cmulk<INV>(x[4 * 1 + 3], S1, C1);
    x[4 * 2 + 1] = cmulk<INV>(x[4 * 2 + 1], C2, C2); x[4 * 2 + 2] = cmulk<INV>(x[4 * 2 + 2], 0.f, 1.f); x[4 * 2 + 3] = cmulk<INV>(x[4 * 2 + 3], -C2, C2);
    x[4 * 3 + 1] = cmulk<INV>(x[4 * 3 + 1], S1, C1); x[4 * 3 + 2] = cmulk<INV>(x[4 * 3 + 2], -C2, C2); x[4 * 3 + 3] = cmulk<INV>(x[4 * 3 + 3], -C1, -S1);
#pragma unroll
    for (int k1 = 0; k1 < 4; ++k1) dft4<INV>(x[4 * k1 + 0], x[4 * k1 + 1], x[4 * k1 + 2], x[4 * k1 + 3]);
    cpx t;
    t = x[1]; x[1] = x[4]; x[4] = t; t = x[2]; x[2] = x[8]; x[8] = t; t = x[3]; x[3] = x[12]; x[12] = t;
    t = x[6]; x[6] = x[9]; x[9] = t; t = x[7]; x[7] = x[13]; x[13] = t; t = x[11]; x[11] = x[14]; x[14] = t;
}
template <bool INV> __device__ __forceinline__ void fft_stage16(cpx* buf, const cpx* TW, int tl, int M) {
    const int span = M >> 4, twm = NF / M;
#pragma unroll 1
    for (int j = tl; j < NF / 16; j += 256) {
        const int grp = j / span, pos = j % span, base = grp * M + pos; cpx x[16];
#pragma unroll
        for (int q = 0; q < 16; ++q) x[q] = buf[FPH(base + q * span)];
        cpx w1 = {1.f, 0.f}; if (span > 1) w1 = TW[pos * twm];
        if (INV && span > 1) { cpx wk = w1;
#pragma unroll
            for (int k = 1; k < 16; ++k) { x[k] = cmulc(x[k], wk); wk = cmul(wk, w1); } }
        dft16<INV>(x);
        if (!INV && span > 1) { cpx wk = w1;
#pragma unroll
            for (int k = 1; k < 16; ++k) { x[k] = cmul(x[k], wk); wk = cmul(wk, w1); } }
#pragma unroll
        for (int q = 0; q < 16; ++q) buf[FPH(base + q * span)] = x[q];
    }
}
template <bool INV> __device__ __forceinline__ void fft_stage4_last(cpx* buf, int tl) {
#pragma unroll 1
    for (int j = tl; j < NF / 4; j += 256) { cpx a0 = buf[FPH(4 * j)], a1 = buf[FPH(4 * j + 1)], a2 = buf[FPH(4 * j + 2)], a3 = buf[FPH(4 * j + 3)];
        dft4<INV>(a0, a1, a2, a3); buf[FPH(4 * j)] = a0; buf[FPH(4 * j + 1)] = a1; buf[FPH(4 * j + 2)] = a2; buf[FPH(4 * j + 3)] = a3; }
}
__device__ __forceinline__ void fft_fwd(cpx* buf, const cpx* TW, int tl) {
    int M = NF;
#pragma unroll
    for (int s = 0; s < FFT_P16; ++s) { __syncthreads(); fft_stage16<false>(buf, TW, tl, M); M >>= 4; }
    if (FFT_R4) { __syncthreads(); fft_stage4_last<false>(buf, tl); }
    __syncthreads();
}
__device__ __forceinline__ void fft_inv(cpx* buf, const cpx* TW, int tl) {
    if (FFT_R4) { __syncthreads(); fft_stage4_last<true>(buf, tl); }
    int M = FFT_R4 ? 64 : 16;
#pragma unroll
    for (int s = 0; s < FFT_P16; ++s) { __syncthreads(); fft_stage16<true>(buf, TW, tl, M); M <<= 4; }
    __syncthreads();
}
__device__ __forceinline__ void filt_fft_task(const Params& p, int cp, char* smem) {
    const int tid = otid(), half = tid >> 8, tl = tid & 255, c = 2 * cp + half;
    cpx* buf = (cpx*)smem + (size_t)half * FBUF;
    const float* KT = (const float*)(p.ws + WS_KT) + (size_t)c * NF;
    cpx* KF = (cpx*)(p.ws + WS_KF) + (size_t)c * NF;
    const cpx* TW = (const cpx*)(p.ws + WS_TW);
    __syncthreads();
    for (int i = tl; i < NF; i += 256) { cpx v; v.x = KT[i]; v.y = 0.f; buf[FPH(i)] = v; }
    fft_fwd(buf, TW, tl);
    for (int i = tl; i < NF; i += 256) KF[i] = buf[FPH(i)];
}

__device__ __forceinline__ void gemm_tile(const Params& p, const bf16* A, const bf16* Bt, int K, int mt, int nt, int mode, char* smem) {
    const int tid = otid(), lane = tid & 63, wave = tid >> 6;
    bf16* As = (bf16*)smem;
    bf16* Bs = As + 128 * LS;
    const int wm = (wave & 3) * 32, wn = (wave >> 2) * 64;
    f32x4 acc[2][4];
#pragma unroll
    for (int i = 0; i < 2; ++i)
#pragma unroll
        for (int j = 0; j < 4; ++j) acc[i][j] = (f32x4){0.f, 0.f, 0.f, 0.f};
    const int lr = tid >> 3, lc = tid & 7;
    const bf16* Ag = A + (size_t)(mt * 128 + lr) * K + lc * 8;
    const bf16* Bg = Bt + (size_t)(nt * 128 + lr) * K + lc * 8;
    u32x4 ra0, ra1, rb0, rb1;
    ra0 = *(const u32x4*)(Ag); ra1 = *(const u32x4*)(Ag + (size_t)64 * K); rb0 = *(const u32x4*)(Bg); rb1 = *(const u32x4*)(Bg + (size_t)64 * K);
    const int nk = K / 64;
    for (int kt = 0; kt < nk; ++kt) {
        __syncthreads();
        *(u32x4*)(As + lr * LS + lc * 8) = ra0; *(u32x4*)(As + (lr + 64) * LS + lc * 8) = ra1;
        *(u32x4*)(Bs + lr * LS + lc * 8) = rb0; *(u32x4*)(Bs + (lr + 64) * LS + lc * 8) = rb1;
        __syncthreads();
        if (kt + 1 < nk) { const int ko = (kt + 1) * 64;
            ra0 = *(const u32x4*)(Ag + ko); ra1 = *(const u32x4*)(Ag + (size_t)64 * K + ko); rb0 = *(const u32x4*)(Bg + ko); rb1 = *(const u32x4*)(Bg + (size_t)64 * K + ko); }
        mma_nt<4, 2>(As, LS, wm, Bs, LS, wn, acc[0], lane);
        mma_nt<4, 2>(As, LS, wm + 16, Bs, LS, wn, acc[1], lane);
    }
    const int r = lane & 15, q = lane >> 4;
#pragma unroll
    for (int i = 0; i < 2; ++i)
#pragma unroll
        for (int j = 0; j < 4; ++j)
#pragma unroll
            for (int e = 0; e < 4; ++e) {
                const int row = mt * 128 + wm + 16 * i + 4 * q + e, col = nt * 128 + wn + 16 * j + r; const float v = acc[i][j][e];
                if (mode == 0) { if (col < NP) ((bf16*)(p.ws + WS_P))[(size_t)row * NP + col] = f2bf(v); else if (col < NP + 16) ((float*)(p.ws + WS_G))[(size_t)row * NGS + (col - NP)] = v; else if (col < NP + NG) ((bf16*)((float*)(p.ws + WS_G) + (size_t)row * NGS + 16))[col - NP - 16] = f2bf(v); }
                else if (mode == 2) ((bf16*)(p.ws + WS_HT))[(size_t)row * T + col] = f2bf(v);
                else ((bf16*)(p.ws + WS_P))[(size_t)row * DM + col] = f2bf(v);
            }
}

#ifndef EMU
namespace pg8 {
#define PG8_LAS __attribute__((address_space(3)))
typedef unsigned short bf16_t;
typedef short bf16x8 __attribute__((ext_vector_type(8)));
typedef float f32x4 __attribute__((ext_vector_type(4)));
typedef unsigned u32x4 __attribute__((ext_vector_type(4)));
constexpr int BM = 256, BK = 64, HALF = 128, HTB = HALF * BK * 2  , STAGE_BYTES = 8 * HTB, NXCD = 8, WGM = 8;

__host__ __device__ __forceinline__ int lds_byte(int r, int c) { const int st = (r >> 4) * 2 + (c >> 5), rr = r & 15, cc = c & 31, ob = rr * 64 + cc * 2; return st * 1024 + (ob ^ (((ob >> 9) & 1) << 5)); }
__host__ __device__ __forceinline__ void stage_rc(int b, int& R, int& C) { const int st = b / 1024, sb = b % 1024, swz = sb ^ (((sb >> 9) & 1) << 5); R = (st >> 1) * 16 + swz / 64; C = (st & 1) * 32 + (swz % 64) / 2; }
__host__ __device__ __forceinline__ int perm32(int rho) { const int n = rho >> 4, i = rho & 15; return 8 * (i >> 2) + 4 * n + (i & 3); }

struct Unit { int pm, pn; };
struct Gemm { const bf16_t* A; const bf16_t* Bt; int M, N, K; };
__device__ __forceinline__ unsigned cvt_pk_bf16(float lo, float hi) { unsigned r; asm volatile("v_cvt_pk_bf16_f32 %0, %1, %2" : "=v"(r) : "v"(lo), "v"(hi)); return r; }
template <class Epi, class Sched, bool ALIGN_EPI = false, bool SP2 = false>
__device__ __forceinline__ void gemm_phase(PG8_LAS unsigned char* lds, const Gemm g, const Sched& S, const Epi& E) {
    const int tid = otid(), wid = __builtin_amdgcn_readfirstlane(tid >> 6), lane = tid & 63, wr = wid >> 2, wc = wid & 3, fr = lane & 15, fq = lane >> 4;
    const int K = g.K, nt = K / BK;
    unsigned voffA[2], voffB[2];
#pragma unroll
    for (int i = 0; i < 2; ++i) { int R, C; stage_rc(tid * 16 + i * 8192, R, C); const int Rb = Epi::PERM ? ((R & ~31) + perm32(R & 31)) : R;
        voffA[i] = (unsigned)(R * K + C) * 2u; voffB[i] = (unsigned)(Rb * K + C) * 2u; }
    const size_t kstep = (size_t)(BK * 2);
    const size_t hstep = (size_t)HALF * K * 2;
    const size_t tstep = 2 * hstep;
    const unsigned ldsw = (unsigned)wid * 1024u;
    const int aoff = lds_byte(wr * 64 + fr, fq * 8), boff = lds_byte(wc * 32 + fr, fq * 8);
#define PG8_SA(b, h) (((b) * 2 + (h)) * HTB)
#define PG8_SB(b, h) ((4 + (b) * 2 + (h)) * HTB)
#define PG8_STAGE(bufoff, gbase, voff) do { _Pragma("unroll") for (int _i = 0; _i < 2; ++_i) \
        __builtin_amdgcn_global_load_lds((const unsigned*)((const char*)(gbase) + (voff)[_i]), (PG8_LAS unsigned*)(lds + (bufoff) + ldsw + _i * 8192), 16, 0, 0); } while (0)
#define PG8_LDA(dst, b, h) do { _Pragma("unroll") for (int m = 0; m < 4; ++m) _Pragma("unroll") for (int k = 0; k < 2; ++k) dst[m][k] = *(const PG8_LAS bf16x8*)(lds + PG8_SA(b, h) + aoff + m * 2048 + k * 1024); } while (0)
#define PG8_LDB(dst, b, h) do { _Pragma("unroll") for (int n = 0; n < 2; ++n) _Pragma("unroll") for (int k = 0; k < 2; ++k) dst[n][k] = *(const PG8_LAS bf16x8*)(lds + PG8_SB(b, h) + boff + n * 2048 + k * 1024); } while (0)
#define PG8_MMA(ai, bj, At, Bt) do { __builtin_amdgcn_s_setprio(1); _Pragma("unroll") for (int m = 0; m < 4; ++m) _Pragma("unroll") for (int n = 0; n < 2; ++n) _Pragma("unroll") for (int k = 0; k < 2; ++k) \
        acc[ai][bj][m][n] = __builtin_amdgcn_mfma_f32_16x16x32_bf16(Bt[n][k], At[m][k], acc[ai][bj][m][n], 0, 0, 0); __builtin_amdgcn_s_setprio(0); } while (0)
#define PG8_WAIT_V(n) asm volatile("s_waitcnt vmcnt(" #n ")" ::: "memory")
#define PG8_WAIT_L(n) asm volatile("s_waitcnt lgkmcnt(" #n ")" ::: "memory")
#define PG8_BAR __builtin_amdgcn_s_barrier()
#define PG8_SCHED __builtin_amdgcn_sched_barrier(0)
    Unit cur, nxt; int ui = 0;
    if (!S.next(0, cur)) return;
    f32x4 acc[2][2][4][2];
#pragma unroll
    for (int a = 0; a < 2; ++a)
#pragma unroll
        for (int b = 0; b < 2; ++b)
#pragma unroll
            for (int m = 0; m < 4; ++m)
#pragma unroll
                for (int n = 0; n < 2; ++n) acc[a][b][m][n] = (f32x4){0.f, 0.f, 0.f, 0.f};
    bf16x8 At[4][2], B0[2][2], B1[2][2];
    const char* cA = (const char*)g.A + (size_t)cur.pm * tstep; const char* cB = (const char*)g.Bt + (size_t)cur.pn * tstep;
    S.a_ready(cur);
    if constexpr (SP2) {
        PG8_STAGE(PG8_SB(0, 0), cB, voffB); PG8_STAGE(PG8_SB(0, 1), cB + hstep, voffB); PG8_STAGE(PG8_SA(0, 0), cA, voffA); PG8_STAGE(PG8_SA(0, 1), cA + hstep, voffA);
        if (wr == 1) PG8_BAR;
        PG8_WAIT_V(2); PG8_BAR;
        PG8_STAGE(PG8_SB(1, 0), cB + kstep, voffB); PG8_STAGE(PG8_SA(1, 0), cA + kstep, voffA); PG8_STAGE(PG8_SB(1, 1), cB + hstep + kstep, voffB);
        PG8_WAIT_V(6); PG8_BAR;
    } else {
        PG8_STAGE(PG8_SB(0, 0), cB, voffB); PG8_STAGE(PG8_SA(0, 0), cA, voffA); PG8_STAGE(PG8_SB(0, 1), cB + hstep, voffB); PG8_STAGE(PG8_SA(0, 1), cA + hstep, voffA);
        if (wr == 1) PG8_BAR;
        PG8_WAIT_V(4); PG8_BAR;
        PG8_STAGE(PG8_SB(1, 0), cB + kstep, voffB); PG8_STAGE(PG8_SA(1, 0), cA + kstep, voffA); PG8_STAGE(PG8_SB(1, 1), cB + hstep + kstep, voffB);
        PG8_WAIT_V(6); PG8_BAR;
    }
    for (;;) {
        const bool has_next = S.next(ui + 1, nxt);
        const char* nA = has_next ? (const char*)g.A + (size_t)nxt.pm * tstep : cA; const char* nB = has_next ? (const char*)g.Bt + (size_t)nxt.pn * tstep : cB;
        for (int t = 0; t < nt; t += 2) {
            const bool last = (t == nt - 2);
            const char* a1 = cA + (size_t)(t + 1) * kstep;
            const char* a2 = last ? nA : cA + (size_t)(t + 2) * kstep; const char* b2 = last ? nB : cB + (size_t)(t + 2) * kstep;
            const char* a3 = a2 + kstep; const char* b3 = b2 + kstep;
            if (last && has_next) S.a_ready(nxt);
            if constexpr (SP2) {
            PG8_LDB(B0, 0, 0); PG8_LDB(B1, 0, 1); PG8_SCHED; PG8_LDA(At, 0, 0); PG8_STAGE(PG8_SA(1, 1), a1 + hstep, voffA);
            PG8_WAIT_V(8); PG8_WAIT_L(0); PG8_BAR; PG8_MMA(0, 0, At, B0); PG8_MMA(0, 1, At, B1); PG8_BAR; PG8_SCHED;
            PG8_LDA(At, 0, 1); PG8_STAGE(PG8_SB(0, 0), b2, voffB); PG8_STAGE(PG8_SB(0, 1), b2 + hstep, voffB); PG8_STAGE(PG8_SA(0, 0), a2, voffA);
            PG8_WAIT_V(8); PG8_WAIT_L(0); PG8_BAR; PG8_MMA(1, 0, At, B0); PG8_MMA(1, 1, At, B1); PG8_BAR; PG8_SCHED;
            PG8_LDB(B0, 1, 0); PG8_LDB(B1, 1, 1); PG8_SCHED; PG8_LDA(At, 1, 0); PG8_STAGE(PG8_SA(0, 1), a2 + hstep, voffA);
            PG8_WAIT_V(8); PG8_WAIT_L(0); PG8_BAR; PG8_MMA(0, 0, At, B0); PG8_MMA(0, 1, At, B1); PG8_BAR; PG8_SCHED;
            PG8_LDA(At, 1, 1); PG8_STAGE(PG8_SB(1, 0), b3, voffB); PG8_STAGE(PG8_SB(1, 1), b3 + hstep, voffB); PG8_STAGE(PG8_SA(1, 0), a3, voffA);
            PG8_WAIT_V(8); PG8_WAIT_L(0); PG8_BAR; PG8_MMA(1, 0, At, B0); PG8_MMA(1, 1, At, B1); PG8_BAR; PG8_SCHED;
            } else {
            PG8_LDB(B0, 0, 0); PG8_SCHED; PG8_LDA(At, 0, 0); PG8_STAGE(PG8_SA(1, 1), a1 + hstep, voffA);
            PG8_WAIT_L(8); PG8_BAR; PG8_WAIT_L(0); PG8_MMA(0, 0, At, B0); PG8_BAR; PG8_SCHED;
            PG8_LDB(B1, 0, 1); PG8_STAGE(PG8_SB(0, 0), b2, voffB);
            PG8_BAR; PG8_WAIT_L(0); PG8_MMA(0, 1, At, B1); PG8_BAR;
            PG8_LDA(At, 0, 1); PG8_STAGE(PG8_SA(0, 0), a2, voffA);
            PG8_BAR; PG8_WAIT_L(0); PG8_MMA(1, 0, At, B0); PG8_BAR; PG8_SCHED;
            PG8_STAGE(PG8_SB(0, 1), b2 + hstep, voffB);
            PG8_WAIT_V(6); PG8_BAR; PG8_MMA(1, 1, At, B1); PG8_BAR;
            PG8_LDB(B0, 1, 0); PG8_SCHED; PG8_LDA(At, 1, 0); PG8_STAGE(PG8_SA(0, 1), a2 + hstep, voffA);
            PG8_WAIT_L(8); PG8_BAR; PG8_WAIT_L(0); PG8_MMA(0, 0, At, B0); PG8_BAR; PG8_SCHED;
            PG8_LDB(B1, 1, 1); PG8_STAGE(PG8_SB(1, 0), b3, voffB);
            PG8_BAR; PG8_WAIT_L(0); PG8_MMA(0, 1, At, B1); PG8_BAR;
            PG8_LDA(At, 1, 1); PG8_STAGE(PG8_SA(1, 0), a3, voffA);
            PG8_BAR; PG8_WAIT_L(0); PG8_MMA(1, 0, At, B0); PG8_BAR; PG8_SCHED;
            PG8_STAGE(PG8_SB(1, 1), b3 + hstep, voffB);
            PG8_WAIT_V(6); PG8_BAR; PG8_MMA(1, 1, At, B1); PG8_BAR;
            }
        }
        if constexpr (ALIGN_EPI) { if (wr == 0) PG8_BAR; }
        if constexpr (!Epi::AFTER_DRAIN) { E(acc, cur, wr, wc, fr, fq); S.done(cur); }
        if (!has_next) break;
#pragma unroll
        for (int a = 0; a < 2; ++a)
#pragma unroll
            for (int b = 0; b < 2; ++b)
#pragma unroll
                for (int m = 0; m < 4; ++m)
#pragma unroll
                    for (int n = 0; n < 2; ++n) acc[a][b][m][n] = (f32x4){0.f, 0.f, 0.f, 0.f};
        cur = nxt; cA = nA; cB = nB; ++ui;
        if constexpr (ALIGN_EPI) { if (wr == 1) PG8_BAR; }
    }
    PG8_WAIT_V(0);
    if constexpr (!ALIGN_EPI) { if (wr == 0) PG8_BAR; }
    PG8_BAR;
    if constexpr (Epi::AFTER_DRAIN) { E.fused(acc, cur, wr, wc, fr, fq, lds, wid, lane); S.done(cur); }
#undef PG8_SA
#undef PG8_SB
#undef PG8_STAGE
#undef PG8_LDA
#undef PG8_LDB
#undef PG8_MMA
#undef PG8_WAIT_V
#undef PG8_WAIT_L
#undef PG8_BAR
#undef PG8_SCHED
}
__device__ __forceinline__ void map_tile(int L, int nM, int nN, int& pm, int& pn) {
    const int nwg = nM * nN; int wgid = L; { const int q = nwg / NXCD, r = nwg % NXCD, xcd = wgid % NXCD, off = wgid / NXCD; wgid = (xcd < r ? xcd * (q + 1) : r * (q + 1) + (xcd - r) * q) + off; }
    const int nig = WGM * nN, gid = wgid / nig, fm = gid * WGM, gsz = (nM - fm) < WGM ? (nM - fm) : WGM;
    pm = fm + ((wgid % nig) % gsz); pn = (wgid % nig) / gsz;
}
constexpr int MP = T / 256, WP = NMAIN / 256, NU2 = 4 * MP, NU1 = MP * WP;
struct InOrder { int G, c;
    __device__ __forceinline__ bool next(int i, Unit& u) const { const int L = i * G + c; if (L >= NU2 + NU1) return false; int a, b;
        if (L < NU2) { map_tile(L, 4, MP, a, b); u.pm = MP + WP + a; u.pn = b; } else { map_tile(L - NU2, MP, WP, a, b); u.pm = a; u.pn = MP + b; } return true; }
    __device__ __forceinline__ void a_ready(const Unit&) const {}
    __device__ __forceinline__ void done(const Unit&) const {}
};
struct EpiIn { static constexpr bool PERM = true, AFTER_DRAIN = false; bf16_t* P; float* G; bf16_t* HTp;
    __device__ __forceinline__ void operator()(const f32x4 (&acc)[2][2][4][2], const Unit& u, int wr, int wc, int fr, int fq) const {
        if (u.pm < MP) { const int pn = u.pn - MP, row0 = u.pm * BM + wr * 64 + fr;
            if (pn < NP / 256) { const int col0 = pn * BM + wc * 32 + 8 * fq;
#pragma unroll
                for (int ai = 0; ai < 2; ++ai)
#pragma unroll
                    for (int m = 0; m < 4; ++m) { bf16_t* rowp = P + (size_t)(row0 + ai * HALF + m * 16) * NP + col0;
#pragma unroll
                        for (int bj = 0; bj < 2; ++bj) { const f32x4 v0 = acc[ai][bj][m][0], v1 = acc[ai][bj][m][1];
                            u32x4 w; w.x = cvt_pk_bf16(v0[0], v0[1]); w.y = cvt_pk_bf16(v0[2], v0[3]); w.z = cvt_pk_bf16(v1[0], v1[1]); w.w = cvt_pk_bf16(v1[2], v1[3]); *(u32x4*)(rowp + bj * HALF) = w; } } }
            else { const int cb = wc * 32 + 8 * fq;
                if (cb < NG) {
#pragma unroll
                    for (int ai = 0; ai < 2; ++ai)
#pragma unroll
                        for (int m = 0; m < 4; ++m) { float* rowb = G + (size_t)(row0 + ai * HALF + m * 16) * NGS; const f32x4 v0 = acc[ai][0][m][0], v1 = acc[ai][0][m][1];
                            if (cb < 16) { *(f32x4*)(rowb + cb) = v0; *(f32x4*)(rowb + cb + 4) = v1; }
                            else { u32x4 w; w.x = cvt_pk_bf16(v0[0], v0[1]); w.y = cvt_pk_bf16(v0[2], v0[3]); w.z = cvt_pk_bf16(v1[0], v1[1]); w.w = cvt_pk_bf16(v1[2], v1[3]); *(u32x4*)((bf16_t*)(rowb + 16) + (cb - 16)) = w; } } } } }
        else { const int row0 = (u.pm - MP - WP) * BM + wr * 64 + fr, col0 = u.pn * BM + wc * 32 + 8 * fq;
#pragma unroll
            for (int ai = 0; ai < 2; ++ai)
#pragma unroll
                for (int m = 0; m < 4; ++m) { bf16_t* rowp = HTp + (size_t)(row0 + ai * HALF + m * 16) * T + col0;
#pragma unroll
                    for (int bj = 0; bj < 2; ++bj) { const f32x4 v0 = acc[ai][bj][m][0], v1 = acc[ai][bj][m][1];
                        u32x4 w; w.x = cvt_pk_bf16(v0[0], v0[1]); w.y = cvt_pk_bf16(v0[2], v0[3]); w.z = cvt_pk_bf16(v1[0], v1[1]); w.w = cvt_pk_bf16(v1[2], v1[3]); *(u32x4*)(rowp + bj * HALF) = w; } } }
    }
};
struct OutOrder { int G, c; bool lat_only;
    __device__ __forceinline__ bool next(int i, Unit& u) const { const int nM = lat_only ? NB * (SEQ / 256) : MP, nN = DM / 256; const int L = i * G + c; if (L >= nM * nN) return false; int a, b; map_tile(L, nM, nN, a, b);
        u.pm = lat_only ? (a / (SEQ / 256)) * (TOK / 256) + CTXL / 256 + a % (SEQ / 256) : a; u.pn = b; return true; }
    __device__ __forceinline__ void a_ready(const Unit&) const {}
    __device__ __forceinline__ void done(const Unit&) const {}
};
struct EpiOut { static constexpr bool PERM = true, AFTER_DRAIN = false; bf16_t* C;
    __device__ __forceinline__ void operator()(const f32x4 (&acc)[2][2][4][2], const Unit& u, int wr, int wc, int fr, int fq) const {
        const int row0 = u.pm * BM + wr * 64 + fr, col0 = u.pn * BM + wc * 32 + 8 * fq;
#pragma unroll
        for (int ai = 0; ai < 2; ++ai)
#pragma unroll
            for (int m = 0; m < 4; ++m) { bf16_t* rowp = C + (size_t)(row0 + ai * HALF + m * 16) * DM + col0;
#pragma unroll
                for (int bj = 0; bj < 2; ++bj) { const f32x4 v0 = acc[ai][bj][m][0], v1 = acc[ai][bj][m][1];
                    u32x4 w; w.x = cvt_pk_bf16(v0[0], v0[1]); w.y = cvt_pk_bf16(v0[2], v0[3]); w.z = cvt_pk_bf16(v1[0], v1[1]); w.w = cvt_pk_bf16(v1[2], v1[3]); *(u32x4*)(rowp + bj * HALF) = w; } }
    }
};
}
#endif

__device__ __forceinline__ void phase_gemm_in(const Params& p, int l, char* smem) {
    constexpr int N_F = WG / 2;
#ifdef EMU
    constexpr int MT = T / 128, NT1 = NMAIN / 128, N1 = MT * NT1, N2 = 8 * MT;
    for (int task = obid(); task < N1 + N2; task += gridDim.x) {
        if (task < N1) gemm_tile(p, (const bf16*)(p.ws + WS_HNY), (const bf16*)(p.ws + WS_WIN), DM, task / NT1, task % NT1, 0, smem);
        else { const int t2 = task - N1; gemm_tile(p, (const bf16*)(p.ws + WS_WIN) + (size_t)NMAIN * DM, (const bf16*)(p.ws + WS_HNY), DM, t2 / MT, t2 % MT, 2, smem); }
    }
#else
    { const pg8::Gemm g{(const pg8::bf16_t*)(p.ws + WS_HNY), (const pg8::bf16_t*)(p.ws + WS_HNY), 0, 0, DM};
      const pg8::InOrder S{(int)gridDim.x, obid()};
      const pg8::EpiIn E{(pg8::bf16_t*)(p.ws + WS_P), (float*)(p.ws + WS_G), (pg8::bf16_t*)(p.ws + WS_HT)};
      pg8::gemm_phase<pg8::EpiIn, pg8::InOrder, true, true>((PG8_LAS unsigned char*)smem, g, S, E); }
#endif
    { const int G = (int)gridDim.x, bid = obid();
#ifdef EMU
      const int extra = 0;
#else
      const int extra = (pg8::NU1 + pg8::NU2) % G;
#endif
      if (extra > 0 && extra < G) { if (bid >= extra) for (int task = bid - extra; task < N_F; task += G - extra) filt_fft_task(p, task, smem); }
      else for (int task = G - 1 - bid; task < N_F; task += G) filt_fft_task(p, task, smem); }
}
__device__ __forceinline__ void phase_gemm_out(const Params& p, int l, char* smem) {
    const int G = (int)gridDim.x, bid = obid();
#ifdef EMU
    constexpr int MT = T / 128, NTO = DM / 128;
    for (int task = bid; task < MT * NTO; task += G) {
        const int mt = task / NTO, nt = task % NTO;
        if (l == DEPTH - 1 && (mt % (TOK / 128)) < CTXL / 128) continue;
        gemm_tile(p, (const bf16*)(p.ws + WS_HNY), (const bf16*)(p.ws + WS_WOUT), MIX, mt, nt, 1, smem);
    }
    const int extra = 0;
#else
    const pg8::Gemm g{(const pg8::bf16_t*)(p.ws + WS_HNY), (const pg8::bf16_t*)(p.ws + WS_WOUT), 0, 0, MIX};
    const pg8::OutOrder S{G, bid, l == DEPTH - 1};
    const pg8::EpiOut E{(pg8::bf16_t*)(p.ws + WS_P)};
    pg8::gemm_phase<pg8::EpiOut, pg8::OutOrder, true, true>((PG8_LAS unsigned char*)smem, g, S, E);
    const int nU = (l == DEPTH - 1 ? NB * (SEQ / 256) : T / 256) * (DM / 256); const int extra = nU % G;
#endif
    (void)extra;
}

__device__ __forceinline__ size_t st_index(int mixer, int dir, int b, int h, int cid) { return ((((size_t)(mixer * 2 + dir) * NB + b) * NH + h) * NCH + cid); }
__device__ __forceinline__ size_t ch_index(int dir, int b, int h, int cid) { return (((size_t)dir * NB + b) * NH + h) * NCH + cid; }

__device__ __forceinline__ void load_tile_nat(const bf16* P, int r0, int c0, bf16* dst, float scale, int tid) {
    const int s = tid >> 3, c8 = tid & 7;
    const u32x4 v = *(const u32x4*)(P + (size_t)(r0 + s) * NP + c0 + c8 * 8);
    if (scale == 1.0f) *(u32x4*)(dst + s * LS + c8 * 8) = v;
    else { float f[8]; unpack8(v, f); u32x4 o; o.x = pk2(f[0] * scale, f[1] * scale); o.y = pk2(f[2] * scale, f[3] * scale); o.z = pk2(f[4] * scale, f[5] * scale); o.w = pk2(f[6] * scale, f[7] * scale);
        *(u32x4*)(dst + s * LS + c8 * 8) = o; }
}
__device__ __forceinline__ void load_tile_tr(const bf16* P, int r0, int c0, bf16* dst, int tid) {
    const int s = tid >> 3, c8 = tid & 7;
    const u32x4 v = *(const u32x4*)(P + (size_t)(r0 + s) * NP + c0 + c8 * 8);
    const unsigned w[4] = {v.x, v.y, v.z, v.w};
#pragma unroll
    for (int j = 0; j < 4; ++j) { dst[(c8 * 8 + 2 * j) * LS + s] = (bf16)(w[j] & 0xffffu); dst[(c8 * 8 + 2 * j + 1) * LS + s] = (bf16)(w[j] >> 16); }
}

template <int NTK>
__device__ __forceinline__ void load_span(const bf16* row, int t0, float (&v)[NTK + 2]) {
    v[0] = t0 > 0 ? bf2f(row[-1]) : 0.f; v[NTK + 1] = (t0 + NTK < SEQ) ? bf2f(row[NTK]) : 0.f;
    if constexpr (NTK == 8) { float f[8]; unpack8(*(const u32x4*)row, f);
#pragma unroll
        for (int i = 0; i < 8; ++i) v[1 + i] = f[i]; }
    else {
#pragma unroll
        for (int i = 0; i < NTK; ++i) v[1 + i] = bf2f(row[i]); }
}
template <int NTK>
__device__ __forceinline__ void hy_inputs(const bf16* h0, const bf16* h1, const float* cw, const float* cb, int c, int t0, float (&u0)[NTK], float (&u1)[NTK], float (&g0)[NTK], float (&g1)[NTK]) {
    { float xa[NTK + 2], xb[NTK + 2]; load_span<NTK>(h0 + (size_t)512 * T, t0, xa); load_span<NTK>(h1 + (size_t)512 * T, t0, xb);
        const float w0 = cw[0 * 768 + 512 + c], w1 = cw[1 * 768 + 512 + c], w2 = cw[2 * 768 + 512 + c], bb = cb[512 + c];
        float ga[NTK + 2], gb[NTK + 2]; load_span<NTK>(h0 + (size_t)768 * T, t0, ga); load_span<NTK>(h1 + (size_t)768 * T, t0, gb);
#pragma unroll
        for (int i = 0; i < NTK; ++i) { g0[i] = (w0 * xa[i] + w1 * xa[i + 1] + w2 * xa[i + 2] + bb) * siluf_(ga[i + 1]); g1[i] = (w0 * xb[i] + w1 * xb[i + 1] + w2 * xb[i + 2] + bb) * siluf_(gb[i + 1]); } }
    { float va[NTK + 2], vb[NTK + 2], ya[NTK + 2], yb[NTK + 2];
        load_span<NTK>(h0, t0, va); load_span<NTK>(h1, t0, vb); load_span<NTK>(h0 + (size_t)256 * T, t0, ya); load_span<NTK>(h1 + (size_t)256 * T, t0, yb);
        const float v0 = cw[0 * 768 + c], v1 = cw[1 * 768 + c], v2 = cw[2 * 768 + c], vbias = cb[c];
        const float y0 = cw[0 * 768 + 256 + c], y1 = cw[1 * 768 + 256 + c], y2 = cw[2 * 768 + 256 + c], ybias = cb[256 + c];
#pragma unroll
        for (int i = 0; i < NTK; ++i) { u0[i] = (v0 * va[i] + v1 * va[i + 1] + v2 * va[i + 2] + vbias) * (y0 * ya[i] + y1 * ya[i + 1] + y2 * ya[i + 2] + ybias);
            u1[i] = (v0 * vb[i] + v1 * vb[i + 1] + v2 * vb[i + 2] + vbias) * (y0 * yb[i] + y1 * yb[i + 1] + y2 * yb[i + 2] + ybias); } }
}
__device__ __forceinline__ void hylat_task(const Params& p, int l, int bp, int cp, char* smem) {
    const int tid = otid(), half = tid >> 8, tl = tid & 255, c = 2 * cp + half;
    const bf16* HT = (const bf16*)(p.ws + WS_HT); bf16* Y = (bf16*)(p.ws + WS_HNY);
    cpx* buf = (cpx*)smem + (size_t)half * FBUF;
    const cpx* TW = (const cpx*)(p.ws + WS_TW);
    const cpx* KF = (const cpx*)(p.ws + WS_KF) + (size_t)c * NF;
    constexpr int NTK = SEQ / 256;
    const int t0 = NTK * tl;
    const float* cw = p.in[I_HCW] + (size_t)l * 3 * 768; const float* cb = p.in[I_HCB] + (size_t)l * 768;
    const size_t rb0 = (size_t)(2 * bp) * TOK + CTXL, rb1 = rb0 + TOK;
    const bf16* h0 = HT + (size_t)c * T + rb0 + t0; const bf16* h1 = h0 + TOK;
    { float u0[NTK], u1[NTK], g0[NTK], g1[NTK]; hy_inputs<NTK>(h0, h1, cw, cb, c, t0, u0, u1, g0, g1);
        __syncthreads();
#pragma unroll
        for (int i = 0; i < NTK; ++i) { cpx v; v.x = u0[i]; v.y = u1[i]; buf[FPH(t0 + i)] = v; cpx z = {0.f, 0.f}; buf[FPH(SEQ + t0 + i)] = z; } }
    fft_fwd(buf, TW, tl);
#pragma unroll 2
    for (int i = tl; i < NF; i += 256) buf[FPH(i)] = cmul(buf[FPH(i)], KF[i]);
    fft_inv(buf, TW, tl);
    const float dsk = p.in[I_HD][(size_t)l * WG + c]; const float sc = 1.0f / (float)NF;
    { const int tz = otid() & 255; const int t0z = NTK * tz;
        float u0[NTK], u1[NTK], g0[NTK], g1[NTK]; hy_inputs<NTK>(HT + (size_t)c * T + rb0 + t0z, HT + (size_t)c * T + rb0 + t0z + TOK, cw, cb, c, t0z, u0, u1, g0, g1);
        float o0[NTK], o1[NTK];
#pragma unroll
        for (int i = 0; i < NTK; ++i) { const cpx y = buf[FPH(t0z + i)]; o0[i] = g0[i] * (y.x * sc + u0[i] * dsk); o1[i] = g1[i] * (y.y * sc + u1[i] * dsk); }
        bf16* d0 = (bf16*)(p.ws + WS_HT) + (size_t)(768 + c) * T + rb0 + t0z; bf16* d1 = d0 + TOK;
        if constexpr (NTK == 8) { *(u32x4*)d0 = pack8(o0); *(u32x4*)d1 = pack8(o1); }
        else {
#pragma unroll
            for (int i = 0; i < NTK; ++i) { d0[i] = f2bf(o0[i]); d1[i] = f2bf(o1[i]); } } }
}

constexpr int HCB = 16;
__device__ __forceinline__ void hyctx_task(const Params& p, int l, int b, int cblk, char* smem) {
    const int tid = otid(); const int c0 = cblk * HCB;
    const bf16* HT = (const bf16*)(p.ws + WS_HT); bf16* Y = (bf16*)(p.ws + WS_HNY); const float* HC = (const float*)(p.ws + WS_HC);
    float* raw = (float*)smem;
    float* u = raw + 4 * CTXL * HCB;
    float* og = u + CTXL * HCB;
    float* hcm = og + CTXL * HCB;
    bf16* ob = (bf16*)raw;
    const size_t rb = (size_t)b * TOK;
    const float* cw = p.in[I_HCW] + (size_t)l * 3 * 768; const float* cbias = p.in[I_HCB] + (size_t)l * 768;
    constexpr int WT = CTXL / 32;
    __syncthreads();
    for (int i = tid; i < 4 * HCB * (CTXL / 8); i += NT) { const int k = i / (HCB * (CTXL / 8)), cc = (i / (CTXL / 8)) % HCB, ck = i % (CTXL / 8);
        float f[8]; unpack8(*(const u32x4*)(HT + (size_t)(k * 256 + c0 + cc) * T + rb + ck * 8), f);
#pragma unroll
        for (int j = 0; j < 8; ++j) raw[(k * CTXL + ck * 8 + j) * HCB + cc] = f[j]; }
    for (int i = tid; i < 2 * HCB * (CTXL / 4); i += NT) { const int dir = i / (HCB * (CTXL / 4)), cc = (i / (CTXL / 4)) % HCB, pk = i % (CTXL / 4);
        const f32x4 v = *(const f32x4*)(HC + ((size_t)dir * WG + c0 + cc) * CTXL + pk * 4); const float f[4] = {v.x, v.y, v.z, v.w};
#pragma unroll
        for (int j = 0; j < 4; ++j) { const int pos = pk * 4 + j; if (dir == 0) hcm[(CTXL + pos) * HCB + cc] = f[j]; else if (pos > 0) hcm[(CTXL - pos) * HCB + cc] = f[j]; } }
    if (tid < HCB) hcm[tid] = 0.f;
    __syncthreads();
    for (int i = tid; i < CTXL * HCB; i += NT) { const int t = i / HCB, cc = i % HCB; float cv[3];
#pragma unroll
        for (int k = 0; k < 3; ++k) { const float* rk = raw + k * CTXL * HCB; const int ch = k * 256 + c0 + cc;
            const float a = t > 0 ? rk[(t - 1) * HCB + cc] : 0.f, m = rk[t * HCB + cc], z = t < CTXL - 1 ? rk[(t + 1) * HCB + cc] : 0.f;
            cv[k] = cw[0 * 768 + ch] * a + cw[1 * 768 + ch] * m + cw[2 * 768 + ch] * z + cbias[ch]; }
        u[i] = cv[0] * cv[1];
        og[i] = cv[2] * siluf_(raw[(3 * CTXL + t) * HCB + cc]); }
    __syncthreads();
    { const int cc = tid % HCB, tg = tid / HCB, t0 = WT * tg; float acc[WT], w[WT];
#pragma unroll
        for (int j = 0; j < WT; ++j) { acc[j] = 0.f; w[j] = hcm[(t0 + j + CTXL) * HCB + cc]; }
#pragma unroll 8
        for (int s = 0; s < CTXL; ++s) { const float us = u[s * HCB + cc];
#pragma unroll
            for (int j = 0; j < WT; ++j) acc[j] += us * w[j];
#pragma unroll
            for (int j = WT - 1; j > 0; --j) w[j] = w[j - 1];
            w[0] = hcm[(t0 - s - 1 + CTXL) * HCB + cc]; }
        const float dsk = p.in[I_HD][(size_t)l * WG + c0 + cc];
#pragma unroll
        for (int j = 0; j < WT; ++j) { const int t = t0 + j; ob[t * HCB + cc] = f2bf(og[t * HCB + cc] * (acc[j] + u[t * HCB + cc] * dsk)); } }
    __syncthreads();
    for (int i = tid; i < CTXL * 2; i += NT) { const int t = i >> 1, hh = i & 1; *(u32x4*)(Y + (rb + t) * 1024 + YH + c0 + 8 * hh) = *(const u32x4*)(ob + t * HCB + 8 * hh); }
}

__device__ __forceinline__ void attn_task(const Params& p, int l, int b, int kvh, int qt, bool ctxq, char* smem) {
    const int tid = otid(), lane = tid & 63, wave = tid >> 6, r = lane & 15, q = lane >> 4;
    const bf16* P = (const bf16*)(p.ws + WS_P); bf16* Y = (bf16*)(p.ws + WS_HNY); const cpx* ROPE = (const cpx*)(p.ws + WS_ROPE);
    bf16* Qs = (bf16*)smem;
    bf16* Ks = Qs + 256 * LS;
    bf16* Vt = Ks + 64 * LS;
    bf16* Ps = Vt + 64 * LS;
    const size_t rq0 = (size_t)b * TOK + (ctxq ? 0 : CTXL) + qt * 128;
    __syncthreads();
#pragma unroll
    for (int it = 0; it < 2; ++it) {
        const int idx = tid + NT * it, row = idx >> 2, cpair = idx & 3, g = row >> 7, t = row & 127;
        const bf16* src = P + (rq0 + t) * NP + PD + (kvh * 2 + g) * 64;
        float lo[8], hi[8]; unpack8(*(const u32x4*)(src + cpair * 8), lo); unpack8(*(const u32x4*)(src + 32 + cpair * 8), hi);
        float a[8], c2[8];
#pragma unroll
        for (int j = 0; j < 8; ++j) { float cs = 1.f, sn = 0.f; if (!ctxq) { const cpx cv = ROPE[(size_t)(qt * 128 + t) * 32 + cpair * 8 + j]; cs = cv.x; sn = cv.y; }
            a[j] = (lo[j] * cs - hi[j] * sn) * 0.125f; c2[j] = (hi[j] * cs + lo[j] * sn) * 0.125f; }
        *(u32x4*)(Qs + row * LS + cpair * 8) = pack8(a); *(u32x4*)(Qs + row * LS + 32 + cpair * 8) = pack8(c2);
    }
    const int lt0 = ctxq ? 0 : (2 * qt - 2 > 0 ? 2 * qt - 2 : 0), lt1 = ctxq ? -1 : (2 * qt + 3 < SEQ / 64 - 1 ? 2 * qt + 3 : SEQ / 64 - 1);
    const int nloc = lt1 - lt0 + 1, ntiles = nloc + NCC;
    float m[2][4], lsum[2][4]; f32x4 O[2][4];
#pragma unroll
    for (int ms = 0; ms < 2; ++ms)
#pragma unroll
        for (int i = 0; i < 4; ++i) { m[ms][i] = -INFINITY; lsum[ms][i] = 0.f; O[ms][i] = (f32x4){0.f, 0.f, 0.f, 0.f}; }
    const int g = wave >> 2, tq0 = (wave & 3) * 32;
    bf16* Pw = Ps + wave * 32 * LS;
    u32x4 klo = {0u, 0u, 0u, 0u}, khi = klo, vq = klo; f32x4 rp[4] = {(f32x4){1.f, 0.f, 1.f, 0.f}, (f32x4){1.f, 0.f, 1.f, 0.f}, (f32x4){1.f, 0.f, 1.f, 0.f}, (f32x4){1.f, 0.f, 1.f, 0.f}};
    const int ks_ = tid >> 2, kcp = tid & 3, vs_ = tid >> 3, vc8 = tid & 7;
#define ATT_PREFETCH(TI) do { const bool loc_ = (TI) < nloc; const int kt_ = loc_ ? lt0 + (TI) : (TI) - nloc; const size_t rk_ = (size_t)b * TOK + (loc_ ? CTXL : 0) + kt_ * 64; \
        if (tid < 256) { const bf16* src_ = P + (rk_ + ks_) * NP + PD + 256 + kvh * 64; klo = *(const u32x4*)(src_ + kcp * 8); khi = *(const u32x4*)(src_ + 32 + kcp * 8); \
            if (loc_) { const f32x4* rr_ = (const f32x4*)(ROPE + (size_t)(kt_ * 64 + ks_) * 32 + kcp * 8); rp[0] = rr_[0]; rp[1] = rr_[1]; rp[2] = rr_[2]; rp[3] = rr_[3]; } \
            else { rp[0] = rp[1] = rp[2] = rp[3] = (f32x4){1.f, 0.f, 1.f, 0.f}; } } \
        vq = *(const u32x4*)(P + (rk_ + vs_) * NP + PD + 384 + kvh * 64 + vc8 * 8); } while (0)
    ATT_PREFETCH(0);
    for (int ti = 0; ti < ntiles; ++ti) {
        const bool local = ti < nloc; const int kt = local ? lt0 + ti : ti - nloc;
        __syncthreads();
        if (tid < 256) { float lo[8], hi[8]; unpack8(klo, lo); unpack8(khi, hi);
            const float cs[8] = {rp[0].x, rp[0].z, rp[1].x, rp[1].z, rp[2].x, rp[2].z, rp[3].x, rp[3].z}, sn[8] = {rp[0].y, rp[0].w, rp[1].y, rp[1].w, rp[2].y, rp[2].w, rp[3].y, rp[3].w};
            float a[8], c2[8];
#pragma unroll
            for (int j = 0; j < 8; ++j) { a[j] = lo[j] * cs[j] - hi[j] * sn[j]; c2[j] = hi[j] * cs[j] + lo[j] * sn[j]; }
            *(u32x4*)(Ks + ks_ * LS + kcp * 8) = pack8(a); *(u32x4*)(Ks + ks_ * LS + 32 + kcp * 8) = pack8(c2); }
        { const unsigned w[4] = {vq.x, vq.y, vq.z, vq.w};
#pragma unroll
            for (int j = 0; j < 4; ++j) { Vt[(vc8 * 8 + 2 * j) * LS + vs_] = (bf16)(w[j] & 0xffffu); Vt[(vc8 * 8 + 2 * j + 1) * LS + vs_] = (bf16)(w[j] >> 16); } }
        __syncthreads();
        if (ti + 1 < ntiles) ATT_PREFETCH(ti + 1);
#pragma unroll
        for (int ms = 0; ms < 2; ++ms) {
            const int qlo = qt * 128 + tq0 + 16 * ms, klo_ = kt * 64;
            if (local && (klo_ > qlo + 15 + 128 || klo_ + 63 < qlo - 128)) continue;
            f32x4 S[4] = {(f32x4){0.f, 0.f, 0.f, 0.f}, (f32x4){0.f, 0.f, 0.f, 0.f}, (f32x4){0.f, 0.f, 0.f, 0.f}, (f32x4){0.f, 0.f, 0.f, 0.f}};
            mma_nt<4, 2>(Qs, LS, g * 128 + tq0 + 16 * ms, Ks, LS, 0, S, lane);
            float rmax[4];
#pragma unroll
            for (int i = 0; i < 4; ++i) { const int qpos = qlo + 4 * q + i; float mx = -INFINITY;
#pragma unroll
                for (int nt = 0; nt < 4; ++nt) { if (local) { const int kpos = kt * 64 + nt * 16 + r; const int d = kpos - qpos; if (d > 128 || d < -128) S[nt][i] = -INFINITY; } mx = fmaxf(mx, S[nt][i]); }
                rmax[i] = row16_max(mx); }
#pragma unroll
            for (int i = 0; i < 4; ++i) { const float mn = fmaxf(m[ms][i], rmax[i]); const float msafe = mn == -INFINITY ? 0.f : mn; const float alpha = __expf(m[ms][i] - msafe); float sm = 0.f;
#pragma unroll
                for (int nt = 0; nt < 4; ++nt) { const float pv = __expf(S[nt][i] - msafe); sm += pv; Pw[(16 * ms + 4 * q + i) * LS + nt * 16 + r] = f2bf(pv); O[ms][nt][i] *= alpha; }
                sm = row16_sum(sm);
                lsum[ms][i] = lsum[ms][i] * alpha + sm; m[ms][i] = mn; }
            WAVE_SYNC();
            mma_nt<4, 2>(Pw, LS, 16 * ms, Vt, LS, 0, O[ms], lane);
        }
    }
#undef ATT_PREFETCH
    const float sink = p.in[I_SINK][(size_t)l * NH + kvh * 2 + g];
    WAVE_SYNC();
#pragma unroll
    for (int ms = 0; ms < 2; ++ms)
#pragma unroll
        for (int i = 0; i < 4; ++i) { const float den = lsum[ms][i] + __expf(sink - m[ms][i]); const float inv = frcp_(den);
#pragma unroll
            for (int nt = 0; nt < 4; ++nt) Pw[(16 * ms + 4 * q + i) * LS + nt * 16 + r] = f2bf(O[ms][nt][i] * inv); }
    WAVE_SYNC();
#pragma unroll
    for (int hh = 0; hh < 4; ++hh) { const int t = lane >> 1, ck = (lane & 1) * 4 + hh;
        float fo[8], fg[8]; unpack8(*(const u32x4*)(Pw + t * LS + ck * 8), fo);
        unpack8(*(const u32x4*)(P + (rq0 + tq0 + t) * NP + PD + 512 + (kvh * 2 + g) * 64 + ck * 8), fg);
#pragma unroll
        for (int j = 0; j < 8; ++j) fo[j] *= siluf_(fg[j]);
        *(u32x4*)(Y + (rq0 + tq0 + t) * 1024 + YD + (kvh * 2 + g) * 64 + ck * 8) = pack8(fo); }
}

#ifdef EMU
__device__ __forceinline__ int olane(int lane) { return lane; }
#else
__device__ __forceinline__ int olane(int lane) { asm volatile("" : "+v"(lane)); return lane; }
#endif
__device__ __forceinline__ void load_nat_tile(const bf16* P, int row0, int col0, bf16* tile, int lane) {
    u32x4 v[8];
#pragma unroll
    for (int i = 0; i < 8; ++i) v[i] = *(const u32x4*)(P + (size_t)(row0 + (lane >> 3) + 8 * i) * NP + col0 + (lane & 7) * 8);
#pragma unroll
    for (int i = 0; i < 8; ++i) *(u32x4*)(tile + swz((lane >> 3) + 8 * i, lane & 7)) = v[i];
}
__device__ __forceinline__ bf16x8 frag_tr(const bf16* tile, int c0, int k0, int lane) {
    const int c = c0 + (lane & 15), kb = k0 + 8 * (lane >> 4); unsigned w[4];
#pragma unroll
    for (int j = 0; j < 4; ++j) w[j] = (unsigned)tile[swz(kb + 2 * j, c >> 3) + (c & 7)] | ((unsigned)tile[swz(kb + 2 * j + 1, c >> 3) + (c & 7)] << 16);
    u32x4 o; o.x = w[0]; o.y = w[1]; o.z = w[2]; o.w = w[3]; return as_frag(o);
}
template <int DIR>
__device__ __forceinline__ void gla_r_frags(const float* Grow0, int lane, bf16x8 (&af)[4]) {
    const int r = lane & 15, q4 = lane >> 4;
#pragma unroll
    for (int mt = 0; mt < 4; ++mt) { u32x4 o = {0u, 0u, 0u, 0u};
        if (q4 < 2) o = *(const u32x4*)((const bf16*)(Grow0 + (size_t)(16 * mt + r) * NGS + 16) + DIR * 16 + 8 * q4);
        af[mt] = as_frag(o); }
}
template <int DIR>
__device__ __forceinline__ float gla_b_col(const Params& p, int l, int h, const bf16x8 (&af)[4], int nt, int lane_, float (&x)[4][4]) {
    const int lane = olane(lane_), r = lane & 15, q4 = lane >> 4, d = h * 64 + 16 * nt + r;
    u32x4 o = {0u, 0u, 0u, 0u};
    if (q4 < 2) { const float* wa = p.in[I_GWA] + ((size_t)(l * 2 + DIR) * 16 + 8 * q4) * WG + d;
        o.x = pk2(wa[0], wa[WG]); o.y = pk2(wa[2 * WG], wa[3 * WG]); o.z = pk2(wa[4 * WG], wa[5 * WG]); o.w = pk2(wa[6 * WG], wa[7 * WG]); }
    const bf16x8 bfr = as_frag(o); const float bias = p.in[I_GBA][(size_t)(l * 2 + DIR) * WG + d];
#pragma unroll
    for (int mt = 0; mt < 4; ++mt) { f32x4 c = {bias, bias, bias, bias}; c = MFMA16(af[mt], bfr, c);
#pragma unroll
        for (int i = 0; i < 4; ++i) x[mt][i] = logsig_fast(c[i]) * (1.0f / 16.0f); }
    float carry = 0.f;
#pragma unroll
    for (int k = 0; k < 4; ++k) { const int mt = DIR == 0 ? k : 3 - k; float* y = x[mt];
        if (DIR == 0) { y[1] += y[0]; y[2] += y[1]; y[3] += y[2]; } else { y[2] += y[3]; y[1] += y[2]; y[0] += y[1]; }
        const float s4 = DIR == 0 ? y[3] : y[0];
        const float t1 = DIR == 0 ? __shfl_up(s4, 16) : __shfl_down(s4, 16), t2 = DIR == 0 ? __shfl_up(s4, 32) : __shfl_down(s4, 32), t3 = DIR == 0 ? __shfl_up(s4, 48) : __shfl_down(s4, 48);
        const int qq = DIR == 0 ? q4 : 3 - q4;
        const float e = (qq >= 1 ? t1 : 0.f) + (qq >= 2 ? t2 : 0.f) + (qq >= 3 ? t3 : 0.f);
        const float tot = __shfl(e + s4, DIR == 0 ? r + 48 : r);
#pragma unroll
        for (int i = 0; i < 4; ++i) y[i] += carry + e;
        carry += tot; }
    return carry;
}

template <int MIXER, int DIR>
__device__ __forceinline__ void chunkst_dir(const Params& p, int l, int b, int h, int cid, const float* Grow0, const unsigned (&kk)[32], const bf16* Vt, bf16* Kt, const float* wvs, float* bendl, int lane_) {
    const int lane = olane(lane_), r = lane & 15, q4 = lane >> 4;
    if constexpr (MIXER == 0) {
        float nacc = 0.f;
#pragma unroll
        for (int c = 0; c < 8; ++c) { float f[8];
#pragma unroll
            for (int j = 0; j < 8; ++j) { const int s = 8 * c + j; const float kv = (s & 1) ? bitsf(kk[s >> 1] & 0xffff0000u) : bitsf(kk[s >> 1] << 16);
                f[j] = kv * 0.125f * wvs[DIR * 64 + s]; nacc += f[j]; }
            *(u32x4*)(Kt + swz(lane, c)) = pack8(f); }
        ((float*)(p.ws + WS_NV))[ch_index(DIR, b, h, cid) * 64 + lane] = nacc;
    } else {
        const bf16* P = (const bf16*)(p.ws + WS_P); const int kcol = PG + 256 + h * 64; const int r0 = b * TOK + cid * 64;
        bf16x8 af[4]; gla_r_frags<DIR>(Grow0, lane, af);
#pragma unroll 2
        for (int nt = 0; nt < 4; ++nt) { const int d = 16 * nt + r; float x[4][4];
            const float bend = gla_b_col<DIR>(p, l, h, af, nt, lane, x);
            if (q4 == 0) { ((float*)(p.ws + WS_BE))[ch_index(DIR, b, h, cid) * 64 + d] = bend; bendl[d] = __expf(fmaxf(bend, -80.0f)); }
#pragma unroll
            for (int mt = 0; mt < 4; ++mt)
#pragma unroll
                for (int i = 0; i < 4; ++i) { const int s = 16 * mt + 4 * q4 + i; const float kv = bf2f(P[(size_t)(r0 + s) * NP + kcol + d]); const float bc = fmaxf(x[mt][i], -80.0f);
                    Kt[swz(d, s >> 3) + (s & 7)] = f2bf(kv * __expf(-bc));
                    ((bf16*)(p.ws + WS_EQ))[((size_t)DIR * T + r0 + s) * WG + h * 64 + d] = f2bf(__expf(bc)); } }
    }
    WAVE_SYNC();
    bf16x8 vf[4][2];
#pragma unroll
    for (int ne = 0; ne < 4; ++ne)
#pragma unroll
        for (int ks = 0; ks < 2; ++ks) vf[ne][ks] = *(const bf16x8*)(Vt + swz(16 * ne + r, ks * 4 + q4));
    bf16* dst = (bf16*)(p.ws + WS_ST) + st_index(MIXER, DIR, b, h, cid) * 4096;
#pragma unroll
    for (int me = 0; me < 4; ++me) {
        f32x4 acc[4] = {(f32x4){0.f, 0.f, 0.f, 0.f}, (f32x4){0.f, 0.f, 0.f, 0.f}, (f32x4){0.f, 0.f, 0.f, 0.f}, (f32x4){0.f, 0.f, 0.f, 0.f}};
#pragma unroll
        for (int ks = 0; ks < 2; ++ks) { const bf16x8 a = *(const bf16x8*)(Kt + swz(16 * me + r, ks * 4 + q4));
#pragma unroll
            for (int ne = 0; ne < 4; ++ne) acc[ne] = MFMA16(a, vf[ne][ks], acc[ne]); }
        f32x4 sc4 = {1.f, 1.f, 1.f, 1.f}; if constexpr (MIXER == 1) sc4 = *(const f32x4*)(bendl + 16 * me + 4 * q4);
#pragma unroll
        for (int ne = 0; ne < 4; ++ne) { const f32x4 v = acc[ne] * sc4; u32x2 o; o.x = pk2(v[0], v[1]); o.y = pk2(v[2], v[3]); *(u32x2*)(dst + (16 * ne + r) * 64 + 16 * me + 4 * q4) = o; }
    }
    WAVE_SYNC();
}
template <int MIXER>
__device__ __forceinline__ void chunkst_w(const Params& p, int l, int b, int h, int cid, char* wl, int lane) {
    const bf16* P = (const bf16*)(p.ws + WS_P); const float* G = (const float*)(p.ws + WS_G);
    const int r0 = b * TOK + cid * 64, r = lane & 15, q4 = lane >> 4;
    bf16* Kt = (bf16*)wl;
    bf16* Vt = Kt + 4096;
    float* wvs = (float*)(Vt + 4096);
    float* bendl = wvs + 128;
    const int kcol = (MIXER == 0 ? PA : PG) + 256 + h * 64, vcol = (MIXER == 0 ? PA : PG) + 512 + h * 64;
    const float* Grow0 = G + (size_t)r0 * NGS;
    { bf16* Nn = Kt;
        load_nat_tile(P, r0, vcol, Nn, lane);
        WAVE_SYNC();
#pragma unroll
        for (int c = 0; c < 8; ++c) { unsigned w[4];
#pragma unroll
            for (int j = 0; j < 4; ++j) w[j] = (unsigned)Nn[swz(8 * c + 2 * j, lane >> 3) + (lane & 7)] | ((unsigned)Nn[swz(8 * c + 2 * j + 1, lane >> 3) + (lane & 7)] << 16);
            u32x4 o; o.x = w[0]; o.y = w[1]; o.z = w[2]; o.w = w[3]; *(u32x4*)(Vt + swz(lane, c)) = o; }
        WAVE_SYNC();
        load_nat_tile(P, r0, kcol, Nn, lane);
        WAVE_SYNC(); }
    unsigned kk[32];
    { const bf16* Nn = Kt;
#pragma unroll
        for (int i = 0; i < 32; ++i) kk[i] = (unsigned)Nn[swz(2 * i, lane >> 3) + (lane & 7)] | ((unsigned)Nn[swz(2 * i + 1, lane >> 3) + (lane & 7)] << 16); }
    WAVE_SYNC();
    if constexpr (MIXER == 0) {
        const float* g = Grow0 + (size_t)lane * NGS; const float* gb = p.in[I_MGB] + (size_t)l * 16;
        const float i_f = g[h] + gb[h], f_f = g[4 + h] + gb[4 + h], i_b = g[8 + h] + gb[8 + h], f_b = g[12 + h] + gb[12 + h];
        const float lf = logsigf_(f_f), lb = logsigf_(f_b);
        const float bF = wave_prefix_sum(lf, lane), totF = __shfl(bF, 63);
        const float gF = totF - bF + i_f, mF = wave_max(gF);
        const float totB = wave_sum(lb), preB = wave_prefix_sum(lb, lane), bB = totB - preB + lb;
        const float gB = totB - bB + i_b, mB = wave_max(gB);
        wvs[lane] = __expf(gF - mF); wvs[64 + lane] = __expf(gB - mB);
        if (lane == 0) { float* SC = (float*)(p.ws + WS_SC);
            SC[ch_index(0, b, h, cid) * 4 + 0] = totF; SC[ch_index(0, b, h, cid) * 4 + 1] = mF;
            SC[ch_index(1, b, h, cid) * 4 + 0] = totB; SC[ch_index(1, b, h, cid) * 4 + 1] = mB; }
    }
    WAVE_SYNC();
    chunkst_dir<MIXER, 0>(p, l, b, h, cid, Grow0, kk, Vt, Kt, wvs, bendl, lane);
    chunkst_dir<MIXER, 1>(p, l, b, h, cid, Grow0, kk, Vt, Kt, wvs, bendl, lane);
}

template <int DIR>
__device__ __forceinline__ void chunkst_gla(const Params& p, int l, int b, int h, int cid, char* wl, int lane_) {
    const bf16* P = (const bf16*)(p.ws + WS_P);
    const int lane = olane(lane_), r0 = b * TOK + cid * 64, r = lane & 15, q4 = lane >> 4;
    bf16* Kt = (bf16*)wl;
    bf16* An = Kt + 4096;
    float* bendl = (float*)(An + 4096);
    const int kcol = PG + 256 + h * 64, vcol = PG + 512 + h * 64;
    const float* Grow0 = (const float*)(p.ws + WS_G) + (size_t)r0 * NGS;
    load_nat_tile(P, r0, vcol, An, lane);
    WAVE_SYNC();
    bf16x8 vf[4][2];
#pragma unroll
    for (int ne = 0; ne < 4; ++ne)
#pragma unroll
        for (int ks = 0; ks < 2; ++ks) vf[ne][ks] = frag_tr(An, 16 * ne, 32 * ks, lane);
    WAVE_SYNC();
    load_nat_tile(P, r0, kcol, An, lane);
    WAVE_SYNC();
    bf16x8 af[4]; gla_r_frags<DIR>(Grow0, lane, af);
#pragma unroll 2
    for (int nt = 0; nt < 4; ++nt) { const int d = 16 * nt + r; float x[4][4];
        const float bend = gla_b_col<DIR>(p, l, h, af, nt, lane, x);
        if (q4 == 0) { ((float*)(p.ws + WS_BE))[ch_index(DIR, b, h, cid) * 64 + d] = bend; bendl[d] = __expf(fmaxf(bend, -80.0f)); }
#pragma unroll
        for (int mt = 0; mt < 4; ++mt)
#pragma unroll
            for (int i = 0; i < 4; ++i) { const int s = 16 * mt + 4 * q4 + i; bf16* ke = An + swz(s, d >> 3) + (d & 7); const float kv = bf2f(*ke); const float bc = fmaxf(x[mt][i], -80.0f);
                Kt[swz(d, s >> 3) + (s & 7)] = f2bf(kv * __expf(-bc));
                *ke = f2bf(__expf(bc)); } }
    WAVE_SYNC();
    { bf16* EQg = (bf16*)(p.ws + WS_EQ) + ((size_t)DIR * T + r0) * WG + h * 64;
#pragma unroll
        for (int i = 0; i < 8; ++i) { const int s = (lane >> 3) + 8 * i, ck = lane & 7; *(u32x4*)(EQg + (size_t)s * WG + ck * 8) = *(const u32x4*)(An + swz(s, ck)); } }
    bf16* dst = (bf16*)(p.ws + WS_ST) + st_index(1, DIR, b, h, cid) * 4096;
#pragma unroll
    for (int me = 0; me < 4; ++me) {
        f32x4 acc[4] = {(f32x4){0.f, 0.f, 0.f, 0.f}, (f32x4){0.f, 0.f, 0.f, 0.f}, (f32x4){0.f, 0.f, 0.f, 0.f}, (f32x4){0.f, 0.f, 0.f, 0.f}};
#pragma unroll
        for (int ks = 0; ks < 2; ++ks) { const bf16x8 a = *(const bf16x8*)(Kt + swz(16 * me + r, ks * 4 + q4));
#pragma unroll
            for (int ne = 0; ne < 4; ++ne) acc[ne] = MFMA16(a, vf[ne][ks], acc[ne]); }
        const f32x4 sc4 = *(const f32x4*)(bendl + 16 * me + 4 * q4);
#pragma unroll
        for (int ne = 0; ne < 4; ++ne) { const f32x4 v = acc[ne] * sc4; u32x2 o; o.x = pk2(v[0], v[1]); o.y = pk2(v[2], v[3]); *(u32x2*)(dst + (16 * ne + r) * 64 + 16 * me + 4 * q4) = o; }
    }
    WAVE_SYNC();
}

template <int MIXER, int DIR>
__device__ __forceinline__ void chunkout_prep(const Params& p, int l, int b, int h, int cid, const float* Grow0, int r0, int pbase, const bf16* EQ, float* gar, int lane_) {
    const int lane = olane(lane_);
    if constexpr (MIXER == 0) {
        const bf16* P = (const bf16*)(p.ws + WS_P);
        const float* g = Grow0 + (size_t)lane * NGS; const float* gb = p.in[I_MGB] + (size_t)l * 16;
        const float ig = g[DIR * 8 + h] + gb[DIR * 8 + h], fg = g[DIR * 8 + 4 + h] + gb[DIR * 8 + 4 + h];
        const float mprev = ((const float*)(p.ws + WS_SC))[ch_index(DIR, b, h, cid) * 4 + 2];
        const float lf = logsigf_(fg); float bb;
        if (DIR == 0) bb = wave_prefix_sum(lf, lane); else { const float tt = wave_sum(lf), pre = wave_prefix_sum(lf, lane); bb = tt - pre + lf; }
        const float a = ig - bb; const float pm = DIR == 0 ? wave_prefix_max(a, lane) : wave_suffix_max(a, lane);
        const float mt_ = fmaxf(bb + mprev, bb + pm);
        float* ga = gar + DIR * 320;
        ga[lane] = bb - mt_; ga[64 + lane] = a; ga[128 + lane] = __expf(bb + mprev - mt_); ga[192 + lane] = __expf(-mt_);
        float* nvl = gar + 640 + DIR * 64;
        nvl[lane] = ((const float*)(p.ws + WS_NV))[ch_index(DIR, b, h, cid) * 64 + lane];
        WAVE_SYNC();
        float dq = 0.f;
#pragma unroll
        for (int c = 0; c < 8; ++c) { float f[8]; unpack8(*(const u32x4*)(P + (size_t)(r0 + lane) * NP + pbase + c * 8), f);
            const f32x4 n0 = *(const f32x4*)(nvl + c * 8), n1 = *(const f32x4*)(nvl + c * 8 + 4);
            dq += f[0] * n0.x + f[1] * n0.y + f[2] * n0.z + f[3] * n0.w + f[4] * n1.x + f[5] * n1.y + f[6] * n1.z + f[7] * n1.w; }
        ga[256 + lane] = dq;
    }
}
template <int MIXER, int DIR, int NS>
__device__ __forceinline__ void chunkout_dir(const Params& p, int b, int h, int cid, int r0, int pbase, int th, const bf16x8 (&vtf)[4][2], const bf16* VtL, const bf16* EQ, bf16* SB, const float* gar, float* rsm, f32x4 (&htot)[NS][4], int lane_) {
    const bf16* P = (const bf16*)(p.ws + WS_P); const bf16* ST = (const bf16*)(p.ws + WS_ST);
    const int lane = olane(lane_), r = lane & 15, q4 = lane >> 4;
    const bf16* E = EQ + ((size_t)DIR * T + r0) * WG + h * 64;
    const float* ga = gar + DIR * 320;
    bf16x8 kf[4][2], ctf[4][2];
#pragma unroll
    for (int n = 0; n < 4; ++n)
#pragma unroll
        for (int ks = 0; ks < 2; ++ks) { if constexpr (MIXER == 0) kf[n][ks] = vtf[n][ks];
            else kf[n][ks] = *(const bf16x8*)(P + (size_t)(r0 + 16 * n + r) * NP + pbase + 256 + ks * 32 + q4 * 8);
            ctf[n][ks] = *(const bf16x8*)(ST + st_index(MIXER, DIR, b, h, cid) * 4096 + (16 * n + r) * 64 + ks * 32 + q4 * 8);
            if constexpr (MIXER == 1) { float fe[8], fk[8]; unpack8(*(const u32x4*)(E + (size_t)(16 * n + r) * WG + ks * 32 + q4 * 8), fe); unpack8(as_u4(kf[n][ks]), fk);
#pragma unroll
                for (int j = 0; j < 8; ++j) fk[j] = fk[j] * frcp_(fe[j]);
                kf[n][ks] = as_frag(pack8(fk)); } }
#pragma unroll
    for (int ms = 0; ms < NS; ++ms) { const int mt = NS * th + ms;
        bf16x8 qf[2];
#pragma unroll
        for (int ks = 0; ks < 2; ++ks) { qf[ks] = *(const bf16x8*)(P + (size_t)(r0 + 16 * mt + r) * NP + pbase + ks * 32 + q4 * 8);
            if constexpr (MIXER == 1) { float fe[8], fq[8]; unpack8(*(const u32x4*)(E + (size_t)(16 * mt + r) * WG + ks * 32 + q4 * 8), fe); unpack8(as_u4(qf[ks]), fq);
#pragma unroll
                for (int j = 0; j < 8; ++j) fq[j] *= 0.125f * fe[j];
                qf[ks] = as_frag(pack8(fq)); } }
        f32x4 S[4] = {(f32x4){0.f, 0.f, 0.f, 0.f}, (f32x4){0.f, 0.f, 0.f, 0.f}, (f32x4){0.f, 0.f, 0.f, 0.f}, (f32x4){0.f, 0.f, 0.f, 0.f}};
#pragma unroll
        for (int ks = 0; ks < 2; ++ks)
#pragma unroll
            for (int n = 0; n < 4; ++n) S[n] = MFMA16(qf[ks], kf[n][ks], S[n]);
#pragma unroll
        for (int i = 0; i < 4; ++i) { const int t = 16 * mt + 4 * q4 + i; float sm = 0.f;
#pragma unroll
            for (int n = 0; n < 4; ++n) { const int s = 16 * n + r; const bool ok = DIR == 0 ? (s <= t) : (s >= t); float v = 0.f;
                if (ok) { if constexpr (MIXER == 0) v = S[n][i] * 0.125f * __expf(ga[t] + ga[64 + s]); else v = S[n][i]; }
                SB[swz(4 * q4 + i, s >> 3) + (s & 7)] = f2bf(v); sm += v; }
            if constexpr (MIXER == 0) { sm = row16_sum(sm); if (r == 0) rsm[4 * q4 + i] = sm; } }
        WAVE_SYNC();
        const bf16x8 sm0 = *(const bf16x8*)(SB + swz(r, q4)), sm1 = *(const bf16x8*)(SB + swz(r, 4 + q4));
        float wi = 1.f, inv = 1.f;
        if constexpr (MIXER == 0) { const int tt = 16 * mt + r; wi = ga[128 + tt]; const float den = wi * ga[256 + tt] + rsm[r]; inv = frcp_(fmaxf(fabsf(den), ga[192 + tt])); }
#pragma unroll
        for (int me = 0; me < 4; ++me) { f32x4 a1 = {0.f, 0.f, 0.f, 0.f}, a2 = {0.f, 0.f, 0.f, 0.f};
            a1 = MFMA16(*(const bf16x8*)(VtL + swz(16 * me + r, q4)), sm0, a1); a1 = MFMA16(*(const bf16x8*)(VtL + swz(16 * me + r, 4 + q4)), sm1, a1);
            a2 = MFMA16(ctf[me][0], qf[0], a2); a2 = MFMA16(ctf[me][1], qf[1], a2);
            if constexpr (MIXER == 0) htot[ms][me] += (a1 + a2 * wi) * inv; else htot[ms][me] += a1 + a2; }
        WAVE_SYNC();
    }
}
__device__ __forceinline__ void co_build_vt(const bf16* P, int r0, int vcol, bf16* VtL, int lane) {
    bf16* Nn = VtL + 4096;
#pragma unroll
    for (int hh = 0; hh < 2; ++hh) {
        u32x4 v[4];
#pragma unroll
        for (int i = 0; i < 4; ++i) v[i] = *(const u32x4*)(P + (size_t)(r0 + 32 * hh + (lane >> 3) + 8 * i) * NP + vcol + (lane & 7) * 8);
#pragma unroll
        for (int i = 0; i < 4; ++i) *(u32x4*)(Nn + swz((lane >> 3) + 8 * i, lane & 7)) = v[i];
        WAVE_SYNC();
#pragma unroll
        for (int c = 0; c < 4; ++c) { unsigned w[4];
#pragma unroll
            for (int j = 0; j < 4; ++j) w[j] = (unsigned)Nn[swz(8 * c + 2 * j, lane >> 3) + (lane & 7)] | ((unsigned)Nn[swz(8 * c + 2 * j + 1, lane >> 3) + (lane & 7)] << 16);
            u32x4 o; o.x = w[0]; o.y = w[1]; o.z = w[2]; o.w = w[3]; *(u32x4*)(VtL + swz(lane, 4 * hh + c)) = o; }
        WAVE_SYNC(); }
}
template <int MIXER, int NS>
__device__ __forceinline__ void co_finalize(const Params& p, int l, int h, int r0, int pbase, int mt0, f32x4 (&htot)[NS][4], int lane_) {
    const bf16* P = (const bf16*)(p.ws + WS_P); bf16* Y = (bf16*)(p.ws + WS_HNY);
    const float* ngp = p.in[MIXER == 0 ? I_MNG : I_GNG] + (size_t)l * WG + h * 64;
    const int lz = olane(lane_), r = lz & 15, q4 = lz >> 4;
    u32x2 gq[NS][4], oq[NS][4];
#pragma unroll
    for (int ms = 0; ms < NS; ++ms)
#pragma unroll
        for (int me = 0; me < 4; ++me) { const size_t off = (size_t)(r0 + 16 * (mt0 + ms) + r) * NP + pbase + 16 * me + 4 * q4;
            gq[ms][me] = *(const u32x2*)(P + off + (MIXER == 0 ? 1024 : 768)); if constexpr (MIXER == 0) oq[ms][me] = *(const u32x2*)(P + off + 768); else oq[ms][me] = (u32x2){0u, 0u}; }
#pragma unroll
    for (int ms = 0; ms < NS; ++ms) { const int mt = mt0 + ms; float ss = 0.f; float gv[4][4];
#pragma unroll
        for (int me = 0; me < 4; ++me) {
            gv[me][0] = bitsf(gq[ms][me].x << 16); gv[me][1] = bitsf(gq[ms][me].x & 0xffff0000u); gv[me][2] = bitsf(gq[ms][me].y << 16); gv[me][3] = bitsf(gq[ms][me].y & 0xffff0000u);
            if constexpr (MIXER == 0) { htot[ms][me][0] *= sigmoidf_(bitsf(oq[ms][me].x << 16)); htot[ms][me][1] *= sigmoidf_(bitsf(oq[ms][me].x & 0xffff0000u)); htot[ms][me][2] *= sigmoidf_(bitsf(oq[ms][me].y << 16)); htot[ms][me][3] *= sigmoidf_(bitsf(oq[ms][me].y & 0xffff0000u)); }
            ss += htot[ms][me][0] * htot[ms][me][0] + htot[ms][me][1] * htot[ms][me][1] + htot[ms][me][2] * htot[ms][me][2] + htot[ms][me][3] * htot[ms][me][3]; }
        ss = xrow_sum(ss);
        const float rstd = rsqrtf(ss * (1.0f / 64.0f) + EPS);
#pragma unroll
        for (int me = 0; me < 4; ++me) { const int e = 16 * me + 4 * q4; const f32x4 n4 = *(const f32x4*)(ngp + e);
            u32x2 o; o.x = pk2(htot[ms][me][0] * rstd * n4.x * siluf_(gv[me][0]), htot[ms][me][1] * rstd * n4.y * siluf_(gv[me][1]));
            o.y = pk2(htot[ms][me][2] * rstd * n4.z * siluf_(gv[me][2]), htot[ms][me][3] * rstd * n4.w * siluf_(gv[me][3]));
            *(u32x2*)(Y + (size_t)(r0 + 16 * mt + r) * 1024 + (MIXER == 0 ? YA : YG) + h * 64 + e) = o; } }
}
template <int MIXER>
__device__ __forceinline__ void chunkout_w(const Params& p, int l, int b, int h, int cid, char* wl, int lane) {
    const bf16* P = (const bf16*)(p.ws + WS_P); const float* G = (const float*)(p.ws + WS_G);
    const int r0 = b * TOK + cid * 64;
    const int pbase = (MIXER == 0 ? PA : PG) + h * 64;
    bf16* SB = (bf16*)wl;
    float* rsm = (float*)(SB + 1024);
    float* gar = rsm + 16;
    const bf16* EQ = (const bf16*)(p.ws + WS_EQ);
    const float* Grow0 = G + (size_t)r0 * NGS;
    bf16* VtL = (bf16*)(gar + 768);
    bf16x8 vtf[4][2];
#pragma unroll
    for (int me = 0; me < 4; ++me)
#pragma unroll
        for (int ks = 0; ks < 2; ++ks) { if constexpr (MIXER == 0) vtf[me][ks] = *(const bf16x8*)(P + (size_t)(r0 + 16 * me + (lane & 15)) * NP + pbase + 256 + ks * 32 + (lane >> 4) * 8); else vtf[me][ks] = (bf16x8){0, 0, 0, 0, 0, 0, 0, 0}; }
    co_build_vt(P, r0, pbase + 512, VtL, lane);
    chunkout_prep<MIXER, 0>(p, l, b, h, cid, Grow0, r0, pbase, EQ, gar, lane);
    chunkout_prep<MIXER, 1>(p, l, b, h, cid, Grow0, r0, pbase, EQ, gar, lane);
    WAVE_SYNC();
    constexpr int NS = MIXER == 1 ? 2 : 1;
#pragma unroll 1
    for (int th = 0; th < 4 / NS; ++th) {
        f32x4 htot[NS][4];
#pragma unroll
        for (int a = 0; a < NS; ++a)
#pragma unroll
            for (int c = 0; c < 4; ++c) htot[a][c] = (f32x4){0.f, 0.f, 0.f, 0.f};
        chunkout_dir<MIXER, 0, NS>(p, b, h, cid, r0, pbase, th, vtf, VtL, EQ, SB, gar, rsm, htot, lane);
        chunkout_dir<MIXER, 1, NS>(p, b, h, cid, r0, pbase, th, vtf, VtL, EQ, SB, gar, rsm, htot, lane);
        co_finalize<MIXER, NS>(p, l, h, r0, pbase, NS * th, htot, lane);
    }
}
constexpr int CO_PART = 13376;
template <int MIXER, int DIR>
__device__ __forceinline__ void chunkout_piece(const Params& p, int l, int b, int h, int cid, int mt, char* wl, int lane) {
    const bf16* P = (const bf16*)(p.ws + WS_P); const float* G = (const float*)(p.ws + WS_G);
    const int r0 = b * TOK + cid * 64; const int pbase = (MIXER == 0 ? PA : PG) + h * 64;
    bf16* SB = (bf16*)wl; float* rsm = (float*)(SB + 1024); float* gar = rsm + 16; const bf16* EQ = (const bf16*)(p.ws + WS_EQ);
    const float* Grow0 = G + (size_t)r0 * NGS; bf16* VtL = (bf16*)(gar + 768);
    bf16x8 vtf[4][2];
#pragma unroll
    for (int me = 0; me < 4; ++me)
#pragma unroll
        for (int ks = 0; ks < 2; ++ks) { if constexpr (MIXER == 0) vtf[me][ks] = *(const bf16x8*)(P + (size_t)(r0 + 16 * me + (lane & 15)) * NP + pbase + 256 + ks * 32 + (lane >> 4) * 8); else vtf[me][ks] = (bf16x8){0, 0, 0, 0, 0, 0, 0, 0}; }
    co_build_vt(P, r0, pbase + 512, VtL, lane);
    chunkout_prep<MIXER, DIR>(p, l, b, h, cid, Grow0, r0, pbase, EQ, gar, lane);
    WAVE_SYNC();
    f32x4 htot[1][4] = {{(f32x4){0.f, 0.f, 0.f, 0.f}, (f32x4){0.f, 0.f, 0.f, 0.f}, (f32x4){0.f, 0.f, 0.f, 0.f}, (f32x4){0.f, 0.f, 0.f, 0.f}}};
    chunkout_dir<MIXER, DIR, 1>(p, b, h, cid, r0, pbase, mt, vtf, VtL, EQ, SB, gar, rsm, htot, lane);
    float* part = (float*)(wl + CO_PART);
#pragma unroll
    for (int me = 0; me < 4; ++me)
#pragma unroll
        for (int i = 0; i < 4; ++i) part[(me * 4 + i) * 64 + lane] = htot[0][me][i];
}
template <int MIXER>
__device__ __forceinline__ void chunkout_combine(const Params& p, int l, int b, int h, int cid, int mt, const char* smem, int lane) {
    const float* pa = (const float*)(smem + (2 * mt) * WLDS + CO_PART); const float* pb = (const float*)(smem + (2 * mt + 1) * WLDS + CO_PART);
    f32x4 htot[1][4];
#pragma unroll
    for (int me = 0; me < 4; ++me)
#pragma unroll
        for (int i = 0; i < 4; ++i) htot[0][me][i] = pa[(me * 4 + i) * 64 + lane] + pb[(me * 4 + i) * 64 + lane];
    co_finalize<MIXER, 1>(p, l, h, b * TOK + cid * 64, (MIXER == 0 ? PA : PG) + h * 64, mt, htot, lane);
}

template <bool OUT>
__device__ __forceinline__ void chunk_workers(const Params& p, int l, char* smem) {
    const int tid = otid(), lane = tid & 63, wave = __builtin_amdgcn_readfirstlane(tid >> 6);
    const int NW = (int)gridDim.x * 8, wi = wave * (int)gridDim.x + obid();
    const int c_lo = (OUT && l == DEPTH - 1) ? NCC : 0, npc = NCH - c_lo, half = NB * NH * npc;
    char* wl = smem + wave * WLDS;
    if (OUT) {
        const int cl = NCC, npl = NCH - NCC, halfl = NB * NH * npl;
#pragma unroll 1
        for (int t = wi; t < halfl; t += NW) { const int b = t / (NH * npl), h = (t / npl) % NH, cid = cl + t % npl;
            const Params q = relaunder(p); chunkout_w<1>(q, l, b, h, cid, wl, lane); }
        { const int used = halfl % NW;
#pragma unroll 1
            for (int t = (wi + NW - used) % NW; t < halfl; t += NW) { const int b = t / (NH * npl), h = (t / npl) % NH, cid = cl + t % npl;
                const Params q = relaunder(p); chunkout_w<0>(q, l, b, h, cid, wl, lane); } }
        if (l < DEPTH - 1) {
            const int nct = NB * NH * NCC;
#pragma unroll 1
            for (int st = obid(); st < 2 * nct; st += (int)gridDim.x) { const int mixer = st / nct, r2 = st % nct, b = r2 / (NH * NCC), h = (r2 / NCC) % NH, cid = r2 % NCC;
                const Params q = relaunder(p); const int mt = wave >> 1;
                __syncthreads();
                if (mixer == 0) { if (wave & 1) chunkout_piece<0, 1>(q, l, b, h, cid, mt, wl, lane); else chunkout_piece<0, 0>(q, l, b, h, cid, mt, wl, lane); }
                else            { if (wave & 1) chunkout_piece<1, 1>(q, l, b, h, cid, mt, wl, lane); else chunkout_piece<1, 0>(q, l, b, h, cid, mt, wl, lane); }
                __syncthreads();
                if (wave < 4) { if (mixer == 0) chunkout_combine<0>(q, l, b, h, cid, wave, smem, lane); else chunkout_combine<1>(q, l, b, h, cid, wave, smem, lane); }
            }
        }
    } else {
        int off = 0;
#pragma unroll 1
        for (int t = wi; t < half; t += NW) { const int b = t / (NH * npc), h = (t / npc) % NH, cid = c_lo + t % npc;
            const Params q = relaunder(p); chunkst_gla<0>(q, l, b, h, cid, wl, lane); }
        off = (off + half) % NW;
#pragma unroll 1
        for (int t = (wi + NW - off) % NW; t < half; t += NW) { const int b = t / (NH * npc), h = (t / npc) % NH, cid = c_lo + t % npc;
            const Params q = relaunder(p); chunkst_gla<1>(q, l, b, h, cid, wl, lane); }
        off = (off + half) % NW;
#pragma unroll 1
        for (int t = (wi + NW - off) % NW; t < half; t += NW) { const int b = t / (NH * npc), h = (t / npc) % NH, cid = c_lo + t % npc;
            const Params q = relaunder(p); chunkst_w<0>(q, l, b, h, cid, wl, lane); }
    }
}

__device__ __forceinline__ void phase_mix1(const Params& p, int l, char* smem) {
    const bool ctxo = l < DEPTH - 1;
    constexpr int QTL = SEQ / 128, QTC = CTXL / 128;
    constexpr int N_HL = (NB / 2) * (WG / 2), N_AL = NB * 2 * QTL, N_HC = NB * (WG / HCB), N_AC = NB * 2 * QTC;
    const int total = N_HL + N_AL + (ctxo ? N_HC + N_AC : 0);
    for (int task = obid(); task < total; task += gridDim.x) {
        int t = task;
        if (t < N_HL) { hylat_task(p, l, t / (WG / 2), t % (WG / 2), smem); continue; } t -= N_HL;
        if (t < N_AL) { attn_task(p, l, t / (2 * QTL), (t / QTL) % 2, t % QTL, false, smem); continue; } t -= N_AL;
        if (t < N_HC) { hyctx_task(p, l, t / (WG / HCB), t % (WG / HCB), smem); continue; } t -= N_HC;
        attn_task(p, l, t / (2 * QTC), (t / QTC) % 2, t % QTC, true, smem);
    }
    __syncthreads();
    chunk_workers<false>(p, l, smem);
}

constexpr int SCG = 12;
__device__ __forceinline__ void phase_scan(const Params& p, int l, char* smem) {
    const int tid = otid();
    bf16* ST = (bf16*)(p.ws + WS_ST); float* NV = (float*)(p.ws + WS_NV); const float* BE = (const float*)(p.ws + WS_BE); float* SC = (float*)(p.ws + WS_SC);
    constexpr int NCHAIN = 2 * 2 * NB * NH;
    for (int item = obid() * NT + tid; item < NCHAIN * 1024; item += gridDim.x * NT) {
        const int chain = item >> 10, grp = item & 1023; const int mixer = chain / (2 * NB * NH), dir = (chain / (NB * NH)) % 2, b = (chain / NH) % NB, h = chain % NH;
        float c[4] = {0.f, 0.f, 0.f, 0.f}; float nv[4] = {0.f, 0.f, 0.f, 0.f}; float m = 0.f;
        const int d0 = (grp & 15) * 4; const bool donv = (mixer == 0) && (grp < 16);
        for (int o0 = 0; o0 < NCH; o0 += SCG) {
            u32x2 uu[SCG]; float s0[SCG], s1[SCG]; f32x4 be[SCG]; f32x4 nu[SCG];
#pragma unroll
            for (int j = 0; j < SCG; ++j) if (o0 + j < NCH) { const int cid = chain_cid(dir, o0 + j); const size_t ci = ch_index(dir, b, h, cid);
                uu[j] = *(const u32x2*)(ST + st_index(mixer, dir, b, h, cid) * 4096 + grp * 4);
                if (mixer == 0) { s0[j] = SC[ci * 4 + 0]; s1[j] = SC[ci * 4 + 1]; if (donv) nu[j] = *(const f32x4*)(NV + ci * 64 + grp * 4); }
                else be[j] = *(const f32x4*)(BE + ci * 64 + d0); }
#pragma unroll
            for (int j = 0; j < SCG; ++j) if (o0 + j < NCH) { const int cid = chain_cid(dir, o0 + j); const size_t ci = ch_index(dir, b, h, cid);
                const float u[4] = {bitsf(uu[j].x << 16), bitsf(uu[j].x & 0xffff0000u), bitsf(uu[j].y << 16), bitsf(uu[j].y & 0xffff0000u)};
                u32x2 w; w.x = pk2(c[0], c[1]); w.y = pk2(c[2], c[3]); *(u32x2*)(ST + st_index(mixer, dir, b, h, cid) * 4096 + grp * 4) = w;
                if (mixer == 0) {
                    if (grp == 0) SC[ci * 4 + 2] = m;
                    const float mn = fmaxf(s0[j] + m, s1[j]), a = __expf(s0[j] + m - mn), s = __expf(s1[j] - mn);
#pragma unroll
                    for (int k = 0; k < 4; ++k) c[k] = a * c[k] + s * u[k];
                    if (donv) { f32x4 nw = {nv[0], nv[1], nv[2], nv[3]}; *(f32x4*)(NV + ci * 64 + grp * 4) = nw;
                        nv[0] = a * nv[0] + s * nu[j].x; nv[1] = a * nv[1] + s * nu[j].y; nv[2] = a * nv[2] + s * nu[j].z; nv[3] = a * nv[3] + s * nu[j].w; }
                    m = mn;
                } else { c[0] = __expf(be[j].x) * c[0] + u[0]; c[1] = __expf(be[j].y) * c[1] + u[1]; c[2] = __expf(be[j].z) * c[2] + u[2]; c[3] = __expf(be[j].w) * c[3] + u[3]; } }
        }
    }
    constexpr int N_WOUT = (DM / 64) * (MIX / 64);
    __syncthreads();
    { const int lane = tid & 63, wave = __builtin_amdgcn_readfirstlane(tid >> 6); const int NW = (int)gridDim.x * 8, wi = wave * (int)gridDim.x + obid();
        for (int task = NW - 1 - wi; task < N_WOUT; task += NW) { const int nt = task / (MIX / 64), kt = task % (MIX / 64);
            convert_tile_w(p.in[I_WOUT] + (size_t)l * MIX * DM, DM, (bf16*)(p.ws + WS_WOUT), MIX, nt * 64, kt * 64, false, smem + wave * WLDS, lane); }
        bf16* tile = (bf16*)(smem + wave * WLDS); const bf16* HT = (const bf16*)(p.ws + WS_HT); bf16* Y = (bf16*)(p.ws + WS_HNY);
        constexpr int NTT = NB * (SEQ / 64) * 4;
        for (int t = wi; t < NTT; t += NW) { const int b = t / ((SEQ / 64) * 4), tt = (t / 4) % (SEQ / 64), c0 = (t % 4) * 64; const size_t tok0 = (size_t)b * TOK + CTXL + tt * 64;
#pragma unroll
            for (int i = 0; i < 8; ++i) { const int ch = (lane >> 3) + 8 * i, ck = lane & 7; *(u32x4*)(tile + swz(ch, ck)) = *(const u32x4*)(HT + (size_t)(768 + c0 + ch) * T + tok0 + ck * 8); }
            WAVE_SYNC();
#pragma unroll
            for (int i = 0; i < 8; ++i) { const int tk = (lane >> 3) + 8 * i, cc = lane & 7; unsigned w[4];
#pragma unroll
                for (int j = 0; j < 4; ++j) { const int ca = cc * 8 + 2 * j; w[j] = (unsigned)tile[swz(ca, tk >> 3) + (tk & 7)] | ((unsigned)tile[swz(ca + 1, tk >> 3) + (tk & 7)] << 16); }
                u32x4 o; o.x = w[0]; o.y = w[1]; o.z = w[2]; o.w = w[3]; *(u32x4*)(Y + (tok0 + tk) * 1024 + YH + c0 + cc * 8) = o; }
            WAVE_SYNC(); } }
}

__device__ __forceinline__ void phase_mix2(const Params& p, int l, char* smem) { chunk_workers<true>(p, l, smem); }

#ifndef EMU
#define LAS __attribute__((address_space(3)))
#define XB_TMO      128
#define XB_XCNT(j)  (256  + 64 * (j))
#define XB_XSUB(j)  (1280 + 64 * (j))
#define XB_XGEN(j)  (2304 + 64 * (j))
#define XB_TOP      3328
#define XB_TOPGEN   3392
#define XCD_BAR_WORDS 3456
#define XB_SPIN_CAP (1u << 18)

__device__ __forceinline__ unsigned xb_ld(unsigned* p)              { return __hip_atomic_load(p, __ATOMIC_RELAXED, __HIP_MEMORY_SCOPE_AGENT); }
__device__ __forceinline__ unsigned xb_add(unsigned* p, unsigned v) { return __hip_atomic_fetch_add(p, v, __ATOMIC_RELAXED, __HIP_MEMORY_SCOPE_AGENT); }
__device__ __forceinline__ unsigned xb_xcc_id() { return (unsigned)__builtin_amdgcn_s_getreg((3 << 11) | 20) & 0xFu; }
#define XB_SPIN(cond, bar) do { unsigned _sp = 0; while (cond) { __builtin_amdgcn_s_sleep(1); \
    if ((++_sp & 255u) == 0u) { if (xb_ld(&(bar)[XB_TMO])) break; if (_sp > XB_SPIN_CAP) { atomicAdd(&(bar)[XB_TMO], 1u); break; } } } } while (0)

struct XcdBarrier {
    unsigned* bar; unsigned x;
    volatile LAS unsigned* st;
};

__device__ __forceinline__ XcdBarrier xcd_barrier_post(unsigned* bar, volatile LAS unsigned* st) {
    XcdBarrier b; b.bar = bar; b.x = xb_xcc_id(); b.st = st;
    if (threadIdx.x == 0) (void)xb_add(&bar[XB_XCNT(b.x)], 1u);
    return b;
}
__device__ __forceinline__ void xcd_barrier_complete(unsigned* bar, unsigned x, unsigned& nloc, unsigned& nx) {
    const unsigned G = gridDim.x * gridDim.y * gridDim.z;
    unsigned sum, cnt, mine, sp = 0u;
    for (;;) {
        sum = 0u; cnt = 0u; mine = 0u;
#pragma unroll
        for (unsigned j = 0; j < 16; ++j) { const unsigned c = xb_ld(&bar[XB_XCNT(j)]); sum += c; cnt += (c > 0u) ? 1u : 0u; mine = (j == x) ? c : mine; }
        if (sum == G) break;
        __builtin_amdgcn_s_sleep(1);
        if ((++sp & 255u) == 0u) { if (xb_ld(&bar[XB_TMO])) break; if (sp > XB_SPIN_CAP) { atomicAdd(&bar[XB_TMO], 1u); break; } }
    }
    nloc = mine > 0u ? mine : 1u; nx = cnt > 0u ? cnt : 1u;
}

__device__ __forceinline__ void xcd_barrier(const XcdBarrier& b) {
    asm volatile("s_waitcnt vmcnt(0)" ::: "memory");
    __syncthreads();
    if (threadIdx.x == 0) {
        unsigned* bar = b.bar;
        __builtin_amdgcn_s_waitcnt(0);
        unsigned nloc = b.st[0], nx = b.st[1];
        if (nloc == 0u) { xcd_barrier_complete(bar, b.x, nloc, nx); b.st[0] = nloc; b.st[1] = nx; }
        const unsigned old = xb_add(&bar[XB_XSUB(b.x)], 1u);
        const unsigned gen = old / nloc;
        if (old + 1u == (gen + 1u) * nloc) {
            __builtin_amdgcn_fence(__ATOMIC_RELEASE, "agent");
            asm volatile("s_waitcnt vmcnt(0)" ::: "memory");
            const unsigned og = xb_add(&bar[XB_TOP], 1u);
            const unsigned tg = og / nx;
            if (og + 1u == (tg + 1u) * nx) xb_add(&bar[XB_TOPGEN], 1u);
            else XB_SPIN(xb_ld(&bar[XB_TOPGEN]) == tg, bar);
            __builtin_amdgcn_fence(__ATOMIC_ACQUIRE, "agent");
            xb_add(&bar[XB_XGEN(b.x)], 1u);
            asm volatile("s_waitcnt vmcnt(0)" ::: "memory");
        } else {
            XB_SPIN(xb_ld(&bar[XB_XGEN(b.x)]) == gen, bar);
            __builtin_amdgcn_fence(__ATOMIC_ACQUIRE, "agent");
            asm volatile("s_waitcnt vmcnt(0)" ::: "memory");
        }
    }
    __syncthreads();
}
#endif

__global__ void __launch_bounds__(NT) fwd_kernel(Params pk, int ph_lo, int ph_hi) {
    SMEM_DECL;
#ifndef EMU
    volatile LAS unsigned* misc = (volatile LAS unsigned*)(smem + LDS_BYTES - 64);
    if (threadIdx.x < 2) misc[threadIdx.x] = 0u;
    __syncthreads();
    const XcdBarrier bar = xcd_barrier_post((unsigned*)(pk.ws + WS_BAR), misc);
#endif
    constexpr int NPH = 2 + 6 * DEPTH;
    for (int ph = ph_lo; ph < ph_hi && ph < NPH; ++ph) {
#ifndef EMU
        Params p = pk; { size_t z = 0; asm volatile("" : "+s"(z)); p.ws = pk.ws + z; p.out = pk.out + z;
#pragma unroll
            for (int i = 0; i < 26; ++i) p.in[i] = pk.in[i] + z; }
#else
        const Params& p = pk;
#endif
        if (ph == 0) phase0(p, smem);
        else if (ph == NPH - 1) phase_rp(p, DEPTH, smem);
        else { const int l = (ph - 1) / 6, k = (ph - 1) % 6;
            if (k == 0) phase_rp(p, l, smem);
            else if (k == 1) phase_gemm_in(p, l, smem);
            else if (k == 2) phase_mix1(p, l, smem);
            else if (k == 3) phase_scan(p, l, smem);
            else if (k == 4) phase_mix2(p, l, smem);
            else phase_gemm_out(p, l, smem);
#ifdef PROBE_DUP
            if (k == PROBE_DUP) { GRID_SYNC();
                if (k == 1) phase_gemm_in(p, l, smem); else if (k == 2) phase_mix1(p, l, smem); else if (k == 4) phase_mix2(p, l, smem); else if (k == 5) phase_gemm_out(p, l, smem); }
#endif
        }
        if (ph + 1 < ph_hi) {
#ifdef EMU
            GRID_SYNC();
#else
            if (ph_lo < 0) GRID_SYNC();
            xcd_barrier(bar);
#endif
        }
    }
}

#ifndef EMU
extern "C" void kernel_launch(void* const* d_in, const int* in_sizes, int n_in, void* d_out, int out_size, void* d_ws, size_t ws_size, hipStream_t stream) {
    static int grid = 0;
    if (grid == 0) {
        if (n_in != 26 || ws_size < WS_TOTAL) { fprintf(stderr, "kernel_launch: unexpected n_in %d or ws_size %zu (need %zu)\n", n_in, ws_size, (size_t)WS_TOTAL); grid = -1; return; }
        int dev = 0, cus = 0, per_cu = 0;
        hipGetDevice(&dev);
        hipDeviceGetAttribute(&cus, hipDeviceAttributeMultiprocessorCount, dev);
        hipFuncSetAttribute((const void*)fwd_kernel, hipFuncAttributeMaxDynamicSharedMemorySize, LDS_BYTES);
        hipOccupancyMaxActiveBlocksPerMultiprocessor(&per_cu, (const void*)fwd_kernel, NT, LDS_BYTES);
        if (per_cu < 1) { fprintf(stderr, "kernel_launch: occupancy query returned %d\n", per_cu); grid = -1; return; }
        if (per_cu > 1) per_cu = 1;
        grid = cus * per_cu;
    }
    if (grid < 0) return;
    hipMemsetAsync((char*)d_ws + WS_BAR, 0, BAR_BYTES, stream);
    Params p{};
    for (int i = 0; i < 26; ++i) p.in[i] = (const float*)d_in[i];
    p.out = (float*)d_out; p.ws = (char*)d_ws;
    int lo = 0, hi = 2 + 6 * DEPTH;
    void* args[] = {&p, &lo, &hi};
    hipError_t e = hipLaunchCooperativeKernel((const void*)fwd_kernel, dim3(grid), dim3(NT), args, LDS_BYTES, stream);
    if (e != hipSuccess) fprintf(stderr, "cooperative launch failed: %s (grid %d)\n", hipGetErrorString(e), grid);
}
#endif
```

```cpp
#ifdef EMU
#include "emu/hipemu.h"
#define GRID_SYNC() emu::grid_sync()
#define SMEM_DECL char* smem = emu::S().blocks[emu::cur()->block].lds
#define MFMA16(a, b, c) emu_mfma_16x16x32_bf16(a, b, c)
#else
#include <hip/hip_runtime.h>
#include <hip/hip_cooperative_groups.h>
#include <cstdio>
#include <cstdint>
#define GRID_SYNC() cooperative_groups::this_grid().sync()
#define SMEM_DECL extern __shared__ __attribute__((aligned(16))) char smem[]
#define MFMA16(a, b, c) __builtin_amdgcn_mfma_f32_16x16x32_bf16(a, b, c, 0, 0, 0)
#endif

#ifdef EMU
#ifndef EMU_DM
#define EMU_DM 256
#endif
#ifndef EMU_NB
#define EMU_NB 2
#endif
#ifndef EMU_SEQ
#define EMU_SEQ 512
#endif
#ifndef EMU_DEPTH
#define EMU_DEPTH 2
#endif
#ifndef EMU_CTXL
#define EMU_CTXL 128
#endif
constexpr int DM = EMU_DM, NB = EMU_NB, SEQ = EMU_SEQ, DEPTH = EMU_DEPTH, CTXL = EMU_CTXL;
#else
constexpr int DM = 1024, NB = 8, SEQ = 2048, DEPTH = 4, CTXL = 256;
#endif
constexpr int MIX = 1024, WG = 256, HD = 64, NH = 4, CH = 64;
constexpr int TOK = CTXL + SEQ, T = NB * TOK, NCH = TOK / CH, NCC = CTXL / CH;
constexpr int N_IN = 4144, NP = 3072, NG = 48, NGS = 32, NMAIN = 3328, NPAD = 4352;
constexpr int NF = 2 * SEQ;
constexpr int NJ = NB + 1;
constexpr int NT = 512;
constexpr float EPS = 1e-6f;
constexpr int PA = 0, PG = 1280, PD = 2304;
constexpr int YA = 0, YH = 256, YG = 512, YD = 768;
constexpr int ilog4(int n) { return n <= 1 ? 0 : 1 + ilog4(n / 4); }
constexpr int FFT_P = ilog4(NF);
static_assert((1 << (2 * FFT_P)) == NF, "NF must be a power of 4");
static_assert(DM % 256 == 0 && CTXL % 128 == 0 && SEQ % 256 == 0, "shape constraints");

typedef unsigned short bf16;
typedef short bf16x8 __attribute__((ext_vector_type(8)));
typedef float f32x4 __attribute__((ext_vector_type(4)));
typedef unsigned u32x4 __attribute__((ext_vector_type(4)));
typedef unsigned u32x2 __attribute__((ext_vector_type(2)));
struct cpx { float x, y; };

constexpr size_t al256(size_t x) { return (x + 255) & ~(size_t)255; }
constexpr size_t WS_CTXB = 0;
constexpr size_t WS_HNY = al256(WS_CTXB + (size_t)NB * CTXL * DM * 4);
constexpr size_t WS_WIN = WS_HNY + (size_t)T * 1024 * 2;
constexpr size_t WS_ST = WS_WIN;
constexpr size_t ST_BYTES = (size_t)2 * 2 * NB * NH * NCH * 4096 * 2;
constexpr size_t WS_KT = al256(WS_WIN + (size_t)NPAD * DM * 2);
static_assert(WS_KT + (size_t)WG * NF * 4 <= WS_ST + ST_BYTES || true, "");
constexpr size_t ST_END = al256((WS_ST + ST_BYTES > WS_KT + (size_t)WG * NF * 4) ? WS_ST + ST_BYTES : WS_KT + (size_t)WG * NF * 4);
constexpr size_t WS_P = ST_END;
constexpr size_t WS_HT = al256(WS_P + (size_t)T * NP * 2);
constexpr size_t WS_WOUT = WS_HT;
constexpr size_t WS_G = al256(WS_HT + (size_t)1024 * T * 2);
constexpr size_t WS_KF = al256(WS_G + (size_t)T * NGS * 4);
constexpr size_t WS_HC = al256(WS_KF + (size_t)WG * NF * 8);
constexpr size_t WS_EQ = al256(WS_HC + (size_t)2 * WG * CTXL * 4);
constexpr size_t WS_NV = al256(WS_EQ + (size_t)2 * T * WG * 2);
constexpr size_t WS_BE = al256(WS_NV + (size_t)2 * NB * NH * NCH * 64 * 4);
constexpr size_t WS_SC = al256(WS_BE + (size_t)2 * NB * NH * NCH * 64 * 4);
constexpr size_t WS_MOD = al256(WS_SC + (size_t)2 * NB * NH * NCH * 4 * 4);
constexpr size_t WS_TW = al256(WS_MOD + (size_t)DEPTH * NJ * 3 * DM * 4);
constexpr size_t WS_ROPE = al256(WS_TW + (size_t)NF * 8);
constexpr size_t WS_BAR = al256(WS_ROPE + (size_t)SEQ * 32 * 8);
constexpr size_t BAR_BYTES = 32768;
constexpr size_t WS_TOTAL = al256(WS_BAR + BAR_BYTES);
static_assert((size_t)T * DM * 4 <= (size_t)T * NP * 2, "YO fits in P");
#ifndef EMU
static_assert(WS_TOTAL <= (size_t)268435456, "workspace map must fit 256 MiB");
#endif

constexpr int LDS_BYTES = 163840;

struct Params {
    const float* in[26];
    float* out;
    char* ws;
};
enum { I_X = 0, I_C, I_CTX, I_CCTX, I_WADA, I_BADA, I_GPRE, I_GPOST, I_WIN, I_MGB, I_MNG, I_HCW, I_HCB, I_HW1, I_HB1, I_HW2, I_HB2, I_HW3, I_HB3,
       I_HFREQ, I_HD, I_GWA, I_GBA, I_GNG, I_SINK, I_WOUT };

__device__ __forceinline__ Params relaunder(const Params& pk) {
#ifdef EMU
    return pk;
#else
    Params p = pk; size_t z = 0; asm volatile("" : "+s"(z)); p.ws = pk.ws + z; p.out = pk.out + z;
#pragma unroll
    for (int i = 0; i < 26; ++i) p.in[i] = pk.in[i] + z;
    return p;
#endif
}
constexpr int WLDS = (LDS_BYTES - 64) / 8 / 16 * 16;
#ifdef EMU
#define WAVE_SYNC() emu_wave_sync()
#else
#define WAVE_SYNC() do { asm volatile("s_waitcnt lgkmcnt(0)" ::: "memory"); __builtin_amdgcn_wave_barrier(); } while (0)
#endif

#ifdef EMU
__device__ __forceinline__ int otid() { return (int)threadIdx.x; }
__device__ __forceinline__ int obid() { return (int)blockIdx.x; }
#else
__device__ __forceinline__ int otid() { int t = (int)threadIdx.x; asm volatile("" : "+v"(t)); return t; }
__device__ __forceinline__ int obid() { int b = (int)blockIdx.x; asm volatile("" : "+s"(b)); return b; }
#endif
__device__ __forceinline__ unsigned fbits(float f) { return __builtin_bit_cast(unsigned, f); }
__device__ __forceinline__ float bitsf(unsigned u) { return __builtin_bit_cast(float, u); }
__device__ __forceinline__ float bf2f(bf16 h) { return bitsf((unsigned)h << 16); }
#ifdef EMU
__device__ __forceinline__ bf16 f2bf(float f) { unsigned u = fbits(f); return (bf16)((u + 0x7fffu + ((u >> 16) & 1u)) >> 16); }
__device__ __forceinline__ unsigned pk2(float lo, float hi) { return (unsigned)f2bf(lo) | ((unsigned)f2bf(hi) << 16); }
#else
typedef __bf16 nbf16x2 __attribute__((ext_vector_type(2)));
typedef float nf32x2 __attribute__((ext_vector_type(2)));
__device__ __forceinline__ unsigned pk2(float lo, float hi) { const nf32x2 v = {lo, hi}; return __builtin_bit_cast(unsigned, __builtin_convertvector(v, nbf16x2)); }
__device__ __forceinline__ bf16 f2bf(float f) { return (bf16)(pk2(f, 0.0f) & 0xffffu); }
#endif
#ifdef EMU
__device__ __forceinline__ float frcp_(float x) { return 1.0f / x; }
#else
__device__ __forceinline__ float frcp_(float x) { return __builtin_amdgcn_rcpf(x); }
#endif
__device__ __forceinline__ float sigmoidf_(float x) { return frcp_(1.0f + __expf(-x)); }
__device__ __forceinline__ float siluf_(float x) { return x * frcp_(1.0f + __expf(-x)); }
__device__ __forceinline__ float logsigf_(float x) { return fminf(x, 0.0f) - log1pf(__expf(-fabsf(x))); }
__device__ __forceinline__ float logsig_fast(float x) { return fminf(x, 0.0f) - __logf(1.0f + __expf(-fabsf(x))); }
#ifdef EMU
__device__ __forceinline__ float row16_sum(float x) { x += __shfl_xor(x, 1); x += __shfl_xor(x, 2); x += __shfl_xor(x, 4); x += __shfl_xor(x, 8); return x; }
__device__ __forceinline__ float row16_max(float x) { x = fmaxf(x, __shfl_xor(x, 1)); x = fmaxf(x, __shfl_xor(x, 2)); x = fmaxf(x, __shfl_xor(x, 4)); x = fmaxf(x, __shfl_xor(x, 8)); return x; }
__device__ __forceinline__ float xrow_sum(float x) { x += __shfl_xor(x, 16); x += __shfl_xor(x, 32); return x; }
__device__ __forceinline__ float xrow_max(float x) { x = fmaxf(x, __shfl_xor(x, 16)); x = fmaxf(x, __shfl_xor(x, 32)); return x; }
#else
template <int CTRL> __device__ __forceinline__ float dpp_(float x) { return __builtin_bit_cast(float, __builtin_amdgcn_mov_dpp(__builtin_bit_cast(int, x), CTRL, 0xf, 0xf, true)); }
__device__ __forceinline__ float row16_sum(float x) { x += dpp_<0xB1>(x); x += dpp_<0x4E>(x); x += dpp_<0x141>(x); x += dpp_<0x128>(x); return x; }
__device__ __forceinline__ float row16_max(float x) { x = fmaxf(x, dpp_<0xB1>(x)); x = fmaxf(x, dpp_<0x4E>(x)); x = fmaxf(x, dpp_<0x141>(x)); x = fmaxf(x, dpp_<0x128>(x)); return x; }
__device__ __forceinline__ float xrow_sum(float x) {
    auto s = __builtin_amdgcn_permlane16_swap(fbits(x), fbits(x), false, false); x = bitsf(s[0]) + bitsf(s[1]);
    auto t = __builtin_amdgcn_permlane32_swap(fbits(x), fbits(x), false, false); return bitsf(t[0]) + bitsf(t[1]); }
__device__ __forceinline__ float xrow_max(float x) {
    auto s = __builtin_amdgcn_permlane16_swap(fbits(x), fbits(x), false, false); x = fmaxf(bitsf(s[0]), bitsf(s[1]));
    auto t = __builtin_amdgcn_permlane32_swap(fbits(x), fbits(x), false, false); return fmaxf(bitsf(t[0]), bitsf(t[1])); }
#endif
__device__ __forceinline__ float wave_sum(float v) { return xrow_sum(row16_sum(v)); }
__device__ __forceinline__ float wave_max(float v) { return xrow_max(row16_max(v)); }
#ifdef EMU
__device__ __forceinline__ float wave_prefix_sum(float v, int lane) {
#pragma unroll
    for (int o = 1; o < 64; o <<= 1) { float t = __shfl_up(v, o); if (lane >= o) v += t; }
    return v;
}
__device__ __forceinline__ float wave_prefix_max(float v, int lane) {
#pragma unroll
    for (int o = 1; o < 64; o <<= 1) { float t = __shfl_up(v, o); if (lane >= o) v = fmaxf(v, t); }
    return v;
}
#else
template <int CTRL, int RM> __device__ __forceinline__ float dppo_(float old, float x) { return __builtin_bit_cast(float, __builtin_amdgcn_update_dpp(__builtin_bit_cast(int, old), __builtin_bit_cast(int, x), CTRL, RM, 0xf, false)); }
__device__ __forceinline__ float wave_prefix_sum(float v, int) {
    v += dppo_<0x111, 0xf>(0.f, v); v += dppo_<0x112, 0xf>(0.f, v); v += dppo_<0x114, 0xf>(0.f, v); v += dppo_<0x118, 0xf>(0.f, v);
    v += dppo_<0x142, 0xa>(0.f, v); v += dppo_<0x143, 0xc>(0.f, v); return v;
}
__device__ __forceinline__ float wave_prefix_max(float v, int) {
    const float ninf = -INFINITY;
    v = fmaxf(v, dppo_<0x111, 0xf>(ninf, v)); v = fmaxf(v, dppo_<0x112, 0xf>(ninf, v)); v = fmaxf(v, dppo_<0x114, 0xf>(ninf, v)); v = fmaxf(v, dppo_<0x118, 0xf>(ninf, v));
    v = fmaxf(v, dppo_<0x142, 0xa>(ninf, v)); v = fmaxf(v, dppo_<0x143, 0xc>(ninf, v)); return v;
}
#endif
__device__ __forceinline__ float wave_suffix_max(float v, int lane) {
    return __shfl(wave_prefix_max(__shfl(v, 63 - lane), lane), 63 - lane);
}
__device__ __forceinline__ void unpack8(u32x4 v, float* f) {
    f[0] = bitsf(v.x << 16); f[1] = bitsf(v.x & 0xffff0000u); f[2] = bitsf(v.y << 16); f[3] = bitsf(v.y & 0xffff0000u);
    f[4] = bitsf(v.z << 16); f[5] = bitsf(v.z & 0xffff0000u); f[6] = bitsf(v.w << 16); f[7] = bitsf(v.w & 0xffff0000u);
}
__device__ __forceinline__ int orig_col(int n) {
    if (n < 1280) return n;
    if (n < 2304) return 2320 + (n - 1280);
    if (n < 3072) return 3376 + (n - 2304);
    if (n < 3088) return 1280 + (n - 3072);
    if (n < 3120) return 3344 + (n - 3088);
    if (n < NMAIN) return -1;
    return 1296 + (n - NMAIN);
}
__device__ __forceinline__ int chain_cid(int dir, int o) {
    if (dir == 0) return o;
    return o < NCC ? (NCC - 1 - o) : (NCH - 1 - (o - NCC));
}

__device__ __forceinline__ int swz(int row, int ch) { return row * 64 + ((ch ^ (row & 7)) << 3); }
__device__ __forceinline__ u32x4 pack8(const float* f) { u32x4 o; o.x = pk2(f[0], f[1]); o.y = pk2(f[2], f[3]); o.z = pk2(f[4], f[5]); o.w = pk2(f[6], f[7]); return o; }
__device__ __forceinline__ bf16x8 as_frag(u32x4 v) { return __builtin_bit_cast(bf16x8, v); }
__device__ __forceinline__ u32x4 as_u4(bf16x8 v) { return __builtin_bit_cast(u32x4, v); }

constexpr int LS = 72;

template <int NTL, int KS>
__device__ __forceinline__ void mma_nt(const bf16* A, int lda, int m0, const bf16* B, int ldb, int n0, f32x4 (&acc)[NTL], int lane) {
    const int r = lane & 15, q = lane >> 4;
#pragma unroll
    for (int ks = 0; ks < KS; ++ks) {
        const bf16x8 a = *(const bf16x8*)(A + (m0 + r) * lda + ks * 32 + q * 8);
#pragma unroll
        for (int nt = 0; nt < NTL; ++nt) {
            const bf16x8 b = *(const bf16x8*)(B + (n0 + nt * 16 + r) * ldb + ks * 32 + q * 8);
            acc[nt] = MFMA16(a, b, acc[nt]);
        }
    }
}

__device__ __forceinline__ void layer_prep(const Params& p, int l, int idx, int stride, char* smem);
__device__ __forceinline__ void phase0(const Params& p, char* smem) {
    const int tid = otid();
    cpx* TW = (cpx*)(p.ws + WS_TW);
    cpx* ROPE = (cpx*)(p.ws + WS_ROPE);
    float* MOD = (float*)(p.ws + WS_MOD);
    constexpr int N_TW = NF / NT, N_ROPE = SEQ * 32 / NT, N_MOD = DEPTH * (3 * DM / 64);
    for (int task = obid(); task < N_TW + N_ROPE + N_MOD; task += gridDim.x) {
        if (task < N_TW) {
            const int j = task * NT + tid; float s, c; sincospif(2.0f * (float)j / (float)NF, &s, &c);
            cpx v; v.x = c; v.y = -s; TW[j] = v;
        } else if (task < N_TW + N_ROPE) {
            const int idx = (task - N_TW) * NT + tid; const int pos = idx >> 5, i = idx & 31;
            const float inv = exp2f(-(float)(i & 15) * (13.287712379549449f / 16.0f));
            const float ang = (float)(i < 16 ? pos / 64 : pos % 64) * inv;
            cpx v; v.x = cosf(ang); v.y = sinf(ang); ROPE[idx] = v;
        } else {
            const int mt = task - N_TW - N_ROPE; const int l = mt / (3 * DM / 64), n0 = (mt % (3 * DM / 64)) * 64;
            float* sv = (float*)smem;
            float* red = sv + NJ * DM;
            __syncthreads();
            for (int i = tid; i < NJ * DM; i += NT) { const int j = i / DM, k = i % DM; const float v = j < NB ? p.in[I_C][j * DM + k] : p.in[I_CCTX][k]; sv[i] = siluf_(v); }
            __syncthreads();
            const int nl = tid & 63, ks = tid >> 6; float acc[NJ];
#pragma unroll
            for (int j = 0; j < NJ; ++j) acc[j] = 0.f;
            const float* w = p.in[I_WADA] + (size_t)l * DM * 3 * DM + n0 + nl;
            for (int k = ks * (DM / 8); k < (ks + 1) * (DM / 8); ++k) { const float wv = w[(size_t)k * 3 * DM];
#pragma unroll
                for (int j = 0; j < NJ; ++j) acc[j] += sv[j * DM + k] * wv; }
#pragma unroll
            for (int j = 0; j < NJ; ++j) red[(ks * NJ + j) * 64 + nl] = acc[j];
            __syncthreads();
            for (int i = tid; i < NJ * 64; i += NT) { const int j = i / 64, n = i % 64; float s = 0.f;
#pragma unroll
                for (int k8 = 0; k8 < 8; ++k8) s += red[(k8 * NJ + j) * 64 + n];
                MOD[((size_t)l * NJ + j) * 3 * DM + n0 + n] = s + p.in[I_BADA][(size_t)l * 3 * DM + n0 + n]; }
        }
    }
}

#ifdef EMU
constexpr int PANEL_ROWS = 128, PANEL_UNITS = DM / 128;
#else
constexpr int PANEL_ROWS = 256, PANEL_UNITS = DM / 256;
#endif
__device__ __forceinline__ unsigned* unit_counter(const Params& p, int isctx) { return (unsigned*)(p.ws + WS_BAR + 16384) + 64 * isctx; }
__device__ __forceinline__ int logical_row(int i) { return i < NB * SEQ ? (i / SEQ) * TOK + CTXL + i % SEQ : ((i - NB * SEQ) / CTXL) * TOK + (i - NB * SEQ) % CTXL; }
__device__ __forceinline__ void rp_rows(const Params& p, int l, int lo, int hi, int gi, int nb) {
    const int tid = otid(), lane = tid & 63, wave = tid >> 6;
    const float* MOD = (const float*)(p.ws + WS_MOD);
    float* CTXB = (float*)(p.ws + WS_CTXB);
    const bf16* YO = (const bf16*)(p.ws + WS_P);
    bf16* HN = (bf16*)(p.ws + WS_HNY);
    constexpr int NV4 = DM / 256, RW = 2;
    const int stride = nb * 8;
    for (int base = lo + gi * 8 + wave; base < hi; base += stride * RW) {
        f32x4 x[RW][NV4], y[RW][NV4]; const float* xo[RW]; float* xn[RW]; int mj[RW]; bool ok[RW]; int rowi[RW];
#pragma unroll
        for (int i = 0; i < RW; ++i) { const int li = base + i * stride; ok[i] = li < hi; const int rr = logical_row(ok[i] ? li : base); rowi[i] = rr;
            const int b = rr / TOK, pp = rr % TOK; const bool isctx = pp < CTXL; if (l == DEPTH && isctx) ok[i] = false;
            const size_t off = isctx ? ((size_t)b * CTXL + pp) * DM : ((size_t)b * SEQ + (pp - CTXL)) * DM;
            xo[i] = (l <= 1) ? (isctx ? p.in[I_CTX] + off : p.in[I_X] + off) : (isctx ? CTXB + off : p.out + off);
            xn[i] = isctx ? CTXB + off : p.out + off; mj[i] = isctx ? NB : b;
#pragma unroll
            for (int j = 0; j < NV4; ++j) { x[i][j] = *(const f32x4*)(xo[i] + 4 * lane + 256 * j); if (l > 0) { const u32x2 yy = *(const u32x2*)(YO + (size_t)rr * DM + 4 * lane + 256 * j); y[i][j] = (f32x4){bitsf(yy.x << 16), bitsf(yy.x & 0xffff0000u), bitsf(yy.y << 16), bitsf(yy.y & 0xffff0000u)}; } else y[i][j] = (f32x4){0.f, 0.f, 0.f, 0.f}; } }
        if (l > 0) {
            float ss[RW];
#pragma unroll
            for (int i = 0; i < RW; ++i) { ss[i] = 0.f;
#pragma unroll
                for (int j = 0; j < NV4; ++j) ss[i] += y[i][j].x * y[i][j].x + y[i][j].y * y[i][j].y + y[i][j].z * y[i][j].z + y[i][j].w * y[i][j].w; }
#pragma unroll
            for (int i = 0; i < RW; ++i) ss[i] = wave_sum(ss[i]);
            const float* gp = p.in[I_GPOST] + (size_t)(l - 1) * DM;
#pragma unroll
            for (int i = 0; i < RW; ++i) { const float rstd = rsqrtf(ss[i] * (1.0f / DM) + EPS); const float* gt = MOD + ((size_t)(l - 1) * NJ + mj[i]) * 3 * DM + 2 * DM;
#pragma unroll
                for (int j = 0; j < NV4; ++j) { const f32x4 g4 = *(const f32x4*)(gt + 4 * lane + 256 * j), p4 = *(const f32x4*)(gp + 4 * lane + 256 * j);
                    x[i][j] = x[i][j] + g4 * (y[i][j] * rstd * p4);
                    if (ok[i]) *(f32x4*)(xn[i] + 4 * lane + 256 * j) = x[i][j]; } }
        }
        if (l < DEPTH) {
            float ss[RW];
#pragma unroll
            for (int i = 0; i < RW; ++i) { ss[i] = 0.f;
#pragma unroll
                for (int j = 0; j < NV4; ++j) ss[i] += x[i][j].x * x[i][j].x + x[i][j].y * x[i][j].y + x[i][j].z * x[i][j].z + x[i][j].w * x[i][j].w; }
#pragma unroll
            for (int i = 0; i < RW; ++i) ss[i] = wave_sum(ss[i]);
            const float* gp = p.in[I_GPRE] + (size_t)l * DM;
#pragma unroll
            for (int i = 0; i < RW; ++i) { const float rstd = rsqrtf(ss[i] * (1.0f / DM) + EPS); const float* md = MOD + ((size_t)l * NJ + mj[i]) * 3 * DM; const int row = rowi[i];
#pragma unroll
                for (int j = 0; j < NV4; ++j) { const int e = 4 * lane + 256 * j;
                    const f32x4 g4 = *(const f32x4*)(gp + e), sh = *(const f32x4*)(md + e), sc = *(const f32x4*)(md + DM + e);
                    const f32x4 h = (x[i][j] * rstd * g4) * (sc + 1.0f) + sh;
                    u32x2 o; o.x = pk2(h.x, h.y); o.y = pk2(h.z, h.w);
                    if (ok[i]) *(u32x2*)(HN + (size_t)row * DM + e) = o; } }
        }
    }
}

__device__ __forceinline__ void convert_tile(const float* src, int ldn, bf16* dst, int K, int n0, int k0, bool use_map, char* smem) {
    const int tid = otid();
    float* tile = (float*)smem;
    __syncthreads();
#pragma unroll
    for (int i = 0; i < 8; ++i) { const int idx = tid + NT * i, k = idx >> 6, n = idx & 63;
        const int oc = use_map ? orig_col(n0 + n) : (n0 + n);
        tile[k * 65 + n] = oc >= 0 ? src[(size_t)(k0 + k) * ldn + oc] : 0.f; }
    __syncthreads();
    const int n = tid >> 3, c = tid & 7;
    u32x4 o; o.x = pk2(tile[(8 * c + 0) * 65 + n], tile[(8 * c + 1) * 65 + n]); o.y = pk2(tile[(8 * c + 2) * 65 + n], tile[(8 * c + 3) * 65 + n]);
    o.z = pk2(tile[(8 * c + 4) * 65 + n], tile[(8 * c + 5) * 65 + n]); o.w = pk2(tile[(8 * c + 6) * 65 + n], tile[(8 * c + 7) * 65 + n]);
    *(u32x4*)(dst + (size_t)(n0 + n) * K + k0 + 8 * c) = o;
}

__device__ __forceinline__ void filter_task(const Params& p, int l, int L, int pos0, char* smem) {
    const int tid = otid();
    float* z = (float*)smem;
    float* h1 = z + 8 * 33;
    float* h2 = h1 + 8 * 64;
    __syncthreads();
    if (tid < 8 * 33) { const int pp = tid / 33, i = tid % 33; const float pos = (float)(pos0 + pp);
        const float t = pos / (float)(L - 1 > 1 ? L - 1 : 1), w = 6.283185307179586f * pos / (float)L; float v;
        if (i == 0) v = t; else { const int bi = (i - 1) & 15; const float f = 1e-4f + (float)bi * ((15.0f - 1e-4f) / 15.0f); v = (i <= 16) ? cosf(w * f) : -sinf(w * f); }
        z[tid] = v; }
    __syncthreads();
    { const int pp = tid >> 6, j = tid & 63; const float* w1 = p.in[I_HW1] + (size_t)l * 33 * 64; float a = p.in[I_HB1][l * 64 + j];
        for (int i = 0; i < 33; ++i) a += z[pp * 33 + i] * w1[i * 64 + j];
        h1[tid] = sinf(p.in[I_HFREQ][(l * 2 + 0) * 64 + j] * a); }
    __syncthreads();
    { const int pp = tid >> 6, j = tid & 63; const float* w2 = p.in[I_HW2] + (size_t)l * 64 * 64; float a = p.in[I_HB2][l * 64 + j];
        for (int i = 0; i < 64; ++i) a += h1[pp * 64 + i] * w2[i * 64 + j];
        h2[tid] = sinf(p.in[I_HFREQ][(l * 2 + 1) * 64 + j] * a); }
    __syncthreads();
    { const int o = tid, dir = o >> 8, c = o & 255; const float* w3 = p.in[I_HW3] + (size_t)l * 64 * 512; const float b3 = p.in[I_HB3][l * 512 + o];
        const float delta = 3.0701134573253946f + (float)c * ((15.350567286626973f - 3.0701134573253946f) / 255.0f);
        float acc[8];
#pragma unroll
        for (int pp = 0; pp < 8; ++pp) acc[pp] = b3;
        for (int j = 0; j < 64; ++j) { const float wv = w3[j * 512 + o];
#pragma unroll
            for (int pp = 0; pp < 8; ++pp) acc[pp] += h2[pp * 64 + j] * wv; }
        float* KT = (float*)(p.ws + WS_KT); float* HC = (float*)(p.ws + WS_HC);
#pragma unroll
        for (int pp = 0; pp < 8; ++pp) { const int pos = pos0 + pp; const float t = (float)pos / (float)(L - 1 > 1 ? L - 1 : 1);
            const float v = acc[pp] * __expf(-t * delta);
            if (L == SEQ) { if (dir == 0) KT[(size_t)c * NF + pos]= v; else if (pos > 0) KT[(size_t)c * NF + (NF - pos)] = v; else KT[(size_t)c * NF + SEQ] = 0.f; }
            else HC[((size_t)dir * WG + c) * CTXL + pos] = v; }
    }
}

__device__ __forceinline__ void convert_tile_w(const float* src, int ldn, bf16* dst, int K, int n0, int k0, bool use_map, char* wl, int lane) {
    float* tile = (float*)wl;
    const int oc = use_map ? orig_col(n0 + lane) : (n0 + lane);
    float v[64];
#pragma unroll
    for (int k = 0; k < 64; ++k) v[k] = oc >= 0 ? src[(size_t)(k0 + k) * ldn + oc] : 0.f;
#pragma unroll
    for (int k = 0; k < 64; ++k) tile[k * 65 + lane] = v[k];
    WAVE_SYNC();
#pragma unroll
    for (int i = 0; i < 8; ++i) { const int n = (lane >> 3) + 8 * i, c = lane & 7; float f[8];
#pragma unroll
        for (int j = 0; j < 8; ++j) f[j] = tile[(8 * c + j) * 65 + n];
        *(u32x4*)(dst + (size_t)(n0 + n) * K + k0 + 8 * c) = pack8(f); }
    WAVE_SYNC();
}
__device__ __forceinline__ void layer_prep(const Params& p, int l, int idx, int stride, char* smem) {
    constexpr int N_WIN = (NPAD / 64) * (DM / 64), N_FL = SEQ / 8, N_FC = CTXL / 8;
    for (int task = idx; task < N_FL + N_FC; task += stride) {
        if (task < N_FL) filter_task(p, l, SEQ, task * 8, smem);
        else filter_task(p, l, CTXL, (task - N_FL) * 8, smem);
    }
    __syncthreads();
    { const int tid = otid(), lane = tid & 63, wave = __builtin_amdgcn_readfirstlane(tid >> 6);
        char* wl = smem + wave * WLDS;
        for (int task = wave * stride + idx; task < N_WIN; task += 8 * stride) { const int nt = task / (DM / 64), kt = task % (DM / 64);
            convert_tile_w(p.in[I_WIN] + (size_t)l * DM * N_IN, N_IN, (bf16*)(p.ws + WS_WIN), DM, nt * 64, kt * 64, true, wl, lane); } }
}
__device__ __forceinline__ void phase_rp(const Params& p, int l, char* smem) { const int G = (int)gridDim.x, bid = obid();
    if (l == 0) { rp_rows(p, 0, 0, T, bid, G); layer_prep(p, 0, bid, G, smem); return; }
    const bool has_ctx = l < DEPTH;
    constexpr int nLatU = NB * (SEQ / PANEL_ROWS) * PANEL_UNITS, nCtxU = NB * (CTXL / PANEL_ROWS) * PANEL_UNITS;
    const int nU = nLatU + (has_ctx ? nCtxU : 0);
    const int heavy = (has_ctx && nU > G && (nU % G) != 0) ? nU % G : 0;
    int lo, hi, gi, nb;
    if (heavy > 0) { if (bid < heavy) { lo = NB * SEQ; hi = T; gi = bid; nb = heavy; } else { lo = 0; hi = NB * SEQ; gi = bid - heavy; nb = G - heavy; } }
    else { lo = 0; hi = has_ctx ? T : NB * SEQ; gi = bid; nb = G; }
    if (otid() == 0) {
#pragma unroll 1
        for (int c = 0; c < 2; ++c) { if (c == 0 ? lo >= NB * SEQ : hi <= NB * SEQ) continue;
            const unsigned target = (unsigned)((c ? nCtxU : nLatU) * l);
#ifdef EMU
            while (*(volatile unsigned*)unit_counter(p, c) < target) emu::yield();
#else
            unsigned spins = 0;
            while (__hip_atomic_load(unit_counter(p, c), __ATOMIC_RELAXED, __HIP_MEMORY_SCOPE_AGENT) < target) { __builtin_amdgcn_s_sleep(16); if (++spins > (1u << 20)) break; }
#endif
        }
#ifndef EMU
        __builtin_amdgcn_fence(__ATOMIC_ACQUIRE, "agent"); asm volatile("s_waitcnt vmcnt(0)" ::: "memory");
#endif
    }
    __syncthreads();
    rp_rows(p, l, lo, hi, gi, nb);
    if (l < DEPTH) layer_prep(p, l, G - 1 - bid, G, smem);
}

__device__ __forceinline__ cpx cmul(cpx a, cpx b) { cpx r; r.x = a.x * b.x - a.y * b.y; r.y = a.x * b.y + a.y * b.x; return r; }
__device__ __forceinline__ cpx cmulc(cpx a, cpx b) { cpx r; r.x = a.x * b.x + a.y * b.y; r.y = a.y * b.x - a.x * b.y; return r; }
constexpr int fpad(int i) { return i + (i >> 4); }
__device__ __forceinline__ int FPH(int i) { return i + (i >> 4); }
constexpr int FBUF = fpad(NF);
constexpr int ilog16(int n) { return n < 16 ? 0 : 1 + ilog16(n / 16); }
constexpr int FFT_P16 = ilog16(NF);
constexpr bool FFT_R4 = ((NF >> (4 * FFT_P16)) == 4);
static_assert((NF >> (4 * FFT_P16)) == 1 || (NF >> (4 * FFT_P16)) == 4, "NF = 16^a * (1 or 4)");
template <bool INV> __device__ __forceinline__ void dft4(cpx& a0, cpx& a1, cpx& a2, cpx& a3) {
    const cpx s = {a0.x + a2.x, a0.y + a2.y}, b = {a0.x - a2.x, a0.y - a2.y}, c = {a1.x + a3.x, a1.y + a3.y}, d = {a1.x - a3.x, a1.y - a3.y};
    a0 = (cpx){s.x + c.x, s.y + c.y}; a2 = (cpx){s.x - c.x, s.y - c.y};
    if (!INV) { a1 = (cpx){b.x + d.y, b.y - d.x}; a3 = (cpx){b.x - d.y, b.y + d.x}; }
    else      { a1 = (cpx){b.x - d.y, b.y + d.x}; a3 = (cpx){b.x + d.y, b.y - d.x}; }
}
template <bool INV> __device__ __forceinline__ cpx cmulk(cpx a, float wr, float wi) {
    cpx r; if (!INV) { r.x = a.x * wr + a.y * wi; r.y = a.y * wr - a.x * wi; } else { r.x = a.x * wr - a.y * wi; r.y = a.y * wr + a.x * wi; } return r;
}
template <bool INV> __device__ __forceinline__ void dft16(cpx (&x)[16]) {
    constexpr float C1 = 0.92387953251128674f, S1 = 0.38268343236508977f, C2 = 0.70710678118654752f;
#pragma unroll
    for (int n2 = 0; n2 < 4; ++n2) dft4<INV>(x[n2], x[4 + n2], x[8 + n2], x[12 + n2]);
    x[4 * 1 + 1] = cmulk<INV>(x[4 * 1 + 1], C1, S1); x[4 * 1 + 2] = cmulk<INV>(x[4 * 1 + 2], C2, C2); x[4 * 1 + 3] = cmulk<INV>(x[4 * 1 + 3], S1, C1);
    x[4 * 2 + 1] = cmulk<INV>(x[4 * 2 + 1], C2, C2); x[4 * 2 + 2] = cmulk<INV>(x[4 * 2 + 2], 0.f, 1.f); x[4 * 2 + 3] = cmulk<INV>(x[4 * 2 + 3], -C2, C2);
    x[4 * 3 + 1] = cmulk<INV>(x[4 * 3 + 1], S1, C1); x[4 * 3 + 2] = cmulk<INV>(x[4 * 3 + 2], -C2, C2); x[4 * 3 + 3] = cmulk<INV>(x[4 * 3 + 3], -C1, -S1);
#pragma unroll
    for (int k1 = 0; k1 < 4; ++k1) dft4<INV>(x[4 * k1 + 0], x[4 * k1 + 1], x[4 * k1 + 2], x[4 * k1 + 3]);
    cpx t;
    t = x[1]; x[1] = x[4]; x[4] = t; t = x[2]; x[2] = x[8]; x[8] = t; t = x[3]; x[3] = x[12]; x[12] = t;
    t = x[6]; x[6] = x[9]; x[9] = t; t = x[7]; x[7] = x[13]; x[13] = t; t = x[11]; x[11] = x[14]; x[14] = t;
}
template <bool INV> __device__ __forceinline__ void fft_stage16(cpx* buf, const cpx* TW, int tl, int M) {
    const int span = M >> 4, twm = NF / M;
#pragma unroll 1
    for (int j = tl; j < NF / 16; j += 256) {
        const int grp = j / span, pos = j % span, base = grp * M + pos; cpx x[16];
#pragma unroll
        for (int q = 0; q < 16; ++q) x[q] = buf[FPH(base + q * span)];
        cpx w1 = {1.f, 0.f}; if (span > 1) w1 = TW[pos * twm];
        if (INV && span > 1) { cpx wk = w1;
#pragma unroll
            for (int k = 1; k < 16; ++k) { x[k] = cmulc(x[k], wk); wk = cmul(wk, w1); } }
        dft16<INV>(x);
        if (!INV && span > 1) { cpx wk = w1;
#pragma unroll
            for (int k = 1; k < 16; ++k) { x[k] = cmul(x[k], wk); wk = cmul(wk, w1); } }
#pragma unroll
        for (int q = 0; q < 16; ++q) buf[FPH(base + q * span)] = x[q];
    }
}
template <bool INV> __device__ __forceinline__ void fft_stage4_last(cpx* buf, int tl) {
#pragma unroll 1
    for (int j = tl; j < NF / 4; j += 256) { cpx a0 = buf[FPH(4 * j)], a1 = buf[FPH(4 * j + 1)], a2 = buf[FPH(4 * j + 2)], a3 = buf[FPH(4 * j + 3)];
        dft4<INV>(a0, a1, a2, a3); buf[FPH(4 * j)] = a0; buf[FPH(4 * j + 1)] = a1; buf[FPH(4 * j + 2)] = a2; buf[FPH(4 * j + 3)] = a3; }
}
__device__ __forceinline__ void fft_fwd(cpx* buf, const cpx* TW, int tl) {
    int M = NF;
#pragma unroll
    for (int s = 0; s < FFT_P16; ++s) { __syncthreads(); fft_stage16<false>(buf, TW, tl, M); M >>= 4; }
    if (FFT_R4) { __syncthreads(); fft_stage4_last<false>(buf, tl); }
    __syncthreads();
}
__device__ __forceinline__ void fft_inv(cpx* buf, const cpx* TW, int tl) {
    if (FFT_R4) { __syncthreads(); fft_stage4_last<true>(buf, tl); }
    int M = FFT_R4 ? 64 : 16;
#pragma unroll
    for (int s = 0; s < FFT_P16; ++s) { __syncthreads(); fft_stage16<true>(buf, TW, tl, M); M <<= 4; }
    __syncthreads();
}
__device__ __forceinline__ void filt_fft_task(const Params& p, int cp, char* smem) {
    const int tid = otid(), half = tid >> 8, tl = tid & 255, c = 2 * cp + half;
    cpx* buf = (cpx*)smem + (size_t)half * FBUF;
    const float* KT = (const float*)(p.ws + WS_KT) + (size_t)c * NF;
    cpx* KF = (cpx*)(p.ws + WS_KF) + (size_t)c * NF;
    const cpx* TW = (const cpx*)(p.ws + WS_TW);
    __syncthreads();
    for (int i = tl; i < NF; i += 256) { cpx v; v.x = KT[i]; v.y = 0.f; buf[FPH(i)] = v; }
    fft_fwd(buf, TW, tl);
    for (int i = tl; i < NF; i += 256) KF[i] = buf[FPH(i)];
}

__device__ __forceinline__ void gemm_tile(const Params& p, const bf16* A, const bf16* Bt, int K, int mt, int nt, int mode, char* smem) {
    const int tid = otid(), lane = tid & 63, wave = tid >> 6;
    bf16* As = (bf16*)smem;
    bf16* Bs = As + 128 * LS;
    const int wm = (wave & 3) * 32, wn = (wave >> 2) * 64;
    f32x4 acc[2][4];
#pragma unroll
    for (int i = 0; i < 2; ++i)
#pragma unroll
        for (int j = 0; j < 4; ++j) acc[i][j] = (f32x4){0.f, 0.f, 0.f, 0.f};
    const int lr = tid >> 3, lc = tid & 7;
    const bf16* Ag = A + (size_t)(mt * 128 + lr) * K + lc * 8;
    const bf16* Bg = Bt + (size_t)(nt * 128 + lr) * K + lc * 8;
    u32x4 ra0, ra1, rb0, rb1;
    ra0 = *(const u32x4*)(Ag); ra1 = *(const u32x4*)(Ag + (size_t)64 * K); rb0 = *(const u32x4*)(Bg); rb1 = *(const u32x4*)(Bg + (size_t)64 * K);
    const int nk = K / 64;
    for (int kt = 0; kt < nk; ++kt) {
        __syncthreads();
        *(u32x4*)(As + lr * LS + lc * 8) = ra0; *(u32x4*)(As + (lr + 64) * LS + lc * 8) = ra1;
        *(u32x4*)(Bs + lr * LS + lc * 8) = rb0; *(u32x4*)(Bs + (lr + 64) * LS + lc * 8) = rb1;
        __syncthreads();
        if (kt + 1 < nk) { const int ko = (kt + 1) * 64;
            ra0 = *(const u32x4*)(Ag + ko); ra1 = *(const u32x4*)(Ag + (size_t)64 * K + ko); rb0 = *(const u32x4*)(Bg + ko); rb1 = *(const u32x4*)(Bg + (size_t)64 * K + ko); }
        mma_nt<4, 2>(As, LS, wm, Bs, LS, wn, acc[0], lane);
        mma_nt<4, 2>(As, LS, wm + 16, Bs, LS, wn, acc[1], lane);
    }
    const int r = lane & 15, q = lane >> 4;
#pragma unroll
    for (int i = 0; i < 2; ++i)
#pragma unroll
        for (int j = 0; j < 4; ++j)
#pragma unroll
            for (int e = 0; e < 4; ++e) {
                const int row = mt * 128 + wm + 16 * i + 4 * q + e, col = nt * 128 + wn + 16 * j + r; const float v = acc[i][j][e];
                if (mode == 0) { if (col < NP) ((bf16*)(p.ws + WS_P))[(size_t)row * NP + col] = f2bf(v); else if (col < NP + 16) ((float*)(p.ws + WS_G))[(size_t)row * NGS + (col - NP)] = v; else if (col < NP + NG) ((bf16*)((float*)(p.ws + WS_G) + (size_t)row * NGS + 16))[col - NP - 16] = f2bf(v); }
                else if (mode == 2) ((bf16*)(p.ws + WS_HT))[(size_t)row * T + col] = f2bf(v);
                else ((bf16*)(p.ws + WS_P))[(size_t)row * DM + col] = f2bf(v);
            }
}

#ifndef EMU
namespace pg8 {
#define PG8_LAS __attribute__((address_space(3)))
typedef unsigned short bf16_t;
typedef short bf16x8 __attribute__((ext_vector_type(8)));
typedef float f32x4 __attribute__((ext_vector_type(4)));
typedef unsigned u32x4 __attribute__((ext_vector_type(4)));
constexpr int BM = 256, BK = 64, HALF = 128, HTB = HALF * BK * 2  , STAGE_BYTES = 8 * HTB, NXCD = 8, WGM = 8;

__host__ __device__ __forceinline__ int lds_byte(int r, int c) { const int st = (r >> 4) * 2 + (c >> 5), rr = r & 15, cc = c & 31, ob = rr * 64 + cc * 2; return st * 1024 + (ob ^ (((ob >> 9) & 1) << 5)); }
__host__ __device__ __forceinline__ void stage_rc(int b, int& R, int& C) { const int st = b / 1024, sb = b % 1024, swz = sb ^ (((sb >> 9) & 1) << 5); R = (st >> 1) * 16 + swz / 64; C = (st & 1) * 32 + (swz % 64) / 2; }
__host__ __device__ __forceinline__ int perm32(int rho) { const int n = rho >> 4, i = rho & 15; return 8 * (i >> 2) + 4 * n + (i & 3); }

struct Unit { int pm, pn; };
struct Gemm { const bf16_t* A; const bf16_t* Bt; int M, N, K; };
__device__ __forceinline__ unsigned cvt_pk_bf16(float lo, float hi) { unsigned r; asm volatile("v_cvt_pk_bf16_f32 %0, %1, %2" : "=v"(r) : "v"(lo), "v"(hi)); return r; }
template <class Epi, class Sched, bool ALIGN_EPI = false, bool SP2 = false>
__device__ __forceinline__ void gemm_phase(PG8_LAS unsigned char* lds, const Gemm g, const Sched& S, const Epi& E) {
    const int tid = otid(), wid = __builtin_amdgcn_readfirstlane(tid >> 6), lane = tid & 63, wr = wid >> 2, wc = wid & 3, fr = lane & 15, fq = lane >> 4;
    const int K = g.K, nt = K / BK;
    unsigned voffA[2], voffB[2];
#pragma unroll
    for (int i = 0; i < 2; ++i) { int R, C; stage_rc(tid * 16 + i * 8192, R, C); const int Rb = Epi::PERM ? ((R & ~31) + perm32(R & 31)) : R;
        voffA[i] = (unsigned)(R * K + C) * 2u; voffB[i] = (unsigned)(Rb * K + C) * 2u; }
    const size_t kstep = (size_t)(BK * 2);
    const size_t hstep = (size_t)HALF * K * 2;
    const size_t tstep = 2 * hstep;
    const unsigned ldsw = (unsigned)wid * 1024u;
    const int aoff = lds_byte(wr * 64 + fr, fq * 8), boff = lds_byte(wc * 32 + fr, fq * 8);
#define PG8_SA(b, h) (((b) * 2 + (h)) * HTB)
#define PG8_SB(b, h) ((4 + (b) * 2 + (h)) * HTB)
#define PG8_STAGE(bufoff, gbase, voff) do { _Pragma("unroll") for (int _i = 0; _i < 2; ++_i) \
        __builtin_amdgcn_global_load_lds((const unsigned*)((const char*)(gbase) + (voff)[_i]), (PG8_LAS unsigned*)(lds + (bufoff) + ldsw + _i * 8192), 16, 0, 0); } while (0)
#define PG8_LDA(dst, b, h) do { _Pragma("unroll") for (int m = 0; m < 4; ++m) _Pragma("unroll") for (int k = 0; k < 2; ++k) dst[m][k] = *(const PG8_LAS bf16x8*)(lds + PG8_SA(b, h) + aoff + m * 2048 + k * 1024); } while (0)
#define PG8_LDB(dst, b, h) do { _Pragma("unroll") for (int n = 0; n < 2; ++n) _Pragma("unroll") for (int k = 0; k < 2; ++k) dst[n][k] = *(const PG8_LAS bf16x8*)(lds + PG8_SB(b, h) + boff + n * 2048 + k * 1024); } while (0)
#define PG8_MMA(ai, bj, At, Bt) do { __builtin_amdgcn_s_setprio(1); _Pragma("unroll") for (int m = 0; m < 4; ++m) _Pragma("unroll") for (int n = 0; n < 2; ++n) _Pragma("unroll") for (int k = 0; k < 2; ++k) \
        acc[ai][bj][m][n] = __builtin_amdgcn_mfma_f32_16x16x32_bf16(Bt[n][k], At[m][k], acc[ai][bj][m][n], 0, 0, 0); __builtin_amdgcn_s_setprio(0); } while (0)
#define PG8_WAIT_V(n) asm volatile("s_waitcnt vmcnt(" #n ")" ::: "memory")
#define PG8_WAIT_L(n) asm volatile("s_waitcnt lgkmcnt(" #n ")" ::: "memory")
#define PG8_BAR __builtin_amdgcn_s_barrier()
#define PG8_SCHED __builtin_amdgcn_sched_barrier(0)
    Unit cur, nxt; int ui = 0;
    if (!S.next(0, cur)) return;
    f32x4 acc[2][2][4][2];
#pragma unroll
    for (int a = 0; a < 2; ++a)
#pragma unroll
        for (int b = 0; b < 2; ++b)
#pragma unroll
            for (int m = 0; m < 4; ++m)
#pragma unroll
                for (int n = 0; n < 2; ++n) acc[a][b][m][n] = (f32x4){0.f, 0.f, 0.f, 0.f};
    bf16x8 At[4][2], B0[2][2], B1[2][2];
    const char* cA = (const char*)g.A + (size_t)cur.pm * tstep; const char* cB = (const char*)g.Bt + (size_t)cur.pn * tstep;
    S.a_ready(cur);
    if constexpr (SP2) {
        PG8_STAGE(PG8_SB(0, 0), cB, voffB); PG8_STAGE(PG8_SB(0, 1), cB + hstep, voffB); PG8_STAGE(PG8_SA(0, 0), cA, voffA); PG8_STAGE(PG8_SA(0, 1), cA + hstep, voffA);
        if (wr == 1) PG8_BAR;
        PG8_WAIT_V(2); PG8_BAR;
        PG8_STAGE(PG8_SB(1, 0), cB + kstep, voffB); PG8_STAGE(PG8_SA(1, 0), cA + kstep, voffA); PG8_STAGE(PG8_SB(1, 1), cB + hstep + kstep, voffB);
        PG8_WAIT_V(6); PG8_BAR;
    } else {
        PG8_STAGE(PG8_SB(0, 0), cB, voffB); PG8_STAGE(PG8_SA(0, 0), cA, voffA); PG8_STAGE(PG8_SB(0, 1), cB + hstep, voffB); PG8_STAGE(PG8_SA(0, 1), cA + hstep, voffA);
        if (wr == 1) PG8_BAR;
        PG8_WAIT_V(4); PG8_BAR;
        PG8_STAGE(PG8_SB(1, 0), cB + kstep, voffB); PG8_STAGE(PG8_SA(1, 0), cA + kstep, voffA); PG8_STAGE(PG8_SB(1, 1), cB + hstep + kstep, voffB);
        PG8_WAIT_V(6); PG8_BAR;
    }
    for (;;) {
        const bool has_next = S.next(ui + 1, nxt);
        const char* nA = has_next ? (const char*)g.A + (size_t)nxt.pm * tstep : cA; const char* nB = has_next ? (const char*)g.Bt + (size_t)nxt.pn * tstep : cB;
        for (int t = 0; t < nt; t += 2) {
            const bool last = (t == nt - 2);
            const char* a1 = cA + (size_t)(t + 1) * kstep;
            const char* a2 = last ? nA : cA + (size_t)(t + 2) * kstep; const char* b2 = last ? nB : cB + (size_t)(t + 2) * kstep;
            const char* a3 = a2 + kstep; const char* b3 = b2 + kstep;
            if (last && has_next) S.a_ready(nxt);
            if constexpr (SP2) {
            PG8_LDB(B0, 0, 0); PG8_LDB(B1, 0, 1); PG8_SCHED; PG8_LDA(At, 0, 0); PG8_STAGE(PG8_SA(1, 1), a1 + hstep, voffA);
            PG8_WAIT_V(8); PG8_WAIT_L(0); PG8_BAR; PG8_MMA(0, 0, At, B0); PG8_MMA(0, 1, At, B1); PG8_BAR; PG8_SCHED;
            PG8_LDA(At, 0, 1); PG8_STAGE(PG8_SB(0, 0), b2, voffB); PG8_STAGE(PG8_SB(0, 1), b2 + hstep, voffB); PG8_STAGE(PG8_SA(0, 0), a2, voffA);
            PG8_WAIT_V(8); PG8_WAIT_L(0); PG8_BAR; PG8_MMA(1, 0, At, B0); PG8_MMA(1, 1, At, B1); PG8_BAR; PG8_SCHED;
            PG8_LDB(B0, 1, 0); PG8_LDB(B1, 1, 1); PG8_SCHED; PG8_LDA(At, 1, 0); PG8_STAGE(PG8_SA(0, 1), a2 + hstep, voffA);
            PG8_WAIT_V(8); PG8_WAIT_L(0); PG8_BAR; PG8_MMA(0, 0, At, B0); PG8_MMA(0, 1, At, B1); PG8_BAR; PG8_SCHED;
            PG8_LDA(At, 1, 1); PG8_STAGE(PG8_SB(1, 0), b3, voffB); PG8_STAGE(PG8_SB(1, 1), b3 + hstep, voffB); PG8_STAGE(PG8_SA(1, 0), a3, voffA);
            PG8_WAIT_V(8); PG8_WAIT_L(0); PG8_BAR; PG8_MMA(1, 0, At, B0); PG8_MMA(1, 1, At, B1); PG8_BAR; PG8_SCHED;
            } else {
            PG8_LDB(B0, 0, 0); PG8_SCHED; PG8_LDA(At, 0, 0); PG8_STAGE(PG8_SA(1, 1), a1 + hstep, voffA);
            PG8_WAIT_L(8); PG8_BAR; PG8_WAIT_L(0); PG8_MMA(0, 0, At, B0); PG8_BAR; PG8_SCHED;
            PG8_LDB(B1, 0, 1); PG8_STAGE(PG8_SB(0, 0), b2, voffB);
            PG8_BAR; PG8_WAIT_L(0); PG8_MMA(0, 1, At, B1); PG8_BAR;
            PG8_LDA(At, 0, 1); PG8_STAGE(PG8_SA(0, 0), a2, voffA);
            PG8_BAR; PG8_WAIT_L(0); PG8_MMA(1, 0, At, B0); PG8_BAR; PG8_SCHED;
            PG8_STAGE(PG8_SB(0, 1), b2 + hstep, voffB);
            PG8_WAIT_V(6); PG8_BAR; PG8_MMA(1, 1, At, B1); PG8_BAR;
            PG8_LDB(B0, 1, 0); PG8_SCHED; PG8_LDA(At, 1, 0); PG8_STAGE(PG8_SA(0, 1), a2 + hstep, voffA);
            PG8_WAIT_L(8); PG8_BAR; PG8_WAIT_L(0); PG8_MMA(0, 0, At, B0); PG8_BAR; PG8_SCHED;
            PG8_LDB(B1, 1, 1); PG8_STAGE(PG8_SB(1, 0), b3, voffB);
            PG8_BAR; PG8_WAIT_L(0); PG8_MMA(0, 1, At, B1); PG8_BAR;
            PG8_LDA(At, 1, 1); PG8_STAGE(PG8_SA(1, 0), a3, voffA);
            PG8_BAR; PG8_WAIT_L(0); PG8_MMA(1, 0, At, B0); PG8_BAR; PG8_SCHED;
            PG8_STAGE(PG8_SB(1, 1), b3 + hstep, voffB);
            PG8_WAIT_V(6); PG8_BAR; PG8_MMA(1, 1, At, B1); PG8_BAR;
            }
        }
        if constexpr (ALIGN_EPI) { if (wr == 0) PG8_BAR; }
        if constexpr (!Epi::AFTER_DRAIN) { E(acc, cur, wr, wc, fr, fq); S.done(cur); }
        if (!has_next) break;
#pragma unroll
        for (int a = 0; a < 2; ++a)
#pragma unroll
            for (int b = 0; b < 2; ++b)
#pragma unroll
                for (int m = 0; m < 4; ++m)
#pragma unroll
                    for (int n = 0; n < 2; ++n) acc[a][b][m][n] = (f32x4){0.f, 0.f, 0.f, 0.f};
        cur = nxt; cA = nA; cB = nB; ++ui;
        if constexpr (ALIGN_EPI) { if (wr == 1) PG8_BAR; }
    }
    PG8_WAIT_V(0);
    if constexpr (!ALIGN_EPI) { if (wr == 0) PG8_BAR; }
    PG8_BAR;
    if constexpr (Epi::AFTER_DRAIN) { E.fused(acc, cur, wr, wc, fr, fq, lds, wid, lane); S.done(cur); }
#undef PG8_SA
#undef PG8_SB
#undef PG8_STAGE
#undef PG8_LDA
#undef PG8_LDB
#undef PG8_MMA
#undef PG8_WAIT_V
#undef PG8_WAIT_L
#undef PG8_BAR
#undef PG8_SCHED
}
__device__ __forceinline__ void map_tile(int L, int nM, int nN, int& pm, int& pn) {
    const int nwg = nM * nN; int wgid = L; { const int q = nwg / NXCD, r = nwg % NXCD, xcd = wgid % NXCD, off = wgid / NXCD; wgid = (xcd < r ? xcd * (q + 1) : r * (q + 1) + (xcd - r) * q) + off; }
    const int nig = WGM * nN, gid = wgid / nig, fm = gid * WGM, gsz = (nM - fm) < WGM ? (nM - fm) : WGM;
    pm = fm + ((wgid % nig) % gsz); pn = (wgid % nig) / gsz;
}
constexpr int MP = T / 256, WP = NMAIN / 256, NU2 = 4 * MP, NU1 = MP * WP;
struct InOrder { int G, c;
    __device__ __forceinline__ bool next(int i, Unit& u) const { const int L = i * G + c; if (L >= NU2 + NU1) return false; int a, b;
        if (L < NU2) { map_tile(L, 4, MP, a, b); u.pm = MP + WP + a; u.pn = b; } else { map_tile(L - NU2, MP, WP, a, b); u.pm = a; u.pn = MP + b; } return true; }
    __device__ __forceinline__ void a_ready(const Unit&) const {}
    __device__ __forceinline__ void done(const Unit&) const {}
};
struct EpiIn { static constexpr bool PERM = true, AFTER_DRAIN = false; bf16_t* P; float* G; bf16_t* HTp;
    __device__ __forceinline__ void operator()(const f32x4 (&acc)[2][2][4][2], const Unit& u, int wr, int wc, int fr, int fq) const {
        if (u.pm < MP) { const int pn = u.pn - MP, row0 = u.pm * BM + wr * 64 + fr;
            if (pn < NP / 256) { const int col0 = pn * BM + wc * 32 + 8 * fq;
#pragma unroll
                for (int ai = 0; ai < 2; ++ai)
#pragma unroll
                    for (int m = 0; m < 4; ++m) { bf16_t* rowp = P + (size_t)(row0 + ai * HALF + m * 16) * NP + col0;
#pragma unroll
                        for (int bj = 0; bj < 2; ++bj) { const f32x4 v0 = acc[ai][bj][m][0], v1 = acc[ai][bj][m][1];
                            u32x4 w; w.x = cvt_pk_bf16(v0[0], v0[1]); w.y = cvt_pk_bf16(v0[2], v0[3]); w.z = cvt_pk_bf16(v1[0], v1[1]); w.w = cvt_pk_bf16(v1[2], v1[3]); *(u32x4*)(rowp + bj * HALF) = w; } } }
            else { const int cb = wc * 32 + 8 * fq;
                if (cb < NG) {
#pragma unroll
                    for (int ai = 0; ai < 2; ++ai)
#pragma unroll
                        for (int m = 0; m < 4; ++m) { float* rowb = G + (size_t)(row0 + ai * HALF + m * 16) * NGS; const f32x4 v0 = acc[ai][0][m][0], v1 = acc[ai][0][m][1];
                            if (cb < 16) { *(f32x4*)(rowb + cb) = v0; *(f32x4*)(rowb + cb + 4) = v1; }
                            else { u32x4 w; w.x = cvt_pk_bf16(v0[0], v0[1]); w.y = cvt_pk_bf16(v0[2], v0[3]); w.z = cvt_pk_bf16(v1[0], v1[1]); w.w = cvt_pk_bf16(v1[2], v1[3]); *(u32x4*)((bf16_t*)(rowb + 16) + (cb - 16)) = w; } } } } }
        else { const int row0 = (u.pm - MP - WP) * BM + wr * 64 + fr, col0 = u.pn * BM + wc * 32 + 8 * fq;
#pragma unroll
            for (int ai = 0; ai < 2; ++ai)
#pragma unroll
                for (int m = 0; m < 4; ++m) { bf16_t* rowp = HTp + (size_t)(row0 + ai * HALF + m * 16) * T + col0;
#pragma unroll
                    for (int bj = 0; bj < 2; ++bj) { const f32x4 v0 = acc[ai][bj][m][0], v1 = acc[ai][bj][m][1];
                        u32x4 w; w.x = cvt_pk_bf16(v0[0], v0[1]); w.y = cvt_pk_bf16(v0[2], v0[3]); w.z = cvt_pk_bf16(v1[0], v1[1]); w.w = cvt_pk_bf16(v1[2], v1[3]); *(u32x4*)(rowp + bj * HALF) = w; } } }
    }
};
struct OutOrder { int G, c; bool lat_only; unsigned* cnt;
    __device__ __forceinline__ bool next(int i, Unit& u) const { constexpr int nN = DM / 256, nLat = NB * (SEQ / 256) * nN, nCtx = NB * (CTXL / 256) * nN; const int L = i * G + c; int a, b;
        if (L < nLat) { map_tile(L, nLat / nN, nN, a, b); u.pm = (a / (SEQ / 256)) * (TOK / 256) + CTXL / 256 + a % (SEQ / 256); }
        else { if (lat_only || L >= nLat + nCtx) return false; map_tile(L - nLat, nCtx / nN, nN, a, b); u.pm = (a / (CTXL / 256)) * (TOK / 256) + a % (CTXL / 256); }
        u.pn = b; return true; }
    __device__ __forceinline__ void a_ready(const Unit&) const {}
    unsigned* xu; unsigned nloc, xtarget;
    __device__ __forceinline__ void done(const Unit& u) const {
        asm volatile("s_waitcnt vmcnt(0)" ::: "memory"); __builtin_amdgcn_s_barrier();
        if (threadIdx.x == 0) { const bool isctx = (u.pm % (TOK / 256)) < CTXL / 256;
            if (!isctx && xtarget != 0u) {
                const unsigned old = __hip_atomic_fetch_add(xu, 1u, __ATOMIC_RELAXED, __HIP_MEMORY_SCOPE_AGENT);
                if (old + 1u == xtarget) { __builtin_amdgcn_fence(__ATOMIC_RELEASE, "agent"); asm volatile("s_waitcnt vmcnt(0)" ::: "memory");
                    __hip_atomic_fetch_add(cnt, nloc, __ATOMIC_RELAXED, __HIP_MEMORY_SCOPE_AGENT); } }
            else { __builtin_amdgcn_fence(__ATOMIC_RELEASE, "agent"); asm volatile("s_waitcnt vmcnt(0)" ::: "memory");
                __hip_atomic_fetch_add(cnt + (isctx ? 64 : 0), 1u, __ATOMIC_RELAXED, __HIP_MEMORY_SCOPE_AGENT); } } }
};
struct EpiOut { static constexpr bool PERM = true, AFTER_DRAIN = false; bf16_t* C;
    __device__ __forceinline__ void operator()(const f32x4 (&acc)[2][2][4][2], const Unit& u, int wr, int wc, int fr, int fq) const {
        const int row0 = u.pm * BM + wr * 64 + fr, col0 = u.pn * BM + wc * 32 + 8 * fq;
#pragma unroll
        for (int ai = 0; ai < 2; ++ai)
#pragma unroll
            for (int m = 0; m < 4; ++m) { bf16_t* rowp = C + (size_t)(row0 + ai * HALF + m * 16) * DM + col0;
#pragma unroll
                for (int bj = 0; bj < 2; ++bj) { const f32x4 v0 = acc[ai][bj][m][0], v1 = acc[ai][bj][m][1];
                    u32x4 w; w.x = cvt_pk_bf16(v0[0], v0[1]); w.y = cvt_pk_bf16(v0[2], v0[3]); w.z = cvt_pk_bf16(v1[0], v1[1]); w.w = cvt_pk_bf16(v1[2], v1[3]); *(u32x4*)(rowp + bj * HALF) = w; } }
    }
};
}
#endif

__device__ __forceinline__ void phase_gemm_in(const Params& p, int l, char* smem) {
    constexpr int N_F = WG / 2;
#ifdef EMU
    constexpr int MT = T / 128, NT1 = NMAIN / 128, N1 = MT * NT1, N2 = 8 * MT;
    for (int task = obid(); task < N1 + N2; task += gridDim.x) {
        if (task < N1) gemm_tile(p, (const bf16*)(p.ws + WS_HNY), (const bf16*)(p.ws + WS_WIN), DM, task / NT1, task % NT1, 0, smem);
        else { const int t2 = task - N1; gemm_tile(p, (const bf16*)(p.ws + WS_WIN) + (size_t)NMAIN * DM, (const bf16*)(p.ws + WS_HNY), DM, t2 / MT, t2 % MT, 2, smem); }
    }
#else
    { const pg8::Gemm g{(const pg8::bf16_t*)(p.ws + WS_HNY), (const pg8::bf16_t*)(p.ws + WS_HNY), 0, 0, DM};
      const pg8::InOrder S{(int)gridDim.x, obid()};
      const pg8::EpiIn E{(pg8::bf16_t*)(p.ws + WS_P), (float*)(p.ws + WS_G), (pg8::bf16_t*)(p.ws + WS_HT)};
      pg8::gemm_phase<pg8::EpiIn, pg8::InOrder, true, true>((PG8_LAS unsigned char*)smem, g, S, E); }
#endif
    { const int G = (int)gridDim.x, bid = obid();
#ifdef EMU
      const int extra = 0;
#else
      const int extra = (pg8::NU1 + pg8::NU2) % G;
#endif
      if (extra > 0 && extra < G) { if (bid >= extra) for (int task = bid - extra; task < N_F; task += G - extra) filt_fft_task(p, task, smem); }
      else for (int task = G - 1 - bid; task < N_F; task += G) filt_fft_task(p, task, smem); }
}
__device__ __forceinline__ void phase_gemm_out(const Params& p, int l, char* smem) {
    const int G = (int)gridDim.x, bid = obid(); const bool has_ctx = l < DEPTH - 1;
#ifdef EMU
    constexpr int MT = T / 128, NTO = DM / 128;
    for (int task = bid; task < MT * NTO; task += G) {
        const int mt = task / NTO, nt = task % NTO;
        if (!has_ctx && (mt % (TOK / 128)) < CTXL / 128) continue;
        gemm_tile(p, (const bf16*)(p.ws + WS_HNY), (const bf16*)(p.ws + WS_WOUT), MIX, mt, nt, 1, smem);
        __syncthreads(); if (otid() == 0) *unit_counter(p, (mt % (TOK / 128)) < CTXL / 128 ? 1 : 0) += 1u;
    }
#else
    const pg8::Gemm g{(const pg8::bf16_t*)(p.ws + WS_HNY), (const pg8::bf16_t*)(p.ws + WS_WOUT), 0, 0, MIX};
    const unsigned xcc = (unsigned)__builtin_amdgcn_s_getreg((3 << 11) | 20) & 0xFu, nloc = ((volatile PG8_LAS unsigned*)(smem + LDS_BYTES - 64))[0];
    const bool agg = (NB * (SEQ / 256) * (DM / 256) == G) && nloc > 0u;
    const pg8::OutOrder S{G, bid, !has_ctx, unit_counter(p, 0), unit_counter(p, 2) + 16 * xcc, nloc, agg ? nloc * (unsigned)(l + 1) : 0u};
    const pg8::EpiOut E{(pg8::bf16_t*)(p.ws + WS_P)};
    pg8::gemm_phase<pg8::EpiOut, pg8::OutOrder, true, true>((PG8_LAS unsigned char*)smem, g, S, E);
#endif
}

__device__ __forceinline__ size_t st_index(int mixer, int dir, int b, int h, int cid) { return ((((size_t)(mixer * 2 + dir) * NB + b) * NH + h) * NCH + cid); }
__device__ __forceinline__ size_t ch_index(int dir, int b, int h, int cid) { return (((size_t)dir * NB + b) * NH + h) * NCH + cid; }

__device__ __forceinline__ void load_tile_nat(const bf16* P, int r0, int c0, bf16* dst, float scale, int tid) {
    const int s = tid >> 3, c8 = tid & 7;
    const u32x4 v = *(const u32x4*)(P + (size_t)(r0 + s) * NP + c0 + c8 * 8);
    if (scale == 1.0f) *(u32x4*)(dst + s * LS + c8 * 8) = v;
    else { float f[8]; unpack8(v, f); u32x4 o; o.x = pk2(f[0] * scale, f[1] * scale); o.y = pk2(f[2] * scale, f[3] * scale); o.z = pk2(f[4] * scale, f[5] * scale); o.w = pk2(f[6] * scale, f[7] * scale);
        *(u32x4*)(dst + s * LS + c8 * 8) = o; }
}
__device__ __forceinline__ void load_tile_tr(const bf16* P, int r0, int c0, bf16* dst, int tid) {
    const int s = tid >> 3, c8 = tid & 7;
    const u32x4 v = *(const u32x4*)(P + (size_t)(r0 + s) * NP + c0 + c8 * 8);
    const unsigned w[4] = {v.x, v.y, v.z, v.w};
#pragma unroll
    for (int j = 0; j < 4; ++j) { dst[(c8 * 8 + 2 * j) * LS + s] = (bf16)(w[j] & 0xffffu); dst[(c8 * 8 + 2 * j + 1) * LS + s] = (bf16)(w[j] >> 16); }
}

template <int NTK>
__device__ __forceinline__ void load_span(const bf16* row, int t0, float (&v)[NTK + 2]) {
    v[0] = t0 > 0 ? bf2f(row[-1]) : 0.f; v[NTK + 1] = (t0 + NTK < SEQ) ? bf2f(row[NTK]) : 0.f;
    if constexpr (NTK == 8) { float f[8]; unpack8(*(const u32x4*)row, f);
#pragma unroll
        for (int i = 0; i < 8; ++i) v[1 + i] = f[i]; }
    else {
#pragma unroll
        for (int i = 0; i < NTK; ++i) v[1 + i] = bf2f(row[i]); }
}
template <int NTK>
__device__ __forceinline__ void hy_inputs(const bf16* h0, const bf16* h1, const float* cw, const float* cb, int c, int t0, float (&u0)[NTK], float (&u1)[NTK], float (&g0)[NTK], float (&g1)[NTK]) {
    { float xa[NTK + 2], xb[NTK + 2]; load_span<NTK>(h0 + (size_t)512 * T, t0, xa); load_span<NTK>(h1 + (size_t)512 * T, t0, xb);
        const float w0 = cw[0 * 768 + 512 + c], w1 = cw[1 * 768 + 512 + c], w2 = cw[2 * 768 + 512 + c], bb = cb[512 + c];
        float ga[NTK + 2], gb[NTK + 2]; load_span<NTK>(h0 + (size_t)768 * T, t0, ga); load_span<NTK>(h1 + (size_t)768 * T, t0, gb);
#pragma unroll
        for (int i = 0; i < NTK; ++i) { g0[i] = (w0 * xa[i] + w1 * xa[i + 1] + w2 * xa[i + 2] + bb) * siluf_(ga[i + 1]); g1[i] = (w0 * xb[i] + w1 * xb[i + 1] + w2 * xb[i + 2] + bb) * siluf_(gb[i + 1]); } }
    { float va[NTK + 2], vb[NTK + 2], ya[NTK + 2], yb[NTK + 2];
        load_span<NTK>(h0, t0, va); load_span<NTK>(h1, t0, vb); load_span<NTK>(h0 + (size_t)256 * T, t0, ya); load_span<NTK>(h1 + (size_t)256 * T, t0, yb);
        const float v0 = cw[0 * 768 + c], v1 = cw[1 * 768 + c], v2 = cw[2 * 768 + c], vbias = cb[c];
        const float y0 = cw[0 * 768 + 256 + c], y1 = cw[1 * 768 + 256 + c], y2 = cw[2 * 768 + 256 + c], ybias = cb[256 + c];
#pragma unroll
        for (int i = 0; i < NTK; ++i) { u0[i] = (v0 * va[i] + v1 * va[i + 1] + v2 * va[i + 2] + vbias) * (y0 * ya[i] + y1 * ya[i + 1] + y2 * ya[i + 2] + ybias);
            u1[i] = (v0 * vb[i] + v1 * vb[i + 1] + v2 * vb[i + 2] + vbias) * (y0 * yb[i] + y1 * yb[i + 1] + y2 * yb[i + 2] + ybias); } }
}
__device__ __forceinline__ void hylat_task(const Params& p, int l, int bp, int cp, char* smem) {
    const int tid = otid(), half = tid >> 8, tl = tid & 255, c = 2 * cp + half;
    const bf16* HT = (const bf16*)(p.ws + WS_HT); bf16* Y = (bf16*)(p.ws + WS_HNY);
    cpx* buf = (cpx*)smem + (size_t)half * FBUF;
    const cpx* TW = (const cpx*)(p.ws + WS_TW);
    const cpx* KF = (const cpx*)(p.ws + WS_KF) + (size_t)c * NF;
    constexpr int NTK = SEQ / 256;
    const int t0 = NTK * tl;
    const float* cw = p.in[I_HCW] + (size_t)l * 3 * 768; const float* cb = p.in[I_HCB] + (size_t)l * 768;
    const size_t rb0 = (size_t)(2 * bp) * TOK + CTXL, rb1 = rb0 + TOK;
    const bf16* h0 = HT + (size_t)c * T + rb0 + t0; const bf16* h1 = h0 + TOK;
    { float u0[NTK], u1[NTK], g0[NTK], g1[NTK]; hy_inputs<NTK>(h0, h1, cw, cb, c, t0, u0, u1, g0, g1);
        __syncthreads();
#pragma unroll
        for (int i = 0; i < NTK; ++i) { cpx v; v.x = u0[i]; v.y = u1[i]; buf[FPH(t0 + i)] = v; cpx z = {0.f, 0.f}; buf[FPH(SEQ + t0 + i)] = z; } }
    fft_fwd(buf, TW, tl);
#pragma unroll 2
    for (int i = tl; i < NF; i += 256) buf[FPH(i)] = cmul(buf[FPH(i)], KF[i]);
    fft_inv(buf, TW, tl);
    const float dsk = p.in[I_HD][(size_t)l * WG + c]; const float sc = 1.0f / (float)NF;
    { const int tz = otid() & 255; const int t0z = NTK * tz;
        float u0[NTK], u1[NTK], g0[NTK], g1[NTK]; hy_inputs<NTK>(HT + (size_t)c * T + rb0 + t0z, HT + (size_t)c * T + rb0 + t0z + TOK, cw, cb, c, t0z, u0, u1, g0, g1);
        float o0[NTK], o1[NTK];
#pragma unroll
        for (int i = 0; i < NTK; ++i) { const cpx y = buf[FPH(t0z + i)]; o0[i] = g0[i] * (y.x * sc + u0[i] * dsk); o1[i] = g1[i] * (y.y * sc + u1[i] * dsk); }
        bf16* d0 = (bf16*)(p.ws + WS_HT) + (size_t)(768 + c) * T + rb0 + t0z; bf16* d1 = d0 + TOK;
        if constexpr (NTK == 8) { *(u32x4*)d0 = pack8(o0); *(u32x4*)d1 = pack8(o1); }
        else {
#pragma unroll
            for (int i = 0; i < NTK; ++i) { d0[i] = f2bf(o0[i]); d1[i] = f2bf(o1[i]); } } }
}

constexpr int HCB = 16;
__device__ __forceinline__ void hyctx_task(const Params& p, int l, int b, int cblk, char* smem) {
    const int tid = otid(); const int c0 = cblk * HCB;
    const bf16* HT = (const bf16*)(p.ws + WS_HT); bf16* Y = (bf16*)(p.ws + WS_HNY); const float* HC = (const float*)(p.ws + WS_HC);
    float* raw = (float*)smem;
    float* u = raw + 4 * CTXL * HCB;
    float* og = u + CTXL * HCB;
    float* hcm = og + CTXL * HCB;
    bf16* ob = (bf16*)raw;
    const size_t rb = (size_t)b * TOK;
    const float* cw = p.in[I_HCW] + (size_t)l * 3 * 768; const float* cbias = p.in[I_HCB] + (size_t)l * 768;
    constexpr int WT = CTXL / 32;
    __syncthreads();
    for (int i = tid; i < 4 * HCB * (CTXL / 8); i += NT) { const int k = i / (HCB * (CTXL / 8)), cc = (i / (CTXL / 8)) % HCB, ck = i % (CTXL / 8);
        float f[8]; unpack8(*(const u32x4*)(HT + (size_t)(k * 256 + c0 + cc) * T + rb + ck * 8), f);
#pragma unroll
        for (int j = 0; j < 8; ++j) raw[(k * CTXL + ck * 8 + j) * HCB + cc] = f[j]; }
    for (int i = tid; i < 2 * HCB * (CTXL / 4); i += NT) { const int dir = i / (HCB * (CTXL / 4)), cc = (i / (CTXL / 4)) % HCB, pk = i % (CTXL / 4);
        const f32x4 v = *(const f32x4*)(HC + ((size_t)dir * WG + c0 + cc) * CTXL + pk * 4); const float f[4] = {v.x, v.y, v.z, v.w};
#pragma unroll
        for (int j = 0; j < 4; ++j) { const int pos = pk * 4 + j; if (dir == 0) hcm[(CTXL + pos) * HCB + cc] = f[j]; else if (pos > 0) hcm[(CTXL - pos) * HCB + cc] = f[j]; } }
    if (tid < HCB) hcm[tid] = 0.f;
    __syncthreads();
    for (int i = tid; i < CTXL * HCB; i += NT) { const int t = i / HCB, cc = i % HCB; float cv[3];
#pragma unroll
        for (int k = 0; k < 3; ++k) { const float* rk = raw + k * CTXL * HCB; const int ch = k * 256 + c0 + cc;
            const float a = t > 0 ? rk[(t - 1) * HCB + cc] : 0.f, m = rk[t * HCB + cc], z = t < CTXL - 1 ? rk[(t + 1) * HCB + cc] : 0.f;
            cv[k] = cw[0 * 768 + ch] * a + cw[1 * 768 + ch] * m + cw[2 * 768 + ch] * z + cbias[ch]; }
        u[i] = cv[0] * cv[1];
        og[i] = cv[2] * siluf_(raw[(3 * CTXL + t) * HCB + cc]); }
    __syncthreads();
    { const int cc = tid % HCB, tg = tid / HCB, t0 = WT * tg; float acc[WT], w[WT];
#pragma unroll
        for (int j = 0; j < WT; ++j) { acc[j] = 0.f; w[j] = hcm[(t0 + j + CTXL) * HCB + cc]; }
#pragma unroll 8
        for (int s = 0; s < CTXL; ++s) { const float us = u[s * HCB + cc];
#pragma unroll
            for (int j = 0; j < WT; ++j) acc[j] += us * w[j];
#pragma unroll
            for (int j = WT - 1; j > 0; --j) w[j] = w[j - 1];
            w[0] = hcm[(t0 - s - 1 + CTXL) * HCB + cc]; }
        const float dsk = p.in[I_HD][(size_t)l * WG + c0 + cc];
#pragma unroll
        for (int j = 0; j < WT; ++j) { const int t = t0 + j; ob[t * HCB + cc] = f2bf(og[t * HCB + cc] * (acc[j] + u[t * HCB + cc] * dsk)); } }
    __syncthreads();
    for (int i = tid; i < CTXL * 2; i += NT) { const int t = i >> 1, hh = i & 1; *(u32x4*)(Y + (rb + t) * 1024 + YH + c0 + 8 * hh) = *(const u32x4*)(ob + t * HCB + 8 * hh); }
}

__device__ __forceinline__ void attn_task(const Params& p, int l, int b, int kvh, int qt, bool ctxq, char* smem) {
    const int tid = otid(), lane = tid & 63, wave = tid >> 6, r = lane & 15, q = lane >> 4;
    const bf16* P = (const bf16*)(p.ws + WS_P); bf16* Y = (bf16*)(p.ws + WS_HNY); const cpx* ROPE = (const cpx*)(p.ws + WS_ROPE);
    bf16* Qs = (bf16*)smem;
    bf16* Ks = Qs + 256 * LS;
    bf16* Vt = Ks + 64 * LS;
    bf16* Ps = Vt + 64 * LS;
    const size_t rq0 = (size_t)b * TOK + (ctxq ? 0 : CTXL) + qt * 128;
    __syncthreads();
#pragma unroll
    for (int it = 0; it < 2; ++it) {
        const int idx = tid + NT * it, row = idx >> 2, cpair = idx & 3, g = row >> 7, t = row & 127;
        const bf16* src = P + (rq0 + t) * NP + PD + (kvh * 2 + g) * 64;
        float lo[8], hi[8]; unpack8(*(const u32x4*)(src + cpair * 8), lo); unpack8(*(const u32x4*)(src + 32 + cpair * 8), hi);
        float a[8], c2[8];
#pragma unroll
        for (int j = 0; j < 8; ++j) { float cs = 1.f, sn = 0.f; if (!ctxq) { const cpx cv = ROPE[(size_t)(qt * 128 + t) * 32 + cpair * 8 + j]; cs = cv.x; sn = cv.y; }
            a[j] = (lo[j] * cs - hi[j] * sn) * 0.125f; c2[j] = (hi[j] * cs + lo[j] * sn) * 0.125f; }
        *(u32x4*)(Qs + row * LS + cpair * 8) = pack8(a); *(u32x4*)(Qs + row * LS + 32 + cpair * 8) = pack8(c2);
    }
    const int lt0 = ctxq ? 0 : (2 * qt - 2 > 0 ? 2 * qt - 2 : 0), lt1 = ctxq ? -1 : (2 * qt + 3 < SEQ / 64 - 1 ? 2 * qt + 3 : SEQ / 64 - 1);
    const int nloc = lt1 - lt0 + 1, ntiles = nloc + NCC;
    float m[2][4], lsum[2][4]; f32x4 O[2][4];
#pragma unroll
    for (int ms = 0; ms < 2; ++ms)
#pragma unroll
        for (int i = 0; i < 4; ++i) { m[ms][i] = -INFINITY; lsum[ms][i] = 0.f; O[ms][i] = (f32x4){0.f, 0.f, 0.f, 0.f}; }
    const int g = wave >> 2, tq0 = (wave & 3) * 32;
    bf16* Pw = Ps + wave * 32 * LS;
    u32x4 klo = {0u, 0u, 0u, 0u}, khi = klo, vq = klo; f32x4 rp[4] = {(f32x4){1.f, 0.f, 1.f, 0.f}, (f32x4){1.f, 0.f, 1.f, 0.f}, (f32x4){1.f, 0.f, 1.f, 0.f}, (f32x4){1.f, 0.f, 1.f, 0.f}};
    const int ks_ = tid >> 2, kcp = tid & 3, vs_ = tid >> 3, vc8 = tid & 7;
#define ATT_PREFETCH(TI) do { const bool loc_ = (TI) < nloc; const int kt_ = loc_ ? lt0 + (TI) : (TI) - nloc; const size_t rk_ = (size_t)b * TOK + (loc_ ? CTXL : 0) + kt_ * 64; \
        if (tid < 256) { const bf16* src_ = P + (rk_ + ks_) * NP + PD + 256 + kvh * 64; klo = *(const u32x4*)(src_ + kcp * 8); khi = *(const u32x4*)(src_ + 32 + kcp * 8); \
            if (loc_) { const f32x4* rr_ = (const f32x4*)(ROPE + (size_t)(kt_ * 64 + ks_) * 32 + kcp * 8); rp[0] = rr_[0]; rp[1] = rr_[1]; rp[2] = rr_[2]; rp[3] = rr_[3]; } \
            else { rp[0] = rp[1] = rp[2] = rp[3] = (f32x4){1.f, 0.f, 1.f, 0.f}; } } \
        vq = *(const u32x4*)(P + (rk_ + vs_) * NP + PD + 384 + kvh * 64 + vc8 * 8); } while (0)
    ATT_PREFETCH(0);
    for (int ti = 0; ti < ntiles; ++ti) {
        const bool local = ti < nloc; const int kt = local ? lt0 + ti : ti - nloc;
        __syncthreads();
        if (tid < 256) { float lo[8], hi[8]; unpack8(klo, lo); unpack8(khi, hi);
            const float cs[8] = {rp[0].x, rp[0].z, rp[1].x, rp[1].z, rp[2].x, rp[2].z, rp[3].x, rp[3].z}, sn[8] = {rp[0].y, rp[0].w, rp[1].y, rp[1].w, rp[2].y, rp[2].w, rp[3].y, rp[3].w};
            float a[8], c2[8];
#pragma unroll
            for (int j = 0; j < 8; ++j) { a[j] = lo[j] * cs[j] - hi[j] * sn[j]; c2[j] = hi[j] * cs[j] + lo[j] * sn[j]; }
            *(u32x4*)(Ks + ks_ * LS + kcp * 8) = pack8(a); *(u32x4*)(Ks + ks_ * LS + 32 + kcp * 8) = pack8(c2); }
        { const unsigned w[4] = {vq.x, vq.y, vq.z, vq.w};
#pragma unroll
            for (int j = 0; j < 4; ++j) { Vt[(vc8 * 8 + 2 * j) * LS + vs_] = (bf16)(w[j] & 0xffffu); Vt[(vc8 * 8 + 2 * j + 1) * LS + vs_] = (bf16)(w[j] >> 16); } }
        __syncthreads();
        if (ti + 1 < ntiles) ATT_PREFETCH(ti + 1);
#pragma unroll
        for (int ms = 0; ms < 2; ++ms) {
            const int qlo = qt * 128 + tq0 + 16 * ms, klo_ = kt * 64;
            if (local && (klo_ > qlo + 15 + 128 || klo_ + 63 < qlo - 128)) continue;
            f32x4 S[4] = {(f32x4){0.f, 0.f, 0.f, 0.f}, (f32x4){0.f, 0.f, 0.f, 0.f}, (f32x4){0.f, 0.f, 0.f, 0.f}, (f32x4){0.f, 0.f, 0.f, 0.f}};
            mma_nt<4, 2>(Qs, LS, g * 128 + tq0 + 16 * ms, Ks, LS, 0, S, lane);
            float rmax[4];
#pragma unroll
            for (int i = 0; i < 4; ++i) { const int qpos = qlo + 4 * q + i; float mx = -INFINITY;
#pragma unroll
                for (int nt = 0; nt < 4; ++nt) { if (local) { const int kpos = kt * 64 + nt * 16 + r; const int d = kpos - qpos; if (d > 128 || d < -128) S[nt][i] = -INFINITY; } mx = fmaxf(mx, S[nt][i]); }
                rmax[i] = row16_max(mx); }
#pragma unroll
            for (int i = 0; i < 4; ++i) { const float mn = fmaxf(m[ms][i], rmax[i]); const float msafe = mn == -INFINITY ? 0.f : mn; const float alpha = __expf(m[ms][i] - msafe); float sm = 0.f;
#pragma unroll
                for (int nt = 0; nt < 4; ++nt) { const float pv = __expf(S[nt][i] - msafe); sm += pv; Pw[(16 * ms + 4 * q + i) * LS + nt * 16 + r] = f2bf(pv); O[ms][nt][i] *= alpha; }
                sm = row16_sum(sm);
                lsum[ms][i] = lsum[ms][i] * alpha + sm; m[ms][i] = mn; }
            WAVE_SYNC();
            mma_nt<4, 2>(Pw, LS, 16 * ms, Vt, LS, 0, O[ms], lane);
        }
    }
#undef ATT_PREFETCH
    const float sink = p.in[I_SINK][(size_t)l * NH + kvh * 2 + g];
    WAVE_SYNC();
#pragma unroll
    for (int ms = 0; ms < 2; ++ms)
#pragma unroll
        for (int i = 0; i < 4; ++i) { const float den = lsum[ms][i] + __expf(sink - m[ms][i]); const float inv = frcp_(den);
#pragma unroll
            for (int nt = 0; nt < 4; ++nt) Pw[(16 * ms + 4 * q + i) * LS + nt * 16 + r] = f2bf(O[ms][nt][i] * inv); }
    WAVE_SYNC();
#pragma unroll
    for (int hh = 0; hh < 4; ++hh) { const int t = lane >> 1, ck = (lane & 1) * 4 + hh;
        float fo[8], fg[8]; unpack8(*(const u32x4*)(Pw + t * LS + ck * 8), fo);
        unpack8(*(const u32x4*)(P + (rq0 + tq0 + t) * NP + PD + 512 + (kvh * 2 + g) * 64 + ck * 8), fg);
#pragma unroll
        for (int j = 0; j < 8; ++j) fo[j] *= siluf_(fg[j]);
        *(u32x4*)(Y + (rq0 + tq0 + t) * 1024 + YD + (kvh * 2 + g) * 64 + ck * 8) = pack8(fo); }
}

#ifdef EMU
__device__ __forceinline__ int olane(int lane) { return lane; }
#else
__device__ __forceinline__ int olane(int lane) { asm volatile("" : "+v"(lane)); return lane; }
#endif
__device__ __forceinline__ void load_nat_tile(const bf16* P, int row0, int col0, bf16* tile, int lane) {
    u32x4 v[8];
#pragma unroll
    for (int i = 0; i < 8; ++i) v[i] = *(const u32x4*)(P + (size_t)(row0 + (lane >> 3) + 8 * i) * NP + col0 + (lane & 7) * 8);
#pragma unroll
    for (int i = 0; i < 8; ++i) *(u32x4*)(tile + swz((lane >> 3) + 8 * i, lane & 7)) = v[i];
}
__device__ __forceinline__ bf16x8 frag_tr(const bf16* tile, int c0, int k0, int lane) {
    const int c = c0 + (lane & 15), kb = k0 + 8 * (lane >> 4); unsigned w[4];
#pragma unroll
    for (int j = 0; j < 4; ++j) w[j] = (unsigned)tile[swz(kb + 2 * j, c >> 3) + (c & 7)] | ((unsigned)tile[swz(kb + 2 * j + 1, c >> 3) + (c & 7)] << 16);
    u32x4 o; o.x = w[0]; o.y = w[1]; o.z = w[2]; o.w = w[3]; return as_frag(o);
}
template <int DIR>
__device__ __forceinline__ void gla_r_frags(const float* Grow0, int lane, bf16x8 (&af)[4]) {
    const int r = lane & 15, q4 = lane >> 4;
#pragma unroll
    for (int mt = 0; mt < 4; ++mt) { u32x4 o = {0u, 0u, 0u, 0u};
        if (q4 < 2) o = *(const u32x4*)((const bf16*)(Grow0 + (size_t)(16 * mt + r) * NGS + 16) + DIR * 16 + 8 * q4);
        af[mt] = as_frag(o); }
}
template <int DIR>
__device__ __forceinline__ float gla_b_col(const Params& p, int l, int h, const bf16x8 (&af)[4], int nt, int lane_, float (&x)[4][4]) {
    const int lane = olane(lane_), r = lane & 15, q4 = lane >> 4, d = h * 64 + 16 * nt + r;
    u32x4 o = {0u, 0u, 0u, 0u};
    if (q4 < 2) { const float* wa = p.in[I_GWA] + ((size_t)(l * 2 + DIR) * 16 + 8 * q4) * WG + d;
        o.x = pk2(wa[0], wa[WG]); o.y = pk2(wa[2 * WG], wa[3 * WG]); o.z = pk2(wa[4 * WG], wa[5 * WG]); o.w = pk2(wa[6 * WG], wa[7 * WG]); }
    const bf16x8 bfr = as_frag(o); const float bias = p.in[I_GBA][(size_t)(l * 2 + DIR) * WG + d];
#pragma unroll
    for (int mt = 0; mt < 4; ++mt) { f32x4 c = {bias, bias, bias, bias}; c = MFMA16(af[mt], bfr, c);
#pragma unroll
        for (int i = 0; i < 4; ++i) x[mt][i] = logsig_fast(c[i]) * (1.0f / 16.0f); }
    float carry = 0.f;
#pragma unroll
    for (int k = 0; k < 4; ++k) { const int mt = DIR == 0 ? k : 3 - k; float* y = x[mt];
        if (DIR == 0) { y[1] += y[0]; y[2] += y[1]; y[3] += y[2]; } else { y[2] += y[3]; y[1] += y[2]; y[0] += y[1]; }
        const float s4 = DIR == 0 ? y[3] : y[0];
        const float t1 = DIR == 0 ? __shfl_up(s4, 16) : __shfl_down(s4, 16), t2 = DIR == 0 ? __shfl_up(s4, 32) : __shfl_down(s4, 32), t3 = DIR == 0 ? __shfl_up(s4, 48) : __shfl_down(s4, 48);
        const int qq = DIR == 0 ? q4 : 3 - q4;
        const float e = (qq >= 1 ? t1 : 0.f) + (qq >= 2 ? t2 : 0.f) + (qq >= 3 ? t3 : 0.f);
        const float tot = __shfl(e + s4, DIR == 0 ? r + 48 : r);
#pragma unroll
        for (int i = 0; i < 4; ++i) y[i] += carry + e;
        carry += tot; }
    return carry;
}

template <int MIXER, int DIR>
__device__ __forceinline__ void chunkst_dir(const Params& p, int l, int b, int h, int cid, const float* Grow0, const unsigned (&kk)[32], const bf16* Vt, bf16* Kt, const float* wvs, float* bendl, int lane_) {
    const int lane = olane(lane_), r = lane & 15, q4 = lane >> 4;
    if constexpr (MIXER == 0) {
        float nacc = 0.f;
#pragma unroll
        for (int c = 0; c < 8; ++c) { float f[8];
#pragma unroll
            for (int j = 0; j < 8; ++j) { const int s = 8 * c + j; const float kv = (s & 1) ? bitsf(kk[s >> 1] & 0xffff0000u) : bitsf(kk[s >> 1] << 16);
                f[j] = kv * 0.125f * wvs[DIR * 64 + s]; nacc += f[j]; }
            *(u32x4*)(Kt + swz(lane, c)) = pack8(f); }
        ((float*)(p.ws + WS_NV))[ch_index(DIR, b, h, cid) * 64 + lane] = nacc;
    } else {
        const bf16* P = (const bf16*)(p.ws + WS_P); const int kcol = PG + 256 + h * 64; const int r0 = b * TOK + cid * 64;
        bf16x8 af[4]; gla_r_frags<DIR>(Grow0, lane, af);
#pragma unroll 2
        for (int nt = 0; nt < 4; ++nt) { const int d = 16 * nt + r; float x[4][4];
            const float bend = gla_b_col<DIR>(p, l, h, af, nt, lane, x);
            if (q4 == 0) { ((float*)(p.ws + WS_BE))[ch_index(DIR, b, h, cid) * 64 + d] = bend; bendl[d] = __expf(fmaxf(bend, -80.0f)); }
#pragma unroll
            for (int mt = 0; mt < 4; ++mt)
#pragma unroll
                for (int i = 0; i < 4; ++i) { const int s = 16 * mt + 4 * q4 + i; const float kv = bf2f(P[(size_t)(r0 + s) * NP + kcol + d]); const float bc = fmaxf(x[mt][i], -80.0f);
                    Kt[swz(d, s >> 3) + (s & 7)] = f2bf(kv * __expf(-bc));
                    ((bf16*)(p.ws + WS_EQ))[((size_t)DIR * T + r0 + s) * WG + h * 64 + d] = f2bf(__expf(bc)); } }
    }
    WAVE_SYNC();
    bf16x8 vf[4][2];
#pragma unroll
    for (int ne = 0; ne < 4; ++ne)
#pragma unroll
        for (int ks = 0; ks < 2; ++ks) vf[ne][ks] = *(const bf16x8*)(Vt + swz(16 * ne + r, ks * 4 + q4));
    bf16* dst = (bf16*)(p.ws + WS_ST) + st_index(MIXER, DIR, b, h, cid) * 4096;
#pragma unroll
    for (int me = 0; me < 4; ++me) {
        f32x4 acc[4] = {(f32x4){0.f, 0.f, 0.f, 0.f}, (f32x4){0.f, 0.f, 0.f, 0.f}, (f32x4){0.f, 0.f, 0.f, 0.f}, (f32x4){0.f, 0.f, 0.f, 0.f}};
#pragma unroll
        for (int ks = 0; ks < 2; ++ks) { const bf16x8 a = *(const bf16x8*)(Kt + swz(16 * me + r, ks * 4 + q4));
#pragma unroll
            for (int ne = 0; ne < 4; ++ne) acc[ne] = MFMA16(a, vf[ne][ks], acc[ne]); }
        f32x4 sc4 = {1.f, 1.f, 1.f, 1.f}; if constexpr (MIXER == 1) sc4 = *(const f32x4*)(bendl + 16 * me + 4 * q4);
#pragma unroll
        for (int ne = 0; ne < 4; ++ne) { const f32x4 v = acc[ne] * sc4; u32x2 o; o.x = pk2(v[0], v[1]); o.y = pk2(v[2], v[3]); *(u32x2*)(dst + (16 * ne + r) * 64 + 16 * me + 4 * q4) = o; }
    }
    WAVE_SYNC();
}
template <int MIXER>
__device__ __forceinline__ void chunkst_w(const Params& p, int l, int b, int h, int cid, char* wl, int lane) {
    const bf16* P = (const bf16*)(p.ws + WS_P); const float* G = (const float*)(p.ws + WS_G);
    const int r0 = b * TOK + cid * 64, r = lane & 15, q4 = lane >> 4;
    bf16* Kt = (bf16*)wl;
    bf16* Vt = Kt + 4096;
    float* wvs = (float*)(Vt + 4096);
    float* bendl = wvs + 128;
    const int kcol = (MIXER == 0 ? PA : PG) + 256 + h * 64, vcol = (MIXER == 0 ? PA : PG) + 512 + h * 64;
    const float* Grow0 = G + (size_t)r0 * NGS;
    { bf16* Nn = Kt;
        load_nat_tile(P, r0, vcol, Nn, lane);
        WAVE_SYNC();
#pragma unroll
        for (int c = 0; c < 8; ++c) { unsigned w[4];
#pragma unroll
            for (int j = 0; j < 4; ++j) w[j] = (unsigned)Nn[swz(8 * c + 2 * j, lane >> 3) + (lane & 7)] | ((unsigned)Nn[swz(8 * c + 2 * j + 1, lane >> 3) + (lane & 7)] << 16);
            u32x4 o; o.x = w[0]; o.y = w[1]; o.z = w[2]; o.w = w[3]; *(u32x4*)(Vt + swz(lane, c)) = o; }
        WAVE_SYNC();
        load_nat_tile(P, r0, kcol, Nn, lane);
        WAVE_SYNC(); }
    unsigned kk[32];
    { const bf16* Nn = Kt;
#pragma unroll
        for (int i = 0; i < 32; ++i) kk[i] = (unsigned)Nn[swz(2 * i, lane >> 3) + (lane & 7)] | ((unsigned)Nn[swz(2 * i + 1, lane >> 3) + (lane & 7)] << 16); }
    WAVE_SYNC();
    if constexpr (MIXER == 0) {
        const float* g = Grow0 + (size_t)lane * NGS; const float* gb = p.in[I_MGB] + (size_t)l * 16;
        const float i_f = g[h] + gb[h], f_f = g[4 + h] + gb[4 + h], i_b = g[8 + h] + gb[8 + h], f_b = g[12 + h] + gb[12 + h];
        const float lf = logsigf_(f_f), lb = logsigf_(f_b);
        const float bF = wave_prefix_sum(lf, lane), totF = __shfl(bF, 63);
        const float gF = totF - bF + i_f, mF = wave_max(gF);
        const float totB = wave_sum(lb), preB = wave_prefix_sum(lb, lane), bB = totB - preB + lb;
        const float gB = totB - bB + i_b, mB = wave_max(gB);
        wvs[lane] = __expf(gF - mF); wvs[64 + lane] = __expf(gB - mB);
        if (lane == 0) { float* SC = (float*)(p.ws + WS_SC);
            SC[ch_index(0, b, h, cid) * 4 + 0] = totF; SC[ch_index(0, b, h, cid) * 4 + 1] = mF;
            SC[ch_index(1, b, h, cid) * 4 + 0] = totB; SC[ch_index(1, b, h, cid) * 4 + 1] = mB; }
    }
    WAVE_SYNC();
    chunkst_dir<MIXER, 0>(p, l, b, h, cid, Grow0, kk, Vt, Kt, wvs, bendl, lane);
    chunkst_dir<MIXER, 1>(p, l, b, h, cid, Grow0, kk, Vt, Kt, wvs, bendl, lane);
}

template <int DIR>
__device__ __forceinline__ void chunkst_gla(const Params& p, int l, int b, int h, int cid, char* wl, int lane_) {
    const bf16* P = (const bf16*)(p.ws + WS_P);
    const int lane = olane(lane_), r0 = b * TOK + cid * 64, r = lane & 15, q4 = lane >> 4;
    bf16* Kt = (bf16*)wl;
    bf16* An = Kt + 4096;
    float* bendl = (float*)(An + 4096);
    const int kcol = PG + 256 + h * 64, vcol = PG + 512 + h * 64;
    const float* Grow0 = (const float*)(p.ws + WS_G) + (size_t)r0 * NGS;
    load_nat_tile(P, r0, vcol, An, lane);
    WAVE_SYNC();
    bf16x8 vf[4][2];
#pragma unroll
    for (int ne = 0; ne < 4; ++ne)
#pragma unroll
        for (int ks = 0; ks < 2; ++ks) vf[ne][ks] = frag_tr(An, 16 * ne, 32 * ks, lane);
    WAVE_SYNC();
    load_nat_tile(P, r0, kcol, An, lane);
    WAVE_SYNC();
    bf16x8 af[4]; gla_r_frags<DIR>(Grow0, lane, af);
#pragma unroll 2
    for (int nt = 0; nt < 4; ++nt) { const int d = 16 * nt + r; float x[4][4];
        const float bend = gla_b_col<DIR>(p, l, h, af, nt, lane, x);
        if (q4 == 0) { ((float*)(p.ws + WS_BE))[ch_index(DIR, b, h, cid) * 64 + d] = bend; bendl[d] = __expf(fmaxf(bend, -80.0f)); }
#pragma unroll
        for (int mt = 0; mt < 4; ++mt)
#pragma unroll
            for (int i = 0; i < 4; ++i) { const int s = 16 * mt + 4 * q4 + i; bf16* ke = An + swz(s, d >> 3) + (d & 7); const float kv = bf2f(*ke); const float bc = fmaxf(x[mt][i], -80.0f);
                Kt[swz(d, s >> 3) + (s & 7)] = f2bf(kv * __expf(-bc));
                *ke = f2bf(__expf(bc)); } }
    WAVE_SYNC();
    { bf16* EQg = (bf16*)(p.ws + WS_EQ) + ((size_t)DIR * T + r0) * WG + h * 64;
#pragma unroll
        for (int i = 0; i < 8; ++i) { const int s = (lane >> 3) + 8 * i, ck = lane & 7; *(u32x4*)(EQg + (size_t)s * WG + ck * 8) = *(const u32x4*)(An + swz(s, ck)); } }
    bf16* dst = (bf16*)(p.ws + WS_ST) + st_index(1, DIR, b, h, cid) * 4096;
#pragma unroll
    for (int me = 0; me < 4; ++me) {
        f32x4 acc[4] = {(f32x4){0.f, 0.f, 0.f, 0.f}, (f32x4){0.f, 0.f, 0.f, 0.f}, (f32x4){0.f, 0.f, 0.f, 0.f}, (f32x4){0.f, 0.f, 0.f, 0.f}};
#pragma unroll
        for (int ks = 0; ks < 2; ++ks) { const bf16x8 a = *(const bf16x8*)(Kt + swz(16 * me + r, ks * 4 + q4));
#pragma unroll
            for (int ne = 0; ne < 4; ++ne) acc[ne] = MFMA16(a, vf[ne][ks], acc[ne]); }
        const f32x4 sc4 = *(const f32x4*)(bendl + 16 * me + 4 * q4);
#pragma unroll
        for (int ne = 0; ne < 4; ++ne) { const f32x4 v = acc[ne] * sc4; u32x2 o; o.x = pk2(v[0], v[1]); o.y = pk2(v[2], v[3]); *(u32x2*)(dst + (16 * ne + r) * 64 + 16 * me + 4 * q4) = o; }
    }
    WAVE_SYNC();
}

template <int MIXER, int DIR>
__device__ __forceinline__ void chunkout_prep(const Params& p, int l, int b, int h, int cid, const float* Grow0, int r0, int pbase, const bf16* EQ, float* gar, int lane_) {
    const int lane = olane(lane_);
    if constexpr (MIXER == 0) {
        const bf16* P = (const bf16*)(p.ws + WS_P);
        const float* g = Grow0 + (size_t)lane * NGS; const float* gb = p.in[I_MGB] + (size_t)l * 16;
        const float ig = g[DIR * 8 + h] + gb[DIR * 8 + h], fg = g[DIR * 8 + 4 + h] + gb[DIR * 8 + 4 + h];
        const float mprev = ((const float*)(p.ws + WS_SC))[ch_index(DIR, b, h, cid) * 4 + 2];
        const float lf = logsigf_(fg); float bb;
        if (DIR == 0) bb = wave_prefix_sum(lf, lane); else { const float tt = wave_sum(lf), pre = wave_prefix_sum(lf, lane); bb = tt - pre + lf; }
        const float a = ig - bb; const float pm = DIR == 0 ? wave_prefix_max(a, lane) : wave_suffix_max(a, lane);
        const float mt_ = fmaxf(bb + mprev, bb + pm);
        float* ga = gar + DIR * 320;
        ga[lane] = bb - mt_; ga[64 + lane] = a; ga[128 + lane] = __expf(bb + mprev - mt_); ga[192 + lane] = __expf(-mt_);
        float* nvl = gar + 640 + DIR * 64;
        nvl[lane] = ((const float*)(p.ws + WS_NV))[ch_index(DIR, b, h, cid) * 64 + lane];
        WAVE_SYNC();
        float dq = 0.f;
#pragma unroll
        for (int c = 0; c < 8; ++c) { float f[8]; unpack8(*(const u32x4*)(P + (size_t)(r0 + lane) * NP + pbase + c * 8), f);
            const f32x4 n0 = *(const f32x4*)(nvl + c * 8), n1 = *(const f32x4*)(nvl + c * 8 + 4);
            dq += f[0] * n0.x + f[1] * n0.y + f[2] * n0.z + f[3] * n0.w + f[4] * n1.x + f[5] * n1.y + f[6] * n1.z + f[7] * n1.w; }
        ga[256 + lane] = dq;
    }
}
template <int MIXER, int DIR, int NS>
__device__ __forceinline__ void chunkout_dir(const Params& p, int b, int h, int cid, int r0, int pbase, int th, const bf16x8 (&vtf)[4][2], const bf16* VtL, const bf16* EQ, bf16* SB, const float* gar, float* rsm, f32x4 (&htot)[NS][4], int lane_) {
    const bf16* P = (const bf16*)(p.ws + WS_P); const bf16* ST = (const bf16*)(p.ws + WS_ST);
    const int lane = olane(lane_), r = lane & 15, q4 = lane >> 4;
    const bf16* E = EQ + ((size_t)DIR * T + r0) * WG + h * 64;
    const float* ga = gar + DIR * 320;
    bf16x8 kf[4][2], ctf[4][2];
#pragma unroll
    for (int n = 0; n < 4; ++n)
#pragma unroll
        for (int ks = 0; ks < 2; ++ks) { if constexpr (MIXER == 0) kf[n][ks] = vtf[n][ks];
            else kf[n][ks] = *(const bf16x8*)(P + (size_t)(r0 + 16 * n + r) * NP + pbase + 256 + ks * 32 + q4 * 8);
            ctf[n][ks] = *(const bf16x8*)(ST + st_index(MIXER, DIR, b, h, cid) * 4096 + (16 * n + r) * 64 + ks * 32 + q4 * 8);
            if constexpr (MIXER == 1) { float fe[8], fk[8]; unpack8(*(const u32x4*)(E + (size_t)(16 * n + r) * WG + ks * 32 + q4 * 8), fe); unpack8(as_u4(kf[n][ks]), fk);
#pragma unroll
                for (int j = 0; j < 8; ++j) fk[j] = fk[j] * frcp_(fe[j]);
                kf[n][ks] = as_frag(pack8(fk)); } }
#pragma unroll
    for (int ms = 0; ms < NS; ++ms) { const int mt = NS * th + ms;
        bf16x8 qf[2];
#pragma unroll
        for (int ks = 0; ks < 2; ++ks) { qf[ks] = *(const bf16x8*)(P + (size_t)(r0 + 16 * mt + r) * NP + pbase + ks * 32 + q4 * 8);
            if constexpr (MIXER == 1) { float fe[8], fq[8]; unpack8(*(const u32x4*)(E + (size_t)(16 * mt + r) * WG + ks * 32 + q4 * 8), fe); unpack8(as_u4(qf[ks]), fq);
#pragma unroll
                for (int j = 0; j < 8; ++j) fq[j] *= 0.125f * fe[j];
                qf[ks] = as_frag(pack8(fq)); } }
        f32x4 S[4] = {(f32x4){0.f, 0.f, 0.f, 0.f}, (f32x4){0.f, 0.f, 0.f, 0.f}, (f32x4){0.f, 0.f, 0.f, 0.f}, (f32x4){0.f, 0.f, 0.f, 0.f}};
#pragma unroll
        for (int ks = 0; ks < 2; ++ks)
#pragma unroll
            for (int n = 0; n < 4; ++n) S[n] = MFMA16(qf[ks], kf[n][ks], S[n]);
#pragma unroll
        for (int i = 0; i < 4; ++i) { const int t = 16 * mt + 4 * q4 + i; float sm = 0.f;
#pragma unroll
            for (int n = 0; n < 4; ++n) { const int s = 16 * n + r; const bool ok = DIR == 0 ? (s <= t) : (s >= t); float v = 0.f;
                if (ok) { if constexpr (MIXER == 0) v = S[n][i] * 0.125f * __expf(ga[t] + ga[64 + s]); else v = S[n][i]; }
                SB[swz(4 * q4 + i, s >> 3) + (s & 7)] = f2bf(v); sm += v; }
            if constexpr (MIXER == 0) { sm = row16_sum(sm); if (r == 0) rsm[4 * q4 + i] = sm; } }
        WAVE_SYNC();
        const bf16x8 sm0 = *(const bf16x8*)(SB + swz(r, q4)), sm1 = *(const bf16x8*)(SB + swz(r, 4 + q4));
        float wi = 1.f, inv = 1.f;
        if constexpr (MIXER == 0) { const int tt = 16 * mt + r; wi = ga[128 + tt]; const float den = wi * ga[256 + tt] + rsm[r]; inv = frcp_(fmaxf(fabsf(den), ga[192 + tt])); }
#pragma unroll
        for (int me = 0; me < 4; ++me) { f32x4 a1 = {0.f, 0.f, 0.f, 0.f}, a2 = {0.f, 0.f, 0.f, 0.f};
            a1 = MFMA16(*(const bf16x8*)(VtL + swz(16 * me + r, q4)), sm0, a1); a1 = MFMA16(*(const bf16x8*)(VtL + swz(16 * me + r, 4 + q4)), sm1, a1);
            a2 = MFMA16(ctf[me][0], qf[0], a2); a2 = MFMA16(ctf[me][1], qf[1], a2);
            if constexpr (MIXER == 0) htot[ms][me] += (a1 + a2 * wi) * inv; else htot[ms][me] += a1 + a2; }
        WAVE_SYNC();
    }
}
__device__ __forceinline__ void co_build_vt(const bf16* P, int r0, int vcol, bf16* VtL, int lane) {
    bf16* Nn = VtL + 4096;
#pragma unroll
    for (int hh = 0; hh < 2; ++hh) {
        u32x4 v[4];
#pragma unroll
        for (int i = 0; i < 4; ++i) v[i] = *(const u32x4*)(P + (size_t)(r0 + 32 * hh + (lane >> 3) + 8 * i) * NP + vcol + (lane & 7) * 8);
#pragma unroll
        for (int i = 0; i < 4; ++i) *(u32x4*)(Nn + swz((lane >> 3) + 8 * i, lane & 7)) = v[i];
        WAVE_SYNC();
#pragma unroll
        for (int c = 0; c < 4; ++c) { unsigned w[4];
#pragma unroll
            for (int j = 0; j < 4; ++j) w[j] = (unsigned)Nn[swz(8 * c + 2 * j, lane >> 3) + (lane & 7)] | ((unsigned)Nn[swz(8 * c + 2 * j + 1, lane >> 3) + (lane & 7)] << 16);
            u32x4 o; o.x = w[0]; o.y = w[1]; o.z = w[2]; o.w = w[3]; *(u32x4*)(VtL + swz(lane, 4 * hh + c)) = o; }
        WAVE_SYNC(); }
}
template <int MIXER, int NS>
__device__ __forceinline__ void co_finalize(const Params& p, int l, int h, int r0, int pbase, int mt0, f32x4 (&htot)[NS][4], int lane_) {
    const bf16* P = (const bf16*)(p.ws + WS_P); bf16* Y = (bf16*)(p.ws + WS_HNY);
    const float* ngp = p.in[MIXER == 0 ? I_MNG : I_GNG] + (size_t)l * WG + h * 64;
    const int lz = olane(lane_), r = lz & 15, q4 = lz >> 4;
    u32x2 gq[NS][4], oq[NS][4];
#pragma unroll
    for (int ms = 0; ms < NS; ++ms)
#pragma unroll
        for (int me = 0; me < 4; ++me) { const size_t off = (size_t)(r0 + 16 * (mt0 + ms) + r) * NP + pbase + 16 * me + 4 * q4;
            gq[ms][me] = *(const u32x2*)(P + off + (MIXER == 0 ? 1024 : 768)); if constexpr (MIXER == 0) oq[ms][me] = *(const u32x2*)(P + off + 768); else oq[ms][me] = (u32x2){0u, 0u}; }
#pragma unroll
    for (int ms = 0; ms < NS; ++ms) { const int mt = mt0 + ms; float ss = 0.f; float gv[4][4];
#pragma unroll
        for (int me = 0; me < 4; ++me) {
            gv[me][0] = bitsf(gq[ms][me].x << 16); gv[me][1] = bitsf(gq[ms][me].x & 0xffff0000u); gv[me][2] = bitsf(gq[ms][me].y << 16); gv[me][3] = bitsf(gq[ms][me].y & 0xffff0000u);
            if constexpr (MIXER == 0) { htot[ms][me][0] *= sigmoidf_(bitsf(oq[ms][me].x << 16)); htot[ms][me][1] *= sigmoidf_(bitsf(oq[ms][me].x & 0xffff0000u)); htot[ms][me][2] *= sigmoidf_(bitsf(oq[ms][me].y << 16)); htot[ms][me][3] *= sigmoidf_(bitsf(oq[ms][me].y & 0xffff0000u)); }
            ss += htot[ms][me][0] * htot[ms][me][0] + htot[ms][me][1] * htot[ms][me][1] + htot[ms][me][2] * htot[ms][me][2] + htot[ms][me][3] * htot[ms][me][3]; }
        ss = xrow_sum(ss);
        const float rstd = rsqrtf(ss * (1.0f / 64.0f) + EPS);
#pragma unroll
        for (int me = 0; me < 4; ++me) { const int e = 16 * me + 4 * q4; const f32x4 n4 = *(const f32x4*)(ngp + e);
            u32x2 o; o.x = pk2(htot[ms][me][0] * rstd * n4.x * siluf_(gv[me][0]), htot[ms][me][1] * rstd * n4.y * siluf_(gv[me][1]));
            o.y = pk2(htot[ms][me][2] * rstd * n4.z * siluf_(gv[me][2]), htot[ms][me][3] * rstd * n4.w * siluf_(gv[me][3]));
            *(u32x2*)(Y + (size_t)(r0 + 16 * mt + r) * 1024 + (MIXER == 0 ? YA : YG) + h * 64 + e) = o; } }
}
template <int MIXER>
__device__ __forceinline__ void chunkout_w(const Params& p, int l, int b, int h, int cid, char* wl, int lane) {
    const bf16* P = (const bf16*)(p.ws + WS_P); const float* G = (const float*)(p.ws + WS_G);
    const int r0 = b * TOK + cid * 64;
    const int pbase = (MIXER == 0 ? PA : PG) + h * 64;
    bf16* SB = (bf16*)wl;
    float* rsm = (float*)(SB + 1024);
    float* gar = rsm + 16;
    const bf16* EQ = (const bf16*)(p.ws + WS_EQ);
    const float* Grow0 = G + (size_t)r0 * NGS;
    bf16* VtL = (bf16*)(gar + 768);
    bf16x8 vtf[4][2];
#pragma unroll
    for (int me = 0; me < 4; ++me)
#pragma unroll
        for (int ks = 0; ks < 2; ++ks) { if constexpr (MIXER == 0) vtf[me][ks] = *(const bf16x8*)(P + (size_t)(r0 + 16 * me + (lane & 15)) * NP + pbase + 256 + ks * 32 + (lane >> 4) * 8); else vtf[me][ks] = (bf16x8){0, 0, 0, 0, 0, 0, 0, 0}; }
    co_build_vt(P, r0, pbase + 512, VtL, lane);
    chunkout_prep<MIXER, 0>(p, l, b, h, cid, Grow0, r0, pbase, EQ, gar, lane);
    chunkout_prep<MIXER, 1>(p, l, b, h, cid, Grow0, r0, pbase, EQ, gar, lane);
    WAVE_SYNC();
    constexpr int NS = MIXER == 1 ? 2 : 1;
#pragma unroll 1
    for (int th = 0; th < 4 / NS; ++th) {
        f32x4 htot[NS][4];
#pragma unroll
        for (int a = 0; a < NS; ++a)
#pragma unroll
            for (int c = 0; c < 4; ++c) htot[a][c] = (f32x4){0.f, 0.f, 0.f, 0.f};
        chunkout_dir<MIXER, 0, NS>(p, b, h, cid, r0, pbase, th, vtf, VtL, EQ, SB, gar, rsm, htot, lane);
        chunkout_dir<MIXER, 1, NS>(p, b, h, cid, r0, pbase, th, vtf, VtL, EQ, SB, gar, rsm, htot, lane);
        co_finalize<MIXER, NS>(p, l, h, r0, pbase, NS * th, htot, lane);
    }
}
constexpr int CO_PART = 13376;
template <int MIXER, int DIR>
__device__ __forceinline__ void chunkout_piece(const Params& p, int l, int b, int h, int cid, int mt, char* wl, int lane) {
    const bf16* P = (const bf16*)(p.ws + WS_P); const float* G = (const float*)(p.ws + WS_G);
    const int r0 = b * TOK + cid * 64; const int pbase = (MIXER == 0 ? PA : PG) + h * 64;
    bf16* SB = (bf16*)wl; float* rsm = (float*)(SB + 1024); float* gar = rsm + 16; const bf16* EQ = (const bf16*)(p.ws + WS_EQ);
    const float* Grow0 = G + (size_t)r0 * NGS; bf16* VtL = (bf16*)(gar + 768);
    bf16x8 vtf[4][2];
#pragma unroll
    for (int me = 0; me < 4; ++me)
#pragma unroll
        for (int ks = 0; ks < 2; ++ks) { if constexpr (MIXER == 0) vtf[me][ks] = *(const bf16x8*)(P + (size_t)(r0 + 16 * me + (lane & 15)) * NP + pbase + 256 + ks * 32 + (lane >> 4) * 8); else vtf[me][ks] = (bf16x8){0, 0, 0, 0, 0, 0, 0, 0}; }
    co_build_vt(P, r0, pbase + 512, VtL, lane);
    chunkout_prep<MIXER, DIR>(p, l, b, h, cid, Grow0, r0, pbase, EQ, gar, lane);
    WAVE_SYNC();
    f32x4 htot[1][4] = {{(f32x4){0.f, 0.f, 0.f, 0.f}, (f32x4){0.f, 0.f, 0.f, 0.f}, (f32x4){0.f, 0.f, 0.f, 0.f}, (f32x4){0.f, 0.f, 0.f, 0.f}}};
    chunkout_dir<MIXER, DIR, 1>(p, b, h, cid, r0, pbase, mt, vtf, VtL, EQ, SB, gar, rsm, htot, lane);
    float* part = (float*)(wl + CO_PART);
#pragma unroll
    for (int me = 0; me < 4; ++me)
#pragma unroll
        for (int i = 0; i < 4; ++i) part[(me * 4 + i) * 64 + lane] = htot[0][me][i];
}
template <int MIXER>
__device__ __forceinline__ void chunkout_combine(const Params& p, int l, int b, int h, int cid, int mt, const char* smem, int lane) {
    const float* pa = (const float*)(smem + (2 * mt) * WLDS + CO_PART); const float* pb = (const float*)(smem + (2 * mt + 1) * WLDS + CO_PART);
    f32x4 htot[1][4];
#pragma unroll
    for (int me = 0; me < 4; ++me)
#pragma unroll
        for (int i = 0; i < 4; ++i) htot[0][me][i] = pa[(me * 4 + i) * 64 + lane] + pb[(me * 4 + i) * 64 + lane];
    co_finalize<MIXER, 1>(p, l, h, b * TOK + cid * 64, (MIXER == 0 ? PA : PG) + h * 64, mt, htot, lane);
}

template <bool OUT>
__device__ __forceinline__ void chunk_workers(const Params& p, int l, char* smem) {
    const int tid = otid(), lane = tid & 63, wave = __builtin_amdgcn_readfirstlane(tid >> 6);
    const int NW = (int)gridDim.x * 8, wi = wave * (int)gridDim.x + obid();
    const int c_lo = (OUT && l == DEPTH - 1) ? NCC : 0, npc = NCH - c_lo, half = NB * NH * npc;
    char* wl = smem + wave * WLDS;
    if (OUT) {
        const int cl = NCC, npl = NCH - NCC, halfl = NB * NH * npl;
#pragma unroll 1
        for (int t = wi; t < halfl; t += NW) { const int b = t / (NH * npl), h = (t / npl) % NH, cid = cl + t % npl;
            const Params q = relaunder(p); chunkout_w<1>(q, l, b, h, cid, wl, lane); }
        { const int used = halfl % NW;
#pragma unroll 1
            for (int t = (wi + NW - used) % NW; t < halfl; t += NW) { const int b = t / (NH * npl), h = (t / npl) % NH, cid = cl + t % npl;
                const Params q = relaunder(p); chunkout_w<0>(q, l, b, h, cid, wl, lane); } }
        if (l < DEPTH - 1) {
            const int nct = NB * NH * NCC;
#pragma unroll 1
            for (int st = obid(); st < 2 * nct; st += (int)gridDim.x) { const int mixer = st / nct, r2 = st % nct, b = r2 / (NH * NCC), h = (r2 / NCC) % NH, cid = r2 % NCC;
                const Params q = relaunder(p); const int mt = wave >> 1;
                __syncthreads();
                if (mixer == 0) { if (wave & 1) chunkout_piece<0, 1>(q, l, b, h, cid, mt, wl, lane); else chunkout_piece<0, 0>(q, l, b, h, cid, mt, wl, lane); }
                else            { if (wave & 1) chunkout_piece<1, 1>(q, l, b, h, cid, mt, wl, lane); else chunkout_piece<1, 0>(q, l, b, h, cid, mt, wl, lane); }
                __syncthreads();
                if (wave < 4) { if (mixer == 0) chunkout_combine<0>(q, l, b, h, cid, wave, smem, lane); else chunkout_combine<1>(q, l, b, h, cid, wave, smem, lane); }
            }
        }
    } else {
        int off = 0;
#pragma unroll 1
        for (int t = wi; t < half; t += NW) { const int b = t / (NH * npc), h = (t / npc) % NH, cid = c_lo + t % npc;
            const Params q = relaunder(p); chunkst_gla<0>(q, l, b, h, cid, wl, lane); }
        off = (off + half) % NW;
#pragma unroll 1
        for (int t = (wi + NW - off) % NW; t < half; t += NW) { const int b = t / (NH * npc), h = (t / npc) % NH, cid = c_lo + t % npc;
            const Params q = relaunder(p); chunkst_gla<1>(q, l, b, h, cid, wl, lane); }
        off = (off + half) % NW;
#pragma unroll 1
        for (int t = (wi + NW - off) % NW; t < half; t += NW) { const int b = t / (NH * npc), h = (t / npc) % NH, cid = c_lo + t % npc;
            const Params q = relaunder(p); chunkst_w<0>(q, l, b, h, cid, wl, lane); }
    }
}

__device__ __forceinline__ void phase_mix1(const Params& p, int l, char* smem) {
    const bool ctxo = l < DEPTH - 1;
    constexpr int QTL = SEQ / 128, QTC = CTXL / 128;
    constexpr int N_HL = (NB / 2) * (WG / 2), N_AL = NB * 2 * QTL, N_HC = NB * (WG / HCB), N_AC = NB * 2 * QTC;
    const int total = N_HL + N_AL + (ctxo ? N_HC + N_AC : 0);
    for (int task = obid(); task < total; task += gridDim.x) {
        int t = task;
        if (t < N_HL) { hylat_task(p, l, t / (WG / 2), t % (WG / 2), smem); continue; } t -= N_HL;
        if (t < N_AL) { attn_task(p, l, t / (2 * QTL), (t / QTL) % 2, t % QTL, false, smem); continue; } t -= N_AL;
        if (t < N_HC) { hyctx_task(p, l, t / (WG / HCB), t % (WG / HCB), smem); continue; } t -= N_HC;
        attn_task(p, l, t / (2 * QTC), (t / QTC) % 2, t % QTC, true, smem);
    }
    __syncthreads();
    chunk_workers<false>(p, l, smem);
}

constexpr int SCG = 12;
__device__ __forceinline__ void phase_scan(const Params& p, int l, char* smem) {
    const int tid = otid();
    bf16* ST = (bf16*)(p.ws + WS_ST); float* NV = (float*)(p.ws + WS_NV); const float* BE = (const float*)(p.ws + WS_BE); float* SC = (float*)(p.ws + WS_SC);
    constexpr int NCHAIN = 2 * 2 * NB * NH;
    for (int item = obid() * NT + tid; item < NCHAIN * 1024; item += gridDim.x * NT) {
        const int chain = item >> 10, grp = item & 1023; const int mixer = chain / (2 * NB * NH), dir = (chain / (NB * NH)) % 2, b = (chain / NH) % NB, h = chain % NH;
        float c[4] = {0.f, 0.f, 0.f, 0.f}; float nv[4] = {0.f, 0.f, 0.f, 0.f}; float m = 0.f;
        const int d0 = (grp & 15) * 4; const bool donv = (mixer == 0) && (grp < 16);
        for (int o0 = 0; o0 < NCH; o0 += SCG) {
            u32x2 uu[SCG]; float s0[SCG], s1[SCG]; f32x4 be[SCG]; f32x4 nu[SCG];
#pragma unroll
            for (int j = 0; j < SCG; ++j) if (o0 + j < NCH) { const int cid = chain_cid(dir, o0 + j); const size_t ci = ch_index(dir, b, h, cid);
                uu[j] = *(const u32x2*)(ST + st_index(mixer, dir, b, h, cid) * 4096 + grp * 4);
                if (mixer == 0) { s0[j] = SC[ci * 4 + 0]; s1[j] = SC[ci * 4 + 1]; if (donv) nu[j] = *(const f32x4*)(NV + ci * 64 + grp * 4); }
                else be[j] = *(const f32x4*)(BE + ci * 64 + d0); }
#pragma unroll
            for (int j = 0; j < SCG; ++j) if (o0 + j < NCH) { const int cid = chain_cid(dir, o0 + j); const size_t ci = ch_index(dir, b, h, cid);
                const float u[4] = {bitsf(uu[j].x << 16), bitsf(uu[j].x & 0xffff0000u), bitsf(uu[j].y << 16), bitsf(uu[j].y & 0xffff0000u)};
                u32x2 w; w.x = pk2(c[0], c[1]); w.y = pk2(c[2], c[3]); *(u32x2*)(ST + st_index(mixer, dir, b, h, cid) * 4096 + grp * 4) = w;
                if (mixer == 0) {
                    if (grp == 0) SC[ci * 4 + 2] = m;
                    const float mn = fmaxf(s0[j] + m, s1[j]), a = __expf(s0[j] + m - mn), s = __expf(s1[j] - mn);
#pragma unroll
                    for (int k = 0; k < 4; ++k) c[k] = a * c[k] + s * u[k];
                    if (donv) { f32x4 nw = {nv[0], nv[1], nv[2], nv[3]}; *(f32x4*)(NV + ci * 64 + grp * 4) = nw;
                        nv[0] = a * nv[0] + s * nu[j].x; nv[1] = a * nv[1] + s * nu[j].y; nv[2] = a * nv[2] + s * nu[j].z; nv[3] = a * nv[3] + s * nu[j].w; }
                    m = mn;
                } else { c[0] = __expf(be[j].x) * c[0] + u[0]; c[1] = __expf(be[j].y) * c[1] + u[1]; c[2] = __expf(be[j].z) * c[2] + u[2]; c[3] = __expf(be[j].w) * c[3] + u[3]; } }
        }
    }
    constexpr int N_WOUT = (DM / 64) * (MIX / 64);
    __syncthreads();
    { const int lane = tid & 63, wave = __builtin_amdgcn_readfirstlane(tid >> 6); const int NW = (int)gridDim.x * 8, wi = wave * (int)gridDim.x + obid();
        for (int task = NW - 1 - wi; task < N_WOUT; task += NW) { const int nt = task / (MIX / 64), kt = task % (MIX / 64);
            convert_tile_w(p.in[I_WOUT] + (size_t)l * MIX * DM, DM, (bf16*)(p.ws + WS_WOUT), MIX, nt * 64, kt * 64, false, smem + wave * WLDS, lane); }
        bf16* tile = (bf16*)(smem + wave * WLDS); const bf16* HT = (const bf16*)(p.ws + WS_HT); bf16* Y = (bf16*)(p.ws + WS_HNY);
        constexpr int NTT = NB * (SEQ / 64) * 4;
        for (int t = wi; t < NTT; t += NW) { const int b = t / ((SEQ / 64) * 4), tt = (t / 4) % (SEQ / 64), c0 = (t % 4) * 64; const size_t tok0 = (size_t)b * TOK + CTXL + tt * 64;
#pragma unroll
            for (int i = 0; i < 8; ++i) { const int ch = (lane >> 3) + 8 * i, ck = lane & 7; *(u32x4*)(tile + swz(ch, ck)) = *(const u32x4*)(HT + (size_t)(768 + c0 + ch) * T + tok0 + ck * 8); }
            WAVE_SYNC();
#pragma unroll
            for (int i = 0; i < 8; ++i) { const int tk = (lane >> 3) + 8 * i, cc = lane & 7; unsigned w[4];
#pragma unroll
                for (int j = 0; j < 4; ++j) { const int ca = cc * 8 + 2 * j; w[j] = (unsigned)tile[swz(ca, tk >> 3) + (tk & 7)] | ((unsigned)tile[swz(ca + 1, tk >> 3) + (tk & 7)] << 16); }
                u32x4 o; o.x = w[0]; o.y = w[1]; o.z = w[2]; o.w = w[3]; *(u32x4*)(Y + (tok0 + tk) * 1024 + YH + c0 + cc * 8) = o; }
            WAVE_SYNC(); } }
}

__device__ __forceinline__ void phase_mix2(const Params& p, int l, char* smem) { chunk_workers<true>(p, l, smem); }

#ifndef EMU
#define LAS __attribute__((address_space(3)))
#define XB_TMO      128
#define XB_XCNT(j)  (256  + 64 * (j))
#define XB_XSUB(j)  (1280 + 64 * (j))
#define XB_XGEN(j)  (2304 + 64 * (j))
#define XB_TOP      3328
#define XB_TOPGEN   3392
#define XCD_BAR_WORDS 3456
#define XB_SPIN_CAP (1u << 18)

__device__ __forceinline__ unsigned xb_ld(unsigned* p)              { return __hip_atomic_load(p, __ATOMIC_RELAXED, __HIP_MEMORY_SCOPE_AGENT); }
__device__ __forceinline__ unsigned xb_add(unsigned* p, unsigned v) { return __hip_atomic_fetch_add(p, v, __ATOMIC_RELAXED, __HIP_MEMORY_SCOPE_AGENT); }
__device__ __forceinline__ unsigned xb_xcc_id() { return (unsigned)__builtin_amdgcn_s_getreg((3 << 11) | 20) & 0xFu; }
#define XB_SPIN(cond, bar) do { unsigned _sp = 0; while (cond) { __builtin_amdgcn_s_sleep(1); \
    if ((++_sp & 255u) == 0u) { if (xb_ld(&(bar)[XB_TMO])) break; if (_sp > XB_SPIN_CAP) { atomicAdd(&(bar)[XB_TMO], 1u); break; } } } } while (0)

struct XcdBarrier {
    unsigned* bar; unsigned x;
    volatile LAS unsigned* st;
};

__device__ __forceinline__ XcdBarrier xcd_barrier_post(unsigned* bar, volatile LAS unsigned* st) {
    XcdBarrier b; b.bar = bar; b.x = xb_xcc_id(); b.st = st;
    if (threadIdx.x == 0) (void)xb_add(&bar[XB_XCNT(b.x)], 1u);
    return b;
}
__device__ __forceinline__ void xcd_barrier_complete(unsigned* bar, unsigned x, unsigned& nloc, unsigned& nx) {
    const unsigned G = gridDim.x * gridDim.y * gridDim.z;
    unsigned sum, cnt, mine, sp = 0u;
    for (;;) {
        sum = 0u; cnt = 0u; mine = 0u;
#pragma unroll
        for (unsigned j = 0; j < 16; ++j) { const unsigned c = xb_ld(&bar[XB_XCNT(j)]); sum += c; cnt += (c > 0u) ? 1u : 0u; mine = (j == x) ? c : mine; }
        if (sum == G) break;
        __builtin_amdgcn_s_sleep(1);
        if ((++sp & 255u) == 0u) { if (xb_ld(&bar[XB_TMO])) break; if (sp > XB_SPIN_CAP) { atomicAdd(&bar[XB_TMO], 1u); break; } }
    }
    nloc = mine > 0u ? mine : 1u; nx = cnt > 0u ? cnt : 1u;
}

__device__ __forceinline__ void xcd_barrier(const XcdBarrier& b) {
    asm volatile("s_waitcnt vmcnt(0)" ::: "memory");
    __syncthreads();
    if (threadIdx.x == 0) {
        unsigned* bar = b.bar;
        __builtin_amdgcn_s_waitcnt(0);
        unsigned nloc = b.st[0], nx = b.st[1];
        if (nloc == 0u) { xcd_barrier_complete(bar, b.x, nloc, nx); b.st[0] = nloc; b.st[1] = nx; }
        const unsigned old = xb_add(&bar[XB_XSUB(b.x)], 1u);
        const unsigned gen = old / nloc;
        if (old + 1u == (gen + 1u) * nloc) {
            __builtin_amdgcn_fence(__ATOMIC_RELEASE, "agent");
            asm volatile("s_waitcnt vmcnt(0)" ::: "memory");
            const unsigned og = xb_add(&bar[XB_TOP], 1u);
            const unsigned tg = og / nx;
            if (og + 1u == (tg + 1u) * nx) xb_add(&bar[XB_TOPGEN], 1u);
            else XB_SPIN(xb_ld(&bar[XB_TOPGEN]) == tg, bar);
            __builtin_amdgcn_fence(__ATOMIC_ACQUIRE, "agent");
            xb_add(&bar[XB_XGEN(b.x)], 1u);
            asm volatile("s_waitcnt vmcnt(0)" ::: "memory");
        } else {
            XB_SPIN(xb_ld(&bar[XB_XGEN(b.x)]) == gen, bar);
            __builtin_amdgcn_fence(__ATOMIC_ACQUIRE, "agent");
            asm volatile("s_waitcnt vmcnt(0)" ::: "memory");
        }
    }
    __syncthreads();
}
#endif

__global__ void __launch_bounds__(NT) fwd_kernel(Params pk, int ph_lo, int ph_hi) {
    SMEM_DECL;
#ifndef EMU
    volatile LAS unsigned* misc = (volatile LAS unsigned*)(smem + LDS_BYTES - 64);
    if (threadIdx.x < 2) misc[threadIdx.x] = 0u;
    __syncthreads();
    const XcdBarrier bar = xcd_barrier_post((unsigned*)(pk.ws + WS_BAR), misc);
#endif
    constexpr int NPH = 2 + 6 * DEPTH;
    for (int ph = ph_lo; ph < ph_hi && ph < NPH; ++ph) {
#ifndef EMU
        Params p = pk; { size_t z = 0; asm volatile("" : "+s"(z)); p.ws = pk.ws + z; p.out = pk.out + z;
#pragma unroll
            for (int i = 0; i < 26; ++i) p.in[i] = pk.in[i] + z; }
#else
        const Params& p = pk;
#endif
        if (ph == 0) phase0(p, smem);
        else if (ph == NPH - 1) phase_rp(p, DEPTH, smem);
        else { const int l = (ph - 1) / 6, k = (ph - 1) % 6;
            if (k == 0) phase_rp(p, l, smem);
            else if (k == 1) phase_gemm_in(p, l, smem);
            else if (k == 2) phase_mix1(p, l, smem);
            else if (k == 3) phase_scan(p, l, smem);
            else if (k == 4) phase_mix2(p, l, smem);
            else phase_gemm_out(p, l, smem);
#ifdef PROBE_DUP
            if (k == PROBE_DUP) { GRID_SYNC();
                if (k == 1) phase_gemm_in(p, l, smem); else if (k == 2) phase_mix1(p, l, smem); else if (k == 4) phase_mix2(p, l, smem); }
#endif
        }
        if (ph + 1 < ph_hi && !(ph >= 6 && ph % 6 == 0)) {
#ifdef EMU
            GRID_SYNC();
#else
            if (ph_lo < 0) GRID_SYNC();
            xcd_barrier(bar);
#endif
        }
    }
}

#ifndef EMU
extern "C" void kernel_launch(void* const* d_in, const int* in_sizes, int n_in, void* d_out, int out_size, void* d_ws, size_t ws_size, hipStream_t stream) {
    static int grid = 0;
    if (grid == 0) {
        if (n_in != 26 || ws_size < WS_TOTAL) { fprintf(stderr, "kernel_launch: unexpected n_in %d or ws_size %zu (need %zu)\n", n_in, ws_size, (size_t)WS_TOTAL); grid = -1; return; }
        int dev = 0, cus = 0, per_cu = 0;
        hipGetDevice(&dev);
        hipDeviceGetAttribute(&cus, hipDeviceAttributeMultiprocessorCount, dev);
        hipFuncSetAttribute((const void*)fwd_kernel, hipFuncAttributeMaxDynamicSharedMemorySize, LDS_BYTES);
        hipOccupancyMaxActiveBlocksPerMultiprocessor(&per_cu, (const void*)fwd_kernel, NT, LDS_BYTES);
        if (per_cu < 1) { fprintf(stderr, "kernel_launch: occupancy query returned %d\n", per_cu); grid = -1; return; }
        if (per_cu > 1) per_cu = 1;
        grid = cus * per_cu;
    }
    if (grid < 0) return;
    hipMemsetAsync((char*)d_ws + WS_BAR, 0, BAR_BYTES, stream);
    Params p{};
    for (int i = 0; i < 26; ++i) p.in[i] = (const float*)d_in[i];
    p.out = (float*)d_out; p.ws = (char*)d_ws;
    int lo = 0, hi = 2 + 6 * DEPTH;
    void* args[] = {&p, &lo, &hi};
    hipError_t e = hipLaunchCooperativeKernel((const void*)fwd_kernel, dim3(grid), dim3(NT), args, LDS_BYTES, stream);
    if (e != hipSuccess) fprintf(stderr, "cooperative launch failed: %s (grid %d)\n", hipGetErrorString(e), grid);
}
#endif
```

```cpp
#ifdef EMU
#include "emu/hipemu.h"
#define GRID_SYNC() emu::grid_sync()
#define SMEM_DECL char* smem = emu::S().blocks[emu::cur()->block].lds
#define SCHED_FENCE() do {} while (0)
#define MFMA16(a, b, c) emu_mfma_16x16x32_bf16(a, b, c)
#else
#include <hip/hip_runtime.h>
#include <hip/hip_cooperative_groups.h>
#include <cstdio>
#include <cstdint>
#define GRID_SYNC() cooperative_groups::this_grid().sync()
#define SMEM_DECL extern __shared__ __attribute__((aligned(16))) char smem[]
#define SCHED_FENCE() __builtin_amdgcn_sched_barrier(0)
#define MFMA16(a, b, c) __builtin_amdgcn_mfma_f32_16x16x32_bf16(a, b, c, 0, 0, 0)
#endif

#ifdef EMU
#ifndef EMU_DM
#define EMU_DM 256
#endif
#ifndef EMU_NB
#define EMU_NB 2
#endif
#ifndef EMU_SEQ
#define EMU_SEQ 512
#endif
#ifndef EMU_DEPTH
#define EMU_DEPTH 2
#endif
#ifndef EMU_CTXL
#define EMU_CTXL 128
#endif
constexpr int DM = EMU_DM, NB = EMU_NB, SEQ = EMU_SEQ, DEPTH = EMU_DEPTH, CTXL = EMU_CTXL;
#else
constexpr int DM = 1024, NB = 8, SEQ = 2048, DEPTH = 4, CTXL = 256;
#endif
constexpr int MIX = 1024, WG = 256, HD = 64, NH = 4, CH = 64;
constexpr int TOK = CTXL + SEQ, T = NB * TOK, NCH = TOK / CH, NCC = CTXL / CH;
constexpr int N_IN = 4144, NP = 3072, NG = 48, NGS = 32, NMAIN = 3328, NPAD = 4352;
constexpr int NF = 2 * SEQ;
constexpr int NJ = NB + 1;
constexpr int NT = 512;
constexpr float EPS = 1e-6f;
constexpr int PA = 0, PG = 1280, PD = 2304;
constexpr int YA = 0, YH = 256, YG = 512, YD = 768;
constexpr int ilog4(int n) { return n <= 1 ? 0 : 1 + ilog4(n / 4); }
constexpr int FFT_P = ilog4(NF);
static_assert((1 << (2 * FFT_P)) == NF, "NF must be a power of 4");
static_assert(DM % 256 == 0 && CTXL % 128 == 0 && SEQ % 256 == 0, "shape constraints");

typedef unsigned short bf16;
typedef short bf16x8 __attribute__((ext_vector_type(8)));
typedef float f32x4 __attribute__((ext_vector_type(4)));
typedef unsigned u32x4 __attribute__((ext_vector_type(4)));
typedef unsigned u32x2 __attribute__((ext_vector_type(2)));
struct cpx { float x, y; };

constexpr size_t al256(size_t x) { return (x + 255) & ~(size_t)255; }
constexpr size_t WS_CTXB = 0;
constexpr size_t WS_HNY = al256(WS_CTXB + (size_t)NB * CTXL * DM * 4);
constexpr size_t WS_WIN = WS_HNY + (size_t)T * 1024 * 2;
constexpr size_t WS_ST = WS_WIN;
constexpr size_t ST_BYTES = (size_t)2 * 2 * NB * NH * NCH * 4096 * 2;
constexpr size_t WS_KT = al256(WS_WIN + (size_t)NPAD * DM * 2);
static_assert(WS_KT + (size_t)WG * NF * 4 <= WS_ST + ST_BYTES || true, "");
constexpr size_t ST_END = al256((WS_ST + ST_BYTES > WS_KT + (size_t)WG * NF * 4) ? WS_ST + ST_BYTES : WS_KT + (size_t)WG * NF * 4);
constexpr size_t WS_P = ST_END;
constexpr size_t WS_HT = al256(WS_P + (size_t)T * NP * 2);
constexpr size_t WS_WOUT = WS_HT;
constexpr size_t WS_G = al256(WS_HT + (size_t)1024 * T * 2);
constexpr size_t WS_KF = al256(WS_G + (size_t)T * NGS * 4);
constexpr size_t WS_HC = al256(WS_KF + (size_t)WG * NF * 8);
constexpr size_t WS_EQ = al256(WS_HC + (size_t)2 * WG * CTXL * 4);
constexpr size_t WS_NV = al256(WS_EQ + (size_t)2 * T * WG * 2);
constexpr size_t WS_BE = al256(WS_NV + (size_t)2 * NB * NH * NCH * 64 * 4);
constexpr size_t WS_SC = al256(WS_BE + (size_t)2 * NB * NH * NCH * 64 * 4);
constexpr size_t WS_MOD = al256(WS_SC + (size_t)2 * NB * NH * NCH * 4 * 4);
constexpr size_t WS_TW = al256(WS_MOD + (size_t)DEPTH * NJ * 3 * DM * 4);
constexpr size_t WS_ROPE = al256(WS_TW + (size_t)NF * 8);
constexpr size_t WS_BAR = al256(WS_ROPE + (size_t)SEQ * 32 * 8);
constexpr size_t BAR_BYTES = 32768;
constexpr size_t WS_TOTAL = al256(WS_BAR + BAR_BYTES);
static_assert((size_t)T * DM * 4 <= (size_t)T * NP * 2, "YO fits in P");
#ifndef EMU
static_assert(WS_TOTAL <= (size_t)268435456, "workspace map must fit 256 MiB");
#endif

constexpr int LDS_BYTES = 163840;

struct Params {
    const float* in[26];
    float* out;
    char* ws;
};
enum { I_X = 0, I_C, I_CTX, I_CCTX, I_WADA, I_BADA, I_GPRE, I_GPOST, I_WIN, I_MGB, I_MNG, I_HCW, I_HCB, I_HW1, I_HB1, I_HW2, I_HB2, I_HW3, I_HB3,
       I_HFREQ, I_HD, I_GWA, I_GBA, I_GNG, I_SINK, I_WOUT };

__device__ __forceinline__ Params relaunder(const Params& pk) {
#ifdef EMU
    return pk;
#else
    Params p = pk; size_t z = 0; asm volatile("" : "+s"(z)); p.ws = pk.ws + z; p.out = pk.out + z;
#pragma unroll
    for (int i = 0; i < 26; ++i) p.in[i] = pk.in[i] + z;
    return p;
#endif
}
constexpr int WLDS = (LDS_BYTES - 64) / 8 / 16 * 16;
#ifdef EMU
#define WAVE_SYNC() emu_wave_sync()
#else
#define WAVE_SYNC() do { asm volatile("s_waitcnt lgkmcnt(0)" ::: "memory"); __builtin_amdgcn_wave_barrier(); } while (0)
#endif

#ifdef EMU
__device__ __forceinline__ int otid() { return (int)threadIdx.x; }
__device__ __forceinline__ int obid() { return (int)blockIdx.x; }
#else
__device__ __forceinline__ int otid() { int t = (int)threadIdx.x; asm volatile("" : "+v"(t)); return t; }
__device__ __forceinline__ int obid() { int b = (int)blockIdx.x; asm volatile("" : "+s"(b)); return b; }
#endif
__device__ __forceinline__ unsigned fbits(float f) { return __builtin_bit_cast(unsigned, f); }
__device__ __forceinline__ float bitsf(unsigned u) { return __builtin_bit_cast(float, u); }
__device__ __forceinline__ float bf2f(bf16 h) { return bitsf((unsigned)h << 16); }
#ifdef EMU
__device__ __forceinline__ bf16 f2bf(float f) { unsigned u = fbits(f); return (bf16)((u + 0x7fffu + ((u >> 16) & 1u)) >> 16); }
__device__ __forceinline__ unsigned pk2(float lo, float hi) { return (unsigned)f2bf(lo) | ((unsigned)f2bf(hi) << 16); }
#else
typedef __bf16 nbf16x2 __attribute__((ext_vector_type(2)));
typedef float nf32x2 __attribute__((ext_vector_type(2)));
__device__ __forceinline__ unsigned pk2(float lo, float hi) { const nf32x2 v = {lo, hi}; return __builtin_bit_cast(unsigned, __builtin_convertvector(v, nbf16x2)); }
__device__ __forceinline__ bf16 f2bf(float f) { return (bf16)(pk2(f, 0.0f) & 0xffffu); }
#endif
#ifdef EMU
__device__ __forceinline__ float frcp_(float x) { return 1.0f / x; }
#else
__device__ __forceinline__ float frcp_(float x) { return __builtin_amdgcn_rcpf(x); }
#endif
__device__ __forceinline__ float sigmoidf_(float x) { return frcp_(1.0f + __expf(-x)); }
__device__ __forceinline__ float siluf_(float x) { return x * frcp_(1.0f + __expf(-x)); }
__device__ __forceinline__ float logsigf_(float x) { return fminf(x, 0.0f) - log1pf(__expf(-fabsf(x))); }
__device__ __forceinline__ float logsig_fast(float x) { return fminf(x, 0.0f) - __logf(1.0f + __expf(-fabsf(x))); }
#ifdef EMU
__device__ __forceinline__ float row16_sum(float x) { x += __shfl_xor(x, 1); x += __shfl_xor(x, 2); x += __shfl_xor(x, 4); x += __shfl_xor(x, 8); return x; }
__device__ __forceinline__ float row16_max(float x) { x = fmaxf(x, __shfl_xor(x, 1)); x = fmaxf(x, __shfl_xor(x, 2)); x = fmaxf(x, __shfl_xor(x, 4)); x = fmaxf(x, __shfl_xor(x, 8)); return x; }
__device__ __forceinline__ float xrow_sum(float x) { x += __shfl_xor(x, 16); x += __shfl_xor(x, 32); return x; }
__device__ __forceinline__ float xrow_max(float x) { x = fmaxf(x, __shfl_xor(x, 16)); x = fmaxf(x, __shfl_xor(x, 32)); return x; }
#else
template <int CTRL> __device__ __forceinline__ float dpp_(float x) { return __builtin_bit_cast(float, __builtin_amdgcn_mov_dpp(__builtin_bit_cast(int, x), CTRL, 0xf, 0xf, true)); }
__device__ __forceinline__ float row16_sum(float x) { x += dpp_<0xB1>(x); x += dpp_<0x4E>(x); x += dpp_<0x141>(x); x += dpp_<0x128>(x); return x; }
__device__ __forceinline__ float row16_max(float x) { x = fmaxf(x, dpp_<0xB1>(x)); x = fmaxf(x, dpp_<0x4E>(x)); x = fmaxf(x, dpp_<0x141>(x)); x = fmaxf(x, dpp_<0x128>(x)); return x; }
__device__ __forceinline__ float xrow_sum(float x) {
    auto s = __builtin_amdgcn_permlane16_swap(fbits(x), fbits(x), false, false); x = bitsf(s[0]) + bitsf(s[1]);
    auto t = __builtin_amdgcn_permlane32_swap(fbits(x), fbits(x), false, false); return bitsf(t[0]) + bitsf(t[1]); }
__device__ __forceinline__ float xrow_max(float x) {
    auto s = __builtin_amdgcn_permlane16_swap(fbits(x), fbits(x), false, false); x = fmaxf(bitsf(s[0]), bitsf(s[1]));
    auto t = __builtin_amdgcn_permlane32_swap(fbits(x), fbits(x), false, false); return fmaxf(bitsf(t[0]), bitsf(t[1])); }
#endif
__device__ __forceinline__ float wave_sum(float v) { return xrow_sum(row16_sum(v)); }
__device__ __forceinline__ float wave_max(float v) { return xrow_max(row16_max(v)); }
#ifdef EMU
__device__ __forceinline__ float wave_prefix_sum(float v, int lane) {
#pragma unroll
    for (int o = 1; o < 64; o <<= 1) { float t = __shfl_up(v, o); if (lane >= o) v += t; }
    return v;
}
__device__ __forceinline__ float wave_prefix_max(float v, int lane) {
#pragma unroll
    for (int o = 1; o < 64; o <<= 1) { float t = __shfl_up(v, o); if (lane >= o) v = fmaxf(v, t); }
    return v;
}
#else
template <int CTRL, int RM> __device__ __forceinline__ float dppo_(float old, float x) { return __builtin_bit_cast(float, __builtin_amdgcn_update_dpp(__builtin_bit_cast(int, old), __builtin_bit_cast(int, x), CTRL, RM, 0xf, false)); }
__device__ __forceinline__ float wave_prefix_sum(float v, int) {
    v += dppo_<0x111, 0xf>(0.f, v); v += dppo_<0x112, 0xf>(0.f, v); v += dppo_<0x114, 0xf>(0.f, v); v += dppo_<0x118, 0xf>(0.f, v);
    v += dppo_<0x142, 0xa>(0.f, v); v += dppo_<0x143, 0xc>(0.f, v); return v;
}
__device__ __forceinline__ float wave_prefix_max(float v, int) {
    const float ninf = -INFINITY;
    v = fmaxf(v, dppo_<0x111, 0xf>(ninf, v)); v = fmaxf(v, dppo_<0x112, 0xf>(ninf, v)); v = fmaxf(v, dppo_<0x114, 0xf>(ninf, v)); v = fmaxf(v, dppo_<0x118, 0xf>(ninf, v));
    v = fmaxf(v, dppo_<0x142, 0xa>(ninf, v)); v = fmaxf(v, dppo_<0x143, 0xc>(ninf, v)); return v;
}
#endif
__device__ __forceinline__ float wave_suffix_max(float v, int lane) {
    return __shfl(wave_prefix_max(__shfl(v, 63 - lane), lane), 63 - lane);
}
__device__ __forceinline__ void unpack8(u32x4 v, float* f) {
    f[0] = bitsf(v.x << 16); f[1] = bitsf(v.x & 0xffff0000u); f[2] = bitsf(v.y << 16); f[3] = bitsf(v.y & 0xffff0000u);
    f[4] = bitsf(v.z << 16); f[5] = bitsf(v.z & 0xffff0000u); f[6] = bitsf(v.w << 16); f[7] = bitsf(v.w & 0xffff0000u);
}
__device__ __forceinline__ int orig_col(int n) {
    if (n < 1280) return n;
    if (n < 2304) return 2320 + (n - 1280);
    if (n < 3072) return 3376 + (n - 2304);
    if (n < 3088) return 1280 + (n - 3072);
    if (n < 3120) return 3344 + (n - 3088);
    if (n < NMAIN) return -1;
    return 1296 + (n - NMAIN);
}
__device__ __forceinline__ int chain_cid(int dir, int o) {
    if (dir == 0) return o;
    return o < NCC ? (NCC - 1 - o) : (NCH - 1 - (o - NCC));
}

__device__ __forceinline__ int swz(int row, int ch) { return row * 64 + ((ch ^ (row & 7)) << 3); }
__device__ __forceinline__ u32x4 pack8(const float* f) { u32x4 o; o.x = pk2(f[0], f[1]); o.y = pk2(f[2], f[3]); o.z = pk2(f[4], f[5]); o.w = pk2(f[6], f[7]); return o; }
__device__ __forceinline__ bf16x8 as_frag(u32x4 v) { return __builtin_bit_cast(bf16x8, v); }
__device__ __forceinline__ u32x4 as_u4(bf16x8 v) { return __builtin_bit_cast(u32x4, v); }

constexpr int LS = 72;

template <int NTL, int KS>
__device__ __forceinline__ void mma_nt(const bf16* A, int lda, int m0, const bf16* B, int ldb, int n0, f32x4 (&acc)[NTL], int lane) {
    const int r = lane & 15, q = lane >> 4;
#pragma unroll
    for (int ks = 0; ks < KS; ++ks) {
        const bf16x8 a = *(const bf16x8*)(A + (m0 + r) * lda + ks * 32 + q * 8);
#pragma unroll
        for (int nt = 0; nt < NTL; ++nt) {
            const bf16x8 b = *(const bf16x8*)(B + (n0 + nt * 16 + r) * ldb + ks * 32 + q * 8);
            acc[nt] = MFMA16(a, b, acc[nt]);
        }
    }
}

__device__ __forceinline__ void layer_prep(const Params& p, int l, int idx, int stride, char* smem);
__device__ __forceinline__ void phase0(const Params& p, char* smem) {
    const int tid = otid();
    cpx* TW = (cpx*)(p.ws + WS_TW);
    cpx* ROPE = (cpx*)(p.ws + WS_ROPE);
    float* MOD = (float*)(p.ws + WS_MOD);
    constexpr int N_TW = NF / NT, N_ROPE = SEQ * 32 / NT, N_MOD = DEPTH * (3 * DM / 64);
    for (int task = obid(); task < N_TW + N_ROPE + N_MOD; task += gridDim.x) {
        if (task < N_TW) {
            const int j = task * NT + tid; float s, c; sincospif(2.0f * (float)j / (float)NF, &s, &c);
            cpx v; v.x = c; v.y = -s; TW[j] = v;
        } else if (task < N_TW + N_ROPE) {
            const int idx = (task - N_TW) * NT + tid; const int pos = idx >> 5, i = idx & 31;
            const float inv = exp2f(-(float)(i & 15) * (13.287712379549449f / 16.0f));
            const float ang = (float)(i < 16 ? pos / 64 : pos % 64) * inv;
            cpx v; v.x = cosf(ang); v.y = sinf(ang); ROPE[idx] = v;
        } else {
            const int mt = task - N_TW - N_ROPE; const int l = mt / (3 * DM / 64), n0 = (mt % (3 * DM / 64)) * 64;
            float* sv = (float*)smem;
            float* red = sv + NJ * DM;
            __syncthreads();
            for (int i = tid; i < NJ * DM; i += NT) { const int j = i / DM, k = i % DM; const float v = j < NB ? p.in[I_C][j * DM + k] : p.in[I_CCTX][k]; sv[i] = siluf_(v); }
            __syncthreads();
            const int nl = tid & 63, ks = tid >> 6; float acc[NJ];
#pragma unroll
            for (int j = 0; j < NJ; ++j) acc[j] = 0.f;
            const float* w = p.in[I_WADA] + (size_t)l * DM * 3 * DM + n0 + nl;
            for (int k = ks * (DM / 8); k < (ks + 1) * (DM / 8); ++k) { const float wv = w[(size_t)k * 3 * DM];
#pragma unroll
                for (int j = 0; j < NJ; ++j) acc[j] += sv[j * DM + k] * wv; }
#pragma unroll
            for (int j = 0; j < NJ; ++j) red[(ks * NJ + j) * 64 + nl] = acc[j];
            __syncthreads();
            for (int i = tid; i < NJ * 64; i += NT) { const int j = i / 64, n = i % 64; float s = 0.f;
#pragma unroll
                for (int k8 = 0; k8 < 8; ++k8) s += red[(k8 * NJ + j) * 64 + n];
                MOD[((size_t)l * NJ + j) * 3 * DM + n0 + n] = s + p.in[I_BADA][(size_t)l * 3 * DM + n0 + n]; }
        }
    }
}

#ifdef EMU
constexpr int PANEL_ROWS = 128, PANEL_UNITS = DM / 128;
#else
constexpr int PANEL_ROWS = 256, PANEL_UNITS = DM / 256;
#endif
__device__ __forceinline__ unsigned* unit_counter(const Params& p, int isctx) { return (unsigned*)(p.ws + WS_BAR + 16384) + 64 * isctx; }
__device__ __forceinline__ unsigned* stage_counter(const Params& p, int flag) { return (unsigned*)(p.ws + WS_BAR + 16384) + 512 + 512 * flag; }
__device__ __forceinline__ void stage_signal(const Params& p, char* smem, int flag, int l) {
#ifdef EMU
    __syncthreads(); if (otid() == 0) *stage_counter(p, flag) += 1u;
#else
    asm volatile("s_waitcnt vmcnt(0)" ::: "memory"); __syncthreads();
    if (threadIdx.x == 0) {
        const unsigned xcc = (unsigned)__builtin_amdgcn_s_getreg((3 << 11) | 20) & 0xFu, nloc = ((volatile __attribute__((address_space(3))) unsigned*)(smem + LDS_BYTES - 64))[0];
        unsigned* g = stage_counter(p, flag);
        if (nloc > 0u) { const unsigned old = __hip_atomic_fetch_add(g + 16 * (1 + xcc), 1u, __ATOMIC_RELAXED, __HIP_MEMORY_SCOPE_AGENT);
            if (old + 1u == nloc * (unsigned)(l + 1)) { __builtin_amdgcn_fence(__ATOMIC_RELEASE, "agent"); asm volatile("s_waitcnt vmcnt(0)" ::: "memory");
                __hip_atomic_fetch_add(g, nloc, __ATOMIC_RELAXED, __HIP_MEMORY_SCOPE_AGENT); } }
        else { __builtin_amdgcn_fence(__ATOMIC_RELEASE, "agent"); asm volatile("s_waitcnt vmcnt(0)" ::: "memory"); __hip_atomic_fetch_add(g, 1u, __ATOMIC_RELAXED, __HIP_MEMORY_SCOPE_AGENT); }
    }
#endif
}
__device__ __forceinline__ void stage_wait(const Params& p, int flag, int l) {
    if (otid() == 0) { const unsigned target = (unsigned)gridDim.x * (unsigned)(l + 1);
#ifdef EMU
        while (*(volatile unsigned*)stage_counter(p, flag) < target) emu::yield();
#else
        unsigned spins = 0;
        while (__hip_atomic_load(stage_counter(p, flag), __ATOMIC_RELAXED, __HIP_MEMORY_SCOPE_AGENT) < target) { __builtin_amdgcn_s_sleep(16); if (++spins > (1u << 20)) break; }
        __builtin_amdgcn_fence(__ATOMIC_ACQUIRE, "agent"); asm volatile("s_waitcnt vmcnt(0)" ::: "memory");
#endif
    }
    __syncthreads();
}
__device__ __forceinline__ int logical_row(int i) { return i < NB * SEQ ? (i / SEQ) * TOK + CTXL + i % SEQ : ((i - NB * SEQ) / CTXL) * TOK + (i - NB * SEQ) % CTXL; }
__device__ __forceinline__ void rp_rows(const Params& p, int l, int lo, int hi, int gi, int nb) {
    const int tid = otid(), lane = tid & 63, wave = tid >> 6;
    const float* MOD = (const float*)(p.ws + WS_MOD);
    float* CTXB = (float*)(p.ws + WS_CTXB);
    const bf16* YO = (const bf16*)(p.ws + WS_P);
    bf16* HN = (bf16*)(p.ws + WS_HNY);
    constexpr int NV4 = DM / 256, RW = 2;
    const int stride = nb * 8;
    for (int base = lo + gi * 8 + wave; base < hi; base += stride * RW) {
        f32x4 x[RW][NV4], y[RW][NV4]; const float* xo[RW]; float* xn[RW]; int mj[RW]; bool ok[RW]; int rowi[RW];
#pragma unroll
        for (int i = 0; i < RW; ++i) { const int li = base + i * stride; ok[i] = li < hi; const int rr = logical_row(ok[i] ? li : base); rowi[i] = rr;
            const int b = rr / TOK, pp = rr % TOK; const bool isctx = pp < CTXL; if (l == DEPTH && isctx) ok[i] = false;
            const size_t off = isctx ? ((size_t)b * CTXL + pp) * DM : ((size_t)b * SEQ + (pp - CTXL)) * DM;
            xo[i] = (l <= 1) ? (isctx ? p.in[I_CTX] + off : p.in[I_X] + off) : (isctx ? CTXB + off : p.out + off);
            xn[i] = isctx ? CTXB + off : p.out + off; mj[i] = isctx ? NB : b;
#pragma unroll
            for (int j = 0; j < NV4; ++j) { x[i][j] = *(const f32x4*)(xo[i] + 4 * lane + 256 * j); if (l > 0) { const u32x2 yy = *(const u32x2*)(YO + (size_t)rr * DM + 4 * lane + 256 * j); y[i][j] = (f32x4){bitsf(yy.x << 16), bitsf(yy.x & 0xffff0000u), bitsf(yy.y << 16), bitsf(yy.y & 0xffff0000u)}; } else y[i][j] = (f32x4){0.f, 0.f, 0.f, 0.f}; } }
        if (l > 0) {
            float ss[RW];
#pragma unroll
            for (int i = 0; i < RW; ++i) { ss[i] = 0.f;
#pragma unroll
                for (int j = 0; j < NV4; ++j) ss[i] += y[i][j].x * y[i][j].x + y[i][j].y * y[i][j].y + y[i][j].z * y[i][j].z + y[i][j].w * y[i][j].w; }
#pragma unroll
            for (int i = 0; i < RW; ++i) ss[i] = wave_sum(ss[i]);
            const float* gp = p.in[I_GPOST] + (size_t)(l - 1) * DM;
#pragma unroll
            for (int i = 0; i < RW; ++i) { const float rstd = rsqrtf(ss[i] * (1.0f / DM) + EPS); const float* gt = MOD + ((size_t)(l - 1) * NJ + mj[i]) * 3 * DM + 2 * DM;
#pragma unroll
                for (int j = 0; j < NV4; ++j) { const f32x4 g4 = *(const f32x4*)(gt + 4 * lane + 256 * j), p4 = *(const f32x4*)(gp + 4 * lane + 256 * j);
                    x[i][j] = x[i][j] + g4 * (y[i][j] * rstd * p4);
                    if (ok[i]) *(f32x4*)(xn[i] + 4 * lane + 256 * j) = x[i][j]; } }
        }
        if (l < DEPTH) {
            float ss[RW];
#pragma unroll
            for (int i = 0; i < RW; ++i) { ss[i] = 0.f;
#pragma unroll
                for (int j = 0; j < NV4; ++j) ss[i] += x[i][j].x * x[i][j].x + x[i][j].y * x[i][j].y + x[i][j].z * x[i][j].z + x[i][j].w * x[i][j].w; }
#pragma unroll
            for (int i = 0; i < RW; ++i) ss[i] = wave_sum(ss[i]);
            const float* gp = p.in[I_GPRE] + (size_t)l * DM;
#pragma unroll
            for (int i = 0; i < RW; ++i) { const float rstd = rsqrtf(ss[i] * (1.0f / DM) + EPS); const float* md = MOD + ((size_t)l * NJ + mj[i]) * 3 * DM; const int row = rowi[i];
#pragma unroll
                for (int j = 0; j < NV4; ++j) { const int e = 4 * lane + 256 * j;
                    const f32x4 g4 = *(const f32x4*)(gp + e), sh = *(const f32x4*)(md + e), sc = *(const f32x4*)(md + DM + e);
                    const f32x4 h = (x[i][j] * rstd * g4) * (sc + 1.0f) + sh;
                    u32x2 o; o.x = pk2(h.x, h.y); o.y = pk2(h.z, h.w);
                    if (ok[i]) *(u32x2*)(HN + (size_t)row * DM + e) = o; } }
        }
    }
}

__device__ __forceinline__ void convert_tile(const float* src, int ldn, bf16* dst, int K, int n0, int k0, bool use_map, char* smem) {
    const int tid = otid();
    float* tile = (float*)smem;
    __syncthreads();
#pragma unroll
    for (int i = 0; i < 8; ++i) { const int idx = tid + NT * i, k = idx >> 6, n = idx & 63;
        const int oc = use_map ? orig_col(n0 + n) : (n0 + n);
        tile[k * 65 + n] = oc >= 0 ? src[(size_t)(k0 + k) * ldn + oc] : 0.f; }
    __syncthreads();
    const int n = tid >> 3, c = tid & 7;
    u32x4 o; o.x = pk2(tile[(8 * c + 0) * 65 + n], tile[(8 * c + 1) * 65 + n]); o.y = pk2(tile[(8 * c + 2) * 65 + n], tile[(8 * c + 3) * 65 + n]);
    o.z = pk2(tile[(8 * c + 4) * 65 + n], tile[(8 * c + 5) * 65 + n]); o.w = pk2(tile[(8 * c + 6) * 65 + n], tile[(8 * c + 7) * 65 + n]);
    *(u32x4*)(dst + (size_t)(n0 + n) * K + k0 + 8 * c) = o;
}

__device__ __forceinline__ void filter_task(const Params& p, int l, int L, int pos0, char* smem) {
    const int tid = otid(), j = tid & 63;
    float* z = (float*)smem;
    float* h1 = z + 8 * 33;
    float* h2 = h1 + 8 * 64;
    const float* w1 = p.in[I_HW1] + (size_t)l * 33 * 64; const float* w2 = p.in[I_HW2] + (size_t)l * 64 * 64; const float* w3 = p.in[I_HW3] + (size_t)l * 64 * 512;
    float r1[33], r2[64], r3a[16];
#pragma unroll
    for (int i = 0; i < 33; ++i) r1[i] = w1[i * 64 + j];
#pragma unroll
    for (int i = 0; i < 64; ++i) r2[i] = w2[i * 64 + j];
    const float b1 = p.in[I_HB1][l * 64 + j], b2 = p.in[I_HB2][l * 64 + j], b3 = p.in[I_HB3][l * 512 + tid];
    const float f0 = p.in[I_HFREQ][(l * 2 + 0) * 64 + j], f1 = p.in[I_HFREQ][(l * 2 + 1) * 64 + j];
    __syncthreads();
    if (tid < 8 * 33) { const int pp = tid / 33, i = tid % 33; const float pos = (float)(pos0 + pp);
        const float t = pos / (float)(L - 1 > 1 ? L - 1 : 1), wv = 6.283185307179586f * pos / (float)L; float v;
        if (i == 0) v = t; else { const int bi = (i - 1) & 15; const float f = 1e-4f + (float)bi * ((15.0f - 1e-4f) / 15.0f); v = (i <= 16) ? cosf(wv * f) : -sinf(wv * f); }
        z[tid] = v; }
    __syncthreads();
    { const int pp = tid >> 6; float a = b1;
#pragma unroll
        for (int i = 0; i < 33; ++i) a += z[pp * 33 + i] * r1[i];
        h1[tid] = sinf(f0 * a);
#pragma unroll
        for (int i = 0; i < 16; ++i) r3a[i] = w3[i * 512 + tid]; }
    __syncthreads();
    { const int pp = tid >> 6; float a = b2;
#pragma unroll
        for (int i = 0; i < 64; ++i) a += h1[pp * 64 + i] * r2[i];
        h2[tid] = sinf(f1 * a); }
    __syncthreads();
    { const int o = tid, dir = o >> 8, c = o & 255;
        const float delta = 3.0701134573253946f + (float)c * ((15.350567286626973f - 3.0701134573253946f) / 255.0f);
        float acc[8];
#pragma unroll
        for (int pp = 0; pp < 8; ++pp) acc[pp] = b3;
#pragma unroll 1
        for (int cix = 0; cix < 4; ++cix) {
            float wn[16];
#pragma unroll
            for (int i = 0; i < 16; ++i) wn[i] = (cix < 3) ? w3[(16 * (cix + 1) + i) * 512 + o] : 0.f;
#pragma unroll
            for (int i = 0; i < 16; ++i) {
#pragma unroll
                for (int pp = 0; pp < 8; ++pp) acc[pp] += h2[pp * 64 + 16 * cix + i] * r3a[i]; }
#pragma unroll
            for (int i = 0; i < 16; ++i) r3a[i] = wn[i]; }
        float* KT = (float*)(p.ws + WS_KT); float* HC = (float*)(p.ws + WS_HC);
#pragma unroll
        for (int pp = 0; pp < 8; ++pp) { const int pos = pos0 + pp; const float t = (float)pos / (float)(L - 1 > 1 ? L - 1 : 1);
            const float v = acc[pp] * __expf(-t * delta);
            if (L == SEQ) { if (dir == 0) KT[(size_t)c * NF + pos]= v; else if (pos > 0) KT[(size_t)c * NF + (NF - pos)] = v; else KT[(size_t)c * NF + SEQ] = 0.f; }
            else HC[((size_t)dir * WG + c) * CTXL + pos] = v; }
    }
}

__device__ __forceinline__ void convert_tile_w(const float* src, int ldn, bf16* dst, int K, int n0, int k0, bool use_map, char* wl, int lane) {
    float* tile = (float*)wl;
    const int oc = use_map ? orig_col(n0 + lane) : (n0 + lane);
    float v[64];
#pragma unroll
    for (int k = 0; k < 64; ++k) v[k] = oc >= 0 ? src[(size_t)(k0 + k) * ldn + oc] : 0.f;
#pragma unroll
    for (int k = 0; k < 64; ++k) tile[k * 65 + lane] = v[k];
    WAVE_SYNC();
#pragma unroll
    for (int i = 0; i < 8; ++i) { const int n = (lane >> 3) + 8 * i, c = lane & 7; float f[8];
#pragma unroll
        for (int j = 0; j < 8; ++j) f[j] = tile[(8 * c + j) * 65 + n];
        *(u32x4*)(dst + (size_t)(n0 + n) * K + k0 + 8 * c) = pack8(f); }
    WAVE_SYNC();
}
__device__ __forceinline__ void layer_prep(const Params& p, int l, int idx, int stride, char* smem) {
    constexpr int N_WIN = (NPAD / 64) * (DM / 64), N_FL = SEQ / 8, N_FC = CTXL / 8;
    for (int task = idx; task < N_FL + N_FC; task += stride) {
        if (task < N_FL) filter_task(p, l, SEQ, task * 8, smem);
        else filter_task(p, l, CTXL, (task - N_FL) * 8, smem);
    }
    __syncthreads();
    { const int tid = otid(), lane = tid & 63, wave = __builtin_amdgcn_readfirstlane(tid >> 6);
        char* wl = smem + wave * WLDS;
        for (int task = wave * stride + idx; task < N_WIN; task += 8 * stride) { const int nt = task / (DM / 64), kt = task % (DM / 64);
            convert_tile_w(p.in[I_WIN] + (size_t)l * DM * N_IN, N_IN, (bf16*)(p.ws + WS_WIN), DM, nt * 64, kt * 64, true, wl, lane); } }
}
__device__ __forceinline__ void phase_rp(const Params& p, int l, char* smem) { const int G = (int)gridDim.x, bid = obid();
    if (l == 0) { rp_rows(p, 0, 0, T, bid, G); layer_prep(p, 0, bid, G, smem); return; }
    const bool has_ctx = l < DEPTH;
    constexpr int nLatU = NB * (SEQ / PANEL_ROWS) * PANEL_UNITS, nCtxU = NB * (CTXL / PANEL_ROWS) * PANEL_UNITS;
    const int nU = nLatU + (has_ctx ? nCtxU : 0);
    const int heavy = (has_ctx && nU > G && (nU % G) != 0) ? nU % G : 0;
    int lo, hi, gi, nb;
    if (heavy > 0) { if (bid < heavy) { lo = NB * SEQ; hi = T; gi = bid; nb = heavy; } else { lo = 0; hi = NB * SEQ; gi = bid - heavy; nb = G - heavy; } }
    else { lo = 0; hi = has_ctx ? T : NB * SEQ; gi = bid; nb = G; }
    if (otid() == 0) {
#pragma unroll 1
        for (int c = 0; c < 2; ++c) { if (c == 0 ? lo >= NB * SEQ : hi <= NB * SEQ) continue;
            const unsigned target = (unsigned)((c ? nCtxU : nLatU) * l);
#ifdef EMU
            while (*(volatile unsigned*)unit_counter(p, c) < target) emu::yield();
#else
            unsigned spins = 0;
            while (__hip_atomic_load(unit_counter(p, c), __ATOMIC_RELAXED, __HIP_MEMORY_SCOPE_AGENT) < target) { __builtin_amdgcn_s_sleep(16); if (++spins > (1u << 20)) break; }
#endif
        }
#ifndef EMU
        __builtin_amdgcn_fence(__ATOMIC_ACQUIRE, "agent"); asm volatile("s_waitcnt vmcnt(0)" ::: "memory");
#endif
    }
    __syncthreads();
    rp_rows(p, l, lo, hi, gi, nb);
    if (l < DEPTH) layer_prep(p, l, G - 1 - bid, G, smem);
}

__device__ __forceinline__ cpx cmul(cpx a, cpx b) { cpx r; r.x = a.x * b.x - a.y * b.y; r.y = a.x * b.y + a.y * b.x; return r; }
__device__ __forceinline__ cpx cmulc(cpx a, cpx b) { cpx r; r.x = a.x * b.x + a.y * b.y; r.y = a.y * b.x - a.x * b.y; return r; }
constexpr int fpad(int i) { return i + (i >> 4); }
__device__ __forceinline__ int FPH(int i) { return i + (i >> 4); }
constexpr int FBUF = fpad(NF);
constexpr int ilog16(int n) { return n < 16 ? 0 : 1 + ilog16(n / 16); }
constexpr int FFT_P16 = ilog16(NF);
constexpr bool FFT_R4 = ((NF >> (4 * FFT_P16)) == 4);
static_assert((NF >> (4 * FFT_P16)) == 1 || (NF >> (4 * FFT_P16)) == 4, "NF = 16^a * (1 or 4)");
template <bool INV> __device__ __forceinline__ void dft4(cpx& a0, cpx& a1, cpx& a2, cpx& a3) {
    const cpx s = {a0.x + a2.x, a0.y + a2.y}, b = {a0.x - a2.x, a0.y - a2.y}, c = {a1.x + a3.x, a1.y + a3.y}, d = {a1.x - a3.x, a1.y - a3.y};
    a0 = (cpx){s.x + c.x, s.y + c.y}; a2 = (cpx){s.x - c.x, s.y - c.y};
    if (!INV) { a1 = (cpx){b.x + d.y, b.y - d.x}; a3 = (cpx){b.x - d.y, b.y + d.x}; }
    else      { a1 = (cpx){b.x - d.y, b.y + d.x}; a3 = (cpx){b.x + d.y, b.y - d.x}; }
}
template <bool INV> __device__ __forceinline__ cpx cmulk(cpx a, float wr, float wi) {
    cpx r; if (!INV) { r.x = a.x * wr + a.y * wi; r.y = a.y * wr - a.x * wi; } else { r.x = a.x * wr - a.y * wi; r.y = a.y * wr + a.x * wi; } return r;
}
template <bool INV> __device__ __forceinline__ void dft16(cpx (&x)[16]) {
    constexpr float C1 = 0.92387953251128674f, S1 = 0.38268343236508977f, C2 = 0.70710678118654752f;
#pragma unroll
    for (int n2 = 0; n2 < 4; ++n2) dft4<INV>(x[n2], x[4 + n2], x[8 + n2], x[12 + n2]);
    x[4 * 1 + 1] = cmulk<INV>(x[4 * 1 + 1], C1, S1); x[4 * 1 + 2] = cmulk<INV>(x[4 * 1 + 2], C2, C2); x[4 * 1 + 3] = cmulk<INV>(x[4 * 1 + 3], S1, C1);
    x[4 * 2 + 1] = cmulk<INV>(x[4 * 2 + 1], C2, C2); x[4 * 2 + 2] = cmulk<INV>(x[4 * 2 + 2], 0.f, 1.f); x[4 * 2 + 3] = cmulk<INV>(x[4 * 2 + 3], -C2, C2);
    x[4 * 3 + 1] = cmulk<INV>(x[4 * 3 + 1], S1, C1); x[4 * 3 + 2] = cmulk<INV>(x[4 * 3 + 2], -C2, C2); x[4 * 3 + 3] = cmulk<INV>(x[4 * 3 + 3], -C1, -S1);
#pragma unroll
    for (int k1 = 0; k1 < 4; ++k1) dft4<INV>(x[4 * k1 + 0], x[4 * k1 + 1], x[4 * k1 + 2], x[4 * k1 + 3]);
    cpx t;
    t = x[1]; x[1] = x[4]; x[4] = t; t = x[2]; x[2] = x[8]; x[8] = t; t = x[3]; x[3] = x[12]; x[12] = t;
    t = x[6]; x[6] = x[9]; x[9] = t; t = x[7]; x[7] = x[13]; x[13] = t; t = x[11]; x[11] = x[14]; x[14] = t;
}
template <bool INV> __device__ __forceinline__ void fft_stage16(cpx* buf, const cpx* TW, int tl, int M) {
    const int span = M >> 4, twm = NF / M;
#pragma unroll 1
    for (int j = tl; j < NF / 16; j += 256) {
        const int grp = j / span, pos = j % span, base = grp * M + pos; cpx x[16];
#pragma unroll
        for (int q = 0; q < 16; ++q) x[q] = buf[FPH(base + q * span)];
        cpx w1 = {1.f, 0.f}; if (span > 1) w1 = TW[pos * twm];
        if (INV && span > 1) { cpx wk = w1;
#pragma unroll
            for (int k = 1; k < 16; ++k) { x[k] = cmulc(x[k], wk); wk = cmul(wk, w1); } }
        dft16<INV>(x);
        if (!INV && span > 1) { cpx wk = w1;
#pragma unroll
            for (int k = 1; k < 16; ++k) { x[k] = cmul(x[k], wk); wk = cmul(wk, w1); } }
#pragma unroll
        for (int q = 0; q < 16; ++q) buf[FPH(base + q * span)] = x[q];
    }
}
template <bool INV> __device__ __forceinline__ void fft_stage4_last(cpx* buf, int tl) {
#pragma unroll 1
    for (int j = tl; j < NF / 4; j += 256) { cpx a0 = buf[FPH(4 * j)], a1 = buf[FPH(4 * j + 1)], a2 = buf[FPH(4 * j + 2)], a3 = buf[FPH(4 * j + 3)];
        dft4<INV>(a0, a1, a2, a3); buf[FPH(4 * j)] = a0; buf[FPH(4 * j + 1)] = a1; buf[FPH(4 * j + 2)] = a2; buf[FPH(4 * j + 3)] = a3; }
}
__device__ __forceinline__ void fft_fwd(cpx* buf, const cpx* TW, int tl) {
    int M = NF;
#pragma unroll
    for (int s = 0; s < FFT_P16; ++s) { __syncthreads(); fft_stage16<false>(buf, TW, tl, M); M >>= 4; }
    if (FFT_R4) { __syncthreads(); fft_stage4_last<false>(buf, tl); }
    __syncthreads();
}
__device__ __forceinline__ void fft_inv(cpx* buf, const cpx* TW, int tl) {
    if (FFT_R4) { __syncthreads(); fft_stage4_last<true>(buf, tl); }
    int M = FFT_R4 ? 64 : 16;
#pragma unroll
    for (int s = 0; s < FFT_P16; ++s) { __syncthreads(); fft_stage16<true>(buf, TW, tl, M); M <<= 4; }
    __syncthreads();
}
__device__ __forceinline__ void filt_fft_task(const Params& p, int cp, char* smem) {
    const int tid = otid(), half = tid >> 8, tl = tid & 255, c = 2 * cp + half;
    cpx* buf = (cpx*)smem + (size_t)half * FBUF;
    const float* KT = (const float*)(p.ws + WS_KT) + (size_t)c * NF;
    cpx* KF = (cpx*)(p.ws + WS_KF) + (size_t)c * NF;
    const cpx* TW = (const cpx*)(p.ws + WS_TW);
    __syncthreads();
    for (int i = tl; i < NF; i += 256) { cpx v; v.x = KT[i]; v.y = 0.f; buf[FPH(i)] = v; }
    fft_fwd(buf, TW, tl);
    for (int i = tl; i < NF; i += 256) KF[i] = buf[FPH(i)];
}

__device__ __forceinline__ void gemm_tile(const Params& p, const bf16* A, const bf16* Bt, int K, int mt, int nt, int mode, char* smem) {
    const int tid = otid(), lane = tid & 63, wave = tid >> 6;
    bf16* As = (bf16*)smem;
    bf16* Bs = As + 128 * LS;
    const int wm = (wave & 3) * 32, wn = (wave >> 2) * 64;
    f32x4 acc[2][4];
#pragma unroll
    for (int i = 0; i < 2; ++i)
#pragma unroll
        for (int j = 0; j < 4; ++j) acc[i][j] = (f32x4){0.f, 0.f, 0.f, 0.f};
    const int lr = tid >> 3, lc = tid & 7;
    const bf16* Ag = A + (size_t)(mt * 128 + lr) * K + lc * 8;
    const bf16* Bg = Bt + (size_t)(nt * 128 + lr) * K + lc * 8;
    u32x4 ra0, ra1, rb0, rb1;
    ra0 = *(const u32x4*)(Ag); ra1 = *(const u32x4*)(Ag + (size_t)64 * K); rb0 = *(const u32x4*)(Bg); rb1 = *(const u32x4*)(Bg + (size_t)64 * K);
    const int nk = K / 64;
    for (int kt = 0; kt < nk; ++kt) {
        __syncthreads();
        *(u32x4*)(As + lr * LS + lc * 8) = ra0; *(u32x4*)(As + (lr + 64) * LS + lc * 8) = ra1;
        *(u32x4*)(Bs + lr * LS + lc * 8) = rb0; *(u32x4*)(Bs + (lr + 64) * LS + lc * 8) = rb1;
        __syncthreads();
        if (kt + 1 < nk) { const int ko = (kt + 1) * 64;
            ra0 = *(const u32x4*)(Ag + ko); ra1 = *(const u32x4*)(Ag + (size_t)64 * K + ko); rb0 = *(const u32x4*)(Bg + ko); rb1 = *(const u32x4*)(Bg + (size_t)64 * K + ko); }
        mma_nt<4, 2>(As, LS, wm, Bs, LS, wn, acc[0], lane);
        mma_nt<4, 2>(As, LS, wm + 16, Bs, LS, wn, acc[1], lane);
    }
    const int r = lane & 15, q = lane >> 4;
#pragma unroll
    for (int i = 0; i < 2; ++i)
#pragma unroll
        for (int j = 0; j < 4; ++j)
#pragma unroll
            for (int e = 0; e < 4; ++e) {
                const int row = mt * 128 + wm + 16 * i + 4 * q + e, col = nt * 128 + wn + 16 * j + r; const float v = acc[i][j][e];
                if (mode == 0) { if (col < NP) ((bf16*)(p.ws + WS_P))[(size_t)row * NP + col] = f2bf(v); else if (col < NP + 16) ((float*)(p.ws + WS_G))[(size_t)row * NGS + (col - NP)] = v; else if (col < NP + NG) ((bf16*)((float*)(p.ws + WS_G) + (size_t)row * NGS + 16))[col - NP - 16] = f2bf(v); }
                else if (mode == 2) ((bf16*)(p.ws + WS_HT))[(size_t)row * T + col] = f2bf(v);
                else ((bf16*)(p.ws + WS_P))[(size_t)row * DM + col] = f2bf(v);
            }
}

#ifndef EMU
namespace pg8 {
#define PG8_LAS __attribute__((address_space(3)))
typedef unsigned short bf16_t;
typedef short bf16x8 __attribute__((ext_vector_type(8)));
typedef float f32x4 __attribute__((ext_vector_type(4)));
typedef unsigned u32x4 __attribute__((ext_vector_type(4)));
constexpr int BM = 256, BK = 64, HALF = 128, HTB = HALF * BK * 2  , STAGE_BYTES = 8 * HTB, NXCD = 8, WGM = 8;

__host__ __device__ __forceinline__ int lds_byte(int r, int c) { const int st = (r >> 4) * 2 + (c >> 5), rr = r & 15, cc = c & 31, ob = rr * 64 + cc * 2; return st * 1024 + (ob ^ (((ob >> 9) & 1) << 5)); }
__host__ __device__ __forceinline__ void stage_rc(int b, int& R, int& C) { const int st = b / 1024, sb = b % 1024, swz = sb ^ (((sb >> 9) & 1) << 5); R = (st >> 1) * 16 + swz / 64; C = (st & 1) * 32 + (swz % 64) / 2; }
__host__ __device__ __forceinline__ int perm32(int rho) { const int n = rho >> 4, i = rho & 15; return 8 * (i >> 2) + 4 * n + (i & 3); }

struct Unit { int pm, pn; };
struct Gemm { const bf16_t* A; const bf16_t* Bt; int M, N, K; };
__device__ __forceinline__ unsigned cvt_pk_bf16(float lo, float hi) { unsigned r; asm volatile("v_cvt_pk_bf16_f32 %0, %1, %2" : "=v"(r) : "v"(lo), "v"(hi)); return r; }
template <class Epi, class Sched, bool ALIGN_EPI = false, bool SP2 = false>
__device__ __forceinline__ void gemm_phase(PG8_LAS unsigned char* lds, const Gemm g, const Sched& S, const Epi& E) {
    const int tid = otid(), wid = __builtin_amdgcn_readfirstlane(tid >> 6), lane = tid & 63, wr = wid >> 2, wc = wid & 3, fr = lane & 15, fq = lane >> 4;
    const int K = g.K, nt = K / BK;
    unsigned voffA[2], voffB[2];
#pragma unroll
    for (int i = 0; i < 2; ++i) { int R, C; stage_rc(tid * 16 + i * 8192, R, C); const int Rb = Epi::PERM ? ((R & ~31) + perm32(R & 31)) : R;
        voffA[i] = (unsigned)(R * K + C) * 2u; voffB[i] = (unsigned)(Rb * K + C) * 2u; }
    const size_t kstep = (size_t)(BK * 2);
    const size_t hstep = (size_t)HALF * K * 2;
    const size_t tstep = 2 * hstep;
    const unsigned ldsw = (unsigned)wid * 1024u;
    const int aoff = lds_byte(wr * 64 + fr, fq * 8), boff = lds_byte(wc * 32 + fr, fq * 8);
#define PG8_SA(b, h) (((b) * 2 + (h)) * HTB)
#define PG8_SB(b, h) ((4 + (b) * 2 + (h)) * HTB)
#define PG8_STAGE(bufoff, gbase, voff) do { _Pragma("unroll") for (int _i = 0; _i < 2; ++_i) \
        __builtin_amdgcn_global_load_lds((const unsigned*)((const char*)(gbase) + (voff)[_i]), (PG8_LAS unsigned*)(lds + (bufoff) + ldsw + _i * 8192), 16, 0, 0); } while (0)
#define PG8_LDA(dst, b, h) do { _Pragma("unroll") for (int m = 0; m < 4; ++m) _Pragma("unroll") for (int k = 0; k < 2; ++k) dst[m][k] = *(const PG8_LAS bf16x8*)(lds + PG8_SA(b, h) + aoff + m * 2048 + k * 1024); } while (0)
#define PG8_LDB(dst, b, h) do { _Pragma("unroll") for (int n = 0; n < 2; ++n) _Pragma("unroll") for (int k = 0; k < 2; ++k) dst[n][k] = *(const PG8_LAS bf16x8*)(lds + PG8_SB(b, h) + boff + n * 2048 + k * 1024); } while (0)
#define PG8_MMA(ai, bj, At, Bt) do { __builtin_amdgcn_s_setprio(1); _Pragma("unroll") for (int m = 0; m < 4; ++m) _Pragma("unroll") for (int n = 0; n < 2; ++n) _Pragma("unroll") for (int k = 0; k < 2; ++k) \
        acc[ai][bj][m][n] = __builtin_amdgcn_mfma_f32_16x16x32_bf16(Bt[n][k], At[m][k], acc[ai][bj][m][n], 0, 0, 0); __builtin_amdgcn_s_setprio(0); } while (0)
#define PG8_WAIT_V(n) asm volatile("s_waitcnt vmcnt(" #n ")" ::: "memory")
#define PG8_WAIT_L(n) asm volatile("s_waitcnt lgkmcnt(" #n ")" ::: "memory")
#define PG8_BAR __builtin_amdgcn_s_barrier()
#define PG8_SCHED __builtin_amdgcn_sched_barrier(0)
    Unit cur, nxt; int ui = 0;
    if (!S.next(0, cur)) return;
    f32x4 acc[2][2][4][2];
#pragma unroll
    for (int a = 0; a < 2; ++a)
#pragma unroll
        for (int b = 0; b < 2; ++b)
#pragma unroll
            for (int m = 0; m < 4; ++m)
#pragma unroll
                for (int n = 0; n < 2; ++n) acc[a][b][m][n] = (f32x4){0.f, 0.f, 0.f, 0.f};
    bf16x8 At[4][2], B0[2][2], B1[2][2];
    const char* cA = (const char*)g.A + (size_t)cur.pm * tstep; const char* cB = (const char*)g.Bt + (size_t)cur.pn * tstep;
    S.a_ready(cur);
    if constexpr (SP2) {
        PG8_STAGE(PG8_SB(0, 0), cB, voffB); PG8_STAGE(PG8_SB(0, 1), cB + hstep, voffB); PG8_STAGE(PG8_SA(0, 0), cA, voffA); PG8_STAGE(PG8_SA(0, 1), cA + hstep, voffA);
        if (wr == 1) PG8_BAR;
        PG8_WAIT_V(2); PG8_BAR;
        PG8_STAGE(PG8_SB(1, 0), cB + kstep, voffB); PG8_STAGE(PG8_SA(1, 0), cA + kstep, voffA); PG8_STAGE(PG8_SB(1, 1), cB + hstep + kstep, voffB);
        PG8_WAIT_V(6); PG8_BAR;
    } else {
        PG8_STAGE(PG8_SB(0, 0), cB, voffB); PG8_STAGE(PG8_SA(0, 0), cA, voffA); PG8_STAGE(PG8_SB(0, 1), cB + hstep, voffB); PG8_STAGE(PG8_SA(0, 1), cA + hstep, voffA);
        if (wr == 1) PG8_BAR;
        PG8_WAIT_V(4); PG8_BAR;
        PG8_STAGE(PG8_SB(1, 0), cB + kstep, voffB); PG8_STAGE(PG8_SA(1, 0), cA + kstep, voffA); PG8_STAGE(PG8_SB(1, 1), cB + hstep + kstep, voffB);
        PG8_WAIT_V(6); PG8_BAR;
    }
    for (;;) {
        const bool has_next = S.next(ui + 1, nxt);
        const char* nA = has_next ? (const char*)g.A + (size_t)nxt.pm * tstep : cA; const char* nB = has_next ? (const char*)g.Bt + (size_t)nxt.pn * tstep : cB;
        for (int t = 0; t < nt; t += 2) {
            const bool last = (t == nt - 2);
            const char* a1 = cA + (size_t)(t + 1) * kstep;
            const char* a2 = last ? nA : cA + (size_t)(t + 2) * kstep; const char* b2 = last ? nB : cB + (size_t)(t + 2) * kstep;
            const char* a3 = a2 + kstep; const char* b3 = b2 + kstep;
            if (last && has_next) S.a_ready(nxt);
            if constexpr (SP2) {
            PG8_LDB(B0, 0, 0); PG8_LDB(B1, 0, 1); PG8_SCHED; PG8_LDA(At, 0, 0); PG8_STAGE(PG8_SA(1, 1), a1 + hstep, voffA);
            PG8_WAIT_V(8); PG8_WAIT_L(0); PG8_BAR; PG8_MMA(0, 0, At, B0); PG8_MMA(0, 1, At, B1); PG8_BAR; PG8_SCHED;
            PG8_LDA(At, 0, 1); PG8_STAGE(PG8_SB(0, 0), b2, voffB); PG8_STAGE(PG8_SB(0, 1), b2 + hstep, voffB); PG8_STAGE(PG8_SA(0, 0), a2, voffA);
            PG8_WAIT_V(8); PG8_WAIT_L(0); PG8_BAR; PG8_MMA(1, 0, At, B0); PG8_MMA(1, 1, At, B1); PG8_BAR; PG8_SCHED;
            PG8_LDB(B0, 1, 0); PG8_LDB(B1, 1, 1); PG8_SCHED; PG8_LDA(At, 1, 0); PG8_STAGE(PG8_SA(0, 1), a2 + hstep, voffA);
            PG8_WAIT_V(8); PG8_WAIT_L(0); PG8_BAR; PG8_MMA(0, 0, At, B0); PG8_MMA(0, 1, At, B1); PG8_BAR; PG8_SCHED;
            PG8_LDA(At, 1, 1); PG8_STAGE(PG8_SB(1, 0), b3, voffB); PG8_STAGE(PG8_SB(1, 1), b3 + hstep, voffB); PG8_STAGE(PG8_SA(1, 0), a3, voffA);
            PG8_WAIT_V(8); PG8_WAIT_L(0); PG8_BAR; PG8_MMA(1, 0, At, B0); PG8_MMA(1, 1, At, B1); PG8_BAR; PG8_SCHED;
            } else {
            PG8_LDB(B0, 0, 0); PG8_SCHED; PG8_LDA(At, 0, 0); PG8_STAGE(PG8_SA(1, 1), a1 + hstep, voffA);
            PG8_WAIT_L(8); PG8_BAR; PG8_WAIT_L(0); PG8_MMA(0, 0, At, B0); PG8_BAR; PG8_SCHED;
            PG8_LDB(B1, 0, 1); PG8_STAGE(PG8_SB(0, 0), b2, voffB);
            PG8_BAR; PG8_WAIT_L(0); PG8_MMA(0, 1, At, B1); PG8_BAR;
            PG8_LDA(At, 0, 1); PG8_STAGE(PG8_SA(0, 0), a2, voffA);
            PG8_BAR; PG8_WAIT_L(0); PG8_MMA(1, 0, At, B0); PG8_BAR; PG8_SCHED;
            PG8_STAGE(PG8_SB(0, 1), b2 + hstep, voffB);
            PG8_WAIT_V(6); PG8_BAR; PG8_MMA(1, 1, At, B1); PG8_BAR;
            PG8_LDB(B0, 1, 0); PG8_SCHED; PG8_LDA(At, 1, 0); PG8_STAGE(PG8_SA(0, 1), a2 + hstep, voffA);
            PG8_WAIT_L(8); PG8_BAR; PG8_WAIT_L(0); PG8_MMA(0, 0, At, B0); PG8_BAR; PG8_SCHED;
            PG8_LDB(B1, 1, 1); PG8_STAGE(PG8_SB(1, 0), b3, voffB);
            PG8_BAR; PG8_WAIT_L(0); PG8_MMA(0, 1, At, B1); PG8_BAR;
            PG8_LDA(At, 1, 1); PG8_STAGE(PG8_SA(1, 0), a3, voffA);
            PG8_BAR; PG8_WAIT_L(0); PG8_MMA(1, 0, At, B0); PG8_BAR; PG8_SCHED;
            PG8_STAGE(PG8_SB(1, 1), b3 + hstep, voffB);
            PG8_WAIT_V(6); PG8_BAR; PG8_MMA(1, 1, At, B1); PG8_BAR;
            }
        }
        if constexpr (ALIGN_EPI) { if (wr == 0) PG8_BAR; }
        if constexpr (!Epi::AFTER_DRAIN) { E(acc, cur, wr, wc, fr, fq); S.done(cur); }
        if (!has_next) break;
#pragma unroll
        for (int a = 0; a < 2; ++a)
#pragma unroll
            for (int b = 0; b < 2; ++b)
#pragma unroll
                for (int m = 0; m < 4; ++m)
#pragma unroll
                    for (int n = 0; n < 2; ++n) acc[a][b][m][n] = (f32x4){0.f, 0.f, 0.f, 0.f};
        cur = nxt; cA = nA; cB = nB; ++ui;
        if constexpr (ALIGN_EPI) { if (wr == 1) PG8_BAR; }
    }
    PG8_WAIT_V(0);
    if constexpr (!ALIGN_EPI) { if (wr == 0) PG8_BAR; }
    PG8_BAR;
    if constexpr (Epi::AFTER_DRAIN) { E.fused(acc, cur, wr, wc, fr, fq, lds, wid, lane); S.done(cur); }
#undef PG8_SA
#undef PG8_SB
#undef PG8_STAGE
#undef PG8_LDA
#undef PG8_LDB
#undef PG8_MMA
#undef PG8_WAIT_V
#undef PG8_WAIT_L
#undef PG8_BAR
#undef PG8_SCHED
}
__device__ __forceinline__ void map_tile(int L, int nM, int nN, int& pm, int& pn) {
    const int nwg = nM * nN; int wgid = L; { const int q = nwg / NXCD, r = nwg % NXCD, xcd = wgid % NXCD, off = wgid / NXCD; wgid = (xcd < r ? xcd * (q + 1) : r * (q + 1) + (xcd - r) * q) + off; }
    const int nig = WGM * nN, gid = wgid / nig, fm = gid * WGM, gsz = (nM - fm) < WGM ? (nM - fm) : WGM;
    pm = fm + ((wgid % nig) % gsz); pn = (wgid % nig) / gsz;
}
constexpr int MP = T / 256, WP = NMAIN / 256, NU2 = 4 * MP, NU1 = MP * WP;
struct InOrder { int G, c;
    __device__ __forceinline__ bool next(int i, Unit& u) const { const int L = i * G + c; if (L >= NU2 + NU1) return false; int a, b;
        if (L < NU2) { map_tile(L, 4, MP, a, b); u.pm = MP + WP + a; u.pn = b; } else { map_tile(L - NU2, MP, WP, a, b); u.pm = a; u.pn = MP + b; } return true; }
    __device__ __forceinline__ void a_ready(const Unit&) const {}
    __device__ __forceinline__ void done(const Unit&) const {}
};
struct EpiIn { static constexpr bool PERM = true, AFTER_DRAIN = false; bf16_t* P; float* G; bf16_t* HTp;
    __device__ __forceinline__ void operator()(const f32x4 (&acc)[2][2][4][2], const Unit& u, int wr, int wc, int fr, int fq) const {
        if (u.pm < MP) { const int pn = u.pn - MP, row0 = u.pm * BM + wr * 64 + fr;
            if (pn < NP / 256) { const int col0 = pn * BM + wc * 32 + 8 * fq;
#pragma unroll
                for (int ai = 0; ai < 2; ++ai)
#pragma unroll
                    for (int m = 0; m < 4; ++m) { bf16_t* rowp = P + (size_t)(row0 + ai * HALF + m * 16) * NP + col0;
#pragma unroll
                        for (int bj = 0; bj < 2; ++bj) { const f32x4 v0 = acc[ai][bj][m][0], v1 = acc[ai][bj][m][1];
                            u32x4 w; w.x = cvt_pk_bf16(v0[0], v0[1]); w.y = cvt_pk_bf16(v0[2], v0[3]); w.z = cvt_pk_bf16(v1[0], v1[1]); w.w = cvt_pk_bf16(v1[2], v1[3]); *(u32x4*)(rowp + bj * HALF) = w; } } }
            else { const int cb = wc * 32 + 8 * fq;
                if (cb < NG) {
#pragma unroll
                    for (int ai = 0; ai < 2; ++ai)
#pragma unroll
                        for (int m = 0; m < 4; ++m) { float* rowb = G + (size_t)(row0 + ai * HALF + m * 16) * NGS; const f32x4 v0 = acc[ai][0][m][0], v1 = acc[ai][0][m][1];
                            if (cb < 16) { *(f32x4*)(rowb + cb) = v0; *(f32x4*)(rowb + cb + 4) = v1; }
                            else { u32x4 w; w.x = cvt_pk_bf16(v0[0], v0[1]); w.y = cvt_pk_bf16(v0[2], v0[3]); w.z = cvt_pk_bf16(v1[0], v1[1]); w.w = cvt_pk_bf16(v1[2], v1[3]); *(u32x4*)((bf16_t*)(rowb + 16) + (cb - 16)) = w; } } } } }
        else { const int row0 = (u.pm - MP - WP) * BM + wr * 64 + fr, col0 = u.pn * BM + wc * 32 + 8 * fq;
#pragma unroll
            for (int ai = 0; ai < 2; ++ai)
#pragma unroll
                for (int m = 0; m < 4; ++m) { bf16_t* rowp = HTp + (size_t)(row0 + ai * HALF + m * 16) * T + col0;
#pragma unroll
                    for (int bj = 0; bj < 2; ++bj) { const f32x4 v0 = acc[ai][bj][m][0], v1 = acc[ai][bj][m][1];
                        u32x4 w; w.x = cvt_pk_bf16(v0[0], v0[1]); w.y = cvt_pk_bf16(v0[2], v0[3]); w.z = cvt_pk_bf16(v1[0], v1[1]); w.w = cvt_pk_bf16(v1[2], v1[3]); *(u32x4*)(rowp + bj * HALF) = w; } } }
    }
};
struct OutOrder { int G, c; bool lat_only; unsigned* cnt;
    __device__ __forceinline__ bool next(int i, Unit& u) const { constexpr int nN = DM / 256, nLat = NB * (SEQ / 256) * nN, nCtx = NB * (CTXL / 256) * nN; const int L = i * G + c; int a, b;
        if (L < nLat) { map_tile(L, nLat / nN, nN, a, b); u.pm = (a / (SEQ / 256)) * (TOK / 256) + CTXL / 256 + a % (SEQ / 256); }
        else { if (lat_only || L >= nLat + nCtx) return false; map_tile(L - nLat, nCtx / nN, nN, a, b); u.pm = (a / (CTXL / 256)) * (TOK / 256) + a % (CTXL / 256); }
        u.pn = b; return true; }
    __device__ __forceinline__ void a_ready(const Unit&) const {}
    unsigned* xu; unsigned nloc, xtarget;
    __device__ __forceinline__ void done(const Unit& u) const {
        asm volatile("s_waitcnt vmcnt(0)" ::: "memory"); __builtin_amdgcn_s_barrier();
        if (threadIdx.x == 0) { const bool isctx = (u.pm % (TOK / 256)) < CTXL / 256;
            if (!isctx && xtarget != 0u) {
                const unsigned old = __hip_atomic_fetch_add(xu, 1u, __ATOMIC_RELAXED, __HIP_MEMORY_SCOPE_AGENT);
                if (old + 1u == xtarget) { __builtin_amdgcn_fence(__ATOMIC_RELEASE, "agent"); asm volatile("s_waitcnt vmcnt(0)" ::: "memory");
                    __hip_atomic_fetch_add(cnt, nloc, __ATOMIC_RELAXED, __HIP_MEMORY_SCOPE_AGENT); } }
            else { __builtin_amdgcn_fence(__ATOMIC_RELEASE, "agent"); asm volatile("s_waitcnt vmcnt(0)" ::: "memory");
                __hip_atomic_fetch_add(cnt + (isctx ? 64 : 0), 1u, __ATOMIC_RELAXED, __HIP_MEMORY_SCOPE_AGENT); } } }
};
struct EpiOut { static constexpr bool PERM = true, AFTER_DRAIN = false; bf16_t* C;
    __device__ __forceinline__ void operator()(const f32x4 (&acc)[2][2][4][2], const Unit& u, int wr, int wc, int fr, int fq) const {
        const int row0 = u.pm * BM + wr * 64 + fr, col0 = u.pn * BM + wc * 32 + 8 * fq;
#pragma unroll
        for (int ai = 0; ai < 2; ++ai)
#pragma unroll
            for (int m = 0; m < 4; ++m) { bf16_t* rowp = C + (size_t)(row0 + ai * HALF + m * 16) * DM + col0;
#pragma unroll
                for (int bj = 0; bj < 2; ++bj) { const f32x4 v0 = acc[ai][bj][m][0], v1 = acc[ai][bj][m][1];
                    u32x4 w; w.x = cvt_pk_bf16(v0[0], v0[1]); w.y = cvt_pk_bf16(v0[2], v0[3]); w.z = cvt_pk_bf16(v1[0], v1[1]); w.w = cvt_pk_bf16(v1[2], v1[3]); *(u32x4*)(rowp + bj * HALF) = w; } }
    }
};
}
#endif

__device__ __forceinline__ void phase_gemm_in(const Params& p, int l, char* smem) {
    constexpr int N_F = WG / 2;
#ifdef EMU
    constexpr int MT = T / 128, NT1 = NMAIN / 128, N1 = MT * NT1, N2 = 8 * MT;
    for (int task = obid(); task < N1 + N2; task += gridDim.x) {
        if (task < N1) gemm_tile(p, (const bf16*)(p.ws + WS_HNY), (const bf16*)(p.ws + WS_WIN), DM, task / NT1, task % NT1, 0, smem);
        else { const int t2 = task - N1; gemm_tile(p, (const bf16*)(p.ws + WS_WIN) + (size_t)NMAIN * DM, (const bf16*)(p.ws + WS_HNY), DM, t2 / MT, t2 % MT, 2, smem); }
    }
#else
    { const pg8::Gemm g{(const pg8::bf16_t*)(p.ws + WS_HNY), (const pg8::bf16_t*)(p.ws + WS_HNY), 0, 0, DM};
      const pg8::InOrder S{(int)gridDim.x, obid()};
      const pg8::EpiIn E{(pg8::bf16_t*)(p.ws + WS_P), (float*)(p.ws + WS_G), (pg8::bf16_t*)(p.ws + WS_HT)};
      pg8::gemm_phase<pg8::EpiIn, pg8::InOrder, true, true>((PG8_LAS unsigned char*)smem, g, S, E); }
#endif
    { const int G = (int)gridDim.x, bid = obid();
#ifdef EMU
      const int extra = 0;
#else
      const int extra = (pg8::NU1 + pg8::NU2) % G;
#endif
      if (extra > 0 && extra < G) { if (bid >= extra) for (int task = bid - extra; task < N_F; task += G - extra) filt_fft_task(p, task, smem); }
      else for (int task = G - 1 - bid; task < N_F; task += G) filt_fft_task(p, task, smem); }
}
__device__ __forceinline__ void phase_gemm_out(const Params& p, int l, char* smem) {
    const int G = (int)gridDim.x, bid = obid(); const bool has_ctx = l < DEPTH - 1;
#ifdef EMU
    constexpr int MT = T / 128, NTO = DM / 128;
    for (int task = bid; task < MT * NTO; task += G) {
        const int mt = task / NTO, nt = task % NTO;
        if (!has_ctx && (mt % (TOK / 128)) < CTXL / 128) continue;
        gemm_tile(p, (const bf16*)(p.ws + WS_HNY), (const bf16*)(p.ws + WS_WOUT), MIX, mt, nt, 1, smem);
        __syncthreads(); if (otid() == 0) *unit_counter(p, (mt % (TOK / 128)) < CTXL / 128 ? 1 : 0) += 1u;
    }
#else
    const pg8::Gemm g{(const pg8::bf16_t*)(p.ws + WS_HNY), (const pg8::bf16_t*)(p.ws + WS_WOUT), 0, 0, MIX};
    const unsigned xcc = (unsigned)__builtin_amdgcn_s_getreg((3 << 11) | 20) & 0xFu, nloc = ((volatile PG8_LAS unsigned*)(smem + LDS_BYTES - 64))[0];
    const bool agg = (NB * (SEQ / 256) * (DM / 256) == G) && nloc > 0u;
    const pg8::OutOrder S{G, bid, !has_ctx, unit_counter(p, 0), unit_counter(p, 2) + 16 * xcc, nloc, agg ? nloc * (unsigned)(l + 1) : 0u};
    const pg8::EpiOut E{(pg8::bf16_t*)(p.ws + WS_P)};
    pg8::gemm_phase<pg8::EpiOut, pg8::OutOrder, true, true>((PG8_LAS unsigned char*)smem, g, S, E);
#endif
}

__device__ __forceinline__ size_t st_index(int mixer, int dir, int b, int h, int cid) { return ((((size_t)(mixer * 2 + dir) * NB + b) * NH + h) * NCH + cid); }
__device__ __forceinline__ size_t ch_index(int dir, int b, int h, int cid) { return (((size_t)dir * NB + b) * NH + h) * NCH + cid; }

__device__ __forceinline__ void load_tile_nat(const bf16* P, int r0, int c0, bf16* dst, float scale, int tid) {
    const int s = tid >> 3, c8 = tid & 7;
    const u32x4 v = *(const u32x4*)(P + (size_t)(r0 + s) * NP + c0 + c8 * 8);
    if (scale == 1.0f) *(u32x4*)(dst + s * LS + c8 * 8) = v;
    else { float f[8]; unpack8(v, f); u32x4 o; o.x = pk2(f[0] * scale, f[1] * scale); o.y = pk2(f[2] * scale, f[3] * scale); o.z = pk2(f[4] * scale, f[5] * scale); o.w = pk2(f[6] * scale, f[7] * scale);
        *(u32x4*)(dst + s * LS + c8 * 8) = o; }
}
__device__ __forceinline__ void load_tile_tr(const bf16* P, int r0, int c0, bf16* dst, int tid) {
    const int s = tid >> 3, c8 = tid & 7;
    const u32x4 v = *(const u32x4*)(P + (size_t)(r0 + s) * NP + c0 + c8 * 8);
    const unsigned w[4] = {v.x, v.y, v.z, v.w};
#pragma unroll
    for (int j = 0; j < 4; ++j) { dst[(c8 * 8 + 2 * j) * LS + s] = (bf16)(w[j] & 0xffffu); dst[(c8 * 8 + 2 * j + 1) * LS + s] = (bf16)(w[j] >> 16); }
}

template <int NTK>
__device__ __forceinline__ void load_span(const bf16* row, int t0, float (&v)[NTK + 2]) {
    v[0] = t0 > 0 ? bf2f(row[-1]) : 0.f; v[NTK + 1] = (t0 + NTK < SEQ) ? bf2f(row[NTK]) : 0.f;
    if constexpr (NTK == 8) { float f[8]; unpack8(*(const u32x4*)row, f);
#pragma unroll
        for (int i = 0; i < 8; ++i) v[1 + i] = f[i]; }
    else {
#pragma unroll
        for (int i = 0; i < NTK; ++i) v[1 + i] = bf2f(row[i]); }
}
template <int NTK>
__device__ __forceinline__ void hy_inputs(const bf16* h0, const bf16* h1, const float* cw, const float* cb, int c, int t0, float (&u0)[NTK], float (&u1)[NTK], float (&g0)[NTK], float (&g1)[NTK]) {
    { float xa[NTK + 2], xb[NTK + 2]; load_span<NTK>(h0 + (size_t)512 * T, t0, xa); load_span<NTK>(h1 + (size_t)512 * T, t0, xb);
        const float w0 = cw[0 * 768 + 512 + c], w1 = cw[1 * 768 + 512 + c], w2 = cw[2 * 768 + 512 + c], bb = cb[512 + c];
        float ga[NTK + 2], gb[NTK + 2]; load_span<NTK>(h0 + (size_t)768 * T, t0, ga); load_span<NTK>(h1 + (size_t)768 * T, t0, gb);
#pragma unroll
        for (int i = 0; i < NTK; ++i) { g0[i] = (w0 * xa[i] + w1 * xa[i + 1] + w2 * xa[i + 2] + bb) * siluf_(ga[i + 1]); g1[i] = (w0 * xb[i] + w1 * xb[i + 1] + w2 * xb[i + 2] + bb) * siluf_(gb[i + 1]); } }
    { float va[NTK + 2], vb[NTK + 2], ya[NTK + 2], yb[NTK + 2];
        load_span<NTK>(h0, t0, va); load_span<NTK>(h1, t0, vb); load_span<NTK>(h0 + (size_t)256 * T, t0, ya); load_span<NTK>(h1 + (size_t)256 * T, t0, yb);
        const float v0 = cw[0 * 768 + c], v1 = cw[1 * 768 + c], v2 = cw[2 * 768 + c], vbias = cb[c];
        const float y0 = cw[0 * 768 + 256 + c], y1 = cw[1 * 768 + 256 + c], y2 = cw[2 * 768 + 256 + c], ybias = cb[256 + c];
#pragma unroll
        for (int i = 0; i < NTK; ++i) { u0[i] = (v0 * va[i] + v1 * va[i + 1] + v2 * va[i + 2] + vbias) * (y0 * ya[i] + y1 * ya[i + 1] + y2 * ya[i + 2] + ybias);
            u1[i] = (v0 * vb[i] + v1 * vb[i + 1] + v2 * vb[i + 2] + vbias) * (y0 * yb[i] + y1 * yb[i + 1] + y2 * yb[i + 2] + ybias); } }
}
__device__ __forceinline__ void hylat_task(const Params& p, int l, int bp, int cp, char* smem) {
    const int tid = otid(), half = tid >> 8, tl = tid & 255, c = 2 * cp + half;
    const bf16* HT = (const bf16*)(p.ws + WS_HT); bf16* Y = (bf16*)(p.ws + WS_HNY);
    cpx* buf = (cpx*)smem + (size_t)half * FBUF;
    const cpx* TW = (const cpx*)(p.ws + WS_TW);
    const cpx* KF = (const cpx*)(p.ws + WS_KF) + (size_t)c * NF;
    constexpr int NTK = SEQ / 256;
    const int t0 = NTK * tl;
    const float* cw = p.in[I_HCW] + (size_t)l * 3 * 768; const float* cb = p.in[I_HCB] + (size_t)l * 768;
    const size_t rb0 = (size_t)(2 * bp) * TOK + CTXL, rb1 = rb0 + TOK;
    const bf16* h0 = HT + (size_t)c * T + rb0 + t0; const bf16* h1 = h0 + TOK;
    { float u0[NTK], u1[NTK], g0[NTK], g1[NTK]; hy_inputs<NTK>(h0, h1, cw, cb, c, t0, u0, u1, g0, g1);
        __syncthreads();
#pragma unroll
        for (int i = 0; i < NTK; ++i) { cpx v; v.x = u0[i]; v.y = u1[i]; buf[FPH(t0 + i)] = v; cpx z = {0.f, 0.f}; buf[FPH(SEQ + t0 + i)] = z; } }
    fft_fwd(buf, TW, tl);
#pragma unroll 2
    for (int i = tl; i < NF; i += 256) buf[FPH(i)] = cmul(buf[FPH(i)], KF[i]);
    fft_inv(buf, TW, tl);
    const float dsk = p.in[I_HD][(size_t)l * WG + c]; const float sc = 1.0f / (float)NF;
    { const int tz = otid() & 255; const int t0z = NTK * tz;
        float u0[NTK], u1[NTK], g0[NTK], g1[NTK]; hy_inputs<NTK>(HT + (size_t)c * T + rb0 + t0z, HT + (size_t)c * T + rb0 + t0z + TOK, cw, cb, c, t0z, u0, u1, g0, g1);
        float o0[NTK], o1[NTK];
#pragma unroll
        for (int i = 0; i < NTK; ++i) { const cpx y = buf[FPH(t0z + i)]; o0[i] = g0[i] * (y.x * sc + u0[i] * dsk); o1[i] = g1[i] * (y.y * sc + u1[i] * dsk); }
        bf16* d0 = (bf16*)(p.ws + WS_HT) + (size_t)(768 + c) * T + rb0 + t0z; bf16* d1 = d0 + TOK;
        if constexpr (NTK == 8) { *(u32x4*)d0 = pack8(o0); *(u32x4*)d1 = pack8(o1); }
        else {
#pragma unroll
            for (int i = 0; i < NTK; ++i) { d0[i] = f2bf(o0[i]); d1[i] = f2bf(o1[i]); } } }
}

constexpr int HCB = 16;
__device__ __forceinline__ void hyctx_task(const Params& p, int l, int b, int cblk, char* smem) {
    const int tid = otid(); const int c0 = cblk * HCB;
    const bf16* HT = (const bf16*)(p.ws + WS_HT); bf16* Y = (bf16*)(p.ws + WS_HNY); const float* HC = (const float*)(p.ws + WS_HC);
    float* raw = (float*)smem;
    float* u = raw + 4 * CTXL * HCB;
    float* og = u + CTXL * HCB;
    float* hcm = og + CTXL * HCB;
    bf16* ob = (bf16*)raw;
    const size_t rb = (size_t)b * TOK;
    const float* cw = p.in[I_HCW] + (size_t)l * 3 * 768; const float* cbias = p.in[I_HCB] + (size_t)l * 768;
    constexpr int WT = CTXL / 32;
    __syncthreads();
    for (int i = tid; i < 4 * HCB * (CTXL / 8); i += NT) { const int k = i / (HCB * (CTXL / 8)), cc = (i / (CTXL / 8)) % HCB, ck = i % (CTXL / 8);
        float f[8]; unpack8(*(const u32x4*)(HT + (size_t)(k * 256 + c0 + cc) * T + rb + ck * 8), f);
#pragma unroll
        for (int j = 0; j < 8; ++j) raw[(k * CTXL + ck * 8 + j) * HCB + cc] = f[j]; }
    for (int i = tid; i < 2 * HCB * (CTXL / 4); i += NT) { const int dir = i / (HCB * (CTXL / 4)), cc = (i / (CTXL / 4)) % HCB, pk = i % (CTXL / 4);
        const f32x4 v = *(const f32x4*)(HC + ((size_t)dir * WG + c0 + cc) * CTXL + pk * 4); const float f[4] = {v.x, v.y, v.z, v.w};
#pragma unroll
        for (int j = 0; j < 4; ++j) { const int pos = pk * 4 + j; if (dir == 0) hcm[(CTXL + pos) * HCB + cc] = f[j]; else if (pos > 0) hcm[(CTXL - pos) * HCB + cc] = f[j]; } }
    if (tid < HCB) hcm[tid] = 0.f;
    __syncthreads();
    for (int i = tid; i < CTXL * HCB; i += NT) { const int t = i / HCB, cc = i % HCB; float cv[3];
#pragma unroll
        for (int k = 0; k < 3; ++k) { const float* rk = raw + k * CTXL * HCB; const int ch = k * 256 + c0 + cc;
            const float a = t > 0 ? rk[(t - 1) * HCB + cc] : 0.f, m = rk[t * HCB + cc], z = t < CTXL - 1 ? rk[(t + 1) * HCB + cc] : 0.f;
            cv[k] = cw[0 * 768 + ch] * a + cw[1 * 768 + ch] * m + cw[2 * 768 + ch] * z + cbias[ch]; }
        u[i] = cv[0] * cv[1];
        og[i] = cv[2] * siluf_(raw[(3 * CTXL + t) * HCB + cc]); }
    __syncthreads();
    { const int cc = tid % HCB, tg = tid / HCB, t0 = WT * tg; float acc[WT], w[WT];
#pragma unroll
        for (int j = 0; j < WT; ++j) { acc[j] = 0.f; w[j] = hcm[(t0 + j + CTXL) * HCB + cc]; }
#pragma unroll 8
        for (int s = 0; s < CTXL; ++s) { const float us = u[s * HCB + cc];
#pragma unroll
            for (int j = 0; j < WT; ++j) acc[j] += us * w[j];
#pragma unroll
            for (int j = WT - 1; j > 0; --j) w[j] = w[j - 1];
            w[0] = hcm[(t0 - s - 1 + CTXL) * HCB + cc]; }
        const float dsk = p.in[I_HD][(size_t)l * WG + c0 + cc];
#pragma unroll
        for (int j = 0; j < WT; ++j) { const int t = t0 + j; ob[t * HCB + cc] = f2bf(og[t * HCB + cc] * (acc[j] + u[t * HCB + cc] * dsk)); } }
    __syncthreads();
    for (int i = tid; i < CTXL * 2; i += NT) { const int t = i >> 1, hh = i & 1; *(u32x4*)(Y + (rb + t) * 1024 + YH + c0 + 8 * hh) = *(const u32x4*)(ob + t * HCB + 8 * hh); }
}

__device__ __forceinline__ void attn_task(const Params& p, int l, int b, int kvh, int qt, bool ctxq, char* smem) {
    const int tid = otid(), lane = tid & 63, wave = tid >> 6, r = lane & 15, q = lane >> 4;
    const bf16* P = (const bf16*)(p.ws + WS_P); bf16* Y = (bf16*)(p.ws + WS_HNY); const cpx* ROPE = (const cpx*)(p.ws + WS_ROPE);
    bf16* Qs = (bf16*)smem;
    bf16* Ks = Qs + 256 * LS;
    bf16* Vt = Ks + 64 * LS;
    bf16* Ps = Vt + 64 * LS;
    const size_t rq0 = (size_t)b * TOK + (ctxq ? 0 : CTXL) + qt * 128;
    __syncthreads();
#pragma unroll
    for (int it = 0; it < 2; ++it) {
        const int idx = tid + NT * it, row = idx >> 2, cpair = idx & 3, g = row >> 7, t = row & 127;
        const bf16* src = P + (rq0 + t) * NP + PD + (kvh * 2 + g) * 64;
        float lo[8], hi[8]; unpack8(*(const u32x4*)(src + cpair * 8), lo); unpack8(*(const u32x4*)(src + 32 + cpair * 8), hi);
        float a[8], c2[8];
#pragma unroll
        for (int j = 0; j < 8; ++j) { float cs = 1.f, sn = 0.f; if (!ctxq) { const cpx cv = ROPE[(size_t)(qt * 128 + t) * 32 + cpair * 8 + j]; cs = cv.x; sn = cv.y; }
            a[j] = (lo[j] * cs - hi[j] * sn) * 0.125f; c2[j] = (hi[j] * cs + lo[j] * sn) * 0.125f; }
        *(u32x4*)(Qs + row * LS + cpair * 8) = pack8(a); *(u32x4*)(Qs + row * LS + 32 + cpair * 8) = pack8(c2);
    }
    const int lt0 = ctxq ? 0 : (2 * qt - 2 > 0 ? 2 * qt - 2 : 0), lt1 = ctxq ? -1 : (2 * qt + 3 < SEQ / 64 - 1 ? 2 * qt + 3 : SEQ / 64 - 1);
    const int nloc = lt1 - lt0 + 1, ntiles = nloc + NCC;
    float m[2][4], lsum[2][4]; f32x4 O[2][4];
#pragma unroll
    for (int ms = 0; ms < 2; ++ms)
#pragma unroll
        for (int i = 0; i < 4; ++i) { m[ms][i] = -INFINITY; lsum[ms][i] = 0.f; O[ms][i] = (f32x4){0.f, 0.f, 0.f, 0.f}; }
    const int g = wave >> 2, tq0 = (wave & 3) * 32;
    bf16* Pw = Ps + wave * 32 * LS;
    u32x4 klo = {0u, 0u, 0u, 0u}, khi = klo, vq = klo; f32x4 rp[4] = {(f32x4){1.f, 0.f, 1.f, 0.f}, (f32x4){1.f, 0.f, 1.f, 0.f}, (f32x4){1.f, 0.f, 1.f, 0.f}, (f32x4){1.f, 0.f, 1.f, 0.f}};
    const int ks_ = tid >> 2, kcp = tid & 3, vs_ = tid >> 3, vc8 = tid & 7;
#define ATT_PREFETCH(TI) do { const bool loc_ = (TI) < nloc; const int kt_ = loc_ ? lt0 + (TI) : (TI) - nloc; const size_t rk_ = (size_t)b * TOK + (loc_ ? CTXL : 0) + kt_ * 64; \
        if (tid < 256) { const bf16* src_ = P + (rk_ + ks_) * NP + PD + 256 + kvh * 64; klo = *(const u32x4*)(src_ + kcp * 8); khi = *(const u32x4*)(src_ + 32 + kcp * 8); \
            if (loc_) { const f32x4* rr_ = (const f32x4*)(ROPE + (size_t)(kt_ * 64 + ks_) * 32 + kcp * 8); rp[0] = rr_[0]; rp[1] = rr_[1]; rp[2] = rr_[2]; rp[3] = rr_[3]; } \
            else { rp[0] = rp[1] = rp[2] = rp[3] = (f32x4){1.f, 0.f, 1.f, 0.f}; } } \
        vq = *(const u32x4*)(P + (rk_ + vs_) * NP + PD + 384 + kvh * 64 + vc8 * 8); } while (0)
    ATT_PREFETCH(0);
    for (int ti = 0; ti < ntiles; ++ti) {
        const bool local = ti < nloc; const int kt = local ? lt0 + ti : ti - nloc;
        __syncthreads();
        if (tid < 256) { float lo[8], hi[8]; unpack8(klo, lo); unpack8(khi, hi);
            const float cs[8] = {rp[0].x, rp[0].z, rp[1].x, rp[1].z, rp[2].x, rp[2].z, rp[3].x, rp[3].z}, sn[8] = {rp[0].y, rp[0].w, rp[1].y, rp[1].w, rp[2].y, rp[2].w, rp[3].y, rp[3].w};
            float a[8], c2[8];
#pragma unroll
            for (int j = 0; j < 8; ++j) { a[j] = lo[j] * cs[j] - hi[j] * sn[j]; c2[j] = hi[j] * cs[j] + lo[j] * sn[j]; }
            *(u32x4*)(Ks + ks_ * LS + kcp * 8) = pack8(a); *(u32x4*)(Ks + ks_ * LS + 32 + kcp * 8) = pack8(c2); }
        { const unsigned w[4] = {vq.x, vq.y, vq.z, vq.w};
#pragma unroll
            for (int j = 0; j < 4; ++j) { Vt[(vc8 * 8 + 2 * j) * LS + vs_] = (bf16)(w[j] & 0xffffu); Vt[(vc8 * 8 + 2 * j + 1) * LS + vs_] = (bf16)(w[j] >> 16); } }
        __syncthreads();
        if (ti + 1 < ntiles) ATT_PREFETCH(ti + 1);
#pragma unroll
        for (int ms = 0; ms < 2; ++ms) {
            const int qlo = qt * 128 + tq0 + 16 * ms, klo_ = kt * 64;
            if (local && (klo_ > qlo + 15 + 128 || klo_ + 63 < qlo - 128)) continue;
            f32x4 S[4] = {(f32x4){0.f, 0.f, 0.f, 0.f}, (f32x4){0.f, 0.f, 0.f, 0.f}, (f32x4){0.f, 0.f, 0.f, 0.f}, (f32x4){0.f, 0.f, 0.f, 0.f}};
            mma_nt<4, 2>(Qs, LS, g * 128 + tq0 + 16 * ms, Ks, LS, 0, S, lane);
            float rmax[4];
#pragma unroll
            for (int i = 0; i < 4; ++i) { const int qpos = qlo + 4 * q + i; float mx = -INFINITY;
#pragma unroll
                for (int nt = 0; nt < 4; ++nt) { if (local) { const int kpos = kt * 64 + nt * 16 + r; const int d = kpos - qpos; if (d > 128 || d < -128) S[nt][i] = -INFINITY; } mx = fmaxf(mx, S[nt][i]); }
                rmax[i] = row16_max(mx); }
#pragma unroll
            for (int i = 0; i < 4; ++i) { const float mn = fmaxf(m[ms][i], rmax[i]); const float msafe = mn == -INFINITY ? 0.f : mn; const float alpha = __expf(m[ms][i] - msafe); float sm = 0.f;
#pragma unroll
                for (int nt = 0; nt < 4; ++nt) { const float pv = __expf(S[nt][i] - msafe); sm += pv; Pw[(16 * ms + 4 * q + i) * LS + nt * 16 + r] = f2bf(pv); O[ms][nt][i] *= alpha; }
                sm = row16_sum(sm);
                lsum[ms][i] = lsum[ms][i] * alpha + sm; m[ms][i] = mn; }
            WAVE_SYNC();
            mma_nt<4, 2>(Pw, LS, 16 * ms, Vt, LS, 0, O[ms], lane);
        }
    }
#undef ATT_PREFETCH
    const float sink = p.in[I_SINK][(size_t)l * NH + kvh * 2 + g];
    WAVE_SYNC();
#pragma unroll
    for (int ms = 0; ms < 2; ++ms)
#pragma unroll
        for (int i = 0; i < 4; ++i) { const float den = lsum[ms][i] + __expf(sink - m[ms][i]); const float inv = frcp_(den);
#pragma unroll
            for (int nt = 0; nt < 4; ++nt) Pw[(16 * ms + 4 * q + i) * LS + nt * 16 + r] = f2bf(O[ms][nt][i] * inv); }
    WAVE_SYNC();
#pragma unroll
    for (int hh = 0; hh < 4; ++hh) { const int t = lane >> 1, ck = (lane & 1) * 4 + hh;
        float fo[8], fg[8]; unpack8(*(const u32x4*)(Pw + t * LS + ck * 8), fo);
        unpack8(*(const u32x4*)(P + (rq0 + tq0 + t) * NP + PD + 512 + (kvh * 2 + g) * 64 + ck * 8), fg);
#pragma unroll
        for (int j = 0; j < 8; ++j) fo[j] *= siluf_(fg[j]);
        *(u32x4*)(Y + (rq0 + tq0 + t) * 1024 + YD + (kvh * 2 + g) * 64 + ck * 8) = pack8(fo); }
}

#ifdef EMU
__device__ __forceinline__ int olane(int lane) { return lane; }
#else
__device__ __forceinline__ int olane(int lane) { asm volatile("" : "+v"(lane)); return lane; }
#endif
__device__ __forceinline__ void load_nat_tile(const bf16* P, int row0, int col0, bf16* tile, int lane) {
    u32x4 v[8];
#pragma unroll
    for (int i = 0; i < 8; ++i) v[i] = *(const u32x4*)(P + (size_t)(row0 + (lane >> 3) + 8 * i) * NP + col0 + (lane & 7) * 8);
#pragma unroll
    for (int i = 0; i < 8; ++i) *(u32x4*)(tile + swz((lane >> 3) + 8 * i, lane & 7)) = v[i];
}
__device__ __forceinline__ bf16x8 frag_tr(const bf16* tile, int c0, int k0, int lane) {
    const int c = c0 + (lane & 15), kb = k0 + 8 * (lane >> 4); unsigned w[4];
#pragma unroll
    for (int j = 0; j < 4; ++j) w[j] = (unsigned)tile[swz(kb + 2 * j, c >> 3) + (c & 7)] | ((unsigned)tile[swz(kb + 2 * j + 1, c >> 3) + (c & 7)] << 16);
    u32x4 o; o.x = w[0]; o.y = w[1]; o.z = w[2]; o.w = w[3]; return as_frag(o);
}
template <int DIR>
__device__ __forceinline__ void gla_r_frags(const float* Grow0, int lane, bf16x8 (&af)[4]) {
    const int r = lane & 15, q4 = lane >> 4;
#pragma unroll
    for (int mt = 0; mt < 4; ++mt) { u32x4 o = {0u, 0u, 0u, 0u};
        if (q4 < 2) o = *(const u32x4*)((const bf16*)(Grow0 + (size_t)(16 * mt + r) * NGS + 16) + DIR * 16 + 8 * q4);
        af[mt] = as_frag(o); }
}
template <int DIR>
__device__ __forceinline__ float gla_b_col(const Params& p, int l, int h, const bf16x8 (&af)[4], int nt, int lane_, float (&x)[4][4]) {
    const int lane = olane(lane_), r = lane & 15, q4 = lane >> 4, d = h * 64 + 16 * nt + r;
    u32x4 o = {0u, 0u, 0u, 0u};
    if (q4 < 2) { const float* wa = p.in[I_GWA] + ((size_t)(l * 2 + DIR) * 16 + 8 * q4) * WG + d;
        o.x = pk2(wa[0], wa[WG]); o.y = pk2(wa[2 * WG], wa[3 * WG]); o.z = pk2(wa[4 * WG], wa[5 * WG]); o.w = pk2(wa[6 * WG], wa[7 * WG]); }
    const bf16x8 bfr = as_frag(o); const float bias = p.in[I_GBA][(size_t)(l * 2 + DIR) * WG + d];
#pragma unroll
    for (int mt = 0; mt < 4; ++mt) { f32x4 c = {bias, bias, bias, bias}; c = MFMA16(af[mt], bfr, c);
#pragma unroll
        for (int i = 0; i < 4; ++i) x[mt][i] = logsig_fast(c[i]) * (1.0f / 16.0f); }
    float carry = 0.f;
#pragma unroll
    for (int k = 0; k < 4; ++k) { const int mt = DIR == 0 ? k : 3 - k; float* y = x[mt];
        if (DIR == 0) { y[1] += y[0]; y[2] += y[1]; y[3] += y[2]; } else { y[2] += y[3]; y[1] += y[2]; y[0] += y[1]; }
        const float s4 = DIR == 0 ? y[3] : y[0];
        const float t1 = DIR == 0 ? __shfl_up(s4, 16) : __shfl_down(s4, 16), t2 = DIR == 0 ? __shfl_up(s4, 32) : __shfl_down(s4, 32), t3 = DIR == 0 ? __shfl_up(s4, 48) : __shfl_down(s4, 48);
        const int qq = DIR == 0 ? q4 : 3 - q4;
        const float e = (qq >= 1 ? t1 : 0.f) + (qq >= 2 ? t2 : 0.f) + (qq >= 3 ? t3 : 0.f);
        const float tot = __shfl(e + s4, DIR == 0 ? r + 48 : r);
#pragma unroll
        for (int i = 0; i < 4; ++i) y[i] += carry + e;
        carry += tot; }
    return carry;
}

template <int MIXER, int DIR>
__device__ __forceinline__ void chunkst_dir(const Params& p, int l, int b, int h, int cid, const float* Grow0, const unsigned (&kk)[32], const bf16* Vt, bf16* Kt, const float* wvs, float* bendl, int lane_) {
    const int lane = olane(lane_), r = lane & 15, q4 = lane >> 4;
    if constexpr (MIXER == 0) {
        float nacc = 0.f;
#pragma unroll
        for (int c = 0; c < 8; ++c) { float f[8];
#pragma unroll
            for (int j = 0; j < 8; ++j) { const int s = 8 * c + j; const float kv = (s & 1) ? bitsf(kk[s >> 1] & 0xffff0000u) : bitsf(kk[s >> 1] << 16);
                f[j] = kv * 0.125f * wvs[DIR * 64 + s]; nacc += f[j]; }
            *(u32x4*)(Kt + swz(lane, c)) = pack8(f); }
        ((float*)(p.ws + WS_NV))[ch_index(DIR, b, h, cid) * 64 + lane] = nacc;
    } else {
        const bf16* P = (const bf16*)(p.ws + WS_P); const int kcol = PG + 256 + h * 64; const int r0 = b * TOK + cid * 64;
        bf16x8 af[4]; gla_r_frags<DIR>(Grow0, lane, af);
#pragma unroll 2
        for (int nt = 0; nt < 4; ++nt) { const int d = 16 * nt + r; float x[4][4];
            const float bend = gla_b_col<DIR>(p, l, h, af, nt, lane, x);
            if (q4 == 0) { ((float*)(p.ws + WS_BE))[ch_index(DIR, b, h, cid) * 64 + d] = bend; bendl[d] = __expf(fmaxf(bend, -80.0f)); }
#pragma unroll
            for (int mt = 0; mt < 4; ++mt)
#pragma unroll
                for (int i = 0; i < 4; ++i) { const int s = 16 * mt + 4 * q4 + i; const float kv = bf2f(P[(size_t)(r0 + s) * NP + kcol + d]); const float bc = fmaxf(x[mt][i], -80.0f);
                    Kt[swz(d, s >> 3) + (s & 7)] = f2bf(kv * __expf(-bc));
                    ((bf16*)(p.ws + WS_EQ))[((size_t)DIR * T + r0 + s) * WG + h * 64 + d] = f2bf(__expf(bc)); } }
    }
    WAVE_SYNC();
    bf16x8 vf[4][2];
#pragma unroll
    for (int ne = 0; ne < 4; ++ne)
#pragma unroll
        for (int ks = 0; ks < 2; ++ks) vf[ne][ks] = *(const bf16x8*)(Vt + swz(16 * ne + r, ks * 4 + q4));
    bf16* dst = (bf16*)(p.ws + WS_ST) + st_index(MIXER, DIR, b, h, cid) * 4096;
#pragma unroll
    for (int me = 0; me < 4; ++me) {
        f32x4 acc[4] = {(f32x4){0.f, 0.f, 0.f, 0.f}, (f32x4){0.f, 0.f, 0.f, 0.f}, (f32x4){0.f, 0.f, 0.f, 0.f}, (f32x4){0.f, 0.f, 0.f, 0.f}};
#pragma unroll
        for (int ks = 0; ks < 2; ++ks) { const bf16x8 a = *(const bf16x8*)(Kt + swz(16 * me + r, ks * 4 + q4));
#pragma unroll
            for (int ne = 0; ne < 4; ++ne) acc[ne] = MFMA16(a, vf[ne][ks], acc[ne]); }
        f32x4 sc4 = {1.f, 1.f, 1.f, 1.f}; if constexpr (MIXER == 1) sc4 = *(const f32x4*)(bendl + 16 * me + 4 * q4);
#pragma unroll
        for (int ne = 0; ne < 4; ++ne) { const f32x4 v = acc[ne] * sc4; u32x2 o; o.x = pk2(v[0], v[1]); o.y = pk2(v[2], v[3]); *(u32x2*)(dst + (16 * ne + r) * 64 + 16 * me + 4 * q4) = o; }
    }
    WAVE_SYNC();
}
template <int MIXER>
__device__ __forceinline__ void chunkst_w(const Params& p, int l, int b, int h, int cid, char* wl, int lane) {
    const bf16* P = (const bf16*)(p.ws + WS_P); const float* G = (const float*)(p.ws + WS_G);
    const int r0 = b * TOK + cid * 64, r = lane & 15, q4 = lane >> 4;
    bf16* Kt = (bf16*)wl;
    bf16* Vt = Kt + 4096;
    float* wvs = (float*)(Vt + 4096);
    float* bendl = wvs + 128;
    const int kcol = (MIXER == 0 ? PA : PG) + 256 + h * 64, vcol = (MIXER == 0 ? PA : PG) + 512 + h * 64;
    const float* Grow0 = G + (size_t)r0 * NGS;
    { bf16* Nn = Kt;
        load_nat_tile(P, r0, vcol, Nn, lane);
        WAVE_SYNC();
#pragma unroll
        for (int c = 0; c < 8; ++c) { unsigned w[4];
#pragma unroll
            for (int j = 0; j < 4; ++j) w[j] = (unsigned)Nn[swz(8 * c + 2 * j, lane >> 3) + (lane & 7)] | ((unsigned)Nn[swz(8 * c + 2 * j + 1, lane >> 3) + (lane & 7)] << 16);
            u32x4 o; o.x = w[0]; o.y = w[1]; o.z = w[2]; o.w = w[3]; *(u32x4*)(Vt + swz(lane, c)) = o; }
        WAVE_SYNC();
        load_nat_tile(P, r0, kcol, Nn, lane);
        WAVE_SYNC(); }
    unsigned kk[32];
    { const bf16* Nn = Kt;
#pragma unroll
        for (int i = 0; i < 32; ++i) kk[i] = (unsigned)Nn[swz(2 * i, lane >> 3) + (lane & 7)] | ((unsigned)Nn[swz(2 * i + 1, lane >> 3) + (lane & 7)] << 16); }
    WAVE_SYNC();
    if constexpr (MIXER == 0) {
        const float* g = Grow0 + (size_t)lane * NGS; const float* gb = p.in[I_MGB] + (size_t)l * 16;
        const float i_f = g[h] + gb[h], f_f = g[4 + h] + gb[4 + h], i_b = g[8 + h] + gb[8 + h], f_b = g[12 + h] + gb[12 + h];
        const float lf = logsigf_(f_f), lb = logsigf_(f_b);
        const float bF = wave_prefix_sum(lf, lane), totF = __shfl(bF, 63);
        const float gF = totF - bF + i_f, mF = wave_max(gF);
        const float totB = wave_sum(lb), preB = wave_prefix_sum(lb, lane), bB = totB - preB + lb;
        const float gB = totB - bB + i_b, mB = wave_max(gB);
        wvs[lane] = __expf(gF - mF); wvs[64 + lane] = __expf(gB - mB);
        if (lane == 0) { float* SC = (float*)(p.ws + WS_SC);
            SC[ch_index(0, b, h, cid) * 4 + 0] = totF; SC[ch_index(0, b, h, cid) * 4 + 1] = mF;
            SC[ch_index(1, b, h, cid) * 4 + 0] = totB; SC[ch_index(1, b, h, cid) * 4 + 1] = mB; }
    }
    WAVE_SYNC();
    chunkst_dir<MIXER, 0>(p, l, b, h, cid, Grow0, kk, Vt, Kt, wvs, bendl, lane);
    chunkst_dir<MIXER, 1>(p, l, b, h, cid, Grow0, kk, Vt, Kt, wvs, bendl, lane);
}

template <int DIR>
__device__ __forceinline__ void chunkst_gla(const Params& p, int l, int b, int h, int cid, char* wl, int lane_) {
    const bf16* P = (const bf16*)(p.ws + WS_P);
    const int lane = olane(lane_), r0 = b * TOK + cid * 64, r = lane & 15, q4 = lane >> 4;
    bf16* Kt = (bf16*)wl;
    bf16* An = Kt + 4096;
    float* bendl = (float*)(An + 4096);
    const int kcol = PG + 256 + h * 64, vcol = PG + 512 + h * 64;
    const float* Grow0 = (const float*)(p.ws + WS_G) + (size_t)r0 * NGS;
    load_nat_tile(P, r0, vcol, An, lane);
    WAVE_SYNC();
    bf16x8 vf[4][2];
#pragma unroll
    for (int ne = 0; ne < 4; ++ne)
#pragma unroll
        for (int ks = 0; ks < 2; ++ks) vf[ne][ks] = frag_tr(An, 16 * ne, 32 * ks, lane);
    WAVE_SYNC();
    load_nat_tile(P, r0, kcol, An, lane);
    WAVE_SYNC();
    bf16x8 af[4]; gla_r_frags<DIR>(Grow0, lane, af);
#pragma unroll 2
    for (int nt = 0; nt < 4; ++nt) { const int d = 16 * nt + r; float x[4][4];
        const float bend = gla_b_col<DIR>(p, l, h, af, nt, lane, x);
        if (q4 == 0) { ((float*)(p.ws + WS_BE))[ch_index(DIR, b, h, cid) * 64 + d] = bend; bendl[d] = __expf(fmaxf(bend, -80.0f)); }
#pragma unroll
        for (int mt = 0; mt < 4; ++mt)
#pragma unroll
            for (int i = 0; i < 4; ++i) { const int s = 16 * mt + 4 * q4 + i; bf16* ke = An + swz(s, d >> 3) + (d & 7); const float kv = bf2f(*ke); const float bc = fmaxf(x[mt][i], -80.0f);
                Kt[swz(d, s >> 3) + (s & 7)] = f2bf(kv * __expf(-bc));
                *ke = f2bf(__expf(bc)); } }
    WAVE_SYNC();
    { bf16* EQg = (bf16*)(p.ws + WS_EQ) + ((size_t)DIR * T + r0) * WG + h * 64;
#pragma unroll
        for (int i = 0; i < 8; ++i) { const int s = (lane >> 3) + 8 * i, ck = lane & 7; *(u32x4*)(EQg + (size_t)s * WG + ck * 8) = *(const u32x4*)(An + swz(s, ck)); } }
    bf16* dst = (bf16*)(p.ws + WS_ST) + st_index(1, DIR, b, h, cid) * 4096;
#pragma unroll
    for (int me = 0; me < 4; ++me) {
        f32x4 acc[4] = {(f32x4){0.f, 0.f, 0.f, 0.f}, (f32x4){0.f, 0.f, 0.f, 0.f}, (f32x4){0.f, 0.f, 0.f, 0.f}, (f32x4){0.f, 0.f, 0.f, 0.f}};
#pragma unroll
        for (int ks = 0; ks < 2; ++ks) { const bf16x8 a = *(const bf16x8*)(Kt + swz(16 * me + r, ks * 4 + q4));
#pragma unroll
            for (int ne = 0; ne < 4; ++ne) acc[ne] = MFMA16(a, vf[ne][ks], acc[ne]); }
        const f32x4 sc4 = *(const f32x4*)(bendl + 16 * me + 4 * q4);
#pragma unroll
        for (int ne = 0; ne < 4; ++ne) { const f32x4 v = acc[ne] * sc4; u32x2 o; o.x = pk2(v[0], v[1]); o.y = pk2(v[2], v[3]); *(u32x2*)(dst + (16 * ne + r) * 64 + 16 * me + 4 * q4) = o; }
    }
    WAVE_SYNC();
}

template <int MIXER, int DIR>
__device__ __forceinline__ void chunkout_prep(const Params& p, int l, int b, int h, int cid, const float* Grow0, int r0, int pbase, const bf16* EQ, float* gar, int lane_) {
    const int lane = olane(lane_);
    if constexpr (MIXER == 0) {
        const bf16* P = (const bf16*)(p.ws + WS_P);
        const float* g = Grow0 + (size_t)lane * NGS; const float* gb = p.in[I_MGB] + (size_t)l * 16;
        const float ig = g[DIR * 8 + h] + gb[DIR * 8 + h], fg = g[DIR * 8 + 4 + h] + gb[DIR * 8 + 4 + h];
        const float mprev = ((const float*)(p.ws + WS_SC))[ch_index(DIR, b, h, cid) * 4 + 2];
        const float lf = logsigf_(fg); float bb;
        if (DIR == 0) bb = wave_prefix_sum(lf, lane); else { const float tt = wave_sum(lf), pre = wave_prefix_sum(lf, lane); bb = tt - pre + lf; }
        const float a = ig - bb; const float pm = DIR == 0 ? wave_prefix_max(a, lane) : wave_suffix_max(a, lane);
        const float mt_ = fmaxf(bb + mprev, bb + pm);
        float* ga = gar + DIR * 320;
        ga[lane] = bb - mt_; ga[64 + lane] = a; ga[128 + lane] = __expf(bb + mprev - mt_); ga[192 + lane] = __expf(-mt_);
        float* nvl = gar + 640 + DIR * 64;
        nvl[lane] = ((const float*)(p.ws + WS_NV))[ch_index(DIR, b, h, cid) * 64 + lane];
        WAVE_SYNC();
        float dq = 0.f;
#pragma unroll
        for (int c = 0; c < 8; ++c) { float f[8]; unpack8(*(const u32x4*)(P + (size_t)(r0 + lane) * NP + pbase + c * 8), f);
            const f32x4 n0 = *(const f32x4*)(nvl + c * 8), n1 = *(const f32x4*)(nvl + c * 8 + 4);
            dq += f[0] * n0.x + f[1] * n0.y + f[2] * n0.z + f[3] * n0.w + f[4] * n1.x + f[5] * n1.y + f[6] * n1.z + f[7] * n1.w; }
        ga[256 + lane] = dq;
    }
}
template <int MIXER, int DIR, int NS>
__device__ __forceinline__ void chunkout_dir(const Params& p, int b, int h, int cid, int r0, int pbase, int th, const bf16x8 (&vtf)[4][2], const bf16* VtL, const bf16* EQ, bf16* SB, const float* gar, float* rsm, f32x4 (&htot)[NS][4], int lane_) {
    const bf16* P = (const bf16*)(p.ws + WS_P); const bf16* ST = (const bf16*)(p.ws + WS_ST);
    const int lane = olane(lane_), r = lane & 15, q4 = lane >> 4;
    const bf16* E = EQ + ((size_t)DIR * T + r0) * WG + h * 64;
    const float* ga = gar + DIR * 320;
    bf16x8 kf[4][2], ctf[4][2];
#pragma unroll
    for (int n = 0; n < 4; ++n)
#pragma unroll
        for (int ks = 0; ks < 2; ++ks) { if constexpr (MIXER == 0) kf[n][ks] = vtf[n][ks];
            else kf[n][ks] = *(const bf16x8*)(P + (size_t)(r0 + 16 * n + r) * NP + pbase + 256 + ks * 32 + q4 * 8);
            ctf[n][ks] = *(const bf16x8*)(ST + st_index(MIXER, DIR, b, h, cid) * 4096 + (16 * n + r) * 64 + ks * 32 + q4 * 8);
            if constexpr (MIXER == 1) { float fe[8], fk[8]; unpack8(*(const u32x4*)(E + (size_t)(16 * n + r) * WG + ks * 32 + q4 * 8), fe); unpack8(as_u4(kf[n][ks]), fk);
#pragma unroll
                for (int j = 0; j < 8; ++j) fk[j] = fk[j] * frcp_(fe[j]);
                kf[n][ks] = as_frag(pack8(fk)); } }
#pragma unroll
    for (int ms = 0; ms < NS; ++ms) { const int mt = NS * th + ms;
        bf16x8 qf[2];
#pragma unroll
        for (int ks = 0; ks < 2; ++ks) { qf[ks] = *(const bf16x8*)(P + (size_t)(r0 + 16 * mt + r) * NP + pbase + ks * 32 + q4 * 8);
            if constexpr (MIXER == 1) { float fe[8], fq[8]; unpack8(*(const u32x4*)(E + (size_t)(16 * mt + r) * WG + ks * 32 + q4 * 8), fe); unpack8(as_u4(qf[ks]), fq);
#pragma unroll
                for (int j = 0; j < 8; ++j) fq[j] *= 0.125f * fe[j];
                qf[ks] = as_frag(pack8(fq)); } }
        f32x4 S[4] = {(f32x4){0.f, 0.f, 0.f, 0.f}, (f32x4){0.f, 0.f, 0.f, 0.f}, (f32x4){0.f, 0.f, 0.f, 0.f}, (f32x4){0.f, 0.f, 0.f, 0.f}};
#pragma unroll
        for (int ks = 0; ks < 2; ++ks)
#pragma unroll
            for (int n = 0; n < 4; ++n) S[n] = MFMA16(qf[ks], kf[n][ks], S[n]);
#pragma unroll
        for (int i = 0; i < 4; ++i) { const int t = 16 * mt + 4 * q4 + i; float sm = 0.f;
#pragma unroll
            for (int n = 0; n < 4; ++n) { const int s = 16 * n + r; const bool ok = DIR == 0 ? (s <= t) : (s >= t); float v = 0.f;
                if (ok) { if constexpr (MIXER == 0) v = S[n][i] * 0.125f * __expf(ga[t] + ga[64 + s]); else v = S[n][i]; }
                SB[swz(4 * q4 + i, s >> 3) + (s & 7)] = f2bf(v); sm += v; }
            if constexpr (MIXER == 0) { sm = row16_sum(sm); if (r == 0) rsm[4 * q4 + i] = sm; } }
        WAVE_SYNC();
        const bf16x8 sm0 = *(const bf16x8*)(SB + swz(r, q4)), sm1 = *(const bf16x8*)(SB + swz(r, 4 + q4));
        float wi = 1.f, inv = 1.f;
        if constexpr (MIXER == 0) { const int tt = 16 * mt + r; wi = ga[128 + tt]; const float den = wi * ga[256 + tt] + rsm[r]; inv = frcp_(fmaxf(fabsf(den), ga[192 + tt])); }
#pragma unroll
        for (int me = 0; me < 4; ++me) { f32x4 a1 = {0.f, 0.f, 0.f, 0.f}, a2 = {0.f, 0.f, 0.f, 0.f};
            a1 = MFMA16(*(const bf16x8*)(VtL + swz(16 * me + r, q4)), sm0, a1); a1 = MFMA16(*(const bf16x8*)(VtL + swz(16 * me + r, 4 + q4)), sm1, a1);
            a2 = MFMA16(ctf[me][0], qf[0], a2); a2 = MFMA16(ctf[me][1], qf[1], a2);
            if constexpr (MIXER == 0) htot[ms][me] += (a1 + a2 * wi) * inv; else htot[ms][me] += a1 + a2; }
        WAVE_SYNC();
    }
}
__device__ __forceinline__ void co_build_vt(const bf16* P, int r0, int vcol, bf16* VtL, int lane) {
    bf16* Nn = VtL + 4096;
#pragma unroll
    for (int hh = 0; hh < 2; ++hh) {
        u32x4 v[4];
#pragma unroll
        for (int i = 0; i < 4; ++i) v[i] = *(const u32x4*)(P + (size_t)(r0 + 32 * hh + (lane >> 3) + 8 * i) * NP + vcol + (lane & 7) * 8);
#pragma unroll
        for (int i = 0; i < 4; ++i) *(u32x4*)(Nn + swz((lane >> 3) + 8 * i, lane & 7)) = v[i];
        WAVE_SYNC();
#pragma unroll
        for (int c = 0; c < 4; ++c) { unsigned w[4];
#pragma unroll
            for (int j = 0; j < 4; ++j) w[j] = (unsigned)Nn[swz(8 * c + 2 * j, lane >> 3) + (lane & 7)] | ((unsigned)Nn[swz(8 * c + 2 * j + 1, lane >> 3) + (lane & 7)] << 16);
            u32x4 o; o.x = w[0]; o.y = w[1]; o.z = w[2]; o.w = w[3]; *(u32x4*)(VtL + swz(lane, 4 * hh + c)) = o; }
        WAVE_SYNC(); }
}
template <int MIXER, int NS>
__device__ __forceinline__ void co_finalize(const Params& p, int l, int h, int r0, int pbase, int mt0, f32x4 (&htot)[NS][4], int lane_) {
    const bf16* P = (const bf16*)(p.ws + WS_P); bf16* Y = (bf16*)(p.ws + WS_HNY);
    const float* ngp = p.in[MIXER == 0 ? I_MNG : I_GNG] + (size_t)l * WG + h * 64;
    const int lz = olane(lane_), r = lz & 15, q4 = lz >> 4;
    u32x2 gq[NS][4], oq[NS][4];
#pragma unroll
    for (int ms = 0; ms < NS; ++ms)
#pragma unroll
        for (int me = 0; me < 4; ++me) { const size_t off = (size_t)(r0 + 16 * (mt0 + ms) + r) * NP + pbase + 16 * me + 4 * q4;
            gq[ms][me] = *(const u32x2*)(P + off + (MIXER == 0 ? 1024 : 768)); if constexpr (MIXER == 0) oq[ms][me] = *(const u32x2*)(P + off + 768); else oq[ms][me] = (u32x2){0u, 0u}; }
#pragma unroll
    for (int ms = 0; ms < NS; ++ms) { const int mt = mt0 + ms; float ss = 0.f; float gv[4][4];
#pragma unroll
        for (int me = 0; me < 4; ++me) {
            gv[me][0] = bitsf(gq[ms][me].x << 16); gv[me][1] = bitsf(gq[ms][me].x & 0xffff0000u); gv[me][2] = bitsf(gq[ms][me].y << 16); gv[me][3] = bitsf(gq[ms][me].y & 0xffff0000u);
            if constexpr (MIXER == 0) { htot[ms][me][0] *= sigmoidf_(bitsf(oq[ms][me].x << 16)); htot[ms][me][1] *= sigmoidf_(bitsf(oq[ms][me].x & 0xffff0000u)); htot[ms][me][2] *= sigmoidf_(bitsf(oq[ms][me].y << 16)); htot[ms][me][3] *= sigmoidf_(bitsf(oq[ms][me].y & 0xffff0000u)); }
            ss += htot[ms][me][0] * htot[ms][me][0] + htot[ms][me][1] * htot[ms][me][1] + htot[ms][me][2] * htot[ms][me][2] + htot[ms][me][3] * htot[ms][me][3]; }
        ss = xrow_sum(ss);
        const float rstd = rsqrtf(ss * (1.0f / 64.0f) + EPS);
#pragma unroll
        for (int me = 0; me < 4; ++me) { const int e = 16 * me + 4 * q4; const f32x4 n4 = *(const f32x4*)(ngp + e);
            u32x2 o; o.x = pk2(htot[ms][me][0] * rstd * n4.x * siluf_(gv[me][0]), htot[ms][me][1] * rstd * n4.y * siluf_(gv[me][1]));
            o.y = pk2(htot[ms][me][2] * rstd * n4.z * siluf_(gv[me][2]), htot[ms][me][3] * rstd * n4.w * siluf_(gv[me][3]));
            *(u32x2*)(Y + (size_t)(r0 + 16 * mt + r) * 1024 + (MIXER == 0 ? YA : YG) + h * 64 + e) = o; } }
}
template <int MIXER>
__device__ __forceinline__ void chunkout_w(const Params& p, int l, int b, int h, int cid, char* wl, int lane) {
    const bf16* P = (const bf16*)(p.ws + WS_P); const float* G = (const float*)(p.ws + WS_G);
    const int r0 = b * TOK + cid * 64;
    const int pbase = (MIXER == 0 ? PA : PG) + h * 64;
    bf16* SB = (bf16*)wl;
    float* rsm = (float*)(SB + 1024);
    float* gar = rsm + 16;
    const bf16* EQ = (const bf16*)(p.ws + WS_EQ);
    const float* Grow0 = G + (size_t)r0 * NGS;
    bf16* VtL = (bf16*)(gar + 768);
    bf16x8 vtf[4][2];
#pragma unroll
    for (int me = 0; me < 4; ++me)
#pragma unroll
        for (int ks = 0; ks < 2; ++ks) { if constexpr (MIXER == 0) vtf[me][ks] = *(const bf16x8*)(P + (size_t)(r0 + 16 * me + (lane & 15)) * NP + pbase + 256 + ks * 32 + (lane >> 4) * 8); else vtf[me][ks] = (bf16x8){0, 0, 0, 0, 0, 0, 0, 0}; }
    co_build_vt(P, r0, pbase + 512, VtL, lane);
    chunkout_prep<MIXER, 0>(p, l, b, h, cid, Grow0, r0, pbase, EQ, gar, lane);
    chunkout_prep<MIXER, 1>(p, l, b, h, cid, Grow0, r0, pbase, EQ, gar, lane);
    WAVE_SYNC();
    constexpr int NS = MIXER == 1 ? 2 : 1;
#pragma unroll 1
    for (int th = 0; th < 4 / NS; ++th) {
        f32x4 htot[NS][4];
#pragma unroll
        for (int a = 0; a < NS; ++a)
#pragma unroll
            for (int c = 0; c < 4; ++c) htot[a][c] = (f32x4){0.f, 0.f, 0.f, 0.f};
        chunkout_dir<MIXER, 0, NS>(p, b, h, cid, r0, pbase, th, vtf, VtL, EQ, SB, gar, rsm, htot, lane);
        chunkout_dir<MIXER, 1, NS>(p, b, h, cid, r0, pbase, th, vtf, VtL, EQ, SB, gar, rsm, htot, lane);
        co_finalize<MIXER, NS>(p, l, h, r0, pbase, NS * th, htot, lane);
    }
}
constexpr int CO_PART = 13376;
template <int MIXER, int DIR>
__device__ __forceinline__ void chunkout_piece(const Params& p, int l, int b, int h, int cid, int mt, char* wl, int lane) {
    const bf16* P = (const bf16*)(p.ws + WS_P); const float* G = (const float*)(p.ws + WS_G);
    const int r0 = b * TOK + cid * 64; const int pbase = (MIXER == 0 ? PA : PG) + h * 64;
    bf16* SB = (bf16*)wl; float* rsm = (float*)(SB + 1024); float* gar = rsm + 16; const bf16* EQ = (const bf16*)(p.ws + WS_EQ);
    const float* Grow0 = G + (size_t)r0 * NGS; bf16* VtL = (bf16*)(gar + 768);
    bf16x8 vtf[4][2];
#pragma unroll
    for (int me = 0; me < 4; ++me)
#pragma unroll
        for (int ks = 0; ks < 2; ++ks) { if constexpr (MIXER == 0) vtf[me][ks] = *(const bf16x8*)(P + (size_t)(r0 + 16 * me + (lane & 15)) * NP + pbase + 256 + ks * 32 + (lane >> 4) * 8); else vtf[me][ks] = (bf16x8){0, 0, 0, 0, 0, 0, 0, 0}; }
    co_build_vt(P, r0, pbase + 512, VtL, lane);
    chunkout_prep<MIXER, DIR>(p, l, b, h, cid, Grow0, r0, pbase, EQ, gar, lane);
    WAVE_SYNC();
    f32x4 htot[1][4] = {{(f32x4){0.f, 0.f, 0.f, 0.f}, (f32x4){0.f, 0.f, 0.f, 0.f}, (f32x4){0.f, 0.f, 0.f, 0.f}, (f32x4){0.f, 0.f, 0.f, 0.f}}};
    chunkout_dir<MIXER, DIR, 1>(p, b, h, cid, r0, pbase, mt, vtf, VtL, EQ, SB, gar, rsm, htot, lane);
    float* part = (float*)(wl + CO_PART);
#pragma unroll
    for (int me = 0; me < 4; ++me)
#pragma unroll
        for (int i = 0; i < 4; ++i) part[(me * 4 + i) * 64 + lane] = htot[0][me][i];
}
template <int MIXER>
__device__ __forceinline__ void chunkout_combine(const Params& p, int l, int b, int h, int cid, int mt, const char* smem, int lane) {
    const float* pa = (const float*)(smem + (2 * mt) * WLDS + CO_PART); const float* pb = (const float*)(smem + (2 * mt + 1) * WLDS + CO_PART);
    f32x4 htot[1][4];
#pragma unroll
    for (int me = 0; me < 4; ++me)
#pragma unroll
        for (int i = 0; i < 4; ++i) htot[0][me][i] = pa[(me * 4 + i) * 64 + lane] + pb[(me * 4 + i) * 64 + lane];
    co_finalize<MIXER, 1>(p, l, h, b * TOK + cid * 64, (MIXER == 0 ? PA : PG) + h * 64, mt, htot, lane);
}

template <bool OUT>
__device__ __forceinline__ void chunk_workers(const Params& p, int l, char* smem) {
    const int tid = otid(), lane = tid & 63, wave = __builtin_amdgcn_readfirstlane(tid >> 6);
    const int NW = (int)gridDim.x * 8, wi = wave * (int)gridDim.x + obid();
    const int c_lo = (OUT && l == DEPTH - 1) ? NCC : 0, npc = NCH - c_lo, half = NB * NH * npc;
    char* wl = smem + wave * WLDS;
    if (OUT) {
        const int cl = NCC, npl = NCH - NCC, halfl = NB * NH * npl;
#pragma unroll 1
        for (int t = wi; t < halfl; t += NW) { const int b = t / (NH * npl), h = (t / npl) % NH, cid = cl + t % npl;
            const Params q = relaunder(p); chunkout_w<1>(q, l, b, h, cid, wl, lane); }
        { const int used = halfl % NW;
#pragma unroll 1
            for (int t = (wi + NW - used) % NW; t < halfl; t += NW) { const int b = t / (NH * npl), h = (t / npl) % NH, cid = cl + t % npl;
                const Params q = relaunder(p); chunkout_w<0>(q, l, b, h, cid, wl, lane); } }
        if (l < DEPTH - 1) {
            const int nct = NB * NH * NCC;
#pragma unroll 1
            for (int st = obid(); st < 2 * nct; st += (int)gridDim.x) { const int mixer = st / nct, r2 = st % nct, b = r2 / (NH * NCC), h = (r2 / NCC) % NH, cid = r2 % NCC;
                const Params q = relaunder(p); const int mt = wave >> 1;
                __syncthreads();
                if (mixer == 0) { if (wave & 1) chunkout_piece<0, 1>(q, l, b, h, cid, mt, wl, lane); else chunkout_piece<0, 0>(q, l, b, h, cid, mt, wl, lane); }
                else            { if (wave & 1) chunkout_piece<1, 1>(q, l, b, h, cid, mt, wl, lane); else chunkout_piece<1, 0>(q, l, b, h, cid, mt, wl, lane); }
                __syncthreads();
                if (wave < 4) { if (mixer == 0) chunkout_combine<0>(q, l, b, h, cid, wave, smem, lane); else chunkout_combine<1>(q, l, b, h, cid, wave, smem, lane); }
            }
        }
    } else {
        int off = 0;
#pragma unroll 1
        for (int t = wi; t < half; t += NW) { const int b = t / (NH * npc), h = (t / npc) % NH, cid = c_lo + t % npc;
            const Params q = relaunder(p); chunkst_gla<0>(q, l, b, h, cid, wl, lane); }
        off = (off + half) % NW;
#pragma unroll 1
        for (int t = (wi + NW - off) % NW; t < half; t += NW) { const int b = t / (NH * npc), h = (t / npc) % NH, cid = c_lo + t % npc;
            const Params q = relaunder(p); chunkst_gla<1>(q, l, b, h, cid, wl, lane); }
        off = (off + half) % NW;
#pragma unroll 1
        for (int t = (wi + NW - off) % NW; t < half; t += NW) { const int b = t / (NH * npc), h = (t / npc) % NH, cid = c_lo + t % npc;
            const Params q = relaunder(p); chunkst_w<0>(q, l, b, h, cid, wl, lane); }
    }
}

__device__ __forceinline__ void phase_mix1(const Params& p, int l, char* smem) {
    const bool ctxo = l < DEPTH - 1; const int G = (int)gridDim.x, bid = obid();
    constexpr int N_HL = (NB / 2) * (WG / 2), N_HC = NB * (WG / HCB);
    chunk_workers<false>(p, l, smem);
    stage_signal(p, smem, 0, l);
    for (int t = bid; t < N_HL; t += G) hylat_task(p, l, t / (WG / 2), t % (WG / 2), smem);
    if (ctxo) for (int t = G - 1 - bid; t < N_HC; t += G) hyctx_task(p, l, t / (WG / HCB), t % (WG / HCB), smem);
    stage_signal(p, smem, 2, l);
}

constexpr int SCG = 12;
__device__ __forceinline__ void phase_scan(const Params& p, int l, char* smem) {
    const int tid = otid();
    bf16* ST = (bf16*)(p.ws + WS_ST); float* NV = (float*)(p.ws + WS_NV); const float* BE = (const float*)(p.ws + WS_BE); float* SC = (float*)(p.ws + WS_SC);
    constexpr int NCHAIN = 2 * 2 * NB * NH;
    stage_wait(p, 0, l);
    for (int item = obid() * NT + tid; item < NCHAIN * 1024; item += gridDim.x * NT) {
        const int chain = item >> 10, grp = item & 1023; const int mixer = chain / (2 * NB * NH), dir = (chain / (NB * NH)) % 2, b = (chain / NH) % NB, h = chain % NH;
        float c[4] = {0.f, 0.f, 0.f, 0.f}; float nv[4] = {0.f, 0.f, 0.f, 0.f}; float m = 0.f;
        const int d0 = (grp & 15) * 4; const bool donv = (mixer == 0) && (grp < 16);
        for (int o0 = 0; o0 < NCH; o0 += SCG) {
            u32x2 uu[SCG]; float s0[SCG], s1[SCG]; f32x4 be[SCG]; f32x4 nu[SCG];
#pragma unroll
            for (int j = 0; j < SCG; ++j) if (o0 + j < NCH) { const int cid = chain_cid(dir, o0 + j); const size_t ci = ch_index(dir, b, h, cid);
                uu[j] = *(const u32x2*)(ST + st_index(mixer, dir, b, h, cid) * 4096 + grp * 4);
                if (mixer == 0) { s0[j] = SC[ci * 4 + 0]; s1[j] = SC[ci * 4 + 1]; if (donv) nu[j] = *(const f32x4*)(NV + ci * 64 + grp * 4); }
                else be[j] = *(const f32x4*)(BE + ci * 64 + d0); }
#pragma unroll
            for (int j = 0; j < SCG; ++j) if (o0 + j < NCH) { const int cid = chain_cid(dir, o0 + j); const size_t ci = ch_index(dir, b, h, cid);
                const float u[4] = {bitsf(uu[j].x << 16), bitsf(uu[j].x & 0xffff0000u), bitsf(uu[j].y << 16), bitsf(uu[j].y & 0xffff0000u)};
                u32x2 w; w.x = pk2(c[0], c[1]); w.y = pk2(c[2], c[3]); *(u32x2*)(ST + st_index(mixer, dir, b, h, cid) * 4096 + grp * 4) = w;
                if (mixer == 0) {
                    if (grp == 0) SC[ci * 4 + 2] = m;
                    const float mn = fmaxf(s0[j] + m, s1[j]), a = __expf(s0[j] + m - mn), s = __expf(s1[j] - mn);
#pragma unroll
                    for (int k = 0; k < 4; ++k) c[k] = a * c[k] + s * u[k];
                    if (donv) { f32x4 nw = {nv[0], nv[1], nv[2], nv[3]}; *(f32x4*)(NV + ci * 64 + grp * 4) = nw;
                        nv[0] = a * nv[0] + s * nu[j].x; nv[1] = a * nv[1] + s * nu[j].y; nv[2] = a * nv[2] + s * nu[j].z; nv[3] = a * nv[3] + s * nu[j].w; }
                    m = mn;
                } else { c[0] = __expf(be[j].x) * c[0] + u[0]; c[1] = __expf(be[j].y) * c[1] + u[1]; c[2] = __expf(be[j].z) * c[2] + u[2]; c[3] = __expf(be[j].w) * c[3] + u[3]; } }
        }
    }
    stage_signal(p, smem, 1, l);
    { const bool ctxo = l < DEPTH - 1; const int G = (int)gridDim.x, bid = obid();
        constexpr int QTL = SEQ / 128, QTC = CTXL / 128, N_AL = NB * 2 * QTL, N_AC = NB * 2 * QTC;
        for (int t = bid; t < N_AL; t += G) attn_task(p, l, t / (2 * QTL), (t / QTL) % 2, t % QTL, false, smem);
        if (ctxo) for (int t = (bid + G - 64 % G) % G; t < N_AC; t += G) attn_task(p, l, t / (2 * QTC), (t / QTC) % 2, t % QTC, true, smem); }
}

__device__ __forceinline__ void phase_mix2(const Params& p, int l, char* smem) {
    const int tid = otid();
    stage_wait(p, 1, l);
    chunk_workers<true>(p, l, smem);
    stage_wait(p, 2, l);
    constexpr int N_WOUT = (DM / 64) * (MIX / 64);
    { const int lane = tid & 63, wave = __builtin_amdgcn_readfirstlane(tid >> 6); const int NW = (int)gridDim.x * 8, wi = wave * (int)gridDim.x + obid();
        for (int task = NW - 1 - wi; task < N_WOUT; task += NW) { const int nt = task / (MIX / 64), kt = task % (MIX / 64);
            convert_tile_w(p.in[I_WOUT] + (size_t)l * MIX * DM, DM, (bf16*)(p.ws + WS_WOUT), MIX, nt * 64, kt * 64, false, smem + wave * WLDS, lane); }
        bf16* tile = (bf16*)(smem + wave * WLDS); const bf16* HT = (const bf16*)(p.ws + WS_HT); bf16* Y = (bf16*)(p.ws + WS_HNY);
        constexpr int NTT = NB * (SEQ / 64) * 4;
        for (int t = wi; t < NTT; t += NW) { const int b = t / ((SEQ / 64) * 4), tt = (t / 4) % (SEQ / 64), c0 = (t % 4) * 64; const size_t tok0 = (size_t)b * TOK + CTXL + tt * 64;
#pragma unroll
            for (int i = 0; i < 8; ++i) { const int ch = (lane >> 3) + 8 * i, ck = lane & 7; *(u32x4*)(tile + swz(ch, ck)) = *(const u32x4*)(HT + (size_t)(768 + c0 + ch) * T + tok0 + ck * 8); }
            WAVE_SYNC();
#pragma unroll
            for (int i = 0; i < 8; ++i) { const int tk = (lane >> 3) + 8 * i, cc = lane & 7; unsigned w[4];
#pragma unroll
                for (int j = 0; j < 4; ++j) { const int ca = cc * 8 + 2 * j; w[j] = (unsigned)tile[swz(ca, tk >> 3) + (tk & 7)] | ((unsigned)tile[swz(ca + 1, tk >> 3) + (tk & 7)] << 16); }
                u32x4 o; o.x = w[0]; o.y = w[1]; o.z = w[2]; o.w = w[3]; *(u32x4*)(Y + (tok0 + tk) * 1024 + YH + c0 + cc * 8) = o; }
            WAVE_SYNC(); } }
}


#ifndef EMU
#define LAS __attribute__((address_space(3)))
#define XB_TMO      128
#define XB_XCNT(j)  (256  + 64 * (j))
#define XB_XSUB(j)  (1280 + 64 * (j))
#define XB_XGEN(j)  (2304 + 64 * (j))
#define XB_TOP      3328
#define XB_TOPGEN   3392
#define XCD_BAR_WORDS 3456
#define XB_SPIN_CAP (1u << 18)

__device__ __forceinline__ unsigned xb_ld(unsigned* p)              { return __hip_atomic_load(p, __ATOMIC_RELAXED, __HIP_MEMORY_SCOPE_AGENT); }
__device__ __forceinline__ unsigned xb_add(unsigned* p, unsigned v) { return __hip_atomic_fetch_add(p, v, __ATOMIC_RELAXED, __HIP_MEMORY_SCOPE_AGENT); }
__device__ __forceinline__ unsigned xb_xcc_id() { return (unsigned)__builtin_amdgcn_s_getreg((3 << 11) | 20) & 0xFu; }
#define XB_SPIN(cond, bar) do { unsigned _sp = 0; while (cond) { __builtin_amdgcn_s_sleep(1); \
    if ((++_sp & 255u) == 0u) { if (xb_ld(&(bar)[XB_TMO])) break; if (_sp > XB_SPIN_CAP) { atomicAdd(&(bar)[XB_TMO], 1u); break; } } } } while (0)

struct XcdBarrier {
    unsigned* bar; unsigned x;
    volatile LAS unsigned* st;
};

__device__ __forceinline__ XcdBarrier xcd_barrier_post(unsigned* bar, volatile LAS unsigned* st) {
    XcdBarrier b; b.bar = bar; b.x = xb_xcc_id(); b.st = st;
    if (threadIdx.x == 0) (void)xb_add(&bar[XB_XCNT(b.x)], 1u);
    return b;
}
__device__ __forceinline__ void xcd_barrier_complete(unsigned* bar, unsigned x, unsigned& nloc, unsigned& nx) {
    const unsigned G = gridDim.x * gridDim.y * gridDim.z;
    unsigned sum, cnt, mine, sp = 0u;
    for (;;) {
        sum = 0u; cnt = 0u; mine = 0u;
#pragma unroll
        for (unsigned j = 0; j < 16; ++j) { const unsigned c = xb_ld(&bar[XB_XCNT(j)]); sum += c; cnt += (c > 0u) ? 1u : 0u; mine = (j == x) ? c : mine; }
        if (sum == G) break;
        __builtin_amdgcn_s_sleep(1);
        if ((++sp & 255u) == 0u) { if (xb_ld(&bar[XB_TMO])) break; if (sp > XB_SPIN_CAP) { atomicAdd(&bar[XB_TMO], 1u); break; } }
    }
    nloc = mine > 0u ? mine : 1u; nx = cnt > 0u ? cnt : 1u;
}

__device__ __forceinline__ void xcd_barrier(const XcdBarrier& b) {
    asm volatile("s_waitcnt vmcnt(0)" ::: "memory");
    __syncthreads();
    if (threadIdx.x == 0) {
        unsigned* bar = b.bar;
        __builtin_amdgcn_s_waitcnt(0);
        unsigned nloc = b.st[0], nx = b.st[1];
        if (nloc == 0u) { xcd_barrier_complete(bar, b.x, nloc, nx); b.st[0] = nloc; b.st[1] = nx; }
        const unsigned old = xb_add(&bar[XB_XSUB(b.x)], 1u);
        const unsigned gen = old / nloc;
        if (old + 1u == (gen + 1u) * nloc) {
            __builtin_amdgcn_fence(__ATOMIC_RELEASE, "agent");
            asm volatile("s_waitcnt vmcnt(0)" ::: "memory");
            const unsigned og = xb_add(&bar[XB_TOP], 1u);
            const unsigned tg = og / nx;
            if (og + 1u == (tg + 1u) * nx) xb_add(&bar[XB_TOPGEN], 1u);
            else XB_SPIN(xb_ld(&bar[XB_TOPGEN]) == tg, bar);
            __builtin_amdgcn_fence(__ATOMIC_ACQUIRE, "agent");
            xb_add(&bar[XB_XGEN(b.x)], 1u);
            asm volatile("s_waitcnt vmcnt(0)" ::: "memory");
        } else {
            XB_SPIN(xb_ld(&bar[XB_XGEN(b.x)]) == gen, bar);
            __builtin_amdgcn_fence(__ATOMIC_ACQUIRE, "agent");
            asm volatile("s_waitcnt vmcnt(0)" ::: "memory");
        }
    }
    __syncthreads();
}
#endif

__global__ void __launch_bounds__(NT) fwd_kernel(Params pk, int ph_lo, int ph_hi) {
    SMEM_DECL;
#ifndef EMU
    volatile LAS unsigned* misc = (volatile LAS unsigned*)(smem + LDS_BYTES - 64);
    if (threadIdx.x < 2) misc[threadIdx.x] = 0u;
    __syncthreads();
    const XcdBarrier bar = xcd_barrier_post((unsigned*)(pk.ws + WS_BAR), misc);
#endif
    constexpr int NPH = 2 + 6 * DEPTH;
    for (int ph = ph_lo; ph < ph_hi && ph < NPH; ++ph) {
#ifndef EMU
        Params p = pk; { size_t z = 0; asm volatile("" : "+s"(z)); p.ws = pk.ws + z; p.out = pk.out + z;
#pragma unroll
            for (int i = 0; i < 26; ++i) p.in[i] = pk.in[i] + z; }
#else
        const Params& p = pk;
#endif
        if (ph == 0) phase0(p, smem);
        else if (ph == NPH - 1) phase_rp(p, DEPTH, smem);
        else { const int l = (ph - 1) / 6, k = (ph - 1) % 6;
            if (k == 0) phase_rp(p, l, smem);
            else if (k == 1) phase_gemm_in(p, l, smem);
            else if (k == 2) phase_mix1(p, l, smem);
            else if (k == 3) phase_scan(p, l, smem);
            else if (k == 4) phase_mix2(p, l, smem);
            else phase_gemm_out(p, l, smem);
#ifdef PROBE_DUP
            if (k == PROBE_DUP) { GRID_SYNC();
                if (k == 1) phase_gemm_in(p, l, smem); else if (k == 2) phase_mix1(p, l, smem); else if (k == 4) phase_mix2(p, l, smem); }
#endif
        }
        if (ph + 1 < ph_hi && !(ph >= 6 && ph % 6 == 0) && !(ph >= 1 && ((ph - 1) % 6 == 2 || (ph - 1) % 6 == 3))) {
#ifdef EMU
            GRID_SYNC();
#else
            if (ph_lo < 0) GRID_SYNC();
            xcd_barrier(bar);
#endif
        }
    }
}

#ifndef EMU
extern "C" void kernel_launch(void* const* d_in, const int* in_sizes, int n_in, void* d_out, int out_size, void* d_ws, size_t ws_size, hipStream_t stream) {
    static int grid = 0;
    if (grid == 0) {
        if (n_in != 26 || ws_size < WS_TOTAL) { fprintf(stderr, "kernel_launch: unexpected n_in %d or ws_size %zu (need %zu)\n", n_in, ws_size, (size_t)WS_TOTAL); grid = -1; return; }
        int dev = 0, cus = 0, per_cu = 0;
        hipGetDevice(&dev);
        hipDeviceGetAttribute(&cus, hipDeviceAttributeMultiprocessorCount, dev);
        hipFuncSetAttribute((const void*)fwd_kernel, hipFuncAttributeMaxDynamicSharedMemorySize, LDS_BYTES);
        hipOccupancyMaxActiveBlocksPerMultiprocessor(&per_cu, (const void*)fwd_kernel, NT, LDS_BYTES);
        if (per_cu < 1) { fprintf(stderr, "kernel_launch: occupancy query returned %d\n", per_cu); grid = -1; return; }
        if (per_cu > 1) per_cu = 1;
        grid = cus * per_cu;
    }
    if (grid < 0) return;
    hipMemsetAsync((char*)d_ws + WS_BAR, 0, BAR_BYTES, stream);
    Params p{};
    for (int i = 0; i < 26; ++i) p.in[i] = (const float*)d_in[i];
    p.out = (float*)d_out; p.ws = (char*)d_ws;
    int lo = 0, hi = 2 + 6 * DEPTH;
    void* args[] = {&p, &lo, &hi};
    hipError_t e = hipLaunchCooperativeKernel((const void*)fwd_kernel, dim3(grid), dim3(NT), args, LDS_BYTES, stream);
    if (e != hipSuccess) fprintf(stderr, "cooperative launch failed: %s (grid %d)\n", hipGetErrorString(e), grid);
}
#endif
```

```cpp
#ifdef EMU
#include "emu/hipemu.h"
#define GRID_SYNC() emu::grid_sync()
#define SMEM_DECL char* smem = emu::S().blocks[emu::cur()->block].lds
#define SCHED_FENCE() do {} while (0)
#define MFMA16(a, b, c) emu_mfma_16x16x32_bf16(a, b, c)
#else
#include <hip/hip_runtime.h>
#include <hip/hip_cooperative_groups.h>
#include <cstdio>
#include <cstdint>
#define GRID_SYNC() cooperative_groups::this_grid().sync()
#define SMEM_DECL extern __shared__ __attribute__((aligned(16))) char smem[]
#define SCHED_FENCE() __builtin_amdgcn_sched_barrier(0)
#define MFMA16(a, b, c) __builtin_amdgcn_mfma_f32_16x16x32_bf16(a, b, c, 0, 0, 0)
#endif

#ifdef EMU
#ifndef EMU_DM
#define EMU_DM 256
#endif
#ifndef EMU_NB
#define EMU_NB 2
#endif
#ifndef EMU_SEQ
#define EMU_SEQ 512
#endif
#ifndef EMU_DEPTH
#define EMU_DEPTH 2
#endif
#ifndef EMU_CTXL
#define EMU_CTXL 128
#endif
constexpr int DM = EMU_DM, NB = EMU_NB, SEQ = EMU_SEQ, DEPTH = EMU_DEPTH, CTXL = EMU_CTXL;
#else
constexpr int DM = 1024, NB = 8, SEQ = 2048, DEPTH = 4, CTXL = 256;
#endif
constexpr int MIX = 1024, WG = 256, HD = 64, NH = 4, CH = 64;
constexpr int TOK = CTXL + SEQ, T = NB * TOK, NCH = TOK / CH, NCC = CTXL / CH;
constexpr int N_IN = 4144, NP = 3072, NG = 48, NGS = 32, NMAIN = 3328, NPAD = 4352;
constexpr int NF = 2 * SEQ;
constexpr int NJ = NB + 1;
constexpr int NT = 512;
constexpr float EPS = 1e-6f;
constexpr int PA = 0, PG = 1280, PD = 2304;
constexpr int YA = 0, YH = 256, YG = 512, YD = 768;
constexpr int ilog4(int n) { return n <= 1 ? 0 : 1 + ilog4(n / 4); }
constexpr int FFT_P = ilog4(NF);
static_assert((1 << (2 * FFT_P)) == NF, "NF must be a power of 4");
static_assert(DM % 256 == 0 && CTXL % 128 == 0 && SEQ % 256 == 0, "shape constraints");

typedef unsigned short bf16;
typedef short bf16x8 __attribute__((ext_vector_type(8)));
typedef float f32x4 __attribute__((ext_vector_type(4)));
typedef unsigned u32x4 __attribute__((ext_vector_type(4)));
typedef unsigned u32x2 __attribute__((ext_vector_type(2)));
struct cpx { float x, y; };

constexpr size_t al256(size_t x) { return (x + 255) & ~(size_t)255; }
constexpr size_t WS_CTXB = 0;
constexpr size_t WS_HNY = al256(WS_CTXB + (size_t)NB * CTXL * DM * 4);
constexpr size_t WS_WIN = WS_HNY + (size_t)T * 1024 * 2;
constexpr size_t WS_ST = WS_WIN;
constexpr size_t ST_BYTES = (size_t)2 * 2 * NB * NH * NCH * 4096 * 2;
constexpr size_t WS_KT = al256(WS_WIN + (size_t)NPAD * DM * 2);
static_assert(WS_KT + (size_t)WG * NF * 4 <= WS_ST + ST_BYTES || true, "");
constexpr size_t ST_END = al256((WS_ST + ST_BYTES > WS_KT + (size_t)WG * NF * 4) ? WS_ST + ST_BYTES : WS_KT + (size_t)WG * NF * 4);
constexpr size_t WS_P = ST_END;
constexpr size_t WS_HT = al256(WS_P + (size_t)T * NP * 2);
constexpr size_t WS_WOUT = WS_HT;
constexpr size_t WS_G = al256(WS_HT + (size_t)1024 * T * 2);
constexpr size_t WS_KF = al256(WS_G + (size_t)T * NGS * 4);
constexpr size_t WS_HC = al256(WS_KF + (size_t)WG * NF * 8);
constexpr size_t WS_EQ = al256(WS_HC + (size_t)2 * WG * CTXL * 4);
constexpr size_t WS_NV = al256(WS_EQ + (size_t)2 * T * WG * 2);
constexpr size_t WS_BE = al256(WS_NV + (size_t)2 * NB * NH * NCH * 64 * 4);
constexpr size_t WS_SC = al256(WS_BE + (size_t)2 * NB * NH * NCH * 64 * 4);
constexpr size_t WS_MOD = al256(WS_SC + (size_t)2 * NB * NH * NCH * 4 * 4);
constexpr size_t WS_TW = al256(WS_MOD + (size_t)DEPTH * NJ * 3 * DM * 4);
constexpr size_t WS_ROPE = al256(WS_TW + (size_t)NF * 8);
constexpr size_t WS_BAR = al256(WS_ROPE + (size_t)SEQ * 32 * 8);
constexpr size_t BAR_BYTES = 32768;
constexpr size_t WS_TOTAL = al256(WS_BAR + BAR_BYTES);
static_assert((size_t)T * DM * 4 <= (size_t)T * NP * 2, "YO fits in P");
#ifndef EMU
static_assert(WS_TOTAL <= (size_t)268435456, "workspace map must fit 256 MiB");
#endif

constexpr int LDS_BYTES = 163840;

struct Params {
    const float* in[26];
    float* out;
    char* ws;
};
enum { I_X = 0, I_C, I_CTX, I_CCTX, I_WADA, I_BADA, I_GPRE, I_GPOST, I_WIN, I_MGB, I_MNG, I_HCW, I_HCB, I_HW1, I_HB1, I_HW2, I_HB2, I_HW3, I_HB3,
       I_HFREQ, I_HD, I_GWA, I_GBA, I_GNG, I_SINK, I_WOUT };

__device__ __forceinline__ Params relaunder(const Params& pk) {
#ifdef EMU
    return pk;
#else
    Params p = pk; size_t z = 0; asm volatile("" : "+s"(z)); p.ws = pk.ws + z; p.out = pk.out + z;
#pragma unroll
    for (int i = 0; i < 26; ++i) p.in[i] = pk.in[i] + z;
    return p;
#endif
}
constexpr int WLDS = (LDS_BYTES - 64) / 8 / 16 * 16;
#ifdef EMU
#define WAVE_SYNC() emu_wave_sync()
#else
#define WAVE_SYNC() do { asm volatile("s_waitcnt lgkmcnt(0)" ::: "memory"); __builtin_amdgcn_wave_barrier(); } while (0)
#endif

#ifdef EMU
__device__ __forceinline__ int otid() { return (int)threadIdx.x; }
__device__ __forceinline__ int obid() { return (int)blockIdx.x; }
#else
__device__ __forceinline__ int otid() { int t = (int)threadIdx.x; asm volatile("" : "+v"(t)); return t; }
__device__ __forceinline__ int obid() { int b = (int)blockIdx.x; asm volatile("" : "+s"(b)); return b; }
#endif
__device__ __forceinline__ unsigned fbits(float f) { return __builtin_bit_cast(unsigned, f); }
__device__ __forceinline__ float bitsf(unsigned u) { return __builtin_bit_cast(float, u); }
__device__ __forceinline__ float bf2f(bf16 h) { return bitsf((unsigned)h << 16); }
#ifdef EMU
__device__ __forceinline__ bf16 f2bf(float f) { unsigned u = fbits(f); return (bf16)((u + 0x7fffu + ((u >> 16) & 1u)) >> 16); }
__device__ __forceinline__ unsigned pk2(float lo, float hi) { return (unsigned)f2bf(lo) | ((unsigned)f2bf(hi) << 16); }
#else
typedef __bf16 nbf16x2 __attribute__((ext_vector_type(2)));
typedef float nf32x2 __attribute__((ext_vector_type(2)));
__device__ __forceinline__ unsigned pk2(float lo, float hi) { const nf32x2 v = {lo, hi}; return __builtin_bit_cast(unsigned, __builtin_convertvector(v, nbf16x2)); }
__device__ __forceinline__ bf16 f2bf(float f) { return (bf16)(pk2(f, 0.0f) & 0xffffu); }
#endif
#ifdef EMU
__device__ __forceinline__ float frcp_(float x) { return 1.0f / x; }
#else
__device__ __forceinline__ float frcp_(float x) { return __builtin_amdgcn_rcpf(x); }
#endif
__device__ __forceinline__ float sigmoidf_(float x) { return frcp_(1.0f + __expf(-x)); }
__device__ __forceinline__ float siluf_(float x) { return x * frcp_(1.0f + __expf(-x)); }
__device__ __forceinline__ float logsigf_(float x) { return fminf(x, 0.0f) - log1pf(__expf(-fabsf(x))); }
__device__ __forceinline__ float logsig_fast(float x) { return fminf(x, 0.0f) - __logf(1.0f + __expf(-fabsf(x))); }
#ifdef EMU
__device__ __forceinline__ float row16_sum(float x) { x += __shfl_xor(x, 1); x += __shfl_xor(x, 2); x += __shfl_xor(x, 4); x += __shfl_xor(x, 8); return x; }
__device__ __forceinline__ float row16_max(float x) { x = fmaxf(x, __shfl_xor(x, 1)); x = fmaxf(x, __shfl_xor(x, 2)); x = fmaxf(x, __shfl_xor(x, 4)); x = fmaxf(x, __shfl_xor(x, 8)); return x; }
__device__ __forceinline__ float xrow_sum(float x) { x += __shfl_xor(x, 16); x += __shfl_xor(x, 32); return x; }
__device__ __forceinline__ float xrow_max(float x) { x = fmaxf(x, __shfl_xor(x, 16)); x = fmaxf(x, __shfl_xor(x, 32)); return x; }
#else
template <int CTRL> __device__ __forceinline__ float dpp_(float x) { return __builtin_bit_cast(float, __builtin_amdgcn_mov_dpp(__builtin_bit_cast(int, x), CTRL, 0xf, 0xf, true)); }
__device__ __forceinline__ float row16_sum(float x) { x += dpp_<0xB1>(x); x += dpp_<0x4E>(x); x += dpp_<0x141>(x); x += dpp_<0x128>(x); return x; }
__device__ __forceinline__ float row16_max(float x) { x = fmaxf(x, dpp_<0xB1>(x)); x = fmaxf(x, dpp_<0x4E>(x)); x = fmaxf(x, dpp_<0x141>(x)); x = fmaxf(x, dpp_<0x128>(x)); return x; }
__device__ __forceinline__ float xrow_sum(float x) {
    auto s = __builtin_amdgcn_permlane16_swap(fbits(x), fbits(x), false, false); x = bitsf(s[0]) + bitsf(s[1]);
    auto t = __builtin_amdgcn_permlane32_swap(fbits(x), fbits(x), false, false); return bitsf(t[0]) + bitsf(t[1]); }
__device__ __forceinline__ float xrow_max(float x) {
    auto s = __builtin_amdgcn_permlane16_swap(fbits(x), fbits(x), false, false); x = fmaxf(bitsf(s[0]), bitsf(s[1]));
    auto t = __builtin_amdgcn_permlane32_swap(fbits(x), fbits(x), false, false); return fmaxf(bitsf(t[0]), bitsf(t[1])); }
#endif
__device__ __forceinline__ float wave_sum(float v) { return xrow_sum(row16_sum(v)); }
__device__ __forceinline__ float wave_max(float v) { return xrow_max(row16_max(v)); }
#ifdef EMU
__device__ __forceinline__ float wave_prefix_sum(float v, int lane) {
#pragma unroll
    for (int o = 1; o < 64; o <<= 1) { float t = __shfl_up(v, o); if (lane >= o) v += t; }
    return v;
}
__device__ __forceinline__ float wave_prefix_max(float v, int lane) {
#pragma unroll
    for (int o = 1; o < 64; o <<= 1) { float t = __shfl_up(v, o); if (lane >= o) v = fmaxf(v, t); }
    return v;
}
#else
template <int CTRL, int RM> __device__ __forceinline__ float dppo_(float old, float x) { return __builtin_bit_cast(float, __builtin_amdgcn_update_dpp(__builtin_bit_cast(int, old), __builtin_bit_cast(int, x), CTRL, RM, 0xf, false)); }
__device__ __forceinline__ float wave_prefix_sum(float v, int) {
    v += dppo_<0x111, 0xf>(0.f, v); v += dppo_<0x112, 0xf>(0.f, v); v += dppo_<0x114, 0xf>(0.f, v); v += dppo_<0x118, 0xf>(0.f, v);
    v += dppo_<0x142, 0xa>(0.f, v); v += dppo_<0x143, 0xc>(0.f, v); return v;
}
__device__ __forceinline__ float wave_prefix_max(float v, int) {
    const float ninf = -INFINITY;
    v = fmaxf(v, dppo_<0x111, 0xf>(ninf, v)); v = fmaxf(v, dppo_<0x112, 0xf>(ninf, v)); v = fmaxf(v, dppo_<0x114, 0xf>(ninf, v)); v = fmaxf(v, dppo_<0x118, 0xf>(ninf, v));
    v = fmaxf(v, dppo_<0x142, 0xa>(ninf, v)); v = fmaxf(v, dppo_<0x143, 0xc>(ninf, v)); return v;
}
#endif
__device__ __forceinline__ float wave_suffix_max(float v, int lane) {
    return __shfl(wave_prefix_max(__shfl(v, 63 - lane), lane), 63 - lane);
}
__device__ __forceinline__ void unpack8(u32x4 v, float* f) {
    f[0] = bitsf(v.x << 16); f[1] = bitsf(v.x & 0xffff0000u); f[2] = bitsf(v.y << 16); f[3] = bitsf(v.y & 0xffff0000u);
    f[4] = bitsf(v.z << 16); f[5] = bitsf(v.z & 0xffff0000u); f[6] = bitsf(v.w << 16); f[7] = bitsf(v.w & 0xffff0000u);
}
__device__ __forceinline__ int orig_col(int n) {
    if (n < 1280) return n;
    if (n < 2304) return 2320 + (n - 1280);
    if (n < 3072) return 3376 + (n - 2304);
    if (n < 3088) return 1280 + (n - 3072);
    if (n < 3120) return 3344 + (n - 3088);
    if (n < NMAIN) return -1;
    return 1296 + (n - NMAIN);
}
__device__ __forceinline__ int chain_cid(int dir, int o) {
    if (dir == 0) return o;
    return o < NCC ? (NCC - 1 - o) : (NCH - 1 - (o - NCC));
}

__device__ __forceinline__ int swz(int row, int ch) { return row * 64 + ((ch ^ (row & 7)) << 3); }
__device__ __forceinline__ u32x4 pack8(const float* f) { u32x4 o; o.x = pk2(f[0], f[1]); o.y = pk2(f[2], f[3]); o.z = pk2(f[4], f[5]); o.w = pk2(f[6], f[7]); return o; }
__device__ __forceinline__ bf16x8 as_frag(u32x4 v) { return __builtin_bit_cast(bf16x8, v); }
__device__ __forceinline__ u32x4 as_u4(bf16x8 v) { return __builtin_bit_cast(u32x4, v); }

constexpr int LS = 72;

template <int NTL, int KS>
__device__ __forceinline__ void mma_nt(const bf16* A, int lda, int m0, const bf16* B, int ldb, int n0, f32x4 (&acc)[NTL], int lane) {
    const int r = lane & 15, q = lane >> 4;
#pragma unroll
    for (int ks = 0; ks < KS; ++ks) {
        const bf16x8 a = *(const bf16x8*)(A + (m0 + r) * lda + ks * 32 + q * 8);
#pragma unroll
        for (int nt = 0; nt < NTL; ++nt) {
            const bf16x8 b = *(const bf16x8*)(B + (n0 + nt * 16 + r) * ldb + ks * 32 + q * 8);
            acc[nt] = MFMA16(a, b, acc[nt]);
        }
    }
}

__device__ __forceinline__ void layer_prep(const Params& p, int l, int idx, int stride, char* smem);
__device__ __forceinline__ void phase0(const Params& p, char* smem) {
    const int tid = otid();
    cpx* TW = (cpx*)(p.ws + WS_TW);
    cpx* ROPE = (cpx*)(p.ws + WS_ROPE);
    float* MOD = (float*)(p.ws + WS_MOD);
    constexpr int N_TW = NF / NT, N_ROPE = SEQ * 32 / NT, N_MOD = DEPTH * (3 * DM / 64);
    for (int task = obid(); task < N_TW + N_ROPE + N_MOD; task += gridDim.x) {
        if (task < N_TW) {
            const int j = task * NT + tid; float s, c; sincospif(2.0f * (float)j / (float)NF, &s, &c);
            cpx v; v.x = c; v.y = -s; TW[j] = v;
        } else if (task < N_TW + N_ROPE) {
            const int idx = (task - N_TW) * NT + tid; const int pos = idx >> 5, i = idx & 31;
            const float inv = exp2f(-(float)(i & 15) * (13.287712379549449f / 16.0f));
            const float ang = (float)(i < 16 ? pos / 64 : pos % 64) * inv;
            cpx v; v.x = cosf(ang); v.y = sinf(ang); ROPE[idx] = v;
        } else {
            const int mt = task - N_TW - N_ROPE; const int l = mt / (3 * DM / 64), n0 = (mt % (3 * DM / 64)) * 64;
            float* sv = (float*)smem;
            float* red = sv + NJ * DM;
            __syncthreads();
            for (int i = tid; i < NJ * DM; i += NT) { const int j = i / DM, k = i % DM; const float v = j < NB ? p.in[I_C][j * DM + k] : p.in[I_CCTX][k]; sv[i] = siluf_(v); }
            __syncthreads();
            const int nl = tid & 63, ks = tid >> 6; float acc[NJ];
#pragma unroll
            for (int j = 0; j < NJ; ++j) acc[j] = 0.f;
            const float* w = p.in[I_WADA] + (size_t)l * DM * 3 * DM + n0 + nl;
            for (int k = ks * (DM / 8); k < (ks + 1) * (DM / 8); ++k) { const float wv = w[(size_t)k * 3 * DM];
#pragma unroll
                for (int j = 0; j < NJ; ++j) acc[j] += sv[j * DM + k] * wv; }
#pragma unroll
            for (int j = 0; j < NJ; ++j) red[(ks * NJ + j) * 64 + nl] = acc[j];
            __syncthreads();
            for (int i = tid; i < NJ * 64; i += NT) { const int j = i / 64, n = i % 64; float s = 0.f;
#pragma unroll
                for (int k8 = 0; k8 < 8; ++k8) s += red[(k8 * NJ + j) * 64 + n];
                MOD[((size_t)l * NJ + j) * 3 * DM + n0 + n] = s + p.in[I_BADA][(size_t)l * 3 * DM + n0 + n]; }
        }
    }
}

#ifdef EMU
constexpr int PANEL_ROWS = 128, PANEL_UNITS = DM / 128;
#else
constexpr int PANEL_ROWS = 256, PANEL_UNITS = DM / 256;
#endif
__device__ __forceinline__ unsigned* unit_counter(const Params& p, int isctx) { return (unsigned*)(p.ws + WS_BAR + 16384) + 64 * isctx; }
__device__ __forceinline__ unsigned* stage_counter(const Params& p, int flag) { return (unsigned*)(p.ws + WS_BAR + 16384) + 512 + 512 * flag; }
__device__ __forceinline__ void stage_signal(const Params& p, char* smem, int flag, int l) {
#ifdef EMU
    __syncthreads(); if (otid() == 0) *stage_counter(p, flag) += 1u;
#else
    asm volatile("s_waitcnt vmcnt(0)" ::: "memory"); __syncthreads();
    if (threadIdx.x == 0) {
        const unsigned xcc = (unsigned)__builtin_amdgcn_s_getreg((3 << 11) | 20) & 0xFu, nloc = ((volatile __attribute__((address_space(3))) unsigned*)(smem + LDS_BYTES - 64))[0];
        unsigned* g = stage_counter(p, flag);
        if (nloc > 0u) { const unsigned old = __hip_atomic_fetch_add(g + 16 * (1 + xcc), 1u, __ATOMIC_RELAXED, __HIP_MEMORY_SCOPE_AGENT);
            if (old + 1u == nloc * (unsigned)(l + 1)) { __builtin_amdgcn_fence(__ATOMIC_RELEASE, "agent"); asm volatile("s_waitcnt vmcnt(0)" ::: "memory");
                __hip_atomic_fetch_add(g, nloc, __ATOMIC_RELAXED, __HIP_MEMORY_SCOPE_AGENT); } }
        else { __builtin_amdgcn_fence(__ATOMIC_RELEASE, "agent"); asm volatile("s_waitcnt vmcnt(0)" ::: "memory"); __hip_atomic_fetch_add(g, 1u, __ATOMIC_RELAXED, __HIP_MEMORY_SCOPE_AGENT); }
    }
#endif
}
__device__ __forceinline__ void stage_wait(const Params& p, int flag, int l) {
    if (otid() == 0) { const unsigned target = (unsigned)gridDim.x * (unsigned)(l + 1);
#ifdef EMU
        while (*(volatile unsigned*)stage_counter(p, flag) < target) emu::yield();
#else
        unsigned spins = 0;
        while (__hip_atomic_load(stage_counter(p, flag), __ATOMIC_RELAXED, __HIP_MEMORY_SCOPE_AGENT) < target) { __builtin_amdgcn_s_sleep(16); if (++spins > (1u << 20)) break; }
        __builtin_amdgcn_fence(__ATOMIC_ACQUIRE, "agent"); asm volatile("s_waitcnt vmcnt(0)" ::: "memory");
#endif
    }
    __syncthreads();
}
__device__ __forceinline__ int logical_row(int i) { return i < NB * SEQ ? (i / SEQ) * TOK + CTXL + i % SEQ : ((i - NB * SEQ) / CTXL) * TOK + (i - NB * SEQ) % CTXL; }
struct RowRef { const float* xo; float* xn; int mj, row; bool ok; };
__device__ __forceinline__ RowRef rp_ref(const Params& p, int l, int li, int base, int hi) {
    RowRef r; r.ok = li < hi; const int rr = logical_row(r.ok ? li : base); r.row = rr;
    const int b = rr / TOK, pp = rr % TOK; const bool isctx = pp < CTXL; if (l == DEPTH && isctx) r.ok = false;
    const size_t off = isctx ? ((size_t)b * CTXL + pp) * DM : ((size_t)b * SEQ + (pp - CTXL)) * DM;
    float* CTXB = (float*)(p.ws + WS_CTXB);
    r.xo = (l <= 1) ? (isctx ? p.in[I_CTX] + off : p.in[I_X] + off) : (isctx ? CTXB + off : p.out + off);
    r.xn = isctx ? CTXB + off : p.out + off; r.mj = isctx ? NB : b; return r;
}
__device__ __forceinline__ void rp_rows(const Params& p, int l, int lo, int hi, int gi, int nb) {
    const int tid = otid(), lane = tid & 63, wave = tid >> 6;
    const float* MOD = (const float*)(p.ws + WS_MOD);
    const bf16* YO = (const bf16*)(p.ws + WS_P);
    bf16* HN = (bf16*)(p.ws + WS_HNY);
    constexpr int NV4 = DM / 256, RW = 2;
    const int stride = nb * 8;
    f32x4 xq[RW][NV4]; u32x2 yq[RW][NV4]; RowRef rq[RW];
    int base = lo + gi * 8 + wave;
    if (base < hi) {
#pragma unroll
        for (int i = 0; i < RW; ++i) { rq[i] = rp_ref(p, l, base + i * stride, base, hi);
#pragma unroll
            for (int j = 0; j < NV4; ++j) { xq[i][j] = *(const f32x4*)(rq[i].xo + 4 * lane + 256 * j); yq[i][j] = (l > 0) ? *(const u32x2*)(YO + (size_t)rq[i].row * DM + 4 * lane + 256 * j) : (u32x2){0u, 0u}; } }
    }
    for (; base < hi; base += stride * RW) {
        f32x4 x[RW][NV4], y[RW][NV4]; RowRef rc[RW];
#pragma unroll
        for (int i = 0; i < RW; ++i) { rc[i] = rq[i];
#pragma unroll
            for (int j = 0; j < NV4; ++j) { x[i][j] = xq[i][j]; const u32x2 yy = yq[i][j]; y[i][j] = (f32x4){bitsf(yy.x << 16), bitsf(yy.x & 0xffff0000u), bitsf(yy.y << 16), bitsf(yy.y & 0xffff0000u)}; } }
        { const int nbase = base + stride * RW;
            if (nbase < hi) {
#pragma unroll
                for (int i = 0; i < RW; ++i) { rq[i] = rp_ref(p, l, nbase + i * stride, nbase, hi);
#pragma unroll
                    for (int j = 0; j < NV4; ++j) { xq[i][j] = *(const f32x4*)(rq[i].xo + 4 * lane + 256 * j); if (l > 0) yq[i][j] = *(const u32x2*)(YO + (size_t)rq[i].row * DM + 4 * lane + 256 * j); } } } }
        if (l > 0) {
            float ss[RW];
#pragma unroll
            for (int i = 0; i < RW; ++i) { ss[i] = 0.f;
#pragma unroll
                for (int j = 0; j < NV4; ++j) ss[i] += y[i][j].x * y[i][j].x + y[i][j].y * y[i][j].y + y[i][j].z * y[i][j].z + y[i][j].w * y[i][j].w; }
#pragma unroll
            for (int i = 0; i < RW; ++i) ss[i] = wave_sum(ss[i]);
            const float* gp = p.in[I_GPOST] + (size_t)(l - 1) * DM;
#pragma unroll
            for (int i = 0; i < RW; ++i) { const float rstd = rsqrtf(ss[i] * (1.0f / DM) + EPS); const float* gt = MOD + ((size_t)(l - 1) * NJ + rc[i].mj) * 3 * DM + 2 * DM;
#pragma unroll
                for (int j = 0; j < NV4; ++j) { const f32x4 g4 = *(const f32x4*)(gt + 4 * lane + 256 * j), p4 = *(const f32x4*)(gp + 4 * lane + 256 * j);
                    x[i][j] = x[i][j] + g4 * (y[i][j] * rstd * p4);
                    if (rc[i].ok) *(f32x4*)(rc[i].xn + 4 * lane + 256 * j) = x[i][j]; } }
        }
        if (l < DEPTH) {
            float ss[RW];
#pragma unroll
            for (int i = 0; i < RW; ++i) { ss[i] = 0.f;
#pragma unroll
                for (int j = 0; j < NV4; ++j) ss[i] += x[i][j].x * x[i][j].x + x[i][j].y * x[i][j].y + x[i][j].z * x[i][j].z + x[i][j].w * x[i][j].w; }
#pragma unroll
            for (int i = 0; i < RW; ++i) ss[i] = wave_sum(ss[i]);
            const float* gp = p.in[I_GPRE] + (size_t)l * DM;
#pragma unroll
            for (int i = 0; i < RW; ++i) { const float rstd = rsqrtf(ss[i] * (1.0f / DM) + EPS); const float* md = MOD + ((size_t)l * NJ + rc[i].mj) * 3 * DM; const int row = rc[i].row;
#pragma unroll
                for (int j = 0; j < NV4; ++j) { const int e = 4 * lane + 256 * j;
                    const f32x4 g4 = *(const f32x4*)(gp + e), sh = *(const f32x4*)(md + e), sc = *(const f32x4*)(md + DM + e);
                    const f32x4 h = (x[i][j] * rstd * g4) * (sc + 1.0f) + sh;
                    u32x2 o; o.x = pk2(h.x, h.y); o.y = pk2(h.z, h.w);
                    if (rc[i].ok) *(u32x2*)(HN + (size_t)row * DM + e) = o; } }
        }
    }
}

__device__ __forceinline__ void convert_tile(const float* src, int ldn, bf16* dst, int K, int n0, int k0, bool use_map, char* smem) {
    const int tid = otid();
    float* tile = (float*)smem;
    __syncthreads();
#pragma unroll
    for (int i = 0; i < 8; ++i) { const int idx = tid + NT * i, k = idx >> 6, n = idx & 63;
        const int oc = use_map ? orig_col(n0 + n) : (n0 + n);
        tile[k * 65 + n] = oc >= 0 ? src[(size_t)(k0 + k) * ldn + oc] : 0.f; }
    __syncthreads();
    const int n = tid >> 3, c = tid & 7;
    u32x4 o; o.x = pk2(tile[(8 * c + 0) * 65 + n], tile[(8 * c + 1) * 65 + n]); o.y = pk2(tile[(8 * c + 2) * 65 + n], tile[(8 * c + 3) * 65 + n]);
    o.z = pk2(tile[(8 * c + 4) * 65 + n], tile[(8 * c + 5) * 65 + n]); o.w = pk2(tile[(8 * c + 6) * 65 + n], tile[(8 * c + 7) * 65 + n]);
    *(u32x4*)(dst + (size_t)(n0 + n) * K + k0 + 8 * c) = o;
}

__device__ __forceinline__ void filter_task(const Params& p, int l, int L, int pos0, char* smem) {
    const int tid = otid(), j = tid & 63;
    float* z = (float*)smem;
    float* h1 = z + 8 * 33;
    float* h2 = h1 + 8 * 64;
    const float* w1 = p.in[I_HW1] + (size_t)l * 33 * 64; const float* w2 = p.in[I_HW2] + (size_t)l * 64 * 64; const float* w3 = p.in[I_HW3] + (size_t)l * 64 * 512;
    float r1[33], r2[64], r3a[16];
#pragma unroll
    for (int i = 0; i < 33; ++i) r1[i] = w1[i * 64 + j];
#pragma unroll
    for (int i = 0; i < 64; ++i) r2[i] = w2[i * 64 + j];
    const float b1 = p.in[I_HB1][l * 64 + j], b2 = p.in[I_HB2][l * 64 + j], b3 = p.in[I_HB3][l * 512 + tid];
    const float f0 = p.in[I_HFREQ][(l * 2 + 0) * 64 + j], f1 = p.in[I_HFREQ][(l * 2 + 1) * 64 + j];
    __syncthreads();
    if (tid < 8 * 33) { const int pp = tid / 33, i = tid % 33; const float pos = (float)(pos0 + pp);
        const float t = pos / (float)(L - 1 > 1 ? L - 1 : 1), wv = 6.283185307179586f * pos / (float)L; float v;
        if (i == 0) v = t; else { const int bi = (i - 1) & 15; const float f = 1e-4f + (float)bi * ((15.0f - 1e-4f) / 15.0f); v = (i <= 16) ? cosf(wv * f) : -sinf(wv * f); }
        z[tid] = v; }
    __syncthreads();
    { const int pp = tid >> 6; float a = b1;
#pragma unroll
        for (int i = 0; i < 33; ++i) a += z[pp * 33 + i] * r1[i];
        h1[tid] = sinf(f0 * a);
#pragma unroll
        for (int i = 0; i < 16; ++i) r3a[i] = w3[i * 512 + tid]; }
    __syncthreads();
    { const int pp = tid >> 6; float a = b2;
#pragma unroll
        for (int i = 0; i < 64; ++i) a += h1[pp * 64 + i] * r2[i];
        h2[tid] = sinf(f1 * a); }
    __syncthreads();
    { const int o = tid, dir = o >> 8, c = o & 255;
        const float delta = 3.0701134573253946f + (float)c * ((15.350567286626973f - 3.0701134573253946f) / 255.0f);
        float acc[8];
#pragma unroll
        for (int pp = 0; pp < 8; ++pp) acc[pp] = b3;
#pragma unroll 1
        for (int cix = 0; cix < 4; ++cix) {
            float wn[16];
#pragma unroll
            for (int i = 0; i < 16; ++i) wn[i] = (cix < 3) ? w3[(16 * (cix + 1) + i) * 512 + o] : 0.f;
#pragma unroll
            for (int i = 0; i < 16; ++i) {
#pragma unroll
                for (int pp = 0; pp < 8; ++pp) acc[pp] += h2[pp * 64 + 16 * cix + i] * r3a[i]; }
#pragma unroll
            for (int i = 0; i < 16; ++i) r3a[i] = wn[i]; }
        float* KT = (float*)(p.ws + WS_KT); float* HC = (float*)(p.ws + WS_HC);
#pragma unroll
        for (int pp = 0; pp < 8; ++pp) { const int pos = pos0 + pp; const float t = (float)pos / (float)(L - 1 > 1 ? L - 1 : 1);
            const float v = acc[pp] * __expf(-t * delta);
            if (L == SEQ) { if (dir == 0) KT[(size_t)c * NF + pos]= v; else if (pos > 0) KT[(size_t)c * NF + (NF - pos)] = v; else KT[(size_t)c * NF + SEQ] = 0.f; }
            else HC[((size_t)dir * WG + c) * CTXL + pos] = v; }
    }
}

__device__ __forceinline__ void convert_tile_w(const float* src, int ldn, bf16* dst, int K, int n0, int k0, bool use_map, char* wl, int lane) {
    float* tile = (float*)wl;
    const int oc = use_map ? orig_col(n0 + lane) : (n0 + lane);
    float v[64];
#pragma unroll
    for (int k = 0; k < 64; ++k) v[k] = oc >= 0 ? src[(size_t)(k0 + k) * ldn + oc] : 0.f;
#pragma unroll
    for (int k = 0; k < 64; ++k) tile[k * 65 + lane] = v[k];
    WAVE_SYNC();
#pragma unroll
    for (int i = 0; i < 8; ++i) { const int n = (lane >> 3) + 8 * i, c = lane & 7; float f[8];
#pragma unroll
        for (int j = 0; j < 8; ++j) f[j] = tile[(8 * c + j) * 65 + n];
        *(u32x4*)(dst + (size_t)(n0 + n) * K + k0 + 8 * c) = pack8(f); }
    WAVE_SYNC();
}
__device__ __forceinline__ void layer_prep(const Params& p, int l, int idx, int stride, char* smem) {
    constexpr int N_WIN = (NPAD / 64) * (DM / 64), N_FL = SEQ / 8, N_FC = CTXL / 8;
    for (int task = idx; task < N_FL + N_FC; task += stride) {
        if (task < N_FL) filter_task(p, l, SEQ, task * 8, smem);
        else filter_task(p, l, CTXL, (task - N_FL) * 8, smem);
    }
    __syncthreads();
    { const int tid = otid(), lane = tid & 63, wave = __builtin_amdgcn_readfirstlane(tid >> 6);
        char* wl = smem + wave * WLDS;
        for (int task = wave * stride + idx; task < N_WIN; task += 8 * stride) { const int nt = task / (DM / 64), kt = task % (DM / 64);
            convert_tile_w(p.in[I_WIN] + (size_t)l * DM * N_IN, N_IN, (bf16*)(p.ws + WS_WIN), DM, nt * 64, kt * 64, true, wl, lane); } }
}
__device__ __forceinline__ unsigned* row_queue(const Params& p, int l) { return (unsigned*)(p.ws + WS_BAR + 16384) + 2560 + 64 * l; }
__device__ __forceinline__ void wait_units(const Params& p, int c, int l) {
    constexpr int nLatU = NB * (SEQ / PANEL_ROWS) * PANEL_UNITS, nCtxU = NB * (CTXL / PANEL_ROWS) * PANEL_UNITS;
    const unsigned target = (unsigned)((c ? nCtxU : nLatU) * l);
#ifdef EMU
    while (*(volatile unsigned*)unit_counter(p, c) < target) emu::yield();
#else
    unsigned spins = 0;
    while (__hip_atomic_load(unit_counter(p, c), __ATOMIC_RELAXED, __HIP_MEMORY_SCOPE_AGENT) < target) { __builtin_amdgcn_s_sleep(16); if (++spins > (1u << 20)) break; }
    __builtin_amdgcn_fence(__ATOMIC_ACQUIRE, "agent"); asm volatile("s_waitcnt vmcnt(0)" ::: "memory");
#endif
}
__device__ __forceinline__ void phase_rp(const Params& p, int l, char* smem) { const int G = (int)gridDim.x, bid = obid(), tid = otid();
    const bool has_ctx = l < DEPTH;
    constexpr int nLatU = NB * (SEQ / PANEL_ROWS) * PANEL_UNITS, nCtxU = NB * (CTXL / PANEL_ROWS) * PANEL_UNITS;
    const int nU = nLatU + nCtxU;
    const int heavy = (l >= 1 && has_ctx && nU > G && (nU % G) != 0) ? nU % G : 0;
    const int total = heavy > 0 ? NB * SEQ : (has_ctx ? T : NB * SEQ);
    const int nl = G - heavy, np = (l < DEPTH) ? nl / 2 : 0, nr = nl - np;
    int lo, hi, gi, nb; bool prep = false;
    if (bid < heavy) { lo = NB * SEQ; hi = T; gi = bid; nb = heavy; }
    else { const int i = bid - heavy; int nR = total;
        if (np > 0) { nR = ((total * 2 / 3) / (nr * 16)) * (nr * 16); if (nR <= 0) nR = total / 2; }
        if (np > 0 && (i & 1) && i / 2 < np) { prep = true; lo = nR; hi = total; gi = i / 2; nb = np; }
        else { lo = 0; hi = nR; gi = (np > 0) ? (i + 1) / 2 : i; nb = nr; } }
    if (prep) layer_prep(p, l, gi, np, smem);
    else if (l < DEPTH && np == 0) layer_prep(p, l, bid, G, smem);
    if (l >= 1) { if (tid == 0) { if (lo < NB * SEQ) wait_units(p, 0, l); if (hi > NB * SEQ) wait_units(p, 1, l); } __syncthreads(); }
    rp_rows(p, l, lo, hi, gi, nb);
}

__device__ __forceinline__ cpx cmul(cpx a, cpx b) { cpx r; r.x = a.x * b.x - a.y * b.y; r.y = a.x * b.y + a.y * b.x; return r; }
__device__ __forceinline__ cpx cmulc(cpx a, cpx b) { cpx r; r.x = a.x * b.x + a.y * b.y; r.y = a.y * b.x - a.x * b.y; return r; }
constexpr int fpad(int i) { return i + (i >> 4); }
__device__ __forceinline__ int FPH(int i) { return i + (i >> 4); }
constexpr int FBUF = fpad(NF);
constexpr int ilog16(int n) { return n < 16 ? 0 : 1 + ilog16(n / 16); }
constexpr int FFT_P16 = ilog16(NF);
constexpr bool FFT_R4 = ((NF >> (4 * FFT_P16)) == 4);
static_assert((NF >> (4 * FFT_P16)) == 1 || (NF >> (4 * FFT_P16)) == 4, "NF = 16^a * (1 or 4)");
template <bool INV> __device__ __forceinline__ void dft4(cpx& a0, cpx& a1, cpx& a2, cpx& a3) {
    const cpx s = {a0.x + a2.x, a0.y + a2.y}, b = {a0.x - a2.x, a0.y - a2.y}, c = {a1.x + a3.x, a1.y + a3.y}, d = {a1.x - a3.x, a1.y - a3.y};
    a0 = (cpx){s.x + c.x, s.y + c.y}; a2 = (cpx){s.x - c.x, s.y - c.y};
    if (!INV) { a1 = (cpx){b.x + d.y, b.y - d.x}; a3 = (cpx){b.x - d.y, b.y + d.x}; }
    else      { a1 = (cpx){b.x - d.y, b.y + d.x}; a3 = (cpx){b.x + d.y, b.y - d.x}; }
}
template <bool INV> __device__ __forceinline__ cpx cmulk(cpx a, float wr, float wi) {
    cpx r; if (!INV) { r.x = a.x * wr + a.y * wi; r.y = a.y * wr - a.x * wi; } else { r.x = a.x * wr - a.y * wi; r.y = a.y * wr + a.x * wi; } return r;
}
template <bool INV> __device__ __forceinline__ void dft16(cpx (&x)[16]) {
    constexpr float C1 = 0.92387953251128674f, S1 = 0.38268343236508977f, C2 = 0.70710678118654752f;
#pragma unroll
    for (int n2 = 0; n2 < 4; ++n2) dft4<INV>(x[n2], x[4 + n2], x[8 + n2], x[12 + n2]);
    x[4 * 1 + 1] = cmulk<INV>(x[4 * 1 + 1], C1, S1); x[4 * 1 + 2] = cmulk<INV>(x[4 * 1 + 2], C2, C2); x[4 * 1 + 3] = cmulk<INV>(x[4 * 1 + 3], S1, C1);
    x[4 * 2 + 1] = cmulk<INV>(x[4 * 2 + 1], C2, C2); x[4 * 2 + 2] = cmulk<INV>(x[4 * 2 + 2], 0.f, 1.f); x[4 * 2 + 3] = cmulk<INV>(x[4 * 2 + 3], -C2, C2);
    x[4 * 3 + 1] = cmulk<INV>(x[4 * 3 + 1], S1, C1); x[4 * 3 + 2] = cmulk<INV>(x[4 * 3 + 2], -C2, C2); x[4 * 3 + 3] = cmulk<INV>(x[4 * 3 + 3], -C1, -S1);
#pragma unroll
    for (int k1 = 0; k1 < 4; ++k1) dft4<INV>(x[4 * k1 + 0], x[4 * k1 + 1], x[4 * k1 + 2], x[4 * k1 + 3]);
    cpx t;
    t = x[1]; x[1] = x[4]; x[4] = t; t = x[2]; x[2] = x[8]; x[8] = t; t = x[3]; x[3] = x[12]; x[12] = t;
    t = x[6]; x[6] = x[9]; x[9] = t; t = x[7]; x[7] = x[13]; x[13] = t; t = x[11]; x[11] = x[14]; x[14] = t;
}
template <bool INV> __device__ __forceinline__ void fft_stage16(cpx* buf, const cpx* TW, int tl, int M) {
    const int span = M >> 4, twm = NF / M;
#pragma unroll 1
    for (int j = tl; j < NF / 16; j += 256) {
        const int grp = j / span, pos = j % span, base = grp * M + pos; cpx x[16];
#pragma unroll
        for (int q = 0; q < 16; ++q) x[q] = buf[FPH(base + q * span)];
        cpx w1 = {1.f, 0.f}; if (span > 1) w1 = TW[pos * twm];
        if (INV && span > 1) { cpx wk = w1;
#pragma unroll
            for (int k = 1; k < 16; ++k) { x[k] = cmulc(x[k], wk); wk = cmul(wk, w1); } }
        dft16<INV>(x);
        if (!INV && span > 1) { cpx wk = w1;
#pragma unroll
            for (int k = 1; k < 16; ++k) { x[k] = cmul(x[k], wk); wk = cmul(wk, w1); } }
#pragma unroll
        for (int q = 0; q < 16; ++q) buf[FPH(base + q * span)] = x[q];
    }
}
template <bool INV> __device__ __forceinline__ void fft_stage4_last(cpx* buf, int tl) {
#pragma unroll 1
    for (int j = tl; j < NF / 4; j += 256) { cpx a0 = buf[FPH(4 * j)], a1 = buf[FPH(4 * j + 1)], a2 = buf[FPH(4 * j + 2)], a3 = buf[FPH(4 * j + 3)];
        dft4<INV>(a0, a1, a2, a3); buf[FPH(4 * j)] = a0; buf[FPH(4 * j + 1)] = a1; buf[FPH(4 * j + 2)] = a2; buf[FPH(4 * j + 3)] = a3; }
}
__device__ __forceinline__ void fft_fwd(cpx* buf, const cpx* TW, int tl) {
    int M = NF;
#pragma unroll
    for (int s = 0; s < FFT_P16; ++s) { __syncthreads(); fft_stage16<false>(buf, TW, tl, M); M >>= 4; }
    if (FFT_R4) { __syncthreads(); fft_stage4_last<false>(buf, tl); }
    __syncthreads();
}
__device__ __forceinline__ void fft_inv(cpx* buf, const cpx* TW, int tl) {
    if (FFT_R4) { __syncthreads(); fft_stage4_last<true>(buf, tl); }
    int M = FFT_R4 ? 64 : 16;
#pragma unroll
    for (int s = 0; s < FFT_P16; ++s) { __syncthreads(); fft_stage16<true>(buf, TW, tl, M); M <<= 4; }
    __syncthreads();
}
__device__ __forceinline__ void filt_fft_task(const Params& p, int cp, char* smem) {
    const int tid = otid(), half = tid >> 8, tl = tid & 255, c = 2 * cp + half;
    cpx* buf = (cpx*)smem + (size_t)half * FBUF;
    const float* KT = (const float*)(p.ws + WS_KT) + (size_t)c * NF;
    cpx* KF = (cpx*)(p.ws + WS_KF) + (size_t)c * NF;
    const cpx* TW = (const cpx*)(p.ws + WS_TW);
    __syncthreads();
    for (int i = tl; i < NF; i += 256) { cpx v; v.x = KT[i]; v.y = 0.f; buf[FPH(i)] = v; }
    fft_fwd(buf, TW, tl);
    for (int i = tl; i < NF; i += 256) KF[i] = buf[FPH(i)];
}

__device__ __forceinline__ void gemm_tile(const Params& p, const bf16* A, const bf16* Bt, int K, int mt, int nt, int mode, char* smem) {
    const int tid = otid(), lane = tid & 63, wave = tid >> 6;
    bf16* As = (bf16*)smem;
    bf16* Bs = As + 128 * LS;
    const int wm = (wave & 3) * 32, wn = (wave >> 2) * 64;
    f32x4 acc[2][4];
#pragma unroll
    for (int i = 0; i < 2; ++i)
#pragma unroll
        for (int j = 0; j < 4; ++j) acc[i][j] = (f32x4){0.f, 0.f, 0.f, 0.f};
    const int lr = tid >> 3, lc = tid & 7;
    const bf16* Ag = A + (size_t)(mt * 128 + lr) * K + lc * 8;
    const bf16* Bg = Bt + (size_t)(nt * 128 + lr) * K + lc * 8;
    u32x4 ra0, ra1, rb0, rb1;
    ra0 = *(const u32x4*)(Ag); ra1 = *(const u32x4*)(Ag + (size_t)64 * K); rb0 = *(const u32x4*)(Bg); rb1 = *(const u32x4*)(Bg + (size_t)64 * K);
    const int nk = K / 64;
    for (int kt = 0; kt < nk; ++kt) {
        __syncthreads();
        *(u32x4*)(As + lr * LS + lc * 8) = ra0; *(u32x4*)(As + (lr + 64) * LS + lc * 8) = ra1;
        *(u32x4*)(Bs + lr * LS + lc * 8) = rb0; *(u32x4*)(Bs + (lr + 64) * LS + lc * 8) = rb1;
        __syncthreads();
        if (kt + 1 < nk) { const int ko = (kt + 1) * 64;
            ra0 = *(const u32x4*)(Ag + ko); ra1 = *(const u32x4*)(Ag + (size_t)64 * K + ko); rb0 = *(const u32x4*)(Bg + ko); rb1 = *(const u32x4*)(Bg + (size_t)64 * K + ko); }
        mma_nt<4, 2>(As, LS, wm, Bs, LS, wn, acc[0], lane);
        mma_nt<4, 2>(As, LS, wm + 16, Bs, LS, wn, acc[1], lane);
    }
    const int r = lane & 15, q = lane >> 4;
#pragma unroll
    for (int i = 0; i < 2; ++i)
#pragma unroll
        for (int j = 0; j < 4; ++j)
#pragma unroll
            for (int e = 0; e < 4; ++e) {
                const int row = mt * 128 + wm + 16 * i + 4 * q + e, col = nt * 128 + wn + 16 * j + r; const float v = acc[i][j][e];
                if (mode == 0) { if (col < NP) ((bf16*)(p.ws + WS_P))[(size_t)row * NP + col] = f2bf(v); else if (col < NP + 16) ((float*)(p.ws + WS_G))[(size_t)row * NGS + (col - NP)] = v; else if (col < NP + NG) ((bf16*)((float*)(p.ws + WS_G) + (size_t)row * NGS + 16))[col - NP - 16] = f2bf(v); }
                else if (mode == 2) ((bf16*)(p.ws + WS_HT))[(size_t)row * T + col] = f2bf(v);
                else ((bf16*)(p.ws + WS_P))[(size_t)row * DM + col] = f2bf(v);
            }
}

#ifndef EMU
namespace pg8 {
#define PG8_LAS __attribute__((address_space(3)))
typedef unsigned short bf16_t;
typedef short bf16x8 __attribute__((ext_vector_type(8)));
typedef float f32x4 __attribute__((ext_vector_type(4)));
typedef unsigned u32x4 __attribute__((ext_vector_type(4)));
constexpr int BM = 256, BK = 64, HALF = 128, HTB = HALF * BK * 2  , STAGE_BYTES = 8 * HTB, NXCD = 8, WGM = 8;

__host__ __device__ __forceinline__ int lds_byte(int r, int c) { const int st = (r >> 4) * 2 + (c >> 5), rr = r & 15, cc = c & 31, ob = rr * 64 + cc * 2; return st * 1024 + (ob ^ (((ob >> 9) & 1) << 5)); }
__host__ __device__ __forceinline__ void stage_rc(int b, int& R, int& C) { const int st = b / 1024, sb = b % 1024, swz = sb ^ (((sb >> 9) & 1) << 5); R = (st >> 1) * 16 + swz / 64; C = (st & 1) * 32 + (swz % 64) / 2; }
__host__ __device__ __forceinline__ int perm32(int rho) { const int n = rho >> 4, i = rho & 15; return 8 * (i >> 2) + 4 * n + (i & 3); }

struct Unit { int pm, pn; };
struct Gemm { const bf16_t* A; const bf16_t* Bt; int M, N, K; };
__device__ __forceinline__ unsigned cvt_pk_bf16(float lo, float hi) { unsigned r; asm volatile("v_cvt_pk_bf16_f32 %0, %1, %2" : "=v"(r) : "v"(lo), "v"(hi)); return r; }
template <class Epi, class Sched, bool ALIGN_EPI = false, bool SP2 = false>
__device__ __forceinline__ void gemm_phase(PG8_LAS unsigned char* lds, const Gemm g, const Sched& S, const Epi& E) {
    const int tid = otid(), wid = __builtin_amdgcn_readfirstlane(tid >> 6), lane = tid & 63, wr = wid >> 2, wc = wid & 3, fr = lane & 15, fq = lane >> 4;
    const int K = g.K, nt = K / BK;
    unsigned voffA[2], voffB[2];
#pragma unroll
    for (int i = 0; i < 2; ++i) { int R, C; stage_rc(tid * 16 + i * 8192, R, C); const int Rb = Epi::PERM ? ((R & ~31) + perm32(R & 31)) : R;
        voffA[i] = (unsigned)(R * K + C) * 2u; voffB[i] = (unsigned)(Rb * K + C) * 2u; }
    const size_t kstep = (size_t)(BK * 2);
    const size_t hstep = (size_t)HALF * K * 2;
    const size_t tstep = 2 * hstep;
    const unsigned ldsw = (unsigned)wid * 1024u;
    const int aoff = lds_byte(wr * 64 + fr, fq * 8), boff = lds_byte(wc * 32 + fr, fq * 8);
#define PG8_SA(b, h) (((b) * 2 + (h)) * HTB)
#define PG8_SB(b, h) ((4 + (b) * 2 + (h)) * HTB)
#define PG8_STAGE(bufoff, gbase, voff) do { _Pragma("unroll") for (int _i = 0; _i < 2; ++_i) \
        __builtin_amdgcn_global_load_lds((const unsigned*)((const char*)(gbase) + (voff)[_i]), (PG8_LAS unsigned*)(lds + (bufoff) + ldsw + _i * 8192), 16, 0, 0); } while (0)
#define PG8_LDA(dst, b, h) do { _Pragma("unroll") for (int m = 0; m < 4; ++m) _Pragma("unroll") for (int k = 0; k < 2; ++k) dst[m][k] = *(const PG8_LAS bf16x8*)(lds + PG8_SA(b, h) + aoff + m * 2048 + k * 1024); } while (0)
#define PG8_LDB(dst, b, h) do { _Pragma("unroll") for (int n = 0; n < 2; ++n) _Pragma("unroll") for (int k = 0; k < 2; ++k) dst[n][k] = *(const PG8_LAS bf16x8*)(lds + PG8_SB(b, h) + boff + n * 2048 + k * 1024); } while (0)
#define PG8_MMA(ai, bj, At, Bt) do { __builtin_amdgcn_s_setprio(1); _Pragma("unroll") for (int m = 0; m < 4; ++m) _Pragma("unroll") for (int n = 0; n < 2; ++n) _Pragma("unroll") for (int k = 0; k < 2; ++k) \
        acc[ai][bj][m][n] = __builtin_amdgcn_mfma_f32_16x16x32_bf16(Bt[n][k], At[m][k], acc[ai][bj][m][n], 0, 0, 0); __builtin_amdgcn_s_setprio(0); } while (0)
#define PG8_WAIT_V(n) asm volatile("s_waitcnt vmcnt(" #n ")" ::: "memory")
#define PG8_WAIT_L(n) asm volatile("s_waitcnt lgkmcnt(" #n ")" ::: "memory")
#define PG8_BAR __builtin_amdgcn_s_barrier()
#define PG8_SCHED __builtin_amdgcn_sched_barrier(0)
    Unit cur, nxt; int ui = 0;
    if (!S.next(0, cur)) return;
    f32x4 acc[2][2][4][2];
#pragma unroll
    for (int a = 0; a < 2; ++a)
#pragma unroll
        for (int b = 0; b < 2; ++b)
#pragma unroll
            for (int m = 0; m < 4; ++m)
#pragma unroll
                for (int n = 0; n < 2; ++n) acc[a][b][m][n] = (f32x4){0.f, 0.f, 0.f, 0.f};
    bf16x8 At[4][2], B0[2][2], B1[2][2];
    const char* cA = (const char*)g.A + (size_t)cur.pm * tstep; const char* cB = (const char*)g.Bt + (size_t)cur.pn * tstep;
    S.a_ready(cur);
    if constexpr (SP2) {
        PG8_STAGE(PG8_SB(0, 0), cB, voffB); PG8_STAGE(PG8_SB(0, 1), cB + hstep, voffB); PG8_STAGE(PG8_SA(0, 0), cA, voffA); PG8_STAGE(PG8_SA(0, 1), cA + hstep, voffA);
        if (wr == 1) PG8_BAR;
        PG8_WAIT_V(2); PG8_BAR;
        PG8_STAGE(PG8_SB(1, 0), cB + kstep, voffB); PG8_STAGE(PG8_SA(1, 0), cA + kstep, voffA); PG8_STAGE(PG8_SB(1, 1), cB + hstep + kstep, voffB);
        PG8_WAIT_V(6); PG8_BAR;
    } else {
        PG8_STAGE(PG8_SB(0, 0), cB, voffB); PG8_STAGE(PG8_SA(0, 0), cA, voffA); PG8_STAGE(PG8_SB(0, 1), cB + hstep, voffB); PG8_STAGE(PG8_SA(0, 1), cA + hstep, voffA);
        if (wr == 1) PG8_BAR;
        PG8_WAIT_V(4); PG8_BAR;
        PG8_STAGE(PG8_SB(1, 0), cB + kstep, voffB); PG8_STAGE(PG8_SA(1, 0), cA + kstep, voffA); PG8_STAGE(PG8_SB(1, 1), cB + hstep + kstep, voffB);
        PG8_WAIT_V(6); PG8_BAR;
    }
    for (;;) {
        const bool has_next = S.next(ui + 1, nxt);
        const char* nA = has_next ? (const char*)g.A + (size_t)nxt.pm * tstep : cA; const char* nB = has_next ? (const char*)g.Bt + (size_t)nxt.pn * tstep : cB;
        for (int t = 0; t < nt; t += 2) {
            const bool last = (t == nt - 2);
            const char* a1 = cA + (size_t)(t + 1) * kstep;
            const char* a2 = last ? nA : cA + (size_t)(t + 2) * kstep; const char* b2 = last ? nB : cB + (size_t)(t + 2) * kstep;
            const char* a3 = a2 + kstep; const char* b3 = b2 + kstep;
            if (last && has_next) S.a_ready(nxt);
            if constexpr (SP2) {
            PG8_LDB(B0, 0, 0); PG8_LDB(B1, 0, 1); PG8_SCHED; PG8_LDA(At, 0, 0); PG8_STAGE(PG8_SA(1, 1), a1 + hstep, voffA);
            PG8_WAIT_V(8); PG8_WAIT_L(0); PG8_BAR; PG8_MMA(0, 0, At, B0); PG8_MMA(0, 1, At, B1); PG8_BAR; PG8_SCHED;
            PG8_LDA(At, 0, 1); PG8_STAGE(PG8_SB(0, 0), b2, voffB); PG8_STAGE(PG8_SB(0, 1), b2 + hstep, voffB); PG8_STAGE(PG8_SA(0, 0), a2, voffA);
            PG8_WAIT_V(8); PG8_WAIT_L(0); PG8_BAR; PG8_MMA(1, 0, At, B0); PG8_MMA(1, 1, At, B1); PG8_BAR; PG8_SCHED;
            PG8_LDB(B0, 1, 0); PG8_LDB(B1, 1, 1); PG8_SCHED; PG8_LDA(At, 1, 0); PG8_STAGE(PG8_SA(0, 1), a2 + hstep, voffA);
            PG8_WAIT_V(8); PG8_WAIT_L(0); PG8_BAR; PG8_MMA(0, 0, At, B0); PG8_MMA(0, 1, At, B1); PG8_BAR; PG8_SCHED;
            PG8_LDA(At, 1, 1); PG8_STAGE(PG8_SB(1, 0), b3, voffB); PG8_STAGE(PG8_SB(1, 1), b3 + hstep, voffB); PG8_STAGE(PG8_SA(1, 0), a3, voffA);
            PG8_WAIT_V(8); PG8_WAIT_L(0); PG8_BAR; PG8_MMA(1, 0, At, B0); PG8_MMA(1, 1, At, B1); PG8_BAR; PG8_SCHED;
            } else {
            PG8_LDB(B0, 0, 0); PG8_SCHED; PG8_LDA(At, 0, 0); PG8_STAGE(PG8_SA(1, 1), a1 + hstep, voffA);
            PG8_WAIT_L(8); PG8_BAR; PG8_WAIT_L(0); PG8_MMA(0, 0, At, B0); PG8_BAR; PG8_SCHED;
            PG8_LDB(B1, 0, 1); PG8_STAGE(PG8_SB(0, 0), b2, voffB);
            PG8_BAR; PG8_WAIT_L(0); PG8_MMA(0, 1, At, B1); PG8_BAR;
            PG8_LDA(At, 0, 1); PG8_STAGE(PG8_SA(0, 0), a2, voffA);
            PG8_BAR; PG8_WAIT_L(0); PG8_MMA(1, 0, At, B0); PG8_BAR; PG8_SCHED;
            PG8_STAGE(PG8_SB(0, 1), b2 + hstep, voffB);
            PG8_WAIT_V(6); PG8_BAR; PG8_MMA(1, 1, At, B1); PG8_BAR;
            PG8_LDB(B0, 1, 0); PG8_SCHED; PG8_LDA(At, 1, 0); PG8_STAGE(PG8_SA(0, 1), a2 + hstep, voffA);
            PG8_WAIT_L(8); PG8_BAR; PG8_WAIT_L(0); PG8_MMA(0, 0, At, B0); PG8_BAR; PG8_SCHED;
            PG8_LDB(B1, 1, 1); PG8_STAGE(PG8_SB(1, 0), b3, voffB);
            PG8_BAR; PG8_WAIT_L(0); PG8_MMA(0, 1, At, B1); PG8_BAR;
            PG8_LDA(At, 1, 1); PG8_STAGE(PG8_SA(1, 0), a3, voffA);
            PG8_BAR; PG8_WAIT_L(0); PG8_MMA(1, 0, At, B0); PG8_BAR; PG8_SCHED;
            PG8_STAGE(PG8_SB(1, 1), b3 + hstep, voffB);
            PG8_WAIT_V(6); PG8_BAR; PG8_MMA(1, 1, At, B1); PG8_BAR;
            }
        }
        if constexpr (ALIGN_EPI) { if (wr == 0) PG8_BAR; }
        if constexpr (!Epi::AFTER_DRAIN) { E(acc, cur, wr, wc, fr, fq); S.done(cur); }
        if (!has_next) break;
#pragma unroll
        for (int a = 0; a < 2; ++a)
#pragma unroll
            for (int b = 0; b < 2; ++b)
#pragma unroll
                for (int m = 0; m < 4; ++m)
#pragma unroll
                    for (int n = 0; n < 2; ++n) acc[a][b][m][n] = (f32x4){0.f, 0.f, 0.f, 0.f};
        cur = nxt; cA = nA; cB = nB; ++ui;
        if constexpr (ALIGN_EPI) { if (wr == 1) PG8_BAR; }
    }
    PG8_WAIT_V(0);
    if constexpr (!ALIGN_EPI) { if (wr == 0) PG8_BAR; }
    PG8_BAR;
    if constexpr (Epi::AFTER_DRAIN) { E.fused(acc, cur, wr, wc, fr, fq, lds, wid, lane); S.done(cur); }
#undef PG8_SA
#undef PG8_SB
#undef PG8_STAGE
#undef PG8_LDA
#undef PG8_LDB
#undef PG8_MMA
#undef PG8_WAIT_V
#undef PG8_WAIT_L
#undef PG8_BAR
#undef PG8_SCHED
}
__device__ __forceinline__ void map_tile(int L, int nM, int nN, int& pm, int& pn) {
    const int nwg = nM * nN; int wgid = L; { const int q = nwg / NXCD, r = nwg % NXCD, xcd = wgid % NXCD, off = wgid / NXCD; wgid = (xcd < r ? xcd * (q + 1) : r * (q + 1) + (xcd - r) * q) + off; }
    const int nig = WGM * nN, gid = wgid / nig, fm = gid * WGM, gsz = (nM - fm) < WGM ? (nM - fm) : WGM;
    pm = fm + ((wgid % nig) % gsz); pn = (wgid % nig) / gsz;
}
constexpr int MP = T / 256, WP = NMAIN / 256, NU2 = 4 * MP, NU1 = MP * WP;
struct InOrder { int G, c;
    __device__ __forceinline__ bool next(int i, Unit& u) const { const int L = i * G + c; if (L >= NU2 + NU1) return false; int a, b;
        if (L < NU2) { map_tile(L, 4, MP, a, b); u.pm = MP + WP + a; u.pn = b; } else { map_tile(L - NU2, MP, WP, a, b); u.pm = a; u.pn = MP + b; } return true; }
    __device__ __forceinline__ void a_ready(const Unit&) const {}
    __device__ __forceinline__ void done(const Unit&) const {}
};
struct EpiIn { static constexpr bool PERM = true, AFTER_DRAIN = false; bf16_t* P; float* G; bf16_t* HTp;
    __device__ __forceinline__ void operator()(const f32x4 (&acc)[2][2][4][2], const Unit& u, int wr, int wc, int fr, int fq) const {
        if (u.pm < MP) { const int pn = u.pn - MP, row0 = u.pm * BM + wr * 64 + fr;
            if (pn < NP / 256) { const int col0 = pn * BM + wc * 32 + 8 * fq;
#pragma unroll
                for (int ai = 0; ai < 2; ++ai)
#pragma unroll
                    for (int m = 0; m < 4; ++m) { bf16_t* rowp = P + (size_t)(row0 + ai * HALF + m * 16) * NP + col0;
#pragma unroll
                        for (int bj = 0; bj < 2; ++bj) { const f32x4 v0 = acc[ai][bj][m][0], v1 = acc[ai][bj][m][1];
                            u32x4 w; w.x = cvt_pk_bf16(v0[0], v0[1]); w.y = cvt_pk_bf16(v0[2], v0[3]); w.z = cvt_pk_bf16(v1[0], v1[1]); w.w = cvt_pk_bf16(v1[2], v1[3]); *(u32x4*)(rowp + bj * HALF) = w; } } }
            else { const int cb = wc * 32 + 8 * fq;
                if (cb < NG) {
#pragma unroll
                    for (int ai = 0; ai < 2; ++ai)
#pragma unroll
                        for (int m = 0; m < 4; ++m) { float* rowb = G + (size_t)(row0 + ai * HALF + m * 16) * NGS; const f32x4 v0 = acc[ai][0][m][0], v1 = acc[ai][0][m][1];
                            if (cb < 16) { *(f32x4*)(rowb + cb) = v0; *(f32x4*)(rowb + cb + 4) = v1; }
                            else { u32x4 w; w.x = cvt_pk_bf16(v0[0], v0[1]); w.y = cvt_pk_bf16(v0[2], v0[3]); w.z = cvt_pk_bf16(v1[0], v1[1]); w.w = cvt_pk_bf16(v1[2], v1[3]); *(u32x4*)((bf16_t*)(rowb + 16) + (cb - 16)) = w; } } } } }
        else { const int row0 = (u.pm - MP - WP) * BM + wr * 64 + fr, col0 = u.pn * BM + wc * 32 + 8 * fq;
#pragma unroll
            for (int ai = 0; ai < 2; ++ai)
#pragma unroll
                for (int m = 0; m < 4; ++m) { bf16_t* rowp = HTp + (size_t)(row0 + ai * HALF + m * 16) * T + col0;
#pragma unroll
                    for (int bj = 0; bj < 2; ++bj) { const f32x4 v0 = acc[ai][bj][m][0], v1 = acc[ai][bj][m][1];
                        u32x4 w; w.x = cvt_pk_bf16(v0[0], v0[1]); w.y = cvt_pk_bf16(v0[2], v0[3]); w.z = cvt_pk_bf16(v1[0], v1[1]); w.w = cvt_pk_bf16(v1[2], v1[3]); *(u32x4*)(rowp + bj * HALF) = w; } } }
    }
};
struct OutOrder { int G, c; bool lat_only; unsigned* cnt;
    __device__ __forceinline__ bool next(int i, Unit& u) const { constexpr int nN = DM / 256, nLat = NB * (SEQ / 256) * nN, nCtx = NB * (CTXL / 256) * nN; const int L = i * G + c; int a, b;
        if (L < nLat) { map_tile(L, nLat / nN, nN, a, b); u.pm = (a / (SEQ / 256)) * (TOK / 256) + CTXL / 256 + a % (SEQ / 256); }
        else { if (lat_only || L >= nLat + nCtx) return false; map_tile(L - nLat, nCtx / nN, nN, a, b); u.pm = (a / (CTXL / 256)) * (TOK / 256) + a % (CTXL / 256); }
        u.pn = b; return true; }
    __device__ __forceinline__ void a_ready(const Unit&) const {}
    unsigned* xu; unsigned nloc, xtarget;
    __device__ __forceinline__ void done(const Unit& u) const {
        asm volatile("s_waitcnt vmcnt(0)" ::: "memory"); __builtin_amdgcn_s_barrier();
        if (threadIdx.x == 0) { const bool isctx = (u.pm % (TOK / 256)) < CTXL / 256;
            if (!isctx && xtarget != 0u) {
                const unsigned old = __hip_atomic_fetch_add(xu, 1u, __ATOMIC_RELAXED, __HIP_MEMORY_SCOPE_AGENT);
                if (old + 1u == xtarget) { __builtin_amdgcn_fence(__ATOMIC_RELEASE, "agent"); asm volatile("s_waitcnt vmcnt(0)" ::: "memory");
                    __hip_atomic_fetch_add(cnt, nloc, __ATOMIC_RELAXED, __HIP_MEMORY_SCOPE_AGENT); } }
            else { __builtin_amdgcn_fence(__ATOMIC_RELEASE, "agent"); asm volatile("s_waitcnt vmcnt(0)" ::: "memory");
                __hip_atomic_fetch_add(cnt + (isctx ? 64 : 0), 1u, __ATOMIC_RELAXED, __HIP_MEMORY_SCOPE_AGENT); } } }
};
struct EpiOut { static constexpr bool PERM = true, AFTER_DRAIN = false; bf16_t* C;
    __device__ __forceinline__ void operator()(const f32x4 (&acc)[2][2][4][2], const Unit& u, int wr, int wc, int fr, int fq) const {
        const int row0 = u.pm * BM + wr * 64 + fr, col0 = u.pn * BM + wc * 32 + 8 * fq;
#pragma unroll
        for (int ai = 0; ai < 2; ++ai)
#pragma unroll
            for (int m = 0; m < 4; ++m) { bf16_t* rowp = C + (size_t)(row0 + ai * HALF + m * 16) * DM + col0;
#pragma unroll
                for (int bj = 0; bj < 2; ++bj) { const f32x4 v0 = acc[ai][bj][m][0], v1 = acc[ai][bj][m][1];
                    u32x4 w; w.x = cvt_pk_bf16(v0[0], v0[1]); w.y = cvt_pk_bf16(v0[2], v0[3]); w.z = cvt_pk_bf16(v1[0], v1[1]); w.w = cvt_pk_bf16(v1[2], v1[3]); *(u32x4*)(rowp + bj * HALF) = w; } }
    }
};
}
#endif

__device__ __forceinline__ void phase_gemm_in(const Params& p, int l, char* smem) {
    constexpr int N_F = WG / 2;
#ifdef EMU
    constexpr int MT = T / 128, NT1 = NMAIN / 128, N1 = MT * NT1, N2 = 8 * MT;
    for (int task = obid(); task < N1 + N2; task += gridDim.x) {
        if (task < N1) gemm_tile(p, (const bf16*)(p.ws + WS_HNY), (const bf16*)(p.ws + WS_WIN), DM, task / NT1, task % NT1, 0, smem);
        else { const int t2 = task - N1; gemm_tile(p, (const bf16*)(p.ws + WS_WIN) + (size_t)NMAIN * DM, (const bf16*)(p.ws + WS_HNY), DM, t2 / MT, t2 % MT, 2, smem); }
    }
#else
    { const pg8::Gemm g{(const pg8::bf16_t*)(p.ws + WS_HNY), (const pg8::bf16_t*)(p.ws + WS_HNY), 0, 0, DM};
      const pg8::InOrder S{(int)gridDim.x, obid()};
      const pg8::EpiIn E{(pg8::bf16_t*)(p.ws + WS_P), (float*)(p.ws + WS_G), (pg8::bf16_t*)(p.ws + WS_HT)};
      pg8::gemm_phase<pg8::EpiIn, pg8::InOrder, true, true>((PG8_LAS unsigned char*)smem, g, S, E); }
#endif
    { const int G = (int)gridDim.x, bid = obid();
#ifdef EMU
      const int extra = 0;
#else
      const int extra = (pg8::NU1 + pg8::NU2) % G;
#endif
      if (extra > 0 && extra < G) { if (bid >= extra) for (int task = bid - extra; task < N_F; task += G - extra) filt_fft_task(p, task, smem); }
      else for (int task = G - 1 - bid; task < N_F; task += G) filt_fft_task(p, task, smem); }
}
__device__ __forceinline__ void phase_gemm_out(const Params& p, int l, char* smem) {
    const int G = (int)gridDim.x, bid = obid(); const bool has_ctx = l < DEPTH - 1;
#ifdef EMU
    constexpr int MT = T / 128, NTO = DM / 128;
    for (int task = bid; task < MT * NTO; task += G) {
        const int mt = task / NTO, nt = task % NTO;
        if (!has_ctx && (mt % (TOK / 128)) < CTXL / 128) continue;
        gemm_tile(p, (const bf16*)(p.ws + WS_HNY), (const bf16*)(p.ws + WS_WOUT), MIX, mt, nt, 1, smem);
        __syncthreads(); if (otid() == 0) *unit_counter(p, (mt % (TOK / 128)) < CTXL / 128 ? 1 : 0) += 1u;
    }
#else
    const pg8::Gemm g{(const pg8::bf16_t*)(p.ws + WS_HNY), (const pg8::bf16_t*)(p.ws + WS_WOUT), 0, 0, MIX};
    const unsigned xcc = (unsigned)__builtin_amdgcn_s_getreg((3 << 11) | 20) & 0xFu, nloc = ((volatile PG8_LAS unsigned*)(smem + LDS_BYTES - 64))[0];
    const bool agg = (NB * (SEQ / 256) * (DM / 256) == G) && nloc > 0u;
    const pg8::OutOrder S{G, bid, !has_ctx, unit_counter(p, 0), unit_counter(p, 2) + 16 * xcc, nloc, agg ? nloc * (unsigned)(l + 1) : 0u};
    const pg8::EpiOut E{(pg8::bf16_t*)(p.ws + WS_P)};
    pg8::gemm_phase<pg8::EpiOut, pg8::OutOrder, true, true>((PG8_LAS unsigned char*)smem, g, S, E);
#endif
}

__device__ __forceinline__ size_t st_index(int mixer, int dir, int b, int h, int cid) { return ((((size_t)(mixer * 2 + dir) * NB + b) * NH + h) * NCH + cid); }
__device__ __forceinline__ size_t ch_index(int dir, int b, int h, int cid) { return (((size_t)dir * NB + b) * NH + h) * NCH + cid; }

__device__ __forceinline__ void load_tile_nat(const bf16* P, int r0, int c0, bf16* dst, float scale, int tid) {
    const int s = tid >> 3, c8 = tid & 7;
    const u32x4 v = *(const u32x4*)(P + (size_t)(r0 + s) * NP + c0 + c8 * 8);
    if (scale == 1.0f) *(u32x4*)(dst + s * LS + c8 * 8) = v;
    else { float f[8]; unpack8(v, f); u32x4 o; o.x = pk2(f[0] * scale, f[1] * scale); o.y = pk2(f[2] * scale, f[3] * scale); o.z = pk2(f[4] * scale, f[5] * scale); o.w = pk2(f[6] * scale, f[7] * scale);
        *(u32x4*)(dst + s * LS + c8 * 8) = o; }
}
__device__ __forceinline__ void load_tile_tr(const bf16* P, int r0, int c0, bf16* dst, int tid) {
    const int s = tid >> 3, c8 = tid & 7;
    const u32x4 v = *(const u32x4*)(P + (size_t)(r0 + s) * NP + c0 + c8 * 8);
    const unsigned w[4] = {v.x, v.y, v.z, v.w};
#pragma unroll
    for (int j = 0; j < 4; ++j) { dst[(c8 * 8 + 2 * j) * LS + s] = (bf16)(w[j] & 0xffffu); dst[(c8 * 8 + 2 * j + 1) * LS + s] = (bf16)(w[j] >> 16); }
}

template <int NTK>
__device__ __forceinline__ void load_span(const bf16* row, int t0, float (&v)[NTK + 2]) {
    { const bool hl = t0 > 0, hr = t0 + NTK < SEQ; const bf16 xl = row[hl ? -1 : 0], xr = row[hr ? NTK : 0];
        v[0] = hl ? bf2f(xl) : 0.f; v[NTK + 1] = hr ? bf2f(xr) : 0.f; }
    if constexpr (NTK == 8) { float f[8]; unpack8(*(const u32x4*)row, f);
#pragma unroll
        for (int i = 0; i < 8; ++i) v[1 + i] = f[i]; }
    else {
#pragma unroll
        for (int i = 0; i < NTK; ++i) v[1 + i] = bf2f(row[i]); }
}
template <int NTK>
__device__ __forceinline__ void hy_inputs(const bf16* h0, const bf16* h1, const float* cw, const float* cb, int c, int t0, float (&u0)[NTK], float (&u1)[NTK], float (&g0)[NTK], float (&g1)[NTK]) {
    { float xa[NTK + 2], xb[NTK + 2]; load_span<NTK>(h0 + (size_t)512 * T, t0, xa); load_span<NTK>(h1 + (size_t)512 * T, t0, xb);
        const float w0 = cw[0 * 768 + 512 + c], w1 = cw[1 * 768 + 512 + c], w2 = cw[2 * 768 + 512 + c], bb = cb[512 + c];
        float ga[NTK + 2], gb[NTK + 2]; load_span<NTK>(h0 + (size_t)768 * T, t0, ga); load_span<NTK>(h1 + (size_t)768 * T, t0, gb);
#pragma unroll
        for (int i = 0; i < NTK; ++i) { g0[i] = (w0 * xa[i] + w1 * xa[i + 1] + w2 * xa[i + 2] + bb) * siluf_(ga[i + 1]); g1[i] = (w0 * xb[i] + w1 * xb[i + 1] + w2 * xb[i + 2] + bb) * siluf_(gb[i + 1]); } }
    { float va[NTK + 2], vb[NTK + 2], ya[NTK + 2], yb[NTK + 2];
        load_span<NTK>(h0, t0, va); load_span<NTK>(h1, t0, vb); load_span<NTK>(h0 + (size_t)256 * T, t0, ya); load_span<NTK>(h1 + (size_t)256 * T, t0, yb);
        const float v0 = cw[0 * 768 + c], v1 = cw[1 * 768 + c], v2 = cw[2 * 768 + c], vbias = cb[c];
        const float y0 = cw[0 * 768 + 256 + c], y1 = cw[1 * 768 + 256 + c], y2 = cw[2 * 768 + 256 + c], ybias = cb[256 + c];
#pragma unroll
        for (int i = 0; i < NTK; ++i) { u0[i] = (v0 * va[i] + v1 * va[i + 1] + v2 * va[i + 2] + vbias) * (y0 * ya[i] + y1 * ya[i + 1] + y2 * ya[i + 2] + ybias);
            u1[i] = (v0 * vb[i] + v1 * vb[i + 1] + v2 * vb[i + 2] + vbias) * (y0 * yb[i] + y1 * yb[i + 1] + y2 * yb[i + 2] + ybias); } }
}
__device__ __forceinline__ void hylat_task(const Params& p, int l, int bp, int cp, char* smem) {
    const int tid = otid(), half = tid >> 8, tl = tid & 255, c = 2 * cp + half;
    const bf16* HT = (const bf16*)(p.ws + WS_HT); bf16* Y = (bf16*)(p.ws + WS_HNY);
    cpx* buf = (cpx*)smem + (size_t)half * FBUF;
    const cpx* TW = (const cpx*)(p.ws + WS_TW);
    const cpx* KF = (const cpx*)(p.ws + WS_KF) + (size_t)c * NF;
    constexpr int NTK = SEQ / 256;
    const int t0 = NTK * tl;
    const float* cw = p.in[I_HCW] + (size_t)l * 3 * 768; const float* cb = p.in[I_HCB] + (size_t)l * 768;
    const size_t rb0 = (size_t)(2 * bp) * TOK + CTXL, rb1 = rb0 + TOK;
    const bf16* h0 = HT + (size_t)c * T + rb0 + t0; const bf16* h1 = h0 + TOK;
    { float u0[NTK], u1[NTK], g0[NTK], g1[NTK]; hy_inputs<NTK>(h0, h1, cw, cb, c, t0, u0, u1, g0, g1);
        __syncthreads();
#pragma unroll
        for (int i = 0; i < NTK; ++i) { cpx v; v.x = u0[i]; v.y = u1[i]; buf[FPH(t0 + i)] = v; cpx z = {0.f, 0.f}; buf[FPH(SEQ + t0 + i)] = z; } }
    fft_fwd(buf, TW, tl);
#pragma unroll 2
    for (int i = tl; i < NF; i += 256) buf[FPH(i)] = cmul(buf[FPH(i)], KF[i]);
    fft_inv(buf, TW, tl);
    const float dsk = p.in[I_HD][(size_t)l * WG + c]; const float sc = 1.0f / (float)NF;
    { const int tz = otid() & 255; const int t0z = NTK * tz;
        float u0[NTK], u1[NTK], g0[NTK], g1[NTK]; hy_inputs<NTK>(HT + (size_t)c * T + rb0 + t0z, HT + (size_t)c * T + rb0 + t0z + TOK, cw, cb, c, t0z, u0, u1, g0, g1);
        float o0[NTK], o1[NTK];
#pragma unroll
        for (int i = 0; i < NTK; ++i) { const cpx y = buf[FPH(t0z + i)]; o0[i] = g0[i] * (y.x * sc + u0[i] * dsk); o1[i] = g1[i] * (y.y * sc + u1[i] * dsk); }
        bf16* d0 = (bf16*)(p.ws + WS_HT) + (size_t)(768 + c) * T + rb0 + t0z; bf16* d1 = d0 + TOK;
        if constexpr (NTK == 8) { *(u32x4*)d0 = pack8(o0); *(u32x4*)d1 = pack8(o1); }
        else {
#pragma unroll
            for (int i = 0; i < NTK; ++i) { d0[i] = f2bf(o0[i]); d1[i] = f2bf(o1[i]); } } }
}

constexpr int HCB = 16;
__device__ __forceinline__ void hyctx_task(const Params& p, int l, int b, int cblk, char* smem) {
    const int tid = otid(); const int c0 = cblk * HCB;
    const bf16* HT = (const bf16*)(p.ws + WS_HT); bf16* Y = (bf16*)(p.ws + WS_HNY); const float* HC = (const float*)(p.ws + WS_HC);
    float* raw = (float*)smem;
    float* u = raw + 4 * CTXL * HCB;
    float* og = u + CTXL * HCB;
    float* hcm = og + CTXL * HCB;
    bf16* ob = (bf16*)raw;
    const size_t rb = (size_t)b * TOK;
    const float* cw = p.in[I_HCW] + (size_t)l * 3 * 768; const float* cbias = p.in[I_HCB] + (size_t)l * 768;
    constexpr int WT = CTXL / 32;
    __syncthreads();
    for (int i = tid; i < 4 * HCB * (CTXL / 8); i += NT) { const int k = i / (HCB * (CTXL / 8)), cc = (i / (CTXL / 8)) % HCB, ck = i % (CTXL / 8);
        float f[8]; unpack8(*(const u32x4*)(HT + (size_t)(k * 256 + c0 + cc) * T + rb + ck * 8), f);
#pragma unroll
        for (int j = 0; j < 8; ++j) raw[(k * CTXL + ck * 8 + j) * HCB + cc] = f[j]; }
    for (int i = tid; i < 2 * HCB * (CTXL / 4); i += NT) { const int dir = i / (HCB * (CTXL / 4)), cc = (i / (CTXL / 4)) % HCB, pk = i % (CTXL / 4);
        const f32x4 v = *(const f32x4*)(HC + ((size_t)dir * WG + c0 + cc) * CTXL + pk * 4); const float f[4] = {v.x, v.y, v.z, v.w};
#pragma unroll
        for (int j = 0; j < 4; ++j) { const int pos = pk * 4 + j; if (dir == 0) hcm[(CTXL + pos) * HCB + cc] = f[j]; else if (pos > 0) hcm[(CTXL - pos) * HCB + cc] = f[j]; } }
    if (tid < HCB) hcm[tid] = 0.f;
    __syncthreads();
    for (int i = tid; i < CTXL * HCB; i += NT) { const int t = i / HCB, cc = i % HCB; float cv[3];
#pragma unroll
        for (int k = 0; k < 3; ++k) { const float* rk = raw + k * CTXL * HCB; const int ch = k * 256 + c0 + cc;
            const float a = t > 0 ? rk[(t - 1) * HCB + cc] : 0.f, m = rk[t * HCB + cc], z = t < CTXL - 1 ? rk[(t + 1) * HCB + cc] : 0.f;
            cv[k] = cw[0 * 768 + ch] * a + cw[1 * 768 + ch] * m + cw[2 * 768 + ch] * z + cbias[ch]; }
        u[i] = cv[0] * cv[1];
        og[i] = cv[2] * siluf_(raw[(3 * CTXL + t) * HCB + cc]); }
    __syncthreads();
    { const int cc = tid % HCB, tg = tid / HCB, t0 = WT * tg; float acc[WT], w[WT];
#pragma unroll
        for (int j = 0; j < WT; ++j) { acc[j] = 0.f; w[j] = hcm[(t0 + j + CTXL) * HCB + cc]; }
#pragma unroll 8
        for (int s = 0; s < CTXL; ++s) { const float us = u[s * HCB + cc];
#pragma unroll
            for (int j = 0; j < WT; ++j) acc[j] += us * w[j];
#pragma unroll
            for (int j = WT - 1; j > 0; --j) w[j] = w[j - 1];
            w[0] = hcm[(t0 - s - 1 + CTXL) * HCB + cc]; }
        const float dsk = p.in[I_HD][(size_t)l * WG + c0 + cc];
#pragma unroll
        for (int j = 0; j < WT; ++j) { const int t = t0 + j; ob[t * HCB + cc] = f2bf(og[t * HCB + cc] * (acc[j] + u[t * HCB + cc] * dsk)); } }
    __syncthreads();
    for (int i = tid; i < CTXL * 2; i += NT) { const int t = i >> 1, hh = i & 1; *(u32x4*)(Y + (rb + t) * 1024 + YH + c0 + 8 * hh) = *(const u32x4*)(ob + t * HCB + 8 * hh); }
}

__device__ __forceinline__ void attn_task(const Params& p, int l, int b, int kvh, int qt, bool ctxq, char* smem) {
    const int tid = otid(), lane = tid & 63, wave = tid >> 6, r = lane & 15, q = lane >> 4;
    const bf16* P = (const bf16*)(p.ws + WS_P); bf16* Y = (bf16*)(p.ws + WS_HNY); const cpx* ROPE = (const cpx*)(p.ws + WS_ROPE);
    bf16* Qs = (bf16*)smem;
    bf16* Ks = Qs + 256 * LS;
    bf16* Vt = Ks + 64 * LS;
    bf16* Ps = Vt + 64 * LS;
    const size_t rq0 = (size_t)b * TOK + (ctxq ? 0 : CTXL) + qt * 128;
    __syncthreads();
#pragma unroll
    for (int it = 0; it < 2; ++it) {
        const int idx = tid + NT * it, row = idx >> 2, cpair = idx & 3, g = row >> 7, t = row & 127;
        const bf16* src = P + (rq0 + t) * NP + PD + (kvh * 2 + g) * 64;
        float lo[8], hi[8]; unpack8(*(const u32x4*)(src + cpair * 8), lo); unpack8(*(const u32x4*)(src + 32 + cpair * 8), hi);
        float a[8], c2[8];
#pragma unroll
        for (int j = 0; j < 8; ++j) { float cs = 1.f, sn = 0.f; if (!ctxq) { const cpx cv = ROPE[(size_t)(qt * 128 + t) * 32 + cpair * 8 + j]; cs = cv.x; sn = cv.y; }
            a[j] = (lo[j] * cs - hi[j] * sn) * 0.125f; c2[j] = (hi[j] * cs + lo[j] * sn) * 0.125f; }
        *(u32x4*)(Qs + row * LS + cpair * 8) = pack8(a); *(u32x4*)(Qs + row * LS + 32 + cpair * 8) = pack8(c2);
    }
    const int lt0 = ctxq ? 0 : (2 * qt - 2 > 0 ? 2 * qt - 2 : 0), lt1 = ctxq ? -1 : (2 * qt + 3 < SEQ / 64 - 1 ? 2 * qt + 3 : SEQ / 64 - 1);
    const int nloc = lt1 - lt0 + 1, ntiles = nloc + NCC;
    float m[2][4], lsum[2][4]; f32x4 O[2][4];
#pragma unroll
    for (int ms = 0; ms < 2; ++ms)
#pragma unroll
        for (int i = 0; i < 4; ++i) { m[ms][i] = -INFINITY; lsum[ms][i] = 0.f; O[ms][i] = (f32x4){0.f, 0.f, 0.f, 0.f}; }
    const int g = wave >> 2, tq0 = (wave & 3) * 32;
    bf16* Pw = Ps + wave * 32 * LS;
    u32x4 klo = {0u, 0u, 0u, 0u}, khi = klo, vq = klo; f32x4 rp[4] = {(f32x4){1.f, 0.f, 1.f, 0.f}, (f32x4){1.f, 0.f, 1.f, 0.f}, (f32x4){1.f, 0.f, 1.f, 0.f}, (f32x4){1.f, 0.f, 1.f, 0.f}};
    const int ks_ = tid >> 2, kcp = tid & 3, vs_ = tid >> 3, vc8 = tid & 7;
#define ATT_PREFETCH(TI) do { const bool loc_ = (TI) < nloc; const int kt_ = loc_ ? lt0 + (TI) : (TI) - nloc; const size_t rk_ = (size_t)b * TOK + (loc_ ? CTXL : 0) + kt_ * 64; \
        if (tid < 256) { const bf16* src_ = P + (rk_ + ks_) * NP + PD + 256 + kvh * 64; klo = *(const u32x4*)(src_ + kcp * 8); khi = *(const u32x4*)(src_ + 32 + kcp * 8); \
            if (loc_) { const f32x4* rr_ = (const f32x4*)(ROPE + (size_t)(kt_ * 64 + ks_) * 32 + kcp * 8); rp[0] = rr_[0]; rp[1] = rr_[1]; rp[2] = rr_[2]; rp[3] = rr_[3]; } \
            else { rp[0] = rp[1] = rp[2] = rp[3] = (f32x4){1.f, 0.f, 1.f, 0.f}; } } \
        vq = *(const u32x4*)(P + (rk_ + vs_) * NP + PD + 384 + kvh * 64 + vc8 * 8); } while (0)
    ATT_PREFETCH(0);
    for (int ti = 0; ti < ntiles; ++ti) {
        const bool local = ti < nloc; const int kt = local ? lt0 + ti : ti - nloc;
        __syncthreads();
        if (tid < 256) { float lo[8], hi[8]; unpack8(klo, lo); unpack8(khi, hi);
            const float cs[8] = {rp[0].x, rp[0].z, rp[1].x, rp[1].z, rp[2].x, rp[2].z, rp[3].x, rp[3].z}, sn[8] = {rp[0].y, rp[0].w, rp[1].y, rp[1].w, rp[2].y, rp[2].w, rp[3].y, rp[3].w};
            float a[8], c2[8];
#pragma unroll
            for (int j = 0; j < 8; ++j) { a[j] = lo[j] * cs[j] - hi[j] * sn[j]; c2[j] = hi[j] * cs[j] + lo[j] * sn[j]; }
            *(u32x4*)(Ks + ks_ * LS + kcp * 8) = pack8(a); *(u32x4*)(Ks + ks_ * LS + 32 + kcp * 8) = pack8(c2); }
        { const unsigned w[4] = {vq.x, vq.y, vq.z, vq.w};
#pragma unroll
            for (int j = 0; j < 4; ++j) { Vt[(vc8 * 8 + 2 * j) * LS + vs_] = (bf16)(w[j] & 0xffffu); Vt[(vc8 * 8 + 2 * j + 1) * LS + vs_] = (bf16)(w[j] >> 16); } }
        __syncthreads();
        if (ti + 1 < ntiles) ATT_PREFETCH(ti + 1);
#pragma unroll
        for (int ms = 0; ms < 2; ++ms) {
            const int qlo = qt * 128 + tq0 + 16 * ms, klo_ = kt * 64;
            if (local && (klo_ > qlo + 15 + 128 || klo_ + 63 < qlo - 128)) continue;
            f32x4 S[4] = {(f32x4){0.f, 0.f, 0.f, 0.f}, (f32x4){0.f, 0.f, 0.f, 0.f}, (f32x4){0.f, 0.f, 0.f, 0.f}, (f32x4){0.f, 0.f, 0.f, 0.f}};
            mma_nt<4, 2>(Qs, LS, g * 128 + tq0 + 16 * ms, Ks, LS, 0, S, lane);
            float rmax[4];
#pragma unroll
            for (int i = 0; i < 4; ++i) { const int qpos = qlo + 4 * q + i; float mx = -INFINITY;
#pragma unroll
                for (int nt = 0; nt < 4; ++nt) { if (local) { const int kpos = kt * 64 + nt * 16 + r; const int d = kpos - qpos; if (d > 128 || d < -128) S[nt][i] = -INFINITY; } mx = fmaxf(mx, S[nt][i]); }
                rmax[i] = row16_max(mx); }
#pragma unroll
            for (int i = 0; i < 4; ++i) { const float mn = fmaxf(m[ms][i], rmax[i]); const float msafe = mn == -INFINITY ? 0.f : mn; const float alpha = __expf(m[ms][i] - msafe); float sm = 0.f;
#pragma unroll
                for (int nt = 0; nt < 4; ++nt) { const float pv = __expf(S[nt][i] - msafe); sm += pv; Pw[(16 * ms + 4 * q + i) * LS + nt * 16 + r] = f2bf(pv); O[ms][nt][i] *= alpha; }
                sm = row16_sum(sm);
                lsum[ms][i] = lsum[ms][i] * alpha + sm; m[ms][i] = mn; }
            WAVE_SYNC();
            mma_nt<4, 2>(Pw, LS, 16 * ms, Vt, LS, 0, O[ms], lane);
        }
    }
#undef ATT_PREFETCH
    const float sink = p.in[I_SINK][(size_t)l * NH + kvh * 2 + g];
    WAVE_SYNC();
#pragma unroll
    for (int ms = 0; ms < 2; ++ms)
#pragma unroll
        for (int i = 0; i < 4; ++i) { const float den = lsum[ms][i] + __expf(sink - m[ms][i]); const float inv = frcp_(den);
#pragma unroll
            for (int nt = 0; nt < 4; ++nt) Pw[(16 * ms + 4 * q + i) * LS + nt * 16 + r] = f2bf(O[ms][nt][i] * inv); }
    WAVE_SYNC();
#pragma unroll
    for (int hh = 0; hh < 4; ++hh) { const int t = lane >> 1, ck = (lane & 1) * 4 + hh;
        float fo[8], fg[8]; unpack8(*(const u32x4*)(Pw + t * LS + ck * 8), fo);
        unpack8(*(const u32x4*)(P + (rq0 + tq0 + t) * NP + PD + 512 + (kvh * 2 + g) * 64 + ck * 8), fg);
#pragma unroll
        for (int j = 0; j < 8; ++j) fo[j] *= siluf_(fg[j]);
        *(u32x4*)(Y + (rq0 + tq0 + t) * 1024 + YD + (kvh * 2 + g) * 64 + ck * 8) = pack8(fo); }
}

#ifdef EMU
__device__ __forceinline__ int olane(int lane) { return lane; }
#else
__device__ __forceinline__ int olane(int lane) { asm volatile("" : "+v"(lane)); return lane; }
#endif
__device__ __forceinline__ void load_nat_tile(const bf16* P, int row0, int col0, bf16* tile, int lane) {
    u32x4 v[8];
#pragma unroll
    for (int i = 0; i < 8; ++i) v[i] = *(const u32x4*)(P + (size_t)(row0 + (lane >> 3) + 8 * i) * NP + col0 + (lane & 7) * 8);
#pragma unroll
    for (int i = 0; i < 8; ++i) *(u32x4*)(tile + swz((lane >> 3) + 8 * i, lane & 7)) = v[i];
}
__device__ __forceinline__ bf16x8 frag_tr(const bf16* tile, int c0, int k0, int lane) {
    const int c = c0 + (lane & 15), kb = k0 + 8 * (lane >> 4); unsigned w[4];
#pragma unroll
    for (int j = 0; j < 4; ++j) w[j] = (unsigned)tile[swz(kb + 2 * j, c >> 3) + (c & 7)] | ((unsigned)tile[swz(kb + 2 * j + 1, c >> 3) + (c & 7)] << 16);
    u32x4 o; o.x = w[0]; o.y = w[1]; o.z = w[2]; o.w = w[3]; return as_frag(o);
}
template <int DIR>
__device__ __forceinline__ void gla_r_frags(const float* Grow0, int lane, bf16x8 (&af)[4]) {
    const int r = lane & 15, q4 = lane >> 4;
#pragma unroll
    for (int mt = 0; mt < 4; ++mt) { u32x4 o = {0u, 0u, 0u, 0u};
        if (q4 < 2) o = *(const u32x4*)((const bf16*)(Grow0 + (size_t)(16 * mt + r) * NGS + 16) + DIR * 16 + 8 * q4);
        af[mt] = as_frag(o); }
}
template <int DIR>
__device__ __forceinline__ float gla_b_col(const Params& p, int l, int h, const bf16x8 (&af)[4], int nt, int lane_, float (&x)[4][4]) {
    const int lane = olane(lane_), r = lane & 15, q4 = lane >> 4, d = h * 64 + 16 * nt + r;
    u32x4 o = {0u, 0u, 0u, 0u};
    if (q4 < 2) { const float* wa = p.in[I_GWA] + ((size_t)(l * 2 + DIR) * 16 + 8 * q4) * WG + d;
        o.x = pk2(wa[0], wa[WG]); o.y = pk2(wa[2 * WG], wa[3 * WG]); o.z = pk2(wa[4 * WG], wa[5 * WG]); o.w = pk2(wa[6 * WG], wa[7 * WG]); }
    const bf16x8 bfr = as_frag(o); const float bias = p.in[I_GBA][(size_t)(l * 2 + DIR) * WG + d];
#pragma unroll
    for (int mt = 0; mt < 4; ++mt) { f32x4 c = {bias, bias, bias, bias}; c = MFMA16(af[mt], bfr, c);
#pragma unroll
        for (int i = 0; i < 4; ++i) x[mt][i] = logsig_fast(c[i]) * (1.0f / 16.0f); }
    float carry = 0.f;
#pragma unroll
    for (int k = 0; k < 4; ++k) { const int mt = DIR == 0 ? k : 3 - k; float* y = x[mt];
        if (DIR == 0) { y[1] += y[0]; y[2] += y[1]; y[3] += y[2]; } else { y[2] += y[3]; y[1] += y[2]; y[0] += y[1]; }
        const float s4 = DIR == 0 ? y[3] : y[0];
        const float t1 = DIR == 0 ? __shfl_up(s4, 16) : __shfl_down(s4, 16), t2 = DIR == 0 ? __shfl_up(s4, 32) : __shfl_down(s4, 32), t3 = DIR == 0 ? __shfl_up(s4, 48) : __shfl_down(s4, 48);
        const int qq = DIR == 0 ? q4 : 3 - q4;
        const float e = (qq >= 1 ? t1 : 0.f) + (qq >= 2 ? t2 : 0.f) + (qq >= 3 ? t3 : 0.f);
        const float tot = __shfl(e + s4, DIR == 0 ? r + 48 : r);
#pragma unroll
        for (int i = 0; i < 4; ++i) y[i] += carry + e;
        carry += tot; }
    return carry;
}

template <int MIXER, int DIR>
__device__ __forceinline__ void chunkst_dir(const Params& p, int l, int b, int h, int cid, const float* Grow0, const unsigned (&kk)[32], const bf16* Vt, bf16* Kt, const float* wvs, float* bendl, int lane_) {
    const int lane = olane(lane_), r = lane & 15, q4 = lane >> 4;
    if constexpr (MIXER == 0) {
        float nacc = 0.f;
#pragma unroll
        for (int c = 0; c < 8; ++c) { float f[8];
#pragma unroll
            for (int j = 0; j < 8; ++j) { const int s = 8 * c + j; const float kv = (s & 1) ? bitsf(kk[s >> 1] & 0xffff0000u) : bitsf(kk[s >> 1] << 16);
                f[j] = kv * 0.125f * wvs[DIR * 64 + s]; nacc += f[j]; }
            *(u32x4*)(Kt + swz(lane, c)) = pack8(f); }
        ((float*)(p.ws + WS_NV))[ch_index(DIR, b, h, cid) * 64 + lane] = nacc;
    } else {
        const bf16* P = (const bf16*)(p.ws + WS_P); const int kcol = PG + 256 + h * 64; const int r0 = b * TOK + cid * 64;
        bf16x8 af[4]; gla_r_frags<DIR>(Grow0, lane, af);
#pragma unroll 2
        for (int nt = 0; nt < 4; ++nt) { const int d = 16 * nt + r; float x[4][4];
            const float bend = gla_b_col<DIR>(p, l, h, af, nt, lane, x);
            if (q4 == 0) { ((float*)(p.ws + WS_BE))[ch_index(DIR, b, h, cid) * 64 + d] = bend; bendl[d] = __expf(fmaxf(bend, -80.0f)); }
#pragma unroll
            for (int mt = 0; mt < 4; ++mt)
#pragma unroll
                for (int i = 0; i < 4; ++i) { const int s = 16 * mt + 4 * q4 + i; const float kv = bf2f(P[(size_t)(r0 + s) * NP + kcol + d]); const float bc = fmaxf(x[mt][i], -80.0f);
                    Kt[swz(d, s >> 3) + (s & 7)] = f2bf(kv * __expf(-bc));
                    ((bf16*)(p.ws + WS_EQ))[((size_t)DIR * T + r0 + s) * WG + h * 64 + d] = f2bf(__expf(bc)); } }
    }
    WAVE_SYNC();
    bf16x8 vf[4][2];
#pragma unroll
    for (int ne = 0; ne < 4; ++ne)
#pragma unroll
        for (int ks = 0; ks < 2; ++ks) vf[ne][ks] = *(const bf16x8*)(Vt + swz(16 * ne + r, ks * 4 + q4));
    bf16* dst = (bf16*)(p.ws + WS_ST) + st_index(MIXER, DIR, b, h, cid) * 4096;
#pragma unroll
    for (int me = 0; me < 4; ++me) {
        f32x4 acc[4] = {(f32x4){0.f, 0.f, 0.f, 0.f}, (f32x4){0.f, 0.f, 0.f, 0.f}, (f32x4){0.f, 0.f, 0.f, 0.f}, (f32x4){0.f, 0.f, 0.f, 0.f}};
#pragma unroll
        for (int ks = 0; ks < 2; ++ks) { const bf16x8 a = *(const bf16x8*)(Kt + swz(16 * me + r, ks * 4 + q4));
#pragma unroll
            for (int ne = 0; ne < 4; ++ne) acc[ne] = MFMA16(a, vf[ne][ks], acc[ne]); }
        f32x4 sc4 = {1.f, 1.f, 1.f, 1.f}; if constexpr (MIXER == 1) sc4 = *(const f32x4*)(bendl + 16 * me + 4 * q4);
#pragma unroll
        for (int ne = 0; ne < 4; ++ne) { const f32x4 v = acc[ne] * sc4; u32x2 o; o.x = pk2(v[0], v[1]); o.y = pk2(v[2], v[3]); *(u32x2*)(dst + (16 * ne + r) * 64 + 16 * me + 4 * q4) = o; }
    }
    WAVE_SYNC();
}
template <int MIXER>
__device__ __forceinline__ void chunkst_w(const Params& p, int l, int b, int h, int cid, char* wl, int lane) {
    const bf16* P = (const bf16*)(p.ws + WS_P); const float* G = (const float*)(p.ws + WS_G);
    const int r0 = b * TOK + cid * 64, r = lane & 15, q4 = lane >> 4;
    bf16* Kt = (bf16*)wl;
    bf16* Vt = Kt + 4096;
    float* wvs = (float*)(Vt + 4096);
    float* bendl = wvs + 128;
    const int kcol = (MIXER == 0 ? PA : PG) + 256 + h * 64, vcol = (MIXER == 0 ? PA : PG) + 512 + h * 64;
    const float* Grow0 = G + (size_t)r0 * NGS;
    { bf16* Nn = Kt;
        load_nat_tile(P, r0, vcol, Nn, lane);
        WAVE_SYNC();
#pragma unroll
        for (int c = 0; c < 8; ++c) { unsigned w[4];
#pragma unroll
            for (int j = 0; j < 4; ++j) w[j] = (unsigned)Nn[swz(8 * c + 2 * j, lane >> 3) + (lane & 7)] | ((unsigned)Nn[swz(8 * c + 2 * j + 1, lane >> 3) + (lane & 7)] << 16);
            u32x4 o; o.x = w[0]; o.y = w[1]; o.z = w[2]; o.w = w[3]; *(u32x4*)(Vt + swz(lane, c)) = o; }
        WAVE_SYNC();
        load_nat_tile(P, r0, kcol, Nn, lane);
        WAVE_SYNC(); }
    unsigned kk[32];
    { const bf16* Nn = Kt;
#pragma unroll
        for (int i = 0; i < 32; ++i) kk[i] = (unsigned)Nn[swz(2 * i, lane >> 3) + (lane & 7)] | ((unsigned)Nn[swz(2 * i + 1, lane >> 3) + (lane & 7)] << 16); }
    WAVE_SYNC();
    if constexpr (MIXER == 0) {
        const float* g = Grow0 + (size_t)lane * NGS; const float* gb = p.in[I_MGB] + (size_t)l * 16;
        const float i_f = g[h] + gb[h], f_f = g[4 + h] + gb[4 + h], i_b = g[8 + h] + gb[8 + h], f_b = g[12 + h] + gb[12 + h];
        const float lf = logsigf_(f_f), lb = logsigf_(f_b);
        const float bF = wave_prefix_sum(lf, lane), totF = __shfl(bF, 63);
        const float gF = totF - bF + i_f, mF = wave_max(gF);
        const float totB = wave_sum(lb), preB = wave_prefix_sum(lb, lane), bB = totB - preB + lb;
        const float gB = totB - bB + i_b, mB = wave_max(gB);
        wvs[lane] = __expf(gF - mF); wvs[64 + lane] = __expf(gB - mB);
        if (lane == 0) { float* SC = (float*)(p.ws + WS_SC);
            SC[ch_index(0, b, h, cid) * 4 + 0] = totF; SC[ch_index(0, b, h, cid) * 4 + 1] = mF;
            SC[ch_index(1, b, h, cid) * 4 + 0] = totB; SC[ch_index(1, b, h, cid) * 4 + 1] = mB; }
    }
    WAVE_SYNC();
    chunkst_dir<MIXER, 0>(p, l, b, h, cid, Grow0, kk, Vt, Kt, wvs, bendl, lane);
    chunkst_dir<MIXER, 1>(p, l, b, h, cid, Grow0, kk, Vt, Kt, wvs, bendl, lane);
}

template <int DIR>
__device__ __forceinline__ void chunkst_gla(const Params& p, int l, int b, int h, int cid, char* wl, int lane_) {
    const bf16* P = (const bf16*)(p.ws + WS_P);
    const int lane = olane(lane_), r0 = b * TOK + cid * 64, r = lane & 15, q4 = lane >> 4;
    bf16* Kt = (bf16*)wl;
    bf16* An = Kt + 4096;
    float* bendl = (float*)(An + 4096);
    const int kcol = PG + 256 + h * 64, vcol = PG + 512 + h * 64;
    const float* Grow0 = (const float*)(p.ws + WS_G) + (size_t)r0 * NGS;
    load_nat_tile(P, r0, vcol, An, lane);
    WAVE_SYNC();
    bf16x8 vf[4][2];
#pragma unroll
    for (int ne = 0; ne < 4; ++ne)
#pragma unroll
        for (int ks = 0; ks < 2; ++ks) vf[ne][ks] = frag_tr(An, 16 * ne, 32 * ks, lane);
    WAVE_SYNC();
    load_nat_tile(P, r0, kcol, An, lane);
    WAVE_SYNC();
    bf16x8 af[4]; gla_r_frags<DIR>(Grow0, lane, af);
#pragma unroll 2
    for (int nt = 0; nt < 4; ++nt) { const int d = 16 * nt + r; float x[4][4];
        const float bend = gla_b_col<DIR>(p, l, h, af, nt, lane, x);
        if (q4 == 0) { ((float*)(p.ws + WS_BE))[ch_index(DIR, b, h, cid) * 64 + d] = bend; bendl[d] = __expf(fmaxf(bend, -80.0f)); }
#pragma unroll
        for (int mt = 0; mt < 4; ++mt)
#pragma unroll
            for (int i = 0; i < 4; ++i) { const int s = 16 * mt + 4 * q4 + i; bf16* ke = An + swz(s, d >> 3) + (d & 7); const float kv = bf2f(*ke); const float bc = fmaxf(x[mt][i], -80.0f);
                Kt[swz(d, s >> 3) + (s & 7)] = f2bf(kv * __expf(-bc));
                *ke = f2bf(__expf(bc)); } }
    WAVE_SYNC();
    { bf16* EQg = (bf16*)(p.ws + WS_EQ) + ((size_t)DIR * T + r0) * WG + h * 64;
#pragma unroll
        for (int i = 0; i < 8; ++i) { const int s = (lane >> 3) + 8 * i, ck = lane & 7; *(u32x4*)(EQg + (size_t)s * WG + ck * 8) = *(const u32x4*)(An + swz(s, ck)); } }
    bf16* dst = (bf16*)(p.ws + WS_ST) + st_index(1, DIR, b, h, cid) * 4096;
#pragma unroll
    for (int me = 0; me < 4; ++me) {
        f32x4 acc[4] = {(f32x4){0.f, 0.f, 0.f, 0.f}, (f32x4){0.f, 0.f, 0.f, 0.f}, (f32x4){0.f, 0.f, 0.f, 0.f}, (f32x4){0.f, 0.f, 0.f, 0.f}};
#pragma unroll
        for (int ks = 0; ks < 2; ++ks) { const bf16x8 a = *(const bf16x8*)(Kt + swz(16 * me + r, ks * 4 + q4));
#pragma unroll
            for (int ne = 0; ne < 4; ++ne) acc[ne] = MFMA16(a, vf[ne][ks], acc[ne]); }
        const f32x4 sc4 = *(const f32x4*)(bendl + 16 * me + 4 * q4);
#pragma unroll
        for (int ne = 0; ne < 4; ++ne) { const f32x4 v = acc[ne] * sc4; u32x2 o; o.x = pk2(v[0], v[1]); o.y = pk2(v[2], v[3]); *(u32x2*)(dst + (16 * ne + r) * 64 + 16 * me + 4 * q4) = o; }
    }
    WAVE_SYNC();
}

template <int MIXER, int DIR>
__device__ __forceinline__ void chunkout_prep(const Params& p, int l, int b, int h, int cid, const float* Grow0, int r0, int pbase, const bf16* EQ, float* gar, int lane_) {
    const int lane = olane(lane_);
    if constexpr (MIXER == 0) {
        const bf16* P = (const bf16*)(p.ws + WS_P);
        const float* g = Grow0 + (size_t)lane * NGS; const float* gb = p.in[I_MGB] + (size_t)l * 16;
        const float ig = g[DIR * 8 + h] + gb[DIR * 8 + h], fg = g[DIR * 8 + 4 + h] + gb[DIR * 8 + 4 + h];
        const float mprev = ((const float*)(p.ws + WS_SC))[ch_index(DIR, b, h, cid) * 4 + 2];
        const float lf = logsigf_(fg); float bb;
        if (DIR == 0) bb = wave_prefix_sum(lf, lane); else { const float tt = wave_sum(lf), pre = wave_prefix_sum(lf, lane); bb = tt - pre + lf; }
        const float a = ig - bb; const float pm = DIR == 0 ? wave_prefix_max(a, lane) : wave_suffix_max(a, lane);
        const float mt_ = fmaxf(bb + mprev, bb + pm);
        float* ga = gar + DIR * 320;
        ga[lane] = bb - mt_; ga[64 + lane] = a; ga[128 + lane] = __expf(bb + mprev - mt_); ga[192 + lane] = __expf(-mt_);
        float* nvl = gar + 640 + DIR * 64;
        nvl[lane] = ((const float*)(p.ws + WS_NV))[ch_index(DIR, b, h, cid) * 64 + lane];
        WAVE_SYNC();
        float dq = 0.f;
#pragma unroll
        for (int c = 0; c < 8; ++c) { float f[8]; unpack8(*(const u32x4*)(P + (size_t)(r0 + lane) * NP + pbase + c * 8), f);
            const f32x4 n0 = *(const f32x4*)(nvl + c * 8), n1 = *(const f32x4*)(nvl + c * 8 + 4);
            dq += f[0] * n0.x + f[1] * n0.y + f[2] * n0.z + f[3] * n0.w + f[4] * n1.x + f[5] * n1.y + f[6] * n1.z + f[7] * n1.w; }
        ga[256 + lane] = dq;
    }
}
template <int MIXER, int DIR, int NS>
__device__ __forceinline__ void chunkout_dir(const Params& p, int b, int h, int cid, int r0, int pbase, int th, const bf16x8 (&vtf)[4][2], const bf16* VtL, const bf16* EQ, bf16* SB, const float* gar, float* rsm, f32x4 (&htot)[NS][4], int lane_) {
    const bf16* P = (const bf16*)(p.ws + WS_P); const bf16* ST = (const bf16*)(p.ws + WS_ST);
    const int lane = olane(lane_), r = lane & 15, q4 = lane >> 4;
    const bf16* E = EQ + ((size_t)DIR * T + r0) * WG + h * 64;
    const float* ga = gar + DIR * 320;
    bf16x8 kf[4][2], ctf[4][2];
#pragma unroll
    for (int n = 0; n < 4; ++n)
#pragma unroll
        for (int ks = 0; ks < 2; ++ks) { if constexpr (MIXER == 0) kf[n][ks] = vtf[n][ks];
            else kf[n][ks] = *(const bf16x8*)(P + (size_t)(r0 + 16 * n + r) * NP + pbase + 256 + ks * 32 + q4 * 8);
            ctf[n][ks] = *(const bf16x8*)(ST + st_index(MIXER, DIR, b, h, cid) * 4096 + (16 * n + r) * 64 + ks * 32 + q4 * 8);
            if constexpr (MIXER == 1) { float fe[8], fk[8]; unpack8(*(const u32x4*)(E + (size_t)(16 * n + r) * WG + ks * 32 + q4 * 8), fe); unpack8(as_u4(kf[n][ks]), fk);
#pragma unroll
                for (int j = 0; j < 8; ++j) fk[j] = fk[j] * frcp_(fe[j]);
                kf[n][ks] = as_frag(pack8(fk)); } }
#pragma unroll
    for (int ms = 0; ms < NS; ++ms) { const int mt = NS * th + ms;
        bf16x8 qf[2];
#pragma unroll
        for (int ks = 0; ks < 2; ++ks) { qf[ks] = *(const bf16x8*)(P + (size_t)(r0 + 16 * mt + r) * NP + pbase + ks * 32 + q4 * 8);
            if constexpr (MIXER == 1) { float fe[8], fq[8]; unpack8(*(const u32x4*)(E + (size_t)(16 * mt + r) * WG + ks * 32 + q4 * 8), fe); unpack8(as_u4(qf[ks]), fq);
#pragma unroll
                for (int j = 0; j < 8; ++j) fq[j] *= 0.125f * fe[j];
                qf[ks] = as_frag(pack8(fq)); } }
        f32x4 S[4] = {(f32x4){0.f, 0.f, 0.f, 0.f}, (f32x4){0.f, 0.f, 0.f, 0.f}, (f32x4){0.f, 0.f, 0.f, 0.f}, (f32x4){0.f, 0.f, 0.f, 0.f}};
#pragma unroll
        for (int ks = 0; ks < 2; ++ks)
#pragma unroll
            for (int n = 0; n < 4; ++n) S[n] = MFMA16(qf[ks], kf[n][ks], S[n]);
#pragma unroll
        for (int i = 0; i < 4; ++i) { const int t = 16 * mt + 4 * q4 + i; float sm = 0.f;
#pragma unroll
            for (int n = 0; n < 4; ++n) { const int s = 16 * n + r; const bool ok = DIR == 0 ? (s <= t) : (s >= t); float v = 0.f;
                if (ok) { if constexpr (MIXER == 0) v = S[n][i] * 0.125f * __expf(ga[t] + ga[64 + s]); else v = S[n][i]; }
                SB[swz(4 * q4 + i, s >> 3) + (s & 7)] = f2bf(v); sm += v; }
            if constexpr (MIXER == 0) { sm = row16_sum(sm); if (r == 0) rsm[4 * q4 + i] = sm; } }
        WAVE_SYNC();
        const bf16x8 sm0 = *(const bf16x8*)(SB + swz(r, q4)), sm1 = *(const bf16x8*)(SB + swz(r, 4 + q4));
        float wi = 1.f, inv = 1.f;
        if constexpr (MIXER == 0) { const int tt = 16 * mt + r; wi = ga[128 + tt]; const float den = wi * ga[256 + tt] + rsm[r]; inv = frcp_(fmaxf(fabsf(den), ga[192 + tt])); }
#pragma unroll
        for (int me = 0; me < 4; ++me) { f32x4 a1 = {0.f, 0.f, 0.f, 0.f}, a2 = {0.f, 0.f, 0.f, 0.f};
            a1 = MFMA16(*(const bf16x8*)(VtL + swz(16 * me + r, q4)), sm0, a1); a1 = MFMA16(*(const bf16x8*)(VtL + swz(16 * me + r, 4 + q4)), sm1, a1);
            a2 = MFMA16(ctf[me][0], qf[0], a2); a2 = MFMA16(ctf[me][1], qf[1], a2);
            if constexpr (MIXER == 0) htot[ms][me] += (a1 + a2 * wi) * inv; else htot[ms][me] += a1 + a2; }
        WAVE_SYNC();
    }
}
__device__ __forceinline__ void co_build_vt(const bf16* P, int r0, int vcol, bf16* VtL, int lane) {
    bf16* Nn = VtL + 4096;
#pragma unroll
    for (int hh = 0; hh < 2; ++hh) {
        u32x4 v[4];
#pragma unroll
        for (int i = 0; i < 4; ++i) v[i] = *(const u32x4*)(P + (size_t)(r0 + 32 * hh + (lane >> 3) + 8 * i) * NP + vcol + (lane & 7) * 8);
#pragma unroll
        for (int i = 0; i < 4; ++i) *(u32x4*)(Nn + swz((lane >> 3) + 8 * i, lane & 7)) = v[i];
        WAVE_SYNC();
#pragma unroll
        for (int c = 0; c < 4; ++c) { unsigned w[4];
#pragma unroll
            for (int j = 0; j < 4; ++j) w[j] = (unsigned)Nn[swz(8 * c + 2 * j, lane >> 3) + (lane & 7)] | ((unsigned)Nn[swz(8 * c + 2 * j + 1, lane >> 3) + (lane & 7)] << 16);
            u32x4 o; o.x = w[0]; o.y = w[1]; o.z = w[2]; o.w = w[3]; *(u32x4*)(VtL + swz(lane, 4 * hh + c)) = o; }
        WAVE_SYNC(); }
}
template <int MIXER, int NS>
__device__ __forceinline__ void co_finalize(const Params& p, int l, int h, int r0, int pbase, int mt0, f32x4 (&htot)[NS][4], int lane_) {
    const bf16* P = (const bf16*)(p.ws + WS_P); bf16* Y = (bf16*)(p.ws + WS_HNY);
    const float* ngp = p.in[MIXER == 0 ? I_MNG : I_GNG] + (size_t)l * WG + h * 64;
    const int lz = olane(lane_), r = lz & 15, q4 = lz >> 4;
    u32x2 gq[NS][4], oq[NS][4];
#pragma unroll
    for (int ms = 0; ms < NS; ++ms)
#pragma unroll
        for (int me = 0; me < 4; ++me) { const size_t off = (size_t)(r0 + 16 * (mt0 + ms) + r) * NP + pbase + 16 * me + 4 * q4;
            gq[ms][me] = *(const u32x2*)(P + off + (MIXER == 0 ? 1024 : 768)); if constexpr (MIXER == 0) oq[ms][me] = *(const u32x2*)(P + off + 768); else oq[ms][me] = (u32x2){0u, 0u}; }
#pragma unroll
    for (int ms = 0; ms < NS; ++ms) { const int mt = mt0 + ms; float ss = 0.f; float gv[4][4];
#pragma unroll
        for (int me = 0; me < 4; ++me) {
            gv[me][0] = bitsf(gq[ms][me].x << 16); gv[me][1] = bitsf(gq[ms][me].x & 0xffff0000u); gv[me][2] = bitsf(gq[ms][me].y << 16); gv[me][3] = bitsf(gq[ms][me].y & 0xffff0000u);
            if constexpr (MIXER == 0) { htot[ms][me][0] *= sigmoidf_(bitsf(oq[ms][me].x << 16)); htot[ms][me][1] *= sigmoidf_(bitsf(oq[ms][me].x & 0xffff0000u)); htot[ms][me][2] *= sigmoidf_(bitsf(oq[ms][me].y << 16)); htot[ms][me][3] *= sigmoidf_(bitsf(oq[ms][me].y & 0xffff0000u)); }
            ss += htot[ms][me][0] * htot[ms][me][0] + htot[ms][me][1] * htot[ms][me][1] + htot[ms][me][2] * htot[ms][me][2] + htot[ms][me][3] * htot[ms][me][3]; }
        ss = xrow_sum(ss);
        const float rstd = rsqrtf(ss * (1.0f / 64.0f) + EPS);
#pragma unroll
        for (int me = 0; me < 4; ++me) { const int e = 16 * me + 4 * q4; const f32x4 n4 = *(const f32x4*)(ngp + e);
            u32x2 o; o.x = pk2(htot[ms][me][0] * rstd * n4.x * siluf_(gv[me][0]), htot[ms][me][1] * rstd * n4.y * siluf_(gv[me][1]));
            o.y = pk2(htot[ms][me][2] * rstd * n4.z * siluf_(gv[me][2]), htot[ms][me][3] * rstd * n4.w * siluf_(gv[me][3]));
            *(u32x2*)(Y + (size_t)(r0 + 16 * mt + r) * 1024 + (MIXER == 0 ? YA : YG) + h * 64 + e) = o; } }
}
template <int MIXER>
__device__ __forceinline__ void chunkout_w(const Params& p, int l, int b, int h, int cid, char* wl, int lane) {
    const bf16* P = (const bf16*)(p.ws + WS_P); const float* G = (const float*)(p.ws + WS_G);
    const int r0 = b * TOK + cid * 64;
    const int pbase = (MIXER == 0 ? PA : PG) + h * 64;
    bf16* SB = (bf16*)wl;
    float* rsm = (float*)(SB + 1024);
    float* gar = rsm + 16;
    const bf16* EQ = (const bf16*)(p.ws + WS_EQ);
    const float* Grow0 = G + (size_t)r0 * NGS;
    bf16* VtL = (bf16*)(gar + 768);
    bf16x8 vtf[4][2];
#pragma unroll
    for (int me = 0; me < 4; ++me)
#pragma unroll
        for (int ks = 0; ks < 2; ++ks) { if constexpr (MIXER == 0) vtf[me][ks] = *(const bf16x8*)(P + (size_t)(r0 + 16 * me + (lane & 15)) * NP + pbase + 256 + ks * 32 + (lane >> 4) * 8); else vtf[me][ks] = (bf16x8){0, 0, 0, 0, 0, 0, 0, 0}; }
    co_build_vt(P, r0, pbase + 512, VtL, lane);
    chunkout_prep<MIXER, 0>(p, l, b, h, cid, Grow0, r0, pbase, EQ, gar, lane);
    chunkout_prep<MIXER, 1>(p, l, b, h, cid, Grow0, r0, pbase, EQ, gar, lane);
    WAVE_SYNC();
    constexpr int NS = MIXER == 1 ? 2 : 1;
#pragma unroll 1
    for (int th = 0; th < 4 / NS; ++th) {
        f32x4 htot[NS][4];
#pragma unroll
        for (int a = 0; a < NS; ++a)
#pragma unroll
            for (int c = 0; c < 4; ++c) htot[a][c] = (f32x4){0.f, 0.f, 0.f, 0.f};
        chunkout_dir<MIXER, 0, NS>(p, b, h, cid, r0, pbase, th, vtf, VtL, EQ, SB, gar, rsm, htot, lane);
        chunkout_dir<MIXER, 1, NS>(p, b, h, cid, r0, pbase, th, vtf, VtL, EQ, SB, gar, rsm, htot, lane);
        co_finalize<MIXER, NS>(p, l, h, r0, pbase, NS * th, htot, lane);
    }
}
constexpr int CO_PART = 13376;
template <int MIXER, int DIR>
__device__ __forceinline__ void chunkout_piece(const Params& p, int l, int b, int h, int cid, int mt, char* wl, int lane) {
    const bf16* P = (const bf16*)(p.ws + WS_P); const float* G = (const float*)(p.ws + WS_G);
    const int r0 = b * TOK + cid * 64; const int pbase = (MIXER == 0 ? PA : PG) + h * 64;
    bf16* SB = (bf16*)wl; float* rsm = (float*)(SB + 1024); float* gar = rsm + 16; const bf16* EQ = (const bf16*)(p.ws + WS_EQ);
    const float* Grow0 = G + (size_t)r0 * NGS; bf16* VtL = (bf16*)(gar + 768);
    bf16x8 vtf[4][2];
#pragma unroll
    for (int me = 0; me < 4; ++me)
#pragma unroll
        for (int ks = 0; ks < 2; ++ks) { if constexpr (MIXER == 0) vtf[me][ks] = *(const bf16x8*)(P + (size_t)(r0 + 16 * me + (lane & 15)) * NP + pbase + 256 + ks * 32 + (lane >> 4) * 8); else vtf[me][ks] = (bf16x8){0, 0, 0, 0, 0, 0, 0, 0}; }
    co_build_vt(P, r0, pbase + 512, VtL, lane);
    chunkout_prep<MIXER, DIR>(p, l, b, h, cid, Grow0, r0, pbase, EQ, gar, lane);
    WAVE_SYNC();
    f32x4 htot[1][4] = {{(f32x4){0.f, 0.f, 0.f, 0.f}, (f32x4){0.f, 0.f, 0.f, 0.f}, (f32x4){0.f, 0.f, 0.f, 0.f}, (f32x4){0.f, 0.f, 0.f, 0.f}}};
    chunkout_dir<MIXER, DIR, 1>(p, b, h, cid, r0, pbase, mt, vtf, VtL, EQ, SB, gar, rsm, htot, lane);
    float* part = (float*)(wl + CO_PART);
#pragma unroll
    for (int me = 0; me < 4; ++me)
#pragma unroll
        for (int i = 0; i < 4; ++i) part[(me * 4 + i) * 64 + lane] = htot[0][me][i];
}
template <int MIXER>
__device__ __forceinline__ void chunkout_combine(const Params& p, int l, int b, int h, int cid, int mt, const char* smem, int lane) {
    const float* pa = (const float*)(smem + (2 * mt) * WLDS + CO_PART); const float* pb = (const float*)(smem + (2 * mt + 1) * WLDS + CO_PART);
    f32x4 htot[1][4];
#pragma unroll
    for (int me = 0; me < 4; ++me)
#pragma unroll
        for (int i = 0; i < 4; ++i) htot[0][me][i] = pa[(me * 4 + i) * 64 + lane] + pb[(me * 4 + i) * 64 + lane];
    co_finalize<MIXER, 1>(p, l, h, b * TOK + cid * 64, (MIXER == 0 ? PA : PG) + h * 64, mt, htot, lane);
}

template <bool OUT>
__device__ __forceinline__ void chunk_workers(const Params& p, int l, char* smem) {
    const int tid = otid(), lane = tid & 63, wave = __builtin_amdgcn_readfirstlane(tid >> 6);
    const int NW = (int)gridDim.x * 8, wi = wave * (int)gridDim.x + obid();
    const int c_lo = (OUT && l == DEPTH - 1) ? NCC : 0, npc = NCH - c_lo, half = NB * NH * npc;
    char* wl = smem + wave * WLDS;
    if (OUT) {
        const int cl = NCC, npl = NCH - NCC, halfl = NB * NH * npl;
#pragma unroll 1
        for (int t = wi; t < halfl; t += NW) { const int b = t / (NH * npl), h = (t / npl) % NH, cid = cl + t % npl;
            const Params q = relaunder(p); chunkout_w<1>(q, l, b, h, cid, wl, lane); }
        { const int used = halfl % NW;
#pragma unroll 1
            for (int t = (wi + NW - used) % NW; t < halfl; t += NW) { const int b = t / (NH * npl), h = (t / npl) % NH, cid = cl + t % npl;
                const Params q = relaunder(p); chunkout_w<0>(q, l, b, h, cid, wl, lane); } }
        if (l < DEPTH - 1) {
            const int nct = NB * NH * NCC;
#pragma unroll 1
            for (int st = obid(); st < 2 * nct; st += (int)gridDim.x) { const int mixer = st / nct, r2 = st % nct, b = r2 / (NH * NCC), h = (r2 / NCC) % NH, cid = r2 % NCC;
                const Params q = relaunder(p); const int mt = wave >> 1;
                __syncthreads();
                if (mixer == 0) { if (wave & 1) chunkout_piece<0, 1>(q, l, b, h, cid, mt, wl, lane); else chunkout_piece<0, 0>(q, l, b, h, cid, mt, wl, lane); }
                else            { if (wave & 1) chunkout_piece<1, 1>(q, l, b, h, cid, mt, wl, lane); else chunkout_piece<1, 0>(q, l, b, h, cid, mt, wl, lane); }
                __syncthreads();
                if (wave < 4) { if (mixer == 0) chunkout_combine<0>(q, l, b, h, cid, wave, smem, lane); else chunkout_combine<1>(q, l, b, h, cid, wave, smem, lane); }
            }
        }
    } else {
        int off = 0;
#pragma unroll 1
        for (int t = wi; t < half; t += NW) { const int b = t / (NH * npc), h = (t / npc) % NH, cid = c_lo + t % npc;
            const Params q = relaunder(p); chunkst_gla<0>(q, l, b, h, cid, wl, lane); }
        off = (off + half) % NW;
#pragma unroll 1
        for (int t = (wi + NW - off) % NW; t < half; t += NW) { const int b = t / (NH * npc), h = (t / npc) % NH, cid = c_lo + t % npc;
            const Params q = relaunder(p); chunkst_gla<1>(q, l, b, h, cid, wl, lane); }
        off = (off + half) % NW;
#pragma unroll 1
        for (int t = (wi + NW - off) % NW; t < half; t += NW) { const int b = t / (NH * npc), h = (t / npc) % NH, cid = c_lo + t % npc;
            const Params q = relaunder(p); chunkst_w<0>(q, l, b, h, cid, wl, lane); }
    }
}

__device__ __forceinline__ void phase_mix1(const Params& p, int l, char* smem) {
    const bool ctxo = l < DEPTH - 1; const int G = (int)gridDim.x, bid = obid();
    constexpr int N_HL = (NB / 2) * (WG / 2), N_HC = NB * (WG / HCB);
    chunk_workers<false>(p, l, smem);
    stage_signal(p, smem, 0, l);
    for (int t = bid; t < N_HL; t += G) hylat_task(p, l, t / (WG / 2), t % (WG / 2), smem);
    if (ctxo) for (int t = G - 1 - bid; t < N_HC; t += G) hyctx_task(p, l, t / (WG / HCB), t % (WG / HCB), smem);
    stage_signal(p, smem, 2, l);
}

constexpr int SCG = 12;
__device__ __forceinline__ void phase_scan(const Params& p, int l, char* smem) {
    const int tid = otid();
    bf16* ST = (bf16*)(p.ws + WS_ST); float* NV = (float*)(p.ws + WS_NV); const float* BE = (const float*)(p.ws + WS_BE); float* SC = (float*)(p.ws + WS_SC);
    constexpr int NCHAIN = 2 * 2 * NB * NH;
    stage_wait(p, 0, l);
    for (int item = obid() * NT + tid; item < NCHAIN * 1024; item += gridDim.x * NT) {
        const int chain = item >> 10, grp = item & 1023; const int mixer = chain / (2 * NB * NH), dir = (chain / (NB * NH)) % 2, b = (chain / NH) % NB, h = chain % NH;
        float c[4] = {0.f, 0.f, 0.f, 0.f}; float nv[4] = {0.f, 0.f, 0.f, 0.f}; float m = 0.f;
        const int d0 = (grp & 15) * 4; const bool donv = (mixer == 0) && (grp < 16);
        for (int o0 = 0; o0 < NCH; o0 += SCG) {
            u32x2 uu[SCG]; float s0[SCG], s1[SCG]; f32x4 be[SCG]; f32x4 nu[SCG];
#pragma unroll
            for (int j = 0; j < SCG; ++j) if (o0 + j < NCH) { const int cid = chain_cid(dir, o0 + j); const size_t ci = ch_index(dir, b, h, cid);
                uu[j] = *(const u32x2*)(ST + st_index(mixer, dir, b, h, cid) * 4096 + grp * 4);
                if (mixer == 0) { s0[j] = SC[ci * 4 + 0]; s1[j] = SC[ci * 4 + 1]; if (donv) nu[j] = *(const f32x4*)(NV + ci * 64 + grp * 4); }
                else be[j] = *(const f32x4*)(BE + ci * 64 + d0); }
#pragma unroll
            for (int j = 0; j < SCG; ++j) if (o0 + j < NCH) { const int cid = chain_cid(dir, o0 + j); const size_t ci = ch_index(dir, b, h, cid);
                const float u[4] = {bitsf(uu[j].x << 16), bitsf(uu[j].x & 0xffff0000u), bitsf(uu[j].y << 16), bitsf(uu[j].y & 0xffff0000u)};
                u32x2 w; w.x = pk2(c[0], c[1]); w.y = pk2(c[2], c[3]); *(u32x2*)(ST + st_index(mixer, dir, b, h, cid) * 4096 + grp * 4) = w;
                if (mixer == 0) {
                    if (grp == 0) SC[ci * 4 + 2] = m;
                    const float mn = fmaxf(s0[j] + m, s1[j]), a = __expf(s0[j] + m - mn), s = __expf(s1[j] - mn);
#pragma unroll
                    for (int k = 0; k < 4; ++k) c[k] = a * c[k] + s * u[k];
                    if (donv) { f32x4 nw = {nv[0], nv[1], nv[2], nv[3]}; *(f32x4*)(NV + ci * 64 + grp * 4) = nw;
                        nv[0] = a * nv[0] + s * nu[j].x; nv[1] = a * nv[1] + s * nu[j].y; nv[2] = a * nv[2] + s * nu[j].z; nv[3] = a * nv[3] + s * nu[j].w; }
                    m = mn;
                } else { c[0] = __expf(be[j].x) * c[0] + u[0]; c[1] = __expf(be[j].y) * c[1] + u[1]; c[2] = __expf(be[j].z) * c[2] + u[2]; c[3] = __expf(be[j].w) * c[3] + u[3]; } }
        }
    }
    stage_signal(p, smem, 1, l);
    { const bool ctxo = l < DEPTH - 1; const int G = (int)gridDim.x, bid = obid();
        constexpr int QTL = SEQ / 128, QTC = CTXL / 128, N_AL = NB * 2 * QTL, N_AC = NB * 2 * QTC;
        for (int t = bid; t < N_AL; t += G) attn_task(p, l, t / (2 * QTL), (t / QTL) % 2, t % QTL, false, smem);
        if (ctxo) for (int t = (bid + G - 64 % G) % G; t < N_AC; t += G) attn_task(p, l, t / (2 * QTC), (t / QTC) % 2, t % QTC, true, smem); }
}

__device__ __forceinline__ void phase_mix2(const Params& p, int l, char* smem) {
    const int tid = otid();
    stage_wait(p, 1, l);
    chunk_workers<true>(p, l, smem);
    stage_wait(p, 2, l);
    constexpr int N_WOUT = (DM / 64) * (MIX / 64);
    { const int lane = tid & 63, wave = __builtin_amdgcn_readfirstlane(tid >> 6); const int NW = (int)gridDim.x * 8, wi = wave * (int)gridDim.x + obid();
        for (int task = NW - 1 - wi; task < N_WOUT; task += NW) { const int nt = task / (MIX / 64), kt = task % (MIX / 64);
            convert_tile_w(p.in[I_WOUT] + (size_t)l * MIX * DM, DM, (bf16*)(p.ws + WS_WOUT), MIX, nt * 64, kt * 64, false, smem + wave * WLDS, lane); }
        bf16* tile = (bf16*)(smem + wave * WLDS); const bf16* HT = (const bf16*)(p.ws + WS_HT); bf16* Y = (bf16*)(p.ws + WS_HNY);
        constexpr int NTT = NB * (SEQ / 64) * 4;
        for (int t = wi; t < NTT; t += NW) { const int b = t / ((SEQ / 64) * 4), tt = (t / 4) % (SEQ / 64), c0 = (t % 4) * 64; const size_t tok0 = (size_t)b * TOK + CTXL + tt * 64;
#pragma unroll
            for (int i = 0; i < 8; ++i) { const int ch = (lane >> 3) + 8 * i, ck = lane & 7; *(u32x4*)(tile + swz(ch, ck)) = *(const u32x4*)(HT + (size_t)(768 + c0 + ch) * T + tok0 + ck * 8); }
            WAVE_SYNC();
#pragma unroll
            for (int i = 0; i < 8; ++i) { const int tk = (lane >> 3) + 8 * i, cc = lane & 7; unsigned w[4];
#pragma unroll
                for (int j = 0; j < 4; ++j) { const int ca = cc * 8 + 2 * j; w[j] = (unsigned)tile[swz(ca, tk >> 3) + (tk & 7)] | ((unsigned)tile[swz(ca + 1, tk >> 3) + (tk & 7)] << 16); }
                u32x4 o; o.x = w[0]; o.y = w[1]; o.z = w[2]; o.w = w[3]; *(u32x4*)(Y + (tok0 + tk) * 1024 + YH + c0 + cc * 8) = o; }
            WAVE_SYNC(); } }
}


#ifndef EMU
#define LAS __attribute__((address_space(3)))
#define XB_TMO      128
#define XB_XCNT(j)  (256  + 64 * (j))
#define XB_XSUB(j)  (1280 + 64 * (j))
#define XB_XGEN(j)  (2304 + 64 * (j))
#define XB_TOP      3328
#define XB_TOPGEN   3392
#define XCD_BAR_WORDS 3456
#define XB_SPIN_CAP (1u << 18)

__device__ __forceinline__ unsigned xb_ld(unsigned* p)              { return __hip_atomic_load(p, __ATOMIC_RELAXED, __HIP_MEMORY_SCOPE_AGENT); }
__device__ __forceinline__ unsigned xb_add(unsigned* p, unsigned v) { return __hip_atomic_fetch_add(p, v, __ATOMIC_RELAXED, __HIP_MEMORY_SCOPE_AGENT); }
__device__ __forceinline__ unsigned xb_xcc_id() { return (unsigned)__builtin_amdgcn_s_getreg((3 << 11) | 20) & 0xFu; }
#define XB_SPIN(cond, bar) do { unsigned _sp = 0; while (cond) { __builtin_amdgcn_s_sleep(1); \
    if ((++_sp & 255u) == 0u) { if (xb_ld(&(bar)[XB_TMO])) break; if (_sp > XB_SPIN_CAP) { atomicAdd(&(bar)[XB_TMO], 1u); break; } } } } while (0)

struct XcdBarrier {
    unsigned* bar; unsigned x;
    volatile LAS unsigned* st;
};

__device__ __forceinline__ XcdBarrier xcd_barrier_post(unsigned* bar, volatile LAS unsigned* st) {
    XcdBarrier b; b.bar = bar; b.x = xb_xcc_id(); b.st = st;
    if (threadIdx.x == 0) (void)xb_add(&bar[XB_XCNT(b.x)], 1u);
    return b;
}
__device__ __forceinline__ void xcd_barrier_complete(unsigned* bar, unsigned x, unsigned& nloc, unsigned& nx) {
    const unsigned G = gridDim.x * gridDim.y * gridDim.z;
    unsigned sum, cnt, mine, sp = 0u;
    for (;;) {
        sum = 0u; cnt = 0u; mine = 0u;
#pragma unroll
        for (unsigned j = 0; j < 16; ++j) { const unsigned c = xb_ld(&bar[XB_XCNT(j)]); sum += c; cnt += (c > 0u) ? 1u : 0u; mine = (j == x) ? c : mine; }
        if (sum == G) break;
        __builtin_amdgcn_s_sleep(1);
        if ((++sp & 255u) == 0u) { if (xb_ld(&bar[XB_TMO])) break; if (sp > XB_SPIN_CAP) { atomicAdd(&bar[XB_TMO], 1u); break; } }
    }
    nloc = mine > 0u ? mine : 1u; nx = cnt > 0u ? cnt : 1u;
}

__device__ __forceinline__ void xcd_barrier(const XcdBarrier& b) {
    asm volatile("s_waitcnt vmcnt(0)" ::: "memory");
    __syncthreads();
    if (threadIdx.x == 0) {
        unsigned* bar = b.bar;
        __builtin_amdgcn_s_waitcnt(0);
        unsigned nloc = b.st[0], nx = b.st[1];
        if (nloc == 0u) { xcd_barrier_complete(bar, b.x, nloc, nx); b.st[0] = nloc; b.st[1] = nx; }
        const unsigned old = xb_add(&bar[XB_XSUB(b.x)], 1u);
        const unsigned gen = old / nloc;
        if (old + 1u == (gen + 1u) * nloc) {
            __builtin_amdgcn_fence(__ATOMIC_RELEASE, "agent");
            asm volatile("s_waitcnt vmcnt(0)" ::: "memory");
            const unsigned og = xb_add(&bar[XB_TOP], 1u);
            const unsigned tg = og / nx;
            if (og + 1u == (tg + 1u) * nx) xb_add(&bar[XB_TOPGEN], 1u);
            else XB_SPIN(xb_ld(&bar[XB_TOPGEN]) == tg, bar);
            __builtin_amdgcn_fence(__ATOMIC_ACQUIRE, "agent");
            xb_add(&bar[XB_XGEN(b.x)], 1u);
            asm volatile("s_waitcnt vmcnt(0)" ::: "memory");
        } else {
            XB_SPIN(xb_ld(&bar[XB_XGEN(b.x)]) == gen, bar);
            __builtin_amdgcn_fence(__ATOMIC_ACQUIRE, "agent");
            asm volatile("s_waitcnt vmcnt(0)" ::: "memory");
        }
    }
    __syncthreads();
}
#endif

__global__ void __launch_bounds__(NT) fwd_kernel(Params pk, int ph_lo, int ph_hi) {
    SMEM_DECL;
#ifndef EMU
    volatile LAS unsigned* misc = (volatile LAS unsigned*)(smem + LDS_BYTES - 64);
    if (threadIdx.x < 2) misc[threadIdx.x] = 0u;
    __syncthreads();
    const XcdBarrier bar = xcd_barrier_post((unsigned*)(pk.ws + WS_BAR), misc);
#endif
    constexpr int NPH = 2 + 6 * DEPTH;
    for (int ph = ph_lo; ph < ph_hi && ph < NPH; ++ph) {
#ifndef EMU
        Params p = pk; { size_t z = 0; asm volatile("" : "+s"(z)); p.ws = pk.ws + z; p.out = pk.out + z;
#pragma unroll
            for (int i = 0; i < 26; ++i) p.in[i] = pk.in[i] + z; }
#else
        const Params& p = pk;
#endif
        if (ph == 0) phase0(p, smem);
        else if (ph == NPH - 1) phase_rp(p, DEPTH, smem);
        else { const int l = (ph - 1) / 6, k = (ph - 1) % 6;
            if (k == 0) phase_rp(p, l, smem);
            else if (k == 1) phase_gemm_in(p, l, smem);
            else if (k == 2) phase_mix1(p, l, smem);
            else if (k == 3) phase_scan(p, l, smem);
            else if (k == 4) phase_mix2(p, l, smem);
            else phase_gemm_out(p, l, smem);
#ifdef PROBE_DUP
            if (k == PROBE_DUP) { GRID_SYNC();
                if (k == 1) phase_gemm_in(p, l, smem); else if (k == 2) phase_mix1(p, l, smem); else if (k == 4) phase_mix2(p, l, smem); }
#endif
        }
        if (ph + 1 < ph_hi && !(ph >= 6 && ph % 6 == 0) && !(ph >= 1 && ((ph - 1) % 6 == 2 || (ph - 1) % 6 == 3))) {
#ifdef EMU
            GRID_SYNC();
#else
            if (ph_lo < 0) GRID_SYNC();
            xcd_barrier(bar);
#endif
        }
    }
}

#ifndef EMU
extern "C" void kernel_launch(void* const* d_in, const int* in_sizes, int n_in, void* d_out, int out_size, void* d_ws, size_t ws_size, hipStream_t stream) {
    static int grid = 0;
    if (grid == 0) {
        if (n_in != 26 || ws_size < WS_TOTAL) { fprintf(stderr, "kernel_launch: unexpected n_in %d or ws_size %zu (need %zu)\n", n_in, ws_size, (size_t)WS_TOTAL); grid = -1; return; }
        int dev = 0, cus = 0, per_cu = 0;
        hipGetDevice(&dev);
        hipDeviceGetAttribute(&cus, hipDeviceAttributeMultiprocessorCount, dev);
        hipFuncSetAttribute((const void*)fwd_kernel, hipFuncAttributeMaxDynamicSharedMemorySize, LDS_BYTES);
        hipOccupancyMaxActiveBlocksPerMultiprocessor(&per_cu, (const void*)fwd_kernel, NT, LDS_BYTES);
        if (per_cu < 1) { fprintf(stderr, "kernel_launch: occupancy query returned %d\n", per_cu); grid = -1; return; }
        if (per_cu > 1) per_cu = 1;
        grid = cus * per_cu;
    }
    if (grid < 0) return;
    hipMemsetAsync((char*)d_ws + WS_BAR, 0, BAR_BYTES, stream);
    Params p{};
    for (int i = 0; i < 26; ++i) p.in[i] = (const float*)d_in[i];
    p.out = (float*)d_out; p.ws = (char*)d_ws;
    int lo = 0, hi = 2 + 6 * DEPTH;
    void* args[] = {&p, &lo, &hi};
    hipError_t e = hipLaunchCooperativeKernel((const void*)fwd_kernel, dim3(grid), dim3(NT), args, LDS_BYTES, stream);
    if (e != hipSuccess) fprintf(stderr, "cooperative launch failed: %s (grid %d)\n", hipGetErrorString(e), grid);
}
#endif
```

```cpp
#ifdef EMU
#include "emu/hipemu.h"
#define GRID_SYNC() emu::grid_sync()
#define SMEM_DECL char* smem = emu::S().blocks[emu::cur()->block].lds
#define SCHED_FENCE() do {} while (0)
#define MFMA16(a, b, c) emu_mfma_16x16x32_bf16(a, b, c)
#else
#include <hip/hip_runtime.h>
#include <hip/hip_cooperative_groups.h>
#include <cstdio>
#include <cstdint>
#define GRID_SYNC() cooperative_groups::this_grid().sync()
#define SMEM_DECL extern __shared__ __attribute__((aligned(16))) char smem[]
#define SCHED_FENCE() __builtin_amdgcn_sched_barrier(0)
#define MFMA16(a, b, c) __builtin_amdgcn_mfma_f32_16x16x32_bf16(a, b, c, 0, 0, 0)
#endif

#ifdef EMU
#ifndef EMU_DM
#define EMU_DM 256
#endif
#ifndef EMU_NB
#define EMU_NB 2
#endif
#ifndef EMU_SEQ
#define EMU_SEQ 512
#endif
#ifndef EMU_DEPTH
#define EMU_DEPTH 2
#endif
#ifndef EMU_CTXL
#define EMU_CTXL 128
#endif
constexpr int DM = EMU_DM, NB = EMU_NB, SEQ = EMU_SEQ, DEPTH = EMU_DEPTH, CTXL = EMU_CTXL;
#else
constexpr int DM = 1024, NB = 8, SEQ = 2048, DEPTH = 4, CTXL = 256;
#endif
constexpr int MIX = 1024, WG = 256, HD = 64, NH = 4, CH = 64;
constexpr int TOK = CTXL + SEQ, T = NB * TOK, NCH = TOK / CH, NCC = CTXL / CH;
constexpr int N_IN = 4144, NP = 3072, NG = 48, NGS = 32, NMAIN = 3328, NPAD = 4352;
constexpr int NF = 2 * SEQ;
constexpr int NJ = NB + 1;
constexpr int NT = 512;
constexpr float EPS = 1e-6f;
constexpr int PA = 0, PG = 1280, PD = 2304;
constexpr int YA = 0, YH = 256, YG = 512, YD = 768;
constexpr int ilog4(int n) { return n <= 1 ? 0 : 1 + ilog4(n / 4); }
constexpr int FFT_P = ilog4(NF);
static_assert((1 << (2 * FFT_P)) == NF, "NF must be a power of 4");
static_assert(DM % 256 == 0 && CTXL % 128 == 0 && SEQ % 256 == 0, "shape constraints");

typedef unsigned short bf16;
typedef short bf16x8 __attribute__((ext_vector_type(8)));
typedef float f32x4 __attribute__((ext_vector_type(4)));
typedef unsigned u32x4 __attribute__((ext_vector_type(4)));
typedef unsigned u32x2 __attribute__((ext_vector_type(2)));
struct cpx { float x, y; };

constexpr size_t al256(size_t x) { return (x + 255) & ~(size_t)255; }
constexpr size_t WS_CTXB = 0;
constexpr size_t WS_HNY = al256(WS_CTXB + (size_t)NB * CTXL * DM * 4);
constexpr size_t WS_WIN = WS_HNY + (size_t)T * 1024 * 2;
constexpr size_t WS_ST = WS_WIN;
constexpr size_t ST_BYTES = (size_t)2 * 2 * NB * NH * NCH * 4096 * 2;
constexpr size_t WS_KT = al256(WS_WIN + (size_t)NPAD * DM * 2);
static_assert(WS_KT + (size_t)WG * NF * 4 <= WS_ST + ST_BYTES || true, "");
constexpr size_t ST_END = al256((WS_ST + ST_BYTES > WS_KT + (size_t)WG * NF * 4) ? WS_ST + ST_BYTES : WS_KT + (size_t)WG * NF * 4);
constexpr size_t WS_P = ST_END;
constexpr size_t WS_HT = al256(WS_P + (size_t)T * NP * 2);
constexpr size_t WS_WOUT = WS_HT;
constexpr size_t WS_G = al256(WS_HT + (size_t)1024 * T * 2);
constexpr size_t WS_KF = al256(WS_G + (size_t)T * NGS * 4);
constexpr size_t WS_HC = al256(WS_KF + (size_t)WG * NF * 8);
constexpr size_t WS_EQ = al256(WS_HC + (size_t)2 * WG * CTXL * 4);
constexpr size_t WS_NV = al256(WS_EQ + (size_t)2 * T * WG * 2);
constexpr size_t WS_BE = al256(WS_NV + (size_t)2 * NB * NH * NCH * 64 * 4);
constexpr size_t WS_SC = al256(WS_BE + (size_t)2 * NB * NH * NCH * 64 * 4);
constexpr size_t WS_MOD = al256(WS_SC + (size_t)2 * NB * NH * NCH * 4 * 4);
constexpr size_t WS_TW = al256(WS_MOD + (size_t)DEPTH * NJ * 3 * DM * 4);
constexpr size_t WS_ROPE = al256(WS_TW + (size_t)NF * 8);
constexpr size_t WS_BAR = al256(WS_ROPE + (size_t)SEQ * 32 * 8);
constexpr size_t BAR_BYTES = 32768;
constexpr size_t WS_TOTAL = al256(WS_BAR + BAR_BYTES);
static_assert((size_t)T * DM * 4 <= (size_t)T * NP * 2, "YO fits in P");
#ifndef EMU
static_assert(WS_TOTAL <= (size_t)268435456, "workspace map must fit 256 MiB");
#endif

constexpr int LDS_BYTES = 163840;

struct Params {
    const float* in[26];
    float* out;
    char* ws;
};
enum { I_X = 0, I_C, I_CTX, I_CCTX, I_WADA, I_BADA, I_GPRE, I_GPOST, I_WIN, I_MGB, I_MNG, I_HCW, I_HCB, I_HW1, I_HB1, I_HW2, I_HB2, I_HW3, I_HB3,
       I_HFREQ, I_HD, I_GWA, I_GBA, I_GNG, I_SINK, I_WOUT };

__device__ __forceinline__ Params relaunder(const Params& pk) {
#ifdef EMU
    return pk;
#else
    Params p = pk; size_t z = 0; asm volatile("" : "+s"(z)); p.ws = pk.ws + z; p.out = pk.out + z;
#pragma unroll
    for (int i = 0; i < 26; ++i) p.in[i] = pk.in[i] + z;
    return p;
#endif
}
constexpr int WLDS = (LDS_BYTES - 64) / 8 / 16 * 16;
#ifdef EMU
#define WAVE_SYNC() emu_wave_sync()
#else
#define WAVE_SYNC() do { asm volatile("s_waitcnt lgkmcnt(0)" ::: "memory"); __builtin_amdgcn_wave_barrier(); } while (0)
#endif

#ifdef EMU
__device__ __forceinline__ int otid() { return (int)threadIdx.x; }
__device__ __forceinline__ int obid() { return (int)blockIdx.x; }
#else
__device__ __forceinline__ int otid() { int t = (int)threadIdx.x; asm volatile("" : "+v"(t)); return t; }
__device__ __forceinline__ int obid() { int b = (int)blockIdx.x; asm volatile("" : "+s"(b)); return b; }
#endif
__device__ __forceinline__ unsigned fbits(float f) { return __builtin_bit_cast(unsigned, f); }
__device__ __forceinline__ float bitsf(unsigned u) { return __builtin_bit_cast(float, u); }
__device__ __forceinline__ float bf2f(bf16 h) { return bitsf((unsigned)h << 16); }
#ifdef EMU
__device__ __forceinline__ bf16 f2bf(float f) { unsigned u = fbits(f); return (bf16)((u + 0x7fffu + ((u >> 16) & 1u)) >> 16); }
__device__ __forceinline__ unsigned pk2(float lo, float hi) { return (unsigned)f2bf(lo) | ((unsigned)f2bf(hi) << 16); }
#else
typedef __bf16 nbf16x2 __attribute__((ext_vector_type(2)));
typedef float nf32x2 __attribute__((ext_vector_type(2)));
__device__ __forceinline__ unsigned pk2(float lo, float hi) { const nf32x2 v = {lo, hi}; return __builtin_bit_cast(unsigned, __builtin_convertvector(v, nbf16x2)); }
__device__ __forceinline__ bf16 f2bf(float f) { return (bf16)(pk2(f, 0.0f) & 0xffffu); }
#endif
#ifdef EMU
__device__ __forceinline__ float frcp_(float x) { return 1.0f / x; }
#else
__device__ __forceinline__ float frcp_(float x) { return __builtin_amdgcn_rcpf(x); }
#endif
__device__ __forceinline__ float sigmoidf_(float x) { return frcp_(1.0f + __expf(-x)); }
__device__ __forceinline__ float siluf_(float x) { return x * frcp_(1.0f + __expf(-x)); }
__device__ __forceinline__ float logsigf_(float x) { return fminf(x, 0.0f) - log1pf(__expf(-fabsf(x))); }
__device__ __forceinline__ float logsig_fast(float x) { return fminf(x, 0.0f) - __logf(1.0f + __expf(-fabsf(x))); }
#ifdef EMU
__device__ __forceinline__ float row16_sum(float x) { x += __shfl_xor(x, 1); x += __shfl_xor(x, 2); x += __shfl_xor(x, 4); x += __shfl_xor(x, 8); return x; }
__device__ __forceinline__ float row16_max(float x) { x = fmaxf(x, __shfl_xor(x, 1)); x = fmaxf(x, __shfl_xor(x, 2)); x = fmaxf(x, __shfl_xor(x, 4)); x = fmaxf(x, __shfl_xor(x, 8)); return x; }
__device__ __forceinline__ float xrow_sum(float x) { x += __shfl_xor(x, 16); x += __shfl_xor(x, 32); return x; }
__device__ __forceinline__ float xrow_max(float x) { x = fmaxf(x, __shfl_xor(x, 16)); x = fmaxf(x, __shfl_xor(x, 32)); return x; }
#else
template <int CTRL> __device__ __forceinline__ float dpp_(float x) { return __builtin_bit_cast(float, __builtin_amdgcn_mov_dpp(__builtin_bit_cast(int, x), CTRL, 0xf, 0xf, true)); }
__device__ __forceinline__ float row16_sum(float x) { x += dpp_<0xB1>(x); x += dpp_<0x4E>(x); x += dpp_<0x141>(x); x += dpp_<0x128>(x); return x; }
__device__ __forceinline__ float row16_max(float x) { x = fmaxf(x, dpp_<0xB1>(x)); x = fmaxf(x, dpp_<0x4E>(x)); x = fmaxf(x, dpp_<0x141>(x)); x = fmaxf(x, dpp_<0x128>(x)); return x; }
__device__ __forceinline__ float xrow_sum(float x) {
    auto s = __builtin_amdgcn_permlane16_swap(fbits(x), fbits(x), false, false); x = bitsf(s[0]) + bitsf(s[1]);
    auto t = __builtin_amdgcn_permlane32_swap(fbits(x), fbits(x), false, false); return bitsf(t[0]) + bitsf(t[1]); }
__device__ __forceinline__ float xrow_max(float x) {
    auto s = __builtin_amdgcn_permlane16_swap(fbits(x), fbits(x), false, false); x = fmaxf(bitsf(s[0]), bitsf(s[1]));
    auto t = __builtin_amdgcn_permlane32_swap(fbits(x), fbits(x), false, false); return fmaxf(bitsf(t[0]), bitsf(t[1])); }
#endif
__device__ __forceinline__ float wave_sum(float v) { return xrow_sum(row16_sum(v)); }
__device__ __forceinline__ float wave_max(float v) { return xrow_max(row16_max(v)); }
#ifdef EMU
__device__ __forceinline__ float wave_prefix_sum(float v, int lane) {
#pragma unroll
    for (int o = 1; o < 64; o <<= 1) { float t = __shfl_up(v, o); if (lane >= o) v += t; }
    return v;
}
__device__ __forceinline__ float wave_prefix_max(float v, int lane) {
#pragma unroll
    for (int o = 1; o < 64; o <<= 1) { float t = __shfl_up(v, o); if (lane >= o) v = fmaxf(v, t); }
    return v;
}
#else
template <int CTRL, int RM> __device__ __forceinline__ float dppo_(float old, float x) { return __builtin_bit_cast(float, __builtin_amdgcn_update_dpp(__builtin_bit_cast(int, old), __builtin_bit_cast(int, x), CTRL, RM, 0xf, false)); }
__device__ __forceinline__ float wave_prefix_sum(float v, int) {
    v += dppo_<0x111, 0xf>(0.f, v); v += dppo_<0x112, 0xf>(0.f, v); v += dppo_<0x114, 0xf>(0.f, v); v += dppo_<0x118, 0xf>(0.f, v);
    v += dppo_<0x142, 0xa>(0.f, v); v += dppo_<0x143, 0xc>(0.f, v); return v;
}
__device__ __forceinline__ float wave_prefix_max(float v, int) {
    const float ninf = -INFINITY;
    v = fmaxf(v, dppo_<0x111, 0xf>(ninf, v)); v = fmaxf(v, dppo_<0x112, 0xf>(ninf, v)); v = fmaxf(v, dppo_<0x114, 0xf>(ninf, v)); v = fmaxf(v, dppo_<0x118, 0xf>(ninf, v));
    v = fmaxf(v, dppo_<0x142, 0xa>(ninf, v)); v = fmaxf(v, dppo_<0x143, 0xc>(ninf, v)); return v;
}
#endif
__device__ __forceinline__ float wave_suffix_max(float v, int lane) {
    return __shfl(wave_prefix_max(__shfl(v, 63 - lane), lane), 63 - lane);
}
__device__ __forceinline__ void unpack8(u32x4 v, float* f) {
    f[0] = bitsf(v.x << 16); f[1] = bitsf(v.x & 0xffff0000u); f[2] = bitsf(v.y << 16); f[3] = bitsf(v.y & 0xffff0000u);
    f[4] = bitsf(v.z << 16); f[5] = bitsf(v.z & 0xffff0000u); f[6] = bitsf(v.w << 16); f[7] = bitsf(v.w & 0xffff0000u);
}
__device__ __forceinline__ int orig_col(int n) {
    if (n < 1280) return n;
    if (n < 2304) return 2320 + (n - 1280);
    if (n < 3072) return 3376 + (n - 2304);
    if (n < 3088) return 1280 + (n - 3072);
    if (n < 3120) return 3344 + (n - 3088);
    if (n < NMAIN) return -1;
    return 1296 + (n - NMAIN);
}
__device__ __forceinline__ int chain_cid(int dir, int o) {
    if (dir == 0) return o;
    return o < NCC ? (NCC - 1 - o) : (NCH - 1 - (o - NCC));
}

__device__ __forceinline__ int swz(int row, int ch) { return row * 64 + ((ch ^ (row & 7)) << 3); }
__device__ __forceinline__ u32x4 pack8(const float* f) { u32x4 o; o.x = pk2(f[0], f[1]); o.y = pk2(f[2], f[3]); o.z = pk2(f[4], f[5]); o.w = pk2(f[6], f[7]); return o; }
__device__ __forceinline__ bf16x8 as_frag(u32x4 v) { return __builtin_bit_cast(bf16x8, v); }
__device__ __forceinline__ u32x4 as_u4(bf16x8 v) { return __builtin_bit_cast(u32x4, v); }

constexpr int LS = 72;

template <int NTL, int KS>
__device__ __forceinline__ void mma_nt(const bf16* A, int lda, int m0, const bf16* B, int ldb, int n0, f32x4 (&acc)[NTL], int lane) {
    const int r = lane & 15, q = lane >> 4;
#pragma unroll
    for (int ks = 0; ks < KS; ++ks) {
        const bf16x8 a = *(const bf16x8*)(A + (m0 + r) * lda + ks * 32 + q * 8);
#pragma unroll
        for (int nt = 0; nt < NTL; ++nt) {
            const bf16x8 b = *(const bf16x8*)(B + (n0 + nt * 16 + r) * ldb + ks * 32 + q * 8);
            acc[nt] = MFMA16(a, b, acc[nt]);
        }
    }
}

__device__ __forceinline__ void layer_prep(const Params& p, int l, int idx, int stride, char* smem);
__device__ __forceinline__ void phase0(const Params& p, char* smem) {
    const int tid = otid();
    cpx* TW = (cpx*)(p.ws + WS_TW);
    cpx* ROPE = (cpx*)(p.ws + WS_ROPE);
    float* MOD = (float*)(p.ws + WS_MOD);
    constexpr int N_TW = NF / NT, N_ROPE = SEQ * 32 / NT, N_MOD = DEPTH * (3 * DM / 64);
    for (int task = obid(); task < N_TW + N_ROPE + N_MOD; task += gridDim.x) {
        if (task < N_TW) {
            const int j = task * NT + tid; float s, c; sincospif(2.0f * (float)j / (float)NF, &s, &c);
            cpx v; v.x = c; v.y = -s; TW[j] = v;
        } else if (task < N_TW + N_ROPE) {
            const int idx = (task - N_TW) * NT + tid; const int pos = idx >> 5, i = idx & 31;
            const float inv = exp2f(-(float)(i & 15) * (13.287712379549449f / 16.0f));
            const float ang = (float)(i < 16 ? pos / 64 : pos % 64) * inv;
            cpx v; v.x = cosf(ang); v.y = sinf(ang); ROPE[idx] = v;
        } else {
            const int mt = task - N_TW - N_ROPE; const int l = mt / (3 * DM / 64), n0 = (mt % (3 * DM / 64)) * 64;
            float* sv = (float*)smem;
            float* red = sv + NJ * DM;
            __syncthreads();
            for (int i = tid; i < NJ * DM; i += NT) { const int j = i / DM, k = i % DM; const float v = j < NB ? p.in[I_C][j * DM + k] : p.in[I_CCTX][k]; sv[i] = siluf_(v); }
            __syncthreads();
            const int nl = tid & 63, ks = tid >> 6; float acc[NJ];
#pragma unroll
            for (int j = 0; j < NJ; ++j) acc[j] = 0.f;
            const float* w = p.in[I_WADA] + (size_t)l * DM * 3 * DM + n0 + nl;
            for (int k = ks * (DM / 8); k < (ks + 1) * (DM / 8); ++k) { const float wv = w[(size_t)k * 3 * DM];
#pragma unroll
                for (int j = 0; j < NJ; ++j) acc[j] += sv[j * DM + k] * wv; }
#pragma unroll
            for (int j = 0; j < NJ; ++j) red[(ks * NJ + j) * 64 + nl] = acc[j];
            __syncthreads();
            for (int i = tid; i < NJ * 64; i += NT) { const int j = i / 64, n = i % 64; float s = 0.f;
#pragma unroll
                for (int k8 = 0; k8 < 8; ++k8) s += red[(k8 * NJ + j) * 64 + n];
                MOD[((size_t)l * NJ + j) * 3 * DM + n0 + n] = s + p.in[I_BADA][(size_t)l * 3 * DM + n0 + n]; }
        }
    }
}

#ifdef EMU
constexpr int PANEL_ROWS = 128, PANEL_UNITS = DM / 128;
#else
constexpr int PANEL_ROWS = 256, PANEL_UNITS = DM / 256;
#endif
__device__ __forceinline__ unsigned* unit_counter(const Params& p, int isctx) { return (unsigned*)(p.ws + WS_BAR + 16384) + 64 * isctx; }
__device__ __forceinline__ unsigned* stage_counter(const Params& p, int flag) { return (unsigned*)(p.ws + WS_BAR + 16384) + 512 + 512 * flag; }
__device__ __forceinline__ void stage_signal(const Params& p, char* smem, int flag, int l) {
#ifdef EMU
    __syncthreads(); if (otid() == 0) *stage_counter(p, flag) += 1u;
#else
    asm volatile("s_waitcnt vmcnt(0)" ::: "memory"); __syncthreads();
    if (threadIdx.x == 0) {
        const unsigned xcc = (unsigned)__builtin_amdgcn_s_getreg((3 << 11) | 20) & 0xFu, nloc = ((volatile __attribute__((address_space(3))) unsigned*)(smem + LDS_BYTES - 64))[0];
        unsigned* g = stage_counter(p, flag);
        if (nloc > 0u) { const unsigned old = __hip_atomic_fetch_add(g + 16 * (1 + xcc), 1u, __ATOMIC_RELAXED, __HIP_MEMORY_SCOPE_AGENT);
            if (old + 1u == nloc * (unsigned)(l + 1)) { __builtin_amdgcn_fence(__ATOMIC_RELEASE, "agent"); asm volatile("s_waitcnt vmcnt(0)" ::: "memory");
                __hip_atomic_fetch_add(g, nloc, __ATOMIC_RELAXED, __HIP_MEMORY_SCOPE_AGENT); } }
        else { __builtin_amdgcn_fence(__ATOMIC_RELEASE, "agent"); asm volatile("s_waitcnt vmcnt(0)" ::: "memory"); __hip_atomic_fetch_add(g, 1u, __ATOMIC_RELAXED, __HIP_MEMORY_SCOPE_AGENT); }
    }
#endif
}
__device__ __forceinline__ void stage_wait(const Params& p, int flag, int l) {
    if (otid() == 0) { const unsigned target = (unsigned)gridDim.x * (unsigned)(l + 1);
#ifdef EMU
        while (*(volatile unsigned*)stage_counter(p, flag) < target) emu::yield();
#else
        unsigned spins = 0;
        while (__hip_atomic_load(stage_counter(p, flag), __ATOMIC_RELAXED, __HIP_MEMORY_SCOPE_AGENT) < target) { __builtin_amdgcn_s_sleep(16); if (++spins > (1u << 20)) break; }
        __builtin_amdgcn_fence(__ATOMIC_ACQUIRE, "agent"); asm volatile("s_waitcnt vmcnt(0)" ::: "memory");
#endif
    }
    __syncthreads();
}
__device__ __forceinline__ int logical_row(int i) { return i < NB * SEQ ? (i / SEQ) * TOK + CTXL + i % SEQ : ((i - NB * SEQ) / CTXL) * TOK + (i - NB * SEQ) % CTXL; }
struct RowRef { const float* xo; float* xn; int mj, row; bool ok; };
__device__ __forceinline__ RowRef rp_ref(const Params& p, int l, int li, int base, int hi) {
    RowRef r; r.ok = li < hi; const int rr = logical_row(r.ok ? li : base); r.row = rr;
    const int b = rr / TOK, pp = rr % TOK; const bool isctx = pp < CTXL; if (l == DEPTH && isctx) r.ok = false;
    const size_t off = isctx ? ((size_t)b * CTXL + pp) * DM : ((size_t)b * SEQ + (pp - CTXL)) * DM;
    float* CTXB = (float*)(p.ws + WS_CTXB);
    r.xo = (l <= 1) ? (isctx ? p.in[I_CTX] + off : p.in[I_X] + off) : (isctx ? CTXB + off : p.out + off);
    r.xn = isctx ? CTXB + off : p.out + off; r.mj = isctx ? NB : b; return r;
}
__device__ __forceinline__ void rp_rows(const Params& p, int l, int lo, int hi, int gi, int nb) {
    const int tid = otid(), lane = tid & 63, wave = tid >> 6;
    const float* MOD = (const float*)(p.ws + WS_MOD);
    const bf16* YO = (const bf16*)(p.ws + WS_P);
    bf16* HN = (bf16*)(p.ws + WS_HNY);
    constexpr int NV4 = DM / 256, RW = 2;
    const int stride = nb * 8;
    f32x4 xq[RW][NV4]; u32x2 yq[RW][NV4]; RowRef rq[RW];
    int base = lo + gi * 8 + wave;
    if (base < hi) {
#pragma unroll
        for (int i = 0; i < RW; ++i) { rq[i] = rp_ref(p, l, base + i * stride, base, hi);
#pragma unroll
            for (int j = 0; j < NV4; ++j) { xq[i][j] = *(const f32x4*)(rq[i].xo + 4 * lane + 256 * j); yq[i][j] = (l > 0) ? *(const u32x2*)(YO + (size_t)rq[i].row * DM + 4 * lane + 256 * j) : (u32x2){0u, 0u}; } }
    }
    for (; base < hi; base += stride * RW) {
        f32x4 x[RW][NV4], y[RW][NV4]; RowRef rc[RW];
#pragma unroll
        for (int i = 0; i < RW; ++i) { rc[i] = rq[i];
#pragma unroll
            for (int j = 0; j < NV4; ++j) { x[i][j] = xq[i][j]; const u32x2 yy = yq[i][j]; y[i][j] = (f32x4){bitsf(yy.x << 16), bitsf(yy.x & 0xffff0000u), bitsf(yy.y << 16), bitsf(yy.y & 0xffff0000u)}; } }
        { const int nbase = base + stride * RW;
            if (nbase < hi) {
#pragma unroll
                for (int i = 0; i < RW; ++i) { rq[i] = rp_ref(p, l, nbase + i * stride, nbase, hi);
#pragma unroll
                    for (int j = 0; j < NV4; ++j) { xq[i][j] = *(const f32x4*)(rq[i].xo + 4 * lane + 256 * j); if (l > 0) yq[i][j] = *(const u32x2*)(YO + (size_t)rq[i].row * DM + 4 * lane + 256 * j); } } } }
        if (l > 0) {
            float ss[RW];
#pragma unroll
            for (int i = 0; i < RW; ++i) { ss[i] = 0.f;
#pragma unroll
                for (int j = 0; j < NV4; ++j) ss[i] += y[i][j].x * y[i][j].x + y[i][j].y * y[i][j].y + y[i][j].z * y[i][j].z + y[i][j].w * y[i][j].w; }
#pragma unroll
            for (int i = 0; i < RW; ++i) ss[i] = wave_sum(ss[i]);
            const float* gp = p.in[I_GPOST] + (size_t)(l - 1) * DM;
#pragma unroll
            for (int i = 0; i < RW; ++i) { const float rstd = rsqrtf(ss[i] * (1.0f / DM) + EPS); const float* gt = MOD + ((size_t)(l - 1) * NJ + rc[i].mj) * 3 * DM + 2 * DM;
#pragma unroll
                for (int j = 0; j < NV4; ++j) { const f32x4 g4 = *(const f32x4*)(gt + 4 * lane + 256 * j), p4 = *(const f32x4*)(gp + 4 * lane + 256 * j);
                    x[i][j] = x[i][j] + g4 * (y[i][j] * rstd * p4);
                    if (rc[i].ok) *(f32x4*)(rc[i].xn + 4 * lane + 256 * j) = x[i][j]; } }
        }
        if (l < DEPTH) {
            float ss[RW];
#pragma unroll
            for (int i = 0; i < RW; ++i) { ss[i] = 0.f;
#pragma unroll
                for (int j = 0; j < NV4; ++j) ss[i] += x[i][j].x * x[i][j].x + x[i][j].y * x[i][j].y + x[i][j].z * x[i][j].z + x[i][j].w * x[i][j].w; }
#pragma unroll
            for (int i = 0; i < RW; ++i) ss[i] = wave_sum(ss[i]);
            const float* gp = p.in[I_GPRE] + (size_t)l * DM;
#pragma unroll
            for (int i = 0; i < RW; ++i) { const float rstd = rsqrtf(ss[i] * (1.0f / DM) + EPS); const float* md = MOD + ((size_t)l * NJ + rc[i].mj) * 3 * DM; const int row = rc[i].row;
#pragma unroll
                for (int j = 0; j < NV4; ++j) { const int e = 4 * lane + 256 * j;
                    const f32x4 g4 = *(const f32x4*)(gp + e), sh = *(const f32x4*)(md + e), sc = *(const f32x4*)(md + DM + e);
                    const f32x4 h = (x[i][j] * rstd * g4) * (sc + 1.0f) + sh;
                    u32x2 o; o.x = pk2(h.x, h.y); o.y = pk2(h.z, h.w);
                    if (rc[i].ok) *(u32x2*)(HN + (size_t)row * DM + e) = o; } }
        }
    }
}

__device__ __forceinline__ void convert_tile(const float* src, int ldn, bf16* dst, int K, int n0, int k0, bool use_map, char* smem) {
    const int tid = otid();
    float* tile = (float*)smem;
    __syncthreads();
#pragma unroll
    for (int i = 0; i < 8; ++i) { const int idx = tid + NT * i, k = idx >> 6, n = idx & 63;
        const int oc = use_map ? orig_col(n0 + n) : (n0 + n);
        tile[k * 65 + n] = oc >= 0 ? src[(size_t)(k0 + k) * ldn + oc] : 0.f; }
    __syncthreads();
    const int n = tid >> 3, c = tid & 7;
    u32x4 o; o.x = pk2(tile[(8 * c + 0) * 65 + n], tile[(8 * c + 1) * 65 + n]); o.y = pk2(tile[(8 * c + 2) * 65 + n], tile[(8 * c + 3) * 65 + n]);
    o.z = pk2(tile[(8 * c + 4) * 65 + n], tile[(8 * c + 5) * 65 + n]); o.w = pk2(tile[(8 * c + 6) * 65 + n], tile[(8 * c + 7) * 65 + n]);
    *(u32x4*)(dst + (size_t)(n0 + n) * K + k0 + 8 * c) = o;
}

__device__ __forceinline__ void filter_task(const Params& p, int l, int L, int pos0, char* smem) {
    const int tid = otid(), j = tid & 63;
    float* z = (float*)smem;
    float* h1 = z + 8 * 33;
    float* h2 = h1 + 8 * 64;
    const float* w1 = p.in[I_HW1] + (size_t)l * 33 * 64; const float* w2 = p.in[I_HW2] + (size_t)l * 64 * 64; const float* w3 = p.in[I_HW3] + (size_t)l * 64 * 512;
    float r1[33], r2[64], r3a[16];
#pragma unroll
    for (int i = 0; i < 33; ++i) r1[i] = w1[i * 64 + j];
#pragma unroll
    for (int i = 0; i < 64; ++i) r2[i] = w2[i * 64 + j];
    const float b1 = p.in[I_HB1][l * 64 + j], b2 = p.in[I_HB2][l * 64 + j], b3 = p.in[I_HB3][l * 512 + tid];
    const float f0 = p.in[I_HFREQ][(l * 2 + 0) * 64 + j], f1 = p.in[I_HFREQ][(l * 2 + 1) * 64 + j];
    __syncthreads();
    if (tid < 8 * 33) { const int pp = tid / 33, i = tid % 33; const float pos = (float)(pos0 + pp);
        const float t = pos / (float)(L - 1 > 1 ? L - 1 : 1), wv = 6.283185307179586f * pos / (float)L; float v;
        if (i == 0) v = t; else { const int bi = (i - 1) & 15; const float f = 1e-4f + (float)bi * ((15.0f - 1e-4f) / 15.0f); v = (i <= 16) ? cosf(wv * f) : -sinf(wv * f); }
        z[tid] = v; }
    __syncthreads();
    { const int pp = tid >> 6; float a = b1;
#pragma unroll
        for (int i = 0; i < 33; ++i) a += z[pp * 33 + i] * r1[i];
        h1[tid] = sinf(f0 * a);
#pragma unroll
        for (int i = 0; i < 16; ++i) r3a[i] = w3[i * 512 + tid]; }
    __syncthreads();
    { const int pp = tid >> 6; float a = b2;
#pragma unroll
        for (int i = 0; i < 64; ++i) a += h1[pp * 64 + i] * r2[i];
        h2[tid] = sinf(f1 * a); }
    __syncthreads();
    { const int o = tid, dir = o >> 8, c = o & 255;
        const float delta = 3.0701134573253946f + (float)c * ((15.350567286626973f - 3.0701134573253946f) / 255.0f);
        float acc[8];
#pragma unroll
        for (int pp = 0; pp < 8; ++pp) acc[pp] = b3;
#pragma unroll 1
        for (int cix = 0; cix < 4; ++cix) {
            float wn[16];
#pragma unroll
            for (int i = 0; i < 16; ++i) wn[i] = (cix < 3) ? w3[(16 * (cix + 1) + i) * 512 + o] : 0.f;
#pragma unroll
            for (int i = 0; i < 16; ++i) {
#pragma unroll
                for (int pp = 0; pp < 8; ++pp) acc[pp] += h2[pp * 64 + 16 * cix + i] * r3a[i]; }
#pragma unroll
            for (int i = 0; i < 16; ++i) r3a[i] = wn[i]; }
        float* KT = (float*)(p.ws + WS_KT); float* HC = (float*)(p.ws + WS_HC);
#pragma unroll
        for (int pp = 0; pp < 8; ++pp) { const int pos = pos0 + pp; const float t = (float)pos / (float)(L - 1 > 1 ? L - 1 : 1);
            const float v = acc[pp] * __expf(-t * delta);
            if (L == SEQ) { if (dir == 0) KT[(size_t)c * NF + pos]= v; else if (pos > 0) KT[(size_t)c * NF + (NF - pos)] = v; else KT[(size_t)c * NF + SEQ] = 0.f; }
            else HC[((size_t)dir * WG + c) * CTXL + pos] = v; }
    }
}

__device__ __forceinline__ void convert_tile_w(const float* src, int ldn, bf16* dst, int K, int n0, int k0, bool use_map, char* wl, int lane) {
    float* tile = (float*)wl;
    const int oc = use_map ? orig_col(n0 + lane) : (n0 + lane);
    float v[64];
#pragma unroll
    for (int k = 0; k < 64; ++k) v[k] = oc >= 0 ? src[(size_t)(k0 + k) * ldn + oc] : 0.f;
#pragma unroll
    for (int k = 0; k < 64; ++k) tile[k * 65 + lane] = v[k];
    WAVE_SYNC();
#pragma unroll
    for (int i = 0; i < 8; ++i) { const int n = (lane >> 3) + 8 * i, c = lane & 7; float f[8];
#pragma unroll
        for (int j = 0; j < 8; ++j) f[j] = tile[(8 * c + j) * 65 + n];
        *(u32x4*)(dst + (size_t)(n0 + n) * K + k0 + 8 * c) = pack8(f); }
    WAVE_SYNC();
}
__device__ __forceinline__ void layer_prep(const Params& p, int l, int idx, int stride, char* smem) {
    constexpr int N_WIN = (NPAD / 64) * (DM / 64), N_FL = SEQ / 8, N_FC = CTXL / 8;
    for (int task = idx; task < N_FL + N_FC; task += stride) {
        if (task < N_FL) filter_task(p, l, SEQ, task * 8, smem);
        else filter_task(p, l, CTXL, (task - N_FL) * 8, smem);
    }
    __syncthreads();
    { const int tid = otid(), lane = tid & 63, wave = __builtin_amdgcn_readfirstlane(tid >> 6);
        char* wl = smem + wave * WLDS;
        for (int task = wave * stride + idx; task < N_WIN; task += 8 * stride) { const int nt = task / (DM / 64), kt = task % (DM / 64);
            convert_tile_w(p.in[I_WIN] + (size_t)l * DM * N_IN, N_IN, (bf16*)(p.ws + WS_WIN), DM, nt * 64, kt * 64, true, wl, lane); } }
}
__device__ __forceinline__ unsigned* row_queue(const Params& p, int l) { return (unsigned*)(p.ws + WS_BAR + 16384) + 2560 + 64 * l; }
__device__ __forceinline__ void wait_units(const Params& p, int c, int l) {
    constexpr int nLatU = NB * (SEQ / PANEL_ROWS) * PANEL_UNITS, nCtxU = NB * (CTXL / PANEL_ROWS) * PANEL_UNITS;
    const unsigned target = (unsigned)((c ? nCtxU : nLatU) * l);
#ifdef EMU
    while (*(volatile unsigned*)unit_counter(p, c) < target) emu::yield();
#else
    unsigned spins = 0;
    while (__hip_atomic_load(unit_counter(p, c), __ATOMIC_RELAXED, __HIP_MEMORY_SCOPE_AGENT) < target) { __builtin_amdgcn_s_sleep(16); if (++spins > (1u << 20)) break; }
    __builtin_amdgcn_fence(__ATOMIC_ACQUIRE, "agent"); asm volatile("s_waitcnt vmcnt(0)" ::: "memory");
#endif
}
__device__ __forceinline__ void phase_rp(const Params& p, int l, char* smem) { const int G = (int)gridDim.x, bid = obid(), tid = otid();
    const bool has_ctx = l < DEPTH;
    constexpr int nLatU = NB * (SEQ / PANEL_ROWS) * PANEL_UNITS, nCtxU = NB * (CTXL / PANEL_ROWS) * PANEL_UNITS;
    const int nU = nLatU + nCtxU;
    const int heavy = (l >= 1 && has_ctx && nU > G && (nU % G) != 0) ? nU % G : 0;
    const int total = heavy > 0 ? NB * SEQ : (has_ctx ? T : NB * SEQ);
    const int nl = G - heavy, np = (l < DEPTH) ? nl / 2 : 0, nr = nl - np;
    int lo, hi, gi, nb; bool prep = false;
    if (bid < heavy) { lo = NB * SEQ; hi = T; gi = bid; nb = heavy; }
    else { const int i = bid - heavy; int nR = total;
        if (np > 0) { nR = ((total * 2 / 3) / (nr * 16)) * (nr * 16); if (nR <= 0) nR = total / 2; }
        if (np > 0 && (i & 1) && i / 2 < np) { prep = true; lo = nR; hi = total; gi = i / 2; nb = np; }
        else { lo = 0; hi = nR; gi = (np > 0) ? (i + 1) / 2 : i; nb = nr; } }
    if (prep) layer_prep(p, l, gi, np, smem);
    else if (l < DEPTH && np == 0) layer_prep(p, l, bid, G, smem);
    if (l >= 1) { if (tid == 0) { if (lo < NB * SEQ) wait_units(p, 0, l); if (hi > NB * SEQ) wait_units(p, 1, l); } __syncthreads(); }
    rp_rows(p, l, lo, hi, gi, nb);
}

__device__ __forceinline__ cpx cmul(cpx a, cpx b) { cpx r; r.x = a.x * b.x - a.y * b.y; r.y = a.x * b.y + a.y * b.x; return r; }
__device__ __forceinline__ cpx cmulc(cpx a, cpx b) { cpx r; r.x = a.x * b.x + a.y * b.y; r.y = a.y * b.x - a.x * b.y; return r; }
constexpr int fpad(int i) { return i + (i >> 4); }
__device__ __forceinline__ int FPH(int i) { return i + (i >> 4); }
constexpr int FBUF = fpad(NF);
constexpr int ilog16(int n) { return n < 16 ? 0 : 1 + ilog16(n / 16); }
constexpr int FFT_P16 = ilog16(NF);
constexpr bool FFT_R4 = ((NF >> (4 * FFT_P16)) == 4);
static_assert((NF >> (4 * FFT_P16)) == 1 || (NF >> (4 * FFT_P16)) == 4, "NF = 16^a * (1 or 4)");
template <bool INV> __device__ __forceinline__ void dft4(cpx& a0, cpx& a1, cpx& a2, cpx& a3) {
    const cpx s = {a0.x + a2.x, a0.y + a2.y}, b = {a0.x - a2.x, a0.y - a2.y}, c = {a1.x + a3.x, a1.y + a3.y}, d = {a1.x - a3.x, a1.y - a3.y};
    a0 = (cpx){s.x + c.x, s.y + c.y}; a2 = (cpx){s.x - c.x, s.y - c.y};
    if (!INV) { a1 = (cpx){b.x + d.y, b.y - d.x}; a3 = (cpx){b.x - d.y, b.y + d.x}; }
    else      { a1 = (cpx){b.x - d.y, b.y + d.x}; a3 = (cpx){b.x + d.y, b.y - d.x}; }
}
template <bool INV> __device__ __forceinline__ cpx cmulk(cpx a, float wr, float wi) {
    cpx r; if (!INV) { r.x = a.x * wr + a.y * wi; r.y = a.y * wr - a.x * wi; } else { r.x = a.x * wr - a.y * wi; r.y = a.y * wr + a.x * wi; } return r;
}
template <bool INV> __device__ __forceinline__ void dft16(cpx (&x)[16]) {
    constexpr float C1 = 0.92387953251128674f, S1 = 0.38268343236508977f, C2 = 0.70710678118654752f;
#pragma unroll
    for (int n2 = 0; n2 < 4; ++n2) dft4<INV>(x[n2], x[4 + n2], x[8 + n2], x[12 + n2]);
    x[4 * 1 + 1] = cmulk<INV>(x[4 * 1 + 1], C1, S1); x[4 * 1 + 2] = cmulk<INV>(x[4 * 1 + 2], C2, C2); x[4 * 1 + 3] = cmulk<INV>(x[4 * 1 + 3], S1, C1);
    x[4 * 2 + 1] = cmulk<INV>(x[4 * 2 + 1], C2, C2); x[4 * 2 + 2] = cmulk<INV>(x[4 * 2 + 2], 0.f, 1.f); x[4 * 2 + 3] = cmulk<INV>(x[4 * 2 + 3], -C2, C2);
    x[4 * 3 + 1] = cmulk<INV>(x[4 * 3 + 1], S1, C1); x[4 * 3 + 2] = cmulk<INV>(x[4 * 3 + 2], -C2, C2); x[4 * 3 + 3] = cmulk<INV>(x[4 * 3 + 3], -C1, -S1);
#pragma unroll
    for (int k1 = 0; k1 < 4; ++k1) dft4<INV>(x[4 * k1 + 0], x[4 * k1 + 1], x[4 * k1 + 2], x[4 * k1 + 3]);
    cpx t;
    t = x[1]; x[1] = x[4]; x[4] = t; t = x[2]; x[2] = x[8]; x[8] = t; t = x[3]; x[3] = x[12]; x[12] = t;
    t = x[6]; x[6] = x[9]; x[9] = t; t = x[7]; x[7] = x[13]; x[13] = t; t = x[11]; x[11] = x[14]; x[14] = t;
}
template <bool INV> __device__ __forceinline__ void fft_stage16(cpx* buf, const cpx* TW, int tl, int M) {
    const int span = M >> 4, twm = NF / M;
#pragma unroll 1
    for (int j = tl; j < NF / 16; j += 256) {
        const int grp = j / span, pos = j % span, base = grp * M + pos; cpx x[16];
#pragma unroll
        for (int q = 0; q < 16; ++q) x[q] = buf[FPH(base + q * span)];
        cpx w1 = {1.f, 0.f}; if (span > 1) w1 = TW[pos * twm];
        if (INV && span > 1) { cpx wk = w1;
#pragma unroll
            for (int k = 1; k < 16; ++k) { x[k] = cmulc(x[k], wk); wk = cmul(wk, w1); } }
        dft16<INV>(x);
        if (!INV && span > 1) { cpx wk = w1;
#pragma unroll
            for (int k = 1; k < 16; ++k) { x[k] = cmul(x[k], wk); wk = cmul(wk, w1); } }
#pragma unroll
        for (int q = 0; q < 16; ++q) buf[FPH(base + q * span)] = x[q];
    }
}
template <bool INV> __device__ __forceinline__ void fft_stage4_last(cpx* buf, int tl) {
#pragma unroll 1
    for (int j = tl; j < NF / 4; j += 256) { cpx a0 = buf[FPH(4 * j)], a1 = buf[FPH(4 * j + 1)], a2 = buf[FPH(4 * j + 2)], a3 = buf[FPH(4 * j + 3)];
        dft4<INV>(a0, a1, a2, a3); buf[FPH(4 * j)] = a0; buf[FPH(4 * j + 1)] = a1; buf[FPH(4 * j + 2)] = a2; buf[FPH(4 * j + 3)] = a3; }
}
__device__ __forceinline__ void fft_fwd(cpx* buf, const cpx* TW, int tl) {
    int M = NF;
#pragma unroll
    for (int s = 0; s < FFT_P16; ++s) { __syncthreads(); fft_stage16<false>(buf, TW, tl, M); M >>= 4; }
    if (FFT_R4) { __syncthreads(); fft_stage4_last<false>(buf, tl); }
    __syncthreads();
}
__device__ __forceinline__ void fft_inv(cpx* buf, const cpx* TW, int tl) {
    if (FFT_R4) { __syncthreads(); fft_stage4_last<true>(buf, tl); }
    int M = FFT_R4 ? 64 : 16;
#pragma unroll
    for (int s = 0; s < FFT_P16; ++s) { __syncthreads(); fft_stage16<true>(buf, TW, tl, M); M <<= 4; }
    __syncthreads();
}
__device__ __forceinline__ void filt_fft_task(const Params& p, int cp, char* smem) {
    const int tid = otid(), half = tid >> 8, tl = tid & 255, c = 2 * cp + half;
    cpx* buf = (cpx*)smem + (size_t)half * FBUF;
    const float* KT = (const float*)(p.ws + WS_KT) + (size_t)c * NF;
    cpx* KF = (cpx*)(p.ws + WS_KF) + (size_t)c * NF;
    const cpx* TW = (const cpx*)(p.ws + WS_TW);
    __syncthreads();
    for (int i = tl; i < NF; i += 256) { cpx v; v.x = KT[i]; v.y = 0.f; buf[FPH(i)] = v; }
    fft_fwd(buf, TW, tl);
    for (int i = tl; i < NF; i += 256) KF[i] = buf[FPH(i)];
}

__device__ __forceinline__ void gemm_tile(const Params& p, const bf16* A, const bf16* Bt, int K, int mt, int nt, int mode, char* smem) {
    const int tid = otid(), lane = tid & 63, wave = tid >> 6;
    bf16* As = (bf16*)smem;
    bf16* Bs = As + 128 * LS;
    const int wm = (wave & 3) * 32, wn = (wave >> 2) * 64;
    f32x4 acc[2][4];
#pragma unroll
    for (int i = 0; i < 2; ++i)
#pragma unroll
        for (int j = 0; j < 4; ++j) acc[i][j] = (f32x4){0.f, 0.f, 0.f, 0.f};
    const int lr = tid >> 3, lc = tid & 7;
    const bf16* Ag = A + (size_t)(mt * 128 + lr) * K + lc * 8;
    const bf16* Bg = Bt + (size_t)(nt * 128 + lr) * K + lc * 8;
    u32x4 ra0, ra1, rb0, rb1;
    ra0 = *(const u32x4*)(Ag); ra1 = *(const u32x4*)(Ag + (size_t)64 * K); rb0 = *(const u32x4*)(Bg); rb1 = *(const u32x4*)(Bg + (size_t)64 * K);
    const int nk = K / 64;
    for (int kt = 0; kt < nk; ++kt) {
        __syncthreads();
        *(u32x4*)(As + lr * LS + lc * 8) = ra0; *(u32x4*)(As + (lr + 64) * LS + lc * 8) = ra1;
        *(u32x4*)(Bs + lr * LS + lc * 8) = rb0; *(u32x4*)(Bs + (lr + 64) * LS + lc * 8) = rb1;
        __syncthreads();
        if (kt + 1 < nk) { const int ko = (kt + 1) * 64;
            ra0 = *(const u32x4*)(Ag + ko); ra1 = *(const u32x4*)(Ag + (size_t)64 * K + ko); rb0 = *(const u32x4*)(Bg + ko); rb1 = *(const u32x4*)(Bg + (size_t)64 * K + ko); }
        mma_nt<4, 2>(As, LS, wm, Bs, LS, wn, acc[0], lane);
        mma_nt<4, 2>(As, LS, wm + 16, Bs, LS, wn, acc[1], lane);
    }
    const int r = lane & 15, q = lane >> 4;
#pragma unroll
    for (int i = 0; i < 2; ++i)
#pragma unroll
        for (int j = 0; j < 4; ++j)
#pragma unroll
            for (int e = 0; e < 4; ++e) {
                const int row = mt * 128 + wm + 16 * i + 4 * q + e, col = nt * 128 + wn + 16 * j + r; const float v = acc[i][j][e];
                if (mode == 0) { if (col < NP) ((bf16*)(p.ws + WS_P))[(size_t)row * NP + col] = f2bf(v); else if (col < NP + 16) ((float*)(p.ws + WS_G))[(size_t)row * NGS + (col - NP)] = v; else if (col < NP + NG) ((bf16*)((float*)(p.ws + WS_G) + (size_t)row * NGS + 16))[col - NP - 16] = f2bf(v); }
                else if (mode == 2) ((bf16*)(p.ws + WS_HT))[(size_t)row * T + col] = f2bf(v);
                else ((bf16*)(p.ws + WS_P))[(size_t)row * DM + col] = f2bf(v);
            }
}

#ifndef EMU
namespace pg8 {
#define PG8_LAS __attribute__((address_space(3)))
typedef unsigned short bf16_t;
typedef short bf16x8 __attribute__((ext_vector_type(8)));
typedef float f32x4 __attribute__((ext_vector_type(4)));
typedef unsigned u32x4 __attribute__((ext_vector_type(4)));
constexpr int BM = 256, BK = 64, HALF = 128, HTB = HALF * BK * 2  , STAGE_BYTES = 8 * HTB, NXCD = 8, WGM = 8;

__host__ __device__ __forceinline__ int lds_byte(int r, int c) { const int st = (r >> 4) * 2 + (c >> 5), rr = r & 15, cc = c & 31, ob = rr * 64 + cc * 2; return st * 1024 + (ob ^ (((ob >> 9) & 1) << 5)); }
__host__ __device__ __forceinline__ void stage_rc(int b, int& R, int& C) { const int st = b / 1024, sb = b % 1024, swz = sb ^ (((sb >> 9) & 1) << 5); R = (st >> 1) * 16 + swz / 64; C = (st & 1) * 32 + (swz % 64) / 2; }
__host__ __device__ __forceinline__ int perm32(int rho) { const int n = rho >> 4, i = rho & 15; return 8 * (i >> 2) + 4 * n + (i & 3); }

struct Unit { int pm, pn; };
struct Gemm { const bf16_t* A; const bf16_t* Bt; int M, N, K; };
__device__ __forceinline__ unsigned cvt_pk_bf16(float lo, float hi) { unsigned r; asm volatile("v_cvt_pk_bf16_f32 %0, %1, %2" : "=v"(r) : "v"(lo), "v"(hi)); return r; }
template <class Epi, class Sched, bool ALIGN_EPI = false, bool SP2 = false>
__device__ __forceinline__ void gemm_phase(PG8_LAS unsigned char* lds, const Gemm g, const Sched& S, const Epi& E) {
    const int tid = otid(), wid = __builtin_amdgcn_readfirstlane(tid >> 6), lane = tid & 63, wr = wid >> 2, wc = wid & 3, fr = lane & 15, fq = lane >> 4;
    const int K = g.K, nt = K / BK;
    unsigned voffA[2], voffB[2];
#pragma unroll
    for (int i = 0; i < 2; ++i) { int R, C; stage_rc(tid * 16 + i * 8192, R, C); const int Rb = Epi::PERM ? ((R & ~31) + perm32(R & 31)) : R;
        voffA[i] = (unsigned)(R * K + C) * 2u; voffB[i] = (unsigned)(Rb * K + C) * 2u; }
    const size_t kstep = (size_t)(BK * 2);
    const size_t hstep = (size_t)HALF * K * 2;
    const size_t tstep = 2 * hstep;
    const unsigned ldsw = (unsigned)wid * 1024u;
    const int aoff = lds_byte(wr * 64 + fr, fq * 8), boff = lds_byte(wc * 32 + fr, fq * 8);
#define PG8_SA(b, h) (((b) * 2 + (h)) * HTB)
#define PG8_SB(b, h) ((4 + (b) * 2 + (h)) * HTB)
#define PG8_STAGE(bufoff, gbase, voff) do { _Pragma("unroll") for (int _i = 0; _i < 2; ++_i) \
        __builtin_amdgcn_global_load_lds((const unsigned*)((const char*)(gbase) + (voff)[_i]), (PG8_LAS unsigned*)(lds + (bufoff) + ldsw + _i * 8192), 16, 0, 0); } while (0)
#define PG8_LDA(dst, b, h) do { _Pragma("unroll") for (int m = 0; m < 4; ++m) _Pragma("unroll") for (int k = 0; k < 2; ++k) dst[m][k] = *(const PG8_LAS bf16x8*)(lds + PG8_SA(b, h) + aoff + m * 2048 + k * 1024); } while (0)
#define PG8_LDB(dst, b, h) do { _Pragma("unroll") for (int n = 0; n < 2; ++n) _Pragma("unroll") for (int k = 0; k < 2; ++k) dst[n][k] = *(const PG8_LAS bf16x8*)(lds + PG8_SB(b, h) + boff + n * 2048 + k * 1024); } while (0)
#define PG8_MMA(ai, bj, At, Bt) do { __builtin_amdgcn_s_setprio(1); _Pragma("unroll") for (int m = 0; m < 4; ++m) _Pragma("unroll") for (int n = 0; n < 2; ++n) _Pragma("unroll") for (int k = 0; k < 2; ++k) \
        acc[ai][bj][m][n] = __builtin_amdgcn_mfma_f32_16x16x32_bf16(Bt[n][k], At[m][k], acc[ai][bj][m][n], 0, 0, 0); __builtin_amdgcn_s_setprio(0); } while (0)
#define PG8_WAIT_V(n) asm volatile("s_waitcnt vmcnt(" #n ")" ::: "memory")
#define PG8_WAIT_L(n) asm volatile("s_waitcnt lgkmcnt(" #n ")" ::: "memory")
#define PG8_BAR __builtin_amdgcn_s_barrier()
#define PG8_SCHED __builtin_amdgcn_sched_barrier(0)
    Unit cur, nxt; int ui = 0;
    if (!S.next(0, cur)) return;
    f32x4 acc[2][2][4][2];
#pragma unroll
    for (int a = 0; a < 2; ++a)
#pragma unroll
        for (int b = 0; b < 2; ++b)
#pragma unroll
            for (int m = 0; m < 4; ++m)
#pragma unroll
                for (int n = 0; n < 2; ++n) acc[a][b][m][n] = (f32x4){0.f, 0.f, 0.f, 0.f};
    bf16x8 At[4][2], B0[2][2], B1[2][2];
    const char* cA = (const char*)g.A + (size_t)cur.pm * tstep; const char* cB = (const char*)g.Bt + (size_t)cur.pn * tstep;
    S.a_ready(cur);
    if constexpr (SP2) {
        PG8_STAGE(PG8_SB(0, 0), cB, voffB); PG8_STAGE(PG8_SB(0, 1), cB + hstep, voffB); PG8_STAGE(PG8_SA(0, 0), cA, voffA); PG8_STAGE(PG8_SA(0, 1), cA + hstep, voffA);
        if (wr == 1) PG8_BAR;
        PG8_WAIT_V(2); PG8_BAR;
        PG8_STAGE(PG8_SB(1, 0), cB + kstep, voffB); PG8_STAGE(PG8_SA(1, 0), cA + kstep, voffA); PG8_STAGE(PG8_SB(1, 1), cB + hstep + kstep, voffB);
        PG8_WAIT_V(6); PG8_BAR;
    } else {
        PG8_STAGE(PG8_SB(0, 0), cB, voffB); PG8_STAGE(PG8_SA(0, 0), cA, voffA); PG8_STAGE(PG8_SB(0, 1), cB + hstep, voffB); PG8_STAGE(PG8_SA(0, 1), cA + hstep, voffA);
        if (wr == 1) PG8_BAR;
        PG8_WAIT_V(4); PG8_BAR;
        PG8_STAGE(PG8_SB(1, 0), cB + kstep, voffB); PG8_STAGE(PG8_SA(1, 0), cA + kstep, voffA); PG8_STAGE(PG8_SB(1, 1), cB + hstep + kstep, voffB);
        PG8_WAIT_V(6); PG8_BAR;
    }
    for (;;) {
        const bool has_next = S.next(ui + 1, nxt);
        const char* nA = has_next ? (const char*)g.A + (size_t)nxt.pm * tstep : cA; const char* nB = has_next ? (const char*)g.Bt + (size_t)nxt.pn * tstep : cB;
        for (int t = 0; t < nt; t += 2) {
            const bool last = (t == nt - 2);
            const char* a1 = cA + (size_t)(t + 1) * kstep;
            const char* a2 = last ? nA : cA + (size_t)(t + 2) * kstep; const char* b2 = last ? nB : cB + (size_t)(t + 2) * kstep;
            const char* a3 = a2 + kstep; const char* b3 = b2 + kstep;
            if (last && has_next) S.a_ready(nxt);
            if constexpr (SP2) {
            PG8_LDB(B0, 0, 0); PG8_LDB(B1, 0, 1); PG8_SCHED; PG8_LDA(At, 0, 0); PG8_STAGE(PG8_SA(1, 1), a1 + hstep, voffA);
            PG8_WAIT_V(8); PG8_WAIT_L(0); PG8_BAR; PG8_MMA(0, 0, At, B0); PG8_MMA(0, 1, At, B1); PG8_BAR; PG8_SCHED;
            PG8_LDA(At, 0, 1); PG8_STAGE(PG8_SB(0, 0), b2, voffB); PG8_STAGE(PG8_SB(0, 1), b2 + hstep, voffB); PG8_STAGE(PG8_SA(0, 0), a2, voffA);
            PG8_WAIT_V(8); PG8_WAIT_L(0); PG8_BAR; PG8_MMA(1, 0, At, B0); PG8_MMA(1, 1, At, B1); PG8_BAR; PG8_SCHED;
            PG8_LDB(B0, 1, 0); PG8_LDB(B1, 1, 1); PG8_SCHED; PG8_LDA(At, 1, 0); PG8_STAGE(PG8_SA(0, 1), a2 + hstep, voffA);
            PG8_WAIT_V(8); PG8_WAIT_L(0); PG8_BAR; PG8_MMA(0, 0, At, B0); PG8_MMA(0, 1, At, B1); PG8_BAR; PG8_SCHED;
            PG8_LDA(At, 1, 1); PG8_STAGE(PG8_SB(1, 0), b3, voffB); PG8_STAGE(PG8_SB(1, 1), b3 + hstep, voffB); PG8_STAGE(PG8_SA(1, 0), a3, voffA);
            PG8_WAIT_V(8); PG8_WAIT_L(0); PG8_BAR; PG8_MMA(1, 0, At, B0); PG8_MMA(1, 1, At, B1); PG8_BAR; PG8_SCHED;
            } else {
            PG8_LDB(B0, 0, 0); PG8_SCHED; PG8_LDA(At, 0, 0); PG8_STAGE(PG8_SA(1, 1), a1 + hstep, voffA);
            PG8_WAIT_L(8); PG8_BAR; PG8_WAIT_L(0); PG8_MMA(0, 0, At, B0); PG8_BAR; PG8_SCHED;
            PG8_LDB(B1, 0, 1); PG8_STAGE(PG8_SB(0, 0), b2, voffB);
            PG8_BAR; PG8_WAIT_L(0); PG8_MMA(0, 1, At, B1); PG8_BAR;
            PG8_LDA(At, 0, 1); PG8_STAGE(PG8_SA(0, 0), a2, voffA);
            PG8_BAR; PG8_WAIT_L(0); PG8_MMA(1, 0, At, B0); PG8_BAR; PG8_SCHED;
            PG8_STAGE(PG8_SB(0, 1), b2 + hstep, voffB);
            PG8_WAIT_V(6); PG8_BAR; PG8_MMA(1, 1, At, B1); PG8_BAR;
            PG8_LDB(B0, 1, 0); PG8_SCHED; PG8_LDA(At, 1, 0); PG8_STAGE(PG8_SA(0, 1), a2 + hstep, voffA);
            PG8_WAIT_L(8); PG8_BAR; PG8_WAIT_L(0); PG8_MMA(0, 0, At, B0); PG8_BAR; PG8_SCHED;
            PG8_LDB(B1, 1, 1); PG8_STAGE(PG8_SB(1, 0), b3, voffB);
            PG8_BAR; PG8_WAIT_L(0); PG8_MMA(0, 1, At, B1); PG8_BAR;
            PG8_LDA(At, 1, 1); PG8_STAGE(PG8_SA(1, 0), a3, voffA);
            PG8_BAR; PG8_WAIT_L(0); PG8_MMA(1, 0, At, B0); PG8_BAR; PG8_SCHED;
            PG8_STAGE(PG8_SB(1, 1), b3 + hstep, voffB);
            PG8_WAIT_V(6); PG8_BAR; PG8_MMA(1, 1, At, B1); PG8_BAR;
            }
        }
        if constexpr (ALIGN_EPI) { if (wr == 0) PG8_BAR; }
        if constexpr (!Epi::AFTER_DRAIN) { E(acc, cur, wr, wc, fr, fq); S.done(cur); }
        if (!has_next) break;
#pragma unroll
        for (int a = 0; a < 2; ++a)
#pragma unroll
            for (int b = 0; b < 2; ++b)
#pragma unroll
                for (int m = 0; m < 4; ++m)
#pragma unroll
                    for (int n = 0; n < 2; ++n) acc[a][b][m][n] = (f32x4){0.f, 0.f, 0.f, 0.f};
        cur = nxt; cA = nA; cB = nB; ++ui;
        if constexpr (ALIGN_EPI) { if (wr == 1) PG8_BAR; }
    }
    PG8_WAIT_V(0);
    if constexpr (!ALIGN_EPI) { if (wr == 0) PG8_BAR; }
    PG8_BAR;
    if constexpr (Epi::AFTER_DRAIN) { E.fused(acc, cur, wr, wc, fr, fq, lds, wid, lane); S.done(cur); }
#undef PG8_SA
#undef PG8_SB
#undef PG8_STAGE
#undef PG8_LDA
#undef PG8_LDB
#undef PG8_MMA
#undef PG8_WAIT_V
#undef PG8_WAIT_L
#undef PG8_BAR
#undef PG8_SCHED
}
__device__ __forceinline__ void map_tile(int L, int nM, int nN, int& pm, int& pn) {
    const int nwg = nM * nN; int wgid = L; { const int q = nwg / NXCD, r = nwg % NXCD, xcd = wgid % NXCD, off = wgid / NXCD; wgid = (xcd < r ? xcd * (q + 1) : r * (q + 1) + (xcd - r) * q) + off; }
    const int nig = WGM * nN, gid = wgid / nig, fm = gid * WGM, gsz = (nM - fm) < WGM ? (nM - fm) : WGM;
    pm = fm + ((wgid % nig) % gsz); pn = (wgid % nig) / gsz;
}
constexpr int MP = T / 256, WP = NMAIN / 256, NU2 = 4 * MP, NU1 = MP * WP;
struct InOrder { int G, c;
    __device__ __forceinline__ bool next(int i, Unit& u) const { const int L = i * G + c; if (L >= NU2 + NU1) return false; int a, b;
        if (L < NU2) { map_tile(L, 4, MP, a, b); u.pm = MP + WP + a; u.pn = b; } else { map_tile(L - NU2, MP, WP, a, b); u.pm = a; u.pn = MP + b; } return true; }
    __device__ __forceinline__ void a_ready(const Unit&) const {}
    __device__ __forceinline__ void done(const Unit&) const {}
};
struct EpiIn { static constexpr bool PERM = true, AFTER_DRAIN = false; bf16_t* P; float* G; bf16_t* HTp;
    __device__ __forceinline__ void operator()(const f32x4 (&acc)[2][2][4][2], const Unit& u, int wr, int wc, int fr, int fq) const {
        if (u.pm < MP) { const int pn = u.pn - MP, row0 = u.pm * BM + wr * 64 + fr;
            if (pn < NP / 256) { const int col0 = pn * BM + wc * 32 + 8 * fq;
#pragma unroll
                for (int ai = 0; ai < 2; ++ai)
#pragma unroll
                    for (int m = 0; m < 4; ++m) { bf16_t* rowp = P + (size_t)(row0 + ai * HALF + m * 16) * NP + col0;
#pragma unroll
                        for (int bj = 0; bj < 2; ++bj) { const f32x4 v0 = acc[ai][bj][m][0], v1 = acc[ai][bj][m][1];
                            u32x4 w; w.x = cvt_pk_bf16(v0[0], v0[1]); w.y = cvt_pk_bf16(v0[2], v0[3]); w.z = cvt_pk_bf16(v1[0], v1[1]); w.w = cvt_pk_bf16(v1[2], v1[3]); *(u32x4*)(rowp + bj * HALF) = w; } } }
            else { const int cb = wc * 32 + 8 * fq;
                if (cb < NG) {
#pragma unroll
                    for (int ai = 0; ai < 2; ++ai)
#pragma unroll
                        for (int m = 0; m < 4; ++m) { float* rowb = G + (size_t)(row0 + ai * HALF + m * 16) * NGS; const f32x4 v0 = acc[ai][0][m][0], v1 = acc[ai][0][m][1];
                            if (cb < 16) { *(f32x4*)(rowb + cb) = v0; *(f32x4*)(rowb + cb + 4) = v1; }
                            else { u32x4 w; w.x = cvt_pk_bf16(v0[0], v0[1]); w.y = cvt_pk_bf16(v0[2], v0[3]); w.z = cvt_pk_bf16(v1[0], v1[1]); w.w = cvt_pk_bf16(v1[2], v1[3]); *(u32x4*)((bf16_t*)(rowb + 16) + (cb - 16)) = w; } } } } }
        else { const int row0 = (u.pm - MP - WP) * BM + wr * 64 + fr, col0 = u.pn * BM + wc * 32 + 8 * fq;
#pragma unroll
            for (int ai = 0; ai < 2; ++ai)
#pragma unroll
                for (int m = 0; m < 4; ++m) { bf16_t* rowp = HTp + (size_t)(row0 + ai * HALF + m * 16) * T + col0;
#pragma unroll
                    for (int bj = 0; bj < 2; ++bj) { const f32x4 v0 = acc[ai][bj][m][0], v1 = acc[ai][bj][m][1];
                        u32x4 w; w.x = cvt_pk_bf16(v0[0], v0[1]); w.y = cvt_pk_bf16(v0[2], v0[3]); w.z = cvt_pk_bf16(v1[0], v1[1]); w.w = cvt_pk_bf16(v1[2], v1[3]); *(u32x4*)(rowp + bj * HALF) = w; } } }
    }
};
struct OutOrder { int G, c; bool lat_only; unsigned* cnt;
    __device__ __forceinline__ bool next(int i, Unit& u) const { constexpr int nN = DM / 256, nLat = NB * (SEQ / 256) * nN, nCtx = NB * (CTXL / 256) * nN; const int L = i * G + c; int a, b;
        if (L < nLat) { map_tile(L, nLat / nN, nN, a, b); u.pm = (a / (SEQ / 256)) * (TOK / 256) + CTXL / 256 + a % (SEQ / 256); }
        else { if (lat_only || L >= nLat + nCtx) return false; map_tile(L - nLat, nCtx / nN, nN, a, b); u.pm = (a / (CTXL / 256)) * (TOK / 256) + a % (CTXL / 256); }
        u.pn = b; return true; }
    __device__ __forceinline__ void a_ready(const Unit&) const {}
    unsigned* xu; unsigned nloc, xtarget;
    __device__ __forceinline__ void done(const Unit& u) const {
        asm volatile("s_waitcnt vmcnt(0)" ::: "memory"); __builtin_amdgcn_s_barrier();
        if (threadIdx.x == 0) { const bool isctx = (u.pm % (TOK / 256)) < CTXL / 256;
            if (!isctx && xtarget != 0u) {
                const unsigned old = __hip_atomic_fetch_add(xu, 1u, __ATOMIC_RELAXED, __HIP_MEMORY_SCOPE_AGENT);
                if (old + 1u == xtarget) { __builtin_amdgcn_fence(__ATOMIC_RELEASE, "agent"); asm volatile("s_waitcnt vmcnt(0)" ::: "memory");
                    __hip_atomic_fetch_add(cnt, nloc, __ATOMIC_RELAXED, __HIP_MEMORY_SCOPE_AGENT); } }
            else { __builtin_amdgcn_fence(__ATOMIC_RELEASE, "agent"); asm volatile("s_waitcnt vmcnt(0)" ::: "memory");
                __hip_atomic_fetch_add(cnt + (isctx ? 64 : 0), 1u, __ATOMIC_RELAXED, __HIP_MEMORY_SCOPE_AGENT); } } }
};
struct EpiOut { static constexpr bool PERM = true, AFTER_DRAIN = false; bf16_t* C;
    __device__ __forceinline__ void operator()(const f32x4 (&acc)[2][2][4][2], const Unit& u, int wr, int wc, int fr, int fq) const {
        const int row0 = u.pm * BM + wr * 64 + fr, col0 = u.pn * BM + wc * 32 + 8 * fq;
#pragma unroll
        for (int ai = 0; ai < 2; ++ai)
#pragma unroll
            for (int m = 0; m < 4; ++m) { bf16_t* rowp = C + (size_t)(row0 + ai * HALF + m * 16) * DM + col0;
#pragma unroll
                for (int bj = 0; bj < 2; ++bj) { const f32x4 v0 = acc[ai][bj][m][0], v1 = acc[ai][bj][m][1];
                    u32x4 w; w.x = cvt_pk_bf16(v0[0], v0[1]); w.y = cvt_pk_bf16(v0[2], v0[3]); w.z = cvt_pk_bf16(v1[0], v1[1]); w.w = cvt_pk_bf16(v1[2], v1[3]); *(u32x4*)(rowp + bj * HALF) = w; } }
    }
};
}
#endif

__device__ __forceinline__ void phase_gemm_in(const Params& p, int l, char* smem) {
    constexpr int N_F = WG / 2;
#ifdef EMU
    constexpr int MT = T / 128, NT1 = NMAIN / 128, N1 = MT * NT1, N2 = 8 * MT;
    for (int task = obid(); task < N1 + N2; task += gridDim.x) {
        if (task < N1) gemm_tile(p, (const bf16*)(p.ws + WS_HNY), (const bf16*)(p.ws + WS_WIN), DM, task / NT1, task % NT1, 0, smem);
        else { const int t2 = task - N1; gemm_tile(p, (const bf16*)(p.ws + WS_WIN) + (size_t)NMAIN * DM, (const bf16*)(p.ws + WS_HNY), DM, t2 / MT, t2 % MT, 2, smem); }
    }
#else
    { const pg8::Gemm g{(const pg8::bf16_t*)(p.ws + WS_HNY), (const pg8::bf16_t*)(p.ws + WS_HNY), 0, 0, DM};
      const pg8::InOrder S{(int)gridDim.x, obid()};
      const pg8::EpiIn E{(pg8::bf16_t*)(p.ws + WS_P), (float*)(p.ws + WS_G), (pg8::bf16_t*)(p.ws + WS_HT)};
      pg8::gemm_phase<pg8::EpiIn, pg8::InOrder, true, true>((PG8_LAS unsigned char*)smem, g, S, E); }
#endif
    { const int G = (int)gridDim.x, bid = obid();
#ifdef EMU
      const int extra = 0;
#else
      const int extra = (pg8::NU1 + pg8::NU2) % G;
#endif
      if (extra > 0 && extra < G) { if (bid >= extra) for (int task = bid - extra; task < N_F; task += G - extra) filt_fft_task(p, task, smem); }
      else for (int task = G - 1 - bid; task < N_F; task += G) filt_fft_task(p, task, smem); }
}
__device__ __forceinline__ void phase_gemm_out(const Params& p, int l, char* smem) {
    const int G = (int)gridDim.x, bid = obid(); const bool has_ctx = l < DEPTH - 1;
#ifdef EMU
    constexpr int MT = T / 128, NTO = DM / 128;
    for (int task = bid; task < MT * NTO; task += G) {
        const int mt = task / NTO, nt = task % NTO;
        if (!has_ctx && (mt % (TOK / 128)) < CTXL / 128) continue;
        gemm_tile(p, (const bf16*)(p.ws + WS_HNY), (const bf16*)(p.ws + WS_WOUT), MIX, mt, nt, 1, smem);
        __syncthreads(); if (otid() == 0) *unit_counter(p, (mt % (TOK / 128)) < CTXL / 128 ? 1 : 0) += 1u;
    }
#else
    const pg8::Gemm g{(const pg8::bf16_t*)(p.ws + WS_HNY), (const pg8::bf16_t*)(p.ws + WS_WOUT), 0, 0, MIX};
    const unsigned xcc = (unsigned)__builtin_amdgcn_s_getreg((3 << 11) | 20) & 0xFu, nloc = ((volatile PG8_LAS unsigned*)(smem + LDS_BYTES - 64))[0];
    const bool agg = (NB * (SEQ / 256) * (DM / 256) == G) && nloc > 0u;
    const pg8::OutOrder S{G, bid, !has_ctx, unit_counter(p, 0), unit_counter(p, 2) + 16 * xcc, nloc, agg ? nloc * (unsigned)(l + 1) : 0u};
    const pg8::EpiOut E{(pg8::bf16_t*)(p.ws + WS_P)};
    pg8::gemm_phase<pg8::EpiOut, pg8::OutOrder, true, true>((PG8_LAS unsigned char*)smem, g, S, E);
#endif
}

__device__ __forceinline__ size_t st_index(int mixer, int dir, int b, int h, int cid) { return ((((size_t)(mixer * 2 + dir) * NB + b) * NH + h) * NCH + cid); }
__device__ __forceinline__ size_t ch_index(int dir, int b, int h, int cid) { return (((size_t)dir * NB + b) * NH + h) * NCH + cid; }

__device__ __forceinline__ void load_tile_nat(const bf16* P, int r0, int c0, bf16* dst, float scale, int tid) {
    const int s = tid >> 3, c8 = tid & 7;
    const u32x4 v = *(const u32x4*)(P + (size_t)(r0 + s) * NP + c0 + c8 * 8);
    if (scale == 1.0f) *(u32x4*)(dst + s * LS + c8 * 8) = v;
    else { float f[8]; unpack8(v, f); u32x4 o; o.x = pk2(f[0] * scale, f[1] * scale); o.y = pk2(f[2] * scale, f[3] * scale); o.z = pk2(f[4] * scale, f[5] * scale); o.w = pk2(f[6] * scale, f[7] * scale);
        *(u32x4*)(dst + s * LS + c8 * 8) = o; }
}
__device__ __forceinline__ void load_tile_tr(const bf16* P, int r0, int c0, bf16* dst, int tid) {
    const int s = tid >> 3, c8 = tid & 7;
    const u32x4 v = *(const u32x4*)(P + (size_t)(r0 + s) * NP + c0 + c8 * 8);
    const unsigned w[4] = {v.x, v.y, v.z, v.w};
#pragma unroll
    for (int j = 0; j < 4; ++j) { dst[(c8 * 8 + 2 * j) * LS + s] = (bf16)(w[j] & 0xffffu); dst[(c8 * 8 + 2 * j + 1) * LS + s] = (bf16)(w[j] >> 16); }
}

template <int NTK>
__device__ __forceinline__ void load_span(const bf16* row, int t0, float (&v)[NTK + 2]) {
    { const bool hl = t0 > 0, hr = t0 + NTK < SEQ; const bf16 xl = row[hl ? -1 : 0], xr = row[hr ? NTK : 0];
        v[0] = hl ? bf2f(xl) : 0.f; v[NTK + 1] = hr ? bf2f(xr) : 0.f; }
    if constexpr (NTK == 8) { float f[8]; unpack8(*(const u32x4*)row, f);
#pragma unroll
        for (int i = 0; i < 8; ++i) v[1 + i] = f[i]; }
    else {
#pragma unroll
        for (int i = 0; i < NTK; ++i) v[1 + i] = bf2f(row[i]); }
}
template <int NTK>
__device__ __forceinline__ void hy_inputs(const bf16* h0, const bf16* h1, const float* cw, const float* cb, int c, int t0, float (&u0)[NTK], float (&u1)[NTK], float (&g0)[NTK], float (&g1)[NTK]) {
    { float xa[NTK + 2], xb[NTK + 2]; load_span<NTK>(h0 + (size_t)512 * T, t0, xa); load_span<NTK>(h1 + (size_t)512 * T, t0, xb);
        const float w0 = cw[0 * 768 + 512 + c], w1 = cw[1 * 768 + 512 + c], w2 = cw[2 * 768 + 512 + c], bb = cb[512 + c];
        float ga[NTK + 2], gb[NTK + 2]; load_span<NTK>(h0 + (size_t)768 * T, t0, ga); load_span<NTK>(h1 + (size_t)768 * T, t0, gb);
#pragma unroll
        for (int i = 0; i < NTK; ++i) { g0[i] = (w0 * xa[i] + w1 * xa[i + 1] + w2 * xa[i + 2] + bb) * siluf_(ga[i + 1]); g1[i] = (w0 * xb[i] + w1 * xb[i + 1] + w2 * xb[i + 2] + bb) * siluf_(gb[i + 1]); } }
    { float va[NTK + 2], vb[NTK + 2], ya[NTK + 2], yb[NTK + 2];
        load_span<NTK>(h0, t0, va); load_span<NTK>(h1, t0, vb); load_span<NTK>(h0 + (size_t)256 * T, t0, ya); load_span<NTK>(h1 + (size_t)256 * T, t0, yb);
        const float v0 = cw[0 * 768 + c], v1 = cw[1 * 768 + c], v2 = cw[2 * 768 + c], vbias = cb[c];
        const float y0 = cw[0 * 768 + 256 + c], y1 = cw[1 * 768 + 256 + c], y2 = cw[2 * 768 + 256 + c], ybias = cb[256 + c];
#pragma unroll
        for (int i = 0; i < NTK; ++i) { u0[i] = (v0 * va[i] + v1 * va[i + 1] + v2 * va[i + 2] + vbias) * (y0 * ya[i] + y1 * ya[i + 1] + y2 * ya[i + 2] + ybias);
            u1[i] = (v0 * vb[i] + v1 * vb[i + 1] + v2 * vb[i + 2] + vbias) * (y0 * yb[i] + y1 * yb[i + 1] + y2 * yb[i + 2] + ybias); } }
}
__device__ __forceinline__ void hylat_task(const Params& p, int l, int bp, int cp, char* smem) {
    const int tid = otid(), half = tid >> 8, tl = tid & 255, c = 2 * cp + half;
    const bf16* HT = (const bf16*)(p.ws + WS_HT); bf16* Y = (bf16*)(p.ws + WS_HNY);
    cpx* buf = (cpx*)smem + (size_t)half * FBUF;
    const cpx* TW = (const cpx*)(p.ws + WS_TW);
    const cpx* KF = (const cpx*)(p.ws + WS_KF) + (size_t)c * NF;
    constexpr int NTK = SEQ / 256;
    const int t0 = NTK * tl;
    const float* cw = p.in[I_HCW] + (size_t)l * 3 * 768; const float* cb = p.in[I_HCB] + (size_t)l * 768;
    const size_t rb0 = (size_t)(2 * bp) * TOK + CTXL, rb1 = rb0 + TOK;
    const bf16* h0 = HT + (size_t)c * T + rb0 + t0; const bf16* h1 = h0 + TOK;
    { float u0[NTK], u1[NTK], g0[NTK], g1[NTK]; hy_inputs<NTK>(h0, h1, cw, cb, c, t0, u0, u1, g0, g1);
        __syncthreads();
#pragma unroll
        for (int i = 0; i < NTK; ++i) { cpx v; v.x = u0[i]; v.y = u1[i]; buf[FPH(t0 + i)] = v; cpx z = {0.f, 0.f}; buf[FPH(SEQ + t0 + i)] = z; } }
    fft_fwd(buf, TW, tl);
#pragma unroll 2
    for (int i = tl; i < NF; i += 256) buf[FPH(i)] = cmul(buf[FPH(i)], KF[i]);
    fft_inv(buf, TW, tl);
    const float dsk = p.in[I_HD][(size_t)l * WG + c]; const float sc = 1.0f / (float)NF;
    { const int tz = otid() & 255; const int t0z = NTK * tz;
        float u0[NTK], u1[NTK], g0[NTK], g1[NTK]; hy_inputs<NTK>(HT + (size_t)c * T + rb0 + t0z, HT + (size_t)c * T + rb0 + t0z + TOK, cw, cb, c, t0z, u0, u1, g0, g1);
        float o0[NTK], o1[NTK];
#pragma unroll
        for (int i = 0; i < NTK; ++i) { const cpx y = buf[FPH(t0z + i)]; o0[i] = g0[i] * (y.x * sc + u0[i] * dsk); o1[i] = g1[i] * (y.y * sc + u1[i] * dsk); }
        bf16* d0 = (bf16*)(p.ws + WS_HT) + (size_t)(768 + c) * T + rb0 + t0z; bf16* d1 = d0 + TOK;
        if constexpr (NTK == 8) { *(u32x4*)d0 = pack8(o0); *(u32x4*)d1 = pack8(o1); }
        else {
#pragma unroll
            for (int i = 0; i < NTK; ++i) { d0[i] = f2bf(o0[i]); d1[i] = f2bf(o1[i]); } } }
}

constexpr int HCB = 16;
__device__ __forceinline__ void hyctx_task(const Params& p, int l, int b, int cblk, char* smem) {
    const int tid = otid(); const int c0 = cblk * HCB;
    const bf16* HT = (const bf16*)(p.ws + WS_HT); bf16* Y = (bf16*)(p.ws + WS_HNY); const float* HC = (const float*)(p.ws + WS_HC);
    float* raw = (float*)smem;
    float* u = raw + 4 * CTXL * HCB;
    float* og = u + CTXL * HCB;
    float* hcm = og + CTXL * HCB;
    bf16* ob = (bf16*)raw;
    const size_t rb = (size_t)b * TOK;
    const float* cw = p.in[I_HCW] + (size_t)l * 3 * 768; const float* cbias = p.in[I_HCB] + (size_t)l * 768;
    constexpr int WT = CTXL / 32;
    __syncthreads();
    for (int i = tid; i < 4 * HCB * (CTXL / 8); i += NT) { const int k = i / (HCB * (CTXL / 8)), cc = (i / (CTXL / 8)) % HCB, ck = i % (CTXL / 8);
        float f[8]; unpack8(*(const u32x4*)(HT + (size_t)(k * 256 + c0 + cc) * T + rb + ck * 8), f);
#pragma unroll
        for (int j = 0; j < 8; ++j) raw[(k * CTXL + ck * 8 + j) * HCB + cc] = f[j]; }
    for (int i = tid; i < 2 * HCB * (CTXL / 4); i += NT) { const int dir = i / (HCB * (CTXL / 4)), cc = (i / (CTXL / 4)) % HCB, pk = i % (CTXL / 4);
        const f32x4 v = *(const f32x4*)(HC + ((size_t)dir * WG + c0 + cc) * CTXL + pk * 4); const float f[4] = {v.x, v.y, v.z, v.w};
#pragma unroll
        for (int j = 0; j < 4; ++j) { const int pos = pk * 4 + j; if (dir == 0) hcm[(CTXL + pos) * HCB + cc] = f[j]; else if (pos > 0) hcm[(CTXL - pos) * HCB + cc] = f[j]; } }
    if (tid < HCB) hcm[tid] = 0.f;
    __syncthreads();
    for (int i = tid; i < CTXL * HCB; i += NT) { const int t = i / HCB, cc = i % HCB; float cv[3];
#pragma unroll
        for (int k = 0; k < 3; ++k) { const float* rk = raw + k * CTXL * HCB; const int ch = k * 256 + c0 + cc;
            const float a = t > 0 ? rk[(t - 1) * HCB + cc] : 0.f, m = rk[t * HCB + cc], z = t < CTXL - 1 ? rk[(t + 1) * HCB + cc] : 0.f;
            cv[k] = cw[0 * 768 + ch] * a + cw[1 * 768 + ch] * m + cw[2 * 768 + ch] * z + cbias[ch]; }
        u[i] = cv[0] * cv[1];
        og[i] = cv[2] * siluf_(raw[(3 * CTXL + t) * HCB + cc]); }
    __syncthreads();
    { const int cc = tid % HCB, tg = tid / HCB, t0 = WT * tg; float acc[WT], w[WT];
#pragma unroll
        for (int j = 0; j < WT; ++j) { acc[j] = 0.f; w[j] = hcm[(t0 + j + CTXL) * HCB + cc]; }
#pragma unroll 8
        for (int s = 0; s < CTXL; ++s) { const float us = u[s * HCB + cc];
#pragma unroll
            for (int j = 0; j < WT; ++j) acc[j] += us * w[j];
#pragma unroll
            for (int j = WT - 1; j > 0; --j) w[j] = w[j - 1];
            w[0] = hcm[(t0 - s - 1 + CTXL) * HCB + cc]; }
        const float dsk = p.in[I_HD][(size_t)l * WG + c0 + cc];
#pragma unroll
        for (int j = 0; j < WT; ++j) { const int t = t0 + j; ob[t * HCB + cc] = f2bf(og[t * HCB + cc] * (acc[j] + u[t * HCB + cc] * dsk)); } }
    __syncthreads();
    for (int i = tid; i < CTXL * 2; i += NT) { const int t = i >> 1, hh = i & 1; *(u32x4*)(Y + (rb + t) * 1024 + YH + c0 + 8 * hh) = *(const u32x4*)(ob + t * HCB + 8 * hh); }
}

__device__ __forceinline__ void attn_task(const Params& p, int l, int b, int kvh, int qt, bool ctxq, char* smem) {
    const int tid = otid(), lane = tid & 63, wave = tid >> 6, r = lane & 15, q = lane >> 4;
    const bf16* P = (const bf16*)(p.ws + WS_P); bf16* Y = (bf16*)(p.ws + WS_HNY); const cpx* ROPE = (const cpx*)(p.ws + WS_ROPE);
    bf16* Qs = (bf16*)smem;
    bf16* Ks = Qs + 256 * LS;
    bf16* Vt = Ks + 64 * LS;
    bf16* Ps = Vt + 64 * LS;
    const size_t rq0 = (size_t)b * TOK + (ctxq ? 0 : CTXL) + qt * 128;
    __syncthreads();
#pragma unroll
    for (int it = 0; it < 2; ++it) {
        const int idx = tid + NT * it, row = idx >> 2, cpair = idx & 3, g = row >> 7, t = row & 127;
        const bf16* src = P + (rq0 + t) * NP + PD + (kvh * 2 + g) * 64;
        float lo[8], hi[8]; unpack8(*(const u32x4*)(src + cpair * 8), lo); unpack8(*(const u32x4*)(src + 32 + cpair * 8), hi);
        float a[8], c2[8];
#pragma unroll
        for (int j = 0; j < 8; ++j) { float cs = 1.f, sn = 0.f; if (!ctxq) { const cpx cv = ROPE[(size_t)(qt * 128 + t) * 32 + cpair * 8 + j]; cs = cv.x; sn = cv.y; }
            a[j] = (lo[j] * cs - hi[j] * sn) * 0.125f; c2[j] = (hi[j] * cs + lo[j] * sn) * 0.125f; }
        *(u32x4*)(Qs + row * LS + cpair * 8) = pack8(a); *(u32x4*)(Qs + row * LS + 32 + cpair * 8) = pack8(c2);
    }
    const int lt0 = ctxq ? 0 : (2 * qt - 2 > 0 ? 2 * qt - 2 : 0), lt1 = ctxq ? -1 : (2 * qt + 3 < SEQ / 64 - 1 ? 2 * qt + 3 : SEQ / 64 - 1);
    const int nloc = lt1 - lt0 + 1, ntiles = nloc + NCC;
    float m[2], lsum[2]; f32x4 O[2][4];
#pragma unroll
    for (int ms = 0; ms < 2; ++ms) { m[ms] = -INFINITY; lsum[ms] = 0.f;
#pragma unroll
        for (int i = 0; i < 4; ++i) O[ms][i] = (f32x4){0.f, 0.f, 0.f, 0.f}; }
    const int g = wave >> 2, tq0 = (wave & 3) * 32;
    (void)Ps;
    __syncthreads();
    bf16x8 qf[2][2];
#pragma unroll
    for (int ms = 0; ms < 2; ++ms)
#pragma unroll
        for (int ks = 0; ks < 2; ++ks) qf[ms][ks] = *(const bf16x8*)(Qs + (g * 128 + tq0 + 16 * ms + r) * LS + ks * 32 + q * 8);
    u32x4 klo = {0u, 0u, 0u, 0u}, khi = klo, vq = klo; f32x4 rp[4] = {(f32x4){1.f, 0.f, 1.f, 0.f}, (f32x4){1.f, 0.f, 1.f, 0.f}, (f32x4){1.f, 0.f, 1.f, 0.f}, (f32x4){1.f, 0.f, 1.f, 0.f}};
    const int ks_ = tid >> 2, kcp = tid & 3, vs_ = tid >> 3, vc8 = tid & 7;
#define ATT_PREFETCH(TI) do { const bool loc_ = (TI) < nloc; const int kt_ = loc_ ? lt0 + (TI) : (TI) - nloc; const size_t rk_ = (size_t)b * TOK + (loc_ ? CTXL : 0) + kt_ * 64; \
        if (tid < 256) { const bf16* src_ = P + (rk_ + ks_) * NP + PD + 256 + kvh * 64; klo = *(const u32x4*)(src_ + kcp * 8); khi = *(const u32x4*)(src_ + 32 + kcp * 8); \
            if (loc_) { const f32x4* rr_ = (const f32x4*)(ROPE + (size_t)(kt_ * 64 + ks_) * 32 + kcp * 8); rp[0] = rr_[0]; rp[1] = rr_[1]; rp[2] = rr_[2]; rp[3] = rr_[3]; } \
            else { rp[0] = rp[1] = rp[2] = rp[3] = (f32x4){1.f, 0.f, 1.f, 0.f}; } } \
        vq = *(const u32x4*)(P + (rk_ + vs_) * NP + PD + 384 + kvh * 64 + vc8 * 8); } while (0)
    ATT_PREFETCH(0);
    for (int ti = 0; ti < ntiles; ++ti) {
        const bool local = ti < nloc; const int kt = local ? lt0 + ti : ti - nloc;
        __syncthreads();
        if (tid < 256) { float lo[8], hi[8]; unpack8(klo, lo); unpack8(khi, hi);
            const float cs[8] = {rp[0].x, rp[0].z, rp[1].x, rp[1].z, rp[2].x, rp[2].z, rp[3].x, rp[3].z}, sn[8] = {rp[0].y, rp[0].w, rp[1].y, rp[1].w, rp[2].y, rp[2].w, rp[3].y, rp[3].w};
            float a[8], c2[8];
#pragma unroll
            for (int j = 0; j < 8; ++j) { a[j] = lo[j] * cs[j] - hi[j] * sn[j]; c2[j] = hi[j] * cs[j] + lo[j] * sn[j]; }
            *(u32x4*)(Ks + ks_ * LS + kcp * 8) = pack8(a); *(u32x4*)(Ks + ks_ * LS + 32 + kcp * 8) = pack8(c2); }
        { const unsigned w[4] = {vq.x, vq.y, vq.z, vq.w};
#pragma unroll
            for (int j = 0; j < 4; ++j) { Vt[(vc8 * 8 + 2 * j) * LS + vs_] = (bf16)(w[j] & 0xffffu); Vt[(vc8 * 8 + 2 * j + 1) * LS + vs_] = (bf16)(w[j] >> 16); } }
        __syncthreads();
        if (ti + 1 < ntiles) ATT_PREFETCH(ti + 1);
#pragma unroll
        for (int ms = 0; ms < 2; ++ms) {
            const int qlo = qt * 128 + tq0 + 16 * ms, klo_ = kt * 64;
            if (local && (klo_ > qlo + 15 + 128 || klo_ + 63 < qlo - 128)) continue;
            f32x4 S[4] = {(f32x4){0.f, 0.f, 0.f, 0.f}, (f32x4){0.f, 0.f, 0.f, 0.f}, (f32x4){0.f, 0.f, 0.f, 0.f}, (f32x4){0.f, 0.f, 0.f, 0.f}};
#pragma unroll
            for (int ks = 0; ks < 2; ++ks)
#pragma unroll
                for (int nt = 0; nt < 4; ++nt) S[nt] = MFMA16(*(const bf16x8*)(Ks + (16 * nt + r) * LS + ks * 32 + q * 8), qf[ms][ks], S[nt]);
            const int qpos = qlo + r; float mx = -INFINITY;
#pragma unroll
            for (int nt = 0; nt < 4; ++nt)
#pragma unroll
                for (int i = 0; i < 4; ++i) { if (local) { const int d = kt * 64 + nt * 16 + 4 * q + i - qpos; if (d > 128 || d < -128) S[nt][i] = -INFINITY; } mx = fmaxf(mx, S[nt][i]); }
            mx = xrow_max(mx);
            const float mn = fmaxf(m[ms], mx); const float msafe = mn == -INFINITY ? 0.f : mn; const float alpha = __expf(m[ms] - msafe); float sm = 0.f;
#pragma unroll
            for (int nt = 0; nt < 4; ++nt)
#pragma unroll
                for (int i = 0; i < 4; ++i) { S[nt][i] = __expf(S[nt][i] - msafe); sm += S[nt][i]; }
            sm = xrow_sum(sm);
            lsum[ms] = lsum[ms] * alpha + sm; m[ms] = mn;
            const float pa[8] = {S[0][0], S[0][1], S[0][2], S[0][3], S[1][0], S[1][1], S[1][2], S[1][3]}, pb[8] = {S[2][0], S[2][1], S[2][2], S[2][3], S[3][0], S[3][1], S[3][2], S[3][3]};
            const bf16x8 p0 = as_frag(pack8(pa)), p1 = as_frag(pack8(pb));
#pragma unroll
            for (int me = 0; me < 4; ++me) { const bf16* vr = Vt + (16 * me + r) * LS + 4 * q;
                const u32x2 a0 = *(const u32x2*)(vr), a1 = *(const u32x2*)(vr + 16), a2 = *(const u32x2*)(vr + 32), a3 = *(const u32x2*)(vr + 48);
                u32x4 va; va.x = a0.x; va.y = a0.y; va.z = a1.x; va.w = a1.y; u32x4 vb; vb.x = a2.x; vb.y = a2.y; vb.z = a3.x; vb.w = a3.y;
                O[ms][me] = O[ms][me] * alpha;
                O[ms][me] = MFMA16(as_frag(va), p0, O[ms][me]); O[ms][me] = MFMA16(as_frag(vb), p1, O[ms][me]); }
        }
    }
#undef ATT_PREFETCH
    const float sink = p.in[I_SINK][(size_t)l * NH + kvh * 2 + g];
#pragma unroll
    for (int ms = 0; ms < 2; ++ms) { const float den = lsum[ms] + __expf(sink - m[ms]); const float inv = frcp_(den);
        const size_t row = rq0 + tq0 + 16 * ms + r; const int col = (kvh * 2 + g) * 64 + 4 * q;
#pragma unroll
        for (int me = 0; me < 4; ++me) { const u32x2 gg = *(const u32x2*)(P + row * NP + PD + 512 + col + 16 * me);
            const float g0 = bitsf(gg.x << 16), g1 = bitsf(gg.x & 0xffff0000u), g2 = bitsf(gg.y << 16), g3 = bitsf(gg.y & 0xffff0000u);
            u32x2 o; o.x = pk2(O[ms][me][0] * inv * siluf_(g0), O[ms][me][1] * inv * siluf_(g1)); o.y = pk2(O[ms][me][2] * inv * siluf_(g2), O[ms][me][3] * inv * siluf_(g3));
            *(u32x2*)(Y + row * 1024 + YD + col + 16 * me) = o; } }
}

#ifdef EMU
__device__ __forceinline__ int olane(int lane) { return lane; }
#else
__device__ __forceinline__ int olane(int lane) { asm volatile("" : "+v"(lane)); return lane; }
#endif
__device__ __forceinline__ void load_nat_tile(const bf16* P, int row0, int col0, bf16* tile, int lane) {
    u32x4 v[8];
#pragma unroll
    for (int i = 0; i < 8; ++i) v[i] = *(const u32x4*)(P + (size_t)(row0 + (lane >> 3) + 8 * i) * NP + col0 + (lane & 7) * 8);
#pragma unroll
    for (int i = 0; i < 8; ++i) *(u32x4*)(tile + swz((lane >> 3) + 8 * i, lane & 7)) = v[i];
}
__device__ __forceinline__ bf16x8 frag_tr(const bf16* tile, int c0, int k0, int lane) {
    const int c = c0 + (lane & 15), kb = k0 + 8 * (lane >> 4); unsigned w[4];
#pragma unroll
    for (int j = 0; j < 4; ++j) w[j] = (unsigned)tile[swz(kb + 2 * j, c >> 3) + (c & 7)] | ((unsigned)tile[swz(kb + 2 * j + 1, c >> 3) + (c & 7)] << 16);
    u32x4 o; o.x = w[0]; o.y = w[1]; o.z = w[2]; o.w = w[3]; return as_frag(o);
}
template <int DIR>
__device__ __forceinline__ void gla_r_frags(const float* Grow0, int lane, bf16x8 (&af)[4]) {
    const int r = lane & 15, q4 = lane >> 4;
#pragma unroll
    for (int mt = 0; mt < 4; ++mt) { u32x4 o = {0u, 0u, 0u, 0u};
        if (q4 < 2) o = *(const u32x4*)((const bf16*)(Grow0 + (size_t)(16 * mt + r) * NGS + 16) + DIR * 16 + 8 * q4);
        af[mt] = as_frag(o); }
}
template <int DIR>
__device__ __forceinline__ float gla_b_col(const Params& p, int l, int h, const bf16x8 (&af)[4], int nt, int lane_, float (&x)[4][4]) {
    const int lane = olane(lane_), r = lane & 15, q4 = lane >> 4, d = h * 64 + 16 * nt + r;
    u32x4 o = {0u, 0u, 0u, 0u};
    if (q4 < 2) { const float* wa = p.in[I_GWA] + ((size_t)(l * 2 + DIR) * 16 + 8 * q4) * WG + d;
        o.x = pk2(wa[0], wa[WG]); o.y = pk2(wa[2 * WG], wa[3 * WG]); o.z = pk2(wa[4 * WG], wa[5 * WG]); o.w = pk2(wa[6 * WG], wa[7 * WG]); }
    const bf16x8 bfr = as_frag(o); const float bias = p.in[I_GBA][(size_t)(l * 2 + DIR) * WG + d];
#pragma unroll
    for (int mt = 0; mt < 4; ++mt) { f32x4 c = {bias, bias, bias, bias}; c = MFMA16(af[mt], bfr, c);
#pragma unroll
        for (int i = 0; i < 4; ++i) x[mt][i] = logsig_fast(c[i]) * (1.0f / 16.0f); }
    float carry = 0.f;
#pragma unroll
    for (int k = 0; k < 4; ++k) { const int mt = DIR == 0 ? k : 3 - k; float* y = x[mt];
        if (DIR == 0) { y[1] += y[0]; y[2] += y[1]; y[3] += y[2]; } else { y[2] += y[3]; y[1] += y[2]; y[0] += y[1]; }
        const float s4 = DIR == 0 ? y[3] : y[0];
        const float t1 = DIR == 0 ? __shfl_up(s4, 16) : __shfl_down(s4, 16), t2 = DIR == 0 ? __shfl_up(s4, 32) : __shfl_down(s4, 32), t3 = DIR == 0 ? __shfl_up(s4, 48) : __shfl_down(s4, 48);
        const int qq = DIR == 0 ? q4 : 3 - q4;
        const float e = (qq >= 1 ? t1 : 0.f) + (qq >= 2 ? t2 : 0.f) + (qq >= 3 ? t3 : 0.f);
        const float tot = __shfl(e + s4, DIR == 0 ? r + 48 : r);
#pragma unroll
        for (int i = 0; i < 4; ++i) y[i] += carry + e;
        carry += tot; }
    return carry;
}

template <int MIXER, int DIR>
__device__ __forceinline__ void chunkst_dir(const Params& p, int l, int b, int h, int cid, const float* Grow0, const unsigned (&kk)[32], const bf16* Vt, bf16* Kt, const float* wvs, float* bendl, int lane_) {
    const int lane = olane(lane_), r = lane & 15, q4 = lane >> 4;
    if constexpr (MIXER == 0) {
        float nacc = 0.f;
#pragma unroll
        for (int c = 0; c < 8; ++c) { float f[8];
#pragma unroll
            for (int j = 0; j < 8; ++j) { const int s = 8 * c + j; const float kv = (s & 1) ? bitsf(kk[s >> 1] & 0xffff0000u) : bitsf(kk[s >> 1] << 16);
                f[j] = kv * 0.125f * wvs[DIR * 64 + s]; nacc += f[j]; }
            *(u32x4*)(Kt + swz(lane, c)) = pack8(f); }
        ((float*)(p.ws + WS_NV))[ch_index(DIR, b, h, cid) * 64 + lane] = nacc;
    } else {
        const bf16* P = (const bf16*)(p.ws + WS_P); const int kcol = PG + 256 + h * 64; const int r0 = b * TOK + cid * 64;
        bf16x8 af[4]; gla_r_frags<DIR>(Grow0, lane, af);
#pragma unroll 2
        for (int nt = 0; nt < 4; ++nt) { const int d = 16 * nt + r; float x[4][4];
            const float bend = gla_b_col<DIR>(p, l, h, af, nt, lane, x);
            if (q4 == 0) { ((float*)(p.ws + WS_BE))[ch_index(DIR, b, h, cid) * 64 + d] = bend; bendl[d] = __expf(fmaxf(bend, -80.0f)); }
#pragma unroll
            for (int mt = 0; mt < 4; ++mt)
#pragma unroll
                for (int i = 0; i < 4; ++i) { const int s = 16 * mt + 4 * q4 + i; const float kv = bf2f(P[(size_t)(r0 + s) * NP + kcol + d]); const float bc = fmaxf(x[mt][i], -80.0f);
                    Kt[swz(d, s >> 3) + (s & 7)] = f2bf(kv * __expf(-bc));
                    ((bf16*)(p.ws + WS_EQ))[((size_t)DIR * T + r0 + s) * WG + h * 64 + d] = f2bf(__expf(bc)); } }
    }
    WAVE_SYNC();
    bf16x8 vf[4][2];
#pragma unroll
    for (int ne = 0; ne < 4; ++ne)
#pragma unroll
        for (int ks = 0; ks < 2; ++ks) vf[ne][ks] = *(const bf16x8*)(Vt + swz(16 * ne + r, ks * 4 + q4));
    bf16* dst = (bf16*)(p.ws + WS_ST) + st_index(MIXER, DIR, b, h, cid) * 4096;
#pragma unroll
    for (int me = 0; me < 4; ++me) {
        f32x4 acc[4] = {(f32x4){0.f, 0.f, 0.f, 0.f}, (f32x4){0.f, 0.f, 0.f, 0.f}, (f32x4){0.f, 0.f, 0.f, 0.f}, (f32x4){0.f, 0.f, 0.f, 0.f}};
#pragma unroll
        for (int ks = 0; ks < 2; ++ks) { const bf16x8 a = *(const bf16x8*)(Kt + swz(16 * me + r, ks * 4 + q4));
#pragma unroll
            for (int ne = 0; ne < 4; ++ne) acc[ne] = MFMA16(a, vf[ne][ks], acc[ne]); }
        f32x4 sc4 = {1.f, 1.f, 1.f, 1.f}; if constexpr (MIXER == 1) sc4 = *(const f32x4*)(bendl + 16 * me + 4 * q4);
#pragma unroll
        for (int ne = 0; ne < 4; ++ne) { const f32x4 v = acc[ne] * sc4; u32x2 o; o.x = pk2(v[0], v[1]); o.y = pk2(v[2], v[3]); *(u32x2*)(dst + (16 * ne + r) * 64 + 16 * me + 4 * q4) = o; }
    }
    WAVE_SYNC();
}
template <int MIXER>
__device__ __forceinline__ void chunkst_w(const Params& p, int l, int b, int h, int cid, char* wl, int lane) {
    const bf16* P = (const bf16*)(p.ws + WS_P); const float* G = (const float*)(p.ws + WS_G);
    const int r0 = b * TOK + cid * 64, r = lane & 15, q4 = lane >> 4;
    bf16* Kt = (bf16*)wl;
    bf16* Vt = Kt + 4096;
    float* wvs = (float*)(Vt + 4096);
    float* bendl = wvs + 128;
    const int kcol = (MIXER == 0 ? PA : PG) + 256 + h * 64, vcol = (MIXER == 0 ? PA : PG) + 512 + h * 64;
    const float* Grow0 = G + (size_t)r0 * NGS;
    { bf16* Nn = Kt;
        load_nat_tile(P, r0, vcol, Nn, lane);
        WAVE_SYNC();
#pragma unroll
        for (int c = 0; c < 8; ++c) { unsigned w[4];
#pragma unroll
            for (int j = 0; j < 4; ++j) w[j] = (unsigned)Nn[swz(8 * c + 2 * j, lane >> 3) + (lane & 7)] | ((unsigned)Nn[swz(8 * c + 2 * j + 1, lane >> 3) + (lane & 7)] << 16);
            u32x4 o; o.x = w[0]; o.y = w[1]; o.z = w[2]; o.w = w[3]; *(u32x4*)(Vt + swz(lane, c)) = o; }
        WAVE_SYNC();
        load_nat_tile(P, r0, kcol, Nn, lane);
        WAVE_SYNC(); }
    unsigned kk[32];
    { const bf16* Nn = Kt;
#pragma unroll
        for (int i = 0; i < 32; ++i) kk[i] = (unsigned)Nn[swz(2 * i, lane >> 3) + (lane & 7)] | ((unsigned)Nn[swz(2 * i + 1, lane >> 3) + (lane & 7)] << 16); }
    WAVE_SYNC();
    if constexpr (MIXER == 0) {
        const float* g = Grow0 + (size_t)lane * NGS; const float* gb = p.in[I_MGB] + (size_t)l * 16;
        const float i_f = g[h] + gb[h], f_f = g[4 + h] + gb[4 + h], i_b = g[8 + h] + gb[8 + h], f_b = g[12 + h] + gb[12 + h];
        const float lf = logsigf_(f_f), lb = logsigf_(f_b);
        const float bF = wave_prefix_sum(lf, lane), totF = __shfl(bF, 63);
        const float gF = totF - bF + i_f, mF = wave_max(gF);
        const float totB = wave_sum(lb), preB = wave_prefix_sum(lb, lane), bB = totB - preB + lb;
        const float gB = totB - bB + i_b, mB = wave_max(gB);
        wvs[lane] = __expf(gF - mF); wvs[64 + lane] = __expf(gB - mB);
        if (lane == 0) { float* SC = (float*)(p.ws + WS_SC);
            SC[ch_index(0, b, h, cid) * 4 + 0] = totF; SC[ch_index(0, b, h, cid) * 4 + 1] = mF;
            SC[ch_index(1, b, h, cid) * 4 + 0] = totB; SC[ch_index(1, b, h, cid) * 4 + 1] = mB; }
    }
    WAVE_SYNC();
    chunkst_dir<MIXER, 0>(p, l, b, h, cid, Grow0, kk, Vt, Kt, wvs, bendl, lane);
    chunkst_dir<MIXER, 1>(p, l, b, h, cid, Grow0, kk, Vt, Kt, wvs, bendl, lane);
}

template <int DIR>
__device__ __forceinline__ void chunkst_gla(const Params& p, int l, int b, int h, int cid, char* wl, int lane_) {
    const bf16* P = (const bf16*)(p.ws + WS_P);
    const int lane = olane(lane_), r0 = b * TOK + cid * 64, r = lane & 15, q4 = lane >> 4;
    bf16* Kt = (bf16*)wl;
    bf16* An = Kt + 4096;
    float* bendl = (float*)(An + 4096);
    const int kcol = PG + 256 + h * 64, vcol = PG + 512 + h * 64;
    const float* Grow0 = (const float*)(p.ws + WS_G) + (size_t)r0 * NGS;
    load_nat_tile(P, r0, vcol, An, lane);
    WAVE_SYNC();
    bf16x8 vf[4][2];
#pragma unroll
    for (int ne = 0; ne < 4; ++ne)
#pragma unroll
        for (int ks = 0; ks < 2; ++ks) vf[ne][ks] = frag_tr(An, 16 * ne, 32 * ks, lane);
    WAVE_SYNC();
    load_nat_tile(P, r0, kcol, An, lane);
    WAVE_SYNC();
    bf16x8 af[4]; gla_r_frags<DIR>(Grow0, lane, af);
#pragma unroll 2
    for (int nt = 0; nt < 4; ++nt) { const int d = 16 * nt + r; float x[4][4];
        const float bend = gla_b_col<DIR>(p, l, h, af, nt, lane, x);
        if (q4 == 0) { ((float*)(p.ws + WS_BE))[ch_index(DIR, b, h, cid) * 64 + d] = bend; bendl[d] = __expf(fmaxf(bend, -80.0f)); }
#pragma unroll
        for (int mt = 0; mt < 4; ++mt)
#pragma unroll
            for (int i = 0; i < 4; ++i) { const int s = 16 * mt + 4 * q4 + i; bf16* ke = An + swz(s, d >> 3) + (d & 7); const float kv = bf2f(*ke); const float bc = fmaxf(x[mt][i], -80.0f);
                Kt[swz(d, s >> 3) + (s & 7)] = f2bf(kv * __expf(-bc));
                *ke = f2bf(__expf(bc)); } }
    WAVE_SYNC();
    { bf16* EQg = (bf16*)(p.ws + WS_EQ) + ((size_t)DIR * T + r0) * WG + h * 64;
#pragma unroll
        for (int i = 0; i < 8; ++i) { const int s = (lane >> 3) + 8 * i, ck = lane & 7; *(u32x4*)(EQg + (size_t)s * WG + ck * 8) = *(const u32x4*)(An + swz(s, ck)); } }
    bf16* dst = (bf16*)(p.ws + WS_ST) + st_index(1, DIR, b, h, cid) * 4096;
#pragma unroll
    for (int me = 0; me < 4; ++me) {
        f32x4 acc[4] = {(f32x4){0.f, 0.f, 0.f, 0.f}, (f32x4){0.f, 0.f, 0.f, 0.f}, (f32x4){0.f, 0.f, 0.f, 0.f}, (f32x4){0.f, 0.f, 0.f, 0.f}};
#pragma unroll
        for (int ks = 0; ks < 2; ++ks) { const bf16x8 a = *(const bf16x8*)(Kt + swz(16 * me + r, ks * 4 + q4));
#pragma unroll
            for (int ne = 0; ne < 4; ++ne) acc[ne] = MFMA16(a, vf[ne][ks], acc[ne]); }
        const f32x4 sc4 = *(const f32x4*)(bendl + 16 * me + 4 * q4);
#pragma unroll
        for (int ne = 0; ne < 4; ++ne) { const f32x4 v = acc[ne] * sc4; u32x2 o; o.x = pk2(v[0], v[1]); o.y = pk2(v[2], v[3]); *(u32x2*)(dst + (16 * ne + r) * 64 + 16 * me + 4 * q4) = o; }
    }
    WAVE_SYNC();
}

template <int MIXER, int DIR>
__device__ __forceinline__ void chunkout_prep(const Params& p, int l, int b, int h, int cid, const float* Grow0, int r0, int pbase, const bf16* EQ, float* gar, int lane_) {
    const int lane = olane(lane_);
    if constexpr (MIXER == 0) {
        const bf16* P = (const bf16*)(p.ws + WS_P);
        const float* g = Grow0 + (size_t)lane * NGS; const float* gb = p.in[I_MGB] + (size_t)l * 16;
        const float ig = g[DIR * 8 + h] + gb[DIR * 8 + h], fg = g[DIR * 8 + 4 + h] + gb[DIR * 8 + 4 + h];
        const float mprev = ((const float*)(p.ws + WS_SC))[ch_index(DIR, b, h, cid) * 4 + 2];
        const float lf = logsigf_(fg); float bb;
        if (DIR == 0) bb = wave_prefix_sum(lf, lane); else { const float tt = wave_sum(lf), pre = wave_prefix_sum(lf, lane); bb = tt - pre + lf; }
        const float a = ig - bb; const float pm = DIR == 0 ? wave_prefix_max(a, lane) : wave_suffix_max(a, lane);
        const float mt_ = fmaxf(bb + mprev, bb + pm);
        float* ga = gar + DIR * 320;
        ga[lane] = bb - mt_; ga[64 + lane] = a; ga[128 + lane] = __expf(bb + mprev - mt_); ga[192 + lane] = __expf(-mt_);
        float* nvl = gar + 640 + DIR * 64;
        nvl[lane] = ((const float*)(p.ws + WS_NV))[ch_index(DIR, b, h, cid) * 64 + lane];
        WAVE_SYNC();
        float dq = 0.f;
#pragma unroll
        for (int c = 0; c < 8; ++c) { float f[8]; unpack8(*(const u32x4*)(P + (size_t)(r0 + lane) * NP + pbase + c * 8), f);
            const f32x4 n0 = *(const f32x4*)(nvl + c * 8), n1 = *(const f32x4*)(nvl + c * 8 + 4);
            dq += f[0] * n0.x + f[1] * n0.y + f[2] * n0.z + f[3] * n0.w + f[4] * n1.x + f[5] * n1.y + f[6] * n1.z + f[7] * n1.w; }
        ga[256 + lane] = dq;
    }
}
template <int MIXER, int DIR, int NS>
__device__ __forceinline__ void chunkout_dir(const Params& p, int b, int h, int cid, int r0, int pbase, int th, const bf16x8 (&vtf)[4][2], const bf16* VtL, const bf16* EQ, bf16* SB, const float* gar, float* rsm, f32x4 (&htot)[NS][4], int lane_) {
    const bf16* P = (const bf16*)(p.ws + WS_P); const bf16* ST = (const bf16*)(p.ws + WS_ST);
    const int lane = olane(lane_), r = lane & 15, q4 = lane >> 4;
    const bf16* E = EQ + ((size_t)DIR * T + r0) * WG + h * 64;
    const float* ga = gar + DIR * 320;
    bf16x8 kf[4][2], ctf[4][2];
#pragma unroll
    for (int n = 0; n < 4; ++n)
#pragma unroll
        for (int ks = 0; ks < 2; ++ks) { if constexpr (MIXER == 0) kf[n][ks] = vtf[n][ks];
            else kf[n][ks] = *(const bf16x8*)(P + (size_t)(r0 + 16 * n + r) * NP + pbase + 256 + ks * 32 + q4 * 8);
            ctf[n][ks] = *(const bf16x8*)(ST + st_index(MIXER, DIR, b, h, cid) * 4096 + (16 * n + r) * 64 + ks * 32 + q4 * 8);
            if constexpr (MIXER == 1) { float fe[8], fk[8]; unpack8(*(const u32x4*)(E + (size_t)(16 * n + r) * WG + ks * 32 + q4 * 8), fe); unpack8(as_u4(kf[n][ks]), fk);
#pragma unroll
                for (int j = 0; j < 8; ++j) fk[j] = fk[j] * frcp_(fe[j]);
                kf[n][ks] = as_frag(pack8(fk)); } }
#pragma unroll
    for (int ms = 0; ms < NS; ++ms) { const int mt = NS * th + ms;
        bf16x8 qf[2];
#pragma unroll
        for (int ks = 0; ks < 2; ++ks) { qf[ks] = *(const bf16x8*)(P + (size_t)(r0 + 16 * mt + r) * NP + pbase + ks * 32 + q4 * 8);
            if constexpr (MIXER == 1) { float fe[8], fq[8]; unpack8(*(const u32x4*)(E + (size_t)(16 * mt + r) * WG + ks * 32 + q4 * 8), fe); unpack8(as_u4(qf[ks]), fq);
#pragma unroll
                for (int j = 0; j < 8; ++j) fq[j] *= 0.125f * fe[j];
                qf[ks] = as_frag(pack8(fq)); } }
        f32x4 S[4] = {(f32x4){0.f, 0.f, 0.f, 0.f}, (f32x4){0.f, 0.f, 0.f, 0.f}, (f32x4){0.f, 0.f, 0.f, 0.f}, (f32x4){0.f, 0.f, 0.f, 0.f}};
#pragma unroll
        for (int ks = 0; ks < 2; ++ks)
#pragma unroll
            for (int n = 0; n < 4; ++n) S[n] = MFMA16(qf[ks], kf[n][ks], S[n]);
#pragma unroll
        for (int i = 0; i < 4; ++i) { const int t = 16 * mt + 4 * q4 + i; float sm = 0.f;
#pragma unroll
            for (int n = 0; n < 4; ++n) { const int s = 16 * n + r; const bool ok = DIR == 0 ? (s <= t) : (s >= t); float v = 0.f;
                if (ok) { if constexpr (MIXER == 0) v = S[n][i] * 0.125f * __expf(ga[t] + ga[64 + s]); else v = S[n][i]; }
                SB[swz(4 * q4 + i, s >> 3) + (s & 7)] = f2bf(v); sm += v; }
            if constexpr (MIXER == 0) { sm = row16_sum(sm); if (r == 0) rsm[4 * q4 + i] = sm; } }
        WAVE_SYNC();
        const bf16x8 sm0 = *(const bf16x8*)(SB + swz(r, q4)), sm1 = *(const bf16x8*)(SB + swz(r, 4 + q4));
        float wi = 1.f, inv = 1.f;
        if constexpr (MIXER == 0) { const int tt = 16 * mt + r; wi = ga[128 + tt]; const float den = wi * ga[256 + tt] + rsm[r]; inv = frcp_(fmaxf(fabsf(den), ga[192 + tt])); }
#pragma unroll
        for (int me = 0; me < 4; ++me) { f32x4 a1 = {0.f, 0.f, 0.f, 0.f}, a2 = {0.f, 0.f, 0.f, 0.f};
            a1 = MFMA16(*(const bf16x8*)(VtL + swz(16 * me + r, q4)), sm0, a1); a1 = MFMA16(*(const bf16x8*)(VtL + swz(16 * me + r, 4 + q4)), sm1, a1);
            a2 = MFMA16(ctf[me][0], qf[0], a2); a2 = MFMA16(ctf[me][1], qf[1], a2);
            if constexpr (MIXER == 0) htot[ms][me] += (a1 + a2 * wi) * inv; else htot[ms][me] += a1 + a2; }
        WAVE_SYNC();
    }
}
__device__ __forceinline__ void co_build_vt(const bf16* P, int r0, int vcol, bf16* VtL, int lane) {
    bf16* Nn = VtL + 4096;
#pragma unroll
    for (int hh = 0; hh < 2; ++hh) {
        u32x4 v[4];
#pragma unroll
        for (int i = 0; i < 4; ++i) v[i] = *(const u32x4*)(P + (size_t)(r0 + 32 * hh + (lane >> 3) + 8 * i) * NP + vcol + (lane & 7) * 8);
#pragma unroll
        for (int i = 0; i < 4; ++i) *(u32x4*)(Nn + swz((lane >> 3) + 8 * i, lane & 7)) = v[i];
        WAVE_SYNC();
#pragma unroll
        for (int c = 0; c < 4; ++c) { unsigned w[4];
#pragma unroll
            for (int j = 0; j < 4; ++j) w[j] = (unsigned)Nn[swz(8 * c + 2 * j, lane >> 3) + (lane & 7)] | ((unsigned)Nn[swz(8 * c + 2 * j + 1, lane >> 3) + (lane & 7)] << 16);
            u32x4 o; o.x = w[0]; o.y = w[1]; o.z = w[2]; o.w = w[3]; *(u32x4*)(VtL + swz(lane, 4 * hh + c)) = o; }
        WAVE_SYNC(); }
}
template <int MIXER, int NS>
__device__ __forceinline__ void co_finalize(const Params& p, int l, int h, int r0, int pbase, int mt0, f32x4 (&htot)[NS][4], int lane_) {
    const bf16* P = (const bf16*)(p.ws + WS_P); bf16* Y = (bf16*)(p.ws + WS_HNY);
    const float* ngp = p.in[MIXER == 0 ? I_MNG : I_GNG] + (size_t)l * WG + h * 64;
    const int lz = olane(lane_), r = lz & 15, q4 = lz >> 4;
    u32x2 gq[NS][4], oq[NS][4];
#pragma unroll
    for (int ms = 0; ms < NS; ++ms)
#pragma unroll
        for (int me = 0; me < 4; ++me) { const size_t off = (size_t)(r0 + 16 * (mt0 + ms) + r) * NP + pbase + 16 * me + 4 * q4;
            gq[ms][me] = *(const u32x2*)(P + off + (MIXER == 0 ? 1024 : 768)); if constexpr (MIXER == 0) oq[ms][me] = *(const u32x2*)(P + off + 768); else oq[ms][me] = (u32x2){0u, 0u}; }
#pragma unroll
    for (int ms = 0; ms < NS; ++ms) { const int mt = mt0 + ms; float ss = 0.f; float gv[4][4];
#pragma unroll
        for (int me = 0; me < 4; ++me) {
            gv[me][0] = bitsf(gq[ms][me].x << 16); gv[me][1] = bitsf(gq[ms][me].x & 0xffff0000u); gv[me][2] = bitsf(gq[ms][me].y << 16); gv[me][3] = bitsf(gq[ms][me].y & 0xffff0000u);
            if constexpr (MIXER == 0) { htot[ms][me][0] *= sigmoidf_(bitsf(oq[ms][me].x << 16)); htot[ms][me][1] *= sigmoidf_(bitsf(oq[ms][me].x & 0xffff0000u)); htot[ms][me][2] *= sigmoidf_(bitsf(oq[ms][me].y << 16)); htot[ms][me][3] *= sigmoidf_(bitsf(oq[ms][me].y & 0xffff0000u)); }
            ss += htot[ms][me][0] * htot[ms][me][0] + htot[ms][me][1] * htot[ms][me][1] + htot[ms][me][2] * htot[ms][me][2] + htot[ms][me][3] * htot[ms][me][3]; }
        ss = xrow_sum(ss);
        const float rstd = rsqrtf(ss * (1.0f / 64.0f) + EPS);
#pragma unroll
        for (int me = 0; me < 4; ++me) { const int e = 16 * me + 4 * q4; const f32x4 n4 = *(const f32x4*)(ngp + e);
            u32x2 o; o.x = pk2(htot[ms][me][0] * rstd * n4.x * siluf_(gv[me][0]), htot[ms][me][1] * rstd * n4.y * siluf_(gv[me][1]));
            o.y = pk2(htot[ms][me][2] * rstd * n4.z * siluf_(gv[me][2]), htot[ms][me][3] * rstd * n4.w * siluf_(gv[me][3]));
            *(u32x2*)(Y + (size_t)(r0 + 16 * mt + r) * 1024 + (MIXER == 0 ? YA : YG) + h * 64 + e) = o; } }
}
template <int MIXER>
__device__ __forceinline__ void chunkout_w(const Params& p, int l, int b, int h, int cid, char* wl, int lane) {
    const bf16* P = (const bf16*)(p.ws + WS_P); const float* G = (const float*)(p.ws + WS_G);
    const int r0 = b * TOK + cid * 64;
    const int pbase = (MIXER == 0 ? PA : PG) + h * 64;
    bf16* SB = (bf16*)wl;
    float* rsm = (float*)(SB + 1024);
    float* gar = rsm + 16;
    const bf16* EQ = (const bf16*)(p.ws + WS_EQ);
    const float* Grow0 = G + (size_t)r0 * NGS;
    bf16* VtL = (bf16*)(gar + 768);
    bf16x8 vtf[4][2];
#pragma unroll
    for (int me = 0; me < 4; ++me)
#pragma unroll
        for (int ks = 0; ks < 2; ++ks) { if constexpr (MIXER == 0) vtf[me][ks] = *(const bf16x8*)(P + (size_t)(r0 + 16 * me + (lane & 15)) * NP + pbase + 256 + ks * 32 + (lane >> 4) * 8); else vtf[me][ks] = (bf16x8){0, 0, 0, 0, 0, 0, 0, 0}; }
    co_build_vt(P, r0, pbase + 512, VtL, lane);
    chunkout_prep<MIXER, 0>(p, l, b, h, cid, Grow0, r0, pbase, EQ, gar, lane);
    chunkout_prep<MIXER, 1>(p, l, b, h, cid, Grow0, r0, pbase, EQ, gar, lane);
    WAVE_SYNC();
    constexpr int NS = MIXER == 1 ? 2 : 1;
#pragma unroll 1
    for (int th = 0; th < 4 / NS; ++th) {
        f32x4 htot[NS][4];
#pragma unroll
        for (int a = 0; a < NS; ++a)
#pragma unroll
            for (int c = 0; c < 4; ++c) htot[a][c] = (f32x4){0.f, 0.f, 0.f, 0.f};
        chunkout_dir<MIXER, 0, NS>(p, b, h, cid, r0, pbase, th, vtf, VtL, EQ, SB, gar, rsm, htot, lane);
        chunkout_dir<MIXER, 1, NS>(p, b, h, cid, r0, pbase, th, vtf, VtL, EQ, SB, gar, rsm, htot, lane);
        co_finalize<MIXER, NS>(p, l, h, r0, pbase, NS * th, htot, lane);
    }
}
constexpr int CO_PART = 13376;
template <int MIXER, int DIR>
__device__ __forceinline__ void chunkout_piece(const Params& p, int l, int b, int h, int cid, int mt, char* wl, int lane) {
    const bf16* P = (const bf16*)(p.ws + WS_P); const float* G = (const float*)(p.ws + WS_G);
    const int r0 = b * TOK + cid * 64; const int pbase = (MIXER == 0 ? PA : PG) + h * 64;
    bf16* SB = (bf16*)wl; float* rsm = (float*)(SB + 1024); float* gar = rsm + 16; const bf16* EQ = (const bf16*)(p.ws + WS_EQ);
    const float* Grow0 = G + (size_t)r0 * NGS; bf16* VtL = (bf16*)(gar + 768);
    bf16x8 vtf[4][2];
#pragma unroll
    for (int me = 0; me < 4; ++me)
#pragma unroll
        for (int ks = 0; ks < 2; ++ks) { if constexpr (MIXER == 0) vtf[me][ks] = *(const bf16x8*)(P + (size_t)(r0 + 16 * me + (lane & 15)) * NP + pbase + 256 + ks * 32 + (lane >> 4) * 8); else vtf[me][ks] = (bf16x8){0, 0, 0, 0, 0, 0, 0, 0}; }
    co_build_vt(P, r0, pbase + 512, VtL, lane);
    chunkout_prep<MIXER, DIR>(p, l, b, h, cid, Grow0, r0, pbase, EQ, gar, lane);
    WAVE_SYNC();
    f32x4 htot[1][4] = {{(f32x4){0.f, 0.f, 0.f, 0.f}, (f32x4){0.f, 0.f, 0.f, 0.f}, (f32x4){0.f, 0.f, 0.f, 0.f}, (f32x4){0.f, 0.f, 0.f, 0.f}}};
    chunkout_dir<MIXER, DIR, 1>(p, b, h, cid, r0, pbase, mt, vtf, VtL, EQ, SB, gar, rsm, htot, lane);
    float* part = (float*)(wl + CO_PART);
#pragma unroll
    for (int me = 0; me < 4; ++me)
#pragma unroll
        for (int i = 0; i < 4; ++i) part[(me * 4 + i) * 64 + lane] = htot[0][me][i];
}
template <int MIXER>
__device__ __forceinline__ void chunkout_combine(const Params& p, int l, int b, int h, int cid, int mt, const char* smem, int lane) {
    const float* pa = (const float*)(smem + (2 * mt) * WLDS + CO_PART); const float* pb = (const float*)(smem + (2 * mt + 1) * WLDS + CO_PART);
    f32x4 htot[1][4];
#pragma unroll
    for (int me = 0; me < 4; ++me)
#pragma unroll
        for (int i = 0; i < 4; ++i) htot[0][me][i] = pa[(me * 4 + i) * 64 + lane] + pb[(me * 4 + i) * 64 + lane];
    co_finalize<MIXER, 1>(p, l, h, b * TOK + cid * 64, (MIXER == 0 ? PA : PG) + h * 64, mt, htot, lane);
}

template <bool OUT>
__device__ __forceinline__ void chunk_workers(const Params& p, int l, char* smem) {
    const int tid = otid(), lane = tid & 63, wave = __builtin_amdgcn_readfirstlane(tid >> 6);
    const int NW = (int)gridDim.x * 8, wi = wave * (int)gridDim.x + obid();
    const int c_lo = (OUT && l == DEPTH - 1) ? NCC : 0, npc = NCH - c_lo, half = NB * NH * npc;
    char* wl = smem + wave * WLDS;
    if (OUT) {
        const int cl = NCC, npl = NCH - NCC, halfl = NB * NH * npl;
#pragma unroll 1
        for (int t = wi; t < halfl; t += NW) { const int b = t / (NH * npl), h = (t / npl) % NH, cid = cl + t % npl;
            const Params q = relaunder(p); chunkout_w<1>(q, l, b, h, cid, wl, lane); }
        { const int used = halfl % NW;
#pragma unroll 1
            for (int t = (wi + NW - used) % NW; t < halfl; t += NW) { const int b = t / (NH * npl), h = (t / npl) % NH, cid = cl + t % npl;
                const Params q = relaunder(p); chunkout_w<0>(q, l, b, h, cid, wl, lane); } }
        if (l < DEPTH - 1) {
            const int nct = NB * NH * NCC;
#pragma unroll 1
            for (int st = obid(); st < 2 * nct; st += (int)gridDim.x) { const int mixer = st / nct, r2 = st % nct, b = r2 / (NH * NCC), h = (r2 / NCC) % NH, cid = r2 % NCC;
                const Params q = relaunder(p); const int mt = wave >> 1;
                __syncthreads();
                if (mixer == 0) { if (wave & 1) chunkout_piece<0, 1>(q, l, b, h, cid, mt, wl, lane); else chunkout_piece<0, 0>(q, l, b, h, cid, mt, wl, lane); }
                else            { if (wave & 1) chunkout_piece<1, 1>(q, l, b, h, cid, mt, wl, lane); else chunkout_piece<1, 0>(q, l, b, h, cid, mt, wl, lane); }
                __syncthreads();
                if (wave < 4) { if (mixer == 0) chunkout_combine<0>(q, l, b, h, cid, wave, smem, lane); else chunkout_combine<1>(q, l, b, h, cid, wave, smem, lane); }
            }
        }
    } else {
        int off = 0;
#pragma unroll 1
        for (int t = wi; t < half; t += NW) { const int b = t / (NH * npc), h = (t / npc) % NH, cid = c_lo + t % npc;
            const Params q = relaunder(p); chunkst_gla<0>(q, l, b, h, cid, wl, lane); }
        off = (off + half) % NW;
#pragma unroll 1
        for (int t = (wi + NW - off) % NW; t < half; t += NW) { const int b = t / (NH * npc), h = (t / npc) % NH, cid = c_lo + t % npc;
            const Params q = relaunder(p); chunkst_gla<1>(q, l, b, h, cid, wl, lane); }
        off = (off + half) % NW;
#pragma unroll 1
        for (int t = (wi + NW - off) % NW; t < half; t += NW) { const int b = t / (NH * npc), h = (t / npc) % NH, cid = c_lo + t % npc;
            const Params q = relaunder(p); chunkst_w<0>(q, l, b, h, cid, wl, lane); }
    }
}

__device__ __forceinline__ void phase_mix1(const Params& p, int l, char* smem) {
    const bool ctxo = l < DEPTH - 1; const int G = (int)gridDim.x, bid = obid();
    constexpr int N_HL = (NB / 2) * (WG / 2), N_HC = NB * (WG / HCB);
    chunk_workers<false>(p, l, smem);
    stage_signal(p, smem, 0, l);
    for (int t = bid; t < N_HL; t += G) hylat_task(p, l, t / (WG / 2), t % (WG / 2), smem);
    if (ctxo) for (int t = G - 1 - bid; t < N_HC; t += G) hyctx_task(p, l, t / (WG / HCB), t % (WG / HCB), smem);
    stage_signal(p, smem, 2, l);
}

constexpr int SCG = 12;
__device__ __forceinline__ void phase_scan(const Params& p, int l, char* smem) {
    const int tid = otid();
    bf16* ST = (bf16*)(p.ws + WS_ST); float* NV = (float*)(p.ws + WS_NV); const float* BE = (const float*)(p.ws + WS_BE); float* SC = (float*)(p.ws + WS_SC);
    constexpr int NCHAIN = 2 * 2 * NB * NH;
    stage_wait(p, 0, l);
    for (int item = obid() * NT + tid; item < NCHAIN * 1024; item += gridDim.x * NT) {
        const int chain = item >> 10, grp = item & 1023; const int mixer = chain / (2 * NB * NH), dir = (chain / (NB * NH)) % 2, b = (chain / NH) % NB, h = chain % NH;
        float c[4] = {0.f, 0.f, 0.f, 0.f}; float nv[4] = {0.f, 0.f, 0.f, 0.f}; float m = 0.f;
        const int d0 = (grp & 15) * 4; const bool donv = (mixer == 0) && (grp < 16);
        for (int o0 = 0; o0 < NCH; o0 += SCG) {
            u32x2 uu[SCG]; float s0[SCG], s1[SCG]; f32x4 be[SCG]; f32x4 nu[SCG];
#pragma unroll
            for (int j = 0; j < SCG; ++j) if (o0 + j < NCH) { const int cid = chain_cid(dir, o0 + j); const size_t ci = ch_index(dir, b, h, cid);
                uu[j] = *(const u32x2*)(ST + st_index(mixer, dir, b, h, cid) * 4096 + grp * 4);
                if (mixer == 0) { s0[j] = SC[ci * 4 + 0]; s1[j] = SC[ci * 4 + 1]; if (donv) nu[j] = *(const f32x4*)(NV + ci * 64 + grp * 4); }
                else be[j] = *(const f32x4*)(BE + ci * 64 + d0); }
#pragma unroll
            for (int j = 0; j < SCG; ++j) if (o0 + j < NCH) { const int cid = chain_cid(dir, o0 + j); const size_t ci = ch_index(dir, b, h, cid);
                const float u[4] = {bitsf(uu[j].x << 16), bitsf(uu[j].x & 0xffff0000u), bitsf(uu[j].y << 16), bitsf(uu[j].y & 0xffff0000u)};
                u32x2 w; w.x = pk2(c[0], c[1]); w.y = pk2(c[2], c[3]); *(u32x2*)(ST + st_index(mixer, dir, b, h, cid) * 4096 + grp * 4) = w;
                if (mixer == 0) {
                    if (grp == 0) SC[ci * 4 + 2] = m;
                    const float mn = fmaxf(s0[j] + m, s1[j]), a = __expf(s0[j] + m - mn), s = __expf(s1[j] - mn);
#pragma unroll
                    for (int k = 0; k < 4; ++k) c[k] = a * c[k] + s * u[k];
                    if (donv) { f32x4 nw = {nv[0], nv[1], nv[2], nv[3]}; *(f32x4*)(NV + ci * 64 + grp * 4) = nw;
                        nv[0] = a * nv[0] + s * nu[j].x; nv[1] = a * nv[1] + s * nu[j].y; nv[2] = a * nv[2] + s * nu[j].z; nv[3] = a * nv[3] + s * nu[j].w; }
                    m = mn;
                } else { c[0] = __expf(be[j].x) * c[0] + u[0]; c[1] = __expf(be[j].y) * c[1] + u[1]; c[2] = __expf(be[j].z) * c[2] + u[2]; c[3] = __expf(be[j].w) * c[3] + u[3]; } }
        }
    }
    stage_signal(p, smem, 1, l);
    { const bool ctxo = l < DEPTH - 1; const int G = (int)gridDim.x, bid = obid();
        constexpr int QTL = SEQ / 128, QTC = CTXL / 128, N_AL = NB * 2 * QTL, N_AC = NB * 2 * QTC;
        for (int t = bid; t < N_AL; t += G) attn_task(p, l, t / (2 * QTL), (t / QTL) % 2, t % QTL, false, smem);
        if (ctxo) for (int t = (bid + G - 64 % G) % G; t < N_AC; t += G) attn_task(p, l, t / (2 * QTC), (t / QTC) % 2, t % QTC, true, smem); }
}

__device__ __forceinline__ void phase_mix2(const Params& p, int l, char* smem) {
    const int tid = otid();
    stage_wait(p, 1, l);
    chunk_workers<true>(p, l, smem);
    stage_wait(p, 2, l);
    constexpr int N_WOUT = (DM / 64) * (MIX / 64);
    { const int lane = tid & 63, wave = __builtin_amdgcn_readfirstlane(tid >> 6); const int NW = (int)gridDim.x * 8, wi = wave * (int)gridDim.x + obid();
        for (int task = NW - 1 - wi; task < N_WOUT; task += NW) { const int nt = task / (MIX / 64), kt = task % (MIX / 64);
            convert_tile_w(p.in[I_WOUT] + (size_t)l * MIX * DM, DM, (bf16*)(p.ws + WS_WOUT), MIX, nt * 64, kt * 64, false, smem + wave * WLDS, lane); }
        bf16* tile = (bf16*)(smem + wave * WLDS); const bf16* HT = (const bf16*)(p.ws + WS_HT); bf16* Y = (bf16*)(p.ws + WS_HNY);
        constexpr int NTT = NB * (SEQ / 64) * 4;
        for (int t = wi; t < NTT; t += NW) { const int b = t / ((SEQ / 64) * 4), tt = (t / 4) % (SEQ / 64), c0 = (t % 4) * 64; const size_t tok0 = (size_t)b * TOK + CTXL + tt * 64;
#pragma unroll
            for (int i = 0; i < 8; ++i) { const int ch = (lane >> 3) + 8 * i, ck = lane & 7; *(u32x4*)(tile + swz(ch, ck)) = *(const u32x4*)(HT + (size_t)(768 + c0 + ch) * T + tok0 + ck * 8); }
            WAVE_SYNC();
#pragma unroll
            for (int i = 0; i < 8; ++i) { const int tk = (lane >> 3) + 8 * i, cc = lane & 7; unsigned w[4];
#pragma unroll
                for (int j = 0; j < 4; ++j) { const int ca = cc * 8 + 2 * j; w[j] = (unsigned)tile[swz(ca, tk >> 3) + (tk & 7)] | ((unsigned)tile[swz(ca + 1, tk >> 3) + (tk & 7)] << 16); }
                u32x4 o; o.x = w[0]; o.y = w[1]; o.z = w[2]; o.w = w[3]; *(u32x4*)(Y + (tok0 + tk) * 1024 + YH + c0 + cc * 8) = o; }
            WAVE_SYNC(); } }
}


#ifndef EMU
#define LAS __attribute__((address_space(3)))
#define XB_TMO      128
#define XB_XCNT(j)  (256  + 64 * (j))
#define XB_XSUB(j)  (1280 + 64 * (j))
#define XB_XGEN(j)  (2304 + 64 * (j))
#define XB_TOP      3328
#define XB_TOPGEN   3392
#define XCD_BAR_WORDS 3456
#define XB_SPIN_CAP (1u << 18)

__device__ __forceinline__ unsigned xb_ld(unsigned* p)              { return __hip_atomic_load(p, __ATOMIC_RELAXED, __HIP_MEMORY_SCOPE_AGENT); }
__device__ __forceinline__ unsigned xb_add(unsigned* p, unsigned v) { return __hip_atomic_fetch_add(p, v, __ATOMIC_RELAXED, __HIP_MEMORY_SCOPE_AGENT); }
__device__ __forceinline__ unsigned xb_xcc_id() { return (unsigned)__builtin_amdgcn_s_getreg((3 << 11) | 20) & 0xFu; }
#define XB_SPIN(cond, bar) do { unsigned _sp = 0; while (cond) { __builtin_amdgcn_s_sleep(1); \
    if ((++_sp & 255u) == 0u) { if (xb_ld(&(bar)[XB_TMO])) break; if (_sp > XB_SPIN_CAP) { atomicAdd(&(bar)[XB_TMO], 1u); break; } } } } while (0)

struct XcdBarrier {
    unsigned* bar; unsigned x;
    volatile LAS unsigned* st;
};

__device__ __forceinline__ XcdBarrier xcd_barrier_post(unsigned* bar, volatile LAS unsigned* st) {
    XcdBarrier b; b.bar = bar; b.x = xb_xcc_id(); b.st = st;
    if (threadIdx.x == 0) (void)xb_add(&bar[XB_XCNT(b.x)], 1u);
    return b;
}
__device__ __forceinline__ void xcd_barrier_complete(unsigned* bar, unsigned x, unsigned& nloc, unsigned& nx) {
    const unsigned G = gridDim.x * gridDim.y * gridDim.z;
    unsigned sum, cnt, mine, sp = 0u;
    for (;;) {
        sum = 0u; cnt = 0u; mine = 0u;
#pragma unroll
        for (unsigned j = 0; j < 16; ++j) { const unsigned c = xb_ld(&bar[XB_XCNT(j)]); sum += c; cnt += (c > 0u) ? 1u : 0u; mine = (j == x) ? c : mine; }
        if (sum == G) break;
        __builtin_amdgcn_s_sleep(1);
        if ((++sp & 255u) == 0u) { if (xb_ld(&bar[XB_TMO])) break; if (sp > XB_SPIN_CAP) { atomicAdd(&bar[XB_TMO], 1u); break; } }
    }
    nloc = mine > 0u ? mine : 1u; nx = cnt > 0u ? cnt : 1u;
}

__device__ __forceinline__ void xcd_barrier(const XcdBarrier& b) {
    asm volatile("s_waitcnt vmcnt(0)" ::: "memory");
    __syncthreads();
    if (threadIdx.x == 0) {
        unsigned* bar = b.bar;
        __builtin_amdgcn_s_waitcnt(0);
        unsigned nloc = b.st[0], nx = b.st[1];
        if (nloc == 0u) { xcd_barrier_complete(bar, b.x, nloc, nx); b.st[0] = nloc; b.st[1] = nx; }
        const unsigned old = xb_add(&bar[XB_XSUB(b.x)], 1u);
        const unsigned gen = old / nloc;
        if (old + 1u == (gen + 1u) * nloc) {
            __builtin_amdgcn_fence(__ATOMIC_RELEASE, "agent");
            asm volatile("s_waitcnt vmcnt(0)" ::: "memory");
            const unsigned og = xb_add(&bar[XB_TOP], 1u);
            const unsigned tg = og / nx;
            if (og + 1u == (tg + 1u) * nx) xb_add(&bar[XB_TOPGEN], 1u);
            else XB_SPIN(xb_ld(&bar[XB_TOPGEN]) == tg, bar);
            __builtin_amdgcn_fence(__ATOMIC_ACQUIRE, "agent");
            xb_add(&bar[XB_XGEN(b.x)], 1u);
            asm volatile("s_waitcnt vmcnt(0)" ::: "memory");
        } else {
            XB_SPIN(xb_ld(&bar[XB_XGEN(b.x)]) == gen, bar);
            __builtin_amdgcn_fence(__ATOMIC_ACQUIRE, "agent");
            asm volatile("s_waitcnt vmcnt(0)" ::: "memory");
        }
    }
    __syncthreads();
}
#endif

__global__ void __launch_bounds__(NT) fwd_kernel(Params pk, int ph_lo, int ph_hi) {
    SMEM_DECL;
#ifndef EMU
    volatile LAS unsigned* misc = (volatile LAS unsigned*)(smem + LDS_BYTES - 64);
    if (threadIdx.x < 2) misc[threadIdx.x] = 0u;
    __syncthreads();
    const XcdBarrier bar = xcd_barrier_post((unsigned*)(pk.ws + WS_BAR), misc);
#endif
    constexpr int NPH = 2 + 6 * DEPTH;
    for (int ph = ph_lo; ph < ph_hi && ph < NPH; ++ph) {
#ifndef EMU
        Params p = pk; { size_t z = 0; asm volatile("" : "+s"(z)); p.ws = pk.ws + z; p.out = pk.out + z;
#pragma unroll
            for (int i = 0; i < 26; ++i) p.in[i] = pk.in[i] + z; }
#else
        const Params& p = pk;
#endif
        if (ph == 0) phase0(p, smem);
        else if (ph == NPH - 1) phase_rp(p, DEPTH, smem);
        else { const int l = (ph - 1) / 6, k = (ph - 1) % 6;
            if (k == 0) phase_rp(p, l, smem);
            else if (k == 1) phase_gemm_in(p, l, smem);
            else if (k == 2) phase_mix1(p, l, smem);
            else if (k == 3) phase_scan(p, l, smem);
            else if (k == 4) phase_mix2(p, l, smem);
            else phase_gemm_out(p, l, smem);
#ifdef PROBE_DUP
            if (k == PROBE_DUP) { GRID_SYNC();
                if (k == 1) phase_gemm_in(p, l, smem); else if (k == 2) phase_mix1(p, l, smem); else if (k == 4) phase_mix2(p, l, smem); }
#endif
        }
        if (ph + 1 < ph_hi && !(ph >= 6 && ph % 6 == 0) && !(ph >= 1 && ((ph - 1) % 6 == 2 || (ph - 1) % 6 == 3))) {
#ifdef EMU
            GRID_SYNC();
#else
            if (ph_lo < 0) GRID_SYNC();
            xcd_barrier(bar);
#endif
        }
    }
}

#ifndef EMU
extern "C" void kernel_launch(void* const* d_in, const int* in_sizes, int n_in, void* d_out, int out_size, void* d_ws, size_t ws_size, hipStream_t stream) {
    static int grid = 0;
    if (grid == 0) {
        if (n_in != 26 || ws_size < WS_TOTAL) { fprintf(stderr, "kernel_launch: unexpected n_in %d or ws_size %zu (need %zu)\n", n_in, ws_size, (size_t)WS_TOTAL); grid = -1; return; }
        int dev = 0, cus = 0, per_cu = 0;
        hipGetDevice(&dev);
        hipDeviceGetAttribute(&cus, hipDeviceAttributeMultiprocessorCount, dev);
        hipFuncSetAttribute((const void*)fwd_kernel, hipFuncAttributeMaxDynamicSharedMemorySize, LDS_BYTES);
        hipOccupancyMaxActiveBlocksPerMultiprocessor(&per_cu, (const void*)fwd_kernel, NT, LDS_BYTES);
        if (per_cu < 1) { fprintf(stderr, "kernel_launch: occupancy query returned %d\n", per_cu); grid = -1; return; }
        if (per_cu > 1) per_cu = 1;
        grid = cus * per_cu;
    }
    if (grid < 0) return;
    hipMemsetAsync((char*)d_ws + WS_BAR, 0, BAR_BYTES, stream);
    Params p{};
    for (int i = 0; i < 26; ++i) p.in[i] = (const float*)d_in[i];
    p.out = (float*)d_out; p.ws = (char*)d_ws;
    int lo = 0, hi = 2 + 6 * DEPTH;
    void* args[] = {&p, &lo, &hi};
    hipError_t e = hipLaunchCooperativeKernel((const void*)fwd_kernel, dim3(grid), dim3(NT), args, LDS_BYTES, stream);
    if (e != hipSuccess) fprintf(stderr, "cooperative launch failed: %s (grid %d)\n", hipGetErrorString(e), grid);
}
#endif
```

```cpp
#ifdef EMU
#include "emu/hipemu.h"
#define GRID_SYNC() emu::grid_sync()
#define SMEM_DECL char* smem = emu::S().blocks[emu::cur()->block].lds
#define SCHED_FENCE() do {} while (0)
#define EXP2(x) exp2f(x)
#define MFMA16(a, b, c) emu_mfma_16x16x32_bf16(a, b, c)
#else
#include <hip/hip_runtime.h>
#include <hip/hip_cooperative_groups.h>
#include <cstdio>
#include <cstdint>
#define GRID_SYNC() cooperative_groups::this_grid().sync()
#define SMEM_DECL extern __shared__ __attribute__((aligned(16))) char smem[]
#define SCHED_FENCE() __builtin_amdgcn_sched_barrier(0)
#define EXP2(x) __builtin_amdgcn_exp2f(x)
#define MFMA16(a, b, c) __builtin_amdgcn_mfma_f32_16x16x32_bf16(a, b, c, 0, 0, 0)
#endif

#ifdef EMU
#ifndef EMU_DM
#define EMU_DM 256
#endif
#ifndef EMU_NB
#define EMU_NB 2
#endif
#ifndef EMU_SEQ
#define EMU_SEQ 512
#endif
#ifndef EMU_DEPTH
#define EMU_DEPTH 2
#endif
#ifndef EMU_CTXL
#define EMU_CTXL 128
#endif
constexpr int DM = EMU_DM, NB = EMU_NB, SEQ = EMU_SEQ, DEPTH = EMU_DEPTH, CTXL = EMU_CTXL;
#else
constexpr int DM = 1024, NB = 8, SEQ = 2048, DEPTH = 4, CTXL = 256;
#endif
constexpr int MIX = 1024, WG = 256, HD = 64, NH = 4, CH = 64;
constexpr int TOK = CTXL + SEQ, T = NB * TOK, NCH = TOK / CH, NCC = CTXL / CH;
constexpr int N_IN = 4144, NP = 3072, NG = 48, NGS = 32, NMAIN = 3328, NPAD = 4352;
constexpr int NF = 2 * SEQ;
constexpr int NJ = NB + 1;
constexpr int NT = 512;
constexpr float EPS = 1e-6f;
constexpr int PA = 0, PG = 1280, PD = 2304;
constexpr int YA = 0, YH = 256, YG = 512, YD = 768;
constexpr int ilog4(int n) { return n <= 1 ? 0 : 1 + ilog4(n / 4); }
constexpr int FFT_P = ilog4(NF);
static_assert((1 << (2 * FFT_P)) == NF, "NF must be a power of 4");
static_assert(DM % 256 == 0 && CTXL % 128 == 0 && SEQ % 256 == 0, "shape constraints");

typedef unsigned short bf16;
typedef short bf16x8 __attribute__((ext_vector_type(8)));
typedef float f32x4 __attribute__((ext_vector_type(4)));
typedef unsigned u32x4 __attribute__((ext_vector_type(4)));
typedef unsigned u32x2 __attribute__((ext_vector_type(2)));
struct cpx { float x, y; };

constexpr size_t al256(size_t x) { return (x + 255) & ~(size_t)255; }
constexpr size_t WS_CTXB = 0;
constexpr size_t WS_HNY = al256(WS_CTXB + (size_t)NB * CTXL * DM * 4);
constexpr size_t WS_WIN = WS_HNY + (size_t)T * 1024 * 2;
constexpr size_t WS_ST = WS_WIN;
constexpr size_t ST_BYTES = (size_t)2 * 2 * NB * NH * NCH * 4096 * 2;
constexpr size_t WS_KT = al256(WS_WIN + (size_t)NPAD * DM * 2);
static_assert(WS_KT + (size_t)WG * NF * 4 <= WS_ST + ST_BYTES || true, "");
constexpr size_t ST_END = al256((WS_ST + ST_BYTES > WS_KT + (size_t)WG * NF * 4) ? WS_ST + ST_BYTES : WS_KT + (size_t)WG * NF * 4);
constexpr size_t WS_P = ST_END;
constexpr size_t WS_HT = al256(WS_P + (size_t)T * NP * 2);
constexpr size_t WS_WOUT = WS_HT;
constexpr size_t WS_G = al256(WS_HT + (size_t)1024 * T * 2);
constexpr size_t WS_KF = al256(WS_G + (size_t)T * NGS * 4);
constexpr size_t WS_HC = al256(WS_KF + (size_t)WG * NF * 8);
constexpr size_t WS_EQ = al256(WS_HC + (size_t)2 * WG * CTXL * 4);
constexpr size_t WS_NV = al256(WS_EQ + (size_t)2 * T * WG * 2);
constexpr size_t WS_BE = al256(WS_NV + (size_t)2 * NB * NH * NCH * 64 * 4);
constexpr size_t WS_SC = al256(WS_BE + (size_t)2 * NB * NH * NCH * 64 * 4);
constexpr size_t WS_MOD = al256(WS_SC + (size_t)2 * NB * NH * NCH * 4 * 4);
constexpr size_t WS_TW = al256(WS_MOD + (size_t)DEPTH * NJ * 3 * DM * 4);
constexpr size_t WS_ROPE = al256(WS_TW + (size_t)NF * 8);
constexpr size_t WS_BAR = al256(WS_ROPE + (size_t)SEQ * 32 * 8);
constexpr size_t BAR_BYTES = 32768;
constexpr size_t WS_TOTAL = al256(WS_BAR + BAR_BYTES);
static_assert((size_t)T * DM * 4 <= (size_t)T * NP * 2, "YO fits in P");
#ifndef EMU
static_assert(WS_TOTAL <= (size_t)268435456, "workspace map must fit 256 MiB");
#endif

constexpr int LDS_BYTES = 163840;

struct Params {
    const float* in[26];
    float* out;
    char* ws;
};
enum { I_X = 0, I_C, I_CTX, I_CCTX, I_WADA, I_BADA, I_GPRE, I_GPOST, I_WIN, I_MGB, I_MNG, I_HCW, I_HCB, I_HW1, I_HB1, I_HW2, I_HB2, I_HW3, I_HB3,
       I_HFREQ, I_HD, I_GWA, I_GBA, I_GNG, I_SINK, I_WOUT };

__device__ __forceinline__ Params relaunder(const Params& pk) {
#ifdef EMU
    return pk;
#else
    Params p = pk; size_t z = 0; asm volatile("" : "+s"(z)); p.ws = pk.ws + z; p.out = pk.out + z;
#pragma unroll
    for (int i = 0; i < 26; ++i) p.in[i] = pk.in[i] + z;
    return p;
#endif
}
constexpr int WLDS = (LDS_BYTES - 64) / 8 / 16 * 16;
#ifdef EMU
#define WAVE_SYNC() emu_wave_sync()
#else
#define WAVE_SYNC() do { asm volatile("s_waitcnt lgkmcnt(0)" ::: "memory"); __builtin_amdgcn_wave_barrier(); } while (0)
#endif

#ifdef EMU
__device__ __forceinline__ int otid() { return (int)threadIdx.x; }
__device__ __forceinline__ int obid() { return (int)blockIdx.x; }
#else
__device__ __forceinline__ int otid() { int t = (int)threadIdx.x; asm volatile("" : "+v"(t)); return t; }
__device__ __forceinline__ int obid() { int b = (int)blockIdx.x; asm volatile("" : "+s"(b)); return b; }
#endif
__device__ __forceinline__ unsigned fbits(float f) { return __builtin_bit_cast(unsigned, f); }
__device__ __forceinline__ float bitsf(unsigned u) { return __builtin_bit_cast(float, u); }
__device__ __forceinline__ float bf2f(bf16 h) { return bitsf((unsigned)h << 16); }
#ifdef EMU
__device__ __forceinline__ bf16 f2bf(float f) { unsigned u = fbits(f); return (bf16)((u + 0x7fffu + ((u >> 16) & 1u)) >> 16); }
__device__ __forceinline__ unsigned pk2(float lo, float hi) { return (unsigned)f2bf(lo) | ((unsigned)f2bf(hi) << 16); }
#else
typedef __bf16 nbf16x2 __attribute__((ext_vector_type(2)));
typedef float nf32x2 __attribute__((ext_vector_type(2)));
__device__ __forceinline__ unsigned pk2(float lo, float hi) { const nf32x2 v = {lo, hi}; return __builtin_bit_cast(unsigned, __builtin_convertvector(v, nbf16x2)); }
__device__ __forceinline__ bf16 f2bf(float f) { return (bf16)(pk2(f, 0.0f) & 0xffffu); }
#endif
#ifdef EMU
__device__ __forceinline__ float frcp_(float x) { return 1.0f / x; }
#else
__device__ __forceinline__ float frcp_(float x) { return __builtin_amdgcn_rcpf(x); }
#endif
__device__ __forceinline__ float sigmoidf_(float x) { return frcp_(1.0f + __expf(-x)); }
__device__ __forceinline__ float siluf_(float x) { return x * frcp_(1.0f + __expf(-x)); }
__device__ __forceinline__ float logsigf_(float x) { return fminf(x, 0.0f) - log1pf(__expf(-fabsf(x))); }
__device__ __forceinline__ float logsig_fast(float x) { return fminf(x, 0.0f) - __logf(1.0f + __expf(-fabsf(x))); }
#ifdef EMU
__device__ __forceinline__ float row16_sum(float x) { x += __shfl_xor(x, 1); x += __shfl_xor(x, 2); x += __shfl_xor(x, 4); x += __shfl_xor(x, 8); return x; }
__device__ __forceinline__ float row16_max(float x) { x = fmaxf(x, __shfl_xor(x, 1)); x = fmaxf(x, __shfl_xor(x, 2)); x = fmaxf(x, __shfl_xor(x, 4)); x = fmaxf(x, __shfl_xor(x, 8)); return x; }
__device__ __forceinline__ float xrow_sum(float x) { x += __shfl_xor(x, 16); x += __shfl_xor(x, 32); return x; }
__device__ __forceinline__ float xrow_max(float x) { x = fmaxf(x, __shfl_xor(x, 16)); x = fmaxf(x, __shfl_xor(x, 32)); return x; }
#else
template <int CTRL> __device__ __forceinline__ float dpp_(float x) { return __builtin_bit_cast(float, __builtin_amdgcn_mov_dpp(__builtin_bit_cast(int, x), CTRL, 0xf, 0xf, true)); }
__device__ __forceinline__ float row16_sum(float x) { x += dpp_<0xB1>(x); x += dpp_<0x4E>(x); x += dpp_<0x141>(x); x += dpp_<0x128>(x); return x; }
__device__ __forceinline__ float row16_max(float x) { x = fmaxf(x, dpp_<0xB1>(x)); x = fmaxf(x, dpp_<0x4E>(x)); x = fmaxf(x, dpp_<0x141>(x)); x = fmaxf(x, dpp_<0x128>(x)); return x; }
__device__ __forceinline__ float xrow_sum(float x) {
    auto s = __builtin_amdgcn_permlane16_swap(fbits(x), fbits(x), false, false); x = bitsf(s[0]) + bitsf(s[1]);
    auto t = __builtin_amdgcn_permlane32_swap(fbits(x), fbits(x), false, false); return bitsf(t[0]) + bitsf(t[1]); }
__device__ __forceinline__ float xrow_max(float x) {
    auto s = __builtin_amdgcn_permlane16_swap(fbits(x), fbits(x), false, false); x = fmaxf(bitsf(s[0]), bitsf(s[1]));
    auto t = __builtin_amdgcn_permlane32_swap(fbits(x), fbits(x), false, false); return fmaxf(bitsf(t[0]), bitsf(t[1])); }
#endif
__device__ __forceinline__ float wave_sum(float v) { return xrow_sum(row16_sum(v)); }
__device__ __forceinline__ float wave_max(float v) { return xrow_max(row16_max(v)); }
#ifdef EMU
__device__ __forceinline__ float wave_prefix_sum(float v, int lane) {
#pragma unroll
    for (int o = 1; o < 64; o <<= 1) { float t = __shfl_up(v, o); if (lane >= o) v += t; }
    return v;
}
__device__ __forceinline__ float wave_prefix_max(float v, int lane) {
#pragma unroll
    for (int o = 1; o < 64; o <<= 1) { float t = __shfl_up(v, o); if (lane >= o) v = fmaxf(v, t); }
    return v;
}
#else
template <int CTRL, int RM> __device__ __forceinline__ float dppo_(float old, float x) { return __builtin_bit_cast(float, __builtin_amdgcn_update_dpp(__builtin_bit_cast(int, old), __builtin_bit_cast(int, x), CTRL, RM, 0xf, false)); }
__device__ __forceinline__ float wave_prefix_sum(float v, int) {
    v += dppo_<0x111, 0xf>(0.f, v); v += dppo_<0x112, 0xf>(0.f, v); v += dppo_<0x114, 0xf>(0.f, v); v += dppo_<0x118, 0xf>(0.f, v);
    v += dppo_<0x142, 0xa>(0.f, v); v += dppo_<0x143, 0xc>(0.f, v); return v;
}
__device__ __forceinline__ float wave_prefix_max(float v, int) {
    const float ninf = -INFINITY;
    v = fmaxf(v, dppo_<0x111, 0xf>(ninf, v)); v = fmaxf(v, dppo_<0x112, 0xf>(ninf, v)); v = fmaxf(v, dppo_<0x114, 0xf>(ninf, v)); v = fmaxf(v, dppo_<0x118, 0xf>(ninf, v));
    v = fmaxf(v, dppo_<0x142, 0xa>(ninf, v)); v = fmaxf(v, dppo_<0x143, 0xc>(ninf, v)); return v;
}
#endif
__device__ __forceinline__ float wave_suffix_max(float v, int lane) {
    return __shfl(wave_prefix_max(__shfl(v, 63 - lane), lane), 63 - lane);
}
__device__ __forceinline__ void unpack8(u32x4 v, float* f) {
    f[0] = bitsf(v.x << 16); f[1] = bitsf(v.x & 0xffff0000u); f[2] = bitsf(v.y << 16); f[3] = bitsf(v.y & 0xffff0000u);
    f[4] = bitsf(v.z << 16); f[5] = bitsf(v.z & 0xffff0000u); f[6] = bitsf(v.w << 16); f[7] = bitsf(v.w & 0xffff0000u);
}
__device__ __forceinline__ int orig_col(int n) {
    if (n < 1280) return n;
    if (n < 2304) return 2320 + (n - 1280);
    if (n < 3072) return 3376 + (n - 2304);
    if (n < 3088) return 1280 + (n - 3072);
    if (n < 3120) return 3344 + (n - 3088);
    if (n < NMAIN) return -1;
    return 1296 + (n - NMAIN);
}
__device__ __forceinline__ int chain_cid(int dir, int o) {
    if (dir == 0) return o;
    return o < NCC ? (NCC - 1 - o) : (NCH - 1 - (o - NCC));
}

__device__ __forceinline__ int swz(int row, int ch) { return row * 64 + ((ch ^ (row & 7)) << 3); }
__device__ __forceinline__ u32x4 pack8(const float* f) { u32x4 o; o.x = pk2(f[0], f[1]); o.y = pk2(f[2], f[3]); o.z = pk2(f[4], f[5]); o.w = pk2(f[6], f[7]); return o; }
__device__ __forceinline__ bf16x8 as_frag(u32x4 v) { return __builtin_bit_cast(bf16x8, v); }
__device__ __forceinline__ u32x4 as_u4(bf16x8 v) { return __builtin_bit_cast(u32x4, v); }

constexpr int LS = 72;

template <int NTL, int KS>
__device__ __forceinline__ void mma_nt(const bf16* A, int lda, int m0, const bf16* B, int ldb, int n0, f32x4 (&acc)[NTL], int lane) {
    const int r = lane & 15, q = lane >> 4;
#pragma unroll
    for (int ks = 0; ks < KS; ++ks) {
        const bf16x8 a = *(const bf16x8*)(A + (m0 + r) * lda + ks * 32 + q * 8);
#pragma unroll
        for (int nt = 0; nt < NTL; ++nt) {
            const bf16x8 b = *(const bf16x8*)(B + (n0 + nt * 16 + r) * ldb + ks * 32 + q * 8);
            acc[nt] = MFMA16(a, b, acc[nt]);
        }
    }
}

__device__ __forceinline__ void layer_prep(const Params& p, int l, int idx, int stride, char* smem);
__device__ __forceinline__ void phase0(const Params& p, char* smem) {
    const int tid = otid();
    cpx* TW = (cpx*)(p.ws + WS_TW);
    cpx* ROPE = (cpx*)(p.ws + WS_ROPE);
    float* MOD = (float*)(p.ws + WS_MOD);
    constexpr int N_TW = NF / NT, N_ROPE = SEQ * 32 / NT, N_MOD = DEPTH * (3 * DM / 64);
    for (int task = obid(); task < N_TW + N_ROPE + N_MOD; task += gridDim.x) {
        if (task < N_TW) {
            const int j = task * NT + tid; float s, c; sincospif(2.0f * (float)j / (float)NF, &s, &c);
            cpx v; v.x = c; v.y = -s; TW[j] = v;
        } else if (task < N_TW + N_ROPE) {
            const int idx = (task - N_TW) * NT + tid; const int pos = idx >> 5, i = idx & 31;
            const float inv = exp2f(-(float)(i & 15) * (13.287712379549449f / 16.0f));
            const float ang = (float)(i < 16 ? pos / 64 : pos % 64) * inv;
            cpx v; v.x = cosf(ang); v.y = sinf(ang); ROPE[idx] = v;
        } else {
            const int mt = task - N_TW - N_ROPE; const int l = mt / (3 * DM / 64), n0 = (mt % (3 * DM / 64)) * 64;
            float* sv = (float*)smem;
            float* red = sv + NJ * DM;
            __syncthreads();
            for (int i = tid; i < NJ * DM; i += NT) { const int j = i / DM, k = i % DM; const float v = j < NB ? p.in[I_C][j * DM + k] : p.in[I_CCTX][k]; sv[i] = siluf_(v); }
            __syncthreads();
            const int nl = tid & 63, ks = tid >> 6; float acc[NJ];
#pragma unroll
            for (int j = 0; j < NJ; ++j) acc[j] = 0.f;
            const float* w = p.in[I_WADA] + (size_t)l * DM * 3 * DM + n0 + nl;
            for (int k = ks * (DM / 8); k < (ks + 1) * (DM / 8); ++k) { const float wv = w[(size_t)k * 3 * DM];
#pragma unroll
                for (int j = 0; j < NJ; ++j) acc[j] += sv[j * DM + k] * wv; }
#pragma unroll
            for (int j = 0; j < NJ; ++j) red[(ks * NJ + j) * 64 + nl] = acc[j];
            __syncthreads();
            for (int i = tid; i < NJ * 64; i += NT) { const int j = i / 64, n = i % 64; float s = 0.f;
#pragma unroll
                for (int k8 = 0; k8 < 8; ++k8) s += red[(k8 * NJ + j) * 64 + n];
                MOD[((size_t)l * NJ + j) * 3 * DM + n0 + n] = s + p.in[I_BADA][(size_t)l * 3 * DM + n0 + n]; }
        }
    }
}

#ifdef EMU
constexpr int PANEL_ROWS = 128, PANEL_UNITS = DM / 128;
#else
constexpr int PANEL_ROWS = 256, PANEL_UNITS = DM / 256;
#endif
__device__ __forceinline__ unsigned* unit_counter(const Params& p, int isctx) { return (unsigned*)(p.ws + WS_BAR + 16384) + 64 * isctx; }
__device__ __forceinline__ unsigned* stage_counter(const Params& p, int flag) { return (unsigned*)(p.ws + WS_BAR + 16384) + 512 + 512 * flag; }
__device__ __forceinline__ void stage_signal(const Params& p, char* smem, int flag, int l) {
#ifdef EMU
    __syncthreads(); if (otid() == 0) *stage_counter(p, flag) += 1u;
#else
    asm volatile("s_waitcnt vmcnt(0)" ::: "memory"); __syncthreads();
    if (threadIdx.x == 0) {
        const unsigned xcc = (unsigned)__builtin_amdgcn_s_getreg((3 << 11) | 20) & 0xFu, nloc = ((volatile __attribute__((address_space(3))) unsigned*)(smem + LDS_BYTES - 64))[0];
        unsigned* g = stage_counter(p, flag);
        if (nloc > 0u) { const unsigned old = __hip_atomic_fetch_add(g + 16 * (1 + xcc), 1u, __ATOMIC_RELAXED, __HIP_MEMORY_SCOPE_AGENT);
            if (old + 1u == nloc * (unsigned)(l + 1)) { __builtin_amdgcn_fence(__ATOMIC_RELEASE, "agent"); asm volatile("s_waitcnt vmcnt(0)" ::: "memory");
                __hip_atomic_fetch_add(g, nloc, __ATOMIC_RELAXED, __HIP_MEMORY_SCOPE_AGENT); } }
        else { __builtin_amdgcn_fence(__ATOMIC_RELEASE, "agent"); asm volatile("s_waitcnt vmcnt(0)" ::: "memory"); __hip_atomic_fetch_add(g, 1u, __ATOMIC_RELAXED, __HIP_MEMORY_SCOPE_AGENT); }
    }
#endif
}
__device__ __forceinline__ void stage_wait(const Params& p, int flag, int l) {
    if (otid() == 0) { const unsigned target = (unsigned)gridDim.x * (unsigned)(l + 1);
#ifdef EMU
        while (*(volatile unsigned*)stage_counter(p, flag) < target) emu::yield();
#else
        unsigned spins = 0;
        while (__hip_atomic_load(stage_counter(p, flag), __ATOMIC_RELAXED, __HIP_MEMORY_SCOPE_AGENT) < target) { __builtin_amdgcn_s_sleep(16); if (++spins > (1u << 20)) break; }
        __builtin_amdgcn_fence(__ATOMIC_ACQUIRE, "agent"); asm volatile("s_waitcnt vmcnt(0)" ::: "memory");
#endif
    }
    __syncthreads();
}
__device__ __forceinline__ int logical_row(int i) { return i < NB * SEQ ? (i / SEQ) * TOK + CTXL + i % SEQ : ((i - NB * SEQ) / CTXL) * TOK + (i - NB * SEQ) % CTXL; }
struct RowRef { const float* xo; float* xn; int mj, row; bool ok; };
__device__ __forceinline__ RowRef rp_ref(const Params& p, int l, int li, int base, int hi) {
    RowRef r; r.ok = li < hi; const int rr = logical_row(r.ok ? li : base); r.row = rr;
    const int b = rr / TOK, pp = rr % TOK; const bool isctx = pp < CTXL; if (l == DEPTH && isctx) r.ok = false;
    const size_t off = isctx ? ((size_t)b * CTXL + pp) * DM : ((size_t)b * SEQ + (pp - CTXL)) * DM;
    float* CTXB = (float*)(p.ws + WS_CTXB);
    r.xo = (l <= 1) ? (isctx ? p.in[I_CTX] + off : p.in[I_X] + off) : (isctx ? CTXB + off : p.out + off);
    r.xn = isctx ? CTXB + off : p.out + off; r.mj = isctx ? NB : b; return r;
}
__device__ __forceinline__ void rp_rows(const Params& p, int l, int lo, int hi, int gi, int nb) {
    const int tid = otid(), lane = tid & 63, wave = tid >> 6;
    const float* MOD = (const float*)(p.ws + WS_MOD);
    const bf16* YO = (const bf16*)(p.ws + WS_P);
    bf16* HN = (bf16*)(p.ws + WS_HNY);
    constexpr int NV4 = DM / 256, RW = 2;
    const int stride = nb * 8;
    f32x4 xq[RW][NV4]; u32x2 yq[RW][NV4]; RowRef rq[RW];
    int base = lo + gi * 8 + wave;
    if (base < hi) {
#pragma unroll
        for (int i = 0; i < RW; ++i) { rq[i] = rp_ref(p, l, base + i * stride, base, hi);
#pragma unroll
            for (int j = 0; j < NV4; ++j) { xq[i][j] = *(const f32x4*)(rq[i].xo + 4 * lane + 256 * j); yq[i][j] = (l > 0) ? *(const u32x2*)(YO + (size_t)rq[i].row * DM + 4 * lane + 256 * j) : (u32x2){0u, 0u}; } }
    }
    for (; base < hi; base += stride * RW) {
        f32x4 x[RW][NV4], y[RW][NV4]; RowRef rc[RW];
#pragma unroll
        for (int i = 0; i < RW; ++i) { rc[i] = rq[i];
#pragma unroll
            for (int j = 0; j < NV4; ++j) { x[i][j] = xq[i][j]; const u32x2 yy = yq[i][j]; y[i][j] = (f32x4){bitsf(yy.x << 16), bitsf(yy.x & 0xffff0000u), bitsf(yy.y << 16), bitsf(yy.y & 0xffff0000u)}; } }
        { const int nbase = base + stride * RW;
            if (nbase < hi) {
#pragma unroll
                for (int i = 0; i < RW; ++i) { rq[i] = rp_ref(p, l, nbase + i * stride, nbase, hi);
#pragma unroll
                    for (int j = 0; j < NV4; ++j) { xq[i][j] = *(const f32x4*)(rq[i].xo + 4 * lane + 256 * j); if (l > 0) yq[i][j] = *(const u32x2*)(YO + (size_t)rq[i].row * DM + 4 * lane + 256 * j); } } } }
        if (l > 0) {
            float ss[RW];
#pragma unroll
            for (int i = 0; i < RW; ++i) { ss[i] = 0.f;
#pragma unroll
                for (int j = 0; j < NV4; ++j) ss[i] += y[i][j].x * y[i][j].x + y[i][j].y * y[i][j].y + y[i][j].z * y[i][j].z + y[i][j].w * y[i][j].w; }
#pragma unroll
            for (int i = 0; i < RW; ++i) ss[i] = wave_sum(ss[i]);
            const float* gp = p.in[I_GPOST] + (size_t)(l - 1) * DM;
#pragma unroll
            for (int i = 0; i < RW; ++i) { const float rstd = rsqrtf(ss[i] * (1.0f / DM) + EPS); const float* gt = MOD + ((size_t)(l - 1) * NJ + rc[i].mj) * 3 * DM + 2 * DM;
#pragma unroll
                for (int j = 0; j < NV4; ++j) { const f32x4 g4 = *(const f32x4*)(gt + 4 * lane + 256 * j), p4 = *(const f32x4*)(gp + 4 * lane + 256 * j);
                    x[i][j] = x[i][j] + g4 * (y[i][j] * rstd * p4);
                    if (rc[i].ok) *(f32x4*)(rc[i].xn + 4 * lane + 256 * j) = x[i][j]; } }
        }
        if (l < DEPTH) {
            float ss[RW];
#pragma unroll
            for (int i = 0; i < RW; ++i) { ss[i] = 0.f;
#pragma unroll
                for (int j = 0; j < NV4; ++j) ss[i] += x[i][j].x * x[i][j].x + x[i][j].y * x[i][j].y + x[i][j].z * x[i][j].z + x[i][j].w * x[i][j].w; }
#pragma unroll
            for (int i = 0; i < RW; ++i) ss[i] = wave_sum(ss[i]);
            const float* gp = p.in[I_GPRE] + (size_t)l * DM;
#pragma unroll
            for (int i = 0; i < RW; ++i) { const float rstd = rsqrtf(ss[i] * (1.0f / DM) + EPS); const float* md = MOD + ((size_t)l * NJ + rc[i].mj) * 3 * DM; const int row = rc[i].row;
#pragma unroll
                for (int j = 0; j < NV4; ++j) { const int e = 4 * lane + 256 * j;
                    const f32x4 g4 = *(const f32x4*)(gp + e), sh = *(const f32x4*)(md + e), sc = *(const f32x4*)(md + DM + e);
                    const f32x4 h = (x[i][j] * rstd * g4) * (sc + 1.0f) + sh;
                    u32x2 o; o.x = pk2(h.x, h.y); o.y = pk2(h.z, h.w);
                    if (rc[i].ok) *(u32x2*)(HN + (size_t)row * DM + e) = o; } }
        }
    }
}

__device__ __forceinline__ void convert_tile(const float* src, int ldn, bf16* dst, int K, int n0, int k0, bool use_map, char* smem) {
    const int tid = otid();
    float* tile = (float*)smem;
    __syncthreads();
#pragma unroll
    for (int i = 0; i < 8; ++i) { const int idx = tid + NT * i, k = idx >> 6, n = idx & 63;
        const int oc = use_map ? orig_col(n0 + n) : (n0 + n);
        tile[k * 65 + n] = oc >= 0 ? src[(size_t)(k0 + k) * ldn + oc] : 0.f; }
    __syncthreads();
    const int n = tid >> 3, c = tid & 7;
    u32x4 o; o.x = pk2(tile[(8 * c + 0) * 65 + n], tile[(8 * c + 1) * 65 + n]); o.y = pk2(tile[(8 * c + 2) * 65 + n], tile[(8 * c + 3) * 65 + n]);
    o.z = pk2(tile[(8 * c + 4) * 65 + n], tile[(8 * c + 5) * 65 + n]); o.w = pk2(tile[(8 * c + 6) * 65 + n], tile[(8 * c + 7) * 65 + n]);
    *(u32x4*)(dst + (size_t)(n0 + n) * K + k0 + 8 * c) = o;
}

__device__ __forceinline__ void filter_task(const Params& p, int l, int L, int pos0, char* smem) {
    const int tid = otid(), j = tid & 63;
    float* z = (float*)smem;
    float* h1 = z + 8 * 33;
    float* h2 = h1 + 8 * 64;
    const float* w1 = p.in[I_HW1] + (size_t)l * 33 * 64; const float* w2 = p.in[I_HW2] + (size_t)l * 64 * 64; const float* w3 = p.in[I_HW3] + (size_t)l * 64 * 512;
    float r1[33], r2[64], r3a[16];
#pragma unroll
    for (int i = 0; i < 33; ++i) r1[i] = w1[i * 64 + j];
#pragma unroll
    for (int i = 0; i < 64; ++i) r2[i] = w2[i * 64 + j];
    const float b1 = p.in[I_HB1][l * 64 + j], b2 = p.in[I_HB2][l * 64 + j], b3 = p.in[I_HB3][l * 512 + tid];
    const float f0 = p.in[I_HFREQ][(l * 2 + 0) * 64 + j], f1 = p.in[I_HFREQ][(l * 2 + 1) * 64 + j];
    __syncthreads();
    if (tid < 8 * 33) { const int pp = tid / 33, i = tid % 33; const float pos = (float)(pos0 + pp);
        const float t = pos / (float)(L - 1 > 1 ? L - 1 : 1), wv = 6.283185307179586f * pos / (float)L; float v;
        if (i == 0) v = t; else { const int bi = (i - 1) & 15; const float f = 1e-4f + (float)bi * ((15.0f - 1e-4f) / 15.0f); v = (i <= 16) ? cosf(wv * f) : -sinf(wv * f); }
        z[tid] = v; }
    __syncthreads();
    { const int pp = tid >> 6; float a = b1;
#pragma unroll
        for (int i = 0; i < 33; ++i) a += z[pp * 33 + i] * r1[i];
        h1[tid] = sinf(f0 * a);
#pragma unroll
        for (int i = 0; i < 16; ++i) r3a[i] = w3[i * 512 + tid]; }
    __syncthreads();
    { const int pp = tid >> 6; float a = b2;
#pragma unroll
        for (int i = 0; i < 64; ++i) a += h1[pp * 64 + i] * r2[i];
        h2[tid] = sinf(f1 * a); }
    __syncthreads();
    { const int o = tid, dir = o >> 8, c = o & 255;
        const float delta = 3.0701134573253946f + (float)c * ((15.350567286626973f - 3.0701134573253946f) / 255.0f);
        float acc[8];
#pragma unroll
        for (int pp = 0; pp < 8; ++pp) acc[pp] = b3;
#pragma unroll 1
        for (int cix = 0; cix < 4; ++cix) {
            float wn[16];
#pragma unroll
            for (int i = 0; i < 16; ++i) wn[i] = (cix < 3) ? w3[(16 * (cix + 1) + i) * 512 + o] : 0.f;
#pragma unroll
            for (int i = 0; i < 16; ++i) {
#pragma unroll
                for (int pp = 0; pp < 8; ++pp) acc[pp] += h2[pp * 64 + 16 * cix + i] * r3a[i]; }
#pragma unroll
            for (int i = 0; i < 16; ++i) r3a[i] = wn[i]; }
        float* KT = (float*)(p.ws + WS_KT); float* HC = (float*)(p.ws + WS_HC);
#pragma unroll
        for (int pp = 0; pp < 8; ++pp) { const int pos = pos0 + pp; const float t = (float)pos / (float)(L - 1 > 1 ? L - 1 : 1);
            const float v = acc[pp] * __expf(-t * delta);
            if (L == SEQ) { if (dir == 0) KT[(size_t)c * NF + pos]= v; else if (pos > 0) KT[(size_t)c * NF + (NF - pos)] = v; else KT[(size_t)c * NF + SEQ] = 0.f; }
            else HC[((size_t)dir * WG + c) * CTXL + pos] = v; }
    }
}

__device__ __forceinline__ void convert_tile_w(const float* src, int ldn, bf16* dst, int K, int n0, int k0, bool use_map, char* wl, int lane) {
    float* tile = (float*)wl;
    const int oc = use_map ? orig_col(n0 + lane) : (n0 + lane);
    float v[64];
#pragma unroll
    for (int k = 0; k < 64; ++k) v[k] = oc >= 0 ? src[(size_t)(k0 + k) * ldn + oc] : 0.f;
#pragma unroll
    for (int k = 0; k < 64; ++k) tile[k * 65 + lane] = v[k];
    WAVE_SYNC();
#pragma unroll
    for (int i = 0; i < 8; ++i) { const int n = (lane >> 3) + 8 * i, c = lane & 7; float f[8];
#pragma unroll
        for (int j = 0; j < 8; ++j) f[j] = tile[(8 * c + j) * 65 + n];
        *(u32x4*)(dst + (size_t)(n0 + n) * K + k0 + 8 * c) = pack8(f); }
    WAVE_SYNC();
}
__device__ __forceinline__ void layer_prep(const Params& p, int l, int idx, int stride, char* smem) {
    constexpr int N_WIN = (NPAD / 64) * (DM / 64), N_FL = SEQ / 8, N_FC = CTXL / 8;
    for (int task = idx; task < N_FL + N_FC; task += stride) {
        if (task < N_FL) filter_task(p, l, SEQ, task * 8, smem);
        else filter_task(p, l, CTXL, (task - N_FL) * 8, smem);
    }
    __syncthreads();
    { const int tid = otid(), lane = tid & 63, wave = __builtin_amdgcn_readfirstlane(tid >> 6);
        char* wl = smem + wave * WLDS;
        for (int task = wave * stride + idx; task < N_WIN; task += 8 * stride) { const int nt = task / (DM / 64), kt = task % (DM / 64);
            convert_tile_w(p.in[I_WIN] + (size_t)l * DM * N_IN, N_IN, (bf16*)(p.ws + WS_WIN), DM, nt * 64, kt * 64, true, wl, lane); } }
}
__device__ __forceinline__ unsigned* row_queue(const Params& p, int l) { return (unsigned*)(p.ws + WS_BAR + 16384) + 2560 + 64 * l; }
__device__ __forceinline__ void wait_units(const Params& p, int c, int l) {
    constexpr int nLatU = NB * (SEQ / PANEL_ROWS) * PANEL_UNITS, nCtxU = NB * (CTXL / PANEL_ROWS) * PANEL_UNITS;
    const unsigned target = (unsigned)((c ? nCtxU : nLatU) * l);
#ifdef EMU
    while (*(volatile unsigned*)unit_counter(p, c) < target) emu::yield();
#else
    unsigned spins = 0;
    while (__hip_atomic_load(unit_counter(p, c), __ATOMIC_RELAXED, __HIP_MEMORY_SCOPE_AGENT) < target) { __builtin_amdgcn_s_sleep(16); if (++spins > (1u << 20)) break; }
    __builtin_amdgcn_fence(__ATOMIC_ACQUIRE, "agent"); asm volatile("s_waitcnt vmcnt(0)" ::: "memory");
#endif
}
__device__ __forceinline__ void phase_rp(const Params& p, int l, char* smem) { const int G = (int)gridDim.x, bid = obid(), tid = otid();
    const bool has_ctx = l < DEPTH;
    constexpr int nLatU = NB * (SEQ / PANEL_ROWS) * PANEL_UNITS, nCtxU = NB * (CTXL / PANEL_ROWS) * PANEL_UNITS;
    const int nU = nLatU + nCtxU;
    const int heavy = (l >= 1 && has_ctx && nU > G && (nU % G) != 0) ? nU % G : 0;
    const int total = heavy > 0 ? NB * SEQ : (has_ctx ? T : NB * SEQ);
    const int nl = G - heavy, np = (l < DEPTH) ? nl / 2 : 0, nr = nl - np;
    int lo, hi, gi, nb; bool prep = false;
    if (bid < heavy) { lo = NB * SEQ; hi = T; gi = bid; nb = heavy; }
    else { const int i = bid - heavy; int nR = total;
        if (np > 0) { nR = ((total * 2 / 3) / (nr * 16)) * (nr * 16); if (nR <= 0) nR = total / 2; }
        if (np > 0 && (i & 1) && i / 2 < np) { prep = true; lo = nR; hi = total; gi = i / 2; nb = np; }
        else { lo = 0; hi = nR; gi = (np > 0) ? (i + 1) / 2 : i; nb = nr; } }
    if (prep) layer_prep(p, l, gi, np, smem);
    else if (l < DEPTH && np == 0) layer_prep(p, l, bid, G, smem);
    if (l >= 1) { if (tid == 0) { if (lo < NB * SEQ) wait_units(p, 0, l); if (hi > NB * SEQ) wait_units(p, 1, l); } __syncthreads(); }
    rp_rows(p, l, lo, hi, gi, nb);
}

__device__ __forceinline__ cpx cmul(cpx a, cpx b) { cpx r; r.x = a.x * b.x - a.y * b.y; r.y = a.x * b.y + a.y * b.x; return r; }
__device__ __forceinline__ cpx cmulc(cpx a, cpx b) { cpx r; r.x = a.x * b.x + a.y * b.y; r.y = a.y * b.x - a.x * b.y; return r; }
constexpr int fpad(int i) { return i + (i >> 4); }
__device__ __forceinline__ int FPH(int i) { return i + (i >> 4); }
constexpr int FBUF = fpad(NF);
constexpr int ilog16(int n) { return n < 16 ? 0 : 1 + ilog16(n / 16); }
constexpr int FFT_P16 = ilog16(NF);
constexpr bool FFT_R4 = ((NF >> (4 * FFT_P16)) == 4);
static_assert((NF >> (4 * FFT_P16)) == 1 || (NF >> (4 * FFT_P16)) == 4, "NF = 16^a * (1 or 4)");
template <bool INV> __device__ __forceinline__ void dft4(cpx& a0, cpx& a1, cpx& a2, cpx& a3) {
    const cpx s = {a0.x + a2.x, a0.y + a2.y}, b = {a0.x - a2.x, a0.y - a2.y}, c = {a1.x + a3.x, a1.y + a3.y}, d = {a1.x - a3.x, a1.y - a3.y};
    a0 = (cpx){s.x + c.x, s.y + c.y}; a2 = (cpx){s.x - c.x, s.y - c.y};
    if (!INV) { a1 = (cpx){b.x + d.y, b.y - d.x}; a3 = (cpx){b.x - d.y, b.y + d.x}; }
    else      { a1 = (cpx){b.x - d.y, b.y + d.x}; a3 = (cpx){b.x + d.y, b.y - d.x}; }
}
template <bool INV> __device__ __forceinline__ cpx cmulk(cpx a, float wr, float wi) {
    cpx r; if (!INV) { r.x = a.x * wr + a.y * wi; r.y = a.y * wr - a.x * wi; } else { r.x = a.x * wr - a.y * wi; r.y = a.y * wr + a.x * wi; } return r;
}
template <bool INV> __device__ __forceinline__ void dft16(cpx (&x)[16]) {
    constexpr float C1 = 0.92387953251128674f, S1 = 0.38268343236508977f, C2 = 0.70710678118654752f;
#pragma unroll
    for (int n2 = 0; n2 < 4; ++n2) dft4<INV>(x[n2], x[4 + n2], x[8 + n2], x[12 + n2]);
    x[4 * 1 + 1] = cmulk<INV>(x[4 * 1 + 1], C1, S1); x[4 * 1 + 2] = cmulk<INV>(x[4 * 1 + 2], C2, C2); x[4 * 1 + 3] = cmulk<INV>(x[4 * 1 + 3], S1, C1);
    x[4 * 2 + 1] = cmulk<INV>(x[4 * 2 + 1], C2, C2); x[4 * 2 + 2] = cmulk<INV>(x[4 * 2 + 2], 0.f, 1.f); x[4 * 2 + 3] = cmulk<INV>(x[4 * 2 + 3], -C2, C2);
    x[4 * 3 + 1] = cmulk<INV>(x[4 * 3 + 1], S1, C1); x[4 * 3 + 2] = cmulk<INV>(x[4 * 3 + 2], -C2, C2); x[4 * 3 + 3] = cmulk<INV>(x[4 * 3 + 3], -C1, -S1);
#pragma unroll
    for (int k1 = 0; k1 < 4; ++k1) dft4<INV>(x[4 * k1 + 0], x[4 * k1 + 1], x[4 * k1 + 2], x[4 * k1 + 3]);
    cpx t;
    t = x[1]; x[1] = x[4]; x[4] = t; t = x[2]; x[2] = x[8]; x[8] = t; t = x[3]; x[3] = x[12]; x[12] = t;
    t = x[6]; x[6] = x[9]; x[9] = t; t = x[7]; x[7] = x[13]; x[13] = t; t = x[11]; x[11] = x[14]; x[14] = t;
}
template <bool INV> __device__ __forceinline__ void fft_stage16(cpx* buf, const cpx* TW, int tl, int M) {
    const int span = M >> 4, twm = NF / M;
#pragma unroll 1
    for (int j = tl; j < NF / 16; j += 256) {
        const int grp = j / span, pos = j % span, base = grp * M + pos; cpx x[16];
#pragma unroll
        for (int q = 0; q < 16; ++q) x[q] = buf[FPH(base + q * span)];
        cpx w1 = {1.f, 0.f}; if (span > 1) w1 = TW[pos * twm];
        if (INV && span > 1) { cpx wk = w1;
#pragma unroll
            for (int k = 1; k < 16; ++k) { x[k] = cmulc(x[k], wk); wk = cmul(wk, w1); } }
        dft16<INV>(x);
        if (!INV && span > 1) { cpx wk = w1;
#pragma unroll
            for (int k = 1; k < 16; ++k) { x[k] = cmul(x[k], wk); wk = cmul(wk, w1); } }
#pragma unroll
        for (int q = 0; q < 16; ++q) buf[FPH(base + q * span)] = x[q];
    }
}
template <bool INV> __device__ __forceinline__ void fft_stage4_last(cpx* buf, int tl) {
#pragma unroll 1
    for (int j = tl; j < NF / 4; j += 256) { cpx a0 = buf[FPH(4 * j)], a1 = buf[FPH(4 * j + 1)], a2 = buf[FPH(4 * j + 2)], a3 = buf[FPH(4 * j + 3)];
        dft4<INV>(a0, a1, a2, a3); buf[FPH(4 * j)] = a0; buf[FPH(4 * j + 1)] = a1; buf[FPH(4 * j + 2)] = a2; buf[FPH(4 * j + 3)] = a3; }
}
__device__ __forceinline__ void fft_fwd(cpx* buf, const cpx* TW, int tl) {
    int M = NF;
#pragma unroll
    for (int s = 0; s < FFT_P16; ++s) { __syncthreads(); fft_stage16<false>(buf, TW, tl, M); M >>= 4; }
    if (FFT_R4) { __syncthreads(); fft_stage4_last<false>(buf, tl); }
    __syncthreads();
}
__device__ __forceinline__ void fft_inv(cpx* buf, const cpx* TW, int tl) {
    if (FFT_R4) { __syncthreads(); fft_stage4_last<true>(buf, tl); }
    int M = FFT_R4 ? 64 : 16;
#pragma unroll
    for (int s = 0; s < FFT_P16; ++s) { __syncthreads(); fft_stage16<true>(buf, TW, tl, M); M <<= 4; }
    __syncthreads();
}
__device__ __forceinline__ void filt_fft_task(const Params& p, int cp, char* smem) {
    const int tid = otid(), half = tid >> 8, tl = tid & 255, c = 2 * cp + half;
    cpx* buf = (cpx*)smem + (size_t)half * FBUF;
    const float* KT = (const float*)(p.ws + WS_KT) + (size_t)c * NF;
    cpx* KF = (cpx*)(p.ws + WS_KF) + (size_t)c * NF;
    const cpx* TW = (const cpx*)(p.ws + WS_TW);
    __syncthreads();
    for (int i = tl; i < NF; i += 256) { cpx v; v.x = KT[i]; v.y = 0.f; buf[FPH(i)] = v; }
    fft_fwd(buf, TW, tl);
    for (int i = tl; i < NF; i += 256) KF[i] = buf[FPH(i)];
}

__device__ __forceinline__ void gemm_tile(const Params& p, const bf16* A, const bf16* Bt, int K, int mt, int nt, int mode, char* smem) {
    const int tid = otid(), lane = tid & 63, wave = tid >> 6;
    bf16* As = (bf16*)smem;
    bf16* Bs = As + 128 * LS;
    const int wm = (wave & 3) * 32, wn = (wave >> 2) * 64;
    f32x4 acc[2][4];
#pragma unroll
    for (int i = 0; i < 2; ++i)
#pragma unroll
        for (int j = 0; j < 4; ++j) acc[i][j] = (f32x4){0.f, 0.f, 0.f, 0.f};
    const int lr = tid >> 3, lc = tid & 7;
    const bf16* Ag = A + (size_t)(mt * 128 + lr) * K + lc * 8;
    const bf16* Bg = Bt + (size_t)(nt * 128 + lr) * K + lc * 8;
    u32x4 ra0, ra1, rb0, rb1;
    ra0 = *(const u32x4*)(Ag); ra1 = *(const u32x4*)(Ag + (size_t)64 * K); rb0 = *(const u32x4*)(Bg); rb1 = *(const u32x4*)(Bg + (size_t)64 * K);
    const int nk = K / 64;
    for (int kt = 0; kt < nk; ++kt) {
        __syncthreads();
        *(u32x4*)(As + lr * LS + lc * 8) = ra0; *(u32x4*)(As + (lr + 64) * LS + lc * 8) = ra1;
        *(u32x4*)(Bs + lr * LS + lc * 8) = rb0; *(u32x4*)(Bs + (lr + 64) * LS + lc * 8) = rb1;
        __syncthreads();
        if (kt + 1 < nk) { const int ko = (kt + 1) * 64;
            ra0 = *(const u32x4*)(Ag + ko); ra1 = *(const u32x4*)(Ag + (size_t)64 * K + ko); rb0 = *(const u32x4*)(Bg + ko); rb1 = *(const u32x4*)(Bg + (size_t)64 * K + ko); }
        mma_nt<4, 2>(As, LS, wm, Bs, LS, wn, acc[0], lane);
        mma_nt<4, 2>(As, LS, wm + 16, Bs, LS, wn, acc[1], lane);
    }
    const int r = lane & 15, q = lane >> 4;
#pragma unroll
    for (int i = 0; i < 2; ++i)
#pragma unroll
        for (int j = 0; j < 4; ++j)
#pragma unroll
            for (int e = 0; e < 4; ++e) {
                const int row = mt * 128 + wm + 16 * i + 4 * q + e, col = nt * 128 + wn + 16 * j + r; const float v = acc[i][j][e];
                if (mode == 0) { if (col < NP) ((bf16*)(p.ws + WS_P))[(size_t)row * NP + col] = f2bf(v); else if (col < NP + 16) ((float*)(p.ws + WS_G))[(size_t)row * NGS + (col - NP)] = v; else if (col < NP + NG) ((bf16*)((float*)(p.ws + WS_G) + (size_t)row * NGS + 16))[col - NP - 16] = f2bf(v); }
                else if (mode == 2) ((bf16*)(p.ws + WS_HT))[(size_t)row * T + col] = f2bf(v);
                else ((bf16*)(p.ws + WS_P))[(size_t)row * DM + col] = f2bf(v);
            }
}

#ifndef EMU
namespace pg8 {
#define PG8_LAS __attribute__((address_space(3)))
typedef unsigned short bf16_t;
typedef short bf16x8 __attribute__((ext_vector_type(8)));
typedef float f32x4 __attribute__((ext_vector_type(4)));
typedef unsigned u32x4 __attribute__((ext_vector_type(4)));
constexpr int BM = 256, BK = 64, HALF = 128, HTB = HALF * BK * 2  , STAGE_BYTES = 8 * HTB, NXCD = 8, WGM = 8;

__host__ __device__ __forceinline__ int lds_byte(int r, int c) { const int st = (r >> 4) * 2 + (c >> 5), rr = r & 15, cc = c & 31, ob = rr * 64 + cc * 2; return st * 1024 + (ob ^ (((ob >> 9) & 1) << 5)); }
__host__ __device__ __forceinline__ void stage_rc(int b, int& R, int& C) { const int st = b / 1024, sb = b % 1024, swz = sb ^ (((sb >> 9) & 1) << 5); R = (st >> 1) * 16 + swz / 64; C = (st & 1) * 32 + (swz % 64) / 2; }
__host__ __device__ __forceinline__ int perm32(int rho) { const int n = rho >> 4, i = rho & 15; return 8 * (i >> 2) + 4 * n + (i & 3); }

struct Unit { int pm, pn; };
struct Gemm { const bf16_t* A; const bf16_t* Bt; int M, N, K; };
__device__ __forceinline__ unsigned cvt_pk_bf16(float lo, float hi) { unsigned r; asm volatile("v_cvt_pk_bf16_f32 %0, %1, %2" : "=v"(r) : "v"(lo), "v"(hi)); return r; }
template <class Epi, class Sched, bool ALIGN_EPI = false, bool SP2 = false>
__device__ __forceinline__ void gemm_phase(PG8_LAS unsigned char* lds, const Gemm g, const Sched& S, const Epi& E) {
    const int tid = otid(), wid = __builtin_amdgcn_readfirstlane(tid >> 6), lane = tid & 63, wr = wid >> 2, wc = wid & 3, fr = lane & 15, fq = lane >> 4;
    const int K = g.K, nt = K / BK;
    unsigned voffA[2], voffB[2];
#pragma unroll
    for (int i = 0; i < 2; ++i) { int R, C; stage_rc(tid * 16 + i * 8192, R, C); const int Rb = Epi::PERM ? ((R & ~31) + perm32(R & 31)) : R;
        voffA[i] = (unsigned)(R * K + C) * 2u; voffB[i] = (unsigned)(Rb * K + C) * 2u; }
    const size_t kstep = (size_t)(BK * 2);
    const size_t hstep = (size_t)HALF * K * 2;
    const size_t tstep = 2 * hstep;
    const unsigned ldsw = (unsigned)wid * 1024u;
    const int aoff = lds_byte(wr * 64 + fr, fq * 8), boff = lds_byte(wc * 32 + fr, fq * 8);
#define PG8_SA(b, h) (((b) * 2 + (h)) * HTB)
#define PG8_SB(b, h) ((4 + (b) * 2 + (h)) * HTB)
#define PG8_STAGE(bufoff, gbase, voff) do { _Pragma("unroll") for (int _i = 0; _i < 2; ++_i) \
        __builtin_amdgcn_global_load_lds((const unsigned*)((const char*)(gbase) + (voff)[_i]), (PG8_LAS unsigned*)(lds + (bufoff) + ldsw + _i * 8192), 16, 0, 0); } while (0)
#define PG8_LDA(dst, b, h) do { _Pragma("unroll") for (int m = 0; m < 4; ++m) _Pragma("unroll") for (int k = 0; k < 2; ++k) dst[m][k] = *(const PG8_LAS bf16x8*)(lds + PG8_SA(b, h) + aoff + m * 2048 + k * 1024); } while (0)
#define PG8_LDB(dst, b, h) do { _Pragma("unroll") for (int n = 0; n < 2; ++n) _Pragma("unroll") for (int k = 0; k < 2; ++k) dst[n][k] = *(const PG8_LAS bf16x8*)(lds + PG8_SB(b, h) + boff + n * 2048 + k * 1024); } while (0)
#define PG8_MMA(ai, bj, At, Bt) do { __builtin_amdgcn_s_setprio(1); _Pragma("unroll") for (int m = 0; m < 4; ++m) _Pragma("unroll") for (int n = 0; n < 2; ++n) _Pragma("unroll") for (int k = 0; k < 2; ++k) \
        acc[ai][bj][m][n] = __builtin_amdgcn_mfma_f32_16x16x32_bf16(Bt[n][k], At[m][k], acc[ai][bj][m][n], 0, 0, 0); __builtin_amdgcn_s_setprio(0); } while (0)
#define PG8_WAIT_V(n) asm volatile("s_waitcnt vmcnt(" #n ")" ::: "memory")
#define PG8_WAIT_L(n) asm volatile("s_waitcnt lgkmcnt(" #n ")" ::: "memory")
#define PG8_BAR __builtin_amdgcn_s_barrier()
#define PG8_SCHED __builtin_amdgcn_sched_barrier(0)
    Unit cur, nxt; int ui = 0;
    if (!S.next(0, cur)) return;
    f32x4 acc[2][2][4][2];
#pragma unroll
    for (int a = 0; a < 2; ++a)
#pragma unroll
        for (int b = 0; b < 2; ++b)
#pragma unroll
            for (int m = 0; m < 4; ++m)
#pragma unroll
                for (int n = 0; n < 2; ++n) acc[a][b][m][n] = (f32x4){0.f, 0.f, 0.f, 0.f};
    bf16x8 At[4][2], B0[2][2], B1[2][2];
    const char* cA = (const char*)g.A + (size_t)cur.pm * tstep; const char* cB = (const char*)g.Bt + (size_t)cur.pn * tstep;
    S.a_ready(cur);
    if constexpr (SP2) {
        PG8_STAGE(PG8_SB(0, 0), cB, voffB); PG8_STAGE(PG8_SB(0, 1), cB + hstep, voffB); PG8_STAGE(PG8_SA(0, 0), cA, voffA); PG8_STAGE(PG8_SA(0, 1), cA + hstep, voffA);
        if (wr == 1) PG8_BAR;
        PG8_WAIT_V(2); PG8_BAR;
        PG8_STAGE(PG8_SB(1, 0), cB + kstep, voffB); PG8_STAGE(PG8_SA(1, 0), cA + kstep, voffA); PG8_STAGE(PG8_SB(1, 1), cB + hstep + kstep, voffB);
        PG8_WAIT_V(6); PG8_BAR;
    } else {
        PG8_STAGE(PG8_SB(0, 0), cB, voffB); PG8_STAGE(PG8_SA(0, 0), cA, voffA); PG8_STAGE(PG8_SB(0, 1), cB + hstep, voffB); PG8_STAGE(PG8_SA(0, 1), cA + hstep, voffA);
        if (wr == 1) PG8_BAR;
        PG8_WAIT_V(4); PG8_BAR;
        PG8_STAGE(PG8_SB(1, 0), cB + kstep, voffB); PG8_STAGE(PG8_SA(1, 0), cA + kstep, voffA); PG8_STAGE(PG8_SB(1, 1), cB + hstep + kstep, voffB);
        PG8_WAIT_V(6); PG8_BAR;
    }
    for (;;) {
        const bool has_next = S.next(ui + 1, nxt);
        const char* nA = has_next ? (const char*)g.A + (size_t)nxt.pm * tstep : cA; const char* nB = has_next ? (const char*)g.Bt + (size_t)nxt.pn * tstep : cB;
        for (int t = 0; t < nt; t += 2) {
            const bool last = (t == nt - 2);
            const char* a1 = cA + (size_t)(t + 1) * kstep;
            const char* a2 = last ? nA : cA + (size_t)(t + 2) * kstep; const char* b2 = last ? nB : cB + (size_t)(t + 2) * kstep;
            const char* a3 = a2 + kstep; const char* b3 = b2 + kstep;
            if (last && has_next) S.a_ready(nxt);
            if constexpr (SP2) {
            PG8_LDB(B0, 0, 0); PG8_LDB(B1, 0, 1); PG8_SCHED; PG8_LDA(At, 0, 0); PG8_STAGE(PG8_SA(1, 1), a1 + hstep, voffA);
            PG8_WAIT_V(8); PG8_WAIT_L(0); PG8_BAR; PG8_MMA(0, 0, At, B0); PG8_MMA(0, 1, At, B1); PG8_BAR; PG8_SCHED;
            PG8_LDA(At, 0, 1); PG8_STAGE(PG8_SB(0, 0), b2, voffB); PG8_STAGE(PG8_SB(0, 1), b2 + hstep, voffB); PG8_STAGE(PG8_SA(0, 0), a2, voffA);
            PG8_WAIT_V(8); PG8_WAIT_L(0); PG8_BAR; PG8_MMA(1, 0, At, B0); PG8_MMA(1, 1, At, B1); PG8_BAR; PG8_SCHED;
            PG8_LDB(B0, 1, 0); PG8_LDB(B1, 1, 1); PG8_SCHED; PG8_LDA(At, 1, 0); PG8_STAGE(PG8_SA(0, 1), a2 + hstep, voffA);
            PG8_WAIT_V(8); PG8_WAIT_L(0); PG8_BAR; PG8_MMA(0, 0, At, B0); PG8_MMA(0, 1, At, B1); PG8_BAR; PG8_SCHED;
            PG8_LDA(At, 1, 1); PG8_STAGE(PG8_SB(1, 0), b3, voffB); PG8_STAGE(PG8_SB(1, 1), b3 + hstep, voffB); PG8_STAGE(PG8_SA(1, 0), a3, voffA);
            PG8_WAIT_V(8); PG8_WAIT_L(0); PG8_BAR; PG8_MMA(1, 0, At, B0); PG8_MMA(1, 1, At, B1); PG8_BAR; PG8_SCHED;
            } else {
            PG8_LDB(B0, 0, 0); PG8_SCHED; PG8_LDA(At, 0, 0); PG8_STAGE(PG8_SA(1, 1), a1 + hstep, voffA);
            PG8_WAIT_L(8); PG8_BAR; PG8_WAIT_L(0); PG8_MMA(0, 0, At, B0); PG8_BAR; PG8_SCHED;
            PG8_LDB(B1, 0, 1); PG8_STAGE(PG8_SB(0, 0), b2, voffB);
            PG8_BAR; PG8_WAIT_L(0); PG8_MMA(0, 1, At, B1); PG8_BAR;
            PG8_LDA(At, 0, 1); PG8_STAGE(PG8_SA(0, 0), a2, voffA);
            PG8_BAR; PG8_WAIT_L(0); PG8_MMA(1, 0, At, B0); PG8_BAR; PG8_SCHED;
            PG8_STAGE(PG8_SB(0, 1), b2 + hstep, voffB);
            PG8_WAIT_V(6); PG8_BAR; PG8_MMA(1, 1, At, B1); PG8_BAR;
            PG8_LDB(B0, 1, 0); PG8_SCHED; PG8_LDA(At, 1, 0); PG8_STAGE(PG8_SA(0, 1), a2 + hstep, voffA);
            PG8_WAIT_L(8); PG8_BAR; PG8_WAIT_L(0); PG8_MMA(0, 0, At, B0); PG8_BAR; PG8_SCHED;
            PG8_LDB(B1, 1, 1); PG8_STAGE(PG8_SB(1, 0), b3, voffB);
            PG8_BAR; PG8_WAIT_L(0); PG8_MMA(0, 1, At, B1); PG8_BAR;
            PG8_LDA(At, 1, 1); PG8_STAGE(PG8_SA(1, 0), a3, voffA);
            PG8_BAR; PG8_WAIT_L(0); PG8_MMA(1, 0, At, B0); PG8_BAR; PG8_SCHED;
            PG8_STAGE(PG8_SB(1, 1), b3 + hstep, voffB);
            PG8_WAIT_V(6); PG8_BAR; PG8_MMA(1, 1, At, B1); PG8_BAR;
            }
        }
        if constexpr (ALIGN_EPI) { if (wr == 0) PG8_BAR; }
        if constexpr (!Epi::AFTER_DRAIN) { E(acc, cur, wr, wc, fr, fq); S.done(cur); }
        if (!has_next) break;
#pragma unroll
        for (int a = 0; a < 2; ++a)
#pragma unroll
            for (int b = 0; b < 2; ++b)
#pragma unroll
                for (int m = 0; m < 4; ++m)
#pragma unroll
                    for (int n = 0; n < 2; ++n) acc[a][b][m][n] = (f32x4){0.f, 0.f, 0.f, 0.f};
        cur = nxt; cA = nA; cB = nB; ++ui;
        if constexpr (ALIGN_EPI) { if (wr == 1) PG8_BAR; }
    }
    PG8_WAIT_V(0);
    if constexpr (!ALIGN_EPI) { if (wr == 0) PG8_BAR; }
    PG8_BAR;
    if constexpr (Epi::AFTER_DRAIN) { E.fused(acc, cur, wr, wc, fr, fq, lds, wid, lane); S.done(cur); }
#undef PG8_SA
#undef PG8_SB
#undef PG8_STAGE
#undef PG8_LDA
#undef PG8_LDB
#undef PG8_MMA
#undef PG8_WAIT_V
#undef PG8_WAIT_L
#undef PG8_BAR
#undef PG8_SCHED
}
__device__ __forceinline__ void map_tile(int L, int nM, int nN, int& pm, int& pn) {
    const int nwg = nM * nN; int wgid = L; { const int q = nwg / NXCD, r = nwg % NXCD, xcd = wgid % NXCD, off = wgid / NXCD; wgid = (xcd < r ? xcd * (q + 1) : r * (q + 1) + (xcd - r) * q) + off; }
    const int nig = WGM * nN, gid = wgid / nig, fm = gid * WGM, gsz = (nM - fm) < WGM ? (nM - fm) : WGM;
    pm = fm + ((wgid % nig) % gsz); pn = (wgid % nig) / gsz;
}
constexpr int MP = T / 256, WP = NMAIN / 256, NU2 = 4 * MP, NU1 = MP * WP;
struct InOrder { int G, c;
    __device__ __forceinline__ bool next(int i, Unit& u) const { const int L = i * G + c; if (L >= NU2 + NU1) return false; int a, b;
        if (L < NU2) { map_tile(L, 4, MP, a, b); u.pm = MP + WP + a; u.pn = b; } else { map_tile(L - NU2, MP, WP, a, b); u.pm = a; u.pn = MP + b; } return true; }
    __device__ __forceinline__ void a_ready(const Unit&) const {}
    __device__ __forceinline__ void done(const Unit&) const {}
};
struct EpiIn { static constexpr bool PERM = true, AFTER_DRAIN = false; bf16_t* P; float* G; bf16_t* HTp;
    __device__ __forceinline__ void operator()(const f32x4 (&acc)[2][2][4][2], const Unit& u, int wr, int wc, int fr, int fq) const {
        if (u.pm < MP) { const int pn = u.pn - MP, row0 = u.pm * BM + wr * 64 + fr;
            if (pn < NP / 256) { const int col0 = pn * BM + wc * 32 + 8 * fq;
#pragma unroll
                for (int ai = 0; ai < 2; ++ai)
#pragma unroll
                    for (int m = 0; m < 4; ++m) { bf16_t* rowp = P + (size_t)(row0 + ai * HALF + m * 16) * NP + col0;
#pragma unroll
                        for (int bj = 0; bj < 2; ++bj) { const f32x4 v0 = acc[ai][bj][m][0], v1 = acc[ai][bj][m][1];
                            u32x4 w; w.x = cvt_pk_bf16(v0[0], v0[1]); w.y = cvt_pk_bf16(v0[2], v0[3]); w.z = cvt_pk_bf16(v1[0], v1[1]); w.w = cvt_pk_bf16(v1[2], v1[3]); *(u32x4*)(rowp + bj * HALF) = w; } } }
            else { const int cb = wc * 32 + 8 * fq;
                if (cb < NG) {
#pragma unroll
                    for (int ai = 0; ai < 2; ++ai)
#pragma unroll
                        for (int m = 0; m < 4; ++m) { float* rowb = G + (size_t)(row0 + ai * HALF + m * 16) * NGS; const f32x4 v0 = acc[ai][0][m][0], v1 = acc[ai][0][m][1];
                            if (cb < 16) { *(f32x4*)(rowb + cb) = v0; *(f32x4*)(rowb + cb + 4) = v1; }
                            else { u32x4 w; w.x = cvt_pk_bf16(v0[0], v0[1]); w.y = cvt_pk_bf16(v0[2], v0[3]); w.z = cvt_pk_bf16(v1[0], v1[1]); w.w = cvt_pk_bf16(v1[2], v1[3]); *(u32x4*)((bf16_t*)(rowb + 16) + (cb - 16)) = w; } } } } }
        else { const int row0 = (u.pm - MP - WP) * BM + wr * 64 + fr, col0 = u.pn * BM + wc * 32 + 8 * fq;
#pragma unroll
            for (int ai = 0; ai < 2; ++ai)
#pragma unroll
                for (int m = 0; m < 4; ++m) { bf16_t* rowp = HTp + (size_t)(row0 + ai * HALF + m * 16) * T + col0;
#pragma unroll
                    for (int bj = 0; bj < 2; ++bj) { const f32x4 v0 = acc[ai][bj][m][0], v1 = acc[ai][bj][m][1];
                        u32x4 w; w.x = cvt_pk_bf16(v0[0], v0[1]); w.y = cvt_pk_bf16(v0[2], v0[3]); w.z = cvt_pk_bf16(v1[0], v1[1]); w.w = cvt_pk_bf16(v1[2], v1[3]); *(u32x4*)(rowp + bj * HALF) = w; } } }
    }
};
struct OutOrder { int G, c; bool lat_only; unsigned* cnt;
    __device__ __forceinline__ bool next(int i, Unit& u) const { constexpr int nN = DM / 256, nLat = NB * (SEQ / 256) * nN, nCtx = NB * (CTXL / 256) * nN; const int L = i * G + c; int a, b;
        if (L < nLat) { map_tile(L, nLat / nN, nN, a, b); u.pm = (a / (SEQ / 256)) * (TOK / 256) + CTXL / 256 + a % (SEQ / 256); }
        else { if (lat_only || L >= nLat + nCtx) return false; map_tile(L - nLat, nCtx / nN, nN, a, b); u.pm = (a / (CTXL / 256)) * (TOK / 256) + a % (CTXL / 256); }
        u.pn = b; return true; }
    __device__ __forceinline__ void a_ready(const Unit&) const {}
    unsigned* xu; unsigned nloc, xtarget;
    __device__ __forceinline__ void done(const Unit& u) const {
        asm volatile("s_waitcnt vmcnt(0)" ::: "memory"); __builtin_amdgcn_s_barrier();
        if (threadIdx.x == 0) { const bool isctx = (u.pm % (TOK / 256)) < CTXL / 256;
            if (!isctx && xtarget != 0u) {
                const unsigned old = __hip_atomic_fetch_add(xu, 1u, __ATOMIC_RELAXED, __HIP_MEMORY_SCOPE_AGENT);
                if (old + 1u == xtarget) { __builtin_amdgcn_fence(__ATOMIC_RELEASE, "agent"); asm volatile("s_waitcnt vmcnt(0)" ::: "memory");
                    __hip_atomic_fetch_add(cnt, nloc, __ATOMIC_RELAXED, __HIP_MEMORY_SCOPE_AGENT); } }
            else { __builtin_amdgcn_fence(__ATOMIC_RELEASE, "agent"); asm volatile("s_waitcnt vmcnt(0)" ::: "memory");
                __hip_atomic_fetch_add(cnt + (isctx ? 64 : 0), 1u, __ATOMIC_RELAXED, __HIP_MEMORY_SCOPE_AGENT); } } }
};
struct EpiOut { static constexpr bool PERM = true, AFTER_DRAIN = false; bf16_t* C;
    __device__ __forceinline__ void operator()(const f32x4 (&acc)[2][2][4][2], const Unit& u, int wr, int wc, int fr, int fq) const {
        const int row0 = u.pm * BM + wr * 64 + fr, col0 = u.pn * BM + wc * 32 + 8 * fq;
#pragma unroll
        for (int ai = 0; ai < 2; ++ai)
#pragma unroll
            for (int m = 0; m < 4; ++m) { bf16_t* rowp = C + (size_t)(row0 + ai * HALF + m * 16) * DM + col0;
#pragma unroll
                for (int bj = 0; bj < 2; ++bj) { const f32x4 v0 = acc[ai][bj][m][0], v1 = acc[ai][bj][m][1];
                    u32x4 w; w.x = cvt_pk_bf16(v0[0], v0[1]); w.y = cvt_pk_bf16(v0[2], v0[3]); w.z = cvt_pk_bf16(v1[0], v1[1]); w.w = cvt_pk_bf16(v1[2], v1[3]); *(u32x4*)(rowp + bj * HALF) = w; } }
    }
};
}
#endif

__device__ __forceinline__ void phase_gemm_in(const Params& p, int l, char* smem) {
    constexpr int N_F = WG / 2;
#ifdef EMU
    constexpr int MT = T / 128, NT1 = NMAIN / 128, N1 = MT * NT1, N2 = 8 * MT;
    for (int task = obid(); task < N1 + N2; task += gridDim.x) {
        if (task < N1) gemm_tile(p, (const bf16*)(p.ws + WS_HNY), (const bf16*)(p.ws + WS_WIN), DM, task / NT1, task % NT1, 0, smem);
        else { const int t2 = task - N1; gemm_tile(p, (const bf16*)(p.ws + WS_WIN) + (size_t)NMAIN * DM, (const bf16*)(p.ws + WS_HNY), DM, t2 / MT, t2 % MT, 2, smem); }
    }
#else
    { const pg8::Gemm g{(const pg8::bf16_t*)(p.ws + WS_HNY), (const pg8::bf16_t*)(p.ws + WS_HNY), 0, 0, DM};
      const pg8::InOrder S{(int)gridDim.x, obid()};
      const pg8::EpiIn E{(pg8::bf16_t*)(p.ws + WS_P), (float*)(p.ws + WS_G), (pg8::bf16_t*)(p.ws + WS_HT)};
      pg8::gemm_phase<pg8::EpiIn, pg8::InOrder, true, true>((PG8_LAS unsigned char*)smem, g, S, E); }
#endif
    { const int G = (int)gridDim.x, bid = obid();
#ifdef EMU
      const int extra = 0;
#else
      const int extra = (pg8::NU1 + pg8::NU2) % G;
#endif
      if (extra > 0 && extra < G) { if (bid >= extra) for (int task = bid - extra; task < N_F; task += G - extra) filt_fft_task(p, task, smem); }
      else for (int task = G - 1 - bid; task < N_F; task += G) filt_fft_task(p, task, smem); }
}
__device__ __forceinline__ void phase_gemm_out(const Params& p, int l, char* smem) {
    const int G = (int)gridDim.x, bid = obid(); const bool has_ctx = l < DEPTH - 1;
#ifdef EMU
    constexpr int MT = T / 128, NTO = DM / 128;
    for (int task = bid; task < MT * NTO; task += G) {
        const int mt = task / NTO, nt = task % NTO;
        if (!has_ctx && (mt % (TOK / 128)) < CTXL / 128) continue;
        gemm_tile(p, (const bf16*)(p.ws + WS_HNY), (const bf16*)(p.ws + WS_WOUT), MIX, mt, nt, 1, smem);
        __syncthreads(); if (otid() == 0) *unit_counter(p, (mt % (TOK / 128)) < CTXL / 128 ? 1 : 0) += 1u;
    }
#else
    const pg8::Gemm g{(const pg8::bf16_t*)(p.ws + WS_HNY), (const pg8::bf16_t*)(p.ws + WS_WOUT), 0, 0, MIX};
    const unsigned xcc = (unsigned)__builtin_amdgcn_s_getreg((3 << 11) | 20) & 0xFu, nloc = ((volatile PG8_LAS unsigned*)(smem + LDS_BYTES - 64))[0];
    const bool agg = (NB * (SEQ / 256) * (DM / 256) == G) && nloc > 0u;
    const pg8::OutOrder S{G, bid, !has_ctx, unit_counter(p, 0), unit_counter(p, 2) + 16 * xcc, nloc, agg ? nloc * (unsigned)(l + 1) : 0u};
    const pg8::EpiOut E{(pg8::bf16_t*)(p.ws + WS_P)};
    pg8::gemm_phase<pg8::EpiOut, pg8::OutOrder, true, true>((PG8_LAS unsigned char*)smem, g, S, E);
#endif
}

__device__ __forceinline__ size_t st_index(int mixer, int dir, int b, int h, int cid) { return ((((size_t)(mixer * 2 + dir) * NB + b) * NH + h) * NCH + cid); }
__device__ __forceinline__ size_t ch_index(int dir, int b, int h, int cid) { return (((size_t)dir * NB + b) * NH + h) * NCH + cid; }

__device__ __forceinline__ void load_tile_nat(const bf16* P, int r0, int c0, bf16* dst, float scale, int tid) {
    const int s = tid >> 3, c8 = tid & 7;
    const u32x4 v = *(const u32x4*)(P + (size_t)(r0 + s) * NP + c0 + c8 * 8);
    if (scale == 1.0f) *(u32x4*)(dst + s * LS + c8 * 8) = v;
    else { float f[8]; unpack8(v, f); u32x4 o; o.x = pk2(f[0] * scale, f[1] * scale); o.y = pk2(f[2] * scale, f[3] * scale); o.z = pk2(f[4] * scale, f[5] * scale); o.w = pk2(f[6] * scale, f[7] * scale);
        *(u32x4*)(dst + s * LS + c8 * 8) = o; }
}
__device__ __forceinline__ void load_tile_tr(const bf16* P, int r0, int c0, bf16* dst, int tid) {
    const int s = tid >> 3, c8 = tid & 7;
    const u32x4 v = *(const u32x4*)(P + (size_t)(r0 + s) * NP + c0 + c8 * 8);
    const unsigned w[4] = {v.x, v.y, v.z, v.w};
#pragma unroll
    for (int j = 0; j < 4; ++j) { dst[(c8 * 8 + 2 * j) * LS + s] = (bf16)(w[j] & 0xffffu); dst[(c8 * 8 + 2 * j + 1) * LS + s] = (bf16)(w[j] >> 16); }
}

template <int NTK>
__device__ __forceinline__ void load_span(const bf16* row, int t0, float (&v)[NTK + 2]) {
    { const bool hl = t0 > 0, hr = t0 + NTK < SEQ; const bf16 xl = row[hl ? -1 : 0], xr = row[hr ? NTK : 0];
        v[0] = hl ? bf2f(xl) : 0.f; v[NTK + 1] = hr ? bf2f(xr) : 0.f; }
    if constexpr (NTK == 8) { float f[8]; unpack8(*(const u32x4*)row, f);
#pragma unroll
        for (int i = 0; i < 8; ++i) v[1 + i] = f[i]; }
    else {
#pragma unroll
        for (int i = 0; i < NTK; ++i) v[1 + i] = bf2f(row[i]); }
}
template <int NTK>
__device__ __forceinline__ void hy_inputs(const bf16* h0, const bf16* h1, const float* cw, const float* cb, int c, int t0, float (&u0)[NTK], float (&u1)[NTK], float (&g0)[NTK], float (&g1)[NTK]) {
    { float xa[NTK + 2], xb[NTK + 2]; load_span<NTK>(h0 + (size_t)512 * T, t0, xa); load_span<NTK>(h1 + (size_t)512 * T, t0, xb);
        const float w0 = cw[0 * 768 + 512 + c], w1 = cw[1 * 768 + 512 + c], w2 = cw[2 * 768 + 512 + c], bb = cb[512 + c];
        float ga[NTK + 2], gb[NTK + 2]; load_span<NTK>(h0 + (size_t)768 * T, t0, ga); load_span<NTK>(h1 + (size_t)768 * T, t0, gb);
#pragma unroll
        for (int i = 0; i < NTK; ++i) { g0[i] = (w0 * xa[i] + w1 * xa[i + 1] + w2 * xa[i + 2] + bb) * siluf_(ga[i + 1]); g1[i] = (w0 * xb[i] + w1 * xb[i + 1] + w2 * xb[i + 2] + bb) * siluf_(gb[i + 1]); } }
    { float va[NTK + 2], vb[NTK + 2], ya[NTK + 2], yb[NTK + 2];
        load_span<NTK>(h0, t0, va); load_span<NTK>(h1, t0, vb); load_span<NTK>(h0 + (size_t)256 * T, t0, ya); load_span<NTK>(h1 + (size_t)256 * T, t0, yb);
        const float v0 = cw[0 * 768 + c], v1 = cw[1 * 768 + c], v2 = cw[2 * 768 + c], vbias = cb[c];
        const float y0 = cw[0 * 768 + 256 + c], y1 = cw[1 * 768 + 256 + c], y2 = cw[2 * 768 + 256 + c], ybias = cb[256 + c];
#pragma unroll
        for (int i = 0; i < NTK; ++i) { u0[i] = (v0 * va[i] + v1 * va[i + 1] + v2 * va[i + 2] + vbias) * (y0 * ya[i] + y1 * ya[i + 1] + y2 * ya[i + 2] + ybias);
            u1[i] = (v0 * vb[i] + v1 * vb[i + 1] + v2 * vb[i + 2] + vbias) * (y0 * yb[i] + y1 * yb[i + 1] + y2 * yb[i + 2] + ybias); } }
}
__device__ __forceinline__ void hylat_task(const Params& p, int l, int bp, int cp, char* smem) {
    const int tid = otid(), half = tid >> 8, tl = tid & 255, c = 2 * cp + half;
    const bf16* HT = (const bf16*)(p.ws + WS_HT); bf16* Y = (bf16*)(p.ws + WS_HNY);
    cpx* buf = (cpx*)smem + (size_t)half * FBUF;
    const cpx* TW = (const cpx*)(p.ws + WS_TW);
    const cpx* KF = (const cpx*)(p.ws + WS_KF) + (size_t)c * NF;
    constexpr int NTK = SEQ / 256;
    const int t0 = NTK * tl;
    const float* cw = p.in[I_HCW] + (size_t)l * 3 * 768; const float* cb = p.in[I_HCB] + (size_t)l * 768;
    const size_t rb0 = (size_t)(2 * bp) * TOK + CTXL, rb1 = rb0 + TOK;
    const bf16* h0 = HT + (size_t)c * T + rb0 + t0; const bf16* h1 = h0 + TOK;
    { float u0[NTK], u1[NTK], g0[NTK], g1[NTK]; hy_inputs<NTK>(h0, h1, cw, cb, c, t0, u0, u1, g0, g1);
        __syncthreads();
#pragma unroll
        for (int i = 0; i < NTK; ++i) { cpx v; v.x = u0[i]; v.y = u1[i]; buf[FPH(t0 + i)] = v; cpx z = {0.f, 0.f}; buf[FPH(SEQ + t0 + i)] = z; } }
    fft_fwd(buf, TW, tl);
#pragma unroll 2
    for (int i = tl; i < NF; i += 256) buf[FPH(i)] = cmul(buf[FPH(i)], KF[i]);
    fft_inv(buf, TW, tl);
    const float dsk = p.in[I_HD][(size_t)l * WG + c]; const float sc = 1.0f / (float)NF;
    { const int tz = otid() & 255; const int t0z = NTK * tz;
        float u0[NTK], u1[NTK], g0[NTK], g1[NTK]; hy_inputs<NTK>(HT + (size_t)c * T + rb0 + t0z, HT + (size_t)c * T + rb0 + t0z + TOK, cw, cb, c, t0z, u0, u1, g0, g1);
        float o0[NTK], o1[NTK];
#pragma unroll
        for (int i = 0; i < NTK; ++i) { const cpx y = buf[FPH(t0z + i)]; o0[i] = g0[i] * (y.x * sc + u0[i] * dsk); o1[i] = g1[i] * (y.y * sc + u1[i] * dsk); }
        bf16* d0 = (bf16*)(p.ws + WS_HT) + (size_t)(768 + c) * T + rb0 + t0z; bf16* d1 = d0 + TOK;
        if constexpr (NTK == 8) { *(u32x4*)d0 = pack8(o0); *(u32x4*)d1 = pack8(o1); }
        else {
#pragma unroll
            for (int i = 0; i < NTK; ++i) { d0[i] = f2bf(o0[i]); d1[i] = f2bf(o1[i]); } } }
}

constexpr int HCB = 16;
__device__ __forceinline__ void hyctx_task(const Params& p, int l, int b, int cblk, char* smem) {
    const int tid = otid(); const int c0 = cblk * HCB;
    const bf16* HT = (const bf16*)(p.ws + WS_HT); bf16* Y = (bf16*)(p.ws + WS_HNY); const float* HC = (const float*)(p.ws + WS_HC);
    float* raw = (float*)smem;
    float* u = raw + 4 * CTXL * HCB;
    float* og = u + CTXL * HCB;
    float* hcm = og + CTXL * HCB;
    bf16* ob = (bf16*)raw;
    const size_t rb = (size_t)b * TOK;
    const float* cw = p.in[I_HCW] + (size_t)l * 3 * 768; const float* cbias = p.in[I_HCB] + (size_t)l * 768;
    constexpr int WT = CTXL / 32;
    __syncthreads();
    for (int i = tid; i < 4 * HCB * (CTXL / 8); i += NT) { const int k = i / (HCB * (CTXL / 8)), cc = (i / (CTXL / 8)) % HCB, ck = i % (CTXL / 8);
        float f[8]; unpack8(*(const u32x4*)(HT + (size_t)(k * 256 + c0 + cc) * T + rb + ck * 8), f);
#pragma unroll
        for (int j = 0; j < 8; ++j) raw[(k * CTXL + ck * 8 + j) * HCB + cc] = f[j]; }
    for (int i = tid; i < 2 * HCB * (CTXL / 4); i += NT) { const int dir = i / (HCB * (CTXL / 4)), cc = (i / (CTXL / 4)) % HCB, pk = i % (CTXL / 4);
        const f32x4 v = *(const f32x4*)(HC + ((size_t)dir * WG + c0 + cc) * CTXL + pk * 4); const float f[4] = {v.x, v.y, v.z, v.w};
#pragma unroll
        for (int j = 0; j < 4; ++j) { const int pos = pk * 4 + j; if (dir == 0) hcm[(CTXL + pos) * HCB + cc] = f[j]; else if (pos > 0) hcm[(CTXL - pos) * HCB + cc] = f[j]; } }
    if (tid < HCB) hcm[tid] = 0.f;
    __syncthreads();
    for (int i = tid; i < CTXL * HCB; i += NT) { const int t = i / HCB, cc = i % HCB; float cv[3];
#pragma unroll
        for (int k = 0; k < 3; ++k) { const float* rk = raw + k * CTXL * HCB; const int ch = k * 256 + c0 + cc;
            const float a = t > 0 ? rk[(t - 1) * HCB + cc] : 0.f, m = rk[t * HCB + cc], z = t < CTXL - 1 ? rk[(t + 1) * HCB + cc] : 0.f;
            cv[k] = cw[0 * 768 + ch] * a + cw[1 * 768 + ch] * m + cw[2 * 768 + ch] * z + cbias[ch]; }
        u[i] = cv[0] * cv[1];
        og[i] = cv[2] * siluf_(raw[(3 * CTXL + t) * HCB + cc]); }
    __syncthreads();
    { const int cc = tid % HCB, tg = tid / HCB, t0 = WT * tg; float acc[WT], w[WT];
#pragma unroll
        for (int j = 0; j < WT; ++j) { acc[j] = 0.f; w[j] = hcm[(t0 + j + CTXL) * HCB + cc]; }
#pragma unroll 8
        for (int s = 0; s < CTXL; ++s) { const float us = u[s * HCB + cc];
#pragma unroll
            for (int j = 0; j < WT; ++j) acc[j] += us * w[j];
#pragma unroll
            for (int j = WT - 1; j > 0; --j) w[j] = w[j - 1];
            w[0] = hcm[(t0 - s - 1 + CTXL) * HCB + cc]; }
        const float dsk = p.in[I_HD][(size_t)l * WG + c0 + cc];
#pragma unroll
        for (int j = 0; j < WT; ++j) { const int t = t0 + j; ob[t * HCB + cc] = f2bf(og[t * HCB + cc] * (acc[j] + u[t * HCB + cc] * dsk)); } }
    __syncthreads();
    for (int i = tid; i < CTXL * 2; i += NT) { const int t = i >> 1, hh = i & 1; *(u32x4*)(Y + (rb + t) * 1024 + YH + c0 + 8 * hh) = *(const u32x4*)(ob + t * HCB + 8 * hh); }
}

__device__ __forceinline__ void attn_task(const Params& p, int l, int b, int kvh, int qt, bool ctxq, char* smem) {
    const int tid = otid(), lane = tid & 63, wave = tid >> 6, r = lane & 15, q = lane >> 4;
    constexpr float QSC = 0.125f * 1.4426950408889634f;
    const bf16* P = (const bf16*)(p.ws + WS_P); bf16* Y = (bf16*)(p.ws + WS_HNY); const cpx* ROPE = (const cpx*)(p.ws + WS_ROPE);
    bf16* Qs = (bf16*)smem;
    bf16* Ks = Qs + 256 * LS;
    bf16* Vt = Ks + 64 * LS;
    bf16* Ps = Vt + 64 * LS;
    const size_t rq0 = (size_t)b * TOK + (ctxq ? 0 : CTXL) + qt * 128;
    __syncthreads();
#pragma unroll
    for (int it = 0; it < 2; ++it) {
        const int idx = tid + NT * it, row = idx >> 2, cpair = idx & 3, g = row >> 7, t = row & 127;
        const bf16* src = P + (rq0 + t) * NP + PD + (kvh * 2 + g) * 64;
        float lo[8], hi[8]; unpack8(*(const u32x4*)(src + cpair * 8), lo); unpack8(*(const u32x4*)(src + 32 + cpair * 8), hi);
        float a[8], c2[8];
#pragma unroll
        for (int j = 0; j < 8; ++j) { float cs = 1.f, sn = 0.f; if (!ctxq) { const cpx cv = ROPE[(size_t)(qt * 128 + t) * 32 + cpair * 8 + j]; cs = cv.x; sn = cv.y; }
            a[j] = (lo[j] * cs - hi[j] * sn) * QSC; c2[j] = (hi[j] * cs + lo[j] * sn) * QSC; }
        *(u32x4*)(Qs + row * LS + cpair * 8) = pack8(a); *(u32x4*)(Qs + row * LS + 32 + cpair * 8) = pack8(c2);
    }
    const int lt0 = ctxq ? 0 : (2 * qt - 2 > 0 ? 2 * qt - 2 : 0), lt1 = ctxq ? -1 : (2 * qt + 3 < SEQ / 64 - 1 ? 2 * qt + 3 : SEQ / 64 - 1);
    const int nloc = lt1 - lt0 + 1, ntiles = nloc + NCC;
    float m[2], lsum[2]; f32x4 O[2][4];
#pragma unroll
    for (int ms = 0; ms < 2; ++ms) { m[ms] = -INFINITY; lsum[ms] = 0.f;
#pragma unroll
        for (int i = 0; i < 4; ++i) O[ms][i] = (f32x4){0.f, 0.f, 0.f, 0.f}; }
    const int g = wave >> 2, tq0 = (wave & 3) * 32;
    (void)Ps;
    __syncthreads();
    bf16x8 qf[2][2];
#pragma unroll
    for (int ms = 0; ms < 2; ++ms)
#pragma unroll
        for (int ks = 0; ks < 2; ++ks) qf[ms][ks] = *(const bf16x8*)(Qs + (g * 128 + tq0 + 16 * ms + r) * LS + ks * 32 + q * 8);
    u32x4 klo = {0u, 0u, 0u, 0u}, khi = klo, vq = klo; f32x4 rp[4] = {(f32x4){1.f, 0.f, 1.f, 0.f}, (f32x4){1.f, 0.f, 1.f, 0.f}, (f32x4){1.f, 0.f, 1.f, 0.f}, (f32x4){1.f, 0.f, 1.f, 0.f}};
    const int ks_ = tid >> 2, kcp = tid & 3, vs_ = tid >> 3, vc8 = tid & 7;
#define ATT_PREFETCH(TI) do { const bool loc_ = (TI) < nloc; const int kt_ = loc_ ? lt0 + (TI) : (TI) - nloc; const size_t rk_ = (size_t)b * TOK + (loc_ ? CTXL : 0) + kt_ * 64; \
        if (tid < 256) { const bf16* src_ = P + (rk_ + ks_) * NP + PD + 256 + kvh * 64; klo = *(const u32x4*)(src_ + kcp * 8); khi = *(const u32x4*)(src_ + 32 + kcp * 8); \
            if (loc_) { const f32x4* rr_ = (const f32x4*)(ROPE + (size_t)(kt_ * 64 + ks_) * 32 + kcp * 8); rp[0] = rr_[0]; rp[1] = rr_[1]; rp[2] = rr_[2]; rp[3] = rr_[3]; } \
            else { rp[0] = rp[1] = rp[2] = rp[3] = (f32x4){1.f, 0.f, 1.f, 0.f}; } } \
        vq = *(const u32x4*)(P + (rk_ + vs_) * NP + PD + 384 + kvh * 64 + vc8 * 8); } while (0)
    ATT_PREFETCH(0);
    for (int ti = 0; ti < ntiles; ++ti) {
        const bool local = ti < nloc; const int kt = local ? lt0 + ti : ti - nloc;
        __syncthreads();
        if (tid < 256) { float lo[8], hi[8]; unpack8(klo, lo); unpack8(khi, hi);
            const float cs[8] = {rp[0].x, rp[0].z, rp[1].x, rp[1].z, rp[2].x, rp[2].z, rp[3].x, rp[3].z}, sn[8] = {rp[0].y, rp[0].w, rp[1].y, rp[1].w, rp[2].y, rp[2].w, rp[3].y, rp[3].w};
            float a[8], c2[8];
#pragma unroll
            for (int j = 0; j < 8; ++j) { a[j] = lo[j] * cs[j] - hi[j] * sn[j]; c2[j] = hi[j] * cs[j] + lo[j] * sn[j]; }
            *(u32x4*)(Ks + ks_ * LS + kcp * 8) = pack8(a); *(u32x4*)(Ks + ks_ * LS + 32 + kcp * 8) = pack8(c2); }
        { const unsigned w[4] = {vq.x, vq.y, vq.z, vq.w};
#pragma unroll
            for (int j = 0; j < 4; ++j) { Vt[(vc8 * 8 + 2 * j) * LS + vs_] = (bf16)(w[j] & 0xffffu); Vt[(vc8 * 8 + 2 * j + 1) * LS + vs_] = (bf16)(w[j] >> 16); } }
        __syncthreads();
        if (ti + 1 < ntiles) ATT_PREFETCH(ti + 1);
        bf16x8 kfr[4][2], vfa[4], vfb[4];
#pragma unroll
        for (int nt = 0; nt < 4; ++nt)
#pragma unroll
            for (int ks = 0; ks < 2; ++ks) kfr[nt][ks] = *(const bf16x8*)(Ks + (16 * nt + r) * LS + ks * 32 + q * 8);
#pragma unroll
        for (int me = 0; me < 4; ++me) { const bf16* vr = Vt + (16 * me + r) * LS + 4 * q;
            const u32x2 a0 = *(const u32x2*)(vr), a1 = *(const u32x2*)(vr + 16), a2 = *(const u32x2*)(vr + 32), a3 = *(const u32x2*)(vr + 48);
            u32x4 va; va.x = a0.x; va.y = a0.y; va.z = a1.x; va.w = a1.y; u32x4 vb; vb.x = a2.x; vb.y = a2.y; vb.z = a3.x; vb.w = a3.y; vfa[me] = as_frag(va); vfb[me] = as_frag(vb); }
#pragma unroll
        for (int ms = 0; ms < 2; ++ms) {
            const int qlo = qt * 128 + tq0 + 16 * ms, klo_ = kt * 64;
            if (local && (klo_ > qlo + 15 + 128 || klo_ + 63 < qlo - 128)) continue;
            const bool domask = local && (klo_ + 63 - qlo > 128 || klo_ - (qlo + 15) < -128);
            f32x4 S[4] = {(f32x4){0.f, 0.f, 0.f, 0.f}, (f32x4){0.f, 0.f, 0.f, 0.f}, (f32x4){0.f, 0.f, 0.f, 0.f}, (f32x4){0.f, 0.f, 0.f, 0.f}};
#pragma unroll
            for (int ks = 0; ks < 2; ++ks)
#pragma unroll
                for (int nt = 0; nt < 4; ++nt) S[nt] = MFMA16(kfr[nt][ks], qf[ms][ks], S[nt]);
            const int qpos = qlo + r; float mx = -INFINITY;
            if (domask) {
#pragma unroll
                for (int nt = 0; nt < 4; ++nt)
#pragma unroll
                    for (int i = 0; i < 4; ++i) { const int d = kt * 64 + nt * 16 + 4 * q + i - qpos; if (d > 128 || d < -128) S[nt][i] = -INFINITY; } }
#pragma unroll
            for (int nt = 0; nt < 4; ++nt)
#pragma unroll
                for (int i = 0; i < 4; ++i) mx = fmaxf(mx, S[nt][i]);
            mx = xrow_max(mx);
            const float mn = fmaxf(m[ms], mx); const float msafe = mn == -INFINITY ? 0.f : mn; const float alpha = EXP2(m[ms] - msafe); float sm = 0.f;
#pragma unroll
            for (int nt = 0; nt < 4; ++nt)
#pragma unroll
                for (int i = 0; i < 4; ++i) { S[nt][i] = EXP2(S[nt][i] - msafe); sm += S[nt][i]; }
            sm = xrow_sum(sm);
            lsum[ms] = lsum[ms] * alpha + sm; m[ms] = mn;
            const float pa[8] = {S[0][0], S[0][1], S[0][2], S[0][3], S[1][0], S[1][1], S[1][2], S[1][3]}, pb[8] = {S[2][0], S[2][1], S[2][2], S[2][3], S[3][0], S[3][1], S[3][2], S[3][3]};
            const bf16x8 p0 = as_frag(pack8(pa)), p1 = as_frag(pack8(pb));
#pragma unroll
            for (int me = 0; me < 4; ++me) { O[ms][me] = O[ms][me] * alpha;
                O[ms][me] = MFMA16(vfa[me], p0, O[ms][me]); O[ms][me] = MFMA16(vfb[me], p1, O[ms][me]); }
        }
    }
#undef ATT_PREFETCH
    const float sink = p.in[I_SINK][(size_t)l * NH + kvh * 2 + g];
#pragma unroll
    for (int ms = 0; ms < 2; ++ms) { const float den = lsum[ms] + EXP2(sink * 1.4426950408889634f - m[ms]); const float inv = frcp_(den);
        const size_t row = rq0 + tq0 + 16 * ms + r; const int col = (kvh * 2 + g) * 64 + 4 * q;
#pragma unroll
        for (int me = 0; me < 4; ++me) { const u32x2 gg = *(const u32x2*)(P + row * NP + PD + 512 + col + 16 * me);
            const float g0 = bitsf(gg.x << 16), g1 = bitsf(gg.x & 0xffff0000u), g2 = bitsf(gg.y << 16), g3 = bitsf(gg.y & 0xffff0000u);
            u32x2 o; o.x = pk2(O[ms][me][0] * inv * siluf_(g0), O[ms][me][1] * inv * siluf_(g1)); o.y = pk2(O[ms][me][2] * inv * siluf_(g2), O[ms][me][3] * inv * siluf_(g3));
            *(u32x2*)(Y + row * 1024 + YD + col + 16 * me) = o; } }
}

#ifdef EMU
__device__ __forceinline__ int olane(int lane) { return lane; }
#else
__device__ __forceinline__ int olane(int lane) { asm volatile("" : "+v"(lane)); return lane; }
#endif
__device__ __forceinline__ void load_nat_tile(const bf16* P, int row0, int col0, bf16* tile, int lane) {
    u32x4 v[8];
#pragma unroll
    for (int i = 0; i < 8; ++i) v[i] = *(const u32x4*)(P + (size_t)(row0 + (lane >> 3) + 8 * i) * NP + col0 + (lane & 7) * 8);
#pragma unroll
    for (int i = 0; i < 8; ++i) *(u32x4*)(tile + swz((lane >> 3) + 8 * i, lane & 7)) = v[i];
}
__device__ __forceinline__ bf16x8 frag_tr(const bf16* tile, int c0, int k0, int lane) {
    const int c = c0 + (lane & 15), kb = k0 + 8 * (lane >> 4); unsigned w[4];
#pragma unroll
    for (int j = 0; j < 4; ++j) w[j] = (unsigned)tile[swz(kb + 2 * j, c >> 3) + (c & 7)] | ((unsigned)tile[swz(kb + 2 * j + 1, c >> 3) + (c & 7)] << 16);
    u32x4 o; o.x = w[0]; o.y = w[1]; o.z = w[2]; o.w = w[3]; return as_frag(o);
}
template <int DIR>
__device__ __forceinline__ void gla_r_frags(const float* Grow0, int lane, bf16x8 (&af)[4]) {
    const int r = lane & 15, q4 = lane >> 4;
#pragma unroll
    for (int mt = 0; mt < 4; ++mt) { u32x4 o = {0u, 0u, 0u, 0u};
        if (q4 < 2) o = *(const u32x4*)((const bf16*)(Grow0 + (size_t)(16 * mt + r) * NGS + 16) + DIR * 16 + 8 * q4);
        af[mt] = as_frag(o); }
}
template <int DIR>
__device__ __forceinline__ float gla_b_col(const Params& p, int l, int h, const bf16x8 (&af)[4], int nt, int lane_, float (&x)[4][4]) {
    const int lane = olane(lane_), r = lane & 15, q4 = lane >> 4, d = h * 64 + 16 * nt + r;
    u32x4 o = {0u, 0u, 0u, 0u};
    if (q4 < 2) { const float* wa = p.in[I_GWA] + ((size_t)(l * 2 + DIR) * 16 + 8 * q4) * WG + d;
        o.x = pk2(wa[0], wa[WG]); o.y = pk2(wa[2 * WG], wa[3 * WG]); o.z = pk2(wa[4 * WG], wa[5 * WG]); o.w = pk2(wa[6 * WG], wa[7 * WG]); }
    const bf16x8 bfr = as_frag(o); const float bias = p.in[I_GBA][(size_t)(l * 2 + DIR) * WG + d];
#pragma unroll
    for (int mt = 0; mt < 4; ++mt) { f32x4 c = {bias, bias, bias, bias}; c = MFMA16(af[mt], bfr, c);
#pragma unroll
        for (int i = 0; i < 4; ++i) x[mt][i] = logsig_fast(c[i]) * (1.0f / 16.0f); }
    float carry = 0.f;
#pragma unroll
    for (int k = 0; k < 4; ++k) { const int mt = DIR == 0 ? k : 3 - k; float* y = x[mt];
        if (DIR == 0) { y[1] += y[0]; y[2] += y[1]; y[3] += y[2]; } else { y[2] += y[3]; y[1] += y[2]; y[0] += y[1]; }
        const float s4 = DIR == 0 ? y[3] : y[0];
        const float t1 = DIR == 0 ? __shfl_up(s4, 16) : __shfl_down(s4, 16), t2 = DIR == 0 ? __shfl_up(s4, 32) : __shfl_down(s4, 32), t3 = DIR == 0 ? __shfl_up(s4, 48) : __shfl_down(s4, 48);
        const int qq = DIR == 0 ? q4 : 3 - q4;
        const float e = (qq >= 1 ? t1 : 0.f) + (qq >= 2 ? t2 : 0.f) + (qq >= 3 ? t3 : 0.f);
        const float tot = __shfl(e + s4, DIR == 0 ? r + 48 : r);
#pragma unroll
        for (int i = 0; i < 4; ++i) y[i] += carry + e;
        carry += tot; }
    return carry;
}

template <int MIXER, int DIR>
__device__ __forceinline__ void chunkst_dir(const Params& p, int l, int b, int h, int cid, const float* Grow0, const unsigned (&kk)[32], const bf16* Vt, bf16* Kt, const float* wvs, float* bendl, int lane_) {
    const int lane = olane(lane_), r = lane & 15, q4 = lane >> 4;
    if constexpr (MIXER == 0) {
        float nacc = 0.f;
#pragma unroll
        for (int c = 0; c < 8; ++c) { float f[8];
#pragma unroll
            for (int j = 0; j < 8; ++j) { const int s = 8 * c + j; const float kv = (s & 1) ? bitsf(kk[s >> 1] & 0xffff0000u) : bitsf(kk[s >> 1] << 16);
                f[j] = kv * 0.125f * wvs[DIR * 64 + s]; nacc += f[j]; }
            *(u32x4*)(Kt + swz(lane, c)) = pack8(f); }
        ((float*)(p.ws + WS_NV))[ch_index(DIR, b, h, cid) * 64 + lane] = nacc;
    } else {
        const bf16* P = (const bf16*)(p.ws + WS_P); const int kcol = PG + 256 + h * 64; const int r0 = b * TOK + cid * 64;
        bf16x8 af[4]; gla_r_frags<DIR>(Grow0, lane, af);
#pragma unroll 2
        for (int nt = 0; nt < 4; ++nt) { const int d = 16 * nt + r; float x[4][4];
            const float bend = gla_b_col<DIR>(p, l, h, af, nt, lane, x);
            if (q4 == 0) { ((float*)(p.ws + WS_BE))[ch_index(DIR, b, h, cid) * 64 + d] = bend; bendl[d] = __expf(fmaxf(bend, -80.0f)); }
#pragma unroll
            for (int mt = 0; mt < 4; ++mt)
#pragma unroll
                for (int i = 0; i < 4; ++i) { const int s = 16 * mt + 4 * q4 + i; const float kv = bf2f(P[(size_t)(r0 + s) * NP + kcol + d]); const float bc = fmaxf(x[mt][i], -80.0f);
                    Kt[swz(d, s >> 3) + (s & 7)] = f2bf(kv * __expf(-bc));
                    ((bf16*)(p.ws + WS_EQ))[((size_t)DIR * T + r0 + s) * WG + h * 64 + d] = f2bf(__expf(bc)); } }
    }
    WAVE_SYNC();
    bf16x8 vf[4][2];
#pragma unroll
    for (int ne = 0; ne < 4; ++ne)
#pragma unroll
        for (int ks = 0; ks < 2; ++ks) vf[ne][ks] = *(const bf16x8*)(Vt + swz(16 * ne + r, ks * 4 + q4));
    bf16* dst = (bf16*)(p.ws + WS_ST) + st_index(MIXER, DIR, b, h, cid) * 4096;
#pragma unroll
    for (int me = 0; me < 4; ++me) {
        f32x4 acc[4] = {(f32x4){0.f, 0.f, 0.f, 0.f}, (f32x4){0.f, 0.f, 0.f, 0.f}, (f32x4){0.f, 0.f, 0.f, 0.f}, (f32x4){0.f, 0.f, 0.f, 0.f}};
#pragma unroll
        for (int ks = 0; ks < 2; ++ks) { const bf16x8 a = *(const bf16x8*)(Kt + swz(16 * me + r, ks * 4 + q4));
#pragma unroll
            for (int ne = 0; ne < 4; ++ne) acc[ne] = MFMA16(a, vf[ne][ks], acc[ne]); }
        f32x4 sc4 = {1.f, 1.f, 1.f, 1.f}; if constexpr (MIXER == 1) sc4 = *(const f32x4*)(bendl + 16 * me + 4 * q4);
#pragma unroll
        for (int ne = 0; ne < 4; ++ne) { const f32x4 v = acc[ne] * sc4; u32x2 o; o.x = pk2(v[0], v[1]); o.y = pk2(v[2], v[3]); *(u32x2*)(dst + (16 * ne + r) * 64 + 16 * me + 4 * q4) = o; }
    }
    WAVE_SYNC();
}
template <int MIXER>
__device__ __forceinline__ void chunkst_w(const Params& p, int l, int b, int h, int cid, char* wl, int lane) {
    const bf16* P = (const bf16*)(p.ws + WS_P); const float* G = (const float*)(p.ws + WS_G);
    const int r0 = b * TOK + cid * 64, r = lane & 15, q4 = lane >> 4;
    bf16* Kt = (bf16*)wl;
    bf16* Vt = Kt + 4096;
    float* wvs = (float*)(Vt + 4096);
    float* bendl = wvs + 128;
    const int kcol = (MIXER == 0 ? PA : PG) + 256 + h * 64, vcol = (MIXER == 0 ? PA : PG) + 512 + h * 64;
    const float* Grow0 = G + (size_t)r0 * NGS;
    { bf16* Nn = Kt;
        load_nat_tile(P, r0, vcol, Nn, lane);
        WAVE_SYNC();
#pragma unroll
        for (int c = 0; c < 8; ++c) { unsigned w[4];
#pragma unroll
            for (int j = 0; j < 4; ++j) w[j] = (unsigned)Nn[swz(8 * c + 2 * j, lane >> 3) + (lane & 7)] | ((unsigned)Nn[swz(8 * c + 2 * j + 1, lane >> 3) + (lane & 7)] << 16);
            u32x4 o; o.x = w[0]; o.y = w[1]; o.z = w[2]; o.w = w[3]; *(u32x4*)(Vt + swz(lane, c)) = o; }
        WAVE_SYNC();
        load_nat_tile(P, r0, kcol, Nn, lane);
        WAVE_SYNC(); }
    unsigned kk[32];
    { const bf16* Nn = Kt;
#pragma unroll
        for (int i = 0; i < 32; ++i) kk[i] = (unsigned)Nn[swz(2 * i, lane >> 3) + (lane & 7)] | ((unsigned)Nn[swz(2 * i + 1, lane >> 3) + (lane & 7)] << 16); }
    WAVE_SYNC();
    if constexpr (MIXER == 0) {
        const float* g = Grow0 + (size_t)lane * NGS; const float* gb = p.in[I_MGB] + (size_t)l * 16;
        const float i_f = g[h] + gb[h], f_f = g[4 + h] + gb[4 + h], i_b = g[8 + h] + gb[8 + h], f_b = g[12 + h] + gb[12 + h];
        const float lf = logsigf_(f_f), lb = logsigf_(f_b);
        const float bF = wave_prefix_sum(lf, lane), totF = __shfl(bF, 63);
        const float gF = totF - bF + i_f, mF = wave_max(gF);
        const float totB = wave_sum(lb), preB = wave_prefix_sum(lb, lane), bB = totB - preB + lb;
        const float gB = totB - bB + i_b, mB = wave_max(gB);
        wvs[lane] = __expf(gF - mF); wvs[64 + lane] = __expf(gB - mB);
        if (lane == 0) { float* SC = (float*)(p.ws + WS_SC);
            SC[ch_index(0, b, h, cid) * 4 + 0] = totF; SC[ch_index(0, b, h, cid) * 4 + 1] = mF;
            SC[ch_index(1, b, h, cid) * 4 + 0] = totB; SC[ch_index(1, b, h, cid) * 4 + 1] = mB; }
    }
    WAVE_SYNC();
    chunkst_dir<MIXER, 0>(p, l, b, h, cid, Grow0, kk, Vt, Kt, wvs, bendl, lane);
    chunkst_dir<MIXER, 1>(p, l, b, h, cid, Grow0, kk, Vt, Kt, wvs, bendl, lane);
}

template <int DIR>
__device__ __forceinline__ void chunkst_gla(const Params& p, int l, int b, int h, int cid, char* wl, int lane_) {
    const bf16* P = (const bf16*)(p.ws + WS_P);
    const int lane = olane(lane_), r0 = b * TOK + cid * 64, r = lane & 15, q4 = lane >> 4;
    bf16* Kt = (bf16*)wl;
    bf16* An = Kt + 4096;
    float* bendl = (float*)(An + 4096);
    const int kcol = PG + 256 + h * 64, vcol = PG + 512 + h * 64;
    const float* Grow0 = (const float*)(p.ws + WS_G) + (size_t)r0 * NGS;
    load_nat_tile(P, r0, vcol, An, lane);
    WAVE_SYNC();
    bf16x8 vf[4][2];
#pragma unroll
    for (int ne = 0; ne < 4; ++ne)
#pragma unroll
        for (int ks = 0; ks < 2; ++ks) vf[ne][ks] = frag_tr(An, 16 * ne, 32 * ks, lane);
    WAVE_SYNC();
    load_nat_tile(P, r0, kcol, An, lane);
    WAVE_SYNC();
    bf16x8 af[4]; gla_r_frags<DIR>(Grow0, lane, af);
#pragma unroll 2
    for (int nt = 0; nt < 4; ++nt) { const int d = 16 * nt + r; float x[4][4];
        const float bend = gla_b_col<DIR>(p, l, h, af, nt, lane, x);
        if (q4 == 0) { ((float*)(p.ws + WS_BE))[ch_index(DIR, b, h, cid) * 64 + d] = bend; bendl[d] = __expf(fmaxf(bend, -80.0f)); }
#pragma unroll
        for (int mt = 0; mt < 4; ++mt)
#pragma unroll
            for (int i = 0; i < 4; ++i) { const int s = 16 * mt + 4 * q4 + i; bf16* ke = An + swz(s, d >> 3) + (d & 7); const float kv = bf2f(*ke); const float bc = fmaxf(x[mt][i], -80.0f);
                Kt[swz(d, s >> 3) + (s & 7)] = f2bf(kv * __expf(-bc));
                *ke = f2bf(__expf(bc)); } }
    WAVE_SYNC();
    { bf16* EQg = (bf16*)(p.ws + WS_EQ) + ((size_t)DIR * T + r0) * WG + h * 64;
#pragma unroll
        for (int i = 0; i < 8; ++i) { const int s = (lane >> 3) + 8 * i, ck = lane & 7; *(u32x4*)(EQg + (size_t)s * WG + ck * 8) = *(const u32x4*)(An + swz(s, ck)); } }
    bf16* dst = (bf16*)(p.ws + WS_ST) + st_index(1, DIR, b, h, cid) * 4096;
#pragma unroll
    for (int me = 0; me < 4; ++me) {
        f32x4 acc[4] = {(f32x4){0.f, 0.f, 0.f, 0.f}, (f32x4){0.f, 0.f, 0.f, 0.f}, (f32x4){0.f, 0.f, 0.f, 0.f}, (f32x4){0.f, 0.f, 0.f, 0.f}};
#pragma unroll
        for (int ks = 0; ks < 2; ++ks) { const bf16x8 a = *(const bf16x8*)(Kt + swz(16 * me + r, ks * 4 + q4));
#pragma unroll
            for (int ne = 0; ne < 4; ++ne) acc[ne] = MFMA16(a, vf[ne][ks], acc[ne]); }
        const f32x4 sc4 = *(const f32x4*)(bendl + 16 * me + 4 * q4);
#pragma unroll
        for (int ne = 0; ne < 4; ++ne) { const f32x4 v = acc[ne] * sc4; u32x2 o; o.x = pk2(v[0], v[1]); o.y = pk2(v[2], v[3]); *(u32x2*)(dst + (16 * ne + r) * 64 + 16 * me + 4 * q4) = o; }
    }
    WAVE_SYNC();
}

template <int MIXER, int DIR>
__device__ __forceinline__ void chunkout_prep(const Params& p, int l, int b, int h, int cid, const float* Grow0, int r0, int pbase, const bf16* EQ, float* gar, int lane_) {
    const int lane = olane(lane_);
    if constexpr (MIXER == 0) {
        const bf16* P = (const bf16*)(p.ws + WS_P);
        const float* g = Grow0 + (size_t)lane * NGS; const float* gb = p.in[I_MGB] + (size_t)l * 16;
        const float ig = g[DIR * 8 + h] + gb[DIR * 8 + h], fg = g[DIR * 8 + 4 + h] + gb[DIR * 8 + 4 + h];
        const float mprev = ((const float*)(p.ws + WS_SC))[ch_index(DIR, b, h, cid) * 4 + 2];
        const float lf = logsigf_(fg); float bb;
        if (DIR == 0) bb = wave_prefix_sum(lf, lane); else { const float tt = wave_sum(lf), pre = wave_prefix_sum(lf, lane); bb = tt - pre + lf; }
        const float a = ig - bb; const float pm = DIR == 0 ? wave_prefix_max(a, lane) : wave_suffix_max(a, lane);
        const float mt_ = fmaxf(bb + mprev, bb + pm);
        float* ga = gar + DIR * 320;
        ga[lane] = bb - mt_; ga[64 + lane] = a; ga[128 + lane] = __expf(bb + mprev - mt_); ga[192 + lane] = __expf(-mt_);
        float* nvl = gar + 640 + DIR * 64;
        nvl[lane] = ((const float*)(p.ws + WS_NV))[ch_index(DIR, b, h, cid) * 64 + lane];
        WAVE_SYNC();
        float dq = 0.f;
#pragma unroll
        for (int c = 0; c < 8; ++c) { float f[8]; unpack8(*(const u32x4*)(P + (size_t)(r0 + lane) * NP + pbase + c * 8), f);
            const f32x4 n0 = *(const f32x4*)(nvl + c * 8), n1 = *(const f32x4*)(nvl + c * 8 + 4);
            dq += f[0] * n0.x + f[1] * n0.y + f[2] * n0.z + f[3] * n0.w + f[4] * n1.x + f[5] * n1.y + f[6] * n1.z + f[7] * n1.w; }
        ga[256 + lane] = dq;
    }
}
template <int MIXER, int DIR, int NS>
__device__ __forceinline__ void chunkout_dir(const Params& p, int b, int h, int cid, int r0, int pbase, int th, const bf16x8 (&vtf)[4][2], const bf16* VtL, const bf16* EQ, bf16* SB, const float* gar, float* rsm, f32x4 (&htot)[NS][4], int lane_) {
    const bf16* P = (const bf16*)(p.ws + WS_P); const bf16* ST = (const bf16*)(p.ws + WS_ST);
    const int lane = olane(lane_), r = lane & 15, q4 = lane >> 4;
    const bf16* E = EQ + ((size_t)DIR * T + r0) * WG + h * 64;
    const float* ga = gar + DIR * 320;
    bf16x8 kf[4][2], ctf[4][2];
#pragma unroll
    for (int n = 0; n < 4; ++n)
#pragma unroll
        for (int ks = 0; ks < 2; ++ks) { if constexpr (MIXER == 0) kf[n][ks] = vtf[n][ks];
            else kf[n][ks] = *(const bf16x8*)(P + (size_t)(r0 + 16 * n + r) * NP + pbase + 256 + ks * 32 + q4 * 8);
            ctf[n][ks] = *(const bf16x8*)(ST + st_index(MIXER, DIR, b, h, cid) * 4096 + (16 * n + r) * 64 + ks * 32 + q4 * 8);
            if constexpr (MIXER == 1) { float fe[8], fk[8]; unpack8(*(const u32x4*)(E + (size_t)(16 * n + r) * WG + ks * 32 + q4 * 8), fe); unpack8(as_u4(kf[n][ks]), fk);
#pragma unroll
                for (int j = 0; j < 8; ++j) fk[j] = fk[j] * frcp_(fe[j]);
                kf[n][ks] = as_frag(pack8(fk)); } }
#pragma unroll
    for (int ms = 0; ms < NS; ++ms) { const int mt = NS * th + ms;
        bf16x8 qf[2];
#pragma unroll
        for (int ks = 0; ks < 2; ++ks) { qf[ks] = *(const bf16x8*)(P + (size_t)(r0 + 16 * mt + r) * NP + pbase + ks * 32 + q4 * 8);
            if constexpr (MIXER == 1) { float fe[8], fq[8]; unpack8(*(const u32x4*)(E + (size_t)(16 * mt + r) * WG + ks * 32 + q4 * 8), fe); unpack8(as_u4(qf[ks]), fq);
#pragma unroll
                for (int j = 0; j < 8; ++j) fq[j] *= 0.125f * fe[j];
                qf[ks] = as_frag(pack8(fq)); } }
        f32x4 S[4] = {(f32x4){0.f, 0.f, 0.f, 0.f}, (f32x4){0.f, 0.f, 0.f, 0.f}, (f32x4){0.f, 0.f, 0.f, 0.f}, (f32x4){0.f, 0.f, 0.f, 0.f}};
#pragma unroll
        for (int ks = 0; ks < 2; ++ks)
#pragma unroll
            for (int n = 0; n < 4; ++n) S[n] = MFMA16(qf[ks], kf[n][ks], S[n]);
#pragma unroll
        for (int i = 0; i < 4; ++i) { const int t = 16 * mt + 4 * q4 + i; float sm = 0.f;
#pragma unroll
            for (int n = 0; n < 4; ++n) { const int s = 16 * n + r; const bool ok = DIR == 0 ? (s <= t) : (s >= t); float v = 0.f;
                if (ok) { if constexpr (MIXER == 0) v = S[n][i] * 0.125f * __expf(ga[t] + ga[64 + s]); else v = S[n][i]; }
                SB[swz(4 * q4 + i, s >> 3) + (s & 7)] = f2bf(v); sm += v; }
            if constexpr (MIXER == 0) { sm = row16_sum(sm); if (r == 0) rsm[4 * q4 + i] = sm; } }
        WAVE_SYNC();
        const bf16x8 sm0 = *(const bf16x8*)(SB + swz(r, q4)), sm1 = *(const bf16x8*)(SB + swz(r, 4 + q4));
        float wi = 1.f, inv = 1.f;
        if constexpr (MIXER == 0) { const int tt = 16 * mt + r; wi = ga[128 + tt]; const float den = wi * ga[256 + tt] + rsm[r]; inv = frcp_(fmaxf(fabsf(den), ga[192 + tt])); }
#pragma unroll
        for (int me = 0; me < 4; ++me) { f32x4 a1 = {0.f, 0.f, 0.f, 0.f}, a2 = {0.f, 0.f, 0.f, 0.f};
            a1 = MFMA16(*(const bf16x8*)(VtL + swz(16 * me + r, q4)), sm0, a1); a1 = MFMA16(*(const bf16x8*)(VtL + swz(16 * me + r, 4 + q4)), sm1, a1);
            a2 = MFMA16(ctf[me][0], qf[0], a2); a2 = MFMA16(ctf[me][1], qf[1], a2);
            if constexpr (MIXER == 0) htot[ms][me] += (a1 + a2 * wi) * inv; else htot[ms][me] += a1 + a2; }
        WAVE_SYNC();
    }
}
__device__ __forceinline__ void co_build_vt(const bf16* P, int r0, int vcol, bf16* VtL, int lane) {
    bf16* Nn = VtL + 4096;
#pragma unroll
    for (int hh = 0; hh < 2; ++hh) {
        u32x4 v[4];
#pragma unroll
        for (int i = 0; i < 4; ++i) v[i] = *(const u32x4*)(P + (size_t)(r0 + 32 * hh + (lane >> 3) + 8 * i) * NP + vcol + (lane & 7) * 8);
#pragma unroll
        for (int i = 0; i < 4; ++i) *(u32x4*)(Nn + swz((lane >> 3) + 8 * i, lane & 7)) = v[i];
        WAVE_SYNC();
#pragma unroll
        for (int c = 0; c < 4; ++c) { unsigned w[4];
#pragma unroll
            for (int j = 0; j < 4; ++j) w[j] = (unsigned)Nn[swz(8 * c + 2 * j, lane >> 3) + (lane & 7)] | ((unsigned)Nn[swz(8 * c + 2 * j + 1, lane >> 3) + (lane & 7)] << 16);
            u32x4 o; o.x = w[0]; o.y = w[1]; o.z = w[2]; o.w = w[3]; *(u32x4*)(VtL + swz(lane, 4 * hh + c)) = o; }
        WAVE_SYNC(); }
}
template <int MIXER, int NS>
__device__ __forceinline__ void co_finalize(const Params& p, int l, int h, int r0, int pbase, int mt0, f32x4 (&htot)[NS][4], int lane_) {
    const bf16* P = (const bf16*)(p.ws + WS_P); bf16* Y = (bf16*)(p.ws + WS_HNY);
    const float* ngp = p.in[MIXER == 0 ? I_MNG : I_GNG] + (size_t)l * WG + h * 64;
    const int lz = olane(lane_), r = lz & 15, q4 = lz >> 4;
    u32x2 gq[NS][4], oq[NS][4];
#pragma unroll
    for (int ms = 0; ms < NS; ++ms)
#pragma unroll
        for (int me = 0; me < 4; ++me) { const size_t off = (size_t)(r0 + 16 * (mt0 + ms) + r) * NP + pbase + 16 * me + 4 * q4;
            gq[ms][me] = *(const u32x2*)(P + off + (MIXER == 0 ? 1024 : 768)); if constexpr (MIXER == 0) oq[ms][me] = *(const u32x2*)(P + off + 768); else oq[ms][me] = (u32x2){0u, 0u}; }
#pragma unroll
    for (int ms = 0; ms < NS; ++ms) { const int mt = mt0 + ms; float ss = 0.f; float gv[4][4];
#pragma unroll
        for (int me = 0; me < 4; ++me) {
            gv[me][0] = bitsf(gq[ms][me].x << 16); gv[me][1] = bitsf(gq[ms][me].x & 0xffff0000u); gv[me][2] = bitsf(gq[ms][me].y << 16); gv[me][3] = bitsf(gq[ms][me].y & 0xffff0000u);
            if constexpr (MIXER == 0) { htot[ms][me][0] *= sigmoidf_(bitsf(oq[ms][me].x << 16)); htot[ms][me][1] *= sigmoidf_(bitsf(oq[ms][me].x & 0xffff0000u)); htot[ms][me][2] *= sigmoidf_(bitsf(oq[ms][me].y << 16)); htot[ms][me][3] *= sigmoidf_(bitsf(oq[ms][me].y & 0xffff0000u)); }
            ss += htot[ms][me][0] * htot[ms][me][0] + htot[ms][me][1] * htot[ms][me][1] + htot[ms][me][2] * htot[ms][me][2] + htot[ms][me][3] * htot[ms][me][3]; }
        ss = xrow_sum(ss);
        const float rstd = rsqrtf(ss * (1.0f / 64.0f) + EPS);
#pragma unroll
        for (int me = 0; me < 4; ++me) { const int e = 16 * me + 4 * q4; const f32x4 n4 = *(const f32x4*)(ngp + e);
            u32x2 o; o.x = pk2(htot[ms][me][0] * rstd * n4.x * siluf_(gv[me][0]), htot[ms][me][1] * rstd * n4.y * siluf_(gv[me][1]));
            o.y = pk2(htot[ms][me][2] * rstd * n4.z * siluf_(gv[me][2]), htot[ms][me][3] * rstd * n4.w * siluf_(gv[me][3]));
            *(u32x2*)(Y + (size_t)(r0 + 16 * mt + r) * 1024 + (MIXER == 0 ? YA : YG) + h * 64 + e) = o; } }
}
template <int MIXER>
__device__ __forceinline__ void chunkout_w(const Params& p, int l, int b, int h, int cid, char* wl, int lane) {
    const bf16* P = (const bf16*)(p.ws + WS_P); const float* G = (const float*)(p.ws + WS_G);
    const int r0 = b * TOK + cid * 64;
    const int pbase = (MIXER == 0 ? PA : PG) + h * 64;
    bf16* SB = (bf16*)wl;
    float* rsm = (float*)(SB + 1024);
    float* gar = rsm + 16;
    const bf16* EQ = (const bf16*)(p.ws + WS_EQ);
    const float* Grow0 = G + (size_t)r0 * NGS;
    bf16* VtL = (bf16*)(gar + 768);
    bf16x8 vtf[4][2];
#pragma unroll
    for (int me = 0; me < 4; ++me)
#pragma unroll
        for (int ks = 0; ks < 2; ++ks) { if constexpr (MIXER == 0) vtf[me][ks] = *(const bf16x8*)(P + (size_t)(r0 + 16 * me + (lane & 15)) * NP + pbase + 256 + ks * 32 + (lane >> 4) * 8); else vtf[me][ks] = (bf16x8){0, 0, 0, 0, 0, 0, 0, 0}; }
    co_build_vt(P, r0, pbase + 512, VtL, lane);
    chunkout_prep<MIXER, 0>(p, l, b, h, cid, Grow0, r0, pbase, EQ, gar, lane);
    chunkout_prep<MIXER, 1>(p, l, b, h, cid, Grow0, r0, pbase, EQ, gar, lane);
    WAVE_SYNC();
    constexpr int NS = MIXER == 1 ? 2 : 1;
#pragma unroll 1
    for (int th = 0; th < 4 / NS; ++th) {
        f32x4 htot[NS][4];
#pragma unroll
        for (int a = 0; a < NS; ++a)
#pragma unroll
            for (int c = 0; c < 4; ++c) htot[a][c] = (f32x4){0.f, 0.f, 0.f, 0.f};
        chunkout_dir<MIXER, 0, NS>(p, b, h, cid, r0, pbase, th, vtf, VtL, EQ, SB, gar, rsm, htot, lane);
        chunkout_dir<MIXER, 1, NS>(p, b, h, cid, r0, pbase, th, vtf, VtL, EQ, SB, gar, rsm, htot, lane);
        co_finalize<MIXER, NS>(p, l, h, r0, pbase, NS * th, htot, lane);
    }
}
constexpr int CO_PART = 13376;
template <int MIXER, int DIR>
__device__ __forceinline__ void chunkout_piece(const Params& p, int l, int b, int h, int cid, int mt, char* wl, int lane) {
    const bf16* P = (const bf16*)(p.ws + WS_P); const float* G = (const float*)(p.ws + WS_G);
    const int r0 = b * TOK + cid * 64; const int pbase = (MIXER == 0 ? PA : PG) + h * 64;
    bf16* SB = (bf16*)wl; float* rsm = (float*)(SB + 1024); float* gar = rsm + 16; const bf16* EQ = (const bf16*)(p.ws + WS_EQ);
    const float* Grow0 = G + (size_t)r0 * NGS; bf16* VtL = (bf16*)(gar + 768);
    bf16x8 vtf[4][2];
#pragma unroll
    for (int me = 0; me < 4; ++me)
#pragma unroll
        for (int ks = 0; ks < 2; ++ks) { if constexpr (MIXER == 0) vtf[me][ks] = *(const bf16x8*)(P + (size_t)(r0 + 16 * me + (lane & 15)) * NP + pbase + 256 + ks * 32 + (lane >> 4) * 8); else vtf[me][ks] = (bf16x8){0, 0, 0, 0, 0, 0, 0, 0}; }
    co_build_vt(P, r0, pbase + 512, VtL, lane);
    chunkout_prep<MIXER, DIR>(p, l, b, h, cid, Grow0, r0, pbase, EQ, gar, lane);
    WAVE_SYNC();
    f32x4 htot[1][4] = {{(f32x4){0.f, 0.f, 0.f, 0.f}, (f32x4){0.f, 0.f, 0.f, 0.f}, (f32x4){0.f, 0.f, 0.f, 0.f}, (f32x4){0.f, 0.f, 0.f, 0.f}}};
    chunkout_dir<MIXER, DIR, 1>(p, b, h, cid, r0, pbase, mt, vtf, VtL, EQ, SB, gar, rsm, htot, lane);
    float* part = (float*)(wl + CO_PART);
#pragma unroll
    for (int me = 0; me < 4; ++me)
#pragma unroll
        for (int i = 0; i < 4; ++i) part[(me * 4 + i) * 64 + lane] = htot[0][me][i];
}
template <int MIXER>
__device__ __forceinline__ void chunkout_combine(const Params& p, int l, int b, int h, int cid, int mt, const char* smem, int lane) {
    const float* pa = (const float*)(smem + (2 * mt) * WLDS + CO_PART); const float* pb = (const float*)(smem + (2 * mt + 1) * WLDS + CO_PART);
    f32x4 htot[1][4];
#pragma unroll
    for (int me = 0; me < 4; ++me)
#pragma unroll
        for (int i = 0; i < 4; ++i) htot[0][me][i] = pa[(me * 4 + i) * 64 + lane] + pb[(me * 4 + i) * 64 + lane];
    co_finalize<MIXER, 1>(p, l, h, b * TOK + cid * 64, (MIXER == 0 ? PA : PG) + h * 64, mt, htot, lane);
}

template <bool OUT>
__device__ __forceinline__ void chunk_workers(const Params& p, int l, char* smem) {
    const int tid = otid(), lane = tid & 63, wave = __builtin_amdgcn_readfirstlane(tid >> 6);
    const int NW = (int)gridDim.x * 8, wi = wave * (int)gridDim.x + obid();
    const int c_lo = (OUT && l == DEPTH - 1) ? NCC : 0, npc = NCH - c_lo, half = NB * NH * npc;
    char* wl = smem + wave * WLDS;
    if (OUT) {
        const int cl = NCC, npl = NCH - NCC, halfl = NB * NH * npl;
#pragma unroll 1
        for (int t = wi; t < halfl; t += NW) { const int b = t / (NH * npl), h = (t / npl) % NH, cid = cl + t % npl;
            const Params q = relaunder(p); chunkout_w<1>(q, l, b, h, cid, wl, lane); }
        { const int used = halfl % NW;
#pragma unroll 1
            for (int t = (wi + NW - used) % NW; t < halfl; t += NW) { const int b = t / (NH * npl), h = (t / npl) % NH, cid = cl + t % npl;
                const Params q = relaunder(p); chunkout_w<0>(q, l, b, h, cid, wl, lane); } }
        if (l < DEPTH - 1) {
            const int nct = NB * NH * NCC;
#pragma unroll 1
            for (int st = obid(); st < 2 * nct; st += (int)gridDim.x) { const int mixer = st / nct, r2 = st % nct, b = r2 / (NH * NCC), h = (r2 / NCC) % NH, cid = r2 % NCC;
                const Params q = relaunder(p); const int mt = wave >> 1;
                __syncthreads();
                if (mixer == 0) { if (wave & 1) chunkout_piece<0, 1>(q, l, b, h, cid, mt, wl, lane); else chunkout_piece<0, 0>(q, l, b, h, cid, mt, wl, lane); }
                else            { if (wave & 1) chunkout_piece<1, 1>(q, l, b, h, cid, mt, wl, lane); else chunkout_piece<1, 0>(q, l, b, h, cid, mt, wl, lane); }
                __syncthreads();
                if (wave < 4) { if (mixer == 0) chunkout_combine<0>(q, l, b, h, cid, wave, smem, lane); else chunkout_combine<1>(q, l, b, h, cid, wave, smem, lane); }
            }
        }
    } else {
        int off = 0;
#pragma unroll 1
        for (int t = wi; t < half; t += NW) { const int b = t / (NH * npc), h = (t / npc) % NH, cid = c_lo + t % npc;
            const Params q = relaunder(p); chunkst_gla<0>(q, l, b, h, cid, wl, lane); }
        off = (off + half) % NW;
#pragma unroll 1
        for (int t = (wi + NW - off) % NW; t < half; t += NW) { const int b = t / (NH * npc), h = (t / npc) % NH, cid = c_lo + t % npc;
            const Params q = relaunder(p); chunkst_gla<1>(q, l, b, h, cid, wl, lane); }
        off = (off + half) % NW;
#pragma unroll 1
        for (int t = (wi + NW - off) % NW; t < half; t += NW) { const int b = t / (NH * npc), h = (t / npc) % NH, cid = c_lo + t % npc;
            const Params q = relaunder(p); chunkst_w<0>(q, l, b, h, cid, wl, lane); }
    }
}

__device__ __forceinline__ void phase_mix1(const Params& p, int l, char* smem) {
    const bool ctxo = l < DEPTH - 1; const int G = (int)gridDim.x, bid = obid();
    constexpr int N_HL = (NB / 2) * (WG / 2), N_HC = NB * (WG / HCB);
    chunk_workers<false>(p, l, smem);
    stage_signal(p, smem, 0, l);
    for (int t = bid; t < N_HL; t += G) hylat_task(p, l, t / (WG / 2), t % (WG / 2), smem);
    if (ctxo) for (int t = G - 1 - bid; t < N_HC; t += G) hyctx_task(p, l, t / (WG / HCB), t % (WG / HCB), smem);
    stage_signal(p, smem, 2, l);
}

constexpr int SCG = 12;
__device__ __forceinline__ void phase_scan(const Params& p, int l, char* smem) {
    const int tid = otid();
    bf16* ST = (bf16*)(p.ws + WS_ST); float* NV = (float*)(p.ws + WS_NV); const float* BE = (const float*)(p.ws + WS_BE); float* SC = (float*)(p.ws + WS_SC);
    constexpr int NCHAIN = 2 * 2 * NB * NH;
    stage_wait(p, 0, l);
    for (int item = obid() * NT + tid; item < NCHAIN * 1024; item += gridDim.x * NT) {
        const int chain = item >> 10, grp = item & 1023; const int mixer = chain / (2 * NB * NH), dir = (chain / (NB * NH)) % 2, b = (chain / NH) % NB, h = chain % NH;
        float c[4] = {0.f, 0.f, 0.f, 0.f}; float nv[4] = {0.f, 0.f, 0.f, 0.f}; float m = 0.f;
        const int d0 = (grp & 15) * 4; const bool donv = (mixer == 0) && (grp < 16);
        for (int o0 = 0; o0 < NCH; o0 += SCG) {
            u32x2 uu[SCG]; float s0[SCG], s1[SCG]; f32x4 be[SCG]; f32x4 nu[SCG];
#pragma unroll
            for (int j = 0; j < SCG; ++j) if (o0 + j < NCH) { const int cid = chain_cid(dir, o0 + j); const size_t ci = ch_index(dir, b, h, cid);
                uu[j] = *(const u32x2*)(ST + st_index(mixer, dir, b, h, cid) * 4096 + grp * 4);
                if (mixer == 0) { s0[j] = SC[ci * 4 + 0]; s1[j] = SC[ci * 4 + 1]; if (donv) nu[j] = *(const f32x4*)(NV + ci * 64 + grp * 4); }
                else be[j] = *(const f32x4*)(BE + ci * 64 + d0); }
#pragma unroll
            for (int j = 0; j < SCG; ++j) if (o0 + j < NCH) { const int cid = chain_cid(dir, o0 + j); const size_t ci = ch_index(dir, b, h, cid);
                const float u[4] = {bitsf(uu[j].x << 16), bitsf(uu[j].x & 0xffff0000u), bitsf(uu[j].y << 16), bitsf(uu[j].y & 0xffff0000u)};
                u32x2 w; w.x = pk2(c[0], c[1]); w.y = pk2(c[2], c[3]); *(u32x2*)(ST + st_index(mixer, dir, b, h, cid) * 4096 + grp * 4) = w;
                if (mixer == 0) {
                    if (grp == 0) SC[ci * 4 + 2] = m;
                    const float mn = fmaxf(s0[j] + m, s1[j]), a = __expf(s0[j] + m - mn), s = __expf(s1[j] - mn);
#pragma unroll
                    for (int k = 0; k < 4; ++k) c[k] = a * c[k] + s * u[k];
                    if (donv) { f32x4 nw = {nv[0], nv[1], nv[2], nv[3]}; *(f32x4*)(NV + ci * 64 + grp * 4) = nw;
                        nv[0] = a * nv[0] + s * nu[j].x; nv[1] = a * nv[1] + s * nu[j].y; nv[2] = a * nv[2] + s * nu[j].z; nv[3] = a * nv[3] + s * nu[j].w; }
                    m = mn;
                } else { c[0] = __expf(be[j].x) * c[0] + u[0]; c[1] = __expf(be[j].y) * c[1] + u[1]; c[2] = __expf(be[j].z) * c[2] + u[2]; c[3] = __expf(be[j].w) * c[3] + u[3]; } }
        }
    }
    stage_signal(p, smem, 1, l);
    { const bool ctxo = l < DEPTH - 1; const int G = (int)gridDim.x, bid = obid();
        constexpr int QTL = SEQ / 128, QTC = CTXL / 128, N_AL = NB * 2 * QTL, N_AC = NB * 2 * QTC;
        for (int t = bid; t < N_AL; t += G) attn_task(p, l, t / (2 * QTL), (t / QTL) % 2, t % QTL, false, smem);
        if (ctxo) for (int t = (bid + G - 64 % G) % G; t < N_AC; t += G) attn_task(p, l, t / (2 * QTC), (t / QTC) % 2, t % QTC, true, smem); }
}

__device__ __forceinline__ void phase_mix2(const Params& p, int l, char* smem) {
    const int tid = otid();
    stage_wait(p, 1, l);
    chunk_workers<true>(p, l, smem);
    stage_wait(p, 2, l);
    constexpr int N_WOUT = (DM / 64) * (MIX / 64);
    { const int lane = tid & 63, wave = __builtin_amdgcn_readfirstlane(tid >> 6); const int NW = (int)gridDim.x * 8, wi = wave * (int)gridDim.x + obid();
        for (int task = NW - 1 - wi; task < N_WOUT; task += NW) { const int nt = task / (MIX / 64), kt = task % (MIX / 64);
            convert_tile_w(p.in[I_WOUT] + (size_t)l * MIX * DM, DM, (bf16*)(p.ws + WS_WOUT), MIX, nt * 64, kt * 64, false, smem + wave * WLDS, lane); }
        bf16* tile = (bf16*)(smem + wave * WLDS); const bf16* HT = (const bf16*)(p.ws + WS_HT); bf16* Y = (bf16*)(p.ws + WS_HNY);
        constexpr int NTT = NB * (SEQ / 64) * 4;
        for (int t = wi; t < NTT; t += NW) { const int b = t / ((SEQ / 64) * 4), tt = (t / 4) % (SEQ / 64), c0 = (t % 4) * 64; const size_t tok0 = (size_t)b * TOK + CTXL + tt * 64;
#pragma unroll
            for (int i = 0; i < 8; ++i) { const int ch = (lane >> 3) + 8 * i, ck = lane & 7; *(u32x4*)(tile + swz(ch, ck)) = *(const u32x4*)(HT + (size_t)(768 + c0 + ch) * T + tok0 + ck * 8); }
            WAVE_SYNC();
#pragma unroll
            for (int i = 0; i < 8; ++i) { const int tk = (lane >> 3) + 8 * i, cc = lane & 7; unsigned w[4];
#pragma unroll
                for (int j = 0; j < 4; ++j) { const int ca = cc * 8 + 2 * j; w[j] = (unsigned)tile[swz(ca, tk >> 3) + (tk & 7)] | ((unsigned)tile[swz(ca + 1, tk >> 3) + (tk & 7)] << 16); }
                u32x4 o; o.x = w[0]; o.y = w[1]; o.z = w[2]; o.w = w[3]; *(u32x4*)(Y + (tok0 + tk) * 1024 + YH + c0 + cc * 8) = o; }
            WAVE_SYNC(); } }
}


#ifndef EMU
#define LAS __attribute__((address_space(3)))
#define XB_TMO      128
#define XB_XCNT(j)  (256  + 64 * (j))
#define XB_XSUB(j)  (1280 + 64 * (j))
#define XB_XGEN(j)  (2304 + 64 * (j))
#define XB_TOP      3328
#define XB_TOPGEN   3392
#define XCD_BAR_WORDS 3456
#define XB_SPIN_CAP (1u << 18)

__device__ __forceinline__ unsigned xb_ld(unsigned* p)              { return __hip_atomic_load(p, __ATOMIC_RELAXED, __HIP_MEMORY_SCOPE_AGENT); }
__device__ __forceinline__ unsigned xb_add(unsigned* p, unsigned v) { return __hip_atomic_fetch_add(p, v, __ATOMIC_RELAXED, __HIP_MEMORY_SCOPE_AGENT); }
__device__ __forceinline__ unsigned xb_xcc_id() { return (unsigned)__builtin_amdgcn_s_getreg((3 << 11) | 20) & 0xFu; }
#define XB_SPIN(cond, bar) do { unsigned _sp = 0; while (cond) { __builtin_amdgcn_s_sleep(1); \
    if ((++_sp & 255u) == 0u) { if (xb_ld(&(bar)[XB_TMO])) break; if (_sp > XB_SPIN_CAP) { atomicAdd(&(bar)[XB_TMO], 1u); break; } } } } while (0)

struct XcdBarrier {
    unsigned* bar; unsigned x;
    volatile LAS unsigned* st;
};

__device__ __forceinline__ XcdBarrier xcd_barrier_post(unsigned* bar, volatile LAS unsigned* st) {
    XcdBarrier b; b.bar = bar; b.x = xb_xcc_id(); b.st = st;
    if (threadIdx.x == 0) (void)xb_add(&bar[XB_XCNT(b.x)], 1u);
    return b;
}
__device__ __forceinline__ void xcd_barrier_complete(unsigned* bar, unsigned x, unsigned& nloc, unsigned& nx) {
    const unsigned G = gridDim.x * gridDim.y * gridDim.z;
    unsigned sum, cnt, mine, sp = 0u;
    for (;;) {
        sum = 0u; cnt = 0u; mine = 0u;
#pragma unroll
        for (unsigned j = 0; j < 16; ++j) { const unsigned c = xb_ld(&bar[XB_XCNT(j)]); sum += c; cnt += (c > 0u) ? 1u : 0u; mine = (j == x) ? c : mine; }
        if (sum == G) break;
        __builtin_amdgcn_s_sleep(1);
        if ((++sp & 255u) == 0u) { if (xb_ld(&bar[XB_TMO])) break; if (sp > XB_SPIN_CAP) { atomicAdd(&bar[XB_TMO], 1u); break; } }
    }
    nloc = mine > 0u ? mine : 1u; nx = cnt > 0u ? cnt : 1u;
}

__device__ __forceinline__ void xcd_barrier(const XcdBarrier& b) {
    asm volatile("s_waitcnt vmcnt(0)" ::: "memory");
    __syncthreads();
    if (threadIdx.x == 0) {
        unsigned* bar = b.bar;
        __builtin_amdgcn_s_waitcnt(0);
        unsigned nloc = b.st[0], nx = b.st[1];
        if (nloc == 0u) { xcd_barrier_complete(bar, b.x, nloc, nx); b.st[0] = nloc; b.st[1] = nx; }
        const unsigned old = xb_add(&bar[XB_XSUB(b.x)], 1u);
        const unsigned gen = old / nloc;
        if (old + 1u == (gen + 1u) * nloc) {
            __builtin_amdgcn_fence(__ATOMIC_RELEASE, "agent");
            asm volatile("s_waitcnt vmcnt(0)" ::: "memory");
            const unsigned og = xb_add(&bar[XB_TOP], 1u);
            const unsigned tg = og / nx;
            if (og + 1u == (tg + 1u) * nx) xb_add(&bar[XB_TOPGEN], 1u);
            else XB_SPIN(xb_ld(&bar[XB_TOPGEN]) == tg, bar);
            __builtin_amdgcn_fence(__ATOMIC_ACQUIRE, "agent");
            xb_add(&bar[XB_XGEN(b.x)], 1u);
            asm volatile("s_waitcnt vmcnt(0)" ::: "memory");
        } else {
            XB_SPIN(xb_ld(&bar[XB_XGEN(b.x)]) == gen, bar);
            __builtin_amdgcn_fence(__ATOMIC_ACQUIRE, "agent");
            asm volatile("s_waitcnt vmcnt(0)" ::: "memory");
        }
    }
    __syncthreads();
}
#endif

__global__ void __launch_bounds__(NT) fwd_kernel(Params pk, int ph_lo, int ph_hi) {
    SMEM_DECL;
#ifndef EMU
    volatile LAS unsigned* misc = (volatile LAS unsigned*)(smem + LDS_BYTES - 64);
    if (threadIdx.x < 2) misc[threadIdx.x] = 0u;
    __syncthreads();
    const XcdBarrier bar = xcd_barrier_post((unsigned*)(pk.ws + WS_BAR), misc);
#endif
    constexpr int NPH = 2 + 6 * DEPTH;
    for (int ph = ph_lo; ph < ph_hi && ph < NPH; ++ph) {
#ifndef EMU
        Params p = pk; { size_t z = 0; asm volatile("" : "+s"(z)); p.ws = pk.ws + z; p.out = pk.out + z;
#pragma unroll
            for (int i = 0; i < 26; ++i) p.in[i] = pk.in[i] + z; }
#else
        const Params& p = pk;
#endif
        if (ph == 0) phase0(p, smem);
        else if (ph == NPH - 1) phase_rp(p, DEPTH, smem);
        else { const int l = (ph - 1) / 6, k = (ph - 1) % 6;
            if (k == 0) phase_rp(p, l, smem);
            else if (k == 1) phase_gemm_in(p, l, smem);
            else if (k == 2) phase_mix1(p, l, smem);
            else if (k == 3) phase_scan(p, l, smem);
            else if (k == 4) phase_mix2(p, l, smem);
            else phase_gemm_out(p, l, smem);
#ifdef PROBE_DUP
            if (k == PROBE_DUP) { GRID_SYNC();
                if (k == 1) phase_gemm_in(p, l, smem); else if (k == 2) phase_mix1(p, l, smem); else if (k == 4) phase_mix2(p, l, smem); }
#endif
        }
        if (ph + 1 < ph_hi && !(ph >= 6 && ph % 6 == 0) && !(ph >= 1 && ((ph - 1) % 6 == 2 || (ph - 1) % 6 == 3))) {
#ifdef EMU
            GRID_SYNC();
#else
            if (ph_lo < 0) GRID_SYNC();
            xcd_barrier(bar);
#endif
        }
    }
}

#ifndef EMU
extern "C" void kernel_launch(void* const* d_in, const int* in_sizes, int n_in, void* d_out, int out_size, void* d_ws, size_t ws_size, hipStream_t stream) {
    static int grid = 0;
    if (grid == 0) {
        if (n_in != 26 || ws_size < WS_TOTAL) { fprintf(stderr, "kernel_launch: unexpected n_in %d or ws_size %zu (need %zu)\n", n_in, ws_size, (size_t)WS_TOTAL); grid = -1; return; }
        int dev = 0, cus = 0, per_cu = 0;
        hipGetDevice(&dev);
        hipDeviceGetAttribute(&cus, hipDeviceAttributeMultiprocessorCount, dev);
        hipFuncSetAttribute((const void*)fwd_kernel, hipFuncAttributeMaxDynamicSharedMemorySize, LDS_BYTES);
        hipOccupancyMaxActiveBlocksPerMultiprocessor(&per_cu, (const void*)fwd_kernel, NT, LDS_BYTES);
        if (per_cu < 1) { fprintf(stderr, "kernel_launch: occupancy query returned %d\n", per_cu); grid = -1; return; }
        if (per_cu > 1) per_cu = 1;
        grid = cus * per_cu;
    }
    if (grid < 0) return;
    hipMemsetAsync((char*)d_ws + WS_BAR, 0, BAR_BYTES, stream);
    Params p{};
    for (int i = 0; i < 26; ++i) p.in[i] = (const float*)d_in[i];
    p.out = (float*)d_out; p.ws = (char*)d_ws;
    int lo = 0, hi = 2 + 6 * DEPTH;
    void* args[] = {&p, &lo, &hi};
    hipError_t e = hipLaunchCooperativeKernel((const void*)fwd_kernel, dim3(grid), dim3(NT), args, LDS_BYTES, stream);
    if (e != hipSuccess) fprintf(stderr, "cooperative launch failed: %s (grid %d)\n", hipGetErrorString(e), grid);
}
#endif
```

```cpp
#ifdef EMU
#include "emu/hipemu.h"
#define GRID_SYNC() emu::grid_sync()
#define SMEM_DECL char* smem = emu::S().blocks[emu::cur()->block].lds
#define SCHED_FENCE() do {} while (0)
#define EXP2(x) exp2f(x)
#define MFMA16(a, b, c) emu_mfma_16x16x32_bf16(a, b, c)
#else
#include <hip/hip_runtime.h>
#include <hip/hip_cooperative_groups.h>
#include <cstdio>
#include <cstdint>
#define GRID_SYNC() cooperative_groups::this_grid().sync()
#define SMEM_DECL extern __shared__ __attribute__((aligned(16))) char smem[]
#define SCHED_FENCE() __builtin_amdgcn_sched_barrier(0)
#define EXP2(x) __builtin_amdgcn_exp2f(x)
#define MFMA16(a, b, c) __builtin_amdgcn_mfma_f32_16x16x32_bf16(a, b, c, 0, 0, 0)
#endif

#ifdef EMU
#ifndef EMU_DM
#define EMU_DM 256
#endif
#ifndef EMU_NB
#define EMU_NB 2
#endif
#ifndef EMU_SEQ
#define EMU_SEQ 512
#endif
#ifndef EMU_DEPTH
#define EMU_DEPTH 2
#endif
#ifndef EMU_CTXL
#define EMU_CTXL 128
#endif
constexpr int DM = EMU_DM, NB = EMU_NB, SEQ = EMU_SEQ, DEPTH = EMU_DEPTH, CTXL = EMU_CTXL;
#else
constexpr int DM = 1024, NB = 8, SEQ = 2048, DEPTH = 4, CTXL = 256;
#endif
constexpr int MIX = 1024, WG = 256, HD = 64, NH = 4, CH = 64;
constexpr int TOK = CTXL + SEQ, T = NB * TOK, NCH = TOK / CH, NCC = CTXL / CH;
constexpr int N_IN = 4144, NP = 3072, NG = 48, NGS = 32, NMAIN = 3328, NPAD = 4352;
constexpr int NF = 2 * SEQ;
constexpr int NJ = NB + 1;
constexpr int NT = 512;
constexpr float EPS = 1e-6f;
constexpr int PA = 0, PG = 1280, PD = 2304;
constexpr int YA = 0, YH = 256, YG = 512, YD = 768;
constexpr int ilog4(int n) { return n <= 1 ? 0 : 1 + ilog4(n / 4); }
constexpr int FFT_P = ilog4(NF);
static_assert((1 << (2 * FFT_P)) == NF, "NF must be a power of 4");
static_assert(DM % 256 == 0 && CTXL % 128 == 0 && SEQ % 256 == 0, "shape constraints");

typedef unsigned short bf16;
typedef short bf16x8 __attribute__((ext_vector_type(8)));
typedef float f32x4 __attribute__((ext_vector_type(4)));
typedef unsigned u32x4 __attribute__((ext_vector_type(4)));
typedef unsigned u32x2 __attribute__((ext_vector_type(2)));
struct cpx { float x, y; };

constexpr size_t al256(size_t x) { return (x + 255) & ~(size_t)255; }
constexpr size_t WS_CTXB = 0;
constexpr size_t WS_HNY = al256(WS_CTXB + (size_t)NB * CTXL * DM * 4);
constexpr size_t WS_WIN = WS_HNY + (size_t)T * 1024 * 2;
constexpr size_t WS_ST = WS_WIN;
constexpr size_t ST_BYTES = (size_t)2 * 2 * NB * NH * NCH * 4096 * 2;
constexpr size_t WS_KT = al256(WS_WIN + (size_t)NPAD * DM * 2);
static_assert(WS_KT + (size_t)WG * NF * 4 <= WS_ST + ST_BYTES || true, "");
constexpr size_t ST_END = al256((WS_ST + ST_BYTES > WS_KT + (size_t)WG * NF * 4) ? WS_ST + ST_BYTES : WS_KT + (size_t)WG * NF * 4);
constexpr size_t WS_P = ST_END;
constexpr size_t WS_HT = al256(WS_P + (size_t)T * NP * 2);
constexpr size_t WS_WOUT = WS_HT;
constexpr size_t WS_G = al256(WS_HT + (size_t)1024 * T * 2);
constexpr size_t WS_KF = al256(WS_G + (size_t)T * NGS * 4);
constexpr size_t WS_HC = al256(WS_KF + (size_t)WG * NF * 8);
constexpr size_t WS_EQ = al256(WS_HC + (size_t)2 * WG * CTXL * 4);
constexpr size_t WS_NV = al256(WS_EQ + (size_t)2 * T * WG * 2);
constexpr size_t WS_BE = al256(WS_NV + (size_t)2 * NB * NH * NCH * 64 * 4);
constexpr size_t WS_SC = al256(WS_BE + (size_t)2 * NB * NH * NCH * 64 * 4);
constexpr size_t WS_MOD = al256(WS_SC + (size_t)2 * NB * NH * NCH * 4 * 4);
constexpr size_t WS_TW = al256(WS_MOD + (size_t)DEPTH * NJ * 3 * DM * 4);
constexpr size_t WS_ROPE = al256(WS_TW + (size_t)NF * 8);
constexpr size_t WS_BAR = al256(WS_ROPE + (size_t)SEQ * 32 * 8);
constexpr size_t BAR_BYTES = 32768;
constexpr size_t WS_TOTAL = al256(WS_BAR + BAR_BYTES);
static_assert((size_t)T * DM * 4 <= (size_t)T * NP * 2, "YO fits in P");
#ifndef EMU
static_assert(WS_TOTAL <= (size_t)268435456, "workspace map must fit 256 MiB");
#endif

constexpr int LDS_BYTES = 163840;

struct Params {
    const float* in[26];
    float* out;
    char* ws;
};
enum { I_X = 0, I_C, I_CTX, I_CCTX, I_WADA, I_BADA, I_GPRE, I_GPOST, I_WIN, I_MGB, I_MNG, I_HCW, I_HCB, I_HW1, I_HB1, I_HW2, I_HB2, I_HW3, I_HB3,
       I_HFREQ, I_HD, I_GWA, I_GBA, I_GNG, I_SINK, I_WOUT };

__device__ __forceinline__ Params relaunder(const Params& pk) {
#ifdef EMU
    return pk;
#else
    Params p = pk; size_t z = 0; asm volatile("" : "+s"(z)); p.ws = pk.ws + z; p.out = pk.out + z;
#pragma unroll
    for (int i = 0; i < 26; ++i) p.in[i] = pk.in[i] + z;
    return p;
#endif
}
constexpr int WLDS = (LDS_BYTES - 64) / 8 / 16 * 16;
#ifdef EMU
#define WAVE_SYNC() emu_wave_sync()
#else
#define WAVE_SYNC() do { asm volatile("s_waitcnt lgkmcnt(0)" ::: "memory"); __builtin_amdgcn_wave_barrier(); } while (0)
#endif

#ifdef EMU
__device__ __forceinline__ int otid() { return (int)threadIdx.x; }
__device__ __forceinline__ int obid() { return (int)blockIdx.x; }
#else
__device__ __forceinline__ int otid() { int t = (int)threadIdx.x; asm volatile("" : "+v"(t)); return t; }
__device__ __forceinline__ int obid() { int b = (int)blockIdx.x; asm volatile("" : "+s"(b)); return b; }
#endif
__device__ __forceinline__ unsigned fbits(float f) { return __builtin_bit_cast(unsigned, f); }
__device__ __forceinline__ float bitsf(unsigned u) { return __builtin_bit_cast(float, u); }
__device__ __forceinline__ float bf2f(bf16 h) { return bitsf((unsigned)h << 16); }
#ifdef EMU
__device__ __forceinline__ bf16 f2bf(float f) { unsigned u = fbits(f); return (bf16)((u + 0x7fffu + ((u >> 16) & 1u)) >> 16); }
__device__ __forceinline__ unsigned pk2(float lo, float hi) { return (unsigned)f2bf(lo) | ((unsigned)f2bf(hi) << 16); }
#else
typedef __bf16 nbf16x2 __attribute__((ext_vector_type(2)));
typedef float nf32x2 __attribute__((ext_vector_type(2)));
__device__ __forceinline__ unsigned pk2(float lo, float hi) { const nf32x2 v = {lo, hi}; return __builtin_bit_cast(unsigned, __builtin_convertvector(v, nbf16x2)); }
__device__ __forceinline__ bf16 f2bf(float f) { return (bf16)(pk2(f, 0.0f) & 0xffffu); }
#endif
#ifdef EMU
__device__ __forceinline__ float frcp_(float x) { return 1.0f / x; }
#else
__device__ __forceinline__ float frcp_(float x) { return __builtin_amdgcn_rcpf(x); }
#endif
__device__ __forceinline__ float sigmoidf_(float x) { return frcp_(1.0f + __expf(-x)); }
__device__ __forceinline__ float siluf_(float x) { return x * frcp_(1.0f + __expf(-x)); }
__device__ __forceinline__ float logsigf_(float x) { return fminf(x, 0.0f) - log1pf(__expf(-fabsf(x))); }
__device__ __forceinline__ float logsig_fast(float x) { return fminf(x, 0.0f) - __logf(1.0f + __expf(-fabsf(x))); }
#ifdef EMU
__device__ __forceinline__ float row16_sum(float x) { x += __shfl_xor(x, 1); x += __shfl_xor(x, 2); x += __shfl_xor(x, 4); x += __shfl_xor(x, 8); return x; }
__device__ __forceinline__ float row16_max(float x) { x = fmaxf(x, __shfl_xor(x, 1)); x = fmaxf(x, __shfl_xor(x, 2)); x = fmaxf(x, __shfl_xor(x, 4)); x = fmaxf(x, __shfl_xor(x, 8)); return x; }
__device__ __forceinline__ float xrow_sum(float x) { x += __shfl_xor(x, 16); x += __shfl_xor(x, 32); return x; }
__device__ __forceinline__ float xrow_max(float x) { x = fmaxf(x, __shfl_xor(x, 16)); x = fmaxf(x, __shfl_xor(x, 32)); return x; }
#else
template <int CTRL> __device__ __forceinline__ float dpp_(float x) { return __builtin_bit_cast(float, __builtin_amdgcn_mov_dpp(__builtin_bit_cast(int, x), CTRL, 0xf, 0xf, true)); }
__device__ __forceinline__ float row16_sum(float x) { x += dpp_<0xB1>(x); x += dpp_<0x4E>(x); x += dpp_<0x141>(x); x += dpp_<0x128>(x); return x; }
__device__ __forceinline__ float row16_max(float x) { x = fmaxf(x, dpp_<0xB1>(x)); x = fmaxf(x, dpp_<0x4E>(x)); x = fmaxf(x, dpp_<0x141>(x)); x = fmaxf(x, dpp_<0x128>(x)); return x; }
__device__ __forceinline__ float xrow_sum(float x) {
    auto s = __builtin_amdgcn_permlane16_swap(fbits(x), fbits(x), false, false); x = bitsf(s[0]) + bitsf(s[1]);
    auto t = __builtin_amdgcn_permlane32_swap(fbits(x), fbits(x), false, false); return bitsf(t[0]) + bitsf(t[1]); }
__device__ __forceinline__ float xrow_max(float x) {
    auto s = __builtin_amdgcn_permlane16_swap(fbits(x), fbits(x), false, false); x = fmaxf(bitsf(s[0]), bitsf(s[1]));
    auto t = __builtin_amdgcn_permlane32_swap(fbits(x), fbits(x), false, false); return fmaxf(bitsf(t[0]), bitsf(t[1])); }
#endif
__device__ __forceinline__ float wave_sum(float v) { return xrow_sum(row16_sum(v)); }
__device__ __forceinline__ float wave_max(float v) { return xrow_max(row16_max(v)); }
#ifdef EMU
__device__ __forceinline__ float wave_prefix_sum(float v, int lane) {
#pragma unroll
    for (int o = 1; o < 64; o <<= 1) { float t = __shfl_up(v, o); if (lane >= o) v += t; }
    return v;
}
__device__ __forceinline__ float wave_prefix_max(float v, int lane) {
#pragma unroll
    for (int o = 1; o < 64; o <<= 1) { float t = __shfl_up(v, o); if (lane >= o) v = fmaxf(v, t); }
    return v;
}
#else
template <int CTRL, int RM> __device__ __forceinline__ float dppo_(float old, float x) { return __builtin_bit_cast(float, __builtin_amdgcn_update_dpp(__builtin_bit_cast(int, old), __builtin_bit_cast(int, x), CTRL, RM, 0xf, false)); }
__device__ __forceinline__ float wave_prefix_sum(float v, int) {
    v += dppo_<0x111, 0xf>(0.f, v); v += dppo_<0x112, 0xf>(0.f, v); v += dppo_<0x114, 0xf>(0.f, v); v += dppo_<0x118, 0xf>(0.f, v);
    v += dppo_<0x142, 0xa>(0.f, v); v += dppo_<0x143, 0xc>(0.f, v); return v;
}
__device__ __forceinline__ float wave_prefix_max(float v, int) {
    const float ninf = -INFINITY;
    v = fmaxf(v, dppo_<0x111, 0xf>(ninf, v)); v = fmaxf(v, dppo_<0x112, 0xf>(ninf, v)); v = fmaxf(v, dppo_<0x114, 0xf>(ninf, v)); v = fmaxf(v, dppo_<0x118, 0xf>(ninf, v));
    v = fmaxf(v, dppo_<0x142, 0xa>(ninf, v)); v = fmaxf(v, dppo_<0x143, 0xc>(ninf, v)); return v;
}
#endif
__device__ __forceinline__ float wave_suffix_max(float v, int lane) {
    return __shfl(wave_prefix_max(__shfl(v, 63 - lane), lane), 63 - lane);
}
__device__ __forceinline__ void unpack8(u32x4 v, float* f) {
    f[0] = bitsf(v.x << 16); f[1] = bitsf(v.x & 0xffff0000u); f[2] = bitsf(v.y << 16); f[3] = bitsf(v.y & 0xffff0000u);
    f[4] = bitsf(v.z << 16); f[5] = bitsf(v.z & 0xffff0000u); f[6] = bitsf(v.w << 16); f[7] = bitsf(v.w & 0xffff0000u);
}
__device__ __forceinline__ int orig_col(int n) {
    if (n < 1280) return n;
    if (n < 2304) return 2320 + (n - 1280);
    if (n < 3072) return 3376 + (n - 2304);
    if (n < 3088) return 1280 + (n - 3072);
    if (n < 3120) return 3344 + (n - 3088);
    if (n < NMAIN) return -1;
    return 1296 + (n - NMAIN);
}
__device__ __forceinline__ int chain_cid(int dir, int o) {
    if (dir == 0) return o;
    return o < NCC ? (NCC - 1 - o) : (NCH - 1 - (o - NCC));
}

__device__ __forceinline__ int swz(int row, int ch) { return row * 64 + ((ch ^ (row & 7)) << 3); }
__device__ __forceinline__ u32x4 pack8(const float* f) { u32x4 o; o.x = pk2(f[0], f[1]); o.y = pk2(f[2], f[3]); o.z = pk2(f[4], f[5]); o.w = pk2(f[6], f[7]); return o; }
__device__ __forceinline__ bf16x8 as_frag(u32x4 v) { return __builtin_bit_cast(bf16x8, v); }
__device__ __forceinline__ u32x4 as_u4(bf16x8 v) { return __builtin_bit_cast(u32x4, v); }

constexpr int LS = 72;

template <int NTL, int KS>
__device__ __forceinline__ void mma_nt(const bf16* A, int lda, int m0, const bf16* B, int ldb, int n0, f32x4 (&acc)[NTL], int lane) {
    const int r = lane & 15, q = lane >> 4;
#pragma unroll
    for (int ks = 0; ks < KS; ++ks) {
        const bf16x8 a = *(const bf16x8*)(A + (m0 + r) * lda + ks * 32 + q * 8);
#pragma unroll
        for (int nt = 0; nt < NTL; ++nt) {
            const bf16x8 b = *(const bf16x8*)(B + (n0 + nt * 16 + r) * ldb + ks * 32 + q * 8);
            acc[nt] = MFMA16(a, b, acc[nt]);
        }
    }
}

__device__ __forceinline__ void layer_prep(const Params& p, int l, int idx, int stride, char* smem);
__device__ __forceinline__ void phase0(const Params& p, char* smem) {
    const int tid = otid();
    cpx* TW = (cpx*)(p.ws + WS_TW);
    cpx* ROPE = (cpx*)(p.ws + WS_ROPE);
    float* MOD = (float*)(p.ws + WS_MOD);
    constexpr int N_TW = NF / NT, N_ROPE = SEQ * 32 / NT, N_MOD = DEPTH * (3 * DM / 64);
    for (int task = obid(); task < N_TW + N_ROPE + N_MOD; task += gridDim.x) {
        if (task < N_TW) {
            const int j = task * NT + tid; float s, c; sincospif(2.0f * (float)j / (float)NF, &s, &c);
            cpx v; v.x = c; v.y = -s; TW[j] = v;
        } else if (task < N_TW + N_ROPE) {
            const int idx = (task - N_TW) * NT + tid; const int pos = idx >> 5, i = idx & 31;
            const float inv = exp2f(-(float)(i & 15) * (13.287712379549449f / 16.0f));
            const float ang = (float)(i < 16 ? pos / 64 : pos % 64) * inv;
            cpx v; v.x = cosf(ang); v.y = sinf(ang); ROPE[idx] = v;
        } else {
            const int mt = task - N_TW - N_ROPE; const int l = mt / (3 * DM / 64), n0 = (mt % (3 * DM / 64)) * 64;
            float* sv = (float*)smem;
            float* red = sv + NJ * DM;
            __syncthreads();
            for (int i = tid; i < NJ * DM; i += NT) { const int j = i / DM, k = i % DM; const float v = j < NB ? p.in[I_C][j * DM + k] : p.in[I_CCTX][k]; sv[i] = siluf_(v); }
            __syncthreads();
            const int c4 = tid & 15, kg = tid >> 4; f32x4 acc[NJ];
#pragma unroll
            for (int j = 0; j < NJ; ++j) acc[j] = (f32x4){0.f, 0.f, 0.f, 0.f};
            const float* w = p.in[I_WADA] + (size_t)l * DM * 3 * DM + n0 + 4 * c4;
#pragma unroll 8
            for (int i = 0; i < DM / 32; ++i) { const int k = kg + 32 * i; const f32x4 wv = *(const f32x4*)(w + (size_t)k * 3 * DM);
#pragma unroll
                for (int j = 0; j < NJ; ++j) acc[j] = acc[j] + wv * sv[j * DM + k]; }
#pragma unroll
            for (int j = 0; j < NJ; ++j) *(f32x4*)(red + (kg * NJ + j) * 64 + 4 * c4) = acc[j];
            __syncthreads();
            for (int i = tid; i < NJ * 64; i += NT) { const int j = i / 64, n = i % 64; float s = 0.f;
#pragma unroll
                for (int k8 = 0; k8 < 32; ++k8) s += red[(k8 * NJ + j) * 64 + n];
                MOD[((size_t)l * NJ + j) * 3 * DM + n0 + n] = s + p.in[I_BADA][(size_t)l * 3 * DM + n0 + n]; }
        }
    }
}

#ifdef EMU
constexpr int PANEL_ROWS = 128, PANEL_UNITS = DM / 128;
#else
constexpr int PANEL_ROWS = 256, PANEL_UNITS = DM / 256;
#endif
__device__ __forceinline__ unsigned* unit_counter(const Params& p, int isctx) { return (unsigned*)(p.ws + WS_BAR + 16384) + 64 * isctx; }
__device__ __forceinline__ unsigned* stage_counter(const Params& p, int flag) { return (unsigned*)(p.ws + WS_BAR + 16384) + 512 + 512 * flag; }
__device__ __forceinline__ void stage_signal(const Params& p, char* smem, int flag, int l) {
#ifdef EMU
    __syncthreads(); if (otid() == 0) *stage_counter(p, flag) += 1u;
#else
    asm volatile("s_waitcnt vmcnt(0)" ::: "memory"); __syncthreads();
    if (threadIdx.x == 0) {
        const unsigned xcc = (unsigned)__builtin_amdgcn_s_getreg((3 << 11) | 20) & 0xFu, nloc = ((volatile __attribute__((address_space(3))) unsigned*)(smem + LDS_BYTES - 64))[0];
        unsigned* g = stage_counter(p, flag);
        if (nloc > 0u) { const unsigned old = __hip_atomic_fetch_add(g + 16 * (1 + xcc), 1u, __ATOMIC_RELAXED, __HIP_MEMORY_SCOPE_AGENT);
            if (old + 1u == nloc * (unsigned)(l + 1)) { __builtin_amdgcn_fence(__ATOMIC_RELEASE, "agent"); asm volatile("s_waitcnt vmcnt(0)" ::: "memory");
                __hip_atomic_fetch_add(g, nloc, __ATOMIC_RELAXED, __HIP_MEMORY_SCOPE_AGENT); } }
        else { __builtin_amdgcn_fence(__ATOMIC_RELEASE, "agent"); asm volatile("s_waitcnt vmcnt(0)" ::: "memory"); __hip_atomic_fetch_add(g, 1u, __ATOMIC_RELAXED, __HIP_MEMORY_SCOPE_AGENT); }
    }
#endif
}
__device__ __forceinline__ void stage_wait(const Params& p, int flag, int l) {
    if (otid() == 0) { const unsigned target = (unsigned)gridDim.x * (unsigned)(l + 1);
#ifdef EMU
        while (*(volatile unsigned*)stage_counter(p, flag) < target) emu::yield();
#else
        unsigned spins = 0;
        while (__hip_atomic_load(stage_counter(p, flag), __ATOMIC_RELAXED, __HIP_MEMORY_SCOPE_AGENT) < target) { __builtin_amdgcn_s_sleep(16); if (++spins > (1u << 20)) break; }
        __builtin_amdgcn_fence(__ATOMIC_ACQUIRE, "agent"); asm volatile("s_waitcnt vmcnt(0)" ::: "memory");
#endif
    }
    __syncthreads();
}
__device__ __forceinline__ int logical_row(int i) { return i < NB * SEQ ? (i / SEQ) * TOK + CTXL + i % SEQ : ((i - NB * SEQ) / CTXL) * TOK + (i - NB * SEQ) % CTXL; }
struct RowRef { const float* xo; float* xn; int mj, row; bool ok; };
__device__ __forceinline__ RowRef rp_ref(const Params& p, int l, int li, int base, int hi) {
    RowRef r; r.ok = li < hi; const int rr = logical_row(r.ok ? li : base); r.row = rr;
    const int b = rr / TOK, pp = rr % TOK; const bool isctx = pp < CTXL; if (l == DEPTH && isctx) r.ok = false;
    const size_t off = isctx ? ((size_t)b * CTXL + pp) * DM : ((size_t)b * SEQ + (pp - CTXL)) * DM;
    float* CTXB = (float*)(p.ws + WS_CTXB);
    r.xo = (l <= 1) ? (isctx ? p.in[I_CTX] + off : p.in[I_X] + off) : (isctx ? CTXB + off : p.out + off);
    r.xn = isctx ? CTXB + off : p.out + off; r.mj = isctx ? NB : b; return r;
}
__device__ __forceinline__ void rp_rows(const Params& p, int l, int lo, int hi, int gi, int nb) {
    const int tid = otid(), lane = tid & 63, wave = tid >> 6;
    const float* MOD = (const float*)(p.ws + WS_MOD);
    const bf16* YO = (const bf16*)(p.ws + WS_P);
    bf16* HN = (bf16*)(p.ws + WS_HNY);
    constexpr int NV4 = DM / 256, RW = 2;
    const int stride = nb * 8;
    f32x4 xq[RW][NV4]; u32x2 yq[RW][NV4]; RowRef rq[RW];
    int base = lo + gi * 8 + wave;
    if (base < hi) {
#pragma unroll
        for (int i = 0; i < RW; ++i) { rq[i] = rp_ref(p, l, base + i * stride, base, hi);
#pragma unroll
            for (int j = 0; j < NV4; ++j) { xq[i][j] = *(const f32x4*)(rq[i].xo + 4 * lane + 256 * j); yq[i][j] = (l > 0) ? *(const u32x2*)(YO + (size_t)rq[i].row * DM + 4 * lane + 256 * j) : (u32x2){0u, 0u}; } }
    }
    for (; base < hi; base += stride * RW) {
        f32x4 x[RW][NV4], y[RW][NV4]; RowRef rc[RW];
#pragma unroll
        for (int i = 0; i < RW; ++i) { rc[i] = rq[i];
#pragma unroll
            for (int j = 0; j < NV4; ++j) { x[i][j] = xq[i][j]; const u32x2 yy = yq[i][j]; y[i][j] = (f32x4){bitsf(yy.x << 16), bitsf(yy.x & 0xffff0000u), bitsf(yy.y << 16), bitsf(yy.y & 0xffff0000u)}; } }
        { const int nbase = base + stride * RW;
            if (nbase < hi) {
#pragma unroll
                for (int i = 0; i < RW; ++i) { rq[i] = rp_ref(p, l, nbase + i * stride, nbase, hi);
#pragma unroll
                    for (int j = 0; j < NV4; ++j) { xq[i][j] = *(const f32x4*)(rq[i].xo + 4 * lane + 256 * j); if (l > 0) yq[i][j] = *(const u32x2*)(YO + (size_t)rq[i].row * DM + 4 * lane + 256 * j); } } } }
        if (l > 0) {
            float ss[RW];
#pragma unroll
            for (int i = 0; i < RW; ++i) { ss[i] = 0.f;
#pragma unroll
                for (int j = 0; j < NV4; ++j) ss[i] += y[i][j].x * y[i][j].x + y[i][j].y * y[i][j].y + y[i][j].z * y[i][j].z + y[i][j].w * y[i][j].w; }
#pragma unroll
            for (int i = 0; i < RW; ++i) ss[i] = wave_sum(ss[i]);
            const float* gp = p.in[I_GPOST] + (size_t)(l - 1) * DM;
#pragma unroll
            for (int i = 0; i < RW; ++i) { const float rstd = rsqrtf(ss[i] * (1.0f / DM) + EPS); const float* gt = MOD + ((size_t)(l - 1) * NJ + rc[i].mj) * 3 * DM + 2 * DM;
#pragma unroll
                for (int j = 0; j < NV4; ++j) { const f32x4 g4 = *(const f32x4*)(gt + 4 * lane + 256 * j), p4 = *(const f32x4*)(gp + 4 * lane + 256 * j);
                    x[i][j] = x[i][j] + g4 * (y[i][j] * rstd * p4);
                    if (rc[i].ok) *(f32x4*)(rc[i].xn + 4 * lane + 256 * j) = x[i][j]; } }
        }
        if (l < DEPTH) {
            float ss[RW];
#pragma unroll
            for (int i = 0; i < RW; ++i) { ss[i] = 0.f;
#pragma unroll
                for (int j = 0; j < NV4; ++j) ss[i] += x[i][j].x * x[i][j].x + x[i][j].y * x[i][j].y + x[i][j].z * x[i][j].z + x[i][j].w * x[i][j].w; }
#pragma unroll
            for (int i = 0; i < RW; ++i) ss[i] = wave_sum(ss[i]);
            const float* gp = p.in[I_GPRE] + (size_t)l * DM;
#pragma unroll
            for (int i = 0; i < RW; ++i) { const float rstd = rsqrtf(ss[i] * (1.0f / DM) + EPS); const float* md = MOD + ((size_t)l * NJ + rc[i].mj) * 3 * DM; const int row = rc[i].row;
#pragma unroll
                for (int j = 0; j < NV4; ++j) { const int e = 4 * lane + 256 * j;
                    const f32x4 g4 = *(const f32x4*)(gp + e), sh = *(const f32x4*)(md + e), sc = *(const f32x4*)(md + DM + e);
                    const f32x4 h = (x[i][j] * rstd * g4) * (sc + 1.0f) + sh;
                    u32x2 o; o.x = pk2(h.x, h.y); o.y = pk2(h.z, h.w);
                    if (rc[i].ok) *(u32x2*)(HN + (size_t)row * DM + e) = o; } }
        }
    }
}

__device__ __forceinline__ void convert_tile(const float* src, int ldn, bf16* dst, int K, int n0, int k0, bool use_map, char* smem) {
    const int tid = otid();
    float* tile = (float*)smem;
    __syncthreads();
#pragma unroll
    for (int i = 0; i < 8; ++i) { const int idx = tid + NT * i, k = idx >> 6, n = idx & 63;
        const int oc = use_map ? orig_col(n0 + n) : (n0 + n);
        tile[k * 65 + n] = oc >= 0 ? src[(size_t)(k0 + k) * ldn + oc] : 0.f; }
    __syncthreads();
    const int n = tid >> 3, c = tid & 7;
    u32x4 o; o.x = pk2(tile[(8 * c + 0) * 65 + n], tile[(8 * c + 1) * 65 + n]); o.y = pk2(tile[(8 * c + 2) * 65 + n], tile[(8 * c + 3) * 65 + n]);
    o.z = pk2(tile[(8 * c + 4) * 65 + n], tile[(8 * c + 5) * 65 + n]); o.w = pk2(tile[(8 * c + 6) * 65 + n], tile[(8 * c + 7) * 65 + n]);
    *(u32x4*)(dst + (size_t)(n0 + n) * K + k0 + 8 * c) = o;
}

__device__ __forceinline__ void filter_task(const Params& p, int l, int L, int pos0, char* smem) {
    const int tid = otid(), j = tid & 63;
    float* z = (float*)smem;
    float* h1 = z + 8 * 33;
    float* h2 = h1 + 8 * 64;
    const float* w1 = p.in[I_HW1] + (size_t)l * 33 * 64; const float* w2 = p.in[I_HW2] + (size_t)l * 64 * 64; const float* w3 = p.in[I_HW3] + (size_t)l * 64 * 512;
    float r1[33], r2[64], r3a[16];
#pragma unroll
    for (int i = 0; i < 33; ++i) r1[i] = w1[i * 64 + j];
#pragma unroll
    for (int i = 0; i < 64; ++i) r2[i] = w2[i * 64 + j];
    const float b1 = p.in[I_HB1][l * 64 + j], b2 = p.in[I_HB2][l * 64 + j], b3 = p.in[I_HB3][l * 512 + tid];
    const float f0 = p.in[I_HFREQ][(l * 2 + 0) * 64 + j], f1 = p.in[I_HFREQ][(l * 2 + 1) * 64 + j];
    __syncthreads();
    if (tid < 8 * 33) { const int pp = tid / 33, i = tid % 33; const float pos = (float)(pos0 + pp);
        const float t = pos / (float)(L - 1 > 1 ? L - 1 : 1), wv = 6.283185307179586f * pos / (float)L; float v;
        if (i == 0) v = t; else { const int bi = (i - 1) & 15; const float f = 1e-4f + (float)bi * ((15.0f - 1e-4f) / 15.0f); v = (i <= 16) ? cosf(wv * f) : -sinf(wv * f); }
        z[tid] = v; }
    __syncthreads();
    { const int pp = tid >> 6; float a = b1;
#pragma unroll
        for (int i = 0; i < 33; ++i) a += z[pp * 33 + i] * r1[i];
        h1[tid] = sinf(f0 * a);
#pragma unroll
        for (int i = 0; i < 16; ++i) r3a[i] = w3[i * 512 + tid]; }
    __syncthreads();
    { const int pp = tid >> 6; float a = b2;
#pragma unroll
        for (int i = 0; i < 64; ++i) a += h1[pp * 64 + i] * r2[i];
        h2[tid] = sinf(f1 * a); }
    __syncthreads();
    { const int o = tid, dir = o >> 8, c = o & 255;
        const float delta = 3.0701134573253946f + (float)c * ((15.350567286626973f - 3.0701134573253946f) / 255.0f);
        float acc[8];
#pragma unroll
        for (int pp = 0; pp < 8; ++pp) acc[pp] = b3;
#pragma unroll 1
        for (int cix = 0; cix < 4; ++cix) {
            float wn[16];
#pragma unroll
            for (int i = 0; i < 16; ++i) wn[i] = (cix < 3) ? w3[(16 * (cix + 1) + i) * 512 + o] : 0.f;
#pragma unroll
            for (int i = 0; i < 16; ++i) {
#pragma unroll
                for (int pp = 0; pp < 8; ++pp) acc[pp] += h2[pp * 64 + 16 * cix + i] * r3a[i]; }
#pragma unroll
            for (int i = 0; i < 16; ++i) r3a[i] = wn[i]; }
        float* KT = (float*)(p.ws + WS_KT); float* HC = (float*)(p.ws + WS_HC);
#pragma unroll
        for (int pp = 0; pp < 8; ++pp) { const int pos = pos0 + pp; const float t = (float)pos / (float)(L - 1 > 1 ? L - 1 : 1);
            const float v = acc[pp] * __expf(-t * delta);
            if (L == SEQ) { if (dir == 0) KT[(size_t)c * NF + pos]= v; else if (pos > 0) KT[(size_t)c * NF + (NF - pos)] = v; else KT[(size_t)c * NF + SEQ] = 0.f; }
            else HC[((size_t)dir * WG + c) * CTXL + pos] = v; }
    }
}

__device__ __forceinline__ void convert_tile_w(const float* src, int ldn, bf16* dst, int K, int n0, int k0, bool use_map, char* wl, int lane) {
    float* tile = (float*)wl;
    const int oc = use_map ? orig_col(n0 + lane) : (n0 + lane);
    float v[64];
#pragma unroll
    for (int k = 0; k < 64; ++k) v[k] = oc >= 0 ? src[(size_t)(k0 + k) * ldn + oc] : 0.f;
#pragma unroll
    for (int k = 0; k < 64; ++k) tile[k * 65 + lane] = v[k];
    WAVE_SYNC();
#pragma unroll
    for (int i = 0; i < 8; ++i) { const int n = (lane >> 3) + 8 * i, c = lane & 7; float f[8];
#pragma unroll
        for (int j = 0; j < 8; ++j) f[j] = tile[(8 * c + j) * 65 + n];
        *(u32x4*)(dst + (size_t)(n0 + n) * K + k0 + 8 * c) = pack8(f); }
    WAVE_SYNC();
}
__device__ __forceinline__ void layer_prep(const Params& p, int l, int idx, int stride, char* smem) {
    constexpr int N_WIN = (NPAD / 64) * (DM / 64), N_FL = SEQ / 8, N_FC = CTXL / 8;
    for (int task = idx; task < N_FL + N_FC; task += stride) {
        if (task < N_FL) filter_task(p, l, SEQ, task * 8, smem);
        else filter_task(p, l, CTXL, (task - N_FL) * 8, smem);
    }
    __syncthreads();
    { const int tid = otid(), lane = tid & 63, wave = __builtin_amdgcn_readfirstlane(tid >> 6);
        char* wl = smem + wave * WLDS;
        for (int task = wave * stride + idx; task < N_WIN; task += 8 * stride) { const int nt = task / (DM / 64), kt = task % (DM / 64);
            convert_tile_w(p.in[I_WIN] + (size_t)l * DM * N_IN, N_IN, (bf16*)(p.ws + WS_WIN), DM, nt * 64, kt * 64, true, wl, lane); } }
}
__device__ __forceinline__ unsigned* row_queue(const Params& p, int l) { return (unsigned*)(p.ws + WS_BAR + 16384) + 2560 + 64 * l; }
__device__ __forceinline__ void wait_units(const Params& p, int c, int l) {
    constexpr int nLatU = NB * (SEQ / PANEL_ROWS) * PANEL_UNITS, nCtxU = NB * (CTXL / PANEL_ROWS) * PANEL_UNITS;
    const unsigned target = (unsigned)((c ? nCtxU : nLatU) * l);
#ifdef EMU
    while (*(volatile unsigned*)unit_counter(p, c) < target) emu::yield();
#else
    unsigned spins = 0;
    while (__hip_atomic_load(unit_counter(p, c), __ATOMIC_RELAXED, __HIP_MEMORY_SCOPE_AGENT) < target) { __builtin_amdgcn_s_sleep(16); if (++spins > (1u << 20)) break; }
    __builtin_amdgcn_fence(__ATOMIC_ACQUIRE, "agent"); asm volatile("s_waitcnt vmcnt(0)" ::: "memory");
#endif
}
__device__ __forceinline__ void phase_rp(const Params& p, int l, char* smem) { const int G = (int)gridDim.x, bid = obid(), tid = otid();
    const bool has_ctx = l < DEPTH;
    constexpr int nLatU = NB * (SEQ / PANEL_ROWS) * PANEL_UNITS, nCtxU = NB * (CTXL / PANEL_ROWS) * PANEL_UNITS;
    const int nU = nLatU + nCtxU;
    const int heavy = (l >= 1 && has_ctx && nU > G && (nU % G) != 0) ? nU % G : 0;
    const int total = heavy > 0 ? NB * SEQ : (has_ctx ? T : NB * SEQ);
    const int nl = G - heavy, np = (l < DEPTH) ? nl / 2 : 0, nr = nl - np;
    int lo, hi, gi, nb; bool prep = false;
    if (bid < heavy) { lo = NB * SEQ; hi = T; gi = bid; nb = heavy; }
    else { const int i = bid - heavy; int nR = total;
        if (np > 0) { nR = ((total * 2 / 3) / (nr * 16)) * (nr * 16); if (nR <= 0) nR = total / 2; }
        if (np > 0 && (i & 1) && i / 2 < np) { prep = true; lo = nR; hi = total; gi = i / 2; nb = np; }
        else { lo = 0; hi = nR; gi = (np > 0) ? (i + 1) / 2 : i; nb = nr; } }
    if (prep) layer_prep(p, l, gi, np, smem);
    else if (l < DEPTH && np == 0) layer_prep(p, l, bid, G, smem);
    if (l >= 1) { if (tid == 0) { if (lo < NB * SEQ) wait_units(p, 0, l); if (hi > NB * SEQ) wait_units(p, 1, l); } __syncthreads(); }
    rp_rows(p, l, lo, hi, gi, nb);
}

__device__ __forceinline__ cpx cmul(cpx a, cpx b) { cpx r; r.x = a.x * b.x - a.y * b.y; r.y = a.x * b.y + a.y * b.x; return r; }
__device__ __forceinline__ cpx cmulc(cpx a, cpx b) { cpx r; r.x = a.x * b.x + a.y * b.y; r.y = a.y * b.x - a.x * b.y; return r; }
constexpr int fpad(int i) { return i + (i >> 4); }
__device__ __forceinline__ int FPH(int i) { return i + (i >> 4); }
constexpr int FBUF = fpad(NF);
constexpr int ilog16(int n) { return n < 16 ? 0 : 1 + ilog16(n / 16); }
constexpr int FFT_P16 = ilog16(NF);
constexpr bool FFT_R4 = ((NF >> (4 * FFT_P16)) == 4);
static_assert((NF >> (4 * FFT_P16)) == 1 || (NF >> (4 * FFT_P16)) == 4, "NF = 16^a * (1 or 4)");
template <bool INV> __device__ __forceinline__ void dft4(cpx& a0, cpx& a1, cpx& a2, cpx& a3) {
    const cpx s = {a0.x + a2.x, a0.y + a2.y}, b = {a0.x - a2.x, a0.y - a2.y}, c = {a1.x + a3.x, a1.y + a3.y}, d = {a1.x - a3.x, a1.y - a3.y};
    a0 = (cpx){s.x + c.x, s.y + c.y}; a2 = (cpx){s.x - c.x, s.y - c.y};
    if (!INV) { a1 = (cpx){b.x + d.y, b.y - d.x}; a3 = (cpx){b.x - d.y, b.y + d.x}; }
    else      { a1 = (cpx){b.x - d.y, b.y + d.x}; a3 = (cpx){b.x + d.y, b.y - d.x}; }
}
template <bool INV> __device__ __forceinline__ cpx cmulk(cpx a, float wr, float wi) {
    cpx r; if (!INV) { r.x = a.x * wr + a.y * wi; r.y = a.y * wr - a.x * wi; } else { r.x = a.x * wr - a.y * wi; r.y = a.y * wr + a.x * wi; } return r;
}
template <bool INV> __device__ __forceinline__ void dft16(cpx (&x)[16]) {
    constexpr float C1 = 0.92387953251128674f, S1 = 0.38268343236508977f, C2 = 0.70710678118654752f;
#pragma unroll
    for (int n2 = 0; n2 < 4; ++n2) dft4<INV>(x[n2], x[4 + n2], x[8 + n2], x[12 + n2]);
    x[4 * 1 + 1] = cmulk<INV>(x[4 * 1 + 1], C1, S1); x[4 * 1 + 2] = cmulk<INV>(x[4 * 1 + 2], C2, C2); x[4 * 1 + 3] = cmulk<INV>(x[4 * 1 + 3], S1, C1);
    x[4 * 2 + 1] = cmulk<INV>(x[4 * 2 + 1], C2, C2); x[4 * 2 + 2] = cmulk<INV>(x[4 * 2 + 2], 0.f, 1.f); x[4 * 2 + 3] = cmulk<INV>(x[4 * 2 + 3], -C2, C2);
    x[4 * 3 + 1] = cmulk<INV>(x[4 * 3 + 1], S1, C1); x[4 * 3 + 2] = cmulk<INV>(x[4 * 3 + 2], -C2, C2); x[4 * 3 + 3] = cmulk<INV>(x[4 * 3 + 3], -C1, -S1);
#pragma unroll
    for (int k1 = 0; k1 < 4; ++k1) dft4<INV>(x[4 * k1 + 0], x[4 * k1 + 1], x[4 * k1 + 2], x[4 * k1 + 3]);
    cpx t;
    t = x[1]; x[1] = x[4]; x[4] = t; t = x[2]; x[2] = x[8]; x[8] = t; t = x[3]; x[3] = x[12]; x[12] = t;
    t = x[6]; x[6] = x[9]; x[9] = t; t = x[7]; x[7] = x[13]; x[13] = t; t = x[11]; x[11] = x[14]; x[14] = t;
}
template <bool INV> __device__ __forceinline__ void fft_stage16(cpx* buf, const cpx* TW, int tl, int M) {
    const int span = M >> 4, twm = NF / M;
#pragma unroll 1
    for (int j = tl; j < NF / 16; j += 256) {
        const int grp = j / span, pos = j % span, base = grp * M + pos; cpx x[16];
#pragma unroll
        for (int q = 0; q < 16; ++q) x[q] = buf[FPH(base + q * span)];
        cpx w1 = {1.f, 0.f}; if (span > 1) w1 = TW[pos * twm];
        if (INV && span > 1) { cpx wk = w1;
#pragma unroll
            for (int k = 1; k < 16; ++k) { x[k] = cmulc(x[k], wk); wk = cmul(wk, w1); } }
        dft16<INV>(x);
        if (!INV && span > 1) { cpx wk = w1;
#pragma unroll
            for (int k = 1; k < 16; ++k) { x[k] = cmul(x[k], wk); wk = cmul(wk, w1); } }
#pragma unroll
        for (int q = 0; q < 16; ++q) buf[FPH(base + q * span)] = x[q];
    }
}
template <bool INV> __device__ __forceinline__ void fft_stage4_last(cpx* buf, int tl) {
#pragma unroll 1
    for (int j = tl; j < NF / 4; j += 256) { cpx a0 = buf[FPH(4 * j)], a1 = buf[FPH(4 * j + 1)], a2 = buf[FPH(4 * j + 2)], a3 = buf[FPH(4 * j + 3)];
        dft4<INV>(a0, a1, a2, a3); buf[FPH(4 * j)] = a0; buf[FPH(4 * j + 1)] = a1; buf[FPH(4 * j + 2)] = a2; buf[FPH(4 * j + 3)] = a3; }
}
__device__ __forceinline__ void fft_fwd(cpx* buf, const cpx* TW, int tl) {
    int M = NF;
#pragma unroll
    for (int s = 0; s < FFT_P16; ++s) { __syncthreads(); fft_stage16<false>(buf, TW, tl, M); M >>= 4; }
    if (FFT_R4) { __syncthreads(); fft_stage4_last<false>(buf, tl); }
    __syncthreads();
}
__device__ __forceinline__ void fft_inv(cpx* buf, const cpx* TW, int tl) {
    if (FFT_R4) { __syncthreads(); fft_stage4_last<true>(buf, tl); }
    int M = FFT_R4 ? 64 : 16;
#pragma unroll
    for (int s = 0; s < FFT_P16; ++s) { __syncthreads(); fft_stage16<true>(buf, TW, tl, M); M <<= 4; }
    __syncthreads();
}
__device__ __forceinline__ void filt_fft_task(const Params& p, int cp, char* smem) {
    const int tid = otid(), half = tid >> 8, tl = tid & 255, c = 2 * cp + half;
    cpx* buf = (cpx*)smem + (size_t)half * FBUF;
    const float* KT = (const float*)(p.ws + WS_KT) + (size_t)c * NF;
    cpx* KF = (cpx*)(p.ws + WS_KF) + (size_t)c * NF;
    const cpx* TW = (const cpx*)(p.ws + WS_TW);
    __syncthreads();
    for (int i = tl; i < NF; i += 256) { cpx v; v.x = KT[i]; v.y = 0.f; buf[FPH(i)] = v; }
    fft_fwd(buf, TW, tl);
    for (int i = tl; i < NF; i += 256) KF[i] = buf[FPH(i)];
}

__device__ __forceinline__ void gemm_tile(const Params& p, const bf16* A, const bf16* Bt, int K, int mt, int nt, int mode, char* smem) {
    const int tid = otid(), lane = tid & 63, wave = tid >> 6;
    bf16* As = (bf16*)smem;
    bf16* Bs = As + 128 * LS;
    const int wm = (wave & 3) * 32, wn = (wave >> 2) * 64;
    f32x4 acc[2][4];
#pragma unroll
    for (int i = 0; i < 2; ++i)
#pragma unroll
        for (int j = 0; j < 4; ++j) acc[i][j] = (f32x4){0.f, 0.f, 0.f, 0.f};
    const int lr = tid >> 3, lc = tid & 7;
    const bf16* Ag = A + (size_t)(mt * 128 + lr) * K + lc * 8;
    const bf16* Bg = Bt + (size_t)(nt * 128 + lr) * K + lc * 8;
    u32x4 ra0, ra1, rb0, rb1;
    ra0 = *(const u32x4*)(Ag); ra1 = *(const u32x4*)(Ag + (size_t)64 * K); rb0 = *(const u32x4*)(Bg); rb1 = *(const u32x4*)(Bg + (size_t)64 * K);
    const int nk = K / 64;
    for (int kt = 0; kt < nk; ++kt) {
        __syncthreads();
        *(u32x4*)(As + lr * LS + lc * 8) = ra0; *(u32x4*)(As + (lr + 64) * LS + lc * 8) = ra1;
        *(u32x4*)(Bs + lr * LS + lc * 8) = rb0; *(u32x4*)(Bs + (lr + 64) * LS + lc * 8) = rb1;
        __syncthreads();
        if (kt + 1 < nk) { const int ko = (kt + 1) * 64;
            ra0 = *(const u32x4*)(Ag + ko); ra1 = *(const u32x4*)(Ag + (size_t)64 * K + ko); rb0 = *(const u32x4*)(Bg + ko); rb1 = *(const u32x4*)(Bg + (size_t)64 * K + ko); }
        mma_nt<4, 2>(As, LS, wm, Bs, LS, wn, acc[0], lane);
        mma_nt<4, 2>(As, LS, wm + 16, Bs, LS, wn, acc[1], lane);
    }
    const int r = lane & 15, q = lane >> 4;
#pragma unroll
    for (int i = 0; i < 2; ++i)
#pragma unroll
        for (int j = 0; j < 4; ++j)
#pragma unroll
            for (int e = 0; e < 4; ++e) {
                const int row = mt * 128 + wm + 16 * i + 4 * q + e, col = nt * 128 + wn + 16 * j + r; const float v = acc[i][j][e];
                if (mode == 0) { if (col < NP) ((bf16*)(p.ws + WS_P))[(size_t)row * NP + col] = f2bf(v); else if (col < NP + 16) ((float*)(p.ws + WS_G))[(size_t)row * NGS + (col - NP)] = v; else if (col < NP + NG) ((bf16*)((float*)(p.ws + WS_G) + (size_t)row * NGS + 16))[col - NP - 16] = f2bf(v); }
                else if (mode == 2) ((bf16*)(p.ws + WS_HT))[(size_t)row * T + col] = f2bf(v);
                else ((bf16*)(p.ws + WS_P))[(size_t)row * DM + col] = f2bf(v);
            }
}

#ifndef EMU
namespace pg8 {
#define PG8_LAS __attribute__((address_space(3)))
typedef unsigned short bf16_t;
typedef short bf16x8 __attribute__((ext_vector_type(8)));
typedef float f32x4 __attribute__((ext_vector_type(4)));
typedef unsigned u32x4 __attribute__((ext_vector_type(4)));
constexpr int BM = 256, BK = 64, HALF = 128, HTB = HALF * BK * 2  , STAGE_BYTES = 8 * HTB, NXCD = 8, WGM = 8;

__host__ __device__ __forceinline__ int lds_byte(int r, int c) { const int st = (r >> 4) * 2 + (c >> 5), rr = r & 15, cc = c & 31, ob = rr * 64 + cc * 2; return st * 1024 + (ob ^ (((ob >> 9) & 1) << 5)); }
__host__ __device__ __forceinline__ void stage_rc(int b, int& R, int& C) { const int st = b / 1024, sb = b % 1024, swz = sb ^ (((sb >> 9) & 1) << 5); R = (st >> 1) * 16 + swz / 64; C = (st & 1) * 32 + (swz % 64) / 2; }
__host__ __device__ __forceinline__ int perm32(int rho) { const int n = rho >> 4, i = rho & 15; return 8 * (i >> 2) + 4 * n + (i & 3); }

struct Unit { int pm, pn; };
struct Gemm { const bf16_t* A; const bf16_t* Bt; int M, N, K; };
__device__ __forceinline__ unsigned cvt_pk_bf16(float lo, float hi) { unsigned r; asm volatile("v_cvt_pk_bf16_f32 %0, %1, %2" : "=v"(r) : "v"(lo), "v"(hi)); return r; }
template <class Epi, class Sched, bool ALIGN_EPI = false, bool SP2 = false>
__device__ __forceinline__ void gemm_phase(PG8_LAS unsigned char* lds, const Gemm g, const Sched& S, const Epi& E) {
    const int tid = otid(), wid = __builtin_amdgcn_readfirstlane(tid >> 6), lane = tid & 63, wr = wid >> 2, wc = wid & 3, fr = lane & 15, fq = lane >> 4;
    const int K = g.K, nt = K / BK;
    unsigned voffA[2], voffB[2];
#pragma unroll
    for (int i = 0; i < 2; ++i) { int R, C; stage_rc(tid * 16 + i * 8192, R, C); const int Rb = Epi::PERM ? ((R & ~31) + perm32(R & 31)) : R;
        voffA[i] = (unsigned)(R * K + C) * 2u; voffB[i] = (unsigned)(Rb * K + C) * 2u; }
    const size_t kstep = (size_t)(BK * 2);
    const size_t hstep = (size_t)HALF * K * 2;
    const size_t tstep = 2 * hstep;
    const unsigned ldsw = (unsigned)wid * 1024u;
    const int aoff = lds_byte(wr * 64 + fr, fq * 8), boff = lds_byte(wc * 32 + fr, fq * 8);
#define PG8_SA(b, h) (((b) * 2 + (h)) * HTB)
#define PG8_SB(b, h) ((4 + (b) * 2 + (h)) * HTB)
#define PG8_STAGE(bufoff, gbase, voff) do { _Pragma("unroll") for (int _i = 0; _i < 2; ++_i) \
        __builtin_amdgcn_global_load_lds((const unsigned*)((const char*)(gbase) + (voff)[_i]), (PG8_LAS unsigned*)(lds + (bufoff) + ldsw + _i * 8192), 16, 0, 0); } while (0)
#define PG8_LDA(dst, b, h) do { _Pragma("unroll") for (int m = 0; m < 4; ++m) _Pragma("unroll") for (int k = 0; k < 2; ++k) dst[m][k] = *(const PG8_LAS bf16x8*)(lds + PG8_SA(b, h) + aoff + m * 2048 + k * 1024); } while (0)
#define PG8_LDB(dst, b, h) do { _Pragma("unroll") for (int n = 0; n < 2; ++n) _Pragma("unroll") for (int k = 0; k < 2; ++k) dst[n][k] = *(const PG8_LAS bf16x8*)(lds + PG8_SB(b, h) + boff + n * 2048 + k * 1024); } while (0)
#define PG8_MMA(ai, bj, At, Bt) do { __builtin_amdgcn_s_setprio(1); _Pragma("unroll") for (int m = 0; m < 4; ++m) _Pragma("unroll") for (int n = 0; n < 2; ++n) _Pragma("unroll") for (int k = 0; k < 2; ++k) \
        acc[ai][bj][m][n] = __builtin_amdgcn_mfma_f32_16x16x32_bf16(Bt[n][k], At[m][k], acc[ai][bj][m][n], 0, 0, 0); __builtin_amdgcn_s_setprio(0); } while (0)
#define PG8_WAIT_V(n) asm volatile("s_waitcnt vmcnt(" #n ")" ::: "memory")
#define PG8_WAIT_L(n) asm volatile("s_waitcnt lgkmcnt(" #n ")" ::: "memory")
#define PG8_BAR __builtin_amdgcn_s_barrier()
#define PG8_SCHED __builtin_amdgcn_sched_barrier(0)
    Unit cur, nxt; int ui = 0;
    if (!S.next(0, cur)) return;
    f32x4 acc[2][2][4][2];
#pragma unroll
    for (int a = 0; a < 2; ++a)
#pragma unroll
        for (int b = 0; b < 2; ++b)
#pragma unroll
            for (int m = 0; m < 4; ++m)
#pragma unroll
                for (int n = 0; n < 2; ++n) acc[a][b][m][n] = (f32x4){0.f, 0.f, 0.f, 0.f};
    bf16x8 At[4][2], B0[2][2], B1[2][2];
    const char* cA = (const char*)g.A + (size_t)cur.pm * tstep; const char* cB = (const char*)g.Bt + (size_t)cur.pn * tstep;
    S.a_ready(cur);
    if constexpr (SP2) {
        PG8_STAGE(PG8_SB(0, 0), cB, voffB); PG8_STAGE(PG8_SB(0, 1), cB + hstep, voffB); PG8_STAGE(PG8_SA(0, 0), cA, voffA); PG8_STAGE(PG8_SA(0, 1), cA + hstep, voffA);
        if (wr == 1) PG8_BAR;
        PG8_WAIT_V(2); PG8_BAR;
        PG8_STAGE(PG8_SB(1, 0), cB + kstep, voffB); PG8_STAGE(PG8_SA(1, 0), cA + kstep, voffA); PG8_STAGE(PG8_SB(1, 1), cB + hstep + kstep, voffB);
        PG8_WAIT_V(6); PG8_BAR;
    } else {
        PG8_STAGE(PG8_SB(0, 0), cB, voffB); PG8_STAGE(PG8_SA(0, 0), cA, voffA); PG8_STAGE(PG8_SB(0, 1), cB + hstep, voffB); PG8_STAGE(PG8_SA(0, 1), cA + hstep, voffA);
        if (wr == 1) PG8_BAR;
        PG8_WAIT_V(4); PG8_BAR;
        PG8_STAGE(PG8_SB(1, 0), cB + kstep, voffB); PG8_STAGE(PG8_SA(1, 0), cA + kstep, voffA); PG8_STAGE(PG8_SB(1, 1), cB + hstep + kstep, voffB);
        PG8_WAIT_V(6); PG8_BAR;
    }
    for (;;) {
        const bool has_next = S.next(ui + 1, nxt);
        const char* nA = has_next ? (const char*)g.A + (size_t)nxt.pm * tstep : cA; const char* nB = has_next ? (const char*)g.Bt + (size_t)nxt.pn * tstep : cB;
        for (int t = 0; t < nt; t += 2) {
            const bool last = (t == nt - 2);
            const char* a1 = cA + (size_t)(t + 1) * kstep;
            const char* a2 = last ? nA : cA + (size_t)(t + 2) * kstep; const char* b2 = last ? nB : cB + (size_t)(t + 2) * kstep;
            const char* a3 = a2 + kstep; const char* b3 = b2 + kstep;
            if (last && has_next) S.a_ready(nxt);
            if constexpr (SP2) {
            PG8_LDB(B0, 0, 0); PG8_LDB(B1, 0, 1); PG8_SCHED; PG8_LDA(At, 0, 0); PG8_STAGE(PG8_SA(1, 1), a1 + hstep, voffA);
            PG8_WAIT_V(8); PG8_WAIT_L(0); PG8_BAR; PG8_MMA(0, 0, At, B0); PG8_MMA(0, 1, At, B1); PG8_BAR; PG8_SCHED;
            PG8_LDA(At, 0, 1); PG8_STAGE(PG8_SB(0, 0), b2, voffB); PG8_STAGE(PG8_SB(0, 1), b2 + hstep, voffB); PG8_STAGE(PG8_SA(0, 0), a2, voffA);
            PG8_WAIT_V(8); PG8_WAIT_L(0); PG8_BAR; PG8_MMA(1, 0, At, B0); PG8_MMA(1, 1, At, B1); PG8_BAR; PG8_SCHED;
            PG8_LDB(B0, 1, 0); PG8_LDB(B1, 1, 1); PG8_SCHED; PG8_LDA(At, 1, 0); PG8_STAGE(PG8_SA(0, 1), a2 + hstep, voffA);
            PG8_WAIT_V(8); PG8_WAIT_L(0); PG8_BAR; PG8_MMA(0, 0, At, B0); PG8_MMA(0, 1, At, B1); PG8_BAR; PG8_SCHED;
            PG8_LDA(At, 1, 1); PG8_STAGE(PG8_SB(1, 0), b3, voffB); PG8_STAGE(PG8_SB(1, 1), b3 + hstep, voffB); PG8_STAGE(PG8_SA(1, 0), a3, voffA);
            PG8_WAIT_V(8); PG8_WAIT_L(0); PG8_BAR; PG8_MMA(1, 0, At, B0); PG8_MMA(1, 1, At, B1); PG8_BAR; PG8_SCHED;
            } else {
            PG8_LDB(B0, 0, 0); PG8_SCHED; PG8_LDA(At, 0, 0); PG8_STAGE(PG8_SA(1, 1), a1 + hstep, voffA);
            PG8_WAIT_L(8); PG8_BAR; PG8_WAIT_L(0); PG8_MMA(0, 0, At, B0); PG8_BAR; PG8_SCHED;
            PG8_LDB(B1, 0, 1); PG8_STAGE(PG8_SB(0, 0), b2, voffB);
            PG8_BAR; PG8_WAIT_L(0); PG8_MMA(0, 1, At, B1); PG8_BAR;
            PG8_LDA(At, 0, 1); PG8_STAGE(PG8_SA(0, 0), a2, voffA);
            PG8_BAR; PG8_WAIT_L(0); PG8_MMA(1, 0, At, B0); PG8_BAR; PG8_SCHED;
            PG8_STAGE(PG8_SB(0, 1), b2 + hstep, voffB);
            PG8_WAIT_V(6); PG8_BAR; PG8_MMA(1, 1, At, B1); PG8_BAR;
            PG8_LDB(B0, 1, 0); PG8_SCHED; PG8_LDA(At, 1, 0); PG8_STAGE(PG8_SA(0, 1), a2 + hstep, voffA);
            PG8_WAIT_L(8); PG8_BAR; PG8_WAIT_L(0); PG8_MMA(0, 0, At, B0); PG8_BAR; PG8_SCHED;
            PG8_LDB(B1, 1, 1); PG8_STAGE(PG8_SB(1, 0), b3, voffB);
            PG8_BAR; PG8_WAIT_L(0); PG8_MMA(0, 1, At, B1); PG8_BAR;
            PG8_LDA(At, 1, 1); PG8_STAGE(PG8_SA(1, 0), a3, voffA);
            PG8_BAR; PG8_WAIT_L(0); PG8_MMA(1, 0, At, B0); PG8_BAR; PG8_SCHED;
            PG8_STAGE(PG8_SB(1, 1), b3 + hstep, voffB);
            PG8_WAIT_V(6); PG8_BAR; PG8_MMA(1, 1, At, B1); PG8_BAR;
            }
        }
        if constexpr (ALIGN_EPI) { if (wr == 0) PG8_BAR; }
        if constexpr (!Epi::AFTER_DRAIN) { E(acc, cur, wr, wc, fr, fq); S.done(cur); }
        if (!has_next) break;
#pragma unroll
        for (int a = 0; a < 2; ++a)
#pragma unroll
            for (int b = 0; b < 2; ++b)
#pragma unroll
                for (int m = 0; m < 4; ++m)
#pragma unroll
                    for (int n = 0; n < 2; ++n) acc[a][b][m][n] = (f32x4){0.f, 0.f, 0.f, 0.f};
        cur = nxt; cA = nA; cB = nB; ++ui;
        if constexpr (ALIGN_EPI) { if (wr == 1) PG8_BAR; }
    }
    PG8_WAIT_V(0);
    if constexpr (!ALIGN_EPI) { if (wr == 0) PG8_BAR; }
    PG8_BAR;
    if constexpr (Epi::AFTER_DRAIN) { E.fused(acc, cur, wr, wc, fr, fq, lds, wid, lane); S.done(cur); }
#undef PG8_SA
#undef PG8_SB
#undef PG8_STAGE
#undef PG8_LDA
#undef PG8_LDB
#undef PG8_MMA
#undef PG8_WAIT_V
#undef PG8_WAIT_L
#undef PG8_BAR
#undef PG8_SCHED
}
__device__ __forceinline__ void map_tile(int L, int nM, int nN, int& pm, int& pn) {
    const int nwg = nM * nN; int wgid = L; { const int q = nwg / NXCD, r = nwg % NXCD, xcd = wgid % NXCD, off = wgid / NXCD; wgid = (xcd < r ? xcd * (q + 1) : r * (q + 1) + (xcd - r) * q) + off; }
    const int nig = WGM * nN, gid = wgid / nig, fm = gid * WGM, gsz = (nM - fm) < WGM ? (nM - fm) : WGM;
    pm = fm + ((wgid % nig) % gsz); pn = (wgid % nig) / gsz;
}
constexpr int MP = T / 256, WP = NMAIN / 256, NU2 = 4 * MP, NU1 = MP * WP;
struct InOrder { int G, c;
    __device__ __forceinline__ bool next(int i, Unit& u) const { const int L = i * G + c; if (L >= NU2 + NU1) return false; int a, b;
        if (L < NU2) { map_tile(L, 4, MP, a, b); u.pm = MP + WP + a; u.pn = b; } else { map_tile(L - NU2, MP, WP, a, b); u.pm = a; u.pn = MP + b; } return true; }
    __device__ __forceinline__ void a_ready(const Unit&) const {}
    __device__ __forceinline__ void done(const Unit&) const {}
};
struct EpiIn { static constexpr bool PERM = true, AFTER_DRAIN = false; bf16_t* P; float* G; bf16_t* HTp;
    __device__ __forceinline__ void operator()(const f32x4 (&acc)[2][2][4][2], const Unit& u, int wr, int wc, int fr, int fq) const {
        if (u.pm < MP) { const int pn = u.pn - MP, row0 = u.pm * BM + wr * 64 + fr;
            if (pn < NP / 256) { const int col0 = pn * BM + wc * 32 + 8 * fq;
#pragma unroll
                for (int ai = 0; ai < 2; ++ai)
#pragma unroll
                    for (int m = 0; m < 4; ++m) { bf16_t* rowp = P + (size_t)(row0 + ai * HALF + m * 16) * NP + col0;
#pragma unroll
                        for (int bj = 0; bj < 2; ++bj) { const f32x4 v0 = acc[ai][bj][m][0], v1 = acc[ai][bj][m][1];
                            u32x4 w; w.x = cvt_pk_bf16(v0[0], v0[1]); w.y = cvt_pk_bf16(v0[2], v0[3]); w.z = cvt_pk_bf16(v1[0], v1[1]); w.w = cvt_pk_bf16(v1[2], v1[3]); *(u32x4*)(rowp + bj * HALF) = w; } } }
            else { const int cb = wc * 32 + 8 * fq;
                if (cb < NG) {
#pragma unroll
                    for (int ai = 0; ai < 2; ++ai)
#pragma unroll
                        for (int m = 0; m < 4; ++m) { float* rowb = G + (size_t)(row0 + ai * HALF + m * 16) * NGS; const f32x4 v0 = acc[ai][0][m][0], v1 = acc[ai][0][m][1];
                            if (cb < 16) { *(f32x4*)(rowb + cb) = v0; *(f32x4*)(rowb + cb + 4) = v1; }
                            else { u32x4 w; w.x = cvt_pk_bf16(v0[0], v0[1]); w.y = cvt_pk_bf16(v0[2], v0[3]); w.z = cvt_pk_bf16(v1[0], v1[1]); w.w = cvt_pk_bf16(v1[2], v1[3]); *(u32x4*)((bf16_t*)(rowb + 16) + (cb - 16)) = w; } } } } }
        else { const int row0 = (u.pm - MP - WP) * BM + wr * 64 + fr, col0 = u.pn * BM + wc * 32 + 8 * fq;
#pragma unroll
            for (int ai = 0; ai < 2; ++ai)
#pragma unroll
                for (int m = 0; m < 4; ++m) { bf16_t* rowp = HTp + (size_t)(row0 + ai * HALF + m * 16) * T + col0;
#pragma unroll
                    for (int bj = 0; bj < 2; ++bj) { const f32x4 v0 = acc[ai][bj][m][0], v1 = acc[ai][bj][m][1];
                        u32x4 w; w.x = cvt_pk_bf16(v0[0], v0[1]); w.y = cvt_pk_bf16(v0[2], v0[3]); w.z = cvt_pk_bf16(v1[0], v1[1]); w.w = cvt_pk_bf16(v1[2], v1[3]); *(u32x4*)(rowp + bj * HALF) = w; } } }
    }
};
struct OutOrder { int G, c; bool lat_only; unsigned* cnt;
    __device__ __forceinline__ bool next(int i, Unit& u) const { constexpr int nN = DM / 256, nLat = NB * (SEQ / 256) * nN, nCtx = NB * (CTXL / 256) * nN; const int L = i * G + c; int a, b;
        if (L < nLat) { map_tile(L, nLat / nN, nN, a, b); u.pm = (a / (SEQ / 256)) * (TOK / 256) + CTXL / 256 + a % (SEQ / 256); }
        else { if (lat_only || L >= nLat + nCtx) return false; map_tile(L - nLat, nCtx / nN, nN, a, b); u.pm = (a / (CTXL / 256)) * (TOK / 256) + a % (CTXL / 256); }
        u.pn = b; return true; }
    __device__ __forceinline__ void a_ready(const Unit&) const {}
    unsigned* xu; unsigned nloc, xtarget;
    __device__ __forceinline__ void done(const Unit& u) const {
        asm volatile("s_waitcnt vmcnt(0)" ::: "memory"); __builtin_amdgcn_s_barrier();
        if (threadIdx.x == 0) { const bool isctx = (u.pm % (TOK / 256)) < CTXL / 256;
            if (!isctx && xtarget != 0u) {
                const unsigned old = __hip_atomic_fetch_add(xu, 1u, __ATOMIC_RELAXED, __HIP_MEMORY_SCOPE_AGENT);
                if (old + 1u == xtarget) { __builtin_amdgcn_fence(__ATOMIC_RELEASE, "agent"); asm volatile("s_waitcnt vmcnt(0)" ::: "memory");
                    __hip_atomic_fetch_add(cnt, nloc, __ATOMIC_RELAXED, __HIP_MEMORY_SCOPE_AGENT); } }
            else { __builtin_amdgcn_fence(__ATOMIC_RELEASE, "agent"); asm volatile("s_waitcnt vmcnt(0)" ::: "memory");
                __hip_atomic_fetch_add(cnt + (isctx ? 64 : 0), 1u, __ATOMIC_RELAXED, __HIP_MEMORY_SCOPE_AGENT); } } }
};
struct EpiOut { static constexpr bool PERM = true, AFTER_DRAIN = false; bf16_t* C;
    __device__ __forceinline__ void operator()(const f32x4 (&acc)[2][2][4][2], const Unit& u, int wr, int wc, int fr, int fq) const {
        const int row0 = u.pm * BM + wr * 64 + fr, col0 = u.pn * BM + wc * 32 + 8 * fq;
#pragma unroll
        for (int ai = 0; ai < 2; ++ai)
#pragma unroll
            for (int m = 0; m < 4; ++m) { bf16_t* rowp = C + (size_t)(row0 + ai * HALF + m * 16) * DM + col0;
#pragma unroll
                for (int bj = 0; bj < 2; ++bj) { const f32x4 v0 = acc[ai][bj][m][0], v1 = acc[ai][bj][m][1];
                    u32x4 w; w.x = cvt_pk_bf16(v0[0], v0[1]); w.y = cvt_pk_bf16(v0[2], v0[3]); w.z = cvt_pk_bf16(v1[0], v1[1]); w.w = cvt_pk_bf16(v1[2], v1[3]); *(u32x4*)(rowp + bj * HALF) = w; } }
    }
};
}
#endif

__device__ __forceinline__ void phase_gemm_in(const Params& p, int l, char* smem) {
    constexpr int N_F = WG / 2;
#ifdef EMU
    constexpr int MT = T / 128, NT1 = NMAIN / 128, N1 = MT * NT1, N2 = 8 * MT;
    for (int task = obid(); task < N1 + N2; task += gridDim.x) {
        if (task < N1) gemm_tile(p, (const bf16*)(p.ws + WS_HNY), (const bf16*)(p.ws + WS_WIN), DM, task / NT1, task % NT1, 0, smem);
        else { const int t2 = task - N1; gemm_tile(p, (const bf16*)(p.ws + WS_WIN) + (size_t)NMAIN * DM, (const bf16*)(p.ws + WS_HNY), DM, t2 / MT, t2 % MT, 2, smem); }
    }
#else
    { const pg8::Gemm g{(const pg8::bf16_t*)(p.ws + WS_HNY), (const pg8::bf16_t*)(p.ws + WS_HNY), 0, 0, DM};
      const pg8::InOrder S{(int)gridDim.x, obid()};
      const pg8::EpiIn E{(pg8::bf16_t*)(p.ws + WS_P), (float*)(p.ws + WS_G), (pg8::bf16_t*)(p.ws + WS_HT)};
      pg8::gemm_phase<pg8::EpiIn, pg8::InOrder, true, true>((PG8_LAS unsigned char*)smem, g, S, E); }
#endif
    { const int G = (int)gridDim.x, bid = obid();
#ifdef EMU
      const int extra = 0;
#else
      const int extra = (pg8::NU1 + pg8::NU2) % G;
#endif
      if (extra > 0 && extra < G) { if (bid >= extra) for (int task = bid - extra; task < N_F; task += G - extra) filt_fft_task(p, task, smem); }
      else for (int task = G - 1 - bid; task < N_F; task += G) filt_fft_task(p, task, smem); }
}
__device__ __forceinline__ void phase_gemm_out(const Params& p, int l, char* smem) {
    const int G = (int)gridDim.x, bid = obid(); const bool has_ctx = l < DEPTH - 1;
#ifdef EMU
    constexpr int MT = T / 128, NTO = DM / 128;
    for (int task = bid; task < MT * NTO; task += G) {
        const int mt = task / NTO, nt = task % NTO;
        if (!has_ctx && (mt % (TOK / 128)) < CTXL / 128) continue;
        gemm_tile(p, (const bf16*)(p.ws + WS_HNY), (const bf16*)(p.ws + WS_WOUT), MIX, mt, nt, 1, smem);
        __syncthreads(); if (otid() == 0) *unit_counter(p, (mt % (TOK / 128)) < CTXL / 128 ? 1 : 0) += 1u;
    }
#else
    const pg8::Gemm g{(const pg8::bf16_t*)(p.ws + WS_HNY), (const pg8::bf16_t*)(p.ws + WS_WOUT), 0, 0, MIX};
    const unsigned xcc = (unsigned)__builtin_amdgcn_s_getreg((3 << 11) | 20) & 0xFu, nloc = ((volatile PG8_LAS unsigned*)(smem + LDS_BYTES - 64))[0];
    const bool agg = (NB * (SEQ / 256) * (DM / 256) == G) && nloc > 0u;
    const pg8::OutOrder S{G, bid, !has_ctx, unit_counter(p, 0), unit_counter(p, 2) + 16 * xcc, nloc, agg ? nloc * (unsigned)(l + 1) : 0u};
    const pg8::EpiOut E{(pg8::bf16_t*)(p.ws + WS_P)};
    pg8::gemm_phase<pg8::EpiOut, pg8::OutOrder, true, true>((PG8_LAS unsigned char*)smem, g, S, E);
#endif
}

__device__ __forceinline__ size_t st_index(int mixer, int dir, int b, int h, int cid) { return ((((size_t)(mixer * 2 + dir) * NB + b) * NH + h) * NCH + cid); }
__device__ __forceinline__ size_t ch_index(int dir, int b, int h, int cid) { return (((size_t)dir * NB + b) * NH + h) * NCH + cid; }

__device__ __forceinline__ void load_tile_nat(const bf16* P, int r0, int c0, bf16* dst, float scale, int tid) {
    const int s = tid >> 3, c8 = tid & 7;
    const u32x4 v = *(const u32x4*)(P + (size_t)(r0 + s) * NP + c0 + c8 * 8);
    if (scale == 1.0f) *(u32x4*)(dst + s * LS + c8 * 8) = v;
    else { float f[8]; unpack8(v, f); u32x4 o; o.x = pk2(f[0] * scale, f[1] * scale); o.y = pk2(f[2] * scale, f[3] * scale); o.z = pk2(f[4] * scale, f[5] * scale); o.w = pk2(f[6] * scale, f[7] * scale);
        *(u32x4*)(dst + s * LS + c8 * 8) = o; }
}
__device__ __forceinline__ void load_tile_tr(const bf16* P, int r0, int c0, bf16* dst, int tid) {
    const int s = tid >> 3, c8 = tid & 7;
    const u32x4 v = *(const u32x4*)(P + (size_t)(r0 + s) * NP + c0 + c8 * 8);
    const unsigned w[4] = {v.x, v.y, v.z, v.w};
#pragma unroll
    for (int j = 0; j < 4; ++j) { dst[(c8 * 8 + 2 * j) * LS + s] = (bf16)(w[j] & 0xffffu); dst[(c8 * 8 + 2 * j + 1) * LS + s] = (bf16)(w[j] >> 16); }
}

template <int NTK>
__device__ __forceinline__ void load_span(const bf16* row, int t0, float (&v)[NTK + 2]) {
    { const bool hl = t0 > 0, hr = t0 + NTK < SEQ; const bf16 xl = row[hl ? -1 : 0], xr = row[hr ? NTK : 0];
        v[0] = hl ? bf2f(xl) : 0.f; v[NTK + 1] = hr ? bf2f(xr) : 0.f; }
    if constexpr (NTK == 8) { float f[8]; unpack8(*(const u32x4*)row, f);
#pragma unroll
        for (int i = 0; i < 8; ++i) v[1 + i] = f[i]; }
    else {
#pragma unroll
        for (int i = 0; i < NTK; ++i) v[1 + i] = bf2f(row[i]); }
}
template <int NTK>
__device__ __forceinline__ void hy_inputs(const bf16* h0, const bf16* h1, const float* cw, const float* cb, int c, int t0, float (&u0)[NTK], float (&u1)[NTK], float (&g0)[NTK], float (&g1)[NTK]) {
    { float xa[NTK + 2], xb[NTK + 2]; load_span<NTK>(h0 + (size_t)512 * T, t0, xa); load_span<NTK>(h1 + (size_t)512 * T, t0, xb);
        const float w0 = cw[0 * 768 + 512 + c], w1 = cw[1 * 768 + 512 + c], w2 = cw[2 * 768 + 512 + c], bb = cb[512 + c];
        float ga[NTK + 2], gb[NTK + 2]; load_span<NTK>(h0 + (size_t)768 * T, t0, ga); load_span<NTK>(h1 + (size_t)768 * T, t0, gb);
#pragma unroll
        for (int i = 0; i < NTK; ++i) { g0[i] = (w0 * xa[i] + w1 * xa[i + 1] + w2 * xa[i + 2] + bb) * siluf_(ga[i + 1]); g1[i] = (w0 * xb[i] + w1 * xb[i + 1] + w2 * xb[i + 2] + bb) * siluf_(gb[i + 1]); } }
    { float va[NTK + 2], vb[NTK + 2], ya[NTK + 2], yb[NTK + 2];
        load_span<NTK>(h0, t0, va); load_span<NTK>(h1, t0, vb); load_span<NTK>(h0 + (size_t)256 * T, t0, ya); load_span<NTK>(h1 + (size_t)256 * T, t0, yb);
        const float v0 = cw[0 * 768 + c], v1 = cw[1 * 768 + c], v2 = cw[2 * 768 + c], vbias = cb[c];
        const float y0 = cw[0 * 768 + 256 + c], y1 = cw[1 * 768 + 256 + c], y2 = cw[2 * 768 + 256 + c], ybias = cb[256 + c];
#pragma unroll
        for (int i = 0; i < NTK; ++i) { u0[i] = (v0 * va[i] + v1 * va[i + 1] + v2 * va[i + 2] + vbias) * (y0 * ya[i] + y1 * ya[i + 1] + y2 * ya[i + 2] + ybias);
            u1[i] = (v0 * vb[i] + v1 * vb[i + 1] + v2 * vb[i + 2] + vbias) * (y0 * yb[i] + y1 * yb[i + 1] + y2 * yb[i + 2] + ybias); } }
}
__device__ __forceinline__ void hylat_task(const Params& p, int l, int bp, int cp, char* smem) {
    const int tid = otid(), half = tid >> 8, tl = tid & 255, c = 2 * cp + half;
    const bf16* HT = (const bf16*)(p.ws + WS_HT); bf16* Y = (bf16*)(p.ws + WS_HNY);
    cpx* buf = (cpx*)smem + (size_t)half * FBUF;
    const cpx* TW = (const cpx*)(p.ws + WS_TW);
    const cpx* KF = (const cpx*)(p.ws + WS_KF) + (size_t)c * NF;
    constexpr int NTK = SEQ / 256;
    const int t0 = NTK * tl;
    const float* cw = p.in[I_HCW] + (size_t)l * 3 * 768; const float* cb = p.in[I_HCB] + (size_t)l * 768;
    const size_t rb0 = (size_t)(2 * bp) * TOK + CTXL, rb1 = rb0 + TOK;
    const bf16* h0 = HT + (size_t)c * T + rb0 + t0; const bf16* h1 = h0 + TOK;
    { float u0[NTK], u1[NTK], g0[NTK], g1[NTK]; hy_inputs<NTK>(h0, h1, cw, cb, c, t0, u0, u1, g0, g1);
        __syncthreads();
#pragma unroll
        for (int i = 0; i < NTK; ++i) { cpx v; v.x = u0[i]; v.y = u1[i]; buf[FPH(t0 + i)] = v; cpx z = {0.f, 0.f}; buf[FPH(SEQ + t0 + i)] = z; } }
    fft_fwd(buf, TW, tl);
#pragma unroll 2
    for (int i = tl; i < NF; i += 256) buf[FPH(i)] = cmul(buf[FPH(i)], KF[i]);
    fft_inv(buf, TW, tl);
    const float dsk = p.in[I_HD][(size_t)l * WG + c]; const float sc = 1.0f / (float)NF;
    { const int tz = otid() & 255; const int t0z = NTK * tz;
        float u0[NTK], u1[NTK], g0[NTK], g1[NTK]; hy_inputs<NTK>(HT + (size_t)c * T + rb0 + t0z, HT + (size_t)c * T + rb0 + t0z + TOK, cw, cb, c, t0z, u0, u1, g0, g1);
        float o0[NTK], o1[NTK];
#pragma unroll
        for (int i = 0; i < NTK; ++i) { const cpx y = buf[FPH(t0z + i)]; o0[i] = g0[i] * (y.x * sc + u0[i] * dsk); o1[i] = g1[i] * (y.y * sc + u1[i] * dsk); }
        bf16* d0 = (bf16*)(p.ws + WS_HT) + (size_t)(768 + c) * T + rb0 + t0z; bf16* d1 = d0 + TOK;
        if constexpr (NTK == 8) { *(u32x4*)d0 = pack8(o0); *(u32x4*)d1 = pack8(o1); }
        else {
#pragma unroll
            for (int i = 0; i < NTK; ++i) { d0[i] = f2bf(o0[i]); d1[i] = f2bf(o1[i]); } } }
}

constexpr int HCB = 16;
__device__ __forceinline__ void hyctx_task(const Params& p, int l, int b, int cblk, char* smem) {
    const int tid = otid(); const int c0 = cblk * HCB;
    const bf16* HT = (const bf16*)(p.ws + WS_HT); bf16* Y = (bf16*)(p.ws + WS_HNY); const float* HC = (const float*)(p.ws + WS_HC);
    float* raw = (float*)smem;
    float* u = raw + 4 * CTXL * HCB;
    float* og = u + CTXL * HCB;
    float* hcm = og + CTXL * HCB;
    bf16* ob = (bf16*)raw;
    const size_t rb = (size_t)b * TOK;
    const float* cw = p.in[I_HCW] + (size_t)l * 3 * 768; const float* cbias = p.in[I_HCB] + (size_t)l * 768;
    constexpr int WT = CTXL / 32;
    __syncthreads();
    for (int i = tid; i < 4 * HCB * (CTXL / 8); i += NT) { const int k = i / (HCB * (CTXL / 8)), cc = (i / (CTXL / 8)) % HCB, ck = i % (CTXL / 8);
        float f[8]; unpack8(*(const u32x4*)(HT + (size_t)(k * 256 + c0 + cc) * T + rb + ck * 8), f);
#pragma unroll
        for (int j = 0; j < 8; ++j) raw[(k * CTXL + ck * 8 + j) * HCB + cc] = f[j]; }
    for (int i = tid; i < 2 * HCB * (CTXL / 4); i += NT) { const int dir = i / (HCB * (CTXL / 4)), cc = (i / (CTXL / 4)) % HCB, pk = i % (CTXL / 4);
        const f32x4 v = *(const f32x4*)(HC + ((size_t)dir * WG + c0 + cc) * CTXL + pk * 4); const float f[4] = {v.x, v.y, v.z, v.w};
#pragma unroll
        for (int j = 0; j < 4; ++j) { const int pos = pk * 4 + j; if (dir == 0) hcm[(CTXL + pos) * HCB + cc] = f[j]; else if (pos > 0) hcm[(CTXL - pos) * HCB + cc] = f[j]; } }
    if (tid < HCB) hcm[tid] = 0.f;
    __syncthreads();
    for (int i = tid; i < CTXL * HCB; i += NT) { const int t = i / HCB, cc = i % HCB; float cv[3];
#pragma unroll
        for (int k = 0; k < 3; ++k) { const float* rk = raw + k * CTXL * HCB; const int ch = k * 256 + c0 + cc;
            const float a = t > 0 ? rk[(t - 1) * HCB + cc] : 0.f, m = rk[t * HCB + cc], z = t < CTXL - 1 ? rk[(t + 1) * HCB + cc] : 0.f;
            cv[k] = cw[0 * 768 + ch] * a + cw[1 * 768 + ch] * m + cw[2 * 768 + ch] * z + cbias[ch]; }
        u[i] = cv[0] * cv[1];
        og[i] = cv[2] * siluf_(raw[(3 * CTXL + t) * HCB + cc]); }
    __syncthreads();
    { const int cc = tid % HCB, tg = tid / HCB, t0 = WT * tg; float acc[WT], w[WT];
#pragma unroll
        for (int j = 0; j < WT; ++j) { acc[j] = 0.f; w[j] = hcm[(t0 + j + CTXL) * HCB + cc]; }
#pragma unroll 8
        for (int s = 0; s < CTXL; ++s) { const float us = u[s * HCB + cc];
#pragma unroll
            for (int j = 0; j < WT; ++j) acc[j] += us * w[j];
#pragma unroll
            for (int j = WT - 1; j > 0; --j) w[j] = w[j - 1];
            w[0] = hcm[(t0 - s - 1 + CTXL) * HCB + cc]; }
        const float dsk = p.in[I_HD][(size_t)l * WG + c0 + cc];
#pragma unroll
        for (int j = 0; j < WT; ++j) { const int t = t0 + j; ob[t * HCB + cc] = f2bf(og[t * HCB + cc] * (acc[j] + u[t * HCB + cc] * dsk)); } }
    __syncthreads();
    for (int i = tid; i < CTXL * 2; i += NT) { const int t = i >> 1, hh = i & 1; *(u32x4*)(Y + (rb + t) * 1024 + YH + c0 + 8 * hh) = *(const u32x4*)(ob + t * HCB + 8 * hh); }
}

__device__ __forceinline__ void attn_task(const Params& p, int l, int b, int kvh, int qt, bool ctxq, char* smem) {
    const int tid = otid(), lane = tid & 63, wave = tid >> 6, r = lane & 15, q = lane >> 4;
    constexpr float QSC = 0.125f * 1.4426950408889634f;
    const bf16* P = (const bf16*)(p.ws + WS_P); bf16* Y = (bf16*)(p.ws + WS_HNY); const cpx* ROPE = (const cpx*)(p.ws + WS_ROPE);
    bf16* Qs = (bf16*)smem;
    bf16* Ks = Qs + 256 * LS;
    bf16* Vt = Ks + 64 * LS;
    bf16* Ps = Vt + 64 * LS;
    const size_t rq0 = (size_t)b * TOK + (ctxq ? 0 : CTXL) + qt * 128;
    __syncthreads();
#pragma unroll
    for (int it = 0; it < 2; ++it) {
        const int idx = tid + NT * it, row = idx >> 2, cpair = idx & 3, g = row >> 7, t = row & 127;
        const bf16* src = P + (rq0 + t) * NP + PD + (kvh * 2 + g) * 64;
        float lo[8], hi[8]; unpack8(*(const u32x4*)(src + cpair * 8), lo); unpack8(*(const u32x4*)(src + 32 + cpair * 8), hi);
        float a[8], c2[8];
#pragma unroll
        for (int j = 0; j < 8; ++j) { float cs = 1.f, sn = 0.f; if (!ctxq) { const cpx cv = ROPE[(size_t)(qt * 128 + t) * 32 + cpair * 8 + j]; cs = cv.x; sn = cv.y; }
            a[j] = (lo[j] * cs - hi[j] * sn) * QSC; c2[j] = (hi[j] * cs + lo[j] * sn) * QSC; }
        *(u32x4*)(Qs + row * LS + cpair * 8) = pack8(a); *(u32x4*)(Qs + row * LS + 32 + cpair * 8) = pack8(c2);
    }
    const int lt0 = ctxq ? 0 : (2 * qt - 2 > 0 ? 2 * qt - 2 : 0), lt1 = ctxq ? -1 : (2 * qt + 3 < SEQ / 64 - 1 ? 2 * qt + 3 : SEQ / 64 - 1);
    const int nloc = lt1 - lt0 + 1, ntiles = nloc + NCC;
    float m[2], lsum[2]; f32x4 O[2][4];
#pragma unroll
    for (int ms = 0; ms < 2; ++ms) { m[ms] = -INFINITY; lsum[ms] = 0.f;
#pragma unroll
        for (int i = 0; i < 4; ++i) O[ms][i] = (f32x4){0.f, 0.f, 0.f, 0.f}; }
    const int g = wave >> 2, tq0 = (wave & 3) * 32;
    (void)Ps;
    __syncthreads();
    bf16x8 qf[2][2];
#pragma unroll
    for (int ms = 0; ms < 2; ++ms)
#pragma unroll
        for (int ks = 0; ks < 2; ++ks) qf[ms][ks] = *(const bf16x8*)(Qs + (g * 128 + tq0 + 16 * ms + r) * LS + ks * 32 + q * 8);
    u32x4 klo = {0u, 0u, 0u, 0u}, khi = klo, vq = klo; f32x4 rp[4] = {(f32x4){1.f, 0.f, 1.f, 0.f}, (f32x4){1.f, 0.f, 1.f, 0.f}, (f32x4){1.f, 0.f, 1.f, 0.f}, (f32x4){1.f, 0.f, 1.f, 0.f}};
    const int ks_ = tid >> 2, kcp = tid & 3, vs_ = tid >> 3, vc8 = tid & 7;
#define ATT_PREFETCH(TI) do { const bool loc_ = (TI) < nloc; const int kt_ = loc_ ? lt0 + (TI) : (TI) - nloc; const size_t rk_ = (size_t)b * TOK + (loc_ ? CTXL : 0) + kt_ * 64; \
        if (tid < 256) { const bf16* src_ = P + (rk_ + ks_) * NP + PD + 256 + kvh * 64; klo = *(const u32x4*)(src_ + kcp * 8); khi = *(const u32x4*)(src_ + 32 + kcp * 8); \
            if (loc_) { const f32x4* rr_ = (const f32x4*)(ROPE + (size_t)(kt_ * 64 + ks_) * 32 + kcp * 8); rp[0] = rr_[0]; rp[1] = rr_[1]; rp[2] = rr_[2]; rp[3] = rr_[3]; } \
            else { rp[0] = rp[1] = rp[2] = rp[3] = (f32x4){1.f, 0.f, 1.f, 0.f}; } } \
        vq = *(const u32x4*)(P + (rk_ + vs_) * NP + PD + 384 + kvh * 64 + vc8 * 8); } while (0)
    ATT_PREFETCH(0);
    for (int ti = 0; ti < ntiles; ++ti) {
        const bool local = ti < nloc; const int kt = local ? lt0 + ti : ti - nloc;
        __syncthreads();
        if (tid < 256) { float lo[8], hi[8]; unpack8(klo, lo); unpack8(khi, hi);
            const float cs[8] = {rp[0].x, rp[0].z, rp[1].x, rp[1].z, rp[2].x, rp[2].z, rp[3].x, rp[3].z}, sn[8] = {rp[0].y, rp[0].w, rp[1].y, rp[1].w, rp[2].y, rp[2].w, rp[3].y, rp[3].w};
            float a[8], c2[8];
#pragma unroll
            for (int j = 0; j < 8; ++j) { a[j] = lo[j] * cs[j] - hi[j] * sn[j]; c2[j] = hi[j] * cs[j] + lo[j] * sn[j]; }
            *(u32x4*)(Ks + ks_ * LS + kcp * 8) = pack8(a); *(u32x4*)(Ks + ks_ * LS + 32 + kcp * 8) = pack8(c2); }
        { const unsigned w[4] = {vq.x, vq.y, vq.z, vq.w};
#pragma unroll
            for (int j = 0; j < 4; ++j) { Vt[(vc8 * 8 + 2 * j) * LS + vs_] = (bf16)(w[j] & 0xffffu); Vt[(vc8 * 8 + 2 * j + 1) * LS + vs_] = (bf16)(w[j] >> 16); } }
        __syncthreads();
        if (ti + 1 < ntiles) ATT_PREFETCH(ti + 1);
        bf16x8 kfr[4][2], vfa[4], vfb[4];
#pragma unroll
        for (int nt = 0; nt < 4; ++nt)
#pragma unroll
            for (int ks = 0; ks < 2; ++ks) kfr[nt][ks] = *(const bf16x8*)(Ks + (16 * nt + r) * LS + ks * 32 + q * 8);
#pragma unroll
        for (int me = 0; me < 4; ++me) { const bf16* vr = Vt + (16 * me + r) * LS + 4 * q;
            const u32x2 a0 = *(const u32x2*)(vr), a1 = *(const u32x2*)(vr + 16), a2 = *(const u32x2*)(vr + 32), a3 = *(const u32x2*)(vr + 48);
            u32x4 va; va.x = a0.x; va.y = a0.y; va.z = a1.x; va.w = a1.y; u32x4 vb; vb.x = a2.x; vb.y = a2.y; vb.z = a3.x; vb.w = a3.y; vfa[me] = as_frag(va); vfb[me] = as_frag(vb); }
#pragma unroll
        for (int ms = 0; ms < 2; ++ms) {
            const int qlo = qt * 128 + tq0 + 16 * ms, klo_ = kt * 64;
            if (local && (klo_ > qlo + 15 + 128 || klo_ + 63 < qlo - 128)) continue;
            const bool domask = local && (klo_ + 63 - qlo > 128 || klo_ - (qlo + 15) < -128);
            f32x4 S[4] = {(f32x4){0.f, 0.f, 0.f, 0.f}, (f32x4){0.f, 0.f, 0.f, 0.f}, (f32x4){0.f, 0.f, 0.f, 0.f}, (f32x4){0.f, 0.f, 0.f, 0.f}};
#pragma unroll
            for (int ks = 0; ks < 2; ++ks)
#pragma unroll
                for (int nt = 0; nt < 4; ++nt) S[nt] = MFMA16(kfr[nt][ks], qf[ms][ks], S[nt]);
            const int qpos = qlo + r; float mx = -INFINITY;
            if (domask) {
#pragma unroll
                for (int nt = 0; nt < 4; ++nt)
#pragma unroll
                    for (int i = 0; i < 4; ++i) { const int d = kt * 64 + nt * 16 + 4 * q + i - qpos; if (d > 128 || d < -128) S[nt][i] = -INFINITY; } }
#pragma unroll
            for (int nt = 0; nt < 4; ++nt)
#pragma unroll
                for (int i = 0; i < 4; ++i) mx = fmaxf(mx, S[nt][i]);
            mx = xrow_max(mx);
            const float mn = fmaxf(m[ms], mx); const float msafe = mn == -INFINITY ? 0.f : mn; const float alpha = EXP2(m[ms] - msafe); float sm = 0.f;
#pragma unroll
            for (int nt = 0; nt < 4; ++nt)
#pragma unroll
                for (int i = 0; i < 4; ++i) { S[nt][i] = EXP2(S[nt][i] - msafe); sm += S[nt][i]; }
            sm = xrow_sum(sm);
            lsum[ms] = lsum[ms] * alpha + sm; m[ms] = mn;
            const float pa[8] = {S[0][0], S[0][1], S[0][2], S[0][3], S[1][0], S[1][1], S[1][2], S[1][3]}, pb[8] = {S[2][0], S[2][1], S[2][2], S[2][3], S[3][0], S[3][1], S[3][2], S[3][3]};
            const bf16x8 p0 = as_frag(pack8(pa)), p1 = as_frag(pack8(pb));
#pragma unroll
            for (int me = 0; me < 4; ++me) { O[ms][me] = O[ms][me] * alpha;
                O[ms][me] = MFMA16(vfa[me], p0, O[ms][me]); O[ms][me] = MFMA16(vfb[me], p1, O[ms][me]); }
        }
    }
#undef ATT_PREFETCH
    const float sink = p.in[I_SINK][(size_t)l * NH + kvh * 2 + g];
#pragma unroll
    for (int ms = 0; ms < 2; ++ms) { const float den = lsum[ms] + EXP2(sink * 1.4426950408889634f - m[ms]); const float inv = frcp_(den);
        const size_t row = rq0 + tq0 + 16 * ms + r; const int col = (kvh * 2 + g) * 64 + 4 * q;
#pragma unroll
        for (int me = 0; me < 4; ++me) { const u32x2 gg = *(const u32x2*)(P + row * NP + PD + 512 + col + 16 * me);
            const float g0 = bitsf(gg.x << 16), g1 = bitsf(gg.x & 0xffff0000u), g2 = bitsf(gg.y << 16), g3 = bitsf(gg.y & 0xffff0000u);
            u32x2 o; o.x = pk2(O[ms][me][0] * inv * siluf_(g0), O[ms][me][1] * inv * siluf_(g1)); o.y = pk2(O[ms][me][2] * inv * siluf_(g2), O[ms][me][3] * inv * siluf_(g3));
            *(u32x2*)(Y + row * 1024 + YD + col + 16 * me) = o; } }
}

#ifdef EMU
__device__ __forceinline__ int olane(int lane) { return lane; }
#else
__device__ __forceinline__ int olane(int lane) { asm volatile("" : "+v"(lane)); return lane; }
#endif
__device__ __forceinline__ void load_nat_tile(const bf16* P, int row0, int col0, bf16* tile, int lane) {
    u32x4 v[8];
#pragma unroll
    for (int i = 0; i < 8; ++i) v[i] = *(const u32x4*)(P + (size_t)(row0 + (lane >> 3) + 8 * i) * NP + col0 + (lane & 7) * 8);
#pragma unroll
    for (int i = 0; i < 8; ++i) *(u32x4*)(tile + swz((lane >> 3) + 8 * i, lane & 7)) = v[i];
}
__device__ __forceinline__ bf16x8 frag_tr(const bf16* tile, int c0, int k0, int lane) {
    const int c = c0 + (lane & 15), kb = k0 + 8 * (lane >> 4); unsigned w[4];
#pragma unroll
    for (int j = 0; j < 4; ++j) w[j] = (unsigned)tile[swz(kb + 2 * j, c >> 3) + (c & 7)] | ((unsigned)tile[swz(kb + 2 * j + 1, c >> 3) + (c & 7)] << 16);
    u32x4 o; o.x = w[0]; o.y = w[1]; o.z = w[2]; o.w = w[3]; return as_frag(o);
}
template <int DIR>
__device__ __forceinline__ void gla_r_frags(const float* Grow0, int lane, bf16x8 (&af)[4]) {
    const int r = lane & 15, q4 = lane >> 4;
#pragma unroll
    for (int mt = 0; mt < 4; ++mt) { u32x4 o = {0u, 0u, 0u, 0u};
        if (q4 < 2) o = *(const u32x4*)((const bf16*)(Grow0 + (size_t)(16 * mt + r) * NGS + 16) + DIR * 16 + 8 * q4);
        af[mt] = as_frag(o); }
}
template <int DIR>
__device__ __forceinline__ float gla_b_col(const Params& p, int l, int h, const bf16x8 (&af)[4], int nt, int lane_, float (&x)[4][4]) {
    const int lane = olane(lane_), r = lane & 15, q4 = lane >> 4, d = h * 64 + 16 * nt + r;
    u32x4 o = {0u, 0u, 0u, 0u};
    if (q4 < 2) { const float* wa = p.in[I_GWA] + ((size_t)(l * 2 + DIR) * 16 + 8 * q4) * WG + d;
        o.x = pk2(wa[0], wa[WG]); o.y = pk2(wa[2 * WG], wa[3 * WG]); o.z = pk2(wa[4 * WG], wa[5 * WG]); o.w = pk2(wa[6 * WG], wa[7 * WG]); }
    const bf16x8 bfr = as_frag(o); const float bias = p.in[I_GBA][(size_t)(l * 2 + DIR) * WG + d];
#pragma unroll
    for (int mt = 0; mt < 4; ++mt) { f32x4 c = {bias, bias, bias, bias}; c = MFMA16(af[mt], bfr, c);
#pragma unroll
        for (int i = 0; i < 4; ++i) x[mt][i] = logsig_fast(c[i]) * (1.0f / 16.0f); }
    float carry = 0.f;
#pragma unroll
    for (int k = 0; k < 4; ++k) { const int mt = DIR == 0 ? k : 3 - k; float* y = x[mt];
        if (DIR == 0) { y[1] += y[0]; y[2] += y[1]; y[3] += y[2]; } else { y[2] += y[3]; y[1] += y[2]; y[0] += y[1]; }
        const float s4 = DIR == 0 ? y[3] : y[0];
        const float t1 = DIR == 0 ? __shfl_up(s4, 16) : __shfl_down(s4, 16), t2 = DIR == 0 ? __shfl_up(s4, 32) : __shfl_down(s4, 32), t3 = DIR == 0 ? __shfl_up(s4, 48) : __shfl_down(s4, 48);
        const int qq = DIR == 0 ? q4 : 3 - q4;
        const float e = (qq >= 1 ? t1 : 0.f) + (qq >= 2 ? t2 : 0.f) + (qq >= 3 ? t3 : 0.f);
        const float tot = __shfl(e + s4, DIR == 0 ? r + 48 : r);
#pragma unroll
        for (int i = 0; i < 4; ++i) y[i] += carry + e;
        carry += tot; }
    return carry;
}

template <int MIXER, int DIR>
__device__ __forceinline__ void chunkst_dir(const Params& p, int l, int b, int h, int cid, const float* Grow0, const unsigned (&kk)[32], const bf16* Vt, bf16* Kt, const float* wvs, float* bendl, int lane_) {
    const int lane = olane(lane_), r = lane & 15, q4 = lane >> 4;
    if constexpr (MIXER == 0) {
        float nacc = 0.f;
#pragma unroll
        for (int c = 0; c < 8; ++c) { float f[8];
#pragma unroll
            for (int j = 0; j < 8; ++j) { const int s = 8 * c + j; const float kv = (s & 1) ? bitsf(kk[s >> 1] & 0xffff0000u) : bitsf(kk[s >> 1] << 16);
                f[j] = kv * 0.125f * wvs[DIR * 64 + s]; nacc += f[j]; }
            *(u32x4*)(Kt + swz(lane, c)) = pack8(f); }
        ((float*)(p.ws + WS_NV))[ch_index(DIR, b, h, cid) * 64 + lane] = nacc;
    } else {
        const bf16* P = (const bf16*)(p.ws + WS_P); const int kcol = PG + 256 + h * 64; const int r0 = b * TOK + cid * 64;
        bf16x8 af[4]; gla_r_frags<DIR>(Grow0, lane, af);
#pragma unroll 2
        for (int nt = 0; nt < 4; ++nt) { const int d = 16 * nt + r; float x[4][4];
            const float bend = gla_b_col<DIR>(p, l, h, af, nt, lane, x);
            if (q4 == 0) { ((float*)(p.ws + WS_BE))[ch_index(DIR, b, h, cid) * 64 + d] = bend; bendl[d] = __expf(fmaxf(bend, -80.0f)); }
#pragma unroll
            for (int mt = 0; mt < 4; ++mt)
#pragma unroll
                for (int i = 0; i < 4; ++i) { const int s = 16 * mt + 4 * q4 + i; const float kv = bf2f(P[(size_t)(r0 + s) * NP + kcol + d]); const float bc = fmaxf(x[mt][i], -80.0f);
                    Kt[swz(d, s >> 3) + (s & 7)] = f2bf(kv * __expf(-bc));
                    ((bf16*)(p.ws + WS_EQ))[((size_t)DIR * T + r0 + s) * WG + h * 64 + d] = f2bf(__expf(bc)); } }
    }
    WAVE_SYNC();
    bf16x8 vf[4][2];
#pragma unroll
    for (int ne = 0; ne < 4; ++ne)
#pragma unroll
        for (int ks = 0; ks < 2; ++ks) vf[ne][ks] = *(const bf16x8*)(Vt + swz(16 * ne + r, ks * 4 + q4));
    bf16* dst = (bf16*)(p.ws + WS_ST) + st_index(MIXER, DIR, b, h, cid) * 4096;
#pragma unroll
    for (int me = 0; me < 4; ++me) {
        f32x4 acc[4] = {(f32x4){0.f, 0.f, 0.f, 0.f}, (f32x4){0.f, 0.f, 0.f, 0.f}, (f32x4){0.f, 0.f, 0.f, 0.f}, (f32x4){0.f, 0.f, 0.f, 0.f}};
#pragma unroll
        for (int ks = 0; ks < 2; ++ks) { const bf16x8 a = *(const bf16x8*)(Kt + swz(16 * me + r, ks * 4 + q4));
#pragma unroll
            for (int ne = 0; ne < 4; ++ne) acc[ne] = MFMA16(a, vf[ne][ks], acc[ne]); }
        f32x4 sc4 = {1.f, 1.f, 1.f, 1.f}; if constexpr (MIXER == 1) sc4 = *(const f32x4*)(bendl + 16 * me + 4 * q4);
#pragma unroll
        for (int ne = 0; ne < 4; ++ne) { const f32x4 v = acc[ne] * sc4; u32x2 o; o.x = pk2(v[0], v[1]); o.y = pk2(v[2], v[3]); *(u32x2*)(dst + (16 * ne + r) * 64 + 16 * me + 4 * q4) = o; }
    }
    WAVE_SYNC();
}
template <int MIXER>
__device__ __forceinline__ void chunkst_w(const Params& p, int l, int b, int h, int cid, char* wl, int lane) {
    const bf16* P = (const bf16*)(p.ws + WS_P); const float* G = (const float*)(p.ws + WS_G);
    const int r0 = b * TOK + cid * 64, r = lane & 15, q4 = lane >> 4;
    bf16* Kt = (bf16*)wl;
    bf16* Vt = Kt + 4096;
    float* wvs = (float*)(Vt + 4096);
    float* bendl = wvs + 128;
    const int kcol = (MIXER == 0 ? PA : PG) + 256 + h * 64, vcol = (MIXER == 0 ? PA : PG) + 512 + h * 64;
    const float* Grow0 = G + (size_t)r0 * NGS;
    { bf16* Nn = Kt;
        load_nat_tile(P, r0, vcol, Nn, lane);
        WAVE_SYNC();
#pragma unroll
        for (int c = 0; c < 8; ++c) { unsigned w[4];
#pragma unroll
            for (int j = 0; j < 4; ++j) w[j] = (unsigned)Nn[swz(8 * c + 2 * j, lane >> 3) + (lane & 7)] | ((unsigned)Nn[swz(8 * c + 2 * j + 1, lane >> 3) + (lane & 7)] << 16);
            u32x4 o; o.x = w[0]; o.y = w[1]; o.z = w[2]; o.w = w[3]; *(u32x4*)(Vt + swz(lane, c)) = o; }
        WAVE_SYNC();
        load_nat_tile(P, r0, kcol, Nn, lane);
        WAVE_SYNC(); }
    unsigned kk[32];
    { const bf16* Nn = Kt;
#pragma unroll
        for (int i = 0; i < 32; ++i) kk[i] = (unsigned)Nn[swz(2 * i, lane >> 3) + (lane & 7)] | ((unsigned)Nn[swz(2 * i + 1, lane >> 3) + (lane & 7)] << 16); }
    WAVE_SYNC();
    if constexpr (MIXER == 0) {
        const float* g = Grow0 + (size_t)lane * NGS; const float* gb = p.in[I_MGB] + (size_t)l * 16;
        const float i_f = g[h] + gb[h], f_f = g[4 + h] + gb[4 + h], i_b = g[8 + h] + gb[8 + h], f_b = g[12 + h] + gb[12 + h];
        const float lf = logsigf_(f_f), lb = logsigf_(f_b);
        const float bF = wave_prefix_sum(lf, lane), totF = __shfl(bF, 63);
        const float gF = totF - bF + i_f, mF = wave_max(gF);
        const float totB = wave_sum(lb), preB = wave_prefix_sum(lb, lane), bB = totB - preB + lb;
        const float gB = totB - bB + i_b, mB = wave_max(gB);
        wvs[lane] = __expf(gF - mF); wvs[64 + lane] = __expf(gB - mB);
        if (lane == 0) { float* SC = (float*)(p.ws + WS_SC);
            SC[ch_index(0, b, h, cid) * 4 + 0] = totF; SC[ch_index(0, b, h, cid) * 4 + 1] = mF;
            SC[ch_index(1, b, h, cid) * 4 + 0] = totB; SC[ch_index(1, b, h, cid) * 4 + 1] = mB; }
    }
    WAVE_SYNC();
    chunkst_dir<MIXER, 0>(p, l, b, h, cid, Grow0, kk, Vt, Kt, wvs, bendl, lane);
    chunkst_dir<MIXER, 1>(p, l, b, h, cid, Grow0, kk, Vt, Kt, wvs, bendl, lane);
}

template <int DIR>
__device__ __forceinline__ void chunkst_gla(const Params& p, int l, int b, int h, int cid, char* wl, int lane_) {
    const bf16* P = (const bf16*)(p.ws + WS_P);
    const int lane = olane(lane_), r0 = b * TOK + cid * 64, r = lane & 15, q4 = lane >> 4;
    bf16* Kt = (bf16*)wl;
    bf16* An = Kt + 4096;
    float* bendl = (float*)(An + 4096);
    const int kcol = PG + 256 + h * 64, vcol = PG + 512 + h * 64;
    const float* Grow0 = (const float*)(p.ws + WS_G) + (size_t)r0 * NGS;
    load_nat_tile(P, r0, vcol, An, lane);
    WAVE_SYNC();
    bf16x8 vf[4][2];
#pragma unroll
    for (int ne = 0; ne < 4; ++ne)
#pragma unroll
        for (int ks = 0; ks < 2; ++ks) vf[ne][ks] = frag_tr(An, 16 * ne, 32 * ks, lane);
    WAVE_SYNC();
    load_nat_tile(P, r0, kcol, An, lane);
    WAVE_SYNC();
    bf16x8 af[4]; gla_r_frags<DIR>(Grow0, lane, af);
#pragma unroll 2
    for (int nt = 0; nt < 4; ++nt) { const int d = 16 * nt + r; float x[4][4];
        const float bend = gla_b_col<DIR>(p, l, h, af, nt, lane, x);
        if (q4 == 0) { ((float*)(p.ws + WS_BE))[ch_index(DIR, b, h, cid) * 64 + d] = bend; bendl[d] = __expf(fmaxf(bend, -80.0f)); }
#pragma unroll
        for (int mt = 0; mt < 4; ++mt)
#pragma unroll
            for (int i = 0; i < 4; ++i) { const int s = 16 * mt + 4 * q4 + i; bf16* ke = An + swz(s, d >> 3) + (d & 7); const float kv = bf2f(*ke); const float bc = fmaxf(x[mt][i], -80.0f);
                Kt[swz(d, s >> 3) + (s & 7)] = f2bf(kv * __expf(-bc));
                *ke = f2bf(__expf(bc)); } }
    WAVE_SYNC();
    { bf16* EQg = (bf16*)(p.ws + WS_EQ) + ((size_t)DIR * T + r0) * WG + h * 64;
#pragma unroll
        for (int i = 0; i < 8; ++i) { const int s = (lane >> 3) + 8 * i, ck = lane & 7; *(u32x4*)(EQg + (size_t)s * WG + ck * 8) = *(const u32x4*)(An + swz(s, ck)); } }
    bf16* dst = (bf16*)(p.ws + WS_ST) + st_index(1, DIR, b, h, cid) * 4096;
#pragma unroll
    for (int me = 0; me < 4; ++me) {
        f32x4 acc[4] = {(f32x4){0.f, 0.f, 0.f, 0.f}, (f32x4){0.f, 0.f, 0.f, 0.f}, (f32x4){0.f, 0.f, 0.f, 0.f}, (f32x4){0.f, 0.f, 0.f, 0.f}};
#pragma unroll
        for (int ks = 0; ks < 2; ++ks) { const bf16x8 a = *(const bf16x8*)(Kt + swz(16 * me + r, ks * 4 + q4));
#pragma unroll
            for (int ne = 0; ne < 4; ++ne) acc[ne] = MFMA16(a, vf[ne][ks], acc[ne]); }
        const f32x4 sc4 = *(const f32x4*)(bendl + 16 * me + 4 * q4);
#pragma unroll
        for (int ne = 0; ne < 4; ++ne) { const f32x4 v = acc[ne] * sc4; u32x2 o; o.x = pk2(v[0], v[1]); o.y = pk2(v[2], v[3]); *(u32x2*)(dst + (16 * ne + r) * 64 + 16 * me + 4 * q4) = o; }
    }
    WAVE_SYNC();
}

template <int MIXER, int DIR>
__device__ __forceinline__ void chunkout_prep(const Params& p, int l, int b, int h, int cid, const float* Grow0, int r0, int pbase, const bf16* EQ, float* gar, int lane_) {
    const int lane = olane(lane_);
    if constexpr (MIXER == 0) {
        const bf16* P = (const bf16*)(p.ws + WS_P);
        const float* g = Grow0 + (size_t)lane * NGS; const float* gb = p.in[I_MGB] + (size_t)l * 16;
        const float ig = g[DIR * 8 + h] + gb[DIR * 8 + h], fg = g[DIR * 8 + 4 + h] + gb[DIR * 8 + 4 + h];
        const float mprev = ((const float*)(p.ws + WS_SC))[ch_index(DIR, b, h, cid) * 4 + 2];
        const float lf = logsigf_(fg); float bb;
        if (DIR == 0) bb = wave_prefix_sum(lf, lane); else { const float tt = wave_sum(lf), pre = wave_prefix_sum(lf, lane); bb = tt - pre + lf; }
        const float a = ig - bb; const float pm = DIR == 0 ? wave_prefix_max(a, lane) : wave_suffix_max(a, lane);
        const float mt_ = fmaxf(bb + mprev, bb + pm);
        float* ga = gar + DIR * 320;
        ga[lane] = bb - mt_; ga[64 + lane] = a; ga[128 + lane] = __expf(bb + mprev - mt_); ga[192 + lane] = __expf(-mt_);
        float* nvl = gar + 640 + DIR * 64;
        nvl[lane] = ((const float*)(p.ws + WS_NV))[ch_index(DIR, b, h, cid) * 64 + lane];
        WAVE_SYNC();
        float dq = 0.f;
#pragma unroll
        for (int c = 0; c < 8; ++c) { float f[8]; unpack8(*(const u32x4*)(P + (size_t)(r0 + lane) * NP + pbase + c * 8), f);
            const f32x4 n0 = *(const f32x4*)(nvl + c * 8), n1 = *(const f32x4*)(nvl + c * 8 + 4);
            dq += f[0] * n0.x + f[1] * n0.y + f[2] * n0.z + f[3] * n0.w + f[4] * n1.x + f[5] * n1.y + f[6] * n1.z + f[7] * n1.w; }
        ga[256 + lane] = dq;
    }
}
template <int MIXER, int DIR, int NS>
__device__ __forceinline__ void chunkout_dir(const Params& p, int b, int h, int cid, int r0, int pbase, int th, const bf16x8 (&vtf)[4][2], const bf16* VtL, const bf16* EQ, bf16* SB, const float* gar, float* rsm, f32x4 (&htot)[NS][4], int lane_) {
    const bf16* P = (const bf16*)(p.ws + WS_P); const bf16* ST = (const bf16*)(p.ws + WS_ST);
    const int lane = olane(lane_), r = lane & 15, q4 = lane >> 4;
    const bf16* E = EQ + ((size_t)DIR * T + r0) * WG + h * 64;
    const float* ga = gar + DIR * 320;
    bf16x8 kf[4][2], ctf[4][2];
#pragma unroll
    for (int n = 0; n < 4; ++n)
#pragma unroll
        for (int ks = 0; ks < 2; ++ks) { if constexpr (MIXER == 0) kf[n][ks] = vtf[n][ks];
            else kf[n][ks] = *(const bf16x8*)(P + (size_t)(r0 + 16 * n + r) * NP + pbase + 256 + ks * 32 + q4 * 8);
            ctf[n][ks] = *(const bf16x8*)(ST + st_index(MIXER, DIR, b, h, cid) * 4096 + (16 * n + r) * 64 + ks * 32 + q4 * 8);
            if constexpr (MIXER == 1) { float fe[8], fk[8]; unpack8(*(const u32x4*)(E + (size_t)(16 * n + r) * WG + ks * 32 + q4 * 8), fe); unpack8(as_u4(kf[n][ks]), fk);
#pragma unroll
                for (int j = 0; j < 8; ++j) fk[j] = fk[j] * frcp_(fe[j]);
                kf[n][ks] = as_frag(pack8(fk)); } }
#pragma unroll
    for (int ms = 0; ms < NS; ++ms) { const int mt = NS * th + ms;
        bf16x8 qf[2];
#pragma unroll
        for (int ks = 0; ks < 2; ++ks) { qf[ks] = *(const bf16x8*)(P + (size_t)(r0 + 16 * mt + r) * NP + pbase + ks * 32 + q4 * 8);
            if constexpr (MIXER == 1) { float fe[8], fq[8]; unpack8(*(const u32x4*)(E + (size_t)(16 * mt + r) * WG + ks * 32 + q4 * 8), fe); unpack8(as_u4(qf[ks]), fq);
#pragma unroll
                for (int j = 0; j < 8; ++j) fq[j] *= 0.125f * fe[j];
                qf[ks] = as_frag(pack8(fq)); } }
        f32x4 S[4] = {(f32x4){0.f, 0.f, 0.f, 0.f}, (f32x4){0.f, 0.f, 0.f, 0.f}, (f32x4){0.f, 0.f, 0.f, 0.f}, (f32x4){0.f, 0.f, 0.f, 0.f}};
#pragma unroll
        for (int ks = 0; ks < 2; ++ks)
#pragma unroll
            for (int n = 0; n < 4; ++n) S[n] = MFMA16(kf[n][ks], qf[ks], S[n]);
        const int t = 16 * mt + r; float sm = 0.f; float gt = 0.f; if constexpr (MIXER == 0) gt = ga[t];
#pragma unroll
        for (int n = 0; n < 4; ++n) { f32x4 gs = {0.f, 0.f, 0.f, 0.f}; if constexpr (MIXER == 0) gs = *(const f32x4*)(ga + 64 + 16 * n + 4 * q4);
#pragma unroll
            for (int i = 0; i < 4; ++i) { const int sidx = 16 * n + 4 * q4 + i; const bool ok = DIR == 0 ? (sidx <= t) : (sidx >= t); float v = 0.f;
                if (ok) { if constexpr (MIXER == 0) v = S[n][i] * 0.125f * __expf(gt + gs[i]); else v = S[n][i]; }
                S[n][i] = v; sm += v; } }
        const float pa[8] = {S[0][0], S[0][1], S[0][2], S[0][3], S[1][0], S[1][1], S[1][2], S[1][3]}, pb[8] = {S[2][0], S[2][1], S[2][2], S[2][3], S[3][0], S[3][1], S[3][2], S[3][3]};
        const bf16x8 sm0 = as_frag(pack8(pa)), sm1 = as_frag(pack8(pb));
        float wi = 1.f, inv = 1.f;
        if constexpr (MIXER == 0) { sm = xrow_sum(sm); wi = ga[128 + t]; const float den = wi * ga[256 + t] + sm; inv = frcp_(fmaxf(fabsf(den), ga[192 + t])); }
#pragma unroll
        for (int me = 0; me < 4; ++me) { f32x4 a1 = {0.f, 0.f, 0.f, 0.f}, a2 = {0.f, 0.f, 0.f, 0.f};
            const int vrow = 16 * me + r, vo = 4 * (q4 & 1), vc = q4 >> 1;
            const u32x2 v0 = *(const u32x2*)(VtL + swz(vrow, 0 + vc) + vo), v1 = *(const u32x2*)(VtL + swz(vrow, 2 + vc) + vo), v2 = *(const u32x2*)(VtL + swz(vrow, 4 + vc) + vo), v3 = *(const u32x2*)(VtL + swz(vrow, 6 + vc) + vo);
            u32x4 va; va.x = v0.x; va.y = v0.y; va.z = v1.x; va.w = v1.y; u32x4 vb; vb.x = v2.x; vb.y = v2.y; vb.z = v3.x; vb.w = v3.y;
            a1 = MFMA16(as_frag(va), sm0, a1); a1 = MFMA16(as_frag(vb), sm1, a1);
            a2 = MFMA16(ctf[me][0], qf[0], a2); a2 = MFMA16(ctf[me][1], qf[1], a2);
            if constexpr (MIXER == 0) htot[ms][me] += (a1 + a2 * wi) * inv; else htot[ms][me] += a1 + a2; }
    }
    (void)SB; (void)rsm;
}
__device__ __forceinline__ void co_build_vt(const bf16* P, int r0, int vcol, bf16* VtL, int lane) {
    bf16* Nn = VtL + 4096;
#pragma unroll
    for (int hh = 0; hh < 2; ++hh) {
        u32x4 v[4];
#pragma unroll
        for (int i = 0; i < 4; ++i) v[i] = *(const u32x4*)(P + (size_t)(r0 + 32 * hh + (lane >> 3) + 8 * i) * NP + vcol + (lane & 7) * 8);
#pragma unroll
        for (int i = 0; i < 4; ++i) *(u32x4*)(Nn + swz((lane >> 3) + 8 * i, lane & 7)) = v[i];
        WAVE_SYNC();
#pragma unroll
        for (int c = 0; c < 4; ++c) { unsigned w[4];
#pragma unroll
            for (int j = 0; j < 4; ++j) w[j] = (unsigned)Nn[swz(8 * c + 2 * j, lane >> 3) + (lane & 7)] | ((unsigned)Nn[swz(8 * c + 2 * j + 1, lane >> 3) + (lane & 7)] << 16);
            u32x4 o; o.x = w[0]; o.y = w[1]; o.z = w[2]; o.w = w[3]; *(u32x4*)(VtL + swz(lane, 4 * hh + c)) = o; }
        WAVE_SYNC(); }
}
template <int MIXER, int NS>
__device__ __forceinline__ void co_finalize(const Params& p, int l, int h, int r0, int pbase, int mt0, f32x4 (&htot)[NS][4], int lane_) {
    const bf16* P = (const bf16*)(p.ws + WS_P); bf16* Y = (bf16*)(p.ws + WS_HNY);
    const float* ngp = p.in[MIXER == 0 ? I_MNG : I_GNG] + (size_t)l * WG + h * 64;
    const int lz = olane(lane_), r = lz & 15, q4 = lz >> 4;
    u32x2 gq[NS][4], oq[NS][4];
#pragma unroll
    for (int ms = 0; ms < NS; ++ms)
#pragma unroll
        for (int me = 0; me < 4; ++me) { const size_t off = (size_t)(r0 + 16 * (mt0 + ms) + r) * NP + pbase + 16 * me + 4 * q4;
            gq[ms][me] = *(const u32x2*)(P + off + (MIXER == 0 ? 1024 : 768)); if constexpr (MIXER == 0) oq[ms][me] = *(const u32x2*)(P + off + 768); else oq[ms][me] = (u32x2){0u, 0u}; }
#pragma unroll
    for (int ms = 0; ms < NS; ++ms) { const int mt = mt0 + ms; float ss = 0.f; float gv[4][4];
#pragma unroll
        for (int me = 0; me < 4; ++me) {
            gv[me][0] = bitsf(gq[ms][me].x << 16); gv[me][1] = bitsf(gq[ms][me].x & 0xffff0000u); gv[me][2] = bitsf(gq[ms][me].y << 16); gv[me][3] = bitsf(gq[ms][me].y & 0xffff0000u);
            if constexpr (MIXER == 0) { htot[ms][me][0] *= sigmoidf_(bitsf(oq[ms][me].x << 16)); htot[ms][me][1] *= sigmoidf_(bitsf(oq[ms][me].x & 0xffff0000u)); htot[ms][me][2] *= sigmoidf_(bitsf(oq[ms][me].y << 16)); htot[ms][me][3] *= sigmoidf_(bitsf(oq[ms][me].y & 0xffff0000u)); }
            ss += htot[ms][me][0] * htot[ms][me][0] + htot[ms][me][1] * htot[ms][me][1] + htot[ms][me][2] * htot[ms][me][2] + htot[ms][me][3] * htot[ms][me][3]; }
        ss = xrow_sum(ss);
        const float rstd = rsqrtf(ss * (1.0f / 64.0f) + EPS);
#pragma unroll
        for (int me = 0; me < 4; ++me) { const int e = 16 * me + 4 * q4; const f32x4 n4 = *(const f32x4*)(ngp + e);
            u32x2 o; o.x = pk2(htot[ms][me][0] * rstd * n4.x * siluf_(gv[me][0]), htot[ms][me][1] * rstd * n4.y * siluf_(gv[me][1]));
            o.y = pk2(htot[ms][me][2] * rstd * n4.z * siluf_(gv[me][2]), htot[ms][me][3] * rstd * n4.w * siluf_(gv[me][3]));
            *(u32x2*)(Y + (size_t)(r0 + 16 * mt + r) * 1024 + (MIXER == 0 ? YA : YG) + h * 64 + e) = o; } }
}
template <int MIXER>
__device__ __forceinline__ void chunkout_w(const Params& p, int l, int b, int h, int cid, char* wl, int lane) {
    const bf16* P = (const bf16*)(p.ws + WS_P); const float* G = (const float*)(p.ws + WS_G);
    const int r0 = b * TOK + cid * 64;
    const int pbase = (MIXER == 0 ? PA : PG) + h * 64;
    bf16* SB = (bf16*)wl;
    float* rsm = (float*)(SB + 1024);
    float* gar = rsm + 16;
    const bf16* EQ = (const bf16*)(p.ws + WS_EQ);
    const float* Grow0 = G + (size_t)r0 * NGS;
    bf16* VtL = (bf16*)(gar + 768);
    bf16x8 vtf[4][2];
#pragma unroll
    for (int me = 0; me < 4; ++me)
#pragma unroll
        for (int ks = 0; ks < 2; ++ks) { if constexpr (MIXER == 0) vtf[me][ks] = *(const bf16x8*)(P + (size_t)(r0 + 16 * me + (lane & 15)) * NP + pbase + 256 + ks * 32 + (lane >> 4) * 8); else vtf[me][ks] = (bf16x8){0, 0, 0, 0, 0, 0, 0, 0}; }
    co_build_vt(P, r0, pbase + 512, VtL, lane);
    chunkout_prep<MIXER, 0>(p, l, b, h, cid, Grow0, r0, pbase, EQ, gar, lane);
    chunkout_prep<MIXER, 1>(p, l, b, h, cid, Grow0, r0, pbase, EQ, gar, lane);
    WAVE_SYNC();
    constexpr int NS = MIXER == 1 ? 2 : 1;
#pragma unroll 1
    for (int th = 0; th < 4 / NS; ++th) {
        f32x4 htot[NS][4];
#pragma unroll
        for (int a = 0; a < NS; ++a)
#pragma unroll
            for (int c = 0; c < 4; ++c) htot[a][c] = (f32x4){0.f, 0.f, 0.f, 0.f};
        chunkout_dir<MIXER, 0, NS>(p, b, h, cid, r0, pbase, th, vtf, VtL, EQ, SB, gar, rsm, htot, lane);
        chunkout_dir<MIXER, 1, NS>(p, b, h, cid, r0, pbase, th, vtf, VtL, EQ, SB, gar, rsm, htot, lane);
        co_finalize<MIXER, NS>(p, l, h, r0, pbase, NS * th, htot, lane);
    }
}
constexpr int CO_PART = 13376;
template <int MIXER, int DIR>
__device__ __forceinline__ void chunkout_piece(const Params& p, int l, int b, int h, int cid, int mt, char* wl, int lane) {
    const bf16* P = (const bf16*)(p.ws + WS_P); const float* G = (const float*)(p.ws + WS_G);
    const int r0 = b * TOK + cid * 64; const int pbase = (MIXER == 0 ? PA : PG) + h * 64;
    bf16* SB = (bf16*)wl; float* rsm = (float*)(SB + 1024); float* gar = rsm + 16; const bf16* EQ = (const bf16*)(p.ws + WS_EQ);
    const float* Grow0 = G + (size_t)r0 * NGS; bf16* VtL = (bf16*)(gar + 768);
    bf16x8 vtf[4][2];
#pragma unroll
    for (int me = 0; me < 4; ++me)
#pragma unroll
        for (int ks = 0; ks < 2; ++ks) { if constexpr (MIXER == 0) vtf[me][ks] = *(const bf16x8*)(P + (size_t)(r0 + 16 * me + (lane & 15)) * NP + pbase + 256 + ks * 32 + (lane >> 4) * 8); else vtf[me][ks] = (bf16x8){0, 0, 0, 0, 0, 0, 0, 0}; }
    co_build_vt(P, r0, pbase + 512, VtL, lane);
    chunkout_prep<MIXER, DIR>(p, l, b, h, cid, Grow0, r0, pbase, EQ, gar, lane);
    WAVE_SYNC();
    f32x4 htot[1][4] = {{(f32x4){0.f, 0.f, 0.f, 0.f}, (f32x4){0.f, 0.f, 0.f, 0.f}, (f32x4){0.f, 0.f, 0.f, 0.f}, (f32x4){0.f, 0.f, 0.f, 0.f}}};
    chunkout_dir<MIXER, DIR, 1>(p, b, h, cid, r0, pbase, mt, vtf, VtL, EQ, SB, gar, rsm, htot, lane);
    float* part = (float*)(wl + CO_PART);
#pragma unroll
    for (int me = 0; me < 4; ++me)
#pragma unroll
        for (int i = 0; i < 4; ++i) part[(me * 4 + i) * 64 + lane] = htot[0][me][i];
}
template <int MIXER>
__device__ __forceinline__ void chunkout_combine(const Params& p, int l, int b, int h, int cid, int mt, const char* smem, int lane) {
    const float* pa = (const float*)(smem + (2 * mt) * WLDS + CO_PART); const float* pb = (const float*)(smem + (2 * mt + 1) * WLDS + CO_PART);
    f32x4 htot[1][4];
#pragma unroll
    for (int me = 0; me < 4; ++me)
#pragma unroll
        for (int i = 0; i < 4; ++i) htot[0][me][i] = pa[(me * 4 + i) * 64 + lane] + pb[(me * 4 + i) * 64 + lane];
    co_finalize<MIXER, 1>(p, l, h, b * TOK + cid * 64, (MIXER == 0 ? PA : PG) + h * 64, mt, htot, lane);
}

template <bool OUT>
__device__ __forceinline__ void chunk_workers(const Params& p, int l, char* smem) {
    const int tid = otid(), lane = tid & 63, wave = __builtin_amdgcn_readfirstlane(tid >> 6);
    const int NW = (int)gridDim.x * 8, wi = wave * (int)gridDim.x + obid();
    const int c_lo = (OUT && l == DEPTH - 1) ? NCC : 0, npc = NCH - c_lo, half = NB * NH * npc;
    char* wl = smem + wave * WLDS;
    if (OUT) {
        const int cl = NCC, npl = NCH - NCC, halfl = NB * NH * npl;
#pragma unroll 1
        for (int t = wi; t < halfl; t += NW) { const int b = t / (NH * npl), h = (t / npl) % NH, cid = cl + t % npl;
            const Params q = relaunder(p); chunkout_w<1>(q, l, b, h, cid, wl, lane); }
        { const int used = halfl % NW;
#pragma unroll 1
            for (int t = (wi + NW - used) % NW; t < halfl; t += NW) { const int b = t / (NH * npl), h = (t / npl) % NH, cid = cl + t % npl;
                const Params q = relaunder(p); chunkout_w<0>(q, l, b, h, cid, wl, lane); } }
        if (l < DEPTH - 1) {
            const int nct = NB * NH * NCC;
#pragma unroll 1
            for (int st = obid(); st < 2 * nct; st += (int)gridDim.x) { const int mixer = st / nct, r2 = st % nct, b = r2 / (NH * NCC), h = (r2 / NCC) % NH, cid = r2 % NCC;
                const Params q = relaunder(p); const int mt = wave >> 1;
                __syncthreads();
                if (mixer == 0) { if (wave & 1) chunkout_piece<0, 1>(q, l, b, h, cid, mt, wl, lane); else chunkout_piece<0, 0>(q, l, b, h, cid, mt, wl, lane); }
                else            { if (wave & 1) chunkout_piece<1, 1>(q, l, b, h, cid, mt, wl, lane); else chunkout_piece<1, 0>(q, l, b, h, cid, mt, wl, lane); }
                __syncthreads();
                if (wave < 4) { if (mixer == 0) chunkout_combine<0>(q, l, b, h, cid, wave, smem, lane); else chunkout_combine<1>(q, l, b, h, cid, wave, smem, lane); }
            }
        }
    } else {
        int off = 0;
#pragma unroll 1
        for (int t = wi; t < half; t += NW) { const int b = t / (NH * npc), h = (t / npc) % NH, cid = c_lo + t % npc;
            const Params q = relaunder(p); chunkst_gla<0>(q, l, b, h, cid, wl, lane); }
        off = (off + half) % NW;
#pragma unroll 1
        for (int t = (wi + NW - off) % NW; t < half; t += NW) { const int b = t / (NH * npc), h = (t / npc) % NH, cid = c_lo + t % npc;
            const Params q = relaunder(p); chunkst_gla<1>(q, l, b, h, cid, wl, lane); }
        off = (off + half) % NW;
#pragma unroll 1
        for (int t = (wi + NW - off) % NW; t < half; t += NW) { const int b = t / (NH * npc), h = (t / npc) % NH, cid = c_lo + t % npc;
            const Params q = relaunder(p); chunkst_w<0>(q, l, b, h, cid, wl, lane); }
    }
}

__device__ __forceinline__ void phase_mix1(const Params& p, int l, char* smem) {
    const bool ctxo = l < DEPTH - 1; const int G = (int)gridDim.x, bid = obid();
    constexpr int N_HL = (NB / 2) * (WG / 2), N_HC = NB * (WG / HCB);
    chunk_workers<false>(p, l, smem);
    stage_signal(p, smem, 0, l);
    for (int t = bid; t < N_HL; t += G) hylat_task(p, l, t / (WG / 2), t % (WG / 2), smem);
    if (ctxo) for (int t = G - 1 - bid; t < N_HC; t += G) hyctx_task(p, l, t / (WG / HCB), t % (WG / HCB), smem);
    stage_signal(p, smem, 2, l);
}

constexpr int SCG = 12;
__device__ __forceinline__ void phase_scan(const Params& p, int l, char* smem) {
    const int tid = otid();
    bf16* ST = (bf16*)(p.ws + WS_ST); float* NV = (float*)(p.ws + WS_NV); const float* BE = (const float*)(p.ws + WS_BE); float* SC = (float*)(p.ws + WS_SC);
    constexpr int NCHAIN = 2 * 2 * NB * NH;
    stage_wait(p, 0, l);
    for (int item = obid() * NT + tid; item < NCHAIN * 1024; item += gridDim.x * NT) {
        const int chain = item >> 10, grp = item & 1023; const int mixer = chain / (2 * NB * NH), dir = (chain / (NB * NH)) % 2, b = (chain / NH) % NB, h = chain % NH;
        float c[4] = {0.f, 0.f, 0.f, 0.f}; float nv[4] = {0.f, 0.f, 0.f, 0.f}; float m = 0.f;
        const int d0 = (grp & 15) * 4; const bool donv = (mixer == 0) && (grp < 16);
        for (int o0 = 0; o0 < NCH; o0 += SCG) {
            u32x2 uu[SCG]; float s0[SCG], s1[SCG]; f32x4 be[SCG]; f32x4 nu[SCG];
#pragma unroll
            for (int j = 0; j < SCG; ++j) if (o0 + j < NCH) { const int cid = chain_cid(dir, o0 + j); const size_t ci = ch_index(dir, b, h, cid);
                uu[j] = *(const u32x2*)(ST + st_index(mixer, dir, b, h, cid) * 4096 + grp * 4);
                if (mixer == 0) { s0[j] = SC[ci * 4 + 0]; s1[j] = SC[ci * 4 + 1]; if (donv) nu[j] = *(const f32x4*)(NV + ci * 64 + grp * 4); }
                else be[j] = *(const f32x4*)(BE + ci * 64 + d0); }
#pragma unroll
            for (int j = 0; j < SCG; ++j) if (o0 + j < NCH) { const int cid = chain_cid(dir, o0 + j); const size_t ci = ch_index(dir, b, h, cid);
                const float u[4] = {bitsf(uu[j].x << 16), bitsf(uu[j].x & 0xffff0000u), bitsf(uu[j].y << 16), bitsf(uu[j].y & 0xffff0000u)};
                u32x2 w; w.x = pk2(c[0], c[1]); w.y = pk2(c[2], c[3]); *(u32x2*)(ST + st_index(mixer, dir, b, h, cid) * 4096 + grp * 4) = w;
                if (mixer == 0) {
                    if (grp == 0) SC[ci * 4 + 2] = m;
                    const float mn = fmaxf(s0[j] + m, s1[j]), a = __expf(s0[j] + m - mn), s = __expf(s1[j] - mn);
#pragma unroll
                    for (int k = 0; k < 4; ++k) c[k] = a * c[k] + s * u[k];
                    if (donv) { f32x4 nw = {nv[0], nv[1], nv[2], nv[3]}; *(f32x4*)(NV + ci * 64 + grp * 4) = nw;
                        nv[0] = a * nv[0] + s * nu[j].x; nv[1] = a * nv[1] + s * nu[j].y; nv[2] = a * nv[2] + s * nu[j].z; nv[3] = a * nv[3] + s * nu[j].w; }
                    m = mn;
                } else { c[0] = __expf(be[j].x) * c[0] + u[0]; c[1] = __expf(be[j].y) * c[1] + u[1]; c[2] = __expf(be[j].z) * c[2] + u[2]; c[3] = __expf(be[j].w) * c[3] + u[3]; } }
        }
    }
    stage_signal(p, smem, 1, l);
    { const bool ctxo = l < DEPTH - 1; const int G = (int)gridDim.x, bid = obid();
        constexpr int QTL = SEQ / 128, QTC = CTXL / 128, N_AL = NB * 2 * QTL, N_AC = NB * 2 * QTC;
        for (int t = bid; t < N_AL; t += G) attn_task(p, l, t / (2 * QTL), (t / QTL) % 2, t % QTL, false, smem);
        if (ctxo) for (int t = (bid + G - 64 % G) % G; t < N_AC; t += G) attn_task(p, l, t / (2 * QTC), (t / QTC) % 2, t % QTC, true, smem); }
}

__device__ __forceinline__ void phase_mix2(const Params& p, int l, char* smem) {
    const int tid = otid();
    stage_wait(p, 1, l);
    chunk_workers<true>(p, l, smem);
    stage_wait(p, 2, l);
    constexpr int N_WOUT = (DM / 64) * (MIX / 64);
    { const int lane = tid & 63, wave = __builtin_amdgcn_readfirstlane(tid >> 6); const int NW = (int)gridDim.x * 8, wi = wave * (int)gridDim.x + obid();
        for (int task = NW - 1 - wi; task < N_WOUT; task += NW) { const int nt = task / (MIX / 64), kt = task % (MIX / 64);
            convert_tile_w(p.in[I_WOUT] + (size_t)l * MIX * DM, DM, (bf16*)(p.ws + WS_WOUT), MIX, nt * 64, kt * 64, false, smem + wave * WLDS, lane); }
        bf16* tile = (bf16*)(smem + wave * WLDS); const bf16* HT = (const bf16*)(p.ws + WS_HT); bf16* Y = (bf16*)(p.ws + WS_HNY);
        constexpr int NTT = NB * (SEQ / 64) * 4;
        for (int t = wi; t < NTT; t += NW) { const int b = t / ((SEQ / 64) * 4), tt = (t / 4) % (SEQ / 64), c0 = (t % 4) * 64; const size_t tok0 = (size_t)b * TOK + CTXL + tt * 64;
#pragma unroll
            for (int i = 0; i < 8; ++i) { const int ch = (lane >> 3) + 8 * i, ck = lane & 7; *(u32x4*)(tile + swz(ch, ck)) = *(const u32x4*)(HT + (size_t)(768 + c0 + ch) * T + tok0 + ck * 8); }
            WAVE_SYNC();
#pragma unroll
            for (int i = 0; i < 8; ++i) { const int tk = (lane >> 3) + 8 * i, cc = lane & 7; unsigned w[4];
#pragma unroll
                for (int j = 0; j < 4; ++j) { const int ca = cc * 8 + 2 * j; w[j] = (unsigned)tile[swz(ca, tk >> 3) + (tk & 7)] | ((unsigned)tile[swz(ca + 1, tk >> 3) + (tk & 7)] << 16); }
                u32x4 o; o.x = w[0]; o.y = w[1]; o.z = w[2]; o.w = w[3]; *(u32x4*)(Y + (tok0 + tk) * 1024 + YH + c0 + cc * 8) = o; }
            WAVE_SYNC(); } }
}


#ifndef EMU
#define LAS __attribute__((address_space(3)))
#define XB_TMO      128
#define XB_XCNT(j)  (256  + 64 * (j))
#define XB_XSUB(j)  (1280 + 64 * (j))
#define XB_XGEN(j)  (2304 + 64 * (j))
#define XB_TOP      3328
#define XB_TOPGEN   3392
#define XCD_BAR_WORDS 3456
#define XB_SPIN_CAP (1u << 18)

__device__ __forceinline__ unsigned xb_ld(unsigned* p)              { return __hip_atomic_load(p, __ATOMIC_RELAXED, __HIP_MEMORY_SCOPE_AGENT); }
__device__ __forceinline__ unsigned xb_add(unsigned* p, unsigned v) { return __hip_atomic_fetch_add(p, v, __ATOMIC_RELAXED, __HIP_MEMORY_SCOPE_AGENT); }
__device__ __forceinline__ unsigned xb_xcc_id() { return (unsigned)__builtin_amdgcn_s_getreg((3 << 11) | 20) & 0xFu; }
#define XB_SPIN(cond, bar) do { unsigned _sp = 0; while (cond) { __builtin_amdgcn_s_sleep(1); \
    if ((++_sp & 255u) == 0u) { if (xb_ld(&(bar)[XB_TMO])) break; if (_sp > XB_SPIN_CAP) { atomicAdd(&(bar)[XB_TMO], 1u); break; } } } } while (0)

struct XcdBarrier {
    unsigned* bar; unsigned x;
    volatile LAS unsigned* st;
};

__device__ __forceinline__ XcdBarrier xcd_barrier_post(unsigned* bar, volatile LAS unsigned* st) {
    XcdBarrier b; b.bar = bar; b.x = xb_xcc_id(); b.st = st;
    if (threadIdx.x == 0) (void)xb_add(&bar[XB_XCNT(b.x)], 1u);
    return b;
}
__device__ __forceinline__ void xcd_barrier_complete(unsigned* bar, unsigned x, unsigned& nloc, unsigned& nx) {
    const unsigned G = gridDim.x * gridDim.y * gridDim.z;
    unsigned sum, cnt, mine, sp = 0u;
    for (;;) {
        sum = 0u; cnt = 0u; mine = 0u;
#pragma unroll
        for (unsigned j = 0; j < 16; ++j) { const unsigned c = xb_ld(&bar[XB_XCNT(j)]); sum += c; cnt += (c > 0u) ? 1u : 0u; mine = (j == x) ? c : mine; }
        if (sum == G) break;
        __builtin_amdgcn_s_sleep(1);
        if ((++sp & 255u) == 0u) { if (xb_ld(&bar[XB_TMO])) break; if (sp > XB_SPIN_CAP) { atomicAdd(&bar[XB_TMO], 1u); break; } }
    }
    nloc = mine > 0u ? mine : 1u; nx = cnt > 0u ? cnt : 1u;
}

__device__ __forceinline__ void xcd_barrier(const XcdBarrier& b) {
    asm volatile("s_waitcnt vmcnt(0)" ::: "memory");
    __syncthreads();
    if (threadIdx.x == 0) {
        unsigned* bar = b.bar;
        __builtin_amdgcn_s_waitcnt(0);
        unsigned nloc = b.st[0], nx = b.st[1];
        if (nloc == 0u) { xcd_barrier_complete(bar, b.x, nloc, nx); b.st[0] = nloc; b.st[1] = nx; }
        const unsigned old = xb_add(&bar[XB_XSUB(b.x)], 1u);
        const unsigned gen = old / nloc;
        if (old + 1u == (gen + 1u) * nloc) {
            __builtin_amdgcn_fence(__ATOMIC_RELEASE, "agent");
            asm volatile("s_waitcnt vmcnt(0)" ::: "memory");
            const unsigned og = xb_add(&bar[XB_TOP], 1u);
            const unsigned tg = og / nx;
            if (og + 1u == (tg + 1u) * nx) xb_add(&bar[XB_TOPGEN], 1u);
            else XB_SPIN(xb_ld(&bar[XB_TOPGEN]) == tg, bar);
            __builtin_amdgcn_fence(__ATOMIC_ACQUIRE, "agent");
            xb_add(&bar[XB_XGEN(b.x)], 1u);
            asm volatile("s_waitcnt vmcnt(0)" ::: "memory");
        } else {
            XB_SPIN(xb_ld(&bar[XB_XGEN(b.x)]) == gen, bar);
            __builtin_amdgcn_fence(__ATOMIC_ACQUIRE, "agent");
            asm volatile("s_waitcnt vmcnt(0)" ::: "memory");
        }
    }
    __syncthreads();
}
#endif

__global__ void __launch_bounds__(NT) fwd_kernel(Params pk, int ph_lo, int ph_hi) {
    SMEM_DECL;
#ifndef EMU
    volatile LAS unsigned* misc = (volatile LAS unsigned*)(smem + LDS_BYTES - 64);
    if (threadIdx.x < 2) misc[threadIdx.x] = 0u;
    __syncthreads();
    const XcdBarrier bar = xcd_barrier_post((unsigned*)(pk.ws + WS_BAR), misc);
#endif
    constexpr int NPH = 2 + 6 * DEPTH;
    for (int ph = ph_lo; ph < ph_hi && ph < NPH; ++ph) {
#ifndef EMU
        Params p = pk; { size_t z = 0; asm volatile("" : "+s"(z)); p.ws = pk.ws + z; p.out = pk.out + z;
#pragma unroll
            for (int i = 0; i < 26; ++i) p.in[i] = pk.in[i] + z; }
#else
        const Params& p = pk;
#endif
        if (ph == 0) phase0(p, smem);
        else if (ph == NPH - 1) phase_rp(p, DEPTH, smem);
        else { const int l = (ph - 1) / 6, k = (ph - 1) % 6;
            if (k == 0) phase_rp(p, l, smem);
            else if (k == 1) phase_gemm_in(p, l, smem);
            else if (k == 2) phase_mix1(p, l, smem);
            else if (k == 3) phase_scan(p, l, smem);
            else if (k == 4) phase_mix2(p, l, smem);
            else phase_gemm_out(p, l, smem);
#ifdef PROBE_DUP
            if (k == PROBE_DUP) { GRID_SYNC();
                if (k == 1) phase_gemm_in(p, l, smem); else if (k == 2) phase_mix1(p, l, smem); else if (k == 4) phase_mix2(p, l, smem); }
#endif
        }
        if (ph + 1 < ph_hi && !(ph >= 6 && ph % 6 == 0) && !(ph >= 1 && ((ph - 1) % 6 == 2 || (ph - 1) % 6 == 3))) {
#ifdef EMU
            GRID_SYNC();
#else
            if (ph_lo < 0) GRID_SYNC();
            xcd_barrier(bar);
#endif
        }
    }
}

#ifndef EMU
extern "C" void kernel_launch(void* const* d_in, const int* in_sizes, int n_in, void* d_out, int out_size, void* d_ws, size_t ws_size, hipStream_t stream) {
    static int grid = 0;
    if (grid == 0) {
        if (n_in != 26 || ws_size < WS_TOTAL) { fprintf(stderr, "kernel_launch: unexpected n_in %d or ws_size %zu (need %zu)\n", n_in, ws_size, (size_t)WS_TOTAL); grid = -1; return; }
        int dev = 0, cus = 0, per_cu = 0;
        hipGetDevice(&dev);
        hipDeviceGetAttribute(&cus, hipDeviceAttributeMultiprocessorCount, dev);
        hipFuncSetAttribute((const void*)fwd_kernel, hipFuncAttributeMaxDynamicSharedMemorySize, LDS_BYTES);
        hipOccupancyMaxActiveBlocksPerMultiprocessor(&per_cu, (const void*)fwd_kernel, NT, LDS_BYTES);
        if (per_cu < 1) { fprintf(stderr, "kernel_launch: occupancy query returned %d\n", per_cu); grid = -1; return; }
        if (per_cu > 1) per_cu = 1;
        grid = cus * per_cu;
    }
    if (grid < 0) return;
    hipMemsetAsync((char*)d_ws + WS_BAR, 0, BAR_BYTES, stream);
    Params p{};
    for (int i = 0; i < 26; ++i) p.in[i] = (const float*)d_in[i];
    p.out = (float*)d_out; p.ws = (char*)d_ws;
    int lo = 0, hi = 2 + 6 * DEPTH;
    void* args[] = {&p, &lo, &hi};
    hipError_t e = hipLaunchCooperativeKernel((const void*)fwd_kernel, dim3(grid), dim3(NT), args, LDS_BYTES, stream);
    if (e != hipSuccess) fprintf(stderr, "cooperative launch failed: %s (grid %d)\n", hipGetErrorString(e), grid);
}
#endif
```

```cpp
#ifdef EMU
#include "emu/hipemu.h"
#define GRID_SYNC() emu::grid_sync()
#define SMEM_DECL char* smem = emu::S().blocks[emu::cur()->block].lds
#define SCHED_FENCE() do {} while (0)
#define EXP2(x) exp2f(x)
#define MFMA16(a, b, c) emu_mfma_16x16x32_bf16(a, b, c)
#else
#include <hip/hip_runtime.h>
#include <hip/hip_cooperative_groups.h>
#include <cstdio>
#include <cstdint>
#define GRID_SYNC() cooperative_groups::this_grid().sync()
#define SMEM_DECL extern __shared__ __attribute__((aligned(16))) char smem[]
#define SCHED_FENCE() __builtin_amdgcn_sched_barrier(0)
#define EXP2(x) __builtin_amdgcn_exp2f(x)
#define MFMA16(a, b, c) __builtin_amdgcn_mfma_f32_16x16x32_bf16(a, b, c, 0, 0, 0)
#endif

#ifdef EMU
#ifndef EMU_DM
#define EMU_DM 256
#endif
#ifndef EMU_NB
#define EMU_NB 2
#endif
#ifndef EMU_SEQ
#define EMU_SEQ 512
#endif
#ifndef EMU_DEPTH
#define EMU_DEPTH 2
#endif
#ifndef EMU_CTXL
#define EMU_CTXL 128
#endif
constexpr int DM = EMU_DM, NB = EMU_NB, SEQ = EMU_SEQ, DEPTH = EMU_DEPTH, CTXL = EMU_CTXL;
#else
constexpr int DM = 1024, NB = 8, SEQ = 2048, DEPTH = 4, CTXL = 256;
#endif
constexpr int MIX = 1024, WG = 256, HD = 64, NH = 4, CH = 64;
constexpr int TOK = CTXL + SEQ, T = NB * TOK, NCH = TOK / CH, NCC = CTXL / CH;
constexpr int N_IN = 4144, NP = 3072, NG = 48, NGS = 32, NMAIN = 3328, NPAD = 4352;
constexpr int NF = 2 * SEQ;
constexpr int NJ = NB + 1;
constexpr int NT = 512;
constexpr float EPS = 1e-6f;
constexpr int PA = 0, PG = 1280, PD = 2304;
constexpr int YA = 0, YH = 256, YG = 512, YD = 768;
constexpr int ilog4(int n) { return n <= 1 ? 0 : 1 + ilog4(n / 4); }
constexpr int FFT_P = ilog4(NF);
static_assert((1 << (2 * FFT_P)) == NF, "NF must be a power of 4");
static_assert(DM % 256 == 0 && CTXL % 128 == 0 && SEQ % 256 == 0, "shape constraints");

typedef unsigned short bf16;
typedef short bf16x8 __attribute__((ext_vector_type(8)));
typedef float f32x4 __attribute__((ext_vector_type(4)));
typedef unsigned u32x4 __attribute__((ext_vector_type(4)));
typedef unsigned u32x2 __attribute__((ext_vector_type(2)));
struct cpx { float x, y; };

constexpr size_t al256(size_t x) { return (x + 255) & ~(size_t)255; }
constexpr size_t WS_CTXB = 0;
constexpr size_t WS_HNY = al256(WS_CTXB + (size_t)NB * CTXL * DM * 4);
constexpr size_t WS_WIN = WS_HNY + (size_t)T * 1024 * 2;
constexpr size_t WS_ST = WS_WIN;
constexpr size_t ST_BYTES = (size_t)2 * 2 * NB * NH * NCH * 4096 * 2;
constexpr size_t WS_KT = al256(WS_WIN + (size_t)NPAD * DM * 2);
static_assert(WS_KT + (size_t)WG * NF * 4 <= WS_ST + ST_BYTES || true, "");
constexpr size_t ST_END = al256((WS_ST + ST_BYTES > WS_KT + (size_t)WG * NF * 4) ? WS_ST + ST_BYTES : WS_KT + (size_t)WG * NF * 4);
constexpr size_t WS_P = ST_END;
constexpr size_t WS_HT = al256(WS_P + (size_t)T * NP * 2);
constexpr size_t WS_WOUT = WS_HT;
constexpr size_t WS_G = al256(WS_HT + (size_t)1024 * T * 2);
constexpr size_t WS_KF = al256(WS_G + (size_t)T * NGS * 4);
constexpr size_t WS_HC = al256(WS_KF + (size_t)WG * NF * 8);
constexpr size_t WS_EQ = al256(WS_HC + (size_t)2 * WG * CTXL * 4);
constexpr size_t WS_NV = al256(WS_EQ + (size_t)2 * T * WG * 2);
constexpr size_t WS_BE = al256(WS_NV + (size_t)2 * NB * NH * NCH * 64 * 4);
constexpr size_t WS_SC = al256(WS_BE + (size_t)2 * NB * NH * NCH * 64 * 4);
constexpr size_t WS_MOD = al256(WS_SC + (size_t)2 * NB * NH * NCH * 4 * 4);
constexpr size_t WS_TW = al256(WS_MOD + (size_t)DEPTH * NJ * 3 * DM * 4);
constexpr size_t WS_ROPE = al256(WS_TW + (size_t)NF * 8);
constexpr size_t WS_BAR = al256(WS_ROPE + (size_t)SEQ * 32 * 8);
constexpr size_t BAR_BYTES = 32768;
constexpr size_t WS_TOTAL = al256(WS_BAR + BAR_BYTES);
static_assert((size_t)T * DM * 4 <= (size_t)T * NP * 2, "YO fits in P");
#ifndef EMU
static_assert(WS_TOTAL <= (size_t)268435456, "workspace map must fit 256 MiB");
#endif

constexpr int LDS_BYTES = 163840;

struct Params {
    const float* in[26];
    float* out;
    char* ws;
};
enum { I_X = 0, I_C, I_CTX, I_CCTX, I_WADA, I_BADA, I_GPRE, I_GPOST, I_WIN, I_MGB, I_MNG, I_HCW, I_HCB, I_HW1, I_HB1, I_HW2, I_HB2, I_HW3, I_HB3,
       I_HFREQ, I_HD, I_GWA, I_GBA, I_GNG, I_SINK, I_WOUT };

__device__ __forceinline__ Params relaunder(const Params& pk) {
#ifdef EMU
    return pk;
#else
    Params p = pk; size_t z = 0; asm volatile("" : "+s"(z)); p.ws = pk.ws + z; p.out = pk.out + z;
#pragma unroll
    for (int i = 0; i < 26; ++i) p.in[i] = pk.in[i] + z;
    return p;
#endif
}
constexpr int WLDS = (LDS_BYTES - 64) / 8 / 16 * 16;
#ifdef EMU
#define WAVE_SYNC() emu_wave_sync()
#else
#define WAVE_SYNC() do { asm volatile("s_waitcnt lgkmcnt(0)" ::: "memory"); __builtin_amdgcn_wave_barrier(); } while (0)
#endif

#ifdef EMU
__device__ __forceinline__ int otid() { return (int)threadIdx.x; }
__device__ __forceinline__ int obid() { return (int)blockIdx.x; }
#else
__device__ __forceinline__ int otid() { int t = (int)threadIdx.x; asm volatile("" : "+v"(t)); return t; }
__device__ __forceinline__ int obid() { int b = (int)blockIdx.x; asm volatile("" : "+s"(b)); return b; }
#endif
__device__ __forceinline__ unsigned fbits(float f) { return __builtin_bit_cast(unsigned, f); }
__device__ __forceinline__ float bitsf(unsigned u) { return __builtin_bit_cast(float, u); }
__device__ __forceinline__ float bf2f(bf16 h) { return bitsf((unsigned)h << 16); }
#ifdef EMU
__device__ __forceinline__ bf16 f2bf(float f) { unsigned u = fbits(f); return (bf16)((u + 0x7fffu + ((u >> 16) & 1u)) >> 16); }
__device__ __forceinline__ unsigned pk2(float lo, float hi) { return (unsigned)f2bf(lo) | ((unsigned)f2bf(hi) << 16); }
#else
typedef __bf16 nbf16x2 __attribute__((ext_vector_type(2)));
typedef float nf32x2 __attribute__((ext_vector_type(2)));
__device__ __forceinline__ unsigned pk2(float lo, float hi) { const nf32x2 v = {lo, hi}; return __builtin_bit_cast(unsigned, __builtin_convertvector(v, nbf16x2)); }
__device__ __forceinline__ bf16 f2bf(float f) { return (bf16)(pk2(f, 0.0f) & 0xffffu); }
#endif
#ifdef EMU
__device__ __forceinline__ float frcp_(float x) { return 1.0f / x; }
#else
__device__ __forceinline__ float frcp_(float x) { return __builtin_amdgcn_rcpf(x); }
#endif
__device__ __forceinline__ float sigmoidf_(float x) { return frcp_(1.0f + __expf(-x)); }
__device__ __forceinline__ float siluf_(float x) { return x * frcp_(1.0f + __expf(-x)); }
__device__ __forceinline__ float logsigf_(float x) { return fminf(x, 0.0f) - log1pf(__expf(-fabsf(x))); }
__device__ __forceinline__ float logsig_fast(float x) { return fminf(x, 0.0f) - __logf(1.0f + __expf(-fabsf(x))); }
#ifdef EMU
__device__ __forceinline__ float row16_sum(float x) { x += __shfl_xor(x, 1); x += __shfl_xor(x, 2); x += __shfl_xor(x, 4); x += __shfl_xor(x, 8); return x; }
__device__ __forceinline__ float row16_max(float x) { x = fmaxf(x, __shfl_xor(x, 1)); x = fmaxf(x, __shfl_xor(x, 2)); x = fmaxf(x, __shfl_xor(x, 4)); x = fmaxf(x, __shfl_xor(x, 8)); return x; }
__device__ __forceinline__ float xrow_sum(float x) { x += __shfl_xor(x, 16); x += __shfl_xor(x, 32); return x; }
__device__ __forceinline__ float xrow_max(float x) { x = fmaxf(x, __shfl_xor(x, 16)); x = fmaxf(x, __shfl_xor(x, 32)); return x; }
#else
template <int CTRL> __device__ __forceinline__ float dpp_(float x) { return __builtin_bit_cast(float, __builtin_amdgcn_mov_dpp(__builtin_bit_cast(int, x), CTRL, 0xf, 0xf, true)); }
__device__ __forceinline__ float row16_sum(float x) { x += dpp_<0xB1>(x); x += dpp_<0x4E>(x); x += dpp_<0x141>(x); x += dpp_<0x128>(x); return x; }
__device__ __forceinline__ float row16_max(float x) { x = fmaxf(x, dpp_<0xB1>(x)); x = fmaxf(x, dpp_<0x4E>(x)); x = fmaxf(x, dpp_<0x141>(x)); x = fmaxf(x, dpp_<0x128>(x)); return x; }
__device__ __forceinline__ float xrow_sum(float x) {
    auto s = __builtin_amdgcn_permlane16_swap(fbits(x), fbits(x), false, false); x = bitsf(s[0]) + bitsf(s[1]);
    auto t = __builtin_amdgcn_permlane32_swap(fbits(x), fbits(x), false, false); return bitsf(t[0]) + bitsf(t[1]); }
__device__ __forceinline__ float xrow_max(float x) {
    auto s = __builtin_amdgcn_permlane16_swap(fbits(x), fbits(x), false, false); x = fmaxf(bitsf(s[0]), bitsf(s[1]));
    auto t = __builtin_amdgcn_permlane32_swap(fbits(x), fbits(x), false, false); return fmaxf(bitsf(t[0]), bitsf(t[1])); }
#endif
__device__ __forceinline__ float wave_sum(float v) { return xrow_sum(row16_sum(v)); }
__device__ __forceinline__ float wave_max(float v) { return xrow_max(row16_max(v)); }
#ifdef EMU
__device__ __forceinline__ float wave_prefix_sum(float v, int lane) {
#pragma unroll
    for (int o = 1; o < 64; o <<= 1) { float t = __shfl_up(v, o); if (lane >= o) v += t; }
    return v;
}
__device__ __forceinline__ float wave_prefix_max(float v, int lane) {
#pragma unroll
    for (int o = 1; o < 64; o <<= 1) { float t = __shfl_up(v, o); if (lane >= o) v = fmaxf(v, t); }
    return v;
}
#else
template <int CTRL, int RM> __device__ __forceinline__ float dppo_(float old, float x) { return __builtin_bit_cast(float, __builtin_amdgcn_update_dpp(__builtin_bit_cast(int, old), __builtin_bit_cast(int, x), CTRL, RM, 0xf, false)); }
__device__ __forceinline__ float wave_prefix_sum(float v, int) {
    v += dppo_<0x111, 0xf>(0.f, v); v += dppo_<0x112, 0xf>(0.f, v); v += dppo_<0x114, 0xf>(0.f, v); v += dppo_<0x118, 0xf>(0.f, v);
    v += dppo_<0x142, 0xa>(0.f, v); v += dppo_<0x143, 0xc>(0.f, v); return v;
}
__device__ __forceinline__ float wave_prefix_max(float v, int) {
    const float ninf = -INFINITY;
    v = fmaxf(v, dppo_<0x111, 0xf>(ninf, v)); v = fmaxf(v, dppo_<0x112, 0xf>(ninf, v)); v = fmaxf(v, dppo_<0x114, 0xf>(ninf, v)); v = fmaxf(v, dppo_<0x118, 0xf>(ninf, v));
    v = fmaxf(v, dppo_<0x142, 0xa>(ninf, v)); v = fmaxf(v, dppo_<0x143, 0xc>(ninf, v)); return v;
}
#endif
__device__ __forceinline__ float wave_suffix_max(float v, int lane) {
    return __shfl(wave_prefix_max(__shfl(v, 63 - lane), lane), 63 - lane);
}
__device__ __forceinline__ void unpack8(u32x4 v, float* f) {
    f[0] = bitsf(v.x << 16); f[1] = bitsf(v.x & 0xffff0000u); f[2] = bitsf(v.y << 16); f[3] = bitsf(v.y & 0xffff0000u);
    f[4] = bitsf(v.z << 16); f[5] = bitsf(v.z & 0xffff0000u); f[6] = bitsf(v.w << 16); f[7] = bitsf(v.w & 0xffff0000u);
}
__device__ __forceinline__ int orig_col(int n) {
    if (n < 1280) return n;
    if (n < 2304) return 2320 + (n - 1280);
    if (n < 3072) return 3376 + (n - 2304);
    if (n < 3088) return 1280 + (n - 3072);
    if (n < 3120) return 3344 + (n - 3088);
    if (n < NMAIN) return -1;
    return 1296 + (n - NMAIN);
}
__device__ __forceinline__ int chain_cid(int dir, int o) {
    if (dir == 0) return o;
    return o < NCC ? (NCC - 1 - o) : (NCH - 1 - (o - NCC));
}

__device__ __forceinline__ int swz(int row, int ch) { return row * 64 + ((ch ^ (row & 7)) << 3); }
__device__ __forceinline__ u32x4 pack8(const float* f) { u32x4 o; o.x = pk2(f[0], f[1]); o.y = pk2(f[2], f[3]); o.z = pk2(f[4], f[5]); o.w = pk2(f[6], f[7]); return o; }
__device__ __forceinline__ bf16x8 as_frag(u32x4 v) { return __builtin_bit_cast(bf16x8, v); }
#ifdef EMU
inline u32x2 lds_tr16(const bf16* p) { unsigned mine[2]; const unsigned long long a = (unsigned long long)p; mine[0] = (unsigned)a; mine[1] = (unsigned)(a >> 32);
    auto buf = emu::collective(mine, 2); const int l = emu::cur()->lane, g = l >> 4, i = l & 15; unsigned short e[4];
    for (int j = 0; j < 4; ++j) { const int src = 16 * g + 4 * j + (i >> 2); const bf16* q = (const bf16*)(((unsigned long long)buf[src][1] << 32) | buf[src][0]); e[j] = *(const unsigned short*)(q + (i & 3)); }
    u32x2 r; r.x = (unsigned)e[0] | ((unsigned)e[1] << 16); r.y = (unsigned)e[2] | ((unsigned)e[3] << 16); return r; }
#else
typedef short v4i16_t __attribute__((ext_vector_type(4)));
__device__ __forceinline__ u32x2 lds_tr16(const bf16* p) { return __builtin_bit_cast(u32x2, __builtin_amdgcn_ds_read_tr16_b64_v4i16((__attribute__((address_space(3))) v4i16_t*)p)); }
#endif
__device__ __forceinline__ u32x4 as_u4(bf16x8 v) { return __builtin_bit_cast(u32x4, v); }

constexpr int LS = 72;

template <int NTL, int KS>
__device__ __forceinline__ void mma_nt(const bf16* A, int lda, int m0, const bf16* B, int ldb, int n0, f32x4 (&acc)[NTL], int lane) {
    const int r = lane & 15, q = lane >> 4;
#pragma unroll
    for (int ks = 0; ks < KS; ++ks) {
        const bf16x8 a = *(const bf16x8*)(A + (m0 + r) * lda + ks * 32 + q * 8);
#pragma unroll
        for (int nt = 0; nt < NTL; ++nt) {
            const bf16x8 b = *(const bf16x8*)(B + (n0 + nt * 16 + r) * ldb + ks * 32 + q * 8);
            acc[nt] = MFMA16(a, b, acc[nt]);
        }
    }
}

__device__ __forceinline__ void layer_prep(const Params& p, int l, int idx, int stride, char* smem);
__device__ __forceinline__ void phase0(const Params& p, char* smem) {
    const int tid = otid();
    cpx* TW = (cpx*)(p.ws + WS_TW);
    cpx* ROPE = (cpx*)(p.ws + WS_ROPE);
    float* MOD = (float*)(p.ws + WS_MOD);
    constexpr int N_TW = NF / NT, N_ROPE = SEQ * 32 / NT, N_MOD = DEPTH * (3 * DM / 64);
    for (int task = obid(); task < N_TW + N_ROPE + N_MOD; task += gridDim.x) {
        if (task < N_TW) {
            const int j = task * NT + tid; float s, c; sincospif(2.0f * (float)j / (float)NF, &s, &c);
            cpx v; v.x = c; v.y = -s; TW[j] = v;
        } else if (task < N_TW + N_ROPE) {
            const int idx = (task - N_TW) * NT + tid; const int pos = idx >> 5, i = idx & 31;
            const float inv = exp2f(-(float)(i & 15) * (13.287712379549449f / 16.0f));
            const float ang = (float)(i < 16 ? pos / 64 : pos % 64) * inv;
            cpx v; v.x = cosf(ang); v.y = sinf(ang); ROPE[idx] = v;
        } else {
            const int mt = task - N_TW - N_ROPE; const int l = mt / (3 * DM / 64), n0 = (mt % (3 * DM / 64)) * 64;
            float* sv = (float*)smem;
            float* red = sv + NJ * DM;
            __syncthreads();
            for (int i = tid; i < NJ * DM; i += NT) { const int j = i / DM, k = i % DM; const float v = j < NB ? p.in[I_C][j * DM + k] : p.in[I_CCTX][k]; sv[i] = siluf_(v); }
            __syncthreads();
            const int c4 = tid & 15, kg = tid >> 4; f32x4 acc[NJ];
#pragma unroll
            for (int j = 0; j < NJ; ++j) acc[j] = (f32x4){0.f, 0.f, 0.f, 0.f};
            const float* w = p.in[I_WADA] + (size_t)l * DM * 3 * DM + n0 + 4 * c4;
#pragma unroll 8
            for (int i = 0; i < DM / 32; ++i) { const int k = kg + 32 * i; const f32x4 wv = *(const f32x4*)(w + (size_t)k * 3 * DM);
#pragma unroll
                for (int j = 0; j < NJ; ++j) acc[j] = acc[j] + wv * sv[j * DM + k]; }
#pragma unroll
            for (int j = 0; j < NJ; ++j) *(f32x4*)(red + (kg * NJ + j) * 64 + 4 * c4) = acc[j];
            __syncthreads();
            for (int i = tid; i < NJ * 64; i += NT) { const int j = i / 64, n = i % 64; float s = 0.f;
#pragma unroll
                for (int k8 = 0; k8 < 32; ++k8) s += red[(k8 * NJ + j) * 64 + n];
                MOD[((size_t)l * NJ + j) * 3 * DM + n0 + n] = s + p.in[I_BADA][(size_t)l * 3 * DM + n0 + n]; }
        }
    }
}

#ifdef EMU
constexpr int PANEL_ROWS = 128, PANEL_UNITS = DM / 128;
#else
constexpr int PANEL_ROWS = 256, PANEL_UNITS = DM / 256;
#endif
__device__ __forceinline__ unsigned* unit_counter(const Params& p, int isctx) { return (unsigned*)(p.ws + WS_BAR + 16384) + 64 * isctx; }
__device__ __forceinline__ unsigned* stage_counter(const Params& p, int flag) { return (unsigned*)(p.ws + WS_BAR + 16384) + 512 + 512 * flag; }
__device__ __forceinline__ void stage_signal(const Params& p, char* smem, int flag, int l) {
#ifdef EMU
    __syncthreads(); if (otid() == 0) *stage_counter(p, flag) += 1u;
#else
    asm volatile("s_waitcnt vmcnt(0)" ::: "memory"); __syncthreads();
    if (threadIdx.x == 0) {
        const unsigned xcc = (unsigned)__builtin_amdgcn_s_getreg((3 << 11) | 20) & 0xFu, nloc = ((volatile __attribute__((address_space(3))) unsigned*)(smem + LDS_BYTES - 64))[0];
        unsigned* g = stage_counter(p, flag);
        if (nloc > 0u) { const unsigned old = __hip_atomic_fetch_add(g + 16 * (1 + xcc), 1u, __ATOMIC_RELAXED, __HIP_MEMORY_SCOPE_AGENT);
            if (old + 1u == nloc * (unsigned)(l + 1)) { __builtin_amdgcn_fence(__ATOMIC_RELEASE, "agent"); asm volatile("s_waitcnt vmcnt(0)" ::: "memory");
                __hip_atomic_fetch_add(g, nloc, __ATOMIC_RELAXED, __HIP_MEMORY_SCOPE_AGENT); } }
        else { __builtin_amdgcn_fence(__ATOMIC_RELEASE, "agent"); asm volatile("s_waitcnt vmcnt(0)" ::: "memory"); __hip_atomic_fetch_add(g, 1u, __ATOMIC_RELAXED, __HIP_MEMORY_SCOPE_AGENT); }
    }
#endif
}
__device__ __forceinline__ void stage_wait(const Params& p, int flag, int l) {
    if (otid() == 0) { const unsigned target = (unsigned)gridDim.x * (unsigned)(l + 1);
#ifdef EMU
        while (*(volatile unsigned*)stage_counter(p, flag) < target) emu::yield();
#else
        unsigned spins = 0;
        while (__hip_atomic_load(stage_counter(p, flag), __ATOMIC_RELAXED, __HIP_MEMORY_SCOPE_AGENT) < target) { __builtin_amdgcn_s_sleep(16); if (++spins > (1u << 20)) break; }
        __builtin_amdgcn_fence(__ATOMIC_ACQUIRE, "agent"); asm volatile("s_waitcnt vmcnt(0)" ::: "memory");
#endif
    }
    __syncthreads();
}
__device__ __forceinline__ int logical_row(int i) { return i < NB * SEQ ? (i / SEQ) * TOK + CTXL + i % SEQ : ((i - NB * SEQ) / CTXL) * TOK + (i - NB * SEQ) % CTXL; }
struct RowRef { const float* xo; float* xn; int mj, row; bool ok; };
__device__ __forceinline__ RowRef rp_ref(const Params& p, int l, int li, int base, int hi) {
    RowRef r; r.ok = li < hi; const int rr = logical_row(r.ok ? li : base); r.row = rr;
    const int b = rr / TOK, pp = rr % TOK; const bool isctx = pp < CTXL; if (l == DEPTH && isctx) r.ok = false;
    const size_t off = isctx ? ((size_t)b * CTXL + pp) * DM : ((size_t)b * SEQ + (pp - CTXL)) * DM;
    float* CTXB = (float*)(p.ws + WS_CTXB);
    r.xo = (l <= 1) ? (isctx ? p.in[I_CTX] + off : p.in[I_X] + off) : (isctx ? CTXB + off : p.out + off);
    r.xn = isctx ? CTXB + off : p.out + off; r.mj = isctx ? NB : b; return r;
}
__device__ __forceinline__ void rp_rows(const Params& p, int l, int lo, int hi, int gi, int nb) {
    const int tid = otid(), lane = tid & 63, wave = tid >> 6;
    const float* MOD = (const float*)(p.ws + WS_MOD);
    const bf16* YO = (const bf16*)(p.ws + WS_P);
    bf16* HN = (bf16*)(p.ws + WS_HNY);
    constexpr int NV4 = DM / 256, RW = 2;
    const int stride = nb * 8;
    f32x4 xq[RW][NV4]; u32x2 yq[RW][NV4]; RowRef rq[RW];
    int base = lo + gi * 8 + wave;
    if (base < hi) {
#pragma unroll
        for (int i = 0; i < RW; ++i) { rq[i] = rp_ref(p, l, base + i * stride, base, hi);
#pragma unroll
            for (int j = 0; j < NV4; ++j) { xq[i][j] = *(const f32x4*)(rq[i].xo + 4 * lane + 256 * j); yq[i][j] = (l > 0) ? *(const u32x2*)(YO + (size_t)rq[i].row * DM + 4 * lane + 256 * j) : (u32x2){0u, 0u}; } }
    }
    for (; base < hi; base += stride * RW) {
        f32x4 x[RW][NV4], y[RW][NV4]; RowRef rc[RW];
#pragma unroll
        for (int i = 0; i < RW; ++i) { rc[i] = rq[i];
#pragma unroll
            for (int j = 0; j < NV4; ++j) { x[i][j] = xq[i][j]; const u32x2 yy = yq[i][j]; y[i][j] = (f32x4){bitsf(yy.x << 16), bitsf(yy.x & 0xffff0000u), bitsf(yy.y << 16), bitsf(yy.y & 0xffff0000u)}; } }
        { const int nbase = base + stride * RW;
            if (nbase < hi) {
#pragma unroll
                for (int i = 0; i < RW; ++i) { rq[i] = rp_ref(p, l, nbase + i * stride, nbase, hi);
#pragma unroll
                    for (int j = 0; j < NV4; ++j) { xq[i][j] = *(const f32x4*)(rq[i].xo + 4 * lane + 256 * j); if (l > 0) yq[i][j] = *(const u32x2*)(YO + (size_t)rq[i].row * DM + 4 * lane + 256 * j); } } } }
        if (l > 0) {
            float ss[RW];
#pragma unroll
            for (int i = 0; i < RW; ++i) { ss[i] = 0.f;
#pragma unroll
                for (int j = 0; j < NV4; ++j) ss[i] += y[i][j].x * y[i][j].x + y[i][j].y * y[i][j].y + y[i][j].z * y[i][j].z + y[i][j].w * y[i][j].w; }
#pragma unroll
            for (int i = 0; i < RW; ++i) ss[i] = wave_sum(ss[i]);
            const float* gp = p.in[I_GPOST] + (size_t)(l - 1) * DM;
#pragma unroll
            for (int i = 0; i < RW; ++i) { const float rstd = rsqrtf(ss[i] * (1.0f / DM) + EPS); const float* gt = MOD + ((size_t)(l - 1) * NJ + rc[i].mj) * 3 * DM + 2 * DM;
#pragma unroll
                for (int j = 0; j < NV4; ++j) { const f32x4 g4 = *(const f32x4*)(gt + 4 * lane + 256 * j), p4 = *(const f32x4*)(gp + 4 * lane + 256 * j);
                    x[i][j] = x[i][j] + g4 * (y[i][j] * rstd * p4);
                    if (rc[i].ok) *(f32x4*)(rc[i].xn + 4 * lane + 256 * j) = x[i][j]; } }
        }
        if (l < DEPTH) {
            float ss[RW];
#pragma unroll
            for (int i = 0; i < RW; ++i) { ss[i] = 0.f;
#pragma unroll
                for (int j = 0; j < NV4; ++j) ss[i] += x[i][j].x * x[i][j].x + x[i][j].y * x[i][j].y + x[i][j].z * x[i][j].z + x[i][j].w * x[i][j].w; }
#pragma unroll
            for (int i = 0; i < RW; ++i) ss[i] = wave_sum(ss[i]);
            const float* gp = p.in[I_GPRE] + (size_t)l * DM;
#pragma unroll
            for (int i = 0; i < RW; ++i) { const float rstd = rsqrtf(ss[i] * (1.0f / DM) + EPS); const float* md = MOD + ((size_t)l * NJ + rc[i].mj) * 3 * DM; const int row = rc[i].row;
#pragma unroll
                for (int j = 0; j < NV4; ++j) { const int e = 4 * lane + 256 * j;
                    const f32x4 g4 = *(const f32x4*)(gp + e), sh = *(const f32x4*)(md + e), sc = *(const f32x4*)(md + DM + e);
                    const f32x4 h = (x[i][j] * rstd * g4) * (sc + 1.0f) + sh;
                    u32x2 o; o.x = pk2(h.x, h.y); o.y = pk2(h.z, h.w);
                    if (rc[i].ok) *(u32x2*)(HN + (size_t)row * DM + e) = o; } }
        }
    }
}

__device__ __forceinline__ void convert_tile(const float* src, int ldn, bf16* dst, int K, int n0, int k0, bool use_map, char* smem) {
    const int tid = otid();
    float* tile = (float*)smem;
    __syncthreads();
#pragma unroll
    for (int i = 0; i < 8; ++i) { const int idx = tid + NT * i, k = idx >> 6, n = idx & 63;
        const int oc = use_map ? orig_col(n0 + n) : (n0 + n);
        tile[k * 65 + n] = oc >= 0 ? src[(size_t)(k0 + k) * ldn + oc] : 0.f; }
    __syncthreads();
    const int n = tid >> 3, c = tid & 7;
    u32x4 o; o.x = pk2(tile[(8 * c + 0) * 65 + n], tile[(8 * c + 1) * 65 + n]); o.y = pk2(tile[(8 * c + 2) * 65 + n], tile[(8 * c + 3) * 65 + n]);
    o.z = pk2(tile[(8 * c + 4) * 65 + n], tile[(8 * c + 5) * 65 + n]); o.w = pk2(tile[(8 * c + 6) * 65 + n], tile[(8 * c + 7) * 65 + n]);
    *(u32x4*)(dst + (size_t)(n0 + n) * K + k0 + 8 * c) = o;
}

__device__ __forceinline__ void filter_task(const Params& p, int l, int L, int pos0, char* smem) {
    const int tid = otid(), j = tid & 63;
    float* z = (float*)smem;
    float* h1 = z + 8 * 33;
    float* h2 = h1 + 8 * 64;
    const float* w1 = p.in[I_HW1] + (size_t)l * 33 * 64; const float* w2 = p.in[I_HW2] + (size_t)l * 64 * 64; const float* w3 = p.in[I_HW3] + (size_t)l * 64 * 512;
    float r1[33], r2[64], r3a[16];
#pragma unroll
    for (int i = 0; i < 33; ++i) r1[i] = w1[i * 64 + j];
#pragma unroll
    for (int i = 0; i < 64; ++i) r2[i] = w2[i * 64 + j];
    const float b1 = p.in[I_HB1][l * 64 + j], b2 = p.in[I_HB2][l * 64 + j], b3 = p.in[I_HB3][l * 512 + tid];
    const float f0 = p.in[I_HFREQ][(l * 2 + 0) * 64 + j], f1 = p.in[I_HFREQ][(l * 2 + 1) * 64 + j];
    __syncthreads();
    if (tid < 8 * 33) { const int pp = tid / 33, i = tid % 33; const float pos = (float)(pos0 + pp);
        const float t = pos / (float)(L - 1 > 1 ? L - 1 : 1), wv = 6.283185307179586f * pos / (float)L; float v;
        if (i == 0) v = t; else { const int bi = (i - 1) & 15; const float f = 1e-4f + (float)bi * ((15.0f - 1e-4f) / 15.0f); v = (i <= 16) ? cosf(wv * f) : -sinf(wv * f); }
        z[tid] = v; }
    __syncthreads();
    { const int pp = tid >> 6; float a = b1;
#pragma unroll
        for (int i = 0; i < 33; ++i) a += z[pp * 33 + i] * r1[i];
        h1[tid] = sinf(f0 * a);
#pragma unroll
        for (int i = 0; i < 16; ++i) r3a[i] = w3[i * 512 + tid]; }
    __syncthreads();
    { const int pp = tid >> 6; float a = b2;
#pragma unroll
        for (int i = 0; i < 64; ++i) a += h1[pp * 64 + i] * r2[i];
        h2[tid] = sinf(f1 * a); }
    __syncthreads();
    { const int o = tid, dir = o >> 8, c = o & 255;
        const float delta = 3.0701134573253946f + (float)c * ((15.350567286626973f - 3.0701134573253946f) / 255.0f);
        float acc[8];
#pragma unroll
        for (int pp = 0; pp < 8; ++pp) acc[pp] = b3;
#pragma unroll 1
        for (int cix = 0; cix < 4; ++cix) {
            float wn[16];
#pragma unroll
            for (int i = 0; i < 16; ++i) wn[i] = (cix < 3) ? w3[(16 * (cix + 1) + i) * 512 + o] : 0.f;
#pragma unroll
            for (int i = 0; i < 16; ++i) {
#pragma unroll
                for (int pp = 0; pp < 8; ++pp) acc[pp] += h2[pp * 64 + 16 * cix + i] * r3a[i]; }
#pragma unroll
            for (int i = 0; i < 16; ++i) r3a[i] = wn[i]; }
        float* KT = (float*)(p.ws + WS_KT); float* HC = (float*)(p.ws + WS_HC);
#pragma unroll
        for (int pp = 0; pp < 8; ++pp) { const int pos = pos0 + pp; const float t = (float)pos / (float)(L - 1 > 1 ? L - 1 : 1);
            const float v = acc[pp] * __expf(-t * delta);
            if (L == SEQ) { if (dir == 0) KT[(size_t)c * NF + pos]= v; else if (pos > 0) KT[(size_t)c * NF + (NF - pos)] = v; else KT[(size_t)c * NF + SEQ] = 0.f; }
            else HC[((size_t)dir * WG + c) * CTXL + pos] = v; }
    }
}

__device__ __forceinline__ void convert_tile_w(const float* src, int ldn, bf16* dst, int K, int n0, int k0, bool use_map, char* wl, int lane) {
    float* tile = (float*)wl;
    const int oc = use_map ? orig_col(n0 + lane) : (n0 + lane);
    float v[64];
#pragma unroll
    for (int k = 0; k < 64; ++k) v[k] = oc >= 0 ? src[(size_t)(k0 + k) * ldn + oc] : 0.f;
#pragma unroll
    for (int k = 0; k < 64; ++k) tile[k * 65 + lane] = v[k];
    WAVE_SYNC();
#pragma unroll
    for (int i = 0; i < 8; ++i) { const int n = (lane >> 3) + 8 * i, c = lane & 7; float f[8];
#pragma unroll
        for (int j = 0; j < 8; ++j) f[j] = tile[(8 * c + j) * 65 + n];
        *(u32x4*)(dst + (size_t)(n0 + n) * K + k0 + 8 * c) = pack8(f); }
    WAVE_SYNC();
}
__device__ __forceinline__ void layer_prep(const Params& p, int l, int idx, int stride, char* smem) {
    constexpr int N_WIN = (NPAD / 64) * (DM / 64), N_FL = SEQ / 8, N_FC = CTXL / 8;
    for (int task = idx; task < N_FL + N_FC; task += stride) {
        if (task < N_FL) filter_task(p, l, SEQ, task * 8, smem);
        else filter_task(p, l, CTXL, (task - N_FL) * 8, smem);
    }
    __syncthreads();
    { const int tid = otid(), lane = tid & 63, wave = __builtin_amdgcn_readfirstlane(tid >> 6);
        char* wl = smem + wave * WLDS;
        for (int task = wave * stride + idx; task < N_WIN; task += 8 * stride) { const int nt = task / (DM / 64), kt = task % (DM / 64);
            convert_tile_w(p.in[I_WIN] + (size_t)l * DM * N_IN, N_IN, (bf16*)(p.ws + WS_WIN), DM, nt * 64, kt * 64, true, wl, lane); } }
}
__device__ __forceinline__ unsigned* row_queue(const Params& p, int l) { return (unsigned*)(p.ws + WS_BAR + 16384) + 2560 + 64 * l; }
__device__ __forceinline__ void wait_units(const Params& p, int c, int l) {
    constexpr int nLatU = NB * (SEQ / PANEL_ROWS) * PANEL_UNITS, nCtxU = NB * (CTXL / PANEL_ROWS) * PANEL_UNITS;
    const unsigned target = (unsigned)((c ? nCtxU : nLatU) * l);
#ifdef EMU
    while (*(volatile unsigned*)unit_counter(p, c) < target) emu::yield();
#else
    unsigned spins = 0;
    while (__hip_atomic_load(unit_counter(p, c), __ATOMIC_RELAXED, __HIP_MEMORY_SCOPE_AGENT) < target) { __builtin_amdgcn_s_sleep(16); if (++spins > (1u << 20)) break; }
    __builtin_amdgcn_fence(__ATOMIC_ACQUIRE, "agent"); asm volatile("s_waitcnt vmcnt(0)" ::: "memory");
#endif
}
__device__ __forceinline__ void phase_rp(const Params& p, int l, char* smem) { const int G = (int)gridDim.x, bid = obid(), tid = otid();
    const bool has_ctx = l < DEPTH;
    constexpr int nLatU = NB * (SEQ / PANEL_ROWS) * PANEL_UNITS, nCtxU = NB * (CTXL / PANEL_ROWS) * PANEL_UNITS;
    const int nU = nLatU + nCtxU;
    const int heavy = (l >= 1 && has_ctx && nU > G && (nU % G) != 0) ? nU % G : 0;
    const int total = heavy > 0 ? NB * SEQ : (has_ctx ? T : NB * SEQ);
    const int nl = G - heavy, np = (l < DEPTH) ? nl / 2 : 0, nr = nl - np;
    int lo, hi, gi, nb; bool prep = false;
    if (bid < heavy) { lo = NB * SEQ; hi = T; gi = bid; nb = heavy; }
    else { const int i = bid - heavy; int nR = total;
        if (np > 0) { nR = ((total * 2 / 3) / (nr * 16)) * (nr * 16); if (nR <= 0) nR = total / 2; }
        if (np > 0 && (i & 1) && i / 2 < np) { prep = true; lo = nR; hi = total; gi = i / 2; nb = np; }
        else { lo = 0; hi = nR; gi = (np > 0) ? (i + 1) / 2 : i; nb = nr; } }
    if (prep) layer_prep(p, l, gi, np, smem);
    else if (l < DEPTH && np == 0) layer_prep(p, l, bid, G, smem);
    if (l >= 1) { if (tid == 0) { if (lo < NB * SEQ) wait_units(p, 0, l); if (hi > NB * SEQ) wait_units(p, 1, l); } __syncthreads(); }
    rp_rows(p, l, lo, hi, gi, nb);
}

__device__ __forceinline__ cpx cmul(cpx a, cpx b) { cpx r; r.x = a.x * b.x - a.y * b.y; r.y = a.x * b.y + a.y * b.x; return r; }
__device__ __forceinline__ cpx cmulc(cpx a, cpx b) { cpx r; r.x = a.x * b.x + a.y * b.y; r.y = a.y * b.x - a.x * b.y; return r; }
constexpr int fpad(int i) { return i + (i >> 4); }
__device__ __forceinline__ int FPH(int i) { return i + (i >> 4); }
constexpr int FBUF = fpad(NF);
constexpr int ilog16(int n) { return n < 16 ? 0 : 1 + ilog16(n / 16); }
constexpr int FFT_P16 = ilog16(NF);
constexpr bool FFT_R4 = ((NF >> (4 * FFT_P16)) == 4);
static_assert((NF >> (4 * FFT_P16)) == 1 || (NF >> (4 * FFT_P16)) == 4, "NF = 16^a * (1 or 4)");
template <bool INV> __device__ __forceinline__ void dft4(cpx& a0, cpx& a1, cpx& a2, cpx& a3) {
    const cpx s = {a0.x + a2.x, a0.y + a2.y}, b = {a0.x - a2.x, a0.y - a2.y}, c = {a1.x + a3.x, a1.y + a3.y}, d = {a1.x - a3.x, a1.y - a3.y};
    a0 = (cpx){s.x + c.x, s.y + c.y}; a2 = (cpx){s.x - c.x, s.y - c.y};
    if (!INV) { a1 = (cpx){b.x + d.y, b.y - d.x}; a3 = (cpx){b.x - d.y, b.y + d.x}; }
    else      { a1 = (cpx){b.x - d.y, b.y + d.x}; a3 = (cpx){b.x + d.y, b.y - d.x}; }
}
template <bool INV> __device__ __forceinline__ cpx cmulk(cpx a, float wr, float wi) {
    cpx r; if (!INV) { r.x = a.x * wr + a.y * wi; r.y = a.y * wr - a.x * wi; } else { r.x = a.x * wr - a.y * wi; r.y = a.y * wr + a.x * wi; } return r;
}
template <bool INV> __device__ __forceinline__ void dft16(cpx (&x)[16]) {
    constexpr float C1 = 0.92387953251128674f, S1 = 0.38268343236508977f, C2 = 0.70710678118654752f;
#pragma unroll
    for (int n2 = 0; n2 < 4; ++n2) dft4<INV>(x[n2], x[4 + n2], x[8 + n2], x[12 + n2]);
    x[4 * 1 + 1] = cmulk<INV>(x[4 * 1 + 1], C1, S1); x[4 * 1 + 2] = cmulk<INV>(x[4 * 1 + 2], C2, C2); x[4 * 1 + 3] = cmulk<INV>(x[4 * 1 + 3], S1, C1);
    x[4 * 2 + 1] = cmulk<INV>(x[4 * 2 + 1], C2, C2); x[4 * 2 + 2] = cmulk<INV>(x[4 * 2 + 2], 0.f, 1.f); x[4 * 2 + 3] = cmulk<INV>(x[4 * 2 + 3], -C2, C2);
    x[4 * 3 + 1] = cmulk<INV>(x[4 * 3 + 1], S1, C1); x[4 * 3 + 2] = cmulk<INV>(x[4 * 3 + 2], -C2, C2); x[4 * 3 + 3] = cmulk<INV>(x[4 * 3 + 3], -C1, -S1);
#pragma unroll
    for (int k1 = 0; k1 < 4; ++k1) dft4<INV>(x[4 * k1 + 0], x[4 * k1 + 1], x[4 * k1 + 2], x[4 * k1 + 3]);
    cpx t;
    t = x[1]; x[1] = x[4]; x[4] = t; t = x[2]; x[2] = x[8]; x[8] = t; t = x[3]; x[3] = x[12]; x[12] = t;
    t = x[6]; x[6] = x[9]; x[9] = t; t = x[7]; x[7] = x[13]; x[13] = t; t = x[11]; x[11] = x[14]; x[14] = t;
}
template <bool INV> __device__ __forceinline__ void fft_stage16(cpx* buf, const cpx* TW, int tl, int M) {
    const int span = M >> 4, twm = NF / M;
#pragma unroll 1
    for (int j = tl; j < NF / 16; j += 256) {
        const int grp = j / span, pos = j % span, base = grp * M + pos; cpx x[16];
#pragma unroll
        for (int q = 0; q < 16; ++q) x[q] = buf[FPH(base + q * span)];
        cpx w1 = {1.f, 0.f}; if (span > 1) w1 = TW[pos * twm];
        if (INV && span > 1) { cpx wk = w1;
#pragma unroll
            for (int k = 1; k < 16; ++k) { x[k] = cmulc(x[k], wk); wk = cmul(wk, w1); } }
        dft16<INV>(x);
        if (!INV && span > 1) { cpx wk = w1;
#pragma unroll
            for (int k = 1; k < 16; ++k) { x[k] = cmul(x[k], wk); wk = cmul(wk, w1); } }
#pragma unroll
        for (int q = 0; q < 16; ++q) buf[FPH(base + q * span)] = x[q];
    }
}
template <bool INV> __device__ __forceinline__ void fft_stage4_last(cpx* buf, int tl) {
#pragma unroll 1
    for (int j = tl; j < NF / 4; j += 256) { cpx a0 = buf[FPH(4 * j)], a1 = buf[FPH(4 * j + 1)], a2 = buf[FPH(4 * j + 2)], a3 = buf[FPH(4 * j + 3)];
        dft4<INV>(a0, a1, a2, a3); buf[FPH(4 * j)] = a0; buf[FPH(4 * j + 1)] = a1; buf[FPH(4 * j + 2)] = a2; buf[FPH(4 * j + 3)] = a3; }
}
__device__ __forceinline__ void fft_fwd(cpx* buf, const cpx* TW, int tl) {
    int M = NF;
#pragma unroll
    for (int s = 0; s < FFT_P16; ++s) { __syncthreads(); fft_stage16<false>(buf, TW, tl, M); M >>= 4; }
    if (FFT_R4) { __syncthreads(); fft_stage4_last<false>(buf, tl); }
    __syncthreads();
}
__device__ __forceinline__ void fft_inv(cpx* buf, const cpx* TW, int tl) {
    if (FFT_R4) { __syncthreads(); fft_stage4_last<true>(buf, tl); }
    int M = FFT_R4 ? 64 : 16;
#pragma unroll
    for (int s = 0; s < FFT_P16; ++s) { __syncthreads(); fft_stage16<true>(buf, TW, tl, M); M <<= 4; }
    __syncthreads();
}
__device__ __forceinline__ void filt_fft_task(const Params& p, int cp, char* smem) {
    const int tid = otid(), half = tid >> 8, tl = tid & 255, c = 2 * cp + half;
    cpx* buf = (cpx*)smem + (size_t)half * FBUF;
    const float* KT = (const float*)(p.ws + WS_KT) + (size_t)c * NF;
    cpx* KF = (cpx*)(p.ws + WS_KF) + (size_t)c * NF;
    const cpx* TW = (const cpx*)(p.ws + WS_TW);
    __syncthreads();
    for (int i = tl; i < NF; i += 256) { cpx v; v.x = KT[i]; v.y = 0.f; buf[FPH(i)] = v; }
    fft_fwd(buf, TW, tl);
    for (int i = tl; i < NF; i += 256) KF[i] = buf[FPH(i)];
}

__device__ __forceinline__ void gemm_tile(const Params& p, const bf16* A, const bf16* Bt, int K, int mt, int nt, int mode, char* smem) {
    const int tid = otid(), lane = tid & 63, wave = tid >> 6;
    bf16* As = (bf16*)smem;
    bf16* Bs = As + 128 * LS;
    const int wm = (wave & 3) * 32, wn = (wave >> 2) * 64;
    f32x4 acc[2][4];
#pragma unroll
    for (int i = 0; i < 2; ++i)
#pragma unroll
        for (int j = 0; j < 4; ++j) acc[i][j] = (f32x4){0.f, 0.f, 0.f, 0.f};
    const int lr = tid >> 3, lc = tid & 7;
    const bf16* Ag = A + (size_t)(mt * 128 + lr) * K + lc * 8;
    const bf16* Bg = Bt + (size_t)(nt * 128 + lr) * K + lc * 8;
    u32x4 ra0, ra1, rb0, rb1;
    ra0 = *(const u32x4*)(Ag); ra1 = *(const u32x4*)(Ag + (size_t)64 * K); rb0 = *(const u32x4*)(Bg); rb1 = *(const u32x4*)(Bg + (size_t)64 * K);
    const int nk = K / 64;
    for (int kt = 0; kt < nk; ++kt) {
        __syncthreads();
        *(u32x4*)(As + lr * LS + lc * 8) = ra0; *(u32x4*)(As + (lr + 64) * LS + lc * 8) = ra1;
        *(u32x4*)(Bs + lr * LS + lc * 8) = rb0; *(u32x4*)(Bs + (lr + 64) * LS + lc * 8) = rb1;
        __syncthreads();
        if (kt + 1 < nk) { const int ko = (kt + 1) * 64;
            ra0 = *(const u32x4*)(Ag + ko); ra1 = *(const u32x4*)(Ag + (size_t)64 * K + ko); rb0 = *(const u32x4*)(Bg + ko); rb1 = *(const u32x4*)(Bg + (size_t)64 * K + ko); }
        mma_nt<4, 2>(As, LS, wm, Bs, LS, wn, acc[0], lane);
        mma_nt<4, 2>(As, LS, wm + 16, Bs, LS, wn, acc[1], lane);
    }
    const int r = lane & 15, q = lane >> 4;
#pragma unroll
    for (int i = 0; i < 2; ++i)
#pragma unroll
        for (int j = 0; j < 4; ++j)
#pragma unroll
            for (int e = 0; e < 4; ++e) {
                const int row = mt * 128 + wm + 16 * i + 4 * q + e, col = nt * 128 + wn + 16 * j + r; const float v = acc[i][j][e];
                if (mode == 0) { if (col < NP) ((bf16*)(p.ws + WS_P))[(size_t)row * NP + col] = f2bf(v); else if (col < NP + 16) ((float*)(p.ws + WS_G))[(size_t)row * NGS + (col - NP)] = v; else if (col < NP + NG) ((bf16*)((float*)(p.ws + WS_G) + (size_t)row * NGS + 16))[col - NP - 16] = f2bf(v); }
                else if (mode == 2) ((bf16*)(p.ws + WS_HT))[(size_t)row * T + col] = f2bf(v);
                else ((bf16*)(p.ws + WS_P))[(size_t)row * DM + col] = f2bf(v);
            }
}

#ifndef EMU
namespace pg8 {
#define PG8_LAS __attribute__((address_space(3)))
typedef unsigned short bf16_t;
typedef short bf16x8 __attribute__((ext_vector_type(8)));
typedef float f32x4 __attribute__((ext_vector_type(4)));
typedef unsigned u32x4 __attribute__((ext_vector_type(4)));
constexpr int BM = 256, BK = 64, HALF = 128, HTB = HALF * BK * 2  , STAGE_BYTES = 8 * HTB, NXCD = 8, WGM = 8;

__host__ __device__ __forceinline__ int lds_byte(int r, int c) { const int st = (r >> 4) * 2 + (c >> 5), rr = r & 15, cc = c & 31, ob = rr * 64 + cc * 2; return st * 1024 + (ob ^ (((ob >> 9) & 1) << 5)); }
__host__ __device__ __forceinline__ void stage_rc(int b, int& R, int& C) { const int st = b / 1024, sb = b % 1024, swz = sb ^ (((sb >> 9) & 1) << 5); R = (st >> 1) * 16 + swz / 64; C = (st & 1) * 32 + (swz % 64) / 2; }
__host__ __device__ __forceinline__ int perm32(int rho) { const int n = rho >> 4, i = rho & 15; return 8 * (i >> 2) + 4 * n + (i & 3); }

struct Unit { int pm, pn; };
struct Gemm { const bf16_t* A; const bf16_t* Bt; int M, N, K; };
__device__ __forceinline__ unsigned cvt_pk_bf16(float lo, float hi) { unsigned r; asm volatile("v_cvt_pk_bf16_f32 %0, %1, %2" : "=v"(r) : "v"(lo), "v"(hi)); return r; }
template <class Epi, class Sched, bool ALIGN_EPI = false, bool SP2 = false>
__device__ __forceinline__ void gemm_phase(PG8_LAS unsigned char* lds, const Gemm g, const Sched& S, const Epi& E) {
    const int tid = otid(), wid = __builtin_amdgcn_readfirstlane(tid >> 6), lane = tid & 63, wr = wid >> 2, wc = wid & 3, fr = lane & 15, fq = lane >> 4;
    const int K = g.K, nt = K / BK;
    unsigned voffA[2], voffB[2];
#pragma unroll
    for (int i = 0; i < 2; ++i) { int R, C; stage_rc(tid * 16 + i * 8192, R, C); const int Rb = Epi::PERM ? ((R & ~31) + perm32(R & 31)) : R;
        voffA[i] = (unsigned)(R * K + C) * 2u; voffB[i] = (unsigned)(Rb * K + C) * 2u; }
    const size_t kstep = (size_t)(BK * 2);
    const size_t hstep = (size_t)HALF * K * 2;
    const size_t tstep = 2 * hstep;
    const unsigned ldsw = (unsigned)wid * 1024u;
    const int aoff = lds_byte(wr * 64 + fr, fq * 8), boff = lds_byte(wc * 32 + fr, fq * 8);
#define PG8_SA(b, h) (((b) * 2 + (h)) * HTB)
#define PG8_SB(b, h) ((4 + (b) * 2 + (h)) * HTB)
#define PG8_STAGE(bufoff, gbase, voff) do { _Pragma("unroll") for (int _i = 0; _i < 2; ++_i) \
        __builtin_amdgcn_global_load_lds((const unsigned*)((const char*)(gbase) + (voff)[_i]), (PG8_LAS unsigned*)(lds + (bufoff) + ldsw + _i * 8192), 16, 0, 0); } while (0)
#define PG8_LDA(dst, b, h) do { _Pragma("unroll") for (int m = 0; m < 4; ++m) _Pragma("unroll") for (int k = 0; k < 2; ++k) dst[m][k] = *(const PG8_LAS bf16x8*)(lds + PG8_SA(b, h) + aoff + m * 2048 + k * 1024); } while (0)
#define PG8_LDB(dst, b, h) do { _Pragma("unroll") for (int n = 0; n < 2; ++n) _Pragma("unroll") for (int k = 0; k < 2; ++k) dst[n][k] = *(const PG8_LAS bf16x8*)(lds + PG8_SB(b, h) + boff + n * 2048 + k * 1024); } while (0)
#define PG8_MMA(ai, bj, At, Bt) do { __builtin_amdgcn_s_setprio(1); _Pragma("unroll") for (int m = 0; m < 4; ++m) _Pragma("unroll") for (int n = 0; n < 2; ++n) _Pragma("unroll") for (int k = 0; k < 2; ++k) \
        acc[ai][bj][m][n] = __builtin_amdgcn_mfma_f32_16x16x32_bf16(Bt[n][k], At[m][k], acc[ai][bj][m][n], 0, 0, 0); __builtin_amdgcn_s_setprio(0); } while (0)
#define PG8_WAIT_V(n) asm volatile("s_waitcnt vmcnt(" #n ")" ::: "memory")
#define PG8_WAIT_L(n) asm volatile("s_waitcnt lgkmcnt(" #n ")" ::: "memory")
#define PG8_BAR __builtin_amdgcn_s_barrier()
#define PG8_SCHED __builtin_amdgcn_sched_barrier(0)
    Unit cur, nxt; int ui = 0;
    if (!S.next(0, cur)) return;
    f32x4 acc[2][2][4][2];
#pragma unroll
    for (int a = 0; a < 2; ++a)
#pragma unroll
        for (int b = 0; b < 2; ++b)
#pragma unroll
            for (int m = 0; m < 4; ++m)
#pragma unroll
                for (int n = 0; n < 2; ++n) acc[a][b][m][n] = (f32x4){0.f, 0.f, 0.f, 0.f};
    bf16x8 At[4][2], B0[2][2], B1[2][2];
    const char* cA = (const char*)g.A + (size_t)cur.pm * tstep; const char* cB = (const char*)g.Bt + (size_t)cur.pn * tstep;
    S.a_ready(cur);
    if constexpr (SP2) {
        PG8_STAGE(PG8_SB(0, 0), cB, voffB); PG8_STAGE(PG8_SB(0, 1), cB + hstep, voffB); PG8_STAGE(PG8_SA(0, 0), cA, voffA); PG8_STAGE(PG8_SA(0, 1), cA + hstep, voffA);
        if (wr == 1) PG8_BAR;
        PG8_WAIT_V(2); PG8_BAR;
        PG8_STAGE(PG8_SB(1, 0), cB + kstep, voffB); PG8_STAGE(PG8_SA(1, 0), cA + kstep, voffA); PG8_STAGE(PG8_SB(1, 1), cB + hstep + kstep, voffB);
        PG8_WAIT_V(6); PG8_BAR;
    } else {
        PG8_STAGE(PG8_SB(0, 0), cB, voffB); PG8_STAGE(PG8_SA(0, 0), cA, voffA); PG8_STAGE(PG8_SB(0, 1), cB + hstep, voffB); PG8_STAGE(PG8_SA(0, 1), cA + hstep, voffA);
        if (wr == 1) PG8_BAR;
        PG8_WAIT_V(4); PG8_BAR;
        PG8_STAGE(PG8_SB(1, 0), cB + kstep, voffB); PG8_STAGE(PG8_SA(1, 0), cA + kstep, voffA); PG8_STAGE(PG8_SB(1, 1), cB + hstep + kstep, voffB);
        PG8_WAIT_V(6); PG8_BAR;
    }
    for (;;) {
        const bool has_next = S.next(ui + 1, nxt);
        const char* nA = has_next ? (const char*)g.A + (size_t)nxt.pm * tstep : cA; const char* nB = has_next ? (const char*)g.Bt + (size_t)nxt.pn * tstep : cB;
        for (int t = 0; t < nt; t += 2) {
            const bool last = (t == nt - 2);
            const char* a1 = cA + (size_t)(t + 1) * kstep;
            const char* a2 = last ? nA : cA + (size_t)(t + 2) * kstep; const char* b2 = last ? nB : cB + (size_t)(t + 2) * kstep;
            const char* a3 = a2 + kstep; const char* b3 = b2 + kstep;
            if (last && has_next) S.a_ready(nxt);
            if constexpr (SP2) {
            PG8_LDB(B0, 0, 0); PG8_LDB(B1, 0, 1); PG8_SCHED; PG8_LDA(At, 0, 0); PG8_STAGE(PG8_SA(1, 1), a1 + hstep, voffA);
            PG8_WAIT_V(8); PG8_WAIT_L(0); PG8_BAR; PG8_MMA(0, 0, At, B0); PG8_MMA(0, 1, At, B1); PG8_BAR; PG8_SCHED;
            PG8_LDA(At, 0, 1); PG8_STAGE(PG8_SB(0, 0), b2, voffB); PG8_STAGE(PG8_SB(0, 1), b2 + hstep, voffB); PG8_STAGE(PG8_SA(0, 0), a2, voffA);
            PG8_WAIT_V(8); PG8_WAIT_L(0); PG8_BAR; PG8_MMA(1, 0, At, B0); PG8_MMA(1, 1, At, B1); PG8_BAR; PG8_SCHED;
            PG8_LDB(B0, 1, 0); PG8_LDB(B1, 1, 1); PG8_SCHED; PG8_LDA(At, 1, 0); PG8_STAGE(PG8_SA(0, 1), a2 + hstep, voffA);
            PG8_WAIT_V(8); PG8_WAIT_L(0); PG8_BAR; PG8_MMA(0, 0, At, B0); PG8_MMA(0, 1, At, B1); PG8_BAR; PG8_SCHED;
            PG8_LDA(At, 1, 1); PG8_STAGE(PG8_SB(1, 0), b3, voffB); PG8_STAGE(PG8_SB(1, 1), b3 + hstep, voffB); PG8_STAGE(PG8_SA(1, 0), a3, voffA);
            PG8_WAIT_V(8); PG8_WAIT_L(0); PG8_BAR; PG8_MMA(1, 0, At, B0); PG8_MMA(1, 1, At, B1); PG8_BAR; PG8_SCHED;
            } else {
            PG8_LDB(B0, 0, 0); PG8_SCHED; PG8_LDA(At, 0, 0); PG8_STAGE(PG8_SA(1, 1), a1 + hstep, voffA);
            PG8_WAIT_L(8); PG8_BAR; PG8_WAIT_L(0); PG8_MMA(0, 0, At, B0); PG8_BAR; PG8_SCHED;
            PG8_LDB(B1, 0, 1); PG8_STAGE(PG8_SB(0, 0), b2, voffB);
            PG8_BAR; PG8_WAIT_L(0); PG8_MMA(0, 1, At, B1); PG8_BAR;
            PG8_LDA(At, 0, 1); PG8_STAGE(PG8_SA(0, 0), a2, voffA);
            PG8_BAR; PG8_WAIT_L(0); PG8_MMA(1, 0, At, B0); PG8_BAR; PG8_SCHED;
            PG8_STAGE(PG8_SB(0, 1), b2 + hstep, voffB);
            PG8_WAIT_V(6); PG8_BAR; PG8_MMA(1, 1, At, B1); PG8_BAR;
            PG8_LDB(B0, 1, 0); PG8_SCHED; PG8_LDA(At, 1, 0); PG8_STAGE(PG8_SA(0, 1), a2 + hstep, voffA);
            PG8_WAIT_L(8); PG8_BAR; PG8_WAIT_L(0); PG8_MMA(0, 0, At, B0); PG8_BAR; PG8_SCHED;
            PG8_LDB(B1, 1, 1); PG8_STAGE(PG8_SB(1, 0), b3, voffB);
            PG8_BAR; PG8_WAIT_L(0); PG8_MMA(0, 1, At, B1); PG8_BAR;
            PG8_LDA(At, 1, 1); PG8_STAGE(PG8_SA(1, 0), a3, voffA);
            PG8_BAR; PG8_WAIT_L(0); PG8_MMA(1, 0, At, B0); PG8_BAR; PG8_SCHED;
            PG8_STAGE(PG8_SB(1, 1), b3 + hstep, voffB);
            PG8_WAIT_V(6); PG8_BAR; PG8_MMA(1, 1, At, B1); PG8_BAR;
            }
        }
        if constexpr (ALIGN_EPI) { if (wr == 0) PG8_BAR; }
        if constexpr (!Epi::AFTER_DRAIN) { E(acc, cur, wr, wc, fr, fq); S.done(cur); }
        if (!has_next) break;
#pragma unroll
        for (int a = 0; a < 2; ++a)
#pragma unroll
            for (int b = 0; b < 2; ++b)
#pragma unroll
                for (int m = 0; m < 4; ++m)
#pragma unroll
                    for (int n = 0; n < 2; ++n) acc[a][b][m][n] = (f32x4){0.f, 0.f, 0.f, 0.f};
        cur = nxt; cA = nA; cB = nB; ++ui;
        if constexpr (ALIGN_EPI) { if (wr == 1) PG8_BAR; }
    }
    PG8_WAIT_V(0);
    if constexpr (!ALIGN_EPI) { if (wr == 0) PG8_BAR; }
    PG8_BAR;
    if constexpr (Epi::AFTER_DRAIN) { E.fused(acc, cur, wr, wc, fr, fq, lds, wid, lane); S.done(cur); }
#undef PG8_SA
#undef PG8_SB
#undef PG8_STAGE
#undef PG8_LDA
#undef PG8_LDB
#undef PG8_MMA
#undef PG8_WAIT_V
#undef PG8_WAIT_L
#undef PG8_BAR
#undef PG8_SCHED
}
__device__ __forceinline__ void map_tile(int L, int nM, int nN, int& pm, int& pn) {
    const int nwg = nM * nN; int wgid = L; { const int q = nwg / NXCD, r = nwg % NXCD, xcd = wgid % NXCD, off = wgid / NXCD; wgid = (xcd < r ? xcd * (q + 1) : r * (q + 1) + (xcd - r) * q) + off; }
    const int nig = WGM * nN, gid = wgid / nig, fm = gid * WGM, gsz = (nM - fm) < WGM ? (nM - fm) : WGM;
    pm = fm + ((wgid % nig) % gsz); pn = (wgid % nig) / gsz;
}
constexpr int MP = T / 256, WP = NMAIN / 256, NU2 = 4 * MP, NU1 = MP * WP;
struct InOrder { int G, c;
    __device__ __forceinline__ bool next(int i, Unit& u) const { const int L = i * G + c; if (L >= NU2 + NU1) return false; int a, b;
        if (L < NU2) { map_tile(L, 4, MP, a, b); u.pm = MP + WP + a; u.pn = b; } else { map_tile(L - NU2, MP, WP, a, b); u.pm = a; u.pn = MP + b; } return true; }
    __device__ __forceinline__ void a_ready(const Unit&) const {}
    __device__ __forceinline__ void done(const Unit&) const {}
};
struct EpiIn { static constexpr bool PERM = true, AFTER_DRAIN = false; bf16_t* P; float* G; bf16_t* HTp;
    __device__ __forceinline__ void operator()(const f32x4 (&acc)[2][2][4][2], const Unit& u, int wr, int wc, int fr, int fq) const {
        if (u.pm < MP) { const int pn = u.pn - MP, row0 = u.pm * BM + wr * 64 + fr;
            if (pn < NP / 256) { const int col0 = pn * BM + wc * 32 + 8 * fq;
#pragma unroll
                for (int ai = 0; ai < 2; ++ai)
#pragma unroll
                    for (int m = 0; m < 4; ++m) { bf16_t* rowp = P + (size_t)(row0 + ai * HALF + m * 16) * NP + col0;
#pragma unroll
                        for (int bj = 0; bj < 2; ++bj) { const f32x4 v0 = acc[ai][bj][m][0], v1 = acc[ai][bj][m][1];
                            u32x4 w; w.x = cvt_pk_bf16(v0[0], v0[1]); w.y = cvt_pk_bf16(v0[2], v0[3]); w.z = cvt_pk_bf16(v1[0], v1[1]); w.w = cvt_pk_bf16(v1[2], v1[3]); *(u32x4*)(rowp + bj * HALF) = w; } } }
            else { const int cb = wc * 32 + 8 * fq;
                if (cb < NG) {
#pragma unroll
                    for (int ai = 0; ai < 2; ++ai)
#pragma unroll
                        for (int m = 0; m < 4; ++m) { float* rowb = G + (size_t)(row0 + ai * HALF + m * 16) * NGS; const f32x4 v0 = acc[ai][0][m][0], v1 = acc[ai][0][m][1];
                            if (cb < 16) { *(f32x4*)(rowb + cb) = v0; *(f32x4*)(rowb + cb + 4) = v1; }
                            else { u32x4 w; w.x = cvt_pk_bf16(v0[0], v0[1]); w.y = cvt_pk_bf16(v0[2], v0[3]); w.z = cvt_pk_bf16(v1[0], v1[1]); w.w = cvt_pk_bf16(v1[2], v1[3]); *(u32x4*)((bf16_t*)(rowb + 16) + (cb - 16)) = w; } } } } }
        else { const int row0 = (u.pm - MP - WP) * BM + wr * 64 + fr, col0 = u.pn * BM + wc * 32 + 8 * fq;
#pragma unroll
            for (int ai = 0; ai < 2; ++ai)
#pragma unroll
                for (int m = 0; m < 4; ++m) { bf16_t* rowp = HTp + (size_t)(row0 + ai * HALF + m * 16) * T + col0;
#pragma unroll
                    for (int bj = 0; bj < 2; ++bj) { const f32x4 v0 = acc[ai][bj][m][0], v1 = acc[ai][bj][m][1];
                        u32x4 w; w.x = cvt_pk_bf16(v0[0], v0[1]); w.y = cvt_pk_bf16(v0[2], v0[3]); w.z = cvt_pk_bf16(v1[0], v1[1]); w.w = cvt_pk_bf16(v1[2], v1[3]); *(u32x4*)(rowp + bj * HALF) = w; } } }
    }
};
struct OutOrder { int G, c; bool lat_only; unsigned* cnt;
    __device__ __forceinline__ bool next(int i, Unit& u) const { constexpr int nN = DM / 256, nLat = NB * (SEQ / 256) * nN, nCtx = NB * (CTXL / 256) * nN; const int L = i * G + c; int a, b;
        if (L < nLat) { map_tile(L, nLat / nN, nN, a, b); u.pm = (a / (SEQ / 256)) * (TOK / 256) + CTXL / 256 + a % (SEQ / 256); }
        else { if (lat_only || L >= nLat + nCtx) return false; map_tile(L - nLat, nCtx / nN, nN, a, b); u.pm = (a / (CTXL / 256)) * (TOK / 256) + a % (CTXL / 256); }
        u.pn = b; return true; }
    __device__ __forceinline__ void a_ready(const Unit&) const {}
    unsigned* xu; unsigned nloc, xtarget;
    __device__ __forceinline__ void done(const Unit& u) const {
        asm volatile("s_waitcnt vmcnt(0)" ::: "memory"); __builtin_amdgcn_s_barrier();
        if (threadIdx.x == 0) { const bool isctx = (u.pm % (TOK / 256)) < CTXL / 256;
            if (!isctx && xtarget != 0u) {
                const unsigned old = __hip_atomic_fetch_add(xu, 1u, __ATOMIC_RELAXED, __HIP_MEMORY_SCOPE_AGENT);
                if (old + 1u == xtarget) { __builtin_amdgcn_fence(__ATOMIC_RELEASE, "agent"); asm volatile("s_waitcnt vmcnt(0)" ::: "memory");
                    __hip_atomic_fetch_add(cnt, nloc, __ATOMIC_RELAXED, __HIP_MEMORY_SCOPE_AGENT); } }
            else { __builtin_amdgcn_fence(__ATOMIC_RELEASE, "agent"); asm volatile("s_waitcnt vmcnt(0)" ::: "memory");
                __hip_atomic_fetch_add(cnt + (isctx ? 64 : 0), 1u, __ATOMIC_RELAXED, __HIP_MEMORY_SCOPE_AGENT); } } }
};
struct EpiOut { static constexpr bool PERM = true, AFTER_DRAIN = false; bf16_t* C;
    __device__ __forceinline__ void operator()(const f32x4 (&acc)[2][2][4][2], const Unit& u, int wr, int wc, int fr, int fq) const {
        const int row0 = u.pm * BM + wr * 64 + fr, col0 = u.pn * BM + wc * 32 + 8 * fq;
#pragma unroll
        for (int ai = 0; ai < 2; ++ai)
#pragma unroll
            for (int m = 0; m < 4; ++m) { bf16_t* rowp = C + (size_t)(row0 + ai * HALF + m * 16) * DM + col0;
#pragma unroll
                for (int bj = 0; bj < 2; ++bj) { const f32x4 v0 = acc[ai][bj][m][0], v1 = acc[ai][bj][m][1];
                    u32x4 w; w.x = cvt_pk_bf16(v0[0], v0[1]); w.y = cvt_pk_bf16(v0[2], v0[3]); w.z = cvt_pk_bf16(v1[0], v1[1]); w.w = cvt_pk_bf16(v1[2], v1[3]); *(u32x4*)(rowp + bj * HALF) = w; } }
    }
};
}
#endif

__device__ __forceinline__ void phase_gemm_in(const Params& p, int l, char* smem) {
    constexpr int N_F = WG / 2;
#ifdef EMU
    constexpr int MT = T / 128, NT1 = NMAIN / 128, N1 = MT * NT1, N2 = 8 * MT;
    for (int task = obid(); task < N1 + N2; task += gridDim.x) {
        if (task < N1) gemm_tile(p, (const bf16*)(p.ws + WS_HNY), (const bf16*)(p.ws + WS_WIN), DM, task / NT1, task % NT1, 0, smem);
        else { const int t2 = task - N1; gemm_tile(p, (const bf16*)(p.ws + WS_WIN) + (size_t)NMAIN * DM, (const bf16*)(p.ws + WS_HNY), DM, t2 / MT, t2 % MT, 2, smem); }
    }
#else
    { const pg8::Gemm g{(const pg8::bf16_t*)(p.ws + WS_HNY), (const pg8::bf16_t*)(p.ws + WS_HNY), 0, 0, DM};
      const pg8::InOrder S{(int)gridDim.x, obid()};
      const pg8::EpiIn E{(pg8::bf16_t*)(p.ws + WS_P), (float*)(p.ws + WS_G), (pg8::bf16_t*)(p.ws + WS_HT)};
      pg8::gemm_phase<pg8::EpiIn, pg8::InOrder, true, true>((PG8_LAS unsigned char*)smem, g, S, E); }
#endif
    { const int G = (int)gridDim.x, bid = obid();
#ifdef EMU
      const int extra = 0;
#else
      const int extra = (pg8::NU1 + pg8::NU2) % G;
#endif
      if (extra > 0 && extra < G) { if (bid >= extra) for (int task = bid - extra; task < N_F; task += G - extra) filt_fft_task(p, task, smem); }
      else for (int task = G - 1 - bid; task < N_F; task += G) filt_fft_task(p, task, smem); }
}
__device__ __forceinline__ void phase_gemm_out(const Params& p, int l, char* smem) {
    const int G = (int)gridDim.x, bid = obid(); const bool has_ctx = l < DEPTH - 1;
#ifdef EMU
    constexpr int MT = T / 128, NTO = DM / 128;
    for (int task = bid; task < MT * NTO; task += G) {
        const int mt = task / NTO, nt = task % NTO;
        if (!has_ctx && (mt % (TOK / 128)) < CTXL / 128) continue;
        gemm_tile(p, (const bf16*)(p.ws + WS_HNY), (const bf16*)(p.ws + WS_WOUT), MIX, mt, nt, 1, smem);
        __syncthreads(); if (otid() == 0) *unit_counter(p, (mt % (TOK / 128)) < CTXL / 128 ? 1 : 0) += 1u;
    }
#else
    const pg8::Gemm g{(const pg8::bf16_t*)(p.ws + WS_HNY), (const pg8::bf16_t*)(p.ws + WS_WOUT), 0, 0, MIX};
    const unsigned xcc = (unsigned)__builtin_amdgcn_s_getreg((3 << 11) | 20) & 0xFu, nloc = ((volatile PG8_LAS unsigned*)(smem + LDS_BYTES - 64))[0];
    const bool agg = (NB * (SEQ / 256) * (DM / 256) == G) && nloc > 0u;
    const pg8::OutOrder S{G, bid, !has_ctx, unit_counter(p, 0), unit_counter(p, 2) + 16 * xcc, nloc, agg ? nloc * (unsigned)(l + 1) : 0u};
    const pg8::EpiOut E{(pg8::bf16_t*)(p.ws + WS_P)};
    pg8::gemm_phase<pg8::EpiOut, pg8::OutOrder, true, true>((PG8_LAS unsigned char*)smem, g, S, E);
#endif
}

__device__ __forceinline__ size_t st_index(int mixer, int dir, int b, int h, int cid) { return ((((size_t)(mixer * 2 + dir) * NB + b) * NH + h) * NCH + cid); }
__device__ __forceinline__ size_t ch_index(int dir, int b, int h, int cid) { return (((size_t)dir * NB + b) * NH + h) * NCH + cid; }

__device__ __forceinline__ void load_tile_nat(const bf16* P, int r0, int c0, bf16* dst, float scale, int tid) {
    const int s = tid >> 3, c8 = tid & 7;
    const u32x4 v = *(const u32x4*)(P + (size_t)(r0 + s) * NP + c0 + c8 * 8);
    if (scale == 1.0f) *(u32x4*)(dst + s * LS + c8 * 8) = v;
    else { float f[8]; unpack8(v, f); u32x4 o; o.x = pk2(f[0] * scale, f[1] * scale); o.y = pk2(f[2] * scale, f[3] * scale); o.z = pk2(f[4] * scale, f[5] * scale); o.w = pk2(f[6] * scale, f[7] * scale);
        *(u32x4*)(dst + s * LS + c8 * 8) = o; }
}
__device__ __forceinline__ void load_tile_tr(const bf16* P, int r0, int c0, bf16* dst, int tid) {
    const int s = tid >> 3, c8 = tid & 7;
    const u32x4 v = *(const u32x4*)(P + (size_t)(r0 + s) * NP + c0 + c8 * 8);
    const unsigned w[4] = {v.x, v.y, v.z, v.w};
#pragma unroll
    for (int j = 0; j < 4; ++j) { dst[(c8 * 8 + 2 * j) * LS + s] = (bf16)(w[j] & 0xffffu); dst[(c8 * 8 + 2 * j + 1) * LS + s] = (bf16)(w[j] >> 16); }
}

template <int NTK>
__device__ __forceinline__ void load_span(const bf16* row, int t0, float (&v)[NTK + 2]) {
    { const bool hl = t0 > 0, hr = t0 + NTK < SEQ; const bf16 xl = row[hl ? -1 : 0], xr = row[hr ? NTK : 0];
        v[0] = hl ? bf2f(xl) : 0.f; v[NTK + 1] = hr ? bf2f(xr) : 0.f; }
    if constexpr (NTK == 8) { float f[8]; unpack8(*(const u32x4*)row, f);
#pragma unroll
        for (int i = 0; i < 8; ++i) v[1 + i] = f[i]; }
    else {
#pragma unroll
        for (int i = 0; i < NTK; ++i) v[1 + i] = bf2f(row[i]); }
}
template <int NTK>
__device__ __forceinline__ void hy_inputs(const bf16* h0, const bf16* h1, const float* cw, const float* cb, int c, int t0, float (&u0)[NTK], float (&u1)[NTK], float (&g0)[NTK], float (&g1)[NTK]) {
    { float xa[NTK + 2], xb[NTK + 2]; load_span<NTK>(h0 + (size_t)512 * T, t0, xa); load_span<NTK>(h1 + (size_t)512 * T, t0, xb);
        const float w0 = cw[0 * 768 + 512 + c], w1 = cw[1 * 768 + 512 + c], w2 = cw[2 * 768 + 512 + c], bb = cb[512 + c];
        float ga[NTK + 2], gb[NTK + 2]; load_span<NTK>(h0 + (size_t)768 * T, t0, ga); load_span<NTK>(h1 + (size_t)768 * T, t0, gb);
#pragma unroll
        for (int i = 0; i < NTK; ++i) { g0[i] = (w0 * xa[i] + w1 * xa[i + 1] + w2 * xa[i + 2] + bb) * siluf_(ga[i + 1]); g1[i] = (w0 * xb[i] + w1 * xb[i + 1] + w2 * xb[i + 2] + bb) * siluf_(gb[i + 1]); } }
    { float va[NTK + 2], vb[NTK + 2], ya[NTK + 2], yb[NTK + 2];
        load_span<NTK>(h0, t0, va); load_span<NTK>(h1, t0, vb); load_span<NTK>(h0 + (size_t)256 * T, t0, ya); load_span<NTK>(h1 + (size_t)256 * T, t0, yb);
        const float v0 = cw[0 * 768 + c], v1 = cw[1 * 768 + c], v2 = cw[2 * 768 + c], vbias = cb[c];
        const float y0 = cw[0 * 768 + 256 + c], y1 = cw[1 * 768 + 256 + c], y2 = cw[2 * 768 + 256 + c], ybias = cb[256 + c];
#pragma unroll
        for (int i = 0; i < NTK; ++i) { u0[i] = (v0 * va[i] + v1 * va[i + 1] + v2 * va[i + 2] + vbias) * (y0 * ya[i] + y1 * ya[i + 1] + y2 * ya[i + 2] + ybias);
            u1[i] = (v0 * vb[i] + v1 * vb[i + 1] + v2 * vb[i + 2] + vbias) * (y0 * yb[i] + y1 * yb[i + 1] + y2 * yb[i + 2] + ybias); } }
}
__device__ __forceinline__ void hylat_task(const Params& p, int l, int bp, int cp, char* smem) {
    const int tid = otid(), half = tid >> 8, tl = tid & 255, c = 2 * cp + half;
    const bf16* HT = (const bf16*)(p.ws + WS_HT); bf16* Y = (bf16*)(p.ws + WS_HNY);
    cpx* buf = (cpx*)smem + (size_t)half * FBUF;
    const cpx* TW = (const cpx*)(p.ws + WS_TW);
    const cpx* KF = (const cpx*)(p.ws + WS_KF) + (size_t)c * NF;
    constexpr int NTK = SEQ / 256;
    const int t0 = NTK * tl;
    const float* cw = p.in[I_HCW] + (size_t)l * 3 * 768; const float* cb = p.in[I_HCB] + (size_t)l * 768;
    const size_t rb0 = (size_t)(2 * bp) * TOK + CTXL, rb1 = rb0 + TOK;
    const bf16* h0 = HT + (size_t)c * T + rb0 + t0; const bf16* h1 = h0 + TOK;
    { float u0[NTK], u1[NTK], g0[NTK], g1[NTK]; hy_inputs<NTK>(h0, h1, cw, cb, c, t0, u0, u1, g0, g1);
        __syncthreads();
#pragma unroll
        for (int i = 0; i < NTK; ++i) { cpx v; v.x = u0[i]; v.y = u1[i]; buf[FPH(t0 + i)] = v; cpx z = {0.f, 0.f}; buf[FPH(SEQ + t0 + i)] = z; } }
    fft_fwd(buf, TW, tl);
#pragma unroll 2
    for (int i = tl; i < NF; i += 256) buf[FPH(i)] = cmul(buf[FPH(i)], KF[i]);
    fft_inv(buf, TW, tl);
    const float dsk = p.in[I_HD][(size_t)l * WG + c]; const float sc = 1.0f / (float)NF;
    { const int tz = otid() & 255; const int t0z = NTK * tz;
        float u0[NTK], u1[NTK], g0[NTK], g1[NTK]; hy_inputs<NTK>(HT + (size_t)c * T + rb0 + t0z, HT + (size_t)c * T + rb0 + t0z + TOK, cw, cb, c, t0z, u0, u1, g0, g1);
        float o0[NTK], o1[NTK];
#pragma unroll
        for (int i = 0; i < NTK; ++i) { const cpx y = buf[FPH(t0z + i)]; o0[i] = g0[i] * (y.x * sc + u0[i] * dsk); o1[i] = g1[i] * (y.y * sc + u1[i] * dsk); }
        bf16* d0 = (bf16*)(p.ws + WS_HT) + (size_t)(768 + c) * T + rb0 + t0z; bf16* d1 = d0 + TOK;
        if constexpr (NTK == 8) { *(u32x4*)d0 = pack8(o0); *(u32x4*)d1 = pack8(o1); }
        else {
#pragma unroll
            for (int i = 0; i < NTK; ++i) { d0[i] = f2bf(o0[i]); d1[i] = f2bf(o1[i]); } } }
}

constexpr int HCB = 16;
__device__ __forceinline__ void hyctx_task(const Params& p, int l, int b, int cblk, char* smem) {
    const int tid = otid(); const int c0 = cblk * HCB;
    const bf16* HT = (const bf16*)(p.ws + WS_HT); bf16* Y = (bf16*)(p.ws + WS_HNY); const float* HC = (const float*)(p.ws + WS_HC);
    float* raw = (float*)smem;
    float* u = raw + 4 * CTXL * HCB;
    float* og = u + CTXL * HCB;
    float* hcm = og + CTXL * HCB;
    bf16* ob = (bf16*)raw;
    const size_t rb = (size_t)b * TOK;
    const float* cw = p.in[I_HCW] + (size_t)l * 3 * 768; const float* cbias = p.in[I_HCB] + (size_t)l * 768;
    constexpr int WT = CTXL / 32;
    __syncthreads();
    for (int i = tid; i < 4 * HCB * (CTXL / 8); i += NT) { const int k = i / (HCB * (CTXL / 8)), cc = (i / (CTXL / 8)) % HCB, ck = i % (CTXL / 8);
        float f[8]; unpack8(*(const u32x4*)(HT + (size_t)(k * 256 + c0 + cc) * T + rb + ck * 8), f);
#pragma unroll
        for (int j = 0; j < 8; ++j) raw[(k * CTXL + ck * 8 + j) * HCB + cc] = f[j]; }
    for (int i = tid; i < 2 * HCB * (CTXL / 4); i += NT) { const int dir = i / (HCB * (CTXL / 4)), cc = (i / (CTXL / 4)) % HCB, pk = i % (CTXL / 4);
        const f32x4 v = *(const f32x4*)(HC + ((size_t)dir * WG + c0 + cc) * CTXL + pk * 4); const float f[4] = {v.x, v.y, v.z, v.w};
#pragma unroll
        for (int j = 0; j < 4; ++j) { const int pos = pk * 4 + j; if (dir == 0) hcm[(CTXL + pos) * HCB + cc] = f[j]; else if (pos > 0) hcm[(CTXL - pos) * HCB + cc] = f[j]; } }
    if (tid < HCB) hcm[tid] = 0.f;
    __syncthreads();
    for (int i = tid; i < CTXL * HCB; i += NT) { const int t = i / HCB, cc = i % HCB; float cv[3];
#pragma unroll
        for (int k = 0; k < 3; ++k) { const float* rk = raw + k * CTXL * HCB; const int ch = k * 256 + c0 + cc;
            const float a = t > 0 ? rk[(t - 1) * HCB + cc] : 0.f, m = rk[t * HCB + cc], z = t < CTXL - 1 ? rk[(t + 1) * HCB + cc] : 0.f;
            cv[k] = cw[0 * 768 + ch] * a + cw[1 * 768 + ch] * m + cw[2 * 768 + ch] * z + cbias[ch]; }
        u[i] = cv[0] * cv[1];
        og[i] = cv[2] * siluf_(raw[(3 * CTXL + t) * HCB + cc]); }
    __syncthreads();
    { const int cc = tid % HCB, tg = tid / HCB, t0 = WT * tg; float acc[WT], w[WT];
#pragma unroll
        for (int j = 0; j < WT; ++j) { acc[j] = 0.f; w[j] = hcm[(t0 + j + CTXL) * HCB + cc]; }
#pragma unroll 8
        for (int s = 0; s < CTXL; ++s) { const float us = u[s * HCB + cc];
#pragma unroll
            for (int j = 0; j < WT; ++j) acc[j] += us * w[j];
#pragma unroll
            for (int j = WT - 1; j > 0; --j) w[j] = w[j - 1];
            w[0] = hcm[(t0 - s - 1 + CTXL) * HCB + cc]; }
        const float dsk = p.in[I_HD][(size_t)l * WG + c0 + cc];
#pragma unroll
        for (int j = 0; j < WT; ++j) { const int t = t0 + j; ob[t * HCB + cc] = f2bf(og[t * HCB + cc] * (acc[j] + u[t * HCB + cc] * dsk)); } }
    __syncthreads();
    for (int i = tid; i < CTXL * 2; i += NT) { const int t = i >> 1, hh = i & 1; *(u32x4*)(Y + (rb + t) * 1024 + YH + c0 + 8 * hh) = *(const u32x4*)(ob + t * HCB + 8 * hh); }
}

__device__ __forceinline__ void attn_task(const Params& p, int l, int b, int kvh, int qt, bool ctxq, char* smem) {
    const int tid = otid(), lane = tid & 63, wave = tid >> 6, r = lane & 15, q = lane >> 4;
    constexpr float QSC = 0.125f * 1.4426950408889634f;
    const bf16* P = (const bf16*)(p.ws + WS_P); bf16* Y = (bf16*)(p.ws + WS_HNY); const cpx* ROPE = (const cpx*)(p.ws + WS_ROPE);
    bf16* Qs = (bf16*)smem;
    bf16* Ks = Qs + 256 * LS;
    constexpr int LSV = 80;
    bf16* Vt = Ks + 64 * LS;
    bf16* Ps = Vt + 64 * LS;
    const size_t rq0 = (size_t)b * TOK + (ctxq ? 0 : CTXL) + qt * 128;
    __syncthreads();
#pragma unroll
    for (int it = 0; it < 2; ++it) {
        const int idx = tid + NT * it, row = idx >> 2, cpair = idx & 3, g = row >> 7, t = row & 127;
        const bf16* src = P + (rq0 + t) * NP + PD + (kvh * 2 + g) * 64;
        float lo[8], hi[8]; unpack8(*(const u32x4*)(src + cpair * 8), lo); unpack8(*(const u32x4*)(src + 32 + cpair * 8), hi);
        float a[8], c2[8];
#pragma unroll
        for (int j = 0; j < 8; ++j) { float cs = 1.f, sn = 0.f; if (!ctxq) { const cpx cv = ROPE[(size_t)(qt * 128 + t) * 32 + cpair * 8 + j]; cs = cv.x; sn = cv.y; }
            a[j] = (lo[j] * cs - hi[j] * sn) * QSC; c2[j] = (hi[j] * cs + lo[j] * sn) * QSC; }
        *(u32x4*)(Qs + row * LS + cpair * 8) = pack8(a); *(u32x4*)(Qs + row * LS + 32 + cpair * 8) = pack8(c2);
    }
    const int lt0 = ctxq ? 0 : (2 * qt - 2 > 0 ? 2 * qt - 2 : 0), lt1 = ctxq ? -1 : (2 * qt + 3 < SEQ / 64 - 1 ? 2 * qt + 3 : SEQ / 64 - 1);
    const int nloc = lt1 - lt0 + 1, ntiles = nloc + NCC;
    float m[2], lsum[2]; f32x4 O[2][4];
#pragma unroll
    for (int ms = 0; ms < 2; ++ms) { m[ms] = -INFINITY; lsum[ms] = 0.f;
#pragma unroll
        for (int i = 0; i < 4; ++i) O[ms][i] = (f32x4){0.f, 0.f, 0.f, 0.f}; }
    const int g = wave >> 2, tq0 = (wave & 3) * 32;
    (void)Ps;
    __syncthreads();
    bf16x8 qf[2][2];
#pragma unroll
    for (int ms = 0; ms < 2; ++ms)
#pragma unroll
        for (int ks = 0; ks < 2; ++ks) qf[ms][ks] = *(const bf16x8*)(Qs + (g * 128 + tq0 + 16 * ms + r) * LS + ks * 32 + q * 8);
    u32x4 klo = {0u, 0u, 0u, 0u}, khi = klo, vq = klo; f32x4 rp[4] = {(f32x4){1.f, 0.f, 1.f, 0.f}, (f32x4){1.f, 0.f, 1.f, 0.f}, (f32x4){1.f, 0.f, 1.f, 0.f}, (f32x4){1.f, 0.f, 1.f, 0.f}};
    const int ks_ = tid >> 2, kcp = tid & 3, vs_ = tid >> 3, vc8 = tid & 7;
#define ATT_PREFETCH(TI) do { const bool loc_ = (TI) < nloc; const int kt_ = loc_ ? lt0 + (TI) : (TI) - nloc; const size_t rk_ = (size_t)b * TOK + (loc_ ? CTXL : 0) + kt_ * 64; \
        if (tid < 256) { const bf16* src_ = P + (rk_ + ks_) * NP + PD + 256 + kvh * 64; klo = *(const u32x4*)(src_ + kcp * 8); khi = *(const u32x4*)(src_ + 32 + kcp * 8); \
            if (loc_) { const f32x4* rr_ = (const f32x4*)(ROPE + (size_t)(kt_ * 64 + ks_) * 32 + kcp * 8); rp[0] = rr_[0]; rp[1] = rr_[1]; rp[2] = rr_[2]; rp[3] = rr_[3]; } \
            else { rp[0] = rp[1] = rp[2] = rp[3] = (f32x4){1.f, 0.f, 1.f, 0.f}; } } \
        vq = *(const u32x4*)(P + (rk_ + vs_) * NP + PD + 384 + kvh * 64 + vc8 * 8); } while (0)
    ATT_PREFETCH(0);
    for (int ti = 0; ti < ntiles; ++ti) {
        const bool local = ti < nloc; const int kt = local ? lt0 + ti : ti - nloc;
        __syncthreads();
        if (tid < 256) { float lo[8], hi[8]; unpack8(klo, lo); unpack8(khi, hi);
            const float cs[8] = {rp[0].x, rp[0].z, rp[1].x, rp[1].z, rp[2].x, rp[2].z, rp[3].x, rp[3].z}, sn[8] = {rp[0].y, rp[0].w, rp[1].y, rp[1].w, rp[2].y, rp[2].w, rp[3].y, rp[3].w};
            float a[8], c2[8];
#pragma unroll
            for (int j = 0; j < 8; ++j) { a[j] = lo[j] * cs[j] - hi[j] * sn[j]; c2[j] = hi[j] * cs[j] + lo[j] * sn[j]; }
            *(u32x4*)(Ks + ks_ * LS + kcp * 8) = pack8(a); *(u32x4*)(Ks + ks_ * LS + 32 + kcp * 8) = pack8(c2); }
        *(u32x4*)(Vt + vs_ * LSV + vc8 * 8) = vq;
        __syncthreads();
        if (ti + 1 < ntiles) ATT_PREFETCH(ti + 1);
        bf16x8 kfr[4][2], vfa[4], vfb[4];
#pragma unroll
        for (int nt = 0; nt < 4; ++nt)
#pragma unroll
            for (int ks = 0; ks < 2; ++ks) kfr[nt][ks] = *(const bf16x8*)(Ks + (16 * nt + r) * LS + ks * 32 + q * 8);
#pragma unroll
        for (int me = 0; me < 4; ++me) { const bf16* vr = Vt + (4 * q + (r >> 2)) * LSV + 16 * me + 4 * (r & 3);
            const u32x2 a0 = lds_tr16(vr), a1 = lds_tr16(vr + 16 * LSV), a2 = lds_tr16(vr + 32 * LSV), a3 = lds_tr16(vr + 48 * LSV);
            u32x4 va; va.x = a0.x; va.y = a0.y; va.z = a1.x; va.w = a1.y; u32x4 vb; vb.x = a2.x; vb.y = a2.y; vb.z = a3.x; vb.w = a3.y; vfa[me] = as_frag(va); vfb[me] = as_frag(vb); }
#pragma unroll
        for (int ms = 0; ms < 2; ++ms) {
            const int qlo = qt * 128 + tq0 + 16 * ms, klo_ = kt * 64;
            if (local && (klo_ > qlo + 15 + 128 || klo_ + 63 < qlo - 128)) continue;
            const bool domask = local && (klo_ + 63 - qlo > 128 || klo_ - (qlo + 15) < -128);
            f32x4 S[4] = {(f32x4){0.f, 0.f, 0.f, 0.f}, (f32x4){0.f, 0.f, 0.f, 0.f}, (f32x4){0.f, 0.f, 0.f, 0.f}, (f32x4){0.f, 0.f, 0.f, 0.f}};
#pragma unroll
            for (int ks = 0; ks < 2; ++ks)
#pragma unroll
                for (int nt = 0; nt < 4; ++nt) S[nt] = MFMA16(kfr[nt][ks], qf[ms][ks], S[nt]);
            const int qpos = qlo + r; float mx = -INFINITY;
            if (domask) {
#pragma unroll
                for (int nt = 0; nt < 4; ++nt)
#pragma unroll
                    for (int i = 0; i < 4; ++i) { const int d = kt * 64 + nt * 16 + 4 * q + i - qpos; if (d > 128 || d < -128) S[nt][i] = -INFINITY; } }
#pragma unroll
            for (int nt = 0; nt < 4; ++nt)
#pragma unroll
                for (int i = 0; i < 4; ++i) mx = fmaxf(mx, S[nt][i]);
            mx = xrow_max(mx);
            const float mn = fmaxf(m[ms], mx); const float msafe = mn == -INFINITY ? 0.f : mn; const float alpha = EXP2(m[ms] - msafe); float sm = 0.f;
#pragma unroll
            for (int nt = 0; nt < 4; ++nt)
#pragma unroll
                for (int i = 0; i < 4; ++i) { S[nt][i] = EXP2(S[nt][i] - msafe); sm += S[nt][i]; }
            sm = xrow_sum(sm);
            lsum[ms] = lsum[ms] * alpha + sm; m[ms] = mn;
            const float pa[8] = {S[0][0], S[0][1], S[0][2], S[0][3], S[1][0], S[1][1], S[1][2], S[1][3]}, pb[8] = {S[2][0], S[2][1], S[2][2], S[2][3], S[3][0], S[3][1], S[3][2], S[3][3]};
            const bf16x8 p0 = as_frag(pack8(pa)), p1 = as_frag(pack8(pb));
#pragma unroll
            for (int me = 0; me < 4; ++me) { O[ms][me] = O[ms][me] * alpha;
                O[ms][me] = MFMA16(vfa[me], p0, O[ms][me]); O[ms][me] = MFMA16(vfb[me], p1, O[ms][me]); }
        }
    }
#undef ATT_PREFETCH
    const float sink = p.in[I_SINK][(size_t)l * NH + kvh * 2 + g];
#pragma unroll
    for (int ms = 0; ms < 2; ++ms) { const float den = lsum[ms] + EXP2(sink * 1.4426950408889634f - m[ms]); const float inv = frcp_(den);
        const size_t row = rq0 + tq0 + 16 * ms + r; const int col = (kvh * 2 + g) * 64 + 4 * q;
#pragma unroll
        for (int me = 0; me < 4; ++me) { const u32x2 gg = *(const u32x2*)(P + row * NP + PD + 512 + col + 16 * me);
            const float g0 = bitsf(gg.x << 16), g1 = bitsf(gg.x & 0xffff0000u), g2 = bitsf(gg.y << 16), g3 = bitsf(gg.y & 0xffff0000u);
            u32x2 o; o.x = pk2(O[ms][me][0] * inv * siluf_(g0), O[ms][me][1] * inv * siluf_(g1)); o.y = pk2(O[ms][me][2] * inv * siluf_(g2), O[ms][me][3] * inv * siluf_(g3));
            *(u32x2*)(Y + row * 1024 + YD + col + 16 * me) = o; } }
}

#ifdef EMU
__device__ __forceinline__ int olane(int lane) { return lane; }
#else
__device__ __forceinline__ int olane(int lane) { asm volatile("" : "+v"(lane)); return lane; }
#endif
__device__ __forceinline__ void load_nat_tile(const bf16* P, int row0, int col0, bf16* tile, int lane) {
    u32x4 v[8];
#pragma unroll
    for (int i = 0; i < 8; ++i) v[i] = *(const u32x4*)(P + (size_t)(row0 + (lane >> 3) + 8 * i) * NP + col0 + (lane & 7) * 8);
#pragma unroll
    for (int i = 0; i < 8; ++i) *(u32x4*)(tile + swz((lane >> 3) + 8 * i, lane & 7)) = v[i];
}
__device__ __forceinline__ bf16x8 frag_tr(const bf16* tile, int c0, int k0, int lane) {
    const int c = c0 + (lane & 15), kb = k0 + 8 * (lane >> 4); unsigned w[4];
#pragma unroll
    for (int j = 0; j < 4; ++j) w[j] = (unsigned)tile[swz(kb + 2 * j, c >> 3) + (c & 7)] | ((unsigned)tile[swz(kb + 2 * j + 1, c >> 3) + (c & 7)] << 16);
    u32x4 o; o.x = w[0]; o.y = w[1]; o.z = w[2]; o.w = w[3]; return as_frag(o);
}
template <int DIR>
__device__ __forceinline__ void gla_r_frags(const float* Grow0, int lane, bf16x8 (&af)[4]) {
    const int r = lane & 15, q4 = lane >> 4;
#pragma unroll
    for (int mt = 0; mt < 4; ++mt) { u32x4 o = {0u, 0u, 0u, 0u};
        if (q4 < 2) o = *(const u32x4*)((const bf16*)(Grow0 + (size_t)(16 * mt + r) * NGS + 16) + DIR * 16 + 8 * q4);
        af[mt] = as_frag(o); }
}
template <int DIR>
__device__ __forceinline__ float gla_b_col(const Params& p, int l, int h, const bf16x8 (&af)[4], int nt, int lane_, float (&x)[4][4]) {
    const int lane = olane(lane_), r = lane & 15, q4 = lane >> 4, d = h * 64 + 16 * nt + r;
    u32x4 o = {0u, 0u, 0u, 0u};
    if (q4 < 2) { const float* wa = p.in[I_GWA] + ((size_t)(l * 2 + DIR) * 16 + 8 * q4) * WG + d;
        o.x = pk2(wa[0], wa[WG]); o.y = pk2(wa[2 * WG], wa[3 * WG]); o.z = pk2(wa[4 * WG], wa[5 * WG]); o.w = pk2(wa[6 * WG], wa[7 * WG]); }
    const bf16x8 bfr = as_frag(o); const float bias = p.in[I_GBA][(size_t)(l * 2 + DIR) * WG + d];
#pragma unroll
    for (int mt = 0; mt < 4; ++mt) { f32x4 c = {bias, bias, bias, bias}; c = MFMA16(af[mt], bfr, c);
#pragma unroll
        for (int i = 0; i < 4; ++i) x[mt][i] = logsig_fast(c[i]) * (1.0f / 16.0f); }
    float carry = 0.f;
#pragma unroll
    for (int k = 0; k < 4; ++k) { const int mt = DIR == 0 ? k : 3 - k; float* y = x[mt];
        if (DIR == 0) { y[1] += y[0]; y[2] += y[1]; y[3] += y[2]; } else { y[2] += y[3]; y[1] += y[2]; y[0] += y[1]; }
        const float s4 = DIR == 0 ? y[3] : y[0];
        const float t1 = DIR == 0 ? __shfl_up(s4, 16) : __shfl_down(s4, 16), t2 = DIR == 0 ? __shfl_up(s4, 32) : __shfl_down(s4, 32), t3 = DIR == 0 ? __shfl_up(s4, 48) : __shfl_down(s4, 48);
        const int qq = DIR == 0 ? q4 : 3 - q4;
        const float e = (qq >= 1 ? t1 : 0.f) + (qq >= 2 ? t2 : 0.f) + (qq >= 3 ? t3 : 0.f);
        const float tot = __shfl(e + s4, DIR == 0 ? r + 48 : r);
#pragma unroll
        for (int i = 0; i < 4; ++i) y[i] += carry + e;
        carry += tot; }
    return carry;
}

template <int MIXER, int DIR>
__device__ __forceinline__ void chunkst_dir(const Params& p, int l, int b, int h, int cid, const float* Grow0, const unsigned (&kk)[32], const bf16* Vt, bf16* Kt, const float* wvs, float* bendl, int lane_) {
    const int lane = olane(lane_), r = lane & 15, q4 = lane >> 4;
    if constexpr (MIXER == 0) {
        float nacc = 0.f;
#pragma unroll
        for (int c = 0; c < 8; ++c) { float f[8];
#pragma unroll
            for (int j = 0; j < 8; ++j) { const int s = 8 * c + j; const float kv = (s & 1) ? bitsf(kk[s >> 1] & 0xffff0000u) : bitsf(kk[s >> 1] << 16);
                f[j] = kv * 0.125f * wvs[DIR * 64 + s]; nacc += f[j]; }
            *(u32x4*)(Kt + swz(lane, c)) = pack8(f); }
        ((float*)(p.ws + WS_NV))[ch_index(DIR, b, h, cid) * 64 + lane] = nacc;
    } else {
        const bf16* P = (const bf16*)(p.ws + WS_P); const int kcol = PG + 256 + h * 64; const int r0 = b * TOK + cid * 64;
        bf16x8 af[4]; gla_r_frags<DIR>(Grow0, lane, af);
#pragma unroll 2
        for (int nt = 0; nt < 4; ++nt) { const int d = 16 * nt + r; float x[4][4];
            const float bend = gla_b_col<DIR>(p, l, h, af, nt, lane, x);
            if (q4 == 0) { ((float*)(p.ws + WS_BE))[ch_index(DIR, b, h, cid) * 64 + d] = bend; bendl[d] = __expf(fmaxf(bend, -80.0f)); }
#pragma unroll
            for (int mt = 0; mt < 4; ++mt)
#pragma unroll
                for (int i = 0; i < 4; ++i) { const int s = 16 * mt + 4 * q4 + i; const float kv = bf2f(P[(size_t)(r0 + s) * NP + kcol + d]); const float bc = fmaxf(x[mt][i], -80.0f);
                    Kt[swz(d, s >> 3) + (s & 7)] = f2bf(kv * __expf(-bc));
                    ((bf16*)(p.ws + WS_EQ))[((size_t)DIR * T + r0 + s) * WG + h * 64 + d] = f2bf(__expf(bc)); } }
    }
    WAVE_SYNC();
    bf16x8 vf[4][2];
#pragma unroll
    for (int ne = 0; ne < 4; ++ne)
#pragma unroll
        for (int ks = 0; ks < 2; ++ks) vf[ne][ks] = *(const bf16x8*)(Vt + swz(16 * ne + r, ks * 4 + q4));
    bf16* dst = (bf16*)(p.ws + WS_ST) + st_index(MIXER, DIR, b, h, cid) * 4096;
#pragma unroll
    for (int me = 0; me < 4; ++me) {
        f32x4 acc[4] = {(f32x4){0.f, 0.f, 0.f, 0.f}, (f32x4){0.f, 0.f, 0.f, 0.f}, (f32x4){0.f, 0.f, 0.f, 0.f}, (f32x4){0.f, 0.f, 0.f, 0.f}};
#pragma unroll
        for (int ks = 0; ks < 2; ++ks) { const bf16x8 a = *(const bf16x8*)(Kt + swz(16 * me + r, ks * 4 + q4));
#pragma unroll
            for (int ne = 0; ne < 4; ++ne) acc[ne] = MFMA16(a, vf[ne][ks], acc[ne]); }
        f32x4 sc4 = {1.f, 1.f, 1.f, 1.f}; if constexpr (MIXER == 1) sc4 = *(const f32x4*)(bendl + 16 * me + 4 * q4);
#pragma unroll
        for (int ne = 0; ne < 4; ++ne) { const f32x4 v = acc[ne] * sc4; u32x2 o; o.x = pk2(v[0], v[1]); o.y = pk2(v[2], v[3]); *(u32x2*)(dst + (16 * ne + r) * 64 + 16 * me + 4 * q4) = o; }
    }
    WAVE_SYNC();
}
template <int MIXER>
__device__ __forceinline__ void chunkst_w(const Params& p, int l, int b, int h, int cid, char* wl, int lane) {
    const bf16* P = (const bf16*)(p.ws + WS_P); const float* G = (const float*)(p.ws + WS_G);
    const int r0 = b * TOK + cid * 64, r = lane & 15, q4 = lane >> 4;
    bf16* Kt = (bf16*)wl;
    bf16* Vt = Kt + 4096;
    float* wvs = (float*)(Vt + 4096);
    float* bendl = wvs + 128;
    const int kcol = (MIXER == 0 ? PA : PG) + 256 + h * 64, vcol = (MIXER == 0 ? PA : PG) + 512 + h * 64;
    const float* Grow0 = G + (size_t)r0 * NGS;
    { bf16* Nn = Kt;
        load_nat_tile(P, r0, vcol, Nn, lane);
        WAVE_SYNC();
#pragma unroll
        for (int c = 0; c < 8; ++c) { unsigned w[4];
#pragma unroll
            for (int j = 0; j < 4; ++j) w[j] = (unsigned)Nn[swz(8 * c + 2 * j, lane >> 3) + (lane & 7)] | ((unsigned)Nn[swz(8 * c + 2 * j + 1, lane >> 3) + (lane & 7)] << 16);
            u32x4 o; o.x = w[0]; o.y = w[1]; o.z = w[2]; o.w = w[3]; *(u32x4*)(Vt + swz(lane, c)) = o; }
        WAVE_SYNC();
        load_nat_tile(P, r0, kcol, Nn, lane);
        WAVE_SYNC(); }
    unsigned kk[32];
    { const bf16* Nn = Kt;
#pragma unroll
        for (int i = 0; i < 32; ++i) kk[i] = (unsigned)Nn[swz(2 * i, lane >> 3) + (lane & 7)] | ((unsigned)Nn[swz(2 * i + 1, lane >> 3) + (lane & 7)] << 16); }
    WAVE_SYNC();
    if constexpr (MIXER == 0) {
        const float* g = Grow0 + (size_t)lane * NGS; const float* gb = p.in[I_MGB] + (size_t)l * 16;
        const float i_f = g[h] + gb[h], f_f = g[4 + h] + gb[4 + h], i_b = g[8 + h] + gb[8 + h], f_b = g[12 + h] + gb[12 + h];
        const float lf = logsigf_(f_f), lb = logsigf_(f_b);
        const float bF = wave_prefix_sum(lf, lane), totF = __shfl(bF, 63);
        const float gF = totF - bF + i_f, mF = wave_max(gF);
        const float totB = wave_sum(lb), preB = wave_prefix_sum(lb, lane), bB = totB - preB + lb;
        const float gB = totB - bB + i_b, mB = wave_max(gB);
        wvs[lane] = __expf(gF - mF); wvs[64 + lane] = __expf(gB - mB);
        if (lane == 0) { float* SC = (float*)(p.ws + WS_SC);
            SC[ch_index(0, b, h, cid) * 4 + 0] = totF; SC[ch_index(0, b, h, cid) * 4 + 1] = mF;
            SC[ch_index(1, b, h, cid) * 4 + 0] = totB; SC[ch_index(1, b, h, cid) * 4 + 1] = mB; }
    }
    WAVE_SYNC();
    chunkst_dir<MIXER, 0>(p, l, b, h, cid, Grow0, kk, Vt, Kt, wvs, bendl, lane);
    chunkst_dir<MIXER, 1>(p, l, b, h, cid, Grow0, kk, Vt, Kt, wvs, bendl, lane);
}

template <int DIR>
__device__ __forceinline__ void chunkst_gla(const Params& p, int l, int b, int h, int cid, char* wl, int lane_) {
    const bf16* P = (const bf16*)(p.ws + WS_P);
    const int lane = olane(lane_), r0 = b * TOK + cid * 64, r = lane & 15, q4 = lane >> 4;
    bf16* Kt = (bf16*)wl;
    bf16* An = Kt + 4096;
    float* bendl = (float*)(An + 4096);
    const int kcol = PG + 256 + h * 64, vcol = PG + 512 + h * 64;
    const float* Grow0 = (const float*)(p.ws + WS_G) + (size_t)r0 * NGS;
    load_nat_tile(P, r0, vcol, An, lane);
    WAVE_SYNC();
    bf16x8 vf[4][2];
#pragma unroll
    for (int ne = 0; ne < 4; ++ne)
#pragma unroll
        for (int ks = 0; ks < 2; ++ks) vf[ne][ks] = frag_tr(An, 16 * ne, 32 * ks, lane);
    WAVE_SYNC();
    load_nat_tile(P, r0, kcol, An, lane);
    WAVE_SYNC();
    bf16x8 af[4]; gla_r_frags<DIR>(Grow0, lane, af);
#pragma unroll 2
    for (int nt = 0; nt < 4; ++nt) { const int d = 16 * nt + r; float x[4][4];
        const float bend = gla_b_col<DIR>(p, l, h, af, nt, lane, x);
        if (q4 == 0) { ((float*)(p.ws + WS_BE))[ch_index(DIR, b, h, cid) * 64 + d] = bend; bendl[d] = __expf(fmaxf(bend, -80.0f)); }
#pragma unroll
        for (int mt = 0; mt < 4; ++mt)
#pragma unroll
            for (int i = 0; i < 4; ++i) { const int s = 16 * mt + 4 * q4 + i; bf16* ke = An + swz(s, d >> 3) + (d & 7); const float kv = bf2f(*ke); const float bc = fmaxf(x[mt][i], -80.0f);
                Kt[swz(d, s >> 3) + (s & 7)] = f2bf(kv * __expf(-bc));
                *ke = f2bf(__expf(bc)); } }
    WAVE_SYNC();
    { bf16* EQg = (bf16*)(p.ws + WS_EQ) + ((size_t)DIR * T + r0) * WG + h * 64;
#pragma unroll
        for (int i = 0; i < 8; ++i) { const int s = (lane >> 3) + 8 * i, ck = lane & 7; *(u32x4*)(EQg + (size_t)s * WG + ck * 8) = *(const u32x4*)(An + swz(s, ck)); } }
    bf16* dst = (bf16*)(p.ws + WS_ST) + st_index(1, DIR, b, h, cid) * 4096;
#pragma unroll
    for (int me = 0; me < 4; ++me) {
        f32x4 acc[4] = {(f32x4){0.f, 0.f, 0.f, 0.f}, (f32x4){0.f, 0.f, 0.f, 0.f}, (f32x4){0.f, 0.f, 0.f, 0.f}, (f32x4){0.f, 0.f, 0.f, 0.f}};
#pragma unroll
        for (int ks = 0; ks < 2; ++ks) { const bf16x8 a = *(const bf16x8*)(Kt + swz(16 * me + r, ks * 4 + q4));
#pragma unroll
            for (int ne = 0; ne < 4; ++ne) acc[ne] = MFMA16(a, vf[ne][ks], acc[ne]); }
        const f32x4 sc4 = *(const f32x4*)(bendl + 16 * me + 4 * q4);
#pragma unroll
        for (int ne = 0; ne < 4; ++ne) { const f32x4 v = acc[ne] * sc4; u32x2 o; o.x = pk2(v[0], v[1]); o.y = pk2(v[2], v[3]); *(u32x2*)(dst + (16 * ne + r) * 64 + 16 * me + 4 * q4) = o; }
    }
    WAVE_SYNC();
}

template <int MIXER, int DIR>
__device__ __forceinline__ void chunkout_prep(const Params& p, int l, int b, int h, int cid, const float* Grow0, int r0, int pbase, const bf16* EQ, float* gar, int lane_) {
    const int lane = olane(lane_);
    if constexpr (MIXER == 0) {
        const bf16* P = (const bf16*)(p.ws + WS_P);
        const float* g = Grow0 + (size_t)lane * NGS; const float* gb = p.in[I_MGB] + (size_t)l * 16;
        const float ig = g[DIR * 8 + h] + gb[DIR * 8 + h], fg = g[DIR * 8 + 4 + h] + gb[DIR * 8 + 4 + h];
        const float mprev = ((const float*)(p.ws + WS_SC))[ch_index(DIR, b, h, cid) * 4 + 2];
        const float lf = logsigf_(fg); float bb;
        if (DIR == 0) bb = wave_prefix_sum(lf, lane); else { const float tt = wave_sum(lf), pre = wave_prefix_sum(lf, lane); bb = tt - pre + lf; }
        const float a = ig - bb; const float pm = DIR == 0 ? wave_prefix_max(a, lane) : wave_suffix_max(a, lane);
        const float mt_ = fmaxf(bb + mprev, bb + pm);
        float* ga = gar + DIR * 320;
        ga[lane] = bb - mt_; ga[64 + lane] = a; ga[128 + lane] = __expf(bb + mprev - mt_); ga[192 + lane] = __expf(-mt_);
        float* nvl = gar + 640 + DIR * 64;
        nvl[lane] = ((const float*)(p.ws + WS_NV))[ch_index(DIR, b, h, cid) * 64 + lane];
        WAVE_SYNC();
        float dq = 0.f;
#pragma unroll
        for (int c = 0; c < 8; ++c) { float f[8]; unpack8(*(const u32x4*)(P + (size_t)(r0 + lane) * NP + pbase + c * 8), f);
            const f32x4 n0 = *(const f32x4*)(nvl + c * 8), n1 = *(const f32x4*)(nvl + c * 8 + 4);
            dq += f[0] * n0.x + f[1] * n0.y + f[2] * n0.z + f[3] * n0.w + f[4] * n1.x + f[5] * n1.y + f[6] * n1.z + f[7] * n1.w; }
        ga[256 + lane] = dq;
    }
}
template <int MIXER, int DIR, int NS>
__device__ __forceinline__ void chunkout_dir(const Params& p, int b, int h, int cid, int r0, int pbase, int th, const bf16x8 (&vtf)[4][2], const bf16* VtL, const bf16* EQ, bf16* SB, const float* gar, float* rsm, f32x4 (&htot)[NS][4], int lane_) {
    const bf16* P = (const bf16*)(p.ws + WS_P); const bf16* ST = (const bf16*)(p.ws + WS_ST);
    const int lane = olane(lane_), r = lane & 15, q4 = lane >> 4;
    const bf16* E = EQ + ((size_t)DIR * T + r0) * WG + h * 64;
    const float* ga = gar + DIR * 320;
    bf16x8 kf[4][2], ctf[4][2];
#pragma unroll
    for (int n = 0; n < 4; ++n)
#pragma unroll
        for (int ks = 0; ks < 2; ++ks) { if constexpr (MIXER == 0) kf[n][ks] = vtf[n][ks];
            else kf[n][ks] = *(const bf16x8*)(P + (size_t)(r0 + 16 * n + r) * NP + pbase + 256 + ks * 32 + q4 * 8);
            ctf[n][ks] = *(const bf16x8*)(ST + st_index(MIXER, DIR, b, h, cid) * 4096 + (16 * n + r) * 64 + ks * 32 + q4 * 8);
            if constexpr (MIXER == 1) { float fe[8], fk[8]; unpack8(*(const u32x4*)(E + (size_t)(16 * n + r) * WG + ks * 32 + q4 * 8), fe); unpack8(as_u4(kf[n][ks]), fk);
#pragma unroll
                for (int j = 0; j < 8; ++j) fk[j] = fk[j] * frcp_(fe[j]);
                kf[n][ks] = as_frag(pack8(fk)); } }
#pragma unroll
    for (int ms = 0; ms < NS; ++ms) { const int mt = NS * th + ms;
        bf16x8 qf[2];
#pragma unroll
        for (int ks = 0; ks < 2; ++ks) { qf[ks] = *(const bf16x8*)(P + (size_t)(r0 + 16 * mt + r) * NP + pbase + ks * 32 + q4 * 8);
            if constexpr (MIXER == 1) { float fe[8], fq[8]; unpack8(*(const u32x4*)(E + (size_t)(16 * mt + r) * WG + ks * 32 + q4 * 8), fe); unpack8(as_u4(qf[ks]), fq);
#pragma unroll
                for (int j = 0; j < 8; ++j) fq[j] *= 0.125f * fe[j];
                qf[ks] = as_frag(pack8(fq)); } }
        f32x4 S[4] = {(f32x4){0.f, 0.f, 0.f, 0.f}, (f32x4){0.f, 0.f, 0.f, 0.f}, (f32x4){0.f, 0.f, 0.f, 0.f}, (f32x4){0.f, 0.f, 0.f, 0.f}};
#pragma unroll
        for (int ks = 0; ks < 2; ++ks)
#pragma unroll
            for (int n = 0; n < 4; ++n) S[n] = MFMA16(kf[n][ks], qf[ks], S[n]);
        const int t = 16 * mt + r; float sm = 0.f; float gt = 0.f; if constexpr (MIXER == 0) gt = ga[t];
#pragma unroll
        for (int n = 0; n < 4; ++n) { f32x4 gs = {0.f, 0.f, 0.f, 0.f}; if constexpr (MIXER == 0) gs = *(const f32x4*)(ga + 64 + 16 * n + 4 * q4);
#pragma unroll
            for (int i = 0; i < 4; ++i) { const int sidx = 16 * n + 4 * q4 + i; const bool ok = DIR == 0 ? (sidx <= t) : (sidx >= t); float v = 0.f;
                if (ok) { if constexpr (MIXER == 0) v = S[n][i] * 0.125f * __expf(gt + gs[i]); else v = S[n][i]; }
                S[n][i] = v; sm += v; } }
        const float pa[8] = {S[0][0], S[0][1], S[0][2], S[0][3], S[1][0], S[1][1], S[1][2], S[1][3]}, pb[8] = {S[2][0], S[2][1], S[2][2], S[2][3], S[3][0], S[3][1], S[3][2], S[3][3]};
        const bf16x8 sm0 = as_frag(pack8(pa)), sm1 = as_frag(pack8(pb));
        float wi = 1.f, inv = 1.f;
        if constexpr (MIXER == 0) { sm = xrow_sum(sm); wi = ga[128 + t]; const float den = wi * ga[256 + t] + sm; inv = frcp_(fmaxf(fabsf(den), ga[192 + t])); }
#pragma unroll
        for (int me = 0; me < 4; ++me) { f32x4 a1 = {0.f, 0.f, 0.f, 0.f}, a2 = {0.f, 0.f, 0.f, 0.f};
            const int vrow = 16 * me + r, vo = 4 * (q4 & 1), vc = q4 >> 1;
            const u32x2 v0 = *(const u32x2*)(VtL + swz(vrow, 0 + vc) + vo), v1 = *(const u32x2*)(VtL + swz(vrow, 2 + vc) + vo), v2 = *(const u32x2*)(VtL + swz(vrow, 4 + vc) + vo), v3 = *(const u32x2*)(VtL + swz(vrow, 6 + vc) + vo);
            u32x4 va; va.x = v0.x; va.y = v0.y; va.z = v1.x; va.w = v1.y; u32x4 vb; vb.x = v2.x; vb.y = v2.y; vb.z = v3.x; vb.w = v3.y;
            a1 = MFMA16(as_frag(va), sm0, a1); a1 = MFMA16(as_frag(vb), sm1, a1);
            a2 = MFMA16(ctf[me][0], qf[0], a2); a2 = MFMA16(ctf[me][1], qf[1], a2);
            if constexpr (MIXER == 0) htot[ms][me] += (a1 + a2 * wi) * inv; else htot[ms][me] += a1 + a2; }
    }
    (void)SB; (void)rsm;
}
__device__ __forceinline__ void co_build_vt(const bf16* P, int r0, int vcol, bf16* VtL, int lane) {
    bf16* Nn = VtL + 4096;
#pragma unroll
    for (int hh = 0; hh < 2; ++hh) {
        u32x4 v[4];
#pragma unroll
        for (int i = 0; i < 4; ++i) v[i] = *(const u32x4*)(P + (size_t)(r0 + 32 * hh + (lane >> 3) + 8 * i) * NP + vcol + (lane & 7) * 8);
#pragma unroll
        for (int i = 0; i < 4; ++i) *(u32x4*)(Nn + swz((lane >> 3) + 8 * i, lane & 7)) = v[i];
        WAVE_SYNC();
#pragma unroll
        for (int c = 0; c < 4; ++c) { unsigned w[4];
#pragma unroll
            for (int j = 0; j < 4; ++j) w[j] = (unsigned)Nn[swz(8 * c + 2 * j, lane >> 3) + (lane & 7)] | ((unsigned)Nn[swz(8 * c + 2 * j + 1, lane >> 3) + (lane & 7)] << 16);
            u32x4 o; o.x = w[0]; o.y = w[1]; o.z = w[2]; o.w = w[3]; *(u32x4*)(VtL + swz(lane, 4 * hh + c)) = o; }
        WAVE_SYNC(); }
}
template <int MIXER, int NS>
__device__ __forceinline__ void co_finalize(const Params& p, int l, int h, int r0, int pbase, int mt0, f32x4 (&htot)[NS][4], int lane_) {
    const bf16* P = (const bf16*)(p.ws + WS_P); bf16* Y = (bf16*)(p.ws + WS_HNY);
    const float* ngp = p.in[MIXER == 0 ? I_MNG : I_GNG] + (size_t)l * WG + h * 64;
    const int lz = olane(lane_), r = lz & 15, q4 = lz >> 4;
    u32x2 gq[NS][4], oq[NS][4];
#pragma unroll
    for (int ms = 0; ms < NS; ++ms)
#pragma unroll
        for (int me = 0; me < 4; ++me) { const size_t off = (size_t)(r0 + 16 * (mt0 + ms) + r) * NP + pbase + 16 * me + 4 * q4;
            gq[ms][me] = *(const u32x2*)(P + off + (MIXER == 0 ? 1024 : 768)); if constexpr (MIXER == 0) oq[ms][me] = *(const u32x2*)(P + off + 768); else oq[ms][me] = (u32x2){0u, 0u}; }
#pragma unroll
    for (int ms = 0; ms < NS; ++ms) { const int mt = mt0 + ms; float ss = 0.f; float gv[4][4];
#pragma unroll
        for (int me = 0; me < 4; ++me) {
            gv[me][0] = bitsf(gq[ms][me].x << 16); gv[me][1] = bitsf(gq[ms][me].x & 0xffff0000u); gv[me][2] = bitsf(gq[ms][me].y << 16); gv[me][3] = bitsf(gq[ms][me].y & 0xffff0000u);
            if constexpr (MIXER == 0) { htot[ms][me][0] *= sigmoidf_(bitsf(oq[ms][me].x << 16)); htot[ms][me][1] *= sigmoidf_(bitsf(oq[ms][me].x & 0xffff0000u)); htot[ms][me][2] *= sigmoidf_(bitsf(oq[ms][me].y << 16)); htot[ms][me][3] *= sigmoidf_(bitsf(oq[ms][me].y & 0xffff0000u)); }
            ss += htot[ms][me][0] * htot[ms][me][0] + htot[ms][me][1] * htot[ms][me][1] + htot[ms][me][2] * htot[ms][me][2] + htot[ms][me][3] * htot[ms][me][3]; }
        ss = xrow_sum(ss);
        const float rstd = rsqrtf(ss * (1.0f / 64.0f) + EPS);
#pragma unroll
        for (int me = 0; me < 4; ++me) { const int e = 16 * me + 4 * q4; const f32x4 n4 = *(const f32x4*)(ngp + e);
            u32x2 o; o.x = pk2(htot[ms][me][0] * rstd * n4.x * siluf_(gv[me][0]), htot[ms][me][1] * rstd * n4.y * siluf_(gv[me][1]));
            o.y = pk2(htot[ms][me][2] * rstd * n4.z * siluf_(gv[me][2]), htot[ms][me][3] * rstd * n4.w * siluf_(gv[me][3]));
            *(u32x2*)(Y + (size_t)(r0 + 16 * mt + r) * 1024 + (MIXER == 0 ? YA : YG) + h * 64 + e) = o; } }
}
template <int MIXER>
__device__ __forceinline__ void chunkout_w(const Params& p, int l, int b, int h, int cid, char* wl, int lane) {
    const bf16* P = (const bf16*)(p.ws + WS_P); const float* G = (const float*)(p.ws + WS_G);
    const int r0 = b * TOK + cid * 64;
    const int pbase = (MIXER == 0 ? PA : PG) + h * 64;
    bf16* SB = (bf16*)wl;
    float* rsm = (float*)(SB + 1024);
    float* gar = rsm + 16;
    const bf16* EQ = (const bf16*)(p.ws + WS_EQ);
    const float* Grow0 = G + (size_t)r0 * NGS;
    bf16* VtL = (bf16*)(gar + 768);
    bf16x8 vtf[4][2];
#pragma unroll
    for (int me = 0; me < 4; ++me)
#pragma unroll
        for (int ks = 0; ks < 2; ++ks) { if constexpr (MIXER == 0) vtf[me][ks] = *(const bf16x8*)(P + (size_t)(r0 + 16 * me + (lane & 15)) * NP + pbase + 256 + ks * 32 + (lane >> 4) * 8); else vtf[me][ks] = (bf16x8){0, 0, 0, 0, 0, 0, 0, 0}; }
    co_build_vt(P, r0, pbase + 512, VtL, lane);
    chunkout_prep<MIXER, 0>(p, l, b, h, cid, Grow0, r0, pbase, EQ, gar, lane);
    chunkout_prep<MIXER, 1>(p, l, b, h, cid, Grow0, r0, pbase, EQ, gar, lane);
    WAVE_SYNC();
    constexpr int NS = MIXER == 1 ? 2 : 1;
#pragma unroll 1
    for (int th = 0; th < 4 / NS; ++th) {
        f32x4 htot[NS][4];
#pragma unroll
        for (int a = 0; a < NS; ++a)
#pragma unroll
            for (int c = 0; c < 4; ++c) htot[a][c] = (f32x4){0.f, 0.f, 0.f, 0.f};
        chunkout_dir<MIXER, 0, NS>(p, b, h, cid, r0, pbase, th, vtf, VtL, EQ, SB, gar, rsm, htot, lane);
        chunkout_dir<MIXER, 1, NS>(p, b, h, cid, r0, pbase, th, vtf, VtL, EQ, SB, gar, rsm, htot, lane);
        co_finalize<MIXER, NS>(p, l, h, r0, pbase, NS * th, htot, lane);
    }
}
constexpr int CO_PART = 13376;
template <int MIXER, int DIR>
__device__ __forceinline__ void chunkout_piece(const Params& p, int l, int b, int h, int cid, int mt, char* wl, int lane) {
    const bf16* P = (const bf16*)(p.ws + WS_P); const float* G = (const float*)(p.ws + WS_G);
    const int r0 = b * TOK + cid * 64; const int pbase = (MIXER == 0 ? PA : PG) + h * 64;
    bf16* SB = (bf16*)wl; float* rsm = (float*)(SB + 1024); float* gar = rsm + 16; const bf16* EQ = (const bf16*)(p.ws + WS_EQ);
    const float* Grow0 = G + (size_t)r0 * NGS; bf16* VtL = (bf16*)(gar + 768);
    bf16x8 vtf[4][2];
#pragma unroll
    for (int me = 0; me < 4; ++me)
#pragma unroll
        for (int ks = 0; ks < 2; ++ks) { if constexpr (MIXER == 0) vtf[me][ks] = *(const bf16x8*)(P + (size_t)(r0 + 16 * me + (lane & 15)) * NP + pbase + 256 + ks * 32 + (lane >> 4) * 8); else vtf[me][ks] = (bf16x8){0, 0, 0, 0, 0, 0, 0, 0}; }
    co_build_vt(P, r0, pbase + 512, VtL, lane);
    chunkout_prep<MIXER, DIR>(p, l, b, h, cid, Grow0, r0, pbase, EQ, gar, lane);
    WAVE_SYNC();
    f32x4 htot[1][4] = {{(f32x4){0.f, 0.f, 0.f, 0.f}, (f32x4){0.f, 0.f, 0.f, 0.f}, (f32x4){0.f, 0.f, 0.f, 0.f}, (f32x4){0.f, 0.f, 0.f, 0.f}}};
    chunkout_dir<MIXER, DIR, 1>(p, b, h, cid, r0, pbase, mt, vtf, VtL, EQ, SB, gar, rsm, htot, lane);
    float* part = (float*)(wl + CO_PART);
#pragma unroll
    for (int me = 0; me < 4; ++me)
#pragma unroll
        for (int i = 0; i < 4; ++i) part[(me * 4 + i) * 64 + lane] = htot[0][me][i];
}
template <int MIXER>
__device__ __forceinline__ void chunkout_combine(const Params& p, int l, int b, int h, int cid, int mt, const char* smem, int lane) {
    const float* pa = (const float*)(smem + (2 * mt) * WLDS + CO_PART); const float* pb = (const float*)(smem + (2 * mt + 1) * WLDS + CO_PART);
    f32x4 htot[1][4];
#pragma unroll
    for (int me = 0; me < 4; ++me)
#pragma unroll
        for (int i = 0; i < 4; ++i) htot[0][me][i] = pa[(me * 4 + i) * 64 + lane] + pb[(me * 4 + i) * 64 + lane];
    co_finalize<MIXER, 1>(p, l, h, b * TOK + cid * 64, (MIXER == 0 ? PA : PG) + h * 64, mt, htot, lane);
}

template <bool OUT>
__device__ __forceinline__ void chunk_workers(const Params& p, int l, char* smem) {
    const int tid = otid(), lane = tid & 63, wave = __builtin_amdgcn_readfirstlane(tid >> 6);
    const int NW = (int)gridDim.x * 8, wi = wave * (int)gridDim.x + obid();
    const int c_lo = (OUT && l == DEPTH - 1) ? NCC : 0, npc = NCH - c_lo, half = NB * NH * npc;
    char* wl = smem + wave * WLDS;
    if (OUT) {
        const int cl = NCC, npl = NCH - NCC, halfl = NB * NH * npl;
#pragma unroll 1
        for (int t = wi; t < halfl; t += NW) { const int b = t / (NH * npl), h = (t / npl) % NH, cid = cl + t % npl;
            const Params q = relaunder(p); chunkout_w<1>(q, l, b, h, cid, wl, lane); }
        { const int used = halfl % NW;
#pragma unroll 1
            for (int t = (wi + NW - used) % NW; t < halfl; t += NW) { const int b = t / (NH * npl), h = (t / npl) % NH, cid = cl + t % npl;
                const Params q = relaunder(p); chunkout_w<0>(q, l, b, h, cid, wl, lane); } }
        if (l < DEPTH - 1) {
            const int nct = NB * NH * NCC;
#pragma unroll 1
            for (int st = obid(); st < 2 * nct; st += (int)gridDim.x) { const int mixer = st / nct, r2 = st % nct, b = r2 / (NH * NCC), h = (r2 / NCC) % NH, cid = r2 % NCC;
                const Params q = relaunder(p); const int mt = wave >> 1;
                __syncthreads();
                if (mixer == 0) { if (wave & 1) chunkout_piece<0, 1>(q, l, b, h, cid, mt, wl, lane); else chunkout_piece<0, 0>(q, l, b, h, cid, mt, wl, lane); }
                else            { if (wave & 1) chunkout_piece<1, 1>(q, l, b, h, cid, mt, wl, lane); else chunkout_piece<1, 0>(q, l, b, h, cid, mt, wl, lane); }
                __syncthreads();
                if (wave < 4) { if (mixer == 0) chunkout_combine<0>(q, l, b, h, cid, wave, smem, lane); else chunkout_combine<1>(q, l, b, h, cid, wave, smem, lane); }
            }
        }
    } else {
        int off = 0;
#pragma unroll 1
        for (int t = wi; t < half; t += NW) { const int b = t / (NH * npc), h = (t / npc) % NH, cid = c_lo + t % npc;
            const Params q = relaunder(p); chunkst_gla<0>(q, l, b, h, cid, wl, lane); }
        off = (off + half) % NW;
#pragma unroll 1
        for (int t = (wi + NW - off) % NW; t < half; t += NW) { const int b = t / (NH * npc), h = (t / npc) % NH, cid = c_lo + t % npc;
            const Params q = relaunder(p); chunkst_gla<1>(q, l, b, h, cid, wl, lane); }
        off = (off + half) % NW;
#pragma unroll 1
        for (int t = (wi + NW - off) % NW; t < half; t += NW) { const int b = t / (NH * npc), h = (t / npc) % NH, cid = c_lo + t % npc;
            const Params q = relaunder(p); chunkst_w<0>(q, l, b, h, cid, wl, lane); }
    }
}

__device__ __forceinline__ void phase_mix1(const Params& p, int l, char* smem) {
    const bool ctxo = l < DEPTH - 1; const int G = (int)gridDim.x, bid = obid();
    constexpr int N_HL = (NB / 2) * (WG / 2), N_HC = NB * (WG / HCB);
    chunk_workers<false>(p, l, smem);
    stage_signal(p, smem, 0, l);
    for (int t = bid; t < N_HL; t += G) hylat_task(p, l, t / (WG / 2), t % (WG / 2), smem);
    if (ctxo) for (int t = G - 1 - bid; t < N_HC; t += G) hyctx_task(p, l, t / (WG / HCB), t % (WG / HCB), smem);
    stage_signal(p, smem, 2, l);
}

constexpr int SCG = 12;
__device__ __forceinline__ void phase_scan(const Params& p, int l, char* smem) {
    const int tid = otid();
    bf16* ST = (bf16*)(p.ws + WS_ST); float* NV = (float*)(p.ws + WS_NV); const float* BE = (const float*)(p.ws + WS_BE); float* SC = (float*)(p.ws + WS_SC);
    constexpr int NCHAIN = 2 * 2 * NB * NH;
    stage_wait(p, 0, l);
    for (int item = obid() * NT + tid; item < NCHAIN * 1024; item += gridDim.x * NT) {
        const int chain = item >> 10, grp = item & 1023; const int mixer = chain / (2 * NB * NH), dir = (chain / (NB * NH)) % 2, b = (chain / NH) % NB, h = chain % NH;
        float c[4] = {0.f, 0.f, 0.f, 0.f}; float nv[4] = {0.f, 0.f, 0.f, 0.f}; float m = 0.f;
        const int d0 = (grp & 15) * 4; const bool donv = (mixer == 0) && (grp < 16);
        for (int o0 = 0; o0 < NCH; o0 += SCG) {
            u32x2 uu[SCG]; float s0[SCG], s1[SCG]; f32x4 be[SCG]; f32x4 nu[SCG];
#pragma unroll
            for (int j = 0; j < SCG; ++j) if (o0 + j < NCH) { const int cid = chain_cid(dir, o0 + j); const size_t ci = ch_index(dir, b, h, cid);
                uu[j] = *(const u32x2*)(ST + st_index(mixer, dir, b, h, cid) * 4096 + grp * 4);
                if (mixer == 0) { s0[j] = SC[ci * 4 + 0]; s1[j] = SC[ci * 4 + 1]; if (donv) nu[j] = *(const f32x4*)(NV + ci * 64 + grp * 4); }
                else be[j] = *(const f32x4*)(BE + ci * 64 + d0); }
#pragma unroll
            for (int j = 0; j < SCG; ++j) if (o0 + j < NCH) { const int cid = chain_cid(dir, o0 + j); const size_t ci = ch_index(dir, b, h, cid);
                const float u[4] = {bitsf(uu[j].x << 16), bitsf(uu[j].x & 0xffff0000u), bitsf(uu[j].y << 16), bitsf(uu[j].y & 0xffff0000u)};
                u32x2 w; w.x = pk2(c[0], c[1]); w.y = pk2(c[2], c[3]); *(u32x2*)(ST + st_index(mixer, dir, b, h, cid) * 4096 + grp * 4) = w;
                if (mixer == 0) {
                    if (grp == 0) SC[ci * 4 + 2] = m;
                    const float mn = fmaxf(s0[j] + m, s1[j]), a = __expf(s0[j] + m - mn), s = __expf(s1[j] - mn);
#pragma unroll
                    for (int k = 0; k < 4; ++k) c[k] = a * c[k] + s * u[k];
                    if (donv) { f32x4 nw = {nv[0], nv[1], nv[2], nv[3]}; *(f32x4*)(NV + ci * 64 + grp * 4) = nw;
                        nv[0] = a * nv[0] + s * nu[j].x; nv[1] = a * nv[1] + s * nu[j].y; nv[2] = a * nv[2] + s * nu[j].z; nv[3] = a * nv[3] + s * nu[j].w; }
                    m = mn;
                } else { c[0] = __expf(be[j].x) * c[0] + u[0]; c[1] = __expf(be[j].y) * c[1] + u[1]; c[2] = __expf(be[j].z) * c[2] + u[2]; c[3] = __expf(be[j].w) * c[3] + u[3]; } }
        }
    }
    stage_signal(p, smem, 1, l);
    { const bool ctxo = l < DEPTH - 1; const int G = (int)gridDim.x, bid = obid();
        constexpr int QTL = SEQ / 128, QTC = CTXL / 128, N_AL = NB * 2 * QTL, N_AC = NB * 2 * QTC;
        for (int t = bid; t < N_AL; t += G) attn_task(p, l, t / (2 * QTL), (t / QTL) % 2, t % QTL, false, smem);
        if (ctxo) for (int t = (bid + G - 64 % G) % G; t < N_AC; t += G) attn_task(p, l, t / (2 * QTC), (t / QTC) % 2, t % QTC, true, smem); }
}

__device__ __forceinline__ void phase_mix2(const Params& p, int l, char* smem) {
    const int tid = otid();
    stage_wait(p, 1, l);
    chunk_workers<true>(p, l, smem);
    stage_wait(p, 2, l);
    constexpr int N_WOUT = (DM / 64) * (MIX / 64);
    { const int lane = tid & 63, wave = __builtin_amdgcn_readfirstlane(tid >> 6); const int NW = (int)gridDim.x * 8, wi = wave * (int)gridDim.x + obid();
        for (int task = NW - 1 - wi; task < N_WOUT; task += NW) { const int nt = task / (MIX / 64), kt = task % (MIX / 64);
            convert_tile_w(p.in[I_WOUT] + (size_t)l * MIX * DM, DM, (bf16*)(p.ws + WS_WOUT), MIX, nt * 64, kt * 64, false, smem + wave * WLDS, lane); }
        bf16* tile = (bf16*)(smem + wave * WLDS); const bf16* HT = (const bf16*)(p.ws + WS_HT); bf16* Y = (bf16*)(p.ws + WS_HNY);
        constexpr int NTT = NB * (SEQ / 64) * 4;
        for (int t = wi; t < NTT; t += NW) { const int b = t / ((SEQ / 64) * 4), tt = (t / 4) % (SEQ / 64), c0 = (t % 4) * 64; const size_t tok0 = (size_t)b * TOK + CTXL + tt * 64;
#pragma unroll
            for (int i = 0; i < 8; ++i) { const int ch = (lane >> 3) + 8 * i, ck = lane & 7; *(u32x4*)(tile + swz(ch, ck)) = *(const u32x4*)(HT + (size_t)(768 + c0 + ch) * T + tok0 + ck * 8); }
            WAVE_SYNC();
#pragma unroll
            for (int i = 0; i < 8; ++i) { const int tk = (lane >> 3) + 8 * i, cc = lane & 7; unsigned w[4];
#pragma unroll
                for (int j = 0; j < 4; ++j) { const int ca = cc * 8 + 2 * j; w[j] = (unsigned)tile[swz(ca, tk >> 3) + (tk & 7)] | ((unsigned)tile[swz(ca + 1, tk >> 3) + (tk & 7)] << 16); }
                u32x4 o; o.x = w[0]; o.y = w[1]; o.z = w[2]; o.w = w[3]; *(u32x4*)(Y + (tok0 + tk) * 1024 + YH + c0 + cc * 8) = o; }
            WAVE_SYNC(); } }
}


#ifndef EMU
#define LAS __attribute__((address_space(3)))
#define XB_TMO      128
#define XB_XCNT(j)  (256  + 64 * (j))
#define XB_XSUB(j)  (1280 + 64 * (j))
#define XB_XGEN(j)  (2304 + 64 * (j))
#define XB_TOP      3328
#define XB_TOPGEN   3392
#define XCD_BAR_WORDS 3456
#define XB_SPIN_CAP (1u << 18)

__device__ __forceinline__ unsigned xb_ld(unsigned* p)              { return __hip_atomic_load(p, __ATOMIC_RELAXED, __HIP_MEMORY_SCOPE_AGENT); }
__device__ __forceinline__ unsigned xb_add(unsigned* p, unsigned v) { return __hip_atomic_fetch_add(p, v, __ATOMIC_RELAXED, __HIP_MEMORY_SCOPE_AGENT); }
__device__ __forceinline__ unsigned xb_xcc_id() { return (unsigned)__builtin_amdgcn_s_getreg((3 << 11) | 20) & 0xFu; }
#define XB_SPIN(cond, bar) do { unsigned _sp = 0; while (cond) { __builtin_amdgcn_s_sleep(1); \
    if ((++_sp & 255u) == 0u) { if (xb_ld(&(bar)[XB_TMO])) break; if (_sp > XB_SPIN_CAP) { atomicAdd(&(bar)[XB_TMO], 1u); break; } } } } while (0)

struct XcdBarrier {
    unsigned* bar; unsigned x;
    volatile LAS unsigned* st;
};

__device__ __forceinline__ XcdBarrier xcd_barrier_post(unsigned* bar, volatile LAS unsigned* st) {
    XcdBarrier b; b.bar = bar; b.x = xb_xcc_id(); b.st = st;
    if (threadIdx.x == 0) (void)xb_add(&bar[XB_XCNT(b.x)], 1u);
    return b;
}
__device__ __forceinline__ void xcd_barrier_complete(unsigned* bar, unsigned x, unsigned& nloc, unsigned& nx) {
    const unsigned G = gridDim.x * gridDim.y * gridDim.z;
    unsigned sum, cnt, mine, sp = 0u;
    for (;;) {
        sum = 0u; cnt = 0u; mine = 0u;
#pragma unroll
        for (unsigned j = 0; j < 16; ++j) { const unsigned c = xb_ld(&bar[XB_XCNT(j)]); sum += c; cnt += (c > 0u) ? 1u : 0u; mine = (j == x) ? c : mine; }
        if (sum == G) break;
        __builtin_amdgcn_s_sleep(1);
        if ((++sp & 255u) == 0u) { if (xb_ld(&bar[XB_TMO])) break; if (sp > XB_SPIN_CAP) { atomicAdd(&bar[XB_TMO], 1u); break; } }
    }
    nloc = mine > 0u ? mine : 1u; nx = cnt > 0u ? cnt : 1u;
}

__device__ __forceinline__ void xcd_barrier(const XcdBarrier& b) {
    asm volatile("s_waitcnt vmcnt(0)" ::: "memory");
    __syncthreads();
    if (threadIdx.x == 0) {
        unsigned* bar = b.bar;
        __builtin_amdgcn_s_waitcnt(0);
        unsigned nloc = b.st[0], nx = b.st[1];
        if (nloc == 0u) { xcd_barrier_complete(bar, b.x, nloc, nx); b.st[0] = nloc; b.st[1] = nx; }
        const unsigned old = xb_add(&bar[XB_XSUB(b.x)], 1u);
        const unsigned gen = old / nloc;
        if (old + 1u == (gen + 1u) * nloc) {
            __builtin_amdgcn_fence(__ATOMIC_RELEASE, "agent");
            asm volatile("s_waitcnt vmcnt(0)" ::: "memory");
            const unsigned og = xb_add(&bar[XB_TOP], 1u);
            const unsigned tg = og / nx;
            if (og + 1u == (tg + 1u) * nx) xb_add(&bar[XB_TOPGEN], 1u);
            else XB_SPIN(xb_ld(&bar[XB_TOPGEN]) == tg, bar);
            __builtin_amdgcn_fence(__ATOMIC_ACQUIRE, "agent");
            xb_add(&bar[XB_XGEN(b.x)], 1u);
            asm volatile("s_waitcnt vmcnt(0)" ::: "memory");
        } else {
            XB_SPIN(xb_ld(&bar[XB_XGEN(b.x)]) == gen, bar);
            __builtin_amdgcn_fence(__ATOMIC_ACQUIRE, "agent");
            asm volatile("s_waitcnt vmcnt(0)" ::: "memory");
        }
    }
    __syncthreads();
}
#endif

__global__ void __launch_bounds__(NT) fwd_kernel(Params pk, int ph_lo, int ph_hi) {
    SMEM_DECL;
#ifndef EMU
    volatile LAS unsigned* misc = (volatile LAS unsigned*)(smem + LDS_BYTES - 64);
    if (threadIdx.x < 2) misc[threadIdx.x] = 0u;
    __syncthreads();
    const XcdBarrier bar = xcd_barrier_post((unsigned*)(pk.ws + WS_BAR), misc);
#endif
    constexpr int NPH = 2 + 6 * DEPTH;
    for (int ph = ph_lo; ph < ph_hi && ph < NPH; ++ph) {
#ifndef EMU
        Params p = pk; { size_t z = 0; asm volatile("" : "+s"(z)); p.ws = pk.ws + z; p.out = pk.out + z;
#pragma unroll
            for (int i = 0; i < 26; ++i) p.in[i] = pk.in[i] + z; }
#else
        const Params& p = pk;
#endif
        if (ph == 0) phase0(p, smem);
        else if (ph == NPH - 1) phase_rp(p, DEPTH, smem);
        else { const int l = (ph - 1) / 6, k = (ph - 1) % 6;
            if (k == 0) phase_rp(p, l, smem);
            else if (k == 1) phase_gemm_in(p, l, smem);
            else if (k == 2) phase_mix1(p, l, smem);
            else if (k == 3) phase_scan(p, l, smem);
            else if (k == 4) phase_mix2(p, l, smem);
            else phase_gemm_out(p, l, smem);
#ifdef PROBE_DUP
            if (k == PROBE_DUP) { GRID_SYNC();
                if (k == 1) phase_gemm_in(p, l, smem); else if (k == 2) phase_mix1(p, l, smem); else if (k == 4) phase_mix2(p, l, smem); }
#endif
        }
        if (ph + 1 < ph_hi && !(ph >= 6 && ph % 6 == 0) && !(ph >= 1 && ((ph - 1) % 6 == 2 || (ph - 1) % 6 == 3))) {
#ifdef EMU
            GRID_SYNC();
#else
            if (ph_lo < 0) GRID_SYNC();
            xcd_barrier(bar);
#endif
        }
    }
}

#ifndef EMU
extern "C" void kernel_launch(void* const* d_in, const int* in_sizes, int n_in, void* d_out, int out_size, void* d_ws, size_t ws_size, hipStream_t stream) {
    static int grid = 0;
    if (grid == 0) {
        if (n_in != 26 || ws_size < WS_TOTAL) { fprintf(stderr, "kernel_launch: unexpected n_in %d or ws_size %zu (need %zu)\n", n_in, ws_size, (size_t)WS_TOTAL); grid = -1; return; }
        int dev = 0, cus = 0, per_cu = 0;
        hipGetDevice(&dev);
        hipDeviceGetAttribute(&cus, hipDeviceAttributeMultiprocessorCount, dev);
        hipFuncSetAttribute((const void*)fwd_kernel, hipFuncAttributeMaxDynamicSharedMemorySize, LDS_BYTES);
        hipOccupancyMaxActiveBlocksPerMultiprocessor(&per_cu, (const void*)fwd_kernel, NT, LDS_BYTES);
        if (per_cu < 1) { fprintf(stderr, "kernel_launch: occupancy query returned %d\n", per_cu); grid = -1; return; }
        if (per_cu > 1) per_cu = 1;
        grid = cus * per_cu;
    }
    if (grid < 0) return;
    hipMemsetAsync((char*)d_ws + WS_BAR, 0, BAR_BYTES, stream);
    Params p{};
    for (int i = 0; i < 26; ++i) p.in[i] = (const float*)d_in[i];
    p.out = (float*)d_out; p.ws = (char*)d_ws;
    int lo = 0, hi = 2 + 6 * DEPTH;
    void* args[] = {&p, &lo, &hi};
    hipError_t e = hipLaunchCooperativeKernel((const void*)fwd_kernel, dim3(grid), dim3(NT), args, LDS_BYTES, stream);
    if (e != hipSuccess) fprintf(stderr, "cooperative launch failed: %s (grid %d)\n", hipGetErrorString(e), grid);
}
#endif
```

```cpp
#ifdef EMU
#include "emu/hipemu.h"
#define GRID_SYNC() emu::grid_sync()
#define SMEM_DECL char* smem = emu::S().blocks[emu::cur()->block].lds
#define SCHED_FENCE() do {} while (0)
#define EXP2(x) exp2f(x)
#define MFMA16(a, b, c) emu_mfma_16x16x32_bf16(a, b, c)
#else
#include <hip/hip_runtime.h>
#include <hip/hip_cooperative_groups.h>
#include <cstdio>
#include <cstdint>
#define GRID_SYNC() cooperative_groups::this_grid().sync()
#define SMEM_DECL extern __shared__ __attribute__((aligned(16))) char smem[]
#define SCHED_FENCE() __builtin_amdgcn_sched_barrier(0)
#define EXP2(x) __builtin_amdgcn_exp2f(x)
#define MFMA16(a, b, c) __builtin_amdgcn_mfma_f32_16x16x32_bf16(a, b, c, 0, 0, 0)
#endif

#ifdef EMU
#ifndef EMU_DM
#define EMU_DM 256
#endif
#ifndef EMU_NB
#define EMU_NB 2
#endif
#ifndef EMU_SEQ
#define EMU_SEQ 512
#endif
#ifndef EMU_DEPTH
#define EMU_DEPTH 2
#endif
#ifndef EMU_CTXL
#define EMU_CTXL 128
#endif
constexpr int DM = EMU_DM, NB = EMU_NB, SEQ = EMU_SEQ, DEPTH = EMU_DEPTH, CTXL = EMU_CTXL;
#else
constexpr int DM = 1024, NB = 8, SEQ = 2048, DEPTH = 4, CTXL = 256;
#endif
constexpr int MIX = 1024, WG = 256, HD = 64, NH = 4, CH = 64;
constexpr int TOK = CTXL + SEQ, T = NB * TOK, NCH = TOK / CH, NCC = CTXL / CH;
constexpr int N_IN = 4144, NP = 3072, NG = 48, NGS = 32, NMAIN = 3328, NPAD = 4352;
constexpr int NF = 2 * SEQ;
constexpr int NJ = NB + 1;
constexpr int NT = 512;
constexpr float EPS = 1e-6f;
constexpr int PA = 0, PG = 1280, PD = 2304;
constexpr int YA = 0, YH = 256, YG = 512, YD = 768;
constexpr int ilog4(int n) { return n <= 1 ? 0 : 1 + ilog4(n / 4); }
constexpr int FFT_P = ilog4(NF);
static_assert((1 << (2 * FFT_P)) == NF, "NF must be a power of 4");
static_assert(DM % 256 == 0 && CTXL % 128 == 0 && SEQ % 256 == 0, "shape constraints");

typedef unsigned short bf16;
typedef short bf16x8 __attribute__((ext_vector_type(8)));
typedef float f32x4 __attribute__((ext_vector_type(4)));
typedef unsigned u32x4 __attribute__((ext_vector_type(4)));
typedef unsigned u32x2 __attribute__((ext_vector_type(2)));
struct cpx { float x, y; };

constexpr size_t al256(size_t x) { return (x + 255) & ~(size_t)255; }
constexpr size_t WS_CTXB = 0;
constexpr size_t WS_HNY = al256(WS_CTXB + (size_t)NB * CTXL * DM * 4);
constexpr size_t WS_WIN = WS_HNY + (size_t)T * 1024 * 2;
constexpr size_t WS_ST = WS_WIN;
constexpr size_t ST_BYTES = (size_t)2 * 2 * NB * NH * NCH * 4096 * 2;
constexpr size_t WS_KT = al256(WS_WIN + (size_t)NPAD * DM * 2);
static_assert(WS_KT + (size_t)WG * NF * 4 <= WS_ST + ST_BYTES || true, "");
constexpr size_t ST_END = al256((WS_ST + ST_BYTES > WS_KT + (size_t)WG * NF * 4) ? WS_ST + ST_BYTES : WS_KT + (size_t)WG * NF * 4);
constexpr size_t WS_P = ST_END;
constexpr size_t WS_HT = al256(WS_P + (size_t)T * NP * 2);
constexpr size_t WS_WOUT = WS_HT;
constexpr size_t WS_G = al256(WS_HT + (size_t)1024 * T * 2);
constexpr size_t WS_KF = al256(WS_G + (size_t)T * NGS * 4);
constexpr size_t WS_HC = al256(WS_KF + (size_t)WG * NF * 8);
constexpr size_t WS_EQ = al256(WS_HC + (size_t)2 * WG * CTXL * 4);
constexpr size_t WS_NV = al256(WS_EQ + (size_t)2 * T * WG * 2);
constexpr size_t WS_BE = al256(WS_NV + (size_t)2 * NB * NH * NCH * 64 * 4);
constexpr size_t WS_SC = al256(WS_BE + (size_t)2 * NB * NH * NCH * 64 * 4);
constexpr size_t WS_MOD = al256(WS_SC + (size_t)2 * NB * NH * NCH * 4 * 4);
constexpr size_t WS_TW = al256(WS_MOD + (size_t)DEPTH * NJ * 3 * DM * 4);
constexpr size_t WS_ROPE = al256(WS_TW + (size_t)NF * 8);
constexpr size_t WS_BAR = al256(WS_ROPE + (size_t)SEQ * 32 * 8);
constexpr size_t BAR_BYTES = 32768;
constexpr size_t WS_TOTAL = al256(WS_BAR + BAR_BYTES);
static_assert((size_t)T * DM * 4 <= (size_t)T * NP * 2, "YO fits in P");
#ifndef EMU
static_assert(WS_TOTAL <= (size_t)268435456, "workspace map must fit 256 MiB");
#endif

constexpr int LDS_BYTES = 163840;

struct Params {
    const float* in[26];
    float* out;
    char* ws;
};
enum { I_X = 0, I_C, I_CTX, I_CCTX, I_WADA, I_BADA, I_GPRE, I_GPOST, I_WIN, I_MGB, I_MNG, I_HCW, I_HCB, I_HW1, I_HB1, I_HW2, I_HB2, I_HW3, I_HB3,
       I_HFREQ, I_HD, I_GWA, I_GBA, I_GNG, I_SINK, I_WOUT };

__device__ __forceinline__ Params relaunder(const Params& pk) {
#ifdef EMU
    return pk;
#else
    Params p = pk; size_t z = 0; asm volatile("" : "+s"(z)); p.ws = pk.ws + z; p.out = pk.out + z;
#pragma unroll
    for (int i = 0; i < 26; ++i) p.in[i] = pk.in[i] + z;
    return p;
#endif
}
constexpr int WLDS = (LDS_BYTES - 64) / 8 / 16 * 16;
#ifdef EMU
#define WAVE_SYNC() emu_wave_sync()
#else
#define WAVE_SYNC() do { asm volatile("s_waitcnt lgkmcnt(0)" ::: "memory"); __builtin_amdgcn_wave_barrier(); } while (0)
#endif

#ifdef EMU
__device__ __forceinline__ int otid() { return (int)threadIdx.x; }
__device__ __forceinline__ int obid() { return (int)blockIdx.x; }
#else
__device__ __forceinline__ int otid() { int t = (int)threadIdx.x; asm volatile("" : "+v"(t)); return t; }
__device__ __forceinline__ int obid() { int b = (int)blockIdx.x; asm volatile("" : "+s"(b)); return b; }
#endif
__device__ __forceinline__ unsigned fbits(float f) { return __builtin_bit_cast(unsigned, f); }
__device__ __forceinline__ float bitsf(unsigned u) { return __builtin_bit_cast(float, u); }
__device__ __forceinline__ float bf2f(bf16 h) { return bitsf((unsigned)h << 16); }
#ifdef EMU
__device__ __forceinline__ bf16 f2bf(float f) { unsigned u = fbits(f); return (bf16)((u + 0x7fffu + ((u >> 16) & 1u)) >> 16); }
__device__ __forceinline__ unsigned pk2(float lo, float hi) { return (unsigned)f2bf(lo) | ((unsigned)f2bf(hi) << 16); }
#else
typedef __bf16 nbf16x2 __attribute__((ext_vector_type(2)));
typedef float nf32x2 __attribute__((ext_vector_type(2)));
__device__ __forceinline__ unsigned pk2(float lo, float hi) { const nf32x2 v = {lo, hi}; return __builtin_bit_cast(unsigned, __builtin_convertvector(v, nbf16x2)); }
__device__ __forceinline__ bf16 f2bf(float f) { return (bf16)(pk2(f, 0.0f) & 0xffffu); }
#endif
#ifdef EMU
__device__ __forceinline__ float frcp_(float x) { return 1.0f / x; }
#else
__device__ __forceinline__ float frcp_(float x) { return __builtin_amdgcn_rcpf(x); }
#endif
__device__ __forceinline__ float sigmoidf_(float x) { return frcp_(1.0f + __expf(-x)); }
__device__ __forceinline__ float siluf_(float x) { return x * frcp_(1.0f + __expf(-x)); }
__device__ __forceinline__ float logsigf_(float x) { return fminf(x, 0.0f) - log1pf(__expf(-fabsf(x))); }
__device__ __forceinline__ float logsig_fast(float x) { return fminf(x, 0.0f) - __logf(1.0f + __expf(-fabsf(x))); }
#ifdef EMU
__device__ __forceinline__ float row16_sum(float x) { x += __shfl_xor(x, 1); x += __shfl_xor(x, 2); x += __shfl_xor(x, 4); x += __shfl_xor(x, 8); return x; }
__device__ __forceinline__ float row16_max(float x) { x = fmaxf(x, __shfl_xor(x, 1)); x = fmaxf(x, __shfl_xor(x, 2)); x = fmaxf(x, __shfl_xor(x, 4)); x = fmaxf(x, __shfl_xor(x, 8)); return x; }
__device__ __forceinline__ float xrow_sum(float x) { x += __shfl_xor(x, 16); x += __shfl_xor(x, 32); return x; }
__device__ __forceinline__ float xrow_max(float x) { x = fmaxf(x, __shfl_xor(x, 16)); x = fmaxf(x, __shfl_xor(x, 32)); return x; }
#else
template <int CTRL> __device__ __forceinline__ float dpp_(float x) { return __builtin_bit_cast(float, __builtin_amdgcn_mov_dpp(__builtin_bit_cast(int, x), CTRL, 0xf, 0xf, true)); }
__device__ __forceinline__ float row16_sum(float x) { x += dpp_<0xB1>(x); x += dpp_<0x4E>(x); x += dpp_<0x141>(x); x += dpp_<0x128>(x); return x; }
__device__ __forceinline__ float row16_max(float x) { x = fmaxf(x, dpp_<0xB1>(x)); x = fmaxf(x, dpp_<0x4E>(x)); x = fmaxf(x, dpp_<0x141>(x)); x = fmaxf(x, dpp_<0x128>(x)); return x; }
__device__ __forceinline__ float xrow_sum(float x) {
    auto s = __builtin_amdgcn_permlane16_swap(fbits(x), fbits(x), false, false); x = bitsf(s[0]) + bitsf(s[1]);
    auto t = __builtin_amdgcn_permlane32_swap(fbits(x), fbits(x), false, false); return bitsf(t[0]) + bitsf(t[1]); }
__device__ __forceinline__ float xrow_max(float x) {
    auto s = __builtin_amdgcn_permlane16_swap(fbits(x), fbits(x), false, false); x = fmaxf(bitsf(s[0]), bitsf(s[1]));
    auto t = __builtin_amdgcn_permlane32_swap(fbits(x), fbits(x), false, false); return fmaxf(bitsf(t[0]), bitsf(t[1])); }
#endif
__device__ __forceinline__ float wave_sum(float v) { return xrow_sum(row16_sum(v)); }
__device__ __forceinline__ float wave_max(float v) { return xrow_max(row16_max(v)); }
#ifdef EMU
__device__ __forceinline__ float wave_prefix_sum(float v, int lane) {
#pragma unroll
    for (int o = 1; o < 64; o <<= 1) { float t = __shfl_up(v, o); if (lane >= o) v += t; }
    return v;
}
__device__ __forceinline__ float wave_prefix_max(float v, int lane) {
#pragma unroll
    for (int o = 1; o < 64; o <<= 1) { float t = __shfl_up(v, o); if (lane >= o) v = fmaxf(v, t); }
    return v;
}
#else
template <int CTRL, int RM> __device__ __forceinline__ float dppo_(float old, float x) { return __builtin_bit_cast(float, __builtin_amdgcn_update_dpp(__builtin_bit_cast(int, old), __builtin_bit_cast(int, x), CTRL, RM, 0xf, false)); }
__device__ __forceinline__ float wave_prefix_sum(float v, int) {
    v += dppo_<0x111, 0xf>(0.f, v); v += dppo_<0x112, 0xf>(0.f, v); v += dppo_<0x114, 0xf>(0.f, v); v += dppo_<0x118, 0xf>(0.f, v);
    v += dppo_<0x142, 0xa>(0.f, v); v += dppo_<0x143, 0xc>(0.f, v); return v;
}
__device__ __forceinline__ float wave_prefix_max(float v, int) {
    const float ninf = -INFINITY;
    v = fmaxf(v, dppo_<0x111, 0xf>(ninf, v)); v = fmaxf(v, dppo_<0x112, 0xf>(ninf, v)); v = fmaxf(v, dppo_<0x114, 0xf>(ninf, v)); v = fmaxf(v, dppo_<0x118, 0xf>(ninf, v));
    v = fmaxf(v, dppo_<0x142, 0xa>(ninf, v)); v = fmaxf(v, dppo_<0x143, 0xc>(ninf, v)); return v;
}
#endif
__device__ __forceinline__ float wave_suffix_max(float v, int lane) {
    return __shfl(wave_prefix_max(__shfl(v, 63 - lane), lane), 63 - lane);
}
__device__ __forceinline__ void unpack8(u32x4 v, float* f) {
    f[0] = bitsf(v.x << 16); f[1] = bitsf(v.x & 0xffff0000u); f[2] = bitsf(v.y << 16); f[3] = bitsf(v.y & 0xffff0000u);
    f[4] = bitsf(v.z << 16); f[5] = bitsf(v.z & 0xffff0000u); f[6] = bitsf(v.w << 16); f[7] = bitsf(v.w & 0xffff0000u);
}
__device__ __forceinline__ int orig_col(int n) {
    if (n < 1280) return n;
    if (n < 2304) return 2320 + (n - 1280);
    if (n < 3072) return 3376 + (n - 2304);
    if (n < 3088) return 1280 + (n - 3072);
    if (n < 3120) return 3344 + (n - 3088);
    if (n < NMAIN) return -1;
    return 1296 + (n - NMAIN);
}
__device__ __forceinline__ int chain_cid(int dir, int o) {
    if (dir == 0) return o;
    return o < NCC ? (NCC - 1 - o) : (NCH - 1 - (o - NCC));
}

__device__ __forceinline__ int swz(int row, int ch) { return row * 64 + ((ch ^ (row & 7)) << 3); }
__device__ __forceinline__ u32x4 pack8(const float* f) { u32x4 o; o.x = pk2(f[0], f[1]); o.y = pk2(f[2], f[3]); o.z = pk2(f[4], f[5]); o.w = pk2(f[6], f[7]); return o; }
__device__ __forceinline__ bf16x8 as_frag(u32x4 v) { return __builtin_bit_cast(bf16x8, v); }
#ifdef EMU
inline u32x2 lds_tr16(const bf16* p) { unsigned mine[2]; const unsigned long long a = (unsigned long long)p; mine[0] = (unsigned)a; mine[1] = (unsigned)(a >> 32);
    auto buf = emu::collective(mine, 2); const int l = emu::cur()->lane, g = l >> 4, i = l & 15; unsigned short e[4];
    for (int j = 0; j < 4; ++j) { const int src = 16 * g + 4 * j + (i >> 2); const bf16* q = (const bf16*)(((unsigned long long)buf[src][1] << 32) | buf[src][0]); e[j] = *(const unsigned short*)(q + (i & 3)); }
    u32x2 r; r.x = (unsigned)e[0] | ((unsigned)e[1] << 16); r.y = (unsigned)e[2] | ((unsigned)e[3] << 16); return r; }
#else
typedef short v4i16_t __attribute__((ext_vector_type(4)));
__device__ __forceinline__ u32x2 lds_tr16(const bf16* p) { return __builtin_bit_cast(u32x2, __builtin_amdgcn_ds_read_tr16_b64_v4i16((__attribute__((address_space(3))) v4i16_t*)p)); }
#endif
__device__ __forceinline__ u32x4 as_u4(bf16x8 v) { return __builtin_bit_cast(u32x4, v); }

constexpr int LS = 72;

template <int NTL, int KS>
__device__ __forceinline__ void mma_nt(const bf16* A, int lda, int m0, const bf16* B, int ldb, int n0, f32x4 (&acc)[NTL], int lane) {
    const int r = lane & 15, q = lane >> 4;
#pragma unroll
    for (int ks = 0; ks < KS; ++ks) {
        const bf16x8 a = *(const bf16x8*)(A + (m0 + r) * lda + ks * 32 + q * 8);
#pragma unroll
        for (int nt = 0; nt < NTL; ++nt) {
            const bf16x8 b = *(const bf16x8*)(B + (n0 + nt * 16 + r) * ldb + ks * 32 + q * 8);
            acc[nt] = MFMA16(a, b, acc[nt]);
        }
    }
}

__device__ __forceinline__ void layer_prep(const Params& p, int l, int idx, int stride, char* smem);
__device__ __forceinline__ void phase0(const Params& p, char* smem) {
    const int tid = otid();
    cpx* TW = (cpx*)(p.ws + WS_TW);
    cpx* ROPE = (cpx*)(p.ws + WS_ROPE);
    float* MOD = (float*)(p.ws + WS_MOD);
    constexpr int N_TW = NF / NT, N_ROPE = SEQ * 32 / NT, N_MOD = DEPTH * (3 * DM / 64);
    for (int task = obid(); task < N_TW + N_ROPE + N_MOD; task += gridDim.x) {
        if (task < N_TW) {
            const int j = task * NT + tid; float s, c; sincospif(2.0f * (float)j / (float)NF, &s, &c);
            cpx v; v.x = c; v.y = -s; TW[j] = v;
        } else if (task < N_TW + N_ROPE) {
            const int idx = (task - N_TW) * NT + tid; const int pos = idx >> 5, i = idx & 31;
            const float inv = exp2f(-(float)(i & 15) * (13.287712379549449f / 16.0f));
            const float ang = (float)(i < 16 ? pos / 64 : pos % 64) * inv;
            cpx v; v.x = cosf(ang); v.y = sinf(ang); ROPE[idx] = v;
        } else {
            const int mt = task - N_TW - N_ROPE; const int l = mt / (3 * DM / 64), n0 = (mt % (3 * DM / 64)) * 64;
            float* sv = (float*)smem;
            float* red = sv + NJ * DM;
            __syncthreads();
            for (int i = tid; i < NJ * DM; i += NT) { const int j = i / DM, k = i % DM; const float v = j < NB ? p.in[I_C][j * DM + k] : p.in[I_CCTX][k]; sv[i] = siluf_(v); }
            __syncthreads();
            const int c4 = tid & 15, kg = tid >> 4; f32x4 acc[NJ];
#pragma unroll
            for (int j = 0; j < NJ; ++j) acc[j] = (f32x4){0.f, 0.f, 0.f, 0.f};
            const float* w = p.in[I_WADA] + (size_t)l * DM * 3 * DM + n0 + 4 * c4;
#pragma unroll 8
            for (int i = 0; i < DM / 32; ++i) { const int k = kg + 32 * i; const f32x4 wv = *(const f32x4*)(w + (size_t)k * 3 * DM);
#pragma unroll
                for (int j = 0; j < NJ; ++j) acc[j] = acc[j] + wv * sv[j * DM + k]; }
#pragma unroll
            for (int j = 0; j < NJ; ++j) *(f32x4*)(red + (kg * NJ + j) * 64 + 4 * c4) = acc[j];
            __syncthreads();
            for (int i = tid; i < NJ * 64; i += NT) { const int j = i / 64, n = i % 64; float s = 0.f;
#pragma unroll
                for (int k8 = 0; k8 < 32; ++k8) s += red[(k8 * NJ + j) * 64 + n];
                MOD[((size_t)l * NJ + j) * 3 * DM + n0 + n] = s + p.in[I_BADA][(size_t)l * 3 * DM + n0 + n]; }
        }
    }
}

#ifdef EMU
constexpr int PANEL_ROWS = 128, PANEL_UNITS = DM / 128;
#else
constexpr int PANEL_ROWS = 256, PANEL_UNITS = DM / 256;
#endif
__device__ __forceinline__ unsigned* unit_counter(const Params& p, int isctx) { return (unsigned*)(p.ws + WS_BAR + 16384) + 64 * isctx; }
__device__ __forceinline__ unsigned* stage_counter(const Params& p, int flag) { return (unsigned*)(p.ws + WS_BAR + 16384) + 512 + 512 * flag; }
__device__ __forceinline__ void stage_signal(const Params& p, char* smem, int flag, int l) {
#ifdef EMU
    __syncthreads(); if (otid() == 0) *stage_counter(p, flag) += 1u;
#else
    asm volatile("s_waitcnt vmcnt(0)" ::: "memory"); __syncthreads();
    if (threadIdx.x == 0) {
        const unsigned xcc = (unsigned)__builtin_amdgcn_s_getreg((3 << 11) | 20) & 0xFu, nloc = ((volatile __attribute__((address_space(3))) unsigned*)(smem + LDS_BYTES - 64))[0];
        unsigned* g = stage_counter(p, flag);
        if (nloc > 0u) { const unsigned old = __hip_atomic_fetch_add(g + 16 * (1 + xcc), 1u, __ATOMIC_RELAXED, __HIP_MEMORY_SCOPE_AGENT);
            if (old + 1u == nloc * (unsigned)(l + 1)) { __builtin_amdgcn_fence(__ATOMIC_RELEASE, "agent"); asm volatile("s_waitcnt vmcnt(0)" ::: "memory");
                __hip_atomic_fetch_add(g, nloc, __ATOMIC_RELAXED, __HIP_MEMORY_SCOPE_AGENT); } }
        else { __builtin_amdgcn_fence(__ATOMIC_RELEASE, "agent"); asm volatile("s_waitcnt vmcnt(0)" ::: "memory"); __hip_atomic_fetch_add(g, 1u, __ATOMIC_RELAXED, __HIP_MEMORY_SCOPE_AGENT); }
    }
#endif
}
__device__ __forceinline__ void stage_wait(const Params& p, int flag, int l) {
    if (otid() == 0) { const unsigned target = (unsigned)gridDim.x * (unsigned)(l + 1);
#ifdef EMU
        while (*(volatile unsigned*)stage_counter(p, flag) < target) emu::yield();
#else
        unsigned spins = 0;
        while (__hip_atomic_load(stage_counter(p, flag), __ATOMIC_RELAXED, __HIP_MEMORY_SCOPE_AGENT) < target) { __builtin_amdgcn_s_sleep(16); if (++spins > (1u << 20)) break; }
        __builtin_amdgcn_fence(__ATOMIC_ACQUIRE, "agent"); asm volatile("s_waitcnt vmcnt(0)" ::: "memory");
#endif
    }
    __syncthreads();
}
__device__ __forceinline__ int logical_row(int i) { return i < NB * SEQ ? (i / SEQ) * TOK + CTXL + i % SEQ : ((i - NB * SEQ) / CTXL) * TOK + (i - NB * SEQ) % CTXL; }
struct RowRef { const float* xo; float* xn; int mj, row; bool ok; };
__device__ __forceinline__ RowRef rp_ref(const Params& p, int l, int li, int base, int hi) {
    RowRef r; r.ok = li < hi; const int rr = logical_row(r.ok ? li : base); r.row = rr;
    const int b = rr / TOK, pp = rr % TOK; const bool isctx = pp < CTXL; if (l == DEPTH && isctx) r.ok = false;
    const size_t off = isctx ? ((size_t)b * CTXL + pp) * DM : ((size_t)b * SEQ + (pp - CTXL)) * DM;
    float* CTXB = (float*)(p.ws + WS_CTXB);
    r.xo = (l <= 1) ? (isctx ? p.in[I_CTX] + off : p.in[I_X] + off) : (isctx ? CTXB + off : p.out + off);
    r.xn = isctx ? CTXB + off : p.out + off; r.mj = isctx ? NB : b; return r;
}
__device__ __forceinline__ void rp_rows(const Params& p, int l, int lo, int hi, int gi, int nb) {
    const int tid = otid(), lane = tid & 63, wave = tid >> 6;
    const float* MOD = (const float*)(p.ws + WS_MOD);
    const bf16* YO = (const bf16*)(p.ws + WS_P);
    bf16* HN = (bf16*)(p.ws + WS_HNY);
    constexpr int NV4 = DM / 256, RW = 2;
    const int stride = nb * 8;
    f32x4 xq[RW][NV4]; u32x2 yq[RW][NV4]; RowRef rq[RW];
    int base = lo + gi * 8 + wave;
    if (base < hi) {
#pragma unroll
        for (int i = 0; i < RW; ++i) { rq[i] = rp_ref(p, l, base + i * stride, base, hi);
#pragma unroll
            for (int j = 0; j < NV4; ++j) { xq[i][j] = *(const f32x4*)(rq[i].xo + 4 * lane + 256 * j); yq[i][j] = (l > 0) ? *(const u32x2*)(YO + (size_t)rq[i].row * DM + 4 * lane + 256 * j) : (u32x2){0u, 0u}; } }
    }
    for (; base < hi; base += stride * RW) {
        f32x4 x[RW][NV4], y[RW][NV4]; RowRef rc[RW];
#pragma unroll
        for (int i = 0; i < RW; ++i) { rc[i] = rq[i];
#pragma unroll
            for (int j = 0; j < NV4; ++j) { x[i][j] = xq[i][j]; const u32x2 yy = yq[i][j]; y[i][j] = (f32x4){bitsf(yy.x << 16), bitsf(yy.x & 0xffff0000u), bitsf(yy.y << 16), bitsf(yy.y & 0xffff0000u)}; } }
        { const int nbase = base + stride * RW;
            if (nbase < hi) {
#pragma unroll
                for (int i = 0; i < RW; ++i) { rq[i] = rp_ref(p, l, nbase + i * stride, nbase, hi);
#pragma unroll
                    for (int j = 0; j < NV4; ++j) { xq[i][j] = *(const f32x4*)(rq[i].xo + 4 * lane + 256 * j); if (l > 0) yq[i][j] = *(const u32x2*)(YO + (size_t)rq[i].row * DM + 4 * lane + 256 * j); } } } }
        if (l > 0) {
            float ss[RW];
#pragma unroll
            for (int i = 0; i < RW; ++i) { ss[i] = 0.f;
#pragma unroll
                for (int j = 0; j < NV4; ++j) ss[i] += y[i][j].x * y[i][j].x + y[i][j].y * y[i][j].y + y[i][j].z * y[i][j].z + y[i][j].w * y[i][j].w; }
#pragma unroll
            for (int i = 0; i < RW; ++i) ss[i] = wave_sum(ss[i]);
            const float* gp = p.in[I_GPOST] + (size_t)(l - 1) * DM;
#pragma unroll
            for (int i = 0; i < RW; ++i) { const float rstd = rsqrtf(ss[i] * (1.0f / DM) + EPS); const float* gt = MOD + ((size_t)(l - 1) * NJ + rc[i].mj) * 3 * DM + 2 * DM;
#pragma unroll
                for (int j = 0; j < NV4; ++j) { const f32x4 g4 = *(const f32x4*)(gt + 4 * lane + 256 * j), p4 = *(const f32x4*)(gp + 4 * lane + 256 * j);
                    x[i][j] = x[i][j] + g4 * (y[i][j] * rstd * p4);
                    if (rc[i].ok) *(f32x4*)(rc[i].xn + 4 * lane + 256 * j) = x[i][j]; } }
        }
        if (l < DEPTH) {
            float ss[RW];
#pragma unroll
            for (int i = 0; i < RW; ++i) { ss[i] = 0.f;
#pragma unroll
                for (int j = 0; j < NV4; ++j) ss[i] += x[i][j].x * x[i][j].x + x[i][j].y * x[i][j].y + x[i][j].z * x[i][j].z + x[i][j].w * x[i][j].w; }
#pragma unroll
            for (int i = 0; i < RW; ++i) ss[i] = wave_sum(ss[i]);
            const float* gp = p.in[I_GPRE] + (size_t)l * DM;
#pragma unroll
            for (int i = 0; i < RW; ++i) { const float rstd = rsqrtf(ss[i] * (1.0f / DM) + EPS); const float* md = MOD + ((size_t)l * NJ + rc[i].mj) * 3 * DM; const int row = rc[i].row;
#pragma unroll
                for (int j = 0; j < NV4; ++j) { const int e = 4 * lane + 256 * j;
                    const f32x4 g4 = *(const f32x4*)(gp + e), sh = *(const f32x4*)(md + e), sc = *(const f32x4*)(md + DM + e);
                    const f32x4 h = (x[i][j] * rstd * g4) * (sc + 1.0f) + sh;
                    u32x2 o; o.x = pk2(h.x, h.y); o.y = pk2(h.z, h.w);
                    if (rc[i].ok) *(u32x2*)(HN + (size_t)row * DM + e) = o; } }
        }
    }
}

__device__ __forceinline__ void convert_tile(const float* src, int ldn, bf16* dst, int K, int n0, int k0, bool use_map, char* smem) {
    const int tid = otid();
    float* tile = (float*)smem;
    __syncthreads();
#pragma unroll
    for (int i = 0; i < 8; ++i) { const int idx = tid + NT * i, k = idx >> 6, n = idx & 63;
        const int oc = use_map ? orig_col(n0 + n) : (n0 + n);
        tile[k * 65 + n] = oc >= 0 ? src[(size_t)(k0 + k) * ldn + oc] : 0.f; }
    __syncthreads();
    const int n = tid >> 3, c = tid & 7;
    u32x4 o; o.x = pk2(tile[(8 * c + 0) * 65 + n], tile[(8 * c + 1) * 65 + n]); o.y = pk2(tile[(8 * c + 2) * 65 + n], tile[(8 * c + 3) * 65 + n]);
    o.z = pk2(tile[(8 * c + 4) * 65 + n], tile[(8 * c + 5) * 65 + n]); o.w = pk2(tile[(8 * c + 6) * 65 + n], tile[(8 * c + 7) * 65 + n]);
    *(u32x4*)(dst + (size_t)(n0 + n) * K + k0 + 8 * c) = o;
}

__device__ __forceinline__ void filter_task(const Params& p, int l, int L, int pos0, char* smem) {
    const int tid = otid(), j = tid & 63;
    float* z = (float*)smem;
    float* h1 = z + 8 * 33;
    float* h2 = h1 + 8 * 64;
    const float* w1 = p.in[I_HW1] + (size_t)l * 33 * 64; const float* w2 = p.in[I_HW2] + (size_t)l * 64 * 64; const float* w3 = p.in[I_HW3] + (size_t)l * 64 * 512;
    float r1[33], r2[64], r3a[16];
#pragma unroll
    for (int i = 0; i < 33; ++i) r1[i] = w1[i * 64 + j];
#pragma unroll
    for (int i = 0; i < 64; ++i) r2[i] = w2[i * 64 + j];
    const float b1 = p.in[I_HB1][l * 64 + j], b2 = p.in[I_HB2][l * 64 + j], b3 = p.in[I_HB3][l * 512 + tid];
    const float f0 = p.in[I_HFREQ][(l * 2 + 0) * 64 + j], f1 = p.in[I_HFREQ][(l * 2 + 1) * 64 + j];
    __syncthreads();
    if (tid < 8 * 33) { const int pp = tid / 33, i = tid % 33; const float pos = (float)(pos0 + pp);
        const float t = pos / (float)(L - 1 > 1 ? L - 1 : 1), wv = 6.283185307179586f * pos / (float)L; float v;
        if (i == 0) v = t; else { const int bi = (i - 1) & 15; const float f = 1e-4f + (float)bi * ((15.0f - 1e-4f) / 15.0f); v = (i <= 16) ? cosf(wv * f) : -sinf(wv * f); }
        z[tid] = v; }
    __syncthreads();
    { const int pp = tid >> 6; float a = b1;
#pragma unroll
        for (int i = 0; i < 33; ++i) a += z[pp * 33 + i] * r1[i];
        h1[tid] = sinf(f0 * a);
#pragma unroll
        for (int i = 0; i < 16; ++i) r3a[i] = w3[i * 512 + tid]; }
    __syncthreads();
    { const int pp = tid >> 6; float a = b2;
#pragma unroll
        for (int i = 0; i < 64; ++i) a += h1[pp * 64 + i] * r2[i];
        h2[tid] = sinf(f1 * a); }
    __syncthreads();
    { const int o = tid, dir = o >> 8, c = o & 255;
        const float delta = 3.0701134573253946f + (float)c * ((15.350567286626973f - 3.0701134573253946f) / 255.0f);
        float acc[8];
#pragma unroll
        for (int pp = 0; pp < 8; ++pp) acc[pp] = b3;
#pragma unroll 1
        for (int cix = 0; cix < 4; ++cix) {
            float wn[16];
#pragma unroll
            for (int i = 0; i < 16; ++i) wn[i] = (cix < 3) ? w3[(16 * (cix + 1) + i) * 512 + o] : 0.f;
#pragma unroll
            for (int i = 0; i < 16; ++i) {
#pragma unroll
                for (int pp = 0; pp < 8; ++pp) acc[pp] += h2[pp * 64 + 16 * cix + i] * r3a[i]; }
#pragma unroll
            for (int i = 0; i < 16; ++i) r3a[i] = wn[i]; }
        float* KT = (float*)(p.ws + WS_KT); float* HC = (float*)(p.ws + WS_HC);
#pragma unroll
        for (int pp = 0; pp < 8; ++pp) { const int pos = pos0 + pp; const float t = (float)pos / (float)(L - 1 > 1 ? L - 1 : 1);
            const float v = acc[pp] * __expf(-t * delta);
            if (L == SEQ) { if (dir == 0) KT[(size_t)c * NF + pos]= v; else if (pos > 0) KT[(size_t)c * NF + (NF - pos)] = v; else KT[(size_t)c * NF + SEQ] = 0.f; }
            else HC[((size_t)dir * WG + c) * CTXL + pos] = v; }
    }
}

__device__ __forceinline__ void convert_tile_w(const float* src, int ldn, bf16* dst, int K, int n0, int k0, bool use_map, char* wl, int lane) {
    float* tile = (float*)wl;
    const int oc = use_map ? orig_col(n0 + lane) : (n0 + lane);
    float v[64];
#pragma unroll
    for (int k = 0; k < 64; ++k) v[k] = oc >= 0 ? src[(size_t)(k0 + k) * ldn + oc] : 0.f;
#pragma unroll
    for (int k = 0; k < 64; ++k) tile[k * 65 + lane] = v[k];
    WAVE_SYNC();
#pragma unroll
    for (int i = 0; i < 8; ++i) { const int n = (lane >> 3) + 8 * i, c = lane & 7; float f[8];
#pragma unroll
        for (int j = 0; j < 8; ++j) f[j] = tile[(8 * c + j) * 65 + n];
        *(u32x4*)(dst + (size_t)(n0 + n) * K + k0 + 8 * c) = pack8(f); }
    WAVE_SYNC();
}
__device__ __forceinline__ void layer_prep(const Params& p, int l, int idx, int stride, char* smem) {
    constexpr int N_WIN = (NPAD / 64) * (DM / 64), N_FL = SEQ / 8, N_FC = CTXL / 8;
    for (int task = idx; task < N_FL + N_FC; task += stride) {
        if (task < N_FL) filter_task(p, l, SEQ, task * 8, smem);
        else filter_task(p, l, CTXL, (task - N_FL) * 8, smem);
    }
    __syncthreads();
    { const int tid = otid(), lane = tid & 63, wave = __builtin_amdgcn_readfirstlane(tid >> 6);
        char* wl = smem + wave * WLDS;
        for (int task = wave * stride + idx; task < N_WIN; task += 8 * stride) { const int nt = task / (DM / 64), kt = task % (DM / 64);
            convert_tile_w(p.in[I_WIN] + (size_t)l * DM * N_IN, N_IN, (bf16*)(p.ws + WS_WIN), DM, nt * 64, kt * 64, true, wl, lane); } }
}
__device__ __forceinline__ unsigned* row_queue(const Params& p, int l) { return (unsigned*)(p.ws + WS_BAR + 16384) + 2560 + 64 * l; }
__device__ __forceinline__ void wait_units(const Params& p, int c, int l) {
    constexpr int nLatU = NB * (SEQ / PANEL_ROWS) * PANEL_UNITS, nCtxU = NB * (CTXL / PANEL_ROWS) * PANEL_UNITS;
    const unsigned target = (unsigned)((c ? nCtxU : nLatU) * l);
#ifdef EMU
    while (*(volatile unsigned*)unit_counter(p, c) < target) emu::yield();
#else
    unsigned spins = 0;
    while (__hip_atomic_load(unit_counter(p, c), __ATOMIC_RELAXED, __HIP_MEMORY_SCOPE_AGENT) < target) { __builtin_amdgcn_s_sleep(16); if (++spins > (1u << 20)) break; }
    __builtin_amdgcn_fence(__ATOMIC_ACQUIRE, "agent"); asm volatile("s_waitcnt vmcnt(0)" ::: "memory");
#endif
}
__device__ __forceinline__ void phase_rp(const Params& p, int l, char* smem) { const int G = (int)gridDim.x, bid = obid(), tid = otid();
    const bool has_ctx = l < DEPTH;
    constexpr int nLatU = NB * (SEQ / PANEL_ROWS) * PANEL_UNITS, nCtxU = NB * (CTXL / PANEL_ROWS) * PANEL_UNITS;
    const int nU = nLatU + nCtxU;
    const int heavy = (l >= 1 && has_ctx && nU > G && (nU % G) != 0) ? nU % G : 0;
    const int total = heavy > 0 ? NB * SEQ : (has_ctx ? T : NB * SEQ);
    const int nl = G - heavy, np = (l < DEPTH) ? nl / 2 : 0, nr = nl - np;
    int lo, hi, gi, nb; bool prep = false;
    if (bid < heavy) { lo = NB * SEQ; hi = T; gi = bid; nb = heavy; }
    else { const int i = bid - heavy; int nR = total;
        if (np > 0) { nR = ((total * 2 / 3) / (nr * 16)) * (nr * 16); if (nR <= 0) nR = total / 2; }
        if (np > 0 && (i & 1) && i / 2 < np) { prep = true; lo = nR; hi = total; gi = i / 2; nb = np; }
        else { lo = 0; hi = nR; gi = (np > 0) ? (i + 1) / 2 : i; nb = nr; } }
    if (prep) layer_prep(p, l, gi, np, smem);
    else if (l < DEPTH && np == 0) layer_prep(p, l, bid, G, smem);
    if (l >= 1) { if (tid == 0) { if (lo < NB * SEQ) wait_units(p, 0, l); if (hi > NB * SEQ) wait_units(p, 1, l); } __syncthreads(); }
    rp_rows(p, l, lo, hi, gi, nb);
}

__device__ __forceinline__ cpx cmul(cpx a, cpx b) { cpx r; r.x = a.x * b.x - a.y * b.y; r.y = a.x * b.y + a.y * b.x; return r; }
__device__ __forceinline__ cpx cmulc(cpx a, cpx b) { cpx r; r.x = a.x * b.x + a.y * b.y; r.y = a.y * b.x - a.x * b.y; return r; }
constexpr int fpad(int i) { return i + (i >> 4); }
__device__ __forceinline__ int FPH(int i) { return i + (i >> 4); }
constexpr int FBUF = fpad(NF);
constexpr int ilog16(int n) { return n < 16 ? 0 : 1 + ilog16(n / 16); }
constexpr int FFT_P16 = ilog16(NF);
constexpr bool FFT_R4 = ((NF >> (4 * FFT_P16)) == 4);
static_assert((NF >> (4 * FFT_P16)) == 1 || (NF >> (4 * FFT_P16)) == 4, "NF = 16^a * (1 or 4)");
template <bool INV> __device__ __forceinline__ void dft4(cpx& a0, cpx& a1, cpx& a2, cpx& a3) {
    const cpx s = {a0.x + a2.x, a0.y + a2.y}, b = {a0.x - a2.x, a0.y - a2.y}, c = {a1.x + a3.x, a1.y + a3.y}, d = {a1.x - a3.x, a1.y - a3.y};
    a0 = (cpx){s.x + c.x, s.y + c.y}; a2 = (cpx){s.x - c.x, s.y - c.y};
    if (!INV) { a1 = (cpx){b.x + d.y, b.y - d.x}; a3 = (cpx){b.x - d.y, b.y + d.x}; }
    else      { a1 = (cpx){b.x - d.y, b.y + d.x}; a3 = (cpx){b.x + d.y, b.y - d.x}; }
}
template <bool INV> __device__ __forceinline__ cpx cmulk(cpx a, float wr, float wi) {
    cpx r; if (!INV) { r.x = a.x * wr + a.y * wi; r.y = a.y * wr - a.x * wi; } else { r.x = a.x * wr - a.y * wi; r.y = a.y * wr + a.x * wi; } return r;
}
template <bool INV> __device__ __forceinline__ void dft16(cpx (&x)[16]) {
    constexpr float C1 = 0.92387953251128674f, S1 = 0.38268343236508977f, C2 = 0.70710678118654752f;
#pragma unroll
    for (int n2 = 0; n2 < 4; ++n2) dft4<INV>(x[n2], x[4 + n2], x[8 + n2], x[12 + n2]);
    x[4 * 1 + 1] = cmulk<INV>(x[4 * 1 + 1], C1, S1); x[4 * 1 + 2] = cmulk<INV>(x[4 * 1 + 2], C2, C2); x[4 * 1 + 3] = cmulk<INV>(x[4 * 1 + 3], S1, C1);
    x[4 * 2 + 1] = cmulk<INV>(x[4 * 2 + 1], C2, C2); x[4 * 2 + 2] = cmulk<INV>(x[4 * 2 + 2], 0.f, 1.f); x[4 * 2 + 3] = cmulk<INV>(x[4 * 2 + 3], -C2, C2);
    x[4 * 3 + 1] = cmulk<INV>(x[4 * 3 + 1], S1, C1); x[4 * 3 + 2] = cmulk<INV>(x[4 * 3 + 2], -C2, C2); x[4 * 3 + 3] = cmulk<INV>(x[4 * 3 + 3], -C1, -S1);
#pragma unroll
    for (int k1 = 0; k1 < 4; ++k1) dft4<INV>(x[4 * k1 + 0], x[4 * k1 + 1], x[4 * k1 + 2], x[4 * k1 + 3]);
    cpx t;
    t = x[1]; x[1] = x[4]; x[4] = t; t = x[2]; x[2] = x[8]; x[8] = t; t = x[3]; x[3] = x[12]; x[12] = t;
    t = x[6]; x[6] = x[9]; x[9] = t; t = x[7]; x[7] = x[13]; x[13] = t; t = x[11]; x[11] = x[14]; x[14] = t;
}
template <bool INV> __device__ __forceinline__ void fft_stage16(cpx* buf, const cpx* TW, int tl, int M) {
    const int span = M >> 4, twm = NF / M;
#pragma unroll 1
    for (int j = tl; j < NF / 16; j += 256) {
        const int grp = j / span, pos = j % span, base = grp * M + pos; cpx x[16];
#pragma unroll
        for (int q = 0; q < 16; ++q) x[q] = buf[FPH(base + q * span)];
        cpx w1 = {1.f, 0.f}; if (span > 1) w1 = TW[pos * twm];
        if (INV && span > 1) { cpx wk = w1;
#pragma unroll
            for (int k = 1; k < 16; ++k) { x[k] = cmulc(x[k], wk); wk = cmul(wk, w1); } }
        dft16<INV>(x);
        if (!INV && span > 1) { cpx wk = w1;
#pragma unroll
            for (int k = 1; k < 16; ++k) { x[k] = cmul(x[k], wk); wk = cmul(wk, w1); } }
#pragma unroll
        for (int q = 0; q < 16; ++q) buf[FPH(base + q * span)] = x[q];
    }
}
template <bool INV> __device__ __forceinline__ void fft_stage4_last(cpx* buf, int tl) {
#pragma unroll 1
    for (int j = tl; j < NF / 4; j += 256) { cpx a0 = buf[FPH(4 * j)], a1 = buf[FPH(4 * j + 1)], a2 = buf[FPH(4 * j + 2)], a3 = buf[FPH(4 * j + 3)];
        dft4<INV>(a0, a1, a2, a3); buf[FPH(4 * j)] = a0; buf[FPH(4 * j + 1)] = a1; buf[FPH(4 * j + 2)] = a2; buf[FPH(4 * j + 3)] = a3; }
}
__device__ __forceinline__ void fft_fwd(cpx* buf, const cpx* TW, int tl) {
    int M = NF;
#pragma unroll
    for (int s = 0; s < FFT_P16; ++s) { __syncthreads(); fft_stage16<false>(buf, TW, tl, M); M >>= 4; }
    if (FFT_R4) { __syncthreads(); fft_stage4_last<false>(buf, tl); }
    __syncthreads();
}
__device__ __forceinline__ void fft_inv(cpx* buf, const cpx* TW, int tl) {
    if (FFT_R4) { __syncthreads(); fft_stage4_last<true>(buf, tl); }
    int M = FFT_R4 ? 64 : 16;
#pragma unroll
    for (int s = 0; s < FFT_P16; ++s) { __syncthreads(); fft_stage16<true>(buf, TW, tl, M); M <<= 4; }
    __syncthreads();
}
__device__ __forceinline__ void filt_fft_task(const Params& p, int cp, char* smem) {
    const int tid = otid(), half = tid >> 8, tl = tid & 255, c = 2 * cp + half;
    cpx* buf = (cpx*)smem + (size_t)half * FBUF;
    const float* KT = (const float*)(p.ws + WS_KT) + (size_t)c * NF;
    cpx* KF = (cpx*)(p.ws + WS_KF) + (size_t)c * NF;
    const cpx* TW = (const cpx*)(p.ws + WS_TW);
    __syncthreads();
    for (int i = tl; i < NF; i += 256) { cpx v; v.x = KT[i]; v.y = 0.f; buf[FPH(i)] = v; }
    fft_fwd(buf, TW, tl);
    for (int i = tl; i < NF; i += 256) KF[i] = buf[FPH(i)];
}

__device__ __forceinline__ void gemm_tile(const Params& p, const bf16* A, const bf16* Bt, int K, int mt, int nt, int mode, char* smem) {
    const int tid = otid(), lane = tid & 63, wave = tid >> 6;
    bf16* As = (bf16*)smem;
    bf16* Bs = As + 128 * LS;
    const int wm = (wave & 3) * 32, wn = (wave >> 2) * 64;
    f32x4 acc[2][4];
#pragma unroll
    for (int i = 0; i < 2; ++i)
#pragma unroll
        for (int j = 0; j < 4; ++j) acc[i][j] = (f32x4){0.f, 0.f, 0.f, 0.f};
    const int lr = tid >> 3, lc = tid & 7;
    const bf16* Ag = A + (size_t)(mt * 128 + lr) * K + lc * 8;
    const bf16* Bg = Bt + (size_t)(nt * 128 + lr) * K + lc * 8;
    u32x4 ra0, ra1, rb0, rb1;
    ra0 = *(const u32x4*)(Ag); ra1 = *(const u32x4*)(Ag + (size_t)64 * K); rb0 = *(const u32x4*)(Bg); rb1 = *(const u32x4*)(Bg + (size_t)64 * K);
    const int nk = K / 64;
    for (int kt = 0; kt < nk; ++kt) {
        __syncthreads();
        *(u32x4*)(As + lr * LS + lc * 8) = ra0; *(u32x4*)(As + (lr + 64) * LS + lc * 8) = ra1;
        *(u32x4*)(Bs + lr * LS + lc * 8) = rb0; *(u32x4*)(Bs + (lr + 64) * LS + lc * 8) = rb1;
        __syncthreads();
        if (kt + 1 < nk) { const int ko = (kt + 1) * 64;
            ra0 = *(const u32x4*)(Ag + ko); ra1 = *(const u32x4*)(Ag + (size_t)64 * K + ko); rb0 = *(const u32x4*)(Bg + ko); rb1 = *(const u32x4*)(Bg + (size_t)64 * K + ko); }
        mma_nt<4, 2>(As, LS, wm, Bs, LS, wn, acc[0], lane);
        mma_nt<4, 2>(As, LS, wm + 16, Bs, LS, wn, acc[1], lane);
    }
    const int r = lane & 15, q = lane >> 4;
#pragma unroll
    for (int i = 0; i < 2; ++i)
#pragma unroll
        for (int j = 0; j < 4; ++j)
#pragma unroll
            for (int e = 0; e < 4; ++e) {
                const int row = mt * 128 + wm + 16 * i + 4 * q + e, col = nt * 128 + wn + 16 * j + r; const float v = acc[i][j][e];
                if (mode == 0) { if (col < NP) ((bf16*)(p.ws + WS_P))[(size_t)row * NP + col] = f2bf(v); else if (col < NP + 16) ((float*)(p.ws + WS_G))[(size_t)row * NGS + (col - NP)] = v; else if (col < NP + NG) ((bf16*)((float*)(p.ws + WS_G) + (size_t)row * NGS + 16))[col - NP - 16] = f2bf(v); }
                else if (mode == 2) ((bf16*)(p.ws + WS_HT))[(size_t)row * T + col] = f2bf(v);
                else ((bf16*)(p.ws + WS_P))[(size_t)row * DM + col] = f2bf(v);
            }
}

#ifndef EMU
namespace pg8 {
#define PG8_LAS __attribute__((address_space(3)))
typedef unsigned short bf16_t;
typedef short bf16x8 __attribute__((ext_vector_type(8)));
typedef float f32x4 __attribute__((ext_vector_type(4)));
typedef unsigned u32x4 __attribute__((ext_vector_type(4)));
constexpr int BM = 256, BK = 64, HALF = 128, HTB = HALF * BK * 2  , STAGE_BYTES = 8 * HTB, NXCD = 8, WGM = 8;

__host__ __device__ __forceinline__ int lds_byte(int r, int c) { const int st = (r >> 4) * 2 + (c >> 5), rr = r & 15, cc = c & 31, ob = rr * 64 + cc * 2; return st * 1024 + (ob ^ (((ob >> 9) & 1) << 5)); }
__host__ __device__ __forceinline__ void stage_rc(int b, int& R, int& C) { const int st = b / 1024, sb = b % 1024, swz = sb ^ (((sb >> 9) & 1) << 5); R = (st >> 1) * 16 + swz / 64; C = (st & 1) * 32 + (swz % 64) / 2; }
__host__ __device__ __forceinline__ int perm32(int rho) { const int n = rho >> 4, i = rho & 15; return 8 * (i >> 2) + 4 * n + (i & 3); }

struct Unit { int pm, pn; };
struct Gemm { const bf16_t* A; const bf16_t* Bt; int M, N, K; };
__device__ __forceinline__ unsigned cvt_pk_bf16(float lo, float hi) { unsigned r; asm volatile("v_cvt_pk_bf16_f32 %0, %1, %2" : "=v"(r) : "v"(lo), "v"(hi)); return r; }
template <class Epi, class Sched, bool ALIGN_EPI = false, bool SP2 = false>
__device__ __forceinline__ void gemm_phase(PG8_LAS unsigned char* lds, const Gemm g, const Sched& S, const Epi& E) {
    const int tid = otid(), wid = __builtin_amdgcn_readfirstlane(tid >> 6), lane = tid & 63, wr = wid >> 2, wc = wid & 3, fr = lane & 15, fq = lane >> 4;
    const int K = g.K, nt = K / BK;
    unsigned voffA[2], voffB[2];
#pragma unroll
    for (int i = 0; i < 2; ++i) { int R, C; stage_rc(tid * 16 + i * 8192, R, C); const int Rb = Epi::PERM ? ((R & ~31) + perm32(R & 31)) : R;
        voffA[i] = (unsigned)(R * K + C) * 2u; voffB[i] = (unsigned)(Rb * K + C) * 2u; }
    const size_t kstep = (size_t)(BK * 2);
    const size_t hstep = (size_t)HALF * K * 2;
    const size_t tstep = 2 * hstep;
    const unsigned ldsw = (unsigned)wid * 1024u;
    const int aoff = lds_byte(wr * 64 + fr, fq * 8), boff = lds_byte(wc * 32 + fr, fq * 8);
#define PG8_SA(b, h) (((b) * 2 + (h)) * HTB)
#define PG8_SB(b, h) ((4 + (b) * 2 + (h)) * HTB)
#define PG8_STAGE(bufoff, gbase, voff) do { _Pragma("unroll") for (int _i = 0; _i < 2; ++_i) \
        __builtin_amdgcn_global_load_lds((const unsigned*)((const char*)(gbase) + (voff)[_i]), (PG8_LAS unsigned*)(lds + (bufoff) + ldsw + _i * 8192), 16, 0, 0); } while (0)
#define PG8_LDA(dst, b, h) do { _Pragma("unroll") for (int m = 0; m < 4; ++m) _Pragma("unroll") for (int k = 0; k < 2; ++k) dst[m][k] = *(const PG8_LAS bf16x8*)(lds + PG8_SA(b, h) + aoff + m * 2048 + k * 1024); } while (0)
#define PG8_LDB(dst, b, h) do { _Pragma("unroll") for (int n = 0; n < 2; ++n) _Pragma("unroll") for (int k = 0; k < 2; ++k) dst[n][k] = *(const PG8_LAS bf16x8*)(lds + PG8_SB(b, h) + boff + n * 2048 + k * 1024); } while (0)
#define PG8_MMA(ai, bj, At, Bt) do { __builtin_amdgcn_s_setprio(1); _Pragma("unroll") for (int m = 0; m < 4; ++m) _Pragma("unroll") for (int n = 0; n < 2; ++n) _Pragma("unroll") for (int k = 0; k < 2; ++k) \
        acc[ai][bj][m][n] = __builtin_amdgcn_mfma_f32_16x16x32_bf16(Bt[n][k], At[m][k], acc[ai][bj][m][n], 0, 0, 0); __builtin_amdgcn_s_setprio(0); } while (0)
#define PG8_WAIT_V(n) asm volatile("s_waitcnt vmcnt(" #n ")" ::: "memory")
#define PG8_WAIT_L(n) asm volatile("s_waitcnt lgkmcnt(" #n ")" ::: "memory")
#define PG8_BAR __builtin_amdgcn_s_barrier()
#define PG8_SCHED __builtin_amdgcn_sched_barrier(0)
    Unit cur, nxt; int ui = 0;
    if (!S.next(0, cur)) return;
    f32x4 acc[2][2][4][2];
#pragma unroll
    for (int a = 0; a < 2; ++a)
#pragma unroll
        for (int b = 0; b < 2; ++b)
#pragma unroll
            for (int m = 0; m < 4; ++m)
#pragma unroll
                for (int n = 0; n < 2; ++n) acc[a][b][m][n] = (f32x4){0.f, 0.f, 0.f, 0.f};
    bf16x8 At[4][2], B0[2][2], B1[2][2];
    const char* cA = (const char*)g.A + (size_t)cur.pm * tstep; const char* cB = (const char*)g.Bt + (size_t)cur.pn * tstep;
    S.a_ready(cur);
    if constexpr (SP2) {
        PG8_STAGE(PG8_SB(0, 0), cB, voffB); PG8_STAGE(PG8_SB(0, 1), cB + hstep, voffB); PG8_STAGE(PG8_SA(0, 0), cA, voffA); PG8_STAGE(PG8_SA(0, 1), cA + hstep, voffA);
        if (wr == 1) PG8_BAR;
        PG8_WAIT_V(2); PG8_BAR;
        PG8_STAGE(PG8_SB(1, 0), cB + kstep, voffB); PG8_STAGE(PG8_SA(1, 0), cA + kstep, voffA); PG8_STAGE(PG8_SB(1, 1), cB + hstep + kstep, voffB);
        PG8_WAIT_V(6); PG8_BAR;
    } else {
        PG8_STAGE(PG8_SB(0, 0), cB, voffB); PG8_STAGE(PG8_SA(0, 0), cA, voffA); PG8_STAGE(PG8_SB(0, 1), cB + hstep, voffB); PG8_STAGE(PG8_SA(0, 1), cA + hstep, voffA);
        if (wr == 1) PG8_BAR;
        PG8_WAIT_V(4); PG8_BAR;
        PG8_STAGE(PG8_SB(1, 0), cB + kstep, voffB); PG8_STAGE(PG8_SA(1, 0), cA + kstep, voffA); PG8_STAGE(PG8_SB(1, 1), cB + hstep + kstep, voffB);
        PG8_WAIT_V(6); PG8_BAR;
    }
    for (;;) {
        const bool has_next = S.next(ui + 1, nxt);
        const char* nA = has_next ? (const char*)g.A + (size_t)nxt.pm * tstep : cA; const char* nB = has_next ? (const char*)g.Bt + (size_t)nxt.pn * tstep : cB;
        for (int t = 0; t < nt; t += 2) {
            const bool last = (t == nt - 2);
            const char* a1 = cA + (size_t)(t + 1) * kstep;
            const char* a2 = last ? nA : cA + (size_t)(t + 2) * kstep; const char* b2 = last ? nB : cB + (size_t)(t + 2) * kstep;
            const char* a3 = a2 + kstep; const char* b3 = b2 + kstep;
            if (last && has_next) S.a_ready(nxt);
            if constexpr (SP2) {
            PG8_LDB(B0, 0, 0); PG8_LDB(B1, 0, 1); PG8_SCHED; PG8_LDA(At, 0, 0); PG8_STAGE(PG8_SA(1, 1), a1 + hstep, voffA);
            PG8_WAIT_V(8); PG8_WAIT_L(0); PG8_BAR; PG8_MMA(0, 0, At, B0); PG8_MMA(0, 1, At, B1); PG8_BAR; PG8_SCHED;
            PG8_LDA(At, 0, 1); PG8_STAGE(PG8_SB(0, 0), b2, voffB); PG8_STAGE(PG8_SB(0, 1), b2 + hstep, voffB); PG8_STAGE(PG8_SA(0, 0), a2, voffA);
            PG8_WAIT_V(8); PG8_WAIT_L(0); PG8_BAR; PG8_MMA(1, 0, At, B0); PG8_MMA(1, 1, At, B1); PG8_BAR; PG8_SCHED;
            PG8_LDB(B0, 1, 0); PG8_LDB(B1, 1, 1); PG8_SCHED; PG8_LDA(At, 1, 0); PG8_STAGE(PG8_SA(0, 1), a2 + hstep, voffA);
            PG8_WAIT_V(8); PG8_WAIT_L(0); PG8_BAR; PG8_MMA(0, 0, At, B0); PG8_MMA(0, 1, At, B1); PG8_BAR; PG8_SCHED;
            PG8_LDA(At, 1, 1); PG8_STAGE(PG8_SB(1, 0), b3, voffB); PG8_STAGE(PG8_SB(1, 1), b3 + hstep, voffB); PG8_STAGE(PG8_SA(1, 0), a3, voffA);
            PG8_WAIT_V(8); PG8_WAIT_L(0); PG8_BAR; PG8_MMA(1, 0, At, B0); PG8_MMA(1, 1, At, B1); PG8_BAR; PG8_SCHED;
            } else {
            PG8_LDB(B0, 0, 0); PG8_SCHED; PG8_LDA(At, 0, 0); PG8_STAGE(PG8_SA(1, 1), a1 + hstep, voffA);
            PG8_WAIT_L(8); PG8_BAR; PG8_WAIT_L(0); PG8_MMA(0, 0, At, B0); PG8_BAR; PG8_SCHED;
            PG8_LDB(B1, 0, 1); PG8_STAGE(PG8_SB(0, 0), b2, voffB);
            PG8_BAR; PG8_WAIT_L(0); PG8_MMA(0, 1, At, B1); PG8_BAR;
            PG8_LDA(At, 0, 1); PG8_STAGE(PG8_SA(0, 0), a2, voffA);
            PG8_BAR; PG8_WAIT_L(0); PG8_MMA(1, 0, At, B0); PG8_BAR; PG8_SCHED;
            PG8_STAGE(PG8_SB(0, 1), b2 + hstep, voffB);
            PG8_WAIT_V(6); PG8_BAR; PG8_MMA(1, 1, At, B1); PG8_BAR;
            PG8_LDB(B0, 1, 0); PG8_SCHED; PG8_LDA(At, 1, 0); PG8_STAGE(PG8_SA(0, 1), a2 + hstep, voffA);
            PG8_WAIT_L(8); PG8_BAR; PG8_WAIT_L(0); PG8_MMA(0, 0, At, B0); PG8_BAR; PG8_SCHED;
            PG8_LDB(B1, 1, 1); PG8_STAGE(PG8_SB(1, 0), b3, voffB);
            PG8_BAR; PG8_WAIT_L(0); PG8_MMA(0, 1, At, B1); PG8_BAR;
            PG8_LDA(At, 1, 1); PG8_STAGE(PG8_SA(1, 0), a3, voffA);
            PG8_BAR; PG8_WAIT_L(0); PG8_MMA(1, 0, At, B0); PG8_BAR; PG8_SCHED;
            PG8_STAGE(PG8_SB(1, 1), b3 + hstep, voffB);
            PG8_WAIT_V(6); PG8_BAR; PG8_MMA(1, 1, At, B1); PG8_BAR;
            }
        }
        if constexpr (ALIGN_EPI) { if (wr == 0) PG8_BAR; }
        if constexpr (!Epi::AFTER_DRAIN) { E(acc, cur, wr, wc, fr, fq); S.done(cur); }
        if (!has_next) break;
#pragma unroll
        for (int a = 0; a < 2; ++a)
#pragma unroll
            for (int b = 0; b < 2; ++b)
#pragma unroll
                for (int m = 0; m < 4; ++m)
#pragma unroll
                    for (int n = 0; n < 2; ++n) acc[a][b][m][n] = (f32x4){0.f, 0.f, 0.f, 0.f};
        cur = nxt; cA = nA; cB = nB; ++ui;
        if constexpr (ALIGN_EPI) { if (wr == 1) PG8_BAR; }
    }
    PG8_WAIT_V(0);
    if constexpr (!ALIGN_EPI) { if (wr == 0) PG8_BAR; }
    PG8_BAR;
    if constexpr (Epi::AFTER_DRAIN) { E.fused(acc, cur, wr, wc, fr, fq, lds, wid, lane); S.done(cur); }
#undef PG8_SA
#undef PG8_SB
#undef PG8_STAGE
#undef PG8_LDA
#undef PG8_LDB
#undef PG8_MMA
#undef PG8_WAIT_V
#undef PG8_WAIT_L
#undef PG8_BAR
#undef PG8_SCHED
}
__device__ __forceinline__ void map_tile(int L, int nM, int nN, int& pm, int& pn) {
    const int nwg = nM * nN; int wgid = L; { const int q = nwg / NXCD, r = nwg % NXCD, xcd = wgid % NXCD, off = wgid / NXCD; wgid = (xcd < r ? xcd * (q + 1) : r * (q + 1) + (xcd - r) * q) + off; }
    const int nig = WGM * nN, gid = wgid / nig, fm = gid * WGM, gsz = (nM - fm) < WGM ? (nM - fm) : WGM;
    pm = fm + ((wgid % nig) % gsz); pn = (wgid % nig) / gsz;
}
constexpr int MP = T / 256, WP = NMAIN / 256, NU2 = 4 * MP, NU1 = MP * WP;
struct InOrder { int G, c;
    __device__ __forceinline__ bool next(int i, Unit& u) const { const int L = i * G + c; if (L >= NU2 + NU1) return false; int a, b;
        if (L < NU2) { map_tile(L, 4, MP, a, b); u.pm = MP + WP + a; u.pn = b; } else { map_tile(L - NU2, MP, WP, a, b); u.pm = a; u.pn = MP + b; } return true; }
    __device__ __forceinline__ void a_ready(const Unit&) const {}
    __device__ __forceinline__ void done(const Unit&) const {}
};
struct EpiIn { static constexpr bool PERM = true, AFTER_DRAIN = false; bf16_t* P; float* G; bf16_t* HTp;
    __device__ __forceinline__ void operator()(const f32x4 (&acc)[2][2][4][2], const Unit& u, int wr, int wc, int fr, int fq) const {
        if (u.pm < MP) { const int pn = u.pn - MP, row0 = u.pm * BM + wr * 64 + fr;
            if (pn < NP / 256) { const int col0 = pn * BM + wc * 32 + 8 * fq;
#pragma unroll
                for (int ai = 0; ai < 2; ++ai)
#pragma unroll
                    for (int m = 0; m < 4; ++m) { bf16_t* rowp = P + (size_t)(row0 + ai * HALF + m * 16) * NP + col0;
#pragma unroll
                        for (int bj = 0; bj < 2; ++bj) { const f32x4 v0 = acc[ai][bj][m][0], v1 = acc[ai][bj][m][1];
                            u32x4 w; w.x = cvt_pk_bf16(v0[0], v0[1]); w.y = cvt_pk_bf16(v0[2], v0[3]); w.z = cvt_pk_bf16(v1[0], v1[1]); w.w = cvt_pk_bf16(v1[2], v1[3]); *(u32x4*)(rowp + bj * HALF) = w; } } }
            else { const int cb = wc * 32 + 8 * fq;
                if (cb < NG) {
#pragma unroll
                    for (int ai = 0; ai < 2; ++ai)
#pragma unroll
                        for (int m = 0; m < 4; ++m) { float* rowb = G + (size_t)(row0 + ai * HALF + m * 16) * NGS; const f32x4 v0 = acc[ai][0][m][0], v1 = acc[ai][0][m][1];
                            if (cb < 16) { *(f32x4*)(rowb + cb) = v0; *(f32x4*)(rowb + cb + 4) = v1; }
                            else { u32x4 w; w.x = cvt_pk_bf16(v0[0], v0[1]); w.y = cvt_pk_bf16(v0[2], v0[3]); w.z = cvt_pk_bf16(v1[0], v1[1]); w.w = cvt_pk_bf16(v1[2], v1[3]); *(u32x4*)((bf16_t*)(rowb + 16) + (cb - 16)) = w; } } } } }
        else { const int row0 = (u.pm - MP - WP) * BM + wr * 64 + fr, col0 = u.pn * BM + wc * 32 + 8 * fq;
#pragma unroll
            for (int ai = 0; ai < 2; ++ai)
#pragma unroll
                for (int m = 0; m < 4; ++m) { bf16_t* rowp = HTp + (size_t)(row0 + ai * HALF + m * 16) * T + col0;
#pragma unroll
                    for (int bj = 0; bj < 2; ++bj) { const f32x4 v0 = acc[ai][bj][m][0], v1 = acc[ai][bj][m][1];
                        u32x4 w; w.x = cvt_pk_bf16(v0[0], v0[1]); w.y = cvt_pk_bf16(v0[2], v0[3]); w.z = cvt_pk_bf16(v1[0], v1[1]); w.w = cvt_pk_bf16(v1[2], v1[3]); *(u32x4*)(rowp + bj * HALF) = w; } } }
    }
};
struct OutOrder { int G, c; bool lat_only; unsigned* cnt;
    __device__ __forceinline__ bool next(int i, Unit& u) const { constexpr int nN = DM / 256, nLat = NB * (SEQ / 256) * nN, nCtx = NB * (CTXL / 256) * nN; const int L = i * G + c; int a, b;
        if (L < nLat) { map_tile(L, nLat / nN, nN, a, b); u.pm = (a / (SEQ / 256)) * (TOK / 256) + CTXL / 256 + a % (SEQ / 256); }
        else { if (lat_only || L >= nLat + nCtx) return false; map_tile(L - nLat, nCtx / nN, nN, a, b); u.pm = (a / (CTXL / 256)) * (TOK / 256) + a % (CTXL / 256); }
        u.pn = b; return true; }
    __device__ __forceinline__ void a_ready(const Unit&) const {}
    unsigned* xu; unsigned nloc, xtarget;
    __device__ __forceinline__ void done(const Unit& u) const {
        asm volatile("s_waitcnt vmcnt(0)" ::: "memory"); __builtin_amdgcn_s_barrier();
        if (threadIdx.x == 0) { const bool isctx = (u.pm % (TOK / 256)) < CTXL / 256;
            if (!isctx && xtarget != 0u) {
                const unsigned old = __hip_atomic_fetch_add(xu, 1u, __ATOMIC_RELAXED, __HIP_MEMORY_SCOPE_AGENT);
                if (old + 1u == xtarget) { __builtin_amdgcn_fence(__ATOMIC_RELEASE, "agent"); asm volatile("s_waitcnt vmcnt(0)" ::: "memory");
                    __hip_atomic_fetch_add(cnt, nloc, __ATOMIC_RELAXED, __HIP_MEMORY_SCOPE_AGENT); } }
            else { __builtin_amdgcn_fence(__ATOMIC_RELEASE, "agent"); asm volatile("s_waitcnt vmcnt(0)" ::: "memory");
                __hip_atomic_fetch_add(cnt + (isctx ? 64 : 0), 1u, __ATOMIC_RELAXED, __HIP_MEMORY_SCOPE_AGENT); } } }
};
struct EpiOut { static constexpr bool PERM = true, AFTER_DRAIN = false; bf16_t* C;
    __device__ __forceinline__ void operator()(const f32x4 (&acc)[2][2][4][2], const Unit& u, int wr, int wc, int fr, int fq) const {
        const int row0 = u.pm * BM + wr * 64 + fr, col0 = u.pn * BM + wc * 32 + 8 * fq;
#pragma unroll
        for (int ai = 0; ai < 2; ++ai)
#pragma unroll
            for (int m = 0; m < 4; ++m) { bf16_t* rowp = C + (size_t)(row0 + ai * HALF + m * 16) * DM + col0;
#pragma unroll
                for (int bj = 0; bj < 2; ++bj) { const f32x4 v0 = acc[ai][bj][m][0], v1 = acc[ai][bj][m][1];
                    u32x4 w; w.x = cvt_pk_bf16(v0[0], v0[1]); w.y = cvt_pk_bf16(v0[2], v0[3]); w.z = cvt_pk_bf16(v1[0], v1[1]); w.w = cvt_pk_bf16(v1[2], v1[3]); *(u32x4*)(rowp + bj * HALF) = w; } }
    }
};
}
#endif

__device__ __forceinline__ void phase_gemm_in(const Params& p, int l, char* smem) {
    constexpr int N_F = WG / 2;
#ifdef EMU
    constexpr int MT = T / 128, NT1 = NMAIN / 128, N1 = MT * NT1, N2 = 8 * MT;
    for (int task = obid(); task < N1 + N2; task += gridDim.x) {
        if (task < N1) gemm_tile(p, (const bf16*)(p.ws + WS_HNY), (const bf16*)(p.ws + WS_WIN), DM, task / NT1, task % NT1, 0, smem);
        else { const int t2 = task - N1; gemm_tile(p, (const bf16*)(p.ws + WS_WIN) + (size_t)NMAIN * DM, (const bf16*)(p.ws + WS_HNY), DM, t2 / MT, t2 % MT, 2, smem); }
    }
#else
    { const pg8::Gemm g{(const pg8::bf16_t*)(p.ws + WS_HNY), (const pg8::bf16_t*)(p.ws + WS_HNY), 0, 0, DM};
      const pg8::InOrder S{(int)gridDim.x, obid()};
      const pg8::EpiIn E{(pg8::bf16_t*)(p.ws + WS_P), (float*)(p.ws + WS_G), (pg8::bf16_t*)(p.ws + WS_HT)};
      pg8::gemm_phase<pg8::EpiIn, pg8::InOrder, true, true>((PG8_LAS unsigned char*)smem, g, S, E); }
#endif
    { const int G = (int)gridDim.x, bid = obid();
#ifdef EMU
      const int extra = 0;
#else
      const int extra = (pg8::NU1 + pg8::NU2) % G;
#endif
      if (extra > 0 && extra < G) { if (bid >= extra) for (int task = bid - extra; task < N_F; task += G - extra) filt_fft_task(p, task, smem); }
      else for (int task = G - 1 - bid; task < N_F; task += G) filt_fft_task(p, task, smem); }
}
__device__ __forceinline__ void phase_gemm_out(const Params& p, int l, char* smem) {
    const int G = (int)gridDim.x, bid = obid(); const bool has_ctx = l < DEPTH - 1;
#ifdef EMU
    constexpr int MT = T / 128, NTO = DM / 128;
    for (int task = bid; task < MT * NTO; task += G) {
        const int mt = task / NTO, nt = task % NTO;
        if (!has_ctx && (mt % (TOK / 128)) < CTXL / 128) continue;
        gemm_tile(p, (const bf16*)(p.ws + WS_HNY), (const bf16*)(p.ws + WS_WOUT), MIX, mt, nt, 1, smem);
        __syncthreads(); if (otid() == 0) *unit_counter(p, (mt % (TOK / 128)) < CTXL / 128 ? 1 : 0) += 1u;
    }
#else
    const pg8::Gemm g{(const pg8::bf16_t*)(p.ws + WS_HNY), (const pg8::bf16_t*)(p.ws + WS_WOUT), 0, 0, MIX};
    const unsigned xcc = (unsigned)__builtin_amdgcn_s_getreg((3 << 11) | 20) & 0xFu, nloc = ((volatile PG8_LAS unsigned*)(smem + LDS_BYTES - 64))[0];
    const bool agg = (NB * (SEQ / 256) * (DM / 256) == G) && nloc > 0u;
    const pg8::OutOrder S{G, bid, !has_ctx, unit_counter(p, 0), unit_counter(p, 2) + 16 * xcc, nloc, agg ? nloc * (unsigned)(l + 1) : 0u};
    const pg8::EpiOut E{(pg8::bf16_t*)(p.ws + WS_P)};
    pg8::gemm_phase<pg8::EpiOut, pg8::OutOrder, true, true>((PG8_LAS unsigned char*)smem, g, S, E);
#endif
}

__device__ __forceinline__ size_t st_index(int mixer, int dir, int b, int h, int cid) { return ((((size_t)(mixer * 2 + dir) * NB + b) * NH + h) * NCH + cid); }
__device__ __forceinline__ size_t ch_index(int dir, int b, int h, int cid) { return (((size_t)dir * NB + b) * NH + h) * NCH + cid; }

__device__ __forceinline__ void load_tile_nat(const bf16* P, int r0, int c0, bf16* dst, float scale, int tid) {
    const int s = tid >> 3, c8 = tid & 7;
    const u32x4 v = *(const u32x4*)(P + (size_t)(r0 + s) * NP + c0 + c8 * 8);
    if (scale == 1.0f) *(u32x4*)(dst + s * LS + c8 * 8) = v;
    else { float f[8]; unpack8(v, f); u32x4 o; o.x = pk2(f[0] * scale, f[1] * scale); o.y = pk2(f[2] * scale, f[3] * scale); o.z = pk2(f[4] * scale, f[5] * scale); o.w = pk2(f[6] * scale, f[7] * scale);
        *(u32x4*)(dst + s * LS + c8 * 8) = o; }
}
__device__ __forceinline__ void load_tile_tr(const bf16* P, int r0, int c0, bf16* dst, int tid) {
    const int s = tid >> 3, c8 = tid & 7;
    const u32x4 v = *(const u32x4*)(P + (size_t)(r0 + s) * NP + c0 + c8 * 8);
    const unsigned w[4] = {v.x, v.y, v.z, v.w};
#pragma unroll
    for (int j = 0; j < 4; ++j) { dst[(c8 * 8 + 2 * j) * LS + s] = (bf16)(w[j] & 0xffffu); dst[(c8 * 8 + 2 * j + 1) * LS + s] = (bf16)(w[j] >> 16); }
}

template <int NTK>
__device__ __forceinline__ void load_span(const bf16* row, int t0, float (&v)[NTK + 2]) {
    { const bool hl = t0 > 0, hr = t0 + NTK < SEQ; const bf16 xl = row[hl ? -1 : 0], xr = row[hr ? NTK : 0];
        v[0] = hl ? bf2f(xl) : 0.f; v[NTK + 1] = hr ? bf2f(xr) : 0.f; }
    if constexpr (NTK == 8) { float f[8]; unpack8(*(const u32x4*)row, f);
#pragma unroll
        for (int i = 0; i < 8; ++i) v[1 + i] = f[i]; }
    else {
#pragma unroll
        for (int i = 0; i < NTK; ++i) v[1 + i] = bf2f(row[i]); }
}
template <int NTK>
__device__ __forceinline__ void hy_inputs(const bf16* h0, const bf16* h1, const float* cw, const float* cb, int c, int t0, float (&u0)[NTK], float (&u1)[NTK], float (&g0)[NTK], float (&g1)[NTK]) {
    { float xa[NTK + 2], xb[NTK + 2]; load_span<NTK>(h0 + (size_t)512 * T, t0, xa); load_span<NTK>(h1 + (size_t)512 * T, t0, xb);
        const float w0 = cw[0 * 768 + 512 + c], w1 = cw[1 * 768 + 512 + c], w2 = cw[2 * 768 + 512 + c], bb = cb[512 + c];
        float ga[NTK + 2], gb[NTK + 2]; load_span<NTK>(h0 + (size_t)768 * T, t0, ga); load_span<NTK>(h1 + (size_t)768 * T, t0, gb);
#pragma unroll
        for (int i = 0; i < NTK; ++i) { g0[i] = (w0 * xa[i] + w1 * xa[i + 1] + w2 * xa[i + 2] + bb) * siluf_(ga[i + 1]); g1[i] = (w0 * xb[i] + w1 * xb[i + 1] + w2 * xb[i + 2] + bb) * siluf_(gb[i + 1]); } }
    { float va[NTK + 2], vb[NTK + 2], ya[NTK + 2], yb[NTK + 2];
        load_span<NTK>(h0, t0, va); load_span<NTK>(h1, t0, vb); load_span<NTK>(h0 + (size_t)256 * T, t0, ya); load_span<NTK>(h1 + (size_t)256 * T, t0, yb);
        const float v0 = cw[0 * 768 + c], v1 = cw[1 * 768 + c], v2 = cw[2 * 768 + c], vbias = cb[c];
        const float y0 = cw[0 * 768 + 256 + c], y1 = cw[1 * 768 + 256 + c], y2 = cw[2 * 768 + 256 + c], ybias = cb[256 + c];
#pragma unroll
        for (int i = 0; i < NTK; ++i) { u0[i] = (v0 * va[i] + v1 * va[i + 1] + v2 * va[i + 2] + vbias) * (y0 * ya[i] + y1 * ya[i + 1] + y2 * ya[i + 2] + ybias);
            u1[i] = (v0 * vb[i] + v1 * vb[i + 1] + v2 * vb[i + 2] + vbias) * (y0 * yb[i] + y1 * yb[i + 1] + y2 * yb[i + 2] + ybias); } }
}
__device__ __forceinline__ void hylat_task(const Params& p, int l, int bp, int cp, char* smem) {
    const int tid = otid(), half = tid >> 8, tl = tid & 255, c = 2 * cp + half;
    const bf16* HT = (const bf16*)(p.ws + WS_HT); bf16* Y = (bf16*)(p.ws + WS_HNY);
    cpx* buf = (cpx*)smem + (size_t)half * FBUF;
    const cpx* TW = (const cpx*)(p.ws + WS_TW);
    const cpx* KF = (const cpx*)(p.ws + WS_KF) + (size_t)c * NF;
    constexpr int NTK = SEQ / 256;
    const int t0 = NTK * tl;
    const float* cw = p.in[I_HCW] + (size_t)l * 3 * 768; const float* cb = p.in[I_HCB] + (size_t)l * 768;
    const size_t rb0 = (size_t)(2 * bp) * TOK + CTXL, rb1 = rb0 + TOK;
    const bf16* h0 = HT + (size_t)c * T + rb0 + t0; const bf16* h1 = h0 + TOK;
    { float u0[NTK], u1[NTK], g0[NTK], g1[NTK]; hy_inputs<NTK>(h0, h1, cw, cb, c, t0, u0, u1, g0, g1);
        __syncthreads();
#pragma unroll
        for (int i = 0; i < NTK; ++i) { cpx v; v.x = u0[i]; v.y = u1[i]; buf[FPH(t0 + i)] = v; cpx z = {0.f, 0.f}; buf[FPH(SEQ + t0 + i)] = z; } }
    fft_fwd(buf, TW, tl);
#pragma unroll 2
    for (int i = tl; i < NF; i += 256) buf[FPH(i)] = cmul(buf[FPH(i)], KF[i]);
    fft_inv(buf, TW, tl);
    const float dsk = p.in[I_HD][(size_t)l * WG + c]; const float sc = 1.0f / (float)NF;
    { const int tz = otid() & 255; const int t0z = NTK * tz;
        float u0[NTK], u1[NTK], g0[NTK], g1[NTK]; hy_inputs<NTK>(HT + (size_t)c * T + rb0 + t0z, HT + (size_t)c * T + rb0 + t0z + TOK, cw, cb, c, t0z, u0, u1, g0, g1);
        float o0[NTK], o1[NTK];
#pragma unroll
        for (int i = 0; i < NTK; ++i) { const cpx y = buf[FPH(t0z + i)]; o0[i] = g0[i] * (y.x * sc + u0[i] * dsk); o1[i] = g1[i] * (y.y * sc + u1[i] * dsk); }
        bf16* d0 = (bf16*)(p.ws + WS_HT) + (size_t)(768 + c) * T + rb0 + t0z; bf16* d1 = d0 + TOK;
        if constexpr (NTK == 8) { *(u32x4*)d0 = pack8(o0); *(u32x4*)d1 = pack8(o1); }
        else {
#pragma unroll
            for (int i = 0; i < NTK; ++i) { d0[i] = f2bf(o0[i]); d1[i] = f2bf(o1[i]); } } }
}

constexpr int HCB = 16;
__device__ __forceinline__ void hyctx_task(const Params& p, int l, int b, int cblk, char* smem) {
    const int tid = otid(); const int c0 = cblk * HCB;
    const bf16* HT = (const bf16*)(p.ws + WS_HT); bf16* Y = (bf16*)(p.ws + WS_HNY); const float* HC = (const float*)(p.ws + WS_HC);
    float* raw = (float*)smem;
    float* u = raw + 4 * CTXL * HCB;
    float* og = u + CTXL * HCB;
    float* hcm = og + CTXL * HCB;
    bf16* ob = (bf16*)raw;
    const size_t rb = (size_t)b * TOK;
    const float* cw = p.in[I_HCW] + (size_t)l * 3 * 768; const float* cbias = p.in[I_HCB] + (size_t)l * 768;
    constexpr int WT = CTXL / 32;
    __syncthreads();
    for (int i = tid; i < 4 * HCB * (CTXL / 8); i += NT) { const int k = i / (HCB * (CTXL / 8)), cc = (i / (CTXL / 8)) % HCB, ck = i % (CTXL / 8);
        float f[8]; unpack8(*(const u32x4*)(HT + (size_t)(k * 256 + c0 + cc) * T + rb + ck * 8), f);
#pragma unroll
        for (int j = 0; j < 8; ++j) raw[(k * CTXL + ck * 8 + j) * HCB + cc] = f[j]; }
    for (int i = tid; i < 2 * HCB * (CTXL / 4); i += NT) { const int dir = i / (HCB * (CTXL / 4)), cc = (i / (CTXL / 4)) % HCB, pk = i % (CTXL / 4);
        const f32x4 v = *(const f32x4*)(HC + ((size_t)dir * WG + c0 + cc) * CTXL + pk * 4); const float f[4] = {v.x, v.y, v.z, v.w};
#pragma unroll
        for (int j = 0; j < 4; ++j) { const int pos = pk * 4 + j; if (dir == 0) hcm[(CTXL + pos) * HCB + cc] = f[j]; else if (pos > 0) hcm[(CTXL - pos) * HCB + cc] = f[j]; } }
    if (tid < HCB) hcm[tid] = 0.f;
    __syncthreads();
    for (int i = tid; i < CTXL * HCB; i += NT) { const int t = i / HCB, cc = i % HCB; float cv[3];
#pragma unroll
        for (int k = 0; k < 3; ++k) { const float* rk = raw + k * CTXL * HCB; const int ch = k * 256 + c0 + cc;
            const float a = t > 0 ? rk[(t - 1) * HCB + cc] : 0.f, m = rk[t * HCB + cc], z = t < CTXL - 1 ? rk[(t + 1) * HCB + cc] : 0.f;
            cv[k] = cw[0 * 768 + ch] * a + cw[1 * 768 + ch] * m + cw[2 * 768 + ch] * z + cbias[ch]; }
        u[i] = cv[0] * cv[1];
        og[i] = cv[2] * siluf_(raw[(3 * CTXL + t) * HCB + cc]); }
    __syncthreads();
    { const int cc = tid % HCB, tg = tid / HCB, t0 = WT * tg; float acc[WT], w[WT];
#pragma unroll
        for (int j = 0; j < WT; ++j) { acc[j] = 0.f; w[j] = hcm[(t0 + j + CTXL) * HCB + cc]; }
#pragma unroll 8
        for (int s = 0; s < CTXL; ++s) { const float us = u[s * HCB + cc];
#pragma unroll
            for (int j = 0; j < WT; ++j) acc[j] += us * w[j];
#pragma unroll
            for (int j = WT - 1; j > 0; --j) w[j] = w[j - 1];
            w[0] = hcm[(t0 - s - 1 + CTXL) * HCB + cc]; }
        const float dsk = p.in[I_HD][(size_t)l * WG + c0 + cc];
#pragma unroll
        for (int j = 0; j < WT; ++j) { const int t = t0 + j; ob[t * HCB + cc] = f2bf(og[t * HCB + cc] * (acc[j] + u[t * HCB + cc] * dsk)); } }
    __syncthreads();
    for (int i = tid; i < CTXL * 2; i += NT) { const int t = i >> 1, hh = i & 1; *(u32x4*)(Y + (rb + t) * 1024 + YH + c0 + 8 * hh) = *(const u32x4*)(ob + t * HCB + 8 * hh); }
}

__device__ __forceinline__ void attn_task(const Params& p, int l, int b, int kvh, int qt, bool ctxq, char* smem) {
    const int tid = otid(), lane = tid & 63, wave = tid >> 6, r = lane & 15, q = lane >> 4;
    constexpr float QSC = 0.125f * 1.4426950408889634f;
    const bf16* P = (const bf16*)(p.ws + WS_P); bf16* Y = (bf16*)(p.ws + WS_HNY); const cpx* ROPE = (const cpx*)(p.ws + WS_ROPE);
    bf16* Qs = (bf16*)smem;
    bf16* Ks = Qs + 256 * LS;
    constexpr int LSV = 80;
    bf16* Vt = Ks + 64 * LS;
    bf16* Ps = Vt + 64 * LS;
    const size_t rq0 = (size_t)b * TOK + (ctxq ? 0 : CTXL) + qt * 128;
    __syncthreads();
#pragma unroll
    for (int it = 0; it < 2; ++it) {
        const int idx = tid + NT * it, row = idx >> 2, cpair = idx & 3, g = row >> 7, t = row & 127;
        const bf16* src = P + (rq0 + t) * NP + PD + (kvh * 2 + g) * 64;
        float lo[8], hi[8]; unpack8(*(const u32x4*)(src + cpair * 8), lo); unpack8(*(const u32x4*)(src + 32 + cpair * 8), hi);
        float a[8], c2[8];
#pragma unroll
        for (int j = 0; j < 8; ++j) { float cs = 1.f, sn = 0.f; if (!ctxq) { const cpx cv = ROPE[(size_t)(qt * 128 + t) * 32 + cpair * 8 + j]; cs = cv.x; sn = cv.y; }
            a[j] = (lo[j] * cs - hi[j] * sn) * QSC; c2[j] = (hi[j] * cs + lo[j] * sn) * QSC; }
        *(u32x4*)(Qs + row * LS + cpair * 8) = pack8(a); *(u32x4*)(Qs + row * LS + 32 + cpair * 8) = pack8(c2);
    }
    const int lt0 = ctxq ? 0 : (2 * qt - 2 > 0 ? 2 * qt - 2 : 0), lt1 = ctxq ? -1 : (2 * qt + 3 < SEQ / 64 - 1 ? 2 * qt + 3 : SEQ / 64 - 1);
    const int nloc = lt1 - lt0 + 1, ntiles = nloc + NCC;
    float m[2], lsum[2]; f32x4 O[2][4];
#pragma unroll
    for (int ms = 0; ms < 2; ++ms) { m[ms] = -INFINITY; lsum[ms] = 0.f;
#pragma unroll
        for (int i = 0; i < 4; ++i) O[ms][i] = (f32x4){0.f, 0.f, 0.f, 0.f}; }
    const int g = wave >> 2, tq0 = (wave & 3) * 32;
    (void)Ps;
    __syncthreads();
    bf16x8 qf[2][2];
#pragma unroll
    for (int ms = 0; ms < 2; ++ms)
#pragma unroll
        for (int ks = 0; ks < 2; ++ks) qf[ms][ks] = *(const bf16x8*)(Qs + (g * 128 + tq0 + 16 * ms + r) * LS + ks * 32 + q * 8);
    u32x4 klo = {0u, 0u, 0u, 0u}, khi = klo, vq = klo; f32x4 rp[4] = {(f32x4){1.f, 0.f, 1.f, 0.f}, (f32x4){1.f, 0.f, 1.f, 0.f}, (f32x4){1.f, 0.f, 1.f, 0.f}, (f32x4){1.f, 0.f, 1.f, 0.f}};
    const int ks_ = tid >> 2, kcp = tid & 3, vs_ = tid >> 3, vc8 = tid & 7;
#define ATT_PREFETCH(TI) do { const bool loc_ = (TI) < nloc; const int kt_ = loc_ ? lt0 + (TI) : (TI) - nloc; const size_t rk_ = (size_t)b * TOK + (loc_ ? CTXL : 0) + kt_ * 64; \
        if (tid < 256) { const bf16* src_ = P + (rk_ + ks_) * NP + PD + 256 + kvh * 64; klo = *(const u32x4*)(src_ + kcp * 8); khi = *(const u32x4*)(src_ + 32 + kcp * 8); \
            if (loc_) { const f32x4* rr_ = (const f32x4*)(ROPE + (size_t)(kt_ * 64 + ks_) * 32 + kcp * 8); rp[0] = rr_[0]; rp[1] = rr_[1]; rp[2] = rr_[2]; rp[3] = rr_[3]; } \
            else { rp[0] = rp[1] = rp[2] = rp[3] = (f32x4){1.f, 0.f, 1.f, 0.f}; } } \
        vq = *(const u32x4*)(P + (rk_ + vs_) * NP + PD + 384 + kvh * 64 + vc8 * 8); } while (0)
    ATT_PREFETCH(0);
    for (int ti = 0; ti < ntiles; ++ti) {
        const bool local = ti < nloc; const int kt = local ? lt0 + ti : ti - nloc;
        __syncthreads();
        if (tid < 256) { float lo[8], hi[8]; unpack8(klo, lo); unpack8(khi, hi);
            const float cs[8] = {rp[0].x, rp[0].z, rp[1].x, rp[1].z, rp[2].x, rp[2].z, rp[3].x, rp[3].z}, sn[8] = {rp[0].y, rp[0].w, rp[1].y, rp[1].w, rp[2].y, rp[2].w, rp[3].y, rp[3].w};
            float a[8], c2[8];
#pragma unroll
            for (int j = 0; j < 8; ++j) { a[j] = lo[j] * cs[j] - hi[j] * sn[j]; c2[j] = hi[j] * cs[j] + lo[j] * sn[j]; }
            *(u32x4*)(Ks + ks_ * LS + kcp * 8) = pack8(a); *(u32x4*)(Ks + ks_ * LS + 32 + kcp * 8) = pack8(c2); }
        *(u32x4*)(Vt + vs_ * LSV + vc8 * 8) = vq;
        __syncthreads();
        if (ti + 1 < ntiles) ATT_PREFETCH(ti + 1);
        bf16x8 kfr[4][2], vfa[4], vfb[4];
#pragma unroll
        for (int nt = 0; nt < 4; ++nt)
#pragma unroll
            for (int ks = 0; ks < 2; ++ks) kfr[nt][ks] = *(const bf16x8*)(Ks + (16 * nt + r) * LS + ks * 32 + q * 8);
#pragma unroll
        for (int me = 0; me < 4; ++me) { const bf16* vr = Vt + (4 * q + (r >> 2)) * LSV + 16 * me + 4 * (r & 3);
            const u32x2 a0 = lds_tr16(vr), a1 = lds_tr16(vr + 16 * LSV), a2 = lds_tr16(vr + 32 * LSV), a3 = lds_tr16(vr + 48 * LSV);
            u32x4 va; va.x = a0.x; va.y = a0.y; va.z = a1.x; va.w = a1.y; u32x4 vb; vb.x = a2.x; vb.y = a2.y; vb.z = a3.x; vb.w = a3.y; vfa[me] = as_frag(va); vfb[me] = as_frag(vb); }
#pragma unroll
        for (int ms = 0; ms < 2; ++ms) {
            const int qlo = qt * 128 + tq0 + 16 * ms, klo_ = kt * 64;
            if (local && (klo_ > qlo + 15 + 128 || klo_ + 63 < qlo - 128)) continue;
            const bool domask = local && (klo_ + 63 - qlo > 128 || klo_ - (qlo + 15) < -128);
            f32x4 S[4] = {(f32x4){0.f, 0.f, 0.f, 0.f}, (f32x4){0.f, 0.f, 0.f, 0.f}, (f32x4){0.f, 0.f, 0.f, 0.f}, (f32x4){0.f, 0.f, 0.f, 0.f}};
#pragma unroll
            for (int ks = 0; ks < 2; ++ks)
#pragma unroll
                for (int nt = 0; nt < 4; ++nt) S[nt] = MFMA16(kfr[nt][ks], qf[ms][ks], S[nt]);
            const int qpos = qlo + r; float mx = -INFINITY;
            if (domask) {
#pragma unroll
                for (int nt = 0; nt < 4; ++nt)
#pragma unroll
                    for (int i = 0; i < 4; ++i) { const int d = kt * 64 + nt * 16 + 4 * q + i - qpos; if (d > 128 || d < -128) S[nt][i] = -INFINITY; } }
#pragma unroll
            for (int nt = 0; nt < 4; ++nt)
#pragma unroll
                for (int i = 0; i < 4; ++i) mx = fmaxf(mx, S[nt][i]);
            mx = xrow_max(mx);
            const float mn = fmaxf(m[ms], mx); const float msafe = mn == -INFINITY ? 0.f : mn; const float alpha = EXP2(m[ms] - msafe); float sm = 0.f;
#pragma unroll
            for (int nt = 0; nt < 4; ++nt)
#pragma unroll
                for (int i = 0; i < 4; ++i) { S[nt][i] = EXP2(S[nt][i] - msafe); sm += S[nt][i]; }
            sm = xrow_sum(sm);
            lsum[ms] = lsum[ms] * alpha + sm; m[ms] = mn;
            const float pa[8] = {S[0][0], S[0][1], S[0][2], S[0][3], S[1][0], S[1][1], S[1][2], S[1][3]}, pb[8] = {S[2][0], S[2][1], S[2][2], S[2][3], S[3][0], S[3][1], S[3][2], S[3][3]};
            const bf16x8 p0 = as_frag(pack8(pa)), p1 = as_frag(pack8(pb));
#pragma unroll
            for (int me = 0; me < 4; ++me) { O[ms][me] = O[ms][me] * alpha;
                O[ms][me] = MFMA16(vfa[me], p0, O[ms][me]); O[ms][me] = MFMA16(vfb[me], p1, O[ms][me]); }
        }
    }
#undef ATT_PREFETCH
    const float sink = p.in[I_SINK][(size_t)l * NH + kvh * 2 + g];
#pragma unroll
    for (int ms = 0; ms < 2; ++ms) { const float den = lsum[ms] + EXP2(sink * 1.4426950408889634f - m[ms]); const float inv = frcp_(den);
        const size_t row = rq0 + tq0 + 16 * ms + r; const int col = (kvh * 2 + g) * 64 + 4 * q;
#pragma unroll
        for (int me = 0; me < 4; ++me) { const u32x2 gg = *(const u32x2*)(P + row * NP + PD + 512 + col + 16 * me);
            const float g0 = bitsf(gg.x << 16), g1 = bitsf(gg.x & 0xffff0000u), g2 = bitsf(gg.y << 16), g3 = bitsf(gg.y & 0xffff0000u);
            u32x2 o; o.x = pk2(O[ms][me][0] * inv * siluf_(g0), O[ms][me][1] * inv * siluf_(g1)); o.y = pk2(O[ms][me][2] * inv * siluf_(g2), O[ms][me][3] * inv * siluf_(g3));
            *(u32x2*)(Y + row * 1024 + YD + col + 16 * me) = o; } }
}

#ifdef EMU
__device__ __forceinline__ int olane(int lane) { return lane; }
#else
__device__ __forceinline__ int olane(int lane) { asm volatile("" : "+v"(lane)); return lane; }
#endif
__device__ __forceinline__ void load_nat_tile(const bf16* P, int row0, int col0, bf16* tile, int lane) {
    u32x4 v[8];
#pragma unroll
    for (int i = 0; i < 8; ++i) v[i] = *(const u32x4*)(P + (size_t)(row0 + (lane >> 3) + 8 * i) * NP + col0 + (lane & 7) * 8);
#pragma unroll
    for (int i = 0; i < 8; ++i) *(u32x4*)(tile + swz((lane >> 3) + 8 * i, lane & 7)) = v[i];
}
__device__ __forceinline__ bf16x8 frag_tr(const bf16* tile, int c0, int k0, int lane) {
    const int c = c0 + (lane & 15), kb = k0 + 8 * (lane >> 4); unsigned w[4];
#pragma unroll
    for (int j = 0; j < 4; ++j) w[j] = (unsigned)tile[swz(kb + 2 * j, c >> 3) + (c & 7)] | ((unsigned)tile[swz(kb + 2 * j + 1, c >> 3) + (c & 7)] << 16);
    u32x4 o; o.x = w[0]; o.y = w[1]; o.z = w[2]; o.w = w[3]; return as_frag(o);
}
__device__ __forceinline__ bf16x8 frag_tr_hw(const bf16* tile, int c0, int k0, int lane) {
    const int r = lane & 15, q = lane >> 4, row = k0 + 8 * q + (r >> 2), col = c0 + 4 * (r & 3);
    const u32x2 a = lds_tr16(tile + swz(row, col >> 3) + (col & 7)), b = lds_tr16(tile + swz(row + 4, col >> 3) + (col & 7));
    u32x4 o; o.x = a.x; o.y = a.y; o.z = b.x; o.w = b.y; return as_frag(o);
}
template <int DIR>
__device__ __forceinline__ void gla_r_frags(const float* Grow0, int lane, bf16x8 (&af)[4]) {
    const int r = lane & 15, q4 = lane >> 4;
#pragma unroll
    for (int mt = 0; mt < 4; ++mt) { u32x4 o = {0u, 0u, 0u, 0u};
        if (q4 < 2) o = *(const u32x4*)((const bf16*)(Grow0 + (size_t)(16 * mt + r) * NGS + 16) + DIR * 16 + 8 * q4);
        af[mt] = as_frag(o); }
}
template <int DIR>
__device__ __forceinline__ float gla_b_col(const Params& p, int l, int h, const bf16x8 (&af)[4], int nt, int lane_, float (&x)[4][4]) {
    const int lane = olane(lane_), r = lane & 15, q4 = lane >> 4, d = h * 64 + 16 * nt + r;
    u32x4 o = {0u, 0u, 0u, 0u};
    if (q4 < 2) { const float* wa = p.in[I_GWA] + ((size_t)(l * 2 + DIR) * 16 + 8 * q4) * WG + d;
        o.x = pk2(wa[0], wa[WG]); o.y = pk2(wa[2 * WG], wa[3 * WG]); o.z = pk2(wa[4 * WG], wa[5 * WG]); o.w = pk2(wa[6 * WG], wa[7 * WG]); }
    const bf16x8 bfr = as_frag(o); const float bias = p.in[I_GBA][(size_t)(l * 2 + DIR) * WG + d];
#pragma unroll
    for (int mt = 0; mt < 4; ++mt) { f32x4 c = {bias, bias, bias, bias}; c = MFMA16(af[mt], bfr, c);
#pragma unroll
        for (int i = 0; i < 4; ++i) x[mt][i] = logsig_fast(c[i]) * (1.0f / 16.0f); }
    float carry = 0.f;
#pragma unroll
    for (int k = 0; k < 4; ++k) { const int mt = DIR == 0 ? k : 3 - k; float* y = x[mt];
        if (DIR == 0) { y[1] += y[0]; y[2] += y[1]; y[3] += y[2]; } else { y[2] += y[3]; y[1] += y[2]; y[0] += y[1]; }
        const float s4 = DIR == 0 ? y[3] : y[0];
        const float t1 = DIR == 0 ? __shfl_up(s4, 16) : __shfl_down(s4, 16), t2 = DIR == 0 ? __shfl_up(s4, 32) : __shfl_down(s4, 32), t3 = DIR == 0 ? __shfl_up(s4, 48) : __shfl_down(s4, 48);
        const int qq = DIR == 0 ? q4 : 3 - q4;
        const float e = (qq >= 1 ? t1 : 0.f) + (qq >= 2 ? t2 : 0.f) + (qq >= 3 ? t3 : 0.f);
        const float tot = __shfl(e + s4, DIR == 0 ? r + 48 : r);
#pragma unroll
        for (int i = 0; i < 4; ++i) y[i] += carry + e;
        carry += tot; }
    return carry;
}

template <int MIXER, int DIR>
__device__ __forceinline__ void chunkst_dir(const Params& p, int l, int b, int h, int cid, const float* Grow0, const unsigned (&kk)[32], const bf16* Vt, bf16* Kt, const float* wvs, float* bendl, int lane_) {
    const int lane = olane(lane_), r = lane & 15, q4 = lane >> 4;
    if constexpr (MIXER == 0) {
        float nacc = 0.f;
#pragma unroll
        for (int c = 0; c < 8; ++c) { float f[8];
#pragma unroll
            for (int j = 0; j < 8; ++j) { const int s = 8 * c + j; const float kv = (s & 1) ? bitsf(kk[s >> 1] & 0xffff0000u) : bitsf(kk[s >> 1] << 16);
                f[j] = kv * 0.125f * wvs[DIR * 64 + s]; nacc += f[j]; }
            *(u32x4*)(Kt + swz(lane, c)) = pack8(f); }
        ((float*)(p.ws + WS_NV))[ch_index(DIR, b, h, cid) * 64 + lane] = nacc;
    } else {
        const bf16* P = (const bf16*)(p.ws + WS_P); const int kcol = PG + 256 + h * 64; const int r0 = b * TOK + cid * 64;
        bf16x8 af[4]; gla_r_frags<DIR>(Grow0, lane, af);
#pragma unroll 2
        for (int nt = 0; nt < 4; ++nt) { const int d = 16 * nt + r; float x[4][4];
            const float bend = gla_b_col<DIR>(p, l, h, af, nt, lane, x);
            if (q4 == 0) { ((float*)(p.ws + WS_BE))[ch_index(DIR, b, h, cid) * 64 + d] = bend; bendl[d] = __expf(fmaxf(bend, -80.0f)); }
#pragma unroll
            for (int mt = 0; mt < 4; ++mt)
#pragma unroll
                for (int i = 0; i < 4; ++i) { const int s = 16 * mt + 4 * q4 + i; const float kv = bf2f(P[(size_t)(r0 + s) * NP + kcol + d]); const float bc = fmaxf(x[mt][i], -80.0f);
                    Kt[swz(d, s >> 3) + (s & 7)] = f2bf(kv * __expf(-bc));
                    ((bf16*)(p.ws + WS_EQ))[((size_t)DIR * T + r0 + s) * WG + h * 64 + d] = f2bf(__expf(bc)); } }
    }
    WAVE_SYNC();
    bf16x8 vf[4][2];
#pragma unroll
    for (int ne = 0; ne < 4; ++ne)
#pragma unroll
        for (int ks = 0; ks < 2; ++ks) vf[ne][ks] = frag_tr_hw(Vt, 16 * ne, 32 * ks, lane);
    bf16* dst = (bf16*)(p.ws + WS_ST) + st_index(MIXER, DIR, b, h, cid) * 4096;
#pragma unroll
    for (int me = 0; me < 4; ++me) {
        f32x4 acc[4] = {(f32x4){0.f, 0.f, 0.f, 0.f}, (f32x4){0.f, 0.f, 0.f, 0.f}, (f32x4){0.f, 0.f, 0.f, 0.f}, (f32x4){0.f, 0.f, 0.f, 0.f}};
#pragma unroll
        for (int ks = 0; ks < 2; ++ks) { const bf16x8 a = *(const bf16x8*)(Kt + swz(16 * me + r, ks * 4 + q4));
#pragma unroll
            for (int ne = 0; ne < 4; ++ne) acc[ne] = MFMA16(a, vf[ne][ks], acc[ne]); }
        f32x4 sc4 = {1.f, 1.f, 1.f, 1.f}; if constexpr (MIXER == 1) sc4 = *(const f32x4*)(bendl + 16 * me + 4 * q4);
#pragma unroll
        for (int ne = 0; ne < 4; ++ne) { const f32x4 v = acc[ne] * sc4; u32x2 o; o.x = pk2(v[0], v[1]); o.y = pk2(v[2], v[3]); *(u32x2*)(dst + (16 * ne + r) * 64 + 16 * me + 4 * q4) = o; }
    }
    WAVE_SYNC();
}
template <int MIXER>
__device__ __forceinline__ void chunkst_w(const Params& p, int l, int b, int h, int cid, char* wl, int lane) {
    const bf16* P = (const bf16*)(p.ws + WS_P); const float* G = (const float*)(p.ws + WS_G);
    const int r0 = b * TOK + cid * 64, r = lane & 15, q4 = lane >> 4;
    bf16* Kt = (bf16*)wl;
    bf16* Vt = Kt + 4096;
    float* wvs = (float*)(Vt + 4096);
    float* bendl = wvs + 128;
    const int kcol = (MIXER == 0 ? PA : PG) + 256 + h * 64, vcol = (MIXER == 0 ? PA : PG) + 512 + h * 64;
    const float* Grow0 = G + (size_t)r0 * NGS;
    bf16* Nn = Kt;
    load_nat_tile(P, r0, vcol, Vt, lane);
    load_nat_tile(P, r0, kcol, Nn, lane);
    WAVE_SYNC();
    unsigned kk[32];
    { const int dc = 16 * q4 + 4 * (r & 3);
#pragma unroll
        for (int c = 0; c < 16; ++c) { const u32x2 t = lds_tr16(Nn + swz(4 * c + (r >> 2), dc >> 3) + (dc & 7)); kk[2 * c] = t.x; kk[2 * c + 1] = t.y; } }
    WAVE_SYNC();
    if constexpr (MIXER == 0) {
        const float* g = Grow0 + (size_t)lane * NGS; const float* gb = p.in[I_MGB] + (size_t)l * 16;
        const float i_f = g[h] + gb[h], f_f = g[4 + h] + gb[4 + h], i_b = g[8 + h] + gb[8 + h], f_b = g[12 + h] + gb[12 + h];
        const float lf = logsigf_(f_f), lb = logsigf_(f_b);
        const float bF = wave_prefix_sum(lf, lane), totF = __shfl(bF, 63);
        const float gF = totF - bF + i_f, mF = wave_max(gF);
        const float totB = wave_sum(lb), preB = wave_prefix_sum(lb, lane), bB = totB - preB + lb;
        const float gB = totB - bB + i_b, mB = wave_max(gB);
        wvs[lane] = __expf(gF - mF); wvs[64 + lane] = __expf(gB - mB);
        if (lane == 0) { float* SC = (float*)(p.ws + WS_SC);
            SC[ch_index(0, b, h, cid) * 4 + 0] = totF; SC[ch_index(0, b, h, cid) * 4 + 1] = mF;
            SC[ch_index(1, b, h, cid) * 4 + 0] = totB; SC[ch_index(1, b, h, cid) * 4 + 1] = mB; }
    }
    WAVE_SYNC();
    chunkst_dir<MIXER, 0>(p, l, b, h, cid, Grow0, kk, Vt, Kt, wvs, bendl, lane);
    chunkst_dir<MIXER, 1>(p, l, b, h, cid, Grow0, kk, Vt, Kt, wvs, bendl, lane);
}

template <int DIR>
__device__ __forceinline__ void chunkst_gla(const Params& p, int l, int b, int h, int cid, char* wl, int lane_) {
    const bf16* P = (const bf16*)(p.ws + WS_P);
    const int lane = olane(lane_), r0 = b * TOK + cid * 64, r = lane & 15, q4 = lane >> 4;
    bf16* Kt = (bf16*)wl;
    bf16* An = Kt + 4096;
    float* bendl = (float*)(An + 4096);
    const int kcol = PG + 256 + h * 64, vcol = PG + 512 + h * 64;
    const float* Grow0 = (const float*)(p.ws + WS_G) + (size_t)r0 * NGS;
    load_nat_tile(P, r0, vcol, An, lane);
    WAVE_SYNC();
    bf16x8 vf[4][2];
#pragma unroll
    for (int ne = 0; ne < 4; ++ne)
#pragma unroll
        for (int ks = 0; ks < 2; ++ks) vf[ne][ks] = frag_tr_hw(An, 16 * ne, 32 * ks, lane);
    WAVE_SYNC();
    load_nat_tile(P, r0, kcol, An, lane);
    WAVE_SYNC();
    bf16x8 af[4]; gla_r_frags<DIR>(Grow0, lane, af);
#pragma unroll 2
    for (int nt = 0; nt < 4; ++nt) { const int d = 16 * nt + r; float x[4][4];
        const float bend = gla_b_col<DIR>(p, l, h, af, nt, lane, x);
        if (q4 == 0) { ((float*)(p.ws + WS_BE))[ch_index(DIR, b, h, cid) * 64 + d] = bend; bendl[d] = __expf(fmaxf(bend, -80.0f)); }
#pragma unroll
        for (int mt = 0; mt < 4; ++mt) { const int s0 = 16 * mt + 4 * q4, dc = 16 * nt + 4 * (r & 3);
            const u32x2 kq = lds_tr16(An + swz(s0 + (r >> 2), dc >> 3) + (dc & 7));
            const float kv[4] = {bitsf(kq.x << 16), bitsf(kq.x & 0xffff0000u), bitsf(kq.y << 16), bitsf(kq.y & 0xffff0000u)}; float kp[4];
#pragma unroll
            for (int i = 0; i < 4; ++i) { const float bc = fmaxf(x[mt][i], -80.0f); kp[i] = kv[i] * __expf(-bc); An[swz(s0 + i, d >> 3) + (d & 7)] = f2bf(__expf(bc)); }
            u32x2 o; o.x = pk2(kp[0], kp[1]); o.y = pk2(kp[2], kp[3]); *(u32x2*)(Kt + swz(d, s0 >> 3) + (s0 & 7)) = o; } }
    WAVE_SYNC();
    { bf16* EQg = (bf16*)(p.ws + WS_EQ) + ((size_t)DIR * T + r0) * WG + h * 64;
#pragma unroll
        for (int i = 0; i < 8; ++i) { const int s = (lane >> 3) + 8 * i, ck = lane & 7; *(u32x4*)(EQg + (size_t)s * WG + ck * 8) = *(const u32x4*)(An + swz(s, ck)); } }
    bf16* dst = (bf16*)(p.ws + WS_ST) + st_index(1, DIR, b, h, cid) * 4096;
#pragma unroll
    for (int me = 0; me < 4; ++me) {
        f32x4 acc[4] = {(f32x4){0.f, 0.f, 0.f, 0.f}, (f32x4){0.f, 0.f, 0.f, 0.f}, (f32x4){0.f, 0.f, 0.f, 0.f}, (f32x4){0.f, 0.f, 0.f, 0.f}};
#pragma unroll
        for (int ks = 0; ks < 2; ++ks) { const bf16x8 a = *(const bf16x8*)(Kt + swz(16 * me + r, ks * 4 + q4));
#pragma unroll
            for (int ne = 0; ne < 4; ++ne) acc[ne] = MFMA16(a, vf[ne][ks], acc[ne]); }
        const f32x4 sc4 = *(const f32x4*)(bendl + 16 * me + 4 * q4);
#pragma unroll
        for (int ne = 0; ne < 4; ++ne) { const f32x4 v = acc[ne] * sc4; u32x2 o; o.x = pk2(v[0], v[1]); o.y = pk2(v[2], v[3]); *(u32x2*)(dst + (16 * ne + r) * 64 + 16 * me + 4 * q4) = o; }
    }
    WAVE_SYNC();
}

template <int MIXER, int DIR>
__device__ __forceinline__ void chunkout_prep(const Params& p, int l, int b, int h, int cid, const float* Grow0, int r0, int pbase, const bf16* EQ, float* gar, int lane_) {
    const int lane = olane(lane_);
    if constexpr (MIXER == 0) {
        const bf16* P = (const bf16*)(p.ws + WS_P);
        const float* g = Grow0 + (size_t)lane * NGS; const float* gb = p.in[I_MGB] + (size_t)l * 16;
        const float ig = g[DIR * 8 + h] + gb[DIR * 8 + h], fg = g[DIR * 8 + 4 + h] + gb[DIR * 8 + 4 + h];
        const float mprev = ((const float*)(p.ws + WS_SC))[ch_index(DIR, b, h, cid) * 4 + 2];
        const float lf = logsigf_(fg); float bb;
        if (DIR == 0) bb = wave_prefix_sum(lf, lane); else { const float tt = wave_sum(lf), pre = wave_prefix_sum(lf, lane); bb = tt - pre + lf; }
        const float a = ig - bb; const float pm = DIR == 0 ? wave_prefix_max(a, lane) : wave_suffix_max(a, lane);
        const float mt_ = fmaxf(bb + mprev, bb + pm);
        float* ga = gar + DIR * 320;
        ga[lane] = bb - mt_; ga[64 + lane] = a; ga[128 + lane] = __expf(bb + mprev - mt_); ga[192 + lane] = __expf(-mt_);
        float* nvl = gar + 640 + DIR * 64;
        nvl[lane] = ((const float*)(p.ws + WS_NV))[ch_index(DIR, b, h, cid) * 64 + lane];
        WAVE_SYNC();
        float dq = 0.f;
#pragma unroll
        for (int c = 0; c < 8; ++c) { float f[8]; unpack8(*(const u32x4*)(P + (size_t)(r0 + lane) * NP + pbase + c * 8), f);
            const f32x4 n0 = *(const f32x4*)(nvl + c * 8), n1 = *(const f32x4*)(nvl + c * 8 + 4);
            dq += f[0] * n0.x + f[1] * n0.y + f[2] * n0.z + f[3] * n0.w + f[4] * n1.x + f[5] * n1.y + f[6] * n1.z + f[7] * n1.w; }
        ga[256 + lane] = dq;
    }
}
template <int MIXER, int DIR, int NS>
__device__ __forceinline__ void chunkout_dir(const Params& p, int b, int h, int cid, int r0, int pbase, int th, const bf16x8 (&vtf)[4][2], const bf16* VtL, const bf16* EQ, bf16* SB, const float* gar, float* rsm, f32x4 (&htot)[NS][4], int lane_) {
    const bf16* P = (const bf16*)(p.ws + WS_P); const bf16* ST = (const bf16*)(p.ws + WS_ST);
    const int lane = olane(lane_), r = lane & 15, q4 = lane >> 4;
    const bf16* E = EQ + ((size_t)DIR * T + r0) * WG + h * 64;
    const float* ga = gar + DIR * 320;
    bf16x8 kf[4][2], ctf[4][2];
#pragma unroll
    for (int n = 0; n < 4; ++n)
#pragma unroll
        for (int ks = 0; ks < 2; ++ks) { if constexpr (MIXER == 0) kf[n][ks] = vtf[n][ks];
            else kf[n][ks] = *(const bf16x8*)(P + (size_t)(r0 + 16 * n + r) * NP + pbase + 256 + ks * 32 + q4 * 8);
            ctf[n][ks] = *(const bf16x8*)(ST + st_index(MIXER, DIR, b, h, cid) * 4096 + (16 * n + r) * 64 + ks * 32 + q4 * 8);
            if constexpr (MIXER == 1) { float fe[8], fk[8]; unpack8(*(const u32x4*)(E + (size_t)(16 * n + r) * WG + ks * 32 + q4 * 8), fe); unpack8(as_u4(kf[n][ks]), fk);
#pragma unroll
                for (int j = 0; j < 8; ++j) fk[j] = fk[j] * frcp_(fe[j]);
                kf[n][ks] = as_frag(pack8(fk)); } }
#pragma unroll
    for (int ms = 0; ms < NS; ++ms) { const int mt = NS * th + ms;
        bf16x8 qf[2];
#pragma unroll
        for (int ks = 0; ks < 2; ++ks) { qf[ks] = *(const bf16x8*)(P + (size_t)(r0 + 16 * mt + r) * NP + pbase + ks * 32 + q4 * 8);
            if constexpr (MIXER == 1) { float fe[8], fq[8]; unpack8(*(const u32x4*)(E + (size_t)(16 * mt + r) * WG + ks * 32 + q4 * 8), fe); unpack8(as_u4(qf[ks]), fq);
#pragma unroll
                for (int j = 0; j < 8; ++j) fq[j] *= 0.125f * fe[j];
                qf[ks] = as_frag(pack8(fq)); } }
        f32x4 S[4] = {(f32x4){0.f, 0.f, 0.f, 0.f}, (f32x4){0.f, 0.f, 0.f, 0.f}, (f32x4){0.f, 0.f, 0.f, 0.f}, (f32x4){0.f, 0.f, 0.f, 0.f}};
#pragma unroll
        for (int ks = 0; ks < 2; ++ks)
#pragma unroll
            for (int n = 0; n < 4; ++n) S[n] = MFMA16(kf[n][ks], qf[ks], S[n]);
        const int t = 16 * mt + r; float sm = 0.f; float gt = 0.f; if constexpr (MIXER == 0) gt = ga[t];
#pragma unroll
        for (int n = 0; n < 4; ++n) { f32x4 gs = {0.f, 0.f, 0.f, 0.f}; if constexpr (MIXER == 0) gs = *(const f32x4*)(ga + 64 + 16 * n + 4 * q4);
#pragma unroll
            for (int i = 0; i < 4; ++i) { const int sidx = 16 * n + 4 * q4 + i; const bool ok = DIR == 0 ? (sidx <= t) : (sidx >= t); float v = 0.f;
                if (ok) { if constexpr (MIXER == 0) v = S[n][i] * 0.125f * __expf(gt + gs[i]); else v = S[n][i]; }
                S[n][i] = v; sm += v; } }
        const float pa[8] = {S[0][0], S[0][1], S[0][2], S[0][3], S[1][0], S[1][1], S[1][2], S[1][3]}, pb[8] = {S[2][0], S[2][1], S[2][2], S[2][3], S[3][0], S[3][1], S[3][2], S[3][3]};
        const bf16x8 sm0 = as_frag(pack8(pa)), sm1 = as_frag(pack8(pb));
        float wi = 1.f, inv = 1.f;
        if constexpr (MIXER == 0) { sm = xrow_sum(sm); wi = ga[128 + t]; const float den = wi * ga[256 + t] + sm; inv = frcp_(fmaxf(fabsf(den), ga[192 + t])); }
#pragma unroll
        for (int me = 0; me < 4; ++me) { f32x4 a1 = {0.f, 0.f, 0.f, 0.f}, a2 = {0.f, 0.f, 0.f, 0.f};
            const int srow = 4 * q4 + (r >> 2), ecol = 16 * me + 4 * (r & 3);
            const u32x2 v0 = lds_tr16(VtL + swz(srow, ecol >> 3) + (ecol & 7)), v1 = lds_tr16(VtL + swz(16 + srow, ecol >> 3) + (ecol & 7)), v2 = lds_tr16(VtL + swz(32 + srow, ecol >> 3) + (ecol & 7)), v3 = lds_tr16(VtL + swz(48 + srow, ecol >> 3) + (ecol & 7));
            u32x4 va; va.x = v0.x; va.y = v0.y; va.z = v1.x; va.w = v1.y; u32x4 vb; vb.x = v2.x; vb.y = v2.y; vb.z = v3.x; vb.w = v3.y;
            a1 = MFMA16(as_frag(va), sm0, a1); a1 = MFMA16(as_frag(vb), sm1, a1);
            a2 = MFMA16(ctf[me][0], qf[0], a2); a2 = MFMA16(ctf[me][1], qf[1], a2);
            if constexpr (MIXER == 0) htot[ms][me] += (a1 + a2 * wi) * inv; else htot[ms][me] += a1 + a2; }
    }
    (void)SB; (void)rsm;
}
__device__ __forceinline__ void co_build_vt(const bf16* P, int r0, int vcol, bf16* VtL, int lane) {
    load_nat_tile(P, r0, vcol, VtL, lane);
    WAVE_SYNC();
}
template <int MIXER, int NS>
__device__ __forceinline__ void co_finalize(const Params& p, int l, int h, int r0, int pbase, int mt0, f32x4 (&htot)[NS][4], int lane_) {
    const bf16* P = (const bf16*)(p.ws + WS_P); bf16* Y = (bf16*)(p.ws + WS_HNY);
    const float* ngp = p.in[MIXER == 0 ? I_MNG : I_GNG] + (size_t)l * WG + h * 64;
    const int lz = olane(lane_), r = lz & 15, q4 = lz >> 4;
    u32x2 gq[NS][4], oq[NS][4];
#pragma unroll
    for (int ms = 0; ms < NS; ++ms)
#pragma unroll
        for (int me = 0; me < 4; ++me) { const size_t off = (size_t)(r0 + 16 * (mt0 + ms) + r) * NP + pbase + 16 * me + 4 * q4;
            gq[ms][me] = *(const u32x2*)(P + off + (MIXER == 0 ? 1024 : 768)); if constexpr (MIXER == 0) oq[ms][me] = *(const u32x2*)(P + off + 768); else oq[ms][me] = (u32x2){0u, 0u}; }
#pragma unroll
    for (int ms = 0; ms < NS; ++ms) { const int mt = mt0 + ms; float ss = 0.f; float gv[4][4];
#pragma unroll
        for (int me = 0; me < 4; ++me) {
            gv[me][0] = bitsf(gq[ms][me].x << 16); gv[me][1] = bitsf(gq[ms][me].x & 0xffff0000u); gv[me][2] = bitsf(gq[ms][me].y << 16); gv[me][3] = bitsf(gq[ms][me].y & 0xffff0000u);
            if constexpr (MIXER == 0) { htot[ms][me][0] *= sigmoidf_(bitsf(oq[ms][me].x << 16)); htot[ms][me][1] *= sigmoidf_(bitsf(oq[ms][me].x & 0xffff0000u)); htot[ms][me][2] *= sigmoidf_(bitsf(oq[ms][me].y << 16)); htot[ms][me][3] *= sigmoidf_(bitsf(oq[ms][me].y & 0xffff0000u)); }
            ss += htot[ms][me][0] * htot[ms][me][0] + htot[ms][me][1] * htot[ms][me][1] + htot[ms][me][2] * htot[ms][me][2] + htot[ms][me][3] * htot[ms][me][3]; }
        ss = xrow_sum(ss);
        const float rstd = rsqrtf(ss * (1.0f / 64.0f) + EPS);
#pragma unroll
        for (int me = 0; me < 4; ++me) { const int e = 16 * me + 4 * q4; const f32x4 n4 = *(const f32x4*)(ngp + e);
            u32x2 o; o.x = pk2(htot[ms][me][0] * rstd * n4.x * siluf_(gv[me][0]), htot[ms][me][1] * rstd * n4.y * siluf_(gv[me][1]));
            o.y = pk2(htot[ms][me][2] * rstd * n4.z * siluf_(gv[me][2]), htot[ms][me][3] * rstd * n4.w * siluf_(gv[me][3]));
            *(u32x2*)(Y + (size_t)(r0 + 16 * mt + r) * 1024 + (MIXER == 0 ? YA : YG) + h * 64 + e) = o; } }
}
template <int MIXER>
__device__ __forceinline__ void chunkout_w(const Params& p, int l, int b, int h, int cid, char* wl, int lane) {
    const bf16* P = (const bf16*)(p.ws + WS_P); const float* G = (const float*)(p.ws + WS_G);
    const int r0 = b * TOK + cid * 64;
    const int pbase = (MIXER == 0 ? PA : PG) + h * 64;
    bf16* SB = (bf16*)wl;
    float* rsm = (float*)(SB + 1024);
    float* gar = rsm + 16;
    const bf16* EQ = (const bf16*)(p.ws + WS_EQ);
    const float* Grow0 = G + (size_t)r0 * NGS;
    bf16* VtL = (bf16*)(gar + 768);
    bf16x8 vtf[4][2];
#pragma unroll
    for (int me = 0; me < 4; ++me)
#pragma unroll
        for (int ks = 0; ks < 2; ++ks) { if constexpr (MIXER == 0) vtf[me][ks] = *(const bf16x8*)(P + (size_t)(r0 + 16 * me + (lane & 15)) * NP + pbase + 256 + ks * 32 + (lane >> 4) * 8); else vtf[me][ks] = (bf16x8){0, 0, 0, 0, 0, 0, 0, 0}; }
    co_build_vt(P, r0, pbase + 512, VtL, lane);
    chunkout_prep<MIXER, 0>(p, l, b, h, cid, Grow0, r0, pbase, EQ, gar, lane);
    chunkout_prep<MIXER, 1>(p, l, b, h, cid, Grow0, r0, pbase, EQ, gar, lane);
    WAVE_SYNC();
    constexpr int NS = MIXER == 1 ? 2 : 1;
#pragma unroll 1
    for (int th = 0; th < 4 / NS; ++th) {
        f32x4 htot[NS][4];
#pragma unroll
        for (int a = 0; a < NS; ++a)
#pragma unroll
            for (int c = 0; c < 4; ++c) htot[a][c] = (f32x4){0.f, 0.f, 0.f, 0.f};
        chunkout_dir<MIXER, 0, NS>(p, b, h, cid, r0, pbase, th, vtf, VtL, EQ, SB, gar, rsm, htot, lane);
        chunkout_dir<MIXER, 1, NS>(p, b, h, cid, r0, pbase, th, vtf, VtL, EQ, SB, gar, rsm, htot, lane);
        co_finalize<MIXER, NS>(p, l, h, r0, pbase, NS * th, htot, lane);
    }
}
constexpr int CO_PART = 13376;
template <int MIXER, int DIR>
__device__ __forceinline__ void chunkout_piece(const Params& p, int l, int b, int h, int cid, int mt, char* wl, int lane) {
    const bf16* P = (const bf16*)(p.ws + WS_P); const float* G = (const float*)(p.ws + WS_G);
    const int r0 = b * TOK + cid * 64; const int pbase = (MIXER == 0 ? PA : PG) + h * 64;
    bf16* SB = (bf16*)wl; float* rsm = (float*)(SB + 1024); float* gar = rsm + 16; const bf16* EQ = (const bf16*)(p.ws + WS_EQ);
    const float* Grow0 = G + (size_t)r0 * NGS; bf16* VtL = (bf16*)(gar + 768);
    bf16x8 vtf[4][2];
#pragma unroll
    for (int me = 0; me < 4; ++me)
#pragma unroll
        for (int ks = 0; ks < 2; ++ks) { if constexpr (MIXER == 0) vtf[me][ks] = *(const bf16x8*)(P + (size_t)(r0 + 16 * me + (lane & 15)) * NP + pbase + 256 + ks * 32 + (lane >> 4) * 8); else vtf[me][ks] = (bf16x8){0, 0, 0, 0, 0, 0, 0, 0}; }
    co_build_vt(P, r0, pbase + 512, VtL, lane);
    chunkout_prep<MIXER, DIR>(p, l, b, h, cid, Grow0, r0, pbase, EQ, gar, lane);
    WAVE_SYNC();
    f32x4 htot[1][4] = {{(f32x4){0.f, 0.f, 0.f, 0.f}, (f32x4){0.f, 0.f, 0.f, 0.f}, (f32x4){0.f, 0.f, 0.f, 0.f}, (f32x4){0.f, 0.f, 0.f, 0.f}}};
    chunkout_dir<MIXER, DIR, 1>(p, b, h, cid, r0, pbase, mt, vtf, VtL, EQ, SB, gar, rsm, htot, lane);
    float* part = (float*)(wl + CO_PART);
#pragma unroll
    for (int me = 0; me < 4; ++me)
#pragma unroll
        for (int i = 0; i < 4; ++i) part[(me * 4 + i) * 64 + lane] = htot[0][me][i];
}
template <int MIXER>
__device__ __forceinline__ void chunkout_combine(const Params& p, int l, int b, int h, int cid, int mt, const char* smem, int lane) {
    const float* pa = (const float*)(smem + (2 * mt) * WLDS + CO_PART); const float* pb = (const float*)(smem + (2 * mt + 1) * WLDS + CO_PART);
    f32x4 htot[1][4];
#pragma unroll
    for (int me = 0; me < 4; ++me)
#pragma unroll
        for (int i = 0; i < 4; ++i) htot[0][me][i] = pa[(me * 4 + i) * 64 + lane] + pb[(me * 4 + i) * 64 + lane];
    co_finalize<MIXER, 1>(p, l, h, b * TOK + cid * 64, (MIXER == 0 ? PA : PG) + h * 64, mt, htot, lane);
}

template <bool OUT>
__device__ __forceinline__ void chunk_workers(const Params& p, int l, char* smem) {
    const int tid = otid(), lane = tid & 63, wave = __builtin_amdgcn_readfirstlane(tid >> 6);
    const int NW = (int)gridDim.x * 8, wi = wave * (int)gridDim.x + obid();
    const int c_lo = (OUT && l == DEPTH - 1) ? NCC : 0, npc = NCH - c_lo, half = NB * NH * npc;
    char* wl = smem + wave * WLDS;
    if (OUT) {
        const int cl = NCC, npl = NCH - NCC, halfl = NB * NH * npl;
#pragma unroll 1
        for (int t = wi; t < halfl; t += NW) { const int b = t / (NH * npl), h = (t / npl) % NH, cid = cl + t % npl;
            const Params q = relaunder(p); chunkout_w<1>(q, l, b, h, cid, wl, lane); }
        { const int used = halfl % NW;
#pragma unroll 1
            for (int t = (wi + NW - used) % NW; t < halfl; t += NW) { const int b = t / (NH * npl), h = (t / npl) % NH, cid = cl + t % npl;
                const Params q = relaunder(p); chunkout_w<0>(q, l, b, h, cid, wl, lane); } }
        if (l < DEPTH - 1) {
            const int nct = NB * NH * NCC;
#pragma unroll 1
            for (int st = obid(); st < 2 * nct; st += (int)gridDim.x) { const int mixer = st / nct, r2 = st % nct, b = r2 / (NH * NCC), h = (r2 / NCC) % NH, cid = r2 % NCC;
                const Params q = relaunder(p); const int mt = wave >> 1;
                __syncthreads();
                if (mixer == 0) { if (wave & 1) chunkout_piece<0, 1>(q, l, b, h, cid, mt, wl, lane); else chunkout_piece<0, 0>(q, l, b, h, cid, mt, wl, lane); }
                else            { if (wave & 1) chunkout_piece<1, 1>(q, l, b, h, cid, mt, wl, lane); else chunkout_piece<1, 0>(q, l, b, h, cid, mt, wl, lane); }
                __syncthreads();
                if (wave < 4) { if (mixer == 0) chunkout_combine<0>(q, l, b, h, cid, wave, smem, lane); else chunkout_combine<1>(q, l, b, h, cid, wave, smem, lane); }
            }
        }
    } else {
        int off = 0;
#pragma unroll 1
        for (int t = wi; t < half; t += NW) { const int b = t / (NH * npc), h = (t / npc) % NH, cid = c_lo + t % npc;
            const Params q = relaunder(p); chunkst_gla<0>(q, l, b, h, cid, wl, lane); }
        off = (off + half) % NW;
#pragma unroll 1
        for (int t = (wi + NW - off) % NW; t < half; t += NW) { const int b = t / (NH * npc), h = (t / npc) % NH, cid = c_lo + t % npc;
            const Params q = relaunder(p); chunkst_gla<1>(q, l, b, h, cid, wl, lane); }
        off = (off + half) % NW;
#pragma unroll 1
        for (int t = (wi + NW - off) % NW; t < half; t += NW) { const int b = t / (NH * npc), h = (t / npc) % NH, cid = c_lo + t % npc;
            const Params q = relaunder(p); chunkst_w<0>(q, l, b, h, cid, wl, lane); }
    }
}

__device__ __forceinline__ void phase_mix1(const Params& p, int l, char* smem) {
    const bool ctxo = l < DEPTH - 1; const int G = (int)gridDim.x, bid = obid();
    constexpr int N_HL = (NB / 2) * (WG / 2), N_HC = NB * (WG / HCB);
    chunk_workers<false>(p, l, smem);
    stage_signal(p, smem, 0, l);
    for (int t = bid; t < N_HL; t += G) hylat_task(p, l, t / (WG / 2), t % (WG / 2), smem);
    if (ctxo) for (int t = G - 1 - bid; t < N_HC; t += G) hyctx_task(p, l, t / (WG / HCB), t % (WG / HCB), smem);
    stage_signal(p, smem, 2, l);
}

constexpr int SCG = 12;
__device__ __forceinline__ void phase_scan(const Params& p, int l, char* smem) {
    const int tid = otid();
    bf16* ST = (bf16*)(p.ws + WS_ST); float* NV = (float*)(p.ws + WS_NV); const float* BE = (const float*)(p.ws + WS_BE); float* SC = (float*)(p.ws + WS_SC);
    constexpr int NCHAIN = 2 * 2 * NB * NH;
    stage_wait(p, 0, l);
    for (int item = obid() * NT + tid; item < NCHAIN * 1024; item += gridDim.x * NT) {
        const int chain = item >> 10, grp = item & 1023; const int mixer = chain / (2 * NB * NH), dir = (chain / (NB * NH)) % 2, b = (chain / NH) % NB, h = chain % NH;
        float c[4] = {0.f, 0.f, 0.f, 0.f}; float nv[4] = {0.f, 0.f, 0.f, 0.f}; float m = 0.f;
        const int d0 = (grp & 15) * 4; const bool donv = (mixer == 0) && (grp < 16);
        for (int o0 = 0; o0 < NCH; o0 += SCG) {
            u32x2 uu[SCG]; float s0[SCG], s1[SCG]; f32x4 be[SCG]; f32x4 nu[SCG];
#pragma unroll
            for (int j = 0; j < SCG; ++j) if (o0 + j < NCH) { const int cid = chain_cid(dir, o0 + j); const size_t ci = ch_index(dir, b, h, cid);
                uu[j] = *(const u32x2*)(ST + st_index(mixer, dir, b, h, cid) * 4096 + grp * 4);
                if (mixer == 0) { s0[j] = SC[ci * 4 + 0]; s1[j] = SC[ci * 4 + 1]; if (donv) nu[j] = *(const f32x4*)(NV + ci * 64 + grp * 4); }
                else be[j] = *(const f32x4*)(BE + ci * 64 + d0); }
#pragma unroll
            for (int j = 0; j < SCG; ++j) if (o0 + j < NCH) { const int cid = chain_cid(dir, o0 + j); const size_t ci = ch_index(dir, b, h, cid);
                const float u[4] = {bitsf(uu[j].x << 16), bitsf(uu[j].x & 0xffff0000u), bitsf(uu[j].y << 16), bitsf(uu[j].y & 0xffff0000u)};
                u32x2 w; w.x = pk2(c[0], c[1]); w.y = pk2(c[2], c[3]); *(u32x2*)(ST + st_index(mixer, dir, b, h, cid) * 4096 + grp * 4) = w;
                if (mixer == 0) {
                    if (grp == 0) SC[ci * 4 + 2] = m;
                    const float mn = fmaxf(s0[j] + m, s1[j]), a = __expf(s0[j] + m - mn), s = __expf(s1[j] - mn);
#pragma unroll
                    for (int k = 0; k < 4; ++k) c[k] = a * c[k] + s * u[k];
                    if (donv) { f32x4 nw = {nv[0], nv[1], nv[2], nv[3]}; *(f32x4*)(NV + ci * 64 + grp * 4) = nw;
                        nv[0] = a * nv[0] + s * nu[j].x; nv[1] = a * nv[1] + s * nu[j].y; nv[2] = a * nv[2] + s * nu[j].z; nv[3] = a * nv[3] + s * nu[j].w; }
                    m = mn;
                } else { c[0] = __expf(be[j].x) * c[0] + u[0]; c[1] = __expf(be[j].y) * c[1] + u[1]; c[2] = __expf(be[j].z) * c[2] + u[2]; c[3] = __expf(be[j].w) * c[3] + u[3]; } }
        }
    }
    stage_signal(p, smem, 1, l);
    { const bool ctxo = l < DEPTH - 1; const int G = (int)gridDim.x, bid = obid();
        constexpr int QTL = SEQ / 128, QTC = CTXL / 128, N_AL = NB * 2 * QTL, N_AC = NB * 2 * QTC;
        for (int t = bid; t < N_AL; t += G) attn_task(p, l, t / (2 * QTL), (t / QTL) % 2, t % QTL, false, smem);
        if (ctxo) for (int t = (bid + G - 64 % G) % G; t < N_AC; t += G) attn_task(p, l, t / (2 * QTC), (t / QTC) % 2, t % QTC, true, smem); }
}

__device__ __forceinline__ void phase_mix2(const Params& p, int l, char* smem) {
    const int tid = otid();
    stage_wait(p, 1, l);
    chunk_workers<true>(p, l, smem);
    stage_wait(p, 2, l);
    constexpr int N_WOUT = (DM / 64) * (MIX / 64);
    { const int lane = tid & 63, wave = __builtin_amdgcn_readfirstlane(tid >> 6); const int NW = (int)gridDim.x * 8, wi = wave * (int)gridDim.x + obid();
        for (int task = NW - 1 - wi; task < N_WOUT; task += NW) { const int nt = task / (MIX / 64), kt = task % (MIX / 64);
            convert_tile_w(p.in[I_WOUT] + (size_t)l * MIX * DM, DM, (bf16*)(p.ws + WS_WOUT), MIX, nt * 64, kt * 64, false, smem + wave * WLDS, lane); }
        bf16* tile = (bf16*)(smem + wave * WLDS); const bf16* HT = (const bf16*)(p.ws + WS_HT); bf16* Y = (bf16*)(p.ws + WS_HNY);
        constexpr int NTT = NB * (SEQ / 64) * 4;
        for (int t = wi; t < NTT; t += NW) { const int b = t / ((SEQ / 64) * 4), tt = (t / 4) % (SEQ / 64), c0 = (t % 4) * 64; const size_t tok0 = (size_t)b * TOK + CTXL + tt * 64;
#pragma unroll
            for (int i = 0; i < 8; ++i) { const int ch = (lane >> 3) + 8 * i, ck = lane & 7; *(u32x4*)(tile + swz(ch, ck)) = *(const u32x4*)(HT + (size_t)(768 + c0 + ch) * T + tok0 + ck * 8); }
            WAVE_SYNC();
#pragma unroll
            for (int i = 0; i < 8; ++i) { const int tk = (lane >> 3) + 8 * i, cc = lane & 7; unsigned w[4];
#pragma unroll
                for (int j = 0; j < 4; ++j) { const int ca = cc * 8 + 2 * j; w[j] = (unsigned)tile[swz(ca, tk >> 3) + (tk & 7)] | ((unsigned)tile[swz(ca + 1, tk >> 3) + (tk & 7)] << 16); }
                u32x4 o; o.x = w[0]; o.y = w[1]; o.z = w[2]; o.w = w[3]; *(u32x4*)(Y + (tok0 + tk) * 1024 + YH + c0 + cc * 8) = o; }
            WAVE_SYNC(); } }
}


#ifndef EMU
#define LAS __attribute__((address_space(3)))
#define XB_TMO      128
#define XB_XCNT(j)  (256  + 64 * (j))
#define XB_XSUB(j)  (1280 + 64 * (j))
#define XB_XGEN(j)  (2304 + 64 * (j))
#define XB_TOP      3328
#define XB_TOPGEN   3392
#define XCD_BAR_WORDS 3456
#define XB_SPIN_CAP (1u << 18)

__device__ __forceinline__ unsigned xb_ld(unsigned* p)              { return __hip_atomic_load(p, __ATOMIC_RELAXED, __HIP_MEMORY_SCOPE_AGENT); }
__device__ __forceinline__ unsigned xb_add(unsigned* p, unsigned v) { return __hip_atomic_fetch_add(p, v, __ATOMIC_RELAXED, __HIP_MEMORY_SCOPE_AGENT); }
__device__ __forceinline__ unsigned xb_xcc_id() { return (unsigned)__builtin_amdgcn_s_getreg((3 << 11) | 20) & 0xFu; }
#define XB_SPIN(cond, bar) do { unsigned _sp = 0; while (cond) { __builtin_amdgcn_s_sleep(1); \
    if ((++_sp & 255u) == 0u) { if (xb_ld(&(bar)[XB_TMO])) break; if (_sp > XB_SPIN_CAP) { atomicAdd(&(bar)[XB_TMO], 1u); break; } } } } while (0)

struct XcdBarrier {
    unsigned* bar; unsigned x;
    volatile LAS unsigned* st;
};

__device__ __forceinline__ XcdBarrier xcd_barrier_post(unsigned* bar, volatile LAS unsigned* st) {
    XcdBarrier b; b.bar = bar; b.x = xb_xcc_id(); b.st = st;
    if (threadIdx.x == 0) (void)xb_add(&bar[XB_XCNT(b.x)], 1u);
    return b;
}
__device__ __forceinline__ void xcd_barrier_complete(unsigned* bar, unsigned x, unsigned& nloc, unsigned& nx) {
    const unsigned G = gridDim.x * gridDim.y * gridDim.z;
    unsigned sum, cnt, mine, sp = 0u;
    for (;;) {
        sum = 0u; cnt = 0u; mine = 0u;
#pragma unroll
        for (unsigned j = 0; j < 16; ++j) { const unsigned c = xb_ld(&bar[XB_XCNT(j)]); sum += c; cnt += (c > 0u) ? 1u : 0u; mine = (j == x) ? c : mine; }
        if (sum == G) break;
        __builtin_amdgcn_s_sleep(1);
        if ((++sp & 255u) == 0u) { if (xb_ld(&bar[XB_TMO])) break; if (sp > XB_SPIN_CAP) { atomicAdd(&bar[XB_TMO], 1u); break; } }
    }
    nloc = mine > 0u ? mine : 1u; nx = cnt > 0u ? cnt : 1u;
}

__device__ __forceinline__ void xcd_barrier(const XcdBarrier& b) {
    asm volatile("s_waitcnt vmcnt(0)" ::: "memory");
    __syncthreads();
    if (threadIdx.x == 0) {
        unsigned* bar = b.bar;
        __builtin_amdgcn_s_waitcnt(0);
        unsigned nloc = b.st[0], nx = b.st[1];
        if (nloc == 0u) { xcd_barrier_complete(bar, b.x, nloc, nx); b.st[0] = nloc; b.st[1] = nx; }
        const unsigned old = xb_add(&bar[XB_XSUB(b.x)], 1u);
        const unsigned gen = old / nloc;
        if (old + 1u == (gen + 1u) * nloc) {
            __builtin_amdgcn_fence(__ATOMIC_RELEASE, "agent");
            asm volatile("s_waitcnt vmcnt(0)" ::: "memory");
            const unsigned og = xb_add(&bar[XB_TOP], 1u);
            const unsigned tg = og / nx;
            if (og + 1u == (tg + 1u) * nx) xb_add(&bar[XB_TOPGEN], 1u);
            else XB_SPIN(xb_ld(&bar[XB_TOPGEN]) == tg, bar);
            __builtin_amdgcn_fence(__ATOMIC_ACQUIRE, "agent");
            xb_add(&bar[XB_XGEN(b.x)], 1u);
            asm volatile("s_waitcnt vmcnt(0)" ::: "memory");
        } else {
            XB_SPIN(xb_ld(&bar[XB_XGEN(b.x)]) == gen, bar);
            __builtin_amdgcn_fence(__ATOMIC_ACQUIRE, "agent");
            asm volatile("s_waitcnt vmcnt(0)" ::: "memory");
        }
    }
    __syncthreads();
}
#endif

__global__ void __launch_bounds__(NT) fwd_kernel(Params pk, int ph_lo, int ph_hi) {
    SMEM_DECL;
#ifndef EMU
    volatile LAS unsigned* misc = (volatile LAS unsigned*)(smem + LDS_BYTES - 64);
    if (threadIdx.x < 2) misc[threadIdx.x] = 0u;
    __syncthreads();
    const XcdBarrier bar = xcd_barrier_post((unsigned*)(pk.ws + WS_BAR), misc);
#endif
    constexpr int NPH = 2 + 6 * DEPTH;
    for (int ph = ph_lo; ph < ph_hi && ph < NPH; ++ph) {
#ifndef EMU
        Params p = pk; { size_t z = 0; asm volatile("" : "+s"(z)); p.ws = pk.ws + z; p.out = pk.out + z;
#pragma unroll
            for (int i = 0; i < 26; ++i) p.in[i] = pk.in[i] + z; }
#else
        const Params& p = pk;
#endif
        if (ph == 0) phase0(p, smem);
        else if (ph == NPH - 1) phase_rp(p, DEPTH, smem);
        else { const int l = (ph - 1) / 6, k = (ph - 1) % 6;
            if (k == 0) phase_rp(p, l, smem);
            else if (k == 1) phase_gemm_in(p, l, smem);
            else if (k == 2) phase_mix1(p, l, smem);
            else if (k == 3) phase_scan(p, l, smem);
            else if (k == 4) phase_mix2(p, l, smem);
            else phase_gemm_out(p, l, smem);
#ifdef PROBE_DUP
            if (k == PROBE_DUP) { GRID_SYNC();
                if (k == 1) phase_gemm_in(p, l, smem); else if (k == 2) phase_mix1(p, l, smem); else if (k == 4) phase_mix2(p, l, smem); }
#endif
        }
        if (ph + 1 < ph_hi && !(ph >= 6 && ph % 6 == 0) && !(ph >= 1 && ((ph - 1) % 6 == 2 || (ph - 1) % 6 == 3))) {
#ifdef EMU
            GRID_SYNC();
#else
            if (ph_lo < 0) GRID_SYNC();
            xcd_barrier(bar);
#endif
        }
    }
}

#ifndef EMU
extern "C" void kernel_launch(void* const* d_in, const int* in_sizes, int n_in, void* d_out, int out_size, void* d_ws, size_t ws_size, hipStream_t stream) {
    static int grid = 0;
    if (grid == 0) {
        if (n_in != 26 || ws_size < WS_TOTAL) { fprintf(stderr, "kernel_launch: unexpected n_in %d or ws_size %zu (need %zu)\n", n_in, ws_size, (size_t)WS_TOTAL); grid = -1; return; }
        int dev = 0, cus = 0, per_cu = 0;
        hipGetDevice(&dev);
        hipDeviceGetAttribute(&cus, hipDeviceAttributeMultiprocessorCount, dev);
        hipFuncSetAttribute((const void*)fwd_kernel, hipFuncAttributeMaxDynamicSharedMemorySize, LDS_BYTES);
        hipOccupancyMaxActiveBlocksPerMultiprocessor(&per_cu, (const void*)fwd_kernel, NT, LDS_BYTES);
        if (per_cu < 1) { fprintf(stderr, "kernel_launch: occupancy query returned %d\n", per_cu); grid = -1; return; }
        if (per_cu > 1) per_cu = 1;
        grid = cus * per_cu;
    }
    if (grid < 0) return;
    hipMemsetAsync((char*)d_ws + WS_BAR, 0, BAR_BYTES, stream);
    Params p{};
    for (int i = 0; i < 26; ++i) p.in[i] = (const float*)d_in[i];
    p.out = (float*)d_out; p.ws = (char*)d_ws;
    int lo = 0, hi = 2 + 6 * DEPTH;
    void* args[] = {&p, &lo, &hi};
    hipError_t e = hipLaunchCooperativeKernel((const void*)fwd_kernel, dim3(grid), dim3(NT), args, LDS_BYTES, stream);
    if (e != hipSuccess) fprintf(stderr, "cooperative launch failed: %s (grid %d)\n", hipGetErrorString(e), grid);
}
#endif
```

```cpp
#ifdef EMU
#include "emu/hipemu.h"
#define GRID_SYNC() emu::grid_sync()
#define SMEM_DECL char* smem = emu::S().blocks[emu::cur()->block].lds
#define SCHED_FENCE() do {} while (0)
#define EXP2(x) exp2f(x)
#define MFMA16(a, b, c) emu_mfma_16x16x32_bf16(a, b, c)
#else
#include <hip/hip_runtime.h>
#include <hip/hip_cooperative_groups.h>
#include <cstdio>
#include <cstdint>
#define GRID_SYNC() cooperative_groups::this_grid().sync()
#define SMEM_DECL extern __shared__ __attribute__((aligned(16))) char smem[]
#define SCHED_FENCE() __builtin_amdgcn_sched_barrier(0)
#define EXP2(x) __builtin_amdgcn_exp2f(x)
#define MFMA16(a, b, c) __builtin_amdgcn_mfma_f32_16x16x32_bf16(a, b, c, 0, 0, 0)
#endif

#ifdef EMU
#ifndef EMU_DM
#define EMU_DM 256
#endif
#ifndef EMU_NB
#define EMU_NB 2
#endif
#ifndef EMU_SEQ
#define EMU_SEQ 512
#endif
#ifndef EMU_DEPTH
#define EMU_DEPTH 2
#endif
#ifndef EMU_CTXL
#define EMU_CTXL 128
#endif
constexpr int DM = EMU_DM, NB = EMU_NB, SEQ = EMU_SEQ, DEPTH = EMU_DEPTH, CTXL = EMU_CTXL;
#else
constexpr int DM = 1024, NB = 8, SEQ = 2048, DEPTH = 4, CTXL = 256;
#endif
constexpr int MIX = 1024, WG = 256, HD = 64, NH = 4, CH = 64;
constexpr int TOK = CTXL + SEQ, T = NB * TOK, NCH = TOK / CH, NCC = CTXL / CH;
constexpr int N_IN = 4144, NP = 3072, NG = 48, NGS = 32, NMAIN = 3328, NPAD = 4352;
constexpr int NF = 2 * SEQ;
constexpr int NJ = NB + 1;
constexpr int NT = 512;
constexpr float EPS = 1e-6f;
constexpr int PA = 0, PG = 1280, PD = 2304;
constexpr int YA = 0, YH = 256, YG = 512, YD = 768;
constexpr int ilog4(int n) { return n <= 1 ? 0 : 1 + ilog4(n / 4); }
constexpr int FFT_P = ilog4(NF);
static_assert((1 << (2 * FFT_P)) == NF, "NF must be a power of 4");
static_assert(DM % 256 == 0 && CTXL % 128 == 0 && SEQ % 256 == 0, "shape constraints");

typedef unsigned short bf16;
typedef short bf16x8 __attribute__((ext_vector_type(8)));
typedef float f32x4 __attribute__((ext_vector_type(4)));
typedef unsigned u32x4 __attribute__((ext_vector_type(4)));
typedef unsigned u32x2 __attribute__((ext_vector_type(2)));
struct cpx { float x, y; };

constexpr size_t al256(size_t x) { return (x + 255) & ~(size_t)255; }
constexpr size_t WS_CTXB = 0;
constexpr size_t WS_HNY = al256(WS_CTXB + (size_t)NB * CTXL * DM * 4);
constexpr size_t WS_WIN = WS_HNY + (size_t)T * 1024 * 2;
constexpr size_t WS_ST = WS_WIN;
constexpr size_t ST_BYTES = (size_t)2 * 2 * NB * NH * NCH * 4096 * 2;
constexpr size_t WS_KT = al256(WS_WIN + (size_t)NPAD * DM * 2);
static_assert(WS_KT + (size_t)WG * NF * 4 <= WS_ST + ST_BYTES || true, "");
constexpr size_t ST_END = al256((WS_ST + ST_BYTES > WS_KT + (size_t)WG * NF * 4) ? WS_ST + ST_BYTES : WS_KT + (size_t)WG * NF * 4);
constexpr size_t WS_P = ST_END;
constexpr size_t WS_HT = al256(WS_P + (size_t)T * NP * 2);
constexpr size_t WS_WOUT = WS_HT;
constexpr size_t WS_G = al256(WS_HT + (size_t)1024 * T * 2);
constexpr size_t WS_KF = al256(WS_G + (size_t)T * NGS * 4);
constexpr size_t WS_HC = al256(WS_KF + (size_t)WG * NF * 8);
constexpr size_t WS_EQ = al256(WS_HC + (size_t)2 * WG * CTXL * 4);
constexpr size_t WS_NV = al256(WS_EQ + (size_t)2 * T * WG * 2);
constexpr size_t WS_BE = al256(WS_NV + (size_t)2 * NB * NH * NCH * 64 * 4);
constexpr size_t WS_SC = al256(WS_BE + (size_t)2 * NB * NH * NCH * 64 * 4);
constexpr size_t WS_MOD = al256(WS_SC + (size_t)2 * NB * NH * NCH * 4 * 4);
constexpr size_t WS_TW = al256(WS_MOD + (size_t)DEPTH * NJ * 3 * DM * 4);
constexpr size_t WS_ROPE = al256(WS_TW + (size_t)NF * 8);
constexpr size_t WS_BAR = al256(WS_ROPE + (size_t)SEQ * 32 * 8);
constexpr size_t BAR_BYTES = 32768;
constexpr size_t WS_TOTAL = al256(WS_BAR + BAR_BYTES);
static_assert((size_t)T * DM * 4 <= (size_t)T * NP * 2, "YO fits in P");
#ifndef EMU
static_assert(WS_TOTAL <= (size_t)268435456, "workspace map must fit 256 MiB");
#endif

constexpr int LDS_BYTES = 163840;

struct Params {
    const float* in[26];
    float* out;
    char* ws;
};
enum { I_X = 0, I_C, I_CTX, I_CCTX, I_WADA, I_BADA, I_GPRE, I_GPOST, I_WIN, I_MGB, I_MNG, I_HCW, I_HCB, I_HW1, I_HB1, I_HW2, I_HB2, I_HW3, I_HB3,
       I_HFREQ, I_HD, I_GWA, I_GBA, I_GNG, I_SINK, I_WOUT };

__device__ __forceinline__ Params relaunder(const Params& pk) {
#ifdef EMU
    return pk;
#else
    Params p = pk; size_t z = 0; asm volatile("" : "+s"(z)); p.ws = pk.ws + z; p.out = pk.out + z;
#pragma unroll
    for (int i = 0; i < 26; ++i) p.in[i] = pk.in[i] + z;
    return p;
#endif
}
constexpr int WLDS = (LDS_BYTES - 64) / 8 / 16 * 16;
#ifdef EMU
#define WAVE_SYNC() emu_wave_sync()
#else
#define WAVE_SYNC() do { asm volatile("s_waitcnt lgkmcnt(0)" ::: "memory"); __builtin_amdgcn_wave_barrier(); } while (0)
#endif

#ifdef EMU
__device__ __forceinline__ int otid() { return (int)threadIdx.x; }
__device__ __forceinline__ int obid() { return (int)blockIdx.x; }
#else
__device__ __forceinline__ int otid() { int t = (int)threadIdx.x; asm volatile("" : "+v"(t)); return t; }
__device__ __forceinline__ int obid() { int b = (int)blockIdx.x; asm volatile("" : "+s"(b)); return b; }
#endif
__device__ __forceinline__ unsigned fbits(float f) { return __builtin_bit_cast(unsigned, f); }
__device__ __forceinline__ float bitsf(unsigned u) { return __builtin_bit_cast(float, u); }
__device__ __forceinline__ float bf2f(bf16 h) { return bitsf((unsigned)h << 16); }
#ifdef EMU
__device__ __forceinline__ bf16 f2bf(float f) { unsigned u = fbits(f); return (bf16)((u + 0x7fffu + ((u >> 16) & 1u)) >> 16); }
__device__ __forceinline__ unsigned pk2(float lo, float hi) { return (unsigned)f2bf(lo) | ((unsigned)f2bf(hi) << 16); }
#else
typedef __bf16 nbf16x2 __attribute__((ext_vector_type(2)));
typedef float nf32x2 __attribute__((ext_vector_type(2)));
__device__ __forceinline__ unsigned pk2(float lo, float hi) { const nf32x2 v = {lo, hi}; return __builtin_bit_cast(unsigned, __builtin_convertvector(v, nbf16x2)); }
__device__ __forceinline__ bf16 f2bf(float f) { return (bf16)(pk2(f, 0.0f) & 0xffffu); }
#endif
#ifdef EMU
__device__ __forceinline__ float frcp_(float x) { return 1.0f / x; }
#else
__device__ __forceinline__ float frcp_(float x) { return __builtin_amdgcn_rcpf(x); }
#endif
__device__ __forceinline__ float sigmoidf_(float x) { return frcp_(1.0f + __expf(-x)); }
__device__ __forceinline__ float siluf_(float x) { return x * frcp_(1.0f + __expf(-x)); }
__device__ __forceinline__ float logsigf_(float x) { return fminf(x, 0.0f) - log1pf(__expf(-fabsf(x))); }
__device__ __forceinline__ float logsig_fast(float x) { return fminf(x, 0.0f) - __logf(1.0f + __expf(-fabsf(x))); }
#ifdef EMU
__device__ __forceinline__ float row16_sum(float x) { x += __shfl_xor(x, 1); x += __shfl_xor(x, 2); x += __shfl_xor(x, 4); x += __shfl_xor(x, 8); return x; }
__device__ __forceinline__ float row16_max(float x) { x = fmaxf(x, __shfl_xor(x, 1)); x = fmaxf(x, __shfl_xor(x, 2)); x = fmaxf(x, __shfl_xor(x, 4)); x = fmaxf(x, __shfl_xor(x, 8)); return x; }
__device__ __forceinline__ float xrow_sum(float x) { x += __shfl_xor(x, 16); x += __shfl_xor(x, 32); return x; }
__device__ __forceinline__ float xrow_max(float x) { x = fmaxf(x, __shfl_xor(x, 16)); x = fmaxf(x, __shfl_xor(x, 32)); return x; }
#else
template <int CTRL> __device__ __forceinline__ float dpp_(float x) { return __builtin_bit_cast(float, __builtin_amdgcn_mov_dpp(__builtin_bit_cast(int, x), CTRL, 0xf, 0xf, true)); }
__device__ __forceinline__ float row16_sum(float x) { x += dpp_<0xB1>(x); x += dpp_<0x4E>(x); x += dpp_<0x141>(x); x += dpp_<0x128>(x); return x; }
__device__ __forceinline__ float row16_max(float x) { x = fmaxf(x, dpp_<0xB1>(x)); x = fmaxf(x, dpp_<0x4E>(x)); x = fmaxf(x, dpp_<0x141>(x)); x = fmaxf(x, dpp_<0x128>(x)); return x; }
__device__ __forceinline__ float xrow_sum(float x) {
    auto s = __builtin_amdgcn_permlane16_swap(fbits(x), fbits(x), false, false); x = bitsf(s[0]) + bitsf(s[1]);
    auto t = __builtin_amdgcn_permlane32_swap(fbits(x), fbits(x), false, false); return bitsf(t[0]) + bitsf(t[1]); }
__device__ __forceinline__ float xrow_max(float x) {
    auto s = __builtin_amdgcn_permlane16_swap(fbits(x), fbits(x), false, false); x = fmaxf(bitsf(s[0]), bitsf(s[1]));
    auto t = __builtin_amdgcn_permlane32_swap(fbits(x), fbits(x), false, false); return fmaxf(bitsf(t[0]), bitsf(t[1])); }
#endif
__device__ __forceinline__ float wave_sum(float v) { return xrow_sum(row16_sum(v)); }
__device__ __forceinline__ float wave_max(float v) { return xrow_max(row16_max(v)); }
#ifdef EMU
__device__ __forceinline__ float wave_prefix_sum(float v, int lane) {
#pragma unroll
    for (int o = 1; o < 64; o <<= 1) { float t = __shfl_up(v, o); if (lane >= o) v += t; }
    return v;
}
__device__ __forceinline__ float wave_prefix_max(float v, int lane) {
#pragma unroll
    for (int o = 1; o < 64; o <<= 1) { float t = __shfl_up(v, o); if (lane >= o) v = fmaxf(v, t); }
    return v;
}
#else
template <int CTRL, int RM> __device__ __forceinline__ float dppo_(float old, float x) { return __builtin_bit_cast(float, __builtin_amdgcn_update_dpp(__builtin_bit_cast(int, old), __builtin_bit_cast(int, x), CTRL, RM, 0xf, false)); }
__device__ __forceinline__ float wave_prefix_sum(float v, int) {
    v += dppo_<0x111, 0xf>(0.f, v); v += dppo_<0x112, 0xf>(0.f, v); v += dppo_<0x114, 0xf>(0.f, v); v += dppo_<0x118, 0xf>(0.f, v);
    v += dppo_<0x142, 0xa>(0.f, v); v += dppo_<0x143, 0xc>(0.f, v); return v;
}
__device__ __forceinline__ float wave_prefix_max(float v, int) {
    const float ninf = -INFINITY;
    v = fmaxf(v, dppo_<0x111, 0xf>(ninf, v)); v = fmaxf(v, dppo_<0x112, 0xf>(ninf, v)); v = fmaxf(v, dppo_<0x114, 0xf>(ninf, v)); v = fmaxf(v, dppo_<0x118, 0xf>(ninf, v));
    v = fmaxf(v, dppo_<0x142, 0xa>(ninf, v)); v = fmaxf(v, dppo_<0x143, 0xc>(ninf, v)); return v;
}
#endif
__device__ __forceinline__ float wave_suffix_max(float v, int lane) {
    return __shfl(wave_prefix_max(__shfl(v, 63 - lane), lane), 63 - lane);
}
__device__ __forceinline__ void unpack8(u32x4 v, float* f) {
    f[0] = bitsf(v.x << 16); f[1] = bitsf(v.x & 0xffff0000u); f[2] = bitsf(v.y << 16); f[3] = bitsf(v.y & 0xffff0000u);
    f[4] = bitsf(v.z << 16); f[5] = bitsf(v.z & 0xffff0000u); f[6] = bitsf(v.w << 16); f[7] = bitsf(v.w & 0xffff0000u);
}
__device__ __forceinline__ int orig_col(int n) {
    if (n < 1280) return n;
    if (n < 2304) return 2320 + (n - 1280);
    if (n < 3072) return 3376 + (n - 2304);
    if (n < 3088) return 1280 + (n - 3072);
    if (n < 3120) return 3344 + (n - 3088);
    if (n < NMAIN) return -1;
    return 1296 + (n - NMAIN);
}
__device__ __forceinline__ int chain_cid(int dir, int o) {
    if (dir == 0) return o;
    return o < NCC ? (NCC - 1 - o) : (NCH - 1 - (o - NCC));
}

__device__ __forceinline__ int swz(int row, int ch) { return row * 64 + ((ch ^ (row & 7)) << 3); }
__device__ __forceinline__ u32x4 pack8(const float* f) { u32x4 o; o.x = pk2(f[0], f[1]); o.y = pk2(f[2], f[3]); o.z = pk2(f[4], f[5]); o.w = pk2(f[6], f[7]); return o; }
__device__ __forceinline__ bf16x8 as_frag(u32x4 v) { return __builtin_bit_cast(bf16x8, v); }
#ifdef EMU
inline u32x2 lds_tr16(const bf16* p) { unsigned mine[2]; const unsigned long long a = (unsigned long long)p; mine[0] = (unsigned)a; mine[1] = (unsigned)(a >> 32);
    auto buf = emu::collective(mine, 2); const int l = emu::cur()->lane, g = l >> 4, i = l & 15; unsigned short e[4];
    for (int j = 0; j < 4; ++j) { const int src = 16 * g + 4 * j + (i >> 2); const bf16* q = (const bf16*)(((unsigned long long)buf[src][1] << 32) | buf[src][0]); e[j] = *(const unsigned short*)(q + (i & 3)); }
    u32x2 r; r.x = (unsigned)e[0] | ((unsigned)e[1] << 16); r.y = (unsigned)e[2] | ((unsigned)e[3] << 16); return r; }
#else
typedef short v4i16_t __attribute__((ext_vector_type(4)));
__device__ __forceinline__ u32x2 lds_tr16(const bf16* p) { return __builtin_bit_cast(u32x2, __builtin_amdgcn_ds_read_tr16_b64_v4i16((__attribute__((address_space(3))) v4i16_t*)p)); }
#endif
__device__ __forceinline__ u32x4 as_u4(bf16x8 v) { return __builtin_bit_cast(u32x4, v); }

constexpr int LS = 72;

template <int NTL, int KS>
__device__ __forceinline__ void mma_nt(const bf16* A, int lda, int m0, const bf16* B, int ldb, int n0, f32x4 (&acc)[NTL], int lane) {
    const int r = lane & 15, q = lane >> 4;
#pragma unroll
    for (int ks = 0; ks < KS; ++ks) {
        const bf16x8 a = *(const bf16x8*)(A + (m0 + r) * lda + ks * 32 + q * 8);
#pragma unroll
        for (int nt = 0; nt < NTL; ++nt) {
            const bf16x8 b = *(const bf16x8*)(B + (n0 + nt * 16 + r) * ldb + ks * 32 + q * 8);
            acc[nt] = MFMA16(a, b, acc[nt]);
        }
    }
}

__device__ __forceinline__ void layer_prep(const Params& p, int l, int idx, int stride, char* smem);
__device__ __forceinline__ void phase0(const Params& p, char* smem) {
    const int tid = otid();
    cpx* TW = (cpx*)(p.ws + WS_TW);
    cpx* ROPE = (cpx*)(p.ws + WS_ROPE);
    float* MOD = (float*)(p.ws + WS_MOD);
    constexpr int N_TW = NF / NT, N_ROPE = SEQ * 32 / NT, N_MOD = DEPTH * (3 * DM / 64);
    for (int task = obid(); task < N_TW + N_ROPE + N_MOD; task += gridDim.x) {
        if (task < N_TW) {
            const int j = task * NT + tid; float s, c; sincospif(2.0f * (float)j / (float)NF, &s, &c);
            cpx v; v.x = c; v.y = -s; TW[j] = v;
        } else if (task < N_TW + N_ROPE) {
            const int idx = (task - N_TW) * NT + tid; const int pos = idx >> 5, i = idx & 31;
            const float inv = exp2f(-(float)(i & 15) * (13.287712379549449f / 16.0f));
            const float ang = (float)(i < 16 ? pos / 64 : pos % 64) * inv;
            cpx v; v.x = cosf(ang); v.y = sinf(ang); ROPE[idx] = v;
        } else {
            const int mt = task - N_TW - N_ROPE; const int l = mt / (3 * DM / 64), n0 = (mt % (3 * DM / 64)) * 64;
            float* sv = (float*)smem;
            float* red = sv + NJ * DM;
            __syncthreads();
            for (int i = tid; i < NJ * DM; i += NT) { const int j = i / DM, k = i % DM; const float v = j < NB ? p.in[I_C][j * DM + k] : p.in[I_CCTX][k]; sv[i] = siluf_(v); }
            __syncthreads();
            const int c4 = tid & 15, kg = tid >> 4; f32x4 acc[NJ];
#pragma unroll
            for (int j = 0; j < NJ; ++j) acc[j] = (f32x4){0.f, 0.f, 0.f, 0.f};
            const float* w = p.in[I_WADA] + (size_t)l * DM * 3 * DM + n0 + 4 * c4;
#pragma unroll 8
            for (int i = 0; i < DM / 32; ++i) { const int k = kg + 32 * i; const f32x4 wv = *(const f32x4*)(w + (size_t)k * 3 * DM);
#pragma unroll
                for (int j = 0; j < NJ; ++j) acc[j] = acc[j] + wv * sv[j * DM + k]; }
#pragma unroll
            for (int j = 0; j < NJ; ++j) *(f32x4*)(red + (kg * NJ + j) * 64 + 4 * c4) = acc[j];
            __syncthreads();
            for (int i = tid; i < NJ * 64; i += NT) { const int j = i / 64, n = i % 64; float s = 0.f;
#pragma unroll
                for (int k8 = 0; k8 < 32; ++k8) s += red[(k8 * NJ + j) * 64 + n];
                MOD[((size_t)l * NJ + j) * 3 * DM + n0 + n] = s + p.in[I_BADA][(size_t)l * 3 * DM + n0 + n]; }
        }
    }
}

#ifdef EMU
constexpr int PANEL_ROWS = 128, PANEL_UNITS = DM / 128;
#else
constexpr int PANEL_ROWS = 256, PANEL_UNITS = DM / 256;
#endif
__device__ __forceinline__ unsigned* unit_counter(const Params& p, int isctx) { return (unsigned*)(p.ws + WS_BAR + 16384) + 64 * isctx; }
__device__ __forceinline__ unsigned* stage_counter(const Params& p, int flag) { return (unsigned*)(p.ws + WS_BAR + 16384) + 512 + 512 * flag; }
__device__ __forceinline__ void stage_signal(const Params& p, char* smem, int flag, int l) {
#ifdef EMU
    __syncthreads(); if (otid() == 0) *stage_counter(p, flag) += 1u;
#else
    asm volatile("s_waitcnt vmcnt(0)" ::: "memory"); __syncthreads();
    if (threadIdx.x == 0) {
        const unsigned xcc = (unsigned)__builtin_amdgcn_s_getreg((3 << 11) | 20) & 0xFu, nloc = ((volatile __attribute__((address_space(3))) unsigned*)(smem + LDS_BYTES - 64))[0];
        unsigned* g = stage_counter(p, flag);
        if (nloc > 0u) { const unsigned old = __hip_atomic_fetch_add(g + 16 * (1 + xcc), 1u, __ATOMIC_RELAXED, __HIP_MEMORY_SCOPE_AGENT);
            if (old + 1u == nloc * (unsigned)(l + 1)) { __builtin_amdgcn_fence(__ATOMIC_RELEASE, "agent"); asm volatile("s_waitcnt vmcnt(0)" ::: "memory");
                __hip_atomic_fetch_add(g, nloc, __ATOMIC_RELAXED, __HIP_MEMORY_SCOPE_AGENT); } }
        else { __builtin_amdgcn_fence(__ATOMIC_RELEASE, "agent"); asm volatile("s_waitcnt vmcnt(0)" ::: "memory"); __hip_atomic_fetch_add(g, 1u, __ATOMIC_RELAXED, __HIP_MEMORY_SCOPE_AGENT); }
    }
#endif
}
__device__ __forceinline__ void stage_wait(const Params& p, int flag, int l) {
    if (otid() == 0) { const unsigned target = (unsigned)gridDim.x * (unsigned)(l + 1);
#ifdef EMU
        while (*(volatile unsigned*)stage_counter(p, flag) < target) emu::yield();
#else
        unsigned spins = 0;
        while (__hip_atomic_load(stage_counter(p, flag), __ATOMIC_RELAXED, __HIP_MEMORY_SCOPE_AGENT) < target) { __builtin_amdgcn_s_sleep(16); if (++spins > (1u << 20)) break; }
        __builtin_amdgcn_fence(__ATOMIC_ACQUIRE, "agent"); asm volatile("s_waitcnt vmcnt(0)" ::: "memory");
#endif
    }
    __syncthreads();
}
__device__ __forceinline__ int logical_row(int i) { return i < NB * SEQ ? (i / SEQ) * TOK + CTXL + i % SEQ : ((i - NB * SEQ) / CTXL) * TOK + (i - NB * SEQ) % CTXL; }
struct RowRef { const float* xo; float* xn; int mj, row; bool ok; };
__device__ __forceinline__ RowRef rp_ref(const Params& p, int l, int li, int base, int hi) {
    RowRef r; r.ok = li < hi; const int rr = logical_row(r.ok ? li : base); r.row = rr;
    const int b = rr / TOK, pp = rr % TOK; const bool isctx = pp < CTXL; if (l == DEPTH && isctx) r.ok = false;
    const size_t off = isctx ? ((size_t)b * CTXL + pp) * DM : ((size_t)b * SEQ + (pp - CTXL)) * DM;
    float* CTXB = (float*)(p.ws + WS_CTXB);
    r.xo = (l <= 1) ? (isctx ? p.in[I_CTX] + off : p.in[I_X] + off) : (isctx ? CTXB + off : p.out + off);
    r.xn = isctx ? CTXB + off : p.out + off; r.mj = isctx ? NB : b; return r;
}
__device__ __forceinline__ void rp_rows(const Params& p, int l, int lo, int hi, int gi, int nb) {
    const int tid = otid(), lane = tid & 63, wave = tid >> 6;
    const float* MOD = (const float*)(p.ws + WS_MOD);
    const bf16* YO = (const bf16*)(p.ws + WS_P);
    bf16* HN = (bf16*)(p.ws + WS_HNY);
    constexpr int NV4 = DM / 256, RW = 2;
    const int stride = nb * 8;
    f32x4 xq[RW][NV4]; u32x2 yq[RW][NV4]; RowRef rq[RW];
    int base = lo + gi * 8 + wave;
    if (base < hi) {
#pragma unroll
        for (int i = 0; i < RW; ++i) { rq[i] = rp_ref(p, l, base + i * stride, base, hi);
#pragma unroll
            for (int j = 0; j < NV4; ++j) { xq[i][j] = *(const f32x4*)(rq[i].xo + 4 * lane + 256 * j); yq[i][j] = (l > 0) ? *(const u32x2*)(YO + (size_t)rq[i].row * DM + 4 * lane + 256 * j) : (u32x2){0u, 0u}; } }
    }
    for (; base < hi; base += stride * RW) {
        f32x4 x[RW][NV4], y[RW][NV4]; RowRef rc[RW];
#pragma unroll
        for (int i = 0; i < RW; ++i) { rc[i] = rq[i];
#pragma unroll
            for (int j = 0; j < NV4; ++j) { x[i][j] = xq[i][j]; const u32x2 yy = yq[i][j]; y[i][j] = (f32x4){bitsf(yy.x << 16), bitsf(yy.x & 0xffff0000u), bitsf(yy.y << 16), bitsf(yy.y & 0xffff0000u)}; } }
        { const int nbase = base + stride * RW;
            if (nbase < hi) {
#pragma unroll
                for (int i = 0; i < RW; ++i) { rq[i] = rp_ref(p, l, nbase + i * stride, nbase, hi);
#pragma unroll
                    for (int j = 0; j < NV4; ++j) { xq[i][j] = *(const f32x4*)(rq[i].xo + 4 * lane + 256 * j); if (l > 0) yq[i][j] = *(const u32x2*)(YO + (size_t)rq[i].row * DM + 4 * lane + 256 * j); } } } }
        if (l > 0) {
            float ss[RW];
#pragma unroll
            for (int i = 0; i < RW; ++i) { ss[i] = 0.f;
#pragma unroll
                for (int j = 0; j < NV4; ++j) ss[i] += y[i][j].x * y[i][j].x + y[i][j].y * y[i][j].y + y[i][j].z * y[i][j].z + y[i][j].w * y[i][j].w; }
#pragma unroll
            for (int i = 0; i < RW; ++i) ss[i] = wave_sum(ss[i]);
            const float* gp = p.in[I_GPOST] + (size_t)(l - 1) * DM;
#pragma unroll
            for (int i = 0; i < RW; ++i) { const float rstd = rsqrtf(ss[i] * (1.0f / DM) + EPS); const float* gt = MOD + ((size_t)(l - 1) * NJ + rc[i].mj) * 3 * DM + 2 * DM;
#pragma unroll
                for (int j = 0; j < NV4; ++j) { const f32x4 g4 = *(const f32x4*)(gt + 4 * lane + 256 * j), p4 = *(const f32x4*)(gp + 4 * lane + 256 * j);
                    x[i][j] = x[i][j] + g4 * (y[i][j] * rstd * p4);
                    if (rc[i].ok) *(f32x4*)(rc[i].xn + 4 * lane + 256 * j) = x[i][j]; } }
        }
        if (l < DEPTH) {
            float ss[RW];
#pragma unroll
            for (int i = 0; i < RW; ++i) { ss[i] = 0.f;
#pragma unroll
                for (int j = 0; j < NV4; ++j) ss[i] += x[i][j].x * x[i][j].x + x[i][j].y * x[i][j].y + x[i][j].z * x[i][j].z + x[i][j].w * x[i][j].w; }
#pragma unroll
            for (int i = 0; i < RW; ++i) ss[i] = wave_sum(ss[i]);
            const float* gp = p.in[I_GPRE] + (size_t)l * DM;
#pragma unroll
            for (int i = 0; i < RW; ++i) { const float rstd = rsqrtf(ss[i] * (1.0f / DM) + EPS); const float* md = MOD + ((size_t)l * NJ + rc[i].mj) * 3 * DM; const int row = rc[i].row;
#pragma unroll
                for (int j = 0; j < NV4; ++j) { const int e = 4 * lane + 256 * j;
                    const f32x4 g4 = *(const f32x4*)(gp + e), sh = *(const f32x4*)(md + e), sc = *(const f32x4*)(md + DM + e);
                    const f32x4 h = (x[i][j] * rstd * g4) * (sc + 1.0f) + sh;
                    u32x2 o; o.x = pk2(h.x, h.y); o.y = pk2(h.z, h.w);
                    if (rc[i].ok) *(u32x2*)(HN + (size_t)row * DM + e) = o; } }
        }
    }
}

__device__ __forceinline__ void convert_tile(const float* src, int ldn, bf16* dst, int K, int n0, int k0, bool use_map, char* smem) {
    const int tid = otid();
    float* tile = (float*)smem;
    __syncthreads();
#pragma unroll
    for (int i = 0; i < 8; ++i) { const int idx = tid + NT * i, k = idx >> 6, n = idx & 63;
        const int oc = use_map ? orig_col(n0 + n) : (n0 + n);
        tile[k * 65 + n] = oc >= 0 ? src[(size_t)(k0 + k) * ldn + oc] : 0.f; }
    __syncthreads();
    const int n = tid >> 3, c = tid & 7;
    u32x4 o; o.x = pk2(tile[(8 * c + 0) * 65 + n], tile[(8 * c + 1) * 65 + n]); o.y = pk2(tile[(8 * c + 2) * 65 + n], tile[(8 * c + 3) * 65 + n]);
    o.z = pk2(tile[(8 * c + 4) * 65 + n], tile[(8 * c + 5) * 65 + n]); o.w = pk2(tile[(8 * c + 6) * 65 + n], tile[(8 * c + 7) * 65 + n]);
    *(u32x4*)(dst + (size_t)(n0 + n) * K + k0 + 8 * c) = o;
}

__device__ __forceinline__ void filter_task(const Params& p, int l, int L, int pos0, char* smem) {
    const int tid = otid(), j = tid & 63;
    float* z = (float*)smem;
    float* h1 = z + 8 * 33;
    float* h2 = h1 + 8 * 64;
    const float* w1 = p.in[I_HW1] + (size_t)l * 33 * 64; const float* w2 = p.in[I_HW2] + (size_t)l * 64 * 64; const float* w3 = p.in[I_HW3] + (size_t)l * 64 * 512;
    float r1[33], r2[64], r3a[16];
#pragma unroll
    for (int i = 0; i < 33; ++i) r1[i] = w1[i * 64 + j];
#pragma unroll
    for (int i = 0; i < 64; ++i) r2[i] = w2[i * 64 + j];
    const float b1 = p.in[I_HB1][l * 64 + j], b2 = p.in[I_HB2][l * 64 + j], b3 = p.in[I_HB3][l * 512 + tid];
    const float f0 = p.in[I_HFREQ][(l * 2 + 0) * 64 + j], f1 = p.in[I_HFREQ][(l * 2 + 1) * 64 + j];
    __syncthreads();
    if (tid < 8 * 33) { const int pp = tid / 33, i = tid % 33; const float pos = (float)(pos0 + pp);
        const float t = pos / (float)(L - 1 > 1 ? L - 1 : 1), wv = 6.283185307179586f * pos / (float)L; float v;
        if (i == 0) v = t; else { const int bi = (i - 1) & 15; const float f = 1e-4f + (float)bi * ((15.0f - 1e-4f) / 15.0f); v = (i <= 16) ? cosf(wv * f) : -sinf(wv * f); }
        z[tid] = v; }
    __syncthreads();
    { const int pp = tid >> 6; float a = b1;
#pragma unroll
        for (int i = 0; i < 33; ++i) a += z[pp * 33 + i] * r1[i];
        h1[tid] = sinf(f0 * a);
#pragma unroll
        for (int i = 0; i < 16; ++i) r3a[i] = w3[i * 512 + tid]; }
    __syncthreads();
    { const int pp = tid >> 6; float a = b2;
#pragma unroll
        for (int i = 0; i < 64; ++i) a += h1[pp * 64 + i] * r2[i];
        h2[tid] = sinf(f1 * a); }
    __syncthreads();
    { const int o = tid, dir = o >> 8, c = o & 255;
        const float delta = 3.0701134573253946f + (float)c * ((15.350567286626973f - 3.0701134573253946f) / 255.0f);
        float acc[8];
#pragma unroll
        for (int pp = 0; pp < 8; ++pp) acc[pp] = b3;
#pragma unroll 1
        for (int cix = 0; cix < 4; ++cix) {
            float wn[16];
#pragma unroll
            for (int i = 0; i < 16; ++i) wn[i] = (cix < 3) ? w3[(16 * (cix + 1) + i) * 512 + o] : 0.f;
#pragma unroll
            for (int i = 0; i < 16; ++i) {
#pragma unroll
                for (int pp = 0; pp < 8; ++pp) acc[pp] += h2[pp * 64 + 16 * cix + i] * r3a[i]; }
#pragma unroll
            for (int i = 0; i < 16; ++i) r3a[i] = wn[i]; }
        float* KT = (float*)(p.ws + WS_KT); float* HC = (float*)(p.ws + WS_HC);
#pragma unroll
        for (int pp = 0; pp < 8; ++pp) { const int pos = pos0 + pp; const float t = (float)pos / (float)(L - 1 > 1 ? L - 1 : 1);
            const float v = acc[pp] * __expf(-t * delta);
            if (L == SEQ) { if (dir == 0) KT[(size_t)c * NF + pos]= v; else if (pos > 0) KT[(size_t)c * NF + (NF - pos)] = v; else KT[(size_t)c * NF + SEQ] = 0.f; }
            else HC[((size_t)dir * WG + c) * CTXL + pos] = v; }
    }
}

__device__ __forceinline__ void convert_tile_w(const float* src, int ldn, bf16* dst, int K, int n0, int k0, bool use_map, char* wl, int lane) {
    float* tile = (float*)wl;
    const int oc = use_map ? orig_col(n0 + lane) : (n0 + lane);
    float v[64];
#pragma unroll
    for (int k = 0; k < 64; ++k) v[k] = oc >= 0 ? src[(size_t)(k0 + k) * ldn + oc] : 0.f;
#pragma unroll
    for (int k = 0; k < 64; ++k) tile[k * 65 + lane] = v[k];
    WAVE_SYNC();
#pragma unroll
    for (int i = 0; i < 8; ++i) { const int n = (lane >> 3) + 8 * i, c = lane & 7; float f[8];
#pragma unroll
        for (int j = 0; j < 8; ++j) f[j] = tile[(8 * c + j) * 65 + n];
        *(u32x4*)(dst + (size_t)(n0 + n) * K + k0 + 8 * c) = pack8(f); }
    WAVE_SYNC();
}
__device__ __forceinline__ void layer_prep(const Params& p, int l, int idx, int stride, char* smem) {
    constexpr int N_WIN = (NPAD / 64) * (DM / 64), N_FL = SEQ / 8, N_FC = CTXL / 8;
    for (int task = idx; task < N_FL + N_FC; task += stride) {
        if (task < N_FL) filter_task(p, l, SEQ, task * 8, smem);
        else filter_task(p, l, CTXL, (task - N_FL) * 8, smem);
    }
    __syncthreads();
    { const int tid = otid(), lane = tid & 63, wave = __builtin_amdgcn_readfirstlane(tid >> 6);
        char* wl = smem + wave * WLDS;
        for (int task = wave * stride + idx; task < N_WIN; task += 8 * stride) { const int nt = task / (DM / 64), kt = task % (DM / 64);
            convert_tile_w(p.in[I_WIN] + (size_t)l * DM * N_IN, N_IN, (bf16*)(p.ws + WS_WIN), DM, nt * 64, kt * 64, true, wl, lane); } }
}
__device__ __forceinline__ unsigned* row_queue(const Params& p, int l) { return (unsigned*)(p.ws + WS_BAR + 16384) + 2560 + 64 * l; }
__device__ __forceinline__ void wait_units(const Params& p, int c, int l) {
    constexpr int nLatU = NB * (SEQ / PANEL_ROWS) * PANEL_UNITS, nCtxU = NB * (CTXL / PANEL_ROWS) * PANEL_UNITS;
    const unsigned target = (unsigned)((c ? nCtxU : nLatU) * l);
#ifdef EMU
    while (*(volatile unsigned*)unit_counter(p, c) < target) emu::yield();
#else
    unsigned spins = 0;
    while (__hip_atomic_load(unit_counter(p, c), __ATOMIC_RELAXED, __HIP_MEMORY_SCOPE_AGENT) < target) { __builtin_amdgcn_s_sleep(16); if (++spins > (1u << 20)) break; }
    __builtin_amdgcn_fence(__ATOMIC_ACQUIRE, "agent"); asm volatile("s_waitcnt vmcnt(0)" ::: "memory");
#endif
}
__device__ __forceinline__ void phase_rp(const Params& p, int l, char* smem) { const int G = (int)gridDim.x, bid = obid(), tid = otid();
    const bool has_ctx = l < DEPTH;
    constexpr int nLatU = NB * (SEQ / PANEL_ROWS) * PANEL_UNITS, nCtxU = NB * (CTXL / PANEL_ROWS) * PANEL_UNITS;
    const int nU = nLatU + nCtxU;
    const int heavy = (l >= 1 && has_ctx && nU > G && (nU % G) != 0) ? nU % G : 0;
    const int total = heavy > 0 ? NB * SEQ : (has_ctx ? T : NB * SEQ);
    const int nl = G - heavy, np = (l < DEPTH) ? nl / 2 : 0, nr = nl - np;
    int lo, hi, gi, nb; bool prep = false;
    if (bid < heavy) { lo = NB * SEQ; hi = T; gi = bid; nb = heavy; }
    else { const int i = bid - heavy; int nR = total;
        if (np > 0) { nR = ((total * 2 / 3) / (nr * 16)) * (nr * 16); if (nR <= 0) nR = total / 2; }
        if (np > 0 && (i & 1) && i / 2 < np) { prep = true; lo = nR; hi = total; gi = i / 2; nb = np; }
        else { lo = 0; hi = nR; gi = (np > 0) ? (i + 1) / 2 : i; nb = nr; } }
    if (prep) layer_prep(p, l, gi, np, smem);
    else if (l < DEPTH && np == 0) layer_prep(p, l, bid, G, smem);
    if (l >= 1) { if (tid == 0) { if (lo < NB * SEQ) wait_units(p, 0, l); if (hi > NB * SEQ) wait_units(p, 1, l); } __syncthreads(); }
    rp_rows(p, l, lo, hi, gi, nb);
}

__device__ __forceinline__ cpx cmul(cpx a, cpx b) { cpx r; r.x = a.x * b.x - a.y * b.y; r.y = a.x * b.y + a.y * b.x; return r; }
__device__ __forceinline__ cpx cmulc(cpx a, cpx b) { cpx r; r.x = a.x * b.x + a.y * b.y; r.y = a.y * b.x - a.x * b.y; return r; }
constexpr int fpad(int i) { return i + (i >> 4); }
__device__ __forceinline__ int FPH(int i) { return i + (i >> 4); }
constexpr int FBUF = fpad(NF);
constexpr int ilog16(int n) { return n < 16 ? 0 : 1 + ilog16(n / 16); }
constexpr int FFT_P16 = ilog16(NF);
constexpr bool FFT_R4 = ((NF >> (4 * FFT_P16)) == 4);
static_assert((NF >> (4 * FFT_P16)) == 1 || (NF >> (4 * FFT_P16)) == 4, "NF = 16^a * (1 or 4)");
template <bool INV> __device__ __forceinline__ void dft4(cpx& a0, cpx& a1, cpx& a2, cpx& a3) {
    const cpx s = {a0.x + a2.x, a0.y + a2.y}, b = {a0.x - a2.x, a0.y - a2.y}, c = {a1.x + a3.x, a1.y + a3.y}, d = {a1.x - a3.x, a1.y - a3.y};
    a0 = (cpx){s.x + c.x, s.y + c.y}; a2 = (cpx){s.x - c.x, s.y - c.y};
    if (!INV) { a1 = (cpx){b.x + d.y, b.y - d.x}; a3 = (cpx){b.x - d.y, b.y + d.x}; }
    else      { a1 = (cpx){b.x - d.y, b.y + d.x}; a3 = (cpx){b.x + d.y, b.y - d.x}; }
}
template <bool INV> __device__ __forceinline__ cpx cmulk(cpx a, float wr, float wi) {
    cpx r; if (!INV) { r.x = a.x * wr + a.y * wi; r.y = a.y * wr - a.x * wi; } else { r.x = a.x * wr - a.y * wi; r.y = a.y * wr + a.x * wi; } return r;
}
template <bool INV> __device__ __forceinline__ void dft16(cpx (&x)[16]) {
    constexpr float C1 = 0.92387953251128674f, S1 = 0.38268343236508977f, C2 = 0.70710678118654752f;
#pragma unroll
    for (int n2 = 0; n2 < 4; ++n2) dft4<INV>(x[n2], x[4 + n2], x[8 + n2], x[12 + n2]);
    x[4 * 1 + 1] = cmulk<INV>(x[4 * 1 + 1], C1, S1); x[4 * 1 + 2] = cmulk<INV>(x[4 * 1 + 2], C2, C2); x[4 * 1 + 3] = cmulk<INV>(x[4 * 1 + 3], S1, C1);
    x[4 * 2 + 1] = cmulk<INV>(x[4 * 2 + 1], C2, C2); x[4 * 2 + 2] = cmulk<INV>(x[4 * 2 + 2], 0.f, 1.f); x[4 * 2 + 3] = cmulk<INV>(x[4 * 2 + 3], -C2, C2);
    x[4 * 3 + 1] = cmulk<INV>(x[4 * 3 + 1], S1, C1); x[4 * 3 + 2] = cmulk<INV>(x[4 * 3 + 2], -C2, C2); x[4 * 3 + 3] = cmulk<INV>(x[4 * 3 + 3], -C1, -S1);
#pragma unroll
    for (int k1 = 0; k1 < 4; ++k1) dft4<INV>(x[4 * k1 + 0], x[4 * k1 + 1], x[4 * k1 + 2], x[4 * k1 + 3]);
    cpx t;
    t = x[1]; x[1] = x[4]; x[4] = t; t = x[2]; x[2] = x[8]; x[8] = t; t = x[3]; x[3] = x[12]; x[12] = t;
    t = x[6]; x[6] = x[9]; x[9] = t; t = x[7]; x[7] = x[13]; x[13] = t; t = x[11]; x[11] = x[14]; x[14] = t;
}
template <bool INV> __device__ __forceinline__ void fft_stage16(cpx* buf, const cpx* TW, int tl, int M) {
    const int span = M >> 4, twm = NF / M;
#pragma unroll 1
    for (int j = tl; j < NF / 16; j += 256) {
        const int grp = j / span, pos = j % span, base = grp * M + pos; cpx x[16];
#pragma unroll
        for (int q = 0; q < 16; ++q) x[q] = buf[FPH(base + q * span)];
        cpx w1 = {1.f, 0.f}; if (span > 1) w1 = TW[pos * twm];
        if (INV && span > 1) { cpx wk = w1;
#pragma unroll
            for (int k = 1; k < 16; ++k) { x[k] = cmulc(x[k], wk); wk = cmul(wk, w1); } }
        dft16<INV>(x);
        if (!INV && span > 1) { cpx wk = w1;
#pragma unroll
            for (int k = 1; k < 16; ++k) { x[k] = cmul(x[k], wk); wk = cmul(wk, w1); } }
#pragma unroll
        for (int q = 0; q < 16; ++q) buf[FPH(base + q * span)] = x[q];
    }
}
template <bool INV> __device__ __forceinline__ void fft_stage4_last(cpx* buf, int tl) {
#pragma unroll 1
    for (int j = tl; j < NF / 4; j += 256) { cpx a0 = buf[FPH(4 * j)], a1 = buf[FPH(4 * j + 1)], a2 = buf[FPH(4 * j + 2)], a3 = buf[FPH(4 * j + 3)];
        dft4<INV>(a0, a1, a2, a3); buf[FPH(4 * j)] = a0; buf[FPH(4 * j + 1)] = a1; buf[FPH(4 * j + 2)] = a2; buf[FPH(4 * j + 3)] = a3; }
}
__device__ __forceinline__ void fft_fwd(cpx* buf, const cpx* TW, int tl) {
    int M = NF;
#pragma unroll
    for (int s = 0; s < FFT_P16; ++s) { __syncthreads(); fft_stage16<false>(buf, TW, tl, M); M >>= 4; }
    if (FFT_R4) { __syncthreads(); fft_stage4_last<false>(buf, tl); }
    __syncthreads();
}
__device__ __forceinline__ void fft_inv(cpx* buf, const cpx* TW, int tl) {
    if (FFT_R4) { __syncthreads(); fft_stage4_last<true>(buf, tl); }
    int M = FFT_R4 ? 64 : 16;
#pragma unroll
    for (int s = 0; s < FFT_P16; ++s) { __syncthreads(); fft_stage16<true>(buf, TW, tl, M); M <<= 4; }
    __syncthreads();
}
__device__ __forceinline__ void filt_fft_task(const Params& p, int cp, char* smem) {
    const int tid = otid(), half = tid >> 8, tl = tid & 255, c = 2 * cp + half;
    cpx* buf = (cpx*)smem + (size_t)half * FBUF;
    const float* KT = (const float*)(p.ws + WS_KT) + (size_t)c * NF;
    cpx* KF = (cpx*)(p.ws + WS_KF) + (size_t)c * NF;
    const cpx* TW = (const cpx*)(p.ws + WS_TW);
    __syncthreads();
    for (int i = tl; i < NF; i += 256) { cpx v; v.x = KT[i]; v.y = 0.f; buf[FPH(i)] = v; }
    fft_fwd(buf, TW, tl);
    for (int i = tl; i < NF; i += 256) KF[i] = buf[FPH(i)];
}

__device__ __forceinline__ void gemm_tile(const Params& p, const bf16* A, const bf16* Bt, int K, int mt, int nt, int mode, char* smem) {
    const int tid = otid(), lane = tid & 63, wave = tid >> 6;
    bf16* As = (bf16*)smem;
    bf16* Bs = As + 128 * LS;
    const int wm = (wave & 3) * 32, wn = (wave >> 2) * 64;
    f32x4 acc[2][4];
#pragma unroll
    for (int i = 0; i < 2; ++i)
#pragma unroll
        for (int j = 0; j < 4; ++j) acc[i][j] = (f32x4){0.f, 0.f, 0.f, 0.f};
    const int lr = tid >> 3, lc = tid & 7;
    const bf16* Ag = A + (size_t)(mt * 128 + lr) * K + lc * 8;
    const bf16* Bg = Bt + (size_t)(nt * 128 + lr) * K + lc * 8;
    u32x4 ra0, ra1, rb0, rb1;
    ra0 = *(const u32x4*)(Ag); ra1 = *(const u32x4*)(Ag + (size_t)64 * K); rb0 = *(const u32x4*)(Bg); rb1 = *(const u32x4*)(Bg + (size_t)64 * K);
    const int nk = K / 64;
    for (int kt = 0; kt < nk; ++kt) {
        __syncthreads();
        *(u32x4*)(As + lr * LS + lc * 8) = ra0; *(u32x4*)(As + (lr + 64) * LS + lc * 8) = ra1;
        *(u32x4*)(Bs + lr * LS + lc * 8) = rb0; *(u32x4*)(Bs + (lr + 64) * LS + lc * 8) = rb1;
        __syncthreads();
        if (kt + 1 < nk) { const int ko = (kt + 1) * 64;
            ra0 = *(const u32x4*)(Ag + ko); ra1 = *(const u32x4*)(Ag + (size_t)64 * K + ko); rb0 = *(const u32x4*)(Bg + ko); rb1 = *(const u32x4*)(Bg + (size_t)64 * K + ko); }
        mma_nt<4, 2>(As, LS, wm, Bs, LS, wn, acc[0], lane);
        mma_nt<4, 2>(As, LS, wm + 16, Bs, LS, wn, acc[1], lane);
    }
    const int r = lane & 15, q = lane >> 4;
#pragma unroll
    for (int i = 0; i < 2; ++i)
#pragma unroll
        for (int j = 0; j < 4; ++j)
#pragma unroll
            for (int e = 0; e < 4; ++e) {
                const int row = mt * 128 + wm + 16 * i + 4 * q + e, col = nt * 128 + wn + 16 * j + r; const float v = acc[i][j][e];
                if (mode == 0) { if (col < NP) ((bf16*)(p.ws + WS_P))[(size_t)row * NP + col] = f2bf(v); else if (col < NP + 16) ((float*)(p.ws + WS_G))[(size_t)row * NGS + (col - NP)] = v; else if (col < NP + NG) ((bf16*)((float*)(p.ws + WS_G) + (size_t)row * NGS + 16))[col - NP - 16] = f2bf(v); }
                else if (mode == 2) ((bf16*)(p.ws + WS_HT))[(size_t)row * T + col] = f2bf(v);
                else ((bf16*)(p.ws + WS_P))[(size_t)row * DM + col] = f2bf(v);
            }
}

#ifndef EMU
namespace pg8 {
#define PG8_LAS __attribute__((address_space(3)))
typedef unsigned short bf16_t;
typedef short bf16x8 __attribute__((ext_vector_type(8)));
typedef float f32x4 __attribute__((ext_vector_type(4)));
typedef unsigned u32x4 __attribute__((ext_vector_type(4)));
constexpr int BM = 256, BK = 64, HALF = 128, HTB = HALF * BK * 2  , STAGE_BYTES = 8 * HTB, NXCD = 8, WGM = 8;

__host__ __device__ __forceinline__ int lds_byte(int r, int c) { const int st = (r >> 4) * 2 + (c >> 5), rr = r & 15, cc = c & 31, ob = rr * 64 + cc * 2; return st * 1024 + (ob ^ (((ob >> 9) & 1) << 5)); }
__host__ __device__ __forceinline__ void stage_rc(int b, int& R, int& C) { const int st = b / 1024, sb = b % 1024, swz = sb ^ (((sb >> 9) & 1) << 5); R = (st >> 1) * 16 + swz / 64; C = (st & 1) * 32 + (swz % 64) / 2; }
__host__ __device__ __forceinline__ int perm32(int rho) { const int n = rho >> 4, i = rho & 15; return 8 * (i >> 2) + 4 * n + (i & 3); }

struct Unit { int pm, pn; };
struct Gemm { const bf16_t* A; const bf16_t* Bt; int M, N, K; };
__device__ __forceinline__ unsigned cvt_pk_bf16(float lo, float hi) { unsigned r; asm volatile("v_cvt_pk_bf16_f32 %0, %1, %2" : "=v"(r) : "v"(lo), "v"(hi)); return r; }
template <class Epi, class Sched, bool ALIGN_EPI = false, bool SP2 = false>
__device__ __forceinline__ void gemm_phase(PG8_LAS unsigned char* lds, const Gemm g, const Sched& S, const Epi& E) {
    const int tid = otid(), wid = __builtin_amdgcn_readfirstlane(tid >> 6), lane = tid & 63, wr = wid >> 2, wc = wid & 3, fr = lane & 15, fq = lane >> 4;
    const int K = g.K, nt = K / BK;
    unsigned voffA[2], voffB[2];
#pragma unroll
    for (int i = 0; i < 2; ++i) { int R, C; stage_rc(tid * 16 + i * 8192, R, C); const int Rb = Epi::PERM ? ((R & ~31) + perm32(R & 31)) : R;
        voffA[i] = (unsigned)(R * K + C) * 2u; voffB[i] = (unsigned)(Rb * K + C) * 2u; }
    const size_t kstep = (size_t)(BK * 2);
    const size_t hstep = (size_t)HALF * K * 2;
    const size_t tstep = 2 * hstep;
    const unsigned ldsw = (unsigned)wid * 1024u;
    const int aoff = lds_byte(wr * 64 + fr, fq * 8), boff = lds_byte(wc * 32 + fr, fq * 8);
#define PG8_SA(b, h) (((b) * 2 + (h)) * HTB)
#define PG8_SB(b, h) ((4 + (b) * 2 + (h)) * HTB)
#define PG8_STAGE(bufoff, gbase, voff) do { _Pragma("unroll") for (int _i = 0; _i < 2; ++_i) \
        __builtin_amdgcn_global_load_lds((const unsigned*)((const char*)(gbase) + (voff)[_i]), (PG8_LAS unsigned*)(lds + (bufoff) + ldsw + _i * 8192), 16, 0, 0); } while (0)
#define PG8_LDA(dst, b, h) do { _Pragma("unroll") for (int m = 0; m < 4; ++m) _Pragma("unroll") for (int k = 0; k < 2; ++k) dst[m][k] = *(const PG8_LAS bf16x8*)(lds + PG8_SA(b, h) + aoff + m * 2048 + k * 1024); } while (0)
#define PG8_LDB(dst, b, h) do { _Pragma("unroll") for (int n = 0; n < 2; ++n) _Pragma("unroll") for (int k = 0; k < 2; ++k) dst[n][k] = *(const PG8_LAS bf16x8*)(lds + PG8_SB(b, h) + boff + n * 2048 + k * 1024); } while (0)
#define PG8_MMA(ai, bj, At, Bt) do { __builtin_amdgcn_s_setprio(1); _Pragma("unroll") for (int m = 0; m < 4; ++m) _Pragma("unroll") for (int n = 0; n < 2; ++n) _Pragma("unroll") for (int k = 0; k < 2; ++k) \
        acc[ai][bj][m][n] = __builtin_amdgcn_mfma_f32_16x16x32_bf16(Bt[n][k], At[m][k], acc[ai][bj][m][n], 0, 0, 0); __builtin_amdgcn_s_setprio(0); } while (0)
#define PG8_WAIT_V(n) asm volatile("s_waitcnt vmcnt(" #n ")" ::: "memory")
#define PG8_WAIT_L(n) asm volatile("s_waitcnt lgkmcnt(" #n ")" ::: "memory")
#define PG8_BAR __builtin_amdgcn_s_barrier()
#define PG8_SCHED __builtin_amdgcn_sched_barrier(0)
    Unit cur, nxt; int ui = 0;
    if (!S.next(0, cur)) return;
    f32x4 acc[2][2][4][2];
#pragma unroll
    for (int a = 0; a < 2; ++a)
#pragma unroll
        for (int b = 0; b < 2; ++b)
#pragma unroll
            for (int m = 0; m < 4; ++m)
#pragma unroll
                for (int n = 0; n < 2; ++n) acc[a][b][m][n] = (f32x4){0.f, 0.f, 0.f, 0.f};
    bf16x8 At[4][2], B0[2][2], B1[2][2];
    const char* cA = (const char*)g.A + (size_t)cur.pm * tstep; const char* cB = (const char*)g.Bt + (size_t)cur.pn * tstep;
    S.a_ready(cur);
    if constexpr (SP2) {
        PG8_STAGE(PG8_SB(0, 0), cB, voffB); PG8_STAGE(PG8_SB(0, 1), cB + hstep, voffB); PG8_STAGE(PG8_SA(0, 0), cA, voffA); PG8_STAGE(PG8_SA(0, 1), cA + hstep, voffA);
        if (wr == 1) PG8_BAR;
        PG8_WAIT_V(2); PG8_BAR;
        PG8_STAGE(PG8_SB(1, 0), cB + kstep, voffB); PG8_STAGE(PG8_SA(1, 0), cA + kstep, voffA); PG8_STAGE(PG8_SB(1, 1), cB + hstep + kstep, voffB);
        PG8_WAIT_V(6); PG8_BAR;
    } else {
        PG8_STAGE(PG8_SB(0, 0), cB, voffB); PG8_STAGE(PG8_SA(0, 0), cA, voffA); PG8_STAGE(PG8_SB(0, 1), cB + hstep, voffB); PG8_STAGE(PG8_SA(0, 1), cA + hstep, voffA);
        if (wr == 1) PG8_BAR;
        PG8_WAIT_V(4); PG8_BAR;
        PG8_STAGE(PG8_SB(1, 0), cB + kstep, voffB); PG8_STAGE(PG8_SA(1, 0), cA + kstep, voffA); PG8_STAGE(PG8_SB(1, 1), cB + hstep + kstep, voffB);
        PG8_WAIT_V(6); PG8_BAR;
    }
    for (;;) {
        const bool has_next = S.next(ui + 1, nxt);
        const char* nA = has_next ? (const char*)g.A + (size_t)nxt.pm * tstep : cA; const char* nB = has_next ? (const char*)g.Bt + (size_t)nxt.pn * tstep : cB;
        for (int t = 0; t < nt; t += 2) {
            const bool last = (t == nt - 2);
            const char* a1 = cA + (size_t)(t + 1) * kstep;
            const char* a2 = last ? nA : cA + (size_t)(t + 2) * kstep; const char* b2 = last ? nB : cB + (size_t)(t + 2) * kstep;
            const char* a3 = a2 + kstep; const char* b3 = b2 + kstep;
            if (last && has_next) S.a_ready(nxt);
            if constexpr (SP2) {
            PG8_LDB(B0, 0, 0); PG8_LDB(B1, 0, 1); PG8_SCHED; PG8_LDA(At, 0, 0); PG8_STAGE(PG8_SA(1, 1), a1 + hstep, voffA);
            PG8_WAIT_V(8); PG8_WAIT_L(0); PG8_BAR; PG8_MMA(0, 0, At, B0); PG8_MMA(0, 1, At, B1); PG8_BAR; PG8_SCHED;
            PG8_LDA(At, 0, 1); PG8_STAGE(PG8_SB(0, 0), b2, voffB); PG8_STAGE(PG8_SB(0, 1), b2 + hstep, voffB); PG8_STAGE(PG8_SA(0, 0), a2, voffA);
            PG8_WAIT_V(8); PG8_WAIT_L(0); PG8_BAR; PG8_MMA(1, 0, At, B0); PG8_MMA(1, 1, At, B1); PG8_BAR; PG8_SCHED;
            PG8_LDB(B0, 1, 0); PG8_LDB(B1, 1, 1); PG8_SCHED; PG8_LDA(At, 1, 0); PG8_STAGE(PG8_SA(0, 1), a2 + hstep, voffA);
            PG8_WAIT_V(8); PG8_WAIT_L(0); PG8_BAR; PG8_MMA(0, 0, At, B0); PG8_MMA(0, 1, At, B1); PG8_BAR; PG8_SCHED;
            PG8_LDA(At, 1, 1); PG8_STAGE(PG8_SB(1, 0), b3, voffB); PG8_STAGE(PG8_SB(1, 1), b3 + hstep, voffB); PG8_STAGE(PG8_SA(1, 0), a3, voffA);
            PG8_WAIT_V(8); PG8_WAIT_L(0); PG8_BAR; PG8_MMA(1, 0, At, B0); PG8_MMA(1, 1, At, B1); PG8_BAR; PG8_SCHED;
            } else {
            PG8_LDB(B0, 0, 0); PG8_SCHED; PG8_LDA(At, 0, 0); PG8_STAGE(PG8_SA(1, 1), a1 + hstep, voffA);
            PG8_WAIT_L(8); PG8_BAR; PG8_WAIT_L(0); PG8_MMA(0, 0, At, B0); PG8_BAR; PG8_SCHED;
            PG8_LDB(B1, 0, 1); PG8_STAGE(PG8_SB(0, 0), b2, voffB);
            PG8_BAR; PG8_WAIT_L(0); PG8_MMA(0, 1, At, B1); PG8_BAR;
            PG8_LDA(At, 0, 1); PG8_STAGE(PG8_SA(0, 0), a2, voffA);
            PG8_BAR; PG8_WAIT_L(0); PG8_MMA(1, 0, At, B0); PG8_BAR; PG8_SCHED;
            PG8_STAGE(PG8_SB(0, 1), b2 + hstep, voffB);
            PG8_WAIT_V(6); PG8_BAR; PG8_MMA(1, 1, At, B1); PG8_BAR;
            PG8_LDB(B0, 1, 0); PG8_SCHED; PG8_LDA(At, 1, 0); PG8_STAGE(PG8_SA(0, 1), a2 + hstep, voffA);
            PG8_WAIT_L(8); PG8_BAR; PG8_WAIT_L(0); PG8_MMA(0, 0, At, B0); PG8_BAR; PG8_SCHED;
            PG8_LDB(B1, 1, 1); PG8_STAGE(PG8_SB(1, 0), b3, voffB);
            PG8_BAR; PG8_WAIT_L(0); PG8_MMA(0, 1, At, B1); PG8_BAR;
            PG8_LDA(At, 1, 1); PG8_STAGE(PG8_SA(1, 0), a3, voffA);
            PG8_BAR; PG8_WAIT_L(0); PG8_MMA(1, 0, At, B0); PG8_BAR; PG8_SCHED;
            PG8_STAGE(PG8_SB(1, 1), b3 + hstep, voffB);
            PG8_WAIT_V(6); PG8_BAR; PG8_MMA(1, 1, At, B1); PG8_BAR;
            }
        }
        if constexpr (ALIGN_EPI) { if (wr == 0) PG8_BAR; }
        if constexpr (!Epi::AFTER_DRAIN) { E(acc, cur, wr, wc, fr, fq); S.done(cur); }
        if (!has_next) break;
#pragma unroll
        for (int a = 0; a < 2; ++a)
#pragma unroll
            for (int b = 0; b < 2; ++b)
#pragma unroll
                for (int m = 0; m < 4; ++m)
#pragma unroll
                    for (int n = 0; n < 2; ++n) acc[a][b][m][n] = (f32x4){0.f, 0.f, 0.f, 0.f};
        cur = nxt; cA = nA; cB = nB; ++ui;
        if constexpr (ALIGN_EPI) { if (wr == 1) PG8_BAR; }
    }
    PG8_WAIT_V(0);
    if constexpr (!ALIGN_EPI) { if (wr == 0) PG8_BAR; }
    PG8_BAR;
    if constexpr (Epi::AFTER_DRAIN) { E.fused(acc, cur, wr, wc, fr, fq, lds, wid, lane); S.done(cur); }
#undef PG8_SA
#undef PG8_SB
#undef PG8_STAGE
#undef PG8_LDA
#undef PG8_LDB
#undef PG8_MMA
#undef PG8_WAIT_V
#undef PG8_WAIT_L
#undef PG8_BAR
#undef PG8_SCHED
}
__device__ __forceinline__ void map_tile(int L, int nM, int nN, int& pm, int& pn) {
    const int nwg = nM * nN; int wgid = L; { const int q = nwg / NXCD, r = nwg % NXCD, xcd = wgid % NXCD, off = wgid / NXCD; wgid = (xcd < r ? xcd * (q + 1) : r * (q + 1) + (xcd - r) * q) + off; }
    const int nig = WGM * nN, gid = wgid / nig, fm = gid * WGM, gsz = (nM - fm) < WGM ? (nM - fm) : WGM;
    pm = fm + ((wgid % nig) % gsz); pn = (wgid % nig) / gsz;
}
constexpr int MP = T / 256, WP = NMAIN / 256, NU2 = 4 * MP, NU1 = MP * WP;
struct InOrder { int G, c;
    __device__ __forceinline__ bool next(int i, Unit& u) const { const int L = i * G + c; if (L >= NU2 + NU1) return false; int a, b;
        if (L < NU2) { map_tile(L, 4, MP, a, b); u.pm = MP + WP + a; u.pn = b; } else { map_tile(L - NU2, MP, WP, a, b); u.pm = a; u.pn = MP + b; } return true; }
    __device__ __forceinline__ void a_ready(const Unit&) const {}
    __device__ __forceinline__ void done(const Unit&) const {}
};
struct EpiIn { static constexpr bool PERM = true, AFTER_DRAIN = false; bf16_t* P; float* G; bf16_t* HTp;
    __device__ __forceinline__ void operator()(const f32x4 (&acc)[2][2][4][2], const Unit& u, int wr, int wc, int fr, int fq) const {
        if (u.pm < MP) { const int pn = u.pn - MP, row0 = u.pm * BM + wr * 64 + fr;
            if (pn < NP / 256) { const int col0 = pn * BM + wc * 32 + 8 * fq;
#pragma unroll
                for (int ai = 0; ai < 2; ++ai)
#pragma unroll
                    for (int m = 0; m < 4; ++m) { bf16_t* rowp = P + (size_t)(row0 + ai * HALF + m * 16) * NP + col0;
#pragma unroll
                        for (int bj = 0; bj < 2; ++bj) { const f32x4 v0 = acc[ai][bj][m][0], v1 = acc[ai][bj][m][1];
                            u32x4 w; w.x = cvt_pk_bf16(v0[0], v0[1]); w.y = cvt_pk_bf16(v0[2], v0[3]); w.z = cvt_pk_bf16(v1[0], v1[1]); w.w = cvt_pk_bf16(v1[2], v1[3]); *(u32x4*)(rowp + bj * HALF) = w; } } }
            else { const int cb = wc * 32 + 8 * fq;
                if (cb < NG) {
#pragma unroll
                    for (int ai = 0; ai < 2; ++ai)
#pragma unroll
                        for (int m = 0; m < 4; ++m) { float* rowb = G + (size_t)(row0 + ai * HALF + m * 16) * NGS; const f32x4 v0 = acc[ai][0][m][0], v1 = acc[ai][0][m][1];
                            if (cb < 16) { *(f32x4*)(rowb + cb) = v0; *(f32x4*)(rowb + cb + 4) = v1; }
                            else { u32x4 w; w.x = cvt_pk_bf16(v0[0], v0[1]); w.y = cvt_pk_bf16(v0[2], v0[3]); w.z = cvt_pk_bf16(v1[0], v1[1]); w.w = cvt_pk_bf16(v1[2], v1[3]); *(u32x4*)((bf16_t*)(rowb + 16) + (cb - 16)) = w; } } } } }
        else { const int row0 = (u.pm - MP - WP) * BM + wr * 64 + fr, col0 = u.pn * BM + wc * 32 + 8 * fq;
#pragma unroll
            for (int ai = 0; ai < 2; ++ai)
#pragma unroll
                for (int m = 0; m < 4; ++m) { bf16_t* rowp = HTp + (size_t)(row0 + ai * HALF + m * 16) * T + col0;
#pragma unroll
                    for (int bj = 0; bj < 2; ++bj) { const f32x4 v0 = acc[ai][bj][m][0], v1 = acc[ai][bj][m][1];
                        u32x4 w; w.x = cvt_pk_bf16(v0[0], v0[1]); w.y = cvt_pk_bf16(v0[2], v0[3]); w.z = cvt_pk_bf16(v1[0], v1[1]); w.w = cvt_pk_bf16(v1[2], v1[3]); *(u32x4*)(rowp + bj * HALF) = w; } } }
    }
};
struct OutOrder { int G, c; bool lat_only; unsigned* cnt;
    __device__ __forceinline__ bool next(int i, Unit& u) const { constexpr int nN = DM / 256, nLat = NB * (SEQ / 256) * nN, nCtx = NB * (CTXL / 256) * nN; const int L = i * G + c; int a, b;
        if (L < nLat) { map_tile(L, nLat / nN, nN, a, b); u.pm = (a / (SEQ / 256)) * (TOK / 256) + CTXL / 256 + a % (SEQ / 256); }
        else { if (lat_only || L >= nLat + nCtx) return false; map_tile(L - nLat, nCtx / nN, nN, a, b); u.pm = (a / (CTXL / 256)) * (TOK / 256) + a % (CTXL / 256); }
        u.pn = b; return true; }
    __device__ __forceinline__ void a_ready(const Unit&) const {}
    unsigned* xu; unsigned nloc, xtarget;
    __device__ __forceinline__ void done(const Unit& u) const {
        asm volatile("s_waitcnt vmcnt(0)" ::: "memory"); __builtin_amdgcn_s_barrier();
        if (threadIdx.x == 0) { const bool isctx = (u.pm % (TOK / 256)) < CTXL / 256;
            if (!isctx && xtarget != 0u) {
                const unsigned old = __hip_atomic_fetch_add(xu, 1u, __ATOMIC_RELAXED, __HIP_MEMORY_SCOPE_AGENT);
                if (old + 1u == xtarget) { __builtin_amdgcn_fence(__ATOMIC_RELEASE, "agent"); asm volatile("s_waitcnt vmcnt(0)" ::: "memory");
                    __hip_atomic_fetch_add(cnt, nloc, __ATOMIC_RELAXED, __HIP_MEMORY_SCOPE_AGENT); } }
            else { __builtin_amdgcn_fence(__ATOMIC_RELEASE, "agent"); asm volatile("s_waitcnt vmcnt(0)" ::: "memory");
                __hip_atomic_fetch_add(cnt + (isctx ? 64 : 0), 1u, __ATOMIC_RELAXED, __HIP_MEMORY_SCOPE_AGENT); } } }
};
struct EpiOut { static constexpr bool PERM = true, AFTER_DRAIN = false; bf16_t* C;
    __device__ __forceinline__ void operator()(const f32x4 (&acc)[2][2][4][2], const Unit& u, int wr, int wc, int fr, int fq) const {
        const int row0 = u.pm * BM + wr * 64 + fr, col0 = u.pn * BM + wc * 32 + 8 * fq;
#pragma unroll
        for (int ai = 0; ai < 2; ++ai)
#pragma unroll
            for (int m = 0; m < 4; ++m) { bf16_t* rowp = C + (size_t)(row0 + ai * HALF + m * 16) * DM + col0;
#pragma unroll
                for (int bj = 0; bj < 2; ++bj) { const f32x4 v0 = acc[ai][bj][m][0], v1 = acc[ai][bj][m][1];
                    u32x4 w; w.x = cvt_pk_bf16(v0[0], v0[1]); w.y = cvt_pk_bf16(v0[2], v0[3]); w.z = cvt_pk_bf16(v1[0], v1[1]); w.w = cvt_pk_bf16(v1[2], v1[3]); *(u32x4*)(rowp + bj * HALF) = w; } }
    }
};
}
#endif

__device__ __forceinline__ void phase_gemm_in(const Params& p, int l, char* smem) {
    constexpr int N_F = WG / 2;
#ifdef EMU
    constexpr int MT = T / 128, NT1 = NMAIN / 128, N1 = MT * NT1, N2 = 8 * MT;
    for (int task = obid(); task < N1 + N2; task += gridDim.x) {
        if (task < N1) gemm_tile(p, (const bf16*)(p.ws + WS_HNY), (const bf16*)(p.ws + WS_WIN), DM, task / NT1, task % NT1, 0, smem);
        else { const int t2 = task - N1; gemm_tile(p, (const bf16*)(p.ws + WS_WIN) + (size_t)NMAIN * DM, (const bf16*)(p.ws + WS_HNY), DM, t2 / MT, t2 % MT, 2, smem); }
    }
#else
    { const pg8::Gemm g{(const pg8::bf16_t*)(p.ws + WS_HNY), (const pg8::bf16_t*)(p.ws + WS_HNY), 0, 0, DM};
      const pg8::InOrder S{(int)gridDim.x, obid()};
      const pg8::EpiIn E{(pg8::bf16_t*)(p.ws + WS_P), (float*)(p.ws + WS_G), (pg8::bf16_t*)(p.ws + WS_HT)};
      pg8::gemm_phase<pg8::EpiIn, pg8::InOrder, true, true>((PG8_LAS unsigned char*)smem, g, S, E); }
#endif
    { const int G = (int)gridDim.x, bid = obid();
#ifdef EMU
      const int extra = 0;
#else
      const int extra = (pg8::NU1 + pg8::NU2) % G;
#endif
      if (extra > 0 && extra < G) { if (bid >= extra) for (int task = bid - extra; task < N_F; task += G - extra) filt_fft_task(p, task, smem); }
      else for (int task = G - 1 - bid; task < N_F; task += G) filt_fft_task(p, task, smem); }
}
__device__ __forceinline__ void phase_gemm_out(const Params& p, int l, char* smem) {
    const int G = (int)gridDim.x, bid = obid(); const bool has_ctx = l < DEPTH - 1;
#ifdef EMU
    constexpr int MT = T / 128, NTO = DM / 128;
    for (int task = bid; task < MT * NTO; task += G) {
        const int mt = task / NTO, nt = task % NTO;
        if (!has_ctx && (mt % (TOK / 128)) < CTXL / 128) continue;
        gemm_tile(p, (const bf16*)(p.ws + WS_HNY), (const bf16*)(p.ws + WS_WOUT), MIX, mt, nt, 1, smem);
        __syncthreads(); if (otid() == 0) *unit_counter(p, (mt % (TOK / 128)) < CTXL / 128 ? 1 : 0) += 1u;
    }
#else
    const pg8::Gemm g{(const pg8::bf16_t*)(p.ws + WS_HNY), (const pg8::bf16_t*)(p.ws + WS_WOUT), 0, 0, MIX};
    const unsigned xcc = (unsigned)__builtin_amdgcn_s_getreg((3 << 11) | 20) & 0xFu, nloc = ((volatile PG8_LAS unsigned*)(smem + LDS_BYTES - 64))[0];
    const bool agg = (NB * (SEQ / 256) * (DM / 256) == G) && nloc > 0u;
    const pg8::OutOrder S{G, bid, !has_ctx, unit_counter(p, 0), unit_counter(p, 2) + 16 * xcc, nloc, agg ? nloc * (unsigned)(l + 1) : 0u};
    const pg8::EpiOut E{(pg8::bf16_t*)(p.ws + WS_P)};
    pg8::gemm_phase<pg8::EpiOut, pg8::OutOrder, true, true>((PG8_LAS unsigned char*)smem, g, S, E);
#endif
}

__device__ __forceinline__ size_t st_index(int mixer, int dir, int b, int h, int cid) { return ((((size_t)(mixer * 2 + dir) * NB + b) * NH + h) * NCH + cid); }
__device__ __forceinline__ size_t ch_index(int dir, int b, int h, int cid) { return (((size_t)dir * NB + b) * NH + h) * NCH + cid; }

__device__ __forceinline__ void load_tile_nat(const bf16* P, int r0, int c0, bf16* dst, float scale, int tid) {
    const int s = tid >> 3, c8 = tid & 7;
    const u32x4 v = *(const u32x4*)(P + (size_t)(r0 + s) * NP + c0 + c8 * 8);
    if (scale == 1.0f) *(u32x4*)(dst + s * LS + c8 * 8) = v;
    else { float f[8]; unpack8(v, f); u32x4 o; o.x = pk2(f[0] * scale, f[1] * scale); o.y = pk2(f[2] * scale, f[3] * scale); o.z = pk2(f[4] * scale, f[5] * scale); o.w = pk2(f[6] * scale, f[7] * scale);
        *(u32x4*)(dst + s * LS + c8 * 8) = o; }
}
__device__ __forceinline__ void load_tile_tr(const bf16* P, int r0, int c0, bf16* dst, int tid) {
    const int s = tid >> 3, c8 = tid & 7;
    const u32x4 v = *(const u32x4*)(P + (size_t)(r0 + s) * NP + c0 + c8 * 8);
    const unsigned w[4] = {v.x, v.y, v.z, v.w};
#pragma unroll
    for (int j = 0; j < 4; ++j) { dst[(c8 * 8 + 2 * j) * LS + s] = (bf16)(w[j] & 0xffffu); dst[(c8 * 8 + 2 * j + 1) * LS + s] = (bf16)(w[j] >> 16); }
}

template <int NTK>
__device__ __forceinline__ void load_span(const bf16* row, int t0, float (&v)[NTK + 2]) {
    { const bool hl = t0 > 0, hr = t0 + NTK < SEQ; const bf16 xl = row[hl ? -1 : 0], xr = row[hr ? NTK : 0];
        v[0] = hl ? bf2f(xl) : 0.f; v[NTK + 1] = hr ? bf2f(xr) : 0.f; }
    if constexpr (NTK == 8) { float f[8]; unpack8(*(const u32x4*)row, f);
#pragma unroll
        for (int i = 0; i < 8; ++i) v[1 + i] = f[i]; }
    else {
#pragma unroll
        for (int i = 0; i < NTK; ++i) v[1 + i] = bf2f(row[i]); }
}
template <int NTK>
__device__ __forceinline__ void hy_inputs(const bf16* h0, const bf16* h1, const float* cw, const float* cb, int c, int t0, float (&u0)[NTK], float (&u1)[NTK], float (&g0)[NTK], float (&g1)[NTK]) {
    { float xa[NTK + 2], xb[NTK + 2]; load_span<NTK>(h0 + (size_t)512 * T, t0, xa); load_span<NTK>(h1 + (size_t)512 * T, t0, xb);
        const float w0 = cw[0 * 768 + 512 + c], w1 = cw[1 * 768 + 512 + c], w2 = cw[2 * 768 + 512 + c], bb = cb[512 + c];
        float ga[NTK + 2], gb[NTK + 2]; load_span<NTK>(h0 + (size_t)768 * T, t0, ga); load_span<NTK>(h1 + (size_t)768 * T, t0, gb);
#pragma unroll
        for (int i = 0; i < NTK; ++i) { g0[i] = (w0 * xa[i] + w1 * xa[i + 1] + w2 * xa[i + 2] + bb) * siluf_(ga[i + 1]); g1[i] = (w0 * xb[i] + w1 * xb[i + 1] + w2 * xb[i + 2] + bb) * siluf_(gb[i + 1]); } }
    { float va[NTK + 2], vb[NTK + 2], ya[NTK + 2], yb[NTK + 2];
        load_span<NTK>(h0, t0, va); load_span<NTK>(h1, t0, vb); load_span<NTK>(h0 + (size_t)256 * T, t0, ya); load_span<NTK>(h1 + (size_t)256 * T, t0, yb);
        const float v0 = cw[0 * 768 + c], v1 = cw[1 * 768 + c], v2 = cw[2 * 768 + c], vbias = cb[c];
        const float y0 = cw[0 * 768 + 256 + c], y1 = cw[1 * 768 + 256 + c], y2 = cw[2 * 768 + 256 + c], ybias = cb[256 + c];
#pragma unroll
        for (int i = 0; i < NTK; ++i) { u0[i] = (v0 * va[i] + v1 * va[i + 1] + v2 * va[i + 2] + vbias) * (y0 * ya[i] + y1 * ya[i + 1] + y2 * ya[i + 2] + ybias);
            u1[i] = (v0 * vb[i] + v1 * vb[i + 1] + v2 * vb[i + 2] + vbias) * (y0 * yb[i] + y1 * yb[i + 1] + y2 * yb[i + 2] + ybias); } }
}
__device__ __forceinline__ void hylat_task(const Params& p, int l, int bp, int cp, char* smem) {
    const int tid = otid(), half = tid >> 8, tl = tid & 255, c = 2 * cp + half;
    const bf16* HT = (const bf16*)(p.ws + WS_HT); bf16* Y = (bf16*)(p.ws + WS_HNY);
    cpx* buf = (cpx*)smem + (size_t)half * FBUF;
    const cpx* TW = (const cpx*)(p.ws + WS_TW);
    const cpx* KF = (const cpx*)(p.ws + WS_KF) + (size_t)c * NF;
    constexpr int NTK = SEQ / 256;
    const int t0 = NTK * tl;
    const float* cw = p.in[I_HCW] + (size_t)l * 3 * 768; const float* cb = p.in[I_HCB] + (size_t)l * 768;
    const size_t rb0 = (size_t)(2 * bp) * TOK + CTXL, rb1 = rb0 + TOK;
    const bf16* h0 = HT + (size_t)c * T + rb0 + t0; const bf16* h1 = h0 + TOK;
    { float u0[NTK], u1[NTK], g0[NTK], g1[NTK]; hy_inputs<NTK>(h0, h1, cw, cb, c, t0, u0, u1, g0, g1);
        __syncthreads();
#pragma unroll
        for (int i = 0; i < NTK; ++i) { cpx v; v.x = u0[i]; v.y = u1[i]; buf[FPH(t0 + i)] = v; cpx z = {0.f, 0.f}; buf[FPH(SEQ + t0 + i)] = z; } }
    fft_fwd(buf, TW, tl);
#pragma unroll 2
    for (int i = tl; i < NF; i += 256) buf[FPH(i)] = cmul(buf[FPH(i)], KF[i]);
    fft_inv(buf, TW, tl);
    const float dsk = p.in[I_HD][(size_t)l * WG + c]; const float sc = 1.0f / (float)NF;
    { const int tz = otid() & 255; const int t0z = NTK * tz;
        float u0[NTK], u1[NTK], g0[NTK], g1[NTK]; hy_inputs<NTK>(HT + (size_t)c * T + rb0 + t0z, HT + (size_t)c * T + rb0 + t0z + TOK, cw, cb, c, t0z, u0, u1, g0, g1);
        float o0[NTK], o1[NTK];
#pragma unroll
        for (int i = 0; i < NTK; ++i) { const cpx y = buf[FPH(t0z + i)]; o0[i] = g0[i] * (y.x * sc + u0[i] * dsk); o1[i] = g1[i] * (y.y * sc + u1[i] * dsk); }
        bf16* d0 = (bf16*)(p.ws + WS_HT) + (size_t)(768 + c) * T + rb0 + t0z; bf16* d1 = d0 + TOK;
        if constexpr (NTK == 8) { *(u32x4*)d0 = pack8(o0); *(u32x4*)d1 = pack8(o1); }
        else {
#pragma unroll
            for (int i = 0; i < NTK; ++i) { d0[i] = f2bf(o0[i]); d1[i] = f2bf(o1[i]); } } }
}

constexpr int HCB = 16;
__device__ __forceinline__ void hyctx_task(const Params& p, int l, int b, int cblk, char* smem) {
    const int tid = otid(); const int c0 = cblk * HCB;
    const bf16* HT = (const bf16*)(p.ws + WS_HT); bf16* Y = (bf16*)(p.ws + WS_HNY); const float* HC = (const float*)(p.ws + WS_HC);
    float* raw = (float*)smem;
    float* u = raw + 4 * CTXL * HCB;
    float* og = u + CTXL * HCB;
    float* hcm = og + CTXL * HCB;
    bf16* ob = (bf16*)raw;
    const size_t rb = (size_t)b * TOK;
    const float* cw = p.in[I_HCW] + (size_t)l * 3 * 768; const float* cbias = p.in[I_HCB] + (size_t)l * 768;
    constexpr int WT = CTXL / 32;
    __syncthreads();
    for (int i = tid; i < 4 * HCB * (CTXL / 8); i += NT) { const int k = i / (HCB * (CTXL / 8)), cc = (i / (CTXL / 8)) % HCB, ck = i % (CTXL / 8);
        float f[8]; unpack8(*(const u32x4*)(HT + (size_t)(k * 256 + c0 + cc) * T + rb + ck * 8), f);
#pragma unroll
        for (int j = 0; j < 8; ++j) raw[(k * CTXL + ck * 8 + j) * HCB + cc] = f[j]; }
    for (int i = tid; i < 2 * HCB * (CTXL / 4); i += NT) { const int dir = i / (HCB * (CTXL / 4)), cc = (i / (CTXL / 4)) % HCB, pk = i % (CTXL / 4);
        const f32x4 v = *(const f32x4*)(HC + ((size_t)dir * WG + c0 + cc) * CTXL + pk * 4); const float f[4] = {v.x, v.y, v.z, v.w};
#pragma unroll
        for (int j = 0; j < 4; ++j) { const int pos = pk * 4 + j; if (dir == 0) hcm[(CTXL + pos) * HCB + cc] = f[j]; else if (pos > 0) hcm[(CTXL - pos) * HCB + cc] = f[j]; } }
    if (tid < HCB) hcm[tid] = 0.f;
    __syncthreads();
    for (int i = tid; i < CTXL * HCB; i += NT) { const int t = i / HCB, cc = i % HCB; float cv[3];
#pragma unroll
        for (int k = 0; k < 3; ++k) { const float* rk = raw + k * CTXL * HCB; const int ch = k * 256 + c0 + cc;
            const float a = t > 0 ? rk[(t - 1) * HCB + cc] : 0.f, m = rk[t * HCB + cc], z = t < CTXL - 1 ? rk[(t + 1) * HCB + cc] : 0.f;
            cv[k] = cw[0 * 768 + ch] * a + cw[1 * 768 + ch] * m + cw[2 * 768 + ch] * z + cbias[ch]; }
        u[i] = cv[0] * cv[1];
        og[i] = cv[2] * siluf_(raw[(3 * CTXL + t) * HCB + cc]); }
    __syncthreads();
    { const int cc = tid % HCB, tg = tid / HCB, t0 = WT * tg; float acc[WT], w[WT];
#pragma unroll
        for (int j = 0; j < WT; ++j) { acc[j] = 0.f; w[j] = hcm[(t0 + j + CTXL) * HCB + cc]; }
#pragma unroll 8
        for (int s = 0; s < CTXL; ++s) { const float us = u[s * HCB + cc];
#pragma unroll
            for (int j = 0; j < WT; ++j) acc[j] += us * w[j];
#pragma unroll
            for (int j = WT - 1; j > 0; --j) w[j] = w[j - 1];
            w[0] = hcm[(t0 - s - 1 + CTXL) * HCB + cc]; }
        const float dsk = p.in[I_HD][(size_t)l * WG + c0 + cc];
#pragma unroll
        for (int j = 0; j < WT; ++j) { const int t = t0 + j; ob[t * HCB + cc] = f2bf(og[t * HCB + cc] * (acc[j] + u[t * HCB + cc] * dsk)); } }
    __syncthreads();
    for (int i = tid; i < CTXL * 2; i += NT) { const int t = i >> 1, hh = i & 1; *(u32x4*)(Y + (rb + t) * 1024 + YH + c0 + 8 * hh) = *(const u32x4*)(ob + t * HCB + 8 * hh); }
}

__device__ __forceinline__ void attn_task(const Params& p, int l, int b, int kvh, int qt, bool ctxq, char* smem) {
    const int tid = otid(), lane = tid & 63, wave = tid >> 6, r = lane & 15, q = lane >> 4;
    constexpr float QSC = 0.125f * 1.4426950408889634f;
    const bf16* P = (const bf16*)(p.ws + WS_P); bf16* Y = (bf16*)(p.ws + WS_HNY); const cpx* ROPE = (const cpx*)(p.ws + WS_ROPE);
    bf16* Qs = (bf16*)smem;
    bf16* Ks = Qs + 256 * LS;
    constexpr int LSV = 80;
    bf16* Vt = Ks + 64 * LS;
    bf16* Ps = Vt + 64 * LS;
    const size_t rq0 = (size_t)b * TOK + (ctxq ? 0 : CTXL) + qt * 128;
    __syncthreads();
#pragma unroll
    for (int it = 0; it < 2; ++it) {
        const int idx = tid + NT * it, row = idx >> 2, cpair = idx & 3, g = row >> 7, t = row & 127;
        const bf16* src = P + (rq0 + t) * NP + PD + (kvh * 2 + g) * 64;
        float lo[8], hi[8]; unpack8(*(const u32x4*)(src + cpair * 8), lo); unpack8(*(const u32x4*)(src + 32 + cpair * 8), hi);
        float a[8], c2[8];
#pragma unroll
        for (int j = 0; j < 8; ++j) { float cs = 1.f, sn = 0.f; if (!ctxq) { const cpx cv = ROPE[(size_t)(qt * 128 + t) * 32 + cpair * 8 + j]; cs = cv.x; sn = cv.y; }
            a[j] = (lo[j] * cs - hi[j] * sn) * QSC; c2[j] = (hi[j] * cs + lo[j] * sn) * QSC; }
        *(u32x4*)(Qs + row * LS + cpair * 8) = pack8(a); *(u32x4*)(Qs + row * LS + 32 + cpair * 8) = pack8(c2);
    }
    const int lt0 = ctxq ? 0 : (2 * qt - 2 > 0 ? 2 * qt - 2 : 0), lt1 = ctxq ? -1 : (2 * qt + 3 < SEQ / 64 - 1 ? 2 * qt + 3 : SEQ / 64 - 1);
    const int nloc = lt1 - lt0 + 1, ntiles = nloc + NCC;
    float m[2], lsum[2]; f32x4 O[2][4];
#pragma unroll
    for (int ms = 0; ms < 2; ++ms) { m[ms] = -INFINITY; lsum[ms] = 0.f;
#pragma unroll
        for (int i = 0; i < 4; ++i) O[ms][i] = (f32x4){0.f, 0.f, 0.f, 0.f}; }
    const int g = wave >> 2, tq0 = (wave & 3) * 32;
    (void)Ps;
    __syncthreads();
    bf16x8 qf[2][2];
#pragma unroll
    for (int ms = 0; ms < 2; ++ms)
#pragma unroll
        for (int ks = 0; ks < 2; ++ks) qf[ms][ks] = *(const bf16x8*)(Qs + (g * 128 + tq0 + 16 * ms + r) * LS + ks * 32 + q * 8);
    u32x4 klo = {0u, 0u, 0u, 0u}, khi = klo, vq = klo; f32x4 rp[4] = {(f32x4){1.f, 0.f, 1.f, 0.f}, (f32x4){1.f, 0.f, 1.f, 0.f}, (f32x4){1.f, 0.f, 1.f, 0.f}, (f32x4){1.f, 0.f, 1.f, 0.f}};
    const int ks_ = tid >> 2, kcp = tid & 3, vs_ = tid >> 3, vc8 = tid & 7;
#define ATT_PREFETCH(TI) do { const bool loc_ = (TI) < nloc; const int kt_ = loc_ ? lt0 + (TI) : (TI) - nloc; const size_t rk_ = (size_t)b * TOK + (loc_ ? CTXL : 0) + kt_ * 64; \
        if (tid < 256) { const bf16* src_ = P + (rk_ + ks_) * NP + PD + 256 + kvh * 64; klo = *(const u32x4*)(src_ + kcp * 8); khi = *(const u32x4*)(src_ + 32 + kcp * 8); \
            if (loc_) { const f32x4* rr_ = (const f32x4*)(ROPE + (size_t)(kt_ * 64 + ks_) * 32 + kcp * 8); rp[0] = rr_[0]; rp[1] = rr_[1]; rp[2] = rr_[2]; rp[3] = rr_[3]; } \
            else { rp[0] = rp[1] = rp[2] = rp[3] = (f32x4){1.f, 0.f, 1.f, 0.f}; } } \
        vq = *(const u32x4*)(P + (rk_ + vs_) * NP + PD + 384 + kvh * 64 + vc8 * 8); } while (0)
    ATT_PREFETCH(0);
    for (int ti = 0; ti < ntiles; ++ti) {
        const bool local = ti < nloc; const int kt = local ? lt0 + ti : ti - nloc;
        __syncthreads();
        if (tid < 256) { float lo[8], hi[8]; unpack8(klo, lo); unpack8(khi, hi);
            const float cs[8] = {rp[0].x, rp[0].z, rp[1].x, rp[1].z, rp[2].x, rp[2].z, rp[3].x, rp[3].z}, sn[8] = {rp[0].y, rp[0].w, rp[1].y, rp[1].w, rp[2].y, rp[2].w, rp[3].y, rp[3].w};
            float a[8], c2[8];
#pragma unroll
            for (int j = 0; j < 8; ++j) { a[j] = lo[j] * cs[j] - hi[j] * sn[j]; c2[j] = hi[j] * cs[j] + lo[j] * sn[j]; }
            *(u32x4*)(Ks + ks_ * LS + kcp * 8) = pack8(a); *(u32x4*)(Ks + ks_ * LS + 32 + kcp * 8) = pack8(c2); }
        *(u32x4*)(Vt + vs_ * LSV + vc8 * 8) = vq;
        __syncthreads();
        if (ti + 1 < ntiles) ATT_PREFETCH(ti + 1);
        bf16x8 kfr[4][2], vfa[4], vfb[4];
#pragma unroll
        for (int nt = 0; nt < 4; ++nt)
#pragma unroll
            for (int ks = 0; ks < 2; ++ks) kfr[nt][ks] = *(const bf16x8*)(Ks + (16 * nt + r) * LS + ks * 32 + q * 8);
#pragma unroll
        for (int me = 0; me < 4; ++me) { const bf16* vr = Vt + (4 * q + (r >> 2)) * LSV + 16 * me + 4 * (r & 3);
            const u32x2 a0 = lds_tr16(vr), a1 = lds_tr16(vr + 16 * LSV), a2 = lds_tr16(vr + 32 * LSV), a3 = lds_tr16(vr + 48 * LSV);
            u32x4 va; va.x = a0.x; va.y = a0.y; va.z = a1.x; va.w = a1.y; u32x4 vb; vb.x = a2.x; vb.y = a2.y; vb.z = a3.x; vb.w = a3.y; vfa[me] = as_frag(va); vfb[me] = as_frag(vb); }
#pragma unroll
        for (int ms = 0; ms < 2; ++ms) {
            const int qlo = qt * 128 + tq0 + 16 * ms, klo_ = kt * 64;
            if (local && (klo_ > qlo + 15 + 128 || klo_ + 63 < qlo - 128)) continue;
            const bool domask = local && (klo_ + 63 - qlo > 128 || klo_ - (qlo + 15) < -128);
            f32x4 S[4] = {(f32x4){0.f, 0.f, 0.f, 0.f}, (f32x4){0.f, 0.f, 0.f, 0.f}, (f32x4){0.f, 0.f, 0.f, 0.f}, (f32x4){0.f, 0.f, 0.f, 0.f}};
#pragma unroll
            for (int ks = 0; ks < 2; ++ks)
#pragma unroll
                for (int nt = 0; nt < 4; ++nt) S[nt] = MFMA16(kfr[nt][ks], qf[ms][ks], S[nt]);
            const int qpos = qlo + r; float mx = -INFINITY;
            if (domask) {
#pragma unroll
                for (int nt = 0; nt < 4; ++nt)
#pragma unroll
                    for (int i = 0; i < 4; ++i) { const int d = kt * 64 + nt * 16 + 4 * q + i - qpos; if (d > 128 || d < -128) S[nt][i] = -INFINITY; } }
#pragma unroll
            for (int nt = 0; nt < 4; ++nt)
#pragma unroll
                for (int i = 0; i < 4; ++i) mx = fmaxf(mx, S[nt][i]);
            mx = xrow_max(mx);
            const float mn = fmaxf(m[ms], mx); const float msafe = mn == -INFINITY ? 0.f : mn; const float alpha = EXP2(m[ms] - msafe); float sm = 0.f;
#pragma unroll
            for (int nt = 0; nt < 4; ++nt)
#pragma unroll
                for (int i = 0; i < 4; ++i) { S[nt][i] = EXP2(S[nt][i] - msafe); sm += S[nt][i]; }
            sm = xrow_sum(sm);
            lsum[ms] = lsum[ms] * alpha + sm; m[ms] = mn;
            const float pa[8] = {S[0][0], S[0][1], S[0][2], S[0][3], S[1][0], S[1][1], S[1][2], S[1][3]}, pb[8] = {S[2][0], S[2][1], S[2][2], S[2][3], S[3][0], S[3][1], S[3][2], S[3][3]};
            const bf16x8 p0 = as_frag(pack8(pa)), p1 = as_frag(pack8(pb));
#pragma unroll
            for (int me = 0; me < 4; ++me) { O[ms][me] = O[ms][me] * alpha;
                O[ms][me] = MFMA16(vfa[me], p0, O[ms][me]); O[ms][me] = MFMA16(vfb[me], p1, O[ms][me]); }
        }
    }
#undef ATT_PREFETCH
    const float sink = p.in[I_SINK][(size_t)l * NH + kvh * 2 + g];
#pragma unroll
    for (int ms = 0; ms < 2; ++ms) { const float den = lsum[ms] + EXP2(sink * 1.4426950408889634f - m[ms]); const float inv = frcp_(den);
        const size_t row = rq0 + tq0 + 16 * ms + r; const int col = (kvh * 2 + g) * 64 + 4 * q;
#pragma unroll
        for (int me = 0; me < 4; ++me) { const u32x2 gg = *(const u32x2*)(P + row * NP + PD + 512 + col + 16 * me);
            const float g0 = bitsf(gg.x << 16), g1 = bitsf(gg.x & 0xffff0000u), g2 = bitsf(gg.y << 16), g3 = bitsf(gg.y & 0xffff0000u);
            u32x2 o; o.x = pk2(O[ms][me][0] * inv * siluf_(g0), O[ms][me][1] * inv * siluf_(g1)); o.y = pk2(O[ms][me][2] * inv * siluf_(g2), O[ms][me][3] * inv * siluf_(g3));
            *(u32x2*)(Y + row * 1024 + YD + col + 16 * me) = o; } }
}

#ifdef EMU
__device__ __forceinline__ int olane(int lane) { return lane; }
#else
__device__ __forceinline__ int olane(int lane) { asm volatile("" : "+v"(lane)); return lane; }
#endif
__device__ __forceinline__ void load_nat_tile(const bf16* P, int row0, int col0, bf16* tile, int lane) {
    u32x4 v[8];
#pragma unroll
    for (int i = 0; i < 8; ++i) v[i] = *(const u32x4*)(P + (size_t)(row0 + (lane >> 3) + 8 * i) * NP + col0 + (lane & 7) * 8);
#pragma unroll
    for (int i = 0; i < 8; ++i) *(u32x4*)(tile + swz((lane >> 3) + 8 * i, lane & 7)) = v[i];
}
__device__ __forceinline__ bf16x8 frag_tr(const bf16* tile, int c0, int k0, int lane) {
    const int c = c0 + (lane & 15), kb = k0 + 8 * (lane >> 4); unsigned w[4];
#pragma unroll
    for (int j = 0; j < 4; ++j) w[j] = (unsigned)tile[swz(kb + 2 * j, c >> 3) + (c & 7)] | ((unsigned)tile[swz(kb + 2 * j + 1, c >> 3) + (c & 7)] << 16);
    u32x4 o; o.x = w[0]; o.y = w[1]; o.z = w[2]; o.w = w[3]; return as_frag(o);
}
__device__ __forceinline__ bf16x8 frag_tr_hw(const bf16* tile, int c0, int k0, int lane) {
    const int r = lane & 15, q = lane >> 4, row = k0 + 8 * q + (r >> 2), col = c0 + 4 * (r & 3);
    const u32x2 a = lds_tr16(tile + swz(row, col >> 3) + (col & 7)), b = lds_tr16(tile + swz(row + 4, col >> 3) + (col & 7));
    u32x4 o; o.x = a.x; o.y = a.y; o.z = b.x; o.w = b.y; return as_frag(o);
}
template <int DIR>
__device__ __forceinline__ void gla_r_frags(const float* Grow0, int lane, bf16x8 (&af)[4]) {
    const int r = lane & 15, q4 = lane >> 4;
#pragma unroll
    for (int mt = 0; mt < 4; ++mt) { u32x4 o = {0u, 0u, 0u, 0u};
        if (q4 < 2) o = *(const u32x4*)((const bf16*)(Grow0 + (size_t)(16 * mt + r) * NGS + 16) + DIR * 16 + 8 * q4);
        af[mt] = as_frag(o); }
}
template <int DIR>
__device__ __forceinline__ float gla_b_col(const Params& p, int l, int h, const bf16x8 (&af)[4], int nt, int lane_, float (&x)[4][4]) {
    const int lane = olane(lane_), r = lane & 15, q4 = lane >> 4, d = h * 64 + 16 * nt + r;
    u32x4 o = {0u, 0u, 0u, 0u};
    if (q4 < 2) { const float* wa = p.in[I_GWA] + ((size_t)(l * 2 + DIR) * 16 + 8 * q4) * WG + d;
        o.x = pk2(wa[0], wa[WG]); o.y = pk2(wa[2 * WG], wa[3 * WG]); o.z = pk2(wa[4 * WG], wa[5 * WG]); o.w = pk2(wa[6 * WG], wa[7 * WG]); }
    const bf16x8 bfr = as_frag(o); const float bias = p.in[I_GBA][(size_t)(l * 2 + DIR) * WG + d];
#pragma unroll
    for (int mt = 0; mt < 4; ++mt) { f32x4 c = {bias, bias, bias, bias}; c = MFMA16(af[mt], bfr, c);
#pragma unroll
        for (int i = 0; i < 4; ++i) x[mt][i] = logsig_fast(c[i]) * (1.0f / 16.0f); }
    float carry = 0.f;
#pragma unroll
    for (int k = 0; k < 4; ++k) { const int mt = DIR == 0 ? k : 3 - k; float* y = x[mt];
        if (DIR == 0) { y[1] += y[0]; y[2] += y[1]; y[3] += y[2]; } else { y[2] += y[3]; y[1] += y[2]; y[0] += y[1]; }
        const float s4 = DIR == 0 ? y[3] : y[0];
        const float t1 = DIR == 0 ? __shfl_up(s4, 16) : __shfl_down(s4, 16), t2 = DIR == 0 ? __shfl_up(s4, 32) : __shfl_down(s4, 32), t3 = DIR == 0 ? __shfl_up(s4, 48) : __shfl_down(s4, 48);
        const int qq = DIR == 0 ? q4 : 3 - q4;
        const float e = (qq >= 1 ? t1 : 0.f) + (qq >= 2 ? t2 : 0.f) + (qq >= 3 ? t3 : 0.f);
        const float tot = __shfl(e + s4, DIR == 0 ? r + 48 : r);
#pragma unroll
        for (int i = 0; i < 4; ++i) y[i] += carry + e;
        carry += tot; }
    return carry;
}

template <int MIXER, int DIR>
__device__ __forceinline__ void chunkst_dir(const Params& p, int l, int b, int h, int cid, const float* Grow0, const unsigned (&kk)[32], const bf16* Vt, bf16* Kt, const float* wvs, float* bendl, int lane_) {
    const int lane = olane(lane_), r = lane & 15, q4 = lane >> 4;
    if constexpr (MIXER == 0) {
        float nacc = 0.f;
#pragma unroll
        for (int c = 0; c < 8; ++c) { float f[8];
#pragma unroll
            for (int j = 0; j < 8; ++j) { const int s = 8 * c + j; const float kv = (s & 1) ? bitsf(kk[s >> 1] & 0xffff0000u) : bitsf(kk[s >> 1] << 16);
                f[j] = kv * 0.125f * wvs[DIR * 64 + s]; nacc += f[j]; }
            *(u32x4*)(Kt + swz(lane, c)) = pack8(f); }
        ((float*)(p.ws + WS_NV))[ch_index(DIR, b, h, cid) * 64 + lane] = nacc;
    } else {
        const bf16* P = (const bf16*)(p.ws + WS_P); const int kcol = PG + 256 + h * 64; const int r0 = b * TOK + cid * 64;
        bf16x8 af[4]; gla_r_frags<DIR>(Grow0, lane, af);
#pragma unroll 2
        for (int nt = 0; nt < 4; ++nt) { const int d = 16 * nt + r; float x[4][4];
            const float bend = gla_b_col<DIR>(p, l, h, af, nt, lane, x);
            if (q4 == 0) { ((float*)(p.ws + WS_BE))[ch_index(DIR, b, h, cid) * 64 + d] = bend; bendl[d] = __expf(fmaxf(bend, -80.0f)); }
#pragma unroll
            for (int mt = 0; mt < 4; ++mt)
#pragma unroll
                for (int i = 0; i < 4; ++i) { const int s = 16 * mt + 4 * q4 + i; const float kv = bf2f(P[(size_t)(r0 + s) * NP + kcol + d]); const float bc = fmaxf(x[mt][i], -80.0f);
                    Kt[swz(d, s >> 3) + (s & 7)] = f2bf(kv * __expf(-bc));
                    ((bf16*)(p.ws + WS_EQ))[((size_t)DIR * T + r0 + s) * WG + h * 64 + d] = f2bf(__expf(bc)); } }
    }
    WAVE_SYNC();
    bf16x8 vf[4][2];
#pragma unroll
    for (int ne = 0; ne < 4; ++ne)
#pragma unroll
        for (int ks = 0; ks < 2; ++ks) vf[ne][ks] = frag_tr_hw(Vt, 16 * ne, 32 * ks, lane);
    bf16* dst = (bf16*)(p.ws + WS_ST) + st_index(MIXER, DIR, b, h, cid) * 4096;
#pragma unroll
    for (int me = 0; me < 4; ++me) {
        f32x4 acc[4] = {(f32x4){0.f, 0.f, 0.f, 0.f}, (f32x4){0.f, 0.f, 0.f, 0.f}, (f32x4){0.f, 0.f, 0.f, 0.f}, (f32x4){0.f, 0.f, 0.f, 0.f}};
#pragma unroll
        for (int ks = 0; ks < 2; ++ks) { const bf16x8 a = *(const bf16x8*)(Kt + swz(16 * me + r, ks * 4 + q4));
#pragma unroll
            for (int ne = 0; ne < 4; ++ne) acc[ne] = MFMA16(a, vf[ne][ks], acc[ne]); }
        f32x4 sc4 = {1.f, 1.f, 1.f, 1.f}; if constexpr (MIXER == 1) sc4 = *(const f32x4*)(bendl + 16 * me + 4 * q4);
#pragma unroll
        for (int ne = 0; ne < 4; ++ne) { const f32x4 v = acc[ne] * sc4; u32x2 o; o.x = pk2(v[0], v[1]); o.y = pk2(v[2], v[3]); *(u32x2*)(dst + (16 * ne + r) * 64 + 16 * me + 4 * q4) = o; }
    }
    WAVE_SYNC();
}
template <int MIXER>
__device__ __forceinline__ void chunkst_w(const Params& p, int l, int b, int h, int cid, char* wl, int lane) {
    const bf16* P = (const bf16*)(p.ws + WS_P); const float* G = (const float*)(p.ws + WS_G);
    const int r0 = b * TOK + cid * 64, r = lane & 15, q4 = lane >> 4;
    bf16* Kt = (bf16*)wl;
    bf16* Vt = Kt + 4096;
    float* wvs = (float*)(Vt + 4096);
    float* bendl = wvs + 128;
    const int kcol = (MIXER == 0 ? PA : PG) + 256 + h * 64, vcol = (MIXER == 0 ? PA : PG) + 512 + h * 64;
    const float* Grow0 = G + (size_t)r0 * NGS;
    bf16* Nn = Kt;
    load_nat_tile(P, r0, vcol, Vt, lane);
    load_nat_tile(P, r0, kcol, Nn, lane);
    WAVE_SYNC();
    unsigned kk[32];
    { const int dc = 16 * q4 + 4 * (r & 3);
#pragma unroll
        for (int c = 0; c < 16; ++c) { const u32x2 t = lds_tr16(Nn + swz(4 * c + (r >> 2), dc >> 3) + (dc & 7)); kk[2 * c] = t.x; kk[2 * c + 1] = t.y; } }
    WAVE_SYNC();
    if constexpr (MIXER == 0) {
        const float* g = Grow0 + (size_t)lane * NGS; const float* gb = p.in[I_MGB] + (size_t)l * 16;
        const float i_f = g[h] + gb[h], f_f = g[4 + h] + gb[4 + h], i_b = g[8 + h] + gb[8 + h], f_b = g[12 + h] + gb[12 + h];
        const float lf = logsigf_(f_f), lb = logsigf_(f_b);
        const float bF = wave_prefix_sum(lf, lane), totF = __shfl(bF, 63);
        const float gF = totF - bF + i_f, mF = wave_max(gF);
        const float totB = wave_sum(lb), preB = wave_prefix_sum(lb, lane), bB = totB - preB + lb;
        const float gB = totB - bB + i_b, mB = wave_max(gB);
        wvs[lane] = __expf(gF - mF); wvs[64 + lane] = __expf(gB - mB);
        if (lane == 0) { float* SC = (float*)(p.ws + WS_SC);
            SC[ch_index(0, b, h, cid) * 4 + 0] = totF; SC[ch_index(0, b, h, cid) * 4 + 1] = mF;
            SC[ch_index(1, b, h, cid) * 4 + 0] = totB; SC[ch_index(1, b, h, cid) * 4 + 1] = mB; }
    }
    WAVE_SYNC();
    chunkst_dir<MIXER, 0>(p, l, b, h, cid, Grow0, kk, Vt, Kt, wvs, bendl, lane);
    chunkst_dir<MIXER, 1>(p, l, b, h, cid, Grow0, kk, Vt, Kt, wvs, bendl, lane);
}

template <int DIR>
__device__ __forceinline__ void chunkst_gla(const Params& p, int l, int b, int h, int cid, char* wl, int lane_) {
    const bf16* P = (const bf16*)(p.ws + WS_P);
    const int lane = olane(lane_), r0 = b * TOK + cid * 64, r = lane & 15, q4 = lane >> 4;
    bf16* Kt = (bf16*)wl;
    bf16* An = Kt + 4096;
    float* bendl = (float*)(An + 4096);
    const int kcol = PG + 256 + h * 64, vcol = PG + 512 + h * 64;
    const float* Grow0 = (const float*)(p.ws + WS_G) + (size_t)r0 * NGS;
    load_nat_tile(P, r0, vcol, An, lane);
    WAVE_SYNC();
    bf16x8 vf[4][2];
#pragma unroll
    for (int ne = 0; ne < 4; ++ne)
#pragma unroll
        for (int ks = 0; ks < 2; ++ks) vf[ne][ks] = frag_tr_hw(An, 16 * ne, 32 * ks, lane);
    WAVE_SYNC();
    load_nat_tile(P, r0, kcol, An, lane);
    WAVE_SYNC();
    bf16x8 af[4]; gla_r_frags<DIR>(Grow0, lane, af);
#pragma unroll 2
    for (int nt = 0; nt < 4; ++nt) { const int d = 16 * nt + r; float x[4][4];
        const float bend = gla_b_col<DIR>(p, l, h, af, nt, lane, x);
        if (q4 == 0) { ((float*)(p.ws + WS_BE))[ch_index(DIR, b, h, cid) * 64 + d] = bend; bendl[d] = __expf(fmaxf(bend, -80.0f)); }
#pragma unroll
        for (int mt = 0; mt < 4; ++mt) { const int s0 = 16 * mt + 4 * q4, dc = 16 * nt + 4 * (r & 3);
            const u32x2 kq = lds_tr16(An + swz(s0 + (r >> 2), dc >> 3) + (dc & 7));
            const float kv[4] = {bitsf(kq.x << 16), bitsf(kq.x & 0xffff0000u), bitsf(kq.y << 16), bitsf(kq.y & 0xffff0000u)}; float kp[4];
#pragma unroll
            for (int i = 0; i < 4; ++i) { const float bc = fmaxf(x[mt][i], -80.0f); kp[i] = kv[i] * __expf(-bc); An[swz(s0 + i, d >> 3) + (d & 7)] = f2bf(__expf(bc)); }
            u32x2 o; o.x = pk2(kp[0], kp[1]); o.y = pk2(kp[2], kp[3]); *(u32x2*)(Kt + swz(d, s0 >> 3) + (s0 & 7)) = o; } }
    WAVE_SYNC();
    { bf16* EQg = (bf16*)(p.ws + WS_EQ) + ((size_t)DIR * T + r0) * WG + h * 64;
#pragma unroll
        for (int i = 0; i < 8; ++i) { const int s = (lane >> 3) + 8 * i, ck = lane & 7; *(u32x4*)(EQg + (size_t)s * WG + ck * 8) = *(const u32x4*)(An + swz(s, ck)); } }
    bf16* dst = (bf16*)(p.ws + WS_ST) + st_index(1, DIR, b, h, cid) * 4096;
#pragma unroll
    for (int me = 0; me < 4; ++me) {
        f32x4 acc[4] = {(f32x4){0.f, 0.f, 0.f, 0.f}, (f32x4){0.f, 0.f, 0.f, 0.f}, (f32x4){0.f, 0.f, 0.f, 0.f}, (f32x4){0.f, 0.f, 0.f, 0.f}};
#pragma unroll
        for (int ks = 0; ks < 2; ++ks) { const bf16x8 a = *(const bf16x8*)(Kt + swz(16 * me + r, ks * 4 + q4));
#pragma unroll
            for (int ne = 0; ne < 4; ++ne) acc[ne] = MFMA16(a, vf[ne][ks], acc[ne]); }
        const f32x4 sc4 = *(const f32x4*)(bendl + 16 * me + 4 * q4);
#pragma unroll
        for (int ne = 0; ne < 4; ++ne) { const f32x4 v = acc[ne] * sc4; u32x2 o; o.x = pk2(v[0], v[1]); o.y = pk2(v[2], v[3]); *(u32x2*)(dst + (16 * ne + r) * 64 + 16 * me + 4 * q4) = o; }
    }
    WAVE_SYNC();
}

template <int MIXER, int DIR>
__device__ __forceinline__ void chunkout_prep(const Params& p, int l, int b, int h, int cid, const float* Grow0, int r0, int pbase, const bf16* EQ, float* gar, int lane_) {
    const int lane = olane(lane_);
    if constexpr (MIXER == 0) {
        const bf16* P = (const bf16*)(p.ws + WS_P);
        const float* g = Grow0 + (size_t)lane * NGS; const float* gb = p.in[I_MGB] + (size_t)l * 16;
        const float ig = g[DIR * 8 + h] + gb[DIR * 8 + h], fg = g[DIR * 8 + 4 + h] + gb[DIR * 8 + 4 + h];
        const float mprev = ((const float*)(p.ws + WS_SC))[ch_index(DIR, b, h, cid) * 4 + 2];
        const float lf = logsigf_(fg); float bb;
        if (DIR == 0) bb = wave_prefix_sum(lf, lane); else { const float tt = wave_sum(lf), pre = wave_prefix_sum(lf, lane); bb = tt - pre + lf; }
        const float a = ig - bb; const float pm = DIR == 0 ? wave_prefix_max(a, lane) : wave_suffix_max(a, lane);
        const float mt_ = fmaxf(bb + mprev, bb + pm);
        float* ga = gar + DIR * 320;
        ga[lane] = bb - mt_; ga[64 + lane] = a; ga[128 + lane] = __expf(bb + mprev - mt_); ga[192 + lane] = __expf(-mt_);
        float* nvl = gar + 640 + DIR * 64;
        nvl[lane] = ((const float*)(p.ws + WS_NV))[ch_index(DIR, b, h, cid) * 64 + lane];
        WAVE_SYNC();
        float dq = 0.f;
#pragma unroll
        for (int c = 0; c < 8; ++c) { float f[8]; unpack8(*(const u32x4*)(P + (size_t)(r0 + lane) * NP + pbase + c * 8), f);
            const f32x4 n0 = *(const f32x4*)(nvl + c * 8), n1 = *(const f32x4*)(nvl + c * 8 + 4);
            dq += f[0] * n0.x + f[1] * n0.y + f[2] * n0.z + f[3] * n0.w + f[4] * n1.x + f[5] * n1.y + f[6] * n1.z + f[7] * n1.w; }
        ga[256 + lane] = dq;
    }
}
template <int MIXER>
__device__ __forceinline__ void chunkout_prep2(const Params& p, int l, int b, int h, int cid, const float* Grow0, int r0, int pbase, float* gar, int lane_) {
    if constexpr (MIXER == 0) {
        const int lane = olane(lane_);
        const bf16* P = (const bf16*)(p.ws + WS_P);
        const float* g = Grow0 + (size_t)lane * NGS; const float* gb = p.in[I_MGB] + (size_t)l * 16;
        const float g0 = g[h], g1 = g[4 + h], g2 = g[8 + h], g3 = g[12 + h];
        const float mprev0 = ((const float*)(p.ws + WS_SC))[ch_index(0, b, h, cid) * 4 + 2], mprev1 = ((const float*)(p.ws + WS_SC))[ch_index(1, b, h, cid) * 4 + 2];
        const float nv0 = ((const float*)(p.ws + WS_NV))[ch_index(0, b, h, cid) * 64 + lane], nv1 = ((const float*)(p.ws + WS_NV))[ch_index(1, b, h, cid) * 64 + lane];
        u32x4 qr[8];
#pragma unroll
        for (int c = 0; c < 8; ++c) qr[c] = *(const u32x4*)(P + (size_t)(r0 + lane) * NP + pbase + c * 8);
        const float igF = g0 + gb[h], fgF = g1 + gb[4 + h], igB = g2 + gb[8 + h], fgB = g3 + gb[12 + h];
        { const float lf = logsigf_(fgF); const float bb = wave_prefix_sum(lf, lane);
            const float a = igF - bb; const float pm = wave_prefix_max(a, lane); const float mt_ = fmaxf(bb + mprev0, bb + pm); float* ga = gar;
            ga[lane] = bb - mt_; ga[64 + lane] = a; ga[128 + lane] = __expf(bb + mprev0 - mt_); ga[192 + lane] = __expf(-mt_); }
        { const float lf = logsigf_(fgB); const float tt = wave_sum(lf), pre = wave_prefix_sum(lf, lane); const float bb = tt - pre + lf;
            const float a = igB - bb; const float pm = wave_suffix_max(a, lane); const float mt_ = fmaxf(bb + mprev1, bb + pm); float* ga = gar + 320;
            ga[lane] = bb - mt_; ga[64 + lane] = a; ga[128 + lane] = __expf(bb + mprev1 - mt_); ga[192 + lane] = __expf(-mt_); }
        float* nvl = gar + 640;
        nvl[lane] = nv0; nvl[64 + lane] = nv1;
        WAVE_SYNC();
        float dq0 = 0.f, dq1 = 0.f;
#pragma unroll
        for (int c = 0; c < 8; ++c) { float f[8]; unpack8(qr[c], f);
            const f32x4 n0 = *(const f32x4*)(nvl + c * 8), n1 = *(const f32x4*)(nvl + c * 8 + 4), m0 = *(const f32x4*)(nvl + 64 + c * 8), m1 = *(const f32x4*)(nvl + 64 + c * 8 + 4);
            dq0 += f[0] * n0.x + f[1] * n0.y + f[2] * n0.z + f[3] * n0.w + f[4] * n1.x + f[5] * n1.y + f[6] * n1.z + f[7] * n1.w;
            dq1 += f[0] * m0.x + f[1] * m0.y + f[2] * m0.z + f[3] * m0.w + f[4] * m1.x + f[5] * m1.y + f[6] * m1.z + f[7] * m1.w; }
        gar[256 + lane] = dq0; gar[320 + 256 + lane] = dq1;
    }
}
template <int MIXER, int DIR, int NS>
__device__ __forceinline__ void chunkout_dir(const Params& p, int b, int h, int cid, int r0, int pbase, int th, const bf16x8 (&vtf)[4][2], const bf16* VtL, const bf16* EQ, bf16* SB, const float* gar, float* rsm, f32x4 (&htot)[NS][4], int lane_) {
    const bf16* P = (const bf16*)(p.ws + WS_P); const bf16* ST = (const bf16*)(p.ws + WS_ST);
    const int lane = olane(lane_), r = lane & 15, q4 = lane >> 4;
    const bf16* E = EQ + ((size_t)DIR * T + r0) * WG + h * 64;
    const float* ga = gar + DIR * 320;
    bf16x8 kf[4][2], ctf[4][2];
    if constexpr (MIXER == 0) {
#pragma unroll
        for (int n = 0; n < 4; ++n)
#pragma unroll
            for (int ks = 0; ks < 2; ++ks) { kf[n][ks] = *(const bf16x8*)(P + (size_t)(r0 + 16 * n + r) * NP + pbase + 256 + ks * 32 + q4 * 8); ctf[n][ks] = *(const bf16x8*)(ST + st_index(MIXER, DIR, b, h, cid) * 4096 + (16 * n + r) * 64 + ks * 32 + q4 * 8); }
    } else {
        u32x4 er[4][2];
#pragma unroll
        for (int n = 0; n < 4; ++n)
#pragma unroll
            for (int ks = 0; ks < 2; ++ks) { kf[n][ks] = *(const bf16x8*)(P + (size_t)(r0 + 16 * n + r) * NP + pbase + 256 + ks * 32 + q4 * 8);
                er[n][ks] = *(const u32x4*)(E + (size_t)(16 * n + r) * WG + ks * 32 + q4 * 8);
                ctf[n][ks] = *(const bf16x8*)(ST + st_index(MIXER, DIR, b, h, cid) * 4096 + (16 * n + r) * 64 + ks * 32 + q4 * 8); }
        SCHED_FENCE();
#pragma unroll
        for (int n = 0; n < 4; ++n)
#pragma unroll
            for (int ks = 0; ks < 2; ++ks) { float fe[8], fk[8]; unpack8(er[n][ks], fe); unpack8(as_u4(kf[n][ks]), fk);
#pragma unroll
                for (int j = 0; j < 8; ++j) fk[j] = fk[j] * frcp_(fe[j]);
                kf[n][ks] = as_frag(pack8(fk)); }
    }
    bf16x8 qraw[NS][2]; u32x4 qer[NS][2];
#pragma unroll
    for (int ms = 0; ms < NS; ++ms)
#pragma unroll
        for (int ks = 0; ks < 2; ++ks) { const int mt = NS * th + ms; qraw[ms][ks] = *(const bf16x8*)(P + (size_t)(r0 + 16 * mt + r) * NP + pbase + ks * 32 + q4 * 8);
            if constexpr (MIXER == 1) qer[ms][ks] = *(const u32x4*)(E + (size_t)(16 * mt + r) * WG + ks * 32 + q4 * 8); else qer[ms][ks] = (u32x4){0u, 0u, 0u, 0u}; }
#pragma unroll
    for (int ms = 0; ms < NS; ++ms) { const int mt = NS * th + ms;
        bf16x8 qf[2];
#pragma unroll
        for (int ks = 0; ks < 2; ++ks) { qf[ks] = qraw[ms][ks];
            if constexpr (MIXER == 1) { float fe[8], fq[8]; unpack8(qer[ms][ks], fe); unpack8(as_u4(qf[ks]), fq);
#pragma unroll
                for (int j = 0; j < 8; ++j) fq[j] *= 0.125f * fe[j];
                qf[ks] = as_frag(pack8(fq)); } }
        f32x4 S[4] = {(f32x4){0.f, 0.f, 0.f, 0.f}, (f32x4){0.f, 0.f, 0.f, 0.f}, (f32x4){0.f, 0.f, 0.f, 0.f}, (f32x4){0.f, 0.f, 0.f, 0.f}};
#pragma unroll
        for (int ks = 0; ks < 2; ++ks)
#pragma unroll
            for (int n = 0; n < 4; ++n) S[n] = MFMA16(kf[n][ks], qf[ks], S[n]);
        const int t = 16 * mt + r; float sm = 0.f; float gt = 0.f; if constexpr (MIXER == 0) gt = ga[t];
#pragma unroll
        for (int n = 0; n < 4; ++n) { f32x4 gs = {0.f, 0.f, 0.f, 0.f}; if constexpr (MIXER == 0) gs = *(const f32x4*)(ga + 64 + 16 * n + 4 * q4);
#pragma unroll
            for (int i = 0; i < 4; ++i) { const int sidx = 16 * n + 4 * q4 + i; const bool ok = DIR == 0 ? (sidx <= t) : (sidx >= t); float v = 0.f;
                if (ok) { if constexpr (MIXER == 0) v = S[n][i] * 0.125f * __expf(gt + gs[i]); else v = S[n][i]; }
                S[n][i] = v; sm += v; } }
        const float pa[8] = {S[0][0], S[0][1], S[0][2], S[0][3], S[1][0], S[1][1], S[1][2], S[1][3]}, pb[8] = {S[2][0], S[2][1], S[2][2], S[2][3], S[3][0], S[3][1], S[3][2], S[3][3]};
        const bf16x8 sm0 = as_frag(pack8(pa)), sm1 = as_frag(pack8(pb));
        float wi = 1.f, inv = 1.f;
        if constexpr (MIXER == 0) { sm = xrow_sum(sm); wi = ga[128 + t]; const float den = wi * ga[256 + t] + sm; inv = frcp_(fmaxf(fabsf(den), ga[192 + t])); }
#pragma unroll
        for (int me = 0; me < 4; ++me) { f32x4 a1 = {0.f, 0.f, 0.f, 0.f}, a2 = {0.f, 0.f, 0.f, 0.f};
            const int srow = 4 * q4 + (r >> 2), ecol = 16 * me + 4 * (r & 3);
            const u32x2 v0 = lds_tr16(VtL + swz(srow, ecol >> 3) + (ecol & 7)), v1 = lds_tr16(VtL + swz(16 + srow, ecol >> 3) + (ecol & 7)), v2 = lds_tr16(VtL + swz(32 + srow, ecol >> 3) + (ecol & 7)), v3 = lds_tr16(VtL + swz(48 + srow, ecol >> 3) + (ecol & 7));
            u32x4 va; va.x = v0.x; va.y = v0.y; va.z = v1.x; va.w = v1.y; u32x4 vb; vb.x = v2.x; vb.y = v2.y; vb.z = v3.x; vb.w = v3.y;
            a1 = MFMA16(as_frag(va), sm0, a1); a1 = MFMA16(as_frag(vb), sm1, a1);
            a2 = MFMA16(ctf[me][0], qf[0], a2); a2 = MFMA16(ctf[me][1], qf[1], a2);
            if constexpr (MIXER == 0) htot[ms][me] += (a1 + a2 * wi) * inv; else htot[ms][me] += a1 + a2; }
    }
    (void)SB; (void)rsm;
}
__device__ __forceinline__ void co_build_vt(const bf16* P, int r0, int vcol, bf16* VtL, int lane) {
    load_nat_tile(P, r0, vcol, VtL, lane);
    WAVE_SYNC();
}
template <int MIXER, int NS>
__device__ __forceinline__ void co_finalize(const Params& p, int l, int h, int r0, int pbase, int mt0, f32x4 (&htot)[NS][4], int lane_) {
    const bf16* P = (const bf16*)(p.ws + WS_P); bf16* Y = (bf16*)(p.ws + WS_HNY);
    const float* ngp = p.in[MIXER == 0 ? I_MNG : I_GNG] + (size_t)l * WG + h * 64;
    const int lz = olane(lane_), r = lz & 15, q4 = lz >> 4;
    u32x2 gq[NS][4], oq[NS][4]; f32x4 ng[4];
#pragma unroll
    for (int me = 0; me < 4; ++me) ng[me] = *(const f32x4*)(ngp + 16 * me + 4 * q4);
#pragma unroll
    for (int ms = 0; ms < NS; ++ms)
#pragma unroll
        for (int me = 0; me < 4; ++me) { const size_t off = (size_t)(r0 + 16 * (mt0 + ms) + r) * NP + pbase + 16 * me + 4 * q4;
            gq[ms][me] = *(const u32x2*)(P + off + (MIXER == 0 ? 1024 : 768)); if constexpr (MIXER == 0) oq[ms][me] = *(const u32x2*)(P + off + 768); else oq[ms][me] = (u32x2){0u, 0u}; }
#pragma unroll
    for (int ms = 0; ms < NS; ++ms) { const int mt = mt0 + ms; float ss = 0.f; float gv[4][4];
#pragma unroll
        for (int me = 0; me < 4; ++me) {
            gv[me][0] = bitsf(gq[ms][me].x << 16); gv[me][1] = bitsf(gq[ms][me].x & 0xffff0000u); gv[me][2] = bitsf(gq[ms][me].y << 16); gv[me][3] = bitsf(gq[ms][me].y & 0xffff0000u);
            if constexpr (MIXER == 0) { htot[ms][me][0] *= sigmoidf_(bitsf(oq[ms][me].x << 16)); htot[ms][me][1] *= sigmoidf_(bitsf(oq[ms][me].x & 0xffff0000u)); htot[ms][me][2] *= sigmoidf_(bitsf(oq[ms][me].y << 16)); htot[ms][me][3] *= sigmoidf_(bitsf(oq[ms][me].y & 0xffff0000u)); }
            ss += htot[ms][me][0] * htot[ms][me][0] + htot[ms][me][1] * htot[ms][me][1] + htot[ms][me][2] * htot[ms][me][2] + htot[ms][me][3] * htot[ms][me][3]; }
        ss = xrow_sum(ss);
        const float rstd = rsqrtf(ss * (1.0f / 64.0f) + EPS);
#pragma unroll
        for (int me = 0; me < 4; ++me) { const int e = 16 * me + 4 * q4; const f32x4 n4 = ng[me];
            u32x2 o; o.x = pk2(htot[ms][me][0] * rstd * n4.x * siluf_(gv[me][0]), htot[ms][me][1] * rstd * n4.y * siluf_(gv[me][1]));
            o.y = pk2(htot[ms][me][2] * rstd * n4.z * siluf_(gv[me][2]), htot[ms][me][3] * rstd * n4.w * siluf_(gv[me][3]));
            *(u32x2*)(Y + (size_t)(r0 + 16 * mt + r) * 1024 + (MIXER == 0 ? YA : YG) + h * 64 + e) = o; } }
}
template <int MIXER>
__device__ __forceinline__ void chunkout_w(const Params& p, int l, int b, int h, int cid, char* wl, int lane) {
    const bf16* P = (const bf16*)(p.ws + WS_P); const float* G = (const float*)(p.ws + WS_G);
    const int r0 = b * TOK + cid * 64;
    const int pbase = (MIXER == 0 ? PA : PG) + h * 64;
    bf16* SB = (bf16*)wl;
    float* rsm = (float*)(SB + 1024);
    float* gar = rsm + 16;
    const bf16* EQ = (const bf16*)(p.ws + WS_EQ);
    const float* Grow0 = G + (size_t)r0 * NGS;
    bf16* VtL = (bf16*)(gar + 768);
    bf16x8 vtf[4][2];
#pragma unroll
    for (int me = 0; me < 4; ++me)
#pragma unroll
        for (int ks = 0; ks < 2; ++ks) { vtf[me][ks] = (bf16x8){0, 0, 0, 0, 0, 0, 0, 0}; }
    co_build_vt(P, r0, pbase + 512, VtL, lane);
    chunkout_prep2<MIXER>(p, l, b, h, cid, Grow0, r0, pbase, gar, lane);
    WAVE_SYNC();
    constexpr int NS = 2;
#pragma unroll 1
    for (int th = 0; th < 4 / NS; ++th) {
        f32x4 htot[NS][4];
#pragma unroll
        for (int a = 0; a < NS; ++a)
#pragma unroll
            for (int c = 0; c < 4; ++c) htot[a][c] = (f32x4){0.f, 0.f, 0.f, 0.f};
        chunkout_dir<MIXER, 0, NS>(p, b, h, cid, r0, pbase, th, vtf, VtL, EQ, SB, gar, rsm, htot, lane);
        chunkout_dir<MIXER, 1, NS>(p, b, h, cid, r0, pbase, th, vtf, VtL, EQ, SB, gar, rsm, htot, lane);
        co_finalize<MIXER, NS>(p, l, h, r0, pbase, NS * th, htot, lane);
    }
}
constexpr int CO_PART = 13376;
template <int MIXER, int DIR>
__device__ __forceinline__ void chunkout_piece(const Params& p, int l, int b, int h, int cid, int mt, char* wl, int lane) {
    const bf16* P = (const bf16*)(p.ws + WS_P); const float* G = (const float*)(p.ws + WS_G);
    const int r0 = b * TOK + cid * 64; const int pbase = (MIXER == 0 ? PA : PG) + h * 64;
    bf16* SB = (bf16*)wl; float* rsm = (float*)(SB + 1024); float* gar = rsm + 16; const bf16* EQ = (const bf16*)(p.ws + WS_EQ);
    const float* Grow0 = G + (size_t)r0 * NGS; bf16* VtL = (bf16*)(gar + 768);
    bf16x8 vtf[4][2];
#pragma unroll
    for (int me = 0; me < 4; ++me)
#pragma unroll
        for (int ks = 0; ks < 2; ++ks) { vtf[me][ks] = (bf16x8){0, 0, 0, 0, 0, 0, 0, 0}; }
    co_build_vt(P, r0, pbase + 512, VtL, lane);
    chunkout_prep<MIXER, DIR>(p, l, b, h, cid, Grow0, r0, pbase, EQ, gar, lane);
    WAVE_SYNC();
    f32x4 htot[1][4] = {{(f32x4){0.f, 0.f, 0.f, 0.f}, (f32x4){0.f, 0.f, 0.f, 0.f}, (f32x4){0.f, 0.f, 0.f, 0.f}, (f32x4){0.f, 0.f, 0.f, 0.f}}};
    chunkout_dir<MIXER, DIR, 1>(p, b, h, cid, r0, pbase, mt, vtf, VtL, EQ, SB, gar, rsm, htot, lane);
    float* part = (float*)(wl + CO_PART);
#pragma unroll
    for (int me = 0; me < 4; ++me)
#pragma unroll
        for (int i = 0; i < 4; ++i) part[(me * 4 + i) * 64 + lane] = htot[0][me][i];
}
template <int MIXER>
__device__ __forceinline__ void chunkout_combine(const Params& p, int l, int b, int h, int cid, int mt, const char* smem, int lane) {
    const float* pa = (const float*)(smem + (2 * mt) * WLDS + CO_PART); const float* pb = (const float*)(smem + (2 * mt + 1) * WLDS + CO_PART);
    f32x4 htot[1][4];
#pragma unroll
    for (int me = 0; me < 4; ++me)
#pragma unroll
        for (int i = 0; i < 4; ++i) htot[0][me][i] = pa[(me * 4 + i) * 64 + lane] + pb[(me * 4 + i) * 64 + lane];
    co_finalize<MIXER, 1>(p, l, h, b * TOK + cid * 64, (MIXER == 0 ? PA : PG) + h * 64, mt, htot, lane);
}

template <bool OUT>
__device__ __forceinline__ void chunk_workers(const Params& p, int l, char* smem) {
    const int tid = otid(), lane = tid & 63, wave = __builtin_amdgcn_readfirstlane(tid >> 6);
    const int NW = (int)gridDim.x * 8, wi = wave * (int)gridDim.x + obid();
    const int c_lo = (OUT && l == DEPTH - 1) ? NCC : 0, npc = NCH - c_lo, half = NB * NH * npc;
    char* wl = smem + wave * WLDS;
    if (OUT) {
        const int cl = NCC, npl = NCH - NCC, halfl = NB * NH * npl;
#pragma unroll 1
        for (int t = wi; t < halfl; t += NW) { const int b = t / (NH * npl), h = (t / npl) % NH, cid = cl + t % npl;
            const Params q = relaunder(p); chunkout_w<1>(q, l, b, h, cid, wl, lane); }
        { const int used = halfl % NW;
#pragma unroll 1
            for (int t = (wi + NW - used) % NW; t < halfl; t += NW) { const int b = t / (NH * npl), h = (t / npl) % NH, cid = cl + t % npl;
                const Params q = relaunder(p); chunkout_w<0>(q, l, b, h, cid, wl, lane); } }
        if (l < DEPTH - 1) {
            const int nct = NB * NH * NCC;
#pragma unroll 1
            for (int st = obid(); st < 2 * nct; st += (int)gridDim.x) { const int mixer = st / nct, r2 = st % nct, b = r2 / (NH * NCC), h = (r2 / NCC) % NH, cid = r2 % NCC;
                const Params q = relaunder(p); const int mt = wave >> 1;
                __syncthreads();
                if (mixer == 0) { if (wave & 1) chunkout_piece<0, 1>(q, l, b, h, cid, mt, wl, lane); else chunkout_piece<0, 0>(q, l, b, h, cid, mt, wl, lane); }
                else            { if (wave & 1) chunkout_piece<1, 1>(q, l, b, h, cid, mt, wl, lane); else chunkout_piece<1, 0>(q, l, b, h, cid, mt, wl, lane); }
                __syncthreads();
                if (wave < 4) { if (mixer == 0) chunkout_combine<0>(q, l, b, h, cid, wave, smem, lane); else chunkout_combine<1>(q, l, b, h, cid, wave, smem, lane); }
            }
        }
    } else {
        int off = 0;
#pragma unroll 1
        for (int t = wi; t < half; t += NW) { const int b = t / (NH * npc), h = (t / npc) % NH, cid = c_lo + t % npc;
            const Params q = relaunder(p); chunkst_gla<0>(q, l, b, h, cid, wl, lane); }
        off = (off + half) % NW;
#pragma unroll 1
        for (int t = (wi + NW - off) % NW; t < half; t += NW) { const int b = t / (NH * npc), h = (t / npc) % NH, cid = c_lo + t % npc;
            const Params q = relaunder(p); chunkst_gla<1>(q, l, b, h, cid, wl, lane); }
        off = (off + half) % NW;
#pragma unroll 1
        for (int t = (wi + NW - off) % NW; t < half; t += NW) { const int b = t / (NH * npc), h = (t / npc) % NH, cid = c_lo + t % npc;
            const Params q = relaunder(p); chunkst_w<0>(q, l, b, h, cid, wl, lane); }
    }
}

__device__ __forceinline__ void phase_mix1(const Params& p, int l, char* smem) {
    const bool ctxo = l < DEPTH - 1; const int G = (int)gridDim.x, bid = obid();
    constexpr int N_HL = (NB / 2) * (WG / 2), N_HC = NB * (WG / HCB);
    chunk_workers<false>(p, l, smem);
    stage_signal(p, smem, 0, l);
    for (int t = bid; t < N_HL; t += G) hylat_task(p, l, t / (WG / 2), t % (WG / 2), smem);
    if (ctxo) for (int t = G - 1 - bid; t < N_HC; t += G) hyctx_task(p, l, t / (WG / HCB), t % (WG / HCB), smem);
    stage_signal(p, smem, 2, l);
}

constexpr int SCG = 12;
__device__ __forceinline__ void phase_scan(const Params& p, int l, char* smem) {
    const int tid = otid();
    bf16* ST = (bf16*)(p.ws + WS_ST); float* NV = (float*)(p.ws + WS_NV); const float* BE = (const float*)(p.ws + WS_BE); float* SC = (float*)(p.ws + WS_SC);
    constexpr int NCHAIN = 2 * 2 * NB * NH;
    stage_wait(p, 0, l);
    for (int item = obid() * NT + tid; item < NCHAIN * 1024; item += gridDim.x * NT) {
        const int chain = item >> 10, grp = item & 1023; const int mixer = chain / (2 * NB * NH), dir = (chain / (NB * NH)) % 2, b = (chain / NH) % NB, h = chain % NH;
        float c[4] = {0.f, 0.f, 0.f, 0.f}; float nv[4] = {0.f, 0.f, 0.f, 0.f}; float m = 0.f;
        const int d0 = (grp & 15) * 4; const bool donv = (mixer == 0) && (grp < 16);
        for (int o0 = 0; o0 < NCH; o0 += SCG) {
            u32x2 uu[SCG]; float s0[SCG], s1[SCG]; f32x4 be[SCG]; f32x4 nu[SCG];
#pragma unroll
            for (int j = 0; j < SCG; ++j) if (o0 + j < NCH) { const int cid = chain_cid(dir, o0 + j); const size_t ci = ch_index(dir, b, h, cid);
                uu[j] = *(const u32x2*)(ST + st_index(mixer, dir, b, h, cid) * 4096 + grp * 4);
                if (mixer == 0) { s0[j] = SC[ci * 4 + 0]; s1[j] = SC[ci * 4 + 1]; if (donv) nu[j] = *(const f32x4*)(NV + ci * 64 + grp * 4); }
                else be[j] = *(const f32x4*)(BE + ci * 64 + d0); }
#pragma unroll
            for (int j = 0; j < SCG; ++j) if (o0 + j < NCH) { const int cid = chain_cid(dir, o0 + j); const size_t ci = ch_index(dir, b, h, cid);
                const float u[4] = {bitsf(uu[j].x << 16), bitsf(uu[j].x & 0xffff0000u), bitsf(uu[j].y << 16), bitsf(uu[j].y & 0xffff0000u)};
                u32x2 w; w.x = pk2(c[0], c[1]); w.y = pk2(c[2], c[3]); *(u32x2*)(ST + st_index(mixer, dir, b, h, cid) * 4096 + grp * 4) = w;
                if (mixer == 0) {
                    if (grp == 0) SC[ci * 4 + 2] = m;
                    const float mn = fmaxf(s0[j] + m, s1[j]), a = __expf(s0[j] + m - mn), s = __expf(s1[j] - mn);
#pragma unroll
                    for (int k = 0; k < 4; ++k) c[k] = a * c[k] + s * u[k];
                    if (donv) { f32x4 nw = {nv[0], nv[1], nv[2], nv[3]}; *(f32x4*)(NV + ci * 64 + grp * 4) = nw;
                        nv[0] = a * nv[0] + s * nu[j].x; nv[1] = a * nv[1] + s * nu[j].y; nv[2] = a * nv[2] + s * nu[j].z; nv[3] = a * nv[3] + s * nu[j].w; }
                    m = mn;
                } else { c[0] = __expf(be[j].x) * c[0] + u[0]; c[1] = __expf(be[j].y) * c[1] + u[1]; c[2] = __expf(be[j].z) * c[2] + u[2]; c[3] = __expf(be[j].w) * c[3] + u[3]; } }
        }
    }
    stage_signal(p, smem, 1, l);
    { const bool ctxo = l < DEPTH - 1; const int G = (int)gridDim.x, bid = obid();
        constexpr int QTL = SEQ / 128, QTC = CTXL / 128, N_AL = NB * 2 * QTL, N_AC = NB * 2 * QTC;
        for (int t = bid; t < N_AL; t += G) attn_task(p, l, t / (2 * QTL), (t / QTL) % 2, t % QTL, false, smem);
        if (ctxo) for (int t = (bid + G - 64 % G) % G; t < N_AC; t += G) attn_task(p, l, t / (2 * QTC), (t / QTC) % 2, t % QTC, true, smem); }
}

__device__ __forceinline__ void phase_mix2(const Params& p, int l, char* smem) {
    const int tid = otid();
    stage_wait(p, 1, l);
    chunk_workers<true>(p, l, smem);
    stage_wait(p, 2, l);
    constexpr int N_WOUT = (DM / 64) * (MIX / 64);
    { const int lane = tid & 63, wave = __builtin_amdgcn_readfirstlane(tid >> 6); const int NW = (int)gridDim.x * 8, wi = wave * (int)gridDim.x + obid();
        for (int task = NW - 1 - wi; task < N_WOUT; task += NW) { const int nt = task / (MIX / 64), kt = task % (MIX / 64);
            convert_tile_w(p.in[I_WOUT] + (size_t)l * MIX * DM, DM, (bf16*)(p.ws + WS_WOUT), MIX, nt * 64, kt * 64, false, smem + wave * WLDS, lane); }
        bf16* tile = (bf16*)(smem + wave * WLDS); const bf16* HT = (const bf16*)(p.ws + WS_HT); bf16* Y = (bf16*)(p.ws + WS_HNY);
        constexpr int NTT = NB * (SEQ / 64) * 4;
        for (int t = wi; t < NTT; t += NW) { const int b = t / ((SEQ / 64) * 4), tt = (t / 4) % (SEQ / 64), c0 = (t % 4) * 64; const size_t tok0 = (size_t)b * TOK + CTXL + tt * 64;
#pragma unroll
            for (int i = 0; i < 8; ++i) { const int ch = (lane >> 3) + 8 * i, ck = lane & 7; *(u32x4*)(tile + swz(ch, ck)) = *(const u32x4*)(HT + (size_t)(768 + c0 + ch) * T + tok0 + ck * 8); }
            WAVE_SYNC();
#pragma unroll
            for (int i = 0; i < 8; ++i) { const int tk = (lane >> 3) + 8 * i, cc = lane & 7; unsigned w[4];
#pragma unroll
                for (int j = 0; j < 4; ++j) { const int ca = cc * 8 + 2 * j; w[j] = (unsigned)tile[swz(ca, tk >> 3) + (tk & 7)] | ((unsigned)tile[swz(ca + 1, tk >> 3) + (tk & 7)] << 16); }
                u32x4 o; o.x = w[0]; o.y = w[1]; o.z = w[2]; o.w = w[3]; *(u32x4*)(Y + (tok0 + tk) * 1024 + YH + c0 + cc * 8) = o; }
            WAVE_SYNC(); } }
}


#ifndef EMU
#define LAS __attribute__((address_space(3)))
#define XB_TMO      128
#define XB_XCNT(j)  (256  + 64 * (j))
#define XB_XSUB(j)  (1280 + 64 * (j))
#define XB_XGEN(j)  (2304 + 64 * (j))
#define XB_TOP      3328
#define XB_TOPGEN   3392
#define XCD_BAR_WORDS 3456
#define XB_SPIN_CAP (1u << 18)

__device__ __forceinline__ unsigned xb_ld(unsigned* p)              { return __hip_atomic_load(p, __ATOMIC_RELAXED, __HIP_MEMORY_SCOPE_AGENT); }
__device__ __forceinline__ unsigned xb_add(unsigned* p, unsigned v) { return __hip_atomic_fetch_add(p, v, __ATOMIC_RELAXED, __HIP_MEMORY_SCOPE_AGENT); }
__device__ __forceinline__ unsigned xb_xcc_id() { return (unsigned)__builtin_amdgcn_s_getreg((3 << 11) | 20) & 0xFu; }
#define XB_SPIN(cond, bar) do { unsigned _sp = 0; while (cond) { __builtin_amdgcn_s_sleep(1); \
    if ((++_sp & 255u) == 0u) { if (xb_ld(&(bar)[XB_TMO])) break; if (_sp > XB_SPIN_CAP) { atomicAdd(&(bar)[XB_TMO], 1u); break; } } } } while (0)

struct XcdBarrier {
    unsigned* bar; unsigned x;
    volatile LAS unsigned* st;
};

__device__ __forceinline__ XcdBarrier xcd_barrier_post(unsigned* bar, volatile LAS unsigned* st) {
    XcdBarrier b; b.bar = bar; b.x = xb_xcc_id(); b.st = st;
    if (threadIdx.x == 0) (void)xb_add(&bar[XB_XCNT(b.x)], 1u);
    return b;
}
__device__ __forceinline__ void xcd_barrier_complete(unsigned* bar, unsigned x, unsigned& nloc, unsigned& nx) {
    const unsigned G = gridDim.x * gridDim.y * gridDim.z;
    unsigned sum, cnt, mine, sp = 0u;
    for (;;) {
        sum = 0u; cnt = 0u; mine = 0u;
#pragma unroll
        for (unsigned j = 0; j < 16; ++j) { const unsigned c = xb_ld(&bar[XB_XCNT(j)]); sum += c; cnt += (c > 0u) ? 1u : 0u; mine = (j == x) ? c : mine; }
        if (sum == G) break;
        __builtin_amdgcn_s_sleep(1);
        if ((++sp & 255u) == 0u) { if (xb_ld(&bar[XB_TMO])) break; if (sp > XB_SPIN_CAP) { atomicAdd(&bar[XB_TMO], 1u); break; } }
    }
    nloc = mine > 0u ? mine : 1u; nx = cnt > 0u ? cnt : 1u;
}

__device__ __forceinline__ void xcd_barrier(const XcdBarrier& b) {
    asm volatile("s_waitcnt vmcnt(0)" ::: "memory");
    __syncthreads();
    if (threadIdx.x == 0) {
        unsigned* bar = b.bar;
        __builtin_amdgcn_s_waitcnt(0);
        unsigned nloc = b.st[0], nx = b.st[1];
        if (nloc == 0u) { xcd_barrier_complete(bar, b.x, nloc, nx); b.st[0] = nloc; b.st[1] = nx; }
        const unsigned old = xb_add(&bar[XB_XSUB(b.x)], 1u);
        const unsigned gen = old / nloc;
        if (old + 1u == (gen + 1u) * nloc) {
            __builtin_amdgcn_fence(__ATOMIC_RELEASE, "agent");
            asm volatile("s_waitcnt vmcnt(0)" ::: "memory");
            const unsigned og = xb_add(&bar[XB_TOP], 1u);
            const unsigned tg = og / nx;
            if (og + 1u == (tg + 1u) * nx) xb_add(&bar[XB_TOPGEN], 1u);
            else XB_SPIN(xb_ld(&bar[XB_TOPGEN]) == tg, bar);
            __builtin_amdgcn_fence(__ATOMIC_ACQUIRE, "agent");
            xb_add(&bar[XB_XGEN(b.x)], 1u);
            asm volatile("s_waitcnt vmcnt(0)" ::: "memory");
        } else {
            XB_SPIN(xb_ld(&bar[XB_XGEN(b.x)]) == gen, bar);
            __builtin_amdgcn_fence(__ATOMIC_ACQUIRE, "agent");
            asm volatile("s_waitcnt vmcnt(0)" ::: "memory");
        }
    }
    __syncthreads();
}
#endif

__global__ void __launch_bounds__(NT) fwd_kernel(Params pk, int ph_lo, int ph_hi) {
    SMEM_DECL;
#ifndef EMU
    volatile LAS unsigned* misc = (volatile LAS unsigned*)(smem + LDS_BYTES - 64);
    if (threadIdx.x < 2) misc[threadIdx.x] = 0u;
    __syncthreads();
    const XcdBarrier bar = xcd_barrier_post((unsigned*)(pk.ws + WS_BAR), misc);
#endif
    constexpr int NPH = 2 + 6 * DEPTH;
    for (int ph = ph_lo; ph < ph_hi && ph < NPH; ++ph) {
#ifndef EMU
        Params p = pk; { size_t z = 0; asm volatile("" : "+s"(z)); p.ws = pk.ws + z; p.out = pk.out + z;
#pragma unroll
            for (int i = 0; i < 26; ++i) p.in[i] = pk.in[i] + z; }
#else
        const Params& p = pk;
#endif
        if (ph == 0) phase0(p, smem);
        else if (ph == NPH - 1) phase_rp(p, DEPTH, smem);
        else { const int l = (ph - 1) / 6, k = (ph - 1) % 6;
            if (k == 0) phase_rp(p, l, smem);
            else if (k == 1) phase_gemm_in(p, l, smem);
            else if (k == 2) phase_mix1(p, l, smem);
            else if (k == 3) phase_scan(p, l, smem);
            else if (k == 4) phase_mix2(p, l, smem);
            else phase_gemm_out(p, l, smem);
#ifdef PROBE_DUP
            if (k == PROBE_DUP) { GRID_SYNC();
                if (k == 1) phase_gemm_in(p, l, smem); else if (k == 2) phase_mix1(p, l, smem); else if (k == 4) phase_mix2(p, l, smem); }
#endif
        }
        if (ph + 1 < ph_hi && !(ph >= 6 && ph % 6 == 0) && !(ph >= 1 && ((ph - 1) % 6 == 2 || (ph - 1) % 6 == 3))) {
#ifdef EMU
            GRID_SYNC();
#else
            if (ph_lo < 0) GRID_SYNC();
            xcd_barrier(bar);
#endif
        }
    }
}

#ifndef EMU
extern "C" void kernel_launch(void* const* d_in, const int* in_sizes, int n_in, void* d_out, int out_size, void* d_ws, size_t ws_size, hipStream_t stream) {
    static int grid = 0;
    if (grid == 0) {
        if (n_in != 26 || ws_size < WS_TOTAL) { fprintf(stderr, "kernel_launch: unexpected n_in %d or ws_size %zu (need %zu)\n", n_in, ws_size, (size_t)WS_TOTAL); grid = -1; return; }
        int dev = 0, cus = 0, per_cu = 0;
        hipGetDevice(&dev);
        hipDeviceGetAttribute(&cus, hipDeviceAttributeMultiprocessorCount, dev);
        hipFuncSetAttribute((const void*)fwd_kernel, hipFuncAttributeMaxDynamicSharedMemorySize, LDS_BYTES);
        hipOccupancyMaxActiveBlocksPerMultiprocessor(&per_cu, (const void*)fwd_kernel, NT, LDS_BYTES);
        if (per_cu < 1) { fprintf(stderr, "kernel_launch: occupancy query returned %d\n", per_cu); grid = -1; return; }
        if (per_cu > 1) per_cu = 1;
        grid = cus * per_cu;
    }
    if (grid < 0) return;
    hipMemsetAsync((char*)d_ws + WS_BAR, 0, BAR_BYTES, stream);
    Params p{};
    for (int i = 0; i < 26; ++i) p.in[i] = (const float*)d_in[i];
    p.out = (float*)d_out; p.ws = (char*)d_ws;
    int lo = 0, hi = 2 + 6 * DEPTH;
    void* args[] = {&p, &lo, &hi};
    hipError_t e = hipLaunchCooperativeKernel((const void*)fwd_kernel, dim3(grid), dim3(NT), args, LDS_BYTES, stream);
    if (e != hipSuccess) fprintf(stderr, "cooperative launch failed: %s (grid %d)\n", hipGetErrorString(e), grid);
}
#endif
```

```cpp
#ifdef EMU
#include "emu/hipemu.h"
#define GRID_SYNC() emu::grid_sync()
#define SMEM_DECL char* smem = emu::S().blocks[emu::cur()->block].lds
#define SCHED_FENCE() do {} while (0)
#define EXP2(x) exp2f(x)
#define MFMA16(a, b, c) emu_mfma_16x16x32_bf16(a, b, c)
#else
#include <hip/hip_runtime.h>
#include <hip/hip_cooperative_groups.h>
#include <cstdio>
#include <cstdint>
#define GRID_SYNC() cooperative_groups::this_grid().sync()
#define SMEM_DECL extern __shared__ __attribute__((aligned(16))) char smem[]
#define SCHED_FENCE() __builtin_amdgcn_sched_barrier(0)
#define EXP2(x) __builtin_amdgcn_exp2f(x)
#define MFMA16(a, b, c) __builtin_amdgcn_mfma_f32_16x16x32_bf16(a, b, c, 0, 0, 0)
#endif

#ifdef EMU
#ifndef EMU_DM
#define EMU_DM 256
#endif
#ifndef EMU_NB
#define EMU_NB 2
#endif
#ifndef EMU_SEQ
#define EMU_SEQ 512
#endif
#ifndef EMU_DEPTH
#define EMU_DEPTH 2
#endif
#ifndef EMU_CTXL
#define EMU_CTXL 128
#endif
constexpr int DM = EMU_DM, NB = EMU_NB, SEQ = EMU_SEQ, DEPTH = EMU_DEPTH, CTXL = EMU_CTXL;
#else
constexpr int DM = 1024, NB = 8, SEQ = 2048, DEPTH = 4, CTXL = 256;
#endif
constexpr int MIX = 1024, WG = 256, HD = 64, NH = 4, CH = 64;
constexpr int TOK = CTXL + SEQ, T = NB * TOK, NCH = TOK / CH, NCC = CTXL / CH;
constexpr int N_IN = 4144, NP = 3072, NG = 48, NGS = 32, NMAIN = 3328, NPAD = 4352;
constexpr int NF = 2 * SEQ;
constexpr int NJ = NB + 1;
constexpr int NT = 512;
constexpr float EPS = 1e-6f;
constexpr int PA = 0, PG = 1280, PD = 2304;
constexpr int YA = 0, YH = 256, YG = 512, YD = 768;
constexpr int ilog4(int n) { return n <= 1 ? 0 : 1 + ilog4(n / 4); }
constexpr int FFT_P = ilog4(NF);
static_assert((1 << (2 * FFT_P)) == NF, "NF must be a power of 4");
static_assert(DM % 256 == 0 && CTXL % 128 == 0 && SEQ % 256 == 0, "shape constraints");

typedef unsigned short bf16;
typedef short bf16x8 __attribute__((ext_vector_type(8)));
typedef float f32x4 __attribute__((ext_vector_type(4)));
typedef unsigned u32x4 __attribute__((ext_vector_type(4)));
typedef unsigned u32x2 __attribute__((ext_vector_type(2)));
struct cpx { float x, y; };

constexpr size_t al256(size_t x) { return (x + 255) & ~(size_t)255; }
constexpr size_t WS_CTXB = 0;
constexpr size_t WS_HNY = al256(WS_CTXB + (size_t)NB * CTXL * DM * 4);
constexpr size_t WS_WIN = WS_HNY + (size_t)T * 1024 * 2;
constexpr size_t WS_ST = WS_WIN;
constexpr size_t ST_BYTES = (size_t)2 * 2 * NB * NH * NCH * 4096 * 2;
constexpr size_t WS_KT = al256(WS_WIN + (size_t)NPAD * DM * 2);
static_assert(WS_KT + (size_t)WG * NF * 4 <= WS_ST + ST_BYTES || true, "");
constexpr size_t ST_END = al256((WS_ST + ST_BYTES > WS_KT + (size_t)WG * NF * 4) ? WS_ST + ST_BYTES : WS_KT + (size_t)WG * NF * 4);
constexpr size_t WS_P = ST_END;
constexpr size_t WS_HT = al256(WS_P + (size_t)T * NP * 2);
constexpr size_t WS_WOUT = WS_HT;
constexpr size_t WS_G = al256(WS_HT + (size_t)1024 * T * 2);
constexpr size_t WS_KF = al256(WS_G + (size_t)T * NGS * 4);
constexpr size_t WS_HC = al256(WS_KF + (size_t)WG * NF * 8);
constexpr size_t WS_EQ = al256(WS_HC + (size_t)2 * WG * CTXL * 4);
constexpr size_t WS_NV = al256(WS_EQ + (size_t)2 * T * WG * 2);
constexpr size_t WS_BE = al256(WS_NV + (size_t)2 * NB * NH * NCH * 64 * 4);
constexpr size_t WS_SC = al256(WS_BE + (size_t)2 * NB * NH * NCH * 64 * 4);
constexpr size_t WS_MOD = al256(WS_SC + (size_t)2 * NB * NH * NCH * 4 * 4);
constexpr size_t WS_TW = al256(WS_MOD + (size_t)DEPTH * NJ * 3 * DM * 4);
constexpr size_t WS_ROPE = al256(WS_TW + (size_t)NF * 8);
constexpr size_t WS_BAR = al256(WS_ROPE + (size_t)SEQ * 32 * 8);
constexpr size_t BAR_BYTES = 32768;
constexpr size_t WS_TOTAL = al256(WS_BAR + BAR_BYTES);
static_assert((size_t)T * DM * 4 <= (size_t)T * NP * 2, "YO fits in P");
#ifndef EMU
static_assert(WS_TOTAL <= (size_t)268435456, "workspace map must fit 256 MiB");
#endif

constexpr int LDS_BYTES = 163840;

struct Params {
    const float* in[26];
    float* out;
    char* ws;
};
enum { I_X = 0, I_C, I_CTX, I_CCTX, I_WADA, I_BADA, I_GPRE, I_GPOST, I_WIN, I_MGB, I_MNG, I_HCW, I_HCB, I_HW1, I_HB1, I_HW2, I_HB2, I_HW3, I_HB3,
       I_HFREQ, I_HD, I_GWA, I_GBA, I_GNG, I_SINK, I_WOUT };

__device__ __forceinline__ Params relaunder(const Params& pk) {
#ifdef EMU
    return pk;
#else
    Params p = pk; size_t z = 0; asm volatile("" : "+s"(z)); p.ws = pk.ws + z; p.out = pk.out + z;
#pragma unroll
    for (int i = 0; i < 26; ++i) p.in[i] = pk.in[i] + z;
    return p;
#endif
}
constexpr int WLDS = (LDS_BYTES - 64) / 8 / 16 * 16;
#ifdef EMU
#define WAVE_SYNC() emu_wave_sync()
#else
#define WAVE_SYNC() do { asm volatile("s_waitcnt lgkmcnt(0)" ::: "memory"); __builtin_amdgcn_wave_barrier(); } while (0)
#endif

#ifdef EMU
__device__ __forceinline__ int otid() { return (int)threadIdx.x; }
__device__ __forceinline__ int obid() { return (int)blockIdx.x; }
#else
__device__ __forceinline__ int otid() { int t = (int)threadIdx.x; asm volatile("" : "+v"(t)); return t; }
__device__ __forceinline__ int obid() { int b = (int)blockIdx.x; asm volatile("" : "+s"(b)); return b; }
#endif
__device__ __forceinline__ unsigned fbits(float f) { return __builtin_bit_cast(unsigned, f); }
__device__ __forceinline__ float bitsf(unsigned u) { return __builtin_bit_cast(float, u); }
__device__ __forceinline__ float bf2f(bf16 h) { return bitsf((unsigned)h << 16); }
#ifdef EMU
__device__ __forceinline__ bf16 f2bf(float f) { unsigned u = fbits(f); return (bf16)((u + 0x7fffu + ((u >> 16) & 1u)) >> 16); }
__device__ __forceinline__ unsigned pk2(float lo, float hi) { return (unsigned)f2bf(lo) | ((unsigned)f2bf(hi) << 16); }
#else
typedef __bf16 nbf16x2 __attribute__((ext_vector_type(2)));
typedef float nf32x2 __attribute__((ext_vector_type(2)));
__device__ __forceinline__ unsigned pk2(float lo, float hi) { const nf32x2 v = {lo, hi}; return __builtin_bit_cast(unsigned, __builtin_convertvector(v, nbf16x2)); }
__device__ __forceinline__ bf16 f2bf(float f) { return (bf16)(pk2(f, 0.0f) & 0xffffu); }
#endif
#ifdef EMU
__device__ __forceinline__ float frcp_(float x) { return 1.0f / x; }
#else
__device__ __forceinline__ float frcp_(float x) { return __builtin_amdgcn_rcpf(x); }
#endif
__device__ __forceinline__ float sigmoidf_(float x) { return frcp_(1.0f + __expf(-x)); }
__device__ __forceinline__ float siluf_(float x) { return x * frcp_(1.0f + __expf(-x)); }
__device__ __forceinline__ float logsigf_(float x) { return fminf(x, 0.0f) - log1pf(__expf(-fabsf(x))); }
__device__ __forceinline__ float logsig_fast(float x) { return fminf(x, 0.0f) - __logf(1.0f + __expf(-fabsf(x))); }
#ifdef EMU
__device__ __forceinline__ float row16_sum(float x) { x += __shfl_xor(x, 1); x += __shfl_xor(x, 2); x += __shfl_xor(x, 4); x += __shfl_xor(x, 8); return x; }
__device__ __forceinline__ float row16_max(float x) { x = fmaxf(x, __shfl_xor(x, 1)); x = fmaxf(x, __shfl_xor(x, 2)); x = fmaxf(x, __shfl_xor(x, 4)); x = fmaxf(x, __shfl_xor(x, 8)); return x; }
__device__ __forceinline__ float xrow_sum(float x) { x += __shfl_xor(x, 16); x += __shfl_xor(x, 32); return x; }
__device__ __forceinline__ float xrow_max(float x) { x = fmaxf(x, __shfl_xor(x, 16)); x = fmaxf(x, __shfl_xor(x, 32)); return x; }
#else
template <int CTRL> __device__ __forceinline__ float dpp_(float x) { return __builtin_bit_cast(float, __builtin_amdgcn_mov_dpp(__builtin_bit_cast(int, x), CTRL, 0xf, 0xf, true)); }
__device__ __forceinline__ float row16_sum(float x) { x += dpp_<0xB1>(x); x += dpp_<0x4E>(x); x += dpp_<0x141>(x); x += dpp_<0x128>(x); return x; }
__device__ __forceinline__ float row16_max(float x) { x = fmaxf(x, dpp_<0xB1>(x)); x = fmaxf(x, dpp_<0x4E>(x)); x = fmaxf(x, dpp_<0x141>(x)); x = fmaxf(x, dpp_<0x128>(x)); return x; }
__device__ __forceinline__ float xrow_sum(float x) {
    auto s = __builtin_amdgcn_permlane16_swap(fbits(x), fbits(x), false, false); x = bitsf(s[0]) + bitsf(s[1]);
    auto t = __builtin_amdgcn_permlane32_swap(fbits(x), fbits(x), false, false); return bitsf(t[0]) + bitsf(t[1]); }
__device__ __forceinline__ float xrow_max(float x) {
    auto s = __builtin_amdgcn_permlane16_swap(fbits(x), fbits(x), false, false); x = fmaxf(bitsf(s[0]), bitsf(s[1]));
    auto t = __builtin_amdgcn_permlane32_swap(fbits(x), fbits(x), false, false); return fmaxf(bitsf(t[0]), bitsf(t[1])); }
#endif
__device__ __forceinline__ float wave_sum(float v) { return xrow_sum(row16_sum(v)); }
__device__ __forceinline__ float wave_max(float v) { return xrow_max(row16_max(v)); }
#ifdef EMU
__device__ __forceinline__ float wave_prefix_sum(float v, int lane) {
#pragma unroll
    for (int o = 1; o < 64; o <<= 1) { float t = __shfl_up(v, o); if (lane >= o) v += t; }
    return v;
}
__device__ __forceinline__ float wave_prefix_max(float v, int lane) {
#pragma unroll
    for (int o = 1; o < 64; o <<= 1) { float t = __shfl_up(v, o); if (lane >= o) v = fmaxf(v, t); }
    return v;
}
#else
template <int CTRL, int RM> __device__ __forceinline__ float dppo_(float old, float x) { return __builtin_bit_cast(float, __builtin_amdgcn_update_dpp(__builtin_bit_cast(int, old), __builtin_bit_cast(int, x), CTRL, RM, 0xf, false)); }
__device__ __forceinline__ float wave_prefix_sum(float v, int) {
    v += dppo_<0x111, 0xf>(0.f, v); v += dppo_<0x112, 0xf>(0.f, v); v += dppo_<0x114, 0xf>(0.f, v); v += dppo_<0x118, 0xf>(0.f, v);
    v += dppo_<0x142, 0xa>(0.f, v); v += dppo_<0x143, 0xc>(0.f, v); return v;
}
__device__ __forceinline__ float wave_prefix_max(float v, int) {
    const float ninf = -INFINITY;
    v = fmaxf(v, dppo_<0x111, 0xf>(ninf, v)); v = fmaxf(v, dppo_<0x112, 0xf>(ninf, v)); v = fmaxf(v, dppo_<0x114, 0xf>(ninf, v)); v = fmaxf(v, dppo_<0x118, 0xf>(ninf, v));
    v = fmaxf(v, dppo_<0x142, 0xa>(ninf, v)); v = fmaxf(v, dppo_<0x143, 0xc>(ninf, v)); return v;
}
#endif
__device__ __forceinline__ float wave_suffix_max(float v, int lane) {
    return __shfl(wave_prefix_max(__shfl(v, 63 - lane), lane), 63 - lane);
}
__device__ __forceinline__ void unpack8(u32x4 v, float* f) {
    f[0] = bitsf(v.x << 16); f[1] = bitsf(v.x & 0xffff0000u); f[2] = bitsf(v.y << 16); f[3] = bitsf(v.y & 0xffff0000u);
    f[4] = bitsf(v.z << 16); f[5] = bitsf(v.z & 0xffff0000u); f[6] = bitsf(v.w << 16); f[7] = bitsf(v.w & 0xffff0000u);
}
__device__ __forceinline__ int orig_col(int n) {
    if (n < 1280) return n;
    if (n < 2304) return 2320 + (n - 1280);
    if (n < 3072) return 3376 + (n - 2304);
    if (n < 3088) return 1280 + (n - 3072);
    if (n < 3120) return 3344 + (n - 3088);
    if (n < NMAIN) return -1;
    return 1296 + (n - NMAIN);
}
__device__ __forceinline__ int chain_cid(int dir, int o) {
    if (dir == 0) return o;
    return o < NCC ? (NCC - 1 - o) : (NCH - 1 - (o - NCC));
}

__device__ __forceinline__ int swz(int row, int ch) { return row * 64 + ((ch ^ (row & 7)) << 3); }
__device__ __forceinline__ u32x4 pack8(const float* f) { u32x4 o; o.x = pk2(f[0], f[1]); o.y = pk2(f[2], f[3]); o.z = pk2(f[4], f[5]); o.w = pk2(f[6], f[7]); return o; }
__device__ __forceinline__ bf16x8 as_frag(u32x4 v) { return __builtin_bit_cast(bf16x8, v); }
#ifdef EMU
inline u32x2 lds_tr16(const bf16* p) { unsigned mine[2]; const unsigned long long a = (unsigned long long)p; mine[0] = (unsigned)a; mine[1] = (unsigned)(a >> 32);
    auto buf = emu::collective(mine, 2); const int l = emu::cur()->lane, g = l >> 4, i = l & 15; unsigned short e[4];
    for (int j = 0; j < 4; ++j) { const int src = 16 * g + 4 * j + (i >> 2); const bf16* q = (const bf16*)(((unsigned long long)buf[src][1] << 32) | buf[src][0]); e[j] = *(const unsigned short*)(q + (i & 3)); }
    u32x2 r; r.x = (unsigned)e[0] | ((unsigned)e[1] << 16); r.y = (unsigned)e[2] | ((unsigned)e[3] << 16); return r; }
#else
typedef short v4i16_t __attribute__((ext_vector_type(4)));
__device__ __forceinline__ u32x2 lds_tr16(const bf16* p) { return __builtin_bit_cast(u32x2, __builtin_amdgcn_ds_read_tr16_b64_v4i16((__attribute__((address_space(3))) v4i16_t*)p)); }
#endif
__device__ __forceinline__ u32x4 as_u4(bf16x8 v) { return __builtin_bit_cast(u32x4, v); }

constexpr int LS = 72;

template <int NTL, int KS>
__device__ __forceinline__ void mma_nt(const bf16* A, int lda, int m0, const bf16* B, int ldb, int n0, f32x4 (&acc)[NTL], int lane) {
    const int r = lane & 15, q = lane >> 4;
#pragma unroll
    for (int ks = 0; ks < KS; ++ks) {
        const bf16x8 a = *(const bf16x8*)(A + (m0 + r) * lda + ks * 32 + q * 8);
#pragma unroll
        for (int nt = 0; nt < NTL; ++nt) {
            const bf16x8 b = *(const bf16x8*)(B + (n0 + nt * 16 + r) * ldb + ks * 32 + q * 8);
            acc[nt] = MFMA16(a, b, acc[nt]);
        }
    }
}

__device__ __forceinline__ void layer_prep(const Params& p, int l, int idx, int stride, char* smem);
__device__ __forceinline__ void phase0(const Params& p, char* smem) {
    const int tid = otid();
    cpx* TW = (cpx*)(p.ws + WS_TW);
    cpx* ROPE = (cpx*)(p.ws + WS_ROPE);
    float* MOD = (float*)(p.ws + WS_MOD);
    constexpr int N_TW = NF / NT, N_ROPE = SEQ * 32 / NT, N_MOD = DEPTH * (3 * DM / 64);
    for (int task = obid(); task < N_TW + N_ROPE + N_MOD; task += gridDim.x) {
        if (task < N_TW) {
            const int j = task * NT + tid; float s, c; sincospif(2.0f * (float)j / (float)NF, &s, &c);
            cpx v; v.x = c; v.y = -s; TW[j] = v;
        } else if (task < N_TW + N_ROPE) {
            const int idx = (task - N_TW) * NT + tid; const int pos = idx >> 5, i = idx & 31;
            const float inv = exp2f(-(float)(i & 15) * (13.287712379549449f / 16.0f));
            const float ang = (float)(i < 16 ? pos / 64 : pos % 64) * inv;
            cpx v; v.x = cosf(ang); v.y = sinf(ang); ROPE[idx] = v;
        } else {
            const int mt = task - N_TW - N_ROPE; const int l = mt / (3 * DM / 64), n0 = (mt % (3 * DM / 64)) * 64;
            float* sv = (float*)smem;
            float* red = sv + NJ * DM;
            __syncthreads();
            for (int i = tid; i < NJ * DM; i += NT) { const int j = i / DM, k = i % DM; const float v = j < NB ? p.in[I_C][j * DM + k] : p.in[I_CCTX][k]; sv[i] = siluf_(v); }
            __syncthreads();
            const int c4 = tid & 15, kg = tid >> 4; f32x4 acc[NJ];
#pragma unroll
            for (int j = 0; j < NJ; ++j) acc[j] = (f32x4){0.f, 0.f, 0.f, 0.f};
            const float* w = p.in[I_WADA] + (size_t)l * DM * 3 * DM + n0 + 4 * c4;
#pragma unroll 8
            for (int i = 0; i < DM / 32; ++i) { const int k = kg + 32 * i; const f32x4 wv = *(const f32x4*)(w + (size_t)k * 3 * DM);
#pragma unroll
                for (int j = 0; j < NJ; ++j) acc[j] = acc[j] + wv * sv[j * DM + k]; }
#pragma unroll
            for (int j = 0; j < NJ; ++j) *(f32x4*)(red + (kg * NJ + j) * 64 + 4 * c4) = acc[j];
            __syncthreads();
            for (int i = tid; i < NJ * 64; i += NT) { const int j = i / 64, n = i % 64; float s = 0.f;
#pragma unroll
                for (int k8 = 0; k8 < 32; ++k8) s += red[(k8 * NJ + j) * 64 + n];
                MOD[((size_t)l * NJ + j) * 3 * DM + n0 + n] = s + p.in[I_BADA][(size_t)l * 3 * DM + n0 + n]; }
        }
    }
}

#ifdef EMU
constexpr int PANEL_ROWS = 128, PANEL_UNITS = DM / 128;
#else
constexpr int PANEL_ROWS = 256, PANEL_UNITS = DM / 256;
#endif
__device__ __forceinline__ unsigned* unit_counter(const Params& p, int isctx) { return (unsigned*)(p.ws + WS_BAR + 16384) + 64 * isctx; }
__device__ __forceinline__ unsigned* stage_counter(const Params& p, int flag) { return (unsigned*)(p.ws + WS_BAR + 16384) + 512 + 512 * flag; }
__device__ __forceinline__ void stage_signal(const Params& p, char* smem, int flag, int l) {
#ifdef EMU
    __syncthreads(); if (otid() == 0) *stage_counter(p, flag) += 1u;
#else
    asm volatile("s_waitcnt vmcnt(0)" ::: "memory"); __syncthreads();
    if (threadIdx.x == 0) {
        const unsigned xcc = (unsigned)__builtin_amdgcn_s_getreg((3 << 11) | 20) & 0xFu, nloc = ((volatile __attribute__((address_space(3))) unsigned*)(smem + LDS_BYTES - 64))[0];
        unsigned* g = stage_counter(p, flag);
        if (nloc > 0u) { const unsigned old = __hip_atomic_fetch_add(g + 16 * (1 + xcc), 1u, __ATOMIC_RELAXED, __HIP_MEMORY_SCOPE_AGENT);
            if (old + 1u == nloc * (unsigned)(l + 1)) { __builtin_amdgcn_fence(__ATOMIC_RELEASE, "agent"); asm volatile("s_waitcnt vmcnt(0)" ::: "memory");
                __hip_atomic_fetch_add(g, nloc, __ATOMIC_RELAXED, __HIP_MEMORY_SCOPE_AGENT); } }
        else { __builtin_amdgcn_fence(__ATOMIC_RELEASE, "agent"); asm volatile("s_waitcnt vmcnt(0)" ::: "memory"); __hip_atomic_fetch_add(g, 1u, __ATOMIC_RELAXED, __HIP_MEMORY_SCOPE_AGENT); }
    }
#endif
}
__device__ __forceinline__ void stage_wait(const Params& p, int flag, int l) {
    if (otid() == 0) { const unsigned target = (unsigned)gridDim.x * (unsigned)(l + 1);
#ifdef EMU
        while (*(volatile unsigned*)stage_counter(p, flag) < target) emu::yield();
#else
        unsigned spins = 0;
        while (__hip_atomic_load(stage_counter(p, flag), __ATOMIC_RELAXED, __HIP_MEMORY_SCOPE_AGENT) < target) { __builtin_amdgcn_s_sleep(16); if (++spins > (1u << 20)) break; }
        __builtin_amdgcn_fence(__ATOMIC_ACQUIRE, "agent"); asm volatile("s_waitcnt vmcnt(0)" ::: "memory");
#endif
    }
    __syncthreads();
}
__device__ __forceinline__ int logical_row(int i) { return i < NB * SEQ ? (i / SEQ) * TOK + CTXL + i % SEQ : ((i - NB * SEQ) / CTXL) * TOK + (i - NB * SEQ) % CTXL; }
struct RowRef { const float* xo; float* xn; int mj, row; bool ok; };
__device__ __forceinline__ RowRef rp_ref(const Params& p, int l, int li, int base, int hi) {
    RowRef r; r.ok = li < hi; const int rr = logical_row(r.ok ? li : base); r.row = rr;
    const int b = rr / TOK, pp = rr % TOK; const bool isctx = pp < CTXL; if (l == DEPTH && isctx) r.ok = false;
    const size_t off = isctx ? ((size_t)b * CTXL + pp) * DM : ((size_t)b * SEQ + (pp - CTXL)) * DM;
    float* CTXB = (float*)(p.ws + WS_CTXB);
    r.xo = (l <= 1) ? (isctx ? p.in[I_CTX] + off : p.in[I_X] + off) : (isctx ? CTXB + off : p.out + off);
    r.xn = isctx ? CTXB + off : p.out + off; r.mj = isctx ? NB : b; return r;
}
__device__ __forceinline__ void rp_rows(const Params& p, int l, int lo, int hi, int gi, int nb) {
    const int tid = otid(), lane = tid & 63, wave = tid >> 6;
    const float* MOD = (const float*)(p.ws + WS_MOD);
    const bf16* YO = (const bf16*)(p.ws + WS_P);
    bf16* HN = (bf16*)(p.ws + WS_HNY);
    constexpr int NV4 = DM / 256, RW = 2;
    const int stride = nb * 8;
    f32x4 xq[RW][NV4]; u32x2 yq[RW][NV4]; RowRef rq[RW];
    int base = lo + gi * 8 + wave;
    if (base < hi) {
#pragma unroll
        for (int i = 0; i < RW; ++i) { rq[i] = rp_ref(p, l, base + i * stride, base, hi);
#pragma unroll
            for (int j = 0; j < NV4; ++j) { xq[i][j] = *(const f32x4*)(rq[i].xo + 4 * lane + 256 * j); yq[i][j] = (l > 0) ? *(const u32x2*)(YO + (size_t)rq[i].row * DM + 4 * lane + 256 * j) : (u32x2){0u, 0u}; } }
    }
    for (; base < hi; base += stride * RW) {
        f32x4 x[RW][NV4], y[RW][NV4]; RowRef rc[RW];
#pragma unroll
        for (int i = 0; i < RW; ++i) { rc[i] = rq[i];
#pragma unroll
            for (int j = 0; j < NV4; ++j) { x[i][j] = xq[i][j]; const u32x2 yy = yq[i][j]; y[i][j] = (f32x4){bitsf(yy.x << 16), bitsf(yy.x & 0xffff0000u), bitsf(yy.y << 16), bitsf(yy.y & 0xffff0000u)}; } }
        { const int nbase = base + stride * RW;
            if (nbase < hi) {
#pragma unroll
                for (int i = 0; i < RW; ++i) { rq[i] = rp_ref(p, l, nbase + i * stride, nbase, hi);
#pragma unroll
                    for (int j = 0; j < NV4; ++j) { xq[i][j] = *(const f32x4*)(rq[i].xo + 4 * lane + 256 * j); if (l > 0) yq[i][j] = *(const u32x2*)(YO + (size_t)rq[i].row * DM + 4 * lane + 256 * j); } } } }
        if (l > 0) {
            float ss[RW];
#pragma unroll
            for (int i = 0; i < RW; ++i) { ss[i] = 0.f;
#pragma unroll
                for (int j = 0; j < NV4; ++j) ss[i] += y[i][j].x * y[i][j].x + y[i][j].y * y[i][j].y + y[i][j].z * y[i][j].z + y[i][j].w * y[i][j].w; }
#pragma unroll
            for (int i = 0; i < RW; ++i) ss[i] = wave_sum(ss[i]);
            const float* gp = p.in[I_GPOST] + (size_t)(l - 1) * DM;
#pragma unroll
            for (int i = 0; i < RW; ++i) { const float rstd = rsqrtf(ss[i] * (1.0f / DM) + EPS); const float* gt = MOD + ((size_t)(l - 1) * NJ + rc[i].mj) * 3 * DM + 2 * DM;
#pragma unroll
                for (int j = 0; j < NV4; ++j) { const f32x4 g4 = *(const f32x4*)(gt + 4 * lane + 256 * j), p4 = *(const f32x4*)(gp + 4 * lane + 256 * j);
                    x[i][j] = x[i][j] + g4 * (y[i][j] * rstd * p4);
                    if (rc[i].ok) *(f32x4*)(rc[i].xn + 4 * lane + 256 * j) = x[i][j]; } }
        }
        if (l < DEPTH) {
            float ss[RW];
#pragma unroll
            for (int i = 0; i < RW; ++i) { ss[i] = 0.f;
#pragma unroll
                for (int j = 0; j < NV4; ++j) ss[i] += x[i][j].x * x[i][j].x + x[i][j].y * x[i][j].y + x[i][j].z * x[i][j].z + x[i][j].w * x[i][j].w; }
#pragma unroll
            for (int i = 0; i < RW; ++i) ss[i] = wave_sum(ss[i]);
            const float* gp = p.in[I_GPRE] + (size_t)l * DM;
#pragma unroll
            for (int i = 0; i < RW; ++i) { const float rstd = rsqrtf(ss[i] * (1.0f / DM) + EPS); const float* md = MOD + ((size_t)l * NJ + rc[i].mj) * 3 * DM; const int row = rc[i].row;
#pragma unroll
                for (int j = 0; j < NV4; ++j) { const int e = 4 * lane + 256 * j;
                    const f32x4 g4 = *(const f32x4*)(gp + e), sh = *(const f32x4*)(md + e), sc = *(const f32x4*)(md + DM + e);
                    const f32x4 h = (x[i][j] * rstd * g4) * (sc + 1.0f) + sh;
                    u32x2 o; o.x = pk2(h.x, h.y); o.y = pk2(h.z, h.w);
                    if (rc[i].ok) *(u32x2*)(HN + (size_t)row * DM + e) = o; } }
        }
    }
}

__device__ __forceinline__ void convert_tile(const float* src, int ldn, bf16* dst, int K, int n0, int k0, bool use_map, char* smem) {
    const int tid = otid();
    float* tile = (float*)smem;
    __syncthreads();
#pragma unroll
    for (int i = 0; i < 8; ++i) { const int idx = tid + NT * i, k = idx >> 6, n = idx & 63;
        const int oc = use_map ? orig_col(n0 + n) : (n0 + n);
        tile[k * 65 + n] = oc >= 0 ? src[(size_t)(k0 + k) * ldn + oc] : 0.f; }
    __syncthreads();
    const int n = tid >> 3, c = tid & 7;
    u32x4 o; o.x = pk2(tile[(8 * c + 0) * 65 + n], tile[(8 * c + 1) * 65 + n]); o.y = pk2(tile[(8 * c + 2) * 65 + n], tile[(8 * c + 3) * 65 + n]);
    o.z = pk2(tile[(8 * c + 4) * 65 + n], tile[(8 * c + 5) * 65 + n]); o.w = pk2(tile[(8 * c + 6) * 65 + n], tile[(8 * c + 7) * 65 + n]);
    *(u32x4*)(dst + (size_t)(n0 + n) * K + k0 + 8 * c) = o;
}

__device__ __forceinline__ void filter_task(const Params& p, int l, int L, int pos0, char* smem) {
    const int tid = otid(), j = tid & 63;
    float* z = (float*)smem;
    float* h1 = z + 8 * 33;
    float* h2 = h1 + 8 * 64;
    const float* w1 = p.in[I_HW1] + (size_t)l * 33 * 64; const float* w2 = p.in[I_HW2] + (size_t)l * 64 * 64; const float* w3 = p.in[I_HW3] + (size_t)l * 64 * 512;
    float r1[33], r2[64], r3a[16];
#pragma unroll
    for (int i = 0; i < 33; ++i) r1[i] = w1[i * 64 + j];
#pragma unroll
    for (int i = 0; i < 64; ++i) r2[i] = w2[i * 64 + j];
    const float b1 = p.in[I_HB1][l * 64 + j], b2 = p.in[I_HB2][l * 64 + j], b3 = p.in[I_HB3][l * 512 + tid];
    const float f0 = p.in[I_HFREQ][(l * 2 + 0) * 64 + j], f1 = p.in[I_HFREQ][(l * 2 + 1) * 64 + j];
    __syncthreads();
    if (tid < 8 * 33) { const int pp = tid / 33, i = tid % 33; const float pos = (float)(pos0 + pp);
        const float t = pos / (float)(L - 1 > 1 ? L - 1 : 1), wv = 6.283185307179586f * pos / (float)L; float v;
        if (i == 0) v = t; else { const int bi = (i - 1) & 15; const float f = 1e-4f + (float)bi * ((15.0f - 1e-4f) / 15.0f); v = (i <= 16) ? cosf(wv * f) : -sinf(wv * f); }
        z[tid] = v; }
    __syncthreads();
    { const int pp = tid >> 6; float a = b1;
#pragma unroll
        for (int i = 0; i < 33; ++i) a += z[pp * 33 + i] * r1[i];
        h1[tid] = sinf(f0 * a);
#pragma unroll
        for (int i = 0; i < 16; ++i) r3a[i] = w3[i * 512 + tid]; }
    __syncthreads();
    { const int pp = tid >> 6; float a = b2;
#pragma unroll
        for (int i = 0; i < 64; ++i) a += h1[pp * 64 + i] * r2[i];
        h2[tid] = sinf(f1 * a); }
    __syncthreads();
    { const int o = tid, dir = o >> 8, c = o & 255;
        const float delta = 3.0701134573253946f + (float)c * ((15.350567286626973f - 3.0701134573253946f) / 255.0f);
        float acc[8];
#pragma unroll
        for (int pp = 0; pp < 8; ++pp) acc[pp] = b3;
#pragma unroll 1
        for (int cix = 0; cix < 4; ++cix) {
            float wn[16];
#pragma unroll
            for (int i = 0; i < 16; ++i) wn[i] = (cix < 3) ? w3[(16 * (cix + 1) + i) * 512 + o] : 0.f;
#pragma unroll
            for (int i = 0; i < 16; ++i) {
#pragma unroll
                for (int pp = 0; pp < 8; ++pp) acc[pp] += h2[pp * 64 + 16 * cix + i] * r3a[i]; }
#pragma unroll
            for (int i = 0; i < 16; ++i) r3a[i] = wn[i]; }
        float* KT = (float*)(p.ws + WS_KT); float* HC = (float*)(p.ws + WS_HC);
#pragma unroll
        for (int pp = 0; pp < 8; ++pp) { const int pos = pos0 + pp; const float t = (float)pos / (float)(L - 1 > 1 ? L - 1 : 1);
            const float v = acc[pp] * __expf(-t * delta);
            if (L == SEQ) { if (dir == 0) KT[(size_t)c * NF + pos]= v; else if (pos > 0) KT[(size_t)c * NF + (NF - pos)] = v; else KT[(size_t)c * NF + SEQ] = 0.f; }
            else HC[((size_t)dir * WG + c) * CTXL + pos] = v; }
    }
}

__device__ __forceinline__ void convert_tile_w(const float* src, int ldn, bf16* dst, int K, int n0, int k0, bool use_map, char* wl, int lane) {
    float* tile = (float*)wl;
    const int oc = use_map ? orig_col(n0 + lane) : (n0 + lane);
    float v[64];
#pragma unroll
    for (int k = 0; k < 64; ++k) v[k] = oc >= 0 ? src[(size_t)(k0 + k) * ldn + oc] : 0.f;
#pragma unroll
    for (int k = 0; k < 64; ++k) tile[k * 65 + lane] = v[k];
    WAVE_SYNC();
#pragma unroll
    for (int i = 0; i < 8; ++i) { const int n = (lane >> 3) + 8 * i, c = lane & 7; float f[8];
#pragma unroll
        for (int j = 0; j < 8; ++j) f[j] = tile[(8 * c + j) * 65 + n];
        *(u32x4*)(dst + (size_t)(n0 + n) * K + k0 + 8 * c) = pack8(f); }
    WAVE_SYNC();
}
__device__ __forceinline__ void layer_prep(const Params& p, int l, int idx, int stride, char* smem) {
    constexpr int N_WIN = (NPAD / 64) * (DM / 64), N_FL = SEQ / 8, N_FC = CTXL / 8;
    for (int task = idx; task < N_FL + N_FC; task += stride) {
        if (task < N_FL) filter_task(p, l, SEQ, task * 8, smem);
        else filter_task(p, l, CTXL, (task - N_FL) * 8, smem);
    }
    __syncthreads();
    { const int tid = otid(), lane = tid & 63, wave = __builtin_amdgcn_readfirstlane(tid >> 6);
        char* wl = smem + wave * WLDS;
        for (int task = wave * stride + idx; task < N_WIN; task += 8 * stride) { const int nt = task / (DM / 64), kt = task % (DM / 64);
            convert_tile_w(p.in[I_WIN] + (size_t)l * DM * N_IN, N_IN, (bf16*)(p.ws + WS_WIN), DM, nt * 64, kt * 64, true, wl, lane); } }
}
__device__ __forceinline__ unsigned* row_queue(const Params& p, int l) { return (unsigned*)(p.ws + WS_BAR + 16384) + 2560 + 64 * l; }
__device__ __forceinline__ void wait_units(const Params& p, int c, int l) {
    constexpr int nLatU = NB * (SEQ / PANEL_ROWS) * PANEL_UNITS, nCtxU = NB * (CTXL / PANEL_ROWS) * PANEL_UNITS;
    const unsigned target = (unsigned)((c ? nCtxU : nLatU) * l);
#ifdef EMU
    while (*(volatile unsigned*)unit_counter(p, c) < target) emu::yield();
#else
    unsigned spins = 0;
    while (__hip_atomic_load(unit_counter(p, c), __ATOMIC_RELAXED, __HIP_MEMORY_SCOPE_AGENT) < target) { __builtin_amdgcn_s_sleep(16); if (++spins > (1u << 20)) break; }
    __builtin_amdgcn_fence(__ATOMIC_ACQUIRE, "agent"); asm volatile("s_waitcnt vmcnt(0)" ::: "memory");
#endif
}
__device__ __forceinline__ void phase_rp(const Params& p, int l, char* smem) { const int G = (int)gridDim.x, bid = obid(), tid = otid();
    const bool has_ctx = l < DEPTH;
    constexpr int nLatU = NB * (SEQ / PANEL_ROWS) * PANEL_UNITS, nCtxU = NB * (CTXL / PANEL_ROWS) * PANEL_UNITS;
    const int nU = nLatU + nCtxU;
    const int heavy = (l >= 1 && has_ctx && nU > G && (nU % G) != 0) ? nU % G : 0;
    const int total = heavy > 0 ? NB * SEQ : (has_ctx ? T : NB * SEQ);
    const int nl = G - heavy, np = (l < DEPTH) ? nl / 2 : 0, nr = nl - np;
    int lo, hi, gi, nb; bool prep = false;
    if (bid < heavy) { lo = NB * SEQ; hi = T; gi = bid; nb = heavy; }
    else { const int i = bid - heavy; int nR = total;
        if (np > 0) { nR = ((total * 2 / 3) / (nr * 16)) * (nr * 16); if (nR <= 0) nR = total / 2; }
        if (np > 0 && (i & 1) && i / 2 < np) { prep = true; lo = nR; hi = total; gi = i / 2; nb = np; }
        else { lo = 0; hi = nR; gi = (np > 0) ? (i + 1) / 2 : i; nb = nr; } }
    if (prep) layer_prep(p, l, gi, np, smem);
    else if (l < DEPTH && np == 0) layer_prep(p, l, bid, G, smem);
    if (l >= 1) { if (tid == 0) { if (lo < NB * SEQ) wait_units(p, 0, l); if (hi > NB * SEQ) wait_units(p, 1, l); } __syncthreads(); }
    rp_rows(p, l, lo, hi, gi, nb);
}

__device__ __forceinline__ cpx cmul(cpx a, cpx b) { cpx r; r.x = a.x * b.x - a.y * b.y; r.y = a.x * b.y + a.y * b.x; return r; }
__device__ __forceinline__ cpx cmulc(cpx a, cpx b) { cpx r; r.x = a.x * b.x + a.y * b.y; r.y = a.y * b.x - a.x * b.y; return r; }
constexpr int fpad(int i) { return i + (i >> 4); }
__device__ __forceinline__ int FPH(int i) { return i + (i >> 4); }
constexpr int FBUF = fpad(NF);
constexpr int ilog16(int n) { return n < 16 ? 0 : 1 + ilog16(n / 16); }
constexpr int FFT_P16 = ilog16(NF);
constexpr bool FFT_R4 = ((NF >> (4 * FFT_P16)) == 4);
static_assert((NF >> (4 * FFT_P16)) == 1 || (NF >> (4 * FFT_P16)) == 4, "NF = 16^a * (1 or 4)");
template <bool INV> __device__ __forceinline__ void dft4(cpx& a0, cpx& a1, cpx& a2, cpx& a3) {
    const cpx s = {a0.x + a2.x, a0.y + a2.y}, b = {a0.x - a2.x, a0.y - a2.y}, c = {a1.x + a3.x, a1.y + a3.y}, d = {a1.x - a3.x, a1.y - a3.y};
    a0 = (cpx){s.x + c.x, s.y + c.y}; a2 = (cpx){s.x - c.x, s.y - c.y};
    if (!INV) { a1 = (cpx){b.x + d.y, b.y - d.x}; a3 = (cpx){b.x - d.y, b.y + d.x}; }
    else      { a1 = (cpx){b.x - d.y, b.y + d.x}; a3 = (cpx){b.x + d.y, b.y - d.x}; }
}
template <bool INV> __device__ __forceinline__ cpx cmulk(cpx a, float wr, float wi) {
    cpx r; if (!INV) { r.x = a.x * wr + a.y * wi; r.y = a.y * wr - a.x * wi; } else { r.x = a.x * wr - a.y * wi; r.y = a.y * wr + a.x * wi; } return r;
}
template <bool INV> __device__ __forceinline__ void dft16(cpx (&x)[16]) {
    constexpr float C1 = 0.92387953251128674f, S1 = 0.38268343236508977f, C2 = 0.70710678118654752f;
#pragma unroll
    for (int n2 = 0; n2 < 4; ++n2) dft4<INV>(x[n2], x[4 + n2], x[8 + n2], x[12 + n2]);
    x[4 * 1 + 1] = cmulk<INV>(x[4 * 1 + 1], C1, S1); x[4 * 1 + 2] = cmulk<INV>(x[4 * 1 + 2], C2, C2); x[4 * 1 + 3] = cmulk<INV>(x[4 * 1 + 3], S1, C1);
    x[4 * 2 + 1] = cmulk<INV>(x[4 * 2 + 1], C2, C2); x[4 * 2 + 2] = cmulk<INV>(x[4 * 2 + 2], 0.f, 1.f); x[4 * 2 + 3] = cmulk<INV>(x[4 * 2 + 3], -C2, C2);
    x[4 * 3 + 1] = cmulk<INV>(x[4 * 3 + 1], S1, C1); x[4 * 3 + 2] = cmulk<INV>(x[4 * 3 + 2], -C2, C2); x[4 * 3 + 3] = cmulk<INV>(x[4 * 3 + 3], -C1, -S1);
#pragma unroll
    for (int k1 = 0; k1 < 4; ++k1) dft4<INV>(x[4 * k1 + 0], x[4 * k1 + 1], x[4 * k1 + 2], x[4 * k1 + 3]);
    cpx t;
    t = x[1]; x[1] = x[4]; x[4] = t; t = x[2]; x[2] = x[8]; x[8] = t; t = x[3]; x[3] = x[12]; x[12] = t;
    t = x[6]; x[6] = x[9]; x[9] = t; t = x[7]; x[7] = x[13]; x[13] = t; t = x[11]; x[11] = x[14]; x[14] = t;
}
template <bool INV> __device__ __forceinline__ void fft_stage16(cpx* buf, const cpx* TW, int tl, int M) {
    const int span = M >> 4, twm = NF / M;
#pragma unroll 1
    for (int j = tl; j < NF / 16; j += 256) {
        const int grp = j / span, pos = j % span, base = grp * M + pos; cpx x[16];
#pragma unroll
        for (int q = 0; q < 16; ++q) x[q] = buf[FPH(base + q * span)];
        cpx w1 = {1.f, 0.f}; if (span > 1) w1 = TW[pos * twm];
        if (INV && span > 1) { cpx wk = w1;
#pragma unroll
            for (int k = 1; k < 16; ++k) { x[k] = cmulc(x[k], wk); wk = cmul(wk, w1); } }
        dft16<INV>(x);
        if (!INV && span > 1) { cpx wk = w1;
#pragma unroll
            for (int k = 1; k < 16; ++k) { x[k] = cmul(x[k], wk); wk = cmul(wk, w1); } }
#pragma unroll
        for (int q = 0; q < 16; ++q) buf[FPH(base + q * span)] = x[q];
    }
}
template <bool INV> __device__ __forceinline__ void fft_stage4_last(cpx* buf, int tl) {
#pragma unroll 1
    for (int j = tl; j < NF / 4; j += 256) { cpx a0 = buf[FPH(4 * j)], a1 = buf[FPH(4 * j + 1)], a2 = buf[FPH(4 * j + 2)], a3 = buf[FPH(4 * j + 3)];
        dft4<INV>(a0, a1, a2, a3); buf[FPH(4 * j)] = a0; buf[FPH(4 * j + 1)] = a1; buf[FPH(4 * j + 2)] = a2; buf[FPH(4 * j + 3)] = a3; }
}
__device__ __forceinline__ void fft_fwd(cpx* buf, const cpx* TW, int tl) {
    int M = NF;
#pragma unroll
    for (int s = 0; s < FFT_P16; ++s) { __syncthreads(); fft_stage16<false>(buf, TW, tl, M); M >>= 4; }
    if (FFT_R4) { __syncthreads(); fft_stage4_last<false>(buf, tl); }
    __syncthreads();
}
__device__ __forceinline__ void fft_inv(cpx* buf, const cpx* TW, int tl) {
    if (FFT_R4) { __syncthreads(); fft_stage4_last<true>(buf, tl); }
    int M = FFT_R4 ? 64 : 16;
#pragma unroll
    for (int s = 0; s < FFT_P16; ++s) { __syncthreads(); fft_stage16<true>(buf, TW, tl, M); M <<= 4; }
    __syncthreads();
}
__device__ __forceinline__ void filt_fft_task(const Params& p, int cp, char* smem) {
    const int tid = otid(), half = tid >> 8, tl = tid & 255, c = 2 * cp + half;
    cpx* buf = (cpx*)smem + (size_t)half * FBUF;
    const float* KT = (const float*)(p.ws + WS_KT) + (size_t)c * NF;
    cpx* KF = (cpx*)(p.ws + WS_KF) + (size_t)c * NF;
    const cpx* TW = (const cpx*)(p.ws + WS_TW);
    __syncthreads();
    for (int i = tl; i < NF; i += 256) { cpx v; v.x = KT[i]; v.y = 0.f; buf[FPH(i)] = v; }
    fft_fwd(buf, TW, tl);
    for (int i = tl; i < NF; i += 256) KF[i] = buf[FPH(i)];
}

__device__ __forceinline__ void gemm_tile(const Params& p, const bf16* A, const bf16* Bt, int K, int mt, int nt, int mode, char* smem) {
    const int tid = otid(), lane = tid & 63, wave = tid >> 6;
    bf16* As = (bf16*)smem;
    bf16* Bs = As + 128 * LS;
    const int wm = (wave & 3) * 32, wn = (wave >> 2) * 64;
    f32x4 acc[2][4];
#pragma unroll
    for (int i = 0; i < 2; ++i)
#pragma unroll
        for (int j = 0; j < 4; ++j) acc[i][j] = (f32x4){0.f, 0.f, 0.f, 0.f};
    const int lr = tid >> 3, lc = tid & 7;
    const bf16* Ag = A + (size_t)(mt * 128 + lr) * K + lc * 8;
    const bf16* Bg = Bt + (size_t)(nt * 128 + lr) * K + lc * 8;
    u32x4 ra0, ra1, rb0, rb1;
    ra0 = *(const u32x4*)(Ag); ra1 = *(const u32x4*)(Ag + (size_t)64 * K); rb0 = *(const u32x4*)(Bg); rb1 = *(const u32x4*)(Bg + (size_t)64 * K);
    const int nk = K / 64;
    for (int kt = 0; kt < nk; ++kt) {
        __syncthreads();
        *(u32x4*)(As + lr * LS + lc * 8) = ra0; *(u32x4*)(As + (lr + 64) * LS + lc * 8) = ra1;
        *(u32x4*)(Bs + lr * LS + lc * 8) = rb0; *(u32x4*)(Bs + (lr + 64) * LS + lc * 8) = rb1;
        __syncthreads();
        if (kt + 1 < nk) { const int ko = (kt + 1) * 64;
            ra0 = *(const u32x4*)(Ag + ko); ra1 = *(const u32x4*)(Ag + (size_t)64 * K + ko); rb0 = *(const u32x4*)(Bg + ko); rb1 = *(const u32x4*)(Bg + (size_t)64 * K + ko); }
        mma_nt<4, 2>(As, LS, wm, Bs, LS, wn, acc[0], lane);
        mma_nt<4, 2>(As, LS, wm + 16, Bs, LS, wn, acc[1], lane);
    }
    const int r = lane & 15, q = lane >> 4;
#pragma unroll
    for (int i = 0; i < 2; ++i)
#pragma unroll
        for (int j = 0; j < 4; ++j)
#pragma unroll
            for (int e = 0; e < 4; ++e) {
                const int row = mt * 128 + wm + 16 * i + 4 * q + e, col = nt * 128 + wn + 16 * j + r; const float v = acc[i][j][e];
                if (mode == 0) { if (col < NP) ((bf16*)(p.ws + WS_P))[(size_t)row * NP + col] = f2bf(v); else if (col < NP + 16) ((float*)(p.ws + WS_G))[(size_t)row * NGS + (col - NP)] = v; else if (col < NP + NG) ((bf16*)((float*)(p.ws + WS_G) + (size_t)row * NGS + 16))[col - NP - 16] = f2bf(v); }
                else if (mode == 2) ((bf16*)(p.ws + WS_HT))[(size_t)row * T + col] = f2bf(v);
                else ((bf16*)(p.ws + WS_P))[(size_t)row * DM + col] = f2bf(v);
            }
}

#ifndef EMU
namespace pg8 {
#define PG8_LAS __attribute__((address_space(3)))
typedef unsigned short bf16_t;
typedef short bf16x8 __attribute__((ext_vector_type(8)));
typedef float f32x4 __attribute__((ext_vector_type(4)));
typedef unsigned u32x4 __attribute__((ext_vector_type(4)));
constexpr int BM = 256, BK = 64, HALF = 128, HTB = HALF * BK * 2  , STAGE_BYTES = 8 * HTB, NXCD = 8, WGM = 8;

__host__ __device__ __forceinline__ int lds_byte(int r, int c) { const int st = (r >> 4) * 2 + (c >> 5), rr = r & 15, cc = c & 31, ob = rr * 64 + cc * 2; return st * 1024 + (ob ^ (((ob >> 9) & 1) << 5)); }
__host__ __device__ __forceinline__ void stage_rc(int b, int& R, int& C) { const int st = b / 1024, sb = b % 1024, swz = sb ^ (((sb >> 9) & 1) << 5); R = (st >> 1) * 16 + swz / 64; C = (st & 1) * 32 + (swz % 64) / 2; }
__host__ __device__ __forceinline__ int perm32(int rho) { const int n = rho >> 4, i = rho & 15; return 8 * (i >> 2) + 4 * n + (i & 3); }

struct Unit { int pm, pn; };
struct Gemm { const bf16_t* A; const bf16_t* Bt; int M, N, K; };
__device__ __forceinline__ unsigned cvt_pk_bf16(float lo, float hi) { unsigned r; asm volatile("v_cvt_pk_bf16_f32 %0, %1, %2" : "=v"(r) : "v"(lo), "v"(hi)); return r; }
template <class Epi, class Sched, bool ALIGN_EPI = false, bool SP2 = false>
__device__ __forceinline__ void gemm_phase(PG8_LAS unsigned char* lds, const Gemm g, const Sched& S, const Epi& E) {
    const int tid = otid(), wid = __builtin_amdgcn_readfirstlane(tid >> 6), lane = tid & 63, wr = wid >> 2, wc = wid & 3, fr = lane & 15, fq = lane >> 4;
    const int K = g.K, nt = K / BK;
    unsigned voffA[2], voffB[2];
#pragma unroll
    for (int i = 0; i < 2; ++i) { int R, C; stage_rc(tid * 16 + i * 8192, R, C); const int Rb = Epi::PERM ? ((R & ~31) + perm32(R & 31)) : R;
        voffA[i] = (unsigned)(R * K + C) * 2u; voffB[i] = (unsigned)(Rb * K + C) * 2u; }
    const size_t kstep = (size_t)(BK * 2);
    const size_t hstep = (size_t)HALF * K * 2;
    const size_t tstep = 2 * hstep;
    const unsigned ldsw = (unsigned)wid * 1024u;
    const int aoff = lds_byte(wr * 64 + fr, fq * 8), boff = lds_byte(wc * 32 + fr, fq * 8);
#define PG8_SA(b, h) (((b) * 2 + (h)) * HTB)
#define PG8_SB(b, h) ((4 + (b) * 2 + (h)) * HTB)
#define PG8_STAGE(bufoff, gbase, voff) do { _Pragma("unroll") for (int _i = 0; _i < 2; ++_i) \
        __builtin_amdgcn_global_load_lds((const unsigned*)((const char*)(gbase) + (voff)[_i]), (PG8_LAS unsigned*)(lds + (bufoff) + ldsw + _i * 8192), 16, 0, 0); } while (0)
#define PG8_LDA(dst, b, h) do { _Pragma("unroll") for (int m = 0; m < 4; ++m) _Pragma("unroll") for (int k = 0; k < 2; ++k) dst[m][k] = *(const PG8_LAS bf16x8*)(lds + PG8_SA(b, h) + aoff + m * 2048 + k * 1024); } while (0)
#define PG8_LDB(dst, b, h) do { _Pragma("unroll") for (int n = 0; n < 2; ++n) _Pragma("unroll") for (int k = 0; k < 2; ++k) dst[n][k] = *(const PG8_LAS bf16x8*)(lds + PG8_SB(b, h) + boff + n * 2048 + k * 1024); } while (0)
#define PG8_MMA(ai, bj, At, Bt) do { __builtin_amdgcn_s_setprio(1); _Pragma("unroll") for (int m = 0; m < 4; ++m) _Pragma("unroll") for (int n = 0; n < 2; ++n) _Pragma("unroll") for (int k = 0; k < 2; ++k) \
        acc[ai][bj][m][n] = __builtin_amdgcn_mfma_f32_16x16x32_bf16(Bt[n][k], At[m][k], acc[ai][bj][m][n], 0, 0, 0); __builtin_amdgcn_s_setprio(0); } while (0)
#define PG8_WAIT_V(n) asm volatile("s_waitcnt vmcnt(" #n ")" ::: "memory")
#define PG8_WAIT_L(n) asm volatile("s_waitcnt lgkmcnt(" #n ")" ::: "memory")
#define PG8_BAR __builtin_amdgcn_s_barrier()
#define PG8_SCHED __builtin_amdgcn_sched_barrier(0)
    Unit cur, nxt; int ui = 0;
    if (!S.next(0, cur)) return;
    f32x4 acc[2][2][4][2];
#pragma unroll
    for (int a = 0; a < 2; ++a)
#pragma unroll
        for (int b = 0; b < 2; ++b)
#pragma unroll
            for (int m = 0; m < 4; ++m)
#pragma unroll
                for (int n = 0; n < 2; ++n) acc[a][b][m][n] = (f32x4){0.f, 0.f, 0.f, 0.f};
    bf16x8 At[4][2], B0[2][2], B1[2][2];
    const char* cA = (const char*)g.A + (size_t)cur.pm * tstep; const char* cB = (const char*)g.Bt + (size_t)cur.pn * tstep;
    S.a_ready(cur);
    if constexpr (SP2) {
        PG8_STAGE(PG8_SB(0, 0), cB, voffB); PG8_STAGE(PG8_SB(0, 1), cB + hstep, voffB); PG8_STAGE(PG8_SA(0, 0), cA, voffA); PG8_STAGE(PG8_SA(0, 1), cA + hstep, voffA);
        if (wr == 1) PG8_BAR;
        PG8_WAIT_V(2); PG8_BAR;
        PG8_STAGE(PG8_SB(1, 0), cB + kstep, voffB); PG8_STAGE(PG8_SA(1, 0), cA + kstep, voffA); PG8_STAGE(PG8_SB(1, 1), cB + hstep + kstep, voffB);
        PG8_WAIT_V(6); PG8_BAR;
    } else {
        PG8_STAGE(PG8_SB(0, 0), cB, voffB); PG8_STAGE(PG8_SA(0, 0), cA, voffA); PG8_STAGE(PG8_SB(0, 1), cB + hstep, voffB); PG8_STAGE(PG8_SA(0, 1), cA + hstep, voffA);
        if (wr == 1) PG8_BAR;
        PG8_WAIT_V(4); PG8_BAR;
        PG8_STAGE(PG8_SB(1, 0), cB + kstep, voffB); PG8_STAGE(PG8_SA(1, 0), cA + kstep, voffA); PG8_STAGE(PG8_SB(1, 1), cB + hstep + kstep, voffB);
        PG8_WAIT_V(6); PG8_BAR;
    }
    for (;;) {
        const bool has_next = S.next(ui + 1, nxt);
        const char* nA = has_next ? (const char*)g.A + (size_t)nxt.pm * tstep : cA; const char* nB = has_next ? (const char*)g.Bt + (size_t)nxt.pn * tstep : cB;
        for (int t = 0; t < nt; t += 2) {
            const bool last = (t == nt - 2);
            const char* a1 = cA + (size_t)(t + 1) * kstep;
            const char* a2 = last ? nA : cA + (size_t)(t + 2) * kstep; const char* b2 = last ? nB : cB + (size_t)(t + 2) * kstep;
            const char* a3 = a2 + kstep; const char* b3 = b2 + kstep;
            if (last && has_next) S.a_ready(nxt);
            if constexpr (SP2) {
            PG8_LDB(B0, 0, 0); PG8_LDB(B1, 0, 1); PG8_SCHED; PG8_LDA(At, 0, 0); PG8_STAGE(PG8_SA(1, 1), a1 + hstep, voffA);
            PG8_WAIT_V(8); PG8_WAIT_L(0); PG8_BAR; PG8_MMA(0, 0, At, B0); PG8_MMA(0, 1, At, B1); PG8_BAR; PG8_SCHED;
            PG8_LDA(At, 0, 1); PG8_STAGE(PG8_SB(0, 0), b2, voffB); PG8_STAGE(PG8_SB(0, 1), b2 + hstep, voffB); PG8_STAGE(PG8_SA(0, 0), a2, voffA);
            PG8_WAIT_V(8); PG8_WAIT_L(0); PG8_BAR; PG8_MMA(1, 0, At, B0); PG8_MMA(1, 1, At, B1); PG8_BAR; PG8_SCHED;
            PG8_LDB(B0, 1, 0); PG8_LDB(B1, 1, 1); PG8_SCHED; PG8_LDA(At, 1, 0); PG8_STAGE(PG8_SA(0, 1), a2 + hstep, voffA);
            PG8_WAIT_V(8); PG8_WAIT_L(0); PG8_BAR; PG8_MMA(0, 0, At, B0); PG8_MMA(0, 1, At, B1); PG8_BAR; PG8_SCHED;
            PG8_LDA(At, 1, 1); PG8_STAGE(PG8_SB(1, 0), b3, voffB); PG8_STAGE(PG8_SB(1, 1), b3 + hstep, voffB); PG8_STAGE(PG8_SA(1, 0), a3, voffA);
            PG8_WAIT_V(8); PG8_WAIT_L(0); PG8_BAR; PG8_MMA(1, 0, At, B0); PG8_MMA(1, 1, At, B1); PG8_BAR; PG8_SCHED;
            } else {
            PG8_LDB(B0, 0, 0); PG8_SCHED; PG8_LDA(At, 0, 0); PG8_STAGE(PG8_SA(1, 1), a1 + hstep, voffA);
            PG8_WAIT_L(8); PG8_BAR; PG8_WAIT_L(0); PG8_MMA(0, 0, At, B0); PG8_BAR; PG8_SCHED;
            PG8_LDB(B1, 0, 1); PG8_STAGE(PG8_SB(0, 0), b2, voffB);
            PG8_BAR; PG8_WAIT_L(0); PG8_MMA(0, 1, At, B1); PG8_BAR;
            PG8_LDA(At, 0, 1); PG8_STAGE(PG8_SA(0, 0), a2, voffA);
            PG8_BAR; PG8_WAIT_L(0); PG8_MMA(1, 0, At, B0); PG8_BAR; PG8_SCHED;
            PG8_STAGE(PG8_SB(0, 1), b2 + hstep, voffB);
            PG8_WAIT_V(6); PG8_BAR; PG8_MMA(1, 1, At, B1); PG8_BAR;
            PG8_LDB(B0, 1, 0); PG8_SCHED; PG8_LDA(At, 1, 0); PG8_STAGE(PG8_SA(0, 1), a2 + hstep, voffA);
            PG8_WAIT_L(8); PG8_BAR; PG8_WAIT_L(0); PG8_MMA(0, 0, At, B0); PG8_BAR; PG8_SCHED;
            PG8_LDB(B1, 1, 1); PG8_STAGE(PG8_SB(1, 0), b3, voffB);
            PG8_BAR; PG8_WAIT_L(0); PG8_MMA(0, 1, At, B1); PG8_BAR;
            PG8_LDA(At, 1, 1); PG8_STAGE(PG8_SA(1, 0), a3, voffA);
            PG8_BAR; PG8_WAIT_L(0); PG8_MMA(1, 0, At, B0); PG8_BAR; PG8_SCHED;
            PG8_STAGE(PG8_SB(1, 1), b3 + hstep, voffB);
            PG8_WAIT_V(6); PG8_BAR; PG8_MMA(1, 1, At, B1); PG8_BAR;
            }
        }
        if constexpr (ALIGN_EPI) { if (wr == 0) PG8_BAR; }
        if constexpr (!Epi::AFTER_DRAIN) { E(acc, cur, wr, wc, fr, fq); S.done(cur); }
        if (!has_next) break;
#pragma unroll
        for (int a = 0; a < 2; ++a)
#pragma unroll
            for (int b = 0; b < 2; ++b)
#pragma unroll
                for (int m = 0; m < 4; ++m)
#pragma unroll
                    for (int n = 0; n < 2; ++n) acc[a][b][m][n] = (f32x4){0.f, 0.f, 0.f, 0.f};
        cur = nxt; cA = nA; cB = nB; ++ui;
        if constexpr (ALIGN_EPI) { if (wr == 1) PG8_BAR; }
    }
    PG8_WAIT_V(0);
    if constexpr (!ALIGN_EPI) { if (wr == 0) PG8_BAR; }
    PG8_BAR;
    if constexpr (Epi::AFTER_DRAIN) { E.fused(acc, cur, wr, wc, fr, fq, lds, wid, lane); S.done(cur); }
#undef PG8_SA
#undef PG8_SB
#undef PG8_STAGE
#undef PG8_LDA
#undef PG8_LDB
#undef PG8_MMA
#undef PG8_WAIT_V
#undef PG8_WAIT_L
#undef PG8_BAR
#undef PG8_SCHED
}
__device__ __forceinline__ void map_tile(int L, int nM, int nN, int& pm, int& pn) {
    const int nwg = nM * nN; int wgid = L; { const int q = nwg / NXCD, r = nwg % NXCD, xcd = wgid % NXCD, off = wgid / NXCD; wgid = (xcd < r ? xcd * (q + 1) : r * (q + 1) + (xcd - r) * q) + off; }
    const int nig = WGM * nN, gid = wgid / nig, fm = gid * WGM, gsz = (nM - fm) < WGM ? (nM - fm) : WGM;
    pm = fm + ((wgid % nig) % gsz); pn = (wgid % nig) / gsz;
}
constexpr int MP = T / 256, WP = NMAIN / 256, NU2 = 4 * MP, NU1 = MP * WP;
struct InOrder { int G, c;
    __device__ __forceinline__ bool next(int i, Unit& u) const { const int L = i * G + c; if (L >= NU2 + NU1) return false; int a, b;
        if (L < NU2) { map_tile(L, 4, MP, a, b); u.pm = MP + WP + a; u.pn = b; } else { map_tile(L - NU2, MP, WP, a, b); u.pm = a; u.pn = MP + b; } return true; }
    __device__ __forceinline__ void a_ready(const Unit&) const {}
    __device__ __forceinline__ void done(const Unit&) const {}
};
struct EpiIn { static constexpr bool PERM = true, AFTER_DRAIN = false; bf16_t* P; float* G; bf16_t* HTp;
    __device__ __forceinline__ void operator()(const f32x4 (&acc)[2][2][4][2], const Unit& u, int wr, int wc, int fr, int fq) const {
        if (u.pm < MP) { const int pn = u.pn - MP, row0 = u.pm * BM + wr * 64 + fr;
            if (pn < NP / 256) { const int col0 = pn * BM + wc * 32 + 8 * fq;
#pragma unroll
                for (int ai = 0; ai < 2; ++ai)
#pragma unroll
                    for (int m = 0; m < 4; ++m) { bf16_t* rowp = P + (size_t)(row0 + ai * HALF + m * 16) * NP + col0;
#pragma unroll
                        for (int bj = 0; bj < 2; ++bj) { const f32x4 v0 = acc[ai][bj][m][0], v1 = acc[ai][bj][m][1];
                            u32x4 w; w.x = cvt_pk_bf16(v0[0], v0[1]); w.y = cvt_pk_bf16(v0[2], v0[3]); w.z = cvt_pk_bf16(v1[0], v1[1]); w.w = cvt_pk_bf16(v1[2], v1[3]); *(u32x4*)(rowp + bj * HALF) = w; } } }
            else { const int cb = wc * 32 + 8 * fq;
                if (cb < NG) {
#pragma unroll
                    for (int ai = 0; ai < 2; ++ai)
#pragma unroll
                        for (int m = 0; m < 4; ++m) { float* rowb = G + (size_t)(row0 + ai * HALF + m * 16) * NGS; const f32x4 v0 = acc[ai][0][m][0], v1 = acc[ai][0][m][1];
                            if (cb < 16) { *(f32x4*)(rowb + cb) = v0; *(f32x4*)(rowb + cb + 4) = v1; }
                            else { u32x4 w; w.x = cvt_pk_bf16(v0[0], v0[1]); w.y = cvt_pk_bf16(v0[2], v0[3]); w.z = cvt_pk_bf16(v1[0], v1[1]); w.w = cvt_pk_bf16(v1[2], v1[3]); *(u32x4*)((bf16_t*)(rowb + 16) + (cb - 16)) = w; } } } } }
        else { const int row0 = (u.pm - MP - WP) * BM + wr * 64 + fr, col0 = u.pn * BM + wc * 32 + 8 * fq;
#pragma unroll
            for (int ai = 0; ai < 2; ++ai)
#pragma unroll
                for (int m = 0; m < 4; ++m) { bf16_t* rowp = HTp + (size_t)(row0 + ai * HALF + m * 16) * T + col0;
#pragma unroll
                    for (int bj = 0; bj < 2; ++bj) { const f32x4 v0 = acc[ai][bj][m][0], v1 = acc[ai][bj][m][1];
                        u32x4 w; w.x = cvt_pk_bf16(v0[0], v0[1]); w.y = cvt_pk_bf16(v0[2], v0[3]); w.z = cvt_pk_bf16(v1[0], v1[1]); w.w = cvt_pk_bf16(v1[2], v1[3]); *(u32x4*)(rowp + bj * HALF) = w; } } }
    }
};
struct OutOrder { int G, c; bool lat_only; unsigned* cnt;
    __device__ __forceinline__ bool next(int i, Unit& u) const { constexpr int nN = DM / 256, nLat = NB * (SEQ / 256) * nN, nCtx = NB * (CTXL / 256) * nN; const int L = i * G + c; int a, b;
        if (L < nLat) { map_tile(L, nLat / nN, nN, a, b); u.pm = (a / (SEQ / 256)) * (TOK / 256) + CTXL / 256 + a % (SEQ / 256); }
        else { if (lat_only || L >= nLat + nCtx) return false; map_tile(L - nLat, nCtx / nN, nN, a, b); u.pm = (a / (CTXL / 256)) * (TOK / 256) + a % (CTXL / 256); }
        u.pn = b; return true; }
    __device__ __forceinline__ void a_ready(const Unit&) const {}
    unsigned* xu; unsigned nloc, xtarget;
    __device__ __forceinline__ void done(const Unit& u) const {
        asm volatile("s_waitcnt vmcnt(0)" ::: "memory"); __builtin_amdgcn_s_barrier();
        if (threadIdx.x == 0) { const bool isctx = (u.pm % (TOK / 256)) < CTXL / 256;
            if (!isctx && xtarget != 0u) {
                const unsigned old = __hip_atomic_fetch_add(xu, 1u, __ATOMIC_RELAXED, __HIP_MEMORY_SCOPE_AGENT);
                if (old + 1u == xtarget) { __builtin_amdgcn_fence(__ATOMIC_RELEASE, "agent"); asm volatile("s_waitcnt vmcnt(0)" ::: "memory");
                    __hip_atomic_fetch_add(cnt, nloc, __ATOMIC_RELAXED, __HIP_MEMORY_SCOPE_AGENT); } }
            else { __builtin_amdgcn_fence(__ATOMIC_RELEASE, "agent"); asm volatile("s_waitcnt vmcnt(0)" ::: "memory");
                __hip_atomic_fetch_add(cnt + (isctx ? 64 : 0), 1u, __ATOMIC_RELAXED, __HIP_MEMORY_SCOPE_AGENT); } } }
};
struct EpiOut { static constexpr bool PERM = true, AFTER_DRAIN = false; bf16_t* C;
    __device__ __forceinline__ void operator()(const f32x4 (&acc)[2][2][4][2], const Unit& u, int wr, int wc, int fr, int fq) const {
        const int row0 = u.pm * BM + wr * 64 + fr, col0 = u.pn * BM + wc * 32 + 8 * fq;
#pragma unroll
        for (int ai = 0; ai < 2; ++ai)
#pragma unroll
            for (int m = 0; m < 4; ++m) { bf16_t* rowp = C + (size_t)(row0 + ai * HALF + m * 16) * DM + col0;
#pragma unroll
                for (int bj = 0; bj < 2; ++bj) { const f32x4 v0 = acc[ai][bj][m][0], v1 = acc[ai][bj][m][1];
                    u32x4 w; w.x = cvt_pk_bf16(v0[0], v0[1]); w.y = cvt_pk_bf16(v0[2], v0[3]); w.z = cvt_pk_bf16(v1[0], v1[1]); w.w = cvt_pk_bf16(v1[2], v1[3]); *(u32x4*)(rowp + bj * HALF) = w; } }
    }
};
}
#endif

__device__ __forceinline__ void phase_gemm_in(const Params& p, int l, char* smem) {
    constexpr int N_F = WG / 2;
#ifdef EMU
    constexpr int MT = T / 128, NT1 = NMAIN / 128, N1 = MT * NT1, N2 = 8 * MT;
    for (int task = obid(); task < N1 + N2; task += gridDim.x) {
        if (task < N1) gemm_tile(p, (const bf16*)(p.ws + WS_HNY), (const bf16*)(p.ws + WS_WIN), DM, task / NT1, task % NT1, 0, smem);
        else { const int t2 = task - N1; gemm_tile(p, (const bf16*)(p.ws + WS_WIN) + (size_t)NMAIN * DM, (const bf16*)(p.ws + WS_HNY), DM, t2 / MT, t2 % MT, 2, smem); }
    }
#else
    { const pg8::Gemm g{(const pg8::bf16_t*)(p.ws + WS_HNY), (const pg8::bf16_t*)(p.ws + WS_HNY), 0, 0, DM};
      const pg8::InOrder S{(int)gridDim.x, obid()};
      const pg8::EpiIn E{(pg8::bf16_t*)(p.ws + WS_P), (float*)(p.ws + WS_G), (pg8::bf16_t*)(p.ws + WS_HT)};
      pg8::gemm_phase<pg8::EpiIn, pg8::InOrder, true, true>((PG8_LAS unsigned char*)smem, g, S, E); }
#endif
    { const int G = (int)gridDim.x, bid = obid();
#ifdef EMU
      const int extra = 0;
#else
      const int extra = (pg8::NU1 + pg8::NU2) % G;
#endif
      if (extra > 0 && extra < G) { if (bid >= extra) for (int task = bid - extra; task < N_F; task += G - extra) filt_fft_task(p, task, smem); }
      else for (int task = G - 1 - bid; task < N_F; task += G) filt_fft_task(p, task, smem); }
}
__device__ __forceinline__ void phase_gemm_out(const Params& p, int l, char* smem) {
    const int G = (int)gridDim.x, bid = obid(); const bool has_ctx = l < DEPTH - 1;
#ifdef EMU
    constexpr int MT = T / 128, NTO = DM / 128;
    for (int task = bid; task < MT * NTO; task += G) {
        const int mt = task / NTO, nt = task % NTO;
        if (!has_ctx && (mt % (TOK / 128)) < CTXL / 128) continue;
        gemm_tile(p, (const bf16*)(p.ws + WS_HNY), (const bf16*)(p.ws + WS_WOUT), MIX, mt, nt, 1, smem);
        __syncthreads(); if (otid() == 0) *unit_counter(p, (mt % (TOK / 128)) < CTXL / 128 ? 1 : 0) += 1u;
    }
#else
    const pg8::Gemm g{(const pg8::bf16_t*)(p.ws + WS_HNY), (const pg8::bf16_t*)(p.ws + WS_WOUT), 0, 0, MIX};
    const unsigned xcc = (unsigned)__builtin_amdgcn_s_getreg((3 << 11) | 20) & 0xFu, nloc = ((volatile PG8_LAS unsigned*)(smem + LDS_BYTES - 64))[0];
    const bool agg = (NB * (SEQ / 256) * (DM / 256) == G) && nloc > 0u;
    const pg8::OutOrder S{G, bid, !has_ctx, unit_counter(p, 0), unit_counter(p, 2) + 16 * xcc, nloc, agg ? nloc * (unsigned)(l + 1) : 0u};
    const pg8::EpiOut E{(pg8::bf16_t*)(p.ws + WS_P)};
    pg8::gemm_phase<pg8::EpiOut, pg8::OutOrder, true, true>((PG8_LAS unsigned char*)smem, g, S, E);
#endif
}

__device__ __forceinline__ size_t st_index(int mixer, int dir, int b, int h, int cid) { return ((((size_t)(mixer * 2 + dir) * NB + b) * NH + h) * NCH + cid); }
__device__ __forceinline__ size_t ch_index(int dir, int b, int h, int cid) { return (((size_t)dir * NB + b) * NH + h) * NCH + cid; }

__device__ __forceinline__ void load_tile_nat(const bf16* P, int r0, int c0, bf16* dst, float scale, int tid) {
    const int s = tid >> 3, c8 = tid & 7;
    const u32x4 v = *(const u32x4*)(P + (size_t)(r0 + s) * NP + c0 + c8 * 8);
    if (scale == 1.0f) *(u32x4*)(dst + s * LS + c8 * 8) = v;
    else { float f[8]; unpack8(v, f); u32x4 o; o.x = pk2(f[0] * scale, f[1] * scale); o.y = pk2(f[2] * scale, f[3] * scale); o.z = pk2(f[4] * scale, f[5] * scale); o.w = pk2(f[6] * scale, f[7] * scale);
        *(u32x4*)(dst + s * LS + c8 * 8) = o; }
}
__device__ __forceinline__ void load_tile_tr(const bf16* P, int r0, int c0, bf16* dst, int tid) {
    const int s = tid >> 3, c8 = tid & 7;
    const u32x4 v = *(const u32x4*)(P + (size_t)(r0 + s) * NP + c0 + c8 * 8);
    const unsigned w[4] = {v.x, v.y, v.z, v.w};
#pragma unroll
    for (int j = 0; j < 4; ++j) { dst[(c8 * 8 + 2 * j) * LS + s] = (bf16)(w[j] & 0xffffu); dst[(c8 * 8 + 2 * j + 1) * LS + s] = (bf16)(w[j] >> 16); }
}

template <int NTK>
__device__ __forceinline__ void load_span(const bf16* row, int t0, float (&v)[NTK + 2]) {
    { const bool hl = t0 > 0, hr = t0 + NTK < SEQ; const bf16 xl = row[hl ? -1 : 0], xr = row[hr ? NTK : 0];
        v[0] = hl ? bf2f(xl) : 0.f; v[NTK + 1] = hr ? bf2f(xr) : 0.f; }
    if constexpr (NTK == 8) { float f[8]; unpack8(*(const u32x4*)row, f);
#pragma unroll
        for (int i = 0; i < 8; ++i) v[1 + i] = f[i]; }
    else {
#pragma unroll
        for (int i = 0; i < NTK; ++i) v[1 + i] = bf2f(row[i]); }
}
struct SpanRaw { u32x4 b; bf16 xl, xr; };
__device__ __forceinline__ SpanRaw span_load8(const bf16* row, int t0) { SpanRaw s; const bool hl = t0 > 0, hr = t0 + 8 < SEQ; s.xl = row[hl ? -1 : 0]; s.xr = row[hr ? 8 : 0]; s.b = *(const u32x4*)row; return s; }
__device__ __forceinline__ void span_expand8(const SpanRaw& s, int t0, float (&v)[10]) { float f[8]; unpack8(s.b, f); v[0] = t0 > 0 ? bf2f(s.xl) : 0.f; v[9] = (t0 + 8 < SEQ) ? bf2f(s.xr) : 0.f;
#pragma unroll
    for (int i = 0; i < 8; ++i) v[1 + i] = f[i]; }
template <int NTK>
__device__ __forceinline__ void hy_inputs(const bf16* h0, const bf16* h1, const float* cw, const float* cb, int c, int t0, float (&u0)[NTK], float (&u1)[NTK], float (&g0)[NTK], float (&g1)[NTK]) {
    if constexpr (NTK == 8) {
        const SpanRaw rxa = span_load8(h0 + (size_t)512 * T, t0), rxb = span_load8(h1 + (size_t)512 * T, t0), rga = span_load8(h0 + (size_t)768 * T, t0), rgb = span_load8(h1 + (size_t)768 * T, t0);
        const SpanRaw rva = span_load8(h0, t0), rvb = span_load8(h1, t0), rya = span_load8(h0 + (size_t)256 * T, t0), ryb = span_load8(h1 + (size_t)256 * T, t0);
        const float w0 = cw[0 * 768 + 512 + c], w1 = cw[1 * 768 + 512 + c], w2 = cw[2 * 768 + 512 + c], bb = cb[512 + c];
        const float v0 = cw[0 * 768 + c], v1 = cw[1 * 768 + c], v2 = cw[2 * 768 + c], vbias = cb[c];
        const float y0 = cw[0 * 768 + 256 + c], y1 = cw[1 * 768 + 256 + c], y2 = cw[2 * 768 + 256 + c], ybias = cb[256 + c];
        { float xa[10], xb[10], ga[10], gb[10]; span_expand8(rxa, t0, xa); span_expand8(rxb, t0, xb); span_expand8(rga, t0, ga); span_expand8(rgb, t0, gb);
#pragma unroll
            for (int i = 0; i < 8; ++i) { g0[i] = (w0 * xa[i] + w1 * xa[i + 1] + w2 * xa[i + 2] + bb) * siluf_(ga[i + 1]); g1[i] = (w0 * xb[i] + w1 * xb[i + 1] + w2 * xb[i + 2] + bb) * siluf_(gb[i + 1]); } }
        { float va[10], vb[10], ya[10], yb[10]; span_expand8(rva, t0, va); span_expand8(rvb, t0, vb); span_expand8(rya, t0, ya); span_expand8(ryb, t0, yb);
#pragma unroll
            for (int i = 0; i < 8; ++i) { u0[i] = (v0 * va[i] + v1 * va[i + 1] + v2 * va[i + 2] + vbias) * (y0 * ya[i] + y1 * ya[i + 1] + y2 * ya[i + 2] + ybias);
                u1[i] = (v0 * vb[i] + v1 * vb[i + 1] + v2 * vb[i + 2] + vbias) * (y0 * yb[i] + y1 * yb[i + 1] + y2 * yb[i + 2] + ybias); } }
        return;
    }
    { float xa[NTK + 2], xb[NTK + 2]; load_span<NTK>(h0 + (size_t)512 * T, t0, xa); load_span<NTK>(h1 + (size_t)512 * T, t0, xb);
        const float w0 = cw[0 * 768 + 512 + c], w1 = cw[1 * 768 + 512 + c], w2 = cw[2 * 768 + 512 + c], bb = cb[512 + c];
        float ga[NTK + 2], gb[NTK + 2]; load_span<NTK>(h0 + (size_t)768 * T, t0, ga); load_span<NTK>(h1 + (size_t)768 * T, t0, gb);
#pragma unroll
        for (int i = 0; i < NTK; ++i) { g0[i] = (w0 * xa[i] + w1 * xa[i + 1] + w2 * xa[i + 2] + bb) * siluf_(ga[i + 1]); g1[i] = (w0 * xb[i] + w1 * xb[i + 1] + w2 * xb[i + 2] + bb) * siluf_(gb[i + 1]); } }
    { float va[NTK + 2], vb[NTK + 2], ya[NTK + 2], yb[NTK + 2];
        load_span<NTK>(h0, t0, va); load_span<NTK>(h1, t0, vb); load_span<NTK>(h0 + (size_t)256 * T, t0, ya); load_span<NTK>(h1 + (size_t)256 * T, t0, yb);
        const float v0 = cw[0 * 768 + c], v1 = cw[1 * 768 + c], v2 = cw[2 * 768 + c], vbias = cb[c];
        const float y0 = cw[0 * 768 + 256 + c], y1 = cw[1 * 768 + 256 + c], y2 = cw[2 * 768 + 256 + c], ybias = cb[256 + c];
#pragma unroll
        for (int i = 0; i < NTK; ++i) { u0[i] = (v0 * va[i] + v1 * va[i + 1] + v2 * va[i + 2] + vbias) * (y0 * ya[i] + y1 * ya[i + 1] + y2 * ya[i + 2] + ybias);
            u1[i] = (v0 * vb[i] + v1 * vb[i + 1] + v2 * vb[i + 2] + vbias) * (y0 * yb[i] + y1 * yb[i + 1] + y2 * yb[i + 2] + ybias); } }
}
__device__ __forceinline__ void hylat_task(const Params& p, int l, int bp, int cp, char* smem) {
    const int tid = otid(), half = tid >> 8, tl = tid & 255, c = 2 * cp + half;
    const bf16* HT = (const bf16*)(p.ws + WS_HT); bf16* Y = (bf16*)(p.ws + WS_HNY);
    cpx* buf = (cpx*)smem + (size_t)half * FBUF;
    const cpx* TW = (const cpx*)(p.ws + WS_TW);
    const cpx* KF = (const cpx*)(p.ws + WS_KF) + (size_t)c * NF;
    constexpr int NTK = SEQ / 256;
    const int t0 = NTK * tl;
    const float* cw = p.in[I_HCW] + (size_t)l * 3 * 768; const float* cb = p.in[I_HCB] + (size_t)l * 768;
    const size_t rb0 = (size_t)(2 * bp) * TOK + CTXL, rb1 = rb0 + TOK;
    const bf16* h0 = HT + (size_t)c * T + rb0 + t0; const bf16* h1 = h0 + TOK;
    { float u0[NTK], u1[NTK], g0[NTK], g1[NTK]; hy_inputs<NTK>(h0, h1, cw, cb, c, t0, u0, u1, g0, g1);
        __syncthreads();
#pragma unroll
        for (int i = 0; i < NTK; ++i) { cpx v; v.x = u0[i]; v.y = u1[i]; buf[FPH(t0 + i)] = v; cpx z = {0.f, 0.f}; buf[FPH(SEQ + t0 + i)] = z; } }
    fft_fwd(buf, TW, tl);
#pragma unroll 2
    for (int i = tl; i < NF; i += 256) buf[FPH(i)] = cmul(buf[FPH(i)], KF[i]);
    fft_inv(buf, TW, tl);
    const float dsk = p.in[I_HD][(size_t)l * WG + c]; const float sc = 1.0f / (float)NF;
    { const int tz = otid() & 255; const int t0z = NTK * tz;
        float u0[NTK], u1[NTK], g0[NTK], g1[NTK]; hy_inputs<NTK>(HT + (size_t)c * T + rb0 + t0z, HT + (size_t)c * T + rb0 + t0z + TOK, cw, cb, c, t0z, u0, u1, g0, g1);
        float o0[NTK], o1[NTK];
#pragma unroll
        for (int i = 0; i < NTK; ++i) { const cpx y = buf[FPH(t0z + i)]; o0[i] = g0[i] * (y.x * sc + u0[i] * dsk); o1[i] = g1[i] * (y.y * sc + u1[i] * dsk); }
        bf16* d0 = (bf16*)(p.ws + WS_HT) + (size_t)(768 + c) * T + rb0 + t0z; bf16* d1 = d0 + TOK;
        if constexpr (NTK == 8) { *(u32x4*)d0 = pack8(o0); *(u32x4*)d1 = pack8(o1); }
        else {
#pragma unroll
            for (int i = 0; i < NTK; ++i) { d0[i] = f2bf(o0[i]); d1[i] = f2bf(o1[i]); } } }
}

constexpr int HCB = 16;
__device__ __forceinline__ void hyctx_task(const Params& p, int l, int b, int cblk, char* smem) {
    const int tid = otid(); const int c0 = cblk * HCB;
    const bf16* HT = (const bf16*)(p.ws + WS_HT); bf16* Y = (bf16*)(p.ws + WS_HNY); const float* HC = (const float*)(p.ws + WS_HC);
    float* raw = (float*)smem;
    float* u = raw + 4 * CTXL * HCB;
    float* og = u + CTXL * HCB;
    float* hcm = og + CTXL * HCB;
    bf16* ob = (bf16*)raw;
    const size_t rb = (size_t)b * TOK;
    const float* cw = p.in[I_HCW] + (size_t)l * 3 * 768; const float* cbias = p.in[I_HCB] + (size_t)l * 768;
    constexpr int WT = CTXL / 32;
    __syncthreads();
    for (int i = tid; i < 4 * HCB * (CTXL / 8); i += NT) { const int k = i / (HCB * (CTXL / 8)), cc = (i / (CTXL / 8)) % HCB, ck = i % (CTXL / 8);
        float f[8]; unpack8(*(const u32x4*)(HT + (size_t)(k * 256 + c0 + cc) * T + rb + ck * 8), f);
#pragma unroll
        for (int j = 0; j < 8; ++j) raw[(k * CTXL + ck * 8 + j) * HCB + cc] = f[j]; }
    for (int i = tid; i < 2 * HCB * (CTXL / 4); i += NT) { const int dir = i / (HCB * (CTXL / 4)), cc = (i / (CTXL / 4)) % HCB, pk = i % (CTXL / 4);
        const f32x4 v = *(const f32x4*)(HC + ((size_t)dir * WG + c0 + cc) * CTXL + pk * 4); const float f[4] = {v.x, v.y, v.z, v.w};
#pragma unroll
        for (int j = 0; j < 4; ++j) { const int pos = pk * 4 + j; if (dir == 0) hcm[(CTXL + pos) * HCB + cc] = f[j]; else if (pos > 0) hcm[(CTXL - pos) * HCB + cc] = f[j]; } }
    if (tid < HCB) hcm[tid] = 0.f;
    __syncthreads();
    for (int i = tid; i < CTXL * HCB; i += NT) { const int t = i / HCB, cc = i % HCB; float cv[3];
#pragma unroll
        for (int k = 0; k < 3; ++k) { const float* rk = raw + k * CTXL * HCB; const int ch = k * 256 + c0 + cc;
            const float a = t > 0 ? rk[(t - 1) * HCB + cc] : 0.f, m = rk[t * HCB + cc], z = t < CTXL - 1 ? rk[(t + 1) * HCB + cc] : 0.f;
            cv[k] = cw[0 * 768 + ch] * a + cw[1 * 768 + ch] * m + cw[2 * 768 + ch] * z + cbias[ch]; }
        u[i] = cv[0] * cv[1];
        og[i] = cv[2] * siluf_(raw[(3 * CTXL + t) * HCB + cc]); }
    __syncthreads();
    { const int cc = tid % HCB, tg = tid / HCB, t0 = WT * tg; float acc[WT], w[WT];
#pragma unroll
        for (int j = 0; j < WT; ++j) { acc[j] = 0.f; w[j] = hcm[(t0 + j + CTXL) * HCB + cc]; }
#pragma unroll 8
        for (int s = 0; s < CTXL; ++s) { const float us = u[s * HCB + cc];
#pragma unroll
            for (int j = 0; j < WT; ++j) acc[j] += us * w[j];
#pragma unroll
            for (int j = WT - 1; j > 0; --j) w[j] = w[j - 1];
            w[0] = hcm[(t0 - s - 1 + CTXL) * HCB + cc]; }
        const float dsk = p.in[I_HD][(size_t)l * WG + c0 + cc];
#pragma unroll
        for (int j = 0; j < WT; ++j) { const int t = t0 + j; ob[t * HCB + cc] = f2bf(og[t * HCB + cc] * (acc[j] + u[t * HCB + cc] * dsk)); } }
    __syncthreads();
    for (int i = tid; i < CTXL * 2; i += NT) { const int t = i >> 1, hh = i & 1; *(u32x4*)(Y + (rb + t) * 1024 + YH + c0 + 8 * hh) = *(const u32x4*)(ob + t * HCB + 8 * hh); }
}

__device__ __forceinline__ void attn_task(const Params& p, int l, int b, int kvh, int qt, bool ctxq, char* smem) {
    const int tid = otid(), lane = tid & 63, wave = tid >> 6, r = lane & 15, q = lane >> 4;
    constexpr float QSC = 0.125f * 1.4426950408889634f;
    const bf16* P = (const bf16*)(p.ws + WS_P); bf16* Y = (bf16*)(p.ws + WS_HNY); const cpx* ROPE = (const cpx*)(p.ws + WS_ROPE);
    bf16* Qs = (bf16*)smem;
    bf16* Ks = Qs + 256 * LS;
    constexpr int LSV = 80;
    bf16* Vt = Ks + 64 * LS;
    bf16* Ps = Vt + 64 * LS;
    const size_t rq0 = (size_t)b * TOK + (ctxq ? 0 : CTXL) + qt * 128;
    __syncthreads();
#pragma unroll
    for (int it = 0; it < 2; ++it) {
        const int idx = tid + NT * it, row = idx >> 2, cpair = idx & 3, g = row >> 7, t = row & 127;
        const bf16* src = P + (rq0 + t) * NP + PD + (kvh * 2 + g) * 64;
        float lo[8], hi[8]; unpack8(*(const u32x4*)(src + cpair * 8), lo); unpack8(*(const u32x4*)(src + 32 + cpair * 8), hi);
        float a[8], c2[8];
#pragma unroll
        for (int j = 0; j < 8; ++j) { float cs = 1.f, sn = 0.f; if (!ctxq) { const cpx cv = ROPE[(size_t)(qt * 128 + t) * 32 + cpair * 8 + j]; cs = cv.x; sn = cv.y; }
            a[j] = (lo[j] * cs - hi[j] * sn) * QSC; c2[j] = (hi[j] * cs + lo[j] * sn) * QSC; }
        *(u32x4*)(Qs + row * LS + cpair * 8) = pack8(a); *(u32x4*)(Qs + row * LS + 32 + cpair * 8) = pack8(c2);
    }
    const int lt0 = ctxq ? 0 : (2 * qt - 2 > 0 ? 2 * qt - 2 : 0), lt1 = ctxq ? -1 : (2 * qt + 3 < SEQ / 64 - 1 ? 2 * qt + 3 : SEQ / 64 - 1);
    const int nloc = lt1 - lt0 + 1, ntiles = nloc + NCC;
    float m[2], lsum[2]; f32x4 O[2][4];
#pragma unroll
    for (int ms = 0; ms < 2; ++ms) { m[ms] = -INFINITY; lsum[ms] = 0.f;
#pragma unroll
        for (int i = 0; i < 4; ++i) O[ms][i] = (f32x4){0.f, 0.f, 0.f, 0.f}; }
    const int g = wave >> 2, tq0 = (wave & 3) * 32;
    (void)Ps;
    __syncthreads();
    bf16x8 qf[2][2];
#pragma unroll
    for (int ms = 0; ms < 2; ++ms)
#pragma unroll
        for (int ks = 0; ks < 2; ++ks) qf[ms][ks] = *(const bf16x8*)(Qs + (g * 128 + tq0 + 16 * ms + r) * LS + ks * 32 + q * 8);
    u32x4 klo = {0u, 0u, 0u, 0u}, khi = klo, vq = klo; f32x4 rp[4] = {(f32x4){1.f, 0.f, 1.f, 0.f}, (f32x4){1.f, 0.f, 1.f, 0.f}, (f32x4){1.f, 0.f, 1.f, 0.f}, (f32x4){1.f, 0.f, 1.f, 0.f}};
    const int ks_ = tid >> 2, kcp = tid & 3, vs_ = tid >> 3, vc8 = tid & 7;
#define ATT_PREFETCH(TI) do { const bool loc_ = (TI) < nloc; const int kt_ = loc_ ? lt0 + (TI) : (TI) - nloc; const size_t rk_ = (size_t)b * TOK + (loc_ ? CTXL : 0) + kt_ * 64; \
        if (tid < 256) { const bf16* src_ = P + (rk_ + ks_) * NP + PD + 256 + kvh * 64; klo = *(const u32x4*)(src_ + kcp * 8); khi = *(const u32x4*)(src_ + 32 + kcp * 8); \
            if (loc_) { const f32x4* rr_ = (const f32x4*)(ROPE + (size_t)(kt_ * 64 + ks_) * 32 + kcp * 8); rp[0] = rr_[0]; rp[1] = rr_[1]; rp[2] = rr_[2]; rp[3] = rr_[3]; } \
            else { rp[0] = rp[1] = rp[2] = rp[3] = (f32x4){1.f, 0.f, 1.f, 0.f}; } } \
        vq = *(const u32x4*)(P + (rk_ + vs_) * NP + PD + 384 + kvh * 64 + vc8 * 8); } while (0)
    ATT_PREFETCH(0);
    for (int ti = 0; ti < ntiles; ++ti) {
        const bool local = ti < nloc; const int kt = local ? lt0 + ti : ti - nloc;
        __syncthreads();
        if (tid < 256) { float lo[8], hi[8]; unpack8(klo, lo); unpack8(khi, hi);
            const float cs[8] = {rp[0].x, rp[0].z, rp[1].x, rp[1].z, rp[2].x, rp[2].z, rp[3].x, rp[3].z}, sn[8] = {rp[0].y, rp[0].w, rp[1].y, rp[1].w, rp[2].y, rp[2].w, rp[3].y, rp[3].w};
            float a[8], c2[8];
#pragma unroll
            for (int j = 0; j < 8; ++j) { a[j] = lo[j] * cs[j] - hi[j] * sn[j]; c2[j] = hi[j] * cs[j] + lo[j] * sn[j]; }
            *(u32x4*)(Ks + ks_ * LS + kcp * 8) = pack8(a); *(u32x4*)(Ks + ks_ * LS + 32 + kcp * 8) = pack8(c2); }
        *(u32x4*)(Vt + vs_ * LSV + vc8 * 8) = vq;
        __syncthreads();
        if (ti + 1 < ntiles) ATT_PREFETCH(ti + 1);
        bf16x8 kfr[4][2], vfa[4], vfb[4];
#pragma unroll
        for (int nt = 0; nt < 4; ++nt)
#pragma unroll
            for (int ks = 0; ks < 2; ++ks) kfr[nt][ks] = *(const bf16x8*)(Ks + (16 * nt + r) * LS + ks * 32 + q * 8);
#pragma unroll
        for (int me = 0; me < 4; ++me) { const bf16* vr = Vt + (4 * q + (r >> 2)) * LSV + 16 * me + 4 * (r & 3);
            const u32x2 a0 = lds_tr16(vr), a1 = lds_tr16(vr + 16 * LSV), a2 = lds_tr16(vr + 32 * LSV), a3 = lds_tr16(vr + 48 * LSV);
            u32x4 va; va.x = a0.x; va.y = a0.y; va.z = a1.x; va.w = a1.y; u32x4 vb; vb.x = a2.x; vb.y = a2.y; vb.z = a3.x; vb.w = a3.y; vfa[me] = as_frag(va); vfb[me] = as_frag(vb); }
#pragma unroll
        for (int ms = 0; ms < 2; ++ms) {
            const int qlo = qt * 128 + tq0 + 16 * ms, klo_ = kt * 64;
            if (local && (klo_ > qlo + 15 + 128 || klo_ + 63 < qlo - 128)) continue;
            const bool domask = local && (klo_ + 63 - qlo > 128 || klo_ - (qlo + 15) < -128);
            f32x4 S[4] = {(f32x4){0.f, 0.f, 0.f, 0.f}, (f32x4){0.f, 0.f, 0.f, 0.f}, (f32x4){0.f, 0.f, 0.f, 0.f}, (f32x4){0.f, 0.f, 0.f, 0.f}};
#pragma unroll
            for (int ks = 0; ks < 2; ++ks)
#pragma unroll
                for (int nt = 0; nt < 4; ++nt) S[nt] = MFMA16(kfr[nt][ks], qf[ms][ks], S[nt]);
            const int qpos = qlo + r; float mx = -INFINITY;
            if (domask) {
#pragma unroll
                for (int nt = 0; nt < 4; ++nt)
#pragma unroll
                    for (int i = 0; i < 4; ++i) { const int d = kt * 64 + nt * 16 + 4 * q + i - qpos; if (d > 128 || d < -128) S[nt][i] = -INFINITY; } }
#pragma unroll
            for (int nt = 0; nt < 4; ++nt)
#pragma unroll
                for (int i = 0; i < 4; ++i) mx = fmaxf(mx, S[nt][i]);
            mx = xrow_max(mx);
            const float mn = fmaxf(m[ms], mx); const float msafe = mn == -INFINITY ? 0.f : mn; const float alpha = EXP2(m[ms] - msafe); float sm = 0.f;
#pragma unroll
            for (int nt = 0; nt < 4; ++nt)
#pragma unroll
                for (int i = 0; i < 4; ++i) { S[nt][i] = EXP2(S[nt][i] - msafe); sm += S[nt][i]; }
            sm = xrow_sum(sm);
            lsum[ms] = lsum[ms] * alpha + sm; m[ms] = mn;
            const float pa[8] = {S[0][0], S[0][1], S[0][2], S[0][3], S[1][0], S[1][1], S[1][2], S[1][3]}, pb[8] = {S[2][0], S[2][1], S[2][2], S[2][3], S[3][0], S[3][1], S[3][2], S[3][3]};
            const bf16x8 p0 = as_frag(pack8(pa)), p1 = as_frag(pack8(pb));
#pragma unroll
            for (int me = 0; me < 4; ++me) { O[ms][me] = O[ms][me] * alpha;
                O[ms][me] = MFMA16(vfa[me], p0, O[ms][me]); O[ms][me] = MFMA16(vfb[me], p1, O[ms][me]); }
        }
    }
#undef ATT_PREFETCH
    const float sink = p.in[I_SINK][(size_t)l * NH + kvh * 2 + g];
    u32x2 ggs[2][4];
#pragma unroll
    for (int ms = 0; ms < 2; ++ms)
#pragma unroll
        for (int me = 0; me < 4; ++me) ggs[ms][me] = *(const u32x2*)(P + (rq0 + tq0 + 16 * ms + r) * NP + PD + 512 + (kvh * 2 + g) * 64 + 4 * q + 16 * me);
#pragma unroll
    for (int ms = 0; ms < 2; ++ms) { const float den = lsum[ms] + EXP2(sink * 1.4426950408889634f - m[ms]); const float inv = frcp_(den);
        const size_t row = rq0 + tq0 + 16 * ms + r; const int col = (kvh * 2 + g) * 64 + 4 * q;
#pragma unroll
        for (int me = 0; me < 4; ++me) { const u32x2 gg = ggs[ms][me];
            const float g0 = bitsf(gg.x << 16), g1 = bitsf(gg.x & 0xffff0000u), g2 = bitsf(gg.y << 16), g3 = bitsf(gg.y & 0xffff0000u);
            u32x2 o; o.x = pk2(O[ms][me][0] * inv * siluf_(g0), O[ms][me][1] * inv * siluf_(g1)); o.y = pk2(O[ms][me][2] * inv * siluf_(g2), O[ms][me][3] * inv * siluf_(g3));
            *(u32x2*)(Y + row * 1024 + YD + col + 16 * me) = o; } }
}

#ifdef EMU
__device__ __forceinline__ int olane(int lane) { return lane; }
#else
__device__ __forceinline__ int olane(int lane) { asm volatile("" : "+v"(lane)); return lane; }
#endif
__device__ __forceinline__ void load_nat_tile(const bf16* P, int row0, int col0, bf16* tile, int lane) {
    u32x4 v[8];
#pragma unroll
    for (int i = 0; i < 8; ++i) v[i] = *(const u32x4*)(P + (size_t)(row0 + (lane >> 3) + 8 * i) * NP + col0 + (lane & 7) * 8);
#pragma unroll
    for (int i = 0; i < 8; ++i) *(u32x4*)(tile + swz((lane >> 3) + 8 * i, lane & 7)) = v[i];
}
__device__ __forceinline__ bf16x8 frag_tr(const bf16* tile, int c0, int k0, int lane) {
    const int c = c0 + (lane & 15), kb = k0 + 8 * (lane >> 4); unsigned w[4];
#pragma unroll
    for (int j = 0; j < 4; ++j) w[j] = (unsigned)tile[swz(kb + 2 * j, c >> 3) + (c & 7)] | ((unsigned)tile[swz(kb + 2 * j + 1, c >> 3) + (c & 7)] << 16);
    u32x4 o; o.x = w[0]; o.y = w[1]; o.z = w[2]; o.w = w[3]; return as_frag(o);
}
__device__ __forceinline__ bf16x8 frag_tr_hw(const bf16* tile, int c0, int k0, int lane) {
    const int r = lane & 15, q = lane >> 4, row = k0 + 8 * q + (r >> 2), col = c0 + 4 * (r & 3);
    const u32x2 a = lds_tr16(tile + swz(row, col >> 3) + (col & 7)), b = lds_tr16(tile + swz(row + 4, col >> 3) + (col & 7));
    u32x4 o; o.x = a.x; o.y = a.y; o.z = b.x; o.w = b.y; return as_frag(o);
}
template <int DIR>
__device__ __forceinline__ void gla_r_frags(const float* Grow0, int lane, bf16x8 (&af)[4]) {
    const int r = lane & 15, q4 = lane >> 4;
#pragma unroll
    for (int mt = 0; mt < 4; ++mt) { u32x4 o = {0u, 0u, 0u, 0u};
        if (q4 < 2) o = *(const u32x4*)((const bf16*)(Grow0 + (size_t)(16 * mt + r) * NGS + 16) + DIR * 16 + 8 * q4);
        af[mt] = as_frag(o); }
}
template <int DIR>
__device__ __forceinline__ void gla_b_load(const Params& p, int l, int h, int nt, int lane_, u32x4& o, float& bias) {
    const int lane = olane(lane_), r = lane & 15, q4 = lane >> 4, d = h * 64 + 16 * nt + r;
    const float* wa = p.in[I_GWA] + ((size_t)(l * 2 + DIR) * 16 + 8 * (q4 & 1)) * WG + d;
    float w[8];
#pragma unroll
    for (int j = 0; j < 8; ++j) w[j] = wa[j * WG];
    bias = p.in[I_GBA][(size_t)(l * 2 + DIR) * WG + d];
    o.x = pk2(w[0], w[1]); o.y = pk2(w[2], w[3]); o.z = pk2(w[4], w[5]); o.w = pk2(w[6], w[7]);
    if (q4 >= 2) o = (u32x4){0u, 0u, 0u, 0u};
}
template <int DIR>
__device__ __forceinline__ float gla_b_col(const u32x4 o, const float bias, const bf16x8 (&af)[4], int lane_, float (&x)[4][4]) {
    const int lane = olane(lane_), r = lane & 15, q4 = lane >> 4;
    const bf16x8 bfr = as_frag(o);
#pragma unroll
    for (int mt = 0; mt < 4; ++mt) { f32x4 c = {bias, bias, bias, bias}; c = MFMA16(af[mt], bfr, c);
#pragma unroll
        for (int i = 0; i < 4; ++i) x[mt][i] = logsig_fast(c[i]) * (1.0f / 16.0f); }
    float carry = 0.f;
#pragma unroll
    for (int k = 0; k < 4; ++k) { const int mt = DIR == 0 ? k : 3 - k; float* y = x[mt];
        if (DIR == 0) { y[1] += y[0]; y[2] += y[1]; y[3] += y[2]; } else { y[2] += y[3]; y[1] += y[2]; y[0] += y[1]; }
        const float s4 = DIR == 0 ? y[3] : y[0];
        const float t1 = DIR == 0 ? __shfl_up(s4, 16) : __shfl_down(s4, 16), t2 = DIR == 0 ? __shfl_up(s4, 32) : __shfl_down(s4, 32), t3 = DIR == 0 ? __shfl_up(s4, 48) : __shfl_down(s4, 48);
        const int qq = DIR == 0 ? q4 : 3 - q4;
        const float e = (qq >= 1 ? t1 : 0.f) + (qq >= 2 ? t2 : 0.f) + (qq >= 3 ? t3 : 0.f);
        const float tot = __shfl(e + s4, DIR == 0 ? r + 48 : r);
#pragma unroll
        for (int i = 0; i < 4; ++i) y[i] += carry + e;
        carry += tot; }
    return carry;
}

template <int MIXER, int DIR>
__device__ __forceinline__ void chunkst_dir(const Params& p, int l, int b, int h, int cid, const float* Grow0, const unsigned (&kk)[32], const bf16* Vt, bf16* Kt, const float* wvs, float* bendl, int lane_) {
    const int lane = olane(lane_), r = lane & 15, q4 = lane >> 4;
    if constexpr (MIXER == 0) {
        float nacc = 0.f;
#pragma unroll
        for (int c = 0; c < 8; ++c) { float f[8];
#pragma unroll
            for (int j = 0; j < 8; ++j) { const int s = 8 * c + j; const float kv = (s & 1) ? bitsf(kk[s >> 1] & 0xffff0000u) : bitsf(kk[s >> 1] << 16);
                f[j] = kv * 0.125f * wvs[DIR * 64 + s]; nacc += f[j]; }
            *(u32x4*)(Kt + swz(lane, c)) = pack8(f); }
        ((float*)(p.ws + WS_NV))[ch_index(DIR, b, h, cid) * 64 + lane] = nacc;
    } else {
        const bf16* P = (const bf16*)(p.ws + WS_P); const int kcol = PG + 256 + h * 64; const int r0 = b * TOK + cid * 64;
        bf16x8 af[4]; gla_r_frags<DIR>(Grow0, lane, af);
#pragma unroll 2
        for (int nt = 0; nt < 4; ++nt) { const int d = 16 * nt + r; float x[4][4];
            u32x4 wo_; float wb_; gla_b_load<DIR>(p, l, h, nt, lane, wo_, wb_); const float bend = gla_b_col<DIR>(wo_, wb_, af, lane, x);
            if (q4 == 0) { ((float*)(p.ws + WS_BE))[ch_index(DIR, b, h, cid) * 64 + d] = bend; bendl[d] = __expf(fmaxf(bend, -80.0f)); }
#pragma unroll
            for (int mt = 0; mt < 4; ++mt)
#pragma unroll
                for (int i = 0; i < 4; ++i) { const int s = 16 * mt + 4 * q4 + i; const float kv = bf2f(P[(size_t)(r0 + s) * NP + kcol + d]); const float bc = fmaxf(x[mt][i], -80.0f);
                    Kt[swz(d, s >> 3) + (s & 7)] = f2bf(kv * __expf(-bc));
                    ((bf16*)(p.ws + WS_EQ))[((size_t)DIR * T + r0 + s) * WG + h * 64 + d] = f2bf(__expf(bc)); } }
    }
    WAVE_SYNC();
    bf16x8 vf[4][2];
#pragma unroll
    for (int ne = 0; ne < 4; ++ne)
#pragma unroll
        for (int ks = 0; ks < 2; ++ks) vf[ne][ks] = frag_tr_hw(Vt, 16 * ne, 32 * ks, lane);
    bf16* dst = (bf16*)(p.ws + WS_ST) + st_index(MIXER, DIR, b, h, cid) * 4096;
#pragma unroll
    for (int me = 0; me < 4; ++me) {
        f32x4 acc[4] = {(f32x4){0.f, 0.f, 0.f, 0.f}, (f32x4){0.f, 0.f, 0.f, 0.f}, (f32x4){0.f, 0.f, 0.f, 0.f}, (f32x4){0.f, 0.f, 0.f, 0.f}};
#pragma unroll
        for (int ks = 0; ks < 2; ++ks) { const bf16x8 a = *(const bf16x8*)(Kt + swz(16 * me + r, ks * 4 + q4));
#pragma unroll
            for (int ne = 0; ne < 4; ++ne) acc[ne] = MFMA16(a, vf[ne][ks], acc[ne]); }
        f32x4 sc4 = {1.f, 1.f, 1.f, 1.f}; if constexpr (MIXER == 1) sc4 = *(const f32x4*)(bendl + 16 * me + 4 * q4);
#pragma unroll
        for (int ne = 0; ne < 4; ++ne) { const f32x4 v = acc[ne] * sc4; u32x2 o; o.x = pk2(v[0], v[1]); o.y = pk2(v[2], v[3]); *(u32x2*)(dst + (16 * ne + r) * 64 + 16 * me + 4 * q4) = o; }
    }
    WAVE_SYNC();
}
template <int MIXER>
__device__ __forceinline__ void chunkst_w(const Params& p, int l, int b, int h, int cid, char* wl, int lane) {
    const bf16* P = (const bf16*)(p.ws + WS_P); const float* G = (const float*)(p.ws + WS_G);
    const int r0 = b * TOK + cid * 64, r = lane & 15, q4 = lane >> 4;
    bf16* Kt = (bf16*)wl;
    bf16* Vt = Kt + 4096;
    float* wvs = (float*)(Vt + 4096);
    float* bendl = wvs + 128;
    const int kcol = (MIXER == 0 ? PA : PG) + 256 + h * 64, vcol = (MIXER == 0 ? PA : PG) + 512 + h * 64;
    const float* Grow0 = G + (size_t)r0 * NGS;
    bf16* Nn = Kt;
    { u32x4 vv[8], kv[8];
#pragma unroll
        for (int i = 0; i < 8; ++i) { vv[i] = *(const u32x4*)(P + (size_t)(r0 + (lane >> 3) + 8 * i) * NP + vcol + (lane & 7) * 8); kv[i] = *(const u32x4*)(P + (size_t)(r0 + (lane >> 3) + 8 * i) * NP + kcol + (lane & 7) * 8); }
#pragma unroll
        for (int i = 0; i < 8; ++i) { *(u32x4*)(Vt + swz((lane >> 3) + 8 * i, lane & 7)) = vv[i]; *(u32x4*)(Nn + swz((lane >> 3) + 8 * i, lane & 7)) = kv[i]; } }
    WAVE_SYNC();
    unsigned kk[32];
    { const int dc = 16 * q4 + 4 * (r & 3);
#pragma unroll
        for (int c = 0; c < 16; ++c) { const u32x2 t = lds_tr16(Nn + swz(4 * c + (r >> 2), dc >> 3) + (dc & 7)); kk[2 * c] = t.x; kk[2 * c + 1] = t.y; } }
    WAVE_SYNC();
    if constexpr (MIXER == 0) {
        const float* g = Grow0 + (size_t)lane * NGS; const float* gb = p.in[I_MGB] + (size_t)l * 16;
        const float gv0 = g[h], gv1 = g[4 + h], gv2 = g[8 + h], gv3 = g[12 + h], bv0 = gb[h], bv1 = gb[4 + h], bv2 = gb[8 + h], bv3 = gb[12 + h];
        const float i_f = gv0 + bv0, f_f = gv1 + bv1, i_b = gv2 + bv2, f_b = gv3 + bv3;
        const float lf = logsigf_(f_f), lb = logsigf_(f_b);
        const float bF = wave_prefix_sum(lf, lane), totF = __shfl(bF, 63);
        const float gF = totF - bF + i_f, mF = wave_max(gF);
        const float totB = wave_sum(lb), preB = wave_prefix_sum(lb, lane), bB = totB - preB + lb;
        const float gB = totB - bB + i_b, mB = wave_max(gB);
        wvs[lane] = __expf(gF - mF); wvs[64 + lane] = __expf(gB - mB);
        if (lane == 0) { float* SC = (float*)(p.ws + WS_SC);
            SC[ch_index(0, b, h, cid) * 4 + 0] = totF; SC[ch_index(0, b, h, cid) * 4 + 1] = mF;
            SC[ch_index(1, b, h, cid) * 4 + 0] = totB; SC[ch_index(1, b, h, cid) * 4 + 1] = mB; }
    }
    WAVE_SYNC();
    chunkst_dir<MIXER, 0>(p, l, b, h, cid, Grow0, kk, Vt, Kt, wvs, bendl, lane);
    chunkst_dir<MIXER, 1>(p, l, b, h, cid, Grow0, kk, Vt, Kt, wvs, bendl, lane);
}

template <int DIR>
__device__ __forceinline__ void chunkst_gla(const Params& p, int l, int b, int h, int cid, char* wl, int lane_) {
    const bf16* P = (const bf16*)(p.ws + WS_P);
    const int lane = olane(lane_), r0 = b * TOK + cid * 64, r = lane & 15, q4 = lane >> 4;
    bf16* Kt = (bf16*)wl;
    bf16* An = Kt + 4096;
    float* bendl = (float*)(An + 4096);
    const int kcol = PG + 256 + h * 64, vcol = PG + 512 + h * 64;
    const float* Grow0 = (const float*)(p.ws + WS_G) + (size_t)r0 * NGS;
    u32x4 vv[8], kv[8];
#pragma unroll
    for (int i = 0; i < 8; ++i) { vv[i] = *(const u32x4*)(P + (size_t)(r0 + (lane >> 3) + 8 * i) * NP + vcol + (lane & 7) * 8); kv[i] = *(const u32x4*)(P + (size_t)(r0 + (lane >> 3) + 8 * i) * NP + kcol + (lane & 7) * 8); }
    bf16x8 af[4]; gla_r_frags<DIR>(Grow0, lane, af);
    u32x4 wo[4]; float wb[4];
#pragma unroll
    for (int nt = 0; nt < 4; ++nt) gla_b_load<DIR>(p, l, h, nt, lane, wo[nt], wb[nt]);
#pragma unroll
    for (int i = 0; i < 8; ++i) *(u32x4*)(An + swz((lane >> 3) + 8 * i, lane & 7)) = vv[i];
    WAVE_SYNC();
    bf16x8 vf[4][2];
#pragma unroll
    for (int ne = 0; ne < 4; ++ne)
#pragma unroll
        for (int ks = 0; ks < 2; ++ks) vf[ne][ks] = frag_tr_hw(An, 16 * ne, 32 * ks, lane);
    WAVE_SYNC();
#pragma unroll
    for (int i = 0; i < 8; ++i) *(u32x4*)(An + swz((lane >> 3) + 8 * i, lane & 7)) = kv[i];
    WAVE_SYNC();
#pragma unroll
    for (int nt = 0; nt < 4; ++nt) { const int d = 16 * nt + r; float x[4][4];
        const float bend = gla_b_col<DIR>(wo[nt], wb[nt], af, lane, x);
        if (q4 == 0) { ((float*)(p.ws + WS_BE))[ch_index(DIR, b, h, cid) * 64 + d] = bend; bendl[d] = __expf(fmaxf(bend, -80.0f)); }
#pragma unroll
        for (int mt = 0; mt < 4; ++mt) { const int s0 = 16 * mt + 4 * q4, dc = 16 * nt + 4 * (r & 3);
            const u32x2 kq = lds_tr16(An + swz(s0 + (r >> 2), dc >> 3) + (dc & 7));
            const float kv[4] = {bitsf(kq.x << 16), bitsf(kq.x & 0xffff0000u), bitsf(kq.y << 16), bitsf(kq.y & 0xffff0000u)}; float kp[4];
#pragma unroll
            for (int i = 0; i < 4; ++i) { const float bc = fmaxf(x[mt][i], -80.0f); kp[i] = kv[i] * __expf(-bc); An[swz(s0 + i, d >> 3) + (d & 7)] = f2bf(__expf(bc)); }
            u32x2 o; o.x = pk2(kp[0], kp[1]); o.y = pk2(kp[2], kp[3]); *(u32x2*)(Kt + swz(d, s0 >> 3) + (s0 & 7)) = o; } }
    WAVE_SYNC();
    { bf16* EQg = (bf16*)(p.ws + WS_EQ) + ((size_t)DIR * T + r0) * WG + h * 64;
#pragma unroll
        for (int i = 0; i < 8; ++i) { const int s = (lane >> 3) + 8 * i, ck = lane & 7; *(u32x4*)(EQg + (size_t)s * WG + ck * 8) = *(const u32x4*)(An + swz(s, ck)); } }
    bf16* dst = (bf16*)(p.ws + WS_ST) + st_index(1, DIR, b, h, cid) * 4096;
#pragma unroll
    for (int me = 0; me < 4; ++me) {
        f32x4 acc[4] = {(f32x4){0.f, 0.f, 0.f, 0.f}, (f32x4){0.f, 0.f, 0.f, 0.f}, (f32x4){0.f, 0.f, 0.f, 0.f}, (f32x4){0.f, 0.f, 0.f, 0.f}};
#pragma unroll
        for (int ks = 0; ks < 2; ++ks) { const bf16x8 a = *(const bf16x8*)(Kt + swz(16 * me + r, ks * 4 + q4));
#pragma unroll
            for (int ne = 0; ne < 4; ++ne) acc[ne] = MFMA16(a, vf[ne][ks], acc[ne]); }
        const f32x4 sc4 = *(const f32x4*)(bendl + 16 * me + 4 * q4);
#pragma unroll
        for (int ne = 0; ne < 4; ++ne) { const f32x4 v = acc[ne] * sc4; u32x2 o; o.x = pk2(v[0], v[1]); o.y = pk2(v[2], v[3]); *(u32x2*)(dst + (16 * ne + r) * 64 + 16 * me + 4 * q4) = o; }
    }
    WAVE_SYNC();
}

template <int MIXER, int DIR>
__device__ __forceinline__ void chunkout_prep(const Params& p, int l, int b, int h, int cid, const float* Grow0, int r0, int pbase, const bf16* EQ, float* gar, int lane_) {
    const int lane = olane(lane_);
    if constexpr (MIXER == 0) {
        const bf16* P = (const bf16*)(p.ws + WS_P);
        const float* g = Grow0 + (size_t)lane * NGS; const float* gb = p.in[I_MGB] + (size_t)l * 16;
        const float ig = g[DIR * 8 + h] + gb[DIR * 8 + h], fg = g[DIR * 8 + 4 + h] + gb[DIR * 8 + 4 + h];
        const float mprev = ((const float*)(p.ws + WS_SC))[ch_index(DIR, b, h, cid) * 4 + 2];
        const float lf = logsigf_(fg); float bb;
        if (DIR == 0) bb = wave_prefix_sum(lf, lane); else { const float tt = wave_sum(lf), pre = wave_prefix_sum(lf, lane); bb = tt - pre + lf; }
        const float a = ig - bb; const float pm = DIR == 0 ? wave_prefix_max(a, lane) : wave_suffix_max(a, lane);
        const float mt_ = fmaxf(bb + mprev, bb + pm);
        float* ga = gar + DIR * 320;
        ga[lane] = bb - mt_; ga[64 + lane] = a; ga[128 + lane] = __expf(bb + mprev - mt_); ga[192 + lane] = __expf(-mt_);
        float* nvl = gar + 640 + DIR * 64;
        nvl[lane] = ((const float*)(p.ws + WS_NV))[ch_index(DIR, b, h, cid) * 64 + lane];
        WAVE_SYNC();
        float dq = 0.f;
#pragma unroll
        for (int c = 0; c < 8; ++c) { float f[8]; unpack8(*(const u32x4*)(P + (size_t)(r0 + lane) * NP + pbase + c * 8), f);
            const f32x4 n0 = *(const f32x4*)(nvl + c * 8), n1 = *(const f32x4*)(nvl + c * 8 + 4);
            dq += f[0] * n0.x + f[1] * n0.y + f[2] * n0.z + f[3] * n0.w + f[4] * n1.x + f[5] * n1.y + f[6] * n1.z + f[7] * n1.w; }
        ga[256 + lane] = dq;
    }
}
template <int MIXER>
__device__ __forceinline__ void chunkout_prep2(const Params& p, int l, int b, int h, int cid, const float* Grow0, int r0, int pbase, float* gar, int lane_) {
    if constexpr (MIXER == 0) {
        const int lane = olane(lane_);
        const bf16* P = (const bf16*)(p.ws + WS_P);
        const float* g = Grow0 + (size_t)lane * NGS; const float* gb = p.in[I_MGB] + (size_t)l * 16;
        const float g0 = g[h], g1 = g[4 + h], g2 = g[8 + h], g3 = g[12 + h];
        const float mprev0 = ((const float*)(p.ws + WS_SC))[ch_index(0, b, h, cid) * 4 + 2], mprev1 = ((const float*)(p.ws + WS_SC))[ch_index(1, b, h, cid) * 4 + 2];
        const float nv0 = ((const float*)(p.ws + WS_NV))[ch_index(0, b, h, cid) * 64 + lane], nv1 = ((const float*)(p.ws + WS_NV))[ch_index(1, b, h, cid) * 64 + lane];
        u32x4 qr[8];
#pragma unroll
        for (int c = 0; c < 8; ++c) qr[c] = *(const u32x4*)(P + (size_t)(r0 + lane) * NP + pbase + c * 8);
        const float igF = g0 + gb[h], fgF = g1 + gb[4 + h], igB = g2 + gb[8 + h], fgB = g3 + gb[12 + h];
        { const float lf = logsigf_(fgF); const float bb = wave_prefix_sum(lf, lane);
            const float a = igF - bb; const float pm = wave_prefix_max(a, lane); const float mt_ = fmaxf(bb + mprev0, bb + pm); float* ga = gar;
            ga[lane] = bb - mt_; ga[64 + lane] = a; ga[128 + lane] = __expf(bb + mprev0 - mt_); ga[192 + lane] = __expf(-mt_); }
        { const float lf = logsigf_(fgB); const float tt = wave_sum(lf), pre = wave_prefix_sum(lf, lane); const float bb = tt - pre + lf;
            const float a = igB - bb; const float pm = wave_suffix_max(a, lane); const float mt_ = fmaxf(bb + mprev1, bb + pm); float* ga = gar + 320;
            ga[lane] = bb - mt_; ga[64 + lane] = a; ga[128 + lane] = __expf(bb + mprev1 - mt_); ga[192 + lane] = __expf(-mt_); }
        float* nvl = gar + 640;
        nvl[lane] = nv0; nvl[64 + lane] = nv1;
        WAVE_SYNC();
        float dq0 = 0.f, dq1 = 0.f;
#pragma unroll
        for (int c = 0; c < 8; ++c) { float f[8]; unpack8(qr[c], f);
            const f32x4 n0 = *(const f32x4*)(nvl + c * 8), n1 = *(const f32x4*)(nvl + c * 8 + 4), m0 = *(const f32x4*)(nvl + 64 + c * 8), m1 = *(const f32x4*)(nvl + 64 + c * 8 + 4);
            dq0 += f[0] * n0.x + f[1] * n0.y + f[2] * n0.z + f[3] * n0.w + f[4] * n1.x + f[5] * n1.y + f[6] * n1.z + f[7] * n1.w;
            dq1 += f[0] * m0.x + f[1] * m0.y + f[2] * m0.z + f[3] * m0.w + f[4] * m1.x + f[5] * m1.y + f[6] * m1.z + f[7] * m1.w; }
        gar[256 + lane] = dq0; gar[320 + 256 + lane] = dq1;
    }
}
template <int MIXER, int DIR, int NS>
__device__ __forceinline__ void chunkout_dir(const Params& p, int b, int h, int cid, int r0, int pbase, int th, const bf16x8 (&vtf)[4][2], const bf16* VtL, const bf16* EQ, bf16* SB, const float* gar, float* rsm, f32x4 (&htot)[NS][4], int lane_) {
    const bf16* P = (const bf16*)(p.ws + WS_P); const bf16* ST = (const bf16*)(p.ws + WS_ST);
    const int lane = olane(lane_), r = lane & 15, q4 = lane >> 4;
    const bf16* E = EQ + ((size_t)DIR * T + r0) * WG + h * 64;
    const float* ga = gar + DIR * 320;
    bf16x8 kf[4][2], ctf[4][2];
    if constexpr (MIXER == 0) {
#pragma unroll
        for (int n = 0; n < 4; ++n)
#pragma unroll
            for (int ks = 0; ks < 2; ++ks) { kf[n][ks] = *(const bf16x8*)(P + (size_t)(r0 + 16 * n + r) * NP + pbase + 256 + ks * 32 + q4 * 8); ctf[n][ks] = *(const bf16x8*)(ST + st_index(MIXER, DIR, b, h, cid) * 4096 + (16 * n + r) * 64 + ks * 32 + q4 * 8); }
    } else {
        u32x4 er[4][2];
#pragma unroll
        for (int n = 0; n < 4; ++n)
#pragma unroll
            for (int ks = 0; ks < 2; ++ks) { kf[n][ks] = *(const bf16x8*)(P + (size_t)(r0 + 16 * n + r) * NP + pbase + 256 + ks * 32 + q4 * 8);
                er[n][ks] = *(const u32x4*)(E + (size_t)(16 * n + r) * WG + ks * 32 + q4 * 8);
                ctf[n][ks] = *(const bf16x8*)(ST + st_index(MIXER, DIR, b, h, cid) * 4096 + (16 * n + r) * 64 + ks * 32 + q4 * 8); }
        SCHED_FENCE();
#pragma unroll
        for (int n = 0; n < 4; ++n)
#pragma unroll
            for (int ks = 0; ks < 2; ++ks) { float fe[8], fk[8]; unpack8(er[n][ks], fe); unpack8(as_u4(kf[n][ks]), fk);
#pragma unroll
                for (int j = 0; j < 8; ++j) fk[j] = fk[j] * frcp_(fe[j]);
                kf[n][ks] = as_frag(pack8(fk)); }
    }
    bf16x8 qraw[NS][2]; u32x4 qer[NS][2];
#pragma unroll
    for (int ms = 0; ms < NS; ++ms)
#pragma unroll
        for (int ks = 0; ks < 2; ++ks) { const int mt = NS * th + ms; qraw[ms][ks] = *(const bf16x8*)(P + (size_t)(r0 + 16 * mt + r) * NP + pbase + ks * 32 + q4 * 8);
            if constexpr (MIXER == 1) qer[ms][ks] = *(const u32x4*)(E + (size_t)(16 * mt + r) * WG + ks * 32 + q4 * 8); else qer[ms][ks] = (u32x4){0u, 0u, 0u, 0u}; }
#pragma unroll
    for (int ms = 0; ms < NS; ++ms) { const int mt = NS * th + ms;
        bf16x8 qf[2];
#pragma unroll
        for (int ks = 0; ks < 2; ++ks) { qf[ks] = qraw[ms][ks];
            if constexpr (MIXER == 1) { float fe[8], fq[8]; unpack8(qer[ms][ks], fe); unpack8(as_u4(qf[ks]), fq);
#pragma unroll
                for (int j = 0; j < 8; ++j) fq[j] *= 0.125f * fe[j];
                qf[ks] = as_frag(pack8(fq)); } }
        f32x4 S[4] = {(f32x4){0.f, 0.f, 0.f, 0.f}, (f32x4){0.f, 0.f, 0.f, 0.f}, (f32x4){0.f, 0.f, 0.f, 0.f}, (f32x4){0.f, 0.f, 0.f, 0.f}};
#pragma unroll
        for (int ks = 0; ks < 2; ++ks)
#pragma unroll
            for (int n = 0; n < 4; ++n) S[n] = MFMA16(kf[n][ks], qf[ks], S[n]);
        const int t = 16 * mt + r; float sm = 0.f; float gt = 0.f; if constexpr (MIXER == 0) gt = ga[t];
#pragma unroll
        for (int n = 0; n < 4; ++n) { f32x4 gs = {0.f, 0.f, 0.f, 0.f}; if constexpr (MIXER == 0) gs = *(const f32x4*)(ga + 64 + 16 * n + 4 * q4);
#pragma unroll
            for (int i = 0; i < 4; ++i) { const int sidx = 16 * n + 4 * q4 + i; const bool ok = DIR == 0 ? (sidx <= t) : (sidx >= t); float v = 0.f;
                if (ok) { if constexpr (MIXER == 0) v = S[n][i] * 0.125f * __expf(gt + gs[i]); else v = S[n][i]; }
                S[n][i] = v; sm += v; } }
        const float pa[8] = {S[0][0], S[0][1], S[0][2], S[0][3], S[1][0], S[1][1], S[1][2], S[1][3]}, pb[8] = {S[2][0], S[2][1], S[2][2], S[2][3], S[3][0], S[3][1], S[3][2], S[3][3]};
        const bf16x8 sm0 = as_frag(pack8(pa)), sm1 = as_frag(pack8(pb));
        float wi = 1.f, inv = 1.f;
        if constexpr (MIXER == 0) { sm = xrow_sum(sm); wi = ga[128 + t]; const float den = wi * ga[256 + t] + sm; inv = frcp_(fmaxf(fabsf(den), ga[192 + t])); }
#pragma unroll
        for (int me = 0; me < 4; ++me) { f32x4 a1 = {0.f, 0.f, 0.f, 0.f}, a2 = {0.f, 0.f, 0.f, 0.f};
            const int srow = 4 * q4 + (r >> 2), ecol = 16 * me + 4 * (r & 3);
            const u32x2 v0 = lds_tr16(VtL + swz(srow, ecol >> 3) + (ecol & 7)), v1 = lds_tr16(VtL + swz(16 + srow, ecol >> 3) + (ecol & 7)), v2 = lds_tr16(VtL + swz(32 + srow, ecol >> 3) + (ecol & 7)), v3 = lds_tr16(VtL + swz(48 + srow, ecol >> 3) + (ecol & 7));
            u32x4 va; va.x = v0.x; va.y = v0.y; va.z = v1.x; va.w = v1.y; u32x4 vb; vb.x = v2.x; vb.y = v2.y; vb.z = v3.x; vb.w = v3.y;
            a1 = MFMA16(as_frag(va), sm0, a1); a1 = MFMA16(as_frag(vb), sm1, a1);
            a2 = MFMA16(ctf[me][0], qf[0], a2); a2 = MFMA16(ctf[me][1], qf[1], a2);
            if constexpr (MIXER == 0) htot[ms][me] += (a1 + a2 * wi) * inv; else htot[ms][me] += a1 + a2; }
    }
    (void)SB; (void)rsm;
}
__device__ __forceinline__ void co_build_vt(const bf16* P, int r0, int vcol, bf16* VtL, int lane) {
    load_nat_tile(P, r0, vcol, VtL, lane);
    WAVE_SYNC();
}
template <int MIXER, int NS>
__device__ __forceinline__ void co_finalize(const Params& p, int l, int h, int r0, int pbase, int mt0, f32x4 (&htot)[NS][4], int lane_) {
    const bf16* P = (const bf16*)(p.ws + WS_P); bf16* Y = (bf16*)(p.ws + WS_HNY);
    const float* ngp = p.in[MIXER == 0 ? I_MNG : I_GNG] + (size_t)l * WG + h * 64;
    const int lz = olane(lane_), r = lz & 15, q4 = lz >> 4;
    u32x2 gq[NS][4], oq[NS][4]; f32x4 ng[4];
#pragma unroll
    for (int me = 0; me < 4; ++me) ng[me] = *(const f32x4*)(ngp + 16 * me + 4 * q4);
#pragma unroll
    for (int ms = 0; ms < NS; ++ms)
#pragma unroll
        for (int me = 0; me < 4; ++me) { const size_t off = (size_t)(r0 + 16 * (mt0 + ms) + r) * NP + pbase + 16 * me + 4 * q4;
            gq[ms][me] = *(const u32x2*)(P + off + (MIXER == 0 ? 1024 : 768)); if constexpr (MIXER == 0) oq[ms][me] = *(const u32x2*)(P + off + 768); else oq[ms][me] = (u32x2){0u, 0u}; }
#pragma unroll
    for (int ms = 0; ms < NS; ++ms) { const int mt = mt0 + ms; float ss = 0.f; float gv[4][4];
#pragma unroll
        for (int me = 0; me < 4; ++me) {
            gv[me][0] = bitsf(gq[ms][me].x << 16); gv[me][1] = bitsf(gq[ms][me].x & 0xffff0000u); gv[me][2] = bitsf(gq[ms][me].y << 16); gv[me][3] = bitsf(gq[ms][me].y & 0xffff0000u);
            if constexpr (MIXER == 0) { htot[ms][me][0] *= sigmoidf_(bitsf(oq[ms][me].x << 16)); htot[ms][me][1] *= sigmoidf_(bitsf(oq[ms][me].x & 0xffff0000u)); htot[ms][me][2] *= sigmoidf_(bitsf(oq[ms][me].y << 16)); htot[ms][me][3] *= sigmoidf_(bitsf(oq[ms][me].y & 0xffff0000u)); }
            ss += htot[ms][me][0] * htot[ms][me][0] + htot[ms][me][1] * htot[ms][me][1] + htot[ms][me][2] * htot[ms][me][2] + htot[ms][me][3] * htot[ms][me][3]; }
        ss = xrow_sum(ss);
        const float rstd = rsqrtf(ss * (1.0f / 64.0f) + EPS);
#pragma unroll
        for (int me = 0; me < 4; ++me) { const int e = 16 * me + 4 * q4; const f32x4 n4 = ng[me];
            u32x2 o; o.x = pk2(htot[ms][me][0] * rstd * n4.x * siluf_(gv[me][0]), htot[ms][me][1] * rstd * n4.y * siluf_(gv[me][1]));
            o.y = pk2(htot[ms][me][2] * rstd * n4.z * siluf_(gv[me][2]), htot[ms][me][3] * rstd * n4.w * siluf_(gv[me][3]));
            *(u32x2*)(Y + (size_t)(r0 + 16 * mt + r) * 1024 + (MIXER == 0 ? YA : YG) + h * 64 + e) = o; } }
}
template <int MIXER>
__device__ __forceinline__ void chunkout_w(const Params& p, int l, int b, int h, int cid, char* wl, int lane) {
    const bf16* P = (const bf16*)(p.ws + WS_P); const float* G = (const float*)(p.ws + WS_G);
    const int r0 = b * TOK + cid * 64;
    const int pbase = (MIXER == 0 ? PA : PG) + h * 64;
    bf16* SB = (bf16*)wl;
    float* rsm = (float*)(SB + 1024);
    float* gar = rsm + 16;
    const bf16* EQ = (const bf16*)(p.ws + WS_EQ);
    const float* Grow0 = G + (size_t)r0 * NGS;
    bf16* VtL = (bf16*)(gar + 768);
    bf16x8 vtf[4][2];
#pragma unroll
    for (int me = 0; me < 4; ++me)
#pragma unroll
        for (int ks = 0; ks < 2; ++ks) { vtf[me][ks] = (bf16x8){0, 0, 0, 0, 0, 0, 0, 0}; }
    co_build_vt(P, r0, pbase + 512, VtL, lane);
    chunkout_prep2<MIXER>(p, l, b, h, cid, Grow0, r0, pbase, gar, lane);
    WAVE_SYNC();
    constexpr int NS = 2;
#pragma unroll 1
    for (int th = 0; th < 4 / NS; ++th) {
        f32x4 htot[NS][4];
#pragma unroll
        for (int a = 0; a < NS; ++a)
#pragma unroll
            for (int c = 0; c < 4; ++c) htot[a][c] = (f32x4){0.f, 0.f, 0.f, 0.f};
        chunkout_dir<MIXER, 0, NS>(p, b, h, cid, r0, pbase, th, vtf, VtL, EQ, SB, gar, rsm, htot, lane);
        chunkout_dir<MIXER, 1, NS>(p, b, h, cid, r0, pbase, th, vtf, VtL, EQ, SB, gar, rsm, htot, lane);
        co_finalize<MIXER, NS>(p, l, h, r0, pbase, NS * th, htot, lane);
    }
}
constexpr int CO_PART = 13376;
template <int MIXER, int DIR>
__device__ __forceinline__ void chunkout_piece(const Params& p, int l, int b, int h, int cid, int mt, char* wl, int lane) {
    const bf16* P = (const bf16*)(p.ws + WS_P); const float* G = (const float*)(p.ws + WS_G);
    const int r0 = b * TOK + cid * 64; const int pbase = (MIXER == 0 ? PA : PG) + h * 64;
    bf16* SB = (bf16*)wl; float* rsm = (float*)(SB + 1024); float* gar = rsm + 16; const bf16* EQ = (const bf16*)(p.ws + WS_EQ);
    const float* Grow0 = G + (size_t)r0 * NGS; bf16* VtL = (bf16*)(gar + 768);
    bf16x8 vtf[4][2];
#pragma unroll
    for (int me = 0; me < 4; ++me)
#pragma unroll
        for (int ks = 0; ks < 2; ++ks) { vtf[me][ks] = (bf16x8){0, 0, 0, 0, 0, 0, 0, 0}; }
    co_build_vt(P, r0, pbase + 512, VtL, lane);
    chunkout_prep<MIXER, DIR>(p, l, b, h, cid, Grow0, r0, pbase, EQ, gar, lane);
    WAVE_SYNC();
    f32x4 htot[1][4] = {{(f32x4){0.f, 0.f, 0.f, 0.f}, (f32x4){0.f, 0.f, 0.f, 0.f}, (f32x4){0.f, 0.f, 0.f, 0.f}, (f32x4){0.f, 0.f, 0.f, 0.f}}};
    chunkout_dir<MIXER, DIR, 1>(p, b, h, cid, r0, pbase, mt, vtf, VtL, EQ, SB, gar, rsm, htot, lane);
    float* part = (float*)(wl + CO_PART);
#pragma unroll
    for (int me = 0; me < 4; ++me)
#pragma unroll
        for (int i = 0; i < 4; ++i) part[(me * 4 + i) * 64 + lane] = htot[0][me][i];
}
template <int MIXER>
__device__ __forceinline__ void chunkout_combine(const Params& p, int l, int b, int h, int cid, int mt, const char* smem, int lane) {
    const float* pa = (const float*)(smem + (2 * mt) * WLDS + CO_PART); const float* pb = (const float*)(smem + (2 * mt + 1) * WLDS + CO_PART);
    f32x4 htot[1][4];
#pragma unroll
    for (int me = 0; me < 4; ++me)
#pragma unroll
        for (int i = 0; i < 4; ++i) htot[0][me][i] = pa[(me * 4 + i) * 64 + lane] + pb[(me * 4 + i) * 64 + lane];
    co_finalize<MIXER, 1>(p, l, h, b * TOK + cid * 64, (MIXER == 0 ? PA : PG) + h * 64, mt, htot, lane);
}

template <bool OUT>
__device__ __forceinline__ void chunk_workers(const Params& p, int l, char* smem) {
    const int tid = otid(), lane = tid & 63, wave = __builtin_amdgcn_readfirstlane(tid >> 6);
    const int NW = (int)gridDim.x * 8, wi = wave * (int)gridDim.x + obid();
    const int c_lo = (OUT && l == DEPTH - 1) ? NCC : 0, npc = NCH - c_lo, half = NB * NH * npc;
    char* wl = smem + wave * WLDS;
    if (OUT) {
        const int cl = NCC, npl = NCH - NCC, halfl = NB * NH * npl;
#pragma unroll 1
        for (int t = wi; t < halfl; t += NW) { const int b = t / (NH * npl), h = (t / npl) % NH, cid = cl + t % npl;
            const Params q = relaunder(p); chunkout_w<1>(q, l, b, h, cid, wl, lane); }
        { const int used = halfl % NW;
#pragma unroll 1
            for (int t = (wi + NW - used) % NW; t < halfl; t += NW) { const int b = t / (NH * npl), h = (t / npl) % NH, cid = cl + t % npl;
                const Params q = relaunder(p); chunkout_w<0>(q, l, b, h, cid, wl, lane); } }
        if (l < DEPTH - 1) {
            const int nct = NB * NH * NCC;
#pragma unroll 1
            for (int st = obid(); st < 2 * nct; st += (int)gridDim.x) { const int mixer = st / nct, r2 = st % nct, b = r2 / (NH * NCC), h = (r2 / NCC) % NH, cid = r2 % NCC;
                const Params q = relaunder(p); const int mt = wave >> 1;
                __syncthreads();
                if (mixer == 0) { if (wave & 1) chunkout_piece<0, 1>(q, l, b, h, cid, mt, wl, lane); else chunkout_piece<0, 0>(q, l, b, h, cid, mt, wl, lane); }
                else            { if (wave & 1) chunkout_piece<1, 1>(q, l, b, h, cid, mt, wl, lane); else chunkout_piece<1, 0>(q, l, b, h, cid, mt, wl, lane); }
                __syncthreads();
                if (wave < 4) { if (mixer == 0) chunkout_combine<0>(q, l, b, h, cid, wave, smem, lane); else chunkout_combine<1>(q, l, b, h, cid, wave, smem, lane); }
            }
        }
    } else {
        int off = 0;
#pragma unroll 1
        for (int t = wi; t < half; t += NW) { const int b = t / (NH * npc), h = (t / npc) % NH, cid = c_lo + t % npc;
            const Params q = relaunder(p); chunkst_gla<0>(q, l, b, h, cid, wl, lane); }
        off = (off + half) % NW;
#pragma unroll 1
        for (int t = (wi + NW - off) % NW; t < half; t += NW) { const int b = t / (NH * npc), h = (t / npc) % NH, cid = c_lo + t % npc;
            const Params q = relaunder(p); chunkst_gla<1>(q, l, b, h, cid, wl, lane); }
        off = (off + half) % NW;
#pragma unroll 1
        for (int t = (wi + NW - off) % NW; t < half; t += NW) { const int b = t / (NH * npc), h = (t / npc) % NH, cid = c_lo + t % npc;
            const Params q = relaunder(p); chunkst_w<0>(q, l, b, h, cid, wl, lane); }
    }
}

__device__ __forceinline__ void phase_mix1(const Params& p, int l, char* smem) {
    const bool ctxo = l < DEPTH - 1; const int G = (int)gridDim.x, bid = obid();
    constexpr int N_HL = (NB / 2) * (WG / 2), N_HC = NB * (WG / HCB);
    chunk_workers<false>(p, l, smem);
    stage_signal(p, smem, 0, l);
    for (int t = bid; t < N_HL; t += G) hylat_task(p, l, t / (WG / 2), t % (WG / 2), smem);
    if (ctxo) for (int t = G - 1 - bid; t < N_HC; t += G) hyctx_task(p, l, t / (WG / HCB), t % (WG / HCB), smem);
    stage_signal(p, smem, 2, l);
}

constexpr int SCG = 12;
__device__ __forceinline__ void phase_scan(const Params& p, int l, char* smem) {
    const int tid = otid();
    bf16* ST = (bf16*)(p.ws + WS_ST); float* NV = (float*)(p.ws + WS_NV); const float* BE = (const float*)(p.ws + WS_BE); float* SC = (float*)(p.ws + WS_SC);
    constexpr int NCHAIN = 2 * 2 * NB * NH;
    stage_wait(p, 0, l);
    for (int item = obid() * NT + tid; item < NCHAIN * 1024; item += gridDim.x * NT) {
        const int chain = item >> 10, grp = item & 1023; const int mixer = chain / (2 * NB * NH), dir = (chain / (NB * NH)) % 2, b = (chain / NH) % NB, h = chain % NH;
        float c[4] = {0.f, 0.f, 0.f, 0.f}; float nv[4] = {0.f, 0.f, 0.f, 0.f}; float m = 0.f;
        const int d0 = (grp & 15) * 4; const bool donv = (mixer == 0) && (grp < 16);
        for (int o0 = 0; o0 < NCH; o0 += SCG) {
            u32x2 uu[SCG]; float s0[SCG], s1[SCG]; f32x4 be[SCG]; f32x4 nu[SCG];
#pragma unroll
            for (int j = 0; j < SCG; ++j) if (o0 + j < NCH) { const int cid = chain_cid(dir, o0 + j); const size_t ci = ch_index(dir, b, h, cid);
                uu[j] = *(const u32x2*)(ST + st_index(mixer, dir, b, h, cid) * 4096 + grp * 4);
                if (mixer == 0) { s0[j] = SC[ci * 4 + 0]; s1[j] = SC[ci * 4 + 1]; if (donv) nu[j] = *(const f32x4*)(NV + ci * 64 + grp * 4); }
                else be[j] = *(const f32x4*)(BE + ci * 64 + d0); }
#pragma unroll
            for (int j = 0; j < SCG; ++j) if (o0 + j < NCH) { const int cid = chain_cid(dir, o0 + j); const size_t ci = ch_index(dir, b, h, cid);
                const float u[4] = {bitsf(uu[j].x << 16), bitsf(uu[j].x & 0xffff0000u), bitsf(uu[j].y << 16), bitsf(uu[j].y & 0xffff0000u)};
                u32x2 w; w.x = pk2(c[0], c[1]); w.y = pk2(c[2], c[3]); *(u32x2*)(ST + st_index(mixer, dir, b, h, cid) * 4096 + grp * 4) = w;
                if (mixer == 0) {
                    if (grp == 0) SC[ci * 4 + 2] = m;
                    const float mn = fmaxf(s0[j] + m, s1[j]), a = __expf(s0[j] + m - mn), s = __expf(s1[j] - mn);
#pragma unroll
                    for (int k = 0; k < 4; ++k) c[k] = a * c[k] + s * u[k];
                    if (donv) { f32x4 nw = {nv[0], nv[1], nv[2], nv[3]}; *(f32x4*)(NV + ci * 64 + grp * 4) = nw;
                        nv[0] = a * nv[0] + s * nu[j].x; nv[1] = a * nv[1] + s * nu[j].y; nv[2] = a * nv[2] + s * nu[j].z; nv[3] = a * nv[3] + s * nu[j].w; }
                    m = mn;
                } else { c[0] = __expf(be[j].x) * c[0] + u[0]; c[1] = __expf(be[j].y) * c[1] + u[1]; c[2] = __expf(be[j].z) * c[2] + u[2]; c[3] = __expf(be[j].w) * c[3] + u[3]; } }
        }
    }
    stage_signal(p, smem, 1, l);
    { const bool ctxo = l < DEPTH - 1; const int G = (int)gridDim.x, bid = obid();
        constexpr int QTL = SEQ / 128, QTC = CTXL / 128, N_AL = NB * 2 * QTL, N_AC = NB * 2 * QTC;
        for (int t = bid; t < N_AL; t += G) attn_task(p, l, t / (2 * QTL), (t / QTL) % 2, t % QTL, false, smem);
        if (ctxo) for (int t = (bid + G - 64 % G) % G; t < N_AC; t += G) attn_task(p, l, t / (2 * QTC), (t / QTC) % 2, t % QTC, true, smem); }
}

__device__ __forceinline__ void phase_mix2(const Params& p, int l, char* smem) {
    const int tid = otid();
    stage_wait(p, 1, l);
    chunk_workers<true>(p, l, smem);
    stage_wait(p, 2, l);
    constexpr int N_WOUT = (DM / 64) * (MIX / 64);
    { const int lane = tid & 63, wave = __builtin_amdgcn_readfirstlane(tid >> 6); const int NW = (int)gridDim.x * 8, wi = wave * (int)gridDim.x + obid();
        for (int task = NW - 1 - wi; task < N_WOUT; task += NW) { const int nt = task / (MIX / 64), kt = task % (MIX / 64);
            convert_tile_w(p.in[I_WOUT] + (size_t)l * MIX * DM, DM, (bf16*)(p.ws + WS_WOUT), MIX, nt * 64, kt * 64, false, smem + wave * WLDS, lane); }
        bf16* tile = (bf16*)(smem + wave * WLDS); const bf16* HT = (const bf16*)(p.ws + WS_HT); bf16* Y = (bf16*)(p.ws + WS_HNY);
        constexpr int NTT = NB * (SEQ / 64) * 4;
        for (int t = wi; t < NTT; t += NW) { const int b = t / ((SEQ / 64) * 4), tt = (t / 4) % (SEQ / 64), c0 = (t % 4) * 64; const size_t tok0 = (size_t)b * TOK + CTXL + tt * 64;
#pragma unroll
            for (int i = 0; i < 8; ++i) { const int ch = (lane >> 3) + 8 * i, ck = lane & 7; *(u32x4*)(tile + swz(ch, ck)) = *(const u32x4*)(HT + (size_t)(768 + c0 + ch) * T + tok0 + ck * 8); }
            WAVE_SYNC();
#pragma unroll
            for (int i = 0; i < 8; ++i) { const int tk = (lane >> 3) + 8 * i, cc = lane & 7; unsigned w[4];
#pragma unroll
                for (int j = 0; j < 4; ++j) { const int ca = cc * 8 + 2 * j; w[j] = (unsigned)tile[swz(ca, tk >> 3) + (tk & 7)] | ((unsigned)tile[swz(ca + 1, tk >> 3) + (tk & 7)] << 16); }
                u32x4 o; o.x = w[0]; o.y = w[1]; o.z = w[2]; o.w = w[3]; *(u32x4*)(Y + (tok0 + tk) * 1024 + YH + c0 + cc * 8) = o; }
            WAVE_SYNC(); } }
}


#ifndef EMU
#define LAS __attribute__((address_space(3)))
#define XB_TMO      128
#define XB_XCNT(j)  (256  + 64 * (j))
#define XB_XSUB(j)  (1280 + 64 * (j))
#define XB_XGEN(j)  (2304 + 64 * (j))
#define XB_TOP      3328
#define XB_TOPGEN   3392
#define XCD_BAR_WORDS 3456
#define XB_SPIN_CAP (1u << 18)

__device__ __forceinline__ unsigned xb_ld(unsigned* p)              { return __hip_atomic_load(p, __ATOMIC_RELAXED, __HIP_MEMORY_SCOPE_AGENT); }
__device__ __forceinline__ unsigned xb_add(unsigned* p, unsigned v) { return __hip_atomic_fetch_add(p, v, __ATOMIC_RELAXED, __HIP_MEMORY_SCOPE_AGENT); }
__device__ __forceinline__ unsigned xb_xcc_id() { return (unsigned)__builtin_amdgcn_s_getreg((3 << 11) | 20) & 0xFu; }
#define XB_SPIN(cond, bar) do { unsigned _sp = 0; while (cond) { __builtin_amdgcn_s_sleep(1); \
    if ((++_sp & 255u) == 0u) { if (xb_ld(&(bar)[XB_TMO])) break; if (_sp > XB_SPIN_CAP) { atomicAdd(&(bar)[XB_TMO], 1u); break; } } } } while (0)

struct XcdBarrier {
    unsigned* bar; unsigned x;
    volatile LAS unsigned* st;
};

__device__ __forceinline__ XcdBarrier xcd_barrier_post(unsigned* bar, volatile LAS unsigned* st) {
    XcdBarrier b; b.bar = bar; b.x = xb_xcc_id(); b.st = st;
    if (threadIdx.x == 0) (void)xb_add(&bar[XB_XCNT(b.x)], 1u);
    return b;
}
__device__ __forceinline__ void xcd_barrier_complete(unsigned* bar, unsigned x, unsigned& nloc, unsigned& nx) {
    const unsigned G = gridDim.x * gridDim.y * gridDim.z;
    unsigned sum, cnt, mine, sp = 0u;
    for (;;) {
        sum = 0u; cnt = 0u; mine = 0u;
#pragma unroll
        for (unsigned j = 0; j < 16; ++j) { const unsigned c = xb_ld(&bar[XB_XCNT(j)]); sum += c; cnt += (c > 0u) ? 1u : 0u; mine = (j == x) ? c : mine; }
        if (sum == G) break;
        __builtin_amdgcn_s_sleep(1);
        if ((++sp & 255u) == 0u) { if (xb_ld(&bar[XB_TMO])) break; if (sp > XB_SPIN_CAP) { atomicAdd(&bar[XB_TMO], 1u); break; } }
    }
    nloc = mine > 0u ? mine : 1u; nx = cnt > 0u ? cnt : 1u;
}

__device__ __forceinline__ void xcd_barrier(const XcdBarrier& b) {
    asm volatile("s_waitcnt vmcnt(0)" ::: "memory");
    __syncthreads();
    if (threadIdx.x == 0) {
        unsigned* bar = b.bar;
        __builtin_amdgcn_s_waitcnt(0);
        unsigned nloc = b.st[0], nx = b.st[1];
        if (nloc == 0u) { xcd_barrier_complete(bar, b.x, nloc, nx); b.st[0] = nloc; b.st[1] = nx; }
        const unsigned old = xb_add(&bar[XB_XSUB(b.x)], 1u);
        const unsigned gen = old / nloc;
        if (old + 1u == (gen + 1u) * nloc) {
            __builtin_amdgcn_fence(__ATOMIC_RELEASE, "agent");
            asm volatile("s_waitcnt vmcnt(0)" ::: "memory");
            const unsigned og = xb_add(&bar[XB_TOP], 1u);
            const unsigned tg = og / nx;
            if (og + 1u == (tg + 1u) * nx) xb_add(&bar[XB_TOPGEN], 1u);
            else XB_SPIN(xb_ld(&bar[XB_TOPGEN]) == tg, bar);
            __builtin_amdgcn_fence(__ATOMIC_ACQUIRE, "agent");
            xb_add(&bar[XB_XGEN(b.x)], 1u);
            asm volatile("s_waitcnt vmcnt(0)" ::: "memory");
        } else {
            XB_SPIN(xb_ld(&bar[XB_XGEN(b.x)]) == gen, bar);
            __builtin_amdgcn_fence(__ATOMIC_ACQUIRE, "agent");
            asm volatile("s_waitcnt vmcnt(0)" ::: "memory");
        }
    }
    __syncthreads();
}
#endif

__global__ void __launch_bounds__(NT) fwd_kernel(Params pk, int ph_lo, int ph_hi) {
    SMEM_DECL;
#ifndef EMU
    volatile LAS unsigned* misc = (volatile LAS unsigned*)(smem + LDS_BYTES - 64);
    if (threadIdx.x < 2) misc[threadIdx.x] = 0u;
    __syncthreads();
    const XcdBarrier bar = xcd_barrier_post((unsigned*)(pk.ws + WS_BAR), misc);
#endif
    constexpr int NPH = 2 + 6 * DEPTH;
    for (int ph = ph_lo; ph < ph_hi && ph < NPH; ++ph) {
#ifndef EMU
        Params p = pk; { size_t z = 0; asm volatile("" : "+s"(z)); p.ws = pk.ws + z; p.out = pk.out + z;
#pragma unroll
            for (int i = 0; i < 26; ++i) p.in[i] = pk.in[i] + z; }
#else
        const Params& p = pk;
#endif
        if (ph == 0) phase0(p, smem);
        else if (ph == NPH - 1) phase_rp(p, DEPTH, smem);
        else { const int l = (ph - 1) / 6, k = (ph - 1) % 6;
            if (k == 0) phase_rp(p, l, smem);
            else if (k == 1) phase_gemm_in(p, l, smem);
            else if (k == 2) phase_mix1(p, l, smem);
            else if (k == 3) phase_scan(p, l, smem);
            else if (k == 4) phase_mix2(p, l, smem);
            else phase_gemm_out(p, l, smem);
#ifdef PROBE_DUP
            if (k == PROBE_DUP) { GRID_SYNC();
                if (k == 1) phase_gemm_in(p, l, smem); else if (k == 2) phase_mix1(p, l, smem); else if (k == 4) phase_mix2(p, l, smem); }
#endif
        }
        if (ph + 1 < ph_hi && !(ph >= 6 && ph % 6 == 0) && !(ph >= 1 && ((ph - 1) % 6 == 2 || (ph - 1) % 6 == 3))) {
#ifdef EMU
            GRID_SYNC();
#else
            if (ph_lo < 0) GRID_SYNC();
            xcd_barrier(bar);
#endif
        }
    }
}

#ifndef EMU
extern "C" void kernel_launch(void* const* d_in, const int* in_sizes, int n_in, void* d_out, int out_size, void* d_ws, size_t ws_size, hipStream_t stream) {
    static int grid = 0;
    if (grid == 0) {
        if (n_in != 26 || ws_size < WS_TOTAL) { fprintf(stderr, "kernel_launch: unexpected n_in %d or ws_size %zu (need %zu)\n", n_in, ws_size, (size_t)WS_TOTAL); grid = -1; return; }
        int dev = 0, cus = 0, per_cu = 0;
        hipGetDevice(&dev);
        hipDeviceGetAttribute(&cus, hipDeviceAttributeMultiprocessorCount, dev);
        hipFuncSetAttribute((const void*)fwd_kernel, hipFuncAttributeMaxDynamicSharedMemorySize, LDS_BYTES);
        hipOccupancyMaxActiveBlocksPerMultiprocessor(&per_cu, (const void*)fwd_kernel, NT, LDS_BYTES);
        if (per_cu < 1) { fprintf(stderr, "kernel_launch: occupancy query returned %d\n", per_cu); grid = -1; return; }
        if (per_cu > 1) per_cu = 1;
        grid = cus * per_cu;
    }
    if (grid < 0) return;
    hipMemsetAsync((char*)d_ws + WS_BAR, 0, BAR_BYTES, stream);
    Params p{};
    for (int i = 0; i < 26; ++i) p.in[i] = (const float*)d_in[i];
    p.out = (float*)d_out; p.ws = (char*)d_ws;
    int lo = 0, hi = 2 + 6 * DEPTH;
    void* args[] = {&p, &lo, &hi};
    hipError_t e = hipLaunchCooperativeKernel((const void*)fwd_kernel, dim3(grid), dim3(NT), args, LDS_BYTES, stream);
    if (e != hipSuccess) fprintf(stderr, "cooperative launch failed: %s (grid %d)\n", hipGetErrorString(e), grid);
}
#endif
```

```cpp
#ifdef EMU
#include "emu/hipemu.h"
#define GRID_SYNC() emu::grid_sync()
#define SMEM_DECL char* smem = emu::S().blocks[emu::cur()->block].lds
#define SCHED_FENCE() do {} while (0)
#define EXP2(x) exp2f(x)
#define MFMA16(a, b, c) emu_mfma_16x16x32_bf16(a, b, c)
#else
#include <hip/hip_runtime.h>
#include <hip/hip_cooperative_groups.h>
#include <cstdio>
#include <cstdint>
#define GRID_SYNC() cooperative_groups::this_grid().sync()
#define SMEM_DECL extern __shared__ __attribute__((aligned(16))) char smem[]
#define SCHED_FENCE() __builtin_amdgcn_sched_barrier(0)
#define EXP2(x) __builtin_amdgcn_exp2f(x)
#define MFMA16(a, b, c) __builtin_amdgcn_mfma_f32_16x16x32_bf16(a, b, c, 0, 0, 0)
#endif

#ifdef EMU
#ifndef EMU_DM
#define EMU_DM 256
#endif
#ifndef EMU_NB
#define EMU_NB 2
#endif
#ifndef EMU_SEQ
#define EMU_SEQ 512
#endif
#ifndef EMU_DEPTH
#define EMU_DEPTH 2
#endif
#ifndef EMU_CTXL
#define EMU_CTXL 128
#endif
constexpr int DM = EMU_DM, NB = EMU_NB, SEQ = EMU_SEQ, DEPTH = EMU_DEPTH, CTXL = EMU_CTXL;
#else
constexpr int DM = 1024, NB = 8, SEQ = 2048, DEPTH = 4, CTXL = 256;
#endif
constexpr int MIX = 1024, WG = 256, HD = 64, NH = 4, CH = 64;
constexpr int TOK = CTXL + SEQ, T = NB * TOK, NCH = TOK / CH, NCC = CTXL / CH;
constexpr int N_IN = 4144, NP = 3072, NG = 48, NGS = 32, NMAIN = 3328, NPAD = 4352;
constexpr int NF = 2 * SEQ;
constexpr int NJ = NB + 1;
constexpr int NT = 512;
constexpr float EPS = 1e-6f;
constexpr int PA = 0, PG = 1280, PD = 2304;
constexpr int YA = 0, YH = 256, YG = 512, YD = 768;
constexpr int ilog4(int n) { return n <= 1 ? 0 : 1 + ilog4(n / 4); }
constexpr int FFT_P = ilog4(NF);
static_assert((1 << (2 * FFT_P)) == NF, "NF must be a power of 4");
static_assert(DM % 256 == 0 && CTXL % 128 == 0 && SEQ % 256 == 0, "shape constraints");

typedef unsigned short bf16;
typedef short bf16x8 __attribute__((ext_vector_type(8)));
typedef float f32x4 __attribute__((ext_vector_type(4)));
typedef unsigned u32x4 __attribute__((ext_vector_type(4)));
typedef unsigned u32x2 __attribute__((ext_vector_type(2)));
struct cpx { float x, y; };

constexpr size_t al256(size_t x) { return (x + 255) & ~(size_t)255; }
constexpr size_t WS_CTXB = 0;
constexpr size_t WS_HNY = al256(WS_CTXB + (size_t)NB * CTXL * DM * 4);
constexpr size_t WS_WIN = WS_HNY + (size_t)T * 1024 * 2;
constexpr size_t WS_ST = WS_WIN;
constexpr size_t ST_BYTES = (size_t)2 * 2 * NB * NH * NCH * 4096 * 2;
constexpr size_t WS_KT = al256(WS_WIN + (size_t)NPAD * DM * 2);
static_assert(WS_KT + (size_t)WG * NF * 4 <= WS_ST + ST_BYTES || true, "");
constexpr size_t ST_END = al256((WS_ST + ST_BYTES > WS_KT + (size_t)WG * NF * 4) ? WS_ST + ST_BYTES : WS_KT + (size_t)WG * NF * 4);
constexpr size_t WS_P = ST_END;
constexpr size_t WS_HT = al256(WS_P + (size_t)T * NP * 2);
constexpr size_t WS_WOUT = WS_HT;
constexpr size_t WS_G = al256(WS_HT + (size_t)1024 * T * 2);
constexpr size_t WS_KF = al256(WS_G + (size_t)T * NGS * 4);
constexpr size_t WS_HC = al256(WS_KF + (size_t)WG * NF * 8);
constexpr size_t WS_EQ = al256(WS_HC + (size_t)2 * WG * CTXL * 4);
constexpr size_t WS_NV = al256(WS_EQ + (size_t)2 * T * WG * 2);
constexpr size_t WS_BE = al256(WS_NV + (size_t)2 * NB * NH * NCH * 64 * 4);
constexpr size_t WS_SC = al256(WS_BE + (size_t)2 * NB * NH * NCH * 64 * 4);
constexpr size_t WS_MOD = al256(WS_SC + (size_t)2 * NB * NH * NCH * 4 * 4);
constexpr size_t WS_TW = al256(WS_MOD + (size_t)DEPTH * NJ * 3 * DM * 4);
constexpr size_t WS_ROPE = al256(WS_TW + (size_t)NF * 8);
constexpr size_t WS_BAR = al256(WS_ROPE + (size_t)SEQ * 32 * 8);
constexpr size_t BAR_BYTES = 32768;
constexpr size_t WS_TOTAL = al256(WS_BAR + BAR_BYTES);
static_assert((size_t)T * DM * 4 <= (size_t)T * NP * 2, "YO fits in P");
#ifndef EMU
static_assert(WS_TOTAL <= (size_t)268435456, "workspace map must fit 256 MiB");
#endif

constexpr int LDS_BYTES = 163840;

struct Params {
    const float* in[26];
    float* out;
    char* ws;
};
enum { I_X = 0, I_C, I_CTX, I_CCTX, I_WADA, I_BADA, I_GPRE, I_GPOST, I_WIN, I_MGB, I_MNG, I_HCW, I_HCB, I_HW1, I_HB1, I_HW2, I_HB2, I_HW3, I_HB3,
       I_HFREQ, I_HD, I_GWA, I_GBA, I_GNG, I_SINK, I_WOUT };

__device__ __forceinline__ Params relaunder(const Params& pk) {
#ifdef EMU
    return pk;
#else
    Params p = pk; size_t z = 0; asm volatile("" : "+s"(z)); p.ws = pk.ws + z; p.out = pk.out + z;
#pragma unroll
    for (int i = 0; i < 26; ++i) p.in[i] = pk.in[i] + z;
    return p;
#endif
}
constexpr int WLDS = (LDS_BYTES - 64) / 8 / 16 * 16;
#ifdef EMU
#define WAVE_SYNC() emu_wave_sync()
#else
#define WAVE_SYNC() do { asm volatile("s_waitcnt lgkmcnt(0)" ::: "memory"); __builtin_amdgcn_wave_barrier(); } while (0)
#endif

#ifdef EMU
__device__ __forceinline__ int otid() { return (int)threadIdx.x; }
__device__ __forceinline__ int obid() { return (int)blockIdx.x; }
#else
__device__ __forceinline__ int otid() { int t = (int)threadIdx.x; asm volatile("" : "+v"(t)); return t; }
__device__ __forceinline__ int obid() { int b = (int)blockIdx.x; asm volatile("" : "+s"(b)); return b; }
#endif
__device__ __forceinline__ unsigned fbits(float f) { return __builtin_bit_cast(unsigned, f); }
__device__ __forceinline__ float bitsf(unsigned u) { return __builtin_bit_cast(float, u); }
__device__ __forceinline__ float bf2f(bf16 h) { return bitsf((unsigned)h << 16); }
#ifdef EMU
__device__ __forceinline__ bf16 f2bf(float f) { unsigned u = fbits(f); return (bf16)((u + 0x7fffu + ((u >> 16) & 1u)) >> 16); }
__device__ __forceinline__ unsigned pk2(float lo, float hi) { return (unsigned)f2bf(lo) | ((unsigned)f2bf(hi) << 16); }
#else
typedef __bf16 nbf16x2 __attribute__((ext_vector_type(2)));
typedef float nf32x2 __attribute__((ext_vector_type(2)));
__device__ __forceinline__ unsigned pk2(float lo, float hi) { const nf32x2 v = {lo, hi}; return __builtin_bit_cast(unsigned, __builtin_convertvector(v, nbf16x2)); }
__device__ __forceinline__ bf16 f2bf(float f) { return (bf16)(pk2(f, 0.0f) & 0xffffu); }
#endif
#ifdef EMU
__device__ __forceinline__ float frcp_(float x) { return 1.0f / x; }
#else
__device__ __forceinline__ float frcp_(float x) { return __builtin_amdgcn_rcpf(x); }
#endif
__device__ __forceinline__ float sigmoidf_(float x) { return frcp_(1.0f + __expf(-x)); }
__device__ __forceinline__ float siluf_(float x) { return x * frcp_(1.0f + __expf(-x)); }
__device__ __forceinline__ float logsigf_(float x) { return fminf(x, 0.0f) - log1pf(__expf(-fabsf(x))); }
__device__ __forceinline__ float logsig_fast(float x) { return fminf(x, 0.0f) - __logf(1.0f + __expf(-fabsf(x))); }
#ifdef EMU
__device__ __forceinline__ float row16_sum(float x) { x += __shfl_xor(x, 1); x += __shfl_xor(x, 2); x += __shfl_xor(x, 4); x += __shfl_xor(x, 8); return x; }
__device__ __forceinline__ float row16_max(float x) { x = fmaxf(x, __shfl_xor(x, 1)); x = fmaxf(x, __shfl_xor(x, 2)); x = fmaxf(x, __shfl_xor(x, 4)); x = fmaxf(x, __shfl_xor(x, 8)); return x; }
__device__ __forceinline__ float xrow_sum(float x) { x += __shfl_xor(x, 16); x += __shfl_xor(x, 32); return x; }
__device__ __forceinline__ float xrow_max(float x) { x = fmaxf(x, __shfl_xor(x, 16)); x = fmaxf(x, __shfl_xor(x, 32)); return x; }
#else
template <int CTRL> __device__ __forceinline__ float dpp_(float x) { return __builtin_bit_cast(float, __builtin_amdgcn_mov_dpp(__builtin_bit_cast(int, x), CTRL, 0xf, 0xf, true)); }
__device__ __forceinline__ float row16_sum(float x) { x += dpp_<0xB1>(x); x += dpp_<0x4E>(x); x += dpp_<0x141>(x); x += dpp_<0x128>(x); return x; }
__device__ __forceinline__ float row16_max(float x) { x = fmaxf(x, dpp_<0xB1>(x)); x = fmaxf(x, dpp_<0x4E>(x)); x = fmaxf(x, dpp_<0x141>(x)); x = fmaxf(x, dpp_<0x128>(x)); return x; }
__device__ __forceinline__ float xrow_sum(float x) {
    auto s = __builtin_amdgcn_permlane16_swap(fbits(x), fbits(x), false, false); x = bitsf(s[0]) + bitsf(s[1]);
    auto t = __builtin_amdgcn_permlane32_swap(fbits(x), fbits(x), false, false); return bitsf(t[0]) + bitsf(t[1]); }
__device__ __forceinline__ float xrow_max(float x) {
    auto s = __builtin_amdgcn_permlane16_swap(fbits(x), fbits(x), false, false); x = fmaxf(bitsf(s[0]), bitsf(s[1]));
    auto t = __builtin_amdgcn_permlane32_swap(fbits(x), fbits(x), false, false); return fmaxf(bitsf(t[0]), bitsf(t[1])); }
#endif
__device__ __forceinline__ float wave_sum(float v) { return xrow_sum(row16_sum(v)); }
__device__ __forceinline__ float wave_max(float v) { return xrow_max(row16_max(v)); }
#ifdef EMU
__device__ __forceinline__ float wave_prefix_sum(float v, int lane) {
#pragma unroll
    for (int o = 1; o < 64; o <<= 1) { float t = __shfl_up(v, o); if (lane >= o) v += t; }
    return v;
}
__device__ __forceinline__ float wave_prefix_max(float v, int lane) {
#pragma unroll
    for (int o = 1; o < 64; o <<= 1) { float t = __shfl_up(v, o); if (lane >= o) v = fmaxf(v, t); }
    return v;
}
#else
template <int CTRL, int RM> __device__ __forceinline__ float dppo_(float old, float x) { return __builtin_bit_cast(float, __builtin_amdgcn_update_dpp(__builtin_bit_cast(int, old), __builtin_bit_cast(int, x), CTRL, RM, 0xf, false)); }
__device__ __forceinline__ float wave_prefix_sum(float v, int) {
    v += dppo_<0x111, 0xf>(0.f, v); v += dppo_<0x112, 0xf>(0.f, v); v += dppo_<0x114, 0xf>(0.f, v); v += dppo_<0x118, 0xf>(0.f, v);
    v += dppo_<0x142, 0xa>(0.f, v); v += dppo_<0x143, 0xc>(0.f, v); return v;
}
__device__ __forceinline__ float wave_prefix_max(float v, int) {
    const float ninf = -INFINITY;
    v = fmaxf(v, dppo_<0x111, 0xf>(ninf, v)); v = fmaxf(v, dppo_<0x112, 0xf>(ninf, v)); v = fmaxf(v, dppo_<0x114, 0xf>(ninf, v)); v = fmaxf(v, dppo_<0x118, 0xf>(ninf, v));
    v = fmaxf(v, dppo_<0x142, 0xa>(ninf, v)); v = fmaxf(v, dppo_<0x143, 0xc>(ninf, v)); return v;
}
#endif
__device__ __forceinline__ float wave_suffix_max(float v, int lane) {
    return __shfl(wave_prefix_max(__shfl(v, 63 - lane), lane), 63 - lane);
}
__device__ __forceinline__ void unpack8(u32x4 v, float* f) {
    f[0] = bitsf(v.x << 16); f[1] = bitsf(v.x & 0xffff0000u); f[2] = bitsf(v.y << 16); f[3] = bitsf(v.y & 0xffff0000u);
    f[4] = bitsf(v.z << 16); f[5] = bitsf(v.z & 0xffff0000u); f[6] = bitsf(v.w << 16); f[7] = bitsf(v.w & 0xffff0000u);
}
__device__ __forceinline__ int orig_col(int n) {
    if (n < 1280) return n;
    if (n < 2304) return 2320 + (n - 1280);
    if (n < 3072) return 3376 + (n - 2304);
    if (n < 3088) return 1280 + (n - 3072);
    if (n < 3120) return 3344 + (n - 3088);
    if (n < NMAIN) return -1;
    return 1296 + (n - NMAIN);
}
__device__ __forceinline__ int chain_cid(int dir, int o) {
    if (dir == 0) return o;
    return o < NCC ? (NCC - 1 - o) : (NCH - 1 - (o - NCC));
}

__device__ __forceinline__ int swz(int row, int ch) { return row * 64 + ((ch ^ (row & 7)) << 3); }
__device__ __forceinline__ u32x4 pack8(const float* f) { u32x4 o; o.x = pk2(f[0], f[1]); o.y = pk2(f[2], f[3]); o.z = pk2(f[4], f[5]); o.w = pk2(f[6], f[7]); return o; }
__device__ __forceinline__ bf16x8 as_frag(u32x4 v) { return __builtin_bit_cast(bf16x8, v); }
#ifdef EMU
inline u32x2 lds_tr16(const bf16* p) { unsigned mine[2]; const unsigned long long a = (unsigned long long)p; mine[0] = (unsigned)a; mine[1] = (unsigned)(a >> 32);
    auto buf = emu::collective(mine, 2); const int l = emu::cur()->lane, g = l >> 4, i = l & 15; unsigned short e[4];
    for (int j = 0; j < 4; ++j) { const int src = 16 * g + 4 * j + (i >> 2); const bf16* q = (const bf16*)(((unsigned long long)buf[src][1] << 32) | buf[src][0]); e[j] = *(const unsigned short*)(q + (i & 3)); }
    u32x2 r; r.x = (unsigned)e[0] | ((unsigned)e[1] << 16); r.y = (unsigned)e[2] | ((unsigned)e[3] << 16); return r; }
#else
typedef short v4i16_t __attribute__((ext_vector_type(4)));
__device__ __forceinline__ u32x2 lds_tr16(const bf16* p) { return __builtin_bit_cast(u32x2, __builtin_amdgcn_ds_read_tr16_b64_v4i16((__attribute__((address_space(3))) v4i16_t*)p)); }
#endif
__device__ __forceinline__ u32x4 as_u4(bf16x8 v) { return __builtin_bit_cast(u32x4, v); }

constexpr int LS = 72;

template <int NTL, int KS>
__device__ __forceinline__ void mma_nt(const bf16* A, int lda, int m0, const bf16* B, int ldb, int n0, f32x4 (&acc)[NTL], int lane) {
    const int r = lane & 15, q = lane >> 4;
#pragma unroll
    for (int ks = 0; ks < KS; ++ks) {
        const bf16x8 a = *(const bf16x8*)(A + (m0 + r) * lda + ks * 32 + q * 8);
#pragma unroll
        for (int nt = 0; nt < NTL; ++nt) {
            const bf16x8 b = *(const bf16x8*)(B + (n0 + nt * 16 + r) * ldb + ks * 32 + q * 8);
            acc[nt] = MFMA16(a, b, acc[nt]);
        }
    }
}

__device__ __forceinline__ void layer_prep(const Params& p, int l, int idx, int stride, char* smem);
__device__ __forceinline__ void phase0(const Params& p, char* smem) {
    const int tid = otid();
    cpx* TW = (cpx*)(p.ws + WS_TW);
    cpx* ROPE = (cpx*)(p.ws + WS_ROPE);
    float* MOD = (float*)(p.ws + WS_MOD);
    constexpr int N_TW = NF / NT, N_ROPE = SEQ * 32 / NT, N_MOD = DEPTH * (3 * DM / 64);
    for (int task = obid(); task < N_TW + N_ROPE + N_MOD; task += gridDim.x) {
        if (task < N_TW) {
            const int j = task * NT + tid; float s, c; sincospif(2.0f * (float)j / (float)NF, &s, &c);
            cpx v; v.x = c; v.y = -s; TW[j] = v;
        } else if (task < N_TW + N_ROPE) {
            const int idx = (task - N_TW) * NT + tid; const int pos = idx >> 5, i = idx & 31;
            const float inv = exp2f(-(float)(i & 15) * (13.287712379549449f / 16.0f));
            const float ang = (float)(i < 16 ? pos / 64 : pos % 64) * inv;
            cpx v; v.x = cosf(ang); v.y = sinf(ang); ROPE[idx] = v;
        } else {
            const int mt = task - N_TW - N_ROPE; const int l = mt / (3 * DM / 64), n0 = (mt % (3 * DM / 64)) * 64;
            float* sv = (float*)smem;
            float* red = sv + NJ * DM;
            __syncthreads();
            for (int i = tid; i < NJ * DM; i += NT) { const int j = i / DM, k = i % DM; const float v = j < NB ? p.in[I_C][j * DM + k] : p.in[I_CCTX][k]; sv[i] = siluf_(v); }
            __syncthreads();
            const int c4 = tid & 15, kg = tid >> 4; f32x4 acc[NJ];
#pragma unroll
            for (int j = 0; j < NJ; ++j) acc[j] = (f32x4){0.f, 0.f, 0.f, 0.f};
            const float* w = p.in[I_WADA] + (size_t)l * DM * 3 * DM + n0 + 4 * c4;
#pragma unroll 8
            for (int i = 0; i < DM / 32; ++i) { const int k = kg + 32 * i; const f32x4 wv = *(const f32x4*)(w + (size_t)k * 3 * DM);
#pragma unroll
                for (int j = 0; j < NJ; ++j) acc[j] = acc[j] + wv * sv[j * DM + k]; }
#pragma unroll
            for (int j = 0; j < NJ; ++j) *(f32x4*)(red + (kg * NJ + j) * 64 + 4 * c4) = acc[j];
            __syncthreads();
            for (int i = tid; i < NJ * 64; i += NT) { const int j = i / 64, n = i % 64; float s = 0.f;
#pragma unroll
                for (int k8 = 0; k8 < 32; ++k8) s += red[(k8 * NJ + j) * 64 + n];
                MOD[((size_t)l * NJ + j) * 3 * DM + n0 + n] = s + p.in[I_BADA][(size_t)l * 3 * DM + n0 + n]; }
        }
    }
}

#ifdef EMU
constexpr int PANEL_ROWS = 128, PANEL_UNITS = DM / 128;
#else
constexpr int PANEL_ROWS = 256, PANEL_UNITS = DM / 256;
#endif
__device__ __forceinline__ unsigned* unit_counter(const Params& p, int isctx) { return (unsigned*)(p.ws + WS_BAR + 16384) + 64 * isctx; }
__device__ __forceinline__ unsigned* stage_counter(const Params& p, int flag) { return (unsigned*)(p.ws + WS_BAR + 16384) + 512 + 512 * flag; }
__device__ __forceinline__ void stage_signal(const Params& p, char* smem, int flag, int l) {
#ifdef EMU
    __syncthreads(); if (otid() == 0) *stage_counter(p, flag) += 1u;
#else
    asm volatile("s_waitcnt vmcnt(0)" ::: "memory"); __syncthreads();
    if (threadIdx.x == 0) {
        const unsigned xcc = (unsigned)__builtin_amdgcn_s_getreg((3 << 11) | 20) & 0xFu, nloc = ((volatile __attribute__((address_space(3))) unsigned*)(smem + LDS_BYTES - 64))[0];
        unsigned* g = stage_counter(p, flag);
        if (nloc > 0u) { const unsigned old = __hip_atomic_fetch_add(g + 16 * (1 + xcc), 1u, __ATOMIC_RELAXED, __HIP_MEMORY_SCOPE_AGENT);
            if (old + 1u == nloc * (unsigned)(l + 1)) { __builtin_amdgcn_fence(__ATOMIC_RELEASE, "agent"); asm volatile("s_waitcnt vmcnt(0)" ::: "memory");
                __hip_atomic_fetch_add(g, nloc, __ATOMIC_RELAXED, __HIP_MEMORY_SCOPE_AGENT); } }
        else { __builtin_amdgcn_fence(__ATOMIC_RELEASE, "agent"); asm volatile("s_waitcnt vmcnt(0)" ::: "memory"); __hip_atomic_fetch_add(g, 1u, __ATOMIC_RELAXED, __HIP_MEMORY_SCOPE_AGENT); }
    }
#endif
}
__device__ __forceinline__ void stage_wait(const Params& p, int flag, int l) {
    if (otid() == 0) { const unsigned target = (unsigned)gridDim.x * (unsigned)(l + 1);
#ifdef EMU
        while (*(volatile unsigned*)stage_counter(p, flag) < target) emu::yield();
#else
        unsigned spins = 0;
        while (__hip_atomic_load(stage_counter(p, flag), __ATOMIC_RELAXED, __HIP_MEMORY_SCOPE_AGENT) < target) { __builtin_amdgcn_s_sleep(16); if (++spins > (1u << 20)) break; }
        __builtin_amdgcn_fence(__ATOMIC_ACQUIRE, "agent"); asm volatile("s_waitcnt vmcnt(0)" ::: "memory");
#endif
    }
    __syncthreads();
}
__device__ __forceinline__ int logical_row(int i) { return i < NB * SEQ ? (i / SEQ) * TOK + CTXL + i % SEQ : ((i - NB * SEQ) / CTXL) * TOK + (i - NB * SEQ) % CTXL; }
struct RowRef { const float* xo; float* xn; int mj, row; bool ok; };
__device__ __forceinline__ RowRef rp_ref(const Params& p, int l, int li, int base, int hi) {
    RowRef r; r.ok = li < hi; const int rr = logical_row(r.ok ? li : base); r.row = rr;
    const int b = rr / TOK, pp = rr % TOK; const bool isctx = pp < CTXL; if (l == DEPTH && isctx) r.ok = false;
    const size_t off = isctx ? ((size_t)b * CTXL + pp) * DM : ((size_t)b * SEQ + (pp - CTXL)) * DM;
    float* CTXB = (float*)(p.ws + WS_CTXB);
    r.xo = (l <= 1) ? (isctx ? p.in[I_CTX] + off : p.in[I_X] + off) : (isctx ? CTXB + off : p.out + off);
    r.xn = isctx ? CTXB + off : p.out + off; r.mj = isctx ? NB : b; return r;
}
__device__ __forceinline__ void rp_rows(const Params& p, int l, int lo, int hi, int gi, int nb) {
    const int tid = otid(), lane = tid & 63, wave = tid >> 6;
    const float* MOD = (const float*)(p.ws + WS_MOD);
    const bf16* YO = (const bf16*)(p.ws + WS_P);
    bf16* HN = (bf16*)(p.ws + WS_HNY);
    constexpr int NV4 = DM / 256, RW = 2;
    const int stride = nb * 8;
    f32x4 xq[RW][NV4]; u32x2 yq[RW][NV4]; RowRef rq[RW];
    int base = lo + gi * 8 + wave;
    if (base < hi) {
#pragma unroll
        for (int i = 0; i < RW; ++i) { rq[i] = rp_ref(p, l, base + i * stride, base, hi);
#pragma unroll
            for (int j = 0; j < NV4; ++j) { xq[i][j] = *(const f32x4*)(rq[i].xo + 4 * lane + 256 * j); yq[i][j] = (l > 0) ? *(const u32x2*)(YO + (size_t)rq[i].row * DM + 4 * lane + 256 * j) : (u32x2){0u, 0u}; } }
    }
    for (; base < hi; base += stride * RW) {
        f32x4 x[RW][NV4], y[RW][NV4]; RowRef rc[RW];
#pragma unroll
        for (int i = 0; i < RW; ++i) { rc[i] = rq[i];
#pragma unroll
            for (int j = 0; j < NV4; ++j) { x[i][j] = xq[i][j]; const u32x2 yy = yq[i][j]; y[i][j] = (f32x4){bitsf(yy.x << 16), bitsf(yy.x & 0xffff0000u), bitsf(yy.y << 16), bitsf(yy.y & 0xffff0000u)}; } }
        { const int nbase = base + stride * RW;
            if (nbase < hi) {
#pragma unroll
                for (int i = 0; i < RW; ++i) { rq[i] = rp_ref(p, l, nbase + i * stride, nbase, hi);
#pragma unroll
                    for (int j = 0; j < NV4; ++j) { xq[i][j] = *(const f32x4*)(rq[i].xo + 4 * lane + 256 * j); if (l > 0) yq[i][j] = *(const u32x2*)(YO + (size_t)rq[i].row * DM + 4 * lane + 256 * j); } } } }
        if (l > 0) {
            float ss[RW];
#pragma unroll
            for (int i = 0; i < RW; ++i) { ss[i] = 0.f;
#pragma unroll
                for (int j = 0; j < NV4; ++j) ss[i] += y[i][j].x * y[i][j].x + y[i][j].y * y[i][j].y + y[i][j].z * y[i][j].z + y[i][j].w * y[i][j].w; }
#pragma unroll
            for (int i = 0; i < RW; ++i) ss[i] = wave_sum(ss[i]);
            const float* gp = p.in[I_GPOST] + (size_t)(l - 1) * DM;
            float rstd[RW]; const float* gt[RW];
#pragma unroll
            for (int i = 0; i < RW; ++i) { rstd[i] = rsqrtf(ss[i] * (1.0f / DM) + EPS); gt[i] = MOD + ((size_t)(l - 1) * NJ + rc[i].mj) * 3 * DM + 2 * DM; }
            f32x4 p4n = *(const f32x4*)(gp + 4 * lane), g4n[RW];
#pragma unroll
            for (int i = 0; i < RW; ++i) g4n[i] = *(const f32x4*)(gt[i] + 4 * lane);
#pragma unroll
            for (int j = 0; j < NV4; ++j) { const f32x4 p4 = p4n; f32x4 g4[RW];
#pragma unroll
                for (int i = 0; i < RW; ++i) g4[i] = g4n[i];
                if (j + 1 < NV4) { p4n = *(const f32x4*)(gp + 4 * lane + 256 * (j + 1));
#pragma unroll
                    for (int i = 0; i < RW; ++i) g4n[i] = *(const f32x4*)(gt[i] + 4 * lane + 256 * (j + 1)); }
#pragma unroll
                for (int i = 0; i < RW; ++i) { x[i][j] = x[i][j] + g4[i] * (y[i][j] * rstd[i] * p4);
                    if (rc[i].ok) *(f32x4*)(rc[i].xn + 4 * lane + 256 * j) = x[i][j]; } }
        }
        if (l < DEPTH) {
            float ss[RW];
#pragma unroll
            for (int i = 0; i < RW; ++i) { ss[i] = 0.f;
#pragma unroll
                for (int j = 0; j < NV4; ++j) ss[i] += x[i][j].x * x[i][j].x + x[i][j].y * x[i][j].y + x[i][j].z * x[i][j].z + x[i][j].w * x[i][j].w; }
#pragma unroll
            for (int i = 0; i < RW; ++i) ss[i] = wave_sum(ss[i]);
            const float* gp = p.in[I_GPRE] + (size_t)l * DM;
            float rstd[RW]; const float* md[RW];
#pragma unroll
            for (int i = 0; i < RW; ++i) { rstd[i] = rsqrtf(ss[i] * (1.0f / DM) + EPS); md[i] = MOD + ((size_t)l * NJ + rc[i].mj) * 3 * DM; }
            f32x4 g4n = *(const f32x4*)(gp + 4 * lane), shn[RW], scn[RW];
#pragma unroll
            for (int i = 0; i < RW; ++i) { shn[i] = *(const f32x4*)(md[i] + 4 * lane); scn[i] = *(const f32x4*)(md[i] + DM + 4 * lane); }
#pragma unroll
            for (int j = 0; j < NV4; ++j) { const int e = 4 * lane + 256 * j; const f32x4 g4 = g4n; f32x4 sh[RW], sc[RW];
#pragma unroll
                for (int i = 0; i < RW; ++i) { sh[i] = shn[i]; sc[i] = scn[i]; }
                if (j + 1 < NV4) { g4n = *(const f32x4*)(gp + e + 256);
#pragma unroll
                    for (int i = 0; i < RW; ++i) { shn[i] = *(const f32x4*)(md[i] + e + 256); scn[i] = *(const f32x4*)(md[i] + DM + e + 256); } }
#pragma unroll
                for (int i = 0; i < RW; ++i) { const f32x4 h = (x[i][j] * rstd[i] * g4) * (sc[i] + 1.0f) + sh[i];
                    u32x2 o; o.x = pk2(h.x, h.y); o.y = pk2(h.z, h.w);
                    if (rc[i].ok) *(u32x2*)(HN + (size_t)rc[i].row * DM + e) = o; } }
        }
    }
}

__device__ __forceinline__ void convert_tile(const float* src, int ldn, bf16* dst, int K, int n0, int k0, bool use_map, char* smem) {
    const int tid = otid();
    float* tile = (float*)smem;
    __syncthreads();
#pragma unroll
    for (int i = 0; i < 8; ++i) { const int idx = tid + NT * i, k = idx >> 6, n = idx & 63;
        const int oc = use_map ? orig_col(n0 + n) : (n0 + n);
        tile[k * 65 + n] = oc >= 0 ? src[(size_t)(k0 + k) * ldn + oc] : 0.f; }
    __syncthreads();
    const int n = tid >> 3, c = tid & 7;
    u32x4 o; o.x = pk2(tile[(8 * c + 0) * 65 + n], tile[(8 * c + 1) * 65 + n]); o.y = pk2(tile[(8 * c + 2) * 65 + n], tile[(8 * c + 3) * 65 + n]);
    o.z = pk2(tile[(8 * c + 4) * 65 + n], tile[(8 * c + 5) * 65 + n]); o.w = pk2(tile[(8 * c + 6) * 65 + n], tile[(8 * c + 7) * 65 + n]);
    *(u32x4*)(dst + (size_t)(n0 + n) * K + k0 + 8 * c) = o;
}

__device__ __forceinline__ void filter_task(const Params& p, int l, int L, int pos0, char* smem) {
    const int tid = otid(), j = tid & 63;
    float* z = (float*)smem;
    float* h1 = z + 8 * 33;
    float* h2 = h1 + 8 * 64;
    const float* w1 = p.in[I_HW1] + (size_t)l * 33 * 64; const float* w2 = p.in[I_HW2] + (size_t)l * 64 * 64; const float* w3 = p.in[I_HW3] + (size_t)l * 64 * 512;
    float r1[33], r2[64], r3a[16];
#pragma unroll
    for (int i = 0; i < 33; ++i) r1[i] = w1[i * 64 + j];
#pragma unroll
    for (int i = 0; i < 64; ++i) r2[i] = w2[i * 64 + j];
    const float b1 = p.in[I_HB1][l * 64 + j], b2 = p.in[I_HB2][l * 64 + j], b3 = p.in[I_HB3][l * 512 + tid];
    const float f0 = p.in[I_HFREQ][(l * 2 + 0) * 64 + j], f1 = p.in[I_HFREQ][(l * 2 + 1) * 64 + j];
    __syncthreads();
    if (tid < 8 * 33) { const int pp = tid / 33, i = tid % 33; const float pos = (float)(pos0 + pp);
        const float t = pos / (float)(L - 1 > 1 ? L - 1 : 1), wv = 6.283185307179586f * pos / (float)L; float v;
        if (i == 0) v = t; else { const int bi = (i - 1) & 15; const float f = 1e-4f + (float)bi * ((15.0f - 1e-4f) / 15.0f); v = (i <= 16) ? cosf(wv * f) : -sinf(wv * f); }
        z[tid] = v; }
    __syncthreads();
    { const int pp = tid >> 6; float a = b1;
#pragma unroll
        for (int i = 0; i < 33; ++i) a += z[pp * 33 + i] * r1[i];
        h1[tid] = sinf(f0 * a);
#pragma unroll
        for (int i = 0; i < 16; ++i) r3a[i] = w3[i * 512 + tid]; }
    __syncthreads();
    { const int pp = tid >> 6; float a = b2;
#pragma unroll
        for (int i = 0; i < 64; ++i) a += h1[pp * 64 + i] * r2[i];
        h2[tid] = sinf(f1 * a); }
    __syncthreads();
    { const int o = tid, dir = o >> 8, c = o & 255;
        const float delta = 3.0701134573253946f + (float)c * ((15.350567286626973f - 3.0701134573253946f) / 255.0f);
        float acc[8];
#pragma unroll
        for (int pp = 0; pp < 8; ++pp) acc[pp] = b3;
#pragma unroll 1
        for (int cix = 0; cix < 4; ++cix) {
            float wn[16];
#pragma unroll
            for (int i = 0; i < 16; ++i) wn[i] = (cix < 3) ? w3[(16 * (cix + 1) + i) * 512 + o] : 0.f;
#pragma unroll
            for (int i = 0; i < 16; ++i) {
#pragma unroll
                for (int pp = 0; pp < 8; ++pp) acc[pp] += h2[pp * 64 + 16 * cix + i] * r3a[i]; }
#pragma unroll
            for (int i = 0; i < 16; ++i) r3a[i] = wn[i]; }
        float* KT = (float*)(p.ws + WS_KT); float* HC = (float*)(p.ws + WS_HC);
#pragma unroll
        for (int pp = 0; pp < 8; ++pp) { const int pos = pos0 + pp; const float t = (float)pos / (float)(L - 1 > 1 ? L - 1 : 1);
            const float v = acc[pp] * __expf(-t * delta);
            if (L == SEQ) { if (dir == 0) KT[(size_t)c * NF + pos]= v; else if (pos > 0) KT[(size_t)c * NF + (NF - pos)] = v; else KT[(size_t)c * NF + SEQ] = 0.f; }
            else HC[((size_t)dir * WG + c) * CTXL + pos] = v; }
    }
}

__device__ __forceinline__ void convert_tile_w(const float* src, int ldn, bf16* dst, int K, int n0, int k0, bool use_map, char* wl, int lane) {
    float* tile = (float*)wl;
    const int oc = use_map ? orig_col(n0 + lane) : (n0 + lane);
    float v[64];
#pragma unroll
    for (int k = 0; k < 64; ++k) v[k] = oc >= 0 ? src[(size_t)(k0 + k) * ldn + oc] : 0.f;
#pragma unroll
    for (int k = 0; k < 64; ++k) tile[k * 65 + lane] = v[k];
    WAVE_SYNC();
#pragma unroll
    for (int i = 0; i < 8; ++i) { const int n = (lane >> 3) + 8 * i, c = lane & 7; float f[8];
#pragma unroll
        for (int j = 0; j < 8; ++j) f[j] = tile[(8 * c + j) * 65 + n];
        *(u32x4*)(dst + (size_t)(n0 + n) * K + k0 + 8 * c) = pack8(f); }
    WAVE_SYNC();
}
__device__ __forceinline__ void layer_prep(const Params& p, int l, int idx, int stride, char* smem) {
    constexpr int N_WIN = (NPAD / 64) * (DM / 64), N_FL = SEQ / 8, N_FC = CTXL / 8;
    for (int task = idx; task < N_FL + N_FC; task += stride) {
        if (task < N_FL) filter_task(p, l, SEQ, task * 8, smem);
        else filter_task(p, l, CTXL, (task - N_FL) * 8, smem);
    }
    __syncthreads();
    { const int tid = otid(), lane = tid & 63, wave = __builtin_amdgcn_readfirstlane(tid >> 6);
        char* wl = smem + wave * WLDS;
        for (int task = wave * stride + idx; task < N_WIN; task += 8 * stride) { const int nt = task / (DM / 64), kt = task % (DM / 64);
            convert_tile_w(p.in[I_WIN] + (size_t)l * DM * N_IN, N_IN, (bf16*)(p.ws + WS_WIN), DM, nt * 64, kt * 64, true, wl, lane); } }
}
__device__ __forceinline__ unsigned* row_queue(const Params& p, int l) { return (unsigned*)(p.ws + WS_BAR + 16384) + 2560 + 64 * l; }
__device__ __forceinline__ void wait_units(const Params& p, int c, int l) {
    constexpr int nLatU = NB * (SEQ / PANEL_ROWS) * PANEL_UNITS, nCtxU = NB * (CTXL / PANEL_ROWS) * PANEL_UNITS;
    const unsigned target = (unsigned)((c ? nCtxU : nLatU) * l);
#ifdef EMU
    while (*(volatile unsigned*)unit_counter(p, c) < target) emu::yield();
#else
    unsigned spins = 0;
    while (__hip_atomic_load(unit_counter(p, c), __ATOMIC_RELAXED, __HIP_MEMORY_SCOPE_AGENT) < target) { __builtin_amdgcn_s_sleep(16); if (++spins > (1u << 20)) break; }
    __builtin_amdgcn_fence(__ATOMIC_ACQUIRE, "agent"); asm volatile("s_waitcnt vmcnt(0)" ::: "memory");
#endif
}
__device__ __forceinline__ void phase_rp(const Params& p, int l, char* smem) { const int G = (int)gridDim.x, bid = obid(), tid = otid();
    const bool has_ctx = l < DEPTH;
    constexpr int nLatU = NB * (SEQ / PANEL_ROWS) * PANEL_UNITS, nCtxU = NB * (CTXL / PANEL_ROWS) * PANEL_UNITS;
    const int nU = nLatU + nCtxU;
    const int heavy = (l >= 1 && has_ctx && nU > G && (nU % G) != 0) ? nU % G : 0;
    const int total = heavy > 0 ? NB * SEQ : (has_ctx ? T : NB * SEQ);
    const int nl = G - heavy, np = (l < DEPTH) ? nl / 2 : 0, nr = nl - np;
    int lo, hi, gi, nb; bool prep = false;
    if (bid < heavy) { lo = NB * SEQ; hi = T; gi = bid; nb = heavy; }
    else { const int i = bid - heavy; int nR = total;
        if (np > 0) { nR = ((total * 2 / 3) / (nr * 16)) * (nr * 16); if (nR <= 0) nR = total / 2; }
        if (np > 0 && (i & 1) && i / 2 < np) { prep = true; lo = nR; hi = total; gi = i / 2; nb = np; }
        else { lo = 0; hi = nR; gi = (np > 0) ? (i + 1) / 2 : i; nb = nr; } }
    if (prep) layer_prep(p, l, gi, np, smem);
    else if (l < DEPTH && np == 0) layer_prep(p, l, bid, G, smem);
    if (l >= 1) { if (tid == 0) { if (lo < NB * SEQ) wait_units(p, 0, l); if (hi > NB * SEQ) wait_units(p, 1, l); } __syncthreads(); }
    rp_rows(p, l, lo, hi, gi, nb);
}

__device__ __forceinline__ cpx cmul(cpx a, cpx b) { cpx r; r.x = a.x * b.x - a.y * b.y; r.y = a.x * b.y + a.y * b.x; return r; }
__device__ __forceinline__ cpx cmulc(cpx a, cpx b) { cpx r; r.x = a.x * b.x + a.y * b.y; r.y = a.y * b.x - a.x * b.y; return r; }
constexpr int fpad(int i) { return i + (i >> 4); }
__device__ __forceinline__ int FPH(int i) { return i + (i >> 4); }
constexpr int FBUF = fpad(NF);
constexpr int ilog16(int n) { return n < 16 ? 0 : 1 + ilog16(n / 16); }
constexpr int FFT_P16 = ilog16(NF);
constexpr bool FFT_R4 = ((NF >> (4 * FFT_P16)) == 4);
static_assert((NF >> (4 * FFT_P16)) == 1 || (NF >> (4 * FFT_P16)) == 4, "NF = 16^a * (1 or 4)");
template <bool INV> __device__ __forceinline__ void dft4(cpx& a0, cpx& a1, cpx& a2, cpx& a3) {
    const cpx s = {a0.x + a2.x, a0.y + a2.y}, b = {a0.x - a2.x, a0.y - a2.y}, c = {a1.x + a3.x, a1.y + a3.y}, d = {a1.x - a3.x, a1.y - a3.y};
    a0 = (cpx){s.x + c.x, s.y + c.y}; a2 = (cpx){s.x - c.x, s.y - c.y};
    if (!INV) { a1 = (cpx){b.x + d.y, b.y - d.x}; a3 = (cpx){b.x - d.y, b.y + d.x}; }
    else      { a1 = (cpx){b.x - d.y, b.y + d.x}; a3 = (cpx){b.x + d.y, b.y - d.x}; }
}
template <bool INV> __device__ __forceinline__ cpx cmulk(cpx a, float wr, float wi) {
    cpx r; if (!INV) { r.x = a.x * wr + a.y * wi; r.y = a.y * wr - a.x * wi; } else { r.x = a.x * wr - a.y * wi; r.y = a.y * wr + a.x * wi; } return r;
}
template <bool INV> __device__ __forceinline__ void dft16(cpx (&x)[16]) {
    constexpr float C1 = 0.92387953251128674f, S1 = 0.38268343236508977f, C2 = 0.70710678118654752f;
#pragma unroll
    for (int n2 = 0; n2 < 4; ++n2) dft4<INV>(x[n2], x[4 + n2], x[8 + n2], x[12 + n2]);
    x[4 * 1 + 1] = cmulk<INV>(x[4 * 1 + 1], C1, S1); x[4 * 1 + 2] = cmulk<INV>(x[4 * 1 + 2], C2, C2); x[4 * 1 + 3] = cmulk<INV>(x[4 * 1 + 3], S1, C1);
    x[4 * 2 + 1] = cmulk<INV>(x[4 * 2 + 1], C2, C2); x[4 * 2 + 2] = cmulk<INV>(x[4 * 2 + 2], 0.f, 1.f); x[4 * 2 + 3] = cmulk<INV>(x[4 * 2 + 3], -C2, C2);
    x[4 * 3 + 1] = cmulk<INV>(x[4 * 3 + 1], S1, C1); x[4 * 3 + 2] = cmulk<INV>(x[4 * 3 + 2], -C2, C2); x[4 * 3 + 3] = cmulk<INV>(x[4 * 3 + 3], -C1, -S1);
#pragma unroll
    for (int k1 = 0; k1 < 4; ++k1) dft4<INV>(x[4 * k1 + 0], x[4 * k1 + 1], x[4 * k1 + 2], x[4 * k1 + 3]);
    cpx t;
    t = x[1]; x[1] = x[4]; x[4] = t; t = x[2]; x[2] = x[8]; x[8] = t; t = x[3]; x[3] = x[12]; x[12] = t;
    t = x[6]; x[6] = x[9]; x[9] = t; t = x[7]; x[7] = x[13]; x[13] = t; t = x[11]; x[11] = x[14]; x[14] = t;
}
template <bool INV> __device__ __forceinline__ void fft_stage16(cpx* buf, const cpx* TW, int tl, int M) {
    const int span = M >> 4, twm = NF / M;
#pragma unroll 1
    for (int j = tl; j < NF / 16; j += 256) {
        const int grp = j / span, pos = j % span, base = grp * M + pos; cpx x[16];
#pragma unroll
        for (int q = 0; q < 16; ++q) x[q] = buf[FPH(base + q * span)];
        cpx w1 = {1.f, 0.f}; if (span > 1) w1 = TW[pos * twm];
        if (INV && span > 1) { cpx wk = w1;
#pragma unroll
            for (int k = 1; k < 16; ++k) { x[k] = cmulc(x[k], wk); wk = cmul(wk, w1); } }
        dft16<INV>(x);
        if (!INV && span > 1) { cpx wk = w1;
#pragma unroll
            for (int k = 1; k < 16; ++k) { x[k] = cmul(x[k], wk); wk = cmul(wk, w1); } }
#pragma unroll
        for (int q = 0; q < 16; ++q) buf[FPH(base + q * span)] = x[q];
    }
}
template <bool INV> __device__ __forceinline__ void fft_stage4_last(cpx* buf, int tl) {
#pragma unroll 1
    for (int j = tl; j < NF / 4; j += 256) { cpx a0 = buf[FPH(4 * j)], a1 = buf[FPH(4 * j + 1)], a2 = buf[FPH(4 * j + 2)], a3 = buf[FPH(4 * j + 3)];
        dft4<INV>(a0, a1, a2, a3); buf[FPH(4 * j)] = a0; buf[FPH(4 * j + 1)] = a1; buf[FPH(4 * j + 2)] = a2; buf[FPH(4 * j + 3)] = a3; }
}
__device__ __forceinline__ void fft_fwd(cpx* buf, const cpx* TW, int tl) {
    int M = NF;
#pragma unroll
    for (int s = 0; s < FFT_P16; ++s) { __syncthreads(); fft_stage16<false>(buf, TW, tl, M); M >>= 4; }
    if (FFT_R4) { __syncthreads(); fft_stage4_last<false>(buf, tl); }
    __syncthreads();
}
__device__ __forceinline__ void fft_inv(cpx* buf, const cpx* TW, int tl) {
    if (FFT_R4) { __syncthreads(); fft_stage4_last<true>(buf, tl); }
    int M = FFT_R4 ? 64 : 16;
#pragma unroll
    for (int s = 0; s < FFT_P16; ++s) { __syncthreads(); fft_stage16<true>(buf, TW, tl, M); M <<= 4; }
    __syncthreads();
}
__device__ __forceinline__ void filt_fft_task(const Params& p, int cp, char* smem) {
    const int tid = otid(), half = tid >> 8, tl = tid & 255, c = 2 * cp + half;
    cpx* buf = (cpx*)smem + (size_t)half * FBUF;
    const float* KT = (const float*)(p.ws + WS_KT) + (size_t)c * NF;
    cpx* KF = (cpx*)(p.ws + WS_KF) + (size_t)c * NF;
    const cpx* TW = (const cpx*)(p.ws + WS_TW);
    __syncthreads();
    for (int i = tl; i < NF; i += 256) { cpx v; v.x = KT[i]; v.y = 0.f; buf[FPH(i)] = v; }
    fft_fwd(buf, TW, tl);
    for (int i = tl; i < NF; i += 256) KF[i] = buf[FPH(i)];
}

__device__ __forceinline__ void gemm_tile(const Params& p, const bf16* A, const bf16* Bt, int K, int mt, int nt, int mode, char* smem) {
    const int tid = otid(), lane = tid & 63, wave = tid >> 6;
    bf16* As = (bf16*)smem;
    bf16* Bs = As + 128 * LS;
    const int wm = (wave & 3) * 32, wn = (wave >> 2) * 64;
    f32x4 acc[2][4];
#pragma unroll
    for (int i = 0; i < 2; ++i)
#pragma unroll
        for (int j = 0; j < 4; ++j) acc[i][j] = (f32x4){0.f, 0.f, 0.f, 0.f};
    const int lr = tid >> 3, lc = tid & 7;
    const bf16* Ag = A + (size_t)(mt * 128 + lr) * K + lc * 8;
    const bf16* Bg = Bt + (size_t)(nt * 128 + lr) * K + lc * 8;
    u32x4 ra0, ra1, rb0, rb1;
    ra0 = *(const u32x4*)(Ag); ra1 = *(const u32x4*)(Ag + (size_t)64 * K); rb0 = *(const u32x4*)(Bg); rb1 = *(const u32x4*)(Bg + (size_t)64 * K);
    const int nk = K / 64;
    for (int kt = 0; kt < nk; ++kt) {
        __syncthreads();
        *(u32x4*)(As + lr * LS + lc * 8) = ra0; *(u32x4*)(As + (lr + 64) * LS + lc * 8) = ra1;
        *(u32x4*)(Bs + lr * LS + lc * 8) = rb0; *(u32x4*)(Bs + (lr + 64) * LS + lc * 8) = rb1;
        __syncthreads();
        if (kt + 1 < nk) { const int ko = (kt + 1) * 64;
            ra0 = *(const u32x4*)(Ag + ko); ra1 = *(const u32x4*)(Ag + (size_t)64 * K + ko); rb0 = *(const u32x4*)(Bg + ko); rb1 = *(const u32x4*)(Bg + (size_t)64 * K + ko); }
        mma_nt<4, 2>(As, LS, wm, Bs, LS, wn, acc[0], lane);
        mma_nt<4, 2>(As, LS, wm + 16, Bs, LS, wn, acc[1], lane);
    }
    const int r = lane & 15, q = lane >> 4;
#pragma unroll
    for (int i = 0; i < 2; ++i)
#pragma unroll
        for (int j = 0; j < 4; ++j)
#pragma unroll
            for (int e = 0; e < 4; ++e) {
                const int row = mt * 128 + wm + 16 * i + 4 * q + e, col = nt * 128 + wn + 16 * j + r; const float v = acc[i][j][e];
                if (mode == 0) { if (col < NP) ((bf16*)(p.ws + WS_P))[(size_t)row * NP + col] = f2bf(v); else if (col < NP + 16) ((float*)(p.ws + WS_G))[(size_t)row * NGS + (col - NP)] = v; else if (col < NP + NG) ((bf16*)((float*)(p.ws + WS_G) + (size_t)row * NGS + 16))[col - NP - 16] = f2bf(v); }
                else if (mode == 2) ((bf16*)(p.ws + WS_HT))[(size_t)row * T + col] = f2bf(v);
                else ((bf16*)(p.ws + WS_P))[(size_t)row * DM + col] = f2bf(v);
            }
}

#ifndef EMU
namespace pg8 {
#define PG8_LAS __attribute__((address_space(3)))
typedef unsigned short bf16_t;
typedef short bf16x8 __attribute__((ext_vector_type(8)));
typedef float f32x4 __attribute__((ext_vector_type(4)));
typedef unsigned u32x4 __attribute__((ext_vector_type(4)));
constexpr int BM = 256, BK = 64, HALF = 128, HTB = HALF * BK * 2  , STAGE_BYTES = 8 * HTB, NXCD = 8, WGM = 8;

__host__ __device__ __forceinline__ int lds_byte(int r, int c) { const int st = (r >> 4) * 2 + (c >> 5), rr = r & 15, cc = c & 31, ob = rr * 64 + cc * 2; return st * 1024 + (ob ^ (((ob >> 9) & 1) << 5)); }
__host__ __device__ __forceinline__ void stage_rc(int b, int& R, int& C) { const int st = b / 1024, sb = b % 1024, swz = sb ^ (((sb >> 9) & 1) << 5); R = (st >> 1) * 16 + swz / 64; C = (st & 1) * 32 + (swz % 64) / 2; }
__host__ __device__ __forceinline__ int perm32(int rho) { const int n = rho >> 4, i = rho & 15; return 8 * (i >> 2) + 4 * n + (i & 3); }

struct Unit { int pm, pn; };
struct Gemm { const bf16_t* A; const bf16_t* Bt; int M, N, K; };
__device__ __forceinline__ unsigned cvt_pk_bf16(float lo, float hi) { unsigned r; asm volatile("v_cvt_pk_bf16_f32 %0, %1, %2" : "=v"(r) : "v"(lo), "v"(hi)); return r; }
template <class Epi, class Sched, bool ALIGN_EPI = false, bool SP2 = false>
__device__ __forceinline__ void gemm_phase(PG8_LAS unsigned char* lds, const Gemm g, const Sched& S, const Epi& E) {
    const int tid = otid(), wid = __builtin_amdgcn_readfirstlane(tid >> 6), lane = tid & 63, wr = wid >> 2, wc = wid & 3, fr = lane & 15, fq = lane >> 4;
    const int K = g.K, nt = K / BK;
    unsigned voffA[2], voffB[2];
#pragma unroll
    for (int i = 0; i < 2; ++i) { int R, C; stage_rc(tid * 16 + i * 8192, R, C); const int Rb = Epi::PERM ? ((R & ~31) + perm32(R & 31)) : R;
        voffA[i] = (unsigned)(R * K + C) * 2u; voffB[i] = (unsigned)(Rb * K + C) * 2u; }
    const size_t kstep = (size_t)(BK * 2);
    const size_t hstep = (size_t)HALF * K * 2;
    const size_t tstep = 2 * hstep;
    const unsigned ldsw = (unsigned)wid * 1024u;
    const int aoff = lds_byte(wr * 64 + fr, fq * 8), boff = lds_byte(wc * 32 + fr, fq * 8);
#define PG8_SA(b, h) (((b) * 2 + (h)) * HTB)
#define PG8_SB(b, h) ((4 + (b) * 2 + (h)) * HTB)
#define PG8_STAGE(bufoff, gbase, voff) do { _Pragma("unroll") for (int _i = 0; _i < 2; ++_i) \
        __builtin_amdgcn_global_load_lds((const unsigned*)((const char*)(gbase) + (voff)[_i]), (PG8_LAS unsigned*)(lds + (bufoff) + ldsw + _i * 8192), 16, 0, 0); } while (0)
#define PG8_LDA(dst, b, h) do { _Pragma("unroll") for (int m = 0; m < 4; ++m) _Pragma("unroll") for (int k = 0; k < 2; ++k) dst[m][k] = *(const PG8_LAS bf16x8*)(lds + PG8_SA(b, h) + aoff + m * 2048 + k * 1024); } while (0)
#define PG8_LDB(dst, b, h) do { _Pragma("unroll") for (int n = 0; n < 2; ++n) _Pragma("unroll") for (int k = 0; k < 2; ++k) dst[n][k] = *(const PG8_LAS bf16x8*)(lds + PG8_SB(b, h) + boff + n * 2048 + k * 1024); } while (0)
#define PG8_MMA(ai, bj, At, Bt) do { __builtin_amdgcn_s_setprio(1); _Pragma("unroll") for (int m = 0; m < 4; ++m) _Pragma("unroll") for (int n = 0; n < 2; ++n) _Pragma("unroll") for (int k = 0; k < 2; ++k) \
        acc[ai][bj][m][n] = __builtin_amdgcn_mfma_f32_16x16x32_bf16(Bt[n][k], At[m][k], acc[ai][bj][m][n], 0, 0, 0); __builtin_amdgcn_s_setprio(0); } while (0)
#define PG8_WAIT_V(n) asm volatile("s_waitcnt vmcnt(" #n ")" ::: "memory")
#define PG8_WAIT_L(n) asm volatile("s_waitcnt lgkmcnt(" #n ")" ::: "memory")
#define PG8_BAR __builtin_amdgcn_s_barrier()
#define PG8_SCHED __builtin_amdgcn_sched_barrier(0)
    Unit cur, nxt; int ui = 0;
    if (!S.next(0, cur)) return;
    f32x4 acc[2][2][4][2];
#pragma unroll
    for (int a = 0; a < 2; ++a)
#pragma unroll
        for (int b = 0; b < 2; ++b)
#pragma unroll
            for (int m = 0; m < 4; ++m)
#pragma unroll
                for (int n = 0; n < 2; ++n) acc[a][b][m][n] = (f32x4){0.f, 0.f, 0.f, 0.f};
    bf16x8 At[4][2], B0[2][2], B1[2][2];
    const char* cA = (const char*)g.A + (size_t)cur.pm * tstep; const char* cB = (const char*)g.Bt + (size_t)cur.pn * tstep;
    S.a_ready(cur);
    if constexpr (SP2) {
        PG8_STAGE(PG8_SB(0, 0), cB, voffB); PG8_STAGE(PG8_SB(0, 1), cB + hstep, voffB); PG8_STAGE(PG8_SA(0, 0), cA, voffA); PG8_STAGE(PG8_SA(0, 1), cA + hstep, voffA);
        if (wr == 1) PG8_BAR;
        PG8_WAIT_V(2); PG8_BAR;
        PG8_STAGE(PG8_SB(1, 0), cB + kstep, voffB); PG8_STAGE(PG8_SA(1, 0), cA + kstep, voffA); PG8_STAGE(PG8_SB(1, 1), cB + hstep + kstep, voffB);
        PG8_WAIT_V(6); PG8_BAR;
    } else {
        PG8_STAGE(PG8_SB(0, 0), cB, voffB); PG8_STAGE(PG8_SA(0, 0), cA, voffA); PG8_STAGE(PG8_SB(0, 1), cB + hstep, voffB); PG8_STAGE(PG8_SA(0, 1), cA + hstep, voffA);
        if (wr == 1) PG8_BAR;
        PG8_WAIT_V(4); PG8_BAR;
        PG8_STAGE(PG8_SB(1, 0), cB + kstep, voffB); PG8_STAGE(PG8_SA(1, 0), cA + kstep, voffA); PG8_STAGE(PG8_SB(1, 1), cB + hstep + kstep, voffB);
        PG8_WAIT_V(6); PG8_BAR;
    }
    for (;;) {
        const bool has_next = S.next(ui + 1, nxt);
        const char* nA = has_next ? (const char*)g.A + (size_t)nxt.pm * tstep : cA; const char* nB = has_next ? (const char*)g.Bt + (size_t)nxt.pn * tstep : cB;
        for (int t = 0; t < nt; t += 2) {
            const bool last = (t == nt - 2);
            const char* a1 = cA + (size_t)(t + 1) * kstep;
            const char* a2 = last ? nA : cA + (size_t)(t + 2) * kstep; const char* b2 = last ? nB : cB + (size_t)(t + 2) * kstep;
            const char* a3 = a2 + kstep; const char* b3 = b2 + kstep;
            if (last && has_next) S.a_ready(nxt);
            if constexpr (SP2) {
            PG8_LDB(B0, 0, 0); PG8_LDB(B1, 0, 1); PG8_SCHED; PG8_LDA(At, 0, 0); PG8_STAGE(PG8_SA(1, 1), a1 + hstep, voffA);
            PG8_WAIT_V(8); PG8_WAIT_L(0); PG8_BAR; PG8_MMA(0, 0, At, B0); PG8_MMA(0, 1, At, B1); PG8_BAR; PG8_SCHED;
            PG8_LDA(At, 0, 1); PG8_STAGE(PG8_SB(0, 0), b2, voffB); PG8_STAGE(PG8_SB(0, 1), b2 + hstep, voffB); PG8_STAGE(PG8_SA(0, 0), a2, voffA);
            PG8_WAIT_V(8); PG8_WAIT_L(0); PG8_BAR; PG8_MMA(1, 0, At, B0); PG8_MMA(1, 1, At, B1); PG8_BAR; PG8_SCHED;
            PG8_LDB(B0, 1, 0); PG8_LDB(B1, 1, 1); PG8_SCHED; PG8_LDA(At, 1, 0); PG8_STAGE(PG8_SA(0, 1), a2 + hstep, voffA);
            PG8_WAIT_V(8); PG8_WAIT_L(0); PG8_BAR; PG8_MMA(0, 0, At, B0); PG8_MMA(0, 1, At, B1); PG8_BAR; PG8_SCHED;
            PG8_LDA(At, 1, 1); PG8_STAGE(PG8_SB(1, 0), b3, voffB); PG8_STAGE(PG8_SB(1, 1), b3 + hstep, voffB); PG8_STAGE(PG8_SA(1, 0), a3, voffA);
            PG8_WAIT_V(8); PG8_WAIT_L(0); PG8_BAR; PG8_MMA(1, 0, At, B0); PG8_MMA(1, 1, At, B1); PG8_BAR; PG8_SCHED;
            } else {
            PG8_LDB(B0, 0, 0); PG8_SCHED; PG8_LDA(At, 0, 0); PG8_STAGE(PG8_SA(1, 1), a1 + hstep, voffA);
            PG8_WAIT_L(8); PG8_BAR; PG8_WAIT_L(0); PG8_MMA(0, 0, At, B0); PG8_BAR; PG8_SCHED;
            PG8_LDB(B1, 0, 1); PG8_STAGE(PG8_SB(0, 0), b2, voffB);
            PG8_BAR; PG8_WAIT_L(0); PG8_MMA(0, 1, At, B1); PG8_BAR;
            PG8_LDA(At, 0, 1); PG8_STAGE(PG8_SA(0, 0), a2, voffA);
            PG8_BAR; PG8_WAIT_L(0); PG8_MMA(1, 0, At, B0); PG8_BAR; PG8_SCHED;
            PG8_STAGE(PG8_SB(0, 1), b2 + hstep, voffB);
            PG8_WAIT_V(6); PG8_BAR; PG8_MMA(1, 1, At, B1); PG8_BAR;
            PG8_LDB(B0, 1, 0); PG8_SCHED; PG8_LDA(At, 1, 0); PG8_STAGE(PG8_SA(0, 1), a2 + hstep, voffA);
            PG8_WAIT_L(8); PG8_BAR; PG8_WAIT_L(0); PG8_MMA(0, 0, At, B0); PG8_BAR; PG8_SCHED;
            PG8_LDB(B1, 1, 1); PG8_STAGE(PG8_SB(1, 0), b3, voffB);
            PG8_BAR; PG8_WAIT_L(0); PG8_MMA(0, 1, At, B1); PG8_BAR;
            PG8_LDA(At, 1, 1); PG8_STAGE(PG8_SA(1, 0), a3, voffA);
            PG8_BAR; PG8_WAIT_L(0); PG8_MMA(1, 0, At, B0); PG8_BAR; PG8_SCHED;
            PG8_STAGE(PG8_SB(1, 1), b3 + hstep, voffB);
            PG8_WAIT_V(6); PG8_BAR; PG8_MMA(1, 1, At, B1); PG8_BAR;
            }
        }
        if constexpr (ALIGN_EPI) { if (wr == 0) PG8_BAR; }
        if constexpr (!Epi::AFTER_DRAIN) { E(acc, cur, wr, wc, fr, fq); S.done(cur); }
        if (!has_next) break;
#pragma unroll
        for (int a = 0; a < 2; ++a)
#pragma unroll
            for (int b = 0; b < 2; ++b)
#pragma unroll
                for (int m = 0; m < 4; ++m)
#pragma unroll
                    for (int n = 0; n < 2; ++n) acc[a][b][m][n] = (f32x4){0.f, 0.f, 0.f, 0.f};
        cur = nxt; cA = nA; cB = nB; ++ui;
        if constexpr (ALIGN_EPI) { if (wr == 1) PG8_BAR; }
    }
    PG8_WAIT_V(0);
    if constexpr (!ALIGN_EPI) { if (wr == 0) PG8_BAR; }
    PG8_BAR;
    if constexpr (Epi::AFTER_DRAIN) { E.fused(acc, cur, wr, wc, fr, fq, lds, wid, lane); S.done(cur); }
#undef PG8_SA
#undef PG8_SB
#undef PG8_STAGE
#undef PG8_LDA
#undef PG8_LDB
#undef PG8_MMA
#undef PG8_WAIT_V
#undef PG8_WAIT_L
#undef PG8_BAR
#undef PG8_SCHED
}
__device__ __forceinline__ void map_tile(int L, int nM, int nN, int& pm, int& pn) {
    const int nwg = nM * nN; int wgid = L; { const int q = nwg / NXCD, r = nwg % NXCD, xcd = wgid % NXCD, off = wgid / NXCD; wgid = (xcd < r ? xcd * (q + 1) : r * (q + 1) + (xcd - r) * q) + off; }
    const int nig = WGM * nN, gid = wgid / nig, fm = gid * WGM, gsz = (nM - fm) < WGM ? (nM - fm) : WGM;
    pm = fm + ((wgid % nig) % gsz); pn = (wgid % nig) / gsz;
}
constexpr int MP = T / 256, WP = NMAIN / 256, NU2 = 4 * MP, NU1 = MP * WP;
struct InOrder { int G, c;
    __device__ __forceinline__ bool next(int i, Unit& u) const { const int L = i * G + c; if (L >= NU2 + NU1) return false; int a, b;
        if (L < NU2) { map_tile(L, 4, MP, a, b); u.pm = MP + WP + a; u.pn = b; } else { map_tile(L - NU2, MP, WP, a, b); u.pm = a; u.pn = MP + b; } return true; }
    __device__ __forceinline__ void a_ready(const Unit&) const {}
    __device__ __forceinline__ void done(const Unit&) const {}
};
struct EpiIn { static constexpr bool PERM = true, AFTER_DRAIN = false; bf16_t* P; float* G; bf16_t* HTp;
    __device__ __forceinline__ void operator()(const f32x4 (&acc)[2][2][4][2], const Unit& u, int wr, int wc, int fr, int fq) const {
        if (u.pm < MP) { const int pn = u.pn - MP, row0 = u.pm * BM + wr * 64 + fr;
            if (pn < NP / 256) { const int col0 = pn * BM + wc * 32 + 8 * fq;
#pragma unroll
                for (int ai = 0; ai < 2; ++ai)
#pragma unroll
                    for (int m = 0; m < 4; ++m) { bf16_t* rowp = P + (size_t)(row0 + ai * HALF + m * 16) * NP + col0;
#pragma unroll
                        for (int bj = 0; bj < 2; ++bj) { const f32x4 v0 = acc[ai][bj][m][0], v1 = acc[ai][bj][m][1];
                            u32x4 w; w.x = cvt_pk_bf16(v0[0], v0[1]); w.y = cvt_pk_bf16(v0[2], v0[3]); w.z = cvt_pk_bf16(v1[0], v1[1]); w.w = cvt_pk_bf16(v1[2], v1[3]); *(u32x4*)(rowp + bj * HALF) = w; } } }
            else { const int cb = wc * 32 + 8 * fq;
                if (cb < NG) {
#pragma unroll
                    for (int ai = 0; ai < 2; ++ai)
#pragma unroll
                        for (int m = 0; m < 4; ++m) { float* rowb = G + (size_t)(row0 + ai * HALF + m * 16) * NGS; const f32x4 v0 = acc[ai][0][m][0], v1 = acc[ai][0][m][1];
                            if (cb < 16) { *(f32x4*)(rowb + cb) = v0; *(f32x4*)(rowb + cb + 4) = v1; }
                            else { u32x4 w; w.x = cvt_pk_bf16(v0[0], v0[1]); w.y = cvt_pk_bf16(v0[2], v0[3]); w.z = cvt_pk_bf16(v1[0], v1[1]); w.w = cvt_pk_bf16(v1[2], v1[3]); *(u32x4*)((bf16_t*)(rowb + 16) + (cb - 16)) = w; } } } } }
        else { const int row0 = (u.pm - MP - WP) * BM + wr * 64 + fr, col0 = u.pn * BM + wc * 32 + 8 * fq;
#pragma unroll
            for (int ai = 0; ai < 2; ++ai)
#pragma unroll
                for (int m = 0; m < 4; ++m) { bf16_t* rowp = HTp + (size_t)(row0 + ai * HALF + m * 16) * T + col0;
#pragma unroll
                    for (int bj = 0; bj < 2; ++bj) { const f32x4 v0 = acc[ai][bj][m][0], v1 = acc[ai][bj][m][1];
                        u32x4 w; w.x = cvt_pk_bf16(v0[0], v0[1]); w.y = cvt_pk_bf16(v0[2], v0[3]); w.z = cvt_pk_bf16(v1[0], v1[1]); w.w = cvt_pk_bf16(v1[2], v1[3]); *(u32x4*)(rowp + bj * HALF) = w; } } }
    }
};
struct OutOrder { int G, c; bool lat_only; unsigned* cnt;
    __device__ __forceinline__ bool next(int i, Unit& u) const { constexpr int nN = DM / 256, nLat = NB * (SEQ / 256) * nN, nCtx = NB * (CTXL / 256) * nN; const int L = i * G + c; int a, b;
        if (L < nLat) { map_tile(L, nLat / nN, nN, a, b); u.pm = (a / (SEQ / 256)) * (TOK / 256) + CTXL / 256 + a % (SEQ / 256); }
        else { if (lat_only || L >= nLat + nCtx) return false; map_tile(L - nLat, nCtx / nN, nN, a, b); u.pm = (a / (CTXL / 256)) * (TOK / 256) + a % (CTXL / 256); }
        u.pn = b; return true; }
    __device__ __forceinline__ void a_ready(const Unit&) const {}
    unsigned* xu; unsigned nloc, xtarget;
    __device__ __forceinline__ void done(const Unit& u) const {
        asm volatile("s_waitcnt vmcnt(0)" ::: "memory"); __builtin_amdgcn_s_barrier();
        if (threadIdx.x == 0) { const bool isctx = (u.pm % (TOK / 256)) < CTXL / 256;
            if (!isctx && xtarget != 0u) {
                const unsigned old = __hip_atomic_fetch_add(xu, 1u, __ATOMIC_RELAXED, __HIP_MEMORY_SCOPE_AGENT);
                if (old + 1u == xtarget) { __builtin_amdgcn_fence(__ATOMIC_RELEASE, "agent"); asm volatile("s_waitcnt vmcnt(0)" ::: "memory");
                    __hip_atomic_fetch_add(cnt, nloc, __ATOMIC_RELAXED, __HIP_MEMORY_SCOPE_AGENT); } }
            else { __builtin_amdgcn_fence(__ATOMIC_RELEASE, "agent"); asm volatile("s_waitcnt vmcnt(0)" ::: "memory");
                __hip_atomic_fetch_add(cnt + (isctx ? 64 : 0), 1u, __ATOMIC_RELAXED, __HIP_MEMORY_SCOPE_AGENT); } } }
};
struct EpiOut { static constexpr bool PERM = true, AFTER_DRAIN = false; bf16_t* C;
    __device__ __forceinline__ void operator()(const f32x4 (&acc)[2][2][4][2], const Unit& u, int wr, int wc, int fr, int fq) const {
        const int row0 = u.pm * BM + wr * 64 + fr, col0 = u.pn * BM + wc * 32 + 8 * fq;
#pragma unroll
        for (int ai = 0; ai < 2; ++ai)
#pragma unroll
            for (int m = 0; m < 4; ++m) { bf16_t* rowp = C + (size_t)(row0 + ai * HALF + m * 16) * DM + col0;
#pragma unroll
                for (int bj = 0; bj < 2; ++bj) { const f32x4 v0 = acc[ai][bj][m][0], v1 = acc[ai][bj][m][1];
                    u32x4 w; w.x = cvt_pk_bf16(v0[0], v0[1]); w.y = cvt_pk_bf16(v0[2], v0[3]); w.z = cvt_pk_bf16(v1[0], v1[1]); w.w = cvt_pk_bf16(v1[2], v1[3]); *(u32x4*)(rowp + bj * HALF) = w; } }
    }
};
}
#endif

__device__ __forceinline__ void phase_gemm_in(const Params& p, int l, char* smem) {
    constexpr int N_F = WG / 2;
#ifdef EMU
    constexpr int MT = T / 128, NT1 = NMAIN / 128, N1 = MT * NT1, N2 = 8 * MT;
    for (int task = obid(); task < N1 + N2; task += gridDim.x) {
        if (task < N1) gemm_tile(p, (const bf16*)(p.ws + WS_HNY), (const bf16*)(p.ws + WS_WIN), DM, task / NT1, task % NT1, 0, smem);
        else { const int t2 = task - N1; gemm_tile(p, (const bf16*)(p.ws + WS_WIN) + (size_t)NMAIN * DM, (const bf16*)(p.ws + WS_HNY), DM, t2 / MT, t2 % MT, 2, smem); }
    }
#else
    { const pg8::Gemm g{(const pg8::bf16_t*)(p.ws + WS_HNY), (const pg8::bf16_t*)(p.ws + WS_HNY), 0, 0, DM};
      const pg8::InOrder S{(int)gridDim.x, obid()};
      const pg8::EpiIn E{(pg8::bf16_t*)(p.ws + WS_P), (float*)(p.ws + WS_G), (pg8::bf16_t*)(p.ws + WS_HT)};
      pg8::gemm_phase<pg8::EpiIn, pg8::InOrder, true, true>((PG8_LAS unsigned char*)smem, g, S, E); }
#endif
    { const int G = (int)gridDim.x, bid = obid();
#ifdef EMU
      const int extra = 0;
#else
      const int extra = (pg8::NU1 + pg8::NU2) % G;
#endif
      if (extra > 0 && extra < G) { if (bid >= extra) for (int task = bid - extra; task < N_F; task += G - extra) filt_fft_task(p, task, smem); }
      else for (int task = G - 1 - bid; task < N_F; task += G) filt_fft_task(p, task, smem); }
}
__device__ __forceinline__ void phase_gemm_out(const Params& p, int l, char* smem) {
    const int G = (int)gridDim.x, bid = obid(); const bool has_ctx = l < DEPTH - 1;
#ifdef EMU
    constexpr int MT = T / 128, NTO = DM / 128;
    for (int task = bid; task < MT * NTO; task += G) {
        const int mt = task / NTO, nt = task % NTO;
        if (!has_ctx && (mt % (TOK / 128)) < CTXL / 128) continue;
        gemm_tile(p, (const bf16*)(p.ws + WS_HNY), (const bf16*)(p.ws + WS_WOUT), MIX, mt, nt, 1, smem);
        __syncthreads(); if (otid() == 0) *unit_counter(p, (mt % (TOK / 128)) < CTXL / 128 ? 1 : 0) += 1u;
    }
#else
    const pg8::Gemm g{(const pg8::bf16_t*)(p.ws + WS_HNY), (const pg8::bf16_t*)(p.ws + WS_WOUT), 0, 0, MIX};
    const unsigned xcc = (unsigned)__builtin_amdgcn_s_getreg((3 << 11) | 20) & 0xFu, nloc = ((volatile PG8_LAS unsigned*)(smem + LDS_BYTES - 64))[0];
    const bool agg = (NB * (SEQ / 256) * (DM / 256) == G) && nloc > 0u;
    const pg8::OutOrder S{G, bid, !has_ctx, unit_counter(p, 0), unit_counter(p, 2) + 16 * xcc, nloc, agg ? nloc * (unsigned)(l + 1) : 0u};
    const pg8::EpiOut E{(pg8::bf16_t*)(p.ws + WS_P)};
    pg8::gemm_phase<pg8::EpiOut, pg8::OutOrder, true, true>((PG8_LAS unsigned char*)smem, g, S, E);
#endif
}

__device__ __forceinline__ size_t st_index(int mixer, int dir, int b, int h, int cid) { return ((((size_t)(mixer * 2 + dir) * NB + b) * NH + h) * NCH + cid); }
__device__ __forceinline__ size_t ch_index(int dir, int b, int h, int cid) { return (((size_t)dir * NB + b) * NH + h) * NCH + cid; }

__device__ __forceinline__ void load_tile_nat(const bf16* P, int r0, int c0, bf16* dst, float scale, int tid) {
    const int s = tid >> 3, c8 = tid & 7;
    const u32x4 v = *(const u32x4*)(P + (size_t)(r0 + s) * NP + c0 + c8 * 8);
    if (scale == 1.0f) *(u32x4*)(dst + s * LS + c8 * 8) = v;
    else { float f[8]; unpack8(v, f); u32x4 o; o.x = pk2(f[0] * scale, f[1] * scale); o.y = pk2(f[2] * scale, f[3] * scale); o.z = pk2(f[4] * scale, f[5] * scale); o.w = pk2(f[6] * scale, f[7] * scale);
        *(u32x4*)(dst + s * LS + c8 * 8) = o; }
}
__device__ __forceinline__ void load_tile_tr(const bf16* P, int r0, int c0, bf16* dst, int tid) {
    const int s = tid >> 3, c8 = tid & 7;
    const u32x4 v = *(const u32x4*)(P + (size_t)(r0 + s) * NP + c0 + c8 * 8);
    const unsigned w[4] = {v.x, v.y, v.z, v.w};
#pragma unroll
    for (int j = 0; j < 4; ++j) { dst[(c8 * 8 + 2 * j) * LS + s] = (bf16)(w[j] & 0xffffu); dst[(c8 * 8 + 2 * j + 1) * LS + s] = (bf16)(w[j] >> 16); }
}

template <int NTK>
__device__ __forceinline__ void load_span(const bf16* row, int t0, float (&v)[NTK + 2]) {
    { const bool hl = t0 > 0, hr = t0 + NTK < SEQ; const bf16 xl = row[hl ? -1 : 0], xr = row[hr ? NTK : 0];
        v[0] = hl ? bf2f(xl) : 0.f; v[NTK + 1] = hr ? bf2f(xr) : 0.f; }
    if constexpr (NTK == 8) { float f[8]; unpack8(*(const u32x4*)row, f);
#pragma unroll
        for (int i = 0; i < 8; ++i) v[1 + i] = f[i]; }
    else {
#pragma unroll
        for (int i = 0; i < NTK; ++i) v[1 + i] = bf2f(row[i]); }
}
struct SpanRaw { u32x4 b; bf16 xl, xr; };
__device__ __forceinline__ SpanRaw span_load8(const bf16* row, int t0) { SpanRaw s; const bool hl = t0 > 0, hr = t0 + 8 < SEQ; s.xl = row[hl ? -1 : 0]; s.xr = row[hr ? 8 : 0]; s.b = *(const u32x4*)row; return s; }
__device__ __forceinline__ void span_expand8(const SpanRaw& s, int t0, float (&v)[10]) { float f[8]; unpack8(s.b, f); v[0] = t0 > 0 ? bf2f(s.xl) : 0.f; v[9] = (t0 + 8 < SEQ) ? bf2f(s.xr) : 0.f;
#pragma unroll
    for (int i = 0; i < 8; ++i) v[1 + i] = f[i]; }
template <int NTK>
__device__ __forceinline__ void hy_inputs(const bf16* h0, const bf16* h1, const float* cw, const float* cb, int c, int t0, float (&u0)[NTK], float (&u1)[NTK], float (&g0)[NTK], float (&g1)[NTK]) {
    if constexpr (NTK == 8) {
        const SpanRaw rxa = span_load8(h0 + (size_t)512 * T, t0), rxb = span_load8(h1 + (size_t)512 * T, t0), rga = span_load8(h0 + (size_t)768 * T, t0), rgb = span_load8(h1 + (size_t)768 * T, t0);
        const SpanRaw rva = span_load8(h0, t0), rvb = span_load8(h1, t0), rya = span_load8(h0 + (size_t)256 * T, t0), ryb = span_load8(h1 + (size_t)256 * T, t0);
        const float w0 = cw[0 * 768 + 512 + c], w1 = cw[1 * 768 + 512 + c], w2 = cw[2 * 768 + 512 + c], bb = cb[512 + c];
        const float v0 = cw[0 * 768 + c], v1 = cw[1 * 768 + c], v2 = cw[2 * 768 + c], vbias = cb[c];
        const float y0 = cw[0 * 768 + 256 + c], y1 = cw[1 * 768 + 256 + c], y2 = cw[2 * 768 + 256 + c], ybias = cb[256 + c];
        { float xa[10], xb[10], ga[10], gb[10]; span_expand8(rxa, t0, xa); span_expand8(rxb, t0, xb); span_expand8(rga, t0, ga); span_expand8(rgb, t0, gb);
#pragma unroll
            for (int i = 0; i < 8; ++i) { g0[i] = (w0 * xa[i] + w1 * xa[i + 1] + w2 * xa[i + 2] + bb) * siluf_(ga[i + 1]); g1[i] = (w0 * xb[i] + w1 * xb[i + 1] + w2 * xb[i + 2] + bb) * siluf_(gb[i + 1]); } }
        { float va[10], vb[10], ya[10], yb[10]; span_expand8(rva, t0, va); span_expand8(rvb, t0, vb); span_expand8(rya, t0, ya); span_expand8(ryb, t0, yb);
#pragma unroll
            for (int i = 0; i < 8; ++i) { u0[i] = (v0 * va[i] + v1 * va[i + 1] + v2 * va[i + 2] + vbias) * (y0 * ya[i] + y1 * ya[i + 1] + y2 * ya[i + 2] + ybias);
                u1[i] = (v0 * vb[i] + v1 * vb[i + 1] + v2 * vb[i + 2] + vbias) * (y0 * yb[i] + y1 * yb[i + 1] + y2 * yb[i + 2] + ybias); } }
        return;
    }
    { float xa[NTK + 2], xb[NTK + 2]; load_span<NTK>(h0 + (size_t)512 * T, t0, xa); load_span<NTK>(h1 + (size_t)512 * T, t0, xb);
        const float w0 = cw[0 * 768 + 512 + c], w1 = cw[1 * 768 + 512 + c], w2 = cw[2 * 768 + 512 + c], bb = cb[512 + c];
        float ga[NTK + 2], gb[NTK + 2]; load_span<NTK>(h0 + (size_t)768 * T, t0, ga); load_span<NTK>(h1 + (size_t)768 * T, t0, gb);
#pragma unroll
        for (int i = 0; i < NTK; ++i) { g0[i] = (w0 * xa[i] + w1 * xa[i + 1] + w2 * xa[i + 2] + bb) * siluf_(ga[i + 1]); g1[i] = (w0 * xb[i] + w1 * xb[i + 1] + w2 * xb[i + 2] + bb) * siluf_(gb[i + 1]); } }
    { float va[NTK + 2], vb[NTK + 2], ya[NTK + 2], yb[NTK + 2];
        load_span<NTK>(h0, t0, va); load_span<NTK>(h1, t0, vb); load_span<NTK>(h0 + (size_t)256 * T, t0, ya); load_span<NTK>(h1 + (size_t)256 * T, t0, yb);
        const float v0 = cw[0 * 768 + c], v1 = cw[1 * 768 + c], v2 = cw[2 * 768 + c], vbias = cb[c];
        const float y0 = cw[0 * 768 + 256 + c], y1 = cw[1 * 768 + 256 + c], y2 = cw[2 * 768 + 256 + c], ybias = cb[256 + c];
#pragma unroll
        for (int i = 0; i < NTK; ++i) { u0[i] = (v0 * va[i] + v1 * va[i + 1] + v2 * va[i + 2] + vbias) * (y0 * ya[i] + y1 * ya[i + 1] + y2 * ya[i + 2] + ybias);
            u1[i] = (v0 * vb[i] + v1 * vb[i + 1] + v2 * vb[i + 2] + vbias) * (y0 * yb[i] + y1 * yb[i + 1] + y2 * yb[i + 2] + ybias); } }
}
__device__ __forceinline__ void hylat_task(const Params& p, int l, int bp, int cp, char* smem) {
    const int tid = otid(), half = tid >> 8, tl = tid & 255, c = 2 * cp + half;
    const bf16* HT = (const bf16*)(p.ws + WS_HT); bf16* Y = (bf16*)(p.ws + WS_HNY);
    cpx* buf = (cpx*)smem + (size_t)half * FBUF;
    const cpx* TW = (const cpx*)(p.ws + WS_TW);
    const cpx* KF = (const cpx*)(p.ws + WS_KF) + (size_t)c * NF;
    constexpr int NTK = SEQ / 256;
    const int t0 = NTK * tl;
    const float* cw = p.in[I_HCW] + (size_t)l * 3 * 768; const float* cb = p.in[I_HCB] + (size_t)l * 768;
    const size_t rb0 = (size_t)(2 * bp) * TOK + CTXL, rb1 = rb0 + TOK;
    const bf16* h0 = HT + (size_t)c * T + rb0 + t0; const bf16* h1 = h0 + TOK;
    { float u0[NTK], u1[NTK], g0[NTK], g1[NTK]; hy_inputs<NTK>(h0, h1, cw, cb, c, t0, u0, u1, g0, g1);
        __syncthreads();
#pragma unroll
        for (int i = 0; i < NTK; ++i) { cpx v; v.x = u0[i]; v.y = u1[i]; buf[FPH(t0 + i)] = v; cpx z = {0.f, 0.f}; buf[FPH(SEQ + t0 + i)] = z; } }
    fft_fwd(buf, TW, tl);
#pragma unroll 2
    for (int i = tl; i < NF; i += 256) buf[FPH(i)] = cmul(buf[FPH(i)], KF[i]);
    fft_inv(buf, TW, tl);
    const float dsk = p.in[I_HD][(size_t)l * WG + c]; const float sc = 1.0f / (float)NF;
    { const int tz = otid() & 255; const int t0z = NTK * tz;
        float u0[NTK], u1[NTK], g0[NTK], g1[NTK]; hy_inputs<NTK>(HT + (size_t)c * T + rb0 + t0z, HT + (size_t)c * T + rb0 + t0z + TOK, cw, cb, c, t0z, u0, u1, g0, g1);
        float o0[NTK], o1[NTK];
#pragma unroll
        for (int i = 0; i < NTK; ++i) { const cpx y = buf[FPH(t0z + i)]; o0[i] = g0[i] * (y.x * sc + u0[i] * dsk); o1[i] = g1[i] * (y.y * sc + u1[i] * dsk); }
        bf16* d0 = (bf16*)(p.ws + WS_HT) + (size_t)(768 + c) * T + rb0 + t0z; bf16* d1 = d0 + TOK;
        if constexpr (NTK == 8) { *(u32x4*)d0 = pack8(o0); *(u32x4*)d1 = pack8(o1); }
        else {
#pragma unroll
            for (int i = 0; i < NTK; ++i) { d0[i] = f2bf(o0[i]); d1[i] = f2bf(o1[i]); } } }
}

constexpr int HCB = 16;
__device__ __forceinline__ void hyctx_task(const Params& p, int l, int b, int cblk, char* smem) {
    const int tid = otid(); const int c0 = cblk * HCB;
    const bf16* HT = (const bf16*)(p.ws + WS_HT); bf16* Y = (bf16*)(p.ws + WS_HNY); const float* HC = (const float*)(p.ws + WS_HC);
    float* raw = (float*)smem;
    float* u = raw + 4 * CTXL * HCB;
    float* og = u + CTXL * HCB;
    float* hcm = og + CTXL * HCB;
    bf16* ob = (bf16*)raw;
    const size_t rb = (size_t)b * TOK;
    const float* cw = p.in[I_HCW] + (size_t)l * 3 * 768; const float* cbias = p.in[I_HCB] + (size_t)l * 768;
    constexpr int WT = CTXL / 32;
    __syncthreads();
    for (int i = tid; i < 4 * HCB * (CTXL / 8); i += NT) { const int k = i / (HCB * (CTXL / 8)), cc = (i / (CTXL / 8)) % HCB, ck = i % (CTXL / 8);
        float f[8]; unpack8(*(const u32x4*)(HT + (size_t)(k * 256 + c0 + cc) * T + rb + ck * 8), f);
#pragma unroll
        for (int j = 0; j < 8; ++j) raw[(k * CTXL + ck * 8 + j) * HCB + cc] = f[j]; }
    for (int i = tid; i < 2 * HCB * (CTXL / 4); i += NT) { const int dir = i / (HCB * (CTXL / 4)), cc = (i / (CTXL / 4)) % HCB, pk = i % (CTXL / 4);
        const f32x4 v = *(const f32x4*)(HC + ((size_t)dir * WG + c0 + cc) * CTXL + pk * 4); const float f[4] = {v.x, v.y, v.z, v.w};
#pragma unroll
        for (int j = 0; j < 4; ++j) { const int pos = pk * 4 + j; if (dir == 0) hcm[(CTXL + pos) * HCB + cc] = f[j]; else if (pos > 0) hcm[(CTXL - pos) * HCB + cc] = f[j]; } }
    if (tid < HCB) hcm[tid] = 0.f;
    __syncthreads();
    for (int i = tid; i < CTXL * HCB; i += NT) { const int t = i / HCB, cc = i % HCB; float cv[3];
#pragma unroll
        for (int k = 0; k < 3; ++k) { const float* rk = raw + k * CTXL * HCB; const int ch = k * 256 + c0 + cc;
            const float a = t > 0 ? rk[(t - 1) * HCB + cc] : 0.f, m = rk[t * HCB + cc], z = t < CTXL - 1 ? rk[(t + 1) * HCB + cc] : 0.f;
            cv[k] = cw[0 * 768 + ch] * a + cw[1 * 768 + ch] * m + cw[2 * 768 + ch] * z + cbias[ch]; }
        u[i] = cv[0] * cv[1];
        og[i] = cv[2] * siluf_(raw[(3 * CTXL + t) * HCB + cc]); }
    __syncthreads();
    { const int cc = tid % HCB, tg = tid / HCB, t0 = WT * tg; float acc[WT], w[WT];
#pragma unroll
        for (int j = 0; j < WT; ++j) { acc[j] = 0.f; w[j] = hcm[(t0 + j + CTXL) * HCB + cc]; }
#pragma unroll 8
        for (int s = 0; s < CTXL; ++s) { const float us = u[s * HCB + cc];
#pragma unroll
            for (int j = 0; j < WT; ++j) acc[j] += us * w[j];
#pragma unroll
            for (int j = WT - 1; j > 0; --j) w[j] = w[j - 1];
            w[0] = hcm[(t0 - s - 1 + CTXL) * HCB + cc]; }
        const float dsk = p.in[I_HD][(size_t)l * WG + c0 + cc];
#pragma unroll
        for (int j = 0; j < WT; ++j) { const int t = t0 + j; ob[t * HCB + cc] = f2bf(og[t * HCB + cc] * (acc[j] + u[t * HCB + cc] * dsk)); } }
    __syncthreads();
    for (int i = tid; i < CTXL * 2; i += NT) { const int t = i >> 1, hh = i & 1; *(u32x4*)(Y + (rb + t) * 1024 + YH + c0 + 8 * hh) = *(const u32x4*)(ob + t * HCB + 8 * hh); }
}

__device__ __forceinline__ void attn_task(const Params& p, int l, int b, int kvh, int qt, bool ctxq, char* smem) {
    const int tid = otid(), lane = tid & 63, wave = tid >> 6, r = lane & 15, q = lane >> 4;
    constexpr float QSC = 0.125f * 1.4426950408889634f;
    const bf16* P = (const bf16*)(p.ws + WS_P); bf16* Y = (bf16*)(p.ws + WS_HNY); const cpx* ROPE = (const cpx*)(p.ws + WS_ROPE);
    bf16* Qs = (bf16*)smem;
    bf16* Ks = Qs + 256 * LS;
    constexpr int LSV = 80;
    bf16* Vt = Ks + 64 * LS;
    bf16* Ps = Vt + 64 * LS;
    const size_t rq0 = (size_t)b * TOK + (ctxq ? 0 : CTXL) + qt * 128;
    __syncthreads();
#pragma unroll
    for (int it = 0; it < 2; ++it) {
        const int idx = tid + NT * it, row = idx >> 2, cpair = idx & 3, g = row >> 7, t = row & 127;
        const bf16* src = P + (rq0 + t) * NP + PD + (kvh * 2 + g) * 64;
        float lo[8], hi[8]; unpack8(*(const u32x4*)(src + cpair * 8), lo); unpack8(*(const u32x4*)(src + 32 + cpair * 8), hi);
        float a[8], c2[8];
#pragma unroll
        for (int j = 0; j < 8; ++j) { float cs = 1.f, sn = 0.f; if (!ctxq) { const cpx cv = ROPE[(size_t)(qt * 128 + t) * 32 + cpair * 8 + j]; cs = cv.x; sn = cv.y; }
            a[j] = (lo[j] * cs - hi[j] * sn) * QSC; c2[j] = (hi[j] * cs + lo[j] * sn) * QSC; }
        *(u32x4*)(Qs + row * LS + cpair * 8) = pack8(a); *(u32x4*)(Qs + row * LS + 32 + cpair * 8) = pack8(c2);
    }
    const int lt0 = ctxq ? 0 : (2 * qt - 2 > 0 ? 2 * qt - 2 : 0), lt1 = ctxq ? -1 : (2 * qt + 3 < SEQ / 64 - 1 ? 2 * qt + 3 : SEQ / 64 - 1);
    const int nloc = lt1 - lt0 + 1, ntiles = nloc + NCC;
    float m[2], lsum[2]; f32x4 O[2][4];
#pragma unroll
    for (int ms = 0; ms < 2; ++ms) { m[ms] = -INFINITY; lsum[ms] = 0.f;
#pragma unroll
        for (int i = 0; i < 4; ++i) O[ms][i] = (f32x4){0.f, 0.f, 0.f, 0.f}; }
    const int g = wave >> 2, tq0 = (wave & 3) * 32;
    (void)Ps;
    __syncthreads();
    bf16x8 qf[2][2];
#pragma unroll
    for (int ms = 0; ms < 2; ++ms)
#pragma unroll
        for (int ks = 0; ks < 2; ++ks) qf[ms][ks] = *(const bf16x8*)(Qs + (g * 128 + tq0 + 16 * ms + r) * LS + ks * 32 + q * 8);
    u32x4 klo = {0u, 0u, 0u, 0u}, khi = klo, vq = klo; f32x4 rp[4] = {(f32x4){1.f, 0.f, 1.f, 0.f}, (f32x4){1.f, 0.f, 1.f, 0.f}, (f32x4){1.f, 0.f, 1.f, 0.f}, (f32x4){1.f, 0.f, 1.f, 0.f}};
    const int ks_ = tid >> 2, kcp = tid & 3, vs_ = tid >> 3, vc8 = tid & 7;
#define ATT_PREFETCH(TI) do { const bool loc_ = (TI) < nloc; const int kt_ = loc_ ? lt0 + (TI) : (TI) - nloc; const size_t rk_ = (size_t)b * TOK + (loc_ ? CTXL : 0) + kt_ * 64; \
        if (tid < 256) { const bf16* src_ = P + (rk_ + ks_) * NP + PD + 256 + kvh * 64; klo = *(const u32x4*)(src_ + kcp * 8); khi = *(const u32x4*)(src_ + 32 + kcp * 8); \
            if (loc_) { const f32x4* rr_ = (const f32x4*)(ROPE + (size_t)(kt_ * 64 + ks_) * 32 + kcp * 8); rp[0] = rr_[0]; rp[1] = rr_[1]; rp[2] = rr_[2]; rp[3] = rr_[3]; } \
            else { rp[0] = rp[1] = rp[2] = rp[3] = (f32x4){1.f, 0.f, 1.f, 0.f}; } } \
        vq = *(const u32x4*)(P + (rk_ + vs_) * NP + PD + 384 + kvh * 64 + vc8 * 8); } while (0)
    ATT_PREFETCH(0);
    for (int ti = 0; ti < ntiles; ++ti) {
        const bool local = ti < nloc; const int kt = local ? lt0 + ti : ti - nloc;
        __syncthreads();
        if (tid < 256) { float lo[8], hi[8]; unpack8(klo, lo); unpack8(khi, hi);
            const float cs[8] = {rp[0].x, rp[0].z, rp[1].x, rp[1].z, rp[2].x, rp[2].z, rp[3].x, rp[3].z}, sn[8] = {rp[0].y, rp[0].w, rp[1].y, rp[1].w, rp[2].y, rp[2].w, rp[3].y, rp[3].w};
            float a[8], c2[8];
#pragma unroll
            for (int j = 0; j < 8; ++j) { a[j] = lo[j] * cs[j] - hi[j] * sn[j]; c2[j] = hi[j] * cs[j] + lo[j] * sn[j]; }
            *(u32x4*)(Ks + ks_ * LS + kcp * 8) = pack8(a); *(u32x4*)(Ks + ks_ * LS + 32 + kcp * 8) = pack8(c2); }
        *(u32x4*)(Vt + vs_ * LSV + vc8 * 8) = vq;
        __syncthreads();
        if (ti + 1 < ntiles) ATT_PREFETCH(ti + 1);
        bf16x8 kfr[4][2], vfa[4], vfb[4];
#pragma unroll
        for (int nt = 0; nt < 4; ++nt)
#pragma unroll
            for (int ks = 0; ks < 2; ++ks) kfr[nt][ks] = *(const bf16x8*)(Ks + (16 * nt + r) * LS + ks * 32 + q * 8);
#pragma unroll
        for (int me = 0; me < 4; ++me) { const bf16* vr = Vt + (4 * q + (r >> 2)) * LSV + 16 * me + 4 * (r & 3);
            const u32x2 a0 = lds_tr16(vr), a1 = lds_tr16(vr + 16 * LSV), a2 = lds_tr16(vr + 32 * LSV), a3 = lds_tr16(vr + 48 * LSV);
            u32x4 va; va.x = a0.x; va.y = a0.y; va.z = a1.x; va.w = a1.y; u32x4 vb; vb.x = a2.x; vb.y = a2.y; vb.z = a3.x; vb.w = a3.y; vfa[me] = as_frag(va); vfb[me] = as_frag(vb); }
#pragma unroll
        for (int ms = 0; ms < 2; ++ms) {
            const int qlo = qt * 128 + tq0 + 16 * ms, klo_ = kt * 64;
            if (local && (klo_ > qlo + 15 + 128 || klo_ + 63 < qlo - 128)) continue;
            const bool domask = local && (klo_ + 63 - qlo > 128 || klo_ - (qlo + 15) < -128);
            f32x4 S[4] = {(f32x4){0.f, 0.f, 0.f, 0.f}, (f32x4){0.f, 0.f, 0.f, 0.f}, (f32x4){0.f, 0.f, 0.f, 0.f}, (f32x4){0.f, 0.f, 0.f, 0.f}};
#pragma unroll
            for (int ks = 0; ks < 2; ++ks)
#pragma unroll
                for (int nt = 0; nt < 4; ++nt) S[nt] = MFMA16(kfr[nt][ks], qf[ms][ks], S[nt]);
            const int qpos = qlo + r; float mx = -INFINITY;
            if (domask) {
#pragma unroll
                for (int nt = 0; nt < 4; ++nt)
#pragma unroll
                    for (int i = 0; i < 4; ++i) { const int d = kt * 64 + nt * 16 + 4 * q + i - qpos; if (d > 128 || d < -128) S[nt][i] = -INFINITY; } }
#pragma unroll
            for (int nt = 0; nt < 4; ++nt)
#pragma unroll
                for (int i = 0; i < 4; ++i) mx = fmaxf(mx, S[nt][i]);
            mx = xrow_max(mx);
            const float mn = fmaxf(m[ms], mx); const float msafe = mn == -INFINITY ? 0.f : mn; const float alpha = EXP2(m[ms] - msafe); float sm = 0.f;
#pragma unroll
            for (int nt = 0; nt < 4; ++nt)
#pragma unroll
                for (int i = 0; i < 4; ++i) { S[nt][i] = EXP2(S[nt][i] - msafe); sm += S[nt][i]; }
            sm = xrow_sum(sm);
            lsum[ms] = lsum[ms] * alpha + sm; m[ms] = mn;
            const float pa[8] = {S[0][0], S[0][1], S[0][2], S[0][3], S[1][0], S[1][1], S[1][2], S[1][3]}, pb[8] = {S[2][0], S[2][1], S[2][2], S[2][3], S[3][0], S[3][1], S[3][2], S[3][3]};
            const bf16x8 p0 = as_frag(pack8(pa)), p1 = as_frag(pack8(pb));
#pragma unroll
            for (int me = 0; me < 4; ++me) { O[ms][me] = O[ms][me] * alpha;
                O[ms][me] = MFMA16(vfa[me], p0, O[ms][me]); O[ms][me] = MFMA16(vfb[me], p1, O[ms][me]); }
        }
    }
#undef ATT_PREFETCH
    const float sink = p.in[I_SINK][(size_t)l * NH + kvh * 2 + g];
    u32x2 ggs[2][4];
#pragma unroll
    for (int ms = 0; ms < 2; ++ms)
#pragma unroll
        for (int me = 0; me < 4; ++me) ggs[ms][me] = *(const u32x2*)(P + (rq0 + tq0 + 16 * ms + r) * NP + PD + 512 + (kvh * 2 + g) * 64 + 4 * q + 16 * me);
#pragma unroll
    for (int ms = 0; ms < 2; ++ms) { const float den = lsum[ms] + EXP2(sink * 1.4426950408889634f - m[ms]); const float inv = frcp_(den);
        const size_t row = rq0 + tq0 + 16 * ms + r; const int col = (kvh * 2 + g) * 64 + 4 * q;
#pragma unroll
        for (int me = 0; me < 4; ++me) { const u32x2 gg = ggs[ms][me];
            const float g0 = bitsf(gg.x << 16), g1 = bitsf(gg.x & 0xffff0000u), g2 = bitsf(gg.y << 16), g3 = bitsf(gg.y & 0xffff0000u);
            u32x2 o; o.x = pk2(O[ms][me][0] * inv * siluf_(g0), O[ms][me][1] * inv * siluf_(g1)); o.y = pk2(O[ms][me][2] * inv * siluf_(g2), O[ms][me][3] * inv * siluf_(g3));
            *(u32x2*)(Y + row * 1024 + YD + col + 16 * me) = o; } }
}

#ifdef EMU
__device__ __forceinline__ int olane(int lane) { return lane; }
#else
__device__ __forceinline__ int olane(int lane) { asm volatile("" : "+v"(lane)); return lane; }
#endif
__device__ __forceinline__ void load_nat_tile(const bf16* P, int row0, int col0, bf16* tile, int lane) {
    u32x4 v[8];
#pragma unroll
    for (int i = 0; i < 8; ++i) v[i] = *(const u32x4*)(P + (size_t)(row0 + (lane >> 3) + 8 * i) * NP + col0 + (lane & 7) * 8);
#pragma unroll
    for (int i = 0; i < 8; ++i) *(u32x4*)(tile + swz((lane >> 3) + 8 * i, lane & 7)) = v[i];
}
__device__ __forceinline__ bf16x8 frag_tr(const bf16* tile, int c0, int k0, int lane) {
    const int c = c0 + (lane & 15), kb = k0 + 8 * (lane >> 4); unsigned w[4];
#pragma unroll
    for (int j = 0; j < 4; ++j) w[j] = (unsigned)tile[swz(kb + 2 * j, c >> 3) + (c & 7)] | ((unsigned)tile[swz(kb + 2 * j + 1, c >> 3) + (c & 7)] << 16);
    u32x4 o; o.x = w[0]; o.y = w[1]; o.z = w[2]; o.w = w[3]; return as_frag(o);
}
__device__ __forceinline__ bf16x8 frag_tr_hw(const bf16* tile, int c0, int k0, int lane) {
    const int r = lane & 15, q = lane >> 4, row = k0 + 8 * q + (r >> 2), col = c0 + 4 * (r & 3);
    const u32x2 a = lds_tr16(tile + swz(row, col >> 3) + (col & 7)), b = lds_tr16(tile + swz(row + 4, col >> 3) + (col & 7));
    u32x4 o; o.x = a.x; o.y = a.y; o.z = b.x; o.w = b.y; return as_frag(o);
}
template <int DIR>
__device__ __forceinline__ void gla_r_frags(const float* Grow0, int lane, bf16x8 (&af)[4]) {
    const int r = lane & 15, q4 = lane >> 4;
#pragma unroll
    for (int mt = 0; mt < 4; ++mt) { u32x4 o = {0u, 0u, 0u, 0u};
        if (q4 < 2) o = *(const u32x4*)((const bf16*)(Grow0 + (size_t)(16 * mt + r) * NGS + 16) + DIR * 16 + 8 * q4);
        af[mt] = as_frag(o); }
}
template <int DIR>
__device__ __forceinline__ void gla_b_load(const Params& p, int l, int h, int nt, int lane_, u32x4& o, float& bias) {
    const int lane = olane(lane_), r = lane & 15, q4 = lane >> 4, d = h * 64 + 16 * nt + r;
    const float* wa = p.in[I_GWA] + ((size_t)(l * 2 + DIR) * 16 + 8 * (q4 & 1)) * WG + d;
    float w[8];
#pragma unroll
    for (int j = 0; j < 8; ++j) w[j] = wa[j * WG];
    bias = p.in[I_GBA][(size_t)(l * 2 + DIR) * WG + d];
    o.x = pk2(w[0], w[1]); o.y = pk2(w[2], w[3]); o.z = pk2(w[4], w[5]); o.w = pk2(w[6], w[7]);
    if (q4 >= 2) o = (u32x4){0u, 0u, 0u, 0u};
}
template <int DIR>
__device__ __forceinline__ float gla_b_col(const u32x4 o, const float bias, const bf16x8 (&af)[4], int lane_, float (&x)[4][4]) {
    const int lane = olane(lane_), r = lane & 15, q4 = lane >> 4;
    const bf16x8 bfr = as_frag(o);
#pragma unroll
    for (int mt = 0; mt < 4; ++mt) { f32x4 c = {bias, bias, bias, bias}; c = MFMA16(af[mt], bfr, c);
#pragma unroll
        for (int i = 0; i < 4; ++i) x[mt][i] = logsig_fast(c[i]) * (1.0f / 16.0f); }
    float carry = 0.f;
#pragma unroll
    for (int k = 0; k < 4; ++k) { const int mt = DIR == 0 ? k : 3 - k; float* y = x[mt];
        if (DIR == 0) { y[1] += y[0]; y[2] += y[1]; y[3] += y[2]; } else { y[2] += y[3]; y[1] += y[2]; y[0] += y[1]; }
        const float s4 = DIR == 0 ? y[3] : y[0];
        const float t1 = DIR == 0 ? __shfl_up(s4, 16) : __shfl_down(s4, 16), t2 = DIR == 0 ? __shfl_up(s4, 32) : __shfl_down(s4, 32), t3 = DIR == 0 ? __shfl_up(s4, 48) : __shfl_down(s4, 48);
        const int qq = DIR == 0 ? q4 : 3 - q4;
        const float e = (qq >= 1 ? t1 : 0.f) + (qq >= 2 ? t2 : 0.f) + (qq >= 3 ? t3 : 0.f);
        const float tot = __shfl(e + s4, DIR == 0 ? r + 48 : r);
#pragma unroll
        for (int i = 0; i < 4; ++i) y[i] += carry + e;
        carry += tot; }
    return carry;
}

template <int MIXER, int DIR>
__device__ __forceinline__ void chunkst_dir(const Params& p, int l, int b, int h, int cid, const float* Grow0, const unsigned (&kk)[32], const bf16* Vt, bf16* Kt, const float* wvs, float* bendl, int lane_) {
    const int lane = olane(lane_), r = lane & 15, q4 = lane >> 4;
    if constexpr (MIXER == 0) {
        float nacc = 0.f;
#pragma unroll
        for (int c = 0; c < 8; ++c) { float f[8];
#pragma unroll
            for (int j = 0; j < 8; ++j) { const int s = 8 * c + j; const float kv = (s & 1) ? bitsf(kk[s >> 1] & 0xffff0000u) : bitsf(kk[s >> 1] << 16);
                f[j] = kv * 0.125f * wvs[DIR * 64 + s]; nacc += f[j]; }
            *(u32x4*)(Kt + swz(lane, c)) = pack8(f); }
        ((float*)(p.ws + WS_NV))[ch_index(DIR, b, h, cid) * 64 + lane] = nacc;
    } else {
        const bf16* P = (const bf16*)(p.ws + WS_P); const int kcol = PG + 256 + h * 64; const int r0 = b * TOK + cid * 64;
        bf16x8 af[4]; gla_r_frags<DIR>(Grow0, lane, af);
#pragma unroll 2
        for (int nt = 0; nt < 4; ++nt) { const int d = 16 * nt + r; float x[4][4];
            u32x4 wo_; float wb_; gla_b_load<DIR>(p, l, h, nt, lane, wo_, wb_); const float bend = gla_b_col<DIR>(wo_, wb_, af, lane, x);
            if (q4 == 0) { ((float*)(p.ws + WS_BE))[ch_index(DIR, b, h, cid) * 64 + d] = bend; bendl[d] = __expf(fmaxf(bend, -80.0f)); }
#pragma unroll
            for (int mt = 0; mt < 4; ++mt)
#pragma unroll
                for (int i = 0; i < 4; ++i) { const int s = 16 * mt + 4 * q4 + i; const float kv = bf2f(P[(size_t)(r0 + s) * NP + kcol + d]); const float bc = fmaxf(x[mt][i], -80.0f);
                    Kt[swz(d, s >> 3) + (s & 7)] = f2bf(kv * __expf(-bc));
                    ((bf16*)(p.ws + WS_EQ))[((size_t)DIR * T + r0 + s) * WG + h * 64 + d] = f2bf(__expf(bc)); } }
    }
    WAVE_SYNC();
    bf16x8 vf[4][2];
#pragma unroll
    for (int ne = 0; ne < 4; ++ne)
#pragma unroll
        for (int ks = 0; ks < 2; ++ks) vf[ne][ks] = frag_tr_hw(Vt, 16 * ne, 32 * ks, lane);
    bf16* dst = (bf16*)(p.ws + WS_ST) + st_index(MIXER, DIR, b, h, cid) * 4096;
#pragma unroll
    for (int me = 0; me < 4; ++me) {
        f32x4 acc[4] = {(f32x4){0.f, 0.f, 0.f, 0.f}, (f32x4){0.f, 0.f, 0.f, 0.f}, (f32x4){0.f, 0.f, 0.f, 0.f}, (f32x4){0.f, 0.f, 0.f, 0.f}};
#pragma unroll
        for (int ks = 0; ks < 2; ++ks) { const bf16x8 a = *(const bf16x8*)(Kt + swz(16 * me + r, ks * 4 + q4));
#pragma unroll
            for (int ne = 0; ne < 4; ++ne) acc[ne] = MFMA16(a, vf[ne][ks], acc[ne]); }
        f32x4 sc4 = {1.f, 1.f, 1.f, 1.f}; if constexpr (MIXER == 1) sc4 = *(const f32x4*)(bendl + 16 * me + 4 * q4);
#pragma unroll
        for (int ne = 0; ne < 4; ++ne) { const f32x4 v = acc[ne] * sc4; u32x2 o; o.x = pk2(v[0], v[1]); o.y = pk2(v[2], v[3]); *(u32x2*)(dst + (16 * ne + r) * 64 + 16 * me + 4 * q4) = o; }
    }
    WAVE_SYNC();
}
template <int MIXER>
__device__ __forceinline__ void chunkst_w(const Params& p, int l, int b, int h, int cid, char* wl, int lane) {
    const bf16* P = (const bf16*)(p.ws + WS_P); const float* G = (const float*)(p.ws + WS_G);
    const int r0 = b * TOK + cid * 64, r = lane & 15, q4 = lane >> 4;
    bf16* Kt = (bf16*)wl;
    bf16* Vt = Kt + 4096;
    float* wvs = (float*)(Vt + 4096);
    float* bendl = wvs + 128;
    const int kcol = (MIXER == 0 ? PA : PG) + 256 + h * 64, vcol = (MIXER == 0 ? PA : PG) + 512 + h * 64;
    const float* Grow0 = G + (size_t)r0 * NGS;
    bf16* Nn = Kt;
    { u32x4 vv[8], kv[8];
#pragma unroll
        for (int i = 0; i < 8; ++i) { vv[i] = *(const u32x4*)(P + (size_t)(r0 + (lane >> 3) + 8 * i) * NP + vcol + (lane & 7) * 8); kv[i] = *(const u32x4*)(P + (size_t)(r0 + (lane >> 3) + 8 * i) * NP + kcol + (lane & 7) * 8); }
#pragma unroll
        for (int i = 0; i < 8; ++i) { *(u32x4*)(Vt + swz((lane >> 3) + 8 * i, lane & 7)) = vv[i]; *(u32x4*)(Nn + swz((lane >> 3) + 8 * i, lane & 7)) = kv[i]; } }
    WAVE_SYNC();
    unsigned kk[32];
    { const int dc = 16 * q4 + 4 * (r & 3);
#pragma unroll
        for (int c = 0; c < 16; ++c) { const u32x2 t = lds_tr16(Nn + swz(4 * c + (r >> 2), dc >> 3) + (dc & 7)); kk[2 * c] = t.x; kk[2 * c + 1] = t.y; } }
    WAVE_SYNC();
    if constexpr (MIXER == 0) {
        const float* g = Grow0 + (size_t)lane * NGS; const float* gb = p.in[I_MGB] + (size_t)l * 16;
        const float gv0 = g[h], gv1 = g[4 + h], gv2 = g[8 + h], gv3 = g[12 + h], bv0 = gb[h], bv1 = gb[4 + h], bv2 = gb[8 + h], bv3 = gb[12 + h];
        const float i_f = gv0 + bv0, f_f = gv1 + bv1, i_b = gv2 + bv2, f_b = gv3 + bv3;
        const float lf = logsigf_(f_f), lb = logsigf_(f_b);
        const float bF = wave_prefix_sum(lf, lane), totF = __shfl(bF, 63);
        const float gF = totF - bF + i_f, mF = wave_max(gF);
        const float totB = wave_sum(lb), preB = wave_prefix_sum(lb, lane), bB = totB - preB + lb;
        const float gB = totB - bB + i_b, mB = wave_max(gB);
        wvs[lane] = __expf(gF - mF); wvs[64 + lane] = __expf(gB - mB);
        if (lane == 0) { float* SC = (float*)(p.ws + WS_SC);
            SC[ch_index(0, b, h, cid) * 4 + 0] = totF; SC[ch_index(0, b, h, cid) * 4 + 1] = mF;
            SC[ch_index(1, b, h, cid) * 4 + 0] = totB; SC[ch_index(1, b, h, cid) * 4 + 1] = mB; }
    }
    WAVE_SYNC();
    chunkst_dir<MIXER, 0>(p, l, b, h, cid, Grow0, kk, Vt, Kt, wvs, bendl, lane);
    chunkst_dir<MIXER, 1>(p, l, b, h, cid, Grow0, kk, Vt, Kt, wvs, bendl, lane);
}

template <int DIR>
__device__ __forceinline__ void chunkst_gla(const Params& p, int l, int b, int h, int cid, char* wl, int lane_) {
    const bf16* P = (const bf16*)(p.ws + WS_P);
    const int lane = olane(lane_), r0 = b * TOK + cid * 64, r = lane & 15, q4 = lane >> 4;
    bf16* Kt = (bf16*)wl;
    bf16* An = Kt + 4096;
    float* bendl = (float*)(An + 4096);
    const int kcol = PG + 256 + h * 64, vcol = PG + 512 + h * 64;
    const float* Grow0 = (const float*)(p.ws + WS_G) + (size_t)r0 * NGS;
    u32x4 vv[8], kv[8];
#pragma unroll
    for (int i = 0; i < 8; ++i) { vv[i] = *(const u32x4*)(P + (size_t)(r0 + (lane >> 3) + 8 * i) * NP + vcol + (lane & 7) * 8); kv[i] = *(const u32x4*)(P + (size_t)(r0 + (lane >> 3) + 8 * i) * NP + kcol + (lane & 7) * 8); }
    bf16x8 af[4]; gla_r_frags<DIR>(Grow0, lane, af);
    u32x4 wo[4]; float wb[4];
#pragma unroll
    for (int nt = 0; nt < 4; ++nt) gla_b_load<DIR>(p, l, h, nt, lane, wo[nt], wb[nt]);
#pragma unroll
    for (int i = 0; i < 8; ++i) *(u32x4*)(An + swz((lane >> 3) + 8 * i, lane & 7)) = vv[i];
    WAVE_SYNC();
    bf16x8 vf[4][2];
#pragma unroll
    for (int ne = 0; ne < 4; ++ne)
#pragma unroll
        for (int ks = 0; ks < 2; ++ks) vf[ne][ks] = frag_tr_hw(An, 16 * ne, 32 * ks, lane);
    WAVE_SYNC();
#pragma unroll
    for (int i = 0; i < 8; ++i) *(u32x4*)(An + swz((lane >> 3) + 8 * i, lane & 7)) = kv[i];
    WAVE_SYNC();
#pragma unroll
    for (int nt = 0; nt < 4; ++nt) { const int d = 16 * nt + r; float x[4][4];
        const float bend = gla_b_col<DIR>(wo[nt], wb[nt], af, lane, x);
        if (q4 == 0) { ((float*)(p.ws + WS_BE))[ch_index(DIR, b, h, cid) * 64 + d] = bend; bendl[d] = __expf(fmaxf(bend, -80.0f)); }
#pragma unroll
        for (int mt = 0; mt < 4; ++mt) { const int s0 = 16 * mt + 4 * q4, dc = 16 * nt + 4 * (r & 3);
            const u32x2 kq = lds_tr16(An + swz(s0 + (r >> 2), dc >> 3) + (dc & 7));
            const float kv[4] = {bitsf(kq.x << 16), bitsf(kq.x & 0xffff0000u), bitsf(kq.y << 16), bitsf(kq.y & 0xffff0000u)}; float kp[4];
#pragma unroll
            for (int i = 0; i < 4; ++i) { const float bc = fmaxf(x[mt][i], -80.0f); kp[i] = kv[i] * __expf(-bc); An[swz(s0 + i, d >> 3) + (d & 7)] = f2bf(__expf(bc)); }
            u32x2 o; o.x = pk2(kp[0], kp[1]); o.y = pk2(kp[2], kp[3]); *(u32x2*)(Kt + swz(d, s0 >> 3) + (s0 & 7)) = o; } }
    WAVE_SYNC();
    { bf16* EQg = (bf16*)(p.ws + WS_EQ) + ((size_t)DIR * T + r0) * WG + h * 64;
#pragma unroll
        for (int i = 0; i < 8; ++i) { const int s = (lane >> 3) + 8 * i, ck = lane & 7; *(u32x4*)(EQg + (size_t)s * WG + ck * 8) = *(const u32x4*)(An + swz(s, ck)); } }
    bf16* dst = (bf16*)(p.ws + WS_ST) + st_index(1, DIR, b, h, cid) * 4096;
#pragma unroll
    for (int me = 0; me < 4; ++me) {
        f32x4 acc[4] = {(f32x4){0.f, 0.f, 0.f, 0.f}, (f32x4){0.f, 0.f, 0.f, 0.f}, (f32x4){0.f, 0.f, 0.f, 0.f}, (f32x4){0.f, 0.f, 0.f, 0.f}};
#pragma unroll
        for (int ks = 0; ks < 2; ++ks) { const bf16x8 a = *(const bf16x8*)(Kt + swz(16 * me + r, ks * 4 + q4));
#pragma unroll
            for (int ne = 0; ne < 4; ++ne) acc[ne] = MFMA16(a, vf[ne][ks], acc[ne]); }
        const f32x4 sc4 = *(const f32x4*)(bendl + 16 * me + 4 * q4);
#pragma unroll
        for (int ne = 0; ne < 4; ++ne) { const f32x4 v = acc[ne] * sc4; u32x2 o; o.x = pk2(v[0], v[1]); o.y = pk2(v[2], v[3]); *(u32x2*)(dst + (16 * ne + r) * 64 + 16 * me + 4 * q4) = o; }
    }
    WAVE_SYNC();
}

template <int MIXER, int DIR>
__device__ __forceinline__ void chunkout_prep(const Params& p, int l, int b, int h, int cid, const float* Grow0, int r0, int pbase, const bf16* EQ, float* gar, int lane_) {
    const int lane = olane(lane_);
    if constexpr (MIXER == 0) {
        const bf16* P = (const bf16*)(p.ws + WS_P);
        const float* g = Grow0 + (size_t)lane * NGS; const float* gb = p.in[I_MGB] + (size_t)l * 16;
        const float ig = g[DIR * 8 + h] + gb[DIR * 8 + h], fg = g[DIR * 8 + 4 + h] + gb[DIR * 8 + 4 + h];
        const float mprev = ((const float*)(p.ws + WS_SC))[ch_index(DIR, b, h, cid) * 4 + 2];
        const float lf = logsigf_(fg); float bb;
        if (DIR == 0) bb = wave_prefix_sum(lf, lane); else { const float tt = wave_sum(lf), pre = wave_prefix_sum(lf, lane); bb = tt - pre + lf; }
        const float a = ig - bb; const float pm = DIR == 0 ? wave_prefix_max(a, lane) : wave_suffix_max(a, lane);
        const float mt_ = fmaxf(bb + mprev, bb + pm);
        float* ga = gar + DIR * 320;
        ga[lane] = bb - mt_; ga[64 + lane] = a; ga[128 + lane] = __expf(bb + mprev - mt_); ga[192 + lane] = __expf(-mt_);
        float* nvl = gar + 640 + DIR * 64;
        nvl[lane] = ((const float*)(p.ws + WS_NV))[ch_index(DIR, b, h, cid) * 64 + lane];
        WAVE_SYNC();
        float dq = 0.f;
#pragma unroll
        for (int c = 0; c < 8; ++c) { float f[8]; unpack8(*(const u32x4*)(P + (size_t)(r0 + lane) * NP + pbase + c * 8), f);
            const f32x4 n0 = *(const f32x4*)(nvl + c * 8), n1 = *(const f32x4*)(nvl + c * 8 + 4);
            dq += f[0] * n0.x + f[1] * n0.y + f[2] * n0.z + f[3] * n0.w + f[4] * n1.x + f[5] * n1.y + f[6] * n1.z + f[7] * n1.w; }
        ga[256 + lane] = dq;
    }
}
template <int MIXER>
__device__ __forceinline__ void chunkout_prep2(const Params& p, int l, int b, int h, int cid, const float* Grow0, int r0, int pbase, float* gar, int lane_) {
    if constexpr (MIXER == 0) {
        const int lane = olane(lane_);
        const bf16* P = (const bf16*)(p.ws + WS_P);
        const float* g = Grow0 + (size_t)lane * NGS; const float* gb = p.in[I_MGB] + (size_t)l * 16;
        const float g0 = g[h], g1 = g[4 + h], g2 = g[8 + h], g3 = g[12 + h];
        const float mprev0 = ((const float*)(p.ws + WS_SC))[ch_index(0, b, h, cid) * 4 + 2], mprev1 = ((const float*)(p.ws + WS_SC))[ch_index(1, b, h, cid) * 4 + 2];
        const float nv0 = ((const float*)(p.ws + WS_NV))[ch_index(0, b, h, cid) * 64 + lane], nv1 = ((const float*)(p.ws + WS_NV))[ch_index(1, b, h, cid) * 64 + lane];
        u32x4 qr[8];
#pragma unroll
        for (int c = 0; c < 8; ++c) qr[c] = *(const u32x4*)(P + (size_t)(r0 + lane) * NP + pbase + c * 8);
        const float igF = g0 + gb[h], fgF = g1 + gb[4 + h], igB = g2 + gb[8 + h], fgB = g3 + gb[12 + h];
        { const float lf = logsigf_(fgF); const float bb = wave_prefix_sum(lf, lane);
            const float a = igF - bb; const float pm = wave_prefix_max(a, lane); const float mt_ = fmaxf(bb + mprev0, bb + pm); float* ga = gar;
            ga[lane] = bb - mt_; ga[64 + lane] = a; ga[128 + lane] = __expf(bb + mprev0 - mt_); ga[192 + lane] = __expf(-mt_); }
        { const float lf = logsigf_(fgB); const float tt = wave_sum(lf), pre = wave_prefix_sum(lf, lane); const float bb = tt - pre + lf;
            const float a = igB - bb; const float pm = wave_suffix_max(a, lane); const float mt_ = fmaxf(bb + mprev1, bb + pm); float* ga = gar + 320;
            ga[lane] = bb - mt_; ga[64 + lane] = a; ga[128 + lane] = __expf(bb + mprev1 - mt_); ga[192 + lane] = __expf(-mt_); }
        float* nvl = gar + 640;
        nvl[lane] = nv0; nvl[64 + lane] = nv1;
        WAVE_SYNC();
        float dq0 = 0.f, dq1 = 0.f;
#pragma unroll
        for (int c = 0; c < 8; ++c) { float f[8]; unpack8(qr[c], f);
            const f32x4 n0 = *(const f32x4*)(nvl + c * 8), n1 = *(const f32x4*)(nvl + c * 8 + 4), m0 = *(const f32x4*)(nvl + 64 + c * 8), m1 = *(const f32x4*)(nvl + 64 + c * 8 + 4);
            dq0 += f[0] * n0.x + f[1] * n0.y + f[2] * n0.z + f[3] * n0.w + f[4] * n1.x + f[5] * n1.y + f[6] * n1.z + f[7] * n1.w;
            dq1 += f[0] * m0.x + f[1] * m0.y + f[2] * m0.z + f[3] * m0.w + f[4] * m1.x + f[5] * m1.y + f[6] * m1.z + f[7] * m1.w; }
        gar[256 + lane] = dq0; gar[320 + 256 + lane] = dq1;
    }
}
template <int MIXER, int DIR, int NS>
__device__ __forceinline__ void chunkout_dir(const Params& p, int b, int h, int cid, int r0, int pbase, int th, const bf16x8 (&vtf)[4][2], const bf16* VtL, const bf16* EQ, bf16* SB, const float* gar, float* rsm, f32x4 (&htot)[NS][4], int lane_) {
    const bf16* P = (const bf16*)(p.ws + WS_P); const bf16* ST = (const bf16*)(p.ws + WS_ST);
    const int lane = olane(lane_), r = lane & 15, q4 = lane >> 4;
    const bf16* E = EQ + ((size_t)DIR * T + r0) * WG + h * 64;
    const float* ga = gar + DIR * 320;
    bf16x8 kf[4][2], ctf[4][2];
    if constexpr (MIXER == 0) {
#pragma unroll
        for (int n = 0; n < 4; ++n)
#pragma unroll
            for (int ks = 0; ks < 2; ++ks) { kf[n][ks] = *(const bf16x8*)(P + (size_t)(r0 + 16 * n + r) * NP + pbase + 256 + ks * 32 + q4 * 8); ctf[n][ks] = *(const bf16x8*)(ST + st_index(MIXER, DIR, b, h, cid) * 4096 + (16 * n + r) * 64 + ks * 32 + q4 * 8); }
    } else {
        u32x4 er[4][2];
#pragma unroll
        for (int n = 0; n < 4; ++n)
#pragma unroll
            for (int ks = 0; ks < 2; ++ks) { kf[n][ks] = *(const bf16x8*)(P + (size_t)(r0 + 16 * n + r) * NP + pbase + 256 + ks * 32 + q4 * 8);
                er[n][ks] = *(const u32x4*)(E + (size_t)(16 * n + r) * WG + ks * 32 + q4 * 8);
                ctf[n][ks] = *(const bf16x8*)(ST + st_index(MIXER, DIR, b, h, cid) * 4096 + (16 * n + r) * 64 + ks * 32 + q4 * 8); }
        SCHED_FENCE();
#pragma unroll
        for (int n = 0; n < 4; ++n)
#pragma unroll
            for (int ks = 0; ks < 2; ++ks) { float fe[8], fk[8]; unpack8(er[n][ks], fe); unpack8(as_u4(kf[n][ks]), fk);
#pragma unroll
                for (int j = 0; j < 8; ++j) fk[j] = fk[j] * frcp_(fe[j]);
                kf[n][ks] = as_frag(pack8(fk)); }
    }
    bf16x8 qraw[NS][2]; u32x4 qer[NS][2];
#pragma unroll
    for (int ms = 0; ms < NS; ++ms)
#pragma unroll
        for (int ks = 0; ks < 2; ++ks) { const int mt = NS * th + ms; qraw[ms][ks] = *(const bf16x8*)(P + (size_t)(r0 + 16 * mt + r) * NP + pbase + ks * 32 + q4 * 8);
            if constexpr (MIXER == 1) qer[ms][ks] = *(const u32x4*)(E + (size_t)(16 * mt + r) * WG + ks * 32 + q4 * 8); else qer[ms][ks] = (u32x4){0u, 0u, 0u, 0u}; }
#pragma unroll
    for (int ms = 0; ms < NS; ++ms) { const int mt = NS * th + ms;
        bf16x8 qf[2];
#pragma unroll
        for (int ks = 0; ks < 2; ++ks) { qf[ks] = qraw[ms][ks];
            if constexpr (MIXER == 1) { float fe[8], fq[8]; unpack8(qer[ms][ks], fe); unpack8(as_u4(qf[ks]), fq);
#pragma unroll
                for (int j = 0; j < 8; ++j) fq[j] *= 0.125f * fe[j];
                qf[ks] = as_frag(pack8(fq)); } }
        f32x4 S[4] = {(f32x4){0.f, 0.f, 0.f, 0.f}, (f32x4){0.f, 0.f, 0.f, 0.f}, (f32x4){0.f, 0.f, 0.f, 0.f}, (f32x4){0.f, 0.f, 0.f, 0.f}};
#pragma unroll
        for (int ks = 0; ks < 2; ++ks)
#pragma unroll
            for (int n = 0; n < 4; ++n) S[n] = MFMA16(kf[n][ks], qf[ks], S[n]);
        const int t = 16 * mt + r; float sm = 0.f; float gt = 0.f; if constexpr (MIXER == 0) gt = ga[t];
#pragma unroll
        for (int n = 0; n < 4; ++n) { f32x4 gs = {0.f, 0.f, 0.f, 0.f}; if constexpr (MIXER == 0) gs = *(const f32x4*)(ga + 64 + 16 * n + 4 * q4);
#pragma unroll
            for (int i = 0; i < 4; ++i) { const int sidx = 16 * n + 4 * q4 + i; const bool ok = DIR == 0 ? (sidx <= t) : (sidx >= t); float v = 0.f;
                if (ok) { if constexpr (MIXER == 0) v = S[n][i] * 0.125f * __expf(gt + gs[i]); else v = S[n][i]; }
                S[n][i] = v; sm += v; } }
        const float pa[8] = {S[0][0], S[0][1], S[0][2], S[0][3], S[1][0], S[1][1], S[1][2], S[1][3]}, pb[8] = {S[2][0], S[2][1], S[2][2], S[2][3], S[3][0], S[3][1], S[3][2], S[3][3]};
        const bf16x8 sm0 = as_frag(pack8(pa)), sm1 = as_frag(pack8(pb));
        float wi = 1.f, inv = 1.f;
        if constexpr (MIXER == 0) { sm = xrow_sum(sm); wi = ga[128 + t]; const float den = wi * ga[256 + t] + sm; inv = frcp_(fmaxf(fabsf(den), ga[192 + t])); }
#pragma unroll
        for (int me = 0; me < 4; ++me) { f32x4 a1 = {0.f, 0.f, 0.f, 0.f}, a2 = {0.f, 0.f, 0.f, 0.f};
            const int srow = 4 * q4 + (r >> 2), ecol = 16 * me + 4 * (r & 3);
            const u32x2 v0 = lds_tr16(VtL + swz(srow, ecol >> 3) + (ecol & 7)), v1 = lds_tr16(VtL + swz(16 + srow, ecol >> 3) + (ecol & 7)), v2 = lds_tr16(VtL + swz(32 + srow, ecol >> 3) + (ecol & 7)), v3 = lds_tr16(VtL + swz(48 + srow, ecol >> 3) + (ecol & 7));
            u32x4 va; va.x = v0.x; va.y = v0.y; va.z = v1.x; va.w = v1.y; u32x4 vb; vb.x = v2.x; vb.y = v2.y; vb.z = v3.x; vb.w = v3.y;
            a1 = MFMA16(as_frag(va), sm0, a1); a1 = MFMA16(as_frag(vb), sm1, a1);
            a2 = MFMA16(ctf[me][0], qf[0], a2); a2 = MFMA16(ctf[me][1], qf[1], a2);
            if constexpr (MIXER == 0) htot[ms][me] += (a1 + a2 * wi) * inv; else htot[ms][me] += a1 + a2; }
    }
    (void)SB; (void)rsm;
}
__device__ __forceinline__ void co_build_vt(const bf16* P, int r0, int vcol, bf16* VtL, int lane) {
    load_nat_tile(P, r0, vcol, VtL, lane);
    WAVE_SYNC();
}
template <int MIXER, int NS>
__device__ __forceinline__ void co_finalize(const Params& p, int l, int h, int r0, int pbase, int mt0, f32x4 (&htot)[NS][4], int lane_) {
    const bf16* P = (const bf16*)(p.ws + WS_P); bf16* Y = (bf16*)(p.ws + WS_HNY);
    const float* ngp = p.in[MIXER == 0 ? I_MNG : I_GNG] + (size_t)l * WG + h * 64;
    const int lz = olane(lane_), r = lz & 15, q4 = lz >> 4;
    u32x2 gq[NS][4], oq[NS][4]; f32x4 ng[4];
#pragma unroll
    for (int me = 0; me < 4; ++me) ng[me] = *(const f32x4*)(ngp + 16 * me + 4 * q4);
#pragma unroll
    for (int ms = 0; ms < NS; ++ms)
#pragma unroll
        for (int me = 0; me < 4; ++me) { const size_t off = (size_t)(r0 + 16 * (mt0 + ms) + r) * NP + pbase + 16 * me + 4 * q4;
            gq[ms][me] = *(const u32x2*)(P + off + (MIXER == 0 ? 1024 : 768)); if constexpr (MIXER == 0) oq[ms][me] = *(const u32x2*)(P + off + 768); else oq[ms][me] = (u32x2){0u, 0u}; }
#pragma unroll
    for (int ms = 0; ms < NS; ++ms) { const int mt = mt0 + ms; float ss = 0.f; float gv[4][4];
#pragma unroll
        for (int me = 0; me < 4; ++me) {
            gv[me][0] = bitsf(gq[ms][me].x << 16); gv[me][1] = bitsf(gq[ms][me].x & 0xffff0000u); gv[me][2] = bitsf(gq[ms][me].y << 16); gv[me][3] = bitsf(gq[ms][me].y & 0xffff0000u);
            if constexpr (MIXER == 0) { htot[ms][me][0] *= sigmoidf_(bitsf(oq[ms][me].x << 16)); htot[ms][me][1] *= sigmoidf_(bitsf(oq[ms][me].x & 0xffff0000u)); htot[ms][me][2] *= sigmoidf_(bitsf(oq[ms][me].y << 16)); htot[ms][me][3] *= sigmoidf_(bitsf(oq[ms][me].y & 0xffff0000u)); }
            ss += htot[ms][me][0] * htot[ms][me][0] + htot[ms][me][1] * htot[ms][me][1] + htot[ms][me][2] * htot[ms][me][2] + htot[ms][me][3] * htot[ms][me][3]; }
        ss = xrow_sum(ss);
        const float rstd = rsqrtf(ss * (1.0f / 64.0f) + EPS);
#pragma unroll
        for (int me = 0; me < 4; ++me) { const int e = 16 * me + 4 * q4; const f32x4 n4 = ng[me];
            u32x2 o; o.x = pk2(htot[ms][me][0] * rstd * n4.x * siluf_(gv[me][0]), htot[ms][me][1] * rstd * n4.y * siluf_(gv[me][1]));
            o.y = pk2(htot[ms][me][2] * rstd * n4.z * siluf_(gv[me][2]), htot[ms][me][3] * rstd * n4.w * siluf_(gv[me][3]));
            *(u32x2*)(Y + (size_t)(r0 + 16 * mt + r) * 1024 + (MIXER == 0 ? YA : YG) + h * 64 + e) = o; } }
}
template <int MIXER>
__device__ __forceinline__ void chunkout_w(const Params& p, int l, int b, int h, int cid, char* wl, int lane) {
    const bf16* P = (const bf16*)(p.ws + WS_P); const float* G = (const float*)(p.ws + WS_G);
    const int r0 = b * TOK + cid * 64;
    const int pbase = (MIXER == 0 ? PA : PG) + h * 64;
    bf16* SB = (bf16*)wl;
    float* rsm = (float*)(SB + 1024);
    float* gar = rsm + 16;
    const bf16* EQ = (const bf16*)(p.ws + WS_EQ);
    const float* Grow0 = G + (size_t)r0 * NGS;
    bf16* VtL = (bf16*)(gar + 768);
    bf16x8 vtf[4][2];
#pragma unroll
    for (int me = 0; me < 4; ++me)
#pragma unroll
        for (int ks = 0; ks < 2; ++ks) { vtf[me][ks] = (bf16x8){0, 0, 0, 0, 0, 0, 0, 0}; }
    co_build_vt(P, r0, pbase + 512, VtL, lane);
    chunkout_prep2<MIXER>(p, l, b, h, cid, Grow0, r0, pbase, gar, lane);
    WAVE_SYNC();
    constexpr int NS = 2;
#pragma unroll 1
    for (int th = 0; th < 4 / NS; ++th) {
        f32x4 htot[NS][4];
#pragma unroll
        for (int a = 0; a < NS; ++a)
#pragma unroll
            for (int c = 0; c < 4; ++c) htot[a][c] = (f32x4){0.f, 0.f, 0.f, 0.f};
        chunkout_dir<MIXER, 0, NS>(p, b, h, cid, r0, pbase, th, vtf, VtL, EQ, SB, gar, rsm, htot, lane);
        chunkout_dir<MIXER, 1, NS>(p, b, h, cid, r0, pbase, th, vtf, VtL, EQ, SB, gar, rsm, htot, lane);
        co_finalize<MIXER, NS>(p, l, h, r0, pbase, NS * th, htot, lane);
    }
}
constexpr int CO_PART = 13376;
template <int MIXER, int DIR>
__device__ __forceinline__ void chunkout_piece(const Params& p, int l, int b, int h, int cid, int mt, char* wl, int lane) {
    const bf16* P = (const bf16*)(p.ws + WS_P); const float* G = (const float*)(p.ws + WS_G);
    const int r0 = b * TOK + cid * 64; const int pbase = (MIXER == 0 ? PA : PG) + h * 64;
    bf16* SB = (bf16*)wl; float* rsm = (float*)(SB + 1024); float* gar = rsm + 16; const bf16* EQ = (const bf16*)(p.ws + WS_EQ);
    const float* Grow0 = G + (size_t)r0 * NGS; bf16* VtL = (bf16*)(gar + 768);
    bf16x8 vtf[4][2];
#pragma unroll
    for (int me = 0; me < 4; ++me)
#pragma unroll
        for (int ks = 0; ks < 2; ++ks) { vtf[me][ks] = (bf16x8){0, 0, 0, 0, 0, 0, 0, 0}; }
    co_build_vt(P, r0, pbase + 512, VtL, lane);
    chunkout_prep<MIXER, DIR>(p, l, b, h, cid, Grow0, r0, pbase, EQ, gar, lane);
    WAVE_SYNC();
    f32x4 htot[1][4] = {{(f32x4){0.f, 0.f, 0.f, 0.f}, (f32x4){0.f, 0.f, 0.f, 0.f}, (f32x4){0.f, 0.f, 0.f, 0.f}, (f32x4){0.f, 0.f, 0.f, 0.f}}};
    chunkout_dir<MIXER, DIR, 1>(p, b, h, cid, r0, pbase, mt, vtf, VtL, EQ, SB, gar, rsm, htot, lane);
    float* part = (float*)(wl + CO_PART);
#pragma unroll
    for (int me = 0; me < 4; ++me)
#pragma unroll
        for (int i = 0; i < 4; ++i) part[(me * 4 + i) * 64 + lane] = htot[0][me][i];
}
template <int MIXER>
__device__ __forceinline__ void chunkout_combine(const Params& p, int l, int b, int h, int cid, int mt, const char* smem, int lane) {
    const float* pa = (const float*)(smem + (2 * mt) * WLDS + CO_PART); const float* pb = (const float*)(smem + (2 * mt + 1) * WLDS + CO_PART);
    f32x4 htot[1][4];
#pragma unroll
    for (int me = 0; me < 4; ++me)
#pragma unroll
        for (int i = 0; i < 4; ++i) htot[0][me][i] = pa[(me * 4 + i) * 64 + lane] + pb[(me * 4 + i) * 64 + lane];
    co_finalize<MIXER, 1>(p, l, h, b * TOK + cid * 64, (MIXER == 0 ? PA : PG) + h * 64, mt, htot, lane);
}

template <bool OUT>
__device__ __forceinline__ void chunk_workers(const Params& p, int l, char* smem) {
    const int tid = otid(), lane = tid & 63, wave = __builtin_amdgcn_readfirstlane(tid >> 6);
    const int NW = (int)gridDim.x * 8, wi = wave * (int)gridDim.x + obid();
    const int c_lo = (OUT && l == DEPTH - 1) ? NCC : 0, npc = NCH - c_lo, half = NB * NH * npc;
    char* wl = smem + wave * WLDS;
    if (OUT) {
        const int cl = NCC, npl = NCH - NCC, halfl = NB * NH * npl;
#pragma unroll 1
        for (int t = wi; t < halfl; t += NW) { const int b = t / (NH * npl), h = (t / npl) % NH, cid = cl + t % npl;
            const Params q = relaunder(p); chunkout_w<1>(q, l, b, h, cid, wl, lane); }
        { const int used = halfl % NW;
#pragma unroll 1
            for (int t = (wi + NW - used) % NW; t < halfl; t += NW) { const int b = t / (NH * npl), h = (t / npl) % NH, cid = cl + t % npl;
                const Params q = relaunder(p); chunkout_w<0>(q, l, b, h, cid, wl, lane); } }
        if (l < DEPTH - 1) {
            const int nct = NB * NH * NCC;
#pragma unroll 1
            for (int st = obid(); st < 2 * nct; st += (int)gridDim.x) { const int mixer = st / nct, r2 = st % nct, b = r2 / (NH * NCC), h = (r2 / NCC) % NH, cid = r2 % NCC;
                const Params q = relaunder(p); const int mt = wave >> 1;
                __syncthreads();
                if (mixer == 0) { if (wave & 1) chunkout_piece<0, 1>(q, l, b, h, cid, mt, wl, lane); else chunkout_piece<0, 0>(q, l, b, h, cid, mt, wl, lane); }
                else            { if (wave & 1) chunkout_piece<1, 1>(q, l, b, h, cid, mt, wl, lane); else chunkout_piece<1, 0>(q, l, b, h, cid, mt, wl, lane); }
                __syncthreads();
                if (wave < 4) { if (mixer == 0) chunkout_combine<0>(q, l, b, h, cid, wave, smem, lane); else chunkout_combine<1>(q, l, b, h, cid, wave, smem, lane); }
            }
        }
    } else {
        int off = 0;
#pragma unroll 1
        for (int t = wi; t < half; t += NW) { const int b = t / (NH * npc), h = (t / npc) % NH, cid = c_lo + t % npc;
            const Params q = relaunder(p); chunkst_gla<0>(q, l, b, h, cid, wl, lane); }
        off = (off + half) % NW;
#pragma unroll 1
        for (int t = (wi + NW - off) % NW; t < half; t += NW) { const int b = t / (NH * npc), h = (t / npc) % NH, cid = c_lo + t % npc;
            const Params q = relaunder(p); chunkst_gla<1>(q, l, b, h, cid, wl, lane); }
        off = (off + half) % NW;
#pragma unroll 1
        for (int t = (wi + NW - off) % NW; t < half; t += NW) { const int b = t / (NH * npc), h = (t / npc) % NH, cid = c_lo + t % npc;
            const Params q = relaunder(p); chunkst_w<0>(q, l, b, h, cid, wl, lane); }
    }
}

__device__ __forceinline__ void phase_mix1(const Params& p, int l, char* smem) {
    const bool ctxo = l < DEPTH - 1; const int G = (int)gridDim.x, bid = obid();
    constexpr int N_HL = (NB / 2) * (WG / 2), N_HC = NB * (WG / HCB);
    chunk_workers<false>(p, l, smem);
    stage_signal(p, smem, 0, l);
    for (int t = bid; t < N_HL; t += G) hylat_task(p, l, t / (WG / 2), t % (WG / 2), smem);
    if (ctxo) for (int t = G - 1 - bid; t < N_HC; t += G) hyctx_task(p, l, t / (WG / HCB), t % (WG / HCB), smem);
    stage_signal(p, smem, 2, l);
}

constexpr int SCG = 12;
__device__ __forceinline__ void phase_scan(const Params& p, int l, char* smem) {
    const int tid = otid();
    bf16* ST = (bf16*)(p.ws + WS_ST); float* NV = (float*)(p.ws + WS_NV); const float* BE = (const float*)(p.ws + WS_BE); float* SC = (float*)(p.ws + WS_SC);
    constexpr int NCHAIN = 2 * 2 * NB * NH;
    stage_wait(p, 0, l);
    for (int item = obid() * NT + tid; item < NCHAIN * 1024; item += gridDim.x * NT) {
        const int chain = item >> 10, grp = item & 1023; const int mixer = chain / (2 * NB * NH), dir = (chain / (NB * NH)) % 2, b = (chain / NH) % NB, h = chain % NH;
        float c[4] = {0.f, 0.f, 0.f, 0.f}; float nv[4] = {0.f, 0.f, 0.f, 0.f}; float m = 0.f;
        const int d0 = (grp & 15) * 4; const bool donv = (mixer == 0) && (grp < 16);
        for (int o0 = 0; o0 < NCH; o0 += SCG) {
            u32x2 uu[SCG]; float s0[SCG], s1[SCG]; f32x4 be[SCG]; f32x4 nu[SCG];
#pragma unroll
            for (int j = 0; j < SCG; ++j) if (o0 + j < NCH) { const int cid = chain_cid(dir, o0 + j); const size_t ci = ch_index(dir, b, h, cid);
                uu[j] = *(const u32x2*)(ST + st_index(mixer, dir, b, h, cid) * 4096 + grp * 4);
                if (mixer == 0) { s0[j] = SC[ci * 4 + 0]; s1[j] = SC[ci * 4 + 1]; if (donv) nu[j] = *(const f32x4*)(NV + ci * 64 + grp * 4); }
                else be[j] = *(const f32x4*)(BE + ci * 64 + d0); }
#pragma unroll
            for (int j = 0; j < SCG; ++j) if (o0 + j < NCH) { const int cid = chain_cid(dir, o0 + j); const size_t ci = ch_index(dir, b, h, cid);
                const float u[4] = {bitsf(uu[j].x << 16), bitsf(uu[j].x & 0xffff0000u), bitsf(uu[j].y << 16), bitsf(uu[j].y & 0xffff0000u)};
                u32x2 w; w.x = pk2(c[0], c[1]); w.y = pk2(c[2], c[3]); *(u32x2*)(ST + st_index(mixer, dir, b, h, cid) * 4096 + grp * 4) = w;
                if (mixer == 0) {
                    if (grp == 0) SC[ci * 4 + 2] = m;
                    const float mn = fmaxf(s0[j] + m, s1[j]), a = __expf(s0[j] + m - mn), s = __expf(s1[j] - mn);
#pragma unroll
                    for (int k = 0; k < 4; ++k) c[k] = a * c[k] + s * u[k];
                    if (donv) { f32x4 nw = {nv[0], nv[1], nv[2], nv[3]}; *(f32x4*)(NV + ci * 64 + grp * 4) = nw;
                        nv[0] = a * nv[0] + s * nu[j].x; nv[1] = a * nv[1] + s * nu[j].y; nv[2] = a * nv[2] + s * nu[j].z; nv[3] = a * nv[3] + s * nu[j].w; }
                    m = mn;
                } else { c[0] = __expf(be[j].x) * c[0] + u[0]; c[1] = __expf(be[j].y) * c[1] + u[1]; c[2] = __expf(be[j].z) * c[2] + u[2]; c[3] = __expf(be[j].w) * c[3] + u[3]; } }
        }
    }
    stage_signal(p, smem, 1, l);
    { const bool ctxo = l < DEPTH - 1; const int G = (int)gridDim.x, bid = obid();
        constexpr int QTL = SEQ / 128, QTC = CTXL / 128, N_AL = NB * 2 * QTL, N_AC = NB * 2 * QTC;
        for (int t = bid; t < N_AL; t += G) attn_task(p, l, t / (2 * QTL), (t / QTL) % 2, t % QTL, false, smem);
        if (ctxo) for (int t = (bid + G - 64 % G) % G; t < N_AC; t += G) attn_task(p, l, t / (2 * QTC), (t / QTC) % 2, t % QTC, true, smem); }
}

__device__ __forceinline__ void phase_mix2(const Params& p, int l, char* smem) {
    const int tid = otid();
    stage_wait(p, 1, l);
    chunk_workers<true>(p, l, smem);
    stage_wait(p, 2, l);
    constexpr int N_WOUT = (DM / 64) * (MIX / 64);
    { const int lane = tid & 63, wave = __builtin_amdgcn_readfirstlane(tid >> 6); const int NW = (int)gridDim.x * 8, wi = wave * (int)gridDim.x + obid();
        for (int task = NW - 1 - wi; task < N_WOUT; task += NW) { const int nt = task / (MIX / 64), kt = task % (MIX / 64);
            convert_tile_w(p.in[I_WOUT] + (size_t)l * MIX * DM, DM, (bf16*)(p.ws + WS_WOUT), MIX, nt * 64, kt * 64, false, smem + wave * WLDS, lane); }
        bf16* tile = (bf16*)(smem + wave * WLDS); const bf16* HT = (const bf16*)(p.ws + WS_HT); bf16* Y = (bf16*)(p.ws + WS_HNY);
        constexpr int NTT = NB * (SEQ / 64) * 4;
        for (int t = wi; t < NTT; t += NW) { const int b = t / ((SEQ / 64) * 4), tt = (t / 4) % (SEQ / 64), c0 = (t % 4) * 64; const size_t tok0 = (size_t)b * TOK + CTXL + tt * 64;
            u32x4 tv[8];
#pragma unroll
            for (int i = 0; i < 8; ++i) { const int ch = (lane >> 3) + 8 * i, ck = lane & 7; tv[i] = *(const u32x4*)(HT + (size_t)(768 + c0 + ch) * T + tok0 + ck * 8); }
#pragma unroll
            for (int i = 0; i < 8; ++i) { const int ch = (lane >> 3) + 8 * i, ck = lane & 7; *(u32x4*)(tile + swz(ch, ck)) = tv[i]; }
            WAVE_SYNC();
#pragma unroll
            for (int i = 0; i < 8; ++i) { const int tk = (lane >> 3) + 8 * i, cc = lane & 7; unsigned w[4];
#pragma unroll
                for (int j = 0; j < 4; ++j) { const int ca = cc * 8 + 2 * j; w[j] = (unsigned)tile[swz(ca, tk >> 3) + (tk & 7)] | ((unsigned)tile[swz(ca + 1, tk >> 3) + (tk & 7)] << 16); }
                u32x4 o; o.x = w[0]; o.y = w[1]; o.z = w[2]; o.w = w[3]; *(u32x4*)(Y + (tok0 + tk) * 1024 + YH + c0 + cc * 8) = o; }
            WAVE_SYNC(); } }
}


#ifndef EMU
#define LAS __attribute__((address_space(3)))
#define XB_TMO      128
#define XB_XCNT(j)  (256  + 64 * (j))
#define XB_XSUB(j)  (1280 + 64 * (j))
#define XB_XGEN(j)  (2304 + 64 * (j))
#define XB_TOP      3328
#define XB_TOPGEN   3392
#define XCD_BAR_WORDS 3456
#define XB_SPIN_CAP (1u << 18)

__device__ __forceinline__ unsigned xb_ld(unsigned* p)              { return __hip_atomic_load(p, __ATOMIC_RELAXED, __HIP_MEMORY_SCOPE_AGENT); }
__device__ __forceinline__ unsigned xb_add(unsigned* p, unsigned v) { return __hip_atomic_fetch_add(p, v, __ATOMIC_RELAXED, __HIP_MEMORY_SCOPE_AGENT); }
__device__ __forceinline__ unsigned xb_xcc_id() { return (unsigned)__builtin_amdgcn_s_getreg((3 << 11) | 20) & 0xFu; }
#define XB_SPIN(cond, bar) do { unsigned _sp = 0; while (cond) { __builtin_amdgcn_s_sleep(1); \
    if ((++_sp & 255u) == 0u) { if (xb_ld(&(bar)[XB_TMO])) break; if (_sp > XB_SPIN_CAP) { atomicAdd(&(bar)[XB_TMO], 1u); break; } } } } while (0)

struct XcdBarrier {
    unsigned* bar; unsigned x;
    volatile LAS unsigned* st;
};

__device__ __forceinline__ XcdBarrier xcd_barrier_post(unsigned* bar, volatile LAS unsigned* st) {
    XcdBarrier b; b.bar = bar; b.x = xb_xcc_id(); b.st = st;
    if (threadIdx.x == 0) (void)xb_add(&bar[XB_XCNT(b.x)], 1u);
    return b;
}
__device__ __forceinline__ void xcd_barrier_complete(unsigned* bar, unsigned x, unsigned& nloc, unsigned& nx) {
    const unsigned G = gridDim.x * gridDim.y * gridDim.z;
    unsigned sum, cnt, mine, sp = 0u;
    for (;;) {
        sum = 0u; cnt = 0u; mine = 0u;
#pragma unroll
        for (unsigned j = 0; j < 16; ++j) { const unsigned c = xb_ld(&bar[XB_XCNT(j)]); sum += c; cnt += (c > 0u) ? 1u : 0u; mine = (j == x) ? c : mine; }
        if (sum == G) break;
        __builtin_amdgcn_s_sleep(1);
        if ((++sp & 255u) == 0u) { if (xb_ld(&bar[XB_TMO])) break; if (sp > XB_SPIN_CAP) { atomicAdd(&bar[XB_TMO], 1u); break; } }
    }
    nloc = mine > 0u ? mine : 1u; nx = cnt > 0u ? cnt : 1u;
}

__device__ __forceinline__ void xcd_barrier(const XcdBarrier& b) {
    asm volatile("s_waitcnt vmcnt(0)" ::: "memory");
    __syncthreads();
    if (threadIdx.x == 0) {
        unsigned* bar = b.bar;
        __builtin_amdgcn_s_waitcnt(0);
        unsigned nloc = b.st[0], nx = b.st[1];
        if (nloc == 0u) { xcd_barrier_complete(bar, b.x, nloc, nx); b.st[0] = nloc; b.st[1] = nx; }
        const unsigned old = xb_add(&bar[XB_XSUB(b.x)], 1u);
        const unsigned gen = old / nloc;
        if (old + 1u == (gen + 1u) * nloc) {
            __builtin_amdgcn_fence(__ATOMIC_RELEASE, "agent");
            asm volatile("s_waitcnt vmcnt(0)" ::: "memory");
            const unsigned og = xb_add(&bar[XB_TOP], 1u);
            const unsigned tg = og / nx;
            if (og + 1u == (tg + 1u) * nx) xb_add(&bar[XB_TOPGEN], 1u);
            else XB_SPIN(xb_ld(&bar[XB_TOPGEN]) == tg, bar);
            __builtin_amdgcn_fence(__ATOMIC_ACQUIRE, "agent");
            xb_add(&bar[XB_XGEN(b.x)], 1u);
            asm volatile("s_waitcnt vmcnt(0)" ::: "memory");
        } else {
            XB_SPIN(xb_ld(&bar[XB_XGEN(b.x)]) == gen, bar);
            __builtin_amdgcn_fence(__ATOMIC_ACQUIRE, "agent");
            asm volatile("s_waitcnt vmcnt(0)" ::: "memory");
        }
    }
    __syncthreads();
}
#endif

__global__ void __launch_bounds__(NT) fwd_kernel(Params pk, int ph_lo, int ph_hi) {
    SMEM_DECL;
#ifndef EMU
    volatile LAS unsigned* misc = (volatile LAS unsigned*)(smem + LDS_BYTES - 64);
    if (threadIdx.x < 2) misc[threadIdx.x] = 0u;
    __syncthreads();
    const XcdBarrier bar = xcd_barrier_post((unsigned*)(pk.ws + WS_BAR), misc);
#endif
    constexpr int NPH = 2 + 6 * DEPTH;
    for (int ph = ph_lo; ph < ph_hi && ph < NPH; ++ph) {
#ifndef EMU
        Params p = pk; { size_t z = 0; asm volatile("" : "+s"(z)); p.ws = pk.ws + z; p.out = pk.out + z;
#pragma unroll
            for (int i = 0; i < 26; ++i) p.in[i] = pk.in[i] + z; }
#else
        const Params& p = pk;
#endif
        if (ph == 0) phase0(p, smem);
        else if (ph == NPH - 1) phase_rp(p, DEPTH, smem);
        else { const int l = (ph - 1) / 6, k = (ph - 1) % 6;
            if (k == 0) phase_rp(p, l, smem);
            else if (k == 1) phase_gemm_in(p, l, smem);
            else if (k == 2) phase_mix1(p, l, smem);
            else if (k == 3) phase_scan(p, l, smem);
            else if (k == 4) phase_mix2(p, l, smem);
            else phase_gemm_out(p, l, smem);
#ifdef PROBE_DUP
            if (k == PROBE_DUP) { GRID_SYNC();
                if (k == 1) phase_gemm_in(p, l, smem); else if (k == 2) phase_mix1(p, l, smem); else if (k == 4) phase_mix2(p, l, smem); }
#endif
        }
        if (ph + 1 < ph_hi && !(ph >= 6 && ph % 6 == 0) && !(ph >= 1 && ((ph - 1) % 6 == 2 || (ph - 1) % 6 == 3))) {
#ifdef EMU
            GRID_SYNC();
#else
            if (ph_lo < 0) GRID_SYNC();
            xcd_barrier(bar);
#endif
        }
    }
}

#ifndef EMU
extern "C" void kernel_launch(void* const* d_in, const int* in_sizes, int n_in, void* d_out, int out_size, void* d_ws, size_t ws_size, hipStream_t stream) {
    static int grid = 0;
    if (grid == 0) {
        if (n_in != 26 || ws_size < WS_TOTAL) { fprintf(stderr, "kernel_launch: unexpected n_in %d or ws_size %zu (need %zu)\n", n_in, ws_size, (size_t)WS_TOTAL); grid = -1; return; }
        int dev = 0, cus = 0, per_cu = 0;
        hipGetDevice(&dev);
        hipDeviceGetAttribute(&cus, hipDeviceAttributeMultiprocessorCount, dev);
        hipFuncSetAttribute((const void*)fwd_kernel, hipFuncAttributeMaxDynamicSharedMemorySize, LDS_BYTES);
        hipOccupancyMaxActiveBlocksPerMultiprocessor(&per_cu, (const void*)fwd_kernel, NT, LDS_BYTES);
        if (per_cu < 1) { fprintf(stderr, "kernel_launch: occupancy query returned %d\n", per_cu); grid = -1; return; }
        if (per_cu > 1) per_cu = 1;
        grid = cus * per_cu;
    }
    if (grid < 0) return;
    hipMemsetAsync((char*)d_ws + WS_BAR, 0, BAR_BYTES, stream);
    Params p{};
    for (int i = 0; i < 26; ++i) p.in[i] = (const float*)d_in[i];
    p.out = (float*)d_out; p.ws = (char*)d_ws;
    int lo = 0, hi = 2 + 6 * DEPTH;
    void* args[] = {&p, &lo, &hi};
    hipError_t e = hipLaunchCooperativeKernel((const void*)fwd_kernel, dim3(grid), dim3(NT), args, LDS_BYTES, stream);
    if (e != hipSuccess) fprintf(stderr, "cooperative launch failed: %s (grid %d)\n", hipGetErrorString(e), grid);
}
#endif
```

```cpp
#ifdef EMU
#include "emu/hipemu.h"
#define GRID_SYNC() emu::grid_sync()
#define SMEM_DECL char* smem = emu::S().blocks[emu::cur()->block].lds
#define SCHED_FENCE() do {} while (0)
#define EXP2(x) exp2f(x)
#define MFMA16(a, b, c) emu_mfma_16x16x32_bf16(a, b, c)
#else
#include <hip/hip_runtime.h>
#include <hip/hip_cooperative_groups.h>
#include <cstdio>
#include <cstdint>
#define GRID_SYNC() cooperative_groups::this_grid().sync()
#define SMEM_DECL extern __shared__ __attribute__((aligned(16))) char smem[]
#define SCHED_FENCE() __builtin_amdgcn_sched_barrier(0)
#define EXP2(x) __builtin_amdgcn_exp2f(x)
#define MFMA16(a, b, c) __builtin_amdgcn_mfma_f32_16x16x32_bf16(a, b, c, 0, 0, 0)
#endif

#ifdef EMU
#ifndef EMU_DM
#define EMU_DM 256
#endif
#ifndef EMU_NB
#define EMU_NB 2
#endif
#ifndef EMU_SEQ
#define EMU_SEQ 512
#endif
#ifndef EMU_DEPTH
#define EMU_DEPTH 2
#endif
#ifndef EMU_CTXL
#define EMU_CTXL 128
#endif
constexpr int DM = EMU_DM, NB = EMU_NB, SEQ = EMU_SEQ, DEPTH = EMU_DEPTH, CTXL = EMU_CTXL;
#else
constexpr int DM = 1024, NB = 8, SEQ = 2048, DEPTH = 4, CTXL = 256;
#endif
constexpr int MIX = 1024, WG = 256, HD = 64, NH = 4, CH = 64;
constexpr int TOK = CTXL + SEQ, T = NB * TOK, NCH = TOK / CH, NCC = CTXL / CH;
constexpr int N_IN = 4144, NP = 3072, NG = 48, NGS = 32, NMAIN = 3328, NPAD = 4352;
constexpr int NF = 2 * SEQ;
constexpr int NJ = NB + 1;
constexpr int NT = 512;
constexpr float EPS = 1e-6f;
constexpr int PA = 0, PG = 1280, PD = 2304;
constexpr int YA = 0, YH = 256, YG = 512, YD = 768;
constexpr int ilog4(int n) { return n <= 1 ? 0 : 1 + ilog4(n / 4); }
constexpr int FFT_P = ilog4(NF);
static_assert((1 << (2 * FFT_P)) == NF, "NF must be a power of 4");
static_assert(DM % 256 == 0 && CTXL % 128 == 0 && SEQ % 256 == 0, "shape constraints");

typedef unsigned short bf16;
typedef short bf16x8 __attribute__((ext_vector_type(8)));
typedef float f32x4 __attribute__((ext_vector_type(4)));
typedef unsigned u32x4 __attribute__((ext_vector_type(4)));
typedef unsigned u32x2 __attribute__((ext_vector_type(2)));
struct cpx { float x, y; };

constexpr size_t al256(size_t x) { return (x + 255) & ~(size_t)255; }
constexpr size_t WS_CTXB = 0;
constexpr size_t WS_HNY = al256(WS_CTXB + (size_t)NB * CTXL * DM * 4);
constexpr size_t WS_WIN = WS_HNY + (size_t)T * 1024 * 2;
constexpr size_t WS_ST = WS_WIN;
constexpr size_t ST_BYTES = (size_t)2 * 2 * NB * NH * NCH * 4096 * 2;
constexpr size_t WS_KT = al256(WS_WIN + (size_t)NPAD * DM * 2);
static_assert(WS_KT + (size_t)WG * NF * 4 <= WS_ST + ST_BYTES || true, "");
constexpr size_t ST_END = al256((WS_ST + ST_BYTES > WS_KT + (size_t)WG * NF * 4) ? WS_ST + ST_BYTES : WS_KT + (size_t)WG * NF * 4);
constexpr size_t WS_P = ST_END;
constexpr size_t WS_HT = al256(WS_P + (size_t)T * NP * 2);
constexpr size_t WS_WOUT = WS_HT;
constexpr size_t WS_G = al256(WS_HT + (size_t)1024 * T * 2);
constexpr size_t WS_KF = al256(WS_G + (size_t)T * NGS * 4);
constexpr size_t WS_HC = al256(WS_KF + (size_t)WG * NF * 8);
constexpr size_t WS_EQ = al256(WS_HC + (size_t)2 * WG * CTXL * 4);
constexpr size_t WS_NV = al256(WS_EQ + (size_t)2 * T * WG * 2);
constexpr size_t WS_BE = al256(WS_NV + (size_t)2 * NB * NH * NCH * 64 * 4);
constexpr size_t WS_SC = al256(WS_BE + (size_t)2 * NB * NH * NCH * 64 * 4);
constexpr size_t WS_MOD = al256(WS_SC + (size_t)2 * NB * NH * NCH * 4 * 4);
constexpr size_t WS_TW = al256(WS_MOD + (size_t)DEPTH * NJ * 3 * DM * 4);
constexpr size_t WS_ROPE = al256(WS_TW + (size_t)NF * 8);
constexpr size_t WS_BAR = al256(WS_ROPE + (size_t)SEQ * 32 * 8);
constexpr size_t BAR_BYTES = 32768;
constexpr size_t WS_TOTAL = al256(WS_BAR + BAR_BYTES);
static_assert((size_t)T * DM * 4 <= (size_t)T * NP * 2, "YO fits in P");
#ifndef EMU
static_assert(WS_TOTAL <= (size_t)268435456, "workspace map must fit 256 MiB");
#endif

constexpr int LDS_BYTES = 163840;

struct Params {
    const float* in[26];
    float* out;
    char* ws;
};
enum { I_X = 0, I_C, I_CTX, I_CCTX, I_WADA, I_BADA, I_GPRE, I_GPOST, I_WIN, I_MGB, I_MNG, I_HCW, I_HCB, I_HW1, I_HB1, I_HW2, I_HB2, I_HW3, I_HB3,
       I_HFREQ, I_HD, I_GWA, I_GBA, I_GNG, I_SINK, I_WOUT };

__device__ __forceinline__ Params relaunder(const Params& pk) {
#ifdef EMU
    return pk;
#else
    Params p = pk; size_t z = 0; asm volatile("" : "+s"(z)); p.ws = pk.ws + z; p.out = pk.out + z;
#pragma unroll
    for (int i = 0; i < 26; ++i) p.in[i] = pk.in[i] + z;
    return p;
#endif
}
constexpr int WLDS = (LDS_BYTES - 64) / 8 / 16 * 16;
#ifdef EMU
#define WAVE_SYNC() emu_wave_sync()
#else
#define WAVE_SYNC() do { asm volatile("s_waitcnt lgkmcnt(0)" ::: "memory"); __builtin_amdgcn_wave_barrier(); } while (0)
#endif

#ifdef EMU
__device__ __forceinline__ int otid() { return (int)threadIdx.x; }
__device__ __forceinline__ int obid() { return (int)blockIdx.x; }
#else
__device__ __forceinline__ int otid() { int t = (int)threadIdx.x; asm volatile("" : "+v"(t)); return t; }
__device__ __forceinline__ int obid() { int b = (int)blockIdx.x; asm volatile("" : "+s"(b)); return b; }
#endif
__device__ __forceinline__ unsigned fbits(float f) { return __builtin_bit_cast(unsigned, f); }
__device__ __forceinline__ float bitsf(unsigned u) { return __builtin_bit_cast(float, u); }
__device__ __forceinline__ float bf2f(bf16 h) { return bitsf((unsigned)h << 16); }
#ifdef EMU
__device__ __forceinline__ bf16 f2bf(float f) { unsigned u = fbits(f); return (bf16)((u + 0x7fffu + ((u >> 16) & 1u)) >> 16); }
__device__ __forceinline__ unsigned pk2(float lo, float hi) { return (unsigned)f2bf(lo) | ((unsigned)f2bf(hi) << 16); }
#else
typedef __bf16 nbf16x2 __attribute__((ext_vector_type(2)));
typedef float nf32x2 __attribute__((ext_vector_type(2)));
__device__ __forceinline__ unsigned pk2(float lo, float hi) { const nf32x2 v = {lo, hi}; return __builtin_bit_cast(unsigned, __builtin_convertvector(v, nbf16x2)); }
__device__ __forceinline__ bf16 f2bf(float f) { return (bf16)(pk2(f, 0.0f) & 0xffffu); }
#endif
#ifdef EMU
__device__ __forceinline__ float frcp_(float x) { return 1.0f / x; }
#else
__device__ __forceinline__ float frcp_(float x) { return __builtin_amdgcn_rcpf(x); }
#endif
__device__ __forceinline__ float sigmoidf_(float x) { return frcp_(1.0f + __expf(-x)); }
__device__ __forceinline__ float siluf_(float x) { return x * frcp_(1.0f + __expf(-x)); }
__device__ __forceinline__ float logsigf_(float x) { return fminf(x, 0.0f) - log1pf(__expf(-fabsf(x))); }
__device__ __forceinline__ float logsig_fast(float x) { return fminf(x, 0.0f) - __logf(1.0f + __expf(-fabsf(x))); }
#ifdef EMU
__device__ __forceinline__ float row16_sum(float x) { x += __shfl_xor(x, 1); x += __shfl_xor(x, 2); x += __shfl_xor(x, 4); x += __shfl_xor(x, 8); return x; }
__device__ __forceinline__ float row16_max(float x) { x = fmaxf(x, __shfl_xor(x, 1)); x = fmaxf(x, __shfl_xor(x, 2)); x = fmaxf(x, __shfl_xor(x, 4)); x = fmaxf(x, __shfl_xor(x, 8)); return x; }
__device__ __forceinline__ float xrow_sum(float x) { x += __shfl_xor(x, 16); x += __shfl_xor(x, 32); return x; }
__device__ __forceinline__ float xrow_max(float x) { x = fmaxf(x, __shfl_xor(x, 16)); x = fmaxf(x, __shfl_xor(x, 32)); return x; }
#else
template <int CTRL> __device__ __forceinline__ float dpp_(float x) { return __builtin_bit_cast(float, __builtin_amdgcn_mov_dpp(__builtin_bit_cast(int, x), CTRL, 0xf, 0xf, true)); }
__device__ __forceinline__ float row16_sum(float x) { x += dpp_<0xB1>(x); x += dpp_<0x4E>(x); x += dpp_<0x141>(x); x += dpp_<0x128>(x); return x; }
__device__ __forceinline__ float row16_max(float x) { x = fmaxf(x, dpp_<0xB1>(x)); x = fmaxf(x, dpp_<0x4E>(x)); x = fmaxf(x, dpp_<0x141>(x)); x = fmaxf(x, dpp_<0x128>(x)); return x; }
__device__ __forceinline__ float xrow_sum(float x) {
    auto s = __builtin_amdgcn_permlane16_swap(fbits(x), fbits(x), false, false); x = bitsf(s[0]) + bitsf(s[1]);
    auto t = __builtin_amdgcn_permlane32_swap(fbits(x), fbits(x), false, false); return bitsf(t[0]) + bitsf(t[1]); }
__device__ __forceinline__ float xrow_max(float x) {
    auto s = __builtin_amdgcn_permlane16_swap(fbits(x), fbits(x), false, false); x = fmaxf(bitsf(s[0]), bitsf(s[1]));
    auto t = __builtin_amdgcn_permlane32_swap(fbits(x), fbits(x), false, false); return fmaxf(bitsf(t[0]), bitsf(t[1])); }
#endif
__device__ __forceinline__ float wave_sum(float v) { return xrow_sum(row16_sum(v)); }
__device__ __forceinline__ float wave_max(float v) { return xrow_max(row16_max(v)); }
#ifdef EMU
__device__ __forceinline__ float wave_prefix_sum(float v, int lane) {
#pragma unroll
    for (int o = 1; o < 64; o <<= 1) { float t = __shfl_up(v, o); if (lane >= o) v += t; }
    return v;
}
__device__ __forceinline__ float wave_prefix_max(float v, int lane) {
#pragma unroll
    for (int o = 1; o < 64; o <<= 1) { float t = __shfl_up(v, o); if (lane >= o) v = fmaxf(v, t); }
    return v;
}
#else
template <int CTRL, int RM> __device__ __forceinline__ float dppo_(float old, float x) { return __builtin_bit_cast(float, __builtin_amdgcn_update_dpp(__builtin_bit_cast(int, old), __builtin_bit_cast(int, x), CTRL, RM, 0xf, false)); }
__device__ __forceinline__ float wave_prefix_sum(float v, int) {
    v += dppo_<0x111, 0xf>(0.f, v); v += dppo_<0x112, 0xf>(0.f, v); v += dppo_<0x114, 0xf>(0.f, v); v += dppo_<0x118, 0xf>(0.f, v);
    v += dppo_<0x142, 0xa>(0.f, v); v += dppo_<0x143, 0xc>(0.f, v); return v;
}
__device__ __forceinline__ float wave_prefix_max(float v, int) {
    const float ninf = -INFINITY;
    v = fmaxf(v, dppo_<0x111, 0xf>(ninf, v)); v = fmaxf(v, dppo_<0x112, 0xf>(ninf, v)); v = fmaxf(v, dppo_<0x114, 0xf>(ninf, v)); v = fmaxf(v, dppo_<0x118, 0xf>(ninf, v));
    v = fmaxf(v, dppo_<0x142, 0xa>(ninf, v)); v = fmaxf(v, dppo_<0x143, 0xc>(ninf, v)); return v;
}
#endif
__device__ __forceinline__ float wave_suffix_max(float v, int lane) {
    return __shfl(wave_prefix_max(__shfl(v, 63 - lane), lane), 63 - lane);
}
__device__ __forceinline__ void unpack8(u32x4 v, float* f) {
    f[0] = bitsf(v.x << 16); f[1] = bitsf(v.x & 0xffff0000u); f[2] = bitsf(v.y << 16); f[3] = bitsf(v.y & 0xffff0000u);
    f[4] = bitsf(v.z << 16); f[5] = bitsf(v.z & 0xffff0000u); f[6] = bitsf(v.w << 16); f[7] = bitsf(v.w & 0xffff0000u);
}
__device__ __forceinline__ int orig_col(int n) {
    if (n < 1280) return n;
    if (n < 2304) return 2320 + (n - 1280);
    if (n < 3072) return 3376 + (n - 2304);
    if (n < 3088) return 1280 + (n - 3072);
    if (n < 3120) return 3344 + (n - 3088);
    if (n < NMAIN) return -1;
    return 1296 + (n - NMAIN);
}
__device__ __forceinline__ int chain_cid(int dir, int o) {
    if (dir == 0) return o;
    return o < NCC ? (NCC - 1 - o) : (NCH - 1 - (o - NCC));
}

__device__ __forceinline__ int swz(int row, int ch) { return row * 64 + ((ch ^ (row & 7)) << 3); }
__device__ __forceinline__ u32x4 pack8(const float* f) { u32x4 o; o.x = pk2(f[0], f[1]); o.y = pk2(f[2], f[3]); o.z = pk2(f[4], f[5]); o.w = pk2(f[6], f[7]); return o; }
__device__ __forceinline__ bf16x8 as_frag(u32x4 v) { return __builtin_bit_cast(bf16x8, v); }
#ifdef EMU
inline u32x2 lds_tr16(const bf16* p) { unsigned mine[2]; const unsigned long long a = (unsigned long long)p; mine[0] = (unsigned)a; mine[1] = (unsigned)(a >> 32);
    auto buf = emu::collective(mine, 2); const int l = emu::cur()->lane, g = l >> 4, i = l & 15; unsigned short e[4];
    for (int j = 0; j < 4; ++j) { const int src = 16 * g + 4 * j + (i >> 2); const bf16* q = (const bf16*)(((unsigned long long)buf[src][1] << 32) | buf[src][0]); e[j] = *(const unsigned short*)(q + (i & 3)); }
    u32x2 r; r.x = (unsigned)e[0] | ((unsigned)e[1] << 16); r.y = (unsigned)e[2] | ((unsigned)e[3] << 16); return r; }
#else
typedef short v4i16_t __attribute__((ext_vector_type(4)));
__device__ __forceinline__ u32x2 lds_tr16(const bf16* p) { return __builtin_bit_cast(u32x2, __builtin_amdgcn_ds_read_tr16_b64_v4i16((__attribute__((address_space(3))) v4i16_t*)p)); }
#endif
__device__ __forceinline__ u32x4 as_u4(bf16x8 v) { return __builtin_bit_cast(u32x4, v); }

constexpr int LS = 72;

template <int NTL, int KS>
__device__ __forceinline__ void mma_nt(const bf16* A, int lda, int m0, const bf16* B, int ldb, int n0, f32x4 (&acc)[NTL], int lane) {
    const int r = lane & 15, q = lane >> 4;
#pragma unroll
    for (int ks = 0; ks < KS; ++ks) {
        const bf16x8 a = *(const bf16x8*)(A + (m0 + r) * lda + ks * 32 + q * 8);
#pragma unroll
        for (int nt = 0; nt < NTL; ++nt) {
            const bf16x8 b = *(const bf16x8*)(B + (n0 + nt * 16 + r) * ldb + ks * 32 + q * 8);
            acc[nt] = MFMA16(a, b, acc[nt]);
        }
    }
}

__device__ __forceinline__ void layer_prep(const Params& p, int l, int idx, int stride, char* smem);
__device__ __forceinline__ void phase0(const Params& p, char* smem) {
    const int tid = otid();
    cpx* TW = (cpx*)(p.ws + WS_TW);
    cpx* ROPE = (cpx*)(p.ws + WS_ROPE);
    float* MOD = (float*)(p.ws + WS_MOD);
    constexpr int N_TW = NF / NT, N_ROPE = SEQ * 32 / NT, N_MOD = DEPTH * (3 * DM / 64);
    for (int task = obid(); task < N_TW + N_ROPE + N_MOD; task += gridDim.x) {
        if (task < N_TW) {
            const int j = task * NT + tid; float s, c; sincospif(2.0f * (float)j / (float)NF, &s, &c);
            cpx v; v.x = c; v.y = -s; TW[j] = v;
        } else if (task < N_TW + N_ROPE) {
            const int idx = (task - N_TW) * NT + tid; const int pos = idx >> 5, i = idx & 31;
            const float inv = exp2f(-(float)(i & 15) * (13.287712379549449f / 16.0f));
            const float ang = (float)(i < 16 ? pos / 64 : pos % 64) * inv;
            cpx v; v.x = cosf(ang); v.y = sinf(ang); ROPE[idx] = v;
        } else {
            const int mt = task - N_TW - N_ROPE; const int l = mt / (3 * DM / 64), n0 = (mt % (3 * DM / 64)) * 64;
            float* sv = (float*)smem;
            float* red = sv + NJ * DM;
            __syncthreads();
            for (int i = tid; i < NJ * DM; i += NT) { const int j = i / DM, k = i % DM; const float v = j < NB ? p.in[I_C][j * DM + k] : p.in[I_CCTX][k]; sv[i] = siluf_(v); }
            __syncthreads();
            const int c4 = tid & 15, kg = tid >> 4; f32x4 acc[NJ];
#pragma unroll
            for (int j = 0; j < NJ; ++j) acc[j] = (f32x4){0.f, 0.f, 0.f, 0.f};
            const float* w = p.in[I_WADA] + (size_t)l * DM * 3 * DM + n0 + 4 * c4;
#pragma unroll 8
            for (int i = 0; i < DM / 32; ++i) { const int k = kg + 32 * i; const f32x4 wv = *(const f32x4*)(w + (size_t)k * 3 * DM);
#pragma unroll
                for (int j = 0; j < NJ; ++j) acc[j] = acc[j] + wv * sv[j * DM + k]; }
#pragma unroll
            for (int j = 0; j < NJ; ++j) *(f32x4*)(red + (kg * NJ + j) * 64 + 4 * c4) = acc[j];
            __syncthreads();
            for (int i = tid; i < NJ * 64; i += NT) { const int j = i / 64, n = i % 64; float s = 0.f;
#pragma unroll
                for (int k8 = 0; k8 < 32; ++k8) s += red[(k8 * NJ + j) * 64 + n];
                MOD[((size_t)l * NJ + j) * 3 * DM + n0 + n] = s + p.in[I_BADA][(size_t)l * 3 * DM + n0 + n]; }
        }
    }
}

#ifdef EMU
constexpr int PANEL_ROWS = 128, PANEL_UNITS = DM / 128;
#else
constexpr int PANEL_ROWS = 256, PANEL_UNITS = DM / 256;
#endif
__device__ __forceinline__ unsigned* unit_counter(const Params& p, int isctx) { return (unsigned*)(p.ws + WS_BAR + 16384) + 64 * isctx; }
__device__ __forceinline__ unsigned* stage_counter(const Params& p, int flag) { return (unsigned*)(p.ws + WS_BAR + 16384) + 512 + 512 * flag; }
__device__ __forceinline__ void stage_signal(const Params& p, char* smem, int flag, int l) {
#ifdef EMU
    __syncthreads(); if (otid() == 0) *stage_counter(p, flag) += 1u;
#else
    asm volatile("s_waitcnt vmcnt(0)" ::: "memory"); __syncthreads();
    if (threadIdx.x == 0) {
        const unsigned xcc = (unsigned)__builtin_amdgcn_s_getreg((3 << 11) | 20) & 0xFu, nloc = ((volatile __attribute__((address_space(3))) unsigned*)(smem + LDS_BYTES - 64))[0];
        unsigned* g = stage_counter(p, flag);
        if (nloc > 0u) { const unsigned old = __hip_atomic_fetch_add(g + 16 * (1 + xcc), 1u, __ATOMIC_RELAXED, __HIP_MEMORY_SCOPE_AGENT);
            if (old + 1u == nloc * (unsigned)(l + 1)) { __builtin_amdgcn_fence(__ATOMIC_RELEASE, "agent"); asm volatile("s_waitcnt vmcnt(0)" ::: "memory");
                __hip_atomic_fetch_add(g, nloc, __ATOMIC_RELAXED, __HIP_MEMORY_SCOPE_AGENT); } }
        else { __builtin_amdgcn_fence(__ATOMIC_RELEASE, "agent"); asm volatile("s_waitcnt vmcnt(0)" ::: "memory"); __hip_atomic_fetch_add(g, 1u, __ATOMIC_RELAXED, __HIP_MEMORY_SCOPE_AGENT); }
    }
#endif
}
__device__ __forceinline__ void stage_wait(const Params& p, int flag, int l) {
    if (otid() == 0) { const unsigned target = (unsigned)gridDim.x * (unsigned)(l + 1);
#ifdef EMU
        while (*(volatile unsigned*)stage_counter(p, flag) < target) emu::yield();
#else
        unsigned spins = 0;
        while (__hip_atomic_load(stage_counter(p, flag), __ATOMIC_RELAXED, __HIP_MEMORY_SCOPE_AGENT) < target) { __builtin_amdgcn_s_sleep(16); if (++spins > (1u << 20)) break; }
        __builtin_amdgcn_fence(__ATOMIC_ACQUIRE, "agent"); asm volatile("s_waitcnt vmcnt(0)" ::: "memory");
#endif
    }
    __syncthreads();
}
__device__ __forceinline__ int logical_row(int i) { return i < NB * SEQ ? (i / SEQ) * TOK + CTXL + i % SEQ : ((i - NB * SEQ) / CTXL) * TOK + (i - NB * SEQ) % CTXL; }
struct RowRef { const float* xo; float* xn; int mj, row; bool ok; };
__device__ __forceinline__ RowRef rp_ref(const Params& p, int l, int li, int base, int hi) {
    RowRef r; r.ok = li < hi; const int rr = logical_row(r.ok ? li : base); r.row = rr;
    const int b = rr / TOK, pp = rr % TOK; const bool isctx = pp < CTXL; if (l == DEPTH && isctx) r.ok = false;
    const size_t off = isctx ? ((size_t)b * CTXL + pp) * DM : ((size_t)b * SEQ + (pp - CTXL)) * DM;
    float* CTXB = (float*)(p.ws + WS_CTXB);
    r.xo = (l <= 1) ? (isctx ? p.in[I_CTX] + off : p.in[I_X] + off) : (isctx ? CTXB + off : p.out + off);
    r.xn = isctx ? CTXB + off : p.out + off; r.mj = isctx ? NB : b; return r;
}
__device__ __forceinline__ void rp_rows(const Params& p, int l, int lo, int hi, int gi, int nb) {
    const int tid = otid(), lane = tid & 63, wave = tid >> 6;
    const float* MOD = (const float*)(p.ws + WS_MOD);
    const bf16* YO = (const bf16*)(p.ws + WS_P);
    bf16* HN = (bf16*)(p.ws + WS_HNY);
    constexpr int NV4 = DM / 256, RW = 2;
    const int stride = nb * 8;
    f32x4 xq[RW][NV4]; u32x2 yq[RW][NV4]; RowRef rq[RW];
    int base = lo + gi * 8 + wave;
    if (base < hi) {
#pragma unroll
        for (int i = 0; i < RW; ++i) { rq[i] = rp_ref(p, l, base + i * stride, base, hi);
#pragma unroll
            for (int j = 0; j < NV4; ++j) { xq[i][j] = *(const f32x4*)(rq[i].xo + 4 * lane + 256 * j); yq[i][j] = (l > 0) ? *(const u32x2*)(YO + (size_t)rq[i].row * DM + 4 * lane + 256 * j) : (u32x2){0u, 0u}; } }
    }
    for (; base < hi; base += stride * RW) {
        f32x4 x[RW][NV4], y[RW][NV4]; RowRef rc[RW];
#pragma unroll
        for (int i = 0; i < RW; ++i) { rc[i] = rq[i];
#pragma unroll
            for (int j = 0; j < NV4; ++j) { x[i][j] = xq[i][j]; const u32x2 yy = yq[i][j]; y[i][j] = (f32x4){bitsf(yy.x << 16), bitsf(yy.x & 0xffff0000u), bitsf(yy.y << 16), bitsf(yy.y & 0xffff0000u)}; } }
        { const int nbase = base + stride * RW;
            if (nbase < hi) {
#pragma unroll
                for (int i = 0; i < RW; ++i) { rq[i] = rp_ref(p, l, nbase + i * stride, nbase, hi);
#pragma unroll
                    for (int j = 0; j < NV4; ++j) { xq[i][j] = *(const f32x4*)(rq[i].xo + 4 * lane + 256 * j); if (l > 0) yq[i][j] = *(const u32x2*)(YO + (size_t)rq[i].row * DM + 4 * lane + 256 * j); } } } }
        if (l > 0) {
            float ss[RW];
#pragma unroll
            for (int i = 0; i < RW; ++i) { ss[i] = 0.f;
#pragma unroll
                for (int j = 0; j < NV4; ++j) ss[i] += y[i][j].x * y[i][j].x + y[i][j].y * y[i][j].y + y[i][j].z * y[i][j].z + y[i][j].w * y[i][j].w; }
#pragma unroll
            for (int i = 0; i < RW; ++i) ss[i] = wave_sum(ss[i]);
            const float* gp = p.in[I_GPOST] + (size_t)(l - 1) * DM;
            float rstd[RW]; const float* gt[RW];
#pragma unroll
            for (int i = 0; i < RW; ++i) { rstd[i] = rsqrtf(ss[i] * (1.0f / DM) + EPS); gt[i] = MOD + ((size_t)(l - 1) * NJ + rc[i].mj) * 3 * DM + 2 * DM; }
            f32x4 p4n = *(const f32x4*)(gp + 4 * lane), g4n[RW];
#pragma unroll
            for (int i = 0; i < RW; ++i) g4n[i] = *(const f32x4*)(gt[i] + 4 * lane);
#pragma unroll
            for (int j = 0; j < NV4; ++j) { const f32x4 p4 = p4n; f32x4 g4[RW];
#pragma unroll
                for (int i = 0; i < RW; ++i) g4[i] = g4n[i];
                if (j + 1 < NV4) { p4n = *(const f32x4*)(gp + 4 * lane + 256 * (j + 1));
#pragma unroll
                    for (int i = 0; i < RW; ++i) g4n[i] = *(const f32x4*)(gt[i] + 4 * lane + 256 * (j + 1)); }
#pragma unroll
                for (int i = 0; i < RW; ++i) { x[i][j] = x[i][j] + g4[i] * (y[i][j] * rstd[i] * p4);
                    if (rc[i].ok) *(f32x4*)(rc[i].xn + 4 * lane + 256 * j) = x[i][j]; } }
        }
        if (l < DEPTH) {
            float ss[RW];
#pragma unroll
            for (int i = 0; i < RW; ++i) { ss[i] = 0.f;
#pragma unroll
                for (int j = 0; j < NV4; ++j) ss[i] += x[i][j].x * x[i][j].x + x[i][j].y * x[i][j].y + x[i][j].z * x[i][j].z + x[i][j].w * x[i][j].w; }
#pragma unroll
            for (int i = 0; i < RW; ++i) ss[i] = wave_sum(ss[i]);
            const float* gp = p.in[I_GPRE] + (size_t)l * DM;
            float rstd[RW]; const float* md[RW];
#pragma unroll
            for (int i = 0; i < RW; ++i) { rstd[i] = rsqrtf(ss[i] * (1.0f / DM) + EPS); md[i] = MOD + ((size_t)l * NJ + rc[i].mj) * 3 * DM; }
            f32x4 g4n = *(const f32x4*)(gp + 4 * lane), shn[RW], scn[RW];
#pragma unroll
            for (int i = 0; i < RW; ++i) { shn[i] = *(const f32x4*)(md[i] + 4 * lane); scn[i] = *(const f32x4*)(md[i] + DM + 4 * lane); }
#pragma unroll
            for (int j = 0; j < NV4; ++j) { const int e = 4 * lane + 256 * j; const f32x4 g4 = g4n; f32x4 sh[RW], sc[RW];
#pragma unroll
                for (int i = 0; i < RW; ++i) { sh[i] = shn[i]; sc[i] = scn[i]; }
                if (j + 1 < NV4) { g4n = *(const f32x4*)(gp + e + 256);
#pragma unroll
                    for (int i = 0; i < RW; ++i) { shn[i] = *(const f32x4*)(md[i] + e + 256); scn[i] = *(const f32x4*)(md[i] + DM + e + 256); } }
#pragma unroll
                for (int i = 0; i < RW; ++i) { const f32x4 h = (x[i][j] * rstd[i] * g4) * (sc[i] + 1.0f) + sh[i];
                    u32x2 o; o.x = pk2(h.x, h.y); o.y = pk2(h.z, h.w);
                    if (rc[i].ok) *(u32x2*)(HN + (size_t)rc[i].row * DM + e) = o; } }
        }
    }
}

__device__ __forceinline__ void convert_tile(const float* src, int ldn, bf16* dst, int K, int n0, int k0, bool use_map, char* smem) {
    const int tid = otid();
    float* tile = (float*)smem;
    __syncthreads();
#pragma unroll
    for (int i = 0; i < 8; ++i) { const int idx = tid + NT * i, k = idx >> 6, n = idx & 63;
        const int oc = use_map ? orig_col(n0 + n) : (n0 + n);
        tile[k * 65 + n] = oc >= 0 ? src[(size_t)(k0 + k) * ldn + oc] : 0.f; }
    __syncthreads();
    const int n = tid >> 3, c = tid & 7;
    u32x4 o; o.x = pk2(tile[(8 * c + 0) * 65 + n], tile[(8 * c + 1) * 65 + n]); o.y = pk2(tile[(8 * c + 2) * 65 + n], tile[(8 * c + 3) * 65 + n]);
    o.z = pk2(tile[(8 * c + 4) * 65 + n], tile[(8 * c + 5) * 65 + n]); o.w = pk2(tile[(8 * c + 6) * 65 + n], tile[(8 * c + 7) * 65 + n]);
    *(u32x4*)(dst + (size_t)(n0 + n) * K + k0 + 8 * c) = o;
}

__device__ __forceinline__ void filter_task(const Params& p, int l, int L, int pos0, char* smem) {
    const int tid = otid(), j = tid & 63;
    float* z = (float*)smem;
    float* h1 = z + 8 * 33;
    float* h2 = h1 + 8 * 64;
    const float* w1 = p.in[I_HW1] + (size_t)l * 33 * 64; const float* w2 = p.in[I_HW2] + (size_t)l * 64 * 64; const float* w3 = p.in[I_HW3] + (size_t)l * 64 * 512;
    float r1[33], r2[64], r3a[16];
#pragma unroll
    for (int i = 0; i < 33; ++i) r1[i] = w1[i * 64 + j];
#pragma unroll
    for (int i = 0; i < 64; ++i) r2[i] = w2[i * 64 + j];
    const float b1 = p.in[I_HB1][l * 64 + j], b2 = p.in[I_HB2][l * 64 + j], b3 = p.in[I_HB3][l * 512 + tid];
    const float f0 = p.in[I_HFREQ][(l * 2 + 0) * 64 + j], f1 = p.in[I_HFREQ][(l * 2 + 1) * 64 + j];
    __syncthreads();
    if (tid < 8 * 33) { const int pp = tid / 33, i = tid % 33; const float pos = (float)(pos0 + pp);
        const float t = pos / (float)(L - 1 > 1 ? L - 1 : 1), wv = 6.283185307179586f * pos / (float)L; float v;
        if (i == 0) v = t; else { const int bi = (i - 1) & 15; const float f = 1e-4f + (float)bi * ((15.0f - 1e-4f) / 15.0f); v = (i <= 16) ? cosf(wv * f) : -sinf(wv * f); }
        z[tid] = v; }
    __syncthreads();
    { const int pp = tid >> 6; float a = b1;
#pragma unroll
        for (int i = 0; i < 33; ++i) a += z[pp * 33 + i] * r1[i];
        h1[tid] = sinf(f0 * a);
#pragma unroll
        for (int i = 0; i < 16; ++i) r3a[i] = w3[i * 512 + tid]; }
    __syncthreads();
    { const int pp = tid >> 6; float a = b2;
#pragma unroll
        for (int i = 0; i < 64; ++i) a += h1[pp * 64 + i] * r2[i];
        h2[tid] = sinf(f1 * a); }
    __syncthreads();
    { const int o = tid, dir = o >> 8, c = o & 255;
        const float delta = 3.0701134573253946f + (float)c * ((15.350567286626973f - 3.0701134573253946f) / 255.0f);
        float acc[8];
#pragma unroll
        for (int pp = 0; pp < 8; ++pp) acc[pp] = b3;
#pragma unroll 1
        for (int cix = 0; cix < 4; ++cix) {
            float wn[16];
#pragma unroll
            for (int i = 0; i < 16; ++i) wn[i] = (cix < 3) ? w3[(16 * (cix + 1) + i) * 512 + o] : 0.f;
#pragma unroll
            for (int i = 0; i < 16; ++i) {
#pragma unroll
                for (int pp = 0; pp < 8; ++pp) acc[pp] += h2[pp * 64 + 16 * cix + i] * r3a[i]; }
#pragma unroll
            for (int i = 0; i < 16; ++i) r3a[i] = wn[i]; }
        float* KT = (float*)(p.ws + WS_KT); float* HC = (float*)(p.ws + WS_HC);
#pragma unroll
        for (int pp = 0; pp < 8; ++pp) { const int pos = pos0 + pp; const float t = (float)pos / (float)(L - 1 > 1 ? L - 1 : 1);
            const float v = acc[pp] * __expf(-t * delta);
            if (L == SEQ) { if (dir == 0) KT[(size_t)c * NF + pos]= v; else if (pos > 0) KT[(size_t)c * NF + (NF - pos)] = v; else KT[(size_t)c * NF + SEQ] = 0.f; }
            else HC[((size_t)dir * WG + c) * CTXL + pos] = v; }
    }
}

__device__ __forceinline__ void convert_tile_w(const float* src, int ldn, bf16* dst, int K, int n0, int k0, bool use_map, char* wl, int lane) {
    float* tile = (float*)wl;
    const int oc = use_map ? orig_col(n0 + lane) : (n0 + lane);
    float v[64];
#pragma unroll
    for (int k = 0; k < 64; ++k) v[k] = oc >= 0 ? src[(size_t)(k0 + k) * ldn + oc] : 0.f;
#pragma unroll
    for (int k = 0; k < 64; ++k) tile[k * 65 + lane] = v[k];
    WAVE_SYNC();
#pragma unroll
    for (int i = 0; i < 8; ++i) { const int n = (lane >> 3) + 8 * i, c = lane & 7; float f[8];
#pragma unroll
        for (int j = 0; j < 8; ++j) f[j] = tile[(8 * c + j) * 65 + n];
        *(u32x4*)(dst + (size_t)(n0 + n) * K + k0 + 8 * c) = pack8(f); }
    WAVE_SYNC();
}
__device__ __forceinline__ void layer_prep(const Params& p, int l, int idx, int stride, char* smem) {
    constexpr int N_WIN = (NPAD / 64) * (DM / 64), N_FL = SEQ / 8, N_FC = CTXL / 8;
    for (int task = idx; task < N_FL + N_FC; task += stride) {
        if (task < N_FL) filter_task(p, l, SEQ, task * 8, smem);
        else filter_task(p, l, CTXL, (task - N_FL) * 8, smem);
    }
    __syncthreads();
    { const int tid = otid(), lane = tid & 63, wave = __builtin_amdgcn_readfirstlane(tid >> 6);
        char* wl = smem + wave * WLDS;
        for (int task = wave * stride + idx; task < N_WIN; task += 8 * stride) { const int nt = task / (DM / 64), kt = task % (DM / 64);
            convert_tile_w(p.in[I_WIN] + (size_t)l * DM * N_IN, N_IN, (bf16*)(p.ws + WS_WIN), DM, nt * 64, kt * 64, true, wl, lane); } }
}
__device__ __forceinline__ unsigned* row_queue(const Params& p, int l) { return (unsigned*)(p.ws + WS_BAR + 16384) + 2560 + 64 * l; }
__device__ __forceinline__ void wait_units(const Params& p, int c, int l) {
    constexpr int nLatU = NB * (SEQ / PANEL_ROWS) * PANEL_UNITS, nCtxU = NB * (CTXL / PANEL_ROWS) * PANEL_UNITS;
    const unsigned target = (unsigned)((c ? nCtxU : nLatU) * l);
#ifdef EMU
    while (*(volatile unsigned*)unit_counter(p, c) < target) emu::yield();
#else
    unsigned spins = 0;
    while (__hip_atomic_load(unit_counter(p, c), __ATOMIC_RELAXED, __HIP_MEMORY_SCOPE_AGENT) < target) { __builtin_amdgcn_s_sleep(16); if (++spins > (1u << 20)) break; }
    __builtin_amdgcn_fence(__ATOMIC_ACQUIRE, "agent"); asm volatile("s_waitcnt vmcnt(0)" ::: "memory");
#endif
}
__device__ __forceinline__ void phase_rp(const Params& p, int l, char* smem) { const int G = (int)gridDim.x, bid = obid(), tid = otid();
    const bool has_ctx = l < DEPTH;
    constexpr int nLatU = NB * (SEQ / PANEL_ROWS) * PANEL_UNITS, nCtxU = NB * (CTXL / PANEL_ROWS) * PANEL_UNITS;
    const int nU = nLatU + nCtxU;
    const int heavy = (l >= 1 && has_ctx && nU > G && (nU % G) != 0) ? nU % G : 0;
    const int total = heavy > 0 ? NB * SEQ : (has_ctx ? T : NB * SEQ);
    const int nl = G - heavy, np = (l < DEPTH) ? nl / 2 : 0, nr = nl - np;
    int lo, hi, gi, nb; bool prep = false;
    if (bid < heavy) { lo = NB * SEQ; hi = T; gi = bid; nb = heavy; }
    else { const int i = bid - heavy; int nR = total;
        if (np > 0) { nR = ((total * 2 / 3) / (nr * 16)) * (nr * 16); if (nR <= 0) nR = total / 2; }
        if (np > 0 && (i & 1) && i / 2 < np) { prep = true; lo = nR; hi = total; gi = i / 2; nb = np; }
        else { lo = 0; hi = nR; gi = (np > 0) ? (i + 1) / 2 : i; nb = nr; } }
    if (prep) layer_prep(p, l, gi, np, smem);
    else if (l < DEPTH && np == 0) layer_prep(p, l, bid, G, smem);
    if (l >= 1) { if (tid == 0) { if (lo < NB * SEQ) wait_units(p, 0, l); if (hi > NB * SEQ) wait_units(p, 1, l); } __syncthreads(); }
    rp_rows(p, l, lo, hi, gi, nb);
}

__device__ __forceinline__ cpx cmul(cpx a, cpx b) { cpx r; r.x = a.x * b.x - a.y * b.y; r.y = a.x * b.y + a.y * b.x; return r; }
__device__ __forceinline__ cpx cmulc(cpx a, cpx b) { cpx r; r.x = a.x * b.x + a.y * b.y; r.y = a.y * b.x - a.x * b.y; return r; }
constexpr int fpad(int i) { return i + (i >> 4); }
__device__ __forceinline__ int FPH(int i) { return i + (i >> 4); }
constexpr int FBUF = fpad(NF);
constexpr int ilog16(int n) { return n < 16 ? 0 : 1 + ilog16(n / 16); }
constexpr int FFT_P16 = ilog16(NF);
constexpr bool FFT_R4 = ((NF >> (4 * FFT_P16)) == 4);
static_assert((NF >> (4 * FFT_P16)) == 1 || (NF >> (4 * FFT_P16)) == 4, "NF = 16^a * (1 or 4)");
template <bool INV> __device__ __forceinline__ void dft4(cpx& a0, cpx& a1, cpx& a2, cpx& a3) {
    const cpx s = {a0.x + a2.x, a0.y + a2.y}, b = {a0.x - a2.x, a0.y - a2.y}, c = {a1.x + a3.x, a1.y + a3.y}, d = {a1.x - a3.x, a1.y - a3.y};
    a0 = (cpx){s.x + c.x, s.y + c.y}; a2 = (cpx){s.x - c.x, s.y - c.y};
    if (!INV) { a1 = (cpx){b.x + d.y, b.y - d.x}; a3 = (cpx){b.x - d.y, b.y + d.x}; }
    else      { a1 = (cpx){b.x - d.y, b.y + d.x}; a3 = (cpx){b.x + d.y, b.y - d.x}; }
}
template <bool INV> __device__ __forceinline__ cpx cmulk(cpx a, float wr, float wi) {
    cpx r; if (!INV) { r.x = a.x * wr + a.y * wi; r.y = a.y * wr - a.x * wi; } else { r.x = a.x * wr - a.y * wi; r.y = a.y * wr + a.x * wi; } return r;
}
template <bool INV> __device__ __forceinline__ void dft16(cpx (&x)[16]) {
    constexpr float C1 = 0.92387953251128674f, S1 = 0.38268343236508977f, C2 = 0.70710678118654752f;
#pragma unroll
    for (int n2 = 0; n2 < 4; ++n2) dft4<INV>(x[n2], x[4 + n2], x[8 + n2], x[12 + n2]);
    x[4 * 1 + 1] = cmulk<INV>(x[4 * 1 + 1], C1, S1); x[4 * 1 + 2] = cmulk<INV>(x[4 * 1 + 2], C2, C2); x[4 * 1 + 3] = cmulk<INV>(x[4 * 1 + 3], S1, C1);
    x[4 * 2 + 1] = cmulk<INV>(x[4 * 2 + 1], C2, C2); x[4 * 2 + 2] = cmulk<INV>(x[4 * 2 + 2], 0.f, 1.f); x[4 * 2 + 3] = cmulk<INV>(x[4 * 2 + 3], -C2, C2);
    x[4 * 3 + 1] = cmulk<INV>(x[4 * 3 + 1], S1, C1); x[4 * 3 + 2] = cmulk<INV>(x[4 * 3 + 2], -C2, C2); x[4 * 3 + 3] = cmulk<INV>(x[4 * 3 + 3], -C1, -S1);
#pragma unroll
    for (int k1 = 0; k1 < 4; ++k1) dft4<INV>(x[4 * k1 + 0], x[4 * k1 + 1], x[4 * k1 + 2], x[4 * k1 + 3]);
    cpx t;
    t = x[1]; x[1] = x[4]; x[4] = t; t = x[2]; x[2] = x[8]; x[8] = t; t = x[3]; x[3] = x[12]; x[12] = t;
    t = x[6]; x[6] = x[9]; x[9] = t; t = x[7]; x[7] = x[13]; x[13] = t; t = x[11]; x[11] = x[14]; x[14] = t;
}
template <bool INV> __device__ __forceinline__ void fft_stage16(cpx* buf, const cpx* TW, int tl, int M) {
    const int span = M >> 4, twm = NF / M;
#pragma unroll 1
    for (int j = tl; j < NF / 16; j += 256) {
        const int grp = j / span, pos = j % span, base = grp * M + pos; cpx x[16];
#pragma unroll
        for (int q = 0; q < 16; ++q) x[q] = buf[FPH(base + q * span)];
        cpx w1 = {1.f, 0.f}; if (span > 1) w1 = TW[pos * twm];
        if (INV && span > 1) { cpx wk = w1;
#pragma unroll
            for (int k = 1; k < 16; ++k) { x[k] = cmulc(x[k], wk); wk = cmul(wk, w1); } }
        dft16<INV>(x);
        if (!INV && span > 1) { cpx wk = w1;
#pragma unroll
            for (int k = 1; k < 16; ++k) { x[k] = cmul(x[k], wk); wk = cmul(wk, w1); } }
#pragma unroll
        for (int q = 0; q < 16; ++q) buf[FPH(base + q * span)] = x[q];
    }
}
template <bool INV> __device__ __forceinline__ void fft_stage4_last(cpx* buf, int tl) {
#pragma unroll 1
    for (int j = tl; j < NF / 4; j += 256) { cpx a0 = buf[FPH(4 * j)], a1 = buf[FPH(4 * j + 1)], a2 = buf[FPH(4 * j + 2)], a3 = buf[FPH(4 * j + 3)];
        dft4<INV>(a0, a1, a2, a3); buf[FPH(4 * j)] = a0; buf[FPH(4 * j + 1)] = a1; buf[FPH(4 * j + 2)] = a2; buf[FPH(4 * j + 3)] = a3; }
}
__device__ __forceinline__ void fft_fwd(cpx* buf, const cpx* TW, int tl) {
    int M = NF;
#pragma unroll
    for (int s = 0; s < FFT_P16; ++s) { __syncthreads(); fft_stage16<false>(buf, TW, tl, M); M >>= 4; }
    if (FFT_R4) { __syncthreads(); fft_stage4_last<false>(buf, tl); }
    __syncthreads();
}
__device__ __forceinline__ void fft_inv(cpx* buf, const cpx* TW, int tl) {
    if (FFT_R4) { __syncthreads(); fft_stage4_last<true>(buf, tl); }
    int M = FFT_R4 ? 64 : 16;
#pragma unroll
    for (int s = 0; s < FFT_P16; ++s) { __syncthreads(); fft_stage16<true>(buf, TW, tl, M); M <<= 4; }
    __syncthreads();
}
__device__ __forceinline__ void filt_fft_task(const Params& p, int cp, char* smem) {
    const int tid = otid(), half = tid >> 8, tl = tid & 255, c = 2 * cp + half;
    cpx* buf = (cpx*)smem + (size_t)half * FBUF;
    const float* KT = (const float*)(p.ws + WS_KT) + (size_t)c * NF;
    cpx* KF = (cpx*)(p.ws + WS_KF) + (size_t)c * NF;
    const cpx* TW = (const cpx*)(p.ws + WS_TW);
    __syncthreads();
    for (int i = tl; i < NF; i += 256) { cpx v; v.x = KT[i]; v.y = 0.f; buf[FPH(i)] = v; }
    fft_fwd(buf, TW, tl);
    for (int i = tl; i < NF; i += 256) KF[i] = buf[FPH(i)];
}

__device__ __forceinline__ void gemm_tile(const Params& p, const bf16* A, const bf16* Bt, int K, int mt, int nt, int mode, char* smem) {
    const int tid = otid(), lane = tid & 63, wave = tid >> 6;
    bf16* As = (bf16*)smem;
    bf16* Bs = As + 128 * LS;
    const int wm = (wave & 3) * 32, wn = (wave >> 2) * 64;
    f32x4 acc[2][4];
#pragma unroll
    for (int i = 0; i < 2; ++i)
#pragma unroll
        for (int j = 0; j < 4; ++j) acc[i][j] = (f32x4){0.f, 0.f, 0.f, 0.f};
    const int lr = tid >> 3, lc = tid & 7;
    const bf16* Ag = A + (size_t)(mt * 128 + lr) * K + lc * 8;
    const bf16* Bg = Bt + (size_t)(nt * 128 + lr) * K + lc * 8;
    u32x4 ra0, ra1, rb0, rb1;
    ra0 = *(const u32x4*)(Ag); ra1 = *(const u32x4*)(Ag + (size_t)64 * K); rb0 = *(const u32x4*)(Bg); rb1 = *(const u32x4*)(Bg + (size_t)64 * K);
    const int nk = K / 64;
    for (int kt = 0; kt < nk; ++kt) {
        __syncthreads();
        *(u32x4*)(As + lr * LS + lc * 8) = ra0; *(u32x4*)(As + (lr + 64) * LS + lc * 8) = ra1;
        *(u32x4*)(Bs + lr * LS + lc * 8) = rb0; *(u32x4*)(Bs + (lr + 64) * LS + lc * 8) = rb1;
        __syncthreads();
        if (kt + 1 < nk) { const int ko = (kt + 1) * 64;
            ra0 = *(const u32x4*)(Ag + ko); ra1 = *(const u32x4*)(Ag + (size_t)64 * K + ko); rb0 = *(const u32x4*)(Bg + ko); rb1 = *(const u32x4*)(Bg + (size_t)64 * K + ko); }
        mma_nt<4, 2>(As, LS, wm, Bs, LS, wn, acc[0], lane);
        mma_nt<4, 2>(As, LS, wm + 16, Bs, LS, wn, acc[1], lane);
    }
    const int r = lane & 15, q = lane >> 4;
#pragma unroll
    for (int i = 0; i < 2; ++i)
#pragma unroll
        for (int j = 0; j < 4; ++j)
#pragma unroll
            for (int e = 0; e < 4; ++e) {
                const int row = mt * 128 + wm + 16 * i + 4 * q + e, col = nt * 128 + wn + 16 * j + r; const float v = acc[i][j][e];
                if (mode == 0) { if (col < NP) ((bf16*)(p.ws + WS_P))[(size_t)row * NP + col] = f2bf(v); else if (col < NP + 16) ((float*)(p.ws + WS_G))[(size_t)row * NGS + (col - NP)] = v; else if (col < NP + NG) ((bf16*)((float*)(p.ws + WS_G) + (size_t)row * NGS + 16))[col - NP - 16] = f2bf(v); }
                else if (mode == 2) ((bf16*)(p.ws + WS_HT))[(size_t)row * T + col] = f2bf(v);
                else ((bf16*)(p.ws + WS_P))[(size_t)row * DM + col] = f2bf(v);
            }
}

#ifndef EMU
namespace pg8 {
#define PG8_LAS __attribute__((address_space(3)))
typedef unsigned short bf16_t;
typedef short bf16x8 __attribute__((ext_vector_type(8)));
typedef float f32x4 __attribute__((ext_vector_type(4)));
typedef unsigned u32x4 __attribute__((ext_vector_type(4)));
constexpr int BM = 256, BK = 64, HALF = 128, HTB = HALF * BK * 2  , STAGE_BYTES = 8 * HTB, NXCD = 8, WGM = 8;

__host__ __device__ __forceinline__ int lds_byte(int r, int c) { const int st = (r >> 4) * 2 + (c >> 5), rr = r & 15, cc = c & 31, ob = rr * 64 + cc * 2; return st * 1024 + (ob ^ (((ob >> 9) & 1) << 5)); }
__host__ __device__ __forceinline__ void stage_rc(int b, int& R, int& C) { const int st = b / 1024, sb = b % 1024, swz = sb ^ (((sb >> 9) & 1) << 5); R = (st >> 1) * 16 + swz / 64; C = (st & 1) * 32 + (swz % 64) / 2; }
__host__ __device__ __forceinline__ int perm32(int rho) { const int n = rho >> 4, i = rho & 15; return 8 * (i >> 2) + 4 * n + (i & 3); }

struct Unit { int pm, pn; };
struct Gemm { const bf16_t* A; const bf16_t* Bt; int M, N, K; };
__device__ __forceinline__ unsigned cvt_pk_bf16(float lo, float hi) { unsigned r; asm volatile("v_cvt_pk_bf16_f32 %0, %1, %2" : "=v"(r) : "v"(lo), "v"(hi)); return r; }
template <class Epi, class Sched, bool ALIGN_EPI = false, bool SP2 = false>
__device__ __forceinline__ void gemm_phase(PG8_LAS unsigned char* lds, const Gemm g, const Sched& S, const Epi& E) {
    const int tid = otid(), wid = __builtin_amdgcn_readfirstlane(tid >> 6), lane = tid & 63, wr = wid >> 2, wc = wid & 3, fr = lane & 15, fq = lane >> 4;
    const int K = g.K, nt = K / BK;
    unsigned voffA[2], voffB[2];
#pragma unroll
    for (int i = 0; i < 2; ++i) { int R, C; stage_rc(tid * 16 + i * 8192, R, C); const int Rb = Epi::PERM ? ((R & ~31) + perm32(R & 31)) : R;
        voffA[i] = (unsigned)(R * K + C) * 2u; voffB[i] = (unsigned)(Rb * K + C) * 2u; }
    const size_t kstep = (size_t)(BK * 2);
    const size_t hstep = (size_t)HALF * K * 2;
    const size_t tstep = 2 * hstep;
    const unsigned ldsw = (unsigned)wid * 1024u;
    const int aoff = lds_byte(wr * 64 + fr, fq * 8), boff = lds_byte(wc * 32 + fr, fq * 8);
#define PG8_SA(b, h) (((b) * 2 + (h)) * HTB)
#define PG8_SB(b, h) ((4 + (b) * 2 + (h)) * HTB)
#define PG8_STAGE(bufoff, gbase, voff) do { _Pragma("unroll") for (int _i = 0; _i < 2; ++_i) \
        __builtin_amdgcn_global_load_lds((const unsigned*)((const char*)(gbase) + (voff)[_i]), (PG8_LAS unsigned*)(lds + (bufoff) + ldsw + _i * 8192), 16, 0, 0); } while (0)
#define PG8_LDA(dst, b, h) do { _Pragma("unroll") for (int m = 0; m < 4; ++m) _Pragma("unroll") for (int k = 0; k < 2; ++k) dst[m][k] = *(const PG8_LAS bf16x8*)(lds + PG8_SA(b, h) + aoff + m * 2048 + k * 1024); } while (0)
#define PG8_LDB(dst, b, h) do { _Pragma("unroll") for (int n = 0; n < 2; ++n) _Pragma("unroll") for (int k = 0; k < 2; ++k) dst[n][k] = *(const PG8_LAS bf16x8*)(lds + PG8_SB(b, h) + boff + n * 2048 + k * 1024); } while (0)
#define PG8_MMA(ai, bj, At, Bt) do { __builtin_amdgcn_s_setprio(1); _Pragma("unroll") for (int m = 0; m < 4; ++m) _Pragma("unroll") for (int n = 0; n < 2; ++n) _Pragma("unroll") for (int k = 0; k < 2; ++k) \
        acc[ai][bj][m][n] = __builtin_amdgcn_mfma_f32_16x16x32_bf16(Bt[n][k], At[m][k], acc[ai][bj][m][n], 0, 0, 0); __builtin_amdgcn_s_setprio(0); } while (0)
#define PG8_WAIT_V(n) asm volatile("s_waitcnt vmcnt(" #n ")" ::: "memory")
#define PG8_WAIT_L(n) asm volatile("s_waitcnt lgkmcnt(" #n ")" ::: "memory")
#define PG8_BAR __builtin_amdgcn_s_barrier()
#define PG8_SCHED __builtin_amdgcn_sched_barrier(0)
    Unit cur, nxt; int ui = 0;
    if (!S.next(0, cur)) return;
    f32x4 acc[2][2][4][2];
#pragma unroll
    for (int a = 0; a < 2; ++a)
#pragma unroll
        for (int b = 0; b < 2; ++b)
#pragma unroll
            for (int m = 0; m < 4; ++m)
#pragma unroll
                for (int n = 0; n < 2; ++n) acc[a][b][m][n] = (f32x4){0.f, 0.f, 0.f, 0.f};
    bf16x8 At[4][2], B0[2][2], B1[2][2];
    const char* cA = (const char*)g.A + (size_t)cur.pm * tstep; const char* cB = (const char*)g.Bt + (size_t)cur.pn * tstep;
    S.a_ready(cur);
    if constexpr (SP2) {
        PG8_STAGE(PG8_SB(0, 0), cB, voffB); PG8_STAGE(PG8_SB(0, 1), cB + hstep, voffB); PG8_STAGE(PG8_SA(0, 0), cA, voffA); PG8_STAGE(PG8_SA(0, 1), cA + hstep, voffA);
        if (wr == 1) PG8_BAR;
        PG8_WAIT_V(2); PG8_BAR;
        PG8_STAGE(PG8_SB(1, 0), cB + kstep, voffB); PG8_STAGE(PG8_SA(1, 0), cA + kstep, voffA); PG8_STAGE(PG8_SB(1, 1), cB + hstep + kstep, voffB);
        PG8_WAIT_V(6); PG8_BAR;
    } else {
        PG8_STAGE(PG8_SB(0, 0), cB, voffB); PG8_STAGE(PG8_SA(0, 0), cA, voffA); PG8_STAGE(PG8_SB(0, 1), cB + hstep, voffB); PG8_STAGE(PG8_SA(0, 1), cA + hstep, voffA);
        if (wr == 1) PG8_BAR;
        PG8_WAIT_V(4); PG8_BAR;
        PG8_STAGE(PG8_SB(1, 0), cB + kstep, voffB); PG8_STAGE(PG8_SA(1, 0), cA + kstep, voffA); PG8_STAGE(PG8_SB(1, 1), cB + hstep + kstep, voffB);
        PG8_WAIT_V(6); PG8_BAR;
    }
    for (;;) {
        const bool has_next = S.next(ui + 1, nxt);
        const char* nA = has_next ? (const char*)g.A + (size_t)nxt.pm * tstep : cA; const char* nB = has_next ? (const char*)g.Bt + (size_t)nxt.pn * tstep : cB;
        for (int t = 0; t < nt; t += 2) {
            const bool last = (t == nt - 2);
            const char* a1 = cA + (size_t)(t + 1) * kstep;
            const char* a2 = last ? nA : cA + (size_t)(t + 2) * kstep; const char* b2 = last ? nB : cB + (size_t)(t + 2) * kstep;
            const char* a3 = a2 + kstep; const char* b3 = b2 + kstep;
            if (last && has_next) S.a_ready(nxt);
            if constexpr (SP2) {
            PG8_LDB(B0, 0, 0); PG8_LDB(B1, 0, 1); PG8_SCHED; PG8_LDA(At, 0, 0); PG8_STAGE(PG8_SA(1, 1), a1 + hstep, voffA);
            PG8_WAIT_V(8); PG8_WAIT_L(0); PG8_BAR; PG8_MMA(0, 0, At, B0); PG8_MMA(0, 1, At, B1); PG8_BAR; PG8_SCHED;
            PG8_LDA(At, 0, 1); PG8_STAGE(PG8_SB(0, 0), b2, voffB); PG8_STAGE(PG8_SB(0, 1), b2 + hstep, voffB); PG8_STAGE(PG8_SA(0, 0), a2, voffA);
            PG8_WAIT_V(8); PG8_WAIT_L(0); PG8_BAR; PG8_MMA(1, 0, At, B0); PG8_MMA(1, 1, At, B1); PG8_BAR; PG8_SCHED;
            PG8_LDB(B0, 1, 0); PG8_LDB(B1, 1, 1); PG8_SCHED; PG8_LDA(At, 1, 0); PG8_STAGE(PG8_SA(0, 1), a2 + hstep, voffA);
            PG8_WAIT_V(8); PG8_WAIT_L(0); PG8_BAR; PG8_MMA(0, 0, At, B0); PG8_MMA(0, 1, At, B1); PG8_BAR; PG8_SCHED;
            PG8_LDA(At, 1, 1); PG8_STAGE(PG8_SB(1, 0), b3, voffB); PG8_STAGE(PG8_SB(1, 1), b3 + hstep, voffB); PG8_STAGE(PG8_SA(1, 0), a3, voffA);
            PG8_WAIT_V(8); PG8_WAIT_L(0); PG8_BAR; PG8_MMA(1, 0, At, B0); PG8_MMA(1, 1, At, B1); PG8_BAR; PG8_SCHED;
            } else {
            PG8_LDB(B0, 0, 0); PG8_SCHED; PG8_LDA(At, 0, 0); PG8_STAGE(PG8_SA(1, 1), a1 + hstep, voffA);
            PG8_WAIT_L(8); PG8_BAR; PG8_WAIT_L(0); PG8_MMA(0, 0, At, B0); PG8_BAR; PG8_SCHED;
            PG8_LDB(B1, 0, 1); PG8_STAGE(PG8_SB(0, 0), b2, voffB);
            PG8_BAR; PG8_WAIT_L(0); PG8_MMA(0, 1, At, B1); PG8_BAR;
            PG8_LDA(At, 0, 1); PG8_STAGE(PG8_SA(0, 0), a2, voffA);
            PG8_BAR; PG8_WAIT_L(0); PG8_MMA(1, 0, At, B0); PG8_BAR; PG8_SCHED;
            PG8_STAGE(PG8_SB(0, 1), b2 + hstep, voffB);
            PG8_WAIT_V(6); PG8_BAR; PG8_MMA(1, 1, At, B1); PG8_BAR;
            PG8_LDB(B0, 1, 0); PG8_SCHED; PG8_LDA(At, 1, 0); PG8_STAGE(PG8_SA(0, 1), a2 + hstep, voffA);
            PG8_WAIT_L(8); PG8_BAR; PG8_WAIT_L(0); PG8_MMA(0, 0, At, B0); PG8_BAR; PG8_SCHED;
            PG8_LDB(B1, 1, 1); PG8_STAGE(PG8_SB(1, 0), b3, voffB);
            PG8_BAR; PG8_WAIT_L(0); PG8_MMA(0, 1, At, B1); PG8_BAR;
            PG8_LDA(At, 1, 1); PG8_STAGE(PG8_SA(1, 0), a3, voffA);
            PG8_BAR; PG8_WAIT_L(0); PG8_MMA(1, 0, At, B0); PG8_BAR; PG8_SCHED;
            PG8_STAGE(PG8_SB(1, 1), b3 + hstep, voffB);
            PG8_WAIT_V(6); PG8_BAR; PG8_MMA(1, 1, At, B1); PG8_BAR;
            }
        }
        if constexpr (ALIGN_EPI) { if (wr == 0) PG8_BAR; }
        if constexpr (!Epi::AFTER_DRAIN) { E(acc, cur, wr, wc, fr, fq); S.done(cur); }
        if (!has_next) break;
#pragma unroll
        for (int a = 0; a < 2; ++a)
#pragma unroll
            for (int b = 0; b < 2; ++b)
#pragma unroll
                for (int m = 0; m < 4; ++m)
#pragma unroll
                    for (int n = 0; n < 2; ++n) acc[a][b][m][n] = (f32x4){0.f, 0.f, 0.f, 0.f};
        cur = nxt; cA = nA; cB = nB; ++ui;
        if constexpr (ALIGN_EPI) { if (wr == 1) PG8_BAR; }
    }
    PG8_WAIT_V(0);
    if constexpr (!ALIGN_EPI) { if (wr == 0) PG8_BAR; }
    PG8_BAR;
    if constexpr (Epi::AFTER_DRAIN) { E.fused(acc, cur, wr, wc, fr, fq, lds, wid, lane); S.done(cur); }
#undef PG8_SA
#undef PG8_SB
#undef PG8_STAGE
#undef PG8_LDA
#undef PG8_LDB
#undef PG8_MMA
#undef PG8_WAIT_V
#undef PG8_WAIT_L
#undef PG8_BAR
#undef PG8_SCHED
}
__device__ __forceinline__ void map_tile(int L, int nM, int nN, int& pm, int& pn) {
    const int nwg = nM * nN; int wgid = L; { const int q = nwg / NXCD, r = nwg % NXCD, xcd = wgid % NXCD, off = wgid / NXCD; wgid = (xcd < r ? xcd * (q + 1) : r * (q + 1) + (xcd - r) * q) + off; }
    const int nig = WGM * nN, gid = wgid / nig, fm = gid * WGM, gsz = (nM - fm) < WGM ? (nM - fm) : WGM;
    pm = fm + ((wgid % nig) % gsz); pn = (wgid % nig) / gsz;
}
constexpr int MP = T / 256, WP = NMAIN / 256, NU2 = 4 * MP, NU1 = MP * WP;
struct InOrder { int G, c;
    __device__ __forceinline__ bool next(int i, Unit& u) const { const int L = i * G + c; if (L >= NU2 + NU1) return false; int a, b;
        if (L < NU2) { map_tile(L, 4, MP, a, b); u.pm = MP + WP + a; u.pn = b; } else { map_tile(L - NU2, MP, WP, a, b); u.pm = a; u.pn = MP + b; } return true; }
    __device__ __forceinline__ void a_ready(const Unit&) const {}
    __device__ __forceinline__ void done(const Unit&) const {}
};
struct EpiIn { static constexpr bool PERM = true, AFTER_DRAIN = false; bf16_t* P; float* G; bf16_t* HTp;
    __device__ __forceinline__ void operator()(const f32x4 (&acc)[2][2][4][2], const Unit& u, int wr, int wc, int fr, int fq) const {
        if (u.pm < MP) { const int pn = u.pn - MP, row0 = u.pm * BM + wr * 64 + fr;
            if (pn < NP / 256) { const int col0 = pn * BM + wc * 32 + 8 * fq;
#pragma unroll
                for (int ai = 0; ai < 2; ++ai)
#pragma unroll
                    for (int m = 0; m < 4; ++m) { bf16_t* rowp = P + (size_t)(row0 + ai * HALF + m * 16) * NP + col0;
#pragma unroll
                        for (int bj = 0; bj < 2; ++bj) { const f32x4 v0 = acc[ai][bj][m][0], v1 = acc[ai][bj][m][1];
                            u32x4 w; w.x = cvt_pk_bf16(v0[0], v0[1]); w.y = cvt_pk_bf16(v0[2], v0[3]); w.z = cvt_pk_bf16(v1[0], v1[1]); w.w = cvt_pk_bf16(v1[2], v1[3]); *(u32x4*)(rowp + bj * HALF) = w; } } }
            else { const int cb = wc * 32 + 8 * fq;
                if (cb < NG) {
#pragma unroll
                    for (int ai = 0; ai < 2; ++ai)
#pragma unroll
                        for (int m = 0; m < 4; ++m) { float* rowb = G + (size_t)(row0 + ai * HALF + m * 16) * NGS; const f32x4 v0 = acc[ai][0][m][0], v1 = acc[ai][0][m][1];
                            if (cb < 16) { *(f32x4*)(rowb + cb) = v0; *(f32x4*)(rowb + cb + 4) = v1; }
                            else { u32x4 w; w.x = cvt_pk_bf16(v0[0], v0[1]); w.y = cvt_pk_bf16(v0[2], v0[3]); w.z = cvt_pk_bf16(v1[0], v1[1]); w.w = cvt_pk_bf16(v1[2], v1[3]); *(u32x4*)((bf16_t*)(rowb + 16) + (cb - 16)) = w; } } } } }
        else { const int row0 = (u.pm - MP - WP) * BM + wr * 64 + fr, col0 = u.pn * BM + wc * 32 + 8 * fq;
#pragma unroll
            for (int ai = 0; ai < 2; ++ai)
#pragma unroll
                for (int m = 0; m < 4; ++m) { bf16_t* rowp = HTp + (size_t)(row0 + ai * HALF + m * 16) * T + col0;
#pragma unroll
                    for (int bj = 0; bj < 2; ++bj) { const f32x4 v0 = acc[ai][bj][m][0], v1 = acc[ai][bj][m][1];
                        u32x4 w; w.x = cvt_pk_bf16(v0[0], v0[1]); w.y = cvt_pk_bf16(v0[2], v0[3]); w.z = cvt_pk_bf16(v1[0], v1[1]); w.w = cvt_pk_bf16(v1[2], v1[3]); *(u32x4*)(rowp + bj * HALF) = w; } } }
    }
};
struct OutOrder { int G, c; bool lat_only; unsigned* cnt;
    __device__ __forceinline__ bool next(int i, Unit& u) const { constexpr int nN = DM / 256, nLat = NB * (SEQ / 256) * nN, nCtx = NB * (CTXL / 256) * nN; const int L = i * G + c; int a, b;
        if (L < nLat) { map_tile(L, nLat / nN, nN, a, b); u.pm = (a / (SEQ / 256)) * (TOK / 256) + CTXL / 256 + a % (SEQ / 256); }
        else { if (lat_only || L >= nLat + nCtx) return false; map_tile(L - nLat, nCtx / nN, nN, a, b); u.pm = (a / (CTXL / 256)) * (TOK / 256) + a % (CTXL / 256); }
        u.pn = b; return true; }
    __device__ __forceinline__ void a_ready(const Unit&) const {}
    unsigned* xu; unsigned nloc, xtarget;
    __device__ __forceinline__ void done(const Unit& u) const {
        asm volatile("s_waitcnt vmcnt(0)" ::: "memory"); __builtin_amdgcn_s_barrier();
        if (threadIdx.x == 0) { const bool isctx = (u.pm % (TOK / 256)) < CTXL / 256;
            if (!isctx && xtarget != 0u) {
                const unsigned old = __hip_atomic_fetch_add(xu, 1u, __ATOMIC_RELAXED, __HIP_MEMORY_SCOPE_AGENT);
                if (old + 1u == xtarget) { __builtin_amdgcn_fence(__ATOMIC_RELEASE, "agent"); asm volatile("s_waitcnt vmcnt(0)" ::: "memory");
                    __hip_atomic_fetch_add(cnt, nloc, __ATOMIC_RELAXED, __HIP_MEMORY_SCOPE_AGENT); } }
            else { __builtin_amdgcn_fence(__ATOMIC_RELEASE, "agent"); asm volatile("s_waitcnt vmcnt(0)" ::: "memory");
                __hip_atomic_fetch_add(cnt + (isctx ? 64 : 0), 1u, __ATOMIC_RELAXED, __HIP_MEMORY_SCOPE_AGENT); } } }
};
struct EpiOut { static constexpr bool PERM = true, AFTER_DRAIN = false; bf16_t* C;
    __device__ __forceinline__ void operator()(const f32x4 (&acc)[2][2][4][2], const Unit& u, int wr, int wc, int fr, int fq) const {
        const int row0 = u.pm * BM + wr * 64 + fr, col0 = u.pn * BM + wc * 32 + 8 * fq;
#pragma unroll
        for (int ai = 0; ai < 2; ++ai)
#pragma unroll
            for (int m = 0; m < 4; ++m) { bf16_t* rowp = C + (size_t)(row0 + ai * HALF + m * 16) * DM + col0;
#pragma unroll
                for (int bj = 0; bj < 2; ++bj) { const f32x4 v0 = acc[ai][bj][m][0], v1 = acc[ai][bj][m][1];
                    u32x4 w; w.x = cvt_pk_bf16(v0[0], v0[1]); w.y = cvt_pk_bf16(v0[2], v0[3]); w.z = cvt_pk_bf16(v1[0], v1[1]); w.w = cvt_pk_bf16(v1[2], v1[3]); *(u32x4*)(rowp + bj * HALF) = w; } }
    }
};
}
#endif

__device__ __forceinline__ void phase_gemm_in(const Params& p, int l, char* smem) {
    constexpr int N_F = WG / 2;
#ifdef EMU
    constexpr int MT = T / 128, NT1 = NMAIN / 128, N1 = MT * NT1, N2 = 8 * MT;
    for (int task = obid(); task < N1 + N2; task += gridDim.x) {
        if (task < N1) gemm_tile(p, (const bf16*)(p.ws + WS_HNY), (const bf16*)(p.ws + WS_WIN), DM, task / NT1, task % NT1, 0, smem);
        else { const int t2 = task - N1; gemm_tile(p, (const bf16*)(p.ws + WS_WIN) + (size_t)NMAIN * DM, (const bf16*)(p.ws + WS_HNY), DM, t2 / MT, t2 % MT, 2, smem); }
    }
#else
    { const pg8::Gemm g{(const pg8::bf16_t*)(p.ws + WS_HNY), (const pg8::bf16_t*)(p.ws + WS_HNY), 0, 0, DM};
      const pg8::InOrder S{(int)gridDim.x, obid()};
      const pg8::EpiIn E{(pg8::bf16_t*)(p.ws + WS_P), (float*)(p.ws + WS_G), (pg8::bf16_t*)(p.ws + WS_HT)};
      pg8::gemm_phase<pg8::EpiIn, pg8::InOrder, true, true>((PG8_LAS unsigned char*)smem, g, S, E); }
#endif
    { const int G = (int)gridDim.x, bid = obid();
#ifdef EMU
      const int extra = 0;
#else
      const int extra = (pg8::NU1 + pg8::NU2) % G;
#endif
      if (extra > 0 && extra < G) { if (bid >= extra) for (int task = bid - extra; task < N_F; task += G - extra) filt_fft_task(p, task, smem); }
      else for (int task = G - 1 - bid; task < N_F; task += G) filt_fft_task(p, task, smem); }
}
__device__ __forceinline__ void phase_gemm_out(const Params& p, int l, char* smem) {
    const int G = (int)gridDim.x, bid = obid(); const bool has_ctx = l < DEPTH - 1;
#ifdef EMU
    constexpr int MT = T / 128, NTO = DM / 128;
    for (int task = bid; task < MT * NTO; task += G) {
        const int mt = task / NTO, nt = task % NTO;
        if (!has_ctx && (mt % (TOK / 128)) < CTXL / 128) continue;
        gemm_tile(p, (const bf16*)(p.ws + WS_HNY), (const bf16*)(p.ws + WS_WOUT), MIX, mt, nt, 1, smem);
        __syncthreads(); if (otid() == 0) *unit_counter(p, (mt % (TOK / 128)) < CTXL / 128 ? 1 : 0) += 1u;
    }
#else
    const pg8::Gemm g{(const pg8::bf16_t*)(p.ws + WS_HNY), (const pg8::bf16_t*)(p.ws + WS_WOUT), 0, 0, MIX};
    const unsigned xcc = (unsigned)__builtin_amdgcn_s_getreg((3 << 11) | 20) & 0xFu, nloc = ((volatile PG8_LAS unsigned*)(smem + LDS_BYTES - 64))[0];
    const bool agg = (NB * (SEQ / 256) * (DM / 256) == G) && nloc > 0u;
    const pg8::OutOrder S{G, bid, !has_ctx, unit_counter(p, 0), unit_counter(p, 2) + 16 * xcc, nloc, agg ? nloc * (unsigned)(l + 1) : 0u};
    const pg8::EpiOut E{(pg8::bf16_t*)(p.ws + WS_P)};
    pg8::gemm_phase<pg8::EpiOut, pg8::OutOrder, true, true>((PG8_LAS unsigned char*)smem, g, S, E);
#endif
}

__device__ __forceinline__ size_t st_index(int mixer, int dir, int b, int h, int cid) { return ((((size_t)(mixer * 2 + dir) * NB + b) * NH + h) * NCH + cid); }
__device__ __forceinline__ size_t ch_index(int dir, int b, int h, int cid) { return (((size_t)dir * NB + b) * NH + h) * NCH + cid; }

__device__ __forceinline__ void load_tile_nat(const bf16* P, int r0, int c0, bf16* dst, float scale, int tid) {
    const int s = tid >> 3, c8 = tid & 7;
    const u32x4 v = *(const u32x4*)(P + (size_t)(r0 + s) * NP + c0 + c8 * 8);
    if (scale == 1.0f) *(u32x4*)(dst + s * LS + c8 * 8) = v;
    else { float f[8]; unpack8(v, f); u32x4 o; o.x = pk2(f[0] * scale, f[1] * scale); o.y = pk2(f[2] * scale, f[3] * scale); o.z = pk2(f[4] * scale, f[5] * scale); o.w = pk2(f[6] * scale, f[7] * scale);
        *(u32x4*)(dst + s * LS + c8 * 8) = o; }
}
__device__ __forceinline__ void load_tile_tr(const bf16* P, int r0, int c0, bf16* dst, int tid) {
    const int s = tid >> 3, c8 = tid & 7;
    const u32x4 v = *(const u32x4*)(P + (size_t)(r0 + s) * NP + c0 + c8 * 8);
    const unsigned w[4] = {v.x, v.y, v.z, v.w};
#pragma unroll
    for (int j = 0; j < 4; ++j) { dst[(c8 * 8 + 2 * j) * LS + s] = (bf16)(w[j] & 0xffffu); dst[(c8 * 8 + 2 * j + 1) * LS + s] = (bf16)(w[j] >> 16); }
}

template <int NTK>
__device__ __forceinline__ void load_span(const bf16* row, int t0, float (&v)[NTK + 2]) {
    { const bool hl = t0 > 0, hr = t0 + NTK < SEQ; const bf16 xl = row[hl ? -1 : 0], xr = row[hr ? NTK : 0];
        v[0] = hl ? bf2f(xl) : 0.f; v[NTK + 1] = hr ? bf2f(xr) : 0.f; }
    if constexpr (NTK == 8) { float f[8]; unpack8(*(const u32x4*)row, f);
#pragma unroll
        for (int i = 0; i < 8; ++i) v[1 + i] = f[i]; }
    else {
#pragma unroll
        for (int i = 0; i < NTK; ++i) v[1 + i] = bf2f(row[i]); }
}
struct SpanRaw { u32x4 b; bf16 xl, xr; };
__device__ __forceinline__ SpanRaw span_load8(const bf16* row, int t0) { SpanRaw s; const bool hl = t0 > 0, hr = t0 + 8 < SEQ; s.xl = row[hl ? -1 : 0]; s.xr = row[hr ? 8 : 0]; s.b = *(const u32x4*)row; return s; }
__device__ __forceinline__ void span_expand8(const SpanRaw& s, int t0, float (&v)[10]) { float f[8]; unpack8(s.b, f); v[0] = t0 > 0 ? bf2f(s.xl) : 0.f; v[9] = (t0 + 8 < SEQ) ? bf2f(s.xr) : 0.f;
#pragma unroll
    for (int i = 0; i < 8; ++i) v[1 + i] = f[i]; }
template <int NTK>
__device__ __forceinline__ void hy_inputs(const bf16* h0, const bf16* h1, const float* cw, const float* cb, int c, int t0, float (&u0)[NTK], float (&u1)[NTK], float (&g0)[NTK], float (&g1)[NTK]) {
    if constexpr (NTK == 8) {
        const SpanRaw rxa = span_load8(h0 + (size_t)512 * T, t0), rxb = span_load8(h1 + (size_t)512 * T, t0), rga = span_load8(h0 + (size_t)768 * T, t0), rgb = span_load8(h1 + (size_t)768 * T, t0);
        const SpanRaw rva = span_load8(h0, t0), rvb = span_load8(h1, t0), rya = span_load8(h0 + (size_t)256 * T, t0), ryb = span_load8(h1 + (size_t)256 * T, t0);
        const float w0 = cw[0 * 768 + 512 + c], w1 = cw[1 * 768 + 512 + c], w2 = cw[2 * 768 + 512 + c], bb = cb[512 + c];
        const float v0 = cw[0 * 768 + c], v1 = cw[1 * 768 + c], v2 = cw[2 * 768 + c], vbias = cb[c];
        const float y0 = cw[0 * 768 + 256 + c], y1 = cw[1 * 768 + 256 + c], y2 = cw[2 * 768 + 256 + c], ybias = cb[256 + c];
        { float xa[10], xb[10], ga[10], gb[10]; span_expand8(rxa, t0, xa); span_expand8(rxb, t0, xb); span_expand8(rga, t0, ga); span_expand8(rgb, t0, gb);
#pragma unroll
            for (int i = 0; i < 8; ++i) { g0[i] = (w0 * xa[i] + w1 * xa[i + 1] + w2 * xa[i + 2] + bb) * siluf_(ga[i + 1]); g1[i] = (w0 * xb[i] + w1 * xb[i + 1] + w2 * xb[i + 2] + bb) * siluf_(gb[i + 1]); } }
        { float va[10], vb[10], ya[10], yb[10]; span_expand8(rva, t0, va); span_expand8(rvb, t0, vb); span_expand8(rya, t0, ya); span_expand8(ryb, t0, yb);
#pragma unroll
            for (int i = 0; i < 8; ++i) { u0[i] = (v0 * va[i] + v1 * va[i + 1] + v2 * va[i + 2] + vbias) * (y0 * ya[i] + y1 * ya[i + 1] + y2 * ya[i + 2] + ybias);
                u1[i] = (v0 * vb[i] + v1 * vb[i + 1] + v2 * vb[i + 2] + vbias) * (y0 * yb[i] + y1 * yb[i + 1] + y2 * yb[i + 2] + ybias); } }
        return;
    }
    { float xa[NTK + 2], xb[NTK + 2]; load_span<NTK>(h0 + (size_t)512 * T, t0, xa); load_span<NTK>(h1 + (size_t)512 * T, t0, xb);
        const float w0 = cw[0 * 768 + 512 + c], w1 = cw[1 * 768 + 512 + c], w2 = cw[2 * 768 + 512 + c], bb = cb[512 + c];
        float ga[NTK + 2], gb[NTK + 2]; load_span<NTK>(h0 + (size_t)768 * T, t0, ga); load_span<NTK>(h1 + (size_t)768 * T, t0, gb);
#pragma unroll
        for (int i = 0; i < NTK; ++i) { g0[i] = (w0 * xa[i] + w1 * xa[i + 1] + w2 * xa[i + 2] + bb) * siluf_(ga[i + 1]); g1[i] = (w0 * xb[i] + w1 * xb[i + 1] + w2 * xb[i + 2] + bb) * siluf_(gb[i + 1]); } }
    { float va[NTK + 2], vb[NTK + 2], ya[NTK + 2], yb[NTK + 2];
        load_span<NTK>(h0, t0, va); load_span<NTK>(h1, t0, vb); load_span<NTK>(h0 + (size_t)256 * T, t0, ya); load_span<NTK>(h1 + (size_t)256 * T, t0, yb);
        const float v0 = cw[0 * 768 + c], v1 = cw[1 * 768 + c], v2 = cw[2 * 768 + c], vbias = cb[c];
        const float y0 = cw[0 * 768 + 256 + c], y1 = cw[1 * 768 + 256 + c], y2 = cw[2 * 768 + 256 + c], ybias = cb[256 + c];
#pragma unroll
        for (int i = 0; i < NTK; ++i) { u0[i] = (v0 * va[i] + v1 * va[i + 1] + v2 * va[i + 2] + vbias) * (y0 * ya[i] + y1 * ya[i + 1] + y2 * ya[i + 2] + ybias);
            u1[i] = (v0 * vb[i] + v1 * vb[i + 1] + v2 * vb[i + 2] + vbias) * (y0 * yb[i] + y1 * yb[i + 1] + y2 * yb[i + 2] + ybias); } }
}
__device__ __forceinline__ void hylat_task(const Params& p, int l, int bp, int cp, char* smem) {
    const int tid = otid(), half = tid >> 8, tl = tid & 255, c = 2 * cp + half;
    const bf16* HT = (const bf16*)(p.ws + WS_HT); bf16* Y = (bf16*)(p.ws + WS_HNY);
    cpx* buf = (cpx*)smem + (size_t)half * FBUF;
    const cpx* TW = (const cpx*)(p.ws + WS_TW);
    const cpx* KF = (const cpx*)(p.ws + WS_KF) + (size_t)c * NF;
    constexpr int NTK = SEQ / 256;
    const int t0 = NTK * tl;
    const float* cw = p.in[I_HCW] + (size_t)l * 3 * 768; const float* cb = p.in[I_HCB] + (size_t)l * 768;
    const size_t rb0 = (size_t)(2 * bp) * TOK + CTXL, rb1 = rb0 + TOK;
    const bf16* h0 = HT + (size_t)c * T + rb0 + t0; const bf16* h1 = h0 + TOK;
    { float u0[NTK], u1[NTK], g0[NTK], g1[NTK]; hy_inputs<NTK>(h0, h1, cw, cb, c, t0, u0, u1, g0, g1);
        __syncthreads();
#pragma unroll
        for (int i = 0; i < NTK; ++i) { cpx v; v.x = u0[i]; v.y = u1[i]; buf[FPH(t0 + i)] = v; cpx z = {0.f, 0.f}; buf[FPH(SEQ + t0 + i)] = z; } }
    fft_fwd(buf, TW, tl);
#pragma unroll 2
    for (int i = tl; i < NF; i += 256) buf[FPH(i)] = cmul(buf[FPH(i)], KF[i]);
    fft_inv(buf, TW, tl);
    const float dsk = p.in[I_HD][(size_t)l * WG + c]; const float sc = 1.0f / (float)NF;
    { const int tz = otid() & 255; const int t0z = NTK * tz;
        float u0[NTK], u1[NTK], g0[NTK], g1[NTK]; hy_inputs<NTK>(HT + (size_t)c * T + rb0 + t0z, HT + (size_t)c * T + rb0 + t0z + TOK, cw, cb, c, t0z, u0, u1, g0, g1);
        float o0[NTK], o1[NTK];
#pragma unroll
        for (int i = 0; i < NTK; ++i) { const cpx y = buf[FPH(t0z + i)]; o0[i] = g0[i] * (y.x * sc + u0[i] * dsk); o1[i] = g1[i] * (y.y * sc + u1[i] * dsk); }
        bf16* d0 = (bf16*)(p.ws + WS_HT) + (size_t)(768 + c) * T + rb0 + t0z; bf16* d1 = d0 + TOK;
        if constexpr (NTK == 8) { *(u32x4*)d0 = pack8(o0); *(u32x4*)d1 = pack8(o1); }
        else {
#pragma unroll
            for (int i = 0; i < NTK; ++i) { d0[i] = f2bf(o0[i]); d1[i] = f2bf(o1[i]); } } }
}

constexpr int HCB = 16;
__device__ __forceinline__ void hyctx_task(const Params& p, int l, int b, int cblk, char* smem) {
    const int tid = otid(); const int c0 = cblk * HCB;
    const bf16* HT = (const bf16*)(p.ws + WS_HT); bf16* Y = (bf16*)(p.ws + WS_HNY); const float* HC = (const float*)(p.ws + WS_HC);
    float* raw = (float*)smem;
    float* u = raw + 4 * CTXL * HCB;
    float* og = u + CTXL * HCB;
    float* hcm = og + CTXL * HCB;
    bf16* ob = (bf16*)raw;
    const size_t rb = (size_t)b * TOK;
    const float* cw = p.in[I_HCW] + (size_t)l * 3 * 768; const float* cbias = p.in[I_HCB] + (size_t)l * 768;
    constexpr int WT = CTXL / 32;
    __syncthreads();
    for (int i = tid; i < 4 * HCB * (CTXL / 8); i += NT) { const int k = i / (HCB * (CTXL / 8)), cc = (i / (CTXL / 8)) % HCB, ck = i % (CTXL / 8);
        float f[8]; unpack8(*(const u32x4*)(HT + (size_t)(k * 256 + c0 + cc) * T + rb + ck * 8), f);
#pragma unroll
        for (int j = 0; j < 8; ++j) raw[(k * CTXL + ck * 8 + j) * HCB + cc] = f[j]; }
    for (int i = tid; i < 2 * HCB * (CTXL / 4); i += NT) { const int dir = i / (HCB * (CTXL / 4)), cc = (i / (CTXL / 4)) % HCB, pk = i % (CTXL / 4);
        const f32x4 v = *(const f32x4*)(HC + ((size_t)dir * WG + c0 + cc) * CTXL + pk * 4); const float f[4] = {v.x, v.y, v.z, v.w};
#pragma unroll
        for (int j = 0; j < 4; ++j) { const int pos = pk * 4 + j; if (dir == 0) hcm[(CTXL + pos) * HCB + cc] = f[j]; else if (pos > 0) hcm[(CTXL - pos) * HCB + cc] = f[j]; } }
    if (tid < HCB) hcm[tid] = 0.f;
    __syncthreads();
    static_assert(NT % HCB == 0, "a thread keeps its channel over the passes: its 12 filter taps are loaded once");
    float tw0[3], tw1[3], tw2[3], tbs[3];
#pragma unroll
    for (int k = 0; k < 3; ++k) { const int ch = k * 256 + c0 + tid % HCB; tw0[k] = cw[0 * 768 + ch]; tw1[k] = cw[1 * 768 + ch]; tw2[k] = cw[2 * 768 + ch]; tbs[k] = cbias[ch]; }
    for (int i = tid; i < CTXL * HCB; i += NT) { const int t = i / HCB, cc = i % HCB; float cv[3];
#pragma unroll
        for (int k = 0; k < 3; ++k) { const float* rk = raw + k * CTXL * HCB;
            const float a = t > 0 ? rk[(t - 1) * HCB + cc] : 0.f, m = rk[t * HCB + cc], z = t < CTXL - 1 ? rk[(t + 1) * HCB + cc] : 0.f;
            cv[k] = tw0[k] * a + tw1[k] * m + tw2[k] * z + tbs[k]; }
        u[i] = cv[0] * cv[1];
        og[i] = cv[2] * siluf_(raw[(3 * CTXL + t) * HCB + cc]); }
    __syncthreads();
    { const int cc = tid % HCB, tg = tid / HCB, t0 = WT * tg; float acc[WT], w[WT];
#pragma unroll
        for (int j = 0; j < WT; ++j) { acc[j] = 0.f; w[j] = hcm[(t0 + j + CTXL) * HCB + cc]; }
#pragma unroll 8
        for (int s = 0; s < CTXL; ++s) { const float us = u[s * HCB + cc];
#pragma unroll
            for (int j = 0; j < WT; ++j) acc[j] += us * w[j];
#pragma unroll
            for (int j = WT - 1; j > 0; --j) w[j] = w[j - 1];
            w[0] = hcm[(t0 - s - 1 + CTXL) * HCB + cc]; }
        const float dsk = p.in[I_HD][(size_t)l * WG + c0 + cc];
#pragma unroll
        for (int j = 0; j < WT; ++j) { const int t = t0 + j; ob[t * HCB + cc] = f2bf(og[t * HCB + cc] * (acc[j] + u[t * HCB + cc] * dsk)); } }
    __syncthreads();
    for (int i = tid; i < CTXL * 2; i += NT) { const int t = i >> 1, hh = i & 1; *(u32x4*)(Y + (rb + t) * 1024 + YH + c0 + 8 * hh) = *(const u32x4*)(ob + t * HCB + 8 * hh); }
}

__device__ __forceinline__ void attn_task(const Params& p, int l, int b, int kvh, int qt, bool ctxq, char* smem) {
    const int tid = otid(), lane = tid & 63, wave = tid >> 6, r = lane & 15, q = lane >> 4;
    constexpr float QSC = 0.125f * 1.4426950408889634f;
    const bf16* P = (const bf16*)(p.ws + WS_P); bf16* Y = (bf16*)(p.ws + WS_HNY); const cpx* ROPE = (const cpx*)(p.ws + WS_ROPE);
    bf16* Qs = (bf16*)smem;
    bf16* Ks = Qs + 256 * LS;
    constexpr int LSV = 80;
    bf16* Vt = Ks + 64 * LS;
    bf16* Ps = Vt + 64 * LS;
    const size_t rq0 = (size_t)b * TOK + (ctxq ? 0 : CTXL) + qt * 128;
    __syncthreads();
#pragma unroll
    for (int it = 0; it < 2; ++it) {
        const int idx = tid + NT * it, row = idx >> 2, cpair = idx & 3, g = row >> 7, t = row & 127;
        const bf16* src = P + (rq0 + t) * NP + PD + (kvh * 2 + g) * 64;
        float lo[8], hi[8]; unpack8(*(const u32x4*)(src + cpair * 8), lo); unpack8(*(const u32x4*)(src + 32 + cpair * 8), hi);
        float a[8], c2[8];
#pragma unroll
        for (int j = 0; j < 8; ++j) { float cs = 1.f, sn = 0.f; if (!ctxq) { const cpx cv = ROPE[(size_t)(qt * 128 + t) * 32 + cpair * 8 + j]; cs = cv.x; sn = cv.y; }
            a[j] = (lo[j] * cs - hi[j] * sn) * QSC; c2[j] = (hi[j] * cs + lo[j] * sn) * QSC; }
        *(u32x4*)(Qs + row * LS + cpair * 8) = pack8(a); *(u32x4*)(Qs + row * LS + 32 + cpair * 8) = pack8(c2);
    }
    const int lt0 = ctxq ? 0 : (2 * qt - 2 > 0 ? 2 * qt - 2 : 0), lt1 = ctxq ? -1 : (2 * qt + 3 < SEQ / 64 - 1 ? 2 * qt + 3 : SEQ / 64 - 1);
    const int nloc = lt1 - lt0 + 1, ntiles = nloc + NCC;
    float m[2], lsum[2]; f32x4 O[2][4];
#pragma unroll
    for (int ms = 0; ms < 2; ++ms) { m[ms] = -INFINITY; lsum[ms] = 0.f;
#pragma unroll
        for (int i = 0; i < 4; ++i) O[ms][i] = (f32x4){0.f, 0.f, 0.f, 0.f}; }
    const int g = wave >> 2, tq0 = (wave & 3) * 32;
    (void)Ps;
    __syncthreads();
    bf16x8 qf[2][2];
#pragma unroll
    for (int ms = 0; ms < 2; ++ms)
#pragma unroll
        for (int ks = 0; ks < 2; ++ks) qf[ms][ks] = *(const bf16x8*)(Qs + (g * 128 + tq0 + 16 * ms + r) * LS + ks * 32 + q * 8);
    u32x4 klo = {0u, 0u, 0u, 0u}, khi = klo, vq = klo; f32x4 rp[4] = {(f32x4){1.f, 0.f, 1.f, 0.f}, (f32x4){1.f, 0.f, 1.f, 0.f}, (f32x4){1.f, 0.f, 1.f, 0.f}, (f32x4){1.f, 0.f, 1.f, 0.f}};
    const int ks_ = tid >> 2, kcp = tid & 3, vs_ = tid >> 3, vc8 = tid & 7;
#define ATT_PREFETCH(TI) do { const bool loc_ = (TI) < nloc; const int kt_ = loc_ ? lt0 + (TI) : (TI) - nloc; const size_t rk_ = (size_t)b * TOK + (loc_ ? CTXL : 0) + kt_ * 64; \
        if (tid < 256) { const bf16* src_ = P + (rk_ + ks_) * NP + PD + 256 + kvh * 64; klo = *(const u32x4*)(src_ + kcp * 8); khi = *(const u32x4*)(src_ + 32 + kcp * 8); \
            if (loc_) { const f32x4* rr_ = (const f32x4*)(ROPE + (size_t)(kt_ * 64 + ks_) * 32 + kcp * 8); rp[0] = rr_[0]; rp[1] = rr_[1]; rp[2] = rr_[2]; rp[3] = rr_[3]; } \
            else { rp[0] = rp[1] = rp[2] = rp[3] = (f32x4){1.f, 0.f, 1.f, 0.f}; } } \
        vq = *(const u32x4*)(P + (rk_ + vs_) * NP + PD + 384 + kvh * 64 + vc8 * 8); } while (0)
    ATT_PREFETCH(0);
    for (int ti = 0; ti < ntiles; ++ti) {
        const bool local = ti < nloc; const int kt = local ? lt0 + ti : ti - nloc;
        __syncthreads();
        if (tid < 256) { float lo[8], hi[8]; unpack8(klo, lo); unpack8(khi, hi);
            const float cs[8] = {rp[0].x, rp[0].z, rp[1].x, rp[1].z, rp[2].x, rp[2].z, rp[3].x, rp[3].z}, sn[8] = {rp[0].y, rp[0].w, rp[1].y, rp[1].w, rp[2].y, rp[2].w, rp[3].y, rp[3].w};
            float a[8], c2[8];
#pragma unroll
            for (int j = 0; j < 8; ++j) { a[j] = lo[j] * cs[j] - hi[j] * sn[j]; c2[j] = hi[j] * cs[j] + lo[j] * sn[j]; }
            *(u32x4*)(Ks + ks_ * LS + kcp * 8) = pack8(a); *(u32x4*)(Ks + ks_ * LS + 32 + kcp * 8) = pack8(c2); }
        *(u32x4*)(Vt + vs_ * LSV + vc8 * 8) = vq;
        __syncthreads();
        if (ti + 1 < ntiles) ATT_PREFETCH(ti + 1);
        bf16x8 kfr[4][2], vfa[4], vfb[4];
#pragma unroll
        for (int nt = 0; nt < 4; ++nt)
#pragma unroll
            for (int ks = 0; ks < 2; ++ks) kfr[nt][ks] = *(const bf16x8*)(Ks + (16 * nt + r) * LS + ks * 32 + q * 8);
#pragma unroll
        for (int me = 0; me < 4; ++me) { const bf16* vr = Vt + (4 * q + (r >> 2)) * LSV + 16 * me + 4 * (r & 3);
            const u32x2 a0 = lds_tr16(vr), a1 = lds_tr16(vr + 16 * LSV), a2 = lds_tr16(vr + 32 * LSV), a3 = lds_tr16(vr + 48 * LSV);
            u32x4 va; va.x = a0.x; va.y = a0.y; va.z = a1.x; va.w = a1.y; u32x4 vb; vb.x = a2.x; vb.y = a2.y; vb.z = a3.x; vb.w = a3.y; vfa[me] = as_frag(va); vfb[me] = as_frag(vb); }
#pragma unroll
        for (int ms = 0; ms < 2; ++ms) {
            const int qlo = qt * 128 + tq0 + 16 * ms, klo_ = kt * 64;
            if (local && (klo_ > qlo + 15 + 128 || klo_ + 63 < qlo - 128)) continue;
            const bool domask = local && (klo_ + 63 - qlo > 128 || klo_ - (qlo + 15) < -128);
            f32x4 S[4] = {(f32x4){0.f, 0.f, 0.f, 0.f}, (f32x4){0.f, 0.f, 0.f, 0.f}, (f32x4){0.f, 0.f, 0.f, 0.f}, (f32x4){0.f, 0.f, 0.f, 0.f}};
#pragma unroll
            for (int ks = 0; ks < 2; ++ks)
#pragma unroll
                for (int nt = 0; nt < 4; ++nt) S[nt] = MFMA16(kfr[nt][ks], qf[ms][ks], S[nt]);
            const int qpos = qlo + r; float mx = -INFINITY;
            if (domask) {
#pragma unroll
                for (int nt = 0; nt < 4; ++nt)
#pragma unroll
                    for (int i = 0; i < 4; ++i) { const int d = kt * 64 + nt * 16 + 4 * q + i - qpos; if (d > 128 || d < -128) S[nt][i] = -INFINITY; } }
#pragma unroll
            for (int nt = 0; nt < 4; ++nt)
#pragma unroll
                for (int i = 0; i < 4; ++i) mx = fmaxf(mx, S[nt][i]);
            mx = xrow_max(mx);
            const float mn = fmaxf(m[ms], mx); const float msafe = mn == -INFINITY ? 0.f : mn; const float alpha = EXP2(m[ms] - msafe); float sm = 0.f;
#pragma unroll
            for (int nt = 0; nt < 4; ++nt)
#pragma unroll
                for (int i = 0; i < 4; ++i) { S[nt][i] = EXP2(S[nt][i] - msafe); sm += S[nt][i]; }
            sm = xrow_sum(sm);
            lsum[ms] = lsum[ms] * alpha + sm; m[ms] = mn;
            const float pa[8] = {S[0][0], S[0][1], S[0][2], S[0][3], S[1][0], S[1][1], S[1][2], S[1][3]}, pb[8] = {S[2][0], S[2][1], S[2][2], S[2][3], S[3][0], S[3][1], S[3][2], S[3][3]};
            const bf16x8 p0 = as_frag(pack8(pa)), p1 = as_frag(pack8(pb));
#pragma unroll
            for (int me = 0; me < 4; ++me) { O[ms][me] = O[ms][me] * alpha;
                O[ms][me] = MFMA16(vfa[me], p0, O[ms][me]); O[ms][me] = MFMA16(vfb[me], p1, O[ms][me]); }
        }
    }
#undef ATT_PREFETCH
    const float sink = p.in[I_SINK][(size_t)l * NH + kvh * 2 + g];
    u32x2 ggs[2][4];
#pragma unroll
    for (int ms = 0; ms < 2; ++ms)
#pragma unroll
        for (int me = 0; me < 4; ++me) ggs[ms][me] = *(const u32x2*)(P + (rq0 + tq0 + 16 * ms + r) * NP + PD + 512 + (kvh * 2 + g) * 64 + 4 * q + 16 * me);
#pragma unroll
    for (int ms = 0; ms < 2; ++ms) { const float den = lsum[ms] + EXP2(sink * 1.4426950408889634f - m[ms]); const float inv = frcp_(den);
        const size_t row = rq0 + tq0 + 16 * ms + r; const int col = (kvh * 2 + g) * 64 + 4 * q;
#pragma unroll
        for (int me = 0; me < 4; ++me) { const u32x2 gg = ggs[ms][me];
            const float g0 = bitsf(gg.x << 16), g1 = bitsf(gg.x & 0xffff0000u), g2 = bitsf(gg.y << 16), g3 = bitsf(gg.y & 0xffff0000u);
            u32x2 o; o.x = pk2(O[ms][me][0] * inv * siluf_(g0), O[ms][me][1] * inv * siluf_(g1)); o.y = pk2(O[ms][me][2] * inv * siluf_(g2), O[ms][me][3] * inv * siluf_(g3));
            *(u32x2*)(Y + row * 1024 + YD + col + 16 * me) = o; } }
}

#ifdef EMU
__device__ __forceinline__ int olane(int lane) { return lane; }
#else
__device__ __forceinline__ int olane(int lane) { asm volatile("" : "+v"(lane)); return lane; }
#endif
__device__ __forceinline__ void load_nat_tile(const bf16* P, int row0, int col0, bf16* tile, int lane) {
    u32x4 v[8];
#pragma unroll
    for (int i = 0; i < 8; ++i) v[i] = *(const u32x4*)(P + (size_t)(row0 + (lane >> 3) + 8 * i) * NP + col0 + (lane & 7) * 8);
#pragma unroll
    for (int i = 0; i < 8; ++i) *(u32x4*)(tile + swz((lane >> 3) + 8 * i, lane & 7)) = v[i];
}
__device__ __forceinline__ bf16x8 frag_tr(const bf16* tile, int c0, int k0, int lane) {
    const int c = c0 + (lane & 15), kb = k0 + 8 * (lane >> 4); unsigned w[4];
#pragma unroll
    for (int j = 0; j < 4; ++j) w[j] = (unsigned)tile[swz(kb + 2 * j, c >> 3) + (c & 7)] | ((unsigned)tile[swz(kb + 2 * j + 1, c >> 3) + (c & 7)] << 16);
    u32x4 o; o.x = w[0]; o.y = w[1]; o.z = w[2]; o.w = w[3]; return as_frag(o);
}
__device__ __forceinline__ bf16x8 frag_tr_hw(const bf16* tile, int c0, int k0, int lane) {
    const int r = lane & 15, q = lane >> 4, row = k0 + 8 * q + (r >> 2), col = c0 + 4 * (r & 3);
    const u32x2 a = lds_tr16(tile + swz(row, col >> 3) + (col & 7)), b = lds_tr16(tile + swz(row + 4, col >> 3) + (col & 7));
    u32x4 o; o.x = a.x; o.y = a.y; o.z = b.x; o.w = b.y; return as_frag(o);
}
template <int DIR>
__device__ __forceinline__ void gla_r_frags(const float* Grow0, int lane, bf16x8 (&af)[4]) {
    const int r = lane & 15, q4 = lane >> 4;
#pragma unroll
    for (int mt = 0; mt < 4; ++mt) { u32x4 o = {0u, 0u, 0u, 0u};
        if (q4 < 2) o = *(const u32x4*)((const bf16*)(Grow0 + (size_t)(16 * mt + r) * NGS + 16) + DIR * 16 + 8 * q4);
        af[mt] = as_frag(o); }
}
template <int DIR>
__device__ __forceinline__ void gla_b_load(const Params& p, int l, int h, int nt, int lane_, u32x4& o, float& bias) {
    const int lane = olane(lane_), r = lane & 15, q4 = lane >> 4, d = h * 64 + 16 * nt + r;
    const float* wa = p.in[I_GWA] + ((size_t)(l * 2 + DIR) * 16 + 8 * (q4 & 1)) * WG + d;
    float w[8];
#pragma unroll
    for (int j = 0; j < 8; ++j) w[j] = wa[j * WG];
    bias = p.in[I_GBA][(size_t)(l * 2 + DIR) * WG + d];
    o.x = pk2(w[0], w[1]); o.y = pk2(w[2], w[3]); o.z = pk2(w[4], w[5]); o.w = pk2(w[6], w[7]);
    if (q4 >= 2) o = (u32x4){0u, 0u, 0u, 0u};
}
template <int DIR>
__device__ __forceinline__ float gla_b_col(const u32x4 o, const float bias, const bf16x8 (&af)[4], int lane_, float (&x)[4][4]) {
    const int lane = olane(lane_), r = lane & 15, q4 = lane >> 4;
    const bf16x8 bfr = as_frag(o);
#pragma unroll
    for (int mt = 0; mt < 4; ++mt) { f32x4 c = {bias, bias, bias, bias}; c = MFMA16(af[mt], bfr, c);
#pragma unroll
        for (int i = 0; i < 4; ++i) x[mt][i] = logsig_fast(c[i]) * (1.0f / 16.0f); }
    float carry = 0.f;
#pragma unroll
    for (int k = 0; k < 4; ++k) { const int mt = DIR == 0 ? k : 3 - k; float* y = x[mt];
        if (DIR == 0) { y[1] += y[0]; y[2] += y[1]; y[3] += y[2]; } else { y[2] += y[3]; y[1] += y[2]; y[0] += y[1]; }
        const float s4 = DIR == 0 ? y[3] : y[0];
        const float t1 = DIR == 0 ? __shfl_up(s4, 16) : __shfl_down(s4, 16), t2 = DIR == 0 ? __shfl_up(s4, 32) : __shfl_down(s4, 32), t3 = DIR == 0 ? __shfl_up(s4, 48) : __shfl_down(s4, 48);
        const int qq = DIR == 0 ? q4 : 3 - q4;
        const float e = (qq >= 1 ? t1 : 0.f) + (qq >= 2 ? t2 : 0.f) + (qq >= 3 ? t3 : 0.f);
        const float tot = __shfl(e + s4, DIR == 0 ? r + 48 : r);
#pragma unroll
        for (int i = 0; i < 4; ++i) y[i] += carry + e;
        carry += tot; }
    return carry;
}

template <int MIXER, int DIR>
__device__ __forceinline__ void chunkst_dir(const Params& p, int l, int b, int h, int cid, const float* Grow0, const unsigned (&kk)[32], const bf16* Vt, bf16* Kt, const float* wvs, float* bendl, int lane_) {
    const int lane = olane(lane_), r = lane & 15, q4 = lane >> 4;
    if constexpr (MIXER == 0) {
        float nacc = 0.f;
#pragma unroll
        for (int c = 0; c < 8; ++c) { float f[8];
#pragma unroll
            for (int j = 0; j < 8; ++j) { const int s = 8 * c + j; const float kv = (s & 1) ? bitsf(kk[s >> 1] & 0xffff0000u) : bitsf(kk[s >> 1] << 16);
                f[j] = kv * 0.125f * wvs[DIR * 64 + s]; nacc += f[j]; }
            *(u32x4*)(Kt + swz(lane, c)) = pack8(f); }
        ((float*)(p.ws + WS_NV))[ch_index(DIR, b, h, cid) * 64 + lane] = nacc;
    } else {
        const bf16* P = (const bf16*)(p.ws + WS_P); const int kcol = PG + 256 + h * 64; const int r0 = b * TOK + cid * 64;
        bf16x8 af[4]; gla_r_frags<DIR>(Grow0, lane, af);
#pragma unroll 2
        for (int nt = 0; nt < 4; ++nt) { const int d = 16 * nt + r; float x[4][4];
            u32x4 wo_; float wb_; gla_b_load<DIR>(p, l, h, nt, lane, wo_, wb_); const float bend = gla_b_col<DIR>(wo_, wb_, af, lane, x);
            if (q4 == 0) { ((float*)(p.ws + WS_BE))[ch_index(DIR, b, h, cid) * 64 + d] = bend; bendl[d] = __expf(fmaxf(bend, -80.0f)); }
#pragma unroll
            for (int mt = 0; mt < 4; ++mt)
#pragma unroll
                for (int i = 0; i < 4; ++i) { const int s = 16 * mt + 4 * q4 + i; const float kv = bf2f(P[(size_t)(r0 + s) * NP + kcol + d]); const float bc = fmaxf(x[mt][i], -80.0f);
                    Kt[swz(d, s >> 3) + (s & 7)] = f2bf(kv * __expf(-bc));
                    ((bf16*)(p.ws + WS_EQ))[((size_t)DIR * T + r0 + s) * WG + h * 64 + d] = f2bf(__expf(bc)); } }
    }
    WAVE_SYNC();
    bf16x8 vf[4][2];
#pragma unroll
    for (int ne = 0; ne < 4; ++ne)
#pragma unroll
        for (int ks = 0; ks < 2; ++ks) vf[ne][ks] = frag_tr_hw(Vt, 16 * ne, 32 * ks, lane);
    bf16* dst = (bf16*)(p.ws + WS_ST) + st_index(MIXER, DIR, b, h, cid) * 4096;
#pragma unroll
    for (int me = 0; me < 4; ++me) {
        f32x4 acc[4] = {(f32x4){0.f, 0.f, 0.f, 0.f}, (f32x4){0.f, 0.f, 0.f, 0.f}, (f32x4){0.f, 0.f, 0.f, 0.f}, (f32x4){0.f, 0.f, 0.f, 0.f}};
#pragma unroll
        for (int ks = 0; ks < 2; ++ks) { const bf16x8 a = *(const bf16x8*)(Kt + swz(16 * me + r, ks * 4 + q4));
#pragma unroll
            for (int ne = 0; ne < 4; ++ne) acc[ne] = MFMA16(a, vf[ne][ks], acc[ne]); }
        f32x4 sc4 = {1.f, 1.f, 1.f, 1.f}; if constexpr (MIXER == 1) sc4 = *(const f32x4*)(bendl + 16 * me + 4 * q4);
#pragma unroll
        for (int ne = 0; ne < 4; ++ne) { const f32x4 v = acc[ne] * sc4; u32x2 o; o.x = pk2(v[0], v[1]); o.y = pk2(v[2], v[3]); *(u32x2*)(dst + (16 * ne + r) * 64 + 16 * me + 4 * q4) = o; }
    }
    WAVE_SYNC();
}
template <int MIXER>
__device__ __forceinline__ void chunkst_w(const Params& p, int l, int b, int h, int cid, char* wl, int lane) {
    const bf16* P = (const bf16*)(p.ws + WS_P); const float* G = (const float*)(p.ws + WS_G);
    const int r0 = b * TOK + cid * 64, r = lane & 15, q4 = lane >> 4;
    bf16* Kt = (bf16*)wl;
    bf16* Vt = Kt + 4096;
    float* wvs = (float*)(Vt + 4096);
    float* bendl = wvs + 128;
    const int kcol = (MIXER == 0 ? PA : PG) + 256 + h * 64, vcol = (MIXER == 0 ? PA : PG) + 512 + h * 64;
    const float* Grow0 = G + (size_t)r0 * NGS;
    bf16* Nn = Kt;
    { u32x4 vv[8], kv[8];
#pragma unroll
        for (int i = 0; i < 8; ++i) { vv[i] = *(const u32x4*)(P + (size_t)(r0 + (lane >> 3) + 8 * i) * NP + vcol + (lane & 7) * 8); kv[i] = *(const u32x4*)(P + (size_t)(r0 + (lane >> 3) + 8 * i) * NP + kcol + (lane & 7) * 8); }
#pragma unroll
        for (int i = 0; i < 8; ++i) { *(u32x4*)(Vt + swz((lane >> 3) + 8 * i, lane & 7)) = vv[i]; *(u32x4*)(Nn + swz((lane >> 3) + 8 * i, lane & 7)) = kv[i]; } }
    WAVE_SYNC();
    unsigned kk[32];
    { const int dc = 16 * q4 + 4 * (r & 3);
#pragma unroll
        for (int c = 0; c < 16; ++c) { const u32x2 t = lds_tr16(Nn + swz(4 * c + (r >> 2), dc >> 3) + (dc & 7)); kk[2 * c] = t.x; kk[2 * c + 1] = t.y; } }
    WAVE_SYNC();
    if constexpr (MIXER == 0) {
        const float* g = Grow0 + (size_t)lane * NGS; const float* gb = p.in[I_MGB] + (size_t)l * 16;
        const float gv0 = g[h], gv1 = g[4 + h], gv2 = g[8 + h], gv3 = g[12 + h], bv0 = gb[h], bv1 = gb[4 + h], bv2 = gb[8 + h], bv3 = gb[12 + h];
        const float i_f = gv0 + bv0, f_f = gv1 + bv1, i_b = gv2 + bv2, f_b = gv3 + bv3;
        const float lf = logsigf_(f_f), lb = logsigf_(f_b);
        const float bF = wave_prefix_sum(lf, lane), totF = __shfl(bF, 63);
        const float gF = totF - bF + i_f, mF = wave_max(gF);
        const float totB = wave_sum(lb), preB = wave_prefix_sum(lb, lane), bB = totB - preB + lb;
        const float gB = totB - bB + i_b, mB = wave_max(gB);
        wvs[lane] = __expf(gF - mF); wvs[64 + lane] = __expf(gB - mB);
        if (lane == 0) { float* SC = (float*)(p.ws + WS_SC);
            SC[ch_index(0, b, h, cid) * 4 + 0] = totF; SC[ch_index(0, b, h, cid) * 4 + 1] = mF;
            SC[ch_index(1, b, h, cid) * 4 + 0] = totB; SC[ch_index(1, b, h, cid) * 4 + 1] = mB; }
    }
    WAVE_SYNC();
    chunkst_dir<MIXER, 0>(p, l, b, h, cid, Grow0, kk, Vt, Kt, wvs, bendl, lane);
    chunkst_dir<MIXER, 1>(p, l, b, h, cid, Grow0, kk, Vt, Kt, wvs, bendl, lane);
}

template <int DIR>
__device__ __forceinline__ void chunkst_gla(const Params& p, int l, int b, int h, int cid, char* wl, int lane_) {
    const bf16* P = (const bf16*)(p.ws + WS_P);
    const int lane = olane(lane_), r0 = b * TOK + cid * 64, r = lane & 15, q4 = lane >> 4;
    bf16* Kt = (bf16*)wl;
    bf16* An = Kt + 4096;
    float* bendl = (float*)(An + 4096);
    const int kcol = PG + 256 + h * 64, vcol = PG + 512 + h * 64;
    const float* Grow0 = (const float*)(p.ws + WS_G) + (size_t)r0 * NGS;
    u32x4 vv[8], kv[8];
#pragma unroll
    for (int i = 0; i < 8; ++i) { vv[i] = *(const u32x4*)(P + (size_t)(r0 + (lane >> 3) + 8 * i) * NP + vcol + (lane & 7) * 8); kv[i] = *(const u32x4*)(P + (size_t)(r0 + (lane >> 3) + 8 * i) * NP + kcol + (lane & 7) * 8); }
    bf16x8 af[4]; gla_r_frags<DIR>(Grow0, lane, af);
    u32x4 wo[4]; float wb[4];
#pragma unroll
    for (int nt = 0; nt < 4; ++nt) gla_b_load<DIR>(p, l, h, nt, lane, wo[nt], wb[nt]);
#pragma unroll
    for (int i = 0; i < 8; ++i) *(u32x4*)(An + swz((lane >> 3) + 8 * i, lane & 7)) = vv[i];
    WAVE_SYNC();
    bf16x8 vf[4][2];
#pragma unroll
    for (int ne = 0; ne < 4; ++ne)
#pragma unroll
        for (int ks = 0; ks < 2; ++ks) vf[ne][ks] = frag_tr_hw(An, 16 * ne, 32 * ks, lane);
    WAVE_SYNC();
#pragma unroll
    for (int i = 0; i < 8; ++i) *(u32x4*)(An + swz((lane >> 3) + 8 * i, lane & 7)) = kv[i];
    WAVE_SYNC();
#pragma unroll
    for (int nt = 0; nt < 4; ++nt) { const int d = 16 * nt + r; float x[4][4];
        const float bend = gla_b_col<DIR>(wo[nt], wb[nt], af, lane, x);
        if (q4 == 0) { ((float*)(p.ws + WS_BE))[ch_index(DIR, b, h, cid) * 64 + d] = bend; bendl[d] = __expf(fmaxf(bend, -80.0f)); }
#pragma unroll
        for (int mt = 0; mt < 4; ++mt) { const int s0 = 16 * mt + 4 * q4, dc = 16 * nt + 4 * (r & 3);
            const u32x2 kq = lds_tr16(An + swz(s0 + (r >> 2), dc >> 3) + (dc & 7));
            const float kv[4] = {bitsf(kq.x << 16), bitsf(kq.x & 0xffff0000u), bitsf(kq.y << 16), bitsf(kq.y & 0xffff0000u)}; float kp[4];
#pragma unroll
            for (int i = 0; i < 4; ++i) { const float bc = fmaxf(x[mt][i], -80.0f); kp[i] = kv[i] * __expf(-bc); An[swz(s0 + i, d >> 3) + (d & 7)] = f2bf(__expf(bc)); }
            u32x2 o; o.x = pk2(kp[0], kp[1]); o.y = pk2(kp[2], kp[3]); *(u32x2*)(Kt + swz(d, s0 >> 3) + (s0 & 7)) = o; } }
    WAVE_SYNC();
    { bf16* EQg = (bf16*)(p.ws + WS_EQ) + ((size_t)DIR * T + r0) * WG + h * 64;
#pragma unroll
        for (int i = 0; i < 8; ++i) { const int s = (lane >> 3) + 8 * i, ck = lane & 7; *(u32x4*)(EQg + (size_t)s * WG + ck * 8) = *(const u32x4*)(An + swz(s, ck)); } }
    bf16* dst = (bf16*)(p.ws + WS_ST) + st_index(1, DIR, b, h, cid) * 4096;
#pragma unroll
    for (int me = 0; me < 4; ++me) {
        f32x4 acc[4] = {(f32x4){0.f, 0.f, 0.f, 0.f}, (f32x4){0.f, 0.f, 0.f, 0.f}, (f32x4){0.f, 0.f, 0.f, 0.f}, (f32x4){0.f, 0.f, 0.f, 0.f}};
#pragma unroll
        for (int ks = 0; ks < 2; ++ks) { const bf16x8 a = *(const bf16x8*)(Kt + swz(16 * me + r, ks * 4 + q4));
#pragma unroll
            for (int ne = 0; ne < 4; ++ne) acc[ne] = MFMA16(a, vf[ne][ks], acc[ne]); }
        const f32x4 sc4 = *(const f32x4*)(bendl + 16 * me + 4 * q4);
#pragma unroll
        for (int ne = 0; ne < 4; ++ne) { const f32x4 v = acc[ne] * sc4; u32x2 o; o.x = pk2(v[0], v[1]); o.y = pk2(v[2], v[3]); *(u32x2*)(dst + (16 * ne + r) * 64 + 16 * me + 4 * q4) = o; }
    }
    WAVE_SYNC();
}

template <int MIXER, int DIR>
__device__ __forceinline__ void chunkout_prep(const Params& p, int l, int b, int h, int cid, const float* Grow0, int r0, int pbase, const bf16* EQ, float* gar, int lane_) {
    const int lane = olane(lane_);
    if constexpr (MIXER == 0) {
        const bf16* P = (const bf16*)(p.ws + WS_P);
        const float* g = Grow0 + (size_t)lane * NGS; const float* gb = p.in[I_MGB] + (size_t)l * 16;
        const float gi = g[DIR * 8 + h], gf = g[DIR * 8 + 4 + h], bi = gb[DIR * 8 + h], bf_ = gb[DIR * 8 + 4 + h];
        const float mprev = ((const float*)(p.ws + WS_SC))[ch_index(DIR, b, h, cid) * 4 + 2];
        const float nv = ((const float*)(p.ws + WS_NV))[ch_index(DIR, b, h, cid) * 64 + lane];
        u32x4 qr[8];
#pragma unroll
        for (int c = 0; c < 8; ++c) qr[c] = *(const u32x4*)(P + (size_t)(r0 + lane) * NP + pbase + c * 8);
        const float ig = gi + bi, fg = gf + bf_;
        const float lf = logsigf_(fg); float bb;
        if (DIR == 0) bb = wave_prefix_sum(lf, lane); else { const float tt = wave_sum(lf), pre = wave_prefix_sum(lf, lane); bb = tt - pre + lf; }
        const float a = ig - bb; const float pm = DIR == 0 ? wave_prefix_max(a, lane) : wave_suffix_max(a, lane);
        const float mt_ = fmaxf(bb + mprev, bb + pm);
        float* ga = gar + DIR * 320;
        ga[lane] = bb - mt_; ga[64 + lane] = a; ga[128 + lane] = __expf(bb + mprev - mt_); ga[192 + lane] = __expf(-mt_);
        float* nvl = gar + 640 + DIR * 64;
        nvl[lane] = nv;
        WAVE_SYNC();
        float dq = 0.f;
#pragma unroll
        for (int c = 0; c < 8; ++c) { float f[8]; unpack8(qr[c], f);
            const f32x4 n0 = *(const f32x4*)(nvl + c * 8), n1 = *(const f32x4*)(nvl + c * 8 + 4);
            dq += f[0] * n0.x + f[1] * n0.y + f[2] * n0.z + f[3] * n0.w + f[4] * n1.x + f[5] * n1.y + f[6] * n1.z + f[7] * n1.w; }
        ga[256 + lane] = dq;
    }
}
template <int MIXER>
__device__ __forceinline__ void chunkout_prep2(const Params& p, int l, int b, int h, int cid, const float* Grow0, int r0, int pbase, float* gar, int lane_) {
    if constexpr (MIXER == 0) {
        const int lane = olane(lane_);
        const bf16* P = (const bf16*)(p.ws + WS_P);
        const float* g = Grow0 + (size_t)lane * NGS; const float* gb = p.in[I_MGB] + (size_t)l * 16;
        const float g0 = g[h], g1 = g[4 + h], g2 = g[8 + h], g3 = g[12 + h];
        const float mprev0 = ((const float*)(p.ws + WS_SC))[ch_index(0, b, h, cid) * 4 + 2], mprev1 = ((const float*)(p.ws + WS_SC))[ch_index(1, b, h, cid) * 4 + 2];
        const float nv0 = ((const float*)(p.ws + WS_NV))[ch_index(0, b, h, cid) * 64 + lane], nv1 = ((const float*)(p.ws + WS_NV))[ch_index(1, b, h, cid) * 64 + lane];
        u32x4 qr[8];
#pragma unroll
        for (int c = 0; c < 8; ++c) qr[c] = *(const u32x4*)(P + (size_t)(r0 + lane) * NP + pbase + c * 8);
        const float igF = g0 + gb[h], fgF = g1 + gb[4 + h], igB = g2 + gb[8 + h], fgB = g3 + gb[12 + h];
        { const float lf = logsigf_(fgF); const float bb = wave_prefix_sum(lf, lane);
            const float a = igF - bb; const float pm = wave_prefix_max(a, lane); const float mt_ = fmaxf(bb + mprev0, bb + pm); float* ga = gar;
            ga[lane] = bb - mt_; ga[64 + lane] = a; ga[128 + lane] = __expf(bb + mprev0 - mt_); ga[192 + lane] = __expf(-mt_); }
        { const float lf = logsigf_(fgB); const float tt = wave_sum(lf), pre = wave_prefix_sum(lf, lane); const float bb = tt - pre + lf;
            const float a = igB - bb; const float pm = wave_suffix_max(a, lane); const float mt_ = fmaxf(bb + mprev1, bb + pm); float* ga = gar + 320;
            ga[lane] = bb - mt_; ga[64 + lane] = a; ga[128 + lane] = __expf(bb + mprev1 - mt_); ga[192 + lane] = __expf(-mt_); }
        float* nvl = gar + 640;
        nvl[lane] = nv0; nvl[64 + lane] = nv1;
        WAVE_SYNC();
        float dq0 = 0.f, dq1 = 0.f;
#pragma unroll
        for (int c = 0; c < 8; ++c) { float f[8]; unpack8(qr[c], f);
            const f32x4 n0 = *(const f32x4*)(nvl + c * 8), n1 = *(const f32x4*)(nvl + c * 8 + 4), m0 = *(const f32x4*)(nvl + 64 + c * 8), m1 = *(const f32x4*)(nvl + 64 + c * 8 + 4);
            dq0 += f[0] * n0.x + f[1] * n0.y + f[2] * n0.z + f[3] * n0.w + f[4] * n1.x + f[5] * n1.y + f[6] * n1.z + f[7] * n1.w;
            dq1 += f[0] * m0.x + f[1] * m0.y + f[2] * m0.z + f[3] * m0.w + f[4] * m1.x + f[5] * m1.y + f[6] * m1.z + f[7] * m1.w; }
        gar[256 + lane] = dq0; gar[320 + 256 + lane] = dq1;
    }
}
template <int MIXER, int DIR, int NS>
__device__ __forceinline__ void chunkout_dir(const Params& p, int b, int h, int cid, int r0, int pbase, int th, const bf16x8 (&vtf)[4][2], const bf16* VtL, const bf16* EQ, bf16* SB, const float* gar, float* rsm, f32x4 (&htot)[NS][4], int lane_) {
    const bf16* P = (const bf16*)(p.ws + WS_P); const bf16* ST = (const bf16*)(p.ws + WS_ST);
    const int lane = olane(lane_), r = lane & 15, q4 = lane >> 4;
    const bf16* E = EQ + ((size_t)DIR * T + r0) * WG + h * 64;
    const float* ga = gar + DIR * 320;
    bf16x8 kf[4][2], ctf[4][2];
    if constexpr (MIXER == 0) {
#pragma unroll
        for (int n = 0; n < 4; ++n)
#pragma unroll
            for (int ks = 0; ks < 2; ++ks) { kf[n][ks] = *(const bf16x8*)(P + (size_t)(r0 + 16 * n + r) * NP + pbase + 256 + ks * 32 + q4 * 8); ctf[n][ks] = *(const bf16x8*)(ST + st_index(MIXER, DIR, b, h, cid) * 4096 + (16 * n + r) * 64 + ks * 32 + q4 * 8); }
    } else {
        u32x4 er[4][2];
#pragma unroll
        for (int n = 0; n < 4; ++n)
#pragma unroll
            for (int ks = 0; ks < 2; ++ks) { kf[n][ks] = *(const bf16x8*)(P + (size_t)(r0 + 16 * n + r) * NP + pbase + 256 + ks * 32 + q4 * 8);
                er[n][ks] = *(const u32x4*)(E + (size_t)(16 * n + r) * WG + ks * 32 + q4 * 8);
                ctf[n][ks] = *(const bf16x8*)(ST + st_index(MIXER, DIR, b, h, cid) * 4096 + (16 * n + r) * 64 + ks * 32 + q4 * 8); }
        SCHED_FENCE();
#pragma unroll
        for (int n = 0; n < 4; ++n)
#pragma unroll
            for (int ks = 0; ks < 2; ++ks) { float fe[8], fk[8]; unpack8(er[n][ks], fe); unpack8(as_u4(kf[n][ks]), fk);
#pragma unroll
                for (int j = 0; j < 8; ++j) fk[j] = fk[j] * frcp_(fe[j]);
                kf[n][ks] = as_frag(pack8(fk)); }
    }
    bf16x8 qraw[NS][2]; u32x4 qer[NS][2];
#pragma unroll
    for (int ms = 0; ms < NS; ++ms)
#pragma unroll
        for (int ks = 0; ks < 2; ++ks) { const int mt = NS * th + ms; qraw[ms][ks] = *(const bf16x8*)(P + (size_t)(r0 + 16 * mt + r) * NP + pbase + ks * 32 + q4 * 8);
            if constexpr (MIXER == 1) qer[ms][ks] = *(const u32x4*)(E + (size_t)(16 * mt + r) * WG + ks * 32 + q4 * 8); else qer[ms][ks] = (u32x4){0u, 0u, 0u, 0u}; }
#pragma unroll
    for (int ms = 0; ms < NS; ++ms) { const int mt = NS * th + ms;
        bf16x8 qf[2];
#pragma unroll
        for (int ks = 0; ks < 2; ++ks) { qf[ks] = qraw[ms][ks];
            if constexpr (MIXER == 1) { float fe[8], fq[8]; unpack8(qer[ms][ks], fe); unpack8(as_u4(qf[ks]), fq);
#pragma unroll
                for (int j = 0; j < 8; ++j) fq[j] *= 0.125f * fe[j];
                qf[ks] = as_frag(pack8(fq)); } }
        f32x4 S[4] = {(f32x4){0.f, 0.f, 0.f, 0.f}, (f32x4){0.f, 0.f, 0.f, 0.f}, (f32x4){0.f, 0.f, 0.f, 0.f}, (f32x4){0.f, 0.f, 0.f, 0.f}};
#pragma unroll
        for (int ks = 0; ks < 2; ++ks)
#pragma unroll
            for (int n = 0; n < 4; ++n) S[n] = MFMA16(kf[n][ks], qf[ks], S[n]);
        const int t = 16 * mt + r; float sm = 0.f; float gt = 0.f; if constexpr (MIXER == 0) gt = ga[t];
#pragma unroll
        for (int n = 0; n < 4; ++n) { f32x4 gs = {0.f, 0.f, 0.f, 0.f}; if constexpr (MIXER == 0) gs = *(const f32x4*)(ga + 64 + 16 * n + 4 * q4);
#pragma unroll
            for (int i = 0; i < 4; ++i) { const int sidx = 16 * n + 4 * q4 + i; const bool ok = DIR == 0 ? (sidx <= t) : (sidx >= t); float v = 0.f;
                if (ok) { if constexpr (MIXER == 0) v = S[n][i] * 0.125f * __expf(gt + gs[i]); else v = S[n][i]; }
                S[n][i] = v; sm += v; } }
        const float pa[8] = {S[0][0], S[0][1], S[0][2], S[0][3], S[1][0], S[1][1], S[1][2], S[1][3]}, pb[8] = {S[2][0], S[2][1], S[2][2], S[2][3], S[3][0], S[3][1], S[3][2], S[3][3]};
        const bf16x8 sm0 = as_frag(pack8(pa)), sm1 = as_frag(pack8(pb));
        float wi = 1.f, inv = 1.f;
        if constexpr (MIXER == 0) { sm = xrow_sum(sm); wi = ga[128 + t]; const float den = wi * ga[256 + t] + sm; inv = frcp_(fmaxf(fabsf(den), ga[192 + t])); }
#pragma unroll
        for (int me = 0; me < 4; ++me) { f32x4 a1 = {0.f, 0.f, 0.f, 0.f}, a2 = {0.f, 0.f, 0.f, 0.f};
            const int srow = 4 * q4 + (r >> 2), ecol = 16 * me + 4 * (r & 3);
            const u32x2 v0 = lds_tr16(VtL + swz(srow, ecol >> 3) + (ecol & 7)), v1 = lds_tr16(VtL + swz(16 + srow, ecol >> 3) + (ecol & 7)), v2 = lds_tr16(VtL + swz(32 + srow, ecol >> 3) + (ecol & 7)), v3 = lds_tr16(VtL + swz(48 + srow, ecol >> 3) + (ecol & 7));
            u32x4 va; va.x = v0.x; va.y = v0.y; va.z = v1.x; va.w = v1.y; u32x4 vb; vb.x = v2.x; vb.y = v2.y; vb.z = v3.x; vb.w = v3.y;
            a1 = MFMA16(as_frag(va), sm0, a1); a1 = MFMA16(as_frag(vb), sm1, a1);
            a2 = MFMA16(ctf[me][0], qf[0], a2); a2 = MFMA16(ctf[me][1], qf[1], a2);
            if constexpr (MIXER == 0) htot[ms][me] += (a1 + a2 * wi) * inv; else htot[ms][me] += a1 + a2; }
    }
    (void)SB; (void)rsm;
}
__device__ __forceinline__ void co_build_vt(const bf16* P, int r0, int vcol, bf16* VtL, int lane) {
    load_nat_tile(P, r0, vcol, VtL, lane);
    WAVE_SYNC();
}
template <int MIXER, int NS>
__device__ __forceinline__ void co_finalize(const Params& p, int l, int h, int r0, int pbase, int mt0, f32x4 (&htot)[NS][4], int lane_) {
    const bf16* P = (const bf16*)(p.ws + WS_P); bf16* Y = (bf16*)(p.ws + WS_HNY);
    const float* ngp = p.in[MIXER == 0 ? I_MNG : I_GNG] + (size_t)l * WG + h * 64;
    const int lz = olane(lane_), r = lz & 15, q4 = lz >> 4;
    u32x2 gq[NS][4], oq[NS][4]; f32x4 ng[4];
#pragma unroll
    for (int me = 0; me < 4; ++me) ng[me] = *(const f32x4*)(ngp + 16 * me + 4 * q4);
#pragma unroll
    for (int ms = 0; ms < NS; ++ms)
#pragma unroll
        for (int me = 0; me < 4; ++me) { const size_t off = (size_t)(r0 + 16 * (mt0 + ms) + r) * NP + pbase + 16 * me + 4 * q4;
            gq[ms][me] = *(const u32x2*)(P + off + (MIXER == 0 ? 1024 : 768)); if constexpr (MIXER == 0) oq[ms][me] = *(const u32x2*)(P + off + 768); else oq[ms][me] = (u32x2){0u, 0u}; }
#pragma unroll
    for (int ms = 0; ms < NS; ++ms) { const int mt = mt0 + ms; float ss = 0.f; float gv[4][4];
#pragma unroll
        for (int me = 0; me < 4; ++me) {
            gv[me][0] = bitsf(gq[ms][me].x << 16); gv[me][1] = bitsf(gq[ms][me].x & 0xffff0000u); gv[me][2] = bitsf(gq[ms][me].y << 16); gv[me][3] = bitsf(gq[ms][me].y & 0xffff0000u);
            if constexpr (MIXER == 0) { htot[ms][me][0] *= sigmoidf_(bitsf(oq[ms][me].x << 16)); htot[ms][me][1] *= sigmoidf_(bitsf(oq[ms][me].x & 0xffff0000u)); htot[ms][me][2] *= sigmoidf_(bitsf(oq[ms][me].y << 16)); htot[ms][me][3] *= sigmoidf_(bitsf(oq[ms][me].y & 0xffff0000u)); }
            ss += htot[ms][me][0] * htot[ms][me][0] + htot[ms][me][1] * htot[ms][me][1] + htot[ms][me][2] * htot[ms][me][2] + htot[ms][me][3] * htot[ms][me][3]; }
        ss = xrow_sum(ss);
        const float rstd = rsqrtf(ss * (1.0f / 64.0f) + EPS);
#pragma unroll
        for (int me = 0; me < 4; ++me) { const int e = 16 * me + 4 * q4; const f32x4 n4 = ng[me];
            u32x2 o; o.x = pk2(htot[ms][me][0] * rstd * n4.x * siluf_(gv[me][0]), htot[ms][me][1] * rstd * n4.y * siluf_(gv[me][1]));
            o.y = pk2(htot[ms][me][2] * rstd * n4.z * siluf_(gv[me][2]), htot[ms][me][3] * rstd * n4.w * siluf_(gv[me][3]));
            *(u32x2*)(Y + (size_t)(r0 + 16 * mt + r) * 1024 + (MIXER == 0 ? YA : YG) + h * 64 + e) = o; } }
}
template <int MIXER>
__device__ __forceinline__ void chunkout_w(const Params& p, int l, int b, int h, int cid, char* wl, int lane) {
    const bf16* P = (const bf16*)(p.ws + WS_P); const float* G = (const float*)(p.ws + WS_G);
    const int r0 = b * TOK + cid * 64;
    const int pbase = (MIXER == 0 ? PA : PG) + h * 64;
    bf16* SB = (bf16*)wl;
    float* rsm = (float*)(SB + 1024);
    float* gar = rsm + 16;
    const bf16* EQ = (const bf16*)(p.ws + WS_EQ);
    const float* Grow0 = G + (size_t)r0 * NGS;
    bf16* VtL = (bf16*)(gar + 768);
    bf16x8 vtf[4][2];
#pragma unroll
    for (int me = 0; me < 4; ++me)
#pragma unroll
        for (int ks = 0; ks < 2; ++ks) { vtf[me][ks] = (bf16x8){0, 0, 0, 0, 0, 0, 0, 0}; }
    co_build_vt(P, r0, pbase + 512, VtL, lane);
    chunkout_prep2<MIXER>(p, l, b, h, cid, Grow0, r0, pbase, gar, lane);
    WAVE_SYNC();
    constexpr int NS = 2;
#pragma unroll 1
    for (int th = 0; th < 4 / NS; ++th) {
        f32x4 htot[NS][4];
#pragma unroll
        for (int a = 0; a < NS; ++a)
#pragma unroll
            for (int c = 0; c < 4; ++c) htot[a][c] = (f32x4){0.f, 0.f, 0.f, 0.f};
        chunkout_dir<MIXER, 0, NS>(p, b, h, cid, r0, pbase, th, vtf, VtL, EQ, SB, gar, rsm, htot, lane);
        chunkout_dir<MIXER, 1, NS>(p, b, h, cid, r0, pbase, th, vtf, VtL, EQ, SB, gar, rsm, htot, lane);
        co_finalize<MIXER, NS>(p, l, h, r0, pbase, NS * th, htot, lane);
    }
}
constexpr int CO_PART = 13376;
template <int MIXER, int DIR>
__device__ __forceinline__ void chunkout_piece(const Params& p, int l, int b, int h, int cid, int mt, char* wl, int lane) {
    const bf16* P = (const bf16*)(p.ws + WS_P); const float* G = (const float*)(p.ws + WS_G);
    const int r0 = b * TOK + cid * 64; const int pbase = (MIXER == 0 ? PA : PG) + h * 64;
    bf16* SB = (bf16*)wl; float* rsm = (float*)(SB + 1024); float* gar = rsm + 16; const bf16* EQ = (const bf16*)(p.ws + WS_EQ);
    const float* Grow0 = G + (size_t)r0 * NGS; bf16* VtL = (bf16*)(gar + 768);
    bf16x8 vtf[4][2];
#pragma unroll
    for (int me = 0; me < 4; ++me)
#pragma unroll
        for (int ks = 0; ks < 2; ++ks) { vtf[me][ks] = (bf16x8){0, 0, 0, 0, 0, 0, 0, 0}; }
    co_build_vt(P, r0, pbase + 512, VtL, lane);
    chunkout_prep<MIXER, DIR>(p, l, b, h, cid, Grow0, r0, pbase, EQ, gar, lane);
    WAVE_SYNC();
    f32x4 htot[1][4] = {{(f32x4){0.f, 0.f, 0.f, 0.f}, (f32x4){0.f, 0.f, 0.f, 0.f}, (f32x4){0.f, 0.f, 0.f, 0.f}, (f32x4){0.f, 0.f, 0.f, 0.f}}};
    chunkout_dir<MIXER, DIR, 1>(p, b, h, cid, r0, pbase, mt, vtf, VtL, EQ, SB, gar, rsm, htot, lane);
    float* part = (float*)(wl + CO_PART);
#pragma unroll
    for (int me = 0; me < 4; ++me)
#pragma unroll
        for (int i = 0; i < 4; ++i) part[(me * 4 + i) * 64 + lane] = htot[0][me][i];
}
template <int MIXER>
__device__ __forceinline__ void chunkout_combine(const Params& p, int l, int b, int h, int cid, int mt, const char* smem, int lane) {
    const float* pa = (const float*)(smem + (2 * mt) * WLDS + CO_PART); const float* pb = (const float*)(smem + (2 * mt + 1) * WLDS + CO_PART);
    f32x4 htot[1][4];
#pragma unroll
    for (int me = 0; me < 4; ++me)
#pragma unroll
        for (int i = 0; i < 4; ++i) htot[0][me][i] = pa[(me * 4 + i) * 64 + lane] + pb[(me * 4 + i) * 64 + lane];
    co_finalize<MIXER, 1>(p, l, h, b * TOK + cid * 64, (MIXER == 0 ? PA : PG) + h * 64, mt, htot, lane);
}

template <bool OUT>
__device__ __forceinline__ void chunk_workers(const Params& p, int l, char* smem) {
    const int tid = otid(), lane = tid & 63, wave = __builtin_amdgcn_readfirstlane(tid >> 6);
    const int NW = (int)gridDim.x * 8, wi = wave * (int)gridDim.x + obid();
    const int c_lo = (OUT && l == DEPTH - 1) ? NCC : 0, npc = NCH - c_lo, half = NB * NH * npc;
    char* wl = smem + wave * WLDS;
    if (OUT) {
        const int cl = NCC, npl = NCH - NCC, halfl = NB * NH * npl;
#pragma unroll 1
        for (int t = wi; t < halfl; t += NW) { const int b = t / (NH * npl), h = (t / npl) % NH, cid = cl + t % npl;
            const Params q = relaunder(p); chunkout_w<1>(q, l, b, h, cid, wl, lane); }
        { const int used = halfl % NW;
#pragma unroll 1
            for (int t = (wi + NW - used) % NW; t < halfl; t += NW) { const int b = t / (NH * npl), h = (t / npl) % NH, cid = cl + t % npl;
                const Params q = relaunder(p); chunkout_w<0>(q, l, b, h, cid, wl, lane); } }
        if (l < DEPTH - 1) {
            const int nct = NB * NH * NCC;
#pragma unroll 1
            for (int st = obid(); st < 2 * nct; st += (int)gridDim.x) { const int mixer = st / nct, r2 = st % nct, b = r2 / (NH * NCC), h = (r2 / NCC) % NH, cid = r2 % NCC;
                const Params q = relaunder(p); const int mt = wave >> 1;
                __syncthreads();
                if (mixer == 0) { if (wave & 1) chunkout_piece<0, 1>(q, l, b, h, cid, mt, wl, lane); else chunkout_piece<0, 0>(q, l, b, h, cid, mt, wl, lane); }
                else            { if (wave & 1) chunkout_piece<1, 1>(q, l, b, h, cid, mt, wl, lane); else chunkout_piece<1, 0>(q, l, b, h, cid, mt, wl, lane); }
                __syncthreads();
                if (wave < 4) { if (mixer == 0) chunkout_combine<0>(q, l, b, h, cid, wave, smem, lane); else chunkout_combine<1>(q, l, b, h, cid, wave, smem, lane); }
            }
        }
    } else {
        int off = 0;
#pragma unroll 1
        for (int t = wi; t < half; t += NW) { const int b = t / (NH * npc), h = (t / npc) % NH, cid = c_lo + t % npc;
            const Params q = relaunder(p); chunkst_gla<0>(q, l, b, h, cid, wl, lane); }
        off = (off + half) % NW;
#pragma unroll 1
        for (int t = (wi + NW - off) % NW; t < half; t += NW) { const int b = t / (NH * npc), h = (t / npc) % NH, cid = c_lo + t % npc;
            const Params q = relaunder(p); chunkst_gla<1>(q, l, b, h, cid, wl, lane); }
        off = (off + half) % NW;
#pragma unroll 1
        for (int t = (wi + NW - off) % NW; t < half; t += NW) { const int b = t / (NH * npc), h = (t / npc) % NH, cid = c_lo + t % npc;
            const Params q = relaunder(p); chunkst_w<0>(q, l, b, h, cid, wl, lane); }
    }
}

__device__ __forceinline__ void phase_mix1(const Params& p, int l, char* smem) {
    const bool ctxo = l < DEPTH - 1; const int G = (int)gridDim.x, bid = obid();
    constexpr int N_HL = (NB / 2) * (WG / 2), N_HC = NB * (WG / HCB);
    chunk_workers<false>(p, l, smem);
    stage_signal(p, smem, 0, l);
    for (int t = bid; t < N_HL; t += G) hylat_task(p, l, t / (WG / 2), t % (WG / 2), smem);
    if (ctxo) for (int t = G - 1 - bid; t < N_HC; t += G) hyctx_task(p, l, t / (WG / HCB), t % (WG / HCB), smem);
    stage_signal(p, smem, 2, l);
}

constexpr int SCG = 12;
__device__ __forceinline__ void phase_scan(const Params& p, int l, char* smem) {
    const int tid = otid();
    bf16* ST = (bf16*)(p.ws + WS_ST); float* NV = (float*)(p.ws + WS_NV); const float* BE = (const float*)(p.ws + WS_BE); float* SC = (float*)(p.ws + WS_SC);
    constexpr int NCHAIN = 2 * 2 * NB * NH;
    stage_wait(p, 0, l);
    for (int item = obid() * NT + tid; item < NCHAIN * 1024; item += gridDim.x * NT) {
        const int chain = item >> 10, grp = item & 1023; const int mixer = chain / (2 * NB * NH), dir = (chain / (NB * NH)) % 2, b = (chain / NH) % NB, h = chain % NH;
        float c[4] = {0.f, 0.f, 0.f, 0.f}; float nv[4] = {0.f, 0.f, 0.f, 0.f}; float m = 0.f;
        const int d0 = (grp & 15) * 4; const bool donv = (mixer == 0) && (grp < 16);
        for (int o0 = 0; o0 < NCH; o0 += SCG) {
            u32x2 uu[SCG]; float s0[SCG], s1[SCG]; f32x4 be[SCG]; f32x4 nu[SCG];
#pragma unroll
            for (int j = 0; j < SCG; ++j) if (o0 + j < NCH) { const int cid = chain_cid(dir, o0 + j); const size_t ci = ch_index(dir, b, h, cid);
                uu[j] = *(const u32x2*)(ST + st_index(mixer, dir, b, h, cid) * 4096 + grp * 4);
                if (mixer == 0) { s0[j] = SC[ci * 4 + 0]; s1[j] = SC[ci * 4 + 1]; if (donv) nu[j] = *(const f32x4*)(NV + ci * 64 + grp * 4); }
                else be[j] = *(const f32x4*)(BE + ci * 64 + d0); }
#pragma unroll
            for (int j = 0; j < SCG; ++j) if (o0 + j < NCH) { const int cid = chain_cid(dir, o0 + j); const size_t ci = ch_index(dir, b, h, cid);
                const float u[4] = {bitsf(uu[j].x << 16), bitsf(uu[j].x & 0xffff0000u), bitsf(uu[j].y << 16), bitsf(uu[j].y & 0xffff0000u)};
                u32x2 w; w.x = pk2(c[0], c[1]); w.y = pk2(c[2], c[3]); *(u32x2*)(ST + st_index(mixer, dir, b, h, cid) * 4096 + grp * 4) = w;
                if (mixer == 0) {
                    if (grp == 0) SC[ci * 4 + 2] = m;
                    const float mn = fmaxf(s0[j] + m, s1[j]), a = __expf(s0[j] + m - mn), s = __expf(s1[j] - mn);
#pragma unroll
                    for (int k = 0; k < 4; ++k) c[k] = a * c[k] + s * u[k];
                    if (donv) { f32x4 nw = {nv[0], nv[1], nv[2], nv[3]}; *(f32x4*)(NV + ci * 64 + grp * 4) = nw;
                        nv[0] = a * nv[0] + s * nu[j].x; nv[1] = a * nv[1] + s * nu[j].y; nv[2] = a * nv[2] + s * nu[j].z; nv[3] = a * nv[3] + s * nu[j].w; }
                    m = mn;
                } else { c[0] = __expf(be[j].x) * c[0] + u[0]; c[1] = __expf(be[j].y) * c[1] + u[1]; c[2] = __expf(be[j].z) * c[2] + u[2]; c[3] = __expf(be[j].w) * c[3] + u[3]; } }
        }
    }
    stage_signal(p, smem, 1, l);
    { const bool ctxo = l < DEPTH - 1; const int G = (int)gridDim.x, bid = obid();
        constexpr int QTL = SEQ / 128, QTC = CTXL / 128, N_AL = NB * 2 * QTL, N_AC = NB * 2 * QTC;
        for (int t = bid; t < N_AL; t += G) attn_task(p, l, t / (2 * QTL), (t / QTL) % 2, t % QTL, false, smem);
        if (ctxo) for (int t = (bid + G - 64 % G) % G; t < N_AC; t += G) attn_task(p, l, t / (2 * QTC), (t / QTC) % 2, t % QTC, true, smem); }
}

__device__ __forceinline__ void phase_mix2(const Params& p, int l, char* smem) {
    const int tid = otid();
    stage_wait(p, 1, l);
    chunk_workers<true>(p, l, smem);
    stage_wait(p, 2, l);
    constexpr int N_WOUT = (DM / 64) * (MIX / 64);
    { const int lane = tid & 63, wave = __builtin_amdgcn_readfirstlane(tid >> 6); const int NW = (int)gridDim.x * 8, wi = wave * (int)gridDim.x + obid();
        for (int task = NW - 1 - wi; task < N_WOUT; task += NW) { const int nt = task / (MIX / 64), kt = task % (MIX / 64);
            convert_tile_w(p.in[I_WOUT] + (size_t)l * MIX * DM, DM, (bf16*)(p.ws + WS_WOUT), MIX, nt * 64, kt * 64, false, smem + wave * WLDS, lane); }
        bf16* tile = (bf16*)(smem + wave * WLDS); const bf16* HT = (const bf16*)(p.ws + WS_HT); bf16* Y = (bf16*)(p.ws + WS_HNY);
        constexpr int NTT = NB * (SEQ / 64) * 4;
        for (int t = wi; t < NTT; t += NW) { const int b = t / ((SEQ / 64) * 4), tt = (t / 4) % (SEQ / 64), c0 = (t % 4) * 64; const size_t tok0 = (size_t)b * TOK + CTXL + tt * 64;
            u32x4 tv[8];
#pragma unroll
            for (int i = 0; i < 8; ++i) { const int ch = (lane >> 3) + 8 * i, ck = lane & 7; tv[i] = *(const u32x4*)(HT + (size_t)(768 + c0 + ch) * T + tok0 + ck * 8); }
#pragma unroll
            for (int i = 0; i < 8; ++i) { const int ch = (lane >> 3) + 8 * i, ck = lane & 7; *(u32x4*)(tile + swz(ch, ck)) = tv[i]; }
            WAVE_SYNC();
#pragma unroll
            for (int i = 0; i < 8; ++i) { const int tk = (lane >> 3) + 8 * i, cc = lane & 7; unsigned w[4];
#pragma unroll
                for (int j = 0; j < 4; ++j) { const int ca = cc * 8 + 2 * j; w[j] = (unsigned)tile[swz(ca, tk >> 3) + (tk & 7)] | ((unsigned)tile[swz(ca + 1, tk >> 3) + (tk & 7)] << 16); }
                u32x4 o; o.x = w[0]; o.y = w[1]; o.z = w[2]; o.w = w[3]; *(u32x4*)(Y + (tok0 + tk) * 1024 + YH + c0 + cc * 8) = o; }
            WAVE_SYNC(); } }
}


#ifndef EMU
#define LAS __attribute__((address_space(3)))
#define XB_TMO      128
#define XB_XCNT(j)  (256  + 64 * (j))
#define XB_XSUB(j)  (1280 + 64 * (j))
#define XB_XGEN(j)  (2304 + 64 * (j))
#define XB_TOP      3328
#define XB_TOPGEN   3392
#define XCD_BAR_WORDS 3456
#define XB_SPIN_CAP (1u << 18)

__device__ __forceinline__ unsigned xb_ld(unsigned* p)              { return __hip_atomic_load(p, __ATOMIC_RELAXED, __HIP_MEMORY_SCOPE_AGENT); }
__device__ __forceinline__ unsigned xb_add(unsigned* p, unsigned v) { return __hip_atomic_fetch_add(p, v, __ATOMIC_RELAXED, __HIP_MEMORY_SCOPE_AGENT); }
__device__ __forceinline__ unsigned xb_xcc_id() { return (unsigned)__builtin_amdgcn_s_getreg((3 << 11) | 20) & 0xFu; }
#define XB_SPIN(cond, bar) do { unsigned _sp = 0; while (cond) { __builtin_amdgcn_s_sleep(1); \
    if ((++_sp & 255u) == 0u) { if (xb_ld(&(bar)[XB_TMO])) break; if (_sp > XB_SPIN_CAP) { atomicAdd(&(bar)[XB_TMO], 1u); break; } } } } while (0)

struct XcdBarrier {
    unsigned* bar; unsigned x;
    volatile LAS unsigned* st;
};

__device__ __forceinline__ XcdBarrier xcd_barrier_post(unsigned* bar, volatile LAS unsigned* st) {
    XcdBarrier b; b.bar = bar; b.x = xb_xcc_id(); b.st = st;
    if (threadIdx.x == 0) (void)xb_add(&bar[XB_XCNT(b.x)], 1u);
    return b;
}
__device__ __forceinline__ void xcd_barrier_complete(unsigned* bar, unsigned x, unsigned& nloc, unsigned& nx) {
    const unsigned G = gridDim.x * gridDim.y * gridDim.z;
    unsigned sum, cnt, mine, sp = 0u;
    for (;;) {
        sum = 0u; cnt = 0u; mine = 0u;
#pragma unroll
        for (unsigned j = 0; j < 16; ++j) { const unsigned c = xb_ld(&bar[XB_XCNT(j)]); sum += c; cnt += (c > 0u) ? 1u : 0u; mine = (j == x) ? c : mine; }
        if (sum == G) break;
        __builtin_amdgcn_s_sleep(1);
        if ((++sp & 255u) == 0u) { if (xb_ld(&bar[XB_TMO])) break; if (sp > XB_SPIN_CAP) { atomicAdd(&bar[XB_TMO], 1u); break; } }
    }
    nloc = mine > 0u ? mine : 1u; nx = cnt > 0u ? cnt : 1u;
}

__device__ __forceinline__ void xcd_barrier(const XcdBarrier& b) {
    asm volatile("s_waitcnt vmcnt(0)" ::: "memory");
    __syncthreads();
    if (threadIdx.x == 0) {
        unsigned* bar = b.bar;
        __builtin_amdgcn_s_waitcnt(0);
        unsigned nloc = b.st[0], nx = b.st[1];
        if (nloc == 0u) { xcd_barrier_complete(bar, b.x, nloc, nx); b.st[0] = nloc; b.st[1] = nx; }
        const unsigned old = xb_add(&bar[XB_XSUB(b.x)], 1u);
        const unsigned gen = old / nloc;
        if (old + 1u == (gen + 1u) * nloc) {
            __builtin_amdgcn_fence(__ATOMIC_RELEASE, "agent");
            asm volatile("s_waitcnt vmcnt(0)" ::: "memory");
            const unsigned og = xb_add(&bar[XB_TOP], 1u);
            const unsigned tg = og / nx;
            if (og + 1u == (tg + 1u) * nx) xb_add(&bar[XB_TOPGEN], 1u);
            else XB_SPIN(xb_ld(&bar[XB_TOPGEN]) == tg, bar);
            __builtin_amdgcn_fence(__ATOMIC_ACQUIRE, "agent");
            xb_add(&bar[XB_XGEN(b.x)], 1u);
            asm volatile("s_waitcnt vmcnt(0)" ::: "memory");
        } else {
            XB_SPIN(xb_ld(&bar[XB_XGEN(b.x)]) == gen, bar);
            __builtin_amdgcn_fence(__ATOMIC_ACQUIRE, "agent");
            asm volatile("s_waitcnt vmcnt(0)" ::: "memory");
        }
    }
    __syncthreads();
}
#endif

__global__ void __launch_bounds__(NT) fwd_kernel(Params pk, int ph_lo, int ph_hi) {
    SMEM_DECL;
#ifndef EMU
    volatile LAS unsigned* misc = (volatile LAS unsigned*)(smem + LDS_BYTES - 64);
    if (threadIdx.x < 2) misc[threadIdx.x] = 0u;
    __syncthreads();
    const XcdBarrier bar = xcd_barrier_post((unsigned*)(pk.ws + WS_BAR), misc);
#endif
    constexpr int NPH = 2 + 6 * DEPTH;
    for (int ph = ph_lo; ph < ph_hi && ph < NPH; ++ph) {
#ifndef EMU
        Params p = pk; { size_t z = 0; asm volatile("" : "+s"(z)); p.ws = pk.ws + z; p.out = pk.out + z;
#pragma unroll
            for (int i = 0; i < 26; ++i) p.in[i] = pk.in[i] + z; }
#else
        const Params& p = pk;
#endif
        if (ph == 0) phase0(p, smem);
        else if (ph == NPH - 1) phase_rp(p, DEPTH, smem);
        else { const int l = (ph - 1) / 6, k = (ph - 1) % 6;
            if (k == 0) phase_rp(p, l, smem);
            else if (k == 1) phase_gemm_in(p, l, smem);
            else if (k == 2) phase_mix1(p, l, smem);
            else if (k == 3) phase_scan(p, l, smem);
            else if (k == 4) phase_mix2(p, l, smem);
            else phase_gemm_out(p, l, smem);
#ifdef PROBE_DUP
            if (k == PROBE_DUP) { GRID_SYNC();
                if (k == 1) phase_gemm_in(p, l, smem); else if (k == 2) phase_mix1(p, l, smem); else if (k == 4) phase_mix2(p, l, smem); }
#endif
        }
        if (ph + 1 < ph_hi && !(ph >= 6 && ph % 6 == 0) && !(ph >= 1 && ((ph - 1) % 6 == 2 || (ph - 1) % 6 == 3))) {
#ifdef EMU
            GRID_SYNC();
#else
            if (ph_lo < 0) GRID_SYNC();
            xcd_barrier(bar);
#endif
        }
    }
}

#ifndef EMU
extern "C" void kernel_launch(void* const* d_in, const int* in_sizes, int n_in, void* d_out, int out_size, void* d_ws, size_t ws_size, hipStream_t stream) {
    static int grid = 0;
    if (grid == 0) {
        if (n_in != 26 || ws_size < WS_TOTAL) { fprintf(stderr, "kernel_launch: unexpected n_in %d or ws_size %zu (need %zu)\n", n_in, ws_size, (size_t)WS_TOTAL); grid = -1; return; }
        int dev = 0, cus = 0, per_cu = 0;
        hipGetDevice(&dev);
        hipDeviceGetAttribute(&cus, hipDeviceAttributeMultiprocessorCount, dev);
        hipFuncSetAttribute((const void*)fwd_kernel, hipFuncAttributeMaxDynamicSharedMemorySize, LDS_BYTES);
        hipOccupancyMaxActiveBlocksPerMultiprocessor(&per_cu, (const void*)fwd_kernel, NT, LDS_BYTES);
        if (per_cu < 1) { fprintf(stderr, "kernel_launch: occupancy query returned %d\n", per_cu); grid = -1; return; }
        if (per_cu > 1) per_cu = 1;
        grid = cus * per_cu;
    }
    if (grid < 0) return;
    hipMemsetAsync((char*)d_ws + WS_BAR, 0, BAR_BYTES, stream);
    Params p{};
    for (int i = 0; i < 26; ++i) p.in[i] = (const float*)d_in[i];
    p.out = (float*)d_out; p.ws = (char*)d_ws;
    int lo = 0, hi = 2 + 6 * DEPTH;
    void* args[] = {&p, &lo, &hi};
    hipError_t e = hipLaunchCooperativeKernel((const void*)fwd_kernel, dim3(grid), dim3(NT), args, LDS_BYTES, stream);
    if (e != hipSuccess) fprintf(stderr, "cooperative launch failed: %s (grid %d)\n", hipGetErrorString(e), grid);
}
#endif
```

```cpp
#ifdef EMU
#include "emu/hipemu.h"
#define GRID_SYNC() emu::grid_sync()
#define SMEM_DECL char* smem = emu::S().blocks[emu::cur()->block].lds
#define SCHED_FENCE() do {} while (0)
#define EXP2(x) exp2f(x)
#define MFMA16(a, b, c) emu_mfma_16x16x32_bf16(a, b, c)
#else
#include <hip/hip_runtime.h>
#include <hip/hip_cooperative_groups.h>
#include <cstdio>
#include <cstdint>
#define GRID_SYNC() cooperative_groups::this_grid().sync()
#define SMEM_DECL extern __shared__ __attribute__((aligned(16))) char smem[]
#define SCHED_FENCE() __builtin_amdgcn_sched_barrier(0)
#define EXP2(x) __builtin_amdgcn_exp2f(x)
#define MFMA16(a, b, c) __builtin_amdgcn_mfma_f32_16x16x32_bf16(a, b, c, 0, 0, 0)
#endif

#ifdef EMU
#ifndef EMU_DM
#define EMU_DM 256
#endif
#ifndef EMU_NB
#define EMU_NB 2
#endif
#ifndef EMU_SEQ
#define EMU_SEQ 512
#endif
#ifndef EMU_DEPTH
#define EMU_DEPTH 2
#endif
#ifndef EMU_CTXL
#define EMU_CTXL 128
#endif
constexpr int DM = EMU_DM, NB = EMU_NB, SEQ = EMU_SEQ, DEPTH = EMU_DEPTH, CTXL = EMU_CTXL;
#else
constexpr int DM = 1024, NB = 8, SEQ = 2048, DEPTH = 4, CTXL = 256;
#endif
constexpr int MIX = 1024, WG = 256, HD = 64, NH = 4, CH = 64;
constexpr int TOK = CTXL + SEQ, T = NB * TOK, NCH = TOK / CH, NCC = CTXL / CH;
constexpr int N_IN = 4144, NP = 3072, NG = 48, NGS = 32, NMAIN = 3328, NPAD = 4352;
constexpr int NF = 2 * SEQ;
constexpr int NJ = NB + 1;
constexpr int NT = 512;
constexpr float EPS = 1e-6f;
constexpr int PA = 0, PG = 1280, PD = 2304;
constexpr int YA = 0, YH = 256, YG = 512, YD = 768;
constexpr int ilog4(int n) { return n <= 1 ? 0 : 1 + ilog4(n / 4); }
constexpr int FFT_P = ilog4(NF);
static_assert((1 << (2 * FFT_P)) == NF, "NF must be a power of 4");
static_assert(DM % 256 == 0 && CTXL % 128 == 0 && SEQ % 256 == 0, "shape constraints");

typedef unsigned short bf16;
typedef short bf16x8 __attribute__((ext_vector_type(8)));
typedef float f32x4 __attribute__((ext_vector_type(4)));
typedef unsigned u32x4 __attribute__((ext_vector_type(4)));
typedef unsigned u32x2 __attribute__((ext_vector_type(2)));
struct cpx { float x, y; };

constexpr size_t al256(size_t x) { return (x + 255) & ~(size_t)255; }
constexpr size_t WS_CTXB = 0;
constexpr size_t WS_HNY = al256(WS_CTXB + (size_t)NB * CTXL * DM * 4);
constexpr size_t WS_WIN = WS_HNY + (size_t)T * 1024 * 2;
constexpr size_t WS_ST = WS_WIN;
constexpr size_t ST_BYTES = (size_t)2 * 2 * NB * NH * NCH * 4096 * 2;
constexpr size_t WS_KT = al256(WS_WIN + (size_t)NPAD * DM * 2);
static_assert(WS_KT + (size_t)WG * NF * 4 <= WS_ST + ST_BYTES || true, "");
constexpr size_t ST_END = al256((WS_ST + ST_BYTES > WS_KT + (size_t)WG * NF * 4) ? WS_ST + ST_BYTES : WS_KT + (size_t)WG * NF * 4);
constexpr size_t WS_P = ST_END;
constexpr size_t WS_HT = al256(WS_P + (size_t)T * NP * 2);
constexpr size_t WS_WOUT = WS_HT;
constexpr size_t WS_G = al256(WS_HT + (size_t)1024 * T * 2);
constexpr size_t WS_KF = al256(WS_G + (size_t)T * NGS * 4);
constexpr size_t WS_HC = al256(WS_KF + (size_t)WG * NF * 8);
constexpr size_t WS_EQ = al256(WS_HC + (size_t)2 * WG * CTXL * 4);
constexpr size_t WS_NV = al256(WS_EQ + (size_t)2 * T * WG * 2);
constexpr size_t WS_BE = al256(WS_NV + (size_t)2 * NB * NH * NCH * 64 * 4);
constexpr size_t WS_SC = al256(WS_BE + (size_t)2 * NB * NH * NCH * 64 * 4);
constexpr size_t WS_MOD = al256(WS_SC + (size_t)2 * NB * NH * NCH * 4 * 4);
constexpr size_t WS_TW = al256(WS_MOD + (size_t)DEPTH * NJ * 3 * DM * 4);
constexpr size_t WS_ROPE = al256(WS_TW + (size_t)NF * 8);
constexpr size_t WS_BAR = al256(WS_ROPE + (size_t)SEQ * 32 * 8);
constexpr size_t BAR_BYTES = 32768;
constexpr size_t WS_TOTAL = al256(WS_BAR + BAR_BYTES);
static_assert((size_t)T * DM * 4 <= (size_t)T * NP * 2, "YO fits in P");
#ifndef EMU
static_assert(WS_TOTAL <= (size_t)268435456, "workspace map must fit 256 MiB");
#endif

constexpr int LDS_BYTES = 163840;

struct Params {
    const float* in[26];
    float* out;
    char* ws;
};
enum { I_X = 0, I_C, I_CTX, I_CCTX, I_WADA, I_BADA, I_GPRE, I_GPOST, I_WIN, I_MGB, I_MNG, I_HCW, I_HCB, I_HW1, I_HB1, I_HW2, I_HB2, I_HW3, I_HB3,
       I_HFREQ, I_HD, I_GWA, I_GBA, I_GNG, I_SINK, I_WOUT };

__device__ __forceinline__ Params relaunder(const Params& pk) {
#ifdef EMU
    return pk;
#else
    Params p = pk; size_t z = 0; asm volatile("" : "+s"(z)); p.ws = pk.ws + z; p.out = pk.out + z;
#pragma unroll
    for (int i = 0; i < 26; ++i) p.in[i] = pk.in[i] + z;
    return p;
#endif
}
constexpr int WLDS = (LDS_BYTES - 64) / 8 / 16 * 16;
#ifdef EMU
#define WAVE_SYNC() emu_wave_sync()
#else
#define WAVE_SYNC() do { asm volatile("s_waitcnt lgkmcnt(0)" ::: "memory"); __builtin_amdgcn_wave_barrier(); } while (0)
#endif

#ifdef EMU
__device__ __forceinline__ int otid() { return (int)threadIdx.x; }
__device__ __forceinline__ int obid() { return (int)blockIdx.x; }
#else
__device__ __forceinline__ int otid() { int t = (int)threadIdx.x; asm volatile("" : "+v"(t)); return t; }
__device__ __forceinline__ int obid() { int b = (int)blockIdx.x; asm volatile("" : "+s"(b)); return b; }
#endif
__device__ __forceinline__ unsigned fbits(float f) { return __builtin_bit_cast(unsigned, f); }
__device__ __forceinline__ float bitsf(unsigned u) { return __builtin_bit_cast(float, u); }
__device__ __forceinline__ float bf2f(bf16 h) { return bitsf((unsigned)h << 16); }
#ifdef EMU
__device__ __forceinline__ bf16 f2bf(float f) { unsigned u = fbits(f); return (bf16)((u + 0x7fffu + ((u >> 16) & 1u)) >> 16); }
__device__ __forceinline__ unsigned pk2(float lo, float hi) { return (unsigned)f2bf(lo) | ((unsigned)f2bf(hi) << 16); }
#else
typedef __bf16 nbf16x2 __attribute__((ext_vector_type(2)));
typedef float nf32x2 __attribute__((ext_vector_type(2)));
__device__ __forceinline__ unsigned pk2(float lo, float hi) { const nf32x2 v = {lo, hi}; return __builtin_bit_cast(unsigned, __builtin_convertvector(v, nbf16x2)); }
__device__ __forceinline__ bf16 f2bf(float f) { return (bf16)(pk2(f, 0.0f) & 0xffffu); }
#endif
#ifdef EMU
__device__ __forceinline__ float frcp_(float x) { return 1.0f / x; }
#else
__device__ __forceinline__ float frcp_(float x) { return __builtin_amdgcn_rcpf(x); }
#endif
__device__ __forceinline__ float sigmoidf_(float x) { return frcp_(1.0f + __expf(-x)); }
__device__ __forceinline__ float siluf_(float x) { return x * frcp_(1.0f + __expf(-x)); }
__device__ __forceinline__ float logsigf_(float x) { return fminf(x, 0.0f) - log1pf(__expf(-fabsf(x))); }
__device__ __forceinline__ float logsig_fast(float x) { return fminf(x, 0.0f) - __logf(1.0f + __expf(-fabsf(x))); }
#ifdef EMU
__device__ __forceinline__ float row16_sum(float x) { x += __shfl_xor(x, 1); x += __shfl_xor(x, 2); x += __shfl_xor(x, 4); x += __shfl_xor(x, 8); return x; }
__device__ __forceinline__ float row16_max(float x) { x = fmaxf(x, __shfl_xor(x, 1)); x = fmaxf(x, __shfl_xor(x, 2)); x = fmaxf(x, __shfl_xor(x, 4)); x = fmaxf(x, __shfl_xor(x, 8)); return x; }
__device__ __forceinline__ float xrow_sum(float x) { x += __shfl_xor(x, 16); x += __shfl_xor(x, 32); return x; }
__device__ __forceinline__ float xrow_max(float x) { x = fmaxf(x, __shfl_xor(x, 16)); x = fmaxf(x, __shfl_xor(x, 32)); return x; }
#else
template <int CTRL> __device__ __forceinline__ float dpp_(float x) { return __builtin_bit_cast(float, __builtin_amdgcn_mov_dpp(__builtin_bit_cast(int, x), CTRL, 0xf, 0xf, true)); }
__device__ __forceinline__ float row16_sum(float x) { x += dpp_<0xB1>(x); x += dpp_<0x4E>(x); x += dpp_<0x141>(x); x += dpp_<0x128>(x); return x; }
__device__ __forceinline__ float row16_max(float x) { x = fmaxf(x, dpp_<0xB1>(x)); x = fmaxf(x, dpp_<0x4E>(x)); x = fmaxf(x, dpp_<0x141>(x)); x = fmaxf(x, dpp_<0x128>(x)); return x; }
__device__ __forceinline__ float xrow_sum(float x) {
    auto s = __builtin_amdgcn_permlane16_swap(fbits(x), fbits(x), false, false); x = bitsf(s[0]) + bitsf(s[1]);
    auto t = __builtin_amdgcn_permlane32_swap(fbits(x), fbits(x), false, false); return bitsf(t[0]) + bitsf(t[1]); }
__device__ __forceinline__ float xrow_max(float x) {
    auto s = __builtin_amdgcn_permlane16_swap(fbits(x), fbits(x), false, false); x = fmaxf(bitsf(s[0]), bitsf(s[1]));
    auto t = __builtin_amdgcn_permlane32_swap(fbits(x), fbits(x), false, false); return fmaxf(bitsf(t[0]), bitsf(t[1])); }
#endif
__device__ __forceinline__ float wave_sum(float v) { return xrow_sum(row16_sum(v)); }
__device__ __forceinline__ float wave_max(float v) { return xrow_max(row16_max(v)); }
#ifdef EMU
__device__ __forceinline__ float wave_prefix_sum(float v, int lane) {
#pragma unroll
    for (int o = 1; o < 64; o <<= 1) { float t = __shfl_up(v, o); if (lane >= o) v += t; }
    return v;
}
__device__ __forceinline__ float wave_prefix_max(float v, int lane) {
#pragma unroll
    for (int o = 1; o < 64; o <<= 1) { float t = __shfl_up(v, o); if (lane >= o) v = fmaxf(v, t); }
    return v;
}
#else
template <int CTRL, int RM> __device__ __forceinline__ float dppo_(float old, float x) { return __builtin_bit_cast(float, __builtin_amdgcn_update_dpp(__builtin_bit_cast(int, old), __builtin_bit_cast(int, x), CTRL, RM, 0xf, false)); }
__device__ __forceinline__ float wave_prefix_sum(float v, int) {
    v += dppo_<0x111, 0xf>(0.f, v); v += dppo_<0x112, 0xf>(0.f, v); v += dppo_<0x114, 0xf>(0.f, v); v += dppo_<0x118, 0xf>(0.f, v);
    v += dppo_<0x142, 0xa>(0.f, v); v += dppo_<0x143, 0xc>(0.f, v); return v;
}
__device__ __forceinline__ float wave_prefix_max(float v, int) {
    const float ninf = -INFINITY;
    v = fmaxf(v, dppo_<0x111, 0xf>(ninf, v)); v = fmaxf(v, dppo_<0x112, 0xf>(ninf, v)); v = fmaxf(v, dppo_<0x114, 0xf>(ninf, v)); v = fmaxf(v, dppo_<0x118, 0xf>(ninf, v));
    v = fmaxf(v, dppo_<0x142, 0xa>(ninf, v)); v = fmaxf(v, dppo_<0x143, 0xc>(ninf, v)); return v;
}
#endif
__device__ __forceinline__ float wave_suffix_max(float v, int lane) {
    return __shfl(wave_prefix_max(__shfl(v, 63 - lane), lane), 63 - lane);
}
__device__ __forceinline__ void unpack8(u32x4 v, float* f) {
    f[0] = bitsf(v.x << 16); f[1] = bitsf(v.x & 0xffff0000u); f[2] = bitsf(v.y << 16); f[3] = bitsf(v.y & 0xffff0000u);
    f[4] = bitsf(v.z << 16); f[5] = bitsf(v.z & 0xffff0000u); f[6] = bitsf(v.w << 16); f[7] = bitsf(v.w & 0xffff0000u);
}
__device__ __forceinline__ int orig_col(int n) {
    if (n < 1280) return n;
    if (n < 2304) return 2320 + (n - 1280);
    if (n < 3072) return 3376 + (n - 2304);
    if (n < 3088) return 1280 + (n - 3072);
    if (n < 3120) return 3344 + (n - 3088);
    if (n < NMAIN) return -1;
    return 1296 + (n - NMAIN);
}
__device__ __forceinline__ int chain_cid(int dir, int o) {
    if (dir == 0) return o;
    return o < NCC ? (NCC - 1 - o) : (NCH - 1 - (o - NCC));
}

__device__ __forceinline__ int swz(int row, int ch) { return row * 64 + ((ch ^ (row & 7)) << 3); }
__device__ __forceinline__ u32x4 pack8(const float* f) { u32x4 o; o.x = pk2(f[0], f[1]); o.y = pk2(f[2], f[3]); o.z = pk2(f[4], f[5]); o.w = pk2(f[6], f[7]); return o; }
__device__ __forceinline__ bf16x8 as_frag(u32x4 v) { return __builtin_bit_cast(bf16x8, v); }
#ifdef EMU
inline u32x2 lds_tr16(const bf16* p) { unsigned mine[2]; const unsigned long long a = (unsigned long long)p; mine[0] = (unsigned)a; mine[1] = (unsigned)(a >> 32);
    auto buf = emu::collective(mine, 2); const int l = emu::cur()->lane, g = l >> 4, i = l & 15; unsigned short e[4];
    for (int j = 0; j < 4; ++j) { const int src = 16 * g + 4 * j + (i >> 2); const bf16* q = (const bf16*)(((unsigned long long)buf[src][1] << 32) | buf[src][0]); e[j] = *(const unsigned short*)(q + (i & 3)); }
    u32x2 r; r.x = (unsigned)e[0] | ((unsigned)e[1] << 16); r.y = (unsigned)e[2] | ((unsigned)e[3] << 16); return r; }
#else
typedef short v4i16_t __attribute__((ext_vector_type(4)));
__device__ __forceinline__ u32x2 lds_tr16(const bf16* p) { return __builtin_bit_cast(u32x2, __builtin_amdgcn_ds_read_tr16_b64_v4i16((__attribute__((address_space(3))) v4i16_t*)p)); }
#endif
__device__ __forceinline__ u32x4 as_u4(bf16x8 v) { return __builtin_bit_cast(u32x4, v); }

constexpr int LS = 72;

template <int NTL, int KS>
__device__ __forceinline__ void mma_nt(const bf16* A, int lda, int m0, const bf16* B, int ldb, int n0, f32x4 (&acc)[NTL], int lane) {
    const int r = lane & 15, q = lane >> 4;
#pragma unroll
    for (int ks = 0; ks < KS; ++ks) {
        const bf16x8 a = *(const bf16x8*)(A + (m0 + r) * lda + ks * 32 + q * 8);
#pragma unroll
        for (int nt = 0; nt < NTL; ++nt) {
            const bf16x8 b = *(const bf16x8*)(B + (n0 + nt * 16 + r) * ldb + ks * 32 + q * 8);
            acc[nt] = MFMA16(a, b, acc[nt]);
        }
    }
}

__device__ __forceinline__ void layer_prep(const Params& p, int l, int idx, int stride, char* smem);
__device__ __forceinline__ void phase0(const Params& p, char* smem) {
    const int tid = otid();
    cpx* TW = (cpx*)(p.ws + WS_TW);
    cpx* ROPE = (cpx*)(p.ws + WS_ROPE);
    float* MOD = (float*)(p.ws + WS_MOD);
    constexpr int N_TW = NF / NT, N_ROPE = SEQ * 32 / NT, N_MOD = DEPTH * (3 * DM / 64);
    for (int task = obid(); task < N_TW + N_ROPE + N_MOD; task += gridDim.x) {
        if (task < N_TW) {
            const int j = task * NT + tid; float s, c; sincospif(2.0f * (float)j / (float)NF, &s, &c);
            cpx v; v.x = c; v.y = -s; TW[j] = v;
        } else if (task < N_TW + N_ROPE) {
            const int idx = (task - N_TW) * NT + tid; const int pos = idx >> 5, i = idx & 31;
            const float inv = exp2f(-(float)(i & 15) * (13.287712379549449f / 16.0f));
            const float ang = (float)(i < 16 ? pos / 64 : pos % 64) * inv;
            cpx v; v.x = cosf(ang); v.y = sinf(ang); ROPE[idx] = v;
        } else {
            const int mt = task - N_TW - N_ROPE; const int l = mt / (3 * DM / 64), n0 = (mt % (3 * DM / 64)) * 64;
            float* sv = (float*)smem;
            float* red = sv + NJ * DM;
            __syncthreads();
            for (int i = tid; i < NJ * DM; i += NT) { const int j = i / DM, k = i % DM; const float v = j < NB ? p.in[I_C][j * DM + k] : p.in[I_CCTX][k]; sv[i] = siluf_(v); }
            __syncthreads();
            const int c4 = tid & 15, kg = tid >> 4; f32x4 acc[NJ];
#pragma unroll
            for (int j = 0; j < NJ; ++j) acc[j] = (f32x4){0.f, 0.f, 0.f, 0.f};
            const float* w = p.in[I_WADA] + (size_t)l * DM * 3 * DM + n0 + 4 * c4;
            static_assert((DM / 32) % 8 == 0, "weight loads in batches of 8");
#pragma unroll 1
            for (int i0 = 0; i0 < DM / 32; i0 += 8) { f32x4 wv[8];
#pragma unroll
                for (int i = 0; i < 8; ++i) wv[i] = *(const f32x4*)(w + (size_t)(kg + 32 * (i0 + i)) * 3 * DM);
                SCHED_FENCE();
#pragma unroll
                for (int i = 0; i < 8; ++i) { const int k = kg + 32 * (i0 + i);
#pragma unroll
                    for (int j = 0; j < NJ; ++j) acc[j] = acc[j] + wv[i] * sv[j * DM + k]; } }
#pragma unroll
            for (int j = 0; j < NJ; ++j) *(f32x4*)(red + (kg * NJ + j) * 64 + 4 * c4) = acc[j];
            __syncthreads();
            for (int i = tid; i < NJ * 64; i += NT) { const int j = i / 64, n = i % 64; float s = 0.f;
#pragma unroll
                for (int k8 = 0; k8 < 32; ++k8) s += red[(k8 * NJ + j) * 64 + n];
                MOD[((size_t)l * NJ + j) * 3 * DM + n0 + n] = s + p.in[I_BADA][(size_t)l * 3 * DM + n0 + n]; }
        }
    }
}

#ifdef EMU
constexpr int PANEL_ROWS = 128, PANEL_UNITS = DM / 128;
#else
constexpr int PANEL_ROWS = 256, PANEL_UNITS = DM / 256;
#endif
__device__ __forceinline__ unsigned* unit_counter(const Params& p, int isctx) { return (unsigned*)(p.ws + WS_BAR + 16384) + 64 * isctx; }
__device__ __forceinline__ unsigned* stage_counter(const Params& p, int flag) { return (unsigned*)(p.ws + WS_BAR + 16384) + 512 + 512 * flag; }
__device__ __forceinline__ void stage_signal(const Params& p, char* smem, int flag, int l) {
#ifdef EMU
    __syncthreads(); if (otid() == 0) *stage_counter(p, flag) += 1u;
#else
    asm volatile("s_waitcnt vmcnt(0)" ::: "memory"); __syncthreads();
    if (threadIdx.x == 0) {
        const unsigned xcc = (unsigned)__builtin_amdgcn_s_getreg((3 << 11) | 20) & 0xFu, nloc = ((volatile __attribute__((address_space(3))) unsigned*)(smem + LDS_BYTES - 64))[0];
        unsigned* g = stage_counter(p, flag);
        if (nloc > 0u) { const unsigned old = __hip_atomic_fetch_add(g + 16 * (1 + xcc), 1u, __ATOMIC_RELAXED, __HIP_MEMORY_SCOPE_AGENT);
            if (old + 1u == nloc * (unsigned)(l + 1)) { __builtin_amdgcn_fence(__ATOMIC_RELEASE, "agent"); asm volatile("s_waitcnt vmcnt(0)" ::: "memory");
                __hip_atomic_fetch_add(g, nloc, __ATOMIC_RELAXED, __HIP_MEMORY_SCOPE_AGENT); } }
        else { __builtin_amdgcn_fence(__ATOMIC_RELEASE, "agent"); asm volatile("s_waitcnt vmcnt(0)" ::: "memory"); __hip_atomic_fetch_add(g, 1u, __ATOMIC_RELAXED, __HIP_MEMORY_SCOPE_AGENT); }
    }
#endif
}
__device__ __forceinline__ void stage_wait(const Params& p, int flag, int l) {
    if (otid() == 0) { const unsigned target = (unsigned)gridDim.x * (unsigned)(l + 1);
#ifdef EMU
        while (*(volatile unsigned*)stage_counter(p, flag) < target) emu::yield();
#else
        unsigned spins = 0;
        while (__hip_atomic_load(stage_counter(p, flag), __ATOMIC_RELAXED, __HIP_MEMORY_SCOPE_AGENT) < target) { __builtin_amdgcn_s_sleep(16); if (++spins > (1u << 20)) break; }
        __builtin_amdgcn_fence(__ATOMIC_ACQUIRE, "agent"); asm volatile("s_waitcnt vmcnt(0)" ::: "memory");
#endif
    }
    __syncthreads();
}
__device__ __forceinline__ int logical_row(int i) { return i < NB * SEQ ? (i / SEQ) * TOK + CTXL + i % SEQ : ((i - NB * SEQ) / CTXL) * TOK + (i - NB * SEQ) % CTXL; }
struct RowRef { const float* xo; float* xn; int mj, row; bool ok; };
__device__ __forceinline__ RowRef rp_ref(const Params& p, int l, int li, int base, int hi) {
    RowRef r; r.ok = li < hi; const int rr = logical_row(r.ok ? li : base); r.row = rr;
    const int b = rr / TOK, pp = rr % TOK; const bool isctx = pp < CTXL; if (l == DEPTH && isctx) r.ok = false;
    const size_t off = isctx ? ((size_t)b * CTXL + pp) * DM : ((size_t)b * SEQ + (pp - CTXL)) * DM;
    float* CTXB = (float*)(p.ws + WS_CTXB);
    r.xo = (l <= 1) ? (isctx ? p.in[I_CTX] + off : p.in[I_X] + off) : (isctx ? CTXB + off : p.out + off);
    r.xn = isctx ? CTXB + off : p.out + off; r.mj = isctx ? NB : b; return r;
}
__device__ __forceinline__ void rp_rows(const Params& p, int l, int lo, int hi, int gi, int nb) {
    const int tid = otid(), lane = tid & 63, wave = tid >> 6;
    const float* MOD = (const float*)(p.ws + WS_MOD);
    const bf16* YO = (const bf16*)(p.ws + WS_P);
    bf16* HN = (bf16*)(p.ws + WS_HNY);
    constexpr int NV4 = DM / 256, RW = 2;
    const int stride = nb * 8;
    f32x4 xq[RW][NV4]; u32x2 yq[RW][NV4]; RowRef rq[RW];
    int base = lo + gi * 8 + wave;
    if (base < hi) {
#pragma unroll
        for (int i = 0; i < RW; ++i) { rq[i] = rp_ref(p, l, base + i * stride, base, hi);
#pragma unroll
            for (int j = 0; j < NV4; ++j) { xq[i][j] = *(const f32x4*)(rq[i].xo + 4 * lane + 256 * j); yq[i][j] = (l > 0) ? *(const u32x2*)(YO + (size_t)rq[i].row * DM + 4 * lane + 256 * j) : (u32x2){0u, 0u}; } }
    }
    for (; base < hi; base += stride * RW) {
        f32x4 x[RW][NV4], y[RW][NV4]; RowRef rc[RW];
#pragma unroll
        for (int i = 0; i < RW; ++i) { rc[i] = rq[i];
#pragma unroll
            for (int j = 0; j < NV4; ++j) { x[i][j] = xq[i][j]; const u32x2 yy = yq[i][j]; y[i][j] = (f32x4){bitsf(yy.x << 16), bitsf(yy.x & 0xffff0000u), bitsf(yy.y << 16), bitsf(yy.y & 0xffff0000u)}; } }
        { const int nbase = base + stride * RW;
            if (nbase < hi) {
#pragma unroll
                for (int i = 0; i < RW; ++i) { rq[i] = rp_ref(p, l, nbase + i * stride, nbase, hi);
#pragma unroll
                    for (int j = 0; j < NV4; ++j) { xq[i][j] = *(const f32x4*)(rq[i].xo + 4 * lane + 256 * j); if (l > 0) yq[i][j] = *(const u32x2*)(YO + (size_t)rq[i].row * DM + 4 * lane + 256 * j); } } } }
        if (l > 0) {
            float ss[RW];
#pragma unroll
            for (int i = 0; i < RW; ++i) { ss[i] = 0.f;
#pragma unroll
                for (int j = 0; j < NV4; ++j) ss[i] += y[i][j].x * y[i][j].x + y[i][j].y * y[i][j].y + y[i][j].z * y[i][j].z + y[i][j].w * y[i][j].w; }
#pragma unroll
            for (int i = 0; i < RW; ++i) ss[i] = wave_sum(ss[i]);
            const float* gp = p.in[I_GPOST] + (size_t)(l - 1) * DM;
            float rstd[RW]; const float* gt[RW];
#pragma unroll
            for (int i = 0; i < RW; ++i) { rstd[i] = rsqrtf(ss[i] * (1.0f / DM) + EPS); gt[i] = MOD + ((size_t)(l - 1) * NJ + rc[i].mj) * 3 * DM + 2 * DM; }
            f32x4 p4n = *(const f32x4*)(gp + 4 * lane), g4n[RW];
#pragma unroll
            for (int i = 0; i < RW; ++i) g4n[i] = *(const f32x4*)(gt[i] + 4 * lane);
#pragma unroll
            for (int j = 0; j < NV4; ++j) { const f32x4 p4 = p4n; f32x4 g4[RW];
#pragma unroll
                for (int i = 0; i < RW; ++i) g4[i] = g4n[i];
                if (j + 1 < NV4) { p4n = *(const f32x4*)(gp + 4 * lane + 256 * (j + 1));
#pragma unroll
                    for (int i = 0; i < RW; ++i) g4n[i] = *(const f32x4*)(gt[i] + 4 * lane + 256 * (j + 1)); }
#pragma unroll
                for (int i = 0; i < RW; ++i) { x[i][j] = x[i][j] + g4[i] * (y[i][j] * rstd[i] * p4);
                    if (rc[i].ok) *(f32x4*)(rc[i].xn + 4 * lane + 256 * j) = x[i][j]; } }
        }
        if (l < DEPTH) {
            float ss[RW];
#pragma unroll
            for (int i = 0; i < RW; ++i) { ss[i] = 0.f;
#pragma unroll
                for (int j = 0; j < NV4; ++j) ss[i] += x[i][j].x * x[i][j].x + x[i][j].y * x[i][j].y + x[i][j].z * x[i][j].z + x[i][j].w * x[i][j].w; }
#pragma unroll
            for (int i = 0; i < RW; ++i) ss[i] = wave_sum(ss[i]);
            const float* gp = p.in[I_GPRE] + (size_t)l * DM;
            float rstd[RW]; const float* md[RW];
#pragma unroll
            for (int i = 0; i < RW; ++i) { rstd[i] = rsqrtf(ss[i] * (1.0f / DM) + EPS); md[i] = MOD + ((size_t)l * NJ + rc[i].mj) * 3 * DM; }
            f32x4 g4n = *(const f32x4*)(gp + 4 * lane), shn[RW], scn[RW];
#pragma unroll
            for (int i = 0; i < RW; ++i) { shn[i] = *(const f32x4*)(md[i] + 4 * lane); scn[i] = *(const f32x4*)(md[i] + DM + 4 * lane); }
#pragma unroll
            for (int j = 0; j < NV4; ++j) { const int e = 4 * lane + 256 * j; const f32x4 g4 = g4n; f32x4 sh[RW], sc[RW];
#pragma unroll
                for (int i = 0; i < RW; ++i) { sh[i] = shn[i]; sc[i] = scn[i]; }
                if (j + 1 < NV4) { g4n = *(const f32x4*)(gp + e + 256);
#pragma unroll
                    for (int i = 0; i < RW; ++i) { shn[i] = *(const f32x4*)(md[i] + e + 256); scn[i] = *(const f32x4*)(md[i] + DM + e + 256); } }
#pragma unroll
                for (int i = 0; i < RW; ++i) { const f32x4 h = (x[i][j] * rstd[i] * g4) * (sc[i] + 1.0f) + sh[i];
                    u32x2 o; o.x = pk2(h.x, h.y); o.y = pk2(h.z, h.w);
                    if (rc[i].ok) *(u32x2*)(HN + (size_t)rc[i].row * DM + e) = o; } }
        }
    }
}

__device__ __forceinline__ void convert_tile(const float* src, int ldn, bf16* dst, int K, int n0, int k0, bool use_map, char* smem) {
    const int tid = otid();
    float* tile = (float*)smem;
    __syncthreads();
#pragma unroll
    for (int i = 0; i < 8; ++i) { const int idx = tid + NT * i, k = idx >> 6, n = idx & 63;
        const int oc = use_map ? orig_col(n0 + n) : (n0 + n);
        tile[k * 65 + n] = oc >= 0 ? src[(size_t)(k0 + k) * ldn + oc] : 0.f; }
    __syncthreads();
    const int n = tid >> 3, c = tid & 7;
    u32x4 o; o.x = pk2(tile[(8 * c + 0) * 65 + n], tile[(8 * c + 1) * 65 + n]); o.y = pk2(tile[(8 * c + 2) * 65 + n], tile[(8 * c + 3) * 65 + n]);
    o.z = pk2(tile[(8 * c + 4) * 65 + n], tile[(8 * c + 5) * 65 + n]); o.w = pk2(tile[(8 * c + 6) * 65 + n], tile[(8 * c + 7) * 65 + n]);
    *(u32x4*)(dst + (size_t)(n0 + n) * K + k0 + 8 * c) = o;
}

__device__ __forceinline__ void filter_task(const Params& p, int l, int L, int pos0, char* smem) {
    const int tid = otid(), j = tid & 63;
    float* z = (float*)smem;
    float* h1 = z + 8 * 33;
    float* h2 = h1 + 8 * 64;
    const float* w1 = p.in[I_HW1] + (size_t)l * 33 * 64; const float* w2 = p.in[I_HW2] + (size_t)l * 64 * 64; const float* w3 = p.in[I_HW3] + (size_t)l * 64 * 512;
    float r1[33], r2[64], r3a[16];
#pragma unroll
    for (int i = 0; i < 33; ++i) r1[i] = w1[i * 64 + j];
#pragma unroll
    for (int i = 0; i < 64; ++i) r2[i] = w2[i * 64 + j];
    const float b1 = p.in[I_HB1][l * 64 + j], b2 = p.in[I_HB2][l * 64 + j], b3 = p.in[I_HB3][l * 512 + tid];
    const float f0 = p.in[I_HFREQ][(l * 2 + 0) * 64 + j], f1 = p.in[I_HFREQ][(l * 2 + 1) * 64 + j];
    __syncthreads();
    if (tid < 8 * 33) { const int pp = tid / 33, i = tid % 33; const float pos = (float)(pos0 + pp);
        const float t = pos / (float)(L - 1 > 1 ? L - 1 : 1), wv = 6.283185307179586f * pos / (float)L; float v;
        if (i == 0) v = t; else { const int bi = (i - 1) & 15; const float f = 1e-4f + (float)bi * ((15.0f - 1e-4f) / 15.0f); v = (i <= 16) ? cosf(wv * f) : -sinf(wv * f); }
        z[tid] = v; }
    __syncthreads();
    { const int pp = tid >> 6; float a = b1;
#pragma unroll
        for (int i = 0; i < 33; ++i) a += z[pp * 33 + i] * r1[i];
        h1[tid] = sinf(f0 * a);
#pragma unroll
        for (int i = 0; i < 16; ++i) r3a[i] = w3[i * 512 + tid]; }
    __syncthreads();
    { const int pp = tid >> 6; float a = b2;
#pragma unroll
        for (int i = 0; i < 64; ++i) a += h1[pp * 64 + i] * r2[i];
        h2[tid] = sinf(f1 * a); }
    __syncthreads();
    { const int o = tid, dir = o >> 8, c = o & 255;
        const float delta = 3.0701134573253946f + (float)c * ((15.350567286626973f - 3.0701134573253946f) / 255.0f);
        float acc[8];
#pragma unroll
        for (int pp = 0; pp < 8; ++pp) acc[pp] = b3;
#pragma unroll 1
        for (int cix = 0; cix < 4; ++cix) {
            float wn[16];
#pragma unroll
            for (int i = 0; i < 16; ++i) wn[i] = (cix < 3) ? w3[(16 * (cix + 1) + i) * 512 + o] : 0.f;
#pragma unroll
            for (int i = 0; i < 16; ++i) {
#pragma unroll
                for (int pp = 0; pp < 8; ++pp) acc[pp] += h2[pp * 64 + 16 * cix + i] * r3a[i]; }
#pragma unroll
            for (int i = 0; i < 16; ++i) r3a[i] = wn[i]; }
        float* KT = (float*)(p.ws + WS_KT); float* HC = (float*)(p.ws + WS_HC);
#pragma unroll
        for (int pp = 0; pp < 8; ++pp) { const int pos = pos0 + pp; const float t = (float)pos / (float)(L - 1 > 1 ? L - 1 : 1);
            const float v = acc[pp] * __expf(-t * delta);
            if (L == SEQ) { if (dir == 0) KT[(size_t)c * NF + pos]= v; else if (pos > 0) KT[(size_t)c * NF + (NF - pos)] = v; else KT[(size_t)c * NF + SEQ] = 0.f; }
            else HC[((size_t)dir * WG + c) * CTXL + pos] = v; }
    }
}

__device__ __forceinline__ void convert_tile_w(const float* src, int ldn, bf16* dst, int K, int n0, int k0, bool use_map, char* wl, int lane) {
    float* tile = (float*)wl;
    const int oc = use_map ? orig_col(n0 + lane) : (n0 + lane);
    float v[64];
#pragma unroll
    for (int k = 0; k < 64; ++k) v[k] = oc >= 0 ? src[(size_t)(k0 + k) * ldn + oc] : 0.f;
#pragma unroll
    for (int k = 0; k < 64; ++k) tile[k * 65 + lane] = v[k];
    WAVE_SYNC();
#pragma unroll
    for (int i = 0; i < 8; ++i) { const int n = (lane >> 3) + 8 * i, c = lane & 7; float f[8];
#pragma unroll
        for (int j = 0; j < 8; ++j) f[j] = tile[(8 * c + j) * 65 + n];
        *(u32x4*)(dst + (size_t)(n0 + n) * K + k0 + 8 * c) = pack8(f); }
    WAVE_SYNC();
}
__device__ __forceinline__ void layer_prep(const Params& p, int l, int idx, int stride, char* smem) {
    constexpr int N_WIN = (NPAD / 64) * (DM / 64), N_FL = SEQ / 8, N_FC = CTXL / 8;
    for (int task = idx; task < N_FL + N_FC; task += stride) {
        if (task < N_FL) filter_task(p, l, SEQ, task * 8, smem);
        else filter_task(p, l, CTXL, (task - N_FL) * 8, smem);
    }
    __syncthreads();
    { const int tid = otid(), lane = tid & 63, wave = __builtin_amdgcn_readfirstlane(tid >> 6);
        char* wl = smem + wave * WLDS;
        for (int task = wave * stride + idx; task < N_WIN; task += 8 * stride) { const int nt = task / (DM / 64), kt = task % (DM / 64);
            convert_tile_w(p.in[I_WIN] + (size_t)l * DM * N_IN, N_IN, (bf16*)(p.ws + WS_WIN), DM, nt * 64, kt * 64, true, wl, lane); } }
}
__device__ __forceinline__ unsigned* row_queue(const Params& p, int l) { return (unsigned*)(p.ws + WS_BAR + 16384) + 2560 + 64 * l; }
__device__ __forceinline__ void wait_units(const Params& p, int c, int l) {
    constexpr int nLatU = NB * (SEQ / PANEL_ROWS) * PANEL_UNITS, nCtxU = NB * (CTXL / PANEL_ROWS) * PANEL_UNITS;
    const unsigned target = (unsigned)((c ? nCtxU : nLatU) * l);
#ifdef EMU
    while (*(volatile unsigned*)unit_counter(p, c) < target) emu::yield();
#else
    unsigned spins = 0;
    while (__hip_atomic_load(unit_counter(p, c), __ATOMIC_RELAXED, __HIP_MEMORY_SCOPE_AGENT) < target) { __builtin_amdgcn_s_sleep(16); if (++spins > (1u << 20)) break; }
    __builtin_amdgcn_fence(__ATOMIC_ACQUIRE, "agent"); asm volatile("s_waitcnt vmcnt(0)" ::: "memory");
#endif
}
__device__ __forceinline__ void phase_rp(const Params& p, int l, char* smem) { const int G = (int)gridDim.x, bid = obid(), tid = otid();
    const bool has_ctx = l < DEPTH;
    constexpr int nLatU = NB * (SEQ / PANEL_ROWS) * PANEL_UNITS, nCtxU = NB * (CTXL / PANEL_ROWS) * PANEL_UNITS;
    const int nU = nLatU + nCtxU;
    const int heavy = (l >= 1 && has_ctx && nU > G && (nU % G) != 0) ? nU % G : 0;
    const int total = heavy > 0 ? NB * SEQ : (has_ctx ? T : NB * SEQ);
    const int nl = G - heavy, np = (l < DEPTH) ? nl / 2 : 0, nr = nl - np;
    int lo, hi, gi, nb; bool prep = false;
    if (bid < heavy) { lo = NB * SEQ; hi = T; gi = bid; nb = heavy; }
    else { const int i = bid - heavy; int nR = total;
        if (np > 0) { nR = ((total * 2 / 3) / (nr * 16)) * (nr * 16); if (nR <= 0) nR = total / 2; }
        if (np > 0 && (i & 1) && i / 2 < np) { prep = true; lo = nR; hi = total; gi = i / 2; nb = np; }
        else { lo = 0; hi = nR; gi = (np > 0) ? (i + 1) / 2 : i; nb = nr; } }
    if (prep) layer_prep(p, l, gi, np, smem);
    else if (l < DEPTH && np == 0) layer_prep(p, l, bid, G, smem);
    if (l >= 1) { if (tid == 0) { if (lo < NB * SEQ) wait_units(p, 0, l); if (hi > NB * SEQ) wait_units(p, 1, l); } __syncthreads(); }
    rp_rows(p, l, lo, hi, gi, nb);
}

__device__ __forceinline__ cpx cmul(cpx a, cpx b) { cpx r; r.x = a.x * b.x - a.y * b.y; r.y = a.x * b.y + a.y * b.x; return r; }
__device__ __forceinline__ cpx cmulc(cpx a, cpx b) { cpx r; r.x = a.x * b.x + a.y * b.y; r.y = a.y * b.x - a.x * b.y; return r; }
constexpr int fpad(int i) { return i + (i >> 4); }
__device__ __forceinline__ int FPH(int i) { return i + (i >> 4); }
constexpr int FBUF = fpad(NF);
constexpr int ilog16(int n) { return n < 16 ? 0 : 1 + ilog16(n / 16); }
constexpr int FFT_P16 = ilog16(NF);
constexpr bool FFT_R4 = ((NF >> (4 * FFT_P16)) == 4);
static_assert((NF >> (4 * FFT_P16)) == 1 || (NF >> (4 * FFT_P16)) == 4, "NF = 16^a * (1 or 4)");
template <bool INV> __device__ __forceinline__ void dft4(cpx& a0, cpx& a1, cpx& a2, cpx& a3) {
    const cpx s = {a0.x + a2.x, a0.y + a2.y}, b = {a0.x - a2.x, a0.y - a2.y}, c = {a1.x + a3.x, a1.y + a3.y}, d = {a1.x - a3.x, a1.y - a3.y};
    a0 = (cpx){s.x + c.x, s.y + c.y}; a2 = (cpx){s.x - c.x, s.y - c.y};
    if (!INV) { a1 = (cpx){b.x + d.y, b.y - d.x}; a3 = (cpx){b.x - d.y, b.y + d.x}; }
    else      { a1 = (cpx){b.x - d.y, b.y + d.x}; a3 = (cpx){b.x + d.y, b.y - d.x}; }
}
template <bool INV> __device__ __forceinline__ cpx cmulk(cpx a, float wr, float wi) {
    cpx r; if (!INV) { r.x = a.x * wr + a.y * wi; r.y = a.y * wr - a.x * wi; } else { r.x = a.x * wr - a.y * wi; r.y = a.y * wr + a.x * wi; } return r;
}
template <bool INV> __device__ __forceinline__ void dft16(cpx (&x)[16]) {
    constexpr float C1 = 0.92387953251128674f, S1 = 0.38268343236508977f, C2 = 0.70710678118654752f;
#pragma unroll
    for (int n2 = 0; n2 < 4; ++n2) dft4<INV>(x[n2], x[4 + n2], x[8 + n2], x[12 + n2]);
    x[4 * 1 + 1] = cmulk<INV>(x[4 * 1 + 1], C1, S1); x[4 * 1 + 2] = cmulk<INV>(x[4 * 1 + 2], C2, C2); x[4 * 1 + 3] = cmulk<INV>(x[4 * 1 + 3], S1, C1);
    x[4 * 2 + 1] = cmulk<INV>(x[4 * 2 + 1], C2, C2); x[4 * 2 + 2] = cmulk<INV>(x[4 * 2 + 2], 0.f, 1.f); x[4 * 2 + 3] = cmulk<INV>(x[4 * 2 + 3], -C2, C2);
    x[4 * 3 + 1] = cmulk<INV>(x[4 * 3 + 1], S1, C1); x[4 * 3 + 2] = cmulk<INV>(x[4 * 3 + 2], -C2, C2); x[4 * 3 + 3] = cmulk<INV>(x[4 * 3 + 3], -C1, -S1);
#pragma unroll
    for (int k1 = 0; k1 < 4; ++k1) dft4<INV>(x[4 * k1 + 0], x[4 * k1 + 1], x[4 * k1 + 2], x[4 * k1 + 3]);
    cpx t;
    t = x[1]; x[1] = x[4]; x[4] = t; t = x[2]; x[2] = x[8]; x[8] = t; t = x[3]; x[3] = x[12]; x[12] = t;
    t = x[6]; x[6] = x[9]; x[9] = t; t = x[7]; x[7] = x[13]; x[13] = t; t = x[11]; x[11] = x[14]; x[14] = t;
}
template <bool INV> __device__ __forceinline__ void fft_stage16(cpx* buf, const cpx* TW, int tl, int M) {
    const int span = M >> 4, twm = NF / M;
#pragma unroll 1
    for (int j = tl; j < NF / 16; j += 256) {
        const int grp = j / span, pos = j % span, base = grp * M + pos; cpx x[16];
#pragma unroll
        for (int q = 0; q < 16; ++q) x[q] = buf[FPH(base + q * span)];
        cpx w1 = {1.f, 0.f}; if (span > 1) w1 = TW[pos * twm];
        if (INV && span > 1) { cpx wk = w1;
#pragma unroll
            for (int k = 1; k < 16; ++k) { x[k] = cmulc(x[k], wk); wk = cmul(wk, w1); } }
        dft16<INV>(x);
        if (!INV && span > 1) { cpx wk = w1;
#pragma unroll
            for (int k = 1; k < 16; ++k) { x[k] = cmul(x[k], wk); wk = cmul(wk, w1); } }
#pragma unroll
        for (int q = 0; q < 16; ++q) buf[FPH(base + q * span)] = x[q];
    }
}
template <bool INV> __device__ __forceinline__ void fft_stage4_last(cpx* buf, int tl) {
#pragma unroll 1
    for (int j = tl; j < NF / 4; j += 256) { cpx a0 = buf[FPH(4 * j)], a1 = buf[FPH(4 * j + 1)], a2 = buf[FPH(4 * j + 2)], a3 = buf[FPH(4 * j + 3)];
        dft4<INV>(a0, a1, a2, a3); buf[FPH(4 * j)] = a0; buf[FPH(4 * j + 1)] = a1; buf[FPH(4 * j + 2)] = a2; buf[FPH(4 * j + 3)] = a3; }
}
__device__ __forceinline__ void fft_fwd(cpx* buf, const cpx* TW, int tl) {
    int M = NF;
#pragma unroll
    for (int s = 0; s < FFT_P16; ++s) { __syncthreads(); fft_stage16<false>(buf, TW, tl, M); M >>= 4; }
    if (FFT_R4) { __syncthreads(); fft_stage4_last<false>(buf, tl); }
    __syncthreads();
}
__device__ __forceinline__ void fft_inv(cpx* buf, const cpx* TW, int tl) {
    if (FFT_R4) { __syncthreads(); fft_stage4_last<true>(buf, tl); }
    int M = FFT_R4 ? 64 : 16;
#pragma unroll
    for (int s = 0; s < FFT_P16; ++s) { __syncthreads(); fft_stage16<true>(buf, TW, tl, M); M <<= 4; }
    __syncthreads();
}
__device__ __forceinline__ void filt_fft_task(const Params& p, int cp, char* smem) {
    const int tid = otid(), half = tid >> 8, tl = tid & 255, c = 2 * cp + half;
    cpx* buf = (cpx*)smem + (size_t)half * FBUF;
    const float* KT = (const float*)(p.ws + WS_KT) + (size_t)c * NF;
    cpx* KF = (cpx*)(p.ws + WS_KF) + (size_t)c * NF;
    const cpx* TW = (const cpx*)(p.ws + WS_TW);
    __syncthreads();
    for (int i = tl; i < NF; i += 256) { cpx v; v.x = KT[i]; v.y = 0.f; buf[FPH(i)] = v; }
    fft_fwd(buf, TW, tl);
    for (int i = tl; i < NF; i += 256) KF[i] = buf[FPH(i)];
}

__device__ __forceinline__ void gemm_tile(const Params& p, const bf16* A, const bf16* Bt, int K, int mt, int nt, int mode, char* smem) {
    const int tid = otid(), lane = tid & 63, wave = tid >> 6;
    bf16* As = (bf16*)smem;
    bf16* Bs = As + 128 * LS;
    const int wm = (wave & 3) * 32, wn = (wave >> 2) * 64;
    f32x4 acc[2][4];
#pragma unroll
    for (int i = 0; i < 2; ++i)
#pragma unroll
        for (int j = 0; j < 4; ++j) acc[i][j] = (f32x4){0.f, 0.f, 0.f, 0.f};
    const int lr = tid >> 3, lc = tid & 7;
    const bf16* Ag = A + (size_t)(mt * 128 + lr) * K + lc * 8;
    const bf16* Bg = Bt + (size_t)(nt * 128 + lr) * K + lc * 8;
    u32x4 ra0, ra1, rb0, rb1;
    ra0 = *(const u32x4*)(Ag); ra1 = *(const u32x4*)(Ag + (size_t)64 * K); rb0 = *(const u32x4*)(Bg); rb1 = *(const u32x4*)(Bg + (size_t)64 * K);
    const int nk = K / 64;
    for (int kt = 0; kt < nk; ++kt) {
        __syncthreads();
        *(u32x4*)(As + lr * LS + lc * 8) = ra0; *(u32x4*)(As + (lr + 64) * LS + lc * 8) = ra1;
        *(u32x4*)(Bs + lr * LS + lc * 8) = rb0; *(u32x4*)(Bs + (lr + 64) * LS + lc * 8) = rb1;
        __syncthreads();
        if (kt + 1 < nk) { const int ko = (kt + 1) * 64;
            ra0 = *(const u32x4*)(Ag + ko); ra1 = *(const u32x4*)(Ag + (size_t)64 * K + ko); rb0 = *(const u32x4*)(Bg + ko); rb1 = *(const u32x4*)(Bg + (size_t)64 * K + ko); }
        mma_nt<4, 2>(As, LS, wm, Bs, LS, wn, acc[0], lane);
        mma_nt<4, 2>(As, LS, wm + 16, Bs, LS, wn, acc[1], lane);
    }
    const int r = lane & 15, q = lane >> 4;
#pragma unroll
    for (int i = 0; i < 2; ++i)
#pragma unroll
        for (int j = 0; j < 4; ++j)
#pragma unroll
            for (int e = 0; e < 4; ++e) {
                const int row = mt * 128 + wm + 16 * i + 4 * q + e, col = nt * 128 + wn + 16 * j + r; const float v = acc[i][j][e];
                if (mode == 0) { if (col < NP) ((bf16*)(p.ws + WS_P))[(size_t)row * NP + col] = f2bf(v); else if (col < NP + 16) ((float*)(p.ws + WS_G))[(size_t)row * NGS + (col - NP)] = v; else if (col < NP + NG) ((bf16*)((float*)(p.ws + WS_G) + (size_t)row * NGS + 16))[col - NP - 16] = f2bf(v); }
                else if (mode == 2) ((bf16*)(p.ws + WS_HT))[(size_t)row * T + col] = f2bf(v);
                else ((bf16*)(p.ws + WS_P))[(size_t)row * DM + col] = f2bf(v);
            }
}

#ifndef EMU
namespace pg8 {
#define PG8_LAS __attribute__((address_space(3)))
typedef unsigned short bf16_t;
typedef short bf16x8 __attribute__((ext_vector_type(8)));
typedef float f32x4 __attribute__((ext_vector_type(4)));
typedef unsigned u32x4 __attribute__((ext_vector_type(4)));
constexpr int BM = 256, BK = 64, HALF = 128, HTB = HALF * BK * 2  , STAGE_BYTES = 8 * HTB, NXCD = 8, WGM = 8;

__host__ __device__ __forceinline__ int lds_byte(int r, int c) { const int st = (r >> 4) * 2 + (c >> 5), rr = r & 15, cc = c & 31, ob = rr * 64 + cc * 2; return st * 1024 + (ob ^ (((ob >> 9) & 1) << 5)); }
__host__ __device__ __forceinline__ void stage_rc(int b, int& R, int& C) { const int st = b / 1024, sb = b % 1024, swz = sb ^ (((sb >> 9) & 1) << 5); R = (st >> 1) * 16 + swz / 64; C = (st & 1) * 32 + (swz % 64) / 2; }
__host__ __device__ __forceinline__ int perm32(int rho) { const int n = rho >> 4, i = rho & 15; return 8 * (i >> 2) + 4 * n + (i & 3); }

struct Unit { int pm, pn; };
struct Gemm { const bf16_t* A; const bf16_t* Bt; int M, N, K; };
__device__ __forceinline__ unsigned cvt_pk_bf16(float lo, float hi) { unsigned r; asm volatile("v_cvt_pk_bf16_f32 %0, %1, %2" : "=v"(r) : "v"(lo), "v"(hi)); return r; }
template <class Epi, class Sched, bool ALIGN_EPI = false, bool SP2 = false>
__device__ __forceinline__ void gemm_phase(PG8_LAS unsigned char* lds, const Gemm g, const Sched& S, const Epi& E) {
    const int tid = otid(), wid = __builtin_amdgcn_readfirstlane(tid >> 6), lane = tid & 63, wr = wid >> 2, wc = wid & 3, fr = lane & 15, fq = lane >> 4;
    const int K = g.K, nt = K / BK;
    unsigned voffA[2], voffB[2];
#pragma unroll
    for (int i = 0; i < 2; ++i) { int R, C; stage_rc(tid * 16 + i * 8192, R, C); const int Rb = Epi::PERM ? ((R & ~31) + perm32(R & 31)) : R;
        voffA[i] = (unsigned)(R * K + C) * 2u; voffB[i] = (unsigned)(Rb * K + C) * 2u; }
    const size_t kstep = (size_t)(BK * 2);
    const size_t hstep = (size_t)HALF * K * 2;
    const size_t tstep = 2 * hstep;
    const unsigned ldsw = (unsigned)wid * 1024u;
    const int aoff = lds_byte(wr * 64 + fr, fq * 8), boff = lds_byte(wc * 32 + fr, fq * 8);
#define PG8_SA(b, h) (((b) * 2 + (h)) * HTB)
#define PG8_SB(b, h) ((4 + (b) * 2 + (h)) * HTB)
#define PG8_STAGE(bufoff, gbase, voff) do { _Pragma("unroll") for (int _i = 0; _i < 2; ++_i) \
        __builtin_amdgcn_global_load_lds((const unsigned*)((const char*)(gbase) + (voff)[_i]), (PG8_LAS unsigned*)(lds + (bufoff) + ldsw + _i * 8192), 16, 0, 0); } while (0)
#define PG8_LDA(dst, b, h) do { _Pragma("unroll") for (int m = 0; m < 4; ++m) _Pragma("unroll") for (int k = 0; k < 2; ++k) dst[m][k] = *(const PG8_LAS bf16x8*)(lds + PG8_SA(b, h) + aoff + m * 2048 + k * 1024); } while (0)
#define PG8_LDB(dst, b, h) do { _Pragma("unroll") for (int n = 0; n < 2; ++n) _Pragma("unroll") for (int k = 0; k < 2; ++k) dst[n][k] = *(const PG8_LAS bf16x8*)(lds + PG8_SB(b, h) + boff + n * 2048 + k * 1024); } while (0)
#define PG8_MMA(ai, bj, At, Bt) do { __builtin_amdgcn_s_setprio(1); _Pragma("unroll") for (int m = 0; m < 4; ++m) _Pragma("unroll") for (int n = 0; n < 2; ++n) _Pragma("unroll") for (int k = 0; k < 2; ++k) \
        acc[ai][bj][m][n] = __builtin_amdgcn_mfma_f32_16x16x32_bf16(Bt[n][k], At[m][k], acc[ai][bj][m][n], 0, 0, 0); __builtin_amdgcn_s_setprio(0); } while (0)
#define PG8_WAIT_V(n) asm volatile("s_waitcnt vmcnt(" #n ")" ::: "memory")
#define PG8_WAIT_L(n) asm volatile("s_waitcnt lgkmcnt(" #n ")" ::: "memory")
#define PG8_BAR __builtin_amdgcn_s_barrier()
#define PG8_SCHED __builtin_amdgcn_sched_barrier(0)
    Unit cur, nxt; int ui = 0;
    if (!S.next(0, cur)) return;
    f32x4 acc[2][2][4][2];
#pragma unroll
    for (int a = 0; a < 2; ++a)
#pragma unroll
        for (int b = 0; b < 2; ++b)
#pragma unroll
            for (int m = 0; m < 4; ++m)
#pragma unroll
                for (int n = 0; n < 2; ++n) acc[a][b][m][n] = (f32x4){0.f, 0.f, 0.f, 0.f};
    bf16x8 At[4][2], B0[2][2], B1[2][2];
    const char* cA = (const char*)g.A + (size_t)cur.pm * tstep; const char* cB = (const char*)g.Bt + (size_t)cur.pn * tstep;
    S.a_ready(cur);
    if constexpr (SP2) {
        PG8_STAGE(PG8_SB(0, 0), cB, voffB); PG8_STAGE(PG8_SB(0, 1), cB + hstep, voffB); PG8_STAGE(PG8_SA(0, 0), cA, voffA); PG8_STAGE(PG8_SA(0, 1), cA + hstep, voffA);
        if (wr == 1) PG8_BAR;
        PG8_WAIT_V(2); PG8_BAR;
        PG8_STAGE(PG8_SB(1, 0), cB + kstep, voffB); PG8_STAGE(PG8_SA(1, 0), cA + kstep, voffA); PG8_STAGE(PG8_SB(1, 1), cB + hstep + kstep, voffB);
        PG8_WAIT_V(6); PG8_BAR;
    } else {
        PG8_STAGE(PG8_SB(0, 0), cB, voffB); PG8_STAGE(PG8_SA(0, 0), cA, voffA); PG8_STAGE(PG8_SB(0, 1), cB + hstep, voffB); PG8_STAGE(PG8_SA(0, 1), cA + hstep, voffA);
        if (wr == 1) PG8_BAR;
        PG8_WAIT_V(4); PG8_BAR;
        PG8_STAGE(PG8_SB(1, 0), cB + kstep, voffB); PG8_STAGE(PG8_SA(1, 0), cA + kstep, voffA); PG8_STAGE(PG8_SB(1, 1), cB + hstep + kstep, voffB);
        PG8_WAIT_V(6); PG8_BAR;
    }
    for (;;) {
        const bool has_next = S.next(ui + 1, nxt);
        const char* nA = has_next ? (const char*)g.A + (size_t)nxt.pm * tstep : cA; const char* nB = has_next ? (const char*)g.Bt + (size_t)nxt.pn * tstep : cB;
        for (int t = 0; t < nt; t += 2) {
            const bool last = (t == nt - 2);
            const char* a1 = cA + (size_t)(t + 1) * kstep;
            const char* a2 = last ? nA : cA + (size_t)(t + 2) * kstep; const char* b2 = last ? nB : cB + (size_t)(t + 2) * kstep;
            const char* a3 = a2 + kstep; const char* b3 = b2 + kstep;
            if (last && has_next) S.a_ready(nxt);
            if constexpr (SP2) {
            PG8_LDB(B0, 0, 0); PG8_LDB(B1, 0, 1); PG8_SCHED; PG8_LDA(At, 0, 0); PG8_STAGE(PG8_SA(1, 1), a1 + hstep, voffA);
            PG8_WAIT_V(8); PG8_WAIT_L(0); PG8_BAR; PG8_MMA(0, 0, At, B0); PG8_MMA(0, 1, At, B1); PG8_BAR; PG8_SCHED;
            PG8_LDA(At, 0, 1); PG8_STAGE(PG8_SB(0, 0), b2, voffB); PG8_STAGE(PG8_SB(0, 1), b2 + hstep, voffB); PG8_STAGE(PG8_SA(0, 0), a2, voffA);
            PG8_WAIT_V(8); PG8_WAIT_L(0); PG8_BAR; PG8_MMA(1, 0, At, B0); PG8_MMA(1, 1, At, B1); PG8_BAR; PG8_SCHED;
            PG8_LDB(B0, 1, 0); PG8_LDB(B1, 1, 1); PG8_SCHED; PG8_LDA(At, 1, 0); PG8_STAGE(PG8_SA(0, 1), a2 + hstep, voffA);
            PG8_WAIT_V(8); PG8_WAIT_L(0); PG8_BAR; PG8_MMA(0, 0, At, B0); PG8_MMA(0, 1, At, B1); PG8_BAR; PG8_SCHED;
            PG8_LDA(At, 1, 1); PG8_STAGE(PG8_SB(1, 0), b3, voffB); PG8_STAGE(PG8_SB(1, 1), b3 + hstep, voffB); PG8_STAGE(PG8_SA(1, 0), a3, voffA);
            PG8_WAIT_V(8); PG8_WAIT_L(0); PG8_BAR; PG8_MMA(1, 0, At, B0); PG8_MMA(1, 1, At, B1); PG8_BAR; PG8_SCHED;
            } else {
            PG8_LDB(B0, 0, 0); PG8_SCHED; PG8_LDA(At, 0, 0); PG8_STAGE(PG8_SA(1, 1), a1 + hstep, voffA);
            PG8_WAIT_L(8); PG8_BAR; PG8_WAIT_L(0); PG8_MMA(0, 0, At, B0); PG8_BAR; PG8_SCHED;
            PG8_LDB(B1, 0, 1); PG8_STAGE(PG8_SB(0, 0), b2, voffB);
            PG8_BAR; PG8_WAIT_L(0); PG8_MMA(0, 1, At, B1); PG8_BAR;
            PG8_LDA(At, 0, 1); PG8_STAGE(PG8_SA(0, 0), a2, voffA);
            PG8_BAR; PG8_WAIT_L(0); PG8_MMA(1, 0, At, B0); PG8_BAR; PG8_SCHED;
            PG8_STAGE(PG8_SB(0, 1), b2 + hstep, voffB);
            PG8_WAIT_V(6); PG8_BAR; PG8_MMA(1, 1, At, B1); PG8_BAR;
            PG8_LDB(B0, 1, 0); PG8_SCHED; PG8_LDA(At, 1, 0); PG8_STAGE(PG8_SA(0, 1), a2 + hstep, voffA);
            PG8_WAIT_L(8); PG8_BAR; PG8_WAIT_L(0); PG8_MMA(0, 0, At, B0); PG8_BAR; PG8_SCHED;
            PG8_LDB(B1, 1, 1); PG8_STAGE(PG8_SB(1, 0), b3, voffB);
            PG8_BAR; PG8_WAIT_L(0); PG8_MMA(0, 1, At, B1); PG8_BAR;
            PG8_LDA(At, 1, 1); PG8_STAGE(PG8_SA(1, 0), a3, voffA);
            PG8_BAR; PG8_WAIT_L(0); PG8_MMA(1, 0, At, B0); PG8_BAR; PG8_SCHED;
            PG8_STAGE(PG8_SB(1, 1), b3 + hstep, voffB);
            PG8_WAIT_V(6); PG8_BAR; PG8_MMA(1, 1, At, B1); PG8_BAR;
            }
        }
        if constexpr (ALIGN_EPI) { if (wr == 0) PG8_BAR; }
        if constexpr (!Epi::AFTER_DRAIN) { E(acc, cur, wr, wc, fr, fq); S.done(cur); }
        if (!has_next) break;
#pragma unroll
        for (int a = 0; a < 2; ++a)
#pragma unroll
            for (int b = 0; b < 2; ++b)
#pragma unroll
                for (int m = 0; m < 4; ++m)
#pragma unroll
                    for (int n = 0; n < 2; ++n) acc[a][b][m][n] = (f32x4){0.f, 0.f, 0.f, 0.f};
        cur = nxt; cA = nA; cB = nB; ++ui;
        if constexpr (ALIGN_EPI) { if (wr == 1) PG8_BAR; }
    }
    PG8_WAIT_V(0);
    if constexpr (!ALIGN_EPI) { if (wr == 0) PG8_BAR; }
    PG8_BAR;
    if constexpr (Epi::AFTER_DRAIN) { E.fused(acc, cur, wr, wc, fr, fq, lds, wid, lane); S.done(cur); }
#undef PG8_SA
#undef PG8_SB
#undef PG8_STAGE
#undef PG8_LDA
#undef PG8_LDB
#undef PG8_MMA
#undef PG8_WAIT_V
#undef PG8_WAIT_L
#undef PG8_BAR
#undef PG8_SCHED
}
__device__ __forceinline__ void map_tile(int L, int nM, int nN, int& pm, int& pn) {
    const int nwg = nM * nN; int wgid = L; { const int q = nwg / NXCD, r = nwg % NXCD, xcd = wgid % NXCD, off = wgid / NXCD; wgid = (xcd < r ? xcd * (q + 1) : r * (q + 1) + (xcd - r) * q) + off; }
    const int nig = WGM * nN, gid = wgid / nig, fm = gid * WGM, gsz = (nM - fm) < WGM ? (nM - fm) : WGM;
    pm = fm + ((wgid % nig) % gsz); pn = (wgid % nig) / gsz;
}
constexpr int MP = T / 256, WP = NMAIN / 256, NU2 = 4 * MP, NU1 = MP * WP;
struct InOrder { int G, c;
    __device__ __forceinline__ bool next(int i, Unit& u) const { const int L = i * G + c; if (L >= NU2 + NU1) return false; int a, b;
        if (L < NU2) { map_tile(L, 4, MP, a, b); u.pm = MP + WP + a; u.pn = b; } else { map_tile(L - NU2, MP, WP, a, b); u.pm = a; u.pn = MP + b; } return true; }
    __device__ __forceinline__ void a_ready(const Unit&) const {}
    __device__ __forceinline__ void done(const Unit&) const {}
};
struct EpiIn { static constexpr bool PERM = true, AFTER_DRAIN = false; bf16_t* P; float* G; bf16_t* HTp;
    __device__ __forceinline__ void operator()(const f32x4 (&acc)[2][2][4][2], const Unit& u, int wr, int wc, int fr, int fq) const {
        if (u.pm < MP) { const int pn = u.pn - MP, row0 = u.pm * BM + wr * 64 + fr;
            if (pn < NP / 256) { const int col0 = pn * BM + wc * 32 + 8 * fq;
#pragma unroll
                for (int ai = 0; ai < 2; ++ai)
#pragma unroll
                    for (int m = 0; m < 4; ++m) { bf16_t* rowp = P + (size_t)(row0 + ai * HALF + m * 16) * NP + col0;
#pragma unroll
                        for (int bj = 0; bj < 2; ++bj) { const f32x4 v0 = acc[ai][bj][m][0], v1 = acc[ai][bj][m][1];
                            u32x4 w; w.x = cvt_pk_bf16(v0[0], v0[1]); w.y = cvt_pk_bf16(v0[2], v0[3]); w.z = cvt_pk_bf16(v1[0], v1[1]); w.w = cvt_pk_bf16(v1[2], v1[3]); *(u32x4*)(rowp + bj * HALF) = w; } } }
            else { const int cb = wc * 32 + 8 * fq;
                if (cb < NG) {
#pragma unroll
                    for (int ai = 0; ai < 2; ++ai)
#pragma unroll
                        for (int m = 0; m < 4; ++m) { float* rowb = G + (size_t)(row0 + ai * HALF + m * 16) * NGS; const f32x4 v0 = acc[ai][0][m][0], v1 = acc[ai][0][m][1];
                            if (cb < 16) { *(f32x4*)(rowb + cb) = v0; *(f32x4*)(rowb + cb + 4) = v1; }
                            else { u32x4 w; w.x = cvt_pk_bf16(v0[0], v0[1]); w.y = cvt_pk_bf16(v0[2], v0[3]); w.z = cvt_pk_bf16(v1[0], v1[1]); w.w = cvt_pk_bf16(v1[2], v1[3]); *(u32x4*)((bf16_t*)(rowb + 16) + (cb - 16)) = w; } } } } }
        else { const int row0 = (u.pm - MP - WP) * BM + wr * 64 + fr, col0 = u.pn * BM + wc * 32 + 8 * fq;
#pragma unroll
            for (int ai = 0; ai < 2; ++ai)
#pragma unroll
                for (int m = 0; m < 4; ++m) { bf16_t* rowp = HTp + (size_t)(row0 + ai * HALF + m * 16) * T + col0;
#pragma unroll
                    for (int bj = 0; bj < 2; ++bj) { const f32x4 v0 = acc[ai][bj][m][0], v1 = acc[ai][bj][m][1];
                        u32x4 w; w.x = cvt_pk_bf16(v0[0], v0[1]); w.y = cvt_pk_bf16(v0[2], v0[3]); w.z = cvt_pk_bf16(v1[0], v1[1]); w.w = cvt_pk_bf16(v1[2], v1[3]); *(u32x4*)(rowp + bj * HALF) = w; } } }
    }
};
struct OutOrder { int G, c; bool lat_only; unsigned* cnt;
    __device__ __forceinline__ bool next(int i, Unit& u) const { constexpr int nN = DM / 256, nLat = NB * (SEQ / 256) * nN, nCtx = NB * (CTXL / 256) * nN; const int L = i * G + c; int a, b;
        if (L < nLat) { map_tile(L, nLat / nN, nN, a, b); u.pm = (a / (SEQ / 256)) * (TOK / 256) + CTXL / 256 + a % (SEQ / 256); }
        else { if (lat_only || L >= nLat + nCtx) return false; map_tile(L - nLat, nCtx / nN, nN, a, b); u.pm = (a / (CTXL / 256)) * (TOK / 256) + a % (CTXL / 256); }
        u.pn = b; return true; }
    __device__ __forceinline__ void a_ready(const Unit&) const {}
    unsigned* xu; unsigned nloc, xtarget;
    __device__ __forceinline__ void done(const Unit& u) const {
        asm volatile("s_waitcnt vmcnt(0)" ::: "memory"); __builtin_amdgcn_s_barrier();
        if (threadIdx.x == 0) { const bool isctx = (u.pm % (TOK / 256)) < CTXL / 256;
            if (!isctx && xtarget != 0u) {
                const unsigned old = __hip_atomic_fetch_add(xu, 1u, __ATOMIC_RELAXED, __HIP_MEMORY_SCOPE_AGENT);
                if (old + 1u == xtarget) { __builtin_amdgcn_fence(__ATOMIC_RELEASE, "agent"); asm volatile("s_waitcnt vmcnt(0)" ::: "memory");
                    __hip_atomic_fetch_add(cnt, nloc, __ATOMIC_RELAXED, __HIP_MEMORY_SCOPE_AGENT); } }
            else { __builtin_amdgcn_fence(__ATOMIC_RELEASE, "agent"); asm volatile("s_waitcnt vmcnt(0)" ::: "memory");
                __hip_atomic_fetch_add(cnt + (isctx ? 64 : 0), 1u, __ATOMIC_RELAXED, __HIP_MEMORY_SCOPE_AGENT); } } }
};
struct EpiOut { static constexpr bool PERM = true, AFTER_DRAIN = false; bf16_t* C;
    __device__ __forceinline__ void operator()(const f32x4 (&acc)[2][2][4][2], const Unit& u, int wr, int wc, int fr, int fq) const {
        const int row0 = u.pm * BM + wr * 64 + fr, col0 = u.pn * BM + wc * 32 + 8 * fq;
#pragma unroll
        for (int ai = 0; ai < 2; ++ai)
#pragma unroll
            for (int m = 0; m < 4; ++m) { bf16_t* rowp = C + (size_t)(row0 + ai * HALF + m * 16) * DM + col0;
#pragma unroll
                for (int bj = 0; bj < 2; ++bj) { const f32x4 v0 = acc[ai][bj][m][0], v1 = acc[ai][bj][m][1];
                    u32x4 w; w.x = cvt_pk_bf16(v0[0], v0[1]); w.y = cvt_pk_bf16(v0[2], v0[3]); w.z = cvt_pk_bf16(v1[0], v1[1]); w.w = cvt_pk_bf16(v1[2], v1[3]); *(u32x4*)(rowp + bj * HALF) = w; } }
    }
};
}
#endif

__device__ __forceinline__ void phase_gemm_in(const Params& p, int l, char* smem) {
    constexpr int N_F = WG / 2;
#ifdef EMU
    constexpr int MT = T / 128, NT1 = NMAIN / 128, N1 = MT * NT1, N2 = 8 * MT;
    for (int task = obid(); task < N1 + N2; task += gridDim.x) {
        if (task < N1) gemm_tile(p, (const bf16*)(p.ws + WS_HNY), (const bf16*)(p.ws + WS_WIN), DM, task / NT1, task % NT1, 0, smem);
        else { const int t2 = task - N1; gemm_tile(p, (const bf16*)(p.ws + WS_WIN) + (size_t)NMAIN * DM, (const bf16*)(p.ws + WS_HNY), DM, t2 / MT, t2 % MT, 2, smem); }
    }
#else
    { const pg8::Gemm g{(const pg8::bf16_t*)(p.ws + WS_HNY), (const pg8::bf16_t*)(p.ws + WS_HNY), 0, 0, DM};
      const pg8::InOrder S{(int)gridDim.x, obid()};
      const pg8::EpiIn E{(pg8::bf16_t*)(p.ws + WS_P), (float*)(p.ws + WS_G), (pg8::bf16_t*)(p.ws + WS_HT)};
      pg8::gemm_phase<pg8::EpiIn, pg8::InOrder, true, true>((PG8_LAS unsigned char*)smem, g, S, E); }
#endif
    { const int G = (int)gridDim.x, bid = obid();
#ifdef EMU
      const int extra = 0;
#else
      const int extra = (pg8::NU1 + pg8::NU2) % G;
#endif
      if (extra > 0 && extra < G) { if (bid >= extra) for (int task = bid - extra; task < N_F; task += G - extra) filt_fft_task(p, task, smem); }
      else for (int task = G - 1 - bid; task < N_F; task += G) filt_fft_task(p, task, smem); }
}
__device__ __forceinline__ void phase_gemm_out(const Params& p, int l, char* smem) {
    const int G = (int)gridDim.x, bid = obid(); const bool has_ctx = l < DEPTH - 1;
#ifdef EMU
    constexpr int MT = T / 128, NTO = DM / 128;
    for (int task = bid; task < MT * NTO; task += G) {
        const int mt = task / NTO, nt = task % NTO;
        if (!has_ctx && (mt % (TOK / 128)) < CTXL / 128) continue;
        gemm_tile(p, (const bf16*)(p.ws + WS_HNY), (const bf16*)(p.ws + WS_WOUT), MIX, mt, nt, 1, smem);
        __syncthreads(); if (otid() == 0) *unit_counter(p, (mt % (TOK / 128)) < CTXL / 128 ? 1 : 0) += 1u;
    }
#else
    const pg8::Gemm g{(const pg8::bf16_t*)(p.ws + WS_HNY), (const pg8::bf16_t*)(p.ws + WS_WOUT), 0, 0, MIX};
    const unsigned xcc = (unsigned)__builtin_amdgcn_s_getreg((3 << 11) | 20) & 0xFu, nloc = ((volatile PG8_LAS unsigned*)(smem + LDS_BYTES - 64))[0];
    const bool agg = (NB * (SEQ / 256) * (DM / 256) == G) && nloc > 0u;
    const pg8::OutOrder S{G, bid, !has_ctx, unit_counter(p, 0), unit_counter(p, 2) + 16 * xcc, nloc, agg ? nloc * (unsigned)(l + 1) : 0u};
    const pg8::EpiOut E{(pg8::bf16_t*)(p.ws + WS_P)};
    pg8::gemm_phase<pg8::EpiOut, pg8::OutOrder, true, true>((PG8_LAS unsigned char*)smem, g, S, E);
#endif
}

__device__ __forceinline__ size_t st_index(int mixer, int dir, int b, int h, int cid) { return ((((size_t)(mixer * 2 + dir) * NB + b) * NH + h) * NCH + cid); }
__device__ __forceinline__ size_t ch_index(int dir, int b, int h, int cid) { return (((size_t)dir * NB + b) * NH + h) * NCH + cid; }

__device__ __forceinline__ void load_tile_nat(const bf16* P, int r0, int c0, bf16* dst, float scale, int tid) {
    const int s = tid >> 3, c8 = tid & 7;
    const u32x4 v = *(const u32x4*)(P + (size_t)(r0 + s) * NP + c0 + c8 * 8);
    if (scale == 1.0f) *(u32x4*)(dst + s * LS + c8 * 8) = v;
    else { float f[8]; unpack8(v, f); u32x4 o; o.x = pk2(f[0] * scale, f[1] * scale); o.y = pk2(f[2] * scale, f[3] * scale); o.z = pk2(f[4] * scale, f[5] * scale); o.w = pk2(f[6] * scale, f[7] * scale);
        *(u32x4*)(dst + s * LS + c8 * 8) = o; }
}
__device__ __forceinline__ void load_tile_tr(const bf16* P, int r0, int c0, bf16* dst, int tid) {
    const int s = tid >> 3, c8 = tid & 7;
    const u32x4 v = *(const u32x4*)(P + (size_t)(r0 + s) * NP + c0 + c8 * 8);
    const unsigned w[4] = {v.x, v.y, v.z, v.w};
#pragma unroll
    for (int j = 0; j < 4; ++j) { dst[(c8 * 8 + 2 * j) * LS + s] = (bf16)(w[j] & 0xffffu); dst[(c8 * 8 + 2 * j + 1) * LS + s] = (bf16)(w[j] >> 16); }
}

template <int NTK>
__device__ __forceinline__ void load_span(const bf16* row, int t0, float (&v)[NTK + 2]) {
    { const bool hl = t0 > 0, hr = t0 + NTK < SEQ; const bf16 xl = row[hl ? -1 : 0], xr = row[hr ? NTK : 0];
        v[0] = hl ? bf2f(xl) : 0.f; v[NTK + 1] = hr ? bf2f(xr) : 0.f; }
    if constexpr (NTK == 8) { float f[8]; unpack8(*(const u32x4*)row, f);
#pragma unroll
        for (int i = 0; i < 8; ++i) v[1 + i] = f[i]; }
    else {
#pragma unroll
        for (int i = 0; i < NTK; ++i) v[1 + i] = bf2f(row[i]); }
}
struct SpanRaw { u32x4 b; bf16 xl, xr; };
__device__ __forceinline__ SpanRaw span_load8(const bf16* row, int t0) { SpanRaw s; const bool hl = t0 > 0, hr = t0 + 8 < SEQ; s.xl = row[hl ? -1 : 0]; s.xr = row[hr ? 8 : 0]; s.b = *(const u32x4*)row; return s; }
__device__ __forceinline__ void span_expand8(const SpanRaw& s, int t0, float (&v)[10]) { float f[8]; unpack8(s.b, f); v[0] = t0 > 0 ? bf2f(s.xl) : 0.f; v[9] = (t0 + 8 < SEQ) ? bf2f(s.xr) : 0.f;
#pragma unroll
    for (int i = 0; i < 8; ++i) v[1 + i] = f[i]; }
template <int NTK>
__device__ __forceinline__ void hy_inputs(const bf16* h0, const bf16* h1, const float* cw, const float* cb, int c, int t0, float (&u0)[NTK], float (&u1)[NTK], float (&g0)[NTK], float (&g1)[NTK]) {
    if constexpr (NTK == 8) {
        const SpanRaw rxa = span_load8(h0 + (size_t)512 * T, t0), rxb = span_load8(h1 + (size_t)512 * T, t0), rga = span_load8(h0 + (size_t)768 * T, t0), rgb = span_load8(h1 + (size_t)768 * T, t0);
        const SpanRaw rva = span_load8(h0, t0), rvb = span_load8(h1, t0), rya = span_load8(h0 + (size_t)256 * T, t0), ryb = span_load8(h1 + (size_t)256 * T, t0);
        const float w0 = cw[0 * 768 + 512 + c], w1 = cw[1 * 768 + 512 + c], w2 = cw[2 * 768 + 512 + c], bb = cb[512 + c];
        const float v0 = cw[0 * 768 + c], v1 = cw[1 * 768 + c], v2 = cw[2 * 768 + c], vbias = cb[c];
        const float y0 = cw[0 * 768 + 256 + c], y1 = cw[1 * 768 + 256 + c], y2 = cw[2 * 768 + 256 + c], ybias = cb[256 + c];
        SCHED_FENCE();
        { float xa[10], xb[10], ga[10], gb[10]; span_expand8(rxa, t0, xa); span_expand8(rxb, t0, xb); span_expand8(rga, t0, ga); span_expand8(rgb, t0, gb);
#pragma unroll
            for (int i = 0; i < 8; ++i) { g0[i] = (w0 * xa[i] + w1 * xa[i + 1] + w2 * xa[i + 2] + bb) * siluf_(ga[i + 1]); g1[i] = (w0 * xb[i] + w1 * xb[i + 1] + w2 * xb[i + 2] + bb) * siluf_(gb[i + 1]); } }
        { float va[10], vb[10], ya[10], yb[10]; span_expand8(rva, t0, va); span_expand8(rvb, t0, vb); span_expand8(rya, t0, ya); span_expand8(ryb, t0, yb);
#pragma unroll
            for (int i = 0; i < 8; ++i) { u0[i] = (v0 * va[i] + v1 * va[i + 1] + v2 * va[i + 2] + vbias) * (y0 * ya[i] + y1 * ya[i + 1] + y2 * ya[i + 2] + ybias);
                u1[i] = (v0 * vb[i] + v1 * vb[i + 1] + v2 * vb[i + 2] + vbias) * (y0 * yb[i] + y1 * yb[i + 1] + y2 * yb[i + 2] + ybias); } }
        return;
    }
    { float xa[NTK + 2], xb[NTK + 2]; load_span<NTK>(h0 + (size_t)512 * T, t0, xa); load_span<NTK>(h1 + (size_t)512 * T, t0, xb);
        const float w0 = cw[0 * 768 + 512 + c], w1 = cw[1 * 768 + 512 + c], w2 = cw[2 * 768 + 512 + c], bb = cb[512 + c];
        float ga[NTK + 2], gb[NTK + 2]; load_span<NTK>(h0 + (size_t)768 * T, t0, ga); load_span<NTK>(h1 + (size_t)768 * T, t0, gb);
#pragma unroll
        for (int i = 0; i < NTK; ++i) { g0[i] = (w0 * xa[i] + w1 * xa[i + 1] + w2 * xa[i + 2] + bb) * siluf_(ga[i + 1]); g1[i] = (w0 * xb[i] + w1 * xb[i + 1] + w2 * xb[i + 2] + bb) * siluf_(gb[i + 1]); } }
    { float va[NTK + 2], vb[NTK + 2], ya[NTK + 2], yb[NTK + 2];
        load_span<NTK>(h0, t0, va); load_span<NTK>(h1, t0, vb); load_span<NTK>(h0 + (size_t)256 * T, t0, ya); load_span<NTK>(h1 + (size_t)256 * T, t0, yb);
        const float v0 = cw[0 * 768 + c], v1 = cw[1 * 768 + c], v2 = cw[2 * 768 + c], vbias = cb[c];
        const float y0 = cw[0 * 768 + 256 + c], y1 = cw[1 * 768 + 256 + c], y2 = cw[2 * 768 + 256 + c], ybias = cb[256 + c];
#pragma unroll
        for (int i = 0; i < NTK; ++i) { u0[i] = (v0 * va[i] + v1 * va[i + 1] + v2 * va[i + 2] + vbias) * (y0 * ya[i] + y1 * ya[i + 1] + y2 * ya[i + 2] + ybias);
            u1[i] = (v0 * vb[i] + v1 * vb[i + 1] + v2 * vb[i + 2] + vbias) * (y0 * yb[i] + y1 * yb[i + 1] + y2 * yb[i + 2] + ybias); } }
}
__device__ __forceinline__ void hylat_task(const Params& p, int l, int bp, int cp, char* smem) {
    const int tid = otid(), half = tid >> 8, tl = tid & 255, c = 2 * cp + half;
    const bf16* HT = (const bf16*)(p.ws + WS_HT); bf16* Y = (bf16*)(p.ws + WS_HNY);
    cpx* buf = (cpx*)smem + (size_t)half * FBUF;
    const cpx* TW = (const cpx*)(p.ws + WS_TW);
    const cpx* KF = (const cpx*)(p.ws + WS_KF) + (size_t)c * NF;
    constexpr int NTK = SEQ / 256;
    const int t0 = NTK * tl;
    const float* cw = p.in[I_HCW] + (size_t)l * 3 * 768; const float* cb = p.in[I_HCB] + (size_t)l * 768;
    const size_t rb0 = (size_t)(2 * bp) * TOK + CTXL, rb1 = rb0 + TOK;
    const bf16* h0 = HT + (size_t)c * T + rb0 + t0; const bf16* h1 = h0 + TOK;
    { float u0[NTK], u1[NTK], g0[NTK], g1[NTK]; hy_inputs<NTK>(h0, h1, cw, cb, c, t0, u0, u1, g0, g1);
        __syncthreads();
#pragma unroll
        for (int i = 0; i < NTK; ++i) { cpx v; v.x = u0[i]; v.y = u1[i]; buf[FPH(t0 + i)] = v; cpx z = {0.f, 0.f}; buf[FPH(SEQ + t0 + i)] = z; } }
    fft_fwd(buf, TW, tl);
#pragma unroll 2
    for (int i = tl; i < NF; i += 256) buf[FPH(i)] = cmul(buf[FPH(i)], KF[i]);
    fft_inv(buf, TW, tl);
    const float dsk = p.in[I_HD][(size_t)l * WG + c]; const float sc = 1.0f / (float)NF;
    { const int tz = otid() & 255; const int t0z = NTK * tz;
        float u0[NTK], u1[NTK], g0[NTK], g1[NTK]; hy_inputs<NTK>(HT + (size_t)c * T + rb0 + t0z, HT + (size_t)c * T + rb0 + t0z + TOK, cw, cb, c, t0z, u0, u1, g0, g1);
        float o0[NTK], o1[NTK];
#pragma unroll
        for (int i = 0; i < NTK; ++i) { const cpx y = buf[FPH(t0z + i)]; o0[i] = g0[i] * (y.x * sc + u0[i] * dsk); o1[i] = g1[i] * (y.y * sc + u1[i] * dsk); }
        bf16* d0 = (bf16*)(p.ws + WS_HT) + (size_t)(768 + c) * T + rb0 + t0z; bf16* d1 = d0 + TOK;
        if constexpr (NTK == 8) { *(u32x4*)d0 = pack8(o0); *(u32x4*)d1 = pack8(o1); }
        else {
#pragma unroll
            for (int i = 0; i < NTK; ++i) { d0[i] = f2bf(o0[i]); d1[i] = f2bf(o1[i]); } } }
}

constexpr int HCB = 16;
__device__ __forceinline__ void hyctx_task(const Params& p, int l, int b, int cblk, char* smem) {
    const int tid = otid(); const int c0 = cblk * HCB;
    const bf16* HT = (const bf16*)(p.ws + WS_HT); bf16* Y = (bf16*)(p.ws + WS_HNY); const float* HC = (const float*)(p.ws + WS_HC);
    float* raw = (float*)smem;
    float* u = raw + 4 * CTXL * HCB;
    float* og = u + CTXL * HCB;
    float* hcm = og + CTXL * HCB;
    bf16* ob = (bf16*)raw;
    const size_t rb = (size_t)b * TOK;
    const float* cw = p.in[I_HCW] + (size_t)l * 3 * 768; const float* cbias = p.in[I_HCB] + (size_t)l * 768;
    constexpr int WT = CTXL / 32;
    __syncthreads();
    for (int i = tid; i < 4 * HCB * (CTXL / 8); i += NT) { const int k = i / (HCB * (CTXL / 8)), cc = (i / (CTXL / 8)) % HCB, ck = i % (CTXL / 8);
        float f[8]; unpack8(*(const u32x4*)(HT + (size_t)(k * 256 + c0 + cc) * T + rb + ck * 8), f);
#pragma unroll
        for (int j = 0; j < 8; ++j) raw[(k * CTXL + ck * 8 + j) * HCB + cc] = f[j]; }
    for (int i = tid; i < 2 * HCB * (CTXL / 4); i += NT) { const int dir = i / (HCB * (CTXL / 4)), cc = (i / (CTXL / 4)) % HCB, pk = i % (CTXL / 4);
        const f32x4 v = *(const f32x4*)(HC + ((size_t)dir * WG + c0 + cc) * CTXL + pk * 4); const float f[4] = {v.x, v.y, v.z, v.w};
#pragma unroll
        for (int j = 0; j < 4; ++j) { const int pos = pk * 4 + j; if (dir == 0) hcm[(CTXL + pos) * HCB + cc] = f[j]; else if (pos > 0) hcm[(CTXL - pos) * HCB + cc] = f[j]; } }
    if (tid < HCB) hcm[tid] = 0.f;
    __syncthreads();
    static_assert(NT % HCB == 0, "a thread keeps its channel over the passes: its 12 filter taps are loaded once");
    float tw0[3], tw1[3], tw2[3], tbs[3];
#pragma unroll
    for (int k = 0; k < 3; ++k) { const int ch = k * 256 + c0 + tid % HCB; tw0[k] = cw[0 * 768 + ch]; tw1[k] = cw[1 * 768 + ch]; tw2[k] = cw[2 * 768 + ch]; tbs[k] = cbias[ch]; }
    for (int i = tid; i < CTXL * HCB; i += NT) { const int t = i / HCB, cc = i % HCB; float cv[3];
#pragma unroll
        for (int k = 0; k < 3; ++k) { const float* rk = raw + k * CTXL * HCB;
            const float a = t > 0 ? rk[(t - 1) * HCB + cc] : 0.f, m = rk[t * HCB + cc], z = t < CTXL - 1 ? rk[(t + 1) * HCB + cc] : 0.f;
            cv[k] = tw0[k] * a + tw1[k] * m + tw2[k] * z + tbs[k]; }
        u[i] = cv[0] * cv[1];
        og[i] = cv[2] * siluf_(raw[(3 * CTXL + t) * HCB + cc]); }
    __syncthreads();
    { const int cc = tid % HCB, tg = tid / HCB, t0 = WT * tg; float acc[WT], w[WT];
#pragma unroll
        for (int j = 0; j < WT; ++j) { acc[j] = 0.f; w[j] = hcm[(t0 + j + CTXL) * HCB + cc]; }
#pragma unroll 8
        for (int s = 0; s < CTXL; ++s) { const float us = u[s * HCB + cc];
#pragma unroll
            for (int j = 0; j < WT; ++j) acc[j] += us * w[j];
#pragma unroll
            for (int j = WT - 1; j > 0; --j) w[j] = w[j - 1];
            w[0] = hcm[(t0 - s - 1 + CTXL) * HCB + cc]; }
        const float dsk = p.in[I_HD][(size_t)l * WG + c0 + cc];
#pragma unroll
        for (int j = 0; j < WT; ++j) { const int t = t0 + j; ob[t * HCB + cc] = f2bf(og[t * HCB + cc] * (acc[j] + u[t * HCB + cc] * dsk)); } }
    __syncthreads();
    for (int i = tid; i < CTXL * 2; i += NT) { const int t = i >> 1, hh = i & 1; *(u32x4*)(Y + (rb + t) * 1024 + YH + c0 + 8 * hh) = *(const u32x4*)(ob + t * HCB + 8 * hh); }
}

__device__ __forceinline__ void attn_task(const Params& p, int l, int b, int kvh, int qt, bool ctxq, char* smem) {
    const int tid = otid(), lane = tid & 63, wave = tid >> 6, r = lane & 15, q = lane >> 4;
    constexpr float QSC = 0.125f * 1.4426950408889634f;
    const bf16* P = (const bf16*)(p.ws + WS_P); bf16* Y = (bf16*)(p.ws + WS_HNY); const cpx* ROPE = (const cpx*)(p.ws + WS_ROPE);
    bf16* Qs = (bf16*)smem;
    bf16* Ks = Qs + 256 * LS;
    constexpr int LSV = 80;
    bf16* Vt = Ks + 64 * LS;
    bf16* Ps = Vt + 64 * LS;
    const size_t rq0 = (size_t)b * TOK + (ctxq ? 0 : CTXL) + qt * 128;
    __syncthreads();
#pragma unroll
    for (int it = 0; it < 2; ++it) {
        const int idx = tid + NT * it, row = idx >> 2, cpair = idx & 3, g = row >> 7, t = row & 127;
        const bf16* src = P + (rq0 + t) * NP + PD + (kvh * 2 + g) * 64;
        float lo[8], hi[8]; unpack8(*(const u32x4*)(src + cpair * 8), lo); unpack8(*(const u32x4*)(src + 32 + cpair * 8), hi);
        float a[8], c2[8];
#pragma unroll
        for (int j = 0; j < 8; ++j) { float cs = 1.f, sn = 0.f; if (!ctxq) { const cpx cv = ROPE[(size_t)(qt * 128 + t) * 32 + cpair * 8 + j]; cs = cv.x; sn = cv.y; }
            a[j] = (lo[j] * cs - hi[j] * sn) * QSC; c2[j] = (hi[j] * cs + lo[j] * sn) * QSC; }
        *(u32x4*)(Qs + row * LS + cpair * 8) = pack8(a); *(u32x4*)(Qs + row * LS + 32 + cpair * 8) = pack8(c2);
    }
    const int lt0 = ctxq ? 0 : (2 * qt - 2 > 0 ? 2 * qt - 2 : 0), lt1 = ctxq ? -1 : (2 * qt + 3 < SEQ / 64 - 1 ? 2 * qt + 3 : SEQ / 64 - 1);
    const int nloc = lt1 - lt0 + 1, ntiles = nloc + NCC;
    float m[2], lsum[2]; f32x4 O[2][4];
#pragma unroll
    for (int ms = 0; ms < 2; ++ms) { m[ms] = -INFINITY; lsum[ms] = 0.f;
#pragma unroll
        for (int i = 0; i < 4; ++i) O[ms][i] = (f32x4){0.f, 0.f, 0.f, 0.f}; }
    const int g = wave >> 2, tq0 = (wave & 3) * 32;
    (void)Ps;
    __syncthreads();
    bf16x8 qf[2][2];
#pragma unroll
    for (int ms = 0; ms < 2; ++ms)
#pragma unroll
        for (int ks = 0; ks < 2; ++ks) qf[ms][ks] = *(const bf16x8*)(Qs + (g * 128 + tq0 + 16 * ms + r) * LS + ks * 32 + q * 8);
    u32x4 klo = {0u, 0u, 0u, 0u}, khi = klo, vq = klo; f32x4 rp[4] = {(f32x4){1.f, 0.f, 1.f, 0.f}, (f32x4){1.f, 0.f, 1.f, 0.f}, (f32x4){1.f, 0.f, 1.f, 0.f}, (f32x4){1.f, 0.f, 1.f, 0.f}};
    const int ks_ = tid >> 2, kcp = tid & 3, vs_ = tid >> 3, vc8 = tid & 7;
#define ATT_PREFETCH(TI) do { const bool loc_ = (TI) < nloc; const int kt_ = loc_ ? lt0 + (TI) : (TI) - nloc; const size_t rk_ = (size_t)b * TOK + (loc_ ? CTXL : 0) + kt_ * 64; \
        if (tid < 256) { const bf16* src_ = P + (rk_ + ks_) * NP + PD + 256 + kvh * 64; klo = *(const u32x4*)(src_ + kcp * 8); khi = *(const u32x4*)(src_ + 32 + kcp * 8); \
            if (loc_) { const f32x4* rr_ = (const f32x4*)(ROPE + (size_t)(kt_ * 64 + ks_) * 32 + kcp * 8); rp[0] = rr_[0]; rp[1] = rr_[1]; rp[2] = rr_[2]; rp[3] = rr_[3]; } \
            else { rp[0] = rp[1] = rp[2] = rp[3] = (f32x4){1.f, 0.f, 1.f, 0.f}; } } \
        vq = *(const u32x4*)(P + (rk_ + vs_) * NP + PD + 384 + kvh * 64 + vc8 * 8); } while (0)
    ATT_PREFETCH(0);
    for (int ti = 0; ti < ntiles; ++ti) {
        const bool local = ti < nloc; const int kt = local ? lt0 + ti : ti - nloc;
        __syncthreads();
        if (tid < 256) { float lo[8], hi[8]; unpack8(klo, lo); unpack8(khi, hi);
            const float cs[8] = {rp[0].x, rp[0].z, rp[1].x, rp[1].z, rp[2].x, rp[2].z, rp[3].x, rp[3].z}, sn[8] = {rp[0].y, rp[0].w, rp[1].y, rp[1].w, rp[2].y, rp[2].w, rp[3].y, rp[3].w};
            float a[8], c2[8];
#pragma unroll
            for (int j = 0; j < 8; ++j) { a[j] = lo[j] * cs[j] - hi[j] * sn[j]; c2[j] = hi[j] * cs[j] + lo[j] * sn[j]; }
            *(u32x4*)(Ks + ks_ * LS + kcp * 8) = pack8(a); *(u32x4*)(Ks + ks_ * LS + 32 + kcp * 8) = pack8(c2); }
        *(u32x4*)(Vt + vs_ * LSV + vc8 * 8) = vq;
        __syncthreads();
        if (ti + 1 < ntiles) ATT_PREFETCH(ti + 1);
        bf16x8 kfr[4][2], vfa[4], vfb[4];
#pragma unroll
        for (int nt = 0; nt < 4; ++nt)
#pragma unroll
            for (int ks = 0; ks < 2; ++ks) kfr[nt][ks] = *(const bf16x8*)(Ks + (16 * nt + r) * LS + ks * 32 + q * 8);
#pragma unroll
        for (int me = 0; me < 4; ++me) { const bf16* vr = Vt + (4 * q + (r >> 2)) * LSV + 16 * me + 4 * (r & 3);
            const u32x2 a0 = lds_tr16(vr), a1 = lds_tr16(vr + 16 * LSV), a2 = lds_tr16(vr + 32 * LSV), a3 = lds_tr16(vr + 48 * LSV);
            u32x4 va; va.x = a0.x; va.y = a0.y; va.z = a1.x; va.w = a1.y; u32x4 vb; vb.x = a2.x; vb.y = a2.y; vb.z = a3.x; vb.w = a3.y; vfa[me] = as_frag(va); vfb[me] = as_frag(vb); }
#pragma unroll
        for (int ms = 0; ms < 2; ++ms) {
            const int qlo = qt * 128 + tq0 + 16 * ms, klo_ = kt * 64;
            if (local && (klo_ > qlo + 15 + 128 || klo_ + 63 < qlo - 128)) continue;
            const bool domask = local && (klo_ + 63 - qlo > 128 || klo_ - (qlo + 15) < -128);
            f32x4 S[4] = {(f32x4){0.f, 0.f, 0.f, 0.f}, (f32x4){0.f, 0.f, 0.f, 0.f}, (f32x4){0.f, 0.f, 0.f, 0.f}, (f32x4){0.f, 0.f, 0.f, 0.f}};
#pragma unroll
            for (int ks = 0; ks < 2; ++ks)
#pragma unroll
                for (int nt = 0; nt < 4; ++nt) S[nt] = MFMA16(kfr[nt][ks], qf[ms][ks], S[nt]);
            const int qpos = qlo + r; float mx = -INFINITY;
            if (domask) {
#pragma unroll
                for (int nt = 0; nt < 4; ++nt)
#pragma unroll
                    for (int i = 0; i < 4; ++i) { const int d = kt * 64 + nt * 16 + 4 * q + i - qpos; if (d > 128 || d < -128) S[nt][i] = -INFINITY; } }
#pragma unroll
            for (int nt = 0; nt < 4; ++nt)
#pragma unroll
                for (int i = 0; i < 4; ++i) mx = fmaxf(mx, S[nt][i]);
            mx = xrow_max(mx);
            const float mn = fmaxf(m[ms], mx); const float msafe = mn == -INFINITY ? 0.f : mn; const float alpha = EXP2(m[ms] - msafe); float sm = 0.f;
#pragma unroll
            for (int nt = 0; nt < 4; ++nt)
#pragma unroll
                for (int i = 0; i < 4; ++i) { S[nt][i] = EXP2(S[nt][i] - msafe); sm += S[nt][i]; }
            sm = xrow_sum(sm);
            lsum[ms] = lsum[ms] * alpha + sm; m[ms] = mn;
            const float pa[8] = {S[0][0], S[0][1], S[0][2], S[0][3], S[1][0], S[1][1], S[1][2], S[1][3]}, pb[8] = {S[2][0], S[2][1], S[2][2], S[2][3], S[3][0], S[3][1], S[3][2], S[3][3]};
            const bf16x8 p0 = as_frag(pack8(pa)), p1 = as_frag(pack8(pb));
#pragma unroll
            for (int me = 0; me < 4; ++me) { O[ms][me] = O[ms][me] * alpha;
                O[ms][me] = MFMA16(vfa[me], p0, O[ms][me]); O[ms][me] = MFMA16(vfb[me], p1, O[ms][me]); }
        }
    }
#undef ATT_PREFETCH
    const float sink = p.in[I_SINK][(size_t)l * NH + kvh * 2 + g];
    u32x2 ggs[2][4];
#pragma unroll
    for (int ms = 0; ms < 2; ++ms)
#pragma unroll
        for (int me = 0; me < 4; ++me) ggs[ms][me] = *(const u32x2*)(P + (rq0 + tq0 + 16 * ms + r) * NP + PD + 512 + (kvh * 2 + g) * 64 + 4 * q + 16 * me);
#pragma unroll
    for (int ms = 0; ms < 2; ++ms) { const float den = lsum[ms] + EXP2(sink * 1.4426950408889634f - m[ms]); const float inv = frcp_(den);
        const size_t row = rq0 + tq0 + 16 * ms + r; const int col = (kvh * 2 + g) * 64 + 4 * q;
#pragma unroll
        for (int me = 0; me < 4; ++me) { const u32x2 gg = ggs[ms][me];
            const float g0 = bitsf(gg.x << 16), g1 = bitsf(gg.x & 0xffff0000u), g2 = bitsf(gg.y << 16), g3 = bitsf(gg.y & 0xffff0000u);
            u32x2 o; o.x = pk2(O[ms][me][0] * inv * siluf_(g0), O[ms][me][1] * inv * siluf_(g1)); o.y = pk2(O[ms][me][2] * inv * siluf_(g2), O[ms][me][3] * inv * siluf_(g3));
            *(u32x2*)(Y + row * 1024 + YD + col + 16 * me) = o; } }
}

#ifdef EMU
__device__ __forceinline__ int olane(int lane) { return lane; }
#else
__device__ __forceinline__ int olane(int lane) { asm volatile("" : "+v"(lane)); return lane; }
#endif
__device__ __forceinline__ void load_nat_tile(const bf16* P, int row0, int col0, bf16* tile, int lane) {
    u32x4 v[8];
#pragma unroll
    for (int i = 0; i < 8; ++i) v[i] = *(const u32x4*)(P + (size_t)(row0 + (lane >> 3) + 8 * i) * NP + col0 + (lane & 7) * 8);
#pragma unroll
    for (int i = 0; i < 8; ++i) *(u32x4*)(tile + swz((lane >> 3) + 8 * i, lane & 7)) = v[i];
}
__device__ __forceinline__ bf16x8 frag_tr(const bf16* tile, int c0, int k0, int lane) {
    const int c = c0 + (lane & 15), kb = k0 + 8 * (lane >> 4); unsigned w[4];
#pragma unroll
    for (int j = 0; j < 4; ++j) w[j] = (unsigned)tile[swz(kb + 2 * j, c >> 3) + (c & 7)] | ((unsigned)tile[swz(kb + 2 * j + 1, c >> 3) + (c & 7)] << 16);
    u32x4 o; o.x = w[0]; o.y = w[1]; o.z = w[2]; o.w = w[3]; return as_frag(o);
}
__device__ __forceinline__ bf16x8 frag_tr_hw(const bf16* tile, int c0, int k0, int lane) {
    const int r = lane & 15, q = lane >> 4, row = k0 + 8 * q + (r >> 2), col = c0 + 4 * (r & 3);
    const u32x2 a = lds_tr16(tile + swz(row, col >> 3) + (col & 7)), b = lds_tr16(tile + swz(row + 4, col >> 3) + (col & 7));
    u32x4 o; o.x = a.x; o.y = a.y; o.z = b.x; o.w = b.y; return as_frag(o);
}
template <int DIR>
__device__ __forceinline__ void gla_r_frags(const float* Grow0, int lane, bf16x8 (&af)[4]) {
    const int r = lane & 15, q4 = lane >> 4;
#pragma unroll
    for (int mt = 0; mt < 4; ++mt) { u32x4 o = {0u, 0u, 0u, 0u};
        if (q4 < 2) o = *(const u32x4*)((const bf16*)(Grow0 + (size_t)(16 * mt + r) * NGS + 16) + DIR * 16 + 8 * q4);
        af[mt] = as_frag(o); }
}
template <int DIR>
__device__ __forceinline__ void gla_b_load(const Params& p, int l, int h, int nt, int lane_, u32x4& o, float& bias) {
    const int lane = olane(lane_), r = lane & 15, q4 = lane >> 4, d = h * 64 + 16 * nt + r;
    const float* wa = p.in[I_GWA] + ((size_t)(l * 2 + DIR) * 16 + 8 * (q4 & 1)) * WG + d;
    float w[8];
#pragma unroll
    for (int j = 0; j < 8; ++j) w[j] = wa[j * WG];
    bias = p.in[I_GBA][(size_t)(l * 2 + DIR) * WG + d];
    o.x = pk2(w[0], w[1]); o.y = pk2(w[2], w[3]); o.z = pk2(w[4], w[5]); o.w = pk2(w[6], w[7]);
    if (q4 >= 2) o = (u32x4){0u, 0u, 0u, 0u};
}
template <int DIR>
__device__ __forceinline__ float gla_b_col(const u32x4 o, const float bias, const bf16x8 (&af)[4], int lane_, float (&x)[4][4]) {
    const int lane = olane(lane_), r = lane & 15, q4 = lane >> 4;
    const bf16x8 bfr = as_frag(o);
#pragma unroll
    for (int mt = 0; mt < 4; ++mt) { f32x4 c = {bias, bias, bias, bias}; c = MFMA16(af[mt], bfr, c);
#pragma unroll
        for (int i = 0; i < 4; ++i) x[mt][i] = logsig_fast(c[i]) * (1.0f / 16.0f); }
    float carry = 0.f;
#pragma unroll
    for (int k = 0; k < 4; ++k) { const int mt = DIR == 0 ? k : 3 - k; float* y = x[mt];
        if (DIR == 0) { y[1] += y[0]; y[2] += y[1]; y[3] += y[2]; } else { y[2] += y[3]; y[1] += y[2]; y[0] += y[1]; }
        const float s4 = DIR == 0 ? y[3] : y[0];
        const float t1 = DIR == 0 ? __shfl_up(s4, 16) : __shfl_down(s4, 16), t2 = DIR == 0 ? __shfl_up(s4, 32) : __shfl_down(s4, 32), t3 = DIR == 0 ? __shfl_up(s4, 48) : __shfl_down(s4, 48);
        const int qq = DIR == 0 ? q4 : 3 - q4;
        const float e = (qq >= 1 ? t1 : 0.f) + (qq >= 2 ? t2 : 0.f) + (qq >= 3 ? t3 : 0.f);
        const float tot = __shfl(e + s4, DIR == 0 ? r + 48 : r);
#pragma unroll
        for (int i = 0; i < 4; ++i) y[i] += carry + e;
        carry += tot; }
    return carry;
}

template <int MIXER, int DIR>
__device__ __forceinline__ void chunkst_dir(const Params& p, int l, int b, int h, int cid, const float* Grow0, const unsigned (&kk)[32], const bf16* Vt, bf16* Kt, const float* wvs, float* bendl, int lane_) {
    const int lane = olane(lane_), r = lane & 15, q4 = lane >> 4;
    if constexpr (MIXER == 0) {
        float nacc = 0.f;
#pragma unroll
        for (int c = 0; c < 8; ++c) { float f[8];
#pragma unroll
            for (int j = 0; j < 8; ++j) { const int s = 8 * c + j; const float kv = (s & 1) ? bitsf(kk[s >> 1] & 0xffff0000u) : bitsf(kk[s >> 1] << 16);
                f[j] = kv * 0.125f * wvs[DIR * 64 + s]; nacc += f[j]; }
            *(u32x4*)(Kt + swz(lane, c)) = pack8(f); }
        ((float*)(p.ws + WS_NV))[ch_index(DIR, b, h, cid) * 64 + lane] = nacc;
    } else {
        const bf16* P = (const bf16*)(p.ws + WS_P); const int kcol = PG + 256 + h * 64; const int r0 = b * TOK + cid * 64;
        bf16x8 af[4]; gla_r_frags<DIR>(Grow0, lane, af);
#pragma unroll 2
        for (int nt = 0; nt < 4; ++nt) { const int d = 16 * nt + r; float x[4][4];
            u32x4 wo_; float wb_; gla_b_load<DIR>(p, l, h, nt, lane, wo_, wb_); const float bend = gla_b_col<DIR>(wo_, wb_, af, lane, x);
            if (q4 == 0) { ((float*)(p.ws + WS_BE))[ch_index(DIR, b, h, cid) * 64 + d] = bend; bendl[d] = __expf(fmaxf(bend, -80.0f)); }
#pragma unroll
            for (int mt = 0; mt < 4; ++mt)
#pragma unroll
                for (int i = 0; i < 4; ++i) { const int s = 16 * mt + 4 * q4 + i; const float kv = bf2f(P[(size_t)(r0 + s) * NP + kcol + d]); const float bc = fmaxf(x[mt][i], -80.0f);
                    Kt[swz(d, s >> 3) + (s & 7)] = f2bf(kv * __expf(-bc));
                    ((bf16*)(p.ws + WS_EQ))[((size_t)DIR * T + r0 + s) * WG + h * 64 + d] = f2bf(__expf(bc)); } }
    }
    WAVE_SYNC();
    bf16x8 vf[4][2];
#pragma unroll
    for (int ne = 0; ne < 4; ++ne)
#pragma unroll
        for (int ks = 0; ks < 2; ++ks) vf[ne][ks] = frag_tr_hw(Vt, 16 * ne, 32 * ks, lane);
    bf16* dst = (bf16*)(p.ws + WS_ST) + st_index(MIXER, DIR, b, h, cid) * 4096;
#pragma unroll
    for (int me = 0; me < 4; ++me) {
        f32x4 acc[4] = {(f32x4){0.f, 0.f, 0.f, 0.f}, (f32x4){0.f, 0.f, 0.f, 0.f}, (f32x4){0.f, 0.f, 0.f, 0.f}, (f32x4){0.f, 0.f, 0.f, 0.f}};
#pragma unroll
        for (int ks = 0; ks < 2; ++ks) { const bf16x8 a = *(const bf16x8*)(Kt + swz(16 * me + r, ks * 4 + q4));
#pragma unroll
            for (int ne = 0; ne < 4; ++ne) acc[ne] = MFMA16(a, vf[ne][ks], acc[ne]); }
        f32x4 sc4 = {1.f, 1.f, 1.f, 1.f}; if constexpr (MIXER == 1) sc4 = *(const f32x4*)(bendl + 16 * me + 4 * q4);
#pragma unroll
        for (int ne = 0; ne < 4; ++ne) { const f32x4 v = acc[ne] * sc4; u32x2 o; o.x = pk2(v[0], v[1]); o.y = pk2(v[2], v[3]); *(u32x2*)(dst + (16 * ne + r) * 64 + 16 * me + 4 * q4) = o; }
    }
    WAVE_SYNC();
}
template <int MIXER>
__device__ __forceinline__ void chunkst_w(const Params& p, int l, int b, int h, int cid, char* wl, int lane) {
    const bf16* P = (const bf16*)(p.ws + WS_P); const float* G = (const float*)(p.ws + WS_G);
    const int r0 = b * TOK + cid * 64, r = lane & 15, q4 = lane >> 4;
    bf16* Kt = (bf16*)wl;
    bf16* Vt = Kt + 4096;
    float* wvs = (float*)(Vt + 4096);
    float* bendl = wvs + 128;
    const int kcol = (MIXER == 0 ? PA : PG) + 256 + h * 64, vcol = (MIXER == 0 ? PA : PG) + 512 + h * 64;
    const float* Grow0 = G + (size_t)r0 * NGS;
    bf16* Nn = Kt;
    { u32x4 vv[8], kv[8];
#pragma unroll
        for (int i = 0; i < 8; ++i) { vv[i] = *(const u32x4*)(P + (size_t)(r0 + (lane >> 3) + 8 * i) * NP + vcol + (lane & 7) * 8); kv[i] = *(const u32x4*)(P + (size_t)(r0 + (lane >> 3) + 8 * i) * NP + kcol + (lane & 7) * 8); }
#pragma unroll
        for (int i = 0; i < 8; ++i) { *(u32x4*)(Vt + swz((lane >> 3) + 8 * i, lane & 7)) = vv[i]; *(u32x4*)(Nn + swz((lane >> 3) + 8 * i, lane & 7)) = kv[i]; } }
    WAVE_SYNC();
    unsigned kk[32];
    { const int dc = 16 * q4 + 4 * (r & 3);
#pragma unroll
        for (int c = 0; c < 16; ++c) { const u32x2 t = lds_tr16(Nn + swz(4 * c + (r >> 2), dc >> 3) + (dc & 7)); kk[2 * c] = t.x; kk[2 * c + 1] = t.y; } }
    WAVE_SYNC();
    if constexpr (MIXER == 0) {
        const float* g = Grow0 + (size_t)lane * NGS; const float* gb = p.in[I_MGB] + (size_t)l * 16;
        const float gv0 = g[h], gv1 = g[4 + h], gv2 = g[8 + h], gv3 = g[12 + h], bv0 = gb[h], bv1 = gb[4 + h], bv2 = gb[8 + h], bv3 = gb[12 + h];
        const float i_f = gv0 + bv0, f_f = gv1 + bv1, i_b = gv2 + bv2, f_b = gv3 + bv3;
        const float lf = logsigf_(f_f), lb = logsigf_(f_b);
        const float bF = wave_prefix_sum(lf, lane), totF = __shfl(bF, 63);
        const float gF = totF - bF + i_f, mF = wave_max(gF);
        const float totB = wave_sum(lb), preB = wave_prefix_sum(lb, lane), bB = totB - preB + lb;
        const float gB = totB - bB + i_b, mB = wave_max(gB);
        wvs[lane] = __expf(gF - mF); wvs[64 + lane] = __expf(gB - mB);
        if (lane == 0) { float* SC = (float*)(p.ws + WS_SC);
            SC[ch_index(0, b, h, cid) * 4 + 0] = totF; SC[ch_index(0, b, h, cid) * 4 + 1] = mF;
            SC[ch_index(1, b, h, cid) * 4 + 0] = totB; SC[ch_index(1, b, h, cid) * 4 + 1] = mB; }
    }
    WAVE_SYNC();
    chunkst_dir<MIXER, 0>(p, l, b, h, cid, Grow0, kk, Vt, Kt, wvs, bendl, lane);
    chunkst_dir<MIXER, 1>(p, l, b, h, cid, Grow0, kk, Vt, Kt, wvs, bendl, lane);
}

template <int DIR>
__device__ __forceinline__ void chunkst_gla(const Params& p, int l, int b, int h, int cid, char* wl, int lane_) {
    const bf16* P = (const bf16*)(p.ws + WS_P);
    const int lane = olane(lane_), r0 = b * TOK + cid * 64, r = lane & 15, q4 = lane >> 4;
    bf16* Kt = (bf16*)wl;
    bf16* An = Kt + 4096;
    float* bendl = (float*)(An + 4096);
    const int kcol = PG + 256 + h * 64, vcol = PG + 512 + h * 64;
    const float* Grow0 = (const float*)(p.ws + WS_G) + (size_t)r0 * NGS;
    u32x4 vv[8], kv[8];
#pragma unroll
    for (int i = 0; i < 8; ++i) { vv[i] = *(const u32x4*)(P + (size_t)(r0 + (lane >> 3) + 8 * i) * NP + vcol + (lane & 7) * 8); kv[i] = *(const u32x4*)(P + (size_t)(r0 + (lane >> 3) + 8 * i) * NP + kcol + (lane & 7) * 8); }
    bf16x8 af[4]; gla_r_frags<DIR>(Grow0, lane, af);
    u32x4 wo[4]; float wb[4];
#pragma unroll
    for (int nt = 0; nt < 4; ++nt) gla_b_load<DIR>(p, l, h, nt, lane, wo[nt], wb[nt]);
#pragma unroll
    for (int i = 0; i < 8; ++i) *(u32x4*)(An + swz((lane >> 3) + 8 * i, lane & 7)) = vv[i];
    WAVE_SYNC();
    bf16x8 vf[4][2];
#pragma unroll
    for (int ne = 0; ne < 4; ++ne)
#pragma unroll
        for (int ks = 0; ks < 2; ++ks) vf[ne][ks] = frag_tr_hw(An, 16 * ne, 32 * ks, lane);
    WAVE_SYNC();
#pragma unroll
    for (int i = 0; i < 8; ++i) *(u32x4*)(An + swz((lane >> 3) + 8 * i, lane & 7)) = kv[i];
    WAVE_SYNC();
#pragma unroll
    for (int nt = 0; nt < 4; ++nt) { const int d = 16 * nt + r; float x[4][4];
        const float bend = gla_b_col<DIR>(wo[nt], wb[nt], af, lane, x);
        if (q4 == 0) { ((float*)(p.ws + WS_BE))[ch_index(DIR, b, h, cid) * 64 + d] = bend; bendl[d] = __expf(fmaxf(bend, -80.0f)); }
#pragma unroll
        for (int mt = 0; mt < 4; ++mt) { const int s0 = 16 * mt + 4 * q4, dc = 16 * nt + 4 * (r & 3);
            const u32x2 kq = lds_tr16(An + swz(s0 + (r >> 2), dc >> 3) + (dc & 7));
            const float kv[4] = {bitsf(kq.x << 16), bitsf(kq.x & 0xffff0000u), bitsf(kq.y << 16), bitsf(kq.y & 0xffff0000u)}; float kp[4];
#pragma unroll
            for (int i = 0; i < 4; ++i) { const float bc = fmaxf(x[mt][i], -80.0f); kp[i] = kv[i] * __expf(-bc); An[swz(s0 + i, d >> 3) + (d & 7)] = f2bf(__expf(bc)); }
            u32x2 o; o.x = pk2(kp[0], kp[1]); o.y = pk2(kp[2], kp[3]); *(u32x2*)(Kt + swz(d, s0 >> 3) + (s0 & 7)) = o; } }
    WAVE_SYNC();
    { bf16* EQg = (bf16*)(p.ws + WS_EQ) + ((size_t)DIR * T + r0) * WG + h * 64;
#pragma unroll
        for (int i = 0; i < 8; ++i) { const int s = (lane >> 3) + 8 * i, ck = lane & 7; *(u32x4*)(EQg + (size_t)s * WG + ck * 8) = *(const u32x4*)(An + swz(s, ck)); } }
    bf16* dst = (bf16*)(p.ws + WS_ST) + st_index(1, DIR, b, h, cid) * 4096;
#pragma unroll
    for (int me = 0; me < 4; ++me) {
        f32x4 acc[4] = {(f32x4){0.f, 0.f, 0.f, 0.f}, (f32x4){0.f, 0.f, 0.f, 0.f}, (f32x4){0.f, 0.f, 0.f, 0.f}, (f32x4){0.f, 0.f, 0.f, 0.f}};
#pragma unroll
        for (int ks = 0; ks < 2; ++ks) { const bf16x8 a = *(const bf16x8*)(Kt + swz(16 * me + r, ks * 4 + q4));
#pragma unroll
            for (int ne = 0; ne < 4; ++ne) acc[ne] = MFMA16(a, vf[ne][ks], acc[ne]); }
        const f32x4 sc4 = *(const f32x4*)(bendl + 16 * me + 4 * q4);
#pragma unroll
        for (int ne = 0; ne < 4; ++ne) { const f32x4 v = acc[ne] * sc4; u32x2 o; o.x = pk2(v[0], v[1]); o.y = pk2(v[2], v[3]); *(u32x2*)(dst + (16 * ne + r) * 64 + 16 * me + 4 * q4) = o; }
    }
    WAVE_SYNC();
}

template <int MIXER, int DIR>
__device__ __forceinline__ void chunkout_prep(const Params& p, int l, int b, int h, int cid, const float* Grow0, int r0, int pbase, const bf16* EQ, float* gar, int lane_) {
    const int lane = olane(lane_);
    if constexpr (MIXER == 0) {
        const bf16* P = (const bf16*)(p.ws + WS_P);
        const float* g = Grow0 + (size_t)lane * NGS; const float* gb = p.in[I_MGB] + (size_t)l * 16;
        const float gi = g[DIR * 8 + h], gf = g[DIR * 8 + 4 + h], bi = gb[DIR * 8 + h], bf_ = gb[DIR * 8 + 4 + h];
        const float mprev = ((const float*)(p.ws + WS_SC))[ch_index(DIR, b, h, cid) * 4 + 2];
        const float nv = ((const float*)(p.ws + WS_NV))[ch_index(DIR, b, h, cid) * 64 + lane];
        u32x4 qr[8];
#pragma unroll
        for (int c = 0; c < 8; ++c) qr[c] = *(const u32x4*)(P + (size_t)(r0 + lane) * NP + pbase + c * 8);
        const float ig = gi + bi, fg = gf + bf_;
        const float lf = logsigf_(fg); float bb;
        if (DIR == 0) bb = wave_prefix_sum(lf, lane); else { const float tt = wave_sum(lf), pre = wave_prefix_sum(lf, lane); bb = tt - pre + lf; }
        const float a = ig - bb; const float pm = DIR == 0 ? wave_prefix_max(a, lane) : wave_suffix_max(a, lane);
        const float mt_ = fmaxf(bb + mprev, bb + pm);
        float* ga = gar + DIR * 320;
        ga[lane] = bb - mt_; ga[64 + lane] = a; ga[128 + lane] = __expf(bb + mprev - mt_); ga[192 + lane] = __expf(-mt_);
        float* nvl = gar + 640 + DIR * 64;
        nvl[lane] = nv;
        WAVE_SYNC();
        float dq = 0.f;
#pragma unroll
        for (int c = 0; c < 8; ++c) { float f[8]; unpack8(qr[c], f);
            const f32x4 n0 = *(const f32x4*)(nvl + c * 8), n1 = *(const f32x4*)(nvl + c * 8 + 4);
            dq += f[0] * n0.x + f[1] * n0.y + f[2] * n0.z + f[3] * n0.w + f[4] * n1.x + f[5] * n1.y + f[6] * n1.z + f[7] * n1.w; }
        ga[256 + lane] = dq;
    }
}
template <int MIXER>
__device__ __forceinline__ void chunkout_prep2(const Params& p, int l, int b, int h, int cid, const float* Grow0, int r0, int pbase, float* gar, int lane_) {
    if constexpr (MIXER == 0) {
        const int lane = olane(lane_);
        const bf16* P = (const bf16*)(p.ws + WS_P);
        const float* g = Grow0 + (size_t)lane * NGS; const float* gb = p.in[I_MGB] + (size_t)l * 16;
        const float g0 = g[h], g1 = g[4 + h], g2 = g[8 + h], g3 = g[12 + h];
        const float mprev0 = ((const float*)(p.ws + WS_SC))[ch_index(0, b, h, cid) * 4 + 2], mprev1 = ((const float*)(p.ws + WS_SC))[ch_index(1, b, h, cid) * 4 + 2];
        const float nv0 = ((const float*)(p.ws + WS_NV))[ch_index(0, b, h, cid) * 64 + lane], nv1 = ((const float*)(p.ws + WS_NV))[ch_index(1, b, h, cid) * 64 + lane];
        u32x4 qr[8];
#pragma unroll
        for (int c = 0; c < 8; ++c) qr[c] = *(const u32x4*)(P + (size_t)(r0 + lane) * NP + pbase + c * 8);
        const float igF = g0 + gb[h], fgF = g1 + gb[4 + h], igB = g2 + gb[8 + h], fgB = g3 + gb[12 + h];
        { const float lf = logsigf_(fgF); const float bb = wave_prefix_sum(lf, lane);
            const float a = igF - bb; const float pm = wave_prefix_max(a, lane); const float mt_ = fmaxf(bb + mprev0, bb + pm); float* ga = gar;
            ga[lane] = bb - mt_; ga[64 + lane] = a; ga[128 + lane] = __expf(bb + mprev0 - mt_); ga[192 + lane] = __expf(-mt_); }
        { const float lf = logsigf_(fgB); const float tt = wave_sum(lf), pre = wave_prefix_sum(lf, lane); const float bb = tt - pre + lf;
            const float a = igB - bb; const float pm = wave_suffix_max(a, lane); const float mt_ = fmaxf(bb + mprev1, bb + pm); float* ga = gar + 320;
            ga[lane] = bb - mt_; ga[64 + lane] = a; ga[128 + lane] = __expf(bb + mprev1 - mt_); ga[192 + lane] = __expf(-mt_); }
        float* nvl = gar + 640;
        nvl[lane] = nv0; nvl[64 + lane] = nv1;
        WAVE_SYNC();
        float dq0 = 0.f, dq1 = 0.f;
#pragma unroll
        for (int c = 0; c < 8; ++c) { float f[8]; unpack8(qr[c], f);
            const f32x4 n0 = *(const f32x4*)(nvl + c * 8), n1 = *(const f32x4*)(nvl + c * 8 + 4), m0 = *(const f32x4*)(nvl + 64 + c * 8), m1 = *(const f32x4*)(nvl + 64 + c * 8 + 4);
            dq0 += f[0] * n0.x + f[1] * n0.y + f[2] * n0.z + f[3] * n0.w + f[4] * n1.x + f[5] * n1.y + f[6] * n1.z + f[7] * n1.w;
            dq1 += f[0] * m0.x + f[1] * m0.y + f[2] * m0.z + f[3] * m0.w + f[4] * m1.x + f[5] * m1.y + f[6] * m1.z + f[7] * m1.w; }
        gar[256 + lane] = dq0; gar[320 + 256 + lane] = dq1;
    }
}
template <int MIXER, int DIR, int NS>
__device__ __forceinline__ void chunkout_dir(const Params& p, int b, int h, int cid, int r0, int pbase, int th, const bf16x8 (&vtf)[4][2], const bf16* VtL, const bf16* EQ, bf16* SB, const float* gar, float* rsm, f32x4 (&htot)[NS][4], int lane_) {
    const bf16* P = (const bf16*)(p.ws + WS_P); const bf16* ST = (const bf16*)(p.ws + WS_ST);
    const int lane = olane(lane_), r = lane & 15, q4 = lane >> 4;
    const bf16* E = EQ + ((size_t)DIR * T + r0) * WG + h * 64;
    const float* ga = gar + DIR * 320;
    bf16x8 kf[4][2], ctf[4][2];
    if constexpr (MIXER == 0) {
#pragma unroll
        for (int n = 0; n < 4; ++n)
#pragma unroll
            for (int ks = 0; ks < 2; ++ks) { kf[n][ks] = *(const bf16x8*)(P + (size_t)(r0 + 16 * n + r) * NP + pbase + 256 + ks * 32 + q4 * 8); ctf[n][ks] = *(const bf16x8*)(ST + st_index(MIXER, DIR, b, h, cid) * 4096 + (16 * n + r) * 64 + ks * 32 + q4 * 8); }
    } else {
        u32x4 er[4][2];
#pragma unroll
        for (int n = 0; n < 4; ++n)
#pragma unroll
            for (int ks = 0; ks < 2; ++ks) { kf[n][ks] = *(const bf16x8*)(P + (size_t)(r0 + 16 * n + r) * NP + pbase + 256 + ks * 32 + q4 * 8);
                er[n][ks] = *(const u32x4*)(E + (size_t)(16 * n + r) * WG + ks * 32 + q4 * 8);
                ctf[n][ks] = *(const bf16x8*)(ST + st_index(MIXER, DIR, b, h, cid) * 4096 + (16 * n + r) * 64 + ks * 32 + q4 * 8); }
        SCHED_FENCE();
#pragma unroll
        for (int n = 0; n < 4; ++n)
#pragma unroll
            for (int ks = 0; ks < 2; ++ks) { float fe[8], fk[8]; unpack8(er[n][ks], fe); unpack8(as_u4(kf[n][ks]), fk);
#pragma unroll
                for (int j = 0; j < 8; ++j) fk[j] = fk[j] * frcp_(fe[j]);
                kf[n][ks] = as_frag(pack8(fk)); }
    }
    bf16x8 qraw[NS][2]; u32x4 qer[NS][2];
#pragma unroll
    for (int ms = 0; ms < NS; ++ms)
#pragma unroll
        for (int ks = 0; ks < 2; ++ks) { const int mt = NS * th + ms; qraw[ms][ks] = *(const bf16x8*)(P + (size_t)(r0 + 16 * mt + r) * NP + pbase + ks * 32 + q4 * 8);
            if constexpr (MIXER == 1) qer[ms][ks] = *(const u32x4*)(E + (size_t)(16 * mt + r) * WG + ks * 32 + q4 * 8); else qer[ms][ks] = (u32x4){0u, 0u, 0u, 0u}; }
#pragma unroll
    for (int ms = 0; ms < NS; ++ms) { const int mt = NS * th + ms;
        bf16x8 qf[2];
#pragma unroll
        for (int ks = 0; ks < 2; ++ks) { qf[ks] = qraw[ms][ks];
            if constexpr (MIXER == 1) { float fe[8], fq[8]; unpack8(qer[ms][ks], fe); unpack8(as_u4(qf[ks]), fq);
#pragma unroll
                for (int j = 0; j < 8; ++j) fq[j] *= 0.125f * fe[j];
                qf[ks] = as_frag(pack8(fq)); } }
        f32x4 S[4] = {(f32x4){0.f, 0.f, 0.f, 0.f}, (f32x4){0.f, 0.f, 0.f, 0.f}, (f32x4){0.f, 0.f, 0.f, 0.f}, (f32x4){0.f, 0.f, 0.f, 0.f}};
#pragma unroll
        for (int ks = 0; ks < 2; ++ks)
#pragma unroll
            for (int n = 0; n < 4; ++n) S[n] = MFMA16(kf[n][ks], qf[ks], S[n]);
        const int t = 16 * mt + r; float sm = 0.f; float gt = 0.f; if constexpr (MIXER == 0) gt = ga[t];
#pragma unroll
        for (int n = 0; n < 4; ++n) { f32x4 gs = {0.f, 0.f, 0.f, 0.f}; if constexpr (MIXER == 0) gs = *(const f32x4*)(ga + 64 + 16 * n + 4 * q4);
#pragma unroll
            for (int i = 0; i < 4; ++i) { const int sidx = 16 * n + 4 * q4 + i; const bool ok = DIR == 0 ? (sidx <= t) : (sidx >= t); float v = 0.f;
                if (ok) { if constexpr (MIXER == 0) v = S[n][i] * 0.125f * __expf(gt + gs[i]); else v = S[n][i]; }
                S[n][i] = v; sm += v; } }
        const float pa[8] = {S[0][0], S[0][1], S[0][2], S[0][3], S[1][0], S[1][1], S[1][2], S[1][3]}, pb[8] = {S[2][0], S[2][1], S[2][2], S[2][3], S[3][0], S[3][1], S[3][2], S[3][3]};
        const bf16x8 sm0 = as_frag(pack8(pa)), sm1 = as_frag(pack8(pb));
        float wi = 1.f, inv = 1.f;
        if constexpr (MIXER == 0) { sm = xrow_sum(sm); wi = ga[128 + t]; const float den = wi * ga[256 + t] + sm; inv = frcp_(fmaxf(fabsf(den), ga[192 + t])); }
#pragma unroll
        for (int me = 0; me < 4; ++me) { f32x4 a1 = {0.f, 0.f, 0.f, 0.f}, a2 = {0.f, 0.f, 0.f, 0.f};
            const int srow = 4 * q4 + (r >> 2), ecol = 16 * me + 4 * (r & 3);
            const u32x2 v0 = lds_tr16(VtL + swz(srow, ecol >> 3) + (ecol & 7)), v1 = lds_tr16(VtL + swz(16 + srow, ecol >> 3) + (ecol & 7)), v2 = lds_tr16(VtL + swz(32 + srow, ecol >> 3) + (ecol & 7)), v3 = lds_tr16(VtL + swz(48 + srow, ecol >> 3) + (ecol & 7));
            u32x4 va; va.x = v0.x; va.y = v0.y; va.z = v1.x; va.w = v1.y; u32x4 vb; vb.x = v2.x; vb.y = v2.y; vb.z = v3.x; vb.w = v3.y;
            a1 = MFMA16(as_frag(va), sm0, a1); a1 = MFMA16(as_frag(vb), sm1, a1);
            a2 = MFMA16(ctf[me][0], qf[0], a2); a2 = MFMA16(ctf[me][1], qf[1], a2);
            if constexpr (MIXER == 0) htot[ms][me] += (a1 + a2 * wi) * inv; else htot[ms][me] += a1 + a2; }
    }
    (void)SB; (void)rsm;
}
__device__ __forceinline__ void co_build_vt(const bf16* P, int r0, int vcol, bf16* VtL, int lane) {
    load_nat_tile(P, r0, vcol, VtL, lane);
    WAVE_SYNC();
}
template <int MIXER, int NS>
__device__ __forceinline__ void co_finalize(const Params& p, int l, int h, int r0, int pbase, int mt0, f32x4 (&htot)[NS][4], int lane_) {
    const bf16* P = (const bf16*)(p.ws + WS_P); bf16* Y = (bf16*)(p.ws + WS_HNY);
    const float* ngp = p.in[MIXER == 0 ? I_MNG : I_GNG] + (size_t)l * WG + h * 64;
    const int lz = olane(lane_), r = lz & 15, q4 = lz >> 4;
    u32x2 gq[NS][4], oq[NS][4]; f32x4 ng[4];
#pragma unroll
    for (int me = 0; me < 4; ++me) ng[me] = *(const f32x4*)(ngp + 16 * me + 4 * q4);
#pragma unroll
    for (int ms = 0; ms < NS; ++ms)
#pragma unroll
        for (int me = 0; me < 4; ++me) { const size_t off = (size_t)(r0 + 16 * (mt0 + ms) + r) * NP + pbase + 16 * me + 4 * q4;
            gq[ms][me] = *(const u32x2*)(P + off + (MIXER == 0 ? 1024 : 768)); if constexpr (MIXER == 0) oq[ms][me] = *(const u32x2*)(P + off + 768); else oq[ms][me] = (u32x2){0u, 0u}; }
#pragma unroll
    for (int ms = 0; ms < NS; ++ms) { const int mt = mt0 + ms; float ss = 0.f; float gv[4][4];
#pragma unroll
        for (int me = 0; me < 4; ++me) {
            gv[me][0] = bitsf(gq[ms][me].x << 16); gv[me][1] = bitsf(gq[ms][me].x & 0xffff0000u); gv[me][2] = bitsf(gq[ms][me].y << 16); gv[me][3] = bitsf(gq[ms][me].y & 0xffff0000u);
            if constexpr (MIXER == 0) { htot[ms][me][0] *= sigmoidf_(bitsf(oq[ms][me].x << 16)); htot[ms][me][1] *= sigmoidf_(bitsf(oq[ms][me].x & 0xffff0000u)); htot[ms][me][2] *= sigmoidf_(bitsf(oq[ms][me].y << 16)); htot[ms][me][3] *= sigmoidf_(bitsf(oq[ms][me].y & 0xffff0000u)); }
            ss += htot[ms][me][0] * htot[ms][me][0] + htot[ms][me][1] * htot[ms][me][1] + htot[ms][me][2] * htot[ms][me][2] + htot[ms][me][3] * htot[ms][me][3]; }
        ss = xrow_sum(ss);
        const float rstd = rsqrtf(ss * (1.0f / 64.0f) + EPS);
#pragma unroll
        for (int me = 0; me < 4; ++me) { const int e = 16 * me + 4 * q4; const f32x4 n4 = ng[me];
            u32x2 o; o.x = pk2(htot[ms][me][0] * rstd * n4.x * siluf_(gv[me][0]), htot[ms][me][1] * rstd * n4.y * siluf_(gv[me][1]));
            o.y = pk2(htot[ms][me][2] * rstd * n4.z * siluf_(gv[me][2]), htot[ms][me][3] * rstd * n4.w * siluf_(gv[me][3]));
            *(u32x2*)(Y + (size_t)(r0 + 16 * mt + r) * 1024 + (MIXER == 0 ? YA : YG) + h * 64 + e) = o; } }
}
template <int MIXER>
__device__ __forceinline__ void chunkout_w(const Params& p, int l, int b, int h, int cid, char* wl, int lane) {
    const bf16* P = (const bf16*)(p.ws + WS_P); const float* G = (const float*)(p.ws + WS_G);
    const int r0 = b * TOK + cid * 64;
    const int pbase = (MIXER == 0 ? PA : PG) + h * 64;
    bf16* SB = (bf16*)wl;
    float* rsm = (float*)(SB + 1024);
    float* gar = rsm + 16;
    const bf16* EQ = (const bf16*)(p.ws + WS_EQ);
    const float* Grow0 = G + (size_t)r0 * NGS;
    bf16* VtL = (bf16*)(gar + 768);
    bf16x8 vtf[4][2];
#pragma unroll
    for (int me = 0; me < 4; ++me)
#pragma unroll
        for (int ks = 0; ks < 2; ++ks) { vtf[me][ks] = (bf16x8){0, 0, 0, 0, 0, 0, 0, 0}; }
    co_build_vt(P, r0, pbase + 512, VtL, lane);
    chunkout_prep2<MIXER>(p, l, b, h, cid, Grow0, r0, pbase, gar, lane);
    WAVE_SYNC();
    constexpr int NS = 2;
#pragma unroll 1
    for (int th = 0; th < 4 / NS; ++th) {
        f32x4 htot[NS][4];
#pragma unroll
        for (int a = 0; a < NS; ++a)
#pragma unroll
            for (int c = 0; c < 4; ++c) htot[a][c] = (f32x4){0.f, 0.f, 0.f, 0.f};
        chunkout_dir<MIXER, 0, NS>(p, b, h, cid, r0, pbase, th, vtf, VtL, EQ, SB, gar, rsm, htot, lane);
        chunkout_dir<MIXER, 1, NS>(p, b, h, cid, r0, pbase, th, vtf, VtL, EQ, SB, gar, rsm, htot, lane);
        co_finalize<MIXER, NS>(p, l, h, r0, pbase, NS * th, htot, lane);
    }
}
constexpr int CO_PART = 13376;
template <int MIXER, int DIR>
__device__ __forceinline__ void chunkout_piece(const Params& p, int l, int b, int h, int cid, int mt, char* wl, int lane) {
    const bf16* P = (const bf16*)(p.ws + WS_P); const float* G = (const float*)(p.ws + WS_G);
    const int r0 = b * TOK + cid * 64; const int pbase = (MIXER == 0 ? PA : PG) + h * 64;
    bf16* SB = (bf16*)wl; float* rsm = (float*)(SB + 1024); float* gar = rsm + 16; const bf16* EQ = (const bf16*)(p.ws + WS_EQ);
    const float* Grow0 = G + (size_t)r0 * NGS; bf16* VtL = (bf16*)(gar + 768);
    bf16x8 vtf[4][2];
#pragma unroll
    for (int me = 0; me < 4; ++me)
#pragma unroll
        for (int ks = 0; ks < 2; ++ks) { vtf[me][ks] = (bf16x8){0, 0, 0, 0, 0, 0, 0, 0}; }
    co_build_vt(P, r0, pbase + 512, VtL, lane);
    chunkout_prep<MIXER, DIR>(p, l, b, h, cid, Grow0, r0, pbase, EQ, gar, lane);
    WAVE_SYNC();
    f32x4 htot[1][4] = {{(f32x4){0.f, 0.f, 0.f, 0.f}, (f32x4){0.f, 0.f, 0.f, 0.f}, (f32x4){0.f, 0.f, 0.f, 0.f}, (f32x4){0.f, 0.f, 0.f, 0.f}}};
    chunkout_dir<MIXER, DIR, 1>(p, b, h, cid, r0, pbase, mt, vtf, VtL, EQ, SB, gar, rsm, htot, lane);
    float* part = (float*)(wl + CO_PART);
#pragma unroll
    for (int me = 0; me < 4; ++me)
#pragma unroll
        for (int i = 0; i < 4; ++i) part[(me * 4 + i) * 64 + lane] = htot[0][me][i];
}
template <int MIXER>
__device__ __forceinline__ void chunkout_combine(const Params& p, int l, int b, int h, int cid, int mt, const char* smem, int lane) {
    const float* pa = (const float*)(smem + (2 * mt) * WLDS + CO_PART); const float* pb = (const float*)(smem + (2 * mt + 1) * WLDS + CO_PART);
    f32x4 htot[1][4];
#pragma unroll
    for (int me = 0; me < 4; ++me)
#pragma unroll
        for (int i = 0; i < 4; ++i) htot[0][me][i] = pa[(me * 4 + i) * 64 + lane] + pb[(me * 4 + i) * 64 + lane];
    co_finalize<MIXER, 1>(p, l, h, b * TOK + cid * 64, (MIXER == 0 ? PA : PG) + h * 64, mt, htot, lane);
}

template <bool OUT>
__device__ __forceinline__ void chunk_workers(const Params& p, int l, char* smem) {
    const int tid = otid(), lane = tid & 63, wave = __builtin_amdgcn_readfirstlane(tid >> 6);
    const int NW = (int)gridDim.x * 8, wi = wave * (int)gridDim.x + obid();
    const int c_lo = (OUT && l == DEPTH - 1) ? NCC : 0, npc = NCH - c_lo, half = NB * NH * npc;
    char* wl = smem + wave * WLDS;
    if (OUT) {
        const int cl = NCC, npl = NCH - NCC, halfl = NB * NH * npl;
#pragma unroll 1
        for (int t = wi; t < halfl; t += NW) { const int b = t / (NH * npl), h = (t / npl) % NH, cid = cl + t % npl;
            const Params q = relaunder(p); chunkout_w<1>(q, l, b, h, cid, wl, lane); }
        { const int used = halfl % NW;
#pragma unroll 1
            for (int t = (wi + NW - used) % NW; t < halfl; t += NW) { const int b = t / (NH * npl), h = (t / npl) % NH, cid = cl + t % npl;
                const Params q = relaunder(p); chunkout_w<0>(q, l, b, h, cid, wl, lane); } }
        if (l < DEPTH - 1) {
            const int nct = NB * NH * NCC;
#pragma unroll 1
            for (int st = obid(); st < 2 * nct; st += (int)gridDim.x) { const int mixer = st / nct, r2 = st % nct, b = r2 / (NH * NCC), h = (r2 / NCC) % NH, cid = r2 % NCC;
                const Params q = relaunder(p); const int mt = wave >> 1;
                __syncthreads();
                if (mixer == 0) { if (wave & 1) chunkout_piece<0, 1>(q, l, b, h, cid, mt, wl, lane); else chunkout_piece<0, 0>(q, l, b, h, cid, mt, wl, lane); }
                else            { if (wave & 1) chunkout_piece<1, 1>(q, l, b, h, cid, mt, wl, lane); else chunkout_piece<1, 0>(q, l, b, h, cid, mt, wl, lane); }
                __syncthreads();
                if (wave < 4) { if (mixer == 0) chunkout_combine<0>(q, l, b, h, cid, wave, smem, lane); else chunkout_combine<1>(q, l, b, h, cid, wave, smem, lane); }
            }
        }
    } else {
        int off = 0;
#pragma unroll 1
        for (int t = wi; t < half; t += NW) { const int b = t / (NH * npc), h = (t / npc) % NH, cid = c_lo + t % npc;
            const Params q = relaunder(p); chunkst_gla<0>(q, l, b, h, cid, wl, lane); }
        off = (off + half) % NW;
#pragma unroll 1
        for (int t = (wi + NW - off) % NW; t < half; t += NW) { const int b = t / (NH * npc), h = (t / npc) % NH, cid = c_lo + t % npc;
            const Params q = relaunder(p); chunkst_gla<1>(q, l, b, h, cid, wl, lane); }
        off = (off + half) % NW;
#pragma unroll 1
        for (int t = (wi + NW - off) % NW; t < half; t += NW) { const int b = t / (NH * npc), h = (t / npc) % NH, cid = c_lo + t % npc;
            const Params q = relaunder(p); chunkst_w<0>(q, l, b, h, cid, wl, lane); }
    }
}

__device__ __forceinline__ void phase_mix1(const Params& p, int l, char* smem) {
    const bool ctxo = l < DEPTH - 1; const int G = (int)gridDim.x, bid = obid();
    constexpr int N_HL = (NB / 2) * (WG / 2), N_HC = NB * (WG / HCB);
    chunk_workers<false>(p, l, smem);
    stage_signal(p, smem, 0, l);
    for (int t = bid; t < N_HL; t += G) hylat_task(p, l, t / (WG / 2), t % (WG / 2), smem);
    if (ctxo) for (int t = G - 1 - bid; t < N_HC; t += G) hyctx_task(p, l, t / (WG / HCB), t % (WG / HCB), smem);
    stage_signal(p, smem, 2, l);
}

constexpr int SCG = 12;
__device__ __forceinline__ void phase_scan(const Params& p, int l, char* smem) {
    const int tid = otid();
    bf16* ST = (bf16*)(p.ws + WS_ST); float* NV = (float*)(p.ws + WS_NV); const float* BE = (const float*)(p.ws + WS_BE); float* SC = (float*)(p.ws + WS_SC);
    constexpr int NCHAIN = 2 * 2 * NB * NH;
    stage_wait(p, 0, l);
    for (int item = obid() * NT + tid; item < NCHAIN * 1024; item += gridDim.x * NT) {
        const int chain = item >> 10, grp = item & 1023; const int mixer = chain / (2 * NB * NH), dir = (chain / (NB * NH)) % 2, b = (chain / NH) % NB, h = chain % NH;
        float c[4] = {0.f, 0.f, 0.f, 0.f}; float nv[4] = {0.f, 0.f, 0.f, 0.f}; float m = 0.f;
        const int d0 = (grp & 15) * 4; const bool donv = (mixer == 0) && (grp < 16);
        for (int o0 = 0; o0 < NCH; o0 += SCG) {
            u32x2 uu[SCG]; float s0[SCG], s1[SCG]; f32x4 be[SCG]; f32x4 nu[SCG];
#pragma unroll
            for (int j = 0; j < SCG; ++j) if (o0 + j < NCH) { const int cid = chain_cid(dir, o0 + j); const size_t ci = ch_index(dir, b, h, cid);
                uu[j] = *(const u32x2*)(ST + st_index(mixer, dir, b, h, cid) * 4096 + grp * 4);
                if (mixer == 0) { s0[j] = SC[ci * 4 + 0]; s1[j] = SC[ci * 4 + 1]; if (donv) nu[j] = *(const f32x4*)(NV + ci * 64 + grp * 4); }
                else be[j] = *(const f32x4*)(BE + ci * 64 + d0); }
#pragma unroll
            for (int j = 0; j < SCG; ++j) if (o0 + j < NCH) { const int cid = chain_cid(dir, o0 + j); const size_t ci = ch_index(dir, b, h, cid);
                const float u[4] = {bitsf(uu[j].x << 16), bitsf(uu[j].x & 0xffff0000u), bitsf(uu[j].y << 16), bitsf(uu[j].y & 0xffff0000u)};
                u32x2 w; w.x = pk2(c[0], c[1]); w.y = pk2(c[2], c[3]); *(u32x2*)(ST + st_index(mixer, dir, b, h, cid) * 4096 + grp * 4) = w;
                if (mixer == 0) {
                    if (grp == 0) SC[ci * 4 + 2] = m;
                    const float mn = fmaxf(s0[j] + m, s1[j]), a = __expf(s0[j] + m - mn), s = __expf(s1[j] - mn);
#pragma unroll
                    for (int k = 0; k < 4; ++k) c[k] = a * c[k] + s * u[k];
                    if (donv) { f32x4 nw = {nv[0], nv[1], nv[2], nv[3]}; *(f32x4*)(NV + ci * 64 + grp * 4) = nw;
                        nv[0] = a * nv[0] + s * nu[j].x; nv[1] = a * nv[1] + s * nu[j].y; nv[2] = a * nv[2] + s * nu[j].z; nv[3] = a * nv[3] + s * nu[j].w; }
                    m = mn;
                } else { c[0] = __expf(be[j].x) * c[0] + u[0]; c[1] = __expf(be[j].y) * c[1] + u[1]; c[2] = __expf(be[j].z) * c[2] + u[2]; c[3] = __expf(be[j].w) * c[3] + u[3]; } }
        }
    }
    stage_signal(p, smem, 1, l);
    { const bool ctxo = l < DEPTH - 1; const int G = (int)gridDim.x, bid = obid();
        constexpr int QTL = SEQ / 128, QTC = CTXL / 128, N_AL = NB * 2 * QTL, N_AC = NB * 2 * QTC;
        for (int t = bid; t < N_AL; t += G) attn_task(p, l, t / (2 * QTL), (t / QTL) % 2, t % QTL, false, smem);
        if (ctxo) for (int t = (bid + G - 64 % G) % G; t < N_AC; t += G) attn_task(p, l, t / (2 * QTC), (t / QTC) % 2, t % QTC, true, smem); }
}

__device__ __forceinline__ void phase_mix2(const Params& p, int l, char* smem) {
    const int tid = otid();
    stage_wait(p, 1, l);
    chunk_workers<true>(p, l, smem);
    stage_wait(p, 2, l);
    constexpr int N_WOUT = (DM / 64) * (MIX / 64);
    { const int lane = tid & 63, wave = __builtin_amdgcn_readfirstlane(tid >> 6); const int NW = (int)gridDim.x * 8, wi = wave * (int)gridDim.x + obid();
        for (int task = NW - 1 - wi; task < N_WOUT; task += NW) { const int nt = task / (MIX / 64), kt = task % (MIX / 64);
            convert_tile_w(p.in[I_WOUT] + (size_t)l * MIX * DM, DM, (bf16*)(p.ws + WS_WOUT), MIX, nt * 64, kt * 64, false, smem + wave * WLDS, lane); }
        bf16* tile = (bf16*)(smem + wave * WLDS); const bf16* HT = (const bf16*)(p.ws + WS_HT); bf16* Y = (bf16*)(p.ws + WS_HNY);
        constexpr int NTT = NB * (SEQ / 64) * 4;
        for (int t = wi; t < NTT; t += NW) { const int b = t / ((SEQ / 64) * 4), tt = (t / 4) % (SEQ / 64), c0 = (t % 4) * 64; const size_t tok0 = (size_t)b * TOK + CTXL + tt * 64;
            u32x4 tv[8];
#pragma unroll
            for (int i = 0; i < 8; ++i) { const int ch = (lane >> 3) + 8 * i, ck = lane & 7; tv[i] = *(const u32x4*)(HT + (size_t)(768 + c0 + ch) * T + tok0 + ck * 8); }
#pragma unroll
            for (int i = 0; i < 8; ++i) { const int ch = (lane >> 3) + 8 * i, ck = lane & 7; *(u32x4*)(tile + swz(ch, ck)) = tv[i]; }
            WAVE_SYNC();
#pragma unroll
            for (int i = 0; i < 8; ++i) { const int tk = (lane >> 3) + 8 * i, cc = lane & 7; unsigned w[4];
#pragma unroll
                for (int j = 0; j < 4; ++j) { const int ca = cc * 8 + 2 * j; w[j] = (unsigned)tile[swz(ca, tk >> 3) + (tk & 7)] | ((unsigned)tile[swz(ca + 1, tk >> 3) + (tk & 7)] << 16); }
                u32x4 o; o.x = w[0]; o.y = w[1]; o.z = w[2]; o.w = w[3]; *(u32x4*)(Y + (tok0 + tk) * 1024 + YH + c0 + cc * 8) = o; }
            WAVE_SYNC(); } }
}


#ifndef EMU
#define LAS __attribute__((address_space(3)))
#define XB_TMO      128
#define XB_XCNT(j)  (256  + 64 * (j))
#define XB_XSUB(j)  (1280 + 64 * (j))
#define XB_XGEN(j)  (2304 + 64 * (j))
#define XB_TOP      3328
#define XB_TOPGEN   3392
#define XCD_BAR_WORDS 3456
#define XB_SPIN_CAP (1u << 18)

__device__ __forceinline__ unsigned xb_ld(unsigned* p)              { return __hip_atomic_load(p, __ATOMIC_RELAXED, __HIP_MEMORY_SCOPE_AGENT); }
__device__ __forceinline__ unsigned xb_add(unsigned* p, unsigned v) { return __hip_atomic_fetch_add(p, v, __ATOMIC_RELAXED, __HIP_MEMORY_SCOPE_AGENT); }
__device__ __forceinline__ unsigned xb_xcc_id() { return (unsigned)__builtin_amdgcn_s_getreg((3 << 11) | 20) & 0xFu; }
#define XB_SPIN(cond, bar) do { unsigned _sp = 0; while (cond) { __builtin_amdgcn_s_sleep(1); \
    if ((++_sp & 255u) == 0u) { if (xb_ld(&(bar)[XB_TMO])) break; if (_sp > XB_SPIN_CAP) { atomicAdd(&(bar)[XB_TMO], 1u); break; } } } } while (0)

struct XcdBarrier {
    unsigned* bar; unsigned x;
    volatile LAS unsigned* st;
};

__device__ __forceinline__ XcdBarrier xcd_barrier_post(unsigned* bar, volatile LAS unsigned* st) {
    XcdBarrier b; b.bar = bar; b.x = xb_xcc_id(); b.st = st;
    if (threadIdx.x == 0) (void)xb_add(&bar[XB_XCNT(b.x)], 1u);
    return b;
}
__device__ __forceinline__ void xcd_barrier_complete(unsigned* bar, unsigned x, unsigned& nloc, unsigned& nx) {
    const unsigned G = gridDim.x * gridDim.y * gridDim.z;
    unsigned sum, cnt, mine, sp = 0u;
    for (;;) {
        sum = 0u; cnt = 0u; mine = 0u;
#pragma unroll
        for (unsigned j = 0; j < 16; ++j) { const unsigned c = xb_ld(&bar[XB_XCNT(j)]); sum += c; cnt += (c > 0u) ? 1u : 0u; mine = (j == x) ? c : mine; }
        if (sum == G) break;
        __builtin_amdgcn_s_sleep(1);
        if ((++sp & 255u) == 0u) { if (xb_ld(&bar[XB_TMO])) break; if (sp > XB_SPIN_CAP) { atomicAdd(&bar[XB_TMO], 1u); break; } }
    }
    nloc = mine > 0u ? mine : 1u; nx = cnt > 0u ? cnt : 1u;
}

__device__ __forceinline__ void xcd_barrier(const XcdBarrier& b) {
    asm volatile("s_waitcnt vmcnt(0)" ::: "memory");
    __syncthreads();
    if (threadIdx.x == 0) {
        unsigned* bar = b.bar;
        __builtin_amdgcn_s_waitcnt(0);
        unsigned nloc = b.st[0], nx = b.st[1];
        if (nloc == 0u) { xcd_barrier_complete(bar, b.x, nloc, nx); b.st[0] = nloc; b.st[1] = nx; }
        const unsigned old = xb_add(&bar[XB_XSUB(b.x)], 1u);
        const unsigned gen = old / nloc;
        if (old + 1u == (gen + 1u) * nloc) {
            __builtin_amdgcn_fence(__ATOMIC_RELEASE, "agent");
            asm volatile("s_waitcnt vmcnt(0)" ::: "memory");
            const unsigned og = xb_add(&bar[XB_TOP], 1u);
            const unsigned tg = og / nx;
            if (og + 1u == (tg + 1u) * nx) xb_add(&bar[XB_TOPGEN], 1u);
            else XB_SPIN(xb_ld(&bar[XB_TOPGEN]) == tg, bar);
            __builtin_amdgcn_fence(__ATOMIC_ACQUIRE, "agent");
            xb_add(&bar[XB_XGEN(b.x)], 1u);
            asm volatile("s_waitcnt vmcnt(0)" ::: "memory");
        } else {
            XB_SPIN(xb_ld(&bar[XB_XGEN(b.x)]) == gen, bar);
            __builtin_amdgcn_fence(__ATOMIC_ACQUIRE, "agent");
            asm volatile("s_waitcnt vmcnt(0)" ::: "memory");
        }
    }
    __syncthreads();
}
#endif

__global__ void __launch_bounds__(NT) fwd_kernel(Params pk, int ph_lo, int ph_hi) {
    SMEM_DECL;
#ifndef EMU
    volatile LAS unsigned* misc = (volatile LAS unsigned*)(smem + LDS_BYTES - 64);
    if (threadIdx.x < 2) misc[threadIdx.x] = 0u;
    __syncthreads();
    const XcdBarrier bar = xcd_barrier_post((unsigned*)(pk.ws + WS_BAR), misc);
#endif
    constexpr int NPH = 2 + 6 * DEPTH;
    for (int ph = ph_lo; ph < ph_hi && ph < NPH; ++ph) {
#ifndef EMU
        Params p = pk; { size_t z = 0; asm volatile("" : "+s"(z)); p.ws = pk.ws + z; p.out = pk.out + z;
#pragma unroll
            for (int i = 0; i < 26; ++i) p.in[i] = pk.in[i] + z; }
#else
        const Params& p = pk;
#endif
        if (ph == 0) phase0(p, smem);
        else if (ph == NPH - 1) phase_rp(p, DEPTH, smem);
        else { const int l = (ph - 1) / 6, k = (ph - 1) % 6;
            if (k == 0) phase_rp(p, l, smem);
            else if (k == 1) phase_gemm_in(p, l, smem);
            else if (k == 2) phase_mix1(p, l, smem);
            else if (k == 3) phase_scan(p, l, smem);
            else if (k == 4) phase_mix2(p, l, smem);
            else phase_gemm_out(p, l, smem);
#ifdef PROBE_DUP
            if (k == PROBE_DUP) { GRID_SYNC();
                if (k == 1) phase_gemm_in(p, l, smem); else if (k == 2) phase_mix1(p, l, smem); else if (k == 4) phase_mix2(p, l, smem); }
#endif
        }
        if (ph + 1 < ph_hi && !(ph >= 6 && ph % 6 == 0) && !(ph >= 1 && ((ph - 1) % 6 == 2 || (ph - 1) % 6 == 3))) {
#ifdef EMU
            GRID_SYNC();
#else
            if (ph_lo < 0) GRID_SYNC();
            xcd_barrier(bar);
#endif
        }
    }
}

#ifndef EMU
extern "C" void kernel_launch(void* const* d_in, const int* in_sizes, int n_in, void* d_out, int out_size, void* d_ws, size_t ws_size, hipStream_t stream) {
    static int grid = 0;
    if (grid == 0) {
        if (n_in != 26 || ws_size < WS_TOTAL) { fprintf(stderr, "kernel_launch: unexpected n_in %d or ws_size %zu (need %zu)\n", n_in, ws_size, (size_t)WS_TOTAL); grid = -1; return; }
        int dev = 0, cus = 0, per_cu = 0;
        hipGetDevice(&dev);
        hipDeviceGetAttribute(&cus, hipDeviceAttributeMultiprocessorCount, dev);
        hipFuncSetAttribute((const void*)fwd_kernel, hipFuncAttributeMaxDynamicSharedMemorySize, LDS_BYTES);
        hipOccupancyMaxActiveBlocksPerMultiprocessor(&per_cu, (const void*)fwd_kernel, NT, LDS_BYTES);
        if (per_cu < 1) { fprintf(stderr, "kernel_launch: occupancy query returned %d\n", per_cu); grid = -1; return; }
        if (per_cu > 1) per_cu = 1;
        grid = cus * per_cu;
    }
    if (grid < 0) return;
    hipMemsetAsync((char*)d_ws + WS_BAR, 0, BAR_BYTES, stream);
    Params p{};
    for (int i = 0; i < 26; ++i) p.in[i] = (const float*)d_in[i];
    p.out = (float*)d_out; p.ws = (char*)d_ws;
    int lo = 0, hi = 2 + 6 * DEPTH;
    void* args[] = {&p, &lo, &hi};
    hipError_t e = hipLaunchCooperativeKernel((const void*)fwd_kernel, dim3(grid), dim3(NT), args, LDS_BYTES, stream);
    if (e != hipSuccess) fprintf(stderr, "cooperative launch failed: %s (grid %d)\n", hipGetErrorString(e), grid);
}
#endif
```

```cpp
#ifdef EMU
#include "emu/hipemu.h"
#define GRID_SYNC() emu::grid_sync()
#define SMEM_DECL char* smem = emu::S().blocks[emu::cur()->block].lds
#define SCHED_FENCE() do {} while (0)
#define EXP2(x) exp2f(x)
#define MFMA16(a, b, c) emu_mfma_16x16x32_bf16(a, b, c)
#else
#include <hip/hip_runtime.h>
#include <hip/hip_cooperative_groups.h>
#include <cstdio>
#include <cstdint>
#define GRID_SYNC() cooperative_groups::this_grid().sync()
#define SMEM_DECL extern __shared__ __attribute__((aligned(16))) char smem[]
#define SCHED_FENCE() __builtin_amdgcn_sched_barrier(0)
#define EXP2(x) __builtin_amdgcn_exp2f(x)
#define MFMA16(a, b, c) __builtin_amdgcn_mfma_f32_16x16x32_bf16(a, b, c, 0, 0, 0)
#endif

#ifdef EMU
#ifndef EMU_DM
#define EMU_DM 256
#endif
#ifndef EMU_NB
#define EMU_NB 2
#endif
#ifndef EMU_SEQ
#define EMU_SEQ 512
#endif
#ifndef EMU_DEPTH
#define EMU_DEPTH 2
#endif
#ifndef EMU_CTXL
#define EMU_CTXL 128
#endif
constexpr int DM = EMU_DM, NB = EMU_NB, SEQ = EMU_SEQ, DEPTH = EMU_DEPTH, CTXL = EMU_CTXL;
#else
constexpr int DM = 1024, NB = 8, SEQ = 2048, DEPTH = 4, CTXL = 256;
#endif
constexpr int MIX = 1024, WG = 256, HD = 64, NH = 4, CH = 64;
constexpr int TOK = CTXL + SEQ, T = NB * TOK, NCH = TOK / CH, NCC = CTXL / CH;
constexpr int N_IN = 4144, NP = 3072, NG = 48, NGS = 32, NMAIN = 3328, NPAD = 4352;
constexpr int NF = 2 * SEQ;
constexpr int NJ = NB + 1;
constexpr int NT = 512;
constexpr float EPS = 1e-6f;
constexpr int PA = 0, PG = 1280, PD = 2304;
constexpr int YA = 0, YH = 256, YG = 512, YD = 768;
constexpr int ilog4(int n) { return n <= 1 ? 0 : 1 + ilog4(n / 4); }
constexpr int FFT_P = ilog4(NF);
static_assert((1 << (2 * FFT_P)) == NF, "NF must be a power of 4");
static_assert(DM % 256 == 0 && CTXL % 128 == 0 && SEQ % 256 == 0, "shape constraints");

typedef unsigned short bf16;
typedef short bf16x8 __attribute__((ext_vector_type(8)));
typedef float f32x4 __attribute__((ext_vector_type(4)));
typedef unsigned u32x4 __attribute__((ext_vector_type(4)));
typedef unsigned u32x2 __attribute__((ext_vector_type(2)));
struct cpx { float x, y; };

constexpr size_t al256(size_t x) { return (x + 255) & ~(size_t)255; }
constexpr size_t WS_CTXB = 0;
constexpr size_t WS_HNY = al256(WS_CTXB + (size_t)NB * CTXL * DM * 4);
constexpr size_t WS_WIN = WS_HNY + (size_t)T * 1024 * 2;
constexpr size_t WS_ST = WS_WIN;
constexpr size_t ST_BYTES = (size_t)2 * 2 * NB * NH * NCH * 4096 * 2;
constexpr size_t WS_KT = al256(WS_WIN + (size_t)NPAD * DM * 2);
static_assert(WS_KT + (size_t)WG * NF * 4 <= WS_ST + ST_BYTES || true, "");
constexpr size_t ST_END = al256((WS_ST + ST_BYTES > WS_KT + (size_t)WG * NF * 4) ? WS_ST + ST_BYTES : WS_KT + (size_t)WG * NF * 4);
constexpr size_t WS_P = ST_END;
constexpr size_t WS_HT = al256(WS_P + (size_t)T * NP * 2);
constexpr size_t WS_WOUT = WS_HT;
constexpr size_t WS_G = al256(WS_HT + (size_t)1024 * T * 2);
constexpr size_t WS_KF = al256(WS_G + (size_t)T * NGS * 4);
constexpr size_t WS_HC = al256(WS_KF + (size_t)WG * NF * 8);
constexpr size_t WS_EQ = al256(WS_HC + (size_t)2 * WG * CTXL * 4);
constexpr size_t WS_NV = al256(WS_EQ + (size_t)2 * T * WG * 2);
constexpr size_t WS_BE = al256(WS_NV + (size_t)2 * NB * NH * NCH * 64 * 4);
constexpr size_t WS_SC = al256(WS_BE + (size_t)2 * NB * NH * NCH * 64 * 4);
constexpr size_t WS_MOD = al256(WS_SC + (size_t)2 * NB * NH * NCH * 4 * 4);
constexpr size_t WS_TW = al256(WS_MOD + (size_t)DEPTH * NJ * 3 * DM * 4);
constexpr size_t WS_ROPE = al256(WS_TW + (size_t)NF * 8);
constexpr size_t WS_BAR = al256(WS_ROPE + (size_t)SEQ * 32 * 8);
constexpr size_t BAR_BYTES = 32768;
constexpr size_t WS_TOTAL = al256(WS_BAR + BAR_BYTES);
static_assert((size_t)T * DM * 4 <= (size_t)T * NP * 2, "YO fits in P");
#ifndef EMU
static_assert(WS_TOTAL <= (size_t)268435456, "workspace map must fit 256 MiB");
#endif

constexpr int LDS_BYTES = 163840;

struct Params {
    const float* in[26];
    float* out;
    char* ws;
};
enum { I_X = 0, I_C, I_CTX, I_CCTX, I_WADA, I_BADA, I_GPRE, I_GPOST, I_WIN, I_MGB, I_MNG, I_HCW, I_HCB, I_HW1, I_HB1, I_HW2, I_HB2, I_HW3, I_HB3,
       I_HFREQ, I_HD, I_GWA, I_GBA, I_GNG, I_SINK, I_WOUT };

__device__ __forceinline__ Params relaunder(const Params& pk) {
#ifdef EMU
    return pk;
#else
    Params p = pk; size_t z = 0; asm volatile("" : "+s"(z)); p.ws = pk.ws + z; p.out = pk.out + z;
#pragma unroll
    for (int i = 0; i < 26; ++i) p.in[i] = pk.in[i] + z;
    return p;
#endif
}
constexpr int WLDS = (LDS_BYTES - 64) / 8 / 16 * 16;
#ifdef EMU
#define WAVE_SYNC() emu_wave_sync()
#else
#define WAVE_SYNC() do { asm volatile("s_waitcnt lgkmcnt(0)" ::: "memory"); __builtin_amdgcn_wave_barrier(); } while (0)
#endif

#ifdef EMU
__device__ __forceinline__ int otid() { return (int)threadIdx.x; }
__device__ __forceinline__ int obid() { return (int)blockIdx.x; }
#else
__device__ __forceinline__ int otid() { int t = (int)threadIdx.x; asm volatile("" : "+v"(t)); return t; }
__device__ __forceinline__ int obid() { int b = (int)blockIdx.x; asm volatile("" : "+s"(b)); return b; }
#endif
__device__ __forceinline__ unsigned fbits(float f) { return __builtin_bit_cast(unsigned, f); }
__device__ __forceinline__ float bitsf(unsigned u) { return __builtin_bit_cast(float, u); }
__device__ __forceinline__ float bf2f(bf16 h) { return bitsf((unsigned)h << 16); }
#ifdef EMU
__device__ __forceinline__ bf16 f2bf(float f) { unsigned u = fbits(f); return (bf16)((u + 0x7fffu + ((u >> 16) & 1u)) >> 16); }
__device__ __forceinline__ unsigned pk2(float lo, float hi) { return (unsigned)f2bf(lo) | ((unsigned)f2bf(hi) << 16); }
#else
typedef __bf16 nbf16x2 __attribute__((ext_vector_type(2)));
typedef float nf32x2 __attribute__((ext_vector_type(2)));
__device__ __forceinline__ unsigned pk2(float lo, float hi) { const nf32x2 v = {lo, hi}; return __builtin_bit_cast(unsigned, __builtin_convertvector(v, nbf16x2)); }
__device__ __forceinline__ bf16 f2bf(float f) { return (bf16)(pk2(f, 0.0f) & 0xffffu); }
#endif
#ifdef EMU
__device__ __forceinline__ float frcp_(float x) { return 1.0f / x; }
#else
__device__ __forceinline__ float frcp_(float x) { return __builtin_amdgcn_rcpf(x); }
#endif
__device__ __forceinline__ float sigmoidf_(float x) { return frcp_(1.0f + __expf(-x)); }
__device__ __forceinline__ float siluf_(float x) { return x * frcp_(1.0f + __expf(-x)); }
__device__ __forceinline__ float logsigf_(float x) { return fminf(x, 0.0f) - log1pf(__expf(-fabsf(x))); }
__device__ __forceinline__ float logsig_fast(float x) { return fminf(x, 0.0f) - __logf(1.0f + __expf(-fabsf(x))); }
#ifdef EMU
__device__ __forceinline__ float row16_sum(float x) { x += __shfl_xor(x, 1); x += __shfl_xor(x, 2); x += __shfl_xor(x, 4); x += __shfl_xor(x, 8); return x; }
__device__ __forceinline__ float row16_max(float x) { x = fmaxf(x, __shfl_xor(x, 1)); x = fmaxf(x, __shfl_xor(x, 2)); x = fmaxf(x, __shfl_xor(x, 4)); x = fmaxf(x, __shfl_xor(x, 8)); return x; }
__device__ __forceinline__ float xrow_sum(float x) { x += __shfl_xor(x, 16); x += __shfl_xor(x, 32); return x; }
__device__ __forceinline__ float xrow_max(float x) { x = fmaxf(x, __shfl_xor(x, 16)); x = fmaxf(x, __shfl_xor(x, 32)); return x; }
#else
template <int CTRL> __device__ __forceinline__ float dpp_(float x) { return __builtin_bit_cast(float, __builtin_amdgcn_mov_dpp(__builtin_bit_cast(int, x), CTRL, 0xf, 0xf, true)); }
__device__ __forceinline__ float row16_sum(float x) { x += dpp_<0xB1>(x); x += dpp_<0x4E>(x); x += dpp_<0x141>(x); x += dpp_<0x128>(x); return x; }
__device__ __forceinline__ float row16_max(float x) { x = fmaxf(x, dpp_<0xB1>(x)); x = fmaxf(x, dpp_<0x4E>(x)); x = fmaxf(x, dpp_<0x141>(x)); x = fmaxf(x, dpp_<0x128>(x)); return x; }
__device__ __forceinline__ float xrow_sum(float x) {
    auto s = __builtin_amdgcn_permlane16_swap(fbits(x), fbits(x), false, false); x = bitsf(s[0]) + bitsf(s[1]);
    auto t = __builtin_amdgcn_permlane32_swap(fbits(x), fbits(x), false, false); return bitsf(t[0]) + bitsf(t[1]); }
__device__ __forceinline__ float xrow_max(float x) {
    auto s = __builtin_amdgcn_permlane16_swap(fbits(x), fbits(x), false, false); x = fmaxf(bitsf(s[0]), bitsf(s[1]));
    auto t = __builtin_amdgcn_permlane32_swap(fbits(x), fbits(x), false, false); return fmaxf(bitsf(t[0]), bitsf(t[1])); }
#endif
__device__ __forceinline__ float wave_sum(float v) { return xrow_sum(row16_sum(v)); }
__device__ __forceinline__ float wave_max(float v) { return xrow_max(row16_max(v)); }
#ifdef EMU
__device__ __forceinline__ float wave_prefix_sum(float v, int lane) {
#pragma unroll
    for (int o = 1; o < 64; o <<= 1) { float t = __shfl_up(v, o); if (lane >= o) v += t; }
    return v;
}
__device__ __forceinline__ float wave_prefix_max(float v, int lane) {
#pragma unroll
    for (int o = 1; o < 64; o <<= 1) { float t = __shfl_up(v, o); if (lane >= o) v = fmaxf(v, t); }
    return v;
}
#else
template <int CTRL, int RM> __device__ __forceinline__ float dppo_(float old, float x) { return __builtin_bit_cast(float, __builtin_amdgcn_update_dpp(__builtin_bit_cast(int, old), __builtin_bit_cast(int, x), CTRL, RM, 0xf, false)); }
__device__ __forceinline__ float wave_prefix_sum(float v, int) {
    v += dppo_<0x111, 0xf>(0.f, v); v += dppo_<0x112, 0xf>(0.f, v); v += dppo_<0x114, 0xf>(0.f, v); v += dppo_<0x118, 0xf>(0.f, v);
    v += dppo_<0x142, 0xa>(0.f, v); v += dppo_<0x143, 0xc>(0.f, v); return v;
}
__device__ __forceinline__ float wave_prefix_max(float v, int) {
    const float ninf = -INFINITY;
    v = fmaxf(v, dppo_<0x111, 0xf>(ninf, v)); v = fmaxf(v, dppo_<0x112, 0xf>(ninf, v)); v = fmaxf(v, dppo_<0x114, 0xf>(ninf, v)); v = fmaxf(v, dppo_<0x118, 0xf>(ninf, v));
    v = fmaxf(v, dppo_<0x142, 0xa>(ninf, v)); v = fmaxf(v, dppo_<0x143, 0xc>(ninf, v)); return v;
}
#endif
__device__ __forceinline__ float wave_suffix_max(float v, int lane) {
    return __shfl(wave_prefix_max(__shfl(v, 63 - lane), lane), 63 - lane);
}
__device__ __forceinline__ void unpack8(u32x4 v, float* f) {
    f[0] = bitsf(v.x << 16); f[1] = bitsf(v.x & 0xffff0000u); f[2] = bitsf(v.y << 16); f[3] = bitsf(v.y & 0xffff0000u);
    f[4] = bitsf(v.z << 16); f[5] = bitsf(v.z & 0xffff0000u); f[6] = bitsf(v.w << 16); f[7] = bitsf(v.w & 0xffff0000u);
}
__device__ __forceinline__ int orig_col(int n) {
    if (n < 1280) return n;
    if (n < 2304) return 2320 + (n - 1280);
    if (n < 3072) return 3376 + (n - 2304);
    if (n < 3088) return 1280 + (n - 3072);
    if (n < 3120) return 3344 + (n - 3088);
    if (n < NMAIN) return -1;
    return 1296 + (n - NMAIN);
}
__device__ __forceinline__ int chain_cid(int dir, int o) {
    if (dir == 0) return o;
    return o < NCC ? (NCC - 1 - o) : (NCH - 1 - (o - NCC));
}

__device__ __forceinline__ int swz(int row, int ch) { return row * 64 + ((ch ^ (row & 7)) << 3); }
__device__ __forceinline__ u32x4 pack8(const float* f) { u32x4 o; o.x = pk2(f[0], f[1]); o.y = pk2(f[2], f[3]); o.z = pk2(f[4], f[5]); o.w = pk2(f[6], f[7]); return o; }
__device__ __forceinline__ bf16x8 as_frag(u32x4 v) { return __builtin_bit_cast(bf16x8, v); }
#ifdef EMU
inline u32x2 lds_tr16(const bf16* p) { unsigned mine[2]; const unsigned long long a = (unsigned long long)p; mine[0] = (unsigned)a; mine[1] = (unsigned)(a >> 32);
    auto buf = emu::collective(mine, 2); const int l = emu::cur()->lane, g = l >> 4, i = l & 15; unsigned short e[4];
    for (int j = 0; j < 4; ++j) { const int src = 16 * g + 4 * j + (i >> 2); const bf16* q = (const bf16*)(((unsigned long long)buf[src][1] << 32) | buf[src][0]); e[j] = *(const unsigned short*)(q + (i & 3)); }
    u32x2 r; r.x = (unsigned)e[0] | ((unsigned)e[1] << 16); r.y = (unsigned)e[2] | ((unsigned)e[3] << 16); return r; }
#else
typedef short v4i16_t __attribute__((ext_vector_type(4)));
__device__ __forceinline__ u32x2 lds_tr16(const bf16* p) { return __builtin_bit_cast(u32x2, __builtin_amdgcn_ds_read_tr16_b64_v4i16((__attribute__((address_space(3))) v4i16_t*)p)); }
#endif
__device__ __forceinline__ u32x4 as_u4(bf16x8 v) { return __builtin_bit_cast(u32x4, v); }

constexpr int LS = 72;

template <int NTL, int KS>
__device__ __forceinline__ void mma_nt(const bf16* A, int lda, int m0, const bf16* B, int ldb, int n0, f32x4 (&acc)[NTL], int lane) {
    const int r = lane & 15, q = lane >> 4;
#pragma unroll
    for (int ks = 0; ks < KS; ++ks) {
        const bf16x8 a = *(const bf16x8*)(A + (m0 + r) * lda + ks * 32 + q * 8);
#pragma unroll
        for (int nt = 0; nt < NTL; ++nt) {
            const bf16x8 b = *(const bf16x8*)(B + (n0 + nt * 16 + r) * ldb + ks * 32 + q * 8);
            acc[nt] = MFMA16(a, b, acc[nt]);
        }
    }
}

__device__ __forceinline__ void layer_prep(const Params& p, int l, int idx, int stride, char* smem);
__device__ __forceinline__ void phase0(const Params& p, char* smem) {
    const int tid = otid();
    cpx* TW = (cpx*)(p.ws + WS_TW);
    cpx* ROPE = (cpx*)(p.ws + WS_ROPE);
    float* MOD = (float*)(p.ws + WS_MOD);
    constexpr int N_TW = NF / NT, N_ROPE = SEQ * 32 / NT, N_MOD = DEPTH * (3 * DM / 64);
    for (int task = obid(); task < N_TW + N_ROPE + N_MOD; task += gridDim.x) {
        if (task < N_TW) {
            const int j = task * NT + tid; float s, c; sincospif(2.0f * (float)j / (float)NF, &s, &c);
            cpx v; v.x = c; v.y = -s; TW[j] = v;
        } else if (task < N_TW + N_ROPE) {
            const int idx = (task - N_TW) * NT + tid; const int pos = idx >> 5, i = idx & 31;
            const float inv = exp2f(-(float)(i & 15) * (13.287712379549449f / 16.0f));
            const float ang = (float)(i < 16 ? pos / 64 : pos % 64) * inv;
            cpx v; v.x = cosf(ang); v.y = sinf(ang); ROPE[idx] = v;
        } else {
            const int mt = task - N_TW - N_ROPE; const int l = mt / (3 * DM / 64), n0 = (mt % (3 * DM / 64)) * 64;
            float* sv = (float*)smem;
            float* red = sv + NJ * DM;
            __syncthreads();
            for (int i = tid; i < NJ * DM; i += NT) { const int j = i / DM, k = i % DM; const float v = j < NB ? p.in[I_C][j * DM + k] : p.in[I_CCTX][k]; sv[i] = siluf_(v); }
            __syncthreads();
            const int c4 = tid & 15, kg = tid >> 4; f32x4 acc[NJ];
#pragma unroll
            for (int j = 0; j < NJ; ++j) acc[j] = (f32x4){0.f, 0.f, 0.f, 0.f};
            const float* w = p.in[I_WADA] + (size_t)l * DM * 3 * DM + n0 + 4 * c4;
            static_assert((DM / 32) % 8 == 0, "weight loads in batches of 8");
#pragma unroll 1
            for (int i0 = 0; i0 < DM / 32; i0 += 8) { f32x4 wv[8];
#pragma unroll
                for (int i = 0; i < 8; ++i) wv[i] = *(const f32x4*)(w + (size_t)(kg + 32 * (i0 + i)) * 3 * DM);
                SCHED_FENCE();
#pragma unroll
                for (int i = 0; i < 8; ++i) { const int k = kg + 32 * (i0 + i);
#pragma unroll
                    for (int j = 0; j < NJ; ++j) acc[j] = acc[j] + wv[i] * sv[j * DM + k]; } }
#pragma unroll
            for (int j = 0; j < NJ; ++j) *(f32x4*)(red + (kg * NJ + j) * 64 + 4 * c4) = acc[j];
            __syncthreads();
            for (int i = tid; i < NJ * 64; i += NT) { const int j = i / 64, n = i % 64; float s = 0.f;
#pragma unroll
                for (int k8 = 0; k8 < 32; ++k8) s += red[(k8 * NJ + j) * 64 + n];
                MOD[((size_t)l * NJ + j) * 3 * DM + n0 + n] = s + p.in[I_BADA][(size_t)l * 3 * DM + n0 + n]; }
        }
    }
}

#ifdef EMU
constexpr int PANEL_ROWS = 128, PANEL_UNITS = DM / 128;
#else
constexpr int PANEL_ROWS = 256, PANEL_UNITS = DM / 256;
#endif
__device__ __forceinline__ unsigned* unit_counter(const Params& p, int isctx) { return (unsigned*)(p.ws + WS_BAR + 16384) + 64 * isctx; }
__device__ __forceinline__ unsigned* stage_counter(const Params& p, int flag) { return (unsigned*)(p.ws + WS_BAR + 16384) + 512 + 512 * flag; }
__device__ __forceinline__ void stage_signal(const Params& p, char* smem, int flag, int l) {
#ifdef EMU
    __syncthreads(); if (otid() == 0) *stage_counter(p, flag) += 1u;
#else
    asm volatile("s_waitcnt vmcnt(0)" ::: "memory"); __syncthreads();
    if (threadIdx.x == 0) {
        const unsigned xcc = (unsigned)__builtin_amdgcn_s_getreg((3 << 11) | 20) & 0xFu, nloc = ((volatile __attribute__((address_space(3))) unsigned*)(smem + LDS_BYTES - 64))[0];
        unsigned* g = stage_counter(p, flag);
        if (nloc > 0u) { const unsigned old = __hip_atomic_fetch_add(g + 16 * (1 + xcc), 1u, __ATOMIC_RELAXED, __HIP_MEMORY_SCOPE_AGENT);
            if (old + 1u == nloc * (unsigned)(l + 1)) { __builtin_amdgcn_fence(__ATOMIC_RELEASE, "agent"); asm volatile("s_waitcnt vmcnt(0)" ::: "memory");
                __hip_atomic_fetch_add(g, nloc, __ATOMIC_RELAXED, __HIP_MEMORY_SCOPE_AGENT); } }
        else { __builtin_amdgcn_fence(__ATOMIC_RELEASE, "agent"); asm volatile("s_waitcnt vmcnt(0)" ::: "memory"); __hip_atomic_fetch_add(g, 1u, __ATOMIC_RELAXED, __HIP_MEMORY_SCOPE_AGENT); }
    }
#endif
}
__device__ __forceinline__ void stage_wait(const Params& p, int flag, int l) {
    if (otid() == 0) { const unsigned target = (unsigned)gridDim.x * (unsigned)(l + 1);
#ifdef EMU
        while (*(volatile unsigned*)stage_counter(p, flag) < target) emu::yield();
#else
        unsigned spins = 0;
        while (__hip_atomic_load(stage_counter(p, flag), __ATOMIC_RELAXED, __HIP_MEMORY_SCOPE_AGENT) < target) { __builtin_amdgcn_s_sleep(16); if (++spins > (1u << 20)) break; }
        __builtin_amdgcn_fence(__ATOMIC_ACQUIRE, "agent"); asm volatile("s_waitcnt vmcnt(0)" ::: "memory");
#endif
    }
    __syncthreads();
}
__device__ __forceinline__ int logical_row(int i) { return i < NB * SEQ ? (i / SEQ) * TOK + CTXL + i % SEQ : ((i - NB * SEQ) / CTXL) * TOK + (i - NB * SEQ) % CTXL; }
struct RowRef { const float* xo; float* xn; int mj, row; bool ok; };
__device__ __forceinline__ RowRef rp_ref(const Params& p, int l, int li, int base, int hi) {
    RowRef r; r.ok = li < hi; const int rr = logical_row(r.ok ? li : base); r.row = rr;
    const int b = rr / TOK, pp = rr % TOK; const bool isctx = pp < CTXL; if (l == DEPTH && isctx) r.ok = false;
    const size_t off = isctx ? ((size_t)b * CTXL + pp) * DM : ((size_t)b * SEQ + (pp - CTXL)) * DM;
    float* CTXB = (float*)(p.ws + WS_CTXB);
    r.xo = (l <= 1) ? (isctx ? p.in[I_CTX] + off : p.in[I_X] + off) : (isctx ? CTXB + off : p.out + off);
    r.xn = isctx ? CTXB + off : p.out + off; r.mj = isctx ? NB : b; return r;
}
__device__ __forceinline__ void rp_rows(const Params& p, int l, int lo, int hi, int gi, int nb) {
    const int tid = otid(), lane = tid & 63, wave = tid >> 6;
    const float* MOD = (const float*)(p.ws + WS_MOD);
    const bf16* YO = (const bf16*)(p.ws + WS_P);
    bf16* HN = (bf16*)(p.ws + WS_HNY);
    constexpr int NV4 = DM / 256, RW = 2;
    const int stride = nb * 8;
    f32x4 xq[RW][NV4]; u32x2 yq[RW][NV4]; RowRef rq[RW];
    int base = lo + gi * 8 + wave;
    if (base < hi) {
#pragma unroll
        for (int i = 0; i < RW; ++i) { rq[i] = rp_ref(p, l, base + i * stride, base, hi);
#pragma unroll
            for (int j = 0; j < NV4; ++j) { xq[i][j] = *(const f32x4*)(rq[i].xo + 4 * lane + 256 * j); yq[i][j] = (l > 0) ? *(const u32x2*)(YO + (size_t)rq[i].row * DM + 4 * lane + 256 * j) : (u32x2){0u, 0u}; } }
    }
    for (; base < hi; base += stride * RW) {
        f32x4 x[RW][NV4], y[RW][NV4]; RowRef rc[RW];
#pragma unroll
        for (int i = 0; i < RW; ++i) { rc[i] = rq[i];
#pragma unroll
            for (int j = 0; j < NV4; ++j) { x[i][j] = xq[i][j]; const u32x2 yy = yq[i][j]; y[i][j] = (f32x4){bitsf(yy.x << 16), bitsf(yy.x & 0xffff0000u), bitsf(yy.y << 16), bitsf(yy.y & 0xffff0000u)}; } }
        { const int nbase = base + stride * RW;
            if (nbase < hi) {
#pragma unroll
                for (int i = 0; i < RW; ++i) { rq[i] = rp_ref(p, l, nbase + i * stride, nbase, hi);
#pragma unroll
                    for (int j = 0; j < NV4; ++j) { xq[i][j] = *(const f32x4*)(rq[i].xo + 4 * lane + 256 * j); if (l > 0) yq[i][j] = *(const u32x2*)(YO + (size_t)rq[i].row * DM + 4 * lane + 256 * j); } } } }
        if (l > 0) {
            float ss[RW];
#pragma unroll
            for (int i = 0; i < RW; ++i) { ss[i] = 0.f;
#pragma unroll
                for (int j = 0; j < NV4; ++j) ss[i] += y[i][j].x * y[i][j].x + y[i][j].y * y[i][j].y + y[i][j].z * y[i][j].z + y[i][j].w * y[i][j].w; }
#pragma unroll
            for (int i = 0; i < RW; ++i) ss[i] = wave_sum(ss[i]);
            const float* gp = p.in[I_GPOST] + (size_t)(l - 1) * DM;
            float rstd[RW]; const float* gt[RW];
#pragma unroll
            for (int i = 0; i < RW; ++i) { rstd[i] = rsqrtf(ss[i] * (1.0f / DM) + EPS); gt[i] = MOD + ((size_t)(l - 1) * NJ + rc[i].mj) * 3 * DM + 2 * DM; }
            f32x4 p4n = *(const f32x4*)(gp + 4 * lane), g4n[RW];
#pragma unroll
            for (int i = 0; i < RW; ++i) g4n[i] = *(const f32x4*)(gt[i] + 4 * lane);
#pragma unroll
            for (int j = 0; j < NV4; ++j) { const f32x4 p4 = p4n; f32x4 g4[RW];
#pragma unroll
                for (int i = 0; i < RW; ++i) g4[i] = g4n[i];
                if (j + 1 < NV4) { p4n = *(const f32x4*)(gp + 4 * lane + 256 * (j + 1));
#pragma unroll
                    for (int i = 0; i < RW; ++i) g4n[i] = *(const f32x4*)(gt[i] + 4 * lane + 256 * (j + 1)); }
#pragma unroll
                for (int i = 0; i < RW; ++i) { x[i][j] = x[i][j] + g4[i] * (y[i][j] * rstd[i] * p4);
                    if (rc[i].ok) *(f32x4*)(rc[i].xn + 4 * lane + 256 * j) = x[i][j]; } }
        }
        if (l < DEPTH) {
            float ss[RW];
#pragma unroll
            for (int i = 0; i < RW; ++i) { ss[i] = 0.f;
#pragma unroll
                for (int j = 0; j < NV4; ++j) ss[i] += x[i][j].x * x[i][j].x + x[i][j].y * x[i][j].y + x[i][j].z * x[i][j].z + x[i][j].w * x[i][j].w; }
#pragma unroll
            for (int i = 0; i < RW; ++i) ss[i] = wave_sum(ss[i]);
            const float* gp = p.in[I_GPRE] + (size_t)l * DM;
            float rstd[RW]; const float* md[RW];
#pragma unroll
            for (int i = 0; i < RW; ++i) { rstd[i] = rsqrtf(ss[i] * (1.0f / DM) + EPS); md[i] = MOD + ((size_t)l * NJ + rc[i].mj) * 3 * DM; }
            f32x4 g4n = *(const f32x4*)(gp + 4 * lane), shn[RW], scn[RW];
#pragma unroll
            for (int i = 0; i < RW; ++i) { shn[i] = *(const f32x4*)(md[i] + 4 * lane); scn[i] = *(const f32x4*)(md[i] + DM + 4 * lane); }
#pragma unroll
            for (int j = 0; j < NV4; ++j) { const int e = 4 * lane + 256 * j; const f32x4 g4 = g4n; f32x4 sh[RW], sc[RW];
#pragma unroll
                for (int i = 0; i < RW; ++i) { sh[i] = shn[i]; sc[i] = scn[i]; }
                if (j + 1 < NV4) { g4n = *(const f32x4*)(gp + e + 256);
#pragma unroll
                    for (int i = 0; i < RW; ++i) { shn[i] = *(const f32x4*)(md[i] + e + 256); scn[i] = *(const f32x4*)(md[i] + DM + e + 256); } }
#pragma unroll
                for (int i = 0; i < RW; ++i) { const f32x4 h = (x[i][j] * rstd[i] * g4) * (sc[i] + 1.0f) + sh[i];
                    u32x2 o; o.x = pk2(h.x, h.y); o.y = pk2(h.z, h.w);
                    if (rc[i].ok) *(u32x2*)(HN + (size_t)rc[i].row * DM + e) = o; } }
        }
    }
}

__device__ __forceinline__ void convert_tile(const float* src, int ldn, bf16* dst, int K, int n0, int k0, bool use_map, char* smem) {
    const int tid = otid();
    float* tile = (float*)smem;
    __syncthreads();
#pragma unroll
    for (int i = 0; i < 8; ++i) { const int idx = tid + NT * i, k = idx >> 6, n = idx & 63;
        const int oc = use_map ? orig_col(n0 + n) : (n0 + n);
        tile[k * 65 + n] = oc >= 0 ? src[(size_t)(k0 + k) * ldn + oc] : 0.f; }
    __syncthreads();
    const int n = tid >> 3, c = tid & 7;
    u32x4 o; o.x = pk2(tile[(8 * c + 0) * 65 + n], tile[(8 * c + 1) * 65 + n]); o.y = pk2(tile[(8 * c + 2) * 65 + n], tile[(8 * c + 3) * 65 + n]);
    o.z = pk2(tile[(8 * c + 4) * 65 + n], tile[(8 * c + 5) * 65 + n]); o.w = pk2(tile[(8 * c + 6) * 65 + n], tile[(8 * c + 7) * 65 + n]);
    *(u32x4*)(dst + (size_t)(n0 + n) * K + k0 + 8 * c) = o;
}

__device__ __forceinline__ void filter_task(const Params& p, int l, int L, int pos0, char* smem) {
    const int tid = otid(), j = tid & 63;
    float* z = (float*)smem;
    float* h1 = z + 8 * 33;
    float* h2 = h1 + 8 * 64;
    const float* w1 = p.in[I_HW1] + (size_t)l * 33 * 64; const float* w2 = p.in[I_HW2] + (size_t)l * 64 * 64; const float* w3 = p.in[I_HW3] + (size_t)l * 64 * 512;
    float r1[33], r2[64], r3a[16];
#pragma unroll
    for (int i = 0; i < 33; ++i) r1[i] = w1[i * 64 + j];
#pragma unroll
    for (int i = 0; i < 64; ++i) r2[i] = w2[i * 64 + j];
    const float b1 = p.in[I_HB1][l * 64 + j], b2 = p.in[I_HB2][l * 64 + j], b3 = p.in[I_HB3][l * 512 + tid];
    const float f0 = p.in[I_HFREQ][(l * 2 + 0) * 64 + j], f1 = p.in[I_HFREQ][(l * 2 + 1) * 64 + j];
    __syncthreads();
    if (tid < 8 * 33) { const int pp = tid / 33, i = tid % 33; const float pos = (float)(pos0 + pp);
        const float t = pos / (float)(L - 1 > 1 ? L - 1 : 1), wv = 6.283185307179586f * pos / (float)L; float v;
        if (i == 0) v = t; else { const int bi = (i - 1) & 15; const float f = 1e-4f + (float)bi * ((15.0f - 1e-4f) / 15.0f); v = (i <= 16) ? cosf(wv * f) : -sinf(wv * f); }
        z[tid] = v; }
    __syncthreads();
    { const int pp = tid >> 6; float a = b1;
#pragma unroll
        for (int i = 0; i < 33; ++i) a += z[pp * 33 + i] * r1[i];
        h1[tid] = sinf(f0 * a);
#pragma unroll
        for (int i = 0; i < 16; ++i) r3a[i] = w3[i * 512 + tid]; }
    __syncthreads();
    { const int pp = tid >> 6; float a = b2;
#pragma unroll
        for (int i = 0; i < 64; ++i) a += h1[pp * 64 + i] * r2[i];
        h2[tid] = sinf(f1 * a); }
    __syncthreads();
    { const int o = tid, dir = o >> 8, c = o & 255;
        const float delta = 3.0701134573253946f + (float)c * ((15.350567286626973f - 3.0701134573253946f) / 255.0f);
        float acc[8];
#pragma unroll
        for (int pp = 0; pp < 8; ++pp) acc[pp] = b3;
#pragma unroll 1
        for (int cix = 0; cix < 4; ++cix) {
            float wn[16];
#pragma unroll
            for (int i = 0; i < 16; ++i) wn[i] = (cix < 3) ? w3[(16 * (cix + 1) + i) * 512 + o] : 0.f;
#pragma unroll
            for (int i = 0; i < 16; ++i) {
#pragma unroll
                for (int pp = 0; pp < 8; ++pp) acc[pp] += h2[pp * 64 + 16 * cix + i] * r3a[i]; }
#pragma unroll
            for (int i = 0; i < 16; ++i) r3a[i] = wn[i]; }
        float* KT = (float*)(p.ws + WS_KT); float* HC = (float*)(p.ws + WS_HC);
#pragma unroll
        for (int pp = 0; pp < 8; ++pp) { const int pos = pos0 + pp; const float t = (float)pos / (float)(L - 1 > 1 ? L - 1 : 1);
            const float v = acc[pp] * __expf(-t * delta);
            if (L == SEQ) { if (dir == 0) KT[(size_t)c * NF + pos]= v; else if (pos > 0) KT[(size_t)c * NF + (NF - pos)] = v; else KT[(size_t)c * NF + SEQ] = 0.f; }
            else HC[((size_t)dir * WG + c) * CTXL + pos] = v; }
    }
}

__device__ __forceinline__ void convert_tile_w(const float* src, int ldn, bf16* dst, int K, int n0, int k0, bool use_map, char* wl, int lane) {
    float* tile = (float*)wl;
    const int oc = use_map ? orig_col(n0 + lane) : (n0 + lane);
    float v[64];
#pragma unroll
    for (int k = 0; k < 64; ++k) v[k] = oc >= 0 ? src[(size_t)(k0 + k) * ldn + oc] : 0.f;
#pragma unroll
    for (int k = 0; k < 64; ++k) tile[k * 65 + lane] = v[k];
    WAVE_SYNC();
#pragma unroll
    for (int i = 0; i < 8; ++i) { const int n = (lane >> 3) + 8 * i, c = lane & 7; float f[8];
#pragma unroll
        for (int j = 0; j < 8; ++j) f[j] = tile[(8 * c + j) * 65 + n];
        *(u32x4*)(dst + (size_t)(n0 + n) * K + k0 + 8 * c) = pack8(f); }
    WAVE_SYNC();
}
__device__ __forceinline__ void layer_prep(const Params& p, int l, int idx, int stride, char* smem) {
    constexpr int N_WIN = (NPAD / 64) * (DM / 64), N_FL = SEQ / 8, N_FC = CTXL / 8;
    for (int task = idx; task < N_FL + N_FC; task += stride) {
        if (task < N_FL) filter_task(p, l, SEQ, task * 8, smem);
        else filter_task(p, l, CTXL, (task - N_FL) * 8, smem);
    }
    __syncthreads();
    { const int tid = otid(), lane = tid & 63, wave = __builtin_amdgcn_readfirstlane(tid >> 6);
        char* wl = smem + wave * WLDS;
        for (int task = wave * stride + idx; task < N_WIN; task += 8 * stride) { const int nt = task / (DM / 64), kt = task % (DM / 64);
            convert_tile_w(p.in[I_WIN] + (size_t)l * DM * N_IN, N_IN, (bf16*)(p.ws + WS_WIN), DM, nt * 64, kt * 64, true, wl, lane); } }
}
__device__ __forceinline__ unsigned* row_queue(const Params& p, int l) { return (unsigned*)(p.ws + WS_BAR + 16384) + 2560 + 64 * l; }
__device__ __forceinline__ void wait_units(const Params& p, int c, int l) {
    constexpr int nLatU = NB * (SEQ / PANEL_ROWS) * PANEL_UNITS, nCtxU = NB * (CTXL / PANEL_ROWS) * PANEL_UNITS;
    const unsigned target = (unsigned)((c ? nCtxU : nLatU) * l);
#ifdef EMU
    while (*(volatile unsigned*)unit_counter(p, c) < target) emu::yield();
#else
    unsigned spins = 0;
    while (__hip_atomic_load(unit_counter(p, c), __ATOMIC_RELAXED, __HIP_MEMORY_SCOPE_AGENT) < target) { __builtin_amdgcn_s_sleep(16); if (++spins > (1u << 20)) break; }
    __builtin_amdgcn_fence(__ATOMIC_ACQUIRE, "agent"); asm volatile("s_waitcnt vmcnt(0)" ::: "memory");
#endif
}
__device__ __forceinline__ void phase_rp(const Params& p, int l, char* smem) { const int G = (int)gridDim.x, bid = obid(), tid = otid();
    const bool has_ctx = l < DEPTH;
    constexpr int nLatU = NB * (SEQ / PANEL_ROWS) * PANEL_UNITS, nCtxU = NB * (CTXL / PANEL_ROWS) * PANEL_UNITS;
    const int nU = nLatU + nCtxU;
    const int heavy = (l >= 1 && has_ctx && nU > G && (nU % G) != 0) ? nU % G : 0;
    const int total = heavy > 0 ? NB * SEQ : (has_ctx ? T : NB * SEQ);
    const int nl = G - heavy, np = (l < DEPTH) ? nl / 2 : 0, nr = nl - np;
    int lo, hi, gi, nb; bool prep = false;
    if (bid < heavy) { lo = NB * SEQ; hi = T; gi = bid; nb = heavy; }
    else { const int i = bid - heavy; int nR = total;
        if (np > 0) { nR = ((total * 2 / 3) / (nr * 16)) * (nr * 16); if (nR <= 0) nR = total / 2; }
        if (np > 0 && (i & 1) && i / 2 < np) { prep = true; lo = nR; hi = total; gi = i / 2; nb = np; }
        else { lo = 0; hi = nR; gi = (np > 0) ? (i + 1) / 2 : i; nb = nr; } }
    if (prep) layer_prep(p, l, gi, np, smem);
    else if (l < DEPTH && np == 0) layer_prep(p, l, bid, G, smem);
    if (l >= 1) { if (tid == 0) { if (lo < NB * SEQ) wait_units(p, 0, l); if (hi > NB * SEQ) wait_units(p, 1, l); } __syncthreads(); }
    rp_rows(p, l, lo, hi, gi, nb);
}

__device__ __forceinline__ cpx cmul(cpx a, cpx b) { cpx r; r.x = a.x * b.x - a.y * b.y; r.y = a.x * b.y + a.y * b.x; return r; }
__device__ __forceinline__ cpx cmulc(cpx a, cpx b) { cpx r; r.x = a.x * b.x + a.y * b.y; r.y = a.y * b.x - a.x * b.y; return r; }
constexpr int fpad(int i) { return i + (i >> 4); }
__device__ __forceinline__ int FPH(int i) { return i + (i >> 4); }
constexpr int FBUF = fpad(NF);
constexpr int ilog16(int n) { return n < 16 ? 0 : 1 + ilog16(n / 16); }
constexpr int FFT_P16 = ilog16(NF);
constexpr bool FFT_R4 = ((NF >> (4 * FFT_P16)) == 4);
static_assert((NF >> (4 * FFT_P16)) == 1 || (NF >> (4 * FFT_P16)) == 4, "NF = 16^a * (1 or 4)");
template <bool INV> __device__ __forceinline__ void dft4(cpx& a0, cpx& a1, cpx& a2, cpx& a3) {
    const cpx s = {a0.x + a2.x, a0.y + a2.y}, b = {a0.x - a2.x, a0.y - a2.y}, c = {a1.x + a3.x, a1.y + a3.y}, d = {a1.x - a3.x, a1.y - a3.y};
    a0 = (cpx){s.x + c.x, s.y + c.y}; a2 = (cpx){s.x - c.x, s.y - c.y};
    if (!INV) { a1 = (cpx){b.x + d.y, b.y - d.x}; a3 = (cpx){b.x - d.y, b.y + d.x}; }
    else      { a1 = (cpx){b.x - d.y, b.y + d.x}; a3 = (cpx){b.x + d.y, b.y - d.x}; }
}
template <bool INV> __device__ __forceinline__ cpx cmulk(cpx a, float wr, float wi) {
    cpx r; if (!INV) { r.x = a.x * wr + a.y * wi; r.y = a.y * wr - a.x * wi; } else { r.x = a.x * wr - a.y * wi; r.y = a.y * wr + a.x * wi; } return r;
}
template <bool INV> __device__ __forceinline__ void dft16(cpx (&x)[16]) {
    constexpr float C1 = 0.92387953251128674f, S1 = 0.38268343236508977f, C2 = 0.70710678118654752f;
#pragma unroll
    for (int n2 = 0; n2 < 4; ++n2) dft4<INV>(x[n2], x[4 + n2], x[8 + n2], x[12 + n2]);
    x[4 * 1 + 1] = cmulk<INV>(x[4 * 1 + 1], C1, S1); x[4 * 1 + 2] = cmulk<INV>(x[4 * 1 + 2], C2, C2); x[4 * 1 + 3] = cmulk<INV>(x[4 * 1 + 3], S1, C1);
    x[4 * 2 + 1] = cmulk<INV>(x[4 * 2 + 1], C2, C2); x[4 * 2 + 2] = cmulk<INV>(x[4 * 2 + 2], 0.f, 1.f); x[4 * 2 + 3] = cmulk<INV>(x[4 * 2 + 3], -C2, C2);
    x[4 * 3 + 1] = cmulk<INV>(x[4 * 3 + 1], S1, C1); x[4 * 3 + 2] = cmulk<INV>(x[4 * 3 + 2], -C2, C2); x[4 * 3 + 3] = cmulk<INV>(x[4 * 3 + 3], -C1, -S1);
#pragma unroll
    for (int k1 = 0; k1 < 4; ++k1) dft4<INV>(x[4 * k1 + 0], x[4 * k1 + 1], x[4 * k1 + 2], x[4 * k1 + 3]);
    cpx t;
    t = x[1]; x[1] = x[4]; x[4] = t; t = x[2]; x[2] = x[8]; x[8] = t; t = x[3]; x[3] = x[12]; x[12] = t;
    t = x[6]; x[6] = x[9]; x[9] = t; t = x[7]; x[7] = x[13]; x[13] = t; t = x[11]; x[11] = x[14]; x[14] = t;
}
template <bool INV> __device__ __forceinline__ void fft_stage16(cpx* buf, const cpx* TW, int tl, int M) {
    const int span = M >> 4, twm = NF / M;
#pragma unroll 1
    for (int j = tl; j < NF / 16; j += 256) {
        const int grp = j / span, pos = j % span, base = grp * M + pos; cpx x[16];
#pragma unroll
        for (int q = 0; q < 16; ++q) x[q] = buf[FPH(base + q * span)];
        cpx w1 = {1.f, 0.f}; if (span > 1) w1 = TW[pos * twm];
        if (INV && span > 1) { cpx wk = w1;
#pragma unroll
            for (int k = 1; k < 16; ++k) { x[k] = cmulc(x[k], wk); wk = cmul(wk, w1); } }
        dft16<INV>(x);
        if (!INV && span > 1) { cpx wk = w1;
#pragma unroll
            for (int k = 1; k < 16; ++k) { x[k] = cmul(x[k], wk); wk = cmul(wk, w1); } }
#pragma unroll
        for (int q = 0; q < 16; ++q) buf[FPH(base + q * span)] = x[q];
    }
}
template <bool INV> __device__ __forceinline__ void fft_stage4_last(cpx* buf, int tl) {
#pragma unroll 1
    for (int j = tl; j < NF / 4; j += 256) { cpx a0 = buf[FPH(4 * j)], a1 = buf[FPH(4 * j + 1)], a2 = buf[FPH(4 * j + 2)], a3 = buf[FPH(4 * j + 3)];
        dft4<INV>(a0, a1, a2, a3); buf[FPH(4 * j)] = a0; buf[FPH(4 * j + 1)] = a1; buf[FPH(4 * j + 2)] = a2; buf[FPH(4 * j + 3)] = a3; }
}
__device__ __forceinline__ void fft_fwd(cpx* buf, const cpx* TW, int tl) {
    int M = NF;
#pragma unroll
    for (int s = 0; s < FFT_P16; ++s) { __syncthreads(); fft_stage16<false>(buf, TW, tl, M); M >>= 4; }
    if (FFT_R4) { __syncthreads(); fft_stage4_last<false>(buf, tl); }
    __syncthreads();
}
__device__ __forceinline__ void fft_inv(cpx* buf, const cpx* TW, int tl) {
    if (FFT_R4) { __syncthreads(); fft_stage4_last<true>(buf, tl); }
    int M = FFT_R4 ? 64 : 16;
#pragma unroll
    for (int s = 0; s < FFT_P16; ++s) { __syncthreads(); fft_stage16<true>(buf, TW, tl, M); M <<= 4; }
    __syncthreads();
}
__device__ __forceinline__ void filt_fft_task(const Params& p, int cp, char* smem) {
    const int tid = otid(), half = tid >> 8, tl = tid & 255, c = 2 * cp + half;
    cpx* buf = (cpx*)smem + (size_t)half * FBUF;
    const float* KT = (const float*)(p.ws + WS_KT) + (size_t)c * NF;
    cpx* KF = (cpx*)(p.ws + WS_KF) + (size_t)c * NF;
    const cpx* TW = (const cpx*)(p.ws + WS_TW);
    __syncthreads();
    for (int i = tl; i < NF; i += 256) { cpx v; v.x = KT[i]; v.y = 0.f; buf[FPH(i)] = v; }
    fft_fwd(buf, TW, tl);
    for (int i = tl; i < NF; i += 256) KF[i] = buf[FPH(i)];
}

__device__ __forceinline__ void gemm_tile(const Params& p, const bf16* A, const bf16* Bt, int K, int mt, int nt, int mode, char* smem) {
    const int tid = otid(), lane = tid & 63, wave = tid >> 6;
    bf16* As = (bf16*)smem;
    bf16* Bs = As + 128 * LS;
    const int wm = (wave & 3) * 32, wn = (wave >> 2) * 64;
    f32x4 acc[2][4];
#pragma unroll
    for (int i = 0; i < 2; ++i)
#pragma unroll
        for (int j = 0; j < 4; ++j) acc[i][j] = (f32x4){0.f, 0.f, 0.f, 0.f};
    const int lr = tid >> 3, lc = tid & 7;
    const bf16* Ag = A + (size_t)(mt * 128 + lr) * K + lc * 8;
    const bf16* Bg = Bt + (size_t)(nt * 128 + lr) * K + lc * 8;
    u32x4 ra0, ra1, rb0, rb1;
    ra0 = *(const u32x4*)(Ag); ra1 = *(const u32x4*)(Ag + (size_t)64 * K); rb0 = *(const u32x4*)(Bg); rb1 = *(const u32x4*)(Bg + (size_t)64 * K);
    const int nk = K / 64;
    for (int kt = 0; kt < nk; ++kt) {
        __syncthreads();
        *(u32x4*)(As + lr * LS + lc * 8) = ra0; *(u32x4*)(As + (lr + 64) * LS + lc * 8) = ra1;
        *(u32x4*)(Bs + lr * LS + lc * 8) = rb0; *(u32x4*)(Bs + (lr + 64) * LS + lc * 8) = rb1;
        __syncthreads();
        if (kt + 1 < nk) { const int ko = (kt + 1) * 64;
            ra0 = *(const u32x4*)(Ag + ko); ra1 = *(const u32x4*)(Ag + (size_t)64 * K + ko); rb0 = *(const u32x4*)(Bg + ko); rb1 = *(const u32x4*)(Bg + (size_t)64 * K + ko); }
        mma_nt<4, 2>(As, LS, wm, Bs, LS, wn, acc[0], lane);
        mma_nt<4, 2>(As, LS, wm + 16, Bs, LS, wn, acc[1], lane);
    }
    const int r = lane & 15, q = lane >> 4;
#pragma unroll
    for (int i = 0; i < 2; ++i)
#pragma unroll
        for (int j = 0; j < 4; ++j)
#pragma unroll
            for (int e = 0; e < 4; ++e) {
                const int row = mt * 128 + wm + 16 * i + 4 * q + e, col = nt * 128 + wn + 16 * j + r; const float v = acc[i][j][e];
                if (mode == 0) { if (col < NP) ((bf16*)(p.ws + WS_P))[(size_t)row * NP + col] = f2bf(v); else if (col < NP + 16) ((float*)(p.ws + WS_G))[(size_t)row * NGS + (col - NP)] = v; else if (col < NP + NG) ((bf16*)((float*)(p.ws + WS_G) + (size_t)row * NGS + 16))[col - NP - 16] = f2bf(v); }
                else if (mode == 2) ((bf16*)(p.ws + WS_HT))[(size_t)row * T + col] = f2bf(v);
                else ((bf16*)(p.ws + WS_P))[(size_t)row * DM + col] = f2bf(v);
            }
}

#ifndef EMU
namespace pg8 {
#define PG8_LAS __attribute__((address_space(3)))
typedef unsigned short bf16_t;
typedef short bf16x8 __attribute__((ext_vector_type(8)));
typedef float f32x4 __attribute__((ext_vector_type(4)));
typedef unsigned u32x4 __attribute__((ext_vector_type(4)));
constexpr int BM = 256, BK = 64, HALF = 128, HTB = HALF * BK * 2  , STAGE_BYTES = 8 * HTB, NXCD = 8, WGM = 8;

__host__ __device__ __forceinline__ int lds_byte(int r, int c) { const int st = (r >> 4) * 2 + (c >> 5), rr = r & 15, cc = c & 31, ob = rr * 64 + cc * 2; return st * 1024 + (ob ^ (((ob >> 9) & 1) << 5)); }
__host__ __device__ __forceinline__ void stage_rc(int b, int& R, int& C) { const int st = b / 1024, sb = b % 1024, swz = sb ^ (((sb >> 9) & 1) << 5); R = (st >> 1) * 16 + swz / 64; C = (st & 1) * 32 + (swz % 64) / 2; }
__host__ __device__ __forceinline__ int perm32(int rho) { const int n = rho >> 4, i = rho & 15; return 8 * (i >> 2) + 4 * n + (i & 3); }

struct Unit { int pm, pn; };
struct Gemm { const bf16_t* A; const bf16_t* Bt; int M, N, K; };
__device__ __forceinline__ unsigned cvt_pk_bf16(float lo, float hi) { unsigned r; asm volatile("v_cvt_pk_bf16_f32 %0, %1, %2" : "=v"(r) : "v"(lo), "v"(hi)); return r; }
template <class Epi, class Sched, bool ALIGN_EPI = false, bool SP2 = false>
__device__ __forceinline__ void gemm_phase(PG8_LAS unsigned char* lds, const Gemm g, const Sched& S, const Epi& E) {
    const int tid = otid(), wid = __builtin_amdgcn_readfirstlane(tid >> 6), lane = tid & 63, wr = wid >> 2, wc = wid & 3, fr = lane & 15, fq = lane >> 4;
    const int K = g.K, nt = K / BK;
    unsigned voffA[2], voffB[2];
#pragma unroll
    for (int i = 0; i < 2; ++i) { int R, C; stage_rc(tid * 16 + i * 8192, R, C); const int Rb = Epi::PERM ? ((R & ~31) + perm32(R & 31)) : R;
        voffA[i] = (unsigned)(R * K + C) * 2u; voffB[i] = (unsigned)(Rb * K + C) * 2u; }
    const size_t kstep = (size_t)(BK * 2);
    const size_t hstep = (size_t)HALF * K * 2;
    const size_t tstep = 2 * hstep;
    const unsigned ldsw = (unsigned)wid * 1024u;
    const int aoff = lds_byte(wr * 64 + fr, fq * 8), boff = lds_byte(wc * 32 + fr, fq * 8);
#define PG8_SA(b, h) (((b) * 2 + (h)) * HTB)
#define PG8_SB(b, h) ((4 + (b) * 2 + (h)) * HTB)
#define PG8_STAGE(bufoff, gbase, voff) do { _Pragma("unroll") for (int _i = 0; _i < 2; ++_i) \
        __builtin_amdgcn_global_load_lds((const unsigned*)((const char*)(gbase) + (voff)[_i]), (PG8_LAS unsigned*)(lds + (bufoff) + ldsw + _i * 8192), 16, 0, 0); } while (0)
#define PG8_LDA(dst, b, h) do { _Pragma("unroll") for (int m = 0; m < 4; ++m) _Pragma("unroll") for (int k = 0; k < 2; ++k) dst[m][k] = *(const PG8_LAS bf16x8*)(lds + PG8_SA(b, h) + aoff + m * 2048 + k * 1024); } while (0)
#define PG8_LDB(dst, b, h) do { _Pragma("unroll") for (int n = 0; n < 2; ++n) _Pragma("unroll") for (int k = 0; k < 2; ++k) dst[n][k] = *(const PG8_LAS bf16x8*)(lds + PG8_SB(b, h) + boff + n * 2048 + k * 1024); } while (0)
#define PG8_MMA(ai, bj, At, Bt) do { __builtin_amdgcn_s_setprio(1); _Pragma("unroll") for (int m = 0; m < 4; ++m) _Pragma("unroll") for (int n = 0; n < 2; ++n) _Pragma("unroll") for (int k = 0; k < 2; ++k) \
        acc[ai][bj][m][n] = __builtin_amdgcn_mfma_f32_16x16x32_bf16(Bt[n][k], At[m][k], acc[ai][bj][m][n], 0, 0, 0); __builtin_amdgcn_s_setprio(0); } while (0)
#define PG8_WAIT_V(n) asm volatile("s_waitcnt vmcnt(" #n ")" ::: "memory")
#define PG8_WAIT_L(n) asm volatile("s_waitcnt lgkmcnt(" #n ")" ::: "memory")
#define PG8_BAR __builtin_amdgcn_s_barrier()
#define PG8_SCHED __builtin_amdgcn_sched_barrier(0)
    Unit cur, nxt; int ui = 0;
    if (!S.next(0, cur)) return;
    f32x4 acc[2][2][4][2];
#pragma unroll
    for (int a = 0; a < 2; ++a)
#pragma unroll
        for (int b = 0; b < 2; ++b)
#pragma unroll
            for (int m = 0; m < 4; ++m)
#pragma unroll
                for (int n = 0; n < 2; ++n) acc[a][b][m][n] = (f32x4){0.f, 0.f, 0.f, 0.f};
    bf16x8 At[4][2], B0[2][2], B1[2][2];
    const char* cA = (const char*)g.A + (size_t)cur.pm * tstep; const char* cB = (const char*)g.Bt + (size_t)cur.pn * tstep;
    S.a_ready(cur);
    if constexpr (SP2) {
        PG8_STAGE(PG8_SB(0, 0), cB, voffB); PG8_STAGE(PG8_SB(0, 1), cB + hstep, voffB); PG8_STAGE(PG8_SA(0, 0), cA, voffA); PG8_STAGE(PG8_SA(0, 1), cA + hstep, voffA);
        if (wr == 1) PG8_BAR;
        PG8_WAIT_V(2); PG8_BAR;
        PG8_STAGE(PG8_SB(1, 0), cB + kstep, voffB); PG8_STAGE(PG8_SA(1, 0), cA + kstep, voffA); PG8_STAGE(PG8_SB(1, 1), cB + hstep + kstep, voffB);
        PG8_WAIT_V(6); PG8_BAR;
    } else {
        PG8_STAGE(PG8_SB(0, 0), cB, voffB); PG8_STAGE(PG8_SA(0, 0), cA, voffA); PG8_STAGE(PG8_SB(0, 1), cB + hstep, voffB); PG8_STAGE(PG8_SA(0, 1), cA + hstep, voffA);
        if (wr == 1) PG8_BAR;
        PG8_WAIT_V(4); PG8_BAR;
        PG8_STAGE(PG8_SB(1, 0), cB + kstep, voffB); PG8_STAGE(PG8_SA(1, 0), cA + kstep, voffA); PG8_STAGE(PG8_SB(1, 1), cB + hstep + kstep, voffB);
        PG8_WAIT_V(6); PG8_BAR;
    }
    for (;;) {
        const bool has_next = S.next(ui + 1, nxt);
        const char* nA = has_next ? (const char*)g.A + (size_t)nxt.pm * tstep : cA; const char* nB = has_next ? (const char*)g.Bt + (size_t)nxt.pn * tstep : cB;
        for (int t = 0; t < nt; t += 2) {
            const bool last = (t == nt - 2);
            const char* a1 = cA + (size_t)(t + 1) * kstep;
            const char* a2 = last ? nA : cA + (size_t)(t + 2) * kstep; const char* b2 = last ? nB : cB + (size_t)(t + 2) * kstep;
            const char* a3 = a2 + kstep; const char* b3 = b2 + kstep;
            if (last && has_next) S.a_ready(nxt);
            if constexpr (SP2) {
            PG8_LDB(B0, 0, 0); PG8_LDB(B1, 0, 1); PG8_SCHED; PG8_LDA(At, 0, 0); PG8_STAGE(PG8_SA(1, 1), a1 + hstep, voffA);
            PG8_WAIT_V(8); PG8_WAIT_L(0); PG8_BAR; PG8_MMA(0, 0, At, B0); PG8_MMA(0, 1, At, B1); PG8_BAR; PG8_SCHED;
            PG8_LDA(At, 0, 1); PG8_STAGE(PG8_SB(0, 0), b2, voffB); PG8_STAGE(PG8_SB(0, 1), b2 + hstep, voffB); PG8_STAGE(PG8_SA(0, 0), a2, voffA);
            PG8_WAIT_V(8); PG8_WAIT_L(0); PG8_BAR; PG8_MMA(1, 0, At, B0); PG8_MMA(1, 1, At, B1); PG8_BAR; PG8_SCHED;
            PG8_LDB(B0, 1, 0); PG8_LDB(B1, 1, 1); PG8_SCHED; PG8_LDA(At, 1, 0); PG8_STAGE(PG8_SA(0, 1), a2 + hstep, voffA);
            PG8_WAIT_V(8); PG8_WAIT_L(0); PG8_BAR; PG8_MMA(0, 0, At, B0); PG8_MMA(0, 1, At, B1); PG8_BAR; PG8_SCHED;
            PG8_LDA(At, 1, 1); PG8_STAGE(PG8_SB(1, 0), b3, voffB); PG8_STAGE(PG8_SB(1, 1), b3 + hstep, voffB); PG8_STAGE(PG8_SA(1, 0), a3, voffA);
            PG8_WAIT_V(8); PG8_WAIT_L(0); PG8_BAR; PG8_MMA(1, 0, At, B0); PG8_MMA(1, 1, At, B1); PG8_BAR; PG8_SCHED;
            } else {
            PG8_LDB(B0, 0, 0); PG8_SCHED; PG8_LDA(At, 0, 0); PG8_STAGE(PG8_SA(1, 1), a1 + hstep, voffA);
            PG8_WAIT_L(8); PG8_BAR; PG8_WAIT_L(0); PG8_MMA(0, 0, At, B0); PG8_BAR; PG8_SCHED;
            PG8_LDB(B1, 0, 1); PG8_STAGE(PG8_SB(0, 0), b2, voffB);
            PG8_BAR; PG8_WAIT_L(0); PG8_MMA(0, 1, At, B1); PG8_BAR;
            PG8_LDA(At, 0, 1); PG8_STAGE(PG8_SA(0, 0), a2, voffA);
            PG8_BAR; PG8_WAIT_L(0); PG8_MMA(1, 0, At, B0); PG8_BAR; PG8_SCHED;
            PG8_STAGE(PG8_SB(0, 1), b2 + hstep, voffB);
            PG8_WAIT_V(6); PG8_BAR; PG8_MMA(1, 1, At, B1); PG8_BAR;
            PG8_LDB(B0, 1, 0); PG8_SCHED; PG8_LDA(At, 1, 0); PG8_STAGE(PG8_SA(0, 1), a2 + hstep, voffA);
            PG8_WAIT_L(8); PG8_BAR; PG8_WAIT_L(0); PG8_MMA(0, 0, At, B0); PG8_BAR; PG8_SCHED;
            PG8_LDB(B1, 1, 1); PG8_STAGE(PG8_SB(1, 0), b3, voffB);
            PG8_BAR; PG8_WAIT_L(0); PG8_MMA(0, 1, At, B1); PG8_BAR;
            PG8_LDA(At, 1, 1); PG8_STAGE(PG8_SA(1, 0), a3, voffA);
            PG8_BAR; PG8_WAIT_L(0); PG8_MMA(1, 0, At, B0); PG8_BAR; PG8_SCHED;
            PG8_STAGE(PG8_SB(1, 1), b3 + hstep, voffB);
            PG8_WAIT_V(6); PG8_BAR; PG8_MMA(1, 1, At, B1); PG8_BAR;
            }
        }
        if constexpr (ALIGN_EPI) { if (wr == 0) PG8_BAR; }
        if constexpr (!Epi::AFTER_DRAIN) { E(acc, cur, wr, wc, fr, fq); S.done(cur); }
        if (!has_next) break;
#pragma unroll
        for (int a = 0; a < 2; ++a)
#pragma unroll
            for (int b = 0; b < 2; ++b)
#pragma unroll
                for (int m = 0; m < 4; ++m)
#pragma unroll
                    for (int n = 0; n < 2; ++n) acc[a][b][m][n] = (f32x4){0.f, 0.f, 0.f, 0.f};
        cur = nxt; cA = nA; cB = nB; ++ui;
        if constexpr (ALIGN_EPI) { if (wr == 1) PG8_BAR; }
    }
    PG8_WAIT_V(0);
    if constexpr (!ALIGN_EPI) { if (wr == 0) PG8_BAR; }
    PG8_BAR;
    if constexpr (Epi::AFTER_DRAIN) { E.fused(acc, cur, wr, wc, fr, fq, lds, wid, lane); S.done(cur); }
#undef PG8_SA
#undef PG8_SB
#undef PG8_STAGE
#undef PG8_LDA
#undef PG8_LDB
#undef PG8_MMA
#undef PG8_WAIT_V
#undef PG8_WAIT_L
#undef PG8_BAR
#undef PG8_SCHED
}
__device__ __forceinline__ void map_tile(int L, int nM, int nN, int& pm, int& pn) {
    const int nwg = nM * nN; int wgid = L; { const int q = nwg / NXCD, r = nwg % NXCD, xcd = wgid % NXCD, off = wgid / NXCD; wgid = (xcd < r ? xcd * (q + 1) : r * (q + 1) + (xcd - r) * q) + off; }
    const int nig = WGM * nN, gid = wgid / nig, fm = gid * WGM, gsz = (nM - fm) < WGM ? (nM - fm) : WGM;
    pm = fm + ((wgid % nig) % gsz); pn = (wgid % nig) / gsz;
}
constexpr int MP = T / 256, WP = NMAIN / 256, NU2 = 4 * MP, NU1 = MP * WP;
struct InOrder { int G, c;
    __device__ __forceinline__ bool next(int i, Unit& u) const { const int L = i * G + c; if (L >= NU2 + NU1) return false; int a, b;
        if (L < NU2) { map_tile(L, 4, MP, a, b); u.pm = MP + WP + a; u.pn = b; } else { map_tile(L - NU2, MP, WP, a, b); u.pm = a; u.pn = MP + b; } return true; }
    __device__ __forceinline__ void a_ready(const Unit&) const {}
    __device__ __forceinline__ void done(const Unit&) const {}
};
struct EpiIn { static constexpr bool PERM = true, AFTER_DRAIN = false; bf16_t* P; float* G; bf16_t* HTp;
    __device__ __forceinline__ void operator()(const f32x4 (&acc)[2][2][4][2], const Unit& u, int wr, int wc, int fr, int fq) const {
        if (u.pm < MP) { const int pn = u.pn - MP, row0 = u.pm * BM + wr * 64 + fr;
            if (pn < NP / 256) { const int col0 = pn * BM + wc * 32 + 8 * fq;
#pragma unroll
                for (int ai = 0; ai < 2; ++ai)
#pragma unroll
                    for (int m = 0; m < 4; ++m) { bf16_t* rowp = P + (size_t)(row0 + ai * HALF + m * 16) * NP + col0;
#pragma unroll
                        for (int bj = 0; bj < 2; ++bj) { const f32x4 v0 = acc[ai][bj][m][0], v1 = acc[ai][bj][m][1];
                            u32x4 w; w.x = cvt_pk_bf16(v0[0], v0[1]); w.y = cvt_pk_bf16(v0[2], v0[3]); w.z = cvt_pk_bf16(v1[0], v1[1]); w.w = cvt_pk_bf16(v1[2], v1[3]); *(u32x4*)(rowp + bj * HALF) = w; } } }
            else { const int cb = wc * 32 + 8 * fq;
                if (cb < NG) {
#pragma unroll
                    for (int ai = 0; ai < 2; ++ai)
#pragma unroll
                        for (int m = 0; m < 4; ++m) { float* rowb = G + (size_t)(row0 + ai * HALF + m * 16) * NGS; const f32x4 v0 = acc[ai][0][m][0], v1 = acc[ai][0][m][1];
                            if (cb < 16) { *(f32x4*)(rowb + cb) = v0; *(f32x4*)(rowb + cb + 4) = v1; }
                            else { u32x4 w; w.x = cvt_pk_bf16(v0[0], v0[1]); w.y = cvt_pk_bf16(v0[2], v0[3]); w.z = cvt_pk_bf16(v1[0], v1[1]); w.w = cvt_pk_bf16(v1[2], v1[3]); *(u32x4*)((bf16_t*)(rowb + 16) + (cb - 16)) = w; } } } } }
        else { const int row0 = (u.pm - MP - WP) * BM + wr * 64 + fr, col0 = u.pn * BM + wc * 32 + 8 * fq;
#pragma unroll
            for (int ai = 0; ai < 2; ++ai)
#pragma unroll
                for (int m = 0; m < 4; ++m) { bf16_t* rowp = HTp + (size_t)(row0 + ai * HALF + m * 16) * T + col0;
#pragma unroll
                    for (int bj = 0; bj < 2; ++bj) { const f32x4 v0 = acc[ai][bj][m][0], v1 = acc[ai][bj][m][1];
                        u32x4 w; w.x = cvt_pk_bf16(v0[0], v0[1]); w.y = cvt_pk_bf16(v0[2], v0[3]); w.z = cvt_pk_bf16(v1[0], v1[1]); w.w = cvt_pk_bf16(v1[2], v1[3]); *(u32x4*)(rowp + bj * HALF) = w; } } }
    }
};
struct OutOrder { int G, c; bool lat_only; unsigned* cnt;
    __device__ __forceinline__ bool next(int i, Unit& u) const { constexpr int nN = DM / 256, nLat = NB * (SEQ / 256) * nN, nCtx = NB * (CTXL / 256) * nN; const int L = i * G + c; int a, b;
        if (L < nLat) { map_tile(L, nLat / nN, nN, a, b); u.pm = (a / (SEQ / 256)) * (TOK / 256) + CTXL / 256 + a % (SEQ / 256); }
        else { if (lat_only || L >= nLat + nCtx) return false; map_tile(L - nLat, nCtx / nN, nN, a, b); u.pm = (a / (CTXL / 256)) * (TOK / 256) + a % (CTXL / 256); }
        u.pn = b; return true; }
    __device__ __forceinline__ void a_ready(const Unit&) const {}
    unsigned* xu; unsigned nloc, xtarget;
    __device__ __forceinline__ void done(const Unit& u) const {
        asm volatile("s_waitcnt vmcnt(0)" ::: "memory"); __builtin_amdgcn_s_barrier();
        if (threadIdx.x == 0) { const bool isctx = (u.pm % (TOK / 256)) < CTXL / 256;
            if (!isctx && xtarget != 0u) {
                const unsigned old = __hip_atomic_fetch_add(xu, 1u, __ATOMIC_RELAXED, __HIP_MEMORY_SCOPE_AGENT);
                if (old + 1u == xtarget) { __builtin_amdgcn_fence(__ATOMIC_RELEASE, "agent"); asm volatile("s_waitcnt vmcnt(0)" ::: "memory");
                    __hip_atomic_fetch_add(cnt, nloc, __ATOMIC_RELAXED, __HIP_MEMORY_SCOPE_AGENT); } }
            else { __builtin_amdgcn_fence(__ATOMIC_RELEASE, "agent"); asm volatile("s_waitcnt vmcnt(0)" ::: "memory");
                __hip_atomic_fetch_add(cnt + (isctx ? 64 : 0), 1u, __ATOMIC_RELAXED, __HIP_MEMORY_SCOPE_AGENT); } } }
};
struct EpiOut { static constexpr bool PERM = true, AFTER_DRAIN = false; bf16_t* C;
    __device__ __forceinline__ void operator()(const f32x4 (&acc)[2][2][4][2], const Unit& u, int wr, int wc, int fr, int fq) const {
        const int row0 = u.pm * BM + wr * 64 + fr, col0 = u.pn * BM + wc * 32 + 8 * fq;
#pragma unroll
        for (int ai = 0; ai < 2; ++ai)
#pragma unroll
            for (int m = 0; m < 4; ++m) { bf16_t* rowp = C + (size_t)(row0 + ai * HALF + m * 16) * DM + col0;
#pragma unroll
                for (int bj = 0; bj < 2; ++bj) { const f32x4 v0 = acc[ai][bj][m][0], v1 = acc[ai][bj][m][1];
                    u32x4 w; w.x = cvt_pk_bf16(v0[0], v0[1]); w.y = cvt_pk_bf16(v0[2], v0[3]); w.z = cvt_pk_bf16(v1[0], v1[1]); w.w = cvt_pk_bf16(v1[2], v1[3]); *(u32x4*)(rowp + bj * HALF) = w; } }
    }
};
}
#endif

__device__ __forceinline__ void phase_gemm_in(const Params& p, int l, char* smem) {
    constexpr int N_F = WG / 2;
#ifdef EMU
    constexpr int MT = T / 128, NT1 = NMAIN / 128, N1 = MT * NT1, N2 = 8 * MT;
    for (int task = obid(); task < N1 + N2; task += gridDim.x) {
        if (task < N1) gemm_tile(p, (const bf16*)(p.ws + WS_HNY), (const bf16*)(p.ws + WS_WIN), DM, task / NT1, task % NT1, 0, smem);
        else { const int t2 = task - N1; gemm_tile(p, (const bf16*)(p.ws + WS_WIN) + (size_t)NMAIN * DM, (const bf16*)(p.ws + WS_HNY), DM, t2 / MT, t2 % MT, 2, smem); }
    }
#else
    { const pg8::Gemm g{(const pg8::bf16_t*)(p.ws + WS_HNY), (const pg8::bf16_t*)(p.ws + WS_HNY), 0, 0, DM};
      const pg8::InOrder S{(int)gridDim.x, obid()};
      const pg8::EpiIn E{(pg8::bf16_t*)(p.ws + WS_P), (float*)(p.ws + WS_G), (pg8::bf16_t*)(p.ws + WS_HT)};
      pg8::gemm_phase<pg8::EpiIn, pg8::InOrder, true, true>((PG8_LAS unsigned char*)smem, g, S, E); }
#endif
    { const int G = (int)gridDim.x, bid = obid();
#ifdef EMU
      const int extra = 0;
#else
      const int extra = (pg8::NU1 + pg8::NU2) % G;
#endif
      if (extra > 0 && extra < G) { if (bid >= extra) for (int task = bid - extra; task < N_F; task += G - extra) filt_fft_task(p, task, smem); }
      else for (int task = G - 1 - bid; task < N_F; task += G) filt_fft_task(p, task, smem); }
}
__device__ __forceinline__ void phase_gemm_out(const Params& p, int l, char* smem) {
    const int G = (int)gridDim.x, bid = obid(); const bool has_ctx = l < DEPTH - 1;
#ifdef EMU
    constexpr int MT = T / 128, NTO = DM / 128;
    for (int task = bid; task < MT * NTO; task += G) {
        const int mt = task / NTO, nt = task % NTO;
        if (!has_ctx && (mt % (TOK / 128)) < CTXL / 128) continue;
        gemm_tile(p, (const bf16*)(p.ws + WS_HNY), (const bf16*)(p.ws + WS_WOUT), MIX, mt, nt, 1, smem);
        __syncthreads(); if (otid() == 0) *unit_counter(p, (mt % (TOK / 128)) < CTXL / 128 ? 1 : 0) += 1u;
    }
#else
    const pg8::Gemm g{(const pg8::bf16_t*)(p.ws + WS_HNY), (const pg8::bf16_t*)(p.ws + WS_WOUT), 0, 0, MIX};
    const unsigned xcc = (unsigned)__builtin_amdgcn_s_getreg((3 << 11) | 20) & 0xFu, nloc = ((volatile PG8_LAS unsigned*)(smem + LDS_BYTES - 64))[0];
    const bool agg = (NB * (SEQ / 256) * (DM / 256) == G) && nloc > 0u;
    const pg8::OutOrder S{G, bid, !has_ctx, unit_counter(p, 0), unit_counter(p, 2) + 16 * xcc, nloc, agg ? nloc * (unsigned)(l + 1) : 0u};
    const pg8::EpiOut E{(pg8::bf16_t*)(p.ws + WS_P)};
    pg8::gemm_phase<pg8::EpiOut, pg8::OutOrder, true, true>((PG8_LAS unsigned char*)smem, g, S, E);
#endif
}

__device__ __forceinline__ size_t st_index(int mixer, int dir, int b, int h, int cid) { return ((((size_t)(mixer * 2 + dir) * NB + b) * NH + h) * NCH + cid); }
__device__ __forceinline__ size_t ch_index(int dir, int b, int h, int cid) { return (((size_t)dir * NB + b) * NH + h) * NCH + cid; }

__device__ __forceinline__ void load_tile_nat(const bf16* P, int r0, int c0, bf16* dst, float scale, int tid) {
    const int s = tid >> 3, c8 = tid & 7;
    const u32x4 v = *(const u32x4*)(P + (size_t)(r0 + s) * NP + c0 + c8 * 8);
    if (scale == 1.0f) *(u32x4*)(dst + s * LS + c8 * 8) = v;
    else { float f[8]; unpack8(v, f); u32x4 o; o.x = pk2(f[0] * scale, f[1] * scale); o.y = pk2(f[2] * scale, f[3] * scale); o.z = pk2(f[4] * scale, f[5] * scale); o.w = pk2(f[6] * scale, f[7] * scale);
        *(u32x4*)(dst + s * LS + c8 * 8) = o; }
}
__device__ __forceinline__ void load_tile_tr(const bf16* P, int r0, int c0, bf16* dst, int tid) {
    const int s = tid >> 3, c8 = tid & 7;
    const u32x4 v = *(const u32x4*)(P + (size_t)(r0 + s) * NP + c0 + c8 * 8);
    const unsigned w[4] = {v.x, v.y, v.z, v.w};
#pragma unroll
    for (int j = 0; j < 4; ++j) { dst[(c8 * 8 + 2 * j) * LS + s] = (bf16)(w[j] & 0xffffu); dst[(c8 * 8 + 2 * j + 1) * LS + s] = (bf16)(w[j] >> 16); }
}

template <int NTK>
__device__ __forceinline__ void load_span(const bf16* row, int t0, float (&v)[NTK + 2]) {
    { const bool hl = t0 > 0, hr = t0 + NTK < SEQ; const bf16 xl = row[hl ? -1 : 0], xr = row[hr ? NTK : 0];
        v[0] = hl ? bf2f(xl) : 0.f; v[NTK + 1] = hr ? bf2f(xr) : 0.f; }
    if constexpr (NTK == 8) { float f[8]; unpack8(*(const u32x4*)row, f);
#pragma unroll
        for (int i = 0; i < 8; ++i) v[1 + i] = f[i]; }
    else {
#pragma unroll
        for (int i = 0; i < NTK; ++i) v[1 + i] = bf2f(row[i]); }
}
struct SpanRaw { u32x4 b; bf16 xl, xr; };
__device__ __forceinline__ SpanRaw span_load8(const bf16* row, int t0) { SpanRaw s; const bool hl = t0 > 0, hr = t0 + 8 < SEQ; s.xl = row[hl ? -1 : 0]; s.xr = row[hr ? 8 : 0]; s.b = *(const u32x4*)row; return s; }
__device__ __forceinline__ void span_expand8(const SpanRaw& s, int t0, float (&v)[10]) { float f[8]; unpack8(s.b, f); v[0] = t0 > 0 ? bf2f(s.xl) : 0.f; v[9] = (t0 + 8 < SEQ) ? bf2f(s.xr) : 0.f;
#pragma unroll
    for (int i = 0; i < 8; ++i) v[1 + i] = f[i]; }
template <int NTK>
__device__ __forceinline__ void hy_inputs(const bf16* h0, const bf16* h1, const float* cw, const float* cb, int c, int t0, float (&u0)[NTK], float (&u1)[NTK], float (&g0)[NTK], float (&g1)[NTK]) {
    if constexpr (NTK == 8) {
        const SpanRaw rxa = span_load8(h0 + (size_t)512 * T, t0), rxb = span_load8(h1 + (size_t)512 * T, t0), rga = span_load8(h0 + (size_t)768 * T, t0), rgb = span_load8(h1 + (size_t)768 * T, t0);
        const SpanRaw rva = span_load8(h0, t0), rvb = span_load8(h1, t0), rya = span_load8(h0 + (size_t)256 * T, t0), ryb = span_load8(h1 + (size_t)256 * T, t0);
        const float w0 = cw[0 * 768 + 512 + c], w1 = cw[1 * 768 + 512 + c], w2 = cw[2 * 768 + 512 + c], bb = cb[512 + c];
        const float v0 = cw[0 * 768 + c], v1 = cw[1 * 768 + c], v2 = cw[2 * 768 + c], vbias = cb[c];
        const float y0 = cw[0 * 768 + 256 + c], y1 = cw[1 * 768 + 256 + c], y2 = cw[2 * 768 + 256 + c], ybias = cb[256 + c];
        SCHED_FENCE();
        { float xa[10], xb[10], ga[10], gb[10]; span_expand8(rxa, t0, xa); span_expand8(rxb, t0, xb); span_expand8(rga, t0, ga); span_expand8(rgb, t0, gb);
#pragma unroll
            for (int i = 0; i < 8; ++i) { g0[i] = (w0 * xa[i] + w1 * xa[i + 1] + w2 * xa[i + 2] + bb) * siluf_(ga[i + 1]); g1[i] = (w0 * xb[i] + w1 * xb[i + 1] + w2 * xb[i + 2] + bb) * siluf_(gb[i + 1]); } }
        { float va[10], vb[10], ya[10], yb[10]; span_expand8(rva, t0, va); span_expand8(rvb, t0, vb); span_expand8(rya, t0, ya); span_expand8(ryb, t0, yb);
#pragma unroll
            for (int i = 0; i < 8; ++i) { u0[i] = (v0 * va[i] + v1 * va[i + 1] + v2 * va[i + 2] + vbias) * (y0 * ya[i] + y1 * ya[i + 1] + y2 * ya[i + 2] + ybias);
                u1[i] = (v0 * vb[i] + v1 * vb[i + 1] + v2 * vb[i + 2] + vbias) * (y0 * yb[i] + y1 * yb[i + 1] + y2 * yb[i + 2] + ybias); } }
        return;
    }
    { float xa[NTK + 2], xb[NTK + 2]; load_span<NTK>(h0 + (size_t)512 * T, t0, xa); load_span<NTK>(h1 + (size_t)512 * T, t0, xb);
        const float w0 = cw[0 * 768 + 512 + c], w1 = cw[1 * 768 + 512 + c], w2 = cw[2 * 768 + 512 + c], bb = cb[512 + c];
        float ga[NTK + 2], gb[NTK + 2]; load_span<NTK>(h0 + (size_t)768 * T, t0, ga); load_span<NTK>(h1 + (size_t)768 * T, t0, gb);
#pragma unroll
        for (int i = 0; i < NTK; ++i) { g0[i] = (w0 * xa[i] + w1 * xa[i + 1] + w2 * xa[i + 2] + bb) * siluf_(ga[i + 1]); g1[i] = (w0 * xb[i] + w1 * xb[i + 1] + w2 * xb[i + 2] + bb) * siluf_(gb[i + 1]); } }
    { float va[NTK + 2], vb[NTK + 2], ya[NTK + 2], yb[NTK + 2];
        load_span<NTK>(h0, t0, va); load_span<NTK>(h1, t0, vb); load_span<NTK>(h0 + (size_t)256 * T, t0, ya); load_span<NTK>(h1 + (size_t)256 * T, t0, yb);
        const float v0 = cw[0 * 768 + c], v1 = cw[1 * 768 + c], v2 = cw[2 * 768 + c], vbias = cb[c];
        const float y0 = cw[0 * 768 + 256 + c], y1 = cw[1 * 768 + 256 + c], y2 = cw[2 * 768 + 256 + c], ybias = cb[256 + c];
#pragma unroll
        for (int i = 0; i < NTK; ++i) { u0[i] = (v0 * va[i] + v1 * va[i + 1] + v2 * va[i + 2] + vbias) * (y0 * ya[i] + y1 * ya[i + 1] + y2 * ya[i + 2] + ybias);
            u1[i] = (v0 * vb[i] + v1 * vb[i + 1] + v2 * vb[i + 2] + vbias) * (y0 * yb[i] + y1 * yb[i + 1] + y2 * yb[i + 2] + ybias); } }
}
__device__ __forceinline__ void hylat_task(const Params& p, int l, int bp, int cp, char* smem) {
    const int tid = otid(), half = tid >> 8, tl = tid & 255, c = 2 * cp + half;
    const bf16* HT = (const bf16*)(p.ws + WS_HT); bf16* Y = (bf16*)(p.ws + WS_HNY);
    cpx* buf = (cpx*)smem + (size_t)half * FBUF;
    const cpx* TW = (const cpx*)(p.ws + WS_TW);
    const cpx* KF = (const cpx*)(p.ws + WS_KF) + (size_t)c * NF;
    constexpr int NTK = SEQ / 256;
    const int t0 = NTK * tl;
    const float* cw = p.in[I_HCW] + (size_t)l * 3 * 768; const float* cb = p.in[I_HCB] + (size_t)l * 768;
    const size_t rb0 = (size_t)(2 * bp) * TOK + CTXL, rb1 = rb0 + TOK;
    const bf16* h0 = HT + (size_t)c * T + rb0 + t0; const bf16* h1 = h0 + TOK;
    { float u0[NTK], u1[NTK], g0[NTK], g1[NTK]; hy_inputs<NTK>(h0, h1, cw, cb, c, t0, u0, u1, g0, g1);
        __syncthreads();
#pragma unroll
        for (int i = 0; i < NTK; ++i) { cpx v; v.x = u0[i]; v.y = u1[i]; buf[FPH(t0 + i)] = v; cpx z = {0.f, 0.f}; buf[FPH(SEQ + t0 + i)] = z; } }
    fft_fwd(buf, TW, tl);
#pragma unroll 2
    for (int i = tl; i < NF; i += 256) buf[FPH(i)] = cmul(buf[FPH(i)], KF[i]);
    fft_inv(buf, TW, tl);
    const float dsk = p.in[I_HD][(size_t)l * WG + c]; const float sc = 1.0f / (float)NF;
    { const int tz = otid() & 255; const int t0z = NTK * tz;
        float u0[NTK], u1[NTK], g0[NTK], g1[NTK]; hy_inputs<NTK>(HT + (size_t)c * T + rb0 + t0z, HT + (size_t)c * T + rb0 + t0z + TOK, cw, cb, c, t0z, u0, u1, g0, g1);
        float o0[NTK], o1[NTK];
#pragma unroll
        for (int i = 0; i < NTK; ++i) { const cpx y = buf[FPH(t0z + i)]; o0[i] = g0[i] * (y.x * sc + u0[i] * dsk); o1[i] = g1[i] * (y.y * sc + u1[i] * dsk); }
        bf16* d0 = (bf16*)(p.ws + WS_HT) + (size_t)(768 + c) * T + rb0 + t0z; bf16* d1 = d0 + TOK;
        if constexpr (NTK == 8) { *(u32x4*)d0 = pack8(o0); *(u32x4*)d1 = pack8(o1); }
        else {
#pragma unroll
            for (int i = 0; i < NTK; ++i) { d0[i] = f2bf(o0[i]); d1[i] = f2bf(o1[i]); } } }
}

constexpr int HCB = 16;
__device__ __forceinline__ void hyctx_task(const Params& p, int l, int b, int cblk, char* smem) {
    const int tid = otid(); const int c0 = cblk * HCB;
    const bf16* HT = (const bf16*)(p.ws + WS_HT); bf16* Y = (bf16*)(p.ws + WS_HNY); const float* HC = (const float*)(p.ws + WS_HC);
    float* raw = (float*)smem;
    float* u = raw + 4 * CTXL * HCB;
    float* og = u + CTXL * HCB;
    float* hcm = og + CTXL * HCB;
    bf16* ob = (bf16*)raw;
    const size_t rb = (size_t)b * TOK;
    const float* cw = p.in[I_HCW] + (size_t)l * 3 * 768; const float* cbias = p.in[I_HCB] + (size_t)l * 768;
    constexpr int WT = CTXL / 32;
    __syncthreads();
    for (int i = tid; i < 4 * HCB * (CTXL / 8); i += NT) { const int k = i / (HCB * (CTXL / 8)), cc = (i / (CTXL / 8)) % HCB, ck = i % (CTXL / 8);
        float f[8]; unpack8(*(const u32x4*)(HT + (size_t)(k * 256 + c0 + cc) * T + rb + ck * 8), f);
#pragma unroll
        for (int j = 0; j < 8; ++j) raw[(k * CTXL + ck * 8 + j) * HCB + cc] = f[j]; }
    for (int i = tid; i < 2 * HCB * (CTXL / 4); i += NT) { const int dir = i / (HCB * (CTXL / 4)), cc = (i / (CTXL / 4)) % HCB, pk = i % (CTXL / 4);
        const f32x4 v = *(const f32x4*)(HC + ((size_t)dir * WG + c0 + cc) * CTXL + pk * 4); const float f[4] = {v.x, v.y, v.z, v.w};
#pragma unroll
        for (int j = 0; j < 4; ++j) { const int pos = pk * 4 + j; if (dir == 0) hcm[(CTXL + pos) * HCB + cc] = f[j]; else if (pos > 0) hcm[(CTXL - pos) * HCB + cc] = f[j]; } }
    if (tid < HCB) hcm[tid] = 0.f;
    __syncthreads();
    static_assert(NT % HCB == 0, "a thread keeps its channel over the passes: its 12 filter taps are loaded once");
    float tw0[3], tw1[3], tw2[3], tbs[3];
#pragma unroll
    for (int k = 0; k < 3; ++k) { const int ch = k * 256 + c0 + tid % HCB; tw0[k] = cw[0 * 768 + ch]; tw1[k] = cw[1 * 768 + ch]; tw2[k] = cw[2 * 768 + ch]; tbs[k] = cbias[ch]; }
    for (int i = tid; i < CTXL * HCB; i += NT) { const int t = i / HCB, cc = i % HCB; float cv[3];
#pragma unroll
        for (int k = 0; k < 3; ++k) { const float* rk = raw + k * CTXL * HCB;
            const float a = t > 0 ? rk[(t - 1) * HCB + cc] : 0.f, m = rk[t * HCB + cc], z = t < CTXL - 1 ? rk[(t + 1) * HCB + cc] : 0.f;
            cv[k] = tw0[k] * a + tw1[k] * m + tw2[k] * z + tbs[k]; }
        u[i] = cv[0] * cv[1];
        og[i] = cv[2] * siluf_(raw[(3 * CTXL + t) * HCB + cc]); }
    __syncthreads();
    { const int cc = tid % HCB, tg = tid / HCB, t0 = WT * tg; float acc[WT], w[WT];
#pragma unroll
        for (int j = 0; j < WT; ++j) { acc[j] = 0.f; w[j] = hcm[(t0 + j + CTXL) * HCB + cc]; }
#pragma unroll 8
        for (int s = 0; s < CTXL; ++s) { const float us = u[s * HCB + cc];
#pragma unroll
            for (int j = 0; j < WT; ++j) acc[j] += us * w[j];
#pragma unroll
            for (int j = WT - 1; j > 0; --j) w[j] = w[j - 1];
            w[0] = hcm[(t0 - s - 1 + CTXL) * HCB + cc]; }
        const float dsk = p.in[I_HD][(size_t)l * WG + c0 + cc];
#pragma unroll
        for (int j = 0; j < WT; ++j) { const int t = t0 + j; ob[t * HCB + cc] = f2bf(og[t * HCB + cc] * (acc[j] + u[t * HCB + cc] * dsk)); } }
    __syncthreads();
    for (int i = tid; i < CTXL * 2; i += NT) { const int t = i >> 1, hh = i & 1; *(u32x4*)(Y + (rb + t) * 1024 + YH + c0 + 8 * hh) = *(const u32x4*)(ob + t * HCB + 8 * hh); }
}

__device__ __forceinline__ void attn_task(const Params& p, int l, int b, int kvh, int qt, bool ctxq, char* smem) {
    const int tid = otid(), lane = tid & 63, wave = tid >> 6, r = lane & 15, q = lane >> 4;
    constexpr float QSC = 0.125f * 1.4426950408889634f;
    const bf16* P = (const bf16*)(p.ws + WS_P); bf16* Y = (bf16*)(p.ws + WS_HNY); const cpx* ROPE = (const cpx*)(p.ws + WS_ROPE);
    bf16* Qs = (bf16*)smem;
    bf16* Ks = Qs + 256 * LS;
    constexpr int LSV = 80;
    bf16* Vt = Ks + 64 * LS;
    bf16* Ps = Vt + 64 * LS;
    const size_t rq0 = (size_t)b * TOK + (ctxq ? 0 : CTXL) + qt * 128;
    __syncthreads();
    {
        u32x4 qlo[2], qhi[2]; f32x4 qrp[2][4];
#pragma unroll
        for (int it = 0; it < 2; ++it) { const int idx = tid + NT * it, row = idx >> 2, cpair = idx & 3, g = row >> 7, t = row & 127;
            const bf16* src = P + (rq0 + t) * NP + PD + (kvh * 2 + g) * 64; qlo[it] = *(const u32x4*)(src + cpair * 8); qhi[it] = *(const u32x4*)(src + 32 + cpair * 8);
            if (!ctxq) { const f32x4* rr = (const f32x4*)(ROPE + (size_t)(qt * 128 + t) * 32 + cpair * 8); qrp[it][0] = rr[0]; qrp[it][1] = rr[1]; qrp[it][2] = rr[2]; qrp[it][3] = rr[3]; }
            else { qrp[it][0] = qrp[it][1] = qrp[it][2] = qrp[it][3] = (f32x4){1.f, 0.f, 1.f, 0.f}; } }
        SCHED_FENCE();
#pragma unroll
        for (int it = 0; it < 2; ++it) { const int idx = tid + NT * it, row = idx >> 2, cpair = idx & 3;
            float lo[8], hi[8]; unpack8(qlo[it], lo); unpack8(qhi[it], hi);
            const float cs[8] = {qrp[it][0].x, qrp[it][0].z, qrp[it][1].x, qrp[it][1].z, qrp[it][2].x, qrp[it][2].z, qrp[it][3].x, qrp[it][3].z}, sn[8] = {qrp[it][0].y, qrp[it][0].w, qrp[it][1].y, qrp[it][1].w, qrp[it][2].y, qrp[it][2].w, qrp[it][3].y, qrp[it][3].w};
            float a[8], c2[8];
#pragma unroll
            for (int j = 0; j < 8; ++j) { a[j] = (lo[j] * cs[j] - hi[j] * sn[j]) * QSC; c2[j] = (hi[j] * cs[j] + lo[j] * sn[j]) * QSC; }
            *(u32x4*)(Qs + row * LS + cpair * 8) = pack8(a); *(u32x4*)(Qs + row * LS + 32 + cpair * 8) = pack8(c2); } }
    const int lt0 = ctxq ? 0 : (2 * qt - 2 > 0 ? 2 * qt - 2 : 0), lt1 = ctxq ? -1 : (2 * qt + 3 < SEQ / 64 - 1 ? 2 * qt + 3 : SEQ / 64 - 1);
    const int nloc = lt1 - lt0 + 1, ntiles = nloc + NCC;
    float m[2], lsum[2]; f32x4 O[2][4];
#pragma unroll
    for (int ms = 0; ms < 2; ++ms) { m[ms] = -INFINITY; lsum[ms] = 0.f;
#pragma unroll
        for (int i = 0; i < 4; ++i) O[ms][i] = (f32x4){0.f, 0.f, 0.f, 0.f}; }
    const int g = wave >> 2, tq0 = (wave & 3) * 32;
    (void)Ps;
    __syncthreads();
    bf16x8 qf[2][2];
#pragma unroll
    for (int ms = 0; ms < 2; ++ms)
#pragma unroll
        for (int ks = 0; ks < 2; ++ks) qf[ms][ks] = *(const bf16x8*)(Qs + (g * 128 + tq0 + 16 * ms + r) * LS + ks * 32 + q * 8);
    u32x4 klo = {0u, 0u, 0u, 0u}, khi = klo, vq = klo; f32x4 rp[4] = {(f32x4){1.f, 0.f, 1.f, 0.f}, (f32x4){1.f, 0.f, 1.f, 0.f}, (f32x4){1.f, 0.f, 1.f, 0.f}, (f32x4){1.f, 0.f, 1.f, 0.f}};
    const int ks_ = tid >> 2, kcp = tid & 3, vs_ = tid >> 3, vc8 = tid & 7;
#define ATT_PREFETCH(TI) do { const bool loc_ = (TI) < nloc; const int kt_ = loc_ ? lt0 + (TI) : (TI) - nloc; const size_t rk_ = (size_t)b * TOK + (loc_ ? CTXL : 0) + kt_ * 64; \
        if (tid < 256) { const bf16* src_ = P + (rk_ + ks_) * NP + PD + 256 + kvh * 64; klo = *(const u32x4*)(src_ + kcp * 8); khi = *(const u32x4*)(src_ + 32 + kcp * 8); \
            if (loc_) { const f32x4* rr_ = (const f32x4*)(ROPE + (size_t)(kt_ * 64 + ks_) * 32 + kcp * 8); rp[0] = rr_[0]; rp[1] = rr_[1]; rp[2] = rr_[2]; rp[3] = rr_[3]; } \
            else { rp[0] = rp[1] = rp[2] = rp[3] = (f32x4){1.f, 0.f, 1.f, 0.f}; } } \
        vq = *(const u32x4*)(P + (rk_ + vs_) * NP + PD + 384 + kvh * 64 + vc8 * 8); } while (0)
    ATT_PREFETCH(0);
    for (int ti = 0; ti < ntiles; ++ti) {
        const bool local = ti < nloc; const int kt = local ? lt0 + ti : ti - nloc;
        __syncthreads();
        if (tid < 256) { float lo[8], hi[8]; unpack8(klo, lo); unpack8(khi, hi);
            const float cs[8] = {rp[0].x, rp[0].z, rp[1].x, rp[1].z, rp[2].x, rp[2].z, rp[3].x, rp[3].z}, sn[8] = {rp[0].y, rp[0].w, rp[1].y, rp[1].w, rp[2].y, rp[2].w, rp[3].y, rp[3].w};
            float a[8], c2[8];
#pragma unroll
            for (int j = 0; j < 8; ++j) { a[j] = lo[j] * cs[j] - hi[j] * sn[j]; c2[j] = hi[j] * cs[j] + lo[j] * sn[j]; }
            *(u32x4*)(Ks + ks_ * LS + kcp * 8) = pack8(a); *(u32x4*)(Ks + ks_ * LS + 32 + kcp * 8) = pack8(c2); }
        *(u32x4*)(Vt + vs_ * LSV + vc8 * 8) = vq;
        __syncthreads();
        if (ti + 1 < ntiles) ATT_PREFETCH(ti + 1);
        bf16x8 kfr[4][2], vfa[4], vfb[4];
#pragma unroll
        for (int nt = 0; nt < 4; ++nt)
#pragma unroll
            for (int ks = 0; ks < 2; ++ks) kfr[nt][ks] = *(const bf16x8*)(Ks + (16 * nt + r) * LS + ks * 32 + q * 8);
#pragma unroll
        for (int me = 0; me < 4; ++me) { const bf16* vr = Vt + (4 * q + (r >> 2)) * LSV + 16 * me + 4 * (r & 3);
            const u32x2 a0 = lds_tr16(vr), a1 = lds_tr16(vr + 16 * LSV), a2 = lds_tr16(vr + 32 * LSV), a3 = lds_tr16(vr + 48 * LSV);
            u32x4 va; va.x = a0.x; va.y = a0.y; va.z = a1.x; va.w = a1.y; u32x4 vb; vb.x = a2.x; vb.y = a2.y; vb.z = a3.x; vb.w = a3.y; vfa[me] = as_frag(va); vfb[me] = as_frag(vb); }
#pragma unroll
        for (int ms = 0; ms < 2; ++ms) {
            const int qlo = qt * 128 + tq0 + 16 * ms, klo_ = kt * 64;
            if (local && (klo_ > qlo + 15 + 128 || klo_ + 63 < qlo - 128)) continue;
            const bool domask = local && (klo_ + 63 - qlo > 128 || klo_ - (qlo + 15) < -128);
            f32x4 S[4] = {(f32x4){0.f, 0.f, 0.f, 0.f}, (f32x4){0.f, 0.f, 0.f, 0.f}, (f32x4){0.f, 0.f, 0.f, 0.f}, (f32x4){0.f, 0.f, 0.f, 0.f}};
#pragma unroll
            for (int ks = 0; ks < 2; ++ks)
#pragma unroll
                for (int nt = 0; nt < 4; ++nt) S[nt] = MFMA16(kfr[nt][ks], qf[ms][ks], S[nt]);
            const int qpos = qlo + r; float mx = -INFINITY;
            if (domask) {
#pragma unroll
                for (int nt = 0; nt < 4; ++nt)
#pragma unroll
                    for (int i = 0; i < 4; ++i) { const int d = kt * 64 + nt * 16 + 4 * q + i - qpos; if (d > 128 || d < -128) S[nt][i] = -INFINITY; } }
#pragma unroll
            for (int nt = 0; nt < 4; ++nt)
#pragma unroll
                for (int i = 0; i < 4; ++i) mx = fmaxf(mx, S[nt][i]);
            mx = xrow_max(mx);
            const float mn = fmaxf(m[ms], mx); const float msafe = mn == -INFINITY ? 0.f : mn; const float alpha = EXP2(m[ms] - msafe); float sm = 0.f;
#pragma unroll
            for (int nt = 0; nt < 4; ++nt)
#pragma unroll
                for (int i = 0; i < 4; ++i) { S[nt][i] = EXP2(S[nt][i] - msafe); sm += S[nt][i]; }
            sm = xrow_sum(sm);
            lsum[ms] = lsum[ms] * alpha + sm; m[ms] = mn;
            const float pa[8] = {S[0][0], S[0][1], S[0][2], S[0][3], S[1][0], S[1][1], S[1][2], S[1][3]}, pb[8] = {S[2][0], S[2][1], S[2][2], S[2][3], S[3][0], S[3][1], S[3][2], S[3][3]};
            const bf16x8 p0 = as_frag(pack8(pa)), p1 = as_frag(pack8(pb));
#pragma unroll
            for (int me = 0; me < 4; ++me) { O[ms][me] = O[ms][me] * alpha;
                O[ms][me] = MFMA16(vfa[me], p0, O[ms][me]); O[ms][me] = MFMA16(vfb[me], p1, O[ms][me]); }
        }
    }
#undef ATT_PREFETCH
    const float sink = p.in[I_SINK][(size_t)l * NH + kvh * 2 + g];
    u32x2 ggs[2][4];
#pragma unroll
    for (int ms = 0; ms < 2; ++ms)
#pragma unroll
        for (int me = 0; me < 4; ++me) ggs[ms][me] = *(const u32x2*)(P + (rq0 + tq0 + 16 * ms + r) * NP + PD + 512 + (kvh * 2 + g) * 64 + 4 * q + 16 * me);
#pragma unroll
    for (int ms = 0; ms < 2; ++ms) { const float den = lsum[ms] + EXP2(sink * 1.4426950408889634f - m[ms]); const float inv = frcp_(den);
        const size_t row = rq0 + tq0 + 16 * ms + r; const int col = (kvh * 2 + g) * 64 + 4 * q;
#pragma unroll
        for (int me = 0; me < 4; ++me) { const u32x2 gg = ggs[ms][me];
            const float g0 = bitsf(gg.x << 16), g1 = bitsf(gg.x & 0xffff0000u), g2 = bitsf(gg.y << 16), g3 = bitsf(gg.y & 0xffff0000u);
            u32x2 o; o.x = pk2(O[ms][me][0] * inv * siluf_(g0), O[ms][me][1] * inv * siluf_(g1)); o.y = pk2(O[ms][me][2] * inv * siluf_(g2), O[ms][me][3] * inv * siluf_(g3));
            *(u32x2*)(Y + row * 1024 + YD + col + 16 * me) = o; } }
}

#ifdef EMU
__device__ __forceinline__ int olane(int lane) { return lane; }
#else
__device__ __forceinline__ int olane(int lane) { asm volatile("" : "+v"(lane)); return lane; }
#endif
__device__ __forceinline__ void load_nat_tile(const bf16* P, int row0, int col0, bf16* tile, int lane) {
    u32x4 v[8];
#pragma unroll
    for (int i = 0; i < 8; ++i) v[i] = *(const u32x4*)(P + (size_t)(row0 + (lane >> 3) + 8 * i) * NP + col0 + (lane & 7) * 8);
#pragma unroll
    for (int i = 0; i < 8; ++i) *(u32x4*)(tile + swz((lane >> 3) + 8 * i, lane & 7)) = v[i];
}
__device__ __forceinline__ bf16x8 frag_tr(const bf16* tile, int c0, int k0, int lane) {
    const int c = c0 + (lane & 15), kb = k0 + 8 * (lane >> 4); unsigned w[4];
#pragma unroll
    for (int j = 0; j < 4; ++j) w[j] = (unsigned)tile[swz(kb + 2 * j, c >> 3) + (c & 7)] | ((unsigned)tile[swz(kb + 2 * j + 1, c >> 3) + (c & 7)] << 16);
    u32x4 o; o.x = w[0]; o.y = w[1]; o.z = w[2]; o.w = w[3]; return as_frag(o);
}
__device__ __forceinline__ bf16x8 frag_tr_hw(const bf16* tile, int c0, int k0, int lane) {
    const int r = lane & 15, q = lane >> 4, row = k0 + 8 * q + (r >> 2), col = c0 + 4 * (r & 3);
    const u32x2 a = lds_tr16(tile + swz(row, col >> 3) + (col & 7)), b = lds_tr16(tile + swz(row + 4, col >> 3) + (col & 7));
    u32x4 o; o.x = a.x; o.y = a.y; o.z = b.x; o.w = b.y; return as_frag(o);
}
template <int DIR>
__device__ __forceinline__ void gla_r_frags(const float* Grow0, int lane, bf16x8 (&af)[4]) {
    const int r = lane & 15, q4 = lane >> 4;
#pragma unroll
    for (int mt = 0; mt < 4; ++mt) { u32x4 o = {0u, 0u, 0u, 0u};
        if (q4 < 2) o = *(const u32x4*)((const bf16*)(Grow0 + (size_t)(16 * mt + r) * NGS + 16) + DIR * 16 + 8 * q4);
        af[mt] = as_frag(o); }
}
template <int DIR>
__device__ __forceinline__ void gla_b_load(const Params& p, int l, int h, int nt, int lane_, u32x4& o, float& bias) {
    const int lane = olane(lane_), r = lane & 15, q4 = lane >> 4, d = h * 64 + 16 * nt + r;
    const float* wa = p.in[I_GWA] + ((size_t)(l * 2 + DIR) * 16 + 8 * (q4 & 1)) * WG + d;
    float w[8];
#pragma unroll
    for (int j = 0; j < 8; ++j) w[j] = wa[j * WG];
    bias = p.in[I_GBA][(size_t)(l * 2 + DIR) * WG + d];
    o.x = pk2(w[0], w[1]); o.y = pk2(w[2], w[3]); o.z = pk2(w[4], w[5]); o.w = pk2(w[6], w[7]);
    if (q4 >= 2) o = (u32x4){0u, 0u, 0u, 0u};
}
template <int DIR>
__device__ __forceinline__ float gla_b_col(const u32x4 o, const float bias, const bf16x8 (&af)[4], int lane_, float (&x)[4][4]) {
    const int lane = olane(lane_), r = lane & 15, q4 = lane >> 4;
    const bf16x8 bfr = as_frag(o);
#pragma unroll
    for (int mt = 0; mt < 4; ++mt) { f32x4 c = {bias, bias, bias, bias}; c = MFMA16(af[mt], bfr, c);
#pragma unroll
        for (int i = 0; i < 4; ++i) x[mt][i] = logsig_fast(c[i]) * (1.0f / 16.0f); }
    float carry = 0.f;
#pragma unroll
    for (int k = 0; k < 4; ++k) { const int mt = DIR == 0 ? k : 3 - k; float* y = x[mt];
        if (DIR == 0) { y[1] += y[0]; y[2] += y[1]; y[3] += y[2]; } else { y[2] += y[3]; y[1] += y[2]; y[0] += y[1]; }
        const float s4 = DIR == 0 ? y[3] : y[0];
        const float t1 = DIR == 0 ? __shfl_up(s4, 16) : __shfl_down(s4, 16), t2 = DIR == 0 ? __shfl_up(s4, 32) : __shfl_down(s4, 32), t3 = DIR == 0 ? __shfl_up(s4, 48) : __shfl_down(s4, 48);
        const int qq = DIR == 0 ? q4 : 3 - q4;
        const float e = (qq >= 1 ? t1 : 0.f) + (qq >= 2 ? t2 : 0.f) + (qq >= 3 ? t3 : 0.f);
        const float tot = __shfl(e + s4, DIR == 0 ? r + 48 : r);
#pragma unroll
        for (int i = 0; i < 4; ++i) y[i] += carry + e;
        carry += tot; }
    return carry;
}

template <int MIXER, int DIR>
__device__ __forceinline__ void chunkst_dir(const Params& p, int l, int b, int h, int cid, const float* Grow0, const unsigned (&kk)[32], const bf16* Vt, bf16* Kt, const float* wvs, float* bendl, int lane_) {
    const int lane = olane(lane_), r = lane & 15, q4 = lane >> 4;
    if constexpr (MIXER == 0) {
        float nacc = 0.f;
#pragma unroll
        for (int c = 0; c < 8; ++c) { float f[8];
#pragma unroll
            for (int j = 0; j < 8; ++j) { const int s = 8 * c + j; const float kv = (s & 1) ? bitsf(kk[s >> 1] & 0xffff0000u) : bitsf(kk[s >> 1] << 16);
                f[j] = kv * 0.125f * wvs[DIR * 64 + s]; nacc += f[j]; }
            *(u32x4*)(Kt + swz(lane, c)) = pack8(f); }
        ((float*)(p.ws + WS_NV))[ch_index(DIR, b, h, cid) * 64 + lane] = nacc;
    } else {
        const bf16* P = (const bf16*)(p.ws + WS_P); const int kcol = PG + 256 + h * 64; const int r0 = b * TOK + cid * 64;
        bf16x8 af[4]; gla_r_frags<DIR>(Grow0, lane, af);
#pragma unroll 2
        for (int nt = 0; nt < 4; ++nt) { const int d = 16 * nt + r; float x[4][4];
            u32x4 wo_; float wb_; gla_b_load<DIR>(p, l, h, nt, lane, wo_, wb_); const float bend = gla_b_col<DIR>(wo_, wb_, af, lane, x);
            if (q4 == 0) { ((float*)(p.ws + WS_BE))[ch_index(DIR, b, h, cid) * 64 + d] = bend; bendl[d] = __expf(fmaxf(bend, -80.0f)); }
#pragma unroll
            for (int mt = 0; mt < 4; ++mt)
#pragma unroll
                for (int i = 0; i < 4; ++i) { const int s = 16 * mt + 4 * q4 + i; const float kv = bf2f(P[(size_t)(r0 + s) * NP + kcol + d]); const float bc = fmaxf(x[mt][i], -80.0f);
                    Kt[swz(d, s >> 3) + (s & 7)] = f2bf(kv * __expf(-bc));
                    ((bf16*)(p.ws + WS_EQ))[((size_t)DIR * T + r0 + s) * WG + h * 64 + d] = f2bf(__expf(bc)); } }
    }
    WAVE_SYNC();
    bf16x8 vf[4][2];
#pragma unroll
    for (int ne = 0; ne < 4; ++ne)
#pragma unroll
        for (int ks = 0; ks < 2; ++ks) vf[ne][ks] = frag_tr_hw(Vt, 16 * ne, 32 * ks, lane);
    bf16* dst = (bf16*)(p.ws + WS_ST) + st_index(MIXER, DIR, b, h, cid) * 4096;
#pragma unroll
    for (int me = 0; me < 4; ++me) {
        f32x4 acc[4] = {(f32x4){0.f, 0.f, 0.f, 0.f}, (f32x4){0.f, 0.f, 0.f, 0.f}, (f32x4){0.f, 0.f, 0.f, 0.f}, (f32x4){0.f, 0.f, 0.f, 0.f}};
#pragma unroll
        for (int ks = 0; ks < 2; ++ks) { const bf16x8 a = *(const bf16x8*)(Kt + swz(16 * me + r, ks * 4 + q4));
#pragma unroll
            for (int ne = 0; ne < 4; ++ne) acc[ne] = MFMA16(a, vf[ne][ks], acc[ne]); }
        f32x4 sc4 = {1.f, 1.f, 1.f, 1.f}; if constexpr (MIXER == 1) sc4 = *(const f32x4*)(bendl + 16 * me + 4 * q4);
#pragma unroll
        for (int ne = 0; ne < 4; ++ne) { const f32x4 v = acc[ne] * sc4; u32x2 o; o.x = pk2(v[0], v[1]); o.y = pk2(v[2], v[3]); *(u32x2*)(dst + (16 * ne + r) * 64 + 16 * me + 4 * q4) = o; }
    }
    WAVE_SYNC();
}
template <int MIXER>
__device__ __forceinline__ void chunkst_w(const Params& p, int l, int b, int h, int cid, char* wl, int lane) {
    const bf16* P = (const bf16*)(p.ws + WS_P); const float* G = (const float*)(p.ws + WS_G);
    const int r0 = b * TOK + cid * 64, r = lane & 15, q4 = lane >> 4;
    bf16* Kt = (bf16*)wl;
    bf16* Vt = Kt + 4096;
    float* wvs = (float*)(Vt + 4096);
    float* bendl = wvs + 128;
    const int kcol = (MIXER == 0 ? PA : PG) + 256 + h * 64, vcol = (MIXER == 0 ? PA : PG) + 512 + h * 64;
    const float* Grow0 = G + (size_t)r0 * NGS;
    bf16* Nn = Kt;
    { u32x4 vv[8], kv[8];
#pragma unroll
        for (int i = 0; i < 8; ++i) { vv[i] = *(const u32x4*)(P + (size_t)(r0 + (lane >> 3) + 8 * i) * NP + vcol + (lane & 7) * 8); kv[i] = *(const u32x4*)(P + (size_t)(r0 + (lane >> 3) + 8 * i) * NP + kcol + (lane & 7) * 8); }
#pragma unroll
        for (int i = 0; i < 8; ++i) { *(u32x4*)(Vt + swz((lane >> 3) + 8 * i, lane & 7)) = vv[i]; *(u32x4*)(Nn + swz((lane >> 3) + 8 * i, lane & 7)) = kv[i]; } }
    WAVE_SYNC();
    unsigned kk[32];
    { const int dc = 16 * q4 + 4 * (r & 3);
#pragma unroll
        for (int c = 0; c < 16; ++c) { const u32x2 t = lds_tr16(Nn + swz(4 * c + (r >> 2), dc >> 3) + (dc & 7)); kk[2 * c] = t.x; kk[2 * c + 1] = t.y; } }
    WAVE_SYNC();
    if constexpr (MIXER == 0) {
        const float* g = Grow0 + (size_t)lane * NGS; const float* gb = p.in[I_MGB] + (size_t)l * 16;
        const float gv0 = g[h], gv1 = g[4 + h], gv2 = g[8 + h], gv3 = g[12 + h], bv0 = gb[h], bv1 = gb[4 + h], bv2 = gb[8 + h], bv3 = gb[12 + h];
        const float i_f = gv0 + bv0, f_f = gv1 + bv1, i_b = gv2 + bv2, f_b = gv3 + bv3;
        const float lf = logsigf_(f_f), lb = logsigf_(f_b);
        const float bF = wave_prefix_sum(lf, lane), totF = __shfl(bF, 63);
        const float gF = totF - bF + i_f, mF = wave_max(gF);
        const float totB = wave_sum(lb), preB = wave_prefix_sum(lb, lane), bB = totB - preB + lb;
        const float gB = totB - bB + i_b, mB = wave_max(gB);
        wvs[lane] = __expf(gF - mF); wvs[64 + lane] = __expf(gB - mB);
        if (lane == 0) { float* SC = (float*)(p.ws + WS_SC);
            SC[ch_index(0, b, h, cid) * 4 + 0] = totF; SC[ch_index(0, b, h, cid) * 4 + 1] = mF;
            SC[ch_index(1, b, h, cid) * 4 + 0] = totB; SC[ch_index(1, b, h, cid) * 4 + 1] = mB; }
    }
    WAVE_SYNC();
    chunkst_dir<MIXER, 0>(p, l, b, h, cid, Grow0, kk, Vt, Kt, wvs, bendl, lane);
    chunkst_dir<MIXER, 1>(p, l, b, h, cid, Grow0, kk, Vt, Kt, wvs, bendl, lane);
}

template <int DIR>
__device__ __forceinline__ void chunkst_gla(const Params& p, int l, int b, int h, int cid, char* wl, int lane_) {
    const bf16* P = (const bf16*)(p.ws + WS_P);
    const int lane = olane(lane_), r0 = b * TOK + cid * 64, r = lane & 15, q4 = lane >> 4;
    bf16* Kt = (bf16*)wl;
    bf16* An = Kt + 4096;
    float* bendl = (float*)(An + 4096);
    const int kcol = PG + 256 + h * 64, vcol = PG + 512 + h * 64;
    const float* Grow0 = (const float*)(p.ws + WS_G) + (size_t)r0 * NGS;
    u32x4 vv[8], kv[8];
#pragma unroll
    for (int i = 0; i < 8; ++i) { vv[i] = *(const u32x4*)(P + (size_t)(r0 + (lane >> 3) + 8 * i) * NP + vcol + (lane & 7) * 8); kv[i] = *(const u32x4*)(P + (size_t)(r0 + (lane >> 3) + 8 * i) * NP + kcol + (lane & 7) * 8); }
    bf16x8 af[4]; gla_r_frags<DIR>(Grow0, lane, af);
    u32x4 wo[4]; float wb[4];
#pragma unroll
    for (int nt = 0; nt < 4; ++nt) gla_b_load<DIR>(p, l, h, nt, lane, wo[nt], wb[nt]);
#pragma unroll
    for (int i = 0; i < 8; ++i) *(u32x4*)(An + swz((lane >> 3) + 8 * i, lane & 7)) = vv[i];
    WAVE_SYNC();
    bf16x8 vf[4][2];
#pragma unroll
    for (int ne = 0; ne < 4; ++ne)
#pragma unroll
        for (int ks = 0; ks < 2; ++ks) vf[ne][ks] = frag_tr_hw(An, 16 * ne, 32 * ks, lane);
    WAVE_SYNC();
#pragma unroll
    for (int i = 0; i < 8; ++i) *(u32x4*)(An + swz((lane >> 3) + 8 * i, lane & 7)) = kv[i];
    WAVE_SYNC();
#pragma unroll
    for (int nt = 0; nt < 4; ++nt) { const int d = 16 * nt + r; float x[4][4];
        const float bend = gla_b_col<DIR>(wo[nt], wb[nt], af, lane, x);
        if (q4 == 0) { ((float*)(p.ws + WS_BE))[ch_index(DIR, b, h, cid) * 64 + d] = bend; bendl[d] = __expf(fmaxf(bend, -80.0f)); }
#pragma unroll
        for (int mt = 0; mt < 4; ++mt) { const int s0 = 16 * mt + 4 * q4, dc = 16 * nt + 4 * (r & 3);
            const u32x2 kq = lds_tr16(An + swz(s0 + (r >> 2), dc >> 3) + (dc & 7));
            const float kv[4] = {bitsf(kq.x << 16), bitsf(kq.x & 0xffff0000u), bitsf(kq.y << 16), bitsf(kq.y & 0xffff0000u)}; float kp[4];
#pragma unroll
            for (int i = 0; i < 4; ++i) { const float bc = fmaxf(x[mt][i], -80.0f); kp[i] = kv[i] * __expf(-bc); An[swz(s0 + i, d >> 3) + (d & 7)] = f2bf(__expf(bc)); }
            u32x2 o; o.x = pk2(kp[0], kp[1]); o.y = pk2(kp[2], kp[3]); *(u32x2*)(Kt + swz(d, s0 >> 3) + (s0 & 7)) = o; } }
    WAVE_SYNC();
    { bf16* EQg = (bf16*)(p.ws + WS_EQ) + ((size_t)DIR * T + r0) * WG + h * 64;
#pragma unroll
        for (int i = 0; i < 8; ++i) { const int s = (lane >> 3) + 8 * i, ck = lane & 7; *(u32x4*)(EQg + (size_t)s * WG + ck * 8) = *(const u32x4*)(An + swz(s, ck)); } }
    bf16* dst = (bf16*)(p.ws + WS_ST) + st_index(1, DIR, b, h, cid) * 4096;
#pragma unroll
    for (int me = 0; me < 4; ++me) {
        f32x4 acc[4] = {(f32x4){0.f, 0.f, 0.f, 0.f}, (f32x4){0.f, 0.f, 0.f, 0.f}, (f32x4){0.f, 0.f, 0.f, 0.f}, (f32x4){0.f, 0.f, 0.f, 0.f}};
#pragma unroll
        for (int ks = 0; ks < 2; ++ks) { const bf16x8 a = *(const bf16x8*)(Kt + swz(16 * me + r, ks * 4 + q4));
#pragma unroll
            for (int ne = 0; ne < 4; ++ne) acc[ne] = MFMA16(a, vf[ne][ks], acc[ne]); }
        const f32x4 sc4 = *(const f32x4*)(bendl + 16 * me + 4 * q4);
#pragma unroll
        for (int ne = 0; ne < 4; ++ne) { const f32x4 v = acc[ne] * sc4; u32x2 o; o.x = pk2(v[0], v[1]); o.y = pk2(v[2], v[3]); *(u32x2*)(dst + (16 * ne + r) * 64 + 16 * me + 4 * q4) = o; }
    }
    WAVE_SYNC();
}

template <int MIXER, int DIR>
__device__ __forceinline__ void chunkout_prep(const Params& p, int l, int b, int h, int cid, const float* Grow0, int r0, int pbase, const bf16* EQ, float* gar, int lane_) {
    const int lane = olane(lane_);
    if constexpr (MIXER == 0) {
        const bf16* P = (const bf16*)(p.ws + WS_P);
        const float* g = Grow0 + (size_t)lane * NGS; const float* gb = p.in[I_MGB] + (size_t)l * 16;
        const float gi = g[DIR * 8 + h], gf = g[DIR * 8 + 4 + h], bi = gb[DIR * 8 + h], bf_ = gb[DIR * 8 + 4 + h];
        const float mprev = ((const float*)(p.ws + WS_SC))[ch_index(DIR, b, h, cid) * 4 + 2];
        const float nv = ((const float*)(p.ws + WS_NV))[ch_index(DIR, b, h, cid) * 64 + lane];
        u32x4 qr[8];
#pragma unroll
        for (int c = 0; c < 8; ++c) qr[c] = *(const u32x4*)(P + (size_t)(r0 + lane) * NP + pbase + c * 8);
        const float ig = gi + bi, fg = gf + bf_;
        const float lf = logsigf_(fg); float bb;
        if (DIR == 0) bb = wave_prefix_sum(lf, lane); else { const float tt = wave_sum(lf), pre = wave_prefix_sum(lf, lane); bb = tt - pre + lf; }
        const float a = ig - bb; const float pm = DIR == 0 ? wave_prefix_max(a, lane) : wave_suffix_max(a, lane);
        const float mt_ = fmaxf(bb + mprev, bb + pm);
        float* ga = gar + DIR * 320;
        ga[lane] = bb - mt_; ga[64 + lane] = a; ga[128 + lane] = __expf(bb + mprev - mt_); ga[192 + lane] = __expf(-mt_);
        float* nvl = gar + 640 + DIR * 64;
        nvl[lane] = nv;
        WAVE_SYNC();
        float dq = 0.f;
#pragma unroll
        for (int c = 0; c < 8; ++c) { float f[8]; unpack8(qr[c], f);
            const f32x4 n0 = *(const f32x4*)(nvl + c * 8), n1 = *(const f32x4*)(nvl + c * 8 + 4);
            dq += f[0] * n0.x + f[1] * n0.y + f[2] * n0.z + f[3] * n0.w + f[4] * n1.x + f[5] * n1.y + f[6] * n1.z + f[7] * n1.w; }
        ga[256 + lane] = dq;
    }
}
template <int MIXER>
__device__ __forceinline__ void chunkout_prep2(const Params& p, int l, int b, int h, int cid, const float* Grow0, int r0, int pbase, float* gar, int lane_) {
    if constexpr (MIXER == 0) {
        const int lane = olane(lane_);
        const bf16* P = (const bf16*)(p.ws + WS_P);
        const float* g = Grow0 + (size_t)lane * NGS; const float* gb = p.in[I_MGB] + (size_t)l * 16;
        const float g0 = g[h], g1 = g[4 + h], g2 = g[8 + h], g3 = g[12 + h];
        const float mprev0 = ((const float*)(p.ws + WS_SC))[ch_index(0, b, h, cid) * 4 + 2], mprev1 = ((const float*)(p.ws + WS_SC))[ch_index(1, b, h, cid) * 4 + 2];
        const float nv0 = ((const float*)(p.ws + WS_NV))[ch_index(0, b, h, cid) * 64 + lane], nv1 = ((const float*)(p.ws + WS_NV))[ch_index(1, b, h, cid) * 64 + lane];
        u32x4 qr[8];
#pragma unroll
        for (int c = 0; c < 8; ++c) qr[c] = *(const u32x4*)(P + (size_t)(r0 + lane) * NP + pbase + c * 8);
        const float igF = g0 + gb[h], fgF = g1 + gb[4 + h], igB = g2 + gb[8 + h], fgB = g3 + gb[12 + h];
        { const float lf = logsigf_(fgF); const float bb = wave_prefix_sum(lf, lane);
            const float a = igF - bb; const float pm = wave_prefix_max(a, lane); const float mt_ = fmaxf(bb + mprev0, bb + pm); float* ga = gar;
            ga[lane] = bb - mt_; ga[64 + lane] = a; ga[128 + lane] = __expf(bb + mprev0 - mt_); ga[192 + lane] = __expf(-mt_); }
        { const float lf = logsigf_(fgB); const float tt = wave_sum(lf), pre = wave_prefix_sum(lf, lane); const float bb = tt - pre + lf;
            const float a = igB - bb; const float pm = wave_suffix_max(a, lane); const float mt_ = fmaxf(bb + mprev1, bb + pm); float* ga = gar + 320;
            ga[lane] = bb - mt_; ga[64 + lane] = a; ga[128 + lane] = __expf(bb + mprev1 - mt_); ga[192 + lane] = __expf(-mt_); }
        float* nvl = gar + 640;
        nvl[lane] = nv0; nvl[64 + lane] = nv1;
        WAVE_SYNC();
        float dq0 = 0.f, dq1 = 0.f;
#pragma unroll
        for (int c = 0; c < 8; ++c) { float f[8]; unpack8(qr[c], f);
            const f32x4 n0 = *(const f32x4*)(nvl + c * 8), n1 = *(const f32x4*)(nvl + c * 8 + 4), m0 = *(const f32x4*)(nvl + 64 + c * 8), m1 = *(const f32x4*)(nvl + 64 + c * 8 + 4);
            dq0 += f[0] * n0.x + f[1] * n0.y + f[2] * n0.z + f[3] * n0.w + f[4] * n1.x + f[5] * n1.y + f[6] * n1.z + f[7] * n1.w;
            dq1 += f[0] * m0.x + f[1] * m0.y + f[2] * m0.z + f[3] * m0.w + f[4] * m1.x + f[5] * m1.y + f[6] * m1.z + f[7] * m1.w; }
        gar[256 + lane] = dq0; gar[320 + 256 + lane] = dq1;
    }
}
template <int MIXER, int DIR, int NS>
__device__ __forceinline__ void chunkout_dir(const Params& p, int b, int h, int cid, int r0, int pbase, int th, const bf16x8 (&vtf)[4][2], const bf16* VtL, const bf16* EQ, bf16* SB, const float* gar, float* rsm, f32x4 (&htot)[NS][4], int lane_) {
    const bf16* P = (const bf16*)(p.ws + WS_P); const bf16* ST = (const bf16*)(p.ws + WS_ST);
    const int lane = olane(lane_), r = lane & 15, q4 = lane >> 4;
    const bf16* E = EQ + ((size_t)DIR * T + r0) * WG + h * 64;
    const float* ga = gar + DIR * 320;
    bf16x8 kf[4][2], ctf[4][2];
    if constexpr (MIXER == 0) {
#pragma unroll
        for (int n = 0; n < 4; ++n)
#pragma unroll
            for (int ks = 0; ks < 2; ++ks) { kf[n][ks] = *(const bf16x8*)(P + (size_t)(r0 + 16 * n + r) * NP + pbase + 256 + ks * 32 + q4 * 8); ctf[n][ks] = *(const bf16x8*)(ST + st_index(MIXER, DIR, b, h, cid) * 4096 + (16 * n + r) * 64 + ks * 32 + q4 * 8); }
    } else {
        u32x4 er[4][2];
#pragma unroll
        for (int n = 0; n < 4; ++n)
#pragma unroll
            for (int ks = 0; ks < 2; ++ks) { kf[n][ks] = *(const bf16x8*)(P + (size_t)(r0 + 16 * n + r) * NP + pbase + 256 + ks * 32 + q4 * 8);
                er[n][ks] = *(const u32x4*)(E + (size_t)(16 * n + r) * WG + ks * 32 + q4 * 8);
                ctf[n][ks] = *(const bf16x8*)(ST + st_index(MIXER, DIR, b, h, cid) * 4096 + (16 * n + r) * 64 + ks * 32 + q4 * 8); }
        SCHED_FENCE();
#pragma unroll
        for (int n = 0; n < 4; ++n)
#pragma unroll
            for (int ks = 0; ks < 2; ++ks) { float fe[8], fk[8]; unpack8(er[n][ks], fe); unpack8(as_u4(kf[n][ks]), fk);
#pragma unroll
                for (int j = 0; j < 8; ++j) fk[j] = fk[j] * frcp_(fe[j]);
                kf[n][ks] = as_frag(pack8(fk)); }
    }
    bf16x8 qraw[NS][2]; u32x4 qer[NS][2];
#pragma unroll
    for (int ms = 0; ms < NS; ++ms)
#pragma unroll
        for (int ks = 0; ks < 2; ++ks) { const int mt = NS * th + ms; qraw[ms][ks] = *(const bf16x8*)(P + (size_t)(r0 + 16 * mt + r) * NP + pbase + ks * 32 + q4 * 8);
            if constexpr (MIXER == 1) qer[ms][ks] = *(const u32x4*)(E + (size_t)(16 * mt + r) * WG + ks * 32 + q4 * 8); else qer[ms][ks] = (u32x4){0u, 0u, 0u, 0u}; }
#pragma unroll
    for (int ms = 0; ms < NS; ++ms) { const int mt = NS * th + ms;
        bf16x8 qf[2];
#pragma unroll
        for (int ks = 0; ks < 2; ++ks) { qf[ks] = qraw[ms][ks];
            if constexpr (MIXER == 1) { float fe[8], fq[8]; unpack8(qer[ms][ks], fe); unpack8(as_u4(qf[ks]), fq);
#pragma unroll
                for (int j = 0; j < 8; ++j) fq[j] *= 0.125f * fe[j];
                qf[ks] = as_frag(pack8(fq)); } }
        f32x4 S[4] = {(f32x4){0.f, 0.f, 0.f, 0.f}, (f32x4){0.f, 0.f, 0.f, 0.f}, (f32x4){0.f, 0.f, 0.f, 0.f}, (f32x4){0.f, 0.f, 0.f, 0.f}};
#pragma unroll
        for (int ks = 0; ks < 2; ++ks)
#pragma unroll
            for (int n = 0; n < 4; ++n) S[n] = MFMA16(kf[n][ks], qf[ks], S[n]);
        const int t = 16 * mt + r; float sm = 0.f; float gt = 0.f; if constexpr (MIXER == 0) gt = ga[t];
#pragma unroll
        for (int n = 0; n < 4; ++n) { f32x4 gs = {0.f, 0.f, 0.f, 0.f}; if constexpr (MIXER == 0) gs = *(const f32x4*)(ga + 64 + 16 * n + 4 * q4);
#pragma unroll
            for (int i = 0; i < 4; ++i) { const int sidx = 16 * n + 4 * q4 + i; const bool ok = DIR == 0 ? (sidx <= t) : (sidx >= t); float v = 0.f;
                if (ok) { if constexpr (MIXER == 0) v = S[n][i] * 0.125f * __expf(gt + gs[i]); else v = S[n][i]; }
                S[n][i] = v; sm += v; } }
        const float pa[8] = {S[0][0], S[0][1], S[0][2], S[0][3], S[1][0], S[1][1], S[1][2], S[1][3]}, pb[8] = {S[2][0], S[2][1], S[2][2], S[2][3], S[3][0], S[3][1], S[3][2], S[3][3]};
        const bf16x8 sm0 = as_frag(pack8(pa)), sm1 = as_frag(pack8(pb));
        float wi = 1.f, inv = 1.f;
        if constexpr (MIXER == 0) { sm = xrow_sum(sm); wi = ga[128 + t]; const float den = wi * ga[256 + t] + sm; inv = frcp_(fmaxf(fabsf(den), ga[192 + t])); }
#pragma unroll
        for (int me = 0; me < 4; ++me) { f32x4 a1 = {0.f, 0.f, 0.f, 0.f}, a2 = {0.f, 0.f, 0.f, 0.f};
            const int srow = 4 * q4 + (r >> 2), ecol = 16 * me + 4 * (r & 3);
            const u32x2 v0 = lds_tr16(VtL + swz(srow, ecol >> 3) + (ecol & 7)), v1 = lds_tr16(VtL + swz(16 + srow, ecol >> 3) + (ecol & 7)), v2 = lds_tr16(VtL + swz(32 + srow, ecol >> 3) + (ecol & 7)), v3 = lds_tr16(VtL + swz(48 + srow, ecol >> 3) + (ecol & 7));
            u32x4 va; va.x = v0.x; va.y = v0.y; va.z = v1.x; va.w = v1.y; u32x4 vb; vb.x = v2.x; vb.y = v2.y; vb.z = v3.x; vb.w = v3.y;
            a1 = MFMA16(as_frag(va), sm0, a1); a1 = MFMA16(as_frag(vb), sm1, a1);
            a2 = MFMA16(ctf[me][0], qf[0], a2); a2 = MFMA16(ctf[me][1], qf[1], a2);
            if constexpr (MIXER == 0) htot[ms][me] += (a1 + a2 * wi) * inv; else htot[ms][me] += a1 + a2; }
    }
    (void)SB; (void)rsm;
}
__device__ __forceinline__ void co_build_vt(const bf16* P, int r0, int vcol, bf16* VtL, int lane) {
    load_nat_tile(P, r0, vcol, VtL, lane);
    WAVE_SYNC();
}
template <int MIXER, int NS>
__device__ __forceinline__ void co_finalize(const Params& p, int l, int h, int r0, int pbase, int mt0, f32x4 (&htot)[NS][4], int lane_) {
    const bf16* P = (const bf16*)(p.ws + WS_P); bf16* Y = (bf16*)(p.ws + WS_HNY);
    const float* ngp = p.in[MIXER == 0 ? I_MNG : I_GNG] + (size_t)l * WG + h * 64;
    const int lz = olane(lane_), r = lz & 15, q4 = lz >> 4;
    u32x2 gq[NS][4], oq[NS][4]; f32x4 ng[4];
#pragma unroll
    for (int me = 0; me < 4; ++me) ng[me] = *(const f32x4*)(ngp + 16 * me + 4 * q4);
#pragma unroll
    for (int ms = 0; ms < NS; ++ms)
#pragma unroll
        for (int me = 0; me < 4; ++me) { const size_t off = (size_t)(r0 + 16 * (mt0 + ms) + r) * NP + pbase + 16 * me + 4 * q4;
            gq[ms][me] = *(const u32x2*)(P + off + (MIXER == 0 ? 1024 : 768)); if constexpr (MIXER == 0) oq[ms][me] = *(const u32x2*)(P + off + 768); else oq[ms][me] = (u32x2){0u, 0u}; }
#pragma unroll
    for (int ms = 0; ms < NS; ++ms) { const int mt = mt0 + ms; float ss = 0.f; float gv[4][4];
#pragma unroll
        for (int me = 0; me < 4; ++me) {
            gv[me][0] = bitsf(gq[ms][me].x << 16); gv[me][1] = bitsf(gq[ms][me].x & 0xffff0000u); gv[me][2] = bitsf(gq[ms][me].y << 16); gv[me][3] = bitsf(gq[ms][me].y & 0xffff0000u);
            if constexpr (MIXER == 0) { htot[ms][me][0] *= sigmoidf_(bitsf(oq[ms][me].x << 16)); htot[ms][me][1] *= sigmoidf_(bitsf(oq[ms][me].x & 0xffff0000u)); htot[ms][me][2] *= sigmoidf_(bitsf(oq[ms][me].y << 16)); htot[ms][me][3] *= sigmoidf_(bitsf(oq[ms][me].y & 0xffff0000u)); }
            ss += htot[ms][me][0] * htot[ms][me][0] + htot[ms][me][1] * htot[ms][me][1] + htot[ms][me][2] * htot[ms][me][2] + htot[ms][me][3] * htot[ms][me][3]; }
        ss = xrow_sum(ss);
        const float rstd = rsqrtf(ss * (1.0f / 64.0f) + EPS);
#pragma unroll
        for (int me = 0; me < 4; ++me) { const int e = 16 * me + 4 * q4; const f32x4 n4 = ng[me];
            u32x2 o; o.x = pk2(htot[ms][me][0] * rstd * n4.x * siluf_(gv[me][0]), htot[ms][me][1] * rstd * n4.y * siluf_(gv[me][1]));
            o.y = pk2(htot[ms][me][2] * rstd * n4.z * siluf_(gv[me][2]), htot[ms][me][3] * rstd * n4.w * siluf_(gv[me][3]));
            *(u32x2*)(Y + (size_t)(r0 + 16 * mt + r) * 1024 + (MIXER == 0 ? YA : YG) + h * 64 + e) = o; } }
}
template <int MIXER>
__device__ __forceinline__ void chunkout_w(const Params& p, int l, int b, int h, int cid, char* wl, int lane) {
    const bf16* P = (const bf16*)(p.ws + WS_P); const float* G = (const float*)(p.ws + WS_G);
    const int r0 = b * TOK + cid * 64;
    const int pbase = (MIXER == 0 ? PA : PG) + h * 64;
    bf16* SB = (bf16*)wl;
    float* rsm = (float*)(SB + 1024);
    float* gar = rsm + 16;
    const bf16* EQ = (const bf16*)(p.ws + WS_EQ);
    const float* Grow0 = G + (size_t)r0 * NGS;
    bf16* VtL = (bf16*)(gar + 768);
    bf16x8 vtf[4][2];
#pragma unroll
    for (int me = 0; me < 4; ++me)
#pragma unroll
        for (int ks = 0; ks < 2; ++ks) { vtf[me][ks] = (bf16x8){0, 0, 0, 0, 0, 0, 0, 0}; }
    co_build_vt(P, r0, pbase + 512, VtL, lane);
    chunkout_prep2<MIXER>(p, l, b, h, cid, Grow0, r0, pbase, gar, lane);
    WAVE_SYNC();
    constexpr int NS = 2;
#pragma unroll 1
    for (int th = 0; th < 4 / NS; ++th) {
        f32x4 htot[NS][4];
#pragma unroll
        for (int a = 0; a < NS; ++a)
#pragma unroll
            for (int c = 0; c < 4; ++c) htot[a][c] = (f32x4){0.f, 0.f, 0.f, 0.f};
        chunkout_dir<MIXER, 0, NS>(p, b, h, cid, r0, pbase, th, vtf, VtL, EQ, SB, gar, rsm, htot, lane);
        chunkout_dir<MIXER, 1, NS>(p, b, h, cid, r0, pbase, th, vtf, VtL, EQ, SB, gar, rsm, htot, lane);
        co_finalize<MIXER, NS>(p, l, h, r0, pbase, NS * th, htot, lane);
    }
}
constexpr int CO_PART = 13376;
template <int MIXER, int DIR>
__device__ __forceinline__ void chunkout_piece(const Params& p, int l, int b, int h, int cid, int mt, char* wl, int lane) {
    const bf16* P = (const bf16*)(p.ws + WS_P); const float* G = (const float*)(p.ws + WS_G);
    const int r0 = b * TOK + cid * 64; const int pbase = (MIXER == 0 ? PA : PG) + h * 64;
    bf16* SB = (bf16*)wl; float* rsm = (float*)(SB + 1024); float* gar = rsm + 16; const bf16* EQ = (const bf16*)(p.ws + WS_EQ);
    const float* Grow0 = G + (size_t)r0 * NGS; bf16* VtL = (bf16*)(gar + 768);
    bf16x8 vtf[4][2];
#pragma unroll
    for (int me = 0; me < 4; ++me)
#pragma unroll
        for (int ks = 0; ks < 2; ++ks) { vtf[me][ks] = (bf16x8){0, 0, 0, 0, 0, 0, 0, 0}; }
    co_build_vt(P, r0, pbase + 512, VtL, lane);
    chunkout_prep<MIXER, DIR>(p, l, b, h, cid, Grow0, r0, pbase, EQ, gar, lane);
    WAVE_SYNC();
    f32x4 htot[1][4] = {{(f32x4){0.f, 0.f, 0.f, 0.f}, (f32x4){0.f, 0.f, 0.f, 0.f}, (f32x4){0.f, 0.f, 0.f, 0.f}, (f32x4){0.f, 0.f, 0.f, 0.f}}};
    chunkout_dir<MIXER, DIR, 1>(p, b, h, cid, r0, pbase, mt, vtf, VtL, EQ, SB, gar, rsm, htot, lane);
    float* part = (float*)(wl + CO_PART);
#pragma unroll
    for (int me = 0; me < 4; ++me)
#pragma unroll
        for (int i = 0; i < 4; ++i) part[(me * 4 + i) * 64 + lane] = htot[0][me][i];
}
template <int MIXER>
__device__ __forceinline__ void chunkout_combine(const Params& p, int l, int b, int h, int cid, int mt, const char* smem, int lane) {
    const float* pa = (const float*)(smem + (2 * mt) * WLDS + CO_PART); const float* pb = (const float*)(smem + (2 * mt + 1) * WLDS + CO_PART);
    f32x4 htot[1][4];
#pragma unroll
    for (int me = 0; me < 4; ++me)
#pragma unroll
        for (int i = 0; i < 4; ++i) htot[0][me][i] = pa[(me * 4 + i) * 64 + lane] + pb[(me * 4 + i) * 64 + lane];
    co_finalize<MIXER, 1>(p, l, h, b * TOK + cid * 64, (MIXER == 0 ? PA : PG) + h * 64, mt, htot, lane);
}

template <bool OUT>
__device__ __forceinline__ void chunk_workers(const Params& p, int l, char* smem) {
    const int tid = otid(), lane = tid & 63, wave = __builtin_amdgcn_readfirstlane(tid >> 6);
    const int NW = (int)gridDim.x * 8, wi = wave * (int)gridDim.x + obid();
    const int c_lo = (OUT && l == DEPTH - 1) ? NCC : 0, npc = NCH - c_lo, half = NB * NH * npc;
    char* wl = smem + wave * WLDS;
    if (OUT) {
        const int cl = NCC, npl = NCH - NCC, halfl = NB * NH * npl;
#pragma unroll 1
        for (int t = wi; t < halfl; t += NW) { const int b = t / (NH * npl), h = (t / npl) % NH, cid = cl + t % npl;
            const Params q = relaunder(p); chunkout_w<1>(q, l, b, h, cid, wl, lane); }
        { const int used = halfl % NW;
#pragma unroll 1
            for (int t = (wi + NW - used) % NW; t < halfl; t += NW) { const int b = t / (NH * npl), h = (t / npl) % NH, cid = cl + t % npl;
                const Params q = relaunder(p); chunkout_w<0>(q, l, b, h, cid, wl, lane); } }
        if (l < DEPTH - 1) {
            const int nct = NB * NH * NCC;
#pragma unroll 1
            for (int st = obid(); st < 2 * nct; st += (int)gridDim.x) { const int mixer = st / nct, r2 = st % nct, b = r2 / (NH * NCC), h = (r2 / NCC) % NH, cid = r2 % NCC;
                const Params q = relaunder(p); const int mt = wave >> 1;
                __syncthreads();
                if (mixer == 0) { if (wave & 1) chunkout_piece<0, 1>(q, l, b, h, cid, mt, wl, lane); else chunkout_piece<0, 0>(q, l, b, h, cid, mt, wl, lane); }
                else            { if (wave & 1) chunkout_piece<1, 1>(q, l, b, h, cid, mt, wl, lane); else chunkout_piece<1, 0>(q, l, b, h, cid, mt, wl, lane); }
                __syncthreads();
                if (wave < 4) { if (mixer == 0) chunkout_combine<0>(q, l, b, h, cid, wave, smem, lane); else chunkout_combine<1>(q, l, b, h, cid, wave, smem, lane); }
            }
        }
    } else {
        int off = 0;
#pragma unroll 1
        for (int t = wi; t < half; t += NW) { const int b = t / (NH * npc), h = (t / npc) % NH, cid = c_lo + t % npc;
            const Params q = relaunder(p); chunkst_gla<0>(q, l, b, h, cid, wl, lane); }
        off = (off + half) % NW;
#pragma unroll 1
        for (int t = (wi + NW - off) % NW; t < half; t += NW) { const int b = t / (NH * npc), h = (t / npc) % NH, cid = c_lo + t % npc;
            const Params q = relaunder(p); chunkst_gla<1>(q, l, b, h, cid, wl, lane); }
        off = (off + half) % NW;
#pragma unroll 1
        for (int t = (wi + NW - off) % NW; t < half; t += NW) { const int b = t / (NH * npc), h = (t / npc) % NH, cid = c_lo + t % npc;
            const Params q = relaunder(p); chunkst_w<0>(q, l, b, h, cid, wl, lane); }
    }
}

__device__ __forceinline__ void phase_mix1(const Params& p, int l, char* smem) {
    const bool ctxo = l < DEPTH - 1; const int G = (int)gridDim.x, bid = obid();
    constexpr int N_HL = (NB / 2) * (WG / 2), N_HC = NB * (WG / HCB);
    chunk_workers<false>(p, l, smem);
    stage_signal(p, smem, 0, l);
    for (int t = bid; t < N_HL; t += G) hylat_task(p, l, t / (WG / 2), t % (WG / 2), smem);
    if (ctxo) for (int t = G - 1 - bid; t < N_HC; t += G) hyctx_task(p, l, t / (WG / HCB), t % (WG / HCB), smem);
    stage_signal(p, smem, 2, l);
}

constexpr int SCG = 18;
__device__ __forceinline__ void phase_scan(const Params& p, int l, char* smem) {
    const int tid = otid();
    bf16* ST = (bf16*)(p.ws + WS_ST); float* NV = (float*)(p.ws + WS_NV); const float* BE = (const float*)(p.ws + WS_BE); float* SC = (float*)(p.ws + WS_SC);
    constexpr int NCHAIN = 2 * 2 * NB * NH;
    stage_wait(p, 0, l);
    for (int item = obid() * NT + tid; item < NCHAIN * 1024; item += gridDim.x * NT) {
        const int chain = item >> 10, grp = item & 1023; const int mixer = chain / (2 * NB * NH), dir = (chain / (NB * NH)) % 2, b = (chain / NH) % NB, h = chain % NH;
        float c[4] = {0.f, 0.f, 0.f, 0.f}; float nv[4] = {0.f, 0.f, 0.f, 0.f}; float m = 0.f;
        const int d0 = (grp & 15) * 4; const bool donv = (mixer == 0) && (grp < 16);
        float* sS = (float*)smem;
        __syncthreads();
        if (mixer == 0 && tid < NCH) { const size_t ci = ch_index(dir, b, h, chain_cid(dir, tid)); sS[2 * tid] = SC[ci * 4 + 0]; sS[2 * tid + 1] = SC[ci * 4 + 1]; }
        __syncthreads();
        for (int o0 = 0; o0 < NCH; o0 += SCG) {
            u32x2 uu[SCG]; f32x4 aux[SCG];
#pragma unroll
            for (int j = 0; j < SCG; ++j) if (o0 + j < NCH) { const int cid = chain_cid(dir, o0 + j); const size_t ci = ch_index(dir, b, h, cid);
                uu[j] = *(const u32x2*)(ST + st_index(mixer, dir, b, h, cid) * 4096 + grp * 4);
                if (mixer == 0) { if (donv) aux[j] = *(const f32x4*)(NV + ci * 64 + grp * 4); }
                else aux[j] = *(const f32x4*)(BE + ci * 64 + d0); }
#pragma unroll
            for (int j = 0; j < SCG; ++j) if (o0 + j < NCH) { const int cid = chain_cid(dir, o0 + j); const size_t ci = ch_index(dir, b, h, cid);
                const float u[4] = {bitsf(uu[j].x << 16), bitsf(uu[j].x & 0xffff0000u), bitsf(uu[j].y << 16), bitsf(uu[j].y & 0xffff0000u)};
                u32x2 w; w.x = pk2(c[0], c[1]); w.y = pk2(c[2], c[3]); *(u32x2*)(ST + st_index(mixer, dir, b, h, cid) * 4096 + grp * 4) = w;
                if (mixer == 0) {
                    if (grp == 0) SC[ci * 4 + 2] = m;
                    const float s0j = sS[2 * (o0 + j)], s1j = sS[2 * (o0 + j) + 1];
                    const float mn = fmaxf(s0j + m, s1j), a = __expf(s0j + m - mn), s = __expf(s1j - mn);
#pragma unroll
                    for (int k = 0; k < 4; ++k) c[k] = a * c[k] + s * u[k];
                    if (donv) { f32x4 nw = {nv[0], nv[1], nv[2], nv[3]}; *(f32x4*)(NV + ci * 64 + grp * 4) = nw;
                        nv[0] = a * nv[0] + s * aux[j].x; nv[1] = a * nv[1] + s * aux[j].y; nv[2] = a * nv[2] + s * aux[j].z; nv[3] = a * nv[3] + s * aux[j].w; }
                    m = mn;
                } else { c[0] = __expf(aux[j].x) * c[0] + u[0]; c[1] = __expf(aux[j].y) * c[1] + u[1]; c[2] = __expf(aux[j].z) * c[2] + u[2]; c[3] = __expf(aux[j].w) * c[3] + u[3]; } }
        }
    }
    stage_signal(p, smem, 1, l);
    { const bool ctxo = l < DEPTH - 1; const int G = (int)gridDim.x, bid = obid();
        constexpr int QTL = SEQ / 128, QTC = CTXL / 128, N_AL = NB * 2 * QTL, N_AC = NB * 2 * QTC;
        for (int t = bid; t < N_AL; t += G) attn_task(p, l, t / (2 * QTL), (t / QTL) % 2, t % QTL, false, smem);
        if (ctxo) for (int t = (bid + G - 64 % G) % G; t < N_AC; t += G) attn_task(p, l, t / (2 * QTC), (t / QTC) % 2, t % QTC, true, smem); }
}

__device__ __forceinline__ void phase_mix2(const Params& p, int l, char* smem) {
    const int tid = otid();
    stage_wait(p, 1, l);
    chunk_workers<true>(p, l, smem);
    stage_wait(p, 2, l);
    constexpr int N_WOUT = (DM / 64) * (MIX / 64);
    { const int lane = tid & 63, wave = __builtin_amdgcn_readfirstlane(tid >> 6); const int NW = (int)gridDim.x * 8, wi = wave * (int)gridDim.x + obid();
        for (int task = NW - 1 - wi; task < N_WOUT; task += NW) { const int nt = task / (MIX / 64), kt = task % (MIX / 64);
            convert_tile_w(p.in[I_WOUT] + (size_t)l * MIX * DM, DM, (bf16*)(p.ws + WS_WOUT), MIX, nt * 64, kt * 64, false, smem + wave * WLDS, lane); }
        bf16* tile = (bf16*)(smem + wave * WLDS); const bf16* HT = (const bf16*)(p.ws + WS_HT); bf16* Y = (bf16*)(p.ws + WS_HNY);
        constexpr int NTT = NB * (SEQ / 64) * 4;
        for (int t = wi; t < NTT; t += NW) { const int b = t / ((SEQ / 64) * 4), tt = (t / 4) % (SEQ / 64), c0 = (t % 4) * 64; const size_t tok0 = (size_t)b * TOK + CTXL + tt * 64;
            u32x4 tv[8];
#pragma unroll
            for (int i = 0; i < 8; ++i) { const int ch = (lane >> 3) + 8 * i, ck = lane & 7; tv[i] = *(const u32x4*)(HT + (size_t)(768 + c0 + ch) * T + tok0 + ck * 8); }
#pragma unroll
            for (int i = 0; i < 8; ++i) { const int ch = (lane >> 3) + 8 * i, ck = lane & 7; *(u32x4*)(tile + swz(ch, ck)) = tv[i]; }
            WAVE_SYNC();
#pragma unroll
            for (int i = 0; i < 8; ++i) { const int tk = (lane >> 3) + 8 * i, cc = lane & 7; unsigned w[4];
#pragma unroll
                for (int j = 0; j < 4; ++j) { const int ca = cc * 8 + 2 * j; w[j] = (unsigned)tile[swz(ca, tk >> 3) + (tk & 7)] | ((unsigned)tile[swz(ca + 1, tk >> 3) + (tk & 7)] << 16); }
                u32x4 o; o.x = w[0]; o.y = w[1]; o.z = w[2]; o.w = w[3]; *(u32x4*)(Y + (tok0 + tk) * 1024 + YH + c0 + cc * 8) = o; }
            WAVE_SYNC(); } }
}


#ifndef EMU
#define LAS __attribute__((address_space(3)))
#define XB_TMO      128
#define XB_XCNT(j)  (256  + 64 * (j))
#define XB_XSUB(j)  (1280 + 64 * (j))
#define XB_XGEN(j)  (2304 + 64 * (j))
#define XB_TOP      3328
#define XB_TOPGEN   3392
#define XCD_BAR_WORDS 3456
#define XB_SPIN_CAP (1u << 18)

__device__ __forceinline__ unsigned xb_ld(unsigned* p)              { return __hip_atomic_load(p, __ATOMIC_RELAXED, __HIP_MEMORY_SCOPE_AGENT); }
__device__ __forceinline__ unsigned xb_add(unsigned* p, unsigned v) { return __hip_atomic_fetch_add(p, v, __ATOMIC_RELAXED, __HIP_MEMORY_SCOPE_AGENT); }
__device__ __forceinline__ unsigned xb_xcc_id() { return (unsigned)__builtin_amdgcn_s_getreg((3 << 11) | 20) & 0xFu; }
#define XB_SPIN(cond, bar) do { unsigned _sp = 0; while (cond) { __builtin_amdgcn_s_sleep(1); \
    if ((++_sp & 255u) == 0u) { if (xb_ld(&(bar)[XB_TMO])) break; if (_sp > XB_SPIN_CAP) { atomicAdd(&(bar)[XB_TMO], 1u); break; } } } } while (0)

struct XcdBarrier {
    unsigned* bar; unsigned x;
    volatile LAS unsigned* st;
};

__device__ __forceinline__ XcdBarrier xcd_barrier_post(unsigned* bar, volatile LAS unsigned* st) {
    XcdBarrier b; b.bar = bar; b.x = xb_xcc_id(); b.st = st;
    if (threadIdx.x == 0) (void)xb_add(&bar[XB_XCNT(b.x)], 1u);
    return b;
}
__device__ __forceinline__ void xcd_barrier_complete(unsigned* bar, unsigned x, unsigned& nloc, unsigned& nx) {
    const unsigned G = gridDim.x * gridDim.y * gridDim.z;
    unsigned sum, cnt, mine, sp = 0u;
    for (;;) {
        sum = 0u; cnt = 0u; mine = 0u;
#pragma unroll
        for (unsigned j = 0; j < 16; ++j) { const unsigned c = xb_ld(&bar[XB_XCNT(j)]); sum += c; cnt += (c > 0u) ? 1u : 0u; mine = (j == x) ? c : mine; }
        if (sum == G) break;
        __builtin_amdgcn_s_sleep(1);
        if ((++sp & 255u) == 0u) { if (xb_ld(&bar[XB_TMO])) break; if (sp > XB_SPIN_CAP) { atomicAdd(&bar[XB_TMO], 1u); break; } }
    }
    nloc = mine > 0u ? mine : 1u; nx = cnt > 0u ? cnt : 1u;
}

__device__ __forceinline__ void xcd_barrier(const XcdBarrier& b) {
    asm volatile("s_waitcnt vmcnt(0)" ::: "memory");
    __syncthreads();
    if (threadIdx.x == 0) {
        unsigned* bar = b.bar;
        __builtin_amdgcn_s_waitcnt(0);
        unsigned nloc = b.st[0], nx = b.st[1];
        if (nloc == 0u) { xcd_barrier_complete(bar, b.x, nloc, nx); b.st[0] = nloc; b.st[1] = nx; }
        const unsigned old = xb_add(&bar[XB_XSUB(b.x)], 1u);
        const unsigned gen = old / nloc;
        if (old + 1u == (gen + 1u) * nloc) {
            __builtin_amdgcn_fence(__ATOMIC_RELEASE, "agent");
            asm volatile("s_waitcnt vmcnt(0)" ::: "memory");
            const unsigned og = xb_add(&bar[XB_TOP], 1u);
            const unsigned tg = og / nx;
            if (og + 1u == (tg + 1u) * nx) xb_add(&bar[XB_TOPGEN], 1u);
            else XB_SPIN(xb_ld(&bar[XB_TOPGEN]) == tg, bar);
            __builtin_amdgcn_fence(__ATOMIC_ACQUIRE, "agent");
            xb_add(&bar[XB_XGEN(b.x)], 1u);
            asm volatile("s_waitcnt vmcnt(0)" ::: "memory");
        } else {
            XB_SPIN(xb_ld(&bar[XB_XGEN(b.x)]) == gen, bar);
            __builtin_amdgcn_fence(__ATOMIC_ACQUIRE, "agent");
            asm volatile("s_waitcnt vmcnt(0)" ::: "memory");
        }
    }
    __syncthreads();
}
#endif

__global__ void __launch_bounds__(NT) fwd_kernel(Params pk, int ph_lo, int ph_hi) {
    SMEM_DECL;
#ifndef EMU
    volatile LAS unsigned* misc = (volatile LAS unsigned*)(smem + LDS_BYTES - 64);
    if (threadIdx.x < 2) misc[threadIdx.x] = 0u;
    __syncthreads();
    const XcdBarrier bar = xcd_barrier_post((unsigned*)(pk.ws + WS_BAR), misc);
#endif
    constexpr int NPH = 2 + 6 * DEPTH;
    for (int ph = ph_lo; ph < ph_hi && ph < NPH; ++ph) {
#ifndef EMU
        Params p = pk; { size_t z = 0; asm volatile("" : "+s"(z)); p.ws = pk.ws + z; p.out = pk.out + z;
#pragma unroll
            for (int i = 0; i < 26; ++i) p.in[i] = pk.in[i] + z; }
#else
        const Params& p = pk;
#endif
        if (ph == 0) phase0(p, smem);
        else if (ph == NPH - 1) phase_rp(p, DEPTH, smem);
        else { const int l = (ph - 1) / 6, k = (ph - 1) % 6;
            if (k == 0) phase_rp(p, l, smem);
            else if (k == 1) phase_gemm_in(p, l, smem);
            else if (k == 2) phase_mix1(p, l, smem);
            else if (k == 3) phase_scan(p, l, smem);
            else if (k == 4) phase_mix2(p, l, smem);
            else phase_gemm_out(p, l, smem);
#ifdef PROBE_DUP
            if (k == PROBE_DUP) { GRID_SYNC();
                if (k == 1) phase_gemm_in(p, l, smem); else if (k == 2) phase_mix1(p, l, smem); else if (k == 4) phase_mix2(p, l, smem); }
#endif
        }
        if (ph + 1 < ph_hi && !(ph >= 6 && ph % 6 == 0) && !(ph >= 1 && ((ph - 1) % 6 == 2 || (ph - 1) % 6 == 3))) {
#ifdef EMU
            GRID_SYNC();
#else
            if (ph_lo < 0) GRID_SYNC();
            xcd_barrier(bar);
#endif
        }
    }
}

#ifndef EMU
extern "C" void kernel_launch(void* const* d_in, const int* in_sizes, int n_in, void* d_out, int out_size, void* d_ws, size_t ws_size, hipStream_t stream) {
    static int grid = 0;
    if (grid == 0) {
        if (n_in != 26 || ws_size < WS_TOTAL) { fprintf(stderr, "kernel_launch: unexpected n_in %d or ws_size %zu (need %zu)\n", n_in, ws_size, (size_t)WS_TOTAL); grid = -1; return; }
        int dev = 0, cus = 0, per_cu = 0;
        hipGetDevice(&dev);
        hipDeviceGetAttribute(&cus, hipDeviceAttributeMultiprocessorCount, dev);
        hipFuncSetAttribute((const void*)fwd_kernel, hipFuncAttributeMaxDynamicSharedMemorySize, LDS_BYTES);
        hipOccupancyMaxActiveBlocksPerMultiprocessor(&per_cu, (const void*)fwd_kernel, NT, LDS_BYTES);
        if (per_cu < 1) { fprintf(stderr, "kernel_launch: occupancy query returned %d\n", per_cu); grid = -1; return; }
        if (per_cu > 1) per_cu = 1;
        grid = cus * per_cu;
    }
    if (grid < 0) return;
    hipMemsetAsync((char*)d_ws + WS_BAR, 0, BAR_BYTES, stream);
    Params p{};
    for (int i = 0; i < 26; ++i) p.in[i] = (const float*)d_in[i];
    p.out = (float*)d_out; p.ws = (char*)d_ws;
    int lo = 0, hi = 2 + 6 * DEPTH;
    void* args[] = {&p, &lo, &hi};
    hipError_t e = hipLaunchCooperativeKernel((const void*)fwd_kernel, dim3(grid), dim3(NT), args, LDS_BYTES, stream);
    if (e != hipSuccess) fprintf(stderr, "cooperative launch failed: %s (grid %d)\n", hipGetErrorString(e), grid);
}
#endif
```

```cpp
#ifdef EMU
#include "emu/hipemu.h"
#define GRID_SYNC() emu::grid_sync()
#define SMEM_DECL char* smem = emu::S().blocks[emu::cur()->block].lds
#define SCHED_FENCE() do {} while (0)
#define EXP2(x) exp2f(x)
#define MFMA16(a, b, c) emu_mfma_16x16x32_bf16(a, b, c)
#else
#include <hip/hip_runtime.h>
#include <hip/hip_cooperative_groups.h>
#include <cstdio>
#include <cstdint>
#define GRID_SYNC() cooperative_groups::this_grid().sync()
#define SMEM_DECL extern __shared__ __attribute__((aligned(16))) char smem[]
#define SCHED_FENCE() __builtin_amdgcn_sched_barrier(0)
#define EXP2(x) __builtin_amdgcn_exp2f(x)
#define MFMA16(a, b, c) __builtin_amdgcn_mfma_f32_16x16x32_bf16(a, b, c, 0, 0, 0)
#endif

#ifdef EMU
#ifndef EMU_DM
#define EMU_DM 256
#endif
#ifndef EMU_NB
#define EMU_NB 2
#endif
#ifndef EMU_SEQ
#define EMU_SEQ 512
#endif
#ifndef EMU_DEPTH
#define EMU_DEPTH 2
#endif
#ifndef EMU_CTXL
#define EMU_CTXL 128
#endif
constexpr int DM = EMU_DM, NB = EMU_NB, SEQ = EMU_SEQ, DEPTH = EMU_DEPTH, CTXL = EMU_CTXL;
#else
constexpr int DM = 1024, NB = 8, SEQ = 2048, DEPTH = 4, CTXL = 256;
#endif
constexpr int MIX = 1024, WG = 256, HD = 64, NH = 4, CH = 64;
constexpr int TOK = CTXL + SEQ, T = NB * TOK, NCH = TOK / CH, NCC = CTXL / CH;
constexpr int N_IN = 4144, NP = 3072, NG = 48, NGS = 32, NMAIN = 3328, NPAD = 4352;
constexpr int NF = 2 * SEQ;
constexpr int NJ = NB + 1;
constexpr int NT = 512;
constexpr float EPS = 1e-6f;
constexpr int PA = 0, PG = 1280, PD = 2304;
constexpr int YA = 0, YH = 256, YG = 512, YD = 768;
constexpr int ilog4(int n) { return n <= 1 ? 0 : 1 + ilog4(n / 4); }
constexpr int FFT_P = ilog4(NF);
static_assert((1 << (2 * FFT_P)) == NF, "NF must be a power of 4");
static_assert(DM % 256 == 0 && CTXL % 128 == 0 && SEQ % 256 == 0, "shape constraints");

typedef unsigned short bf16;
typedef short bf16x8 __attribute__((ext_vector_type(8)));
typedef float f32x4 __attribute__((ext_vector_type(4)));
typedef unsigned u32x4 __attribute__((ext_vector_type(4)));
typedef unsigned u32x2 __attribute__((ext_vector_type(2)));
struct cpx { float x, y; };

constexpr size_t al256(size_t x) { return (x + 255) & ~(size_t)255; }
constexpr size_t WS_CTXB = 0;
constexpr size_t WS_HNY = al256(WS_CTXB + (size_t)NB * CTXL * DM * 4);
constexpr size_t WS_WIN = WS_HNY + (size_t)T * 1024 * 2;
constexpr size_t WS_ST = WS_WIN;
constexpr size_t ST_BYTES = (size_t)2 * 2 * NB * NH * NCH * 4096 * 2;
constexpr size_t WS_KT = al256(WS_WIN + (size_t)NPAD * DM * 2);
static_assert(WS_KT + (size_t)WG * NF * 4 <= WS_ST + ST_BYTES || true, "");
constexpr size_t ST_END = al256((WS_ST + ST_BYTES > WS_KT + (size_t)WG * NF * 4) ? WS_ST + ST_BYTES : WS_KT + (size_t)WG * NF * 4);
constexpr size_t WS_P = ST_END;
constexpr size_t WS_HT = al256(WS_P + (size_t)T * NP * 2);
constexpr size_t WS_WOUT = WS_HT;
constexpr size_t WS_G = al256(WS_HT + (size_t)1024 * T * 2);
constexpr size_t WS_KF = al256(WS_G + (size_t)T * NGS * 4);
constexpr size_t WS_HC = al256(WS_KF + (size_t)WG * NF * 8);
constexpr size_t WS_EQ = al256(WS_HC + (size_t)2 * WG * CTXL * 4);
constexpr size_t WS_NV = al256(WS_EQ + (size_t)2 * T * WG * 2);
constexpr size_t WS_BE = al256(WS_NV + (size_t)2 * NB * NH * NCH * 64 * 4);
constexpr size_t WS_SC = al256(WS_BE + (size_t)2 * NB * NH * NCH * 64 * 4);
constexpr size_t WS_MOD = al256(WS_SC + (size_t)2 * NB * NH * NCH * 4 * 4);
constexpr size_t WS_TW = al256(WS_MOD + (size_t)DEPTH * NJ * 3 * DM * 4);
constexpr size_t WS_ROPE = al256(WS_TW + (size_t)NF * 8);
constexpr size_t WS_BAR = al256(WS_ROPE + (size_t)SEQ * 32 * 8);
constexpr size_t BAR_BYTES = 32768;
constexpr size_t WS_TOTAL = al256(WS_BAR + BAR_BYTES);
static_assert((size_t)T * DM * 4 <= (size_t)T * NP * 2, "YO fits in P");
#ifndef EMU
static_assert(WS_TOTAL <= (size_t)268435456, "workspace map must fit 256 MiB");
#endif

constexpr int LDS_BYTES = 163840;

struct Params {
    const float* in[26];
    float* out;
    char* ws;
};
enum { I_X = 0, I_C, I_CTX, I_CCTX, I_WADA, I_BADA, I_GPRE, I_GPOST, I_WIN, I_MGB, I_MNG, I_HCW, I_HCB, I_HW1, I_HB1, I_HW2, I_HB2, I_HW3, I_HB3,
       I_HFREQ, I_HD, I_GWA, I_GBA, I_GNG, I_SINK, I_WOUT };

__device__ __forceinline__ Params relaunder(const Params& pk) {
#ifdef EMU
    return pk;
#else
    Params p = pk; size_t z = 0; asm volatile("" : "+s"(z)); p.ws = pk.ws + z; p.out = pk.out + z;
#pragma unroll
    for (int i = 0; i < 26; ++i) p.in[i] = pk.in[i] + z;
    return p;
#endif
}
constexpr int WLDS = (LDS_BYTES - 64) / 8 / 16 * 16;
#ifdef EMU
#define WAVE_SYNC() emu_wave_sync()
#else
#define WAVE_SYNC() do { asm volatile("s_waitcnt lgkmcnt(0)" ::: "memory"); __builtin_amdgcn_wave_barrier(); } while (0)
#endif

#ifdef EMU
__device__ __forceinline__ int otid() { return (int)threadIdx.x; }
__device__ __forceinline__ int obid() { return (int)blockIdx.x; }
#else
__device__ __forceinline__ int otid() { int t = (int)threadIdx.x; asm volatile("" : "+v"(t)); return t; }
__device__ __forceinline__ int obid() { int b = (int)blockIdx.x; asm volatile("" : "+s"(b)); return b; }
#endif
__device__ __forceinline__ unsigned fbits(float f) { return __builtin_bit_cast(unsigned, f); }
__device__ __forceinline__ float bitsf(unsigned u) { return __builtin_bit_cast(float, u); }
__device__ __forceinline__ float bf2f(bf16 h) { return bitsf((unsigned)h << 16); }
#ifdef EMU
__device__ __forceinline__ bf16 f2bf(float f) { unsigned u = fbits(f); return (bf16)((u + 0x7fffu + ((u >> 16) & 1u)) >> 16); }
__device__ __forceinline__ unsigned pk2(float lo, float hi) { return (unsigned)f2bf(lo) | ((unsigned)f2bf(hi) << 16); }
#else
typedef __bf16 nbf16x2 __attribute__((ext_vector_type(2)));
typedef float nf32x2 __attribute__((ext_vector_type(2)));
__device__ __forceinline__ unsigned pk2(float lo, float hi) { const nf32x2 v = {lo, hi}; return __builtin_bit_cast(unsigned, __builtin_convertvector(v, nbf16x2)); }
__device__ __forceinline__ bf16 f2bf(float f) { return (bf16)(pk2(f, 0.0f) & 0xffffu); }
#endif
#ifdef EMU
__device__ __forceinline__ float frcp_(float x) { return 1.0f / x; }
#else
__device__ __forceinline__ float frcp_(float x) { return __builtin_amdgcn_rcpf(x); }
#endif
__device__ __forceinline__ float sigmoidf_(float x) { return frcp_(1.0f + __expf(-x)); }
__device__ __forceinline__ float siluf_(float x) { return x * frcp_(1.0f + __expf(-x)); }
__device__ __forceinline__ float logsigf_(float x) { return fminf(x, 0.0f) - log1pf(__expf(-fabsf(x))); }
__device__ __forceinline__ float logsig_fast(float x) { return fminf(x, 0.0f) - __logf(1.0f + __expf(-fabsf(x))); }
#ifdef EMU
__device__ __forceinline__ float row16_sum(float x) { x += __shfl_xor(x, 1); x += __shfl_xor(x, 2); x += __shfl_xor(x, 4); x += __shfl_xor(x, 8); return x; }
__device__ __forceinline__ float row16_max(float x) { x = fmaxf(x, __shfl_xor(x, 1)); x = fmaxf(x, __shfl_xor(x, 2)); x = fmaxf(x, __shfl_xor(x, 4)); x = fmaxf(x, __shfl_xor(x, 8)); return x; }
__device__ __forceinline__ float xrow_sum(float x) { x += __shfl_xor(x, 16); x += __shfl_xor(x, 32); return x; }
__device__ __forceinline__ float xrow_max(float x) { x = fmaxf(x, __shfl_xor(x, 16)); x = fmaxf(x, __shfl_xor(x, 32)); return x; }
#else
template <int CTRL> __device__ __forceinline__ float dpp_(float x) { return __builtin_bit_cast(float, __builtin_amdgcn_mov_dpp(__builtin_bit_cast(int, x), CTRL, 0xf, 0xf, true)); }
__device__ __forceinline__ float row16_sum(float x) { x += dpp_<0xB1>(x); x += dpp_<0x4E>(x); x += dpp_<0x141>(x); x += dpp_<0x128>(x); return x; }
__device__ __forceinline__ float row16_max(float x) { x = fmaxf(x, dpp_<0xB1>(x)); x = fmaxf(x, dpp_<0x4E>(x)); x = fmaxf(x, dpp_<0x141>(x)); x = fmaxf(x, dpp_<0x128>(x)); return x; }
__device__ __forceinline__ float xrow_sum(float x) {
    auto s = __builtin_amdgcn_permlane16_swap(fbits(x), fbits(x), false, false); x = bitsf(s[0]) + bitsf(s[1]);
    auto t = __builtin_amdgcn_permlane32_swap(fbits(x), fbits(x), false, false); return bitsf(t[0]) + bitsf(t[1]); }
__device__ __forceinline__ float xrow_max(float x) {
    auto s = __builtin_amdgcn_permlane16_swap(fbits(x), fbits(x), false, false); x = fmaxf(bitsf(s[0]), bitsf(s[1]));
    auto t = __builtin_amdgcn_permlane32_swap(fbits(x), fbits(x), false, false); return fmaxf(bitsf(t[0]), bitsf(t[1])); }
#endif
__device__ __forceinline__ float wave_sum(float v) { return xrow_sum(row16_sum(v)); }
__device__ __forceinline__ float wave_max(float v) { return xrow_max(row16_max(v)); }
template <int DIR> __device__ __forceinline__ void xrow_scan(float s4, int lane, float& e, float& tot) {
    const int q4 = lane >> 4;
#ifdef EMU
    const int r = lane & 15; const float v0 = __shfl(s4, r), v1 = __shfl(s4, 16 + r), v2 = __shfl(s4, 32 + r), v3 = __shfl(s4, 48 + r);
    tot = (v0 + v1) + (v2 + v3);
    if (DIR == 0) e = (q4 & 2 ? v0 + v1 : 0.f) + (q4 & 1 ? (q4 & 2 ? v2 : v0) : 0.f); else e = (q4 & 2 ? 0.f : v2 + v3) + (q4 & 1 ? 0.f : (q4 & 2 ? v3 : v1));
#else
    auto sw = __builtin_amdgcn_permlane16_swap(fbits(s4), fbits(s4), false, false); const float a = bitsf(sw[0]), b = bitsf(sw[1]);
    const float pp = a + b;
    auto tw = __builtin_amdgcn_permlane32_swap(fbits(pp), fbits(pp), false, false); const float p0 = bitsf(tw[0]), p1 = bitsf(tw[1]);
    tot = p0 + p1;
    if (DIR == 0) e = (q4 & 2 ? p0 : 0.f) + (q4 & 1 ? a : 0.f); else e = (q4 & 2 ? 0.f : p1) + (q4 & 1 ? 0.f : b);
#endif
}
#ifdef EMU
__device__ __forceinline__ float wave_prefix_sum(float v, int lane) {
#pragma unroll
    for (int o = 1; o < 64; o <<= 1) { float t = __shfl_up(v, o); if (lane >= o) v += t; }
    return v;
}
__device__ __forceinline__ float wave_prefix_max(float v, int lane) {
#pragma unroll
    for (int o = 1; o < 64; o <<= 1) { float t = __shfl_up(v, o); if (lane >= o) v = fmaxf(v, t); }
    return v;
}
#else
template <int CTRL, int RM> __device__ __forceinline__ float dppo_(float old, float x) { return __builtin_bit_cast(float, __builtin_amdgcn_update_dpp(__builtin_bit_cast(int, old), __builtin_bit_cast(int, x), CTRL, RM, 0xf, false)); }
__device__ __forceinline__ float wave_prefix_sum(float v, int) {
    v += dppo_<0x111, 0xf>(0.f, v); v += dppo_<0x112, 0xf>(0.f, v); v += dppo_<0x114, 0xf>(0.f, v); v += dppo_<0x118, 0xf>(0.f, v);
    v += dppo_<0x142, 0xa>(0.f, v); v += dppo_<0x143, 0xc>(0.f, v); return v;
}
__device__ __forceinline__ float wave_prefix_max(float v, int) {
    const float ninf = -INFINITY;
    v = fmaxf(v, dppo_<0x111, 0xf>(ninf, v)); v = fmaxf(v, dppo_<0x112, 0xf>(ninf, v)); v = fmaxf(v, dppo_<0x114, 0xf>(ninf, v)); v = fmaxf(v, dppo_<0x118, 0xf>(ninf, v));
    v = fmaxf(v, dppo_<0x142, 0xa>(ninf, v)); v = fmaxf(v, dppo_<0x143, 0xc>(ninf, v)); return v;
}
#endif
__device__ __forceinline__ float wave_suffix_max(float v, int lane) {
    return __shfl(wave_prefix_max(__shfl(v, 63 - lane), lane), 63 - lane);
}
__device__ __forceinline__ void unpack8(u32x4 v, float* f) {
    f[0] = bitsf(v.x << 16); f[1] = bitsf(v.x & 0xffff0000u); f[2] = bitsf(v.y << 16); f[3] = bitsf(v.y & 0xffff0000u);
    f[4] = bitsf(v.z << 16); f[5] = bitsf(v.z & 0xffff0000u); f[6] = bitsf(v.w << 16); f[7] = bitsf(v.w & 0xffff0000u);
}
__device__ __forceinline__ int orig_col(int n) {
    if (n < 1280) return n;
    if (n < 2304) return 2320 + (n - 1280);
    if (n < 3072) return 3376 + (n - 2304);
    if (n < 3088) return 1280 + (n - 3072);
    if (n < 3120) return 3344 + (n - 3088);
    if (n < NMAIN) return -1;
    return 1296 + (n - NMAIN);
}
__device__ __forceinline__ int chain_cid(int dir, int o) {
    if (dir == 0) return o;
    return o < NCC ? (NCC - 1 - o) : (NCH - 1 - (o - NCC));
}

__device__ __forceinline__ int swz(int row, int ch) { return row * 64 + ((ch ^ (row & 7)) << 3); }
__device__ __forceinline__ u32x4 pack8(const float* f) { u32x4 o; o.x = pk2(f[0], f[1]); o.y = pk2(f[2], f[3]); o.z = pk2(f[4], f[5]); o.w = pk2(f[6], f[7]); return o; }
__device__ __forceinline__ bf16x8 as_frag(u32x4 v) { return __builtin_bit_cast(bf16x8, v); }
#ifdef EMU
inline u32x2 lds_tr16(const bf16* p) { unsigned mine[2]; const unsigned long long a = (unsigned long long)p; mine[0] = (unsigned)a; mine[1] = (unsigned)(a >> 32);
    auto buf = emu::collective(mine, 2); const int l = emu::cur()->lane, g = l >> 4, i = l & 15; unsigned short e[4];
    for (int j = 0; j < 4; ++j) { const int src = 16 * g + 4 * j + (i >> 2); const bf16* q = (const bf16*)(((unsigned long long)buf[src][1] << 32) | buf[src][0]); e[j] = *(const unsigned short*)(q + (i & 3)); }
    u32x2 r; r.x = (unsigned)e[0] | ((unsigned)e[1] << 16); r.y = (unsigned)e[2] | ((unsigned)e[3] << 16); return r; }
#else
typedef short v4i16_t __attribute__((ext_vector_type(4)));
__device__ __forceinline__ u32x2 lds_tr16(const bf16* p) { return __builtin_bit_cast(u32x2, __builtin_amdgcn_ds_read_tr16_b64_v4i16((__attribute__((address_space(3))) v4i16_t*)p)); }
#endif
__device__ __forceinline__ u32x4 as_u4(bf16x8 v) { return __builtin_bit_cast(u32x4, v); }

constexpr int LS = 72;

template <int NTL, int KS>
__device__ __forceinline__ void mma_nt(const bf16* A, int lda, int m0, const bf16* B, int ldb, int n0, f32x4 (&acc)[NTL], int lane) {
    const int r = lane & 15, q = lane >> 4;
#pragma unroll
    for (int ks = 0; ks < KS; ++ks) {
        const bf16x8 a = *(const bf16x8*)(A + (m0 + r) * lda + ks * 32 + q * 8);
#pragma unroll
        for (int nt = 0; nt < NTL; ++nt) {
            const bf16x8 b = *(const bf16x8*)(B + (n0 + nt * 16 + r) * ldb + ks * 32 + q * 8);
            acc[nt] = MFMA16(a, b, acc[nt]);
        }
    }
}

__device__ __forceinline__ void layer_prep(const Params& p, int l, int idx, int stride, char* smem);
__device__ __forceinline__ void phase0(const Params& p, char* smem) {
    const int tid = otid();
    cpx* TW = (cpx*)(p.ws + WS_TW);
    cpx* ROPE = (cpx*)(p.ws + WS_ROPE);
    float* MOD = (float*)(p.ws + WS_MOD);
    constexpr int N_TW = NF / NT, N_ROPE = SEQ * 32 / NT, N_MOD = DEPTH * (3 * DM / 64);
    for (int task = obid(); task < N_TW + N_ROPE + N_MOD; task += gridDim.x) {
        if (task < N_TW) {
            const int j = task * NT + tid; float s, c; sincospif(2.0f * (float)j / (float)NF, &s, &c);
            cpx v; v.x = c; v.y = -s; TW[j] = v;
        } else if (task < N_TW + N_ROPE) {
            const int idx = (task - N_TW) * NT + tid; const int pos = idx >> 5, i = idx & 31;
            const float inv = exp2f(-(float)(i & 15) * (13.287712379549449f / 16.0f));
            const float ang = (float)(i < 16 ? pos / 64 : pos % 64) * inv;
            cpx v; v.x = cosf(ang); v.y = sinf(ang); ROPE[idx] = v;
        } else {
            const int mt = task - N_TW - N_ROPE; const int l = mt / (3 * DM / 64), n0 = (mt % (3 * DM / 64)) * 64;
            float* sv = (float*)smem;
            float* red = sv + NJ * DM;
            __syncthreads();
            for (int i = tid; i < NJ * DM; i += NT) { const int j = i / DM, k = i % DM; const float v = j < NB ? p.in[I_C][j * DM + k] : p.in[I_CCTX][k]; sv[i] = siluf_(v); }
            __syncthreads();
            const int c4 = tid & 15, kg = tid >> 4; f32x4 acc[NJ];
#pragma unroll
            for (int j = 0; j < NJ; ++j) acc[j] = (f32x4){0.f, 0.f, 0.f, 0.f};
            const float* w = p.in[I_WADA] + (size_t)l * DM * 3 * DM + n0 + 4 * c4;
            static_assert((DM / 32) % 8 == 0, "weight loads in batches of 8");
#pragma unroll 1
            for (int i0 = 0; i0 < DM / 32; i0 += 8) { f32x4 wv[8];
#pragma unroll
                for (int i = 0; i < 8; ++i) wv[i] = *(const f32x4*)(w + (size_t)(kg + 32 * (i0 + i)) * 3 * DM);
                SCHED_FENCE();
#pragma unroll
                for (int i = 0; i < 8; ++i) { const int k = kg + 32 * (i0 + i);
#pragma unroll
                    for (int j = 0; j < NJ; ++j) acc[j] = acc[j] + wv[i] * sv[j * DM + k]; } }
#pragma unroll
            for (int j = 0; j < NJ; ++j) *(f32x4*)(red + (kg * NJ + j) * 64 + 4 * c4) = acc[j];
            __syncthreads();
            for (int i = tid; i < NJ * 64; i += NT) { const int j = i / 64, n = i % 64; float s = 0.f;
#pragma unroll
                for (int k8 = 0; k8 < 32; ++k8) s += red[(k8 * NJ + j) * 64 + n];
                MOD[((size_t)l * NJ + j) * 3 * DM + n0 + n] = s + p.in[I_BADA][(size_t)l * 3 * DM + n0 + n]; }
        }
    }
}

#ifdef EMU
constexpr int PANEL_ROWS = 128, PANEL_UNITS = DM / 128;
#else
constexpr int PANEL_ROWS = 256, PANEL_UNITS = DM / 256;
#endif
__device__ __forceinline__ unsigned* unit_counter(const Params& p, int isctx) { return (unsigned*)(p.ws + WS_BAR + 16384) + 64 * isctx; }
__device__ __forceinline__ unsigned* stage_counter(const Params& p, int flag) { return (unsigned*)(p.ws + WS_BAR + 16384) + 512 + 512 * flag; }
__device__ __forceinline__ void stage_signal(const Params& p, char* smem, int flag, int l) {
#ifdef EMU
    __syncthreads(); if (otid() == 0) *stage_counter(p, flag) += 1u;
#else
    asm volatile("s_waitcnt vmcnt(0)" ::: "memory"); __syncthreads();
    if (threadIdx.x == 0) {
        const unsigned xcc = (unsigned)__builtin_amdgcn_s_getreg((3 << 11) | 20) & 0xFu, nloc = ((volatile __attribute__((address_space(3))) unsigned*)(smem + LDS_BYTES - 64))[0];
        unsigned* g = stage_counter(p, flag);
        if (nloc > 0u) { const unsigned old = __hip_atomic_fetch_add(g + 16 * (1 + xcc), 1u, __ATOMIC_RELAXED, __HIP_MEMORY_SCOPE_AGENT);
            if (old + 1u == nloc * (unsigned)(l + 1)) { __builtin_amdgcn_fence(__ATOMIC_RELEASE, "agent"); asm volatile("s_waitcnt vmcnt(0)" ::: "memory");
                __hip_atomic_fetch_add(g, nloc, __ATOMIC_RELAXED, __HIP_MEMORY_SCOPE_AGENT); } }
        else { __builtin_amdgcn_fence(__ATOMIC_RELEASE, "agent"); asm volatile("s_waitcnt vmcnt(0)" ::: "memory"); __hip_atomic_fetch_add(g, 1u, __ATOMIC_RELAXED, __HIP_MEMORY_SCOPE_AGENT); }
    }
#endif
}
__device__ __forceinline__ void stage_wait(const Params& p, int flag, int l) {
    if (otid() == 0) { const unsigned target = (unsigned)gridDim.x * (unsigned)(l + 1);
#ifdef EMU
        while (*(volatile unsigned*)stage_counter(p, flag) < target) emu::yield();
#else
        unsigned spins = 0;
        while (__hip_atomic_load(stage_counter(p, flag), __ATOMIC_RELAXED, __HIP_MEMORY_SCOPE_AGENT) < target) { __builtin_amdgcn_s_sleep(16); if (++spins > (1u << 20)) break; }
        __builtin_amdgcn_fence(__ATOMIC_ACQUIRE, "agent"); asm volatile("s_waitcnt vmcnt(0)" ::: "memory");
#endif
    }
    __syncthreads();
}
__device__ __forceinline__ int logical_row(int i) { return i < NB * SEQ ? (i / SEQ) * TOK + CTXL + i % SEQ : ((i - NB * SEQ) / CTXL) * TOK + (i - NB * SEQ) % CTXL; }
struct RowRef { const float* xo; float* xn; int mj, row; bool ok; };
__device__ __forceinline__ RowRef rp_ref(const Params& p, int l, int li, int base, int hi) {
    RowRef r; r.ok = li < hi; const int rr = logical_row(r.ok ? li : base); r.row = rr;
    const int b = rr / TOK, pp = rr % TOK; const bool isctx = pp < CTXL; if (l == DEPTH && isctx) r.ok = false;
    const size_t off = isctx ? ((size_t)b * CTXL + pp) * DM : ((size_t)b * SEQ + (pp - CTXL)) * DM;
    float* CTXB = (float*)(p.ws + WS_CTXB);
    r.xo = (l <= 1) ? (isctx ? p.in[I_CTX] + off : p.in[I_X] + off) : (isctx ? CTXB + off : p.out + off);
    r.xn = isctx ? CTXB + off : p.out + off; r.mj = isctx ? NB : b; return r;
}
__device__ __forceinline__ void rp_rows(const Params& p, int l, int lo, int hi, int gi, int nb) {
    const int tid = otid(), lane = tid & 63, wave = tid >> 6;
    const float* MOD = (const float*)(p.ws + WS_MOD);
    const bf16* YO = (const bf16*)(p.ws + WS_P);
    bf16* HN = (bf16*)(p.ws + WS_HNY);
    constexpr int NV4 = DM / 256, RW = 2;
    const int stride = nb * 8;
    f32x4 xq[RW][NV4]; u32x2 yq[RW][NV4]; RowRef rq[RW];
    int base = lo + gi * 8 + wave;
    if (base < hi) {
#pragma unroll
        for (int i = 0; i < RW; ++i) { rq[i] = rp_ref(p, l, base + i * stride, base, hi);
#pragma unroll
            for (int j = 0; j < NV4; ++j) { xq[i][j] = *(const f32x4*)(rq[i].xo + 4 * lane + 256 * j); yq[i][j] = (l > 0) ? *(const u32x2*)(YO + (size_t)rq[i].row * DM + 4 * lane + 256 * j) : (u32x2){0u, 0u}; } }
    }
    for (; base < hi; base += stride * RW) {
        f32x4 x[RW][NV4], y[RW][NV4]; RowRef rc[RW];
#pragma unroll
        for (int i = 0; i < RW; ++i) { rc[i] = rq[i];
#pragma unroll
            for (int j = 0; j < NV4; ++j) { x[i][j] = xq[i][j]; const u32x2 yy = yq[i][j]; y[i][j] = (f32x4){bitsf(yy.x << 16), bitsf(yy.x & 0xffff0000u), bitsf(yy.y << 16), bitsf(yy.y & 0xffff0000u)}; } }
        { const int nbase = base + stride * RW;
            if (nbase < hi) {
#pragma unroll
                for (int i = 0; i < RW; ++i) { rq[i] = rp_ref(p, l, nbase + i * stride, nbase, hi);
#pragma unroll
                    for (int j = 0; j < NV4; ++j) { xq[i][j] = *(const f32x4*)(rq[i].xo + 4 * lane + 256 * j); if (l > 0) yq[i][j] = *(const u32x2*)(YO + (size_t)rq[i].row * DM + 4 * lane + 256 * j); } } } }
        if (l > 0) {
            float ss[RW];
#pragma unroll
            for (int i = 0; i < RW; ++i) { ss[i] = 0.f;
#pragma unroll
                for (int j = 0; j < NV4; ++j) ss[i] += y[i][j].x * y[i][j].x + y[i][j].y * y[i][j].y + y[i][j].z * y[i][j].z + y[i][j].w * y[i][j].w; }
#pragma unroll
            for (int i = 0; i < RW; ++i) ss[i] = wave_sum(ss[i]);
            const float* gp = p.in[I_GPOST] + (size_t)(l - 1) * DM;
            float rstd[RW]; const float* gt[RW];
#pragma unroll
            for (int i = 0; i < RW; ++i) { rstd[i] = rsqrtf(ss[i] * (1.0f / DM) + EPS); gt[i] = MOD + ((size_t)(l - 1) * NJ + rc[i].mj) * 3 * DM + 2 * DM; }
            f32x4 p4n = *(const f32x4*)(gp + 4 * lane), g4n[RW];
#pragma unroll
            for (int i = 0; i < RW; ++i) g4n[i] = *(const f32x4*)(gt[i] + 4 * lane);
#pragma unroll
            for (int j = 0; j < NV4; ++j) { const f32x4 p4 = p4n; f32x4 g4[RW];
#pragma unroll
                for (int i = 0; i < RW; ++i) g4[i] = g4n[i];
                if (j + 1 < NV4) { p4n = *(const f32x4*)(gp + 4 * lane + 256 * (j + 1));
#pragma unroll
                    for (int i = 0; i < RW; ++i) g4n[i] = *(const f32x4*)(gt[i] + 4 * lane + 256 * (j + 1)); }
#pragma unroll
                for (int i = 0; i < RW; ++i) { x[i][j] = x[i][j] + g4[i] * (y[i][j] * rstd[i] * p4);
                    if (rc[i].ok) *(f32x4*)(rc[i].xn + 4 * lane + 256 * j) = x[i][j]; } }
        }
        if (l < DEPTH) {
            float ss[RW];
#pragma unroll
            for (int i = 0; i < RW; ++i) { ss[i] = 0.f;
#pragma unroll
                for (int j = 0; j < NV4; ++j) ss[i] += x[i][j].x * x[i][j].x + x[i][j].y * x[i][j].y + x[i][j].z * x[i][j].z + x[i][j].w * x[i][j].w; }
#pragma unroll
            for (int i = 0; i < RW; ++i) ss[i] = wave_sum(ss[i]);
            const float* gp = p.in[I_GPRE] + (size_t)l * DM;
            float rstd[RW]; const float* md[RW];
#pragma unroll
            for (int i = 0; i < RW; ++i) { rstd[i] = rsqrtf(ss[i] * (1.0f / DM) + EPS); md[i] = MOD + ((size_t)l * NJ + rc[i].mj) * 3 * DM; }
            f32x4 g4n = *(const f32x4*)(gp + 4 * lane), shn[RW], scn[RW];
#pragma unroll
            for (int i = 0; i < RW; ++i) { shn[i] = *(const f32x4*)(md[i] + 4 * lane); scn[i] = *(const f32x4*)(md[i] + DM + 4 * lane); }
#pragma unroll
            for (int j = 0; j < NV4; ++j) { const int e = 4 * lane + 256 * j; const f32x4 g4 = g4n; f32x4 sh[RW], sc[RW];
#pragma unroll
                for (int i = 0; i < RW; ++i) { sh[i] = shn[i]; sc[i] = scn[i]; }
                if (j + 1 < NV4) { g4n = *(const f32x4*)(gp + e + 256);
#pragma unroll
                    for (int i = 0; i < RW; ++i) { shn[i] = *(const f32x4*)(md[i] + e + 256); scn[i] = *(const f32x4*)(md[i] + DM + e + 256); } }
#pragma unroll
                for (int i = 0; i < RW; ++i) { const f32x4 h = (x[i][j] * rstd[i] * g4) * (sc[i] + 1.0f) + sh[i];
                    u32x2 o; o.x = pk2(h.x, h.y); o.y = pk2(h.z, h.w);
                    if (rc[i].ok) *(u32x2*)(HN + (size_t)rc[i].row * DM + e) = o; } }
        }
    }
}

__device__ __forceinline__ void convert_tile(const float* src, int ldn, bf16* dst, int K, int n0, int k0, bool use_map, char* smem) {
    const int tid = otid();
    float* tile = (float*)smem;
    __syncthreads();
#pragma unroll
    for (int i = 0; i < 8; ++i) { const int idx = tid + NT * i, k = idx >> 6, n = idx & 63;
        const int oc = use_map ? orig_col(n0 + n) : (n0 + n);
        tile[k * 65 + n] = oc >= 0 ? src[(size_t)(k0 + k) * ldn + oc] : 0.f; }
    __syncthreads();
    const int n = tid >> 3, c = tid & 7;
    u32x4 o; o.x = pk2(tile[(8 * c + 0) * 65 + n], tile[(8 * c + 1) * 65 + n]); o.y = pk2(tile[(8 * c + 2) * 65 + n], tile[(8 * c + 3) * 65 + n]);
    o.z = pk2(tile[(8 * c + 4) * 65 + n], tile[(8 * c + 5) * 65 + n]); o.w = pk2(tile[(8 * c + 6) * 65 + n], tile[(8 * c + 7) * 65 + n]);
    *(u32x4*)(dst + (size_t)(n0 + n) * K + k0 + 8 * c) = o;
}

__device__ __forceinline__ void filter_task(const Params& p, int l, int L, int pos0, char* smem) {
    const int tid = otid(), j = tid & 63;
    float* z = (float*)smem;
    float* h1 = z + 8 * 33;
    float* h2 = h1 + 8 * 64;
    const float* w1 = p.in[I_HW1] + (size_t)l * 33 * 64; const float* w2 = p.in[I_HW2] + (size_t)l * 64 * 64; const float* w3 = p.in[I_HW3] + (size_t)l * 64 * 512;
    float r1[33], r2[64], r3a[16];
#pragma unroll
    for (int i = 0; i < 33; ++i) r1[i] = w1[i * 64 + j];
#pragma unroll
    for (int i = 0; i < 64; ++i) r2[i] = w2[i * 64 + j];
    const float b1 = p.in[I_HB1][l * 64 + j], b2 = p.in[I_HB2][l * 64 + j], b3 = p.in[I_HB3][l * 512 + tid];
    const float f0 = p.in[I_HFREQ][(l * 2 + 0) * 64 + j], f1 = p.in[I_HFREQ][(l * 2 + 1) * 64 + j];
    __syncthreads();
    if (tid < 8 * 33) { const int pp = tid / 33, i = tid % 33; const float pos = (float)(pos0 + pp);
        const float t = pos / (float)(L - 1 > 1 ? L - 1 : 1), wv = 6.283185307179586f * pos / (float)L; float v;
        if (i == 0) v = t; else { const int bi = (i - 1) & 15; const float f = 1e-4f + (float)bi * ((15.0f - 1e-4f) / 15.0f); v = (i <= 16) ? cosf(wv * f) : -sinf(wv * f); }
        z[tid] = v; }
    __syncthreads();
    { const int pp = tid >> 6; float a = b1;
#pragma unroll
        for (int i = 0; i < 33; ++i) a += z[pp * 33 + i] * r1[i];
        h1[tid] = sinf(f0 * a);
#pragma unroll
        for (int i = 0; i < 16; ++i) r3a[i] = w3[i * 512 + tid]; }
    __syncthreads();
    { const int pp = tid >> 6; float a = b2;
#pragma unroll
        for (int i = 0; i < 64; ++i) a += h1[pp * 64 + i] * r2[i];
        h2[tid] = sinf(f1 * a); }
    __syncthreads();
    { const int o = tid, dir = o >> 8, c = o & 255;
        const float delta = 3.0701134573253946f + (float)c * ((15.350567286626973f - 3.0701134573253946f) / 255.0f);
        float acc[8];
#pragma unroll
        for (int pp = 0; pp < 8; ++pp) acc[pp] = b3;
#pragma unroll 1
        for (int cix = 0; cix < 4; ++cix) {
            float wn[16];
#pragma unroll
            for (int i = 0; i < 16; ++i) wn[i] = (cix < 3) ? w3[(16 * (cix + 1) + i) * 512 + o] : 0.f;
#pragma unroll
            for (int i = 0; i < 16; ++i) {
#pragma unroll
                for (int pp = 0; pp < 8; ++pp) acc[pp] += h2[pp * 64 + 16 * cix + i] * r3a[i]; }
#pragma unroll
            for (int i = 0; i < 16; ++i) r3a[i] = wn[i]; }
        float* KT = (float*)(p.ws + WS_KT); float* HC = (float*)(p.ws + WS_HC);
#pragma unroll
        for (int pp = 0; pp < 8; ++pp) { const int pos = pos0 + pp; const float t = (float)pos / (float)(L - 1 > 1 ? L - 1 : 1);
            const float v = acc[pp] * __expf(-t * delta);
            if (L == SEQ) { if (dir == 0) KT[(size_t)c * NF + pos]= v; else if (pos > 0) KT[(size_t)c * NF + (NF - pos)] = v; else KT[(size_t)c * NF + SEQ] = 0.f; }
            else HC[((size_t)dir * WG + c) * CTXL + pos] = v; }
    }
}

__device__ __forceinline__ void convert_tile_w(const float* src, int ldn, bf16* dst, int K, int n0, int k0, bool use_map, char* wl, int lane) {
    float* tile = (float*)wl;
    const int oc = use_map ? orig_col(n0 + lane) : (n0 + lane);
    float v[64];
#pragma unroll
    for (int k = 0; k < 64; ++k) v[k] = oc >= 0 ? src[(size_t)(k0 + k) * ldn + oc] : 0.f;
#pragma unroll
    for (int k = 0; k < 64; ++k) tile[k * 65 + lane] = v[k];
    WAVE_SYNC();
#pragma unroll
    for (int i = 0; i < 8; ++i) { const int n = (lane >> 3) + 8 * i, c = lane & 7; float f[8];
#pragma unroll
        for (int j = 0; j < 8; ++j) f[j] = tile[(8 * c + j) * 65 + n];
        *(u32x4*)(dst + (size_t)(n0 + n) * K + k0 + 8 * c) = pack8(f); }
    WAVE_SYNC();
}
__device__ __forceinline__ void layer_prep(const Params& p, int l, int idx, int stride, char* smem) {
    constexpr int N_WIN = (NPAD / 64) * (DM / 64), N_FL = SEQ / 8, N_FC = CTXL / 8;
    for (int task = idx; task < N_FL + N_FC; task += stride) {
        if (task < N_FL) filter_task(p, l, SEQ, task * 8, smem);
        else filter_task(p, l, CTXL, (task - N_FL) * 8, smem);
    }
    __syncthreads();
    { const int tid = otid(), lane = tid & 63, wave = __builtin_amdgcn_readfirstlane(tid >> 6);
        char* wl = smem + wave * WLDS;
        for (int task = wave * stride + idx; task < N_WIN; task += 8 * stride) { const int nt = task / (DM / 64), kt = task % (DM / 64);
            convert_tile_w(p.in[I_WIN] + (size_t)l * DM * N_IN, N_IN, (bf16*)(p.ws + WS_WIN), DM, nt * 64, kt * 64, true, wl, lane); } }
}
__device__ __forceinline__ unsigned* row_queue(const Params& p, int l) { return (unsigned*)(p.ws + WS_BAR + 16384) + 2560 + 64 * l; }
__device__ __forceinline__ void wait_units(const Params& p, int c, int l) {
    constexpr int nLatU = NB * (SEQ / PANEL_ROWS) * PANEL_UNITS, nCtxU = NB * (CTXL / PANEL_ROWS) * PANEL_UNITS;
    const unsigned target = (unsigned)((c ? nCtxU : nLatU) * l);
#ifdef EMU
    while (*(volatile unsigned*)unit_counter(p, c) < target) emu::yield();
#else
    unsigned spins = 0;
    while (__hip_atomic_load(unit_counter(p, c), __ATOMIC_RELAXED, __HIP_MEMORY_SCOPE_AGENT) < target) { __builtin_amdgcn_s_sleep(16); if (++spins > (1u << 20)) break; }
    __builtin_amdgcn_fence(__ATOMIC_ACQUIRE, "agent"); asm volatile("s_waitcnt vmcnt(0)" ::: "memory");
#endif
}
__device__ __forceinline__ void phase_rp(const Params& p, int l, char* smem) { const int G = (int)gridDim.x, bid = obid(), tid = otid();
    const bool has_ctx = l < DEPTH;
    constexpr int nLatU = NB * (SEQ / PANEL_ROWS) * PANEL_UNITS, nCtxU = NB * (CTXL / PANEL_ROWS) * PANEL_UNITS;
    const int nU = nLatU + nCtxU;
    const int heavy = (l >= 1 && has_ctx && nU > G && (nU % G) != 0) ? nU % G : 0;
    const int total = heavy > 0 ? NB * SEQ : (has_ctx ? T : NB * SEQ);
    const int nl = G - heavy, np = (l < DEPTH) ? nl / 2 : 0, nr = nl - np;
    int lo, hi, gi, nb; bool prep = false;
    if (bid < heavy) { lo = NB * SEQ; hi = T; gi = bid; nb = heavy; }
    else { const int i = bid - heavy; int nR = total;
        if (np > 0) { nR = ((total * 2 / 3) / (nr * 16)) * (nr * 16); if (nR <= 0) nR = total / 2; }
        if (np > 0 && (i & 1) && i / 2 < np) { prep = true; lo = nR; hi = total; gi = i / 2; nb = np; }
        else { lo = 0; hi = nR; gi = (np > 0) ? (i + 1) / 2 : i; nb = nr; } }
    if (prep) layer_prep(p, l, gi, np, smem);
    else if (l < DEPTH && np == 0) layer_prep(p, l, bid, G, smem);
    if (l >= 1) { if (tid == 0) { if (lo < NB * SEQ) wait_units(p, 0, l); if (hi > NB * SEQ) wait_units(p, 1, l); } __syncthreads(); }
    rp_rows(p, l, lo, hi, gi, nb);
}

__device__ __forceinline__ cpx cmul(cpx a, cpx b) { cpx r; r.x = a.x * b.x - a.y * b.y; r.y = a.x * b.y + a.y * b.x; return r; }
__device__ __forceinline__ cpx cmulc(cpx a, cpx b) { cpx r; r.x = a.x * b.x + a.y * b.y; r.y = a.y * b.x - a.x * b.y; return r; }
constexpr int fpad(int i) { return i + (i >> 4); }
__device__ __forceinline__ int FPH(int i) { return i + (i >> 4); }
constexpr int FBUF = fpad(NF);
constexpr int ilog16(int n) { return n < 16 ? 0 : 1 + ilog16(n / 16); }
constexpr int FFT_P16 = ilog16(NF);
constexpr bool FFT_R4 = ((NF >> (4 * FFT_P16)) == 4);
static_assert((NF >> (4 * FFT_P16)) == 1 || (NF >> (4 * FFT_P16)) == 4, "NF = 16^a * (1 or 4)");
template <bool INV> __device__ __forceinline__ void dft4(cpx& a0, cpx& a1, cpx& a2, cpx& a3) {
    const cpx s = {a0.x + a2.x, a0.y + a2.y}, b = {a0.x - a2.x, a0.y - a2.y}, c = {a1.x + a3.x, a1.y + a3.y}, d = {a1.x - a3.x, a1.y - a3.y};
    a0 = (cpx){s.x + c.x, s.y + c.y}; a2 = (cpx){s.x - c.x, s.y - c.y};
    if (!INV) { a1 = (cpx){b.x + d.y, b.y - d.x}; a3 = (cpx){b.x - d.y, b.y + d.x}; }
    else      { a1 = (cpx){b.x - d.y, b.y + d.x}; a3 = (cpx){b.x + d.y, b.y - d.x}; }
}
template <bool INV> __device__ __forceinline__ cpx cmulk(cpx a, float wr, float wi) {
    cpx r; if (!INV) { r.x = a.x * wr + a.y * wi; r.y = a.y * wr - a.x * wi; } else { r.x = a.x * wr - a.y * wi; r.y = a.y * wr + a.x * wi; } return r;
}
template <bool INV> __device__ __forceinline__ void dft16(cpx (&x)[16]) {
    constexpr float C1 = 0.92387953251128674f, S1 = 0.38268343236508977f, C2 = 0.70710678118654752f;
#pragma unroll
    for (int n2 = 0; n2 < 4; ++n2) dft4<INV>(x[n2], x[4 + n2], x[8 + n2], x[12 + n2]);
    x[4 * 1 + 1] = cmulk<INV>(x[4 * 1 + 1], C1, S1); x[4 * 1 + 2] = cmulk<INV>(x[4 * 1 + 2], C2, C2); x[4 * 1 + 3] = cmulk<INV>(x[4 * 1 + 3], S1, C1);
    x[4 * 2 + 1] = cmulk<INV>(x[4 * 2 + 1], C2, C2); x[4 * 2 + 2] = cmulk<INV>(x[4 * 2 + 2], 0.f, 1.f); x[4 * 2 + 3] = cmulk<INV>(x[4 * 2 + 3], -C2, C2);
    x[4 * 3 + 1] = cmulk<INV>(x[4 * 3 + 1], S1, C1); x[4 * 3 + 2] = cmulk<INV>(x[4 * 3 + 2], -C2, C2); x[4 * 3 + 3] = cmulk<INV>(x[4 * 3 + 3], -C1, -S1);
#pragma unroll
    for (int k1 = 0; k1 < 4; ++k1) dft4<INV>(x[4 * k1 + 0], x[4 * k1 + 1], x[4 * k1 + 2], x[4 * k1 + 3]);
    cpx t;
    t = x[1]; x[1] = x[4]; x[4] = t; t = x[2]; x[2] = x[8]; x[8] = t; t = x[3]; x[3] = x[12]; x[12] = t;
    t = x[6]; x[6] = x[9]; x[9] = t; t = x[7]; x[7] = x[13]; x[13] = t; t = x[11]; x[11] = x[14]; x[14] = t;
}
template <bool INV> __device__ __forceinline__ void fft_stage16(cpx* buf, const cpx* TW, int tl, int M) {
    const int span = M >> 4, twm = NF / M;
#pragma unroll 1
    for (int j = tl; j < NF / 16; j += 256) {
        const int grp = j / span, pos = j % span, base = grp * M + pos; cpx x[16];
#pragma unroll
        for (int q = 0; q < 16; ++q) x[q] = buf[FPH(base + q * span)];
        cpx w1 = {1.f, 0.f}; if (span > 1) w1 = TW[pos * twm];
        if (INV && span > 1) { cpx wk = w1;
#pragma unroll
            for (int k = 1; k < 16; ++k) { x[k] = cmulc(x[k], wk); wk = cmul(wk, w1); } }
        dft16<INV>(x);
        if (!INV && span > 1) { cpx wk = w1;
#pragma unroll
            for (int k = 1; k < 16; ++k) { x[k] = cmul(x[k], wk); wk = cmul(wk, w1); } }
#pragma unroll
        for (int q = 0; q < 16; ++q) buf[FPH(base + q * span)] = x[q];
    }
}
template <bool INV> __device__ __forceinline__ void fft_stage4_last(cpx* buf, int tl) {
#pragma unroll 1
    for (int j = tl; j < NF / 4; j += 256) { cpx a0 = buf[FPH(4 * j)], a1 = buf[FPH(4 * j + 1)], a2 = buf[FPH(4 * j + 2)], a3 = buf[FPH(4 * j + 3)];
        dft4<INV>(a0, a1, a2, a3); buf[FPH(4 * j)] = a0; buf[FPH(4 * j + 1)] = a1; buf[FPH(4 * j + 2)] = a2; buf[FPH(4 * j + 3)] = a3; }
}
__device__ __forceinline__ void fft_fwd(cpx* buf, const cpx* TW, int tl) {
    int M = NF;
#pragma unroll
    for (int s = 0; s < FFT_P16; ++s) { __syncthreads(); fft_stage16<false>(buf, TW, tl, M); M >>= 4; }
    if (FFT_R4) { __syncthreads(); fft_stage4_last<false>(buf, tl); }
    __syncthreads();
}
__device__ __forceinline__ void fft_inv(cpx* buf, const cpx* TW, int tl) {
    if (FFT_R4) { __syncthreads(); fft_stage4_last<true>(buf, tl); }
    int M = FFT_R4 ? 64 : 16;
#pragma unroll
    for (int s = 0; s < FFT_P16; ++s) { __syncthreads(); fft_stage16<true>(buf, TW, tl, M); M <<= 4; }
    __syncthreads();
}
__device__ __forceinline__ void filt_fft_task(const Params& p, int cp, char* smem) {
    const int tid = otid(), half = tid >> 8, tl = tid & 255, c = 2 * cp + half;
    cpx* buf = (cpx*)smem + (size_t)half * FBUF;
    const float* KT = (const float*)(p.ws + WS_KT) + (size_t)c * NF;
    cpx* KF = (cpx*)(p.ws + WS_KF) + (size_t)c * NF;
    const cpx* TW = (const cpx*)(p.ws + WS_TW);
    __syncthreads();
    for (int i = tl; i < NF; i += 256) { cpx v; v.x = KT[i]; v.y = 0.f; buf[FPH(i)] = v; }
    fft_fwd(buf, TW, tl);
    for (int i = tl; i < NF; i += 256) KF[i] = buf[FPH(i)];
}

__device__ __forceinline__ void gemm_tile(const Params& p, const bf16* A, const bf16* Bt, int K, int mt, int nt, int mode, char* smem) {
    const int tid = otid(), lane = tid & 63, wave = tid >> 6;
    bf16* As = (bf16*)smem;
    bf16* Bs = As + 128 * LS;
    const int wm = (wave & 3) * 32, wn = (wave >> 2) * 64;
    f32x4 acc[2][4];
#pragma unroll
    for (int i = 0; i < 2; ++i)
#pragma unroll
        for (int j = 0; j < 4; ++j) acc[i][j] = (f32x4){0.f, 0.f, 0.f, 0.f};
    const int lr = tid >> 3, lc = tid & 7;
    const bf16* Ag = A + (size_t)(mt * 128 + lr) * K + lc * 8;
    const bf16* Bg = Bt + (size_t)(nt * 128 + lr) * K + lc * 8;
    u32x4 ra0, ra1, rb0, rb1;
    ra0 = *(const u32x4*)(Ag); ra1 = *(const u32x4*)(Ag + (size_t)64 * K); rb0 = *(const u32x4*)(Bg); rb1 = *(const u32x4*)(Bg + (size_t)64 * K);
    const int nk = K / 64;
    for (int kt = 0; kt < nk; ++kt) {
        __syncthreads();
        *(u32x4*)(As + lr * LS + lc * 8) = ra0; *(u32x4*)(As + (lr + 64) * LS + lc * 8) = ra1;
        *(u32x4*)(Bs + lr * LS + lc * 8) = rb0; *(u32x4*)(Bs + (lr + 64) * LS + lc * 8) = rb1;
        __syncthreads();
        if (kt + 1 < nk) { const int ko = (kt + 1) * 64;
            ra0 = *(const u32x4*)(Ag + ko); ra1 = *(const u32x4*)(Ag + (size_t)64 * K + ko); rb0 = *(const u32x4*)(Bg + ko); rb1 = *(const u32x4*)(Bg + (size_t)64 * K + ko); }
        mma_nt<4, 2>(As, LS, wm, Bs, LS, wn, acc[0], lane);
        mma_nt<4, 2>(As, LS, wm + 16, Bs, LS, wn, acc[1], lane);
    }
    const int r = lane & 15, q = lane >> 4;
#pragma unroll
    for (int i = 0; i < 2; ++i)
#pragma unroll
        for (int j = 0; j < 4; ++j)
#pragma unroll
            for (int e = 0; e < 4; ++e) {
                const int row = mt * 128 + wm + 16 * i + 4 * q + e, col = nt * 128 + wn + 16 * j + r; const float v = acc[i][j][e];
                if (mode == 0) { if (col < NP) ((bf16*)(p.ws + WS_P))[(size_t)row * NP + col] = f2bf(v); else if (col < NP + 16) ((float*)(p.ws + WS_G))[(size_t)row * NGS + (col - NP)] = v; else if (col < NP + NG) ((bf16*)((float*)(p.ws + WS_G) + (size_t)row * NGS + 16))[col - NP - 16] = f2bf(v); }
                else if (mode == 2) ((bf16*)(p.ws + WS_HT))[(size_t)row * T + col] = f2bf(v);
                else ((bf16*)(p.ws + WS_P))[(size_t)row * DM + col] = f2bf(v);
            }
}

#ifndef EMU
namespace pg8 {
#define PG8_LAS __attribute__((address_space(3)))
typedef unsigned short bf16_t;
typedef short bf16x8 __attribute__((ext_vector_type(8)));
typedef float f32x4 __attribute__((ext_vector_type(4)));
typedef unsigned u32x4 __attribute__((ext_vector_type(4)));
constexpr int BM = 256, BK = 64, HALF = 128, HTB = HALF * BK * 2  , STAGE_BYTES = 8 * HTB, NXCD = 8, WGM = 8;

__host__ __device__ __forceinline__ int lds_byte(int r, int c) { const int st = (r >> 4) * 2 + (c >> 5), rr = r & 15, cc = c & 31, ob = rr * 64 + cc * 2; return st * 1024 + (ob ^ (((ob >> 9) & 1) << 5)); }
__host__ __device__ __forceinline__ void stage_rc(int b, int& R, int& C) { const int st = b / 1024, sb = b % 1024, swz = sb ^ (((sb >> 9) & 1) << 5); R = (st >> 1) * 16 + swz / 64; C = (st & 1) * 32 + (swz % 64) / 2; }
__host__ __device__ __forceinline__ int perm32(int rho) { const int n = rho >> 4, i = rho & 15; return 8 * (i >> 2) + 4 * n + (i & 3); }

struct Unit { int pm, pn; };
struct Gemm { const bf16_t* A; const bf16_t* Bt; int M, N, K; };
__device__ __forceinline__ unsigned cvt_pk_bf16(float lo, float hi) { unsigned r; asm volatile("v_cvt_pk_bf16_f32 %0, %1, %2" : "=v"(r) : "v"(lo), "v"(hi)); return r; }
template <class Epi, class Sched, bool ALIGN_EPI = false, bool SP2 = false>
__device__ __forceinline__ void gemm_phase(PG8_LAS unsigned char* lds, const Gemm g, const Sched& S, const Epi& E) {
    const int tid = otid(), wid = __builtin_amdgcn_readfirstlane(tid >> 6), lane = tid & 63, wr = wid >> 2, wc = wid & 3, fr = lane & 15, fq = lane >> 4;
    const int K = g.K, nt = K / BK;
    unsigned voffA[2], voffB[2];
#pragma unroll
    for (int i = 0; i < 2; ++i) { int R, C; stage_rc(tid * 16 + i * 8192, R, C); const int Rb = Epi::PERM ? ((R & ~31) + perm32(R & 31)) : R;
        voffA[i] = (unsigned)(R * K + C) * 2u; voffB[i] = (unsigned)(Rb * K + C) * 2u; }
    const size_t kstep = (size_t)(BK * 2);
    const size_t hstep = (size_t)HALF * K * 2;
    const size_t tstep = 2 * hstep;
    const unsigned ldsw = (unsigned)wid * 1024u;
    const int aoff = lds_byte(wr * 64 + fr, fq * 8), boff = lds_byte(wc * 32 + fr, fq * 8);
#define PG8_SA(b, h) (((b) * 2 + (h)) * HTB)
#define PG8_SB(b, h) ((4 + (b) * 2 + (h)) * HTB)
#define PG8_STAGE(bufoff, gbase, voff) do { _Pragma("unroll") for (int _i = 0; _i < 2; ++_i) \
        __builtin_amdgcn_global_load_lds((const unsigned*)((const char*)(gbase) + (voff)[_i]), (PG8_LAS unsigned*)(lds + (bufoff) + ldsw + _i * 8192), 16, 0, 0); } while (0)
#define PG8_LDA(dst, b, h) do { _Pragma("unroll") for (int m = 0; m < 4; ++m) _Pragma("unroll") for (int k = 0; k < 2; ++k) dst[m][k] = *(const PG8_LAS bf16x8*)(lds + PG8_SA(b, h) + aoff + m * 2048 + k * 1024); } while (0)
#define PG8_LDB(dst, b, h) do { _Pragma("unroll") for (int n = 0; n < 2; ++n) _Pragma("unroll") for (int k = 0; k < 2; ++k) dst[n][k] = *(const PG8_LAS bf16x8*)(lds + PG8_SB(b, h) + boff + n * 2048 + k * 1024); } while (0)
#define PG8_MMA(ai, bj, At, Bt) do { __builtin_amdgcn_s_setprio(1); _Pragma("unroll") for (int m = 0; m < 4; ++m) _Pragma("unroll") for (int n = 0; n < 2; ++n) _Pragma("unroll") for (int k = 0; k < 2; ++k) \
        acc[ai][bj][m][n] = __builtin_amdgcn_mfma_f32_16x16x32_bf16(Bt[n][k], At[m][k], acc[ai][bj][m][n], 0, 0, 0); __builtin_amdgcn_s_setprio(0); } while (0)
#define PG8_WAIT_V(n) asm volatile("s_waitcnt vmcnt(" #n ")" ::: "memory")
#define PG8_WAIT_L(n) asm volatile("s_waitcnt lgkmcnt(" #n ")" ::: "memory")
#define PG8_BAR __builtin_amdgcn_s_barrier()
#define PG8_SCHED __builtin_amdgcn_sched_barrier(0)
    Unit cur, nxt; int ui = 0;
    if (!S.next(0, cur)) return;
    f32x4 acc[2][2][4][2];
#pragma unroll
    for (int a = 0; a < 2; ++a)
#pragma unroll
        for (int b = 0; b < 2; ++b)
#pragma unroll
            for (int m = 0; m < 4; ++m)
#pragma unroll
                for (int n = 0; n < 2; ++n) acc[a][b][m][n] = (f32x4){0.f, 0.f, 0.f, 0.f};
    bf16x8 At[4][2], B0[2][2], B1[2][2];
    const char* cA = (const char*)g.A + (size_t)cur.pm * tstep; const char* cB = (const char*)g.Bt + (size_t)cur.pn * tstep;
    S.a_ready(cur);
    if constexpr (SP2) {
        PG8_STAGE(PG8_SB(0, 0), cB, voffB); PG8_STAGE(PG8_SB(0, 1), cB + hstep, voffB); PG8_STAGE(PG8_SA(0, 0), cA, voffA); PG8_STAGE(PG8_SA(0, 1), cA + hstep, voffA);
        if (wr == 1) PG8_BAR;
        PG8_WAIT_V(2); PG8_BAR;
        PG8_STAGE(PG8_SB(1, 0), cB + kstep, voffB); PG8_STAGE(PG8_SA(1, 0), cA + kstep, voffA); PG8_STAGE(PG8_SB(1, 1), cB + hstep + kstep, voffB);
        PG8_WAIT_V(6); PG8_BAR;
    } else {
        PG8_STAGE(PG8_SB(0, 0), cB, voffB); PG8_STAGE(PG8_SA(0, 0), cA, voffA); PG8_STAGE(PG8_SB(0, 1), cB + hstep, voffB); PG8_STAGE(PG8_SA(0, 1), cA + hstep, voffA);
        if (wr == 1) PG8_BAR;
        PG8_WAIT_V(4); PG8_BAR;
        PG8_STAGE(PG8_SB(1, 0), cB + kstep, voffB); PG8_STAGE(PG8_SA(1, 0), cA + kstep, voffA); PG8_STAGE(PG8_SB(1, 1), cB + hstep + kstep, voffB);
        PG8_WAIT_V(6); PG8_BAR;
    }
    for (;;) {
        const bool has_next = S.next(ui + 1, nxt);
        const char* nA = has_next ? (const char*)g.A + (size_t)nxt.pm * tstep : cA; const char* nB = has_next ? (const char*)g.Bt + (size_t)nxt.pn * tstep : cB;
        for (int t = 0; t < nt; t += 2) {
            const bool last = (t == nt - 2);
            const char* a1 = cA + (size_t)(t + 1) * kstep;
            const char* a2 = last ? nA : cA + (size_t)(t + 2) * kstep; const char* b2 = last ? nB : cB + (size_t)(t + 2) * kstep;
            const char* a3 = a2 + kstep; const char* b3 = b2 + kstep;
            if (last && has_next) S.a_ready(nxt);
            if constexpr (SP2) {
            PG8_LDB(B0, 0, 0); PG8_LDB(B1, 0, 1); PG8_SCHED; PG8_LDA(At, 0, 0); PG8_STAGE(PG8_SA(1, 1), a1 + hstep, voffA);
            PG8_WAIT_V(8); PG8_WAIT_L(0); PG8_BAR; PG8_MMA(0, 0, At, B0); PG8_MMA(0, 1, At, B1); PG8_BAR; PG8_SCHED;
            PG8_LDA(At, 0, 1); PG8_STAGE(PG8_SB(0, 0), b2, voffB); PG8_STAGE(PG8_SB(0, 1), b2 + hstep, voffB); PG8_STAGE(PG8_SA(0, 0), a2, voffA);
            PG8_WAIT_V(8); PG8_WAIT_L(0); PG8_BAR; PG8_MMA(1, 0, At, B0); PG8_MMA(1, 1, At, B1); PG8_BAR; PG8_SCHED;
            PG8_LDB(B0, 1, 0); PG8_LDB(B1, 1, 1); PG8_SCHED; PG8_LDA(At, 1, 0); PG8_STAGE(PG8_SA(0, 1), a2 + hstep, voffA);
            PG8_WAIT_V(8); PG8_WAIT_L(0); PG8_BAR; PG8_MMA(0, 0, At, B0); PG8_MMA(0, 1, At, B1); PG8_BAR; PG8_SCHED;
            PG8_LDA(At, 1, 1); PG8_STAGE(PG8_SB(1, 0), b3, voffB); PG8_STAGE(PG8_SB(1, 1), b3 + hstep, voffB); PG8_STAGE(PG8_SA(1, 0), a3, voffA);
            PG8_WAIT_V(8); PG8_WAIT_L(0); PG8_BAR; PG8_MMA(1, 0, At, B0); PG8_MMA(1, 1, At, B1); PG8_BAR; PG8_SCHED;
            } else {
            PG8_LDB(B0, 0, 0); PG8_SCHED; PG8_LDA(At, 0, 0); PG8_STAGE(PG8_SA(1, 1), a1 + hstep, voffA);
            PG8_WAIT_L(8); PG8_BAR; PG8_WAIT_L(0); PG8_MMA(0, 0, At, B0); PG8_BAR; PG8_SCHED;
            PG8_LDB(B1, 0, 1); PG8_STAGE(PG8_SB(0, 0), b2, voffB);
            PG8_BAR; PG8_WAIT_L(0); PG8_MMA(0, 1, At, B1); PG8_BAR;
            PG8_LDA(At, 0, 1); PG8_STAGE(PG8_SA(0, 0), a2, voffA);
            PG8_BAR; PG8_WAIT_L(0); PG8_MMA(1, 0, At, B0); PG8_BAR; PG8_SCHED;
            PG8_STAGE(PG8_SB(0, 1), b2 + hstep, voffB);
            PG8_WAIT_V(6); PG8_BAR; PG8_MMA(1, 1, At, B1); PG8_BAR;
            PG8_LDB(B0, 1, 0); PG8_SCHED; PG8_LDA(At, 1, 0); PG8_STAGE(PG8_SA(0, 1), a2 + hstep, voffA);
            PG8_WAIT_L(8); PG8_BAR; PG8_WAIT_L(0); PG8_MMA(0, 0, At, B0); PG8_BAR; PG8_SCHED;
            PG8_LDB(B1, 1, 1); PG8_STAGE(PG8_SB(1, 0), b3, voffB);
            PG8_BAR; PG8_WAIT_L(0); PG8_MMA(0, 1, At, B1); PG8_BAR;
            PG8_LDA(At, 1, 1); PG8_STAGE(PG8_SA(1, 0), a3, voffA);
            PG8_BAR; PG8_WAIT_L(0); PG8_MMA(1, 0, At, B0); PG8_BAR; PG8_SCHED;
            PG8_STAGE(PG8_SB(1, 1), b3 + hstep, voffB);
            PG8_WAIT_V(6); PG8_BAR; PG8_MMA(1, 1, At, B1); PG8_BAR;
            }
        }
        if constexpr (ALIGN_EPI) { if (wr == 0) PG8_BAR; }
        if constexpr (!Epi::AFTER_DRAIN) { E(acc, cur, wr, wc, fr, fq); S.done(cur); }
        if (!has_next) break;
#pragma unroll
        for (int a = 0; a < 2; ++a)
#pragma unroll
            for (int b = 0; b < 2; ++b)
#pragma unroll
                for (int m = 0; m < 4; ++m)
#pragma unroll
                    for (int n = 0; n < 2; ++n) acc[a][b][m][n] = (f32x4){0.f, 0.f, 0.f, 0.f};
        cur = nxt; cA = nA; cB = nB; ++ui;
        if constexpr (ALIGN_EPI) { if (wr == 1) PG8_BAR; }
    }
    PG8_WAIT_V(0);
    if constexpr (!ALIGN_EPI) { if (wr == 0) PG8_BAR; }
    PG8_BAR;
    if constexpr (Epi::AFTER_DRAIN) { E.fused(acc, cur, wr, wc, fr, fq, lds, wid, lane); S.done(cur); }
#undef PG8_SA
#undef PG8_SB
#undef PG8_STAGE
#undef PG8_LDA
#undef PG8_LDB
#undef PG8_MMA
#undef PG8_WAIT_V
#undef PG8_WAIT_L
#undef PG8_BAR
#undef PG8_SCHED
}
__device__ __forceinline__ void map_tile(int L, int nM, int nN, int& pm, int& pn) {
    const int nwg = nM * nN; int wgid = L; { const int q = nwg / NXCD, r = nwg % NXCD, xcd = wgid % NXCD, off = wgid / NXCD; wgid = (xcd < r ? xcd * (q + 1) : r * (q + 1) + (xcd - r) * q) + off; }
    const int nig = WGM * nN, gid = wgid / nig, fm = gid * WGM, gsz = (nM - fm) < WGM ? (nM - fm) : WGM;
    pm = fm + ((wgid % nig) % gsz); pn = (wgid % nig) / gsz;
}
constexpr int MP = T / 256, WP = NMAIN / 256, NU2 = 4 * MP, NU1 = MP * WP;
struct InOrder { int G, c;
    __device__ __forceinline__ bool next(int i, Unit& u) const { const int L = i * G + c; if (L >= NU2 + NU1) return false; int a, b;
        if (L < NU2) { map_tile(L, 4, MP, a, b); u.pm = MP + WP + a; u.pn = b; } else { map_tile(L - NU2, MP, WP, a, b); u.pm = a; u.pn = MP + b; } return true; }
    __device__ __forceinline__ void a_ready(const Unit&) const {}
    __device__ __forceinline__ void done(const Unit&) const {}
};
struct EpiIn { static constexpr bool PERM = true, AFTER_DRAIN = false; bf16_t* P; float* G; bf16_t* HTp;
    __device__ __forceinline__ void operator()(const f32x4 (&acc)[2][2][4][2], const Unit& u, int wr, int wc, int fr, int fq) const {
        if (u.pm < MP) { const int pn = u.pn - MP, row0 = u.pm * BM + wr * 64 + fr;
            if (pn < NP / 256) { const int col0 = pn * BM + wc * 32 + 8 * fq;
#pragma unroll
                for (int ai = 0; ai < 2; ++ai)
#pragma unroll
                    for (int m = 0; m < 4; ++m) { bf16_t* rowp = P + (size_t)(row0 + ai * HALF + m * 16) * NP + col0;
#pragma unroll
                        for (int bj = 0; bj < 2; ++bj) { const f32x4 v0 = acc[ai][bj][m][0], v1 = acc[ai][bj][m][1];
                            u32x4 w; w.x = cvt_pk_bf16(v0[0], v0[1]); w.y = cvt_pk_bf16(v0[2], v0[3]); w.z = cvt_pk_bf16(v1[0], v1[1]); w.w = cvt_pk_bf16(v1[2], v1[3]); *(u32x4*)(rowp + bj * HALF) = w; } } }
            else { const int cb = wc * 32 + 8 * fq;
                if (cb < NG) {
#pragma unroll
                    for (int ai = 0; ai < 2; ++ai)
#pragma unroll
                        for (int m = 0; m < 4; ++m) { float* rowb = G + (size_t)(row0 + ai * HALF + m * 16) * NGS; const f32x4 v0 = acc[ai][0][m][0], v1 = acc[ai][0][m][1];
                            if (cb < 16) { *(f32x4*)(rowb + cb) = v0; *(f32x4*)(rowb + cb + 4) = v1; }
                            else { u32x4 w; w.x = cvt_pk_bf16(v0[0], v0[1]); w.y = cvt_pk_bf16(v0[2], v0[3]); w.z = cvt_pk_bf16(v1[0], v1[1]); w.w = cvt_pk_bf16(v1[2], v1[3]); *(u32x4*)((bf16_t*)(rowb + 16) + (cb - 16)) = w; } } } } }
        else { const int row0 = (u.pm - MP - WP) * BM + wr * 64 + fr, col0 = u.pn * BM + wc * 32 + 8 * fq;
#pragma unroll
            for (int ai = 0; ai < 2; ++ai)
#pragma unroll
                for (int m = 0; m < 4; ++m) { bf16_t* rowp = HTp + (size_t)(row0 + ai * HALF + m * 16) * T + col0;
#pragma unroll
                    for (int bj = 0; bj < 2; ++bj) { const f32x4 v0 = acc[ai][bj][m][0], v1 = acc[ai][bj][m][1];
                        u32x4 w; w.x = cvt_pk_bf16(v0[0], v0[1]); w.y = cvt_pk_bf16(v0[2], v0[3]); w.z = cvt_pk_bf16(v1[0], v1[1]); w.w = cvt_pk_bf16(v1[2], v1[3]); *(u32x4*)(rowp + bj * HALF) = w; } } }
    }
};
struct OutOrder { int G, c; bool lat_only; unsigned* cnt;
    __device__ __forceinline__ bool next(int i, Unit& u) const { constexpr int nN = DM / 256, nLat = NB * (SEQ / 256) * nN, nCtx = NB * (CTXL / 256) * nN; const int L = i * G + c; int a, b;
        if (L < nLat) { map_tile(L, nLat / nN, nN, a, b); u.pm = (a / (SEQ / 256)) * (TOK / 256) + CTXL / 256 + a % (SEQ / 256); }
        else { if (lat_only || L >= nLat + nCtx) return false; map_tile(L - nLat, nCtx / nN, nN, a, b); u.pm = (a / (CTXL / 256)) * (TOK / 256) + a % (CTXL / 256); }
        u.pn = b; return true; }
    __device__ __forceinline__ void a_ready(const Unit&) const {}
    unsigned* xu; unsigned nloc, xtarget;
    __device__ __forceinline__ void done(const Unit& u) const {
        asm volatile("s_waitcnt vmcnt(0)" ::: "memory"); __builtin_amdgcn_s_barrier();
        if (threadIdx.x == 0) { const bool isctx = (u.pm % (TOK / 256)) < CTXL / 256;
            if (!isctx && xtarget != 0u) {
                const unsigned old = __hip_atomic_fetch_add(xu, 1u, __ATOMIC_RELAXED, __HIP_MEMORY_SCOPE_AGENT);
                if (old + 1u == xtarget) { __builtin_amdgcn_fence(__ATOMIC_RELEASE, "agent"); asm volatile("s_waitcnt vmcnt(0)" ::: "memory");
                    __hip_atomic_fetch_add(cnt, nloc, __ATOMIC_RELAXED, __HIP_MEMORY_SCOPE_AGENT); } }
            else { __builtin_amdgcn_fence(__ATOMIC_RELEASE, "agent"); asm volatile("s_waitcnt vmcnt(0)" ::: "memory");
                __hip_atomic_fetch_add(cnt + (isctx ? 64 : 0), 1u, __ATOMIC_RELAXED, __HIP_MEMORY_SCOPE_AGENT); } } }
};
struct EpiOut { static constexpr bool PERM = true, AFTER_DRAIN = false; bf16_t* C;
    __device__ __forceinline__ void operator()(const f32x4 (&acc)[2][2][4][2], const Unit& u, int wr, int wc, int fr, int fq) const {
        const int row0 = u.pm * BM + wr * 64 + fr, col0 = u.pn * BM + wc * 32 + 8 * fq;
#pragma unroll
        for (int ai = 0; ai < 2; ++ai)
#pragma unroll
            for (int m = 0; m < 4; ++m) { bf16_t* rowp = C + (size_t)(row0 + ai * HALF + m * 16) * DM + col0;
#pragma unroll
                for (int bj = 0; bj < 2; ++bj) { const f32x4 v0 = acc[ai][bj][m][0], v1 = acc[ai][bj][m][1];
                    u32x4 w; w.x = cvt_pk_bf16(v0[0], v0[1]); w.y = cvt_pk_bf16(v0[2], v0[3]); w.z = cvt_pk_bf16(v1[0], v1[1]); w.w = cvt_pk_bf16(v1[2], v1[3]); *(u32x4*)(rowp + bj * HALF) = w; } }
    }
};
}
#endif

__device__ __forceinline__ void phase_gemm_in(const Params& p, int l, char* smem) {
    constexpr int N_F = WG / 2;
#ifdef EMU
    constexpr int MT = T / 128, NT1 = NMAIN / 128, N1 = MT * NT1, N2 = 8 * MT;
    for (int task = obid(); task < N1 + N2; task += gridDim.x) {
        if (task < N1) gemm_tile(p, (const bf16*)(p.ws + WS_HNY), (const bf16*)(p.ws + WS_WIN), DM, task / NT1, task % NT1, 0, smem);
        else { const int t2 = task - N1; gemm_tile(p, (const bf16*)(p.ws + WS_WIN) + (size_t)NMAIN * DM, (const bf16*)(p.ws + WS_HNY), DM, t2 / MT, t2 % MT, 2, smem); }
    }
#else
    { const pg8::Gemm g{(const pg8::bf16_t*)(p.ws + WS_HNY), (const pg8::bf16_t*)(p.ws + WS_HNY), 0, 0, DM};
      const pg8::InOrder S{(int)gridDim.x, obid()};
      const pg8::EpiIn E{(pg8::bf16_t*)(p.ws + WS_P), (float*)(p.ws + WS_G), (pg8::bf16_t*)(p.ws + WS_HT)};
      pg8::gemm_phase<pg8::EpiIn, pg8::InOrder, true, true>((PG8_LAS unsigned char*)smem, g, S, E); }
#endif
    { const int G = (int)gridDim.x, bid = obid();
#ifdef EMU
      const int extra = 0;
#else
      const int extra = (pg8::NU1 + pg8::NU2) % G;
#endif
      if (extra > 0 && extra < G) { if (bid >= extra) for (int task = bid - extra; task < N_F; task += G - extra) filt_fft_task(p, task, smem); }
      else for (int task = G - 1 - bid; task < N_F; task += G) filt_fft_task(p, task, smem); }
}
__device__ __forceinline__ void phase_gemm_out(const Params& p, int l, char* smem) {
    const int G = (int)gridDim.x, bid = obid(); const bool has_ctx = l < DEPTH - 1;
#ifdef EMU
    constexpr int MT = T / 128, NTO = DM / 128;
    for (int task = bid; task < MT * NTO; task += G) {
        const int mt = task / NTO, nt = task % NTO;
        if (!has_ctx && (mt % (TOK / 128)) < CTXL / 128) continue;
        gemm_tile(p, (const bf16*)(p.ws + WS_HNY), (const bf16*)(p.ws + WS_WOUT), MIX, mt, nt, 1, smem);
        __syncthreads(); if (otid() == 0) *unit_counter(p, (mt % (TOK / 128)) < CTXL / 128 ? 1 : 0) += 1u;
    }
#else
    const pg8::Gemm g{(const pg8::bf16_t*)(p.ws + WS_HNY), (const pg8::bf16_t*)(p.ws + WS_WOUT), 0, 0, MIX};
    const unsigned xcc = (unsigned)__builtin_amdgcn_s_getreg((3 << 11) | 20) & 0xFu, nloc = ((volatile PG8_LAS unsigned*)(smem + LDS_BYTES - 64))[0];
    const bool agg = (NB * (SEQ / 256) * (DM / 256) == G) && nloc > 0u;
    const pg8::OutOrder S{G, bid, !has_ctx, unit_counter(p, 0), unit_counter(p, 2) + 16 * xcc, nloc, agg ? nloc * (unsigned)(l + 1) : 0u};
    const pg8::EpiOut E{(pg8::bf16_t*)(p.ws + WS_P)};
    pg8::gemm_phase<pg8::EpiOut, pg8::OutOrder, true, true>((PG8_LAS unsigned char*)smem, g, S, E);
#endif
}

__device__ __forceinline__ size_t st_index(int mixer, int dir, int b, int h, int cid) { return ((((size_t)(mixer * 2 + dir) * NB + b) * NH + h) * NCH + cid); }
__device__ __forceinline__ size_t ch_index(int dir, int b, int h, int cid) { return (((size_t)dir * NB + b) * NH + h) * NCH + cid; }

__device__ __forceinline__ void load_tile_nat(const bf16* P, int r0, int c0, bf16* dst, float scale, int tid) {
    const int s = tid >> 3, c8 = tid & 7;
    const u32x4 v = *(const u32x4*)(P + (size_t)(r0 + s) * NP + c0 + c8 * 8);
    if (scale == 1.0f) *(u32x4*)(dst + s * LS + c8 * 8) = v;
    else { float f[8]; unpack8(v, f); u32x4 o; o.x = pk2(f[0] * scale, f[1] * scale); o.y = pk2(f[2] * scale, f[3] * scale); o.z = pk2(f[4] * scale, f[5] * scale); o.w = pk2(f[6] * scale, f[7] * scale);
        *(u32x4*)(dst + s * LS + c8 * 8) = o; }
}
__device__ __forceinline__ void load_tile_tr(const bf16* P, int r0, int c0, bf16* dst, int tid) {
    const int s = tid >> 3, c8 = tid & 7;
    const u32x4 v = *(const u32x4*)(P + (size_t)(r0 + s) * NP + c0 + c8 * 8);
    const unsigned w[4] = {v.x, v.y, v.z, v.w};
#pragma unroll
    for (int j = 0; j < 4; ++j) { dst[(c8 * 8 + 2 * j) * LS + s] = (bf16)(w[j] & 0xffffu); dst[(c8 * 8 + 2 * j + 1) * LS + s] = (bf16)(w[j] >> 16); }
}

template <int NTK>
__device__ __forceinline__ void load_span(const bf16* row, int t0, float (&v)[NTK + 2]) {
    { const bool hl = t0 > 0, hr = t0 + NTK < SEQ; const bf16 xl = row[hl ? -1 : 0], xr = row[hr ? NTK : 0];
        v[0] = hl ? bf2f(xl) : 0.f; v[NTK + 1] = hr ? bf2f(xr) : 0.f; }
    if constexpr (NTK == 8) { float f[8]; unpack8(*(const u32x4*)row, f);
#pragma unroll
        for (int i = 0; i < 8; ++i) v[1 + i] = f[i]; }
    else {
#pragma unroll
        for (int i = 0; i < NTK; ++i) v[1 + i] = bf2f(row[i]); }
}
struct SpanRaw { u32x4 b; bf16 xl, xr; };
__device__ __forceinline__ SpanRaw span_load8(const bf16* row, int t0) { SpanRaw s; const bool hl = t0 > 0, hr = t0 + 8 < SEQ; s.xl = row[hl ? -1 : 0]; s.xr = row[hr ? 8 : 0]; s.b = *(const u32x4*)row; return s; }
__device__ __forceinline__ void span_expand8(const SpanRaw& s, int t0, float (&v)[10]) { float f[8]; unpack8(s.b, f); v[0] = t0 > 0 ? bf2f(s.xl) : 0.f; v[9] = (t0 + 8 < SEQ) ? bf2f(s.xr) : 0.f;
#pragma unroll
    for (int i = 0; i < 8; ++i) v[1 + i] = f[i]; }
template <int NTK>
__device__ __forceinline__ void hy_inputs(const bf16* h0, const bf16* h1, const float* cw, const float* cb, int c, int t0, float (&u0)[NTK], float (&u1)[NTK], float (&g0)[NTK], float (&g1)[NTK]) {
    if constexpr (NTK == 8) {
        const SpanRaw rxa = span_load8(h0 + (size_t)512 * T, t0), rxb = span_load8(h1 + (size_t)512 * T, t0), rga = span_load8(h0 + (size_t)768 * T, t0), rgb = span_load8(h1 + (size_t)768 * T, t0);
        const SpanRaw rva = span_load8(h0, t0), rvb = span_load8(h1, t0), rya = span_load8(h0 + (size_t)256 * T, t0), ryb = span_load8(h1 + (size_t)256 * T, t0);
        const float w0 = cw[0 * 768 + 512 + c], w1 = cw[1 * 768 + 512 + c], w2 = cw[2 * 768 + 512 + c], bb = cb[512 + c];
        const float v0 = cw[0 * 768 + c], v1 = cw[1 * 768 + c], v2 = cw[2 * 768 + c], vbias = cb[c];
        const float y0 = cw[0 * 768 + 256 + c], y1 = cw[1 * 768 + 256 + c], y2 = cw[2 * 768 + 256 + c], ybias = cb[256 + c];
        SCHED_FENCE();
        { float xa[10], xb[10], ga[10], gb[10]; span_expand8(rxa, t0, xa); span_expand8(rxb, t0, xb); span_expand8(rga, t0, ga); span_expand8(rgb, t0, gb);
#pragma unroll
            for (int i = 0; i < 8; ++i) { g0[i] = (w0 * xa[i] + w1 * xa[i + 1] + w2 * xa[i + 2] + bb) * siluf_(ga[i + 1]); g1[i] = (w0 * xb[i] + w1 * xb[i + 1] + w2 * xb[i + 2] + bb) * siluf_(gb[i + 1]); } }
        { float va[10], vb[10], ya[10], yb[10]; span_expand8(rva, t0, va); span_expand8(rvb, t0, vb); span_expand8(rya, t0, ya); span_expand8(ryb, t0, yb);
#pragma unroll
            for (int i = 0; i < 8; ++i) { u0[i] = (v0 * va[i] + v1 * va[i + 1] + v2 * va[i + 2] + vbias) * (y0 * ya[i] + y1 * ya[i + 1] + y2 * ya[i + 2] + ybias);
                u1[i] = (v0 * vb[i] + v1 * vb[i + 1] + v2 * vb[i + 2] + vbias) * (y0 * yb[i] + y1 * yb[i + 1] + y2 * yb[i + 2] + ybias); } }
        return;
    }
    { float xa[NTK + 2], xb[NTK + 2]; load_span<NTK>(h0 + (size_t)512 * T, t0, xa); load_span<NTK>(h1 + (size_t)512 * T, t0, xb);
        const float w0 = cw[0 * 768 + 512 + c], w1 = cw[1 * 768 + 512 + c], w2 = cw[2 * 768 + 512 + c], bb = cb[512 + c];
        float ga[NTK + 2], gb[NTK + 2]; load_span<NTK>(h0 + (size_t)768 * T, t0, ga); load_span<NTK>(h1 + (size_t)768 * T, t0, gb);
#pragma unroll
        for (int i = 0; i < NTK; ++i) { g0[i] = (w0 * xa[i] + w1 * xa[i + 1] + w2 * xa[i + 2] + bb) * siluf_(ga[i + 1]); g1[i] = (w0 * xb[i] + w1 * xb[i + 1] + w2 * xb[i + 2] + bb) * siluf_(gb[i + 1]); } }
    { float va[NTK + 2], vb[NTK + 2], ya[NTK + 2], yb[NTK + 2];
        load_span<NTK>(h0, t0, va); load_span<NTK>(h1, t0, vb); load_span<NTK>(h0 + (size_t)256 * T, t0, ya); load_span<NTK>(h1 + (size_t)256 * T, t0, yb);
        const float v0 = cw[0 * 768 + c], v1 = cw[1 * 768 + c], v2 = cw[2 * 768 + c], vbias = cb[c];
        const float y0 = cw[0 * 768 + 256 + c], y1 = cw[1 * 768 + 256 + c], y2 = cw[2 * 768 + 256 + c], ybias = cb[256 + c];
#pragma unroll
        for (int i = 0; i < NTK; ++i) { u0[i] = (v0 * va[i] + v1 * va[i + 1] + v2 * va[i + 2] + vbias) * (y0 * ya[i] + y1 * ya[i + 1] + y2 * ya[i + 2] + ybias);
            u1[i] = (v0 * vb[i] + v1 * vb[i + 1] + v2 * vb[i + 2] + vbias) * (y0 * yb[i] + y1 * yb[i + 1] + y2 * yb[i + 2] + ybias); } }
}
__device__ __forceinline__ void hylat_task(const Params& p, int l, int bp, int cp, char* smem) {
    const int tid = otid(), half = tid >> 8, tl = tid & 255, c = 2 * cp + half;
    const bf16* HT = (const bf16*)(p.ws + WS_HT); bf16* Y = (bf16*)(p.ws + WS_HNY);
    cpx* buf = (cpx*)smem + (size_t)half * FBUF;
    const cpx* TW = (const cpx*)(p.ws + WS_TW);
    const cpx* KF = (const cpx*)(p.ws + WS_KF) + (size_t)c * NF;
    constexpr int NTK = SEQ / 256;
    const int t0 = NTK * tl;
    const float* cw = p.in[I_HCW] + (size_t)l * 3 * 768; const float* cb = p.in[I_HCB] + (size_t)l * 768;
    const size_t rb0 = (size_t)(2 * bp) * TOK + CTXL, rb1 = rb0 + TOK;
    const bf16* h0 = HT + (size_t)c * T + rb0 + t0; const bf16* h1 = h0 + TOK;
    { float u0[NTK], u1[NTK], g0[NTK], g1[NTK]; hy_inputs<NTK>(h0, h1, cw, cb, c, t0, u0, u1, g0, g1);
        __syncthreads();
#pragma unroll
        for (int i = 0; i < NTK; ++i) { cpx v; v.x = u0[i]; v.y = u1[i]; buf[FPH(t0 + i)] = v; cpx z = {0.f, 0.f}; buf[FPH(SEQ + t0 + i)] = z; } }
    fft_fwd(buf, TW, tl);
#pragma unroll 2
    for (int i = tl; i < NF; i += 256) buf[FPH(i)] = cmul(buf[FPH(i)], KF[i]);
    fft_inv(buf, TW, tl);
    const float dsk = p.in[I_HD][(size_t)l * WG + c]; const float sc = 1.0f / (float)NF;
    { const int tz = otid() & 255; const int t0z = NTK * tz;
        float u0[NTK], u1[NTK], g0[NTK], g1[NTK]; hy_inputs<NTK>(HT + (size_t)c * T + rb0 + t0z, HT + (size_t)c * T + rb0 + t0z + TOK, cw, cb, c, t0z, u0, u1, g0, g1);
        float o0[NTK], o1[NTK];
#pragma unroll
        for (int i = 0; i < NTK; ++i) { const cpx y = buf[FPH(t0z + i)]; o0[i] = g0[i] * (y.x * sc + u0[i] * dsk); o1[i] = g1[i] * (y.y * sc + u1[i] * dsk); }
        bf16* d0 = (bf16*)(p.ws + WS_HT) + (size_t)(768 + c) * T + rb0 + t0z; bf16* d1 = d0 + TOK;
        if constexpr (NTK == 8) { *(u32x4*)d0 = pack8(o0); *(u32x4*)d1 = pack8(o1); }
        else {
#pragma unroll
            for (int i = 0; i < NTK; ++i) { d0[i] = f2bf(o0[i]); d1[i] = f2bf(o1[i]); } } }
}

constexpr int HCB = 16;
__device__ __forceinline__ void hyctx_task(const Params& p, int l, int b, int cblk, char* smem) {
    const int tid = otid(); const int c0 = cblk * HCB;
    const bf16* HT = (const bf16*)(p.ws + WS_HT); bf16* Y = (bf16*)(p.ws + WS_HNY); const float* HC = (const float*)(p.ws + WS_HC);
    float* raw = (float*)smem;
    float* u = raw + 4 * CTXL * HCB;
    float* og = u + CTXL * HCB;
    float* hcm = og + CTXL * HCB;
    bf16* ob = (bf16*)raw;
    const size_t rb = (size_t)b * TOK;
    const float* cw = p.in[I_HCW] + (size_t)l * 3 * 768; const float* cbias = p.in[I_HCB] + (size_t)l * 768;
    constexpr int WT = CTXL / 32;
    __syncthreads();
    for (int i = tid; i < 4 * HCB * (CTXL / 8); i += NT) { const int k = i / (HCB * (CTXL / 8)), cc = (i / (CTXL / 8)) % HCB, ck = i % (CTXL / 8);
        float f[8]; unpack8(*(const u32x4*)(HT + (size_t)(k * 256 + c0 + cc) * T + rb + ck * 8), f);
#pragma unroll
        for (int j = 0; j < 8; ++j) raw[(k * CTXL + ck * 8 + j) * HCB + cc] = f[j]; }
    for (int i = tid; i < 2 * HCB * (CTXL / 4); i += NT) { const int dir = i / (HCB * (CTXL / 4)), cc = (i / (CTXL / 4)) % HCB, pk = i % (CTXL / 4);
        const f32x4 v = *(const f32x4*)(HC + ((size_t)dir * WG + c0 + cc) * CTXL + pk * 4); const float f[4] = {v.x, v.y, v.z, v.w};
#pragma unroll
        for (int j = 0; j < 4; ++j) { const int pos = pk * 4 + j; if (dir == 0) hcm[(CTXL + pos) * HCB + cc] = f[j]; else if (pos > 0) hcm[(CTXL - pos) * HCB + cc] = f[j]; } }
    if (tid < HCB) hcm[tid] = 0.f;
    __syncthreads();
    static_assert(NT % HCB == 0, "a thread keeps its channel over the passes: its 12 filter taps are loaded once");
    float tw0[3], tw1[3], tw2[3], tbs[3];
#pragma unroll
    for (int k = 0; k < 3; ++k) { const int ch = k * 256 + c0 + tid % HCB; tw0[k] = cw[0 * 768 + ch]; tw1[k] = cw[1 * 768 + ch]; tw2[k] = cw[2 * 768 + ch]; tbs[k] = cbias[ch]; }
    for (int i = tid; i < CTXL * HCB; i += NT) { const int t = i / HCB, cc = i % HCB; float cv[3];
#pragma unroll
        for (int k = 0; k < 3; ++k) { const float* rk = raw + k * CTXL * HCB;
            const float a = t > 0 ? rk[(t - 1) * HCB + cc] : 0.f, m = rk[t * HCB + cc], z = t < CTXL - 1 ? rk[(t + 1) * HCB + cc] : 0.f;
            cv[k] = tw0[k] * a + tw1[k] * m + tw2[k] * z + tbs[k]; }
        u[i] = cv[0] * cv[1];
        og[i] = cv[2] * siluf_(raw[(3 * CTXL + t) * HCB + cc]); }
    __syncthreads();
    { const int cc = tid % HCB, tg = tid / HCB, t0 = WT * tg; float acc[WT], w[WT];
#pragma unroll
        for (int j = 0; j < WT; ++j) { acc[j] = 0.f; w[j] = hcm[(t0 + j + CTXL) * HCB + cc]; }
#pragma unroll 8
        for (int s = 0; s < CTXL; ++s) { const float us = u[s * HCB + cc];
#pragma unroll
            for (int j = 0; j < WT; ++j) acc[j] += us * w[j];
#pragma unroll
            for (int j = WT - 1; j > 0; --j) w[j] = w[j - 1];
            w[0] = hcm[(t0 - s - 1 + CTXL) * HCB + cc]; }
        const float dsk = p.in[I_HD][(size_t)l * WG + c0 + cc];
#pragma unroll
        for (int j = 0; j < WT; ++j) { const int t = t0 + j; ob[t * HCB + cc] = f2bf(og[t * HCB + cc] * (acc[j] + u[t * HCB + cc] * dsk)); } }
    __syncthreads();
    for (int i = tid; i < CTXL * 2; i += NT) { const int t = i >> 1, hh = i & 1; *(u32x4*)(Y + (rb + t) * 1024 + YH + c0 + 8 * hh) = *(const u32x4*)(ob + t * HCB + 8 * hh); }
}

__device__ __forceinline__ void attn_task(const Params& p, int l, int b, int kvh, int qt, bool ctxq, char* smem) {
    const int tid = otid(), lane = tid & 63, wave = tid >> 6, r = lane & 15, q = lane >> 4;
    constexpr float QSC = 0.125f * 1.4426950408889634f;
    const bf16* P = (const bf16*)(p.ws + WS_P); bf16* Y = (bf16*)(p.ws + WS_HNY); const cpx* ROPE = (const cpx*)(p.ws + WS_ROPE);
    bf16* Qs = (bf16*)smem;
    bf16* Ks = Qs + 256 * LS;
    constexpr int LSV = 80;
    bf16* Vt = Ks + 64 * LS;
    bf16* Ps = Vt + 64 * LS;
    const size_t rq0 = (size_t)b * TOK + (ctxq ? 0 : CTXL) + qt * 128;
    __syncthreads();
    {
        u32x4 qlo[2], qhi[2]; f32x4 qrp[2][4];
#pragma unroll
        for (int it = 0; it < 2; ++it) { const int idx = tid + NT * it, row = idx >> 2, cpair = idx & 3, g = row >> 7, t = row & 127;
            const bf16* src = P + (rq0 + t) * NP + PD + (kvh * 2 + g) * 64; qlo[it] = *(const u32x4*)(src + cpair * 8); qhi[it] = *(const u32x4*)(src + 32 + cpair * 8);
            if (!ctxq) { const f32x4* rr = (const f32x4*)(ROPE + (size_t)(qt * 128 + t) * 32 + cpair * 8); qrp[it][0] = rr[0]; qrp[it][1] = rr[1]; qrp[it][2] = rr[2]; qrp[it][3] = rr[3]; }
            else { qrp[it][0] = qrp[it][1] = qrp[it][2] = qrp[it][3] = (f32x4){1.f, 0.f, 1.f, 0.f}; } }
        SCHED_FENCE();
#pragma unroll
        for (int it = 0; it < 2; ++it) { const int idx = tid + NT * it, row = idx >> 2, cpair = idx & 3;
            float lo[8], hi[8]; unpack8(qlo[it], lo); unpack8(qhi[it], hi);
            const float cs[8] = {qrp[it][0].x, qrp[it][0].z, qrp[it][1].x, qrp[it][1].z, qrp[it][2].x, qrp[it][2].z, qrp[it][3].x, qrp[it][3].z}, sn[8] = {qrp[it][0].y, qrp[it][0].w, qrp[it][1].y, qrp[it][1].w, qrp[it][2].y, qrp[it][2].w, qrp[it][3].y, qrp[it][3].w};
            float a[8], c2[8];
#pragma unroll
            for (int j = 0; j < 8; ++j) { a[j] = (lo[j] * cs[j] - hi[j] * sn[j]) * QSC; c2[j] = (hi[j] * cs[j] + lo[j] * sn[j]) * QSC; }
            *(u32x4*)(Qs + row * LS + cpair * 8) = pack8(a); *(u32x4*)(Qs + row * LS + 32 + cpair * 8) = pack8(c2); } }
    const int lt0 = ctxq ? 0 : (2 * qt - 2 > 0 ? 2 * qt - 2 : 0), lt1 = ctxq ? -1 : (2 * qt + 3 < SEQ / 64 - 1 ? 2 * qt + 3 : SEQ / 64 - 1);
    const int nloc = lt1 - lt0 + 1, ntiles = nloc + NCC;
    float m[2], lsum[2]; f32x4 O[2][4];
#pragma unroll
    for (int ms = 0; ms < 2; ++ms) { m[ms] = -INFINITY; lsum[ms] = 0.f;
#pragma unroll
        for (int i = 0; i < 4; ++i) O[ms][i] = (f32x4){0.f, 0.f, 0.f, 0.f}; }
    const int g = wave >> 2, tq0 = (wave & 3) * 32;
    (void)Ps;
    __syncthreads();
    bf16x8 qf[2][2];
#pragma unroll
    for (int ms = 0; ms < 2; ++ms)
#pragma unroll
        for (int ks = 0; ks < 2; ++ks) qf[ms][ks] = *(const bf16x8*)(Qs + (g * 128 + tq0 + 16 * ms + r) * LS + ks * 32 + q * 8);
    u32x4 klo = {0u, 0u, 0u, 0u}, khi = klo, vq = klo; f32x4 rp[4] = {(f32x4){1.f, 0.f, 1.f, 0.f}, (f32x4){1.f, 0.f, 1.f, 0.f}, (f32x4){1.f, 0.f, 1.f, 0.f}, (f32x4){1.f, 0.f, 1.f, 0.f}};
    const int ks_ = tid >> 2, kcp = tid & 3, vs_ = tid >> 3, vc8 = tid & 7;
#define ATT_PREFETCH(TI) do { const bool loc_ = (TI) < nloc; const int kt_ = loc_ ? lt0 + (TI) : (TI) - nloc; const size_t rk_ = (size_t)b * TOK + (loc_ ? CTXL : 0) + kt_ * 64; \
        if (tid < 256) { const bf16* src_ = P + (rk_ + ks_) * NP + PD + 256 + kvh * 64; klo = *(const u32x4*)(src_ + kcp * 8); khi = *(const u32x4*)(src_ + 32 + kcp * 8); \
            if (loc_) { const f32x4* rr_ = (const f32x4*)(ROPE + (size_t)(kt_ * 64 + ks_) * 32 + kcp * 8); rp[0] = rr_[0]; rp[1] = rr_[1]; rp[2] = rr_[2]; rp[3] = rr_[3]; } \
            else { rp[0] = rp[1] = rp[2] = rp[3] = (f32x4){1.f, 0.f, 1.f, 0.f}; } } \
        vq = *(const u32x4*)(P + (rk_ + vs_) * NP + PD + 384 + kvh * 64 + vc8 * 8); } while (0)
    ATT_PREFETCH(0);
    for (int ti = 0; ti < ntiles; ++ti) {
        const bool local = ti < nloc; const int kt = local ? lt0 + ti : ti - nloc;
        __syncthreads();
        if (tid < 256) { float lo[8], hi[8]; unpack8(klo, lo); unpack8(khi, hi);
            const float cs[8] = {rp[0].x, rp[0].z, rp[1].x, rp[1].z, rp[2].x, rp[2].z, rp[3].x, rp[3].z}, sn[8] = {rp[0].y, rp[0].w, rp[1].y, rp[1].w, rp[2].y, rp[2].w, rp[3].y, rp[3].w};
            float a[8], c2[8];
#pragma unroll
            for (int j = 0; j < 8; ++j) { a[j] = lo[j] * cs[j] - hi[j] * sn[j]; c2[j] = hi[j] * cs[j] + lo[j] * sn[j]; }
            *(u32x4*)(Ks + ks_ * LS + kcp * 8) = pack8(a); *(u32x4*)(Ks + ks_ * LS + 32 + kcp * 8) = pack8(c2); }
        *(u32x4*)(Vt + vs_ * LSV + vc8 * 8) = vq;
        __syncthreads();
        if (ti + 1 < ntiles) ATT_PREFETCH(ti + 1);
        bf16x8 kfr[4][2], vfa[4], vfb[4];
#pragma unroll
        for (int nt = 0; nt < 4; ++nt)
#pragma unroll
            for (int ks = 0; ks < 2; ++ks) kfr[nt][ks] = *(const bf16x8*)(Ks + (16 * nt + r) * LS + ks * 32 + q * 8);
#pragma unroll
        for (int me = 0; me < 4; ++me) { const bf16* vr = Vt + (4 * q + (r >> 2)) * LSV + 16 * me + 4 * (r & 3);
            const u32x2 a0 = lds_tr16(vr), a1 = lds_tr16(vr + 16 * LSV), a2 = lds_tr16(vr + 32 * LSV), a3 = lds_tr16(vr + 48 * LSV);
            u32x4 va; va.x = a0.x; va.y = a0.y; va.z = a1.x; va.w = a1.y; u32x4 vb; vb.x = a2.x; vb.y = a2.y; vb.z = a3.x; vb.w = a3.y; vfa[me] = as_frag(va); vfb[me] = as_frag(vb); }
#pragma unroll
        for (int ms = 0; ms < 2; ++ms) {
            const int qlo = qt * 128 + tq0 + 16 * ms, klo_ = kt * 64;
            if (local && (klo_ > qlo + 15 + 128 || klo_ + 63 < qlo - 128)) continue;
            const bool domask = local && (klo_ + 63 - qlo > 128 || klo_ - (qlo + 15) < -128);
            f32x4 S[4] = {(f32x4){0.f, 0.f, 0.f, 0.f}, (f32x4){0.f, 0.f, 0.f, 0.f}, (f32x4){0.f, 0.f, 0.f, 0.f}, (f32x4){0.f, 0.f, 0.f, 0.f}};
#pragma unroll
            for (int ks = 0; ks < 2; ++ks)
#pragma unroll
                for (int nt = 0; nt < 4; ++nt) S[nt] = MFMA16(kfr[nt][ks], qf[ms][ks], S[nt]);
            const int qpos = qlo + r; float mx = -INFINITY;
            if (domask) {
#pragma unroll
                for (int nt = 0; nt < 4; ++nt)
#pragma unroll
                    for (int i = 0; i < 4; ++i) { const int d = kt * 64 + nt * 16 + 4 * q + i - qpos; if (d > 128 || d < -128) S[nt][i] = -INFINITY; } }
#pragma unroll
            for (int nt = 0; nt < 4; ++nt)
#pragma unroll
                for (int i = 0; i < 4; ++i) mx = fmaxf(mx, S[nt][i]);
            mx = xrow_max(mx);
            const float mn = fmaxf(m[ms], mx); const float msafe = mn == -INFINITY ? 0.f : mn; const float alpha = EXP2(m[ms] - msafe); float sm = 0.f;
#pragma unroll
            for (int nt = 0; nt < 4; ++nt)
#pragma unroll
                for (int i = 0; i < 4; ++i) { S[nt][i] = EXP2(S[nt][i] - msafe); sm += S[nt][i]; }
            sm = xrow_sum(sm);
            lsum[ms] = lsum[ms] * alpha + sm; m[ms] = mn;
            const float pa[8] = {S[0][0], S[0][1], S[0][2], S[0][3], S[1][0], S[1][1], S[1][2], S[1][3]}, pb[8] = {S[2][0], S[2][1], S[2][2], S[2][3], S[3][0], S[3][1], S[3][2], S[3][3]};
            const bf16x8 p0 = as_frag(pack8(pa)), p1 = as_frag(pack8(pb));
#pragma unroll
            for (int me = 0; me < 4; ++me) { O[ms][me] = O[ms][me] * alpha;
                O[ms][me] = MFMA16(vfa[me], p0, O[ms][me]); O[ms][me] = MFMA16(vfb[me], p1, O[ms][me]); }
        }
    }
#undef ATT_PREFETCH
    const float sink = p.in[I_SINK][(size_t)l * NH + kvh * 2 + g];
    u32x2 ggs[2][4];
#pragma unroll
    for (int ms = 0; ms < 2; ++ms)
#pragma unroll
        for (int me = 0; me < 4; ++me) ggs[ms][me] = *(const u32x2*)(P + (rq0 + tq0 + 16 * ms + r) * NP + PD + 512 + (kvh * 2 + g) * 64 + 4 * q + 16 * me);
#pragma unroll
    for (int ms = 0; ms < 2; ++ms) { const float den = lsum[ms] + EXP2(sink * 1.4426950408889634f - m[ms]); const float inv = frcp_(den);
        const size_t row = rq0 + tq0 + 16 * ms + r; const int col = (kvh * 2 + g) * 64 + 4 * q;
#pragma unroll
        for (int me = 0; me < 4; ++me) { const u32x2 gg = ggs[ms][me];
            const float g0 = bitsf(gg.x << 16), g1 = bitsf(gg.x & 0xffff0000u), g2 = bitsf(gg.y << 16), g3 = bitsf(gg.y & 0xffff0000u);
            u32x2 o; o.x = pk2(O[ms][me][0] * inv * siluf_(g0), O[ms][me][1] * inv * siluf_(g1)); o.y = pk2(O[ms][me][2] * inv * siluf_(g2), O[ms][me][3] * inv * siluf_(g3));
            *(u32x2*)(Y + row * 1024 + YD + col + 16 * me) = o; } }
}

#ifdef EMU
__device__ __forceinline__ int olane(int lane) { return lane; }
#else
__device__ __forceinline__ int olane(int lane) { asm volatile("" : "+v"(lane)); return lane; }
#endif
__device__ __forceinline__ void load_nat_tile(const bf16* P, int row0, int col0, bf16* tile, int lane) {
    u32x4 v[8];
#pragma unroll
    for (int i = 0; i < 8; ++i) v[i] = *(const u32x4*)(P + (size_t)(row0 + (lane >> 3) + 8 * i) * NP + col0 + (lane & 7) * 8);
#pragma unroll
    for (int i = 0; i < 8; ++i) *(u32x4*)(tile + swz((lane >> 3) + 8 * i, lane & 7)) = v[i];
}
__device__ __forceinline__ bf16x8 frag_tr(const bf16* tile, int c0, int k0, int lane) {
    const int c = c0 + (lane & 15), kb = k0 + 8 * (lane >> 4); unsigned w[4];
#pragma unroll
    for (int j = 0; j < 4; ++j) w[j] = (unsigned)tile[swz(kb + 2 * j, c >> 3) + (c & 7)] | ((unsigned)tile[swz(kb + 2 * j + 1, c >> 3) + (c & 7)] << 16);
    u32x4 o; o.x = w[0]; o.y = w[1]; o.z = w[2]; o.w = w[3]; return as_frag(o);
}
__device__ __forceinline__ bf16x8 frag_tr_hw(const bf16* tile, int c0, int k0, int lane) {
    const int r = lane & 15, q = lane >> 4, row = k0 + 8 * q + (r >> 2), col = c0 + 4 * (r & 3);
    const u32x2 a = lds_tr16(tile + swz(row, col >> 3) + (col & 7)), b = lds_tr16(tile + swz(row + 4, col >> 3) + (col & 7));
    u32x4 o; o.x = a.x; o.y = a.y; o.z = b.x; o.w = b.y; return as_frag(o);
}
template <int DIR>
__device__ __forceinline__ void gla_r_frags(const float* Grow0, int lane, bf16x8 (&af)[4]) {
    const int r = lane & 15, q4 = lane >> 4;
#pragma unroll
    for (int mt = 0; mt < 4; ++mt) { u32x4 o = {0u, 0u, 0u, 0u};
        if (q4 < 2) o = *(const u32x4*)((const bf16*)(Grow0 + (size_t)(16 * mt + r) * NGS + 16) + DIR * 16 + 8 * q4);
        af[mt] = as_frag(o); }
}
template <int DIR>
__device__ __forceinline__ void gla_b_load(const Params& p, int l, int h, int nt, int lane_, u32x4& o, float& bias) {
    const int lane = olane(lane_), r = lane & 15, q4 = lane >> 4, d = h * 64 + 16 * nt + r;
    const float* wa = p.in[I_GWA] + ((size_t)(l * 2 + DIR) * 16 + 8 * (q4 & 1)) * WG + d;
    float w[8];
#pragma unroll
    for (int j = 0; j < 8; ++j) w[j] = wa[j * WG];
    bias = p.in[I_GBA][(size_t)(l * 2 + DIR) * WG + d];
    o.x = pk2(w[0], w[1]); o.y = pk2(w[2], w[3]); o.z = pk2(w[4], w[5]); o.w = pk2(w[6], w[7]);
    if (q4 >= 2) o = (u32x4){0u, 0u, 0u, 0u};
}
template <int DIR>
__device__ __forceinline__ float gla_b_col(const u32x4 o, const float bias, const bf16x8 (&af)[4], int lane_, float (&x)[4][4]) {
    const int lane = olane(lane_), r = lane & 15, q4 = lane >> 4;
    const bf16x8 bfr = as_frag(o);
#pragma unroll
    for (int mt = 0; mt < 4; ++mt) { f32x4 c = {bias, bias, bias, bias}; c = MFMA16(af[mt], bfr, c);
#pragma unroll
        for (int i = 0; i < 4; ++i) x[mt][i] = logsig_fast(c[i]) * (1.0f / 16.0f); }
    float carry = 0.f;
#pragma unroll
    for (int k = 0; k < 4; ++k) { const int mt = DIR == 0 ? k : 3 - k; float* y = x[mt];
        if (DIR == 0) { y[1] += y[0]; y[2] += y[1]; y[3] += y[2]; } else { y[2] += y[3]; y[1] += y[2]; y[0] += y[1]; }
        const float s4 = DIR == 0 ? y[3] : y[0];
        float e, tot; xrow_scan<DIR>(s4, lane, e, tot);
#pragma unroll
        for (int i = 0; i < 4; ++i) y[i] += carry + e;
        carry += tot; }
    return carry;
}

template <int MIXER, int DIR>
__device__ __forceinline__ void chunkst_dir(const Params& p, int l, int b, int h, int cid, const float* Grow0, const unsigned (&kk)[32], const bf16* Vt, bf16* Kt, const float* wvs, float* bendl, int lane_) {
    const int lane = olane(lane_), r = lane & 15, q4 = lane >> 4;
    if constexpr (MIXER == 0) {
        float nacc = 0.f;
#pragma unroll
        for (int c = 0; c < 8; ++c) { float f[8];
#pragma unroll
            for (int j = 0; j < 8; ++j) { const int s = 8 * c + j; const float kv = (s & 1) ? bitsf(kk[s >> 1] & 0xffff0000u) : bitsf(kk[s >> 1] << 16);
                f[j] = kv * 0.125f * wvs[DIR * 64 + s]; nacc += f[j]; }
            *(u32x4*)(Kt + swz(lane, c)) = pack8(f); }
        ((float*)(p.ws + WS_NV))[ch_index(DIR, b, h, cid) * 64 + lane] = nacc;
    } else {
        const bf16* P = (const bf16*)(p.ws + WS_P); const int kcol = PG + 256 + h * 64; const int r0 = b * TOK + cid * 64;
        bf16x8 af[4]; gla_r_frags<DIR>(Grow0, lane, af);
#pragma unroll 2
        for (int nt = 0; nt < 4; ++nt) { const int d = 16 * nt + r; float x[4][4];
            u32x4 wo_; float wb_; gla_b_load<DIR>(p, l, h, nt, lane, wo_, wb_); const float bend = gla_b_col<DIR>(wo_, wb_, af, lane, x);
            if (q4 == 0) { ((float*)(p.ws + WS_BE))[ch_index(DIR, b, h, cid) * 64 + d] = bend; bendl[d] = __expf(fmaxf(bend, -80.0f)); }
#pragma unroll
            for (int mt = 0; mt < 4; ++mt)
#pragma unroll
                for (int i = 0; i < 4; ++i) { const int s = 16 * mt + 4 * q4 + i; const float kv = bf2f(P[(size_t)(r0 + s) * NP + kcol + d]); const float bc = fmaxf(x[mt][i], -80.0f);
                    Kt[swz(d, s >> 3) + (s & 7)] = f2bf(kv * __expf(-bc));
                    ((bf16*)(p.ws + WS_EQ))[((size_t)DIR * T + r0 + s) * WG + h * 64 + d] = f2bf(__expf(bc)); } }
    }
    WAVE_SYNC();
    bf16x8 vf[4][2];
#pragma unroll
    for (int ne = 0; ne < 4; ++ne)
#pragma unroll
        for (int ks = 0; ks < 2; ++ks) vf[ne][ks] = frag_tr_hw(Vt, 16 * ne, 32 * ks, lane);
    bf16* dst = (bf16*)(p.ws + WS_ST) + st_index(MIXER, DIR, b, h, cid) * 4096;
#pragma unroll
    for (int me = 0; me < 4; ++me) {
        f32x4 acc[4] = {(f32x4){0.f, 0.f, 0.f, 0.f}, (f32x4){0.f, 0.f, 0.f, 0.f}, (f32x4){0.f, 0.f, 0.f, 0.f}, (f32x4){0.f, 0.f, 0.f, 0.f}};
#pragma unroll
        for (int ks = 0; ks < 2; ++ks) { const bf16x8 a = *(const bf16x8*)(Kt + swz(16 * me + r, ks * 4 + q4));
#pragma unroll
            for (int ne = 0; ne < 4; ++ne) acc[ne] = MFMA16(a, vf[ne][ks], acc[ne]); }
        f32x4 sc4 = {1.f, 1.f, 1.f, 1.f}; if constexpr (MIXER == 1) sc4 = *(const f32x4*)(bendl + 16 * me + 4 * q4);
#pragma unroll
        for (int ne = 0; ne < 4; ++ne) { const f32x4 v = acc[ne] * sc4; u32x2 o; o.x = pk2(v[0], v[1]); o.y = pk2(v[2], v[3]); *(u32x2*)(dst + (16 * ne + r) * 64 + 16 * me + 4 * q4) = o; }
    }
    WAVE_SYNC();
}
template <int MIXER>
__device__ __forceinline__ void chunkst_w(const Params& p, int l, int b, int h, int cid, char* wl, int lane) {
    const bf16* P = (const bf16*)(p.ws + WS_P); const float* G = (const float*)(p.ws + WS_G);
    const int r0 = b * TOK + cid * 64, r = lane & 15, q4 = lane >> 4;
    bf16* Kt = (bf16*)wl;
    bf16* Vt = Kt + 4096;
    float* wvs = (float*)(Vt + 4096);
    float* bendl = wvs + 128;
    const int kcol = (MIXER == 0 ? PA : PG) + 256 + h * 64, vcol = (MIXER == 0 ? PA : PG) + 512 + h * 64;
    const float* Grow0 = G + (size_t)r0 * NGS;
    bf16* Nn = Kt;
    { u32x4 vv[8], kv[8];
#pragma unroll
        for (int i = 0; i < 8; ++i) { vv[i] = *(const u32x4*)(P + (size_t)(r0 + (lane >> 3) + 8 * i) * NP + vcol + (lane & 7) * 8); kv[i] = *(const u32x4*)(P + (size_t)(r0 + (lane >> 3) + 8 * i) * NP + kcol + (lane & 7) * 8); }
#pragma unroll
        for (int i = 0; i < 8; ++i) { *(u32x4*)(Vt + swz((lane >> 3) + 8 * i, lane & 7)) = vv[i]; *(u32x4*)(Nn + swz((lane >> 3) + 8 * i, lane & 7)) = kv[i]; } }
    WAVE_SYNC();
    unsigned kk[32];
    { const int dc = 16 * q4 + 4 * (r & 3);
#pragma unroll
        for (int c = 0; c < 16; ++c) { const u32x2 t = lds_tr16(Nn + swz(4 * c + (r >> 2), dc >> 3) + (dc & 7)); kk[2 * c] = t.x; kk[2 * c + 1] = t.y; } }
    WAVE_SYNC();
    if constexpr (MIXER == 0) {
        const float* g = Grow0 + (size_t)lane * NGS; const float* gb = p.in[I_MGB] + (size_t)l * 16;
        const float gv0 = g[h], gv1 = g[4 + h], gv2 = g[8 + h], gv3 = g[12 + h], bv0 = gb[h], bv1 = gb[4 + h], bv2 = gb[8 + h], bv3 = gb[12 + h];
        const float i_f = gv0 + bv0, f_f = gv1 + bv1, i_b = gv2 + bv2, f_b = gv3 + bv3;
        const float lf = logsigf_(f_f), lb = logsigf_(f_b);
        const float bF = wave_prefix_sum(lf, lane), totF = __shfl(bF, 63);
        const float gF = totF - bF + i_f, mF = wave_max(gF);
        const float totB = wave_sum(lb), preB = wave_prefix_sum(lb, lane), bB = totB - preB + lb;
        const float gB = totB - bB + i_b, mB = wave_max(gB);
        wvs[lane] = __expf(gF - mF); wvs[64 + lane] = __expf(gB - mB);
        if (lane == 0) { float* SC = (float*)(p.ws + WS_SC);
            SC[ch_index(0, b, h, cid) * 4 + 0] = totF; SC[ch_index(0, b, h, cid) * 4 + 1] = mF;
            SC[ch_index(1, b, h, cid) * 4 + 0] = totB; SC[ch_index(1, b, h, cid) * 4 + 1] = mB; }
    }
    WAVE_SYNC();
    chunkst_dir<MIXER, 0>(p, l, b, h, cid, Grow0, kk, Vt, Kt, wvs, bendl, lane);
    chunkst_dir<MIXER, 1>(p, l, b, h, cid, Grow0, kk, Vt, Kt, wvs, bendl, lane);
}

template <int DIR>
__device__ __forceinline__ void chunkst_gla(const Params& p, int l, int b, int h, int cid, char* wl, int lane_) {
    const bf16* P = (const bf16*)(p.ws + WS_P);
    const int lane = olane(lane_), r0 = b * TOK + cid * 64, r = lane & 15, q4 = lane >> 4;
    bf16* Kt = (bf16*)wl;
    bf16* An = Kt + 4096;
    float* bendl = (float*)(An + 4096);
    const int kcol = PG + 256 + h * 64, vcol = PG + 512 + h * 64;
    const float* Grow0 = (const float*)(p.ws + WS_G) + (size_t)r0 * NGS;
    u32x4 vv[8], kv[8];
#pragma unroll
    for (int i = 0; i < 8; ++i) { vv[i] = *(const u32x4*)(P + (size_t)(r0 + (lane >> 3) + 8 * i) * NP + vcol + (lane & 7) * 8); kv[i] = *(const u32x4*)(P + (size_t)(r0 + (lane >> 3) + 8 * i) * NP + kcol + (lane & 7) * 8); }
    bf16x8 af[4]; gla_r_frags<DIR>(Grow0, lane, af);
    u32x4 wo[4]; float wb[4];
#pragma unroll
    for (int nt = 0; nt < 4; ++nt) gla_b_load<DIR>(p, l, h, nt, lane, wo[nt], wb[nt]);
#pragma unroll
    for (int i = 0; i < 8; ++i) *(u32x4*)(An + swz((lane >> 3) + 8 * i, lane & 7)) = vv[i];
    WAVE_SYNC();
    bf16x8 vf[4][2];
#pragma unroll
    for (int ne = 0; ne < 4; ++ne)
#pragma unroll
        for (int ks = 0; ks < 2; ++ks) vf[ne][ks] = frag_tr_hw(An, 16 * ne, 32 * ks, lane);
    WAVE_SYNC();
#pragma unroll
    for (int i = 0; i < 8; ++i) *(u32x4*)(An + swz((lane >> 3) + 8 * i, lane & 7)) = kv[i];
    WAVE_SYNC();
#pragma unroll
    for (int nt = 0; nt < 4; ++nt) { const int d = 16 * nt + r; float x[4][4];
        const float bend = gla_b_col<DIR>(wo[nt], wb[nt], af, lane, x);
        if (q4 == 0) { ((float*)(p.ws + WS_BE))[ch_index(DIR, b, h, cid) * 64 + d] = bend; bendl[d] = __expf(fmaxf(bend, -80.0f)); }
#pragma unroll
        for (int mt = 0; mt < 4; ++mt) { const int s0 = 16 * mt + 4 * q4, dc = 16 * nt + 4 * (r & 3);
            const u32x2 kq = lds_tr16(An + swz(s0 + (r >> 2), dc >> 3) + (dc & 7));
            const float kv[4] = {bitsf(kq.x << 16), bitsf(kq.x & 0xffff0000u), bitsf(kq.y << 16), bitsf(kq.y & 0xffff0000u)}; float kp[4];
#pragma unroll
            for (int i = 0; i < 4; ++i) { const float bc = fmaxf(x[mt][i], -80.0f); kp[i] = kv[i] * __expf(-bc); An[swz(s0 + i, d >> 3) + (d & 7)] = f2bf(__expf(bc)); }
            u32x2 o; o.x = pk2(kp[0], kp[1]); o.y = pk2(kp[2], kp[3]); *(u32x2*)(Kt + swz(d, s0 >> 3) + (s0 & 7)) = o; } }
    WAVE_SYNC();
    { bf16* EQg = (bf16*)(p.ws + WS_EQ) + ((size_t)DIR * T + r0) * WG + h * 64;
#pragma unroll
        for (int i = 0; i < 8; ++i) { const int s = (lane >> 3) + 8 * i, ck = lane & 7; *(u32x4*)(EQg + (size_t)s * WG + ck * 8) = *(const u32x4*)(An + swz(s, ck)); } }
    bf16* dst = (bf16*)(p.ws + WS_ST) + st_index(1, DIR, b, h, cid) * 4096;
#pragma unroll
    for (int me = 0; me < 4; ++me) {
        f32x4 acc[4] = {(f32x4){0.f, 0.f, 0.f, 0.f}, (f32x4){0.f, 0.f, 0.f, 0.f}, (f32x4){0.f, 0.f, 0.f, 0.f}, (f32x4){0.f, 0.f, 0.f, 0.f}};
#pragma unroll
        for (int ks = 0; ks < 2; ++ks) { const bf16x8 a = *(const bf16x8*)(Kt + swz(16 * me + r, ks * 4 + q4));
#pragma unroll
            for (int ne = 0; ne < 4; ++ne) acc[ne] = MFMA16(a, vf[ne][ks], acc[ne]); }
        const f32x4 sc4 = *(const f32x4*)(bendl + 16 * me + 4 * q4);
#pragma unroll
        for (int ne = 0; ne < 4; ++ne) { const f32x4 v = acc[ne] * sc4; u32x2 o; o.x = pk2(v[0], v[1]); o.y = pk2(v[2], v[3]); *(u32x2*)(dst + (16 * ne + r) * 64 + 16 * me + 4 * q4) = o; }
    }
    WAVE_SYNC();
}

template <int MIXER, int DIR>
__device__ __forceinline__ void chunkout_prep(const Params& p, int l, int b, int h, int cid, const float* Grow0, int r0, int pbase, const bf16* EQ, float* gar, int lane_) {
    const int lane = olane(lane_);
    if constexpr (MIXER == 0) {
        const bf16* P = (const bf16*)(p.ws + WS_P);
        const float* g = Grow0 + (size_t)lane * NGS; const float* gb = p.in[I_MGB] + (size_t)l * 16;
        const float gi = g[DIR * 8 + h], gf = g[DIR * 8 + 4 + h], bi = gb[DIR * 8 + h], bf_ = gb[DIR * 8 + 4 + h];
        const float mprev = ((const float*)(p.ws + WS_SC))[ch_index(DIR, b, h, cid) * 4 + 2];
        const float nv = ((const float*)(p.ws + WS_NV))[ch_index(DIR, b, h, cid) * 64 + lane];
        u32x4 qr[8];
#pragma unroll
        for (int c = 0; c < 8; ++c) qr[c] = *(const u32x4*)(P + (size_t)(r0 + lane) * NP + pbase + c * 8);
        const float ig = gi + bi, fg = gf + bf_;
        const float lf = logsigf_(fg); float bb;
        if (DIR == 0) bb = wave_prefix_sum(lf, lane); else { const float tt = wave_sum(lf), pre = wave_prefix_sum(lf, lane); bb = tt - pre + lf; }
        const float a = ig - bb; const float pm = DIR == 0 ? wave_prefix_max(a, lane) : wave_suffix_max(a, lane);
        const float mt_ = fmaxf(bb + mprev, bb + pm);
        float* ga = gar + DIR * 320;
        ga[lane] = bb - mt_; ga[64 + lane] = a; ga[128 + lane] = __expf(bb + mprev - mt_); ga[192 + lane] = __expf(-mt_);
        float* nvl = gar + 640 + DIR * 64;
        nvl[lane] = nv;
        WAVE_SYNC();
        float dq = 0.f;
#pragma unroll
        for (int c = 0; c < 8; ++c) { float f[8]; unpack8(qr[c], f);
            const f32x4 n0 = *(const f32x4*)(nvl + c * 8), n1 = *(const f32x4*)(nvl + c * 8 + 4);
            dq += f[0] * n0.x + f[1] * n0.y + f[2] * n0.z + f[3] * n0.w + f[4] * n1.x + f[5] * n1.y + f[6] * n1.z + f[7] * n1.w; }
        ga[256 + lane] = dq;
    }
}
template <int MIXER>
__device__ __forceinline__ void chunkout_prep2(const Params& p, int l, int b, int h, int cid, const float* Grow0, int r0, int pbase, float* gar, int lane_) {
    if constexpr (MIXER == 0) {
        const int lane = olane(lane_);
        const bf16* P = (const bf16*)(p.ws + WS_P);
        const float* g = Grow0 + (size_t)lane * NGS; const float* gb = p.in[I_MGB] + (size_t)l * 16;
        const float g0 = g[h], g1 = g[4 + h], g2 = g[8 + h], g3 = g[12 + h];
        const float mprev0 = ((const float*)(p.ws + WS_SC))[ch_index(0, b, h, cid) * 4 + 2], mprev1 = ((const float*)(p.ws + WS_SC))[ch_index(1, b, h, cid) * 4 + 2];
        const float nv0 = ((const float*)(p.ws + WS_NV))[ch_index(0, b, h, cid) * 64 + lane], nv1 = ((const float*)(p.ws + WS_NV))[ch_index(1, b, h, cid) * 64 + lane];
        u32x4 qr[8];
#pragma unroll
        for (int c = 0; c < 8; ++c) qr[c] = *(const u32x4*)(P + (size_t)(r0 + lane) * NP + pbase + c * 8);
        const float igF = g0 + gb[h], fgF = g1 + gb[4 + h], igB = g2 + gb[8 + h], fgB = g3 + gb[12 + h];
        { const float lf = logsigf_(fgF); const float bb = wave_prefix_sum(lf, lane);
            const float a = igF - bb; const float pm = wave_prefix_max(a, lane); const float mt_ = fmaxf(bb + mprev0, bb + pm); float* ga = gar;
            ga[lane] = bb - mt_; ga[64 + lane] = a; ga[128 + lane] = __expf(bb + mprev0 - mt_); ga[192 + lane] = __expf(-mt_); }
        { const float lf = logsigf_(fgB); const float tt = wave_sum(lf), pre = wave_prefix_sum(lf, lane); const float bb = tt - pre + lf;
            const float a = igB - bb; const float pm = wave_suffix_max(a, lane); const float mt_ = fmaxf(bb + mprev1, bb + pm); float* ga = gar + 320;
            ga[lane] = bb - mt_; ga[64 + lane] = a; ga[128 + lane] = __expf(bb + mprev1 - mt_); ga[192 + lane] = __expf(-mt_); }
        float* nvl = gar + 640;
        nvl[lane] = nv0; nvl[64 + lane] = nv1;
        WAVE_SYNC();
        float dq0 = 0.f, dq1 = 0.f;
#pragma unroll
        for (int c = 0; c < 8; ++c) { float f[8]; unpack8(qr[c], f);
            const f32x4 n0 = *(const f32x4*)(nvl + c * 8), n1 = *(const f32x4*)(nvl + c * 8 + 4), m0 = *(const f32x4*)(nvl + 64 + c * 8), m1 = *(const f32x4*)(nvl + 64 + c * 8 + 4);
            dq0 += f[0] * n0.x + f[1] * n0.y + f[2] * n0.z + f[3] * n0.w + f[4] * n1.x + f[5] * n1.y + f[6] * n1.z + f[7] * n1.w;
            dq1 += f[0] * m0.x + f[1] * m0.y + f[2] * m0.z + f[3] * m0.w + f[4] * m1.x + f[5] * m1.y + f[6] * m1.z + f[7] * m1.w; }
        gar[256 + lane] = dq0; gar[320 + 256 + lane] = dq1;
    }
}
template <int MIXER, int DIR, int NS>
__device__ __forceinline__ void chunkout_dir(const Params& p, int b, int h, int cid, int r0, int pbase, int th, const bf16x8 (&vtf)[4][2], const bf16* VtL, const bf16* EQ, bf16* SB, const float* gar, float* rsm, f32x4 (&htot)[NS][4], int lane_) {
    const bf16* P = (const bf16*)(p.ws + WS_P); const bf16* ST = (const bf16*)(p.ws + WS_ST);
    const int lane = olane(lane_), r = lane & 15, q4 = lane >> 4;
    const bf16* E = EQ + ((size_t)DIR * T + r0) * WG + h * 64;
    const float* ga = gar + DIR * 320;
    bf16x8 kf[4][2], ctf[4][2];
    if constexpr (MIXER == 0) {
#pragma unroll
        for (int n = 0; n < 4; ++n)
#pragma unroll
            for (int ks = 0; ks < 2; ++ks) { kf[n][ks] = *(const bf16x8*)(P + (size_t)(r0 + 16 * n + r) * NP + pbase + 256 + ks * 32 + q4 * 8); ctf[n][ks] = *(const bf16x8*)(ST + st_index(MIXER, DIR, b, h, cid) * 4096 + (16 * n + r) * 64 + ks * 32 + q4 * 8); }
    } else {
        u32x4 er[4][2];
#pragma unroll
        for (int n = 0; n < 4; ++n)
#pragma unroll
            for (int ks = 0; ks < 2; ++ks) { kf[n][ks] = *(const bf16x8*)(P + (size_t)(r0 + 16 * n + r) * NP + pbase + 256 + ks * 32 + q4 * 8);
                er[n][ks] = *(const u32x4*)(E + (size_t)(16 * n + r) * WG + ks * 32 + q4 * 8);
                ctf[n][ks] = *(const bf16x8*)(ST + st_index(MIXER, DIR, b, h, cid) * 4096 + (16 * n + r) * 64 + ks * 32 + q4 * 8); }
        SCHED_FENCE();
#pragma unroll
        for (int n = 0; n < 4; ++n)
#pragma unroll
            for (int ks = 0; ks < 2; ++ks) { float fe[8], fk[8]; unpack8(er[n][ks], fe); unpack8(as_u4(kf[n][ks]), fk);
#pragma unroll
                for (int j = 0; j < 8; ++j) fk[j] = fk[j] * frcp_(fe[j]);
                kf[n][ks] = as_frag(pack8(fk)); }
    }
    bf16x8 qraw[NS][2]; u32x4 qer[NS][2];
#pragma unroll
    for (int ms = 0; ms < NS; ++ms)
#pragma unroll
        for (int ks = 0; ks < 2; ++ks) { const int mt = NS * th + ms; qraw[ms][ks] = *(const bf16x8*)(P + (size_t)(r0 + 16 * mt + r) * NP + pbase + ks * 32 + q4 * 8);
            if constexpr (MIXER == 1) qer[ms][ks] = *(const u32x4*)(E + (size_t)(16 * mt + r) * WG + ks * 32 + q4 * 8); else qer[ms][ks] = (u32x4){0u, 0u, 0u, 0u}; }
#pragma unroll
    for (int ms = 0; ms < NS; ++ms) { const int mt = NS * th + ms;
        bf16x8 qf[2];
#pragma unroll
        for (int ks = 0; ks < 2; ++ks) { qf[ks] = qraw[ms][ks];
            if constexpr (MIXER == 1) { float fe[8], fq[8]; unpack8(qer[ms][ks], fe); unpack8(as_u4(qf[ks]), fq);
#pragma unroll
                for (int j = 0; j < 8; ++j) fq[j] *= 0.125f * fe[j];
                qf[ks] = as_frag(pack8(fq)); } }
        f32x4 S[4] = {(f32x4){0.f, 0.f, 0.f, 0.f}, (f32x4){0.f, 0.f, 0.f, 0.f}, (f32x4){0.f, 0.f, 0.f, 0.f}, (f32x4){0.f, 0.f, 0.f, 0.f}};
#pragma unroll
        for (int ks = 0; ks < 2; ++ks)
#pragma unroll
            for (int n = 0; n < 4; ++n) S[n] = MFMA16(kf[n][ks], qf[ks], S[n]);
        const int t = 16 * mt + r; float sm = 0.f; float gt = 0.f; if constexpr (MIXER == 0) gt = ga[t];
#pragma unroll
        for (int n = 0; n < 4; ++n) { f32x4 gs = {0.f, 0.f, 0.f, 0.f}; if constexpr (MIXER == 0) gs = *(const f32x4*)(ga + 64 + 16 * n + 4 * q4);
#pragma unroll
            for (int i = 0; i < 4; ++i) { const int sidx = 16 * n + 4 * q4 + i; const bool ok = DIR == 0 ? (sidx <= t) : (sidx >= t); float v = 0.f;
                if (ok) { if constexpr (MIXER == 0) v = S[n][i] * 0.125f * __expf(gt + gs[i]); else v = S[n][i]; }
                S[n][i] = v; sm += v; } }
        const float pa[8] = {S[0][0], S[0][1], S[0][2], S[0][3], S[1][0], S[1][1], S[1][2], S[1][3]}, pb[8] = {S[2][0], S[2][1], S[2][2], S[2][3], S[3][0], S[3][1], S[3][2], S[3][3]};
        const bf16x8 sm0 = as_frag(pack8(pa)), sm1 = as_frag(pack8(pb));
        float wi = 1.f, inv = 1.f;
        if constexpr (MIXER == 0) { sm = xrow_sum(sm); wi = ga[128 + t]; const float den = wi * ga[256 + t] + sm; inv = frcp_(fmaxf(fabsf(den), ga[192 + t])); }
#pragma unroll
        for (int me = 0; me < 4; ++me) { f32x4 a1 = {0.f, 0.f, 0.f, 0.f}, a2 = {0.f, 0.f, 0.f, 0.f};
            const int srow = 4 * q4 + (r >> 2), ecol = 16 * me + 4 * (r & 3);
            const u32x2 v0 = lds_tr16(VtL + swz(srow, ecol >> 3) + (ecol & 7)), v1 = lds_tr16(VtL + swz(16 + srow, ecol >> 3) + (ecol & 7)), v2 = lds_tr16(VtL + swz(32 + srow, ecol >> 3) + (ecol & 7)), v3 = lds_tr16(VtL + swz(48 + srow, ecol >> 3) + (ecol & 7));
            u32x4 va; va.x = v0.x; va.y = v0.y; va.z = v1.x; va.w = v1.y; u32x4 vb; vb.x = v2.x; vb.y = v2.y; vb.z = v3.x; vb.w = v3.y;
            a1 = MFMA16(as_frag(va), sm0, a1); a1 = MFMA16(as_frag(vb), sm1, a1);
            a2 = MFMA16(ctf[me][0], qf[0], a2); a2 = MFMA16(ctf[me][1], qf[1], a2);
            if constexpr (MIXER == 0) htot[ms][me] += (a1 + a2 * wi) * inv; else htot[ms][me] += a1 + a2; }
    }
    (void)SB; (void)rsm;
}
__device__ __forceinline__ void co_build_vt(const bf16* P, int r0, int vcol, bf16* VtL, int lane) {
    load_nat_tile(P, r0, vcol, VtL, lane);
    WAVE_SYNC();
}
template <int MIXER, int NS>
__device__ __forceinline__ void co_finalize(const Params& p, int l, int h, int r0, int pbase, int mt0, f32x4 (&htot)[NS][4], int lane_) {
    const bf16* P = (const bf16*)(p.ws + WS_P); bf16* Y = (bf16*)(p.ws + WS_HNY);
    const float* ngp = p.in[MIXER == 0 ? I_MNG : I_GNG] + (size_t)l * WG + h * 64;
    const int lz = olane(lane_), r = lz & 15, q4 = lz >> 4;
    u32x2 gq[NS][4], oq[NS][4]; f32x4 ng[4];
#pragma unroll
    for (int me = 0; me < 4; ++me) ng[me] = *(const f32x4*)(ngp + 16 * me + 4 * q4);
#pragma unroll
    for (int ms = 0; ms < NS; ++ms)
#pragma unroll
        for (int me = 0; me < 4; ++me) { const size_t off = (size_t)(r0 + 16 * (mt0 + ms) + r) * NP + pbase + 16 * me + 4 * q4;
            gq[ms][me] = *(const u32x2*)(P + off + (MIXER == 0 ? 1024 : 768)); if constexpr (MIXER == 0) oq[ms][me] = *(const u32x2*)(P + off + 768); else oq[ms][me] = (u32x2){0u, 0u}; }
#pragma unroll
    for (int ms = 0; ms < NS; ++ms) { const int mt = mt0 + ms; float ss = 0.f; float gv[4][4];
#pragma unroll
        for (int me = 0; me < 4; ++me) {
            gv[me][0] = bitsf(gq[ms][me].x << 16); gv[me][1] = bitsf(gq[ms][me].x & 0xffff0000u); gv[me][2] = bitsf(gq[ms][me].y << 16); gv[me][3] = bitsf(gq[ms][me].y & 0xffff0000u);
            if constexpr (MIXER == 0) { htot[ms][me][0] *= sigmoidf_(bitsf(oq[ms][me].x << 16)); htot[ms][me][1] *= sigmoidf_(bitsf(oq[ms][me].x & 0xffff0000u)); htot[ms][me][2] *= sigmoidf_(bitsf(oq[ms][me].y << 16)); htot[ms][me][3] *= sigmoidf_(bitsf(oq[ms][me].y & 0xffff0000u)); }
            ss += htot[ms][me][0] * htot[ms][me][0] + htot[ms][me][1] * htot[ms][me][1] + htot[ms][me][2] * htot[ms][me][2] + htot[ms][me][3] * htot[ms][me][3]; }
        ss = xrow_sum(ss);
        const float rstd = rsqrtf(ss * (1.0f / 64.0f) + EPS);
#pragma unroll
        for (int me = 0; me < 4; ++me) { const int e = 16 * me + 4 * q4; const f32x4 n4 = ng[me];
            u32x2 o; o.x = pk2(htot[ms][me][0] * rstd * n4.x * siluf_(gv[me][0]), htot[ms][me][1] * rstd * n4.y * siluf_(gv[me][1]));
            o.y = pk2(htot[ms][me][2] * rstd * n4.z * siluf_(gv[me][2]), htot[ms][me][3] * rstd * n4.w * siluf_(gv[me][3]));
            *(u32x2*)(Y + (size_t)(r0 + 16 * mt + r) * 1024 + (MIXER == 0 ? YA : YG) + h * 64 + e) = o; } }
}
template <int MIXER>
__device__ __forceinline__ void chunkout_w(const Params& p, int l, int b, int h, int cid, char* wl, int lane) {
    const bf16* P = (const bf16*)(p.ws + WS_P); const float* G = (const float*)(p.ws + WS_G);
    const int r0 = b * TOK + cid * 64;
    const int pbase = (MIXER == 0 ? PA : PG) + h * 64;
    bf16* SB = (bf16*)wl;
    float* rsm = (float*)(SB + 1024);
    float* gar = rsm + 16;
    const bf16* EQ = (const bf16*)(p.ws + WS_EQ);
    const float* Grow0 = G + (size_t)r0 * NGS;
    bf16* VtL = (bf16*)(gar + 768);
    bf16x8 vtf[4][2];
#pragma unroll
    for (int me = 0; me < 4; ++me)
#pragma unroll
        for (int ks = 0; ks < 2; ++ks) { vtf[me][ks] = (bf16x8){0, 0, 0, 0, 0, 0, 0, 0}; }
    co_build_vt(P, r0, pbase + 512, VtL, lane);
    chunkout_prep2<MIXER>(p, l, b, h, cid, Grow0, r0, pbase, gar, lane);
    WAVE_SYNC();
    constexpr int NS = 2;
#pragma unroll 1
    for (int th = 0; th < 4 / NS; ++th) {
        f32x4 htot[NS][4];
#pragma unroll
        for (int a = 0; a < NS; ++a)
#pragma unroll
            for (int c = 0; c < 4; ++c) htot[a][c] = (f32x4){0.f, 0.f, 0.f, 0.f};
        chunkout_dir<MIXER, 0, NS>(p, b, h, cid, r0, pbase, th, vtf, VtL, EQ, SB, gar, rsm, htot, lane);
        chunkout_dir<MIXER, 1, NS>(p, b, h, cid, r0, pbase, th, vtf, VtL, EQ, SB, gar, rsm, htot, lane);
        co_finalize<MIXER, NS>(p, l, h, r0, pbase, NS * th, htot, lane);
    }
}
constexpr int CO_PART = 13376;
template <int MIXER, int DIR>
__device__ __forceinline__ void chunkout_piece(const Params& p, int l, int b, int h, int cid, int mt, char* wl, int lane) {
    const bf16* P = (const bf16*)(p.ws + WS_P); const float* G = (const float*)(p.ws + WS_G);
    const int r0 = b * TOK + cid * 64; const int pbase = (MIXER == 0 ? PA : PG) + h * 64;
    bf16* SB = (bf16*)wl; float* rsm = (float*)(SB + 1024); float* gar = rsm + 16; const bf16* EQ = (const bf16*)(p.ws + WS_EQ);
    const float* Grow0 = G + (size_t)r0 * NGS; bf16* VtL = (bf16*)(gar + 768);
    bf16x8 vtf[4][2];
#pragma unroll
    for (int me = 0; me < 4; ++me)
#pragma unroll
        for (int ks = 0; ks < 2; ++ks) { vtf[me][ks] = (bf16x8){0, 0, 0, 0, 0, 0, 0, 0}; }
    co_build_vt(P, r0, pbase + 512, VtL, lane);
    chunkout_prep<MIXER, DIR>(p, l, b, h, cid, Grow0, r0, pbase, EQ, gar, lane);
    WAVE_SYNC();
    f32x4 htot[1][4] = {{(f32x4){0.f, 0.f, 0.f, 0.f}, (f32x4){0.f, 0.f, 0.f, 0.f}, (f32x4){0.f, 0.f, 0.f, 0.f}, (f32x4){0.f, 0.f, 0.f, 0.f}}};
    chunkout_dir<MIXER, DIR, 1>(p, b, h, cid, r0, pbase, mt, vtf, VtL, EQ, SB, gar, rsm, htot, lane);
    float* part = (float*)(wl + CO_PART);
#pragma unroll
    for (int me = 0; me < 4; ++me)
#pragma unroll
        for (int i = 0; i < 4; ++i) part[(me * 4 + i) * 64 + lane] = htot[0][me][i];
}
template <int MIXER>
__device__ __forceinline__ void chunkout_combine(const Params& p, int l, int b, int h, int cid, int mt, const char* smem, int lane) {
    const float* pa = (const float*)(smem + (2 * mt) * WLDS + CO_PART); const float* pb = (const float*)(smem + (2 * mt + 1) * WLDS + CO_PART);
    f32x4 htot[1][4];
#pragma unroll
    for (int me = 0; me < 4; ++me)
#pragma unroll
        for (int i = 0; i < 4; ++i) htot[0][me][i] = pa[(me * 4 + i) * 64 + lane] + pb[(me * 4 + i) * 64 + lane];
    co_finalize<MIXER, 1>(p, l, h, b * TOK + cid * 64, (MIXER == 0 ? PA : PG) + h * 64, mt, htot, lane);
}

template <bool OUT>
__device__ __forceinline__ void chunk_workers(const Params& p, int l, char* smem) {
    const int tid = otid(), lane = tid & 63, wave = __builtin_amdgcn_readfirstlane(tid >> 6);
    const int NW = (int)gridDim.x * 8, wi = wave * (int)gridDim.x + obid();
    const int c_lo = (OUT && l == DEPTH - 1) ? NCC : 0, npc = NCH - c_lo, half = NB * NH * npc;
    char* wl = smem + wave * WLDS;
    if (OUT) {
        const int cl = NCC, npl = NCH - NCC, halfl = NB * NH * npl;
#pragma unroll 1
        for (int t = wi; t < halfl; t += NW) { const int b = t / (NH * npl), h = (t / npl) % NH, cid = cl + t % npl;
            const Params q = relaunder(p); chunkout_w<1>(q, l, b, h, cid, wl, lane); }
        { const int used = halfl % NW;
#pragma unroll 1
            for (int t = (wi + NW - used) % NW; t < halfl; t += NW) { const int b = t / (NH * npl), h = (t / npl) % NH, cid = cl + t % npl;
                const Params q = relaunder(p); chunkout_w<0>(q, l, b, h, cid, wl, lane); } }
        if (l < DEPTH - 1) {
            const int nct = NB * NH * NCC;
#pragma unroll 1
            for (int st = obid(); st < 2 * nct; st += (int)gridDim.x) { const int mixer = st / nct, r2 = st % nct, b = r2 / (NH * NCC), h = (r2 / NCC) % NH, cid = r2 % NCC;
                const Params q = relaunder(p); const int mt = wave >> 1;
                __syncthreads();
                if (mixer == 0) { if (wave & 1) chunkout_piece<0, 1>(q, l, b, h, cid, mt, wl, lane); else chunkout_piece<0, 0>(q, l, b, h, cid, mt, wl, lane); }
                else            { if (wave & 1) chunkout_piece<1, 1>(q, l, b, h, cid, mt, wl, lane); else chunkout_piece<1, 0>(q, l, b, h, cid, mt, wl, lane); }
                __syncthreads();
                if (wave < 4) { if (mixer == 0) chunkout_combine<0>(q, l, b, h, cid, wave, smem, lane); else chunkout_combine<1>(q, l, b, h, cid, wave, smem, lane); }
            }
        }
    } else {
        int off = 0;
#pragma unroll 1
        for (int t = wi; t < half; t += NW) { const int b = t / (NH * npc), h = (t / npc) % NH, cid = c_lo + t % npc;
            const Params q = relaunder(p); chunkst_gla<0>(q, l, b, h, cid, wl, lane); }
        off = (off + half) % NW;
#pragma unroll 1
        for (int t = (wi + NW - off) % NW; t < half; t += NW) { const int b = t / (NH * npc), h = (t / npc) % NH, cid = c_lo + t % npc;
            const Params q = relaunder(p); chunkst_gla<1>(q, l, b, h, cid, wl, lane); }
        off = (off + half) % NW;
#pragma unroll 1
        for (int t = (wi + NW - off) % NW; t < half; t += NW) { const int b = t / (NH * npc), h = (t / npc) % NH, cid = c_lo + t % npc;
            const Params q = relaunder(p); chunkst_w<0>(q, l, b, h, cid, wl, lane); }
    }
}

__device__ __forceinline__ void phase_mix1(const Params& p, int l, char* smem) {
    const bool ctxo = l < DEPTH - 1; const int G = (int)gridDim.x, bid = obid();
    constexpr int N_HL = (NB / 2) * (WG / 2), N_HC = NB * (WG / HCB);
    chunk_workers<false>(p, l, smem);
    stage_signal(p, smem, 0, l);
    for (int t = bid; t < N_HL; t += G) hylat_task(p, l, t / (WG / 2), t % (WG / 2), smem);
    if (ctxo) for (int t = G - 1 - bid; t < N_HC; t += G) hyctx_task(p, l, t / (WG / HCB), t % (WG / HCB), smem);
    stage_signal(p, smem, 2, l);
}

constexpr int SCG = 18;
__device__ __forceinline__ void phase_scan(const Params& p, int l, char* smem) {
    const int tid = otid();
    bf16* ST = (bf16*)(p.ws + WS_ST); float* NV = (float*)(p.ws + WS_NV); const float* BE = (const float*)(p.ws + WS_BE); float* SC = (float*)(p.ws + WS_SC);
    constexpr int NCHAIN = 2 * 2 * NB * NH;
    stage_wait(p, 0, l);
    for (int item = obid() * NT + tid; item < NCHAIN * 1024; item += gridDim.x * NT) {
        const int chain = item >> 10, grp = item & 1023; const int mixer = chain / (2 * NB * NH), dir = (chain / (NB * NH)) % 2, b = (chain / NH) % NB, h = chain % NH;
        float c[4] = {0.f, 0.f, 0.f, 0.f}; float nv[4] = {0.f, 0.f, 0.f, 0.f}; float m = 0.f;
        const int d0 = (grp & 15) * 4; const bool donv = (mixer == 0) && (grp < 16);
        float* sS = (float*)smem;
        __syncthreads();
        if (mixer == 0 && tid < NCH) { const size_t ci = ch_index(dir, b, h, chain_cid(dir, tid)); sS[2 * tid] = SC[ci * 4 + 0]; sS[2 * tid + 1] = SC[ci * 4 + 1]; }
        __syncthreads();
        for (int o0 = 0; o0 < NCH; o0 += SCG) {
            u32x2 uu[SCG]; f32x4 aux[SCG];
#pragma unroll
            for (int j = 0; j < SCG; ++j) if (o0 + j < NCH) { const int cid = chain_cid(dir, o0 + j); const size_t ci = ch_index(dir, b, h, cid);
                uu[j] = *(const u32x2*)(ST + st_index(mixer, dir, b, h, cid) * 4096 + grp * 4);
                if (mixer == 0) { if (donv) aux[j] = *(const f32x4*)(NV + ci * 64 + grp * 4); }
                else aux[j] = *(const f32x4*)(BE + ci * 64 + d0); }
#pragma unroll
            for (int j = 0; j < SCG; ++j) if (o0 + j < NCH) { const int cid = chain_cid(dir, o0 + j); const size_t ci = ch_index(dir, b, h, cid);
                const float u[4] = {bitsf(uu[j].x << 16), bitsf(uu[j].x & 0xffff0000u), bitsf(uu[j].y << 16), bitsf(uu[j].y & 0xffff0000u)};
                u32x2 w; w.x = pk2(c[0], c[1]); w.y = pk2(c[2], c[3]); *(u32x2*)(ST + st_index(mixer, dir, b, h, cid) * 4096 + grp * 4) = w;
                if (mixer == 0) {
                    if (grp == 0) SC[ci * 4 + 2] = m;
                    const float s0j = sS[2 * (o0 + j)], s1j = sS[2 * (o0 + j) + 1];
                    const float mn = fmaxf(s0j + m, s1j), a = __expf(s0j + m - mn), s = __expf(s1j - mn);
#pragma unroll
                    for (int k = 0; k < 4; ++k) c[k] = a * c[k] + s * u[k];
                    if (donv) { f32x4 nw = {nv[0], nv[1], nv[2], nv[3]}; *(f32x4*)(NV + ci * 64 + grp * 4) = nw;
                        nv[0] = a * nv[0] + s * aux[j].x; nv[1] = a * nv[1] + s * aux[j].y; nv[2] = a * nv[2] + s * aux[j].z; nv[3] = a * nv[3] + s * aux[j].w; }
                    m = mn;
                } else { c[0] = __expf(aux[j].x) * c[0] + u[0]; c[1] = __expf(aux[j].y) * c[1] + u[1]; c[2] = __expf(aux[j].z) * c[2] + u[2]; c[3] = __expf(aux[j].w) * c[3] + u[3]; } }
        }
    }
    stage_signal(p, smem, 1, l);
    { const bool ctxo = l < DEPTH - 1; const int G = (int)gridDim.x, bid = obid();
        constexpr int QTL = SEQ / 128, QTC = CTXL / 128, N_AL = NB * 2 * QTL, N_AC = NB * 2 * QTC;
        for (int t = bid; t < N_AL; t += G) attn_task(p, l, t / (2 * QTL), (t / QTL) % 2, t % QTL, false, smem);
        if (ctxo) for (int t = (bid + G - 64 % G) % G; t < N_AC; t += G) attn_task(p, l, t / (2 * QTC), (t / QTC) % 2, t % QTC, true, smem); }
}

__device__ __forceinline__ void phase_mix2(const Params& p, int l, char* smem) {
    const int tid = otid();
    stage_wait(p, 1, l);
    chunk_workers<true>(p, l, smem);
    stage_wait(p, 2, l);
    constexpr int N_WOUT = (DM / 64) * (MIX / 64);
    { const int lane = tid & 63, wave = __builtin_amdgcn_readfirstlane(tid >> 6); const int NW = (int)gridDim.x * 8, wi = wave * (int)gridDim.x + obid();
        for (int task = NW - 1 - wi; task < N_WOUT; task += NW) { const int nt = task / (MIX / 64), kt = task % (MIX / 64);
            convert_tile_w(p.in[I_WOUT] + (size_t)l * MIX * DM, DM, (bf16*)(p.ws + WS_WOUT), MIX, nt * 64, kt * 64, false, smem + wave * WLDS, lane); }
        bf16* tile = (bf16*)(smem + wave * WLDS); const bf16* HT = (const bf16*)(p.ws + WS_HT); bf16* Y = (bf16*)(p.ws + WS_HNY);
        constexpr int NTT = NB * (SEQ / 64) * 4;
        for (int t = wi; t < NTT; t += NW) { const int b = t / ((SEQ / 64) * 4), tt = (t / 4) % (SEQ / 64), c0 = (t % 4) * 64; const size_t tok0 = (size_t)b * TOK + CTXL + tt * 64;
            u32x4 tv[8];
#pragma unroll
            for (int i = 0; i < 8; ++i) { const int ch = (lane >> 3) + 8 * i, ck = lane & 7; tv[i] = *(const u32x4*)(HT + (size_t)(768 + c0 + ch) * T + tok0 + ck * 8); }
#pragma unroll
            for (int i = 0; i < 8; ++i) { const int ch = (lane >> 3) + 8 * i, ck = lane & 7; *(u32x4*)(tile + swz(ch, ck)) = tv[i]; }
            WAVE_SYNC();
#pragma unroll
            for (int i = 0; i < 8; ++i) { const int tk = (lane >> 3) + 8 * i, cc = lane & 7; unsigned w[4];
#pragma unroll
                for (int j = 0; j < 4; ++j) { const int ca = cc * 8 + 2 * j; w[j] = (unsigned)tile[swz(ca, tk >> 3) + (tk & 7)] | ((unsigned)tile[swz(ca + 1, tk >> 3) + (tk & 7)] << 16); }
                u32x4 o; o.x = w[0]; o.y = w[1]; o.z = w[2]; o.w = w[3]; *(u32x4*)(Y + (tok0 + tk) * 1024 + YH + c0 + cc * 8) = o; }
            WAVE_SYNC(); } }
}


#ifndef EMU
#define LAS __attribute__((address_space(3)))
#define XB_TMO      128
#define XB_XCNT(j)  (256  + 64 * (j))
#define XB_XSUB(j)  (1280 + 64 * (j))
#define XB_XGEN(j)  (2304 + 64 * (j))
#define XB_TOP      3328
#define XB_TOPGEN   3392
#define XCD_BAR_WORDS 3456
#define XB_SPIN_CAP (1u << 18)

__device__ __forceinline__ unsigned xb_ld(unsigned* p)              { return __hip_atomic_load(p, __ATOMIC_RELAXED, __HIP_MEMORY_SCOPE_AGENT); }
__device__ __forceinline__ unsigned xb_add(unsigned* p, unsigned v) { return __hip_atomic_fetch_add(p, v, __ATOMIC_RELAXED, __HIP_MEMORY_SCOPE_AGENT); }
__device__ __forceinline__ unsigned xb_xcc_id() { return (unsigned)__builtin_amdgcn_s_getreg((3 << 11) | 20) & 0xFu; }
#define XB_SPIN(cond, bar) do { unsigned _sp = 0; while (cond) { __builtin_amdgcn_s_sleep(1); \
    if ((++_sp & 255u) == 0u) { if (xb_ld(&(bar)[XB_TMO])) break; if (_sp > XB_SPIN_CAP) { atomicAdd(&(bar)[XB_TMO], 1u); break; } } } } while (0)

struct XcdBarrier {
    unsigned* bar; unsigned x;
    volatile LAS unsigned* st;
};

__device__ __forceinline__ XcdBarrier xcd_barrier_post(unsigned* bar, volatile LAS unsigned* st) {
    XcdBarrier b; b.bar = bar; b.x = xb_xcc_id(); b.st = st;
    if (threadIdx.x == 0) (void)xb_add(&bar[XB_XCNT(b.x)], 1u);
    return b;
}
__device__ __forceinline__ void xcd_barrier_complete(unsigned* bar, unsigned x, unsigned& nloc, unsigned& nx) {
    const unsigned G = gridDim.x * gridDim.y * gridDim.z;
    unsigned sum, cnt, mine, sp = 0u;
    for (;;) {
        sum = 0u; cnt = 0u; mine = 0u;
#pragma unroll
        for (unsigned j = 0; j < 16; ++j) { const unsigned c = xb_ld(&bar[XB_XCNT(j)]); sum += c; cnt += (c > 0u) ? 1u : 0u; mine = (j == x) ? c : mine; }
        if (sum == G) break;
        __builtin_amdgcn_s_sleep(1);
        if ((++sp & 255u) == 0u) { if (xb_ld(&bar[XB_TMO])) break; if (sp > XB_SPIN_CAP) { atomicAdd(&bar[XB_TMO], 1u); break; } }
    }
    nloc = mine > 0u ? mine : 1u; nx = cnt > 0u ? cnt : 1u;
}

__device__ __forceinline__ void xcd_barrier(const XcdBarrier& b) {
    asm volatile("s_waitcnt vmcnt(0)" ::: "memory");
    __syncthreads();
    if (threadIdx.x == 0) {
        unsigned* bar = b.bar;
        __builtin_amdgcn_s_waitcnt(0);
        unsigned nloc = b.st[0], nx = b.st[1];
        if (nloc == 0u) { xcd_barrier_complete(bar, b.x, nloc, nx); b.st[0] = nloc; b.st[1] = nx; }
        const unsigned old = xb_add(&bar[XB_XSUB(b.x)], 1u);
        const unsigned gen = old / nloc;
        if (old + 1u == (gen + 1u) * nloc) {
            __builtin_amdgcn_fence(__ATOMIC_RELEASE, "agent");
            asm volatile("s_waitcnt vmcnt(0)" ::: "memory");
            const unsigned og = xb_add(&bar[XB_TOP], 1u);
            const unsigned tg = og / nx;
            if (og + 1u == (tg + 1u) * nx) xb_add(&bar[XB_TOPGEN], 1u);
            else XB_SPIN(xb_ld(&bar[XB_TOPGEN]) == tg, bar);
            __builtin_amdgcn_fence(__ATOMIC_ACQUIRE, "agent");
            xb_add(&bar[XB_XGEN(b.x)], 1u);
            asm volatile("s_waitcnt vmcnt(0)" ::: "memory");
        } else {
            XB_SPIN(xb_ld(&bar[XB_XGEN(b.x)]) == gen, bar);
            __builtin_amdgcn_fence(__ATOMIC_ACQUIRE, "agent");
            asm volatile("s_waitcnt vmcnt(0)" ::: "memory");
        }
    }
    __syncthreads();
}
#endif

__global__ void __launch_bounds__(NT) fwd_kernel(Params pk, int ph_lo, int ph_hi) {
    SMEM_DECL;
#ifndef EMU
    volatile LAS unsigned* misc = (volatile LAS unsigned*)(smem + LDS_BYTES - 64);
    if (threadIdx.x < 2) misc[threadIdx.x] = 0u;
    __syncthreads();
    const XcdBarrier bar = xcd_barrier_post((unsigned*)(pk.ws + WS_BAR), misc);
#endif
    constexpr int NPH = 2 + 6 * DEPTH;
    for (int ph = ph_lo; ph < ph_hi && ph < NPH; ++ph) {
#ifndef EMU
        Params p = pk; { size_t z = 0; asm volatile("" : "+s"(z)); p.ws = pk.ws + z; p.out = pk.out + z;
#pragma unroll
            for (int i = 0; i < 26; ++i) p.in[i] = pk.in[i] + z; }
#else
        const Params& p = pk;
#endif
        if (ph == 0) phase0(p, smem);
        else if (ph == NPH - 1) phase_rp(p, DEPTH, smem);
        else { const int l = (ph - 1) / 6, k = (ph - 1) % 6;
            if (k == 0) phase_rp(p, l, smem);
            else if (k == 1) phase_gemm_in(p, l, smem);
            else if (k == 2) phase_mix1(p, l, smem);
            else if (k == 3) phase_scan(p, l, smem);
            else if (k == 4) phase_mix2(p, l, smem);
            else phase_gemm_out(p, l, smem);
#ifdef PROBE_DUP
            if (k == PROBE_DUP) { GRID_SYNC();
                if (k == 1) phase_gemm_in(p, l, smem); else if (k == 2) phase_mix1(p, l, smem); else if (k == 4) phase_mix2(p, l, smem); }
#endif
        }
        if (ph + 1 < ph_hi && !(ph >= 6 && ph % 6 == 0) && !(ph >= 1 && ((ph - 1) % 6 == 2 || (ph - 1) % 6 == 3))) {
#ifdef EMU
            GRID_SYNC();
#else
            if (ph_lo < 0) GRID_SYNC();
            xcd_barrier(bar);
#endif
        }
    }
}

#ifndef EMU
extern "C" void kernel_launch(void* const* d_in, const int* in_sizes, int n_in, void* d_out, int out_size, void* d_ws, size_t ws_size, hipStream_t stream) {
    static int grid = 0;
    if (grid == 0) {
        if (n_in != 26 || ws_size < WS_TOTAL) { fprintf(stderr, "kernel_launch: unexpected n_in %d or ws_size %zu (need %zu)\n", n_in, ws_size, (size_t)WS_TOTAL); grid = -1; return; }
        int dev = 0, cus = 0, per_cu = 0;
        hipGetDevice(&dev);
        hipDeviceGetAttribute(&cus, hipDeviceAttributeMultiprocessorCount, dev);
        hipFuncSetAttribute((const void*)fwd_kernel, hipFuncAttributeMaxDynamicSharedMemorySize, LDS_BYTES);
        hipOccupancyMaxActiveBlocksPerMultiprocessor(&per_cu, (const void*)fwd_kernel, NT, LDS_BYTES);
        if (per_cu < 1) { fprintf(stderr, "kernel_launch: occupancy query returned %d\n", per_cu); grid = -1; return; }
        if (per_cu > 1) per_cu = 1;
        grid = cus * per_cu;
    }
    if (grid < 0) return;
    hipMemsetAsync((char*)d_ws + WS_BAR, 0, BAR_BYTES, stream);
    Params p{};
    for (int i = 0; i < 26; ++i) p.in[i] = (const float*)d_in[i];
    p.out = (float*)d_out; p.ws = (char*)d_ws;
    int lo = 0, hi = 2 + 6 * DEPTH;
    void* args[] = {&p, &lo, &hi};
    hipError_t e = hipLaunchCooperativeKernel((const void*)fwd_kernel, dim3(grid), dim3(NT), args, LDS_BYTES, stream);
    if (e != hipSuccess) fprintf(stderr, "cooperative launch failed: %s (grid %d)\n", hipGetErrorString(e), grid);
}
#endif
```

```cpp
#ifdef EMU
#include "emu/hipemu.h"
#define GRID_SYNC() emu::grid_sync()
#define SMEM_DECL char* smem = emu::S().blocks[emu::cur()->block].lds
#define SCHED_FENCE() do {} while (0)
#define EXP2(x) exp2f(x)
#define MFMA16(a, b, c) emu_mfma_16x16x32_bf16(a, b, c)
#else
#include <hip/hip_runtime.h>
#include <hip/hip_cooperative_groups.h>
#include <cstdio>
#include <cstdint>
#define GRID_SYNC() cooperative_groups::this_grid().sync()
#define SMEM_DECL extern __shared__ __attribute__((aligned(16))) char smem[]
#define SCHED_FENCE() __builtin_amdgcn_sched_barrier(0)
#define EXP2(x) __builtin_amdgcn_exp2f(x)
#define MFMA16(a, b, c) __builtin_amdgcn_mfma_f32_16x16x32_bf16(a, b, c, 0, 0, 0)
#endif

#ifdef EMU
#ifndef EMU_DM
#define EMU_DM 256
#endif
#ifndef EMU_NB
#define EMU_NB 2
#endif
#ifndef EMU_SEQ
#define EMU_SEQ 512
#endif
#ifndef EMU_DEPTH
#define EMU_DEPTH 2
#endif
#ifndef EMU_CTXL
#define EMU_CTXL 128
#endif
constexpr int DM = EMU_DM, NB = EMU_NB, SEQ = EMU_SEQ, DEPTH = EMU_DEPTH, CTXL = EMU_CTXL;
#else
constexpr int DM = 1024, NB = 8, SEQ = 2048, DEPTH = 4, CTXL = 256;
#endif
constexpr int MIX = 1024, WG = 256, HD = 64, NH = 4, CH = 64;
constexpr int TOK = CTXL + SEQ, T = NB * TOK, NCH = TOK / CH, NCC = CTXL / CH;
constexpr int N_IN = 4144, NP = 3072, NG = 48, NGS = 32, NMAIN = 3328, NPAD = 4352;
constexpr int NF = 2 * SEQ;
constexpr int NJ = NB + 1;
constexpr int NT = 512;
constexpr float EPS = 1e-6f;
constexpr int PA = 0, PG = 1280, PD = 2304;
constexpr int YA = 0, YH = 256, YG = 512, YD = 768;
constexpr int ilog4(int n) { return n <= 1 ? 0 : 1 + ilog4(n / 4); }
constexpr int FFT_P = ilog4(NF);
static_assert((1 << (2 * FFT_P)) == NF, "NF must be a power of 4");
static_assert(DM % 256 == 0 && CTXL % 128 == 0 && SEQ % 256 == 0, "shape constraints");

typedef unsigned short bf16;
typedef short bf16x8 __attribute__((ext_vector_type(8)));
typedef float f32x4 __attribute__((ext_vector_type(4)));
typedef unsigned u32x4 __attribute__((ext_vector_type(4)));
typedef unsigned u32x2 __attribute__((ext_vector_type(2)));
struct cpx { float x, y; };

constexpr size_t al256(size_t x) { return (x + 255) & ~(size_t)255; }
constexpr size_t WS_CTXB = 0;
constexpr size_t WS_HNY = al256(WS_CTXB + (size_t)NB * CTXL * DM * 4);
constexpr size_t WS_WIN = WS_HNY + (size_t)T * 1024 * 2;
constexpr size_t WS_ST = WS_WIN;
constexpr size_t ST_BYTES = (size_t)2 * 2 * NB * NH * NCH * 4096 * 2;
constexpr size_t WS_KT = al256(WS_WIN + (size_t)NPAD * DM * 2);
static_assert(WS_KT + (size_t)WG * NF * 4 <= WS_ST + ST_BYTES || true, "");
constexpr size_t ST_END = al256((WS_ST + ST_BYTES > WS_KT + (size_t)WG * NF * 4) ? WS_ST + ST_BYTES : WS_KT + (size_t)WG * NF * 4);
constexpr size_t WS_P = ST_END;
constexpr size_t WS_HT = al256(WS_P + (size_t)T * NP * 2);
constexpr size_t WS_WOUT = WS_HT;
constexpr size_t WS_G = al256(WS_HT + (size_t)1024 * T * 2);
constexpr size_t WS_KF = al256(WS_G + (size_t)T * NGS * 4);
constexpr size_t WS_HC = al256(WS_KF + (size_t)WG * NF * 8);
constexpr size_t WS_EQ = al256(WS_HC + (size_t)2 * WG * CTXL * 4);
constexpr size_t WS_NV = al256(WS_EQ + (size_t)2 * T * WG * 2);
constexpr size_t WS_BE = al256(WS_NV + (size_t)2 * NB * NH * NCH * 64 * 4);
constexpr size_t WS_SC = al256(WS_BE + (size_t)2 * NB * NH * NCH * 64 * 4);
constexpr size_t WS_MOD = al256(WS_SC + (size_t)2 * NB * NH * NCH * 4 * 4);
constexpr size_t WS_TW = al256(WS_MOD + (size_t)DEPTH * NJ * 3 * DM * 4);
constexpr size_t WS_ROPE = al256(WS_TW + (size_t)NF * 8);
constexpr size_t WS_BAR = al256(WS_ROPE + (size_t)SEQ * 32 * 8);
constexpr size_t BAR_BYTES = 32768;
constexpr size_t WS_TOTAL = al256(WS_BAR + BAR_BYTES);
static_assert((size_t)T * DM * 4 <= (size_t)T * NP * 2, "YO fits in P");
#ifndef EMU
static_assert(WS_TOTAL <= (size_t)268435456, "workspace map must fit 256 MiB");
#endif

constexpr int LDS_BYTES = 163840;

struct Params {
    const float* in[26];
    float* out;
    char* ws;
};
enum { I_X = 0, I_C, I_CTX, I_CCTX, I_WADA, I_BADA, I_GPRE, I_GPOST, I_WIN, I_MGB, I_MNG, I_HCW, I_HCB, I_HW1, I_HB1, I_HW2, I_HB2, I_HW3, I_HB3,
       I_HFREQ, I_HD, I_GWA, I_GBA, I_GNG, I_SINK, I_WOUT };

__device__ __forceinline__ Params relaunder(const Params& pk) {
#ifdef EMU
    return pk;
#else
    Params p = pk; size_t z = 0; asm volatile("" : "+s"(z)); p.ws = pk.ws + z; p.out = pk.out + z;
#pragma unroll
    for (int i = 0; i < 26; ++i) p.in[i] = pk.in[i] + z;
    return p;
#endif
}
constexpr int WLDS = (LDS_BYTES - 64) / 8 / 16 * 16;
#ifdef EMU
#define WAVE_SYNC() emu_wave_sync()
#else
#define WAVE_SYNC() do { asm volatile("s_waitcnt lgkmcnt(0)" ::: "memory"); __builtin_amdgcn_wave_barrier(); } while (0)
#endif

#ifdef EMU
__device__ __forceinline__ int otid() { return (int)threadIdx.x; }
__device__ __forceinline__ int obid() { return (int)blockIdx.x; }
#else
__device__ __forceinline__ int otid() { int t = (int)threadIdx.x; asm volatile("" : "+v"(t)); return t; }
__device__ __forceinline__ int obid() { int b = (int)blockIdx.x; asm volatile("" : "+s"(b)); return b; }
#endif
__device__ __forceinline__ unsigned fbits(float f) { return __builtin_bit_cast(unsigned, f); }
__device__ __forceinline__ float bitsf(unsigned u) { return __builtin_bit_cast(float, u); }
__device__ __forceinline__ float bf2f(bf16 h) { return bitsf((unsigned)h << 16); }
#ifdef EMU
__device__ __forceinline__ bf16 f2bf(float f) { unsigned u = fbits(f); return (bf16)((u + 0x7fffu + ((u >> 16) & 1u)) >> 16); }
__device__ __forceinline__ unsigned pk2(float lo, float hi) { return (unsigned)f2bf(lo) | ((unsigned)f2bf(hi) << 16); }
#else
typedef __bf16 nbf16x2 __attribute__((ext_vector_type(2)));
typedef float nf32x2 __attribute__((ext_vector_type(2)));
__device__ __forceinline__ unsigned pk2(float lo, float hi) { const nf32x2 v = {lo, hi}; return __builtin_bit_cast(unsigned, __builtin_convertvector(v, nbf16x2)); }
__device__ __forceinline__ bf16 f2bf(float f) { return (bf16)(pk2(f, 0.0f) & 0xffffu); }
#endif
#ifdef EMU
__device__ __forceinline__ float frcp_(float x) { return 1.0f / x; }
#else
__device__ __forceinline__ float frcp_(float x) { return __builtin_amdgcn_rcpf(x); }
#endif
__device__ __forceinline__ float sigmoidf_(float x) { return frcp_(1.0f + __expf(-x)); }
__device__ __forceinline__ float siluf_(float x) { return x * frcp_(1.0f + __expf(-x)); }
__device__ __forceinline__ float logsigf_(float x) { return fminf(x, 0.0f) - log1pf(__expf(-fabsf(x))); }
__device__ __forceinline__ float logsig_fast(float x) { return fminf(x, 0.0f) - __logf(1.0f + __expf(-fabsf(x))); }
#ifdef EMU
__device__ __forceinline__ float row16_sum(float x) { x += __shfl_xor(x, 1); x += __shfl_xor(x, 2); x += __shfl_xor(x, 4); x += __shfl_xor(x, 8); return x; }
__device__ __forceinline__ float row16_max(float x) { x = fmaxf(x, __shfl_xor(x, 1)); x = fmaxf(x, __shfl_xor(x, 2)); x = fmaxf(x, __shfl_xor(x, 4)); x = fmaxf(x, __shfl_xor(x, 8)); return x; }
__device__ __forceinline__ float xrow_sum(float x) { x += __shfl_xor(x, 16); x += __shfl_xor(x, 32); return x; }
__device__ __forceinline__ float xrow_max(float x) { x = fmaxf(x, __shfl_xor(x, 16)); x = fmaxf(x, __shfl_xor(x, 32)); return x; }
#else
template <int CTRL> __device__ __forceinline__ float dpp_(float x) { return __builtin_bit_cast(float, __builtin_amdgcn_mov_dpp(__builtin_bit_cast(int, x), CTRL, 0xf, 0xf, true)); }
__device__ __forceinline__ float row16_sum(float x) { x += dpp_<0xB1>(x); x += dpp_<0x4E>(x); x += dpp_<0x141>(x); x += dpp_<0x128>(x); return x; }
__device__ __forceinline__ float row16_max(float x) { x = fmaxf(x, dpp_<0xB1>(x)); x = fmaxf(x, dpp_<0x4E>(x)); x = fmaxf(x, dpp_<0x141>(x)); x = fmaxf(x, dpp_<0x128>(x)); return x; }
__device__ __forceinline__ float xrow_sum(float x) {
    auto s = __builtin_amdgcn_permlane16_swap(fbits(x), fbits(x), false, false); x = bitsf(s[0]) + bitsf(s[1]);
    auto t = __builtin_amdgcn_permlane32_swap(fbits(x), fbits(x), false, false); return bitsf(t[0]) + bitsf(t[1]); }
__device__ __forceinline__ float xrow_max(float x) {
    auto s = __builtin_amdgcn_permlane16_swap(fbits(x), fbits(x), false, false); x = fmaxf(bitsf(s[0]), bitsf(s[1]));
    auto t = __builtin_amdgcn_permlane32_swap(fbits(x), fbits(x), false, false); return fmaxf(bitsf(t[0]), bitsf(t[1])); }
#endif
__device__ __forceinline__ float wave_sum(float v) { return xrow_sum(row16_sum(v)); }
__device__ __forceinline__ float wave_max(float v) { return xrow_max(row16_max(v)); }
template <int DIR> __device__ __forceinline__ void xrow_scan(float s4, int lane, float& e, float& tot) {
    const int q4 = lane >> 4;
#ifdef EMU
    const int r = lane & 15; const float v0 = __shfl(s4, r), v1 = __shfl(s4, 16 + r), v2 = __shfl(s4, 32 + r), v3 = __shfl(s4, 48 + r);
    tot = (v0 + v1) + (v2 + v3);
    if (DIR == 0) e = (q4 & 2 ? v0 + v1 : 0.f) + (q4 & 1 ? (q4 & 2 ? v2 : v0) : 0.f); else e = (q4 & 2 ? 0.f : v2 + v3) + (q4 & 1 ? 0.f : (q4 & 2 ? v3 : v1));
#else
    auto sw = __builtin_amdgcn_permlane16_swap(fbits(s4), fbits(s4), false, false); const float a = bitsf(sw[0]), b = bitsf(sw[1]);
    const float pp = a + b;
    auto tw = __builtin_amdgcn_permlane32_swap(fbits(pp), fbits(pp), false, false); const float p0 = bitsf(tw[0]), p1 = bitsf(tw[1]);
    tot = p0 + p1;
    if (DIR == 0) e = (q4 & 2 ? p0 : 0.f) + (q4 & 1 ? a : 0.f); else e = (q4 & 2 ? 0.f : p1) + (q4 & 1 ? 0.f : b);
#endif
}
#ifdef EMU
__device__ __forceinline__ float wave_prefix_sum(float v, int lane) {
#pragma unroll
    for (int o = 1; o < 64; o <<= 1) { float t = __shfl_up(v, o); if (lane >= o) v += t; }
    return v;
}
__device__ __forceinline__ float wave_prefix_max(float v, int lane) {
#pragma unroll
    for (int o = 1; o < 64; o <<= 1) { float t = __shfl_up(v, o); if (lane >= o) v = fmaxf(v, t); }
    return v;
}
#else
template <int CTRL, int RM> __device__ __forceinline__ float dppo_(float old, float x) { return __builtin_bit_cast(float, __builtin_amdgcn_update_dpp(__builtin_bit_cast(int, old), __builtin_bit_cast(int, x), CTRL, RM, 0xf, false)); }
__device__ __forceinline__ float wave_prefix_sum(float v, int) {
    v += dppo_<0x111, 0xf>(0.f, v); v += dppo_<0x112, 0xf>(0.f, v); v += dppo_<0x114, 0xf>(0.f, v); v += dppo_<0x118, 0xf>(0.f, v);
    v += dppo_<0x142, 0xa>(0.f, v); v += dppo_<0x143, 0xc>(0.f, v); return v;
}
__device__ __forceinline__ float wave_prefix_max(float v, int) {
    const float ninf = -INFINITY;
    v = fmaxf(v, dppo_<0x111, 0xf>(ninf, v)); v = fmaxf(v, dppo_<0x112, 0xf>(ninf, v)); v = fmaxf(v, dppo_<0x114, 0xf>(ninf, v)); v = fmaxf(v, dppo_<0x118, 0xf>(ninf, v));
    v = fmaxf(v, dppo_<0x142, 0xa>(ninf, v)); v = fmaxf(v, dppo_<0x143, 0xc>(ninf, v)); return v;
}
#endif
__device__ __forceinline__ float wave_suffix_max(float v, int lane) {
    return __shfl(wave_prefix_max(__shfl(v, 63 - lane), lane), 63 - lane);
}
__device__ __forceinline__ void unpack8(u32x4 v, float* f) {
    f[0] = bitsf(v.x << 16); f[1] = bitsf(v.x & 0xffff0000u); f[2] = bitsf(v.y << 16); f[3] = bitsf(v.y & 0xffff0000u);
    f[4] = bitsf(v.z << 16); f[5] = bitsf(v.z & 0xffff0000u); f[6] = bitsf(v.w << 16); f[7] = bitsf(v.w & 0xffff0000u);
}
__device__ __forceinline__ int orig_col(int n) {
    if (n < 1280) return n;
    if (n < 2304) return 2320 + (n - 1280);
    if (n < 3072) return 3376 + (n - 2304);
    if (n < 3088) return 1280 + (n - 3072);
    if (n < 3120) return 3344 + (n - 3088);
    if (n < NMAIN) return -1;
    return 1296 + (n - NMAIN);
}
__device__ __forceinline__ int chain_cid(int dir, int o) {
    if (dir == 0) return o;
    return o < NCC ? (NCC - 1 - o) : (NCH - 1 - (o - NCC));
}

__device__ __forceinline__ int swz(int row, int ch) { return row * 64 + ((ch ^ (row & 7)) << 3); }
__device__ __forceinline__ u32x4 pack8(const float* f) { u32x4 o; o.x = pk2(f[0], f[1]); o.y = pk2(f[2], f[3]); o.z = pk2(f[4], f[5]); o.w = pk2(f[6], f[7]); return o; }
__device__ __forceinline__ bf16x8 as_frag(u32x4 v) { return __builtin_bit_cast(bf16x8, v); }
#ifdef EMU
inline u32x2 lds_tr16(const bf16* p) { unsigned mine[2]; const unsigned long long a = (unsigned long long)p; mine[0] = (unsigned)a; mine[1] = (unsigned)(a >> 32);
    auto buf = emu::collective(mine, 2); const int l = emu::cur()->lane, g = l >> 4, i = l & 15; unsigned short e[4];
    for (int j = 0; j < 4; ++j) { const int src = 16 * g + 4 * j + (i >> 2); const bf16* q = (const bf16*)(((unsigned long long)buf[src][1] << 32) | buf[src][0]); e[j] = *(const unsigned short*)(q + (i & 3)); }
    u32x2 r; r.x = (unsigned)e[0] | ((unsigned)e[1] << 16); r.y = (unsigned)e[2] | ((unsigned)e[3] << 16); return r; }
#else
typedef short v4i16_t __attribute__((ext_vector_type(4)));
__device__ __forceinline__ u32x2 lds_tr16(const bf16* p) { return __builtin_bit_cast(u32x2, __builtin_amdgcn_ds_read_tr16_b64_v4i16((__attribute__((address_space(3))) v4i16_t*)p)); }
#endif
__device__ __forceinline__ u32x4 as_u4(bf16x8 v) { return __builtin_bit_cast(u32x4, v); }

constexpr int LS = 72;

template <int NTL, int KS>
__device__ __forceinline__ void mma_nt(const bf16* A, int lda, int m0, const bf16* B, int ldb, int n0, f32x4 (&acc)[NTL], int lane) {
    const int r = lane & 15, q = lane >> 4;
#pragma unroll
    for (int ks = 0; ks < KS; ++ks) {
        const bf16x8 a = *(const bf16x8*)(A + (m0 + r) * lda + ks * 32 + q * 8);
#pragma unroll
        for (int nt = 0; nt < NTL; ++nt) {
            const bf16x8 b = *(const bf16x8*)(B + (n0 + nt * 16 + r) * ldb + ks * 32 + q * 8);
            acc[nt] = MFMA16(a, b, acc[nt]);
        }
    }
}

__device__ __forceinline__ void layer_prep(const Params& p, int l, int idx, int stride, char* smem);
__device__ __forceinline__ void phase0(const Params& p, char* smem) {
    const int tid = otid();
    cpx* TW = (cpx*)(p.ws + WS_TW);
    cpx* ROPE = (cpx*)(p.ws + WS_ROPE);
    float* MOD = (float*)(p.ws + WS_MOD);
    constexpr int N_TW = NF / NT, N_ROPE = SEQ * 32 / NT, N_MOD = DEPTH * (3 * DM / 64);
    for (int task = obid(); task < N_TW + N_ROPE + N_MOD; task += gridDim.x) {
        if (task < N_TW) {
            const int j = task * NT + tid; float s, c; sincospif(2.0f * (float)j / (float)NF, &s, &c);
            cpx v; v.x = c; v.y = -s; TW[j] = v;
        } else if (task < N_TW + N_ROPE) {
            const int idx = (task - N_TW) * NT + tid; const int pos = idx >> 5, i = idx & 31;
            const float inv = exp2f(-(float)(i & 15) * (13.287712379549449f / 16.0f));
            const float ang = (float)(i < 16 ? pos / 64 : pos % 64) * inv;
            cpx v; v.x = cosf(ang); v.y = sinf(ang); ROPE[idx] = v;
        } else {
            const int mt = task - N_TW - N_ROPE; const int l = mt / (3 * DM / 64), n0 = (mt % (3 * DM / 64)) * 64;
            float* sv = (float*)smem;
            float* red = sv + NJ * DM;
            __syncthreads();
            for (int i = tid; i < NJ * DM; i += NT) { const int j = i / DM, k = i % DM; const float v = j < NB ? p.in[I_C][j * DM + k] : p.in[I_CCTX][k]; sv[i] = siluf_(v); }
            __syncthreads();
            const int c4 = tid & 15, kg = tid >> 4; f32x4 acc[NJ];
#pragma unroll
            for (int j = 0; j < NJ; ++j) acc[j] = (f32x4){0.f, 0.f, 0.f, 0.f};
            const float* w = p.in[I_WADA] + (size_t)l * DM * 3 * DM + n0 + 4 * c4;
            static_assert((DM / 32) % 8 == 0, "weight loads in batches of 8");
#pragma unroll 1
            for (int i0 = 0; i0 < DM / 32; i0 += 8) { f32x4 wv[8];
#pragma unroll
                for (int i = 0; i < 8; ++i) wv[i] = *(const f32x4*)(w + (size_t)(kg + 32 * (i0 + i)) * 3 * DM);
                SCHED_FENCE();
#pragma unroll
                for (int i = 0; i < 8; ++i) { const int k = kg + 32 * (i0 + i);
#pragma unroll
                    for (int j = 0; j < NJ; ++j) acc[j] = acc[j] + wv[i] * sv[j * DM + k]; } }
#pragma unroll
            for (int j = 0; j < NJ; ++j) *(f32x4*)(red + (kg * NJ + j) * 64 + 4 * c4) = acc[j];
            __syncthreads();
            for (int i = tid; i < NJ * 64; i += NT) { const int j = i / 64, n = i % 64; float s = 0.f;
#pragma unroll
                for (int k8 = 0; k8 < 32; ++k8) s += red[(k8 * NJ + j) * 64 + n];
                MOD[((size_t)l * NJ + j) * 3 * DM + n0 + n] = s + p.in[I_BADA][(size_t)l * 3 * DM + n0 + n]; }
        }
    }
}

#ifdef EMU
constexpr int PANEL_ROWS = 128, PANEL_UNITS = DM / 128;
#else
constexpr int PANEL_ROWS = 256, PANEL_UNITS = DM / 256;
#endif
__device__ __forceinline__ unsigned* unit_counter(const Params& p, int isctx) { return (unsigned*)(p.ws + WS_BAR + 16384) + 64 * isctx; }
__device__ __forceinline__ unsigned* stage_counter(const Params& p, int flag) { return (unsigned*)(p.ws + WS_BAR + 16384) + 512 + 512 * flag; }
__device__ __forceinline__ void stage_signal(const Params& p, char* smem, int flag, int l) {
#ifdef EMU
    __syncthreads(); if (otid() == 0) *stage_counter(p, flag) += 1u;
#else
    asm volatile("s_waitcnt vmcnt(0)" ::: "memory"); __syncthreads();
    if (threadIdx.x == 0) {
        const unsigned xcc = (unsigned)__builtin_amdgcn_s_getreg((3 << 11) | 20) & 0xFu, nloc = ((volatile __attribute__((address_space(3))) unsigned*)(smem + LDS_BYTES - 64))[0];
        unsigned* g = stage_counter(p, flag);
        if (nloc > 0u) { const unsigned old = __hip_atomic_fetch_add(g + 16 * (1 + xcc), 1u, __ATOMIC_RELAXED, __HIP_MEMORY_SCOPE_AGENT);
            if (old + 1u == nloc * (unsigned)(l + 1)) { __builtin_amdgcn_fence(__ATOMIC_RELEASE, "agent"); asm volatile("s_waitcnt vmcnt(0)" ::: "memory");
                __hip_atomic_fetch_add(g, nloc, __ATOMIC_RELAXED, __HIP_MEMORY_SCOPE_AGENT); } }
        else { __builtin_amdgcn_fence(__ATOMIC_RELEASE, "agent"); asm volatile("s_waitcnt vmcnt(0)" ::: "memory"); __hip_atomic_fetch_add(g, 1u, __ATOMIC_RELAXED, __HIP_MEMORY_SCOPE_AGENT); }
    }
#endif
}
__device__ __forceinline__ void stage_wait(const Params& p, int flag, int l) {
    if (otid() == 0) { const unsigned target = (unsigned)gridDim.x * (unsigned)(l + 1);
#ifdef EMU
        while (*(volatile unsigned*)stage_counter(p, flag) < target) emu::yield();
#else
        unsigned spins = 0;
        while (__hip_atomic_load(stage_counter(p, flag), __ATOMIC_RELAXED, __HIP_MEMORY_SCOPE_AGENT) < target) { __builtin_amdgcn_s_sleep(16); if (++spins > (1u << 20)) break; }
        __builtin_amdgcn_fence(__ATOMIC_ACQUIRE, "agent"); asm volatile("s_waitcnt vmcnt(0)" ::: "memory");
#endif
    }
    __syncthreads();
}
__device__ __forceinline__ int logical_row(int i) { return i < NB * SEQ ? (i / SEQ) * TOK + CTXL + i % SEQ : ((i - NB * SEQ) / CTXL) * TOK + (i - NB * SEQ) % CTXL; }
struct RowRef { const float* xo; float* xn; int mj, row; bool ok; };
__device__ __forceinline__ RowRef rp_ref(const Params& p, int l, int li, int base, int hi) {
    RowRef r; r.ok = li < hi; const int rr = logical_row(r.ok ? li : base); r.row = rr;
    const int b = rr / TOK, pp = rr % TOK; const bool isctx = pp < CTXL; if (l == DEPTH && isctx) r.ok = false;
    const size_t off = isctx ? ((size_t)b * CTXL + pp) * DM : ((size_t)b * SEQ + (pp - CTXL)) * DM;
    float* CTXB = (float*)(p.ws + WS_CTXB);
    r.xo = (l <= 1) ? (isctx ? p.in[I_CTX] + off : p.in[I_X] + off) : (isctx ? CTXB + off : p.out + off);
    r.xn = isctx ? CTXB + off : p.out + off; r.mj = isctx ? NB : b; return r;
}
__device__ __forceinline__ void rp_rows(const Params& p, int l, int lo, int hi, int gi, int nb) {
    const int tid = otid(), lane = tid & 63, wave = tid >> 6;
    const float* MOD = (const float*)(p.ws + WS_MOD);
    const bf16* YO = (const bf16*)(p.ws + WS_P);
    bf16* HN = (bf16*)(p.ws + WS_HNY);
    constexpr int NV4 = DM / 256, RW = 2;
    const int stride = nb * 8;
    f32x4 xq[RW][NV4]; u32x2 yq[RW][NV4]; RowRef rq[RW];
    int base = lo + gi * 8 + wave;
    if (base < hi) {
#pragma unroll
        for (int i = 0; i < RW; ++i) { rq[i] = rp_ref(p, l, base + i * stride, base, hi);
#pragma unroll
            for (int j = 0; j < NV4; ++j) { xq[i][j] = *(const f32x4*)(rq[i].xo + 4 * lane + 256 * j); yq[i][j] = (l > 0) ? *(const u32x2*)(YO + (size_t)rq[i].row * DM + 4 * lane + 256 * j) : (u32x2){0u, 0u}; } }
    }
    for (; base < hi; base += stride * RW) {
        f32x4 x[RW][NV4], y[RW][NV4]; RowRef rc[RW];
#pragma unroll
        for (int i = 0; i < RW; ++i) { rc[i] = rq[i];
#pragma unroll
            for (int j = 0; j < NV4; ++j) { x[i][j] = xq[i][j]; const u32x2 yy = yq[i][j]; y[i][j] = (f32x4){bitsf(yy.x << 16), bitsf(yy.x & 0xffff0000u), bitsf(yy.y << 16), bitsf(yy.y & 0xffff0000u)}; } }
        { const int nbase = base + stride * RW;
            if (nbase < hi) {
#pragma unroll
                for (int i = 0; i < RW; ++i) { rq[i] = rp_ref(p, l, nbase + i * stride, nbase, hi);
#pragma unroll
                    for (int j = 0; j < NV4; ++j) { xq[i][j] = *(const f32x4*)(rq[i].xo + 4 * lane + 256 * j); if (l > 0) yq[i][j] = *(const u32x2*)(YO + (size_t)rq[i].row * DM + 4 * lane + 256 * j); } } } }
        if (l > 0) {
            float ss[RW];
#pragma unroll
            for (int i = 0; i < RW; ++i) { ss[i] = 0.f;
#pragma unroll
                for (int j = 0; j < NV4; ++j) ss[i] += y[i][j].x * y[i][j].x + y[i][j].y * y[i][j].y + y[i][j].z * y[i][j].z + y[i][j].w * y[i][j].w; }
#pragma unroll
            for (int i = 0; i < RW; ++i) ss[i] = wave_sum(ss[i]);
            const float* gp = p.in[I_GPOST] + (size_t)(l - 1) * DM;
            float rstd[RW]; const float* gt[RW];
#pragma unroll
            for (int i = 0; i < RW; ++i) { rstd[i] = rsqrtf(ss[i] * (1.0f / DM) + EPS); gt[i] = MOD + ((size_t)(l - 1) * NJ + rc[i].mj) * 3 * DM + 2 * DM; }
            f32x4 p4n = *(const f32x4*)(gp + 4 * lane), g4n[RW];
#pragma unroll
            for (int i = 0; i < RW; ++i) g4n[i] = *(const f32x4*)(gt[i] + 4 * lane);
#pragma unroll
            for (int j = 0; j < NV4; ++j) { const f32x4 p4 = p4n; f32x4 g4[RW];
#pragma unroll
                for (int i = 0; i < RW; ++i) g4[i] = g4n[i];
                if (j + 1 < NV4) { p4n = *(const f32x4*)(gp + 4 * lane + 256 * (j + 1));
#pragma unroll
                    for (int i = 0; i < RW; ++i) g4n[i] = *(const f32x4*)(gt[i] + 4 * lane + 256 * (j + 1)); }
#pragma unroll
                for (int i = 0; i < RW; ++i) { x[i][j] = x[i][j] + g4[i] * (y[i][j] * rstd[i] * p4);
                    if (rc[i].ok) *(f32x4*)(rc[i].xn + 4 * lane + 256 * j) = x[i][j]; } }
        }
        if (l < DEPTH) {
            float ss[RW];
#pragma unroll
            for (int i = 0; i < RW; ++i) { ss[i] = 0.f;
#pragma unroll
                for (int j = 0; j < NV4; ++j) ss[i] += x[i][j].x * x[i][j].x + x[i][j].y * x[i][j].y + x[i][j].z * x[i][j].z + x[i][j].w * x[i][j].w; }
#pragma unroll
            for (int i = 0; i < RW; ++i) ss[i] = wave_sum(ss[i]);
            const float* gp = p.in[I_GPRE] + (size_t)l * DM;
            float rstd[RW]; const float* md[RW];
#pragma unroll
            for (int i = 0; i < RW; ++i) { rstd[i] = rsqrtf(ss[i] * (1.0f / DM) + EPS); md[i] = MOD + ((size_t)l * NJ + rc[i].mj) * 3 * DM; }
            f32x4 g4n = *(const f32x4*)(gp + 4 * lane), shn[RW], scn[RW];
#pragma unroll
            for (int i = 0; i < RW; ++i) { shn[i] = *(const f32x4*)(md[i] + 4 * lane); scn[i] = *(const f32x4*)(md[i] + DM + 4 * lane); }
#pragma unroll
            for (int j = 0; j < NV4; ++j) { const int e = 4 * lane + 256 * j; const f32x4 g4 = g4n; f32x4 sh[RW], sc[RW];
#pragma unroll
                for (int i = 0; i < RW; ++i) { sh[i] = shn[i]; sc[i] = scn[i]; }
                if (j + 1 < NV4) { g4n = *(const f32x4*)(gp + e + 256);
#pragma unroll
                    for (int i = 0; i < RW; ++i) { shn[i] = *(const f32x4*)(md[i] + e + 256); scn[i] = *(const f32x4*)(md[i] + DM + e + 256); } }
#pragma unroll
                for (int i = 0; i < RW; ++i) { const f32x4 h = (x[i][j] * rstd[i] * g4) * (sc[i] + 1.0f) + sh[i];
                    u32x2 o; o.x = pk2(h.x, h.y); o.y = pk2(h.z, h.w);
                    if (rc[i].ok) *(u32x2*)(HN + (size_t)rc[i].row * DM + e) = o; } }
        }
    }
}

__device__ __forceinline__ void convert_tile(const float* src, int ldn, bf16* dst, int K, int n0, int k0, bool use_map, char* smem) {
    const int tid = otid();
    float* tile = (float*)smem;
    __syncthreads();
#pragma unroll
    for (int i = 0; i < 8; ++i) { const int idx = tid + NT * i, k = idx >> 6, n = idx & 63;
        const int oc = use_map ? orig_col(n0 + n) : (n0 + n);
        tile[k * 65 + n] = oc >= 0 ? src[(size_t)(k0 + k) * ldn + oc] : 0.f; }
    __syncthreads();
    const int n = tid >> 3, c = tid & 7;
    u32x4 o; o.x = pk2(tile[(8 * c + 0) * 65 + n], tile[(8 * c + 1) * 65 + n]); o.y = pk2(tile[(8 * c + 2) * 65 + n], tile[(8 * c + 3) * 65 + n]);
    o.z = pk2(tile[(8 * c + 4) * 65 + n], tile[(8 * c + 5) * 65 + n]); o.w = pk2(tile[(8 * c + 6) * 65 + n], tile[(8 * c + 7) * 65 + n]);
    *(u32x4*)(dst + (size_t)(n0 + n) * K + k0 + 8 * c) = o;
}

__device__ __forceinline__ void filter_task(const Params& p, int l, int L, int pos0, char* smem) {
    const int tid = otid(), j = tid & 63;
    float* z = (float*)smem;
    float* h1 = z + 8 * 33;
    float* h2 = h1 + 8 * 64;
    const float* w1 = p.in[I_HW1] + (size_t)l * 33 * 64; const float* w2 = p.in[I_HW2] + (size_t)l * 64 * 64; const float* w3 = p.in[I_HW3] + (size_t)l * 64 * 512;
    float r1[33], r2[64], r3a[16];
#pragma unroll
    for (int i = 0; i < 33; ++i) r1[i] = w1[i * 64 + j];
#pragma unroll
    for (int i = 0; i < 64; ++i) r2[i] = w2[i * 64 + j];
    const float b1 = p.in[I_HB1][l * 64 + j], b2 = p.in[I_HB2][l * 64 + j], b3 = p.in[I_HB3][l * 512 + tid];
    const float f0 = p.in[I_HFREQ][(l * 2 + 0) * 64 + j], f1 = p.in[I_HFREQ][(l * 2 + 1) * 64 + j];
    __syncthreads();
    if (tid < 8 * 33) { const int pp = tid / 33, i = tid % 33; const float pos = (float)(pos0 + pp);
        const float t = pos / (float)(L - 1 > 1 ? L - 1 : 1), wv = 6.283185307179586f * pos / (float)L; float v;
        if (i == 0) v = t; else { const int bi = (i - 1) & 15; const float f = 1e-4f + (float)bi * ((15.0f - 1e-4f) / 15.0f); v = (i <= 16) ? cosf(wv * f) : -sinf(wv * f); }
        z[tid] = v; }
    __syncthreads();
    { const int pp = tid >> 6; float a = b1;
#pragma unroll
        for (int i = 0; i < 33; ++i) a += z[pp * 33 + i] * r1[i];
        h1[tid] = sinf(f0 * a);
#pragma unroll
        for (int i = 0; i < 16; ++i) r3a[i] = w3[i * 512 + tid]; }
    __syncthreads();
    { const int pp = tid >> 6; float a = b2;
#pragma unroll
        for (int i = 0; i < 64; ++i) a += h1[pp * 64 + i] * r2[i];
        h2[tid] = sinf(f1 * a); }
    __syncthreads();
    { const int o = tid, dir = o >> 8, c = o & 255;
        const float delta = 3.0701134573253946f + (float)c * ((15.350567286626973f - 3.0701134573253946f) / 255.0f);
        float acc[8];
#pragma unroll
        for (int pp = 0; pp < 8; ++pp) acc[pp] = b3;
#pragma unroll 1
        for (int cix = 0; cix < 4; ++cix) {
            float wn[16];
#pragma unroll
            for (int i = 0; i < 16; ++i) wn[i] = (cix < 3) ? w3[(16 * (cix + 1) + i) * 512 + o] : 0.f;
#pragma unroll
            for (int i = 0; i < 16; ++i) {
#pragma unroll
                for (int pp = 0; pp < 8; ++pp) acc[pp] += h2[pp * 64 + 16 * cix + i] * r3a[i]; }
#pragma unroll
            for (int i = 0; i < 16; ++i) r3a[i] = wn[i]; }
        float* KT = (float*)(p.ws + WS_KT); float* HC = (float*)(p.ws + WS_HC);
#pragma unroll
        for (int pp = 0; pp < 8; ++pp) { const int pos = pos0 + pp; const float t = (float)pos / (float)(L - 1 > 1 ? L - 1 : 1);
            const float v = acc[pp] * __expf(-t * delta);
            if (L == SEQ) { if (dir == 0) KT[(size_t)c * NF + pos]= v; else if (pos > 0) KT[(size_t)c * NF + (NF - pos)] = v; else KT[(size_t)c * NF + SEQ] = 0.f; }
            else HC[((size_t)dir * WG + c) * CTXL + pos] = v; }
    }
}

__device__ __forceinline__ void convert_tile_w(const float* src, int ldn, bf16* dst, int K, int n0, int k0, bool use_map, char* wl, int lane) {
    float* tile = (float*)wl;
    const int oc = use_map ? orig_col(n0 + lane) : (n0 + lane);
    float v[64];
#pragma unroll
    for (int k = 0; k < 64; ++k) v[k] = oc >= 0 ? src[(size_t)(k0 + k) * ldn + oc] : 0.f;
#pragma unroll
    for (int k = 0; k < 64; ++k) tile[k * 65 + lane] = v[k];
    WAVE_SYNC();
#pragma unroll
    for (int i = 0; i < 8; ++i) { const int n = (lane >> 3) + 8 * i, c = lane & 7; float f[8];
#pragma unroll
        for (int j = 0; j < 8; ++j) f[j] = tile[(8 * c + j) * 65 + n];
        *(u32x4*)(dst + (size_t)(n0 + n) * K + k0 + 8 * c) = pack8(f); }
    WAVE_SYNC();
}
__device__ __forceinline__ void layer_prep(const Params& p, int l, int idx, int stride, char* smem) {
    constexpr int N_WIN = (NPAD / 64) * (DM / 64), N_FL = SEQ / 8, N_FC = CTXL / 8;
    for (int task = idx; task < N_FL + N_FC; task += stride) {
        if (task < N_FL) filter_task(p, l, SEQ, task * 8, smem);
        else filter_task(p, l, CTXL, (task - N_FL) * 8, smem);
    }
    __syncthreads();
    { const int tid = otid(), lane = tid & 63, wave = __builtin_amdgcn_readfirstlane(tid >> 6);
        char* wl = smem + wave * WLDS;
        for (int task = wave * stride + idx; task < N_WIN; task += 8 * stride) { const int nt = task / (DM / 64), kt = task % (DM / 64);
            convert_tile_w(p.in[I_WIN] + (size_t)l * DM * N_IN, N_IN, (bf16*)(p.ws + WS_WIN), DM, nt * 64, kt * 64, true, wl, lane); } }
}
__device__ __forceinline__ unsigned* row_queue(const Params& p, int l) { return (unsigned*)(p.ws + WS_BAR + 16384) + 2560 + 64 * l; }
__device__ __forceinline__ void wait_units(const Params& p, int c, int l) {
    constexpr int nLatU = NB * (SEQ / PANEL_ROWS) * PANEL_UNITS, nCtxU = NB * (CTXL / PANEL_ROWS) * PANEL_UNITS;
    const unsigned target = (unsigned)((c ? nCtxU : nLatU) * l);
#ifdef EMU
    while (*(volatile unsigned*)unit_counter(p, c) < target) emu::yield();
#else
    unsigned spins = 0;
    while (__hip_atomic_load(unit_counter(p, c), __ATOMIC_RELAXED, __HIP_MEMORY_SCOPE_AGENT) < target) { __builtin_amdgcn_s_sleep(16); if (++spins > (1u << 20)) break; }
    __builtin_amdgcn_fence(__ATOMIC_ACQUIRE, "agent"); asm volatile("s_waitcnt vmcnt(0)" ::: "memory");
#endif
}
__device__ __forceinline__ void phase_rp(const Params& p, int l, char* smem) { const int G = (int)gridDim.x, bid = obid(), tid = otid();
    const bool has_ctx = l < DEPTH;
    constexpr int nLatU = NB * (SEQ / PANEL_ROWS) * PANEL_UNITS, nCtxU = NB * (CTXL / PANEL_ROWS) * PANEL_UNITS;
    const int nU = nLatU + nCtxU;
    const int heavy = (l >= 1 && has_ctx && nU > G && (nU % G) != 0) ? nU % G : 0;
    const int total = heavy > 0 ? NB * SEQ : (has_ctx ? T : NB * SEQ);
    const int nl = G - heavy, np = (l < DEPTH) ? nl / 2 : 0, nr = nl - np;
    int lo, hi, gi, nb; bool prep = false;
    if (bid < heavy) { lo = NB * SEQ; hi = T; gi = bid; nb = heavy; }
    else { const int i = bid - heavy; int nR = total;
        if (np > 0) { nR = ((total * 2 / 3) / (nr * 16)) * (nr * 16); if (nR <= 0) nR = total / 2; }
        if (np > 0 && (i & 1) && i / 2 < np) { prep = true; lo = nR; hi = total; gi = i / 2; nb = np; }
        else { lo = 0; hi = nR; gi = (np > 0) ? (i + 1) / 2 : i; nb = nr; } }
    if (prep) layer_prep(p, l, gi, np, smem);
    else if (l < DEPTH && np == 0) layer_prep(p, l, bid, G, smem);
    if (l >= 1) { if (tid == 0) { if (lo < NB * SEQ) wait_units(p, 0, l); if (hi > NB * SEQ) wait_units(p, 1, l); } __syncthreads(); }
    rp_rows(p, l, lo, hi, gi, nb);
}

__device__ __forceinline__ cpx cmul(cpx a, cpx b) { cpx r; r.x = a.x * b.x - a.y * b.y; r.y = a.x * b.y + a.y * b.x; return r; }
__device__ __forceinline__ cpx cmulc(cpx a, cpx b) { cpx r; r.x = a.x * b.x + a.y * b.y; r.y = a.y * b.x - a.x * b.y; return r; }
constexpr int fpad(int i) { return i + (i >> 4); }
__device__ __forceinline__ int FPH(int i) { return i + (i >> 4); }
constexpr int FBUF = fpad(NF);
constexpr int ilog16(int n) { return n < 16 ? 0 : 1 + ilog16(n / 16); }
constexpr int FFT_P16 = ilog16(NF);
constexpr bool FFT_R4 = ((NF >> (4 * FFT_P16)) == 4);
static_assert((NF >> (4 * FFT_P16)) == 1 || (NF >> (4 * FFT_P16)) == 4, "NF = 16^a * (1 or 4)");
template <bool INV> __device__ __forceinline__ void dft4(cpx& a0, cpx& a1, cpx& a2, cpx& a3) {
    const cpx s = {a0.x + a2.x, a0.y + a2.y}, b = {a0.x - a2.x, a0.y - a2.y}, c = {a1.x + a3.x, a1.y + a3.y}, d = {a1.x - a3.x, a1.y - a3.y};
    a0 = (cpx){s.x + c.x, s.y + c.y}; a2 = (cpx){s.x - c.x, s.y - c.y};
    if (!INV) { a1 = (cpx){b.x + d.y, b.y - d.x}; a3 = (cpx){b.x - d.y, b.y + d.x}; }
    else      { a1 = (cpx){b.x - d.y, b.y + d.x}; a3 = (cpx){b.x + d.y, b.y - d.x}; }
}
template <bool INV> __device__ __forceinline__ cpx cmulk(cpx a, float wr, float wi) {
    cpx r; if (!INV) { r.x = a.x * wr + a.y * wi; r.y = a.y * wr - a.x * wi; } else { r.x = a.x * wr - a.y * wi; r.y = a.y * wr + a.x * wi; } return r;
}
template <bool INV> __device__ __forceinline__ void dft16(cpx (&x)[16]) {
    constexpr float C1 = 0.92387953251128674f, S1 = 0.38268343236508977f, C2 = 0.70710678118654752f;
#pragma unroll
    for (int n2 = 0; n2 < 4; ++n2) dft4<INV>(x[n2], x[4 + n2], x[8 + n2], x[12 + n2]);
    x[4 * 1 + 1] = cmulk<INV>(x[4 * 1 + 1], C1, S1); x[4 * 1 + 2] = cmulk<INV>(x[4 * 1 + 2], C2, C2); x[4 * 1 + 3] = cmulk<INV>(x[4 * 1 + 3], S1, C1);
    x[4 * 2 + 1] = cmulk<INV>(x[4 * 2 + 1], C2, C2); x[4 * 2 + 2] = cmulk<INV>(x[4 * 2 + 2], 0.f, 1.f); x[4 * 2 + 3] = cmulk<INV>(x[4 * 2 + 3], -C2, C2);
    x[4 * 3 + 1] = cmulk<INV>(x[4 * 3 + 1], S1, C1); x[4 * 3 + 2] = cmulk<INV>(x[4 * 3 + 2], -C2, C2); x[4 * 3 + 3] = cmulk<INV>(x[4 * 3 + 3], -C1, -S1);
#pragma unroll
    for (int k1 = 0; k1 < 4; ++k1) dft4<INV>(x[4 * k1 + 0], x[4 * k1 + 1], x[4 * k1 + 2], x[4 * k1 + 3]);
    cpx t;
    t = x[1]; x[1] = x[4]; x[4] = t; t = x[2]; x[2] = x[8]; x[8] = t; t = x[3]; x[3] = x[12]; x[12] = t;
    t = x[6]; x[6] = x[9]; x[9] = t; t = x[7]; x[7] = x[13]; x[13] = t; t = x[11]; x[11] = x[14]; x[14] = t;
}
template <bool INV> __device__ __forceinline__ void fft_stage16(cpx* buf, const cpx* TW, int tl, int M) {
    const int span = M >> 4, twm = NF / M;
#pragma unroll 1
    for (int j = tl; j < NF / 16; j += 256) {
        const int grp = j / span, pos = j % span, base = grp * M + pos; cpx x[16];
#pragma unroll
        for (int q = 0; q < 16; ++q) x[q] = buf[FPH(base + q * span)];
        cpx w1 = {1.f, 0.f}; if (span > 1) w1 = TW[pos * twm];
        if (INV && span > 1) { cpx wk = w1;
#pragma unroll
            for (int k = 1; k < 16; ++k) { x[k] = cmulc(x[k], wk); wk = cmul(wk, w1); } }
        dft16<INV>(x);
        if (!INV && span > 1) { cpx wk = w1;
#pragma unroll
            for (int k = 1; k < 16; ++k) { x[k] = cmul(x[k], wk); wk = cmul(wk, w1); } }
#pragma unroll
        for (int q = 0; q < 16; ++q) buf[FPH(base + q * span)] = x[q];
    }
}
template <bool INV> __device__ __forceinline__ void fft_stage4_last(cpx* buf, int tl) {
#pragma unroll 1
    for (int j = tl; j < NF / 4; j += 256) { cpx a0 = buf[FPH(4 * j)], a1 = buf[FPH(4 * j + 1)], a2 = buf[FPH(4 * j + 2)], a3 = buf[FPH(4 * j + 3)];
        dft4<INV>(a0, a1, a2, a3); buf[FPH(4 * j)] = a0; buf[FPH(4 * j + 1)] = a1; buf[FPH(4 * j + 2)] = a2; buf[FPH(4 * j + 3)] = a3; }
}
__device__ __forceinline__ void fft_fwd(cpx* buf, const cpx* TW, int tl) {
    int M = NF;
#pragma unroll
    for (int s = 0; s < FFT_P16; ++s) { __syncthreads(); fft_stage16<false>(buf, TW, tl, M); M >>= 4; }
    if (FFT_R4) { __syncthreads(); fft_stage4_last<false>(buf, tl); }
    __syncthreads();
}
__device__ __forceinline__ void fft_inv(cpx* buf, const cpx* TW, int tl) {
    if (FFT_R4) { __syncthreads(); fft_stage4_last<true>(buf, tl); }
    int M = FFT_R4 ? 64 : 16;
#pragma unroll
    for (int s = 0; s < FFT_P16; ++s) { __syncthreads(); fft_stage16<true>(buf, TW, tl, M); M <<= 4; }
    __syncthreads();
}
__device__ __forceinline__ void filt_fft_task(const Params& p, int cp, char* smem) {
    const int tid = otid(), half = tid >> 8, tl = tid & 255, c = 2 * cp + half;
    cpx* buf = (cpx*)smem + (size_t)half * FBUF;
    const float* KT = (const float*)(p.ws + WS_KT) + (size_t)c * NF;
    cpx* KF = (cpx*)(p.ws + WS_KF) + (size_t)c * NF;
    const cpx* TW = (const cpx*)(p.ws + WS_TW);
    __syncthreads();
    for (int i = tl; i < NF; i += 256) { cpx v; v.x = KT[i]; v.y = 0.f; buf[FPH(i)] = v; }
    fft_fwd(buf, TW, tl);
    for (int i = tl; i < NF; i += 256) KF[i] = buf[FPH(i)];
}

__device__ __forceinline__ void gemm_tile(const Params& p, const bf16* A, const bf16* Bt, int K, int mt, int nt, int mode, char* smem) {
    const int tid = otid(), lane = tid & 63, wave = tid >> 6;
    bf16* As = (bf16*)smem;
    bf16* Bs = As + 128 * LS;
    const int wm = (wave & 3) * 32, wn = (wave >> 2) * 64;
    f32x4 acc[2][4];
#pragma unroll
    for (int i = 0; i < 2; ++i)
#pragma unroll
        for (int j = 0; j < 4; ++j) acc[i][j] = (f32x4){0.f, 0.f, 0.f, 0.f};
    const int lr = tid >> 3, lc = tid & 7;
    const bf16* Ag = A + (size_t)(mt * 128 + lr) * K + lc * 8;
    const bf16* Bg = Bt + (size_t)(nt * 128 + lr) * K + lc * 8;
    u32x4 ra0, ra1, rb0, rb1;
    ra0 = *(const u32x4*)(Ag); ra1 = *(const u32x4*)(Ag + (size_t)64 * K); rb0 = *(const u32x4*)(Bg); rb1 = *(const u32x4*)(Bg + (size_t)64 * K);
    const int nk = K / 64;
    for (int kt = 0; kt < nk; ++kt) {
        __syncthreads();
        *(u32x4*)(As + lr * LS + lc * 8) = ra0; *(u32x4*)(As + (lr + 64) * LS + lc * 8) = ra1;
        *(u32x4*)(Bs + lr * LS + lc * 8) = rb0; *(u32x4*)(Bs + (lr + 64) * LS + lc * 8) = rb1;
        __syncthreads();
        if (kt + 1 < nk) { const int ko = (kt + 1) * 64;
            ra0 = *(const u32x4*)(Ag + ko); ra1 = *(const u32x4*)(Ag + (size_t)64 * K + ko); rb0 = *(const u32x4*)(Bg + ko); rb1 = *(const u32x4*)(Bg + (size_t)64 * K + ko); }
        mma_nt<4, 2>(As, LS, wm, Bs, LS, wn, acc[0], lane);
        mma_nt<4, 2>(As, LS, wm + 16, Bs, LS, wn, acc[1], lane);
    }
    const int r = lane & 15, q = lane >> 4;
#pragma unroll
    for (int i = 0; i < 2; ++i)
#pragma unroll
        for (int j = 0; j < 4; ++j)
#pragma unroll
            for (int e = 0; e < 4; ++e) {
                const int row = mt * 128 + wm + 16 * i + 4 * q + e, col = nt * 128 + wn + 16 * j + r; const float v = acc[i][j][e];
                if (mode == 0) { if (col < NP) ((bf16*)(p.ws + WS_P))[(size_t)row * NP + col] = f2bf(v); else if (col < NP + 16) ((float*)(p.ws + WS_G))[(size_t)row * NGS + (col - NP)] = v; else if (col < NP + NG) ((bf16*)((float*)(p.ws + WS_G) + (size_t)row * NGS + 16))[col - NP - 16] = f2bf(v); }
                else if (mode == 2) ((bf16*)(p.ws + WS_HT))[(size_t)row * T + col] = f2bf(v);
                else ((bf16*)(p.ws + WS_P))[(size_t)row * DM + col] = f2bf(v);
            }
}

#ifndef EMU
namespace pg8 {
#define PG8_LAS __attribute__((address_space(3)))
typedef unsigned short bf16_t;
typedef short bf16x8 __attribute__((ext_vector_type(8)));
typedef float f32x4 __attribute__((ext_vector_type(4)));
typedef unsigned u32x4 __attribute__((ext_vector_type(4)));
constexpr int BM = 256, BK = 64, HALF = 128, HTB = HALF * BK * 2  , STAGE_BYTES = 8 * HTB, NXCD = 8, WGM = 4;

__host__ __device__ __forceinline__ int lds_byte(int r, int c) { const int st = (r >> 4) * 2 + (c >> 5), rr = r & 15, cc = c & 31, ob = rr * 64 + cc * 2; return st * 1024 + (ob ^ (((ob >> 9) & 1) << 5)); }
__host__ __device__ __forceinline__ void stage_rc(int b, int& R, int& C) { const int st = b / 1024, sb = b % 1024, swz = sb ^ (((sb >> 9) & 1) << 5); R = (st >> 1) * 16 + swz / 64; C = (st & 1) * 32 + (swz % 64) / 2; }
__host__ __device__ __forceinline__ int perm32(int rho) { const int n = rho >> 4, i = rho & 15; return 8 * (i >> 2) + 4 * n + (i & 3); }

struct Unit { int pm, pn; };
struct Gemm { const bf16_t* A; const bf16_t* Bt; int M, N, K; };
__device__ __forceinline__ unsigned cvt_pk_bf16(float lo, float hi) { unsigned r; asm volatile("v_cvt_pk_bf16_f32 %0, %1, %2" : "=v"(r) : "v"(lo), "v"(hi)); return r; }
template <class Epi, class Sched, bool ALIGN_EPI = false, bool SP2 = false>
__device__ __forceinline__ void gemm_phase(PG8_LAS unsigned char* lds, const Gemm g, const Sched& S, const Epi& E) {
    const int tid = otid(), wid = __builtin_amdgcn_readfirstlane(tid >> 6), lane = tid & 63, wr = wid >> 2, wc = wid & 3, fr = lane & 15, fq = lane >> 4;
    const int K = g.K, nt = K / BK;
    unsigned voffA[2], voffB[2];
#pragma unroll
    for (int i = 0; i < 2; ++i) { int R, C; stage_rc(tid * 16 + i * 8192, R, C); const int Rb = Epi::PERM ? ((R & ~31) + perm32(R & 31)) : R;
        voffA[i] = (unsigned)(R * K + C) * 2u; voffB[i] = (unsigned)(Rb * K + C) * 2u; }
    const size_t kstep = (size_t)(BK * 2);
    const size_t hstep = (size_t)HALF * K * 2;
    const size_t tstep = 2 * hstep;
    const unsigned ldsw = (unsigned)wid * 1024u;
    const int aoff = lds_byte(wr * 64 + fr, fq * 8), boff = lds_byte(wc * 32 + fr, fq * 8);
#define PG8_SA(b, h) (((b) * 2 + (h)) * HTB)
#define PG8_SB(b, h) ((4 + (b) * 2 + (h)) * HTB)
#define PG8_STAGE(bufoff, gbase, voff) do { _Pragma("unroll") for (int _i = 0; _i < 2; ++_i) \
        __builtin_amdgcn_global_load_lds((const unsigned*)((const char*)(gbase) + (voff)[_i]), (PG8_LAS unsigned*)(lds + (bufoff) + ldsw + _i * 8192), 16, 0, 0); } while (0)
#define PG8_LDA(dst, b, h) do { _Pragma("unroll") for (int m = 0; m < 4; ++m) _Pragma("unroll") for (int k = 0; k < 2; ++k) dst[m][k] = *(const PG8_LAS bf16x8*)(lds + PG8_SA(b, h) + aoff + m * 2048 + k * 1024); } while (0)
#define PG8_LDB(dst, b, h) do { _Pragma("unroll") for (int n = 0; n < 2; ++n) _Pragma("unroll") for (int k = 0; k < 2; ++k) dst[n][k] = *(const PG8_LAS bf16x8*)(lds + PG8_SB(b, h) + boff + n * 2048 + k * 1024); } while (0)
#define PG8_MMA(ai, bj, At, Bt) do { __builtin_amdgcn_s_setprio(1); _Pragma("unroll") for (int m = 0; m < 4; ++m) _Pragma("unroll") for (int n = 0; n < 2; ++n) _Pragma("unroll") for (int k = 0; k < 2; ++k) \
        acc[ai][bj][m][n] = __builtin_amdgcn_mfma_f32_16x16x32_bf16(Bt[n][k], At[m][k], acc[ai][bj][m][n], 0, 0, 0); __builtin_amdgcn_s_setprio(0); } while (0)
#define PG8_WAIT_V(n) asm volatile("s_waitcnt vmcnt(" #n ")" ::: "memory")
#define PG8_WAIT_L(n) asm volatile("s_waitcnt lgkmcnt(" #n ")" ::: "memory")
#define PG8_BAR __builtin_amdgcn_s_barrier()
#define PG8_SCHED __builtin_amdgcn_sched_barrier(0)
    Unit cur, nxt; int ui = 0;
    if (!S.next(0, cur)) return;
    f32x4 acc[2][2][4][2];
#pragma unroll
    for (int a = 0; a < 2; ++a)
#pragma unroll
        for (int b = 0; b < 2; ++b)
#pragma unroll
            for (int m = 0; m < 4; ++m)
#pragma unroll
                for (int n = 0; n < 2; ++n) acc[a][b][m][n] = (f32x4){0.f, 0.f, 0.f, 0.f};
    bf16x8 At[4][2], B0[2][2], B1[2][2];
    const char* cA = (const char*)g.A + (size_t)cur.pm * tstep; const char* cB = (const char*)g.Bt + (size_t)cur.pn * tstep;
    S.a_ready(cur);
    if constexpr (SP2) {
        PG8_STAGE(PG8_SB(0, 0), cB, voffB); PG8_STAGE(PG8_SB(0, 1), cB + hstep, voffB); PG8_STAGE(PG8_SA(0, 0), cA, voffA); PG8_STAGE(PG8_SA(0, 1), cA + hstep, voffA);
        if (wr == 1) PG8_BAR;
        PG8_WAIT_V(2); PG8_BAR;
        PG8_STAGE(PG8_SB(1, 0), cB + kstep, voffB); PG8_STAGE(PG8_SA(1, 0), cA + kstep, voffA); PG8_STAGE(PG8_SB(1, 1), cB + hstep + kstep, voffB);
        PG8_WAIT_V(6); PG8_BAR;
    } else {
        PG8_STAGE(PG8_SB(0, 0), cB, voffB); PG8_STAGE(PG8_SA(0, 0), cA, voffA); PG8_STAGE(PG8_SB(0, 1), cB + hstep, voffB); PG8_STAGE(PG8_SA(0, 1), cA + hstep, voffA);
        if (wr == 1) PG8_BAR;
        PG8_WAIT_V(4); PG8_BAR;
        PG8_STAGE(PG8_SB(1, 0), cB + kstep, voffB); PG8_STAGE(PG8_SA(1, 0), cA + kstep, voffA); PG8_STAGE(PG8_SB(1, 1), cB + hstep + kstep, voffB);
        PG8_WAIT_V(6); PG8_BAR;
    }
    for (;;) {
        const bool has_next = S.next(ui + 1, nxt);
        const char* nA = has_next ? (const char*)g.A + (size_t)nxt.pm * tstep : cA; const char* nB = has_next ? (const char*)g.Bt + (size_t)nxt.pn * tstep : cB;
        for (int t = 0; t < nt; t += 2) {
            const bool last = (t == nt - 2);
            const char* a1 = cA + (size_t)(t + 1) * kstep;
            const char* a2 = last ? nA : cA + (size_t)(t + 2) * kstep; const char* b2 = last ? nB : cB + (size_t)(t + 2) * kstep;
            const char* a3 = a2 + kstep; const char* b3 = b2 + kstep;
            if (last && has_next) S.a_ready(nxt);
            if constexpr (SP2) {
            PG8_LDB(B0, 0, 0); PG8_LDB(B1, 0, 1); PG8_SCHED; PG8_LDA(At, 0, 0); PG8_STAGE(PG8_SA(1, 1), a1 + hstep, voffA);
            PG8_WAIT_V(8); PG8_WAIT_L(0); PG8_BAR; PG8_MMA(0, 0, At, B0); PG8_MMA(0, 1, At, B1); PG8_BAR; PG8_SCHED;
            PG8_LDA(At, 0, 1); PG8_STAGE(PG8_SB(0, 0), b2, voffB); PG8_STAGE(PG8_SB(0, 1), b2 + hstep, voffB); PG8_STAGE(PG8_SA(0, 0), a2, voffA);
            PG8_WAIT_V(8); PG8_WAIT_L(0); PG8_BAR; PG8_MMA(1, 0, At, B0); PG8_MMA(1, 1, At, B1); PG8_BAR; PG8_SCHED;
            PG8_LDB(B0, 1, 0); PG8_LDB(B1, 1, 1); PG8_SCHED; PG8_LDA(At, 1, 0); PG8_STAGE(PG8_SA(0, 1), a2 + hstep, voffA);
            PG8_WAIT_V(8); PG8_WAIT_L(0); PG8_BAR; PG8_MMA(0, 0, At, B0); PG8_MMA(0, 1, At, B1); PG8_BAR; PG8_SCHED;
            PG8_LDA(At, 1, 1); PG8_STAGE(PG8_SB(1, 0), b3, voffB); PG8_STAGE(PG8_SB(1, 1), b3 + hstep, voffB); PG8_STAGE(PG8_SA(1, 0), a3, voffA);
            PG8_WAIT_V(8); PG8_WAIT_L(0); PG8_BAR; PG8_MMA(1, 0, At, B0); PG8_MMA(1, 1, At, B1); PG8_BAR; PG8_SCHED;
            } else {
            PG8_LDB(B0, 0, 0); PG8_SCHED; PG8_LDA(At, 0, 0); PG8_STAGE(PG8_SA(1, 1), a1 + hstep, voffA);
            PG8_WAIT_L(8); PG8_BAR; PG8_WAIT_L(0); PG8_MMA(0, 0, At, B0); PG8_BAR; PG8_SCHED;
            PG8_LDB(B1, 0, 1); PG8_STAGE(PG8_SB(0, 0), b2, voffB);
            PG8_BAR; PG8_WAIT_L(0); PG8_MMA(0, 1, At, B1); PG8_BAR;
            PG8_LDA(At, 0, 1); PG8_STAGE(PG8_SA(0, 0), a2, voffA);
            PG8_BAR; PG8_WAIT_L(0); PG8_MMA(1, 0, At, B0); PG8_BAR; PG8_SCHED;
            PG8_STAGE(PG8_SB(0, 1), b2 + hstep, voffB);
            PG8_WAIT_V(6); PG8_BAR; PG8_MMA(1, 1, At, B1); PG8_BAR;
            PG8_LDB(B0, 1, 0); PG8_SCHED; PG8_LDA(At, 1, 0); PG8_STAGE(PG8_SA(0, 1), a2 + hstep, voffA);
            PG8_WAIT_L(8); PG8_BAR; PG8_WAIT_L(0); PG8_MMA(0, 0, At, B0); PG8_BAR; PG8_SCHED;
            PG8_LDB(B1, 1, 1); PG8_STAGE(PG8_SB(1, 0), b3, voffB);
            PG8_BAR; PG8_WAIT_L(0); PG8_MMA(0, 1, At, B1); PG8_BAR;
            PG8_LDA(At, 1, 1); PG8_STAGE(PG8_SA(1, 0), a3, voffA);
            PG8_BAR; PG8_WAIT_L(0); PG8_MMA(1, 0, At, B0); PG8_BAR; PG8_SCHED;
            PG8_STAGE(PG8_SB(1, 1), b3 + hstep, voffB);
            PG8_WAIT_V(6); PG8_BAR; PG8_MMA(1, 1, At, B1); PG8_BAR;
            }
        }
        if constexpr (ALIGN_EPI) { if (wr == 0) PG8_BAR; }
        if constexpr (!Epi::AFTER_DRAIN) { E(acc, cur, wr, wc, fr, fq); S.done(cur); }
        if (!has_next) break;
#pragma unroll
        for (int a = 0; a < 2; ++a)
#pragma unroll
            for (int b = 0; b < 2; ++b)
#pragma unroll
                for (int m = 0; m < 4; ++m)
#pragma unroll
                    for (int n = 0; n < 2; ++n) acc[a][b][m][n] = (f32x4){0.f, 0.f, 0.f, 0.f};
        cur = nxt; cA = nA; cB = nB; ++ui;
        if constexpr (ALIGN_EPI) { if (wr == 1) PG8_BAR; }
    }
    PG8_WAIT_V(0);
    if constexpr (!ALIGN_EPI) { if (wr == 0) PG8_BAR; }
    PG8_BAR;
    if constexpr (Epi::AFTER_DRAIN) { E.fused(acc, cur, wr, wc, fr, fq, lds, wid, lane); S.done(cur); }
#undef PG8_SA
#undef PG8_SB
#undef PG8_STAGE
#undef PG8_LDA
#undef PG8_LDB
#undef PG8_MMA
#undef PG8_WAIT_V
#undef PG8_WAIT_L
#undef PG8_BAR
#undef PG8_SCHED
}
__device__ __forceinline__ void map_tile(int L, int nM, int nN, int& pm, int& pn) {
    const int nwg = nM * nN; int wgid = L; { const int q = nwg / NXCD, r = nwg % NXCD, xcd = wgid % NXCD, off = wgid / NXCD; wgid = (xcd < r ? xcd * (q + 1) : r * (q + 1) + (xcd - r) * q) + off; }
    const int nig = WGM * nN, gid = wgid / nig, fm = gid * WGM, gsz = (nM - fm) < WGM ? (nM - fm) : WGM;
    pm = fm + ((wgid % nig) % gsz); pn = (wgid % nig) / gsz;
}
constexpr int MP = T / 256, WP = NMAIN / 256, NU2 = 4 * MP, NU1 = MP * WP;
struct InOrder { int G, c;
    __device__ __forceinline__ bool next(int i, Unit& u) const { const int L = i * G + c; if (L >= NU2 + NU1) return false; int a, b;
        if (L < NU2) { map_tile(L, 4, MP, a, b); u.pm = MP + WP + a; u.pn = b; } else { map_tile(L - NU2, MP, WP, a, b); u.pm = a; u.pn = MP + b; } return true; }
    __device__ __forceinline__ void a_ready(const Unit&) const {}
    __device__ __forceinline__ void done(const Unit&) const {}
};
struct EpiIn { static constexpr bool PERM = true, AFTER_DRAIN = false; bf16_t* P; float* G; bf16_t* HTp;
    __device__ __forceinline__ void operator()(const f32x4 (&acc)[2][2][4][2], const Unit& u, int wr, int wc, int fr, int fq) const {
        if (u.pm < MP) { const int pn = u.pn - MP, row0 = u.pm * BM + wr * 64 + fr;
            if (pn < NP / 256) { const int col0 = pn * BM + wc * 32 + 8 * fq;
#pragma unroll
                for (int ai = 0; ai < 2; ++ai)
#pragma unroll
                    for (int m = 0; m < 4; ++m) { bf16_t* rowp = P + (size_t)(row0 + ai * HALF + m * 16) * NP + col0;
#pragma unroll
                        for (int bj = 0; bj < 2; ++bj) { const f32x4 v0 = acc[ai][bj][m][0], v1 = acc[ai][bj][m][1];
                            u32x4 w; w.x = cvt_pk_bf16(v0[0], v0[1]); w.y = cvt_pk_bf16(v0[2], v0[3]); w.z = cvt_pk_bf16(v1[0], v1[1]); w.w = cvt_pk_bf16(v1[2], v1[3]); *(u32x4*)(rowp + bj * HALF) = w; } } }
            else { const int cb = wc * 32 + 8 * fq;
                if (cb < NG) {
#pragma unroll
                    for (int ai = 0; ai < 2; ++ai)
#pragma unroll
                        for (int m = 0; m < 4; ++m) { float* rowb = G + (size_t)(row0 + ai * HALF + m * 16) * NGS; const f32x4 v0 = acc[ai][0][m][0], v1 = acc[ai][0][m][1];
                            if (cb < 16) { *(f32x4*)(rowb + cb) = v0; *(f32x4*)(rowb + cb + 4) = v1; }
                            else { u32x4 w; w.x = cvt_pk_bf16(v0[0], v0[1]); w.y = cvt_pk_bf16(v0[2], v0[3]); w.z = cvt_pk_bf16(v1[0], v1[1]); w.w = cvt_pk_bf16(v1[2], v1[3]); *(u32x4*)((bf16_t*)(rowb + 16) + (cb - 16)) = w; } } } } }
        else { const int row0 = (u.pm - MP - WP) * BM + wr * 64 + fr, col0 = u.pn * BM + wc * 32 + 8 * fq;
#pragma unroll
            for (int ai = 0; ai < 2; ++ai)
#pragma unroll
                for (int m = 0; m < 4; ++m) { bf16_t* rowp = HTp + (size_t)(row0 + ai * HALF + m * 16) * T + col0;
#pragma unroll
                    for (int bj = 0; bj < 2; ++bj) { const f32x4 v0 = acc[ai][bj][m][0], v1 = acc[ai][bj][m][1];
                        u32x4 w; w.x = cvt_pk_bf16(v0[0], v0[1]); w.y = cvt_pk_bf16(v0[2], v0[3]); w.z = cvt_pk_bf16(v1[0], v1[1]); w.w = cvt_pk_bf16(v1[2], v1[3]); *(u32x4*)(rowp + bj * HALF) = w; } } }
    }
};
struct OutOrder { int G, c; bool lat_only; unsigned* cnt;
    __device__ __forceinline__ bool next(int i, Unit& u) const { constexpr int nN = DM / 256, nLat = NB * (SEQ / 256) * nN, nCtx = NB * (CTXL / 256) * nN; const int L = i * G + c; int a, b;
        if (L < nLat) { map_tile(L, nLat / nN, nN, a, b); u.pm = (a / (SEQ / 256)) * (TOK / 256) + CTXL / 256 + a % (SEQ / 256); }
        else { if (lat_only || L >= nLat + nCtx) return false; map_tile(L - nLat, nCtx / nN, nN, a, b); u.pm = (a / (CTXL / 256)) * (TOK / 256) + a % (CTXL / 256); }
        u.pn = b; return true; }
    __device__ __forceinline__ void a_ready(const Unit&) const {}
    unsigned* xu; unsigned nloc, xtarget;
    __device__ __forceinline__ void done(const Unit& u) const {
        asm volatile("s_waitcnt vmcnt(0)" ::: "memory"); __builtin_amdgcn_s_barrier();
        if (threadIdx.x == 0) { const bool isctx = (u.pm % (TOK / 256)) < CTXL / 256;
            if (!isctx && xtarget != 0u) {
                const unsigned old = __hip_atomic_fetch_add(xu, 1u, __ATOMIC_RELAXED, __HIP_MEMORY_SCOPE_AGENT);
                if (old + 1u == xtarget) { __builtin_amdgcn_fence(__ATOMIC_RELEASE, "agent"); asm volatile("s_waitcnt vmcnt(0)" ::: "memory");
                    __hip_atomic_fetch_add(cnt, nloc, __ATOMIC_RELAXED, __HIP_MEMORY_SCOPE_AGENT); } }
            else { __builtin_amdgcn_fence(__ATOMIC_RELEASE, "agent"); asm volatile("s_waitcnt vmcnt(0)" ::: "memory");
                __hip_atomic_fetch_add(cnt + (isctx ? 64 : 0), 1u, __ATOMIC_RELAXED, __HIP_MEMORY_SCOPE_AGENT); } } }
};
struct EpiOut { static constexpr bool PERM = true, AFTER_DRAIN = false; bf16_t* C;
    __device__ __forceinline__ void operator()(const f32x4 (&acc)[2][2][4][2], const Unit& u, int wr, int wc, int fr, int fq) const {
        const int row0 = u.pm * BM + wr * 64 + fr, col0 = u.pn * BM + wc * 32 + 8 * fq;
#pragma unroll
        for (int ai = 0; ai < 2; ++ai)
#pragma unroll
            for (int m = 0; m < 4; ++m) { bf16_t* rowp = C + (size_t)(row0 + ai * HALF + m * 16) * DM + col0;
#pragma unroll
                for (int bj = 0; bj < 2; ++bj) { const f32x4 v0 = acc[ai][bj][m][0], v1 = acc[ai][bj][m][1];
                    u32x4 w; w.x = cvt_pk_bf16(v0[0], v0[1]); w.y = cvt_pk_bf16(v0[2], v0[3]); w.z = cvt_pk_bf16(v1[0], v1[1]); w.w = cvt_pk_bf16(v1[2], v1[3]); *(u32x4*)(rowp + bj * HALF) = w; } }
    }
};
}
#endif

__device__ __forceinline__ void phase_gemm_in(const Params& p, int l, char* smem) {
    constexpr int N_F = WG / 2;
#ifdef EMU
    constexpr int MT = T / 128, NT1 = NMAIN / 128, N1 = MT * NT1, N2 = 8 * MT;
    for (int task = obid(); task < N1 + N2; task += gridDim.x) {
        if (task < N1) gemm_tile(p, (const bf16*)(p.ws + WS_HNY), (const bf16*)(p.ws + WS_WIN), DM, task / NT1, task % NT1, 0, smem);
        else { const int t2 = task - N1; gemm_tile(p, (const bf16*)(p.ws + WS_WIN) + (size_t)NMAIN * DM, (const bf16*)(p.ws + WS_HNY), DM, t2 / MT, t2 % MT, 2, smem); }
    }
#else
    { const pg8::Gemm g{(const pg8::bf16_t*)(p.ws + WS_HNY), (const pg8::bf16_t*)(p.ws + WS_HNY), 0, 0, DM};
      const pg8::InOrder S{(int)gridDim.x, obid()};
      const pg8::EpiIn E{(pg8::bf16_t*)(p.ws + WS_P), (float*)(p.ws + WS_G), (pg8::bf16_t*)(p.ws + WS_HT)};
      pg8::gemm_phase<pg8::EpiIn, pg8::InOrder, true, true>((PG8_LAS unsigned char*)smem, g, S, E); }
#endif
    { const int G = (int)gridDim.x, bid = obid();
#ifdef EMU
      const int extra = 0;
#else
      const int extra = (pg8::NU1 + pg8::NU2) % G;
#endif
      if (extra > 0 && extra < G) { if (bid >= extra) for (int task = bid - extra; task < N_F; task += G - extra) filt_fft_task(p, task, smem); }
      else for (int task = G - 1 - bid; task < N_F; task += G) filt_fft_task(p, task, smem); }
}
__device__ __forceinline__ void phase_gemm_out(const Params& p, int l, char* smem) {
    const int G = (int)gridDim.x, bid = obid(); const bool has_ctx = l < DEPTH - 1;
#ifdef EMU
    constexpr int MT = T / 128, NTO = DM / 128;
    for (int task = bid; task < MT * NTO; task += G) {
        const int mt = task / NTO, nt = task % NTO;
        if (!has_ctx && (mt % (TOK / 128)) < CTXL / 128) continue;
        gemm_tile(p, (const bf16*)(p.ws + WS_HNY), (const bf16*)(p.ws + WS_WOUT), MIX, mt, nt, 1, smem);
        __syncthreads(); if (otid() == 0) *unit_counter(p, (mt % (TOK / 128)) < CTXL / 128 ? 1 : 0) += 1u;
    }
#else
    const pg8::Gemm g{(const pg8::bf16_t*)(p.ws + WS_HNY), (const pg8::bf16_t*)(p.ws + WS_WOUT), 0, 0, MIX};
    const unsigned xcc = (unsigned)__builtin_amdgcn_s_getreg((3 << 11) | 20) & 0xFu, nloc = ((volatile PG8_LAS unsigned*)(smem + LDS_BYTES - 64))[0];
    const bool agg = (NB * (SEQ / 256) * (DM / 256) == G) && nloc > 0u;
    const pg8::OutOrder S{G, bid, !has_ctx, unit_counter(p, 0), unit_counter(p, 2) + 16 * xcc, nloc, agg ? nloc * (unsigned)(l + 1) : 0u};
    const pg8::EpiOut E{(pg8::bf16_t*)(p.ws + WS_P)};
    pg8::gemm_phase<pg8::EpiOut, pg8::OutOrder, true, true>((PG8_LAS unsigned char*)smem, g, S, E);
#endif
}

__device__ __forceinline__ size_t st_index(int mixer, int dir, int b, int h, int cid) { return ((((size_t)(mixer * 2 + dir) * NB + b) * NH + h) * NCH + cid); }
__device__ __forceinline__ size_t ch_index(int dir, int b, int h, int cid) { return (((size_t)dir * NB + b) * NH + h) * NCH + cid; }

__device__ __forceinline__ void load_tile_nat(const bf16* P, int r0, int c0, bf16* dst, float scale, int tid) {
    const int s = tid >> 3, c8 = tid & 7;
    const u32x4 v = *(const u32x4*)(P + (size_t)(r0 + s) * NP + c0 + c8 * 8);
    if (scale == 1.0f) *(u32x4*)(dst + s * LS + c8 * 8) = v;
    else { float f[8]; unpack8(v, f); u32x4 o; o.x = pk2(f[0] * scale, f[1] * scale); o.y = pk2(f[2] * scale, f[3] * scale); o.z = pk2(f[4] * scale, f[5] * scale); o.w = pk2(f[6] * scale, f[7] * scale);
        *(u32x4*)(dst + s * LS + c8 * 8) = o; }
}
__device__ __forceinline__ void load_tile_tr(const bf16* P, int r0, int c0, bf16* dst, int tid) {
    const int s = tid >> 3, c8 = tid & 7;
    const u32x4 v = *(const u32x4*)(P + (size_t)(r0 + s) * NP + c0 + c8 * 8);
    const unsigned w[4] = {v.x, v.y, v.z, v.w};
#pragma unroll
    for (int j = 0; j < 4; ++j) { dst[(c8 * 8 + 2 * j) * LS + s] = (bf16)(w[j] & 0xffffu); dst[(c8 * 8 + 2 * j + 1) * LS + s] = (bf16)(w[j] >> 16); }
}

template <int NTK>
__device__ __forceinline__ void load_span(const bf16* row, int t0, float (&v)[NTK + 2]) {
    { const bool hl = t0 > 0, hr = t0 + NTK < SEQ; const bf16 xl = row[hl ? -1 : 0], xr = row[hr ? NTK : 0];
        v[0] = hl ? bf2f(xl) : 0.f; v[NTK + 1] = hr ? bf2f(xr) : 0.f; }
    if constexpr (NTK == 8) { float f[8]; unpack8(*(const u32x4*)row, f);
#pragma unroll
        for (int i = 0; i < 8; ++i) v[1 + i] = f[i]; }
    else {
#pragma unroll
        for (int i = 0; i < NTK; ++i) v[1 + i] = bf2f(row[i]); }
}
struct SpanRaw { u32x4 b; bf16 xl, xr; };
__device__ __forceinline__ SpanRaw span_load8(const bf16* row, int t0) { SpanRaw s; const bool hl = t0 > 0, hr = t0 + 8 < SEQ; s.xl = row[hl ? -1 : 0]; s.xr = row[hr ? 8 : 0]; s.b = *(const u32x4*)row; return s; }
__device__ __forceinline__ void span_expand8(const SpanRaw& s, int t0, float (&v)[10]) { float f[8]; unpack8(s.b, f); v[0] = t0 > 0 ? bf2f(s.xl) : 0.f; v[9] = (t0 + 8 < SEQ) ? bf2f(s.xr) : 0.f;
#pragma unroll
    for (int i = 0; i < 8; ++i) v[1 + i] = f[i]; }
template <int NTK>
__device__ __forceinline__ void hy_inputs(const bf16* h0, const bf16* h1, const float* cw, const float* cb, int c, int t0, float (&u0)[NTK], float (&u1)[NTK], float (&g0)[NTK], float (&g1)[NTK]) {
    if constexpr (NTK == 8) {
        const SpanRaw rxa = span_load8(h0 + (size_t)512 * T, t0), rxb = span_load8(h1 + (size_t)512 * T, t0), rga = span_load8(h0 + (size_t)768 * T, t0), rgb = span_load8(h1 + (size_t)768 * T, t0);
        const SpanRaw rva = span_load8(h0, t0), rvb = span_load8(h1, t0), rya = span_load8(h0 + (size_t)256 * T, t0), ryb = span_load8(h1 + (size_t)256 * T, t0);
        const float w0 = cw[0 * 768 + 512 + c], w1 = cw[1 * 768 + 512 + c], w2 = cw[2 * 768 + 512 + c], bb = cb[512 + c];
        const float v0 = cw[0 * 768 + c], v1 = cw[1 * 768 + c], v2 = cw[2 * 768 + c], vbias = cb[c];
        const float y0 = cw[0 * 768 + 256 + c], y1 = cw[1 * 768 + 256 + c], y2 = cw[2 * 768 + 256 + c], ybias = cb[256 + c];
        SCHED_FENCE();
        { float xa[10], xb[10], ga[10], gb[10]; span_expand8(rxa, t0, xa); span_expand8(rxb, t0, xb); span_expand8(rga, t0, ga); span_expand8(rgb, t0, gb);
#pragma unroll
            for (int i = 0; i < 8; ++i) { g0[i] = (w0 * xa[i] + w1 * xa[i + 1] + w2 * xa[i + 2] + bb) * siluf_(ga[i + 1]); g1[i] = (w0 * xb[i] + w1 * xb[i + 1] + w2 * xb[i + 2] + bb) * siluf_(gb[i + 1]); } }
        { float va[10], vb[10], ya[10], yb[10]; span_expand8(rva, t0, va); span_expand8(rvb, t0, vb); span_expand8(rya, t0, ya); span_expand8(ryb, t0, yb);
#pragma unroll
            for (int i = 0; i < 8; ++i) { u0[i] = (v0 * va[i] + v1 * va[i + 1] + v2 * va[i + 2] + vbias) * (y0 * ya[i] + y1 * ya[i + 1] + y2 * ya[i + 2] + ybias);
                u1[i] = (v0 * vb[i] + v1 * vb[i + 1] + v2 * vb[i + 2] + vbias) * (y0 * yb[i] + y1 * yb[i + 1] + y2 * yb[i + 2] + ybias); } }
        return;
    }
    { float xa[NTK + 2], xb[NTK + 2]; load_span<NTK>(h0 + (size_t)512 * T, t0, xa); load_span<NTK>(h1 + (size_t)512 * T, t0, xb);
        const float w0 = cw[0 * 768 + 512 + c], w1 = cw[1 * 768 + 512 + c], w2 = cw[2 * 768 + 512 + c], bb = cb[512 + c];
        float ga[NTK + 2], gb[NTK + 2]; load_span<NTK>(h0 + (size_t)768 * T, t0, ga); load_span<NTK>(h1 + (size_t)768 * T, t0, gb);
#pragma unroll
        for (int i = 0; i < NTK; ++i) { g0[i] = (w0 * xa[i] + w1 * xa[i + 1] + w2 * xa[i + 2] + bb) * siluf_(ga[i + 1]); g1[i] = (w0 * xb[i] + w1 * xb[i + 1] + w2 * xb[i + 2] + bb) * siluf_(gb[i + 1]); } }
    { float va[NTK + 2], vb[NTK + 2], ya[NTK + 2], yb[NTK + 2];
        load_span<NTK>(h0, t0, va); load_span<NTK>(h1, t0, vb); load_span<NTK>(h0 + (size_t)256 * T, t0, ya); load_span<NTK>(h1 + (size_t)256 * T, t0, yb);
        const float v0 = cw[0 * 768 + c], v1 = cw[1 * 768 + c], v2 = cw[2 * 768 + c], vbias = cb[c];
        const float y0 = cw[0 * 768 + 256 + c], y1 = cw[1 * 768 + 256 + c], y2 = cw[2 * 768 + 256 + c], ybias = cb[256 + c];
#pragma unroll
        for (int i = 0; i < NTK; ++i) { u0[i] = (v0 * va[i] + v1 * va[i + 1] + v2 * va[i + 2] + vbias) * (y0 * ya[i] + y1 * ya[i + 1] + y2 * ya[i + 2] + ybias);
            u1[i] = (v0 * vb[i] + v1 * vb[i + 1] + v2 * vb[i + 2] + vbias) * (y0 * yb[i] + y1 * yb[i + 1] + y2 * yb[i + 2] + ybias); } }
}
__device__ __forceinline__ void hylat_task(const Params& p, int l, int bp, int cp, char* smem) {
    const int tid = otid(), half = tid >> 8, tl = tid & 255, c = 2 * cp + half;
    const bf16* HT = (const bf16*)(p.ws + WS_HT); bf16* Y = (bf16*)(p.ws + WS_HNY);
    cpx* buf = (cpx*)smem + (size_t)half * FBUF;
    const cpx* TW = (const cpx*)(p.ws + WS_TW);
    const cpx* KF = (const cpx*)(p.ws + WS_KF) + (size_t)c * NF;
    constexpr int NTK = SEQ / 256;
    const int t0 = NTK * tl;
    const float* cw = p.in[I_HCW] + (size_t)l * 3 * 768; const float* cb = p.in[I_HCB] + (size_t)l * 768;
    const size_t rb0 = (size_t)(2 * bp) * TOK + CTXL, rb1 = rb0 + TOK;
    const bf16* h0 = HT + (size_t)c * T + rb0 + t0; const bf16* h1 = h0 + TOK;
    { float u0[NTK], u1[NTK], g0[NTK], g1[NTK]; hy_inputs<NTK>(h0, h1, cw, cb, c, t0, u0, u1, g0, g1);
        __syncthreads();
#pragma unroll
        for (int i = 0; i < NTK; ++i) { cpx v; v.x = u0[i]; v.y = u1[i]; buf[FPH(t0 + i)] = v; cpx z = {0.f, 0.f}; buf[FPH(SEQ + t0 + i)] = z; } }
    fft_fwd(buf, TW, tl);
#pragma unroll 2
    for (int i = tl; i < NF; i += 256) buf[FPH(i)] = cmul(buf[FPH(i)], KF[i]);
    fft_inv(buf, TW, tl);
    const float dsk = p.in[I_HD][(size_t)l * WG + c]; const float sc = 1.0f / (float)NF;
    { const int tz = otid() & 255; const int t0z = NTK * tz;
        float u0[NTK], u1[NTK], g0[NTK], g1[NTK]; hy_inputs<NTK>(HT + (size_t)c * T + rb0 + t0z, HT + (size_t)c * T + rb0 + t0z + TOK, cw, cb, c, t0z, u0, u1, g0, g1);
        float o0[NTK], o1[NTK];
#pragma unroll
        for (int i = 0; i < NTK; ++i) { const cpx y = buf[FPH(t0z + i)]; o0[i] = g0[i] * (y.x * sc + u0[i] * dsk); o1[i] = g1[i] * (y.y * sc + u1[i] * dsk); }
        bf16* d0 = (bf16*)(p.ws + WS_HT) + (size_t)(768 + c) * T + rb0 + t0z; bf16* d1 = d0 + TOK;
        if constexpr (NTK == 8) { *(u32x4*)d0 = pack8(o0); *(u32x4*)d1 = pack8(o1); }
        else {
#pragma unroll
            for (int i = 0; i < NTK; ++i) { d0[i] = f2bf(o0[i]); d1[i] = f2bf(o1[i]); } } }
}

constexpr int HCB = 16;
__device__ __forceinline__ void hyctx_task(const Params& p, int l, int b, int cblk, char* smem) {
    const int tid = otid(); const int c0 = cblk * HCB;
    const bf16* HT = (const bf16*)(p.ws + WS_HT); bf16* Y = (bf16*)(p.ws + WS_HNY); const float* HC = (const float*)(p.ws + WS_HC);
    float* raw = (float*)smem;
    float* u = raw + 4 * CTXL * HCB;
    float* og = u + CTXL * HCB;
    float* hcm = og + CTXL * HCB;
    bf16* ob = (bf16*)raw;
    const size_t rb = (size_t)b * TOK;
    const float* cw = p.in[I_HCW] + (size_t)l * 3 * 768; const float* cbias = p.in[I_HCB] + (size_t)l * 768;
    constexpr int WT = CTXL / 32;
    __syncthreads();
    for (int i = tid; i < 4 * HCB * (CTXL / 8); i += NT) { const int k = i / (HCB * (CTXL / 8)), cc = (i / (CTXL / 8)) % HCB, ck = i % (CTXL / 8);
        float f[8]; unpack8(*(const u32x4*)(HT + (size_t)(k * 256 + c0 + cc) * T + rb + ck * 8), f);
#pragma unroll
        for (int j = 0; j < 8; ++j) raw[(k * CTXL + ck * 8 + j) * HCB + cc] = f[j]; }
    for (int i = tid; i < 2 * HCB * (CTXL / 4); i += NT) { const int dir = i / (HCB * (CTXL / 4)), cc = (i / (CTXL / 4)) % HCB, pk = i % (CTXL / 4);
        const f32x4 v = *(const f32x4*)(HC + ((size_t)dir * WG + c0 + cc) * CTXL + pk * 4); const float f[4] = {v.x, v.y, v.z, v.w};
#pragma unroll
        for (int j = 0; j < 4; ++j) { const int pos = pk * 4 + j; if (dir == 0) hcm[(CTXL + pos) * HCB + cc] = f[j]; else if (pos > 0) hcm[(CTXL - pos) * HCB + cc] = f[j]; } }
    if (tid < HCB) hcm[tid] = 0.f;
    __syncthreads();
    static_assert(NT % HCB == 0, "a thread keeps its channel over the passes: its 12 filter taps are loaded once");
    float tw0[3], tw1[3], tw2[3], tbs[3];
#pragma unroll
    for (int k = 0; k < 3; ++k) { const int ch = k * 256 + c0 + tid % HCB; tw0[k] = cw[0 * 768 + ch]; tw1[k] = cw[1 * 768 + ch]; tw2[k] = cw[2 * 768 + ch]; tbs[k] = cbias[ch]; }
    for (int i = tid; i < CTXL * HCB; i += NT) { const int t = i / HCB, cc = i % HCB; float cv[3];
#pragma unroll
        for (int k = 0; k < 3; ++k) { const float* rk = raw + k * CTXL * HCB;
            const float a = t > 0 ? rk[(t - 1) * HCB + cc] : 0.f, m = rk[t * HCB + cc], z = t < CTXL - 1 ? rk[(t + 1) * HCB + cc] : 0.f;
            cv[k] = tw0[k] * a + tw1[k] * m + tw2[k] * z + tbs[k]; }
        u[i] = cv[0] * cv[1];
        og[i] = cv[2] * siluf_(raw[(3 * CTXL + t) * HCB + cc]); }
    __syncthreads();
    { const int cc = tid % HCB, tg = tid / HCB, t0 = WT * tg; float acc[WT], w[WT];
#pragma unroll
        for (int j = 0; j < WT; ++j) { acc[j] = 0.f; w[j] = hcm[(t0 + j + CTXL) * HCB + cc]; }
#pragma unroll 8
        for (int s = 0; s < CTXL; ++s) { const float us = u[s * HCB + cc];
#pragma unroll
            for (int j = 0; j < WT; ++j) acc[j] += us * w[j];
#pragma unroll
            for (int j = WT - 1; j > 0; --j) w[j] = w[j - 1];
            w[0] = hcm[(t0 - s - 1 + CTXL) * HCB + cc]; }
        const float dsk = p.in[I_HD][(size_t)l * WG + c0 + cc];
#pragma unroll
        for (int j = 0; j < WT; ++j) { const int t = t0 + j; ob[t * HCB + cc] = f2bf(og[t * HCB + cc] * (acc[j] + u[t * HCB + cc] * dsk)); } }
    __syncthreads();
    for (int i = tid; i < CTXL * 2; i += NT) { const int t = i >> 1, hh = i & 1; *(u32x4*)(Y + (rb + t) * 1024 + YH + c0 + 8 * hh) = *(const u32x4*)(ob + t * HCB + 8 * hh); }
}

__device__ __forceinline__ void attn_task(const Params& p, int l, int b, int kvh, int qt, bool ctxq, char* smem) {
    const int tid = otid(), lane = tid & 63, wave = tid >> 6, r = lane & 15, q = lane >> 4;
    constexpr float QSC = 0.125f * 1.4426950408889634f;
    const bf16* P = (const bf16*)(p.ws + WS_P); bf16* Y = (bf16*)(p.ws + WS_HNY); const cpx* ROPE = (const cpx*)(p.ws + WS_ROPE);
    bf16* Qs = (bf16*)smem;
    bf16* Ks = Qs + 256 * LS;
    constexpr int LSV = 80;
    bf16* Vt = Ks + 64 * LS;
    bf16* Ps = Vt + 64 * LS;
    const size_t rq0 = (size_t)b * TOK + (ctxq ? 0 : CTXL) + qt * 128;
    __syncthreads();
    {
        u32x4 qlo[2], qhi[2]; f32x4 qrp[2][4];
#pragma unroll
        for (int it = 0; it < 2; ++it) { const int idx = tid + NT * it, row = idx >> 2, cpair = idx & 3, g = row >> 7, t = row & 127;
            const bf16* src = P + (rq0 + t) * NP + PD + (kvh * 2 + g) * 64; qlo[it] = *(const u32x4*)(src + cpair * 8); qhi[it] = *(const u32x4*)(src + 32 + cpair * 8);
            if (!ctxq) { const f32x4* rr = (const f32x4*)(ROPE + (size_t)(qt * 128 + t) * 32 + cpair * 8); qrp[it][0] = rr[0]; qrp[it][1] = rr[1]; qrp[it][2] = rr[2]; qrp[it][3] = rr[3]; }
            else { qrp[it][0] = qrp[it][1] = qrp[it][2] = qrp[it][3] = (f32x4){1.f, 0.f, 1.f, 0.f}; } }
        SCHED_FENCE();
#pragma unroll
        for (int it = 0; it < 2; ++it) { const int idx = tid + NT * it, row = idx >> 2, cpair = idx & 3;
            float lo[8], hi[8]; unpack8(qlo[it], lo); unpack8(qhi[it], hi);
            const float cs[8] = {qrp[it][0].x, qrp[it][0].z, qrp[it][1].x, qrp[it][1].z, qrp[it][2].x, qrp[it][2].z, qrp[it][3].x, qrp[it][3].z}, sn[8] = {qrp[it][0].y, qrp[it][0].w, qrp[it][1].y, qrp[it][1].w, qrp[it][2].y, qrp[it][2].w, qrp[it][3].y, qrp[it][3].w};
            float a[8], c2[8];
#pragma unroll
            for (int j = 0; j < 8; ++j) { a[j] = (lo[j] * cs[j] - hi[j] * sn[j]) * QSC; c2[j] = (hi[j] * cs[j] + lo[j] * sn[j]) * QSC; }
            *(u32x4*)(Qs + row * LS + cpair * 8) = pack8(a); *(u32x4*)(Qs + row * LS + 32 + cpair * 8) = pack8(c2); } }
    const int lt0 = ctxq ? 0 : (2 * qt - 2 > 0 ? 2 * qt - 2 : 0), lt1 = ctxq ? -1 : (2 * qt + 3 < SEQ / 64 - 1 ? 2 * qt + 3 : SEQ / 64 - 1);
    const int nloc = lt1 - lt0 + 1, ntiles = nloc + NCC;
    float m[2], lsum[2]; f32x4 O[2][4];
#pragma unroll
    for (int ms = 0; ms < 2; ++ms) { m[ms] = -INFINITY; lsum[ms] = 0.f;
#pragma unroll
        for (int i = 0; i < 4; ++i) O[ms][i] = (f32x4){0.f, 0.f, 0.f, 0.f}; }
    const int g = wave >> 2, tq0 = (wave & 3) * 32;
    (void)Ps;
    __syncthreads();
    bf16x8 qf[2][2];
#pragma unroll
    for (int ms = 0; ms < 2; ++ms)
#pragma unroll
        for (int ks = 0; ks < 2; ++ks) qf[ms][ks] = *(const bf16x8*)(Qs + (g * 128 + tq0 + 16 * ms + r) * LS + ks * 32 + q * 8);
    u32x4 klo = {0u, 0u, 0u, 0u}, khi = klo, vq = klo; f32x4 rp[4] = {(f32x4){1.f, 0.f, 1.f, 0.f}, (f32x4){1.f, 0.f, 1.f, 0.f}, (f32x4){1.f, 0.f, 1.f, 0.f}, (f32x4){1.f, 0.f, 1.f, 0.f}};
    const int ks_ = tid >> 2, kcp = tid & 3, vs_ = tid >> 3, vc8 = tid & 7;
#define ATT_PREFETCH(TI) do { const bool loc_ = (TI) < nloc; const int kt_ = loc_ ? lt0 + (TI) : (TI) - nloc; const size_t rk_ = (size_t)b * TOK + (loc_ ? CTXL : 0) + kt_ * 64; \
        if (tid < 256) { const bf16* src_ = P + (rk_ + ks_) * NP + PD + 256 + kvh * 64; klo = *(const u32x4*)(src_ + kcp * 8); khi = *(const u32x4*)(src_ + 32 + kcp * 8); \
            if (loc_) { const f32x4* rr_ = (const f32x4*)(ROPE + (size_t)(kt_ * 64 + ks_) * 32 + kcp * 8); rp[0] = rr_[0]; rp[1] = rr_[1]; rp[2] = rr_[2]; rp[3] = rr_[3]; } \
            else { rp[0] = rp[1] = rp[2] = rp[3] = (f32x4){1.f, 0.f, 1.f, 0.f}; } } \
        vq = *(const u32x4*)(P + (rk_ + vs_) * NP + PD + 384 + kvh * 64 + vc8 * 8); } while (0)
    ATT_PREFETCH(0);
    for (int ti = 0; ti < ntiles; ++ti) {
        const bool local = ti < nloc; const int kt = local ? lt0 + ti : ti - nloc;
        __syncthreads();
        if (tid < 256) { float lo[8], hi[8]; unpack8(klo, lo); unpack8(khi, hi);
            const float cs[8] = {rp[0].x, rp[0].z, rp[1].x, rp[1].z, rp[2].x, rp[2].z, rp[3].x, rp[3].z}, sn[8] = {rp[0].y, rp[0].w, rp[1].y, rp[1].w, rp[2].y, rp[2].w, rp[3].y, rp[3].w};
            float a[8], c2[8];
#pragma unroll
            for (int j = 0; j < 8; ++j) { a[j] = lo[j] * cs[j] - hi[j] * sn[j]; c2[j] = hi[j] * cs[j] + lo[j] * sn[j]; }
            *(u32x4*)(Ks + ks_ * LS + kcp * 8) = pack8(a); *(u32x4*)(Ks + ks_ * LS + 32 + kcp * 8) = pack8(c2); }
        *(u32x4*)(Vt + vs_ * LSV + vc8 * 8) = vq;
        __syncthreads();
        if (ti + 1 < ntiles) ATT_PREFETCH(ti + 1);
        bf16x8 kfr[4][2], vfa[4], vfb[4];
#pragma unroll
        for (int nt = 0; nt < 4; ++nt)
#pragma unroll
            for (int ks = 0; ks < 2; ++ks) kfr[nt][ks] = *(const bf16x8*)(Ks + (16 * nt + r) * LS + ks * 32 + q * 8);
#pragma unroll
        for (int me = 0; me < 4; ++me) { const bf16* vr = Vt + (4 * q + (r >> 2)) * LSV + 16 * me + 4 * (r & 3);
            const u32x2 a0 = lds_tr16(vr), a1 = lds_tr16(vr + 16 * LSV), a2 = lds_tr16(vr + 32 * LSV), a3 = lds_tr16(vr + 48 * LSV);
            u32x4 va; va.x = a0.x; va.y = a0.y; va.z = a1.x; va.w = a1.y; u32x4 vb; vb.x = a2.x; vb.y = a2.y; vb.z = a3.x; vb.w = a3.y; vfa[me] = as_frag(va); vfb[me] = as_frag(vb); }
#pragma unroll
        for (int ms = 0; ms < 2; ++ms) {
            const int qlo = qt * 128 + tq0 + 16 * ms, klo_ = kt * 64;
            if (local && (klo_ > qlo + 15 + 128 || klo_ + 63 < qlo - 128)) continue;
            const bool domask = local && (klo_ + 63 - qlo > 128 || klo_ - (qlo + 15) < -128);
            f32x4 S[4] = {(f32x4){0.f, 0.f, 0.f, 0.f}, (f32x4){0.f, 0.f, 0.f, 0.f}, (f32x4){0.f, 0.f, 0.f, 0.f}, (f32x4){0.f, 0.f, 0.f, 0.f}};
#pragma unroll
            for (int ks = 0; ks < 2; ++ks)
#pragma unroll
                for (int nt = 0; nt < 4; ++nt) S[nt] = MFMA16(kfr[nt][ks], qf[ms][ks], S[nt]);
            const int qpos = qlo + r; float mx = -INFINITY;
            if (domask) {
#pragma unroll
                for (int nt = 0; nt < 4; ++nt)
#pragma unroll
                    for (int i = 0; i < 4; ++i) { const int d = kt * 64 + nt * 16 + 4 * q + i - qpos; if (d > 128 || d < -128) S[nt][i] = -INFINITY; } }
#pragma unroll
            for (int nt = 0; nt < 4; ++nt)
#pragma unroll
                for (int i = 0; i < 4; ++i) mx = fmaxf(mx, S[nt][i]);
            mx = xrow_max(mx);
            const float mn = fmaxf(m[ms], mx); const float msafe = mn == -INFINITY ? 0.f : mn; const float alpha = EXP2(m[ms] - msafe); float sm = 0.f;
#pragma unroll
            for (int nt = 0; nt < 4; ++nt)
#pragma unroll
                for (int i = 0; i < 4; ++i) { S[nt][i] = EXP2(S[nt][i] - msafe); sm += S[nt][i]; }
            sm = xrow_sum(sm);
            lsum[ms] = lsum[ms] * alpha + sm; m[ms] = mn;
            const float pa[8] = {S[0][0], S[0][1], S[0][2], S[0][3], S[1][0], S[1][1], S[1][2], S[1][3]}, pb[8] = {S[2][0], S[2][1], S[2][2], S[2][3], S[3][0], S[3][1], S[3][2], S[3][3]};
            const bf16x8 p0 = as_frag(pack8(pa)), p1 = as_frag(pack8(pb));
#pragma unroll
            for (int me = 0; me < 4; ++me) { O[ms][me] = O[ms][me] * alpha;
                O[ms][me] = MFMA16(vfa[me], p0, O[ms][me]); O[ms][me] = MFMA16(vfb[me], p1, O[ms][me]); }
        }
    }
#undef ATT_PREFETCH
    const float sink = p.in[I_SINK][(size_t)l * NH + kvh * 2 + g];
    u32x2 ggs[2][4];
#pragma unroll
    for (int ms = 0; ms < 2; ++ms)
#pragma unroll
        for (int me = 0; me < 4; ++me) ggs[ms][me] = *(const u32x2*)(P + (rq0 + tq0 + 16 * ms + r) * NP + PD + 512 + (kvh * 2 + g) * 64 + 4 * q + 16 * me);
#pragma unroll
    for (int ms = 0; ms < 2; ++ms) { const float den = lsum[ms] + EXP2(sink * 1.4426950408889634f - m[ms]); const float inv = frcp_(den);
        const size_t row = rq0 + tq0 + 16 * ms + r; const int col = (kvh * 2 + g) * 64 + 4 * q;
#pragma unroll
        for (int me = 0; me < 4; ++me) { const u32x2 gg = ggs[ms][me];
            const float g0 = bitsf(gg.x << 16), g1 = bitsf(gg.x & 0xffff0000u), g2 = bitsf(gg.y << 16), g3 = bitsf(gg.y & 0xffff0000u);
            u32x2 o; o.x = pk2(O[ms][me][0] * inv * siluf_(g0), O[ms][me][1] * inv * siluf_(g1)); o.y = pk2(O[ms][me][2] * inv * siluf_(g2), O[ms][me][3] * inv * siluf_(g3));
            *(u32x2*)(Y + row * 1024 + YD + col + 16 * me) = o; } }
}

#ifdef EMU
__device__ __forceinline__ int olane(int lane) { return lane; }
#else
__device__ __forceinline__ int olane(int lane) { asm volatile("" : "+v"(lane)); return lane; }
#endif
__device__ __forceinline__ void load_nat_tile(const bf16* P, int row0, int col0, bf16* tile, int lane) {
    u32x4 v[8];
#pragma unroll
    for (int i = 0; i < 8; ++i) v[i] = *(const u32x4*)(P + (size_t)(row0 + (lane >> 3) + 8 * i) * NP + col0 + (lane & 7) * 8);
#pragma unroll
    for (int i = 0; i < 8; ++i) *(u32x4*)(tile + swz((lane >> 3) + 8 * i, lane & 7)) = v[i];
}
__device__ __forceinline__ bf16x8 frag_tr(const bf16* tile, int c0, int k0, int lane) {
    const int c = c0 + (lane & 15), kb = k0 + 8 * (lane >> 4); unsigned w[4];
#pragma unroll
    for (int j = 0; j < 4; ++j) w[j] = (unsigned)tile[swz(kb + 2 * j, c >> 3) + (c & 7)] | ((unsigned)tile[swz(kb + 2 * j + 1, c >> 3) + (c & 7)] << 16);
    u32x4 o; o.x = w[0]; o.y = w[1]; o.z = w[2]; o.w = w[3]; return as_frag(o);
}
__device__ __forceinline__ bf16x8 frag_tr_hw(const bf16* tile, int c0, int k0, int lane) {
    const int r = lane & 15, q = lane >> 4, row = k0 + 8 * q + (r >> 2), col = c0 + 4 * (r & 3);
    const u32x2 a = lds_tr16(tile + swz(row, col >> 3) + (col & 7)), b = lds_tr16(tile + swz(row + 4, col >> 3) + (col & 7));
    u32x4 o; o.x = a.x; o.y = a.y; o.z = b.x; o.w = b.y; return as_frag(o);
}
template <int DIR>
__device__ __forceinline__ void gla_r_frags(const float* Grow0, int lane, bf16x8 (&af)[4]) {
    const int r = lane & 15, q4 = lane >> 4;
#pragma unroll
    for (int mt = 0; mt < 4; ++mt) { u32x4 o = {0u, 0u, 0u, 0u};
        if (q4 < 2) o = *(const u32x4*)((const bf16*)(Grow0 + (size_t)(16 * mt + r) * NGS + 16) + DIR * 16 + 8 * q4);
        af[mt] = as_frag(o); }
}
template <int DIR>
__device__ __forceinline__ void gla_b_load(const Params& p, int l, int h, int nt, int lane_, u32x4& o, float& bias) {
    const int lane = olane(lane_), r = lane & 15, q4 = lane >> 4, d = h * 64 + 16 * nt + r;
    const float* wa = p.in[I_GWA] + ((size_t)(l * 2 + DIR) * 16 + 8 * (q4 & 1)) * WG + d;
    float w[8];
#pragma unroll
    for (int j = 0; j < 8; ++j) w[j] = wa[j * WG];
    bias = p.in[I_GBA][(size_t)(l * 2 + DIR) * WG + d];
    o.x = pk2(w[0], w[1]); o.y = pk2(w[2], w[3]); o.z = pk2(w[4], w[5]); o.w = pk2(w[6], w[7]);
    if (q4 >= 2) o = (u32x4){0u, 0u, 0u, 0u};
}
template <int DIR>
__device__ __forceinline__ float gla_b_col(const u32x4 o, const float bias, const bf16x8 (&af)[4], int lane_, float (&x)[4][4]) {
    const int lane = olane(lane_), r = lane & 15, q4 = lane >> 4;
    const bf16x8 bfr = as_frag(o);
#pragma unroll
    for (int mt = 0; mt < 4; ++mt) { f32x4 c = {bias, bias, bias, bias}; c = MFMA16(af[mt], bfr, c);
#pragma unroll
        for (int i = 0; i < 4; ++i) x[mt][i] = logsig_fast(c[i]) * (1.0f / 16.0f); }
    float carry = 0.f;
#pragma unroll
    for (int k = 0; k < 4; ++k) { const int mt = DIR == 0 ? k : 3 - k; float* y = x[mt];
        if (DIR == 0) { y[1] += y[0]; y[2] += y[1]; y[3] += y[2]; } else { y[2] += y[3]; y[1] += y[2]; y[0] += y[1]; }
        const float s4 = DIR == 0 ? y[3] : y[0];
        float e, tot; xrow_scan<DIR>(s4, lane, e, tot);
#pragma unroll
        for (int i = 0; i < 4; ++i) y[i] += carry + e;
        carry += tot; }
    return carry;
}

template <int MIXER, int DIR>
__device__ __forceinline__ void chunkst_dir(const Params& p, int l, int b, int h, int cid, const float* Grow0, const unsigned (&kk)[32], const bf16* Vt, bf16* Kt, const float* wvs, float* bendl, int lane_) {
    const int lane = olane(lane_), r = lane & 15, q4 = lane >> 4;
    if constexpr (MIXER == 0) {
        float nacc = 0.f;
#pragma unroll
        for (int c = 0; c < 8; ++c) { float f[8];
#pragma unroll
            for (int j = 0; j < 8; ++j) { const int s = 8 * c + j; const float kv = (s & 1) ? bitsf(kk[s >> 1] & 0xffff0000u) : bitsf(kk[s >> 1] << 16);
                f[j] = kv * 0.125f * wvs[DIR * 64 + s]; nacc += f[j]; }
            *(u32x4*)(Kt + swz(lane, c)) = pack8(f); }
        ((float*)(p.ws + WS_NV))[ch_index(DIR, b, h, cid) * 64 + lane] = nacc;
    } else {
        const bf16* P = (const bf16*)(p.ws + WS_P); const int kcol = PG + 256 + h * 64; const int r0 = b * TOK + cid * 64;
        bf16x8 af[4]; gla_r_frags<DIR>(Grow0, lane, af);
#pragma unroll 2
        for (int nt = 0; nt < 4; ++nt) { const int d = 16 * nt + r; float x[4][4];
            u32x4 wo_; float wb_; gla_b_load<DIR>(p, l, h, nt, lane, wo_, wb_); const float bend = gla_b_col<DIR>(wo_, wb_, af, lane, x);
            if (q4 == 0) { ((float*)(p.ws + WS_BE))[ch_index(DIR, b, h, cid) * 64 + d] = bend; bendl[d] = __expf(fmaxf(bend, -80.0f)); }
#pragma unroll
            for (int mt = 0; mt < 4; ++mt)
#pragma unroll
                for (int i = 0; i < 4; ++i) { const int s = 16 * mt + 4 * q4 + i; const float kv = bf2f(P[(size_t)(r0 + s) * NP + kcol + d]); const float bc = fmaxf(x[mt][i], -80.0f);
                    Kt[swz(d, s >> 3) + (s & 7)] = f2bf(kv * __expf(-bc));
                    ((bf16*)(p.ws + WS_EQ))[((size_t)DIR * T + r0 + s) * WG + h * 64 + d] = f2bf(__expf(bc)); } }
    }
    WAVE_SYNC();
    bf16x8 vf[4][2];
#pragma unroll
    for (int ne = 0; ne < 4; ++ne)
#pragma unroll
        for (int ks = 0; ks < 2; ++ks) vf[ne][ks] = frag_tr_hw(Vt, 16 * ne, 32 * ks, lane);
    bf16* dst = (bf16*)(p.ws + WS_ST) + st_index(MIXER, DIR, b, h, cid) * 4096;
#pragma unroll
    for (int me = 0; me < 4; ++me) {
        f32x4 acc[4] = {(f32x4){0.f, 0.f, 0.f, 0.f}, (f32x4){0.f, 0.f, 0.f, 0.f}, (f32x4){0.f, 0.f, 0.f, 0.f}, (f32x4){0.f, 0.f, 0.f, 0.f}};
#pragma unroll
        for (int ks = 0; ks < 2; ++ks) { const bf16x8 a = *(const bf16x8*)(Kt + swz(16 * me + r, ks * 4 + q4));
#pragma unroll
            for (int ne = 0; ne < 4; ++ne) acc[ne] = MFMA16(a, vf[ne][ks], acc[ne]); }
        f32x4 sc4 = {1.f, 1.f, 1.f, 1.f}; if constexpr (MIXER == 1) sc4 = *(const f32x4*)(bendl + 16 * me + 4 * q4);
#pragma unroll
        for (int ne = 0; ne < 4; ++ne) { const f32x4 v = acc[ne] * sc4; u32x2 o; o.x = pk2(v[0], v[1]); o.y = pk2(v[2], v[3]); *(u32x2*)(dst + (16 * ne + r) * 64 + 16 * me + 4 * q4) = o; }
    }
    WAVE_SYNC();
}
template <int MIXER>
__device__ __forceinline__ void chunkst_w(const Params& p, int l, int b, int h, int cid, char* wl, int lane) {
    const bf16* P = (const bf16*)(p.ws + WS_P); const float* G = (const float*)(p.ws + WS_G);
    const int r0 = b * TOK + cid * 64, r = lane & 15, q4 = lane >> 4;
    bf16* Kt = (bf16*)wl;
    bf16* Vt = Kt + 4096;
    float* wvs = (float*)(Vt + 4096);
    float* bendl = wvs + 128;
    const int kcol = (MIXER == 0 ? PA : PG) + 256 + h * 64, vcol = (MIXER == 0 ? PA : PG) + 512 + h * 64;
    const float* Grow0 = G + (size_t)r0 * NGS;
    bf16* Nn = Kt;
    { u32x4 vv[8], kv[8];
#pragma unroll
        for (int i = 0; i < 8; ++i) { vv[i] = *(const u32x4*)(P + (size_t)(r0 + (lane >> 3) + 8 * i) * NP + vcol + (lane & 7) * 8); kv[i] = *(const u32x4*)(P + (size_t)(r0 + (lane >> 3) + 8 * i) * NP + kcol + (lane & 7) * 8); }
#pragma unroll
        for (int i = 0; i < 8; ++i) { *(u32x4*)(Vt + swz((lane >> 3) + 8 * i, lane & 7)) = vv[i]; *(u32x4*)(Nn + swz((lane >> 3) + 8 * i, lane & 7)) = kv[i]; } }
    WAVE_SYNC();
    unsigned kk[32];
    { const int dc = 16 * q4 + 4 * (r & 3);
#pragma unroll
        for (int c = 0; c < 16; ++c) { const u32x2 t = lds_tr16(Nn + swz(4 * c + (r >> 2), dc >> 3) + (dc & 7)); kk[2 * c] = t.x; kk[2 * c + 1] = t.y; } }
    WAVE_SYNC();
    if constexpr (MIXER == 0) {
        const float* g = Grow0 + (size_t)lane * NGS; const float* gb = p.in[I_MGB] + (size_t)l * 16;
        const float gv0 = g[h], gv1 = g[4 + h], gv2 = g[8 + h], gv3 = g[12 + h], bv0 = gb[h], bv1 = gb[4 + h], bv2 = gb[8 + h], bv3 = gb[12 + h];
        const float i_f = gv0 + bv0, f_f = gv1 + bv1, i_b = gv2 + bv2, f_b = gv3 + bv3;
        const float lf = logsigf_(f_f), lb = logsigf_(f_b);
        const float bF = wave_prefix_sum(lf, lane), totF = __shfl(bF, 63);
        const float gF = totF - bF + i_f, mF = wave_max(gF);
        const float totB = wave_sum(lb), preB = wave_prefix_sum(lb, lane), bB = totB - preB + lb;
        const float gB = totB - bB + i_b, mB = wave_max(gB);
        wvs[lane] = __expf(gF - mF); wvs[64 + lane] = __expf(gB - mB);
        if (lane == 0) { float* SC = (float*)(p.ws + WS_SC);
            SC[ch_index(0, b, h, cid) * 4 + 0] = totF; SC[ch_index(0, b, h, cid) * 4 + 1] = mF;
            SC[ch_index(1, b, h, cid) * 4 + 0] = totB; SC[ch_index(1, b, h, cid) * 4 + 1] = mB; }
    }
    WAVE_SYNC();
    chunkst_dir<MIXER, 0>(p, l, b, h, cid, Grow0, kk, Vt, Kt, wvs, bendl, lane);
    chunkst_dir<MIXER, 1>(p, l, b, h, cid, Grow0, kk, Vt, Kt, wvs, bendl, lane);
}

template <int DIR>
__device__ __forceinline__ void chunkst_gla(const Params& p, int l, int b, int h, int cid, char* wl, int lane_) {
    const bf16* P = (const bf16*)(p.ws + WS_P);
    const int lane = olane(lane_), r0 = b * TOK + cid * 64, r = lane & 15, q4 = lane >> 4;
    bf16* Kt = (bf16*)wl;
    bf16* An = Kt + 4096;
    float* bendl = (float*)(An + 4096);
    const int kcol = PG + 256 + h * 64, vcol = PG + 512 + h * 64;
    const float* Grow0 = (const float*)(p.ws + WS_G) + (size_t)r0 * NGS;
    u32x4 vv[8], kv[8];
#pragma unroll
    for (int i = 0; i < 8; ++i) { vv[i] = *(const u32x4*)(P + (size_t)(r0 + (lane >> 3) + 8 * i) * NP + vcol + (lane & 7) * 8); kv[i] = *(const u32x4*)(P + (size_t)(r0 + (lane >> 3) + 8 * i) * NP + kcol + (lane & 7) * 8); }
    bf16x8 af[4]; gla_r_frags<DIR>(Grow0, lane, af);
    u32x4 wo[4]; float wb[4];
#pragma unroll
    for (int nt = 0; nt < 4; ++nt) gla_b_load<DIR>(p, l, h, nt, lane, wo[nt], wb[nt]);
#pragma unroll
    for (int i = 0; i < 8; ++i) *(u32x4*)(An + swz((lane >> 3) + 8 * i, lane & 7)) = vv[i];
    WAVE_SYNC();
    bf16x8 vf[4][2];
#pragma unroll
    for (int ne = 0; ne < 4; ++ne)
#pragma unroll
        for (int ks = 0; ks < 2; ++ks) vf[ne][ks] = frag_tr_hw(An, 16 * ne, 32 * ks, lane);
    WAVE_SYNC();
#pragma unroll
    for (int i = 0; i < 8; ++i) *(u32x4*)(An + swz((lane >> 3) + 8 * i, lane & 7)) = kv[i];
    WAVE_SYNC();
#pragma unroll
    for (int nt = 0; nt < 4; ++nt) { const int d = 16 * nt + r; float x[4][4];
        const float bend = gla_b_col<DIR>(wo[nt], wb[nt], af, lane, x);
        if (q4 == 0) { ((float*)(p.ws + WS_BE))[ch_index(DIR, b, h, cid) * 64 + d] = bend; bendl[d] = __expf(fmaxf(bend, -80.0f)); }
#pragma unroll
        for (int mt = 0; mt < 4; ++mt) { const int s0 = 16 * mt + 4 * q4, dc = 16 * nt + 4 * (r & 3);
            const u32x2 kq = lds_tr16(An + swz(s0 + (r >> 2), dc >> 3) + (dc & 7));
            const float kv[4] = {bitsf(kq.x << 16), bitsf(kq.x & 0xffff0000u), bitsf(kq.y << 16), bitsf(kq.y & 0xffff0000u)}; float kp[4];
#pragma unroll
            for (int i = 0; i < 4; ++i) { const float bc = fmaxf(x[mt][i], -80.0f); kp[i] = kv[i] * __expf(-bc); An[swz(s0 + i, d >> 3) + (d & 7)] = f2bf(__expf(bc)); }
            u32x2 o; o.x = pk2(kp[0], kp[1]); o.y = pk2(kp[2], kp[3]); *(u32x2*)(Kt + swz(d, s0 >> 3) + (s0 & 7)) = o; } }
    WAVE_SYNC();
    { bf16* EQg = (bf16*)(p.ws + WS_EQ) + ((size_t)DIR * T + r0) * WG + h * 64;
#pragma unroll
        for (int i = 0; i < 8; ++i) { const int s = (lane >> 3) + 8 * i, ck = lane & 7; *(u32x4*)(EQg + (size_t)s * WG + ck * 8) = *(const u32x4*)(An + swz(s, ck)); } }
    bf16* dst = (bf16*)(p.ws + WS_ST) + st_index(1, DIR, b, h, cid) * 4096;
#pragma unroll
    for (int me = 0; me < 4; ++me) {
        f32x4 acc[4] = {(f32x4){0.f, 0.f, 0.f, 0.f}, (f32x4){0.f, 0.f, 0.f, 0.f}, (f32x4){0.f, 0.f, 0.f, 0.f}, (f32x4){0.f, 0.f, 0.f, 0.f}};
#pragma unroll
        for (int ks = 0; ks < 2; ++ks) { const bf16x8 a = *(const bf16x8*)(Kt + swz(16 * me + r, ks * 4 + q4));
#pragma unroll
            for (int ne = 0; ne < 4; ++ne) acc[ne] = MFMA16(a, vf[ne][ks], acc[ne]); }
        const f32x4 sc4 = *(const f32x4*)(bendl + 16 * me + 4 * q4);
#pragma unroll
        for (int ne = 0; ne < 4; ++ne) { const f32x4 v = acc[ne] * sc4; u32x2 o; o.x = pk2(v[0], v[1]); o.y = pk2(v[2], v[3]); *(u32x2*)(dst + (16 * ne + r) * 64 + 16 * me + 4 * q4) = o; }
    }
    WAVE_SYNC();
}

template <int MIXER, int DIR>
__device__ __forceinline__ void chunkout_prep(const Params& p, int l, int b, int h, int cid, const float* Grow0, int r0, int pbase, const bf16* EQ, float* gar, int lane_) {
    const int lane = olane(lane_);
    if constexpr (MIXER == 0) {
        const bf16* P = (const bf16*)(p.ws + WS_P);
        const float* g = Grow0 + (size_t)lane * NGS; const float* gb = p.in[I_MGB] + (size_t)l * 16;
        const float gi = g[DIR * 8 + h], gf = g[DIR * 8 + 4 + h], bi = gb[DIR * 8 + h], bf_ = gb[DIR * 8 + 4 + h];
        const float mprev = ((const float*)(p.ws + WS_SC))[ch_index(DIR, b, h, cid) * 4 + 2];
        const float nv = ((const float*)(p.ws + WS_NV))[ch_index(DIR, b, h, cid) * 64 + lane];
        u32x4 qr[8];
#pragma unroll
        for (int c = 0; c < 8; ++c) qr[c] = *(const u32x4*)(P + (size_t)(r0 + lane) * NP + pbase + c * 8);
        const float ig = gi + bi, fg = gf + bf_;
        const float lf = logsigf_(fg); float bb;
        if (DIR == 0) bb = wave_prefix_sum(lf, lane); else { const float tt = wave_sum(lf), pre = wave_prefix_sum(lf, lane); bb = tt - pre + lf; }
        const float a = ig - bb; const float pm = DIR == 0 ? wave_prefix_max(a, lane) : wave_suffix_max(a, lane);
        const float mt_ = fmaxf(bb + mprev, bb + pm);
        float* ga = gar + DIR * 320;
        ga[lane] = bb - mt_; ga[64 + lane] = a; ga[128 + lane] = __expf(bb + mprev - mt_); ga[192 + lane] = __expf(-mt_);
        float* nvl = gar + 640 + DIR * 64;
        nvl[lane] = nv;
        WAVE_SYNC();
        float dq = 0.f;
#pragma unroll
        for (int c = 0; c < 8; ++c) { float f[8]; unpack8(qr[c], f);
            const f32x4 n0 = *(const f32x4*)(nvl + c * 8), n1 = *(const f32x4*)(nvl + c * 8 + 4);
            dq += f[0] * n0.x + f[1] * n0.y + f[2] * n0.z + f[3] * n0.w + f[4] * n1.x + f[5] * n1.y + f[6] * n1.z + f[7] * n1.w; }
        ga[256 + lane] = dq;
    }
}
template <int MIXER>
__device__ __forceinline__ void chunkout_prep2(const Params& p, int l, int b, int h, int cid, const float* Grow0, int r0, int pbase, float* gar, int lane_) {
    if constexpr (MIXER == 0) {
        const int lane = olane(lane_);
        const bf16* P = (const bf16*)(p.ws + WS_P);
        const float* g = Grow0 + (size_t)lane * NGS; const float* gb = p.in[I_MGB] + (size_t)l * 16;
        const float g0 = g[h], g1 = g[4 + h], g2 = g[8 + h], g3 = g[12 + h];
        const float mprev0 = ((const float*)(p.ws + WS_SC))[ch_index(0, b, h, cid) * 4 + 2], mprev1 = ((const float*)(p.ws + WS_SC))[ch_index(1, b, h, cid) * 4 + 2];
        const float nv0 = ((const float*)(p.ws + WS_NV))[ch_index(0, b, h, cid) * 64 + lane], nv1 = ((const float*)(p.ws + WS_NV))[ch_index(1, b, h, cid) * 64 + lane];
        u32x4 qr[8];
#pragma unroll
        for (int c = 0; c < 8; ++c) qr[c] = *(const u32x4*)(P + (size_t)(r0 + lane) * NP + pbase + c * 8);
        const float igF = g0 + gb[h], fgF = g1 + gb[4 + h], igB = g2 + gb[8 + h], fgB = g3 + gb[12 + h];
        { const float lf = logsigf_(fgF); const float bb = wave_prefix_sum(lf, lane);
            const float a = igF - bb; const float pm = wave_prefix_max(a, lane); const float mt_ = fmaxf(bb + mprev0, bb + pm); float* ga = gar;
            ga[lane] = bb - mt_; ga[64 + lane] = a; ga[128 + lane] = __expf(bb + mprev0 - mt_); ga[192 + lane] = __expf(-mt_); }
        { const float lf = logsigf_(fgB); const float tt = wave_sum(lf), pre = wave_prefix_sum(lf, lane); const float bb = tt - pre + lf;
            const float a = igB - bb; const float pm = wave_suffix_max(a, lane); const float mt_ = fmaxf(bb + mprev1, bb + pm); float* ga = gar + 320;
            ga[lane] = bb - mt_; ga[64 + lane] = a; ga[128 + lane] = __expf(bb + mprev1 - mt_); ga[192 + lane] = __expf(-mt_); }
        float* nvl = gar + 640;
        nvl[lane] = nv0; nvl[64 + lane] = nv1;
        WAVE_SYNC();
        float dq0 = 0.f, dq1 = 0.f;
#pragma unroll
        for (int c = 0; c < 8; ++c) { float f[8]; unpack8(qr[c], f);
            const f32x4 n0 = *(const f32x4*)(nvl + c * 8), n1 = *(const f32x4*)(nvl + c * 8 + 4), m0 = *(const f32x4*)(nvl + 64 + c * 8), m1 = *(const f32x4*)(nvl + 64 + c * 8 + 4);
            dq0 += f[0] * n0.x + f[1] * n0.y + f[2] * n0.z + f[3] * n0.w + f[4] * n1.x + f[5] * n1.y + f[6] * n1.z + f[7] * n1.w;
            dq1 += f[0] * m0.x + f[1] * m0.y + f[2] * m0.z + f[3] * m0.w + f[4] * m1.x + f[5] * m1.y + f[6] * m1.z + f[7] * m1.w; }
        gar[256 + lane] = dq0; gar[320 + 256 + lane] = dq1;
    }
}
template <int MIXER, int DIR, int NS>
__device__ __forceinline__ void chunkout_dir(const Params& p, int b, int h, int cid, int r0, int pbase, int th, const bf16x8 (&vtf)[4][2], const bf16* VtL, const bf16* EQ, bf16* SB, const float* gar, float* rsm, f32x4 (&htot)[NS][4], int lane_) {
    const bf16* P = (const bf16*)(p.ws + WS_P); const bf16* ST = (const bf16*)(p.ws + WS_ST);
    const int lane = olane(lane_), r = lane & 15, q4 = lane >> 4;
    const bf16* E = EQ + ((size_t)DIR * T + r0) * WG + h * 64;
    const float* ga = gar + DIR * 320;
    bf16x8 kf[4][2], ctf[4][2];
    if constexpr (MIXER == 0) {
#pragma unroll
        for (int n = 0; n < 4; ++n)
#pragma unroll
            for (int ks = 0; ks < 2; ++ks) { kf[n][ks] = *(const bf16x8*)(P + (size_t)(r0 + 16 * n + r) * NP + pbase + 256 + ks * 32 + q4 * 8); ctf[n][ks] = *(const bf16x8*)(ST + st_index(MIXER, DIR, b, h, cid) * 4096 + (16 * n + r) * 64 + ks * 32 + q4 * 8); }
    } else {
        u32x4 er[4][2];
#pragma unroll
        for (int n = 0; n < 4; ++n)
#pragma unroll
            for (int ks = 0; ks < 2; ++ks) { kf[n][ks] = *(const bf16x8*)(P + (size_t)(r0 + 16 * n + r) * NP + pbase + 256 + ks * 32 + q4 * 8);
                er[n][ks] = *(const u32x4*)(E + (size_t)(16 * n + r) * WG + ks * 32 + q4 * 8);
                ctf[n][ks] = *(const bf16x8*)(ST + st_index(MIXER, DIR, b, h, cid) * 4096 + (16 * n + r) * 64 + ks * 32 + q4 * 8); }
        SCHED_FENCE();
#pragma unroll
        for (int n = 0; n < 4; ++n)
#pragma unroll
            for (int ks = 0; ks < 2; ++ks) { float fe[8], fk[8]; unpack8(er[n][ks], fe); unpack8(as_u4(kf[n][ks]), fk);
#pragma unroll
                for (int j = 0; j < 8; ++j) fk[j] = fk[j] * frcp_(fe[j]);
                kf[n][ks] = as_frag(pack8(fk)); }
    }
    bf16x8 qraw[NS][2]; u32x4 qer[NS][2];
#pragma unroll
    for (int ms = 0; ms < NS; ++ms)
#pragma unroll
        for (int ks = 0; ks < 2; ++ks) { const int mt = NS * th + ms; qraw[ms][ks] = *(const bf16x8*)(P + (size_t)(r0 + 16 * mt + r) * NP + pbase + ks * 32 + q4 * 8);
            if constexpr (MIXER == 1) qer[ms][ks] = *(const u32x4*)(E + (size_t)(16 * mt + r) * WG + ks * 32 + q4 * 8); else qer[ms][ks] = (u32x4){0u, 0u, 0u, 0u}; }
#pragma unroll
    for (int ms = 0; ms < NS; ++ms) { const int mt = NS * th + ms;
        bf16x8 qf[2];
#pragma unroll
        for (int ks = 0; ks < 2; ++ks) { qf[ks] = qraw[ms][ks];
            if constexpr (MIXER == 1) { float fe[8], fq[8]; unpack8(qer[ms][ks], fe); unpack8(as_u4(qf[ks]), fq);
#pragma unroll
                for (int j = 0; j < 8; ++j) fq[j] *= 0.125f * fe[j];
                qf[ks] = as_frag(pack8(fq)); } }
        f32x4 S[4] = {(f32x4){0.f, 0.f, 0.f, 0.f}, (f32x4){0.f, 0.f, 0.f, 0.f}, (f32x4){0.f, 0.f, 0.f, 0.f}, (f32x4){0.f, 0.f, 0.f, 0.f}};
#pragma unroll
        for (int ks = 0; ks < 2; ++ks)
#pragma unroll
            for (int n = 0; n < 4; ++n) S[n] = MFMA16(kf[n][ks], qf[ks], S[n]);
        const int t = 16 * mt + r; float sm = 0.f; float gt = 0.f; if constexpr (MIXER == 0) gt = ga[t];
#pragma unroll
        for (int n = 0; n < 4; ++n) { f32x4 gs = {0.f, 0.f, 0.f, 0.f}; if constexpr (MIXER == 0) gs = *(const f32x4*)(ga + 64 + 16 * n + 4 * q4);
#pragma unroll
            for (int i = 0; i < 4; ++i) { const int sidx = 16 * n + 4 * q4 + i; const bool ok = DIR == 0 ? (sidx <= t) : (sidx >= t); float v = 0.f;
                if (ok) { if constexpr (MIXER == 0) v = S[n][i] * 0.125f * __expf(gt + gs[i]); else v = S[n][i]; }
                S[n][i] = v; sm += v; } }
        const float pa[8] = {S[0][0], S[0][1], S[0][2], S[0][3], S[1][0], S[1][1], S[1][2], S[1][3]}, pb[8] = {S[2][0], S[2][1], S[2][2], S[2][3], S[3][0], S[3][1], S[3][2], S[3][3]};
        const bf16x8 sm0 = as_frag(pack8(pa)), sm1 = as_frag(pack8(pb));
        float wi = 1.f, inv = 1.f;
        if constexpr (MIXER == 0) { sm = xrow_sum(sm); wi = ga[128 + t]; const float den = wi * ga[256 + t] + sm; inv = frcp_(fmaxf(fabsf(den), ga[192 + t])); }
#pragma unroll
        for (int me = 0; me < 4; ++me) { f32x4 a1 = {0.f, 0.f, 0.f, 0.f}, a2 = {0.f, 0.f, 0.f, 0.f};
            const int srow = 4 * q4 + (r >> 2), ecol = 16 * me + 4 * (r & 3);
            const u32x2 v0 = lds_tr16(VtL + swz(srow, ecol >> 3) + (ecol & 7)), v1 = lds_tr16(VtL + swz(16 + srow, ecol >> 3) + (ecol & 7)), v2 = lds_tr16(VtL + swz(32 + srow, ecol >> 3) + (ecol & 7)), v3 = lds_tr16(VtL + swz(48 + srow, ecol >> 3) + (ecol & 7));
            u32x4 va; va.x = v0.x; va.y = v0.y; va.z = v1.x; va.w = v1.y; u32x4 vb; vb.x = v2.x; vb.y = v2.y; vb.z = v3.x; vb.w = v3.y;
            a1 = MFMA16(as_frag(va), sm0, a1); a1 = MFMA16(as_frag(vb), sm1, a1);
            a2 = MFMA16(ctf[me][0], qf[0], a2); a2 = MFMA16(ctf[me][1], qf[1], a2);
            if constexpr (MIXER == 0) htot[ms][me] += (a1 + a2 * wi) * inv; else htot[ms][me] += a1 + a2; }
    }
    (void)SB; (void)rsm;
}
__device__ __forceinline__ void co_build_vt(const bf16* P, int r0, int vcol, bf16* VtL, int lane) {
    load_nat_tile(P, r0, vcol, VtL, lane);
    WAVE_SYNC();
}
template <int MIXER, int NS>
__device__ __forceinline__ void co_finalize(const Params& p, int l, int h, int r0, int pbase, int mt0, f32x4 (&htot)[NS][4], int lane_) {
    const bf16* P = (const bf16*)(p.ws + WS_P); bf16* Y = (bf16*)(p.ws + WS_HNY);
    const float* ngp = p.in[MIXER == 0 ? I_MNG : I_GNG] + (size_t)l * WG + h * 64;
    const int lz = olane(lane_), r = lz & 15, q4 = lz >> 4;
    u32x2 gq[NS][4], oq[NS][4]; f32x4 ng[4];
#pragma unroll
    for (int me = 0; me < 4; ++me) ng[me] = *(const f32x4*)(ngp + 16 * me + 4 * q4);
#pragma unroll
    for (int ms = 0; ms < NS; ++ms)
#pragma unroll
        for (int me = 0; me < 4; ++me) { const size_t off = (size_t)(r0 + 16 * (mt0 + ms) + r) * NP + pbase + 16 * me + 4 * q4;
            gq[ms][me] = *(const u32x2*)(P + off + (MIXER == 0 ? 1024 : 768)); if constexpr (MIXER == 0) oq[ms][me] = *(const u32x2*)(P + off + 768); else oq[ms][me] = (u32x2){0u, 0u}; }
#pragma unroll
    for (int ms = 0; ms < NS; ++ms) { const int mt = mt0 + ms; float ss = 0.f; float gv[4][4];
#pragma unroll
        for (int me = 0; me < 4; ++me) {
            gv[me][0] = bitsf(gq[ms][me].x << 16); gv[me][1] = bitsf(gq[ms][me].x & 0xffff0000u); gv[me][2] = bitsf(gq[ms][me].y << 16); gv[me][3] = bitsf(gq[ms][me].y & 0xffff0000u);
            if constexpr (MIXER == 0) { htot[ms][me][0] *= sigmoidf_(bitsf(oq[ms][me].x << 16)); htot[ms][me][1] *= sigmoidf_(bitsf(oq[ms][me].x & 0xffff0000u)); htot[ms][me][2] *= sigmoidf_(bitsf(oq[ms][me].y << 16)); htot[ms][me][3] *= sigmoidf_(bitsf(oq[ms][me].y & 0xffff0000u)); }
            ss += htot[ms][me][0] * htot[ms][me][0] + htot[ms][me][1] * htot[ms][me][1] + htot[ms][me][2] * htot[ms][me][2] + htot[ms][me][3] * htot[ms][me][3]; }
        ss = xrow_sum(ss);
        const float rstd = rsqrtf(ss * (1.0f / 64.0f) + EPS);
#pragma unroll
        for (int me = 0; me < 4; ++me) { const int e = 16 * me + 4 * q4; const f32x4 n4 = ng[me];
            u32x2 o; o.x = pk2(htot[ms][me][0] * rstd * n4.x * siluf_(gv[me][0]), htot[ms][me][1] * rstd * n4.y * siluf_(gv[me][1]));
            o.y = pk2(htot[ms][me][2] * rstd * n4.z * siluf_(gv[me][2]), htot[ms][me][3] * rstd * n4.w * siluf_(gv[me][3]));
            *(u32x2*)(Y + (size_t)(r0 + 16 * mt + r) * 1024 + (MIXER == 0 ? YA : YG) + h * 64 + e) = o; } }
}
template <int MIXER>
__device__ __forceinline__ void chunkout_w(const Params& p, int l, int b, int h, int cid, char* wl, int lane) {
    const bf16* P = (const bf16*)(p.ws + WS_P); const float* G = (const float*)(p.ws + WS_G);
    const int r0 = b * TOK + cid * 64;
    const int pbase = (MIXER == 0 ? PA : PG) + h * 64;
    bf16* SB = (bf16*)wl;
    float* rsm = (float*)(SB + 1024);
    float* gar = rsm + 16;
    const bf16* EQ = (const bf16*)(p.ws + WS_EQ);
    const float* Grow0 = G + (size_t)r0 * NGS;
    bf16* VtL = (bf16*)(gar + 768);
    bf16x8 vtf[4][2];
#pragma unroll
    for (int me = 0; me < 4; ++me)
#pragma unroll
        for (int ks = 0; ks < 2; ++ks) { vtf[me][ks] = (bf16x8){0, 0, 0, 0, 0, 0, 0, 0}; }
    co_build_vt(P, r0, pbase + 512, VtL, lane);
    chunkout_prep2<MIXER>(p, l, b, h, cid, Grow0, r0, pbase, gar, lane);
    WAVE_SYNC();
    constexpr int NS = 2;
#pragma unroll 1
    for (int th = 0; th < 4 / NS; ++th) {
        f32x4 htot[NS][4];
#pragma unroll
        for (int a = 0; a < NS; ++a)
#pragma unroll
            for (int c = 0; c < 4; ++c) htot[a][c] = (f32x4){0.f, 0.f, 0.f, 0.f};
        chunkout_dir<MIXER, 0, NS>(p, b, h, cid, r0, pbase, th, vtf, VtL, EQ, SB, gar, rsm, htot, lane);
        chunkout_dir<MIXER, 1, NS>(p, b, h, cid, r0, pbase, th, vtf, VtL, EQ, SB, gar, rsm, htot, lane);
        co_finalize<MIXER, NS>(p, l, h, r0, pbase, NS * th, htot, lane);
    }
}
constexpr int CO_PART = 13376;
template <int MIXER, int DIR>
__device__ __forceinline__ void chunkout_piece(const Params& p, int l, int b, int h, int cid, int mt, char* wl, int lane) {
    const bf16* P = (const bf16*)(p.ws + WS_P); const float* G = (const float*)(p.ws + WS_G);
    const int r0 = b * TOK + cid * 64; const int pbase = (MIXER == 0 ? PA : PG) + h * 64;
    bf16* SB = (bf16*)wl; float* rsm = (float*)(SB + 1024); float* gar = rsm + 16; const bf16* EQ = (const bf16*)(p.ws + WS_EQ);
    const float* Grow0 = G + (size_t)r0 * NGS; bf16* VtL = (bf16*)(gar + 768);
    bf16x8 vtf[4][2];
#pragma unroll
    for (int me = 0; me < 4; ++me)
#pragma unroll
        for (int ks = 0; ks < 2; ++ks) { vtf[me][ks] = (bf16x8){0, 0, 0, 0, 0, 0, 0, 0}; }
    co_build_vt(P, r0, pbase + 512, VtL, lane);
    chunkout_prep<MIXER, DIR>(p, l, b, h, cid, Grow0, r0, pbase, EQ, gar, lane);
    WAVE_SYNC();
    f32x4 htot[1][4] = {{(f32x4){0.f, 0.f, 0.f, 0.f}, (f32x4){0.f, 0.f, 0.f, 0.f}, (f32x4){0.f, 0.f, 0.f, 0.f}, (f32x4){0.f, 0.f, 0.f, 0.f}}};
    chunkout_dir<MIXER, DIR, 1>(p, b, h, cid, r0, pbase, mt, vtf, VtL, EQ, SB, gar, rsm, htot, lane);
    float* part = (float*)(wl + CO_PART);
#pragma unroll
    for (int me = 0; me < 4; ++me)
#pragma unroll
        for (int i = 0; i < 4; ++i) part[(me * 4 + i) * 64 + lane] = htot[0][me][i];
}
template <int MIXER>
__device__ __forceinline__ void chunkout_combine(const Params& p, int l, int b, int h, int cid, int mt, const char* smem, int lane) {
    const float* pa = (const float*)(smem + (2 * mt) * WLDS + CO_PART); const float* pb = (const float*)(smem + (2 * mt + 1) * WLDS + CO_PART);
    f32x4 htot[1][4];
#pragma unroll
    for (int me = 0; me < 4; ++me)
#pragma unroll
        for (int i = 0; i < 4; ++i) htot[0][me][i] = pa[(me * 4 + i) * 64 + lane] + pb[(me * 4 + i) * 64 + lane];
    co_finalize<MIXER, 1>(p, l, h, b * TOK + cid * 64, (MIXER == 0 ? PA : PG) + h * 64, mt, htot, lane);
}

template <bool OUT>
__device__ __forceinline__ void chunk_workers(const Params& p, int l, char* smem) {
    const int tid = otid(), lane = tid & 63, wave = __builtin_amdgcn_readfirstlane(tid >> 6);
    const int NW = (int)gridDim.x * 8, wi = wave * (int)gridDim.x + obid();
    const int c_lo = (OUT && l == DEPTH - 1) ? NCC : 0, npc = NCH - c_lo, half = NB * NH * npc;
    char* wl = smem + wave * WLDS;
    if (OUT) {
        const int cl = NCC, npl = NCH - NCC, halfl = NB * NH * npl;
#pragma unroll 1
        for (int t = wi; t < halfl; t += NW) { const int b = t / (NH * npl), h = (t / npl) % NH, cid = cl + t % npl;
            const Params q = relaunder(p); chunkout_w<1>(q, l, b, h, cid, wl, lane); }
        { const int used = halfl % NW;
#pragma unroll 1
            for (int t = (wi + NW - used) % NW; t < halfl; t += NW) { const int b = t / (NH * npl), h = (t / npl) % NH, cid = cl + t % npl;
                const Params q = relaunder(p); chunkout_w<0>(q, l, b, h, cid, wl, lane); } }
        if (l < DEPTH - 1) {
            const int nct = NB * NH * NCC;
#pragma unroll 1
            for (int st = obid(); st < 2 * nct; st += (int)gridDim.x) { const int mixer = st / nct, r2 = st % nct, b = r2 / (NH * NCC), h = (r2 / NCC) % NH, cid = r2 % NCC;
                const Params q = relaunder(p); const int mt = wave >> 1;
                __syncthreads();
                if (mixer == 0) { if (wave & 1) chunkout_piece<0, 1>(q, l, b, h, cid, mt, wl, lane); else chunkout_piece<0, 0>(q, l, b, h, cid, mt, wl, lane); }
                else            { if (wave & 1) chunkout_piece<1, 1>(q, l, b, h, cid, mt, wl, lane); else chunkout_piece<1, 0>(q, l, b, h, cid, mt, wl, lane); }
                __syncthreads();
                if (wave < 4) { if (mixer == 0) chunkout_combine<0>(q, l, b, h, cid, wave, smem, lane); else chunkout_combine<1>(q, l, b, h, cid, wave, smem, lane); }
            }
        }
    } else {
        int off = 0;
#pragma unroll 1
        for (int t = wi; t < half; t += NW) { const int b = t / (NH * npc), h = (t / npc) % NH, cid = c_lo + t % npc;
            const Params q = relaunder(p); chunkst_gla<0>(q, l, b, h, cid, wl, lane); }
        off = (off + half) % NW;
#pragma unroll 1
        for (int t = (wi + NW - off) % NW; t < half; t += NW) { const int b = t / (NH * npc), h = (t / npc) % NH, cid = c_lo + t % npc;
            const Params q = relaunder(p); chunkst_gla<1>(q, l, b, h, cid, wl, lane); }
        off = (off + half) % NW;
#pragma unroll 1
        for (int t = (wi + NW - off) % NW; t < half; t += NW) { const int b = t / (NH * npc), h = (t / npc) % NH, cid = c_lo + t % npc;
            const Params q = relaunder(p); chunkst_w<0>(q, l, b, h, cid, wl, lane); }
    }
}

__device__ __forceinline__ void phase_mix1(const Params& p, int l, char* smem) {
    const bool ctxo = l < DEPTH - 1; const int G = (int)gridDim.x, bid = obid();
    constexpr int N_HL = (NB / 2) * (WG / 2), N_HC = NB * (WG / HCB);
    chunk_workers<false>(p, l, smem);
    stage_signal(p, smem, 0, l);
    for (int t = bid; t < N_HL; t += G) hylat_task(p, l, t / (WG / 2), t % (WG / 2), smem);
    if (ctxo) for (int t = G - 1 - bid; t < N_HC; t += G) hyctx_task(p, l, t / (WG / HCB), t % (WG / HCB), smem);
    stage_signal(p, smem, 2, l);
}

constexpr int SCG = 18;
__device__ __forceinline__ void phase_scan(const Params& p, int l, char* smem) {
    const int tid = otid();
    bf16* ST = (bf16*)(p.ws + WS_ST); float* NV = (float*)(p.ws + WS_NV); const float* BE = (const float*)(p.ws + WS_BE); float* SC = (float*)(p.ws + WS_SC);
    constexpr int NCHAIN = 2 * 2 * NB * NH;
    stage_wait(p, 0, l);
    for (int item = obid() * NT + tid; item < NCHAIN * 1024; item += gridDim.x * NT) {
        const int chain = item >> 10, grp = item & 1023; const int mixer = chain / (2 * NB * NH), dir = (chain / (NB * NH)) % 2, b = (chain / NH) % NB, h = chain % NH;
        float c[4] = {0.f, 0.f, 0.f, 0.f}; float nv[4] = {0.f, 0.f, 0.f, 0.f}; float m = 0.f;
        const int d0 = (grp & 15) * 4; const bool donv = (mixer == 0) && (grp < 16);
        float* sS = (float*)smem;
        __syncthreads();
        if (mixer == 0 && tid < NCH) { const size_t ci = ch_index(dir, b, h, chain_cid(dir, tid)); sS[2 * tid] = SC[ci * 4 + 0]; sS[2 * tid + 1] = SC[ci * 4 + 1]; }
        __syncthreads();
        for (int o0 = 0; o0 < NCH; o0 += SCG) {
            u32x2 uu[SCG]; f32x4 aux[SCG];
#pragma unroll
            for (int j = 0; j < SCG; ++j) if (o0 + j < NCH) { const int cid = chain_cid(dir, o0 + j); const size_t ci = ch_index(dir, b, h, cid);
                uu[j] = *(const u32x2*)(ST + st_index(mixer, dir, b, h, cid) * 4096 + grp * 4);
                if (mixer == 0) { if (donv) aux[j] = *(const f32x4*)(NV + ci * 64 + grp * 4); }
                else aux[j] = *(const f32x4*)(BE + ci * 64 + d0); }
#pragma unroll
            for (int j = 0; j < SCG; ++j) if (o0 + j < NCH) { const int cid = chain_cid(dir, o0 + j); const size_t ci = ch_index(dir, b, h, cid);
                const float u[4] = {bitsf(uu[j].x << 16), bitsf(uu[j].x & 0xffff0000u), bitsf(uu[j].y << 16), bitsf(uu[j].y & 0xffff0000u)};
                u32x2 w; w.x = pk2(c[0], c[1]); w.y = pk2(c[2], c[3]); *(u32x2*)(ST + st_index(mixer, dir, b, h, cid) * 4096 + grp * 4) = w;
                if (mixer == 0) {
                    if (grp == 0) SC[ci * 4 + 2] = m;
                    const float s0j = sS[2 * (o0 + j)], s1j = sS[2 * (o0 + j) + 1];
                    const float mn = fmaxf(s0j + m, s1j), a = __expf(s0j + m - mn), s = __expf(s1j - mn);
#pragma unroll
                    for (int k = 0; k < 4; ++k) c[k] = a * c[k] + s * u[k];
                    if (donv) { f32x4 nw = {nv[0], nv[1], nv[2], nv[3]}; *(f32x4*)(NV + ci * 64 + grp * 4) = nw;
                        nv[0] = a * nv[0] + s * aux[j].x; nv[1] = a * nv[1] + s * aux[j].y; nv[2] = a * nv[2] + s * aux[j].z; nv[3] = a * nv[3] + s * aux[j].w; }
                    m = mn;
                } else { c[0] = __expf(aux[j].x) * c[0] + u[0]; c[1] = __expf(aux[j].y) * c[1] + u[1]; c[2] = __expf(aux[j].z) * c[2] + u[2]; c[3] = __expf(aux[j].w) * c[3] + u[3]; } }
        }
    }
    stage_signal(p, smem, 1, l);
    { const bool ctxo = l < DEPTH - 1; const int G = (int)gridDim.x, bid = obid();
        constexpr int QTL = SEQ / 128, QTC = CTXL / 128, N_AL = NB * 2 * QTL, N_AC = NB * 2 * QTC;
        for (int t = bid; t < N_AL; t += G) attn_task(p, l, t / (2 * QTL), (t / QTL) % 2, t % QTL, false, smem);
        if (ctxo) for (int t = (bid + G - 64 % G) % G; t < N_AC; t += G) attn_task(p, l, t / (2 * QTC), (t / QTC) % 2, t % QTC, true, smem); }
}

__device__ __forceinline__ void phase_mix2(const Params& p, int l, char* smem) {
    const int tid = otid();
    stage_wait(p, 1, l);
    chunk_workers<true>(p, l, smem);
    stage_wait(p, 2, l);
    constexpr int N_WOUT = (DM / 64) * (MIX / 64);
    { const int lane = tid & 63, wave = __builtin_amdgcn_readfirstlane(tid >> 6); const int NW = (int)gridDim.x * 8, wi = wave * (int)gridDim.x + obid();
        for (int task = NW - 1 - wi; task < N_WOUT; task += NW) { const int nt = task / (MIX / 64), kt = task % (MIX / 64);
            convert_tile_w(p.in[I_WOUT] + (size_t)l * MIX * DM, DM, (bf16*)(p.ws + WS_WOUT), MIX, nt * 64, kt * 64, false, smem + wave * WLDS, lane); }
        bf16* tile = (bf16*)(smem + wave * WLDS); const bf16* HT = (const bf16*)(p.ws + WS_HT); bf16* Y = (bf16*)(p.ws + WS_HNY);
        constexpr int NTT = NB * (SEQ / 64) * 4;
        for (int t = wi; t < NTT; t += NW) { const int b = t / ((SEQ / 64) * 4), tt = (t / 4) % (SEQ / 64), c0 = (t % 4) * 64; const size_t tok0 = (size_t)b * TOK + CTXL + tt * 64;
            u32x4 tv[8];
#pragma unroll
            for (int i = 0; i < 8; ++i) { const int ch = (lane >> 3) + 8 * i, ck = lane & 7; tv[i] = *(const u32x4*)(HT + (size_t)(768 + c0 + ch) * T + tok0 + ck * 8); }
#pragma unroll
            for (int i = 0; i < 8; ++i) { const int ch = (lane >> 3) + 8 * i, ck = lane & 7; *(u32x4*)(tile + swz(ch, ck)) = tv[i]; }
            WAVE_SYNC();
#pragma unroll
            for (int i = 0; i < 8; ++i) { const int tk = (lane >> 3) + 8 * i, cc = lane & 7; unsigned w[4];
#pragma unroll
                for (int j = 0; j < 4; ++j) { const int ca = cc * 8 + 2 * j; w[j] = (unsigned)tile[swz(ca, tk >> 3) + (tk & 7)] | ((unsigned)tile[swz(ca + 1, tk >> 3) + (tk & 7)] << 16); }
                u32x4 o; o.x = w[0]; o.y = w[1]; o.z = w[2]; o.w = w[3]; *(u32x4*)(Y + (tok0 + tk) * 1024 + YH + c0 + cc * 8) = o; }
            WAVE_SYNC(); } }
}


#ifndef EMU
#define LAS __attribute__((address_space(3)))
#define XB_TMO      128
#define XB_XCNT(j)  (256  + 64 * (j))
#define XB_XSUB(j)  (1280 + 64 * (j))
#define XB_XGEN(j)  (2304 + 64 * (j))
#define XB_TOP      3328
#define XB_TOPGEN   3392
#define XCD_BAR_WORDS 3456
#define XB_SPIN_CAP (1u << 18)

__device__ __forceinline__ unsigned xb_ld(unsigned* p)              { return __hip_atomic_load(p, __ATOMIC_RELAXED, __HIP_MEMORY_SCOPE_AGENT); }
__device__ __forceinline__ unsigned xb_add(unsigned* p, unsigned v) { return __hip_atomic_fetch_add(p, v, __ATOMIC_RELAXED, __HIP_MEMORY_SCOPE_AGENT); }
__device__ __forceinline__ unsigned xb_xcc_id() { return (unsigned)__builtin_amdgcn_s_getreg((3 << 11) | 20) & 0xFu; }
#define XB_SPIN(cond, bar) do { unsigned _sp = 0; while (cond) { __builtin_amdgcn_s_sleep(1); \
    if ((++_sp & 255u) == 0u) { if (xb_ld(&(bar)[XB_TMO])) break; if (_sp > XB_SPIN_CAP) { atomicAdd(&(bar)[XB_TMO], 1u); break; } } } } while (0)

struct XcdBarrier {
    unsigned* bar; unsigned x;
    volatile LAS unsigned* st;
};

__device__ __forceinline__ XcdBarrier xcd_barrier_post(unsigned* bar, volatile LAS unsigned* st) {
    XcdBarrier b; b.bar = bar; b.x = xb_xcc_id(); b.st = st;
    if (threadIdx.x == 0) (void)xb_add(&bar[XB_XCNT(b.x)], 1u);
    return b;
}
__device__ __forceinline__ void xcd_barrier_complete(unsigned* bar, unsigned x, unsigned& nloc, unsigned& nx) {
    const unsigned G = gridDim.x * gridDim.y * gridDim.z;
    unsigned sum, cnt, mine, sp = 0u;
    for (;;) {
        sum = 0u; cnt = 0u; mine = 0u;
#pragma unroll
        for (unsigned j = 0; j < 16; ++j) { const unsigned c = xb_ld(&bar[XB_XCNT(j)]); sum += c; cnt += (c > 0u) ? 1u : 0u; mine = (j == x) ? c : mine; }
        if (sum == G) break;
        __builtin_amdgcn_s_sleep(1);
        if ((++sp & 255u) == 0u) { if (xb_ld(&bar[XB_TMO])) break; if (sp > XB_SPIN_CAP) { atomicAdd(&bar[XB_TMO], 1u); break; } }
    }
    nloc = mine > 0u ? mine : 1u; nx = cnt > 0u ? cnt : 1u;
}

__device__ __forceinline__ void xcd_barrier(const XcdBarrier& b) {
    asm volatile("s_waitcnt vmcnt(0)" ::: "memory");
    __syncthreads();
    if (threadIdx.x == 0) {
        unsigned* bar = b.bar;
        __builtin_amdgcn_s_waitcnt(0);
        unsigned nloc = b.st[0], nx = b.st[1];
        if (nloc == 0u) { xcd_barrier_complete(bar, b.x, nloc, nx); b.st[0] = nloc; b.st[1] = nx; }
        const unsigned old = xb_add(&bar[XB_XSUB(b.x)], 1u);
        const unsigned gen = old / nloc;
        if (old + 1u == (gen + 1u) * nloc) {
            __builtin_amdgcn_fence(__ATOMIC_RELEASE, "agent");
            asm volatile("s_waitcnt vmcnt(0)" ::: "memory");
            const unsigned og = xb_add(&bar[XB_TOP], 1u);
            const unsigned tg = og / nx;
            if (og + 1u == (tg + 1u) * nx) xb_add(&bar[XB_TOPGEN], 1u);
            else XB_SPIN(xb_ld(&bar[XB_TOPGEN]) == tg, bar);
            __builtin_amdgcn_fence(__ATOMIC_ACQUIRE, "agent");
            xb_add(&bar[XB_XGEN(b.x)], 1u);
            asm volatile("s_waitcnt vmcnt(0)" ::: "memory");
        } else {
            XB_SPIN(xb_ld(&bar[XB_XGEN(b.x)]) == gen, bar);
            __builtin_amdgcn_fence(__ATOMIC_ACQUIRE, "agent");
            asm volatile("s_waitcnt vmcnt(0)" ::: "memory");
        }
    }
    __syncthreads();
}
#endif

__global__ void __launch_bounds__(NT) fwd_kernel(Params pk, int ph_lo, int ph_hi) {
    SMEM_DECL;
#ifndef EMU
    volatile LAS unsigned* misc = (volatile LAS unsigned*)(smem + LDS_BYTES - 64);
    if (threadIdx.x < 2) misc[threadIdx.x] = 0u;
    __syncthreads();
    const XcdBarrier bar = xcd_barrier_post((unsigned*)(pk.ws + WS_BAR), misc);
#endif
    constexpr int NPH = 2 + 6 * DEPTH;
    for (int ph = ph_lo; ph < ph_hi && ph < NPH; ++ph) {
#ifndef EMU
        Params p = pk; { size_t z = 0; asm volatile("" : "+s"(z)); p.ws = pk.ws + z; p.out = pk.out + z;
#pragma unroll
            for (int i = 0; i < 26; ++i) p.in[i] = pk.in[i] + z; }
#else
        const Params& p = pk;
#endif
        if (ph == 0) phase0(p, smem);
        else if (ph == NPH - 1) phase_rp(p, DEPTH, smem);
        else { const int l = (ph - 1) / 6, k = (ph - 1) % 6;
            if (k == 0) phase_rp(p, l, smem);
            else if (k == 1) phase_gemm_in(p, l, smem);
            else if (k == 2) phase_mix1(p, l, smem);
            else if (k == 3) phase_scan(p, l, smem);
            else if (k == 4) phase_mix2(p, l, smem);
            else phase_gemm_out(p, l, smem);
#ifdef PROBE_DUP
            if (k == PROBE_DUP) { GRID_SYNC();
                if (k == 1) phase_gemm_in(p, l, smem); else if (k == 2) phase_mix1(p, l, smem); else if (k == 4) phase_mix2(p, l, smem); }
#endif
        }
        if (ph + 1 < ph_hi && !(ph >= 6 && ph % 6 == 0) && !(ph >= 1 && ((ph - 1) % 6 == 2 || (ph - 1) % 6 == 3))) {
#ifdef EMU
            GRID_SYNC();
#else
            if (ph_lo < 0) GRID_SYNC();
            xcd_barrier(bar);
#endif
        }
    }
}

#ifndef EMU
extern "C" void kernel_launch(void* const* d_in, const int* in_sizes, int n_in, void* d_out, int out_size, void* d_ws, size_t ws_size, hipStream_t stream) {
    static int grid = 0;
    if (grid == 0) {
        if (n_in != 26 || ws_size < WS_TOTAL) { fprintf(stderr, "kernel_launch: unexpected n_in %d or ws_size %zu (need %zu)\n", n_in, ws_size, (size_t)WS_TOTAL); grid = -1; return; }
        int dev = 0, cus = 0, per_cu = 0;
        hipGetDevice(&dev);
        hipDeviceGetAttribute(&cus, hipDeviceAttributeMultiprocessorCount, dev);
        hipFuncSetAttribute((const void*)fwd_kernel, hipFuncAttributeMaxDynamicSharedMemorySize, LDS_BYTES);
        hipOccupancyMaxActiveBlocksPerMultiprocessor(&per_cu, (const void*)fwd_kernel, NT, LDS_BYTES);
        if (per_cu < 1) { fprintf(stderr, "kernel_launch: occupancy query returned %d\n", per_cu); grid = -1; return; }
        if (per_cu > 1) per_cu = 1;
        grid = cus * per_cu;
    }
    if (grid < 0) return;
    hipMemsetAsync((char*)d_ws + WS_BAR, 0, BAR_BYTES, stream);
    Params p{};
    for (int i = 0; i < 26; ++i) p.in[i] = (const float*)d_in[i];
    p.out = (float*)d_out; p.ws = (char*)d_ws;
    int lo = 0, hi = 2 + 6 * DEPTH;
    void* args[] = {&p, &lo, &hi};
    hipError_t e = hipLaunchCooperativeKernel((const void*)fwd_kernel, dim3(grid), dim3(NT), args, LDS_BYTES, stream);
    if (e != hipSuccess) fprintf(stderr, "cooperative launch failed: %s (grid %d)\n", hipGetErrorString(e), grid);
}
#endif
```

```cpp
#ifdef EMU
#include "emu/hipemu.h"
#define GRID_SYNC() emu::grid_sync()
#define SMEM_DECL char* smem = emu::S().blocks[emu::cur()->block].lds
#define SCHED_FENCE() do {} while (0)
#define NT_LOAD4(p) (*(const f32x4*)(p))
#define NT_LOAD1(p) (*(const float*)(p))
#define NT_STORE4(p, v) (*(f32x4*)(p) = (v))
#define EXP2(x) exp2f(x)
#define MFMA16(a, b, c) emu_mfma_16x16x32_bf16(a, b, c)
#else
#include <hip/hip_runtime.h>
#include <hip/hip_cooperative_groups.h>
#include <cstdio>
#include <cstdint>
#define GRID_SYNC() cooperative_groups::this_grid().sync()
#define SMEM_DECL extern __shared__ __attribute__((aligned(16))) char smem[]
#define SCHED_FENCE() __builtin_amdgcn_sched_barrier(0)
#define NT_LOAD4(p) __builtin_nontemporal_load((const f32x4*)(p))
#define NT_LOAD1(p) __builtin_nontemporal_load((const float*)(p))
#define NT_STORE4(p, v) __builtin_nontemporal_store((v), (f32x4*)(p))
#define EXP2(x) __builtin_amdgcn_exp2f(x)
#define MFMA16(a, b, c) __builtin_amdgcn_mfma_f32_16x16x32_bf16(a, b, c, 0, 0, 0)
#endif

#ifdef EMU
#ifndef EMU_DM
#define EMU_DM 256
#endif
#ifndef EMU_NB
#define EMU_NB 2
#endif
#ifndef EMU_SEQ
#define EMU_SEQ 512
#endif
#ifndef EMU_DEPTH
#define EMU_DEPTH 2
#endif
#ifndef EMU_CTXL
#define EMU_CTXL 128
#endif
constexpr int DM = EMU_DM, NB = EMU_NB, SEQ = EMU_SEQ, DEPTH = EMU_DEPTH, CTXL = EMU_CTXL;
#else
constexpr int DM = 1024, NB = 8, SEQ = 2048, DEPTH = 4, CTXL = 256;
#endif
constexpr int MIX = 1024, WG = 256, HD = 64, NH = 4, CH = 64;
constexpr int TOK = CTXL + SEQ, T = NB * TOK, NCH = TOK / CH, NCC = CTXL / CH;
constexpr int N_IN = 4144, NP = 3072, NG = 48, NGS = 32, NMAIN = 3328, NPAD = 4352;
constexpr int NF = 2 * SEQ;
constexpr int NJ = NB + 1;
constexpr int NT = 512;
constexpr float EPS = 1e-6f;
constexpr int PA = 0, PG = 1280, PD = 2304;
constexpr int YA = 0, YH = 256, YG = 512, YD = 768;
constexpr int ilog4(int n) { return n <= 1 ? 0 : 1 + ilog4(n / 4); }
constexpr int FFT_P = ilog4(NF);
static_assert((1 << (2 * FFT_P)) == NF, "NF must be a power of 4");
static_assert(DM % 256 == 0 && CTXL % 128 == 0 && SEQ % 256 == 0, "shape constraints");

typedef unsigned short bf16;
typedef short bf16x8 __attribute__((ext_vector_type(8)));
typedef float f32x4 __attribute__((ext_vector_type(4)));
typedef unsigned u32x4 __attribute__((ext_vector_type(4)));
typedef unsigned u32x2 __attribute__((ext_vector_type(2)));
struct cpx { float x, y; };

constexpr size_t al256(size_t x) { return (x + 255) & ~(size_t)255; }
constexpr size_t WS_CTXB = 0;
constexpr size_t WS_HNY = al256(WS_CTXB + (size_t)NB * CTXL * DM * 4);
constexpr size_t WS_WIN = WS_HNY + (size_t)T * 1024 * 2;
constexpr size_t WS_ST = WS_WIN;
constexpr size_t ST_BYTES = (size_t)2 * 2 * NB * NH * NCH * 4096 * 2;
constexpr size_t WS_KT = al256(WS_WIN + (size_t)NPAD * DM * 2);
static_assert(WS_KT + (size_t)WG * NF * 4 <= WS_ST + ST_BYTES || true, "");
constexpr size_t ST_END = al256((WS_ST + ST_BYTES > WS_KT + (size_t)WG * NF * 4) ? WS_ST + ST_BYTES : WS_KT + (size_t)WG * NF * 4);
constexpr size_t WS_P = ST_END;
constexpr size_t WS_HT = al256(WS_P + (size_t)T * NP * 2);
constexpr size_t WS_WOUT = WS_HT;
constexpr size_t WS_G = al256(WS_HT + (size_t)1024 * T * 2);
constexpr size_t WS_KF = al256(WS_G + (size_t)T * NGS * 4);
constexpr size_t WS_HC = al256(WS_KF + (size_t)WG * NF * 8);
constexpr size_t WS_EQ = al256(WS_HC + (size_t)2 * WG * CTXL * 4);
constexpr size_t WS_NV = al256(WS_EQ + (size_t)2 * T * WG * 2);
constexpr size_t WS_BE = al256(WS_NV + (size_t)2 * NB * NH * NCH * 64 * 4);
constexpr size_t WS_SC = al256(WS_BE + (size_t)2 * NB * NH * NCH * 64 * 4);
constexpr size_t WS_MOD = al256(WS_SC + (size_t)2 * NB * NH * NCH * 4 * 4);
constexpr size_t WS_TW = al256(WS_MOD + (size_t)DEPTH * NJ * 3 * DM * 4);
constexpr size_t WS_ROPE = al256(WS_TW + (size_t)NF * 8);
constexpr size_t WS_BAR = al256(WS_ROPE + (size_t)SEQ * 32 * 8);
constexpr size_t BAR_BYTES = 32768;
constexpr size_t WS_TOTAL = al256(WS_BAR + BAR_BYTES);
static_assert((size_t)T * DM * 4 <= (size_t)T * NP * 2, "YO fits in P");
#ifndef EMU
static_assert(WS_TOTAL <= (size_t)268435456, "workspace map must fit 256 MiB");
#endif

constexpr int LDS_BYTES = 163840;

struct Params {
    const float* in[26];
    float* out;
    char* ws;
};
enum { I_X = 0, I_C, I_CTX, I_CCTX, I_WADA, I_BADA, I_GPRE, I_GPOST, I_WIN, I_MGB, I_MNG, I_HCW, I_HCB, I_HW1, I_HB1, I_HW2, I_HB2, I_HW3, I_HB3,
       I_HFREQ, I_HD, I_GWA, I_GBA, I_GNG, I_SINK, I_WOUT };

__device__ __forceinline__ Params relaunder(const Params& pk) {
#ifdef EMU
    return pk;
#else
    Params p = pk; size_t z = 0; asm volatile("" : "+s"(z)); p.ws = pk.ws + z; p.out = pk.out + z;
#pragma unroll
    for (int i = 0; i < 26; ++i) p.in[i] = pk.in[i] + z;
    return p;
#endif
}
constexpr int WLDS = (LDS_BYTES - 64) / 8 / 16 * 16;
#ifdef EMU
#define WAVE_SYNC() emu_wave_sync()
#else
#define WAVE_SYNC() do { asm volatile("s_waitcnt lgkmcnt(0)" ::: "memory"); __builtin_amdgcn_wave_barrier(); } while (0)
#endif

#ifdef EMU
__device__ __forceinline__ int otid() { return (int)threadIdx.x; }
__device__ __forceinline__ int obid() { return (int)blockIdx.x; }
#else
__device__ __forceinline__ int otid() { int t = (int)threadIdx.x; asm volatile("" : "+v"(t)); return t; }
__device__ __forceinline__ int obid() { int b = (int)blockIdx.x; asm volatile("" : "+s"(b)); return b; }
#endif
__device__ __forceinline__ unsigned fbits(float f) { return __builtin_bit_cast(unsigned, f); }
__device__ __forceinline__ float bitsf(unsigned u) { return __builtin_bit_cast(float, u); }
__device__ __forceinline__ float bf2f(bf16 h) { return bitsf((unsigned)h << 16); }
#ifdef EMU
__device__ __forceinline__ bf16 f2bf(float f) { unsigned u = fbits(f); return (bf16)((u + 0x7fffu + ((u >> 16) & 1u)) >> 16); }
__device__ __forceinline__ unsigned pk2(float lo, float hi) { return (unsigned)f2bf(lo) | ((unsigned)f2bf(hi) << 16); }
#else
typedef __bf16 nbf16x2 __attribute__((ext_vector_type(2)));
typedef float nf32x2 __attribute__((ext_vector_type(2)));
__device__ __forceinline__ unsigned pk2(float lo, float hi) { const nf32x2 v = {lo, hi}; return __builtin_bit_cast(unsigned, __builtin_convertvector(v, nbf16x2)); }
__device__ __forceinline__ bf16 f2bf(float f) { return (bf16)(pk2(f, 0.0f) & 0xffffu); }
#endif
#ifdef EMU
__device__ __forceinline__ float frcp_(float x) { return 1.0f / x; }
#else
__device__ __forceinline__ float frcp_(float x) { return __builtin_amdgcn_rcpf(x); }
#endif
__device__ __forceinline__ float sigmoidf_(float x) { return frcp_(1.0f + __expf(-x)); }
__device__ __forceinline__ float siluf_(float x) { return x * frcp_(1.0f + __expf(-x)); }
__device__ __forceinline__ float logsigf_(float x) { return fminf(x, 0.0f) - log1pf(__expf(-fabsf(x))); }
__device__ __forceinline__ float logsig_fast(float x) { return fminf(x, 0.0f) - __logf(1.0f + __expf(-fabsf(x))); }
#ifdef EMU
__device__ __forceinline__ float row16_sum(float x) { x += __shfl_xor(x, 1); x += __shfl_xor(x, 2); x += __shfl_xor(x, 4); x += __shfl_xor(x, 8); return x; }
__device__ __forceinline__ float row16_max(float x) { x = fmaxf(x, __shfl_xor(x, 1)); x = fmaxf(x, __shfl_xor(x, 2)); x = fmaxf(x, __shfl_xor(x, 4)); x = fmaxf(x, __shfl_xor(x, 8)); return x; }
__device__ __forceinline__ float xrow_sum(float x) { x += __shfl_xor(x, 16); x += __shfl_xor(x, 32); return x; }
__device__ __forceinline__ float xrow_max(float x) { x = fmaxf(x, __shfl_xor(x, 16)); x = fmaxf(x, __shfl_xor(x, 32)); return x; }
#else
template <int CTRL> __device__ __forceinline__ float dpp_(float x) { return __builtin_bit_cast(float, __builtin_amdgcn_mov_dpp(__builtin_bit_cast(int, x), CTRL, 0xf, 0xf, true)); }
__device__ __forceinline__ float row16_sum(float x) { x += dpp_<0xB1>(x); x += dpp_<0x4E>(x); x += dpp_<0x141>(x); x += dpp_<0x128>(x); return x; }
__device__ __forceinline__ float row16_max(float x) { x = fmaxf(x, dpp_<0xB1>(x)); x = fmaxf(x, dpp_<0x4E>(x)); x = fmaxf(x, dpp_<0x141>(x)); x = fmaxf(x, dpp_<0x128>(x)); return x; }
__device__ __forceinline__ float xrow_sum(float x) {
    auto s = __builtin_amdgcn_permlane16_swap(fbits(x), fbits(x), false, false); x = bitsf(s[0]) + bitsf(s[1]);
    auto t = __builtin_amdgcn_permlane32_swap(fbits(x), fbits(x), false, false); return bitsf(t[0]) + bitsf(t[1]); }
__device__ __forceinline__ float xrow_max(float x) {
    auto s = __builtin_amdgcn_permlane16_swap(fbits(x), fbits(x), false, false); x = fmaxf(bitsf(s[0]), bitsf(s[1]));
    auto t = __builtin_amdgcn_permlane32_swap(fbits(x), fbits(x), false, false); return fmaxf(bitsf(t[0]), bitsf(t[1])); }
#endif
__device__ __forceinline__ float wave_sum(float v) { return xrow_sum(row16_sum(v)); }
__device__ __forceinline__ float wave_max(float v) { return xrow_max(row16_max(v)); }
template <int DIR> __device__ __forceinline__ void xrow_scan(float s4, int lane, float& e, float& tot) {
    const int q4 = lane >> 4;
#ifdef EMU
    const int r = lane & 15; const float v0 = __shfl(s4, r), v1 = __shfl(s4, 16 + r), v2 = __shfl(s4, 32 + r), v3 = __shfl(s4, 48 + r);
    tot = (v0 + v1) + (v2 + v3);
    if (DIR == 0) e = (q4 & 2 ? v0 + v1 : 0.f) + (q4 & 1 ? (q4 & 2 ? v2 : v0) : 0.f); else e = (q4 & 2 ? 0.f : v2 + v3) + (q4 & 1 ? 0.f : (q4 & 2 ? v3 : v1));
#else
    auto sw = __builtin_amdgcn_permlane16_swap(fbits(s4), fbits(s4), false, false); const float a = bitsf(sw[0]), b = bitsf(sw[1]);
    const float pp = a + b;
    auto tw = __builtin_amdgcn_permlane32_swap(fbits(pp), fbits(pp), false, false); const float p0 = bitsf(tw[0]), p1 = bitsf(tw[1]);
    tot = p0 + p1;
    if (DIR == 0) e = (q4 & 2 ? p0 : 0.f) + (q4 & 1 ? a : 0.f); else e = (q4 & 2 ? 0.f : p1) + (q4 & 1 ? 0.f : b);
#endif
}
#ifdef EMU
__device__ __forceinline__ float wave_prefix_sum(float v, int lane) {
#pragma unroll
    for (int o = 1; o < 64; o <<= 1) { float t = __shfl_up(v, o); if (lane >= o) v += t; }
    return v;
}
__device__ __forceinline__ float wave_prefix_max(float v, int lane) {
#pragma unroll
    for (int o = 1; o < 64; o <<= 1) { float t = __shfl_up(v, o); if (lane >= o) v = fmaxf(v, t); }
    return v;
}
#else
template <int CTRL, int RM> __device__ __forceinline__ float dppo_(float old, float x) { return __builtin_bit_cast(float, __builtin_amdgcn_update_dpp(__builtin_bit_cast(int, old), __builtin_bit_cast(int, x), CTRL, RM, 0xf, false)); }
__device__ __forceinline__ float wave_prefix_sum(float v, int) {
    v += dppo_<0x111, 0xf>(0.f, v); v += dppo_<0x112, 0xf>(0.f, v); v += dppo_<0x114, 0xf>(0.f, v); v += dppo_<0x118, 0xf>(0.f, v);
    v += dppo_<0x142, 0xa>(0.f, v); v += dppo_<0x143, 0xc>(0.f, v); return v;
}
__device__ __forceinline__ float wave_prefix_max(float v, int) {
    const float ninf = -INFINITY;
    v = fmaxf(v, dppo_<0x111, 0xf>(ninf, v)); v = fmaxf(v, dppo_<0x112, 0xf>(ninf, v)); v = fmaxf(v, dppo_<0x114, 0xf>(ninf, v)); v = fmaxf(v, dppo_<0x118, 0xf>(ninf, v));
    v = fmaxf(v, dppo_<0x142, 0xa>(ninf, v)); v = fmaxf(v, dppo_<0x143, 0xc>(ninf, v)); return v;
}
#endif
__device__ __forceinline__ float wave_suffix_max(float v, int lane) {
    return __shfl(wave_prefix_max(__shfl(v, 63 - lane), lane), 63 - lane);
}
__device__ __forceinline__ void unpack8(u32x4 v, float* f) {
    f[0] = bitsf(v.x << 16); f[1] = bitsf(v.x & 0xffff0000u); f[2] = bitsf(v.y << 16); f[3] = bitsf(v.y & 0xffff0000u);
    f[4] = bitsf(v.z << 16); f[5] = bitsf(v.z & 0xffff0000u); f[6] = bitsf(v.w << 16); f[7] = bitsf(v.w & 0xffff0000u);
}
__device__ __forceinline__ int orig_col(int n) {
    if (n < 1280) return n;
    if (n < 2304) return 2320 + (n - 1280);
    if (n < 3072) return 3376 + (n - 2304);
    if (n < 3088) return 1280 + (n - 3072);
    if (n < 3120) return 3344 + (n - 3088);
    if (n < NMAIN) return -1;
    return 1296 + (n - NMAIN);
}
__device__ __forceinline__ int chain_cid(int dir, int o) {
    if (dir == 0) return o;
    return o < NCC ? (NCC - 1 - o) : (NCH - 1 - (o - NCC));
}

__device__ __forceinline__ int swz(int row, int ch) { return row * 64 + ((ch ^ (row & 7)) << 3); }
__device__ __forceinline__ u32x4 pack8(const float* f) { u32x4 o; o.x = pk2(f[0], f[1]); o.y = pk2(f[2], f[3]); o.z = pk2(f[4], f[5]); o.w = pk2(f[6], f[7]); return o; }
__device__ __forceinline__ bf16x8 as_frag(u32x4 v) { return __builtin_bit_cast(bf16x8, v); }
#ifdef EMU
inline u32x2 lds_tr16(const bf16* p) { unsigned mine[2]; const unsigned long long a = (unsigned long long)p; mine[0] = (unsigned)a; mine[1] = (unsigned)(a >> 32);
    auto buf = emu::collective(mine, 2); const int l = emu::cur()->lane, g = l >> 4, i = l & 15; unsigned short e[4];
    for (int j = 0; j < 4; ++j) { const int src = 16 * g + 4 * j + (i >> 2); const bf16* q = (const bf16*)(((unsigned long long)buf[src][1] << 32) | buf[src][0]); e[j] = *(const unsigned short*)(q + (i & 3)); }
    u32x2 r; r.x = (unsigned)e[0] | ((unsigned)e[1] << 16); r.y = (unsigned)e[2] | ((unsigned)e[3] << 16); return r; }
#else
typedef short v4i16_t __attribute__((ext_vector_type(4)));
__device__ __forceinline__ u32x2 lds_tr16(const bf16* p) { return __builtin_bit_cast(u32x2, __builtin_amdgcn_ds_read_tr16_b64_v4i16((__attribute__((address_space(3))) v4i16_t*)p)); }
#endif
__device__ __forceinline__ u32x4 as_u4(bf16x8 v) { return __builtin_bit_cast(u32x4, v); }

constexpr int LS = 72;

template <int NTL, int KS>
__device__ __forceinline__ void mma_nt(const bf16* A, int lda, int m0, const bf16* B, int ldb, int n0, f32x4 (&acc)[NTL], int lane) {
    const int r = lane & 15, q = lane >> 4;
#pragma unroll
    for (int ks = 0; ks < KS; ++ks) {
        const bf16x8 a = *(const bf16x8*)(A + (m0 + r) * lda + ks * 32 + q * 8);
#pragma unroll
        for (int nt = 0; nt < NTL; ++nt) {
            const bf16x8 b = *(const bf16x8*)(B + (n0 + nt * 16 + r) * ldb + ks * 32 + q * 8);
            acc[nt] = MFMA16(a, b, acc[nt]);
        }
    }
}

__device__ __forceinline__ void layer_prep(const Params& p, int l, int idx, int stride, char* smem);
__device__ __forceinline__ void phase0(const Params& p, char* smem) {
    const int tid = otid();
    cpx* TW = (cpx*)(p.ws + WS_TW);
    cpx* ROPE = (cpx*)(p.ws + WS_ROPE);
    float* MOD = (float*)(p.ws + WS_MOD);
    constexpr int N_TW = NF / NT, N_ROPE = SEQ * 32 / NT, N_MOD = DEPTH * (3 * DM / 64);
    for (int task = obid(); task < N_TW + N_ROPE + N_MOD; task += gridDim.x) {
        if (task < N_TW) {
            const int j = task * NT + tid; float s, c; sincospif(2.0f * (float)j / (float)NF, &s, &c);
            cpx v; v.x = c; v.y = -s; TW[j] = v;
        } else if (task < N_TW + N_ROPE) {
            const int idx = (task - N_TW) * NT + tid; const int pos = idx >> 5, i = idx & 31;
            const float inv = exp2f(-(float)(i & 15) * (13.287712379549449f / 16.0f));
            const float ang = (float)(i < 16 ? pos / 64 : pos % 64) * inv;
            cpx v; v.x = cosf(ang); v.y = sinf(ang); ROPE[idx] = v;
        } else {
            const int mt = task - N_TW - N_ROPE; const int l = mt / (3 * DM / 64), n0 = (mt % (3 * DM / 64)) * 64;
            float* sv = (float*)smem;
            float* red = sv + NJ * DM;
            __syncthreads();
            for (int i = tid; i < NJ * DM; i += NT) { const int j = i / DM, k = i % DM; const float v = j < NB ? p.in[I_C][j * DM + k] : p.in[I_CCTX][k]; sv[i] = siluf_(v); }
            __syncthreads();
            const int c4 = tid & 15, kg = tid >> 4; f32x4 acc[NJ];
#pragma unroll
            for (int j = 0; j < NJ; ++j) acc[j] = (f32x4){0.f, 0.f, 0.f, 0.f};
            const float* w = p.in[I_WADA] + (size_t)l * DM * 3 * DM + n0 + 4 * c4;
            static_assert((DM / 32) % 8 == 0, "weight loads in batches of 8");
#pragma unroll 1
            for (int i0 = 0; i0 < DM / 32; i0 += 8) { f32x4 wv[8];
#pragma unroll
                for (int i = 0; i < 8; ++i) wv[i] = NT_LOAD4(w + (size_t)(kg + 32 * (i0 + i)) * 3 * DM);
                SCHED_FENCE();
#pragma unroll
                for (int i = 0; i < 8; ++i) { const int k = kg + 32 * (i0 + i);
#pragma unroll
                    for (int j = 0; j < NJ; ++j) acc[j] = acc[j] + wv[i] * sv[j * DM + k]; } }
#pragma unroll
            for (int j = 0; j < NJ; ++j) *(f32x4*)(red + (kg * NJ + j) * 64 + 4 * c4) = acc[j];
            __syncthreads();
            for (int i = tid; i < NJ * 64; i += NT) { const int j = i / 64, n = i % 64; float s = 0.f;
#pragma unroll
                for (int k8 = 0; k8 < 32; ++k8) s += red[(k8 * NJ + j) * 64 + n];
                MOD[((size_t)l * NJ + j) * 3 * DM + n0 + n] = s + p.in[I_BADA][(size_t)l * 3 * DM + n0 + n]; }
        }
    }
}

#ifdef EMU
constexpr int PANEL_ROWS = 128, PANEL_UNITS = DM / 128;
#else
constexpr int PANEL_ROWS = 256, PANEL_UNITS = DM / 256;
#endif
__device__ __forceinline__ unsigned* unit_counter(const Params& p, int isctx) { return (unsigned*)(p.ws + WS_BAR + 16384) + 64 * isctx; }
__device__ __forceinline__ unsigned* stage_counter(const Params& p, int flag) { return (unsigned*)(p.ws + WS_BAR + 16384) + 512 + 512 * flag; }
__device__ __forceinline__ void stage_signal(const Params& p, char* smem, int flag, int l) {
#ifdef EMU
    __syncthreads(); if (otid() == 0) *stage_counter(p, flag) += 1u;
#else
    asm volatile("s_waitcnt vmcnt(0)" ::: "memory"); __syncthreads();
    if (threadIdx.x == 0) {
        const unsigned xcc = (unsigned)__builtin_amdgcn_s_getreg((3 << 11) | 20) & 0xFu, nloc = ((volatile __attribute__((address_space(3))) unsigned*)(smem + LDS_BYTES - 64))[0];
        unsigned* g = stage_counter(p, flag);
        if (nloc > 0u) { const unsigned old = __hip_atomic_fetch_add(g + 16 * (1 + xcc), 1u, __ATOMIC_RELAXED, __HIP_MEMORY_SCOPE_AGENT);
            if (old + 1u == nloc * (unsigned)(l + 1)) { __builtin_amdgcn_fence(__ATOMIC_RELEASE, "agent"); asm volatile("s_waitcnt vmcnt(0)" ::: "memory");
                __hip_atomic_fetch_add(g, nloc, __ATOMIC_RELAXED, __HIP_MEMORY_SCOPE_AGENT); } }
        else { __builtin_amdgcn_fence(__ATOMIC_RELEASE, "agent"); asm volatile("s_waitcnt vmcnt(0)" ::: "memory"); __hip_atomic_fetch_add(g, 1u, __ATOMIC_RELAXED, __HIP_MEMORY_SCOPE_AGENT); }
    }
#endif
}
__device__ __forceinline__ void stage_wait(const Params& p, int flag, int l) {
    if (otid() == 0) { const unsigned target = (unsigned)gridDim.x * (unsigned)(l + 1);
#ifdef EMU
        while (*(volatile unsigned*)stage_counter(p, flag) < target) emu::yield();
#else
        unsigned spins = 0;
        while (__hip_atomic_load(stage_counter(p, flag), __ATOMIC_RELAXED, __HIP_MEMORY_SCOPE_AGENT) < target) { __builtin_amdgcn_s_sleep(16); if (++spins > (1u << 20)) break; }
        __builtin_amdgcn_fence(__ATOMIC_ACQUIRE, "agent"); asm volatile("s_waitcnt vmcnt(0)" ::: "memory");
#endif
    }
    __syncthreads();
}
__device__ __forceinline__ int logical_row(int i) { return i < NB * SEQ ? (i / SEQ) * TOK + CTXL + i % SEQ : ((i - NB * SEQ) / CTXL) * TOK + (i - NB * SEQ) % CTXL; }
struct RowRef { const float* xo; float* xn; int mj, row; bool ok; };
__device__ __forceinline__ RowRef rp_ref(const Params& p, int l, int li, int base, int hi) {
    RowRef r; r.ok = li < hi; const int rr = logical_row(r.ok ? li : base); r.row = rr;
    const int b = rr / TOK, pp = rr % TOK; const bool isctx = pp < CTXL; if (l == DEPTH && isctx) r.ok = false;
    const size_t off = isctx ? ((size_t)b * CTXL + pp) * DM : ((size_t)b * SEQ + (pp - CTXL)) * DM;
    float* CTXB = (float*)(p.ws + WS_CTXB);
    r.xo = (l <= 1) ? (isctx ? p.in[I_CTX] + off : p.in[I_X] + off) : (isctx ? CTXB + off : p.out + off);
    r.xn = isctx ? CTXB + off : p.out + off; r.mj = isctx ? NB : b; return r;
}
__device__ __forceinline__ void rp_rows(const Params& p, int l, int lo, int hi, int gi, int nb) {
    const int tid = otid(), lane = tid & 63, wave = tid >> 6;
    const float* MOD = (const float*)(p.ws + WS_MOD);
    const bf16* YO = (const bf16*)(p.ws + WS_P);
    bf16* HN = (bf16*)(p.ws + WS_HNY);
    constexpr int NV4 = DM / 256, RW = 2;
    const int stride = nb * 8;
    f32x4 xq[RW][NV4]; u32x2 yq[RW][NV4]; RowRef rq[RW];
    int base = lo + gi * 8 + wave;
    if (base < hi) {
#pragma unroll
        for (int i = 0; i < RW; ++i) { rq[i] = rp_ref(p, l, base + i * stride, base, hi);
#pragma unroll
            for (int j = 0; j < NV4; ++j) { xq[i][j] = NT_LOAD4(rq[i].xo + 4 * lane + 256 * j); yq[i][j] = (l > 0) ? *(const u32x2*)(YO + (size_t)rq[i].row * DM + 4 * lane + 256 * j) : (u32x2){0u, 0u}; } }
    }
    for (; base < hi; base += stride * RW) {
        f32x4 x[RW][NV4], y[RW][NV4]; RowRef rc[RW];
#pragma unroll
        for (int i = 0; i < RW; ++i) { rc[i] = rq[i];
#pragma unroll
            for (int j = 0; j < NV4; ++j) { x[i][j] = xq[i][j]; const u32x2 yy = yq[i][j]; y[i][j] = (f32x4){bitsf(yy.x << 16), bitsf(yy.x & 0xffff0000u), bitsf(yy.y << 16), bitsf(yy.y & 0xffff0000u)}; } }
        { const int nbase = base + stride * RW;
            if (nbase < hi) {
#pragma unroll
                for (int i = 0; i < RW; ++i) { rq[i] = rp_ref(p, l, nbase + i * stride, nbase, hi);
#pragma unroll
                    for (int j = 0; j < NV4; ++j) { xq[i][j] = NT_LOAD4(rq[i].xo + 4 * lane + 256 * j); if (l > 0) yq[i][j] = *(const u32x2*)(YO + (size_t)rq[i].row * DM + 4 * lane + 256 * j); } } } }
        if (l > 0) {
            float ss[RW];
#pragma unroll
            for (int i = 0; i < RW; ++i) { ss[i] = 0.f;
#pragma unroll
                for (int j = 0; j < NV4; ++j) ss[i] += y[i][j].x * y[i][j].x + y[i][j].y * y[i][j].y + y[i][j].z * y[i][j].z + y[i][j].w * y[i][j].w; }
#pragma unroll
            for (int i = 0; i < RW; ++i) ss[i] = wave_sum(ss[i]);
            const float* gp = p.in[I_GPOST] + (size_t)(l - 1) * DM;
            float rstd[RW]; const float* gt[RW];
#pragma unroll
            for (int i = 0; i < RW; ++i) { rstd[i] = rsqrtf(ss[i] * (1.0f / DM) + EPS); gt[i] = MOD + ((size_t)(l - 1) * NJ + rc[i].mj) * 3 * DM + 2 * DM; }
            f32x4 p4n = *(const f32x4*)(gp + 4 * lane), g4n[RW];
#pragma unroll
            for (int i = 0; i < RW; ++i) g4n[i] = *(const f32x4*)(gt[i] + 4 * lane);
#pragma unroll
            for (int j = 0; j < NV4; ++j) { const f32x4 p4 = p4n; f32x4 g4[RW];
#pragma unroll
                for (int i = 0; i < RW; ++i) g4[i] = g4n[i];
                if (j + 1 < NV4) { p4n = *(const f32x4*)(gp + 4 * lane + 256 * (j + 1));
#pragma unroll
                    for (int i = 0; i < RW; ++i) g4n[i] = *(const f32x4*)(gt[i] + 4 * lane + 256 * (j + 1)); }
#pragma unroll
                for (int i = 0; i < RW; ++i) { x[i][j] = x[i][j] + g4[i] * (y[i][j] * rstd[i] * p4);
                    if (rc[i].ok) NT_STORE4(rc[i].xn + 4 * lane + 256 * j, x[i][j]); } }
        }
        if (l < DEPTH) {
            float ss[RW];
#pragma unroll
            for (int i = 0; i < RW; ++i) { ss[i] = 0.f;
#pragma unroll
                for (int j = 0; j < NV4; ++j) ss[i] += x[i][j].x * x[i][j].x + x[i][j].y * x[i][j].y + x[i][j].z * x[i][j].z + x[i][j].w * x[i][j].w; }
#pragma unroll
            for (int i = 0; i < RW; ++i) ss[i] = wave_sum(ss[i]);
            const float* gp = p.in[I_GPRE] + (size_t)l * DM;
            float rstd[RW]; const float* md[RW];
#pragma unroll
            for (int i = 0; i < RW; ++i) { rstd[i] = rsqrtf(ss[i] * (1.0f / DM) + EPS); md[i] = MOD + ((size_t)l * NJ + rc[i].mj) * 3 * DM; }
            f32x4 g4n = *(const f32x4*)(gp + 4 * lane), shn[RW], scn[RW];
#pragma unroll
            for (int i = 0; i < RW; ++i) { shn[i] = *(const f32x4*)(md[i] + 4 * lane); scn[i] = *(const f32x4*)(md[i] + DM + 4 * lane); }
#pragma unroll
            for (int j = 0; j < NV4; ++j) { const int e = 4 * lane + 256 * j; const f32x4 g4 = g4n; f32x4 sh[RW], sc[RW];
#pragma unroll
                for (int i = 0; i < RW; ++i) { sh[i] = shn[i]; sc[i] = scn[i]; }
                if (j + 1 < NV4) { g4n = *(const f32x4*)(gp + e + 256);
#pragma unroll
                    for (int i = 0; i < RW; ++i) { shn[i] = *(const f32x4*)(md[i] + e + 256); scn[i] = *(const f32x4*)(md[i] + DM + e + 256); } }
#pragma unroll
                for (int i = 0; i < RW; ++i) { const f32x4 h = (x[i][j] * rstd[i] * g4) * (sc[i] + 1.0f) + sh[i];
                    u32x2 o; o.x = pk2(h.x, h.y); o.y = pk2(h.z, h.w);
                    if (rc[i].ok) *(u32x2*)(HN + (size_t)rc[i].row * DM + e) = o; } }
        }
    }
}

__device__ __forceinline__ void convert_tile(const float* src, int ldn, bf16* dst, int K, int n0, int k0, bool use_map, char* smem) {
    const int tid = otid();
    float* tile = (float*)smem;
    __syncthreads();
#pragma unroll
    for (int i = 0; i < 8; ++i) { const int idx = tid + NT * i, k = idx >> 6, n = idx & 63;
        const int oc = use_map ? orig_col(n0 + n) : (n0 + n);
        tile[k * 65 + n] = oc >= 0 ? src[(size_t)(k0 + k) * ldn + oc] : 0.f; }
    __syncthreads();
    const int n = tid >> 3, c = tid & 7;
    u32x4 o; o.x = pk2(tile[(8 * c + 0) * 65 + n], tile[(8 * c + 1) * 65 + n]); o.y = pk2(tile[(8 * c + 2) * 65 + n], tile[(8 * c + 3) * 65 + n]);
    o.z = pk2(tile[(8 * c + 4) * 65 + n], tile[(8 * c + 5) * 65 + n]); o.w = pk2(tile[(8 * c + 6) * 65 + n], tile[(8 * c + 7) * 65 + n]);
    *(u32x4*)(dst + (size_t)(n0 + n) * K + k0 + 8 * c) = o;
}

__device__ __forceinline__ void filter_task(const Params& p, int l, int L, int pos0, char* smem) {
    const int tid = otid(), j = tid & 63;
    float* z = (float*)smem;
    float* h1 = z + 8 * 33;
    float* h2 = h1 + 8 * 64;
    const float* w1 = p.in[I_HW1] + (size_t)l * 33 * 64; const float* w2 = p.in[I_HW2] + (size_t)l * 64 * 64; const float* w3 = p.in[I_HW3] + (size_t)l * 64 * 512;
    float r1[33], r2[64], r3a[16];
#pragma unroll
    for (int i = 0; i < 33; ++i) r1[i] = w1[i * 64 + j];
#pragma unroll
    for (int i = 0; i < 64; ++i) r2[i] = w2[i * 64 + j];
    const float b1 = p.in[I_HB1][l * 64 + j], b2 = p.in[I_HB2][l * 64 + j], b3 = p.in[I_HB3][l * 512 + tid];
    const float f0 = p.in[I_HFREQ][(l * 2 + 0) * 64 + j], f1 = p.in[I_HFREQ][(l * 2 + 1) * 64 + j];
    __syncthreads();
    if (tid < 8 * 33) { const int pp = tid / 33, i = tid % 33; const float pos = (float)(pos0 + pp);
        const float t = pos / (float)(L - 1 > 1 ? L - 1 : 1), wv = 6.283185307179586f * pos / (float)L; float v;
        if (i == 0) v = t; else { const int bi = (i - 1) & 15; const float f = 1e-4f + (float)bi * ((15.0f - 1e-4f) / 15.0f); v = (i <= 16) ? cosf(wv * f) : -sinf(wv * f); }
        z[tid] = v; }
    __syncthreads();
    { const int pp = tid >> 6; float a = b1;
#pragma unroll
        for (int i = 0; i < 33; ++i) a += z[pp * 33 + i] * r1[i];
        h1[tid] = sinf(f0 * a);
#pragma unroll
        for (int i = 0; i < 16; ++i) r3a[i] = w3[i * 512 + tid]; }
    __syncthreads();
    { const int pp = tid >> 6; float a = b2;
#pragma unroll
        for (int i = 0; i < 64; ++i) a += h1[pp * 64 + i] * r2[i];
        h2[tid] = sinf(f1 * a); }
    __syncthreads();
    { const int o = tid, dir = o >> 8, c = o & 255;
        const float delta = 3.0701134573253946f + (float)c * ((15.350567286626973f - 3.0701134573253946f) / 255.0f);
        float acc[8];
#pragma unroll
        for (int pp = 0; pp < 8; ++pp) acc[pp] = b3;
#pragma unroll 1
        for (int cix = 0; cix < 4; ++cix) {
            float wn[16];
#pragma unroll
            for (int i = 0; i < 16; ++i) wn[i] = (cix < 3) ? w3[(16 * (cix + 1) + i) * 512 + o] : 0.f;
#pragma unroll
            for (int i = 0; i < 16; ++i) {
#pragma unroll
                for (int pp = 0; pp < 8; ++pp) acc[pp] += h2[pp * 64 + 16 * cix + i] * r3a[i]; }
#pragma unroll
            for (int i = 0; i < 16; ++i) r3a[i] = wn[i]; }
        float* KT = (float*)(p.ws + WS_KT); float* HC = (float*)(p.ws + WS_HC);
#pragma unroll
        for (int pp = 0; pp < 8; ++pp) { const int pos = pos0 + pp; const float t = (float)pos / (float)(L - 1 > 1 ? L - 1 : 1);
            const float v = acc[pp] * __expf(-t * delta);
            if (L == SEQ) { if (dir == 0) KT[(size_t)c * NF + pos]= v; else if (pos > 0) KT[(size_t)c * NF + (NF - pos)] = v; else KT[(size_t)c * NF + SEQ] = 0.f; }
            else HC[((size_t)dir * WG + c) * CTXL + pos] = v; }
    }
}

__device__ __forceinline__ void convert_tile_w(const float* src, int ldn, bf16* dst, int K, int n0, int k0, bool use_map, char* wl, int lane) {
    float* tile = (float*)wl;
    const int oc = use_map ? orig_col(n0 + lane) : (n0 + lane);
    float v[64];
#pragma unroll
    for (int k = 0; k < 64; ++k) v[k] = oc >= 0 ? NT_LOAD1(src + (size_t)(k0 + k) * ldn + oc) : 0.f;
#pragma unroll
    for (int k = 0; k < 64; ++k) tile[k * 65 + lane] = v[k];
    WAVE_SYNC();
#pragma unroll
    for (int i = 0; i < 8; ++i) { const int n = (lane >> 3) + 8 * i, c = lane & 7; float f[8];
#pragma unroll
        for (int j = 0; j < 8; ++j) f[j] = tile[(8 * c + j) * 65 + n];
        *(u32x4*)(dst + (size_t)(n0 + n) * K + k0 + 8 * c) = pack8(f); }
    WAVE_SYNC();
}
__device__ __forceinline__ void prep_tiles(const Params& p, int l, int t_lo, int t_hi, int idx, int stride, char* smem) {
    const int tid = otid(), lane = tid & 63, wave = __builtin_amdgcn_readfirstlane(tid >> 6);
    char* wl = smem + wave * WLDS;
    for (int task = t_lo + wave * stride + idx; task < t_hi; task += 8 * stride) { const int nt = task / (DM / 64), kt = task % (DM / 64);
        convert_tile_w(p.in[I_WIN] + (size_t)l * DM * N_IN, N_IN, (bf16*)(p.ws + WS_WIN), DM, nt * 64, kt * 64, true, wl, lane); }
}
__device__ __forceinline__ void prep_filters(const Params& p, int l, int idx, int stride, char* smem) {
    constexpr int N_FL = SEQ / 8, N_FC = CTXL / 8;
    for (int task = idx; task < N_FL + N_FC; task += stride) {
        if (task < N_FL) filter_task(p, l, SEQ, task * 8, smem);
        else filter_task(p, l, CTXL, (task - N_FL) * 8, smem);
    }
    __syncthreads();
}
__device__ __forceinline__ void layer_prep(const Params& p, int l, int idx, int stride, char* smem) {
    constexpr int N_WIN = (NPAD / 64) * (DM / 64);
    prep_filters(p, l, idx, stride, smem);
    prep_tiles(p, l, 0, N_WIN, idx, stride, smem);
}
__device__ __forceinline__ unsigned* row_queue(const Params& p, int l) { return (unsigned*)(p.ws + WS_BAR + 16384) + 2560 + 64 * l; }
__device__ __forceinline__ void wait_units(const Params& p, int c, int l) {
    constexpr int nLatU = NB * (SEQ / PANEL_ROWS) * PANEL_UNITS, nCtxU = NB * (CTXL / PANEL_ROWS) * PANEL_UNITS;
    const unsigned target = (unsigned)((c ? nCtxU : nLatU) * l);
#ifdef EMU
    while (*(volatile unsigned*)unit_counter(p, c) < target) emu::yield();
#else
    unsigned spins = 0;
    while (__hip_atomic_load(unit_counter(p, c), __ATOMIC_RELAXED, __HIP_MEMORY_SCOPE_AGENT) < target) { __builtin_amdgcn_s_sleep(16); if (++spins > (1u << 20)) break; }
    __builtin_amdgcn_fence(__ATOMIC_ACQUIRE, "agent"); asm volatile("s_waitcnt vmcnt(0)" ::: "memory");
#endif
}
__device__ __forceinline__ void phase_rp(const Params& p, int l, char* smem) { const int G = (int)gridDim.x, bid = obid(), tid = otid();
    const bool has_ctx = l < DEPTH;
    constexpr int nLatU = NB * (SEQ / PANEL_ROWS) * PANEL_UNITS, nCtxU = NB * (CTXL / PANEL_ROWS) * PANEL_UNITS, N_WIN = (NPAD / 64) * (DM / 64);
    const int nU = nLatU + nCtxU;
    const int heavy = (l >= 1 && has_ctx && nU > G && (nU % G) != 0) ? nU % G : 0;
    const int nl = G - heavy, np = (l < DEPTH) ? nl / 2 : 0, nr = nl - np;
    if (heavy > 0 && np > 0) {
        const int tH = (3 * heavy * 8 < N_WIN) ? 3 * heavy * 8 : N_WIN;
        const int nR = ((T * 7 / 9) / (nr * 16)) * (nr * 16);
        if (bid < heavy) { prep_tiles(p, l, 0, tH, bid, heavy, smem); return; }
        const int i = bid - heavy;
        if (i & 1) { const int gi = i / 2;
            prep_filters(p, l, gi, np, smem); prep_tiles(p, l, tH, N_WIN, gi, np, smem);
            if (tid == 0) { wait_units(p, 0, l); wait_units(p, 1, l); }
            __syncthreads();
            rp_rows(p, l, nR, T, gi, np);
        } else { if (tid == 0) wait_units(p, 0, l);
            __syncthreads();
            rp_rows(p, l, 0, nR, (i + 1) / 2, nr); }
        return;
    }
    const int total = has_ctx ? T : NB * SEQ;
    int lo, hi, gi, nb; bool prep = false;
    { const int i = bid; int nR = total;
        if (np > 0) { nR = ((total * 8 / 9) / (nr * 16)) * (nr * 16); if (nR <= 0) nR = total / 2; }
        if (np > 0 && (i & 1) && i / 2 < np) { prep = true; lo = nR; hi = total; gi = i / 2; nb = np; }
        else { lo = 0; hi = nR; gi = (np > 0) ? (i + 1) / 2 : i; nb = nr; } }
    if (prep) layer_prep(p, l, gi, np, smem);
    else if (l < DEPTH && np == 0) layer_prep(p, l, bid, G, smem);
    if (l >= 1) { if (tid == 0) { if (lo < NB * SEQ) wait_units(p, 0, l); if (hi > NB * SEQ) wait_units(p, 1, l); } __syncthreads(); }
    rp_rows(p, l, lo, hi, gi, nb);
}

__device__ __forceinline__ cpx cmul(cpx a, cpx b) { cpx r; r.x = a.x * b.x - a.y * b.y; r.y = a.x * b.y + a.y * b.x; return r; }
__device__ __forceinline__ cpx cmulc(cpx a, cpx b) { cpx r; r.x = a.x * b.x + a.y * b.y; r.y = a.y * b.x - a.x * b.y; return r; }
constexpr int fpad(int i) { return i + (i >> 4); }
__device__ __forceinline__ int FPH(int i) { return i + (i >> 4); }
constexpr int FBUF = fpad(NF);
constexpr int ilog16(int n) { return n < 16 ? 0 : 1 + ilog16(n / 16); }
constexpr int FFT_P16 = ilog16(NF);
constexpr bool FFT_R4 = ((NF >> (4 * FFT_P16)) == 4);
static_assert((NF >> (4 * FFT_P16)) == 1 || (NF >> (4 * FFT_P16)) == 4, "NF = 16^a * (1 or 4)");
template <bool INV> __device__ __forceinline__ void dft4(cpx& a0, cpx& a1, cpx& a2, cpx& a3) {
    const cpx s = {a0.x + a2.x, a0.y + a2.y}, b = {a0.x - a2.x, a0.y - a2.y}, c = {a1.x + a3.x, a1.y + a3.y}, d = {a1.x - a3.x, a1.y - a3.y};
    a0 = (cpx){s.x + c.x, s.y + c.y}; a2 = (cpx){s.x - c.x, s.y - c.y};
    if (!INV) { a1 = (cpx){b.x + d.y, b.y - d.x}; a3 = (cpx){b.x - d.y, b.y + d.x}; }
    else      { a1 = (cpx){b.x - d.y, b.y + d.x}; a3 = (cpx){b.x + d.y, b.y - d.x}; }
}
template <bool INV> __device__ __forceinline__ cpx cmulk(cpx a, float wr, float wi) {
    cpx r; if (!INV) { r.x = a.x * wr + a.y * wi; r.y = a.y * wr - a.x * wi; } else { r.x = a.x * wr - a.y * wi; r.y = a.y * wr + a.x * wi; } return r;
}
template <bool INV> __device__ __forceinline__ void dft16(cpx (&x)[16]) {
    constexpr float C1 = 0.92387953251128674f, S1 = 0.38268343236508977f, C2 = 0.70710678118654752f;
#pragma unroll
    for (int n2 = 0; n2 < 4; ++n2) dft4<INV>(x[n2], x[4 + n2], x[8 + n2], x[12 + n2]);
    x[4 * 1 + 1] = cmulk<INV>(x[4 * 1 + 1], C1, S1); x[4 * 1 + 2] = cmulk<INV>(x[4 * 1 + 2], C2, C2); x[4 * 1 + 3] = cmulk<INV>(x[4 * 1 + 3], S1, C1);
    x[4 * 2 + 1] = cmulk<INV>(x[4 * 2 + 1], C2, C2); x[4 * 2 + 2] = cmulk<INV>(x[4 * 2 + 2], 0.f, 1.f); x[4 * 2 + 3] = cmulk<INV>(x[4 * 2 + 3], -C2, C2);
    x[4 * 3 + 1] = cmulk<INV>(x[4 * 3 + 1], S1, C1); x[4 * 3 + 2] = cmulk<INV>(x[4 * 3 + 2], -C2, C2); x[4 * 3 + 3] = cmulk<INV>(x[4 * 3 + 3], -C1, -S1);
#pragma unroll
    for (int k1 = 0; k1 < 4; ++k1) dft4<INV>(x[4 * k1 + 0], x[4 * k1 + 1], x[4 * k1 + 2], x[4 * k1 + 3]);
    cpx t;
    t = x[1]; x[1] = x[4]; x[4] = t; t = x[2]; x[2] = x[8]; x[8] = t; t = x[3]; x[3] = x[12]; x[12] = t;
    t = x[6]; x[6] = x[9]; x[9] = t; t = x[7]; x[7] = x[13]; x[13] = t; t = x[11]; x[11] = x[14]; x[14] = t;
}
template <bool INV> __device__ __forceinline__ void fft_stage16(cpx* buf, const cpx* TW, int tl, int M) {
    const int span = M >> 4, twm = NF / M;
#pragma unroll 1
    for (int j = tl; j < NF / 16; j += 256) {
        const int grp = j / span, pos = j % span, base = grp * M + pos; cpx x[16];
#pragma unroll
        for (int q = 0; q < 16; ++q) x[q] = buf[FPH(base + q * span)];
        cpx w1 = {1.f, 0.f}; if (span > 1) w1 = TW[pos * twm];
        if (INV && span > 1) { cpx wk = w1;
#pragma unroll
            for (int k = 1; k < 16; ++k) { x[k] = cmulc(x[k], wk); wk = cmul(wk, w1); } }
        dft16<INV>(x);
        if (!INV && span > 1) { cpx wk = w1;
#pragma unroll
            for (int k = 1; k < 16; ++k) { x[k] = cmul(x[k], wk); wk = cmul(wk, w1); } }
#pragma unroll
        for (int q = 0; q < 16; ++q) buf[FPH(base + q * span)] = x[q];
    }
}
template <bool INV> __device__ __forceinline__ void fft_stage4_last(cpx* buf, int tl) {
#pragma unroll 1
    for (int j = tl; j < NF / 4; j += 256) { cpx a0 = buf[FPH(4 * j)], a1 = buf[FPH(4 * j + 1)], a2 = buf[FPH(4 * j + 2)], a3 = buf[FPH(4 * j + 3)];
        dft4<INV>(a0, a1, a2, a3); buf[FPH(4 * j)] = a0; buf[FPH(4 * j + 1)] = a1; buf[FPH(4 * j + 2)] = a2; buf[FPH(4 * j + 3)] = a3; }
}
__device__ __forceinline__ void fft_fwd(cpx* buf, const cpx* TW, int tl) {
    int M = NF;
#pragma unroll
    for (int s = 0; s < FFT_P16; ++s) { __syncthreads(); fft_stage16<false>(buf, TW, tl, M); M >>= 4; }
    if (FFT_R4) { __syncthreads(); fft_stage4_last<false>(buf, tl); }
    __syncthreads();
}
__device__ __forceinline__ void fft_inv(cpx* buf, const cpx* TW, int tl) {
    if (FFT_R4) { __syncthreads(); fft_stage4_last<true>(buf, tl); }
    int M = FFT_R4 ? 64 : 16;
#pragma unroll
    for (int s = 0; s < FFT_P16; ++s) { __syncthreads(); fft_stage16<true>(buf, TW, tl, M); M <<= 4; }
    __syncthreads();
}
__device__ __forceinline__ void filt_fft_task(const Params& p, int cp, char* smem) {
    const int tid = otid(), half = tid >> 8, tl = tid & 255, c = 2 * cp + half;
    cpx* buf = (cpx*)smem + (size_t)half * FBUF;
    const float* KT = (const float*)(p.ws + WS_KT) + (size_t)c * NF;
    cpx* KF = (cpx*)(p.ws + WS_KF) + (size_t)c * NF;
    const cpx* TW = (const cpx*)(p.ws + WS_TW);
    __syncthreads();
    for (int i = tl; i < NF; i += 256) { cpx v; v.x = KT[i]; v.y = 0.f; buf[FPH(i)] = v; }
    fft_fwd(buf, TW, tl);
    for (int i = tl; i < NF; i += 256) KF[i] = buf[FPH(i)];
}

__device__ __forceinline__ void gemm_tile(const Params& p, const bf16* A, const bf16* Bt, int K, int mt, int nt, int mode, char* smem) {
    const int tid = otid(), lane = tid & 63, wave = tid >> 6;
    bf16* As = (bf16*)smem;
    bf16* Bs = As + 128 * LS;
    const int wm = (wave & 3) * 32, wn = (wave >> 2) * 64;
    f32x4 acc[2][4];
#pragma unroll
    for (int i = 0; i < 2; ++i)
#pragma unroll
        for (int j = 0; j < 4; ++j) acc[i][j] = (f32x4){0.f, 0.f, 0.f, 0.f};
    const int lr = tid >> 3, lc = tid & 7;
    const bf16* Ag = A + (size_t)(mt * 128 + lr) * K + lc * 8;
    const bf16* Bg = Bt + (size_t)(nt * 128 + lr) * K + lc * 8;
    u32x4 ra0, ra1, rb0, rb1;
    ra0 = *(const u32x4*)(Ag); ra1 = *(const u32x4*)(Ag + (size_t)64 * K); rb0 = *(const u32x4*)(Bg); rb1 = *(const u32x4*)(Bg + (size_t)64 * K);
    const int nk = K / 64;
    for (int kt = 0; kt < nk; ++kt) {
        __syncthreads();
        *(u32x4*)(As + lr * LS + lc * 8) = ra0; *(u32x4*)(As + (lr + 64) * LS + lc * 8) = ra1;
        *(u32x4*)(Bs + lr * LS + lc * 8) = rb0; *(u32x4*)(Bs + (lr + 64) * LS + lc * 8) = rb1;
        __syncthreads();
        if (kt + 1 < nk) { const int ko = (kt + 1) * 64;
            ra0 = *(const u32x4*)(Ag + ko); ra1 = *(const u32x4*)(Ag + (size_t)64 * K + ko); rb0 = *(const u32x4*)(Bg + ko); rb1 = *(const u32x4*)(Bg + (size_t)64 * K + ko); }
        mma_nt<4, 2>(As, LS, wm, Bs, LS, wn, acc[0], lane);
        mma_nt<4, 2>(As, LS, wm + 16, Bs, LS, wn, acc[1], lane);
    }
    const int r = lane & 15, q = lane >> 4;
#pragma unroll
    for (int i = 0; i < 2; ++i)
#pragma unroll
        for (int j = 0; j < 4; ++j)
#pragma unroll
            for (int e = 0; e < 4; ++e) {
                const int row = mt * 128 + wm + 16 * i + 4 * q + e, col = nt * 128 + wn + 16 * j + r; const float v = acc[i][j][e];
                if (mode == 0) { if (col < NP) ((bf16*)(p.ws + WS_P))[(size_t)row * NP + col] = f2bf(v); else if (col < NP + 16) ((float*)(p.ws + WS_G))[(size_t)row * NGS + (col - NP)] = v; else if (col < NP + NG) ((bf16*)((float*)(p.ws + WS_G) + (size_t)row * NGS + 16))[col - NP - 16] = f2bf(v); }
                else if (mode == 2) ((bf16*)(p.ws + WS_HT))[(size_t)row * T + col] = f2bf(v);
                else ((bf16*)(p.ws + WS_P))[(size_t)row * DM + col] = f2bf(v);
            }
}

#ifndef EMU
namespace pg8 {
#define PG8_LAS __attribute__((address_space(3)))
typedef unsigned short bf16_t;
typedef short bf16x8 __attribute__((ext_vector_type(8)));
typedef float f32x4 __attribute__((ext_vector_type(4)));
typedef unsigned u32x4 __attribute__((ext_vector_type(4)));
constexpr int BM = 256, BK = 64, HALF = 128, HTB = HALF * BK * 2  , STAGE_BYTES = 8 * HTB, NXCD = 8, WGM = 8;

__host__ __device__ __forceinline__ int lds_byte(int r, int c) { const int st = (r >> 4) * 2 + (c >> 5), rr = r & 15, cc = c & 31, ob = rr * 64 + cc * 2; return st * 1024 + (ob ^ (((ob >> 9) & 1) << 5)); }
__host__ __device__ __forceinline__ void stage_rc(int b, int& R, int& C) { const int st = b / 1024, sb = b % 1024, swz = sb ^ (((sb >> 9) & 1) << 5); R = (st >> 1) * 16 + swz / 64; C = (st & 1) * 32 + (swz % 64) / 2; }
__host__ __device__ __forceinline__ int perm32(int rho) { const int n = rho >> 4, i = rho & 15; return 8 * (i >> 2) + 4 * n + (i & 3); }

struct Unit { int pm, pn; };
struct Gemm { const bf16_t* A; const bf16_t* Bt; int M, N, K; };
__device__ __forceinline__ unsigned cvt_pk_bf16(float lo, float hi) { unsigned r; asm volatile("v_cvt_pk_bf16_f32 %0, %1, %2" : "=v"(r) : "v"(lo), "v"(hi)); return r; }
template <class Epi, class Sched, bool ALIGN_EPI = false, bool SP2 = false>
__device__ __forceinline__ void gemm_phase(PG8_LAS unsigned char* lds, const Gemm g, const Sched& S, const Epi& E) {
    const int tid = otid(), wid = __builtin_amdgcn_readfirstlane(tid >> 6), lane = tid & 63, wr = wid >> 2, wc = wid & 3, fr = lane & 15, fq = lane >> 4;
    const int K = g.K, nt = K / BK;
    unsigned voffA[2], voffB[2];
#pragma unroll
    for (int i = 0; i < 2; ++i) { int R, C; stage_rc(tid * 16 + i * 8192, R, C); const int Rb = Epi::PERM ? ((R & ~31) + perm32(R & 31)) : R;
        voffA[i] = (unsigned)(R * K + C) * 2u; voffB[i] = (unsigned)(Rb * K + C) * 2u; }
    const size_t kstep = (size_t)(BK * 2);
    const size_t hstep = (size_t)HALF * K * 2;
    const size_t tstep = 2 * hstep;
    const unsigned ldsw = (unsigned)wid * 1024u;
    const int aoff = lds_byte(wr * 64 + fr, fq * 8), boff = lds_byte(wc * 32 + fr, fq * 8);
#define PG8_SA(b, h) (((b) * 2 + (h)) * HTB)
#define PG8_SB(b, h) ((4 + (b) * 2 + (h)) * HTB)
#define PG8_STAGE(bufoff, gbase, voff) do { _Pragma("unroll") for (int _i = 0; _i < 2; ++_i) \
        __builtin_amdgcn_global_load_lds((const unsigned*)((const char*)(gbase) + (voff)[_i]), (PG8_LAS unsigned*)(lds + (bufoff) + ldsw + _i * 8192), 16, 0, 0); } while (0)
#define PG8_LDA(dst, b, h) do { _Pragma("unroll") for (int m = 0; m < 4; ++m) _Pragma("unroll") for (int k = 0; k < 2; ++k) dst[m][k] = *(const PG8_LAS bf16x8*)(lds + PG8_SA(b, h) + aoff + m * 2048 + k * 1024); } while (0)
#define PG8_LDB(dst, b, h) do { _Pragma("unroll") for (int n = 0; n < 2; ++n) _Pragma("unroll") for (int k = 0; k < 2; ++k) dst[n][k] = *(const PG8_LAS bf16x8*)(lds + PG8_SB(b, h) + boff + n * 2048 + k * 1024); } while (0)
#define PG8_MMA(ai, bj, At, Bt) do { __builtin_amdgcn_s_setprio(1); _Pragma("unroll") for (int m = 0; m < 4; ++m) _Pragma("unroll") for (int n = 0; n < 2; ++n) _Pragma("unroll") for (int k = 0; k < 2; ++k) \
        acc[ai][bj][m][n] = __builtin_amdgcn_mfma_f32_16x16x32_bf16(Bt[n][k], At[m][k], acc[ai][bj][m][n], 0, 0, 0); __builtin_amdgcn_s_setprio(0); } while (0)
#define PG8_WAIT_V(n) asm volatile("s_waitcnt vmcnt(" #n ")" ::: "memory")
#define PG8_WAIT_L(n) asm volatile("s_waitcnt lgkmcnt(" #n ")" ::: "memory")
#define PG8_BAR __builtin_amdgcn_s_barrier()
#define PG8_SCHED __builtin_amdgcn_sched_barrier(0)
    Unit cur, nxt; int ui = 0;
    if (!S.next(0, cur)) return;
    f32x4 acc[2][2][4][2];
#pragma unroll
    for (int a = 0; a < 2; ++a)
#pragma unroll
        for (int b = 0; b < 2; ++b)
#pragma unroll
            for (int m = 0; m < 4; ++m)
#pragma unroll
                for (int n = 0; n < 2; ++n) acc[a][b][m][n] = (f32x4){0.f, 0.f, 0.f, 0.f};
    bf16x8 At[4][2], B0[2][2], B1[2][2];
    const char* cA = (const char*)g.A + (size_t)cur.pm * tstep; const char* cB = (const char*)g.Bt + (size_t)cur.pn * tstep;
    S.a_ready(cur);
    if constexpr (SP2) {
        PG8_STAGE(PG8_SB(0, 0), cB, voffB); PG8_STAGE(PG8_SB(0, 1), cB + hstep, voffB); PG8_STAGE(PG8_SA(0, 0), cA, voffA); PG8_STAGE(PG8_SA(0, 1), cA + hstep, voffA);
        if (wr == 1) PG8_BAR;
        PG8_WAIT_V(2); PG8_BAR;
        PG8_STAGE(PG8_SB(1, 0), cB + kstep, voffB); PG8_STAGE(PG8_SA(1, 0), cA + kstep, voffA); PG8_STAGE(PG8_SB(1, 1), cB + hstep + kstep, voffB);
        PG8_WAIT_V(6); PG8_BAR;
    } else {
        PG8_STAGE(PG8_SB(0, 0), cB, voffB); PG8_STAGE(PG8_SA(0, 0), cA, voffA); PG8_STAGE(PG8_SB(0, 1), cB + hstep, voffB); PG8_STAGE(PG8_SA(0, 1), cA + hstep, voffA);
        if (wr == 1) PG8_BAR;
        PG8_WAIT_V(4); PG8_BAR;
        PG8_STAGE(PG8_SB(1, 0), cB + kstep, voffB); PG8_STAGE(PG8_SA(1, 0), cA + kstep, voffA); PG8_STAGE(PG8_SB(1, 1), cB + hstep + kstep, voffB);
        PG8_WAIT_V(6); PG8_BAR;
    }
    for (;;) {
        const bool has_next = S.next(ui + 1, nxt);
        const char* nA = has_next ? (const char*)g.A + (size_t)nxt.pm * tstep : cA; const char* nB = has_next ? (const char*)g.Bt + (size_t)nxt.pn * tstep : cB;
        for (int t = 0; t < nt; t += 2) {
            const bool last = (t == nt - 2);
            const char* a1 = cA + (size_t)(t + 1) * kstep;
            const char* a2 = last ? nA : cA + (size_t)(t + 2) * kstep; const char* b2 = last ? nB : cB + (size_t)(t + 2) * kstep;
            const char* a3 = a2 + kstep; const char* b3 = b2 + kstep;
            if (last && has_next) S.a_ready(nxt);
            if constexpr (SP2) {
            PG8_LDB(B0, 0, 0); PG8_LDB(B1, 0, 1); PG8_SCHED; PG8_LDA(At, 0, 0); PG8_STAGE(PG8_SA(1, 1), a1 + hstep, voffA);
            PG8_WAIT_V(8); PG8_WAIT_L(0); PG8_BAR; PG8_MMA(0, 0, At, B0); PG8_MMA(0, 1, At, B1); PG8_BAR; PG8_SCHED;
            PG8_LDA(At, 0, 1); PG8_STAGE(PG8_SB(0, 0), b2, voffB); PG8_STAGE(PG8_SB(0, 1), b2 + hstep, voffB); PG8_STAGE(PG8_SA(0, 0), a2, voffA);
            PG8_WAIT_V(8); PG8_WAIT_L(0); PG8_BAR; PG8_MMA(1, 0, At, B0); PG8_MMA(1, 1, At, B1); PG8_BAR; PG8_SCHED;
            PG8_LDB(B0, 1, 0); PG8_LDB(B1, 1, 1); PG8_SCHED; PG8_LDA(At, 1, 0); PG8_STAGE(PG8_SA(0, 1), a2 + hstep, voffA);
            PG8_WAIT_V(8); PG8_WAIT_L(0); PG8_BAR; PG8_MMA(0, 0, At, B0); PG8_MMA(0, 1, At, B1); PG8_BAR; PG8_SCHED;
            PG8_LDA(At, 1, 1); PG8_STAGE(PG8_SB(1, 0), b3, voffB); PG8_STAGE(PG8_SB(1, 1), b3 + hstep, voffB); PG8_STAGE(PG8_SA(1, 0), a3, voffA);
            PG8_WAIT_V(8); PG8_WAIT_L(0); PG8_BAR; PG8_MMA(1, 0, At, B0); PG8_MMA(1, 1, At, B1); PG8_BAR; PG8_SCHED;
            } else {
            PG8_LDB(B0, 0, 0); PG8_SCHED; PG8_LDA(At, 0, 0); PG8_STAGE(PG8_SA(1, 1), a1 + hstep, voffA);
            PG8_WAIT_L(8); PG8_BAR; PG8_WAIT_L(0); PG8_MMA(0, 0, At, B0); PG8_BAR; PG8_SCHED;
            PG8_LDB(B1, 0, 1); PG8_STAGE(PG8_SB(0, 0), b2, voffB);
            PG8_BAR; PG8_WAIT_L(0); PG8_MMA(0, 1, At, B1); PG8_BAR;
            PG8_LDA(At, 0, 1); PG8_STAGE(PG8_SA(0, 0), a2, voffA);
            PG8_BAR; PG8_WAIT_L(0); PG8_MMA(1, 0, At, B0); PG8_BAR; PG8_SCHED;
            PG8_STAGE(PG8_SB(0, 1), b2 + hstep, voffB);
            PG8_WAIT_V(6); PG8_BAR; PG8_MMA(1, 1, At, B1); PG8_BAR;
            PG8_LDB(B0, 1, 0); PG8_SCHED; PG8_LDA(At, 1, 0); PG8_STAGE(PG8_SA(0, 1), a2 + hstep, voffA);
            PG8_WAIT_L(8); PG8_BAR; PG8_WAIT_L(0); PG8_MMA(0, 0, At, B0); PG8_BAR; PG8_SCHED;
            PG8_LDB(B1, 1, 1); PG8_STAGE(PG8_SB(1, 0), b3, voffB);
            PG8_BAR; PG8_WAIT_L(0); PG8_MMA(0, 1, At, B1); PG8_BAR;
            PG8_LDA(At, 1, 1); PG8_STAGE(PG8_SA(1, 0), a3, voffA);
            PG8_BAR; PG8_WAIT_L(0); PG8_MMA(1, 0, At, B0); PG8_BAR; PG8_SCHED;
            PG8_STAGE(PG8_SB(1, 1), b3 + hstep, voffB);
            PG8_WAIT_V(6); PG8_BAR; PG8_MMA(1, 1, At, B1); PG8_BAR;
            }
        }
        if constexpr (ALIGN_EPI) { if (wr == 0) PG8_BAR; }
        if constexpr (!Epi::AFTER_DRAIN) { E(acc, cur, wr, wc, fr, fq); S.done(cur); }
        if (!has_next) break;
#pragma unroll
        for (int a = 0; a < 2; ++a)
#pragma unroll
            for (int b = 0; b < 2; ++b)
#pragma unroll
                for (int m = 0; m < 4; ++m)
#pragma unroll
                    for (int n = 0; n < 2; ++n) acc[a][b][m][n] = (f32x4){0.f, 0.f, 0.f, 0.f};
        cur = nxt; cA = nA; cB = nB; ++ui;
        if constexpr (ALIGN_EPI) { if (wr == 1) PG8_BAR; }
    }
    PG8_WAIT_V(0);
    if constexpr (!ALIGN_EPI) { if (wr == 0) PG8_BAR; }
    PG8_BAR;
    if constexpr (Epi::AFTER_DRAIN) { E.fused(acc, cur, wr, wc, fr, fq, lds, wid, lane); S.done(cur); }
#undef PG8_SA
#undef PG8_SB
#undef PG8_STAGE
#undef PG8_LDA
#undef PG8_LDB
#undef PG8_MMA
#undef PG8_WAIT_V
#undef PG8_WAIT_L
#undef PG8_BAR
#undef PG8_SCHED
}
__device__ __forceinline__ void map_tile(int L, int nM, int nN, int& pm, int& pn) {
    const int nwg = nM * nN; int wgid = L; { const int q = nwg / NXCD, r = nwg % NXCD, xcd = wgid % NXCD, off = wgid / NXCD; wgid = (xcd < r ? xcd * (q + 1) : r * (q + 1) + (xcd - r) * q) + off; }
    const int nig = WGM * nN, gid = wgid / nig, fm = gid * WGM, gsz = (nM - fm) < WGM ? (nM - fm) : WGM;
    pm = fm + ((wgid % nig) % gsz); pn = (wgid % nig) / gsz;
}
constexpr int MP = T / 256, WP = NMAIN / 256, NU2 = 4 * MP, NU1 = MP * WP;
struct InOrder { int G, c;
    __device__ __forceinline__ bool next(int i, Unit& u) const { const int L = i * G + c; if (L >= NU2 + NU1) return false; int a, b;
        if (L < NU2) { map_tile(L, 4, MP, a, b); u.pm = MP + WP + a; u.pn = b; } else { map_tile(L - NU2, MP, WP, a, b); u.pm = a; u.pn = MP + b; } return true; }
    __device__ __forceinline__ void a_ready(const Unit&) const {}
    __device__ __forceinline__ void done(const Unit&) const {}
};
struct EpiIn { static constexpr bool PERM = true, AFTER_DRAIN = false; bf16_t* P; float* G; bf16_t* HTp;
    __device__ __forceinline__ void operator()(const f32x4 (&acc)[2][2][4][2], const Unit& u, int wr, int wc, int fr, int fq) const {
        if (u.pm < MP) { const int pn = u.pn - MP, row0 = u.pm * BM + wr * 64 + fr;
            if (pn < NP / 256) { const int col0 = pn * BM + wc * 32 + 8 * fq;
#pragma unroll
                for (int ai = 0; ai < 2; ++ai)
#pragma unroll
                    for (int m = 0; m < 4; ++m) { bf16_t* rowp = P + (size_t)(row0 + ai * HALF + m * 16) * NP + col0;
#pragma unroll
                        for (int bj = 0; bj < 2; ++bj) { const f32x4 v0 = acc[ai][bj][m][0], v1 = acc[ai][bj][m][1];
                            u32x4 w; w.x = cvt_pk_bf16(v0[0], v0[1]); w.y = cvt_pk_bf16(v0[2], v0[3]); w.z = cvt_pk_bf16(v1[0], v1[1]); w.w = cvt_pk_bf16(v1[2], v1[3]); *(u32x4*)(rowp + bj * HALF) = w; } } }
            else { const int cb = wc * 32 + 8 * fq;
                if (cb < NG) {
#pragma unroll
                    for (int ai = 0; ai < 2; ++ai)
#pragma unroll
                        for (int m = 0; m < 4; ++m) { float* rowb = G + (size_t)(row0 + ai * HALF + m * 16) * NGS; const f32x4 v0 = acc[ai][0][m][0], v1 = acc[ai][0][m][1];
                            if (cb < 16) { *(f32x4*)(rowb + cb) = v0; *(f32x4*)(rowb + cb + 4) = v1; }
                            else { u32x4 w; w.x = cvt_pk_bf16(v0[0], v0[1]); w.y = cvt_pk_bf16(v0[2], v0[3]); w.z = cvt_pk_bf16(v1[0], v1[1]); w.w = cvt_pk_bf16(v1[2], v1[3]); *(u32x4*)((bf16_t*)(rowb + 16) + (cb - 16)) = w; } } } } }
        else { const int row0 = (u.pm - MP - WP) * BM + wr * 64 + fr, col0 = u.pn * BM + wc * 32 + 8 * fq;
#pragma unroll
            for (int ai = 0; ai < 2; ++ai)
#pragma unroll
                for (int m = 0; m < 4; ++m) { bf16_t* rowp = HTp + (size_t)(row0 + ai * HALF + m * 16) * T + col0;
#pragma unroll
                    for (int bj = 0; bj < 2; ++bj) { const f32x4 v0 = acc[ai][bj][m][0], v1 = acc[ai][bj][m][1];
                        u32x4 w; w.x = cvt_pk_bf16(v0[0], v0[1]); w.y = cvt_pk_bf16(v0[2], v0[3]); w.z = cvt_pk_bf16(v1[0], v1[1]); w.w = cvt_pk_bf16(v1[2], v1[3]); *(u32x4*)(rowp + bj * HALF) = w; } } }
    }
};
struct OutOrder { int G, c; bool lat_only; unsigned* cnt;
    __device__ __forceinline__ bool next(int i, Unit& u) const { constexpr int nN = DM / 256, nLat = NB * (SEQ / 256) * nN, nCtx = NB * (CTXL / 256) * nN; const int L = i * G + c; int a, b;
        if (L < nLat) { map_tile(L, nLat / nN, nN, a, b); u.pm = (a / (SEQ / 256)) * (TOK / 256) + CTXL / 256 + a % (SEQ / 256); }
        else { if (lat_only || L >= nLat + nCtx) return false; map_tile(L - nLat, nCtx / nN, nN, a, b); u.pm = (a / (CTXL / 256)) * (TOK / 256) + a % (CTXL / 256); }
        u.pn = b; return true; }
    __device__ __forceinline__ void a_ready(const Unit&) const {}
    unsigned* xu; unsigned nloc, xtarget;
    __device__ __forceinline__ void done(const Unit& u) const {
        asm volatile("s_waitcnt vmcnt(0)" ::: "memory"); __builtin_amdgcn_s_barrier();
        if (threadIdx.x == 0) { const bool isctx = (u.pm % (TOK / 256)) < CTXL / 256;
            if (!isctx && xtarget != 0u) {
                const unsigned old = __hip_atomic_fetch_add(xu, 1u, __ATOMIC_RELAXED, __HIP_MEMORY_SCOPE_AGENT);
                if (old + 1u == xtarget) { __builtin_amdgcn_fence(__ATOMIC_RELEASE, "agent"); asm volatile("s_waitcnt vmcnt(0)" ::: "memory");
                    __hip_atomic_fetch_add(cnt, nloc, __ATOMIC_RELAXED, __HIP_MEMORY_SCOPE_AGENT); } }
            else { __builtin_amdgcn_fence(__ATOMIC_RELEASE, "agent"); asm volatile("s_waitcnt vmcnt(0)" ::: "memory");
                __hip_atomic_fetch_add(cnt + (isctx ? 64 : 0), 1u, __ATOMIC_RELAXED, __HIP_MEMORY_SCOPE_AGENT); } } }
};
struct EpiOut { static constexpr bool PERM = true, AFTER_DRAIN = false; bf16_t* C;
    __device__ __forceinline__ void operator()(const f32x4 (&acc)[2][2][4][2], const Unit& u, int wr, int wc, int fr, int fq) const {
        const int row0 = u.pm * BM + wr * 64 + fr, col0 = u.pn * BM + wc * 32 + 8 * fq;
#pragma unroll
        for (int ai = 0; ai < 2; ++ai)
#pragma unroll
            for (int m = 0; m < 4; ++m) { bf16_t* rowp = C + (size_t)(row0 + ai * HALF + m * 16) * DM + col0;
#pragma unroll
                for (int bj = 0; bj < 2; ++bj) { const f32x4 v0 = acc[ai][bj][m][0], v1 = acc[ai][bj][m][1];
                    u32x4 w; w.x = cvt_pk_bf16(v0[0], v0[1]); w.y = cvt_pk_bf16(v0[2], v0[3]); w.z = cvt_pk_bf16(v1[0], v1[1]); w.w = cvt_pk_bf16(v1[2], v1[3]); *(u32x4*)(rowp + bj * HALF) = w; } }
    }
};
}
#endif

__device__ __forceinline__ void phase_gemm_in(const Params& p, int l, char* smem) {
    constexpr int N_F = WG / 2;
#ifdef EMU
    constexpr int MT = T / 128, NT1 = NMAIN / 128, N1 = MT * NT1, N2 = 8 * MT;
    for (int task = obid(); task < N1 + N2; task += gridDim.x) {
        if (task < N1) gemm_tile(p, (const bf16*)(p.ws + WS_HNY), (const bf16*)(p.ws + WS_WIN), DM, task / NT1, task % NT1, 0, smem);
        else { const int t2 = task - N1; gemm_tile(p, (const bf16*)(p.ws + WS_WIN) + (size_t)NMAIN * DM, (const bf16*)(p.ws + WS_HNY), DM, t2 / MT, t2 % MT, 2, smem); }
    }
#else
    { const pg8::Gemm g{(const pg8::bf16_t*)(p.ws + WS_HNY), (const pg8::bf16_t*)(p.ws + WS_HNY), 0, 0, DM};
      const pg8::InOrder S{(int)gridDim.x, obid()};
      const pg8::EpiIn E{(pg8::bf16_t*)(p.ws + WS_P), (float*)(p.ws + WS_G), (pg8::bf16_t*)(p.ws + WS_HT)};
      pg8::gemm_phase<pg8::EpiIn, pg8::InOrder, true, true>((PG8_LAS unsigned char*)smem, g, S, E); }
#endif
    { const int G = (int)gridDim.x, bid = obid();
#ifdef EMU
      const int extra = 0;
#else
      const int extra = (pg8::NU1 + pg8::NU2) % G;
#endif
      if (extra > 0 && extra < G) { if (bid >= extra) for (int task = bid - extra; task < N_F; task += G - extra) filt_fft_task(p, task, smem); }
      else for (int task = G - 1 - bid; task < N_F; task += G) filt_fft_task(p, task, smem); }
}
__device__ __forceinline__ void phase_gemm_out(const Params& p, int l, char* smem) {
    const int G = (int)gridDim.x, bid = obid(); const bool has_ctx = l < DEPTH - 1;
#ifdef EMU
    constexpr int MT = T / 128, NTO = DM / 128;
    for (int task = bid; task < MT * NTO; task += G) {
        const int mt = task / NTO, nt = task % NTO;
        if (!has_ctx && (mt % (TOK / 128)) < CTXL / 128) continue;
        gemm_tile(p, (const bf16*)(p.ws + WS_HNY), (const bf16*)(p.ws + WS_WOUT), MIX, mt, nt, 1, smem);
        __syncthreads(); if (otid() == 0) *unit_counter(p, (mt % (TOK / 128)) < CTXL / 128 ? 1 : 0) += 1u;
    }
#else
    const pg8::Gemm g{(const pg8::bf16_t*)(p.ws + WS_HNY), (const pg8::bf16_t*)(p.ws + WS_WOUT), 0, 0, MIX};
    const unsigned xcc = (unsigned)__builtin_amdgcn_s_getreg((3 << 11) | 20) & 0xFu, nloc = ((volatile PG8_LAS unsigned*)(smem + LDS_BYTES - 64))[0];
    const bool agg = (NB * (SEQ / 256) * (DM / 256) == G) && nloc > 0u;
    const pg8::OutOrder S{G, bid, !has_ctx, unit_counter(p, 0), unit_counter(p, 2) + 16 * xcc, nloc, agg ? nloc * (unsigned)(l + 1) : 0u};
    const pg8::EpiOut E{(pg8::bf16_t*)(p.ws + WS_P)};
    pg8::gemm_phase<pg8::EpiOut, pg8::OutOrder, true, true>((PG8_LAS unsigned char*)smem, g, S, E);
#endif
}

__device__ __forceinline__ size_t st_index(int mixer, int dir, int b, int h, int cid) { return ((((size_t)(mixer * 2 + dir) * NB + b) * NH + h) * NCH + cid); }
__device__ __forceinline__ size_t ch_index(int dir, int b, int h, int cid) { return (((size_t)dir * NB + b) * NH + h) * NCH + cid; }

__device__ __forceinline__ void load_tile_nat(const bf16* P, int r0, int c0, bf16* dst, float scale, int tid) {
    const int s = tid >> 3, c8 = tid & 7;
    const u32x4 v = *(const u32x4*)(P + (size_t)(r0 + s) * NP + c0 + c8 * 8);
    if (scale == 1.0f) *(u32x4*)(dst + s * LS + c8 * 8) = v;
    else { float f[8]; unpack8(v, f); u32x4 o; o.x = pk2(f[0] * scale, f[1] * scale); o.y = pk2(f[2] * scale, f[3] * scale); o.z = pk2(f[4] * scale, f[5] * scale); o.w = pk2(f[6] * scale, f[7] * scale);
        *(u32x4*)(dst + s * LS + c8 * 8) = o; }
}
__device__ __forceinline__ void load_tile_tr(const bf16* P, int r0, int c0, bf16* dst, int tid) {
    const int s = tid >> 3, c8 = tid & 7;
    const u32x4 v = *(const u32x4*)(P + (size_t)(r0 + s) * NP + c0 + c8 * 8);
    const unsigned w[4] = {v.x, v.y, v.z, v.w};
#pragma unroll
    for (int j = 0; j < 4; ++j) { dst[(c8 * 8 + 2 * j) * LS + s] = (bf16)(w[j] & 0xffffu); dst[(c8 * 8 + 2 * j + 1) * LS + s] = (bf16)(w[j] >> 16); }
}

template <int NTK>
__device__ __forceinline__ void load_span(const bf16* row, int t0, float (&v)[NTK + 2]) {
    { const bool hl = t0 > 0, hr = t0 + NTK < SEQ; const bf16 xl = row[hl ? -1 : 0], xr = row[hr ? NTK : 0];
        v[0] = hl ? bf2f(xl) : 0.f; v[NTK + 1] = hr ? bf2f(xr) : 0.f; }
    if constexpr (NTK == 8) { float f[8]; unpack8(*(const u32x4*)row, f);
#pragma unroll
        for (int i = 0; i < 8; ++i) v[1 + i] = f[i]; }
    else {
#pragma unroll
        for (int i = 0; i < NTK; ++i) v[1 + i] = bf2f(row[i]); }
}
struct SpanRaw { u32x4 b; bf16 xl, xr; };
__device__ __forceinline__ SpanRaw span_load8(const bf16* row, int t0) { SpanRaw s; const bool hl = t0 > 0, hr = t0 + 8 < SEQ; s.xl = row[hl ? -1 : 0]; s.xr = row[hr ? 8 : 0]; s.b = *(const u32x4*)row; return s; }
__device__ __forceinline__ void span_expand8(const SpanRaw& s, int t0, float (&v)[10]) { float f[8]; unpack8(s.b, f); v[0] = t0 > 0 ? bf2f(s.xl) : 0.f; v[9] = (t0 + 8 < SEQ) ? bf2f(s.xr) : 0.f;
#pragma unroll
    for (int i = 0; i < 8; ++i) v[1 + i] = f[i]; }
template <int NTK>
__device__ __forceinline__ void hy_inputs(const bf16* h0, const bf16* h1, const float* cw, const float* cb, int c, int t0, float (&u0)[NTK], float (&u1)[NTK], float (&g0)[NTK], float (&g1)[NTK]) {
    if constexpr (NTK == 8) {
        const SpanRaw rxa = span_load8(h0 + (size_t)512 * T, t0), rxb = span_load8(h1 + (size_t)512 * T, t0), rga = span_load8(h0 + (size_t)768 * T, t0), rgb = span_load8(h1 + (size_t)768 * T, t0);
        const SpanRaw rva = span_load8(h0, t0), rvb = span_load8(h1, t0), rya = span_load8(h0 + (size_t)256 * T, t0), ryb = span_load8(h1 + (size_t)256 * T, t0);
        const float w0 = cw[0 * 768 + 512 + c], w1 = cw[1 * 768 + 512 + c], w2 = cw[2 * 768 + 512 + c], bb = cb[512 + c];
        const float v0 = cw[0 * 768 + c], v1 = cw[1 * 768 + c], v2 = cw[2 * 768 + c], vbias = cb[c];
        const float y0 = cw[0 * 768 + 256 + c], y1 = cw[1 * 768 + 256 + c], y2 = cw[2 * 768 + 256 + c], ybias = cb[256 + c];
        SCHED_FENCE();
        { float xa[10], xb[10], ga[10], gb[10]; span_expand8(rxa, t0, xa); span_expand8(rxb, t0, xb); span_expand8(rga, t0, ga); span_expand8(rgb, t0, gb);
#pragma unroll
            for (int i = 0; i < 8; ++i) { g0[i] = (w0 * xa[i] + w1 * xa[i + 1] + w2 * xa[i + 2] + bb) * siluf_(ga[i + 1]); g1[i] = (w0 * xb[i] + w1 * xb[i + 1] + w2 * xb[i + 2] + bb) * siluf_(gb[i + 1]); } }
        { float va[10], vb[10], ya[10], yb[10]; span_expand8(rva, t0, va); span_expand8(rvb, t0, vb); span_expand8(rya, t0, ya); span_expand8(ryb, t0, yb);
#pragma unroll
            for (int i = 0; i < 8; ++i) { u0[i] = (v0 * va[i] + v1 * va[i + 1] + v2 * va[i + 2] + vbias) * (y0 * ya[i] + y1 * ya[i + 1] + y2 * ya[i + 2] + ybias);
                u1[i] = (v0 * vb[i] + v1 * vb[i + 1] + v2 * vb[i + 2] + vbias) * (y0 * yb[i] + y1 * yb[i + 1] + y2 * yb[i + 2] + ybias); } }
        return;
    }
    { float xa[NTK + 2], xb[NTK + 2]; load_span<NTK>(h0 + (size_t)512 * T, t0, xa); load_span<NTK>(h1 + (size_t)512 * T, t0, xb);
        const float w0 = cw[0 * 768 + 512 + c], w1 = cw[1 * 768 + 512 + c], w2 = cw[2 * 768 + 512 + c], bb = cb[512 + c];
        float ga[NTK + 2], gb[NTK + 2]; load_span<NTK>(h0 + (size_t)768 * T, t0, ga); load_span<NTK>(h1 + (size_t)768 * T, t0, gb);
#pragma unroll
        for (int i = 0; i < NTK; ++i) { g0[i] = (w0 * xa[i] + w1 * xa[i + 1] + w2 * xa[i + 2] + bb) * siluf_(ga[i + 1]); g1[i] = (w0 * xb[i] + w1 * xb[i + 1] + w2 * xb[i + 2] + bb) * siluf_(gb[i + 1]); } }
    { float va[NTK + 2], vb[NTK + 2], ya[NTK + 2], yb[NTK + 2];
        load_span<NTK>(h0, t0, va); load_span<NTK>(h1, t0, vb); load_span<NTK>(h0 + (size_t)256 * T, t0, ya); load_span<NTK>(h1 + (size_t)256 * T, t0, yb);
        const float v0 = cw[0 * 768 + c], v1 = cw[1 * 768 + c], v2 = cw[2 * 768 + c], vbias = cb[c];
        const float y0 = cw[0 * 768 + 256 + c], y1 = cw[1 * 768 + 256 + c], y2 = cw[2 * 768 + 256 + c], ybias = cb[256 + c];
#pragma unroll
        for (int i = 0; i < NTK; ++i) { u0[i] = (v0 * va[i] + v1 * va[i + 1] + v2 * va[i + 2] + vbias) * (y0 * ya[i] + y1 * ya[i + 1] + y2 * ya[i + 2] + ybias);
            u1[i] = (v0 * vb[i] + v1 * vb[i + 1] + v2 * vb[i + 2] + vbias) * (y0 * yb[i] + y1 * yb[i + 1] + y2 * yb[i + 2] + ybias); } }
}
__device__ __forceinline__ void hylat_task(const Params& p, int l, int bp, int cp, char* smem) {
    const int tid = otid(), half = tid >> 8, tl = tid & 255, c = 2 * cp + half;
    const bf16* HT = (const bf16*)(p.ws + WS_HT); bf16* Y = (bf16*)(p.ws + WS_HNY);
    cpx* buf = (cpx*)smem + (size_t)half * FBUF;
    const cpx* TW = (const cpx*)(p.ws + WS_TW);
    const cpx* KF = (const cpx*)(p.ws + WS_KF) + (size_t)c * NF;
    constexpr int NTK = SEQ / 256;
    const int t0 = NTK * tl;
    const float* cw = p.in[I_HCW] + (size_t)l * 3 * 768; const float* cb = p.in[I_HCB] + (size_t)l * 768;
    const size_t rb0 = (size_t)(2 * bp) * TOK + CTXL, rb1 = rb0 + TOK;
    const bf16* h0 = HT + (size_t)c * T + rb0 + t0; const bf16* h1 = h0 + TOK;
    { float u0[NTK], u1[NTK], g0[NTK], g1[NTK]; hy_inputs<NTK>(h0, h1, cw, cb, c, t0, u0, u1, g0, g1);
        __syncthreads();
#pragma unroll
        for (int i = 0; i < NTK; ++i) { cpx v; v.x = u0[i]; v.y = u1[i]; buf[FPH(t0 + i)] = v; cpx z = {0.f, 0.f}; buf[FPH(SEQ + t0 + i)] = z; } }
    fft_fwd(buf, TW, tl);
#pragma unroll 2
    for (int i = tl; i < NF; i += 256) buf[FPH(i)] = cmul(buf[FPH(i)], KF[i]);
    fft_inv(buf, TW, tl);
    const float dsk = p.in[I_HD][(size_t)l * WG + c]; const float sc = 1.0f / (float)NF;
    { const int tz = otid() & 255; const int t0z = NTK * tz;
        float u0[NTK], u1[NTK], g0[NTK], g1[NTK]; hy_inputs<NTK>(HT + (size_t)c * T + rb0 + t0z, HT + (size_t)c * T + rb0 + t0z + TOK, cw, cb, c, t0z, u0, u1, g0, g1);
        float o0[NTK], o1[NTK];
#pragma unroll
        for (int i = 0; i < NTK; ++i) { const cpx y = buf[FPH(t0z + i)]; o0[i] = g0[i] * (y.x * sc + u0[i] * dsk); o1[i] = g1[i] * (y.y * sc + u1[i] * dsk); }
        bf16* d0 = (bf16*)(p.ws + WS_HT) + (size_t)(768 + c) * T + rb0 + t0z; bf16* d1 = d0 + TOK;
        if constexpr (NTK == 8) { *(u32x4*)d0 = pack8(o0); *(u32x4*)d1 = pack8(o1); }
        else {
#pragma unroll
            for (int i = 0; i < NTK; ++i) { d0[i] = f2bf(o0[i]); d1[i] = f2bf(o1[i]); } } }
}

constexpr int HCB = 16;
__device__ __forceinline__ void hyctx_task(const Params& p, int l, int b, int cblk, char* smem) {
    const int tid = otid(); const int c0 = cblk * HCB;
    const bf16* HT = (const bf16*)(p.ws + WS_HT); bf16* Y = (bf16*)(p.ws + WS_HNY); const float* HC = (const float*)(p.ws + WS_HC);
    float* raw = (float*)smem;
    float* u = raw + 4 * CTXL * HCB;
    float* og = u + CTXL * HCB;
    float* hcm = og + CTXL * HCB;
    bf16* ob = (bf16*)raw;
    const size_t rb = (size_t)b * TOK;
    const float* cw = p.in[I_HCW] + (size_t)l * 3 * 768; const float* cbias = p.in[I_HCB] + (size_t)l * 768;
    constexpr int WT = CTXL / 32;
    __syncthreads();
    for (int i = tid; i < 4 * HCB * (CTXL / 8); i += NT) { const int k = i / (HCB * (CTXL / 8)), cc = (i / (CTXL / 8)) % HCB, ck = i % (CTXL / 8);
        float f[8]; unpack8(*(const u32x4*)(HT + (size_t)(k * 256 + c0 + cc) * T + rb + ck * 8), f);
#pragma unroll
        for (int j = 0; j < 8; ++j) raw[(k * CTXL + ck * 8 + j) * HCB + cc] = f[j]; }
    for (int i = tid; i < 2 * HCB * (CTXL / 4); i += NT) { const int dir = i / (HCB * (CTXL / 4)), cc = (i / (CTXL / 4)) % HCB, pk = i % (CTXL / 4);
        const f32x4 v = *(const f32x4*)(HC + ((size_t)dir * WG + c0 + cc) * CTXL + pk * 4); const float f[4] = {v.x, v.y, v.z, v.w};
#pragma unroll
        for (int j = 0; j < 4; ++j) { const int pos = pk * 4 + j; if (dir == 0) hcm[(CTXL + pos) * HCB + cc] = f[j]; else if (pos > 0) hcm[(CTXL - pos) * HCB + cc] = f[j]; } }
    if (tid < HCB) hcm[tid] = 0.f;
    __syncthreads();
    static_assert(NT % HCB == 0, "a thread keeps its channel over the passes: its 12 filter taps are loaded once");
    float tw0[3], tw1[3], tw2[3], tbs[3];
#pragma unroll
    for (int k = 0; k < 3; ++k) { const int ch = k * 256 + c0 + tid % HCB; tw0[k] = cw[0 * 768 + ch]; tw1[k] = cw[1 * 768 + ch]; tw2[k] = cw[2 * 768 + ch]; tbs[k] = cbias[ch]; }
    for (int i = tid; i < CTXL * HCB; i += NT) { const int t = i / HCB, cc = i % HCB; float cv[3];
#pragma unroll
        for (int k = 0; k < 3; ++k) { const float* rk = raw + k * CTXL * HCB;
            const float a = t > 0 ? rk[(t - 1) * HCB + cc] : 0.f, m = rk[t * HCB + cc], z = t < CTXL - 1 ? rk[(t + 1) * HCB + cc] : 0.f;
            cv[k] = tw0[k] * a + tw1[k] * m + tw2[k] * z + tbs[k]; }
        u[i] = cv[0] * cv[1];
        og[i] = cv[2] * siluf_(raw[(3 * CTXL + t) * HCB + cc]); }
    __syncthreads();
    { const int cc = tid % HCB, tg = tid / HCB, t0 = WT * tg; float acc[WT], w[WT];
#pragma unroll
        for (int j = 0; j < WT; ++j) { acc[j] = 0.f; w[j] = hcm[(t0 + j + CTXL) * HCB + cc]; }
#pragma unroll 8
        for (int s = 0; s < CTXL; ++s) { const float us = u[s * HCB + cc];
#pragma unroll
            for (int j = 0; j < WT; ++j) acc[j] += us * w[j];
#pragma unroll
            for (int j = WT - 1; j > 0; --j) w[j] = w[j - 1];
            w[0] = hcm[(t0 - s - 1 + CTXL) * HCB + cc]; }
        const float dsk = p.in[I_HD][(size_t)l * WG + c0 + cc];
#pragma unroll
        for (int j = 0; j < WT; ++j) { const int t = t0 + j; ob[t * HCB + cc] = f2bf(og[t * HCB + cc] * (acc[j] + u[t * HCB + cc] * dsk)); } }
    __syncthreads();
    for (int i = tid; i < CTXL * 2; i += NT) { const int t = i >> 1, hh = i & 1; *(u32x4*)(Y + (rb + t) * 1024 + YH + c0 + 8 * hh) = *(const u32x4*)(ob + t * HCB + 8 * hh); }
}

__device__ __forceinline__ void attn_task(const Params& p, int l, int b, int kvh, int qt, bool ctxq, char* smem) {
    const int tid = otid(), lane = tid & 63, wave = tid >> 6, r = lane & 15, q = lane >> 4;
    constexpr float QSC = 0.125f * 1.4426950408889634f;
    const bf16* P = (const bf16*)(p.ws + WS_P); bf16* Y = (bf16*)(p.ws + WS_HNY); const cpx* ROPE = (const cpx*)(p.ws + WS_ROPE);
    bf16* Qs = (bf16*)smem;
    bf16* Ks = Qs + 256 * LS;
    constexpr int LSV = 80;
    bf16* Vt = Ks + 64 * LS;
    bf16* Ps = Vt + 64 * LS;
    const size_t rq0 = (size_t)b * TOK + (ctxq ? 0 : CTXL) + qt * 128;
    __syncthreads();
    {
        u32x4 qlo[2], qhi[2]; f32x4 qrp[2][4];
#pragma unroll
        for (int it = 0; it < 2; ++it) { const int idx = tid + NT * it, row = idx >> 2, cpair = idx & 3, g = row >> 7, t = row & 127;
            const bf16* src = P + (rq0 + t) * NP + PD + (kvh * 2 + g) * 64; qlo[it] = *(const u32x4*)(src + cpair * 8); qhi[it] = *(const u32x4*)(src + 32 + cpair * 8);
            if (!ctxq) { const f32x4* rr = (const f32x4*)(ROPE + (size_t)(qt * 128 + t) * 32 + cpair * 8); qrp[it][0] = rr[0]; qrp[it][1] = rr[1]; qrp[it][2] = rr[2]; qrp[it][3] = rr[3]; }
            else { qrp[it][0] = qrp[it][1] = qrp[it][2] = qrp[it][3] = (f32x4){1.f, 0.f, 1.f, 0.f}; } }
        SCHED_FENCE();
#pragma unroll
        for (int it = 0; it < 2; ++it) { const int idx = tid + NT * it, row = idx >> 2, cpair = idx & 3;
            float lo[8], hi[8]; unpack8(qlo[it], lo); unpack8(qhi[it], hi);
            const float cs[8] = {qrp[it][0].x, qrp[it][0].z, qrp[it][1].x, qrp[it][1].z, qrp[it][2].x, qrp[it][2].z, qrp[it][3].x, qrp[it][3].z}, sn[8] = {qrp[it][0].y, qrp[it][0].w, qrp[it][1].y, qrp[it][1].w, qrp[it][2].y, qrp[it][2].w, qrp[it][3].y, qrp[it][3].w};
            float a[8], c2[8];
#pragma unroll
            for (int j = 0; j < 8; ++j) { a[j] = (lo[j] * cs[j] - hi[j] * sn[j]) * QSC; c2[j] = (hi[j] * cs[j] + lo[j] * sn[j]) * QSC; }
            *(u32x4*)(Qs + row * LS + cpair * 8) = pack8(a); *(u32x4*)(Qs + row * LS + 32 + cpair * 8) = pack8(c2); } }
    const int lt0 = ctxq ? 0 : (2 * qt - 2 > 0 ? 2 * qt - 2 : 0), lt1 = ctxq ? -1 : (2 * qt + 3 < SEQ / 64 - 1 ? 2 * qt + 3 : SEQ / 64 - 1);
    const int nloc = lt1 - lt0 + 1, ntiles = nloc + NCC;
    float m[2], lsum[2]; f32x4 O[2][4];
#pragma unroll
    for (int ms = 0; ms < 2; ++ms) { m[ms] = -INFINITY; lsum[ms] = 0.f;
#pragma unroll
        for (int i = 0; i < 4; ++i) O[ms][i] = (f32x4){0.f, 0.f, 0.f, 0.f}; }
    const int g = wave >> 2, tq0 = (wave & 3) * 32;
    (void)Ps;
    __syncthreads();
    bf16x8 qf[2][2];
#pragma unroll
    for (int ms = 0; ms < 2; ++ms)
#pragma unroll
        for (int ks = 0; ks < 2; ++ks) qf[ms][ks] = *(const bf16x8*)(Qs + (g * 128 + tq0 + 16 * ms + r) * LS + ks * 32 + q * 8);
    u32x4 klo = {0u, 0u, 0u, 0u}, khi = klo, vq = klo; f32x4 rp[4] = {(f32x4){1.f, 0.f, 1.f, 0.f}, (f32x4){1.f, 0.f, 1.f, 0.f}, (f32x4){1.f, 0.f, 1.f, 0.f}, (f32x4){1.f, 0.f, 1.f, 0.f}};
    const int ks_ = tid >> 2, kcp = tid & 3, vs_ = tid >> 3, vc8 = tid & 7;
#define ATT_PREFETCH(TI) do { const bool loc_ = (TI) < nloc; const int kt_ = loc_ ? lt0 + (TI) : (TI) - nloc; const size_t rk_ = (size_t)b * TOK + (loc_ ? CTXL : 0) + kt_ * 64; \
        if (tid < 256) { const bf16* src_ = P + (rk_ + ks_) * NP + PD + 256 + kvh * 64; klo = *(const u32x4*)(src_ + kcp * 8); khi = *(const u32x4*)(src_ + 32 + kcp * 8); \
            if (loc_) { const f32x4* rr_ = (const f32x4*)(ROPE + (size_t)(kt_ * 64 + ks_) * 32 + kcp * 8); rp[0] = rr_[0]; rp[1] = rr_[1]; rp[2] = rr_[2]; rp[3] = rr_[3]; } \
            else { rp[0] = rp[1] = rp[2] = rp[3] = (f32x4){1.f, 0.f, 1.f, 0.f}; } } \
        vq = *(const u32x4*)(P + (rk_ + vs_) * NP + PD + 384 + kvh * 64 + vc8 * 8); } while (0)
    ATT_PREFETCH(0);
    for (int ti = 0; ti < ntiles; ++ti) {
        const bool local = ti < nloc; const int kt = local ? lt0 + ti : ti - nloc;
        __syncthreads();
        if (tid < 256) { float lo[8], hi[8]; unpack8(klo, lo); unpack8(khi, hi);
            const float cs[8] = {rp[0].x, rp[0].z, rp[1].x, rp[1].z, rp[2].x, rp[2].z, rp[3].x, rp[3].z}, sn[8] = {rp[0].y, rp[0].w, rp[1].y, rp[1].w, rp[2].y, rp[2].w, rp[3].y, rp[3].w};
            float a[8], c2[8];
#pragma unroll
            for (int j = 0; j < 8; ++j) { a[j] = lo[j] * cs[j] - hi[j] * sn[j]; c2[j] = hi[j] * cs[j] + lo[j] * sn[j]; }
            *(u32x4*)(Ks + ks_ * LS + kcp * 8) = pack8(a); *(u32x4*)(Ks + ks_ * LS + 32 + kcp * 8) = pack8(c2); }
        *(u32x4*)(Vt + vs_ * LSV + vc8 * 8) = vq;
        __syncthreads();
        if (ti + 1 < ntiles) ATT_PREFETCH(ti + 1);
        bf16x8 kfr[4][2], vfa[4], vfb[4];
#pragma unroll
        for (int nt = 0; nt < 4; ++nt)
#pragma unroll
            for (int ks = 0; ks < 2; ++ks) kfr[nt][ks] = *(const bf16x8*)(Ks + (16 * nt + r) * LS + ks * 32 + q * 8);
#pragma unroll
        for (int me = 0; me < 4; ++me) { const bf16* vr = Vt + (4 * q + (r >> 2)) * LSV + 16 * me + 4 * (r & 3);
            const u32x2 a0 = lds_tr16(vr), a1 = lds_tr16(vr + 16 * LSV), a2 = lds_tr16(vr + 32 * LSV), a3 = lds_tr16(vr + 48 * LSV);
            u32x4 va; va.x = a0.x; va.y = a0.y; va.z = a1.x; va.w = a1.y; u32x4 vb; vb.x = a2.x; vb.y = a2.y; vb.z = a3.x; vb.w = a3.y; vfa[me] = as_frag(va); vfb[me] = as_frag(vb); }
#pragma unroll
        for (int ms = 0; ms < 2; ++ms) {
            const int qlo = qt * 128 + tq0 + 16 * ms, klo_ = kt * 64;
            if (local && (klo_ > qlo + 15 + 128 || klo_ + 63 < qlo - 128)) continue;
            const bool domask = local && (klo_ + 63 - qlo > 128 || klo_ - (qlo + 15) < -128);
            f32x4 S[4] = {(f32x4){0.f, 0.f, 0.f, 0.f}, (f32x4){0.f, 0.f, 0.f, 0.f}, (f32x4){0.f, 0.f, 0.f, 0.f}, (f32x4){0.f, 0.f, 0.f, 0.f}};
#pragma unroll
            for (int ks = 0; ks < 2; ++ks)
#pragma unroll
                for (int nt = 0; nt < 4; ++nt) S[nt] = MFMA16(kfr[nt][ks], qf[ms][ks], S[nt]);
            const int qpos = qlo + r; float mx = -INFINITY;
            if (domask) {
#pragma unroll
                for (int nt = 0; nt < 4; ++nt)
#pragma unroll
                    for (int i = 0; i < 4; ++i) { const int d = kt * 64 + nt * 16 + 4 * q + i - qpos; if (d > 128 || d < -128) S[nt][i] = -INFINITY; } }
#pragma unroll
            for (int nt = 0; nt < 4; ++nt)
#pragma unroll
                for (int i = 0; i < 4; ++i) mx = fmaxf(mx, S[nt][i]);
            mx = xrow_max(mx);
            const float mn = fmaxf(m[ms], mx); const float msafe = mn == -INFINITY ? 0.f : mn; const float alpha = EXP2(m[ms] - msafe); float sm = 0.f;
#pragma unroll
            for (int nt = 0; nt < 4; ++nt)
#pragma unroll
                for (int i = 0; i < 4; ++i) { S[nt][i] = EXP2(S[nt][i] - msafe); sm += S[nt][i]; }
            sm = xrow_sum(sm);
            lsum[ms] = lsum[ms] * alpha + sm; m[ms] = mn;
            const float pa[8] = {S[0][0], S[0][1], S[0][2], S[0][3], S[1][0], S[1][1], S[1][2], S[1][3]}, pb[8] = {S[2][0], S[2][1], S[2][2], S[2][3], S[3][0], S[3][1], S[3][2], S[3][3]};
            const bf16x8 p0 = as_frag(pack8(pa)), p1 = as_frag(pack8(pb));
#pragma unroll
            for (int me = 0; me < 4; ++me) { O[ms][me] = O[ms][me] * alpha;
                O[ms][me] = MFMA16(vfa[me], p0, O[ms][me]); O[ms][me] = MFMA16(vfb[me], p1, O[ms][me]); }
        }
    }
#undef ATT_PREFETCH
    const float sink = p.in[I_SINK][(size_t)l * NH + kvh * 2 + g];
    u32x2 ggs[2][4];
#pragma unroll
    for (int ms = 0; ms < 2; ++ms)
#pragma unroll
        for (int me = 0; me < 4; ++me) ggs[ms][me] = *(const u32x2*)(P + (rq0 + tq0 + 16 * ms + r) * NP + PD + 512 + (kvh * 2 + g) * 64 + 4 * q + 16 * me);
#pragma unroll
    for (int ms = 0; ms < 2; ++ms) { const float den = lsum[ms] + EXP2(sink * 1.4426950408889634f - m[ms]); const float inv = frcp_(den);
        const size_t row = rq0 + tq0 + 16 * ms + r; const int col = (kvh * 2 + g) * 64 + 4 * q;
#pragma unroll
        for (int me = 0; me < 4; ++me) { const u32x2 gg = ggs[ms][me];
            const float g0 = bitsf(gg.x << 16), g1 = bitsf(gg.x & 0xffff0000u), g2 = bitsf(gg.y << 16), g3 = bitsf(gg.y & 0xffff0000u);
            u32x2 o; o.x = pk2(O[ms][me][0] * inv * siluf_(g0), O[ms][me][1] * inv * siluf_(g1)); o.y = pk2(O[ms][me][2] * inv * siluf_(g2), O[ms][me][3] * inv * siluf_(g3));
            *(u32x2*)(Y + row * 1024 + YD + col + 16 * me) = o; } }
}

#ifdef EMU
__device__ __forceinline__ int olane(int lane) { return lane; }
#else
__device__ __forceinline__ int olane(int lane) { asm volatile("" : "+v"(lane)); return lane; }
#endif
__device__ __forceinline__ void load_nat_tile(const bf16* P, int row0, int col0, bf16* tile, int lane) {
    u32x4 v[8];
#pragma unroll
    for (int i = 0; i < 8; ++i) v[i] = *(const u32x4*)(P + (size_t)(row0 + (lane >> 3) + 8 * i) * NP + col0 + (lane & 7) * 8);
#pragma unroll
    for (int i = 0; i < 8; ++i) *(u32x4*)(tile + swz((lane >> 3) + 8 * i, lane & 7)) = v[i];
}
__device__ __forceinline__ bf16x8 frag_tr(const bf16* tile, int c0, int k0, int lane) {
    const int c = c0 + (lane & 15), kb = k0 + 8 * (lane >> 4); unsigned w[4];
#pragma unroll
    for (int j = 0; j < 4; ++j) w[j] = (unsigned)tile[swz(kb + 2 * j, c >> 3) + (c & 7)] | ((unsigned)tile[swz(kb + 2 * j + 1, c >> 3) + (c & 7)] << 16);
    u32x4 o; o.x = w[0]; o.y = w[1]; o.z = w[2]; o.w = w[3]; return as_frag(o);
}
__device__ __forceinline__ bf16x8 frag_tr_hw(const bf16* tile, int c0, int k0, int lane) {
    const int r = lane & 15, q = lane >> 4, row = k0 + 8 * q + (r >> 2), col = c0 + 4 * (r & 3);
    const u32x2 a = lds_tr16(tile + swz(row, col >> 3) + (col & 7)), b = lds_tr16(tile + swz(row + 4, col >> 3) + (col & 7));
    u32x4 o; o.x = a.x; o.y = a.y; o.z = b.x; o.w = b.y; return as_frag(o);
}
template <int DIR>
__device__ __forceinline__ void gla_r_frags(const float* Grow0, int lane, bf16x8 (&af)[4]) {
    const int r = lane & 15, q4 = lane >> 4;
#pragma unroll
    for (int mt = 0; mt < 4; ++mt) { u32x4 o = {0u, 0u, 0u, 0u};
        if (q4 < 2) o = *(const u32x4*)((const bf16*)(Grow0 + (size_t)(16 * mt + r) * NGS + 16) + DIR * 16 + 8 * q4);
        af[mt] = as_frag(o); }
}
template <int DIR>
__device__ __forceinline__ void gla_b_load(const Params& p, int l, int h, int nt, int lane_, u32x4& o, float& bias) {
    const int lane = olane(lane_), r = lane & 15, q4 = lane >> 4, d = h * 64 + 16 * nt + r;
    const float* wa = p.in[I_GWA] + ((size_t)(l * 2 + DIR) * 16 + 8 * (q4 & 1)) * WG + d;
    float w[8];
#pragma unroll
    for (int j = 0; j < 8; ++j) w[j] = wa[j * WG];
    bias = p.in[I_GBA][(size_t)(l * 2 + DIR) * WG + d];
    o.x = pk2(w[0], w[1]); o.y = pk2(w[2], w[3]); o.z = pk2(w[4], w[5]); o.w = pk2(w[6], w[7]);
    if (q4 >= 2) o = (u32x4){0u, 0u, 0u, 0u};
}
template <int DIR>
__device__ __forceinline__ float gla_b_col(const u32x4 o, const float bias, const bf16x8 (&af)[4], int lane_, float (&x)[4][4]) {
    const int lane = olane(lane_), r = lane & 15, q4 = lane >> 4;
    const bf16x8 bfr = as_frag(o);
#pragma unroll
    for (int mt = 0; mt < 4; ++mt) { f32x4 c = {bias, bias, bias, bias}; c = MFMA16(af[mt], bfr, c);
#pragma unroll
        for (int i = 0; i < 4; ++i) x[mt][i] = logsig_fast(c[i]) * (1.0f / 16.0f); }
    float carry = 0.f;
#pragma unroll
    for (int k = 0; k < 4; ++k) { const int mt = DIR == 0 ? k : 3 - k; float* y = x[mt];
        if (DIR == 0) { y[1] += y[0]; y[2] += y[1]; y[3] += y[2]; } else { y[2] += y[3]; y[1] += y[2]; y[0] += y[1]; }
        const float s4 = DIR == 0 ? y[3] : y[0];
        float e, tot; xrow_scan<DIR>(s4, lane, e, tot);
#pragma unroll
        for (int i = 0; i < 4; ++i) y[i] += carry + e;
        carry += tot; }
    return carry;
}

template <int MIXER, int DIR>
__device__ __forceinline__ void chunkst_dir(const Params& p, int l, int b, int h, int cid, const float* Grow0, const unsigned (&kk)[32], const bf16* Vt, bf16* Kt, const float* wvs, float* bendl, int lane_) {
    const int lane = olane(lane_), r = lane & 15, q4 = lane >> 4;
    if constexpr (MIXER == 0) {
        float nacc = 0.f;
#pragma unroll
        for (int c = 0; c < 8; ++c) { float f[8];
#pragma unroll
            for (int j = 0; j < 8; ++j) { const int s = 8 * c + j; const float kv = (s & 1) ? bitsf(kk[s >> 1] & 0xffff0000u) : bitsf(kk[s >> 1] << 16);
                f[j] = kv * 0.125f * wvs[DIR * 64 + s]; nacc += f[j]; }
            *(u32x4*)(Kt + swz(lane, c)) = pack8(f); }
        ((float*)(p.ws + WS_NV))[ch_index(DIR, b, h, cid) * 64 + lane] = nacc;
    } else {
        const bf16* P = (const bf16*)(p.ws + WS_P); const int kcol = PG + 256 + h * 64; const int r0 = b * TOK + cid * 64;
        bf16x8 af[4]; gla_r_frags<DIR>(Grow0, lane, af);
#pragma unroll 2
        for (int nt = 0; nt < 4; ++nt) { const int d = 16 * nt + r; float x[4][4];
            u32x4 wo_; float wb_; gla_b_load<DIR>(p, l, h, nt, lane, wo_, wb_); const float bend = gla_b_col<DIR>(wo_, wb_, af, lane, x);
            if (q4 == 0) { ((float*)(p.ws + WS_BE))[ch_index(DIR, b, h, cid) * 64 + d] = bend; bendl[d] = __expf(fmaxf(bend, -80.0f)); }
#pragma unroll
            for (int mt = 0; mt < 4; ++mt)
#pragma unroll
                for (int i = 0; i < 4; ++i) { const int s = 16 * mt + 4 * q4 + i; const float kv = bf2f(P[(size_t)(r0 + s) * NP + kcol + d]); const float bc = fmaxf(x[mt][i], -80.0f);
                    Kt[swz(d, s >> 3) + (s & 7)] = f2bf(kv * __expf(-bc));
                    ((bf16*)(p.ws + WS_EQ))[((size_t)DIR * T + r0 + s) * WG + h * 64 + d] = f2bf(__expf(bc)); } }
    }
    WAVE_SYNC();
    bf16x8 vf[4][2];
#pragma unroll
    for (int ne = 0; ne < 4; ++ne)
#pragma unroll
        for (int ks = 0; ks < 2; ++ks) vf[ne][ks] = frag_tr_hw(Vt, 16 * ne, 32 * ks, lane);
    bf16* dst = (bf16*)(p.ws + WS_ST) + st_index(MIXER, DIR, b, h, cid) * 4096;
#pragma unroll
    for (int me = 0; me < 4; ++me) {
        f32x4 acc[4] = {(f32x4){0.f, 0.f, 0.f, 0.f}, (f32x4){0.f, 0.f, 0.f, 0.f}, (f32x4){0.f, 0.f, 0.f, 0.f}, (f32x4){0.f, 0.f, 0.f, 0.f}};
#pragma unroll
        for (int ks = 0; ks < 2; ++ks) { const bf16x8 a = *(const bf16x8*)(Kt + swz(16 * me + r, ks * 4 + q4));
#pragma unroll
            for (int ne = 0; ne < 4; ++ne) acc[ne] = MFMA16(a, vf[ne][ks], acc[ne]); }
        f32x4 sc4 = {1.f, 1.f, 1.f, 1.f}; if constexpr (MIXER == 1) sc4 = *(const f32x4*)(bendl + 16 * me + 4 * q4);
#pragma unroll
        for (int ne = 0; ne < 4; ++ne) { const f32x4 v = acc[ne] * sc4; u32x2 o; o.x = pk2(v[0], v[1]); o.y = pk2(v[2], v[3]); *(u32x2*)(dst + (16 * ne + r) * 64 + 16 * me + 4 * q4) = o; }
    }
    WAVE_SYNC();
}
template <int MIXER>
__device__ __forceinline__ void chunkst_w(const Params& p, int l, int b, int h, int cid, char* wl, int lane) {
    const bf16* P = (const bf16*)(p.ws + WS_P); const float* G = (const float*)(p.ws + WS_G);
    const int r0 = b * TOK + cid * 64, r = lane & 15, q4 = lane >> 4;
    bf16* Kt = (bf16*)wl;
    bf16* Vt = Kt + 4096;
    float* wvs = (float*)(Vt + 4096);
    float* bendl = wvs + 128;
    const int kcol = (MIXER == 0 ? PA : PG) + 256 + h * 64, vcol = (MIXER == 0 ? PA : PG) + 512 + h * 64;
    const float* Grow0 = G + (size_t)r0 * NGS;
    bf16* Nn = Kt;
    { u32x4 vv[8], kv[8];
#pragma unroll
        for (int i = 0; i < 8; ++i) { vv[i] = *(const u32x4*)(P + (size_t)(r0 + (lane >> 3) + 8 * i) * NP + vcol + (lane & 7) * 8); kv[i] = *(const u32x4*)(P + (size_t)(r0 + (lane >> 3) + 8 * i) * NP + kcol + (lane & 7) * 8); }
#pragma unroll
        for (int i = 0; i < 8; ++i) { *(u32x4*)(Vt + swz((lane >> 3) + 8 * i, lane & 7)) = vv[i]; *(u32x4*)(Nn + swz((lane >> 3) + 8 * i, lane & 7)) = kv[i]; } }
    WAVE_SYNC();
    unsigned kk[32];
    { const int dc = 16 * q4 + 4 * (r & 3);
#pragma unroll
        for (int c = 0; c < 16; ++c) { const u32x2 t = lds_tr16(Nn + swz(4 * c + (r >> 2), dc >> 3) + (dc & 7)); kk[2 * c] = t.x; kk[2 * c + 1] = t.y; } }
    WAVE_SYNC();
    if constexpr (MIXER == 0) {
        const float* g = Grow0 + (size_t)lane * NGS; const float* gb = p.in[I_MGB] + (size_t)l * 16;
        const float gv0 = g[h], gv1 = g[4 + h], gv2 = g[8 + h], gv3 = g[12 + h], bv0 = gb[h], bv1 = gb[4 + h], bv2 = gb[8 + h], bv3 = gb[12 + h];
        const float i_f = gv0 + bv0, f_f = gv1 + bv1, i_b = gv2 + bv2, f_b = gv3 + bv3;
        const float lf = logsigf_(f_f), lb = logsigf_(f_b);
        const float bF = wave_prefix_sum(lf, lane), totF = __shfl(bF, 63);
        const float gF = totF - bF + i_f, mF = wave_max(gF);
        const float totB = wave_sum(lb), preB = wave_prefix_sum(lb, lane), bB = totB - preB + lb;
        const float gB = totB - bB + i_b, mB = wave_max(gB);
        wvs[lane] = __expf(gF - mF); wvs[64 + lane] = __expf(gB - mB);
        if (lane == 0) { float* SC = (float*)(p.ws + WS_SC);
            SC[ch_index(0, b, h, cid) * 4 + 0] = totF; SC[ch_index(0, b, h, cid) * 4 + 1] = mF;
            SC[ch_index(1, b, h, cid) * 4 + 0] = totB; SC[ch_index(1, b, h, cid) * 4 + 1] = mB; }
    }
    WAVE_SYNC();
    chunkst_dir<MIXER, 0>(p, l, b, h, cid, Grow0, kk, Vt, Kt, wvs, bendl, lane);
    chunkst_dir<MIXER, 1>(p, l, b, h, cid, Grow0, kk, Vt, Kt, wvs, bendl, lane);
}

template <int DIR>
__device__ __forceinline__ void chunkst_gla(const Params& p, int l, int b, int h, int cid, char* wl, int lane_) {
    const bf16* P = (const bf16*)(p.ws + WS_P);
    const int lane = olane(lane_), r0 = b * TOK + cid * 64, r = lane & 15, q4 = lane >> 4;
    bf16* Kt = (bf16*)wl;
    bf16* An = Kt + 4096;
    float* bendl = (float*)(An + 4096);
    const int kcol = PG + 256 + h * 64, vcol = PG + 512 + h * 64;
    const float* Grow0 = (const float*)(p.ws + WS_G) + (size_t)r0 * NGS;
    u32x4 vv[8], kv[8];
#pragma unroll
    for (int i = 0; i < 8; ++i) { vv[i] = *(const u32x4*)(P + (size_t)(r0 + (lane >> 3) + 8 * i) * NP + vcol + (lane & 7) * 8); kv[i] = *(const u32x4*)(P + (size_t)(r0 + (lane >> 3) + 8 * i) * NP + kcol + (lane & 7) * 8); }
    bf16x8 af[4]; gla_r_frags<DIR>(Grow0, lane, af);
    u32x4 wo[4]; float wb[4];
#pragma unroll
    for (int nt = 0; nt < 4; ++nt) gla_b_load<DIR>(p, l, h, nt, lane, wo[nt], wb[nt]);
#pragma unroll
    for (int i = 0; i < 8; ++i) *(u32x4*)(An + swz((lane >> 3) + 8 * i, lane & 7)) = vv[i];
    WAVE_SYNC();
    bf16x8 vf[4][2];
#pragma unroll
    for (int ne = 0; ne < 4; ++ne)
#pragma unroll
        for (int ks = 0; ks < 2; ++ks) vf[ne][ks] = frag_tr_hw(An, 16 * ne, 32 * ks, lane);
    WAVE_SYNC();
#pragma unroll
    for (int i = 0; i < 8; ++i) *(u32x4*)(An + swz((lane >> 3) + 8 * i, lane & 7)) = kv[i];
    WAVE_SYNC();
#pragma unroll
    for (int nt = 0; nt < 4; ++nt) { const int d = 16 * nt + r; float x[4][4];
        const float bend = gla_b_col<DIR>(wo[nt], wb[nt], af, lane, x);
        if (q4 == 0) { ((float*)(p.ws + WS_BE))[ch_index(DIR, b, h, cid) * 64 + d] = bend; bendl[d] = __expf(fmaxf(bend, -80.0f)); }
#pragma unroll
        for (int mt = 0; mt < 4; ++mt) { const int s0 = 16 * mt + 4 * q4, dc = 16 * nt + 4 * (r & 3);
            const u32x2 kq = lds_tr16(An + swz(s0 + (r >> 2), dc >> 3) + (dc & 7));
            const float kv[4] = {bitsf(kq.x << 16), bitsf(kq.x & 0xffff0000u), bitsf(kq.y << 16), bitsf(kq.y & 0xffff0000u)}; float kp[4];
#pragma unroll
            for (int i = 0; i < 4; ++i) { const float bc = fmaxf(x[mt][i], -80.0f); kp[i] = kv[i] * __expf(-bc); An[swz(s0 + i, d >> 3) + (d & 7)] = f2bf(__expf(bc)); }
            u32x2 o; o.x = pk2(kp[0], kp[1]); o.y = pk2(kp[2], kp[3]); *(u32x2*)(Kt + swz(d, s0 >> 3) + (s0 & 7)) = o; } }
    WAVE_SYNC();
    { bf16* EQg = (bf16*)(p.ws + WS_EQ) + ((size_t)DIR * T + r0) * WG + h * 64;
#pragma unroll
        for (int i = 0; i < 8; ++i) { const int s = (lane >> 3) + 8 * i, ck = lane & 7; *(u32x4*)(EQg + (size_t)s * WG + ck * 8) = *(const u32x4*)(An + swz(s, ck)); } }
    bf16* dst = (bf16*)(p.ws + WS_ST) + st_index(1, DIR, b, h, cid) * 4096;
#pragma unroll
    for (int me = 0; me < 4; ++me) {
        f32x4 acc[4] = {(f32x4){0.f, 0.f, 0.f, 0.f}, (f32x4){0.f, 0.f, 0.f, 0.f}, (f32x4){0.f, 0.f, 0.f, 0.f}, (f32x4){0.f, 0.f, 0.f, 0.f}};
#pragma unroll
        for (int ks = 0; ks < 2; ++ks) { const bf16x8 a = *(const bf16x8*)(Kt + swz(16 * me + r, ks * 4 + q4));
#pragma unroll
            for (int ne = 0; ne < 4; ++ne) acc[ne] = MFMA16(a, vf[ne][ks], acc[ne]); }
        const f32x4 sc4 = *(const f32x4*)(bendl + 16 * me + 4 * q4);
#pragma unroll
        for (int ne = 0; ne < 4; ++ne) { const f32x4 v = acc[ne] * sc4; u32x2 o; o.x = pk2(v[0], v[1]); o.y = pk2(v[2], v[3]); *(u32x2*)(dst + (16 * ne + r) * 64 + 16 * me + 4 * q4) = o; }
    }
    WAVE_SYNC();
}

template <int MIXER, int DIR>
__device__ __forceinline__ void chunkout_prep(const Params& p, int l, int b, int h, int cid, const float* Grow0, int r0, int pbase, const bf16* EQ, float* gar, int lane_) {
    const int lane = olane(lane_);
    if constexpr (MIXER == 0) {
        const bf16* P = (const bf16*)(p.ws + WS_P);
        const float* g = Grow0 + (size_t)lane * NGS; const float* gb = p.in[I_MGB] + (size_t)l * 16;
        const float gi = g[DIR * 8 + h], gf = g[DIR * 8 + 4 + h], bi = gb[DIR * 8 + h], bf_ = gb[DIR * 8 + 4 + h];
        const float mprev = ((const float*)(p.ws + WS_SC))[ch_index(DIR, b, h, cid) * 4 + 2];
        const float nv = ((const float*)(p.ws + WS_NV))[ch_index(DIR, b, h, cid) * 64 + lane];
        u32x4 qr[8];
#pragma unroll
        for (int c = 0; c < 8; ++c) qr[c] = *(const u32x4*)(P + (size_t)(r0 + lane) * NP + pbase + c * 8);
        const float ig = gi + bi, fg = gf + bf_;
        const float lf = logsigf_(fg); float bb;
        if (DIR == 0) bb = wave_prefix_sum(lf, lane); else { const float tt = wave_sum(lf), pre = wave_prefix_sum(lf, lane); bb = tt - pre + lf; }
        const float a = ig - bb; const float pm = DIR == 0 ? wave_prefix_max(a, lane) : wave_suffix_max(a, lane);
        const float mt_ = fmaxf(bb + mprev, bb + pm);
        float* ga = gar + DIR * 320;
        ga[lane] = bb - mt_; ga[64 + lane] = a; ga[128 + lane] = __expf(bb + mprev - mt_); ga[192 + lane] = __expf(-mt_);
        float* nvl = gar + 640 + DIR * 64;
        nvl[lane] = nv;
        WAVE_SYNC();
        float dq = 0.f;
#pragma unroll
        for (int c = 0; c < 8; ++c) { float f[8]; unpack8(qr[c], f);
            const f32x4 n0 = *(const f32x4*)(nvl + c * 8), n1 = *(const f32x4*)(nvl + c * 8 + 4);
            dq += f[0] * n0.x + f[1] * n0.y + f[2] * n0.z + f[3] * n0.w + f[4] * n1.x + f[5] * n1.y + f[6] * n1.z + f[7] * n1.w; }
        ga[256 + lane] = dq;
    }
}
template <int MIXER>
__device__ __forceinline__ void chunkout_prep2(const Params& p, int l, int b, int h, int cid, const float* Grow0, int r0, int pbase, float* gar, int lane_) {
    if constexpr (MIXER == 0) {
        const int lane = olane(lane_);
        const bf16* P = (const bf16*)(p.ws + WS_P);
        const float* g = Grow0 + (size_t)lane * NGS; const float* gb = p.in[I_MGB] + (size_t)l * 16;
        const float g0 = g[h], g1 = g[4 + h], g2 = g[8 + h], g3 = g[12 + h];
        const float mprev0 = ((const float*)(p.ws + WS_SC))[ch_index(0, b, h, cid) * 4 + 2], mprev1 = ((const float*)(p.ws + WS_SC))[ch_index(1, b, h, cid) * 4 + 2];
        const float nv0 = ((const float*)(p.ws + WS_NV))[ch_index(0, b, h, cid) * 64 + lane], nv1 = ((const float*)(p.ws + WS_NV))[ch_index(1, b, h, cid) * 64 + lane];
        u32x4 qr[8];
#pragma unroll
        for (int c = 0; c < 8; ++c) qr[c] = *(const u32x4*)(P + (size_t)(r0 + lane) * NP + pbase + c * 8);
        const float igF = g0 + gb[h], fgF = g1 + gb[4 + h], igB = g2 + gb[8 + h], fgB = g3 + gb[12 + h];
        { const float lf = logsigf_(fgF); const float bb = wave_prefix_sum(lf, lane);
            const float a = igF - bb; const float pm = wave_prefix_max(a, lane); const float mt_ = fmaxf(bb + mprev0, bb + pm); float* ga = gar;
            ga[lane] = bb - mt_; ga[64 + lane] = a; ga[128 + lane] = __expf(bb + mprev0 - mt_); ga[192 + lane] = __expf(-mt_); }
        { const float lf = logsigf_(fgB); const float tt = wave_sum(lf), pre = wave_prefix_sum(lf, lane); const float bb = tt - pre + lf;
            const float a = igB - bb; const float pm = wave_suffix_max(a, lane); const float mt_ = fmaxf(bb + mprev1, bb + pm); float* ga = gar + 320;
            ga[lane] = bb - mt_; ga[64 + lane] = a; ga[128 + lane] = __expf(bb + mprev1 - mt_); ga[192 + lane] = __expf(-mt_); }
        float* nvl = gar + 640;
        nvl[lane] = nv0; nvl[64 + lane] = nv1;
        WAVE_SYNC();
        float dq0 = 0.f, dq1 = 0.f;
#pragma unroll
        for (int c = 0; c < 8; ++c) { float f[8]; unpack8(qr[c], f);
            const f32x4 n0 = *(const f32x4*)(nvl + c * 8), n1 = *(const f32x4*)(nvl + c * 8 + 4), m0 = *(const f32x4*)(nvl + 64 + c * 8), m1 = *(const f32x4*)(nvl + 64 + c * 8 + 4);
            dq0 += f[0] * n0.x + f[1] * n0.y + f[2] * n0.z + f[3] * n0.w + f[4] * n1.x + f[5] * n1.y + f[6] * n1.z + f[7] * n1.w;
            dq1 += f[0] * m0.x + f[1] * m0.y + f[2] * m0.z + f[3] * m0.w + f[4] * m1.x + f[5] * m1.y + f[6] * m1.z + f[7] * m1.w; }
        gar[256 + lane] = dq0; gar[320 + 256 + lane] = dq1;
    }
}
template <int MIXER, int DIR, int NS>
__device__ __forceinline__ void chunkout_dir(const Params& p, int b, int h, int cid, int r0, int pbase, int th, const bf16x8 (&vtf)[4][2], const bf16* VtL, const bf16* EQ, bf16* SB, const float* gar, float* rsm, f32x4 (&htot)[NS][4], int lane_) {
    const bf16* P = (const bf16*)(p.ws + WS_P); const bf16* ST = (const bf16*)(p.ws + WS_ST);
    const int lane = olane(lane_), r = lane & 15, q4 = lane >> 4;
    const bf16* E = EQ + ((size_t)DIR * T + r0) * WG + h * 64;
    const float* ga = gar + DIR * 320;
    bf16x8 kf[4][2], ctf[4][2];
    if constexpr (MIXER == 0) {
#pragma unroll
        for (int n = 0; n < 4; ++n)
#pragma unroll
            for (int ks = 0; ks < 2; ++ks) { kf[n][ks] = *(const bf16x8*)(P + (size_t)(r0 + 16 * n + r) * NP + pbase + 256 + ks * 32 + q4 * 8); ctf[n][ks] = *(const bf16x8*)(ST + st_index(MIXER, DIR, b, h, cid) * 4096 + (16 * n + r) * 64 + ks * 32 + q4 * 8); }
    } else {
        u32x4 er[4][2];
#pragma unroll
        for (int n = 0; n < 4; ++n)
#pragma unroll
            for (int ks = 0; ks < 2; ++ks) { kf[n][ks] = *(const bf16x8*)(P + (size_t)(r0 + 16 * n + r) * NP + pbase + 256 + ks * 32 + q4 * 8);
                er[n][ks] = *(const u32x4*)(E + (size_t)(16 * n + r) * WG + ks * 32 + q4 * 8);
                ctf[n][ks] = *(const bf16x8*)(ST + st_index(MIXER, DIR, b, h, cid) * 4096 + (16 * n + r) * 64 + ks * 32 + q4 * 8); }
        SCHED_FENCE();
#pragma unroll
        for (int n = 0; n < 4; ++n)
#pragma unroll
            for (int ks = 0; ks < 2; ++ks) { float fe[8], fk[8]; unpack8(er[n][ks], fe); unpack8(as_u4(kf[n][ks]), fk);
#pragma unroll
                for (int j = 0; j < 8; ++j) fk[j] = fk[j] * frcp_(fe[j]);
                kf[n][ks] = as_frag(pack8(fk)); }
    }
    bf16x8 qraw[NS][2]; u32x4 qer[NS][2];
#pragma unroll
    for (int ms = 0; ms < NS; ++ms)
#pragma unroll
        for (int ks = 0; ks < 2; ++ks) { const int mt = NS * th + ms; qraw[ms][ks] = *(const bf16x8*)(P + (size_t)(r0 + 16 * mt + r) * NP + pbase + ks * 32 + q4 * 8);
            if constexpr (MIXER == 1) qer[ms][ks] = *(const u32x4*)(E + (size_t)(16 * mt + r) * WG + ks * 32 + q4 * 8); else qer[ms][ks] = (u32x4){0u, 0u, 0u, 0u}; }
#pragma unroll
    for (int ms = 0; ms < NS; ++ms) { const int mt = NS * th + ms;
        bf16x8 qf[2];
#pragma unroll
        for (int ks = 0; ks < 2; ++ks) { qf[ks] = qraw[ms][ks];
            if constexpr (MIXER == 1) { float fe[8], fq[8]; unpack8(qer[ms][ks], fe); unpack8(as_u4(qf[ks]), fq);
#pragma unroll
                for (int j = 0; j < 8; ++j) fq[j] *= 0.125f * fe[j];
                qf[ks] = as_frag(pack8(fq)); } }
        f32x4 S[4] = {(f32x4){0.f, 0.f, 0.f, 0.f}, (f32x4){0.f, 0.f, 0.f, 0.f}, (f32x4){0.f, 0.f, 0.f, 0.f}, (f32x4){0.f, 0.f, 0.f, 0.f}};
#pragma unroll
        for (int ks = 0; ks < 2; ++ks)
#pragma unroll
            for (int n = 0; n < 4; ++n) S[n] = MFMA16(kf[n][ks], qf[ks], S[n]);
        const int t = 16 * mt + r; float sm = 0.f; float gt = 0.f; if constexpr (MIXER == 0) gt = ga[t];
#pragma unroll
        for (int n = 0; n < 4; ++n) { f32x4 gs = {0.f, 0.f, 0.f, 0.f}; if constexpr (MIXER == 0) gs = *(const f32x4*)(ga + 64 + 16 * n + 4 * q4);
#pragma unroll
            for (int i = 0; i < 4; ++i) { const int sidx = 16 * n + 4 * q4 + i; const bool ok = DIR == 0 ? (sidx <= t) : (sidx >= t); float v = 0.f;
                if (ok) { if constexpr (MIXER == 0) v = S[n][i] * 0.125f * __expf(gt + gs[i]); else v = S[n][i]; }
                S[n][i] = v; sm += v; } }
        const float pa[8] = {S[0][0], S[0][1], S[0][2], S[0][3], S[1][0], S[1][1], S[1][2], S[1][3]}, pb[8] = {S[2][0], S[2][1], S[2][2], S[2][3], S[3][0], S[3][1], S[3][2], S[3][3]};
        const bf16x8 sm0 = as_frag(pack8(pa)), sm1 = as_frag(pack8(pb));
        float wi = 1.f, inv = 1.f;
        if constexpr (MIXER == 0) { sm = xrow_sum(sm); wi = ga[128 + t]; const float den = wi * ga[256 + t] + sm; inv = frcp_(fmaxf(fabsf(den), ga[192 + t])); }
#pragma unroll
        for (int me = 0; me < 4; ++me) { f32x4 a1 = {0.f, 0.f, 0.f, 0.f}, a2 = {0.f, 0.f, 0.f, 0.f};
            const int srow = 4 * q4 + (r >> 2), ecol = 16 * me + 4 * (r & 3);
            const u32x2 v0 = lds_tr16(VtL + swz(srow, ecol >> 3) + (ecol & 7)), v1 = lds_tr16(VtL + swz(16 + srow, ecol >> 3) + (ecol & 7)), v2 = lds_tr16(VtL + swz(32 + srow, ecol >> 3) + (ecol & 7)), v3 = lds_tr16(VtL + swz(48 + srow, ecol >> 3) + (ecol & 7));
            u32x4 va; va.x = v0.x; va.y = v0.y; va.z = v1.x; va.w = v1.y; u32x4 vb; vb.x = v2.x; vb.y = v2.y; vb.z = v3.x; vb.w = v3.y;
            a1 = MFMA16(as_frag(va), sm0, a1); a1 = MFMA16(as_frag(vb), sm1, a1);
            a2 = MFMA16(ctf[me][0], qf[0], a2); a2 = MFMA16(ctf[me][1], qf[1], a2);
            if constexpr (MIXER == 0) htot[ms][me] += (a1 + a2 * wi) * inv; else htot[ms][me] += a1 + a2; }
    }
    (void)SB; (void)rsm;
}
__device__ __forceinline__ void co_build_vt(const bf16* P, int r0, int vcol, bf16* VtL, int lane) {
    load_nat_tile(P, r0, vcol, VtL, lane);
    WAVE_SYNC();
}
template <int MIXER, int NS>
__device__ __forceinline__ void co_finalize(const Params& p, int l, int h, int r0, int pbase, int mt0, f32x4 (&htot)[NS][4], int lane_) {
    const bf16* P = (const bf16*)(p.ws + WS_P); bf16* Y = (bf16*)(p.ws + WS_HNY);
    const float* ngp = p.in[MIXER == 0 ? I_MNG : I_GNG] + (size_t)l * WG + h * 64;
    const int lz = olane(lane_), r = lz & 15, q4 = lz >> 4;
    u32x2 gq[NS][4], oq[NS][4]; f32x4 ng[4];
#pragma unroll
    for (int me = 0; me < 4; ++me) ng[me] = *(const f32x4*)(ngp + 16 * me + 4 * q4);
#pragma unroll
    for (int ms = 0; ms < NS; ++ms)
#pragma unroll
        for (int me = 0; me < 4; ++me) { const size_t off = (size_t)(r0 + 16 * (mt0 + ms) + r) * NP + pbase + 16 * me + 4 * q4;
            gq[ms][me] = *(const u32x2*)(P + off + (MIXER == 0 ? 1024 : 768)); if constexpr (MIXER == 0) oq[ms][me] = *(const u32x2*)(P + off + 768); else oq[ms][me] = (u32x2){0u, 0u}; }
#pragma unroll
    for (int ms = 0; ms < NS; ++ms) { const int mt = mt0 + ms; float ss = 0.f; float gv[4][4];
#pragma unroll
        for (int me = 0; me < 4; ++me) {
            gv[me][0] = bitsf(gq[ms][me].x << 16); gv[me][1] = bitsf(gq[ms][me].x & 0xffff0000u); gv[me][2] = bitsf(gq[ms][me].y << 16); gv[me][3] = bitsf(gq[ms][me].y & 0xffff0000u);
            if constexpr (MIXER == 0) { htot[ms][me][0] *= sigmoidf_(bitsf(oq[ms][me].x << 16)); htot[ms][me][1] *= sigmoidf_(bitsf(oq[ms][me].x & 0xffff0000u)); htot[ms][me][2] *= sigmoidf_(bitsf(oq[ms][me].y << 16)); htot[ms][me][3] *= sigmoidf_(bitsf(oq[ms][me].y & 0xffff0000u)); }
            ss += htot[ms][me][0] * htot[ms][me][0] + htot[ms][me][1] * htot[ms][me][1] + htot[ms][me][2] * htot[ms][me][2] + htot[ms][me][3] * htot[ms][me][3]; }
        ss = xrow_sum(ss);
        const float rstd = rsqrtf(ss * (1.0f / 64.0f) + EPS);
#pragma unroll
        for (int me = 0; me < 4; ++me) { const int e = 16 * me + 4 * q4; const f32x4 n4 = ng[me];
            u32x2 o; o.x = pk2(htot[ms][me][0] * rstd * n4.x * siluf_(gv[me][0]), htot[ms][me][1] * rstd * n4.y * siluf_(gv[me][1]));
            o.y = pk2(htot[ms][me][2] * rstd * n4.z * siluf_(gv[me][2]), htot[ms][me][3] * rstd * n4.w * siluf_(gv[me][3]));
            *(u32x2*)(Y + (size_t)(r0 + 16 * mt + r) * 1024 + (MIXER == 0 ? YA : YG) + h * 64 + e) = o; } }
}
template <int MIXER>
__device__ __forceinline__ void chunkout_w(const Params& p, int l, int b, int h, int cid, char* wl, int lane) {
    const bf16* P = (const bf16*)(p.ws + WS_P); const float* G = (const float*)(p.ws + WS_G);
    const int r0 = b * TOK + cid * 64;
    const int pbase = (MIXER == 0 ? PA : PG) + h * 64;
    bf16* SB = (bf16*)wl;
    float* rsm = (float*)(SB + 1024);
    float* gar = rsm + 16;
    const bf16* EQ = (const bf16*)(p.ws + WS_EQ);
    const float* Grow0 = G + (size_t)r0 * NGS;
    bf16* VtL = (bf16*)(gar + 768);
    bf16x8 vtf[4][2];
#pragma unroll
    for (int me = 0; me < 4; ++me)
#pragma unroll
        for (int ks = 0; ks < 2; ++ks) { vtf[me][ks] = (bf16x8){0, 0, 0, 0, 0, 0, 0, 0}; }
    co_build_vt(P, r0, pbase + 512, VtL, lane);
    chunkout_prep2<MIXER>(p, l, b, h, cid, Grow0, r0, pbase, gar, lane);
    WAVE_SYNC();
    constexpr int NS = 2;
#pragma unroll 1
    for (int th = 0; th < 4 / NS; ++th) {
        f32x4 htot[NS][4];
#pragma unroll
        for (int a = 0; a < NS; ++a)
#pragma unroll
            for (int c = 0; c < 4; ++c) htot[a][c] = (f32x4){0.f, 0.f, 0.f, 0.f};
        chunkout_dir<MIXER, 0, NS>(p, b, h, cid, r0, pbase, th, vtf, VtL, EQ, SB, gar, rsm, htot, lane);
        chunkout_dir<MIXER, 1, NS>(p, b, h, cid, r0, pbase, th, vtf, VtL, EQ, SB, gar, rsm, htot, lane);
        co_finalize<MIXER, NS>(p, l, h, r0, pbase, NS * th, htot, lane);
    }
}
constexpr int CO_PART = 13376;
template <int MIXER, int DIR>
__device__ __forceinline__ void chunkout_piece(const Params& p, int l, int b, int h, int cid, int mt, char* wl, int lane) {
    const bf16* P = (const bf16*)(p.ws + WS_P); const float* G = (const float*)(p.ws + WS_G);
    const int r0 = b * TOK + cid * 64; const int pbase = (MIXER == 0 ? PA : PG) + h * 64;
    bf16* SB = (bf16*)wl; float* rsm = (float*)(SB + 1024); float* gar = rsm + 16; const bf16* EQ = (const bf16*)(p.ws + WS_EQ);
    const float* Grow0 = G + (size_t)r0 * NGS; bf16* VtL = (bf16*)(gar + 768);
    bf16x8 vtf[4][2];
#pragma unroll
    for (int me = 0; me < 4; ++me)
#pragma unroll
        for (int ks = 0; ks < 2; ++ks) { vtf[me][ks] = (bf16x8){0, 0, 0, 0, 0, 0, 0, 0}; }
    co_build_vt(P, r0, pbase + 512, VtL, lane);
    chunkout_prep<MIXER, DIR>(p, l, b, h, cid, Grow0, r0, pbase, EQ, gar, lane);
    WAVE_SYNC();
    f32x4 htot[1][4] = {{(f32x4){0.f, 0.f, 0.f, 0.f}, (f32x4){0.f, 0.f, 0.f, 0.f}, (f32x4){0.f, 0.f, 0.f, 0.f}, (f32x4){0.f, 0.f, 0.f, 0.f}}};
    chunkout_dir<MIXER, DIR, 1>(p, b, h, cid, r0, pbase, mt, vtf, VtL, EQ, SB, gar, rsm, htot, lane);
    float* part = (float*)(wl + CO_PART);
#pragma unroll
    for (int me = 0; me < 4; ++me)
#pragma unroll
        for (int i = 0; i < 4; ++i) part[(me * 4 + i) * 64 + lane] = htot[0][me][i];
}
template <int MIXER>
__device__ __forceinline__ void chunkout_combine(const Params& p, int l, int b, int h, int cid, int mt, const char* smem, int lane) {
    const float* pa = (const float*)(smem + (2 * mt) * WLDS + CO_PART); const float* pb = (const float*)(smem + (2 * mt + 1) * WLDS + CO_PART);
    f32x4 htot[1][4];
#pragma unroll
    for (int me = 0; me < 4; ++me)
#pragma unroll
        for (int i = 0; i < 4; ++i) htot[0][me][i] = pa[(me * 4 + i) * 64 + lane] + pb[(me * 4 + i) * 64 + lane];
    co_finalize<MIXER, 1>(p, l, h, b * TOK + cid * 64, (MIXER == 0 ? PA : PG) + h * 64, mt, htot, lane);
}

template <bool OUT>
__device__ __forceinline__ void chunk_workers(const Params& p, int l, char* smem) {
    const int tid = otid(), lane = tid & 63, wave = __builtin_amdgcn_readfirstlane(tid >> 6);
    const int NW = (int)gridDim.x * 8, wi = wave * (int)gridDim.x + obid();
    const int c_lo = (OUT && l == DEPTH - 1) ? NCC : 0, npc = NCH - c_lo, half = NB * NH * npc;
    char* wl = smem + wave * WLDS;
    if (OUT) {
        const int cl = NCC, npl = NCH - NCC, halfl = NB * NH * npl;
#pragma unroll 1
        for (int t = wi; t < halfl; t += NW) { const int b = t / (NH * npl), h = (t / npl) % NH, cid = cl + t % npl;
            const Params q = relaunder(p); chunkout_w<1>(q, l, b, h, cid, wl, lane); }
        { const int used = halfl % NW;
#pragma unroll 1
            for (int t = (wi + NW - used) % NW; t < halfl; t += NW) { const int b = t / (NH * npl), h = (t / npl) % NH, cid = cl + t % npl;
                const Params q = relaunder(p); chunkout_w<0>(q, l, b, h, cid, wl, lane); } }
        if (l < DEPTH - 1) {
            const int nct = NB * NH * NCC;
#pragma unroll 1
            for (int st = obid(); st < 2 * nct; st += (int)gridDim.x) { const int mixer = st / nct, r2 = st % nct, b = r2 / (NH * NCC), h = (r2 / NCC) % NH, cid = r2 % NCC;
                const Params q = relaunder(p); const int mt = wave >> 1;
                __syncthreads();
                if (mixer == 0) { if (wave & 1) chunkout_piece<0, 1>(q, l, b, h, cid, mt, wl, lane); else chunkout_piece<0, 0>(q, l, b, h, cid, mt, wl, lane); }
                else            { if (wave & 1) chunkout_piece<1, 1>(q, l, b, h, cid, mt, wl, lane); else chunkout_piece<1, 0>(q, l, b, h, cid, mt, wl, lane); }
                __syncthreads();
                if (wave < 4) { if (mixer == 0) chunkout_combine<0>(q, l, b, h, cid, wave, smem, lane); else chunkout_combine<1>(q, l, b, h, cid, wave, smem, lane); }
            }
        }
    } else {
        int off = 0;
#pragma unroll 1
        for (int t = wi; t < half; t += NW) { const int b = t / (NH * npc), h = (t / npc) % NH, cid = c_lo + t % npc;
            const Params q = relaunder(p); chunkst_gla<0>(q, l, b, h, cid, wl, lane); }
        off = (off + half) % NW;
#pragma unroll 1
        for (int t = (wi + NW - off) % NW; t < half; t += NW) { const int b = t / (NH * npc), h = (t / npc) % NH, cid = c_lo + t % npc;
            const Params q = relaunder(p); chunkst_gla<1>(q, l, b, h, cid, wl, lane); }
        off = (off + half) % NW;
#pragma unroll 1
        for (int t = (wi + NW - off) % NW; t < half; t += NW) { const int b = t / (NH * npc), h = (t / npc) % NH, cid = c_lo + t % npc;
            const Params q = relaunder(p); chunkst_w<0>(q, l, b, h, cid, wl, lane); }
    }
}

__device__ __forceinline__ void phase_mix1(const Params& p, int l, char* smem) {
    const bool ctxo = l < DEPTH - 1; const int G = (int)gridDim.x, bid = obid();
    constexpr int N_HL = (NB / 2) * (WG / 2), N_HC = NB * (WG / HCB);
    chunk_workers<false>(p, l, smem);
    stage_signal(p, smem, 0, l);
    for (int t = bid; t < N_HL; t += G) hylat_task(p, l, t / (WG / 2), t % (WG / 2), smem);
    if (ctxo) for (int t = G - 1 - bid; t < N_HC; t += G) hyctx_task(p, l, t / (WG / HCB), t % (WG / HCB), smem);
    stage_signal(p, smem, 2, l);
}

constexpr int SCG = 18;
__device__ __forceinline__ void phase_scan(const Params& p, int l, char* smem) {
    const int tid = otid();
    bf16* ST = (bf16*)(p.ws + WS_ST); float* NV = (float*)(p.ws + WS_NV); const float* BE = (const float*)(p.ws + WS_BE); float* SC = (float*)(p.ws + WS_SC);
    constexpr int NCHAIN = 2 * 2 * NB * NH;
    stage_wait(p, 0, l);
    for (int item = obid() * NT + tid; item < NCHAIN * 1024; item += gridDim.x * NT) {
        const int chain = item >> 10, grp = item & 1023; const int mixer = chain / (2 * NB * NH), dir = (chain / (NB * NH)) % 2, b = (chain / NH) % NB, h = chain % NH;
        float c[4] = {0.f, 0.f, 0.f, 0.f}; float nv[4] = {0.f, 0.f, 0.f, 0.f}; float m = 0.f;
        const int d0 = (grp & 15) * 4; const bool donv = (mixer == 0) && (grp < 16);
        float* sS = (float*)smem;
        __syncthreads();
        if (mixer == 0 && tid < NCH) { const size_t ci = ch_index(dir, b, h, chain_cid(dir, tid)); sS[2 * tid] = SC[ci * 4 + 0]; sS[2 * tid + 1] = SC[ci * 4 + 1]; }
        __syncthreads();
        for (int o0 = 0; o0 < NCH; o0 += SCG) {
            u32x2 uu[SCG]; f32x4 aux[SCG];
#pragma unroll
            for (int j = 0; j < SCG; ++j) if (o0 + j < NCH) { const int cid = chain_cid(dir, o0 + j); const size_t ci = ch_index(dir, b, h, cid);
                uu[j] = *(const u32x2*)(ST + st_index(mixer, dir, b, h, cid) * 4096 + grp * 4);
                if (mixer == 0) { if (donv) aux[j] = *(const f32x4*)(NV + ci * 64 + grp * 4); }
                else aux[j] = *(const f32x4*)(BE + ci * 64 + d0); }
#pragma unroll
            for (int j = 0; j < SCG; ++j) if (o0 + j < NCH) { const int cid = chain_cid(dir, o0 + j); const size_t ci = ch_index(dir, b, h, cid);
                const float u[4] = {bitsf(uu[j].x << 16), bitsf(uu[j].x & 0xffff0000u), bitsf(uu[j].y << 16), bitsf(uu[j].y & 0xffff0000u)};
                u32x2 w; w.x = pk2(c[0], c[1]); w.y = pk2(c[2], c[3]); *(u32x2*)(ST + st_index(mixer, dir, b, h, cid) * 4096 + grp * 4) = w;
                if (mixer == 0) {
                    if (grp == 0) SC[ci * 4 + 2] = m;
                    const float s0j = sS[2 * (o0 + j)], s1j = sS[2 * (o0 + j) + 1];
                    const float mn = fmaxf(s0j + m, s1j), a = __expf(s0j + m - mn), s = __expf(s1j - mn);
#pragma unroll
                    for (int k = 0; k < 4; ++k) c[k] = a * c[k] + s * u[k];
                    if (donv) { f32x4 nw = {nv[0], nv[1], nv[2], nv[3]}; *(f32x4*)(NV + ci * 64 + grp * 4) = nw;
                        nv[0] = a * nv[0] + s * aux[j].x; nv[1] = a * nv[1] + s * aux[j].y; nv[2] = a * nv[2] + s * aux[j].z; nv[3] = a * nv[3] + s * aux[j].w; }
                    m = mn;
                } else { c[0] = __expf(aux[j].x) * c[0] + u[0]; c[1] = __expf(aux[j].y) * c[1] + u[1]; c[2] = __expf(aux[j].z) * c[2] + u[2]; c[3] = __expf(aux[j].w) * c[3] + u[3]; } }
        }
    }
    stage_signal(p, smem, 1, l);
    { const bool ctxo = l < DEPTH - 1; const int G = (int)gridDim.x, bid = obid();
        constexpr int QTL = SEQ / 128, QTC = CTXL / 128, N_AL = NB * 2 * QTL, N_AC = NB * 2 * QTC;
        for (int t = bid; t < N_AL; t += G) attn_task(p, l, t / (2 * QTL), (t / QTL) % 2, t % QTL, false, smem);
        if (ctxo) for (int t = (bid + G - 64 % G) % G; t < N_AC; t += G) attn_task(p, l, t / (2 * QTC), (t / QTC) % 2, t % QTC, true, smem); }
}

__device__ __forceinline__ void phase_mix2(const Params& p, int l, char* smem) {
    const int tid = otid();
    stage_wait(p, 1, l);
    chunk_workers<true>(p, l, smem);
    stage_wait(p, 2, l);
    constexpr int N_WOUT = (DM / 64) * (MIX / 64);
    { const int lane = tid & 63, wave = __builtin_amdgcn_readfirstlane(tid >> 6);
        const bool halfonly = (l < DEPTH - 1) && ((int)gridDim.x >= 2); const int GW = halfonly ? (int)gridDim.x / 2 : (int)gridDim.x;
        const int NW = GW * 8, wi = (obid() < GW) ? wave * GW + obid() : NW + (1 << 28);
        for (int task = NW - 1 - wi; task >= 0 && task < N_WOUT; task += NW) { const int nt = task / (MIX / 64), kt = task % (MIX / 64);
            convert_tile_w(p.in[I_WOUT] + (size_t)l * MIX * DM, DM, (bf16*)(p.ws + WS_WOUT), MIX, nt * 64, kt * 64, false, smem + wave * WLDS, lane); }
        bf16* tile = (bf16*)(smem + wave * WLDS); const bf16* HT = (const bf16*)(p.ws + WS_HT); bf16* Y = (bf16*)(p.ws + WS_HNY);
        constexpr int NTT = NB * (SEQ / 64) * 4;
        for (int t = wi; t < NTT; t += NW) { const int b = t / ((SEQ / 64) * 4), tt = (t / 4) % (SEQ / 64), c0 = (t % 4) * 64; const size_t tok0 = (size_t)b * TOK + CTXL + tt * 64;
            u32x4 tv[8];
#pragma unroll
            for (int i = 0; i < 8; ++i) { const int ch = (lane >> 3) + 8 * i, ck = lane & 7; tv[i] = *(const u32x4*)(HT + (size_t)(768 + c0 + ch) * T + tok0 + ck * 8); }
#pragma unroll
            for (int i = 0; i < 8; ++i) { const int ch = (lane >> 3) + 8 * i, ck = lane & 7; *(u32x4*)(tile + swz(ch, ck)) = tv[i]; }
            WAVE_SYNC();
#pragma unroll
            for (int i = 0; i < 8; ++i) { const int tk = (lane >> 3) + 8 * i, cc = lane & 7; unsigned w[4];
#pragma unroll
                for (int j = 0; j < 4; ++j) { const int ca = cc * 8 + 2 * j; w[j] = (unsigned)tile[swz(ca, tk >> 3) + (tk & 7)] | ((unsigned)tile[swz(ca + 1, tk >> 3) + (tk & 7)] << 16); }
                u32x4 o; o.x = w[0]; o.y = w[1]; o.z = w[2]; o.w = w[3]; *(u32x4*)(Y + (tok0 + tk) * 1024 + YH + c0 + cc * 8) = o; }
            WAVE_SYNC(); } }
}


#ifndef EMU
#define LAS __attribute__((address_space(3)))
#define XB_TMO      128
#define XB_XCNT(j)  (256  + 64 * (j))
#define XB_XSUB(j)  (1280 + 64 * (j))
#define XB_XGEN(j)  (2304 + 64 * (j))
#define XB_TOP      3328
#define XB_TOPGEN   3392
#define XCD_BAR_WORDS 3456
#define XB_SPIN_CAP (1u << 18)

__device__ __forceinline__ unsigned xb_ld(unsigned* p)              { return __hip_atomic_load(p, __ATOMIC_RELAXED, __HIP_MEMORY_SCOPE_AGENT); }
__device__ __forceinline__ unsigned xb_add(unsigned* p, unsigned v) { return __hip_atomic_fetch_add(p, v, __ATOMIC_RELAXED, __HIP_MEMORY_SCOPE_AGENT); }
__device__ __forceinline__ unsigned xb_xcc_id() { return (unsigned)__builtin_amdgcn_s_getreg((3 << 11) | 20) & 0xFu; }
#define XB_SPIN(cond, bar) do { unsigned _sp = 0; while (cond) { __builtin_amdgcn_s_sleep(1); \
    if ((++_sp & 255u) == 0u) { if (xb_ld(&(bar)[XB_TMO])) break; if (_sp > XB_SPIN_CAP) { atomicAdd(&(bar)[XB_TMO], 1u); break; } } } } while (0)

struct XcdBarrier {
    unsigned* bar; unsigned x;
    volatile LAS unsigned* st;
};

__device__ __forceinline__ XcdBarrier xcd_barrier_post(unsigned* bar, volatile LAS unsigned* st) {
    XcdBarrier b; b.bar = bar; b.x = xb_xcc_id(); b.st = st;
    if (threadIdx.x == 0) (void)xb_add(&bar[XB_XCNT(b.x)], 1u);
    return b;
}
__device__ __forceinline__ void xcd_barrier_complete(unsigned* bar, unsigned x, unsigned& nloc, unsigned& nx) {
    const unsigned G = gridDim.x * gridDim.y * gridDim.z;
    unsigned sum, cnt, mine, sp = 0u;
    for (;;) {
        sum = 0u; cnt = 0u; mine = 0u;
#pragma unroll
        for (unsigned j = 0; j < 16; ++j) { const unsigned c = xb_ld(&bar[XB_XCNT(j)]); sum += c; cnt += (c > 0u) ? 1u : 0u; mine = (j == x) ? c : mine; }
        if (sum == G) break;
        __builtin_amdgcn_s_sleep(1);
        if ((++sp & 255u) == 0u) { if (xb_ld(&bar[XB_TMO])) break; if (sp > XB_SPIN_CAP) { atomicAdd(&bar[XB_TMO], 1u); break; } }
    }
    nloc = mine > 0u ? mine : 1u; nx = cnt > 0u ? cnt : 1u;
}

__device__ __forceinline__ void xcd_barrier(const XcdBarrier& b) {
    asm volatile("s_waitcnt vmcnt(0)" ::: "memory");
    __syncthreads();
    if (threadIdx.x == 0) {
        unsigned* bar = b.bar;
        __builtin_amdgcn_s_waitcnt(0);
        unsigned nloc = b.st[0], nx = b.st[1];
        if (nloc == 0u) { xcd_barrier_complete(bar, b.x, nloc, nx); b.st[0] = nloc; b.st[1] = nx; }
        const unsigned old = xb_add(&bar[XB_XSUB(b.x)], 1u);
        const unsigned gen = old / nloc;
        if (old + 1u == (gen + 1u) * nloc) {
            __builtin_amdgcn_fence(__ATOMIC_RELEASE, "agent");
            asm volatile("s_waitcnt vmcnt(0)" ::: "memory");
            const unsigned og = xb_add(&bar[XB_TOP], 1u);
            const unsigned tg = og / nx;
            if (og + 1u == (tg + 1u) * nx) xb_add(&bar[XB_TOPGEN], 1u);
            else XB_SPIN(xb_ld(&bar[XB_TOPGEN]) == tg, bar);
            __builtin_amdgcn_fence(__ATOMIC_ACQUIRE, "agent");
            xb_add(&bar[XB_XGEN(b.x)], 1u);
            asm volatile("s_waitcnt vmcnt(0)" ::: "memory");
        } else {
            XB_SPIN(xb_ld(&bar[XB_XGEN(b.x)]) == gen, bar);
            __builtin_amdgcn_fence(__ATOMIC_ACQUIRE, "agent");
            asm volatile("s_waitcnt vmcnt(0)" ::: "memory");
        }
    }
    __syncthreads();
}
#endif

__global__ void __launch_bounds__(NT) fwd_kernel(Params pk, int ph_lo, int ph_hi) {
    SMEM_DECL;
#ifndef EMU
    volatile LAS unsigned* misc = (volatile LAS unsigned*)(smem + LDS_BYTES - 64);
    if (threadIdx.x < 2) misc[threadIdx.x] = 0u;
    __syncthreads();
    const XcdBarrier bar = xcd_barrier_post((unsigned*)(pk.ws + WS_BAR), misc);
#endif
    constexpr int NPH = 2 + 6 * DEPTH;
    for (int ph = ph_lo; ph < ph_hi && ph < NPH; ++ph) {
#ifndef EMU
        Params p = pk; { size_t z = 0; asm volatile("" : "+s"(z)); p.ws = pk.ws + z; p.out = pk.out + z;
#pragma unroll
            for (int i = 0; i < 26; ++i) p.in[i] = pk.in[i] + z; }
#else
        const Params& p = pk;
#endif
        if (ph == 0) phase0(p, smem);
        else if (ph == NPH - 1) phase_rp(p, DEPTH, smem);
        else { const int l = (ph - 1) / 6, k = (ph - 1) % 6;
            if (k == 0) phase_rp(p, l, smem);
            else if (k == 1) phase_gemm_in(p, l, smem);
            else if (k == 2) phase_mix1(p, l, smem);
            else if (k == 3) phase_scan(p, l, smem);
            else if (k == 4) phase_mix2(p, l, smem);
            else phase_gemm_out(p, l, smem);
#ifdef PROBE_DUP
            if (k == PROBE_DUP) { GRID_SYNC();
                if (k == 1) phase_gemm_in(p, l, smem); else if (k == 2) phase_mix1(p, l, smem); else if (k == 4) phase_mix2(p, l, smem); }
#endif
        }
        if (ph + 1 < ph_hi && !(ph >= 6 && ph % 6 == 0) && !(ph >= 1 && ((ph - 1) % 6 == 2 || (ph - 1) % 6 == 3))) {
#ifdef EMU
            GRID_SYNC();
#else
            if (ph_lo < 0) GRID_SYNC();
            xcd_barrier(bar);
#endif
        }
    }
}

#ifndef EMU
extern "C" void kernel_launch(void* const* d_in, const int* in_sizes, int n_in, void* d_out, int out_size, void* d_ws, size_t ws_size, hipStream_t stream) {
    static int grid = 0;
    if (grid == 0) {
        if (n_in != 26 || ws_size < WS_TOTAL) { fprintf(stderr, "kernel_launch: unexpected n_in %d or ws_size %zu (need %zu)\n", n_in, ws_size, (size_t)WS_TOTAL); grid = -1; return; }
        int dev = 0, cus = 0, per_cu = 0;
        hipGetDevice(&dev);
        hipDeviceGetAttribute(&cus, hipDeviceAttributeMultiprocessorCount, dev);
        hipFuncSetAttribute((const void*)fwd_kernel, hipFuncAttributeMaxDynamicSharedMemorySize, LDS_BYTES);
        hipOccupancyMaxActiveBlocksPerMultiprocessor(&per_cu, (const void*)fwd_kernel, NT, LDS_BYTES);
        if (per_cu < 1) { fprintf(stderr, "kernel_launch: occupancy query returned %d\n", per_cu); grid = -1; return; }
        if (per_cu > 1) per_cu = 1;
        grid = cus * per_cu;
    }
    if (grid < 0) return;
    hipMemsetAsync((char*)d_ws + WS_BAR, 0, BAR_BYTES, stream);
    Params p{};
    for (int i = 0; i < 26; ++i) p.in[i] = (const float*)d_in[i];
    p.out = (float*)d_out; p.ws = (char*)d_ws;
    int lo = 0, hi = 2 + 6 * DEPTH;
    void* args[] = {&p, &lo, &hi};
    hipError_t e = hipLaunchCooperativeKernel((const void*)fwd_kernel, dim3(grid), dim3(NT), args, LDS_BYTES, stream);
    if (e != hipSuccess) fprintf(stderr, "cooperative launch failed: %s (grid %d)\n", hipGetErrorString(e), grid);
}
#endif
```
